# Optimizing an MI355X kernel written in HIP

```python
import math
import jax, jax.numpy as jnp
from jax import lax
import numpy as np

D_MODEL = 1024
BATCH = 4
SEQ = 8192
DEPTH = 4

GRID_W = 64
CTX_LEN = 256
N_EVEN = (DEPTH + 1) // 2
N_ODD = DEPTH // 2

CONV_GROUPS = 4
D_CONV = 256
CONV_WIDTH = 3
RWKV_HEADS = 12
RWKV_HD = 64
D_RWKV = RWKV_HEADS * RWKV_HD
LORA_DECAY = 64
LORA_A = 64
LORA_G = 128
RWKV_COLS = 3 * D_RWKV + 2 * LORA_DECAY + 2 * LORA_A + LORA_G
D_IN_EVEN = 3 * D_CONV + RWKV_COLS
DECAY_SCALE = math.exp(-0.5)
GN_EPS = 64e-5
DIFF_HEADS = 6
DIFF_HD = 64
DIFF_VD = 2 * DIFF_HD
D_DIFF = DIFF_HEADS * DIFF_VD
AXIS_DIM = DIFF_HD // 2
ROPE_BASE = 10000.0
Q_BLOCK = 128
GMLP_GROUPS = 4
D_GMLP = 256
GMLP_GD = D_GMLP // GMLP_GROUPS
GMLP_CHUNK = 128
D_IN_ODD = 3 * D_DIFF + 2 * D_GMLP
N_EXPERTS = 16
EC_FACTOR = 2
D_EXPERT = 2048
ALPHA = (2.0 * DEPTH) ** 0.25
BETA = (8.0 * DEPTH) ** -0.25
LN_EPS = 1e-5
RMS_EPS = 1e-5

kernel_name = "hybrid_dit_conv_rwkv7_diffattn_gmlp_ecmoe"


def layer_norm(x, g, b, eps=LN_EPS):
    xf = x.astype(jnp.float32)
    mu = jnp.mean(xf, axis=-1, keepdims=True)
    var = jnp.mean(jnp.square(xf - mu), axis=-1, keepdims=True)
    return ((xf - mu) * lax.rsqrt(var + eps)).astype(x.dtype) * g + b


def rms_norm(x, g):
    xf = x.astype(jnp.float32)
    return (xf * lax.rsqrt(jnp.mean(jnp.square(xf), axis=-1, keepdims=True) + RMS_EPS)).astype(x.dtype) * g


def shift_prev(u):
    return jnp.pad(u, ((0, 0), (1, 0), (0, 0)))[:, :-1]


def shift_next(u):
    return jnp.pad(u, ((0, 0), (0, 1), (0, 0)))[:, 1:]


def short_conv_mixer(p, conv_w):
    bg, cg, xin = jnp.split(p, 3, axis=-1)
    u = cg * xin
    return bg * (conv_w[0] * shift_prev(u) + conv_w[1] * u + conv_w[2] * shift_next(u))


def rwkv_features(p, shift_mu, decay_up, decay_0, a_up, a_0, g_up, k_xi, k_alpha):
    B, T, _ = p.shape
    H, K = RWKV_HEADS, RWKV_HD
    p = p + shift_mu * (0.5 * (shift_prev(p) + shift_next(p)) - p)
    r, k, v, dd, da, dg = jnp.split(
        p, [D_RWKV, 2 * D_RWKV, 3 * D_RWKV, 3 * D_RWKV + 2 * LORA_DECAY,
            3 * D_RWKV + 2 * LORA_DECAY + 2 * LORA_A], axis=-1)
    dd = dd.reshape(B, T, 2, LORA_DECAY)
    da = da.reshape(B, T, 2, LORA_A)
    w = jnp.exp(-DECAY_SCALE * jax.nn.sigmoid(decay_0 + jnp.einsum("btdr,drc->btdc", jnp.tanh(dd), decay_up)))
    a = jax.nn.sigmoid(a_0 + jnp.einsum("btdr,drc->btdc", da, a_up))
    g = jax.nn.sigmoid(dg) @ g_up
    kk = (k * k_xi).reshape(B, T, H, K)
    kk = kk * lax.rsqrt(jnp.sum(jnp.square(kk.astype(jnp.float32)), axis=-1, keepdims=True) + 1e-12).astype(kk.dtype)
    w = w.reshape(B, T, 2, H, K)
    a = a.reshape(B, T, 2, H, K)
    k_rep = k.reshape(B, T, 1, H, K) * (1.0 + (a - 1.0) * k_alpha.reshape(H, K))
    return (r.reshape(B, T, H, K), w, kk, a, k_rep, v.reshape(B, T, H, K), g)


def wkv_scan(s0, feats, d, reverse):
    r, w, kk, a, k_rep, v, _ = feats

    def step(s, inp):
        r_t, w_t, kk_t, a_t, k_t, v_t = inp
        sa = jnp.einsum("bhvk,bhk->bhv", s, kk_t)
        s = (s * w_t[:, :, None, :] - sa[..., None] * (kk_t * a_t)[:, :, None, :]
             + v_t[..., None] * k_t[:, :, None, :])
        return s, jnp.einsum("bhvk,bhk->bhv", s, r_t)

    xs = tuple(jnp.swapaxes(z, 0, 1).astype(jnp.float32)
               for z in (r, w[:, :, d], kk, a[:, :, d], k_rep[:, :, d], v))
    s_final, ys = lax.scan(step, s0, xs, reverse=reverse)
    return s_final, jnp.swapaxes(ys, 0, 1)


def rwkv_output(y, feats, r_bonus, gn_g, gn_b):
    r, _, _, _, k_rep, v, g = feats
    B, T = r.shape[:2]
    H, K = RWKV_HEADS, RWKV_HD
    yn = layer_norm(y.astype(r.dtype), gn_g.reshape(H, K), gn_b.reshape(H, K), eps=GN_EPS)
    bonus = jnp.sum(r * jnp.mean(k_rep, axis=2) * r_bonus.reshape(H, K), axis=-1, keepdims=True) * v
    return g * (yn + bonus).reshape(B, T, D_RWKV)


def rwkv_mixer(pc, px, shift_mu, decay_up, decay_0, a_up, a_0, g_up, k_xi, k_alpha,
               r_bonus, gn_g, gn_b, ctx_out):
    fc = rwkv_features(pc, shift_mu, decay_up, decay_0, a_up, a_0, g_up, k_xi, k_alpha)
    fx = rwkv_features(px, shift_mu, decay_up, decay_0, a_up, a_0, g_up, k_xi, k_alpha)
    B = px.shape[0]
    y_c, y_x = [], []
    for d, rev in ((0, False), (1, True)):
        s0 = jnp.zeros((B, RWKV_HEADS, RWKV_HD, RWKV_HD), jnp.float32)
        s_ctx, yc_d = wkv_scan(s0, fc, d, rev)
        _, yx_d = wkv_scan(s_ctx, fx, d, rev)
        y_c.append(yc_d)
        y_x.append(yx_d)
    out_x = rwkv_output(y_x[0] + y_x[1], fx, r_bonus, gn_g, gn_b)
    out_c = rwkv_output(y_c[0] + y_c[1], fc, r_bonus, gn_g, gn_b) if ctx_out else None
    return out_c, out_x


def even_mixer(hc, hx, w_in, w_out, conv_w, shift_mu, decay_up, decay_0, a_up, a_0, g_up,
               k_xi, k_alpha, r_bonus, gn_g, gn_b, ctx_out):
    px = hx @ w_in
    pc = hc @ (w_in if ctx_out else w_in[:, 3 * D_CONV:])
    rw_c_in = pc[..., 3 * D_CONV:] if ctx_out else pc
    rw_c, rw_x = rwkv_mixer(rw_c_in, px[..., 3 * D_CONV:], shift_mu, decay_up, decay_0, a_up, a_0,
                            g_up, k_xi, k_alpha, r_bonus, gn_g, gn_b, ctx_out)
    yx = jnp.concatenate([short_conv_mixer(px[..., :3 * D_CONV], conv_w), rw_x], axis=-1) @ w_out
    yc = None
    if ctx_out:
        yc = jnp.concatenate([short_conv_mixer(pc[..., :3 * D_CONV], conv_w), rw_c], axis=-1) @ w_out
    return yc, yx


def axial_rope_tables(T):
    rows = T // GRID_W
    row = jnp.repeat(jnp.arange(rows), GRID_W).astype(jnp.float32)
    col = jnp.tile(jnp.arange(GRID_W), rows).astype(jnp.float32)
    inv = ROPE_BASE ** (-jnp.arange(0, AXIS_DIM, 2, dtype=jnp.float32) / AXIS_DIM)
    ang_r = row[:, None] * inv
    ang_c = col[:, None] * inv
    return jnp.cos(ang_r), jnp.sin(ang_r), jnp.cos(ang_c), jnp.sin(ang_c)


def rotate(x, cos, sin):
    x1, x2 = jnp.split(x, 2, axis=-1)
    cos = cos[None, :, None, None, :].astype(x.dtype)
    sin = sin[None, :, None, None, :].astype(x.dtype)
    return jnp.concatenate([x1 * cos - x2 * sin, x1 * sin + x2 * cos], axis=-1)


def axial_rope(x, tables):
    cr, sr, cc, sc = tables
    return jnp.concatenate([rotate(x[..., :AXIS_DIM], cr, sr), rotate(x[..., AXIS_DIM:], cc, sc)], axis=-1)


def diff_attn(q, k, v, lam):
    s = jnp.einsum("bhmqd,bhmkd->bhmqk", q, k).astype(jnp.float32) * (DIFF_HD ** -0.5)
    p = jax.nn.softmax(s, axis=-1)
    pd = (p[:, :, 0] - lam * p[:, :, 1]).astype(v.dtype)
    return jnp.einsum("bhqk,bhkv->bhqv", pd, v)


def diff_attention_mixer(qc, kc, vc, qx, kx, vx, lam_q1, lam_k1, lam_q2, lam_k2, subln_g, lam_init):
    B, T, _ = qx.shape
    tables = axial_rope_tables(T)

    def split_qk(z):
        return z.reshape(B, z.shape[1], DIFF_HEADS, 2, DIFF_HD)

    def to_bhm(z):
        return jnp.transpose(z, (0, 2, 3, 1, 4))

    def v_heads(z):
        return jnp.transpose(z.reshape(B, z.shape[1], DIFF_HEADS, DIFF_VD), (0, 2, 1, 3))

    def head_norm(o):
        return (rms_norm(o, subln_g) * (1.0 - lam_init)).reshape(B, o.shape[1], D_DIFF)

    lam = (jnp.exp(jnp.sum(lam_q1 * lam_k1).astype(jnp.float32))
           - jnp.exp(jnp.sum(lam_q2 * lam_k2).astype(jnp.float32)) + lam_init)
    kc_h, vc_h = to_bhm(split_qk(kc)), v_heads(vc)
    qx_h = to_bhm(axial_rope(split_qk(qx), tables))
    k_all = jnp.concatenate([kc_h, to_bhm(axial_rope(split_qk(kx), tables))], axis=3)
    v_all = jnp.concatenate([vc_h, v_heads(vx)], axis=2)
    nb = T // Q_BLOCK
    q_blocks = jnp.moveaxis(qx_h.reshape(B, DIFF_HEADS, 2, nb, Q_BLOCK, DIFF_HD), 3, 0)
    o_blocks = lax.map(lambda qb: diff_attn(qb, k_all, v_all, lam), q_blocks)
    out_x = head_norm(jnp.transpose(o_blocks, (1, 0, 3, 2, 4)).reshape(B, T, DIFF_HEADS, DIFF_VD))
    out_c = None
    if qc is not None:
        o_c = diff_attn(to_bhm(split_qk(qc)), kc_h, vc_h, lam)
        out_c = head_norm(jnp.transpose(o_c, (0, 2, 1, 3)))
    return out_c, out_x


def chunk_gmlp(p, ln_g, ln_b, ws, bs):
    B, T, _ = p.shape
    u, v = jnp.split(jax.nn.gelu(p, approximate=False), 2, axis=-1)
    v = layer_norm(v, ln_g, ln_b).reshape(B, T // GMLP_CHUNK, GMLP_CHUNK, GMLP_GROUPS, GMLP_GD)
    mixed = jnp.einsum("gpq,bnqgc->bnpgc", ws, v) + jnp.transpose(bs)[None, None, :, :, None]
    return u * mixed.reshape(B, T, D_GMLP)


def odd_mixer(hc, hx, w_in, w_out, lam_q1, lam_k1, lam_q2, lam_k2, subln_g,
              gmlp_ln_g, gmlp_ln_b, gmlp_ws, gmlp_bs, lam_init, ctx_out):
    px = hx @ w_in
    qx, kx, vx, gx = jnp.split(px, [D_DIFF, 2 * D_DIFF, 3 * D_DIFF], axis=-1)
    if ctx_out:
        qc, kc, vc, gc = jnp.split(hc @ w_in, [D_DIFF, 2 * D_DIFF, 3 * D_DIFF], axis=-1)
    else:
        kc, vc = jnp.split(hc @ w_in[:, D_DIFF:3 * D_DIFF], 2, axis=-1)
        qc, gc = None, None
    att_c, att_x = diff_attention_mixer(qc, kc, vc, qx, kx, vx, lam_q1, lam_k1, lam_q2, lam_k2,
                                        subln_g, lam_init)
    yx = jnp.concatenate([att_x, chunk_gmlp(gx, gmlp_ln_g, gmlp_ln_b, gmlp_ws, gmlp_bs)], axis=-1) @ w_out
    yc = None
    if ctx_out:
        yc = jnp.concatenate([att_c, chunk_gmlp(gc, gmlp_ln_g, gmlp_ln_b, gmlp_ws, gmlp_bs)], axis=-1) @ w_out
    return yc, yx


def expert_choice_ffn(h, w_router, w_e1, w_e3, w_e2):
    B, T, _ = h.shape
    cap = EC_FACTOR * T // N_EXPERTS
    aff = jax.nn.softmax(jnp.einsum("btd,de->bte", h, w_router).astype(jnp.float32), axis=-1)
    gate, idx = lax.top_k(jnp.swapaxes(aff, 1, 2), cap)
    b_idx = jnp.arange(B)[:, None, None]
    xs = h[b_idx, idx]
    hid = jax.nn.silu(jnp.einsum("becd,edf->becf", xs, w_e1)) * jnp.einsum("becd,edf->becf", xs, w_e3)
    ye = jnp.einsum("becf,efd->becd", hid, w_e2) * gate[..., None].astype(h.dtype)
    return jnp.zeros_like(h).at[b_idx, idx].add(ye)


def setup_inputs(seed: int = 0) -> dict:
    key = jax.random.key(seed)
    D = D_MODEL
    specs = [
        ("x", (BATCH, SEQ, D), "n", 0.0, 1.0),
        ("c", (BATCH, D), "n", 0.0, 1.0),
        ("ctx", (BATCH, CTX_LEN, D), "n", 0.0, 1.0),
        ("c_ctx", (D,), "n", 0.0, 1.0),
        ("w_mod", (DEPTH, D, 6 * D), "n", 0.0, 0.5 * D ** -0.5),
        ("b_mod", (DEPTH, 6 * D), "n", 0.0, 0.02),
        ("ln_g", (DEPTH, 2, D), "n", 1.0, 0.02),
        ("ln_b", (DEPTH, 2, D), "n", 0.0, 0.02),
        ("even_w_in", (N_EVEN, D, D_IN_EVEN), "n", 0.0, D ** -0.5),
        ("even_w_out", (N_EVEN, D_CONV + D_RWKV, D), "n", 0.0, BETA * (D_CONV + D_RWKV) ** -0.5),
        ("conv_w", (N_EVEN, CONV_WIDTH, D_CONV), "n", 0.0, CONV_WIDTH ** -0.5),
        ("shift_mu", (N_EVEN, RWKV_COLS), "u", 0.0, 1.0),
        ("decay_up", (N_EVEN, 2, LORA_DECAY, D_RWKV), "n", 0.0, 0.1 * LORA_DECAY ** -0.5),
        ("decay_0", (N_EVEN, 2, D_RWKV), "n", 0.0, 1.0),
        ("a_up", (N_EVEN, 2, LORA_A, D_RWKV), "n", 0.0, 0.5 * LORA_A ** -0.5),
        ("a_0", (N_EVEN, 2, D_RWKV), "n", 0.0, 1.0),
        ("g_up", (N_EVEN, LORA_G, D_RWKV), "n", 0.0, LORA_G ** -0.5),
        ("k_xi", (N_EVEN, D_RWKV), "n", 0.85, 0.05),
        ("k_alpha", (N_EVEN, D_RWKV), "n", 1.0, 0.05),
        ("r_bonus", (N_EVEN, D_RWKV), "n", 0.0, 0.1),
        ("gn_g", (N_EVEN, D_RWKV), "n", 1.0, 0.02),
        ("gn_b", (N_EVEN, D_RWKV), "n", 0.0, 0.02),
        ("odd_w_in", (N_ODD, D, D_IN_ODD), "n", 0.0, D ** -0.5),
        ("odd_w_out", (N_ODD, D_DIFF + D_GMLP, D), "n", 0.0, BETA * (D_DIFF + D_GMLP) ** -0.5),
        ("lam_q1", (N_ODD, DIFF_HD), "n", 0.0, 0.1),
        ("lam_k1", (N_ODD, DIFF_HD), "n", 0.0, 0.1),
        ("lam_q2", (N_ODD, DIFF_HD), "n", 0.0, 0.1),
        ("lam_k2", (N_ODD, DIFF_HD), "n", 0.0, 0.1),
        ("subln_g", (N_ODD, DIFF_VD), "n", 1.0, 0.02),
        ("gmlp_ln_g", (N_ODD, D_GMLP), "n", 1.0, 0.02),
        ("gmlp_ln_b", (N_ODD, D_GMLP), "n", 0.0, 0.02),
        ("gmlp_ws", (N_ODD, GMLP_GROUPS, GMLP_CHUNK, GMLP_CHUNK), "n", 0.0, 0.5 * GMLP_CHUNK ** -0.5),
        ("gmlp_bs", (N_ODD, GMLP_GROUPS, GMLP_CHUNK), "n", 1.0, 0.1),
        ("w_router", (DEPTH, D, N_EXPERTS), "n", 0.0, D ** -0.5),
        ("w_e1", (DEPTH, N_EXPERTS, D, D_EXPERT), "n", 0.0, D ** -0.5),
        ("w_e3", (DEPTH, N_EXPERTS, D, D_EXPERT), "n", 0.0, D ** -0.5),
        ("w_e2", (DEPTH, N_EXPERTS, D_EXPERT, D), "n", 0.0, BETA * D_EXPERT ** -0.5),
    ]
    keys = jax.random.split(key, len(specs))
    out = {}
    for i, (name, shape, kind, centre, scale) in enumerate(specs):
        if kind == "u":
            sample = jax.random.uniform(keys[i], shape, jnp.float32)
        else:
            sample = jax.random.normal(keys[i], shape, jnp.float32)
        out[name] = centre + scale * sample
    return out


def reference(x, c, ctx, c_ctx, w_mod, b_mod, ln_g, ln_b, even_w_in, even_w_out, conv_w, shift_mu,
              decay_up, decay_0, a_up, a_0, g_up, k_xi, k_alpha, r_bonus, gn_g, gn_b,
              odd_w_in, odd_w_out, lam_q1, lam_k1, lam_q2, lam_k2, subln_g, gmlp_ln_g, gmlp_ln_b,
              gmlp_ws, gmlp_bs, w_router, w_e1, w_e3, w_e2):
    for l in range(DEPTH):
        ctx_out = l < DEPTH - 1
        i = l // 2
        mod_x = jax.nn.silu(c) @ w_mod[l] + b_mod[l]
        mod_c = jax.nn.silu(c_ctx) @ w_mod[l] + b_mod[l]
        sh_m, sc_m, g_m, sh_f, sc_f, g_f = jnp.split(mod_x[:, None, :], 6, axis=-1)
        csh_m, csc_m, cg_m, csh_f, csc_f, cg_f = jnp.split(mod_c, 6)
        hx = x * (1.0 + sc_m) + sh_m
        hc = ctx * (1.0 + csc_m) + csh_m
        if l % 2 == 0:
            yc, yx = even_mixer(hc, hx, even_w_in[i], even_w_out[i], conv_w[i], shift_mu[i],
                                decay_up[i], decay_0[i], a_up[i], a_0[i], g_up[i], k_xi[i],
                                k_alpha[i], r_bonus[i], gn_g[i], gn_b[i], ctx_out)
        else:
            lam_init = 0.8 - 0.6 * math.exp(-0.3 * l)
            yc, yx = odd_mixer(hc, hx, odd_w_in[i], odd_w_out[i], lam_q1[i], lam_k1[i], lam_q2[i],
                               lam_k2[i], subln_g[i], gmlp_ln_g[i], gmlp_ln_b[i], gmlp_ws[i],
                               gmlp_bs[i], lam_init, ctx_out)
        x = layer_norm(ALPHA * x + g_m * yx, ln_g[l, 0], ln_b[l, 0])
        x = layer_norm(ALPHA * x + g_f * expert_choice_ffn(x * (1.0 + sc_f) + sh_f, w_router[l],
                                                           w_e1[l], w_e3[l], w_e2[l]),
                       ln_g[l, 1], ln_b[l, 1])
        if ctx_out:
            ctx = layer_norm(ALPHA * ctx + cg_m * yc, ln_g[l, 0], ln_b[l, 0])
            ctx = layer_norm(ALPHA * ctx + cg_f * expert_choice_ffn(ctx * (1.0 + csc_f) + csh_f, w_router[l],
                                                                    w_e1[l], w_e3[l], w_e2[l]),
                             ln_g[l, 1], ln_b[l, 1])
    return x
```

```cpp
#include <hip/hip_runtime.h>
#include <cstdio>
#include <cstdint>
#include <cmath>

#ifndef MK_MULTI
#define MK_MULTI 1
#endif

#define GAS __attribute__((address_space(1)))
#define LAS __attribute__((address_space(3)))
typedef unsigned short bf16_t;
typedef short bf16x8 __attribute__((ext_vector_type(8)));
typedef float f32x4 __attribute__((ext_vector_type(4)));
typedef float f32x2 __attribute__((ext_vector_type(2)));
typedef float f32x16 __attribute__((ext_vector_type(16)));
typedef unsigned u32x4 __attribute__((ext_vector_type(4)));
typedef unsigned u32x2 __attribute__((ext_vector_type(2)));
typedef __bf16 bf16x2_t __attribute__((ext_vector_type(2)));

constexpr int NB = 4, TT = 8192, DM = 1024, NLAT = NB * TT, CTXL = 256, NCTX = NB * CTXL, MROWS = NLAT + NCTX;
constexpr int DEPTH = 4;
constexpr int D_CONV = 256, RW_H = 12, RW_K = 64, D_RWKV = 768, RWKV_COLS = 2688, D_IN_EVEN = 3456, D_IN_EVEN_PAD = 3584;
constexpr int D_DIFF = 768, D_GMLP = 256, D_IN_ODD = 2816;
constexpr int NEXP = 16, D_EXP = 2048, CAP_L = 1024, CAP_C = 32, ESLOTS = 4352;
constexpr int P_LD = 3584;
constexpr int LORA_K = 384, LORA_N = 3840;
constexpr int LKEYS = CTXL + TT;
constexpr float ALPHA_DN = 1.6817928305074290f;
constexpr float DECAY_SCALE = 0.6065306597126334f;
constexpr float GN_EPS = 64e-5f, LN_EPS = 1e-5f, RMS_EPS = 1e-5f;

constexpr size_t al256(size_t x) { return (x + 255) & ~(size_t)255; }
constexpr size_t WS_CTL = 0;
constexpr size_t CTL_BYTES = 65536;
constexpr size_t WS_MOD = WS_CTL + CTL_BYTES;
constexpr size_t WS_WIN = WS_MOD + al256((size_t)DEPTH * 5 * 6144 * 4);
constexpr size_t WS_WOUT = WS_WIN + (size_t)D_IN_EVEN_PAD * DM * 2;
constexpr size_t WS_WLORA = WS_WOUT + (size_t)DM * DM * 2;
constexpr size_t WS_WE13 = WS_WLORA + (size_t)LORA_N * LORA_K * 2;
constexpr size_t WS_WE2 = WS_WE13 + (size_t)NEXP * 4096 * DM * 2;
constexpr size_t WS_X = WS_WE2 + (size_t)NEXP * DM * D_EXP * 2;
constexpr size_t WS_H = WS_X + (size_t)MROWS * DM * 4;
constexpr size_t WS_A2 = WS_H + (size_t)MROWS * DM * 2;
constexpr size_t WS_P = WS_A2 + (size_t)MROWS * DM * 2;
constexpr size_t WS_AFF = WS_P + (size_t)MROWS * P_LD * 2;
constexpr size_t WS_SLOT = WS_AFF + (size_t)MROWS * 16 * 4;
constexpr size_t WS_IDX = WS_SLOT + (size_t)MROWS * 16 * 4;
constexpr size_t WS_GATE = WS_IDX + al256((size_t)NEXP * ESLOTS * 4);
constexpr size_t WS_R2 = WS_GATE + al256((size_t)NEXP * ESLOTS * 4);
constexpr size_t WS_SCN = WS_R2;
constexpr size_t WS_G = WS_SCN + (size_t)MROWS * 12 * 9 * 64 * 4;
constexpr size_t WS_LIN = WS_G + (size_t)MROWS * 768 * 2;
constexpr size_t WS_EVEN_END = WS_LIN + (size_t)MROWS * 384 * 2;
constexpr size_t WS_Y = WS_P;
constexpr size_t WS_Q = WS_R2;
constexpr size_t WS_KA = WS_Q + (size_t)MROWS * 768 * 2;
constexpr size_t WS_VT = WS_KA + (size_t)NB * LKEYS * 768 * 2;
constexpr size_t WS_HID = WS_R2;
constexpr size_t WS_YE = WS_HID + (size_t)NEXP * ESLOTS * D_EXP * 2;
constexpr size_t WS_END = WS_EVEN_END;
static_assert(WS_END <= (size_t)2147483648ull, "workspace over 2 GiB");
static_assert((size_t)2 * MROWS * 768 * 4 <= (size_t)MROWS * P_LD * 2, "Y aliases P");
static_assert(WS_YE + (size_t)NEXP * ESLOTS * DM * 2 <= WS_END, "moe region");

constexpr int LDS_BYTES = 147456;
constexpr int LDS_MISC = 140 * 1024;
constexpr int LDS_PTAB = LDS_MISC + 256;
constexpr int NWAVES = 8, NTHR = 512;

__device__ __forceinline__ unsigned f2bf(float f) { unsigned u = __float_as_uint(f); return (u + 0x7fffu + ((u >> 16) & 1u)) >> 16; }
__device__ __forceinline__ unsigned pk2(float lo, float hi) { f32x2 v = {lo, hi}; bf16x2_t b = __builtin_convertvector(v, bf16x2_t); return __builtin_bit_cast(unsigned, b); }
__device__ __forceinline__ float bflo(unsigned u) { return __uint_as_float(u << 16); }
__device__ __forceinline__ float bfhi(unsigned u) { return __uint_as_float(u & 0xffff0000u); }
__device__ __forceinline__ float bf2f(bf16_t b) { return __uint_as_float((unsigned)b << 16); }
__device__ __forceinline__ float sigmoidf_(float x) { return 1.f / (1.f + __expf(-x)); }
__device__ __forceinline__ float wave_sum(float v) {
#pragma unroll
    for (int o = 1; o < 64; o <<= 1) v += __shfl_xor(v, o);
    return v;
}
__device__ __forceinline__ float sum16(float v) {
#pragma unroll
    for (int o = 1; o < 16; o <<= 1) v += __shfl_xor(v, o);
    return v;
}
__device__ __forceinline__ float gelu_erf(float x) { return 0.5f * x * (1.f + erff(x * 0.70710678118654752f)); }

#define XB_TMO      128
#define XB_XCNT(j)  (256  + 64 * (j))
#define XB_XSUB(j)  (1280 + 64 * (j))
#define XB_XGEN(j)  (2304 + 64 * (j))
#define XB_TOP      3328
#define XB_TOPGEN   3392
#define XCD_BAR_WORDS 3456
#define XB_SPIN_CAP (1u << 20)

__device__ __forceinline__ unsigned xb_ld(unsigned* p)              { return __hip_atomic_load(p, __ATOMIC_RELAXED, __HIP_MEMORY_SCOPE_AGENT); }
__device__ __forceinline__ unsigned xb_add(unsigned* p, unsigned v) { return __hip_atomic_fetch_add(p, v, __ATOMIC_RELAXED, __HIP_MEMORY_SCOPE_AGENT); }
__device__ __forceinline__ unsigned xb_xcc_id() { return (unsigned)__builtin_amdgcn_s_getreg((3 << 11) | 20) & 0xFu; }
#define XB_SPIN(cond, bar) do { unsigned _sp = 0; while (cond) { __builtin_amdgcn_s_sleep(1); \
    if ((++_sp & 255u) == 0u) { if (xb_ld(&(bar)[XB_TMO])) break; if (_sp > XB_SPIN_CAP) { atomicAdd(&(bar)[XB_TMO], 1u); break; } } } } while (0)

struct XcdBarrier { unsigned* bar; unsigned x; volatile LAS unsigned* st; };

__device__ __forceinline__ XcdBarrier xcd_barrier_post(unsigned* bar, volatile LAS unsigned* st) {
    XcdBarrier b; b.bar = bar; b.x = xb_xcc_id(); b.st = st;
    if (threadIdx.x == 0) (void)xb_add(&bar[XB_XCNT(b.x)], 1u);
    return b;
}
__device__ __forceinline__ void xcd_barrier_complete(unsigned* bar, unsigned x, unsigned& nloc, unsigned& nx) {
    const unsigned G = gridDim.x * gridDim.y * gridDim.z;
    unsigned sum, cnt, mine, sp = 0u;
    for (;;) {
        sum = 0u; cnt = 0u; mine = 0u;
#pragma unroll
        for (unsigned j = 0; j < 16; ++j) { const unsigned c = xb_ld(&bar[XB_XCNT(j)]); sum += c; cnt += (c > 0u) ? 1u : 0u; mine = (j == x) ? c : mine; }
        if (sum == G) break;
        __builtin_amdgcn_s_sleep(1);
        if ((++sp & 255u) == 0u) { if (xb_ld(&bar[XB_TMO])) break; if (sp > XB_SPIN_CAP) { atomicAdd(&bar[XB_TMO], 1u); break; } }
    }
    nloc = mine > 0u ? mine : 1u; nx = cnt > 0u ? cnt : 1u;
}
__device__ __forceinline__ void xcd_barrier(const XcdBarrier& b) {
    asm volatile("s_waitcnt vmcnt(0)" ::: "memory");
    __syncthreads();
    if (threadIdx.x == 0) {
        unsigned* bar = b.bar;
        __builtin_amdgcn_s_waitcnt(0);
        unsigned nloc = b.st[0], nx = b.st[1];
        if (nloc == 0u) { xcd_barrier_complete(bar, b.x, nloc, nx); b.st[0] = nloc; b.st[1] = nx; }
        const unsigned old = xb_add(&bar[XB_XSUB(b.x)], 1u);
        const unsigned gen = old / nloc;
        if (old + 1u == (gen + 1u) * nloc) {
            __builtin_amdgcn_fence(__ATOMIC_RELEASE, "agent");
            asm volatile("s_waitcnt vmcnt(0)" ::: "memory");
            const unsigned og = xb_add(&bar[XB_TOP], 1u);
            const unsigned tg = og / nx;
            if (og + 1u == (tg + 1u) * nx) xb_add(&bar[XB_TOPGEN], 1u);
            else XB_SPIN(xb_ld(&bar[XB_TOPGEN]) == tg, bar);
            __builtin_amdgcn_fence(__ATOMIC_ACQUIRE, "agent");
            xb_add(&bar[XB_XGEN(b.x)], 1u);
            asm volatile("s_waitcnt vmcnt(0)" ::: "memory");
        } else {
            XB_SPIN(xb_ld(&bar[XB_XGEN(b.x)]) == gen, bar);
            __builtin_amdgcn_fence(__ATOMIC_ACQUIRE, "agent");
            asm volatile("s_waitcnt vmcnt(0)" ::: "memory");
        }
    }
    __syncthreads();
}

namespace pg8 {
constexpr int BM = 256, BK = 64, HALF = 128, HTB = HALF * BK * 2, STAGE_BYTES = 8 * HTB, NXCD = 8, WGM = 8;
__host__ __device__ __forceinline__ int lds_byte(int r, int c) { const int st = (r >> 4) * 2 + (c >> 5), rr = r & 15, cc = c & 31, ob = rr * 64 + cc * 2; return st * 1024 + (ob ^ (((ob >> 9) & 1) << 5)); }
__host__ __device__ __forceinline__ void stage_rc(int b, int& R, int& C) { const int st = b / 1024, sb = b % 1024, swz = sb ^ (((sb >> 9) & 1) << 5); R = (st >> 1) * 16 + swz / 64; C = (st & 1) * 32 + (swz % 64) / 2; }

struct Unit { int pm, pn; };
struct Gemm { const bf16_t* A; const bf16_t* Bt; int K; };

template <int MODE> struct Order {
    int nM, nN, nwg, G, c; const int* idx; long bstride;
    __device__ __forceinline__ void init(int nM_, int nN_, int G_, int c_, const int* idx_, long bstride_) { nM = nM_; nN = nN_; nwg = nM * nN; G = G_; c = c_; idx = idx_; bstride = bstride_; }
    __device__ __forceinline__ bool next(int i, Unit& u) const {
        const long L = (long)i * G + c; if (L >= nwg) return false;
        int wgid = (int)L; { const int q = nwg / NXCD, r = nwg % NXCD, xcd = wgid % NXCD, off = wgid / NXCD; wgid = (xcd < r ? xcd * (q + 1) : r * (q + 1) + (xcd - r) * q) + off; }
        const int nig = WGM * nN, gid = wgid / nig, fm = gid * WGM, gsz = (nM - fm) < WGM ? (nM - fm) : WGM;
        u.pm = fm + ((wgid % nig) % gsz); u.pn = (wgid % nig) / gsz; return true;
    }
    __device__ __forceinline__ unsigned arow(const Unit& u, int r) const { if (MODE == 1) return (unsigned)idx[u.pm * BM + r]; return (unsigned)(u.pm * BM + r); }
    __device__ __forceinline__ long bbase(const Unit& u, int K) const { long o = (long)u.pn * BM * K; if (MODE != 0) o += (long)(u.pm / 17) * bstride; return o; }
};

template <class Epi, class Sched>
__device__ __forceinline__ void gemm_phase(LAS unsigned char* lds, const Gemm g, const Sched& S, const Epi& E) {
    int tid = threadIdx.x; asm volatile("" : "+v"(tid));
    const int wid = __builtin_amdgcn_readfirstlane(tid >> 6), wr = wid >> 2, wc = wid & 3;
    const int K = g.K, nt = K / BK;
    unsigned voffB[2];
    { const int lane = tid & 63, fr = lane & 15, fq = lane >> 4; (void)fr; (void)fq; }
#pragma unroll
    for (int i = 0; i < 2; ++i) { int R, Cc; stage_rc(tid * 16 + i * 8192, R, Cc); voffB[i] = (unsigned)(R * K + Cc) * 2u; }
    const size_t kstep = (size_t)(BK * 2);
    const size_t hstep = (size_t)HALF * K * 2;
    const unsigned ldsw = (unsigned)wid * 1024u;
    const int aoff = lds_byte(wr * 64 + (tid & 15), ((tid & 63) >> 4) * 8), boff = lds_byte(wc * 32 + (tid & 15), ((tid & 63) >> 4) * 8);
#define PG8_SA(b, h) (((b) * 2 + (h)) * HTB)
#define PG8_SB(b, h) ((4 + (b) * 2 + (h)) * HTB)
#define PG8_STAGE(bufoff, gbase, voff) do { _Pragma("unroll") for (int _i = 0; _i < 2; ++_i) \
        __builtin_amdgcn_global_load_lds((const unsigned*)((const char*)(gbase) + (voff)[_i]), (LAS unsigned*)(lds + (bufoff) + ldsw + _i * 8192), 16, 0, 0); } while (0)
#define PG8_LDA(dst, b, h) do { _Pragma("unroll") for (int m = 0; m < 4; ++m) _Pragma("unroll") for (int k = 0; k < 2; ++k) dst[m][k] = *(const LAS bf16x8*)(lds + PG8_SA(b, h) + aoff + m * 2048 + k * 1024); } while (0)
#define PG8_LDB(dst, b, h) do { _Pragma("unroll") for (int n = 0; n < 2; ++n) _Pragma("unroll") for (int k = 0; k < 2; ++k) dst[n][k] = *(const LAS bf16x8*)(lds + PG8_SB(b, h) + boff + n * 2048 + k * 1024); } while (0)
#define PG8_MMA(ai, bj, At, Bt) do { __builtin_amdgcn_s_setprio(1); _Pragma("unroll") for (int m = 0; m < 4; ++m) _Pragma("unroll") for (int n = 0; n < 2; ++n) _Pragma("unroll") for (int k = 0; k < 2; ++k) \
        acc[ai][bj][m][n] = __builtin_amdgcn_mfma_f32_16x16x32_bf16(Bt[n][k], At[m][k], acc[ai][bj][m][n], 0, 0, 0); __builtin_amdgcn_s_setprio(0); } while (0)
#define PG8_WAIT_V(n) asm volatile("s_waitcnt vmcnt(" #n ")" ::: "memory")
#define PG8_WAIT_L(n) asm volatile("s_waitcnt lgkmcnt(" #n ")" ::: "memory")
#define PG8_BAR __builtin_amdgcn_s_barrier()
#define PG8_SCHED __builtin_amdgcn_sched_barrier(0)
#define PG8_ROWOFFS(dst, u, tq) do { _Pragma("unroll") for (int _i = 0; _i < 2; ++_i) { int _R, _C; stage_rc((tq) * 16 + _i * 8192, _R, _C); _Pragma("unroll") for (int _h = 0; _h < 2; ++_h) dst[_h][_i] = (S.arow(u, _h * HALF + _R) * (unsigned)K + (unsigned)_C) * 2u; } } while (0)
    Unit cur, nxt; int ui = 0;
    if (!S.next(0, cur)) return;
    f32x4 acc[2][2][4][2];
#pragma unroll
    for (int a = 0; a < 2; ++a)
#pragma unroll
        for (int b = 0; b < 2; ++b)
#pragma unroll
            for (int m = 0; m < 4; ++m)
#pragma unroll
                for (int n = 0; n < 2; ++n) acc[a][b][m][n] = (f32x4){0.f, 0.f, 0.f, 0.f};
    bf16x8 At[4][2], B0[2][2], B1[2][2];
    unsigned vcur[2][2];
    PG8_ROWOFFS(vcur, cur, tid);
    const char* const Ab = (const char*)g.A;
    const char* cB = (const char*)g.Bt + (size_t)S.bbase(cur, K) * 2;
    PG8_STAGE(PG8_SB(0, 0), cB, voffB); PG8_STAGE(PG8_SA(0, 0), Ab, vcur[0]); PG8_STAGE(PG8_SB(0, 1), cB + hstep, voffB); PG8_STAGE(PG8_SA(0, 1), Ab, vcur[1]);
    if (wr == 1) PG8_BAR;
    PG8_WAIT_V(4); PG8_BAR;
    PG8_STAGE(PG8_SB(1, 0), cB + kstep, voffB); PG8_STAGE(PG8_SA(1, 0), Ab + kstep, vcur[0]); PG8_STAGE(PG8_SB(1, 1), cB + hstep + kstep, voffB);
    PG8_WAIT_V(6); PG8_BAR;
    for (;;) {
        const bool has_next = S.next(ui + 1, nxt);
        const char* nB = has_next ? (const char*)g.Bt + (size_t)S.bbase(nxt, K) * 2 : cB;
        for (int t = 0; t < nt; t += 2) {
            const bool last = (t == nt - 2);
            const char* a1 = Ab + (size_t)(t + 1) * kstep;
            const char* a2 = last ? Ab : Ab + (size_t)(t + 2) * kstep; const char* b2 = last ? nB : cB + (size_t)(t + 2) * kstep;
            const char* a3 = a2 + kstep; const char* b3 = b2 + kstep;
            PG8_LDB(B0, 0, 0); PG8_SCHED; PG8_LDA(At, 0, 0); PG8_STAGE(PG8_SA(1, 1), a1, vcur[1]);
            PG8_WAIT_L(8); PG8_BAR; PG8_WAIT_L(0); PG8_MMA(0, 0, At, B0); PG8_BAR; PG8_SCHED;
            if (last && has_next) { int tq = tid; asm volatile("" : "+v"(tq)); PG8_ROWOFFS(vcur, nxt, tq); }
            PG8_LDB(B1, 0, 1); PG8_STAGE(PG8_SB(0, 0), b2, voffB);
            PG8_BAR; PG8_WAIT_L(0); PG8_MMA(0, 1, At, B1); PG8_BAR;
            PG8_LDA(At, 0, 1); PG8_STAGE(PG8_SA(0, 0), a2, vcur[0]);
            PG8_BAR; PG8_WAIT_L(0); PG8_MMA(1, 0, At, B0); PG8_BAR; PG8_SCHED;
            PG8_STAGE(PG8_SB(0, 1), b2 + hstep, voffB);
            PG8_WAIT_V(6); PG8_BAR; PG8_MMA(1, 1, At, B1); PG8_BAR;
            PG8_LDB(B0, 1, 0); PG8_SCHED; PG8_LDA(At, 1, 0); PG8_STAGE(PG8_SA(0, 1), a2, vcur[1]);
            PG8_WAIT_L(8); PG8_BAR; PG8_WAIT_L(0); PG8_MMA(0, 0, At, B0); PG8_BAR; PG8_SCHED;
            PG8_LDB(B1, 1, 1); PG8_STAGE(PG8_SB(1, 0), b3, voffB);
            PG8_BAR; PG8_WAIT_L(0); PG8_MMA(0, 1, At, B1); PG8_BAR;
            PG8_LDA(At, 1, 1); PG8_STAGE(PG8_SA(1, 0), a3, vcur[0]);
            PG8_BAR; PG8_WAIT_L(0); PG8_MMA(1, 0, At, B0); PG8_BAR; PG8_SCHED;
            PG8_STAGE(PG8_SB(1, 1), b3 + hstep, voffB);
            PG8_WAIT_V(6); PG8_BAR; PG8_MMA(1, 1, At, B1); PG8_BAR;
        }
        { int tz = tid; asm volatile("" : "+v"(tz)); const int ln = tz & 63; E(acc, cur, wr, wc, ln & 15, ln >> 4); }
        if (!has_next) break;
#pragma unroll
        for (int a = 0; a < 2; ++a)
#pragma unroll
            for (int b = 0; b < 2; ++b)
#pragma unroll
                for (int m = 0; m < 4; ++m)
#pragma unroll
                    for (int n = 0; n < 2; ++n) acc[a][b][m][n] = (f32x4){0.f, 0.f, 0.f, 0.f};
        cur = nxt; cB = nB; ++ui;
    }
    PG8_WAIT_V(0);
    if (wr == 0) PG8_BAR;
    PG8_BAR;
#undef PG8_SA
#undef PG8_SB
#undef PG8_STAGE
#undef PG8_LDA
#undef PG8_LDB
#undef PG8_MMA
#undef PG8_WAIT_V
#undef PG8_WAIT_L
#undef PG8_BAR
#undef PG8_SCHED
#undef PG8_ROWOFFS
}

#define EPI_LOOP for (int ai = 0; ai < 2; ++ai) for (int m = 0; m < 4; ++m) for (int bj = 0; bj < 2; ++bj) for (int n = 0; n < 2; ++n)
struct EpiBf16 {
    bf16_t* O; int ldc;
    __device__ __forceinline__ void operator()(const f32x4 (&acc)[2][2][4][2], const Unit& u, int wr, int wc, int fr, int fq) const {
        const int row0 = u.pm * BM + wr * 64 + fr, col0 = u.pn * BM + wc * 32 + 4 * fq;
#pragma unroll
        for (int ai = 0; ai < 2; ++ai)
#pragma unroll
            for (int m = 0; m < 4; ++m) { bf16_t* rowp = O + (size_t)(row0 + ai * HALF + m * 16) * ldc + col0;
#pragma unroll
                for (int bj = 0; bj < 2; ++bj)
#pragma unroll
                    for (int n = 0; n < 2; ++n) { const f32x4 v = acc[ai][bj][m][n]; u32x2 o; o.x = pk2(v[0], v[1]); o.y = pk2(v[2], v[3]); *(u32x2*)(rowp + bj * HALF + n * 16) = o; } }
    }
};
struct EpiRes {
    float* X; const float* modl;
    __device__ __forceinline__ void operator()(const f32x4 (&acc)[2][2][4][2], const Unit& u, int wr, int wc, int fr, int fq) const {
        const int row0 = u.pm * BM + wr * 64 + fr, col0 = u.pn * BM + wc * 32 + 4 * fq;
        const int mi = (u.pm * BM < NLAT) ? (u.pm * BM) / TT : 4;
        const float* gate = modl + mi * 6144 + 2 * DM;
        f32x4 gv[2][2];
#pragma unroll
        for (int bj = 0; bj < 2; ++bj)
#pragma unroll
            for (int n = 0; n < 2; ++n) gv[bj][n] = *(const f32x4*)(gate + col0 + bj * HALF + n * 16);
#pragma unroll
        for (int ai = 0; ai < 2; ++ai)
#pragma unroll
            for (int m = 0; m < 4; ++m) { float* rowp = X + (size_t)(row0 + ai * HALF + m * 16) * DM + col0;
#pragma unroll
                for (int bj = 0; bj < 2; ++bj)
#pragma unroll
                    for (int n = 0; n < 2; ++n) { f32x4* p = (f32x4*)(rowp + bj * HALF + n * 16); const f32x4 x = *p; *p = x * ALPHA_DN + gv[bj][n] * acc[ai][bj][m][n]; } }
    }
};
struct EpiSwiGLU {
    bf16_t* HID;
    __device__ __forceinline__ void operator()(const f32x4 (&acc)[2][2][4][2], const Unit& u, int wr, int wc, int fr, int fq) const {
        const int row0 = u.pm * BM + wr * 64 + fr, f0 = u.pn * HALF + wc * 32 + 4 * fq;
#pragma unroll
        for (int ai = 0; ai < 2; ++ai)
#pragma unroll
            for (int m = 0; m < 4; ++m) { bf16_t* rowp = HID + (size_t)(row0 + ai * HALF + m * 16) * D_EXP + f0;
#pragma unroll
                for (int n = 0; n < 2; ++n) { const f32x4 a = acc[ai][0][m][n], b = acc[ai][1][m][n]; float h[4];
#pragma unroll
                    for (int j = 0; j < 4; ++j) h[j] = a[j] / (1.f + __expf(-a[j])) * b[j];
                    u32x2 o; o.x = pk2(h[0], h[1]); o.y = pk2(h[2], h[3]); *(u32x2*)(rowp + n * 16) = o; } }
    }
};
struct EpiYE {
    bf16_t* YE; const float* gate;
    __device__ __forceinline__ void operator()(const f32x4 (&acc)[2][2][4][2], const Unit& u, int wr, int wc, int fr, int fq) const {
        const int row0 = u.pm * BM + wr * 64 + fr, col0 = u.pn * BM + wc * 32 + 4 * fq;
#pragma unroll
        for (int ai = 0; ai < 2; ++ai)
#pragma unroll
            for (int m = 0; m < 4; ++m) { const int row = row0 + ai * HALF + m * 16; const float gt = gate[row]; bf16_t* rowp = YE + (size_t)row * DM + col0;
#pragma unroll
                for (int bj = 0; bj < 2; ++bj)
#pragma unroll
                    for (int n = 0; n < 2; ++n) { const f32x4 v = acc[ai][bj][m][n] * gt; u32x2 o; o.x = pk2(v[0], v[1]); o.y = pk2(v[2], v[3]); *(u32x2*)(rowp + bj * HALF + n * 16) = o; } }
    }
};
struct EpiLora {
    float* SCN; bf16_t* G; const float* decay0; const float* a0; const float* kalpha;
    __device__ __forceinline__ void operator()(const f32x4 (&acc)[2][2][4][2], const Unit& u, int wr, int wc, int fr, int fq) const {
        const int row0 = u.pm * BM + wr * 64 + fr;
        const int seg = u.pn / 3, cb = (u.pn % 3) * BM + wc * 32 + 4 * fq;
#pragma unroll
        for (int bj = 0; bj < 2; ++bj)
#pragma unroll
            for (int n = 0; n < 2; ++n) {
                const int col = cb + bj * HALF + n * 16, head = col >> 6, kx = col & 63;
                if (seg < 2) {
                    const f32x4 d0 = *(const f32x4*)(decay0 + seg * 768 + col);
#pragma unroll
                    for (int ai = 0; ai < 2; ++ai)
#pragma unroll
                        for (int m = 0; m < 4; ++m) { const int row = row0 + ai * HALF + m * 16; f32x4 w;
#pragma unroll
                            for (int j = 0; j < 4; ++j) w[j] = __expf(-DECAY_SCALE * sigmoidf_(d0[j] + acc[ai][bj][m][n][j]));
                            *(f32x4*)(SCN + ((size_t)(row * 12 + head) * 9 + 3 + 3 * seg) * 64 + kx) = w; }
                } else if (seg < 4) {
                    const int d = seg - 2;
                    const f32x4 a00 = *(const f32x4*)(a0 + d * 768 + col), kal = *(const f32x4*)(kalpha + col);
#pragma unroll
                    for (int ai = 0; ai < 2; ++ai)
#pragma unroll
                        for (int m = 0; m < 4; ++m) { const int row = row0 + ai * HALF + m * 16; float* base = SCN + (size_t)(row * 12 + head) * 9 * 64 + kx;
                            const f32x4 kk = *(const f32x4*)(base + 1 * 64); const f32x4 ks = *(const f32x4*)(base + (5 + 3 * d) * 64); f32x4 bb, kr;
#pragma unroll
                            for (int j = 0; j < 4; ++j) { const float a = sigmoidf_(a00[j] + acc[ai][bj][m][n][j]); bb[j] = kk[j] * a; kr[j] = ks[j] * (1.f + (a - 1.f) * kal[j]); }
                            *(f32x4*)(base + (4 + 3 * d) * 64) = bb; *(f32x4*)(base + (5 + 3 * d) * 64) = kr; }
                } else {
#pragma unroll
                    for (int ai = 0; ai < 2; ++ai)
#pragma unroll
                        for (int m = 0; m < 4; ++m) { const int row = row0 + ai * HALF + m * 16; const f32x4 v = acc[ai][bj][m][n]; u32x2 o; o.x = pk2(v[0], v[1]); o.y = pk2(v[2], v[3]);
                            *(u32x2*)(G + (size_t)row * 768 + col) = o; }
                }
            }
    }
};
}

struct Args { const float* in[37]; float* out; unsigned char* ws; int lo, hi; };
enum { I_X = 0, I_C, I_CTX, I_CCTX, I_WMOD, I_BMOD, I_LNG, I_LNB, I_EWIN, I_EWOUT, I_CONVW, I_MU, I_DUP, I_D0, I_AUP, I_A0, I_GUP, I_KXI, I_KAL, I_RBON, I_GNG, I_GNB,
       I_OWIN, I_OWOUT, I_LQ1, I_LK1, I_LQ2, I_LK2, I_SUBG, I_GLNG, I_GLNB, I_GWS, I_GBS, I_WR, I_WE1, I_WE3, I_WE2 };

struct Ctx {
    LAS unsigned char* lds;
    int tid, lane, wave, G, vcu, gw, NGW;
};
__device__ __forceinline__ void mkctx(Ctx& C, LAS unsigned char* lds) {
    int tid = threadIdx.x; asm volatile("" : "+v"(tid));
    C.lds = lds; C.tid = tid; C.lane = tid & 63; C.wave = __builtin_amdgcn_readfirstlane(tid >> 6);
    C.G = gridDim.x; { const int bx = blockIdx.x; C.vcu = (C.G % 8 == 0) ? (bx % 8) * (C.G / 8) + bx / 8 : bx; }
    C.gw = blockIdx.x * NWAVES + C.wave; C.NGW = C.G * NWAVES;
}
__device__ __forceinline__ void ldargs(Args& A, LAS unsigned char* lds) {
    LAS const u32x2* tb = (LAS const u32x2*)(lds + LDS_PTAB); asm volatile("" : "+v"(tb));
#pragma unroll
    for (int i = 0; i < 37; ++i) { const u32x2 v = tb[i]; A.in[i] = (const float*)(((unsigned long long)(unsigned)__builtin_amdgcn_readfirstlane((int)v.y) << 32) | (unsigned)__builtin_amdgcn_readfirstlane((int)v.x)); }
    { const u32x2 v = tb[37]; A.out = (float*)(((unsigned long long)(unsigned)__builtin_amdgcn_readfirstlane((int)v.y) << 32) | (unsigned)__builtin_amdgcn_readfirstlane((int)v.x)); }
    { const u32x2 v = tb[38]; A.ws = (unsigned char*)(((unsigned long long)(unsigned)__builtin_amdgcn_readfirstlane((int)v.y) << 32) | (unsigned)__builtin_amdgcn_readfirstlane((int)v.x)); }
    A.lo = 0; A.hi = 0;
}
__device__ __forceinline__ int row_mi(int row) { return row < NLAT ? (row >> 13) : 4; }

__device__ __forceinline__ void phase_init(const Ctx& C, const Args& A) {
    unsigned char* ws = A.ws;
    float* MOD = (float*)(ws + WS_MOD);
    LAS float* sv = (LAS float*)C.lds;
    LAS float* red = sv + 5 * 1024;
    for (int i = C.tid; i < 5 * 1024; i += NTHR) { const int v = i >> 10, k = i & 1023; const float c = (v < 4) ? A.in[I_C][v * DM + k] : A.in[I_CCTX][k]; sv[i] = c / (1.f + __expf(-c)); }
    __syncthreads();
    const int j = C.tid & 127, kp = C.tid >> 7;
    for (int it = blockIdx.x; it < DEPTH * 48; it += C.G) {
        const int l = it / 48, cg = it % 48, col = cg * 128 + j;
        const float* W = A.in[I_WMOD] + (size_t)l * DM * 6144 + col;
        float a0 = 0.f, a1 = 0.f, a2 = 0.f, a3 = 0.f, a4 = 0.f;
#pragma unroll 4
        for (int k = kp * 256; k < kp * 256 + 256; ++k) { const float w = W[(size_t)k * 6144]; a0 += sv[k] * w; a1 += sv[1024 + k] * w; a2 += sv[2048 + k] * w; a3 += sv[3072 + k] * w; a4 += sv[4096 + k] * w; }
        red[(kp * 5 + 0) * 128 + j] = a0; red[(kp * 5 + 1) * 128 + j] = a1; red[(kp * 5 + 2) * 128 + j] = a2; red[(kp * 5 + 3) * 128 + j] = a3; red[(kp * 5 + 4) * 128 + j] = a4;
        __syncthreads();
        for (int o = C.tid; o < 5 * 128; o += NTHR) { const int v = o >> 7, jj = o & 127; const int cc = cg * 128 + jj;
            const float s = red[(0 * 5 + v) * 128 + jj] + red[(1 * 5 + v) * 128 + jj] + red[(2 * 5 + v) * 128 + jj] + red[(3 * 5 + v) * 128 + jj];
            MOD[((size_t)l * 5 + v) * 6144 + cc] = s + A.in[I_BMOD][l * 6144 + cc]; }
        __syncthreads();
    }
    f32x4* X4 = (f32x4*)(ws + WS_X);
    const f32x4* x4 = (const f32x4*)A.in[I_X]; const f32x4* c4 = (const f32x4*)A.in[I_CTX];
    const size_t nl = (size_t)NLAT * DM / 4, nc = (size_t)NCTX * DM / 4;
    for (size_t i = (size_t)blockIdx.x * NTHR + C.tid; i < nl + nc; i += (size_t)C.G * NTHR) X4[i] = (i < nl) ? x4[i] : c4[i - nl];
}

__device__ __forceinline__ void transpose_item(const float* W, int ldw, int k0, int n0, bf16_t* WT, int ldt, int drow0, LAS float* scr, int lane) {
#pragma unroll 8
    for (int k = 0; k < 64; ++k) scr[k * 65 + lane] = W[(size_t)(k0 + k) * ldw + n0 + lane];
    asm volatile("s_waitcnt lgkmcnt(0)" ::: "memory");
    const int c = lane & 7;
#pragma unroll
    for (int j = 0; j < 8; ++j) { const int n = (lane >> 3) + 8 * j; const LAS float* s = scr + (8 * c) * 65 + n;
        u32x4 o; o.x = pk2(s[0 * 65], s[1 * 65]); o.y = pk2(s[2 * 65], s[3 * 65]); o.z = pk2(s[4 * 65], s[5 * 65]); o.w = pk2(s[6 * 65], s[7 * 65]);
        *(u32x4*)(WT + (size_t)(drow0 + n) * ldt + k0 + 8 * c) = o; }
    asm volatile("s_waitcnt lgkmcnt(0)" ::: "memory");
}
__device__ __forceinline__ void phase_conv(const Ctx& C, const Args& A, int l) {
    unsigned char* ws = A.ws;
    const int i2 = l >> 1; const bool odd = (l & 1);
    LAS float* scr = (LAS float*)C.lds + C.wave * (64 * 65);
    bf16_t* WIN = (bf16_t*)(ws + WS_WIN); bf16_t* WOUT = (bf16_t*)(ws + WS_WOUT); bf16_t* WE13 = (bf16_t*)(ws + WS_WE13); bf16_t* WE2 = (bf16_t*)(ws + WS_WE2);
    const int nin = odd ? D_IN_ODD : D_IN_EVEN;
    const float* win = odd ? A.in[I_OWIN] + (size_t)i2 * DM * D_IN_ODD : A.in[I_EWIN] + (size_t)i2 * DM * D_IN_EVEN;
    const float* wout = odd ? A.in[I_OWOUT] + (size_t)i2 * DM * DM : A.in[I_EWOUT] + (size_t)i2 * DM * DM;
    const int n_in = 16 * (nin / 64), n_out = 16 * 16, n_e13 = NEXP * 2 * 16 * 32, n_e2 = NEXP * 32 * 16;
    const int total = n_in + n_out + n_e13 + n_e2;
    for (int it = C.gw; it < total; it += C.NGW) {
        int r = it;
        if (r < n_in) { const int nb = nin / 64, kb = r / nb, nn = r % nb; transpose_item(win, nin, kb * 64, nn * 64, WIN, DM, nn * 64, scr, C.lane); continue; } r -= n_in;
        if (r < n_out) { const int kb = r / 16, nn = r % 16; transpose_item(wout, DM, kb * 64, nn * 64, WOUT, DM, nn * 64, scr, C.lane); continue; } r -= n_out;
        if (r < n_e13) { const int e = r / 1024, q = r % 1024, mat = q / 512, q2 = q % 512, kb = q2 / 32, nn = q2 % 32;
            const float* W = (mat ? A.in[I_WE3] : A.in[I_WE1]) + ((size_t)l * NEXP + e) * DM * D_EXP;
            const int f0 = nn * 64; const int drow = (f0 >> 7) * 256 + mat * 128 + (f0 & 127);
            transpose_item(W, D_EXP, kb * 64, f0, WE13 + (size_t)e * 4096 * DM, DM, drow, scr, C.lane); continue; } r -= n_e13;
        { const int e = r / 512, q = r % 512, kb = q / 16, nn = q % 16;
            const float* W = A.in[I_WE2] + ((size_t)l * NEXP + e) * D_EXP * DM;
            transpose_item(W, DM, kb * 64, nn * 64, WE2 + (size_t)e * DM * D_EXP, D_EXP, nn * 64, scr, C.lane); }
    }
    if (!odd) {
        u32x4* z = (u32x4*)(WIN + (size_t)D_IN_EVEN * DM);
        for (int i = blockIdx.x * NTHR + C.tid; i < (D_IN_EVEN_PAD - D_IN_EVEN) * DM / 8; i += C.G * NTHR) z[i] = (u32x4){0u, 0u, 0u, 0u};
        bf16_t* WL = (bf16_t*)(ws + WS_WLORA);
        const float* dup = A.in[I_DUP] + (size_t)i2 * 2 * 64 * 768; const float* aup = A.in[I_AUP] + (size_t)i2 * 2 * 64 * 768; const float* gup = A.in[I_GUP] + (size_t)i2 * 128 * 768;
        for (int i = blockIdx.x * NTHR + C.tid; i < LORA_N * LORA_K; i += C.G * NTHR) {
            const int kk = i / LORA_N, n = i % LORA_N, seg = n / 768, col = n % 768; float v = 0.f;
            if (seg == 0) { if (kk < 64) v = dup[(size_t)(0 * 64 + kk) * 768 + col]; }
            else if (seg == 1) { if (kk >= 64 && kk < 128) v = dup[(size_t)(1 * 64 + kk - 64) * 768 + col]; }
            else if (seg == 2) { if (kk >= 128 && kk < 192) v = aup[(size_t)(0 * 64 + kk - 128) * 768 + col]; }
            else if (seg == 3) { if (kk >= 192 && kk < 256) v = aup[(size_t)(1 * 64 + kk - 192) * 768 + col]; }
            else { if (kk >= 256) v = gup[(size_t)(kk - 256) * 768 + col]; }
            WL[(size_t)n * LORA_K + kk] = (bf16_t)f2bf(v);
        }
    }
}

__device__ __forceinline__ void phase_modh(const Ctx& C, const Args& A, int l) {
    const float* X = (const float*)(A.ws + WS_X); bf16_t* H = (bf16_t*)(A.ws + WS_H); const float* MOD = (const float*)(A.ws + WS_MOD) + (size_t)l * 5 * 6144;
    for (int row = C.gw; row < MROWS; row += C.NGW) {
        const float* md = MOD + row_mi(row) * 6144;
#pragma unroll
        for (int j = 0; j < 4; ++j) { const int col = 4 * C.lane + 256 * j; const f32x4 x = *(const f32x4*)(X + (size_t)row * DM + col), sh = *(const f32x4*)(md + col), sc = *(const f32x4*)(md + DM + col);
            const f32x4 h = x * (sc + 1.f) + sh; u32x2 o; o.x = pk2(h[0], h[1]); o.y = pk2(h[2], h[3]); *(u32x2*)(H + (size_t)row * DM + col) = o; }
    }
}

__device__ __forceinline__ f32x4 ld4bf(const bf16_t* p) { const u32x2 u = *(const u32x2*)p; return (f32x4){bflo(u.x), bfhi(u.x), bflo(u.y), bfhi(u.y)}; }
__device__ __forceinline__ void st4bf(bf16_t* p, f32x4 v) { u32x2 o; o.x = pk2(v[0], v[1]); o.y = pk2(v[2], v[3]); *(u32x2*)p = o; }
__device__ __forceinline__ void seq_info(int row, bool& hasp, bool& hasn) {
    if (row < NLAT) { const int t = row & (TT - 1); hasp = t > 0; hasn = t < TT - 1; }
    else { const int t = (row - NLAT) & (CTXL - 1); hasp = t > 0; hasn = t < CTXL - 1; }
}
__device__ __forceinline__ void phase_ef1(const Ctx& C, const Args& A, int l) {
    const int i2 = l >> 1; unsigned char* ws = A.ws;
    const bf16_t* P = (const bf16_t*)(ws + WS_P); bf16_t* A2 = (bf16_t*)(ws + WS_A2); float* SCN = (float*)(ws + WS_SCN); bf16_t* LIN = (bf16_t*)(ws + WS_LIN);
    const float* cw = A.in[I_CONVW] + (size_t)i2 * 3 * 256; const float* mu = A.in[I_MU] + (size_t)i2 * RWKV_COLS; const float* kxi = A.in[I_KXI] + (size_t)i2 * 768;
    const f32x4 z4 = {0.f, 0.f, 0.f, 0.f};
    for (int row = C.gw; row < MROWS; row += C.NGW) {
        bool hasp, hasn; seq_info(row, hasp, hasn);
        const bf16_t* p0 = P + (size_t)row * P_LD; const bf16_t* pm = p0 - P_LD; const bf16_t* pp = p0 + P_LD;
        {
            const int j4 = 4 * C.lane;
            const f32x4 bg = ld4bf(p0 + j4), u0 = ld4bf(p0 + 256 + j4) * ld4bf(p0 + 512 + j4);
            const f32x4 um = hasp ? ld4bf(pm + 256 + j4) * ld4bf(pm + 512 + j4) : z4, up = hasn ? ld4bf(pp + 256 + j4) * ld4bf(pp + 512 + j4) : z4;
            const f32x4 w0 = *(const f32x4*)(cw + j4), w1 = *(const f32x4*)(cw + 256 + j4), w2 = *(const f32x4*)(cw + 512 + j4);
            st4bf(A2 + (size_t)row * DM + j4, bg * (w0 * um + w1 * u0 + w2 * up));
        }
#pragma unroll
        for (int it = 0; it < 11; ++it) {
            const int c = it * 256 + 4 * C.lane;
            if (c < RWKV_COLS) {
                const f32x4 x0 = ld4bf(p0 + 768 + c), xm = hasp ? ld4bf(pm + 768 + c) : z4, xp = hasn ? ld4bf(pp + 768 + c) : z4, m4 = *(const f32x4*)(mu + c);
                const f32x4 ps = x0 + m4 * ((xm + xp) * 0.5f - x0);
                if (it < 3) { const int head = c >> 6, kx = c & 63; *(f32x4*)(SCN + ((size_t)(row * 12 + head) * 9 + 0) * 64 + kx) = ps; }
                else if (it < 6) { const int c1 = c - 768, head = c1 >> 6, kx = c1 & 63; const f32x4 kv = ps * *(const f32x4*)(kxi + c1);
                    const float ss = sum16(kv[0] * kv[0] + kv[1] * kv[1] + kv[2] * kv[2] + kv[3] * kv[3]); const float rn = rsqrtf(ss + 1e-12f);
                    float* base = SCN + (size_t)(row * 12 + head) * 9 * 64 + kx;
                    *(f32x4*)(base + 1 * 64) = kv * rn; *(f32x4*)(base + 5 * 64) = ps; *(f32x4*)(base + 8 * 64) = ps; }
                else if (it < 9) { const int c1 = c - 1536, head = c1 >> 6, kx = c1 & 63; *(f32x4*)(SCN + ((size_t)(row * 12 + head) * 9 + 2) * 64 + kx) = ps; }
                else { const int c1 = c - 2304; f32x4 o;
                    if (c1 < 128) { o = (f32x4){tanhf(ps[0]), tanhf(ps[1]), tanhf(ps[2]), tanhf(ps[3])}; }
                    else if (c1 < 256) { o = ps; }
                    else { o = (f32x4){sigmoidf_(ps[0]), sigmoidf_(ps[1]), sigmoidf_(ps[2]), sigmoidf_(ps[3])}; }
                    st4bf(LIN + (size_t)row * LORA_K + c1, o); }
            }
        }
    }
}

__device__ __forceinline__ int scan_row(int i, int b, int d) {
    if (d == 0) return i < CTXL ? NLAT + b * CTXL + i : b * TT + (i - CTXL);
    return i < CTXL ? NLAT + b * CTXL + (CTXL - 1 - i) : b * TT + (TT - 1 - (i - CTXL));
}
__device__ __forceinline__ float red8(float v) {
    v += __uint_as_float((unsigned)__builtin_amdgcn_update_dpp(0, (int)__float_as_uint(v), 0xB1, 0xF, 0xF, true));
    v += __uint_as_float((unsigned)__builtin_amdgcn_update_dpp(0, (int)__float_as_uint(v), 0x4E, 0xF, 0xF, true));
    v += __uint_as_float((unsigned)__builtin_amdgcn_update_dpp(0, (int)__float_as_uint(v), 0x141, 0xF, 0xF, true));
    return v;
}
__device__ __forceinline__ void phase_scan(const Ctx& C, const Args& A) {
    for (int u = blockIdx.x; u < 192; u += C.G) {
    const int half = u & 1, d = (u >> 1) & 1, h = (u >> 2) % 12, b = u / 48;
    const float* SCN = (const float*)(A.ws + WS_SCN); float* Y = (float*)(A.ws + WS_Y) + (size_t)d * MROWS * 768;
    LAS float* buf = (LAS float*)C.lds; LAS float* ybuf = buf + 2 * 32 * 352;
    constexpr int NCH = LKEYS / 32;
    f32x4 st[6];
    int pq[6], ps_[6], poff[6], pslot[6];
#pragma unroll
    for (int j = 0; j < 6; ++j) { const int p = C.tid + NTHR * j; const int s = p / 88, q = p % 88, vec = q >> 4; ps_[j] = s; pq[j] = q;
        pslot[j] = vec == 0 ? 3 + 3 * d : vec == 1 ? 1 : vec == 2 ? 4 + 3 * d : vec == 3 ? 5 + 3 * d : vec == 4 ? 0 : 2;
        poff[j] = vec < 5 ? (q & 15) * 4 : half * 32 + (q - 80) * 4; }
#define SCAN_LOADG(c) do { _Pragma("unroll") for (int j = 0; j < 6; ++j) if (C.tid + NTHR * j < 2816) { const int row = scan_row((c) * 32 + ps_[j], b, d); \
        st[j] = *(const f32x4*)(SCN + ((size_t)(row * 12 + h) * 9 + pslot[j]) * 64 + poff[j]); } } while (0)
#define SCAN_STORE(bi) do { _Pragma("unroll") for (int j = 0; j < 6; ++j) if (C.tid + NTHR * j < 2816) *(LAS f32x4*)(buf + (bi) * (32 * 352) + ps_[j] * 352 + pq[j] * 4) = st[j]; } while (0)
    SCAN_LOADG(0); SCAN_STORE(0); __syncthreads();
    float S[8];
#pragma unroll
    for (int j = 0; j < 8; ++j) S[j] = 0.f;
    const int rl = C.lane >> 3, ks = C.lane & 7;
    for (int c = 0; c < NCH; ++c) {
        if (c + 1 < NCH) SCAN_LOADG(c + 1);
        if (C.wave < 4) {
            const LAS float* cur = buf + (c & 1) * (32 * 352);
            LAS float* yb = ybuf + (c & 1) * 1024 + C.wave * 8 + rl;
            for (int s = 0; s < 32; ++s) {
                const LAS float* bp = cur + s * 352 + ks * 8;
                const f32x4 w0 = *(const LAS f32x4*)(bp), w1 = *(const LAS f32x4*)(bp + 4), k0 = *(const LAS f32x4*)(bp + 64), k1 = *(const LAS f32x4*)(bp + 68);
                const f32x4 b0 = *(const LAS f32x4*)(bp + 128), b1 = *(const LAS f32x4*)(bp + 132), q0 = *(const LAS f32x4*)(bp + 192), q1 = *(const LAS f32x4*)(bp + 196);
                const f32x4 r0 = *(const LAS f32x4*)(bp + 256), r1 = *(const LAS f32x4*)(bp + 260);
                const float vv = cur[s * 352 + 320 + C.wave * 8 + rl];
                float sa = (S[0] * k0[0] + S[1] * k0[1]) + (S[2] * k0[2] + S[3] * k0[3]) + ((S[4] * k1[0] + S[5] * k1[1]) + (S[6] * k1[2] + S[7] * k1[3]));
                sa = red8(sa);
#pragma unroll
                for (int j = 0; j < 4; ++j) { S[j] = S[j] * w0[j] + (vv * q0[j] - sa * b0[j]); S[4 + j] = S[4 + j] * w1[j] + (vv * q1[j] - sa * b1[j]); }
                float y = (S[0] * r0[0] + S[1] * r0[1]) + (S[2] * r0[2] + S[3] * r0[3]) + ((S[4] * r1[0] + S[5] * r1[1]) + (S[6] * r1[2] + S[7] * r1[3]));
                y = red8(y);
                if (ks == 0) yb[s * 32] = y;
            }
        }
        if (c + 1 < NCH) SCAN_STORE((c + 1) & 1);
        __syncthreads();
#pragma unroll
        for (int i = 0; i < 2; ++i) { const int e = C.tid + NTHR * i, s = e >> 5, r = e & 31; const int row = scan_row(c * 32 + s, b, d);
            Y[(size_t)row * 768 + h * 64 + half * 32 + r] = ybuf[(c & 1) * 1024 + e]; }
    }
    __syncthreads();
    }
#undef SCAN_LOADG
#undef SCAN_STORE
}

__device__ __forceinline__ void phase_ef2(const Ctx& C, const Args& A, int l) {
    const int i2 = l >> 1; unsigned char* ws = A.ws;
    const float* SCN = (const float*)(ws + WS_SCN); const float* Y0 = (const float*)(ws + WS_Y); const float* Y1 = Y0 + (size_t)MROWS * 768;
    const bf16_t* G = (const bf16_t*)(ws + WS_G); bf16_t* A2 = (bf16_t*)(ws + WS_A2);
    const float* rb = A.in[I_RBON] + (size_t)i2 * 768; const float* gg = A.in[I_GNG] + (size_t)i2 * 768; const float* gb = A.in[I_GNB] + (size_t)i2 * 768;
    for (int row = C.gw; row < MROWS; row += C.NGW) {
#pragma unroll
        for (int it = 0; it < 3; ++it) {
            const int c = it * 256 + 4 * C.lane, head = c >> 6, kx = c & 63;
            const f32x4 y = *(const f32x4*)(Y0 + (size_t)row * 768 + c) + *(const f32x4*)(Y1 + (size_t)row * 768 + c);
            const float mean = sum16((y[0] + y[1]) + (y[2] + y[3])) * (1.f / 64.f);
            const f32x4 dd = y - mean;
            const float var = sum16((dd[0] * dd[0] + dd[1] * dd[1]) + (dd[2] * dd[2] + dd[3] * dd[3])) * (1.f / 64.f);
            const float rstd = rsqrtf(var + GN_EPS);
            const float* base = SCN + (size_t)(row * 12 + head) * 9 * 64 + kx;
            const f32x4 r = *(const f32x4*)(base), v = *(const f32x4*)(base + 2 * 64), k0 = *(const f32x4*)(base + 5 * 64), k1 = *(const f32x4*)(base + 8 * 64);
            const f32x4 rb4 = *(const f32x4*)(rb + c);
            const f32x4 t = r * (k0 + k1) * 0.5f * rb4;
            const float bs = sum16((t[0] + t[1]) + (t[2] + t[3]));
            const f32x4 yn = dd * rstd * *(const f32x4*)(gg + c) + *(const f32x4*)(gb + c);
            const f32x4 g = ld4bf(G + (size_t)row * 768 + c);
            st4bf(A2 + (size_t)row * DM + 256 + c, g * (yn + v * bs));
        }
    }
}

__device__ __forceinline__ int crow(int r, int hi) { return (r & 3) + 8 * (r >> 2) + 4 * hi; }
constexpr float QSCALE = 0.125f * 1.4426950408889634f;
__device__ __forceinline__ void phase_of1(const Ctx& C, const Args& A, int l) {
    const int i2 = l >> 1; unsigned char* ws = A.ws;
    const bf16_t* P = (const bf16_t*)(ws + WS_P); bf16_t* A2 = (bf16_t*)(ws + WS_A2); bf16_t* Q = (bf16_t*)(ws + WS_Q); bf16_t* KA = (bf16_t*)(ws + WS_KA); bf16_t* VT = (bf16_t*)(ws + WS_VT);
    const float* lng = A.in[I_GLNG] + (size_t)i2 * 256; const float* lnb = A.in[I_GLNB] + (size_t)i2 * 256;
    const float* gws = A.in[I_GWS] + (size_t)i2 * 4 * 128 * 128; const float* gbs = A.in[I_GBS] + (size_t)i2 * 4 * 128;
    LAS bf16_t* vt = (LAS bf16_t*)C.lds;
    LAS bf16_t* vT = (LAS bf16_t*)(C.lds + 128 * 272);
    const int r32 = C.lane & 31, hi = C.lane >> 5;
    const int axis = (C.lane & 31) >> 4, jj = C.lane & 15;
    const float inv = powf(10000.f, -(float)jj * (1.f / 16.f));
    for (int u = blockIdx.x; u < 264; u += C.G) {
        const bool isctx = u >= 256; const int uc = u - 256;
        const int b = isctx ? (uc >> 1) : (u >> 6), pos0 = isctx ? (uc & 1) * 128 : (u & 63) * 128;
        const int row0 = isctx ? NLAT + b * CTXL + pos0 : b * TT + pos0, L0 = isctx ? pos0 : CTXL + pos0;
        for (int r = C.wave; r < 128; r += NWAVES) {
            const int grow = row0 + r, t = pos0 + r; float cs = 1.f, sn = 0.f;
            if (!isctx) { const float ang = (float)(axis ? (t & 63) : (t >> 6)) * inv; cs = cosf(ang); sn = sinf(ang); }
            const bf16_t* pr = P + (size_t)grow * P_LD; bf16_t* qo = Q + (size_t)grow * 768; bf16_t* ko = KA + ((size_t)b * LKEYS + L0 + r) * 768;
#pragma unroll
            for (int i = 0; i < 6; ++i) { const int base = (2 * i + hi) * 64 + axis * 32 + jj;
                const float q1 = bf2f(pr[base]), q2 = bf2f(pr[base + 16]), k1 = bf2f(pr[768 + base]), k2 = bf2f(pr[768 + base + 16]);
                qo[base] = (bf16_t)f2bf((q1 * cs - q2 * sn) * QSCALE); qo[base + 16] = (bf16_t)f2bf((q1 * sn + q2 * cs) * QSCALE);
                ko[base] = (bf16_t)f2bf(k1 * cs - k2 * sn); ko[base + 16] = (bf16_t)f2bf(k1 * sn + k2 * cs); }
        }
        for (int hh = 0; hh < 6; ++hh) {
#pragma unroll
            for (int i = 0; i < 4; ++i) { const int piece = C.tid + NTHR * i, r = piece >> 4, part = piece & 15;
                *(LAS u32x4*)(vt + r * 136 + part * 8) = *(const u32x4*)(P + (size_t)(row0 + r) * P_LD + 1536 + hh * 128 + part * 8); }
            __syncthreads();
#pragma unroll
            for (int i = 0; i < 4; ++i) { const int item = C.tid + NTHR * i, d = item >> 4, tg = item & 15; const LAS bf16_t* s = vt + (tg * 8) * 136 + d;
                u32x4 o; o.x = (unsigned)s[0] | ((unsigned)s[136] << 16); o.y = (unsigned)s[2 * 136] | ((unsigned)s[3 * 136] << 16);
                o.z = (unsigned)s[4 * 136] | ((unsigned)s[5 * 136] << 16); o.w = (unsigned)s[6 * 136] | ((unsigned)s[7 * 136] << 16);
                *(u32x4*)(VT + ((size_t)(b * 6 + hh) * 128 + d) * LKEYS + L0 + tg * 8) = o; }
            __syncthreads();
        }
        for (int r = C.wave; r < 128; r += NWAVES) {
            const int c4 = 4 * C.lane; const f32x4 raw = ld4bf(P + (size_t)(row0 + r) * P_LD + 2560 + c4);
            const f32x4 gv = {gelu_erf(raw[0]), gelu_erf(raw[1]), gelu_erf(raw[2]), gelu_erf(raw[3])};
            const float mean = wave_sum((gv[0] + gv[1]) + (gv[2] + gv[3])) * (1.f / 256.f); const f32x4 dd = gv - mean;
            const float var = wave_sum((dd[0] * dd[0] + dd[1] * dd[1]) + (dd[2] * dd[2] + dd[3] * dd[3])) * (1.f / 256.f); const float rstd = rsqrtf(var + LN_EPS);
            const f32x4 o = dd * rstd * *(const f32x4*)(lng + c4) + *(const f32x4*)(lnb + c4);
#pragma unroll
            for (int k = 0; k < 4; ++k) vT[(c4 + k) * 136 + r] = (bf16_t)f2bf(o[k]);
        }
        __syncthreads();
        {
            const int g = C.wave >> 1, cblk = C.wave & 1, cc = g * 64 + cblk * 32 + r32;
            for (int pblk = 0; pblk < 4; ++pblk) {
                f32x16 acc;
#pragma unroll
                for (int i = 0; i < 16; ++i) acc[i] = 0.f;
                const float* wrow = gws + ((size_t)g * 128 + pblk * 32 + r32) * 128 + 8 * hi;
#pragma unroll
                for (int ks = 0; ks < 8; ++ks) { const f32x4 w0 = *(const f32x4*)(wrow + ks * 16), w1 = *(const f32x4*)(wrow + ks * 16 + 4);
                    u32x4 au; au.x = pk2(w0[0], w0[1]); au.y = pk2(w0[2], w0[3]); au.z = pk2(w1[0], w1[1]); au.w = pk2(w1[2], w1[3]);
                    const bf16x8 bf = *(const LAS bf16x8*)(vT + cc * 136 + ks * 16 + 8 * hi);
                    acc = __builtin_amdgcn_mfma_f32_32x32x16_bf16(__builtin_bit_cast(bf16x8, au), bf, acc, 0, 0, 0); }
#pragma unroll
                for (int reg = 0; reg < 16; ++reg) { const int p = pblk * 32 + crow(reg, hi); const size_t grow = (size_t)(row0 + p);
                    const float uu = gelu_erf(bf2f(P[grow * P_LD + 2304 + cc])); const float mixed = acc[reg] + gbs[g * 128 + p];
                    A2[grow * DM + 768 + cc] = (bf16_t)f2bf(uu * mixed); }
            }
        }
        __syncthreads();
    }
}

__device__ __forceinline__ void phase_attn(const Ctx& C, const Args& A, int l) {
    const int i2 = l >> 1; unsigned char* ws = A.ws;
    const bf16_t* Q = (const bf16_t*)(ws + WS_Q); const bf16_t* KA = (const bf16_t*)(ws + WS_KA); const bf16_t* VT = (const bf16_t*)(ws + WS_VT); bf16_t* A2 = (bf16_t*)(ws + WS_A2);
    const float lam_init = 0.8f - 0.6f * expf(-0.3f * (float)l);
    float s1 = 0.f, s2 = 0.f;
    for (int j = 0; j < 64; ++j) { s1 += A.in[I_LQ1][i2 * 64 + j] * A.in[I_LK1][i2 * 64 + j]; s2 += A.in[I_LQ2][i2 * 64 + j] * A.in[I_LK2][i2 * 64 + j]; }
    const float lam = expf(s1) - expf(s2) + lam_init;
    const float* subg = A.in[I_SUBG] + (size_t)i2 * 128;
    const int r32 = C.lane & 31, hi = C.lane >> 5, map = C.wave >> 2, qw = C.wave & 3;
    LAS unsigned char* Kt = C.lds; LAS unsigned char* Vt = C.lds + 2 * 17408; LAS float* xch = (LAS float*)C.lds;
    const int NU = 1536 + (l == 1 ? 48 : 0);
    for (int n = C.vcu; n < NU; n += C.G) {
        int bh, qt; bool isctx = false;
        if (n < 1536) { const int round = n >> 8, slot = n & 255; bh = (slot >> 5) * 3 + (round >> 1); qt = (round & 1) * 32 + (slot & 31); }
        else { isctx = true; bh = (n - 1536) >> 1; qt = (n - 1536) & 1; }
        const int b = bh / 6, h = bh % 6;
        const int qrow0 = isctx ? NLAT + b * CTXL + qt * 128 : b * TT + qt * 128;
        const int NT = isctx ? CTXL / 64 : LKEYS / 64;
        const bf16_t* Kb = KA + (size_t)b * LKEYS * 768 + h * 128;
        const bf16_t* Vb = VT + (size_t)(b * 6 + h) * 128 * LKEYS;
        bf16x8 qf[4];
        { const bf16_t* qp = Q + (size_t)(qrow0 + qw * 32 + r32) * 768 + h * 128 + map * 64 + 8 * hi;
#pragma unroll
          for (int ks = 0; ks < 4; ++ks) qf[ks] = *(const bf16x8*)(qp + ks * 16); }
        f32x16 O[4];
#pragma unroll
        for (int d = 0; d < 4; ++d)
#pragma unroll
            for (int i = 0; i < 16; ++i) O[d][i] = 0.f;
        float m = -1e30f, lsum = 0.f;
        u32x4 kreg[2], vreg[2];
#define AT_LOAD(t) do { _Pragma("unroll") for (int i = 0; i < 2; ++i) { const int piece = C.tid + NTHR * i; \
            kreg[i] = *(const u32x4*)(Kb + (size_t)((t) * 64 + (piece >> 4)) * 768 + (piece & 15) * 8); \
            vreg[i] = *(const u32x4*)(Vb + (size_t)(piece >> 3) * LKEYS + (t) * 64 + (piece & 7) * 8); } } while (0)
#define AT_STORE(bi) do { _Pragma("unroll") for (int i = 0; i < 2; ++i) { const int piece = C.tid + NTHR * i; \
            *(LAS u32x4*)(Kt + (bi) * 17408 + (piece >> 4) * 272 + (piece & 15) * 16) = kreg[i]; \
            LAS unsigned char* vd = Vt + (bi) * 17408 + (piece >> 3) * 136 + (piece & 7) * 16; \
            *(LAS u32x2*)vd = (u32x2){vreg[i].x, vreg[i].y}; *(LAS u32x2*)(vd + 8) = (u32x2){vreg[i].z, vreg[i].w}; } } while (0)
        AT_LOAD(0); AT_STORE(0); __syncthreads();
        for (int t = 0; t < NT; ++t) {
            if (t + 1 < NT) AT_LOAD(t + 1);
            const int bi = t & 1;
            f32x16 p0, p1;
#pragma unroll
            for (int i = 0; i < 16; ++i) { p0[i] = 0.f; p1[i] = 0.f; }
            { const LAS unsigned char* kb = Kt + bi * 17408 + r32 * 272 + map * 128 + hi * 16;
#pragma unroll
              for (int ks = 0; ks < 4; ++ks) { const bf16x8 a0 = *(const LAS bf16x8*)(kb + ks * 32), a1 = *(const LAS bf16x8*)(kb + 32 * 272 + ks * 32);
                  p0 = __builtin_amdgcn_mfma_f32_32x32x16_bf16(a0, qf[ks], p0, 0, 0, 0); p1 = __builtin_amdgcn_mfma_f32_32x32x16_bf16(a1, qf[ks], p1, 0, 0, 0); } }
            float mx = fmaxf(p0[0], p1[0]);
#pragma unroll
            for (int i = 1; i < 16; ++i) mx = fmaxf(mx, fmaxf(p0[i], p1[i]));
            mx = fmaxf(mx, __shfl_xor(mx, 32));
            const float mnew = fmaxf(m, mx);
            if (__any(mnew > m)) { const float sc = __builtin_amdgcn_exp2f(m - mnew); lsum *= sc;
#pragma unroll
                for (int d = 0; d < 4; ++d)
#pragma unroll
                    for (int i = 0; i < 16; ++i) O[d][i] *= sc;
                m = mnew; }
            float ps = 0.f;
#pragma unroll
            for (int i = 0; i < 16; ++i) { p0[i] = __builtin_amdgcn_exp2f(p0[i] - m); p1[i] = __builtin_amdgcn_exp2f(p1[i] - m); ps += p0[i] + p1[i]; }
            lsum += ps;
            bf16x8 pb[4];
            { u32x4 w; w.x = pk2(p0[0], p0[1]); w.y = pk2(p0[2], p0[3]); w.z = pk2(p0[4], p0[5]); w.w = pk2(p0[6], p0[7]); pb[0] = __builtin_bit_cast(bf16x8, w);
              w.x = pk2(p0[8], p0[9]); w.y = pk2(p0[10], p0[11]); w.z = pk2(p0[12], p0[13]); w.w = pk2(p0[14], p0[15]); pb[1] = __builtin_bit_cast(bf16x8, w);
              w.x = pk2(p1[0], p1[1]); w.y = pk2(p1[2], p1[3]); w.z = pk2(p1[4], p1[5]); w.w = pk2(p1[6], p1[7]); pb[2] = __builtin_bit_cast(bf16x8, w);
              w.x = pk2(p1[8], p1[9]); w.y = pk2(p1[10], p1[11]); w.z = pk2(p1[12], p1[13]); w.w = pk2(p1[14], p1[15]); pb[3] = __builtin_bit_cast(bf16x8, w); }
            { const LAS unsigned char* vb = Vt + bi * 17408 + r32 * 136 + hi * 8;
#pragma unroll
              for (int d = 0; d < 4; ++d)
#pragma unroll
                  for (int kst = 0; kst < 4; ++kst) { const LAS unsigned char* vp = vb + d * (32 * 136) + kst * 32;
                      const u32x2 lo = *(const LAS u32x2*)vp, hh = *(const LAS u32x2*)(vp + 16); const u32x4 av = {lo.x, lo.y, hh.x, hh.y};
                      O[d] = __builtin_amdgcn_mfma_f32_32x32x16_bf16(__builtin_bit_cast(bf16x8, av), pb[kst], O[d], 0, 0, 0); } }
            if (t + 1 < NT) AT_STORE((t + 1) & 1);
            __syncthreads();
        }
#undef AT_LOAD
#undef AT_STORE
        const float ltot = lsum + __shfl_xor(lsum, 32);
        const float invl = 1.f / ltot;
        if (map == 1) { const float f = lam * invl;
#pragma unroll
            for (int d = 0; d < 4; ++d)
#pragma unroll
                for (int i = 0; i < 16; ++i) xch[(qw * 64 + d * 16 + i) * 64 + C.lane] = O[d][i] * f; }
        __syncthreads();
        if (map == 0) { float ss = 0.f;
#pragma unroll
            for (int d = 0; d < 4; ++d)
#pragma unroll
                for (int i = 0; i < 16; ++i) { const float o = O[d][i] * invl - xch[(qw * 64 + d * 16 + i) * 64 + C.lane]; O[d][i] = o; ss += o * o; }
            ss += __shfl_xor(ss, 32);
            const float rn = rsqrtf(ss * (1.f / 128.f) + RMS_EPS) * (1.f - lam_init);
            bf16_t* orow = A2 + (size_t)(qrow0 + qw * 32 + r32) * DM + h * 128;
#pragma unroll
            for (int d = 0; d < 4; ++d)
#pragma unroll
                for (int g4 = 0; g4 < 4; ++g4) { const int dd = 32 * d + 8 * g4 + 4 * hi; const f32x4 sg = *(const f32x4*)(subg + dd);
                    const f32x4 v = {O[d][4 * g4] * rn * sg[0], O[d][4 * g4 + 1] * rn * sg[1], O[d][4 * g4 + 2] * rn * sg[2], O[d][4 * g4 + 3] * rn * sg[3]};
                    st4bf(orow + dd, v); } }
        __syncthreads();
    }
}

__device__ __forceinline__ void phase_rt(const Ctx& C, const Args& A, int l) {
    unsigned char* ws = A.ws; float* X = (float*)(ws + WS_X); bf16_t* H = (bf16_t*)(ws + WS_H); float* AFF = (float*)(ws + WS_AFF);
    const float* MOD = (const float*)(ws + WS_MOD) + (size_t)l * 5 * 6144;
    const float* lng = A.in[I_LNG] + (size_t)(l * 2 + 0) * DM; const float* lnb = A.in[I_LNB] + (size_t)(l * 2 + 0) * DM;
    LAS float* wrs = (LAS float*)C.lds;
    { const float* wr = A.in[I_WR] + (size_t)l * DM * 16; for (int i = C.tid; i < DM * 16; i += NTHR) wrs[(i & 15) * 1024 + (i >> 4)] = wr[i]; }
    __syncthreads();
    for (int row = C.gw; row < MROWS; row += C.NGW) {
        const float* md = MOD + row_mi(row) * 6144;
        f32x4 x[4]; float s = 0.f;
#pragma unroll
        for (int j = 0; j < 4; ++j) { x[j] = *(const f32x4*)(X + (size_t)row * DM + 4 * C.lane + 256 * j); s += (x[j][0] + x[j][1]) + (x[j][2] + x[j][3]); }
        const float mean = wave_sum(s) * (1.f / DM); float s2 = 0.f;
#pragma unroll
        for (int j = 0; j < 4; ++j) { x[j] = x[j] - mean; s2 += (x[j][0] * x[j][0] + x[j][1] * x[j][1]) + (x[j][2] * x[j][2] + x[j][3] * x[j][3]); }
        const float rstd = rsqrtf(wave_sum(s2) * (1.f / DM) + LN_EPS);
        float v[16];
#pragma unroll
        for (int e = 0; e < 16; ++e) v[e] = 0.f;
#pragma unroll
        for (int j = 0; j < 4; ++j) { const int col = 4 * C.lane + 256 * j;
            const f32x4 x1 = x[j] * rstd * *(const f32x4*)(lng + col) + *(const f32x4*)(lnb + col);
            *(f32x4*)(X + (size_t)row * DM + col) = x1;
            const f32x4 h = x1 * (*(const f32x4*)(md + 4 * DM + col) + 1.f) + *(const f32x4*)(md + 3 * DM + col);
            st4bf(H + (size_t)row * DM + col, h);
#pragma unroll
            for (int e = 0; e < 16; ++e) { const f32x4 w = *(const LAS f32x4*)(wrs + e * 1024 + col); v[e] += (h[0] * w[0] + h[1] * w[1]) + (h[2] * w[2] + h[3] * w[3]); }
            __builtin_amdgcn_sched_barrier(0); }
#pragma unroll
        for (int i = 0; i < 8; ++i) { const float send = (C.lane & 32) ? v[i] : v[i + 8], keep = (C.lane & 32) ? v[i + 8] : v[i]; v[i] = keep + __shfl_xor(send, 32); }
#pragma unroll
        for (int i = 0; i < 4; ++i) { const float send = (C.lane & 16) ? v[i] : v[i + 4], keep = (C.lane & 16) ? v[i + 4] : v[i]; v[i] = keep + __shfl_xor(send, 16); }
#pragma unroll
        for (int i = 0; i < 2; ++i) { const float send = (C.lane & 8) ? v[i] : v[i + 2], keep = (C.lane & 8) ? v[i + 2] : v[i]; v[i] = keep + __shfl_xor(send, 8); }
        { const float send = (C.lane & 4) ? v[0] : v[1], keep = (C.lane & 4) ? v[1] : v[0]; v[0] = keep + __shfl_xor(send, 4); }
        float z = v[0]; z += __shfl_xor(z, 1); z += __shfl_xor(z, 2);
        float mx = z;
#pragma unroll
        for (int o = 4; o < 64; o <<= 1) mx = fmaxf(mx, __shfl_xor(mx, o));
        const float ex = expf(z - mx); float sm = ex;
#pragma unroll
        for (int o = 4; o < 64; o <<= 1) sm += __shfl_xor(sm, o);
        if ((C.lane & 3) == 0) AFF[(size_t)row * 16 + (C.lane >> 2)] = ex / sm;
    }
}

__device__ __forceinline__ void phase_tk(const Ctx& C, const Args& A) {
    unsigned char* ws = A.ws; const float* AFF = (const float*)(ws + WS_AFF); int* SLOT = (int*)(ws + WS_SLOT); int* IDX = (int*)(ws + WS_IDX); float* GATE = (float*)(ws + WS_GATE);
    LAS unsigned* key = (LAS unsigned*)C.lds;
    LAS unsigned* hist = key + 8192;
    LAS unsigned* scn = hist + 256;
    LAS unsigned* wtot = scn + 256;
    LAS unsigned* bc = wtot + 8;
    for (int u = blockIdx.x; u < 128; u += C.G) {
        const bool isctx = u >= 64; const int uu = u & 63, b = uu >> 4, e = uu & 15;
        const int n = isctx ? CTXL : TT, cap = isctx ? CAP_C : CAP_L;
        const int row0 = isctx ? NLAT + b * CTXL : b * TT;
        const int slot0 = e * ESLOTS + (isctx ? 4 * CAP_L + b * CAP_C : b * CAP_L);
        for (int i = C.tid; i < n; i += NTHR) key[i] = __float_as_uint(AFF[(size_t)(row0 + i) * 16 + e]);
        unsigned prefix = 0u, pmask = 0u; int need = cap;
        for (int pass = 0; pass < 4; ++pass) {
            const int shift = 24 - 8 * pass;
            if (C.tid < 256) hist[C.tid] = 0u;
            __syncthreads();
            for (int i = C.tid; i < n; i += NTHR) { const unsigned k = key[i]; if ((k & pmask) == prefix) __hip_atomic_fetch_add(&hist[(k >> shift) & 255u], 1u, __ATOMIC_RELAXED, __HIP_MEMORY_SCOPE_WORKGROUP); }
            __syncthreads();
            if (C.tid < 256) scn[C.tid] = hist[C.tid];
            __syncthreads();
            for (int off = 1; off < 256; off <<= 1) {
                unsigned a = 0u; if (C.tid < 256 && C.tid + off < 256) a = scn[C.tid + off];
                __syncthreads();
                if (C.tid < 256) scn[C.tid] += a;
                __syncthreads();
            }
            if (C.tid < 256) { const unsigned above = (C.tid < 255) ? scn[C.tid + 1] : 0u;
                if (scn[C.tid] >= (unsigned)need && above < (unsigned)need) { bc[0] = (unsigned)C.tid; bc[1] = (unsigned)need - above; } }
            __syncthreads();
            prefix |= bc[0] << shift; pmask |= 255u << shift; need = (int)bc[1];
            __syncthreads();
        }
        const int per = (n + NTHR - 1) / NTHR; const int i0 = C.tid * per;
        unsigned cg = 0u, ce = 0u;
        for (int j = 0; j < per; ++j) { const int i = i0 + j; if (i < n) { const unsigned k = key[i]; cg += (k > prefix); ce += (k == prefix); } }
        unsigned pk = cg | (ce << 16), inc = pk;
#pragma unroll
        for (int o = 1; o < 64; o <<= 1) { const unsigned t = __shfl_up(inc, o); if (C.lane >= o) inc += t; }
        if (C.lane == 63) wtot[C.wave] = inc;
        __syncthreads();
        unsigned wbase = 0u;
        for (int w = 0; w < C.wave; ++w) wbase += wtot[w];
        const unsigned excl = wbase + inc - pk;
        unsigned rg = excl & 0xffffu, re = excl >> 16;
        const int ngt = cap - need;
        for (int j = 0; j < per; ++j) { const int i = i0 + j; if (i < n) { const unsigned k = key[i]; int pos = -1;
            if (k > prefix) { pos = (int)rg; ++rg; } else if (k == prefix) { if ((int)re < need) pos = ngt + (int)re; ++re; }
            const int row = row0 + i;
            if (pos >= 0) { IDX[slot0 + pos] = row; GATE[slot0 + pos] = __uint_as_float(k); SLOT[(size_t)row * 16 + e] = slot0 + pos; }
            else SLOT[(size_t)row * 16 + e] = -1; } }
        if (isctx && b == 0 && C.tid < ESLOTS - 4224) { IDX[e * ESLOTS + 4224 + C.tid] = 0; GATE[e * ESLOTS + 4224 + C.tid] = 0.f; }
        __syncthreads();
    }
}

__device__ __forceinline__ void phase_cb(const Ctx& C, const Args& A, int l) {
    unsigned char* ws = A.ws; float* X = (float*)(ws + WS_X); bf16_t* H = (bf16_t*)(ws + WS_H); const int* SLOT = (const int*)(ws + WS_SLOT); const bf16_t* YE = (const bf16_t*)(ws + WS_YE);
    const float* MOD = (const float*)(ws + WS_MOD) + (size_t)l * 5 * 6144; const float* MODN = MOD + 5 * 6144;
    const float* lng = A.in[I_LNG] + (size_t)(l * 2 + 1) * DM; const float* lnb = A.in[I_LNB] + (size_t)(l * 2 + 1) * DM;
    for (int row = C.gw; row < MROWS; row += C.NGW) {
        const int mi = row_mi(row); const float* md = MOD + mi * 6144;
        f32x4 acc[4];
#pragma unroll
        for (int j = 0; j < 4; ++j) acc[j] = (f32x4){0.f, 0.f, 0.f, 0.f};
        for (int e = 0; e < 16; ++e) { const int s = __builtin_amdgcn_readfirstlane(SLOT[(size_t)row * 16 + e]);
            if (s >= 0) {
#pragma unroll
                for (int j = 0; j < 4; ++j) acc[j] += ld4bf(YE + (size_t)s * DM + 4 * C.lane + 256 * j); } }
        f32x4 x[4]; float sm = 0.f;
#pragma unroll
        for (int j = 0; j < 4; ++j) { const int col = 4 * C.lane + 256 * j; x[j] = *(const f32x4*)(X + (size_t)row * DM + col) * ALPHA_DN + *(const f32x4*)(md + 5 * DM + col) * acc[j];
            sm += (x[j][0] + x[j][1]) + (x[j][2] + x[j][3]); }
        const float mean = wave_sum(sm) * (1.f / DM); float s2 = 0.f;
#pragma unroll
        for (int j = 0; j < 4; ++j) { x[j] = x[j] - mean; s2 += (x[j][0] * x[j][0] + x[j][1] * x[j][1]) + (x[j][2] * x[j][2] + x[j][3] * x[j][3]); }
        const float rstd = rsqrtf(wave_sum(s2) * (1.f / DM) + LN_EPS);
#pragma unroll
        for (int j = 0; j < 4; ++j) { const int col = 4 * C.lane + 256 * j;
            const f32x4 x2 = x[j] * rstd * *(const f32x4*)(lng + col) + *(const f32x4*)(lnb + col);
            *(f32x4*)(X + (size_t)row * DM + col) = x2;
            if (l < DEPTH - 1) { const float* mn = MODN + mi * 6144; st4bf(H + (size_t)row * DM + col, x2 * (*(const f32x4*)(mn + DM + col) + 1.f) + *(const f32x4*)(mn + col)); }
            else if (row < NLAT) *(f32x4*)(A.out + (size_t)row * DM + col) = x2; }
    }
}


#ifndef GEMM_NOINLINE
#define GEMM_NOINLINE 0
#endif
#if GEMM_NOINLINE
#define GEMM_FN __device__ __noinline__
#else
#define GEMM_FN __device__ __forceinline__
#endif
GEMM_FN void gphase_in(LAS unsigned char* lds, unsigned char* ws, int nN, int G) {
    pg8::Gemm g{(const bf16_t*)(ws + WS_H), (const bf16_t*)(ws + WS_WIN), DM}; pg8::Order<0> S; S.init(MROWS / 256, nN, G, (int)blockIdx.x, nullptr, 0);
    pg8::EpiBf16 E{(bf16_t*)(ws + WS_P), P_LD}; pg8::gemm_phase(lds, g, S, E); }
GEMM_FN void gphase_lora(LAS unsigned char* lds, unsigned char* ws, const float* d0, const float* a0, const float* kal, int G) {
    pg8::Gemm g{(const bf16_t*)(ws + WS_LIN), (const bf16_t*)(ws + WS_WLORA), LORA_K}; pg8::Order<0> S; S.init(MROWS / 256, LORA_N / 256, G, (int)blockIdx.x, nullptr, 0);
    pg8::EpiLora E{(float*)(ws + WS_SCN), (bf16_t*)(ws + WS_G), d0, a0, kal}; pg8::gemm_phase(lds, g, S, E); }
GEMM_FN void gphase_out(LAS unsigned char* lds, unsigned char* ws, const float* modl, int G) {
    pg8::Gemm g{(const bf16_t*)(ws + WS_A2), (const bf16_t*)(ws + WS_WOUT), DM}; pg8::Order<0> S; S.init(MROWS / 256, DM / 256, G, (int)blockIdx.x, nullptr, 0);
    pg8::EpiRes E{(float*)(ws + WS_X), modl}; pg8::gemm_phase(lds, g, S, E); }
GEMM_FN void gphase_e1(LAS unsigned char* lds, unsigned char* ws, int G) {
    pg8::Gemm g{(const bf16_t*)(ws + WS_H), (const bf16_t*)(ws + WS_WE13), DM}; pg8::Order<1> S; S.init(NEXP * 17, 4096 / 256, G, (int)blockIdx.x, (const int*)(ws + WS_IDX), (long)4096 * DM);
    pg8::EpiSwiGLU E{(bf16_t*)(ws + WS_HID)}; pg8::gemm_phase(lds, g, S, E); }
GEMM_FN void gphase_e2(LAS unsigned char* lds, unsigned char* ws, int G) {
    pg8::Gemm g{(const bf16_t*)(ws + WS_HID), (const bf16_t*)(ws + WS_WE2), D_EXP}; pg8::Order<2> S; S.init(NEXP * 17, DM / 256, G, (int)blockIdx.x, nullptr, (long)DM * D_EXP);
    pg8::EpiYE E{(bf16_t*)(ws + WS_YE), (const float*)(ws + WS_GATE)}; pg8::gemm_phase(lds, g, S, E); }

constexpr int NSTEP = 1 + DEPTH * 12;
__global__ void __launch_bounds__(NTHR, 2) mk_fwd(Args KA) {
    extern __shared__ __attribute__((aligned(16))) unsigned char lds_raw[];
    volatile LAS unsigned* MISC = (volatile LAS unsigned*)((LAS unsigned char*)lds_raw + LDS_MISC);
    if (threadIdx.x < 16) MISC[threadIdx.x] = 0u;
    if (threadIdx.x == 0) { LAS unsigned long long* tb = (LAS unsigned long long*)((LAS unsigned char*)lds_raw + LDS_PTAB);
#pragma unroll
        for (int i = 0; i < 37; ++i) tb[i] = (unsigned long long)KA.in[i];
        tb[37] = (unsigned long long)KA.out; tb[38] = (unsigned long long)KA.ws; }
    __syncthreads();
    const int lo = KA.lo, hi = KA.hi;
    unsigned bar_x = 0;
    if (hi - lo > 1) { const XcdBarrier b0 = xcd_barrier_post((unsigned*)(KA.ws + WS_CTL), MISC); bar_x = b0.x; }
#ifndef PH_MASK
#define PH_MASK 0xFFFFFF
#endif
#define RUN(k, ...) do { if (((PH_MASK >> (((k) == 0) ? 0 : 1 + ((k) - 1) % 12 + (((k) - 1) % 12 >= 2 && ((k) - 1) % 12 <= 5 && odd ? 12 : 0))) & 1) && lo <= (k) && (k) < hi) { \
        Ctx C; mkctx(C, (LAS unsigned char*)lds_raw); Args A; ldargs(A, (LAS unsigned char*)lds_raw); unsigned char* ws = A.ws; \
        const float* MODL = (const float*)(ws + WS_MOD) + (size_t)l * 5 * 6144; (void)MODL; \
        __VA_ARGS__; if ((k) + 1 < hi) { XcdBarrier bar; bar.bar = (unsigned*)(ws + WS_CTL); bar.x = bar_x; bar.st = MISC; xcd_barrier(bar); } } } while (0)
    { const bool odd = false; const int l = 0; RUN(0, phase_init(C, A)); }
#pragma unroll 1
    for (int l = 0; l < DEPTH; ++l) {
        const int sb = 1 + l * 12; const bool odd = l & 1;
        RUN(sb + 0, { phase_conv(C, A, l); if (l == 0) phase_modh(C, A, 0); });
        RUN(sb + 1, gphase_in(C.lds, ws, odd ? D_IN_ODD / 256 : D_IN_EVEN_PAD / 256, C.G));
        if (!odd) {
            RUN(sb + 2, phase_ef1(C, A, l));
            RUN(sb + 3, { const int i2 = l >> 1; gphase_lora(C.lds, ws, A.in[I_D0] + (size_t)i2 * 2 * 768, A.in[I_A0] + (size_t)i2 * 2 * 768, A.in[I_KAL] + (size_t)i2 * 768, C.G); });
            RUN(sb + 4, phase_scan(C, A));
            RUN(sb + 5, phase_ef2(C, A, l));
        } else {
            RUN(sb + 2, phase_of1(C, A, l));
            RUN(sb + 3, phase_attn(C, A, l));
        }
        RUN(sb + 6, gphase_out(C.lds, ws, MODL, C.G));
        RUN(sb + 7, phase_rt(C, A, l));
        RUN(sb + 8, phase_tk(C, A));
        RUN(sb + 9, gphase_e1(C.lds, ws, C.G));
        RUN(sb + 10, gphase_e2(C.lds, ws, C.G));
        RUN(sb + 11, phase_cb(C, A, l));
    }
#undef RUN
}

#ifdef PHASE_PROBE
#define PROBE_PRE extern __shared__ __attribute__((aligned(16))) unsigned char lds_raw[]; Ctx C; mkctx(C, (LAS unsigned char*)lds_raw); unsigned char* ws = A.ws; (void)ws;
__global__ void __launch_bounds__(NTHR, 2) pr_init(Args A) { PROBE_PRE phase_init(C, A); }
__global__ void __launch_bounds__(NTHR, 2) pr_conv(Args A) { PROBE_PRE phase_conv(C, A, A.lo); }
__global__ void __launch_bounds__(NTHR, 2) pr_modh(Args A) { PROBE_PRE phase_modh(C, A, A.lo); }
__global__ void __launch_bounds__(NTHR, 2) pr_ef1(Args A) { PROBE_PRE phase_ef1(C, A, A.lo); }
__global__ void __launch_bounds__(NTHR, 2) pr_scan(Args A) { PROBE_PRE phase_scan(C, A); }
__global__ void __launch_bounds__(NTHR, 2) pr_ef2(Args A) { PROBE_PRE phase_ef2(C, A, A.lo); }
__global__ void __launch_bounds__(NTHR, 2) pr_of1(Args A) { PROBE_PRE phase_of1(C, A, A.lo); }
__global__ void __launch_bounds__(NTHR, 2) pr_attn(Args A) { PROBE_PRE phase_attn(C, A, A.lo); }
__global__ void __launch_bounds__(NTHR, 2) pr_rt(Args A) { PROBE_PRE phase_rt(C, A, A.lo); }
__global__ void __launch_bounds__(NTHR, 2) pr_tk(Args A) { PROBE_PRE phase_tk(C, A); }
__global__ void __launch_bounds__(NTHR, 2) pr_cb(Args A) { PROBE_PRE phase_cb(C, A, A.lo); }
__global__ void __launch_bounds__(NTHR, 2) pr_gemm_in(Args A) { PROBE_PRE pg8::Gemm g{(const bf16_t*)(ws + WS_H), (const bf16_t*)(ws + WS_WIN), DM}; pg8::Order<0> S; S.init(MROWS / 256, A.lo, C.G, (int)blockIdx.x, nullptr, 0);
                      pg8::EpiBf16 E{(bf16_t*)(ws + WS_P), P_LD}; pg8::gemm_phase(C.lds, g, S, E); }
__global__ void __launch_bounds__(NTHR, 2) pr_gemm_lora(Args A) { PROBE_PRE pg8::Gemm g{(const bf16_t*)(ws + WS_LIN), (const bf16_t*)(ws + WS_WLORA), LORA_K}; pg8::Order<0> S; S.init(MROWS / 256, LORA_N / 256, C.G, (int)blockIdx.x, nullptr, 0);
                          const int i2 = A.lo; pg8::EpiLora E{(float*)(ws + WS_SCN), (bf16_t*)(ws + WS_G), A.in[I_D0] + (size_t)i2 * 2 * 768, A.in[I_A0] + (size_t)i2 * 2 * 768, A.in[I_KAL] + (size_t)i2 * 768};
                          pg8::gemm_phase(C.lds, g, S, E); }
__global__ void __launch_bounds__(NTHR, 2) pr_gemm_out(Args A) { PROBE_PRE pg8::Gemm g{(const bf16_t*)(ws + WS_A2), (const bf16_t*)(ws + WS_WOUT), DM}; pg8::Order<0> S; S.init(MROWS / 256, DM / 256, C.G, (int)blockIdx.x, nullptr, 0);
                      pg8::EpiRes E{(float*)(ws + WS_X), (const float*)(ws + WS_MOD)}; pg8::gemm_phase(C.lds, g, S, E); }
__global__ void __launch_bounds__(NTHR, 2) pr_gemm_e1(Args A) { PROBE_PRE pg8::Gemm g{(const bf16_t*)(ws + WS_H), (const bf16_t*)(ws + WS_WE13), DM}; pg8::Order<1> S; S.init(NEXP * 17, 4096 / 256, C.G, (int)blockIdx.x, (const int*)(ws + WS_IDX), (long)4096 * DM);
                      pg8::EpiSwiGLU E{(bf16_t*)(ws + WS_HID)}; pg8::gemm_phase(C.lds, g, S, E); }
__global__ void __launch_bounds__(NTHR, 2) pr_gemm_e2(Args A) { PROBE_PRE pg8::Gemm g{(const bf16_t*)(ws + WS_HID), (const bf16_t*)(ws + WS_WE2), D_EXP}; pg8::Order<2> S; S.init(NEXP * 17, DM / 256, C.G, (int)blockIdx.x, nullptr, (long)DM * D_EXP);
                       pg8::EpiYE E{(bf16_t*)(ws + WS_YE), (const float*)(ws + WS_GATE)}; pg8::gemm_phase(C.lds, g, S, E); }
#endif

extern "C" void kernel_launch(void* const* d_in, const int* in_sizes, int n_in, void* d_out, int out_size, void* d_ws, size_t ws_size, hipStream_t stream) {
    static int grid = 0;
    if (grid == 0) {
        if (n_in != 37 || out_size != NLAT * DM || ws_size < WS_END) { fprintf(stderr, "kernel_launch: unexpected shapes: n_in %d out %d ws %zu (need %zu)\n", n_in, out_size, ws_size, (size_t)WS_END); grid = -1; return; }
        int dev = 0, cus = 0, per_cu = 0;
        if (hipGetDevice(&dev) != hipSuccess || hipDeviceGetAttribute(&cus, hipDeviceAttributeMultiprocessorCount, dev) != hipSuccess) { grid = -1; return; }
        if (hipFuncSetAttribute((const void*)mk_fwd, hipFuncAttributeMaxDynamicSharedMemorySize, LDS_BYTES) != hipSuccess) { fprintf(stderr, "kernel_launch: hipFuncSetAttribute failed\n"); grid = -1; return; }
        if (hipOccupancyMaxActiveBlocksPerMultiprocessor(&per_cu, (const void*)mk_fwd, NTHR, LDS_BYTES) != hipSuccess || per_cu < 1) fprintf(stderr, "kernel_launch: occupancy query reports %d\n", per_cu);
        (void)hipGetLastError();
        grid = cus;
    }
    if (grid < 0) return;
    (void)hipMemsetAsync((char*)d_ws + WS_CTL, 0, CTL_BYTES, stream);
    Args a{};
    for (int i = 0; i < 37; ++i) a.in[i] = (const float*)d_in[i];
    a.out = (float*)d_out; a.ws = (unsigned char*)d_ws;
#if MK_MULTI
    for (int k = 0; k < NSTEP; ++k) {
        if (k >= 1) { const int l = (k - 1) / 12, s = (k - 1) % 12; if ((l & 1) && (s == 4 || s == 5)) continue; }
        a.lo = k; a.hi = k + 1;
        hipLaunchKernelGGL(mk_fwd, dim3(grid), dim3(NTHR), LDS_BYTES, stream, a);
    }
#else
    a.lo = 0; a.hi = NSTEP;
    hipLaunchKernelGGL(mk_fwd, dim3(grid), dim3(NTHR), LDS_BYTES, stream, a);
#endif
    const hipError_t le = hipPeekAtLastError();
    if (le != hipSuccess) fprintf(stderr, "kernel_launch: launch failed: %s\n", hipGetErrorName(le));
}
```

```cpp
#include <hip/hip_runtime.h>
#include <cstdio>
#include <cstdint>
#include <cmath>

#ifndef MK_MULTI
#define MK_MULTI 0
#endif

#define GAS __attribute__((address_space(1)))
#define LAS __attribute__((address_space(3)))
typedef unsigned short bf16_t;
typedef short bf16x8 __attribute__((ext_vector_type(8)));
typedef float f32x4 __attribute__((ext_vector_type(4)));
typedef float f32x2 __attribute__((ext_vector_type(2)));
typedef float f32x16 __attribute__((ext_vector_type(16)));
typedef unsigned u32x4 __attribute__((ext_vector_type(4)));
typedef unsigned u32x2 __attribute__((ext_vector_type(2)));
typedef __bf16 bf16x2_t __attribute__((ext_vector_type(2)));

constexpr int NB = 4, TT = 8192, DM = 1024, NLAT = NB * TT, CTXL = 256, NCTX = NB * CTXL, MROWS = NLAT + NCTX;
constexpr int DEPTH = 4;
constexpr int D_CONV = 256, RW_H = 12, RW_K = 64, D_RWKV = 768, RWKV_COLS = 2688, D_IN_EVEN = 3456, D_IN_EVEN_PAD = 3584;
constexpr int D_DIFF = 768, D_GMLP = 256, D_IN_ODD = 2816;
constexpr int NEXP = 16, D_EXP = 2048, CAP_L = 1024, CAP_C = 32, ESLOTS = 4352;
constexpr int P_LD = 3584;
constexpr int LORA_K = 384, LORA_N = 3840;
constexpr int LKEYS = CTXL + TT;
constexpr float ALPHA_DN = 1.6817928305074290f;
constexpr float DECAY_SCALE = 0.6065306597126334f;
constexpr float GN_EPS = 64e-5f, LN_EPS = 1e-5f, RMS_EPS = 1e-5f;

constexpr size_t al256(size_t x) { return (x + 255) & ~(size_t)255; }
constexpr size_t WS_CTL = 0;
constexpr size_t CTL_BYTES = 65536;
constexpr size_t WS_MOD = WS_CTL + CTL_BYTES;
constexpr size_t WS_WIN = WS_MOD + al256((size_t)DEPTH * 5 * 6144 * 4);
constexpr size_t WS_WOUT = WS_WIN + (size_t)D_IN_EVEN_PAD * DM * 2;
constexpr size_t WS_WLORA = WS_WOUT + (size_t)DM * DM * 2;
constexpr size_t WS_WE13 = WS_WLORA + (size_t)LORA_N * LORA_K * 2;
constexpr size_t WS_WE2 = WS_WE13 + (size_t)NEXP * 4096 * DM * 2;
constexpr size_t WS_X = WS_WE2 + (size_t)NEXP * DM * D_EXP * 2;
constexpr size_t WS_H = WS_X + (size_t)MROWS * DM * 4;
constexpr size_t WS_A2 = WS_H + (size_t)MROWS * DM * 2;
constexpr size_t WS_P = WS_A2 + (size_t)MROWS * DM * 2;
constexpr size_t WS_AFF = WS_P + (size_t)MROWS * P_LD * 2;
constexpr size_t WS_SLOT = WS_AFF + (size_t)MROWS * 16 * 4;
constexpr size_t WS_IDX = WS_SLOT + (size_t)MROWS * 16 * 4;
constexpr size_t WS_GATE = WS_IDX + al256((size_t)NEXP * ESLOTS * 4);
constexpr size_t WS_R2 = WS_GATE + al256((size_t)NEXP * ESLOTS * 4);
constexpr size_t WS_SCN = WS_R2;
constexpr size_t WS_G = WS_SCN + (size_t)MROWS * 12 * 9 * 64 * 4;
constexpr size_t WS_LIN = WS_G + (size_t)MROWS * 768 * 2;
constexpr size_t WS_EVEN_END = WS_LIN + (size_t)MROWS * 384 * 2;
constexpr size_t WS_Y = WS_P;
constexpr size_t WS_Q = WS_R2;
constexpr size_t WS_KA = WS_Q + (size_t)MROWS * 768 * 2;
constexpr size_t WS_VT = WS_KA + (size_t)NB * LKEYS * 768 * 2;
constexpr size_t WS_HID = WS_R2;
constexpr size_t WS_YE = WS_HID + (size_t)NEXP * ESLOTS * D_EXP * 2;
constexpr size_t WS_END = WS_EVEN_END;
static_assert(WS_END <= (size_t)2147483648ull, "workspace over 2 GiB");
static_assert((size_t)2 * MROWS * 768 * 4 <= (size_t)MROWS * P_LD * 2, "Y aliases P");
static_assert(WS_YE + (size_t)NEXP * ESLOTS * DM * 2 <= WS_END, "moe region");

constexpr int LDS_BYTES = 147456;
constexpr int LDS_MISC = 140 * 1024;
constexpr int LDS_PTAB = LDS_MISC + 256;
constexpr int NWAVES = 8, NTHR = 512;

__device__ __forceinline__ unsigned f2bf(float f) { unsigned u = __float_as_uint(f); return (u + 0x7fffu + ((u >> 16) & 1u)) >> 16; }
__device__ __forceinline__ unsigned pk2(float lo, float hi) { f32x2 v = {lo, hi}; bf16x2_t b = __builtin_convertvector(v, bf16x2_t); return __builtin_bit_cast(unsigned, b); }
__device__ __forceinline__ float bflo(unsigned u) { return __uint_as_float(u << 16); }
__device__ __forceinline__ float bfhi(unsigned u) { return __uint_as_float(u & 0xffff0000u); }
__device__ __forceinline__ float bf2f(bf16_t b) { return __uint_as_float((unsigned)b << 16); }
__device__ __forceinline__ float sigmoidf_(float x) { return 1.f / (1.f + __expf(-x)); }
__device__ __forceinline__ float wave_sum(float v) {
#pragma unroll
    for (int o = 1; o < 64; o <<= 1) v += __shfl_xor(v, o);
    return v;
}
__device__ __forceinline__ float sum16(float v) {
#pragma unroll
    for (int o = 1; o < 16; o <<= 1) v += __shfl_xor(v, o);
    return v;
}
__device__ __forceinline__ float gelu_erf(float x) { return 0.5f * x * (1.f + erff(x * 0.70710678118654752f)); }

#define XB_TMO      128
#define XB_XCNT(j)  (256  + 64 * (j))
#define XB_XSUB(j)  (1280 + 64 * (j))
#define XB_XGEN(j)  (2304 + 64 * (j))
#define XB_TOP      3328
#define XB_TOPGEN   3392
#define XCD_BAR_WORDS 3456
#define XB_SPIN_CAP (1u << 20)

__device__ __forceinline__ unsigned xb_ld(unsigned* p)              { return __hip_atomic_load(p, __ATOMIC_RELAXED, __HIP_MEMORY_SCOPE_AGENT); }
__device__ __forceinline__ unsigned xb_add(unsigned* p, unsigned v) { return __hip_atomic_fetch_add(p, v, __ATOMIC_RELAXED, __HIP_MEMORY_SCOPE_AGENT); }
__device__ __forceinline__ unsigned xb_xcc_id() { return (unsigned)__builtin_amdgcn_s_getreg((3 << 11) | 20) & 0xFu; }
#define XB_SPIN(cond, bar) do { unsigned _sp = 0; while (cond) { __builtin_amdgcn_s_sleep(1); \
    if ((++_sp & 255u) == 0u) { if (xb_ld(&(bar)[XB_TMO])) break; if (_sp > XB_SPIN_CAP) { atomicAdd(&(bar)[XB_TMO], 1u); break; } } } } while (0)

struct XcdBarrier { unsigned* bar; unsigned x; volatile LAS unsigned* st; };

__device__ __forceinline__ XcdBarrier xcd_barrier_post(unsigned* bar, volatile LAS unsigned* st) {
    XcdBarrier b; b.bar = bar; b.x = xb_xcc_id(); b.st = st;
    if (threadIdx.x == 0) (void)xb_add(&bar[XB_XCNT(b.x)], 1u);
    return b;
}
__device__ __forceinline__ void xcd_barrier_complete(unsigned* bar, unsigned x, unsigned& nloc, unsigned& nx) {
    const unsigned G = gridDim.x * gridDim.y * gridDim.z;
    unsigned sum, cnt, mine, sp = 0u;
    for (;;) {
        sum = 0u; cnt = 0u; mine = 0u;
#pragma unroll
        for (unsigned j = 0; j < 16; ++j) { const unsigned c = xb_ld(&bar[XB_XCNT(j)]); sum += c; cnt += (c > 0u) ? 1u : 0u; mine = (j == x) ? c : mine; }
        if (sum == G) break;
        __builtin_amdgcn_s_sleep(1);
        if ((++sp & 255u) == 0u) { if (xb_ld(&bar[XB_TMO])) break; if (sp > XB_SPIN_CAP) { atomicAdd(&bar[XB_TMO], 1u); break; } }
    }
    nloc = mine > 0u ? mine : 1u; nx = cnt > 0u ? cnt : 1u;
}
__device__ __forceinline__ void xcd_barrier(const XcdBarrier& b) {
    asm volatile("s_waitcnt vmcnt(0)" ::: "memory");
    __syncthreads();
    if (threadIdx.x == 0) {
        unsigned* bar = b.bar;
        __builtin_amdgcn_s_waitcnt(0);
        unsigned nloc = b.st[0], nx = b.st[1];
        if (nloc == 0u) { xcd_barrier_complete(bar, b.x, nloc, nx); b.st[0] = nloc; b.st[1] = nx; }
        const unsigned old = xb_add(&bar[XB_XSUB(b.x)], 1u);
        const unsigned gen = old / nloc;
        if (old + 1u == (gen + 1u) * nloc) {
            __builtin_amdgcn_fence(__ATOMIC_RELEASE, "agent");
            asm volatile("s_waitcnt vmcnt(0)" ::: "memory");
            const unsigned og = xb_add(&bar[XB_TOP], 1u);
            const unsigned tg = og / nx;
            if (og + 1u == (tg + 1u) * nx) xb_add(&bar[XB_TOPGEN], 1u);
            else XB_SPIN(xb_ld(&bar[XB_TOPGEN]) == tg, bar);
            __builtin_amdgcn_fence(__ATOMIC_ACQUIRE, "agent");
            xb_add(&bar[XB_XGEN(b.x)], 1u);
            asm volatile("s_waitcnt vmcnt(0)" ::: "memory");
        } else {
            XB_SPIN(xb_ld(&bar[XB_XGEN(b.x)]) == gen, bar);
            __builtin_amdgcn_fence(__ATOMIC_ACQUIRE, "agent");
            asm volatile("s_waitcnt vmcnt(0)" ::: "memory");
        }
    }
    __syncthreads();
}

namespace pg8 {
constexpr int BM = 256, BK = 64, HALF = 128, HTB = HALF * BK * 2, STAGE_BYTES = 8 * HTB, NXCD = 8, WGM = 8;
__host__ __device__ __forceinline__ int lds_byte(int r, int c) { const int st = (r >> 4) * 2 + (c >> 5), rr = r & 15, cc = c & 31, ob = rr * 64 + cc * 2; return st * 1024 + (ob ^ (((ob >> 9) & 1) << 5)); }
__host__ __device__ __forceinline__ void stage_rc(int b, int& R, int& C) { const int st = b / 1024, sb = b % 1024, swz = sb ^ (((sb >> 9) & 1) << 5); R = (st >> 1) * 16 + swz / 64; C = (st & 1) * 32 + (swz % 64) / 2; }

struct Unit { int pm, pn; };
struct Gemm { const bf16_t* A; const bf16_t* Bt; int K; };

template <int MODE> struct Order {
    int nM, nN, nwg, G, c; const int* idx; long bstride;
    __device__ __forceinline__ void init(int nM_, int nN_, int G_, int c_, const int* idx_, long bstride_) { nM = nM_; nN = nN_; nwg = nM * nN; G = G_; c = c_; idx = idx_; bstride = bstride_; }
    __device__ __forceinline__ bool next(int i, Unit& u) const {
        const long L = (long)i * G + c; if (L >= nwg) return false;
        int wgid = (int)L; { const int q = nwg / NXCD, r = nwg % NXCD, xcd = wgid % NXCD, off = wgid / NXCD; wgid = (xcd < r ? xcd * (q + 1) : r * (q + 1) + (xcd - r) * q) + off; }
        const int nig = WGM * nN, gid = wgid / nig, fm = gid * WGM, gsz = (nM - fm) < WGM ? (nM - fm) : WGM;
        u.pm = fm + ((wgid % nig) % gsz); u.pn = (wgid % nig) / gsz; return true;
    }
    __device__ __forceinline__ unsigned arow(const Unit& u, int r) const { if (MODE == 1) return (unsigned)idx[u.pm * BM + r]; return (unsigned)(u.pm * BM + r); }
    __device__ __forceinline__ long bbase(const Unit& u, int K) const { long o = (long)u.pn * BM * K; if (MODE != 0) o += (long)(u.pm / 17) * bstride; return o; }
};

template <class Epi, class Sched>
__device__ __forceinline__ void gemm_phase(LAS unsigned char* lds, const Gemm g, const Sched& S, const Epi& E) {
    int tid = threadIdx.x; asm volatile("" : "+v"(tid));
    const int wid = __builtin_amdgcn_readfirstlane(tid >> 6), wr = wid >> 2, wc = wid & 3;
    const int K = g.K, nt = K / BK;
    unsigned voffB[2];
    { const int lane = tid & 63, fr = lane & 15, fq = lane >> 4; (void)fr; (void)fq; }
#pragma unroll
    for (int i = 0; i < 2; ++i) { int R, Cc; stage_rc(tid * 16 + i * 8192, R, Cc); voffB[i] = (unsigned)(R * K + Cc) * 2u; }
    const size_t kstep = (size_t)(BK * 2);
    const size_t hstep = (size_t)HALF * K * 2;
    const unsigned ldsw = (unsigned)wid * 1024u;
    const int aoff = lds_byte(wr * 64 + (tid & 15), ((tid & 63) >> 4) * 8), boff = lds_byte(wc * 32 + (tid & 15), ((tid & 63) >> 4) * 8);
#define PG8_SA(b, h) (((b) * 2 + (h)) * HTB)
#define PG8_SB(b, h) ((4 + (b) * 2 + (h)) * HTB)
#define PG8_STAGE(bufoff, gbase, voff) do { _Pragma("unroll") for (int _i = 0; _i < 2; ++_i) \
        __builtin_amdgcn_global_load_lds((const unsigned*)((const char*)(gbase) + (voff)[_i]), (LAS unsigned*)(lds + (bufoff) + ldsw + _i * 8192), 16, 0, 0); } while (0)
#define PG8_LDA(dst, b, h) do { _Pragma("unroll") for (int m = 0; m < 4; ++m) _Pragma("unroll") for (int k = 0; k < 2; ++k) dst[m][k] = *(const LAS bf16x8*)(lds + PG8_SA(b, h) + aoff + m * 2048 + k * 1024); } while (0)
#define PG8_LDB(dst, b, h) do { _Pragma("unroll") for (int n = 0; n < 2; ++n) _Pragma("unroll") for (int k = 0; k < 2; ++k) dst[n][k] = *(const LAS bf16x8*)(lds + PG8_SB(b, h) + boff + n * 2048 + k * 1024); } while (0)
#define PG8_MMA(ai, bj, At, Bt) do { __builtin_amdgcn_s_setprio(1); _Pragma("unroll") for (int m = 0; m < 4; ++m) _Pragma("unroll") for (int n = 0; n < 2; ++n) _Pragma("unroll") for (int k = 0; k < 2; ++k) \
        acc[ai][bj][m][n] = __builtin_amdgcn_mfma_f32_16x16x32_bf16(Bt[n][k], At[m][k], acc[ai][bj][m][n], 0, 0, 0); __builtin_amdgcn_s_setprio(0); } while (0)
#define PG8_WAIT_V(n) asm volatile("s_waitcnt vmcnt(" #n ")" ::: "memory")
#define PG8_WAIT_L(n) asm volatile("s_waitcnt lgkmcnt(" #n ")" ::: "memory")
#define PG8_BAR __builtin_amdgcn_s_barrier()
#define PG8_SCHED __builtin_amdgcn_sched_barrier(0)
#define PG8_ROWOFFS(dst, u, tq) do { _Pragma("unroll") for (int _i = 0; _i < 2; ++_i) { int _R, _C; stage_rc((tq) * 16 + _i * 8192, _R, _C); _Pragma("unroll") for (int _h = 0; _h < 2; ++_h) dst[_h][_i] = (S.arow(u, _h * HALF + _R) * (unsigned)K + (unsigned)_C) * 2u; } } while (0)
    Unit cur, nxt; int ui = 0;
    if (!S.next(0, cur)) return;
    f32x4 acc[2][2][4][2];
#pragma unroll
    for (int a = 0; a < 2; ++a)
#pragma unroll
        for (int b = 0; b < 2; ++b)
#pragma unroll
            for (int m = 0; m < 4; ++m)
#pragma unroll
                for (int n = 0; n < 2; ++n) acc[a][b][m][n] = (f32x4){0.f, 0.f, 0.f, 0.f};
    bf16x8 At[4][2], B0[2][2], B1[2][2];
    unsigned vcur[2][2];
    PG8_ROWOFFS(vcur, cur, tid);
    const char* const Ab = (const char*)g.A;
    const char* cB = (const char*)g.Bt + (size_t)S.bbase(cur, K) * 2;
    PG8_STAGE(PG8_SB(0, 0), cB, voffB); PG8_STAGE(PG8_SA(0, 0), Ab, vcur[0]); PG8_STAGE(PG8_SB(0, 1), cB + hstep, voffB); PG8_STAGE(PG8_SA(0, 1), Ab, vcur[1]);
    if (wr == 1) PG8_BAR;
    PG8_WAIT_V(4); PG8_BAR;
    PG8_STAGE(PG8_SB(1, 0), cB + kstep, voffB); PG8_STAGE(PG8_SA(1, 0), Ab + kstep, vcur[0]); PG8_STAGE(PG8_SB(1, 1), cB + hstep + kstep, voffB);
    PG8_WAIT_V(6); PG8_BAR;
    for (;;) {
        const bool has_next = S.next(ui + 1, nxt);
        const char* nB = has_next ? (const char*)g.Bt + (size_t)S.bbase(nxt, K) * 2 : cB;
        for (int t = 0; t < nt; t += 2) {
            const bool last = (t == nt - 2);
            const char* a1 = Ab + (size_t)(t + 1) * kstep;
            const char* a2 = last ? Ab : Ab + (size_t)(t + 2) * kstep; const char* b2 = last ? nB : cB + (size_t)(t + 2) * kstep;
            const char* a3 = a2 + kstep; const char* b3 = b2 + kstep;
            PG8_LDB(B0, 0, 0); PG8_SCHED; PG8_LDA(At, 0, 0); PG8_STAGE(PG8_SA(1, 1), a1, vcur[1]);
            PG8_WAIT_L(8); PG8_BAR; PG8_WAIT_L(0); PG8_MMA(0, 0, At, B0); PG8_BAR; PG8_SCHED;
            if (last && has_next) { int tq = tid; asm volatile("" : "+v"(tq)); PG8_ROWOFFS(vcur, nxt, tq); }
            PG8_LDB(B1, 0, 1); PG8_STAGE(PG8_SB(0, 0), b2, voffB);
            PG8_BAR; PG8_WAIT_L(0); PG8_MMA(0, 1, At, B1); PG8_BAR;
            PG8_LDA(At, 0, 1); PG8_STAGE(PG8_SA(0, 0), a2, vcur[0]);
            PG8_BAR; PG8_WAIT_L(0); PG8_MMA(1, 0, At, B0); PG8_BAR; PG8_SCHED;
            PG8_STAGE(PG8_SB(0, 1), b2 + hstep, voffB);
            PG8_WAIT_V(6); PG8_BAR; PG8_MMA(1, 1, At, B1); PG8_BAR;
            PG8_LDB(B0, 1, 0); PG8_SCHED; PG8_LDA(At, 1, 0); PG8_STAGE(PG8_SA(0, 1), a2, vcur[1]);
            PG8_WAIT_L(8); PG8_BAR; PG8_WAIT_L(0); PG8_MMA(0, 0, At, B0); PG8_BAR; PG8_SCHED;
            PG8_LDB(B1, 1, 1); PG8_STAGE(PG8_SB(1, 0), b3, voffB);
            PG8_BAR; PG8_WAIT_L(0); PG8_MMA(0, 1, At, B1); PG8_BAR;
            PG8_LDA(At, 1, 1); PG8_STAGE(PG8_SA(1, 0), a3, vcur[0]);
            PG8_BAR; PG8_WAIT_L(0); PG8_MMA(1, 0, At, B0); PG8_BAR; PG8_SCHED;
            PG8_STAGE(PG8_SB(1, 1), b3 + hstep, voffB);
            PG8_WAIT_V(6); PG8_BAR; PG8_MMA(1, 1, At, B1); PG8_BAR;
        }
        { int tz = tid; asm volatile("" : "+v"(tz)); const int ln = tz & 63; E(acc, cur, wr, wc, ln & 15, ln >> 4); }
        if (!has_next) break;
#pragma unroll
        for (int a = 0; a < 2; ++a)
#pragma unroll
            for (int b = 0; b < 2; ++b)
#pragma unroll
                for (int m = 0; m < 4; ++m)
#pragma unroll
                    for (int n = 0; n < 2; ++n) acc[a][b][m][n] = (f32x4){0.f, 0.f, 0.f, 0.f};
        cur = nxt; cB = nB; ++ui;
    }
    PG8_WAIT_V(0);
    if (wr == 0) PG8_BAR;
    PG8_BAR;
#undef PG8_SA
#undef PG8_SB
#undef PG8_STAGE
#undef PG8_LDA
#undef PG8_LDB
#undef PG8_MMA
#undef PG8_WAIT_V
#undef PG8_WAIT_L
#undef PG8_BAR
#undef PG8_SCHED
#undef PG8_ROWOFFS
}

#define EPI_LOOP for (int ai = 0; ai < 2; ++ai) for (int m = 0; m < 4; ++m) for (int bj = 0; bj < 2; ++bj) for (int n = 0; n < 2; ++n)
struct EpiBf16 {
    bf16_t* O; int ldc;
    __device__ __forceinline__ void operator()(const f32x4 (&acc)[2][2][4][2], const Unit& u, int wr, int wc, int fr, int fq) const {
        const int row0 = u.pm * BM + wr * 64 + fr, col0 = u.pn * BM + wc * 32 + 4 * fq;
#pragma unroll
        for (int ai = 0; ai < 2; ++ai)
#pragma unroll
            for (int m = 0; m < 4; ++m) { bf16_t* rowp = O + (size_t)(row0 + ai * HALF + m * 16) * ldc + col0;
#pragma unroll
                for (int bj = 0; bj < 2; ++bj)
#pragma unroll
                    for (int n = 0; n < 2; ++n) { const f32x4 v = acc[ai][bj][m][n]; u32x2 o; o.x = pk2(v[0], v[1]); o.y = pk2(v[2], v[3]); *(u32x2*)(rowp + bj * HALF + n * 16) = o; } }
    }
};
struct EpiRes {
    float* X; const float* modl;
    __device__ __forceinline__ void operator()(const f32x4 (&acc)[2][2][4][2], const Unit& u, int wr, int wc, int fr, int fq) const {
        const int row0 = u.pm * BM + wr * 64 + fr, col0 = u.pn * BM + wc * 32 + 4 * fq;
        const int mi = (u.pm * BM < NLAT) ? (u.pm * BM) / TT : 4;
        const float* gate = modl + mi * 6144 + 2 * DM;
        f32x4 gv[2][2];
#pragma unroll
        for (int bj = 0; bj < 2; ++bj)
#pragma unroll
            for (int n = 0; n < 2; ++n) gv[bj][n] = *(const f32x4*)(gate + col0 + bj * HALF + n * 16);
#pragma unroll
        for (int ai = 0; ai < 2; ++ai)
#pragma unroll
            for (int m = 0; m < 4; ++m) { float* rowp = X + (size_t)(row0 + ai * HALF + m * 16) * DM + col0;
#pragma unroll
                for (int bj = 0; bj < 2; ++bj)
#pragma unroll
                    for (int n = 0; n < 2; ++n) { f32x4* p = (f32x4*)(rowp + bj * HALF + n * 16); const f32x4 x = *p; *p = x * ALPHA_DN + gv[bj][n] * acc[ai][bj][m][n]; } }
    }
};
struct EpiSwiGLU {
    bf16_t* HID;
    __device__ __forceinline__ void operator()(const f32x4 (&acc)[2][2][4][2], const Unit& u, int wr, int wc, int fr, int fq) const {
        const int row0 = u.pm * BM + wr * 64 + fr, f0 = u.pn * HALF + wc * 32 + 4 * fq;
#pragma unroll
        for (int ai = 0; ai < 2; ++ai)
#pragma unroll
            for (int m = 0; m < 4; ++m) { bf16_t* rowp = HID + (size_t)(row0 + ai * HALF + m * 16) * D_EXP + f0;
#pragma unroll
                for (int n = 0; n < 2; ++n) { const f32x4 a = acc[ai][0][m][n], b = acc[ai][1][m][n]; float h[4];
#pragma unroll
                    for (int j = 0; j < 4; ++j) h[j] = a[j] / (1.f + __expf(-a[j])) * b[j];
                    u32x2 o; o.x = pk2(h[0], h[1]); o.y = pk2(h[2], h[3]); *(u32x2*)(rowp + n * 16) = o; } }
    }
};
struct EpiYE {
    bf16_t* YE; const float* gate;
    __device__ __forceinline__ void operator()(const f32x4 (&acc)[2][2][4][2], const Unit& u, int wr, int wc, int fr, int fq) const {
        const int row0 = u.pm * BM + wr * 64 + fr, col0 = u.pn * BM + wc * 32 + 4 * fq;
#pragma unroll
        for (int ai = 0; ai < 2; ++ai)
#pragma unroll
            for (int m = 0; m < 4; ++m) { const int row = row0 + ai * HALF + m * 16; const float gt = gate[row]; bf16_t* rowp = YE + (size_t)row * DM + col0;
#pragma unroll
                for (int bj = 0; bj < 2; ++bj)
#pragma unroll
                    for (int n = 0; n < 2; ++n) { const f32x4 v = acc[ai][bj][m][n] * gt; u32x2 o; o.x = pk2(v[0], v[1]); o.y = pk2(v[2], v[3]); *(u32x2*)(rowp + bj * HALF + n * 16) = o; } }
    }
};
struct EpiLora {
    float* SCN; bf16_t* G; const float* decay0; const float* a0; const float* kalpha;
    __device__ __forceinline__ void operator()(const f32x4 (&acc)[2][2][4][2], const Unit& u, int wr, int wc, int fr, int fq) const {
        const int row0 = u.pm * BM + wr * 64 + fr;
        const int seg = u.pn / 3, cb = (u.pn % 3) * BM + wc * 32 + 4 * fq;
#pragma unroll
        for (int bj = 0; bj < 2; ++bj)
#pragma unroll
            for (int n = 0; n < 2; ++n) {
                const int col = cb + bj * HALF + n * 16, head = col >> 6, kx = col & 63;
                if (seg < 2) {
                    const f32x4 d0 = *(const f32x4*)(decay0 + seg * 768 + col);
#pragma unroll
                    for (int ai = 0; ai < 2; ++ai)
#pragma unroll
                        for (int m = 0; m < 4; ++m) { const int row = row0 + ai * HALF + m * 16; f32x4 w;
#pragma unroll
                            for (int j = 0; j < 4; ++j) w[j] = __expf(-DECAY_SCALE * sigmoidf_(d0[j] + acc[ai][bj][m][n][j]));
                            *(f32x4*)(SCN + ((size_t)(row * 12 + head) * 9 + 3 + 3 * seg) * 64 + kx) = w; }
                } else if (seg < 4) {
                    const int d = seg - 2;
                    const f32x4 a00 = *(const f32x4*)(a0 + d * 768 + col), kal = *(const f32x4*)(kalpha + col);
#pragma unroll
                    for (int ai = 0; ai < 2; ++ai)
#pragma unroll
                        for (int m = 0; m < 4; ++m) { const int row = row0 + ai * HALF + m * 16; float* base = SCN + (size_t)(row * 12 + head) * 9 * 64 + kx;
                            const f32x4 kk = *(const f32x4*)(base + 1 * 64); const f32x4 ks = *(const f32x4*)(base + (5 + 3 * d) * 64); f32x4 bb, kr;
#pragma unroll
                            for (int j = 0; j < 4; ++j) { const float a = sigmoidf_(a00[j] + acc[ai][bj][m][n][j]); bb[j] = kk[j] * a; kr[j] = ks[j] * (1.f + (a - 1.f) * kal[j]); }
                            *(f32x4*)(base + (4 + 3 * d) * 64) = bb; *(f32x4*)(base + (5 + 3 * d) * 64) = kr; }
                } else {
#pragma unroll
                    for (int ai = 0; ai < 2; ++ai)
#pragma unroll
                        for (int m = 0; m < 4; ++m) { const int row = row0 + ai * HALF + m * 16; const f32x4 v = acc[ai][bj][m][n]; u32x2 o; o.x = pk2(v[0], v[1]); o.y = pk2(v[2], v[3]);
                            *(u32x2*)(G + (size_t)row * 768 + col) = o; }
                }
            }
    }
};
}

struct Args { const float* in[37]; float* out; unsigned char* ws; int lo, hi; };
enum { I_X = 0, I_C, I_CTX, I_CCTX, I_WMOD, I_BMOD, I_LNG, I_LNB, I_EWIN, I_EWOUT, I_CONVW, I_MU, I_DUP, I_D0, I_AUP, I_A0, I_GUP, I_KXI, I_KAL, I_RBON, I_GNG, I_GNB,
       I_OWIN, I_OWOUT, I_LQ1, I_LK1, I_LQ2, I_LK2, I_SUBG, I_GLNG, I_GLNB, I_GWS, I_GBS, I_WR, I_WE1, I_WE3, I_WE2 };

struct Ctx {
    LAS unsigned char* lds;
    int tid, lane, wave, G, vcu, gw, NGW;
};
__device__ __forceinline__ void mkctx(Ctx& C, LAS unsigned char* lds) {
    int tid = threadIdx.x; asm volatile("" : "+v"(tid));
    C.lds = lds; C.tid = tid; C.lane = tid & 63; C.wave = __builtin_amdgcn_readfirstlane(tid >> 6);
    C.G = gridDim.x; { const int bx = blockIdx.x; C.vcu = (C.G % 8 == 0) ? (bx % 8) * (C.G / 8) + bx / 8 : bx; }
    C.gw = blockIdx.x * NWAVES + C.wave; C.NGW = C.G * NWAVES;
}
__device__ __forceinline__ void ldargs(Args& A, LAS unsigned char* lds) {
    LAS const u32x2* tb = (LAS const u32x2*)(lds + LDS_PTAB); asm volatile("" : "+v"(tb));
#pragma unroll
    for (int i = 0; i < 37; ++i) { const u32x2 v = tb[i]; A.in[i] = (const float*)(((unsigned long long)(unsigned)__builtin_amdgcn_readfirstlane((int)v.y) << 32) | (unsigned)__builtin_amdgcn_readfirstlane((int)v.x)); }
    { const u32x2 v = tb[37]; A.out = (float*)(((unsigned long long)(unsigned)__builtin_amdgcn_readfirstlane((int)v.y) << 32) | (unsigned)__builtin_amdgcn_readfirstlane((int)v.x)); }
    { const u32x2 v = tb[38]; A.ws = (unsigned char*)(((unsigned long long)(unsigned)__builtin_amdgcn_readfirstlane((int)v.y) << 32) | (unsigned)__builtin_amdgcn_readfirstlane((int)v.x)); }
    A.lo = 0; A.hi = 0;
}
__device__ __forceinline__ int row_mi(int row) { return row < NLAT ? (row >> 13) : 4; }

__device__ __forceinline__ void phase_init(const Ctx& C, const Args& A) {
    unsigned char* ws = A.ws;
    float* MOD = (float*)(ws + WS_MOD);
    LAS float* sv = (LAS float*)C.lds;
    LAS float* red = sv + 5 * 1024;
    for (int i = C.tid; i < 5 * 1024; i += NTHR) { const int v = i >> 10, k = i & 1023; const float c = (v < 4) ? A.in[I_C][v * DM + k] : A.in[I_CCTX][k]; sv[i] = c / (1.f + __expf(-c)); }
    __syncthreads();
    const int j = C.tid & 127, kp = C.tid >> 7;
    for (int it = blockIdx.x; it < DEPTH * 48; it += C.G) {
        const int l = it / 48, cg = it % 48, col = cg * 128 + j;
        const float* W = A.in[I_WMOD] + (size_t)l * DM * 6144 + col;
        float a0 = 0.f, a1 = 0.f, a2 = 0.f, a3 = 0.f, a4 = 0.f;
#pragma unroll 4
        for (int k = kp * 256; k < kp * 256 + 256; ++k) { const float w = W[(size_t)k * 6144]; a0 += sv[k] * w; a1 += sv[1024 + k] * w; a2 += sv[2048 + k] * w; a3 += sv[3072 + k] * w; a4 += sv[4096 + k] * w; }
        red[(kp * 5 + 0) * 128 + j] = a0; red[(kp * 5 + 1) * 128 + j] = a1; red[(kp * 5 + 2) * 128 + j] = a2; red[(kp * 5 + 3) * 128 + j] = a3; red[(kp * 5 + 4) * 128 + j] = a4;
        __syncthreads();
        for (int o = C.tid; o < 5 * 128; o += NTHR) { const int v = o >> 7, jj = o & 127; const int cc = cg * 128 + jj;
            const float s = red[(0 * 5 + v) * 128 + jj] + red[(1 * 5 + v) * 128 + jj] + red[(2 * 5 + v) * 128 + jj] + red[(3 * 5 + v) * 128 + jj];
            MOD[((size_t)l * 5 + v) * 6144 + cc] = s + A.in[I_BMOD][l * 6144 + cc]; }
        __syncthreads();
    }
    f32x4* X4 = (f32x4*)(ws + WS_X);
    const f32x4* x4 = (const f32x4*)A.in[I_X]; const f32x4* c4 = (const f32x4*)A.in[I_CTX];
    const size_t nl = (size_t)NLAT * DM / 4, nc = (size_t)NCTX * DM / 4;
    for (size_t i = (size_t)blockIdx.x * NTHR + C.tid; i < nl + nc; i += (size_t)C.G * NTHR) X4[i] = (i < nl) ? x4[i] : c4[i - nl];
}

__device__ __forceinline__ void transpose_item(const float* W, int ldw, int k0, int n0, bf16_t* WT, int ldt, int drow0, LAS float* scr, int lane) {
#pragma unroll 8
    for (int k = 0; k < 64; ++k) scr[k * 65 + lane] = W[(size_t)(k0 + k) * ldw + n0 + lane];
    asm volatile("s_waitcnt lgkmcnt(0)" ::: "memory");
    const int c = lane & 7;
#pragma unroll
    for (int j = 0; j < 8; ++j) { const int n = (lane >> 3) + 8 * j; const LAS float* s = scr + (8 * c) * 65 + n;
        u32x4 o; o.x = pk2(s[0 * 65], s[1 * 65]); o.y = pk2(s[2 * 65], s[3 * 65]); o.z = pk2(s[4 * 65], s[5 * 65]); o.w = pk2(s[6 * 65], s[7 * 65]);
        *(u32x4*)(WT + (size_t)(drow0 + n) * ldt + k0 + 8 * c) = o; }
    asm volatile("s_waitcnt lgkmcnt(0)" ::: "memory");
}
__device__ __forceinline__ void phase_conv(const Ctx& C, const Args& A, int l) {
    unsigned char* ws = A.ws;
    const int i2 = l >> 1; const bool odd = (l & 1);
    LAS float* scr = (LAS float*)C.lds + C.wave * (64 * 65);
    bf16_t* WIN = (bf16_t*)(ws + WS_WIN); bf16_t* WOUT = (bf16_t*)(ws + WS_WOUT); bf16_t* WE13 = (bf16_t*)(ws + WS_WE13); bf16_t* WE2 = (bf16_t*)(ws + WS_WE2);
    const int nin = odd ? D_IN_ODD : D_IN_EVEN;
    const float* win = odd ? A.in[I_OWIN] + (size_t)i2 * DM * D_IN_ODD : A.in[I_EWIN] + (size_t)i2 * DM * D_IN_EVEN;
    const float* wout = odd ? A.in[I_OWOUT] + (size_t)i2 * DM * DM : A.in[I_EWOUT] + (size_t)i2 * DM * DM;
    const int n_in = 16 * (nin / 64), n_out = 16 * 16, n_e13 = NEXP * 2 * 16 * 32, n_e2 = NEXP * 32 * 16;
    const int total = n_in + n_out + n_e13 + n_e2;
    for (int it = C.gw; it < total; it += C.NGW) {
        int r = it;
        if (r < n_in) { const int nb = nin / 64, kb = r / nb, nn = r % nb; transpose_item(win, nin, kb * 64, nn * 64, WIN, DM, nn * 64, scr, C.lane); continue; } r -= n_in;
        if (r < n_out) { const int kb = r / 16, nn = r % 16; transpose_item(wout, DM, kb * 64, nn * 64, WOUT, DM, nn * 64, scr, C.lane); continue; } r -= n_out;
        if (r < n_e13) { const int e = r / 1024, q = r % 1024, mat = q / 512, q2 = q % 512, kb = q2 / 32, nn = q2 % 32;
            const float* W = (mat ? A.in[I_WE3] : A.in[I_WE1]) + ((size_t)l * NEXP + e) * DM * D_EXP;
            const int f0 = nn * 64; const int drow = (f0 >> 7) * 256 + mat * 128 + (f0 & 127);
            transpose_item(W, D_EXP, kb * 64, f0, WE13 + (size_t)e * 4096 * DM, DM, drow, scr, C.lane); continue; } r -= n_e13;
        { const int e = r / 512, q = r % 512, kb = q / 16, nn = q % 16;
            const float* W = A.in[I_WE2] + ((size_t)l * NEXP + e) * D_EXP * DM;
            transpose_item(W, DM, kb * 64, nn * 64, WE2 + (size_t)e * DM * D_EXP, D_EXP, nn * 64, scr, C.lane); }
    }
    if (!odd) {
        u32x4* z = (u32x4*)(WIN + (size_t)D_IN_EVEN * DM);
        for (int i = blockIdx.x * NTHR + C.tid; i < (D_IN_EVEN_PAD - D_IN_EVEN) * DM / 8; i += C.G * NTHR) z[i] = (u32x4){0u, 0u, 0u, 0u};
        bf16_t* WL = (bf16_t*)(ws + WS_WLORA);
        const float* dup = A.in[I_DUP] + (size_t)i2 * 2 * 64 * 768; const float* aup = A.in[I_AUP] + (size_t)i2 * 2 * 64 * 768; const float* gup = A.in[I_GUP] + (size_t)i2 * 128 * 768;
        for (int i = blockIdx.x * NTHR + C.tid; i < LORA_N * LORA_K; i += C.G * NTHR) {
            const int kk = i / LORA_N, n = i % LORA_N, seg = n / 768, col = n % 768; float v = 0.f;
            if (seg == 0) { if (kk < 64) v = dup[(size_t)(0 * 64 + kk) * 768 + col]; }
            else if (seg == 1) { if (kk >= 64 && kk < 128) v = dup[(size_t)(1 * 64 + kk - 64) * 768 + col]; }
            else if (seg == 2) { if (kk >= 128 && kk < 192) v = aup[(size_t)(0 * 64 + kk - 128) * 768 + col]; }
            else if (seg == 3) { if (kk >= 192 && kk < 256) v = aup[(size_t)(1 * 64 + kk - 192) * 768 + col]; }
            else { if (kk >= 256) v = gup[(size_t)(kk - 256) * 768 + col]; }
            WL[(size_t)n * LORA_K + kk] = (bf16_t)f2bf(v);
        }
    }
}

__device__ __forceinline__ void phase_modh(const Ctx& C, const Args& A, int l) {
    const float* X = (const float*)(A.ws + WS_X); bf16_t* H = (bf16_t*)(A.ws + WS_H); const float* MOD = (const float*)(A.ws + WS_MOD) + (size_t)l * 5 * 6144;
    for (int row = C.gw; row < MROWS; row += C.NGW) {
        const float* md = MOD + row_mi(row) * 6144;
#pragma unroll
        for (int j = 0; j < 4; ++j) { const int col = 4 * C.lane + 256 * j; const f32x4 x = *(const f32x4*)(X + (size_t)row * DM + col), sh = *(const f32x4*)(md + col), sc = *(const f32x4*)(md + DM + col);
            const f32x4 h = x * (sc + 1.f) + sh; u32x2 o; o.x = pk2(h[0], h[1]); o.y = pk2(h[2], h[3]); *(u32x2*)(H + (size_t)row * DM + col) = o; }
    }
}

__device__ __forceinline__ f32x4 ld4bf(const bf16_t* p) { const u32x2 u = *(const u32x2*)p; return (f32x4){bflo(u.x), bfhi(u.x), bflo(u.y), bfhi(u.y)}; }
__device__ __forceinline__ void st4bf(bf16_t* p, f32x4 v) { u32x2 o; o.x = pk2(v[0], v[1]); o.y = pk2(v[2], v[3]); *(u32x2*)p = o; }
__device__ __forceinline__ void seq_info(int row, bool& hasp, bool& hasn) {
    if (row < NLAT) { const int t = row & (TT - 1); hasp = t > 0; hasn = t < TT - 1; }
    else { const int t = (row - NLAT) & (CTXL - 1); hasp = t > 0; hasn = t < CTXL - 1; }
}
__device__ __forceinline__ void phase_ef1(const Ctx& C, const Args& A, int l) {
    const int i2 = l >> 1; unsigned char* ws = A.ws;
    const bf16_t* P = (const bf16_t*)(ws + WS_P); bf16_t* A2 = (bf16_t*)(ws + WS_A2); float* SCN = (float*)(ws + WS_SCN); bf16_t* LIN = (bf16_t*)(ws + WS_LIN);
    const float* cw = A.in[I_CONVW] + (size_t)i2 * 3 * 256; const float* mu = A.in[I_MU] + (size_t)i2 * RWKV_COLS; const float* kxi = A.in[I_KXI] + (size_t)i2 * 768;
    const f32x4 z4 = {0.f, 0.f, 0.f, 0.f};
    for (int row = C.gw; row < MROWS; row += C.NGW) {
        bool hasp, hasn; seq_info(row, hasp, hasn);
        const bf16_t* p0 = P + (size_t)row * P_LD; const bf16_t* pm = p0 - P_LD; const bf16_t* pp = p0 + P_LD;
        {
            const int j4 = 4 * C.lane;
            const f32x4 bg = ld4bf(p0 + j4), u0 = ld4bf(p0 + 256 + j4) * ld4bf(p0 + 512 + j4);
            const f32x4 um = hasp ? ld4bf(pm + 256 + j4) * ld4bf(pm + 512 + j4) : z4, up = hasn ? ld4bf(pp + 256 + j4) * ld4bf(pp + 512 + j4) : z4;
            const f32x4 w0 = *(const f32x4*)(cw + j4), w1 = *(const f32x4*)(cw + 256 + j4), w2 = *(const f32x4*)(cw + 512 + j4);
            st4bf(A2 + (size_t)row * DM + j4, bg * (w0 * um + w1 * u0 + w2 * up));
        }
#pragma unroll
        for (int it = 0; it < 11; ++it) {
            const int c = it * 256 + 4 * C.lane;
            if (c < RWKV_COLS) {
                const f32x4 x0 = ld4bf(p0 + 768 + c), xm = hasp ? ld4bf(pm + 768 + c) : z4, xp = hasn ? ld4bf(pp + 768 + c) : z4, m4 = *(const f32x4*)(mu + c);
                const f32x4 ps = x0 + m4 * ((xm + xp) * 0.5f - x0);
                if (it < 3) { const int head = c >> 6, kx = c & 63; *(f32x4*)(SCN + ((size_t)(row * 12 + head) * 9 + 0) * 64 + kx) = ps; }
                else if (it < 6) { const int c1 = c - 768, head = c1 >> 6, kx = c1 & 63; const f32x4 kv = ps * *(const f32x4*)(kxi + c1);
                    const float ss = sum16(kv[0] * kv[0] + kv[1] * kv[1] + kv[2] * kv[2] + kv[3] * kv[3]); const float rn = rsqrtf(ss + 1e-12f);
                    float* base = SCN + (size_t)(row * 12 + head) * 9 * 64 + kx;
                    *(f32x4*)(base + 1 * 64) = kv * rn; *(f32x4*)(base + 5 * 64) = ps; *(f32x4*)(base + 8 * 64) = ps; }
                else if (it < 9) { const int c1 = c - 1536, head = c1 >> 6, kx = c1 & 63; *(f32x4*)(SCN + ((size_t)(row * 12 + head) * 9 + 2) * 64 + kx) = ps; }
                else { const int c1 = c - 2304; f32x4 o;
                    if (c1 < 128) { o = (f32x4){tanhf(ps[0]), tanhf(ps[1]), tanhf(ps[2]), tanhf(ps[3])}; }
                    else if (c1 < 256) { o = ps; }
                    else { o = (f32x4){sigmoidf_(ps[0]), sigmoidf_(ps[1]), sigmoidf_(ps[2]), sigmoidf_(ps[3])}; }
                    st4bf(LIN + (size_t)row * LORA_K + c1, o); }
            }
        }
    }
}

__device__ __forceinline__ int scan_row(int i, int b, int d) {
    if (d == 0) return i < CTXL ? NLAT + b * CTXL + i : b * TT + (i - CTXL);
    return i < CTXL ? NLAT + b * CTXL + (CTXL - 1 - i) : b * TT + (TT - 1 - (i - CTXL));
}
__device__ __forceinline__ float red8(float v) {
    v += __uint_as_float((unsigned)__builtin_amdgcn_update_dpp(0, (int)__float_as_uint(v), 0xB1, 0xF, 0xF, true));
    v += __uint_as_float((unsigned)__builtin_amdgcn_update_dpp(0, (int)__float_as_uint(v), 0x4E, 0xF, 0xF, true));
    v += __uint_as_float((unsigned)__builtin_amdgcn_update_dpp(0, (int)__float_as_uint(v), 0x141, 0xF, 0xF, true));
    return v;
}
__device__ __forceinline__ void phase_scan(const Ctx& C, const Args& A) {
    for (int u = blockIdx.x; u < 192; u += C.G) {
    const int half = u & 1, d = (u >> 1) & 1, h = (u >> 2) % 12, b = u / 48;
    const float* SCN = (const float*)(A.ws + WS_SCN); float* Y = (float*)(A.ws + WS_Y) + (size_t)d * MROWS * 768;
    LAS float* buf = (LAS float*)C.lds; LAS float* ybuf = buf + 2 * 32 * 352;
    constexpr int NCH = LKEYS / 32;
    f32x4 st[6];
    int pq[6], ps_[6], poff[6], pslot[6];
#pragma unroll
    for (int j = 0; j < 6; ++j) { const int p = C.tid + NTHR * j; const int s = p / 88, q = p % 88, vec = q >> 4; ps_[j] = s; pq[j] = q;
        pslot[j] = vec == 0 ? 3 + 3 * d : vec == 1 ? 1 : vec == 2 ? 4 + 3 * d : vec == 3 ? 5 + 3 * d : vec == 4 ? 0 : 2;
        poff[j] = vec < 5 ? (q & 15) * 4 : half * 32 + (q - 80) * 4; }
#define SCAN_LOADG(c) do { _Pragma("unroll") for (int j = 0; j < 6; ++j) if (C.tid + NTHR * j < 2816) { const int row = scan_row((c) * 32 + ps_[j], b, d); \
        st[j] = *(const f32x4*)(SCN + ((size_t)(row * 12 + h) * 9 + pslot[j]) * 64 + poff[j]); } } while (0)
#define SCAN_STORE(bi) do { _Pragma("unroll") for (int j = 0; j < 6; ++j) if (C.tid + NTHR * j < 2816) *(LAS f32x4*)(buf + (bi) * (32 * 352) + ps_[j] * 352 + pq[j] * 4) = st[j]; } while (0)
    SCAN_LOADG(0); SCAN_STORE(0); __syncthreads();
    float S[8];
#pragma unroll
    for (int j = 0; j < 8; ++j) S[j] = 0.f;
    const int rl = C.lane >> 3, ks = C.lane & 7;
    for (int c = 0; c < NCH; ++c) {
        if (c + 1 < NCH) SCAN_LOADG(c + 1);
        if (C.wave < 4) {
            const LAS float* cur = buf + (c & 1) * (32 * 352);
            LAS float* yb = ybuf + (c & 1) * 1024 + C.wave * 8 + rl;
            for (int s = 0; s < 32; ++s) {
                const LAS float* bp = cur + s * 352 + ks * 8;
                const f32x4 w0 = *(const LAS f32x4*)(bp), w1 = *(const LAS f32x4*)(bp + 4), k0 = *(const LAS f32x4*)(bp + 64), k1 = *(const LAS f32x4*)(bp + 68);
                const f32x4 b0 = *(const LAS f32x4*)(bp + 128), b1 = *(const LAS f32x4*)(bp + 132), q0 = *(const LAS f32x4*)(bp + 192), q1 = *(const LAS f32x4*)(bp + 196);
                const f32x4 r0 = *(const LAS f32x4*)(bp + 256), r1 = *(const LAS f32x4*)(bp + 260);
                const float vv = cur[s * 352 + 320 + C.wave * 8 + rl];
                float sa = (S[0] * k0[0] + S[1] * k0[1]) + (S[2] * k0[2] + S[3] * k0[3]) + ((S[4] * k1[0] + S[5] * k1[1]) + (S[6] * k1[2] + S[7] * k1[3]));
                sa = red8(sa);
#pragma unroll
                for (int j = 0; j < 4; ++j) { S[j] = S[j] * w0[j] + (vv * q0[j] - sa * b0[j]); S[4 + j] = S[4 + j] * w1[j] + (vv * q1[j] - sa * b1[j]); }
                float y = (S[0] * r0[0] + S[1] * r0[1]) + (S[2] * r0[2] + S[3] * r0[3]) + ((S[4] * r1[0] + S[5] * r1[1]) + (S[6] * r1[2] + S[7] * r1[3]));
                y = red8(y);
                if (ks == 0) yb[s * 32] = y;
            }
        }
        if (c + 1 < NCH) SCAN_STORE((c + 1) & 1);
        __syncthreads();
#pragma unroll
        for (int i = 0; i < 2; ++i) { const int e = C.tid + NTHR * i, s = e >> 5, r = e & 31; const int row = scan_row(c * 32 + s, b, d);
            Y[(size_t)row * 768 + h * 64 + half * 32 + r] = ybuf[(c & 1) * 1024 + e]; }
    }
    __syncthreads();
    }
#undef SCAN_LOADG
#undef SCAN_STORE
}

__device__ __forceinline__ void phase_ef2(const Ctx& C, const Args& A, int l) {
    const int i2 = l >> 1; unsigned char* ws = A.ws;
    const float* SCN = (const float*)(ws + WS_SCN); const float* Y0 = (const float*)(ws + WS_Y); const float* Y1 = Y0 + (size_t)MROWS * 768;
    const bf16_t* G = (const bf16_t*)(ws + WS_G); bf16_t* A2 = (bf16_t*)(ws + WS_A2);
    const float* rb = A.in[I_RBON] + (size_t)i2 * 768; const float* gg = A.in[I_GNG] + (size_t)i2 * 768; const float* gb = A.in[I_GNB] + (size_t)i2 * 768;
    for (int row = C.gw; row < MROWS; row += C.NGW) {
#pragma unroll
        for (int it = 0; it < 3; ++it) {
            const int c = it * 256 + 4 * C.lane, head = c >> 6, kx = c & 63;
            const f32x4 y = *(const f32x4*)(Y0 + (size_t)row * 768 + c) + *(const f32x4*)(Y1 + (size_t)row * 768 + c);
            const float mean = sum16((y[0] + y[1]) + (y[2] + y[3])) * (1.f / 64.f);
            const f32x4 dd = y - mean;
            const float var = sum16((dd[0] * dd[0] + dd[1] * dd[1]) + (dd[2] * dd[2] + dd[3] * dd[3])) * (1.f / 64.f);
            const float rstd = rsqrtf(var + GN_EPS);
            const float* base = SCN + (size_t)(row * 12 + head) * 9 * 64 + kx;
            const f32x4 r = *(const f32x4*)(base), v = *(const f32x4*)(base + 2 * 64), k0 = *(const f32x4*)(base + 5 * 64), k1 = *(const f32x4*)(base + 8 * 64);
            const f32x4 rb4 = *(const f32x4*)(rb + c);
            const f32x4 t = r * (k0 + k1) * 0.5f * rb4;
            const float bs = sum16((t[0] + t[1]) + (t[2] + t[3]));
            const f32x4 yn = dd * rstd * *(const f32x4*)(gg + c) + *(const f32x4*)(gb + c);
            const f32x4 g = ld4bf(G + (size_t)row * 768 + c);
            st4bf(A2 + (size_t)row * DM + 256 + c, g * (yn + v * bs));
        }
    }
}

__device__ __forceinline__ int crow(int r, int hi) { return (r & 3) + 8 * (r >> 2) + 4 * hi; }
constexpr float QSCALE = 0.125f * 1.4426950408889634f;
__device__ __forceinline__ void phase_of1(const Ctx& C, const Args& A, int l) {
    const int i2 = l >> 1; unsigned char* ws = A.ws;
    const bf16_t* P = (const bf16_t*)(ws + WS_P); bf16_t* A2 = (bf16_t*)(ws + WS_A2); bf16_t* Q = (bf16_t*)(ws + WS_Q); bf16_t* KA = (bf16_t*)(ws + WS_KA); bf16_t* VT = (bf16_t*)(ws + WS_VT);
    const float* lng = A.in[I_GLNG] + (size_t)i2 * 256; const float* lnb = A.in[I_GLNB] + (size_t)i2 * 256;
    const float* gws = A.in[I_GWS] + (size_t)i2 * 4 * 128 * 128; const float* gbs = A.in[I_GBS] + (size_t)i2 * 4 * 128;
    LAS bf16_t* vt = (LAS bf16_t*)C.lds;
    LAS bf16_t* vT = (LAS bf16_t*)(C.lds + 128 * 272);
    const int r32 = C.lane & 31, hi = C.lane >> 5;
    const int axis = (C.lane & 31) >> 4, jj = C.lane & 15;
    const float inv = powf(10000.f, -(float)jj * (1.f / 16.f));
    for (int u = blockIdx.x; u < 264; u += C.G) {
        const bool isctx = u >= 256; const int uc = u - 256;
        const int b = isctx ? (uc >> 1) : (u >> 6), pos0 = isctx ? (uc & 1) * 128 : (u & 63) * 128;
        const int row0 = isctx ? NLAT + b * CTXL + pos0 : b * TT + pos0, L0 = isctx ? pos0 : CTXL + pos0;
        for (int r = C.wave; r < 128; r += NWAVES) {
            const int grow = row0 + r, t = pos0 + r; float cs = 1.f, sn = 0.f;
            if (!isctx) { const float ang = (float)(axis ? (t & 63) : (t >> 6)) * inv; cs = cosf(ang); sn = sinf(ang); }
            const bf16_t* pr = P + (size_t)grow * P_LD; bf16_t* qo = Q + (size_t)grow * 768; bf16_t* ko = KA + ((size_t)b * LKEYS + L0 + r) * 768;
#pragma unroll
            for (int i = 0; i < 6; ++i) { const int base = (2 * i + hi) * 64 + axis * 32 + jj;
                const float q1 = bf2f(pr[base]), q2 = bf2f(pr[base + 16]), k1 = bf2f(pr[768 + base]), k2 = bf2f(pr[768 + base + 16]);
                qo[base] = (bf16_t)f2bf((q1 * cs - q2 * sn) * QSCALE); qo[base + 16] = (bf16_t)f2bf((q1 * sn + q2 * cs) * QSCALE);
                ko[base] = (bf16_t)f2bf(k1 * cs - k2 * sn); ko[base + 16] = (bf16_t)f2bf(k1 * sn + k2 * cs); }
        }
        for (int hh = 0; hh < 6; ++hh) {
#pragma unroll
            for (int i = 0; i < 4; ++i) { const int piece = C.tid + NTHR * i, r = piece >> 4, part = piece & 15;
                *(LAS u32x4*)(vt + r * 136 + part * 8) = *(const u32x4*)(P + (size_t)(row0 + r) * P_LD + 1536 + hh * 128 + part * 8); }
            __syncthreads();
#pragma unroll
            for (int i = 0; i < 4; ++i) { const int item = C.tid + NTHR * i, d = item >> 4, tg = item & 15; const LAS bf16_t* s = vt + (tg * 8) * 136 + d;
                u32x4 o; o.x = (unsigned)s[0] | ((unsigned)s[136] << 16); o.y = (unsigned)s[2 * 136] | ((unsigned)s[3 * 136] << 16);
                o.z = (unsigned)s[4 * 136] | ((unsigned)s[5 * 136] << 16); o.w = (unsigned)s[6 * 136] | ((unsigned)s[7 * 136] << 16);
                *(u32x4*)(VT + ((size_t)(b * 6 + hh) * 128 + d) * LKEYS + L0 + tg * 8) = o; }
            __syncthreads();
        }
        for (int r = C.wave; r < 128; r += NWAVES) {
            const int c4 = 4 * C.lane; const f32x4 raw = ld4bf(P + (size_t)(row0 + r) * P_LD + 2560 + c4);
            const f32x4 gv = {gelu_erf(raw[0]), gelu_erf(raw[1]), gelu_erf(raw[2]), gelu_erf(raw[3])};
            const float mean = wave_sum((gv[0] + gv[1]) + (gv[2] + gv[3])) * (1.f / 256.f); const f32x4 dd = gv - mean;
            const float var = wave_sum((dd[0] * dd[0] + dd[1] * dd[1]) + (dd[2] * dd[2] + dd[3] * dd[3])) * (1.f / 256.f); const float rstd = rsqrtf(var + LN_EPS);
            const f32x4 o = dd * rstd * *(const f32x4*)(lng + c4) + *(const f32x4*)(lnb + c4);
#pragma unroll
            for (int k = 0; k < 4; ++k) vT[(c4 + k) * 136 + r] = (bf16_t)f2bf(o[k]);
        }
        __syncthreads();
        {
            const int g = C.wave >> 1, cblk = C.wave & 1, cc = g * 64 + cblk * 32 + r32;
            for (int pblk = 0; pblk < 4; ++pblk) {
                f32x16 acc;
#pragma unroll
                for (int i = 0; i < 16; ++i) acc[i] = 0.f;
                const float* wrow = gws + ((size_t)g * 128 + pblk * 32 + r32) * 128 + 8 * hi;
#pragma unroll
                for (int ks = 0; ks < 8; ++ks) { const f32x4 w0 = *(const f32x4*)(wrow + ks * 16), w1 = *(const f32x4*)(wrow + ks * 16 + 4);
                    u32x4 au; au.x = pk2(w0[0], w0[1]); au.y = pk2(w0[2], w0[3]); au.z = pk2(w1[0], w1[1]); au.w = pk2(w1[2], w1[3]);
                    const bf16x8 bf = *(const LAS bf16x8*)(vT + cc * 136 + ks * 16 + 8 * hi);
                    acc = __builtin_amdgcn_mfma_f32_32x32x16_bf16(__builtin_bit_cast(bf16x8, au), bf, acc, 0, 0, 0); }
#pragma unroll
                for (int reg = 0; reg < 16; ++reg) { const int p = pblk * 32 + crow(reg, hi); const size_t grow = (size_t)(row0 + p);
                    const float uu = gelu_erf(bf2f(P[grow * P_LD + 2304 + cc])); const float mixed = acc[reg] + gbs[g * 128 + p];
                    A2[grow * DM + 768 + cc] = (bf16_t)f2bf(uu * mixed); }
            }
        }
        __syncthreads();
    }
}

__device__ __forceinline__ void phase_attn(const Ctx& C, const Args& A, int l) {
    const int i2 = l >> 1; unsigned char* ws = A.ws;
    const bf16_t* Q = (const bf16_t*)(ws + WS_Q); const bf16_t* KA = (const bf16_t*)(ws + WS_KA); const bf16_t* VT = (const bf16_t*)(ws + WS_VT); bf16_t* A2 = (bf16_t*)(ws + WS_A2);
    const float lam_init = 0.8f - 0.6f * expf(-0.3f * (float)l);
    float s1 = 0.f, s2 = 0.f;
    for (int j = 0; j < 64; ++j) { s1 += A.in[I_LQ1][i2 * 64 + j] * A.in[I_LK1][i2 * 64 + j]; s2 += A.in[I_LQ2][i2 * 64 + j] * A.in[I_LK2][i2 * 64 + j]; }
    const float lam = expf(s1) - expf(s2) + lam_init;
    const float* subg = A.in[I_SUBG] + (size_t)i2 * 128;
    const int r32 = C.lane & 31, hi = C.lane >> 5, map = C.wave >> 2, qw = C.wave & 3;
    LAS unsigned char* Kt = C.lds; LAS unsigned char* Vt = C.lds + 2 * 17408; LAS float* xch = (LAS float*)C.lds;
    const int NU = 1536 + (l == 1 ? 48 : 0);
    for (int n = C.vcu; n < NU; n += C.G) {
        int bh, qt; bool isctx = false;
        if (n < 1536) { const int round = n >> 8, slot = n & 255; bh = (slot >> 5) * 3 + (round >> 1); qt = (round & 1) * 32 + (slot & 31); }
        else { isctx = true; bh = (n - 1536) >> 1; qt = (n - 1536) & 1; }
        const int b = bh / 6, h = bh % 6;
        const int qrow0 = isctx ? NLAT + b * CTXL + qt * 128 : b * TT + qt * 128;
        const int NT = isctx ? CTXL / 64 : LKEYS / 64;
        const bf16_t* Kb = KA + (size_t)b * LKEYS * 768 + h * 128;
        const bf16_t* Vb = VT + (size_t)(b * 6 + h) * 128 * LKEYS;
        bf16x8 qf[4];
        { const bf16_t* qp = Q + (size_t)(qrow0 + qw * 32 + r32) * 768 + h * 128 + map * 64 + 8 * hi;
#pragma unroll
          for (int ks = 0; ks < 4; ++ks) qf[ks] = *(const bf16x8*)(qp + ks * 16); }
        f32x16 O[4];
#pragma unroll
        for (int d = 0; d < 4; ++d)
#pragma unroll
            for (int i = 0; i < 16; ++i) O[d][i] = 0.f;
        float m = -1e30f, lsum = 0.f;
        u32x4 kreg[2], vreg[2];
#define AT_LOAD(t) do { _Pragma("unroll") for (int i = 0; i < 2; ++i) { const int piece = C.tid + NTHR * i; \
            kreg[i] = *(const u32x4*)(Kb + (size_t)((t) * 64 + (piece >> 4)) * 768 + (piece & 15) * 8); \
            vreg[i] = *(const u32x4*)(Vb + (size_t)(piece >> 3) * LKEYS + (t) * 64 + (piece & 7) * 8); } } while (0)
#define AT_STORE(bi) do { _Pragma("unroll") for (int i = 0; i < 2; ++i) { const int piece = C.tid + NTHR * i; \
            *(LAS u32x4*)(Kt + (bi) * 17408 + (piece >> 4) * 272 + (piece & 15) * 16) = kreg[i]; \
            LAS unsigned char* vd = Vt + (bi) * 17408 + (piece >> 3) * 136 + (piece & 7) * 16; \
            *(LAS u32x2*)vd = (u32x2){vreg[i].x, vreg[i].y}; *(LAS u32x2*)(vd + 8) = (u32x2){vreg[i].z, vreg[i].w}; } } while (0)
        AT_LOAD(0); AT_STORE(0); __syncthreads();
        for (int t = 0; t < NT; ++t) {
            if (t + 1 < NT) AT_LOAD(t + 1);
            const int bi = t & 1;
            f32x16 p0, p1;
#pragma unroll
            for (int i = 0; i < 16; ++i) { p0[i] = 0.f; p1[i] = 0.f; }
            { const LAS unsigned char* kb = Kt + bi * 17408 + r32 * 272 + map * 128 + hi * 16;
#pragma unroll
              for (int ks = 0; ks < 4; ++ks) { const bf16x8 a0 = *(const LAS bf16x8*)(kb + ks * 32), a1 = *(const LAS bf16x8*)(kb + 32 * 272 + ks * 32);
                  p0 = __builtin_amdgcn_mfma_f32_32x32x16_bf16(a0, qf[ks], p0, 0, 0, 0); p1 = __builtin_amdgcn_mfma_f32_32x32x16_bf16(a1, qf[ks], p1, 0, 0, 0); } }
            float mx = fmaxf(p0[0], p1[0]);
#pragma unroll
            for (int i = 1; i < 16; ++i) mx = fmaxf(mx, fmaxf(p0[i], p1[i]));
            mx = fmaxf(mx, __shfl_xor(mx, 32));
            const float mnew = fmaxf(m, mx);
            if (__any(mnew > m)) { const float sc = __builtin_amdgcn_exp2f(m - mnew); lsum *= sc;
#pragma unroll
                for (int d = 0; d < 4; ++d)
#pragma unroll
                    for (int i = 0; i < 16; ++i) O[d][i] *= sc;
                m = mnew; }
            float ps = 0.f;
#pragma unroll
            for (int i = 0; i < 16; ++i) { p0[i] = __builtin_amdgcn_exp2f(p0[i] - m); p1[i] = __builtin_amdgcn_exp2f(p1[i] - m); ps += p0[i] + p1[i]; }
            lsum += ps;
            bf16x8 pb[4];
            { u32x4 w; w.x = pk2(p0[0], p0[1]); w.y = pk2(p0[2], p0[3]); w.z = pk2(p0[4], p0[5]); w.w = pk2(p0[6], p0[7]); pb[0] = __builtin_bit_cast(bf16x8, w);
              w.x = pk2(p0[8], p0[9]); w.y = pk2(p0[10], p0[11]); w.z = pk2(p0[12], p0[13]); w.w = pk2(p0[14], p0[15]); pb[1] = __builtin_bit_cast(bf16x8, w);
              w.x = pk2(p1[0], p1[1]); w.y = pk2(p1[2], p1[3]); w.z = pk2(p1[4], p1[5]); w.w = pk2(p1[6], p1[7]); pb[2] = __builtin_bit_cast(bf16x8, w);
              w.x = pk2(p1[8], p1[9]); w.y = pk2(p1[10], p1[11]); w.z = pk2(p1[12], p1[13]); w.w = pk2(p1[14], p1[15]); pb[3] = __builtin_bit_cast(bf16x8, w); }
            { const LAS unsigned char* vb = Vt + bi * 17408 + r32 * 136 + hi * 8;
#pragma unroll
              for (int d = 0; d < 4; ++d)
#pragma unroll
                  for (int kst = 0; kst < 4; ++kst) { const LAS unsigned char* vp = vb + d * (32 * 136) + kst * 32;
                      const u32x2 lo = *(const LAS u32x2*)vp, hh = *(const LAS u32x2*)(vp + 16); const u32x4 av = {lo.x, lo.y, hh.x, hh.y};
                      O[d] = __builtin_amdgcn_mfma_f32_32x32x16_bf16(__builtin_bit_cast(bf16x8, av), pb[kst], O[d], 0, 0, 0); } }
            if (t + 1 < NT) AT_STORE((t + 1) & 1);
            __syncthreads();
        }
#undef AT_LOAD
#undef AT_STORE
        const float ltot = lsum + __shfl_xor(lsum, 32);
        const float invl = 1.f / ltot;
        if (map == 1) { const float f = lam * invl;
#pragma unroll
            for (int d = 0; d < 4; ++d)
#pragma unroll
                for (int i = 0; i < 16; ++i) xch[(qw * 64 + d * 16 + i) * 64 + C.lane] = O[d][i] * f; }
        __syncthreads();
        if (map == 0) { float ss = 0.f;
#pragma unroll
            for (int d = 0; d < 4; ++d)
#pragma unroll
                for (int i = 0; i < 16; ++i) { const float o = O[d][i] * invl - xch[(qw * 64 + d * 16 + i) * 64 + C.lane]; O[d][i] = o; ss += o * o; }
            ss += __shfl_xor(ss, 32);
            const float rn = rsqrtf(ss * (1.f / 128.f) + RMS_EPS) * (1.f - lam_init);
            bf16_t* orow = A2 + (size_t)(qrow0 + qw * 32 + r32) * DM + h * 128;
#pragma unroll
            for (int d = 0; d < 4; ++d)
#pragma unroll
                for (int g4 = 0; g4 < 4; ++g4) { const int dd = 32 * d + 8 * g4 + 4 * hi; const f32x4 sg = *(const f32x4*)(subg + dd);
                    const f32x4 v = {O[d][4 * g4] * rn * sg[0], O[d][4 * g4 + 1] * rn * sg[1], O[d][4 * g4 + 2] * rn * sg[2], O[d][4 * g4 + 3] * rn * sg[3]};
                    st4bf(orow + dd, v); } }
        __syncthreads();
    }
}

__device__ __forceinline__ void phase_rt(const Ctx& C, const Args& A, int l) {
    unsigned char* ws = A.ws; float* X = (float*)(ws + WS_X); bf16_t* H = (bf16_t*)(ws + WS_H); float* AFF = (float*)(ws + WS_AFF);
    const float* MOD = (const float*)(ws + WS_MOD) + (size_t)l * 5 * 6144;
    const float* lng = A.in[I_LNG] + (size_t)(l * 2 + 0) * DM; const float* lnb = A.in[I_LNB] + (size_t)(l * 2 + 0) * DM;
    LAS float* wrs = (LAS float*)C.lds;
    { const float* wr = A.in[I_WR] + (size_t)l * DM * 16; for (int i = C.tid; i < DM * 16; i += NTHR) wrs[(i & 15) * 1024 + (i >> 4)] = wr[i]; }
    __syncthreads();
    for (int row = C.gw; row < MROWS; row += C.NGW) {
        const float* md = MOD + row_mi(row) * 6144;
        f32x4 x[4]; float s = 0.f;
#pragma unroll
        for (int j = 0; j < 4; ++j) { x[j] = *(const f32x4*)(X + (size_t)row * DM + 4 * C.lane + 256 * j); s += (x[j][0] + x[j][1]) + (x[j][2] + x[j][3]); }
        const float mean = wave_sum(s) * (1.f / DM); float s2 = 0.f;
#pragma unroll
        for (int j = 0; j < 4; ++j) { x[j] = x[j] - mean; s2 += (x[j][0] * x[j][0] + x[j][1] * x[j][1]) + (x[j][2] * x[j][2] + x[j][3] * x[j][3]); }
        const float rstd = rsqrtf(wave_sum(s2) * (1.f / DM) + LN_EPS);
        float v[16];
#pragma unroll
        for (int e = 0; e < 16; ++e) v[e] = 0.f;
#pragma unroll
        for (int j = 0; j < 4; ++j) { const int col = 4 * C.lane + 256 * j;
            const f32x4 x1 = x[j] * rstd * *(const f32x4*)(lng + col) + *(const f32x4*)(lnb + col);
            *(f32x4*)(X + (size_t)row * DM + col) = x1;
            const f32x4 h = x1 * (*(const f32x4*)(md + 4 * DM + col) + 1.f) + *(const f32x4*)(md + 3 * DM + col);
            st4bf(H + (size_t)row * DM + col, h);
#pragma unroll
            for (int e = 0; e < 16; ++e) { const f32x4 w = *(const LAS f32x4*)(wrs + e * 1024 + col); v[e] += (h[0] * w[0] + h[1] * w[1]) + (h[2] * w[2] + h[3] * w[3]); }
            __builtin_amdgcn_sched_barrier(0); }
#pragma unroll
        for (int i = 0; i < 8; ++i) { const float send = (C.lane & 32) ? v[i] : v[i + 8], keep = (C.lane & 32) ? v[i + 8] : v[i]; v[i] = keep + __shfl_xor(send, 32); }
#pragma unroll
        for (int i = 0; i < 4; ++i) { const float send = (C.lane & 16) ? v[i] : v[i + 4], keep = (C.lane & 16) ? v[i + 4] : v[i]; v[i] = keep + __shfl_xor(send, 16); }
#pragma unroll
        for (int i = 0; i < 2; ++i) { const float send = (C.lane & 8) ? v[i] : v[i + 2], keep = (C.lane & 8) ? v[i + 2] : v[i]; v[i] = keep + __shfl_xor(send, 8); }
        { const float send = (C.lane & 4) ? v[0] : v[1], keep = (C.lane & 4) ? v[1] : v[0]; v[0] = keep + __shfl_xor(send, 4); }
        float z = v[0]; z += __shfl_xor(z, 1); z += __shfl_xor(z, 2);
        float mx = z;
#pragma unroll
        for (int o = 4; o < 64; o <<= 1) mx = fmaxf(mx, __shfl_xor(mx, o));
        const float ex = expf(z - mx); float sm = ex;
#pragma unroll
        for (int o = 4; o < 64; o <<= 1) sm += __shfl_xor(sm, o);
        if ((C.lane & 3) == 0) AFF[(size_t)row * 16 + (C.lane >> 2)] = ex / sm;
    }
}

__device__ __forceinline__ void phase_tk(const Ctx& C, const Args& A) {
    unsigned char* ws = A.ws; const float* AFF = (const float*)(ws + WS_AFF); int* SLOT = (int*)(ws + WS_SLOT); int* IDX = (int*)(ws + WS_IDX); float* GATE = (float*)(ws + WS_GATE);
    LAS unsigned* key = (LAS unsigned*)C.lds;
    LAS unsigned* hist = key + 8192;
    LAS unsigned* scn = hist + 256;
    LAS unsigned* wtot = scn + 256;
    LAS unsigned* bc = wtot + 8;
    for (int u = blockIdx.x; u < 128; u += C.G) {
        const bool isctx = u >= 64; const int uu = u & 63, b = uu >> 4, e = uu & 15;
        const int n = isctx ? CTXL : TT, cap = isctx ? CAP_C : CAP_L;
        const int row0 = isctx ? NLAT + b * CTXL : b * TT;
        const int slot0 = e * ESLOTS + (isctx ? 4 * CAP_L + b * CAP_C : b * CAP_L);
        for (int i = C.tid; i < n; i += NTHR) key[i] = __float_as_uint(AFF[(size_t)(row0 + i) * 16 + e]);
        unsigned prefix = 0u, pmask = 0u; int need = cap;
        for (int pass = 0; pass < 4; ++pass) {
            const int shift = 24 - 8 * pass;
            if (C.tid < 256) hist[C.tid] = 0u;
            __syncthreads();
            for (int i = C.tid; i < n; i += NTHR) { const unsigned k = key[i]; if ((k & pmask) == prefix) __hip_atomic_fetch_add(&hist[(k >> shift) & 255u], 1u, __ATOMIC_RELAXED, __HIP_MEMORY_SCOPE_WORKGROUP); }
            __syncthreads();
            if (C.tid < 256) scn[C.tid] = hist[C.tid];
            __syncthreads();
            for (int off = 1; off < 256; off <<= 1) {
                unsigned a = 0u; if (C.tid < 256 && C.tid + off < 256) a = scn[C.tid + off];
                __syncthreads();
                if (C.tid < 256) scn[C.tid] += a;
                __syncthreads();
            }
            if (C.tid < 256) { const unsigned above = (C.tid < 255) ? scn[C.tid + 1] : 0u;
                if (scn[C.tid] >= (unsigned)need && above < (unsigned)need) { bc[0] = (unsigned)C.tid; bc[1] = (unsigned)need - above; } }
            __syncthreads();
            prefix |= bc[0] << shift; pmask |= 255u << shift; need = (int)bc[1];
            __syncthreads();
        }
        const int per = (n + NTHR - 1) / NTHR; const int i0 = C.tid * per;
        unsigned cg = 0u, ce = 0u;
        for (int j = 0; j < per; ++j) { const int i = i0 + j; if (i < n) { const unsigned k = key[i]; cg += (k > prefix); ce += (k == prefix); } }
        unsigned pk = cg | (ce << 16), inc = pk;
#pragma unroll
        for (int o = 1; o < 64; o <<= 1) { const unsigned t = __shfl_up(inc, o); if (C.lane >= o) inc += t; }
        if (C.lane == 63) wtot[C.wave] = inc;
        __syncthreads();
        unsigned wbase = 0u;
        for (int w = 0; w < C.wave; ++w) wbase += wtot[w];
        const unsigned excl = wbase + inc - pk;
        unsigned rg = excl & 0xffffu, re = excl >> 16;
        const int ngt = cap - need;
        for (int j = 0; j < per; ++j) { const int i = i0 + j; if (i < n) { const unsigned k = key[i]; int pos = -1;
            if (k > prefix) { pos = (int)rg; ++rg; } else if (k == prefix) { if ((int)re < need) pos = ngt + (int)re; ++re; }
            const int row = row0 + i;
            if (pos >= 0) { IDX[slot0 + pos] = row; GATE[slot0 + pos] = __uint_as_float(k); SLOT[(size_t)row * 16 + e] = slot0 + pos; }
            else SLOT[(size_t)row * 16 + e] = -1; } }
        if (isctx && b == 0 && C.tid < ESLOTS - 4224) { IDX[e * ESLOTS + 4224 + C.tid] = 0; GATE[e * ESLOTS + 4224 + C.tid] = 0.f; }
        __syncthreads();
    }
}

__device__ __forceinline__ void phase_cb(const Ctx& C, const Args& A, int l) {
    unsigned char* ws = A.ws; float* X = (float*)(ws + WS_X); bf16_t* H = (bf16_t*)(ws + WS_H); const int* SLOT = (const int*)(ws + WS_SLOT); const bf16_t* YE = (const bf16_t*)(ws + WS_YE);
    const float* MOD = (const float*)(ws + WS_MOD) + (size_t)l * 5 * 6144; const float* MODN = MOD + 5 * 6144;
    const float* lng = A.in[I_LNG] + (size_t)(l * 2 + 1) * DM; const float* lnb = A.in[I_LNB] + (size_t)(l * 2 + 1) * DM;
    for (int row = C.gw; row < MROWS; row += C.NGW) {
        const int mi = row_mi(row); const float* md = MOD + mi * 6144;
        f32x4 acc[4];
#pragma unroll
        for (int j = 0; j < 4; ++j) acc[j] = (f32x4){0.f, 0.f, 0.f, 0.f};
        for (int e = 0; e < 16; ++e) { const int s = __builtin_amdgcn_readfirstlane(SLOT[(size_t)row * 16 + e]);
            if (s >= 0) {
#pragma unroll
                for (int j = 0; j < 4; ++j) acc[j] += ld4bf(YE + (size_t)s * DM + 4 * C.lane + 256 * j); } }
        f32x4 x[4]; float sm = 0.f;
#pragma unroll
        for (int j = 0; j < 4; ++j) { const int col = 4 * C.lane + 256 * j; x[j] = *(const f32x4*)(X + (size_t)row * DM + col) * ALPHA_DN + *(const f32x4*)(md + 5 * DM + col) * acc[j];
            sm += (x[j][0] + x[j][1]) + (x[j][2] + x[j][3]); }
        const float mean = wave_sum(sm) * (1.f / DM); float s2 = 0.f;
#pragma unroll
        for (int j = 0; j < 4; ++j) { x[j] = x[j] - mean; s2 += (x[j][0] * x[j][0] + x[j][1] * x[j][1]) + (x[j][2] * x[j][2] + x[j][3] * x[j][3]); }
        const float rstd = rsqrtf(wave_sum(s2) * (1.f / DM) + LN_EPS);
#pragma unroll
        for (int j = 0; j < 4; ++j) { const int col = 4 * C.lane + 256 * j;
            const f32x4 x2 = x[j] * rstd * *(const f32x4*)(lng + col) + *(const f32x4*)(lnb + col);
            *(f32x4*)(X + (size_t)row * DM + col) = x2;
            if (l < DEPTH - 1) { const float* mn = MODN + mi * 6144; st4bf(H + (size_t)row * DM + col, x2 * (*(const f32x4*)(mn + DM + col) + 1.f) + *(const f32x4*)(mn + col)); }
            else if (row < NLAT) *(f32x4*)(A.out + (size_t)row * DM + col) = x2; }
    }
}


#ifndef GEMM_NOINLINE
#define GEMM_NOINLINE 0
#endif
#if GEMM_NOINLINE
#define GEMM_FN __device__ __noinline__
#else
#define GEMM_FN __device__ __forceinline__
#endif
GEMM_FN void gphase_in(LAS unsigned char* lds, unsigned char* ws, int nN, int G) {
    pg8::Gemm g{(const bf16_t*)(ws + WS_H), (const bf16_t*)(ws + WS_WIN), DM}; pg8::Order<0> S; S.init(MROWS / 256, nN, G, (int)blockIdx.x, nullptr, 0);
    pg8::EpiBf16 E{(bf16_t*)(ws + WS_P), P_LD}; pg8::gemm_phase(lds, g, S, E); }
GEMM_FN void gphase_lora(LAS unsigned char* lds, unsigned char* ws, const float* d0, const float* a0, const float* kal, int G) {
    pg8::Gemm g{(const bf16_t*)(ws + WS_LIN), (const bf16_t*)(ws + WS_WLORA), LORA_K}; pg8::Order<0> S; S.init(MROWS / 256, LORA_N / 256, G, (int)blockIdx.x, nullptr, 0);
    pg8::EpiLora E{(float*)(ws + WS_SCN), (bf16_t*)(ws + WS_G), d0, a0, kal}; pg8::gemm_phase(lds, g, S, E); }
GEMM_FN void gphase_out(LAS unsigned char* lds, unsigned char* ws, const float* modl, int G) {
    pg8::Gemm g{(const bf16_t*)(ws + WS_A2), (const bf16_t*)(ws + WS_WOUT), DM}; pg8::Order<0> S; S.init(MROWS / 256, DM / 256, G, (int)blockIdx.x, nullptr, 0);
    pg8::EpiRes E{(float*)(ws + WS_X), modl}; pg8::gemm_phase(lds, g, S, E); }
GEMM_FN void gphase_e1(LAS unsigned char* lds, unsigned char* ws, int G) {
    pg8::Gemm g{(const bf16_t*)(ws + WS_H), (const bf16_t*)(ws + WS_WE13), DM}; pg8::Order<1> S; S.init(NEXP * 17, 4096 / 256, G, (int)blockIdx.x, (const int*)(ws + WS_IDX), (long)4096 * DM);
    pg8::EpiSwiGLU E{(bf16_t*)(ws + WS_HID)}; pg8::gemm_phase(lds, g, S, E); }
GEMM_FN void gphase_e2(LAS unsigned char* lds, unsigned char* ws, int G) {
    pg8::Gemm g{(const bf16_t*)(ws + WS_HID), (const bf16_t*)(ws + WS_WE2), D_EXP}; pg8::Order<2> S; S.init(NEXP * 17, DM / 256, G, (int)blockIdx.x, nullptr, (long)DM * D_EXP);
    pg8::EpiYE E{(bf16_t*)(ws + WS_YE), (const float*)(ws + WS_GATE)}; pg8::gemm_phase(lds, g, S, E); }

constexpr int NSTEP = 1 + DEPTH * 12;
__global__ void __launch_bounds__(NTHR, 2) mk_fwd(Args KA) {
    extern __shared__ __attribute__((aligned(16))) unsigned char lds_raw[];
    volatile LAS unsigned* MISC = (volatile LAS unsigned*)((LAS unsigned char*)lds_raw + LDS_MISC);
    if (threadIdx.x < 16) MISC[threadIdx.x] = 0u;
    if (threadIdx.x == 0) { LAS unsigned long long* tb = (LAS unsigned long long*)((LAS unsigned char*)lds_raw + LDS_PTAB);
#pragma unroll
        for (int i = 0; i < 37; ++i) tb[i] = (unsigned long long)KA.in[i];
        tb[37] = (unsigned long long)KA.out; tb[38] = (unsigned long long)KA.ws; }
    __syncthreads();
    const int lo = KA.lo, hi = KA.hi;
    unsigned bar_x = 0;
    if (hi - lo > 1) { const XcdBarrier b0 = xcd_barrier_post((unsigned*)(KA.ws + WS_CTL), MISC); bar_x = b0.x; }
#ifndef PH_MASK
#define PH_MASK 0xFFFFFF
#endif
#define RUN(k, ...) do { if (((PH_MASK >> (((k) == 0) ? 0 : 1 + ((k) - 1) % 12 + (((k) - 1) % 12 >= 2 && ((k) - 1) % 12 <= 5 && odd ? 12 : 0))) & 1) && lo <= (k) && (k) < hi) { \
        Ctx C; mkctx(C, (LAS unsigned char*)lds_raw); Args A; ldargs(A, (LAS unsigned char*)lds_raw); unsigned char* ws = A.ws; \
        const float* MODL = (const float*)(ws + WS_MOD) + (size_t)l * 5 * 6144; (void)MODL; \
        __VA_ARGS__; if ((k) + 1 < hi) { XcdBarrier bar; bar.bar = (unsigned*)(ws + WS_CTL); bar.x = bar_x; bar.st = MISC; xcd_barrier(bar); } } } while (0)
    { const bool odd = false; const int l = 0; RUN(0, phase_init(C, A)); }
#pragma unroll 1
    for (int l = 0; l < DEPTH; ++l) {
        const int sb = 1 + l * 12; const bool odd = l & 1;
        RUN(sb + 0, { phase_conv(C, A, l); if (l == 0) phase_modh(C, A, 0); });
        RUN(sb + 1, gphase_in(C.lds, ws, odd ? D_IN_ODD / 256 : D_IN_EVEN_PAD / 256, C.G));
        if (!odd) {
            RUN(sb + 2, phase_ef1(C, A, l));
            RUN(sb + 3, { const int i2 = l >> 1; gphase_lora(C.lds, ws, A.in[I_D0] + (size_t)i2 * 2 * 768, A.in[I_A0] + (size_t)i2 * 2 * 768, A.in[I_KAL] + (size_t)i2 * 768, C.G); });
            RUN(sb + 4, phase_scan(C, A));
            RUN(sb + 5, phase_ef2(C, A, l));
        } else {
            RUN(sb + 2, phase_of1(C, A, l));
            RUN(sb + 3, phase_attn(C, A, l));
        }
        RUN(sb + 6, gphase_out(C.lds, ws, MODL, C.G));
        RUN(sb + 7, phase_rt(C, A, l));
        RUN(sb + 8, phase_tk(C, A));
        RUN(sb + 9, gphase_e1(C.lds, ws, C.G));
        RUN(sb + 10, gphase_e2(C.lds, ws, C.G));
        RUN(sb + 11, phase_cb(C, A, l));
    }
#undef RUN
}

#ifdef PHASE_PROBE
#define PROBE_PRE extern __shared__ __attribute__((aligned(16))) unsigned char lds_raw[]; Ctx C; mkctx(C, (LAS unsigned char*)lds_raw); unsigned char* ws = A.ws; (void)ws;
__global__ void __launch_bounds__(NTHR, 2) pr_init(Args A) { PROBE_PRE phase_init(C, A); }
__global__ void __launch_bounds__(NTHR, 2) pr_conv(Args A) { PROBE_PRE phase_conv(C, A, A.lo); }
__global__ void __launch_bounds__(NTHR, 2) pr_modh(Args A) { PROBE_PRE phase_modh(C, A, A.lo); }
__global__ void __launch_bounds__(NTHR, 2) pr_ef1(Args A) { PROBE_PRE phase_ef1(C, A, A.lo); }
__global__ void __launch_bounds__(NTHR, 2) pr_scan(Args A) { PROBE_PRE phase_scan(C, A); }
__global__ void __launch_bounds__(NTHR, 2) pr_ef2(Args A) { PROBE_PRE phase_ef2(C, A, A.lo); }
__global__ void __launch_bounds__(NTHR, 2) pr_of1(Args A) { PROBE_PRE phase_of1(C, A, A.lo); }
__global__ void __launch_bounds__(NTHR, 2) pr_attn(Args A) { PROBE_PRE phase_attn(C, A, A.lo); }
__global__ void __launch_bounds__(NTHR, 2) pr_rt(Args A) { PROBE_PRE phase_rt(C, A, A.lo); }
__global__ void __launch_bounds__(NTHR, 2) pr_tk(Args A) { PROBE_PRE phase_tk(C, A); }
__global__ void __launch_bounds__(NTHR, 2) pr_cb(Args A) { PROBE_PRE phase_cb(C, A, A.lo); }
__global__ void __launch_bounds__(NTHR, 2) pr_gemm_in(Args A) { PROBE_PRE pg8::Gemm g{(const bf16_t*)(ws + WS_H), (const bf16_t*)(ws + WS_WIN), DM}; pg8::Order<0> S; S.init(MROWS / 256, A.lo, C.G, (int)blockIdx.x, nullptr, 0);
                      pg8::EpiBf16 E{(bf16_t*)(ws + WS_P), P_LD}; pg8::gemm_phase(C.lds, g, S, E); }
__global__ void __launch_bounds__(NTHR, 2) pr_gemm_lora(Args A) { PROBE_PRE pg8::Gemm g{(const bf16_t*)(ws + WS_LIN), (const bf16_t*)(ws + WS_WLORA), LORA_K}; pg8::Order<0> S; S.init(MROWS / 256, LORA_N / 256, C.G, (int)blockIdx.x, nullptr, 0);
                          const int i2 = A.lo; pg8::EpiLora E{(float*)(ws + WS_SCN), (bf16_t*)(ws + WS_G), A.in[I_D0] + (size_t)i2 * 2 * 768, A.in[I_A0] + (size_t)i2 * 2 * 768, A.in[I_KAL] + (size_t)i2 * 768};
                          pg8::gemm_phase(C.lds, g, S, E); }
__global__ void __launch_bounds__(NTHR, 2) pr_gemm_out(Args A) { PROBE_PRE pg8::Gemm g{(const bf16_t*)(ws + WS_A2), (const bf16_t*)(ws + WS_WOUT), DM}; pg8::Order<0> S; S.init(MROWS / 256, DM / 256, C.G, (int)blockIdx.x, nullptr, 0);
                      pg8::EpiRes E{(float*)(ws + WS_X), (const float*)(ws + WS_MOD)}; pg8::gemm_phase(C.lds, g, S, E); }
__global__ void __launch_bounds__(NTHR, 2) pr_gemm_e1(Args A) { PROBE_PRE pg8::Gemm g{(const bf16_t*)(ws + WS_H), (const bf16_t*)(ws + WS_WE13), DM}; pg8::Order<1> S; S.init(NEXP * 17, 4096 / 256, C.G, (int)blockIdx.x, (const int*)(ws + WS_IDX), (long)4096 * DM);
                      pg8::EpiSwiGLU E{(bf16_t*)(ws + WS_HID)}; pg8::gemm_phase(C.lds, g, S, E); }
__global__ void __launch_bounds__(NTHR, 2) pr_gemm_e2(Args A) { PROBE_PRE pg8::Gemm g{(const bf16_t*)(ws + WS_HID), (const bf16_t*)(ws + WS_WE2), D_EXP}; pg8::Order<2> S; S.init(NEXP * 17, DM / 256, C.G, (int)blockIdx.x, nullptr, (long)DM * D_EXP);
                       pg8::EpiYE E{(bf16_t*)(ws + WS_YE), (const float*)(ws + WS_GATE)}; pg8::gemm_phase(C.lds, g, S, E); }
#endif

extern "C" void kernel_launch(void* const* d_in, const int* in_sizes, int n_in, void* d_out, int out_size, void* d_ws, size_t ws_size, hipStream_t stream) {
    static int grid = 0;
    if (grid == 0) {
        if (n_in != 37 || out_size != NLAT * DM || ws_size < WS_END) { fprintf(stderr, "kernel_launch: unexpected shapes: n_in %d out %d ws %zu (need %zu)\n", n_in, out_size, ws_size, (size_t)WS_END); grid = -1; return; }
        int dev = 0, cus = 0, per_cu = 0;
        if (hipGetDevice(&dev) != hipSuccess || hipDeviceGetAttribute(&cus, hipDeviceAttributeMultiprocessorCount, dev) != hipSuccess) { grid = -1; return; }
        if (hipFuncSetAttribute((const void*)mk_fwd, hipFuncAttributeMaxDynamicSharedMemorySize, LDS_BYTES) != hipSuccess) { fprintf(stderr, "kernel_launch: hipFuncSetAttribute failed\n"); grid = -1; return; }
        if (hipOccupancyMaxActiveBlocksPerMultiprocessor(&per_cu, (const void*)mk_fwd, NTHR, LDS_BYTES) != hipSuccess || per_cu < 1) fprintf(stderr, "kernel_launch: occupancy query reports %d\n", per_cu);
        (void)hipGetLastError();
        grid = cus;
    }
    if (grid < 0) return;
    (void)hipMemsetAsync((char*)d_ws + WS_CTL, 0, CTL_BYTES, stream);
    Args a{};
    for (int i = 0; i < 37; ++i) a.in[i] = (const float*)d_in[i];
    a.out = (float*)d_out; a.ws = (unsigned char*)d_ws;
#if MK_MULTI
    for (int k = 0; k < NSTEP; ++k) {
        if (k >= 1) { const int l = (k - 1) / 12, s = (k - 1) % 12; if ((l & 1) && (s == 4 || s == 5)) continue; }
        a.lo = k; a.hi = k + 1;
        hipLaunchKernelGGL(mk_fwd, dim3(grid), dim3(NTHR), LDS_BYTES, stream, a);
    }
#else
    a.lo = 0; a.hi = NSTEP;
    hipLaunchKernelGGL(mk_fwd, dim3(grid), dim3(NTHR), LDS_BYTES, stream, a);
#endif
    const hipError_t le = hipPeekAtLastError();
    if (le != hipSuccess) fprintf(stderr, "kernel_launch: launch failed: %s\n", hipGetErrorName(le));
}
```

```cpp
#include <hip/hip_runtime.h>
#include <cstdio>
#include <cstdint>
#include <cmath>

#ifndef MK_MULTI
#define MK_MULTI 0
#endif

#define GAS __attribute__((address_space(1)))
#define LAS __attribute__((address_space(3)))
typedef unsigned short bf16_t;
typedef short bf16x8 __attribute__((ext_vector_type(8)));
typedef float f32x4 __attribute__((ext_vector_type(4)));
typedef float f32x2 __attribute__((ext_vector_type(2)));
typedef float f32x16 __attribute__((ext_vector_type(16)));
typedef unsigned u32x4 __attribute__((ext_vector_type(4)));
typedef unsigned u32x2 __attribute__((ext_vector_type(2)));
typedef __bf16 bf16x2_t __attribute__((ext_vector_type(2)));

constexpr int NB = 4, TT = 8192, DM = 1024, NLAT = NB * TT, CTXL = 256, NCTX = NB * CTXL, MROWS = NLAT + NCTX;
constexpr int DEPTH = 4;
constexpr int D_CONV = 256, RW_H = 12, RW_K = 64, D_RWKV = 768, RWKV_COLS = 2688, D_IN_EVEN = 3456, D_IN_EVEN_PAD = 3584;
constexpr int D_DIFF = 768, D_GMLP = 256, D_IN_ODD = 2816;
constexpr int NEXP = 16, D_EXP = 2048, CAP_L = 1024, CAP_C = 32, ESLOTS = 4352;
constexpr int P_LD = 3584;
constexpr int LORA_K = 384, LORA_N = 3840;
constexpr int LKEYS = CTXL + TT;
constexpr float ALPHA_DN = 1.6817928305074290f;
constexpr float DECAY_SCALE = 0.6065306597126334f;
constexpr float GN_EPS = 64e-5f, LN_EPS = 1e-5f, RMS_EPS = 1e-5f;

constexpr size_t al256(size_t x) { return (x + 255) & ~(size_t)255; }
constexpr size_t WS_CTL = 0;
constexpr size_t CTL_BYTES = 65536;
constexpr size_t WS_MOD = WS_CTL + CTL_BYTES;
constexpr size_t WS_WIN = WS_MOD + al256((size_t)DEPTH * 5 * 6144 * 4);
constexpr size_t WS_WOUT = WS_WIN + (size_t)D_IN_EVEN_PAD * DM * 2;
constexpr size_t WS_WLORA = WS_WOUT + (size_t)DM * DM * 2;
constexpr size_t WS_WE13 = WS_WLORA + (size_t)LORA_N * LORA_K * 2;
constexpr size_t WS_WE2 = WS_WE13 + (size_t)NEXP * 4096 * DM * 2;
constexpr size_t WS_X = WS_WE2 + (size_t)NEXP * DM * D_EXP * 2;
constexpr size_t WS_H = WS_X + (size_t)MROWS * DM * 4;
constexpr size_t WS_A2 = WS_H + (size_t)MROWS * DM * 2;
constexpr size_t WS_P = WS_A2 + (size_t)MROWS * DM * 2;
constexpr size_t WS_AFF = WS_P + (size_t)MROWS * P_LD * 2;
constexpr size_t WS_SLOT = WS_AFF + (size_t)MROWS * 16 * 4;
constexpr size_t WS_IDX = WS_SLOT + (size_t)MROWS * 16 * 4;
constexpr size_t WS_GATE = WS_IDX + al256((size_t)NEXP * ESLOTS * 4);
constexpr size_t WS_R2 = WS_GATE + al256((size_t)NEXP * ESLOTS * 4);
constexpr size_t WS_SCN = WS_R2;
constexpr size_t WS_G = WS_SCN + (size_t)MROWS * 12 * 9 * 64 * 4;
constexpr size_t WS_LIN = WS_G + (size_t)MROWS * 768 * 2;
constexpr size_t WS_EVEN_END = WS_LIN + (size_t)MROWS * 384 * 2;
constexpr size_t WS_Y = WS_P;
constexpr size_t WS_Q = WS_R2;
constexpr size_t WS_KA = WS_Q + (size_t)MROWS * 768 * 2;
constexpr size_t WS_VT = WS_KA + (size_t)NB * LKEYS * 768 * 2;
constexpr size_t WS_HID = WS_R2;
constexpr size_t WS_YE = WS_HID + (size_t)NEXP * ESLOTS * D_EXP * 2;
constexpr size_t WS_END = WS_EVEN_END;
static_assert(WS_END <= (size_t)2147483648ull, "workspace over 2 GiB");
static_assert((size_t)2 * MROWS * 768 * 4 <= (size_t)MROWS * P_LD * 2, "Y aliases P");
static_assert(WS_YE + (size_t)NEXP * ESLOTS * DM * 2 <= WS_END, "moe region");

constexpr int LDS_BYTES = 147456;
constexpr int LDS_MISC = 140 * 1024;
constexpr int LDS_PTAB = LDS_MISC + 256;
constexpr int NWAVES = 8, NTHR = 512;

__device__ __forceinline__ unsigned f2bf(float f) { unsigned u = __float_as_uint(f); return (u + 0x7fffu + ((u >> 16) & 1u)) >> 16; }
__device__ __forceinline__ unsigned pk2(float lo, float hi) { f32x2 v = {lo, hi}; bf16x2_t b = __builtin_convertvector(v, bf16x2_t); return __builtin_bit_cast(unsigned, b); }
__device__ __forceinline__ float bflo(unsigned u) { return __uint_as_float(u << 16); }
__device__ __forceinline__ float bfhi(unsigned u) { return __uint_as_float(u & 0xffff0000u); }
__device__ __forceinline__ float bf2f(bf16_t b) { return __uint_as_float((unsigned)b << 16); }
__device__ __forceinline__ float sigmoidf_(float x) { return 1.f / (1.f + __expf(-x)); }
__device__ __forceinline__ float wave_sum(float v) {
#pragma unroll
    for (int o = 1; o < 64; o <<= 1) v += __shfl_xor(v, o);
    return v;
}
__device__ __forceinline__ float sum16(float v) {
#pragma unroll
    for (int o = 1; o < 16; o <<= 1) v += __shfl_xor(v, o);
    return v;
}
__device__ __forceinline__ float gelu_erf(float x) { return 0.5f * x * (1.f + erff(x * 0.70710678118654752f)); }

#define XB_TMO      128
#define XB_XCNT(j)  (256  + 64 * (j))
#define XB_XSUB(j)  (1280 + 64 * (j))
#define XB_XGEN(j)  (2304 + 64 * (j))
#define XB_TOP      3328
#define XB_TOPGEN   3392
#define XCD_BAR_WORDS 3456
#define XB_SPIN_CAP (1u << 20)

__device__ __forceinline__ unsigned xb_ld(unsigned* p)              { return __hip_atomic_load(p, __ATOMIC_RELAXED, __HIP_MEMORY_SCOPE_AGENT); }
__device__ __forceinline__ unsigned xb_add(unsigned* p, unsigned v) { return __hip_atomic_fetch_add(p, v, __ATOMIC_RELAXED, __HIP_MEMORY_SCOPE_AGENT); }
__device__ __forceinline__ unsigned xb_xcc_id() { return (unsigned)__builtin_amdgcn_s_getreg((3 << 11) | 20) & 0xFu; }
#define XB_SPIN(cond, bar) do { unsigned _sp = 0; while (cond) { __builtin_amdgcn_s_sleep(1); \
    if ((++_sp & 255u) == 0u) { if (xb_ld(&(bar)[XB_TMO])) break; if (_sp > XB_SPIN_CAP) { atomicAdd(&(bar)[XB_TMO], 1u); break; } } } } while (0)

struct XcdBarrier { unsigned* bar; unsigned x; volatile LAS unsigned* st; };

__device__ __forceinline__ XcdBarrier xcd_barrier_post(unsigned* bar, volatile LAS unsigned* st) {
    XcdBarrier b; b.bar = bar; b.x = xb_xcc_id(); b.st = st;
    if (threadIdx.x == 0) (void)xb_add(&bar[XB_XCNT(b.x)], 1u);
    return b;
}
__device__ __forceinline__ void xcd_barrier_complete(unsigned* bar, unsigned x, unsigned& nloc, unsigned& nx) {
    const unsigned G = gridDim.x * gridDim.y * gridDim.z;
    unsigned sum, cnt, mine, sp = 0u;
    for (;;) {
        sum = 0u; cnt = 0u; mine = 0u;
#pragma unroll
        for (unsigned j = 0; j < 16; ++j) { const unsigned c = xb_ld(&bar[XB_XCNT(j)]); sum += c; cnt += (c > 0u) ? 1u : 0u; mine = (j == x) ? c : mine; }
        if (sum == G) break;
        __builtin_amdgcn_s_sleep(1);
        if ((++sp & 255u) == 0u) { if (xb_ld(&bar[XB_TMO])) break; if (sp > XB_SPIN_CAP) { atomicAdd(&bar[XB_TMO], 1u); break; } }
    }
    nloc = mine > 0u ? mine : 1u; nx = cnt > 0u ? cnt : 1u;
}
__device__ __forceinline__ void xcd_barrier(const XcdBarrier& b) {
    asm volatile("s_waitcnt vmcnt(0)" ::: "memory");
    __syncthreads();
    if (threadIdx.x == 0) {
        unsigned* bar = b.bar;
        __builtin_amdgcn_s_waitcnt(0);
        unsigned nloc = b.st[0], nx = b.st[1];
        if (nloc == 0u) { xcd_barrier_complete(bar, b.x, nloc, nx); b.st[0] = nloc; b.st[1] = nx; }
        const unsigned old = xb_add(&bar[XB_XSUB(b.x)], 1u);
        const unsigned gen = old / nloc;
        if (old + 1u == (gen + 1u) * nloc) {
            __builtin_amdgcn_fence(__ATOMIC_RELEASE, "agent");
            asm volatile("s_waitcnt vmcnt(0)" ::: "memory");
            const unsigned og = xb_add(&bar[XB_TOP], 1u);
            const unsigned tg = og / nx;
            if (og + 1u == (tg + 1u) * nx) xb_add(&bar[XB_TOPGEN], 1u);
            else XB_SPIN(xb_ld(&bar[XB_TOPGEN]) == tg, bar);
            __builtin_amdgcn_fence(__ATOMIC_ACQUIRE, "agent");
            xb_add(&bar[XB_XGEN(b.x)], 1u);
            asm volatile("s_waitcnt vmcnt(0)" ::: "memory");
        } else {
            XB_SPIN(xb_ld(&bar[XB_XGEN(b.x)]) == gen, bar);
            __builtin_amdgcn_fence(__ATOMIC_ACQUIRE, "agent");
            asm volatile("s_waitcnt vmcnt(0)" ::: "memory");
        }
    }
    __syncthreads();
}

namespace pg8 {
constexpr int BM = 256, BK = 64, HALF = 128, HTB = HALF * BK * 2, STAGE_BYTES = 8 * HTB, NXCD = 8, WGM = 8;
__host__ __device__ __forceinline__ int lds_byte(int r, int c) { const int st = (r >> 4) * 2 + (c >> 5), rr = r & 15, cc = c & 31, ob = rr * 64 + cc * 2; return st * 1024 + (ob ^ (((ob >> 9) & 1) << 5)); }
__host__ __device__ __forceinline__ void stage_rc(int b, int& R, int& C) { const int st = b / 1024, sb = b % 1024, swz = sb ^ (((sb >> 9) & 1) << 5); R = (st >> 1) * 16 + swz / 64; C = (st & 1) * 32 + (swz % 64) / 2; }

struct Unit { int pm, pn; };
struct Gemm { const bf16_t* A; const bf16_t* Bt; int K; };

template <int MODE> struct Order {
    int nM, nN, nwg, G, c; const int* idx; long bstride;
    __device__ __forceinline__ void init(int nM_, int nN_, int G_, int c_, const int* idx_, long bstride_) { nM = nM_; nN = nN_; nwg = nM * nN; G = G_; c = c_; idx = idx_; bstride = bstride_; }
    __device__ __forceinline__ bool next(int i, Unit& u) const {
        const long L = (long)i * G + c; if (L >= nwg) return false;
        int wgid = (int)L; { const int q = nwg / NXCD, r = nwg % NXCD, xcd = wgid % NXCD, off = wgid / NXCD; wgid = (xcd < r ? xcd * (q + 1) : r * (q + 1) + (xcd - r) * q) + off; }
        const int nig = WGM * nN, gid = wgid / nig, fm = gid * WGM, gsz = (nM - fm) < WGM ? (nM - fm) : WGM;
        u.pm = fm + ((wgid % nig) % gsz); u.pn = (wgid % nig) / gsz; return true;
    }
    __device__ __forceinline__ unsigned arow(const Unit& u, int r) const { if (MODE == 1) return (unsigned)idx[u.pm * BM + r]; return (unsigned)(u.pm * BM + r); }
    __device__ __forceinline__ long bbase(const Unit& u, int K) const { long o = (long)u.pn * BM * K; if (MODE != 0) o += (long)(u.pm / 17) * bstride; return o; }
};

template <class Epi, class Sched>
__device__ __forceinline__ void gemm_phase(LAS unsigned char* lds, const Gemm g, const Sched& S, const Epi& E) {
    int tid = threadIdx.x; asm volatile("" : "+v"(tid));
    const int wid = __builtin_amdgcn_readfirstlane(tid >> 6), wr = wid >> 2, wc = wid & 3;
    const int K = g.K, nt = K / BK;
    unsigned voffB[2];
    { const int lane = tid & 63, fr = lane & 15, fq = lane >> 4; (void)fr; (void)fq; }
#pragma unroll
    for (int i = 0; i < 2; ++i) { int R, Cc; stage_rc(tid * 16 + i * 8192, R, Cc); voffB[i] = (unsigned)(R * K + Cc) * 2u; }
    const size_t kstep = (size_t)(BK * 2);
    const size_t hstep = (size_t)HALF * K * 2;
    const unsigned ldsw = (unsigned)wid * 1024u;
    const int aoff = lds_byte(wr * 64 + (tid & 15), ((tid & 63) >> 4) * 8), boff = lds_byte(wc * 32 + (tid & 15), ((tid & 63) >> 4) * 8);
#define PG8_SA(b, h) (((b) * 2 + (h)) * HTB)
#define PG8_SB(b, h) ((4 + (b) * 2 + (h)) * HTB)
#define PG8_STAGE(bufoff, gbase, voff) do { _Pragma("unroll") for (int _i = 0; _i < 2; ++_i) \
        __builtin_amdgcn_global_load_lds((const unsigned*)((const char*)(gbase) + (voff)[_i]), (LAS unsigned*)(lds + (bufoff) + ldsw + _i * 8192), 16, 0, 0); } while (0)
#define PG8_LDA(dst, b, h) do { _Pragma("unroll") for (int m = 0; m < 4; ++m) _Pragma("unroll") for (int k = 0; k < 2; ++k) dst[m][k] = *(const LAS bf16x8*)(lds + PG8_SA(b, h) + aoff + m * 2048 + k * 1024); } while (0)
#define PG8_LDB(dst, b, h) do { _Pragma("unroll") for (int n = 0; n < 2; ++n) _Pragma("unroll") for (int k = 0; k < 2; ++k) dst[n][k] = *(const LAS bf16x8*)(lds + PG8_SB(b, h) + boff + n * 2048 + k * 1024); } while (0)
#define PG8_MMA(ai, bj, At, Bt) do { __builtin_amdgcn_s_setprio(1); _Pragma("unroll") for (int m = 0; m < 4; ++m) _Pragma("unroll") for (int n = 0; n < 2; ++n) _Pragma("unroll") for (int k = 0; k < 2; ++k) \
        acc[ai][bj][m][n] = __builtin_amdgcn_mfma_f32_16x16x32_bf16(Bt[n][k], At[m][k], acc[ai][bj][m][n], 0, 0, 0); __builtin_amdgcn_s_setprio(0); } while (0)
#define PG8_WAIT_V(n) asm volatile("s_waitcnt vmcnt(" #n ")" ::: "memory")
#define PG8_WAIT_L(n) asm volatile("s_waitcnt lgkmcnt(" #n ")" ::: "memory")
#define PG8_BAR __builtin_amdgcn_s_barrier()
#define PG8_SCHED __builtin_amdgcn_sched_barrier(0)
#define PG8_ROWOFFS(dst, u, tq) do { _Pragma("unroll") for (int _i = 0; _i < 2; ++_i) { int _R, _C; stage_rc((tq) * 16 + _i * 8192, _R, _C); _Pragma("unroll") for (int _h = 0; _h < 2; ++_h) dst[_h][_i] = (S.arow(u, _h * HALF + _R) * (unsigned)K + (unsigned)_C) * 2u; } } while (0)
    Unit cur, nxt; int ui = 0;
    if (!S.next(0, cur)) return;
    f32x4 acc[2][2][4][2];
#pragma unroll
    for (int a = 0; a < 2; ++a)
#pragma unroll
        for (int b = 0; b < 2; ++b)
#pragma unroll
            for (int m = 0; m < 4; ++m)
#pragma unroll
                for (int n = 0; n < 2; ++n) acc[a][b][m][n] = (f32x4){0.f, 0.f, 0.f, 0.f};
    bf16x8 At[4][2], B0[2][2], B1[2][2];
    unsigned vcur[2][2];
    PG8_ROWOFFS(vcur, cur, tid);
    const char* const Ab = (const char*)g.A;
    const char* cB = (const char*)g.Bt + (size_t)S.bbase(cur, K) * 2;
    PG8_STAGE(PG8_SB(0, 0), cB, voffB); PG8_STAGE(PG8_SA(0, 0), Ab, vcur[0]); PG8_STAGE(PG8_SB(0, 1), cB + hstep, voffB); PG8_STAGE(PG8_SA(0, 1), Ab, vcur[1]);
    if (wr == 1) PG8_BAR;
    PG8_WAIT_V(4); PG8_BAR;
    PG8_STAGE(PG8_SB(1, 0), cB + kstep, voffB); PG8_STAGE(PG8_SA(1, 0), Ab + kstep, vcur[0]); PG8_STAGE(PG8_SB(1, 1), cB + hstep + kstep, voffB);
    PG8_WAIT_V(6); PG8_BAR;
    for (;;) {
        const bool has_next = S.next(ui + 1, nxt);
        const char* nB = has_next ? (const char*)g.Bt + (size_t)S.bbase(nxt, K) * 2 : cB;
        for (int t = 0; t < nt; t += 2) {
            const bool last = (t == nt - 2);
            const char* a1 = Ab + (size_t)(t + 1) * kstep;
            const char* a2 = last ? Ab : Ab + (size_t)(t + 2) * kstep; const char* b2 = last ? nB : cB + (size_t)(t + 2) * kstep;
            const char* a3 = a2 + kstep; const char* b3 = b2 + kstep;
            PG8_LDB(B0, 0, 0); PG8_SCHED; PG8_LDA(At, 0, 0); PG8_STAGE(PG8_SA(1, 1), a1, vcur[1]);
            PG8_WAIT_L(8); PG8_BAR; PG8_WAIT_L(0); PG8_MMA(0, 0, At, B0); PG8_BAR; PG8_SCHED;
            if (last && has_next) { int tq = tid; asm volatile("" : "+v"(tq)); PG8_ROWOFFS(vcur, nxt, tq); }
            PG8_LDB(B1, 0, 1); PG8_STAGE(PG8_SB(0, 0), b2, voffB);
            PG8_BAR; PG8_WAIT_L(0); PG8_MMA(0, 1, At, B1); PG8_BAR;
            PG8_LDA(At, 0, 1); PG8_STAGE(PG8_SA(0, 0), a2, vcur[0]);
            PG8_BAR; PG8_WAIT_L(0); PG8_MMA(1, 0, At, B0); PG8_BAR; PG8_SCHED;
            PG8_STAGE(PG8_SB(0, 1), b2 + hstep, voffB);
            PG8_WAIT_V(6); PG8_BAR; PG8_MMA(1, 1, At, B1); PG8_BAR;
            PG8_LDB(B0, 1, 0); PG8_SCHED; PG8_LDA(At, 1, 0); PG8_STAGE(PG8_SA(0, 1), a2, vcur[1]);
            PG8_WAIT_L(8); PG8_BAR; PG8_WAIT_L(0); PG8_MMA(0, 0, At, B0); PG8_BAR; PG8_SCHED;
            PG8_LDB(B1, 1, 1); PG8_STAGE(PG8_SB(1, 0), b3, voffB);
            PG8_BAR; PG8_WAIT_L(0); PG8_MMA(0, 1, At, B1); PG8_BAR;
            PG8_LDA(At, 1, 1); PG8_STAGE(PG8_SA(1, 0), a3, vcur[0]);
            PG8_BAR; PG8_WAIT_L(0); PG8_MMA(1, 0, At, B0); PG8_BAR; PG8_SCHED;
            PG8_STAGE(PG8_SB(1, 1), b3 + hstep, voffB);
            PG8_WAIT_V(6); PG8_BAR; PG8_MMA(1, 1, At, B1); PG8_BAR;
        }
        { int tz = tid; asm volatile("" : "+v"(tz)); const int ln = tz & 63; E(acc, cur, wr, wc, ln & 15, ln >> 4); }
        if (!has_next) break;
#pragma unroll
        for (int a = 0; a < 2; ++a)
#pragma unroll
            for (int b = 0; b < 2; ++b)
#pragma unroll
                for (int m = 0; m < 4; ++m)
#pragma unroll
                    for (int n = 0; n < 2; ++n) acc[a][b][m][n] = (f32x4){0.f, 0.f, 0.f, 0.f};
        cur = nxt; cB = nB; ++ui;
    }
    PG8_WAIT_V(0);
    if (wr == 0) PG8_BAR;
    PG8_BAR;
#undef PG8_SA
#undef PG8_SB
#undef PG8_STAGE
#undef PG8_LDA
#undef PG8_LDB
#undef PG8_MMA
#undef PG8_WAIT_V
#undef PG8_WAIT_L
#undef PG8_BAR
#undef PG8_SCHED
#undef PG8_ROWOFFS
}

#define EPI_LOOP for (int ai = 0; ai < 2; ++ai) for (int m = 0; m < 4; ++m) for (int bj = 0; bj < 2; ++bj) for (int n = 0; n < 2; ++n)
struct EpiBf16 {
    bf16_t* O; int ldc;
    __device__ __forceinline__ void operator()(const f32x4 (&acc)[2][2][4][2], const Unit& u, int wr, int wc, int fr, int fq) const {
        const int row0 = u.pm * BM + wr * 64 + fr, col0 = u.pn * BM + wc * 32 + 4 * fq;
#pragma unroll
        for (int ai = 0; ai < 2; ++ai)
#pragma unroll
            for (int m = 0; m < 4; ++m) { bf16_t* rowp = O + (size_t)(row0 + ai * HALF + m * 16) * ldc + col0;
#pragma unroll
                for (int bj = 0; bj < 2; ++bj)
#pragma unroll
                    for (int n = 0; n < 2; ++n) { const f32x4 v = acc[ai][bj][m][n]; u32x2 o; o.x = pk2(v[0], v[1]); o.y = pk2(v[2], v[3]); *(u32x2*)(rowp + bj * HALF + n * 16) = o; } }
    }
};
struct EpiRes {
    float* X; const float* modl;
    __device__ __forceinline__ void operator()(const f32x4 (&acc)[2][2][4][2], const Unit& u, int wr, int wc, int fr, int fq) const {
        const int row0 = u.pm * BM + wr * 64 + fr, col0 = u.pn * BM + wc * 32 + 4 * fq;
        const int mi = (u.pm * BM < NLAT) ? (u.pm * BM) / TT : 4;
        const float* gate = modl + mi * 6144 + 2 * DM;
        f32x4 gv[2][2];
#pragma unroll
        for (int bj = 0; bj < 2; ++bj)
#pragma unroll
            for (int n = 0; n < 2; ++n) gv[bj][n] = *(const f32x4*)(gate + col0 + bj * HALF + n * 16);
#pragma unroll
        for (int ai = 0; ai < 2; ++ai)
#pragma unroll
            for (int m = 0; m < 4; ++m) { float* rowp = X + (size_t)(row0 + ai * HALF + m * 16) * DM + col0;
#pragma unroll
                for (int bj = 0; bj < 2; ++bj)
#pragma unroll
                    for (int n = 0; n < 2; ++n) { f32x4* p = (f32x4*)(rowp + bj * HALF + n * 16); const f32x4 x = *p; *p = x * ALPHA_DN + gv[bj][n] * acc[ai][bj][m][n]; } }
    }
};
struct EpiSwiGLU {
    bf16_t* HID;
    __device__ __forceinline__ void operator()(const f32x4 (&acc)[2][2][4][2], const Unit& u, int wr, int wc, int fr, int fq) const {
        const int row0 = u.pm * BM + wr * 64 + fr, f0 = u.pn * HALF + wc * 32 + 4 * fq;
#pragma unroll
        for (int ai = 0; ai < 2; ++ai)
#pragma unroll
            for (int m = 0; m < 4; ++m) { bf16_t* rowp = HID + (size_t)(row0 + ai * HALF + m * 16) * D_EXP + f0;
#pragma unroll
                for (int n = 0; n < 2; ++n) { const f32x4 a = acc[ai][0][m][n], b = acc[ai][1][m][n]; float h[4];
#pragma unroll
                    for (int j = 0; j < 4; ++j) h[j] = a[j] / (1.f + __expf(-a[j])) * b[j];
                    u32x2 o; o.x = pk2(h[0], h[1]); o.y = pk2(h[2], h[3]); *(u32x2*)(rowp + n * 16) = o; } }
    }
};
struct EpiYE {
    bf16_t* YE; const float* gate;
    __device__ __forceinline__ void operator()(const f32x4 (&acc)[2][2][4][2], const Unit& u, int wr, int wc, int fr, int fq) const {
        const int row0 = u.pm * BM + wr * 64 + fr, col0 = u.pn * BM + wc * 32 + 4 * fq;
#pragma unroll
        for (int ai = 0; ai < 2; ++ai)
#pragma unroll
            for (int m = 0; m < 4; ++m) { const int row = row0 + ai * HALF + m * 16; const float gt = gate[row]; bf16_t* rowp = YE + (size_t)row * DM + col0;
#pragma unroll
                for (int bj = 0; bj < 2; ++bj)
#pragma unroll
                    for (int n = 0; n < 2; ++n) { const f32x4 v = acc[ai][bj][m][n] * gt; u32x2 o; o.x = pk2(v[0], v[1]); o.y = pk2(v[2], v[3]); *(u32x2*)(rowp + bj * HALF + n * 16) = o; } }
    }
};
struct EpiLora {
    float* SCN; bf16_t* G; const float* decay0; const float* a0; const float* kalpha;
    __device__ __forceinline__ void operator()(const f32x4 (&acc)[2][2][4][2], const Unit& u, int wr, int wc, int fr, int fq) const {
        const int row0 = u.pm * BM + wr * 64 + fr;
        const int seg = u.pn / 3, cb = (u.pn % 3) * BM + wc * 32 + 4 * fq;
#pragma unroll
        for (int bj = 0; bj < 2; ++bj)
#pragma unroll
            for (int n = 0; n < 2; ++n) {
                const int col = cb + bj * HALF + n * 16, head = col >> 6, kx = col & 63;
                if (seg < 2) {
                    const f32x4 d0 = *(const f32x4*)(decay0 + seg * 768 + col);
#pragma unroll
                    for (int ai = 0; ai < 2; ++ai)
#pragma unroll
                        for (int m = 0; m < 4; ++m) { const int row = row0 + ai * HALF + m * 16; f32x4 w;
#pragma unroll
                            for (int j = 0; j < 4; ++j) w[j] = __expf(-DECAY_SCALE * sigmoidf_(d0[j] + acc[ai][bj][m][n][j]));
                            *(f32x4*)(SCN + ((size_t)(row * 12 + head) * 9 + 3 + 3 * seg) * 64 + kx) = w; }
                } else if (seg < 4) {
                    const int d = seg - 2;
                    const f32x4 a00 = *(const f32x4*)(a0 + d * 768 + col), kal = *(const f32x4*)(kalpha + col);
#pragma unroll
                    for (int ai = 0; ai < 2; ++ai)
#pragma unroll
                        for (int m = 0; m < 4; ++m) { const int row = row0 + ai * HALF + m * 16; float* base = SCN + (size_t)(row * 12 + head) * 9 * 64 + kx;
                            const f32x4 kk = *(const f32x4*)(base + 1 * 64); const f32x4 ks = *(const f32x4*)(base + (5 + 3 * d) * 64); f32x4 bb, kr;
#pragma unroll
                            for (int j = 0; j < 4; ++j) { const float a = sigmoidf_(a00[j] + acc[ai][bj][m][n][j]); bb[j] = kk[j] * a; kr[j] = ks[j] * (1.f + (a - 1.f) * kal[j]); }
                            *(f32x4*)(base + (4 + 3 * d) * 64) = bb; *(f32x4*)(base + (5 + 3 * d) * 64) = kr; }
                } else {
#pragma unroll
                    for (int ai = 0; ai < 2; ++ai)
#pragma unroll
                        for (int m = 0; m < 4; ++m) { const int row = row0 + ai * HALF + m * 16; const f32x4 v = acc[ai][bj][m][n]; u32x2 o; o.x = pk2(v[0], v[1]); o.y = pk2(v[2], v[3]);
                            *(u32x2*)(G + (size_t)row * 768 + col) = o; }
                }
            }
    }
};
}

struct Args { const float* in[37]; float* out; unsigned char* ws; int lo, hi; };
enum { I_X = 0, I_C, I_CTX, I_CCTX, I_WMOD, I_BMOD, I_LNG, I_LNB, I_EWIN, I_EWOUT, I_CONVW, I_MU, I_DUP, I_D0, I_AUP, I_A0, I_GUP, I_KXI, I_KAL, I_RBON, I_GNG, I_GNB,
       I_OWIN, I_OWOUT, I_LQ1, I_LK1, I_LQ2, I_LK2, I_SUBG, I_GLNG, I_GLNB, I_GWS, I_GBS, I_WR, I_WE1, I_WE3, I_WE2 };

struct Ctx {
    LAS unsigned char* lds;
    int tid, lane, wave, G, vcu, gw, NGW;
};
__device__ __forceinline__ void mkctx(Ctx& C, LAS unsigned char* lds) {
    int tid = threadIdx.x; asm volatile("" : "+v"(tid));
    C.lds = lds; C.tid = tid; C.lane = tid & 63; C.wave = __builtin_amdgcn_readfirstlane(tid >> 6);
    C.G = gridDim.x; { const int bx = blockIdx.x; C.vcu = (C.G % 8 == 0) ? (bx % 8) * (C.G / 8) + bx / 8 : bx; }
    C.gw = blockIdx.x * NWAVES + C.wave; C.NGW = C.G * NWAVES;
}
__device__ __forceinline__ void ldargs(Args& A, LAS unsigned char* lds) {
    LAS const u32x2* tb = (LAS const u32x2*)(lds + LDS_PTAB); asm volatile("" : "+v"(tb));
#pragma unroll
    for (int i = 0; i < 37; ++i) { const u32x2 v = tb[i]; A.in[i] = (const float*)(((unsigned long long)(unsigned)__builtin_amdgcn_readfirstlane((int)v.y) << 32) | (unsigned)__builtin_amdgcn_readfirstlane((int)v.x)); }
    { const u32x2 v = tb[37]; A.out = (float*)(((unsigned long long)(unsigned)__builtin_amdgcn_readfirstlane((int)v.y) << 32) | (unsigned)__builtin_amdgcn_readfirstlane((int)v.x)); }
    { const u32x2 v = tb[38]; A.ws = (unsigned char*)(((unsigned long long)(unsigned)__builtin_amdgcn_readfirstlane((int)v.y) << 32) | (unsigned)__builtin_amdgcn_readfirstlane((int)v.x)); }
    A.lo = 0; A.hi = 0;
}
__device__ __forceinline__ int row_mi(int row) { return row < NLAT ? (row >> 13) : 4; }

__device__ __forceinline__ void phase_init(const Ctx& C, const Args& A) {
    unsigned char* ws = A.ws;
    float* MOD = (float*)(ws + WS_MOD);
    LAS float* sv = (LAS float*)C.lds;
    LAS float* red = sv + 5 * 1024;
    for (int i = C.tid; i < 5 * 1024; i += NTHR) { const int v = i >> 10, k = i & 1023; const float c = (v < 4) ? A.in[I_C][v * DM + k] : A.in[I_CCTX][k]; sv[i] = c / (1.f + __expf(-c)); }
    __syncthreads();
    const int j = C.tid & 127, kp = C.tid >> 7;
    for (int it = blockIdx.x; it < DEPTH * 48; it += C.G) {
        const int l = it / 48, cg = it % 48, col = cg * 128 + j;
        const float* W = A.in[I_WMOD] + (size_t)l * DM * 6144 + col;
        float a0 = 0.f, a1 = 0.f, a2 = 0.f, a3 = 0.f, a4 = 0.f;
#pragma unroll 4
        for (int k = kp * 256; k < kp * 256 + 256; ++k) { const float w = W[(size_t)k * 6144]; a0 += sv[k] * w; a1 += sv[1024 + k] * w; a2 += sv[2048 + k] * w; a3 += sv[3072 + k] * w; a4 += sv[4096 + k] * w; }
        red[(kp * 5 + 0) * 128 + j] = a0; red[(kp * 5 + 1) * 128 + j] = a1; red[(kp * 5 + 2) * 128 + j] = a2; red[(kp * 5 + 3) * 128 + j] = a3; red[(kp * 5 + 4) * 128 + j] = a4;
        __syncthreads();
        for (int o = C.tid; o < 5 * 128; o += NTHR) { const int v = o >> 7, jj = o & 127; const int cc = cg * 128 + jj;
            const float s = red[(0 * 5 + v) * 128 + jj] + red[(1 * 5 + v) * 128 + jj] + red[(2 * 5 + v) * 128 + jj] + red[(3 * 5 + v) * 128 + jj];
            MOD[((size_t)l * 5 + v) * 6144 + cc] = s + A.in[I_BMOD][l * 6144 + cc]; }
        __syncthreads();
    }
    f32x4* X4 = (f32x4*)(ws + WS_X);
    const f32x4* x4 = (const f32x4*)A.in[I_X]; const f32x4* c4 = (const f32x4*)A.in[I_CTX];
    const size_t nl = (size_t)NLAT * DM / 4, nc = (size_t)NCTX * DM / 4;
    for (size_t i = (size_t)blockIdx.x * NTHR + C.tid; i < nl + nc; i += (size_t)C.G * NTHR) X4[i] = (i < nl) ? x4[i] : c4[i - nl];
}

__device__ __forceinline__ void transpose_item(const float* W, int ldw, int k0, int n0, bf16_t* WT, int ldt, int drow0, LAS float* scr, int lane) {
    { float v[64]; const float* src = W + (size_t)k0 * ldw + n0 + lane;
#pragma unroll
      for (int k = 0; k < 64; ++k) v[k] = __builtin_nontemporal_load(src + (size_t)k * ldw);
#pragma unroll
      for (int k = 0; k < 64; ++k) scr[k * 65 + lane] = v[k]; }
    asm volatile("s_waitcnt lgkmcnt(0)" ::: "memory");
    const int c = lane & 7;
#pragma unroll
    for (int j = 0; j < 8; ++j) { const int n = (lane >> 3) + 8 * j; const LAS float* s = scr + (8 * c) * 65 + n;
        u32x4 o; o.x = pk2(s[0 * 65], s[1 * 65]); o.y = pk2(s[2 * 65], s[3 * 65]); o.z = pk2(s[4 * 65], s[5 * 65]); o.w = pk2(s[6 * 65], s[7 * 65]);
        *(u32x4*)(WT + (size_t)(drow0 + n) * ldt + k0 + 8 * c) = o; }
    asm volatile("s_waitcnt lgkmcnt(0)" ::: "memory");
}
__device__ __forceinline__ void phase_conv(const Ctx& C, const Args& A, int l) {
    unsigned char* ws = A.ws;
    const int i2 = l >> 1; const bool odd = (l & 1);
    LAS float* scr = (LAS float*)C.lds + C.wave * (64 * 65);
    bf16_t* WIN = (bf16_t*)(ws + WS_WIN); bf16_t* WOUT = (bf16_t*)(ws + WS_WOUT); bf16_t* WE13 = (bf16_t*)(ws + WS_WE13); bf16_t* WE2 = (bf16_t*)(ws + WS_WE2);
    const int nin = odd ? D_IN_ODD : D_IN_EVEN;
    const float* win = odd ? A.in[I_OWIN] + (size_t)i2 * DM * D_IN_ODD : A.in[I_EWIN] + (size_t)i2 * DM * D_IN_EVEN;
    const float* wout = odd ? A.in[I_OWOUT] + (size_t)i2 * DM * DM : A.in[I_EWOUT] + (size_t)i2 * DM * DM;
    const int n_in = 16 * (nin / 64), n_out = 16 * 16, n_e13 = NEXP * 2 * 16 * 32, n_e2 = NEXP * 32 * 16;
    const int total = n_in + n_out + n_e13 + n_e2;
    for (int it = C.gw; it < total; it += C.NGW) {
        int r = it;
        if (r < n_in) { const int nb = nin / 64, kb = r / nb, nn = r % nb; transpose_item(win, nin, kb * 64, nn * 64, WIN, DM, nn * 64, scr, C.lane); continue; } r -= n_in;
        if (r < n_out) { const int kb = r / 16, nn = r % 16; transpose_item(wout, DM, kb * 64, nn * 64, WOUT, DM, nn * 64, scr, C.lane); continue; } r -= n_out;
        if (r < n_e13) { const int e = r / 1024, q = r % 1024, mat = q / 512, q2 = q % 512, kb = q2 / 32, nn = q2 % 32;
            const float* W = (mat ? A.in[I_WE3] : A.in[I_WE1]) + ((size_t)l * NEXP + e) * DM * D_EXP;
            const int f0 = nn * 64; const int drow = (f0 >> 7) * 256 + mat * 128 + (f0 & 127);
            transpose_item(W, D_EXP, kb * 64, f0, WE13 + (size_t)e * 4096 * DM, DM, drow, scr, C.lane); continue; } r -= n_e13;
        { const int e = r / 512, q = r % 512, kb = q / 16, nn = q % 16;
            const float* W = A.in[I_WE2] + ((size_t)l * NEXP + e) * D_EXP * DM;
            transpose_item(W, DM, kb * 64, nn * 64, WE2 + (size_t)e * DM * D_EXP, D_EXP, nn * 64, scr, C.lane); }
    }
    if (!odd) {
        u32x4* z = (u32x4*)(WIN + (size_t)D_IN_EVEN * DM);
        for (int i = blockIdx.x * NTHR + C.tid; i < (D_IN_EVEN_PAD - D_IN_EVEN) * DM / 8; i += C.G * NTHR) z[i] = (u32x4){0u, 0u, 0u, 0u};
        bf16_t* WL = (bf16_t*)(ws + WS_WLORA);
        const float* dup = A.in[I_DUP] + (size_t)i2 * 2 * 64 * 768; const float* aup = A.in[I_AUP] + (size_t)i2 * 2 * 64 * 768; const float* gup = A.in[I_GUP] + (size_t)i2 * 128 * 768;
        for (int i = blockIdx.x * NTHR + C.tid; i < LORA_N * LORA_K; i += C.G * NTHR) {
            const int kk = i / LORA_N, n = i % LORA_N, seg = n / 768, col = n % 768; float v = 0.f;
            if (seg == 0) { if (kk < 64) v = dup[(size_t)(0 * 64 + kk) * 768 + col]; }
            else if (seg == 1) { if (kk >= 64 && kk < 128) v = dup[(size_t)(1 * 64 + kk - 64) * 768 + col]; }
            else if (seg == 2) { if (kk >= 128 && kk < 192) v = aup[(size_t)(0 * 64 + kk - 128) * 768 + col]; }
            else if (seg == 3) { if (kk >= 192 && kk < 256) v = aup[(size_t)(1 * 64 + kk - 192) * 768 + col]; }
            else { if (kk >= 256) v = gup[(size_t)(kk - 256) * 768 + col]; }
            WL[(size_t)n * LORA_K + kk] = (bf16_t)f2bf(v);
        }
    }
}

__device__ __forceinline__ void phase_modh(const Ctx& C, const Args& A, int l) {
    const float* X = (const float*)(A.ws + WS_X); bf16_t* H = (bf16_t*)(A.ws + WS_H); const float* MOD = (const float*)(A.ws + WS_MOD) + (size_t)l * 5 * 6144;
    for (int row = C.gw; row < MROWS; row += C.NGW) {
        const float* md = MOD + row_mi(row) * 6144;
#pragma unroll
        for (int j = 0; j < 4; ++j) { const int col = 4 * C.lane + 256 * j; const f32x4 x = *(const f32x4*)(X + (size_t)row * DM + col), sh = *(const f32x4*)(md + col), sc = *(const f32x4*)(md + DM + col);
            const f32x4 h = x * (sc + 1.f) + sh; u32x2 o; o.x = pk2(h[0], h[1]); o.y = pk2(h[2], h[3]); *(u32x2*)(H + (size_t)row * DM + col) = o; }
    }
}

__device__ __forceinline__ f32x4 ld4bf(const bf16_t* p) { const u32x2 u = *(const u32x2*)p; return (f32x4){bflo(u.x), bfhi(u.x), bflo(u.y), bfhi(u.y)}; }
__device__ __forceinline__ void st4bf(bf16_t* p, f32x4 v) { u32x2 o; o.x = pk2(v[0], v[1]); o.y = pk2(v[2], v[3]); *(u32x2*)p = o; }
__device__ __forceinline__ void seq_info(int row, bool& hasp, bool& hasn) {
    if (row < NLAT) { const int t = row & (TT - 1); hasp = t > 0; hasn = t < TT - 1; }
    else { const int t = (row - NLAT) & (CTXL - 1); hasp = t > 0; hasn = t < CTXL - 1; }
}
__device__ __forceinline__ void phase_ef1(const Ctx& C, const Args& A, int l) {
    const int i2 = l >> 1; unsigned char* ws = A.ws;
    const bf16_t* P = (const bf16_t*)(ws + WS_P); bf16_t* A2 = (bf16_t*)(ws + WS_A2); float* SCN = (float*)(ws + WS_SCN); bf16_t* LIN = (bf16_t*)(ws + WS_LIN);
    const float* cw = A.in[I_CONVW] + (size_t)i2 * 3 * 256; const float* mu = A.in[I_MU] + (size_t)i2 * RWKV_COLS; const float* kxi = A.in[I_KXI] + (size_t)i2 * 768;
    const f32x4 z4 = {0.f, 0.f, 0.f, 0.f};
    for (int row = C.gw; row < MROWS; row += C.NGW) {
        bool hasp, hasn; seq_info(row, hasp, hasn);
        const bf16_t* p0 = P + (size_t)row * P_LD; const bf16_t* pm = p0 - P_LD; const bf16_t* pp = p0 + P_LD;
        {
            const int j4 = 4 * C.lane;
            const f32x4 bg = ld4bf(p0 + j4), u0 = ld4bf(p0 + 256 + j4) * ld4bf(p0 + 512 + j4);
            const f32x4 um = hasp ? ld4bf(pm + 256 + j4) * ld4bf(pm + 512 + j4) : z4, up = hasn ? ld4bf(pp + 256 + j4) * ld4bf(pp + 512 + j4) : z4;
            const f32x4 w0 = *(const f32x4*)(cw + j4), w1 = *(const f32x4*)(cw + 256 + j4), w2 = *(const f32x4*)(cw + 512 + j4);
            st4bf(A2 + (size_t)row * DM + j4, bg * (w0 * um + w1 * u0 + w2 * up));
        }
#pragma unroll
        for (int it = 0; it < 11; ++it) {
            const int c = it * 256 + 4 * C.lane;
            if (c < RWKV_COLS) {
                const f32x4 x0 = ld4bf(p0 + 768 + c), xm = hasp ? ld4bf(pm + 768 + c) : z4, xp = hasn ? ld4bf(pp + 768 + c) : z4, m4 = *(const f32x4*)(mu + c);
                const f32x4 ps = x0 + m4 * ((xm + xp) * 0.5f - x0);
                if (it < 3) { const int head = c >> 6, kx = c & 63; *(f32x4*)(SCN + ((size_t)(row * 12 + head) * 9 + 0) * 64 + kx) = ps; }
                else if (it < 6) { const int c1 = c - 768, head = c1 >> 6, kx = c1 & 63; const f32x4 kv = ps * *(const f32x4*)(kxi + c1);
                    const float ss = sum16(kv[0] * kv[0] + kv[1] * kv[1] + kv[2] * kv[2] + kv[3] * kv[3]); const float rn = rsqrtf(ss + 1e-12f);
                    float* base = SCN + (size_t)(row * 12 + head) * 9 * 64 + kx;
                    *(f32x4*)(base + 1 * 64) = kv * rn; *(f32x4*)(base + 5 * 64) = ps; *(f32x4*)(base + 8 * 64) = ps; }
                else if (it < 9) { const int c1 = c - 1536, head = c1 >> 6, kx = c1 & 63; *(f32x4*)(SCN + ((size_t)(row * 12 + head) * 9 + 2) * 64 + kx) = ps; }
                else { const int c1 = c - 2304; f32x4 o;
                    if (c1 < 128) { o = (f32x4){tanhf(ps[0]), tanhf(ps[1]), tanhf(ps[2]), tanhf(ps[3])}; }
                    else if (c1 < 256) { o = ps; }
                    else { o = (f32x4){sigmoidf_(ps[0]), sigmoidf_(ps[1]), sigmoidf_(ps[2]), sigmoidf_(ps[3])}; }
                    st4bf(LIN + (size_t)row * LORA_K + c1, o); }
            }
        }
    }
}

__device__ __forceinline__ int scan_row(int i, int b, int d) {
    if (d == 0) return i < CTXL ? NLAT + b * CTXL + i : b * TT + (i - CTXL);
    return i < CTXL ? NLAT + b * CTXL + (CTXL - 1 - i) : b * TT + (TT - 1 - (i - CTXL));
}
__device__ __forceinline__ float red8(float v) {
    v += __uint_as_float((unsigned)__builtin_amdgcn_update_dpp(0, (int)__float_as_uint(v), 0xB1, 0xF, 0xF, true));
    v += __uint_as_float((unsigned)__builtin_amdgcn_update_dpp(0, (int)__float_as_uint(v), 0x4E, 0xF, 0xF, true));
    v += __uint_as_float((unsigned)__builtin_amdgcn_update_dpp(0, (int)__float_as_uint(v), 0x141, 0xF, 0xF, true));
    return v;
}
__device__ __forceinline__ float red16(float v) {
    v += __uint_as_float((unsigned)__builtin_amdgcn_update_dpp(0, (int)__float_as_uint(v), 0xB1, 0xF, 0xF, true));
    v += __uint_as_float((unsigned)__builtin_amdgcn_update_dpp(0, (int)__float_as_uint(v), 0x4E, 0xF, 0xF, true));
    v += __uint_as_float((unsigned)__builtin_amdgcn_update_dpp(0, (int)__float_as_uint(v), 0x141, 0xF, 0xF, true));
    v += __uint_as_float((unsigned)__builtin_amdgcn_update_dpp(0, (int)__float_as_uint(v), 0x140, 0xF, 0xF, true));
    return v;
}
__device__ __forceinline__ void phase_scan(const Ctx& C, const Args& A) {
    for (int u = blockIdx.x; u < 192; u += C.G) {
    const int half = u & 1, d = (u >> 1) & 1, h = (u >> 2) % 12, b = u / 48;
    const float* SCN = (const float*)(A.ws + WS_SCN); float* Y = (float*)(A.ws + WS_Y) + (size_t)d * MROWS * 768;
    LAS float* buf = (LAS float*)C.lds; LAS float* ybuf = buf + 2 * 32 * 352;
    constexpr int NCH = LKEYS / 32;
    f32x4 st[6];
    int ps_[6], prel[6], pdst[6];
#pragma unroll
    for (int j = 0; j < 6; ++j) { const int p = C.tid + NTHR * j; const int s = p / 88, q = p % 88, vec = q >> 4; ps_[j] = s; pdst[j] = s * 352 + q * 4;
        const int slot = vec == 0 ? 3 + 3 * d : vec == 1 ? 1 : vec == 2 ? 4 + 3 * d : vec == 3 ? 5 + 3 * d : vec == 4 ? 0 : 2;
        prel[j] = slot * 64 + (vec < 5 ? (q & 15) * 4 : half * 32 + (q - 80) * 4); }
    const int sgn = d ? -1 : 1;
    const float* SCNh = SCN + (size_t)h * 576;
#define SCAN_ROW0(c) (((c) * 32 < CTXL) ? (NLAT + b * CTXL + (d ? CTXL - 1 - (c) * 32 : (c) * 32)) : (b * TT + (d ? TT - 1 - ((c) * 32 - CTXL) : (c) * 32 - CTXL)))
#define SCAN_LOADG(c) do { const int row0_ = SCAN_ROW0(c); _Pragma("unroll") for (int j = 0; j < 6; ++j) if (j < 5 || C.tid < 2816 - 5 * NTHR) { \
        st[j] = *(const f32x4*)(SCNh + (size_t)(row0_ + sgn * ps_[j]) * (12 * 576) + prel[j]); } } while (0)
#define SCAN_STORE(bi) do { _Pragma("unroll") for (int j = 0; j < 6; ++j) if (j < 5 || C.tid < 2816 - 5 * NTHR) *(LAS f32x4*)(buf + (bi) * (32 * 352) + pdst[j]) = st[j]; } while (0)
    SCAN_LOADG(0); SCAN_STORE(0); __syncthreads();
    float S0 = 0.f, S1 = 0.f, S2 = 0.f, S3 = 0.f;
    const int rl = C.lane >> 4, ks = C.lane & 15;
#define SC_LD(R, s) do { const LAS float* bp_ = cur + (s) * 352 + ks * 4; \
        R##w = *(const LAS f32x4*)(bp_); R##k = *(const LAS f32x4*)(bp_ + 64); R##b = *(const LAS f32x4*)(bp_ + 128); R##q = *(const LAS f32x4*)(bp_ + 192); R##r = *(const LAS f32x4*)(bp_ + 256); \
        R##vv = cur[(s) * 352 + 320 + C.wave * 4 + rl]; } while (0)
#define SC_STEP(R, s) do { \
        const float sa = red16((S0 * R##k[0] + S1 * R##k[1]) + (S2 * R##k[2] + S3 * R##k[3])); \
        S0 = S0 * R##w[0] + (R##vv * R##q[0] - sa * R##b[0]); S1 = S1 * R##w[1] + (R##vv * R##q[1] - sa * R##b[1]); \
        S2 = S2 * R##w[2] + (R##vv * R##q[2] - sa * R##b[2]); S3 = S3 * R##w[3] + (R##vv * R##q[3] - sa * R##b[3]); \
        const float y = red16((S0 * R##r[0] + S1 * R##r[1]) + (S2 * R##r[2] + S3 * R##r[3])); if (ks == 0) yb[(s) * 32] = y; } while (0)
    for (int c = 0; c < NCH; ++c) {
        if (c + 1 < NCH) SCAN_LOADG(c + 1);
        {
            const LAS float* cur = buf + (c & 1) * (32 * 352);
            LAS float* yb = ybuf + (c & 1) * 1024 + C.wave * 4 + rl;
            f32x4 Aw, Ak, Ab, Aq, Ar, Bw, Bk, Bb, Bq, Br, Cw, Ck, Cb, Cq, Cr, Dw, Dk, Db, Dq, Dr; float Avv, Bvv, Cvv, Dvv;
            SC_LD(A, 0); SC_LD(B, 1);
#pragma unroll 1
            for (int s = 0; s < 32; s += 4) {
                SC_LD(C, s + 2); __builtin_amdgcn_sched_barrier(0); SC_STEP(A, s); __builtin_amdgcn_sched_barrier(0);
                SC_LD(D, s + 3); __builtin_amdgcn_sched_barrier(0); SC_STEP(B, s + 1); __builtin_amdgcn_sched_barrier(0);
                SC_LD(A, s + 4); __builtin_amdgcn_sched_barrier(0); SC_STEP(C, s + 2); __builtin_amdgcn_sched_barrier(0);
                SC_LD(B, s + 5); __builtin_amdgcn_sched_barrier(0); SC_STEP(D, s + 3); __builtin_amdgcn_sched_barrier(0);
            }
        }
        if (c + 1 < NCH) SCAN_STORE((c + 1) & 1);
        __syncthreads();
        { const int row0_ = SCAN_ROW0(c);
#pragma unroll
          for (int i = 0; i < 2; ++i) { const int e = C.tid + NTHR * i, s = e >> 5, r = e & 31;
            Y[(size_t)(row0_ + sgn * s) * 768 + h * 64 + half * 32 + r] = ybuf[(c & 1) * 1024 + e]; } }
    }
    __syncthreads();
    }
#undef SCAN_LOADG
#undef SCAN_STORE
#undef SCAN_ROW0
#undef SC_LD
#undef SC_STEP
}

__device__ __forceinline__ void phase_ef2(const Ctx& C, const Args& A, int l) {
    const int i2 = l >> 1; unsigned char* ws = A.ws;
    const float* SCN = (const float*)(ws + WS_SCN); const float* Y0 = (const float*)(ws + WS_Y); const float* Y1 = Y0 + (size_t)MROWS * 768;
    const bf16_t* G = (const bf16_t*)(ws + WS_G); bf16_t* A2 = (bf16_t*)(ws + WS_A2);
    const float* rb = A.in[I_RBON] + (size_t)i2 * 768; const float* gg = A.in[I_GNG] + (size_t)i2 * 768; const float* gb = A.in[I_GNB] + (size_t)i2 * 768;
    for (int row = C.gw; row < MROWS; row += C.NGW) {
#pragma unroll
        for (int it = 0; it < 3; ++it) {
            const int c = it * 256 + 4 * C.lane, head = c >> 6, kx = c & 63;
            const f32x4 y = *(const f32x4*)(Y0 + (size_t)row * 768 + c) + *(const f32x4*)(Y1 + (size_t)row * 768 + c);
            const float mean = sum16((y[0] + y[1]) + (y[2] + y[3])) * (1.f / 64.f);
            const f32x4 dd = y - mean;
            const float var = sum16((dd[0] * dd[0] + dd[1] * dd[1]) + (dd[2] * dd[2] + dd[3] * dd[3])) * (1.f / 64.f);
            const float rstd = rsqrtf(var + GN_EPS);
            const float* base = SCN + (size_t)(row * 12 + head) * 9 * 64 + kx;
            const f32x4 r = *(const f32x4*)(base), v = *(const f32x4*)(base + 2 * 64), k0 = *(const f32x4*)(base + 5 * 64), k1 = *(const f32x4*)(base + 8 * 64);
            const f32x4 rb4 = *(const f32x4*)(rb + c);
            const f32x4 t = r * (k0 + k1) * 0.5f * rb4;
            const float bs = sum16((t[0] + t[1]) + (t[2] + t[3]));
            const f32x4 yn = dd * rstd * *(const f32x4*)(gg + c) + *(const f32x4*)(gb + c);
            const f32x4 g = ld4bf(G + (size_t)row * 768 + c);
            st4bf(A2 + (size_t)row * DM + 256 + c, g * (yn + v * bs));
        }
    }
}

__device__ __forceinline__ float max3f(float a, float b, float c) { float r; asm("v_max3_f32 %0, %1, %2, %3" : "=v"(r) : "v"(a), "v"(b), "v"(c)); return r; }
__device__ __forceinline__ int crow(int r, int hi) { return (r & 3) + 8 * (r >> 2) + 4 * hi; }
constexpr float QSCALE = 0.125f * 1.4426950408889634f;
__device__ __forceinline__ void phase_of1(const Ctx& C, const Args& A, int l) {
    const int i2 = l >> 1; unsigned char* ws = A.ws;
    const bf16_t* P = (const bf16_t*)(ws + WS_P); bf16_t* A2 = (bf16_t*)(ws + WS_A2); bf16_t* Q = (bf16_t*)(ws + WS_Q); bf16_t* KA = (bf16_t*)(ws + WS_KA); bf16_t* VT = (bf16_t*)(ws + WS_VT);
    const float* lng = A.in[I_GLNG] + (size_t)i2 * 256; const float* lnb = A.in[I_GLNB] + (size_t)i2 * 256;
    const float* gws = A.in[I_GWS] + (size_t)i2 * 4 * 128 * 128; const float* gbs = A.in[I_GBS] + (size_t)i2 * 4 * 128;
    LAS bf16_t* vt = (LAS bf16_t*)C.lds;
    LAS bf16_t* vT = (LAS bf16_t*)(C.lds + 128 * 272);
    const int r32 = C.lane & 31, hi = C.lane >> 5;
    const int axis = (C.lane & 31) >> 4, jj = C.lane & 15;
    const float inv = powf(10000.f, -(float)jj * (1.f / 16.f));
    for (int u = blockIdx.x; u < 264; u += C.G) {
        const bool isctx = u >= 256; const int uc = u - 256;
        const int b = isctx ? (uc >> 1) : (u >> 6), pos0 = isctx ? (uc & 1) * 128 : (u & 63) * 128;
        const int row0 = isctx ? NLAT + b * CTXL + pos0 : b * TT + pos0, L0 = isctx ? pos0 : CTXL + pos0;
        for (int r = C.wave; r < 128; r += NWAVES) {
            const int grow = row0 + r, t = pos0 + r; float cs = 1.f, sn = 0.f;
            if (!isctx) { const float ang = (float)(axis ? (t & 63) : (t >> 6)) * inv; cs = cosf(ang); sn = sinf(ang); }
            const bf16_t* pr = P + (size_t)grow * P_LD; bf16_t* qo = Q + (size_t)grow * 768; bf16_t* ko = KA + ((size_t)b * LKEYS + L0 + r) * 768;
#pragma unroll
            for (int i = 0; i < 6; ++i) { const int base = (2 * i + hi) * 64 + axis * 32 + jj;
                const float q1 = bf2f(pr[base]), q2 = bf2f(pr[base + 16]), k1 = bf2f(pr[768 + base]), k2 = bf2f(pr[768 + base + 16]);
                qo[base] = (bf16_t)f2bf((q1 * cs - q2 * sn) * QSCALE); qo[base + 16] = (bf16_t)f2bf((q1 * sn + q2 * cs) * QSCALE);
                ko[base] = (bf16_t)f2bf(k1 * cs - k2 * sn); ko[base + 16] = (bf16_t)f2bf(k1 * sn + k2 * cs); }
        }
        for (int hh = 0; hh < 6; ++hh) {
#pragma unroll
            for (int i = 0; i < 4; ++i) { const int piece = C.tid + NTHR * i, r = piece >> 4, part = piece & 15;
                *(LAS u32x4*)(vt + r * 136 + part * 8) = *(const u32x4*)(P + (size_t)(row0 + r) * P_LD + 1536 + hh * 128 + part * 8); }
            __syncthreads();
#pragma unroll
            for (int i = 0; i < 4; ++i) { const int item = C.tid + NTHR * i, d = item >> 4, tg = item & 15; const LAS bf16_t* s = vt + (tg * 8) * 136 + d;
                u32x4 o; o.x = (unsigned)s[0] | ((unsigned)s[136] << 16); o.y = (unsigned)s[2 * 136] | ((unsigned)s[3 * 136] << 16);
                o.z = (unsigned)s[4 * 136] | ((unsigned)s[5 * 136] << 16); o.w = (unsigned)s[6 * 136] | ((unsigned)s[7 * 136] << 16);
                *(u32x4*)(VT + ((size_t)(b * 6 + hh) * 128 + d) * LKEYS + L0 + tg * 8) = o; }
            __syncthreads();
        }
        for (int r = C.wave; r < 128; r += NWAVES) {
            const int c4 = 4 * C.lane; const f32x4 raw = ld4bf(P + (size_t)(row0 + r) * P_LD + 2560 + c4);
            const f32x4 gv = {gelu_erf(raw[0]), gelu_erf(raw[1]), gelu_erf(raw[2]), gelu_erf(raw[3])};
            const float mean = wave_sum((gv[0] + gv[1]) + (gv[2] + gv[3])) * (1.f / 256.f); const f32x4 dd = gv - mean;
            const float var = wave_sum((dd[0] * dd[0] + dd[1] * dd[1]) + (dd[2] * dd[2] + dd[3] * dd[3])) * (1.f / 256.f); const float rstd = rsqrtf(var + LN_EPS);
            const f32x4 o = dd * rstd * *(const f32x4*)(lng + c4) + *(const f32x4*)(lnb + c4);
#pragma unroll
            for (int k = 0; k < 4; ++k) vT[(c4 + k) * 136 + r] = (bf16_t)f2bf(o[k]);
        }
        __syncthreads();
        {
            const int g = C.wave >> 1, cblk = C.wave & 1, cc = g * 64 + cblk * 32 + r32;
            for (int pblk = 0; pblk < 4; ++pblk) {
                f32x16 acc;
#pragma unroll
                for (int i = 0; i < 16; ++i) acc[i] = 0.f;
                const float* wrow = gws + ((size_t)g * 128 + pblk * 32 + r32) * 128 + 8 * hi;
#pragma unroll
                for (int ks = 0; ks < 8; ++ks) { const f32x4 w0 = *(const f32x4*)(wrow + ks * 16), w1 = *(const f32x4*)(wrow + ks * 16 + 4);
                    u32x4 au; au.x = pk2(w0[0], w0[1]); au.y = pk2(w0[2], w0[3]); au.z = pk2(w1[0], w1[1]); au.w = pk2(w1[2], w1[3]);
                    const bf16x8 bf = *(const LAS bf16x8*)(vT + cc * 136 + ks * 16 + 8 * hi);
                    acc = __builtin_amdgcn_mfma_f32_32x32x16_bf16(__builtin_bit_cast(bf16x8, au), bf, acc, 0, 0, 0); }
#pragma unroll
                for (int reg = 0; reg < 16; ++reg) { const int p = pblk * 32 + crow(reg, hi); const size_t grow = (size_t)(row0 + p);
                    const float uu = gelu_erf(bf2f(P[grow * P_LD + 2304 + cc])); const float mixed = acc[reg] + gbs[g * 128 + p];
                    A2[grow * DM + 768 + cc] = (bf16_t)f2bf(uu * mixed); }
            }
        }
        __syncthreads();
    }
}

__device__ __forceinline__ void phase_attn(const Ctx& C, const Args& A, int l) {
    const int i2 = l >> 1; unsigned char* ws = A.ws;
    const bf16_t* Q = (const bf16_t*)(ws + WS_Q); const bf16_t* KA = (const bf16_t*)(ws + WS_KA); const bf16_t* VT = (const bf16_t*)(ws + WS_VT); bf16_t* A2 = (bf16_t*)(ws + WS_A2);
    const float lam_init = 0.8f - 0.6f * expf(-0.3f * (float)l);
    float s1 = 0.f, s2 = 0.f;
    for (int j = 0; j < 64; ++j) { s1 += A.in[I_LQ1][i2 * 64 + j] * A.in[I_LK1][i2 * 64 + j]; s2 += A.in[I_LQ2][i2 * 64 + j] * A.in[I_LK2][i2 * 64 + j]; }
    const float lam = expf(s1) - expf(s2) + lam_init;
    const float* subg = A.in[I_SUBG] + (size_t)i2 * 128;
    const int r32 = C.lane & 31, hi = C.lane >> 5, map = C.wave >> 2, qw = C.wave & 3;
    LAS unsigned char* Kt = C.lds; LAS unsigned char* Vt = C.lds + 2 * 17408; LAS float* xch = (LAS float*)C.lds;
    const int NU = 1536 + (l == 1 ? 48 : 0);
    for (int n = C.vcu; n < NU; n += C.G) {
        int bh, qt; bool isctx = false;
        if (n < 1536) { const int round = n >> 8, slot = n & 255; bh = (slot >> 5) * 3 + (round >> 1); qt = (round & 1) * 32 + (slot & 31); }
        else { isctx = true; bh = (n - 1536) >> 1; qt = (n - 1536) & 1; }
        const int b = bh / 6, h = bh % 6;
        const int qrow0 = isctx ? NLAT + b * CTXL + qt * 128 : b * TT + qt * 128;
        const int NT = isctx ? CTXL / 64 : LKEYS / 64;
        const bf16_t* Kb = KA + (size_t)b * LKEYS * 768 + h * 128;
        const bf16_t* Vb = VT + (size_t)(b * 6 + h) * 128 * LKEYS;
        bf16x8 qf[4];
        { const bf16_t* qp = Q + (size_t)(qrow0 + qw * 32 + r32) * 768 + h * 128 + map * 64 + 8 * hi;
#pragma unroll
          for (int ks = 0; ks < 4; ++ks) qf[ks] = *(const bf16x8*)(qp + ks * 16); }
        f32x16 O[4];
#pragma unroll
        for (int d = 0; d < 4; ++d)
#pragma unroll
            for (int i = 0; i < 16; ++i) O[d][i] = 0.f;
        float m = -1e30f, lsum = 0.f;
        u32x4 kreg[2], vreg[2];
#define AT_LOAD(t) do { _Pragma("unroll") for (int i = 0; i < 2; ++i) { const int piece = C.tid + NTHR * i; \
            kreg[i] = *(const u32x4*)(Kb + (size_t)((t) * 64 + (piece >> 4)) * 768 + (piece & 15) * 8); \
            vreg[i] = *(const u32x4*)(Vb + (size_t)(piece >> 3) * LKEYS + (t) * 64 + (piece & 7) * 8); } } while (0)
#define AT_STORE(bi) do { _Pragma("unroll") for (int i = 0; i < 2; ++i) { const int piece = C.tid + NTHR * i; \
            *(LAS u32x4*)(Kt + (bi) * 17408 + (piece >> 4) * 272 + (piece & 15) * 16) = kreg[i]; \
            LAS unsigned char* vd = Vt + (bi) * 17408 + (piece >> 3) * 136 + (piece & 7) * 16; \
            *(LAS u32x2*)vd = (u32x2){vreg[i].x, vreg[i].y}; *(LAS u32x2*)(vd + 8) = (u32x2){vreg[i].z, vreg[i].w}; } } while (0)
        AT_LOAD(0); AT_STORE(0); __syncthreads();
        for (int t = 0; t < NT; ++t) {
            if (t + 1 < NT) AT_LOAD(t + 1);
            const int bi = t & 1;
            const LAS unsigned char* kb = Kt + bi * 17408 + r32 * 272 + map * 128 + hi * 16;
            const LAS unsigned char* vb = Vt + bi * 17408 + r32 * 136 + hi * 8;
            bf16x8 kf[8];
#pragma unroll
            for (int ks = 0; ks < 4; ++ks) { kf[2 * ks] = *(const LAS bf16x8*)(kb + ks * 32); kf[2 * ks + 1] = *(const LAS bf16x8*)(kb + 32 * 272 + ks * 32); }
            u32x4 va[4], vc[4];
#define AT_LDV(dst, d) do { _Pragma("unroll") for (int kst = 0; kst < 4; ++kst) { const LAS unsigned char* vp = vb + (d) * (32 * 136) + kst * 32; \
                const u32x2 lo = *(const LAS u32x2*)vp, hh = *(const LAS u32x2*)(vp + 16); dst[kst] = (u32x4){lo.x, lo.y, hh.x, hh.y}; } } while (0)
#define AT_PV(src, d) do { _Pragma("unroll") for (int kst = 0; kst < 4; ++kst) O[d] = __builtin_amdgcn_mfma_f32_32x32x16_bf16(__builtin_bit_cast(bf16x8, src[kst]), pb[kst], O[d], 0, 0, 0); } while (0)
            AT_LDV(va, 0);
            __builtin_amdgcn_sched_barrier(0);
            f32x16 p0, p1;
#pragma unroll
            for (int i = 0; i < 16; ++i) { p0[i] = 0.f; p1[i] = 0.f; }
#pragma unroll
            for (int ks = 0; ks < 4; ++ks) { p0 = __builtin_amdgcn_mfma_f32_32x32x16_bf16(kf[2 * ks], qf[ks], p0, 0, 0, 0); p1 = __builtin_amdgcn_mfma_f32_32x32x16_bf16(kf[2 * ks + 1], qf[ks], p1, 0, 0, 0); }
            asm volatile("s_nop 15\n\ts_nop 7" : "+v"(p0), "+v"(p1));
            float mx = max3f(p0[0], p0[1], p1[0]), mx2 = max3f(p0[2], p0[3], p1[1]); mx = max3f(mx, p1[2], p1[3]);
#pragma unroll
            for (int i = 4; i < 16; i += 4) { mx = max3f(mx, p0[i], p0[i + 1]); mx2 = max3f(mx2, p0[i + 2], p0[i + 3]); mx = max3f(mx, p1[i], p1[i + 1]); mx2 = max3f(mx2, p1[i + 2], p1[i + 3]); }
            mx = max3f(mx, mx2, m);
            { auto rr = __builtin_amdgcn_permlane32_swap(__float_as_uint(mx), __float_as_uint(mx), false, false); mx = fmaxf(__uint_as_float(rr[0]), __uint_as_float(rr[1])); }
            const float mnew = mx;
            if (__any(mnew > m)) { const float sc = __builtin_amdgcn_exp2f(m - mnew); lsum *= sc;
#pragma unroll
                for (int d = 0; d < 4; ++d)
#pragma unroll
                    for (int i = 0; i < 16; ++i) O[d][i] *= sc;
                m = mnew; }
            float ps = 0.f, ps2 = 0.f;
#pragma unroll
            for (int i = 0; i < 16; ++i) { p0[i] = __builtin_amdgcn_exp2f(p0[i] - m); p1[i] = __builtin_amdgcn_exp2f(p1[i] - m); ps += p0[i]; ps2 += p1[i]; }
            lsum += ps + ps2;
            bf16x8 pb[4];
            { u32x4 w; w.x = pk2(p0[0], p0[1]); w.y = pk2(p0[2], p0[3]); w.z = pk2(p0[4], p0[5]); w.w = pk2(p0[6], p0[7]); pb[0] = __builtin_bit_cast(bf16x8, w);
              w.x = pk2(p0[8], p0[9]); w.y = pk2(p0[10], p0[11]); w.z = pk2(p0[12], p0[13]); w.w = pk2(p0[14], p0[15]); pb[1] = __builtin_bit_cast(bf16x8, w);
              w.x = pk2(p1[0], p1[1]); w.y = pk2(p1[2], p1[3]); w.z = pk2(p1[4], p1[5]); w.w = pk2(p1[6], p1[7]); pb[2] = __builtin_bit_cast(bf16x8, w);
              w.x = pk2(p1[8], p1[9]); w.y = pk2(p1[10], p1[11]); w.z = pk2(p1[12], p1[13]); w.w = pk2(p1[14], p1[15]); pb[3] = __builtin_bit_cast(bf16x8, w); }
            __builtin_amdgcn_sched_barrier(0);
            AT_LDV(vc, 1); __builtin_amdgcn_sched_barrier(0); AT_PV(va, 0); __builtin_amdgcn_sched_barrier(0);
            AT_LDV(va, 2); __builtin_amdgcn_sched_barrier(0); AT_PV(vc, 1); __builtin_amdgcn_sched_barrier(0);
            AT_LDV(vc, 3); __builtin_amdgcn_sched_barrier(0); AT_PV(va, 2); __builtin_amdgcn_sched_barrier(0);
            AT_PV(vc, 3);
            if (t + 1 < NT) AT_STORE((t + 1) & 1);
            __syncthreads();
        }
#undef AT_LDV
#undef AT_PV
#undef AT_LOAD
#undef AT_STORE
        const float ltot = lsum + __shfl_xor(lsum, 32);
        const float invl = 1.f / ltot;
        if (map == 1) { const float f = lam * invl;
#pragma unroll
            for (int d = 0; d < 4; ++d)
#pragma unroll
                for (int i = 0; i < 16; ++i) xch[(qw * 64 + d * 16 + i) * 64 + C.lane] = O[d][i] * f; }
        __syncthreads();
        if (map == 0) { float ss = 0.f;
#pragma unroll
            for (int d = 0; d < 4; ++d)
#pragma unroll
                for (int i = 0; i < 16; ++i) { const float o = O[d][i] * invl - xch[(qw * 64 + d * 16 + i) * 64 + C.lane]; O[d][i] = o; ss += o * o; }
            ss += __shfl_xor(ss, 32);
            const float rn = rsqrtf(ss * (1.f / 128.f) + RMS_EPS) * (1.f - lam_init);
            bf16_t* orow = A2 + (size_t)(qrow0 + qw * 32 + r32) * DM + h * 128;
#pragma unroll
            for (int d = 0; d < 4; ++d)
#pragma unroll
                for (int g4 = 0; g4 < 4; ++g4) { const int dd = 32 * d + 8 * g4 + 4 * hi; const f32x4 sg = *(const f32x4*)(subg + dd);
                    const f32x4 v = {O[d][4 * g4] * rn * sg[0], O[d][4 * g4 + 1] * rn * sg[1], O[d][4 * g4 + 2] * rn * sg[2], O[d][4 * g4 + 3] * rn * sg[3]};
                    st4bf(orow + dd, v); } }
        __syncthreads();
    }
}

__device__ __forceinline__ void phase_rt(const Ctx& C, const Args& A, int l) {
    unsigned char* ws = A.ws; float* X = (float*)(ws + WS_X); bf16_t* H = (bf16_t*)(ws + WS_H); float* AFF = (float*)(ws + WS_AFF);
    const float* MOD = (const float*)(ws + WS_MOD) + (size_t)l * 5 * 6144;
    const float* lng = A.in[I_LNG] + (size_t)(l * 2 + 0) * DM; const float* lnb = A.in[I_LNB] + (size_t)(l * 2 + 0) * DM;
    LAS float* wrs = (LAS float*)C.lds;
    { const float* wr = A.in[I_WR] + (size_t)l * DM * 16; for (int i = C.tid; i < DM * 16; i += NTHR) wrs[(i & 15) * 1024 + (i >> 4)] = wr[i]; }
    __syncthreads();
    for (int row = C.gw; row < MROWS; row += C.NGW) {
        const float* md = MOD + row_mi(row) * 6144;
        f32x4 x[4]; float s = 0.f;
#pragma unroll
        for (int j = 0; j < 4; ++j) { x[j] = *(const f32x4*)(X + (size_t)row * DM + 4 * C.lane + 256 * j); s += (x[j][0] + x[j][1]) + (x[j][2] + x[j][3]); }
        const float mean = wave_sum(s) * (1.f / DM); float s2 = 0.f;
#pragma unroll
        for (int j = 0; j < 4; ++j) { x[j] = x[j] - mean; s2 += (x[j][0] * x[j][0] + x[j][1] * x[j][1]) + (x[j][2] * x[j][2] + x[j][3] * x[j][3]); }
        const float rstd = rsqrtf(wave_sum(s2) * (1.f / DM) + LN_EPS);
        float v[16];
#pragma unroll
        for (int e = 0; e < 16; ++e) v[e] = 0.f;
#pragma unroll
        for (int j = 0; j < 4; ++j) { const int col = 4 * C.lane + 256 * j;
            const f32x4 x1 = x[j] * rstd * *(const f32x4*)(lng + col) + *(const f32x4*)(lnb + col);
            *(f32x4*)(X + (size_t)row * DM + col) = x1;
            const f32x4 h = x1 * (*(const f32x4*)(md + 4 * DM + col) + 1.f) + *(const f32x4*)(md + 3 * DM + col);
            st4bf(H + (size_t)row * DM + col, h);
#pragma unroll
            for (int e = 0; e < 16; ++e) { const f32x4 w = *(const LAS f32x4*)(wrs + e * 1024 + col); v[e] += (h[0] * w[0] + h[1] * w[1]) + (h[2] * w[2] + h[3] * w[3]); }
            __builtin_amdgcn_sched_barrier(0); }
#pragma unroll
        for (int i = 0; i < 8; ++i) { const float send = (C.lane & 32) ? v[i] : v[i + 8], keep = (C.lane & 32) ? v[i + 8] : v[i]; v[i] = keep + __shfl_xor(send, 32); }
#pragma unroll
        for (int i = 0; i < 4; ++i) { const float send = (C.lane & 16) ? v[i] : v[i + 4], keep = (C.lane & 16) ? v[i + 4] : v[i]; v[i] = keep + __shfl_xor(send, 16); }
#pragma unroll
        for (int i = 0; i < 2; ++i) { const float send = (C.lane & 8) ? v[i] : v[i + 2], keep = (C.lane & 8) ? v[i + 2] : v[i]; v[i] = keep + __shfl_xor(send, 8); }
        { const float send = (C.lane & 4) ? v[0] : v[1], keep = (C.lane & 4) ? v[1] : v[0]; v[0] = keep + __shfl_xor(send, 4); }
        float z = v[0]; z += __shfl_xor(z, 1); z += __shfl_xor(z, 2);
        float mx = z;
#pragma unroll
        for (int o = 4; o < 64; o <<= 1) mx = fmaxf(mx, __shfl_xor(mx, o));
        const float ex = expf(z - mx); float sm = ex;
#pragma unroll
        for (int o = 4; o < 64; o <<= 1) sm += __shfl_xor(sm, o);
        if ((C.lane & 3) == 0) AFF[(size_t)row * 16 + (C.lane >> 2)] = ex / sm;
    }
}

__device__ __forceinline__ void phase_tk(const Ctx& C, const Args& A) {
    unsigned char* ws = A.ws; const float* AFF = (const float*)(ws + WS_AFF); int* SLOT = (int*)(ws + WS_SLOT); int* IDX = (int*)(ws + WS_IDX); float* GATE = (float*)(ws + WS_GATE);
    LAS unsigned* key = (LAS unsigned*)C.lds;
    LAS unsigned* hist = key + 8192;
    LAS unsigned* scn = hist + 256;
    LAS unsigned* wtot = scn + 256;
    LAS unsigned* bc = wtot + 8;
    for (int u = blockIdx.x; u < 128; u += C.G) {
        const bool isctx = u >= 64; const int uu = u & 63, b = uu >> 4, e = uu & 15;
        const int n = isctx ? CTXL : TT, cap = isctx ? CAP_C : CAP_L;
        const int row0 = isctx ? NLAT + b * CTXL : b * TT;
        const int slot0 = e * ESLOTS + (isctx ? 4 * CAP_L + b * CAP_C : b * CAP_L);
        for (int i = C.tid; i < n; i += NTHR) key[i] = __float_as_uint(AFF[(size_t)(row0 + i) * 16 + e]);
        unsigned prefix = 0u, pmask = 0u; int need = cap;
        for (int pass = 0; pass < 4; ++pass) {
            const int shift = 24 - 8 * pass;
            if (C.tid < 256) hist[C.tid] = 0u;
            __syncthreads();
            for (int i = C.tid; i < n; i += NTHR) { const unsigned k = key[i]; if ((k & pmask) == prefix) __hip_atomic_fetch_add(&hist[(k >> shift) & 255u], 1u, __ATOMIC_RELAXED, __HIP_MEMORY_SCOPE_WORKGROUP); }
            __syncthreads();
            if (C.tid < 256) scn[C.tid] = hist[C.tid];
            __syncthreads();
            for (int off = 1; off < 256; off <<= 1) {
                unsigned a = 0u; if (C.tid < 256 && C.tid + off < 256) a = scn[C.tid + off];
                __syncthreads();
                if (C.tid < 256) scn[C.tid] += a;
                __syncthreads();
            }
            if (C.tid < 256) { const unsigned above = (C.tid < 255) ? scn[C.tid + 1] : 0u;
                if (scn[C.tid] >= (unsigned)need && above < (unsigned)need) { bc[0] = (unsigned)C.tid; bc[1] = (unsigned)need - above; } }
            __syncthreads();
            prefix |= bc[0] << shift; pmask |= 255u << shift; need = (int)bc[1];
            __syncthreads();
        }
        const int per = (n + NTHR - 1) / NTHR; const int i0 = C.tid * per;
        unsigned cg = 0u, ce = 0u;
        for (int j = 0; j < per; ++j) { const int i = i0 + j; if (i < n) { const unsigned k = key[i]; cg += (k > prefix); ce += (k == prefix); } }
        unsigned pk = cg | (ce << 16), inc = pk;
#pragma unroll
        for (int o = 1; o < 64; o <<= 1) { const unsigned t = __shfl_up(inc, o); if (C.lane >= o) inc += t; }
        if (C.lane == 63) wtot[C.wave] = inc;
        __syncthreads();
        unsigned wbase = 0u;
        for (int w = 0; w < C.wave; ++w) wbase += wtot[w];
        const unsigned excl = wbase + inc - pk;
        unsigned rg = excl & 0xffffu, re = excl >> 16;
        const int ngt = cap - need;
        for (int j = 0; j < per; ++j) { const int i = i0 + j; if (i < n) { const unsigned k = key[i]; int pos = -1;
            if (k > prefix) { pos = (int)rg; ++rg; } else if (k == prefix) { if ((int)re < need) pos = ngt + (int)re; ++re; }
            const int row = row0 + i;
            if (pos >= 0) { IDX[slot0 + pos] = row; GATE[slot0 + pos] = __uint_as_float(k); SLOT[(size_t)row * 16 + e] = slot0 + pos; }
            else SLOT[(size_t)row * 16 + e] = -1; } }
        if (isctx && b == 0 && C.tid < ESLOTS - 4224) { IDX[e * ESLOTS + 4224 + C.tid] = 0; GATE[e * ESLOTS + 4224 + C.tid] = 0.f; }
        __syncthreads();
    }
}

__device__ __forceinline__ void phase_cb(const Ctx& C, const Args& A, int l) {
    unsigned char* ws = A.ws; float* X = (float*)(ws + WS_X); bf16_t* H = (bf16_t*)(ws + WS_H); const int* SLOT = (const int*)(ws + WS_SLOT); const bf16_t* YE = (const bf16_t*)(ws + WS_YE);
    const float* MOD = (const float*)(ws + WS_MOD) + (size_t)l * 5 * 6144; const float* MODN = MOD + 5 * 6144;
    const float* lng = A.in[I_LNG] + (size_t)(l * 2 + 1) * DM; const float* lnb = A.in[I_LNB] + (size_t)(l * 2 + 1) * DM;
    for (int row = C.gw; row < MROWS; row += C.NGW) {
        const int mi = row_mi(row); const float* md = MOD + mi * 6144;
        f32x4 acc[4];
#pragma unroll
        for (int j = 0; j < 4; ++j) acc[j] = (f32x4){0.f, 0.f, 0.f, 0.f};
        for (int e = 0; e < 16; ++e) { const int s = __builtin_amdgcn_readfirstlane(SLOT[(size_t)row * 16 + e]);
            if (s >= 0) {
#pragma unroll
                for (int j = 0; j < 4; ++j) acc[j] += ld4bf(YE + (size_t)s * DM + 4 * C.lane + 256 * j); } }
        f32x4 x[4]; float sm = 0.f;
#pragma unroll
        for (int j = 0; j < 4; ++j) { const int col = 4 * C.lane + 256 * j; x[j] = *(const f32x4*)(X + (size_t)row * DM + col) * ALPHA_DN + *(const f32x4*)(md + 5 * DM + col) * acc[j];
            sm += (x[j][0] + x[j][1]) + (x[j][2] + x[j][3]); }
        const float mean = wave_sum(sm) * (1.f / DM); float s2 = 0.f;
#pragma unroll
        for (int j = 0; j < 4; ++j) { x[j] = x[j] - mean; s2 += (x[j][0] * x[j][0] + x[j][1] * x[j][1]) + (x[j][2] * x[j][2] + x[j][3] * x[j][3]); }
        const float rstd = rsqrtf(wave_sum(s2) * (1.f / DM) + LN_EPS);
#pragma unroll
        for (int j = 0; j < 4; ++j) { const int col = 4 * C.lane + 256 * j;
            const f32x4 x2 = x[j] * rstd * *(const f32x4*)(lng + col) + *(const f32x4*)(lnb + col);
            *(f32x4*)(X + (size_t)row * DM + col) = x2;
            if (l < DEPTH - 1) { const float* mn = MODN + mi * 6144; st4bf(H + (size_t)row * DM + col, x2 * (*(const f32x4*)(mn + DM + col) + 1.f) + *(const f32x4*)(mn + col)); }
            else if (row < NLAT) *(f32x4*)(A.out + (size_t)row * DM + col) = x2; }
    }
}


#ifndef GEMM_NOINLINE
#define GEMM_NOINLINE 0
#endif
#if GEMM_NOINLINE
#define GEMM_FN __device__ __noinline__
#else
#define GEMM_FN __device__ __forceinline__
#endif
GEMM_FN void gphase_in(LAS unsigned char* lds, unsigned char* ws, int nN, int G) {
    pg8::Gemm g{(const bf16_t*)(ws + WS_H), (const bf16_t*)(ws + WS_WIN), DM}; pg8::Order<0> S; S.init(MROWS / 256, nN, G, (int)blockIdx.x, nullptr, 0);
    pg8::EpiBf16 E{(bf16_t*)(ws + WS_P), P_LD}; pg8::gemm_phase(lds, g, S, E); }
GEMM_FN void gphase_lora(LAS unsigned char* lds, unsigned char* ws, const float* d0, const float* a0, const float* kal, int G) {
    pg8::Gemm g{(const bf16_t*)(ws + WS_LIN), (const bf16_t*)(ws + WS_WLORA), LORA_K}; pg8::Order<0> S; S.init(MROWS / 256, LORA_N / 256, G, (int)blockIdx.x, nullptr, 0);
    pg8::EpiLora E{(float*)(ws + WS_SCN), (bf16_t*)(ws + WS_G), d0, a0, kal}; pg8::gemm_phase(lds, g, S, E); }
GEMM_FN void gphase_out(LAS unsigned char* lds, unsigned char* ws, const float* modl, int G) {
    pg8::Gemm g{(const bf16_t*)(ws + WS_A2), (const bf16_t*)(ws + WS_WOUT), DM}; pg8::Order<0> S; S.init(MROWS / 256, DM / 256, G, (int)blockIdx.x, nullptr, 0);
    pg8::EpiRes E{(float*)(ws + WS_X), modl}; pg8::gemm_phase(lds, g, S, E); }
GEMM_FN void gphase_e1(LAS unsigned char* lds, unsigned char* ws, int G) {
    pg8::Gemm g{(const bf16_t*)(ws + WS_H), (const bf16_t*)(ws + WS_WE13), DM}; pg8::Order<1> S; S.init(NEXP * 17, 4096 / 256, G, (int)blockIdx.x, (const int*)(ws + WS_IDX), (long)4096 * DM);
    pg8::EpiSwiGLU E{(bf16_t*)(ws + WS_HID)}; pg8::gemm_phase(lds, g, S, E); }
GEMM_FN void gphase_e2(LAS unsigned char* lds, unsigned char* ws, int G) {
    pg8::Gemm g{(const bf16_t*)(ws + WS_HID), (const bf16_t*)(ws + WS_WE2), D_EXP}; pg8::Order<2> S; S.init(NEXP * 17, DM / 256, G, (int)blockIdx.x, nullptr, (long)DM * D_EXP);
    pg8::EpiYE E{(bf16_t*)(ws + WS_YE), (const float*)(ws + WS_GATE)}; pg8::gemm_phase(lds, g, S, E); }

constexpr int NSTEP = 1 + DEPTH * 12;
__global__ void __launch_bounds__(NTHR, 2) mk_fwd(Args KA) {
    extern __shared__ __attribute__((aligned(16))) unsigned char lds_raw[];
    volatile LAS unsigned* MISC = (volatile LAS unsigned*)((LAS unsigned char*)lds_raw + LDS_MISC);
    if (threadIdx.x < 16) MISC[threadIdx.x] = 0u;
    if (threadIdx.x == 0) { LAS unsigned long long* tb = (LAS unsigned long long*)((LAS unsigned char*)lds_raw + LDS_PTAB);
#pragma unroll
        for (int i = 0; i < 37; ++i) tb[i] = (unsigned long long)KA.in[i];
        tb[37] = (unsigned long long)KA.out; tb[38] = (unsigned long long)KA.ws; }
    __syncthreads();
    const int lo = KA.lo, hi = KA.hi;
    unsigned bar_x = 0;
    if (hi - lo > 1) { const XcdBarrier b0 = xcd_barrier_post((unsigned*)(KA.ws + WS_CTL), MISC); bar_x = b0.x; }
#ifndef PH_MASK
#define PH_MASK 0xFFFFFF
#endif
#ifndef REP_MASK
#define REP_MASK 0
#endif
#define PH_BIT(k) (((k) == 0) ? 0 : 1 + ((k) - 1) % 12 + (((k) - 1) % 12 >= 2 && ((k) - 1) % 12 <= 5 && odd ? 12 : 0))
#define RUN(k, ...) do { if (((PH_MASK >> PH_BIT(k)) & 1) && lo <= (k) && (k) < hi) { const int nrep = ((REP_MASK >> PH_BIT(k)) & 1) ? 2 : 1; \
        _Pragma("unroll 1") for (int rep = 0; rep < nrep; ++rep) { \
        Ctx C; mkctx(C, (LAS unsigned char*)lds_raw); Args A; ldargs(A, (LAS unsigned char*)lds_raw); unsigned char* ws = A.ws; \
        const float* MODL = (const float*)(ws + WS_MOD) + (size_t)l * 5 * 6144; (void)MODL; \
        __VA_ARGS__; if ((k) + 1 < hi || rep + 1 < nrep) { XcdBarrier bar; bar.bar = (unsigned*)(ws + WS_CTL); bar.x = bar_x; bar.st = MISC; xcd_barrier(bar); } } } } while (0)
    { const bool odd = false; const int l = 0; RUN(0, phase_init(C, A)); }
#pragma unroll 1
    for (int l = 0; l < DEPTH; ++l) {
        const int sb = 1 + l * 12; const bool odd = l & 1;
        RUN(sb + 0, { phase_conv(C, A, l); if (l == 0) phase_modh(C, A, 0); });
        RUN(sb + 1, gphase_in(C.lds, ws, odd ? D_IN_ODD / 256 : D_IN_EVEN_PAD / 256, C.G));
        if (!odd) {
            RUN(sb + 2, phase_ef1(C, A, l));
            RUN(sb + 3, { const int i2 = l >> 1; gphase_lora(C.lds, ws, A.in[I_D0] + (size_t)i2 * 2 * 768, A.in[I_A0] + (size_t)i2 * 2 * 768, A.in[I_KAL] + (size_t)i2 * 768, C.G); });
            RUN(sb + 4, phase_scan(C, A));
            RUN(sb + 5, phase_ef2(C, A, l));
        } else {
            RUN(sb + 2, phase_of1(C, A, l));
            RUN(sb + 3, phase_attn(C, A, l));
        }
        RUN(sb + 6, gphase_out(C.lds, ws, MODL, C.G));
        RUN(sb + 7, phase_rt(C, A, l));
        RUN(sb + 8, phase_tk(C, A));
        RUN(sb + 9, gphase_e1(C.lds, ws, C.G));
        RUN(sb + 10, gphase_e2(C.lds, ws, C.G));
        RUN(sb + 11, phase_cb(C, A, l));
    }
#undef RUN
}

#ifdef PHASE_PROBE
#define PROBE_PRE extern __shared__ __attribute__((aligned(16))) unsigned char lds_raw[]; Ctx C; mkctx(C, (LAS unsigned char*)lds_raw); unsigned char* ws = A.ws; (void)ws;
__global__ void __launch_bounds__(NTHR, 2) pr_init(Args A) { PROBE_PRE phase_init(C, A); }
__global__ void __launch_bounds__(NTHR, 2) pr_conv(Args A) { PROBE_PRE phase_conv(C, A, A.lo); }
__global__ void __launch_bounds__(NTHR, 2) pr_modh(Args A) { PROBE_PRE phase_modh(C, A, A.lo); }
__global__ void __launch_bounds__(NTHR, 2) pr_ef1(Args A) { PROBE_PRE phase_ef1(C, A, A.lo); }
__global__ void __launch_bounds__(NTHR, 2) pr_scan(Args A) { PROBE_PRE phase_scan(C, A); }
__global__ void __launch_bounds__(NTHR, 2) pr_ef2(Args A) { PROBE_PRE phase_ef2(C, A, A.lo); }
__global__ void __launch_bounds__(NTHR, 2) pr_of1(Args A) { PROBE_PRE phase_of1(C, A, A.lo); }
__global__ void __launch_bounds__(NTHR, 2) pr_attn(Args A) { PROBE_PRE phase_attn(C, A, A.lo); }
__global__ void __launch_bounds__(NTHR, 2) pr_rt(Args A) { PROBE_PRE phase_rt(C, A, A.lo); }
__global__ void __launch_bounds__(NTHR, 2) pr_tk(Args A) { PROBE_PRE phase_tk(C, A); }
__global__ void __launch_bounds__(NTHR, 2) pr_cb(Args A) { PROBE_PRE phase_cb(C, A, A.lo); }
__global__ void __launch_bounds__(NTHR, 2) pr_gemm_in(Args A) { PROBE_PRE pg8::Gemm g{(const bf16_t*)(ws + WS_H), (const bf16_t*)(ws + WS_WIN), DM}; pg8::Order<0> S; S.init(MROWS / 256, A.lo, C.G, (int)blockIdx.x, nullptr, 0);
                      pg8::EpiBf16 E{(bf16_t*)(ws + WS_P), P_LD}; pg8::gemm_phase(C.lds, g, S, E); }
__global__ void __launch_bounds__(NTHR, 2) pr_gemm_lora(Args A) { PROBE_PRE pg8::Gemm g{(const bf16_t*)(ws + WS_LIN), (const bf16_t*)(ws + WS_WLORA), LORA_K}; pg8::Order<0> S; S.init(MROWS / 256, LORA_N / 256, C.G, (int)blockIdx.x, nullptr, 0);
                          const int i2 = A.lo; pg8::EpiLora E{(float*)(ws + WS_SCN), (bf16_t*)(ws + WS_G), A.in[I_D0] + (size_t)i2 * 2 * 768, A.in[I_A0] + (size_t)i2 * 2 * 768, A.in[I_KAL] + (size_t)i2 * 768};
                          pg8::gemm_phase(C.lds, g, S, E); }
__global__ void __launch_bounds__(NTHR, 2) pr_gemm_out(Args A) { PROBE_PRE pg8::Gemm g{(const bf16_t*)(ws + WS_A2), (const bf16_t*)(ws + WS_WOUT), DM}; pg8::Order<0> S; S.init(MROWS / 256, DM / 256, C.G, (int)blockIdx.x, nullptr, 0);
                      pg8::EpiRes E{(float*)(ws + WS_X), (const float*)(ws + WS_MOD)}; pg8::gemm_phase(C.lds, g, S, E); }
__global__ void __launch_bounds__(NTHR, 2) pr_gemm_e1(Args A) { PROBE_PRE pg8::Gemm g{(const bf16_t*)(ws + WS_H), (const bf16_t*)(ws + WS_WE13), DM}; pg8::Order<1> S; S.init(NEXP * 17, 4096 / 256, C.G, (int)blockIdx.x, (const int*)(ws + WS_IDX), (long)4096 * DM);
                      pg8::EpiSwiGLU E{(bf16_t*)(ws + WS_HID)}; pg8::gemm_phase(C.lds, g, S, E); }
__global__ void __launch_bounds__(NTHR, 2) pr_gemm_e2(Args A) { PROBE_PRE pg8::Gemm g{(const bf16_t*)(ws + WS_HID), (const bf16_t*)(ws + WS_WE2), D_EXP}; pg8::Order<2> S; S.init(NEXP * 17, DM / 256, C.G, (int)blockIdx.x, nullptr, (long)DM * D_EXP);
                       pg8::EpiYE E{(bf16_t*)(ws + WS_YE), (const float*)(ws + WS_GATE)}; pg8::gemm_phase(C.lds, g, S, E); }
#endif

extern "C" void kernel_launch(void* const* d_in, const int* in_sizes, int n_in, void* d_out, int out_size, void* d_ws, size_t ws_size, hipStream_t stream) {
    static int grid = 0;
    if (grid == 0) {
        if (n_in != 37 || out_size != NLAT * DM || ws_size < WS_END) { fprintf(stderr, "kernel_launch: unexpected shapes: n_in %d out %d ws %zu (need %zu)\n", n_in, out_size, ws_size, (size_t)WS_END); grid = -1; return; }
        int dev = 0, cus = 0, per_cu = 0;
        if (hipGetDevice(&dev) != hipSuccess || hipDeviceGetAttribute(&cus, hipDeviceAttributeMultiprocessorCount, dev) != hipSuccess) { grid = -1; return; }
        if (hipFuncSetAttribute((const void*)mk_fwd, hipFuncAttributeMaxDynamicSharedMemorySize, LDS_BYTES) != hipSuccess) { fprintf(stderr, "kernel_launch: hipFuncSetAttribute failed\n"); grid = -1; return; }
        if (hipOccupancyMaxActiveBlocksPerMultiprocessor(&per_cu, (const void*)mk_fwd, NTHR, LDS_BYTES) != hipSuccess || per_cu < 1) fprintf(stderr, "kernel_launch: occupancy query reports %d\n", per_cu);
        (void)hipGetLastError();
        grid = cus;
    }
    if (grid < 0) return;
    (void)hipMemsetAsync((char*)d_ws + WS_CTL, 0, CTL_BYTES, stream);
    Args a{};
    for (int i = 0; i < 37; ++i) a.in[i] = (const float*)d_in[i];
    a.out = (float*)d_out; a.ws = (unsigned char*)d_ws;
#if MK_MULTI
    for (int k = 0; k < NSTEP; ++k) {
        if (k >= 1) { const int l = (k - 1) / 12, s = (k - 1) % 12; if ((l & 1) && (s == 4 || s == 5)) continue; }
        a.lo = k; a.hi = k + 1;
        hipLaunchKernelGGL(mk_fwd, dim3(grid), dim3(NTHR), LDS_BYTES, stream, a);
    }
#else
    a.lo = 0; a.hi = NSTEP;
    hipLaunchKernelGGL(mk_fwd, dim3(grid), dim3(NTHR), LDS_BYTES, stream, a);
#endif
    const hipError_t le = hipPeekAtLastError();
    if (le != hipSuccess) fprintf(stderr, "kernel_launch: launch failed: %s\n", hipGetErrorName(le));
}
```

```cpp
#include <hip/hip_runtime.h>
#include <cstdio>
#include <cstdint>
#include <cmath>

#ifndef MK_MULTI
#define MK_MULTI 0
#endif

#define GAS __attribute__((address_space(1)))
#define LAS __attribute__((address_space(3)))
typedef unsigned short bf16_t;
typedef short bf16x8 __attribute__((ext_vector_type(8)));
typedef float f32x4 __attribute__((ext_vector_type(4)));
typedef float f32x2 __attribute__((ext_vector_type(2)));
typedef float f32x16 __attribute__((ext_vector_type(16)));
typedef unsigned u32x4 __attribute__((ext_vector_type(4)));
typedef unsigned u32x2 __attribute__((ext_vector_type(2)));
typedef __bf16 bf16x2_t __attribute__((ext_vector_type(2)));

constexpr int NB = 4, TT = 8192, DM = 1024, NLAT = NB * TT, CTXL = 256, NCTX = NB * CTXL, MROWS = NLAT + NCTX;
constexpr int DEPTH = 4;
constexpr int D_CONV = 256, RW_H = 12, RW_K = 64, D_RWKV = 768, RWKV_COLS = 2688, D_IN_EVEN = 3456, D_IN_EVEN_PAD = 3584;
constexpr int D_DIFF = 768, D_GMLP = 256, D_IN_ODD = 2816;
constexpr int NEXP = 16, D_EXP = 2048, CAP_L = 1024, CAP_C = 32, ESLOTS = 4352;
constexpr int P_LD = 3584;
constexpr int LORA_K = 384, LORA_N = 3840;
constexpr int LKEYS = CTXL + TT;
constexpr float ALPHA_DN = 1.6817928305074290f;
constexpr float DECAY_SCALE = 0.6065306597126334f;
constexpr float GN_EPS = 64e-5f, LN_EPS = 1e-5f, RMS_EPS = 1e-5f;
constexpr float QSCALE = 0.125f * 1.4426950408889634f;

constexpr size_t al256(size_t x) { return (x + 255) & ~(size_t)255; }
constexpr size_t WS_CTL = 0;
constexpr size_t CTL_BYTES = 65536;
constexpr size_t WS_MOD = WS_CTL + CTL_BYTES;
constexpr size_t WS_ROPE = WS_MOD + al256((size_t)DEPTH * 5 * 6144 * 4);
constexpr size_t WS_WIN = WS_ROPE + 32768;
constexpr size_t WS_WOUT = WS_WIN + (size_t)D_IN_EVEN_PAD * DM * 2;
constexpr size_t WS_WLORA = WS_WOUT + (size_t)DM * DM * 2;
constexpr size_t WS_WE13 = WS_WLORA + (size_t)LORA_N * LORA_K * 2;
constexpr size_t WS_WE2 = WS_WE13 + (size_t)NEXP * 4096 * DM * 2;
constexpr size_t WS_X = WS_WE2 + (size_t)NEXP * DM * D_EXP * 2;
constexpr size_t WS_H = WS_X + (size_t)MROWS * DM * 4;
constexpr size_t WS_A2 = WS_H + (size_t)MROWS * DM * 2;
constexpr size_t WS_P = WS_A2 + (size_t)MROWS * DM * 2;
constexpr size_t WS_AFF = WS_P + (size_t)MROWS * P_LD * 2;
constexpr size_t WS_SLOT = WS_AFF + (size_t)MROWS * 16 * 4;
constexpr size_t WS_IDX = WS_SLOT + (size_t)MROWS * 16 * 4;
constexpr size_t WS_GATE = WS_IDX + al256((size_t)NEXP * ESLOTS * 4);
constexpr size_t WS_R2 = WS_GATE + al256((size_t)NEXP * ESLOTS * 4);
constexpr size_t WS_SCN = WS_R2;
constexpr size_t WS_G = WS_SCN + (size_t)MROWS * 12 * 9 * 64 * 4;
constexpr size_t WS_LIN = WS_G + (size_t)MROWS * 768 * 2;
constexpr size_t WS_EVEN_END = WS_LIN + (size_t)MROWS * 384 * 2;
constexpr size_t WS_Y = WS_P;
constexpr size_t WS_Q = WS_R2;
constexpr size_t WS_KA = WS_Q + (size_t)MROWS * 768 * 2;
constexpr size_t WS_VT = WS_KA + (size_t)NB * LKEYS * 768 * 2;
constexpr size_t WS_HID = WS_R2;
constexpr size_t WS_YE = WS_HID + (size_t)NEXP * ESLOTS * D_EXP * 2;
constexpr size_t WS_END = WS_EVEN_END;
static_assert(WS_END <= (size_t)2147483648ull, "workspace over 2 GiB");
static_assert((size_t)2 * MROWS * 768 * 4 <= (size_t)MROWS * P_LD * 2, "Y aliases P");
static_assert(WS_YE + (size_t)NEXP * ESLOTS * DM * 2 <= WS_END, "moe region");

constexpr int LDS_BYTES = 147456;
constexpr int LDS_MISC = 140 * 1024;
constexpr int LDS_PTAB = LDS_MISC + 256;
constexpr int NWAVES = 8, NTHR = 512;

__device__ __forceinline__ unsigned f2bf(float f) { unsigned u = __float_as_uint(f); return (u + 0x7fffu + ((u >> 16) & 1u)) >> 16; }
__device__ __forceinline__ unsigned pk2(float lo, float hi) { f32x2 v = {lo, hi}; bf16x2_t b = __builtin_convertvector(v, bf16x2_t); return __builtin_bit_cast(unsigned, b); }
__device__ __forceinline__ float bflo(unsigned u) { return __uint_as_float(u << 16); }
__device__ __forceinline__ float bfhi(unsigned u) { return __uint_as_float(u & 0xffff0000u); }
__device__ __forceinline__ float bf2f(bf16_t b) { return __uint_as_float((unsigned)b << 16); }
__device__ __forceinline__ float sigmoidf_(float x) { return 1.f / (1.f + __expf(-x)); }
__device__ __forceinline__ float wave_sum(float v) {
#pragma unroll
    for (int o = 1; o < 64; o <<= 1) v += __shfl_xor(v, o);
    return v;
}
__device__ __forceinline__ float sum16(float v) {
#pragma unroll
    for (int o = 1; o < 16; o <<= 1) v += __shfl_xor(v, o);
    return v;
}
__device__ __forceinline__ float gelu_erf(float x) { return 0.5f * x * (1.f + erff(x * 0.70710678118654752f)); }

#define XB_TMO      128
#define XB_XCNT(j)  (256  + 64 * (j))
#define XB_XSUB(j)  (1280 + 64 * (j))
#define XB_XGEN(j)  (2304 + 64 * (j))
#define XB_TOP      3328
#define XB_TOPGEN   3392
#define XCD_BAR_WORDS 3456
#define XB_SPIN_CAP (1u << 20)

__device__ __forceinline__ unsigned xb_ld(unsigned* p)              { return __hip_atomic_load(p, __ATOMIC_RELAXED, __HIP_MEMORY_SCOPE_AGENT); }
__device__ __forceinline__ unsigned xb_add(unsigned* p, unsigned v) { return __hip_atomic_fetch_add(p, v, __ATOMIC_RELAXED, __HIP_MEMORY_SCOPE_AGENT); }
__device__ __forceinline__ unsigned xb_xcc_id() { return (unsigned)__builtin_amdgcn_s_getreg((3 << 11) | 20) & 0xFu; }
#define XB_SPIN(cond, bar) do { unsigned _sp = 0; while (cond) { __builtin_amdgcn_s_sleep(1); \
    if ((++_sp & 255u) == 0u) { if (xb_ld(&(bar)[XB_TMO])) break; if (_sp > XB_SPIN_CAP) { atomicAdd(&(bar)[XB_TMO], 1u); break; } } } } while (0)

struct XcdBarrier { unsigned* bar; unsigned x; volatile LAS unsigned* st; };

__device__ __forceinline__ XcdBarrier xcd_barrier_post(unsigned* bar, volatile LAS unsigned* st) {
    XcdBarrier b; b.bar = bar; b.x = xb_xcc_id(); b.st = st;
    if (threadIdx.x == 0) (void)xb_add(&bar[XB_XCNT(b.x)], 1u);
    return b;
}
__device__ __forceinline__ void xcd_barrier_complete(unsigned* bar, unsigned x, unsigned& nloc, unsigned& nx) {
    const unsigned G = gridDim.x * gridDim.y * gridDim.z;
    unsigned sum, cnt, mine, sp = 0u;
    for (;;) {
        sum = 0u; cnt = 0u; mine = 0u;
#pragma unroll
        for (unsigned j = 0; j < 16; ++j) { const unsigned c = xb_ld(&bar[XB_XCNT(j)]); sum += c; cnt += (c > 0u) ? 1u : 0u; mine = (j == x) ? c : mine; }
        if (sum == G) break;
        __builtin_amdgcn_s_sleep(1);
        if ((++sp & 255u) == 0u) { if (xb_ld(&bar[XB_TMO])) break; if (sp > XB_SPIN_CAP) { atomicAdd(&bar[XB_TMO], 1u); break; } }
    }
    nloc = mine > 0u ? mine : 1u; nx = cnt > 0u ? cnt : 1u;
}
__device__ __forceinline__ void xcd_barrier(const XcdBarrier& b) {
    asm volatile("s_waitcnt vmcnt(0)" ::: "memory");
    __syncthreads();
    if (threadIdx.x == 0) {
        unsigned* bar = b.bar;
        __builtin_amdgcn_s_waitcnt(0);
        unsigned nloc = b.st[0], nx = b.st[1];
        if (nloc == 0u) { xcd_barrier_complete(bar, b.x, nloc, nx); b.st[0] = nloc; b.st[1] = nx; }
        const unsigned old = xb_add(&bar[XB_XSUB(b.x)], 1u);
        const unsigned gen = old / nloc;
        if (old + 1u == (gen + 1u) * nloc) {
            __builtin_amdgcn_fence(__ATOMIC_RELEASE, "agent");
            asm volatile("s_waitcnt vmcnt(0)" ::: "memory");
            const unsigned og = xb_add(&bar[XB_TOP], 1u);
            const unsigned tg = og / nx;
            if (og + 1u == (tg + 1u) * nx) xb_add(&bar[XB_TOPGEN], 1u);
            else XB_SPIN(xb_ld(&bar[XB_TOPGEN]) == tg, bar);
            __builtin_amdgcn_fence(__ATOMIC_ACQUIRE, "agent");
            xb_add(&bar[XB_XGEN(b.x)], 1u);
            asm volatile("s_waitcnt vmcnt(0)" ::: "memory");
        } else {
            XB_SPIN(xb_ld(&bar[XB_XGEN(b.x)]) == gen, bar);
            __builtin_amdgcn_fence(__ATOMIC_ACQUIRE, "agent");
            asm volatile("s_waitcnt vmcnt(0)" ::: "memory");
        }
    }
    __syncthreads();
}

namespace pg8 {
constexpr int BM = 256, BK = 64, HALF = 128, HTB = HALF * BK * 2, STAGE_BYTES = 8 * HTB, NXCD = 8, WGM = 8;
__host__ __device__ __forceinline__ int lds_byte(int r, int c) { const int st = (r >> 4) * 2 + (c >> 5), rr = r & 15, cc = c & 31, ob = rr * 64 + cc * 2; return st * 1024 + (ob ^ (((ob >> 9) & 1) << 5)); }
__host__ __device__ __forceinline__ void stage_rc(int b, int& R, int& C) { const int st = b / 1024, sb = b % 1024, swz = sb ^ (((sb >> 9) & 1) << 5); R = (st >> 1) * 16 + swz / 64; C = (st & 1) * 32 + (swz % 64) / 2; }

struct Unit { int pm, pn; };
struct Gemm { const bf16_t* A; const bf16_t* Bt; int K; };

template <int MODE> struct Order {
    int nM, nN, nwg, G, c; const int* idx; long bstride;
    __device__ __forceinline__ void init(int nM_, int nN_, int G_, int c_, const int* idx_, long bstride_) { nM = nM_; nN = nN_; nwg = nM * nN; G = G_; c = c_; idx = idx_; bstride = bstride_; }
    __device__ __forceinline__ bool next(int i, Unit& u) const {
        const long L = (long)i * G + c; if (L >= nwg) return false;
        int wgid = (int)L; { const int q = nwg / NXCD, r = nwg % NXCD, xcd = wgid % NXCD, off = wgid / NXCD; wgid = (xcd < r ? xcd * (q + 1) : r * (q + 1) + (xcd - r) * q) + off; }
        const int nig = WGM * nN, gid = wgid / nig, fm = gid * WGM, gsz = (nM - fm) < WGM ? (nM - fm) : WGM;
        u.pm = fm + ((wgid % nig) % gsz); u.pn = (wgid % nig) / gsz; return true;
    }
    __device__ __forceinline__ unsigned arow(const Unit& u, int r) const { if (MODE == 1) return (unsigned)idx[u.pm * BM + r]; return (unsigned)(u.pm * BM + r); }
    __device__ __forceinline__ long bbase(const Unit& u, int K) const { long o = (long)u.pn * BM * K; if (MODE != 0) o += (long)(u.pm / 17) * bstride; return o; }
};

template <class Epi, class Sched>
__device__ __forceinline__ void gemm_phase(LAS unsigned char* lds, const Gemm g, const Sched& S, const Epi& E) {
    int tid = threadIdx.x; asm volatile("" : "+v"(tid));
    const int wid = __builtin_amdgcn_readfirstlane(tid >> 6), wr = wid >> 2, wc = wid & 3;
    const int K = g.K, nt = K / BK;
    unsigned voffB[2];
    { const int lane = tid & 63, fr = lane & 15, fq = lane >> 4; (void)fr; (void)fq; }
#pragma unroll
    for (int i = 0; i < 2; ++i) { int R, Cc; stage_rc(tid * 16 + i * 8192, R, Cc); voffB[i] = (unsigned)(R * K + Cc) * 2u; }
    const size_t kstep = (size_t)(BK * 2);
    const size_t hstep = (size_t)HALF * K * 2;
    const unsigned ldsw = (unsigned)wid * 1024u;
    const int aoff = lds_byte(wr * 64 + (tid & 15), ((tid & 63) >> 4) * 8), boff = lds_byte(wc * 32 + (tid & 15), ((tid & 63) >> 4) * 8);
#define PG8_SA(b, h) (((b) * 2 + (h)) * HTB)
#define PG8_SB(b, h) ((4 + (b) * 2 + (h)) * HTB)
#define PG8_STAGE(bufoff, gbase, voff) do { _Pragma("unroll") for (int _i = 0; _i < 2; ++_i) \
        __builtin_amdgcn_global_load_lds((const unsigned*)((const char*)(gbase) + (voff)[_i]), (LAS unsigned*)(lds + (bufoff) + ldsw + _i * 8192), 16, 0, 0); } while (0)
#define PG8_LDA(dst, b, h) do { _Pragma("unroll") for (int m = 0; m < 4; ++m) _Pragma("unroll") for (int k = 0; k < 2; ++k) dst[m][k] = *(const LAS bf16x8*)(lds + PG8_SA(b, h) + aoff + m * 2048 + k * 1024); } while (0)
#define PG8_LDB(dst, b, h) do { _Pragma("unroll") for (int n = 0; n < 2; ++n) _Pragma("unroll") for (int k = 0; k < 2; ++k) dst[n][k] = *(const LAS bf16x8*)(lds + PG8_SB(b, h) + boff + n * 2048 + k * 1024); } while (0)
#define PG8_MMA(ai, bj, At, Bt) do { __builtin_amdgcn_s_setprio(1); _Pragma("unroll") for (int m = 0; m < 4; ++m) _Pragma("unroll") for (int n = 0; n < 2; ++n) _Pragma("unroll") for (int k = 0; k < 2; ++k) \
        acc[ai][bj][m][n] = __builtin_amdgcn_mfma_f32_16x16x32_bf16(Bt[n][k], At[m][k], acc[ai][bj][m][n], 0, 0, 0); __builtin_amdgcn_s_setprio(0); } while (0)
#define PG8_WAIT_V(n) asm volatile("s_waitcnt vmcnt(" #n ")" ::: "memory")
#define PG8_WAIT_L(n) asm volatile("s_waitcnt lgkmcnt(" #n ")" ::: "memory")
#define PG8_BAR __builtin_amdgcn_s_barrier()
#define PG8_SCHED __builtin_amdgcn_sched_barrier(0)
#define PG8_ROWOFFS(dst, u, tq) do { _Pragma("unroll") for (int _i = 0; _i < 2; ++_i) { int _R, _C; stage_rc((tq) * 16 + _i * 8192, _R, _C); _Pragma("unroll") for (int _h = 0; _h < 2; ++_h) dst[_h][_i] = (S.arow(u, _h * HALF + _R) * (unsigned)K + (unsigned)_C) * 2u; } } while (0)
    Unit cur, nxt; int ui = 0;
    if (!S.next(0, cur)) return;
    f32x4 acc[2][2][4][2];
#pragma unroll
    for (int a = 0; a < 2; ++a)
#pragma unroll
        for (int b = 0; b < 2; ++b)
#pragma unroll
            for (int m = 0; m < 4; ++m)
#pragma unroll
                for (int n = 0; n < 2; ++n) acc[a][b][m][n] = (f32x4){0.f, 0.f, 0.f, 0.f};
    bf16x8 At[4][2], B0[2][2], B1[2][2];
    unsigned vcur[2][2];
    PG8_ROWOFFS(vcur, cur, tid);
    const char* const Ab = (const char*)g.A;
    const char* cB = (const char*)g.Bt + (size_t)S.bbase(cur, K) * 2;
    PG8_STAGE(PG8_SB(0, 0), cB, voffB); PG8_STAGE(PG8_SA(0, 0), Ab, vcur[0]); PG8_STAGE(PG8_SB(0, 1), cB + hstep, voffB); PG8_STAGE(PG8_SA(0, 1), Ab, vcur[1]);
    if (wr == 1) PG8_BAR;
    PG8_WAIT_V(4); PG8_BAR;
    PG8_STAGE(PG8_SB(1, 0), cB + kstep, voffB); PG8_STAGE(PG8_SA(1, 0), Ab + kstep, vcur[0]); PG8_STAGE(PG8_SB(1, 1), cB + hstep + kstep, voffB);
    PG8_WAIT_V(6); PG8_BAR;
    for (;;) {
        const bool has_next = S.next(ui + 1, nxt);
        const char* nB = has_next ? (const char*)g.Bt + (size_t)S.bbase(nxt, K) * 2 : cB;
        for (int t = 0; t < nt; t += 2) {
            const bool last = (t == nt - 2);
            const char* a1 = Ab + (size_t)(t + 1) * kstep;
            const char* a2 = last ? Ab : Ab + (size_t)(t + 2) * kstep; const char* b2 = last ? nB : cB + (size_t)(t + 2) * kstep;
            const char* a3 = a2 + kstep; const char* b3 = b2 + kstep;
            PG8_LDB(B0, 0, 0); PG8_SCHED; PG8_LDA(At, 0, 0); PG8_STAGE(PG8_SA(1, 1), a1, vcur[1]);
            PG8_WAIT_L(8); PG8_BAR; PG8_WAIT_L(0); PG8_MMA(0, 0, At, B0); PG8_BAR; PG8_SCHED;
            if (last && has_next) { int tq = tid; asm volatile("" : "+v"(tq)); PG8_ROWOFFS(vcur, nxt, tq); }
            PG8_LDB(B1, 0, 1); PG8_STAGE(PG8_SB(0, 0), b2, voffB);
            PG8_BAR; PG8_WAIT_L(0); PG8_MMA(0, 1, At, B1); PG8_BAR;
            PG8_LDA(At, 0, 1); PG8_STAGE(PG8_SA(0, 0), a2, vcur[0]);
            PG8_BAR; PG8_WAIT_L(0); PG8_MMA(1, 0, At, B0); PG8_BAR; PG8_SCHED;
            PG8_STAGE(PG8_SB(0, 1), b2 + hstep, voffB);
            PG8_WAIT_V(6); PG8_BAR; PG8_MMA(1, 1, At, B1); PG8_BAR;
            PG8_LDB(B0, 1, 0); PG8_SCHED; PG8_LDA(At, 1, 0); PG8_STAGE(PG8_SA(0, 1), a2, vcur[1]);
            PG8_WAIT_L(8); PG8_BAR; PG8_WAIT_L(0); PG8_MMA(0, 0, At, B0); PG8_BAR; PG8_SCHED;
            PG8_LDB(B1, 1, 1); PG8_STAGE(PG8_SB(1, 0), b3, voffB);
            PG8_BAR; PG8_WAIT_L(0); PG8_MMA(0, 1, At, B1); PG8_BAR;
            PG8_LDA(At, 1, 1); PG8_STAGE(PG8_SA(1, 0), a3, vcur[0]);
            PG8_BAR; PG8_WAIT_L(0); PG8_MMA(1, 0, At, B0); PG8_BAR; PG8_SCHED;
            PG8_STAGE(PG8_SB(1, 1), b3 + hstep, voffB);
            PG8_WAIT_V(6); PG8_BAR; PG8_MMA(1, 1, At, B1); PG8_BAR;
        }
        { int tz = tid; asm volatile("" : "+v"(tz)); const int ln = tz & 63; E(acc, cur, wr, wc, ln & 15, ln >> 4); }
        if (!has_next) break;
#pragma unroll
        for (int a = 0; a < 2; ++a)
#pragma unroll
            for (int b = 0; b < 2; ++b)
#pragma unroll
                for (int m = 0; m < 4; ++m)
#pragma unroll
                    for (int n = 0; n < 2; ++n) acc[a][b][m][n] = (f32x4){0.f, 0.f, 0.f, 0.f};
        cur = nxt; cB = nB; ++ui;
    }
    PG8_WAIT_V(0);
    if (wr == 0) PG8_BAR;
    PG8_BAR;
#undef PG8_SA
#undef PG8_SB
#undef PG8_STAGE
#undef PG8_LDA
#undef PG8_LDB
#undef PG8_MMA
#undef PG8_WAIT_V
#undef PG8_WAIT_L
#undef PG8_BAR
#undef PG8_SCHED
#undef PG8_ROWOFFS
}

#define EPI_LOOP for (int ai = 0; ai < 2; ++ai) for (int m = 0; m < 4; ++m) for (int bj = 0; bj < 2; ++bj) for (int n = 0; n < 2; ++n)
struct EpiBf16 {
    bf16_t* O; int ldc;
    __device__ __forceinline__ void operator()(const f32x4 (&acc)[2][2][4][2], const Unit& u, int wr, int wc, int fr, int fq) const {
        const int row0 = u.pm * BM + wr * 64 + fr, col0 = u.pn * BM + wc * 32 + 4 * fq;
#pragma unroll
        for (int ai = 0; ai < 2; ++ai)
#pragma unroll
            for (int m = 0; m < 4; ++m) { bf16_t* rowp = O + (size_t)(row0 + ai * HALF + m * 16) * ldc + col0;
#pragma unroll
                for (int bj = 0; bj < 2; ++bj)
#pragma unroll
                    for (int n = 0; n < 2; ++n) { const f32x4 v = acc[ai][bj][m][n]; u32x2 o; o.x = pk2(v[0], v[1]); o.y = pk2(v[2], v[3]); *(u32x2*)(rowp + bj * HALF + n * 16) = o; } }
    }
};
struct EpiOdd {
    bf16_t* P; bf16_t* Q; bf16_t* KA; const float* rope;
    __device__ __forceinline__ void operator()(const f32x4 (&acc)[2][2][4][2], const Unit& u, int wr, int wc, int fr, int fq) const {
        const int row0 = u.pm * BM + wr * 64 + fr, col0 = u.pn * BM + wc * 32 + 4 * fq;
        if (u.pn >= 6) {
#pragma unroll
            for (int ai = 0; ai < 2; ++ai)
#pragma unroll
                for (int m = 0; m < 4; ++m) { bf16_t* rowp = P + (size_t)(row0 + ai * HALF + m * 16) * P_LD + col0;
#pragma unroll
                    for (int bj = 0; bj < 2; ++bj)
#pragma unroll
                        for (int n = 0; n < 2; ++n) { const f32x4 v = acc[ai][bj][m][n]; u32x2 o; o.x = pk2(v[0], v[1]); o.y = pk2(v[2], v[3]); *(u32x2*)(rowp + bj * HALF + n * 16) = o; } }
            return;
        }
        const bool isk = u.pn >= 3, isctx = u.pm >= NLAT / BM; const int axis = wc & 1;
        const int cq = col0 - (isk ? 768 : 0);
#pragma unroll
        for (int ai = 0; ai < 2; ++ai)
#pragma unroll
            for (int m = 0; m < 4; ++m) { const int row = row0 + ai * HALF + m * 16;
                f32x4 cs = {1.f, 1.f, 1.f, 1.f}, sn = {0.f, 0.f, 0.f, 0.f}; size_t orow;
                if (!isctx) { const int t = row & (TT - 1); const int pos = axis ? 128 + (t & 63) : (t >> 6);
                    cs = *(const f32x4*)(rope + pos * 16 + 4 * fq); sn = *(const f32x4*)(rope + 192 * 16 + pos * 16 + 4 * fq);
                    orow = isk ? (size_t)(row >> 13) * LKEYS + CTXL + t : (size_t)row; }
                else { const int rc = row - NLAT; orow = isk ? (size_t)(rc >> 8) * LKEYS + (rc & 255) : (size_t)row; }
                bf16_t* op = (isk ? KA : Q) + orow * 768 + cq; const float sc = isk ? 1.f : QSCALE;
#pragma unroll
                for (int bj = 0; bj < 2; ++bj) { const f32x4 x1 = acc[ai][bj][m][0], x2 = acc[ai][bj][m][1];
                    const f32x4 o1 = (x1 * cs - x2 * sn) * sc, o2 = (x1 * sn + x2 * cs) * sc;
                    u32x2 a; a.x = pk2(o1[0], o1[1]); a.y = pk2(o1[2], o1[3]); *(u32x2*)(op + bj * HALF) = a;
                    u32x2 b; b.x = pk2(o2[0], o2[1]); b.y = pk2(o2[2], o2[3]); *(u32x2*)(op + bj * HALF + 16) = b; } }
    }
};
struct EpiRes {
    float* X; const float* modl;
    __device__ __forceinline__ void operator()(const f32x4 (&acc)[2][2][4][2], const Unit& u, int wr, int wc, int fr, int fq) const {
        const int row0 = u.pm * BM + wr * 64 + fr, col0 = u.pn * BM + wc * 32 + 4 * fq;
        const int mi = (u.pm * BM < NLAT) ? (u.pm * BM) / TT : 4;
        const float* gate = modl + mi * 6144 + 2 * DM;
        f32x4 gv[2][2];
#pragma unroll
        for (int bj = 0; bj < 2; ++bj)
#pragma unroll
            for (int n = 0; n < 2; ++n) gv[bj][n] = *(const f32x4*)(gate + col0 + bj * HALF + n * 16);
#pragma unroll
        for (int ai = 0; ai < 2; ++ai)
#pragma unroll
            for (int m = 0; m < 4; ++m) { float* rowp = X + (size_t)(row0 + ai * HALF + m * 16) * DM + col0;
#pragma unroll
                for (int bj = 0; bj < 2; ++bj)
#pragma unroll
                    for (int n = 0; n < 2; ++n) { f32x4* p = (f32x4*)(rowp + bj * HALF + n * 16); const f32x4 x = *p; *p = x * ALPHA_DN + gv[bj][n] * acc[ai][bj][m][n]; } }
    }
};
struct EpiSwiGLU {
    bf16_t* HID;
    __device__ __forceinline__ void operator()(const f32x4 (&acc)[2][2][4][2], const Unit& u, int wr, int wc, int fr, int fq) const {
        const int row0 = u.pm * BM + wr * 64 + fr, f0 = u.pn * HALF + wc * 32 + 4 * fq;
#pragma unroll
        for (int ai = 0; ai < 2; ++ai)
#pragma unroll
            for (int m = 0; m < 4; ++m) { bf16_t* rowp = HID + (size_t)(row0 + ai * HALF + m * 16) * D_EXP + f0;
#pragma unroll
                for (int n = 0; n < 2; ++n) { const f32x4 a = acc[ai][0][m][n], b = acc[ai][1][m][n]; float h[4];
#pragma unroll
                    for (int j = 0; j < 4; ++j) h[j] = a[j] / (1.f + __expf(-a[j])) * b[j];
                    u32x2 o; o.x = pk2(h[0], h[1]); o.y = pk2(h[2], h[3]); *(u32x2*)(rowp + n * 16) = o; } }
    }
};
struct EpiYE {
    bf16_t* YE; const float* gate;
    __device__ __forceinline__ void operator()(const f32x4 (&acc)[2][2][4][2], const Unit& u, int wr, int wc, int fr, int fq) const {
        const int row0 = u.pm * BM + wr * 64 + fr, col0 = u.pn * BM + wc * 32 + 4 * fq;
#pragma unroll
        for (int ai = 0; ai < 2; ++ai)
#pragma unroll
            for (int m = 0; m < 4; ++m) { const int row = row0 + ai * HALF + m * 16; const float gt = gate[row]; bf16_t* rowp = YE + (size_t)row * DM + col0;
#pragma unroll
                for (int bj = 0; bj < 2; ++bj)
#pragma unroll
                    for (int n = 0; n < 2; ++n) { const f32x4 v = acc[ai][bj][m][n] * gt; u32x2 o; o.x = pk2(v[0], v[1]); o.y = pk2(v[2], v[3]); *(u32x2*)(rowp + bj * HALF + n * 16) = o; } }
    }
};
struct EpiLora {
    float* SCN; bf16_t* G; const float* decay0; const float* a0; const float* kalpha;
    __device__ __forceinline__ void operator()(const f32x4 (&acc)[2][2][4][2], const Unit& u, int wr, int wc, int fr, int fq) const {
        const int row0 = u.pm * BM + wr * 64 + fr;
        const int seg = u.pn / 3, cb = (u.pn % 3) * BM + wc * 32 + 4 * fq;
#pragma unroll
        for (int bj = 0; bj < 2; ++bj)
#pragma unroll
            for (int n = 0; n < 2; ++n) {
                const int col = cb + bj * HALF + n * 16, head = col >> 6, kx = col & 63;
                if (seg < 2) {
                    const f32x4 d0 = *(const f32x4*)(decay0 + seg * 768 + col);
#pragma unroll
                    for (int ai = 0; ai < 2; ++ai)
#pragma unroll
                        for (int m = 0; m < 4; ++m) { const int row = row0 + ai * HALF + m * 16; f32x4 w;
#pragma unroll
                            for (int j = 0; j < 4; ++j) w[j] = __expf(-DECAY_SCALE * sigmoidf_(d0[j] + acc[ai][bj][m][n][j]));
                            *(f32x4*)(SCN + ((size_t)(row * 12 + head) * 9 + 3 + 3 * seg) * 64 + kx) = w; }
                } else if (seg < 4) {
                    const int d = seg - 2;
                    const f32x4 a00 = *(const f32x4*)(a0 + d * 768 + col), kal = *(const f32x4*)(kalpha + col);
#pragma unroll
                    for (int ai = 0; ai < 2; ++ai)
#pragma unroll
                        for (int m = 0; m < 4; ++m) { const int row = row0 + ai * HALF + m * 16; float* base = SCN + (size_t)(row * 12 + head) * 9 * 64 + kx;
                            const f32x4 kk = *(const f32x4*)(base + 1 * 64); const f32x4 ks = *(const f32x4*)(base + (5 + 3 * d) * 64); f32x4 bb, kr;
#pragma unroll
                            for (int j = 0; j < 4; ++j) { const float a = sigmoidf_(a00[j] + acc[ai][bj][m][n][j]); bb[j] = kk[j] * a; kr[j] = ks[j] * (1.f + (a - 1.f) * kal[j]); }
                            *(f32x4*)(base + (4 + 3 * d) * 64) = bb; *(f32x4*)(base + (5 + 3 * d) * 64) = kr; }
                } else {
#pragma unroll
                    for (int ai = 0; ai < 2; ++ai)
#pragma unroll
                        for (int m = 0; m < 4; ++m) { const int row = row0 + ai * HALF + m * 16; const f32x4 v = acc[ai][bj][m][n]; u32x2 o; o.x = pk2(v[0], v[1]); o.y = pk2(v[2], v[3]);
                            *(u32x2*)(G + (size_t)row * 768 + col) = o; }
                }
            }
    }
};
}

struct Args { const float* in[37]; float* out; unsigned char* ws; int lo, hi; };
enum { I_X = 0, I_C, I_CTX, I_CCTX, I_WMOD, I_BMOD, I_LNG, I_LNB, I_EWIN, I_EWOUT, I_CONVW, I_MU, I_DUP, I_D0, I_AUP, I_A0, I_GUP, I_KXI, I_KAL, I_RBON, I_GNG, I_GNB,
       I_OWIN, I_OWOUT, I_LQ1, I_LK1, I_LQ2, I_LK2, I_SUBG, I_GLNG, I_GLNB, I_GWS, I_GBS, I_WR, I_WE1, I_WE3, I_WE2 };

struct Ctx {
    LAS unsigned char* lds;
    int tid, lane, wave, G, vcu, gw, NGW;
};
__device__ __forceinline__ void mkctx(Ctx& C, LAS unsigned char* lds) {
    int tid = threadIdx.x; asm volatile("" : "+v"(tid));
    C.lds = lds; C.tid = tid; C.lane = tid & 63; C.wave = __builtin_amdgcn_readfirstlane(tid >> 6);
    C.G = gridDim.x; { const int bx = blockIdx.x; C.vcu = (C.G % 8 == 0) ? (bx % 8) * (C.G / 8) + bx / 8 : bx; }
    C.gw = blockIdx.x * NWAVES + C.wave; C.NGW = C.G * NWAVES;
}
__device__ __forceinline__ void ldargs(Args& A, LAS unsigned char* lds) {
    LAS const u32x2* tb = (LAS const u32x2*)(lds + LDS_PTAB); asm volatile("" : "+v"(tb));
#pragma unroll
    for (int i = 0; i < 37; ++i) { const u32x2 v = tb[i]; A.in[i] = (const float*)(((unsigned long long)(unsigned)__builtin_amdgcn_readfirstlane((int)v.y) << 32) | (unsigned)__builtin_amdgcn_readfirstlane((int)v.x)); }
    { const u32x2 v = tb[37]; A.out = (float*)(((unsigned long long)(unsigned)__builtin_amdgcn_readfirstlane((int)v.y) << 32) | (unsigned)__builtin_amdgcn_readfirstlane((int)v.x)); }
    { const u32x2 v = tb[38]; A.ws = (unsigned char*)(((unsigned long long)(unsigned)__builtin_amdgcn_readfirstlane((int)v.y) << 32) | (unsigned)__builtin_amdgcn_readfirstlane((int)v.x)); }
    A.lo = 0; A.hi = 0;
}
__device__ __forceinline__ int row_mi(int row) { return row < NLAT ? (row >> 13) : 4; }

__device__ __forceinline__ void phase_init(const Ctx& C, const Args& A) {
    unsigned char* ws = A.ws;
    float* MOD = (float*)(ws + WS_MOD);
    LAS float* sv = (LAS float*)C.lds;
    LAS float* red = sv + 5 * 1024;
    for (int i = C.tid; i < 5 * 1024; i += NTHR) { const int v = i >> 10, k = i & 1023; const float c = (v < 4) ? A.in[I_C][v * DM + k] : A.in[I_CCTX][k]; sv[i] = c / (1.f + __expf(-c)); }
    __syncthreads();
    const int j = C.tid & 127, kp = C.tid >> 7;
    for (int it = blockIdx.x; it < DEPTH * 48; it += C.G) {
        const int l = it / 48, cg = it % 48, col = cg * 128 + j;
        const float* W = A.in[I_WMOD] + (size_t)l * DM * 6144 + col;
        float a0 = 0.f, a1 = 0.f, a2 = 0.f, a3 = 0.f, a4 = 0.f;
#pragma unroll 4
        for (int k = kp * 256; k < kp * 256 + 256; ++k) { const float w = W[(size_t)k * 6144]; a0 += sv[k] * w; a1 += sv[1024 + k] * w; a2 += sv[2048 + k] * w; a3 += sv[3072 + k] * w; a4 += sv[4096 + k] * w; }
        red[(kp * 5 + 0) * 128 + j] = a0; red[(kp * 5 + 1) * 128 + j] = a1; red[(kp * 5 + 2) * 128 + j] = a2; red[(kp * 5 + 3) * 128 + j] = a3; red[(kp * 5 + 4) * 128 + j] = a4;
        __syncthreads();
        for (int o = C.tid; o < 5 * 128; o += NTHR) { const int v = o >> 7, jj = o & 127; const int cc = cg * 128 + jj;
            const float s = red[(0 * 5 + v) * 128 + jj] + red[(1 * 5 + v) * 128 + jj] + red[(2 * 5 + v) * 128 + jj] + red[(3 * 5 + v) * 128 + jj];
            MOD[((size_t)l * 5 + v) * 6144 + cc] = s + A.in[I_BMOD][l * 6144 + cc]; }
        __syncthreads();
    }
    if (blockIdx.x == C.G - 1) { float* rope = (float*)(ws + WS_ROPE);
        for (int i = C.tid; i < 192 * 16; i += NTHR) { const int pos = i >> 4, j = i & 15; const float ang = (float)(pos < 128 ? pos : pos - 128) * powf(10000.f, -(float)j * (1.f / 16.f));
            rope[i] = cosf(ang); rope[192 * 16 + i] = sinf(ang); } }
    f32x4* X4 = (f32x4*)(ws + WS_X);
    const f32x4* x4 = (const f32x4*)A.in[I_X]; const f32x4* c4 = (const f32x4*)A.in[I_CTX];
    const size_t nl = (size_t)NLAT * DM / 4, nc = (size_t)NCTX * DM / 4;
    for (size_t i = (size_t)blockIdx.x * NTHR + C.tid; i < nl + nc; i += (size_t)C.G * NTHR) X4[i] = (i < nl) ? x4[i] : c4[i - nl];
}

__device__ __forceinline__ void transpose_item(const float* W, int ldw, int k0, int n0, bf16_t* WT, int ldt, int drow0, LAS float* scr, int lane) {
    { float v[64]; const float* src = W + (size_t)k0 * ldw + n0 + lane;
#pragma unroll
      for (int k = 0; k < 64; ++k) v[k] = __builtin_nontemporal_load(src + (size_t)k * ldw);
#pragma unroll
      for (int k = 0; k < 64; ++k) scr[k * 65 + lane] = v[k]; }
    asm volatile("s_waitcnt lgkmcnt(0)" ::: "memory");
    const int c = lane & 7;
#pragma unroll
    for (int j = 0; j < 8; ++j) { const int n = (lane >> 3) + 8 * j; const LAS float* s = scr + (8 * c) * 65 + n;
        u32x4 o; o.x = pk2(s[0 * 65], s[1 * 65]); o.y = pk2(s[2 * 65], s[3 * 65]); o.z = pk2(s[4 * 65], s[5 * 65]); o.w = pk2(s[6 * 65], s[7 * 65]);
        *(u32x4*)(WT + (size_t)(drow0 + n) * ldt + k0 + 8 * c) = o; }
    asm volatile("s_waitcnt lgkmcnt(0)" ::: "memory");
}
__device__ __forceinline__ void phase_conv(const Ctx& C, const Args& A, int l) {
    unsigned char* ws = A.ws;
    const int i2 = l >> 1; const bool odd = (l & 1);
    LAS float* scr = (LAS float*)C.lds + C.wave * (64 * 65);
    bf16_t* WIN = (bf16_t*)(ws + WS_WIN); bf16_t* WOUT = (bf16_t*)(ws + WS_WOUT); bf16_t* WE13 = (bf16_t*)(ws + WS_WE13); bf16_t* WE2 = (bf16_t*)(ws + WS_WE2);
    const int nin = odd ? D_IN_ODD : D_IN_EVEN;
    const float* win = odd ? A.in[I_OWIN] + (size_t)i2 * DM * D_IN_ODD : A.in[I_EWIN] + (size_t)i2 * DM * D_IN_EVEN;
    const float* wout = odd ? A.in[I_OWOUT] + (size_t)i2 * DM * DM : A.in[I_EWOUT] + (size_t)i2 * DM * DM;
    const int n_in = 16 * (nin / 64), n_out = 16 * 16, n_e13 = NEXP * 2 * 16 * 32, n_e2 = NEXP * 32 * 16;
    const int total = n_in + n_out + n_e13 + n_e2;
    for (int it = C.gw; it < total; it += C.NGW) {
        int r = it;
        if (r < n_in) { const int nb = nin / 64, kb = r / nb, nn = r % nb; transpose_item(win, nin, kb * 64, nn * 64, WIN, DM, nn * 64, scr, C.lane); continue; } r -= n_in;
        if (r < n_out) { const int kb = r / 16, nn = r % 16; transpose_item(wout, DM, kb * 64, nn * 64, WOUT, DM, nn * 64, scr, C.lane); continue; } r -= n_out;
        if (r < n_e13) { const int e = r / 1024, q = r % 1024, mat = q / 512, q2 = q % 512, kb = q2 / 32, nn = q2 % 32;
            const float* W = (mat ? A.in[I_WE3] : A.in[I_WE1]) + ((size_t)l * NEXP + e) * DM * D_EXP;
            const int f0 = nn * 64; const int drow = (f0 >> 7) * 256 + mat * 128 + (f0 & 127);
            transpose_item(W, D_EXP, kb * 64, f0, WE13 + (size_t)e * 4096 * DM, DM, drow, scr, C.lane); continue; } r -= n_e13;
        { const int e = r / 512, q = r % 512, kb = q / 16, nn = q % 16;
            const float* W = A.in[I_WE2] + ((size_t)l * NEXP + e) * D_EXP * DM;
            transpose_item(W, DM, kb * 64, nn * 64, WE2 + (size_t)e * DM * D_EXP, D_EXP, nn * 64, scr, C.lane); }
    }
    if (!odd) {
        u32x4* z = (u32x4*)(WIN + (size_t)D_IN_EVEN * DM);
        for (int i = blockIdx.x * NTHR + C.tid; i < (D_IN_EVEN_PAD - D_IN_EVEN) * DM / 8; i += C.G * NTHR) z[i] = (u32x4){0u, 0u, 0u, 0u};
        bf16_t* WL = (bf16_t*)(ws + WS_WLORA);
        const float* dup = A.in[I_DUP] + (size_t)i2 * 2 * 64 * 768; const float* aup = A.in[I_AUP] + (size_t)i2 * 2 * 64 * 768; const float* gup = A.in[I_GUP] + (size_t)i2 * 128 * 768;
        for (int i = blockIdx.x * NTHR + C.tid; i < LORA_N * LORA_K; i += C.G * NTHR) {
            const int kk = i / LORA_N, n = i % LORA_N, seg = n / 768, col = n % 768; float v = 0.f;
            if (seg == 0) { if (kk < 64) v = dup[(size_t)(0 * 64 + kk) * 768 + col]; }
            else if (seg == 1) { if (kk >= 64 && kk < 128) v = dup[(size_t)(1 * 64 + kk - 64) * 768 + col]; }
            else if (seg == 2) { if (kk >= 128 && kk < 192) v = aup[(size_t)(0 * 64 + kk - 128) * 768 + col]; }
            else if (seg == 3) { if (kk >= 192 && kk < 256) v = aup[(size_t)(1 * 64 + kk - 192) * 768 + col]; }
            else { if (kk >= 256) v = gup[(size_t)(kk - 256) * 768 + col]; }
            WL[(size_t)n * LORA_K + kk] = (bf16_t)f2bf(v);
        }
    }
}

__device__ __forceinline__ void phase_modh(const Ctx& C, const Args& A, int l) {
    const float* X = (const float*)(A.ws + WS_X); bf16_t* H = (bf16_t*)(A.ws + WS_H); const float* MOD = (const float*)(A.ws + WS_MOD) + (size_t)l * 5 * 6144;
    for (int row = C.gw; row < MROWS; row += C.NGW) {
        const float* md = MOD + row_mi(row) * 6144;
#pragma unroll
        for (int j = 0; j < 4; ++j) { const int col = 4 * C.lane + 256 * j; const f32x4 x = *(const f32x4*)(X + (size_t)row * DM + col), sh = *(const f32x4*)(md + col), sc = *(const f32x4*)(md + DM + col);
            const f32x4 h = x * (sc + 1.f) + sh; u32x2 o; o.x = pk2(h[0], h[1]); o.y = pk2(h[2], h[3]); *(u32x2*)(H + (size_t)row * DM + col) = o; }
    }
}

__device__ __forceinline__ f32x4 ld4bf(const bf16_t* p) { const u32x2 u = *(const u32x2*)p; return (f32x4){bflo(u.x), bfhi(u.x), bflo(u.y), bfhi(u.y)}; }
__device__ __forceinline__ void st4bf(bf16_t* p, f32x4 v) { u32x2 o; o.x = pk2(v[0], v[1]); o.y = pk2(v[2], v[3]); *(u32x2*)p = o; }
__device__ __forceinline__ void seq_info(int row, bool& hasp, bool& hasn) {
    if (row < NLAT) { const int t = row & (TT - 1); hasp = t > 0; hasn = t < TT - 1; }
    else { const int t = (row - NLAT) & (CTXL - 1); hasp = t > 0; hasn = t < CTXL - 1; }
}
__device__ __forceinline__ void phase_ef1(const Ctx& C, const Args& A, int l) {
    const int i2 = l >> 1; unsigned char* ws = A.ws;
    const bf16_t* P = (const bf16_t*)(ws + WS_P); bf16_t* A2 = (bf16_t*)(ws + WS_A2); float* SCN = (float*)(ws + WS_SCN); bf16_t* LIN = (bf16_t*)(ws + WS_LIN);
    const float* cw = A.in[I_CONVW] + (size_t)i2 * 3 * 256; const float* mu = A.in[I_MU] + (size_t)i2 * RWKV_COLS; const float* kxi = A.in[I_KXI] + (size_t)i2 * 768;
    const f32x4 z4 = {0.f, 0.f, 0.f, 0.f};
    for (int row = C.gw; row < MROWS; row += C.NGW) {
        bool hasp, hasn; seq_info(row, hasp, hasn);
        const bf16_t* p0 = P + (size_t)row * P_LD; const bf16_t* pm = p0 - P_LD; const bf16_t* pp = p0 + P_LD;
        {
            const int j4 = 4 * C.lane;
            const f32x4 bg = ld4bf(p0 + j4), u0 = ld4bf(p0 + 256 + j4) * ld4bf(p0 + 512 + j4);
            const f32x4 um = hasp ? ld4bf(pm + 256 + j4) * ld4bf(pm + 512 + j4) : z4, up = hasn ? ld4bf(pp + 256 + j4) * ld4bf(pp + 512 + j4) : z4;
            const f32x4 w0 = *(const f32x4*)(cw + j4), w1 = *(const f32x4*)(cw + 256 + j4), w2 = *(const f32x4*)(cw + 512 + j4);
            st4bf(A2 + (size_t)row * DM + j4, bg * (w0 * um + w1 * u0 + w2 * up));
        }
#pragma unroll
        for (int it = 0; it < 11; ++it) {
            const int c = it * 256 + 4 * C.lane;
            if (c < RWKV_COLS) {
                const f32x4 x0 = ld4bf(p0 + 768 + c), xm = hasp ? ld4bf(pm + 768 + c) : z4, xp = hasn ? ld4bf(pp + 768 + c) : z4, m4 = *(const f32x4*)(mu + c);
                const f32x4 ps = x0 + m4 * ((xm + xp) * 0.5f - x0);
                if (it < 3) { const int head = c >> 6, kx = c & 63; *(f32x4*)(SCN + ((size_t)(row * 12 + head) * 9 + 0) * 64 + kx) = ps; }
                else if (it < 6) { const int c1 = c - 768, head = c1 >> 6, kx = c1 & 63; const f32x4 kv = ps * *(const f32x4*)(kxi + c1);
                    const float ss = sum16(kv[0] * kv[0] + kv[1] * kv[1] + kv[2] * kv[2] + kv[3] * kv[3]); const float rn = rsqrtf(ss + 1e-12f);
                    float* base = SCN + (size_t)(row * 12 + head) * 9 * 64 + kx;
                    *(f32x4*)(base + 1 * 64) = kv * rn; *(f32x4*)(base + 5 * 64) = ps; *(f32x4*)(base + 8 * 64) = ps; }
                else if (it < 9) { const int c1 = c - 1536, head = c1 >> 6, kx = c1 & 63; *(f32x4*)(SCN + ((size_t)(row * 12 + head) * 9 + 2) * 64 + kx) = ps; }
                else { const int c1 = c - 2304; f32x4 o;
                    if (c1 < 128) { o = (f32x4){tanhf(ps[0]), tanhf(ps[1]), tanhf(ps[2]), tanhf(ps[3])}; }
                    else if (c1 < 256) { o = ps; }
                    else { o = (f32x4){sigmoidf_(ps[0]), sigmoidf_(ps[1]), sigmoidf_(ps[2]), sigmoidf_(ps[3])}; }
                    st4bf(LIN + (size_t)row * LORA_K + c1, o); }
            }
        }
    }
}

__device__ __forceinline__ int scan_row(int i, int b, int d) {
    if (d == 0) return i < CTXL ? NLAT + b * CTXL + i : b * TT + (i - CTXL);
    return i < CTXL ? NLAT + b * CTXL + (CTXL - 1 - i) : b * TT + (TT - 1 - (i - CTXL));
}
__device__ __forceinline__ float red8(float v) {
    v += __uint_as_float((unsigned)__builtin_amdgcn_update_dpp(0, (int)__float_as_uint(v), 0xB1, 0xF, 0xF, true));
    v += __uint_as_float((unsigned)__builtin_amdgcn_update_dpp(0, (int)__float_as_uint(v), 0x4E, 0xF, 0xF, true));
    v += __uint_as_float((unsigned)__builtin_amdgcn_update_dpp(0, (int)__float_as_uint(v), 0x141, 0xF, 0xF, true));
    return v;
}
__device__ __forceinline__ float red16(float v) {
    v += __uint_as_float((unsigned)__builtin_amdgcn_update_dpp(0, (int)__float_as_uint(v), 0xB1, 0xF, 0xF, true));
    v += __uint_as_float((unsigned)__builtin_amdgcn_update_dpp(0, (int)__float_as_uint(v), 0x4E, 0xF, 0xF, true));
    v += __uint_as_float((unsigned)__builtin_amdgcn_update_dpp(0, (int)__float_as_uint(v), 0x141, 0xF, 0xF, true));
    v += __uint_as_float((unsigned)__builtin_amdgcn_update_dpp(0, (int)__float_as_uint(v), 0x140, 0xF, 0xF, true));
    return v;
}
__device__ __forceinline__ void phase_scan(const Ctx& C, const Args& A) {
    for (int u = blockIdx.x; u < 192; u += C.G) {
    const int half = u & 1, d = (u >> 1) & 1, h = (u >> 2) % 12, b = u / 48;
    const float* SCN = (const float*)(A.ws + WS_SCN); float* Y = (float*)(A.ws + WS_Y) + (size_t)d * MROWS * 768;
    LAS float* buf = (LAS float*)C.lds; LAS float* ybuf = buf + 2 * 32 * 352;
    constexpr int NCH = LKEYS / 32;
    f32x4 st[6];
    int ps_[6], prel[6], pdst[6];
#pragma unroll
    for (int j = 0; j < 6; ++j) { const int p = C.tid + NTHR * j; const int s = p / 88, q = p % 88, vec = q >> 4; ps_[j] = s; pdst[j] = s * 352 + q * 4;
        const int slot = vec == 0 ? 3 + 3 * d : vec == 1 ? 1 : vec == 2 ? 4 + 3 * d : vec == 3 ? 5 + 3 * d : vec == 4 ? 0 : 2;
        prel[j] = slot * 64 + (vec < 5 ? (q & 15) * 4 : half * 32 + (q - 80) * 4); }
    const int sgn = d ? -1 : 1;
    const float* SCNh = SCN + (size_t)h * 576;
#define SCAN_ROW0(c) (((c) * 32 < CTXL) ? (NLAT + b * CTXL + (d ? CTXL - 1 - (c) * 32 : (c) * 32)) : (b * TT + (d ? TT - 1 - ((c) * 32 - CTXL) : (c) * 32 - CTXL)))
#define SCAN_LOADG(c) do { const int row0_ = SCAN_ROW0(c); _Pragma("unroll") for (int j = 0; j < 6; ++j) if (j < 5 || C.tid < 2816 - 5 * NTHR) { \
        st[j] = *(const f32x4*)(SCNh + (size_t)(row0_ + sgn * ps_[j]) * (12 * 576) + prel[j]); } } while (0)
#define SCAN_STORE(bi) do { _Pragma("unroll") for (int j = 0; j < 6; ++j) if (j < 5 || C.tid < 2816 - 5 * NTHR) *(LAS f32x4*)(buf + (bi) * (32 * 352) + pdst[j]) = st[j]; } while (0)
    SCAN_LOADG(0); SCAN_STORE(0); __syncthreads();
    float S0 = 0.f, S1 = 0.f, S2 = 0.f, S3 = 0.f;
    const int rl = C.lane >> 4, ks = C.lane & 15;
#define SC_LD(R, s) do { const LAS float* bp_ = cur + (s) * 352 + ks * 4; \
        R##w = *(const LAS f32x4*)(bp_); R##k = *(const LAS f32x4*)(bp_ + 64); R##b = *(const LAS f32x4*)(bp_ + 128); R##q = *(const LAS f32x4*)(bp_ + 192); R##r = *(const LAS f32x4*)(bp_ + 256); \
        R##vv = cur[(s) * 352 + 320 + C.wave * 4 + rl]; } while (0)
#define SC_STEP(R, s) do { \
        const float sa = red16((S0 * R##k[0] + S1 * R##k[1]) + (S2 * R##k[2] + S3 * R##k[3])); \
        S0 = S0 * R##w[0] + (R##vv * R##q[0] - sa * R##b[0]); S1 = S1 * R##w[1] + (R##vv * R##q[1] - sa * R##b[1]); \
        S2 = S2 * R##w[2] + (R##vv * R##q[2] - sa * R##b[2]); S3 = S3 * R##w[3] + (R##vv * R##q[3] - sa * R##b[3]); \
        const float y = red16((S0 * R##r[0] + S1 * R##r[1]) + (S2 * R##r[2] + S3 * R##r[3])); if (ks == 0) yb[(s) * 32] = y; } while (0)
    for (int c = 0; c < NCH; ++c) {
        if (c + 1 < NCH) SCAN_LOADG(c + 1);
        {
            const LAS float* cur = buf + (c & 1) * (32 * 352);
            LAS float* yb = ybuf + (c & 1) * 1024 + C.wave * 4 + rl;
            f32x4 Aw, Ak, Ab, Aq, Ar, Bw, Bk, Bb, Bq, Br, Cw, Ck, Cb, Cq, Cr, Dw, Dk, Db, Dq, Dr; float Avv, Bvv, Cvv, Dvv;
            SC_LD(A, 0); SC_LD(B, 1);
#pragma unroll 1
            for (int s = 0; s < 32; s += 4) {
                SC_LD(C, s + 2); __builtin_amdgcn_sched_barrier(0); SC_STEP(A, s); __builtin_amdgcn_sched_barrier(0);
                SC_LD(D, s + 3); __builtin_amdgcn_sched_barrier(0); SC_STEP(B, s + 1); __builtin_amdgcn_sched_barrier(0);
                SC_LD(A, s + 4); __builtin_amdgcn_sched_barrier(0); SC_STEP(C, s + 2); __builtin_amdgcn_sched_barrier(0);
                SC_LD(B, s + 5); __builtin_amdgcn_sched_barrier(0); SC_STEP(D, s + 3); __builtin_amdgcn_sched_barrier(0);
            }
        }
        if (c + 1 < NCH) SCAN_STORE((c + 1) & 1);
        __syncthreads();
        { const int row0_ = SCAN_ROW0(c);
#pragma unroll
          for (int i = 0; i < 2; ++i) { const int e = C.tid + NTHR * i, s = e >> 5, r = e & 31;
            Y[(size_t)(row0_ + sgn * s) * 768 + h * 64 + half * 32 + r] = ybuf[(c & 1) * 1024 + e]; } }
    }
    __syncthreads();
    }
#undef SCAN_LOADG
#undef SCAN_STORE
#undef SCAN_ROW0
#undef SC_LD
#undef SC_STEP
}

__device__ __forceinline__ void phase_ef2(const Ctx& C, const Args& A, int l) {
    const int i2 = l >> 1; unsigned char* ws = A.ws;
    const float* SCN = (const float*)(ws + WS_SCN); const float* Y0 = (const float*)(ws + WS_Y); const float* Y1 = Y0 + (size_t)MROWS * 768;
    const bf16_t* G = (const bf16_t*)(ws + WS_G); bf16_t* A2 = (bf16_t*)(ws + WS_A2);
    const float* rb = A.in[I_RBON] + (size_t)i2 * 768; const float* gg = A.in[I_GNG] + (size_t)i2 * 768; const float* gb = A.in[I_GNB] + (size_t)i2 * 768;
    for (int row = C.gw; row < MROWS; row += C.NGW) {
#pragma unroll
        for (int it = 0; it < 3; ++it) {
            const int c = it * 256 + 4 * C.lane, head = c >> 6, kx = c & 63;
            const f32x4 y = *(const f32x4*)(Y0 + (size_t)row * 768 + c) + *(const f32x4*)(Y1 + (size_t)row * 768 + c);
            const float mean = sum16((y[0] + y[1]) + (y[2] + y[3])) * (1.f / 64.f);
            const f32x4 dd = y - mean;
            const float var = sum16((dd[0] * dd[0] + dd[1] * dd[1]) + (dd[2] * dd[2] + dd[3] * dd[3])) * (1.f / 64.f);
            const float rstd = rsqrtf(var + GN_EPS);
            const float* base = SCN + (size_t)(row * 12 + head) * 9 * 64 + kx;
            const f32x4 r = *(const f32x4*)(base), v = *(const f32x4*)(base + 2 * 64), k0 = *(const f32x4*)(base + 5 * 64), k1 = *(const f32x4*)(base + 8 * 64);
            const f32x4 rb4 = *(const f32x4*)(rb + c);
            const f32x4 t = r * (k0 + k1) * 0.5f * rb4;
            const float bs = sum16((t[0] + t[1]) + (t[2] + t[3]));
            const f32x4 yn = dd * rstd * *(const f32x4*)(gg + c) + *(const f32x4*)(gb + c);
            const f32x4 g = ld4bf(G + (size_t)row * 768 + c);
            st4bf(A2 + (size_t)row * DM + 256 + c, g * (yn + v * bs));
        }
    }
}

__device__ __forceinline__ float max3f(float a, float b, float c) { float r; asm("v_max3_f32 %0, %1, %2, %3" : "=v"(r) : "v"(a), "v"(b), "v"(c)); return r; }
__device__ __forceinline__ int crow(int r, int hi) { return (r & 3) + 8 * (r >> 2) + 4 * hi; }
__device__ __forceinline__ void phase_of1(const Ctx& C, const Args& A, int l) {
    const int i2 = l >> 1; unsigned char* ws = A.ws;
    const bf16_t* P = (const bf16_t*)(ws + WS_P); bf16_t* A2 = (bf16_t*)(ws + WS_A2); bf16_t* VT = (bf16_t*)(ws + WS_VT);
    const float* lng = A.in[I_GLNG] + (size_t)i2 * 256; const float* lnb = A.in[I_GLNB] + (size_t)i2 * 256;
    const float* gws = A.in[I_GWS] + (size_t)i2 * 4 * 128 * 128; const float* gbs = A.in[I_GBS] + (size_t)i2 * 4 * 128;
    LAS bf16_t* vt = (LAS bf16_t*)C.lds;
    LAS bf16_t* uL = (LAS bf16_t*)C.lds;
    LAS bf16_t* vT = (LAS bf16_t*)(C.lds + 128 * 528);
    const int r32 = C.lane & 31, hi = C.lane >> 5;
    for (int u = blockIdx.x; u < 264; u += C.G) {
        const bool isctx = u >= 256; const int uc = u - 256;
        const int b = isctx ? (uc >> 1) : (u >> 6), pos0 = isctx ? (uc & 1) * 128 : (u & 63) * 128;
        const int row0 = isctx ? NLAT + b * CTXL + pos0 : b * TT + pos0, L0 = isctx ? pos0 : CTXL + pos0;
        for (int hh = 0; hh < 6; ++hh) {
#pragma unroll
            for (int i = 0; i < 4; ++i) { const int piece = C.tid + NTHR * i, r = piece >> 4, part = piece & 15;
                *(LAS u32x4*)(vt + r * 136 + part * 8) = *(const u32x4*)(P + (size_t)(row0 + r) * P_LD + 1536 + hh * 128 + part * 8); }
            __syncthreads();
#pragma unroll
            for (int i = 0; i < 4; ++i) { const int item = C.tid + NTHR * i, d = item >> 4, tg = item & 15; const LAS bf16_t* s = vt + (tg * 8) * 136 + d;
                u32x4 o; o.x = (unsigned)s[0] | ((unsigned)s[136] << 16); o.y = (unsigned)s[2 * 136] | ((unsigned)s[3 * 136] << 16);
                o.z = (unsigned)s[4 * 136] | ((unsigned)s[5 * 136] << 16); o.w = (unsigned)s[6 * 136] | ((unsigned)s[7 * 136] << 16);
                *(u32x4*)(VT + ((size_t)(b * 6 + hh) * 128 + d) * LKEYS + L0 + tg * 8) = o; }
            __syncthreads();
        }
        for (int r = C.wave; r < 128; r += NWAVES) {
            const int c4 = 4 * C.lane; const bf16_t* pr = P + (size_t)(row0 + r) * P_LD + 2304;
            const f32x4 ur = ld4bf(pr + c4), raw = ld4bf(pr + 256 + c4);
            { const f32x4 gu = {gelu_erf(ur[0]), gelu_erf(ur[1]), gelu_erf(ur[2]), gelu_erf(ur[3])}; u32x2 o; o.x = pk2(gu[0], gu[1]); o.y = pk2(gu[2], gu[3]); *(LAS u32x2*)(uL + r * 264 + c4) = o; }
            const f32x4 gv = {gelu_erf(raw[0]), gelu_erf(raw[1]), gelu_erf(raw[2]), gelu_erf(raw[3])};
            const float mean = wave_sum((gv[0] + gv[1]) + (gv[2] + gv[3])) * (1.f / 256.f); const f32x4 dd = gv - mean;
            const float var = wave_sum((dd[0] * dd[0] + dd[1] * dd[1]) + (dd[2] * dd[2] + dd[3] * dd[3])) * (1.f / 256.f); const float rstd = rsqrtf(var + LN_EPS);
            const f32x4 o = dd * rstd * *(const f32x4*)(lng + c4) + *(const f32x4*)(lnb + c4);
#pragma unroll
            for (int k = 0; k < 4; ++k) vT[(c4 + k) * 136 + r] = (bf16_t)f2bf(o[k]);
        }
        __syncthreads();
        {
            const int g = C.wave >> 1, cblk = C.wave & 1, cc = g * 64 + cblk * 32 + r32;
            for (int pblk = 0; pblk < 4; ++pblk) {
                f32x16 acc;
#pragma unroll
                for (int i = 0; i < 16; ++i) acc[i] = 0.f;
                const float* wrow = gws + ((size_t)g * 128 + pblk * 32 + r32) * 128 + 8 * hi;
#pragma unroll
                for (int ks = 0; ks < 8; ++ks) { const f32x4 w0 = *(const f32x4*)(wrow + ks * 16), w1 = *(const f32x4*)(wrow + ks * 16 + 4);
                    u32x4 au; au.x = pk2(w0[0], w0[1]); au.y = pk2(w0[2], w0[3]); au.z = pk2(w1[0], w1[1]); au.w = pk2(w1[2], w1[3]);
                    const bf16x8 bf = *(const LAS bf16x8*)(vT + cc * 136 + ks * 16 + 8 * hi);
                    acc = __builtin_amdgcn_mfma_f32_32x32x16_bf16(__builtin_bit_cast(bf16x8, au), bf, acc, 0, 0, 0); }
#pragma unroll
                for (int reg = 0; reg < 16; ++reg) { const int p = pblk * 32 + crow(reg, hi);
                    const float uu = bf2f(uL[p * 264 + cc]); const float mixed = acc[reg] + gbs[g * 128 + p];
                    uL[p * 264 + cc] = (bf16_t)f2bf(uu * mixed); }
            }
        }
        __syncthreads();
#pragma unroll
        for (int i = 0; i < 8; ++i) { const int piece = C.tid + NTHR * i, r = piece >> 5, part = piece & 31;
            *(u32x4*)(A2 + (size_t)(row0 + r) * DM + 768 + part * 8) = *(const LAS u32x4*)(uL + r * 264 + part * 8); }
        __syncthreads();
    }
}

__device__ __forceinline__ void phase_attn(const Ctx& C, const Args& A, int l) {
    const int i2 = l >> 1; unsigned char* ws = A.ws;
    const bf16_t* Q = (const bf16_t*)(ws + WS_Q); const bf16_t* KA = (const bf16_t*)(ws + WS_KA); const bf16_t* VT = (const bf16_t*)(ws + WS_VT); bf16_t* A2 = (bf16_t*)(ws + WS_A2);
    const float lam_init = 0.8f - 0.6f * expf(-0.3f * (float)l);
    float s1 = 0.f, s2 = 0.f;
    for (int j = 0; j < 64; ++j) { s1 += A.in[I_LQ1][i2 * 64 + j] * A.in[I_LK1][i2 * 64 + j]; s2 += A.in[I_LQ2][i2 * 64 + j] * A.in[I_LK2][i2 * 64 + j]; }
    const float lam = expf(s1) - expf(s2) + lam_init;
    const float* subg = A.in[I_SUBG] + (size_t)i2 * 128;
    const int r32 = C.lane & 31, hi = C.lane >> 5, map = C.wave >> 2, qw = C.wave & 3;
    LAS unsigned char* Kt = C.lds; LAS unsigned char* Vt = C.lds + 2 * 17408; LAS float* xch = (LAS float*)C.lds;
    const int NU = 1536 + (l == 1 ? 48 : 0);
    for (int n = C.vcu; n < NU; n += C.G) {
        int bh, qt; bool isctx = false;
        if (n < 1536) { const int round = n >> 8, slot = n & 255; bh = (slot >> 5) * 3 + (round >> 1); qt = (round & 1) * 32 + (slot & 31); }
        else { isctx = true; bh = (n - 1536) >> 1; qt = (n - 1536) & 1; }
        const int b = bh / 6, h = bh % 6;
        const int qrow0 = isctx ? NLAT + b * CTXL + qt * 128 : b * TT + qt * 128;
        const int NT = isctx ? CTXL / 64 : LKEYS / 64;
        const bf16_t* Kb = KA + (size_t)b * LKEYS * 768 + h * 128;
        const bf16_t* Vb = VT + (size_t)(b * 6 + h) * 128 * LKEYS;
        bf16x8 qf[4];
        { const bf16_t* qp = Q + (size_t)(qrow0 + qw * 32 + r32) * 768 + h * 128 + map * 64 + 8 * hi;
#pragma unroll
          for (int ks = 0; ks < 4; ++ks) qf[ks] = *(const bf16x8*)(qp + ks * 16); }
        f32x16 O[4];
#pragma unroll
        for (int d = 0; d < 4; ++d)
#pragma unroll
            for (int i = 0; i < 16; ++i) O[d][i] = 0.f;
        float m = -1e30f, lsum = 0.f;
        u32x4 kreg[2], vreg[2];
#define AT_LOAD(t) do { _Pragma("unroll") for (int i = 0; i < 2; ++i) { const int piece = C.tid + NTHR * i; \
            kreg[i] = *(const u32x4*)(Kb + (size_t)((t) * 64 + (piece >> 4)) * 768 + (piece & 15) * 8); \
            vreg[i] = *(const u32x4*)(Vb + (size_t)(piece >> 3) * LKEYS + (t) * 64 + (piece & 7) * 8); } } while (0)
#define AT_STORE(bi) do { _Pragma("unroll") for (int i = 0; i < 2; ++i) { const int piece = C.tid + NTHR * i; \
            *(LAS u32x4*)(Kt + (bi) * 17408 + (piece >> 4) * 272 + (piece & 15) * 16) = kreg[i]; \
            LAS unsigned char* vd = Vt + (bi) * 17408 + (piece >> 3) * 136 + (piece & 7) * 16; \
            *(LAS u32x2*)vd = (u32x2){vreg[i].x, vreg[i].y}; *(LAS u32x2*)(vd + 8) = (u32x2){vreg[i].z, vreg[i].w}; } } while (0)
        AT_LOAD(0); AT_STORE(0); __syncthreads();
        for (int t = 0; t < NT; ++t) {
            if (t + 1 < NT) AT_LOAD(t + 1);
            const int bi = t & 1;
            const LAS unsigned char* kb = Kt + bi * 17408 + r32 * 272 + map * 128 + hi * 16;
            const LAS unsigned char* vb = Vt + bi * 17408 + r32 * 136 + hi * 8;
            bf16x8 kf[8];
#pragma unroll
            for (int ks = 0; ks < 4; ++ks) { kf[2 * ks] = *(const LAS bf16x8*)(kb + ks * 32); kf[2 * ks + 1] = *(const LAS bf16x8*)(kb + 32 * 272 + ks * 32); }
            u32x4 va[4], vc[4];
#define AT_LDV(dst, d) do { _Pragma("unroll") for (int kst = 0; kst < 4; ++kst) { const LAS unsigned char* vp = vb + (d) * (32 * 136) + kst * 32; \
                const u32x2 lo = *(const LAS u32x2*)vp, hh = *(const LAS u32x2*)(vp + 16); dst[kst] = (u32x4){lo.x, lo.y, hh.x, hh.y}; } } while (0)
#define AT_PV(src, d) do { _Pragma("unroll") for (int kst = 0; kst < 4; ++kst) O[d] = __builtin_amdgcn_mfma_f32_32x32x16_bf16(__builtin_bit_cast(bf16x8, src[kst]), pb[kst], O[d], 0, 0, 0); } while (0)
            AT_LDV(va, 0);
            __builtin_amdgcn_sched_barrier(0);
            f32x16 p0, p1;
#pragma unroll
            for (int i = 0; i < 16; ++i) { p0[i] = 0.f; p1[i] = 0.f; }
#pragma unroll
            for (int ks = 0; ks < 4; ++ks) { p0 = __builtin_amdgcn_mfma_f32_32x32x16_bf16(kf[2 * ks], qf[ks], p0, 0, 0, 0); p1 = __builtin_amdgcn_mfma_f32_32x32x16_bf16(kf[2 * ks + 1], qf[ks], p1, 0, 0, 0); }
            asm volatile("s_nop 15\n\ts_nop 7" : "+v"(p0), "+v"(p1));
            float mx = max3f(p0[0], p0[1], p1[0]), mx2 = max3f(p0[2], p0[3], p1[1]); mx = max3f(mx, p1[2], p1[3]);
#pragma unroll
            for (int i = 4; i < 16; i += 4) { mx = max3f(mx, p0[i], p0[i + 1]); mx2 = max3f(mx2, p0[i + 2], p0[i + 3]); mx = max3f(mx, p1[i], p1[i + 1]); mx2 = max3f(mx2, p1[i + 2], p1[i + 3]); }
            mx = max3f(mx, mx2, m);
            { auto rr = __builtin_amdgcn_permlane32_swap(__float_as_uint(mx), __float_as_uint(mx), false, false); mx = fmaxf(__uint_as_float(rr[0]), __uint_as_float(rr[1])); }
            const float mnew = mx;
            if (__any(mnew > m)) { const float sc = __builtin_amdgcn_exp2f(m - mnew); lsum *= sc;
#pragma unroll
                for (int d = 0; d < 4; ++d)
#pragma unroll
                    for (int i = 0; i < 16; ++i) O[d][i] *= sc;
                m = mnew; }
            float ps = 0.f, ps2 = 0.f;
#pragma unroll
            for (int i = 0; i < 16; ++i) { p0[i] = __builtin_amdgcn_exp2f(p0[i] - m); p1[i] = __builtin_amdgcn_exp2f(p1[i] - m); ps += p0[i]; ps2 += p1[i]; }
            lsum += ps + ps2;
            bf16x8 pb[4];
            { u32x4 w; w.x = pk2(p0[0], p0[1]); w.y = pk2(p0[2], p0[3]); w.z = pk2(p0[4], p0[5]); w.w = pk2(p0[6], p0[7]); pb[0] = __builtin_bit_cast(bf16x8, w);
              w.x = pk2(p0[8], p0[9]); w.y = pk2(p0[10], p0[11]); w.z = pk2(p0[12], p0[13]); w.w = pk2(p0[14], p0[15]); pb[1] = __builtin_bit_cast(bf16x8, w);
              w.x = pk2(p1[0], p1[1]); w.y = pk2(p1[2], p1[3]); w.z = pk2(p1[4], p1[5]); w.w = pk2(p1[6], p1[7]); pb[2] = __builtin_bit_cast(bf16x8, w);
              w.x = pk2(p1[8], p1[9]); w.y = pk2(p1[10], p1[11]); w.z = pk2(p1[12], p1[13]); w.w = pk2(p1[14], p1[15]); pb[3] = __builtin_bit_cast(bf16x8, w); }
            __builtin_amdgcn_sched_barrier(0);
            AT_LDV(vc, 1); __builtin_amdgcn_sched_barrier(0); AT_PV(va, 0); __builtin_amdgcn_sched_barrier(0);
            AT_LDV(va, 2); __builtin_amdgcn_sched_barrier(0); AT_PV(vc, 1); __builtin_amdgcn_sched_barrier(0);
            AT_LDV(vc, 3); __builtin_amdgcn_sched_barrier(0); AT_PV(va, 2); __builtin_amdgcn_sched_barrier(0);
            AT_PV(vc, 3);
            if (t + 1 < NT) AT_STORE((t + 1) & 1);
            __syncthreads();
        }
#undef AT_LDV
#undef AT_PV
#undef AT_LOAD
#undef AT_STORE
        const float ltot = lsum + __shfl_xor(lsum, 32);
        const float invl = 1.f / ltot;
        if (map == 1) { const float f = lam * invl;
#pragma unroll
            for (int d = 0; d < 4; ++d)
#pragma unroll
                for (int i = 0; i < 16; ++i) xch[(qw * 64 + d * 16 + i) * 64 + C.lane] = O[d][i] * f; }
        __syncthreads();
        if (map == 0) { float ss = 0.f;
#pragma unroll
            for (int d = 0; d < 4; ++d)
#pragma unroll
                for (int i = 0; i < 16; ++i) { const float o = O[d][i] * invl - xch[(qw * 64 + d * 16 + i) * 64 + C.lane]; O[d][i] = o; ss += o * o; }
            ss += __shfl_xor(ss, 32);
            const float rn = rsqrtf(ss * (1.f / 128.f) + RMS_EPS) * (1.f - lam_init);
            bf16_t* orow = A2 + (size_t)(qrow0 + qw * 32 + r32) * DM + h * 128;
#pragma unroll
            for (int d = 0; d < 4; ++d)
#pragma unroll
                for (int g4 = 0; g4 < 4; ++g4) { const int dd = 32 * d + 8 * g4 + 4 * hi; const f32x4 sg = *(const f32x4*)(subg + dd);
                    const f32x4 v = {O[d][4 * g4] * rn * sg[0], O[d][4 * g4 + 1] * rn * sg[1], O[d][4 * g4 + 2] * rn * sg[2], O[d][4 * g4 + 3] * rn * sg[3]};
                    st4bf(orow + dd, v); } }
        __syncthreads();
    }
}

__device__ __forceinline__ void phase_rt(const Ctx& C, const Args& A, int l) {
    unsigned char* ws = A.ws; float* X = (float*)(ws + WS_X); bf16_t* H = (bf16_t*)(ws + WS_H); float* AFF = (float*)(ws + WS_AFF);
    const float* MOD = (const float*)(ws + WS_MOD) + (size_t)l * 5 * 6144;
    const float* lng = A.in[I_LNG] + (size_t)(l * 2 + 0) * DM; const float* lnb = A.in[I_LNB] + (size_t)(l * 2 + 0) * DM;
    LAS float* wrs = (LAS float*)C.lds;
    { const float* wr = A.in[I_WR] + (size_t)l * DM * 16; for (int i = C.tid; i < DM * 16; i += NTHR) wrs[(i & 15) * 1024 + (i >> 4)] = wr[i]; }
    __syncthreads();
    for (int row = C.gw; row < MROWS; row += C.NGW) {
        const float* md = MOD + row_mi(row) * 6144;
        f32x4 x[4]; float s = 0.f;
#pragma unroll
        for (int j = 0; j < 4; ++j) { x[j] = *(const f32x4*)(X + (size_t)row * DM + 4 * C.lane + 256 * j); s += (x[j][0] + x[j][1]) + (x[j][2] + x[j][3]); }
        const float mean = wave_sum(s) * (1.f / DM); float s2 = 0.f;
#pragma unroll
        for (int j = 0; j < 4; ++j) { x[j] = x[j] - mean; s2 += (x[j][0] * x[j][0] + x[j][1] * x[j][1]) + (x[j][2] * x[j][2] + x[j][3] * x[j][3]); }
        const float rstd = rsqrtf(wave_sum(s2) * (1.f / DM) + LN_EPS);
        float v[16];
#pragma unroll
        for (int e = 0; e < 16; ++e) v[e] = 0.f;
#pragma unroll
        for (int j = 0; j < 4; ++j) { const int col = 4 * C.lane + 256 * j;
            const f32x4 x1 = x[j] * rstd * *(const f32x4*)(lng + col) + *(const f32x4*)(lnb + col);
            *(f32x4*)(X + (size_t)row * DM + col) = x1;
            const f32x4 h = x1 * (*(const f32x4*)(md + 4 * DM + col) + 1.f) + *(const f32x4*)(md + 3 * DM + col);
            st4bf(H + (size_t)row * DM + col, h);
#pragma unroll
            for (int e = 0; e < 16; ++e) { const f32x4 w = *(const LAS f32x4*)(wrs + e * 1024 + col); v[e] += (h[0] * w[0] + h[1] * w[1]) + (h[2] * w[2] + h[3] * w[3]); }
            __builtin_amdgcn_sched_barrier(0); }
#pragma unroll
        for (int i = 0; i < 8; ++i) { const float send = (C.lane & 32) ? v[i] : v[i + 8], keep = (C.lane & 32) ? v[i + 8] : v[i]; v[i] = keep + __shfl_xor(send, 32); }
#pragma unroll
        for (int i = 0; i < 4; ++i) { const float send = (C.lane & 16) ? v[i] : v[i + 4], keep = (C.lane & 16) ? v[i + 4] : v[i]; v[i] = keep + __shfl_xor(send, 16); }
#pragma unroll
        for (int i = 0; i < 2; ++i) { const float send = (C.lane & 8) ? v[i] : v[i + 2], keep = (C.lane & 8) ? v[i + 2] : v[i]; v[i] = keep + __shfl_xor(send, 8); }
        { const float send = (C.lane & 4) ? v[0] : v[1], keep = (C.lane & 4) ? v[1] : v[0]; v[0] = keep + __shfl_xor(send, 4); }
        float z = v[0]; z += __shfl_xor(z, 1); z += __shfl_xor(z, 2);
        float mx = z;
#pragma unroll
        for (int o = 4; o < 64; o <<= 1) mx = fmaxf(mx, __shfl_xor(mx, o));
        const float ex = expf(z - mx); float sm = ex;
#pragma unroll
        for (int o = 4; o < 64; o <<= 1) sm += __shfl_xor(sm, o);
        if ((C.lane & 3) == 0) AFF[(size_t)row * 16 + (C.lane >> 2)] = ex / sm;
    }
}

__device__ __forceinline__ void phase_tk(const Ctx& C, const Args& A) {
    unsigned char* ws = A.ws; const float* AFF = (const float*)(ws + WS_AFF); int* SLOT = (int*)(ws + WS_SLOT); int* IDX = (int*)(ws + WS_IDX); float* GATE = (float*)(ws + WS_GATE);
    LAS unsigned* key = (LAS unsigned*)C.lds;
    LAS unsigned* hist = key + 8192;
    LAS unsigned* scn = hist + 256;
    LAS unsigned* wtot = scn + 256;
    LAS unsigned* bc = wtot + 8;
    for (int u = blockIdx.x; u < 128; u += C.G) {
        const bool isctx = u >= 64; const int uu = u & 63, b = uu >> 4, e = uu & 15;
        const int n = isctx ? CTXL : TT, cap = isctx ? CAP_C : CAP_L;
        const int row0 = isctx ? NLAT + b * CTXL : b * TT;
        const int slot0 = e * ESLOTS + (isctx ? 4 * CAP_L + b * CAP_C : b * CAP_L);
        for (int i = C.tid; i < n; i += NTHR) key[i] = __float_as_uint(AFF[(size_t)(row0 + i) * 16 + e]);
        unsigned prefix = 0u, pmask = 0u; int need = cap;
        for (int pass = 0; pass < 4; ++pass) {
            const int shift = 24 - 8 * pass;
            if (C.tid < 256) hist[C.tid] = 0u;
            __syncthreads();
            for (int i = C.tid; i < n; i += NTHR) { const unsigned k = key[i]; if ((k & pmask) == prefix) __hip_atomic_fetch_add(&hist[(k >> shift) & 255u], 1u, __ATOMIC_RELAXED, __HIP_MEMORY_SCOPE_WORKGROUP); }
            __syncthreads();
            if (C.tid < 256) scn[C.tid] = hist[C.tid];
            __syncthreads();
            for (int off = 1; off < 256; off <<= 1) {
                unsigned a = 0u; if (C.tid < 256 && C.tid + off < 256) a = scn[C.tid + off];
                __syncthreads();
                if (C.tid < 256) scn[C.tid] += a;
                __syncthreads();
            }
            if (C.tid < 256) { const unsigned above = (C.tid < 255) ? scn[C.tid + 1] : 0u;
                if (scn[C.tid] >= (unsigned)need && above < (unsigned)need) { bc[0] = (unsigned)C.tid; bc[1] = (unsigned)need - above; } }
            __syncthreads();
            prefix |= bc[0] << shift; pmask |= 255u << shift; need = (int)bc[1];
            __syncthreads();
        }
        const int per = (n + NTHR - 1) / NTHR; const int i0 = C.tid * per;
        unsigned cg = 0u, ce = 0u;
        for (int j = 0; j < per; ++j) { const int i = i0 + j; if (i < n) { const unsigned k = key[i]; cg += (k > prefix); ce += (k == prefix); } }
        unsigned pk = cg | (ce << 16), inc = pk;
#pragma unroll
        for (int o = 1; o < 64; o <<= 1) { const unsigned t = __shfl_up(inc, o); if (C.lane >= o) inc += t; }
        if (C.lane == 63) wtot[C.wave] = inc;
        __syncthreads();
        unsigned wbase = 0u;
        for (int w = 0; w < C.wave; ++w) wbase += wtot[w];
        const unsigned excl = wbase + inc - pk;
        unsigned rg = excl & 0xffffu, re = excl >> 16;
        const int ngt = cap - need;
        for (int j = 0; j < per; ++j) { const int i = i0 + j; if (i < n) { const unsigned k = key[i]; int pos = -1;
            if (k > prefix) { pos = (int)rg; ++rg; } else if (k == prefix) { if ((int)re < need) pos = ngt + (int)re; ++re; }
            const int row = row0 + i;
            if (pos >= 0) { IDX[slot0 + pos] = row; GATE[slot0 + pos] = __uint_as_float(k); SLOT[(size_t)row * 16 + e] = slot0 + pos; }
            else SLOT[(size_t)row * 16 + e] = -1; } }
        if (isctx && b == 0 && C.tid < ESLOTS - 4224) { IDX[e * ESLOTS + 4224 + C.tid] = 0; GATE[e * ESLOTS + 4224 + C.tid] = 0.f; }
        __syncthreads();
    }
}

__device__ __forceinline__ void phase_cb(const Ctx& C, const Args& A, int l) {
    unsigned char* ws = A.ws; float* X = (float*)(ws + WS_X); bf16_t* H = (bf16_t*)(ws + WS_H); const int* SLOT = (const int*)(ws + WS_SLOT); const bf16_t* YE = (const bf16_t*)(ws + WS_YE);
    const float* MOD = (const float*)(ws + WS_MOD) + (size_t)l * 5 * 6144; const float* MODN = MOD + 5 * 6144;
    const float* lng = A.in[I_LNG] + (size_t)(l * 2 + 1) * DM; const float* lnb = A.in[I_LNB] + (size_t)(l * 2 + 1) * DM;
    for (int row = C.gw; row < MROWS; row += C.NGW) {
        const int mi = row_mi(row); const float* md = MOD + mi * 6144;
        f32x4 acc[4];
#pragma unroll
        for (int j = 0; j < 4; ++j) acc[j] = (f32x4){0.f, 0.f, 0.f, 0.f};
        for (int e = 0; e < 16; ++e) { const int s = __builtin_amdgcn_readfirstlane(SLOT[(size_t)row * 16 + e]);
            if (s >= 0) {
#pragma unroll
                for (int j = 0; j < 4; ++j) acc[j] += ld4bf(YE + (size_t)s * DM + 4 * C.lane + 256 * j); } }
        f32x4 x[4]; float sm = 0.f;
#pragma unroll
        for (int j = 0; j < 4; ++j) { const int col = 4 * C.lane + 256 * j; x[j] = *(const f32x4*)(X + (size_t)row * DM + col) * ALPHA_DN + *(const f32x4*)(md + 5 * DM + col) * acc[j];
            sm += (x[j][0] + x[j][1]) + (x[j][2] + x[j][3]); }
        const float mean = wave_sum(sm) * (1.f / DM); float s2 = 0.f;
#pragma unroll
        for (int j = 0; j < 4; ++j) { x[j] = x[j] - mean; s2 += (x[j][0] * x[j][0] + x[j][1] * x[j][1]) + (x[j][2] * x[j][2] + x[j][3] * x[j][3]); }
        const float rstd = rsqrtf(wave_sum(s2) * (1.f / DM) + LN_EPS);
#pragma unroll
        for (int j = 0; j < 4; ++j) { const int col = 4 * C.lane + 256 * j;
            const f32x4 x2 = x[j] * rstd * *(const f32x4*)(lng + col) + *(const f32x4*)(lnb + col);
            *(f32x4*)(X + (size_t)row * DM + col) = x2;
            if (l < DEPTH - 1) { const float* mn = MODN + mi * 6144; st4bf(H + (size_t)row * DM + col, x2 * (*(const f32x4*)(mn + DM + col) + 1.f) + *(const f32x4*)(mn + col)); }
            else if (row < NLAT) *(f32x4*)(A.out + (size_t)row * DM + col) = x2; }
    }
}


#ifndef GEMM_NOINLINE
#define GEMM_NOINLINE 0
#endif
#if GEMM_NOINLINE
#define GEMM_FN __device__ __noinline__
#else
#define GEMM_FN __device__ __forceinline__
#endif
GEMM_FN void gphase_in(LAS unsigned char* lds, unsigned char* ws, int nN, int G) {
    pg8::Gemm g{(const bf16_t*)(ws + WS_H), (const bf16_t*)(ws + WS_WIN), DM}; pg8::Order<0> S; S.init(MROWS / 256, nN, G, (int)blockIdx.x, nullptr, 0);
    pg8::EpiBf16 E{(bf16_t*)(ws + WS_P), P_LD}; pg8::gemm_phase(lds, g, S, E); }
GEMM_FN void gphase_in_odd(LAS unsigned char* lds, unsigned char* ws, int G) {
    pg8::Gemm g{(const bf16_t*)(ws + WS_H), (const bf16_t*)(ws + WS_WIN), DM}; pg8::Order<0> S; S.init(MROWS / 256, D_IN_ODD / 256, G, (int)blockIdx.x, nullptr, 0);
    pg8::EpiOdd E{(bf16_t*)(ws + WS_P), (bf16_t*)(ws + WS_Q), (bf16_t*)(ws + WS_KA), (const float*)(ws + WS_ROPE)}; pg8::gemm_phase(lds, g, S, E); }
GEMM_FN void gphase_lora(LAS unsigned char* lds, unsigned char* ws, const float* d0, const float* a0, const float* kal, int G) {
    pg8::Gemm g{(const bf16_t*)(ws + WS_LIN), (const bf16_t*)(ws + WS_WLORA), LORA_K}; pg8::Order<0> S; S.init(MROWS / 256, LORA_N / 256, G, (int)blockIdx.x, nullptr, 0);
    pg8::EpiLora E{(float*)(ws + WS_SCN), (bf16_t*)(ws + WS_G), d0, a0, kal}; pg8::gemm_phase(lds, g, S, E); }
GEMM_FN void gphase_out(LAS unsigned char* lds, unsigned char* ws, const float* modl, int G) {
    pg8::Gemm g{(const bf16_t*)(ws + WS_A2), (const bf16_t*)(ws + WS_WOUT), DM}; pg8::Order<0> S; S.init(MROWS / 256, DM / 256, G, (int)blockIdx.x, nullptr, 0);
    pg8::EpiRes E{(float*)(ws + WS_X), modl}; pg8::gemm_phase(lds, g, S, E); }
GEMM_FN void gphase_e1(LAS unsigned char* lds, unsigned char* ws, int G) {
    pg8::Gemm g{(const bf16_t*)(ws + WS_H), (const bf16_t*)(ws + WS_WE13), DM}; pg8::Order<1> S; S.init(NEXP * 17, 4096 / 256, G, (int)blockIdx.x, (const int*)(ws + WS_IDX), (long)4096 * DM);
    pg8::EpiSwiGLU E{(bf16_t*)(ws + WS_HID)}; pg8::gemm_phase(lds, g, S, E); }
GEMM_FN void gphase_e2(LAS unsigned char* lds, unsigned char* ws, int G) {
    pg8::Gemm g{(const bf16_t*)(ws + WS_HID), (const bf16_t*)(ws + WS_WE2), D_EXP}; pg8::Order<2> S; S.init(NEXP * 17, DM / 256, G, (int)blockIdx.x, nullptr, (long)DM * D_EXP);
    pg8::EpiYE E{(bf16_t*)(ws + WS_YE), (const float*)(ws + WS_GATE)}; pg8::gemm_phase(lds, g, S, E); }

constexpr int NSTEP = 1 + DEPTH * 12;
__global__ void __launch_bounds__(NTHR, 2) mk_fwd(Args KA) {
    extern __shared__ __attribute__((aligned(16))) unsigned char lds_raw[];
    volatile LAS unsigned* MISC = (volatile LAS unsigned*)((LAS unsigned char*)lds_raw + LDS_MISC);
    if (threadIdx.x < 16) MISC[threadIdx.x] = 0u;
    if (threadIdx.x == 0) { LAS unsigned long long* tb = (LAS unsigned long long*)((LAS unsigned char*)lds_raw + LDS_PTAB);
#pragma unroll
        for (int i = 0; i < 37; ++i) tb[i] = (unsigned long long)KA.in[i];
        tb[37] = (unsigned long long)KA.out; tb[38] = (unsigned long long)KA.ws; }
    __syncthreads();
    const int lo = KA.lo, hi = KA.hi;
    unsigned bar_x = 0;
    if (hi - lo > 1) { const XcdBarrier b0 = xcd_barrier_post((unsigned*)(KA.ws + WS_CTL), MISC); bar_x = b0.x; }
#ifndef PH_MASK
#define PH_MASK 0xFFFFFF
#endif
#ifndef REP_MASK
#define REP_MASK 0
#endif
#define PH_BIT(k) (((k) == 0) ? 0 : 1 + ((k) - 1) % 12 + (((k) - 1) % 12 >= 2 && ((k) - 1) % 12 <= 5 && odd ? 12 : 0))
#define RUN(k, ...) do { if (((PH_MASK >> PH_BIT(k)) & 1) && lo <= (k) && (k) < hi) { const int nrep = ((REP_MASK >> PH_BIT(k)) & 1) ? 2 : 1; \
        _Pragma("unroll 1") for (int rep = 0; rep < nrep; ++rep) { \
        Ctx C; mkctx(C, (LAS unsigned char*)lds_raw); Args A; ldargs(A, (LAS unsigned char*)lds_raw); unsigned char* ws = A.ws; \
        const float* MODL = (const float*)(ws + WS_MOD) + (size_t)l * 5 * 6144; (void)MODL; \
        __VA_ARGS__; if ((k) + 1 < hi || rep + 1 < nrep) { XcdBarrier bar; bar.bar = (unsigned*)(ws + WS_CTL); bar.x = bar_x; bar.st = MISC; xcd_barrier(bar); } } } } while (0)
    { const bool odd = false; const int l = 0; RUN(0, phase_init(C, A)); }
#pragma unroll 1
    for (int l = 0; l < DEPTH; ++l) {
        const int sb = 1 + l * 12; const bool odd = l & 1;
        RUN(sb + 0, { phase_conv(C, A, l); if (l == 0) phase_modh(C, A, 0); });
        if (odd) { RUN(sb + 1, gphase_in_odd(C.lds, ws, C.G)); } else { RUN(sb + 1, gphase_in(C.lds, ws, D_IN_EVEN_PAD / 256, C.G)); }
        if (!odd) {
            RUN(sb + 2, phase_ef1(C, A, l));
            RUN(sb + 3, { const int i2 = l >> 1; gphase_lora(C.lds, ws, A.in[I_D0] + (size_t)i2 * 2 * 768, A.in[I_A0] + (size_t)i2 * 2 * 768, A.in[I_KAL] + (size_t)i2 * 768, C.G); });
            RUN(sb + 4, phase_scan(C, A));
            RUN(sb + 5, phase_ef2(C, A, l));
        } else {
            RUN(sb + 2, phase_of1(C, A, l));
            RUN(sb + 3, phase_attn(C, A, l));
        }
        RUN(sb + 6, gphase_out(C.lds, ws, MODL, C.G));
        RUN(sb + 7, phase_rt(C, A, l));
        RUN(sb + 8, phase_tk(C, A));
        RUN(sb + 9, gphase_e1(C.lds, ws, C.G));
        RUN(sb + 10, gphase_e2(C.lds, ws, C.G));
        RUN(sb + 11, phase_cb(C, A, l));
    }
#undef RUN
}

#ifdef PHASE_PROBE
#define PROBE_PRE extern __shared__ __attribute__((aligned(16))) unsigned char lds_raw[]; Ctx C; mkctx(C, (LAS unsigned char*)lds_raw); unsigned char* ws = A.ws; (void)ws;
__global__ void __launch_bounds__(NTHR, 2) pr_init(Args A) { PROBE_PRE phase_init(C, A); }
__global__ void __launch_bounds__(NTHR, 2) pr_conv(Args A) { PROBE_PRE phase_conv(C, A, A.lo); }
__global__ void __launch_bounds__(NTHR, 2) pr_modh(Args A) { PROBE_PRE phase_modh(C, A, A.lo); }
__global__ void __launch_bounds__(NTHR, 2) pr_ef1(Args A) { PROBE_PRE phase_ef1(C, A, A.lo); }
__global__ void __launch_bounds__(NTHR, 2) pr_scan(Args A) { PROBE_PRE phase_scan(C, A); }
__global__ void __launch_bounds__(NTHR, 2) pr_ef2(Args A) { PROBE_PRE phase_ef2(C, A, A.lo); }
__global__ void __launch_bounds__(NTHR, 2) pr_of1(Args A) { PROBE_PRE phase_of1(C, A, A.lo); }
__global__ void __launch_bounds__(NTHR, 2) pr_attn(Args A) { PROBE_PRE phase_attn(C, A, A.lo); }
__global__ void __launch_bounds__(NTHR, 2) pr_rt(Args A) { PROBE_PRE phase_rt(C, A, A.lo); }
__global__ void __launch_bounds__(NTHR, 2) pr_tk(Args A) { PROBE_PRE phase_tk(C, A); }
__global__ void __launch_bounds__(NTHR, 2) pr_cb(Args A) { PROBE_PRE phase_cb(C, A, A.lo); }
__global__ void __launch_bounds__(NTHR, 2) pr_gemm_in(Args A) { PROBE_PRE pg8::Gemm g{(const bf16_t*)(ws + WS_H), (const bf16_t*)(ws + WS_WIN), DM}; pg8::Order<0> S; S.init(MROWS / 256, A.lo, C.G, (int)blockIdx.x, nullptr, 0);
                      pg8::EpiBf16 E{(bf16_t*)(ws + WS_P), P_LD}; pg8::gemm_phase(C.lds, g, S, E); }
__global__ void __launch_bounds__(NTHR, 2) pr_gemm_lora(Args A) { PROBE_PRE pg8::Gemm g{(const bf16_t*)(ws + WS_LIN), (const bf16_t*)(ws + WS_WLORA), LORA_K}; pg8::Order<0> S; S.init(MROWS / 256, LORA_N / 256, C.G, (int)blockIdx.x, nullptr, 0);
                          const int i2 = A.lo; pg8::EpiLora E{(float*)(ws + WS_SCN), (bf16_t*)(ws + WS_G), A.in[I_D0] + (size_t)i2 * 2 * 768, A.in[I_A0] + (size_t)i2 * 2 * 768, A.in[I_KAL] + (size_t)i2 * 768};
                          pg8::gemm_phase(C.lds, g, S, E); }
__global__ void __launch_bounds__(NTHR, 2) pr_gemm_out(Args A) { PROBE_PRE pg8::Gemm g{(const bf16_t*)(ws + WS_A2), (const bf16_t*)(ws + WS_WOUT), DM}; pg8::Order<0> S; S.init(MROWS / 256, DM / 256, C.G, (int)blockIdx.x, nullptr, 0);
                      pg8::EpiRes E{(float*)(ws + WS_X), (const float*)(ws + WS_MOD)}; pg8::gemm_phase(C.lds, g, S, E); }
__global__ void __launch_bounds__(NTHR, 2) pr_gemm_e1(Args A) { PROBE_PRE pg8::Gemm g{(const bf16_t*)(ws + WS_H), (const bf16_t*)(ws + WS_WE13), DM}; pg8::Order<1> S; S.init(NEXP * 17, 4096 / 256, C.G, (int)blockIdx.x, (const int*)(ws + WS_IDX), (long)4096 * DM);
                      pg8::EpiSwiGLU E{(bf16_t*)(ws + WS_HID)}; pg8::gemm_phase(C.lds, g, S, E); }
__global__ void __launch_bounds__(NTHR, 2) pr_gemm_e2(Args A) { PROBE_PRE pg8::Gemm g{(const bf16_t*)(ws + WS_HID), (const bf16_t*)(ws + WS_WE2), D_EXP}; pg8::Order<2> S; S.init(NEXP * 17, DM / 256, C.G, (int)blockIdx.x, nullptr, (long)DM * D_EXP);
                       pg8::EpiYE E{(bf16_t*)(ws + WS_YE), (const float*)(ws + WS_GATE)}; pg8::gemm_phase(C.lds, g, S, E); }
#endif

extern "C" void kernel_launch(void* const* d_in, const int* in_sizes, int n_in, void* d_out, int out_size, void* d_ws, size_t ws_size, hipStream_t stream) {
    static int grid = 0;
    if (grid == 0) {
        if (n_in != 37 || out_size != NLAT * DM || ws_size < WS_END) { fprintf(stderr, "kernel_launch: unexpected shapes: n_in %d out %d ws %zu (need %zu)\n", n_in, out_size, ws_size, (size_t)WS_END); grid = -1; return; }
        int dev = 0, cus = 0, per_cu = 0;
        if (hipGetDevice(&dev) != hipSuccess || hipDeviceGetAttribute(&cus, hipDeviceAttributeMultiprocessorCount, dev) != hipSuccess) { grid = -1; return; }
        if (hipFuncSetAttribute((const void*)mk_fwd, hipFuncAttributeMaxDynamicSharedMemorySize, LDS_BYTES) != hipSuccess) { fprintf(stderr, "kernel_launch: hipFuncSetAttribute failed\n"); grid = -1; return; }
        if (hipOccupancyMaxActiveBlocksPerMultiprocessor(&per_cu, (const void*)mk_fwd, NTHR, LDS_BYTES) != hipSuccess || per_cu < 1) fprintf(stderr, "kernel_launch: occupancy query reports %d\n", per_cu);
        (void)hipGetLastError();
        grid = cus;
    }
    if (grid < 0) return;
    (void)hipMemsetAsync((char*)d_ws + WS_CTL, 0, CTL_BYTES, stream);
    Args a{};
    for (int i = 0; i < 37; ++i) a.in[i] = (const float*)d_in[i];
    a.out = (float*)d_out; a.ws = (unsigned char*)d_ws;
#if MK_MULTI
    for (int k = 0; k < NSTEP; ++k) {
        if (k >= 1) { const int l = (k - 1) / 12, s = (k - 1) % 12; if ((l & 1) && (s == 4 || s == 5)) continue; }
        a.lo = k; a.hi = k + 1;
        hipLaunchKernelGGL(mk_fwd, dim3(grid), dim3(NTHR), LDS_BYTES, stream, a);
    }
#else
    a.lo = 0; a.hi = NSTEP;
    hipLaunchKernelGGL(mk_fwd, dim3(grid), dim3(NTHR), LDS_BYTES, stream, a);
#endif
    const hipError_t le = hipPeekAtLastError();
    if (le != hipSuccess) fprintf(stderr, "kernel_launch: launch failed: %s\n", hipGetErrorName(le));
}
```

```cpp
#include <hip/hip_runtime.h>
#include <cstdio>
#include <cstdint>
#include <cmath>

#ifndef MK_MULTI
#define MK_MULTI 0
#endif

#define GAS __attribute__((address_space(1)))
#define LAS __attribute__((address_space(3)))
typedef unsigned short bf16_t;
typedef short bf16x8 __attribute__((ext_vector_type(8)));
typedef float f32x4 __attribute__((ext_vector_type(4)));
typedef float f32x2 __attribute__((ext_vector_type(2)));
typedef float f32x16 __attribute__((ext_vector_type(16)));
typedef unsigned u32x4 __attribute__((ext_vector_type(4)));
typedef unsigned u32x2 __attribute__((ext_vector_type(2)));
typedef __bf16 bf16x2_t __attribute__((ext_vector_type(2)));

constexpr int NB = 4, TT = 8192, DM = 1024, NLAT = NB * TT, CTXL = 256, NCTX = NB * CTXL, MROWS = NLAT + NCTX;
constexpr int DEPTH = 4;
constexpr int D_CONV = 256, RW_H = 12, RW_K = 64, D_RWKV = 768, RWKV_COLS = 2688, D_IN_EVEN = 3456, D_IN_EVEN_PAD = 3584;
constexpr int D_DIFF = 768, D_GMLP = 256, D_IN_ODD = 2816;
constexpr int NEXP = 16, D_EXP = 2048, CAP_L = 1024, CAP_C = 32, ESLOTS = 4352;
constexpr int P_LD = 3584;
constexpr int LORA_K = 384, LORA_N = 3840;
constexpr int LKEYS = CTXL + TT;
constexpr float ALPHA_DN = 1.6817928305074290f;
constexpr float DECAY_SCALE = 0.6065306597126334f;
constexpr float GN_EPS = 64e-5f, LN_EPS = 1e-5f, RMS_EPS = 1e-5f;
constexpr float QSCALE = 0.125f * 1.4426950408889634f;

constexpr size_t al256(size_t x) { return (x + 255) & ~(size_t)255; }
constexpr size_t WS_CTL = 0;
constexpr size_t CTL_BYTES = 65536;
constexpr size_t WS_MOD = WS_CTL + CTL_BYTES;
constexpr size_t WS_ROPE = WS_MOD + al256((size_t)DEPTH * 5 * 6144 * 4);
constexpr size_t WS_WIN = WS_ROPE + 32768;
constexpr size_t WS_WOUT = WS_WIN + (size_t)D_IN_EVEN_PAD * DM * 2;
constexpr size_t WS_WLORA = WS_WOUT + (size_t)DM * DM * 2;
constexpr size_t WS_WE13 = WS_WLORA + (size_t)LORA_N * LORA_K * 2;
constexpr size_t WS_WE2 = WS_WE13 + (size_t)NEXP * 4096 * DM * 2;
constexpr size_t WS_X = WS_WE2 + (size_t)NEXP * DM * D_EXP * 2;
constexpr size_t WS_H = WS_X + (size_t)MROWS * DM * 4;
constexpr size_t WS_A2 = WS_H + (size_t)MROWS * DM * 2;
constexpr size_t WS_P = WS_A2 + (size_t)MROWS * DM * 2;
constexpr size_t WS_AFF = WS_P + (size_t)MROWS * P_LD * 2;
constexpr size_t WS_SLOT = WS_AFF + (size_t)MROWS * 16 * 4;
constexpr size_t WS_IDX = WS_SLOT + (size_t)MROWS * 16 * 4;
constexpr size_t WS_GATE = WS_IDX + al256((size_t)NEXP * ESLOTS * 4);
constexpr size_t WS_R2 = WS_GATE + al256((size_t)NEXP * ESLOTS * 4);
constexpr size_t WS_SCN = WS_R2;
constexpr size_t WS_G = WS_SCN + (size_t)MROWS * 12 * 9 * 64 * 4;
constexpr size_t WS_LIN = WS_G + (size_t)MROWS * 768 * 2;
constexpr size_t WS_EVEN_END = WS_LIN + (size_t)MROWS * 384 * 2;
constexpr size_t WS_Y = WS_P;
constexpr size_t WS_Q = WS_R2;
constexpr size_t WS_KA = WS_Q + (size_t)MROWS * 768 * 2;
constexpr size_t WS_VT = WS_KA + (size_t)NB * LKEYS * 768 * 2;
constexpr size_t WS_HID = WS_R2;
constexpr size_t WS_YE = WS_HID + (size_t)NEXP * ESLOTS * D_EXP * 2;
constexpr size_t WS_END = WS_EVEN_END;
static_assert(WS_END <= (size_t)2147483648ull, "workspace over 2 GiB");
static_assert((size_t)2 * MROWS * 768 * 4 <= (size_t)MROWS * P_LD * 2, "Y aliases P");
static_assert(WS_YE + (size_t)NEXP * ESLOTS * DM * 2 <= WS_END, "moe region");

constexpr int LDS_BYTES = 147456;
constexpr int LDS_MISC = 140 * 1024;
constexpr int LDS_PTAB = LDS_MISC + 256;
constexpr int NWAVES = 8, NTHR = 512;

__device__ __forceinline__ unsigned f2bf(float f) { unsigned u = __float_as_uint(f); return (u + 0x7fffu + ((u >> 16) & 1u)) >> 16; }
__device__ __forceinline__ unsigned pk2(float lo, float hi) { f32x2 v = {lo, hi}; bf16x2_t b = __builtin_convertvector(v, bf16x2_t); return __builtin_bit_cast(unsigned, b); }
__device__ __forceinline__ float bflo(unsigned u) { return __uint_as_float(u << 16); }
__device__ __forceinline__ float bfhi(unsigned u) { return __uint_as_float(u & 0xffff0000u); }
__device__ __forceinline__ float bf2f(bf16_t b) { return __uint_as_float((unsigned)b << 16); }
__device__ __forceinline__ float sigmoidf_(float x) { return 1.f / (1.f + __expf(-x)); }
__device__ __forceinline__ float wave_sum(float v) {
#pragma unroll
    for (int o = 1; o < 64; o <<= 1) v += __shfl_xor(v, o);
    return v;
}
__device__ __forceinline__ float sum16(float v) {
#pragma unroll
    for (int o = 1; o < 16; o <<= 1) v += __shfl_xor(v, o);
    return v;
}
__device__ __forceinline__ float gelu_erf(float x) { return 0.5f * x * (1.f + erff(x * 0.70710678118654752f)); }

#define XB_TMO      128
#define XB_XCNT(j)  (256  + 64 * (j))
#define XB_XSUB(j)  (1280 + 64 * (j))
#define XB_XGEN(j)  (2304 + 64 * (j))
#define XB_TOP      3328
#define XB_TOPGEN   3392
#define XCD_BAR_WORDS 3456
#define XB_SPIN_CAP (1u << 20)

__device__ __forceinline__ unsigned xb_ld(unsigned* p)              { return __hip_atomic_load(p, __ATOMIC_RELAXED, __HIP_MEMORY_SCOPE_AGENT); }
__device__ __forceinline__ unsigned xb_add(unsigned* p, unsigned v) { return __hip_atomic_fetch_add(p, v, __ATOMIC_RELAXED, __HIP_MEMORY_SCOPE_AGENT); }
__device__ __forceinline__ unsigned xb_xcc_id() { return (unsigned)__builtin_amdgcn_s_getreg((3 << 11) | 20) & 0xFu; }
#define XB_SPIN(cond, bar) do { unsigned _sp = 0; while (cond) { __builtin_amdgcn_s_sleep(1); \
    if ((++_sp & 255u) == 0u) { if (xb_ld(&(bar)[XB_TMO])) break; if (_sp > XB_SPIN_CAP) { atomicAdd(&(bar)[XB_TMO], 1u); break; } } } } while (0)

struct XcdBarrier { unsigned* bar; unsigned x; volatile LAS unsigned* st; };

__device__ __forceinline__ XcdBarrier xcd_barrier_post(unsigned* bar, volatile LAS unsigned* st) {
    XcdBarrier b; b.bar = bar; b.x = xb_xcc_id(); b.st = st;
    if (threadIdx.x == 0) (void)xb_add(&bar[XB_XCNT(b.x)], 1u);
    return b;
}
__device__ __forceinline__ void xcd_barrier_complete(unsigned* bar, unsigned x, unsigned& nloc, unsigned& nx) {
    const unsigned G = gridDim.x * gridDim.y * gridDim.z;
    unsigned sum, cnt, mine, sp = 0u;
    for (;;) {
        sum = 0u; cnt = 0u; mine = 0u;
#pragma unroll
        for (unsigned j = 0; j < 16; ++j) { const unsigned c = xb_ld(&bar[XB_XCNT(j)]); sum += c; cnt += (c > 0u) ? 1u : 0u; mine = (j == x) ? c : mine; }
        if (sum == G) break;
        __builtin_amdgcn_s_sleep(1);
        if ((++sp & 255u) == 0u) { if (xb_ld(&bar[XB_TMO])) break; if (sp > XB_SPIN_CAP) { atomicAdd(&bar[XB_TMO], 1u); break; } }
    }
    nloc = mine > 0u ? mine : 1u; nx = cnt > 0u ? cnt : 1u;
}
__device__ __forceinline__ void xcd_barrier(const XcdBarrier& b) {
    asm volatile("s_waitcnt vmcnt(0)" ::: "memory");
    __syncthreads();
    if (threadIdx.x == 0) {
        unsigned* bar = b.bar;
        __builtin_amdgcn_s_waitcnt(0);
        unsigned nloc = b.st[0], nx = b.st[1];
        if (nloc == 0u) { xcd_barrier_complete(bar, b.x, nloc, nx); b.st[0] = nloc; b.st[1] = nx; }
        const unsigned old = xb_add(&bar[XB_XSUB(b.x)], 1u);
        const unsigned gen = old / nloc;
        if (old + 1u == (gen + 1u) * nloc) {
            __builtin_amdgcn_fence(__ATOMIC_RELEASE, "agent");
            asm volatile("s_waitcnt vmcnt(0)" ::: "memory");
            const unsigned og = xb_add(&bar[XB_TOP], 1u);
            const unsigned tg = og / nx;
            if (og + 1u == (tg + 1u) * nx) xb_add(&bar[XB_TOPGEN], 1u);
            else XB_SPIN(xb_ld(&bar[XB_TOPGEN]) == tg, bar);
            __builtin_amdgcn_fence(__ATOMIC_ACQUIRE, "agent");
            xb_add(&bar[XB_XGEN(b.x)], 1u);
            asm volatile("s_waitcnt vmcnt(0)" ::: "memory");
        } else {
            XB_SPIN(xb_ld(&bar[XB_XGEN(b.x)]) == gen, bar);
            __builtin_amdgcn_fence(__ATOMIC_ACQUIRE, "agent");
            asm volatile("s_waitcnt vmcnt(0)" ::: "memory");
        }
    }
    __syncthreads();
}

namespace pg8 {
constexpr int BM = 256, BK = 64, HALF = 128, HTB = HALF * BK * 2, STAGE_BYTES = 8 * HTB, NXCD = 8, WGM = 8;
__host__ __device__ __forceinline__ int lds_byte(int r, int c) { const int st = (r >> 4) * 2 + (c >> 5), rr = r & 15, cc = c & 31, ob = rr * 64 + cc * 2; return st * 1024 + (ob ^ (((ob >> 9) & 1) << 5)); }
__host__ __device__ __forceinline__ void stage_rc(int b, int& R, int& C) { const int st = b / 1024, sb = b % 1024, swz = sb ^ (((sb >> 9) & 1) << 5); R = (st >> 1) * 16 + swz / 64; C = (st & 1) * 32 + (swz % 64) / 2; }

struct Unit { int pm, pn; };
struct Gemm { const bf16_t* A; const bf16_t* Bt; int K; };

template <int MODE> struct Order {
    int nM, nN, nwg, G, c; const int* idx; long bstride;
    __device__ __forceinline__ void init(int nM_, int nN_, int G_, int c_, const int* idx_, long bstride_) { nM = nM_; nN = nN_; nwg = nM * nN; G = G_; c = c_; idx = idx_; bstride = bstride_; }
    __device__ __forceinline__ bool next(int i, Unit& u) const {
        const long L = (long)i * G + c; if (L >= nwg) return false;
        int wgid = (int)L; { const int q = nwg / NXCD, r = nwg % NXCD, xcd = wgid % NXCD, off = wgid / NXCD; wgid = (xcd < r ? xcd * (q + 1) : r * (q + 1) + (xcd - r) * q) + off; }
        const int nig = WGM * nN, gid = wgid / nig, fm = gid * WGM, gsz = (nM - fm) < WGM ? (nM - fm) : WGM;
        u.pm = fm + ((wgid % nig) % gsz); u.pn = (wgid % nig) / gsz; return true;
    }
    __device__ __forceinline__ unsigned arow(const Unit& u, int r) const { if (MODE == 1) return (unsigned)idx[u.pm * BM + r]; return (unsigned)(u.pm * BM + r); }
    __device__ __forceinline__ long bbase(const Unit& u, int K) const { long o = (long)u.pn * BM * K; if (MODE != 0) o += (long)(u.pm / 17) * bstride; return o; }
};

template <class Epi, class Sched>
__device__ __forceinline__ void gemm_phase(LAS unsigned char* lds, const Gemm g, const Sched& S, const Epi& E) {
    int tid = threadIdx.x; asm volatile("" : "+v"(tid));
    const int wid = __builtin_amdgcn_readfirstlane(tid >> 6), wr = wid >> 2, wc = wid & 3;
    const int K = g.K, nt = K / BK;
    unsigned voffB[2];
    { const int lane = tid & 63, fr = lane & 15, fq = lane >> 4; (void)fr; (void)fq; }
#pragma unroll
    for (int i = 0; i < 2; ++i) { int R, Cc; stage_rc(tid * 16 + i * 8192, R, Cc); voffB[i] = (unsigned)(R * K + Cc) * 2u; }
    const size_t kstep = (size_t)(BK * 2);
    const size_t hstep = (size_t)HALF * K * 2;
    const unsigned ldsw = (unsigned)wid * 1024u;
    const int aoff = lds_byte(wr * 64 + (tid & 15), ((tid & 63) >> 4) * 8), boff = lds_byte(wc * 32 + (tid & 15), ((tid & 63) >> 4) * 8);
#define PG8_SA(b, h) (((b) * 2 + (h)) * HTB)
#define PG8_SB(b, h) ((4 + (b) * 2 + (h)) * HTB)
#define PG8_STAGE(bufoff, gbase, voff) do { _Pragma("unroll") for (int _i = 0; _i < 2; ++_i) \
        __builtin_amdgcn_global_load_lds((const unsigned*)((const char*)(gbase) + (voff)[_i]), (LAS unsigned*)(lds + (bufoff) + ldsw + _i * 8192), 16, 0, 0); } while (0)
#define PG8_LDA(dst, b, h) do { _Pragma("unroll") for (int m = 0; m < 4; ++m) _Pragma("unroll") for (int k = 0; k < 2; ++k) dst[m][k] = *(const LAS bf16x8*)(lds + PG8_SA(b, h) + aoff + m * 2048 + k * 1024); } while (0)
#define PG8_LDB(dst, b, h) do { _Pragma("unroll") for (int n = 0; n < 2; ++n) _Pragma("unroll") for (int k = 0; k < 2; ++k) dst[n][k] = *(const LAS bf16x8*)(lds + PG8_SB(b, h) + boff + n * 2048 + k * 1024); } while (0)
#define PG8_MMA(ai, bj, At, Bt) do { __builtin_amdgcn_s_setprio(1); _Pragma("unroll") for (int m = 0; m < 4; ++m) _Pragma("unroll") for (int n = 0; n < 2; ++n) _Pragma("unroll") for (int k = 0; k < 2; ++k) \
        acc[ai][bj][m][n] = __builtin_amdgcn_mfma_f32_16x16x32_bf16(Bt[n][k], At[m][k], acc[ai][bj][m][n], 0, 0, 0); __builtin_amdgcn_s_setprio(0); } while (0)
#define PG8_WAIT_V(n) asm volatile("s_waitcnt vmcnt(" #n ")" ::: "memory")
#define PG8_WAIT_L(n) asm volatile("s_waitcnt lgkmcnt(" #n ")" ::: "memory")
#define PG8_BAR __builtin_amdgcn_s_barrier()
#define PG8_SCHED __builtin_amdgcn_sched_barrier(0)
#define PG8_ROWOFFS(dst, u, tq) do { _Pragma("unroll") for (int _i = 0; _i < 2; ++_i) { int _R, _C; stage_rc((tq) * 16 + _i * 8192, _R, _C); _Pragma("unroll") for (int _h = 0; _h < 2; ++_h) dst[_h][_i] = (S.arow(u, _h * HALF + _R) * (unsigned)K + (unsigned)_C) * 2u; } } while (0)
    Unit cur, nxt; int ui = 0;
    if (!S.next(0, cur)) return;
    f32x4 acc[2][2][4][2];
#pragma unroll
    for (int a = 0; a < 2; ++a)
#pragma unroll
        for (int b = 0; b < 2; ++b)
#pragma unroll
            for (int m = 0; m < 4; ++m)
#pragma unroll
                for (int n = 0; n < 2; ++n) acc[a][b][m][n] = (f32x4){0.f, 0.f, 0.f, 0.f};
    bf16x8 At[4][2], B0[2][2], B1[2][2];
    unsigned vcur[2][2];
    PG8_ROWOFFS(vcur, cur, tid);
    const char* const Ab = (const char*)g.A;
    const char* cB = (const char*)g.Bt + (size_t)S.bbase(cur, K) * 2;
    PG8_STAGE(PG8_SB(0, 0), cB, voffB); PG8_STAGE(PG8_SB(0, 1), cB + hstep, voffB); PG8_STAGE(PG8_SA(0, 0), Ab, vcur[0]); PG8_STAGE(PG8_SA(0, 1), Ab, vcur[1]);
    if (wr == 1) PG8_BAR;
    PG8_WAIT_V(2); PG8_BAR;
    PG8_STAGE(PG8_SB(1, 0), cB + kstep, voffB); PG8_STAGE(PG8_SA(1, 0), Ab + kstep, vcur[0]); PG8_STAGE(PG8_SB(1, 1), cB + hstep + kstep, voffB);
    PG8_WAIT_V(6); PG8_BAR;
    for (;;) {
        const bool has_next = S.next(ui + 1, nxt);
        const char* nB = has_next ? (const char*)g.Bt + (size_t)S.bbase(nxt, K) * 2 : cB;
        for (int t = 0; t < nt; t += 2) {
            const bool last = (t == nt - 2);
            const char* a1 = Ab + (size_t)(t + 1) * kstep;
            const char* a2 = last ? Ab : Ab + (size_t)(t + 2) * kstep; const char* b2 = last ? nB : cB + (size_t)(t + 2) * kstep;
            const char* a3 = a2 + kstep; const char* b3 = b2 + kstep;
            PG8_LDB(B0, 0, 0); PG8_LDB(B1, 0, 1); PG8_SCHED; PG8_LDA(At, 0, 0); PG8_STAGE(PG8_SA(1, 1), a1, vcur[1]);
            PG8_WAIT_V(8); PG8_WAIT_L(0); PG8_BAR; PG8_MMA(0, 0, At, B0); PG8_MMA(0, 1, At, B1); PG8_BAR; PG8_SCHED;
            if (last && has_next) { int tq = tid; asm volatile("" : "+v"(tq)); PG8_ROWOFFS(vcur, nxt, tq); }
            PG8_LDA(At, 0, 1); PG8_STAGE(PG8_SB(0, 0), b2, voffB); PG8_STAGE(PG8_SB(0, 1), b2 + hstep, voffB); PG8_STAGE(PG8_SA(0, 0), a2, vcur[0]);
            PG8_WAIT_V(8); PG8_WAIT_L(0); PG8_BAR; PG8_MMA(1, 0, At, B0); PG8_MMA(1, 1, At, B1); PG8_BAR; PG8_SCHED;
            PG8_LDB(B0, 1, 0); PG8_LDB(B1, 1, 1); PG8_SCHED; PG8_LDA(At, 1, 0); PG8_STAGE(PG8_SA(0, 1), a2, vcur[1]);
            PG8_WAIT_V(8); PG8_WAIT_L(0); PG8_BAR; PG8_MMA(0, 0, At, B0); PG8_MMA(0, 1, At, B1); PG8_BAR; PG8_SCHED;
            PG8_LDA(At, 1, 1); PG8_STAGE(PG8_SB(1, 0), b3, voffB); PG8_STAGE(PG8_SB(1, 1), b3 + hstep, voffB); PG8_STAGE(PG8_SA(1, 0), a3, vcur[0]);
            PG8_WAIT_V(8); PG8_WAIT_L(0); PG8_BAR; PG8_MMA(1, 0, At, B0); PG8_MMA(1, 1, At, B1); PG8_BAR; PG8_SCHED;
        }
        if (wr == 0) PG8_BAR;
        { int tz = tid; asm volatile("" : "+v"(tz)); const int ln = tz & 63; E(acc, cur, wr, wc, ln & 15, ln >> 4); }
        if (!has_next) break;
#pragma unroll
        for (int a = 0; a < 2; ++a)
#pragma unroll
            for (int b = 0; b < 2; ++b)
#pragma unroll
                for (int m = 0; m < 4; ++m)
#pragma unroll
                    for (int n = 0; n < 2; ++n) acc[a][b][m][n] = (f32x4){0.f, 0.f, 0.f, 0.f};
        cur = nxt; cB = nB; ++ui;
        if (wr == 1) PG8_BAR;
    }
    PG8_WAIT_V(0);
    PG8_BAR;
#undef PG8_SA
#undef PG8_SB
#undef PG8_STAGE
#undef PG8_LDA
#undef PG8_LDB
#undef PG8_MMA
#undef PG8_WAIT_V
#undef PG8_WAIT_L
#undef PG8_BAR
#undef PG8_SCHED
#undef PG8_ROWOFFS
}

#define EPI_LOOP for (int ai = 0; ai < 2; ++ai) for (int m = 0; m < 4; ++m) for (int bj = 0; bj < 2; ++bj) for (int n = 0; n < 2; ++n)
struct EpiBf16 {
    bf16_t* O; int ldc;
    __device__ __forceinline__ void operator()(const f32x4 (&acc)[2][2][4][2], const Unit& u, int wr, int wc, int fr, int fq) const {
        const int row0 = u.pm * BM + wr * 64 + fr, col0 = u.pn * BM + wc * 32 + 4 * fq;
#pragma unroll
        for (int ai = 0; ai < 2; ++ai)
#pragma unroll
            for (int m = 0; m < 4; ++m) { bf16_t* rowp = O + (size_t)(row0 + ai * HALF + m * 16) * ldc + col0;
#pragma unroll
                for (int bj = 0; bj < 2; ++bj)
#pragma unroll
                    for (int n = 0; n < 2; ++n) { const f32x4 v = acc[ai][bj][m][n]; u32x2 o; o.x = pk2(v[0], v[1]); o.y = pk2(v[2], v[3]); *(u32x2*)(rowp + bj * HALF + n * 16) = o; } }
    }
};
struct EpiOdd {
    bf16_t* P; bf16_t* Q; bf16_t* KA; const float* rope;
    __device__ __forceinline__ void operator()(const f32x4 (&acc)[2][2][4][2], const Unit& u, int wr, int wc, int fr, int fq) const {
        const int row0 = u.pm * BM + wr * 64 + fr, col0 = u.pn * BM + wc * 32 + 4 * fq;
        if (u.pn >= 6) {
#pragma unroll
            for (int ai = 0; ai < 2; ++ai)
#pragma unroll
                for (int m = 0; m < 4; ++m) { bf16_t* rowp = P + (size_t)(row0 + ai * HALF + m * 16) * P_LD + col0;
#pragma unroll
                    for (int bj = 0; bj < 2; ++bj)
#pragma unroll
                        for (int n = 0; n < 2; ++n) { const f32x4 v = acc[ai][bj][m][n]; u32x2 o; o.x = pk2(v[0], v[1]); o.y = pk2(v[2], v[3]); *(u32x2*)(rowp + bj * HALF + n * 16) = o; } }
            return;
        }
        const bool isk = u.pn >= 3, isctx = u.pm >= NLAT / BM; const int axis = wc & 1;
        const int cq = col0 - (isk ? 768 : 0);
#pragma unroll
        for (int ai = 0; ai < 2; ++ai)
#pragma unroll
            for (int m = 0; m < 4; ++m) { const int row = row0 + ai * HALF + m * 16;
                f32x4 cs = {1.f, 1.f, 1.f, 1.f}, sn = {0.f, 0.f, 0.f, 0.f}; size_t orow;
                if (!isctx) { const int t = row & (TT - 1); const int pos = axis ? 128 + (t & 63) : (t >> 6);
                    cs = *(const f32x4*)(rope + pos * 16 + 4 * fq); sn = *(const f32x4*)(rope + 192 * 16 + pos * 16 + 4 * fq);
                    orow = isk ? (size_t)(row >> 13) * LKEYS + CTXL + t : (size_t)row; }
                else { const int rc = row - NLAT; orow = isk ? (size_t)(rc >> 8) * LKEYS + (rc & 255) : (size_t)row; }
                bf16_t* op = (isk ? KA : Q) + orow * 768 + cq; const float sc = isk ? 1.f : QSCALE;
#pragma unroll
                for (int bj = 0; bj < 2; ++bj) { const f32x4 x1 = acc[ai][bj][m][0], x2 = acc[ai][bj][m][1];
                    const f32x4 o1 = (x1 * cs - x2 * sn) * sc, o2 = (x1 * sn + x2 * cs) * sc;
                    u32x2 a; a.x = pk2(o1[0], o1[1]); a.y = pk2(o1[2], o1[3]); *(u32x2*)(op + bj * HALF) = a;
                    u32x2 b; b.x = pk2(o2[0], o2[1]); b.y = pk2(o2[2], o2[3]); *(u32x2*)(op + bj * HALF + 16) = b; } }
    }
};
struct EpiRes {
    float* X; const float* modl;
    __device__ __forceinline__ void operator()(const f32x4 (&acc)[2][2][4][2], const Unit& u, int wr, int wc, int fr, int fq) const {
        const int row0 = u.pm * BM + wr * 64 + fr, col0 = u.pn * BM + wc * 32 + 4 * fq;
        const int mi = (u.pm * BM < NLAT) ? (u.pm * BM) / TT : 4;
        const float* gate = modl + mi * 6144 + 2 * DM;
        f32x4 gv[2][2];
#pragma unroll
        for (int bj = 0; bj < 2; ++bj)
#pragma unroll
            for (int n = 0; n < 2; ++n) gv[bj][n] = *(const f32x4*)(gate + col0 + bj * HALF + n * 16);
#pragma unroll
        for (int ai = 0; ai < 2; ++ai)
#pragma unroll
            for (int m = 0; m < 4; ++m) { float* rowp = X + (size_t)(row0 + ai * HALF + m * 16) * DM + col0;
#pragma unroll
                for (int bj = 0; bj < 2; ++bj)
#pragma unroll
                    for (int n = 0; n < 2; ++n) { f32x4* p = (f32x4*)(rowp + bj * HALF + n * 16); const f32x4 x = *p; *p = x * ALPHA_DN + gv[bj][n] * acc[ai][bj][m][n]; } }
    }
};
struct EpiSwiGLU {
    bf16_t* HID;
    __device__ __forceinline__ void operator()(const f32x4 (&acc)[2][2][4][2], const Unit& u, int wr, int wc, int fr, int fq) const {
        const int row0 = u.pm * BM + wr * 64 + fr, f0 = u.pn * HALF + wc * 32 + 4 * fq;
#pragma unroll
        for (int ai = 0; ai < 2; ++ai)
#pragma unroll
            for (int m = 0; m < 4; ++m) { bf16_t* rowp = HID + (size_t)(row0 + ai * HALF + m * 16) * D_EXP + f0;
#pragma unroll
                for (int n = 0; n < 2; ++n) { const f32x4 a = acc[ai][0][m][n], b = acc[ai][1][m][n]; float h[4];
#pragma unroll
                    for (int j = 0; j < 4; ++j) h[j] = a[j] / (1.f + __expf(-a[j])) * b[j];
                    u32x2 o; o.x = pk2(h[0], h[1]); o.y = pk2(h[2], h[3]); *(u32x2*)(rowp + n * 16) = o; } }
    }
};
struct EpiYE {
    bf16_t* YE; const float* gate;
    __device__ __forceinline__ void operator()(const f32x4 (&acc)[2][2][4][2], const Unit& u, int wr, int wc, int fr, int fq) const {
        const int row0 = u.pm * BM + wr * 64 + fr, col0 = u.pn * BM + wc * 32 + 4 * fq;
#pragma unroll
        for (int ai = 0; ai < 2; ++ai)
#pragma unroll
            for (int m = 0; m < 4; ++m) { const int row = row0 + ai * HALF + m * 16; const float gt = gate[row]; bf16_t* rowp = YE + (size_t)row * DM + col0;
#pragma unroll
                for (int bj = 0; bj < 2; ++bj)
#pragma unroll
                    for (int n = 0; n < 2; ++n) { const f32x4 v = acc[ai][bj][m][n] * gt; u32x2 o; o.x = pk2(v[0], v[1]); o.y = pk2(v[2], v[3]); *(u32x2*)(rowp + bj * HALF + n * 16) = o; } }
    }
};
struct EpiLora {
    float* SCN; bf16_t* G; const float* decay0; const float* a0; const float* kalpha;
    __device__ __forceinline__ void operator()(const f32x4 (&acc)[2][2][4][2], const Unit& u, int wr, int wc, int fr, int fq) const {
        const int row0 = u.pm * BM + wr * 64 + fr;
        const int seg = u.pn / 3, cb = (u.pn % 3) * BM + wc * 32 + 4 * fq;
#pragma unroll
        for (int bj = 0; bj < 2; ++bj)
#pragma unroll
            for (int n = 0; n < 2; ++n) {
                const int col = cb + bj * HALF + n * 16, head = col >> 6, kx = col & 63;
                if (seg < 2) {
                    const f32x4 d0 = *(const f32x4*)(decay0 + seg * 768 + col);
#pragma unroll
                    for (int ai = 0; ai < 2; ++ai)
#pragma unroll
                        for (int m = 0; m < 4; ++m) { const int row = row0 + ai * HALF + m * 16; f32x4 w;
#pragma unroll
                            for (int j = 0; j < 4; ++j) w[j] = __expf(-DECAY_SCALE * sigmoidf_(d0[j] + acc[ai][bj][m][n][j]));
                            *(f32x4*)(SCN + ((size_t)(row * 12 + head) * 9 + 3 + 3 * seg) * 64 + kx) = w; }
                } else if (seg < 4) {
                    const int d = seg - 2;
                    const f32x4 a00 = *(const f32x4*)(a0 + d * 768 + col), kal = *(const f32x4*)(kalpha + col);
#pragma unroll
                    for (int ai = 0; ai < 2; ++ai)
#pragma unroll
                        for (int m = 0; m < 4; ++m) { const int row = row0 + ai * HALF + m * 16; float* base = SCN + (size_t)(row * 12 + head) * 9 * 64 + kx;
                            const f32x4 kk = *(const f32x4*)(base + 1 * 64); const f32x4 ks = *(const f32x4*)(base + (5 + 3 * d) * 64); f32x4 bb, kr;
#pragma unroll
                            for (int j = 0; j < 4; ++j) { const float a = sigmoidf_(a00[j] + acc[ai][bj][m][n][j]); bb[j] = kk[j] * a; kr[j] = ks[j] * (1.f + (a - 1.f) * kal[j]); }
                            *(f32x4*)(base + (4 + 3 * d) * 64) = bb; *(f32x4*)(base + (5 + 3 * d) * 64) = kr; }
                } else {
#pragma unroll
                    for (int ai = 0; ai < 2; ++ai)
#pragma unroll
                        for (int m = 0; m < 4; ++m) { const int row = row0 + ai * HALF + m * 16; const f32x4 v = acc[ai][bj][m][n]; u32x2 o; o.x = pk2(v[0], v[1]); o.y = pk2(v[2], v[3]);
                            *(u32x2*)(G + (size_t)row * 768 + col) = o; }
                }
            }
    }
};
}

struct Args { const float* in[37]; float* out; unsigned char* ws; int lo, hi; };
enum { I_X = 0, I_C, I_CTX, I_CCTX, I_WMOD, I_BMOD, I_LNG, I_LNB, I_EWIN, I_EWOUT, I_CONVW, I_MU, I_DUP, I_D0, I_AUP, I_A0, I_GUP, I_KXI, I_KAL, I_RBON, I_GNG, I_GNB,
       I_OWIN, I_OWOUT, I_LQ1, I_LK1, I_LQ2, I_LK2, I_SUBG, I_GLNG, I_GLNB, I_GWS, I_GBS, I_WR, I_WE1, I_WE3, I_WE2 };

struct Ctx {
    LAS unsigned char* lds;
    int tid, lane, wave, G, vcu, gw, NGW;
};
__device__ __forceinline__ void mkctx(Ctx& C, LAS unsigned char* lds) {
    int tid = threadIdx.x; asm volatile("" : "+v"(tid));
    C.lds = lds; C.tid = tid; C.lane = tid & 63; C.wave = __builtin_amdgcn_readfirstlane(tid >> 6);
    C.G = gridDim.x; { const int bx = blockIdx.x; C.vcu = (C.G % 8 == 0) ? (bx % 8) * (C.G / 8) + bx / 8 : bx; }
    C.gw = blockIdx.x * NWAVES + C.wave; C.NGW = C.G * NWAVES;
}
__device__ __forceinline__ void ldargs(Args& A, LAS unsigned char* lds) {
    LAS const u32x2* tb = (LAS const u32x2*)(lds + LDS_PTAB); asm volatile("" : "+v"(tb));
#pragma unroll
    for (int i = 0; i < 37; ++i) { const u32x2 v = tb[i]; A.in[i] = (const float*)(((unsigned long long)(unsigned)__builtin_amdgcn_readfirstlane((int)v.y) << 32) | (unsigned)__builtin_amdgcn_readfirstlane((int)v.x)); }
    { const u32x2 v = tb[37]; A.out = (float*)(((unsigned long long)(unsigned)__builtin_amdgcn_readfirstlane((int)v.y) << 32) | (unsigned)__builtin_amdgcn_readfirstlane((int)v.x)); }
    { const u32x2 v = tb[38]; A.ws = (unsigned char*)(((unsigned long long)(unsigned)__builtin_amdgcn_readfirstlane((int)v.y) << 32) | (unsigned)__builtin_amdgcn_readfirstlane((int)v.x)); }
    A.lo = 0; A.hi = 0;
}
__device__ __forceinline__ int row_mi(int row) { return row < NLAT ? (row >> 13) : 4; }

__device__ __forceinline__ void phase_init(const Ctx& C, const Args& A) {
    unsigned char* ws = A.ws;
    float* MOD = (float*)(ws + WS_MOD);
    LAS float* sv = (LAS float*)C.lds;
    LAS float* red = sv + 5 * 1024;
    for (int i = C.tid; i < 5 * 1024; i += NTHR) { const int v = i >> 10, k = i & 1023; const float c = (v < 4) ? A.in[I_C][v * DM + k] : A.in[I_CCTX][k]; sv[i] = c / (1.f + __expf(-c)); }
    __syncthreads();
    const int j = C.tid & 127, kp = C.tid >> 7;
    for (int it = blockIdx.x; it < DEPTH * 48; it += C.G) {
        const int l = it / 48, cg = it % 48, col = cg * 128 + j;
        const float* W = A.in[I_WMOD] + (size_t)l * DM * 6144 + col;
        float a0 = 0.f, a1 = 0.f, a2 = 0.f, a3 = 0.f, a4 = 0.f;
#pragma unroll 4
        for (int k = kp * 256; k < kp * 256 + 256; ++k) { const float w = W[(size_t)k * 6144]; a0 += sv[k] * w; a1 += sv[1024 + k] * w; a2 += sv[2048 + k] * w; a3 += sv[3072 + k] * w; a4 += sv[4096 + k] * w; }
        red[(kp * 5 + 0) * 128 + j] = a0; red[(kp * 5 + 1) * 128 + j] = a1; red[(kp * 5 + 2) * 128 + j] = a2; red[(kp * 5 + 3) * 128 + j] = a3; red[(kp * 5 + 4) * 128 + j] = a4;
        __syncthreads();
        for (int o = C.tid; o < 5 * 128; o += NTHR) { const int v = o >> 7, jj = o & 127; const int cc = cg * 128 + jj;
            const float s = red[(0 * 5 + v) * 128 + jj] + red[(1 * 5 + v) * 128 + jj] + red[(2 * 5 + v) * 128 + jj] + red[(3 * 5 + v) * 128 + jj];
            MOD[((size_t)l * 5 + v) * 6144 + cc] = s + A.in[I_BMOD][l * 6144 + cc]; }
        __syncthreads();
    }
    if (blockIdx.x == C.G - 1) { float* rope = (float*)(ws + WS_ROPE);
        for (int i = C.tid; i < 192 * 16; i += NTHR) { const int pos = i >> 4, j = i & 15; const float ang = (float)(pos < 128 ? pos : pos - 128) * powf(10000.f, -(float)j * (1.f / 16.f));
            rope[i] = cosf(ang); rope[192 * 16 + i] = sinf(ang); } }
    f32x4* X4 = (f32x4*)(ws + WS_X);
    const f32x4* x4 = (const f32x4*)A.in[I_X]; const f32x4* c4 = (const f32x4*)A.in[I_CTX];
    const size_t nl = (size_t)NLAT * DM / 4, nc = (size_t)NCTX * DM / 4;
    for (size_t i = (size_t)blockIdx.x * NTHR + C.tid; i < nl + nc; i += (size_t)C.G * NTHR) X4[i] = (i < nl) ? x4[i] : c4[i - nl];
}

__device__ __forceinline__ void transpose_item(const float* W, int ldw, int k0, int n0, bf16_t* WT, int ldt, int drow0, LAS float* scr, int lane) {
    { float v[64]; const float* src = W + (size_t)k0 * ldw + n0 + lane;
#pragma unroll
      for (int k = 0; k < 64; ++k) v[k] = __builtin_nontemporal_load(src + (size_t)k * ldw);
#pragma unroll
      for (int k = 0; k < 64; ++k) scr[k * 65 + lane] = v[k]; }
    asm volatile("s_waitcnt lgkmcnt(0)" ::: "memory");
    const int c = lane & 7;
#pragma unroll
    for (int j = 0; j < 8; ++j) { const int n = (lane >> 3) + 8 * j; const LAS float* s = scr + (8 * c) * 65 + n;
        u32x4 o; o.x = pk2(s[0 * 65], s[1 * 65]); o.y = pk2(s[2 * 65], s[3 * 65]); o.z = pk2(s[4 * 65], s[5 * 65]); o.w = pk2(s[6 * 65], s[7 * 65]);
        *(u32x4*)(WT + (size_t)(drow0 + n) * ldt + k0 + 8 * c) = o; }
    asm volatile("s_waitcnt lgkmcnt(0)" ::: "memory");
}
__device__ __forceinline__ void phase_conv(const Ctx& C, const Args& A, int l) {
    unsigned char* ws = A.ws;
    const int i2 = l >> 1; const bool odd = (l & 1);
    LAS float* scr = (LAS float*)C.lds + C.wave * (64 * 65);
    bf16_t* WIN = (bf16_t*)(ws + WS_WIN); bf16_t* WOUT = (bf16_t*)(ws + WS_WOUT); bf16_t* WE13 = (bf16_t*)(ws + WS_WE13); bf16_t* WE2 = (bf16_t*)(ws + WS_WE2);
    const int nin = odd ? D_IN_ODD : D_IN_EVEN;
    const float* win = odd ? A.in[I_OWIN] + (size_t)i2 * DM * D_IN_ODD : A.in[I_EWIN] + (size_t)i2 * DM * D_IN_EVEN;
    const float* wout = odd ? A.in[I_OWOUT] + (size_t)i2 * DM * DM : A.in[I_EWOUT] + (size_t)i2 * DM * DM;
    const int n_in = 16 * (nin / 64), n_out = 16 * 16, n_e13 = NEXP * 2 * 16 * 32, n_e2 = NEXP * 32 * 16;
    const int total = n_in + n_out + n_e13 + n_e2;
    for (int it = C.gw; it < total; it += C.NGW) {
        int r = it;
        if (r < n_in) { const int nb = nin / 64, kb = r / nb, nn = r % nb; transpose_item(win, nin, kb * 64, nn * 64, WIN, DM, nn * 64, scr, C.lane); continue; } r -= n_in;
        if (r < n_out) { const int kb = r / 16, nn = r % 16; transpose_item(wout, DM, kb * 64, nn * 64, WOUT, DM, nn * 64, scr, C.lane); continue; } r -= n_out;
        if (r < n_e13) { const int e = r / 1024, q = r % 1024, mat = q / 512, q2 = q % 512, kb = q2 / 32, nn = q2 % 32;
            const float* W = (mat ? A.in[I_WE3] : A.in[I_WE1]) + ((size_t)l * NEXP + e) * DM * D_EXP;
            const int f0 = nn * 64; const int drow = (f0 >> 7) * 256 + mat * 128 + (f0 & 127);
            transpose_item(W, D_EXP, kb * 64, f0, WE13 + (size_t)e * 4096 * DM, DM, drow, scr, C.lane); continue; } r -= n_e13;
        { const int e = r / 512, q = r % 512, kb = q / 16, nn = q % 16;
            const float* W = A.in[I_WE2] + ((size_t)l * NEXP + e) * D_EXP * DM;
            transpose_item(W, DM, kb * 64, nn * 64, WE2 + (size_t)e * DM * D_EXP, D_EXP, nn * 64, scr, C.lane); }
    }
    if (!odd) {
        u32x4* z = (u32x4*)(WIN + (size_t)D_IN_EVEN * DM);
        for (int i = blockIdx.x * NTHR + C.tid; i < (D_IN_EVEN_PAD - D_IN_EVEN) * DM / 8; i += C.G * NTHR) z[i] = (u32x4){0u, 0u, 0u, 0u};
        bf16_t* WL = (bf16_t*)(ws + WS_WLORA);
        const float* dup = A.in[I_DUP] + (size_t)i2 * 2 * 64 * 768; const float* aup = A.in[I_AUP] + (size_t)i2 * 2 * 64 * 768; const float* gup = A.in[I_GUP] + (size_t)i2 * 128 * 768;
        for (int i = blockIdx.x * NTHR + C.tid; i < LORA_N * LORA_K; i += C.G * NTHR) {
            const int kk = i / LORA_N, n = i % LORA_N, seg = n / 768, col = n % 768; float v = 0.f;
            if (seg == 0) { if (kk < 64) v = dup[(size_t)(0 * 64 + kk) * 768 + col]; }
            else if (seg == 1) { if (kk >= 64 && kk < 128) v = dup[(size_t)(1 * 64 + kk - 64) * 768 + col]; }
            else if (seg == 2) { if (kk >= 128 && kk < 192) v = aup[(size_t)(0 * 64 + kk - 128) * 768 + col]; }
            else if (seg == 3) { if (kk >= 192 && kk < 256) v = aup[(size_t)(1 * 64 + kk - 192) * 768 + col]; }
            else { if (kk >= 256) v = gup[(size_t)(kk - 256) * 768 + col]; }
            WL[(size_t)n * LORA_K + kk] = (bf16_t)f2bf(v);
        }
    }
}

__device__ __forceinline__ void phase_modh(const Ctx& C, const Args& A, int l) {
    const float* X = (const float*)(A.ws + WS_X); bf16_t* H = (bf16_t*)(A.ws + WS_H); const float* MOD = (const float*)(A.ws + WS_MOD) + (size_t)l * 5 * 6144;
    for (int row = C.gw; row < MROWS; row += C.NGW) {
        const float* md = MOD + row_mi(row) * 6144;
#pragma unroll
        for (int j = 0; j < 4; ++j) { const int col = 4 * C.lane + 256 * j; const f32x4 x = *(const f32x4*)(X + (size_t)row * DM + col), sh = *(const f32x4*)(md + col), sc = *(const f32x4*)(md + DM + col);
            const f32x4 h = x * (sc + 1.f) + sh; u32x2 o; o.x = pk2(h[0], h[1]); o.y = pk2(h[2], h[3]); *(u32x2*)(H + (size_t)row * DM + col) = o; }
    }
}

__device__ __forceinline__ f32x4 ld4bf(const bf16_t* p) { const u32x2 u = *(const u32x2*)p; return (f32x4){bflo(u.x), bfhi(u.x), bflo(u.y), bfhi(u.y)}; }
__device__ __forceinline__ void st4bf(bf16_t* p, f32x4 v) { u32x2 o; o.x = pk2(v[0], v[1]); o.y = pk2(v[2], v[3]); *(u32x2*)p = o; }
__device__ __forceinline__ void seq_info(int row, bool& hasp, bool& hasn) {
    if (row < NLAT) { const int t = row & (TT - 1); hasp = t > 0; hasn = t < TT - 1; }
    else { const int t = (row - NLAT) & (CTXL - 1); hasp = t > 0; hasn = t < CTXL - 1; }
}
__device__ __forceinline__ void phase_ef1(const Ctx& C, const Args& A, int l) {
    const int i2 = l >> 1; unsigned char* ws = A.ws;
    const bf16_t* P = (const bf16_t*)(ws + WS_P); bf16_t* A2 = (bf16_t*)(ws + WS_A2); float* SCN = (float*)(ws + WS_SCN); bf16_t* LIN = (bf16_t*)(ws + WS_LIN);
    const float* cw = A.in[I_CONVW] + (size_t)i2 * 3 * 256; const float* mu = A.in[I_MU] + (size_t)i2 * RWKV_COLS; const float* kxi = A.in[I_KXI] + (size_t)i2 * 768;
    const f32x4 z4 = {0.f, 0.f, 0.f, 0.f};
    for (int row = C.gw; row < MROWS; row += C.NGW) {
        bool hasp, hasn; seq_info(row, hasp, hasn);
        const bf16_t* p0 = P + (size_t)row * P_LD; const bf16_t* pm = p0 - P_LD; const bf16_t* pp = p0 + P_LD;
        {
            const int j4 = 4 * C.lane;
            const f32x4 bg = ld4bf(p0 + j4), u0 = ld4bf(p0 + 256 + j4) * ld4bf(p0 + 512 + j4);
            const f32x4 um = hasp ? ld4bf(pm + 256 + j4) * ld4bf(pm + 512 + j4) : z4, up = hasn ? ld4bf(pp + 256 + j4) * ld4bf(pp + 512 + j4) : z4;
            const f32x4 w0 = *(const f32x4*)(cw + j4), w1 = *(const f32x4*)(cw + 256 + j4), w2 = *(const f32x4*)(cw + 512 + j4);
            st4bf(A2 + (size_t)row * DM + j4, bg * (w0 * um + w1 * u0 + w2 * up));
        }
#pragma unroll
        for (int it = 0; it < 11; ++it) {
            const int c = it * 256 + 4 * C.lane;
            if (c < RWKV_COLS) {
                const f32x4 x0 = ld4bf(p0 + 768 + c), xm = hasp ? ld4bf(pm + 768 + c) : z4, xp = hasn ? ld4bf(pp + 768 + c) : z4, m4 = *(const f32x4*)(mu + c);
                const f32x4 ps = x0 + m4 * ((xm + xp) * 0.5f - x0);
                if (it < 3) { const int head = c >> 6, kx = c & 63; *(f32x4*)(SCN + ((size_t)(row * 12 + head) * 9 + 0) * 64 + kx) = ps; }
                else if (it < 6) { const int c1 = c - 768, head = c1 >> 6, kx = c1 & 63; const f32x4 kv = ps * *(const f32x4*)(kxi + c1);
                    const float ss = sum16(kv[0] * kv[0] + kv[1] * kv[1] + kv[2] * kv[2] + kv[3] * kv[3]); const float rn = rsqrtf(ss + 1e-12f);
                    float* base = SCN + (size_t)(row * 12 + head) * 9 * 64 + kx;
                    *(f32x4*)(base + 1 * 64) = kv * rn; *(f32x4*)(base + 5 * 64) = ps; *(f32x4*)(base + 8 * 64) = ps; }
                else if (it < 9) { const int c1 = c - 1536, head = c1 >> 6, kx = c1 & 63; *(f32x4*)(SCN + ((size_t)(row * 12 + head) * 9 + 2) * 64 + kx) = ps; }
                else { const int c1 = c - 2304; f32x4 o;
                    if (c1 < 128) { o = (f32x4){tanhf(ps[0]), tanhf(ps[1]), tanhf(ps[2]), tanhf(ps[3])}; }
                    else if (c1 < 256) { o = ps; }
                    else { o = (f32x4){sigmoidf_(ps[0]), sigmoidf_(ps[1]), sigmoidf_(ps[2]), sigmoidf_(ps[3])}; }
                    st4bf(LIN + (size_t)row * LORA_K + c1, o); }
            }
        }
    }
}

__device__ __forceinline__ int scan_row(int i, int b, int d) {
    if (d == 0) return i < CTXL ? NLAT + b * CTXL + i : b * TT + (i - CTXL);
    return i < CTXL ? NLAT + b * CTXL + (CTXL - 1 - i) : b * TT + (TT - 1 - (i - CTXL));
}
__device__ __forceinline__ float red8(float v) {
    v += __uint_as_float((unsigned)__builtin_amdgcn_update_dpp(0, (int)__float_as_uint(v), 0xB1, 0xF, 0xF, true));
    v += __uint_as_float((unsigned)__builtin_amdgcn_update_dpp(0, (int)__float_as_uint(v), 0x4E, 0xF, 0xF, true));
    v += __uint_as_float((unsigned)__builtin_amdgcn_update_dpp(0, (int)__float_as_uint(v), 0x141, 0xF, 0xF, true));
    return v;
}
__device__ __forceinline__ float red16(float v) {
    v += __uint_as_float((unsigned)__builtin_amdgcn_update_dpp(0, (int)__float_as_uint(v), 0xB1, 0xF, 0xF, true));
    v += __uint_as_float((unsigned)__builtin_amdgcn_update_dpp(0, (int)__float_as_uint(v), 0x4E, 0xF, 0xF, true));
    v += __uint_as_float((unsigned)__builtin_amdgcn_update_dpp(0, (int)__float_as_uint(v), 0x141, 0xF, 0xF, true));
    v += __uint_as_float((unsigned)__builtin_amdgcn_update_dpp(0, (int)__float_as_uint(v), 0x140, 0xF, 0xF, true));
    return v;
}
__device__ __forceinline__ void phase_scan(const Ctx& C, const Args& A) {
    for (int u = blockIdx.x; u < 192; u += C.G) {
    const int half = u & 1, d = (u >> 1) & 1, h = (u >> 2) % 12, b = u / 48;
    const float* SCN = (const float*)(A.ws + WS_SCN); float* Y = (float*)(A.ws + WS_Y) + (size_t)d * MROWS * 768;
    LAS float* buf = (LAS float*)C.lds; LAS float* ybuf = buf + 2 * 32 * 352;
    constexpr int NCH = LKEYS / 32;
    f32x4 st[6];
    int ps_[6], prel[6], pdst[6];
#pragma unroll
    for (int j = 0; j < 6; ++j) { const int p = C.tid + NTHR * j; const int s = p / 88, q = p % 88, vec = q >> 4; ps_[j] = s; pdst[j] = s * 352 + q * 4;
        const int slot = vec == 0 ? 3 + 3 * d : vec == 1 ? 1 : vec == 2 ? 4 + 3 * d : vec == 3 ? 5 + 3 * d : vec == 4 ? 0 : 2;
        prel[j] = slot * 64 + (vec < 5 ? (q & 15) * 4 : half * 32 + (q - 80) * 4); }
    const int sgn = d ? -1 : 1;
    const float* SCNh = SCN + (size_t)h * 576;
#define SCAN_ROW0(c) (((c) * 32 < CTXL) ? (NLAT + b * CTXL + (d ? CTXL - 1 - (c) * 32 : (c) * 32)) : (b * TT + (d ? TT - 1 - ((c) * 32 - CTXL) : (c) * 32 - CTXL)))
#define SCAN_LOADG(c) do { const int row0_ = SCAN_ROW0(c); _Pragma("unroll") for (int j = 0; j < 6; ++j) if (j < 5 || C.tid < 2816 - 5 * NTHR) { \
        st[j] = *(const f32x4*)(SCNh + (size_t)(row0_ + sgn * ps_[j]) * (12 * 576) + prel[j]); } } while (0)
#define SCAN_STORE(bi) do { _Pragma("unroll") for (int j = 0; j < 6; ++j) if (j < 5 || C.tid < 2816 - 5 * NTHR) *(LAS f32x4*)(buf + (bi) * (32 * 352) + pdst[j]) = st[j]; } while (0)
    SCAN_LOADG(0); SCAN_STORE(0); __syncthreads();
    f32x2 Sa = {0.f, 0.f}, Sb = {0.f, 0.f};
    const int rl = C.lane >> 4, ks = C.lane & 15;
    float ycol = 0.f;
#define SC_LD(R, s) do { const LAS float* bp_ = cur + (s) * 352 + ks * 4; \
        R##w = *(const LAS f32x4*)(bp_); R##k = *(const LAS f32x4*)(bp_ + 64); R##b = *(const LAS f32x4*)(bp_ + 128); R##q = *(const LAS f32x4*)(bp_ + 192); R##r = *(const LAS f32x4*)(bp_ + 256); \
        R##vv = cur[(s) * 352 + 320 + C.wave * 4 + rl]; } while (0)
#define SC_LO(v) ((f32x2){v[0], v[1]})
#define SC_HI(v) ((f32x2){v[2], v[3]})
#define SC_DPP(x, ctrl) __uint_as_float((unsigned)__builtin_amdgcn_update_dpp(0, (int)__float_as_uint(x), ctrl, 0xF, 0xF, true))
#define SC_STEP(R, P, s) do { \
        f32x2 pa = __builtin_elementwise_fma(Sb, SC_HI(R##k), Sa * SC_LO(R##k)), py = __builtin_elementwise_fma(Sb, SC_HI(P##r), Sa * SC_LO(P##r)); \
        float a_ = pa.x + pa.y, y_ = py.x + py.y; \
        a_ += SC_DPP(a_, 0xB1); y_ += SC_DPP(y_, 0xB1); a_ += SC_DPP(a_, 0x4E); y_ += SC_DPP(y_, 0x4E); \
        a_ += SC_DPP(a_, 0x141); y_ += SC_DPP(y_, 0x141); a_ += SC_DPP(a_, 0x140); y_ += SC_DPP(y_, 0x140); \
        ycol = (ks == ((s) & 15)) ? y_ : ycol; \
        const f32x2 na = {-a_, -a_}, vv2 = {R##vv, R##vv}; \
        Sa = __builtin_elementwise_fma(Sa, SC_LO(R##w), __builtin_elementwise_fma(na, SC_LO(R##b), vv2 * SC_LO(R##q))); \
        Sb = __builtin_elementwise_fma(Sb, SC_HI(R##w), __builtin_elementwise_fma(na, SC_HI(R##b), vv2 * SC_HI(R##q))); } while (0)
    f32x4 Aw, Ak, Ab, Aq, Ar, Bw, Bk, Bb, Bq, Br, Cw, Ck, Cb, Cq, Cr, Dw, Dk, Db, Dq, Dr; float Avv, Bvv, Cvv, Dvv;
    Dr = (f32x4){0.f, 0.f, 0.f, 0.f};
    for (int c = 0; c < NCH; ++c) {
        if (c + 1 < NCH) SCAN_LOADG(c + 1);
        {
            const LAS float* cur = buf + (c & 1) * (32 * 352);
            LAS float* yb = ybuf + (c & 1) * 1024 + C.wave * 4 + rl + ks * 32;
            SC_LD(A, 0); SC_LD(B, 1);
#pragma unroll 1
            for (int s = 0; s < 32; s += 4) {
                SC_LD(C, s + 2); __builtin_amdgcn_sched_barrier(0); SC_STEP(A, D, s); __builtin_amdgcn_sched_barrier(0);
                SC_LD(D, s + 3); __builtin_amdgcn_sched_barrier(0); SC_STEP(B, A, s + 1); __builtin_amdgcn_sched_barrier(0);
                SC_LD(A, s + 4); __builtin_amdgcn_sched_barrier(0); SC_STEP(C, B, s + 2); __builtin_amdgcn_sched_barrier(0);
                SC_LD(B, s + 5); __builtin_amdgcn_sched_barrier(0); SC_STEP(D, C, s + 3); __builtin_amdgcn_sched_barrier(0);
                if ((s & 15) == 12) yb[(s & 16) * 32] = ycol;
            }
        }
        if (c + 1 < NCH) SCAN_STORE((c + 1) & 1);
        __syncthreads();
        { const int row0_ = SCAN_ROW0(c);
#pragma unroll
          for (int i = 0; i < 2; ++i) { const int e = C.tid + NTHR * i, s = e >> 5, r = e & 31;
            const int row = (s > 0) ? row0_ + sgn * (s - 1) : scan_row(c * 32 - 1, b, d);
            if (s > 0 || c > 0) Y[(size_t)row * 768 + h * 64 + half * 32 + r] = ybuf[(c & 1) * 1024 + e]; } }
    }
    {
        f32x2 py = __builtin_elementwise_fma(Sb, SC_HI(Dr), Sa * SC_LO(Dr)); float y_ = py.x + py.y;
        y_ += SC_DPP(y_, 0xB1); y_ += SC_DPP(y_, 0x4E); y_ += SC_DPP(y_, 0x141); y_ += SC_DPP(y_, 0x140);
        if (ks == 0) Y[(size_t)scan_row(LKEYS - 1, b, d) * 768 + h * 64 + half * 32 + C.wave * 4 + rl] = y_;
    }
    __syncthreads();
    }
#undef SCAN_LOADG
#undef SCAN_STORE
#undef SCAN_ROW0
#undef SC_LD
#undef SC_STEP
#undef SC_LO
#undef SC_HI
#undef SC_DPP
}

__device__ __forceinline__ void phase_ef2(const Ctx& C, const Args& A, int l) {
    const int i2 = l >> 1; unsigned char* ws = A.ws;
    const float* SCN = (const float*)(ws + WS_SCN); const float* Y0 = (const float*)(ws + WS_Y); const float* Y1 = Y0 + (size_t)MROWS * 768;
    const bf16_t* G = (const bf16_t*)(ws + WS_G); bf16_t* A2 = (bf16_t*)(ws + WS_A2);
    const float* rb = A.in[I_RBON] + (size_t)i2 * 768; const float* gg = A.in[I_GNG] + (size_t)i2 * 768; const float* gb = A.in[I_GNB] + (size_t)i2 * 768;
    for (int row = C.gw; row < MROWS; row += C.NGW) {
#pragma unroll
        for (int it = 0; it < 3; ++it) {
            const int c = it * 256 + 4 * C.lane, head = c >> 6, kx = c & 63;
            const f32x4 y = *(const f32x4*)(Y0 + (size_t)row * 768 + c) + *(const f32x4*)(Y1 + (size_t)row * 768 + c);
            const float mean = sum16((y[0] + y[1]) + (y[2] + y[3])) * (1.f / 64.f);
            const f32x4 dd = y - mean;
            const float var = sum16((dd[0] * dd[0] + dd[1] * dd[1]) + (dd[2] * dd[2] + dd[3] * dd[3])) * (1.f / 64.f);
            const float rstd = rsqrtf(var + GN_EPS);
            const float* base = SCN + (size_t)(row * 12 + head) * 9 * 64 + kx;
            const f32x4 r = *(const f32x4*)(base), v = *(const f32x4*)(base + 2 * 64), k0 = *(const f32x4*)(base + 5 * 64), k1 = *(const f32x4*)(base + 8 * 64);
            const f32x4 rb4 = *(const f32x4*)(rb + c);
            const f32x4 t = r * (k0 + k1) * 0.5f * rb4;
            const float bs = sum16((t[0] + t[1]) + (t[2] + t[3]));
            const f32x4 yn = dd * rstd * *(const f32x4*)(gg + c) + *(const f32x4*)(gb + c);
            const f32x4 g = ld4bf(G + (size_t)row * 768 + c);
            st4bf(A2 + (size_t)row * DM + 256 + c, g * (yn + v * bs));
        }
    }
}

__device__ __forceinline__ float max3f(float a, float b, float c) { float r; asm("v_max3_f32 %0, %1, %2, %3" : "=v"(r) : "v"(a), "v"(b), "v"(c)); return r; }
__device__ __forceinline__ int crow(int r, int hi) { return (r & 3) + 8 * (r >> 2) + 4 * hi; }
__device__ __forceinline__ void phase_of1(const Ctx& C, const Args& A, int l) {
    const int i2 = l >> 1; unsigned char* ws = A.ws;
    const bf16_t* P = (const bf16_t*)(ws + WS_P); bf16_t* A2 = (bf16_t*)(ws + WS_A2); bf16_t* VT = (bf16_t*)(ws + WS_VT);
    const float* lng = A.in[I_GLNG] + (size_t)i2 * 256; const float* lnb = A.in[I_GLNB] + (size_t)i2 * 256;
    const float* gws = A.in[I_GWS] + (size_t)i2 * 4 * 128 * 128; const float* gbs = A.in[I_GBS] + (size_t)i2 * 4 * 128;
    LAS bf16_t* vt = (LAS bf16_t*)C.lds;
    LAS bf16_t* uL = (LAS bf16_t*)C.lds;
    LAS bf16_t* vT = (LAS bf16_t*)(C.lds + 128 * 528);
    const int r32 = C.lane & 31, hi = C.lane >> 5;
    for (int u = blockIdx.x; u < 264; u += C.G) {
        const bool isctx = u >= 256; const int uc = u - 256;
        const int b = isctx ? (uc >> 1) : (u >> 6), pos0 = isctx ? (uc & 1) * 128 : (u & 63) * 128;
        const int row0 = isctx ? NLAT + b * CTXL + pos0 : b * TT + pos0, L0 = isctx ? pos0 : CTXL + pos0;
        for (int hh = 0; hh < 6; ++hh) {
#pragma unroll
            for (int i = 0; i < 4; ++i) { const int piece = C.tid + NTHR * i, r = piece >> 4, part = piece & 15;
                *(LAS u32x4*)(vt + r * 136 + part * 8) = *(const u32x4*)(P + (size_t)(row0 + r) * P_LD + 1536 + hh * 128 + part * 8); }
            __syncthreads();
#pragma unroll
            for (int i = 0; i < 4; ++i) { const int item = C.tid + NTHR * i, d = item >> 4, tg = item & 15; const LAS bf16_t* s = vt + (tg * 8) * 136 + d;
                u32x4 o; o.x = (unsigned)s[0] | ((unsigned)s[136] << 16); o.y = (unsigned)s[2 * 136] | ((unsigned)s[3 * 136] << 16);
                o.z = (unsigned)s[4 * 136] | ((unsigned)s[5 * 136] << 16); o.w = (unsigned)s[6 * 136] | ((unsigned)s[7 * 136] << 16);
                *(u32x4*)(VT + ((size_t)(b * 6 + hh) * 128 + d) * LKEYS + L0 + tg * 8) = o; }
            __syncthreads();
        }
        for (int r = C.wave; r < 128; r += NWAVES) {
            const int c4 = 4 * C.lane; const bf16_t* pr = P + (size_t)(row0 + r) * P_LD + 2304;
            const f32x4 ur = ld4bf(pr + c4), raw = ld4bf(pr + 256 + c4);
            { const f32x4 gu = {gelu_erf(ur[0]), gelu_erf(ur[1]), gelu_erf(ur[2]), gelu_erf(ur[3])}; u32x2 o; o.x = pk2(gu[0], gu[1]); o.y = pk2(gu[2], gu[3]); *(LAS u32x2*)(uL + r * 264 + c4) = o; }
            const f32x4 gv = {gelu_erf(raw[0]), gelu_erf(raw[1]), gelu_erf(raw[2]), gelu_erf(raw[3])};
            const float mean = wave_sum((gv[0] + gv[1]) + (gv[2] + gv[3])) * (1.f / 256.f); const f32x4 dd = gv - mean;
            const float var = wave_sum((dd[0] * dd[0] + dd[1] * dd[1]) + (dd[2] * dd[2] + dd[3] * dd[3])) * (1.f / 256.f); const float rstd = rsqrtf(var + LN_EPS);
            const f32x4 o = dd * rstd * *(const f32x4*)(lng + c4) + *(const f32x4*)(lnb + c4);
#pragma unroll
            for (int k = 0; k < 4; ++k) vT[(c4 + k) * 136 + r] = (bf16_t)f2bf(o[k]);
        }
        __syncthreads();
        {
            const int g = C.wave >> 1, cblk = C.wave & 1, cc = g * 64 + cblk * 32 + r32;
            for (int pblk = 0; pblk < 4; ++pblk) {
                f32x16 acc;
#pragma unroll
                for (int i = 0; i < 16; ++i) acc[i] = 0.f;
                const float* wrow = gws + ((size_t)g * 128 + pblk * 32 + r32) * 128 + 8 * hi;
#pragma unroll
                for (int ks = 0; ks < 8; ++ks) { const f32x4 w0 = *(const f32x4*)(wrow + ks * 16), w1 = *(const f32x4*)(wrow + ks * 16 + 4);
                    u32x4 au; au.x = pk2(w0[0], w0[1]); au.y = pk2(w0[2], w0[3]); au.z = pk2(w1[0], w1[1]); au.w = pk2(w1[2], w1[3]);
                    const bf16x8 bf = *(const LAS bf16x8*)(vT + cc * 136 + ks * 16 + 8 * hi);
                    acc = __builtin_amdgcn_mfma_f32_32x32x16_bf16(__builtin_bit_cast(bf16x8, au), bf, acc, 0, 0, 0); }
#pragma unroll
                for (int reg = 0; reg < 16; ++reg) { const int p = pblk * 32 + crow(reg, hi);
                    const float uu = bf2f(uL[p * 264 + cc]); const float mixed = acc[reg] + gbs[g * 128 + p];
                    uL[p * 264 + cc] = (bf16_t)f2bf(uu * mixed); }
            }
        }
        __syncthreads();
#pragma unroll
        for (int i = 0; i < 8; ++i) { const int piece = C.tid + NTHR * i, r = piece >> 5, part = piece & 31;
            *(u32x4*)(A2 + (size_t)(row0 + r) * DM + 768 + part * 8) = *(const LAS u32x4*)(uL + r * 264 + part * 8); }
        __syncthreads();
    }
}

__device__ __forceinline__ void phase_attn(const Ctx& C, const Args& A, int l) {
    const int i2 = l >> 1; unsigned char* ws = A.ws;
    const bf16_t* Q = (const bf16_t*)(ws + WS_Q); const bf16_t* KA = (const bf16_t*)(ws + WS_KA); const bf16_t* VT = (const bf16_t*)(ws + WS_VT); bf16_t* A2 = (bf16_t*)(ws + WS_A2);
    const float lam_init = 0.8f - 0.6f * expf(-0.3f * (float)l);
    float s1 = 0.f, s2 = 0.f;
    for (int j = 0; j < 64; ++j) { s1 += A.in[I_LQ1][i2 * 64 + j] * A.in[I_LK1][i2 * 64 + j]; s2 += A.in[I_LQ2][i2 * 64 + j] * A.in[I_LK2][i2 * 64 + j]; }
    const float lam = expf(s1) - expf(s2) + lam_init;
    const float* subg = A.in[I_SUBG] + (size_t)i2 * 128;
    const int r32 = C.lane & 31, hi = C.lane >> 5, map = C.wave >> 2, qw = C.wave & 3;
    LAS unsigned char* Kt = C.lds; LAS unsigned char* Vt = C.lds + 2 * 17408; LAS float* xch = (LAS float*)C.lds;
    const int NU = 1536 + (l == 1 ? 48 : 0);
    for (int n = C.vcu; n < NU; n += C.G) {
        int bh, qt; bool isctx = false;
        if (n < 1536) { const int round = n >> 8, slot = n & 255; bh = (slot >> 5) * 3 + (round >> 1); qt = (round & 1) * 32 + (slot & 31); }
        else { isctx = true; bh = (n - 1536) >> 1; qt = (n - 1536) & 1; }
        const int b = bh / 6, h = bh % 6;
        const int qrow0 = isctx ? NLAT + b * CTXL + qt * 128 : b * TT + qt * 128;
        const int NT = isctx ? CTXL / 64 : LKEYS / 64;
        const bf16_t* Kb = KA + (size_t)b * LKEYS * 768 + h * 128;
        const bf16_t* Vb = VT + (size_t)(b * 6 + h) * 128 * LKEYS;
        bf16x8 qf[4];
        { const bf16_t* qp = Q + (size_t)(qrow0 + qw * 32 + r32) * 768 + h * 128 + map * 64 + 8 * hi;
#pragma unroll
          for (int ks = 0; ks < 4; ++ks) qf[ks] = *(const bf16x8*)(qp + ks * 16); }
        f32x16 O[4];
#pragma unroll
        for (int d = 0; d < 4; ++d)
#pragma unroll
            for (int i = 0; i < 16; ++i) O[d][i] = 0.f;
        float m = -1e30f, lsum = 0.f;
        u32x4 kreg[2], vreg[2];
#define AT_LOAD(t) do { _Pragma("unroll") for (int i = 0; i < 2; ++i) { const int piece = C.tid + NTHR * i; \
            kreg[i] = *(const u32x4*)(Kb + (size_t)((t) * 64 + (piece >> 4)) * 768 + (piece & 15) * 8); \
            vreg[i] = *(const u32x4*)(Vb + (size_t)(piece >> 3) * LKEYS + (t) * 64 + (piece & 7) * 8); } } while (0)
#define AT_STORE(bi) do { _Pragma("unroll") for (int i = 0; i < 2; ++i) { const int piece = C.tid + NTHR * i; \
            *(LAS u32x4*)(Kt + (bi) * 17408 + (piece >> 4) * 272 + (piece & 15) * 16) = kreg[i]; \
            LAS unsigned char* vd = Vt + (bi) * 17408 + (piece >> 3) * 136 + (piece & 7) * 16; \
            *(LAS u32x2*)vd = (u32x2){vreg[i].x, vreg[i].y}; *(LAS u32x2*)(vd + 8) = (u32x2){vreg[i].z, vreg[i].w}; } } while (0)
        AT_LOAD(0); AT_STORE(0); __syncthreads();
        for (int t = 0; t < NT; ++t) {
            if (t + 1 < NT) AT_LOAD(t + 1);
            const int bi = t & 1;
            const LAS unsigned char* kb = Kt + bi * 17408 + r32 * 272 + map * 128 + hi * 16;
            const LAS unsigned char* vb = Vt + bi * 17408 + r32 * 136 + hi * 8;
            bf16x8 kf[8];
#pragma unroll
            for (int ks = 0; ks < 4; ++ks) { kf[2 * ks] = *(const LAS bf16x8*)(kb + ks * 32); kf[2 * ks + 1] = *(const LAS bf16x8*)(kb + 32 * 272 + ks * 32); }
            u32x4 va[4], vc[4];
#define AT_LDV(dst, d) do { _Pragma("unroll") for (int kst = 0; kst < 4; ++kst) { const LAS unsigned char* vp = vb + (d) * (32 * 136) + kst * 32; \
                const u32x2 lo = *(const LAS u32x2*)vp, hh = *(const LAS u32x2*)(vp + 16); dst[kst] = (u32x4){lo.x, lo.y, hh.x, hh.y}; } } while (0)
#define AT_PV(src, d) do { _Pragma("unroll") for (int kst = 0; kst < 4; ++kst) O[d] = __builtin_amdgcn_mfma_f32_32x32x16_bf16(__builtin_bit_cast(bf16x8, src[kst]), pb[kst], O[d], 0, 0, 0); } while (0)
            AT_LDV(va, 0);
            __builtin_amdgcn_sched_barrier(0);
            f32x16 p0, p1;
#pragma unroll
            for (int i = 0; i < 16; ++i) { p0[i] = 0.f; p1[i] = 0.f; }
#pragma unroll
            for (int ks = 0; ks < 4; ++ks) { p0 = __builtin_amdgcn_mfma_f32_32x32x16_bf16(kf[2 * ks], qf[ks], p0, 0, 0, 0); p1 = __builtin_amdgcn_mfma_f32_32x32x16_bf16(kf[2 * ks + 1], qf[ks], p1, 0, 0, 0); }
            asm volatile("s_nop 15\n\ts_nop 7" : "+v"(p0), "+v"(p1));
            float mx = max3f(p0[0], p0[1], p1[0]), mx2 = max3f(p0[2], p0[3], p1[1]); mx = max3f(mx, p1[2], p1[3]);
#pragma unroll
            for (int i = 4; i < 16; i += 4) { mx = max3f(mx, p0[i], p0[i + 1]); mx2 = max3f(mx2, p0[i + 2], p0[i + 3]); mx = max3f(mx, p1[i], p1[i + 1]); mx2 = max3f(mx2, p1[i + 2], p1[i + 3]); }
            mx = max3f(mx, mx2, m);
            { auto rr = __builtin_amdgcn_permlane32_swap(__float_as_uint(mx), __float_as_uint(mx), false, false); mx = fmaxf(__uint_as_float(rr[0]), __uint_as_float(rr[1])); }
            const float mnew = mx;
            if (__any(mnew > m)) { const float sc = __builtin_amdgcn_exp2f(m - mnew); lsum *= sc;
#pragma unroll
                for (int d = 0; d < 4; ++d)
#pragma unroll
                    for (int i = 0; i < 16; ++i) O[d][i] *= sc;
                m = mnew; }
            float ps = 0.f, ps2 = 0.f;
#pragma unroll
            for (int i = 0; i < 16; ++i) { p0[i] = __builtin_amdgcn_exp2f(p0[i] - m); p1[i] = __builtin_amdgcn_exp2f(p1[i] - m); ps += p0[i]; ps2 += p1[i]; }
            lsum += ps + ps2;
            bf16x8 pb[4];
            { u32x4 w; w.x = pk2(p0[0], p0[1]); w.y = pk2(p0[2], p0[3]); w.z = pk2(p0[4], p0[5]); w.w = pk2(p0[6], p0[7]); pb[0] = __builtin_bit_cast(bf16x8, w);
              w.x = pk2(p0[8], p0[9]); w.y = pk2(p0[10], p0[11]); w.z = pk2(p0[12], p0[13]); w.w = pk2(p0[14], p0[15]); pb[1] = __builtin_bit_cast(bf16x8, w);
              w.x = pk2(p1[0], p1[1]); w.y = pk2(p1[2], p1[3]); w.z = pk2(p1[4], p1[5]); w.w = pk2(p1[6], p1[7]); pb[2] = __builtin_bit_cast(bf16x8, w);
              w.x = pk2(p1[8], p1[9]); w.y = pk2(p1[10], p1[11]); w.z = pk2(p1[12], p1[13]); w.w = pk2(p1[14], p1[15]); pb[3] = __builtin_bit_cast(bf16x8, w); }
            __builtin_amdgcn_sched_barrier(0);
            AT_LDV(vc, 1); __builtin_amdgcn_sched_barrier(0); AT_PV(va, 0); __builtin_amdgcn_sched_barrier(0);
            AT_LDV(va, 2); __builtin_amdgcn_sched_barrier(0); AT_PV(vc, 1); __builtin_amdgcn_sched_barrier(0);
            AT_LDV(vc, 3); __builtin_amdgcn_sched_barrier(0); AT_PV(va, 2); __builtin_amdgcn_sched_barrier(0);
            AT_PV(vc, 3);
            if (t + 1 < NT) AT_STORE((t + 1) & 1);
            __syncthreads();
        }
#undef AT_LDV
#undef AT_PV
#undef AT_LOAD
#undef AT_STORE
        const float ltot = lsum + __shfl_xor(lsum, 32);
        const float invl = 1.f / ltot;
        if (map == 1) { const float f = lam * invl;
#pragma unroll
            for (int d = 0; d < 4; ++d)
#pragma unroll
                for (int i = 0; i < 16; ++i) xch[(qw * 64 + d * 16 + i) * 64 + C.lane] = O[d][i] * f; }
        __syncthreads();
        if (map == 0) { float ss = 0.f;
#pragma unroll
            for (int d = 0; d < 4; ++d)
#pragma unroll
                for (int i = 0; i < 16; ++i) { const float o = O[d][i] * invl - xch[(qw * 64 + d * 16 + i) * 64 + C.lane]; O[d][i] = o; ss += o * o; }
            ss += __shfl_xor(ss, 32);
            const float rn = rsqrtf(ss * (1.f / 128.f) + RMS_EPS) * (1.f - lam_init);
            bf16_t* orow = A2 + (size_t)(qrow0 + qw * 32 + r32) * DM + h * 128;
#pragma unroll
            for (int d = 0; d < 4; ++d)
#pragma unroll
                for (int g4 = 0; g4 < 4; ++g4) { const int dd = 32 * d + 8 * g4 + 4 * hi; const f32x4 sg = *(const f32x4*)(subg + dd);
                    const f32x4 v = {O[d][4 * g4] * rn * sg[0], O[d][4 * g4 + 1] * rn * sg[1], O[d][4 * g4 + 2] * rn * sg[2], O[d][4 * g4 + 3] * rn * sg[3]};
                    st4bf(orow + dd, v); } }
        __syncthreads();
    }
}

__device__ __forceinline__ void phase_rt(const Ctx& C, const Args& A, int l) {
    unsigned char* ws = A.ws; float* X = (float*)(ws + WS_X); bf16_t* H = (bf16_t*)(ws + WS_H); float* AFF = (float*)(ws + WS_AFF);
    const float* MOD = (const float*)(ws + WS_MOD) + (size_t)l * 5 * 6144;
    const float* lng = A.in[I_LNG] + (size_t)(l * 2 + 0) * DM; const float* lnb = A.in[I_LNB] + (size_t)(l * 2 + 0) * DM;
    LAS float* wrs = (LAS float*)C.lds;
    { const float* wr = A.in[I_WR] + (size_t)l * DM * 16; for (int i = C.tid; i < DM * 16; i += NTHR) wrs[(i & 15) * 1024 + (i >> 4)] = wr[i]; }
    __syncthreads();
    for (int row = C.gw; row < MROWS; row += C.NGW) {
        const float* md = MOD + row_mi(row) * 6144;
        f32x4 x[4]; float s = 0.f;
#pragma unroll
        for (int j = 0; j < 4; ++j) { x[j] = *(const f32x4*)(X + (size_t)row * DM + 4 * C.lane + 256 * j); s += (x[j][0] + x[j][1]) + (x[j][2] + x[j][3]); }
        const float mean = wave_sum(s) * (1.f / DM); float s2 = 0.f;
#pragma unroll
        for (int j = 0; j < 4; ++j) { x[j] = x[j] - mean; s2 += (x[j][0] * x[j][0] + x[j][1] * x[j][1]) + (x[j][2] * x[j][2] + x[j][3] * x[j][3]); }
        const float rstd = rsqrtf(wave_sum(s2) * (1.f / DM) + LN_EPS);
        float v[16];
#pragma unroll
        for (int e = 0; e < 16; ++e) v[e] = 0.f;
#pragma unroll
        for (int j = 0; j < 4; ++j) { const int col = 4 * C.lane + 256 * j;
            const f32x4 x1 = x[j] * rstd * *(const f32x4*)(lng + col) + *(const f32x4*)(lnb + col);
            *(f32x4*)(X + (size_t)row * DM + col) = x1;
            const f32x4 h = x1 * (*(const f32x4*)(md + 4 * DM + col) + 1.f) + *(const f32x4*)(md + 3 * DM + col);
            st4bf(H + (size_t)row * DM + col, h);
#pragma unroll
            for (int e = 0; e < 16; ++e) { const f32x4 w = *(const LAS f32x4*)(wrs + e * 1024 + col); v[e] += (h[0] * w[0] + h[1] * w[1]) + (h[2] * w[2] + h[3] * w[3]); }
            __builtin_amdgcn_sched_barrier(0); }
#pragma unroll
        for (int i = 0; i < 8; ++i) { const float send = (C.lane & 32) ? v[i] : v[i + 8], keep = (C.lane & 32) ? v[i + 8] : v[i]; v[i] = keep + __shfl_xor(send, 32); }
#pragma unroll
        for (int i = 0; i < 4; ++i) { const float send = (C.lane & 16) ? v[i] : v[i + 4], keep = (C.lane & 16) ? v[i + 4] : v[i]; v[i] = keep + __shfl_xor(send, 16); }
#pragma unroll
        for (int i = 0; i < 2; ++i) { const float send = (C.lane & 8) ? v[i] : v[i + 2], keep = (C.lane & 8) ? v[i + 2] : v[i]; v[i] = keep + __shfl_xor(send, 8); }
        { const float send = (C.lane & 4) ? v[0] : v[1], keep = (C.lane & 4) ? v[1] : v[0]; v[0] = keep + __shfl_xor(send, 4); }
        float z = v[0]; z += __shfl_xor(z, 1); z += __shfl_xor(z, 2);
        float mx = z;
#pragma unroll
        for (int o = 4; o < 64; o <<= 1) mx = fmaxf(mx, __shfl_xor(mx, o));
        const float ex = expf(z - mx); float sm = ex;
#pragma unroll
        for (int o = 4; o < 64; o <<= 1) sm += __shfl_xor(sm, o);
        if ((C.lane & 3) == 0) AFF[(size_t)row * 16 + (C.lane >> 2)] = ex / sm;
    }
}

__device__ __forceinline__ void phase_tk(const Ctx& C, const Args& A) {
    unsigned char* ws = A.ws; const float* AFF = (const float*)(ws + WS_AFF); int* SLOT = (int*)(ws + WS_SLOT); int* IDX = (int*)(ws + WS_IDX); float* GATE = (float*)(ws + WS_GATE);
    LAS unsigned* key = (LAS unsigned*)C.lds;
    LAS unsigned* hist = key + 8192;
    LAS unsigned* scn = hist + 256;
    LAS unsigned* wtot = scn + 256;
    LAS unsigned* bc = wtot + 8;
    for (int u = blockIdx.x; u < 128; u += C.G) {
        const bool isctx = u >= 64; const int uu = u & 63, b = uu >> 4, e = uu & 15;
        const int n = isctx ? CTXL : TT, cap = isctx ? CAP_C : CAP_L;
        const int row0 = isctx ? NLAT + b * CTXL : b * TT;
        const int slot0 = e * ESLOTS + (isctx ? 4 * CAP_L + b * CAP_C : b * CAP_L);
        for (int i = C.tid; i < n; i += NTHR) key[i] = __float_as_uint(AFF[(size_t)(row0 + i) * 16 + e]);
        unsigned prefix = 0u, pmask = 0u; int need = cap;
        for (int pass = 0; pass < 4; ++pass) {
            const int shift = 24 - 8 * pass;
            if (C.tid < 256) hist[C.tid] = 0u;
            __syncthreads();
            for (int i = C.tid; i < n; i += NTHR) { const unsigned k = key[i]; if ((k & pmask) == prefix) __hip_atomic_fetch_add(&hist[(k >> shift) & 255u], 1u, __ATOMIC_RELAXED, __HIP_MEMORY_SCOPE_WORKGROUP); }
            __syncthreads();
            if (C.tid < 256) scn[C.tid] = hist[C.tid];
            __syncthreads();
            for (int off = 1; off < 256; off <<= 1) {
                unsigned a = 0u; if (C.tid < 256 && C.tid + off < 256) a = scn[C.tid + off];
                __syncthreads();
                if (C.tid < 256) scn[C.tid] += a;
                __syncthreads();
            }
            if (C.tid < 256) { const unsigned above = (C.tid < 255) ? scn[C.tid + 1] : 0u;
                if (scn[C.tid] >= (unsigned)need && above < (unsigned)need) { bc[0] = (unsigned)C.tid; bc[1] = (unsigned)need - above; } }
            __syncthreads();
            prefix |= bc[0] << shift; pmask |= 255u << shift; need = (int)bc[1];
            __syncthreads();
        }
        const int per = (n + NTHR - 1) / NTHR; const int i0 = C.tid * per;
        unsigned cg = 0u, ce = 0u;
        for (int j = 0; j < per; ++j) { const int i = i0 + j; if (i < n) { const unsigned k = key[i]; cg += (k > prefix); ce += (k == prefix); } }
        unsigned pk = cg | (ce << 16), inc = pk;
#pragma unroll
        for (int o = 1; o < 64; o <<= 1) { const unsigned t = __shfl_up(inc, o); if (C.lane >= o) inc += t; }
        if (C.lane == 63) wtot[C.wave] = inc;
        __syncthreads();
        unsigned wbase = 0u;
        for (int w = 0; w < C.wave; ++w) wbase += wtot[w];
        const unsigned excl = wbase + inc - pk;
        unsigned rg = excl & 0xffffu, re = excl >> 16;
        const int ngt = cap - need;
        for (int j = 0; j < per; ++j) { const int i = i0 + j; if (i < n) { const unsigned k = key[i]; int pos = -1;
            if (k > prefix) { pos = (int)rg; ++rg; } else if (k == prefix) { if ((int)re < need) pos = ngt + (int)re; ++re; }
            const int row = row0 + i;
            if (pos >= 0) { IDX[slot0 + pos] = row; GATE[slot0 + pos] = __uint_as_float(k); SLOT[(size_t)row * 16 + e] = slot0 + pos; }
            else SLOT[(size_t)row * 16 + e] = -1; } }
        if (isctx && b == 0 && C.tid < ESLOTS - 4224) { IDX[e * ESLOTS + 4224 + C.tid] = 0; GATE[e * ESLOTS + 4224 + C.tid] = 0.f; }
        __syncthreads();
    }
}

__device__ __forceinline__ void phase_cb(const Ctx& C, const Args& A, int l) {
    unsigned char* ws = A.ws; float* X = (float*)(ws + WS_X); bf16_t* H = (bf16_t*)(ws + WS_H); const int* SLOT = (const int*)(ws + WS_SLOT); const bf16_t* YE = (const bf16_t*)(ws + WS_YE);
    const float* MOD = (const float*)(ws + WS_MOD) + (size_t)l * 5 * 6144; const float* MODN = MOD + 5 * 6144;
    const float* lng = A.in[I_LNG] + (size_t)(l * 2 + 1) * DM; const float* lnb = A.in[I_LNB] + (size_t)(l * 2 + 1) * DM;
    for (int row = C.gw; row < MROWS; row += C.NGW) {
        const int mi = row_mi(row); const float* md = MOD + mi * 6144;
        f32x4 acc[4];
#pragma unroll
        for (int j = 0; j < 4; ++j) acc[j] = (f32x4){0.f, 0.f, 0.f, 0.f};
        for (int e = 0; e < 16; ++e) { const int s = __builtin_amdgcn_readfirstlane(SLOT[(size_t)row * 16 + e]);
            if (s >= 0) {
#pragma unroll
                for (int j = 0; j < 4; ++j) acc[j] += ld4bf(YE + (size_t)s * DM + 4 * C.lane + 256 * j); } }
        f32x4 x[4]; float sm = 0.f;
#pragma unroll
        for (int j = 0; j < 4; ++j) { const int col = 4 * C.lane + 256 * j; x[j] = *(const f32x4*)(X + (size_t)row * DM + col) * ALPHA_DN + *(const f32x4*)(md + 5 * DM + col) * acc[j];
            sm += (x[j][0] + x[j][1]) + (x[j][2] + x[j][3]); }
        const float mean = wave_sum(sm) * (1.f / DM); float s2 = 0.f;
#pragma unroll
        for (int j = 0; j < 4; ++j) { x[j] = x[j] - mean; s2 += (x[j][0] * x[j][0] + x[j][1] * x[j][1]) + (x[j][2] * x[j][2] + x[j][3] * x[j][3]); }
        const float rstd = rsqrtf(wave_sum(s2) * (1.f / DM) + LN_EPS);
#pragma unroll
        for (int j = 0; j < 4; ++j) { const int col = 4 * C.lane + 256 * j;
            const f32x4 x2 = x[j] * rstd * *(const f32x4*)(lng + col) + *(const f32x4*)(lnb + col);
            *(f32x4*)(X + (size_t)row * DM + col) = x2;
            if (l < DEPTH - 1) { const float* mn = MODN + mi * 6144; st4bf(H + (size_t)row * DM + col, x2 * (*(const f32x4*)(mn + DM + col) + 1.f) + *(const f32x4*)(mn + col)); }
            else if (row < NLAT) *(f32x4*)(A.out + (size_t)row * DM + col) = x2; }
    }
}


#ifndef GEMM_NOINLINE
#define GEMM_NOINLINE 0
#endif
#if GEMM_NOINLINE
#define GEMM_FN __device__ __noinline__
#else
#define GEMM_FN __device__ __forceinline__
#endif
GEMM_FN void gphase_in(LAS unsigned char* lds, unsigned char* ws, int nN, int G) {
    pg8::Gemm g{(const bf16_t*)(ws + WS_H), (const bf16_t*)(ws + WS_WIN), DM}; pg8::Order<0> S; S.init(MROWS / 256, nN, G, (int)blockIdx.x, nullptr, 0);
    pg8::EpiBf16 E{(bf16_t*)(ws + WS_P), P_LD}; pg8::gemm_phase(lds, g, S, E); }
GEMM_FN void gphase_in_odd(LAS unsigned char* lds, unsigned char* ws, int G) {
    pg8::Gemm g{(const bf16_t*)(ws + WS_H), (const bf16_t*)(ws + WS_WIN), DM}; pg8::Order<0> S; S.init(MROWS / 256, D_IN_ODD / 256, G, (int)blockIdx.x, nullptr, 0);
    pg8::EpiOdd E{(bf16_t*)(ws + WS_P), (bf16_t*)(ws + WS_Q), (bf16_t*)(ws + WS_KA), (const float*)(ws + WS_ROPE)}; pg8::gemm_phase(lds, g, S, E); }
GEMM_FN void gphase_lora(LAS unsigned char* lds, unsigned char* ws, const float* d0, const float* a0, const float* kal, int G) {
    pg8::Gemm g{(const bf16_t*)(ws + WS_LIN), (const bf16_t*)(ws + WS_WLORA), LORA_K}; pg8::Order<0> S; S.init(MROWS / 256, LORA_N / 256, G, (int)blockIdx.x, nullptr, 0);
    pg8::EpiLora E{(float*)(ws + WS_SCN), (bf16_t*)(ws + WS_G), d0, a0, kal}; pg8::gemm_phase(lds, g, S, E); }
GEMM_FN void gphase_out(LAS unsigned char* lds, unsigned char* ws, const float* modl, int G) {
    pg8::Gemm g{(const bf16_t*)(ws + WS_A2), (const bf16_t*)(ws + WS_WOUT), DM}; pg8::Order<0> S; S.init(MROWS / 256, DM / 256, G, (int)blockIdx.x, nullptr, 0);
    pg8::EpiRes E{(float*)(ws + WS_X), modl}; pg8::gemm_phase(lds, g, S, E); }
GEMM_FN void gphase_e1(LAS unsigned char* lds, unsigned char* ws, int G) {
    pg8::Gemm g{(const bf16_t*)(ws + WS_H), (const bf16_t*)(ws + WS_WE13), DM}; pg8::Order<1> S; S.init(NEXP * 17, 4096 / 256, G, (int)blockIdx.x, (const int*)(ws + WS_IDX), (long)4096 * DM);
    pg8::EpiSwiGLU E{(bf16_t*)(ws + WS_HID)}; pg8::gemm_phase(lds, g, S, E); }
GEMM_FN void gphase_e2(LAS unsigned char* lds, unsigned char* ws, int G) {
    pg8::Gemm g{(const bf16_t*)(ws + WS_HID), (const bf16_t*)(ws + WS_WE2), D_EXP}; pg8::Order<2> S; S.init(NEXP * 17, DM / 256, G, (int)blockIdx.x, nullptr, (long)DM * D_EXP);
    pg8::EpiYE E{(bf16_t*)(ws + WS_YE), (const float*)(ws + WS_GATE)}; pg8::gemm_phase(lds, g, S, E); }

constexpr int NSTEP = 1 + DEPTH * 12;
__global__ void __launch_bounds__(NTHR, 2) mk_fwd(Args KA) {
    extern __shared__ __attribute__((aligned(16))) unsigned char lds_raw[];
    volatile LAS unsigned* MISC = (volatile LAS unsigned*)((LAS unsigned char*)lds_raw + LDS_MISC);
    if (threadIdx.x < 16) MISC[threadIdx.x] = 0u;
    if (threadIdx.x == 0) { LAS unsigned long long* tb = (LAS unsigned long long*)((LAS unsigned char*)lds_raw + LDS_PTAB);
#pragma unroll
        for (int i = 0; i < 37; ++i) tb[i] = (unsigned long long)KA.in[i];
        tb[37] = (unsigned long long)KA.out; tb[38] = (unsigned long long)KA.ws; }
    __syncthreads();
    const int lo = KA.lo, hi = KA.hi;
    unsigned bar_x = 0;
    if (hi - lo > 1) { const XcdBarrier b0 = xcd_barrier_post((unsigned*)(KA.ws + WS_CTL), MISC); bar_x = b0.x; }
#ifndef PH_MASK
#define PH_MASK 0xFFFFFF
#endif
#ifndef REP_MASK
#define REP_MASK 0
#endif
#define PH_BIT(k) (((k) == 0) ? 0 : 1 + ((k) - 1) % 12 + (((k) - 1) % 12 >= 2 && ((k) - 1) % 12 <= 5 && odd ? 12 : 0))
#define RUN(k, ...) do { if (((PH_MASK >> PH_BIT(k)) & 1) && lo <= (k) && (k) < hi) { const int nrep = ((REP_MASK >> PH_BIT(k)) & 1) ? 2 : 1; \
        _Pragma("unroll 1") for (int rep = 0; rep < nrep; ++rep) { \
        Ctx C; mkctx(C, (LAS unsigned char*)lds_raw); Args A; ldargs(A, (LAS unsigned char*)lds_raw); unsigned char* ws = A.ws; \
        const float* MODL = (const float*)(ws + WS_MOD) + (size_t)l * 5 * 6144; (void)MODL; \
        __VA_ARGS__; if ((k) + 1 < hi || rep + 1 < nrep) { XcdBarrier bar; bar.bar = (unsigned*)(ws + WS_CTL); bar.x = bar_x; bar.st = MISC; xcd_barrier(bar); } } } } while (0)
    { const bool odd = false; const int l = 0; RUN(0, phase_init(C, A)); }
#pragma unroll 1
    for (int l = 0; l < DEPTH; ++l) {
        const int sb = 1 + l * 12; const bool odd = l & 1;
        RUN(sb + 0, { phase_conv(C, A, l); if (l == 0) phase_modh(C, A, 0); });
        if (odd) { RUN(sb + 1, gphase_in_odd(C.lds, ws, C.G)); } else { RUN(sb + 1, gphase_in(C.lds, ws, D_IN_EVEN_PAD / 256, C.G)); }
        if (!odd) {
            RUN(sb + 2, phase_ef1(C, A, l));
            RUN(sb + 3, { const int i2 = l >> 1; gphase_lora(C.lds, ws, A.in[I_D0] + (size_t)i2 * 2 * 768, A.in[I_A0] + (size_t)i2 * 2 * 768, A.in[I_KAL] + (size_t)i2 * 768, C.G); });
            RUN(sb + 4, phase_scan(C, A));
            RUN(sb + 5, phase_ef2(C, A, l));
        } else {
            RUN(sb + 2, phase_of1(C, A, l));
            RUN(sb + 3, phase_attn(C, A, l));
        }
        RUN(sb + 6, gphase_out(C.lds, ws, MODL, C.G));
        RUN(sb + 7, phase_rt(C, A, l));
        RUN(sb + 8, phase_tk(C, A));
        RUN(sb + 9, gphase_e1(C.lds, ws, C.G));
        RUN(sb + 10, gphase_e2(C.lds, ws, C.G));
        RUN(sb + 11, phase_cb(C, A, l));
    }
#undef RUN
}

#ifdef PHASE_PROBE
#define PROBE_PRE extern __shared__ __attribute__((aligned(16))) unsigned char lds_raw[]; Ctx C; mkctx(C, (LAS unsigned char*)lds_raw); unsigned char* ws = A.ws; (void)ws;
__global__ void __launch_bounds__(NTHR, 2) pr_init(Args A) { PROBE_PRE phase_init(C, A); }
__global__ void __launch_bounds__(NTHR, 2) pr_conv(Args A) { PROBE_PRE phase_conv(C, A, A.lo); }
__global__ void __launch_bounds__(NTHR, 2) pr_modh(Args A) { PROBE_PRE phase_modh(C, A, A.lo); }
__global__ void __launch_bounds__(NTHR, 2) pr_ef1(Args A) { PROBE_PRE phase_ef1(C, A, A.lo); }
__global__ void __launch_bounds__(NTHR, 2) pr_scan(Args A) { PROBE_PRE phase_scan(C, A); }
__global__ void __launch_bounds__(NTHR, 2) pr_ef2(Args A) { PROBE_PRE phase_ef2(C, A, A.lo); }
__global__ void __launch_bounds__(NTHR, 2) pr_of1(Args A) { PROBE_PRE phase_of1(C, A, A.lo); }
__global__ void __launch_bounds__(NTHR, 2) pr_attn(Args A) { PROBE_PRE phase_attn(C, A, A.lo); }
__global__ void __launch_bounds__(NTHR, 2) pr_rt(Args A) { PROBE_PRE phase_rt(C, A, A.lo); }
__global__ void __launch_bounds__(NTHR, 2) pr_tk(Args A) { PROBE_PRE phase_tk(C, A); }
__global__ void __launch_bounds__(NTHR, 2) pr_cb(Args A) { PROBE_PRE phase_cb(C, A, A.lo); }
__global__ void __launch_bounds__(NTHR, 2) pr_gemm_in(Args A) { PROBE_PRE pg8::Gemm g{(const bf16_t*)(ws + WS_H), (const bf16_t*)(ws + WS_WIN), DM}; pg8::Order<0> S; S.init(MROWS / 256, A.lo, C.G, (int)blockIdx.x, nullptr, 0);
                      pg8::EpiBf16 E{(bf16_t*)(ws + WS_P), P_LD}; pg8::gemm_phase(C.lds, g, S, E); }
__global__ void __launch_bounds__(NTHR, 2) pr_gemm_lora(Args A) { PROBE_PRE pg8::Gemm g{(const bf16_t*)(ws + WS_LIN), (const bf16_t*)(ws + WS_WLORA), LORA_K}; pg8::Order<0> S; S.init(MROWS / 256, LORA_N / 256, C.G, (int)blockIdx.x, nullptr, 0);
                          const int i2 = A.lo; pg8::EpiLora E{(float*)(ws + WS_SCN), (bf16_t*)(ws + WS_G), A.in[I_D0] + (size_t)i2 * 2 * 768, A.in[I_A0] + (size_t)i2 * 2 * 768, A.in[I_KAL] + (size_t)i2 * 768};
                          pg8::gemm_phase(C.lds, g, S, E); }
__global__ void __launch_bounds__(NTHR, 2) pr_gemm_out(Args A) { PROBE_PRE pg8::Gemm g{(const bf16_t*)(ws + WS_A2), (const bf16_t*)(ws + WS_WOUT), DM}; pg8::Order<0> S; S.init(MROWS / 256, DM / 256, C.G, (int)blockIdx.x, nullptr, 0);
                      pg8::EpiRes E{(float*)(ws + WS_X), (const float*)(ws + WS_MOD)}; pg8::gemm_phase(C.lds, g, S, E); }
__global__ void __launch_bounds__(NTHR, 2) pr_gemm_e1(Args A) { PROBE_PRE pg8::Gemm g{(const bf16_t*)(ws + WS_H), (const bf16_t*)(ws + WS_WE13), DM}; pg8::Order<1> S; S.init(NEXP * 17, 4096 / 256, C.G, (int)blockIdx.x, (const int*)(ws + WS_IDX), (long)4096 * DM);
                      pg8::EpiSwiGLU E{(bf16_t*)(ws + WS_HID)}; pg8::gemm_phase(C.lds, g, S, E); }
__global__ void __launch_bounds__(NTHR, 2) pr_gemm_e2(Args A) { PROBE_PRE pg8::Gemm g{(const bf16_t*)(ws + WS_HID), (const bf16_t*)(ws + WS_WE2), D_EXP}; pg8::Order<2> S; S.init(NEXP * 17, DM / 256, C.G, (int)blockIdx.x, nullptr, (long)DM * D_EXP);
                       pg8::EpiYE E{(bf16_t*)(ws + WS_YE), (const float*)(ws + WS_GATE)}; pg8::gemm_phase(C.lds, g, S, E); }
#endif

extern "C" void kernel_launch(void* const* d_in, const int* in_sizes, int n_in, void* d_out, int out_size, void* d_ws, size_t ws_size, hipStream_t stream) {
    static int grid = 0;
    if (grid == 0) {
        if (n_in != 37 || out_size != NLAT * DM || ws_size < WS_END) { fprintf(stderr, "kernel_launch: unexpected shapes: n_in %d out %d ws %zu (need %zu)\n", n_in, out_size, ws_size, (size_t)WS_END); grid = -1; return; }
        int dev = 0, cus = 0, per_cu = 0;
        if (hipGetDevice(&dev) != hipSuccess || hipDeviceGetAttribute(&cus, hipDeviceAttributeMultiprocessorCount, dev) != hipSuccess) { grid = -1; return; }
        if (hipFuncSetAttribute((const void*)mk_fwd, hipFuncAttributeMaxDynamicSharedMemorySize, LDS_BYTES) != hipSuccess) { fprintf(stderr, "kernel_launch: hipFuncSetAttribute failed\n"); grid = -1; return; }
        if (hipOccupancyMaxActiveBlocksPerMultiprocessor(&per_cu, (const void*)mk_fwd, NTHR, LDS_BYTES) != hipSuccess || per_cu < 1) fprintf(stderr, "kernel_launch: occupancy query reports %d\n", per_cu);
        (void)hipGetLastError();
        grid = cus;
    }
    if (grid < 0) return;
    (void)hipMemsetAsync((char*)d_ws + WS_CTL, 0, CTL_BYTES, stream);
    Args a{};
    for (int i = 0; i < 37; ++i) a.in[i] = (const float*)d_in[i];
    a.out = (float*)d_out; a.ws = (unsigned char*)d_ws;
#if MK_MULTI
    for (int k = 0; k < NSTEP; ++k) {
        if (k >= 1) { const int l = (k - 1) / 12, s = (k - 1) % 12; if ((l & 1) && (s == 4 || s == 5)) continue; }
        a.lo = k; a.hi = k + 1;
        hipLaunchKernelGGL(mk_fwd, dim3(grid), dim3(NTHR), LDS_BYTES, stream, a);
    }
#else
    a.lo = 0; a.hi = NSTEP;
    hipLaunchKernelGGL(mk_fwd, dim3(grid), dim3(NTHR), LDS_BYTES, stream, a);
#endif
    const hipError_t le = hipPeekAtLastError();
    if (le != hipSuccess) fprintf(stderr, "kernel_launch: launch failed: %s\n", hipGetErrorName(le));
}
```

```cpp
#include <hip/hip_runtime.h>
#include <cstdio>
#include <cstdint>
#include <cmath>

#ifndef MK_MULTI
#define MK_MULTI 0
#endif

#define GAS __attribute__((address_space(1)))
#define LAS __attribute__((address_space(3)))
typedef unsigned short bf16_t;
typedef short bf16x8 __attribute__((ext_vector_type(8)));
typedef float f32x4 __attribute__((ext_vector_type(4)));
typedef float f32x2 __attribute__((ext_vector_type(2)));
typedef float f32x16 __attribute__((ext_vector_type(16)));
typedef unsigned u32x4 __attribute__((ext_vector_type(4)));
typedef unsigned u32x2 __attribute__((ext_vector_type(2)));
typedef __bf16 bf16x2_t __attribute__((ext_vector_type(2)));

constexpr int NB = 4, TT = 8192, DM = 1024, NLAT = NB * TT, CTXL = 256, NCTX = NB * CTXL, MROWS = NLAT + NCTX;
constexpr int DEPTH = 4;
constexpr int D_CONV = 256, RW_H = 12, RW_K = 64, D_RWKV = 768, RWKV_COLS = 2688, D_IN_EVEN = 3456, D_IN_EVEN_PAD = 3584;
constexpr int D_DIFF = 768, D_GMLP = 256, D_IN_ODD = 2816;
constexpr int NEXP = 16, D_EXP = 2048, CAP_L = 1024, CAP_C = 32, ESLOTS = 4352;
constexpr int P_LD = 3584;
constexpr int LORA_K = 384, LORA_N = 3840;
constexpr int LKEYS = CTXL + TT;
constexpr float ALPHA_DN = 1.6817928305074290f;
constexpr float DECAY_SCALE = 0.6065306597126334f;
constexpr float GN_EPS = 64e-5f, LN_EPS = 1e-5f, RMS_EPS = 1e-5f;
constexpr float QSCALE = 0.125f * 1.4426950408889634f;

constexpr size_t al256(size_t x) { return (x + 255) & ~(size_t)255; }
constexpr size_t WS_CTL = 0;
constexpr size_t CTL_BYTES = 65536;
constexpr size_t WS_MOD = WS_CTL + CTL_BYTES;
constexpr size_t WS_ROPE = WS_MOD + al256((size_t)DEPTH * 5 * 6144 * 4);
constexpr size_t WS_WIN = WS_ROPE + 32768;
constexpr size_t WS_WOUT = WS_WIN + (size_t)D_IN_EVEN_PAD * DM * 2;
constexpr size_t WS_WLORA = WS_WOUT + (size_t)DM * DM * 2;
constexpr size_t WS_WE13 = WS_WLORA + (size_t)LORA_N * LORA_K * 2;
constexpr size_t WS_WE2 = WS_WE13 + (size_t)NEXP * 4096 * DM * 2;
constexpr size_t WS_X = WS_WE2 + (size_t)NEXP * DM * D_EXP * 2;
constexpr size_t WS_H = WS_X + (size_t)MROWS * DM * 4;
constexpr size_t WS_A2 = WS_H + (size_t)MROWS * DM * 2;
constexpr size_t WS_P = WS_A2 + (size_t)MROWS * DM * 2;
constexpr size_t WS_AFF = WS_P + (size_t)MROWS * P_LD * 2;
constexpr size_t WS_SLOT = WS_AFF + (size_t)MROWS * 16 * 4;
constexpr size_t WS_IDX = WS_SLOT + (size_t)MROWS * 16 * 4;
constexpr size_t WS_GATE = WS_IDX + al256((size_t)NEXP * ESLOTS * 4);
constexpr size_t WS_R2 = WS_GATE + al256((size_t)NEXP * ESLOTS * 4);
constexpr int SC_REC = 1408, SC_ROW = 12 * SC_REC, SC_W = 0, SC_R = 512, SC_KK = 640, SC_V = 768, SC_B = 896, SC_KR = 1024;
constexpr size_t WS_SCN = WS_R2;
constexpr size_t WS_G = WS_SCN + (size_t)MROWS * SC_ROW;
constexpr size_t WS_LIN = WS_G + (size_t)MROWS * 768 * 2;
constexpr size_t WS_EVEN_END = WS_LIN + (size_t)MROWS * 384 * 2;
constexpr size_t WS_Y = WS_P;
constexpr size_t WS_Q = WS_R2;
constexpr size_t WS_KA = WS_Q + (size_t)MROWS * 768 * 2;
constexpr size_t WS_VT = WS_KA + (size_t)NB * LKEYS * 768 * 2;
constexpr size_t WS_HID = WS_R2;
constexpr size_t WS_YE = WS_HID + (size_t)NEXP * ESLOTS * D_EXP * 2;
constexpr size_t WS_END = WS_EVEN_END;
static_assert(WS_END <= (size_t)2147483648ull, "workspace over 2 GiB");
static_assert((size_t)2 * MROWS * 768 * 4 <= (size_t)MROWS * P_LD * 2, "Y aliases P");
static_assert(WS_YE + (size_t)NEXP * ESLOTS * DM * 2 <= WS_END, "moe region");

constexpr int LDS_BYTES = 147456;
constexpr int LDS_MISC = 140 * 1024;
constexpr int LDS_PTAB = LDS_MISC + 256;
constexpr int NWAVES = 8, NTHR = 512;

__device__ __forceinline__ unsigned f2bf(float f) { unsigned u = __float_as_uint(f); return (u + 0x7fffu + ((u >> 16) & 1u)) >> 16; }
__device__ __forceinline__ unsigned pk2(float lo, float hi) { f32x2 v = {lo, hi}; bf16x2_t b = __builtin_convertvector(v, bf16x2_t); return __builtin_bit_cast(unsigned, b); }
__device__ __forceinline__ float bflo(unsigned u) { return __uint_as_float(u << 16); }
__device__ __forceinline__ float bfhi(unsigned u) { return __uint_as_float(u & 0xffff0000u); }
__device__ __forceinline__ float bf2f(bf16_t b) { return __uint_as_float((unsigned)b << 16); }
__device__ __forceinline__ float sigmoidf_(float x) { return 1.f / (1.f + __expf(-x)); }
__device__ __forceinline__ float wave_sum(float v) {
#pragma unroll
    for (int o = 1; o < 64; o <<= 1) v += __shfl_xor(v, o);
    return v;
}
__device__ __forceinline__ float sum16(float v) {
#pragma unroll
    for (int o = 1; o < 16; o <<= 1) v += __shfl_xor(v, o);
    return v;
}
__device__ __forceinline__ f32x4 ld4bf_(const void* p) { const u32x2 u = *(const u32x2*)p; return (f32x4){bflo(u.x), bfhi(u.x), bflo(u.y), bfhi(u.y)}; }
__device__ __forceinline__ void st4bf_(void* p, f32x4 v) { u32x2 o; o.x = pk2(v[0], v[1]); o.y = pk2(v[2], v[3]); *(u32x2*)p = o; }
__device__ __forceinline__ float gelu_erf(float x) { return 0.5f * x * (1.f + erff(x * 0.70710678118654752f)); }

#define XB_TMO      128
#define XB_XCNT(j)  (256  + 64 * (j))
#define XB_XSUB(j)  (1280 + 64 * (j))
#define XB_XGEN(j)  (2304 + 64 * (j))
#define XB_TOP      3328
#define XB_TOPGEN   3392
#define XCD_BAR_WORDS 3456
#define XB_SPIN_CAP (1u << 20)

__device__ __forceinline__ unsigned xb_ld(unsigned* p)              { return __hip_atomic_load(p, __ATOMIC_RELAXED, __HIP_MEMORY_SCOPE_AGENT); }
__device__ __forceinline__ unsigned xb_add(unsigned* p, unsigned v) { return __hip_atomic_fetch_add(p, v, __ATOMIC_RELAXED, __HIP_MEMORY_SCOPE_AGENT); }
__device__ __forceinline__ unsigned xb_xcc_id() { return (unsigned)__builtin_amdgcn_s_getreg((3 << 11) | 20) & 0xFu; }
#define XB_SPIN(cond, bar) do { unsigned _sp = 0; while (cond) { __builtin_amdgcn_s_sleep(1); \
    if ((++_sp & 255u) == 0u) { if (xb_ld(&(bar)[XB_TMO])) break; if (_sp > XB_SPIN_CAP) { atomicAdd(&(bar)[XB_TMO], 1u); break; } } } } while (0)

struct XcdBarrier { unsigned* bar; unsigned x; volatile LAS unsigned* st; };

__device__ __forceinline__ XcdBarrier xcd_barrier_post(unsigned* bar, volatile LAS unsigned* st) {
    XcdBarrier b; b.bar = bar; b.x = xb_xcc_id(); b.st = st;
    if (threadIdx.x == 0) (void)xb_add(&bar[XB_XCNT(b.x)], 1u);
    return b;
}
__device__ __forceinline__ void xcd_barrier_complete(unsigned* bar, unsigned x, unsigned& nloc, unsigned& nx) {
    const unsigned G = gridDim.x * gridDim.y * gridDim.z;
    unsigned sum, cnt, mine, sp = 0u;
    for (;;) {
        sum = 0u; cnt = 0u; mine = 0u;
#pragma unroll
        for (unsigned j = 0; j < 16; ++j) { const unsigned c = xb_ld(&bar[XB_XCNT(j)]); sum += c; cnt += (c > 0u) ? 1u : 0u; mine = (j == x) ? c : mine; }
        if (sum == G) break;
        __builtin_amdgcn_s_sleep(1);
        if ((++sp & 255u) == 0u) { if (xb_ld(&bar[XB_TMO])) break; if (sp > XB_SPIN_CAP) { atomicAdd(&bar[XB_TMO], 1u); break; } }
    }
    nloc = mine > 0u ? mine : 1u; nx = cnt > 0u ? cnt : 1u;
}
__device__ __forceinline__ void xcd_barrier(const XcdBarrier& b) {
    asm volatile("s_waitcnt vmcnt(0)" ::: "memory");
    __syncthreads();
    if (threadIdx.x == 0) {
        unsigned* bar = b.bar;
        __builtin_amdgcn_s_waitcnt(0);
        unsigned nloc = b.st[0], nx = b.st[1];
        if (nloc == 0u) { xcd_barrier_complete(bar, b.x, nloc, nx); b.st[0] = nloc; b.st[1] = nx; }
        const unsigned old = xb_add(&bar[XB_XSUB(b.x)], 1u);
        const unsigned gen = old / nloc;
        if (old + 1u == (gen + 1u) * nloc) {
            __builtin_amdgcn_fence(__ATOMIC_RELEASE, "agent");
            asm volatile("s_waitcnt vmcnt(0)" ::: "memory");
            const unsigned og = xb_add(&bar[XB_TOP], 1u);
            const unsigned tg = og / nx;
            if (og + 1u == (tg + 1u) * nx) xb_add(&bar[XB_TOPGEN], 1u);
            else XB_SPIN(xb_ld(&bar[XB_TOPGEN]) == tg, bar);
            __builtin_amdgcn_fence(__ATOMIC_ACQUIRE, "agent");
            xb_add(&bar[XB_XGEN(b.x)], 1u);
            asm volatile("s_waitcnt vmcnt(0)" ::: "memory");
        } else {
            XB_SPIN(xb_ld(&bar[XB_XGEN(b.x)]) == gen, bar);
            __builtin_amdgcn_fence(__ATOMIC_ACQUIRE, "agent");
            asm volatile("s_waitcnt vmcnt(0)" ::: "memory");
        }
    }
    __syncthreads();
}

namespace pg8 {
constexpr int BM = 256, BK = 64, HALF = 128, HTB = HALF * BK * 2, STAGE_BYTES = 8 * HTB, NXCD = 8, WGM = 8;
__host__ __device__ __forceinline__ int lds_byte(int r, int c) { const int st = (r >> 4) * 2 + (c >> 5), rr = r & 15, cc = c & 31, ob = rr * 64 + cc * 2; return st * 1024 + (ob ^ (((ob >> 9) & 1) << 5)); }
__host__ __device__ __forceinline__ void stage_rc(int b, int& R, int& C) { const int st = b / 1024, sb = b % 1024, swz = sb ^ (((sb >> 9) & 1) << 5); R = (st >> 1) * 16 + swz / 64; C = (st & 1) * 32 + (swz % 64) / 2; }

struct Unit { int pm, pn; };
struct Gemm { const bf16_t* A; const bf16_t* Bt; int K; };

template <int MODE> struct Order {
    int nM, nN, nwg, G, c; const int* idx; long bstride;
    __device__ __forceinline__ void init(int nM_, int nN_, int G_, int c_, const int* idx_, long bstride_) { nM = nM_; nN = nN_; nwg = nM * nN; G = G_; c = c_; idx = idx_; bstride = bstride_; }
    __device__ __forceinline__ bool next(int i, Unit& u) const {
        const long L = (long)i * G + c; if (L >= nwg) return false;
        int wgid = (int)L; { const int q = nwg / NXCD, r = nwg % NXCD, xcd = wgid % NXCD, off = wgid / NXCD; wgid = (xcd < r ? xcd * (q + 1) : r * (q + 1) + (xcd - r) * q) + off; }
        const int nig = WGM * nN, gid = wgid / nig, fm = gid * WGM, gsz = (nM - fm) < WGM ? (nM - fm) : WGM;
        u.pm = fm + ((wgid % nig) % gsz); u.pn = (wgid % nig) / gsz; return true;
    }
    __device__ __forceinline__ unsigned arow(const Unit& u, int r) const { if (MODE == 1) return (unsigned)idx[u.pm * BM + r]; return (unsigned)(u.pm * BM + r); }
    __device__ __forceinline__ long bbase(const Unit& u, int K) const { long o = (long)u.pn * BM * K; if (MODE != 0) o += (long)(u.pm / 17) * bstride; return o; }
};

template <class Epi, class Sched>
__device__ __forceinline__ void gemm_phase(LAS unsigned char* lds, const Gemm g, const Sched& S, const Epi& E) {
    int tid = threadIdx.x; asm volatile("" : "+v"(tid));
    const int wid = __builtin_amdgcn_readfirstlane(tid >> 6), wr = wid >> 2, wc = wid & 3;
    const int K = g.K, nt = K / BK;
    unsigned voffB[2];
    { const int lane = tid & 63, fr = lane & 15, fq = lane >> 4; (void)fr; (void)fq; }
#pragma unroll
    for (int i = 0; i < 2; ++i) { int R, Cc; stage_rc(tid * 16 + i * 8192, R, Cc); voffB[i] = (unsigned)(R * K + Cc) * 2u; }
    const size_t kstep = (size_t)(BK * 2);
    const size_t hstep = (size_t)HALF * K * 2;
    const unsigned ldsw = (unsigned)wid * 1024u;
    const int aoff = lds_byte(wr * 64 + (tid & 15), ((tid & 63) >> 4) * 8), boff = lds_byte(wc * 32 + (tid & 15), ((tid & 63) >> 4) * 8);
#define PG8_SA(b, h) (((b) * 2 + (h)) * HTB)
#define PG8_SB(b, h) ((4 + (b) * 2 + (h)) * HTB)
#define PG8_STAGE(bufoff, gbase, voff) do { _Pragma("unroll") for (int _i = 0; _i < 2; ++_i) \
        __builtin_amdgcn_global_load_lds((const unsigned*)((const char*)(gbase) + (voff)[_i]), (LAS unsigned*)(lds + (bufoff) + ldsw + _i * 8192), 16, 0, 0); } while (0)
#define PG8_LDA(dst, b, h) do { _Pragma("unroll") for (int m = 0; m < 4; ++m) _Pragma("unroll") for (int k = 0; k < 2; ++k) dst[m][k] = *(const LAS bf16x8*)(lds + PG8_SA(b, h) + aoff + m * 2048 + k * 1024); } while (0)
#define PG8_LDB(dst, b, h) do { _Pragma("unroll") for (int n = 0; n < 2; ++n) _Pragma("unroll") for (int k = 0; k < 2; ++k) dst[n][k] = *(const LAS bf16x8*)(lds + PG8_SB(b, h) + boff + n * 2048 + k * 1024); } while (0)
#define PG8_MMA(ai, bj, At, Bt) do { __builtin_amdgcn_s_setprio(1); _Pragma("unroll") for (int m = 0; m < 4; ++m) _Pragma("unroll") for (int n = 0; n < 2; ++n) _Pragma("unroll") for (int k = 0; k < 2; ++k) \
        acc[ai][bj][m][n] = __builtin_amdgcn_mfma_f32_16x16x32_bf16(Bt[n][k], At[m][k], acc[ai][bj][m][n], 0, 0, 0); __builtin_amdgcn_s_setprio(0); } while (0)
#define PG8_WAIT_V(n) asm volatile("s_waitcnt vmcnt(" #n ")" ::: "memory")
#define PG8_WAIT_L(n) asm volatile("s_waitcnt lgkmcnt(" #n ")" ::: "memory")
#define PG8_BAR __builtin_amdgcn_s_barrier()
#define PG8_SCHED __builtin_amdgcn_sched_barrier(0)
#define PG8_ROWOFFS(dst, u, tq) do { _Pragma("unroll") for (int _i = 0; _i < 2; ++_i) { int _R, _C; stage_rc((tq) * 16 + _i * 8192, _R, _C); _Pragma("unroll") for (int _h = 0; _h < 2; ++_h) dst[_h][_i] = (S.arow(u, _h * HALF + _R) * (unsigned)K + (unsigned)_C) * 2u; } } while (0)
    Unit cur, nxt; int ui = 0;
    if (!S.next(0, cur)) return;
    f32x4 acc[2][2][4][2];
#pragma unroll
    for (int a = 0; a < 2; ++a)
#pragma unroll
        for (int b = 0; b < 2; ++b)
#pragma unroll
            for (int m = 0; m < 4; ++m)
#pragma unroll
                for (int n = 0; n < 2; ++n) acc[a][b][m][n] = (f32x4){0.f, 0.f, 0.f, 0.f};
    bf16x8 At[4][2], B0[2][2], B1[2][2];
    unsigned vcur[2][2];
    PG8_ROWOFFS(vcur, cur, tid);
    const char* const Ab = (const char*)g.A;
    const char* cB = (const char*)g.Bt + (size_t)S.bbase(cur, K) * 2;
    PG8_STAGE(PG8_SB(0, 0), cB, voffB); PG8_STAGE(PG8_SB(0, 1), cB + hstep, voffB); PG8_STAGE(PG8_SA(0, 0), Ab, vcur[0]); PG8_STAGE(PG8_SA(0, 1), Ab, vcur[1]);
    if (wr == 1) PG8_BAR;
    PG8_WAIT_V(2); PG8_BAR;
    PG8_STAGE(PG8_SB(1, 0), cB + kstep, voffB); PG8_STAGE(PG8_SA(1, 0), Ab + kstep, vcur[0]); PG8_STAGE(PG8_SB(1, 1), cB + hstep + kstep, voffB);
    PG8_WAIT_V(6); PG8_BAR;
    for (;;) {
        const bool has_next = S.next(ui + 1, nxt);
        const char* nB = has_next ? (const char*)g.Bt + (size_t)S.bbase(nxt, K) * 2 : cB;
        for (int t = 0; t < nt; t += 2) {
            const bool last = (t == nt - 2);
            const char* a1 = Ab + (size_t)(t + 1) * kstep;
            const char* a2 = last ? Ab : Ab + (size_t)(t + 2) * kstep; const char* b2 = last ? nB : cB + (size_t)(t + 2) * kstep;
            const char* a3 = a2 + kstep; const char* b3 = b2 + kstep;
            PG8_LDB(B0, 0, 0); PG8_LDB(B1, 0, 1); PG8_SCHED; PG8_LDA(At, 0, 0); PG8_STAGE(PG8_SA(1, 1), a1, vcur[1]);
            PG8_WAIT_V(8); PG8_WAIT_L(0); PG8_BAR; PG8_MMA(0, 0, At, B0); PG8_MMA(0, 1, At, B1); PG8_BAR; PG8_SCHED;
            if (last && has_next) { int tq = tid; asm volatile("" : "+v"(tq)); PG8_ROWOFFS(vcur, nxt, tq); }
            PG8_LDA(At, 0, 1); PG8_STAGE(PG8_SB(0, 0), b2, voffB); PG8_STAGE(PG8_SB(0, 1), b2 + hstep, voffB); PG8_STAGE(PG8_SA(0, 0), a2, vcur[0]);
            PG8_WAIT_V(8); PG8_WAIT_L(0); PG8_BAR; PG8_MMA(1, 0, At, B0); PG8_MMA(1, 1, At, B1); PG8_BAR; PG8_SCHED;
            PG8_LDB(B0, 1, 0); PG8_LDB(B1, 1, 1); PG8_SCHED; PG8_LDA(At, 1, 0); PG8_STAGE(PG8_SA(0, 1), a2, vcur[1]);
            PG8_WAIT_V(8); PG8_WAIT_L(0); PG8_BAR; PG8_MMA(0, 0, At, B0); PG8_MMA(0, 1, At, B1); PG8_BAR; PG8_SCHED;
            PG8_LDA(At, 1, 1); PG8_STAGE(PG8_SB(1, 0), b3, voffB); PG8_STAGE(PG8_SB(1, 1), b3 + hstep, voffB); PG8_STAGE(PG8_SA(1, 0), a3, vcur[0]);
            PG8_WAIT_V(8); PG8_WAIT_L(0); PG8_BAR; PG8_MMA(1, 0, At, B0); PG8_MMA(1, 1, At, B1); PG8_BAR; PG8_SCHED;
        }
        if (wr == 0) PG8_BAR;
        { int tz = tid; asm volatile("" : "+v"(tz)); const int ln = tz & 63; E(acc, cur, wr, wc, ln & 15, ln >> 4); }
        if (!has_next) break;
#pragma unroll
        for (int a = 0; a < 2; ++a)
#pragma unroll
            for (int b = 0; b < 2; ++b)
#pragma unroll
                for (int m = 0; m < 4; ++m)
#pragma unroll
                    for (int n = 0; n < 2; ++n) acc[a][b][m][n] = (f32x4){0.f, 0.f, 0.f, 0.f};
        cur = nxt; cB = nB; ++ui;
        if (wr == 1) PG8_BAR;
    }
    PG8_WAIT_V(0);
    PG8_BAR;
#undef PG8_SA
#undef PG8_SB
#undef PG8_STAGE
#undef PG8_LDA
#undef PG8_LDB
#undef PG8_MMA
#undef PG8_WAIT_V
#undef PG8_WAIT_L
#undef PG8_BAR
#undef PG8_SCHED
#undef PG8_ROWOFFS
}

#define EPI_LOOP for (int ai = 0; ai < 2; ++ai) for (int m = 0; m < 4; ++m) for (int bj = 0; bj < 2; ++bj) for (int n = 0; n < 2; ++n)
struct EpiBf16 {
    bf16_t* O; int ldc;
    __device__ __forceinline__ void operator()(const f32x4 (&acc)[2][2][4][2], const Unit& u, int wr, int wc, int fr, int fq) const {
        const int row0 = u.pm * BM + wr * 64 + fr, col0 = u.pn * BM + wc * 32 + 4 * fq;
#pragma unroll
        for (int ai = 0; ai < 2; ++ai)
#pragma unroll
            for (int m = 0; m < 4; ++m) { bf16_t* rowp = O + (size_t)(row0 + ai * HALF + m * 16) * ldc + col0;
#pragma unroll
                for (int bj = 0; bj < 2; ++bj)
#pragma unroll
                    for (int n = 0; n < 2; ++n) { const f32x4 v = acc[ai][bj][m][n]; u32x2 o; o.x = pk2(v[0], v[1]); o.y = pk2(v[2], v[3]); *(u32x2*)(rowp + bj * HALF + n * 16) = o; } }
    }
};
struct EpiOdd {
    bf16_t* P; bf16_t* Q; bf16_t* KA; const float* rope;
    __device__ __forceinline__ void operator()(const f32x4 (&acc)[2][2][4][2], const Unit& u, int wr, int wc, int fr, int fq) const {
        const int row0 = u.pm * BM + wr * 64 + fr, col0 = u.pn * BM + wc * 32 + 4 * fq;
        if (u.pn >= 6) {
#pragma unroll
            for (int ai = 0; ai < 2; ++ai)
#pragma unroll
                for (int m = 0; m < 4; ++m) { bf16_t* rowp = P + (size_t)(row0 + ai * HALF + m * 16) * P_LD + col0;
#pragma unroll
                    for (int bj = 0; bj < 2; ++bj)
#pragma unroll
                        for (int n = 0; n < 2; ++n) { const f32x4 v = acc[ai][bj][m][n]; u32x2 o; o.x = pk2(v[0], v[1]); o.y = pk2(v[2], v[3]); *(u32x2*)(rowp + bj * HALF + n * 16) = o; } }
            return;
        }
        const bool isk = u.pn >= 3, isctx = u.pm >= NLAT / BM; const int axis = wc & 1;
        const int cq = col0 - (isk ? 768 : 0);
#pragma unroll
        for (int ai = 0; ai < 2; ++ai)
#pragma unroll
            for (int m = 0; m < 4; ++m) { const int row = row0 + ai * HALF + m * 16;
                f32x4 cs = {1.f, 1.f, 1.f, 1.f}, sn = {0.f, 0.f, 0.f, 0.f}; size_t orow;
                if (!isctx) { const int t = row & (TT - 1); const int pos = axis ? 128 + (t & 63) : (t >> 6);
                    cs = *(const f32x4*)(rope + pos * 16 + 4 * fq); sn = *(const f32x4*)(rope + 192 * 16 + pos * 16 + 4 * fq);
                    orow = isk ? (size_t)(row >> 13) * LKEYS + CTXL + t : (size_t)row; }
                else { const int rc = row - NLAT; orow = isk ? (size_t)(rc >> 8) * LKEYS + (rc & 255) : (size_t)row; }
                bf16_t* op = (isk ? KA : Q) + orow * 768 + cq; const float sc = isk ? 1.f : QSCALE;
#pragma unroll
                for (int bj = 0; bj < 2; ++bj) { const f32x4 x1 = acc[ai][bj][m][0], x2 = acc[ai][bj][m][1];
                    const f32x4 o1 = (x1 * cs - x2 * sn) * sc, o2 = (x1 * sn + x2 * cs) * sc;
                    u32x2 a; a.x = pk2(o1[0], o1[1]); a.y = pk2(o1[2], o1[3]); *(u32x2*)(op + bj * HALF) = a;
                    u32x2 b; b.x = pk2(o2[0], o2[1]); b.y = pk2(o2[2], o2[3]); *(u32x2*)(op + bj * HALF + 16) = b; } }
    }
};
struct EpiRes {
    float* X; const float* modl;
    __device__ __forceinline__ void operator()(const f32x4 (&acc)[2][2][4][2], const Unit& u, int wr, int wc, int fr, int fq) const {
        const int row0 = u.pm * BM + wr * 64 + fr, col0 = u.pn * BM + wc * 32 + 4 * fq;
        const int mi = (u.pm * BM < NLAT) ? (u.pm * BM) / TT : 4;
        const float* gate = modl + mi * 6144 + 2 * DM;
        f32x4 gv[2][2];
#pragma unroll
        for (int bj = 0; bj < 2; ++bj)
#pragma unroll
            for (int n = 0; n < 2; ++n) gv[bj][n] = *(const f32x4*)(gate + col0 + bj * HALF + n * 16);
#pragma unroll
        for (int ai = 0; ai < 2; ++ai)
#pragma unroll
            for (int m = 0; m < 4; ++m) { float* rowp = X + (size_t)(row0 + ai * HALF + m * 16) * DM + col0;
#pragma unroll
                for (int bj = 0; bj < 2; ++bj)
#pragma unroll
                    for (int n = 0; n < 2; ++n) { f32x4* p = (f32x4*)(rowp + bj * HALF + n * 16); const f32x4 x = *p; *p = x * ALPHA_DN + gv[bj][n] * acc[ai][bj][m][n]; } }
    }
};
struct EpiSwiGLU {
    bf16_t* HID;
    __device__ __forceinline__ void operator()(const f32x4 (&acc)[2][2][4][2], const Unit& u, int wr, int wc, int fr, int fq) const {
        const int row0 = u.pm * BM + wr * 64 + fr, f0 = u.pn * HALF + wc * 32 + 4 * fq;
#pragma unroll
        for (int ai = 0; ai < 2; ++ai)
#pragma unroll
            for (int m = 0; m < 4; ++m) { bf16_t* rowp = HID + (size_t)(row0 + ai * HALF + m * 16) * D_EXP + f0;
#pragma unroll
                for (int n = 0; n < 2; ++n) { const f32x4 a = acc[ai][0][m][n], b = acc[ai][1][m][n]; float h[4];
#pragma unroll
                    for (int j = 0; j < 4; ++j) h[j] = a[j] / (1.f + __expf(-a[j])) * b[j];
                    u32x2 o; o.x = pk2(h[0], h[1]); o.y = pk2(h[2], h[3]); *(u32x2*)(rowp + n * 16) = o; } }
    }
};
struct EpiYE {
    bf16_t* YE; const float* gate;
    __device__ __forceinline__ void operator()(const f32x4 (&acc)[2][2][4][2], const Unit& u, int wr, int wc, int fr, int fq) const {
        const int row0 = u.pm * BM + wr * 64 + fr, col0 = u.pn * BM + wc * 32 + 4 * fq;
#pragma unroll
        for (int ai = 0; ai < 2; ++ai)
#pragma unroll
            for (int m = 0; m < 4; ++m) { const int row = row0 + ai * HALF + m * 16; const float gt = gate[row]; bf16_t* rowp = YE + (size_t)row * DM + col0;
#pragma unroll
                for (int bj = 0; bj < 2; ++bj)
#pragma unroll
                    for (int n = 0; n < 2; ++n) { const f32x4 v = acc[ai][bj][m][n] * gt; u32x2 o; o.x = pk2(v[0], v[1]); o.y = pk2(v[2], v[3]); *(u32x2*)(rowp + bj * HALF + n * 16) = o; } }
    }
};
struct EpiLora {
    unsigned char* SCN; bf16_t* G; const float* decay0; const float* a0; const float* kalpha;
    __device__ __forceinline__ void operator()(const f32x4 (&acc)[2][2][4][2], const Unit& u, int wr, int wc, int fr, int fq) const {
        const int row0 = u.pm * BM + wr * 64 + fr;
        const int seg = u.pn / 3, cb = (u.pn % 3) * BM + wc * 32 + 4 * fq;
#pragma unroll
        for (int bj = 0; bj < 2; ++bj)
#pragma unroll
            for (int n = 0; n < 2; ++n) {
                const int col = cb + bj * HALF + n * 16, head = col >> 6, kx = col & 63;
                if (seg < 2) {
                    const f32x4 d0 = *(const f32x4*)(decay0 + seg * 768 + col);
#pragma unroll
                    for (int ai = 0; ai < 2; ++ai)
#pragma unroll
                        for (int m = 0; m < 4; ++m) { const int row = row0 + ai * HALF + m * 16; f32x4 w;
#pragma unroll
                            for (int j = 0; j < 4; ++j) w[j] = __expf(-DECAY_SCALE * sigmoidf_(d0[j] + acc[ai][bj][m][n][j]));
                            *(f32x4*)(SCN + (size_t)(row * 12 + head) * SC_REC + SC_W + seg * 256 + kx * 4) = w; }
                } else if (seg < 4) {
                    const int d = seg - 2;
                    const f32x4 a00 = *(const f32x4*)(a0 + d * 768 + col), kal = *(const f32x4*)(kalpha + col);
#pragma unroll
                    for (int ai = 0; ai < 2; ++ai)
#pragma unroll
                        for (int m = 0; m < 4; ++m) { const int row = row0 + ai * HALF + m * 16; unsigned char* base = SCN + (size_t)(row * 12 + head) * SC_REC + kx * 2;
                            const f32x4 kk = ld4bf_(base + SC_KK); const f32x4 ks = ld4bf_(base + SC_KR + 256 * d); f32x4 bb, kr;
#pragma unroll
                            for (int j = 0; j < 4; ++j) { const float a = sigmoidf_(a00[j] + acc[ai][bj][m][n][j]); bb[j] = kk[j] * a; kr[j] = ks[j] * (1.f + (a - 1.f) * kal[j]); }
                            st4bf_(base + SC_B + 256 * d, bb); st4bf_(base + SC_KR + 256 * d, kr); }
                } else {
#pragma unroll
                    for (int ai = 0; ai < 2; ++ai)
#pragma unroll
                        for (int m = 0; m < 4; ++m) { const int row = row0 + ai * HALF + m * 16; const f32x4 v = acc[ai][bj][m][n]; u32x2 o; o.x = pk2(v[0], v[1]); o.y = pk2(v[2], v[3]);
                            *(u32x2*)(G + (size_t)row * 768 + col) = o; }
                }
            }
    }
};
}

struct Args { const float* in[37]; float* out; unsigned char* ws; int lo, hi; };
enum { I_X = 0, I_C, I_CTX, I_CCTX, I_WMOD, I_BMOD, I_LNG, I_LNB, I_EWIN, I_EWOUT, I_CONVW, I_MU, I_DUP, I_D0, I_AUP, I_A0, I_GUP, I_KXI, I_KAL, I_RBON, I_GNG, I_GNB,
       I_OWIN, I_OWOUT, I_LQ1, I_LK1, I_LQ2, I_LK2, I_SUBG, I_GLNG, I_GLNB, I_GWS, I_GBS, I_WR, I_WE1, I_WE3, I_WE2 };

struct Ctx {
    LAS unsigned char* lds;
    int tid, lane, wave, G, vcu, gw, NGW;
};
__device__ __forceinline__ void mkctx(Ctx& C, LAS unsigned char* lds) {
    int tid = threadIdx.x; asm volatile("" : "+v"(tid));
    C.lds = lds; C.tid = tid; C.lane = tid & 63; C.wave = __builtin_amdgcn_readfirstlane(tid >> 6);
    C.G = gridDim.x; { const int bx = blockIdx.x; C.vcu = (C.G % 8 == 0) ? (bx % 8) * (C.G / 8) + bx / 8 : bx; }
    C.gw = blockIdx.x * NWAVES + C.wave; C.NGW = C.G * NWAVES;
}
__device__ __forceinline__ void ldargs(Args& A, LAS unsigned char* lds) {
    LAS const u32x2* tb = (LAS const u32x2*)(lds + LDS_PTAB); asm volatile("" : "+v"(tb));
#pragma unroll
    for (int i = 0; i < 37; ++i) { const u32x2 v = tb[i]; A.in[i] = (const float*)(((unsigned long long)(unsigned)__builtin_amdgcn_readfirstlane((int)v.y) << 32) | (unsigned)__builtin_amdgcn_readfirstlane((int)v.x)); }
    { const u32x2 v = tb[37]; A.out = (float*)(((unsigned long long)(unsigned)__builtin_amdgcn_readfirstlane((int)v.y) << 32) | (unsigned)__builtin_amdgcn_readfirstlane((int)v.x)); }
    { const u32x2 v = tb[38]; A.ws = (unsigned char*)(((unsigned long long)(unsigned)__builtin_amdgcn_readfirstlane((int)v.y) << 32) | (unsigned)__builtin_amdgcn_readfirstlane((int)v.x)); }
    A.lo = 0; A.hi = 0;
}
__device__ __forceinline__ int row_mi(int row) { return row < NLAT ? (row >> 13) : 4; }

__device__ __forceinline__ void phase_init(const Ctx& C, const Args& A) {
    unsigned char* ws = A.ws;
    float* MOD = (float*)(ws + WS_MOD);
    LAS float* sv = (LAS float*)C.lds;
    LAS float* red = sv + 5 * 1024;
    for (int i = C.tid; i < 5 * 1024; i += NTHR) { const int v = i >> 10, k = i & 1023; const float c = (v < 4) ? A.in[I_C][v * DM + k] : A.in[I_CCTX][k]; sv[i] = c / (1.f + __expf(-c)); }
    __syncthreads();
    const int j = C.tid & 127, kp = C.tid >> 7;
    for (int it = blockIdx.x; it < DEPTH * 48; it += C.G) {
        const int l = it / 48, cg = it % 48, col = cg * 128 + j;
        const float* W = A.in[I_WMOD] + (size_t)l * DM * 6144 + col;
        float a0 = 0.f, a1 = 0.f, a2 = 0.f, a3 = 0.f, a4 = 0.f;
#pragma unroll 4
        for (int k = kp * 256; k < kp * 256 + 256; ++k) { const float w = W[(size_t)k * 6144]; a0 += sv[k] * w; a1 += sv[1024 + k] * w; a2 += sv[2048 + k] * w; a3 += sv[3072 + k] * w; a4 += sv[4096 + k] * w; }
        red[(kp * 5 + 0) * 128 + j] = a0; red[(kp * 5 + 1) * 128 + j] = a1; red[(kp * 5 + 2) * 128 + j] = a2; red[(kp * 5 + 3) * 128 + j] = a3; red[(kp * 5 + 4) * 128 + j] = a4;
        __syncthreads();
        for (int o = C.tid; o < 5 * 128; o += NTHR) { const int v = o >> 7, jj = o & 127; const int cc = cg * 128 + jj;
            const float s = red[(0 * 5 + v) * 128 + jj] + red[(1 * 5 + v) * 128 + jj] + red[(2 * 5 + v) * 128 + jj] + red[(3 * 5 + v) * 128 + jj];
            MOD[((size_t)l * 5 + v) * 6144 + cc] = s + A.in[I_BMOD][l * 6144 + cc]; }
        __syncthreads();
    }
    if (blockIdx.x == C.G - 1) { float* rope = (float*)(ws + WS_ROPE);
        for (int i = C.tid; i < 192 * 16; i += NTHR) { const int pos = i >> 4, j = i & 15; const float ang = (float)(pos < 128 ? pos : pos - 128) * powf(10000.f, -(float)j * (1.f / 16.f));
            rope[i] = cosf(ang); rope[192 * 16 + i] = sinf(ang); } }
    f32x4* X4 = (f32x4*)(ws + WS_X);
    const f32x4* x4 = (const f32x4*)A.in[I_X]; const f32x4* c4 = (const f32x4*)A.in[I_CTX];
    const size_t nl = (size_t)NLAT * DM / 4, nc = (size_t)NCTX * DM / 4;
    for (size_t i = (size_t)blockIdx.x * NTHR + C.tid; i < nl + nc; i += (size_t)C.G * NTHR) X4[i] = (i < nl) ? x4[i] : c4[i - nl];
}

__device__ __forceinline__ void transpose_item(const float* W, int ldw, int k0, int n0, bf16_t* WT, int ldt, int drow0, LAS float* scr, int lane) {
    { float v[64]; const float* src = W + (size_t)k0 * ldw + n0 + lane;
#pragma unroll
      for (int k = 0; k < 64; ++k) v[k] = __builtin_nontemporal_load(src + (size_t)k * ldw);
#pragma unroll
      for (int k = 0; k < 64; ++k) scr[k * 65 + lane] = v[k]; }
    asm volatile("s_waitcnt lgkmcnt(0)" ::: "memory");
    const int c = lane & 7;
#pragma unroll
    for (int j = 0; j < 8; ++j) { const int n = (lane >> 3) + 8 * j; const LAS float* s = scr + (8 * c) * 65 + n;
        u32x4 o; o.x = pk2(s[0 * 65], s[1 * 65]); o.y = pk2(s[2 * 65], s[3 * 65]); o.z = pk2(s[4 * 65], s[5 * 65]); o.w = pk2(s[6 * 65], s[7 * 65]);
        *(u32x4*)(WT + (size_t)(drow0 + n) * ldt + k0 + 8 * c) = o; }
    asm volatile("s_waitcnt lgkmcnt(0)" ::: "memory");
}
__device__ __forceinline__ void phase_conv(const Ctx& C, const Args& A, int l) {
    unsigned char* ws = A.ws;
    const int i2 = l >> 1; const bool odd = (l & 1);
    LAS float* scr = (LAS float*)C.lds + C.wave * (64 * 65);
    bf16_t* WIN = (bf16_t*)(ws + WS_WIN); bf16_t* WOUT = (bf16_t*)(ws + WS_WOUT); bf16_t* WE13 = (bf16_t*)(ws + WS_WE13); bf16_t* WE2 = (bf16_t*)(ws + WS_WE2);
    const int nin = odd ? D_IN_ODD : D_IN_EVEN;
    const float* win = odd ? A.in[I_OWIN] + (size_t)i2 * DM * D_IN_ODD : A.in[I_EWIN] + (size_t)i2 * DM * D_IN_EVEN;
    const float* wout = odd ? A.in[I_OWOUT] + (size_t)i2 * DM * DM : A.in[I_EWOUT] + (size_t)i2 * DM * DM;
    const int n_in = 16 * (nin / 64), n_out = 16 * 16, n_e13 = NEXP * 2 * 16 * 32, n_e2 = NEXP * 32 * 16;
    const int total = n_in + n_out + n_e13 + n_e2;
    for (int it = C.gw; it < total; it += C.NGW) {
        int r = it;
        if (r < n_in) { const int nb = nin / 64, kb = r / nb, nn = r % nb; transpose_item(win, nin, kb * 64, nn * 64, WIN, DM, nn * 64, scr, C.lane); continue; } r -= n_in;
        if (r < n_out) { const int kb = r / 16, nn = r % 16; transpose_item(wout, DM, kb * 64, nn * 64, WOUT, DM, nn * 64, scr, C.lane); continue; } r -= n_out;
        if (r < n_e13) { const int e = r / 1024, q = r % 1024, mat = q / 512, q2 = q % 512, kb = q2 / 32, nn = q2 % 32;
            const float* W = (mat ? A.in[I_WE3] : A.in[I_WE1]) + ((size_t)l * NEXP + e) * DM * D_EXP;
            const int f0 = nn * 64; const int drow = (f0 >> 7) * 256 + mat * 128 + (f0 & 127);
            transpose_item(W, D_EXP, kb * 64, f0, WE13 + (size_t)e * 4096 * DM, DM, drow, scr, C.lane); continue; } r -= n_e13;
        { const int e = r / 512, q = r % 512, kb = q / 16, nn = q % 16;
            const float* W = A.in[I_WE2] + ((size_t)l * NEXP + e) * D_EXP * DM;
            transpose_item(W, DM, kb * 64, nn * 64, WE2 + (size_t)e * DM * D_EXP, D_EXP, nn * 64, scr, C.lane); }
    }
    if (!odd) {
        u32x4* z = (u32x4*)(WIN + (size_t)D_IN_EVEN * DM);
        for (int i = blockIdx.x * NTHR + C.tid; i < (D_IN_EVEN_PAD - D_IN_EVEN) * DM / 8; i += C.G * NTHR) z[i] = (u32x4){0u, 0u, 0u, 0u};
        bf16_t* WL = (bf16_t*)(ws + WS_WLORA);
        const float* dup = A.in[I_DUP] + (size_t)i2 * 2 * 64 * 768; const float* aup = A.in[I_AUP] + (size_t)i2 * 2 * 64 * 768; const float* gup = A.in[I_GUP] + (size_t)i2 * 128 * 768;
        for (int i = blockIdx.x * NTHR + C.tid; i < LORA_N * LORA_K; i += C.G * NTHR) {
            const int kk = i / LORA_N, n = i % LORA_N, seg = n / 768, col = n % 768; float v = 0.f;
            if (seg == 0) { if (kk < 64) v = dup[(size_t)(0 * 64 + kk) * 768 + col]; }
            else if (seg == 1) { if (kk >= 64 && kk < 128) v = dup[(size_t)(1 * 64 + kk - 64) * 768 + col]; }
            else if (seg == 2) { if (kk >= 128 && kk < 192) v = aup[(size_t)(0 * 64 + kk - 128) * 768 + col]; }
            else if (seg == 3) { if (kk >= 192 && kk < 256) v = aup[(size_t)(1 * 64 + kk - 192) * 768 + col]; }
            else { if (kk >= 256) v = gup[(size_t)(kk - 256) * 768 + col]; }
            WL[(size_t)n * LORA_K + kk] = (bf16_t)f2bf(v);
        }
    }
}

__device__ __forceinline__ void phase_modh(const Ctx& C, const Args& A, int l) {
    const float* X = (const float*)(A.ws + WS_X); bf16_t* H = (bf16_t*)(A.ws + WS_H); const float* MOD = (const float*)(A.ws + WS_MOD) + (size_t)l * 5 * 6144;
    for (int row = C.gw; row < MROWS; row += C.NGW) {
        const float* md = MOD + row_mi(row) * 6144;
#pragma unroll
        for (int j = 0; j < 4; ++j) { const int col = 4 * C.lane + 256 * j; const f32x4 x = *(const f32x4*)(X + (size_t)row * DM + col), sh = *(const f32x4*)(md + col), sc = *(const f32x4*)(md + DM + col);
            const f32x4 h = x * (sc + 1.f) + sh; u32x2 o; o.x = pk2(h[0], h[1]); o.y = pk2(h[2], h[3]); *(u32x2*)(H + (size_t)row * DM + col) = o; }
    }
}

__device__ __forceinline__ f32x4 ld4bf(const bf16_t* p) { const u32x2 u = *(const u32x2*)p; return (f32x4){bflo(u.x), bfhi(u.x), bflo(u.y), bfhi(u.y)}; }
__device__ __forceinline__ void st4bf(bf16_t* p, f32x4 v) { u32x2 o; o.x = pk2(v[0], v[1]); o.y = pk2(v[2], v[3]); *(u32x2*)p = o; }
__device__ __forceinline__ void seq_info(int row, bool& hasp, bool& hasn) {
    if (row < NLAT) { const int t = row & (TT - 1); hasp = t > 0; hasn = t < TT - 1; }
    else { const int t = (row - NLAT) & (CTXL - 1); hasp = t > 0; hasn = t < CTXL - 1; }
}
__device__ __forceinline__ void phase_ef1(const Ctx& C, const Args& A, int l) {
    const int i2 = l >> 1; unsigned char* ws = A.ws;
    const bf16_t* P = (const bf16_t*)(ws + WS_P); bf16_t* A2 = (bf16_t*)(ws + WS_A2); unsigned char* SCN = ws + WS_SCN; bf16_t* LIN = (bf16_t*)(ws + WS_LIN);
    const float* cw = A.in[I_CONVW] + (size_t)i2 * 3 * 256; const float* mu = A.in[I_MU] + (size_t)i2 * RWKV_COLS; const float* kxi = A.in[I_KXI] + (size_t)i2 * 768;
    const f32x4 z4 = {0.f, 0.f, 0.f, 0.f};
    for (int row = C.gw; row < MROWS; row += C.NGW) {
        bool hasp, hasn; seq_info(row, hasp, hasn);
        const bf16_t* p0 = P + (size_t)row * P_LD; const bf16_t* pm = p0 - P_LD; const bf16_t* pp = p0 + P_LD;
        {
            const int j4 = 4 * C.lane;
            const f32x4 bg = ld4bf(p0 + j4), u0 = ld4bf(p0 + 256 + j4) * ld4bf(p0 + 512 + j4);
            const f32x4 um = hasp ? ld4bf(pm + 256 + j4) * ld4bf(pm + 512 + j4) : z4, up = hasn ? ld4bf(pp + 256 + j4) * ld4bf(pp + 512 + j4) : z4;
            const f32x4 w0 = *(const f32x4*)(cw + j4), w1 = *(const f32x4*)(cw + 256 + j4), w2 = *(const f32x4*)(cw + 512 + j4);
            st4bf(A2 + (size_t)row * DM + j4, bg * (w0 * um + w1 * u0 + w2 * up));
        }
#pragma unroll
        for (int it = 0; it < 11; ++it) {
            const int c = it * 256 + 4 * C.lane;
            if (c < RWKV_COLS) {
                const f32x4 x0 = ld4bf(p0 + 768 + c), xm = hasp ? ld4bf(pm + 768 + c) : z4, xp = hasn ? ld4bf(pp + 768 + c) : z4, m4 = *(const f32x4*)(mu + c);
                const f32x4 ps = x0 + m4 * ((xm + xp) * 0.5f - x0);
                if (it < 3) { const int head = c >> 6, kx = c & 63; st4bf_(SCN + (size_t)(row * 12 + head) * SC_REC + SC_R + kx * 2, ps); }
                else if (it < 6) { const int c1 = c - 768, head = c1 >> 6, kx = c1 & 63; const f32x4 kv = ps * *(const f32x4*)(kxi + c1);
                    const float ss = sum16(kv[0] * kv[0] + kv[1] * kv[1] + kv[2] * kv[2] + kv[3] * kv[3]); const float rn = rsqrtf(ss + 1e-12f);
                    unsigned char* base = SCN + (size_t)(row * 12 + head) * SC_REC + kx * 2;
                    st4bf_(base + SC_KK, kv * rn); st4bf_(base + SC_KR, ps); st4bf_(base + SC_KR + 256, ps); }
                else if (it < 9) { const int c1 = c - 1536, head = c1 >> 6, kx = c1 & 63; st4bf_(SCN + (size_t)(row * 12 + head) * SC_REC + SC_V + kx * 2, ps); }
                else { const int c1 = c - 2304; f32x4 o;
                    if (c1 < 128) { o = (f32x4){tanhf(ps[0]), tanhf(ps[1]), tanhf(ps[2]), tanhf(ps[3])}; }
                    else if (c1 < 256) { o = ps; }
                    else { o = (f32x4){sigmoidf_(ps[0]), sigmoidf_(ps[1]), sigmoidf_(ps[2]), sigmoidf_(ps[3])}; }
                    st4bf(LIN + (size_t)row * LORA_K + c1, o); }
            }
        }
    }
}

__device__ __forceinline__ int scan_row(int i, int b, int d) {
    if (d == 0) return i < CTXL ? NLAT + b * CTXL + i : b * TT + (i - CTXL);
    return i < CTXL ? NLAT + b * CTXL + (CTXL - 1 - i) : b * TT + (TT - 1 - (i - CTXL));
}
__device__ __forceinline__ float red8(float v) {
    v += __uint_as_float((unsigned)__builtin_amdgcn_update_dpp(0, (int)__float_as_uint(v), 0xB1, 0xF, 0xF, true));
    v += __uint_as_float((unsigned)__builtin_amdgcn_update_dpp(0, (int)__float_as_uint(v), 0x4E, 0xF, 0xF, true));
    v += __uint_as_float((unsigned)__builtin_amdgcn_update_dpp(0, (int)__float_as_uint(v), 0x141, 0xF, 0xF, true));
    return v;
}
__device__ __forceinline__ float red16(float v) {
    v += __uint_as_float((unsigned)__builtin_amdgcn_update_dpp(0, (int)__float_as_uint(v), 0xB1, 0xF, 0xF, true));
    v += __uint_as_float((unsigned)__builtin_amdgcn_update_dpp(0, (int)__float_as_uint(v), 0x4E, 0xF, 0xF, true));
    v += __uint_as_float((unsigned)__builtin_amdgcn_update_dpp(0, (int)__float_as_uint(v), 0x141, 0xF, 0xF, true));
    v += __uint_as_float((unsigned)__builtin_amdgcn_update_dpp(0, (int)__float_as_uint(v), 0x140, 0xF, 0xF, true));
    return v;
}
__device__ __forceinline__ void phase_scan(const Ctx& C, const Args& A) {
    for (int u = blockIdx.x; u < 192; u += C.G) {
    const int half = u & 1, d = (u >> 1) & 1, h = (u >> 2) % 12, b = u / 48;
    const unsigned char* SCN = A.ws + WS_SCN; float* Y = (float*)(A.ws + WS_Y) + (size_t)d * MROWS * 768;
    LAS float* buf = (LAS float*)C.lds; LAS float* ybuf = buf + 2 * 32 * 352;
    constexpr int NCH = LKEYS / 32;
    u32x4 st[4];
    int ps_[4], psrc[4], pdst[4]; bool pf32[4];
#pragma unroll
    for (int j = 0; j < 4; ++j) { const int p = C.tid + NTHR * j; const int s = p / 52, q = p % 52; ps_[j] = s;
        if (q < 16) { psrc[j] = SC_W + 256 * d + q * 16; pdst[j] = s * 352 + q * 4; pf32[j] = true; }
        else if (q < 48) { const int vec = (q - 16) >> 3, part = (q - 16) & 7; const int so = vec == 0 ? SC_KK : vec == 1 ? SC_B + 256 * d : vec == 2 ? SC_KR + 256 * d : SC_R;
            psrc[j] = so + part * 16; pdst[j] = s * 352 + 64 * (vec + 1) + part * 8; pf32[j] = false; }
        else { const int part = q - 48; psrc[j] = SC_V + half * 64 + part * 16; pdst[j] = s * 352 + 320 + part * 8; pf32[j] = false; } }
    const int sgn = d ? -1 : 1;
    const unsigned char* SCNh = SCN + (size_t)h * SC_REC;
#define SCAN_ROW0(c) (((c) * 32 < CTXL) ? (NLAT + b * CTXL + (d ? CTXL - 1 - (c) * 32 : (c) * 32)) : (b * TT + (d ? TT - 1 - ((c) * 32 - CTXL) : (c) * 32 - CTXL)))
#define SCAN_LOADG(c) do { const int row0_ = SCAN_ROW0(c); _Pragma("unroll") for (int j = 0; j < 4; ++j) if (j < 3 || C.tid < 1664 - 3 * NTHR) { \
        st[j] = *(const u32x4*)(SCNh + (size_t)(row0_ + sgn * ps_[j]) * SC_ROW + psrc[j]); } } while (0)
#define SCAN_STORE(bi) do { _Pragma("unroll") for (int j = 0; j < 4; ++j) if (j < 3 || C.tid < 1664 - 3 * NTHR) { LAS float* dp = buf + (bi) * (32 * 352) + pdst[j]; \
        if (pf32[j]) *(LAS u32x4*)dp = st[j]; \
        else { *(LAS f32x4*)dp = (f32x4){bflo(st[j].x), bfhi(st[j].x), bflo(st[j].y), bfhi(st[j].y)}; *(LAS f32x4*)(dp + 4) = (f32x4){bflo(st[j].z), bfhi(st[j].z), bflo(st[j].w), bfhi(st[j].w)}; } } } while (0)
    SCAN_LOADG(0); SCAN_STORE(0); __syncthreads();
    f32x2 Sa = {0.f, 0.f}, Sb = {0.f, 0.f};
    const int rl = C.lane >> 4, ks = C.lane & 15;
    float ycol = 0.f;
#define SC_LD(R, s) do { const LAS float* bp_ = cur + (s) * 352 + ks * 4; \
        R##w = *(const LAS f32x4*)(bp_); R##k = *(const LAS f32x4*)(bp_ + 64); R##b = *(const LAS f32x4*)(bp_ + 128); R##q = *(const LAS f32x4*)(bp_ + 192); R##r = *(const LAS f32x4*)(bp_ + 256); \
        R##vv = cur[(s) * 352 + 320 + C.wave * 4 + rl]; } while (0)
#define SC_LO(v) ((f32x2){v[0], v[1]})
#define SC_HI(v) ((f32x2){v[2], v[3]})
#define SC_DPP(x, ctrl) __uint_as_float((unsigned)__builtin_amdgcn_update_dpp(0, (int)__float_as_uint(x), ctrl, 0xF, 0xF, true))
#define SC_STEP(R, P, s) do { \
        f32x2 pa = __builtin_elementwise_fma(Sb, SC_HI(R##k), Sa * SC_LO(R##k)), py = __builtin_elementwise_fma(Sb, SC_HI(P##r), Sa * SC_LO(P##r)); \
        float a_ = pa.x + pa.y, y_ = py.x + py.y; \
        a_ += SC_DPP(a_, 0xB1); y_ += SC_DPP(y_, 0xB1); a_ += SC_DPP(a_, 0x4E); y_ += SC_DPP(y_, 0x4E); \
        a_ += SC_DPP(a_, 0x141); y_ += SC_DPP(y_, 0x141); a_ += SC_DPP(a_, 0x140); y_ += SC_DPP(y_, 0x140); \
        ycol = (ks == ((s) & 15)) ? y_ : ycol; \
        const f32x2 na = {-a_, -a_}, vv2 = {R##vv, R##vv}; \
        Sa = __builtin_elementwise_fma(Sa, SC_LO(R##w), __builtin_elementwise_fma(na, SC_LO(R##b), vv2 * SC_LO(R##q))); \
        Sb = __builtin_elementwise_fma(Sb, SC_HI(R##w), __builtin_elementwise_fma(na, SC_HI(R##b), vv2 * SC_HI(R##q))); } while (0)
    f32x4 Aw, Ak, Ab, Aq, Ar, Bw, Bk, Bb, Bq, Br, Cw, Ck, Cb, Cq, Cr, Dw, Dk, Db, Dq, Dr; float Avv, Bvv, Cvv, Dvv;
    Dr = (f32x4){0.f, 0.f, 0.f, 0.f};
    for (int c = 0; c < NCH; ++c) {
        if (c + 1 < NCH) SCAN_LOADG(c + 1);
        {
            const LAS float* cur = buf + (c & 1) * (32 * 352);
            LAS float* yb = ybuf + (c & 1) * 1024 + C.wave * 4 + rl + ks * 32;
            SC_LD(A, 0); SC_LD(B, 1);
#pragma unroll 1
            for (int s = 0; s < 32; s += 4) {
                SC_LD(C, s + 2); __builtin_amdgcn_sched_barrier(0); SC_STEP(A, D, s); __builtin_amdgcn_sched_barrier(0);
                SC_LD(D, s + 3); __builtin_amdgcn_sched_barrier(0); SC_STEP(B, A, s + 1); __builtin_amdgcn_sched_barrier(0);
                SC_LD(A, s + 4); __builtin_amdgcn_sched_barrier(0); SC_STEP(C, B, s + 2); __builtin_amdgcn_sched_barrier(0);
                SC_LD(B, s + 5); __builtin_amdgcn_sched_barrier(0); SC_STEP(D, C, s + 3); __builtin_amdgcn_sched_barrier(0);
                if ((s & 15) == 12) yb[(s & 16) * 32] = ycol;
            }
        }
        if (c + 1 < NCH) SCAN_STORE((c + 1) & 1);
        __syncthreads();
        { const int row0_ = SCAN_ROW0(c);
#pragma unroll
          for (int i = 0; i < 2; ++i) { const int e = C.tid + NTHR * i, s = e >> 5, r = e & 31;
            const int row = (s > 0) ? row0_ + sgn * (s - 1) : scan_row(c * 32 - 1, b, d);
            if (s > 0 || c > 0) Y[(size_t)row * 768 + h * 64 + half * 32 + r] = ybuf[(c & 1) * 1024 + e]; } }
    }
    {
        f32x2 py = __builtin_elementwise_fma(Sb, SC_HI(Dr), Sa * SC_LO(Dr)); float y_ = py.x + py.y;
        y_ += SC_DPP(y_, 0xB1); y_ += SC_DPP(y_, 0x4E); y_ += SC_DPP(y_, 0x141); y_ += SC_DPP(y_, 0x140);
        if (ks == 0) Y[(size_t)scan_row(LKEYS - 1, b, d) * 768 + h * 64 + half * 32 + C.wave * 4 + rl] = y_;
    }
    __syncthreads();
    }
#undef SCAN_LOADG
#undef SCAN_STORE
#undef SCAN_ROW0
#undef SC_LD
#undef SC_STEP
#undef SC_LO
#undef SC_HI
#undef SC_DPP
}

__device__ __forceinline__ void phase_ef2(const Ctx& C, const Args& A, int l) {
    const int i2 = l >> 1; unsigned char* ws = A.ws;
    const unsigned char* SCN = ws + WS_SCN; const float* Y0 = (const float*)(ws + WS_Y); const float* Y1 = Y0 + (size_t)MROWS * 768;
    const bf16_t* G = (const bf16_t*)(ws + WS_G); bf16_t* A2 = (bf16_t*)(ws + WS_A2);
    const float* rb = A.in[I_RBON] + (size_t)i2 * 768; const float* gg = A.in[I_GNG] + (size_t)i2 * 768; const float* gb = A.in[I_GNB] + (size_t)i2 * 768;
    for (int row = C.gw; row < MROWS; row += C.NGW) {
#pragma unroll
        for (int it = 0; it < 3; ++it) {
            const int c = it * 256 + 4 * C.lane, head = c >> 6, kx = c & 63;
            const f32x4 y = *(const f32x4*)(Y0 + (size_t)row * 768 + c) + *(const f32x4*)(Y1 + (size_t)row * 768 + c);
            const float mean = sum16((y[0] + y[1]) + (y[2] + y[3])) * (1.f / 64.f);
            const f32x4 dd = y - mean;
            const float var = sum16((dd[0] * dd[0] + dd[1] * dd[1]) + (dd[2] * dd[2] + dd[3] * dd[3])) * (1.f / 64.f);
            const float rstd = rsqrtf(var + GN_EPS);
            const unsigned char* base = SCN + (size_t)(row * 12 + head) * SC_REC + kx * 2;
            const f32x4 r = ld4bf_(base + SC_R), v = ld4bf_(base + SC_V), k0 = ld4bf_(base + SC_KR), k1 = ld4bf_(base + SC_KR + 256);
            const f32x4 rb4 = *(const f32x4*)(rb + c);
            const f32x4 t = r * (k0 + k1) * 0.5f * rb4;
            const float bs = sum16((t[0] + t[1]) + (t[2] + t[3]));
            const f32x4 yn = dd * rstd * *(const f32x4*)(gg + c) + *(const f32x4*)(gb + c);
            const f32x4 g = ld4bf(G + (size_t)row * 768 + c);
            st4bf(A2 + (size_t)row * DM + 256 + c, g * (yn + v * bs));
        }
    }
}

__device__ __forceinline__ float max3f(float a, float b, float c) { float r; asm("v_max3_f32 %0, %1, %2, %3" : "=v"(r) : "v"(a), "v"(b), "v"(c)); return r; }
__device__ __forceinline__ int crow(int r, int hi) { return (r & 3) + 8 * (r >> 2) + 4 * hi; }
__device__ __forceinline__ void phase_of1(const Ctx& C, const Args& A, int l) {
    const int i2 = l >> 1; unsigned char* ws = A.ws;
    const bf16_t* P = (const bf16_t*)(ws + WS_P); bf16_t* A2 = (bf16_t*)(ws + WS_A2); bf16_t* VT = (bf16_t*)(ws + WS_VT);
    const float* lng = A.in[I_GLNG] + (size_t)i2 * 256; const float* lnb = A.in[I_GLNB] + (size_t)i2 * 256;
    const float* gws = A.in[I_GWS] + (size_t)i2 * 4 * 128 * 128; const float* gbs = A.in[I_GBS] + (size_t)i2 * 4 * 128;
    LAS bf16_t* vt = (LAS bf16_t*)C.lds;
    LAS bf16_t* uL = (LAS bf16_t*)C.lds;
    LAS bf16_t* vT = (LAS bf16_t*)(C.lds + 128 * 528);
    const int r32 = C.lane & 31, hi = C.lane >> 5;
    for (int u = blockIdx.x; u < 264; u += C.G) {
        const bool isctx = u >= 256; const int uc = u - 256;
        const int b = isctx ? (uc >> 1) : (u >> 6), pos0 = isctx ? (uc & 1) * 128 : (u & 63) * 128;
        const int row0 = isctx ? NLAT + b * CTXL + pos0 : b * TT + pos0, L0 = isctx ? pos0 : CTXL + pos0;
        for (int hh = 0; hh < 6; ++hh) {
#pragma unroll
            for (int i = 0; i < 4; ++i) { const int piece = C.tid + NTHR * i, r = piece >> 4, part = piece & 15;
                *(LAS u32x4*)(vt + r * 136 + part * 8) = *(const u32x4*)(P + (size_t)(row0 + r) * P_LD + 1536 + hh * 128 + part * 8); }
            __syncthreads();
#pragma unroll
            for (int i = 0; i < 4; ++i) { const int item = C.tid + NTHR * i, d = item >> 4, tg = item & 15; const LAS bf16_t* s = vt + (tg * 8) * 136 + d;
                u32x4 o; o.x = (unsigned)s[0] | ((unsigned)s[136] << 16); o.y = (unsigned)s[2 * 136] | ((unsigned)s[3 * 136] << 16);
                o.z = (unsigned)s[4 * 136] | ((unsigned)s[5 * 136] << 16); o.w = (unsigned)s[6 * 136] | ((unsigned)s[7 * 136] << 16);
                *(u32x4*)(VT + ((size_t)(b * 6 + hh) * 128 + d) * LKEYS + L0 + tg * 8) = o; }
            __syncthreads();
        }
        for (int r = C.wave; r < 128; r += NWAVES) {
            const int c4 = 4 * C.lane; const bf16_t* pr = P + (size_t)(row0 + r) * P_LD + 2304;
            const f32x4 ur = ld4bf(pr + c4), raw = ld4bf(pr + 256 + c4);
            { const f32x4 gu = {gelu_erf(ur[0]), gelu_erf(ur[1]), gelu_erf(ur[2]), gelu_erf(ur[3])}; u32x2 o; o.x = pk2(gu[0], gu[1]); o.y = pk2(gu[2], gu[3]); *(LAS u32x2*)(uL + r * 264 + c4) = o; }
            const f32x4 gv = {gelu_erf(raw[0]), gelu_erf(raw[1]), gelu_erf(raw[2]), gelu_erf(raw[3])};
            const float mean = wave_sum((gv[0] + gv[1]) + (gv[2] + gv[3])) * (1.f / 256.f); const f32x4 dd = gv - mean;
            const float var = wave_sum((dd[0] * dd[0] + dd[1] * dd[1]) + (dd[2] * dd[2] + dd[3] * dd[3])) * (1.f / 256.f); const float rstd = rsqrtf(var + LN_EPS);
            const f32x4 o = dd * rstd * *(const f32x4*)(lng + c4) + *(const f32x4*)(lnb + c4);
#pragma unroll
            for (int k = 0; k < 4; ++k) vT[(c4 + k) * 136 + r] = (bf16_t)f2bf(o[k]);
        }
        __syncthreads();
        {
            const int g = C.wave >> 1, cblk = C.wave & 1, cc = g * 64 + cblk * 32 + r32;
            for (int pblk = 0; pblk < 4; ++pblk) {
                f32x16 acc;
#pragma unroll
                for (int i = 0; i < 16; ++i) acc[i] = 0.f;
                const float* wrow = gws + ((size_t)g * 128 + pblk * 32 + r32) * 128 + 8 * hi;
#pragma unroll
                for (int ks = 0; ks < 8; ++ks) { const f32x4 w0 = *(const f32x4*)(wrow + ks * 16), w1 = *(const f32x4*)(wrow + ks * 16 + 4);
                    u32x4 au; au.x = pk2(w0[0], w0[1]); au.y = pk2(w0[2], w0[3]); au.z = pk2(w1[0], w1[1]); au.w = pk2(w1[2], w1[3]);
                    const bf16x8 bf = *(const LAS bf16x8*)(vT + cc * 136 + ks * 16 + 8 * hi);
                    acc = __builtin_amdgcn_mfma_f32_32x32x16_bf16(__builtin_bit_cast(bf16x8, au), bf, acc, 0, 0, 0); }
#pragma unroll
                for (int reg = 0; reg < 16; ++reg) { const int p = pblk * 32 + crow(reg, hi);
                    const float uu = bf2f(uL[p * 264 + cc]); const float mixed = acc[reg] + gbs[g * 128 + p];
                    uL[p * 264 + cc] = (bf16_t)f2bf(uu * mixed); }
            }
        }
        __syncthreads();
#pragma unroll
        for (int i = 0; i < 8; ++i) { const int piece = C.tid + NTHR * i, r = piece >> 5, part = piece & 31;
            *(u32x4*)(A2 + (size_t)(row0 + r) * DM + 768 + part * 8) = *(const LAS u32x4*)(uL + r * 264 + part * 8); }
        __syncthreads();
    }
}

__device__ __forceinline__ void phase_attn(const Ctx& C, const Args& A, int l) {
    const int i2 = l >> 1; unsigned char* ws = A.ws;
    const bf16_t* Q = (const bf16_t*)(ws + WS_Q); const bf16_t* KA = (const bf16_t*)(ws + WS_KA); const bf16_t* VT = (const bf16_t*)(ws + WS_VT); bf16_t* A2 = (bf16_t*)(ws + WS_A2);
    const float lam_init = 0.8f - 0.6f * expf(-0.3f * (float)l);
    float s1 = 0.f, s2 = 0.f;
    for (int j = 0; j < 64; ++j) { s1 += A.in[I_LQ1][i2 * 64 + j] * A.in[I_LK1][i2 * 64 + j]; s2 += A.in[I_LQ2][i2 * 64 + j] * A.in[I_LK2][i2 * 64 + j]; }
    const float lam = expf(s1) - expf(s2) + lam_init;
    const float* subg = A.in[I_SUBG] + (size_t)i2 * 128;
    const int r32 = C.lane & 31, hi = C.lane >> 5, map = C.wave >> 2, qw = C.wave & 3;
    LAS unsigned char* Kt = C.lds; LAS unsigned char* Vt = C.lds + 2 * 17408; LAS float* xch = (LAS float*)C.lds;
    const int NU = 1536 + (l == 1 ? 48 : 0);
    for (int n = C.vcu; n < NU; n += C.G) {
        int bh, qt; bool isctx = false;
        if (n < 1536) { const int round = n >> 8, slot = n & 255; bh = (slot >> 5) * 3 + (round >> 1); qt = (round & 1) * 32 + (slot & 31); }
        else { isctx = true; bh = (n - 1536) >> 1; qt = (n - 1536) & 1; }
        const int b = bh / 6, h = bh % 6;
        const int qrow0 = isctx ? NLAT + b * CTXL + qt * 128 : b * TT + qt * 128;
        const int NT = isctx ? CTXL / 64 : LKEYS / 64;
        const bf16_t* Kb = KA + (size_t)b * LKEYS * 768 + h * 128;
        const bf16_t* Vb = VT + (size_t)(b * 6 + h) * 128 * LKEYS;
        bf16x8 qf[4];
        { const bf16_t* qp = Q + (size_t)(qrow0 + qw * 32 + r32) * 768 + h * 128 + map * 64 + 8 * hi;
#pragma unroll
          for (int ks = 0; ks < 4; ++ks) qf[ks] = *(const bf16x8*)(qp + ks * 16); }
        f32x16 O[4];
#pragma unroll
        for (int d = 0; d < 4; ++d)
#pragma unroll
            for (int i = 0; i < 16; ++i) O[d][i] = 0.f;
        float m = -1e30f, lsum = 0.f;
        u32x4 kreg[2], vreg[2];
#define AT_LOAD(t) do { _Pragma("unroll") for (int i = 0; i < 2; ++i) { const int piece = C.tid + NTHR * i; \
            kreg[i] = *(const u32x4*)(Kb + (size_t)((t) * 64 + (piece >> 4)) * 768 + (piece & 15) * 8); \
            vreg[i] = *(const u32x4*)(Vb + (size_t)(piece >> 3) * LKEYS + (t) * 64 + (piece & 7) * 8); } } while (0)
#define AT_STORE(bi) do { _Pragma("unroll") for (int i = 0; i < 2; ++i) { const int piece = C.tid + NTHR * i; \
            *(LAS u32x4*)(Kt + (bi) * 17408 + (piece >> 4) * 272 + (piece & 15) * 16) = kreg[i]; \
            LAS unsigned char* vd = Vt + (bi) * 17408 + (piece >> 3) * 136 + (piece & 7) * 16; \
            *(LAS u32x2*)vd = (u32x2){vreg[i].x, vreg[i].y}; *(LAS u32x2*)(vd + 8) = (u32x2){vreg[i].z, vreg[i].w}; } } while (0)
        AT_LOAD(0); AT_STORE(0); __syncthreads();
        for (int t = 0; t < NT; ++t) {
            if (t + 1 < NT) AT_LOAD(t + 1);
            const int bi = t & 1;
            const LAS unsigned char* kb = Kt + bi * 17408 + r32 * 272 + map * 128 + hi * 16;
            const LAS unsigned char* vb = Vt + bi * 17408 + r32 * 136 + hi * 8;
            bf16x8 kf[8];
#pragma unroll
            for (int ks = 0; ks < 4; ++ks) { kf[2 * ks] = *(const LAS bf16x8*)(kb + ks * 32); kf[2 * ks + 1] = *(const LAS bf16x8*)(kb + 32 * 272 + ks * 32); }
            u32x4 va[4], vc[4];
#define AT_LDV(dst, d) do { _Pragma("unroll") for (int kst = 0; kst < 4; ++kst) { const LAS unsigned char* vp = vb + (d) * (32 * 136) + kst * 32; \
                const u32x2 lo = *(const LAS u32x2*)vp, hh = *(const LAS u32x2*)(vp + 16); dst[kst] = (u32x4){lo.x, lo.y, hh.x, hh.y}; } } while (0)
#define AT_PV(src, d) do { _Pragma("unroll") for (int kst = 0; kst < 4; ++kst) O[d] = __builtin_amdgcn_mfma_f32_32x32x16_bf16(__builtin_bit_cast(bf16x8, src[kst]), pb[kst], O[d], 0, 0, 0); } while (0)
            AT_LDV(va, 0);
            __builtin_amdgcn_sched_barrier(0);
            f32x16 p0, p1;
#pragma unroll
            for (int i = 0; i < 16; ++i) { p0[i] = 0.f; p1[i] = 0.f; }
#pragma unroll
            for (int ks = 0; ks < 4; ++ks) { p0 = __builtin_amdgcn_mfma_f32_32x32x16_bf16(kf[2 * ks], qf[ks], p0, 0, 0, 0); p1 = __builtin_amdgcn_mfma_f32_32x32x16_bf16(kf[2 * ks + 1], qf[ks], p1, 0, 0, 0); }
            asm volatile("s_nop 15\n\ts_nop 7" : "+v"(p0), "+v"(p1));
            float mx = max3f(p0[0], p0[1], p1[0]), mx2 = max3f(p0[2], p0[3], p1[1]); mx = max3f(mx, p1[2], p1[3]);
#pragma unroll
            for (int i = 4; i < 16; i += 4) { mx = max3f(mx, p0[i], p0[i + 1]); mx2 = max3f(mx2, p0[i + 2], p0[i + 3]); mx = max3f(mx, p1[i], p1[i + 1]); mx2 = max3f(mx2, p1[i + 2], p1[i + 3]); }
            mx = max3f(mx, mx2, m);
            { auto rr = __builtin_amdgcn_permlane32_swap(__float_as_uint(mx), __float_as_uint(mx), false, false); mx = fmaxf(__uint_as_float(rr[0]), __uint_as_float(rr[1])); }
            const float mnew = mx;
            if (__any(mnew > m)) { const float sc = __builtin_amdgcn_exp2f(m - mnew); lsum *= sc;
#pragma unroll
                for (int d = 0; d < 4; ++d)
#pragma unroll
                    for (int i = 0; i < 16; ++i) O[d][i] *= sc;
                m = mnew; }
            float ps = 0.f, ps2 = 0.f;
#pragma unroll
            for (int i = 0; i < 16; ++i) { p0[i] = __builtin_amdgcn_exp2f(p0[i] - m); p1[i] = __builtin_amdgcn_exp2f(p1[i] - m); ps += p0[i]; ps2 += p1[i]; }
            lsum += ps + ps2;
            bf16x8 pb[4];
            { u32x4 w; w.x = pk2(p0[0], p0[1]); w.y = pk2(p0[2], p0[3]); w.z = pk2(p0[4], p0[5]); w.w = pk2(p0[6], p0[7]); pb[0] = __builtin_bit_cast(bf16x8, w);
              w.x = pk2(p0[8], p0[9]); w.y = pk2(p0[10], p0[11]); w.z = pk2(p0[12], p0[13]); w.w = pk2(p0[14], p0[15]); pb[1] = __builtin_bit_cast(bf16x8, w);
              w.x = pk2(p1[0], p1[1]); w.y = pk2(p1[2], p1[3]); w.z = pk2(p1[4], p1[5]); w.w = pk2(p1[6], p1[7]); pb[2] = __builtin_bit_cast(bf16x8, w);
              w.x = pk2(p1[8], p1[9]); w.y = pk2(p1[10], p1[11]); w.z = pk2(p1[12], p1[13]); w.w = pk2(p1[14], p1[15]); pb[3] = __builtin_bit_cast(bf16x8, w); }
            __builtin_amdgcn_sched_barrier(0);
            AT_LDV(vc, 1); __builtin_amdgcn_sched_barrier(0); AT_PV(va, 0); __builtin_amdgcn_sched_barrier(0);
            AT_LDV(va, 2); __builtin_amdgcn_sched_barrier(0); AT_PV(vc, 1); __builtin_amdgcn_sched_barrier(0);
            AT_LDV(vc, 3); __builtin_amdgcn_sched_barrier(0); AT_PV(va, 2); __builtin_amdgcn_sched_barrier(0);
            AT_PV(vc, 3);
            if (t + 1 < NT) AT_STORE((t + 1) & 1);
            __syncthreads();
        }
#undef AT_LDV
#undef AT_PV
#undef AT_LOAD
#undef AT_STORE
        const float ltot = lsum + __shfl_xor(lsum, 32);
        const float invl = 1.f / ltot;
        if (map == 1) { const float f = lam * invl;
#pragma unroll
            for (int d = 0; d < 4; ++d)
#pragma unroll
                for (int i = 0; i < 16; ++i) xch[(qw * 64 + d * 16 + i) * 64 + C.lane] = O[d][i] * f; }
        __syncthreads();
        if (map == 0) { float ss = 0.f;
#pragma unroll
            for (int d = 0; d < 4; ++d)
#pragma unroll
                for (int i = 0; i < 16; ++i) { const float o = O[d][i] * invl - xch[(qw * 64 + d * 16 + i) * 64 + C.lane]; O[d][i] = o; ss += o * o; }
            ss += __shfl_xor(ss, 32);
            const float rn = rsqrtf(ss * (1.f / 128.f) + RMS_EPS) * (1.f - lam_init);
            bf16_t* orow = A2 + (size_t)(qrow0 + qw * 32 + r32) * DM + h * 128;
#pragma unroll
            for (int d = 0; d < 4; ++d)
#pragma unroll
                for (int g4 = 0; g4 < 4; ++g4) { const int dd = 32 * d + 8 * g4 + 4 * hi; const f32x4 sg = *(const f32x4*)(subg + dd);
                    const f32x4 v = {O[d][4 * g4] * rn * sg[0], O[d][4 * g4 + 1] * rn * sg[1], O[d][4 * g4 + 2] * rn * sg[2], O[d][4 * g4 + 3] * rn * sg[3]};
                    st4bf(orow + dd, v); } }
        __syncthreads();
    }
}

__device__ __forceinline__ void phase_rt(const Ctx& C, const Args& A, int l) {
    unsigned char* ws = A.ws; float* X = (float*)(ws + WS_X); bf16_t* H = (bf16_t*)(ws + WS_H); float* AFF = (float*)(ws + WS_AFF);
    const float* MOD = (const float*)(ws + WS_MOD) + (size_t)l * 5 * 6144;
    const float* lng = A.in[I_LNG] + (size_t)(l * 2 + 0) * DM; const float* lnb = A.in[I_LNB] + (size_t)(l * 2 + 0) * DM;
    LAS float* wrs = (LAS float*)C.lds;
    { const float* wr = A.in[I_WR] + (size_t)l * DM * 16; for (int i = C.tid; i < DM * 16; i += NTHR) wrs[(i & 15) * 1024 + (i >> 4)] = wr[i]; }
    __syncthreads();
    for (int row = C.gw; row < MROWS; row += C.NGW) {
        const float* md = MOD + row_mi(row) * 6144;
        f32x4 x[4]; float s = 0.f;
#pragma unroll
        for (int j = 0; j < 4; ++j) { x[j] = *(const f32x4*)(X + (size_t)row * DM + 4 * C.lane + 256 * j); s += (x[j][0] + x[j][1]) + (x[j][2] + x[j][3]); }
        const float mean = wave_sum(s) * (1.f / DM); float s2 = 0.f;
#pragma unroll
        for (int j = 0; j < 4; ++j) { x[j] = x[j] - mean; s2 += (x[j][0] * x[j][0] + x[j][1] * x[j][1]) + (x[j][2] * x[j][2] + x[j][3] * x[j][3]); }
        const float rstd = rsqrtf(wave_sum(s2) * (1.f / DM) + LN_EPS);
        float v[16];
#pragma unroll
        for (int e = 0; e < 16; ++e) v[e] = 0.f;
#pragma unroll
        for (int j = 0; j < 4; ++j) { const int col = 4 * C.lane + 256 * j;
            const f32x4 x1 = x[j] * rstd * *(const f32x4*)(lng + col) + *(const f32x4*)(lnb + col);
            *(f32x4*)(X + (size_t)row * DM + col) = x1;
            const f32x4 h = x1 * (*(const f32x4*)(md + 4 * DM + col) + 1.f) + *(const f32x4*)(md + 3 * DM + col);
            st4bf(H + (size_t)row * DM + col, h);
#pragma unroll
            for (int e = 0; e < 16; ++e) { const f32x4 w = *(const LAS f32x4*)(wrs + e * 1024 + col); v[e] += (h[0] * w[0] + h[1] * w[1]) + (h[2] * w[2] + h[3] * w[3]); }
            __builtin_amdgcn_sched_barrier(0); }
#pragma unroll
        for (int i = 0; i < 8; ++i) { const float send = (C.lane & 32) ? v[i] : v[i + 8], keep = (C.lane & 32) ? v[i + 8] : v[i]; v[i] = keep + __shfl_xor(send, 32); }
#pragma unroll
        for (int i = 0; i < 4; ++i) { const float send = (C.lane & 16) ? v[i] : v[i + 4], keep = (C.lane & 16) ? v[i + 4] : v[i]; v[i] = keep + __shfl_xor(send, 16); }
#pragma unroll
        for (int i = 0; i < 2; ++i) { const float send = (C.lane & 8) ? v[i] : v[i + 2], keep = (C.lane & 8) ? v[i + 2] : v[i]; v[i] = keep + __shfl_xor(send, 8); }
        { const float send = (C.lane & 4) ? v[0] : v[1], keep = (C.lane & 4) ? v[1] : v[0]; v[0] = keep + __shfl_xor(send, 4); }
        float z = v[0]; z += __shfl_xor(z, 1); z += __shfl_xor(z, 2);
        float mx = z;
#pragma unroll
        for (int o = 4; o < 64; o <<= 1) mx = fmaxf(mx, __shfl_xor(mx, o));
        const float ex = expf(z - mx); float sm = ex;
#pragma unroll
        for (int o = 4; o < 64; o <<= 1) sm += __shfl_xor(sm, o);
        if ((C.lane & 3) == 0) AFF[(size_t)row * 16 + (C.lane >> 2)] = ex / sm;
    }
}

__device__ __forceinline__ void phase_tk(const Ctx& C, const Args& A) {
    unsigned char* ws = A.ws; const float* AFF = (const float*)(ws + WS_AFF); int* SLOT = (int*)(ws + WS_SLOT); int* IDX = (int*)(ws + WS_IDX); float* GATE = (float*)(ws + WS_GATE);
    LAS unsigned* key = (LAS unsigned*)C.lds;
    LAS unsigned* hist = key + 8192;
    LAS unsigned* scn = hist + 256;
    LAS unsigned* wtot = scn + 256;
    LAS unsigned* bc = wtot + 8;
    for (int u = blockIdx.x; u < 128; u += C.G) {
        const bool isctx = u >= 64; const int uu = u & 63, b = uu >> 4, e = uu & 15;
        const int n = isctx ? CTXL : TT, cap = isctx ? CAP_C : CAP_L;
        const int row0 = isctx ? NLAT + b * CTXL : b * TT;
        const int slot0 = e * ESLOTS + (isctx ? 4 * CAP_L + b * CAP_C : b * CAP_L);
        for (int i = C.tid; i < n; i += NTHR) key[i] = __float_as_uint(AFF[(size_t)(row0 + i) * 16 + e]);
        unsigned prefix = 0u, pmask = 0u; int need = cap;
        for (int pass = 0; pass < 4; ++pass) {
            const int shift = 24 - 8 * pass;
            if (C.tid < 256) hist[C.tid] = 0u;
            __syncthreads();
            for (int i = C.tid; i < n; i += NTHR) { const unsigned k = key[i]; if ((k & pmask) == prefix) __hip_atomic_fetch_add(&hist[(k >> shift) & 255u], 1u, __ATOMIC_RELAXED, __HIP_MEMORY_SCOPE_WORKGROUP); }
            __syncthreads();
            if (C.tid < 256) scn[C.tid] = hist[C.tid];
            __syncthreads();
            for (int off = 1; off < 256; off <<= 1) {
                unsigned a = 0u; if (C.tid < 256 && C.tid + off < 256) a = scn[C.tid + off];
                __syncthreads();
                if (C.tid < 256) scn[C.tid] += a;
                __syncthreads();
            }
            if (C.tid < 256) { const unsigned above = (C.tid < 255) ? scn[C.tid + 1] : 0u;
                if (scn[C.tid] >= (unsigned)need && above < (unsigned)need) { bc[0] = (unsigned)C.tid; bc[1] = (unsigned)need - above; } }
            __syncthreads();
            prefix |= bc[0] << shift; pmask |= 255u << shift; need = (int)bc[1];
            __syncthreads();
        }
        const int per = (n + NTHR - 1) / NTHR; const int i0 = C.tid * per;
        unsigned cg = 0u, ce = 0u;
        for (int j = 0; j < per; ++j) { const int i = i0 + j; if (i < n) { const unsigned k = key[i]; cg += (k > prefix); ce += (k == prefix); } }
        unsigned pk = cg | (ce << 16), inc = pk;
#pragma unroll
        for (int o = 1; o < 64; o <<= 1) { const unsigned t = __shfl_up(inc, o); if (C.lane >= o) inc += t; }
        if (C.lane == 63) wtot[C.wave] = inc;
        __syncthreads();
        unsigned wbase = 0u;
        for (int w = 0; w < C.wave; ++w) wbase += wtot[w];
        const unsigned excl = wbase + inc - pk;
        unsigned rg = excl & 0xffffu, re = excl >> 16;
        const int ngt = cap - need;
        for (int j = 0; j < per; ++j) { const int i = i0 + j; if (i < n) { const unsigned k = key[i]; int pos = -1;
            if (k > prefix) { pos = (int)rg; ++rg; } else if (k == prefix) { if ((int)re < need) pos = ngt + (int)re; ++re; }
            const int row = row0 + i;
            if (pos >= 0) { IDX[slot0 + pos] = row; GATE[slot0 + pos] = __uint_as_float(k); SLOT[(size_t)row * 16 + e] = slot0 + pos; }
            else SLOT[(size_t)row * 16 + e] = -1; } }
        if (isctx && b == 0 && C.tid < ESLOTS - 4224) { IDX[e * ESLOTS + 4224 + C.tid] = 0; GATE[e * ESLOTS + 4224 + C.tid] = 0.f; }
        __syncthreads();
    }
}

__device__ __forceinline__ void phase_cb(const Ctx& C, const Args& A, int l) {
    unsigned char* ws = A.ws; float* X = (float*)(ws + WS_X); bf16_t* H = (bf16_t*)(ws + WS_H); const int* SLOT = (const int*)(ws + WS_SLOT); const bf16_t* YE = (const bf16_t*)(ws + WS_YE);
    const float* MOD = (const float*)(ws + WS_MOD) + (size_t)l * 5 * 6144; const float* MODN = MOD + 5 * 6144;
    const float* lng = A.in[I_LNG] + (size_t)(l * 2 + 1) * DM; const float* lnb = A.in[I_LNB] + (size_t)(l * 2 + 1) * DM;
    for (int row = C.gw; row < MROWS; row += C.NGW) {
        const int mi = row_mi(row); const float* md = MOD + mi * 6144;
        f32x4 acc[4];
#pragma unroll
        for (int j = 0; j < 4; ++j) acc[j] = (f32x4){0.f, 0.f, 0.f, 0.f};
        for (int e = 0; e < 16; ++e) { const int s = __builtin_amdgcn_readfirstlane(SLOT[(size_t)row * 16 + e]);
            if (s >= 0) {
#pragma unroll
                for (int j = 0; j < 4; ++j) acc[j] += ld4bf(YE + (size_t)s * DM + 4 * C.lane + 256 * j); } }
        f32x4 x[4]; float sm = 0.f;
#pragma unroll
        for (int j = 0; j < 4; ++j) { const int col = 4 * C.lane + 256 * j; x[j] = *(const f32x4*)(X + (size_t)row * DM + col) * ALPHA_DN + *(const f32x4*)(md + 5 * DM + col) * acc[j];
            sm += (x[j][0] + x[j][1]) + (x[j][2] + x[j][3]); }
        const float mean = wave_sum(sm) * (1.f / DM); float s2 = 0.f;
#pragma unroll
        for (int j = 0; j < 4; ++j) { x[j] = x[j] - mean; s2 += (x[j][0] * x[j][0] + x[j][1] * x[j][1]) + (x[j][2] * x[j][2] + x[j][3] * x[j][3]); }
        const float rstd = rsqrtf(wave_sum(s2) * (1.f / DM) + LN_EPS);
#pragma unroll
        for (int j = 0; j < 4; ++j) { const int col = 4 * C.lane + 256 * j;
            const f32x4 x2 = x[j] * rstd * *(const f32x4*)(lng + col) + *(const f32x4*)(lnb + col);
            *(f32x4*)(X + (size_t)row * DM + col) = x2;
            if (l < DEPTH - 1) { const float* mn = MODN + mi * 6144; st4bf(H + (size_t)row * DM + col, x2 * (*(const f32x4*)(mn + DM + col) + 1.f) + *(const f32x4*)(mn + col)); }
            else if (row < NLAT) *(f32x4*)(A.out + (size_t)row * DM + col) = x2; }
    }
}


#ifndef GEMM_NOINLINE
#define GEMM_NOINLINE 0
#endif
#if GEMM_NOINLINE
#define GEMM_FN __device__ __noinline__
#else
#define GEMM_FN __device__ __forceinline__
#endif
GEMM_FN void gphase_in(LAS unsigned char* lds, unsigned char* ws, int nN, int G) {
    pg8::Gemm g{(const bf16_t*)(ws + WS_H), (const bf16_t*)(ws + WS_WIN), DM}; pg8::Order<0> S; S.init(MROWS / 256, nN, G, (int)blockIdx.x, nullptr, 0);
    pg8::EpiBf16 E{(bf16_t*)(ws + WS_P), P_LD}; pg8::gemm_phase(lds, g, S, E); }
GEMM_FN void gphase_in_odd(LAS unsigned char* lds, unsigned char* ws, int G) {
    pg8::Gemm g{(const bf16_t*)(ws + WS_H), (const bf16_t*)(ws + WS_WIN), DM}; pg8::Order<0> S; S.init(MROWS / 256, D_IN_ODD / 256, G, (int)blockIdx.x, nullptr, 0);
    pg8::EpiOdd E{(bf16_t*)(ws + WS_P), (bf16_t*)(ws + WS_Q), (bf16_t*)(ws + WS_KA), (const float*)(ws + WS_ROPE)}; pg8::gemm_phase(lds, g, S, E); }
GEMM_FN void gphase_lora(LAS unsigned char* lds, unsigned char* ws, const float* d0, const float* a0, const float* kal, int G) {
    pg8::Gemm g{(const bf16_t*)(ws + WS_LIN), (const bf16_t*)(ws + WS_WLORA), LORA_K}; pg8::Order<0> S; S.init(MROWS / 256, LORA_N / 256, G, (int)blockIdx.x, nullptr, 0);
    pg8::EpiLora E{ws + WS_SCN, (bf16_t*)(ws + WS_G), d0, a0, kal}; pg8::gemm_phase(lds, g, S, E); }
GEMM_FN void gphase_out(LAS unsigned char* lds, unsigned char* ws, const float* modl, int G) {
    pg8::Gemm g{(const bf16_t*)(ws + WS_A2), (const bf16_t*)(ws + WS_WOUT), DM}; pg8::Order<0> S; S.init(MROWS / 256, DM / 256, G, (int)blockIdx.x, nullptr, 0);
    pg8::EpiRes E{(float*)(ws + WS_X), modl}; pg8::gemm_phase(lds, g, S, E); }
GEMM_FN void gphase_e1(LAS unsigned char* lds, unsigned char* ws, int G) {
    pg8::Gemm g{(const bf16_t*)(ws + WS_H), (const bf16_t*)(ws + WS_WE13), DM}; pg8::Order<1> S; S.init(NEXP * 17, 4096 / 256, G, (int)blockIdx.x, (const int*)(ws + WS_IDX), (long)4096 * DM);
    pg8::EpiSwiGLU E{(bf16_t*)(ws + WS_HID)}; pg8::gemm_phase(lds, g, S, E); }
GEMM_FN void gphase_e2(LAS unsigned char* lds, unsigned char* ws, int G) {
    pg8::Gemm g{(const bf16_t*)(ws + WS_HID), (const bf16_t*)(ws + WS_WE2), D_EXP}; pg8::Order<2> S; S.init(NEXP * 17, DM / 256, G, (int)blockIdx.x, nullptr, (long)DM * D_EXP);
    pg8::EpiYE E{(bf16_t*)(ws + WS_YE), (const float*)(ws + WS_GATE)}; pg8::gemm_phase(lds, g, S, E); }

constexpr int NSTEP = 1 + DEPTH * 12;
__global__ void __launch_bounds__(NTHR, 2) mk_fwd(Args KA) {
    extern __shared__ __attribute__((aligned(16))) unsigned char lds_raw[];
    volatile LAS unsigned* MISC = (volatile LAS unsigned*)((LAS unsigned char*)lds_raw + LDS_MISC);
    if (threadIdx.x < 16) MISC[threadIdx.x] = 0u;
    if (threadIdx.x == 0) { LAS unsigned long long* tb = (LAS unsigned long long*)((LAS unsigned char*)lds_raw + LDS_PTAB);
#pragma unroll
        for (int i = 0; i < 37; ++i) tb[i] = (unsigned long long)KA.in[i];
        tb[37] = (unsigned long long)KA.out; tb[38] = (unsigned long long)KA.ws; }
    __syncthreads();
    const int lo = KA.lo, hi = KA.hi;
    unsigned bar_x = 0;
    if (hi - lo > 1) { const XcdBarrier b0 = xcd_barrier_post((unsigned*)(KA.ws + WS_CTL), MISC); bar_x = b0.x; }
#ifndef PH_MASK
#define PH_MASK 0xFFFFFF
#endif
#ifndef REP_MASK
#define REP_MASK 0
#endif
#define PH_BIT(k) (((k) == 0) ? 0 : 1 + ((k) - 1) % 12 + (((k) - 1) % 12 >= 2 && ((k) - 1) % 12 <= 5 && odd ? 12 : 0))
#define RUN(k, ...) do { if (((PH_MASK >> PH_BIT(k)) & 1) && lo <= (k) && (k) < hi) { const int nrep = ((REP_MASK >> PH_BIT(k)) & 1) ? 2 : 1; \
        _Pragma("unroll 1") for (int rep = 0; rep < nrep; ++rep) { \
        Ctx C; mkctx(C, (LAS unsigned char*)lds_raw); Args A; ldargs(A, (LAS unsigned char*)lds_raw); unsigned char* ws = A.ws; \
        const float* MODL = (const float*)(ws + WS_MOD) + (size_t)l * 5 * 6144; (void)MODL; \
        __VA_ARGS__; if ((k) + 1 < hi || rep + 1 < nrep) { XcdBarrier bar; bar.bar = (unsigned*)(ws + WS_CTL); bar.x = bar_x; bar.st = MISC; xcd_barrier(bar); } } } } while (0)
    { const bool odd = false; const int l = 0; RUN(0, phase_init(C, A)); }
#pragma unroll 1
    for (int l = 0; l < DEPTH; ++l) {
        const int sb = 1 + l * 12; const bool odd = l & 1;
        RUN(sb + 0, { phase_conv(C, A, l); if (l == 0) phase_modh(C, A, 0); });
        if (odd) { RUN(sb + 1, gphase_in_odd(C.lds, ws, C.G)); } else { RUN(sb + 1, gphase_in(C.lds, ws, D_IN_EVEN_PAD / 256, C.G)); }
        if (!odd) {
            RUN(sb + 2, phase_ef1(C, A, l));
            RUN(sb + 3, { const int i2 = l >> 1; gphase_lora(C.lds, ws, A.in[I_D0] + (size_t)i2 * 2 * 768, A.in[I_A0] + (size_t)i2 * 2 * 768, A.in[I_KAL] + (size_t)i2 * 768, C.G); });
            RUN(sb + 4, phase_scan(C, A));
            RUN(sb + 5, phase_ef2(C, A, l));
        } else {
            RUN(sb + 2, phase_of1(C, A, l));
            RUN(sb + 3, phase_attn(C, A, l));
        }
        RUN(sb + 6, gphase_out(C.lds, ws, MODL, C.G));
        RUN(sb + 7, phase_rt(C, A, l));
        RUN(sb + 8, phase_tk(C, A));
        RUN(sb + 9, gphase_e1(C.lds, ws, C.G));
        RUN(sb + 10, gphase_e2(C.lds, ws, C.G));
        RUN(sb + 11, phase_cb(C, A, l));
    }
#undef RUN
}

#ifdef PHASE_PROBE
#define PROBE_PRE extern __shared__ __attribute__((aligned(16))) unsigned char lds_raw[]; Ctx C; mkctx(C, (LAS unsigned char*)lds_raw); unsigned char* ws = A.ws; (void)ws;
__global__ void __launch_bounds__(NTHR, 2) pr_init(Args A) { PROBE_PRE phase_init(C, A); }
__global__ void __launch_bounds__(NTHR, 2) pr_conv(Args A) { PROBE_PRE phase_conv(C, A, A.lo); }
__global__ void __launch_bounds__(NTHR, 2) pr_modh(Args A) { PROBE_PRE phase_modh(C, A, A.lo); }
__global__ void __launch_bounds__(NTHR, 2) pr_ef1(Args A) { PROBE_PRE phase_ef1(C, A, A.lo); }
__global__ void __launch_bounds__(NTHR, 2) pr_scan(Args A) { PROBE_PRE phase_scan(C, A); }
__global__ void __launch_bounds__(NTHR, 2) pr_ef2(Args A) { PROBE_PRE phase_ef2(C, A, A.lo); }
__global__ void __launch_bounds__(NTHR, 2) pr_of1(Args A) { PROBE_PRE phase_of1(C, A, A.lo); }
__global__ void __launch_bounds__(NTHR, 2) pr_attn(Args A) { PROBE_PRE phase_attn(C, A, A.lo); }
__global__ void __launch_bounds__(NTHR, 2) pr_rt(Args A) { PROBE_PRE phase_rt(C, A, A.lo); }
__global__ void __launch_bounds__(NTHR, 2) pr_tk(Args A) { PROBE_PRE phase_tk(C, A); }
__global__ void __launch_bounds__(NTHR, 2) pr_cb(Args A) { PROBE_PRE phase_cb(C, A, A.lo); }
__global__ void __launch_bounds__(NTHR, 2) pr_gemm_in(Args A) { PROBE_PRE pg8::Gemm g{(const bf16_t*)(ws + WS_H), (const bf16_t*)(ws + WS_WIN), DM}; pg8::Order<0> S; S.init(MROWS / 256, A.lo, C.G, (int)blockIdx.x, nullptr, 0);
                      pg8::EpiBf16 E{(bf16_t*)(ws + WS_P), P_LD}; pg8::gemm_phase(C.lds, g, S, E); }
__global__ void __launch_bounds__(NTHR, 2) pr_gemm_lora(Args A) { PROBE_PRE pg8::Gemm g{(const bf16_t*)(ws + WS_LIN), (const bf16_t*)(ws + WS_WLORA), LORA_K}; pg8::Order<0> S; S.init(MROWS / 256, LORA_N / 256, C.G, (int)blockIdx.x, nullptr, 0);
                          const int i2 = A.lo; pg8::EpiLora E{ws + WS_SCN, (bf16_t*)(ws + WS_G), A.in[I_D0] + (size_t)i2 * 2 * 768, A.in[I_A0] + (size_t)i2 * 2 * 768, A.in[I_KAL] + (size_t)i2 * 768};
                          pg8::gemm_phase(C.lds, g, S, E); }
__global__ void __launch_bounds__(NTHR, 2) pr_gemm_out(Args A) { PROBE_PRE pg8::Gemm g{(const bf16_t*)(ws + WS_A2), (const bf16_t*)(ws + WS_WOUT), DM}; pg8::Order<0> S; S.init(MROWS / 256, DM / 256, C.G, (int)blockIdx.x, nullptr, 0);
                      pg8::EpiRes E{(float*)(ws + WS_X), (const float*)(ws + WS_MOD)}; pg8::gemm_phase(C.lds, g, S, E); }
__global__ void __launch_bounds__(NTHR, 2) pr_gemm_e1(Args A) { PROBE_PRE pg8::Gemm g{(const bf16_t*)(ws + WS_H), (const bf16_t*)(ws + WS_WE13), DM}; pg8::Order<1> S; S.init(NEXP * 17, 4096 / 256, C.G, (int)blockIdx.x, (const int*)(ws + WS_IDX), (long)4096 * DM);
                      pg8::EpiSwiGLU E{(bf16_t*)(ws + WS_HID)}; pg8::gemm_phase(C.lds, g, S, E); }
__global__ void __launch_bounds__(NTHR, 2) pr_gemm_e2(Args A) { PROBE_PRE pg8::Gemm g{(const bf16_t*)(ws + WS_HID), (const bf16_t*)(ws + WS_WE2), D_EXP}; pg8::Order<2> S; S.init(NEXP * 17, DM / 256, C.G, (int)blockIdx.x, nullptr, (long)DM * D_EXP);
                       pg8::EpiYE E{(bf16_t*)(ws + WS_YE), (const float*)(ws + WS_GATE)}; pg8::gemm_phase(C.lds, g, S, E); }
#endif

extern "C" void kernel_launch(void* const* d_in, const int* in_sizes, int n_in, void* d_out, int out_size, void* d_ws, size_t ws_size, hipStream_t stream) {
    static int grid = 0;
    if (grid == 0) {
        if (n_in != 37 || out_size != NLAT * DM || ws_size < WS_END) { fprintf(stderr, "kernel_launch: unexpected shapes: n_in %d out %d ws %zu (need %zu)\n", n_in, out_size, ws_size, (size_t)WS_END); grid = -1; return; }
        int dev = 0, cus = 0, per_cu = 0;
        if (hipGetDevice(&dev) != hipSuccess || hipDeviceGetAttribute(&cus, hipDeviceAttributeMultiprocessorCount, dev) != hipSuccess) { grid = -1; return; }
        if (hipFuncSetAttribute((const void*)mk_fwd, hipFuncAttributeMaxDynamicSharedMemorySize, LDS_BYTES) != hipSuccess) { fprintf(stderr, "kernel_launch: hipFuncSetAttribute failed\n"); grid = -1; return; }
        if (hipOccupancyMaxActiveBlocksPerMultiprocessor(&per_cu, (const void*)mk_fwd, NTHR, LDS_BYTES) != hipSuccess || per_cu < 1) fprintf(stderr, "kernel_launch: occupancy query reports %d\n", per_cu);
        (void)hipGetLastError();
        grid = cus;
    }
    if (grid < 0) return;
    (void)hipMemsetAsync((char*)d_ws + WS_CTL, 0, CTL_BYTES, stream);
    Args a{};
    for (int i = 0; i < 37; ++i) a.in[i] = (const float*)d_in[i];
    a.out = (float*)d_out; a.ws = (unsigned char*)d_ws;
#if MK_MULTI
    for (int k = 0; k < NSTEP; ++k) {
        if (k >= 1) { const int l = (k - 1) / 12, s = (k - 1) % 12; if ((l & 1) && (s == 4 || s == 5)) continue; }
        a.lo = k; a.hi = k + 1;
        hipLaunchKernelGGL(mk_fwd, dim3(grid), dim3(NTHR), LDS_BYTES, stream, a);
    }
#else
    a.lo = 0; a.hi = NSTEP;
    hipLaunchKernelGGL(mk_fwd, dim3(grid), dim3(NTHR), LDS_BYTES, stream, a);
#endif
    const hipError_t le = hipPeekAtLastError();
    if (le != hipSuccess) fprintf(stderr, "kernel_launch: launch failed: %s\n", hipGetErrorName(le));
}
```

```cpp
#include <hip/hip_runtime.h>
#include <cstdio>
#include <cstdint>
#include <cmath>

#ifndef MK_MULTI
#define MK_MULTI 0
#endif
#ifndef CHUNKED_SCAN
#define CHUNKED_SCAN 1
#endif

#define GAS __attribute__((address_space(1)))
#define LAS __attribute__((address_space(3)))
typedef unsigned short bf16_t;
typedef short bf16x8 __attribute__((ext_vector_type(8)));
typedef float f32x4 __attribute__((ext_vector_type(4)));
typedef float f32x2 __attribute__((ext_vector_type(2)));
typedef float f32x16 __attribute__((ext_vector_type(16)));
typedef unsigned u32x4 __attribute__((ext_vector_type(4)));
typedef unsigned u32x2 __attribute__((ext_vector_type(2)));
typedef __bf16 bf16x2_t __attribute__((ext_vector_type(2)));

constexpr int NB = 4, TT = 8192, DM = 1024, NLAT = NB * TT, CTXL = 256, NCTX = NB * CTXL, MROWS = NLAT + NCTX;
constexpr int DEPTH = 4;
constexpr int D_CONV = 256, RW_H = 12, RW_K = 64, D_RWKV = 768, RWKV_COLS = 2688, D_IN_EVEN = 3456, D_IN_EVEN_PAD = 3584;
constexpr int D_DIFF = 768, D_GMLP = 256, D_IN_ODD = 2816;
constexpr int NEXP = 16, D_EXP = 2048, CAP_L = 1024, CAP_C = 32, ESLOTS = 4352;
constexpr int P_LD = 3584;
constexpr int LORA_K = 384, LORA_N = 3840;
constexpr int LKEYS = CTXL + TT;
constexpr float ALPHA_DN = 1.6817928305074290f;
constexpr float DECAY_SCALE = 0.6065306597126334f;
constexpr float GN_EPS = 64e-5f, LN_EPS = 1e-5f, RMS_EPS = 1e-5f;
constexpr float QSCALE = 0.125f * 1.4426950408889634f;

constexpr size_t al256(size_t x) { return (x + 255) & ~(size_t)255; }
constexpr size_t WS_CTL = 0;
constexpr size_t CTL_BYTES = 65536;
constexpr size_t WS_MOD = WS_CTL + CTL_BYTES;
constexpr size_t WS_ROPE = WS_MOD + al256((size_t)DEPTH * 5 * 6144 * 4);
constexpr size_t WS_WIN = WS_ROPE + 32768;
constexpr size_t WS_WOUT = WS_WIN + (size_t)D_IN_EVEN_PAD * DM * 2;
constexpr size_t WS_WLORA = WS_WOUT + (size_t)DM * DM * 2;
constexpr size_t WS_WE13 = WS_WLORA + (size_t)LORA_N * LORA_K * 2;
constexpr size_t WS_WE2 = WS_WE13 + (size_t)NEXP * 4096 * DM * 2;
constexpr size_t WS_X = WS_WE2 + (size_t)NEXP * DM * D_EXP * 2;
constexpr size_t WS_H = WS_X + (size_t)MROWS * DM * 4;
constexpr size_t WS_A2 = WS_H + (size_t)MROWS * DM * 2;
constexpr size_t WS_P = WS_A2 + (size_t)MROWS * DM * 2;
constexpr size_t WS_AFF = WS_P + (size_t)MROWS * P_LD * 2;
constexpr size_t WS_SLOT = WS_AFF + (size_t)MROWS * 16 * 4;
constexpr size_t WS_IDX = WS_SLOT + (size_t)MROWS * 16 * 4;
constexpr size_t WS_GATE = WS_IDX + al256((size_t)NEXP * ESLOTS * 4);
constexpr size_t WS_R2 = WS_GATE + al256((size_t)NEXP * ESLOTS * 4);
constexpr int SC_REC = 1408, SC_ROW = 12 * SC_REC, SC_W = 0, SC_R = 512, SC_KK = 640, SC_V = 768, SC_B = 896, SC_KR = 1024;
constexpr size_t WS_SCN = WS_R2;
constexpr size_t WS_G = WS_SCN + (size_t)MROWS * SC_ROW;
constexpr size_t WS_LIN = WS_G + (size_t)MROWS * 768 * 2;
constexpr int CS_L = 64, CS_NCH = LKEYS / CS_L, CS_UNITS = NB * RW_H * 2;
constexpr size_t WS_CHK = WS_LIN + (size_t)MROWS * 384 * 2;
constexpr size_t WS_EVEN_END = WS_CHK + (size_t)CS_UNITS * CS_NCH * 32768;
constexpr size_t WS_Y = WS_P;
constexpr size_t WS_Q = WS_R2;
constexpr size_t WS_KA = WS_Q + (size_t)MROWS * 768 * 2;
constexpr size_t WS_VT = WS_KA + (size_t)NB * LKEYS * 768 * 2;
constexpr size_t WS_HID = WS_R2;
constexpr size_t WS_YE = WS_HID + (size_t)NEXP * ESLOTS * D_EXP * 2;
constexpr size_t WS_END = WS_EVEN_END;
static_assert(WS_END <= (size_t)2147483648ull, "workspace over 2 GiB");
static_assert((size_t)2 * MROWS * 768 * 4 <= (size_t)MROWS * P_LD * 2, "Y aliases P");
static_assert(WS_YE + (size_t)NEXP * ESLOTS * DM * 2 <= WS_END, "moe region");

constexpr int LDS_BYTES = 147456;
constexpr int LDS_MISC = 140 * 1024;
constexpr int LDS_PTAB = LDS_MISC + 256;
constexpr int NWAVES = 8, NTHR = 512;

__device__ __forceinline__ unsigned f2bf(float f) { unsigned u = __float_as_uint(f); return (u + 0x7fffu + ((u >> 16) & 1u)) >> 16; }
__device__ __forceinline__ unsigned pk2(float lo, float hi) { f32x2 v = {lo, hi}; bf16x2_t b = __builtin_convertvector(v, bf16x2_t); return __builtin_bit_cast(unsigned, b); }
__device__ __forceinline__ float bflo(unsigned u) { return __uint_as_float(u << 16); }
__device__ __forceinline__ float bfhi(unsigned u) { return __uint_as_float(u & 0xffff0000u); }
__device__ __forceinline__ float bf2f(bf16_t b) { return __uint_as_float((unsigned)b << 16); }
__device__ __forceinline__ float sigmoidf_(float x) { return 1.f / (1.f + __expf(-x)); }
__device__ __forceinline__ float wave_sum(float v) {
#pragma unroll
    for (int o = 1; o < 64; o <<= 1) v += __shfl_xor(v, o);
    return v;
}
__device__ __forceinline__ float sum16(float v) {
#pragma unroll
    for (int o = 1; o < 16; o <<= 1) v += __shfl_xor(v, o);
    return v;
}
__device__ __forceinline__ f32x4 ld4bf_(const void* p) { const u32x2 u = *(const u32x2*)p; return (f32x4){bflo(u.x), bfhi(u.x), bflo(u.y), bfhi(u.y)}; }
__device__ __forceinline__ void st4bf_(void* p, f32x4 v) { u32x2 o; o.x = pk2(v[0], v[1]); o.y = pk2(v[2], v[3]); *(u32x2*)p = o; }
__device__ __forceinline__ float max3f(float a, float b, float c) { float r; asm("v_max3_f32 %0, %1, %2, %3" : "=v"(r) : "v"(a), "v"(b), "v"(c)); return r; }
__device__ __forceinline__ int crow(int r, int hi) { return (r & 3) + 8 * (r >> 2) + 4 * hi; }
__device__ __forceinline__ float gelu_erf(float x) { return 0.5f * x * (1.f + erff(x * 0.70710678118654752f)); }

#define XB_TMO      128
#define XB_XCNT(j)  (256  + 64 * (j))
#define XB_XSUB(j)  (1280 + 64 * (j))
#define XB_XGEN(j)  (2304 + 64 * (j))
#define XB_TOP      3328
#define XB_TOPGEN   3392
#define XCD_BAR_WORDS 3456
#define XB_SPIN_CAP (1u << 20)

__device__ __forceinline__ unsigned xb_ld(unsigned* p)              { return __hip_atomic_load(p, __ATOMIC_RELAXED, __HIP_MEMORY_SCOPE_AGENT); }
__device__ __forceinline__ unsigned xb_add(unsigned* p, unsigned v) { return __hip_atomic_fetch_add(p, v, __ATOMIC_RELAXED, __HIP_MEMORY_SCOPE_AGENT); }
__device__ __forceinline__ unsigned xb_xcc_id() { return (unsigned)__builtin_amdgcn_s_getreg((3 << 11) | 20) & 0xFu; }
#define XB_SPIN(cond, bar) do { unsigned _sp = 0; while (cond) { __builtin_amdgcn_s_sleep(1); \
    if ((++_sp & 255u) == 0u) { if (xb_ld(&(bar)[XB_TMO])) break; if (_sp > XB_SPIN_CAP) { atomicAdd(&(bar)[XB_TMO], 1u); break; } } } } while (0)

struct XcdBarrier { unsigned* bar; unsigned x; volatile LAS unsigned* st; };

__device__ __forceinline__ XcdBarrier xcd_barrier_post(unsigned* bar, volatile LAS unsigned* st) {
    XcdBarrier b; b.bar = bar; b.x = xb_xcc_id(); b.st = st;
    if (threadIdx.x == 0) (void)xb_add(&bar[XB_XCNT(b.x)], 1u);
    return b;
}
__device__ __forceinline__ void xcd_barrier_complete(unsigned* bar, unsigned x, unsigned& nloc, unsigned& nx) {
    const unsigned G = gridDim.x * gridDim.y * gridDim.z;
    unsigned sum, cnt, mine, sp = 0u;
    for (;;) {
        sum = 0u; cnt = 0u; mine = 0u;
#pragma unroll
        for (unsigned j = 0; j < 16; ++j) { const unsigned c = xb_ld(&bar[XB_XCNT(j)]); sum += c; cnt += (c > 0u) ? 1u : 0u; mine = (j == x) ? c : mine; }
        if (sum == G) break;
        __builtin_amdgcn_s_sleep(1);
        if ((++sp & 255u) == 0u) { if (xb_ld(&bar[XB_TMO])) break; if (sp > XB_SPIN_CAP) { atomicAdd(&bar[XB_TMO], 1u); break; } }
    }
    nloc = mine > 0u ? mine : 1u; nx = cnt > 0u ? cnt : 1u;
}
__device__ __forceinline__ void xcd_barrier(const XcdBarrier& b) {
    asm volatile("s_waitcnt vmcnt(0)" ::: "memory");
    __syncthreads();
    if (threadIdx.x == 0) {
        unsigned* bar = b.bar;
        __builtin_amdgcn_s_waitcnt(0);
        unsigned nloc = b.st[0], nx = b.st[1];
        if (nloc == 0u) { xcd_barrier_complete(bar, b.x, nloc, nx); b.st[0] = nloc; b.st[1] = nx; }
        const unsigned old = xb_add(&bar[XB_XSUB(b.x)], 1u);
        const unsigned gen = old / nloc;
        if (old + 1u == (gen + 1u) * nloc) {
            __builtin_amdgcn_fence(__ATOMIC_RELEASE, "agent");
            asm volatile("s_waitcnt vmcnt(0)" ::: "memory");
            const unsigned og = xb_add(&bar[XB_TOP], 1u);
            const unsigned tg = og / nx;
            if (og + 1u == (tg + 1u) * nx) xb_add(&bar[XB_TOPGEN], 1u);
            else XB_SPIN(xb_ld(&bar[XB_TOPGEN]) == tg, bar);
            __builtin_amdgcn_fence(__ATOMIC_ACQUIRE, "agent");
            xb_add(&bar[XB_XGEN(b.x)], 1u);
            asm volatile("s_waitcnt vmcnt(0)" ::: "memory");
        } else {
            XB_SPIN(xb_ld(&bar[XB_XGEN(b.x)]) == gen, bar);
            __builtin_amdgcn_fence(__ATOMIC_ACQUIRE, "agent");
            asm volatile("s_waitcnt vmcnt(0)" ::: "memory");
        }
    }
    __syncthreads();
}

namespace pg8 {
constexpr int BM = 256, BK = 64, HALF = 128, HTB = HALF * BK * 2, STAGE_BYTES = 8 * HTB, NXCD = 8, WGM = 8;
__host__ __device__ __forceinline__ int lds_byte(int r, int c) { const int st = (r >> 4) * 2 + (c >> 5), rr = r & 15, cc = c & 31, ob = rr * 64 + cc * 2; return st * 1024 + (ob ^ (((ob >> 9) & 1) << 5)); }
__host__ __device__ __forceinline__ void stage_rc(int b, int& R, int& C) { const int st = b / 1024, sb = b % 1024, swz = sb ^ (((sb >> 9) & 1) << 5); R = (st >> 1) * 16 + swz / 64; C = (st & 1) * 32 + (swz % 64) / 2; }

struct Unit { int pm, pn; };
struct Gemm { const bf16_t* A; const bf16_t* Bt; int K; };

template <int MODE> struct Order {
    int nM, nN, nwg, G, c; const int* idx; long bstride;
    __device__ __forceinline__ void init(int nM_, int nN_, int G_, int c_, const int* idx_, long bstride_) { nM = nM_; nN = nN_; nwg = nM * nN; G = G_; c = c_; idx = idx_; bstride = bstride_; }
    __device__ __forceinline__ bool next(int i, Unit& u) const {
        const long L = (long)i * G + c; if (L >= nwg) return false;
        int wgid = (int)L; { const int q = nwg / NXCD, r = nwg % NXCD, xcd = wgid % NXCD, off = wgid / NXCD; wgid = (xcd < r ? xcd * (q + 1) : r * (q + 1) + (xcd - r) * q) + off; }
        const int nig = WGM * nN, gid = wgid / nig, fm = gid * WGM, gsz = (nM - fm) < WGM ? (nM - fm) : WGM;
        u.pm = fm + ((wgid % nig) % gsz); u.pn = (wgid % nig) / gsz; return true;
    }
    __device__ __forceinline__ unsigned arow(const Unit& u, int r) const { if (MODE == 1) return (unsigned)idx[u.pm * BM + r]; return (unsigned)(u.pm * BM + r); }
    __device__ __forceinline__ long bbase(const Unit& u, int K) const { long o = (long)u.pn * BM * K; if (MODE != 0) o += (long)(u.pm / 17) * bstride; return o; }
};

template <class Epi, class Sched>
__device__ __forceinline__ void gemm_phase(LAS unsigned char* lds, const Gemm g, const Sched& S, const Epi& E) {
    int tid = threadIdx.x; asm volatile("" : "+v"(tid));
    const int wid = __builtin_amdgcn_readfirstlane(tid >> 6), wr = wid >> 2, wc = wid & 3;
    const int K = g.K, nt = K / BK;
    unsigned voffB[2];
    { const int lane = tid & 63, fr = lane & 15, fq = lane >> 4; (void)fr; (void)fq; }
#pragma unroll
    for (int i = 0; i < 2; ++i) { int R, Cc; stage_rc(tid * 16 + i * 8192, R, Cc); voffB[i] = (unsigned)(R * K + Cc) * 2u; }
    const size_t kstep = (size_t)(BK * 2);
    const size_t hstep = (size_t)HALF * K * 2;
    const unsigned ldsw = (unsigned)wid * 1024u;
    const int aoff = lds_byte(wr * 64 + (tid & 15), ((tid & 63) >> 4) * 8), boff = lds_byte(wc * 32 + (tid & 15), ((tid & 63) >> 4) * 8);
#define PG8_SA(b, h) (((b) * 2 + (h)) * HTB)
#define PG8_SB(b, h) ((4 + (b) * 2 + (h)) * HTB)
#define PG8_STAGE(bufoff, gbase, voff) do { _Pragma("unroll") for (int _i = 0; _i < 2; ++_i) \
        __builtin_amdgcn_global_load_lds((const unsigned*)((const char*)(gbase) + (voff)[_i]), (LAS unsigned*)(lds + (bufoff) + ldsw + _i * 8192), 16, 0, 0); } while (0)
#define PG8_LDA(dst, b, h) do { _Pragma("unroll") for (int m = 0; m < 4; ++m) _Pragma("unroll") for (int k = 0; k < 2; ++k) dst[m][k] = *(const LAS bf16x8*)(lds + PG8_SA(b, h) + aoff + m * 2048 + k * 1024); } while (0)
#define PG8_LDB(dst, b, h) do { _Pragma("unroll") for (int n = 0; n < 2; ++n) _Pragma("unroll") for (int k = 0; k < 2; ++k) dst[n][k] = *(const LAS bf16x8*)(lds + PG8_SB(b, h) + boff + n * 2048 + k * 1024); } while (0)
#define PG8_MMA(ai, bj, At, Bt) do { __builtin_amdgcn_s_setprio(1); _Pragma("unroll") for (int m = 0; m < 4; ++m) _Pragma("unroll") for (int n = 0; n < 2; ++n) _Pragma("unroll") for (int k = 0; k < 2; ++k) \
        acc[ai][bj][m][n] = __builtin_amdgcn_mfma_f32_16x16x32_bf16(Bt[n][k], At[m][k], acc[ai][bj][m][n], 0, 0, 0); __builtin_amdgcn_s_setprio(0); } while (0)
#define PG8_WAIT_V(n) asm volatile("s_waitcnt vmcnt(" #n ")" ::: "memory")
#define PG8_WAIT_L(n) asm volatile("s_waitcnt lgkmcnt(" #n ")" ::: "memory")
#define PG8_BAR __builtin_amdgcn_s_barrier()
#define PG8_SCHED __builtin_amdgcn_sched_barrier(0)
#define PG8_ROWOFFS(dst, u, tq) do { _Pragma("unroll") for (int _i = 0; _i < 2; ++_i) { int _R, _C; stage_rc((tq) * 16 + _i * 8192, _R, _C); _Pragma("unroll") for (int _h = 0; _h < 2; ++_h) dst[_h][_i] = (S.arow(u, _h * HALF + _R) * (unsigned)K + (unsigned)_C) * 2u; } } while (0)
    Unit cur, nxt; int ui = 0;
    if (!S.next(0, cur)) return;
    f32x4 acc[2][2][4][2];
#pragma unroll
    for (int a = 0; a < 2; ++a)
#pragma unroll
        for (int b = 0; b < 2; ++b)
#pragma unroll
            for (int m = 0; m < 4; ++m)
#pragma unroll
                for (int n = 0; n < 2; ++n) acc[a][b][m][n] = (f32x4){0.f, 0.f, 0.f, 0.f};
    bf16x8 At[4][2], B0[2][2], B1[2][2];
    unsigned vcur[2][2];
    PG8_ROWOFFS(vcur, cur, tid);
    const char* const Ab = (const char*)g.A;
    const char* cB = (const char*)g.Bt + (size_t)S.bbase(cur, K) * 2;
    PG8_STAGE(PG8_SB(0, 0), cB, voffB); PG8_STAGE(PG8_SB(0, 1), cB + hstep, voffB); PG8_STAGE(PG8_SA(0, 0), Ab, vcur[0]); PG8_STAGE(PG8_SA(0, 1), Ab, vcur[1]);
    if (wr == 1) PG8_BAR;
    PG8_WAIT_V(2); PG8_BAR;
    PG8_STAGE(PG8_SB(1, 0), cB + kstep, voffB); PG8_STAGE(PG8_SA(1, 0), Ab + kstep, vcur[0]); PG8_STAGE(PG8_SB(1, 1), cB + hstep + kstep, voffB);
    PG8_WAIT_V(6); PG8_BAR;
    for (;;) {
        const bool has_next = S.next(ui + 1, nxt);
        const char* nB = has_next ? (const char*)g.Bt + (size_t)S.bbase(nxt, K) * 2 : cB;
        for (int t = 0; t < nt; t += 2) {
            const bool last = (t == nt - 2);
            const char* a1 = Ab + (size_t)(t + 1) * kstep;
            const char* a2 = last ? Ab : Ab + (size_t)(t + 2) * kstep; const char* b2 = last ? nB : cB + (size_t)(t + 2) * kstep;
            const char* a3 = a2 + kstep; const char* b3 = b2 + kstep;
            PG8_LDB(B0, 0, 0); PG8_LDB(B1, 0, 1); PG8_SCHED; PG8_LDA(At, 0, 0); PG8_STAGE(PG8_SA(1, 1), a1, vcur[1]);
            PG8_WAIT_V(8); PG8_WAIT_L(0); PG8_BAR; PG8_MMA(0, 0, At, B0); PG8_MMA(0, 1, At, B1); PG8_BAR; PG8_SCHED;
            if (last && has_next) { int tq = tid; asm volatile("" : "+v"(tq)); PG8_ROWOFFS(vcur, nxt, tq); }
            PG8_LDA(At, 0, 1); PG8_STAGE(PG8_SB(0, 0), b2, voffB); PG8_STAGE(PG8_SB(0, 1), b2 + hstep, voffB); PG8_STAGE(PG8_SA(0, 0), a2, vcur[0]);
            PG8_WAIT_V(8); PG8_WAIT_L(0); PG8_BAR; PG8_MMA(1, 0, At, B0); PG8_MMA(1, 1, At, B1); PG8_BAR; PG8_SCHED;
            PG8_LDB(B0, 1, 0); PG8_LDB(B1, 1, 1); PG8_SCHED; PG8_LDA(At, 1, 0); PG8_STAGE(PG8_SA(0, 1), a2, vcur[1]);
            PG8_WAIT_V(8); PG8_WAIT_L(0); PG8_BAR; PG8_MMA(0, 0, At, B0); PG8_MMA(0, 1, At, B1); PG8_BAR; PG8_SCHED;
            PG8_LDA(At, 1, 1); PG8_STAGE(PG8_SB(1, 0), b3, voffB); PG8_STAGE(PG8_SB(1, 1), b3 + hstep, voffB); PG8_STAGE(PG8_SA(1, 0), a3, vcur[0]);
            PG8_WAIT_V(8); PG8_WAIT_L(0); PG8_BAR; PG8_MMA(1, 0, At, B0); PG8_MMA(1, 1, At, B1); PG8_BAR; PG8_SCHED;
        }
        if (wr == 0) PG8_BAR;
        { int tz = tid; asm volatile("" : "+v"(tz)); const int ln = tz & 63; E(acc, cur, wr, wc, ln & 15, ln >> 4); }
        if (!has_next) break;
#pragma unroll
        for (int a = 0; a < 2; ++a)
#pragma unroll
            for (int b = 0; b < 2; ++b)
#pragma unroll
                for (int m = 0; m < 4; ++m)
#pragma unroll
                    for (int n = 0; n < 2; ++n) acc[a][b][m][n] = (f32x4){0.f, 0.f, 0.f, 0.f};
        cur = nxt; cB = nB; ++ui;
        if (wr == 1) PG8_BAR;
    }
    PG8_WAIT_V(0);
    PG8_BAR;
#undef PG8_SA
#undef PG8_SB
#undef PG8_STAGE
#undef PG8_LDA
#undef PG8_LDB
#undef PG8_MMA
#undef PG8_WAIT_V
#undef PG8_WAIT_L
#undef PG8_BAR
#undef PG8_SCHED
#undef PG8_ROWOFFS
}

#define EPI_LOOP for (int ai = 0; ai < 2; ++ai) for (int m = 0; m < 4; ++m) for (int bj = 0; bj < 2; ++bj) for (int n = 0; n < 2; ++n)
struct EpiBf16 {
    bf16_t* O; int ldc;
    __device__ __forceinline__ void operator()(const f32x4 (&acc)[2][2][4][2], const Unit& u, int wr, int wc, int fr, int fq) const {
        const int row0 = u.pm * BM + wr * 64 + fr, col0 = u.pn * BM + wc * 32 + 4 * fq;
#pragma unroll
        for (int ai = 0; ai < 2; ++ai)
#pragma unroll
            for (int m = 0; m < 4; ++m) { bf16_t* rowp = O + (size_t)(row0 + ai * HALF + m * 16) * ldc + col0;
#pragma unroll
                for (int bj = 0; bj < 2; ++bj)
#pragma unroll
                    for (int n = 0; n < 2; ++n) { const f32x4 v = acc[ai][bj][m][n]; u32x2 o; o.x = pk2(v[0], v[1]); o.y = pk2(v[2], v[3]); *(u32x2*)(rowp + bj * HALF + n * 16) = o; } }
    }
};
struct EpiOdd {
    bf16_t* P; bf16_t* Q; bf16_t* KA; const float* rope;
    __device__ __forceinline__ void operator()(const f32x4 (&acc)[2][2][4][2], const Unit& u, int wr, int wc, int fr, int fq) const {
        const int row0 = u.pm * BM + wr * 64 + fr, col0 = u.pn * BM + wc * 32 + 4 * fq;
        if (u.pn >= 6) {
#pragma unroll
            for (int ai = 0; ai < 2; ++ai)
#pragma unroll
                for (int m = 0; m < 4; ++m) { bf16_t* rowp = P + (size_t)(row0 + ai * HALF + m * 16) * P_LD + col0;
#pragma unroll
                    for (int bj = 0; bj < 2; ++bj)
#pragma unroll
                        for (int n = 0; n < 2; ++n) { const f32x4 v = acc[ai][bj][m][n]; u32x2 o; o.x = pk2(v[0], v[1]); o.y = pk2(v[2], v[3]); *(u32x2*)(rowp + bj * HALF + n * 16) = o; } }
            return;
        }
        const bool isk = u.pn >= 3, isctx = u.pm >= NLAT / BM; const int axis = wc & 1;
        const int cq = col0 - (isk ? 768 : 0);
#pragma unroll
        for (int ai = 0; ai < 2; ++ai)
#pragma unroll
            for (int m = 0; m < 4; ++m) { const int row = row0 + ai * HALF + m * 16;
                f32x4 cs = {1.f, 1.f, 1.f, 1.f}, sn = {0.f, 0.f, 0.f, 0.f}; size_t orow;
                if (!isctx) { const int t = row & (TT - 1); const int pos = axis ? 128 + (t & 63) : (t >> 6);
                    cs = *(const f32x4*)(rope + pos * 16 + 4 * fq); sn = *(const f32x4*)(rope + 192 * 16 + pos * 16 + 4 * fq);
                    orow = isk ? (size_t)(row >> 13) * LKEYS + CTXL + t : (size_t)row; }
                else { const int rc = row - NLAT; orow = isk ? (size_t)(rc >> 8) * LKEYS + (rc & 255) : (size_t)row; }
                bf16_t* op = (isk ? KA : Q) + orow * 768 + cq; const float sc = isk ? 1.f : QSCALE;
#pragma unroll
                for (int bj = 0; bj < 2; ++bj) { const f32x4 x1 = acc[ai][bj][m][0], x2 = acc[ai][bj][m][1];
                    const f32x4 o1 = (x1 * cs - x2 * sn) * sc, o2 = (x1 * sn + x2 * cs) * sc;
                    u32x2 a; a.x = pk2(o1[0], o1[1]); a.y = pk2(o1[2], o1[3]); *(u32x2*)(op + bj * HALF) = a;
                    u32x2 b; b.x = pk2(o2[0], o2[1]); b.y = pk2(o2[2], o2[3]); *(u32x2*)(op + bj * HALF + 16) = b; } }
    }
};
struct EpiRes {
    float* X; const float* modl;
    __device__ __forceinline__ void operator()(const f32x4 (&acc)[2][2][4][2], const Unit& u, int wr, int wc, int fr, int fq) const {
        const int row0 = u.pm * BM + wr * 64 + fr, col0 = u.pn * BM + wc * 32 + 4 * fq;
        const int mi = (u.pm * BM < NLAT) ? (u.pm * BM) / TT : 4;
        const float* gate = modl + mi * 6144 + 2 * DM;
        f32x4 gv[2][2];
#pragma unroll
        for (int bj = 0; bj < 2; ++bj)
#pragma unroll
            for (int n = 0; n < 2; ++n) gv[bj][n] = *(const f32x4*)(gate + col0 + bj * HALF + n * 16);
#pragma unroll
        for (int ai = 0; ai < 2; ++ai)
#pragma unroll
            for (int m = 0; m < 4; ++m) { float* rowp = X + (size_t)(row0 + ai * HALF + m * 16) * DM + col0;
#pragma unroll
                for (int bj = 0; bj < 2; ++bj)
#pragma unroll
                    for (int n = 0; n < 2; ++n) { f32x4* p = (f32x4*)(rowp + bj * HALF + n * 16); const f32x4 x = *p; *p = x * ALPHA_DN + gv[bj][n] * acc[ai][bj][m][n]; } }
    }
};
struct EpiSwiGLU {
    bf16_t* HID;
    __device__ __forceinline__ void operator()(const f32x4 (&acc)[2][2][4][2], const Unit& u, int wr, int wc, int fr, int fq) const {
        const int row0 = u.pm * BM + wr * 64 + fr, f0 = u.pn * HALF + wc * 32 + 4 * fq;
#pragma unroll
        for (int ai = 0; ai < 2; ++ai)
#pragma unroll
            for (int m = 0; m < 4; ++m) { bf16_t* rowp = HID + (size_t)(row0 + ai * HALF + m * 16) * D_EXP + f0;
#pragma unroll
                for (int n = 0; n < 2; ++n) { const f32x4 a = acc[ai][0][m][n], b = acc[ai][1][m][n]; float h[4];
#pragma unroll
                    for (int j = 0; j < 4; ++j) h[j] = a[j] / (1.f + __expf(-a[j])) * b[j];
                    u32x2 o; o.x = pk2(h[0], h[1]); o.y = pk2(h[2], h[3]); *(u32x2*)(rowp + n * 16) = o; } }
    }
};
struct EpiYE {
    bf16_t* YE; const float* gate;
    __device__ __forceinline__ void operator()(const f32x4 (&acc)[2][2][4][2], const Unit& u, int wr, int wc, int fr, int fq) const {
        const int row0 = u.pm * BM + wr * 64 + fr, col0 = u.pn * BM + wc * 32 + 4 * fq;
#pragma unroll
        for (int ai = 0; ai < 2; ++ai)
#pragma unroll
            for (int m = 0; m < 4; ++m) { const int row = row0 + ai * HALF + m * 16; const float gt = gate[row]; bf16_t* rowp = YE + (size_t)row * DM + col0;
#pragma unroll
                for (int bj = 0; bj < 2; ++bj)
#pragma unroll
                    for (int n = 0; n < 2; ++n) { const f32x4 v = acc[ai][bj][m][n] * gt; u32x2 o; o.x = pk2(v[0], v[1]); o.y = pk2(v[2], v[3]); *(u32x2*)(rowp + bj * HALF + n * 16) = o; } }
    }
};
struct EpiLora {
    unsigned char* SCN; bf16_t* G; const float* decay0; const float* a0; const float* kalpha;
    __device__ __forceinline__ void operator()(const f32x4 (&acc)[2][2][4][2], const Unit& u, int wr, int wc, int fr, int fq) const {
        const int row0 = u.pm * BM + wr * 64 + fr;
        const int seg = u.pn / 3, cb = (u.pn % 3) * BM + wc * 32 + 4 * fq;
#pragma unroll
        for (int bj = 0; bj < 2; ++bj)
#pragma unroll
            for (int n = 0; n < 2; ++n) {
                const int col = cb + bj * HALF + n * 16, head = col >> 6, kx = col & 63;
                if (seg < 2) {
                    const f32x4 d0 = *(const f32x4*)(decay0 + seg * 768 + col);
#pragma unroll
                    for (int ai = 0; ai < 2; ++ai)
#pragma unroll
                        for (int m = 0; m < 4; ++m) { const int row = row0 + ai * HALF + m * 16; f32x4 w;
#pragma unroll
                            for (int j = 0; j < 4; ++j) { const float lw = -DECAY_SCALE * sigmoidf_(d0[j] + acc[ai][bj][m][n][j]); w[j] = CHUNKED_SCAN ? lw : __expf(lw); }
                            *(f32x4*)(SCN + (size_t)(row * 12 + head) * SC_REC + SC_W + seg * 256 + kx * 4) = w; }
                } else if (seg < 4) {
                    const int d = seg - 2;
                    const f32x4 a00 = *(const f32x4*)(a0 + d * 768 + col), kal = *(const f32x4*)(kalpha + col);
#pragma unroll
                    for (int ai = 0; ai < 2; ++ai)
#pragma unroll
                        for (int m = 0; m < 4; ++m) { const int row = row0 + ai * HALF + m * 16; unsigned char* base = SCN + (size_t)(row * 12 + head) * SC_REC + kx * 2;
                            const f32x4 kk = ld4bf_(base + SC_KK); const f32x4 ks = ld4bf_(base + SC_KR + 256 * d); f32x4 bb, kr;
#pragma unroll
                            for (int j = 0; j < 4; ++j) { const float a = sigmoidf_(a00[j] + acc[ai][bj][m][n][j]); bb[j] = kk[j] * a; kr[j] = ks[j] * (1.f + (a - 1.f) * kal[j]); }
                            st4bf_(base + SC_B + 256 * d, bb); st4bf_(base + SC_KR + 256 * d, kr); }
                } else {
#pragma unroll
                    for (int ai = 0; ai < 2; ++ai)
#pragma unroll
                        for (int m = 0; m < 4; ++m) { const int row = row0 + ai * HALF + m * 16; const f32x4 v = acc[ai][bj][m][n]; u32x2 o; o.x = pk2(v[0], v[1]); o.y = pk2(v[2], v[3]);
                            *(u32x2*)(G + (size_t)row * 768 + col) = o; }
                }
            }
    }
};
}

struct Args { const float* in[37]; float* out; unsigned char* ws; int lo, hi; };
enum { I_X = 0, I_C, I_CTX, I_CCTX, I_WMOD, I_BMOD, I_LNG, I_LNB, I_EWIN, I_EWOUT, I_CONVW, I_MU, I_DUP, I_D0, I_AUP, I_A0, I_GUP, I_KXI, I_KAL, I_RBON, I_GNG, I_GNB,
       I_OWIN, I_OWOUT, I_LQ1, I_LK1, I_LQ2, I_LK2, I_SUBG, I_GLNG, I_GLNB, I_GWS, I_GBS, I_WR, I_WE1, I_WE3, I_WE2 };

struct Ctx {
    LAS unsigned char* lds;
    int tid, lane, wave, G, vcu, gw, NGW;
};
__device__ __forceinline__ void mkctx(Ctx& C, LAS unsigned char* lds) {
    int tid = threadIdx.x; asm volatile("" : "+v"(tid));
    C.lds = lds; C.tid = tid; C.lane = tid & 63; C.wave = __builtin_amdgcn_readfirstlane(tid >> 6);
    C.G = gridDim.x; { const int bx = blockIdx.x; C.vcu = (C.G % 8 == 0) ? (bx % 8) * (C.G / 8) + bx / 8 : bx; }
    C.gw = blockIdx.x * NWAVES + C.wave; C.NGW = C.G * NWAVES;
}
__device__ __forceinline__ void ldargs(Args& A, LAS unsigned char* lds) {
    LAS const u32x2* tb = (LAS const u32x2*)(lds + LDS_PTAB); asm volatile("" : "+v"(tb));
#pragma unroll
    for (int i = 0; i < 37; ++i) { const u32x2 v = tb[i]; A.in[i] = (const float*)(((unsigned long long)(unsigned)__builtin_amdgcn_readfirstlane((int)v.y) << 32) | (unsigned)__builtin_amdgcn_readfirstlane((int)v.x)); }
    { const u32x2 v = tb[37]; A.out = (float*)(((unsigned long long)(unsigned)__builtin_amdgcn_readfirstlane((int)v.y) << 32) | (unsigned)__builtin_amdgcn_readfirstlane((int)v.x)); }
    { const u32x2 v = tb[38]; A.ws = (unsigned char*)(((unsigned long long)(unsigned)__builtin_amdgcn_readfirstlane((int)v.y) << 32) | (unsigned)__builtin_amdgcn_readfirstlane((int)v.x)); }
    A.lo = 0; A.hi = 0;
}
__device__ __forceinline__ int row_mi(int row) { return row < NLAT ? (row >> 13) : 4; }

__device__ __forceinline__ void phase_init(const Ctx& C, const Args& A) {
    unsigned char* ws = A.ws;
    float* MOD = (float*)(ws + WS_MOD);
    LAS float* sv = (LAS float*)C.lds;
    LAS float* red = sv + 5 * 1024;
    for (int i = C.tid; i < 5 * 1024; i += NTHR) { const int v = i >> 10, k = i & 1023; const float c = (v < 4) ? A.in[I_C][v * DM + k] : A.in[I_CCTX][k]; sv[i] = c / (1.f + __expf(-c)); }
    __syncthreads();
    const int j = C.tid & 127, kp = C.tid >> 7;
    for (int it = blockIdx.x; it < DEPTH * 48; it += C.G) {
        const int l = it / 48, cg = it % 48, col = cg * 128 + j;
        const float* W = A.in[I_WMOD] + (size_t)l * DM * 6144 + col;
        float a0 = 0.f, a1 = 0.f, a2 = 0.f, a3 = 0.f, a4 = 0.f;
#pragma unroll 4
        for (int k = kp * 256; k < kp * 256 + 256; ++k) { const float w = W[(size_t)k * 6144]; a0 += sv[k] * w; a1 += sv[1024 + k] * w; a2 += sv[2048 + k] * w; a3 += sv[3072 + k] * w; a4 += sv[4096 + k] * w; }
        red[(kp * 5 + 0) * 128 + j] = a0; red[(kp * 5 + 1) * 128 + j] = a1; red[(kp * 5 + 2) * 128 + j] = a2; red[(kp * 5 + 3) * 128 + j] = a3; red[(kp * 5 + 4) * 128 + j] = a4;
        __syncthreads();
        for (int o = C.tid; o < 5 * 128; o += NTHR) { const int v = o >> 7, jj = o & 127; const int cc = cg * 128 + jj;
            const float s = red[(0 * 5 + v) * 128 + jj] + red[(1 * 5 + v) * 128 + jj] + red[(2 * 5 + v) * 128 + jj] + red[(3 * 5 + v) * 128 + jj];
            MOD[((size_t)l * 5 + v) * 6144 + cc] = s + A.in[I_BMOD][l * 6144 + cc]; }
        __syncthreads();
    }
    if (blockIdx.x == C.G - 1) { float* rope = (float*)(ws + WS_ROPE);
        for (int i = C.tid; i < 192 * 16; i += NTHR) { const int pos = i >> 4, j = i & 15; const float ang = (float)(pos < 128 ? pos : pos - 128) * powf(10000.f, -(float)j * (1.f / 16.f));
            rope[i] = cosf(ang); rope[192 * 16 + i] = sinf(ang); } }
    f32x4* X4 = (f32x4*)(ws + WS_X);
    const f32x4* x4 = (const f32x4*)A.in[I_X]; const f32x4* c4 = (const f32x4*)A.in[I_CTX];
    const size_t nl = (size_t)NLAT * DM / 4, nc = (size_t)NCTX * DM / 4;
    for (size_t i = (size_t)blockIdx.x * NTHR + C.tid; i < nl + nc; i += (size_t)C.G * NTHR) X4[i] = (i < nl) ? x4[i] : c4[i - nl];
}

__device__ __forceinline__ void transpose_item(const float* W, int ldw, int k0, int n0, bf16_t* WT, int ldt, int drow0, LAS float* scr, int lane) {
    { float v[64]; const float* src = W + (size_t)k0 * ldw + n0 + lane;
#pragma unroll
      for (int k = 0; k < 64; ++k) v[k] = __builtin_nontemporal_load(src + (size_t)k * ldw);
#pragma unroll
      for (int k = 0; k < 64; ++k) scr[k * 65 + lane] = v[k]; }
    asm volatile("s_waitcnt lgkmcnt(0)" ::: "memory");
    const int c = lane & 7;
#pragma unroll
    for (int j = 0; j < 8; ++j) { const int n = (lane >> 3) + 8 * j; const LAS float* s = scr + (8 * c) * 65 + n;
        u32x4 o; o.x = pk2(s[0 * 65], s[1 * 65]); o.y = pk2(s[2 * 65], s[3 * 65]); o.z = pk2(s[4 * 65], s[5 * 65]); o.w = pk2(s[6 * 65], s[7 * 65]);
        *(u32x4*)(WT + (size_t)(drow0 + n) * ldt + k0 + 8 * c) = o; }
    asm volatile("s_waitcnt lgkmcnt(0)" ::: "memory");
}
__device__ __forceinline__ void phase_conv(const Ctx& C, const Args& A, int l) {
    unsigned char* ws = A.ws;
    const int i2 = l >> 1; const bool odd = (l & 1);
    LAS float* scr = (LAS float*)C.lds + C.wave * (64 * 65);
    bf16_t* WIN = (bf16_t*)(ws + WS_WIN); bf16_t* WOUT = (bf16_t*)(ws + WS_WOUT); bf16_t* WE13 = (bf16_t*)(ws + WS_WE13); bf16_t* WE2 = (bf16_t*)(ws + WS_WE2);
    const int nin = odd ? D_IN_ODD : D_IN_EVEN;
    const float* win = odd ? A.in[I_OWIN] + (size_t)i2 * DM * D_IN_ODD : A.in[I_EWIN] + (size_t)i2 * DM * D_IN_EVEN;
    const float* wout = odd ? A.in[I_OWOUT] + (size_t)i2 * DM * DM : A.in[I_EWOUT] + (size_t)i2 * DM * DM;
    const int n_in = 16 * (nin / 64), n_out = 16 * 16, n_e13 = NEXP * 2 * 16 * 32, n_e2 = NEXP * 32 * 16;
    const int total = n_in + n_out + n_e13 + n_e2;
    for (int it = C.gw; it < total; it += C.NGW) {
        int r = it;
        if (r < n_in) { const int nb = nin / 64, kb = r / nb, nn = r % nb; transpose_item(win, nin, kb * 64, nn * 64, WIN, DM, nn * 64, scr, C.lane); continue; } r -= n_in;
        if (r < n_out) { const int kb = r / 16, nn = r % 16; transpose_item(wout, DM, kb * 64, nn * 64, WOUT, DM, nn * 64, scr, C.lane); continue; } r -= n_out;
        if (r < n_e13) { const int e = r / 1024, q = r % 1024, mat = q / 512, q2 = q % 512, kb = q2 / 32, nn = q2 % 32;
            const float* W = (mat ? A.in[I_WE3] : A.in[I_WE1]) + ((size_t)l * NEXP + e) * DM * D_EXP;
            const int f0 = nn * 64; const int drow = (f0 >> 7) * 256 + mat * 128 + (f0 & 127);
            transpose_item(W, D_EXP, kb * 64, f0, WE13 + (size_t)e * 4096 * DM, DM, drow, scr, C.lane); continue; } r -= n_e13;
        { const int e = r / 512, q = r % 512, kb = q / 16, nn = q % 16;
            const float* W = A.in[I_WE2] + ((size_t)l * NEXP + e) * D_EXP * DM;
            transpose_item(W, DM, kb * 64, nn * 64, WE2 + (size_t)e * DM * D_EXP, D_EXP, nn * 64, scr, C.lane); }
    }
    if (!odd) {
        u32x4* z = (u32x4*)(WIN + (size_t)D_IN_EVEN * DM);
        for (int i = blockIdx.x * NTHR + C.tid; i < (D_IN_EVEN_PAD - D_IN_EVEN) * DM / 8; i += C.G * NTHR) z[i] = (u32x4){0u, 0u, 0u, 0u};
        bf16_t* WL = (bf16_t*)(ws + WS_WLORA);
        const float* dup = A.in[I_DUP] + (size_t)i2 * 2 * 64 * 768; const float* aup = A.in[I_AUP] + (size_t)i2 * 2 * 64 * 768; const float* gup = A.in[I_GUP] + (size_t)i2 * 128 * 768;
        for (int i = blockIdx.x * NTHR + C.tid; i < LORA_N * LORA_K; i += C.G * NTHR) {
            const int kk = i / LORA_N, n = i % LORA_N, seg = n / 768, col = n % 768; float v = 0.f;
            if (seg == 0) { if (kk < 64) v = dup[(size_t)(0 * 64 + kk) * 768 + col]; }
            else if (seg == 1) { if (kk >= 64 && kk < 128) v = dup[(size_t)(1 * 64 + kk - 64) * 768 + col]; }
            else if (seg == 2) { if (kk >= 128 && kk < 192) v = aup[(size_t)(0 * 64 + kk - 128) * 768 + col]; }
            else if (seg == 3) { if (kk >= 192 && kk < 256) v = aup[(size_t)(1 * 64 + kk - 192) * 768 + col]; }
            else { if (kk >= 256) v = gup[(size_t)(kk - 256) * 768 + col]; }
            WL[(size_t)n * LORA_K + kk] = (bf16_t)f2bf(v);
        }
    }
}

__device__ __forceinline__ void phase_modh(const Ctx& C, const Args& A, int l) {
    const float* X = (const float*)(A.ws + WS_X); bf16_t* H = (bf16_t*)(A.ws + WS_H); const float* MOD = (const float*)(A.ws + WS_MOD) + (size_t)l * 5 * 6144;
    for (int row = C.gw; row < MROWS; row += C.NGW) {
        const float* md = MOD + row_mi(row) * 6144;
#pragma unroll
        for (int j = 0; j < 4; ++j) { const int col = 4 * C.lane + 256 * j; const f32x4 x = *(const f32x4*)(X + (size_t)row * DM + col), sh = *(const f32x4*)(md + col), sc = *(const f32x4*)(md + DM + col);
            const f32x4 h = x * (sc + 1.f) + sh; u32x2 o; o.x = pk2(h[0], h[1]); o.y = pk2(h[2], h[3]); *(u32x2*)(H + (size_t)row * DM + col) = o; }
    }
}

__device__ __forceinline__ f32x4 ld4bf(const bf16_t* p) { const u32x2 u = *(const u32x2*)p; return (f32x4){bflo(u.x), bfhi(u.x), bflo(u.y), bfhi(u.y)}; }
__device__ __forceinline__ void st4bf(bf16_t* p, f32x4 v) { u32x2 o; o.x = pk2(v[0], v[1]); o.y = pk2(v[2], v[3]); *(u32x2*)p = o; }
__device__ __forceinline__ void seq_info(int row, bool& hasp, bool& hasn) {
    if (row < NLAT) { const int t = row & (TT - 1); hasp = t > 0; hasn = t < TT - 1; }
    else { const int t = (row - NLAT) & (CTXL - 1); hasp = t > 0; hasn = t < CTXL - 1; }
}
__device__ __forceinline__ void phase_ef1(const Ctx& C, const Args& A, int l) {
    const int i2 = l >> 1; unsigned char* ws = A.ws;
    const bf16_t* P = (const bf16_t*)(ws + WS_P); bf16_t* A2 = (bf16_t*)(ws + WS_A2); unsigned char* SCN = ws + WS_SCN; bf16_t* LIN = (bf16_t*)(ws + WS_LIN);
    const float* cw = A.in[I_CONVW] + (size_t)i2 * 3 * 256; const float* mu = A.in[I_MU] + (size_t)i2 * RWKV_COLS; const float* kxi = A.in[I_KXI] + (size_t)i2 * 768;
    const f32x4 z4 = {0.f, 0.f, 0.f, 0.f};
    for (int row = C.gw; row < MROWS; row += C.NGW) {
        bool hasp, hasn; seq_info(row, hasp, hasn);
        const bf16_t* p0 = P + (size_t)row * P_LD; const bf16_t* pm = p0 - P_LD; const bf16_t* pp = p0 + P_LD;
        {
            const int j4 = 4 * C.lane;
            const f32x4 bg = ld4bf(p0 + j4), u0 = ld4bf(p0 + 256 + j4) * ld4bf(p0 + 512 + j4);
            const f32x4 um = hasp ? ld4bf(pm + 256 + j4) * ld4bf(pm + 512 + j4) : z4, up = hasn ? ld4bf(pp + 256 + j4) * ld4bf(pp + 512 + j4) : z4;
            const f32x4 w0 = *(const f32x4*)(cw + j4), w1 = *(const f32x4*)(cw + 256 + j4), w2 = *(const f32x4*)(cw + 512 + j4);
            st4bf(A2 + (size_t)row * DM + j4, bg * (w0 * um + w1 * u0 + w2 * up));
        }
#pragma unroll
        for (int it = 0; it < 11; ++it) {
            const int c = it * 256 + 4 * C.lane;
            if (c < RWKV_COLS) {
                const f32x4 x0 = ld4bf(p0 + 768 + c), xm = hasp ? ld4bf(pm + 768 + c) : z4, xp = hasn ? ld4bf(pp + 768 + c) : z4, m4 = *(const f32x4*)(mu + c);
                const f32x4 ps = x0 + m4 * ((xm + xp) * 0.5f - x0);
                if (it < 3) { const int head = c >> 6, kx = c & 63; st4bf_(SCN + (size_t)(row * 12 + head) * SC_REC + SC_R + kx * 2, ps); }
                else if (it < 6) { const int c1 = c - 768, head = c1 >> 6, kx = c1 & 63; const f32x4 kv = ps * *(const f32x4*)(kxi + c1);
                    const float ss = sum16(kv[0] * kv[0] + kv[1] * kv[1] + kv[2] * kv[2] + kv[3] * kv[3]); const float rn = rsqrtf(ss + 1e-12f);
                    unsigned char* base = SCN + (size_t)(row * 12 + head) * SC_REC + kx * 2;
                    st4bf_(base + SC_KK, kv * rn); st4bf_(base + SC_KR, ps); st4bf_(base + SC_KR + 256, ps); }
                else if (it < 9) { const int c1 = c - 1536, head = c1 >> 6, kx = c1 & 63; st4bf_(SCN + (size_t)(row * 12 + head) * SC_REC + SC_V + kx * 2, ps); }
                else { const int c1 = c - 2304; f32x4 o;
                    if (c1 < 128) { o = (f32x4){tanhf(ps[0]), tanhf(ps[1]), tanhf(ps[2]), tanhf(ps[3])}; }
                    else if (c1 < 256) { o = ps; }
                    else { o = (f32x4){sigmoidf_(ps[0]), sigmoidf_(ps[1]), sigmoidf_(ps[2]), sigmoidf_(ps[3])}; }
                    st4bf(LIN + (size_t)row * LORA_K + c1, o); }
            }
        }
    }
}

__device__ __forceinline__ int scan_row(int i, int b, int d) {
    if (d == 0) return i < CTXL ? NLAT + b * CTXL + i : b * TT + (i - CTXL);
    return i < CTXL ? NLAT + b * CTXL + (CTXL - 1 - i) : b * TT + (TT - 1 - (i - CTXL));
}
__device__ __forceinline__ float red8(float v) {
    v += __uint_as_float((unsigned)__builtin_amdgcn_update_dpp(0, (int)__float_as_uint(v), 0xB1, 0xF, 0xF, true));
    v += __uint_as_float((unsigned)__builtin_amdgcn_update_dpp(0, (int)__float_as_uint(v), 0x4E, 0xF, 0xF, true));
    v += __uint_as_float((unsigned)__builtin_amdgcn_update_dpp(0, (int)__float_as_uint(v), 0x141, 0xF, 0xF, true));
    return v;
}
__device__ __forceinline__ float red16(float v) {
    v += __uint_as_float((unsigned)__builtin_amdgcn_update_dpp(0, (int)__float_as_uint(v), 0xB1, 0xF, 0xF, true));
    v += __uint_as_float((unsigned)__builtin_amdgcn_update_dpp(0, (int)__float_as_uint(v), 0x4E, 0xF, 0xF, true));
    v += __uint_as_float((unsigned)__builtin_amdgcn_update_dpp(0, (int)__float_as_uint(v), 0x141, 0xF, 0xF, true));
    v += __uint_as_float((unsigned)__builtin_amdgcn_update_dpp(0, (int)__float_as_uint(v), 0x140, 0xF, 0xF, true));
    return v;
}
__device__ __forceinline__ void phase_scan(const Ctx& C, const Args& A) {
    for (int u = blockIdx.x; u < 192; u += C.G) {
    const int half = u & 1, d = (u >> 1) & 1, h = (u >> 2) % 12, b = u / 48;
    const unsigned char* SCN = A.ws + WS_SCN; float* Y = (float*)(A.ws + WS_Y) + (size_t)d * MROWS * 768;
    LAS float* buf = (LAS float*)C.lds; LAS float* ybuf = buf + 2 * 32 * 352;
    constexpr int NCH = LKEYS / 32;
    u32x4 st[4];
    int ps_[4], psrc[4], pdst[4]; bool pf32[4];
#pragma unroll
    for (int j = 0; j < 4; ++j) { const int p = C.tid + NTHR * j; const int s = p / 52, q = p % 52; ps_[j] = s;
        if (q < 16) { psrc[j] = SC_W + 256 * d + q * 16; pdst[j] = s * 352 + q * 4; pf32[j] = true; }
        else if (q < 48) { const int vec = (q - 16) >> 3, part = (q - 16) & 7; const int so = vec == 0 ? SC_KK : vec == 1 ? SC_B + 256 * d : vec == 2 ? SC_KR + 256 * d : SC_R;
            psrc[j] = so + part * 16; pdst[j] = s * 352 + 64 * (vec + 1) + part * 8; pf32[j] = false; }
        else { const int part = q - 48; psrc[j] = SC_V + half * 64 + part * 16; pdst[j] = s * 352 + 320 + part * 8; pf32[j] = false; } }
    const int sgn = d ? -1 : 1;
    const unsigned char* SCNh = SCN + (size_t)h * SC_REC;
#define SCAN_ROW0(c) (((c) * 32 < CTXL) ? (NLAT + b * CTXL + (d ? CTXL - 1 - (c) * 32 : (c) * 32)) : (b * TT + (d ? TT - 1 - ((c) * 32 - CTXL) : (c) * 32 - CTXL)))
#define SCAN_LOADG(c) do { const int row0_ = SCAN_ROW0(c); _Pragma("unroll") for (int j = 0; j < 4; ++j) if (j < 3 || C.tid < 1664 - 3 * NTHR) { \
        st[j] = *(const u32x4*)(SCNh + (size_t)(row0_ + sgn * ps_[j]) * SC_ROW + psrc[j]); } } while (0)
#define SCAN_STORE(bi) do { _Pragma("unroll") for (int j = 0; j < 4; ++j) if (j < 3 || C.tid < 1664 - 3 * NTHR) { LAS float* dp = buf + (bi) * (32 * 352) + pdst[j]; \
        if (pf32[j]) *(LAS u32x4*)dp = st[j]; \
        else { *(LAS f32x4*)dp = (f32x4){bflo(st[j].x), bfhi(st[j].x), bflo(st[j].y), bfhi(st[j].y)}; *(LAS f32x4*)(dp + 4) = (f32x4){bflo(st[j].z), bfhi(st[j].z), bflo(st[j].w), bfhi(st[j].w)}; } } } while (0)
    SCAN_LOADG(0); SCAN_STORE(0); __syncthreads();
    f32x2 Sa = {0.f, 0.f}, Sb = {0.f, 0.f};
    const int rl = C.lane >> 4, ks = C.lane & 15;
    float ycol = 0.f;
#define SC_LD(R, s) do { const LAS float* bp_ = cur + (s) * 352 + ks * 4; \
        R##w = *(const LAS f32x4*)(bp_); R##k = *(const LAS f32x4*)(bp_ + 64); R##b = *(const LAS f32x4*)(bp_ + 128); R##q = *(const LAS f32x4*)(bp_ + 192); R##r = *(const LAS f32x4*)(bp_ + 256); \
        R##vv = cur[(s) * 352 + 320 + C.wave * 4 + rl]; } while (0)
#define SC_LO(v) ((f32x2){v[0], v[1]})
#define SC_HI(v) ((f32x2){v[2], v[3]})
#define SC_DPP(x, ctrl) __uint_as_float((unsigned)__builtin_amdgcn_update_dpp(0, (int)__float_as_uint(x), ctrl, 0xF, 0xF, true))
#define SC_STEP(R, P, s) do { \
        f32x2 pa = __builtin_elementwise_fma(Sb, SC_HI(R##k), Sa * SC_LO(R##k)), py = __builtin_elementwise_fma(Sb, SC_HI(P##r), Sa * SC_LO(P##r)); \
        float a_ = pa.x + pa.y, y_ = py.x + py.y; \
        a_ += SC_DPP(a_, 0xB1); y_ += SC_DPP(y_, 0xB1); a_ += SC_DPP(a_, 0x4E); y_ += SC_DPP(y_, 0x4E); \
        a_ += SC_DPP(a_, 0x141); y_ += SC_DPP(y_, 0x141); a_ += SC_DPP(a_, 0x140); y_ += SC_DPP(y_, 0x140); \
        ycol = (ks == ((s) & 15)) ? y_ : ycol; \
        const f32x2 na = {-a_, -a_}, vv2 = {R##vv, R##vv}; \
        Sa = __builtin_elementwise_fma(Sa, SC_LO(R##w), __builtin_elementwise_fma(na, SC_LO(R##b), vv2 * SC_LO(R##q))); \
        Sb = __builtin_elementwise_fma(Sb, SC_HI(R##w), __builtin_elementwise_fma(na, SC_HI(R##b), vv2 * SC_HI(R##q))); } while (0)
    f32x4 Aw, Ak, Ab, Aq, Ar, Bw, Bk, Bb, Bq, Br, Cw, Ck, Cb, Cq, Cr, Dw, Dk, Db, Dq, Dr; float Avv, Bvv, Cvv, Dvv;
    Dr = (f32x4){0.f, 0.f, 0.f, 0.f};
    for (int c = 0; c < NCH; ++c) {
        if (c + 1 < NCH) SCAN_LOADG(c + 1);
        {
            const LAS float* cur = buf + (c & 1) * (32 * 352);
            LAS float* yb = ybuf + (c & 1) * 1024 + C.wave * 4 + rl + ks * 32;
            SC_LD(A, 0); SC_LD(B, 1);
#pragma unroll 1
            for (int s = 0; s < 32; s += 4) {
                SC_LD(C, s + 2); __builtin_amdgcn_sched_barrier(0); SC_STEP(A, D, s); __builtin_amdgcn_sched_barrier(0);
                SC_LD(D, s + 3); __builtin_amdgcn_sched_barrier(0); SC_STEP(B, A, s + 1); __builtin_amdgcn_sched_barrier(0);
                SC_LD(A, s + 4); __builtin_amdgcn_sched_barrier(0); SC_STEP(C, B, s + 2); __builtin_amdgcn_sched_barrier(0);
                SC_LD(B, s + 5); __builtin_amdgcn_sched_barrier(0); SC_STEP(D, C, s + 3); __builtin_amdgcn_sched_barrier(0);
                if ((s & 15) == 12) yb[(s & 16) * 32] = ycol;
            }
        }
        if (c + 1 < NCH) SCAN_STORE((c + 1) & 1);
        __syncthreads();
        { const int row0_ = SCAN_ROW0(c);
#pragma unroll
          for (int i = 0; i < 2; ++i) { const int e = C.tid + NTHR * i, s = e >> 5, r = e & 31;
            const int row = (s > 0) ? row0_ + sgn * (s - 1) : scan_row(c * 32 - 1, b, d);
            if (s > 0 || c > 0) Y[(size_t)row * 768 + h * 64 + half * 32 + r] = ybuf[(c & 1) * 1024 + e]; } }
    }
    {
        f32x2 py = __builtin_elementwise_fma(Sb, SC_HI(Dr), Sa * SC_LO(Dr)); float y_ = py.x + py.y;
        y_ += SC_DPP(y_, 0xB1); y_ += SC_DPP(y_, 0x4E); y_ += SC_DPP(y_, 0x141); y_ += SC_DPP(y_, 0x140);
        if (ks == 0) Y[(size_t)scan_row(LKEYS - 1, b, d) * 768 + h * 64 + half * 32 + C.wave * 4 + rl] = y_;
    }
    __syncthreads();
    }
#undef SCAN_LOADG
#undef SCAN_STORE
#undef SCAN_ROW0
#undef SC_LD
#undef SC_STEP
#undef SC_LO
#undef SC_HI
#undef SC_DPP
}

constexpr int CSP = 72;
constexpr int CS_MAT = 64 * CSP * 2;
constexpr int CS_WT = 0, CS_KB = CS_MAT, CS_BB = 2 * CS_MAT, CS_RT = 3 * CS_MAT, CS_BHT = 4 * CS_MAT, CS_KHT = 5 * CS_MAT, CS_VMT = 6 * CS_MAT;
constexpr int CS_M2F = 7 * CS_MAT;
constexpr int CS_M1T = CS_M2F + 16384;
constexpr int CS_N2 = CS_M1T + CS_MAT;
constexpr int CS_GT = CS_N2 + CS_MAT;
constexpr int CS_Z = CS_M2F, CS_U = CS_M2F + CS_MAT;
constexpr int CS_GL = CS_GT + 2 * CS_MAT;
static_assert(CS_GL + 256 <= LDS_MISC, "chunked-scan LDS map");
__device__ __forceinline__ void cs_mma(f32x16& acc, const LAS unsigned char* Am, const LAS unsigned char* Bm, int ti, int tj, int r32, int hi) {
    const LAS unsigned char* ap = Am + (ti * 32 + r32) * (CSP * 2) + hi * 16; const LAS unsigned char* bp = Bm + (tj * 32 + r32) * (CSP * 2) + hi * 16;
#pragma unroll
    for (int ks = 0; ks < 4; ++ks) acc = __builtin_amdgcn_mfma_f32_32x32x16_bf16(*(const LAS bf16x8*)(ap + ks * 32), *(const LAS bf16x8*)(bp + ks * 32), acc, 0, 0, 0);
}
__device__ __forceinline__ void cs_store_t(LAS unsigned char* Om, const f32x16& acc, int ti, int tj, int r32, int hi) {
    LAS unsigned char* op = Om + (tj * 32 + r32) * (CSP * 2) + (ti * 32 + 4 * hi) * 2;
#pragma unroll
    for (int g = 0; g < 4; ++g) { u32x2 o; o.x = pk2(acc[4 * g], acc[4 * g + 1]); o.y = pk2(acc[4 * g + 2], acc[4 * g + 3]); *(LAS u32x2*)(op + g * 16) = o; }
}
#define CS_BAR() asm volatile("s_waitcnt lgkmcnt(0)\n\ts_barrier" ::: "memory")
__device__ __forceinline__ void phase_csa(const Ctx& C, const Args& A) {
    const unsigned char* SCN = A.ws + WS_SCN; unsigned char* CHK = A.ws + WS_CHK;
    LAS unsigned char* L = C.lds;
    const int r32 = C.lane & 31, hi = C.lane >> 5;
    float lwv[8]; u32x4 ukk, ub, ukr, ur, uv;
#define CSA_GEOM(cu_) const int unit = (cu_) / CS_NCH, ch = (cu_) % CS_NCH; const int d = unit & 1, h = (unit >> 1) % 12, b = unit / 24; \
        const int step0 = ch * CS_L; const int sgn = d ? -1 : 1; \
        const int row0 = (step0 < CTXL) ? (NLAT + b * CTXL + (d ? CTXL - 1 - step0 : step0)) : (b * TT + (d ? TT - 1 - (step0 - CTXL) : step0 - CTXL)); \
        const unsigned char* rec0 = SCN + (size_t)row0 * SC_ROW + (size_t)h * SC_REC;
#define CSA_LOAD(cu_) do { CSA_GEOM(cu_); \
        { const int k = C.tid & 63, sg = C.tid >> 6; _Pragma("unroll") for (int j = 0; j < 8; ++j) lwv[j] = *(const float*)(rec0 + (long)sgn * (8 * sg + j) * SC_ROW + SC_W + 256 * d + k * 4); } \
        { const int t = C.tid >> 3, k0 = (C.tid & 7) * 8; const unsigned char* rp = rec0 + (long)sgn * t * SC_ROW; \
          ukk = *(const u32x4*)(rp + SC_KK + k0 * 2); ub = *(const u32x4*)(rp + SC_B + 256 * d + k0 * 2); ukr = *(const u32x4*)(rp + SC_KR + 256 * d + k0 * 2); ur = *(const u32x4*)(rp + SC_R + k0 * 2); uv = *(const u32x4*)(rp + SC_V + k0 * 2); } } while (0)
    if ((int)blockIdx.x < CS_UNITS * CS_NCH) CSA_LOAD((int)blockIdx.x);
    for (int cu = blockIdx.x; cu < CS_UNITS * CS_NCH; cu += C.G) {
        LAS float* csf = (LAS float*)(L + CS_M2F);
        LAS float* seg = (LAS float*)(L + CS_M1T);
        { const int k = C.tid & 63, sg = C.tid >> 6;
#pragma unroll
          for (int j = 1; j < 8; ++j) lwv[j] += lwv[j - 1];
          seg[sg * 64 + k] = lwv[7];
          CS_BAR();
          float off = 0.f, tot = 0.f;
#pragma unroll
          for (int s2 = 0; s2 < 8; ++s2) { const float v = seg[s2 * 64 + k]; off += (s2 < sg) ? v : 0.f; tot += v; }
#pragma unroll
          for (int j = 0; j < 8; ++j) csf[(8 * sg + j) * 64 + k] = lwv[j] + off;
          if (sg == 7) ((LAS float*)(L + CS_GL))[k] = __expf(tot); }
        CS_BAR();
        { const int t = C.tid >> 3, k0 = (C.tid & 7) * 8;
          float wt[8], kb[8], bb[8], rt[8], bh[8], kh[8];
#pragma unroll
          for (int j = 0; j < 8; ++j) { const unsigned pkk = j < 2 ? ukk.x : j < 4 ? ukk.y : j < 6 ? ukk.z : ukk.w, pb = j < 2 ? ub.x : j < 4 ? ub.y : j < 6 ? ub.z : ub.w, pkr = j < 2 ? ukr.x : j < 4 ? ukr.y : j < 6 ? ukr.z : ukr.w, pr = j < 2 ? ur.x : j < 4 ? ur.y : j < 6 ? ur.z : ur.w;
              const float kkv = (j & 1) ? bfhi(pkk) : bflo(pkk), bv = (j & 1) ? bfhi(pb) : bflo(pb), krv = (j & 1) ? bfhi(pkr) : bflo(pkr), rv = (j & 1) ? bfhi(pr) : bflo(pr);
              const float cst = csf[t * 64 + k0 + j], csp = t > 0 ? csf[(t - 1) * 64 + k0 + j] : 0.f, csl = csf[63 * 64 + k0 + j];
              const float einv = __expf(-cst), el = __expf(csl - cst);
              wt[j] = kkv * __expf(csp); kb[j] = krv * einv; bb[j] = bv * einv; rt[j] = rv * __expf(cst); bh[j] = bv * el; kh[j] = krv * el; }
          u32x4 o;
          o.x = pk2(wt[0], wt[1]); o.y = pk2(wt[2], wt[3]); o.z = pk2(wt[4], wt[5]); o.w = pk2(wt[6], wt[7]); *(LAS u32x4*)(L + CS_WT + t * (CSP * 2) + k0 * 2) = o;
          o.x = pk2(kb[0], kb[1]); o.y = pk2(kb[2], kb[3]); o.z = pk2(kb[4], kb[5]); o.w = pk2(kb[6], kb[7]); *(LAS u32x4*)(L + CS_KB + t * (CSP * 2) + k0 * 2) = o;
          o.x = pk2(bb[0], bb[1]); o.y = pk2(bb[2], bb[3]); o.z = pk2(bb[4], bb[5]); o.w = pk2(bb[6], bb[7]); *(LAS u32x4*)(L + CS_BB + t * (CSP * 2) + k0 * 2) = o;
          o.x = pk2(rt[0], rt[1]); o.y = pk2(rt[2], rt[3]); o.z = pk2(rt[4], rt[5]); o.w = pk2(rt[6], rt[7]); *(LAS u32x4*)(L + CS_RT + t * (CSP * 2) + k0 * 2) = o;
#pragma unroll
          for (int j = 0; j < 8; ++j) { *(LAS bf16_t*)(L + CS_BHT + (k0 + j) * (CSP * 2) + t * 2) = (bf16_t)f2bf(bh[j]); *(LAS bf16_t*)(L + CS_KHT + (k0 + j) * (CSP * 2) + t * 2) = (bf16_t)f2bf(kh[j]);
              const unsigned pv = j < 2 ? uv.x : j < 4 ? uv.y : j < 6 ? uv.z : uv.w; *(LAS bf16_t*)(L + CS_VMT + (k0 + j) * (CSP * 2) + t * 2) = (bf16_t)((j & 1) ? (pv >> 16) : (pv & 0xffffu)); } }
        if (cu + C.G < CS_UNITS * CS_NCH) CSA_LOAD(cu + C.G);
        CS_BAR();
        for (int job = C.wave; job < 12; job += NWAVES) { const int p = job >> 2, ti = (job >> 1) & 1, tj = job & 1;
            f32x16 acc;
#pragma unroll
            for (int i = 0; i < 16; ++i) acc[i] = 0.f;
            if (p == 0) { cs_mma(acc, L + CS_WT, L + CS_BB, ti, tj, r32, hi);
                const int i = tj * 32 + r32; LAS float* mp = (LAS float*)(L + CS_M2F) + i * 64;
#pragma unroll
                for (int reg = 0; reg < 16; ++reg) { const int t = ti * 32 + crow(reg, hi); mp[(t & 3) * 16 + (t >> 2)] = (i < t) ? acc[reg] : 0.f; } }
            else if (p == 1) { cs_mma(acc, L + CS_WT, L + CS_KB, ti, tj, r32, hi);
                const int i = tj * 32 + r32;
#pragma unroll
                for (int reg = 0; reg < 16; ++reg) { const int t = ti * 32 + crow(reg, hi); acc[reg] = (i < t) ? acc[reg] : 0.f; }
                cs_store_t(L + CS_M1T, acc, ti, tj, r32, hi); }
            else { cs_mma(acc, L + CS_BB, L + CS_RT, ti, tj, r32, hi);
                const int t = tj * 32 + r32;
#pragma unroll
                for (int reg = 0; reg < 16; ++reg) { const int i = ti * 32 + crow(reg, hi); acc[reg] = (i <= t) ? acc[reg] : 0.f; }
                cs_store_t(L + CS_N2, acc, ti, tj, r32, hi); } }
        CS_BAR();
        { const int c = C.tid >> 2, q = C.tid & 3; float acc[16];
          { const LAS unsigned char* rcol = (c < 64) ? (L + CS_WT + c * 2) : (L + CS_M1T + (c - 64) * (CSP * 2)); const int rstride = (c < 64) ? CSP * 2 : 2;
#pragma unroll
            for (int j = 0; j < 16; ++j) acc[j] = bf2f(*(const LAS bf16_t*)(rcol + (4 * j + q) * rstride)); }
          const LAS float* m2c = (const LAS float*)(L + CS_M2F) + q * 16;
#pragma clang loop unroll(full)
          for (int i = 0; i < 64; ++i) {
              const float mine = -acc[i >> 2];
              float gi;
              switch (i & 3) { case 0: gi = __uint_as_float((unsigned)__builtin_amdgcn_update_dpp(0, (int)__float_as_uint(mine), 0x00, 0xF, 0xF, true)); break;
                               case 1: gi = __uint_as_float((unsigned)__builtin_amdgcn_update_dpp(0, (int)__float_as_uint(mine), 0x55, 0xF, 0xF, true)); break;
                               case 2: gi = __uint_as_float((unsigned)__builtin_amdgcn_update_dpp(0, (int)__float_as_uint(mine), 0xAA, 0xF, 0xF, true)); break;
                               default: gi = __uint_as_float((unsigned)__builtin_amdgcn_update_dpp(0, (int)__float_as_uint(mine), 0xFF, 0xF, 0xF, true)); break; }
#pragma unroll
              for (int j4 = (i >> 4); j4 < 4; ++j4) { const f32x4 m = *(const LAS f32x4*)(m2c + i * 64 + j4 * 4);
#pragma unroll
                  for (int e = 0; e < 4; ++e) if (4 * j4 + e >= (i >> 2)) acc[4 * j4 + e] += m[e] * gi; }
          }
#pragma unroll
          for (int j = 0; j < 16; ++j) *(LAS bf16_t*)(L + CS_GT + c * (CSP * 2) + (4 * j + q) * 2) = (bf16_t)f2bf(-acc[j]); }
        CS_BAR();
        unsigned char* outp = CHK + (size_t)cu * 32768;
        for (int job = C.wave; job < 16; job += NWAVES) { const int p = job >> 2, ti = (job >> 1) & 1, tj = job & 1;
            f32x16 acc;
            if (p == 0) {
                const LAS unsigned char* rp = L + CS_RT + (tj * 32 + r32) * (CSP * 2) + (ti * 32 + 4 * hi) * 2;
#pragma unroll
                for (int g = 0; g < 4; ++g) { const u32x2 u = *(const LAS u32x2*)(rp + g * 16); acc[4 * g] = bflo(u.x); acc[4 * g + 1] = bfhi(u.x); acc[4 * g + 2] = bflo(u.y); acc[4 * g + 3] = bfhi(u.y); }
                cs_mma(acc, L + CS_GT, L + CS_N2, ti, tj, r32, hi);
#pragma unroll
                for (int g = 0; g < 4; ++g) { u32x2 o; o.x = pk2(acc[4 * g], acc[4 * g + 1]); o.y = pk2(acc[4 * g + 2], acc[4 * g + 3]);
                    *(u32x2*)(outp + 8192 + (((tj * 4 + 2 * ti + (g >> 1)) * 64 + (g & 1) * 32 + r32) * 16) + hi * 8) = o; } }
            else if (p == 1) {
#pragma unroll
                for (int i = 0; i < 16; ++i) acc[i] = 0.f;
                cs_mma(acc, L + CS_KB, L + CS_RT, ti, tj, r32, hi);
                const int t = tj * 32 + r32;
#pragma unroll
                for (int reg = 0; reg < 16; ++reg) { const int i = ti * 32 + crow(reg, hi); acc[reg] = (i <= t) ? acc[reg] : 0.f; }
                cs_mma(acc, L + CS_GT + 64 * (CSP * 2), L + CS_N2, ti, tj, r32, hi);
                cs_store_t(L + CS_Z, acc, ti, tj, r32, hi); }
            else if (p == 2) {
#pragma unroll
                for (int i = 0; i < 16; ++i) acc[i] = 0.f;
                cs_mma(acc, L + CS_GT, L + CS_BHT, ti, tj, r32, hi);
                const int k = tj * 32 + r32; const float gl = ((const LAS float*)(L + CS_GL))[k];
#pragma unroll
                for (int reg = 0; reg < 16; ++reg) { const int cc = ti * 32 + crow(reg, hi); acc[reg] += (cc == k) ? gl : 0.f; }
#pragma unroll
                for (int g = 0; g < 4; ++g) { u32x2 o; o.x = pk2(acc[4 * g], acc[4 * g + 1]); o.y = pk2(acc[4 * g + 2], acc[4 * g + 3]);
                    *(u32x2*)(outp + (((tj * 4 + 2 * ti + (g >> 1)) * 64 + (g & 1) * 32 + r32) * 16) + hi * 8) = o; } }
            else {
                const LAS unsigned char* kp = L + CS_KHT + (tj * 32 + r32) * (CSP * 2) + (ti * 32 + 4 * hi) * 2;
#pragma unroll
                for (int g = 0; g < 4; ++g) { const u32x2 u = *(const LAS u32x2*)(kp + g * 16); acc[4 * g] = bflo(u.x); acc[4 * g + 1] = bfhi(u.x); acc[4 * g + 2] = bflo(u.y); acc[4 * g + 3] = bfhi(u.y); }
                cs_mma(acc, L + CS_GT + 64 * (CSP * 2), L + CS_BHT, ti, tj, r32, hi);
                cs_store_t(L + CS_U, acc, ti, tj, r32, hi); } }
        CS_BAR();
        { const int p = C.wave >> 2, ti = (C.wave >> 1) & 1, tj = C.wave & 1;
          f32x16 acc;
#pragma unroll
          for (int i = 0; i < 16; ++i) acc[i] = 0.f;
          cs_mma(acc, L + (p ? CS_U : CS_Z), L + CS_VMT, ti, tj, r32, hi);
          unsigned char* op = outp + (p ? 16384 : 24576) + ((ti * 2 + tj) * 64 + C.lane) * 32;
          u32x4 o0, o1; o0.x = pk2(acc[0], acc[1]); o0.y = pk2(acc[2], acc[3]); o0.z = pk2(acc[4], acc[5]); o0.w = pk2(acc[6], acc[7]);
          o1.x = pk2(acc[8], acc[9]); o1.y = pk2(acc[10], acc[11]); o1.z = pk2(acc[12], acc[13]); o1.w = pk2(acc[14], acc[15]);
          *(u32x4*)op = o0; *(u32x4*)(op + 16) = o1; }
        CS_BAR();
    }
}
__device__ __forceinline__ void phase_csb(const Ctx& C, const Args& A) {
    const unsigned char* CHK = A.ws + WS_CHK;
    LAS unsigned char* L = C.lds;
    const int r32 = C.lane & 31, hi = C.lane >> 5;
    const bool isS = C.wave < 4; const int ti = (C.wave >> 1) & 1, tj = C.wave & 1;
    for (int unit = blockIdx.x; unit < CS_UNITS; unit += C.G) {
        const int d = unit & 1, h = (unit >> 1) % 12, b = unit / 24;
        float* Y = (float*)(A.ws + WS_Y) + (size_t)d * MROWS * 768;
        for (int i = C.tid; i < 2 * CS_MAT / 4; i += NTHR) ((LAS unsigned*)L)[i] = 0u;
        CS_BAR();
        bf16x8 afA[4], afB[4], afC[4]; u32x4 cA0, cA1, cB0, cB1, cC0, cC1;
#define CSB_LOAD(A4, C0, C1, ch_) do { const unsigned char* op_ = CHK + ((size_t)unit * CS_NCH + (ch_)) * 32768; \
            const unsigned char* am_ = op_ + (isS ? 0 : 8192) + (ti * 4 * 64 + C.lane) * 16;     \
            _Pragma("unroll") for (int ks = 0; ks < 4; ++ks) A4[ks] = *(const bf16x8*)(am_ + ks * 1024); \
            const unsigned char* cp_ = op_ + (isS ? 16384 : 24576) + ((ti * 2 + tj) * 64 + C.lane) * 32; C0 = *(const u32x4*)cp_; C1 = *(const u32x4*)(cp_ + 16); } while (0)
#define CSB_STEP(A4, C0, C1, ch_) do { \
            const LAS unsigned char* Sb = L + ((ch_) & 1) * CS_MAT; LAS unsigned char* Sn = L + (((ch_) + 1) & 1) * CS_MAT; \
            f32x16 acc; \
            acc[0] = bflo(C0.x); acc[1] = bfhi(C0.x); acc[2] = bflo(C0.y); acc[3] = bfhi(C0.y); acc[4] = bflo(C0.z); acc[5] = bfhi(C0.z); acc[6] = bflo(C0.w); acc[7] = bfhi(C0.w); \
            acc[8] = bflo(C1.x); acc[9] = bfhi(C1.x); acc[10] = bflo(C1.y); acc[11] = bfhi(C1.y); acc[12] = bflo(C1.z); acc[13] = bfhi(C1.z); acc[14] = bflo(C1.w); acc[15] = bfhi(C1.w); \
            const LAS unsigned char* bp = Sb + (tj * 32 + r32) * (CSP * 2) + hi * 16; \
            _Pragma("unroll") for (int ks = 0; ks < 4; ++ks) acc = __builtin_amdgcn_mfma_f32_32x32x16_bf16(A4[ks], *(const LAS bf16x8*)(bp + ks * 32), acc, 0, 0, 0); \
            if (isS) { cs_store_t(Sn, acc, ti, tj, r32, hi); }     \
            else {     \
                const int step0 = (ch_) * CS_L; const int sgn = d ? -1 : 1; \
                const int row0 = (step0 < CTXL) ? (NLAT + b * CTXL + (d ? CTXL - 1 - step0 : step0)) : (b * TT + (d ? TT - 1 - (step0 - CTXL) : step0 - CTXL)); \
                float* yp = Y + (size_t)(row0 + sgn * (ti * 32 + 4 * hi)) * 768 + h * 64 + tj * 32 + r32; const long ys = (long)sgn * 768; \
                _Pragma("unroll") for (int reg = 0; reg < 16; ++reg) yp[ys * ((reg & 3) + 8 * (reg >> 2))] = acc[reg]; } \
            CS_BAR(); } while (0)
        CSB_LOAD(afA, cA0, cA1, 0); CSB_LOAD(afB, cB0, cB1, 1);
        static_assert(CS_NCH % 3 == 0, "chunk loop is unrolled by three");
        for (int ch = 0; ch < CS_NCH; ch += 3) {
            if (ch == 0) CSB_LOAD(afC, cC0, cC1, 2);
            CSB_STEP(afA, cA0, cA1, ch);     if (ch + 3 < CS_NCH) CSB_LOAD(afA, cA0, cA1, ch + 3);
            CSB_STEP(afB, cB0, cB1, ch + 1); if (ch + 4 < CS_NCH) CSB_LOAD(afB, cB0, cB1, ch + 4);
            CSB_STEP(afC, cC0, cC1, ch + 2); if (ch + 5 < CS_NCH) CSB_LOAD(afC, cC0, cC1, ch + 5);
        }
        CS_BAR();
    }
#undef CSB_LOAD
#undef CSB_STEP
}

#undef CS_BAR
__device__ __forceinline__ void phase_ef2(const Ctx& C, const Args& A, int l) {
    const int i2 = l >> 1; unsigned char* ws = A.ws;
    const unsigned char* SCN = ws + WS_SCN; const float* Y0 = (const float*)(ws + WS_Y); const float* Y1 = Y0 + (size_t)MROWS * 768;
    const bf16_t* G = (const bf16_t*)(ws + WS_G); bf16_t* A2 = (bf16_t*)(ws + WS_A2);
    const float* rb = A.in[I_RBON] + (size_t)i2 * 768; const float* gg = A.in[I_GNG] + (size_t)i2 * 768; const float* gb = A.in[I_GNB] + (size_t)i2 * 768;
    for (int row = C.gw; row < MROWS; row += C.NGW) {
#pragma unroll
        for (int it = 0; it < 3; ++it) {
            const int c = it * 256 + 4 * C.lane, head = c >> 6, kx = c & 63;
            const f32x4 y = *(const f32x4*)(Y0 + (size_t)row * 768 + c) + *(const f32x4*)(Y1 + (size_t)row * 768 + c);
            const float mean = sum16((y[0] + y[1]) + (y[2] + y[3])) * (1.f / 64.f);
            const f32x4 dd = y - mean;
            const float var = sum16((dd[0] * dd[0] + dd[1] * dd[1]) + (dd[2] * dd[2] + dd[3] * dd[3])) * (1.f / 64.f);
            const float rstd = rsqrtf(var + GN_EPS);
            const unsigned char* base = SCN + (size_t)(row * 12 + head) * SC_REC + kx * 2;
            const f32x4 r = ld4bf_(base + SC_R), v = ld4bf_(base + SC_V), k0 = ld4bf_(base + SC_KR), k1 = ld4bf_(base + SC_KR + 256);
            const f32x4 rb4 = *(const f32x4*)(rb + c);
            const f32x4 t = r * (k0 + k1) * 0.5f * rb4;
            const float bs = sum16((t[0] + t[1]) + (t[2] + t[3]));
            const f32x4 yn = dd * rstd * *(const f32x4*)(gg + c) + *(const f32x4*)(gb + c);
            const f32x4 g = ld4bf(G + (size_t)row * 768 + c);
            st4bf(A2 + (size_t)row * DM + 256 + c, g * (yn + v * bs));
        }
    }
}

__device__ __forceinline__ void phase_of1(const Ctx& C, const Args& A, int l) {
    const int i2 = l >> 1; unsigned char* ws = A.ws;
    const bf16_t* P = (const bf16_t*)(ws + WS_P); bf16_t* A2 = (bf16_t*)(ws + WS_A2); bf16_t* VT = (bf16_t*)(ws + WS_VT);
    const float* lng = A.in[I_GLNG] + (size_t)i2 * 256; const float* lnb = A.in[I_GLNB] + (size_t)i2 * 256;
    const float* gws = A.in[I_GWS] + (size_t)i2 * 4 * 128 * 128; const float* gbs = A.in[I_GBS] + (size_t)i2 * 4 * 128;
    LAS bf16_t* vt = (LAS bf16_t*)C.lds;
    LAS bf16_t* uL = (LAS bf16_t*)C.lds;
    LAS bf16_t* vT = (LAS bf16_t*)(C.lds + 128 * 528);
    const int r32 = C.lane & 31, hi = C.lane >> 5;
    for (int u = blockIdx.x; u < 264; u += C.G) {
        const bool isctx = u >= 256; const int uc = u - 256;
        const int b = isctx ? (uc >> 1) : (u >> 6), pos0 = isctx ? (uc & 1) * 128 : (u & 63) * 128;
        const int row0 = isctx ? NLAT + b * CTXL + pos0 : b * TT + pos0, L0 = isctx ? pos0 : CTXL + pos0;
        for (int hh = 0; hh < 6; ++hh) {
#pragma unroll
            for (int i = 0; i < 4; ++i) { const int piece = C.tid + NTHR * i, r = piece >> 4, part = piece & 15;
                *(LAS u32x4*)(vt + r * 136 + part * 8) = *(const u32x4*)(P + (size_t)(row0 + r) * P_LD + 1536 + hh * 128 + part * 8); }
            __syncthreads();
#pragma unroll
            for (int i = 0; i < 4; ++i) { const int item = C.tid + NTHR * i, d = item >> 4, tg = item & 15; const LAS bf16_t* s = vt + (tg * 8) * 136 + d;
                u32x4 o; o.x = (unsigned)s[0] | ((unsigned)s[136] << 16); o.y = (unsigned)s[2 * 136] | ((unsigned)s[3 * 136] << 16);
                o.z = (unsigned)s[4 * 136] | ((unsigned)s[5 * 136] << 16); o.w = (unsigned)s[6 * 136] | ((unsigned)s[7 * 136] << 16);
                *(u32x4*)(VT + ((size_t)(b * 6 + hh) * 128 + d) * LKEYS + L0 + tg * 8) = o; }
            __syncthreads();
        }
        for (int r = C.wave; r < 128; r += NWAVES) {
            const int c4 = 4 * C.lane; const bf16_t* pr = P + (size_t)(row0 + r) * P_LD + 2304;
            const f32x4 ur = ld4bf(pr + c4), raw = ld4bf(pr + 256 + c4);
            { const f32x4 gu = {gelu_erf(ur[0]), gelu_erf(ur[1]), gelu_erf(ur[2]), gelu_erf(ur[3])}; u32x2 o; o.x = pk2(gu[0], gu[1]); o.y = pk2(gu[2], gu[3]); *(LAS u32x2*)(uL + r * 264 + c4) = o; }
            const f32x4 gv = {gelu_erf(raw[0]), gelu_erf(raw[1]), gelu_erf(raw[2]), gelu_erf(raw[3])};
            const float mean = wave_sum((gv[0] + gv[1]) + (gv[2] + gv[3])) * (1.f / 256.f); const f32x4 dd = gv - mean;
            const float var = wave_sum((dd[0] * dd[0] + dd[1] * dd[1]) + (dd[2] * dd[2] + dd[3] * dd[3])) * (1.f / 256.f); const float rstd = rsqrtf(var + LN_EPS);
            const f32x4 o = dd * rstd * *(const f32x4*)(lng + c4) + *(const f32x4*)(lnb + c4);
#pragma unroll
            for (int k = 0; k < 4; ++k) vT[(c4 + k) * 136 + r] = (bf16_t)f2bf(o[k]);
        }
        __syncthreads();
        {
            const int g = C.wave >> 1, cblk = C.wave & 1, cc = g * 64 + cblk * 32 + r32;
            for (int pblk = 0; pblk < 4; ++pblk) {
                f32x16 acc;
#pragma unroll
                for (int i = 0; i < 16; ++i) acc[i] = 0.f;
                const float* wrow = gws + ((size_t)g * 128 + pblk * 32 + r32) * 128 + 8 * hi;
#pragma unroll
                for (int ks = 0; ks < 8; ++ks) { const f32x4 w0 = *(const f32x4*)(wrow + ks * 16), w1 = *(const f32x4*)(wrow + ks * 16 + 4);
                    u32x4 au; au.x = pk2(w0[0], w0[1]); au.y = pk2(w0[2], w0[3]); au.z = pk2(w1[0], w1[1]); au.w = pk2(w1[2], w1[3]);
                    const bf16x8 bf = *(const LAS bf16x8*)(vT + cc * 136 + ks * 16 + 8 * hi);
                    acc = __builtin_amdgcn_mfma_f32_32x32x16_bf16(__builtin_bit_cast(bf16x8, au), bf, acc, 0, 0, 0); }
#pragma unroll
                for (int reg = 0; reg < 16; ++reg) { const int p = pblk * 32 + crow(reg, hi);
                    const float uu = bf2f(uL[p * 264 + cc]); const float mixed = acc[reg] + gbs[g * 128 + p];
                    uL[p * 264 + cc] = (bf16_t)f2bf(uu * mixed); }
            }
        }
        __syncthreads();
#pragma unroll
        for (int i = 0; i < 8; ++i) { const int piece = C.tid + NTHR * i, r = piece >> 5, part = piece & 31;
            *(u32x4*)(A2 + (size_t)(row0 + r) * DM + 768 + part * 8) = *(const LAS u32x4*)(uL + r * 264 + part * 8); }
        __syncthreads();
    }
}

__device__ __forceinline__ void phase_attn(const Ctx& C, const Args& A, int l) {
    const int i2 = l >> 1; unsigned char* ws = A.ws;
    const bf16_t* Q = (const bf16_t*)(ws + WS_Q); const bf16_t* KA = (const bf16_t*)(ws + WS_KA); const bf16_t* VT = (const bf16_t*)(ws + WS_VT); bf16_t* A2 = (bf16_t*)(ws + WS_A2);
    const float lam_init = 0.8f - 0.6f * expf(-0.3f * (float)l);
    float s1 = 0.f, s2 = 0.f;
    for (int j = 0; j < 64; ++j) { s1 += A.in[I_LQ1][i2 * 64 + j] * A.in[I_LK1][i2 * 64 + j]; s2 += A.in[I_LQ2][i2 * 64 + j] * A.in[I_LK2][i2 * 64 + j]; }
    const float lam = expf(s1) - expf(s2) + lam_init;
    const float* subg = A.in[I_SUBG] + (size_t)i2 * 128;
    const int r32 = C.lane & 31, hi = C.lane >> 5, map = C.wave >> 2, qw = C.wave & 3;
    LAS unsigned char* Kt = C.lds; LAS unsigned char* Vt = C.lds + 2 * 17408; LAS float* xch = (LAS float*)C.lds;
    const int NU = 1536 + (l == 1 ? 48 : 0);
    for (int n = C.vcu; n < NU; n += C.G) {
        int bh, qt; bool isctx = false;
        if (n < 1536) { const int round = n >> 8, slot = n & 255; bh = (slot >> 5) * 3 + (round >> 1); qt = (round & 1) * 32 + (slot & 31); }
        else { isctx = true; bh = (n - 1536) >> 1; qt = (n - 1536) & 1; }
        const int b = bh / 6, h = bh % 6;
        const int qrow0 = isctx ? NLAT + b * CTXL + qt * 128 : b * TT + qt * 128;
        const int NT = isctx ? CTXL / 64 : LKEYS / 64;
        const bf16_t* Kb = KA + (size_t)b * LKEYS * 768 + h * 128;
        const bf16_t* Vb = VT + (size_t)(b * 6 + h) * 128 * LKEYS;
        bf16x8 qf[4];
        { const bf16_t* qp = Q + (size_t)(qrow0 + qw * 32 + r32) * 768 + h * 128 + map * 64 + 8 * hi;
#pragma unroll
          for (int ks = 0; ks < 4; ++ks) qf[ks] = *(const bf16x8*)(qp + ks * 16); }
        f32x16 O[4];
#pragma unroll
        for (int d = 0; d < 4; ++d)
#pragma unroll
            for (int i = 0; i < 16; ++i) O[d][i] = 0.f;
        float m = -1e30f, lsum = 0.f;
        u32x4 kreg[2], vreg[2];
#define AT_LOAD(t) do { _Pragma("unroll") for (int i = 0; i < 2; ++i) { const int piece = C.tid + NTHR * i; \
            kreg[i] = *(const u32x4*)(Kb + (size_t)((t) * 64 + (piece >> 4)) * 768 + (piece & 15) * 8); \
            vreg[i] = *(const u32x4*)(Vb + (size_t)(piece >> 3) * LKEYS + (t) * 64 + (piece & 7) * 8); } } while (0)
#define AT_STORE(bi) do { _Pragma("unroll") for (int i = 0; i < 2; ++i) { const int piece = C.tid + NTHR * i; \
            *(LAS u32x4*)(Kt + (bi) * 17408 + (piece >> 4) * 272 + (piece & 15) * 16) = kreg[i]; \
            LAS unsigned char* vd = Vt + (bi) * 17408 + (piece >> 3) * 136 + (piece & 7) * 16; \
            *(LAS u32x2*)vd = (u32x2){vreg[i].x, vreg[i].y}; *(LAS u32x2*)(vd + 8) = (u32x2){vreg[i].z, vreg[i].w}; } } while (0)
        AT_LOAD(0); AT_STORE(0); __syncthreads();
        for (int t = 0; t < NT; ++t) {
            if (t + 1 < NT) AT_LOAD(t + 1);
            const int bi = t & 1;
            const LAS unsigned char* kb = Kt + bi * 17408 + r32 * 272 + map * 128 + hi * 16;
            const LAS unsigned char* vb = Vt + bi * 17408 + r32 * 136 + hi * 8;
            bf16x8 kf[8];
#pragma unroll
            for (int ks = 0; ks < 4; ++ks) { kf[2 * ks] = *(const LAS bf16x8*)(kb + ks * 32); kf[2 * ks + 1] = *(const LAS bf16x8*)(kb + 32 * 272 + ks * 32); }
            u32x4 va[4], vc[4];
#define AT_LDV(dst, d) do { _Pragma("unroll") for (int kst = 0; kst < 4; ++kst) { const LAS unsigned char* vp = vb + (d) * (32 * 136) + kst * 32; \
                const u32x2 lo = *(const LAS u32x2*)vp, hh = *(const LAS u32x2*)(vp + 16); dst[kst] = (u32x4){lo.x, lo.y, hh.x, hh.y}; } } while (0)
#define AT_PV(src, d) do { _Pragma("unroll") for (int kst = 0; kst < 4; ++kst) O[d] = __builtin_amdgcn_mfma_f32_32x32x16_bf16(__builtin_bit_cast(bf16x8, src[kst]), pb[kst], O[d], 0, 0, 0); } while (0)
            AT_LDV(va, 0);
            __builtin_amdgcn_sched_barrier(0);
            f32x16 p0, p1;
#pragma unroll
            for (int i = 0; i < 16; ++i) { p0[i] = 0.f; p1[i] = 0.f; }
#pragma unroll
            for (int ks = 0; ks < 4; ++ks) { p0 = __builtin_amdgcn_mfma_f32_32x32x16_bf16(kf[2 * ks], qf[ks], p0, 0, 0, 0); p1 = __builtin_amdgcn_mfma_f32_32x32x16_bf16(kf[2 * ks + 1], qf[ks], p1, 0, 0, 0); }
            asm volatile("s_nop 15\n\ts_nop 7" : "+v"(p0), "+v"(p1));
            float mx = max3f(p0[0], p0[1], p1[0]), mx2 = max3f(p0[2], p0[3], p1[1]); mx = max3f(mx, p1[2], p1[3]);
#pragma unroll
            for (int i = 4; i < 16; i += 4) { mx = max3f(mx, p0[i], p0[i + 1]); mx2 = max3f(mx2, p0[i + 2], p0[i + 3]); mx = max3f(mx, p1[i], p1[i + 1]); mx2 = max3f(mx2, p1[i + 2], p1[i + 3]); }
            mx = max3f(mx, mx2, m);
            { auto rr = __builtin_amdgcn_permlane32_swap(__float_as_uint(mx), __float_as_uint(mx), false, false); mx = fmaxf(__uint_as_float(rr[0]), __uint_as_float(rr[1])); }
            const float mnew = mx;
            if (__any(mnew > m)) { const float sc = __builtin_amdgcn_exp2f(m - mnew); lsum *= sc;
#pragma unroll
                for (int d = 0; d < 4; ++d)
#pragma unroll
                    for (int i = 0; i < 16; ++i) O[d][i] *= sc;
                m = mnew; }
            float ps = 0.f, ps2 = 0.f;
#pragma unroll
            for (int i = 0; i < 16; ++i) { p0[i] = __builtin_amdgcn_exp2f(p0[i] - m); p1[i] = __builtin_amdgcn_exp2f(p1[i] - m); ps += p0[i]; ps2 += p1[i]; }
            lsum += ps + ps2;
            bf16x8 pb[4];
            { u32x4 w; w.x = pk2(p0[0], p0[1]); w.y = pk2(p0[2], p0[3]); w.z = pk2(p0[4], p0[5]); w.w = pk2(p0[6], p0[7]); pb[0] = __builtin_bit_cast(bf16x8, w);
              w.x = pk2(p0[8], p0[9]); w.y = pk2(p0[10], p0[11]); w.z = pk2(p0[12], p0[13]); w.w = pk2(p0[14], p0[15]); pb[1] = __builtin_bit_cast(bf16x8, w);
              w.x = pk2(p1[0], p1[1]); w.y = pk2(p1[2], p1[3]); w.z = pk2(p1[4], p1[5]); w.w = pk2(p1[6], p1[7]); pb[2] = __builtin_bit_cast(bf16x8, w);
              w.x = pk2(p1[8], p1[9]); w.y = pk2(p1[10], p1[11]); w.z = pk2(p1[12], p1[13]); w.w = pk2(p1[14], p1[15]); pb[3] = __builtin_bit_cast(bf16x8, w); }
            __builtin_amdgcn_sched_barrier(0);
            AT_LDV(vc, 1); __builtin_amdgcn_sched_barrier(0); AT_PV(va, 0); __builtin_amdgcn_sched_barrier(0);
            AT_LDV(va, 2); __builtin_amdgcn_sched_barrier(0); AT_PV(vc, 1); __builtin_amdgcn_sched_barrier(0);
            AT_LDV(vc, 3); __builtin_amdgcn_sched_barrier(0); AT_PV(va, 2); __builtin_amdgcn_sched_barrier(0);
            AT_PV(vc, 3);
            if (t + 1 < NT) AT_STORE((t + 1) & 1);
            __syncthreads();
        }
#undef AT_LDV
#undef AT_PV
#undef AT_LOAD
#undef AT_STORE
        const float ltot = lsum + __shfl_xor(lsum, 32);
        const float invl = 1.f / ltot;
        if (map == 1) { const float f = lam * invl;
#pragma unroll
            for (int d = 0; d < 4; ++d)
#pragma unroll
                for (int i = 0; i < 16; ++i) xch[(qw * 64 + d * 16 + i) * 64 + C.lane] = O[d][i] * f; }
        __syncthreads();
        if (map == 0) { float ss = 0.f;
#pragma unroll
            for (int d = 0; d < 4; ++d)
#pragma unroll
                for (int i = 0; i < 16; ++i) { const float o = O[d][i] * invl - xch[(qw * 64 + d * 16 + i) * 64 + C.lane]; O[d][i] = o; ss += o * o; }
            ss += __shfl_xor(ss, 32);
            const float rn = rsqrtf(ss * (1.f / 128.f) + RMS_EPS) * (1.f - lam_init);
            bf16_t* orow = A2 + (size_t)(qrow0 + qw * 32 + r32) * DM + h * 128;
#pragma unroll
            for (int d = 0; d < 4; ++d)
#pragma unroll
                for (int g4 = 0; g4 < 4; ++g4) { const int dd = 32 * d + 8 * g4 + 4 * hi; const f32x4 sg = *(const f32x4*)(subg + dd);
                    const f32x4 v = {O[d][4 * g4] * rn * sg[0], O[d][4 * g4 + 1] * rn * sg[1], O[d][4 * g4 + 2] * rn * sg[2], O[d][4 * g4 + 3] * rn * sg[3]};
                    st4bf(orow + dd, v); } }
        __syncthreads();
    }
}

__device__ __forceinline__ void phase_rt(const Ctx& C, const Args& A, int l) {
    unsigned char* ws = A.ws; float* X = (float*)(ws + WS_X); bf16_t* H = (bf16_t*)(ws + WS_H); float* AFF = (float*)(ws + WS_AFF);
    const float* MOD = (const float*)(ws + WS_MOD) + (size_t)l * 5 * 6144;
    const float* lng = A.in[I_LNG] + (size_t)(l * 2 + 0) * DM; const float* lnb = A.in[I_LNB] + (size_t)(l * 2 + 0) * DM;
    LAS float* wrs = (LAS float*)C.lds;
    { const float* wr = A.in[I_WR] + (size_t)l * DM * 16; for (int i = C.tid; i < DM * 16; i += NTHR) wrs[(i & 15) * 1024 + (i >> 4)] = wr[i]; }
    __syncthreads();
    for (int row = C.gw; row < MROWS; row += C.NGW) {
        const float* md = MOD + row_mi(row) * 6144;
        f32x4 x[4]; float s = 0.f;
#pragma unroll
        for (int j = 0; j < 4; ++j) { x[j] = *(const f32x4*)(X + (size_t)row * DM + 4 * C.lane + 256 * j); s += (x[j][0] + x[j][1]) + (x[j][2] + x[j][3]); }
        const float mean = wave_sum(s) * (1.f / DM); float s2 = 0.f;
#pragma unroll
        for (int j = 0; j < 4; ++j) { x[j] = x[j] - mean; s2 += (x[j][0] * x[j][0] + x[j][1] * x[j][1]) + (x[j][2] * x[j][2] + x[j][3] * x[j][3]); }
        const float rstd = rsqrtf(wave_sum(s2) * (1.f / DM) + LN_EPS);
        float v[16];
#pragma unroll
        for (int e = 0; e < 16; ++e) v[e] = 0.f;
#pragma unroll
        for (int j = 0; j < 4; ++j) { const int col = 4 * C.lane + 256 * j;
            const f32x4 x1 = x[j] * rstd * *(const f32x4*)(lng + col) + *(const f32x4*)(lnb + col);
            *(f32x4*)(X + (size_t)row * DM + col) = x1;
            const f32x4 h = x1 * (*(const f32x4*)(md + 4 * DM + col) + 1.f) + *(const f32x4*)(md + 3 * DM + col);
            st4bf(H + (size_t)row * DM + col, h);
#pragma unroll
            for (int e = 0; e < 16; ++e) { const f32x4 w = *(const LAS f32x4*)(wrs + e * 1024 + col); v[e] += (h[0] * w[0] + h[1] * w[1]) + (h[2] * w[2] + h[3] * w[3]); }
            __builtin_amdgcn_sched_barrier(0); }
#pragma unroll
        for (int i = 0; i < 8; ++i) { const float send = (C.lane & 32) ? v[i] : v[i + 8], keep = (C.lane & 32) ? v[i + 8] : v[i]; v[i] = keep + __shfl_xor(send, 32); }
#pragma unroll
        for (int i = 0; i < 4; ++i) { const float send = (C.lane & 16) ? v[i] : v[i + 4], keep = (C.lane & 16) ? v[i + 4] : v[i]; v[i] = keep + __shfl_xor(send, 16); }
#pragma unroll
        for (int i = 0; i < 2; ++i) { const float send = (C.lane & 8) ? v[i] : v[i + 2], keep = (C.lane & 8) ? v[i + 2] : v[i]; v[i] = keep + __shfl_xor(send, 8); }
        { const float send = (C.lane & 4) ? v[0] : v[1], keep = (C.lane & 4) ? v[1] : v[0]; v[0] = keep + __shfl_xor(send, 4); }
        float z = v[0]; z += __shfl_xor(z, 1); z += __shfl_xor(z, 2);
        float mx = z;
#pragma unroll
        for (int o = 4; o < 64; o <<= 1) mx = fmaxf(mx, __shfl_xor(mx, o));
        const float ex = expf(z - mx); float sm = ex;
#pragma unroll
        for (int o = 4; o < 64; o <<= 1) sm += __shfl_xor(sm, o);
        if ((C.lane & 3) == 0) AFF[(size_t)row * 16 + (C.lane >> 2)] = ex / sm;
    }
}

__device__ __forceinline__ void phase_tk(const Ctx& C, const Args& A) {
    unsigned char* ws = A.ws; const float* AFF = (const float*)(ws + WS_AFF); int* SLOT = (int*)(ws + WS_SLOT); int* IDX = (int*)(ws + WS_IDX); float* GATE = (float*)(ws + WS_GATE);
    LAS unsigned* key = (LAS unsigned*)C.lds;
    LAS unsigned* hist = key + 8192;
    LAS unsigned* scn = hist + 256;
    LAS unsigned* wtot = scn + 256;
    LAS unsigned* bc = wtot + 8;
    for (int u = blockIdx.x; u < 128; u += C.G) {
        const bool isctx = u >= 64; const int uu = u & 63, b = uu >> 4, e = uu & 15;
        const int n = isctx ? CTXL : TT, cap = isctx ? CAP_C : CAP_L;
        const int row0 = isctx ? NLAT + b * CTXL : b * TT;
        const int slot0 = e * ESLOTS + (isctx ? 4 * CAP_L + b * CAP_C : b * CAP_L);
        for (int i = C.tid; i < n; i += NTHR) key[i] = __float_as_uint(AFF[(size_t)(row0 + i) * 16 + e]);
        unsigned prefix = 0u, pmask = 0u; int need = cap;
        for (int pass = 0; pass < 4; ++pass) {
            const int shift = 24 - 8 * pass;
            if (C.tid < 256) hist[C.tid] = 0u;
            __syncthreads();
            for (int i = C.tid; i < n; i += NTHR) { const unsigned k = key[i]; if ((k & pmask) == prefix) __hip_atomic_fetch_add(&hist[(k >> shift) & 255u], 1u, __ATOMIC_RELAXED, __HIP_MEMORY_SCOPE_WORKGROUP); }
            __syncthreads();
            if (C.tid < 256) scn[C.tid] = hist[C.tid];
            __syncthreads();
            for (int off = 1; off < 256; off <<= 1) {
                unsigned a = 0u; if (C.tid < 256 && C.tid + off < 256) a = scn[C.tid + off];
                __syncthreads();
                if (C.tid < 256) scn[C.tid] += a;
                __syncthreads();
            }
            if (C.tid < 256) { const unsigned above = (C.tid < 255) ? scn[C.tid + 1] : 0u;
                if (scn[C.tid] >= (unsigned)need && above < (unsigned)need) { bc[0] = (unsigned)C.tid; bc[1] = (unsigned)need - above; } }
            __syncthreads();
            prefix |= bc[0] << shift; pmask |= 255u << shift; need = (int)bc[1];
            __syncthreads();
        }
        const int per = (n + NTHR - 1) / NTHR; const int i0 = C.tid * per;
        unsigned cg = 0u, ce = 0u;
        for (int j = 0; j < per; ++j) { const int i = i0 + j; if (i < n) { const unsigned k = key[i]; cg += (k > prefix); ce += (k == prefix); } }
        unsigned pk = cg | (ce << 16), inc = pk;
#pragma unroll
        for (int o = 1; o < 64; o <<= 1) { const unsigned t = __shfl_up(inc, o); if (C.lane >= o) inc += t; }
        if (C.lane == 63) wtot[C.wave] = inc;
        __syncthreads();
        unsigned wbase = 0u;
        for (int w = 0; w < C.wave; ++w) wbase += wtot[w];
        const unsigned excl = wbase + inc - pk;
        unsigned rg = excl & 0xffffu, re = excl >> 16;
        const int ngt = cap - need;
        for (int j = 0; j < per; ++j) { const int i = i0 + j; if (i < n) { const unsigned k = key[i]; int pos = -1;
            if (k > prefix) { pos = (int)rg; ++rg; } else if (k == prefix) { if ((int)re < need) pos = ngt + (int)re; ++re; }
            const int row = row0 + i;
            if (pos >= 0) { IDX[slot0 + pos] = row; GATE[slot0 + pos] = __uint_as_float(k); SLOT[(size_t)row * 16 + e] = slot0 + pos; }
            else SLOT[(size_t)row * 16 + e] = -1; } }
        if (isctx && b == 0 && C.tid < ESLOTS - 4224) { IDX[e * ESLOTS + 4224 + C.tid] = 0; GATE[e * ESLOTS + 4224 + C.tid] = 0.f; }
        __syncthreads();
    }
}

__device__ __forceinline__ void phase_cb(const Ctx& C, const Args& A, int l) {
    unsigned char* ws = A.ws; float* X = (float*)(ws + WS_X); bf16_t* H = (bf16_t*)(ws + WS_H); const int* SLOT = (const int*)(ws + WS_SLOT); const bf16_t* YE = (const bf16_t*)(ws + WS_YE);
    const float* MOD = (const float*)(ws + WS_MOD) + (size_t)l * 5 * 6144; const float* MODN = MOD + 5 * 6144;
    const float* lng = A.in[I_LNG] + (size_t)(l * 2 + 1) * DM; const float* lnb = A.in[I_LNB] + (size_t)(l * 2 + 1) * DM;
    for (int row = C.gw; row < MROWS; row += C.NGW) {
        const int mi = row_mi(row); const float* md = MOD + mi * 6144;
        f32x4 acc[4];
#pragma unroll
        for (int j = 0; j < 4; ++j) acc[j] = (f32x4){0.f, 0.f, 0.f, 0.f};
        for (int e = 0; e < 16; ++e) { const int s = __builtin_amdgcn_readfirstlane(SLOT[(size_t)row * 16 + e]);
            if (s >= 0) {
#pragma unroll
                for (int j = 0; j < 4; ++j) acc[j] += ld4bf(YE + (size_t)s * DM + 4 * C.lane + 256 * j); } }
        f32x4 x[4]; float sm = 0.f;
#pragma unroll
        for (int j = 0; j < 4; ++j) { const int col = 4 * C.lane + 256 * j; x[j] = *(const f32x4*)(X + (size_t)row * DM + col) * ALPHA_DN + *(const f32x4*)(md + 5 * DM + col) * acc[j];
            sm += (x[j][0] + x[j][1]) + (x[j][2] + x[j][3]); }
        const float mean = wave_sum(sm) * (1.f / DM); float s2 = 0.f;
#pragma unroll
        for (int j = 0; j < 4; ++j) { x[j] = x[j] - mean; s2 += (x[j][0] * x[j][0] + x[j][1] * x[j][1]) + (x[j][2] * x[j][2] + x[j][3] * x[j][3]); }
        const float rstd = rsqrtf(wave_sum(s2) * (1.f / DM) + LN_EPS);
#pragma unroll
        for (int j = 0; j < 4; ++j) { const int col = 4 * C.lane + 256 * j;
            const f32x4 x2 = x[j] * rstd * *(const f32x4*)(lng + col) + *(const f32x4*)(lnb + col);
            *(f32x4*)(X + (size_t)row * DM + col) = x2;
            if (l < DEPTH - 1) { const float* mn = MODN + mi * 6144; st4bf(H + (size_t)row * DM + col, x2 * (*(const f32x4*)(mn + DM + col) + 1.f) + *(const f32x4*)(mn + col)); }
            else if (row < NLAT) *(f32x4*)(A.out + (size_t)row * DM + col) = x2; }
    }
}


#ifndef GEMM_NOINLINE
#define GEMM_NOINLINE 0
#endif
#if GEMM_NOINLINE
#define GEMM_FN __device__ __noinline__
#else
#define GEMM_FN __device__ __forceinline__
#endif
GEMM_FN void gphase_in(LAS unsigned char* lds, unsigned char* ws, int nN, int G) {
    pg8::Gemm g{(const bf16_t*)(ws + WS_H), (const bf16_t*)(ws + WS_WIN), DM}; pg8::Order<0> S; S.init(MROWS / 256, nN, G, (int)blockIdx.x, nullptr, 0);
    pg8::EpiBf16 E{(bf16_t*)(ws + WS_P), P_LD}; pg8::gemm_phase(lds, g, S, E); }
GEMM_FN void gphase_in_odd(LAS unsigned char* lds, unsigned char* ws, int G) {
    pg8::Gemm g{(const bf16_t*)(ws + WS_H), (const bf16_t*)(ws + WS_WIN), DM}; pg8::Order<0> S; S.init(MROWS / 256, D_IN_ODD / 256, G, (int)blockIdx.x, nullptr, 0);
    pg8::EpiOdd E{(bf16_t*)(ws + WS_P), (bf16_t*)(ws + WS_Q), (bf16_t*)(ws + WS_KA), (const float*)(ws + WS_ROPE)}; pg8::gemm_phase(lds, g, S, E); }
GEMM_FN void gphase_lora(LAS unsigned char* lds, unsigned char* ws, const float* d0, const float* a0, const float* kal, int G) {
    pg8::Gemm g{(const bf16_t*)(ws + WS_LIN), (const bf16_t*)(ws + WS_WLORA), LORA_K}; pg8::Order<0> S; S.init(MROWS / 256, LORA_N / 256, G, (int)blockIdx.x, nullptr, 0);
    pg8::EpiLora E{ws + WS_SCN, (bf16_t*)(ws + WS_G), d0, a0, kal}; pg8::gemm_phase(lds, g, S, E); }
GEMM_FN void gphase_out(LAS unsigned char* lds, unsigned char* ws, const float* modl, int G) {
    pg8::Gemm g{(const bf16_t*)(ws + WS_A2), (const bf16_t*)(ws + WS_WOUT), DM}; pg8::Order<0> S; S.init(MROWS / 256, DM / 256, G, (int)blockIdx.x, nullptr, 0);
    pg8::EpiRes E{(float*)(ws + WS_X), modl}; pg8::gemm_phase(lds, g, S, E); }
GEMM_FN void gphase_e1(LAS unsigned char* lds, unsigned char* ws, int G) {
    pg8::Gemm g{(const bf16_t*)(ws + WS_H), (const bf16_t*)(ws + WS_WE13), DM}; pg8::Order<1> S; S.init(NEXP * 17, 4096 / 256, G, (int)blockIdx.x, (const int*)(ws + WS_IDX), (long)4096 * DM);
    pg8::EpiSwiGLU E{(bf16_t*)(ws + WS_HID)}; pg8::gemm_phase(lds, g, S, E); }
GEMM_FN void gphase_e2(LAS unsigned char* lds, unsigned char* ws, int G) {
    pg8::Gemm g{(const bf16_t*)(ws + WS_HID), (const bf16_t*)(ws + WS_WE2), D_EXP}; pg8::Order<2> S; S.init(NEXP * 17, DM / 256, G, (int)blockIdx.x, nullptr, (long)DM * D_EXP);
    pg8::EpiYE E{(bf16_t*)(ws + WS_YE), (const float*)(ws + WS_GATE)}; pg8::gemm_phase(lds, g, S, E); }

constexpr int NSLOT = 13;
constexpr int NSTEP = 1 + DEPTH * NSLOT;
__global__ void __launch_bounds__(NTHR, 2) mk_fwd(Args KA) {
    extern __shared__ __attribute__((aligned(16))) unsigned char lds_raw[];
    volatile LAS unsigned* MISC = (volatile LAS unsigned*)((LAS unsigned char*)lds_raw + LDS_MISC);
    if (threadIdx.x < 16) MISC[threadIdx.x] = 0u;
    if (threadIdx.x == 0) { LAS unsigned long long* tb = (LAS unsigned long long*)((LAS unsigned char*)lds_raw + LDS_PTAB);
#pragma unroll
        for (int i = 0; i < 37; ++i) tb[i] = (unsigned long long)KA.in[i];
        tb[37] = (unsigned long long)KA.out; tb[38] = (unsigned long long)KA.ws; }
    __syncthreads();
    const int lo = KA.lo, hi = KA.hi;
    unsigned bar_x = 0;
    if (hi - lo > 1) { const XcdBarrier b0 = xcd_barrier_post((unsigned*)(KA.ws + WS_CTL), MISC); bar_x = b0.x; }
#ifndef PH_MASK
#define PH_MASK 0xFFFFFF
#endif
#ifndef REP_MASK
#define REP_MASK 0
#endif
#define PH_BIT(k) (((k) == 0) ? 0 : 1 + ((k) - 1) % NSLOT + (((k) - 1) % NSLOT >= 2 && ((k) - 1) % NSLOT <= 3 && odd ? 12 : 0))
#define RUN(k, ...) do { if (((PH_MASK >> PH_BIT(k)) & 1) && lo <= (k) && (k) < hi) { const int nrep = ((REP_MASK >> PH_BIT(k)) & 1) ? 2 : 1; \
        _Pragma("unroll 1") for (int rep = 0; rep < nrep; ++rep) { \
        Ctx C; mkctx(C, (LAS unsigned char*)lds_raw); Args A; ldargs(A, (LAS unsigned char*)lds_raw); unsigned char* ws = A.ws; \
        const float* MODL = (const float*)(ws + WS_MOD) + (size_t)l * 5 * 6144; (void)MODL; \
        __VA_ARGS__; if ((k) + 1 < hi || rep + 1 < nrep) { XcdBarrier bar; bar.bar = (unsigned*)(ws + WS_CTL); bar.x = bar_x; bar.st = MISC; xcd_barrier(bar); } } } } while (0)
    { const bool odd = false; const int l = 0; RUN(0, phase_init(C, A)); }
#pragma unroll 1
    for (int l = 0; l < DEPTH; ++l) {
        const int sb = 1 + l * NSLOT; const bool odd = l & 1;
        RUN(sb + 0, { phase_conv(C, A, l); if (l == 0) phase_modh(C, A, 0); });
        if (odd) { RUN(sb + 1, gphase_in_odd(C.lds, ws, C.G)); } else { RUN(sb + 1, gphase_in(C.lds, ws, D_IN_EVEN_PAD / 256, C.G)); }
        if (!odd) {
            RUN(sb + 2, phase_ef1(C, A, l));
            RUN(sb + 3, { const int i2 = l >> 1; gphase_lora(C.lds, ws, A.in[I_D0] + (size_t)i2 * 2 * 768, A.in[I_A0] + (size_t)i2 * 2 * 768, A.in[I_KAL] + (size_t)i2 * 768, C.G); });
#if CHUNKED_SCAN
            RUN(sb + 4, phase_csa(C, A));
            RUN(sb + 5, phase_csb(C, A));
#else
            RUN(sb + 4, phase_scan(C, A));
#endif
            RUN(sb + 6, phase_ef2(C, A, l));
        } else {
            RUN(sb + 2, phase_of1(C, A, l));
            RUN(sb + 3, phase_attn(C, A, l));
        }
        RUN(sb + 7, gphase_out(C.lds, ws, MODL, C.G));
        RUN(sb + 8, phase_rt(C, A, l));
        RUN(sb + 9, phase_tk(C, A));
        RUN(sb + 10, gphase_e1(C.lds, ws, C.G));
        RUN(sb + 11, gphase_e2(C.lds, ws, C.G));
        RUN(sb + 12, phase_cb(C, A, l));
    }
#undef RUN
}

#ifdef PHASE_PROBE
#define PROBE_PRE extern __shared__ __attribute__((aligned(16))) unsigned char lds_raw[]; Ctx C; mkctx(C, (LAS unsigned char*)lds_raw); unsigned char* ws = A.ws; (void)ws;
__global__ void __launch_bounds__(NTHR, 2) pr_init(Args A) { PROBE_PRE phase_init(C, A); }
__global__ void __launch_bounds__(NTHR, 2) pr_conv(Args A) { PROBE_PRE phase_conv(C, A, A.lo); }
__global__ void __launch_bounds__(NTHR, 2) pr_modh(Args A) { PROBE_PRE phase_modh(C, A, A.lo); }
__global__ void __launch_bounds__(NTHR, 2) pr_ef1(Args A) { PROBE_PRE phase_ef1(C, A, A.lo); }
__global__ void __launch_bounds__(NTHR, 2) pr_scan(Args A) { PROBE_PRE phase_scan(C, A); }
__global__ void __launch_bounds__(NTHR, 2) pr_ef2(Args A) { PROBE_PRE phase_ef2(C, A, A.lo); }
__global__ void __launch_bounds__(NTHR, 2) pr_csa(Args A) { PROBE_PRE phase_csa(C, A); }
__global__ void __launch_bounds__(NTHR, 2) pr_csb(Args A) { PROBE_PRE phase_csb(C, A); }
__global__ void __launch_bounds__(NTHR, 2) pr_of1(Args A) { PROBE_PRE phase_of1(C, A, A.lo); }
__global__ void __launch_bounds__(NTHR, 2) pr_attn(Args A) { PROBE_PRE phase_attn(C, A, A.lo); }
__global__ void __launch_bounds__(NTHR, 2) pr_rt(Args A) { PROBE_PRE phase_rt(C, A, A.lo); }
__global__ void __launch_bounds__(NTHR, 2) pr_tk(Args A) { PROBE_PRE phase_tk(C, A); }
__global__ void __launch_bounds__(NTHR, 2) pr_cb(Args A) { PROBE_PRE phase_cb(C, A, A.lo); }
__global__ void __launch_bounds__(NTHR, 2) pr_gemm_in(Args A) { PROBE_PRE pg8::Gemm g{(const bf16_t*)(ws + WS_H), (const bf16_t*)(ws + WS_WIN), DM}; pg8::Order<0> S; S.init(MROWS / 256, A.lo, C.G, (int)blockIdx.x, nullptr, 0);
                      pg8::EpiBf16 E{(bf16_t*)(ws + WS_P), P_LD}; pg8::gemm_phase(C.lds, g, S, E); }
__global__ void __launch_bounds__(NTHR, 2) pr_gemm_lora(Args A) { PROBE_PRE pg8::Gemm g{(const bf16_t*)(ws + WS_LIN), (const bf16_t*)(ws + WS_WLORA), LORA_K}; pg8::Order<0> S; S.init(MROWS / 256, LORA_N / 256, C.G, (int)blockIdx.x, nullptr, 0);
                          const int i2 = A.lo; pg8::EpiLora E{ws + WS_SCN, (bf16_t*)(ws + WS_G), A.in[I_D0] + (size_t)i2 * 2 * 768, A.in[I_A0] + (size_t)i2 * 2 * 768, A.in[I_KAL] + (size_t)i2 * 768};
                          pg8::gemm_phase(C.lds, g, S, E); }
__global__ void __launch_bounds__(NTHR, 2) pr_gemm_out(Args A) { PROBE_PRE pg8::Gemm g{(const bf16_t*)(ws + WS_A2), (const bf16_t*)(ws + WS_WOUT), DM}; pg8::Order<0> S; S.init(MROWS / 256, DM / 256, C.G, (int)blockIdx.x, nullptr, 0);
                      pg8::EpiRes E{(float*)(ws + WS_X), (const float*)(ws + WS_MOD)}; pg8::gemm_phase(C.lds, g, S, E); }
__global__ void __launch_bounds__(NTHR, 2) pr_gemm_e1(Args A) { PROBE_PRE pg8::Gemm g{(const bf16_t*)(ws + WS_H), (const bf16_t*)(ws + WS_WE13), DM}; pg8::Order<1> S; S.init(NEXP * 17, 4096 / 256, C.G, (int)blockIdx.x, (const int*)(ws + WS_IDX), (long)4096 * DM);
                      pg8::EpiSwiGLU E{(bf16_t*)(ws + WS_HID)}; pg8::gemm_phase(C.lds, g, S, E); }
__global__ void __launch_bounds__(NTHR, 2) pr_gemm_e2(Args A) { PROBE_PRE pg8::Gemm g{(const bf16_t*)(ws + WS_HID), (const bf16_t*)(ws + WS_WE2), D_EXP}; pg8::Order<2> S; S.init(NEXP * 17, DM / 256, C.G, (int)blockIdx.x, nullptr, (long)DM * D_EXP);
                       pg8::EpiYE E{(bf16_t*)(ws + WS_YE), (const float*)(ws + WS_GATE)}; pg8::gemm_phase(C.lds, g, S, E); }
#endif

extern "C" void kernel_launch(void* const* d_in, const int* in_sizes, int n_in, void* d_out, int out_size, void* d_ws, size_t ws_size, hipStream_t stream) {
    static int grid = 0;
    if (grid == 0) {
        if (n_in != 37 || out_size != NLAT * DM || ws_size < WS_END) { fprintf(stderr, "kernel_launch: unexpected shapes: n_in %d out %d ws %zu (need %zu)\n", n_in, out_size, ws_size, (size_t)WS_END); grid = -1; return; }
        int dev = 0, cus = 0, per_cu = 0;
        if (hipGetDevice(&dev) != hipSuccess || hipDeviceGetAttribute(&cus, hipDeviceAttributeMultiprocessorCount, dev) != hipSuccess) { grid = -1; return; }
        if (hipFuncSetAttribute((const void*)mk_fwd, hipFuncAttributeMaxDynamicSharedMemorySize, LDS_BYTES) != hipSuccess) { fprintf(stderr, "kernel_launch: hipFuncSetAttribute failed\n"); grid = -1; return; }
        if (hipOccupancyMaxActiveBlocksPerMultiprocessor(&per_cu, (const void*)mk_fwd, NTHR, LDS_BYTES) != hipSuccess || per_cu < 1) fprintf(stderr, "kernel_launch: occupancy query reports %d\n", per_cu);
        (void)hipGetLastError();
        grid = cus;
    }
    if (grid < 0) return;
    (void)hipMemsetAsync((char*)d_ws + WS_CTL, 0, CTL_BYTES, stream);
    Args a{};
    for (int i = 0; i < 37; ++i) a.in[i] = (const float*)d_in[i];
    a.out = (float*)d_out; a.ws = (unsigned char*)d_ws;
#if MK_MULTI
    for (int k = 0; k < NSTEP; ++k) {
        if (k >= 1) { const int l = (k - 1) / NSLOT, s = (k - 1) % NSLOT; if ((l & 1) && (s >= 4 && s <= 6)) continue; if (!(l & 1) && !CHUNKED_SCAN && s == 5) continue; }
        a.lo = k; a.hi = k + 1;
        hipLaunchKernelGGL(mk_fwd, dim3(grid), dim3(NTHR), LDS_BYTES, stream, a);
    }
#else
    a.lo = 0; a.hi = NSTEP;
    hipLaunchKernelGGL(mk_fwd, dim3(grid), dim3(NTHR), LDS_BYTES, stream, a);
#endif
    const hipError_t le = hipPeekAtLastError();
    if (le != hipSuccess) fprintf(stderr, "kernel_launch: launch failed: %s\n", hipGetErrorName(le));
}
```

```cpp
#include <hip/hip_runtime.h>
#include <cstdio>
#include <cstdint>
#include <cmath>

#ifndef MK_MULTI
#define MK_MULTI 0
#endif
#ifndef CHUNKED_SCAN
#define CHUNKED_SCAN 1
#endif

#define GAS __attribute__((address_space(1)))
#define LAS __attribute__((address_space(3)))
typedef unsigned short bf16_t;
typedef short bf16x8 __attribute__((ext_vector_type(8)));
typedef float f32x4 __attribute__((ext_vector_type(4)));
typedef float f32x2 __attribute__((ext_vector_type(2)));
typedef float f32x16 __attribute__((ext_vector_type(16)));
typedef unsigned u32x4 __attribute__((ext_vector_type(4)));
typedef unsigned u32x2 __attribute__((ext_vector_type(2)));
typedef __bf16 bf16x2_t __attribute__((ext_vector_type(2)));

constexpr int NB = 4, TT = 8192, DM = 1024, NLAT = NB * TT, CTXL = 256, NCTX = NB * CTXL, MROWS = NLAT + NCTX;
constexpr int DEPTH = 4;
constexpr int D_CONV = 256, RW_H = 12, RW_K = 64, D_RWKV = 768, RWKV_COLS = 2688, D_IN_EVEN = 3456, D_IN_EVEN_PAD = 3584;
constexpr int D_DIFF = 768, D_GMLP = 256, D_IN_ODD = 2816;
constexpr int NEXP = 16, D_EXP = 2048, CAP_L = 1024, CAP_C = 32, ESLOTS = 4352;
constexpr int P_LD = 3584;
constexpr int LORA_K = 384, LORA_N = 3840;
constexpr int LKEYS = CTXL + TT;
constexpr float ALPHA_DN = 1.6817928305074290f;
constexpr float DECAY_SCALE = 0.6065306597126334f;
constexpr float GN_EPS = 64e-5f, LN_EPS = 1e-5f, RMS_EPS = 1e-5f;
constexpr float QSCALE = 0.125f * 1.4426950408889634f;

constexpr size_t al256(size_t x) { return (x + 255) & ~(size_t)255; }
constexpr size_t WS_CTL = 0;
constexpr size_t CTL_BYTES = 65536;
constexpr size_t WS_MOD = WS_CTL + CTL_BYTES;
constexpr size_t WS_ROPE = WS_MOD + al256((size_t)DEPTH * 5 * 6144 * 4);
constexpr size_t WS_WIN = WS_ROPE + 32768;
constexpr size_t WS_WOUT = WS_WIN + (size_t)D_IN_EVEN_PAD * DM * 2;
constexpr size_t WS_WLORA = WS_WOUT + (size_t)DM * DM * 2;
constexpr size_t WS_WE13 = WS_WLORA + (size_t)LORA_N * LORA_K * 2;
constexpr size_t WE13_BYTES = (size_t)NEXP * 4096 * DM * 2, WE2_BYTES = (size_t)NEXP * DM * D_EXP * 2;
constexpr size_t WS_WE2 = WS_WE13 + 2 * WE13_BYTES;
constexpr size_t WS_X = WS_WE2 + 2 * WE2_BYTES;
constexpr size_t WS_H = WS_X + (size_t)MROWS * DM * 4;
constexpr size_t WS_A2 = WS_H + (size_t)MROWS * DM * 2;
constexpr size_t WS_P = WS_A2 + (size_t)MROWS * DM * 2;
constexpr size_t WS_AFF = WS_P + (size_t)MROWS * P_LD * 2;
constexpr size_t WS_SLOT = WS_AFF + (size_t)MROWS * 16 * 4;
constexpr size_t WS_IDX = WS_SLOT + (size_t)MROWS * 16 * 4;
constexpr size_t WS_GATE = WS_IDX + al256((size_t)NEXP * ESLOTS * 4);
constexpr size_t WS_R2 = WS_GATE + al256((size_t)NEXP * ESLOTS * 4);
constexpr int SC_REC = 1408, SC_ROW = 12 * SC_REC, SC_W = 0, SC_R = 512, SC_KK = 640, SC_V = 768, SC_B = 896, SC_KR = 1024;
constexpr size_t WS_SCN = WS_R2;
constexpr size_t WS_G = WS_SCN + (size_t)MROWS * SC_ROW;
constexpr size_t WS_LIN = WS_G + (size_t)MROWS * 768 * 2;
constexpr int CS_L = 64, CS_NCH = LKEYS / CS_L, CS_UNITS = NB * RW_H * 2;
constexpr size_t WS_CHK = WS_LIN + (size_t)MROWS * 384 * 2;
constexpr size_t WS_EVEN_END = WS_CHK + (size_t)CS_UNITS * CS_NCH * 32768;
constexpr size_t WS_Y = WS_P;
constexpr size_t WS_Q = WS_R2;
constexpr size_t WS_KA = WS_Q + (size_t)MROWS * 768 * 2;
constexpr size_t WS_VT = WS_KA + (size_t)NB * LKEYS * 768 * 2;
constexpr size_t WS_HID = WS_R2;
constexpr size_t WS_YE = WS_HID + (size_t)NEXP * ESLOTS * D_EXP * 2;
constexpr size_t WS_END = WS_EVEN_END;
static_assert(WS_END <= (size_t)2147483648ull, "workspace over 2 GiB");
static_assert((size_t)2 * MROWS * 768 * 4 <= (size_t)MROWS * P_LD * 2, "Y aliases P");
static_assert(WS_YE + (size_t)NEXP * ESLOTS * DM * 2 <= WS_END, "moe region");

constexpr int LDS_BYTES = 147456;
constexpr int LDS_MISC = 140 * 1024;
constexpr int LDS_PTAB = LDS_MISC + 256;
constexpr int NWAVES = 8, NTHR = 512;

__device__ __forceinline__ unsigned f2bf(float f) { unsigned u = __float_as_uint(f); return (u + 0x7fffu + ((u >> 16) & 1u)) >> 16; }
__device__ __forceinline__ unsigned pk2(float lo, float hi) { f32x2 v = {lo, hi}; bf16x2_t b = __builtin_convertvector(v, bf16x2_t); return __builtin_bit_cast(unsigned, b); }
__device__ __forceinline__ float bflo(unsigned u) { return __uint_as_float(u << 16); }
__device__ __forceinline__ float bfhi(unsigned u) { return __uint_as_float(u & 0xffff0000u); }
__device__ __forceinline__ float bf2f(bf16_t b) { return __uint_as_float((unsigned)b << 16); }
__device__ __forceinline__ float sigmoidf_(float x) { return 1.f / (1.f + __expf(-x)); }
__device__ __forceinline__ float wave_sum(float v) {
#pragma unroll
    for (int o = 1; o < 64; o <<= 1) v += __shfl_xor(v, o);
    return v;
}
__device__ __forceinline__ float sum16(float v) {
#pragma unroll
    for (int o = 1; o < 16; o <<= 1) v += __shfl_xor(v, o);
    return v;
}
__device__ __forceinline__ f32x4 ld4bf_(const void* p) { const u32x2 u = *(const u32x2*)p; return (f32x4){bflo(u.x), bfhi(u.x), bflo(u.y), bfhi(u.y)}; }
__device__ __forceinline__ void st4bf_(void* p, f32x4 v) { u32x2 o; o.x = pk2(v[0], v[1]); o.y = pk2(v[2], v[3]); *(u32x2*)p = o; }
__device__ __forceinline__ float max3f(float a, float b, float c) { float r; asm("v_max3_f32 %0, %1, %2, %3" : "=v"(r) : "v"(a), "v"(b), "v"(c)); return r; }
__device__ __forceinline__ int crow(int r, int hi) { return (r & 3) + 8 * (r >> 2) + 4 * hi; }
__device__ __forceinline__ float gelu_erf(float x) { return 0.5f * x * (1.f + erff(x * 0.70710678118654752f)); }

#define XB_TMO      128
#define XB_XCNT(j)  (256  + 64 * (j))
#define XB_XSUB(j)  (1280 + 64 * (j))
#define XB_XGEN(j)  (2304 + 64 * (j))
#define XB_TOP      3328
#define XB_TOPGEN   3392
#define XCD_BAR_WORDS 3456
#define XB_SPIN_CAP (1u << 20)

__device__ __forceinline__ unsigned xb_ld(unsigned* p)              { return __hip_atomic_load(p, __ATOMIC_RELAXED, __HIP_MEMORY_SCOPE_AGENT); }
__device__ __forceinline__ unsigned xb_add(unsigned* p, unsigned v) { return __hip_atomic_fetch_add(p, v, __ATOMIC_RELAXED, __HIP_MEMORY_SCOPE_AGENT); }
__device__ __forceinline__ unsigned xb_xcc_id() { return (unsigned)__builtin_amdgcn_s_getreg((3 << 11) | 20) & 0xFu; }
#define XB_SPIN(cond, bar) do { unsigned _sp = 0; while (cond) { __builtin_amdgcn_s_sleep(1); \
    if ((++_sp & 255u) == 0u) { if (xb_ld(&(bar)[XB_TMO])) break; if (_sp > XB_SPIN_CAP) { atomicAdd(&(bar)[XB_TMO], 1u); break; } } } } while (0)

struct XcdBarrier { unsigned* bar; unsigned x; volatile LAS unsigned* st; };

__device__ __forceinline__ XcdBarrier xcd_barrier_post(unsigned* bar, volatile LAS unsigned* st) {
    XcdBarrier b; b.bar = bar; b.x = xb_xcc_id(); b.st = st;
    if (threadIdx.x == 0) (void)xb_add(&bar[XB_XCNT(b.x)], 1u);
    return b;
}
__device__ __forceinline__ void xcd_barrier_complete(unsigned* bar, unsigned x, unsigned& nloc, unsigned& nx) {
    const unsigned G = gridDim.x * gridDim.y * gridDim.z;
    unsigned sum, cnt, mine, sp = 0u;
    for (;;) {
        sum = 0u; cnt = 0u; mine = 0u;
#pragma unroll
        for (unsigned j = 0; j < 16; ++j) { const unsigned c = xb_ld(&bar[XB_XCNT(j)]); sum += c; cnt += (c > 0u) ? 1u : 0u; mine = (j == x) ? c : mine; }
        if (sum == G) break;
        __builtin_amdgcn_s_sleep(1);
        if ((++sp & 255u) == 0u) { if (xb_ld(&bar[XB_TMO])) break; if (sp > XB_SPIN_CAP) { atomicAdd(&bar[XB_TMO], 1u); break; } }
    }
    nloc = mine > 0u ? mine : 1u; nx = cnt > 0u ? cnt : 1u;
}
__device__ __forceinline__ void xcd_barrier(const XcdBarrier& b) {
    asm volatile("s_waitcnt vmcnt(0)" ::: "memory");
    __syncthreads();
    if (threadIdx.x == 0) {
        unsigned* bar = b.bar;
        __builtin_amdgcn_s_waitcnt(0);
        unsigned nloc = b.st[0], nx = b.st[1];
        if (nloc == 0u) { xcd_barrier_complete(bar, b.x, nloc, nx); b.st[0] = nloc; b.st[1] = nx; }
        const unsigned old = xb_add(&bar[XB_XSUB(b.x)], 1u);
        const unsigned gen = old / nloc;
        if (old + 1u == (gen + 1u) * nloc) {
            __builtin_amdgcn_fence(__ATOMIC_RELEASE, "agent");
            asm volatile("s_waitcnt vmcnt(0)" ::: "memory");
            const unsigned og = xb_add(&bar[XB_TOP], 1u);
            const unsigned tg = og / nx;
            if (og + 1u == (tg + 1u) * nx) xb_add(&bar[XB_TOPGEN], 1u);
            else XB_SPIN(xb_ld(&bar[XB_TOPGEN]) == tg, bar);
            __builtin_amdgcn_fence(__ATOMIC_ACQUIRE, "agent");
            xb_add(&bar[XB_XGEN(b.x)], 1u);
            asm volatile("s_waitcnt vmcnt(0)" ::: "memory");
        } else {
            XB_SPIN(xb_ld(&bar[XB_XGEN(b.x)]) == gen, bar);
            __builtin_amdgcn_fence(__ATOMIC_ACQUIRE, "agent");
            asm volatile("s_waitcnt vmcnt(0)" ::: "memory");
        }
    }
    __syncthreads();
}

namespace pg8 {
constexpr int BM = 256, BK = 64, HALF = 128, HTB = HALF * BK * 2, STAGE_BYTES = 8 * HTB, NXCD = 8, WGM = 8;
__host__ __device__ __forceinline__ int lds_byte(int r, int c) { const int st = (r >> 4) * 2 + (c >> 5), rr = r & 15, cc = c & 31, ob = rr * 64 + cc * 2; return st * 1024 + (ob ^ (((ob >> 9) & 1) << 5)); }
__host__ __device__ __forceinline__ void stage_rc(int b, int& R, int& C) { const int st = b / 1024, sb = b % 1024, swz = sb ^ (((sb >> 9) & 1) << 5); R = (st >> 1) * 16 + swz / 64; C = (st & 1) * 32 + (swz % 64) / 2; }

struct Unit { int pm, pn; };
struct Gemm { const bf16_t* A; const bf16_t* Bt; int K; };

template <int MODE> struct Order {
    int nM, nN, nwg, G, c; const int* idx; long bstride;
    __device__ __forceinline__ void init(int nM_, int nN_, int G_, int c_, const int* idx_, long bstride_) { nM = nM_; nN = nN_; nwg = nM * nN; G = G_; c = c_; idx = idx_; bstride = bstride_; }
    __device__ __forceinline__ bool next(int i, Unit& u) const {
        const long L = (long)i * G + c; if (L >= nwg) return false;
        int wgid = (int)L; { const int q = nwg / NXCD, r = nwg % NXCD, xcd = wgid % NXCD, off = wgid / NXCD; wgid = (xcd < r ? xcd * (q + 1) : r * (q + 1) + (xcd - r) * q) + off; }
        const int nig = WGM * nN, gid = wgid / nig, fm = gid * WGM, gsz = (nM - fm) < WGM ? (nM - fm) : WGM;
        u.pm = fm + ((wgid % nig) % gsz); u.pn = (wgid % nig) / gsz; return true;
    }
    __device__ __forceinline__ unsigned arow(const Unit& u, int r) const { if (MODE == 1) return (unsigned)idx[u.pm * BM + r]; return (unsigned)(u.pm * BM + r); }
    __device__ __forceinline__ long bbase(const Unit& u, int K) const { long o = (long)u.pn * BM * K; if (MODE != 0) o += (long)(u.pm / 17) * bstride; return o; }
};

template <class Epi, class Sched>
__device__ __forceinline__ void gemm_phase(LAS unsigned char* lds, const Gemm g, const Sched& S, const Epi& E) {
    int tid = threadIdx.x; asm volatile("" : "+v"(tid));
    const int wid = __builtin_amdgcn_readfirstlane(tid >> 6), wr = wid >> 2, wc = wid & 3;
    const int K = g.K, nt = K / BK;
    unsigned voffB[2];
    { const int lane = tid & 63, fr = lane & 15, fq = lane >> 4; (void)fr; (void)fq; }
#pragma unroll
    for (int i = 0; i < 2; ++i) { int R, Cc; stage_rc(tid * 16 + i * 8192, R, Cc); voffB[i] = (unsigned)(R * K + Cc) * 2u; }
    const size_t kstep = (size_t)(BK * 2);
    const size_t hstep = (size_t)HALF * K * 2;
    const unsigned ldsw = (unsigned)wid * 1024u;
    const int aoff = lds_byte(wr * 64 + (tid & 15), ((tid & 63) >> 4) * 8), boff = lds_byte(wc * 32 + (tid & 15), ((tid & 63) >> 4) * 8);
#define PG8_SA(b, h) (((b) * 2 + (h)) * HTB)
#define PG8_SB(b, h) ((4 + (b) * 2 + (h)) * HTB)
#define PG8_STAGE(bufoff, gbase, voff) do { _Pragma("unroll") for (int _i = 0; _i < 2; ++_i) \
        __builtin_amdgcn_global_load_lds((const unsigned*)((const char*)(gbase) + (voff)[_i]), (LAS unsigned*)(lds + (bufoff) + ldsw + _i * 8192), 16, 0, 0); } while (0)
#define PG8_LDA(dst, b, h) do { _Pragma("unroll") for (int m = 0; m < 4; ++m) _Pragma("unroll") for (int k = 0; k < 2; ++k) dst[m][k] = *(const LAS bf16x8*)(lds + PG8_SA(b, h) + aoff + m * 2048 + k * 1024); } while (0)
#define PG8_LDB(dst, b, h) do { _Pragma("unroll") for (int n = 0; n < 2; ++n) _Pragma("unroll") for (int k = 0; k < 2; ++k) dst[n][k] = *(const LAS bf16x8*)(lds + PG8_SB(b, h) + boff + n * 2048 + k * 1024); } while (0)
#define PG8_MMA(ai, bj, At, Bt) do { __builtin_amdgcn_s_setprio(1); _Pragma("unroll") for (int m = 0; m < 4; ++m) _Pragma("unroll") for (int n = 0; n < 2; ++n) _Pragma("unroll") for (int k = 0; k < 2; ++k) \
        acc[ai][bj][m][n] = __builtin_amdgcn_mfma_f32_16x16x32_bf16(Bt[n][k], At[m][k], acc[ai][bj][m][n], 0, 0, 0); __builtin_amdgcn_s_setprio(0); } while (0)
#define PG8_WAIT_V(n) asm volatile("s_waitcnt vmcnt(" #n ")" ::: "memory")
#define PG8_WAIT_L(n) asm volatile("s_waitcnt lgkmcnt(" #n ")" ::: "memory")
#define PG8_BAR __builtin_amdgcn_s_barrier()
#define PG8_SCHED __builtin_amdgcn_sched_barrier(0)
#define PG8_ROWOFFS(dst, u, tq) do { _Pragma("unroll") for (int _i = 0; _i < 2; ++_i) { int _R, _C; stage_rc((tq) * 16 + _i * 8192, _R, _C); _Pragma("unroll") for (int _h = 0; _h < 2; ++_h) dst[_h][_i] = (S.arow(u, _h * HALF + _R) * (unsigned)K + (unsigned)_C) * 2u; } } while (0)
    Unit cur, nxt; int ui = 0;
    if (!S.next(0, cur)) return;
    f32x4 acc[2][2][4][2];
#pragma unroll
    for (int a = 0; a < 2; ++a)
#pragma unroll
        for (int b = 0; b < 2; ++b)
#pragma unroll
            for (int m = 0; m < 4; ++m)
#pragma unroll
                for (int n = 0; n < 2; ++n) acc[a][b][m][n] = (f32x4){0.f, 0.f, 0.f, 0.f};
    bf16x8 At[4][2], B0[2][2], B1[2][2];
    unsigned vcur[2][2];
    PG8_ROWOFFS(vcur, cur, tid);
    const char* const Ab = (const char*)g.A;
    const char* cB = (const char*)g.Bt + (size_t)S.bbase(cur, K) * 2;
    PG8_STAGE(PG8_SB(0, 0), cB, voffB); PG8_STAGE(PG8_SB(0, 1), cB + hstep, voffB); PG8_STAGE(PG8_SA(0, 0), Ab, vcur[0]); PG8_STAGE(PG8_SA(0, 1), Ab, vcur[1]);
    if (wr == 1) PG8_BAR;
    PG8_WAIT_V(2); PG8_BAR;
    PG8_STAGE(PG8_SB(1, 0), cB + kstep, voffB); PG8_STAGE(PG8_SA(1, 0), Ab + kstep, vcur[0]); PG8_STAGE(PG8_SB(1, 1), cB + hstep + kstep, voffB);
    PG8_WAIT_V(6); PG8_BAR;
    for (;;) {
        const bool has_next = S.next(ui + 1, nxt);
        const char* nB = has_next ? (const char*)g.Bt + (size_t)S.bbase(nxt, K) * 2 : cB;
        for (int t = 0; t < nt; t += 2) {
            const bool last = (t == nt - 2);
            const char* a1 = Ab + (size_t)(t + 1) * kstep;
            const char* a2 = last ? Ab : Ab + (size_t)(t + 2) * kstep; const char* b2 = last ? nB : cB + (size_t)(t + 2) * kstep;
            const char* a3 = a2 + kstep; const char* b3 = b2 + kstep;
            PG8_LDB(B0, 0, 0); PG8_LDB(B1, 0, 1); PG8_SCHED; PG8_LDA(At, 0, 0); PG8_STAGE(PG8_SA(1, 1), a1, vcur[1]);
            PG8_WAIT_V(8); PG8_WAIT_L(0); PG8_BAR; PG8_MMA(0, 0, At, B0); PG8_MMA(0, 1, At, B1); PG8_BAR; PG8_SCHED;
            if (last && has_next) { int tq = tid; asm volatile("" : "+v"(tq)); PG8_ROWOFFS(vcur, nxt, tq); }
            PG8_LDA(At, 0, 1); PG8_STAGE(PG8_SB(0, 0), b2, voffB); PG8_STAGE(PG8_SB(0, 1), b2 + hstep, voffB); PG8_STAGE(PG8_SA(0, 0), a2, vcur[0]);
            PG8_WAIT_V(8); PG8_WAIT_L(0); PG8_BAR; PG8_MMA(1, 0, At, B0); PG8_MMA(1, 1, At, B1); PG8_BAR; PG8_SCHED;
            PG8_LDB(B0, 1, 0); PG8_LDB(B1, 1, 1); PG8_SCHED; PG8_LDA(At, 1, 0); PG8_STAGE(PG8_SA(0, 1), a2, vcur[1]);
            PG8_WAIT_V(8); PG8_WAIT_L(0); PG8_BAR; PG8_MMA(0, 0, At, B0); PG8_MMA(0, 1, At, B1); PG8_BAR; PG8_SCHED;
            PG8_LDA(At, 1, 1); PG8_STAGE(PG8_SB(1, 0), b3, voffB); PG8_STAGE(PG8_SB(1, 1), b3 + hstep, voffB); PG8_STAGE(PG8_SA(1, 0), a3, vcur[0]);
            PG8_WAIT_V(8); PG8_WAIT_L(0); PG8_BAR; PG8_MMA(1, 0, At, B0); PG8_MMA(1, 1, At, B1); PG8_BAR; PG8_SCHED;
        }
        if (wr == 0) PG8_BAR;
        { int tz = tid; asm volatile("" : "+v"(tz)); const int ln = tz & 63; E(acc, cur, wr, wc, ln & 15, ln >> 4); }
        if (!has_next) break;
#pragma unroll
        for (int a = 0; a < 2; ++a)
#pragma unroll
            for (int b = 0; b < 2; ++b)
#pragma unroll
                for (int m = 0; m < 4; ++m)
#pragma unroll
                    for (int n = 0; n < 2; ++n) acc[a][b][m][n] = (f32x4){0.f, 0.f, 0.f, 0.f};
        cur = nxt; cB = nB; ++ui;
        if (wr == 1) PG8_BAR;
    }
    PG8_WAIT_V(0);
    PG8_BAR;
#undef PG8_SA
#undef PG8_SB
#undef PG8_STAGE
#undef PG8_LDA
#undef PG8_LDB
#undef PG8_MMA
#undef PG8_WAIT_V
#undef PG8_WAIT_L
#undef PG8_BAR
#undef PG8_SCHED
#undef PG8_ROWOFFS
}

#define EPI_LOOP for (int ai = 0; ai < 2; ++ai) for (int m = 0; m < 4; ++m) for (int bj = 0; bj < 2; ++bj) for (int n = 0; n < 2; ++n)
struct EpiBf16 {
    bf16_t* O; int ldc;
    __device__ __forceinline__ void operator()(const f32x4 (&acc)[2][2][4][2], const Unit& u, int wr, int wc, int fr, int fq) const {
        const int row0 = u.pm * BM + wr * 64 + fr, col0 = u.pn * BM + wc * 32 + 4 * fq;
#pragma unroll
        for (int ai = 0; ai < 2; ++ai)
#pragma unroll
            for (int m = 0; m < 4; ++m) { bf16_t* rowp = O + (size_t)(row0 + ai * HALF + m * 16) * ldc + col0;
#pragma unroll
                for (int bj = 0; bj < 2; ++bj)
#pragma unroll
                    for (int n = 0; n < 2; ++n) { const f32x4 v = acc[ai][bj][m][n]; u32x2 o; o.x = pk2(v[0], v[1]); o.y = pk2(v[2], v[3]); *(u32x2*)(rowp + bj * HALF + n * 16) = o; } }
    }
};
struct EpiOdd {
    bf16_t* P; bf16_t* Q; bf16_t* KA; const float* rope;
    __device__ __forceinline__ void operator()(const f32x4 (&acc)[2][2][4][2], const Unit& u, int wr, int wc, int fr, int fq) const {
        const int row0 = u.pm * BM + wr * 64 + fr, col0 = u.pn * BM + wc * 32 + 4 * fq;
        if (u.pn >= 6) {
#pragma unroll
            for (int ai = 0; ai < 2; ++ai)
#pragma unroll
                for (int m = 0; m < 4; ++m) { bf16_t* rowp = P + (size_t)(row0 + ai * HALF + m * 16) * P_LD + col0;
#pragma unroll
                    for (int bj = 0; bj < 2; ++bj)
#pragma unroll
                        for (int n = 0; n < 2; ++n) { const f32x4 v = acc[ai][bj][m][n]; u32x2 o; o.x = pk2(v[0], v[1]); o.y = pk2(v[2], v[3]); *(u32x2*)(rowp + bj * HALF + n * 16) = o; } }
            return;
        }
        const bool isk = u.pn >= 3, isctx = u.pm >= NLAT / BM; const int axis = wc & 1;
        const int cq = col0 - (isk ? 768 : 0);
#pragma unroll
        for (int ai = 0; ai < 2; ++ai)
#pragma unroll
            for (int m = 0; m < 4; ++m) { const int row = row0 + ai * HALF + m * 16;
                f32x4 cs = {1.f, 1.f, 1.f, 1.f}, sn = {0.f, 0.f, 0.f, 0.f}; size_t orow;
                if (!isctx) { const int t = row & (TT - 1); const int pos = axis ? 128 + (t & 63) : (t >> 6);
                    cs = *(const f32x4*)(rope + pos * 16 + 4 * fq); sn = *(const f32x4*)(rope + 192 * 16 + pos * 16 + 4 * fq);
                    orow = isk ? (size_t)(row >> 13) * LKEYS + CTXL + t : (size_t)row; }
                else { const int rc = row - NLAT; orow = isk ? (size_t)(rc >> 8) * LKEYS + (rc & 255) : (size_t)row; }
                bf16_t* op = (isk ? KA : Q) + orow * 768 + cq; const float sc = isk ? 1.f : QSCALE;
#pragma unroll
                for (int bj = 0; bj < 2; ++bj) { const f32x4 x1 = acc[ai][bj][m][0], x2 = acc[ai][bj][m][1];
                    const f32x4 o1 = (x1 * cs - x2 * sn) * sc, o2 = (x1 * sn + x2 * cs) * sc;
                    u32x2 a; a.x = pk2(o1[0], o1[1]); a.y = pk2(o1[2], o1[3]); *(u32x2*)(op + bj * HALF) = a;
                    u32x2 b; b.x = pk2(o2[0], o2[1]); b.y = pk2(o2[2], o2[3]); *(u32x2*)(op + bj * HALF + 16) = b; } }
    }
};
struct EpiRes {
    float* X; const float* modl;
    __device__ __forceinline__ void operator()(const f32x4 (&acc)[2][2][4][2], const Unit& u, int wr, int wc, int fr, int fq) const {
        const int row0 = u.pm * BM + wr * 64 + fr, col0 = u.pn * BM + wc * 32 + 4 * fq;
        const int mi = (u.pm * BM < NLAT) ? (u.pm * BM) / TT : 4;
        const float* gate = modl + mi * 6144 + 2 * DM;
        f32x4 gv[2][2];
#pragma unroll
        for (int bj = 0; bj < 2; ++bj)
#pragma unroll
            for (int n = 0; n < 2; ++n) gv[bj][n] = *(const f32x4*)(gate + col0 + bj * HALF + n * 16);
#pragma unroll
        for (int ai = 0; ai < 2; ++ai)
#pragma unroll
            for (int m = 0; m < 4; ++m) { float* rowp = X + (size_t)(row0 + ai * HALF + m * 16) * DM + col0;
#pragma unroll
                for (int bj = 0; bj < 2; ++bj)
#pragma unroll
                    for (int n = 0; n < 2; ++n) { f32x4* p = (f32x4*)(rowp + bj * HALF + n * 16); const f32x4 x = *p; *p = x * ALPHA_DN + gv[bj][n] * acc[ai][bj][m][n]; } }
    }
};
struct EpiSwiGLU {
    bf16_t* HID;
    __device__ __forceinline__ void operator()(const f32x4 (&acc)[2][2][4][2], const Unit& u, int wr, int wc, int fr, int fq) const {
        const int row0 = u.pm * BM + wr * 64 + fr, f0 = u.pn * HALF + wc * 32 + 4 * fq;
#pragma unroll
        for (int ai = 0; ai < 2; ++ai)
#pragma unroll
            for (int m = 0; m < 4; ++m) { bf16_t* rowp = HID + (size_t)(row0 + ai * HALF + m * 16) * D_EXP + f0;
#pragma unroll
                for (int n = 0; n < 2; ++n) { const f32x4 a = acc[ai][0][m][n], b = acc[ai][1][m][n]; float h[4];
#pragma unroll
                    for (int j = 0; j < 4; ++j) h[j] = a[j] / (1.f + __expf(-a[j])) * b[j];
                    u32x2 o; o.x = pk2(h[0], h[1]); o.y = pk2(h[2], h[3]); *(u32x2*)(rowp + n * 16) = o; } }
    }
};
struct EpiYE {
    bf16_t* YE; const float* gate;
    __device__ __forceinline__ void operator()(const f32x4 (&acc)[2][2][4][2], const Unit& u, int wr, int wc, int fr, int fq) const {
        const int row0 = u.pm * BM + wr * 64 + fr, col0 = u.pn * BM + wc * 32 + 4 * fq;
#pragma unroll
        for (int ai = 0; ai < 2; ++ai)
#pragma unroll
            for (int m = 0; m < 4; ++m) { const int row = row0 + ai * HALF + m * 16; const float gt = gate[row]; bf16_t* rowp = YE + (size_t)row * DM + col0;
#pragma unroll
                for (int bj = 0; bj < 2; ++bj)
#pragma unroll
                    for (int n = 0; n < 2; ++n) { const f32x4 v = acc[ai][bj][m][n] * gt; u32x2 o; o.x = pk2(v[0], v[1]); o.y = pk2(v[2], v[3]); *(u32x2*)(rowp + bj * HALF + n * 16) = o; } }
    }
};
struct EpiLora {
    unsigned char* SCN; bf16_t* G; const float* decay0; const float* a0; const float* kalpha;
    __device__ __forceinline__ void operator()(const f32x4 (&acc)[2][2][4][2], const Unit& u, int wr, int wc, int fr, int fq) const {
        const int row0 = u.pm * BM + wr * 64 + fr;
        const int seg = u.pn / 3, cb = (u.pn % 3) * BM + wc * 32 + 4 * fq;
#pragma unroll
        for (int bj = 0; bj < 2; ++bj)
#pragma unroll
            for (int n = 0; n < 2; ++n) {
                const int col = cb + bj * HALF + n * 16, head = col >> 6, kx = col & 63;
                if (seg < 2) {
                    const f32x4 d0 = *(const f32x4*)(decay0 + seg * 768 + col);
#pragma unroll
                    for (int ai = 0; ai < 2; ++ai)
#pragma unroll
                        for (int m = 0; m < 4; ++m) { const int row = row0 + ai * HALF + m * 16; f32x4 w;
#pragma unroll
                            for (int j = 0; j < 4; ++j) { const float lw = -DECAY_SCALE * sigmoidf_(d0[j] + acc[ai][bj][m][n][j]); w[j] = CHUNKED_SCAN ? lw : __expf(lw); }
                            *(f32x4*)(SCN + (size_t)(row * 12 + head) * SC_REC + SC_W + seg * 256 + kx * 4) = w; }
                } else if (seg < 4) {
                    const int d = seg - 2;
                    const f32x4 a00 = *(const f32x4*)(a0 + d * 768 + col), kal = *(const f32x4*)(kalpha + col);
#pragma unroll
                    for (int ai = 0; ai < 2; ++ai)
#pragma unroll
                        for (int m = 0; m < 4; ++m) { const int row = row0 + ai * HALF + m * 16; unsigned char* base = SCN + (size_t)(row * 12 + head) * SC_REC + kx * 2;
                            const f32x4 kk = ld4bf_(base + SC_KK); const f32x4 ks = ld4bf_(base + SC_KR + 256 * d); f32x4 bb, kr;
#pragma unroll
                            for (int j = 0; j < 4; ++j) { const float a = sigmoidf_(a00[j] + acc[ai][bj][m][n][j]); bb[j] = kk[j] * a; kr[j] = ks[j] * (1.f + (a - 1.f) * kal[j]); }
                            st4bf_(base + SC_B + 256 * d, bb); st4bf_(base + SC_KR + 256 * d, kr); }
                } else {
#pragma unroll
                    for (int ai = 0; ai < 2; ++ai)
#pragma unroll
                        for (int m = 0; m < 4; ++m) { const int row = row0 + ai * HALF + m * 16; const f32x4 v = acc[ai][bj][m][n]; u32x2 o; o.x = pk2(v[0], v[1]); o.y = pk2(v[2], v[3]);
                            *(u32x2*)(G + (size_t)row * 768 + col) = o; }
                }
            }
    }
};
}

struct Args { const float* in[37]; float* out; unsigned char* ws; int lo, hi; };
enum { I_X = 0, I_C, I_CTX, I_CCTX, I_WMOD, I_BMOD, I_LNG, I_LNB, I_EWIN, I_EWOUT, I_CONVW, I_MU, I_DUP, I_D0, I_AUP, I_A0, I_GUP, I_KXI, I_KAL, I_RBON, I_GNG, I_GNB,
       I_OWIN, I_OWOUT, I_LQ1, I_LK1, I_LQ2, I_LK2, I_SUBG, I_GLNG, I_GLNB, I_GWS, I_GBS, I_WR, I_WE1, I_WE3, I_WE2 };

struct Ctx {
    LAS unsigned char* lds;
    int tid, lane, wave, G, vcu, gw, NGW;
};
__device__ __forceinline__ void mkctx(Ctx& C, LAS unsigned char* lds) {
    int tid = threadIdx.x; asm volatile("" : "+v"(tid));
    C.lds = lds; C.tid = tid; C.lane = tid & 63; C.wave = __builtin_amdgcn_readfirstlane(tid >> 6);
    C.G = gridDim.x; { const int bx = blockIdx.x; C.vcu = (C.G % 8 == 0) ? (bx % 8) * (C.G / 8) + bx / 8 : bx; }
    C.gw = blockIdx.x * NWAVES + C.wave; C.NGW = C.G * NWAVES;
}
__device__ __forceinline__ void ldargs(Args& A, LAS unsigned char* lds) {
    LAS const u32x2* tb = (LAS const u32x2*)(lds + LDS_PTAB); asm volatile("" : "+v"(tb));
#pragma unroll
    for (int i = 0; i < 37; ++i) { const u32x2 v = tb[i]; A.in[i] = (const float*)(((unsigned long long)(unsigned)__builtin_amdgcn_readfirstlane((int)v.y) << 32) | (unsigned)__builtin_amdgcn_readfirstlane((int)v.x)); }
    { const u32x2 v = tb[37]; A.out = (float*)(((unsigned long long)(unsigned)__builtin_amdgcn_readfirstlane((int)v.y) << 32) | (unsigned)__builtin_amdgcn_readfirstlane((int)v.x)); }
    { const u32x2 v = tb[38]; A.ws = (unsigned char*)(((unsigned long long)(unsigned)__builtin_amdgcn_readfirstlane((int)v.y) << 32) | (unsigned)__builtin_amdgcn_readfirstlane((int)v.x)); }
    A.lo = 0; A.hi = 0;
}
__device__ __forceinline__ int row_mi(int row) { return row < NLAT ? (row >> 13) : 4; }

__device__ __forceinline__ void phase_init(const Ctx& C, const Args& A) {
    unsigned char* ws = A.ws;
    float* MOD = (float*)(ws + WS_MOD);
    LAS float* sv = (LAS float*)C.lds;
    LAS float* red = sv + 5 * 1024;
    for (int i = C.tid; i < 5 * 1024; i += NTHR) { const int v = i >> 10, k = i & 1023; const float c = (v < 4) ? A.in[I_C][v * DM + k] : A.in[I_CCTX][k]; sv[i] = c / (1.f + __expf(-c)); }
    __syncthreads();
    const int j = C.tid & 127, kp = C.tid >> 7;
    for (int it = blockIdx.x; it < DEPTH * 48; it += C.G) {
        const int l = it / 48, cg = it % 48, col = cg * 128 + j;
        const float* W = A.in[I_WMOD] + (size_t)l * DM * 6144 + col;
        float a0 = 0.f, a1 = 0.f, a2 = 0.f, a3 = 0.f, a4 = 0.f;
#pragma unroll 4
        for (int k = kp * 256; k < kp * 256 + 256; ++k) { const float w = W[(size_t)k * 6144]; a0 += sv[k] * w; a1 += sv[1024 + k] * w; a2 += sv[2048 + k] * w; a3 += sv[3072 + k] * w; a4 += sv[4096 + k] * w; }
        red[(kp * 5 + 0) * 128 + j] = a0; red[(kp * 5 + 1) * 128 + j] = a1; red[(kp * 5 + 2) * 128 + j] = a2; red[(kp * 5 + 3) * 128 + j] = a3; red[(kp * 5 + 4) * 128 + j] = a4;
        __syncthreads();
        for (int o = C.tid; o < 5 * 128; o += NTHR) { const int v = o >> 7, jj = o & 127; const int cc = cg * 128 + jj;
            const float s = red[(0 * 5 + v) * 128 + jj] + red[(1 * 5 + v) * 128 + jj] + red[(2 * 5 + v) * 128 + jj] + red[(3 * 5 + v) * 128 + jj];
            MOD[((size_t)l * 5 + v) * 6144 + cc] = s + A.in[I_BMOD][l * 6144 + cc]; }
        __syncthreads();
    }
    if (blockIdx.x == C.G - 1) { float* rope = (float*)(ws + WS_ROPE);
        for (int i = C.tid; i < 192 * 16; i += NTHR) { const int pos = i >> 4, j = i & 15; const float ang = (float)(pos < 128 ? pos : pos - 128) * powf(10000.f, -(float)j * (1.f / 16.f));
            rope[i] = cosf(ang); rope[192 * 16 + i] = sinf(ang); } }
    f32x4* X4 = (f32x4*)(ws + WS_X);
    const f32x4* x4 = (const f32x4*)A.in[I_X]; const f32x4* c4 = (const f32x4*)A.in[I_CTX];
    const size_t nl = (size_t)NLAT * DM / 4, nc = (size_t)NCTX * DM / 4;
    for (size_t i = (size_t)blockIdx.x * NTHR + C.tid; i < nl + nc; i += (size_t)C.G * NTHR) X4[i] = (i < nl) ? x4[i] : c4[i - nl];
}

__device__ __forceinline__ void transpose_item(const float* W, int ldw, int k0, int n0, bf16_t* WT, int ldt, int drow0, LAS float* scr, int lane) {
    { float v[64]; const float* src = W + (size_t)k0 * ldw + n0 + lane;
#pragma unroll
      for (int k = 0; k < 64; ++k) v[k] = __builtin_nontemporal_load(src + (size_t)k * ldw);
#pragma unroll
      for (int k = 0; k < 64; ++k) scr[k * 65 + lane] = v[k]; }
    asm volatile("s_waitcnt lgkmcnt(0)" ::: "memory");
    const int c = lane & 7;
#pragma unroll
    for (int j = 0; j < 8; ++j) { const int n = (lane >> 3) + 8 * j; const LAS float* s = scr + (8 * c) * 65 + n;
        u32x4 o; o.x = pk2(s[0 * 65], s[1 * 65]); o.y = pk2(s[2 * 65], s[3 * 65]); o.z = pk2(s[4 * 65], s[5 * 65]); o.w = pk2(s[6 * 65], s[7 * 65]);
        *(u32x4*)(WT + (size_t)(drow0 + n) * ldt + k0 + 8 * c) = o; }
    asm volatile("s_waitcnt lgkmcnt(0)" ::: "memory");
}
__device__ __forceinline__ void conv_items(const Ctx& C, const Args& A, int l, int gw, int NGW, bool do_in, bool do_out, bool do_exp) {
    unsigned char* ws = A.ws;
    const int i2 = l >> 1; const bool odd = (l & 1);
    LAS float* scr = (LAS float*)C.lds + C.wave * (64 * 65);
    bf16_t* WIN = (bf16_t*)(ws + WS_WIN); bf16_t* WOUT = (bf16_t*)(ws + WS_WOUT); bf16_t* WE13 = (bf16_t*)(ws + WS_WE13 + (size_t)(l & 1) * WE13_BYTES); bf16_t* WE2 = (bf16_t*)(ws + WS_WE2 + (size_t)(l & 1) * WE2_BYTES);
    const int nin = odd ? D_IN_ODD : D_IN_EVEN;
    const float* win = odd ? A.in[I_OWIN] + (size_t)i2 * DM * D_IN_ODD : A.in[I_EWIN] + (size_t)i2 * DM * D_IN_EVEN;
    const float* wout = odd ? A.in[I_OWOUT] + (size_t)i2 * DM * DM : A.in[I_EWOUT] + (size_t)i2 * DM * DM;
    const int n_in = do_in ? 16 * (nin / 64) : 0, n_out = do_out ? 16 * 16 : 0, n_e13 = do_exp ? NEXP * 2 * 16 * 32 : 0, n_e2 = do_exp ? NEXP * 32 * 16 : 0;
    const int total = n_in + n_out + n_e13 + n_e2;
    for (int it = gw; it < total; it += NGW) {
        int r = it;
        if (r < n_in) { const int nb = nin / 64, kb = r / nb, nn = r % nb; transpose_item(win, nin, kb * 64, nn * 64, WIN, DM, nn * 64, scr, C.lane); continue; } r -= n_in;
        if (r < n_out) { const int kb = r / 16, nn = r % 16; transpose_item(wout, DM, kb * 64, nn * 64, WOUT, DM, nn * 64, scr, C.lane); continue; } r -= n_out;
        if (r < n_e13) { const int e = r / 1024, q = r % 1024, mat = q / 512, q2 = q % 512, kb = q2 / 32, nn = q2 % 32;
            const float* W = (mat ? A.in[I_WE3] : A.in[I_WE1]) + ((size_t)l * NEXP + e) * DM * D_EXP;
            const int f0 = nn * 64; const int drow = (f0 >> 7) * 256 + mat * 128 + (f0 & 127);
            transpose_item(W, D_EXP, kb * 64, f0, WE13 + (size_t)e * 4096 * DM, DM, drow, scr, C.lane); continue; } r -= n_e13;
        { const int e = r / 512, q = r % 512, kb = q / 16, nn = q % 16;
            const float* W = A.in[I_WE2] + ((size_t)l * NEXP + e) * D_EXP * DM;
            transpose_item(W, DM, kb * 64, nn * 64, WE2 + (size_t)e * DM * D_EXP, D_EXP, nn * 64, scr, C.lane); }
    }
}
__device__ __forceinline__ void phase_conv(const Ctx& C, const Args& A, int l) {
    unsigned char* ws = A.ws;
    const int i2 = l >> 1; const bool odd = (l & 1);
    bf16_t* WIN = (bf16_t*)(ws + WS_WIN);
    const bool early = CHUNKED_SCAN && odd;
    conv_items(C, A, l, C.gw, C.NGW, !early, true, !early);
    if (!odd) {
        u32x4* z = (u32x4*)(WIN + (size_t)D_IN_EVEN * DM);
        for (int i = blockIdx.x * NTHR + C.tid; i < (D_IN_EVEN_PAD - D_IN_EVEN) * DM / 8; i += C.G * NTHR) z[i] = (u32x4){0u, 0u, 0u, 0u};
        bf16_t* WL = (bf16_t*)(ws + WS_WLORA);
        const float* dup = A.in[I_DUP] + (size_t)i2 * 2 * 64 * 768; const float* aup = A.in[I_AUP] + (size_t)i2 * 2 * 64 * 768; const float* gup = A.in[I_GUP] + (size_t)i2 * 128 * 768;
        for (int i = blockIdx.x * NTHR + C.tid; i < LORA_N * LORA_K; i += C.G * NTHR) {
            const int kk = i / LORA_N, n = i % LORA_N, seg = n / 768, col = n % 768; float v = 0.f;
            if (seg == 0) { if (kk < 64) v = dup[(size_t)(0 * 64 + kk) * 768 + col]; }
            else if (seg == 1) { if (kk >= 64 && kk < 128) v = dup[(size_t)(1 * 64 + kk - 64) * 768 + col]; }
            else if (seg == 2) { if (kk >= 128 && kk < 192) v = aup[(size_t)(0 * 64 + kk - 128) * 768 + col]; }
            else if (seg == 3) { if (kk >= 192 && kk < 256) v = aup[(size_t)(1 * 64 + kk - 192) * 768 + col]; }
            else { if (kk >= 256) v = gup[(size_t)(kk - 256) * 768 + col]; }
            WL[(size_t)n * LORA_K + kk] = (bf16_t)f2bf(v);
        }
    }
}

__device__ __forceinline__ void phase_modh(const Ctx& C, const Args& A, int l) {
    const float* X = (const float*)(A.ws + WS_X); bf16_t* H = (bf16_t*)(A.ws + WS_H); const float* MOD = (const float*)(A.ws + WS_MOD) + (size_t)l * 5 * 6144;
    for (int row = C.gw; row < MROWS; row += C.NGW) {
        const float* md = MOD + row_mi(row) * 6144;
#pragma unroll
        for (int j = 0; j < 4; ++j) { const int col = 4 * C.lane + 256 * j; const f32x4 x = *(const f32x4*)(X + (size_t)row * DM + col), sh = *(const f32x4*)(md + col), sc = *(const f32x4*)(md + DM + col);
            const f32x4 h = x * (sc + 1.f) + sh; u32x2 o; o.x = pk2(h[0], h[1]); o.y = pk2(h[2], h[3]); *(u32x2*)(H + (size_t)row * DM + col) = o; }
    }
}

__device__ __forceinline__ f32x4 ld4bf(const bf16_t* p) { const u32x2 u = *(const u32x2*)p; return (f32x4){bflo(u.x), bfhi(u.x), bflo(u.y), bfhi(u.y)}; }
__device__ __forceinline__ void st4bf(bf16_t* p, f32x4 v) { u32x2 o; o.x = pk2(v[0], v[1]); o.y = pk2(v[2], v[3]); *(u32x2*)p = o; }
__device__ __forceinline__ void seq_info(int row, bool& hasp, bool& hasn) {
    if (row < NLAT) { const int t = row & (TT - 1); hasp = t > 0; hasn = t < TT - 1; }
    else { const int t = (row - NLAT) & (CTXL - 1); hasp = t > 0; hasn = t < CTXL - 1; }
}
__device__ __forceinline__ void phase_ef1(const Ctx& C, const Args& A, int l) {
    const int i2 = l >> 1; unsigned char* ws = A.ws;
    const bf16_t* P = (const bf16_t*)(ws + WS_P); bf16_t* A2 = (bf16_t*)(ws + WS_A2); unsigned char* SCN = ws + WS_SCN; bf16_t* LIN = (bf16_t*)(ws + WS_LIN);
    const float* cw = A.in[I_CONVW] + (size_t)i2 * 3 * 256; const float* mu = A.in[I_MU] + (size_t)i2 * RWKV_COLS; const float* kxi = A.in[I_KXI] + (size_t)i2 * 768;
    const f32x4 z4 = {0.f, 0.f, 0.f, 0.f};
    for (int row = C.gw; row < MROWS; row += C.NGW) {
        bool hasp, hasn; seq_info(row, hasp, hasn);
        const bf16_t* p0 = P + (size_t)row * P_LD; const bf16_t* pm = p0 - P_LD; const bf16_t* pp = p0 + P_LD;
        {
            const int j4 = 4 * C.lane;
            const f32x4 bg = ld4bf(p0 + j4), u0 = ld4bf(p0 + 256 + j4) * ld4bf(p0 + 512 + j4);
            const f32x4 um = hasp ? ld4bf(pm + 256 + j4) * ld4bf(pm + 512 + j4) : z4, up = hasn ? ld4bf(pp + 256 + j4) * ld4bf(pp + 512 + j4) : z4;
            const f32x4 w0 = *(const f32x4*)(cw + j4), w1 = *(const f32x4*)(cw + 256 + j4), w2 = *(const f32x4*)(cw + 512 + j4);
            st4bf(A2 + (size_t)row * DM + j4, bg * (w0 * um + w1 * u0 + w2 * up));
        }
#pragma unroll
        for (int it = 0; it < 11; ++it) {
            const int c = it * 256 + 4 * C.lane;
            if (c < RWKV_COLS) {
                const f32x4 x0 = ld4bf(p0 + 768 + c), xm = hasp ? ld4bf(pm + 768 + c) : z4, xp = hasn ? ld4bf(pp + 768 + c) : z4, m4 = *(const f32x4*)(mu + c);
                const f32x4 ps = x0 + m4 * ((xm + xp) * 0.5f - x0);
                if (it < 3) { const int head = c >> 6, kx = c & 63; st4bf_(SCN + (size_t)(row * 12 + head) * SC_REC + SC_R + kx * 2, ps); }
                else if (it < 6) { const int c1 = c - 768, head = c1 >> 6, kx = c1 & 63; const f32x4 kv = ps * *(const f32x4*)(kxi + c1);
                    const float ss = sum16(kv[0] * kv[0] + kv[1] * kv[1] + kv[2] * kv[2] + kv[3] * kv[3]); const float rn = rsqrtf(ss + 1e-12f);
                    unsigned char* base = SCN + (size_t)(row * 12 + head) * SC_REC + kx * 2;
                    st4bf_(base + SC_KK, kv * rn); st4bf_(base + SC_KR, ps); st4bf_(base + SC_KR + 256, ps); }
                else if (it < 9) { const int c1 = c - 1536, head = c1 >> 6, kx = c1 & 63; st4bf_(SCN + (size_t)(row * 12 + head) * SC_REC + SC_V + kx * 2, ps); }
                else { const int c1 = c - 2304; f32x4 o;
                    if (c1 < 128) { o = (f32x4){tanhf(ps[0]), tanhf(ps[1]), tanhf(ps[2]), tanhf(ps[3])}; }
                    else if (c1 < 256) { o = ps; }
                    else { o = (f32x4){sigmoidf_(ps[0]), sigmoidf_(ps[1]), sigmoidf_(ps[2]), sigmoidf_(ps[3])}; }
                    st4bf(LIN + (size_t)row * LORA_K + c1, o); }
            }
        }
    }
}

__device__ __forceinline__ int scan_row(int i, int b, int d) {
    if (d == 0) return i < CTXL ? NLAT + b * CTXL + i : b * TT + (i - CTXL);
    return i < CTXL ? NLAT + b * CTXL + (CTXL - 1 - i) : b * TT + (TT - 1 - (i - CTXL));
}
__device__ __forceinline__ float red8(float v) {
    v += __uint_as_float((unsigned)__builtin_amdgcn_update_dpp(0, (int)__float_as_uint(v), 0xB1, 0xF, 0xF, true));
    v += __uint_as_float((unsigned)__builtin_amdgcn_update_dpp(0, (int)__float_as_uint(v), 0x4E, 0xF, 0xF, true));
    v += __uint_as_float((unsigned)__builtin_amdgcn_update_dpp(0, (int)__float_as_uint(v), 0x141, 0xF, 0xF, true));
    return v;
}
__device__ __forceinline__ float red16(float v) {
    v += __uint_as_float((unsigned)__builtin_amdgcn_update_dpp(0, (int)__float_as_uint(v), 0xB1, 0xF, 0xF, true));
    v += __uint_as_float((unsigned)__builtin_amdgcn_update_dpp(0, (int)__float_as_uint(v), 0x4E, 0xF, 0xF, true));
    v += __uint_as_float((unsigned)__builtin_amdgcn_update_dpp(0, (int)__float_as_uint(v), 0x141, 0xF, 0xF, true));
    v += __uint_as_float((unsigned)__builtin_amdgcn_update_dpp(0, (int)__float_as_uint(v), 0x140, 0xF, 0xF, true));
    return v;
}
__device__ __forceinline__ void phase_scan(const Ctx& C, const Args& A) {
    for (int u = blockIdx.x; u < 192; u += C.G) {
    const int half = u & 1, d = (u >> 1) & 1, h = (u >> 2) % 12, b = u / 48;
    const unsigned char* SCN = A.ws + WS_SCN; float* Y = (float*)(A.ws + WS_Y) + (size_t)d * MROWS * 768;
    LAS float* buf = (LAS float*)C.lds; LAS float* ybuf = buf + 2 * 32 * 352;
    constexpr int NCH = LKEYS / 32;
    u32x4 st[4];
    int ps_[4], psrc[4], pdst[4]; bool pf32[4];
#pragma unroll
    for (int j = 0; j < 4; ++j) { const int p = C.tid + NTHR * j; const int s = p / 52, q = p % 52; ps_[j] = s;
        if (q < 16) { psrc[j] = SC_W + 256 * d + q * 16; pdst[j] = s * 352 + q * 4; pf32[j] = true; }
        else if (q < 48) { const int vec = (q - 16) >> 3, part = (q - 16) & 7; const int so = vec == 0 ? SC_KK : vec == 1 ? SC_B + 256 * d : vec == 2 ? SC_KR + 256 * d : SC_R;
            psrc[j] = so + part * 16; pdst[j] = s * 352 + 64 * (vec + 1) + part * 8; pf32[j] = false; }
        else { const int part = q - 48; psrc[j] = SC_V + half * 64 + part * 16; pdst[j] = s * 352 + 320 + part * 8; pf32[j] = false; } }
    const int sgn = d ? -1 : 1;
    const unsigned char* SCNh = SCN + (size_t)h * SC_REC;
#define SCAN_ROW0(c) (((c) * 32 < CTXL) ? (NLAT + b * CTXL + (d ? CTXL - 1 - (c) * 32 : (c) * 32)) : (b * TT + (d ? TT - 1 - ((c) * 32 - CTXL) : (c) * 32 - CTXL)))
#define SCAN_LOADG(c) do { const int row0_ = SCAN_ROW0(c); _Pragma("unroll") for (int j = 0; j < 4; ++j) if (j < 3 || C.tid < 1664 - 3 * NTHR) { \
        st[j] = *(const u32x4*)(SCNh + (size_t)(row0_ + sgn * ps_[j]) * SC_ROW + psrc[j]); } } while (0)
#define SCAN_STORE(bi) do { _Pragma("unroll") for (int j = 0; j < 4; ++j) if (j < 3 || C.tid < 1664 - 3 * NTHR) { LAS float* dp = buf + (bi) * (32 * 352) + pdst[j]; \
        if (pf32[j]) *(LAS u32x4*)dp = st[j]; \
        else { *(LAS f32x4*)dp = (f32x4){bflo(st[j].x), bfhi(st[j].x), bflo(st[j].y), bfhi(st[j].y)}; *(LAS f32x4*)(dp + 4) = (f32x4){bflo(st[j].z), bfhi(st[j].z), bflo(st[j].w), bfhi(st[j].w)}; } } } while (0)
    SCAN_LOADG(0); SCAN_STORE(0); __syncthreads();
    f32x2 Sa = {0.f, 0.f}, Sb = {0.f, 0.f};
    const int rl = C.lane >> 4, ks = C.lane & 15;
    float ycol = 0.f;
#define SC_LD(R, s) do { const LAS float* bp_ = cur + (s) * 352 + ks * 4; \
        R##w = *(const LAS f32x4*)(bp_); R##k = *(const LAS f32x4*)(bp_ + 64); R##b = *(const LAS f32x4*)(bp_ + 128); R##q = *(const LAS f32x4*)(bp_ + 192); R##r = *(const LAS f32x4*)(bp_ + 256); \
        R##vv = cur[(s) * 352 + 320 + C.wave * 4 + rl]; } while (0)
#define SC_LO(v) ((f32x2){v[0], v[1]})
#define SC_HI(v) ((f32x2){v[2], v[3]})
#define SC_DPP(x, ctrl) __uint_as_float((unsigned)__builtin_amdgcn_update_dpp(0, (int)__float_as_uint(x), ctrl, 0xF, 0xF, true))
#define SC_STEP(R, P, s) do { \
        f32x2 pa = __builtin_elementwise_fma(Sb, SC_HI(R##k), Sa * SC_LO(R##k)), py = __builtin_elementwise_fma(Sb, SC_HI(P##r), Sa * SC_LO(P##r)); \
        float a_ = pa.x + pa.y, y_ = py.x + py.y; \
        a_ += SC_DPP(a_, 0xB1); y_ += SC_DPP(y_, 0xB1); a_ += SC_DPP(a_, 0x4E); y_ += SC_DPP(y_, 0x4E); \
        a_ += SC_DPP(a_, 0x141); y_ += SC_DPP(y_, 0x141); a_ += SC_DPP(a_, 0x140); y_ += SC_DPP(y_, 0x140); \
        ycol = (ks == ((s) & 15)) ? y_ : ycol; \
        const f32x2 na = {-a_, -a_}, vv2 = {R##vv, R##vv}; \
        Sa = __builtin_elementwise_fma(Sa, SC_LO(R##w), __builtin_elementwise_fma(na, SC_LO(R##b), vv2 * SC_LO(R##q))); \
        Sb = __builtin_elementwise_fma(Sb, SC_HI(R##w), __builtin_elementwise_fma(na, SC_HI(R##b), vv2 * SC_HI(R##q))); } while (0)
    f32x4 Aw, Ak, Ab, Aq, Ar, Bw, Bk, Bb, Bq, Br, Cw, Ck, Cb, Cq, Cr, Dw, Dk, Db, Dq, Dr; float Avv, Bvv, Cvv, Dvv;
    Dr = (f32x4){0.f, 0.f, 0.f, 0.f};
    for (int c = 0; c < NCH; ++c) {
        if (c + 1 < NCH) SCAN_LOADG(c + 1);
        {
            const LAS float* cur = buf + (c & 1) * (32 * 352);
            LAS float* yb = ybuf + (c & 1) * 1024 + C.wave * 4 + rl + ks * 32;
            SC_LD(A, 0); SC_LD(B, 1);
#pragma unroll 1
            for (int s = 0; s < 32; s += 4) {
                SC_LD(C, s + 2); __builtin_amdgcn_sched_barrier(0); SC_STEP(A, D, s); __builtin_amdgcn_sched_barrier(0);
                SC_LD(D, s + 3); __builtin_amdgcn_sched_barrier(0); SC_STEP(B, A, s + 1); __builtin_amdgcn_sched_barrier(0);
                SC_LD(A, s + 4); __builtin_amdgcn_sched_barrier(0); SC_STEP(C, B, s + 2); __builtin_amdgcn_sched_barrier(0);
                SC_LD(B, s + 5); __builtin_amdgcn_sched_barrier(0); SC_STEP(D, C, s + 3); __builtin_amdgcn_sched_barrier(0);
                if ((s & 15) == 12) yb[(s & 16) * 32] = ycol;
            }
        }
        if (c + 1 < NCH) SCAN_STORE((c + 1) & 1);
        __syncthreads();
        { const int row0_ = SCAN_ROW0(c);
#pragma unroll
          for (int i = 0; i < 2; ++i) { const int e = C.tid + NTHR * i, s = e >> 5, r = e & 31;
            const int row = (s > 0) ? row0_ + sgn * (s - 1) : scan_row(c * 32 - 1, b, d);
            if (s > 0 || c > 0) Y[(size_t)row * 768 + h * 64 + half * 32 + r] = ybuf[(c & 1) * 1024 + e]; } }
    }
    {
        f32x2 py = __builtin_elementwise_fma(Sb, SC_HI(Dr), Sa * SC_LO(Dr)); float y_ = py.x + py.y;
        y_ += SC_DPP(y_, 0xB1); y_ += SC_DPP(y_, 0x4E); y_ += SC_DPP(y_, 0x141); y_ += SC_DPP(y_, 0x140);
        if (ks == 0) Y[(size_t)scan_row(LKEYS - 1, b, d) * 768 + h * 64 + half * 32 + C.wave * 4 + rl] = y_;
    }
    __syncthreads();
    }
#undef SCAN_LOADG
#undef SCAN_STORE
#undef SCAN_ROW0
#undef SC_LD
#undef SC_STEP
#undef SC_LO
#undef SC_HI
#undef SC_DPP
}

constexpr int CSP = 72;
constexpr int CS_MAT = 64 * CSP * 2;
constexpr int CS_WT = 0, CS_KB = CS_MAT, CS_BB = 2 * CS_MAT, CS_RT = 3 * CS_MAT, CS_BHT = 4 * CS_MAT, CS_KHT = 5 * CS_MAT, CS_VMT = 6 * CS_MAT;
constexpr int CS_M2F = 7 * CS_MAT;
constexpr int CS_M1T = CS_M2F + 16384;
constexpr int CS_N2 = CS_M1T + CS_MAT;
constexpr int CS_GT = CS_N2 + CS_MAT;
constexpr int CS_Z = CS_M2F, CS_U = CS_M2F + CS_MAT;
constexpr int CS_GL = CS_GT + 2 * CS_MAT;
static_assert(CS_GL + 256 <= LDS_MISC, "chunked-scan LDS map");
__device__ __forceinline__ void cs_mma(f32x16& acc, const LAS unsigned char* Am, const LAS unsigned char* Bm, int ti, int tj, int r32, int hi) {
    const LAS unsigned char* ap = Am + (ti * 32 + r32) * (CSP * 2) + hi * 16; const LAS unsigned char* bp = Bm + (tj * 32 + r32) * (CSP * 2) + hi * 16;
#pragma unroll
    for (int ks = 0; ks < 4; ++ks) acc = __builtin_amdgcn_mfma_f32_32x32x16_bf16(*(const LAS bf16x8*)(ap + ks * 32), *(const LAS bf16x8*)(bp + ks * 32), acc, 0, 0, 0);
}
__device__ __forceinline__ void cs_store_t(LAS unsigned char* Om, const f32x16& acc, int ti, int tj, int r32, int hi) {
    LAS unsigned char* op = Om + (tj * 32 + r32) * (CSP * 2) + (ti * 32 + 4 * hi) * 2;
#pragma unroll
    for (int g = 0; g < 4; ++g) { u32x2 o; o.x = pk2(acc[4 * g], acc[4 * g + 1]); o.y = pk2(acc[4 * g + 2], acc[4 * g + 3]); *(LAS u32x2*)(op + g * 16) = o; }
}
#define CS_BAR() asm volatile("s_waitcnt lgkmcnt(0)\n\ts_barrier" ::: "memory")
__device__ __forceinline__ void phase_csa(const Ctx& C, const Args& A) {
    const unsigned char* SCN = A.ws + WS_SCN; unsigned char* CHK = A.ws + WS_CHK;
    LAS unsigned char* L = C.lds;
    const int r32 = C.lane & 31, hi = C.lane >> 5;
    float lwv[8]; u32x4 ukk, ub, ukr, ur, uv;
#define CSA_GEOM(cu_) const int unit = (cu_) / CS_NCH, ch = (cu_) % CS_NCH; const int d = unit & 1, h = (unit >> 1) % 12, b = unit / 24; \
        const int step0 = ch * CS_L; const int sgn = d ? -1 : 1; \
        const int row0 = (step0 < CTXL) ? (NLAT + b * CTXL + (d ? CTXL - 1 - step0 : step0)) : (b * TT + (d ? TT - 1 - (step0 - CTXL) : step0 - CTXL)); \
        const unsigned char* rec0 = SCN + (size_t)row0 * SC_ROW + (size_t)h * SC_REC;
#define CSA_LOAD(cu_) do { CSA_GEOM(cu_); \
        { const int k = C.tid & 63, sg = C.tid >> 6; _Pragma("unroll") for (int j = 0; j < 8; ++j) lwv[j] = *(const float*)(rec0 + (long)sgn * (8 * sg + j) * SC_ROW + SC_W + 256 * d + k * 4); } \
        { const int t = C.tid >> 3, k0 = (C.tid & 7) * 8; const unsigned char* rp = rec0 + (long)sgn * t * SC_ROW; \
          ukk = *(const u32x4*)(rp + SC_KK + k0 * 2); ub = *(const u32x4*)(rp + SC_B + 256 * d + k0 * 2); ukr = *(const u32x4*)(rp + SC_KR + 256 * d + k0 * 2); ur = *(const u32x4*)(rp + SC_R + k0 * 2); uv = *(const u32x4*)(rp + SC_V + k0 * 2); } } while (0)
    if ((int)blockIdx.x < CS_UNITS * CS_NCH) CSA_LOAD((int)blockIdx.x);
    for (int cu = blockIdx.x; cu < CS_UNITS * CS_NCH; cu += C.G) {
        LAS float* csf = (LAS float*)(L + CS_M2F);
        LAS float* seg = (LAS float*)(L + CS_M1T);
        { const int k = C.tid & 63, sg = C.tid >> 6;
#pragma unroll
          for (int j = 1; j < 8; ++j) lwv[j] += lwv[j - 1];
          seg[sg * 64 + k] = lwv[7];
          CS_BAR();
          float off = 0.f, tot = 0.f;
#pragma unroll
          for (int s2 = 0; s2 < 8; ++s2) { const float v = seg[s2 * 64 + k]; off += (s2 < sg) ? v : 0.f; tot += v; }
#pragma unroll
          for (int j = 0; j < 8; ++j) csf[(8 * sg + j) * 64 + k] = lwv[j] + off;
          if (sg == 7) ((LAS float*)(L + CS_GL))[k] = __expf(tot); }
        CS_BAR();
        { const int t = C.tid >> 3, k0 = (C.tid & 7) * 8;
          float wt[8], kb[8], bb[8], rt[8], bh[8], kh[8];
#pragma unroll
          for (int j = 0; j < 8; ++j) { const unsigned pkk = j < 2 ? ukk.x : j < 4 ? ukk.y : j < 6 ? ukk.z : ukk.w, pb = j < 2 ? ub.x : j < 4 ? ub.y : j < 6 ? ub.z : ub.w, pkr = j < 2 ? ukr.x : j < 4 ? ukr.y : j < 6 ? ukr.z : ukr.w, pr = j < 2 ? ur.x : j < 4 ? ur.y : j < 6 ? ur.z : ur.w;
              const float kkv = (j & 1) ? bfhi(pkk) : bflo(pkk), bv = (j & 1) ? bfhi(pb) : bflo(pb), krv = (j & 1) ? bfhi(pkr) : bflo(pkr), rv = (j & 1) ? bfhi(pr) : bflo(pr);
              const float cst = csf[t * 64 + k0 + j], csp = t > 0 ? csf[(t - 1) * 64 + k0 + j] : 0.f, csl = csf[63 * 64 + k0 + j];
              const float einv = __expf(-cst), el = __expf(csl - cst);
              wt[j] = kkv * __expf(csp); kb[j] = krv * einv; bb[j] = bv * einv; rt[j] = rv * __expf(cst); bh[j] = bv * el; kh[j] = krv * el; }
          u32x4 o;
          o.x = pk2(wt[0], wt[1]); o.y = pk2(wt[2], wt[3]); o.z = pk2(wt[4], wt[5]); o.w = pk2(wt[6], wt[7]); *(LAS u32x4*)(L + CS_WT + t * (CSP * 2) + k0 * 2) = o;
          o.x = pk2(kb[0], kb[1]); o.y = pk2(kb[2], kb[3]); o.z = pk2(kb[4], kb[5]); o.w = pk2(kb[6], kb[7]); *(LAS u32x4*)(L + CS_KB + t * (CSP * 2) + k0 * 2) = o;
          o.x = pk2(bb[0], bb[1]); o.y = pk2(bb[2], bb[3]); o.z = pk2(bb[4], bb[5]); o.w = pk2(bb[6], bb[7]); *(LAS u32x4*)(L + CS_BB + t * (CSP * 2) + k0 * 2) = o;
          o.x = pk2(rt[0], rt[1]); o.y = pk2(rt[2], rt[3]); o.z = pk2(rt[4], rt[5]); o.w = pk2(rt[6], rt[7]); *(LAS u32x4*)(L + CS_RT + t * (CSP * 2) + k0 * 2) = o;
#pragma unroll
          for (int j = 0; j < 8; ++j) { *(LAS bf16_t*)(L + CS_BHT + (k0 + j) * (CSP * 2) + t * 2) = (bf16_t)f2bf(bh[j]); *(LAS bf16_t*)(L + CS_KHT + (k0 + j) * (CSP * 2) + t * 2) = (bf16_t)f2bf(kh[j]);
              const unsigned pv = j < 2 ? uv.x : j < 4 ? uv.y : j < 6 ? uv.z : uv.w; *(LAS bf16_t*)(L + CS_VMT + (k0 + j) * (CSP * 2) + t * 2) = (bf16_t)((j & 1) ? (pv >> 16) : (pv & 0xffffu)); } }
        if (cu + C.G < CS_UNITS * CS_NCH) CSA_LOAD(cu + C.G);
        CS_BAR();
        for (int job = C.wave; job < 12; job += NWAVES) { const int p = job >> 2, ti = (job >> 1) & 1, tj = job & 1;
            f32x16 acc;
#pragma unroll
            for (int i = 0; i < 16; ++i) acc[i] = 0.f;
            if (p == 0) { cs_mma(acc, L + CS_WT, L + CS_BB, ti, tj, r32, hi);
                const int i = tj * 32 + r32; LAS float* mp = (LAS float*)(L + CS_M2F) + i * 64;
#pragma unroll
                for (int reg = 0; reg < 16; ++reg) { const int t = ti * 32 + crow(reg, hi); mp[(t & 3) * 16 + (t >> 2)] = (i < t) ? acc[reg] : 0.f; } }
            else if (p == 1) { cs_mma(acc, L + CS_WT, L + CS_KB, ti, tj, r32, hi);
                const int i = tj * 32 + r32;
#pragma unroll
                for (int reg = 0; reg < 16; ++reg) { const int t = ti * 32 + crow(reg, hi); acc[reg] = (i < t) ? acc[reg] : 0.f; }
                cs_store_t(L + CS_M1T, acc, ti, tj, r32, hi); }
            else { cs_mma(acc, L + CS_BB, L + CS_RT, ti, tj, r32, hi);
                const int t = tj * 32 + r32;
#pragma unroll
                for (int reg = 0; reg < 16; ++reg) { const int i = ti * 32 + crow(reg, hi); acc[reg] = (i <= t) ? acc[reg] : 0.f; }
                cs_store_t(L + CS_N2, acc, ti, tj, r32, hi); } }
        CS_BAR();
        { const int c = C.tid >> 2, q = C.tid & 3; float acc[16];
          { const LAS unsigned char* rcol = (c < 64) ? (L + CS_WT + c * 2) : (L + CS_M1T + (c - 64) * (CSP * 2)); const int rstride = (c < 64) ? CSP * 2 : 2;
#pragma unroll
            for (int j = 0; j < 16; ++j) acc[j] = bf2f(*(const LAS bf16_t*)(rcol + (4 * j + q) * rstride)); }
          const LAS float* m2c = (const LAS float*)(L + CS_M2F) + q * 16;
#pragma clang loop unroll(full)
          for (int i = 0; i < 64; ++i) {
              const float mine = -acc[i >> 2];
              float gi;
              switch (i & 3) { case 0: gi = __uint_as_float((unsigned)__builtin_amdgcn_update_dpp(0, (int)__float_as_uint(mine), 0x00, 0xF, 0xF, true)); break;
                               case 1: gi = __uint_as_float((unsigned)__builtin_amdgcn_update_dpp(0, (int)__float_as_uint(mine), 0x55, 0xF, 0xF, true)); break;
                               case 2: gi = __uint_as_float((unsigned)__builtin_amdgcn_update_dpp(0, (int)__float_as_uint(mine), 0xAA, 0xF, 0xF, true)); break;
                               default: gi = __uint_as_float((unsigned)__builtin_amdgcn_update_dpp(0, (int)__float_as_uint(mine), 0xFF, 0xF, 0xF, true)); break; }
#pragma unroll
              for (int j4 = (i >> 4); j4 < 4; ++j4) { const f32x4 m = *(const LAS f32x4*)(m2c + i * 64 + j4 * 4);
#pragma unroll
                  for (int e = 0; e < 4; ++e) if (4 * j4 + e >= (i >> 2)) acc[4 * j4 + e] += m[e] * gi; }
          }
#pragma unroll
          for (int j = 0; j < 16; ++j) *(LAS bf16_t*)(L + CS_GT + c * (CSP * 2) + (4 * j + q) * 2) = (bf16_t)f2bf(-acc[j]); }
        CS_BAR();
        unsigned char* outp = CHK + (size_t)cu * 32768;
        for (int job = C.wave; job < 16; job += NWAVES) { const int p = job >> 2, ti = (job >> 1) & 1, tj = job & 1;
            f32x16 acc;
            if (p == 0) {
                const LAS unsigned char* rp = L + CS_RT + (tj * 32 + r32) * (CSP * 2) + (ti * 32 + 4 * hi) * 2;
#pragma unroll
                for (int g = 0; g < 4; ++g) { const u32x2 u = *(const LAS u32x2*)(rp + g * 16); acc[4 * g] = bflo(u.x); acc[4 * g + 1] = bfhi(u.x); acc[4 * g + 2] = bflo(u.y); acc[4 * g + 3] = bfhi(u.y); }
                cs_mma(acc, L + CS_GT, L + CS_N2, ti, tj, r32, hi);
#pragma unroll
                for (int g = 0; g < 4; ++g) { u32x2 o; o.x = pk2(acc[4 * g], acc[4 * g + 1]); o.y = pk2(acc[4 * g + 2], acc[4 * g + 3]);
                    *(u32x2*)(outp + 8192 + (((tj * 4 + 2 * ti + (g >> 1)) * 64 + (g & 1) * 32 + r32) * 16) + hi * 8) = o; } }
            else if (p == 1) {
#pragma unroll
                for (int i = 0; i < 16; ++i) acc[i] = 0.f;
                cs_mma(acc, L + CS_KB, L + CS_RT, ti, tj, r32, hi);
                const int t = tj * 32 + r32;
#pragma unroll
                for (int reg = 0; reg < 16; ++reg) { const int i = ti * 32 + crow(reg, hi); acc[reg] = (i <= t) ? acc[reg] : 0.f; }
                cs_mma(acc, L + CS_GT + 64 * (CSP * 2), L + CS_N2, ti, tj, r32, hi);
                cs_store_t(L + CS_Z, acc, ti, tj, r32, hi); }
            else if (p == 2) {
#pragma unroll
                for (int i = 0; i < 16; ++i) acc[i] = 0.f;
                cs_mma(acc, L + CS_GT, L + CS_BHT, ti, tj, r32, hi);
                const int k = tj * 32 + r32; const float gl = ((const LAS float*)(L + CS_GL))[k];
#pragma unroll
                for (int reg = 0; reg < 16; ++reg) { const int cc = ti * 32 + crow(reg, hi); acc[reg] += (cc == k) ? gl : 0.f; }
#pragma unroll
                for (int g = 0; g < 4; ++g) { u32x2 o; o.x = pk2(acc[4 * g], acc[4 * g + 1]); o.y = pk2(acc[4 * g + 2], acc[4 * g + 3]);
                    *(u32x2*)(outp + (((tj * 4 + 2 * ti + (g >> 1)) * 64 + (g & 1) * 32 + r32) * 16) + hi * 8) = o; } }
            else {
                const LAS unsigned char* kp = L + CS_KHT + (tj * 32 + r32) * (CSP * 2) + (ti * 32 + 4 * hi) * 2;
#pragma unroll
                for (int g = 0; g < 4; ++g) { const u32x2 u = *(const LAS u32x2*)(kp + g * 16); acc[4 * g] = bflo(u.x); acc[4 * g + 1] = bfhi(u.x); acc[4 * g + 2] = bflo(u.y); acc[4 * g + 3] = bfhi(u.y); }
                cs_mma(acc, L + CS_GT + 64 * (CSP * 2), L + CS_BHT, ti, tj, r32, hi);
                cs_store_t(L + CS_U, acc, ti, tj, r32, hi); } }
        CS_BAR();
        { const int p = C.wave >> 2, ti = (C.wave >> 1) & 1, tj = C.wave & 1;
          f32x16 acc;
#pragma unroll
          for (int i = 0; i < 16; ++i) acc[i] = 0.f;
          cs_mma(acc, L + (p ? CS_U : CS_Z), L + CS_VMT, ti, tj, r32, hi);
          unsigned char* op = outp + (p ? 16384 : 24576) + ((ti * 2 + tj) * 64 + C.lane) * 32;
          u32x4 o0, o1; o0.x = pk2(acc[0], acc[1]); o0.y = pk2(acc[2], acc[3]); o0.z = pk2(acc[4], acc[5]); o0.w = pk2(acc[6], acc[7]);
          o1.x = pk2(acc[8], acc[9]); o1.y = pk2(acc[10], acc[11]); o1.z = pk2(acc[12], acc[13]); o1.w = pk2(acc[14], acc[15]);
          *(u32x4*)op = o0; *(u32x4*)(op + 16) = o1; }
        CS_BAR();
    }
}
__device__ __forceinline__ void phase_csb(const Ctx& C, const Args& A, int l) {
    if ((int)blockIdx.x >= CS_UNITS) { conv_items(C, A, l + 1, ((int)blockIdx.x - CS_UNITS) * NWAVES + C.wave, (C.G - CS_UNITS) * NWAVES, true, false, true); return; }
    const unsigned char* CHK = A.ws + WS_CHK;
    LAS unsigned char* L = C.lds;
    const int r32 = C.lane & 31, hi = C.lane >> 5;
    const bool isS = C.wave < 4; const int ti = (C.wave >> 1) & 1, tj = C.wave & 1;
    for (int unit = blockIdx.x; unit < CS_UNITS; unit += C.G) {
        const int d = unit & 1, h = (unit >> 1) % 12, b = unit / 24;
        float* Y = (float*)(A.ws + WS_Y) + (size_t)d * MROWS * 768;
        for (int i = C.tid; i < 2 * CS_MAT / 4; i += NTHR) ((LAS unsigned*)L)[i] = 0u;
        CS_BAR();
        bf16x8 afA[4], afB[4], afC[4]; u32x4 cA0, cA1, cB0, cB1, cC0, cC1;
#define CSB_LOAD(A4, C0, C1, ch_) do { const unsigned char* op_ = CHK + ((size_t)unit * CS_NCH + (ch_)) * 32768; \
            const unsigned char* am_ = op_ + (isS ? 0 : 8192) + (ti * 4 * 64 + C.lane) * 16;     \
            _Pragma("unroll") for (int ks = 0; ks < 4; ++ks) A4[ks] = *(const bf16x8*)(am_ + ks * 1024); \
            const unsigned char* cp_ = op_ + (isS ? 16384 : 24576) + ((ti * 2 + tj) * 64 + C.lane) * 32; C0 = *(const u32x4*)cp_; C1 = *(const u32x4*)(cp_ + 16); } while (0)
#define CSB_STEP(A4, C0, C1, ch_) do { \
            const LAS unsigned char* Sb = L + ((ch_) & 1) * CS_MAT; LAS unsigned char* Sn = L + (((ch_) + 1) & 1) * CS_MAT; \
            f32x16 acc; \
            acc[0] = bflo(C0.x); acc[1] = bfhi(C0.x); acc[2] = bflo(C0.y); acc[3] = bfhi(C0.y); acc[4] = bflo(C0.z); acc[5] = bfhi(C0.z); acc[6] = bflo(C0.w); acc[7] = bfhi(C0.w); \
            acc[8] = bflo(C1.x); acc[9] = bfhi(C1.x); acc[10] = bflo(C1.y); acc[11] = bfhi(C1.y); acc[12] = bflo(C1.z); acc[13] = bfhi(C1.z); acc[14] = bflo(C1.w); acc[15] = bfhi(C1.w); \
            const LAS unsigned char* bp = Sb + (tj * 32 + r32) * (CSP * 2) + hi * 16; \
            _Pragma("unroll") for (int ks = 0; ks < 4; ++ks) acc = __builtin_amdgcn_mfma_f32_32x32x16_bf16(A4[ks], *(const LAS bf16x8*)(bp + ks * 32), acc, 0, 0, 0); \
            if (isS) { cs_store_t(Sn, acc, ti, tj, r32, hi); }     \
            else {     \
                const int step0 = (ch_) * CS_L; const int sgn = d ? -1 : 1; \
                const int row0 = (step0 < CTXL) ? (NLAT + b * CTXL + (d ? CTXL - 1 - step0 : step0)) : (b * TT + (d ? TT - 1 - (step0 - CTXL) : step0 - CTXL)); \
                float* yp = Y + (size_t)(row0 + sgn * (ti * 32 + 4 * hi)) * 768 + h * 64 + tj * 32 + r32; const long ys = (long)sgn * 768; \
                _Pragma("unroll") for (int reg = 0; reg < 16; ++reg) yp[ys * ((reg & 3) + 8 * (reg >> 2))] = acc[reg]; } \
            CS_BAR(); } while (0)
        CSB_LOAD(afA, cA0, cA1, 0); CSB_LOAD(afB, cB0, cB1, 1);
        static_assert(CS_NCH % 3 == 0, "chunk loop is unrolled by three");
        for (int ch = 0; ch < CS_NCH; ch += 3) {
            if (ch == 0) CSB_LOAD(afC, cC0, cC1, 2);
            CSB_STEP(afA, cA0, cA1, ch);     if (ch + 3 < CS_NCH) CSB_LOAD(afA, cA0, cA1, ch + 3);
            CSB_STEP(afB, cB0, cB1, ch + 1); if (ch + 4 < CS_NCH) CSB_LOAD(afB, cB0, cB1, ch + 4);
            CSB_STEP(afC, cC0, cC1, ch + 2); if (ch + 5 < CS_NCH) CSB_LOAD(afC, cC0, cC1, ch + 5);
        }
        CS_BAR();
    }
#undef CSB_LOAD
#undef CSB_STEP
}

#undef CS_BAR
__device__ __forceinline__ void phase_ef2(const Ctx& C, const Args& A, int l) {
    const int i2 = l >> 1; unsigned char* ws = A.ws;
    const unsigned char* SCN = ws + WS_SCN; const float* Y0 = (const float*)(ws + WS_Y); const float* Y1 = Y0 + (size_t)MROWS * 768;
    const bf16_t* G = (const bf16_t*)(ws + WS_G); bf16_t* A2 = (bf16_t*)(ws + WS_A2);
    const float* rb = A.in[I_RBON] + (size_t)i2 * 768; const float* gg = A.in[I_GNG] + (size_t)i2 * 768; const float* gb = A.in[I_GNB] + (size_t)i2 * 768;
    for (int row = C.gw; row < MROWS; row += C.NGW) {
#pragma unroll
        for (int it = 0; it < 3; ++it) {
            const int c = it * 256 + 4 * C.lane, head = c >> 6, kx = c & 63;
            const f32x4 y = *(const f32x4*)(Y0 + (size_t)row * 768 + c) + *(const f32x4*)(Y1 + (size_t)row * 768 + c);
            const float mean = sum16((y[0] + y[1]) + (y[2] + y[3])) * (1.f / 64.f);
            const f32x4 dd = y - mean;
            const float var = sum16((dd[0] * dd[0] + dd[1] * dd[1]) + (dd[2] * dd[2] + dd[3] * dd[3])) * (1.f / 64.f);
            const float rstd = rsqrtf(var + GN_EPS);
            const unsigned char* base = SCN + (size_t)(row * 12 + head) * SC_REC + kx * 2;
            const f32x4 r = ld4bf_(base + SC_R), v = ld4bf_(base + SC_V), k0 = ld4bf_(base + SC_KR), k1 = ld4bf_(base + SC_KR + 256);
            const f32x4 rb4 = *(const f32x4*)(rb + c);
            const f32x4 t = r * (k0 + k1) * 0.5f * rb4;
            const float bs = sum16((t[0] + t[1]) + (t[2] + t[3]));
            const f32x4 yn = dd * rstd * *(const f32x4*)(gg + c) + *(const f32x4*)(gb + c);
            const f32x4 g = ld4bf(G + (size_t)row * 768 + c);
            st4bf(A2 + (size_t)row * DM + 256 + c, g * (yn + v * bs));
        }
    }
}

__device__ __forceinline__ void phase_of1(const Ctx& C, const Args& A, int l) {
    const int i2 = l >> 1; unsigned char* ws = A.ws;
    const bf16_t* P = (const bf16_t*)(ws + WS_P); bf16_t* A2 = (bf16_t*)(ws + WS_A2); bf16_t* VT = (bf16_t*)(ws + WS_VT);
    const float* lng = A.in[I_GLNG] + (size_t)i2 * 256; const float* lnb = A.in[I_GLNB] + (size_t)i2 * 256;
    const float* gws = A.in[I_GWS] + (size_t)i2 * 4 * 128 * 128; const float* gbs = A.in[I_GBS] + (size_t)i2 * 4 * 128;
    LAS bf16_t* vt = (LAS bf16_t*)C.lds;
    LAS bf16_t* uL = (LAS bf16_t*)C.lds;
    LAS bf16_t* vT = (LAS bf16_t*)(C.lds + 128 * 528);
    const int r32 = C.lane & 31, hi = C.lane >> 5;
    for (int u = blockIdx.x; u < 264; u += C.G) {
        const bool isctx = u >= 256; const int uc = u - 256;
        const int b = isctx ? (uc >> 1) : (u >> 6), pos0 = isctx ? (uc & 1) * 128 : (u & 63) * 128;
        const int row0 = isctx ? NLAT + b * CTXL + pos0 : b * TT + pos0, L0 = isctx ? pos0 : CTXL + pos0;
        for (int hh = 0; hh < 6; ++hh) {
#pragma unroll
            for (int i = 0; i < 4; ++i) { const int piece = C.tid + NTHR * i, r = piece >> 4, part = piece & 15;
                *(LAS u32x4*)(vt + r * 136 + part * 8) = *(const u32x4*)(P + (size_t)(row0 + r) * P_LD + 1536 + hh * 128 + part * 8); }
            __syncthreads();
#pragma unroll
            for (int i = 0; i < 4; ++i) { const int item = C.tid + NTHR * i, d = item >> 4, tg = item & 15; const LAS bf16_t* s = vt + (tg * 8) * 136 + d;
                u32x4 o; o.x = (unsigned)s[0] | ((unsigned)s[136] << 16); o.y = (unsigned)s[2 * 136] | ((unsigned)s[3 * 136] << 16);
                o.z = (unsigned)s[4 * 136] | ((unsigned)s[5 * 136] << 16); o.w = (unsigned)s[6 * 136] | ((unsigned)s[7 * 136] << 16);
                *(u32x4*)(VT + ((size_t)(b * 6 + hh) * 128 + d) * LKEYS + L0 + tg * 8) = o; }
            __syncthreads();
        }
        for (int r = C.wave; r < 128; r += NWAVES) {
            const int c4 = 4 * C.lane; const bf16_t* pr = P + (size_t)(row0 + r) * P_LD + 2304;
            const f32x4 ur = ld4bf(pr + c4), raw = ld4bf(pr + 256 + c4);
            { const f32x4 gu = {gelu_erf(ur[0]), gelu_erf(ur[1]), gelu_erf(ur[2]), gelu_erf(ur[3])}; u32x2 o; o.x = pk2(gu[0], gu[1]); o.y = pk2(gu[2], gu[3]); *(LAS u32x2*)(uL + r * 264 + c4) = o; }
            const f32x4 gv = {gelu_erf(raw[0]), gelu_erf(raw[1]), gelu_erf(raw[2]), gelu_erf(raw[3])};
            const float mean = wave_sum((gv[0] + gv[1]) + (gv[2] + gv[3])) * (1.f / 256.f); const f32x4 dd = gv - mean;
            const float var = wave_sum((dd[0] * dd[0] + dd[1] * dd[1]) + (dd[2] * dd[2] + dd[3] * dd[3])) * (1.f / 256.f); const float rstd = rsqrtf(var + LN_EPS);
            const f32x4 o = dd * rstd * *(const f32x4*)(lng + c4) + *(const f32x4*)(lnb + c4);
#pragma unroll
            for (int k = 0; k < 4; ++k) vT[(c4 + k) * 136 + r] = (bf16_t)f2bf(o[k]);
        }
        __syncthreads();
        {
            const int g = C.wave >> 1, cblk = C.wave & 1, cc = g * 64 + cblk * 32 + r32;
            for (int pblk = 0; pblk < 4; ++pblk) {
                f32x16 acc;
#pragma unroll
                for (int i = 0; i < 16; ++i) acc[i] = 0.f;
                const float* wrow = gws + ((size_t)g * 128 + pblk * 32 + r32) * 128 + 8 * hi;
#pragma unroll
                for (int ks = 0; ks < 8; ++ks) { const f32x4 w0 = *(const f32x4*)(wrow + ks * 16), w1 = *(const f32x4*)(wrow + ks * 16 + 4);
                    u32x4 au; au.x = pk2(w0[0], w0[1]); au.y = pk2(w0[2], w0[3]); au.z = pk2(w1[0], w1[1]); au.w = pk2(w1[2], w1[3]);
                    const bf16x8 bf = *(const LAS bf16x8*)(vT + cc * 136 + ks * 16 + 8 * hi);
                    acc = __builtin_amdgcn_mfma_f32_32x32x16_bf16(__builtin_bit_cast(bf16x8, au), bf, acc, 0, 0, 0); }
#pragma unroll
                for (int reg = 0; reg < 16; ++reg) { const int p = pblk * 32 + crow(reg, hi);
                    const float uu = bf2f(uL[p * 264 + cc]); const float mixed = acc[reg] + gbs[g * 128 + p];
                    uL[p * 264 + cc] = (bf16_t)f2bf(uu * mixed); }
            }
        }
        __syncthreads();
#pragma unroll
        for (int i = 0; i < 8; ++i) { const int piece = C.tid + NTHR * i, r = piece >> 5, part = piece & 31;
            *(u32x4*)(A2 + (size_t)(row0 + r) * DM + 768 + part * 8) = *(const LAS u32x4*)(uL + r * 264 + part * 8); }
        __syncthreads();
    }
}

__device__ __forceinline__ void phase_attn(const Ctx& C, const Args& A, int l) {
    const int i2 = l >> 1; unsigned char* ws = A.ws;
    const bf16_t* Q = (const bf16_t*)(ws + WS_Q); const bf16_t* KA = (const bf16_t*)(ws + WS_KA); const bf16_t* VT = (const bf16_t*)(ws + WS_VT); bf16_t* A2 = (bf16_t*)(ws + WS_A2);
    const float lam_init = 0.8f - 0.6f * expf(-0.3f * (float)l);
    float s1 = 0.f, s2 = 0.f;
    for (int j = 0; j < 64; ++j) { s1 += A.in[I_LQ1][i2 * 64 + j] * A.in[I_LK1][i2 * 64 + j]; s2 += A.in[I_LQ2][i2 * 64 + j] * A.in[I_LK2][i2 * 64 + j]; }
    const float lam = expf(s1) - expf(s2) + lam_init;
    const float* subg = A.in[I_SUBG] + (size_t)i2 * 128;
    const int r32 = C.lane & 31, hi = C.lane >> 5, map = C.wave >> 2, qw = C.wave & 3;
    LAS unsigned char* Kt = C.lds; LAS unsigned char* Vt = C.lds + 2 * 17408; LAS float* xch = (LAS float*)C.lds;
    const int NU = 1536 + (l == 1 ? 48 : 0);
    for (int n = C.vcu; n < NU; n += C.G) {
        int bh, qt; bool isctx = false;
        if (n < 1536) { const int round = n >> 8, slot = n & 255; bh = (slot >> 5) * 3 + (round >> 1); qt = (round & 1) * 32 + (slot & 31); }
        else { isctx = true; bh = (n - 1536) >> 1; qt = (n - 1536) & 1; }
        const int b = bh / 6, h = bh % 6;
        const int qrow0 = isctx ? NLAT + b * CTXL + qt * 128 : b * TT + qt * 128;
        const int NT = isctx ? CTXL / 64 : LKEYS / 64;
        const bf16_t* Kb = KA + (size_t)b * LKEYS * 768 + h * 128;
        const bf16_t* Vb = VT + (size_t)(b * 6 + h) * 128 * LKEYS;
        bf16x8 qf[4];
        { const bf16_t* qp = Q + (size_t)(qrow0 + qw * 32 + r32) * 768 + h * 128 + map * 64 + 8 * hi;
#pragma unroll
          for (int ks = 0; ks < 4; ++ks) qf[ks] = *(const bf16x8*)(qp + ks * 16); }
        f32x16 O[4];
#pragma unroll
        for (int d = 0; d < 4; ++d)
#pragma unroll
            for (int i = 0; i < 16; ++i) O[d][i] = 0.f;
        float m = 0.f, lsum = 0.f;
        u32x4 kreg[2], vreg[2];
#define AT_LOAD(t) do { _Pragma("unroll") for (int i = 0; i < 2; ++i) { const int piece = C.tid + NTHR * i; \
            kreg[i] = *(const u32x4*)(Kb + (size_t)((t) * 64 + (piece >> 4)) * 768 + (piece & 15) * 8); \
            vreg[i] = *(const u32x4*)(Vb + (size_t)(piece >> 3) * LKEYS + (t) * 64 + (piece & 7) * 8); } } while (0)
#define AT_STORE(bi) do { _Pragma("unroll") for (int i = 0; i < 2; ++i) { const int piece = C.tid + NTHR * i; \
            *(LAS u32x4*)(Kt + (bi) * 17408 + (piece >> 4) * 272 + (piece & 15) * 16) = kreg[i]; \
            LAS unsigned char* vd = Vt + (bi) * 17408 + (piece >> 3) * 136 + (piece & 7) * 16; \
            *(LAS u32x2*)vd = (u32x2){vreg[i].x, vreg[i].y}; *(LAS u32x2*)(vd + 8) = (u32x2){vreg[i].z, vreg[i].w}; } } while (0)
        AT_LOAD(0); AT_STORE(0); __syncthreads();
        for (int t = 0; t < NT; ++t) {
            if (t + 1 < NT) AT_LOAD(t + 1);
            const int bi = t & 1;
            const LAS unsigned char* kb = Kt + bi * 17408 + r32 * 272 + map * 128 + hi * 16;
            const LAS unsigned char* vb = Vt + bi * 17408 + r32 * 136 + hi * 8;
            bf16x8 kf[8];
#pragma unroll
            for (int ks = 0; ks < 4; ++ks) { kf[2 * ks] = *(const LAS bf16x8*)(kb + ks * 32); kf[2 * ks + 1] = *(const LAS bf16x8*)(kb + 32 * 272 + ks * 32); }
            u32x4 va[4], vc[4];
#define AT_LDV(dst, d) do { _Pragma("unroll") for (int kst = 0; kst < 4; ++kst) { const LAS unsigned char* vp = vb + (d) * (32 * 136) + kst * 32; \
                const u32x2 lo = *(const LAS u32x2*)vp, hh = *(const LAS u32x2*)(vp + 16); dst[kst] = (u32x4){lo.x, lo.y, hh.x, hh.y}; } } while (0)
#define AT_PV(src, d) do { _Pragma("unroll") for (int kst = 0; kst < 4; ++kst) O[d] = __builtin_amdgcn_mfma_f32_32x32x16_bf16(__builtin_bit_cast(bf16x8, src[kst]), pb[kst], O[d], 0, 0, 0); } while (0)
            AT_LDV(va, 0);
            __builtin_amdgcn_sched_barrier(0);
            f32x16 p0, p1;
            { const float nm = -m;
#pragma unroll
              for (int i = 0; i < 16; ++i) { p0[i] = nm; p1[i] = nm; } }
#pragma unroll
            for (int ks = 0; ks < 4; ++ks) { p0 = __builtin_amdgcn_mfma_f32_32x32x16_bf16(kf[2 * ks], qf[ks], p0, 0, 0, 0); p1 = __builtin_amdgcn_mfma_f32_32x32x16_bf16(kf[2 * ks + 1], qf[ks], p1, 0, 0, 0); }
            asm volatile("s_nop 15\n\ts_nop 7" : "+v"(p0), "+v"(p1));
            float mx = max3f(p0[0], p0[1], p1[0]), mx2 = max3f(p0[2], p0[3], p1[1]); mx = max3f(mx, p1[2], p1[3]);
#pragma unroll
            for (int i = 4; i < 16; i += 4) { mx = max3f(mx, p0[i], p0[i + 1]); mx2 = max3f(mx2, p0[i + 2], p0[i + 3]); mx = max3f(mx, p1[i], p1[i + 1]); mx2 = max3f(mx2, p1[i + 2], p1[i + 3]); }
            mx = fmaxf(mx, mx2);
            { auto rr = __builtin_amdgcn_permlane32_swap(__float_as_uint(mx), __float_as_uint(mx), false, false); mx = fmaxf(__uint_as_float(rr[0]), __uint_as_float(rr[1])); }
            if (t == 0 || __any(mx > 8.f)) { const float dl = (t == 0) ? mx : fmaxf(mx, 0.f); const float sc = __builtin_amdgcn_exp2f(-dl); lsum *= sc;
#pragma unroll
                for (int d = 0; d < 4; ++d)
#pragma unroll
                    for (int i = 0; i < 16; ++i) O[d][i] *= sc;
#pragma unroll
                for (int i = 0; i < 16; ++i) { p0[i] -= dl; p1[i] -= dl; }
                m += dl; }
            float ps = 0.f, ps2 = 0.f;
#pragma unroll
            for (int i = 0; i < 16; ++i) { p0[i] = __builtin_amdgcn_exp2f(p0[i]); p1[i] = __builtin_amdgcn_exp2f(p1[i]); ps += p0[i]; ps2 += p1[i]; }
            lsum += ps + ps2;
            bf16x8 pb[4];
            { u32x4 w; w.x = pk2(p0[0], p0[1]); w.y = pk2(p0[2], p0[3]); w.z = pk2(p0[4], p0[5]); w.w = pk2(p0[6], p0[7]); pb[0] = __builtin_bit_cast(bf16x8, w);
              w.x = pk2(p0[8], p0[9]); w.y = pk2(p0[10], p0[11]); w.z = pk2(p0[12], p0[13]); w.w = pk2(p0[14], p0[15]); pb[1] = __builtin_bit_cast(bf16x8, w);
              w.x = pk2(p1[0], p1[1]); w.y = pk2(p1[2], p1[3]); w.z = pk2(p1[4], p1[5]); w.w = pk2(p1[6], p1[7]); pb[2] = __builtin_bit_cast(bf16x8, w);
              w.x = pk2(p1[8], p1[9]); w.y = pk2(p1[10], p1[11]); w.z = pk2(p1[12], p1[13]); w.w = pk2(p1[14], p1[15]); pb[3] = __builtin_bit_cast(bf16x8, w); }
            __builtin_amdgcn_sched_barrier(0);
            AT_LDV(vc, 1); __builtin_amdgcn_sched_barrier(0); AT_PV(va, 0); __builtin_amdgcn_sched_barrier(0);
            AT_LDV(va, 2); __builtin_amdgcn_sched_barrier(0); AT_PV(vc, 1); __builtin_amdgcn_sched_barrier(0);
            AT_LDV(vc, 3); __builtin_amdgcn_sched_barrier(0); AT_PV(va, 2); __builtin_amdgcn_sched_barrier(0);
            AT_PV(vc, 3);
            if (t + 1 < NT) AT_STORE((t + 1) & 1);
            __syncthreads();
        }
#undef AT_LDV
#undef AT_PV
#undef AT_LOAD
#undef AT_STORE
        const float ltot = lsum + __shfl_xor(lsum, 32);
        const float invl = 1.f / ltot;
        if (map == 1) { const float f = lam * invl;
#pragma unroll
            for (int d = 0; d < 4; ++d)
#pragma unroll
                for (int i = 0; i < 16; ++i) xch[(qw * 64 + d * 16 + i) * 64 + C.lane] = O[d][i] * f; }
        __syncthreads();
        if (map == 0) { float ss = 0.f;
#pragma unroll
            for (int d = 0; d < 4; ++d)
#pragma unroll
                for (int i = 0; i < 16; ++i) { const float o = O[d][i] * invl - xch[(qw * 64 + d * 16 + i) * 64 + C.lane]; O[d][i] = o; ss += o * o; }
            ss += __shfl_xor(ss, 32);
            const float rn = rsqrtf(ss * (1.f / 128.f) + RMS_EPS) * (1.f - lam_init);
            bf16_t* orow = A2 + (size_t)(qrow0 + qw * 32 + r32) * DM + h * 128;
#pragma unroll
            for (int d = 0; d < 4; ++d)
#pragma unroll
                for (int g4 = 0; g4 < 4; ++g4) { const int dd = 32 * d + 8 * g4 + 4 * hi; const f32x4 sg = *(const f32x4*)(subg + dd);
                    const f32x4 v = {O[d][4 * g4] * rn * sg[0], O[d][4 * g4 + 1] * rn * sg[1], O[d][4 * g4 + 2] * rn * sg[2], O[d][4 * g4 + 3] * rn * sg[3]};
                    st4bf(orow + dd, v); } }
        __syncthreads();
    }
}

__device__ __forceinline__ void phase_rt(const Ctx& C, const Args& A, int l) {
    unsigned char* ws = A.ws; float* X = (float*)(ws + WS_X); bf16_t* H = (bf16_t*)(ws + WS_H); float* AFF = (float*)(ws + WS_AFF);
    const float* MOD = (const float*)(ws + WS_MOD) + (size_t)l * 5 * 6144;
    const float* lng = A.in[I_LNG] + (size_t)(l * 2 + 0) * DM; const float* lnb = A.in[I_LNB] + (size_t)(l * 2 + 0) * DM;
    LAS float* wrs = (LAS float*)C.lds;
    { const float* wr = A.in[I_WR] + (size_t)l * DM * 16; for (int i = C.tid; i < DM * 16; i += NTHR) wrs[(i & 15) * 1024 + (i >> 4)] = wr[i]; }
    __syncthreads();
    for (int row = C.gw; row < MROWS; row += C.NGW) {
        const float* md = MOD + row_mi(row) * 6144;
        f32x4 x[4]; float s = 0.f;
#pragma unroll
        for (int j = 0; j < 4; ++j) { x[j] = *(const f32x4*)(X + (size_t)row * DM + 4 * C.lane + 256 * j); s += (x[j][0] + x[j][1]) + (x[j][2] + x[j][3]); }
        const float mean = wave_sum(s) * (1.f / DM); float s2 = 0.f;
#pragma unroll
        for (int j = 0; j < 4; ++j) { x[j] = x[j] - mean; s2 += (x[j][0] * x[j][0] + x[j][1] * x[j][1]) + (x[j][2] * x[j][2] + x[j][3] * x[j][3]); }
        const float rstd = rsqrtf(wave_sum(s2) * (1.f / DM) + LN_EPS);
        float v[16];
#pragma unroll
        for (int e = 0; e < 16; ++e) v[e] = 0.f;
#pragma unroll
        for (int j = 0; j < 4; ++j) { const int col = 4 * C.lane + 256 * j;
            const f32x4 x1 = x[j] * rstd * *(const f32x4*)(lng + col) + *(const f32x4*)(lnb + col);
            *(f32x4*)(X + (size_t)row * DM + col) = x1;
            const f32x4 h = x1 * (*(const f32x4*)(md + 4 * DM + col) + 1.f) + *(const f32x4*)(md + 3 * DM + col);
            st4bf(H + (size_t)row * DM + col, h);
#pragma unroll
            for (int e = 0; e < 16; ++e) { const f32x4 w = *(const LAS f32x4*)(wrs + e * 1024 + col); v[e] += (h[0] * w[0] + h[1] * w[1]) + (h[2] * w[2] + h[3] * w[3]); }
            __builtin_amdgcn_sched_barrier(0); }
#pragma unroll
        for (int i = 0; i < 8; ++i) { const float send = (C.lane & 32) ? v[i] : v[i + 8], keep = (C.lane & 32) ? v[i + 8] : v[i]; v[i] = keep + __shfl_xor(send, 32); }
#pragma unroll
        for (int i = 0; i < 4; ++i) { const float send = (C.lane & 16) ? v[i] : v[i + 4], keep = (C.lane & 16) ? v[i + 4] : v[i]; v[i] = keep + __shfl_xor(send, 16); }
#pragma unroll
        for (int i = 0; i < 2; ++i) { const float send = (C.lane & 8) ? v[i] : v[i + 2], keep = (C.lane & 8) ? v[i + 2] : v[i]; v[i] = keep + __shfl_xor(send, 8); }
        { const float send = (C.lane & 4) ? v[0] : v[1], keep = (C.lane & 4) ? v[1] : v[0]; v[0] = keep + __shfl_xor(send, 4); }
        float z = v[0]; z += __shfl_xor(z, 1); z += __shfl_xor(z, 2);
        float mx = z;
#pragma unroll
        for (int o = 4; o < 64; o <<= 1) mx = fmaxf(mx, __shfl_xor(mx, o));
        const float ex = expf(z - mx); float sm = ex;
#pragma unroll
        for (int o = 4; o < 64; o <<= 1) sm += __shfl_xor(sm, o);
        if ((C.lane & 3) == 0) AFF[(size_t)row * 16 + (C.lane >> 2)] = ex / sm;
    }
}

__device__ __forceinline__ void phase_tk(const Ctx& C, const Args& A) {
    unsigned char* ws = A.ws; const float* AFF = (const float*)(ws + WS_AFF); int* SLOT = (int*)(ws + WS_SLOT); int* IDX = (int*)(ws + WS_IDX); float* GATE = (float*)(ws + WS_GATE);
    LAS unsigned* key = (LAS unsigned*)C.lds;
    LAS unsigned* hist = key + 8192;
    LAS unsigned* scn = hist + 256;
    LAS unsigned* wtot = scn + 256;
    LAS unsigned* bc = wtot + 8;
    for (int u = blockIdx.x; u < 128; u += C.G) {
        const bool isctx = u >= 64; const int uu = u & 63, b = uu >> 4, e = uu & 15;
        const int n = isctx ? CTXL : TT, cap = isctx ? CAP_C : CAP_L;
        const int row0 = isctx ? NLAT + b * CTXL : b * TT;
        const int slot0 = e * ESLOTS + (isctx ? 4 * CAP_L + b * CAP_C : b * CAP_L);
        for (int i = C.tid; i < n; i += NTHR) key[i] = __float_as_uint(AFF[(size_t)(row0 + i) * 16 + e]);
        unsigned prefix = 0u, pmask = 0u; int need = cap;
        for (int pass = 0; pass < 4; ++pass) {
            const int shift = 24 - 8 * pass;
            if (C.tid < 256) hist[C.tid] = 0u;
            __syncthreads();
            for (int i = C.tid; i < n; i += NTHR) { const unsigned k = key[i]; if ((k & pmask) == prefix) __hip_atomic_fetch_add(&hist[(k >> shift) & 255u], 1u, __ATOMIC_RELAXED, __HIP_MEMORY_SCOPE_WORKGROUP); }
            __syncthreads();
            if (C.tid < 256) scn[C.tid] = hist[C.tid];
            __syncthreads();
            for (int off = 1; off < 256; off <<= 1) {
                unsigned a = 0u; if (C.tid < 256 && C.tid + off < 256) a = scn[C.tid + off];
                __syncthreads();
                if (C.tid < 256) scn[C.tid] += a;
                __syncthreads();
            }
            if (C.tid < 256) { const unsigned above = (C.tid < 255) ? scn[C.tid + 1] : 0u;
                if (scn[C.tid] >= (unsigned)need && above < (unsigned)need) { bc[0] = (unsigned)C.tid; bc[1] = (unsigned)need - above; } }
            __syncthreads();
            prefix |= bc[0] << shift; pmask |= 255u << shift; need = (int)bc[1];
            __syncthreads();
        }
        const int per = (n + NTHR - 1) / NTHR; const int i0 = C.tid * per;
        unsigned cg = 0u, ce = 0u;
        for (int j = 0; j < per; ++j) { const int i = i0 + j; if (i < n) { const unsigned k = key[i]; cg += (k > prefix); ce += (k == prefix); } }
        unsigned pk = cg | (ce << 16), inc = pk;
#pragma unroll
        for (int o = 1; o < 64; o <<= 1) { const unsigned t = __shfl_up(inc, o); if (C.lane >= o) inc += t; }
        if (C.lane == 63) wtot[C.wave] = inc;
        __syncthreads();
        unsigned wbase = 0u;
        for (int w = 0; w < C.wave; ++w) wbase += wtot[w];
        const unsigned excl = wbase + inc - pk;
        unsigned rg = excl & 0xffffu, re = excl >> 16;
        const int ngt = cap - need;
        for (int j = 0; j < per; ++j) { const int i = i0 + j; if (i < n) { const unsigned k = key[i]; int pos = -1;
            if (k > prefix) { pos = (int)rg; ++rg; } else if (k == prefix) { if ((int)re < need) pos = ngt + (int)re; ++re; }
            const int row = row0 + i;
            if (pos >= 0) { IDX[slot0 + pos] = row; GATE[slot0 + pos] = __uint_as_float(k); SLOT[(size_t)row * 16 + e] = slot0 + pos; }
            else SLOT[(size_t)row * 16 + e] = -1; } }
        if (isctx && b == 0 && C.tid < ESLOTS - 4224) { IDX[e * ESLOTS + 4224 + C.tid] = 0; GATE[e * ESLOTS + 4224 + C.tid] = 0.f; }
        __syncthreads();
    }
}

__device__ __forceinline__ void phase_cb(const Ctx& C, const Args& A, int l) {
    unsigned char* ws = A.ws; float* X = (float*)(ws + WS_X); bf16_t* H = (bf16_t*)(ws + WS_H); const int* SLOT = (const int*)(ws + WS_SLOT); const bf16_t* YE = (const bf16_t*)(ws + WS_YE);
    const float* MOD = (const float*)(ws + WS_MOD) + (size_t)l * 5 * 6144; const float* MODN = MOD + 5 * 6144;
    const float* lng = A.in[I_LNG] + (size_t)(l * 2 + 1) * DM; const float* lnb = A.in[I_LNB] + (size_t)(l * 2 + 1) * DM;
    for (int row = C.gw; row < MROWS; row += C.NGW) {
        const int mi = row_mi(row); const float* md = MOD + mi * 6144;
        f32x4 acc[4];
#pragma unroll
        for (int j = 0; j < 4; ++j) acc[j] = (f32x4){0.f, 0.f, 0.f, 0.f};
        for (int e = 0; e < 16; ++e) { const int s = __builtin_amdgcn_readfirstlane(SLOT[(size_t)row * 16 + e]);
            if (s >= 0) {
#pragma unroll
                for (int j = 0; j < 4; ++j) acc[j] += ld4bf(YE + (size_t)s * DM + 4 * C.lane + 256 * j); } }
        f32x4 x[4]; float sm = 0.f;
#pragma unroll
        for (int j = 0; j < 4; ++j) { const int col = 4 * C.lane + 256 * j; x[j] = *(const f32x4*)(X + (size_t)row * DM + col) * ALPHA_DN + *(const f32x4*)(md + 5 * DM + col) * acc[j];
            sm += (x[j][0] + x[j][1]) + (x[j][2] + x[j][3]); }
        const float mean = wave_sum(sm) * (1.f / DM); float s2 = 0.f;
#pragma unroll
        for (int j = 0; j < 4; ++j) { x[j] = x[j] - mean; s2 += (x[j][0] * x[j][0] + x[j][1] * x[j][1]) + (x[j][2] * x[j][2] + x[j][3] * x[j][3]); }
        const float rstd = rsqrtf(wave_sum(s2) * (1.f / DM) + LN_EPS);
#pragma unroll
        for (int j = 0; j < 4; ++j) { const int col = 4 * C.lane + 256 * j;
            const f32x4 x2 = x[j] * rstd * *(const f32x4*)(lng + col) + *(const f32x4*)(lnb + col);
            *(f32x4*)(X + (size_t)row * DM + col) = x2;
            if (l < DEPTH - 1) { const float* mn = MODN + mi * 6144; st4bf(H + (size_t)row * DM + col, x2 * (*(const f32x4*)(mn + DM + col) + 1.f) + *(const f32x4*)(mn + col)); }
            else if (row < NLAT) *(f32x4*)(A.out + (size_t)row * DM + col) = x2; }
    }
}


#ifndef GEMM_NOINLINE
#define GEMM_NOINLINE 0
#endif
#if GEMM_NOINLINE
#define GEMM_FN __device__ __noinline__
#else
#define GEMM_FN __device__ __forceinline__
#endif
GEMM_FN void gphase_in(LAS unsigned char* lds, unsigned char* ws, int nN, int G) {
    pg8::Gemm g{(const bf16_t*)(ws + WS_H), (const bf16_t*)(ws + WS_WIN), DM}; pg8::Order<0> S; S.init(MROWS / 256, nN, G, (int)blockIdx.x, nullptr, 0);
    pg8::EpiBf16 E{(bf16_t*)(ws + WS_P), P_LD}; pg8::gemm_phase(lds, g, S, E); }
GEMM_FN void gphase_in_odd(LAS unsigned char* lds, unsigned char* ws, int G) {
    pg8::Gemm g{(const bf16_t*)(ws + WS_H), (const bf16_t*)(ws + WS_WIN), DM}; pg8::Order<0> S; S.init(MROWS / 256, D_IN_ODD / 256, G, (int)blockIdx.x, nullptr, 0);
    pg8::EpiOdd E{(bf16_t*)(ws + WS_P), (bf16_t*)(ws + WS_Q), (bf16_t*)(ws + WS_KA), (const float*)(ws + WS_ROPE)}; pg8::gemm_phase(lds, g, S, E); }
GEMM_FN void gphase_lora(LAS unsigned char* lds, unsigned char* ws, const float* d0, const float* a0, const float* kal, int G) {
    pg8::Gemm g{(const bf16_t*)(ws + WS_LIN), (const bf16_t*)(ws + WS_WLORA), LORA_K}; pg8::Order<0> S; S.init(MROWS / 256, LORA_N / 256, G, (int)blockIdx.x, nullptr, 0);
    pg8::EpiLora E{ws + WS_SCN, (bf16_t*)(ws + WS_G), d0, a0, kal}; pg8::gemm_phase(lds, g, S, E); }
GEMM_FN void gphase_out(LAS unsigned char* lds, unsigned char* ws, const float* modl, int G) {
    pg8::Gemm g{(const bf16_t*)(ws + WS_A2), (const bf16_t*)(ws + WS_WOUT), DM}; pg8::Order<0> S; S.init(MROWS / 256, DM / 256, G, (int)blockIdx.x, nullptr, 0);
    pg8::EpiRes E{(float*)(ws + WS_X), modl}; pg8::gemm_phase(lds, g, S, E); }
GEMM_FN void gphase_e1(LAS unsigned char* lds, unsigned char* ws, int G, int l) {
    pg8::Gemm g{(const bf16_t*)(ws + WS_H), (const bf16_t*)(ws + WS_WE13 + (size_t)(l & 1) * WE13_BYTES), DM}; pg8::Order<1> S; S.init(NEXP * 17, 4096 / 256, G, (int)blockIdx.x, (const int*)(ws + WS_IDX), (long)4096 * DM);
    pg8::EpiSwiGLU E{(bf16_t*)(ws + WS_HID)}; pg8::gemm_phase(lds, g, S, E); }
GEMM_FN void gphase_e2(LAS unsigned char* lds, unsigned char* ws, int G, int l) {
    pg8::Gemm g{(const bf16_t*)(ws + WS_HID), (const bf16_t*)(ws + WS_WE2 + (size_t)(l & 1) * WE2_BYTES), D_EXP}; pg8::Order<2> S; S.init(NEXP * 17, DM / 256, G, (int)blockIdx.x, nullptr, (long)DM * D_EXP);
    pg8::EpiYE E{(bf16_t*)(ws + WS_YE), (const float*)(ws + WS_GATE)}; pg8::gemm_phase(lds, g, S, E); }

constexpr int NSLOT = 13;
constexpr int NSTEP = 1 + DEPTH * NSLOT;
__global__ void __launch_bounds__(NTHR, 2) mk_fwd(Args KA) {
    extern __shared__ __attribute__((aligned(16))) unsigned char lds_raw[];
    volatile LAS unsigned* MISC = (volatile LAS unsigned*)((LAS unsigned char*)lds_raw + LDS_MISC);
    if (threadIdx.x < 16) MISC[threadIdx.x] = 0u;
    if (threadIdx.x == 0) { LAS unsigned long long* tb = (LAS unsigned long long*)((LAS unsigned char*)lds_raw + LDS_PTAB);
#pragma unroll
        for (int i = 0; i < 37; ++i) tb[i] = (unsigned long long)KA.in[i];
        tb[37] = (unsigned long long)KA.out; tb[38] = (unsigned long long)KA.ws; }
    __syncthreads();
    const int lo = KA.lo, hi = KA.hi;
    unsigned bar_x = 0;
    if (hi - lo > 1) { const XcdBarrier b0 = xcd_barrier_post((unsigned*)(KA.ws + WS_CTL), MISC); bar_x = b0.x; }
#ifndef PH_MASK
#define PH_MASK 0xFFFFFF
#endif
#ifndef REP_MASK
#define REP_MASK 0
#endif
#define PH_BIT(k) (((k) == 0) ? 0 : 1 + ((k) - 1) % NSLOT + (((k) - 1) % NSLOT >= 2 && ((k) - 1) % NSLOT <= 3 && odd ? 12 : 0))
#define RUN(k, ...) do { if (((PH_MASK >> PH_BIT(k)) & 1) && lo <= (k) && (k) < hi) { const int nrep = ((REP_MASK >> PH_BIT(k)) & 1) ? 2 : 1; \
        _Pragma("unroll 1") for (int rep = 0; rep < nrep; ++rep) { \
        Ctx C; mkctx(C, (LAS unsigned char*)lds_raw); Args A; ldargs(A, (LAS unsigned char*)lds_raw); unsigned char* ws = A.ws; \
        const float* MODL = (const float*)(ws + WS_MOD) + (size_t)l * 5 * 6144; (void)MODL; \
        __VA_ARGS__; if ((k) + 1 < hi || rep + 1 < nrep) { XcdBarrier bar; bar.bar = (unsigned*)(ws + WS_CTL); bar.x = bar_x; bar.st = MISC; xcd_barrier(bar); } } } } while (0)
    { const bool odd = false; const int l = 0; RUN(0, phase_init(C, A)); }
#pragma unroll 1
    for (int l = 0; l < DEPTH; ++l) {
        const int sb = 1 + l * NSLOT; const bool odd = l & 1;
        RUN(sb + 0, { phase_conv(C, A, l); if (l == 0) phase_modh(C, A, 0); });
        if (odd) { RUN(sb + 1, gphase_in_odd(C.lds, ws, C.G)); } else { RUN(sb + 1, gphase_in(C.lds, ws, D_IN_EVEN_PAD / 256, C.G)); }
        if (!odd) {
            RUN(sb + 2, phase_ef1(C, A, l));
            RUN(sb + 3, { const int i2 = l >> 1; gphase_lora(C.lds, ws, A.in[I_D0] + (size_t)i2 * 2 * 768, A.in[I_A0] + (size_t)i2 * 2 * 768, A.in[I_KAL] + (size_t)i2 * 768, C.G); });
#if CHUNKED_SCAN
            RUN(sb + 4, phase_csa(C, A));
            RUN(sb + 5, phase_csb(C, A, l));
#else
            RUN(sb + 4, phase_scan(C, A));
#endif
            RUN(sb + 6, phase_ef2(C, A, l));
        } else {
            RUN(sb + 2, phase_of1(C, A, l));
            RUN(sb + 3, phase_attn(C, A, l));
        }
        RUN(sb + 7, gphase_out(C.lds, ws, MODL, C.G));
        RUN(sb + 8, phase_rt(C, A, l));
        RUN(sb + 9, phase_tk(C, A));
        RUN(sb + 10, gphase_e1(C.lds, ws, C.G, l));
        RUN(sb + 11, gphase_e2(C.lds, ws, C.G, l));
        RUN(sb + 12, phase_cb(C, A, l));
    }
#undef RUN
}

#ifdef PHASE_PROBE
#define PROBE_PRE extern __shared__ __attribute__((aligned(16))) unsigned char lds_raw[]; Ctx C; mkctx(C, (LAS unsigned char*)lds_raw); unsigned char* ws = A.ws; (void)ws;
__global__ void __launch_bounds__(NTHR, 2) pr_init(Args A) { PROBE_PRE phase_init(C, A); }
__global__ void __launch_bounds__(NTHR, 2) pr_conv(Args A) { PROBE_PRE phase_conv(C, A, A.lo); }
__global__ void __launch_bounds__(NTHR, 2) pr_modh(Args A) { PROBE_PRE phase_modh(C, A, A.lo); }
__global__ void __launch_bounds__(NTHR, 2) pr_ef1(Args A) { PROBE_PRE phase_ef1(C, A, A.lo); }
__global__ void __launch_bounds__(NTHR, 2) pr_scan(Args A) { PROBE_PRE phase_scan(C, A); }
__global__ void __launch_bounds__(NTHR, 2) pr_ef2(Args A) { PROBE_PRE phase_ef2(C, A, A.lo); }
__global__ void __launch_bounds__(NTHR, 2) pr_csa(Args A) { PROBE_PRE phase_csa(C, A); }
__global__ void __launch_bounds__(NTHR, 2) pr_csb(Args A) { PROBE_PRE phase_csb(C, A, A.lo); }
__global__ void __launch_bounds__(NTHR, 2) pr_of1(Args A) { PROBE_PRE phase_of1(C, A, A.lo); }
__global__ void __launch_bounds__(NTHR, 2) pr_attn(Args A) { PROBE_PRE phase_attn(C, A, A.lo); }
__global__ void __launch_bounds__(NTHR, 2) pr_rt(Args A) { PROBE_PRE phase_rt(C, A, A.lo); }
__global__ void __launch_bounds__(NTHR, 2) pr_tk(Args A) { PROBE_PRE phase_tk(C, A); }
__global__ void __launch_bounds__(NTHR, 2) pr_cb(Args A) { PROBE_PRE phase_cb(C, A, A.lo); }
__global__ void __launch_bounds__(NTHR, 2) pr_gemm_in(Args A) { PROBE_PRE pg8::Gemm g{(const bf16_t*)(ws + WS_H), (const bf16_t*)(ws + WS_WIN), DM}; pg8::Order<0> S; S.init(MROWS / 256, A.lo, C.G, (int)blockIdx.x, nullptr, 0);
                      pg8::EpiBf16 E{(bf16_t*)(ws + WS_P), P_LD}; pg8::gemm_phase(C.lds, g, S, E); }
__global__ void __launch_bounds__(NTHR, 2) pr_gemm_lora(Args A) { PROBE_PRE pg8::Gemm g{(const bf16_t*)(ws + WS_LIN), (const bf16_t*)(ws + WS_WLORA), LORA_K}; pg8::Order<0> S; S.init(MROWS / 256, LORA_N / 256, C.G, (int)blockIdx.x, nullptr, 0);
                          const int i2 = A.lo; pg8::EpiLora E{ws + WS_SCN, (bf16_t*)(ws + WS_G), A.in[I_D0] + (size_t)i2 * 2 * 768, A.in[I_A0] + (size_t)i2 * 2 * 768, A.in[I_KAL] + (size_t)i2 * 768};
                          pg8::gemm_phase(C.lds, g, S, E); }
__global__ void __launch_bounds__(NTHR, 2) pr_gemm_out(Args A) { PROBE_PRE pg8::Gemm g{(const bf16_t*)(ws + WS_A2), (const bf16_t*)(ws + WS_WOUT), DM}; pg8::Order<0> S; S.init(MROWS / 256, DM / 256, C.G, (int)blockIdx.x, nullptr, 0);
                      pg8::EpiRes E{(float*)(ws + WS_X), (const float*)(ws + WS_MOD)}; pg8::gemm_phase(C.lds, g, S, E); }
__global__ void __launch_bounds__(NTHR, 2) pr_gemm_e1(Args A) { PROBE_PRE pg8::Gemm g{(const bf16_t*)(ws + WS_H), (const bf16_t*)(ws + WS_WE13), DM}; pg8::Order<1> S; S.init(NEXP * 17, 4096 / 256, C.G, (int)blockIdx.x, (const int*)(ws + WS_IDX), (long)4096 * DM);
                      pg8::EpiSwiGLU E{(bf16_t*)(ws + WS_HID)}; pg8::gemm_phase(C.lds, g, S, E); }
__global__ void __launch_bounds__(NTHR, 2) pr_gemm_e2(Args A) { PROBE_PRE pg8::Gemm g{(const bf16_t*)(ws + WS_HID), (const bf16_t*)(ws + WS_WE2), D_EXP}; pg8::Order<2> S; S.init(NEXP * 17, DM / 256, C.G, (int)blockIdx.x, nullptr, (long)DM * D_EXP);
                       pg8::EpiYE E{(bf16_t*)(ws + WS_YE), (const float*)(ws + WS_GATE)}; pg8::gemm_phase(C.lds, g, S, E); }
#endif

extern "C" void kernel_launch(void* const* d_in, const int* in_sizes, int n_in, void* d_out, int out_size, void* d_ws, size_t ws_size, hipStream_t stream) {
    static int grid = 0;
    if (grid == 0) {
        if (n_in != 37 || out_size != NLAT * DM || ws_size < WS_END) { fprintf(stderr, "kernel_launch: unexpected shapes: n_in %d out %d ws %zu (need %zu)\n", n_in, out_size, ws_size, (size_t)WS_END); grid = -1; return; }
        int dev = 0, cus = 0, per_cu = 0;
        if (hipGetDevice(&dev) != hipSuccess || hipDeviceGetAttribute(&cus, hipDeviceAttributeMultiprocessorCount, dev) != hipSuccess) { grid = -1; return; }
        if (hipFuncSetAttribute((const void*)mk_fwd, hipFuncAttributeMaxDynamicSharedMemorySize, LDS_BYTES) != hipSuccess) { fprintf(stderr, "kernel_launch: hipFuncSetAttribute failed\n"); grid = -1; return; }
        if (hipOccupancyMaxActiveBlocksPerMultiprocessor(&per_cu, (const void*)mk_fwd, NTHR, LDS_BYTES) != hipSuccess || per_cu < 1) fprintf(stderr, "kernel_launch: occupancy query reports %d\n", per_cu);
        (void)hipGetLastError();
        grid = cus;
    }
    if (grid < 0) return;
    (void)hipMemsetAsync((char*)d_ws + WS_CTL, 0, CTL_BYTES, stream);
    Args a{};
    for (int i = 0; i < 37; ++i) a.in[i] = (const float*)d_in[i];
    a.out = (float*)d_out; a.ws = (unsigned char*)d_ws;
#if MK_MULTI
    for (int k = 0; k < NSTEP; ++k) {
        if (k >= 1) { const int l = (k - 1) / NSLOT, s = (k - 1) % NSLOT; if ((l & 1) && (s >= 4 && s <= 6)) continue; if (!(l & 1) && !CHUNKED_SCAN && s == 5) continue; }
        a.lo = k; a.hi = k + 1;
        hipLaunchKernelGGL(mk_fwd, dim3(grid), dim3(NTHR), LDS_BYTES, stream, a);
    }
#else
    a.lo = 0; a.hi = NSTEP;
    hipLaunchKernelGGL(mk_fwd, dim3(grid), dim3(NTHR), LDS_BYTES, stream, a);
#endif
    const hipError_t le = hipPeekAtLastError();
    if (le != hipSuccess) fprintf(stderr, "kernel_launch: launch failed: %s\n", hipGetErrorName(le));
}
```

```cpp
#include <hip/hip_runtime.h>
#include <cstdio>
#include <cstdint>
#include <cmath>

#ifndef MK_MULTI
#define MK_MULTI 0
#endif
#ifndef CHUNKED_SCAN
#define CHUNKED_SCAN 1
#endif

#define GAS __attribute__((address_space(1)))
#define LAS __attribute__((address_space(3)))
typedef unsigned short bf16_t;
typedef short bf16x8 __attribute__((ext_vector_type(8)));
typedef float f32x4 __attribute__((ext_vector_type(4)));
typedef float f32x2 __attribute__((ext_vector_type(2)));
typedef float f32x16 __attribute__((ext_vector_type(16)));
typedef unsigned u32x4 __attribute__((ext_vector_type(4)));
typedef unsigned u32x2 __attribute__((ext_vector_type(2)));
typedef __bf16 bf16x2_t __attribute__((ext_vector_type(2)));

constexpr int NB = 4, TT = 8192, DM = 1024, NLAT = NB * TT, CTXL = 256, NCTX = NB * CTXL, MROWS = NLAT + NCTX;
constexpr int DEPTH = 4;
constexpr int D_CONV = 256, RW_H = 12, RW_K = 64, D_RWKV = 768, RWKV_COLS = 2688, D_IN_EVEN = 3456, D_IN_EVEN_PAD = 3584;
constexpr int D_DIFF = 768, D_GMLP = 256, D_IN_ODD = 2816;
constexpr int NEXP = 16, D_EXP = 2048, CAP_L = 1024, CAP_C = 32, ESLOTS = 4352;
constexpr int P_LD = 3584;
constexpr int LORA_K = 384, LORA_N = 3840;
constexpr int LKEYS = CTXL + TT;
constexpr float ALPHA_DN = 1.6817928305074290f;
constexpr float DECAY_SCALE = 0.6065306597126334f;
constexpr float GN_EPS = 64e-5f, LN_EPS = 1e-5f, RMS_EPS = 1e-5f;
constexpr float QSCALE = 0.125f * 1.4426950408889634f;

constexpr size_t al256(size_t x) { return (x + 255) & ~(size_t)255; }
constexpr size_t WS_CTL = 0;
constexpr size_t CTL_BYTES = 65536;
constexpr size_t WS_MOD = WS_CTL + CTL_BYTES;
constexpr size_t WS_ROPE = WS_MOD + al256((size_t)DEPTH * 5 * 6144 * 4);
constexpr size_t WS_WIN = WS_ROPE + 32768;
constexpr size_t WS_WOUT = WS_WIN + (size_t)D_IN_EVEN_PAD * DM * 2;
constexpr size_t WS_WLORA = WS_WOUT + (size_t)DM * DM * 2;
constexpr size_t WS_WE13 = WS_WLORA + (size_t)LORA_N * LORA_K * 2;
constexpr size_t WE13_BYTES = (size_t)NEXP * 4096 * DM * 2, WE2_BYTES = (size_t)NEXP * DM * D_EXP * 2;
constexpr size_t WS_WE2 = WS_WE13 + 2 * WE13_BYTES;
constexpr size_t WS_X = WS_WE2 + 2 * WE2_BYTES;
constexpr size_t WS_H = WS_X + (size_t)MROWS * DM * 4;
constexpr size_t WS_A2 = WS_H + (size_t)MROWS * DM * 2;
constexpr size_t WS_P = WS_A2 + (size_t)MROWS * DM * 2;
constexpr size_t WS_AFF = WS_P + (size_t)MROWS * P_LD * 2;
constexpr size_t WS_SLOT = WS_AFF + (size_t)MROWS * 16 * 4;
constexpr size_t WS_IDX = WS_SLOT + (size_t)MROWS * 16 * 4;
constexpr size_t WS_GATE = WS_IDX + al256((size_t)NEXP * ESLOTS * 4);
constexpr size_t WS_R2 = WS_GATE + al256((size_t)NEXP * ESLOTS * 4);
constexpr int SC_REC = 1408, SC_ROW = 12 * SC_REC, SC_W = 0, SC_R = 512, SC_KK = 640, SC_V = 768, SC_B = 896, SC_KR = 1024;
constexpr size_t WS_SCN = WS_R2;
constexpr size_t WS_G = WS_SCN + (size_t)MROWS * SC_ROW;
constexpr size_t WS_LIN = WS_G + (size_t)MROWS * 768 * 2;
constexpr int CS_L = 64, CS_NCH = LKEYS / CS_L, CS_UNITS = NB * RW_H * 2;
constexpr size_t WS_CHK = WS_LIN + (size_t)MROWS * 384 * 2;
constexpr size_t WS_EVEN_END = WS_CHK + (size_t)CS_UNITS * CS_NCH * 32768;
constexpr size_t WS_Y = WS_P;
constexpr size_t WS_Q = WS_R2;
constexpr size_t WS_KA = WS_Q + (size_t)MROWS * 768 * 2;
constexpr size_t WS_VT = WS_KA + (size_t)NB * LKEYS * 768 * 2;
constexpr size_t WS_HID = WS_R2;
constexpr size_t WS_YE = WS_HID + (size_t)NEXP * ESLOTS * D_EXP * 2;
constexpr size_t WS_END = WS_EVEN_END;
static_assert(WS_END <= (size_t)2147483648ull, "workspace over 2 GiB");
static_assert((size_t)2 * MROWS * 768 * 4 <= (size_t)MROWS * P_LD * 2, "Y aliases P");
static_assert(WS_YE + (size_t)NEXP * ESLOTS * DM * 2 <= WS_END, "moe region");

constexpr int LDS_BYTES = 147456;
constexpr int LDS_MISC = 140 * 1024;
constexpr int LDS_PTAB = LDS_MISC + 256;
constexpr int NWAVES = 8, NTHR = 512;

__device__ __forceinline__ unsigned f2bf(float f) { unsigned u = __float_as_uint(f); return (u + 0x7fffu + ((u >> 16) & 1u)) >> 16; }
__device__ __forceinline__ unsigned pk2(float lo, float hi) { f32x2 v = {lo, hi}; bf16x2_t b = __builtin_convertvector(v, bf16x2_t); return __builtin_bit_cast(unsigned, b); }
__device__ __forceinline__ float bflo(unsigned u) { return __uint_as_float(u << 16); }
__device__ __forceinline__ float bfhi(unsigned u) { return __uint_as_float(u & 0xffff0000u); }
__device__ __forceinline__ float bf2f(bf16_t b) { return __uint_as_float((unsigned)b << 16); }
__device__ __forceinline__ float sigmoidf_(float x) { return 1.f / (1.f + __expf(-x)); }
__device__ __forceinline__ float wave_sum(float v) {
#pragma unroll
    for (int o = 1; o < 64; o <<= 1) v += __shfl_xor(v, o);
    return v;
}
__device__ __forceinline__ float sum16(float v) {
#pragma unroll
    for (int o = 1; o < 16; o <<= 1) v += __shfl_xor(v, o);
    return v;
}
__device__ __forceinline__ f32x4 ld4bf_(const void* p) { const u32x2 u = *(const u32x2*)p; return (f32x4){bflo(u.x), bfhi(u.x), bflo(u.y), bfhi(u.y)}; }
__device__ __forceinline__ void st4bf_(void* p, f32x4 v) { u32x2 o; o.x = pk2(v[0], v[1]); o.y = pk2(v[2], v[3]); *(u32x2*)p = o; }
__device__ __forceinline__ float max3f(float a, float b, float c) { float r; asm("v_max3_f32 %0, %1, %2, %3" : "=v"(r) : "v"(a), "v"(b), "v"(c)); return r; }
__device__ __forceinline__ int crow(int r, int hi) { return (r & 3) + 8 * (r >> 2) + 4 * hi; }
__device__ __forceinline__ float gelu_erf(float x) { return 0.5f * x * (1.f + erff(x * 0.70710678118654752f)); }

#define XB_TMO      128
#define XB_XCNT(j)  (256  + 64 * (j))
#define XB_XSUB(j)  (1280 + 64 * (j))
#define XB_XGEN(j)  (2304 + 64 * (j))
#define XB_TOP      3328
#define XB_TOPGEN   3392
#define XCD_BAR_WORDS 3456
#define XB_SPIN_CAP (1u << 20)

__device__ __forceinline__ unsigned xb_ld(unsigned* p)              { return __hip_atomic_load(p, __ATOMIC_RELAXED, __HIP_MEMORY_SCOPE_AGENT); }
__device__ __forceinline__ unsigned xb_add(unsigned* p, unsigned v) { return __hip_atomic_fetch_add(p, v, __ATOMIC_RELAXED, __HIP_MEMORY_SCOPE_AGENT); }
__device__ __forceinline__ unsigned xb_xcc_id() { return (unsigned)__builtin_amdgcn_s_getreg((3 << 11) | 20) & 0xFu; }
#define XB_SPIN(cond, bar) do { unsigned _sp = 0; while (cond) { __builtin_amdgcn_s_sleep(1); \
    if ((++_sp & 255u) == 0u) { if (xb_ld(&(bar)[XB_TMO])) break; if (_sp > XB_SPIN_CAP) { atomicAdd(&(bar)[XB_TMO], 1u); break; } } } } while (0)

struct XcdBarrier { unsigned* bar; unsigned x; volatile LAS unsigned* st; };

__device__ __forceinline__ XcdBarrier xcd_barrier_post(unsigned* bar, volatile LAS unsigned* st) {
    XcdBarrier b; b.bar = bar; b.x = xb_xcc_id(); b.st = st;
    if (threadIdx.x == 0) (void)xb_add(&bar[XB_XCNT(b.x)], 1u);
    return b;
}
__device__ __forceinline__ void xcd_barrier_complete(unsigned* bar, unsigned x, unsigned& nloc, unsigned& nx) {
    const unsigned G = gridDim.x * gridDim.y * gridDim.z;
    unsigned sum, cnt, mine, sp = 0u;
    for (;;) {
        sum = 0u; cnt = 0u; mine = 0u;
#pragma unroll
        for (unsigned j = 0; j < 16; ++j) { const unsigned c = xb_ld(&bar[XB_XCNT(j)]); sum += c; cnt += (c > 0u) ? 1u : 0u; mine = (j == x) ? c : mine; }
        if (sum == G) break;
        __builtin_amdgcn_s_sleep(1);
        if ((++sp & 255u) == 0u) { if (xb_ld(&bar[XB_TMO])) break; if (sp > XB_SPIN_CAP) { atomicAdd(&bar[XB_TMO], 1u); break; } }
    }
    nloc = mine > 0u ? mine : 1u; nx = cnt > 0u ? cnt : 1u;
}
__device__ __forceinline__ void xcd_barrier(const XcdBarrier& b) {
    asm volatile("s_waitcnt vmcnt(0)" ::: "memory");
    __syncthreads();
    if (threadIdx.x == 0) {
        unsigned* bar = b.bar;
        __builtin_amdgcn_s_waitcnt(0);
        unsigned nloc = b.st[0], nx = b.st[1];
        if (nloc == 0u) { xcd_barrier_complete(bar, b.x, nloc, nx); b.st[0] = nloc; b.st[1] = nx; }
        const unsigned old = xb_add(&bar[XB_XSUB(b.x)], 1u);
        const unsigned gen = old / nloc;
        if (old + 1u == (gen + 1u) * nloc) {
            __builtin_amdgcn_fence(__ATOMIC_RELEASE, "agent");
            asm volatile("s_waitcnt vmcnt(0)" ::: "memory");
            const unsigned og = xb_add(&bar[XB_TOP], 1u);
            const unsigned tg = og / nx;
            if (og + 1u == (tg + 1u) * nx) xb_add(&bar[XB_TOPGEN], 1u);
            else XB_SPIN(xb_ld(&bar[XB_TOPGEN]) == tg, bar);
            __builtin_amdgcn_fence(__ATOMIC_ACQUIRE, "agent");
            xb_add(&bar[XB_XGEN(b.x)], 1u);
            asm volatile("s_waitcnt vmcnt(0)" ::: "memory");
        } else {
            XB_SPIN(xb_ld(&bar[XB_XGEN(b.x)]) == gen, bar);
            __builtin_amdgcn_fence(__ATOMIC_ACQUIRE, "agent");
            asm volatile("s_waitcnt vmcnt(0)" ::: "memory");
        }
    }
    __syncthreads();
}

namespace pg8 {
constexpr int BM = 256, BK = 64, HALF = 128, HTB = HALF * BK * 2, STAGE_BYTES = 8 * HTB, NXCD = 8, WGM = 8;
__host__ __device__ __forceinline__ int lds_byte(int r, int c) { const int st = (r >> 4) * 2 + (c >> 5), rr = r & 15, cc = c & 31, ob = rr * 64 + cc * 2; return st * 1024 + (ob ^ (((ob >> 9) & 1) << 5)); }
__host__ __device__ __forceinline__ void stage_rc(int b, int& R, int& C) { const int st = b / 1024, sb = b % 1024, swz = sb ^ (((sb >> 9) & 1) << 5); R = (st >> 1) * 16 + swz / 64; C = (st & 1) * 32 + (swz % 64) / 2; }

struct Unit { int pm, pn, hf; };
struct Gemm { const bf16_t* A; const bf16_t* Bt; int K; };

template <int MODE> struct Order {
    int nM, nN, nwg, G, c; const int* idx; long bstride;
    __device__ __forceinline__ void init(int nM_, int nN_, int G_, int c_, const int* idx_, long bstride_) { nM = nM_; nN = nN_; nwg = nM * nN; G = G_; c = c_; idx = idx_; bstride = bstride_; }
    __device__ __forceinline__ bool next(int i, Unit& u) const {
        const long L = (long)i * G + c; if (L >= nwg) return false;
        int wgid = (int)L; { const int q = nwg / NXCD, r = nwg % NXCD, xcd = wgid % NXCD, off = wgid / NXCD; wgid = (xcd < r ? xcd * (q + 1) : r * (q + 1) + (xcd - r) * q) + off; }
        const int nig = WGM * nN, gid = wgid / nig, fm = gid * WGM, gsz = (nM - fm) < WGM ? (nM - fm) : WGM;
        u.pm = fm + ((wgid % nig) % gsz); u.pn = (wgid % nig) / gsz; u.hf = (MODE != 0 && (u.pm % 17) == 16) ? 1 : 0; return true;
    }
    __device__ __forceinline__ unsigned arow(const Unit& u, int r) const { if (MODE == 1) return (unsigned)idx[u.pm * BM + r]; return (unsigned)(u.pm * BM + r); }
    __device__ __forceinline__ long bbase(const Unit& u, int K) const { long o = (long)u.pn * BM * K; if (MODE != 0) o += (long)(u.pm / 17) * bstride; return o; }
};

template <int MODE> struct OrderExp {
    int nN, G, c0; const int* idx; long bstride;
    __device__ __forceinline__ void init(int nN_, int G_, int c_, const int* idx_, long bstride_) { nN = nN_; G = G_; c0 = c_; idx = idx_; bstride = bstride_; }
    __device__ __forceinline__ bool next(int i0, Unit& u) const {
        const int v = i0 * G + c0, i = v >> 8, c = v & 255;
        const int x = c & 7, slot = c >> 3, per = 32 / nN, nfull = 256 / (8 * per);
        if (i > nfull) return false;
        if (i < nfull) { u.pn = slot / per; const int f = (i * 8 + x) * per + (slot % per); u.pm = (f >> 4) * 17 + (f & 15); u.hf = 0; return true; }
        if (i == nfull && slot < 2 * nN) { u.pn = slot >> 1; u.pm = (x * 2 + (slot & 1)) * 17 + 16; u.hf = 1; return true; }
        return false;
    }
    __device__ __forceinline__ unsigned arow(const Unit& u, int r) const { if (MODE == 1) return (unsigned)idx[u.pm * BM + r]; return (unsigned)(u.pm * BM + r); }
    __device__ __forceinline__ long bbase(const Unit& u, int K) const { return (long)u.pn * BM * K + (long)(u.pm / 17) * bstride; }
};

template <class Epi, class Sched>
__device__ __forceinline__ void gemm_phase(LAS unsigned char* lds, const Gemm g, const Sched& S, const Epi& E) {
    int tid = threadIdx.x; asm volatile("" : "+v"(tid));
    const int wid = __builtin_amdgcn_readfirstlane(tid >> 6), wr = wid >> 2, wc = wid & 3;
    const int K = g.K, nt = K / BK;
    unsigned voffB[2];
    { const int lane = tid & 63, fr = lane & 15, fq = lane >> 4; (void)fr; (void)fq; }
#pragma unroll
    for (int i = 0; i < 2; ++i) { int R, Cc; stage_rc(tid * 16 + i * 8192, R, Cc); voffB[i] = (unsigned)(R * K + Cc) * 2u; }
    const size_t kstep = (size_t)(BK * 2);
    const size_t hstep = (size_t)HALF * K * 2;
    const unsigned ldsw = (unsigned)wid * 1024u;
    const int aoff = lds_byte(wr * 64 + (tid & 15), ((tid & 63) >> 4) * 8), boff = lds_byte(wc * 32 + (tid & 15), ((tid & 63) >> 4) * 8);
#define PG8_SA(b, h) (((b) * 2 + (h)) * HTB)
#define PG8_SB(b, h) ((4 + (b) * 2 + (h)) * HTB)
#define PG8_STAGE(bufoff, gbase, voff) do { _Pragma("unroll") for (int _i = 0; _i < 2; ++_i) \
        __builtin_amdgcn_global_load_lds((const unsigned*)((const char*)(gbase) + (voff)[_i]), (LAS unsigned*)(lds + (bufoff) + ldsw + _i * 8192), 16, 0, 0); } while (0)
#define PG8_LDA(dst, b, h) do { _Pragma("unroll") for (int m = 0; m < 4; ++m) _Pragma("unroll") for (int k = 0; k < 2; ++k) dst[m][k] = *(const LAS bf16x8*)(lds + PG8_SA(b, h) + aoff + m * 2048 + k * 1024); } while (0)
#define PG8_LDB(dst, b, h) do { _Pragma("unroll") for (int n = 0; n < 2; ++n) _Pragma("unroll") for (int k = 0; k < 2; ++k) dst[n][k] = *(const LAS bf16x8*)(lds + PG8_SB(b, h) + boff + n * 2048 + k * 1024); } while (0)
#define PG8_MMA(ai, bj, At, Bt) do { __builtin_amdgcn_s_setprio(1); _Pragma("unroll") for (int m = 0; m < 4; ++m) _Pragma("unroll") for (int n = 0; n < 2; ++n) _Pragma("unroll") for (int k = 0; k < 2; ++k) \
        acc[ai][bj][m][n] = __builtin_amdgcn_mfma_f32_16x16x32_bf16(Bt[n][k], At[m][k], acc[ai][bj][m][n], 0, 0, 0); __builtin_amdgcn_s_setprio(0); } while (0)
#define PG8_WAIT_V(n) asm volatile("s_waitcnt vmcnt(" #n ")" ::: "memory")
#define PG8_WAIT_L(n) asm volatile("s_waitcnt lgkmcnt(" #n ")" ::: "memory")
#define PG8_BAR __builtin_amdgcn_s_barrier()
#define PG8_SCHED __builtin_amdgcn_sched_barrier(0)
#define PG8_ROWOFFS(dst, u, tq) do { _Pragma("unroll") for (int _i = 0; _i < 2; ++_i) { int _R, _C; stage_rc((tq) * 16 + _i * 8192, _R, _C); _Pragma("unroll") for (int _h = 0; _h < 2; ++_h) dst[_h][_i] = (S.arow(u, _h * HALF + _R) * (unsigned)K + (unsigned)_C) * 2u; } } while (0)
    Unit cur, nxt; int ui = 0;
    if (!S.next(0, cur)) return;
    float zf = 0.f; asm volatile("" : "+v"(zf));
    f32x4 acc[2][2][4][2];
#pragma unroll
    for (int a = 0; a < 2; ++a)
#pragma unroll
        for (int b = 0; b < 2; ++b)
#pragma unroll
            for (int m = 0; m < 4; ++m)
#pragma unroll
                for (int n = 0; n < 2; ++n) acc[a][b][m][n] = (f32x4){zf, zf, zf, zf};
    bf16x8 At[4][2], B0[2][2], B1[2][2];
    unsigned vcur[2][2];
    PG8_ROWOFFS(vcur, cur, tid);
    const char* const Ab = (const char*)g.A;
    const char* cB = (const char*)g.Bt + (size_t)S.bbase(cur, K) * 2;
    PG8_STAGE(PG8_SB(0, 0), cB, voffB); PG8_STAGE(PG8_SB(0, 1), cB + hstep, voffB); PG8_STAGE(PG8_SA(0, 0), Ab, vcur[0]); PG8_STAGE(PG8_SA(0, 1), Ab, vcur[1]);
    if (wr == 1) PG8_BAR;
    PG8_WAIT_V(2); PG8_BAR;
    PG8_STAGE(PG8_SB(1, 0), cB + kstep, voffB); PG8_STAGE(PG8_SA(1, 0), Ab + kstep, vcur[0]); PG8_STAGE(PG8_SB(1, 1), cB + hstep + kstep, voffB);
    PG8_WAIT_V(6); PG8_BAR;
    for (;;) {
        const bool has_next = S.next(ui + 1, nxt);
        const char* nB = has_next ? (const char*)g.Bt + (size_t)S.bbase(nxt, K) * 2 : cB;
        for (int t = 0; t < nt; t += 2) {
            const bool last = (t == nt - 2);
            const char* a1 = Ab + (size_t)(t + 1) * kstep;
            const char* a2 = last ? Ab : Ab + (size_t)(t + 2) * kstep; const char* b2 = last ? nB : cB + (size_t)(t + 2) * kstep;
            const char* a3 = a2 + kstep; const char* b3 = b2 + kstep;
            PG8_LDB(B0, 0, 0); PG8_LDB(B1, 0, 1); PG8_SCHED; PG8_LDA(At, 0, 0); PG8_STAGE(PG8_SA(1, 1), a1, vcur[1]);
            PG8_WAIT_V(8); PG8_WAIT_L(0); PG8_BAR; PG8_MMA(0, 0, At, B0); PG8_MMA(0, 1, At, B1); PG8_BAR; PG8_SCHED;
            if (last && has_next) { int tq = tid; asm volatile("" : "+v"(tq)); PG8_ROWOFFS(vcur, nxt, tq); }
            PG8_LDA(At, 0, 1); PG8_STAGE(PG8_SB(0, 0), b2, voffB); PG8_STAGE(PG8_SB(0, 1), b2 + hstep, voffB); PG8_STAGE(PG8_SA(0, 0), a2, vcur[0]);
            PG8_WAIT_V(8); PG8_WAIT_L(0); PG8_BAR; if (!cur.hf) { PG8_MMA(1, 0, At, B0); PG8_MMA(1, 1, At, B1); } PG8_BAR; PG8_SCHED;
            PG8_LDB(B0, 1, 0); PG8_LDB(B1, 1, 1); PG8_SCHED; PG8_LDA(At, 1, 0); PG8_STAGE(PG8_SA(0, 1), a2, vcur[1]);
            PG8_WAIT_V(8); PG8_WAIT_L(0); PG8_BAR; PG8_MMA(0, 0, At, B0); PG8_MMA(0, 1, At, B1); PG8_BAR; PG8_SCHED;
            PG8_LDA(At, 1, 1); PG8_STAGE(PG8_SB(1, 0), b3, voffB); PG8_STAGE(PG8_SB(1, 1), b3 + hstep, voffB); PG8_STAGE(PG8_SA(1, 0), a3, vcur[0]);
            PG8_WAIT_V(8); PG8_WAIT_L(0); PG8_BAR; if (!cur.hf) { PG8_MMA(1, 0, At, B0); PG8_MMA(1, 1, At, B1); } PG8_BAR; PG8_SCHED;
        }
        if (wr == 0) PG8_BAR;
        { int tz = tid; asm volatile("" : "+v"(tz)); const int ln = tz & 63; E(acc, cur, wr, wc, ln & 15, ln >> 4); }
        if (!has_next) break;
#pragma unroll
        for (int a = 0; a < 2; ++a)
#pragma unroll
            for (int b = 0; b < 2; ++b)
#pragma unroll
                for (int m = 0; m < 4; ++m)
#pragma unroll
                    for (int n = 0; n < 2; ++n) acc[a][b][m][n] = (f32x4){zf, zf, zf, zf};
        cur = nxt; cB = nB; ++ui;
        if (wr == 1) PG8_BAR;
    }
    PG8_WAIT_V(0);
    PG8_BAR;
#undef PG8_SA
#undef PG8_SB
#undef PG8_STAGE
#undef PG8_LDA
#undef PG8_LDB
#undef PG8_MMA
#undef PG8_WAIT_V
#undef PG8_WAIT_L
#undef PG8_BAR
#undef PG8_SCHED
#undef PG8_ROWOFFS
}

#define EPI_LOOP for (int ai = 0; ai < 2; ++ai) for (int m = 0; m < 4; ++m) for (int bj = 0; bj < 2; ++bj) for (int n = 0; n < 2; ++n)
struct EpiBf16 {
    bf16_t* O; int ldc;
    __device__ __forceinline__ void operator()(const f32x4 (&acc)[2][2][4][2], const Unit& u, int wr, int wc, int fr, int fq) const {
        const int row0 = u.pm * BM + wr * 64 + fr, col0 = u.pn * BM + wc * 32 + 4 * fq;
#pragma unroll
        for (int ai = 0; ai < 2; ++ai)
#pragma unroll
            for (int m = 0; m < 4; ++m) { bf16_t* rowp = O + (size_t)(row0 + ai * HALF + m * 16) * ldc + col0;
#pragma unroll
                for (int bj = 0; bj < 2; ++bj)
#pragma unroll
                    for (int n = 0; n < 2; ++n) { const f32x4 v = acc[ai][bj][m][n]; u32x2 o; o.x = pk2(v[0], v[1]); o.y = pk2(v[2], v[3]); *(u32x2*)(rowp + bj * HALF + n * 16) = o; } }
    }
};
struct EpiOdd {
    bf16_t* P; bf16_t* Q; bf16_t* KA; const float* rope;
    __device__ __forceinline__ void operator()(const f32x4 (&acc)[2][2][4][2], const Unit& u, int wr, int wc, int fr, int fq) const {
        const int row0 = u.pm * BM + wr * 64 + fr, col0 = u.pn * BM + wc * 32 + 4 * fq;
        if (u.pn >= 6) {
#pragma unroll
            for (int ai = 0; ai < 2; ++ai)
#pragma unroll
                for (int m = 0; m < 4; ++m) { bf16_t* rowp = P + (size_t)(row0 + ai * HALF + m * 16) * P_LD + col0;
#pragma unroll
                    for (int bj = 0; bj < 2; ++bj)
#pragma unroll
                        for (int n = 0; n < 2; ++n) { const f32x4 v = acc[ai][bj][m][n]; u32x2 o; o.x = pk2(v[0], v[1]); o.y = pk2(v[2], v[3]); *(u32x2*)(rowp + bj * HALF + n * 16) = o; } }
            return;
        }
        const bool isk = u.pn >= 3, isctx = u.pm >= NLAT / BM; const int axis = wc & 1;
        const int cq = col0 - (isk ? 768 : 0);
#pragma unroll
        for (int ai = 0; ai < 2; ++ai)
#pragma unroll
            for (int m = 0; m < 4; ++m) { const int row = row0 + ai * HALF + m * 16;
                f32x4 cs = {1.f, 1.f, 1.f, 1.f}, sn = {0.f, 0.f, 0.f, 0.f}; size_t orow;
                if (!isctx) { const int t = row & (TT - 1); const int pos = axis ? 128 + (t & 63) : (t >> 6);
                    cs = *(const f32x4*)(rope + pos * 16 + 4 * fq); sn = *(const f32x4*)(rope + 192 * 16 + pos * 16 + 4 * fq);
                    orow = isk ? (size_t)(row >> 13) * LKEYS + CTXL + t : (size_t)row; }
                else { const int rc = row - NLAT; orow = isk ? (size_t)(rc >> 8) * LKEYS + (rc & 255) : (size_t)row; }
                bf16_t* op = (isk ? KA : Q) + orow * 768 + cq; const float sc = isk ? 1.f : QSCALE;
#pragma unroll
                for (int bj = 0; bj < 2; ++bj) { const f32x4 x1 = acc[ai][bj][m][0], x2 = acc[ai][bj][m][1];
                    const f32x4 o1 = (x1 * cs - x2 * sn) * sc, o2 = (x1 * sn + x2 * cs) * sc;
                    u32x2 a; a.x = pk2(o1[0], o1[1]); a.y = pk2(o1[2], o1[3]); *(u32x2*)(op + bj * HALF) = a;
                    u32x2 b; b.x = pk2(o2[0], o2[1]); b.y = pk2(o2[2], o2[3]); *(u32x2*)(op + bj * HALF + 16) = b; } }
    }
};
struct EpiRes {
    float* X; const float* modl;
    __device__ __forceinline__ void operator()(const f32x4 (&acc)[2][2][4][2], const Unit& u, int wr, int wc, int fr, int fq) const {
        const int row0 = u.pm * BM + wr * 64 + fr, col0 = u.pn * BM + wc * 32 + 4 * fq;
        const int mi = (u.pm * BM < NLAT) ? (u.pm * BM) / TT : 4;
        const float* gate = modl + mi * 6144 + 2 * DM;
        f32x4 gv[2][2];
#pragma unroll
        for (int bj = 0; bj < 2; ++bj)
#pragma unroll
            for (int n = 0; n < 2; ++n) gv[bj][n] = *(const f32x4*)(gate + col0 + bj * HALF + n * 16);
#pragma unroll
        for (int ai = 0; ai < 2; ++ai)
#pragma unroll
            for (int m = 0; m < 4; ++m) { float* rowp = X + (size_t)(row0 + ai * HALF + m * 16) * DM + col0;
#pragma unroll
                for (int bj = 0; bj < 2; ++bj)
#pragma unroll
                    for (int n = 0; n < 2; ++n) { f32x4* p = (f32x4*)(rowp + bj * HALF + n * 16); const f32x4 x = *p; *p = x * ALPHA_DN + gv[bj][n] * acc[ai][bj][m][n]; } }
    }
};
struct EpiSwiGLU {
    bf16_t* HID;
    __device__ __forceinline__ void operator()(const f32x4 (&acc)[2][2][4][2], const Unit& u, int wr, int wc, int fr, int fq) const {
        const int row0 = u.pm * BM + wr * 64 + fr, f0 = u.pn * HALF + wc * 32 + 4 * fq;
#pragma unroll
        for (int ai = 0; ai < 2; ++ai) if (ai == 0 || !u.hf)
#pragma unroll
            for (int m = 0; m < 4; ++m) { bf16_t* rowp = HID + (size_t)(row0 + ai * HALF + m * 16) * D_EXP + f0;
#pragma unroll
                for (int n = 0; n < 2; ++n) { const f32x4 a = acc[ai][0][m][n], b = acc[ai][1][m][n]; float h[4];
#pragma unroll
                    for (int j = 0; j < 4; ++j) h[j] = a[j] / (1.f + __expf(-a[j])) * b[j];
                    u32x2 o; o.x = pk2(h[0], h[1]); o.y = pk2(h[2], h[3]); *(u32x2*)(rowp + n * 16) = o; } }
    }
};
struct EpiYE {
    bf16_t* YE; const float* gate;
    __device__ __forceinline__ void operator()(const f32x4 (&acc)[2][2][4][2], const Unit& u, int wr, int wc, int fr, int fq) const {
        const int row0 = u.pm * BM + wr * 64 + fr, col0 = u.pn * BM + wc * 32 + 4 * fq;
#pragma unroll
        for (int ai = 0; ai < 2; ++ai) if (ai == 0 || !u.hf)
#pragma unroll
            for (int m = 0; m < 4; ++m) { const int row = row0 + ai * HALF + m * 16; const float gt = gate[row]; bf16_t* rowp = YE + (size_t)row * DM + col0;
#pragma unroll
                for (int bj = 0; bj < 2; ++bj)
#pragma unroll
                    for (int n = 0; n < 2; ++n) { const f32x4 v = acc[ai][bj][m][n] * gt; u32x2 o; o.x = pk2(v[0], v[1]); o.y = pk2(v[2], v[3]); *(u32x2*)(rowp + bj * HALF + n * 16) = o; } }
    }
};
struct EpiLora {
    unsigned char* SCN; bf16_t* G; const float* decay0; const float* a0; const float* kalpha;
    __device__ __forceinline__ void operator()(const f32x4 (&acc)[2][2][4][2], const Unit& u, int wr, int wc, int fr, int fq) const {
        const int row0 = u.pm * BM + wr * 64 + fr;
        const int seg = u.pn / 3, cb = (u.pn % 3) * BM + wc * 32 + 4 * fq;
#pragma unroll
        for (int bj = 0; bj < 2; ++bj)
#pragma unroll
            for (int n = 0; n < 2; ++n) {
                const int col = cb + bj * HALF + n * 16, head = col >> 6, kx = col & 63;
                if (seg < 2) {
                    const f32x4 d0 = *(const f32x4*)(decay0 + seg * 768 + col);
#pragma unroll
                    for (int ai = 0; ai < 2; ++ai)
#pragma unroll
                        for (int m = 0; m < 4; ++m) { const int row = row0 + ai * HALF + m * 16; f32x4 w;
#pragma unroll
                            for (int j = 0; j < 4; ++j) { const float lw = -DECAY_SCALE * sigmoidf_(d0[j] + acc[ai][bj][m][n][j]); w[j] = CHUNKED_SCAN ? lw : __expf(lw); }
                            *(f32x4*)(SCN + (size_t)(row * 12 + head) * SC_REC + SC_W + seg * 256 + kx * 4) = w; }
                } else if (seg < 4) {
                    const int d = seg - 2;
                    const f32x4 a00 = *(const f32x4*)(a0 + d * 768 + col), kal = *(const f32x4*)(kalpha + col);
#pragma unroll
                    for (int ai = 0; ai < 2; ++ai)
#pragma unroll
                        for (int m = 0; m < 4; ++m) { const int row = row0 + ai * HALF + m * 16; unsigned char* base = SCN + (size_t)(row * 12 + head) * SC_REC + kx * 2;
                            const f32x4 kk = ld4bf_(base + SC_KK); const f32x4 ks = ld4bf_(base + SC_KR + 256 * d); f32x4 bb, kr;
#pragma unroll
                            for (int j = 0; j < 4; ++j) { const float a = sigmoidf_(a00[j] + acc[ai][bj][m][n][j]); bb[j] = kk[j] * a; kr[j] = ks[j] * (1.f + (a - 1.f) * kal[j]); }
                            st4bf_(base + SC_B + 256 * d, bb); st4bf_(base + SC_KR + 256 * d, kr); }
                } else {
#pragma unroll
                    for (int ai = 0; ai < 2; ++ai)
#pragma unroll
                        for (int m = 0; m < 4; ++m) { const int row = row0 + ai * HALF + m * 16; const f32x4 v = acc[ai][bj][m][n]; u32x2 o; o.x = pk2(v[0], v[1]); o.y = pk2(v[2], v[3]);
                            *(u32x2*)(G + (size_t)row * 768 + col) = o; }
                }
            }
    }
};
}

struct Args { const float* in[37]; float* out; unsigned char* ws; int lo, hi; };
enum { I_X = 0, I_C, I_CTX, I_CCTX, I_WMOD, I_BMOD, I_LNG, I_LNB, I_EWIN, I_EWOUT, I_CONVW, I_MU, I_DUP, I_D0, I_AUP, I_A0, I_GUP, I_KXI, I_KAL, I_RBON, I_GNG, I_GNB,
       I_OWIN, I_OWOUT, I_LQ1, I_LK1, I_LQ2, I_LK2, I_SUBG, I_GLNG, I_GLNB, I_GWS, I_GBS, I_WR, I_WE1, I_WE3, I_WE2 };

struct Ctx {
    LAS unsigned char* lds;
    int tid, lane, wave, G, vcu, gw, NGW;
};
__device__ __forceinline__ void mkctx(Ctx& C, LAS unsigned char* lds) {
    int tid = threadIdx.x; asm volatile("" : "+v"(tid));
    C.lds = lds; C.tid = tid; C.lane = tid & 63; C.wave = __builtin_amdgcn_readfirstlane(tid >> 6);
    C.G = gridDim.x; { const int bx = blockIdx.x; C.vcu = (C.G % 8 == 0) ? (bx % 8) * (C.G / 8) + bx / 8 : bx; }
    C.gw = blockIdx.x * NWAVES + C.wave; C.NGW = C.G * NWAVES;
}
__device__ __forceinline__ void ldargs(Args& A, LAS unsigned char* lds) {
    LAS const u32x2* tb = (LAS const u32x2*)(lds + LDS_PTAB); asm volatile("" : "+v"(tb));
#pragma unroll
    for (int i = 0; i < 37; ++i) { const u32x2 v = tb[i]; A.in[i] = (const float*)(((unsigned long long)(unsigned)__builtin_amdgcn_readfirstlane((int)v.y) << 32) | (unsigned)__builtin_amdgcn_readfirstlane((int)v.x)); }
    { const u32x2 v = tb[37]; A.out = (float*)(((unsigned long long)(unsigned)__builtin_amdgcn_readfirstlane((int)v.y) << 32) | (unsigned)__builtin_amdgcn_readfirstlane((int)v.x)); }
    { const u32x2 v = tb[38]; A.ws = (unsigned char*)(((unsigned long long)(unsigned)__builtin_amdgcn_readfirstlane((int)v.y) << 32) | (unsigned)__builtin_amdgcn_readfirstlane((int)v.x)); }
    A.lo = 0; A.hi = 0;
}
__device__ __forceinline__ int row_mi(int row) { return row < NLAT ? (row >> 13) : 4; }

__device__ __forceinline__ void phase_init(const Ctx& C, const Args& A) {
    unsigned char* ws = A.ws;
    float* MOD = (float*)(ws + WS_MOD);
    LAS float* sv = (LAS float*)C.lds;
    LAS float* red = sv + 5 * 1024;
    for (int i = C.tid; i < 5 * 1024; i += NTHR) { const int v = i >> 10, k = i & 1023; const float c = (v < 4) ? A.in[I_C][v * DM + k] : A.in[I_CCTX][k]; sv[i] = c / (1.f + __expf(-c)); }
    __syncthreads();
    const int j = C.tid & 127, kp = C.tid >> 7;
    for (int it = blockIdx.x; it < DEPTH * 48; it += C.G) {
        const int l = it / 48, cg = it % 48, col = cg * 128 + j;
        const float* W = A.in[I_WMOD] + (size_t)l * DM * 6144 + col;
        float a0 = 0.f, a1 = 0.f, a2 = 0.f, a3 = 0.f, a4 = 0.f;
#pragma unroll 4
        for (int k = kp * 256; k < kp * 256 + 256; ++k) { const float w = W[(size_t)k * 6144]; a0 += sv[k] * w; a1 += sv[1024 + k] * w; a2 += sv[2048 + k] * w; a3 += sv[3072 + k] * w; a4 += sv[4096 + k] * w; }
        red[(kp * 5 + 0) * 128 + j] = a0; red[(kp * 5 + 1) * 128 + j] = a1; red[(kp * 5 + 2) * 128 + j] = a2; red[(kp * 5 + 3) * 128 + j] = a3; red[(kp * 5 + 4) * 128 + j] = a4;
        __syncthreads();
        for (int o = C.tid; o < 5 * 128; o += NTHR) { const int v = o >> 7, jj = o & 127; const int cc = cg * 128 + jj;
            const float s = red[(0 * 5 + v) * 128 + jj] + red[(1 * 5 + v) * 128 + jj] + red[(2 * 5 + v) * 128 + jj] + red[(3 * 5 + v) * 128 + jj];
            MOD[((size_t)l * 5 + v) * 6144 + cc] = s + A.in[I_BMOD][l * 6144 + cc]; }
        __syncthreads();
    }
    if (blockIdx.x == C.G - 1) { float* rope = (float*)(ws + WS_ROPE);
        for (int i = C.tid; i < 192 * 16; i += NTHR) { const int pos = i >> 4, j = i & 15; const float ang = (float)(pos < 128 ? pos : pos - 128) * powf(10000.f, -(float)j * (1.f / 16.f));
            rope[i] = cosf(ang); rope[192 * 16 + i] = sinf(ang); } }
    f32x4* X4 = (f32x4*)(ws + WS_X);
    const f32x4* x4 = (const f32x4*)A.in[I_X]; const f32x4* c4 = (const f32x4*)A.in[I_CTX];
    const size_t nl = (size_t)NLAT * DM / 4, nc = (size_t)NCTX * DM / 4;
    for (size_t i = (size_t)blockIdx.x * NTHR + C.tid; i < nl + nc; i += (size_t)C.G * NTHR) X4[i] = (i < nl) ? x4[i] : c4[i - nl];
}

__device__ __forceinline__ void transpose_item(const float* W, int ldw, int k0, int n0, bf16_t* WT, int ldt, int drow0, LAS float* scr, int lane) {
    { float v[64]; const float* src = W + (size_t)k0 * ldw + n0 + lane;
#pragma unroll
      for (int k = 0; k < 64; ++k) v[k] = __builtin_nontemporal_load(src + (size_t)k * ldw);
#pragma unroll
      for (int k = 0; k < 64; ++k) scr[k * 65 + lane] = v[k]; }
    asm volatile("s_waitcnt lgkmcnt(0)" ::: "memory");
    const int c = lane & 7;
#pragma unroll
    for (int j = 0; j < 8; ++j) { const int n = (lane >> 3) + 8 * j; const LAS float* s = scr + (8 * c) * 65 + n;
        u32x4 o; o.x = pk2(s[0 * 65], s[1 * 65]); o.y = pk2(s[2 * 65], s[3 * 65]); o.z = pk2(s[4 * 65], s[5 * 65]); o.w = pk2(s[6 * 65], s[7 * 65]);
        *(u32x4*)(WT + (size_t)(drow0 + n) * ldt + k0 + 8 * c) = o; }
    asm volatile("s_waitcnt lgkmcnt(0)" ::: "memory");
}
__device__ __forceinline__ void conv_items(const Ctx& C, const Args& A, int l, int gw, int NGW, bool do_in, bool do_out, bool do_exp) {
    unsigned char* ws = A.ws;
    const int i2 = l >> 1; const bool odd = (l & 1);
    LAS float* scr = (LAS float*)C.lds + C.wave * (64 * 65);
    bf16_t* WIN = (bf16_t*)(ws + WS_WIN); bf16_t* WOUT = (bf16_t*)(ws + WS_WOUT); bf16_t* WE13 = (bf16_t*)(ws + WS_WE13 + (size_t)(l & 1) * WE13_BYTES); bf16_t* WE2 = (bf16_t*)(ws + WS_WE2 + (size_t)(l & 1) * WE2_BYTES);
    const int nin = odd ? D_IN_ODD : D_IN_EVEN;
    const float* win = odd ? A.in[I_OWIN] + (size_t)i2 * DM * D_IN_ODD : A.in[I_EWIN] + (size_t)i2 * DM * D_IN_EVEN;
    const float* wout = odd ? A.in[I_OWOUT] + (size_t)i2 * DM * DM : A.in[I_EWOUT] + (size_t)i2 * DM * DM;
    const int n_in = do_in ? 16 * (nin / 64) : 0, n_out = do_out ? 16 * 16 : 0, n_e13 = do_exp ? NEXP * 2 * 16 * 32 : 0, n_e2 = do_exp ? NEXP * 32 * 16 : 0;
    const int total = n_in + n_out + n_e13 + n_e2;
    for (int it = gw; it < total; it += NGW) {
        int r = it;
        if (r < n_in) { const int nb = nin / 64, kb = r / nb, nn = r % nb; transpose_item(win, nin, kb * 64, nn * 64, WIN, DM, nn * 64, scr, C.lane); continue; } r -= n_in;
        if (r < n_out) { const int kb = r / 16, nn = r % 16; transpose_item(wout, DM, kb * 64, nn * 64, WOUT, DM, nn * 64, scr, C.lane); continue; } r -= n_out;
        if (r < n_e13) { const int e = r / 1024, q = r % 1024, mat = q / 512, q2 = q % 512, kb = q2 / 32, nn = q2 % 32;
            const float* W = (mat ? A.in[I_WE3] : A.in[I_WE1]) + ((size_t)l * NEXP + e) * DM * D_EXP;
            const int f0 = nn * 64; const int drow = (f0 >> 7) * 256 + mat * 128 + (f0 & 127);
            transpose_item(W, D_EXP, kb * 64, f0, WE13 + (size_t)e * 4096 * DM, DM, drow, scr, C.lane); continue; } r -= n_e13;
        { const int e = r / 512, q = r % 512, kb = q / 16, nn = q % 16;
            const float* W = A.in[I_WE2] + ((size_t)l * NEXP + e) * D_EXP * DM;
            transpose_item(W, DM, kb * 64, nn * 64, WE2 + (size_t)e * DM * D_EXP, D_EXP, nn * 64, scr, C.lane); }
    }
}
__device__ __forceinline__ void phase_conv(const Ctx& C, const Args& A, int l) {
    unsigned char* ws = A.ws;
    const int i2 = l >> 1; const bool odd = (l & 1);
    bf16_t* WIN = (bf16_t*)(ws + WS_WIN);
    const bool early = CHUNKED_SCAN && odd;
    conv_items(C, A, l, C.gw, C.NGW, !early, true, !early);
    if (!odd) {
        u32x4* z = (u32x4*)(WIN + (size_t)D_IN_EVEN * DM);
        unsigned zz = 0u; asm volatile("" : "+v"(zz));
        for (int i = blockIdx.x * NTHR + C.tid; i < (D_IN_EVEN_PAD - D_IN_EVEN) * DM / 8; i += C.G * NTHR) z[i] = (u32x4){zz, zz, zz, zz};
        bf16_t* WL = (bf16_t*)(ws + WS_WLORA);
        const float* dup = A.in[I_DUP] + (size_t)i2 * 2 * 64 * 768; const float* aup = A.in[I_AUP] + (size_t)i2 * 2 * 64 * 768; const float* gup = A.in[I_GUP] + (size_t)i2 * 128 * 768;
        for (int i = blockIdx.x * NTHR + C.tid; i < LORA_N * LORA_K; i += C.G * NTHR) {
            const int kk = i / LORA_N, n = i % LORA_N, seg = n / 768, col = n % 768; float v = 0.f;
            if (seg == 0) { if (kk < 64) v = dup[(size_t)(0 * 64 + kk) * 768 + col]; }
            else if (seg == 1) { if (kk >= 64 && kk < 128) v = dup[(size_t)(1 * 64 + kk - 64) * 768 + col]; }
            else if (seg == 2) { if (kk >= 128 && kk < 192) v = aup[(size_t)(0 * 64 + kk - 128) * 768 + col]; }
            else if (seg == 3) { if (kk >= 192 && kk < 256) v = aup[(size_t)(1 * 64 + kk - 192) * 768 + col]; }
            else { if (kk >= 256) v = gup[(size_t)(kk - 256) * 768 + col]; }
            WL[(size_t)n * LORA_K + kk] = (bf16_t)f2bf(v);
        }
    }
}

__device__ __forceinline__ void phase_modh(const Ctx& C, const Args& A, int l) {
    const float* X = (const float*)(A.ws + WS_X); bf16_t* H = (bf16_t*)(A.ws + WS_H); const float* MOD = (const float*)(A.ws + WS_MOD) + (size_t)l * 5 * 6144;
    for (int row = C.gw; row < MROWS; row += C.NGW) {
        const float* md = MOD + row_mi(row) * 6144;
#pragma unroll
        for (int j = 0; j < 4; ++j) { const int col = 4 * C.lane + 256 * j; const f32x4 x = *(const f32x4*)(X + (size_t)row * DM + col), sh = *(const f32x4*)(md + col), sc = *(const f32x4*)(md + DM + col);
            const f32x4 h = x * (sc + 1.f) + sh; u32x2 o; o.x = pk2(h[0], h[1]); o.y = pk2(h[2], h[3]); *(u32x2*)(H + (size_t)row * DM + col) = o; }
    }
}

__device__ __forceinline__ f32x4 ld4bf(const bf16_t* p) { const u32x2 u = *(const u32x2*)p; return (f32x4){bflo(u.x), bfhi(u.x), bflo(u.y), bfhi(u.y)}; }
__device__ __forceinline__ void st4bf(bf16_t* p, f32x4 v) { u32x2 o; o.x = pk2(v[0], v[1]); o.y = pk2(v[2], v[3]); *(u32x2*)p = o; }
__device__ __forceinline__ void seq_info(int row, bool& hasp, bool& hasn) {
    if (row < NLAT) { const int t = row & (TT - 1); hasp = t > 0; hasn = t < TT - 1; }
    else { const int t = (row - NLAT) & (CTXL - 1); hasp = t > 0; hasn = t < CTXL - 1; }
}
__device__ __forceinline__ void phase_ef1(const Ctx& C, const Args& A, int l) {
    const int i2 = l >> 1; unsigned char* ws = A.ws;
    const bf16_t* P = (const bf16_t*)(ws + WS_P); bf16_t* A2 = (bf16_t*)(ws + WS_A2); unsigned char* SCN = ws + WS_SCN; bf16_t* LIN = (bf16_t*)(ws + WS_LIN);
    const float* cw = A.in[I_CONVW] + (size_t)i2 * 3 * 256; const float* mu = A.in[I_MU] + (size_t)i2 * RWKV_COLS; const float* kxi = A.in[I_KXI] + (size_t)i2 * 768;
    const f32x4 z4 = {0.f, 0.f, 0.f, 0.f};
    for (int row = C.gw; row < MROWS; row += C.NGW) {
        bool hasp, hasn; seq_info(row, hasp, hasn);
        const bf16_t* p0 = P + (size_t)row * P_LD; const bf16_t* pm = p0 - P_LD; const bf16_t* pp = p0 + P_LD;
        {
            const int j4 = 4 * C.lane;
            const f32x4 bg = ld4bf(p0 + j4), u0 = ld4bf(p0 + 256 + j4) * ld4bf(p0 + 512 + j4);
            const f32x4 um = hasp ? ld4bf(pm + 256 + j4) * ld4bf(pm + 512 + j4) : z4, up = hasn ? ld4bf(pp + 256 + j4) * ld4bf(pp + 512 + j4) : z4;
            const f32x4 w0 = *(const f32x4*)(cw + j4), w1 = *(const f32x4*)(cw + 256 + j4), w2 = *(const f32x4*)(cw + 512 + j4);
            st4bf(A2 + (size_t)row * DM + j4, bg * (w0 * um + w1 * u0 + w2 * up));
        }
#pragma unroll
        for (int it = 0; it < 11; ++it) {
            const int c = it * 256 + 4 * C.lane;
            if (c < RWKV_COLS) {
                const f32x4 x0 = ld4bf(p0 + 768 + c), xm = hasp ? ld4bf(pm + 768 + c) : z4, xp = hasn ? ld4bf(pp + 768 + c) : z4, m4 = *(const f32x4*)(mu + c);
                const f32x4 ps = x0 + m4 * ((xm + xp) * 0.5f - x0);
                if (it < 3) { const int head = c >> 6, kx = c & 63; st4bf_(SCN + (size_t)(row * 12 + head) * SC_REC + SC_R + kx * 2, ps); }
                else if (it < 6) { const int c1 = c - 768, head = c1 >> 6, kx = c1 & 63; const f32x4 kv = ps * *(const f32x4*)(kxi + c1);
                    const float ss = sum16(kv[0] * kv[0] + kv[1] * kv[1] + kv[2] * kv[2] + kv[3] * kv[3]); const float rn = rsqrtf(ss + 1e-12f);
                    unsigned char* base = SCN + (size_t)(row * 12 + head) * SC_REC + kx * 2;
                    st4bf_(base + SC_KK, kv * rn); st4bf_(base + SC_KR, ps); st4bf_(base + SC_KR + 256, ps); }
                else if (it < 9) { const int c1 = c - 1536, head = c1 >> 6, kx = c1 & 63; st4bf_(SCN + (size_t)(row * 12 + head) * SC_REC + SC_V + kx * 2, ps); }
                else { const int c1 = c - 2304; f32x4 o;
                    if (c1 < 128) { o = (f32x4){tanhf(ps[0]), tanhf(ps[1]), tanhf(ps[2]), tanhf(ps[3])}; }
                    else if (c1 < 256) { o = ps; }
                    else { o = (f32x4){sigmoidf_(ps[0]), sigmoidf_(ps[1]), sigmoidf_(ps[2]), sigmoidf_(ps[3])}; }
                    st4bf(LIN + (size_t)row * LORA_K + c1, o); }
            }
        }
    }
}

__device__ __forceinline__ int scan_row(int i, int b, int d) {
    if (d == 0) return i < CTXL ? NLAT + b * CTXL + i : b * TT + (i - CTXL);
    return i < CTXL ? NLAT + b * CTXL + (CTXL - 1 - i) : b * TT + (TT - 1 - (i - CTXL));
}
__device__ __forceinline__ float red8(float v) {
    v += __uint_as_float((unsigned)__builtin_amdgcn_update_dpp(0, (int)__float_as_uint(v), 0xB1, 0xF, 0xF, true));
    v += __uint_as_float((unsigned)__builtin_amdgcn_update_dpp(0, (int)__float_as_uint(v), 0x4E, 0xF, 0xF, true));
    v += __uint_as_float((unsigned)__builtin_amdgcn_update_dpp(0, (int)__float_as_uint(v), 0x141, 0xF, 0xF, true));
    return v;
}
__device__ __forceinline__ float red16(float v) {
    v += __uint_as_float((unsigned)__builtin_amdgcn_update_dpp(0, (int)__float_as_uint(v), 0xB1, 0xF, 0xF, true));
    v += __uint_as_float((unsigned)__builtin_amdgcn_update_dpp(0, (int)__float_as_uint(v), 0x4E, 0xF, 0xF, true));
    v += __uint_as_float((unsigned)__builtin_amdgcn_update_dpp(0, (int)__float_as_uint(v), 0x141, 0xF, 0xF, true));
    v += __uint_as_float((unsigned)__builtin_amdgcn_update_dpp(0, (int)__float_as_uint(v), 0x140, 0xF, 0xF, true));
    return v;
}
__device__ __forceinline__ void phase_scan(const Ctx& C, const Args& A) {
    for (int u = blockIdx.x; u < 192; u += C.G) {
    const int half = u & 1, d = (u >> 1) & 1, h = (u >> 2) % 12, b = u / 48;
    const unsigned char* SCN = A.ws + WS_SCN; float* Y = (float*)(A.ws + WS_Y) + (size_t)d * MROWS * 768;
    LAS float* buf = (LAS float*)C.lds; LAS float* ybuf = buf + 2 * 32 * 352;
    constexpr int NCH = LKEYS / 32;
    u32x4 st[4];
    int ps_[4], psrc[4], pdst[4]; bool pf32[4];
#pragma unroll
    for (int j = 0; j < 4; ++j) { const int p = C.tid + NTHR * j; const int s = p / 52, q = p % 52; ps_[j] = s;
        if (q < 16) { psrc[j] = SC_W + 256 * d + q * 16; pdst[j] = s * 352 + q * 4; pf32[j] = true; }
        else if (q < 48) { const int vec = (q - 16) >> 3, part = (q - 16) & 7; const int so = vec == 0 ? SC_KK : vec == 1 ? SC_B + 256 * d : vec == 2 ? SC_KR + 256 * d : SC_R;
            psrc[j] = so + part * 16; pdst[j] = s * 352 + 64 * (vec + 1) + part * 8; pf32[j] = false; }
        else { const int part = q - 48; psrc[j] = SC_V + half * 64 + part * 16; pdst[j] = s * 352 + 320 + part * 8; pf32[j] = false; } }
    const int sgn = d ? -1 : 1;
    const unsigned char* SCNh = SCN + (size_t)h * SC_REC;
#define SCAN_ROW0(c) (((c) * 32 < CTXL) ? (NLAT + b * CTXL + (d ? CTXL - 1 - (c) * 32 : (c) * 32)) : (b * TT + (d ? TT - 1 - ((c) * 32 - CTXL) : (c) * 32 - CTXL)))
#define SCAN_LOADG(c) do { const int row0_ = SCAN_ROW0(c); _Pragma("unroll") for (int j = 0; j < 4; ++j) if (j < 3 || C.tid < 1664 - 3 * NTHR) { \
        st[j] = *(const u32x4*)(SCNh + (size_t)(row0_ + sgn * ps_[j]) * SC_ROW + psrc[j]); } } while (0)
#define SCAN_STORE(bi) do { _Pragma("unroll") for (int j = 0; j < 4; ++j) if (j < 3 || C.tid < 1664 - 3 * NTHR) { LAS float* dp = buf + (bi) * (32 * 352) + pdst[j]; \
        if (pf32[j]) *(LAS u32x4*)dp = st[j]; \
        else { *(LAS f32x4*)dp = (f32x4){bflo(st[j].x), bfhi(st[j].x), bflo(st[j].y), bfhi(st[j].y)}; *(LAS f32x4*)(dp + 4) = (f32x4){bflo(st[j].z), bfhi(st[j].z), bflo(st[j].w), bfhi(st[j].w)}; } } } while (0)
    SCAN_LOADG(0); SCAN_STORE(0); __syncthreads();
    f32x2 Sa = {0.f, 0.f}, Sb = {0.f, 0.f};
    const int rl = C.lane >> 4, ks = C.lane & 15;
    float ycol = 0.f;
#define SC_LD(R, s) do { const LAS float* bp_ = cur + (s) * 352 + ks * 4; \
        R##w = *(const LAS f32x4*)(bp_); R##k = *(const LAS f32x4*)(bp_ + 64); R##b = *(const LAS f32x4*)(bp_ + 128); R##q = *(const LAS f32x4*)(bp_ + 192); R##r = *(const LAS f32x4*)(bp_ + 256); \
        R##vv = cur[(s) * 352 + 320 + C.wave * 4 + rl]; } while (0)
#define SC_LO(v) ((f32x2){v[0], v[1]})
#define SC_HI(v) ((f32x2){v[2], v[3]})
#define SC_DPP(x, ctrl) __uint_as_float((unsigned)__builtin_amdgcn_update_dpp(0, (int)__float_as_uint(x), ctrl, 0xF, 0xF, true))
#define SC_STEP(R, P, s) do { \
        f32x2 pa = __builtin_elementwise_fma(Sb, SC_HI(R##k), Sa * SC_LO(R##k)), py = __builtin_elementwise_fma(Sb, SC_HI(P##r), Sa * SC_LO(P##r)); \
        float a_ = pa.x + pa.y, y_ = py.x + py.y; \
        a_ += SC_DPP(a_, 0xB1); y_ += SC_DPP(y_, 0xB1); a_ += SC_DPP(a_, 0x4E); y_ += SC_DPP(y_, 0x4E); \
        a_ += SC_DPP(a_, 0x141); y_ += SC_DPP(y_, 0x141); a_ += SC_DPP(a_, 0x140); y_ += SC_DPP(y_, 0x140); \
        ycol = (ks == ((s) & 15)) ? y_ : ycol; \
        const f32x2 na = {-a_, -a_}, vv2 = {R##vv, R##vv}; \
        Sa = __builtin_elementwise_fma(Sa, SC_LO(R##w), __builtin_elementwise_fma(na, SC_LO(R##b), vv2 * SC_LO(R##q))); \
        Sb = __builtin_elementwise_fma(Sb, SC_HI(R##w), __builtin_elementwise_fma(na, SC_HI(R##b), vv2 * SC_HI(R##q))); } while (0)
    f32x4 Aw, Ak, Ab, Aq, Ar, Bw, Bk, Bb, Bq, Br, Cw, Ck, Cb, Cq, Cr, Dw, Dk, Db, Dq, Dr; float Avv, Bvv, Cvv, Dvv;
    Dr = (f32x4){0.f, 0.f, 0.f, 0.f};
    for (int c = 0; c < NCH; ++c) {
        if (c + 1 < NCH) SCAN_LOADG(c + 1);
        {
            const LAS float* cur = buf + (c & 1) * (32 * 352);
            LAS float* yb = ybuf + (c & 1) * 1024 + C.wave * 4 + rl + ks * 32;
            SC_LD(A, 0); SC_LD(B, 1);
#pragma unroll 1
            for (int s = 0; s < 32; s += 4) {
                SC_LD(C, s + 2); __builtin_amdgcn_sched_barrier(0); SC_STEP(A, D, s); __builtin_amdgcn_sched_barrier(0);
                SC_LD(D, s + 3); __builtin_amdgcn_sched_barrier(0); SC_STEP(B, A, s + 1); __builtin_amdgcn_sched_barrier(0);
                SC_LD(A, s + 4); __builtin_amdgcn_sched_barrier(0); SC_STEP(C, B, s + 2); __builtin_amdgcn_sched_barrier(0);
                SC_LD(B, s + 5); __builtin_amdgcn_sched_barrier(0); SC_STEP(D, C, s + 3); __builtin_amdgcn_sched_barrier(0);
                if ((s & 15) == 12) yb[(s & 16) * 32] = ycol;
            }
        }
        if (c + 1 < NCH) SCAN_STORE((c + 1) & 1);
        __syncthreads();
        { const int row0_ = SCAN_ROW0(c);
#pragma unroll
          for (int i = 0; i < 2; ++i) { const int e = C.tid + NTHR * i, s = e >> 5, r = e & 31;
            const int row = (s > 0) ? row0_ + sgn * (s - 1) : scan_row(c * 32 - 1, b, d);
            if (s > 0 || c > 0) Y[(size_t)row * 768 + h * 64 + half * 32 + r] = ybuf[(c & 1) * 1024 + e]; } }
    }
    {
        f32x2 py = __builtin_elementwise_fma(Sb, SC_HI(Dr), Sa * SC_LO(Dr)); float y_ = py.x + py.y;
        y_ += SC_DPP(y_, 0xB1); y_ += SC_DPP(y_, 0x4E); y_ += SC_DPP(y_, 0x141); y_ += SC_DPP(y_, 0x140);
        if (ks == 0) Y[(size_t)scan_row(LKEYS - 1, b, d) * 768 + h * 64 + half * 32 + C.wave * 4 + rl] = y_;
    }
    __syncthreads();
    }
#undef SCAN_LOADG
#undef SCAN_STORE
#undef SCAN_ROW0
#undef SC_LD
#undef SC_STEP
#undef SC_LO
#undef SC_HI
#undef SC_DPP
}

constexpr int CSP = 72;
constexpr int CS_MAT = 64 * CSP * 2;
constexpr int CS_WT = 0, CS_KB = CS_MAT, CS_BB = 2 * CS_MAT, CS_RT = 3 * CS_MAT, CS_BHT = 4 * CS_MAT, CS_KHT = 5 * CS_MAT, CS_VMT = 6 * CS_MAT;
constexpr int CS_M2F = 7 * CS_MAT;
constexpr int CS_M1T = CS_M2F + 16384;
constexpr int CS_N2 = CS_M1T + CS_MAT;
constexpr int CS_GT = CS_N2 + CS_MAT;
constexpr int CS_Z = CS_M2F, CS_U = CS_M2F + CS_MAT;
constexpr int CS_GL = CS_GT + 2 * CS_MAT;
static_assert(CS_GL + 256 <= LDS_MISC, "chunked-scan LDS map");
template <bool SWZB = false>
__device__ __forceinline__ void cs_mma(f32x16& acc, const LAS unsigned char* Am, const LAS unsigned char* Bm, int ti, int tj, int r32, int hi) {
    const LAS unsigned char* ap = Am + (ti * 32 + r32) * (CSP * 2) + hi * 16; const int brow = tj * 32 + r32; const LAS unsigned char* bp = Bm + brow * (CSP * 2);
    const int sw = SWZB ? ((brow >> 3) & 7) : 0;
#pragma unroll
    for (int ks = 0; ks < 4; ++ks) acc = __builtin_amdgcn_mfma_f32_32x32x16_bf16(*(const LAS bf16x8*)(ap + ks * 32), *(const LAS bf16x8*)(bp + (((ks * 2 + hi) ^ sw) * 16)), acc, 0, 0, 0);
}
__device__ __forceinline__ void cs_store_t(LAS unsigned char* Om, const f32x16& acc, int ti, int tj, int r32, int hi) {
    LAS unsigned char* op = Om + (tj * 32 + r32) * (CSP * 2) + (ti * 32 + 4 * hi) * 2;
#pragma unroll
    for (int g = 0; g < 4; ++g) { u32x2 o; o.x = pk2(acc[4 * g], acc[4 * g + 1]); o.y = pk2(acc[4 * g + 2], acc[4 * g + 3]); *(LAS u32x2*)(op + g * 16) = o; }
}
#define CS_BAR() asm volatile("s_waitcnt lgkmcnt(0)\n\ts_barrier" ::: "memory")
__device__ __forceinline__ void phase_csa(const Ctx& C, const Args& A) {
    const unsigned char* SCN = A.ws + WS_SCN; unsigned char* CHK = A.ws + WS_CHK;
    LAS unsigned char* L = C.lds;
    const int r32 = C.lane & 31, hi = C.lane >> 5;
    float lwv[8]; u32x4 ukk, ub, ukr, ur, uv;
#define CSA_GEOM(cu_) const int unit = (cu_) / CS_NCH, ch = (cu_) % CS_NCH; const int d = unit & 1, h = (unit >> 1) % 12, b = unit / 24; \
        const int step0 = ch * CS_L; const int sgn = d ? -1 : 1; \
        const int row0 = (step0 < CTXL) ? (NLAT + b * CTXL + (d ? CTXL - 1 - step0 : step0)) : (b * TT + (d ? TT - 1 - (step0 - CTXL) : step0 - CTXL)); \
        const unsigned char* rec0 = SCN + (size_t)row0 * SC_ROW + (size_t)h * SC_REC;
#define CSA_LOAD(cu_) do { CSA_GEOM(cu_); \
        { const int k = C.tid & 63, sg = C.tid >> 6; _Pragma("unroll") for (int j = 0; j < 8; ++j) lwv[j] = *(const float*)(rec0 + (long)sgn * (8 * sg + j) * SC_ROW + SC_W + 256 * d + k * 4); } \
        { const int t = C.tid >> 3, k0 = (C.tid & 7) * 8; const unsigned char* rp = rec0 + (long)sgn * t * SC_ROW; \
          ukk = *(const u32x4*)(rp + SC_KK + k0 * 2); ub = *(const u32x4*)(rp + SC_B + 256 * d + k0 * 2); ukr = *(const u32x4*)(rp + SC_KR + 256 * d + k0 * 2); ur = *(const u32x4*)(rp + SC_R + k0 * 2); uv = *(const u32x4*)(rp + SC_V + k0 * 2); } } while (0)
    if ((int)blockIdx.x < CS_UNITS * CS_NCH) CSA_LOAD((int)blockIdx.x);
    for (int cu = blockIdx.x; cu < CS_UNITS * CS_NCH; cu += C.G) {
        LAS float* csf = (LAS float*)(L + CS_M2F);
        LAS float* seg = (LAS float*)(L + CS_N2);
        { const int k = C.tid & 63, sg = C.tid >> 6;
#pragma unroll
          for (int j = 1; j < 8; ++j) lwv[j] += lwv[j - 1];
          seg[sg * 64 + k] = lwv[7];
          CS_BAR();
          float off = 0.f, tot = 0.f;
#pragma unroll
          for (int s2 = 0; s2 < 8; ++s2) { const float v = seg[s2 * 64 + k]; off += (s2 < sg) ? v : 0.f; tot += v; }
#pragma unroll
          for (int j = 0; j < 8; ++j) csf[(8 * sg + j) * 65 + k] = lwv[j] + off;
          if (sg == 7) ((LAS float*)(L + CS_GL))[k] = __expf(tot); }
        CS_BAR();
        { const int t = C.tid >> 3, k0 = (C.tid & 7) * 8;
          float wt[8], kb[8], bb[8], rt[8], bh[8], kh[8];
#pragma unroll
          for (int j = 0; j < 8; ++j) { const unsigned pkk = j < 2 ? ukk.x : j < 4 ? ukk.y : j < 6 ? ukk.z : ukk.w, pb = j < 2 ? ub.x : j < 4 ? ub.y : j < 6 ? ub.z : ub.w, pkr = j < 2 ? ukr.x : j < 4 ? ukr.y : j < 6 ? ukr.z : ukr.w, pr = j < 2 ? ur.x : j < 4 ? ur.y : j < 6 ? ur.z : ur.w;
              const float kkv = (j & 1) ? bfhi(pkk) : bflo(pkk), bv = (j & 1) ? bfhi(pb) : bflo(pb), krv = (j & 1) ? bfhi(pkr) : bflo(pkr), rv = (j & 1) ? bfhi(pr) : bflo(pr);
              const float cst = csf[t * 65 + k0 + j], csp = t > 0 ? csf[(t - 1) * 65 + k0 + j] : 0.f, csl = csf[63 * 65 + k0 + j];
              const float einv = __expf(-cst), el = __expf(csl - cst);
              wt[j] = kkv * __expf(csp); kb[j] = krv * einv; bb[j] = bv * einv; rt[j] = rv * __expf(cst); bh[j] = bv * el; kh[j] = krv * el; }
          u32x4 o;
          o.x = pk2(wt[0], wt[1]); o.y = pk2(wt[2], wt[3]); o.z = pk2(wt[4], wt[5]); o.w = pk2(wt[6], wt[7]); *(LAS u32x4*)(L + CS_WT + t * (CSP * 2) + k0 * 2) = o;
          o.x = pk2(kb[0], kb[1]); o.y = pk2(kb[2], kb[3]); o.z = pk2(kb[4], kb[5]); o.w = pk2(kb[6], kb[7]); *(LAS u32x4*)(L + CS_KB + t * (CSP * 2) + k0 * 2) = o;
          o.x = pk2(bb[0], bb[1]); o.y = pk2(bb[2], bb[3]); o.z = pk2(bb[4], bb[5]); o.w = pk2(bb[6], bb[7]); *(LAS u32x4*)(L + CS_BB + t * (CSP * 2) + k0 * 2) = o;
          o.x = pk2(rt[0], rt[1]); o.y = pk2(rt[2], rt[3]); o.z = pk2(rt[4], rt[5]); o.w = pk2(rt[6], rt[7]); *(LAS u32x4*)(L + CS_RT + t * (CSP * 2) + k0 * 2) = o;
#pragma unroll
          for (int j = 0; j < 8; ++j) { const int to = ((((t >> 3) ^ ((k0 >> 3) & 7)) * 8) + (t & 7)) * 2;
              *(LAS bf16_t*)(L + CS_BHT + (k0 + j) * (CSP * 2) + to) = (bf16_t)f2bf(bh[j]); *(LAS bf16_t*)(L + CS_KHT + (k0 + j) * (CSP * 2) + to) = (bf16_t)f2bf(kh[j]);
              const unsigned pv = j < 2 ? uv.x : j < 4 ? uv.y : j < 6 ? uv.z : uv.w; *(LAS bf16_t*)(L + CS_VMT + (k0 + j) * (CSP * 2) + to) = (bf16_t)((j & 1) ? (pv >> 16) : (pv & 0xffffu)); } }
        if (cu + C.G < CS_UNITS * CS_NCH) CSA_LOAD(cu + C.G);
        CS_BAR();
        for (int job = C.wave; job < 12; job += NWAVES) { const int p = job >> 2, ti = (job >> 1) & 1, tj = job & 1;
            f32x16 acc;
#pragma unroll
            for (int i = 0; i < 16; ++i) acc[i] = 0.f;
            if (p == 0) { cs_mma(acc, L + CS_WT, L + CS_BB, ti, tj, r32, hi);
                const int i = tj * 32 + r32; LAS float* mp = (LAS float*)(L + CS_M2F) + i * 64;
#pragma unroll
                for (int reg = 0; reg < 16; ++reg) { const int t = ti * 32 + crow(reg, hi); mp[(t & 3) * 16 + (t >> 2)] = (i < t) ? acc[reg] : 0.f; } }
            else if (p == 1) { cs_mma(acc, L + CS_WT, L + CS_KB, ti, tj, r32, hi);
                const int i = tj * 32 + r32;
#pragma unroll
                for (int reg = 0; reg < 16; ++reg) { const int t = ti * 32 + crow(reg, hi); acc[reg] = (i < t) ? acc[reg] : 0.f; }
                cs_store_t(L + CS_M1T, acc, ti, tj, r32, hi); }
            else { cs_mma(acc, L + CS_BB, L + CS_RT, ti, tj, r32, hi);
                const int t = tj * 32 + r32;
#pragma unroll
                for (int reg = 0; reg < 16; ++reg) { const int i = ti * 32 + crow(reg, hi); acc[reg] = (i <= t) ? acc[reg] : 0.f; }
                cs_store_t(L + CS_N2, acc, ti, tj, r32, hi); } }
        CS_BAR();
        { const int c = C.tid >> 2, q = C.tid & 3; float acc[16];
          { const LAS unsigned char* rcol = (c < 64) ? (L + CS_WT + c * 2) : (L + CS_M1T + (c - 64) * (CSP * 2)); const int rstride = (c < 64) ? CSP * 2 : 2;
#pragma unroll
            for (int j = 0; j < 16; ++j) acc[j] = bf2f(*(const LAS bf16_t*)(rcol + (4 * j + q) * rstride)); }
          const LAS float* m2c = (const LAS float*)(L + CS_M2F) + q * 16;
#pragma clang loop unroll(full)
          for (int i = 0; i < 64; ++i) {
              const float mine = -acc[i >> 2];
              float gi;
              switch (i & 3) { case 0: gi = __uint_as_float((unsigned)__builtin_amdgcn_update_dpp(0, (int)__float_as_uint(mine), 0x00, 0xF, 0xF, true)); break;
                               case 1: gi = __uint_as_float((unsigned)__builtin_amdgcn_update_dpp(0, (int)__float_as_uint(mine), 0x55, 0xF, 0xF, true)); break;
                               case 2: gi = __uint_as_float((unsigned)__builtin_amdgcn_update_dpp(0, (int)__float_as_uint(mine), 0xAA, 0xF, 0xF, true)); break;
                               default: gi = __uint_as_float((unsigned)__builtin_amdgcn_update_dpp(0, (int)__float_as_uint(mine), 0xFF, 0xF, 0xF, true)); break; }
#pragma unroll
              for (int j4 = (i >> 4); j4 < 4; ++j4) { const f32x4 m = *(const LAS f32x4*)(m2c + i * 64 + j4 * 4);
#pragma unroll
                  for (int e = 0; e < 4; ++e) if (4 * j4 + e >= (i >> 2)) acc[4 * j4 + e] += m[e] * gi; }
          }
#pragma unroll
          for (int j = 0; j < 16; ++j) *(LAS bf16_t*)(L + CS_GT + c * (CSP * 2) + (4 * j + q) * 2) = (bf16_t)f2bf(-acc[j]); }
        CS_BAR();
        unsigned char* outp = CHK + (size_t)cu * 32768;
        for (int job = C.wave; job < 16; job += NWAVES) { const int p = job >> 2, ti = (job >> 1) & 1, tj = job & 1;
            f32x16 acc;
            if (p == 0) {
                const LAS unsigned char* rp = L + CS_RT + (tj * 32 + r32) * (CSP * 2) + (ti * 32 + 4 * hi) * 2;
#pragma unroll
                for (int g = 0; g < 4; ++g) { const u32x2 u = *(const LAS u32x2*)(rp + g * 16); acc[4 * g] = bflo(u.x); acc[4 * g + 1] = bfhi(u.x); acc[4 * g + 2] = bflo(u.y); acc[4 * g + 3] = bfhi(u.y); }
                cs_mma(acc, L + CS_GT, L + CS_N2, ti, tj, r32, hi);
#pragma unroll
                for (int g = 0; g < 4; ++g) { u32x2 o; o.x = pk2(acc[4 * g], acc[4 * g + 1]); o.y = pk2(acc[4 * g + 2], acc[4 * g + 3]);
                    *(u32x2*)(outp + 8192 + (((tj * 4 + 2 * ti + (g >> 1)) * 64 + (g & 1) * 32 + r32) * 16) + hi * 8) = o; } }
            else if (p == 1) {
#pragma unroll
                for (int i = 0; i < 16; ++i) acc[i] = 0.f;
                cs_mma(acc, L + CS_KB, L + CS_RT, ti, tj, r32, hi);
                const int t = tj * 32 + r32;
#pragma unroll
                for (int reg = 0; reg < 16; ++reg) { const int i = ti * 32 + crow(reg, hi); acc[reg] = (i <= t) ? acc[reg] : 0.f; }
                cs_mma(acc, L + CS_GT + 64 * (CSP * 2), L + CS_N2, ti, tj, r32, hi);
                cs_store_t(L + CS_Z, acc, ti, tj, r32, hi); }
            else if (p == 2) {
#pragma unroll
                for (int i = 0; i < 16; ++i) acc[i] = 0.f;
                cs_mma<true>(acc, L + CS_GT, L + CS_BHT, ti, tj, r32, hi);
                const int k = tj * 32 + r32; const float gl = ((const LAS float*)(L + CS_GL))[k];
#pragma unroll
                for (int reg = 0; reg < 16; ++reg) { const int cc = ti * 32 + crow(reg, hi); acc[reg] += (cc == k) ? gl : 0.f; }
#pragma unroll
                for (int g = 0; g < 4; ++g) { u32x2 o; o.x = pk2(acc[4 * g], acc[4 * g + 1]); o.y = pk2(acc[4 * g + 2], acc[4 * g + 3]);
                    *(u32x2*)(outp + (((tj * 4 + 2 * ti + (g >> 1)) * 64 + (g & 1) * 32 + r32) * 16) + hi * 8) = o; } }
            else {
                const int krow = tj * 32 + r32; const LAS unsigned char* kp = L + CS_KHT + krow * (CSP * 2) + hi * 8;
#pragma unroll
                for (int g = 0; g < 4; ++g) { const u32x2 u = *(const LAS u32x2*)(kp + (((ti * 4 + g) ^ ((krow >> 3) & 7)) * 16)); acc[4 * g] = bflo(u.x); acc[4 * g + 1] = bfhi(u.x); acc[4 * g + 2] = bflo(u.y); acc[4 * g + 3] = bfhi(u.y); }
                cs_mma<true>(acc, L + CS_GT + 64 * (CSP * 2), L + CS_BHT, ti, tj, r32, hi);
                cs_store_t(L + CS_U, acc, ti, tj, r32, hi); } }
        CS_BAR();
        { const int p = C.wave >> 2, ti = (C.wave >> 1) & 1, tj = C.wave & 1;
          f32x16 acc;
#pragma unroll
          for (int i = 0; i < 16; ++i) acc[i] = 0.f;
          cs_mma<true>(acc, L + (p ? CS_U : CS_Z), L + CS_VMT, ti, tj, r32, hi);
          unsigned char* op = outp + (p ? 16384 : 24576) + ((ti * 2 + tj) * 64 + C.lane) * 32;
          u32x4 o0, o1; o0.x = pk2(acc[0], acc[1]); o0.y = pk2(acc[2], acc[3]); o0.z = pk2(acc[4], acc[5]); o0.w = pk2(acc[6], acc[7]);
          o1.x = pk2(acc[8], acc[9]); o1.y = pk2(acc[10], acc[11]); o1.z = pk2(acc[12], acc[13]); o1.w = pk2(acc[14], acc[15]);
          *(u32x4*)op = o0; *(u32x4*)(op + 16) = o1; }
        CS_BAR();
    }
}
__device__ __forceinline__ void phase_csb(const Ctx& C, const Args& A, int l) {
    if ((int)blockIdx.x >= CS_UNITS) { conv_items(C, A, l + 1, ((int)blockIdx.x - CS_UNITS) * NWAVES + C.wave, (C.G - CS_UNITS) * NWAVES, true, false, true); return; }
    const unsigned char* CHK = A.ws + WS_CHK;
    LAS unsigned char* L = C.lds;
    const int r32 = C.lane & 31, hi = C.lane >> 5;
    const bool isS = C.wave < 4; const int ti = (C.wave >> 1) & 1, tj = C.wave & 1;
    for (int unit = blockIdx.x; unit < CS_UNITS; unit += C.G) {
        const int d = unit & 1, h = (unit >> 1) % 12, b = unit / 24;
        float* Y = (float*)(A.ws + WS_Y) + (size_t)d * MROWS * 768;
        for (int i = C.tid; i < 2 * CS_MAT / 4; i += NTHR) ((LAS unsigned*)L)[i] = 0u;
        CS_BAR();
        bf16x8 afA[4], afB[4], afC[4]; u32x4 cA0, cA1, cB0, cB1, cC0, cC1;
#define CSB_LOAD(A4, C0, C1, ch_) do { const unsigned char* op_ = CHK + ((size_t)unit * CS_NCH + (ch_)) * 32768; \
            const unsigned char* am_ = op_ + (isS ? 0 : 8192) + (ti * 4 * 64 + C.lane) * 16;     \
            _Pragma("unroll") for (int ks = 0; ks < 4; ++ks) A4[ks] = *(const bf16x8*)(am_ + ks * 1024); \
            const unsigned char* cp_ = op_ + (isS ? 16384 : 24576) + ((ti * 2 + tj) * 64 + C.lane) * 32; C0 = *(const u32x4*)cp_; C1 = *(const u32x4*)(cp_ + 16); } while (0)
#define CSB_STEP(A4, C0, C1, ch_) do { \
            const LAS unsigned char* Sb = L + ((ch_) & 1) * CS_MAT; LAS unsigned char* Sn = L + (((ch_) + 1) & 1) * CS_MAT; \
            f32x16 acc; \
            acc[0] = bflo(C0.x); acc[1] = bfhi(C0.x); acc[2] = bflo(C0.y); acc[3] = bfhi(C0.y); acc[4] = bflo(C0.z); acc[5] = bfhi(C0.z); acc[6] = bflo(C0.w); acc[7] = bfhi(C0.w); \
            acc[8] = bflo(C1.x); acc[9] = bfhi(C1.x); acc[10] = bflo(C1.y); acc[11] = bfhi(C1.y); acc[12] = bflo(C1.z); acc[13] = bfhi(C1.z); acc[14] = bflo(C1.w); acc[15] = bfhi(C1.w); \
            const LAS unsigned char* bp = Sb + (tj * 32 + r32) * (CSP * 2) + hi * 16; \
            _Pragma("unroll") for (int ks = 0; ks < 4; ++ks) acc = __builtin_amdgcn_mfma_f32_32x32x16_bf16(A4[ks], *(const LAS bf16x8*)(bp + ks * 32), acc, 0, 0, 0); \
            if (isS) { cs_store_t(Sn, acc, ti, tj, r32, hi); }     \
            else {     \
                const int step0 = (ch_) * CS_L; const int sgn = d ? -1 : 1; \
                const int row0 = (step0 < CTXL) ? (NLAT + b * CTXL + (d ? CTXL - 1 - step0 : step0)) : (b * TT + (d ? TT - 1 - (step0 - CTXL) : step0 - CTXL)); \
                float* yp = Y + (size_t)(row0 + sgn * (ti * 32 + 4 * hi)) * 768 + h * 64 + tj * 32 + r32; const long ys = (long)sgn * 768; \
                _Pragma("unroll") for (int reg = 0; reg < 16; ++reg) yp[ys * ((reg & 3) + 8 * (reg >> 2))] = acc[reg]; } \
            CS_BAR(); } while (0)
        CSB_LOAD(afA, cA0, cA1, 0); CSB_LOAD(afB, cB0, cB1, 1);
        static_assert(CS_NCH % 3 == 0, "chunk loop is unrolled by three");
        for (int ch = 0; ch < CS_NCH; ch += 3) {
            if (ch == 0) CSB_LOAD(afC, cC0, cC1, 2);
            CSB_STEP(afA, cA0, cA1, ch);     if (ch + 3 < CS_NCH) CSB_LOAD(afA, cA0, cA1, ch + 3);
            CSB_STEP(afB, cB0, cB1, ch + 1); if (ch + 4 < CS_NCH) CSB_LOAD(afB, cB0, cB1, ch + 4);
            CSB_STEP(afC, cC0, cC1, ch + 2); if (ch + 5 < CS_NCH) CSB_LOAD(afC, cC0, cC1, ch + 5);
        }
        CS_BAR();
    }
#undef CSB_LOAD
#undef CSB_STEP
}

#undef CS_BAR
__device__ __forceinline__ void phase_ef2(const Ctx& C, const Args& A, int l) {
    const int i2 = l >> 1; unsigned char* ws = A.ws;
    const unsigned char* SCN = ws + WS_SCN; const float* Y0 = (const float*)(ws + WS_Y); const float* Y1 = Y0 + (size_t)MROWS * 768;
    const bf16_t* G = (const bf16_t*)(ws + WS_G); bf16_t* A2 = (bf16_t*)(ws + WS_A2);
    const float* rb = A.in[I_RBON] + (size_t)i2 * 768; const float* gg = A.in[I_GNG] + (size_t)i2 * 768; const float* gb = A.in[I_GNB] + (size_t)i2 * 768;
    for (int row = C.gw; row < MROWS; row += C.NGW) {
#pragma unroll
        for (int it = 0; it < 3; ++it) {
            const int c = it * 256 + 4 * C.lane, head = c >> 6, kx = c & 63;
            const f32x4 y = *(const f32x4*)(Y0 + (size_t)row * 768 + c) + *(const f32x4*)(Y1 + (size_t)row * 768 + c);
            const float mean = sum16((y[0] + y[1]) + (y[2] + y[3])) * (1.f / 64.f);
            const f32x4 dd = y - mean;
            const float var = sum16((dd[0] * dd[0] + dd[1] * dd[1]) + (dd[2] * dd[2] + dd[3] * dd[3])) * (1.f / 64.f);
            const float rstd = rsqrtf(var + GN_EPS);
            const unsigned char* base = SCN + (size_t)(row * 12 + head) * SC_REC + kx * 2;
            const f32x4 r = ld4bf_(base + SC_R), v = ld4bf_(base + SC_V), k0 = ld4bf_(base + SC_KR), k1 = ld4bf_(base + SC_KR + 256);
            const f32x4 rb4 = *(const f32x4*)(rb + c);
            const f32x4 t = r * (k0 + k1) * 0.5f * rb4;
            const float bs = sum16((t[0] + t[1]) + (t[2] + t[3]));
            const f32x4 yn = dd * rstd * *(const f32x4*)(gg + c) + *(const f32x4*)(gb + c);
            const f32x4 g = ld4bf(G + (size_t)row * 768 + c);
            st4bf(A2 + (size_t)row * DM + 256 + c, g * (yn + v * bs));
        }
    }
}

__device__ __forceinline__ void phase_of1(const Ctx& C, const Args& A, int l) {
    const int i2 = l >> 1; unsigned char* ws = A.ws;
    const bf16_t* P = (const bf16_t*)(ws + WS_P); bf16_t* A2 = (bf16_t*)(ws + WS_A2); bf16_t* VT = (bf16_t*)(ws + WS_VT);
    const float* lng = A.in[I_GLNG] + (size_t)i2 * 256; const float* lnb = A.in[I_GLNB] + (size_t)i2 * 256;
    const float* gws = A.in[I_GWS] + (size_t)i2 * 4 * 128 * 128; const float* gbs = A.in[I_GBS] + (size_t)i2 * 4 * 128;
    LAS bf16_t* vt = (LAS bf16_t*)C.lds;
    LAS bf16_t* uL = (LAS bf16_t*)C.lds;
    LAS bf16_t* vT = (LAS bf16_t*)(C.lds + 128 * 528);
    const int r32 = C.lane & 31, hi = C.lane >> 5;
    for (int u = blockIdx.x; u < 264; u += C.G) {
        const bool isctx = u >= 256; const int uc = u - 256;
        const int b = isctx ? (uc >> 1) : (u >> 6), pos0 = isctx ? (uc & 1) * 128 : (u & 63) * 128;
        const int row0 = isctx ? NLAT + b * CTXL + pos0 : b * TT + pos0, L0 = isctx ? pos0 : CTXL + pos0;
        for (int hh = 0; hh < 6; ++hh) {
#pragma unroll
            for (int i = 0; i < 4; ++i) { const int piece = C.tid + NTHR * i, r = piece >> 4, part = piece & 15;
                *(LAS u32x4*)(vt + r * 136 + part * 8) = *(const u32x4*)(P + (size_t)(row0 + r) * P_LD + 1536 + hh * 128 + part * 8); }
            __syncthreads();
#pragma unroll
            for (int i = 0; i < 4; ++i) { const int item = C.tid + NTHR * i, d = item >> 4, tg = item & 15; const LAS bf16_t* s = vt + (tg * 8) * 136 + d;
                u32x4 o; o.x = (unsigned)s[0] | ((unsigned)s[136] << 16); o.y = (unsigned)s[2 * 136] | ((unsigned)s[3 * 136] << 16);
                o.z = (unsigned)s[4 * 136] | ((unsigned)s[5 * 136] << 16); o.w = (unsigned)s[6 * 136] | ((unsigned)s[7 * 136] << 16);
                *(u32x4*)(VT + ((size_t)(b * 6 + hh) * 128 + d) * LKEYS + L0 + tg * 8) = o; }
            __syncthreads();
        }
        for (int r = C.wave; r < 128; r += NWAVES) {
            const int c4 = 4 * C.lane; const bf16_t* pr = P + (size_t)(row0 + r) * P_LD + 2304;
            const f32x4 ur = ld4bf(pr + c4), raw = ld4bf(pr + 256 + c4);
            { const f32x4 gu = {gelu_erf(ur[0]), gelu_erf(ur[1]), gelu_erf(ur[2]), gelu_erf(ur[3])}; u32x2 o; o.x = pk2(gu[0], gu[1]); o.y = pk2(gu[2], gu[3]); *(LAS u32x2*)(uL + r * 264 + c4) = o; }
            const f32x4 gv = {gelu_erf(raw[0]), gelu_erf(raw[1]), gelu_erf(raw[2]), gelu_erf(raw[3])};
            const float mean = wave_sum((gv[0] + gv[1]) + (gv[2] + gv[3])) * (1.f / 256.f); const f32x4 dd = gv - mean;
            const float var = wave_sum((dd[0] * dd[0] + dd[1] * dd[1]) + (dd[2] * dd[2] + dd[3] * dd[3])) * (1.f / 256.f); const float rstd = rsqrtf(var + LN_EPS);
            const f32x4 o = dd * rstd * *(const f32x4*)(lng + c4) + *(const f32x4*)(lnb + c4);
#pragma unroll
            for (int k = 0; k < 4; ++k) vT[(c4 + k) * 136 + r] = (bf16_t)f2bf(o[k]);
        }
        __syncthreads();
        {
            const int g = C.wave >> 1, cblk = C.wave & 1, cc = g * 64 + cblk * 32 + r32;
            for (int pblk = 0; pblk < 4; ++pblk) {
                f32x16 acc;
#pragma unroll
                for (int i = 0; i < 16; ++i) acc[i] = 0.f;
                const float* wrow = gws + ((size_t)g * 128 + pblk * 32 + r32) * 128 + 8 * hi;
#pragma unroll
                for (int ks = 0; ks < 8; ++ks) { const f32x4 w0 = *(const f32x4*)(wrow + ks * 16), w1 = *(const f32x4*)(wrow + ks * 16 + 4);
                    u32x4 au; au.x = pk2(w0[0], w0[1]); au.y = pk2(w0[2], w0[3]); au.z = pk2(w1[0], w1[1]); au.w = pk2(w1[2], w1[3]);
                    const bf16x8 bf = *(const LAS bf16x8*)(vT + cc * 136 + ks * 16 + 8 * hi);
                    acc = __builtin_amdgcn_mfma_f32_32x32x16_bf16(__builtin_bit_cast(bf16x8, au), bf, acc, 0, 0, 0); }
#pragma unroll
                for (int reg = 0; reg < 16; ++reg) { const int p = pblk * 32 + crow(reg, hi);
                    const float uu = bf2f(uL[p * 264 + cc]); const float mixed = acc[reg] + gbs[g * 128 + p];
                    uL[p * 264 + cc] = (bf16_t)f2bf(uu * mixed); }
            }
        }
        __syncthreads();
#pragma unroll
        for (int i = 0; i < 8; ++i) { const int piece = C.tid + NTHR * i, r = piece >> 5, part = piece & 31;
            *(u32x4*)(A2 + (size_t)(row0 + r) * DM + 768 + part * 8) = *(const LAS u32x4*)(uL + r * 264 + part * 8); }
        __syncthreads();
    }
}

__device__ __forceinline__ void phase_attn(const Ctx& C, const Args& A, int l) {
    const int i2 = l >> 1; unsigned char* ws = A.ws;
    const bf16_t* Q = (const bf16_t*)(ws + WS_Q); const bf16_t* KA = (const bf16_t*)(ws + WS_KA); const bf16_t* VT = (const bf16_t*)(ws + WS_VT); bf16_t* A2 = (bf16_t*)(ws + WS_A2);
    const float lam_init = 0.8f - 0.6f * expf(-0.3f * (float)l);
    float s1 = 0.f, s2 = 0.f;
    for (int j = 0; j < 64; ++j) { s1 += A.in[I_LQ1][i2 * 64 + j] * A.in[I_LK1][i2 * 64 + j]; s2 += A.in[I_LQ2][i2 * 64 + j] * A.in[I_LK2][i2 * 64 + j]; }
    const float lam = expf(s1) - expf(s2) + lam_init;
    const float* subg = A.in[I_SUBG] + (size_t)i2 * 128;
    const int r32 = C.lane & 31, hi = C.lane >> 5, map = C.wave >> 2, qw = C.wave & 3;
    LAS unsigned char* Kt = C.lds; LAS unsigned char* Vt = C.lds + 2 * 17408; LAS float* xch = (LAS float*)C.lds;
    const int NU = 1536 + (l == 1 ? 48 : 0);
    for (int n = C.vcu; n < NU; n += C.G) {
        int bh, qt; bool isctx = false;
        if (n < 1536) { const int round = n >> 8, slot = n & 255; bh = (slot >> 5) * 3 + (round >> 1); qt = (round & 1) * 32 + (slot & 31); }
        else { isctx = true; bh = (n - 1536) >> 1; qt = (n - 1536) & 1; }
        const int b = bh / 6, h = bh % 6;
        const int qrow0 = isctx ? NLAT + b * CTXL + qt * 128 : b * TT + qt * 128;
        const int NT = isctx ? CTXL / 64 : LKEYS / 64;
        const bf16_t* Kb = KA + (size_t)b * LKEYS * 768 + h * 128;
        const bf16_t* Vb = VT + (size_t)(b * 6 + h) * 128 * LKEYS;
        bf16x8 qf[4];
        { const bf16_t* qp = Q + (size_t)(qrow0 + qw * 32 + r32) * 768 + h * 128 + map * 64 + 8 * hi;
#pragma unroll
          for (int ks = 0; ks < 4; ++ks) qf[ks] = *(const bf16x8*)(qp + ks * 16); }
        f32x16 O[4];
#pragma unroll
        for (int d = 0; d < 4; ++d)
#pragma unroll
            for (int i = 0; i < 16; ++i) O[d][i] = 0.f;
        float m = 0.f, lsum = 0.f;
        u32x4 kreg[2], vreg[2];
#define AT_LOAD(t) do { _Pragma("unroll") for (int i = 0; i < 2; ++i) { const int piece = C.tid + NTHR * i; \
            kreg[i] = *(const u32x4*)(Kb + (size_t)((t) * 64 + (piece >> 4)) * 768 + (piece & 15) * 8); \
            vreg[i] = *(const u32x4*)(Vb + (size_t)(piece >> 3) * LKEYS + (t) * 64 + (piece & 7) * 8); } } while (0)
#define AT_STORE(bi) do { _Pragma("unroll") for (int i = 0; i < 2; ++i) { const int piece = C.tid + NTHR * i; \
            *(LAS u32x4*)(Kt + (bi) * 17408 + (piece >> 4) * 272 + (piece & 15) * 16) = kreg[i]; \
            LAS unsigned char* vd = Vt + (bi) * 18432 + (piece >> 3) * 144 + ((piece & 7) >> 1) * 32 + (piece & 1) * 8; \
            *(LAS u32x2*)vd = (u32x2){vreg[i].x, vreg[i].y}; *(LAS u32x2*)(vd + 16) = (u32x2){vreg[i].z, vreg[i].w}; } } while (0)
        AT_LOAD(0); AT_STORE(0); __syncthreads();
        for (int t = 0; t < NT; ++t) {
            if (t + 1 < NT) AT_LOAD(t + 1);
            const int bi = t & 1;
            const LAS unsigned char* kb = Kt + bi * 17408 + r32 * 272 + map * 128 + hi * 16;
            const LAS unsigned char* vb = Vt + bi * 18432 + r32 * 144 + hi * 16;
            bf16x8 kf[8];
#pragma unroll
            for (int ks = 0; ks < 4; ++ks) { kf[2 * ks] = *(const LAS bf16x8*)(kb + ks * 32); kf[2 * ks + 1] = *(const LAS bf16x8*)(kb + 32 * 272 + ks * 32); }
            u32x4 va[4], vc[4];
#define AT_LDV(dst, d) do { _Pragma("unroll") for (int kst = 0; kst < 4; ++kst) dst[kst] = *(const LAS u32x4*)(vb + (d) * (32 * 144) + kst * 32); } while (0)
#define AT_PV(src, d) do { _Pragma("unroll") for (int kst = 0; kst < 4; ++kst) O[d] = __builtin_amdgcn_mfma_f32_32x32x16_bf16(__builtin_bit_cast(bf16x8, src[kst]), pb[kst], O[d], 0, 0, 0); } while (0)
            AT_LDV(va, 0);
            __builtin_amdgcn_sched_barrier(0);
            f32x16 p0, p1;
            { const float nm = -m;
#pragma unroll
              for (int i = 0; i < 16; ++i) { p0[i] = nm; p1[i] = nm; } }
#pragma unroll
            for (int ks = 0; ks < 4; ++ks) { p0 = __builtin_amdgcn_mfma_f32_32x32x16_bf16(kf[2 * ks], qf[ks], p0, 0, 0, 0); p1 = __builtin_amdgcn_mfma_f32_32x32x16_bf16(kf[2 * ks + 1], qf[ks], p1, 0, 0, 0); }
            asm volatile("s_nop 15\n\ts_nop 7" : "+v"(p0), "+v"(p1));
            float mx = max3f(p0[0], p0[1], p1[0]), mx2 = max3f(p0[2], p0[3], p1[1]); mx = max3f(mx, p1[2], p1[3]);
#pragma unroll
            for (int i = 4; i < 16; i += 4) { mx = max3f(mx, p0[i], p0[i + 1]); mx2 = max3f(mx2, p0[i + 2], p0[i + 3]); mx = max3f(mx, p1[i], p1[i + 1]); mx2 = max3f(mx2, p1[i + 2], p1[i + 3]); }
            mx = fmaxf(mx, mx2);
            { auto rr = __builtin_amdgcn_permlane32_swap(__float_as_uint(mx), __float_as_uint(mx), false, false); mx = fmaxf(__uint_as_float(rr[0]), __uint_as_float(rr[1])); }
            if (t == 0 || __any(mx > 8.f)) { const float dl = (t == 0) ? mx : fmaxf(mx, 0.f); const float sc = __builtin_amdgcn_exp2f(-dl); lsum *= sc;
#pragma unroll
                for (int d = 0; d < 4; ++d)
#pragma unroll
                    for (int i = 0; i < 16; ++i) O[d][i] *= sc;
#pragma unroll
                for (int i = 0; i < 16; ++i) { p0[i] -= dl; p1[i] -= dl; }
                m += dl; }
            float ps = 0.f, ps2 = 0.f;
#pragma unroll
            for (int i = 0; i < 16; ++i) { p0[i] = __builtin_amdgcn_exp2f(p0[i]); p1[i] = __builtin_amdgcn_exp2f(p1[i]); ps += p0[i]; ps2 += p1[i]; }
            lsum += ps + ps2;
            bf16x8 pb[4];
            { u32x4 w; w.x = pk2(p0[0], p0[1]); w.y = pk2(p0[2], p0[3]); w.z = pk2(p0[4], p0[5]); w.w = pk2(p0[6], p0[7]); pb[0] = __builtin_bit_cast(bf16x8, w);
              w.x = pk2(p0[8], p0[9]); w.y = pk2(p0[10], p0[11]); w.z = pk2(p0[12], p0[13]); w.w = pk2(p0[14], p0[15]); pb[1] = __builtin_bit_cast(bf16x8, w);
              w.x = pk2(p1[0], p1[1]); w.y = pk2(p1[2], p1[3]); w.z = pk2(p1[4], p1[5]); w.w = pk2(p1[6], p1[7]); pb[2] = __builtin_bit_cast(bf16x8, w);
              w.x = pk2(p1[8], p1[9]); w.y = pk2(p1[10], p1[11]); w.z = pk2(p1[12], p1[13]); w.w = pk2(p1[14], p1[15]); pb[3] = __builtin_bit_cast(bf16x8, w); }
            __builtin_amdgcn_sched_barrier(0);
            AT_LDV(vc, 1); __builtin_amdgcn_sched_barrier(0); AT_PV(va, 0); __builtin_amdgcn_sched_barrier(0);
            AT_LDV(va, 2); __builtin_amdgcn_sched_barrier(0); AT_PV(vc, 1); __builtin_amdgcn_sched_barrier(0);
            AT_LDV(vc, 3); __builtin_amdgcn_sched_barrier(0); AT_PV(va, 2); __builtin_amdgcn_sched_barrier(0);
            AT_PV(vc, 3);
            if (t + 1 < NT) AT_STORE((t + 1) & 1);
            __syncthreads();
        }
#undef AT_LDV
#undef AT_PV
#undef AT_LOAD
#undef AT_STORE
        const float ltot = lsum + __shfl_xor(lsum, 32);
        const float invl = 1.f / ltot;
        if (map == 1) { const float f = lam * invl;
#pragma unroll
            for (int d = 0; d < 4; ++d)
#pragma unroll
                for (int i = 0; i < 16; ++i) xch[(qw * 64 + d * 16 + i) * 64 + C.lane] = O[d][i] * f; }
        __syncthreads();
        if (map == 0) { float ss = 0.f;
#pragma unroll
            for (int d = 0; d < 4; ++d)
#pragma unroll
                for (int i = 0; i < 16; ++i) { const float o = O[d][i] * invl - xch[(qw * 64 + d * 16 + i) * 64 + C.lane]; O[d][i] = o; ss += o * o; }
            ss += __shfl_xor(ss, 32);
            const float rn = rsqrtf(ss * (1.f / 128.f) + RMS_EPS) * (1.f - lam_init);
            bf16_t* orow = A2 + (size_t)(qrow0 + qw * 32 + r32) * DM + h * 128;
#pragma unroll
            for (int d = 0; d < 4; ++d)
#pragma unroll
                for (int g4 = 0; g4 < 4; ++g4) { const int dd = 32 * d + 8 * g4 + 4 * hi; const f32x4 sg = *(const f32x4*)(subg + dd);
                    const f32x4 v = {O[d][4 * g4] * rn * sg[0], O[d][4 * g4 + 1] * rn * sg[1], O[d][4 * g4 + 2] * rn * sg[2], O[d][4 * g4 + 3] * rn * sg[3]};
                    st4bf(orow + dd, v); } }
        __syncthreads();
    }
}

__device__ __forceinline__ void phase_rt(const Ctx& C, const Args& A, int l) {
    unsigned char* ws = A.ws; float* X = (float*)(ws + WS_X); bf16_t* H = (bf16_t*)(ws + WS_H); float* AFF = (float*)(ws + WS_AFF);
    const float* MOD = (const float*)(ws + WS_MOD) + (size_t)l * 5 * 6144;
    const float* lng = A.in[I_LNG] + (size_t)(l * 2 + 0) * DM; const float* lnb = A.in[I_LNB] + (size_t)(l * 2 + 0) * DM;
    LAS float* wrs = (LAS float*)C.lds;
    { const float* wr = A.in[I_WR] + (size_t)l * DM * 16; for (int i = C.tid; i < DM * 16; i += NTHR) wrs[(i & 15) * 1024 + (i >> 4)] = wr[i]; }
    __syncthreads();
    for (int row = C.gw; row < MROWS; row += C.NGW) {
        const float* md = MOD + row_mi(row) * 6144;
        f32x4 x[4]; float s = 0.f;
#pragma unroll
        for (int j = 0; j < 4; ++j) { x[j] = *(const f32x4*)(X + (size_t)row * DM + 4 * C.lane + 256 * j); s += (x[j][0] + x[j][1]) + (x[j][2] + x[j][3]); }
        const float mean = wave_sum(s) * (1.f / DM); float s2 = 0.f;
#pragma unroll
        for (int j = 0; j < 4; ++j) { x[j] = x[j] - mean; s2 += (x[j][0] * x[j][0] + x[j][1] * x[j][1]) + (x[j][2] * x[j][2] + x[j][3] * x[j][3]); }
        const float rstd = rsqrtf(wave_sum(s2) * (1.f / DM) + LN_EPS);
        float v[16];
#pragma unroll
        for (int e = 0; e < 16; ++e) v[e] = 0.f;
#pragma unroll
        for (int j = 0; j < 4; ++j) { const int col = 4 * C.lane + 256 * j;
            const f32x4 x1 = x[j] * rstd * *(const f32x4*)(lng + col) + *(const f32x4*)(lnb + col);
            *(f32x4*)(X + (size_t)row * DM + col) = x1;
            const f32x4 h = x1 * (*(const f32x4*)(md + 4 * DM + col) + 1.f) + *(const f32x4*)(md + 3 * DM + col);
            st4bf(H + (size_t)row * DM + col, h);
#pragma unroll
            for (int e = 0; e < 16; ++e) { const f32x4 w = *(const LAS f32x4*)(wrs + e * 1024 + col); v[e] += (h[0] * w[0] + h[1] * w[1]) + (h[2] * w[2] + h[3] * w[3]); }
            __builtin_amdgcn_sched_barrier(0); }
#pragma unroll
        for (int i = 0; i < 8; ++i) { const float send = (C.lane & 32) ? v[i] : v[i + 8], keep = (C.lane & 32) ? v[i + 8] : v[i]; v[i] = keep + __shfl_xor(send, 32); }
#pragma unroll
        for (int i = 0; i < 4; ++i) { const float send = (C.lane & 16) ? v[i] : v[i + 4], keep = (C.lane & 16) ? v[i + 4] : v[i]; v[i] = keep + __shfl_xor(send, 16); }
#pragma unroll
        for (int i = 0; i < 2; ++i) { const float send = (C.lane & 8) ? v[i] : v[i + 2], keep = (C.lane & 8) ? v[i + 2] : v[i]; v[i] = keep + __shfl_xor(send, 8); }
        { const float send = (C.lane & 4) ? v[0] : v[1], keep = (C.lane & 4) ? v[1] : v[0]; v[0] = keep + __shfl_xor(send, 4); }
        float z = v[0]; z += __shfl_xor(z, 1); z += __shfl_xor(z, 2);
        float mx = z;
#pragma unroll
        for (int o = 4; o < 64; o <<= 1) mx = fmaxf(mx, __shfl_xor(mx, o));
        const float ex = expf(z - mx); float sm = ex;
#pragma unroll
        for (int o = 4; o < 64; o <<= 1) sm += __shfl_xor(sm, o);
        if ((C.lane & 3) == 0) AFF[(size_t)row * 16 + (C.lane >> 2)] = ex / sm;
    }
}

__device__ __forceinline__ void phase_tk(const Ctx& C, const Args& A) {
    unsigned char* ws = A.ws; const float* AFF = (const float*)(ws + WS_AFF); int* SLOT = (int*)(ws + WS_SLOT); int* IDX = (int*)(ws + WS_IDX); float* GATE = (float*)(ws + WS_GATE);
    LAS unsigned* key = (LAS unsigned*)C.lds;
    LAS unsigned* hist = key + 8192;
    LAS unsigned* scn = hist + 256;
    LAS unsigned* wtot = scn + 256;
    LAS unsigned* bc = wtot + 8;
    for (int u = blockIdx.x; u < 128; u += C.G) {
        const bool isctx = u >= 64; const int uu = u & 63, b = uu >> 4, e = uu & 15;
        const int n = isctx ? CTXL : TT, cap = isctx ? CAP_C : CAP_L;
        const int row0 = isctx ? NLAT + b * CTXL : b * TT;
        const int slot0 = e * ESLOTS + (isctx ? 4 * CAP_L + b * CAP_C : b * CAP_L);
        for (int i = C.tid; i < n; i += NTHR) key[i] = __float_as_uint(AFF[(size_t)(row0 + i) * 16 + e]);
        unsigned prefix = 0u, pmask = 0u; int need = cap;
        for (int pass = 0; pass < 4; ++pass) {
            const int shift = 24 - 8 * pass;
            if (C.tid < 256) hist[C.tid] = 0u;
            __syncthreads();
            for (int i = C.tid; i < n; i += NTHR) { const unsigned k = key[i]; if ((k & pmask) == prefix) __hip_atomic_fetch_add(&hist[(k >> shift) & 255u], 1u, __ATOMIC_RELAXED, __HIP_MEMORY_SCOPE_WORKGROUP); }
            __syncthreads();
            if (C.tid < 256) scn[C.tid] = hist[C.tid];
            __syncthreads();
            for (int off = 1; off < 256; off <<= 1) {
                unsigned a = 0u; if (C.tid < 256 && C.tid + off < 256) a = scn[C.tid + off];
                __syncthreads();
                if (C.tid < 256) scn[C.tid] += a;
                __syncthreads();
            }
            if (C.tid < 256) { const unsigned above = (C.tid < 255) ? scn[C.tid + 1] : 0u;
                if (scn[C.tid] >= (unsigned)need && above < (unsigned)need) { bc[0] = (unsigned)C.tid; bc[1] = (unsigned)need - above; } }
            __syncthreads();
            prefix |= bc[0] << shift; pmask |= 255u << shift; need = (int)bc[1];
            __syncthreads();
        }
        const int per = (n + NTHR - 1) / NTHR; const int i0 = C.tid * per;
        unsigned cg = 0u, ce = 0u;
        for (int j = 0; j < per; ++j) { const int i = i0 + j; if (i < n) { const unsigned k = key[i]; cg += (k > prefix); ce += (k == prefix); } }
        unsigned pk = cg | (ce << 16), inc = pk;
#pragma unroll
        for (int o = 1; o < 64; o <<= 1) { const unsigned t = __shfl_up(inc, o); if (C.lane >= o) inc += t; }
        if (C.lane == 63) wtot[C.wave] = inc;
        __syncthreads();
        unsigned wbase = 0u;
        for (int w = 0; w < C.wave; ++w) wbase += wtot[w];
        const unsigned excl = wbase + inc - pk;
        unsigned rg = excl & 0xffffu, re = excl >> 16;
        const int ngt = cap - need;
        for (int j = 0; j < per; ++j) { const int i = i0 + j; if (i < n) { const unsigned k = key[i]; int pos = -1;
            if (k > prefix) { pos = (int)rg; ++rg; } else if (k == prefix) { if ((int)re < need) pos = ngt + (int)re; ++re; }
            const int row = row0 + i;
            if (pos >= 0) { IDX[slot0 + pos] = row; GATE[slot0 + pos] = __uint_as_float(k); SLOT[(size_t)row * 16 + e] = slot0 + pos; }
            else SLOT[(size_t)row * 16 + e] = -1; } }
        if (isctx && b == 0 && C.tid < ESLOTS - 4224) { IDX[e * ESLOTS + 4224 + C.tid] = 0; GATE[e * ESLOTS + 4224 + C.tid] = 0.f; }
        __syncthreads();
    }
}

__device__ __forceinline__ void phase_cb(const Ctx& C, const Args& A, int l) {
    unsigned char* ws = A.ws; float* X = (float*)(ws + WS_X); bf16_t* H = (bf16_t*)(ws + WS_H); const int* SLOT = (const int*)(ws + WS_SLOT); const bf16_t* YE = (const bf16_t*)(ws + WS_YE);
    const float* MOD = (const float*)(ws + WS_MOD) + (size_t)l * 5 * 6144; const float* MODN = MOD + 5 * 6144;
    const float* lng = A.in[I_LNG] + (size_t)(l * 2 + 1) * DM; const float* lnb = A.in[I_LNB] + (size_t)(l * 2 + 1) * DM;
    for (int row = C.gw; row < MROWS; row += C.NGW) {
        const int mi = row_mi(row); const float* md = MOD + mi * 6144;
        f32x4 acc[4];
#pragma unroll
        for (int j = 0; j < 4; ++j) acc[j] = (f32x4){0.f, 0.f, 0.f, 0.f};
        for (int e = 0; e < 16; ++e) { const int s = __builtin_amdgcn_readfirstlane(SLOT[(size_t)row * 16 + e]);
            if (s >= 0) {
#pragma unroll
                for (int j = 0; j < 4; ++j) acc[j] += ld4bf(YE + (size_t)s * DM + 4 * C.lane + 256 * j); } }
        f32x4 x[4]; float sm = 0.f;
#pragma unroll
        for (int j = 0; j < 4; ++j) { const int col = 4 * C.lane + 256 * j; x[j] = *(const f32x4*)(X + (size_t)row * DM + col) * ALPHA_DN + *(const f32x4*)(md + 5 * DM + col) * acc[j];
            sm += (x[j][0] + x[j][1]) + (x[j][2] + x[j][3]); }
        const float mean = wave_sum(sm) * (1.f / DM); float s2 = 0.f;
#pragma unroll
        for (int j = 0; j < 4; ++j) { x[j] = x[j] - mean; s2 += (x[j][0] * x[j][0] + x[j][1] * x[j][1]) + (x[j][2] * x[j][2] + x[j][3] * x[j][3]); }
        const float rstd = rsqrtf(wave_sum(s2) * (1.f / DM) + LN_EPS);
#pragma unroll
        for (int j = 0; j < 4; ++j) { const int col = 4 * C.lane + 256 * j;
            const f32x4 x2 = x[j] * rstd * *(const f32x4*)(lng + col) + *(const f32x4*)(lnb + col);
            *(f32x4*)(X + (size_t)row * DM + col) = x2;
            if (l < DEPTH - 1) { const float* mn = MODN + mi * 6144; st4bf(H + (size_t)row * DM + col, x2 * (*(const f32x4*)(mn + DM + col) + 1.f) + *(const f32x4*)(mn + col)); }
            else if (row < NLAT) *(f32x4*)(A.out + (size_t)row * DM + col) = x2; }
    }
}


#ifndef GEMM_NOINLINE
#define GEMM_NOINLINE 0
#endif
#if GEMM_NOINLINE
#define GEMM_FN __device__ __noinline__
#else
#define GEMM_FN __device__ __forceinline__
#endif
GEMM_FN void gphase_in(LAS unsigned char* lds, unsigned char* ws, int nN, int G) {
    pg8::Gemm g{(const bf16_t*)(ws + WS_H), (const bf16_t*)(ws + WS_WIN), DM}; pg8::Order<0> S; S.init(MROWS / 256, nN, G, (int)blockIdx.x, nullptr, 0);
    pg8::EpiBf16 E{(bf16_t*)(ws + WS_P), P_LD}; pg8::gemm_phase(lds, g, S, E); }
GEMM_FN void gphase_in_odd(LAS unsigned char* lds, unsigned char* ws, int G) {
    pg8::Gemm g{(const bf16_t*)(ws + WS_H), (const bf16_t*)(ws + WS_WIN), DM}; pg8::Order<0> S; S.init(MROWS / 256, D_IN_ODD / 256, G, (int)blockIdx.x, nullptr, 0);
    pg8::EpiOdd E{(bf16_t*)(ws + WS_P), (bf16_t*)(ws + WS_Q), (bf16_t*)(ws + WS_KA), (const float*)(ws + WS_ROPE)}; pg8::gemm_phase(lds, g, S, E); }
GEMM_FN void gphase_lora(LAS unsigned char* lds, unsigned char* ws, const float* d0, const float* a0, const float* kal, int G) {
    pg8::Gemm g{(const bf16_t*)(ws + WS_LIN), (const bf16_t*)(ws + WS_WLORA), LORA_K}; pg8::Order<0> S; S.init(MROWS / 256, LORA_N / 256, G, (int)blockIdx.x, nullptr, 0);
    pg8::EpiLora E{ws + WS_SCN, (bf16_t*)(ws + WS_G), d0, a0, kal}; pg8::gemm_phase(lds, g, S, E); }
GEMM_FN void gphase_out(LAS unsigned char* lds, unsigned char* ws, const float* modl, int G) {
    pg8::Gemm g{(const bf16_t*)(ws + WS_A2), (const bf16_t*)(ws + WS_WOUT), DM}; pg8::Order<0> S; S.init(MROWS / 256, DM / 256, G, (int)blockIdx.x, nullptr, 0);
    pg8::EpiRes E{(float*)(ws + WS_X), modl}; pg8::gemm_phase(lds, g, S, E); }
GEMM_FN void gphase_e1(LAS unsigned char* lds, unsigned char* ws, int G, int l) {
    pg8::Gemm g{(const bf16_t*)(ws + WS_H), (const bf16_t*)(ws + WS_WE13 + (size_t)(l & 1) * WE13_BYTES), DM}; pg8::EpiSwiGLU E{(bf16_t*)(ws + WS_HID)};
    pg8::OrderExp<1> S; S.init(4096 / 256, G, (int)blockIdx.x, (const int*)(ws + WS_IDX), (long)4096 * DM); pg8::gemm_phase(lds, g, S, E); }
GEMM_FN void gphase_e2(LAS unsigned char* lds, unsigned char* ws, int G, int l) {
    pg8::Gemm g{(const bf16_t*)(ws + WS_HID), (const bf16_t*)(ws + WS_WE2 + (size_t)(l & 1) * WE2_BYTES), D_EXP}; pg8::EpiYE E{(bf16_t*)(ws + WS_YE), (const float*)(ws + WS_GATE)};
    pg8::OrderExp<2> S; S.init(DM / 256, G, (int)blockIdx.x, nullptr, (long)DM * D_EXP); pg8::gemm_phase(lds, g, S, E); }

constexpr int NSLOT = 13;
constexpr int NSTEP = 1 + DEPTH * NSLOT;
__global__ void __launch_bounds__(NTHR, 2) mk_fwd(Args KA) {
    extern __shared__ __attribute__((aligned(16))) unsigned char lds_raw[];
    volatile LAS unsigned* MISC = (volatile LAS unsigned*)((LAS unsigned char*)lds_raw + LDS_MISC);
    if (threadIdx.x < 16) MISC[threadIdx.x] = 0u;
    if (threadIdx.x == 0) { LAS unsigned long long* tb = (LAS unsigned long long*)((LAS unsigned char*)lds_raw + LDS_PTAB);
#pragma unroll
        for (int i = 0; i < 37; ++i) tb[i] = (unsigned long long)KA.in[i];
        tb[37] = (unsigned long long)KA.out; tb[38] = (unsigned long long)KA.ws; }
    __syncthreads();
    const int lo = KA.lo, hi = KA.hi;
    unsigned bar_x = 0;
    if (hi - lo > 1) { const XcdBarrier b0 = xcd_barrier_post((unsigned*)(KA.ws + WS_CTL), MISC); bar_x = b0.x; }
#ifndef PH_MASK
#define PH_MASK 0xFFFFFF
#endif
#ifndef REP_MASK
#define REP_MASK 0
#endif
#define PH_BIT(k) (((k) == 0) ? 0 : 1 + ((k) - 1) % NSLOT + (((k) - 1) % NSLOT >= 2 && ((k) - 1) % NSLOT <= 3 && odd ? 12 : 0))
#define RUN(k, ...) do { if (((PH_MASK >> PH_BIT(k)) & 1) && lo <= (k) && (k) < hi) { const int nrep = ((REP_MASK >> PH_BIT(k)) & 1) ? 2 : 1; \
        _Pragma("unroll 1") for (int rep = 0; rep < nrep; ++rep) { \
        Ctx C; mkctx(C, (LAS unsigned char*)lds_raw); Args A; ldargs(A, (LAS unsigned char*)lds_raw); unsigned char* ws = A.ws; \
        const float* MODL = (const float*)(ws + WS_MOD) + (size_t)l * 5 * 6144; (void)MODL; \
        __VA_ARGS__; if ((k) + 1 < hi || rep + 1 < nrep) { XcdBarrier bar; bar.bar = (unsigned*)(ws + WS_CTL); bar.x = bar_x; bar.st = MISC; xcd_barrier(bar); } } } } while (0)
    { const bool odd = false; const int l = 0; RUN(0, phase_init(C, A)); }
#pragma unroll 1
    for (int l = 0; l < DEPTH; ++l) {
        const int sb = 1 + l * NSLOT; const bool odd = l & 1;
        RUN(sb + 0, { phase_conv(C, A, l); if (l == 0) phase_modh(C, A, 0); });
        if (odd) { RUN(sb + 1, gphase_in_odd(C.lds, ws, C.G)); } else { RUN(sb + 1, gphase_in(C.lds, ws, D_IN_EVEN_PAD / 256, C.G)); }
        if (!odd) {
            RUN(sb + 2, phase_ef1(C, A, l));
            RUN(sb + 3, { const int i2 = l >> 1; gphase_lora(C.lds, ws, A.in[I_D0] + (size_t)i2 * 2 * 768, A.in[I_A0] + (size_t)i2 * 2 * 768, A.in[I_KAL] + (size_t)i2 * 768, C.G); });
#if CHUNKED_SCAN
            RUN(sb + 4, phase_csa(C, A));
            RUN(sb + 5, phase_csb(C, A, l));
#else
            RUN(sb + 4, phase_scan(C, A));
#endif
            RUN(sb + 6, phase_ef2(C, A, l));
        } else {
            RUN(sb + 2, phase_of1(C, A, l));
            RUN(sb + 3, phase_attn(C, A, l));
        }
        RUN(sb + 7, gphase_out(C.lds, ws, MODL, C.G));
        RUN(sb + 8, phase_rt(C, A, l));
        RUN(sb + 9, phase_tk(C, A));
        RUN(sb + 10, gphase_e1(C.lds, ws, C.G, l));
        RUN(sb + 11, gphase_e2(C.lds, ws, C.G, l));
        RUN(sb + 12, phase_cb(C, A, l));
    }
#undef RUN
}

#ifdef PHASE_PROBE
#define PROBE_PRE extern __shared__ __attribute__((aligned(16))) unsigned char lds_raw[]; Ctx C; mkctx(C, (LAS unsigned char*)lds_raw); unsigned char* ws = A.ws; (void)ws;
__global__ void __launch_bounds__(NTHR, 2) pr_init(Args A) { PROBE_PRE phase_init(C, A); }
__global__ void __launch_bounds__(NTHR, 2) pr_conv(Args A) { PROBE_PRE phase_conv(C, A, A.lo); }
__global__ void __launch_bounds__(NTHR, 2) pr_modh(Args A) { PROBE_PRE phase_modh(C, A, A.lo); }
__global__ void __launch_bounds__(NTHR, 2) pr_ef1(Args A) { PROBE_PRE phase_ef1(C, A, A.lo); }
__global__ void __launch_bounds__(NTHR, 2) pr_scan(Args A) { PROBE_PRE phase_scan(C, A); }
__global__ void __launch_bounds__(NTHR, 2) pr_ef2(Args A) { PROBE_PRE phase_ef2(C, A, A.lo); }
__global__ void __launch_bounds__(NTHR, 2) pr_csa(Args A) { PROBE_PRE phase_csa(C, A); }
__global__ void __launch_bounds__(NTHR, 2) pr_csb(Args A) { PROBE_PRE phase_csb(C, A, A.lo); }
__global__ void __launch_bounds__(NTHR, 2) pr_of1(Args A) { PROBE_PRE phase_of1(C, A, A.lo); }
__global__ void __launch_bounds__(NTHR, 2) pr_attn(Args A) { PROBE_PRE phase_attn(C, A, A.lo); }
__global__ void __launch_bounds__(NTHR, 2) pr_rt(Args A) { PROBE_PRE phase_rt(C, A, A.lo); }
__global__ void __launch_bounds__(NTHR, 2) pr_tk(Args A) { PROBE_PRE phase_tk(C, A); }
__global__ void __launch_bounds__(NTHR, 2) pr_cb(Args A) { PROBE_PRE phase_cb(C, A, A.lo); }
__global__ void __launch_bounds__(NTHR, 2) pr_gemm_in(Args A) { PROBE_PRE pg8::Gemm g{(const bf16_t*)(ws + WS_H), (const bf16_t*)(ws + WS_WIN), DM}; pg8::Order<0> S; S.init(MROWS / 256, A.lo, C.G, (int)blockIdx.x, nullptr, 0);
                      pg8::EpiBf16 E{(bf16_t*)(ws + WS_P), P_LD}; pg8::gemm_phase(C.lds, g, S, E); }
__global__ void __launch_bounds__(NTHR, 2) pr_gemm_lora(Args A) { PROBE_PRE pg8::Gemm g{(const bf16_t*)(ws + WS_LIN), (const bf16_t*)(ws + WS_WLORA), LORA_K}; pg8::Order<0> S; S.init(MROWS / 256, LORA_N / 256, C.G, (int)blockIdx.x, nullptr, 0);
                          const int i2 = A.lo; pg8::EpiLora E{ws + WS_SCN, (bf16_t*)(ws + WS_G), A.in[I_D0] + (size_t)i2 * 2 * 768, A.in[I_A0] + (size_t)i2 * 2 * 768, A.in[I_KAL] + (size_t)i2 * 768};
                          pg8::gemm_phase(C.lds, g, S, E); }
__global__ void __launch_bounds__(NTHR, 2) pr_gemm_out(Args A) { PROBE_PRE pg8::Gemm g{(const bf16_t*)(ws + WS_A2), (const bf16_t*)(ws + WS_WOUT), DM}; pg8::Order<0> S; S.init(MROWS / 256, DM / 256, C.G, (int)blockIdx.x, nullptr, 0);
                      pg8::EpiRes E{(float*)(ws + WS_X), (const float*)(ws + WS_MOD)}; pg8::gemm_phase(C.lds, g, S, E); }
__global__ void __launch_bounds__(NTHR, 2) pr_gemm_e1(Args A) { PROBE_PRE pg8::Gemm g{(const bf16_t*)(ws + WS_H), (const bf16_t*)(ws + WS_WE13), DM}; pg8::Order<1> S; S.init(NEXP * 17, 4096 / 256, C.G, (int)blockIdx.x, (const int*)(ws + WS_IDX), (long)4096 * DM);
                      pg8::EpiSwiGLU E{(bf16_t*)(ws + WS_HID)}; pg8::gemm_phase(C.lds, g, S, E); }
__global__ void __launch_bounds__(NTHR, 2) pr_gemm_e2(Args A) { PROBE_PRE pg8::Gemm g{(const bf16_t*)(ws + WS_HID), (const bf16_t*)(ws + WS_WE2), D_EXP}; pg8::Order<2> S; S.init(NEXP * 17, DM / 256, C.G, (int)blockIdx.x, nullptr, (long)DM * D_EXP);
                       pg8::EpiYE E{(bf16_t*)(ws + WS_YE), (const float*)(ws + WS_GATE)}; pg8::gemm_phase(C.lds, g, S, E); }
#endif

extern "C" void kernel_launch(void* const* d_in, const int* in_sizes, int n_in, void* d_out, int out_size, void* d_ws, size_t ws_size, hipStream_t stream) {
    static int grid = 0;
    if (grid == 0) {
        if (n_in != 37 || out_size != NLAT * DM || ws_size < WS_END) { fprintf(stderr, "kernel_launch: unexpected shapes: n_in %d out %d ws %zu (need %zu)\n", n_in, out_size, ws_size, (size_t)WS_END); grid = -1; return; }
        int dev = 0, cus = 0, per_cu = 0;
        if (hipGetDevice(&dev) != hipSuccess || hipDeviceGetAttribute(&cus, hipDeviceAttributeMultiprocessorCount, dev) != hipSuccess) { grid = -1; return; }
        if (hipFuncSetAttribute((const void*)mk_fwd, hipFuncAttributeMaxDynamicSharedMemorySize, LDS_BYTES) != hipSuccess) { fprintf(stderr, "kernel_launch: hipFuncSetAttribute failed\n"); grid = -1; return; }
        if (hipOccupancyMaxActiveBlocksPerMultiprocessor(&per_cu, (const void*)mk_fwd, NTHR, LDS_BYTES) != hipSuccess || per_cu < 1) fprintf(stderr, "kernel_launch: occupancy query reports %d\n", per_cu);
        (void)hipGetLastError();
        grid = cus;
    }
    if (grid < 0) return;
    (void)hipMemsetAsync((char*)d_ws + WS_CTL, 0, CTL_BYTES, stream);
    Args a{};
    for (int i = 0; i < 37; ++i) a.in[i] = (const float*)d_in[i];
    a.out = (float*)d_out; a.ws = (unsigned char*)d_ws;
#if MK_MULTI
    for (int k = 0; k < NSTEP; ++k) {
        if (k >= 1) { const int l = (k - 1) / NSLOT, s = (k - 1) % NSLOT; if ((l & 1) && (s >= 4 && s <= 6)) continue; if (!(l & 1) && !CHUNKED_SCAN && s == 5) continue; }
        a.lo = k; a.hi = k + 1;
        hipLaunchKernelGGL(mk_fwd, dim3(grid), dim3(NTHR), LDS_BYTES, stream, a);
    }
#else
    a.lo = 0; a.hi = NSTEP;
    hipLaunchKernelGGL(mk_fwd, dim3(grid), dim3(NTHR), LDS_BYTES, stream, a);
#endif
    const hipError_t le = hipPeekAtLastError();
    if (le != hipSuccess) fprintf(stderr, "kernel_launch: launch failed: %s\n", hipGetErrorName(le));
}
```

```cpp
#include <hip/hip_runtime.h>
#include <cstdio>
#include <cstdint>
#include <cmath>

#ifndef MK_MULTI
#define MK_MULTI 0
#endif
#ifndef CHUNKED_SCAN
#define CHUNKED_SCAN 1
#endif

#define GAS __attribute__((address_space(1)))
#define LAS __attribute__((address_space(3)))
typedef unsigned short bf16_t;
typedef short bf16x8 __attribute__((ext_vector_type(8)));
typedef float f32x4 __attribute__((ext_vector_type(4)));
typedef float f32x2 __attribute__((ext_vector_type(2)));
typedef float f32x16 __attribute__((ext_vector_type(16)));
typedef unsigned u32x4 __attribute__((ext_vector_type(4)));
typedef unsigned u32x2 __attribute__((ext_vector_type(2)));
typedef __bf16 bf16x2_t __attribute__((ext_vector_type(2)));

constexpr int NB = 4, TT = 8192, DM = 1024, NLAT = NB * TT, CTXL = 256, NCTX = NB * CTXL, MROWS = NLAT + NCTX;
constexpr int DEPTH = 4;
constexpr int D_CONV = 256, RW_H = 12, RW_K = 64, D_RWKV = 768, RWKV_COLS = 2688, D_IN_EVEN = 3456, D_IN_EVEN_PAD = 3584;
constexpr int D_DIFF = 768, D_GMLP = 256, D_IN_ODD = 2816;
constexpr int NEXP = 16, D_EXP = 2048, CAP_L = 1024, CAP_C = 32, ESLOTS = 4352;
constexpr int P_LD = 3584;
constexpr int LORA_K = 384, LORA_N = 3840;
constexpr int LKEYS = CTXL + TT;
constexpr float ALPHA_DN = 1.6817928305074290f;
constexpr float DECAY_SCALE = 0.6065306597126334f;
constexpr float GN_EPS = 64e-5f, LN_EPS = 1e-5f, RMS_EPS = 1e-5f;
constexpr float QSCALE = 0.125f * 1.4426950408889634f;

constexpr size_t al256(size_t x) { return (x + 255) & ~(size_t)255; }
constexpr size_t WS_CTL = 0;
constexpr size_t CTL_BYTES = 65536;
constexpr size_t WS_MOD = WS_CTL + CTL_BYTES;
constexpr size_t WS_ROPE = WS_MOD + al256((size_t)DEPTH * 5 * 6144 * 4);
constexpr size_t WS_WIN = WS_ROPE + 32768;
constexpr size_t WS_WOUT = WS_WIN + (size_t)D_IN_EVEN_PAD * DM * 2;
constexpr size_t WS_WLORA = WS_WOUT + (size_t)DM * DM * 2;
constexpr size_t WS_WE13 = WS_WLORA + (size_t)LORA_N * LORA_K * 2;
constexpr size_t WE13_BYTES = (size_t)NEXP * 4096 * DM * 2, WE2_BYTES = (size_t)NEXP * DM * D_EXP * 2;
constexpr size_t WS_WE2 = WS_WE13 + 2 * WE13_BYTES;
constexpr size_t WS_X = WS_WE2 + 2 * WE2_BYTES;
constexpr size_t WS_H = WS_X + (size_t)MROWS * DM * 4;
constexpr size_t WS_A2 = WS_H + (size_t)MROWS * DM * 2;
constexpr size_t WS_P = WS_A2 + (size_t)MROWS * DM * 2;
constexpr size_t WS_AFF = WS_P + (size_t)MROWS * P_LD * 2;
constexpr size_t WS_SLOT = WS_AFF + (size_t)MROWS * 16 * 4;
constexpr size_t WS_IDX = WS_SLOT + (size_t)MROWS * 16 * 4;
constexpr size_t WS_GATE = WS_IDX + al256((size_t)NEXP * ESLOTS * 4);
constexpr size_t WS_R2 = WS_GATE + al256((size_t)NEXP * ESLOTS * 4);
constexpr int SC_REC = 1408, SC_ROW = 12 * SC_REC, SC_W = 0, SC_R = 512, SC_KK = 640, SC_V = 768, SC_B = 896, SC_KR = 1024;
constexpr size_t WS_SCN = WS_R2;
constexpr size_t WS_G = WS_SCN + (size_t)MROWS * SC_ROW;
constexpr size_t WS_LIN = WS_G + (size_t)MROWS * 768 * 2;
constexpr int CS_L = 64, CS_NCH = LKEYS / CS_L, CS_UNITS = NB * RW_H * 2;
constexpr size_t WS_CHK = WS_LIN + (size_t)MROWS * 384 * 2;
constexpr size_t WS_EVEN_END = WS_CHK + (size_t)CS_UNITS * CS_NCH * 32768;
constexpr size_t WS_Y = WS_P;
constexpr size_t WS_Q = WS_R2;
constexpr size_t WS_KA = WS_Q + (size_t)MROWS * 768 * 2;
constexpr size_t WS_VT = WS_KA + (size_t)NB * LKEYS * 768 * 2;
constexpr size_t WS_HID = WS_R2;
constexpr size_t WS_YE = WS_HID + (size_t)NEXP * ESLOTS * D_EXP * 2;
constexpr size_t WS_END = WS_EVEN_END;
static_assert(WS_END <= (size_t)2147483648ull, "workspace over 2 GiB");
static_assert((size_t)2 * MROWS * 768 * 4 <= (size_t)MROWS * P_LD * 2, "Y aliases P");
static_assert(WS_YE + (size_t)NEXP * ESLOTS * DM * 2 <= WS_END, "moe region");

constexpr int LDS_BYTES = 147456;
constexpr int LDS_MISC = 140 * 1024;
constexpr int LDS_PTAB = LDS_MISC + 256;
constexpr int NWAVES = 8, NTHR = 512;

__device__ __forceinline__ unsigned f2bf(float f) { unsigned u = __float_as_uint(f); return (u + 0x7fffu + ((u >> 16) & 1u)) >> 16; }
__device__ __forceinline__ unsigned pk2(float lo, float hi) { f32x2 v = {lo, hi}; bf16x2_t b = __builtin_convertvector(v, bf16x2_t); return __builtin_bit_cast(unsigned, b); }
__device__ __forceinline__ float bflo(unsigned u) { return __uint_as_float(u << 16); }
__device__ __forceinline__ float bfhi(unsigned u) { return __uint_as_float(u & 0xffff0000u); }
__device__ __forceinline__ float bf2f(bf16_t b) { return __uint_as_float((unsigned)b << 16); }
__device__ __forceinline__ float sigmoidf_(float x) { return 1.f / (1.f + __expf(-x)); }
__device__ __forceinline__ float wave_sum(float v) {
#pragma unroll
    for (int o = 1; o < 64; o <<= 1) v += __shfl_xor(v, o);
    return v;
}
__device__ __forceinline__ float sum16(float v) {
#pragma unroll
    for (int o = 1; o < 16; o <<= 1) v += __shfl_xor(v, o);
    return v;
}
__device__ __forceinline__ f32x4 ld4bf_(const void* p) { const u32x2 u = *(const u32x2*)p; return (f32x4){bflo(u.x), bfhi(u.x), bflo(u.y), bfhi(u.y)}; }
__device__ __forceinline__ void st4bf_(void* p, f32x4 v) { u32x2 o; o.x = pk2(v[0], v[1]); o.y = pk2(v[2], v[3]); *(u32x2*)p = o; }
__device__ __forceinline__ float max3f(float a, float b, float c) { float r; asm("v_max3_f32 %0, %1, %2, %3" : "=v"(r) : "v"(a), "v"(b), "v"(c)); return r; }
__device__ __forceinline__ int crow(int r, int hi) { return (r & 3) + 8 * (r >> 2) + 4 * hi; }
__device__ __forceinline__ float gelu_erf(float x) { return 0.5f * x * (1.f + erff(x * 0.70710678118654752f)); }

#define XB_TMO      128
#define XB_XCNT(j)  (256  + 64 * (j))
#define XB_XSUB(j)  (1280 + 64 * (j))
#define XB_XGEN(j)  (2304 + 64 * (j))
#define XB_TOP      3328
#define XB_TOPGEN   3392
#define XCD_BAR_WORDS 3456
#define XB_SPIN_CAP (1u << 20)

__device__ __forceinline__ unsigned xb_ld(unsigned* p)              { return __hip_atomic_load(p, __ATOMIC_RELAXED, __HIP_MEMORY_SCOPE_AGENT); }
__device__ __forceinline__ unsigned xb_add(unsigned* p, unsigned v) { return __hip_atomic_fetch_add(p, v, __ATOMIC_RELAXED, __HIP_MEMORY_SCOPE_AGENT); }
__device__ __forceinline__ unsigned xb_xcc_id() { return (unsigned)__builtin_amdgcn_s_getreg((3 << 11) | 20) & 0xFu; }
#define XB_SPIN(cond, bar) do { unsigned _sp = 0; while (cond) { __builtin_amdgcn_s_sleep(1); \
    if ((++_sp & 255u) == 0u) { if (xb_ld(&(bar)[XB_TMO])) break; if (_sp > XB_SPIN_CAP) { atomicAdd(&(bar)[XB_TMO], 1u); break; } } } } while (0)

struct XcdBarrier { unsigned* bar; unsigned x; volatile LAS unsigned* st; };

__device__ __forceinline__ XcdBarrier xcd_barrier_post(unsigned* bar, volatile LAS unsigned* st) {
    XcdBarrier b; b.bar = bar; b.x = xb_xcc_id(); b.st = st;
    if (threadIdx.x == 0) (void)xb_add(&bar[XB_XCNT(b.x)], 1u);
    return b;
}
__device__ __forceinline__ void xcd_barrier_complete(unsigned* bar, unsigned x, unsigned& nloc, unsigned& nx) {
    const unsigned G = gridDim.x * gridDim.y * gridDim.z;
    unsigned sum, cnt, mine, sp = 0u;
    for (;;) {
        sum = 0u; cnt = 0u; mine = 0u;
#pragma unroll
        for (unsigned j = 0; j < 16; ++j) { const unsigned c = xb_ld(&bar[XB_XCNT(j)]); sum += c; cnt += (c > 0u) ? 1u : 0u; mine = (j == x) ? c : mine; }
        if (sum == G) break;
        __builtin_amdgcn_s_sleep(1);
        if ((++sp & 255u) == 0u) { if (xb_ld(&bar[XB_TMO])) break; if (sp > XB_SPIN_CAP) { atomicAdd(&bar[XB_TMO], 1u); break; } }
    }
    nloc = mine > 0u ? mine : 1u; nx = cnt > 0u ? cnt : 1u;
}
__device__ __forceinline__ void xcd_barrier(const XcdBarrier& b) {
    asm volatile("s_waitcnt vmcnt(0)" ::: "memory");
    __syncthreads();
    if (threadIdx.x == 0) {
        unsigned* bar = b.bar;
        __builtin_amdgcn_s_waitcnt(0);
        unsigned nloc = b.st[0], nx = b.st[1];
        if (nloc == 0u) { xcd_barrier_complete(bar, b.x, nloc, nx); b.st[0] = nloc; b.st[1] = nx; }
        const unsigned old = xb_add(&bar[XB_XSUB(b.x)], 1u);
        const unsigned gen = old / nloc;
        if (old + 1u == (gen + 1u) * nloc) {
            __builtin_amdgcn_fence(__ATOMIC_RELEASE, "agent");
            asm volatile("s_waitcnt vmcnt(0)" ::: "memory");
            const unsigned og = xb_add(&bar[XB_TOP], 1u);
            const unsigned tg = og / nx;
            if (og + 1u == (tg + 1u) * nx) xb_add(&bar[XB_TOPGEN], 1u);
            else XB_SPIN(xb_ld(&bar[XB_TOPGEN]) == tg, bar);
            __builtin_amdgcn_fence(__ATOMIC_ACQUIRE, "agent");
            xb_add(&bar[XB_XGEN(b.x)], 1u);
            asm volatile("s_waitcnt vmcnt(0)" ::: "memory");
        } else {
            XB_SPIN(xb_ld(&bar[XB_XGEN(b.x)]) == gen, bar);
            __builtin_amdgcn_fence(__ATOMIC_ACQUIRE, "agent");
            asm volatile("s_waitcnt vmcnt(0)" ::: "memory");
        }
    }
    __syncthreads();
}

namespace pg8 {
constexpr int BM = 256, BK = 64, HALF = 128, HTB = HALF * BK * 2, STAGE_BYTES = 8 * HTB, NXCD = 8, WGM = 8;
__host__ __device__ __forceinline__ int lds_byte(int r, int c) { const int st = (r >> 4) * 2 + (c >> 5), rr = r & 15, cc = c & 31, ob = rr * 64 + cc * 2; return st * 1024 + (ob ^ (((ob >> 9) & 1) << 5)); }
__host__ __device__ __forceinline__ void stage_rc(int b, int& R, int& C) { const int st = b / 1024, sb = b % 1024, swz = sb ^ (((sb >> 9) & 1) << 5); R = (st >> 1) * 16 + swz / 64; C = (st & 1) * 32 + (swz % 64) / 2; }

struct Unit { int pm, pn, hf; };
struct Gemm { const bf16_t* A; const bf16_t* Bt; int K; };

template <int MODE> struct Order {
    static constexpr bool GATHER = (MODE == 1);
    int nM, nN, nwg, G, c; const int* idx; long bstride;
    __device__ __forceinline__ void init(int nM_, int nN_, int G_, int c_, const int* idx_, long bstride_) { nM = nM_; nN = nN_; nwg = nM * nN; G = G_; c = c_; idx = idx_; bstride = bstride_; }
    __device__ __forceinline__ bool next(int i, Unit& u) const {
        const long L = (long)i * G + c; if (L >= nwg) return false;
        int wgid = (int)L; { const int q = nwg / NXCD, r = nwg % NXCD, xcd = wgid % NXCD, off = wgid / NXCD; wgid = (xcd < r ? xcd * (q + 1) : r * (q + 1) + (xcd - r) * q) + off; }
        const int nig = WGM * nN, gid = wgid / nig, fm = gid * WGM, gsz = (nM - fm) < WGM ? (nM - fm) : WGM;
        u.pm = fm + ((wgid % nig) % gsz); u.pn = (wgid % nig) / gsz; u.hf = (MODE != 0 && (u.pm % 17) == 16) ? 1 : 0; return true;
    }
    __device__ __forceinline__ unsigned arow(const Unit& u, int r) const { if (MODE == 1) return (unsigned)idx[u.pm * BM + r]; return (unsigned)(u.pm * BM + r); }
    __device__ __forceinline__ long bbase(const Unit& u, int K) const { long o = (long)u.pn * BM * K; if (MODE != 0) o += (long)(u.pm / 17) * bstride; return o; }
};

template <int MODE> struct OrderExp {
    static constexpr bool GATHER = (MODE == 1);
    int nN, G, c0; const int* idx; long bstride;
    __device__ __forceinline__ void init(int nN_, int G_, int c_, const int* idx_, long bstride_) { nN = nN_; G = G_; c0 = c_; idx = idx_; bstride = bstride_; }
    __device__ __forceinline__ bool next(int i0, Unit& u) const {
        const int v = i0 * G + c0, i = v >> 8, c = v & 255;
        const int x = c & 7, slot = c >> 3, per = 32 / nN, nfull = 256 / (8 * per);
        if (i > nfull) return false;
        if (i < nfull) { u.pn = slot / per; const int f = (i * 8 + x) * per + (slot % per); u.pm = (f >> 4) * 17 + (f & 15); u.hf = 0; return true; }
        if (i == nfull && slot < 2 * nN) { u.pn = slot >> 1; u.pm = (x * 2 + (slot & 1)) * 17 + 16; u.hf = 1; return true; }
        return false;
    }
    __device__ __forceinline__ unsigned arow(const Unit& u, int r) const { if (MODE == 1) return (unsigned)idx[u.pm * BM + r]; return (unsigned)(u.pm * BM + r); }
    __device__ __forceinline__ long bbase(const Unit& u, int K) const { return (long)u.pn * BM * K + (long)(u.pm / 17) * bstride; }
};

template <class Epi, class Sched>
__device__ __forceinline__ void gemm_phase(LAS unsigned char* lds, const Gemm g, const Sched& S, const Epi& E) {
    int tid = threadIdx.x; asm volatile("" : "+v"(tid));
    const int wid = __builtin_amdgcn_readfirstlane(tid >> 6), wr = wid >> 2, wc = wid & 3;
    const int K = g.K, nt = K / BK;
    unsigned voffB[2];
    { const int lane = tid & 63, fr = lane & 15, fq = lane >> 4; (void)fr; (void)fq; }
#pragma unroll
    for (int i = 0; i < 2; ++i) { int R, Cc; stage_rc(tid * 16 + i * 8192, R, Cc); voffB[i] = (unsigned)(R * K + Cc) * 2u; }
    const size_t kstep = (size_t)(BK * 2);
    const size_t hstep = (size_t)HALF * K * 2;
    const unsigned ldsw = (unsigned)wid * 1024u;
    const int aoff = lds_byte(wr * 64 + (tid & 15), ((tid & 63) >> 4) * 8), boff = lds_byte(wc * 32 + (tid & 15), ((tid & 63) >> 4) * 8);
#define PG8_SA(b, h) (((b) * 2 + (h)) * HTB)
#define PG8_SB(b, h) ((4 + (b) * 2 + (h)) * HTB)
#define PG8_STAGE(bufoff, gbase, voff) do { _Pragma("unroll") for (int _i = 0; _i < 2; ++_i) \
        __builtin_amdgcn_global_load_lds((const unsigned*)((const char*)(gbase) + (voff)[_i]), (LAS unsigned*)(lds + (bufoff) + ldsw + _i * 8192), 16, 0, 0); } while (0)
#define PG8_LDA(dst, b, h) do { _Pragma("unroll") for (int m = 0; m < 4; ++m) _Pragma("unroll") for (int k = 0; k < 2; ++k) dst[m][k] = *(const LAS bf16x8*)(lds + PG8_SA(b, h) + aoff + m * 2048 + k * 1024); } while (0)
#define PG8_LDB(dst, b, h) do { _Pragma("unroll") for (int n = 0; n < 2; ++n) _Pragma("unroll") for (int k = 0; k < 2; ++k) dst[n][k] = *(const LAS bf16x8*)(lds + PG8_SB(b, h) + boff + n * 2048 + k * 1024); } while (0)
#define PG8_MMA(ai, bj, At, Bt) do { __builtin_amdgcn_s_setprio(1); _Pragma("unroll") for (int m = 0; m < 4; ++m) _Pragma("unroll") for (int n = 0; n < 2; ++n) _Pragma("unroll") for (int k = 0; k < 2; ++k) \
        acc[ai][bj][m][n] = __builtin_amdgcn_mfma_f32_16x16x32_bf16(Bt[n][k], At[m][k], acc[ai][bj][m][n], 0, 0, 0); __builtin_amdgcn_s_setprio(0); } while (0)
#define PG8_WAIT_V(n) asm volatile("s_waitcnt vmcnt(" #n ")" ::: "memory")
#define PG8_WAIT_L(n) asm volatile("s_waitcnt lgkmcnt(" #n ")" ::: "memory")
#define PG8_BAR __builtin_amdgcn_s_barrier()
#define PG8_SCHED __builtin_amdgcn_sched_barrier(0)
#define PG8_ROWOFFS(dst, u, tq) do { _Pragma("unroll") for (int _i = 0; _i < 2; ++_i) { int _R, _C; stage_rc((tq) * 16 + _i * 8192, _R, _C); _Pragma("unroll") for (int _h = 0; _h < 2; ++_h) dst[_h][_i] = (S.arow(u, _h * HALF + _R) * (unsigned)K + (unsigned)_C) * 2u; } } while (0)
    Unit cur, nxt; int ui = 0;
    if (!S.next(0, cur)) return;
    float zf = 0.f; asm volatile("" : "+v"(zf));
    f32x4 acc[2][2][4][2];
#pragma unroll
    for (int a = 0; a < 2; ++a)
#pragma unroll
        for (int b = 0; b < 2; ++b)
#pragma unroll
            for (int m = 0; m < 4; ++m)
#pragma unroll
                for (int n = 0; n < 2; ++n) acc[a][b][m][n] = (f32x4){zf, zf, zf, zf};
    bf16x8 At[4][2], B0[2][2], B1[2][2];
    unsigned vcur[2][2];
    if constexpr (Sched::GATHER) { PG8_ROWOFFS(vcur, cur, tid); }
    const char* const Ab = (const char*)g.A;
    const char* cA = Sched::GATHER ? Ab : Ab + (size_t)(unsigned)__builtin_amdgcn_readfirstlane((int)S.arow(cur, 0)) * K * 2;
#define PG8_STAGEA(bufoff, ptr, h) do { if constexpr (Sched::GATHER) { PG8_STAGE(bufoff, ptr, vcur[h]); } else { PG8_STAGE(bufoff, (ptr) + (h) * hstep, voffB); } } while (0)
    const char* cB = (const char*)g.Bt + (size_t)S.bbase(cur, K) * 2;
    PG8_STAGE(PG8_SB(0, 0), cB, voffB); PG8_STAGE(PG8_SB(0, 1), cB + hstep, voffB); PG8_STAGEA(PG8_SA(0, 0), cA, 0); PG8_STAGEA(PG8_SA(0, 1), cA, 1);
    if (wr == 1) PG8_BAR;
    PG8_WAIT_V(2); PG8_BAR;
    PG8_STAGE(PG8_SB(1, 0), cB + kstep, voffB); PG8_STAGEA(PG8_SA(1, 0), cA + kstep, 0); PG8_STAGE(PG8_SB(1, 1), cB + hstep + kstep, voffB);
    PG8_WAIT_V(6); PG8_BAR;
    for (;;) {
        const bool has_next = S.next(ui + 1, nxt);
        const char* nB = has_next ? (const char*)g.Bt + (size_t)S.bbase(nxt, K) * 2 : cB;
        const char* nA = (Sched::GATHER || !has_next) ? cA : Ab + (size_t)(unsigned)__builtin_amdgcn_readfirstlane((int)S.arow(nxt, 0)) * K * 2;
#pragma unroll 1
        for (int t = 0; t < nt; t += 2) {
            const bool last = (t == nt - 2);
            const char* a1 = cA + (size_t)(t + 1) * kstep;
            const char* a2 = last ? nA : cA + (size_t)(t + 2) * kstep; const char* b2 = last ? nB : cB + (size_t)(t + 2) * kstep;
            const char* a3 = a2 + kstep; const char* b3 = b2 + kstep;
            PG8_LDB(B0, 0, 0); PG8_LDB(B1, 0, 1); PG8_SCHED; PG8_LDA(At, 0, 0); PG8_STAGEA(PG8_SA(1, 1), a1, 1);
            PG8_WAIT_V(8); PG8_WAIT_L(0); PG8_BAR; PG8_MMA(0, 0, At, B0); PG8_MMA(0, 1, At, B1); PG8_BAR; PG8_SCHED;
            if constexpr (Sched::GATHER) { if (last && has_next) { int tq = tid; asm volatile("" : "+v"(tq)); PG8_ROWOFFS(vcur, nxt, tq); } }
            PG8_LDA(At, 0, 1); PG8_STAGE(PG8_SB(0, 0), b2, voffB); PG8_STAGE(PG8_SB(0, 1), b2 + hstep, voffB); PG8_STAGEA(PG8_SA(0, 0), a2, 0);
            PG8_WAIT_V(8); PG8_WAIT_L(0); PG8_BAR; if (!cur.hf) { PG8_MMA(1, 0, At, B0); PG8_MMA(1, 1, At, B1); } PG8_BAR; PG8_SCHED;
            PG8_LDB(B0, 1, 0); PG8_LDB(B1, 1, 1); PG8_SCHED; PG8_LDA(At, 1, 0); PG8_STAGEA(PG8_SA(0, 1), a2, 1);
            PG8_WAIT_V(8); PG8_WAIT_L(0); PG8_BAR; PG8_MMA(0, 0, At, B0); PG8_MMA(0, 1, At, B1); PG8_BAR; PG8_SCHED;
            PG8_LDA(At, 1, 1); PG8_STAGE(PG8_SB(1, 0), b3, voffB); PG8_STAGE(PG8_SB(1, 1), b3 + hstep, voffB); PG8_STAGEA(PG8_SA(1, 0), a3, 0);
            PG8_WAIT_V(8); PG8_WAIT_L(0); PG8_BAR; if (!cur.hf) { PG8_MMA(1, 0, At, B0); PG8_MMA(1, 1, At, B1); } PG8_BAR; PG8_SCHED;
        }
        if (wr == 0) PG8_BAR;
        { int tz = tid; asm volatile("" : "+v"(tz)); const int ln = tz & 63; E(acc, cur, wr, wc, ln & 15, ln >> 4); }
        if (!has_next) break;
#pragma unroll
        for (int a = 0; a < 2; ++a)
#pragma unroll
            for (int b = 0; b < 2; ++b)
#pragma unroll
                for (int m = 0; m < 4; ++m)
#pragma unroll
                    for (int n = 0; n < 2; ++n) acc[a][b][m][n] = (f32x4){zf, zf, zf, zf};
        cur = nxt; cB = nB; cA = nA; ++ui;
        if (wr == 1) PG8_BAR;
    }
    PG8_WAIT_V(0);
    PG8_BAR;
#undef PG8_SA
#undef PG8_SB
#undef PG8_STAGE
#undef PG8_LDA
#undef PG8_LDB
#undef PG8_MMA
#undef PG8_WAIT_V
#undef PG8_WAIT_L
#undef PG8_BAR
#undef PG8_SCHED
#undef PG8_ROWOFFS
#undef PG8_STAGEA
}

#define EPI_LOOP for (int ai = 0; ai < 2; ++ai) for (int m = 0; m < 4; ++m) for (int bj = 0; bj < 2; ++bj) for (int n = 0; n < 2; ++n)
struct EpiBf16 {
    bf16_t* O; int ldc;
    __device__ __forceinline__ void operator()(const f32x4 (&acc)[2][2][4][2], const Unit& u, int wr, int wc, int fr, int fq) const {
        const int row0 = u.pm * BM + wr * 64 + fr, col0 = u.pn * BM + wc * 32 + 4 * fq;
#pragma unroll
        for (int ai = 0; ai < 2; ++ai)
#pragma unroll
            for (int m = 0; m < 4; ++m) { bf16_t* rowp = O + (size_t)(row0 + ai * HALF + m * 16) * ldc + col0;
#pragma unroll
                for (int bj = 0; bj < 2; ++bj)
#pragma unroll
                    for (int n = 0; n < 2; ++n) { const f32x4 v = acc[ai][bj][m][n]; u32x2 o; o.x = pk2(v[0], v[1]); o.y = pk2(v[2], v[3]); *(u32x2*)(rowp + bj * HALF + n * 16) = o; } }
    }
};
struct EpiOdd {
    bf16_t* P; bf16_t* Q; bf16_t* KA; const float* rope;
    __device__ __forceinline__ void operator()(const f32x4 (&acc)[2][2][4][2], const Unit& u, int wr, int wc, int fr, int fq) const {
        const int row0 = u.pm * BM + wr * 64 + fr, col0 = u.pn * BM + wc * 32 + 4 * fq;
        if (u.pn >= 6) {
#pragma unroll
            for (int ai = 0; ai < 2; ++ai)
#pragma unroll
                for (int m = 0; m < 4; ++m) { bf16_t* rowp = P + (size_t)(row0 + ai * HALF + m * 16) * P_LD + col0;
#pragma unroll
                    for (int bj = 0; bj < 2; ++bj)
#pragma unroll
                        for (int n = 0; n < 2; ++n) { const f32x4 v = acc[ai][bj][m][n]; u32x2 o; o.x = pk2(v[0], v[1]); o.y = pk2(v[2], v[3]); *(u32x2*)(rowp + bj * HALF + n * 16) = o; } }
            return;
        }
        const bool isk = u.pn >= 3, isctx = u.pm >= NLAT / BM; const int axis = wc & 1;
        const int cq = col0 - (isk ? 768 : 0);
#pragma unroll
        for (int ai = 0; ai < 2; ++ai)
#pragma unroll
            for (int m = 0; m < 4; ++m) { const int row = row0 + ai * HALF + m * 16;
                f32x4 cs = {1.f, 1.f, 1.f, 1.f}, sn = {0.f, 0.f, 0.f, 0.f}; size_t orow;
                if (!isctx) { const int t = row & (TT - 1); const int pos = axis ? 128 + (t & 63) : (t >> 6);
                    cs = *(const f32x4*)(rope + pos * 16 + 4 * fq); sn = *(const f32x4*)(rope + 192 * 16 + pos * 16 + 4 * fq);
                    orow = isk ? (size_t)(row >> 13) * LKEYS + CTXL + t : (size_t)row; }
                else { const int rc = row - NLAT; orow = isk ? (size_t)(rc >> 8) * LKEYS + (rc & 255) : (size_t)row; }
                bf16_t* op = (isk ? KA : Q) + orow * 768 + cq; const float sc = isk ? 1.f : QSCALE;
#pragma unroll
                for (int bj = 0; bj < 2; ++bj) { const f32x4 x1 = acc[ai][bj][m][0], x2 = acc[ai][bj][m][1];
                    const f32x4 o1 = (x1 * cs - x2 * sn) * sc, o2 = (x1 * sn + x2 * cs) * sc;
                    u32x2 a; a.x = pk2(o1[0], o1[1]); a.y = pk2(o1[2], o1[3]); *(u32x2*)(op + bj * HALF) = a;
                    u32x2 b; b.x = pk2(o2[0], o2[1]); b.y = pk2(o2[2], o2[3]); *(u32x2*)(op + bj * HALF + 16) = b; } }
    }
};
struct EpiRes {
    float* X; const float* modl;
    __device__ __forceinline__ void operator()(const f32x4 (&acc)[2][2][4][2], const Unit& u, int wr, int wc, int fr, int fq) const {
        const int row0 = u.pm * BM + wr * 64 + fr, col0 = u.pn * BM + wc * 32 + 4 * fq;
        const int mi = (u.pm * BM < NLAT) ? (u.pm * BM) / TT : 4;
        const float* gate = modl + mi * 6144 + 2 * DM;
        f32x4 gv[2][2];
#pragma unroll
        for (int bj = 0; bj < 2; ++bj)
#pragma unroll
            for (int n = 0; n < 2; ++n) gv[bj][n] = *(const f32x4*)(gate + col0 + bj * HALF + n * 16);
#pragma unroll
        for (int ai = 0; ai < 2; ++ai)
#pragma unroll
            for (int m = 0; m < 4; ++m) { float* rowp = X + (size_t)(row0 + ai * HALF + m * 16) * DM + col0;
#pragma unroll
                for (int bj = 0; bj < 2; ++bj)
#pragma unroll
                    for (int n = 0; n < 2; ++n) { f32x4* p = (f32x4*)(rowp + bj * HALF + n * 16); const f32x4 x = *p; *p = x * ALPHA_DN + gv[bj][n] * acc[ai][bj][m][n]; } }
    }
};
struct EpiSwiGLU {
    bf16_t* HID;
    __device__ __forceinline__ void operator()(const f32x4 (&acc)[2][2][4][2], const Unit& u, int wr, int wc, int fr, int fq) const {
        const int row0 = u.pm * BM + wr * 64 + fr, f0 = u.pn * HALF + wc * 32 + 4 * fq;
#pragma unroll
        for (int ai = 0; ai < 2; ++ai) if (ai == 0 || !u.hf)
#pragma unroll
            for (int m = 0; m < 4; ++m) { bf16_t* rowp = HID + (size_t)(row0 + ai * HALF + m * 16) * D_EXP + f0;
#pragma unroll
                for (int n = 0; n < 2; ++n) { const f32x4 a = acc[ai][0][m][n], b = acc[ai][1][m][n]; float h[4];
#pragma unroll
                    for (int j = 0; j < 4; ++j) h[j] = a[j] / (1.f + __expf(-a[j])) * b[j];
                    u32x2 o; o.x = pk2(h[0], h[1]); o.y = pk2(h[2], h[3]); *(u32x2*)(rowp + n * 16) = o; } }
    }
};
struct EpiYE {
    bf16_t* YE; const float* gate;
    __device__ __forceinline__ void operator()(const f32x4 (&acc)[2][2][4][2], const Unit& u, int wr, int wc, int fr, int fq) const {
        const int row0 = u.pm * BM + wr * 64 + fr, col0 = u.pn * BM + wc * 32 + 4 * fq;
#pragma unroll
        for (int ai = 0; ai < 2; ++ai) if (ai == 0 || !u.hf)
#pragma unroll
            for (int m = 0; m < 4; ++m) { const int row = row0 + ai * HALF + m * 16; const float gt = gate[row]; bf16_t* rowp = YE + (size_t)row * DM + col0;
#pragma unroll
                for (int bj = 0; bj < 2; ++bj)
#pragma unroll
                    for (int n = 0; n < 2; ++n) { const f32x4 v = acc[ai][bj][m][n] * gt; u32x2 o; o.x = pk2(v[0], v[1]); o.y = pk2(v[2], v[3]); *(u32x2*)(rowp + bj * HALF + n * 16) = o; } }
    }
};
struct EpiLora {
    unsigned char* SCN; bf16_t* G; const float* decay0; const float* a0; const float* kalpha;
    __device__ __forceinline__ void operator()(const f32x4 (&acc)[2][2][4][2], const Unit& u, int wr, int wc, int fr, int fq) const {
        const int row0 = u.pm * BM + wr * 64 + fr;
        const int seg = u.pn / 3, cb = (u.pn % 3) * BM + wc * 32 + 4 * fq;
#pragma unroll
        for (int bj = 0; bj < 2; ++bj)
#pragma unroll
            for (int n = 0; n < 2; ++n) {
                const int col = cb + bj * HALF + n * 16, head = col >> 6, kx = col & 63;
                if (seg < 2) {
                    const f32x4 d0 = *(const f32x4*)(decay0 + seg * 768 + col);
#pragma unroll
                    for (int ai = 0; ai < 2; ++ai)
#pragma unroll
                        for (int m = 0; m < 4; ++m) { const int row = row0 + ai * HALF + m * 16; f32x4 w;
#pragma unroll
                            for (int j = 0; j < 4; ++j) { const float lw = -DECAY_SCALE * sigmoidf_(d0[j] + acc[ai][bj][m][n][j]); w[j] = CHUNKED_SCAN ? lw : __expf(lw); }
                            *(f32x4*)(SCN + (size_t)(row * 12 + head) * SC_REC + SC_W + seg * 256 + kx * 4) = w; __builtin_amdgcn_sched_barrier(0); }
                } else if (seg < 4) {
                    const int d = seg - 2;
                    const f32x4 a00 = *(const f32x4*)(a0 + d * 768 + col), kal = *(const f32x4*)(kalpha + col);
#pragma unroll
                    for (int ai = 0; ai < 2; ++ai)
#pragma unroll
                        for (int m = 0; m < 4; ++m) { const int row = row0 + ai * HALF + m * 16; unsigned char* base = SCN + (size_t)(row * 12 + head) * SC_REC + kx * 2;
                            const f32x4 kk = ld4bf_(base + SC_KK); const f32x4 ks = ld4bf_(base + SC_KR + 256 * d); f32x4 bb, kr;
#pragma unroll
                            for (int j = 0; j < 4; ++j) { const float a = sigmoidf_(a00[j] + acc[ai][bj][m][n][j]); bb[j] = kk[j] * a; kr[j] = ks[j] * (1.f + (a - 1.f) * kal[j]); }
                            st4bf_(base + SC_B + 256 * d, bb); st4bf_(base + SC_KR + 256 * d, kr); __builtin_amdgcn_sched_barrier(0); }
                } else {
#pragma unroll
                    for (int ai = 0; ai < 2; ++ai)
#pragma unroll
                        for (int m = 0; m < 4; ++m) { const int row = row0 + ai * HALF + m * 16; const f32x4 v = acc[ai][bj][m][n]; u32x2 o; o.x = pk2(v[0], v[1]); o.y = pk2(v[2], v[3]);
                            *(u32x2*)(G + (size_t)row * 768 + col) = o; }
                }
            }
    }
};
}

struct Args { const float* in[37]; float* out; unsigned char* ws; int lo, hi; };
enum { I_X = 0, I_C, I_CTX, I_CCTX, I_WMOD, I_BMOD, I_LNG, I_LNB, I_EWIN, I_EWOUT, I_CONVW, I_MU, I_DUP, I_D0, I_AUP, I_A0, I_GUP, I_KXI, I_KAL, I_RBON, I_GNG, I_GNB,
       I_OWIN, I_OWOUT, I_LQ1, I_LK1, I_LQ2, I_LK2, I_SUBG, I_GLNG, I_GLNB, I_GWS, I_GBS, I_WR, I_WE1, I_WE3, I_WE2 };

struct Ctx {
    LAS unsigned char* lds;
    int tid, lane, wave, G, vcu, gw, NGW;
};
__device__ __forceinline__ void mkctx(Ctx& C, LAS unsigned char* lds) {
    int tid = threadIdx.x; asm volatile("" : "+v"(tid));
    C.lds = lds; C.tid = tid; C.lane = tid & 63; C.wave = __builtin_amdgcn_readfirstlane(tid >> 6);
    C.G = gridDim.x; { const int bx = blockIdx.x; C.vcu = (C.G % 8 == 0) ? (bx % 8) * (C.G / 8) + bx / 8 : bx; }
    C.gw = blockIdx.x * NWAVES + C.wave; C.NGW = C.G * NWAVES;
}
__device__ __forceinline__ void ldargs(Args& A, LAS unsigned char* lds) {
    LAS const u32x2* tb = (LAS const u32x2*)(lds + LDS_PTAB); asm volatile("" : "+v"(tb));
#pragma unroll
    for (int i = 0; i < 37; ++i) { const u32x2 v = tb[i]; A.in[i] = (const float*)(((unsigned long long)(unsigned)__builtin_amdgcn_readfirstlane((int)v.y) << 32) | (unsigned)__builtin_amdgcn_readfirstlane((int)v.x)); }
    { const u32x2 v = tb[37]; A.out = (float*)(((unsigned long long)(unsigned)__builtin_amdgcn_readfirstlane((int)v.y) << 32) | (unsigned)__builtin_amdgcn_readfirstlane((int)v.x)); }
    { const u32x2 v = tb[38]; A.ws = (unsigned char*)(((unsigned long long)(unsigned)__builtin_amdgcn_readfirstlane((int)v.y) << 32) | (unsigned)__builtin_amdgcn_readfirstlane((int)v.x)); }
    A.lo = 0; A.hi = 0;
}
__device__ __forceinline__ int row_mi(int row) { return row < NLAT ? (row >> 13) : 4; }

__device__ __forceinline__ void phase_init(const Ctx& C, const Args& A) {
    unsigned char* ws = A.ws;
    float* MOD = (float*)(ws + WS_MOD);
    LAS float* sv = (LAS float*)C.lds;
    LAS float* red = sv + 5 * 1024;
    for (int i = C.tid; i < 5 * 1024; i += NTHR) { const int v = i >> 10, k = i & 1023; const float c = (v < 4) ? A.in[I_C][v * DM + k] : A.in[I_CCTX][k]; sv[i] = c / (1.f + __expf(-c)); }
    __syncthreads();
    const int j = C.tid & 127, kp = C.tid >> 7;
    for (int it = blockIdx.x; it < DEPTH * 48; it += C.G) {
        const int l = it / 48, cg = it % 48, col = cg * 128 + j;
        const float* W = A.in[I_WMOD] + (size_t)l * DM * 6144 + col;
        float a0 = 0.f, a1 = 0.f, a2 = 0.f, a3 = 0.f, a4 = 0.f;
#pragma unroll 4
        for (int k = kp * 256; k < kp * 256 + 256; ++k) { const float w = W[(size_t)k * 6144]; a0 += sv[k] * w; a1 += sv[1024 + k] * w; a2 += sv[2048 + k] * w; a3 += sv[3072 + k] * w; a4 += sv[4096 + k] * w; }
        red[(kp * 5 + 0) * 128 + j] = a0; red[(kp * 5 + 1) * 128 + j] = a1; red[(kp * 5 + 2) * 128 + j] = a2; red[(kp * 5 + 3) * 128 + j] = a3; red[(kp * 5 + 4) * 128 + j] = a4;
        __syncthreads();
        for (int o = C.tid; o < 5 * 128; o += NTHR) { const int v = o >> 7, jj = o & 127; const int cc = cg * 128 + jj;
            const float s = red[(0 * 5 + v) * 128 + jj] + red[(1 * 5 + v) * 128 + jj] + red[(2 * 5 + v) * 128 + jj] + red[(3 * 5 + v) * 128 + jj];
            MOD[((size_t)l * 5 + v) * 6144 + cc] = s + A.in[I_BMOD][l * 6144 + cc]; }
        __syncthreads();
    }
    if (blockIdx.x == C.G - 1) { float* rope = (float*)(ws + WS_ROPE);
        for (int i = C.tid; i < 192 * 16; i += NTHR) { const int pos = i >> 4, j = i & 15; const float ang = (float)(pos < 128 ? pos : pos - 128) * powf(10000.f, -(float)j * (1.f / 16.f));
            rope[i] = cosf(ang); rope[192 * 16 + i] = sinf(ang); } }
    f32x4* X4 = (f32x4*)(ws + WS_X);
    const f32x4* x4 = (const f32x4*)A.in[I_X]; const f32x4* c4 = (const f32x4*)A.in[I_CTX];
    const size_t nl = (size_t)NLAT * DM / 4, nc = (size_t)NCTX * DM / 4;
    for (size_t i = (size_t)blockIdx.x * NTHR + C.tid; i < nl + nc; i += (size_t)C.G * NTHR) X4[i] = (i < nl) ? x4[i] : c4[i - nl];
}

__device__ __forceinline__ void transpose_item(const float* W, int ldw, int k0, int n0, bf16_t* WT, int ldt, int drow0, LAS float* scr, int lane) {
    { float v[64]; const float* src = W + (size_t)k0 * ldw + n0 + lane;
#pragma unroll
      for (int k = 0; k < 64; ++k) v[k] = __builtin_nontemporal_load(src + (size_t)k * ldw);
#pragma unroll
      for (int k = 0; k < 64; ++k) scr[k * 65 + lane] = v[k]; }
    asm volatile("s_waitcnt lgkmcnt(0)" ::: "memory");
    const int c = lane & 7;
#pragma unroll
    for (int j = 0; j < 8; ++j) { const int n = (lane >> 3) + 8 * j; const LAS float* s = scr + (8 * c) * 65 + n;
        u32x4 o; o.x = pk2(s[0 * 65], s[1 * 65]); o.y = pk2(s[2 * 65], s[3 * 65]); o.z = pk2(s[4 * 65], s[5 * 65]); o.w = pk2(s[6 * 65], s[7 * 65]);
        *(u32x4*)(WT + (size_t)(drow0 + n) * ldt + k0 + 8 * c) = o; }
    asm volatile("s_waitcnt lgkmcnt(0)" ::: "memory");
}
__device__ __forceinline__ void conv_items(const Ctx& C, const Args& A, int l, int gw, int NGW, bool do_in, bool do_out, bool do_exp) {
    unsigned char* ws = A.ws;
    const int i2 = l >> 1; const bool odd = (l & 1);
    LAS float* scr = (LAS float*)C.lds + C.wave * (64 * 65);
    bf16_t* WIN = (bf16_t*)(ws + WS_WIN); bf16_t* WOUT = (bf16_t*)(ws + WS_WOUT); bf16_t* WE13 = (bf16_t*)(ws + WS_WE13 + (size_t)(l & 1) * WE13_BYTES); bf16_t* WE2 = (bf16_t*)(ws + WS_WE2 + (size_t)(l & 1) * WE2_BYTES);
    const int nin = odd ? D_IN_ODD : D_IN_EVEN;
    const float* win = odd ? A.in[I_OWIN] + (size_t)i2 * DM * D_IN_ODD : A.in[I_EWIN] + (size_t)i2 * DM * D_IN_EVEN;
    const float* wout = odd ? A.in[I_OWOUT] + (size_t)i2 * DM * DM : A.in[I_EWOUT] + (size_t)i2 * DM * DM;
    const int n_in = do_in ? 16 * (nin / 64) : 0, n_out = do_out ? 16 * 16 : 0, n_e13 = do_exp ? NEXP * 2 * 16 * 32 : 0, n_e2 = do_exp ? NEXP * 32 * 16 : 0;
    const int total = n_in + n_out + n_e13 + n_e2;
    for (int it = gw; it < total; it += NGW) {
        int r = it;
        if (r < n_in) { const int nb = nin / 64, kb = r / nb, nn = r % nb; transpose_item(win, nin, kb * 64, nn * 64, WIN, DM, nn * 64, scr, C.lane); continue; } r -= n_in;
        if (r < n_out) { const int kb = r / 16, nn = r % 16; transpose_item(wout, DM, kb * 64, nn * 64, WOUT, DM, nn * 64, scr, C.lane); continue; } r -= n_out;
        if (r < n_e13) { const int e = r / 1024, q = r % 1024, mat = q / 512, q2 = q % 512, kb = q2 / 32, nn = q2 % 32;
            const float* W = (mat ? A.in[I_WE3] : A.in[I_WE1]) + ((size_t)l * NEXP + e) * DM * D_EXP;
            const int f0 = nn * 64; const int drow = (f0 >> 7) * 256 + mat * 128 + (f0 & 127);
            transpose_item(W, D_EXP, kb * 64, f0, WE13 + (size_t)e * 4096 * DM, DM, drow, scr, C.lane); continue; } r -= n_e13;
        { const int e = r / 512, q = r % 512, kb = q / 16, nn = q % 16;
            const float* W = A.in[I_WE2] + ((size_t)l * NEXP + e) * D_EXP * DM;
            transpose_item(W, DM, kb * 64, nn * 64, WE2 + (size_t)e * DM * D_EXP, D_EXP, nn * 64, scr, C.lane); }
    }
}
__device__ __forceinline__ void phase_conv(const Ctx& C, const Args& A, int l) {
    unsigned char* ws = A.ws;
    const int i2 = l >> 1; const bool odd = (l & 1);
    bf16_t* WIN = (bf16_t*)(ws + WS_WIN);
    const bool early = CHUNKED_SCAN && odd;
    conv_items(C, A, l, C.gw, C.NGW, !early, true, !early);
    if (!odd) {
        u32x4* z = (u32x4*)(WIN + (size_t)D_IN_EVEN * DM);
        unsigned zz = 0u; asm volatile("" : "+v"(zz));
        for (int i = blockIdx.x * NTHR + C.tid; i < (D_IN_EVEN_PAD - D_IN_EVEN) * DM / 8; i += C.G * NTHR) z[i] = (u32x4){zz, zz, zz, zz};
        bf16_t* WL = (bf16_t*)(ws + WS_WLORA);
        const float* dup = A.in[I_DUP] + (size_t)i2 * 2 * 64 * 768; const float* aup = A.in[I_AUP] + (size_t)i2 * 2 * 64 * 768; const float* gup = A.in[I_GUP] + (size_t)i2 * 128 * 768;
        for (int i = blockIdx.x * NTHR + C.tid; i < LORA_N * LORA_K; i += C.G * NTHR) {
            const int kk = i / LORA_N, n = i % LORA_N, seg = n / 768, col = n % 768; float v = 0.f;
            if (seg == 0) { if (kk < 64) v = dup[(size_t)(0 * 64 + kk) * 768 + col]; }
            else if (seg == 1) { if (kk >= 64 && kk < 128) v = dup[(size_t)(1 * 64 + kk - 64) * 768 + col]; }
            else if (seg == 2) { if (kk >= 128 && kk < 192) v = aup[(size_t)(0 * 64 + kk - 128) * 768 + col]; }
            else if (seg == 3) { if (kk >= 192 && kk < 256) v = aup[(size_t)(1 * 64 + kk - 192) * 768 + col]; }
            else { if (kk >= 256) v = gup[(size_t)(kk - 256) * 768 + col]; }
            WL[(size_t)n * LORA_K + kk] = (bf16_t)f2bf(v);
        }
    }
}

__device__ __forceinline__ void phase_modh(const Ctx& C, const Args& A, int l) {
    const float* X = (const float*)(A.ws + WS_X); bf16_t* H = (bf16_t*)(A.ws + WS_H); const float* MOD = (const float*)(A.ws + WS_MOD) + (size_t)l * 5 * 6144;
    for (int row = C.gw; row < MROWS; row += C.NGW) {
        const float* md = MOD + row_mi(row) * 6144;
#pragma unroll
        for (int j = 0; j < 4; ++j) { const int col = 4 * C.lane + 256 * j; const f32x4 x = *(const f32x4*)(X + (size_t)row * DM + col), sh = *(const f32x4*)(md + col), sc = *(const f32x4*)(md + DM + col);
            const f32x4 h = x * (sc + 1.f) + sh; u32x2 o; o.x = pk2(h[0], h[1]); o.y = pk2(h[2], h[3]); *(u32x2*)(H + (size_t)row * DM + col) = o; }
    }
}

__device__ __forceinline__ f32x4 ld4bf(const bf16_t* p) { const u32x2 u = *(const u32x2*)p; return (f32x4){bflo(u.x), bfhi(u.x), bflo(u.y), bfhi(u.y)}; }
__device__ __forceinline__ void st4bf(bf16_t* p, f32x4 v) { u32x2 o; o.x = pk2(v[0], v[1]); o.y = pk2(v[2], v[3]); *(u32x2*)p = o; }
__device__ __forceinline__ void seq_info(int row, bool& hasp, bool& hasn) {
    if (row < NLAT) { const int t = row & (TT - 1); hasp = t > 0; hasn = t < TT - 1; }
    else { const int t = (row - NLAT) & (CTXL - 1); hasp = t > 0; hasn = t < CTXL - 1; }
}
__device__ __forceinline__ void phase_ef1(const Ctx& C, const Args& A, int l) {
    const int i2 = l >> 1; unsigned char* ws = A.ws;
    const bf16_t* P = (const bf16_t*)(ws + WS_P); bf16_t* A2 = (bf16_t*)(ws + WS_A2); unsigned char* SCN = ws + WS_SCN; bf16_t* LIN = (bf16_t*)(ws + WS_LIN);
    const float* cw = A.in[I_CONVW] + (size_t)i2 * 3 * 256; const float* mu = A.in[I_MU] + (size_t)i2 * RWKV_COLS; const float* kxi = A.in[I_KXI] + (size_t)i2 * 768;
    const f32x4 z4 = {0.f, 0.f, 0.f, 0.f};
    for (int row = C.gw; row < MROWS; row += C.NGW) {
        bool hasp, hasn; seq_info(row, hasp, hasn);
        const bf16_t* p0 = P + (size_t)row * P_LD; const bf16_t* pm = p0 - P_LD; const bf16_t* pp = p0 + P_LD;
        {
            const int j4 = 4 * C.lane;
            const f32x4 bg = ld4bf(p0 + j4), u0 = ld4bf(p0 + 256 + j4) * ld4bf(p0 + 512 + j4);
            const f32x4 um = hasp ? ld4bf(pm + 256 + j4) * ld4bf(pm + 512 + j4) : z4, up = hasn ? ld4bf(pp + 256 + j4) * ld4bf(pp + 512 + j4) : z4;
            const f32x4 w0 = *(const f32x4*)(cw + j4), w1 = *(const f32x4*)(cw + 256 + j4), w2 = *(const f32x4*)(cw + 512 + j4);
            st4bf(A2 + (size_t)row * DM + j4, bg * (w0 * um + w1 * u0 + w2 * up));
        }
#pragma unroll
        for (int it = 0; it < 11; ++it) {
            const int c = it * 256 + 4 * C.lane;
            if (c < RWKV_COLS) {
                const f32x4 x0 = ld4bf(p0 + 768 + c), xm = hasp ? ld4bf(pm + 768 + c) : z4, xp = hasn ? ld4bf(pp + 768 + c) : z4, m4 = *(const f32x4*)(mu + c);
                const f32x4 ps = x0 + m4 * ((xm + xp) * 0.5f - x0);
                if (it < 3) { const int head = c >> 6, kx = c & 63; st4bf_(SCN + (size_t)(row * 12 + head) * SC_REC + SC_R + kx * 2, ps); }
                else if (it < 6) { const int c1 = c - 768, head = c1 >> 6, kx = c1 & 63; const f32x4 kv = ps * *(const f32x4*)(kxi + c1);
                    const float ss = sum16(kv[0] * kv[0] + kv[1] * kv[1] + kv[2] * kv[2] + kv[3] * kv[3]); const float rn = rsqrtf(ss + 1e-12f);
                    unsigned char* base = SCN + (size_t)(row * 12 + head) * SC_REC + kx * 2;
                    st4bf_(base + SC_KK, kv * rn); st4bf_(base + SC_KR, ps); st4bf_(base + SC_KR + 256, ps); }
                else if (it < 9) { const int c1 = c - 1536, head = c1 >> 6, kx = c1 & 63; st4bf_(SCN + (size_t)(row * 12 + head) * SC_REC + SC_V + kx * 2, ps); }
                else { const int c1 = c - 2304; f32x4 o;
                    if (c1 < 128) { o = (f32x4){tanhf(ps[0]), tanhf(ps[1]), tanhf(ps[2]), tanhf(ps[3])}; }
                    else if (c1 < 256) { o = ps; }
                    else { o = (f32x4){sigmoidf_(ps[0]), sigmoidf_(ps[1]), sigmoidf_(ps[2]), sigmoidf_(ps[3])}; }
                    st4bf(LIN + (size_t)row * LORA_K + c1, o); }
            }
        }
    }
}

__device__ __forceinline__ int scan_row(int i, int b, int d) {
    if (d == 0) return i < CTXL ? NLAT + b * CTXL + i : b * TT + (i - CTXL);
    return i < CTXL ? NLAT + b * CTXL + (CTXL - 1 - i) : b * TT + (TT - 1 - (i - CTXL));
}
__device__ __forceinline__ float red8(float v) {
    v += __uint_as_float((unsigned)__builtin_amdgcn_update_dpp(0, (int)__float_as_uint(v), 0xB1, 0xF, 0xF, true));
    v += __uint_as_float((unsigned)__builtin_amdgcn_update_dpp(0, (int)__float_as_uint(v), 0x4E, 0xF, 0xF, true));
    v += __uint_as_float((unsigned)__builtin_amdgcn_update_dpp(0, (int)__float_as_uint(v), 0x141, 0xF, 0xF, true));
    return v;
}
__device__ __forceinline__ float red16(float v) {
    v += __uint_as_float((unsigned)__builtin_amdgcn_update_dpp(0, (int)__float_as_uint(v), 0xB1, 0xF, 0xF, true));
    v += __uint_as_float((unsigned)__builtin_amdgcn_update_dpp(0, (int)__float_as_uint(v), 0x4E, 0xF, 0xF, true));
    v += __uint_as_float((unsigned)__builtin_amdgcn_update_dpp(0, (int)__float_as_uint(v), 0x141, 0xF, 0xF, true));
    v += __uint_as_float((unsigned)__builtin_amdgcn_update_dpp(0, (int)__float_as_uint(v), 0x140, 0xF, 0xF, true));
    return v;
}
__device__ __forceinline__ void phase_scan(const Ctx& C, const Args& A) {
    for (int u = blockIdx.x; u < 192; u += C.G) {
    const int half = u & 1, d = (u >> 1) & 1, h = (u >> 2) % 12, b = u / 48;
    const unsigned char* SCN = A.ws + WS_SCN; float* Y = (float*)(A.ws + WS_Y) + (size_t)d * MROWS * 768;
    LAS float* buf = (LAS float*)C.lds; LAS float* ybuf = buf + 2 * 32 * 352;
    constexpr int NCH = LKEYS / 32;
    u32x4 st[4];
    int ps_[4], psrc[4], pdst[4]; bool pf32[4];
#pragma unroll
    for (int j = 0; j < 4; ++j) { const int p = C.tid + NTHR * j; const int s = p / 52, q = p % 52; ps_[j] = s;
        if (q < 16) { psrc[j] = SC_W + 256 * d + q * 16; pdst[j] = s * 352 + q * 4; pf32[j] = true; }
        else if (q < 48) { const int vec = (q - 16) >> 3, part = (q - 16) & 7; const int so = vec == 0 ? SC_KK : vec == 1 ? SC_B + 256 * d : vec == 2 ? SC_KR + 256 * d : SC_R;
            psrc[j] = so + part * 16; pdst[j] = s * 352 + 64 * (vec + 1) + part * 8; pf32[j] = false; }
        else { const int part = q - 48; psrc[j] = SC_V + half * 64 + part * 16; pdst[j] = s * 352 + 320 + part * 8; pf32[j] = false; } }
    const int sgn = d ? -1 : 1;
    const unsigned char* SCNh = SCN + (size_t)h * SC_REC;
#define SCAN_ROW0(c) (((c) * 32 < CTXL) ? (NLAT + b * CTXL + (d ? CTXL - 1 - (c) * 32 : (c) * 32)) : (b * TT + (d ? TT - 1 - ((c) * 32 - CTXL) : (c) * 32 - CTXL)))
#define SCAN_LOADG(c) do { const int row0_ = SCAN_ROW0(c); _Pragma("unroll") for (int j = 0; j < 4; ++j) if (j < 3 || C.tid < 1664 - 3 * NTHR) { \
        st[j] = *(const u32x4*)(SCNh + (size_t)(row0_ + sgn * ps_[j]) * SC_ROW + psrc[j]); } } while (0)
#define SCAN_STORE(bi) do { _Pragma("unroll") for (int j = 0; j < 4; ++j) if (j < 3 || C.tid < 1664 - 3 * NTHR) { LAS float* dp = buf + (bi) * (32 * 352) + pdst[j]; \
        if (pf32[j]) *(LAS u32x4*)dp = st[j]; \
        else { *(LAS f32x4*)dp = (f32x4){bflo(st[j].x), bfhi(st[j].x), bflo(st[j].y), bfhi(st[j].y)}; *(LAS f32x4*)(dp + 4) = (f32x4){bflo(st[j].z), bfhi(st[j].z), bflo(st[j].w), bfhi(st[j].w)}; } } } while (0)
    SCAN_LOADG(0); SCAN_STORE(0); __syncthreads();
    f32x2 Sa = {0.f, 0.f}, Sb = {0.f, 0.f};
    const int rl = C.lane >> 4, ks = C.lane & 15;
    float ycol = 0.f;
#define SC_LD(R, s) do { const LAS float* bp_ = cur + (s) * 352 + ks * 4; \
        R##w = *(const LAS f32x4*)(bp_); R##k = *(const LAS f32x4*)(bp_ + 64); R##b = *(const LAS f32x4*)(bp_ + 128); R##q = *(const LAS f32x4*)(bp_ + 192); R##r = *(const LAS f32x4*)(bp_ + 256); \
        R##vv = cur[(s) * 352 + 320 + C.wave * 4 + rl]; } while (0)
#define SC_LO(v) ((f32x2){v[0], v[1]})
#define SC_HI(v) ((f32x2){v[2], v[3]})
#define SC_DPP(x, ctrl) __uint_as_float((unsigned)__builtin_amdgcn_update_dpp(0, (int)__float_as_uint(x), ctrl, 0xF, 0xF, true))
#define SC_STEP(R, P, s) do { \
        f32x2 pa = __builtin_elementwise_fma(Sb, SC_HI(R##k), Sa * SC_LO(R##k)), py = __builtin_elementwise_fma(Sb, SC_HI(P##r), Sa * SC_LO(P##r)); \
        float a_ = pa.x + pa.y, y_ = py.x + py.y; \
        a_ += SC_DPP(a_, 0xB1); y_ += SC_DPP(y_, 0xB1); a_ += SC_DPP(a_, 0x4E); y_ += SC_DPP(y_, 0x4E); \
        a_ += SC_DPP(a_, 0x141); y_ += SC_DPP(y_, 0x141); a_ += SC_DPP(a_, 0x140); y_ += SC_DPP(y_, 0x140); \
        ycol = (ks == ((s) & 15)) ? y_ : ycol; \
        const f32x2 na = {-a_, -a_}, vv2 = {R##vv, R##vv}; \
        Sa = __builtin_elementwise_fma(Sa, SC_LO(R##w), __builtin_elementwise_fma(na, SC_LO(R##b), vv2 * SC_LO(R##q))); \
        Sb = __builtin_elementwise_fma(Sb, SC_HI(R##w), __builtin_elementwise_fma(na, SC_HI(R##b), vv2 * SC_HI(R##q))); } while (0)
    f32x4 Aw, Ak, Ab, Aq, Ar, Bw, Bk, Bb, Bq, Br, Cw, Ck, Cb, Cq, Cr, Dw, Dk, Db, Dq, Dr; float Avv, Bvv, Cvv, Dvv;
    Dr = (f32x4){0.f, 0.f, 0.f, 0.f};
    for (int c = 0; c < NCH; ++c) {
        if (c + 1 < NCH) SCAN_LOADG(c + 1);
        {
            const LAS float* cur = buf + (c & 1) * (32 * 352);
            LAS float* yb = ybuf + (c & 1) * 1024 + C.wave * 4 + rl + ks * 32;
            SC_LD(A, 0); SC_LD(B, 1);
#pragma unroll 1
            for (int s = 0; s < 32; s += 4) {
                SC_LD(C, s + 2); __builtin_amdgcn_sched_barrier(0); SC_STEP(A, D, s); __builtin_amdgcn_sched_barrier(0);
                SC_LD(D, s + 3); __builtin_amdgcn_sched_barrier(0); SC_STEP(B, A, s + 1); __builtin_amdgcn_sched_barrier(0);
                SC_LD(A, s + 4); __builtin_amdgcn_sched_barrier(0); SC_STEP(C, B, s + 2); __builtin_amdgcn_sched_barrier(0);
                SC_LD(B, s + 5); __builtin_amdgcn_sched_barrier(0); SC_STEP(D, C, s + 3); __builtin_amdgcn_sched_barrier(0);
                if ((s & 15) == 12) yb[(s & 16) * 32] = ycol;
            }
        }
        if (c + 1 < NCH) SCAN_STORE((c + 1) & 1);
        __syncthreads();
        { const int row0_ = SCAN_ROW0(c);
#pragma unroll
          for (int i = 0; i < 2; ++i) { const int e = C.tid + NTHR * i, s = e >> 5, r = e & 31;
            const int row = (s > 0) ? row0_ + sgn * (s - 1) : scan_row(c * 32 - 1, b, d);
            if (s > 0 || c > 0) Y[(size_t)row * 768 + h * 64 + half * 32 + r] = ybuf[(c & 1) * 1024 + e]; } }
    }
    {
        f32x2 py = __builtin_elementwise_fma(Sb, SC_HI(Dr), Sa * SC_LO(Dr)); float y_ = py.x + py.y;
        y_ += SC_DPP(y_, 0xB1); y_ += SC_DPP(y_, 0x4E); y_ += SC_DPP(y_, 0x141); y_ += SC_DPP(y_, 0x140);
        if (ks == 0) Y[(size_t)scan_row(LKEYS - 1, b, d) * 768 + h * 64 + half * 32 + C.wave * 4 + rl] = y_;
    }
    __syncthreads();
    }
#undef SCAN_LOADG
#undef SCAN_STORE
#undef SCAN_ROW0
#undef SC_LD
#undef SC_STEP
#undef SC_LO
#undef SC_HI
#undef SC_DPP
}

constexpr int CSP = 72;
constexpr int CS_MAT = 64 * CSP * 2;
constexpr int CS_WT = 0, CS_KB = CS_MAT, CS_BB = 2 * CS_MAT, CS_RT = 3 * CS_MAT, CS_BHT = 4 * CS_MAT, CS_KHT = 5 * CS_MAT, CS_VMT = 6 * CS_MAT;
constexpr int CS_M2F = 7 * CS_MAT;
constexpr int CS_M1T = CS_M2F + 16384;
constexpr int CS_N2 = CS_M1T + CS_MAT;
constexpr int CS_GT = CS_N2 + CS_MAT;
constexpr int CS_Z = CS_M2F, CS_U = CS_M2F + CS_MAT;
constexpr int CS_GL = CS_GT + 2 * CS_MAT;
static_assert(CS_GL + 256 <= LDS_MISC, "chunked-scan LDS map");
template <bool SWZB = false>
__device__ __forceinline__ void cs_mma(f32x16& acc, const LAS unsigned char* Am, const LAS unsigned char* Bm, int ti, int tj, int r32, int hi) {
    const LAS unsigned char* ap = Am + (ti * 32 + r32) * (CSP * 2) + hi * 16; const int brow = tj * 32 + r32; const LAS unsigned char* bp = Bm + brow * (CSP * 2);
    const int sw = SWZB ? ((brow >> 3) & 7) : 0;
#pragma unroll
    for (int ks = 0; ks < 4; ++ks) acc = __builtin_amdgcn_mfma_f32_32x32x16_bf16(*(const LAS bf16x8*)(ap + ks * 32), *(const LAS bf16x8*)(bp + (((ks * 2 + hi) ^ sw) * 16)), acc, 0, 0, 0);
}
__device__ __forceinline__ void cs_store_t(LAS unsigned char* Om, const f32x16& acc, int ti, int tj, int r32, int hi) {
    LAS unsigned char* op = Om + (tj * 32 + r32) * (CSP * 2) + (ti * 32 + 4 * hi) * 2;
#pragma unroll
    for (int g = 0; g < 4; ++g) { u32x2 o; o.x = pk2(acc[4 * g], acc[4 * g + 1]); o.y = pk2(acc[4 * g + 2], acc[4 * g + 3]); *(LAS u32x2*)(op + g * 16) = o; }
}
#define CS_BAR() asm volatile("s_waitcnt lgkmcnt(0)\n\ts_barrier" ::: "memory")
__device__ __forceinline__ void phase_csa(const Ctx& C, const Args& A) {
    const unsigned char* SCN = A.ws + WS_SCN; unsigned char* CHK = A.ws + WS_CHK;
    LAS unsigned char* L = C.lds;
    const int r32 = C.lane & 31, hi = C.lane >> 5;
    float lwv[8]; u32x4 ukk, ub, ukr, ur, uv;
#define CSA_GEOM(cu_) const int unit = (cu_) / CS_NCH, ch = (cu_) % CS_NCH; const int d = unit & 1, h = (unit >> 1) % 12, b = unit / 24; \
        const int step0 = ch * CS_L; const int sgn = d ? -1 : 1; \
        const int row0 = (step0 < CTXL) ? (NLAT + b * CTXL + (d ? CTXL - 1 - step0 : step0)) : (b * TT + (d ? TT - 1 - (step0 - CTXL) : step0 - CTXL)); \
        const unsigned char* rec0 = SCN + (size_t)row0 * SC_ROW + (size_t)h * SC_REC;
#define CSA_LOAD(cu_) do { CSA_GEOM(cu_); \
        { const int k = C.tid & 63, sg = C.tid >> 6; _Pragma("unroll") for (int j = 0; j < 8; ++j) lwv[j] = *(const float*)(rec0 + (long)sgn * (8 * sg + j) * SC_ROW + SC_W + 256 * d + k * 4); } \
        { const int t = C.tid >> 3, k0 = (C.tid & 7) * 8; const unsigned char* rp = rec0 + (long)sgn * t * SC_ROW; \
          ukk = *(const u32x4*)(rp + SC_KK + k0 * 2); ub = *(const u32x4*)(rp + SC_B + 256 * d + k0 * 2); ukr = *(const u32x4*)(rp + SC_KR + 256 * d + k0 * 2); ur = *(const u32x4*)(rp + SC_R + k0 * 2); uv = *(const u32x4*)(rp + SC_V + k0 * 2); } } while (0)
    if ((int)blockIdx.x < CS_UNITS * CS_NCH) CSA_LOAD((int)blockIdx.x);
    for (int cu = blockIdx.x; cu < CS_UNITS * CS_NCH; cu += C.G) {
        LAS float* csf = (LAS float*)(L + CS_M2F);
        LAS float* seg = (LAS float*)(L + CS_N2);
        { const int k = C.tid & 63, sg = C.tid >> 6;
#pragma unroll
          for (int j = 1; j < 8; ++j) lwv[j] += lwv[j - 1];
          seg[sg * 64 + k] = lwv[7];
          CS_BAR();
          float off = 0.f, tot = 0.f;
#pragma unroll
          for (int s2 = 0; s2 < 8; ++s2) { const float v = seg[s2 * 64 + k]; off += (s2 < sg) ? v : 0.f; tot += v; }
#pragma unroll
          for (int j = 0; j < 8; ++j) csf[(8 * sg + j) * 65 + k] = lwv[j] + off;
          if (sg == 7) ((LAS float*)(L + CS_GL))[k] = __expf(tot); }
        CS_BAR();
        { const int t = C.tid >> 3, k0 = (C.tid & 7) * 8;
          float wt[8], kb[8], bb[8], rt[8], bh[8], kh[8];
#pragma unroll
          for (int j = 0; j < 8; ++j) { const unsigned pkk = j < 2 ? ukk.x : j < 4 ? ukk.y : j < 6 ? ukk.z : ukk.w, pb = j < 2 ? ub.x : j < 4 ? ub.y : j < 6 ? ub.z : ub.w, pkr = j < 2 ? ukr.x : j < 4 ? ukr.y : j < 6 ? ukr.z : ukr.w, pr = j < 2 ? ur.x : j < 4 ? ur.y : j < 6 ? ur.z : ur.w;
              const float kkv = (j & 1) ? bfhi(pkk) : bflo(pkk), bv = (j & 1) ? bfhi(pb) : bflo(pb), krv = (j & 1) ? bfhi(pkr) : bflo(pkr), rv = (j & 1) ? bfhi(pr) : bflo(pr);
              const float cst = csf[t * 65 + k0 + j], csp = t > 0 ? csf[(t - 1) * 65 + k0 + j] : 0.f, csl = csf[63 * 65 + k0 + j];
              const float einv = __expf(-cst), el = __expf(csl - cst);
              wt[j] = kkv * __expf(csp); kb[j] = krv * einv; bb[j] = bv * einv; rt[j] = rv * __expf(cst); bh[j] = bv * el; kh[j] = krv * el; }
          u32x4 o;
          o.x = pk2(wt[0], wt[1]); o.y = pk2(wt[2], wt[3]); o.z = pk2(wt[4], wt[5]); o.w = pk2(wt[6], wt[7]); *(LAS u32x4*)(L + CS_WT + t * (CSP * 2) + k0 * 2) = o;
          o.x = pk2(kb[0], kb[1]); o.y = pk2(kb[2], kb[3]); o.z = pk2(kb[4], kb[5]); o.w = pk2(kb[6], kb[7]); *(LAS u32x4*)(L + CS_KB + t * (CSP * 2) + k0 * 2) = o;
          o.x = pk2(bb[0], bb[1]); o.y = pk2(bb[2], bb[3]); o.z = pk2(bb[4], bb[5]); o.w = pk2(bb[6], bb[7]); *(LAS u32x4*)(L + CS_BB + t * (CSP * 2) + k0 * 2) = o;
          o.x = pk2(rt[0], rt[1]); o.y = pk2(rt[2], rt[3]); o.z = pk2(rt[4], rt[5]); o.w = pk2(rt[6], rt[7]); *(LAS u32x4*)(L + CS_RT + t * (CSP * 2) + k0 * 2) = o;
#pragma unroll
          for (int j = 0; j < 8; ++j) { const int to = ((((t >> 3) ^ ((k0 >> 3) & 7)) * 8) + (t & 7)) * 2;
              *(LAS bf16_t*)(L + CS_BHT + (k0 + j) * (CSP * 2) + to) = (bf16_t)f2bf(bh[j]); *(LAS bf16_t*)(L + CS_KHT + (k0 + j) * (CSP * 2) + to) = (bf16_t)f2bf(kh[j]);
              const unsigned pv = j < 2 ? uv.x : j < 4 ? uv.y : j < 6 ? uv.z : uv.w; *(LAS bf16_t*)(L + CS_VMT + (k0 + j) * (CSP * 2) + to) = (bf16_t)((j & 1) ? (pv >> 16) : (pv & 0xffffu)); } }
        if (cu + C.G < CS_UNITS * CS_NCH) CSA_LOAD(cu + C.G);
        CS_BAR();
        for (int job = C.wave; job < 12; job += NWAVES) { const int p = job >> 2, ti = (job >> 1) & 1, tj = job & 1;
            f32x16 acc;
#pragma unroll
            for (int i = 0; i < 16; ++i) acc[i] = 0.f;
            if (p == 0) { cs_mma(acc, L + CS_WT, L + CS_BB, ti, tj, r32, hi);
                const int i = tj * 32 + r32; LAS float* mp = (LAS float*)(L + CS_M2F) + i * 64;
#pragma unroll
                for (int reg = 0; reg < 16; ++reg) { const int t = ti * 32 + crow(reg, hi); mp[(t & 3) * 16 + (t >> 2)] = (i < t) ? acc[reg] : 0.f; } }
            else if (p == 1) { cs_mma(acc, L + CS_WT, L + CS_KB, ti, tj, r32, hi);
                const int i = tj * 32 + r32;
#pragma unroll
                for (int reg = 0; reg < 16; ++reg) { const int t = ti * 32 + crow(reg, hi); acc[reg] = (i < t) ? acc[reg] : 0.f; }
                cs_store_t(L + CS_M1T, acc, ti, tj, r32, hi); }
            else { cs_mma(acc, L + CS_BB, L + CS_RT, ti, tj, r32, hi);
                const int t = tj * 32 + r32;
#pragma unroll
                for (int reg = 0; reg < 16; ++reg) { const int i = ti * 32 + crow(reg, hi); acc[reg] = (i <= t) ? acc[reg] : 0.f; }
                cs_store_t(L + CS_N2, acc, ti, tj, r32, hi); } }
        CS_BAR();
        { const int c = C.tid >> 2, q = C.tid & 3; float acc[16];
          { const LAS unsigned char* rcol = (c < 64) ? (L + CS_WT + c * 2) : (L + CS_M1T + (c - 64) * (CSP * 2)); const int rstride = (c < 64) ? CSP * 2 : 2;
#pragma unroll
            for (int j = 0; j < 16; ++j) acc[j] = bf2f(*(const LAS bf16_t*)(rcol + (4 * j + q) * rstride)); }
          const LAS float* m2c = (const LAS float*)(L + CS_M2F) + q * 16;
#pragma clang loop unroll(full)
          for (int i = 0; i < 64; ++i) {
              const float mine = -acc[i >> 2];
              float gi;
              switch (i & 3) { case 0: gi = __uint_as_float((unsigned)__builtin_amdgcn_update_dpp(0, (int)__float_as_uint(mine), 0x00, 0xF, 0xF, true)); break;
                               case 1: gi = __uint_as_float((unsigned)__builtin_amdgcn_update_dpp(0, (int)__float_as_uint(mine), 0x55, 0xF, 0xF, true)); break;
                               case 2: gi = __uint_as_float((unsigned)__builtin_amdgcn_update_dpp(0, (int)__float_as_uint(mine), 0xAA, 0xF, 0xF, true)); break;
                               default: gi = __uint_as_float((unsigned)__builtin_amdgcn_update_dpp(0, (int)__float_as_uint(mine), 0xFF, 0xF, 0xF, true)); break; }
#pragma unroll
              for (int j4 = (i >> 4); j4 < 4; ++j4) { const f32x4 m = *(const LAS f32x4*)(m2c + i * 64 + j4 * 4);
#pragma unroll
                  for (int e = 0; e < 4; ++e) if (4 * j4 + e >= (i >> 2)) acc[4 * j4 + e] += m[e] * gi; }
          }
#pragma unroll
          for (int j = 0; j < 16; ++j) *(LAS bf16_t*)(L + CS_GT + c * (CSP * 2) + (4 * j + q) * 2) = (bf16_t)f2bf(-acc[j]); }
        CS_BAR();
        unsigned char* outp = CHK + (size_t)cu * 32768;
        for (int job = C.wave; job < 16; job += NWAVES) { const int p = job >> 2, ti = (job >> 1) & 1, tj = job & 1;
            f32x16 acc;
            if (p == 0) {
                const LAS unsigned char* rp = L + CS_RT + (tj * 32 + r32) * (CSP * 2) + (ti * 32 + 4 * hi) * 2;
#pragma unroll
                for (int g = 0; g < 4; ++g) { const u32x2 u = *(const LAS u32x2*)(rp + g * 16); acc[4 * g] = bflo(u.x); acc[4 * g + 1] = bfhi(u.x); acc[4 * g + 2] = bflo(u.y); acc[4 * g + 3] = bfhi(u.y); }
                cs_mma(acc, L + CS_GT, L + CS_N2, ti, tj, r32, hi);
#pragma unroll
                for (int g = 0; g < 4; ++g) { u32x2 o; o.x = pk2(acc[4 * g], acc[4 * g + 1]); o.y = pk2(acc[4 * g + 2], acc[4 * g + 3]);
                    *(u32x2*)(outp + 8192 + (((tj * 4 + 2 * ti + (g >> 1)) * 64 + (g & 1) * 32 + r32) * 16) + hi * 8) = o; } }
            else if (p == 1) {
#pragma unroll
                for (int i = 0; i < 16; ++i) acc[i] = 0.f;
                cs_mma(acc, L + CS_KB, L + CS_RT, ti, tj, r32, hi);
                const int t = tj * 32 + r32;
#pragma unroll
                for (int reg = 0; reg < 16; ++reg) { const int i = ti * 32 + crow(reg, hi); acc[reg] = (i <= t) ? acc[reg] : 0.f; }
                cs_mma(acc, L + CS_GT + 64 * (CSP * 2), L + CS_N2, ti, tj, r32, hi);
                cs_store_t(L + CS_Z, acc, ti, tj, r32, hi); }
            else if (p == 2) {
#pragma unroll
                for (int i = 0; i < 16; ++i) acc[i] = 0.f;
                cs_mma<true>(acc, L + CS_GT, L + CS_BHT, ti, tj, r32, hi);
                const int k = tj * 32 + r32; const float gl = ((const LAS float*)(L + CS_GL))[k];
#pragma unroll
                for (int reg = 0; reg < 16; ++reg) { const int cc = ti * 32 + crow(reg, hi); acc[reg] += (cc == k) ? gl : 0.f; }
#pragma unroll
                for (int g = 0; g < 4; ++g) { u32x2 o; o.x = pk2(acc[4 * g], acc[4 * g + 1]); o.y = pk2(acc[4 * g + 2], acc[4 * g + 3]);
                    *(u32x2*)(outp + (((tj * 4 + 2 * ti + (g >> 1)) * 64 + (g & 1) * 32 + r32) * 16) + hi * 8) = o; } }
            else {
                const int krow = tj * 32 + r32; const LAS unsigned char* kp = L + CS_KHT + krow * (CSP * 2) + hi * 8;
#pragma unroll
                for (int g = 0; g < 4; ++g) { const u32x2 u = *(const LAS u32x2*)(kp + (((ti * 4 + g) ^ ((krow >> 3) & 7)) * 16)); acc[4 * g] = bflo(u.x); acc[4 * g + 1] = bfhi(u.x); acc[4 * g + 2] = bflo(u.y); acc[4 * g + 3] = bfhi(u.y); }
                cs_mma<true>(acc, L + CS_GT + 64 * (CSP * 2), L + CS_BHT, ti, tj, r32, hi);
                cs_store_t(L + CS_U, acc, ti, tj, r32, hi); } }
        CS_BAR();
        { const int p = C.wave >> 2, ti = (C.wave >> 1) & 1, tj = C.wave & 1;
          f32x16 acc;
#pragma unroll
          for (int i = 0; i < 16; ++i) acc[i] = 0.f;
          cs_mma<true>(acc, L + (p ? CS_U : CS_Z), L + CS_VMT, ti, tj, r32, hi);
          unsigned char* op = outp + (p ? 16384 : 24576) + ((ti * 2 + tj) * 64 + C.lane) * 32;
          u32x4 o0, o1; o0.x = pk2(acc[0], acc[1]); o0.y = pk2(acc[2], acc[3]); o0.z = pk2(acc[4], acc[5]); o0.w = pk2(acc[6], acc[7]);
          o1.x = pk2(acc[8], acc[9]); o1.y = pk2(acc[10], acc[11]); o1.z = pk2(acc[12], acc[13]); o1.w = pk2(acc[14], acc[15]);
          *(u32x4*)op = o0; *(u32x4*)(op + 16) = o1; }
        CS_BAR();
    }
}
__device__ __forceinline__ void phase_csb(const Ctx& C, const Args& A, int l) {
    if ((int)blockIdx.x >= CS_UNITS) { conv_items(C, A, l + 1, ((int)blockIdx.x - CS_UNITS) * NWAVES + C.wave, (C.G - CS_UNITS) * NWAVES, true, false, true); return; }
    const unsigned char* CHK = A.ws + WS_CHK;
    LAS unsigned char* L = C.lds;
    const int r32 = C.lane & 31, hi = C.lane >> 5;
    const bool isS = C.wave < 4; const int ti = (C.wave >> 1) & 1, tj = C.wave & 1;
    for (int unit = blockIdx.x; unit < CS_UNITS; unit += C.G) {
        const int d = unit & 1, h = (unit >> 1) % 12, b = unit / 24;
        float* Y = (float*)(A.ws + WS_Y) + (size_t)d * MROWS * 768;
        for (int i = C.tid; i < 2 * CS_MAT / 4; i += NTHR) ((LAS unsigned*)L)[i] = 0u;
        CS_BAR();
        bf16x8 afA[4], afB[4], afC[4]; u32x4 cA0, cA1, cB0, cB1, cC0, cC1;
#define CSB_LOAD(A4, C0, C1, ch_) do { const unsigned char* op_ = CHK + ((size_t)unit * CS_NCH + (ch_)) * 32768; \
            const unsigned char* am_ = op_ + (isS ? 0 : 8192) + (ti * 4 * 64 + C.lane) * 16;     \
            _Pragma("unroll") for (int ks = 0; ks < 4; ++ks) A4[ks] = *(const bf16x8*)(am_ + ks * 1024); \
            const unsigned char* cp_ = op_ + (isS ? 16384 : 24576) + ((ti * 2 + tj) * 64 + C.lane) * 32; C0 = *(const u32x4*)cp_; C1 = *(const u32x4*)(cp_ + 16); } while (0)
#define CSB_STEP(A4, C0, C1, ch_) do { \
            const LAS unsigned char* Sb = L + ((ch_) & 1) * CS_MAT; LAS unsigned char* Sn = L + (((ch_) + 1) & 1) * CS_MAT; \
            f32x16 acc; \
            acc[0] = bflo(C0.x); acc[1] = bfhi(C0.x); acc[2] = bflo(C0.y); acc[3] = bfhi(C0.y); acc[4] = bflo(C0.z); acc[5] = bfhi(C0.z); acc[6] = bflo(C0.w); acc[7] = bfhi(C0.w); \
            acc[8] = bflo(C1.x); acc[9] = bfhi(C1.x); acc[10] = bflo(C1.y); acc[11] = bfhi(C1.y); acc[12] = bflo(C1.z); acc[13] = bfhi(C1.z); acc[14] = bflo(C1.w); acc[15] = bfhi(C1.w); \
            const LAS unsigned char* bp = Sb + (tj * 32 + r32) * (CSP * 2) + hi * 16; \
            _Pragma("unroll") for (int ks = 0; ks < 4; ++ks) acc = __builtin_amdgcn_mfma_f32_32x32x16_bf16(A4[ks], *(const LAS bf16x8*)(bp + ks * 32), acc, 0, 0, 0); \
            if (isS) { cs_store_t(Sn, acc, ti, tj, r32, hi); }     \
            else {     \
                const int step0 = (ch_) * CS_L; const int sgn = d ? -1 : 1; \
                const int row0 = (step0 < CTXL) ? (NLAT + b * CTXL + (d ? CTXL - 1 - step0 : step0)) : (b * TT + (d ? TT - 1 - (step0 - CTXL) : step0 - CTXL)); \
                float* yp = Y + (size_t)(row0 + sgn * (ti * 32 + 4 * hi)) * 768 + h * 64 + tj * 32 + r32; const long ys = (long)sgn * 768; \
                _Pragma("unroll") for (int reg = 0; reg < 16; ++reg) yp[ys * ((reg & 3) + 8 * (reg >> 2))] = acc[reg]; } \
            CS_BAR(); } while (0)
        CSB_LOAD(afA, cA0, cA1, 0); CSB_LOAD(afB, cB0, cB1, 1);
        static_assert(CS_NCH % 3 == 0, "chunk loop is unrolled by three");
        for (int ch = 0; ch < CS_NCH; ch += 3) {
            if (ch == 0) CSB_LOAD(afC, cC0, cC1, 2);
            CSB_STEP(afA, cA0, cA1, ch);     if (ch + 3 < CS_NCH) CSB_LOAD(afA, cA0, cA1, ch + 3);
            CSB_STEP(afB, cB0, cB1, ch + 1); if (ch + 4 < CS_NCH) CSB_LOAD(afB, cB0, cB1, ch + 4);
            CSB_STEP(afC, cC0, cC1, ch + 2); if (ch + 5 < CS_NCH) CSB_LOAD(afC, cC0, cC1, ch + 5);
        }
        CS_BAR();
    }
#undef CSB_LOAD
#undef CSB_STEP
}

#undef CS_BAR
__device__ __forceinline__ void phase_ef2(const Ctx& C, const Args& A, int l) {
    const int i2 = l >> 1; unsigned char* ws = A.ws;
    const unsigned char* SCN = ws + WS_SCN; const float* Y0 = (const float*)(ws + WS_Y); const float* Y1 = Y0 + (size_t)MROWS * 768;
    const bf16_t* G = (const bf16_t*)(ws + WS_G); bf16_t* A2 = (bf16_t*)(ws + WS_A2);
    const float* rb = A.in[I_RBON] + (size_t)i2 * 768; const float* gg = A.in[I_GNG] + (size_t)i2 * 768; const float* gb = A.in[I_GNB] + (size_t)i2 * 768;
    for (int row = C.gw; row < MROWS; row += C.NGW) {
#pragma unroll
        for (int it = 0; it < 3; ++it) {
            const int c = it * 256 + 4 * C.lane, head = c >> 6, kx = c & 63;
            const f32x4 y = *(const f32x4*)(Y0 + (size_t)row * 768 + c) + *(const f32x4*)(Y1 + (size_t)row * 768 + c);
            const float mean = sum16((y[0] + y[1]) + (y[2] + y[3])) * (1.f / 64.f);
            const f32x4 dd = y - mean;
            const float var = sum16((dd[0] * dd[0] + dd[1] * dd[1]) + (dd[2] * dd[2] + dd[3] * dd[3])) * (1.f / 64.f);
            const float rstd = rsqrtf(var + GN_EPS);
            const unsigned char* base = SCN + (size_t)(row * 12 + head) * SC_REC + kx * 2;
            const f32x4 r = ld4bf_(base + SC_R), v = ld4bf_(base + SC_V), k0 = ld4bf_(base + SC_KR), k1 = ld4bf_(base + SC_KR + 256);
            const f32x4 rb4 = *(const f32x4*)(rb + c);
            const f32x4 t = r * (k0 + k1) * 0.5f * rb4;
            const float bs = sum16((t[0] + t[1]) + (t[2] + t[3]));
            const f32x4 yn = dd * rstd * *(const f32x4*)(gg + c) + *(const f32x4*)(gb + c);
            const f32x4 g = ld4bf(G + (size_t)row * 768 + c);
            st4bf(A2 + (size_t)row * DM + 256 + c, g * (yn + v * bs));
        }
    }
}

__device__ __forceinline__ void phase_of1(const Ctx& C, const Args& A, int l) {
    const int i2 = l >> 1; unsigned char* ws = A.ws;
    const bf16_t* P = (const bf16_t*)(ws + WS_P); bf16_t* A2 = (bf16_t*)(ws + WS_A2); bf16_t* VT = (bf16_t*)(ws + WS_VT);
    const float* lng = A.in[I_GLNG] + (size_t)i2 * 256; const float* lnb = A.in[I_GLNB] + (size_t)i2 * 256;
    const float* gws = A.in[I_GWS] + (size_t)i2 * 4 * 128 * 128; const float* gbs = A.in[I_GBS] + (size_t)i2 * 4 * 128;
    LAS bf16_t* vt = (LAS bf16_t*)C.lds;
    LAS bf16_t* uL = (LAS bf16_t*)C.lds;
    LAS bf16_t* vT = (LAS bf16_t*)(C.lds + 128 * 528);
    const int r32 = C.lane & 31, hi = C.lane >> 5;
    for (int u = blockIdx.x; u < 264; u += C.G) {
        const bool isctx = u >= 256; const int uc = u - 256;
        const int b = isctx ? (uc >> 1) : (u >> 6), pos0 = isctx ? (uc & 1) * 128 : (u & 63) * 128;
        const int row0 = isctx ? NLAT + b * CTXL + pos0 : b * TT + pos0, L0 = isctx ? pos0 : CTXL + pos0;
        for (int hh = 0; hh < 6; ++hh) {
#pragma unroll
            for (int i = 0; i < 4; ++i) { const int piece = C.tid + NTHR * i, r = piece >> 4, part = piece & 15;
                *(LAS u32x4*)(vt + r * 136 + part * 8) = *(const u32x4*)(P + (size_t)(row0 + r) * P_LD + 1536 + hh * 128 + part * 8); }
            __syncthreads();
#pragma unroll
            for (int i = 0; i < 4; ++i) { const int item = C.tid + NTHR * i, d = item >> 4, tg = item & 15; const LAS bf16_t* s = vt + (tg * 8) * 136 + d;
                u32x4 o; o.x = (unsigned)s[0] | ((unsigned)s[136] << 16); o.y = (unsigned)s[2 * 136] | ((unsigned)s[3 * 136] << 16);
                o.z = (unsigned)s[4 * 136] | ((unsigned)s[5 * 136] << 16); o.w = (unsigned)s[6 * 136] | ((unsigned)s[7 * 136] << 16);
                *(u32x4*)(VT + ((size_t)(b * 6 + hh) * 128 + d) * LKEYS + L0 + tg * 8) = o; }
            __syncthreads();
        }
        for (int r = C.wave; r < 128; r += NWAVES) {
            const int c4 = 4 * C.lane; const bf16_t* pr = P + (size_t)(row0 + r) * P_LD + 2304;
            const f32x4 ur = ld4bf(pr + c4), raw = ld4bf(pr + 256 + c4);
            { const f32x4 gu = {gelu_erf(ur[0]), gelu_erf(ur[1]), gelu_erf(ur[2]), gelu_erf(ur[3])}; u32x2 o; o.x = pk2(gu[0], gu[1]); o.y = pk2(gu[2], gu[3]); *(LAS u32x2*)(uL + r * 264 + c4) = o; }
            const f32x4 gv = {gelu_erf(raw[0]), gelu_erf(raw[1]), gelu_erf(raw[2]), gelu_erf(raw[3])};
            const float mean = wave_sum((gv[0] + gv[1]) + (gv[2] + gv[3])) * (1.f / 256.f); const f32x4 dd = gv - mean;
            const float var = wave_sum((dd[0] * dd[0] + dd[1] * dd[1]) + (dd[2] * dd[2] + dd[3] * dd[3])) * (1.f / 256.f); const float rstd = rsqrtf(var + LN_EPS);
            const f32x4 o = dd * rstd * *(const f32x4*)(lng + c4) + *(const f32x4*)(lnb + c4);
#pragma unroll
            for (int k = 0; k < 4; ++k) vT[(c4 + k) * 136 + r] = (bf16_t)f2bf(o[k]);
        }
        __syncthreads();
        {
            const int g = C.wave >> 1, cblk = C.wave & 1, cc = g * 64 + cblk * 32 + r32;
            for (int pblk = 0; pblk < 4; ++pblk) {
                f32x16 acc;
#pragma unroll
                for (int i = 0; i < 16; ++i) acc[i] = 0.f;
                const float* wrow = gws + ((size_t)g * 128 + pblk * 32 + r32) * 128 + 8 * hi;
#pragma unroll
                for (int ks = 0; ks < 8; ++ks) { const f32x4 w0 = *(const f32x4*)(wrow + ks * 16), w1 = *(const f32x4*)(wrow + ks * 16 + 4);
                    u32x4 au; au.x = pk2(w0[0], w0[1]); au.y = pk2(w0[2], w0[3]); au.z = pk2(w1[0], w1[1]); au.w = pk2(w1[2], w1[3]);
                    const bf16x8 bf = *(const LAS bf16x8*)(vT + cc * 136 + ks * 16 + 8 * hi);
                    acc = __builtin_amdgcn_mfma_f32_32x32x16_bf16(__builtin_bit_cast(bf16x8, au), bf, acc, 0, 0, 0); }
#pragma unroll
                for (int reg = 0; reg < 16; ++reg) { const int p = pblk * 32 + crow(reg, hi);
                    const float uu = bf2f(uL[p * 264 + cc]); const float mixed = acc[reg] + gbs[g * 128 + p];
                    uL[p * 264 + cc] = (bf16_t)f2bf(uu * mixed); }
            }
        }
        __syncthreads();
#pragma unroll
        for (int i = 0; i < 8; ++i) { const int piece = C.tid + NTHR * i, r = piece >> 5, part = piece & 31;
            *(u32x4*)(A2 + (size_t)(row0 + r) * DM + 768 + part * 8) = *(const LAS u32x4*)(uL + r * 264 + part * 8); }
        __syncthreads();
    }
}

__device__ __forceinline__ void phase_attn(const Ctx& C, const Args& A, int l) {
    const int i2 = l >> 1; unsigned char* ws = A.ws;
    const bf16_t* Q = (const bf16_t*)(ws + WS_Q); const bf16_t* KA = (const bf16_t*)(ws + WS_KA); const bf16_t* VT = (const bf16_t*)(ws + WS_VT); bf16_t* A2 = (bf16_t*)(ws + WS_A2);
    const float lam_init = 0.8f - 0.6f * expf(-0.3f * (float)l);
    float s1 = 0.f, s2 = 0.f;
    for (int j = 0; j < 64; ++j) { s1 += A.in[I_LQ1][i2 * 64 + j] * A.in[I_LK1][i2 * 64 + j]; s2 += A.in[I_LQ2][i2 * 64 + j] * A.in[I_LK2][i2 * 64 + j]; }
    const float lam = expf(s1) - expf(s2) + lam_init;
    const float* subg = A.in[I_SUBG] + (size_t)i2 * 128;
    const int r32 = C.lane & 31, hi = C.lane >> 5, map = C.wave >> 2, qw = C.wave & 3;
    LAS unsigned char* Kt = C.lds; LAS unsigned char* Vt = C.lds + 2 * 16384; LAS float* xch = (LAS float*)C.lds;
    const int NU = 1536 + (l == 1 ? 48 : 0);
    for (int n = C.vcu; n < NU; n += C.G) {
        int bh, qt; bool isctx = false;
        if (n < 1536) { const int round = n >> 8, slot = n & 255; bh = (slot >> 5) * 3 + (round >> 1); qt = (round & 1) * 32 + (slot & 31); }
        else { isctx = true; bh = (n - 1536) >> 1; qt = (n - 1536) & 1; }
        const int b = bh / 6, h = bh % 6;
        const int qrow0 = isctx ? NLAT + b * CTXL + qt * 128 : b * TT + qt * 128;
        const int NT = isctx ? CTXL / 64 : LKEYS / 64;
        const bf16_t* Kb = KA + (size_t)b * LKEYS * 768 + h * 128;
        const bf16_t* Vb = VT + (size_t)(b * 6 + h) * 128 * LKEYS;
        bf16x8 qf[4];
        { const bf16_t* qp = Q + (size_t)(qrow0 + qw * 32 + r32) * 768 + h * 128 + map * 64 + 8 * hi;
#pragma unroll
          for (int ks = 0; ks < 4; ++ks) qf[ks] = *(const bf16x8*)(qp + ks * 16); }
        f32x16 O[4];
#pragma unroll
        for (int d = 0; d < 4; ++d)
#pragma unroll
            for (int i = 0; i < 16; ++i) O[d][i] = 0.f;
        float m = 0.f, lsum = 0.f;
        unsigned ksrc[2], vsrc[2];
#pragma unroll
        for (int i = 0; i < 2; ++i) { const int row = 4 * (2 * C.wave + i) + (C.lane >> 4), x = row & 15, pi = x < 4 ? x : x < 8 ? x + 4 : x < 12 ? x - 4 : x;
            ksrc[i] = (unsigned)(((row & ~15) + pi) * 768 + (((C.lane & 15) ^ x) * 8));
            const int d = 8 * (2 * C.wave + i) + (C.lane >> 3); vsrc[i] = (unsigned)(d * LKEYS + (((C.lane & 7) ^ ((d >> 1) & 7)) * 8)); }
#define AT_DMA_K(tt, slot) do { _Pragma("unroll") for (int i = 0; i < 2; ++i) __builtin_amdgcn_global_load_lds((const unsigned*)(Kb + (size_t)(tt) * 64 * 768 + ksrc[i]), (LAS unsigned*)(Kt + (slot) * 16384 + (2 * C.wave + i) * 1024), 16, 0, 0); } while (0)
#define AT_DMA_V(tt, slot) do { _Pragma("unroll") for (int i = 0; i < 2; ++i) __builtin_amdgcn_global_load_lds((const unsigned*)(Vb + (size_t)(tt) * 64 + vsrc[i]), (LAS unsigned*)(Vt + (slot) * 16384 + (2 * C.wave + i) * 1024), 16, 0, 0); } while (0)
#define AT_BAR() asm volatile("s_waitcnt vmcnt(0) lgkmcnt(0)\n\ts_barrier" ::: "memory")
#define AT_SB() __builtin_amdgcn_sched_barrier(0)
        const int ksw = r32 & 15, vsw = (r32 >> 1) & 7;
#define AT_QK(P0, P1, ks_) do { const float nm_ = -m; _Pragma("unroll") for (int i = 0; i < 16; ++i) { P0[i] = nm_; P1[i] = nm_; } \
            const LAS unsigned char* kbp_ = Kt + (ks_) * 16384 + r32 * 256; \
            _Pragma("unroll") for (int ks = 0; ks < 4; ++ks) { const int co_ = ((map * 8 + ks * 2 + hi) ^ ksw) * 16; \
                P0 = __builtin_amdgcn_mfma_f32_32x32x16_bf16(*(const LAS bf16x8*)(kbp_ + co_), qf[ks], P0, 0, 0, 0); P1 = __builtin_amdgcn_mfma_f32_32x32x16_bf16(*(const LAS bf16x8*)(kbp_ + 32 * 256 + co_), qf[ks], P1, 0, 0, 0); } } while (0)
#define AT_LDV(dst, vs_, d) do { _Pragma("unroll") for (int kst = 0; kst < 4; ++kst) dst[kst] = *(const LAS u32x4*)(Vt + (vs_) * 16384 + ((d) * 32 + r32) * 128 + (((kst * 2 + hi) ^ vsw) * 16)); } while (0)
#define AT_PV(src, d) do { _Pragma("unroll") for (int kst = 0; kst < 4; ++kst) O[d] = __builtin_amdgcn_mfma_f32_32x32x16_bf16(__builtin_bit_cast(bf16x8, src[kst]), pb[kst], O[d], 0, 0, 0); } while (0)
#define AT_SOFTPV(P0, P1, N0, N1, first, hasn, vs_) do { \
            asm volatile("s_nop 15\n\ts_nop 7" : "+v"(P0), "+v"(P1)); \
            float mx = max3f(P0[0], P0[1], P1[0]), mx2 = max3f(P0[2], P0[3], P1[1]); mx = max3f(mx, P1[2], P1[3]); \
            _Pragma("unroll") for (int i = 4; i < 16; i += 4) { mx = max3f(mx, P0[i], P0[i + 1]); mx2 = max3f(mx2, P0[i + 2], P0[i + 3]); mx = max3f(mx, P1[i], P1[i + 1]); mx2 = max3f(mx2, P1[i + 2], P1[i + 3]); } \
            mx = fmaxf(mx, mx2); \
            { auto rr = __builtin_amdgcn_permlane32_swap(__float_as_uint(mx), __float_as_uint(mx), false, false); mx = fmaxf(__uint_as_float(rr[0]), __uint_as_float(rr[1])); } \
            if ((first) || __any(mx > 8.f)) { const float dl = (first) ? mx : fmaxf(mx, 0.f); const float sc = __builtin_amdgcn_exp2f(-dl); lsum *= sc; \
                _Pragma("unroll") for (int d = 0; d < 4; ++d) _Pragma("unroll") for (int i = 0; i < 16; ++i) O[d][i] *= sc; \
                _Pragma("unroll") for (int i = 0; i < 16; ++i) { P0[i] -= dl; P1[i] -= dl; } \
                if (hasn) { asm volatile("s_nop 15\n\ts_nop 7" : "+v"(N0), "+v"(N1)); _Pragma("unroll") for (int i = 0; i < 16; ++i) { N0[i] -= dl; N1[i] -= dl; } } \
                m += dl; } \
            float ps = 0.f, ps2 = 0.f; \
            _Pragma("unroll") for (int i = 0; i < 16; ++i) { P0[i] = __builtin_amdgcn_exp2f(P0[i]); P1[i] = __builtin_amdgcn_exp2f(P1[i]); ps += P0[i]; ps2 += P1[i]; } \
            lsum += ps + ps2; \
            bf16x8 pb[4]; \
            { u32x4 w; w.x = pk2(P0[0], P0[1]); w.y = pk2(P0[2], P0[3]); w.z = pk2(P0[4], P0[5]); w.w = pk2(P0[6], P0[7]); pb[0] = __builtin_bit_cast(bf16x8, w); \
              w.x = pk2(P0[8], P0[9]); w.y = pk2(P0[10], P0[11]); w.z = pk2(P0[12], P0[13]); w.w = pk2(P0[14], P0[15]); pb[1] = __builtin_bit_cast(bf16x8, w); \
              w.x = pk2(P1[0], P1[1]); w.y = pk2(P1[2], P1[3]); w.z = pk2(P1[4], P1[5]); w.w = pk2(P1[6], P1[7]); pb[2] = __builtin_bit_cast(bf16x8, w); \
              w.x = pk2(P1[8], P1[9]); w.y = pk2(P1[10], P1[11]); w.z = pk2(P1[12], P1[13]); w.w = pk2(P1[14], P1[15]); pb[3] = __builtin_bit_cast(bf16x8, w); } \
            u32x4 va[4]; \
            AT_LDV(va, vs_, 0); AT_SB(); AT_PV(va, 0); AT_SB(); AT_LDV(va, vs_, 1); AT_SB(); AT_PV(va, 1); AT_SB(); AT_LDV(va, vs_, 2); AT_SB(); AT_PV(va, 2); AT_SB(); AT_LDV(va, vs_, 3); AT_SB(); AT_PV(va, 3); AT_SB(); } while (0)
        f32x16 pA0, pA1, pB0, pB1;
        AT_DMA_K(0, 0); AT_DMA_V(0, 0); AT_DMA_K(1, 1);
        AT_BAR();
        AT_QK(pA0, pA1, 0);
        asm volatile("s_waitcnt lgkmcnt(0)\n\ts_barrier" ::: "memory");
        for (int t = 0; t < NT; t += 2) {
            if (t + 2 < NT) AT_DMA_K(t + 2, 0);
            AT_DMA_V(t + 1, 1);
            AT_SB(); AT_QK(pB0, pB1, 1); AT_SB();
            AT_SOFTPV(pA0, pA1, pB0, pB1, t == 0, true, 0);
            AT_BAR();
            if (t + 3 < NT) AT_DMA_K(t + 3, 1);
            if (t + 2 < NT) AT_DMA_V(t + 2, 0);
            AT_SB(); if (t + 2 < NT) { AT_QK(pA0, pA1, 0); } AT_SB();
            AT_SOFTPV(pB0, pB1, pA0, pA1, false, t + 2 < NT, 1);
            AT_BAR();
        }
#undef AT_DMA_K
#undef AT_DMA_V
#undef AT_BAR
#undef AT_SB
#undef AT_QK
#undef AT_LDV
#undef AT_PV
#undef AT_SOFTPV
        const float ltot = lsum + __shfl_xor(lsum, 32);
        const float invl = 1.f / ltot;
        if (map == 1) { const float f = lam * invl;
#pragma unroll
            for (int d = 0; d < 4; ++d)
#pragma unroll
                for (int i = 0; i < 16; ++i) xch[(qw * 64 + d * 16 + i) * 64 + C.lane] = O[d][i] * f; }
        __syncthreads();
        if (map == 0) { float ss = 0.f;
#pragma unroll
            for (int d = 0; d < 4; ++d)
#pragma unroll
                for (int i = 0; i < 16; ++i) { const float o = O[d][i] * invl - xch[(qw * 64 + d * 16 + i) * 64 + C.lane]; O[d][i] = o; ss += o * o; }
            ss += __shfl_xor(ss, 32);
            const float rn = rsqrtf(ss * (1.f / 128.f) + RMS_EPS) * (1.f - lam_init);
            bf16_t* orow = A2 + (size_t)(qrow0 + qw * 32 + r32) * DM + h * 128;
#pragma unroll
            for (int d = 0; d < 4; ++d)
#pragma unroll
                for (int g4 = 0; g4 < 4; ++g4) { const int dd = 32 * d + 8 * g4 + 4 * hi; const f32x4 sg = *(const f32x4*)(subg + dd);
                    const f32x4 v = {O[d][4 * g4] * rn * sg[0], O[d][4 * g4 + 1] * rn * sg[1], O[d][4 * g4 + 2] * rn * sg[2], O[d][4 * g4 + 3] * rn * sg[3]};
                    st4bf(orow + dd, v); } }
        __syncthreads();
    }
}

__device__ __forceinline__ void phase_rt(const Ctx& C, const Args& A, int l) {
    unsigned char* ws = A.ws; float* X = (float*)(ws + WS_X); bf16_t* H = (bf16_t*)(ws + WS_H); float* AFF = (float*)(ws + WS_AFF);
    const float* MOD = (const float*)(ws + WS_MOD) + (size_t)l * 5 * 6144;
    const float* lng = A.in[I_LNG] + (size_t)(l * 2 + 0) * DM; const float* lnb = A.in[I_LNB] + (size_t)(l * 2 + 0) * DM;
    LAS float* wrs = (LAS float*)C.lds;
    { const float* wr = A.in[I_WR] + (size_t)l * DM * 16; for (int i = C.tid; i < DM * 16; i += NTHR) wrs[(i & 15) * 1024 + (i >> 4)] = wr[i]; }
    __syncthreads();
    for (int row = C.gw; row < MROWS; row += C.NGW) {
        const float* md = MOD + row_mi(row) * 6144;
        f32x4 x[4]; float s = 0.f;
#pragma unroll
        for (int j = 0; j < 4; ++j) { x[j] = *(const f32x4*)(X + (size_t)row * DM + 4 * C.lane + 256 * j); s += (x[j][0] + x[j][1]) + (x[j][2] + x[j][3]); }
        const float mean = wave_sum(s) * (1.f / DM); float s2 = 0.f;
#pragma unroll
        for (int j = 0; j < 4; ++j) { x[j] = x[j] - mean; s2 += (x[j][0] * x[j][0] + x[j][1] * x[j][1]) + (x[j][2] * x[j][2] + x[j][3] * x[j][3]); }
        const float rstd = rsqrtf(wave_sum(s2) * (1.f / DM) + LN_EPS);
        float v[16];
#pragma unroll
        for (int e = 0; e < 16; ++e) v[e] = 0.f;
#pragma unroll
        for (int j = 0; j < 4; ++j) { const int col = 4 * C.lane + 256 * j;
            const f32x4 x1 = x[j] * rstd * *(const f32x4*)(lng + col) + *(const f32x4*)(lnb + col);
            *(f32x4*)(X + (size_t)row * DM + col) = x1;
            const f32x4 h = x1 * (*(const f32x4*)(md + 4 * DM + col) + 1.f) + *(const f32x4*)(md + 3 * DM + col);
            st4bf(H + (size_t)row * DM + col, h);
#pragma unroll
            for (int e = 0; e < 16; ++e) { const f32x4 w = *(const LAS f32x4*)(wrs + e * 1024 + col); v[e] += (h[0] * w[0] + h[1] * w[1]) + (h[2] * w[2] + h[3] * w[3]); }
            __builtin_amdgcn_sched_barrier(0); }
#pragma unroll
        for (int i = 0; i < 8; ++i) { const float send = (C.lane & 32) ? v[i] : v[i + 8], keep = (C.lane & 32) ? v[i + 8] : v[i]; v[i] = keep + __shfl_xor(send, 32); }
#pragma unroll
        for (int i = 0; i < 4; ++i) { const float send = (C.lane & 16) ? v[i] : v[i + 4], keep = (C.lane & 16) ? v[i + 4] : v[i]; v[i] = keep + __shfl_xor(send, 16); }
#pragma unroll
        for (int i = 0; i < 2; ++i) { const float send = (C.lane & 8) ? v[i] : v[i + 2], keep = (C.lane & 8) ? v[i + 2] : v[i]; v[i] = keep + __shfl_xor(send, 8); }
        { const float send = (C.lane & 4) ? v[0] : v[1], keep = (C.lane & 4) ? v[1] : v[0]; v[0] = keep + __shfl_xor(send, 4); }
        float z = v[0]; z += __shfl_xor(z, 1); z += __shfl_xor(z, 2);
        float mx = z;
#pragma unroll
        for (int o = 4; o < 64; o <<= 1) mx = fmaxf(mx, __shfl_xor(mx, o));
        const float ex = expf(z - mx); float sm = ex;
#pragma unroll
        for (int o = 4; o < 64; o <<= 1) sm += __shfl_xor(sm, o);
        if ((C.lane & 3) == 0) AFF[(size_t)row * 16 + (C.lane >> 2)] = ex / sm;
    }
}

__device__ __forceinline__ void phase_tk(const Ctx& C, const Args& A) {
    unsigned char* ws = A.ws; const float* AFF = (const float*)(ws + WS_AFF); int* SLOT = (int*)(ws + WS_SLOT); int* IDX = (int*)(ws + WS_IDX); float* GATE = (float*)(ws + WS_GATE);
    LAS unsigned* key = (LAS unsigned*)C.lds;
    LAS unsigned* hist = key + 8192;
    LAS unsigned* scn = hist + 256;
    LAS unsigned* wtot = scn + 256;
    LAS unsigned* bc = wtot + 8;
    for (int u = blockIdx.x; u < 128; u += C.G) {
        const bool isctx = u >= 64; const int uu = u & 63, b = uu >> 4, e = uu & 15;
        const int n = isctx ? CTXL : TT, cap = isctx ? CAP_C : CAP_L;
        const int row0 = isctx ? NLAT + b * CTXL : b * TT;
        const int slot0 = e * ESLOTS + (isctx ? 4 * CAP_L + b * CAP_C : b * CAP_L);
        for (int i = C.tid; i < n; i += NTHR) key[i] = __float_as_uint(AFF[(size_t)(row0 + i) * 16 + e]);
        unsigned prefix = 0u, pmask = 0u; int need = cap;
        for (int pass = 0; pass < 4; ++pass) {
            const int shift = 24 - 8 * pass;
            if (C.tid < 256) hist[C.tid] = 0u;
            __syncthreads();
            for (int i = C.tid; i < n; i += NTHR) { const unsigned k = key[i]; if ((k & pmask) == prefix) __hip_atomic_fetch_add(&hist[(k >> shift) & 255u], 1u, __ATOMIC_RELAXED, __HIP_MEMORY_SCOPE_WORKGROUP); }
            __syncthreads();
            if (C.tid < 256) scn[C.tid] = hist[C.tid];
            __syncthreads();
            for (int off = 1; off < 256; off <<= 1) {
                unsigned a = 0u; if (C.tid < 256 && C.tid + off < 256) a = scn[C.tid + off];
                __syncthreads();
                if (C.tid < 256) scn[C.tid] += a;
                __syncthreads();
            }
            if (C.tid < 256) { const unsigned above = (C.tid < 255) ? scn[C.tid + 1] : 0u;
                if (scn[C.tid] >= (unsigned)need && above < (unsigned)need) { bc[0] = (unsigned)C.tid; bc[1] = (unsigned)need - above; } }
            __syncthreads();
            prefix |= bc[0] << shift; pmask |= 255u << shift; need = (int)bc[1];
            __syncthreads();
        }
        const int per = (n + NTHR - 1) / NTHR; const int i0 = C.tid * per;
        unsigned cg = 0u, ce = 0u;
        for (int j = 0; j < per; ++j) { const int i = i0 + j; if (i < n) { const unsigned k = key[i]; cg += (k > prefix); ce += (k == prefix); } }
        unsigned pk = cg | (ce << 16), inc = pk;
#pragma unroll
        for (int o = 1; o < 64; o <<= 1) { const unsigned t = __shfl_up(inc, o); if (C.lane >= o) inc += t; }
        if (C.lane == 63) wtot[C.wave] = inc;
        __syncthreads();
        unsigned wbase = 0u;
        for (int w = 0; w < C.wave; ++w) wbase += wtot[w];
        const unsigned excl = wbase + inc - pk;
        unsigned rg = excl & 0xffffu, re = excl >> 16;
        const int ngt = cap - need;
        for (int j = 0; j < per; ++j) { const int i = i0 + j; if (i < n) { const unsigned k = key[i]; int pos = -1;
            if (k > prefix) { pos = (int)rg; ++rg; } else if (k == prefix) { if ((int)re < need) pos = ngt + (int)re; ++re; }
            const int row = row0 + i;
            if (pos >= 0) { IDX[slot0 + pos] = row; GATE[slot0 + pos] = __uint_as_float(k); SLOT[(size_t)row * 16 + e] = slot0 + pos; }
            else SLOT[(size_t)row * 16 + e] = -1; } }
        if (isctx && b == 0 && C.tid < ESLOTS - 4224) { IDX[e * ESLOTS + 4224 + C.tid] = 0; GATE[e * ESLOTS + 4224 + C.tid] = 0.f; }
        __syncthreads();
    }
}

__device__ __forceinline__ void phase_cb(const Ctx& C, const Args& A, int l) {
    unsigned char* ws = A.ws; float* X = (float*)(ws + WS_X); bf16_t* H = (bf16_t*)(ws + WS_H); const int* SLOT = (const int*)(ws + WS_SLOT); const bf16_t* YE = (const bf16_t*)(ws + WS_YE);
    const float* MOD = (const float*)(ws + WS_MOD) + (size_t)l * 5 * 6144; const float* MODN = MOD + 5 * 6144;
    const float* lng = A.in[I_LNG] + (size_t)(l * 2 + 1) * DM; const float* lnb = A.in[I_LNB] + (size_t)(l * 2 + 1) * DM;
    for (int row = C.gw; row < MROWS; row += C.NGW) {
        const int mi = row_mi(row); const float* md = MOD + mi * 6144;
        f32x4 acc[4];
#pragma unroll
        for (int j = 0; j < 4; ++j) acc[j] = (f32x4){0.f, 0.f, 0.f, 0.f};
        for (int e = 0; e < 16; ++e) { const int s = __builtin_amdgcn_readfirstlane(SLOT[(size_t)row * 16 + e]);
            if (s >= 0) {
#pragma unroll
                for (int j = 0; j < 4; ++j) acc[j] += ld4bf(YE + (size_t)s * DM + 4 * C.lane + 256 * j); } }
        f32x4 x[4]; float sm = 0.f;
#pragma unroll
        for (int j = 0; j < 4; ++j) { const int col = 4 * C.lane + 256 * j; x[j] = *(const f32x4*)(X + (size_t)row * DM + col) * ALPHA_DN + *(const f32x4*)(md + 5 * DM + col) * acc[j];
            sm += (x[j][0] + x[j][1]) + (x[j][2] + x[j][3]); }
        const float mean = wave_sum(sm) * (1.f / DM); float s2 = 0.f;
#pragma unroll
        for (int j = 0; j < 4; ++j) { x[j] = x[j] - mean; s2 += (x[j][0] * x[j][0] + x[j][1] * x[j][1]) + (x[j][2] * x[j][2] + x[j][3] * x[j][3]); }
        const float rstd = rsqrtf(wave_sum(s2) * (1.f / DM) + LN_EPS);
#pragma unroll
        for (int j = 0; j < 4; ++j) { const int col = 4 * C.lane + 256 * j;
            const f32x4 x2 = x[j] * rstd * *(const f32x4*)(lng + col) + *(const f32x4*)(lnb + col);
            *(f32x4*)(X + (size_t)row * DM + col) = x2;
            if (l < DEPTH - 1) { const float* mn = MODN + mi * 6144; st4bf(H + (size_t)row * DM + col, x2 * (*(const f32x4*)(mn + DM + col) + 1.f) + *(const f32x4*)(mn + col)); }
            else if (row < NLAT) *(f32x4*)(A.out + (size_t)row * DM + col) = x2; }
    }
}


#ifndef GEMM_NOINLINE
#define GEMM_NOINLINE 0
#endif
#if GEMM_NOINLINE
#define GEMM_FN __device__ __noinline__
#else
#define GEMM_FN __device__ __forceinline__
#endif
GEMM_FN void gphase_in(LAS unsigned char* lds, unsigned char* ws, int nN, int G) {
    int bx = blockIdx.x; asm volatile("" : "+s"(bx), "+s"(G));
    pg8::Gemm g{(const bf16_t*)(ws + WS_H), (const bf16_t*)(ws + WS_WIN), DM}; pg8::Order<0> S; S.init(MROWS / 256, nN, G, bx, nullptr, 0);
    pg8::EpiBf16 E{(bf16_t*)(ws + WS_P), P_LD}; pg8::gemm_phase(lds, g, S, E); }
GEMM_FN void gphase_in_odd(LAS unsigned char* lds, unsigned char* ws, int G) {
    int bx = blockIdx.x; asm volatile("" : "+s"(bx), "+s"(G));
    pg8::Gemm g{(const bf16_t*)(ws + WS_H), (const bf16_t*)(ws + WS_WIN), DM}; pg8::Order<0> S; S.init(MROWS / 256, D_IN_ODD / 256, G, bx, nullptr, 0);
    pg8::EpiOdd E{(bf16_t*)(ws + WS_P), (bf16_t*)(ws + WS_Q), (bf16_t*)(ws + WS_KA), (const float*)(ws + WS_ROPE)}; pg8::gemm_phase(lds, g, S, E); }
GEMM_FN void gphase_lora(LAS unsigned char* lds, unsigned char* ws, const float* d0, const float* a0, const float* kal, int G) {
    int bx = blockIdx.x; asm volatile("" : "+s"(bx), "+s"(G));
    pg8::Gemm g{(const bf16_t*)(ws + WS_LIN), (const bf16_t*)(ws + WS_WLORA), LORA_K}; pg8::Order<0> S; S.init(MROWS / 256, LORA_N / 256, G, bx, nullptr, 0);
    pg8::EpiLora E{ws + WS_SCN, (bf16_t*)(ws + WS_G), d0, a0, kal}; pg8::gemm_phase(lds, g, S, E); }
GEMM_FN void gphase_out(LAS unsigned char* lds, unsigned char* ws, const float* modl, int G) {
    int bx = blockIdx.x; asm volatile("" : "+s"(bx), "+s"(G));
    pg8::Gemm g{(const bf16_t*)(ws + WS_A2), (const bf16_t*)(ws + WS_WOUT), DM}; pg8::Order<0> S; S.init(MROWS / 256, DM / 256, G, bx, nullptr, 0);
    pg8::EpiRes E{(float*)(ws + WS_X), modl}; pg8::gemm_phase(lds, g, S, E); }
GEMM_FN void gphase_e1(LAS unsigned char* lds, unsigned char* ws, int G, int l) {
    int bx = blockIdx.x; asm volatile("" : "+s"(bx), "+s"(G));
    pg8::Gemm g{(const bf16_t*)(ws + WS_H), (const bf16_t*)(ws + WS_WE13 + (size_t)(l & 1) * WE13_BYTES), DM}; pg8::EpiSwiGLU E{(bf16_t*)(ws + WS_HID)};
    pg8::OrderExp<1> S; S.init(4096 / 256, G, bx, (const int*)(ws + WS_IDX), (long)4096 * DM); pg8::gemm_phase(lds, g, S, E); }
GEMM_FN void gphase_e2(LAS unsigned char* lds, unsigned char* ws, int G, int l) {
    int bx = blockIdx.x; asm volatile("" : "+s"(bx), "+s"(G));
    pg8::Gemm g{(const bf16_t*)(ws + WS_HID), (const bf16_t*)(ws + WS_WE2 + (size_t)(l & 1) * WE2_BYTES), D_EXP}; pg8::EpiYE E{(bf16_t*)(ws + WS_YE), (const float*)(ws + WS_GATE)};
    pg8::OrderExp<2> S; S.init(DM / 256, G, bx, nullptr, (long)DM * D_EXP); pg8::gemm_phase(lds, g, S, E); }

constexpr int NSLOT = 13;
constexpr int NSTEP = 1 + DEPTH * NSLOT;
__global__ void __launch_bounds__(NTHR, 2) mk_fwd(Args KA) {
    extern __shared__ __attribute__((aligned(16))) unsigned char lds_raw[];
    volatile LAS unsigned* MISC = (volatile LAS unsigned*)((LAS unsigned char*)lds_raw + LDS_MISC);
    if (threadIdx.x < 16) MISC[threadIdx.x] = 0u;
    if (threadIdx.x == 0) { LAS unsigned long long* tb = (LAS unsigned long long*)((LAS unsigned char*)lds_raw + LDS_PTAB);
#pragma unroll
        for (int i = 0; i < 37; ++i) tb[i] = (unsigned long long)KA.in[i];
        tb[37] = (unsigned long long)KA.out; tb[38] = (unsigned long long)KA.ws; }
    __syncthreads();
    const int lo = KA.lo, hi = KA.hi;
    unsigned bar_x = 0;
    if (hi - lo > 1) { const XcdBarrier b0 = xcd_barrier_post((unsigned*)(KA.ws + WS_CTL), MISC); bar_x = b0.x; }
#ifndef PH_MASK
#define PH_MASK 0xFFFFFF
#endif
#ifndef REP_MASK
#define REP_MASK 0
#endif
#define PH_BIT(k) (((k) == 0) ? 0 : 1 + ((k) - 1) % NSLOT + (((k) - 1) % NSLOT >= 2 && ((k) - 1) % NSLOT <= 3 && odd ? 12 : 0))
#define RUN(k, ...) do { if (((PH_MASK >> PH_BIT(k)) & 1) && lo <= (k) && (k) < hi) { const int nrep = ((REP_MASK >> PH_BIT(k)) & 1) ? 2 : 1; \
        _Pragma("unroll 1") for (int rep = 0; rep < nrep; ++rep) { \
        Ctx C; mkctx(C, (LAS unsigned char*)lds_raw); Args A; ldargs(A, (LAS unsigned char*)lds_raw); unsigned char* ws = A.ws; \
        const float* MODL = (const float*)(ws + WS_MOD) + (size_t)l * 5 * 6144; (void)MODL; \
        __VA_ARGS__; if ((k) + 1 < hi || rep + 1 < nrep) { XcdBarrier bar; bar.bar = (unsigned*)(ws + WS_CTL); bar.x = bar_x; bar.st = MISC; xcd_barrier(bar); } } } } while (0)
    { const bool odd = false; const int l = 0; RUN(0, phase_init(C, A)); }
#pragma unroll 1
    for (int l = 0; l < DEPTH; ++l) {
        const int sb = 1 + l * NSLOT; const bool odd = l & 1;
        RUN(sb + 0, { phase_conv(C, A, l); if (l == 0) phase_modh(C, A, 0); });
        if (odd) { RUN(sb + 1, gphase_in_odd(C.lds, ws, C.G)); } else { RUN(sb + 1, gphase_in(C.lds, ws, D_IN_EVEN_PAD / 256, C.G)); }
        if (!odd) {
            RUN(sb + 2, phase_ef1(C, A, l));
            RUN(sb + 3, { const int i2 = l >> 1; gphase_lora(C.lds, ws, A.in[I_D0] + (size_t)i2 * 2 * 768, A.in[I_A0] + (size_t)i2 * 2 * 768, A.in[I_KAL] + (size_t)i2 * 768, C.G); });
#if CHUNKED_SCAN
            RUN(sb + 4, phase_csa(C, A));
            RUN(sb + 5, phase_csb(C, A, l));
#else
            RUN(sb + 4, phase_scan(C, A));
#endif
            RUN(sb + 6, phase_ef2(C, A, l));
        } else {
            RUN(sb + 2, phase_of1(C, A, l));
            RUN(sb + 3, phase_attn(C, A, l));
        }
        RUN(sb + 7, gphase_out(C.lds, ws, MODL, C.G));
        RUN(sb + 8, phase_rt(C, A, l));
        RUN(sb + 9, phase_tk(C, A));
        RUN(sb + 10, gphase_e1(C.lds, ws, C.G, l));
        RUN(sb + 11, gphase_e2(C.lds, ws, C.G, l));
        RUN(sb + 12, phase_cb(C, A, l));
    }
#undef RUN
}

#ifdef PHASE_PROBE
#define PROBE_PRE extern __shared__ __attribute__((aligned(16))) unsigned char lds_raw[]; Ctx C; mkctx(C, (LAS unsigned char*)lds_raw); unsigned char* ws = A.ws; (void)ws;
__global__ void __launch_bounds__(NTHR, 2) pr_init(Args A) { PROBE_PRE phase_init(C, A); }
__global__ void __launch_bounds__(NTHR, 2) pr_conv(Args A) { PROBE_PRE phase_conv(C, A, A.lo); }
__global__ void __launch_bounds__(NTHR, 2) pr_modh(Args A) { PROBE_PRE phase_modh(C, A, A.lo); }
__global__ void __launch_bounds__(NTHR, 2) pr_ef1(Args A) { PROBE_PRE phase_ef1(C, A, A.lo); }
__global__ void __launch_bounds__(NTHR, 2) pr_scan(Args A) { PROBE_PRE phase_scan(C, A); }
__global__ void __launch_bounds__(NTHR, 2) pr_ef2(Args A) { PROBE_PRE phase_ef2(C, A, A.lo); }
__global__ void __launch_bounds__(NTHR, 2) pr_csa(Args A) { PROBE_PRE phase_csa(C, A); }
__global__ void __launch_bounds__(NTHR, 2) pr_csb(Args A) { PROBE_PRE phase_csb(C, A, A.lo); }
__global__ void __launch_bounds__(NTHR, 2) pr_of1(Args A) { PROBE_PRE phase_of1(C, A, A.lo); }
__global__ void __launch_bounds__(NTHR, 2) pr_attn(Args A) { PROBE_PRE phase_attn(C, A, A.lo); }
__global__ void __launch_bounds__(NTHR, 2) pr_rt(Args A) { PROBE_PRE phase_rt(C, A, A.lo); }
__global__ void __launch_bounds__(NTHR, 2) pr_tk(Args A) { PROBE_PRE phase_tk(C, A); }
__global__ void __launch_bounds__(NTHR, 2) pr_cb(Args A) { PROBE_PRE phase_cb(C, A, A.lo); }
__global__ void __launch_bounds__(NTHR, 2) pr_gemm_in(Args A) { PROBE_PRE pg8::Gemm g{(const bf16_t*)(ws + WS_H), (const bf16_t*)(ws + WS_WIN), DM}; pg8::Order<0> S; S.init(MROWS / 256, A.lo, C.G, (int)blockIdx.x, nullptr, 0);
                      pg8::EpiBf16 E{(bf16_t*)(ws + WS_P), P_LD}; pg8::gemm_phase(C.lds, g, S, E); }
__global__ void __launch_bounds__(NTHR, 2) pr_gemm_lora(Args A) { PROBE_PRE pg8::Gemm g{(const bf16_t*)(ws + WS_LIN), (const bf16_t*)(ws + WS_WLORA), LORA_K}; pg8::Order<0> S; S.init(MROWS / 256, LORA_N / 256, C.G, (int)blockIdx.x, nullptr, 0);
                          const int i2 = A.lo; pg8::EpiLora E{ws + WS_SCN, (bf16_t*)(ws + WS_G), A.in[I_D0] + (size_t)i2 * 2 * 768, A.in[I_A0] + (size_t)i2 * 2 * 768, A.in[I_KAL] + (size_t)i2 * 768};
                          pg8::gemm_phase(C.lds, g, S, E); }
__global__ void __launch_bounds__(NTHR, 2) pr_gemm_out(Args A) { PROBE_PRE pg8::Gemm g{(const bf16_t*)(ws + WS_A2), (const bf16_t*)(ws + WS_WOUT), DM}; pg8::Order<0> S; S.init(MROWS / 256, DM / 256, C.G, (int)blockIdx.x, nullptr, 0);
                      pg8::EpiRes E{(float*)(ws + WS_X), (const float*)(ws + WS_MOD)}; pg8::gemm_phase(C.lds, g, S, E); }
__global__ void __launch_bounds__(NTHR, 2) pr_gemm_e1(Args A) { PROBE_PRE pg8::Gemm g{(const bf16_t*)(ws + WS_H), (const bf16_t*)(ws + WS_WE13), DM}; pg8::Order<1> S; S.init(NEXP * 17, 4096 / 256, C.G, (int)blockIdx.x, (const int*)(ws + WS_IDX), (long)4096 * DM);
                      pg8::EpiSwiGLU E{(bf16_t*)(ws + WS_HID)}; pg8::gemm_phase(C.lds, g, S, E); }
__global__ void __launch_bounds__(NTHR, 2) pr_gemm_e2(Args A) { PROBE_PRE pg8::Gemm g{(const bf16_t*)(ws + WS_HID), (const bf16_t*)(ws + WS_WE2), D_EXP}; pg8::Order<2> S; S.init(NEXP * 17, DM / 256, C.G, (int)blockIdx.x, nullptr, (long)DM * D_EXP);
                       pg8::EpiYE E{(bf16_t*)(ws + WS_YE), (const float*)(ws + WS_GATE)}; pg8::gemm_phase(C.lds, g, S, E); }
#endif

extern "C" void kernel_launch(void* const* d_in, const int* in_sizes, int n_in, void* d_out, int out_size, void* d_ws, size_t ws_size, hipStream_t stream) {
    static int grid = 0;
    if (grid == 0) {
        if (n_in != 37 || out_size != NLAT * DM || ws_size < WS_END) { fprintf(stderr, "kernel_launch: unexpected shapes: n_in %d out %d ws %zu (need %zu)\n", n_in, out_size, ws_size, (size_t)WS_END); grid = -1; return; }
        int dev = 0, cus = 0, per_cu = 0;
        if (hipGetDevice(&dev) != hipSuccess || hipDeviceGetAttribute(&cus, hipDeviceAttributeMultiprocessorCount, dev) != hipSuccess) { grid = -1; return; }
        if (hipFuncSetAttribute((const void*)mk_fwd, hipFuncAttributeMaxDynamicSharedMemorySize, LDS_BYTES) != hipSuccess) { fprintf(stderr, "kernel_launch: hipFuncSetAttribute failed\n"); grid = -1; return; }
        if (hipOccupancyMaxActiveBlocksPerMultiprocessor(&per_cu, (const void*)mk_fwd, NTHR, LDS_BYTES) != hipSuccess || per_cu < 1) fprintf(stderr, "kernel_launch: occupancy query reports %d\n", per_cu);
        (void)hipGetLastError();
        grid = cus;
    }
    if (grid < 0) return;
    (void)hipMemsetAsync((char*)d_ws + WS_CTL, 0, CTL_BYTES, stream);
    Args a{};
    for (int i = 0; i < 37; ++i) a.in[i] = (const float*)d_in[i];
    a.out = (float*)d_out; a.ws = (unsigned char*)d_ws;
#if MK_MULTI
    for (int k = 0; k < NSTEP; ++k) {
        if (k >= 1) { const int l = (k - 1) / NSLOT, s = (k - 1) % NSLOT; if ((l & 1) && (s >= 4 && s <= 6)) continue; if (!(l & 1) && !CHUNKED_SCAN && s == 5) continue; }
        a.lo = k; a.hi = k + 1;
        hipLaunchKernelGGL(mk_fwd, dim3(grid), dim3(NTHR), LDS_BYTES, stream, a);
    }
#else
    a.lo = 0; a.hi = NSTEP;
    hipLaunchKernelGGL(mk_fwd, dim3(grid), dim3(NTHR), LDS_BYTES, stream, a);
#endif
    const hipError_t le = hipPeekAtLastError();
    if (le != hipSuccess) fprintf(stderr, "kernel_launch: launch failed: %s\n", hipGetErrorName(le));
}
```

```cpp
#include <hip/hip_runtime.h>
#include <cstdio>
#include <cstdint>
#include <cmath>

#ifndef MK_MULTI
#define MK_MULTI 0
#endif
#ifndef CHUNKED_SCAN
#define CHUNKED_SCAN 1
#endif

#define GAS __attribute__((address_space(1)))
#define LAS __attribute__((address_space(3)))
typedef unsigned short bf16_t;
typedef short bf16x8 __attribute__((ext_vector_type(8)));
typedef float f32x4 __attribute__((ext_vector_type(4)));
typedef float f32x2 __attribute__((ext_vector_type(2)));
typedef float f32x16 __attribute__((ext_vector_type(16)));
typedef unsigned u32x4 __attribute__((ext_vector_type(4)));
typedef unsigned u32x2 __attribute__((ext_vector_type(2)));
typedef __bf16 bf16x2_t __attribute__((ext_vector_type(2)));

constexpr int NB = 4, TT = 8192, DM = 1024, NLAT = NB * TT, CTXL = 256, NCTX = NB * CTXL, MROWS = NLAT + NCTX;
constexpr int DEPTH = 4;
constexpr int D_CONV = 256, RW_H = 12, RW_K = 64, D_RWKV = 768, RWKV_COLS = 2688, D_IN_EVEN = 3456, D_IN_EVEN_PAD = 3584;
constexpr int D_DIFF = 768, D_GMLP = 256, D_IN_ODD = 2816;
constexpr int NEXP = 16, D_EXP = 2048, CAP_L = 1024, CAP_C = 32, ESLOTS = 4352;
constexpr int P_LD = 3584;
constexpr int LORA_K = 384, LORA_N = 3840;
constexpr int LKEYS = CTXL + TT;
constexpr float ALPHA_DN = 1.6817928305074290f;
constexpr float DECAY_SCALE = 0.6065306597126334f;
constexpr float GN_EPS = 64e-5f, LN_EPS = 1e-5f, RMS_EPS = 1e-5f;
constexpr float QSCALE = 0.125f * 1.4426950408889634f;

constexpr size_t al256(size_t x) { return (x + 255) & ~(size_t)255; }
constexpr size_t WS_CTL = 0;
constexpr size_t CTL_BYTES = 65536;
constexpr size_t WS_MOD = WS_CTL + CTL_BYTES;
constexpr size_t WS_ROPE = WS_MOD + al256((size_t)DEPTH * 5 * 6144 * 4);
constexpr size_t WS_WIN = WS_ROPE + 32768;
constexpr size_t WS_WOUT = WS_WIN + (size_t)D_IN_EVEN_PAD * DM * 2;
constexpr size_t WS_WLORA = WS_WOUT + (size_t)DM * DM * 2;
constexpr size_t WS_WE13 = WS_WLORA + (size_t)LORA_N * LORA_K * 2;
constexpr size_t WE13_BYTES = (size_t)NEXP * 4096 * DM * 2, WE2_BYTES = (size_t)NEXP * DM * D_EXP * 2;
constexpr size_t WS_WE2 = WS_WE13 + 2 * WE13_BYTES;
constexpr size_t WS_X = WS_WE2 + 2 * WE2_BYTES;
constexpr size_t WS_H = WS_X + (size_t)MROWS * DM * 4;
constexpr size_t WS_A2 = WS_H + (size_t)MROWS * DM * 2;
constexpr size_t WS_P = WS_A2 + (size_t)MROWS * DM * 2;
constexpr size_t WS_AFF = WS_P + (size_t)MROWS * P_LD * 2;
constexpr size_t WS_SLOT = WS_AFF + (size_t)MROWS * 16 * 4;
constexpr size_t WS_IDX = WS_SLOT + (size_t)MROWS * 16 * 4;
constexpr size_t WS_GATE = WS_IDX + al256((size_t)NEXP * ESLOTS * 4);
constexpr size_t WS_R2 = WS_GATE + al256((size_t)NEXP * ESLOTS * 4);
constexpr int SC_REC = 1408, SC_ROW = 12 * SC_REC, SC_W = 0, SC_R = 512, SC_KK = 640, SC_V = 768, SC_B = 896, SC_KR = 1024;
constexpr size_t WS_SCN = WS_R2;
constexpr size_t WS_G = WS_SCN + (size_t)MROWS * SC_ROW;
constexpr size_t WS_LIN = WS_G + (size_t)MROWS * 768 * 2;
constexpr int CS_L = 64, CS_NCH = LKEYS / CS_L, CS_UNITS = NB * RW_H * 2;
constexpr size_t WS_CHK = WS_LIN + (size_t)MROWS * 384 * 2;
constexpr size_t WS_EVEN_END = WS_CHK + (size_t)CS_UNITS * CS_NCH * 32768;
constexpr size_t WS_Y = WS_P;
constexpr size_t WS_Q = WS_R2;
constexpr size_t WS_KA = WS_Q + (size_t)MROWS * 768 * 2;
constexpr size_t WS_VT = WS_KA + (size_t)NB * LKEYS * 768 * 2;
constexpr size_t WS_HID = WS_R2;
constexpr size_t WS_YE = WS_HID + (size_t)NEXP * ESLOTS * D_EXP * 2;
constexpr size_t WS_END = WS_EVEN_END;
static_assert(WS_END <= (size_t)2147483648ull, "workspace over 2 GiB");
static_assert((size_t)2 * MROWS * 768 * 4 <= (size_t)MROWS * P_LD * 2, "Y aliases P");
static_assert(WS_YE + (size_t)NEXP * ESLOTS * DM * 2 <= WS_END, "moe region");

constexpr int LDS_BYTES = 147456;
constexpr int LDS_MISC = 140 * 1024;
constexpr int LDS_PTAB = LDS_MISC + 256;
constexpr int NWAVES = 8, NTHR = 512;

__device__ __forceinline__ unsigned f2bf(float f) { unsigned u = __float_as_uint(f); return (u + 0x7fffu + ((u >> 16) & 1u)) >> 16; }
__device__ __forceinline__ unsigned pk2(float lo, float hi) { f32x2 v = {lo, hi}; bf16x2_t b = __builtin_convertvector(v, bf16x2_t); return __builtin_bit_cast(unsigned, b); }
__device__ __forceinline__ float bflo(unsigned u) { return __uint_as_float(u << 16); }
__device__ __forceinline__ float bfhi(unsigned u) { return __uint_as_float(u & 0xffff0000u); }
__device__ __forceinline__ float bf2f(bf16_t b) { return __uint_as_float((unsigned)b << 16); }
__device__ __forceinline__ float sigmoidf_(float x) { return 1.f / (1.f + __expf(-x)); }
__device__ __forceinline__ float wave_sum(float v) {
#pragma unroll
    for (int o = 1; o < 64; o <<= 1) v += __shfl_xor(v, o);
    return v;
}
__device__ __forceinline__ float sum16(float v) {
#pragma unroll
    for (int o = 1; o < 16; o <<= 1) v += __shfl_xor(v, o);
    return v;
}
__device__ __forceinline__ f32x4 ld4bf_(const void* p) { const u32x2 u = *(const u32x2*)p; return (f32x4){bflo(u.x), bfhi(u.x), bflo(u.y), bfhi(u.y)}; }
__device__ __forceinline__ void st4bf_(void* p, f32x4 v) { u32x2 o; o.x = pk2(v[0], v[1]); o.y = pk2(v[2], v[3]); *(u32x2*)p = o; }
__device__ __forceinline__ float max3f(float a, float b, float c) { float r; asm("v_max3_f32 %0, %1, %2, %3" : "=v"(r) : "v"(a), "v"(b), "v"(c)); return r; }
__device__ __forceinline__ int crow(int r, int hi) { return (r & 3) + 8 * (r >> 2) + 4 * hi; }
__device__ __forceinline__ float gelu_erf(float x) { return 0.5f * x * (1.f + erff(x * 0.70710678118654752f)); }

#define XB_TMO      128
#define XB_XCNT(j)  (256  + 64 * (j))
#define XB_XSUB(j)  (1280 + 64 * (j))
#define XB_XGEN(j)  (2304 + 64 * (j))
#define XB_TOP      3328
#define XB_TOPGEN   3392
#define XCD_BAR_WORDS 3456
#define XB_SPIN_CAP (1u << 20)

__device__ __forceinline__ unsigned xb_ld(unsigned* p)              { return __hip_atomic_load(p, __ATOMIC_RELAXED, __HIP_MEMORY_SCOPE_AGENT); }
__device__ __forceinline__ unsigned xb_add(unsigned* p, unsigned v) { return __hip_atomic_fetch_add(p, v, __ATOMIC_RELAXED, __HIP_MEMORY_SCOPE_AGENT); }
__device__ __forceinline__ unsigned xb_xcc_id() { return (unsigned)__builtin_amdgcn_s_getreg((3 << 11) | 20) & 0xFu; }
#define XB_SPIN(cond, bar) do { unsigned _sp = 0; while (cond) { __builtin_amdgcn_s_sleep(1); \
    if ((++_sp & 255u) == 0u) { if (xb_ld(&(bar)[XB_TMO])) break; if (_sp > XB_SPIN_CAP) { atomicAdd(&(bar)[XB_TMO], 1u); break; } } } } while (0)

struct XcdBarrier { unsigned* bar; unsigned x; volatile LAS unsigned* st; };

__device__ __forceinline__ XcdBarrier xcd_barrier_post(unsigned* bar, volatile LAS unsigned* st) {
    XcdBarrier b; b.bar = bar; b.x = xb_xcc_id(); b.st = st;
    if (threadIdx.x == 0) (void)xb_add(&bar[XB_XCNT(b.x)], 1u);
    return b;
}
__device__ __forceinline__ void xcd_barrier_complete(unsigned* bar, unsigned x, unsigned& nloc, unsigned& nx) {
    const unsigned G = gridDim.x * gridDim.y * gridDim.z;
    unsigned sum, cnt, mine, sp = 0u;
    for (;;) {
        sum = 0u; cnt = 0u; mine = 0u;
#pragma unroll
        for (unsigned j = 0; j < 16; ++j) { const unsigned c = xb_ld(&bar[XB_XCNT(j)]); sum += c; cnt += (c > 0u) ? 1u : 0u; mine = (j == x) ? c : mine; }
        if (sum == G) break;
        __builtin_amdgcn_s_sleep(1);
        if ((++sp & 255u) == 0u) { if (xb_ld(&bar[XB_TMO])) break; if (sp > XB_SPIN_CAP) { atomicAdd(&bar[XB_TMO], 1u); break; } }
    }
    nloc = mine > 0u ? mine : 1u; nx = cnt > 0u ? cnt : 1u;
}
__device__ __forceinline__ void xcd_barrier(const XcdBarrier& b) {
    asm volatile("s_waitcnt vmcnt(0)" ::: "memory");
    __syncthreads();
    if (threadIdx.x == 0) {
        unsigned* bar = b.bar;
        __builtin_amdgcn_s_waitcnt(0);
        unsigned nloc = b.st[0], nx = b.st[1];
        if (nloc == 0u) { xcd_barrier_complete(bar, b.x, nloc, nx); b.st[0] = nloc; b.st[1] = nx; }
        const unsigned old = xb_add(&bar[XB_XSUB(b.x)], 1u);
        const unsigned gen = old / nloc;
        if (old + 1u == (gen + 1u) * nloc) {
            __builtin_amdgcn_fence(__ATOMIC_RELEASE, "agent");
            asm volatile("s_waitcnt vmcnt(0)" ::: "memory");
            const unsigned og = xb_add(&bar[XB_TOP], 1u);
            const unsigned tg = og / nx;
            if (og + 1u == (tg + 1u) * nx) xb_add(&bar[XB_TOPGEN], 1u);
            else XB_SPIN(xb_ld(&bar[XB_TOPGEN]) == tg, bar);
            __builtin_amdgcn_fence(__ATOMIC_ACQUIRE, "agent");
            xb_add(&bar[XB_XGEN(b.x)], 1u);
            asm volatile("s_waitcnt vmcnt(0)" ::: "memory");
        } else {
            XB_SPIN(xb_ld(&bar[XB_XGEN(b.x)]) == gen, bar);
            __builtin_amdgcn_fence(__ATOMIC_ACQUIRE, "agent");
            asm volatile("s_waitcnt vmcnt(0)" ::: "memory");
        }
    }
    __syncthreads();
}

namespace pg8 {
constexpr int BM = 256, BK = 64, HALF = 128, HTB = HALF * BK * 2, STAGE_BYTES = 8 * HTB, NXCD = 8, WGM = 8;
__host__ __device__ __forceinline__ int lds_byte(int r, int c) { const int st = (r >> 4) * 2 + (c >> 5), rr = r & 15, cc = c & 31, ob = rr * 64 + cc * 2; return st * 1024 + (ob ^ (((ob >> 9) & 1) << 5)); }
__host__ __device__ __forceinline__ void stage_rc(int b, int& R, int& C) { const int st = b / 1024, sb = b % 1024, swz = sb ^ (((sb >> 9) & 1) << 5); R = (st >> 1) * 16 + swz / 64; C = (st & 1) * 32 + (swz % 64) / 2; }

struct Unit { int pm, pn, hf; };
struct Gemm { const bf16_t* A; const bf16_t* Bt; int K; };

template <int MODE> struct Order {
    static constexpr bool GATHER = (MODE == 1);
    int nM, nN, nwg, G, c; const int* idx; long bstride;
    __device__ __forceinline__ void init(int nM_, int nN_, int G_, int c_, const int* idx_, long bstride_) { nM = nM_; nN = nN_; nwg = nM * nN; G = G_; c = c_; idx = idx_; bstride = bstride_; }
    __device__ __forceinline__ bool next(int i, Unit& u) const {
        const long L = (long)i * G + c; if (L >= nwg) return false;
        int wgid = (int)L; { const int q = nwg / NXCD, r = nwg % NXCD, xcd = wgid % NXCD, off = wgid / NXCD; wgid = (xcd < r ? xcd * (q + 1) : r * (q + 1) + (xcd - r) * q) + off; }
        const int nig = WGM * nN, gid = wgid / nig, fm = gid * WGM, gsz = (nM - fm) < WGM ? (nM - fm) : WGM;
        u.pm = fm + ((wgid % nig) % gsz); u.pn = (wgid % nig) / gsz; u.hf = (MODE != 0 && (u.pm % 17) == 16) ? 1 : 0; return true;
    }
    __device__ __forceinline__ unsigned arow(const Unit& u, int r) const { if (MODE == 1) return (unsigned)idx[u.pm * BM + r]; return (unsigned)(u.pm * BM + r); }
    __device__ __forceinline__ long bbase(const Unit& u, int K) const { long o = (long)u.pn * BM * K; if (MODE != 0) o += (long)(u.pm / 17) * bstride; return o; }
};

template <int MODE> struct OrderExp {
    static constexpr bool GATHER = (MODE == 1);
    int nN, G, c0; const int* idx; long bstride;
    __device__ __forceinline__ void init(int nN_, int G_, int c_, const int* idx_, long bstride_) { nN = nN_; G = G_; c0 = c_; idx = idx_; bstride = bstride_; }
    __device__ __forceinline__ bool next(int i0, Unit& u) const {
        const int v = i0 * G + c0, i = v >> 8, c = v & 255;
        const int x = c & 7, slot = c >> 3, per = 32 / nN, nfull = 256 / (8 * per);
        if (i > nfull) return false;
        if (i < nfull) { u.pn = slot / per; const int f = (i * 8 + x) * per + (slot % per); u.pm = (f >> 4) * 17 + (f & 15); u.hf = 0; return true; }
        if (i == nfull && slot < 2 * nN) { u.pn = slot >> 1; u.pm = (x * 2 + (slot & 1)) * 17 + 16; u.hf = 1; return true; }
        return false;
    }
    __device__ __forceinline__ unsigned arow(const Unit& u, int r) const { if (MODE == 1) return (unsigned)idx[u.pm * BM + r]; return (unsigned)(u.pm * BM + r); }
    __device__ __forceinline__ long bbase(const Unit& u, int K) const { return (long)u.pn * BM * K + (long)(u.pm / 17) * bstride; }
};

template <class Epi, class Sched>
__device__ __forceinline__ void gemm_phase(LAS unsigned char* lds, const Gemm g, const Sched& S, const Epi& E) {
    int tid = threadIdx.x; asm volatile("" : "+v"(tid));
    const int wid = __builtin_amdgcn_readfirstlane(tid >> 6), wr = wid >> 2, wc = wid & 3;
    const int K = g.K, nt = K / BK;
    unsigned voffB[2];
    { const int lane = tid & 63, fr = lane & 15, fq = lane >> 4; (void)fr; (void)fq; }
#pragma unroll
    for (int i = 0; i < 2; ++i) { int R, Cc; stage_rc(tid * 16 + i * 8192, R, Cc); voffB[i] = (unsigned)(R * K + Cc) * 2u; }
    const size_t kstep = (size_t)(BK * 2);
    const size_t hstep = (size_t)HALF * K * 2;
    const unsigned ldsw = (unsigned)wid * 1024u;
    const int aoff = lds_byte(wr * 64 + (tid & 15), ((tid & 63) >> 4) * 8), boff = lds_byte(wc * 32 + (tid & 15), ((tid & 63) >> 4) * 8);
#define PG8_SA(b, h) (((b) * 2 + (h)) * HTB)
#define PG8_SB(b, h) ((4 + (b) * 2 + (h)) * HTB)
#define PG8_STAGE(bufoff, gbase, voff) do { _Pragma("unroll") for (int _i = 0; _i < 2; ++_i) \
        __builtin_amdgcn_global_load_lds((const unsigned*)((const char*)(gbase) + (voff)[_i]), (LAS unsigned*)(lds + (bufoff) + ldsw + _i * 8192), 16, 0, 0); } while (0)
#define PG8_LDA(dst, b, h) do { _Pragma("unroll") for (int m = 0; m < 4; ++m) _Pragma("unroll") for (int k = 0; k < 2; ++k) dst[m][k] = *(const LAS bf16x8*)(lds + PG8_SA(b, h) + aoff + m * 2048 + k * 1024); } while (0)
#define PG8_LDB(dst, b, h) do { _Pragma("unroll") for (int n = 0; n < 2; ++n) _Pragma("unroll") for (int k = 0; k < 2; ++k) dst[n][k] = *(const LAS bf16x8*)(lds + PG8_SB(b, h) + boff + n * 2048 + k * 1024); } while (0)
#define PG8_MMA(ai, bj, At, Bt) do { __builtin_amdgcn_s_setprio(1); _Pragma("unroll") for (int m = 0; m < 4; ++m) _Pragma("unroll") for (int n = 0; n < 2; ++n) _Pragma("unroll") for (int k = 0; k < 2; ++k) \
        acc[ai][bj][m][n] = __builtin_amdgcn_mfma_f32_16x16x32_bf16(Bt[n][k], At[m][k], acc[ai][bj][m][n], 0, 0, 0); __builtin_amdgcn_s_setprio(0); } while (0)
#define PG8_WAIT_V(n) asm volatile("s_waitcnt vmcnt(" #n ")" ::: "memory")
#define PG8_WAIT_L(n) asm volatile("s_waitcnt lgkmcnt(" #n ")" ::: "memory")
#define PG8_BAR __builtin_amdgcn_s_barrier()
#define PG8_SCHED __builtin_amdgcn_sched_barrier(0)
#define PG8_ROWOFFS(dst, u, tq) do { _Pragma("unroll") for (int _i = 0; _i < 2; ++_i) { int _R, _C; stage_rc((tq) * 16 + _i * 8192, _R, _C); _Pragma("unroll") for (int _h = 0; _h < 2; ++_h) dst[_h][_i] = (S.arow(u, _h * HALF + _R) * (unsigned)K + (unsigned)_C) * 2u; } } while (0)
    Unit cur, nxt; int ui = 0;
    if (!S.next(0, cur)) return;
    float zf = 0.f; asm volatile("" : "+v"(zf));
    f32x4 acc[2][2][4][2];
#pragma unroll
    for (int a = 0; a < 2; ++a)
#pragma unroll
        for (int b = 0; b < 2; ++b)
#pragma unroll
            for (int m = 0; m < 4; ++m)
#pragma unroll
                for (int n = 0; n < 2; ++n) acc[a][b][m][n] = (f32x4){zf, zf, zf, zf};
    bf16x8 At[4][2], B0[2][2], B1[2][2];
    unsigned vcur[2][2];
    if constexpr (Sched::GATHER) { PG8_ROWOFFS(vcur, cur, tid); }
    const char* const Ab = (const char*)g.A;
    const char* cA = Sched::GATHER ? Ab : Ab + (size_t)(unsigned)__builtin_amdgcn_readfirstlane((int)S.arow(cur, 0)) * K * 2;
#define PG8_STAGEA(bufoff, ptr, h) do { if constexpr (Sched::GATHER) { PG8_STAGE(bufoff, ptr, vcur[h]); } else { PG8_STAGE(bufoff, (ptr) + (h) * hstep, voffB); } } while (0)
    const char* cB = (const char*)g.Bt + (size_t)S.bbase(cur, K) * 2;
    PG8_STAGE(PG8_SB(0, 0), cB, voffB); PG8_STAGE(PG8_SB(0, 1), cB + hstep, voffB); PG8_STAGEA(PG8_SA(0, 0), cA, 0); PG8_STAGEA(PG8_SA(0, 1), cA, 1);
    if (wr == 1) PG8_BAR;
    PG8_WAIT_V(2); PG8_BAR;
    PG8_STAGE(PG8_SB(1, 0), cB + kstep, voffB); PG8_STAGEA(PG8_SA(1, 0), cA + kstep, 0); PG8_STAGE(PG8_SB(1, 1), cB + hstep + kstep, voffB);
    PG8_WAIT_V(6); PG8_BAR;
    for (;;) {
        const bool has_next = S.next(ui + 1, nxt);
        const char* nB = has_next ? (const char*)g.Bt + (size_t)S.bbase(nxt, K) * 2 : cB;
        const char* nA = (Sched::GATHER || !has_next) ? cA : Ab + (size_t)(unsigned)__builtin_amdgcn_readfirstlane((int)S.arow(nxt, 0)) * K * 2;
#pragma unroll 1
        for (int t = 0; t < nt; t += 2) {
            const bool last = (t == nt - 2);
            const char* a1 = cA + (size_t)(t + 1) * kstep;
            const char* a2 = last ? nA : cA + (size_t)(t + 2) * kstep; const char* b2 = last ? nB : cB + (size_t)(t + 2) * kstep;
            const char* a3 = a2 + kstep; const char* b3 = b2 + kstep;
            PG8_LDB(B0, 0, 0); PG8_LDB(B1, 0, 1); PG8_SCHED; PG8_LDA(At, 0, 0); PG8_STAGEA(PG8_SA(1, 1), a1, 1);
            PG8_WAIT_V(8); PG8_WAIT_L(0); PG8_BAR; PG8_MMA(0, 0, At, B0); PG8_MMA(0, 1, At, B1); PG8_BAR; PG8_SCHED;
            if constexpr (Sched::GATHER) { if (last && has_next) { int tq = tid; asm volatile("" : "+v"(tq)); PG8_ROWOFFS(vcur, nxt, tq); } }
            PG8_LDA(At, 0, 1); PG8_STAGE(PG8_SB(0, 0), b2, voffB); PG8_STAGE(PG8_SB(0, 1), b2 + hstep, voffB); PG8_STAGEA(PG8_SA(0, 0), a2, 0);
            PG8_WAIT_V(8); PG8_WAIT_L(0); PG8_BAR; if (!cur.hf) { PG8_MMA(1, 0, At, B0); PG8_MMA(1, 1, At, B1); } PG8_BAR; PG8_SCHED;
            PG8_LDB(B0, 1, 0); PG8_LDB(B1, 1, 1); PG8_SCHED; PG8_LDA(At, 1, 0); PG8_STAGEA(PG8_SA(0, 1), a2, 1);
            PG8_WAIT_V(8); PG8_WAIT_L(0); PG8_BAR; PG8_MMA(0, 0, At, B0); PG8_MMA(0, 1, At, B1); PG8_BAR; PG8_SCHED;
            PG8_LDA(At, 1, 1); PG8_STAGE(PG8_SB(1, 0), b3, voffB); PG8_STAGE(PG8_SB(1, 1), b3 + hstep, voffB); PG8_STAGEA(PG8_SA(1, 0), a3, 0);
            PG8_WAIT_V(8); PG8_WAIT_L(0); PG8_BAR; if (!cur.hf) { PG8_MMA(1, 0, At, B0); PG8_MMA(1, 1, At, B1); } PG8_BAR; PG8_SCHED;
        }
        if (wr == 0) PG8_BAR;
        { int tz = tid; asm volatile("" : "+v"(tz)); const int ln = tz & 63; E(acc, cur, wr, wc, ln & 15, ln >> 4); }
        if (!has_next) break;
#pragma unroll
        for (int a = 0; a < 2; ++a)
#pragma unroll
            for (int b = 0; b < 2; ++b)
#pragma unroll
                for (int m = 0; m < 4; ++m)
#pragma unroll
                    for (int n = 0; n < 2; ++n) acc[a][b][m][n] = (f32x4){zf, zf, zf, zf};
        cur = nxt; cB = nB; cA = nA; ++ui;
        if (wr == 1) PG8_BAR;
    }
    PG8_WAIT_V(0);
    PG8_BAR;
#undef PG8_SA
#undef PG8_SB
#undef PG8_STAGE
#undef PG8_LDA
#undef PG8_LDB
#undef PG8_MMA
#undef PG8_WAIT_V
#undef PG8_WAIT_L
#undef PG8_BAR
#undef PG8_SCHED
#undef PG8_ROWOFFS
#undef PG8_STAGEA
}

#define EPI_LOOP for (int ai = 0; ai < 2; ++ai) for (int m = 0; m < 4; ++m) for (int bj = 0; bj < 2; ++bj) for (int n = 0; n < 2; ++n)
struct EpiBf16 {
    bf16_t* O; int ldc;
    __device__ __forceinline__ void operator()(const f32x4 (&acc)[2][2][4][2], const Unit& u, int wr, int wc, int fr, int fq) const {
        const int row0 = u.pm * BM + wr * 64 + fr, col0 = u.pn * BM + wc * 32 + 4 * fq;
#pragma unroll
        for (int ai = 0; ai < 2; ++ai)
#pragma unroll
            for (int m = 0; m < 4; ++m) { bf16_t* rowp = O + (size_t)(row0 + ai * HALF + m * 16) * ldc + col0;
#pragma unroll
                for (int bj = 0; bj < 2; ++bj)
#pragma unroll
                    for (int n = 0; n < 2; ++n) { const f32x4 v = acc[ai][bj][m][n]; u32x2 o; o.x = pk2(v[0], v[1]); o.y = pk2(v[2], v[3]); *(u32x2*)(rowp + bj * HALF + n * 16) = o; } }
    }
};
struct EpiOdd {
    bf16_t* P; bf16_t* Q; bf16_t* KA; const float* rope;
    __device__ __forceinline__ void operator()(const f32x4 (&acc)[2][2][4][2], const Unit& u, int wr, int wc, int fr, int fq) const {
        const int row0 = u.pm * BM + wr * 64 + fr, col0 = u.pn * BM + wc * 32 + 4 * fq;
        if (u.pn >= 6) {
#pragma unroll
            for (int ai = 0; ai < 2; ++ai)
#pragma unroll
                for (int m = 0; m < 4; ++m) { bf16_t* rowp = P + (size_t)(row0 + ai * HALF + m * 16) * P_LD + col0;
#pragma unroll
                    for (int bj = 0; bj < 2; ++bj)
#pragma unroll
                        for (int n = 0; n < 2; ++n) { const f32x4 v = acc[ai][bj][m][n]; u32x2 o; o.x = pk2(v[0], v[1]); o.y = pk2(v[2], v[3]); *(u32x2*)(rowp + bj * HALF + n * 16) = o; } }
            return;
        }
        const bool isk = u.pn >= 3, isctx = u.pm >= NLAT / BM; const int axis = wc & 1;
        const int cq = col0 - (isk ? 768 : 0);
#pragma unroll
        for (int ai = 0; ai < 2; ++ai)
#pragma unroll
            for (int m = 0; m < 4; ++m) { const int row = row0 + ai * HALF + m * 16;
                f32x4 cs = {1.f, 1.f, 1.f, 1.f}, sn = {0.f, 0.f, 0.f, 0.f}; size_t orow;
                if (!isctx) { const int t = row & (TT - 1); const int pos = axis ? 128 + (t & 63) : (t >> 6);
                    cs = *(const f32x4*)(rope + pos * 16 + 4 * fq); sn = *(const f32x4*)(rope + 192 * 16 + pos * 16 + 4 * fq);
                    orow = isk ? (size_t)(row >> 13) * LKEYS + CTXL + t : (size_t)row; }
                else { const int rc = row - NLAT; orow = isk ? (size_t)(rc >> 8) * LKEYS + (rc & 255) : (size_t)row; }
                bf16_t* op = (isk ? KA : Q) + orow * 768 + cq; const float sc = isk ? 1.f : QSCALE;
#pragma unroll
                for (int bj = 0; bj < 2; ++bj) { const f32x4 x1 = acc[ai][bj][m][0], x2 = acc[ai][bj][m][1];
                    const f32x4 o1 = (x1 * cs - x2 * sn) * sc, o2 = (x1 * sn + x2 * cs) * sc;
                    u32x2 a; a.x = pk2(o1[0], o1[1]); a.y = pk2(o1[2], o1[3]); *(u32x2*)(op + bj * HALF) = a;
                    u32x2 b; b.x = pk2(o2[0], o2[1]); b.y = pk2(o2[2], o2[3]); *(u32x2*)(op + bj * HALF + 16) = b; } }
    }
};
struct EpiRes {
    float* X; const float* modl;
    __device__ __forceinline__ void operator()(const f32x4 (&acc)[2][2][4][2], const Unit& u, int wr, int wc, int fr, int fq) const {
        const int row0 = u.pm * BM + wr * 64 + fr, col0 = u.pn * BM + wc * 32 + 4 * fq;
        const int mi = (u.pm * BM < NLAT) ? (u.pm * BM) / TT : 4;
        const float* gate = modl + mi * 6144 + 2 * DM;
        f32x4 gv[2][2];
#pragma unroll
        for (int bj = 0; bj < 2; ++bj)
#pragma unroll
            for (int n = 0; n < 2; ++n) gv[bj][n] = *(const f32x4*)(gate + col0 + bj * HALF + n * 16);
#pragma unroll
        for (int ai = 0; ai < 2; ++ai)
#pragma unroll
            for (int m = 0; m < 4; ++m) { float* rowp = X + (size_t)(row0 + ai * HALF + m * 16) * DM + col0;
#pragma unroll
                for (int bj = 0; bj < 2; ++bj)
#pragma unroll
                    for (int n = 0; n < 2; ++n) { f32x4* p = (f32x4*)(rowp + bj * HALF + n * 16); const f32x4 x = *p; *p = x * ALPHA_DN + gv[bj][n] * acc[ai][bj][m][n]; } }
    }
};
struct EpiSwiGLU {
    bf16_t* HID;
    __device__ __forceinline__ void operator()(const f32x4 (&acc)[2][2][4][2], const Unit& u, int wr, int wc, int fr, int fq) const {
        const int row0 = u.pm * BM + wr * 64 + fr, f0 = u.pn * HALF + wc * 32 + 4 * fq;
#pragma unroll
        for (int ai = 0; ai < 2; ++ai) if (ai == 0 || !u.hf)
#pragma unroll
            for (int m = 0; m < 4; ++m) { bf16_t* rowp = HID + (size_t)(row0 + ai * HALF + m * 16) * D_EXP + f0;
#pragma unroll
                for (int n = 0; n < 2; ++n) { const f32x4 a = acc[ai][0][m][n], b = acc[ai][1][m][n]; float h[4];
#pragma unroll
                    for (int j = 0; j < 4; ++j) h[j] = a[j] / (1.f + __expf(-a[j])) * b[j];
                    u32x2 o; o.x = pk2(h[0], h[1]); o.y = pk2(h[2], h[3]); *(u32x2*)(rowp + n * 16) = o; } }
    }
};
struct EpiYE {
    bf16_t* YE; const float* gate;
    __device__ __forceinline__ void operator()(const f32x4 (&acc)[2][2][4][2], const Unit& u, int wr, int wc, int fr, int fq) const {
        const int row0 = u.pm * BM + wr * 64 + fr, col0 = u.pn * BM + wc * 32 + 4 * fq;
        float gts[2][4];
#pragma unroll
        for (int ai = 0; ai < 2; ++ai)
#pragma unroll
            for (int m = 0; m < 4; ++m) gts[ai][m] = gate[row0 + ai * HALF + m * 16];
#pragma unroll
        for (int ai = 0; ai < 2; ++ai) if (ai == 0 || !u.hf)
#pragma unroll
            for (int m = 0; m < 4; ++m) { const int row = row0 + ai * HALF + m * 16; const float gt = gts[ai][m]; bf16_t* rowp = YE + (size_t)row * DM + col0;
#pragma unroll
                for (int bj = 0; bj < 2; ++bj)
#pragma unroll
                    for (int n = 0; n < 2; ++n) { const f32x4 v = acc[ai][bj][m][n] * gt; u32x2 o; o.x = pk2(v[0], v[1]); o.y = pk2(v[2], v[3]); *(u32x2*)(rowp + bj * HALF + n * 16) = o; } }
    }
};
struct EpiLora {
    unsigned char* SCN; bf16_t* G; const float* decay0; const float* a0; const float* kalpha;
    __device__ __forceinline__ void operator()(const f32x4 (&acc)[2][2][4][2], const Unit& u, int wr, int wc, int fr, int fq) const {
        const int row0 = u.pm * BM + wr * 64 + fr;
        const int seg = u.pn / 3, cb = (u.pn % 3) * BM + wc * 32 + 4 * fq;
#pragma unroll
        for (int bj = 0; bj < 2; ++bj)
#pragma unroll
            for (int n = 0; n < 2; ++n) {
                const int col = cb + bj * HALF + n * 16, head = col >> 6, kx = col & 63;
                if (seg < 2) {
                    const f32x4 d0 = *(const f32x4*)(decay0 + seg * 768 + col);
#pragma unroll
                    for (int ai = 0; ai < 2; ++ai)
#pragma unroll
                        for (int m = 0; m < 4; ++m) { const int row = row0 + ai * HALF + m * 16; f32x4 w;
#pragma unroll
                            for (int j = 0; j < 4; ++j) { const float lw = -DECAY_SCALE * sigmoidf_(d0[j] + acc[ai][bj][m][n][j]); w[j] = CHUNKED_SCAN ? lw : __expf(lw); }
                            *(f32x4*)(SCN + (size_t)(row * 12 + head) * SC_REC + SC_W + seg * 256 + kx * 4) = w; __builtin_amdgcn_sched_barrier(0); }
                } else if (seg < 4) {
                    const int d = seg - 2;
                    const f32x4 a00 = *(const f32x4*)(a0 + d * 768 + col), kal = *(const f32x4*)(kalpha + col);
                    u32x2 kkr[2][4], ksr[2][4];
#pragma unroll
                    for (int ai = 0; ai < 2; ++ai)
#pragma unroll
                        for (int m = 0; m < 4; ++m) { const unsigned char* base = SCN + (size_t)((row0 + ai * HALF + m * 16) * 12 + head) * SC_REC + kx * 2;
                            kkr[ai][m] = *(const u32x2*)(base + SC_KK); ksr[ai][m] = *(const u32x2*)(base + SC_KR + 256 * d); }
#pragma unroll
                    for (int ai = 0; ai < 2; ++ai)
#pragma unroll
                        for (int m = 0; m < 4; ++m) { const int row = row0 + ai * HALF + m * 16; unsigned char* base = SCN + (size_t)(row * 12 + head) * SC_REC + kx * 2;
                            const f32x4 kk = {bflo(kkr[ai][m].x), bfhi(kkr[ai][m].x), bflo(kkr[ai][m].y), bfhi(kkr[ai][m].y)}; const f32x4 ks = {bflo(ksr[ai][m].x), bfhi(ksr[ai][m].x), bflo(ksr[ai][m].y), bfhi(ksr[ai][m].y)}; f32x4 bb, kr;
#pragma unroll
                            for (int j = 0; j < 4; ++j) { const float a = sigmoidf_(a00[j] + acc[ai][bj][m][n][j]); bb[j] = kk[j] * a; kr[j] = ks[j] * (1.f + (a - 1.f) * kal[j]); }
                            st4bf_(base + SC_B + 256 * d, bb); st4bf_(base + SC_KR + 256 * d, kr); __builtin_amdgcn_sched_barrier(0); }
                } else {
#pragma unroll
                    for (int ai = 0; ai < 2; ++ai)
#pragma unroll
                        for (int m = 0; m < 4; ++m) { const int row = row0 + ai * HALF + m * 16; const f32x4 v = acc[ai][bj][m][n]; u32x2 o; o.x = pk2(v[0], v[1]); o.y = pk2(v[2], v[3]);
                            *(u32x2*)(G + (size_t)row * 768 + col) = o; }
                }
            }
    }
};
}

struct Args { const float* in[37]; float* out; unsigned char* ws; int lo, hi; };
enum { I_X = 0, I_C, I_CTX, I_CCTX, I_WMOD, I_BMOD, I_LNG, I_LNB, I_EWIN, I_EWOUT, I_CONVW, I_MU, I_DUP, I_D0, I_AUP, I_A0, I_GUP, I_KXI, I_KAL, I_RBON, I_GNG, I_GNB,
       I_OWIN, I_OWOUT, I_LQ1, I_LK1, I_LQ2, I_LK2, I_SUBG, I_GLNG, I_GLNB, I_GWS, I_GBS, I_WR, I_WE1, I_WE3, I_WE2 };

struct Ctx {
    LAS unsigned char* lds;
    int tid, lane, wave, G, vcu, gw, NGW;
};
__device__ __forceinline__ void mkctx(Ctx& C, LAS unsigned char* lds) {
    int tid = threadIdx.x; asm volatile("" : "+v"(tid));
    C.lds = lds; C.tid = tid; C.lane = tid & 63; C.wave = __builtin_amdgcn_readfirstlane(tid >> 6);
    C.G = gridDim.x; { const int bx = blockIdx.x; C.vcu = (C.G % 8 == 0) ? (bx % 8) * (C.G / 8) + bx / 8 : bx; }
    C.gw = blockIdx.x * NWAVES + C.wave; C.NGW = C.G * NWAVES;
}
__device__ __forceinline__ void ldargs(Args& A, LAS unsigned char* lds) {
    LAS const u32x2* tb = (LAS const u32x2*)(lds + LDS_PTAB); asm volatile("" : "+v"(tb));
#pragma unroll
    for (int i = 0; i < 37; ++i) { const u32x2 v = tb[i]; A.in[i] = (const float*)(((unsigned long long)(unsigned)__builtin_amdgcn_readfirstlane((int)v.y) << 32) | (unsigned)__builtin_amdgcn_readfirstlane((int)v.x)); }
    { const u32x2 v = tb[37]; A.out = (float*)(((unsigned long long)(unsigned)__builtin_amdgcn_readfirstlane((int)v.y) << 32) | (unsigned)__builtin_amdgcn_readfirstlane((int)v.x)); }
    { const u32x2 v = tb[38]; A.ws = (unsigned char*)(((unsigned long long)(unsigned)__builtin_amdgcn_readfirstlane((int)v.y) << 32) | (unsigned)__builtin_amdgcn_readfirstlane((int)v.x)); }
    A.lo = 0; A.hi = 0;
}
__device__ __forceinline__ int row_mi(int row) { return row < NLAT ? (row >> 13) : 4; }

__device__ __forceinline__ void phase_init(const Ctx& C, const Args& A) {
    unsigned char* ws = A.ws;
    float* MOD = (float*)(ws + WS_MOD);
    LAS float* sv = (LAS float*)C.lds;
    LAS float* red = sv + 5 * 1024;
    for (int i = C.tid; i < 5 * 1024; i += NTHR) { const int v = i >> 10, k = i & 1023; const float c = (v < 4) ? A.in[I_C][v * DM + k] : A.in[I_CCTX][k]; sv[i] = c / (1.f + __expf(-c)); }
    __syncthreads();
    const int j = C.tid & 127, kp = C.tid >> 7;
    for (int it = blockIdx.x; it < DEPTH * 48; it += C.G) {
        const int l = it / 48, cg = it % 48, col = cg * 128 + j;
        const float* W = A.in[I_WMOD] + (size_t)l * DM * 6144 + col;
        float a0 = 0.f, a1 = 0.f, a2 = 0.f, a3 = 0.f, a4 = 0.f;
#pragma unroll 4
        for (int k = kp * 256; k < kp * 256 + 256; ++k) { const float w = W[(size_t)k * 6144]; a0 += sv[k] * w; a1 += sv[1024 + k] * w; a2 += sv[2048 + k] * w; a3 += sv[3072 + k] * w; a4 += sv[4096 + k] * w; }
        red[(kp * 5 + 0) * 128 + j] = a0; red[(kp * 5 + 1) * 128 + j] = a1; red[(kp * 5 + 2) * 128 + j] = a2; red[(kp * 5 + 3) * 128 + j] = a3; red[(kp * 5 + 4) * 128 + j] = a4;
        __syncthreads();
        for (int o = C.tid; o < 5 * 128; o += NTHR) { const int v = o >> 7, jj = o & 127; const int cc = cg * 128 + jj;
            const float s = red[(0 * 5 + v) * 128 + jj] + red[(1 * 5 + v) * 128 + jj] + red[(2 * 5 + v) * 128 + jj] + red[(3 * 5 + v) * 128 + jj];
            MOD[((size_t)l * 5 + v) * 6144 + cc] = s + A.in[I_BMOD][l * 6144 + cc]; }
        __syncthreads();
    }
    if (blockIdx.x == C.G - 1) { float* rope = (float*)(ws + WS_ROPE);
        for (int i = C.tid; i < 192 * 16; i += NTHR) { const int pos = i >> 4, j = i & 15; const float ang = (float)(pos < 128 ? pos : pos - 128) * powf(10000.f, -(float)j * (1.f / 16.f));
            rope[i] = cosf(ang); rope[192 * 16 + i] = sinf(ang); } }
    f32x4* X4 = (f32x4*)(ws + WS_X);
    const f32x4* x4 = (const f32x4*)A.in[I_X]; const f32x4* c4 = (const f32x4*)A.in[I_CTX];
    const size_t nl = (size_t)NLAT * DM / 4, nc = (size_t)NCTX * DM / 4;
    for (size_t i = (size_t)blockIdx.x * NTHR + C.tid; i < nl + nc; i += (size_t)C.G * NTHR) X4[i] = (i < nl) ? x4[i] : c4[i - nl];
}

__device__ __forceinline__ void transpose_item(const float* W, int ldw, int k0, int n0, bf16_t* WT, int ldt, int drow0, LAS float* scr, int lane) {
    { float v[64]; const float* src = W + (size_t)k0 * ldw + n0 + lane;
#pragma unroll
      for (int k = 0; k < 64; ++k) v[k] = __builtin_nontemporal_load(src + (size_t)k * ldw);
#pragma unroll
      for (int k = 0; k < 64; ++k) scr[k * 65 + lane] = v[k]; }
    asm volatile("s_waitcnt lgkmcnt(0)" ::: "memory");
    const int c = lane & 7;
#pragma unroll
    for (int j = 0; j < 8; ++j) { const int n = (lane >> 3) + 8 * j; const LAS float* s = scr + (8 * c) * 65 + n;
        u32x4 o; o.x = pk2(s[0 * 65], s[1 * 65]); o.y = pk2(s[2 * 65], s[3 * 65]); o.z = pk2(s[4 * 65], s[5 * 65]); o.w = pk2(s[6 * 65], s[7 * 65]);
        *(u32x4*)(WT + (size_t)(drow0 + n) * ldt + k0 + 8 * c) = o; }
    asm volatile("s_waitcnt lgkmcnt(0)" ::: "memory");
}
__device__ __forceinline__ void conv_items(const Ctx& C, const Args& A, int l, int gw, int NGW, bool do_in, bool do_out, bool do_exp) {
    unsigned char* ws = A.ws;
    const int i2 = l >> 1; const bool odd = (l & 1);
    LAS float* scr = (LAS float*)C.lds + C.wave * (64 * 65);
    bf16_t* WIN = (bf16_t*)(ws + WS_WIN); bf16_t* WOUT = (bf16_t*)(ws + WS_WOUT); bf16_t* WE13 = (bf16_t*)(ws + WS_WE13 + (size_t)(l & 1) * WE13_BYTES); bf16_t* WE2 = (bf16_t*)(ws + WS_WE2 + (size_t)(l & 1) * WE2_BYTES);
    const int nin = odd ? D_IN_ODD : D_IN_EVEN;
    const float* win = odd ? A.in[I_OWIN] + (size_t)i2 * DM * D_IN_ODD : A.in[I_EWIN] + (size_t)i2 * DM * D_IN_EVEN;
    const float* wout = odd ? A.in[I_OWOUT] + (size_t)i2 * DM * DM : A.in[I_EWOUT] + (size_t)i2 * DM * DM;
    const int n_in = do_in ? 16 * (nin / 64) : 0, n_out = do_out ? 16 * 16 : 0, n_e13 = do_exp ? NEXP * 2 * 16 * 32 : 0, n_e2 = do_exp ? NEXP * 32 * 16 : 0;
    const int total = n_in + n_out + n_e13 + n_e2;
    for (int it = gw; it < total; it += NGW) {
        int r = it;
        if (r < n_in) { const int nb = nin / 64, kb = r / nb, nn = r % nb; transpose_item(win, nin, kb * 64, nn * 64, WIN, DM, nn * 64, scr, C.lane); continue; } r -= n_in;
        if (r < n_out) { const int kb = r / 16, nn = r % 16; transpose_item(wout, DM, kb * 64, nn * 64, WOUT, DM, nn * 64, scr, C.lane); continue; } r -= n_out;
        if (r < n_e13) { const int e = r / 1024, q = r % 1024, mat = q / 512, q2 = q % 512, kb = q2 / 32, nn = q2 % 32;
            const float* W = (mat ? A.in[I_WE3] : A.in[I_WE1]) + ((size_t)l * NEXP + e) * DM * D_EXP;
            const int f0 = nn * 64; const int drow = (f0 >> 7) * 256 + mat * 128 + (f0 & 127);
            transpose_item(W, D_EXP, kb * 64, f0, WE13 + (size_t)e * 4096 * DM, DM, drow, scr, C.lane); continue; } r -= n_e13;
        { const int e = r / 512, q = r % 512, kb = q / 16, nn = q % 16;
            const float* W = A.in[I_WE2] + ((size_t)l * NEXP + e) * D_EXP * DM;
            transpose_item(W, DM, kb * 64, nn * 64, WE2 + (size_t)e * DM * D_EXP, D_EXP, nn * 64, scr, C.lane); }
    }
}
__device__ __forceinline__ void phase_conv(const Ctx& C, const Args& A, int l) {
    unsigned char* ws = A.ws;
    const int i2 = l >> 1; const bool odd = (l & 1);
    bf16_t* WIN = (bf16_t*)(ws + WS_WIN);
    const bool early = CHUNKED_SCAN && odd;
    conv_items(C, A, l, C.gw, C.NGW, !early, true, !early);
    if (!odd) {
        u32x4* z = (u32x4*)(WIN + (size_t)D_IN_EVEN * DM);
        unsigned zz = 0u; asm volatile("" : "+v"(zz));
        for (int i = blockIdx.x * NTHR + C.tid; i < (D_IN_EVEN_PAD - D_IN_EVEN) * DM / 8; i += C.G * NTHR) z[i] = (u32x4){zz, zz, zz, zz};
        bf16_t* WL = (bf16_t*)(ws + WS_WLORA);
        const float* dup = A.in[I_DUP] + (size_t)i2 * 2 * 64 * 768; const float* aup = A.in[I_AUP] + (size_t)i2 * 2 * 64 * 768; const float* gup = A.in[I_GUP] + (size_t)i2 * 128 * 768;
        for (int i = blockIdx.x * NTHR + C.tid; i < LORA_N * LORA_K; i += C.G * NTHR) {
            const int kk = i / LORA_N, n = i % LORA_N, seg = n / 768, col = n % 768; float v = 0.f;
            if (seg == 0) { if (kk < 64) v = dup[(size_t)(0 * 64 + kk) * 768 + col]; }
            else if (seg == 1) { if (kk >= 64 && kk < 128) v = dup[(size_t)(1 * 64 + kk - 64) * 768 + col]; }
            else if (seg == 2) { if (kk >= 128 && kk < 192) v = aup[(size_t)(0 * 64 + kk - 128) * 768 + col]; }
            else if (seg == 3) { if (kk >= 192 && kk < 256) v = aup[(size_t)(1 * 64 + kk - 192) * 768 + col]; }
            else { if (kk >= 256) v = gup[(size_t)(kk - 256) * 768 + col]; }
            WL[(size_t)n * LORA_K + kk] = (bf16_t)f2bf(v);
        }
    }
}

__device__ __forceinline__ void phase_modh(const Ctx& C, const Args& A, int l) {
    const float* X = (const float*)(A.ws + WS_X); bf16_t* H = (bf16_t*)(A.ws + WS_H); const float* MOD = (const float*)(A.ws + WS_MOD) + (size_t)l * 5 * 6144;
    for (int row = C.gw; row < MROWS; row += C.NGW) {
        const float* md = MOD + row_mi(row) * 6144;
#pragma unroll
        for (int j = 0; j < 4; ++j) { const int col = 4 * C.lane + 256 * j; const f32x4 x = *(const f32x4*)(X + (size_t)row * DM + col), sh = *(const f32x4*)(md + col), sc = *(const f32x4*)(md + DM + col);
            const f32x4 h = x * (sc + 1.f) + sh; u32x2 o; o.x = pk2(h[0], h[1]); o.y = pk2(h[2], h[3]); *(u32x2*)(H + (size_t)row * DM + col) = o; }
    }
}

__device__ __forceinline__ f32x4 ld4bf(const bf16_t* p) { const u32x2 u = *(const u32x2*)p; return (f32x4){bflo(u.x), bfhi(u.x), bflo(u.y), bfhi(u.y)}; }
__device__ __forceinline__ void st4bf(bf16_t* p, f32x4 v) { u32x2 o; o.x = pk2(v[0], v[1]); o.y = pk2(v[2], v[3]); *(u32x2*)p = o; }
__device__ __forceinline__ void seq_info(int row, bool& hasp, bool& hasn) {
    if (row < NLAT) { const int t = row & (TT - 1); hasp = t > 0; hasn = t < TT - 1; }
    else { const int t = (row - NLAT) & (CTXL - 1); hasp = t > 0; hasn = t < CTXL - 1; }
}
__device__ __forceinline__ void phase_ef1(const Ctx& C, const Args& A, int l) {
    const int i2 = l >> 1; unsigned char* ws = A.ws;
    const bf16_t* P = (const bf16_t*)(ws + WS_P); bf16_t* A2 = (bf16_t*)(ws + WS_A2); unsigned char* SCN = ws + WS_SCN; bf16_t* LIN = (bf16_t*)(ws + WS_LIN);
    const float* cw = A.in[I_CONVW] + (size_t)i2 * 3 * 256; const float* mu = A.in[I_MU] + (size_t)i2 * RWKV_COLS; const float* kxi = A.in[I_KXI] + (size_t)i2 * 768;
    const f32x4 z4 = {0.f, 0.f, 0.f, 0.f};
    for (int row = C.gw; row < MROWS; row += C.NGW) {
        bool hasp, hasn; seq_info(row, hasp, hasn);
        const bf16_t* p0 = P + (size_t)row * P_LD; const bf16_t* pm = p0 - P_LD; const bf16_t* pp = p0 + P_LD;
        {
            const int j4 = 4 * C.lane;
            const f32x4 bg = ld4bf(p0 + j4), u0 = ld4bf(p0 + 256 + j4) * ld4bf(p0 + 512 + j4);
            const f32x4 um = hasp ? ld4bf(pm + 256 + j4) * ld4bf(pm + 512 + j4) : z4, up = hasn ? ld4bf(pp + 256 + j4) * ld4bf(pp + 512 + j4) : z4;
            const f32x4 w0 = *(const f32x4*)(cw + j4), w1 = *(const f32x4*)(cw + 256 + j4), w2 = *(const f32x4*)(cw + 512 + j4);
            st4bf(A2 + (size_t)row * DM + j4, bg * (w0 * um + w1 * u0 + w2 * up));
        }
#pragma unroll
        for (int it = 0; it < 11; ++it) {
            const int c = it * 256 + 4 * C.lane;
            if (c < RWKV_COLS) {
                const f32x4 x0 = ld4bf(p0 + 768 + c), xm = hasp ? ld4bf(pm + 768 + c) : z4, xp = hasn ? ld4bf(pp + 768 + c) : z4, m4 = *(const f32x4*)(mu + c);
                const f32x4 ps = x0 + m4 * ((xm + xp) * 0.5f - x0);
                if (it < 3) { const int head = c >> 6, kx = c & 63; st4bf_(SCN + (size_t)(row * 12 + head) * SC_REC + SC_R + kx * 2, ps); }
                else if (it < 6) { const int c1 = c - 768, head = c1 >> 6, kx = c1 & 63; const f32x4 kv = ps * *(const f32x4*)(kxi + c1);
                    const float ss = sum16(kv[0] * kv[0] + kv[1] * kv[1] + kv[2] * kv[2] + kv[3] * kv[3]); const float rn = rsqrtf(ss + 1e-12f);
                    unsigned char* base = SCN + (size_t)(row * 12 + head) * SC_REC + kx * 2;
                    st4bf_(base + SC_KK, kv * rn); st4bf_(base + SC_KR, ps); st4bf_(base + SC_KR + 256, ps); }
                else if (it < 9) { const int c1 = c - 1536, head = c1 >> 6, kx = c1 & 63; st4bf_(SCN + (size_t)(row * 12 + head) * SC_REC + SC_V + kx * 2, ps); }
                else { const int c1 = c - 2304; f32x4 o;
                    if (c1 < 128) { o = (f32x4){tanhf(ps[0]), tanhf(ps[1]), tanhf(ps[2]), tanhf(ps[3])}; }
                    else if (c1 < 256) { o = ps; }
                    else { o = (f32x4){sigmoidf_(ps[0]), sigmoidf_(ps[1]), sigmoidf_(ps[2]), sigmoidf_(ps[3])}; }
                    st4bf(LIN + (size_t)row * LORA_K + c1, o); }
            }
        }
    }
}

__device__ __forceinline__ int scan_row(int i, int b, int d) {
    if (d == 0) return i < CTXL ? NLAT + b * CTXL + i : b * TT + (i - CTXL);
    return i < CTXL ? NLAT + b * CTXL + (CTXL - 1 - i) : b * TT + (TT - 1 - (i - CTXL));
}
__device__ __forceinline__ float red8(float v) {
    v += __uint_as_float((unsigned)__builtin_amdgcn_update_dpp(0, (int)__float_as_uint(v), 0xB1, 0xF, 0xF, true));
    v += __uint_as_float((unsigned)__builtin_amdgcn_update_dpp(0, (int)__float_as_uint(v), 0x4E, 0xF, 0xF, true));
    v += __uint_as_float((unsigned)__builtin_amdgcn_update_dpp(0, (int)__float_as_uint(v), 0x141, 0xF, 0xF, true));
    return v;
}
__device__ __forceinline__ float red16(float v) {
    v += __uint_as_float((unsigned)__builtin_amdgcn_update_dpp(0, (int)__float_as_uint(v), 0xB1, 0xF, 0xF, true));
    v += __uint_as_float((unsigned)__builtin_amdgcn_update_dpp(0, (int)__float_as_uint(v), 0x4E, 0xF, 0xF, true));
    v += __uint_as_float((unsigned)__builtin_amdgcn_update_dpp(0, (int)__float_as_uint(v), 0x141, 0xF, 0xF, true));
    v += __uint_as_float((unsigned)__builtin_amdgcn_update_dpp(0, (int)__float_as_uint(v), 0x140, 0xF, 0xF, true));
    return v;
}
__device__ __forceinline__ void phase_scan(const Ctx& C, const Args& A) {
    for (int u = blockIdx.x; u < 192; u += C.G) {
    const int half = u & 1, d = (u >> 1) & 1, h = (u >> 2) % 12, b = u / 48;
    const unsigned char* SCN = A.ws + WS_SCN; float* Y = (float*)(A.ws + WS_Y) + (size_t)d * MROWS * 768;
    LAS float* buf = (LAS float*)C.lds; LAS float* ybuf = buf + 2 * 32 * 352;
    constexpr int NCH = LKEYS / 32;
    u32x4 st[4];
    int ps_[4], psrc[4], pdst[4]; bool pf32[4];
#pragma unroll
    for (int j = 0; j < 4; ++j) { const int p = C.tid + NTHR * j; const int s = p / 52, q = p % 52; ps_[j] = s;
        if (q < 16) { psrc[j] = SC_W + 256 * d + q * 16; pdst[j] = s * 352 + q * 4; pf32[j] = true; }
        else if (q < 48) { const int vec = (q - 16) >> 3, part = (q - 16) & 7; const int so = vec == 0 ? SC_KK : vec == 1 ? SC_B + 256 * d : vec == 2 ? SC_KR + 256 * d : SC_R;
            psrc[j] = so + part * 16; pdst[j] = s * 352 + 64 * (vec + 1) + part * 8; pf32[j] = false; }
        else { const int part = q - 48; psrc[j] = SC_V + half * 64 + part * 16; pdst[j] = s * 352 + 320 + part * 8; pf32[j] = false; } }
    const int sgn = d ? -1 : 1;
    const unsigned char* SCNh = SCN + (size_t)h * SC_REC;
#define SCAN_ROW0(c) (((c) * 32 < CTXL) ? (NLAT + b * CTXL + (d ? CTXL - 1 - (c) * 32 : (c) * 32)) : (b * TT + (d ? TT - 1 - ((c) * 32 - CTXL) : (c) * 32 - CTXL)))
#define SCAN_LOADG(c) do { const int row0_ = SCAN_ROW0(c); _Pragma("unroll") for (int j = 0; j < 4; ++j) if (j < 3 || C.tid < 1664 - 3 * NTHR) { \
        st[j] = *(const u32x4*)(SCNh + (size_t)(row0_ + sgn * ps_[j]) * SC_ROW + psrc[j]); } } while (0)
#define SCAN_STORE(bi) do { _Pragma("unroll") for (int j = 0; j < 4; ++j) if (j < 3 || C.tid < 1664 - 3 * NTHR) { LAS float* dp = buf + (bi) * (32 * 352) + pdst[j]; \
        if (pf32[j]) *(LAS u32x4*)dp = st[j]; \
        else { *(LAS f32x4*)dp = (f32x4){bflo(st[j].x), bfhi(st[j].x), bflo(st[j].y), bfhi(st[j].y)}; *(LAS f32x4*)(dp + 4) = (f32x4){bflo(st[j].z), bfhi(st[j].z), bflo(st[j].w), bfhi(st[j].w)}; } } } while (0)
    SCAN_LOADG(0); SCAN_STORE(0); __syncthreads();
    f32x2 Sa = {0.f, 0.f}, Sb = {0.f, 0.f};
    const int rl = C.lane >> 4, ks = C.lane & 15;
    float ycol = 0.f;
#define SC_LD(R, s) do { const LAS float* bp_ = cur + (s) * 352 + ks * 4; \
        R##w = *(const LAS f32x4*)(bp_); R##k = *(const LAS f32x4*)(bp_ + 64); R##b = *(const LAS f32x4*)(bp_ + 128); R##q = *(const LAS f32x4*)(bp_ + 192); R##r = *(const LAS f32x4*)(bp_ + 256); \
        R##vv = cur[(s) * 352 + 320 + C.wave * 4 + rl]; } while (0)
#define SC_LO(v) ((f32x2){v[0], v[1]})
#define SC_HI(v) ((f32x2){v[2], v[3]})
#define SC_DPP(x, ctrl) __uint_as_float((unsigned)__builtin_amdgcn_update_dpp(0, (int)__float_as_uint(x), ctrl, 0xF, 0xF, true))
#define SC_STEP(R, P, s) do { \
        f32x2 pa = __builtin_elementwise_fma(Sb, SC_HI(R##k), Sa * SC_LO(R##k)), py = __builtin_elementwise_fma(Sb, SC_HI(P##r), Sa * SC_LO(P##r)); \
        float a_ = pa.x + pa.y, y_ = py.x + py.y; \
        a_ += SC_DPP(a_, 0xB1); y_ += SC_DPP(y_, 0xB1); a_ += SC_DPP(a_, 0x4E); y_ += SC_DPP(y_, 0x4E); \
        a_ += SC_DPP(a_, 0x141); y_ += SC_DPP(y_, 0x141); a_ += SC_DPP(a_, 0x140); y_ += SC_DPP(y_, 0x140); \
        ycol = (ks == ((s) & 15)) ? y_ : ycol; \
        const f32x2 na = {-a_, -a_}, vv2 = {R##vv, R##vv}; \
        Sa = __builtin_elementwise_fma(Sa, SC_LO(R##w), __builtin_elementwise_fma(na, SC_LO(R##b), vv2 * SC_LO(R##q))); \
        Sb = __builtin_elementwise_fma(Sb, SC_HI(R##w), __builtin_elementwise_fma(na, SC_HI(R##b), vv2 * SC_HI(R##q))); } while (0)
    f32x4 Aw, Ak, Ab, Aq, Ar, Bw, Bk, Bb, Bq, Br, Cw, Ck, Cb, Cq, Cr, Dw, Dk, Db, Dq, Dr; float Avv, Bvv, Cvv, Dvv;
    Dr = (f32x4){0.f, 0.f, 0.f, 0.f};
    for (int c = 0; c < NCH; ++c) {
        if (c + 1 < NCH) SCAN_LOADG(c + 1);
        {
            const LAS float* cur = buf + (c & 1) * (32 * 352);
            LAS float* yb = ybuf + (c & 1) * 1024 + C.wave * 4 + rl + ks * 32;
            SC_LD(A, 0); SC_LD(B, 1);
#pragma unroll 1
            for (int s = 0; s < 32; s += 4) {
                SC_LD(C, s + 2); __builtin_amdgcn_sched_barrier(0); SC_STEP(A, D, s); __builtin_amdgcn_sched_barrier(0);
                SC_LD(D, s + 3); __builtin_amdgcn_sched_barrier(0); SC_STEP(B, A, s + 1); __builtin_amdgcn_sched_barrier(0);
                SC_LD(A, s + 4); __builtin_amdgcn_sched_barrier(0); SC_STEP(C, B, s + 2); __builtin_amdgcn_sched_barrier(0);
                SC_LD(B, s + 5); __builtin_amdgcn_sched_barrier(0); SC_STEP(D, C, s + 3); __builtin_amdgcn_sched_barrier(0);
                if ((s & 15) == 12) yb[(s & 16) * 32] = ycol;
            }
        }
        if (c + 1 < NCH) SCAN_STORE((c + 1) & 1);
        __syncthreads();
        { const int row0_ = SCAN_ROW0(c);
#pragma unroll
          for (int i = 0; i < 2; ++i) { const int e = C.tid + NTHR * i, s = e >> 5, r = e & 31;
            const int row = (s > 0) ? row0_ + sgn * (s - 1) : scan_row(c * 32 - 1, b, d);
            if (s > 0 || c > 0) Y[(size_t)row * 768 + h * 64 + half * 32 + r] = ybuf[(c & 1) * 1024 + e]; } }
    }
    {
        f32x2 py = __builtin_elementwise_fma(Sb, SC_HI(Dr), Sa * SC_LO(Dr)); float y_ = py.x + py.y;
        y_ += SC_DPP(y_, 0xB1); y_ += SC_DPP(y_, 0x4E); y_ += SC_DPP(y_, 0x141); y_ += SC_DPP(y_, 0x140);
        if (ks == 0) Y[(size_t)scan_row(LKEYS - 1, b, d) * 768 + h * 64 + half * 32 + C.wave * 4 + rl] = y_;
    }
    __syncthreads();
    }
#undef SCAN_LOADG
#undef SCAN_STORE
#undef SCAN_ROW0
#undef SC_LD
#undef SC_STEP
#undef SC_LO
#undef SC_HI
#undef SC_DPP
}

constexpr int CSP = 72;
constexpr int CS_MAT = 64 * CSP * 2;
constexpr int CS_WT = 0, CS_KB = CS_MAT, CS_BB = 2 * CS_MAT, CS_RT = 3 * CS_MAT, CS_BHT = 4 * CS_MAT, CS_KHT = 5 * CS_MAT, CS_VMT = 6 * CS_MAT;
constexpr int CS_M2F = 7 * CS_MAT;
constexpr int CS_M1T = CS_M2F + 16384;
constexpr int CS_N2 = CS_M1T + CS_MAT;
constexpr int CS_GT = CS_N2 + CS_MAT;
constexpr int CS_Z = CS_M2F, CS_U = CS_M2F + CS_MAT;
constexpr int CS_GL = CS_GT + 2 * CS_MAT;
static_assert(CS_GL + 256 <= LDS_MISC, "chunked-scan LDS map");
template <bool SWZB = false>
__device__ __forceinline__ void cs_mma(f32x16& acc, const LAS unsigned char* Am, const LAS unsigned char* Bm, int ti, int tj, int r32, int hi) {
    const LAS unsigned char* ap = Am + (ti * 32 + r32) * (CSP * 2) + hi * 16; const int brow = tj * 32 + r32; const LAS unsigned char* bp = Bm + brow * (CSP * 2);
    const int sw = SWZB ? ((brow >> 3) & 7) : 0;
#pragma unroll
    for (int ks = 0; ks < 4; ++ks) acc = __builtin_amdgcn_mfma_f32_32x32x16_bf16(*(const LAS bf16x8*)(ap + ks * 32), *(const LAS bf16x8*)(bp + (((ks * 2 + hi) ^ sw) * 16)), acc, 0, 0, 0);
}
__device__ __forceinline__ void cs_store_t(LAS unsigned char* Om, const f32x16& acc, int ti, int tj, int r32, int hi) {
    LAS unsigned char* op = Om + (tj * 32 + r32) * (CSP * 2) + (ti * 32 + 4 * hi) * 2;
#pragma unroll
    for (int g = 0; g < 4; ++g) { u32x2 o; o.x = pk2(acc[4 * g], acc[4 * g + 1]); o.y = pk2(acc[4 * g + 2], acc[4 * g + 3]); *(LAS u32x2*)(op + g * 16) = o; }
}
#define CS_BAR() asm volatile("s_waitcnt lgkmcnt(0)\n\ts_barrier" ::: "memory")
__device__ __forceinline__ void phase_csa(const Ctx& C, const Args& A) {
    const unsigned char* SCN = A.ws + WS_SCN; unsigned char* CHK = A.ws + WS_CHK;
    LAS unsigned char* L = C.lds;
    const int r32 = C.lane & 31, hi = C.lane >> 5;
    float lwv[8]; u32x4 ukk, ub, ukr, ur, uv;
#define CSA_GEOM(cu_) const int unit = (cu_) / CS_NCH, ch = (cu_) % CS_NCH; const int d = unit & 1, h = (unit >> 1) % 12, b = unit / 24; \
        const int step0 = ch * CS_L; const int sgn = d ? -1 : 1; \
        const int row0 = (step0 < CTXL) ? (NLAT + b * CTXL + (d ? CTXL - 1 - step0 : step0)) : (b * TT + (d ? TT - 1 - (step0 - CTXL) : step0 - CTXL)); \
        const unsigned char* rec0 = SCN + (size_t)row0 * SC_ROW + (size_t)h * SC_REC;
#define CSA_LOAD(cu_) do { CSA_GEOM(cu_); \
        { const int k = C.tid & 63, sg = C.tid >> 6; _Pragma("unroll") for (int j = 0; j < 8; ++j) lwv[j] = *(const float*)(rec0 + (long)sgn * (8 * sg + j) * SC_ROW + SC_W + 256 * d + k * 4); } \
        { const int t = C.tid >> 3, k0 = (C.tid & 7) * 8; const unsigned char* rp = rec0 + (long)sgn * t * SC_ROW; \
          ukk = *(const u32x4*)(rp + SC_KK + k0 * 2); ub = *(const u32x4*)(rp + SC_B + 256 * d + k0 * 2); ukr = *(const u32x4*)(rp + SC_KR + 256 * d + k0 * 2); ur = *(const u32x4*)(rp + SC_R + k0 * 2); uv = *(const u32x4*)(rp + SC_V + k0 * 2); } } while (0)
    if ((int)blockIdx.x < CS_UNITS * CS_NCH) CSA_LOAD((int)blockIdx.x);
    for (int cu = blockIdx.x; cu < CS_UNITS * CS_NCH; cu += C.G) {
        LAS float* csf = (LAS float*)(L + CS_M2F);
        LAS float* seg = (LAS float*)(L + CS_N2);
        { const int k = C.tid & 63, sg = C.tid >> 6;
#pragma unroll
          for (int j = 1; j < 8; ++j) lwv[j] += lwv[j - 1];
          seg[sg * 64 + k] = lwv[7];
          CS_BAR();
          float off = 0.f, tot = 0.f;
#pragma unroll
          for (int s2 = 0; s2 < 8; ++s2) { const float v = seg[s2 * 64 + k]; off += (s2 < sg) ? v : 0.f; tot += v; }
#pragma unroll
          for (int j = 0; j < 8; ++j) csf[(8 * sg + j) * 65 + k] = lwv[j] + off;
          if (sg == 7) ((LAS float*)(L + CS_GL))[k] = __expf(tot); }
        CS_BAR();
        { const int t = C.tid >> 3, k0 = (C.tid & 7) * 8;
          float wt[8], kb[8], bb[8], rt[8], bh[8], kh[8];
#pragma unroll
          for (int j = 0; j < 8; ++j) { const unsigned pkk = j < 2 ? ukk.x : j < 4 ? ukk.y : j < 6 ? ukk.z : ukk.w, pb = j < 2 ? ub.x : j < 4 ? ub.y : j < 6 ? ub.z : ub.w, pkr = j < 2 ? ukr.x : j < 4 ? ukr.y : j < 6 ? ukr.z : ukr.w, pr = j < 2 ? ur.x : j < 4 ? ur.y : j < 6 ? ur.z : ur.w;
              const float kkv = (j & 1) ? bfhi(pkk) : bflo(pkk), bv = (j & 1) ? bfhi(pb) : bflo(pb), krv = (j & 1) ? bfhi(pkr) : bflo(pkr), rv = (j & 1) ? bfhi(pr) : bflo(pr);
              const float cst = csf[t * 65 + k0 + j], csp = t > 0 ? csf[(t - 1) * 65 + k0 + j] : 0.f, csl = csf[63 * 65 + k0 + j];
              const float einv = __expf(-cst), el = __expf(csl - cst);
              wt[j] = kkv * __expf(csp); kb[j] = krv * einv; bb[j] = bv * einv; rt[j] = rv * __expf(cst); bh[j] = bv * el; kh[j] = krv * el; }
          u32x4 o;
          o.x = pk2(wt[0], wt[1]); o.y = pk2(wt[2], wt[3]); o.z = pk2(wt[4], wt[5]); o.w = pk2(wt[6], wt[7]); *(LAS u32x4*)(L + CS_WT + t * (CSP * 2) + k0 * 2) = o;
          o.x = pk2(kb[0], kb[1]); o.y = pk2(kb[2], kb[3]); o.z = pk2(kb[4], kb[5]); o.w = pk2(kb[6], kb[7]); *(LAS u32x4*)(L + CS_KB + t * (CSP * 2) + k0 * 2) = o;
          o.x = pk2(bb[0], bb[1]); o.y = pk2(bb[2], bb[3]); o.z = pk2(bb[4], bb[5]); o.w = pk2(bb[6], bb[7]); *(LAS u32x4*)(L + CS_BB + t * (CSP * 2) + k0 * 2) = o;
          o.x = pk2(rt[0], rt[1]); o.y = pk2(rt[2], rt[3]); o.z = pk2(rt[4], rt[5]); o.w = pk2(rt[6], rt[7]); *(LAS u32x4*)(L + CS_RT + t * (CSP * 2) + k0 * 2) = o;
#pragma unroll
          for (int j = 0; j < 8; ++j) { const int to = ((((t >> 3) ^ ((k0 >> 3) & 7)) * 8) + (t & 7)) * 2;
              *(LAS bf16_t*)(L + CS_BHT + (k0 + j) * (CSP * 2) + to) = (bf16_t)f2bf(bh[j]); *(LAS bf16_t*)(L + CS_KHT + (k0 + j) * (CSP * 2) + to) = (bf16_t)f2bf(kh[j]);
              const unsigned pv = j < 2 ? uv.x : j < 4 ? uv.y : j < 6 ? uv.z : uv.w; *(LAS bf16_t*)(L + CS_VMT + (k0 + j) * (CSP * 2) + to) = (bf16_t)((j & 1) ? (pv >> 16) : (pv & 0xffffu)); } }
        if (cu + C.G < CS_UNITS * CS_NCH) CSA_LOAD(cu + C.G);
        CS_BAR();
        for (int job = C.wave; job < 12; job += NWAVES) { const int p = job >> 2, ti = (job >> 1) & 1, tj = job & 1;
            f32x16 acc;
#pragma unroll
            for (int i = 0; i < 16; ++i) acc[i] = 0.f;
            if (p == 0) { cs_mma(acc, L + CS_WT, L + CS_BB, ti, tj, r32, hi);
                const int i = tj * 32 + r32; LAS float* mp = (LAS float*)(L + CS_M2F) + i * 64;
#pragma unroll
                for (int reg = 0; reg < 16; ++reg) { const int t = ti * 32 + crow(reg, hi); mp[(t & 3) * 16 + (t >> 2)] = (i < t) ? acc[reg] : 0.f; } }
            else if (p == 1) { cs_mma(acc, L + CS_WT, L + CS_KB, ti, tj, r32, hi);
                const int i = tj * 32 + r32;
#pragma unroll
                for (int reg = 0; reg < 16; ++reg) { const int t = ti * 32 + crow(reg, hi); acc[reg] = (i < t) ? acc[reg] : 0.f; }
                cs_store_t(L + CS_M1T, acc, ti, tj, r32, hi); }
            else { cs_mma(acc, L + CS_BB, L + CS_RT, ti, tj, r32, hi);
                const int t = tj * 32 + r32;
#pragma unroll
                for (int reg = 0; reg < 16; ++reg) { const int i = ti * 32 + crow(reg, hi); acc[reg] = (i <= t) ? acc[reg] : 0.f; }
                cs_store_t(L + CS_N2, acc, ti, tj, r32, hi); } }
        CS_BAR();
        { const int c = C.tid >> 2, q = C.tid & 3; float acc[16];
          { const LAS unsigned char* rcol = (c < 64) ? (L + CS_WT + c * 2) : (L + CS_M1T + (c - 64) * (CSP * 2)); const int rstride = (c < 64) ? CSP * 2 : 2;
#pragma unroll
            for (int j = 0; j < 16; ++j) acc[j] = bf2f(*(const LAS bf16_t*)(rcol + (4 * j + q) * rstride)); }
          const LAS float* m2c = (const LAS float*)(L + CS_M2F) + q * 16;
#pragma clang loop unroll(full)
          for (int i = 0; i < 64; ++i) {
              const float mine = -acc[i >> 2];
              float gi;
              switch (i & 3) { case 0: gi = __uint_as_float((unsigned)__builtin_amdgcn_update_dpp(0, (int)__float_as_uint(mine), 0x00, 0xF, 0xF, true)); break;
                               case 1: gi = __uint_as_float((unsigned)__builtin_amdgcn_update_dpp(0, (int)__float_as_uint(mine), 0x55, 0xF, 0xF, true)); break;
                               case 2: gi = __uint_as_float((unsigned)__builtin_amdgcn_update_dpp(0, (int)__float_as_uint(mine), 0xAA, 0xF, 0xF, true)); break;
                               default: gi = __uint_as_float((unsigned)__builtin_amdgcn_update_dpp(0, (int)__float_as_uint(mine), 0xFF, 0xF, 0xF, true)); break; }
#pragma unroll
              for (int j4 = (i >> 4); j4 < 4; ++j4) { const f32x4 m = *(const LAS f32x4*)(m2c + i * 64 + j4 * 4);
#pragma unroll
                  for (int e = 0; e < 4; ++e) if (4 * j4 + e >= (i >> 2)) acc[4 * j4 + e] += m[e] * gi; }
          }
#pragma unroll
          for (int j = 0; j < 16; ++j) *(LAS bf16_t*)(L + CS_GT + c * (CSP * 2) + (4 * j + q) * 2) = (bf16_t)f2bf(-acc[j]); }
        CS_BAR();
        unsigned char* outp = CHK + (size_t)cu * 32768;
        for (int job = C.wave; job < 16; job += NWAVES) { const int p = job >> 2, ti = (job >> 1) & 1, tj = job & 1;
            f32x16 acc;
            if (p == 0) {
                const LAS unsigned char* rp = L + CS_RT + (tj * 32 + r32) * (CSP * 2) + (ti * 32 + 4 * hi) * 2;
#pragma unroll
                for (int g = 0; g < 4; ++g) { const u32x2 u = *(const LAS u32x2*)(rp + g * 16); acc[4 * g] = bflo(u.x); acc[4 * g + 1] = bfhi(u.x); acc[4 * g + 2] = bflo(u.y); acc[4 * g + 3] = bfhi(u.y); }
                cs_mma(acc, L + CS_GT, L + CS_N2, ti, tj, r32, hi);
#pragma unroll
                for (int g = 0; g < 4; ++g) { u32x2 o; o.x = pk2(acc[4 * g], acc[4 * g + 1]); o.y = pk2(acc[4 * g + 2], acc[4 * g + 3]);
                    *(u32x2*)(outp + 8192 + (((tj * 4 + 2 * ti + (g >> 1)) * 64 + (g & 1) * 32 + r32) * 16) + hi * 8) = o; } }
            else if (p == 1) {
#pragma unroll
                for (int i = 0; i < 16; ++i) acc[i] = 0.f;
                cs_mma(acc, L + CS_KB, L + CS_RT, ti, tj, r32, hi);
                const int t = tj * 32 + r32;
#pragma unroll
                for (int reg = 0; reg < 16; ++reg) { const int i = ti * 32 + crow(reg, hi); acc[reg] = (i <= t) ? acc[reg] : 0.f; }
                cs_mma(acc, L + CS_GT + 64 * (CSP * 2), L + CS_N2, ti, tj, r32, hi);
                cs_store_t(L + CS_Z, acc, ti, tj, r32, hi); }
            else if (p == 2) {
#pragma unroll
                for (int i = 0; i < 16; ++i) acc[i] = 0.f;
                cs_mma<true>(acc, L + CS_GT, L + CS_BHT, ti, tj, r32, hi);
                const int k = tj * 32 + r32; const float gl = ((const LAS float*)(L + CS_GL))[k];
#pragma unroll
                for (int reg = 0; reg < 16; ++reg) { const int cc = ti * 32 + crow(reg, hi); acc[reg] += (cc == k) ? gl : 0.f; }
#pragma unroll
                for (int g = 0; g < 4; ++g) { u32x2 o; o.x = pk2(acc[4 * g], acc[4 * g + 1]); o.y = pk2(acc[4 * g + 2], acc[4 * g + 3]);
                    *(u32x2*)(outp + (((tj * 4 + 2 * ti + (g >> 1)) * 64 + (g & 1) * 32 + r32) * 16) + hi * 8) = o; } }
            else {
                const int krow = tj * 32 + r32; const LAS unsigned char* kp = L + CS_KHT + krow * (CSP * 2) + hi * 8;
#pragma unroll
                for (int g = 0; g < 4; ++g) { const u32x2 u = *(const LAS u32x2*)(kp + (((ti * 4 + g) ^ ((krow >> 3) & 7)) * 16)); acc[4 * g] = bflo(u.x); acc[4 * g + 1] = bfhi(u.x); acc[4 * g + 2] = bflo(u.y); acc[4 * g + 3] = bfhi(u.y); }
                cs_mma<true>(acc, L + CS_GT + 64 * (CSP * 2), L + CS_BHT, ti, tj, r32, hi);
                cs_store_t(L + CS_U, acc, ti, tj, r32, hi); } }
        CS_BAR();
        { const int p = C.wave >> 2, ti = (C.wave >> 1) & 1, tj = C.wave & 1;
          f32x16 acc;
#pragma unroll
          for (int i = 0; i < 16; ++i) acc[i] = 0.f;
          cs_mma<true>(acc, L + (p ? CS_U : CS_Z), L + CS_VMT, ti, tj, r32, hi);
          unsigned char* op = outp + (p ? 16384 : 24576) + ((ti * 2 + tj) * 64 + C.lane) * 32;
          u32x4 o0, o1; o0.x = pk2(acc[0], acc[1]); o0.y = pk2(acc[2], acc[3]); o0.z = pk2(acc[4], acc[5]); o0.w = pk2(acc[6], acc[7]);
          o1.x = pk2(acc[8], acc[9]); o1.y = pk2(acc[10], acc[11]); o1.z = pk2(acc[12], acc[13]); o1.w = pk2(acc[14], acc[15]);
          *(u32x4*)op = o0; *(u32x4*)(op + 16) = o1; }
        CS_BAR();
    }
}
__device__ __forceinline__ void phase_csb(const Ctx& C, const Args& A, int l) {
    if ((int)blockIdx.x >= CS_UNITS) { conv_items(C, A, l + 1, ((int)blockIdx.x - CS_UNITS) * NWAVES + C.wave, (C.G - CS_UNITS) * NWAVES, true, false, true); return; }
    const unsigned char* CHK = A.ws + WS_CHK;
    LAS unsigned char* L = C.lds;
    const int r32 = C.lane & 31, hi = C.lane >> 5;
    const bool isS = C.wave < 4; const int ti = (C.wave >> 1) & 1, tj = C.wave & 1;
    for (int unit = blockIdx.x; unit < CS_UNITS; unit += C.G) {
        const int d = unit & 1, h = (unit >> 1) % 12, b = unit / 24;
        float* Y = (float*)(A.ws + WS_Y) + (size_t)d * MROWS * 768;
        for (int i = C.tid; i < 2 * CS_MAT / 4; i += NTHR) ((LAS unsigned*)L)[i] = 0u;
        CS_BAR();
        bf16x8 afA[4], afB[4], afC[4]; u32x4 cA0, cA1, cB0, cB1, cC0, cC1;
#define CSB_LOAD(A4, C0, C1, ch_) do { const unsigned char* op_ = CHK + ((size_t)unit * CS_NCH + (ch_)) * 32768; \
            const unsigned char* am_ = op_ + (isS ? 0 : 8192) + (ti * 4 * 64 + C.lane) * 16;     \
            _Pragma("unroll") for (int ks = 0; ks < 4; ++ks) A4[ks] = *(const bf16x8*)(am_ + ks * 1024); \
            const unsigned char* cp_ = op_ + (isS ? 16384 : 24576) + ((ti * 2 + tj) * 64 + C.lane) * 32; C0 = *(const u32x4*)cp_; C1 = *(const u32x4*)(cp_ + 16); } while (0)
#define CSB_STEP(A4, C0, C1, ch_) do { \
            const LAS unsigned char* Sb = L + ((ch_) & 1) * CS_MAT; LAS unsigned char* Sn = L + (((ch_) + 1) & 1) * CS_MAT; \
            f32x16 acc; \
            acc[0] = bflo(C0.x); acc[1] = bfhi(C0.x); acc[2] = bflo(C0.y); acc[3] = bfhi(C0.y); acc[4] = bflo(C0.z); acc[5] = bfhi(C0.z); acc[6] = bflo(C0.w); acc[7] = bfhi(C0.w); \
            acc[8] = bflo(C1.x); acc[9] = bfhi(C1.x); acc[10] = bflo(C1.y); acc[11] = bfhi(C1.y); acc[12] = bflo(C1.z); acc[13] = bfhi(C1.z); acc[14] = bflo(C1.w); acc[15] = bfhi(C1.w); \
            const LAS unsigned char* bp = Sb + (tj * 32 + r32) * (CSP * 2) + hi * 16; \
            _Pragma("unroll") for (int ks = 0; ks < 4; ++ks) acc = __builtin_amdgcn_mfma_f32_32x32x16_bf16(A4[ks], *(const LAS bf16x8*)(bp + ks * 32), acc, 0, 0, 0); \
            if (isS) { cs_store_t(Sn, acc, ti, tj, r32, hi); }     \
            else {     \
                const int step0 = (ch_) * CS_L; const int sgn = d ? -1 : 1; \
                const int row0 = (step0 < CTXL) ? (NLAT + b * CTXL + (d ? CTXL - 1 - step0 : step0)) : (b * TT + (d ? TT - 1 - (step0 - CTXL) : step0 - CTXL)); \
                float* yp = Y + (size_t)(row0 + sgn * (ti * 32 + 4 * hi)) * 768 + h * 64 + tj * 32 + r32; const long ys = (long)sgn * 768; \
                _Pragma("unroll") for (int reg = 0; reg < 16; ++reg) yp[ys * ((reg & 3) + 8 * (reg >> 2))] = acc[reg]; } \
            CS_BAR(); } while (0)
        CSB_LOAD(afA, cA0, cA1, 0); CSB_LOAD(afB, cB0, cB1, 1);
        static_assert(CS_NCH % 3 == 0, "chunk loop is unrolled by three");
        for (int ch = 0; ch < CS_NCH; ch += 3) {
            if (ch == 0) CSB_LOAD(afC, cC0, cC1, 2);
            CSB_STEP(afA, cA0, cA1, ch);     if (ch + 3 < CS_NCH) CSB_LOAD(afA, cA0, cA1, ch + 3);
            CSB_STEP(afB, cB0, cB1, ch + 1); if (ch + 4 < CS_NCH) CSB_LOAD(afB, cB0, cB1, ch + 4);
            CSB_STEP(afC, cC0, cC1, ch + 2); if (ch + 5 < CS_NCH) CSB_LOAD(afC, cC0, cC1, ch + 5);
        }
        CS_BAR();
    }
#undef CSB_LOAD
#undef CSB_STEP
}

#undef CS_BAR
__device__ __forceinline__ void phase_ef2(const Ctx& C, const Args& A, int l) {
    const int i2 = l >> 1; unsigned char* ws = A.ws;
    const unsigned char* SCN = ws + WS_SCN; const float* Y0 = (const float*)(ws + WS_Y); const float* Y1 = Y0 + (size_t)MROWS * 768;
    const bf16_t* G = (const bf16_t*)(ws + WS_G); bf16_t* A2 = (bf16_t*)(ws + WS_A2);
    const float* rb = A.in[I_RBON] + (size_t)i2 * 768; const float* gg = A.in[I_GNG] + (size_t)i2 * 768; const float* gb = A.in[I_GNB] + (size_t)i2 * 768;
    for (int row = C.gw; row < MROWS; row += C.NGW) {
#pragma unroll
        for (int it = 0; it < 3; ++it) {
            const int c = it * 256 + 4 * C.lane, head = c >> 6, kx = c & 63;
            const f32x4 y = *(const f32x4*)(Y0 + (size_t)row * 768 + c) + *(const f32x4*)(Y1 + (size_t)row * 768 + c);
            const float mean = sum16((y[0] + y[1]) + (y[2] + y[3])) * (1.f / 64.f);
            const f32x4 dd = y - mean;
            const float var = sum16((dd[0] * dd[0] + dd[1] * dd[1]) + (dd[2] * dd[2] + dd[3] * dd[3])) * (1.f / 64.f);
            const float rstd = rsqrtf(var + GN_EPS);
            const unsigned char* base = SCN + (size_t)(row * 12 + head) * SC_REC + kx * 2;
            const f32x4 r = ld4bf_(base + SC_R), v = ld4bf_(base + SC_V), k0 = ld4bf_(base + SC_KR), k1 = ld4bf_(base + SC_KR + 256);
            const f32x4 rb4 = *(const f32x4*)(rb + c);
            const f32x4 t = r * (k0 + k1) * 0.5f * rb4;
            const float bs = sum16((t[0] + t[1]) + (t[2] + t[3]));
            const f32x4 yn = dd * rstd * *(const f32x4*)(gg + c) + *(const f32x4*)(gb + c);
            const f32x4 g = ld4bf(G + (size_t)row * 768 + c);
            st4bf(A2 + (size_t)row * DM + 256 + c, g * (yn + v * bs));
        }
    }
}

__device__ __forceinline__ void phase_of1(const Ctx& C, const Args& A, int l) {
    const int i2 = l >> 1; unsigned char* ws = A.ws;
    const bf16_t* P = (const bf16_t*)(ws + WS_P); bf16_t* A2 = (bf16_t*)(ws + WS_A2); bf16_t* VT = (bf16_t*)(ws + WS_VT);
    const float* lng = A.in[I_GLNG] + (size_t)i2 * 256; const float* lnb = A.in[I_GLNB] + (size_t)i2 * 256;
    const float* gws = A.in[I_GWS] + (size_t)i2 * 4 * 128 * 128; const float* gbs = A.in[I_GBS] + (size_t)i2 * 4 * 128;
    LAS bf16_t* vt = (LAS bf16_t*)C.lds;
    LAS bf16_t* uL = (LAS bf16_t*)C.lds;
    LAS bf16_t* vT = (LAS bf16_t*)(C.lds + 128 * 528);
    const int r32 = C.lane & 31, hi = C.lane >> 5;
    for (int u = blockIdx.x; u < 264; u += C.G) {
        const bool isctx = u >= 256; const int uc = u - 256;
        const int b = isctx ? (uc >> 1) : (u >> 6), pos0 = isctx ? (uc & 1) * 128 : (u & 63) * 128;
        const int row0 = isctx ? NLAT + b * CTXL + pos0 : b * TT + pos0, L0 = isctx ? pos0 : CTXL + pos0;
        for (int hh = 0; hh < 6; ++hh) {
#pragma unroll
            for (int i = 0; i < 4; ++i) { const int piece = C.tid + NTHR * i, r = piece >> 4, part = piece & 15;
                *(LAS u32x4*)(vt + r * 136 + part * 8) = *(const u32x4*)(P + (size_t)(row0 + r) * P_LD + 1536 + hh * 128 + part * 8); }
            __syncthreads();
#pragma unroll
            for (int i = 0; i < 4; ++i) { const int item = C.tid + NTHR * i, d = item >> 4, tg = item & 15; const LAS bf16_t* s = vt + (tg * 8) * 136 + d;
                u32x4 o; o.x = (unsigned)s[0] | ((unsigned)s[136] << 16); o.y = (unsigned)s[2 * 136] | ((unsigned)s[3 * 136] << 16);
                o.z = (unsigned)s[4 * 136] | ((unsigned)s[5 * 136] << 16); o.w = (unsigned)s[6 * 136] | ((unsigned)s[7 * 136] << 16);
                *(u32x4*)(VT + ((size_t)(b * 6 + hh) * 128 + d) * LKEYS + L0 + tg * 8) = o; }
            __syncthreads();
        }
        for (int r = C.wave; r < 128; r += NWAVES) {
            const int c4 = 4 * C.lane; const bf16_t* pr = P + (size_t)(row0 + r) * P_LD + 2304;
            const f32x4 ur = ld4bf(pr + c4), raw = ld4bf(pr + 256 + c4);
            { const f32x4 gu = {gelu_erf(ur[0]), gelu_erf(ur[1]), gelu_erf(ur[2]), gelu_erf(ur[3])}; u32x2 o; o.x = pk2(gu[0], gu[1]); o.y = pk2(gu[2], gu[3]); *(LAS u32x2*)(uL + r * 264 + c4) = o; }
            const f32x4 gv = {gelu_erf(raw[0]), gelu_erf(raw[1]), gelu_erf(raw[2]), gelu_erf(raw[3])};
            const float mean = wave_sum((gv[0] + gv[1]) + (gv[2] + gv[3])) * (1.f / 256.f); const f32x4 dd = gv - mean;
            const float var = wave_sum((dd[0] * dd[0] + dd[1] * dd[1]) + (dd[2] * dd[2] + dd[3] * dd[3])) * (1.f / 256.f); const float rstd = rsqrtf(var + LN_EPS);
            const f32x4 o = dd * rstd * *(const f32x4*)(lng + c4) + *(const f32x4*)(lnb + c4);
#pragma unroll
            for (int k = 0; k < 4; ++k) vT[(c4 + k) * 136 + r] = (bf16_t)f2bf(o[k]);
        }
        __syncthreads();
        {
            const int g = C.wave >> 1, cblk = C.wave & 1, cc = g * 64 + cblk * 32 + r32;
            for (int pblk = 0; pblk < 4; ++pblk) {
                f32x16 acc;
#pragma unroll
                for (int i = 0; i < 16; ++i) acc[i] = 0.f;
                const float* wrow = gws + ((size_t)g * 128 + pblk * 32 + r32) * 128 + 8 * hi;
#pragma unroll
                for (int ks = 0; ks < 8; ++ks) { const f32x4 w0 = *(const f32x4*)(wrow + ks * 16), w1 = *(const f32x4*)(wrow + ks * 16 + 4);
                    u32x4 au; au.x = pk2(w0[0], w0[1]); au.y = pk2(w0[2], w0[3]); au.z = pk2(w1[0], w1[1]); au.w = pk2(w1[2], w1[3]);
                    const bf16x8 bf = *(const LAS bf16x8*)(vT + cc * 136 + ks * 16 + 8 * hi);
                    acc = __builtin_amdgcn_mfma_f32_32x32x16_bf16(__builtin_bit_cast(bf16x8, au), bf, acc, 0, 0, 0); }
#pragma unroll
                for (int reg = 0; reg < 16; ++reg) { const int p = pblk * 32 + crow(reg, hi);
                    const float uu = bf2f(uL[p * 264 + cc]); const float mixed = acc[reg] + gbs[g * 128 + p];
                    uL[p * 264 + cc] = (bf16_t)f2bf(uu * mixed); }
            }
        }
        __syncthreads();
#pragma unroll
        for (int i = 0; i < 8; ++i) { const int piece = C.tid + NTHR * i, r = piece >> 5, part = piece & 31;
            *(u32x4*)(A2 + (size_t)(row0 + r) * DM + 768 + part * 8) = *(const LAS u32x4*)(uL + r * 264 + part * 8); }
        __syncthreads();
    }
}

__device__ __forceinline__ void phase_attn(const Ctx& C, const Args& A, int l) {
    const int i2 = l >> 1; unsigned char* ws = A.ws;
    const bf16_t* Q = (const bf16_t*)(ws + WS_Q); const bf16_t* KA = (const bf16_t*)(ws + WS_KA); const bf16_t* VT = (const bf16_t*)(ws + WS_VT); bf16_t* A2 = (bf16_t*)(ws + WS_A2);
    const float lam_init = 0.8f - 0.6f * expf(-0.3f * (float)l);
    float s1 = 0.f, s2 = 0.f;
    for (int j = 0; j < 64; ++j) { s1 += A.in[I_LQ1][i2 * 64 + j] * A.in[I_LK1][i2 * 64 + j]; s2 += A.in[I_LQ2][i2 * 64 + j] * A.in[I_LK2][i2 * 64 + j]; }
    const float lam = expf(s1) - expf(s2) + lam_init;
    const float* subg = A.in[I_SUBG] + (size_t)i2 * 128;
    const int r32 = C.lane & 31, hi = C.lane >> 5, map = C.wave >> 2, qw = C.wave & 3;
    LAS unsigned char* Kt = C.lds; LAS unsigned char* Vt = C.lds + 2 * 16384; LAS float* xch = (LAS float*)C.lds;
    const int NU = 1536 + (l == 1 ? 48 : 0);
    for (int n = C.vcu; n < NU; n += C.G) {
        int bh, qt; bool isctx = false;
        if (n < 1536) { const int round = n >> 8, slot = n & 255; bh = (slot >> 5) * 3 + (round >> 1); qt = (round & 1) * 32 + (slot & 31); }
        else { isctx = true; bh = (n - 1536) >> 1; qt = (n - 1536) & 1; }
        const int b = bh / 6, h = bh % 6;
        const int qrow0 = isctx ? NLAT + b * CTXL + qt * 128 : b * TT + qt * 128;
        const int NT = isctx ? CTXL / 64 : LKEYS / 64;
        const bf16_t* Kb = KA + (size_t)b * LKEYS * 768 + h * 128;
        const bf16_t* Vb = VT + (size_t)(b * 6 + h) * 128 * LKEYS;
        bf16x8 qf[4];
        { const bf16_t* qp = Q + (size_t)(qrow0 + qw * 32 + r32) * 768 + h * 128 + map * 64 + 8 * hi;
#pragma unroll
          for (int ks = 0; ks < 4; ++ks) qf[ks] = *(const bf16x8*)(qp + ks * 16); }
        f32x16 O[4];
#pragma unroll
        for (int d = 0; d < 4; ++d)
#pragma unroll
            for (int i = 0; i < 16; ++i) O[d][i] = 0.f;
        float m = 0.f, lsum = 0.f;
        unsigned ksrc[2], vsrc[2];
#pragma unroll
        for (int i = 0; i < 2; ++i) { const int row = 4 * (2 * C.wave + i) + (C.lane >> 4), x = row & 15, pi = x < 4 ? x : x < 8 ? x + 4 : x < 12 ? x - 4 : x;
            ksrc[i] = (unsigned)(((row & ~15) + pi) * 768 + (((C.lane & 15) ^ x) * 8));
            const int d = 8 * (2 * C.wave + i) + (C.lane >> 3); vsrc[i] = (unsigned)(d * LKEYS + (((C.lane & 7) ^ ((d >> 1) & 7)) * 8)); }
#define AT_DMA_K(tt, slot) do { _Pragma("unroll") for (int i = 0; i < 2; ++i) __builtin_amdgcn_global_load_lds((const unsigned*)(Kb + (size_t)(tt) * 64 * 768 + ksrc[i]), (LAS unsigned*)(Kt + (slot) * 16384 + (2 * C.wave + i) * 1024), 16, 0, 0); } while (0)
#define AT_DMA_V(tt, slot) do { _Pragma("unroll") for (int i = 0; i < 2; ++i) __builtin_amdgcn_global_load_lds((const unsigned*)(Vb + (size_t)(tt) * 64 + vsrc[i]), (LAS unsigned*)(Vt + (slot) * 16384 + (2 * C.wave + i) * 1024), 16, 0, 0); } while (0)
#define AT_BAR() asm volatile("s_waitcnt vmcnt(0) lgkmcnt(0)\n\ts_barrier" ::: "memory")
#define AT_SB() __builtin_amdgcn_sched_barrier(0)
        const int ksw = r32 & 15, vsw = (r32 >> 1) & 7;
#define AT_QK(P0, P1, ks_) do { const float nm_ = -m; _Pragma("unroll") for (int i = 0; i < 16; ++i) { P0[i] = nm_; P1[i] = nm_; } \
            const LAS unsigned char* kbp_ = Kt + (ks_) * 16384 + r32 * 256; \
            _Pragma("unroll") for (int ks = 0; ks < 4; ++ks) { const int co_ = ((map * 8 + ks * 2 + hi) ^ ksw) * 16; \
                P0 = __builtin_amdgcn_mfma_f32_32x32x16_bf16(*(const LAS bf16x8*)(kbp_ + co_), qf[ks], P0, 0, 0, 0); P1 = __builtin_amdgcn_mfma_f32_32x32x16_bf16(*(const LAS bf16x8*)(kbp_ + 32 * 256 + co_), qf[ks], P1, 0, 0, 0); } } while (0)
#define AT_LDV(dst, vs_, d) do { _Pragma("unroll") for (int kst = 0; kst < 4; ++kst) dst[kst] = *(const LAS u32x4*)(Vt + (vs_) * 16384 + ((d) * 32 + r32) * 128 + (((kst * 2 + hi) ^ vsw) * 16)); } while (0)
#define AT_PV(src, d) do { _Pragma("unroll") for (int kst = 0; kst < 4; ++kst) O[d] = __builtin_amdgcn_mfma_f32_32x32x16_bf16(__builtin_bit_cast(bf16x8, src[kst]), pb[kst], O[d], 0, 0, 0); } while (0)
#define AT_SOFTPV(P0, P1, N0, N1, first, hasn, vs_) do { \
            asm volatile("s_nop 15\n\ts_nop 7" : "+v"(P0), "+v"(P1)); \
            float mx = max3f(P0[0], P0[1], P1[0]), mx2 = max3f(P0[2], P0[3], P1[1]); mx = max3f(mx, P1[2], P1[3]); \
            _Pragma("unroll") for (int i = 4; i < 16; i += 4) { mx = max3f(mx, P0[i], P0[i + 1]); mx2 = max3f(mx2, P0[i + 2], P0[i + 3]); mx = max3f(mx, P1[i], P1[i + 1]); mx2 = max3f(mx2, P1[i + 2], P1[i + 3]); } \
            mx = fmaxf(mx, mx2); \
            { auto rr = __builtin_amdgcn_permlane32_swap(__float_as_uint(mx), __float_as_uint(mx), false, false); mx = fmaxf(__uint_as_float(rr[0]), __uint_as_float(rr[1])); } \
            if ((first) || __any(mx > 8.f)) { const float dl = (first) ? mx : fmaxf(mx, 0.f); const float sc = __builtin_amdgcn_exp2f(-dl); lsum *= sc; \
                _Pragma("unroll") for (int d = 0; d < 4; ++d) _Pragma("unroll") for (int i = 0; i < 16; ++i) O[d][i] *= sc; \
                _Pragma("unroll") for (int i = 0; i < 16; ++i) { P0[i] -= dl; P1[i] -= dl; } \
                if (hasn) { asm volatile("s_nop 15\n\ts_nop 7" : "+v"(N0), "+v"(N1)); _Pragma("unroll") for (int i = 0; i < 16; ++i) { N0[i] -= dl; N1[i] -= dl; } } \
                m += dl; } \
            float ps = 0.f, ps2 = 0.f; \
            _Pragma("unroll") for (int i = 0; i < 16; ++i) { P0[i] = __builtin_amdgcn_exp2f(P0[i]); P1[i] = __builtin_amdgcn_exp2f(P1[i]); ps += P0[i]; ps2 += P1[i]; } \
            lsum += ps + ps2; \
            bf16x8 pb[4]; \
            { u32x4 w; w.x = pk2(P0[0], P0[1]); w.y = pk2(P0[2], P0[3]); w.z = pk2(P0[4], P0[5]); w.w = pk2(P0[6], P0[7]); pb[0] = __builtin_bit_cast(bf16x8, w); \
              w.x = pk2(P0[8], P0[9]); w.y = pk2(P0[10], P0[11]); w.z = pk2(P0[12], P0[13]); w.w = pk2(P0[14], P0[15]); pb[1] = __builtin_bit_cast(bf16x8, w); \
              w.x = pk2(P1[0], P1[1]); w.y = pk2(P1[2], P1[3]); w.z = pk2(P1[4], P1[5]); w.w = pk2(P1[6], P1[7]); pb[2] = __builtin_bit_cast(bf16x8, w); \
              w.x = pk2(P1[8], P1[9]); w.y = pk2(P1[10], P1[11]); w.z = pk2(P1[12], P1[13]); w.w = pk2(P1[14], P1[15]); pb[3] = __builtin_bit_cast(bf16x8, w); } \
            u32x4 va[4]; \
            AT_LDV(va, vs_, 0); AT_SB(); AT_PV(va, 0); AT_SB(); AT_LDV(va, vs_, 1); AT_SB(); AT_PV(va, 1); AT_SB(); AT_LDV(va, vs_, 2); AT_SB(); AT_PV(va, 2); AT_SB(); AT_LDV(va, vs_, 3); AT_SB(); AT_PV(va, 3); AT_SB(); } while (0)
        f32x16 pA0, pA1, pB0, pB1;
        AT_DMA_K(0, 0); AT_DMA_V(0, 0); AT_DMA_K(1, 1);
        AT_BAR();
        AT_QK(pA0, pA1, 0);
        asm volatile("s_waitcnt lgkmcnt(0)\n\ts_barrier" ::: "memory");
        for (int t = 0; t < NT; t += 2) {
            if (t + 2 < NT) AT_DMA_K(t + 2, 0);
            AT_DMA_V(t + 1, 1);
            AT_SB(); AT_QK(pB0, pB1, 1); AT_SB();
            AT_SOFTPV(pA0, pA1, pB0, pB1, t == 0, true, 0);
            AT_BAR();
            if (t + 3 < NT) AT_DMA_K(t + 3, 1);
            if (t + 2 < NT) AT_DMA_V(t + 2, 0);
            AT_SB(); if (t + 2 < NT) { AT_QK(pA0, pA1, 0); } AT_SB();
            AT_SOFTPV(pB0, pB1, pA0, pA1, false, t + 2 < NT, 1);
            AT_BAR();
        }
#undef AT_DMA_K
#undef AT_DMA_V
#undef AT_BAR
#undef AT_SB
#undef AT_QK
#undef AT_LDV
#undef AT_PV
#undef AT_SOFTPV
        const float ltot = lsum + __shfl_xor(lsum, 32);
        const float invl = 1.f / ltot;
        if (map == 1) { const float f = lam * invl;
#pragma unroll
            for (int d = 0; d < 4; ++d)
#pragma unroll
                for (int i = 0; i < 16; ++i) xch[(qw * 64 + d * 16 + i) * 64 + C.lane] = O[d][i] * f; }
        __syncthreads();
        if (map == 0) { float ss = 0.f;
#pragma unroll
            for (int d = 0; d < 4; ++d)
#pragma unroll
                for (int i = 0; i < 16; ++i) { const float o = O[d][i] * invl - xch[(qw * 64 + d * 16 + i) * 64 + C.lane]; O[d][i] = o; ss += o * o; }
            ss += __shfl_xor(ss, 32);
            const float rn = rsqrtf(ss * (1.f / 128.f) + RMS_EPS) * (1.f - lam_init);
            bf16_t* orow = A2 + (size_t)(qrow0 + qw * 32 + r32) * DM + h * 128;
#pragma unroll
            for (int d = 0; d < 4; ++d)
#pragma unroll
                for (int g4 = 0; g4 < 4; ++g4) { const int dd = 32 * d + 8 * g4 + 4 * hi; const f32x4 sg = *(const f32x4*)(subg + dd);
                    const f32x4 v = {O[d][4 * g4] * rn * sg[0], O[d][4 * g4 + 1] * rn * sg[1], O[d][4 * g4 + 2] * rn * sg[2], O[d][4 * g4 + 3] * rn * sg[3]};
                    st4bf(orow + dd, v); } }
        __syncthreads();
    }
}

__device__ __forceinline__ void phase_rt(const Ctx& C, const Args& A, int l) {
    unsigned char* ws = A.ws; float* X = (float*)(ws + WS_X); bf16_t* H = (bf16_t*)(ws + WS_H); float* AFF = (float*)(ws + WS_AFF);
    const float* MOD = (const float*)(ws + WS_MOD) + (size_t)l * 5 * 6144;
    const float* lng = A.in[I_LNG] + (size_t)(l * 2 + 0) * DM; const float* lnb = A.in[I_LNB] + (size_t)(l * 2 + 0) * DM;
    LAS float* wrs = (LAS float*)C.lds;
    { const float* wr = A.in[I_WR] + (size_t)l * DM * 16; for (int i = C.tid; i < DM * 16; i += NTHR) wrs[(i & 15) * 1024 + (i >> 4)] = wr[i]; }
    __syncthreads();
    for (int row = C.gw; row < MROWS; row += C.NGW) {
        const float* md = MOD + row_mi(row) * 6144;
        f32x4 x[4]; float s = 0.f;
#pragma unroll
        for (int j = 0; j < 4; ++j) { x[j] = *(const f32x4*)(X + (size_t)row * DM + 4 * C.lane + 256 * j); s += (x[j][0] + x[j][1]) + (x[j][2] + x[j][3]); }
        const float mean = wave_sum(s) * (1.f / DM); float s2 = 0.f;
#pragma unroll
        for (int j = 0; j < 4; ++j) { x[j] = x[j] - mean; s2 += (x[j][0] * x[j][0] + x[j][1] * x[j][1]) + (x[j][2] * x[j][2] + x[j][3] * x[j][3]); }
        const float rstd = rsqrtf(wave_sum(s2) * (1.f / DM) + LN_EPS);
        float v[16];
#pragma unroll
        for (int e = 0; e < 16; ++e) v[e] = 0.f;
#pragma unroll
        for (int j = 0; j < 4; ++j) { const int col = 4 * C.lane + 256 * j;
            const f32x4 x1 = x[j] * rstd * *(const f32x4*)(lng + col) + *(const f32x4*)(lnb + col);
            *(f32x4*)(X + (size_t)row * DM + col) = x1;
            const f32x4 h = x1 * (*(const f32x4*)(md + 4 * DM + col) + 1.f) + *(const f32x4*)(md + 3 * DM + col);
            st4bf(H + (size_t)row * DM + col, h);
#pragma unroll
            for (int e = 0; e < 16; ++e) { const f32x4 w = *(const LAS f32x4*)(wrs + e * 1024 + col); v[e] += (h[0] * w[0] + h[1] * w[1]) + (h[2] * w[2] + h[3] * w[3]); }
            __builtin_amdgcn_sched_barrier(0); }
#pragma unroll
        for (int i = 0; i < 8; ++i) { const float send = (C.lane & 32) ? v[i] : v[i + 8], keep = (C.lane & 32) ? v[i + 8] : v[i]; v[i] = keep + __shfl_xor(send, 32); }
#pragma unroll
        for (int i = 0; i < 4; ++i) { const float send = (C.lane & 16) ? v[i] : v[i + 4], keep = (C.lane & 16) ? v[i + 4] : v[i]; v[i] = keep + __shfl_xor(send, 16); }
#pragma unroll
        for (int i = 0; i < 2; ++i) { const float send = (C.lane & 8) ? v[i] : v[i + 2], keep = (C.lane & 8) ? v[i + 2] : v[i]; v[i] = keep + __shfl_xor(send, 8); }
        { const float send = (C.lane & 4) ? v[0] : v[1], keep = (C.lane & 4) ? v[1] : v[0]; v[0] = keep + __shfl_xor(send, 4); }
        float z = v[0]; z += __shfl_xor(z, 1); z += __shfl_xor(z, 2);
        float mx = z;
#pragma unroll
        for (int o = 4; o < 64; o <<= 1) mx = fmaxf(mx, __shfl_xor(mx, o));
        const float ex = expf(z - mx); float sm = ex;
#pragma unroll
        for (int o = 4; o < 64; o <<= 1) sm += __shfl_xor(sm, o);
        if ((C.lane & 3) == 0) AFF[(size_t)row * 16 + (C.lane >> 2)] = ex / sm;
    }
}

__device__ __forceinline__ void phase_tk(const Ctx& C, const Args& A) {
    unsigned char* ws = A.ws; const float* AFF = (const float*)(ws + WS_AFF); int* SLOT = (int*)(ws + WS_SLOT); int* IDX = (int*)(ws + WS_IDX); float* GATE = (float*)(ws + WS_GATE);
    LAS unsigned* key = (LAS unsigned*)C.lds;
    LAS unsigned* hist = key + 8192;
    LAS unsigned* scn = hist + 256;
    LAS unsigned* wtot = scn + 256;
    LAS unsigned* bc = wtot + 8;
    for (int u = blockIdx.x; u < 128; u += C.G) {
        const bool isctx = u >= 64; const int uu = u & 63, b = uu >> 4, e = uu & 15;
        const int n = isctx ? CTXL : TT, cap = isctx ? CAP_C : CAP_L;
        const int row0 = isctx ? NLAT + b * CTXL : b * TT;
        const int slot0 = e * ESLOTS + (isctx ? 4 * CAP_L + b * CAP_C : b * CAP_L);
        for (int i = C.tid; i < n; i += NTHR) key[i] = __float_as_uint(AFF[(size_t)(row0 + i) * 16 + e]);
        unsigned prefix = 0u, pmask = 0u; int need = cap;
        for (int pass = 0; pass < 4; ++pass) {
            const int shift = 24 - 8 * pass;
            if (C.tid < 256) hist[C.tid] = 0u;
            __syncthreads();
            for (int i = C.tid; i < n; i += NTHR) { const unsigned k = key[i]; if ((k & pmask) == prefix) __hip_atomic_fetch_add(&hist[(k >> shift) & 255u], 1u, __ATOMIC_RELAXED, __HIP_MEMORY_SCOPE_WORKGROUP); }
            __syncthreads();
            if (C.tid < 256) scn[C.tid] = hist[C.tid];
            __syncthreads();
            for (int off = 1; off < 256; off <<= 1) {
                unsigned a = 0u; if (C.tid < 256 && C.tid + off < 256) a = scn[C.tid + off];
                __syncthreads();
                if (C.tid < 256) scn[C.tid] += a;
                __syncthreads();
            }
            if (C.tid < 256) { const unsigned above = (C.tid < 255) ? scn[C.tid + 1] : 0u;
                if (scn[C.tid] >= (unsigned)need && above < (unsigned)need) { bc[0] = (unsigned)C.tid; bc[1] = (unsigned)need - above; } }
            __syncthreads();
            prefix |= bc[0] << shift; pmask |= 255u << shift; need = (int)bc[1];
            __syncthreads();
        }
        const int per = (n + NTHR - 1) / NTHR; const int i0 = C.tid * per;
        unsigned cg = 0u, ce = 0u;
        for (int j = 0; j < per; ++j) { const int i = i0 + j; if (i < n) { const unsigned k = key[i]; cg += (k > prefix); ce += (k == prefix); } }
        unsigned pk = cg | (ce << 16), inc = pk;
#pragma unroll
        for (int o = 1; o < 64; o <<= 1) { const unsigned t = __shfl_up(inc, o); if (C.lane >= o) inc += t; }
        if (C.lane == 63) wtot[C.wave] = inc;
        __syncthreads();
        unsigned wbase = 0u;
        for (int w = 0; w < C.wave; ++w) wbase += wtot[w];
        const unsigned excl = wbase + inc - pk;
        unsigned rg = excl & 0xffffu, re = excl >> 16;
        const int ngt = cap - need;
        for (int j = 0; j < per; ++j) { const int i = i0 + j; if (i < n) { const unsigned k = key[i]; int pos = -1;
            if (k > prefix) { pos = (int)rg; ++rg; } else if (k == prefix) { if ((int)re < need) pos = ngt + (int)re; ++re; }
            const int row = row0 + i;
            if (pos >= 0) { IDX[slot0 + pos] = row; GATE[slot0 + pos] = __uint_as_float(k); SLOT[(size_t)row * 16 + e] = slot0 + pos; }
            else SLOT[(size_t)row * 16 + e] = -1; } }
        if (isctx && b == 0 && C.tid < ESLOTS - 4224) { IDX[e * ESLOTS + 4224 + C.tid] = 0; GATE[e * ESLOTS + 4224 + C.tid] = 0.f; }
        __syncthreads();
    }
}

__device__ __forceinline__ void phase_cb(const Ctx& C, const Args& A, int l) {
    unsigned char* ws = A.ws; float* X = (float*)(ws + WS_X); bf16_t* H = (bf16_t*)(ws + WS_H); const int* SLOT = (const int*)(ws + WS_SLOT); const bf16_t* YE = (const bf16_t*)(ws + WS_YE);
    const float* MOD = (const float*)(ws + WS_MOD) + (size_t)l * 5 * 6144; const float* MODN = MOD + 5 * 6144;
    const float* lng = A.in[I_LNG] + (size_t)(l * 2 + 1) * DM; const float* lnb = A.in[I_LNB] + (size_t)(l * 2 + 1) * DM;
    for (int row = C.gw; row < MROWS; row += C.NGW) {
        const int mi = row_mi(row); const float* md = MOD + mi * 6144;
        f32x4 acc[4];
#pragma unroll
        for (int j = 0; j < 4; ++j) acc[j] = (f32x4){0.f, 0.f, 0.f, 0.f};
        for (int e = 0; e < 16; ++e) { const int s = __builtin_amdgcn_readfirstlane(SLOT[(size_t)row * 16 + e]);
            if (s >= 0) {
#pragma unroll
                for (int j = 0; j < 4; ++j) acc[j] += ld4bf(YE + (size_t)s * DM + 4 * C.lane + 256 * j); } }
        f32x4 x[4]; float sm = 0.f;
#pragma unroll
        for (int j = 0; j < 4; ++j) { const int col = 4 * C.lane + 256 * j; x[j] = *(const f32x4*)(X + (size_t)row * DM + col) * ALPHA_DN + *(const f32x4*)(md + 5 * DM + col) * acc[j];
            sm += (x[j][0] + x[j][1]) + (x[j][2] + x[j][3]); }
        const float mean = wave_sum(sm) * (1.f / DM); float s2 = 0.f;
#pragma unroll
        for (int j = 0; j < 4; ++j) { x[j] = x[j] - mean; s2 += (x[j][0] * x[j][0] + x[j][1] * x[j][1]) + (x[j][2] * x[j][2] + x[j][3] * x[j][3]); }
        const float rstd = rsqrtf(wave_sum(s2) * (1.f / DM) + LN_EPS);
#pragma unroll
        for (int j = 0; j < 4; ++j) { const int col = 4 * C.lane + 256 * j;
            const f32x4 x2 = x[j] * rstd * *(const f32x4*)(lng + col) + *(const f32x4*)(lnb + col);
            *(f32x4*)(X + (size_t)row * DM + col) = x2;
            if (l < DEPTH - 1) { const float* mn = MODN + mi * 6144; st4bf(H + (size_t)row * DM + col, x2 * (*(const f32x4*)(mn + DM + col) + 1.f) + *(const f32x4*)(mn + col)); }
            else if (row < NLAT) *(f32x4*)(A.out + (size_t)row * DM + col) = x2; }
    }
}


#ifndef GEMM_NOINLINE
#define GEMM_NOINLINE 0
#endif
#if GEMM_NOINLINE
#define GEMM_FN __device__ __noinline__
#else
#define GEMM_FN __device__ __forceinline__
#endif
GEMM_FN void gphase_in(LAS unsigned char* lds, unsigned char* ws, int nN, int G) {
    int bx = blockIdx.x; asm volatile("" : "+s"(bx), "+s"(G));
    pg8::Gemm g{(const bf16_t*)(ws + WS_H), (const bf16_t*)(ws + WS_WIN), DM}; pg8::Order<0> S; S.init(MROWS / 256, nN, G, bx, nullptr, 0);
    pg8::EpiBf16 E{(bf16_t*)(ws + WS_P), P_LD}; pg8::gemm_phase(lds, g, S, E); }
GEMM_FN void gphase_in_odd(LAS unsigned char* lds, unsigned char* ws, int G) {
    int bx = blockIdx.x; asm volatile("" : "+s"(bx), "+s"(G));
    pg8::Gemm g{(const bf16_t*)(ws + WS_H), (const bf16_t*)(ws + WS_WIN), DM}; pg8::Order<0> S; S.init(MROWS / 256, D_IN_ODD / 256, G, bx, nullptr, 0);
    pg8::EpiOdd E{(bf16_t*)(ws + WS_P), (bf16_t*)(ws + WS_Q), (bf16_t*)(ws + WS_KA), (const float*)(ws + WS_ROPE)}; pg8::gemm_phase(lds, g, S, E); }
GEMM_FN void gphase_lora(LAS unsigned char* lds, unsigned char* ws, const float* d0, const float* a0, const float* kal, int G) {
    int bx = blockIdx.x; asm volatile("" : "+s"(bx), "+s"(G));
    pg8::Gemm g{(const bf16_t*)(ws + WS_LIN), (const bf16_t*)(ws + WS_WLORA), LORA_K}; pg8::Order<0> S; S.init(MROWS / 256, LORA_N / 256, G, bx, nullptr, 0);
    pg8::EpiLora E{ws + WS_SCN, (bf16_t*)(ws + WS_G), d0, a0, kal}; pg8::gemm_phase(lds, g, S, E); }
GEMM_FN void gphase_out(LAS unsigned char* lds, unsigned char* ws, const float* modl, int G) {
    int bx = blockIdx.x; asm volatile("" : "+s"(bx), "+s"(G));
    pg8::Gemm g{(const bf16_t*)(ws + WS_A2), (const bf16_t*)(ws + WS_WOUT), DM}; pg8::Order<0> S; S.init(MROWS / 256, DM / 256, G, bx, nullptr, 0);
    pg8::EpiRes E{(float*)(ws + WS_X), modl}; pg8::gemm_phase(lds, g, S, E); }
GEMM_FN void gphase_e1(LAS unsigned char* lds, unsigned char* ws, int G, int l) {
    int bx = blockIdx.x; asm volatile("" : "+s"(bx), "+s"(G));
    pg8::Gemm g{(const bf16_t*)(ws + WS_H), (const bf16_t*)(ws + WS_WE13 + (size_t)(l & 1) * WE13_BYTES), DM}; pg8::EpiSwiGLU E{(bf16_t*)(ws + WS_HID)};
    pg8::OrderExp<1> S; S.init(4096 / 256, G, bx, (const int*)(ws + WS_IDX), (long)4096 * DM); pg8::gemm_phase(lds, g, S, E); }
GEMM_FN void gphase_e2(LAS unsigned char* lds, unsigned char* ws, int G, int l) {
    int bx = blockIdx.x; asm volatile("" : "+s"(bx), "+s"(G));
    pg8::Gemm g{(const bf16_t*)(ws + WS_HID), (const bf16_t*)(ws + WS_WE2 + (size_t)(l & 1) * WE2_BYTES), D_EXP}; pg8::EpiYE E{(bf16_t*)(ws + WS_YE), (const float*)(ws + WS_GATE)};
    pg8::OrderExp<2> S; S.init(DM / 256, G, bx, nullptr, (long)DM * D_EXP); pg8::gemm_phase(lds, g, S, E); }

constexpr int NSLOT = 13;
constexpr int NSTEP = 1 + DEPTH * NSLOT;
__global__ void __launch_bounds__(NTHR, 2) mk_fwd(Args KA) {
    extern __shared__ __attribute__((aligned(16))) unsigned char lds_raw[];
    volatile LAS unsigned* MISC = (volatile LAS unsigned*)((LAS unsigned char*)lds_raw + LDS_MISC);
    if (threadIdx.x < 16) MISC[threadIdx.x] = 0u;
    if (threadIdx.x == 0) { LAS unsigned long long* tb = (LAS unsigned long long*)((LAS unsigned char*)lds_raw + LDS_PTAB);
#pragma unroll
        for (int i = 0; i < 37; ++i) tb[i] = (unsigned long long)KA.in[i];
        tb[37] = (unsigned long long)KA.out; tb[38] = (unsigned long long)KA.ws; }
    __syncthreads();
    const int lo = KA.lo, hi = KA.hi;
    unsigned bar_x = 0;
    if (hi - lo > 1) { const XcdBarrier b0 = xcd_barrier_post((unsigned*)(KA.ws + WS_CTL), MISC); bar_x = b0.x; }
#ifndef PH_MASK
#define PH_MASK 0xFFFFFF
#endif
#ifndef REP_MASK
#define REP_MASK 0
#endif
#define PH_BIT(k) (((k) == 0) ? 0 : 1 + ((k) - 1) % NSLOT + (((k) - 1) % NSLOT >= 2 && ((k) - 1) % NSLOT <= 3 && odd ? 12 : 0))
#define RUN(k, ...) do { if (((PH_MASK >> PH_BIT(k)) & 1) && lo <= (k) && (k) < hi) { const int nrep = ((REP_MASK >> PH_BIT(k)) & 1) ? 2 : 1; \
        _Pragma("unroll 1") for (int rep = 0; rep < nrep; ++rep) { \
        Ctx C; mkctx(C, (LAS unsigned char*)lds_raw); Args A; ldargs(A, (LAS unsigned char*)lds_raw); unsigned char* ws = A.ws; \
        const float* MODL = (const float*)(ws + WS_MOD) + (size_t)l * 5 * 6144; (void)MODL; \
        __VA_ARGS__; if ((k) + 1 < hi || rep + 1 < nrep) { XcdBarrier bar; bar.bar = (unsigned*)(ws + WS_CTL); bar.x = bar_x; bar.st = MISC; xcd_barrier(bar); } } } } while (0)
    { const bool odd = false; const int l = 0; RUN(0, phase_init(C, A)); }
#pragma unroll 1
    for (int l = 0; l < DEPTH; ++l) {
        const int sb = 1 + l * NSLOT; const bool odd = l & 1;
        RUN(sb + 0, { phase_conv(C, A, l); if (l == 0) phase_modh(C, A, 0); });
        if (odd) { RUN(sb + 1, gphase_in_odd(C.lds, ws, C.G)); } else { RUN(sb + 1, gphase_in(C.lds, ws, D_IN_EVEN_PAD / 256, C.G)); }
        if (!odd) {
            RUN(sb + 2, phase_ef1(C, A, l));
            RUN(sb + 3, { const int i2 = l >> 1; gphase_lora(C.lds, ws, A.in[I_D0] + (size_t)i2 * 2 * 768, A.in[I_A0] + (size_t)i2 * 2 * 768, A.in[I_KAL] + (size_t)i2 * 768, C.G); });
#if CHUNKED_SCAN
            RUN(sb + 4, phase_csa(C, A));
            RUN(sb + 5, phase_csb(C, A, l));
#else
            RUN(sb + 4, phase_scan(C, A));
#endif
            RUN(sb + 6, phase_ef2(C, A, l));
        } else {
            RUN(sb + 2, phase_of1(C, A, l));
            RUN(sb + 3, phase_attn(C, A, l));
        }
        RUN(sb + 7, gphase_out(C.lds, ws, MODL, C.G));
        RUN(sb + 8, phase_rt(C, A, l));
        RUN(sb + 9, phase_tk(C, A));
        RUN(sb + 10, gphase_e1(C.lds, ws, C.G, l));
        RUN(sb + 11, gphase_e2(C.lds, ws, C.G, l));
        RUN(sb + 12, phase_cb(C, A, l));
    }
#undef RUN
}

#ifdef PHASE_PROBE
#define PROBE_PRE extern __shared__ __attribute__((aligned(16))) unsigned char lds_raw[]; Ctx C; mkctx(C, (LAS unsigned char*)lds_raw); unsigned char* ws = A.ws; (void)ws;
__global__ void __launch_bounds__(NTHR, 2) pr_init(Args A) { PROBE_PRE phase_init(C, A); }
__global__ void __launch_bounds__(NTHR, 2) pr_conv(Args A) { PROBE_PRE phase_conv(C, A, A.lo); }
__global__ void __launch_bounds__(NTHR, 2) pr_modh(Args A) { PROBE_PRE phase_modh(C, A, A.lo); }
__global__ void __launch_bounds__(NTHR, 2) pr_ef1(Args A) { PROBE_PRE phase_ef1(C, A, A.lo); }
__global__ void __launch_bounds__(NTHR, 2) pr_scan(Args A) { PROBE_PRE phase_scan(C, A); }
__global__ void __launch_bounds__(NTHR, 2) pr_ef2(Args A) { PROBE_PRE phase_ef2(C, A, A.lo); }
__global__ void __launch_bounds__(NTHR, 2) pr_csa(Args A) { PROBE_PRE phase_csa(C, A); }
__global__ void __launch_bounds__(NTHR, 2) pr_csb(Args A) { PROBE_PRE phase_csb(C, A, A.lo); }
__global__ void __launch_bounds__(NTHR, 2) pr_of1(Args A) { PROBE_PRE phase_of1(C, A, A.lo); }
__global__ void __launch_bounds__(NTHR, 2) pr_attn(Args A) { PROBE_PRE phase_attn(C, A, A.lo); }
__global__ void __launch_bounds__(NTHR, 2) pr_rt(Args A) { PROBE_PRE phase_rt(C, A, A.lo); }
__global__ void __launch_bounds__(NTHR, 2) pr_tk(Args A) { PROBE_PRE phase_tk(C, A); }
__global__ void __launch_bounds__(NTHR, 2) pr_cb(Args A) { PROBE_PRE phase_cb(C, A, A.lo); }
__global__ void __launch_bounds__(NTHR, 2) pr_gemm_in(Args A) { PROBE_PRE pg8::Gemm g{(const bf16_t*)(ws + WS_H), (const bf16_t*)(ws + WS_WIN), DM}; pg8::Order<0> S; S.init(MROWS / 256, A.lo, C.G, (int)blockIdx.x, nullptr, 0);
                      pg8::EpiBf16 E{(bf16_t*)(ws + WS_P), P_LD}; pg8::gemm_phase(C.lds, g, S, E); }
__global__ void __launch_bounds__(NTHR, 2) pr_gemm_lora(Args A) { PROBE_PRE pg8::Gemm g{(const bf16_t*)(ws + WS_LIN), (const bf16_t*)(ws + WS_WLORA), LORA_K}; pg8::Order<0> S; S.init(MROWS / 256, LORA_N / 256, C.G, (int)blockIdx.x, nullptr, 0);
                          const int i2 = A.lo; pg8::EpiLora E{ws + WS_SCN, (bf16_t*)(ws + WS_G), A.in[I_D0] + (size_t)i2 * 2 * 768, A.in[I_A0] + (size_t)i2 * 2 * 768, A.in[I_KAL] + (size_t)i2 * 768};
                          pg8::gemm_phase(C.lds, g, S, E); }
__global__ void __launch_bounds__(NTHR, 2) pr_gemm_out(Args A) { PROBE_PRE pg8::Gemm g{(const bf16_t*)(ws + WS_A2), (const bf16_t*)(ws + WS_WOUT), DM}; pg8::Order<0> S; S.init(MROWS / 256, DM / 256, C.G, (int)blockIdx.x, nullptr, 0);
                      pg8::EpiRes E{(float*)(ws + WS_X), (const float*)(ws + WS_MOD)}; pg8::gemm_phase(C.lds, g, S, E); }
__global__ void __launch_bounds__(NTHR, 2) pr_gemm_e1(Args A) { PROBE_PRE pg8::Gemm g{(const bf16_t*)(ws + WS_H), (const bf16_t*)(ws + WS_WE13), DM}; pg8::Order<1> S; S.init(NEXP * 17, 4096 / 256, C.G, (int)blockIdx.x, (const int*)(ws + WS_IDX), (long)4096 * DM);
                      pg8::EpiSwiGLU E{(bf16_t*)(ws + WS_HID)}; pg8::gemm_phase(C.lds, g, S, E); }
__global__ void __launch_bounds__(NTHR, 2) pr_gemm_e2(Args A) { PROBE_PRE pg8::Gemm g{(const bf16_t*)(ws + WS_HID), (const bf16_t*)(ws + WS_WE2), D_EXP}; pg8::Order<2> S; S.init(NEXP * 17, DM / 256, C.G, (int)blockIdx.x, nullptr, (long)DM * D_EXP);
                       pg8::EpiYE E{(bf16_t*)(ws + WS_YE), (const float*)(ws + WS_GATE)}; pg8::gemm_phase(C.lds, g, S, E); }
#endif

extern "C" void kernel_launch(void* const* d_in, const int* in_sizes, int n_in, void* d_out, int out_size, void* d_ws, size_t ws_size, hipStream_t stream) {
    static int grid = 0;
    if (grid == 0) {
        if (n_in != 37 || out_size != NLAT * DM || ws_size < WS_END) { fprintf(stderr, "kernel_launch: unexpected shapes: n_in %d out %d ws %zu (need %zu)\n", n_in, out_size, ws_size, (size_t)WS_END); grid = -1; return; }
        int dev = 0, cus = 0, per_cu = 0;
        if (hipGetDevice(&dev) != hipSuccess || hipDeviceGetAttribute(&cus, hipDeviceAttributeMultiprocessorCount, dev) != hipSuccess) { grid = -1; return; }
        if (hipFuncSetAttribute((const void*)mk_fwd, hipFuncAttributeMaxDynamicSharedMemorySize, LDS_BYTES) != hipSuccess) { fprintf(stderr, "kernel_launch: hipFuncSetAttribute failed\n"); grid = -1; return; }
        if (hipOccupancyMaxActiveBlocksPerMultiprocessor(&per_cu, (const void*)mk_fwd, NTHR, LDS_BYTES) != hipSuccess || per_cu < 1) fprintf(stderr, "kernel_launch: occupancy query reports %d\n", per_cu);
        (void)hipGetLastError();
        grid = cus;
    }
    if (grid < 0) return;
    (void)hipMemsetAsync((char*)d_ws + WS_CTL, 0, CTL_BYTES, stream);
    Args a{};
    for (int i = 0; i < 37; ++i) a.in[i] = (const float*)d_in[i];
    a.out = (float*)d_out; a.ws = (unsigned char*)d_ws;
#if MK_MULTI
    for (int k = 0; k < NSTEP; ++k) {
        if (k >= 1) { const int l = (k - 1) / NSLOT, s = (k - 1) % NSLOT; if ((l & 1) && (s >= 4 && s <= 6)) continue; if (!(l & 1) && !CHUNKED_SCAN && s == 5) continue; }
        a.lo = k; a.hi = k + 1;
        hipLaunchKernelGGL(mk_fwd, dim3(grid), dim3(NTHR), LDS_BYTES, stream, a);
    }
#else
    a.lo = 0; a.hi = NSTEP;
    hipLaunchKernelGGL(mk_fwd, dim3(grid), dim3(NTHR), LDS_BYTES, stream, a);
#endif
    const hipError_t le = hipPeekAtLastError();
    if (le != hipSuccess) fprintf(stderr, "kernel_launch: launch failed: %s\n", hipGetErrorName(le));
}
```

```cpp
#include <hip/hip_runtime.h>
#include <cstdio>
#include <cstdint>
#include <cmath>

#ifndef MK_MULTI
#define MK_MULTI 0
#endif
#ifndef CHUNKED_SCAN
#define CHUNKED_SCAN 1
#endif

#define GAS __attribute__((address_space(1)))
#define LAS __attribute__((address_space(3)))
typedef unsigned short bf16_t;
typedef short bf16x8 __attribute__((ext_vector_type(8)));
typedef float f32x4 __attribute__((ext_vector_type(4)));
typedef float f32x2 __attribute__((ext_vector_type(2)));
typedef float f32x16 __attribute__((ext_vector_type(16)));
typedef unsigned u32x4 __attribute__((ext_vector_type(4)));
typedef unsigned u32x2 __attribute__((ext_vector_type(2)));
typedef __bf16 bf16x2_t __attribute__((ext_vector_type(2)));

constexpr int NB = 4, TT = 8192, DM = 1024, NLAT = NB * TT, CTXL = 256, NCTX = NB * CTXL, MROWS = NLAT + NCTX;
constexpr int DEPTH = 4;
constexpr int D_CONV = 256, RW_H = 12, RW_K = 64, D_RWKV = 768, RWKV_COLS = 2688, D_IN_EVEN = 3456, D_IN_EVEN_PAD = 3584;
constexpr int D_DIFF = 768, D_GMLP = 256, D_IN_ODD = 2816;
constexpr int NEXP = 16, D_EXP = 2048, CAP_L = 1024, CAP_C = 32, ESLOTS = 4352;
constexpr int P_LD = 3584;
constexpr int LORA_K = 384, LORA_N = 3840;
constexpr int LKEYS = CTXL + TT;
constexpr float ALPHA_DN = 1.6817928305074290f;
constexpr float DECAY_SCALE = 0.6065306597126334f;
constexpr float GN_EPS = 64e-5f, LN_EPS = 1e-5f, RMS_EPS = 1e-5f;
constexpr float QSCALE = 0.125f * 1.4426950408889634f;

constexpr size_t al256(size_t x) { return (x + 255) & ~(size_t)255; }
constexpr size_t WS_CTL = 0;
constexpr size_t CTL_BYTES = 65536;
constexpr size_t WS_MOD = WS_CTL + CTL_BYTES;
constexpr size_t WS_ROPE = WS_MOD + al256((size_t)DEPTH * 5 * 6144 * 4);
constexpr size_t WS_WIN = WS_ROPE + 32768;
constexpr size_t WS_WOUT = WS_WIN + (size_t)D_IN_EVEN_PAD * DM * 2;
constexpr size_t WS_WLORA = WS_WOUT + (size_t)DM * DM * 2;
constexpr size_t WS_WE13 = WS_WLORA + (size_t)LORA_N * LORA_K * 2;
constexpr size_t WE13_BYTES = (size_t)NEXP * 4096 * DM * 2, WE2_BYTES = (size_t)NEXP * DM * D_EXP * 2;
constexpr size_t WS_WE2 = WS_WE13 + 2 * WE13_BYTES;
constexpr size_t WS_X = WS_WE2 + 2 * WE2_BYTES;
constexpr size_t WS_H = WS_X + (size_t)MROWS * DM * 4;
constexpr size_t WS_A2 = WS_H + (size_t)MROWS * DM * 2;
constexpr size_t WS_P = WS_A2 + (size_t)MROWS * DM * 2;
constexpr size_t WS_AFF = WS_P + (size_t)MROWS * P_LD * 2;
constexpr size_t WS_SLOT = WS_AFF + (size_t)MROWS * 16 * 4;
constexpr size_t WS_IDX = WS_SLOT + (size_t)MROWS * 16 * 4;
constexpr size_t WS_GATE = WS_IDX + al256((size_t)NEXP * ESLOTS * 4);
constexpr size_t WS_R2 = WS_GATE + al256((size_t)NEXP * ESLOTS * 4);
constexpr int SC_REC = 1408, SC_ROW = 12 * SC_REC, SC_W = 0, SC_R = 512, SC_KK = 640, SC_V = 768, SC_B = 896, SC_KR = 1024;
constexpr size_t WS_SCN = WS_R2;
constexpr size_t WS_G = WS_SCN + (size_t)MROWS * SC_ROW;
constexpr size_t WS_LIN = WS_G + (size_t)MROWS * 768 * 2;
constexpr int CS_L = 64, CS_NCH = LKEYS / CS_L, CS_UNITS = NB * RW_H * 2;
constexpr size_t WS_CHK = WS_LIN + (size_t)MROWS * 384 * 2;
constexpr size_t WS_EVEN_END = WS_CHK + (size_t)CS_UNITS * CS_NCH * 32768;
constexpr size_t WS_Y = WS_P;
constexpr size_t WS_Q = WS_R2;
constexpr size_t WS_KA = WS_Q + (size_t)MROWS * 768 * 2;
constexpr size_t WS_VT = WS_KA + (size_t)NB * LKEYS * 768 * 2;
constexpr size_t WS_HID = WS_R2;
constexpr size_t WS_YE = WS_HID + (size_t)NEXP * ESLOTS * D_EXP * 2;
constexpr size_t WS_END = WS_EVEN_END;
static_assert(WS_END <= (size_t)2147483648ull, "workspace over 2 GiB");
static_assert((size_t)2 * MROWS * 768 * 4 <= (size_t)MROWS * P_LD * 2, "Y aliases P");
static_assert(WS_YE + (size_t)NEXP * ESLOTS * DM * 2 <= WS_END, "moe region");

constexpr int LDS_BYTES = 147456;
constexpr int LDS_MISC = 140 * 1024;
constexpr int LDS_PTAB = LDS_MISC + 256;
constexpr int NWAVES = 8, NTHR = 512;

__device__ __forceinline__ unsigned f2bf(float f) { unsigned u = __float_as_uint(f); return (u + 0x7fffu + ((u >> 16) & 1u)) >> 16; }
__device__ __forceinline__ unsigned pk2(float lo, float hi) { f32x2 v = {lo, hi}; bf16x2_t b = __builtin_convertvector(v, bf16x2_t); return __builtin_bit_cast(unsigned, b); }
__device__ __forceinline__ float bflo(unsigned u) { return __uint_as_float(u << 16); }
__device__ __forceinline__ float bfhi(unsigned u) { return __uint_as_float(u & 0xffff0000u); }
__device__ __forceinline__ float bf2f(bf16_t b) { return __uint_as_float((unsigned)b << 16); }
__device__ __forceinline__ float sigmoidf_(float x) { return 1.f / (1.f + __expf(-x)); }
__device__ __forceinline__ float wave_sum(float v) {
#pragma unroll
    for (int o = 1; o < 64; o <<= 1) v += __shfl_xor(v, o);
    return v;
}
__device__ __forceinline__ float sum16(float v) {
#pragma unroll
    for (int o = 1; o < 16; o <<= 1) v += __shfl_xor(v, o);
    return v;
}
__device__ __forceinline__ f32x4 ld4bf_(const void* p) { const u32x2 u = *(const u32x2*)p; return (f32x4){bflo(u.x), bfhi(u.x), bflo(u.y), bfhi(u.y)}; }
__device__ __forceinline__ void st4bf_(void* p, f32x4 v) { u32x2 o; o.x = pk2(v[0], v[1]); o.y = pk2(v[2], v[3]); *(u32x2*)p = o; }
__device__ __forceinline__ float max3f(float a, float b, float c) { float r; asm("v_max3_f32 %0, %1, %2, %3" : "=v"(r) : "v"(a), "v"(b), "v"(c)); return r; }
__device__ __forceinline__ int crow(int r, int hi) { return (r & 3) + 8 * (r >> 2) + 4 * hi; }
__device__ __forceinline__ float gelu_erf(float x) { return 0.5f * x * (1.f + erff(x * 0.70710678118654752f)); }

#define XB_TMO      128
#define XB_XCNT(j)  (256  + 64 * (j))
#define XB_XSUB(j)  (1280 + 64 * (j))
#define XB_XGEN(j)  (2304 + 64 * (j))
#define XB_TOP      3328
#define XB_TOPGEN   3392
#define XCD_BAR_WORDS 3456
#define XB_SPIN_CAP (1u << 20)

__device__ __forceinline__ unsigned xb_ld(unsigned* p)              { return __hip_atomic_load(p, __ATOMIC_RELAXED, __HIP_MEMORY_SCOPE_AGENT); }
__device__ __forceinline__ unsigned xb_add(unsigned* p, unsigned v) { return __hip_atomic_fetch_add(p, v, __ATOMIC_RELAXED, __HIP_MEMORY_SCOPE_AGENT); }
__device__ __forceinline__ unsigned xb_xcc_id() { return (unsigned)__builtin_amdgcn_s_getreg((3 << 11) | 20) & 0xFu; }
#define XB_SPIN(cond, bar) do { unsigned _sp = 0; while (cond) { __builtin_amdgcn_s_sleep(1); \
    if ((++_sp & 255u) == 0u) { if (xb_ld(&(bar)[XB_TMO])) break; if (_sp > XB_SPIN_CAP) { atomicAdd(&(bar)[XB_TMO], 1u); break; } } } } while (0)

struct XcdBarrier { unsigned* bar; unsigned x; volatile LAS unsigned* st; };

__device__ __forceinline__ XcdBarrier xcd_barrier_post(unsigned* bar, volatile LAS unsigned* st) {
    XcdBarrier b; b.bar = bar; b.x = xb_xcc_id(); b.st = st;
    if (threadIdx.x == 0) (void)xb_add(&bar[XB_XCNT(b.x)], 1u);
    return b;
}
__device__ __forceinline__ void xcd_barrier_complete(unsigned* bar, unsigned x, unsigned& nloc, unsigned& nx) {
    const unsigned G = gridDim.x * gridDim.y * gridDim.z;
    unsigned sum, cnt, mine, sp = 0u;
    for (;;) {
        sum = 0u; cnt = 0u; mine = 0u;
#pragma unroll
        for (unsigned j = 0; j < 16; ++j) { const unsigned c = xb_ld(&bar[XB_XCNT(j)]); sum += c; cnt += (c > 0u) ? 1u : 0u; mine = (j == x) ? c : mine; }
        if (sum == G) break;
        __builtin_amdgcn_s_sleep(1);
        if ((++sp & 255u) == 0u) { if (xb_ld(&bar[XB_TMO])) break; if (sp > XB_SPIN_CAP) { atomicAdd(&bar[XB_TMO], 1u); break; } }
    }
    nloc = mine > 0u ? mine : 1u; nx = cnt > 0u ? cnt : 1u;
}
__device__ __forceinline__ void xcd_barrier(const XcdBarrier& b) {
    asm volatile("s_waitcnt vmcnt(0)" ::: "memory");
    __syncthreads();
    if (threadIdx.x == 0) {
        unsigned* bar = b.bar;
        __builtin_amdgcn_s_waitcnt(0);
        unsigned nloc = b.st[0], nx = b.st[1];
        if (nloc == 0u) { xcd_barrier_complete(bar, b.x, nloc, nx); b.st[0] = nloc; b.st[1] = nx; }
        const unsigned old = xb_add(&bar[XB_XSUB(b.x)], 1u);
        const unsigned gen = old / nloc;
        if (old + 1u == (gen + 1u) * nloc) {
            __builtin_amdgcn_fence(__ATOMIC_RELEASE, "agent");
            asm volatile("s_waitcnt vmcnt(0)" ::: "memory");
            const unsigned og = xb_add(&bar[XB_TOP], 1u);
            const unsigned tg = og / nx;
            if (og + 1u == (tg + 1u) * nx) xb_add(&bar[XB_TOPGEN], 1u);
            else XB_SPIN(xb_ld(&bar[XB_TOPGEN]) == tg, bar);
            __builtin_amdgcn_fence(__ATOMIC_ACQUIRE, "agent");
            xb_add(&bar[XB_XGEN(b.x)], 1u);
            asm volatile("s_waitcnt vmcnt(0)" ::: "memory");
        } else {
            XB_SPIN(xb_ld(&bar[XB_XGEN(b.x)]) == gen, bar);
            __builtin_amdgcn_fence(__ATOMIC_ACQUIRE, "agent");
            asm volatile("s_waitcnt vmcnt(0)" ::: "memory");
        }
    }
    __syncthreads();
}

namespace pg8 {
constexpr int BM = 256, BK = 64, HALF = 128, HTB = HALF * BK * 2, STAGE_BYTES = 8 * HTB, NXCD = 8, WGM = 8;
__host__ __device__ __forceinline__ int lds_byte(int r, int c) { const int st = (r >> 4) * 2 + (c >> 5), rr = r & 15, cc = c & 31, ob = rr * 64 + cc * 2; return st * 1024 + (ob ^ (((ob >> 9) & 1) << 5)); }
__host__ __device__ __forceinline__ void stage_rc(int b, int& R, int& C) { const int st = b / 1024, sb = b % 1024, swz = sb ^ (((sb >> 9) & 1) << 5); R = (st >> 1) * 16 + swz / 64; C = (st & 1) * 32 + (swz % 64) / 2; }

struct Unit { int pm, pn, hf; };
struct Gemm { const bf16_t* A; const bf16_t* Bt; int K; };

template <int MODE> struct Order {
    static constexpr bool GATHER = (MODE == 1);
    int nM, nN, nwg, G, c; const int* idx; long bstride;
    __device__ __forceinline__ void init(int nM_, int nN_, int G_, int c_, const int* idx_, long bstride_) { nM = nM_; nN = nN_; nwg = nM * nN; G = G_; c = c_; idx = idx_; bstride = bstride_; }
    __device__ __forceinline__ bool next(int i, Unit& u) const {
        const long L = (long)i * G + c; if (L >= nwg) return false;
        int wgid = (int)L; { const int q = nwg / NXCD, r = nwg % NXCD, xcd = wgid % NXCD, off = wgid / NXCD; wgid = (xcd < r ? xcd * (q + 1) : r * (q + 1) + (xcd - r) * q) + off; }
        const int nig = WGM * nN, gid = wgid / nig, fm = gid * WGM, gsz = (nM - fm) < WGM ? (nM - fm) : WGM;
        u.pm = fm + ((wgid % nig) % gsz); u.pn = (wgid % nig) / gsz; u.hf = (MODE != 0 && (u.pm % 17) == 16) ? 1 : 0; return true;
    }
    __device__ __forceinline__ unsigned arow(const Unit& u, int r) const { if (MODE == 1) return (unsigned)idx[u.pm * BM + r]; return (unsigned)(u.pm * BM + r); }
    __device__ __forceinline__ long bbase(const Unit& u, int K) const { long o = (long)u.pn * BM * K; if (MODE != 0) o += (long)(u.pm / 17) * bstride; return o; }
};

template <int MODE> struct OrderExp {
    static constexpr bool GATHER = (MODE == 1);
    int nN, G, c0; const int* idx; long bstride;
    __device__ __forceinline__ void init(int nN_, int G_, int c_, const int* idx_, long bstride_) { nN = nN_; G = G_; c0 = c_; idx = idx_; bstride = bstride_; }
    __device__ __forceinline__ bool next(int i0, Unit& u) const {
        const int v = i0 * G + c0, i = v >> 8, c = v & 255;
        const int x = c & 7, slot = c >> 3, per = 32 / nN, nfull = 256 / (8 * per);
        if (i > nfull) return false;
        if (i < nfull) { u.pn = slot / per; const int f = (i * 8 + x) * per + (slot % per); u.pm = (f >> 4) * 17 + (f & 15); u.hf = 0; return true; }
        if (i == nfull && slot < 2 * nN) { u.pn = slot >> 1; u.pm = (x * 2 + (slot & 1)) * 17 + 16; u.hf = 1; return true; }
        return false;
    }
    __device__ __forceinline__ unsigned arow(const Unit& u, int r) const { if (MODE == 1) return (unsigned)idx[u.pm * BM + r]; return (unsigned)(u.pm * BM + r); }
    __device__ __forceinline__ long bbase(const Unit& u, int K) const { return (long)u.pn * BM * K + (long)(u.pm / 17) * bstride; }
};

template <class Epi, class Sched>
__device__ __forceinline__ void gemm_phase(LAS unsigned char* lds, const Gemm g, const Sched& S, const Epi& E) {
    int tid = threadIdx.x; asm volatile("" : "+v"(tid));
    const int wid = __builtin_amdgcn_readfirstlane(tid >> 6), wr = wid >> 2, wc = wid & 3;
    const int K = g.K, nt = K / BK;
    unsigned voffB[2];
    { const int lane = tid & 63, fr = lane & 15, fq = lane >> 4; (void)fr; (void)fq; }
#pragma unroll
    for (int i = 0; i < 2; ++i) { int R, Cc; stage_rc(tid * 16 + i * 8192, R, Cc); voffB[i] = (unsigned)(R * K + Cc) * 2u; }
    const size_t kstep = (size_t)(BK * 2);
    const size_t hstep = (size_t)HALF * K * 2;
    const unsigned ldsw = (unsigned)wid * 1024u;
    const int aoff = lds_byte(wr * 64 + (tid & 15), ((tid & 63) >> 4) * 8), boff = lds_byte(wc * 32 + (tid & 15), ((tid & 63) >> 4) * 8);
#define PG8_SA(b, h) (((b) * 2 + (h)) * HTB)
#define PG8_SB(b, h) ((4 + (b) * 2 + (h)) * HTB)
#define PG8_STAGE(bufoff, gbase, voff) do { _Pragma("unroll") for (int _i = 0; _i < 2; ++_i) \
        __builtin_amdgcn_global_load_lds((const unsigned*)((const char*)(gbase) + (voff)[_i]), (LAS unsigned*)(lds + (bufoff) + ldsw + _i * 8192), 16, 0, 0); } while (0)
#define PG8_LDA(dst, b, h) do { _Pragma("unroll") for (int m = 0; m < 4; ++m) _Pragma("unroll") for (int k = 0; k < 2; ++k) dst[m][k] = *(const LAS bf16x8*)(lds + PG8_SA(b, h) + aoff + m * 2048 + k * 1024); } while (0)
#define PG8_LDB(dst, b, h) do { _Pragma("unroll") for (int n = 0; n < 2; ++n) _Pragma("unroll") for (int k = 0; k < 2; ++k) dst[n][k] = *(const LAS bf16x8*)(lds + PG8_SB(b, h) + boff + n * 2048 + k * 1024); } while (0)
#define PG8_MMA(ai, bj, At, Bt) do { __builtin_amdgcn_s_setprio(1); _Pragma("unroll") for (int m = 0; m < 4; ++m) _Pragma("unroll") for (int n = 0; n < 2; ++n) _Pragma("unroll") for (int k = 0; k < 2; ++k) \
        acc[ai][bj][m][n] = __builtin_amdgcn_mfma_f32_16x16x32_bf16(Bt[n][k], At[m][k], acc[ai][bj][m][n], 0, 0, 0); __builtin_amdgcn_s_setprio(0); } while (0)
#define PG8_WAIT_V(n) asm volatile("s_waitcnt vmcnt(" #n ")" ::: "memory")
#define PG8_WAIT_L(n) asm volatile("s_waitcnt lgkmcnt(" #n ")" ::: "memory")
#define PG8_BAR __builtin_amdgcn_s_barrier()
#define PG8_SCHED __builtin_amdgcn_sched_barrier(0)
#define PG8_ROWOFFS(dst, u, tq) do { _Pragma("unroll") for (int _i = 0; _i < 2; ++_i) { int _R, _C; stage_rc((tq) * 16 + _i * 8192, _R, _C); _Pragma("unroll") for (int _h = 0; _h < 2; ++_h) dst[_h][_i] = (S.arow(u, _h * HALF + _R) * (unsigned)K + (unsigned)_C) * 2u; } } while (0)
    Unit cur, nxt; int ui = 0;
    if (!S.next(0, cur)) return;
    float zf = 0.f; asm volatile("" : "+v"(zf));
    f32x4 acc[2][2][4][2];
#pragma unroll
    for (int a = 0; a < 2; ++a)
#pragma unroll
        for (int b = 0; b < 2; ++b)
#pragma unroll
            for (int m = 0; m < 4; ++m)
#pragma unroll
                for (int n = 0; n < 2; ++n) acc[a][b][m][n] = (f32x4){zf, zf, zf, zf};
    bf16x8 At[4][2], B0[2][2], B1[2][2];
    unsigned vcur[2][2];
    if constexpr (Sched::GATHER) { PG8_ROWOFFS(vcur, cur, tid); }
    const char* const Ab = (const char*)g.A;
    const char* cA = Sched::GATHER ? Ab : Ab + (size_t)(unsigned)__builtin_amdgcn_readfirstlane((int)S.arow(cur, 0)) * K * 2;
#define PG8_STAGEA(bufoff, ptr, h) do { if constexpr (Sched::GATHER) { PG8_STAGE(bufoff, ptr, vcur[h]); } else { PG8_STAGE(bufoff, (ptr) + (h) * hstep, voffB); } } while (0)
    const char* cB = (const char*)g.Bt + (size_t)S.bbase(cur, K) * 2;
    PG8_STAGE(PG8_SB(0, 0), cB, voffB); PG8_STAGE(PG8_SB(0, 1), cB + hstep, voffB); PG8_STAGEA(PG8_SA(0, 0), cA, 0); PG8_STAGEA(PG8_SA(0, 1), cA, 1);
    if (wr == 1) PG8_BAR;
    PG8_WAIT_V(2); PG8_BAR;
    PG8_STAGE(PG8_SB(1, 0), cB + kstep, voffB); PG8_STAGEA(PG8_SA(1, 0), cA + kstep, 0); PG8_STAGE(PG8_SB(1, 1), cB + hstep + kstep, voffB);
    PG8_WAIT_V(6); PG8_BAR;
    for (;;) {
        const bool has_next = S.next(ui + 1, nxt);
        const char* nB = has_next ? (const char*)g.Bt + (size_t)S.bbase(nxt, K) * 2 : cB;
        const char* nA = (Sched::GATHER || !has_next) ? cA : Ab + (size_t)(unsigned)__builtin_amdgcn_readfirstlane((int)S.arow(nxt, 0)) * K * 2;
#pragma unroll 1
        for (int t = 0; t < nt; t += 2) {
            const bool last = (t == nt - 2);
            const char* a1 = cA + (size_t)(t + 1) * kstep;
            const char* a2 = last ? nA : cA + (size_t)(t + 2) * kstep; const char* b2 = last ? nB : cB + (size_t)(t + 2) * kstep;
            const char* a3 = a2 + kstep; const char* b3 = b2 + kstep;
            PG8_LDB(B0, 0, 0); PG8_LDB(B1, 0, 1); PG8_SCHED; PG8_LDA(At, 0, 0); PG8_STAGEA(PG8_SA(1, 1), a1, 1);
            PG8_WAIT_V(8); PG8_WAIT_L(0); PG8_BAR; PG8_MMA(0, 0, At, B0); PG8_MMA(0, 1, At, B1); PG8_BAR; PG8_SCHED;
            if constexpr (Sched::GATHER) { if (last && has_next) { int tq = tid; asm volatile("" : "+v"(tq)); PG8_ROWOFFS(vcur, nxt, tq); } }
            PG8_LDA(At, 0, 1); PG8_STAGE(PG8_SB(0, 0), b2, voffB); PG8_STAGE(PG8_SB(0, 1), b2 + hstep, voffB); PG8_STAGEA(PG8_SA(0, 0), a2, 0);
            PG8_WAIT_V(8); PG8_WAIT_L(0); PG8_BAR; if (!cur.hf) { PG8_MMA(1, 0, At, B0); PG8_MMA(1, 1, At, B1); } PG8_BAR; PG8_SCHED;
            PG8_LDB(B0, 1, 0); PG8_LDB(B1, 1, 1); PG8_SCHED; PG8_LDA(At, 1, 0); PG8_STAGEA(PG8_SA(0, 1), a2, 1);
            PG8_WAIT_V(8); PG8_WAIT_L(0); PG8_BAR; PG8_MMA(0, 0, At, B0); PG8_MMA(0, 1, At, B1); PG8_BAR; PG8_SCHED;
            PG8_LDA(At, 1, 1); PG8_STAGE(PG8_SB(1, 0), b3, voffB); PG8_STAGE(PG8_SB(1, 1), b3 + hstep, voffB); PG8_STAGEA(PG8_SA(1, 0), a3, 0);
            PG8_WAIT_V(8); PG8_WAIT_L(0); PG8_BAR; if (!cur.hf) { PG8_MMA(1, 0, At, B0); PG8_MMA(1, 1, At, B1); } PG8_BAR; PG8_SCHED;
        }
        if (wr == 0) PG8_BAR;
        { int tz = tid; asm volatile("" : "+v"(tz)); const int ln = tz & 63; E(acc, cur, wr, wc, ln & 15, ln >> 4); }
        if (!has_next) break;
#pragma unroll
        for (int a = 0; a < 2; ++a)
#pragma unroll
            for (int b = 0; b < 2; ++b)
#pragma unroll
                for (int m = 0; m < 4; ++m)
#pragma unroll
                    for (int n = 0; n < 2; ++n) acc[a][b][m][n] = (f32x4){zf, zf, zf, zf};
        cur = nxt; cB = nB; cA = nA; ++ui;
        if (wr == 1) PG8_BAR;
    }
    PG8_WAIT_V(0);
    PG8_BAR;
#undef PG8_SA
#undef PG8_SB
#undef PG8_STAGE
#undef PG8_LDA
#undef PG8_LDB
#undef PG8_MMA
#undef PG8_WAIT_V
#undef PG8_WAIT_L
#undef PG8_BAR
#undef PG8_SCHED
#undef PG8_ROWOFFS
#undef PG8_STAGEA
}

#define EPI_LOOP for (int ai = 0; ai < 2; ++ai) for (int m = 0; m < 4; ++m) for (int bj = 0; bj < 2; ++bj) for (int n = 0; n < 2; ++n)
struct EpiBf16 {
    bf16_t* O; int ldc;
    __device__ __forceinline__ void operator()(const f32x4 (&acc)[2][2][4][2], const Unit& u, int wr, int wc, int fr, int fq) const {
        const int row0 = u.pm * BM + wr * 64 + fr, col0 = u.pn * BM + wc * 32 + 4 * fq;
#pragma unroll
        for (int ai = 0; ai < 2; ++ai)
#pragma unroll
            for (int m = 0; m < 4; ++m) { bf16_t* rowp = O + (size_t)(row0 + ai * HALF + m * 16) * ldc + col0;
#pragma unroll
                for (int bj = 0; bj < 2; ++bj)
#pragma unroll
                    for (int n = 0; n < 2; ++n) { const f32x4 v = acc[ai][bj][m][n]; u32x2 o; o.x = pk2(v[0], v[1]); o.y = pk2(v[2], v[3]); *(u32x2*)(rowp + bj * HALF + n * 16) = o; } }
    }
};
struct EpiOdd {
    bf16_t* P; bf16_t* Q; bf16_t* KA; const float* rope;
    __device__ __forceinline__ void operator()(const f32x4 (&acc)[2][2][4][2], const Unit& u, int wr, int wc, int fr, int fq) const {
        const int row0 = u.pm * BM + wr * 64 + fr, col0 = u.pn * BM + wc * 32 + 4 * fq;
        if (u.pn >= 6) {
#pragma unroll
            for (int ai = 0; ai < 2; ++ai)
#pragma unroll
                for (int m = 0; m < 4; ++m) { bf16_t* rowp = P + (size_t)(row0 + ai * HALF + m * 16) * P_LD + col0;
#pragma unroll
                    for (int bj = 0; bj < 2; ++bj)
#pragma unroll
                        for (int n = 0; n < 2; ++n) { const f32x4 v = acc[ai][bj][m][n]; u32x2 o; o.x = pk2(v[0], v[1]); o.y = pk2(v[2], v[3]); *(u32x2*)(rowp + bj * HALF + n * 16) = o; } }
            return;
        }
        const bool isk = u.pn >= 3, isctx = u.pm >= NLAT / BM; const int axis = wc & 1;
        const int cq = col0 - (isk ? 768 : 0);
#pragma unroll
        for (int ai = 0; ai < 2; ++ai)
#pragma unroll
            for (int m = 0; m < 4; ++m) { const int row = row0 + ai * HALF + m * 16;
                f32x4 cs = {1.f, 1.f, 1.f, 1.f}, sn = {0.f, 0.f, 0.f, 0.f}; size_t orow;
                if (!isctx) { const int t = row & (TT - 1); const int pos = axis ? 128 + (t & 63) : (t >> 6);
                    cs = *(const f32x4*)(rope + pos * 16 + 4 * fq); sn = *(const f32x4*)(rope + 192 * 16 + pos * 16 + 4 * fq);
                    orow = isk ? (size_t)(row >> 13) * LKEYS + CTXL + t : (size_t)row; }
                else { const int rc = row - NLAT; orow = isk ? (size_t)(rc >> 8) * LKEYS + (rc & 255) : (size_t)row; }
                bf16_t* op = (isk ? KA : Q) + orow * 768 + cq; const float sc = isk ? 1.f : QSCALE;
#pragma unroll
                for (int bj = 0; bj < 2; ++bj) { const f32x4 x1 = acc[ai][bj][m][0], x2 = acc[ai][bj][m][1];
                    const f32x4 o1 = (x1 * cs - x2 * sn) * sc, o2 = (x1 * sn + x2 * cs) * sc;
                    u32x2 a; a.x = pk2(o1[0], o1[1]); a.y = pk2(o1[2], o1[3]); *(u32x2*)(op + bj * HALF) = a;
                    u32x2 b; b.x = pk2(o2[0], o2[1]); b.y = pk2(o2[2], o2[3]); *(u32x2*)(op + bj * HALF + 16) = b; } }
    }
};
struct EpiRes {
    float* X; const float* modl;
    __device__ __forceinline__ void operator()(const f32x4 (&acc)[2][2][4][2], const Unit& u, int wr, int wc, int fr, int fq) const {
        const int row0 = u.pm * BM + wr * 64 + fr, col0 = u.pn * BM + wc * 32 + 4 * fq;
        const int mi = (u.pm * BM < NLAT) ? (u.pm * BM) / TT : 4;
        const float* gate = modl + mi * 6144 + 2 * DM;
        f32x4 gv[2][2];
#pragma unroll
        for (int bj = 0; bj < 2; ++bj)
#pragma unroll
            for (int n = 0; n < 2; ++n) gv[bj][n] = *(const f32x4*)(gate + col0 + bj * HALF + n * 16);
#pragma unroll
        for (int ai = 0; ai < 2; ++ai)
#pragma unroll
            for (int m = 0; m < 4; ++m) { float* rowp = X + (size_t)(row0 + ai * HALF + m * 16) * DM + col0;
#pragma unroll
                for (int bj = 0; bj < 2; ++bj)
#pragma unroll
                    for (int n = 0; n < 2; ++n) { f32x4* p = (f32x4*)(rowp + bj * HALF + n * 16); const f32x4 x = *p; *p = x * ALPHA_DN + gv[bj][n] * acc[ai][bj][m][n]; } }
    }
};
struct EpiSwiGLU {
    bf16_t* HID;
    __device__ __forceinline__ void operator()(const f32x4 (&acc)[2][2][4][2], const Unit& u, int wr, int wc, int fr, int fq) const {
        const int row0 = u.pm * BM + wr * 64 + fr, f0 = u.pn * HALF + wc * 32 + 4 * fq;
#pragma unroll
        for (int ai = 0; ai < 2; ++ai) if (ai == 0 || !u.hf)
#pragma unroll
            for (int m = 0; m < 4; ++m) { bf16_t* rowp = HID + (size_t)(row0 + ai * HALF + m * 16) * D_EXP + f0;
#pragma unroll
                for (int n = 0; n < 2; ++n) { const f32x4 a = acc[ai][0][m][n], b = acc[ai][1][m][n]; float h[4];
#pragma unroll
                    for (int j = 0; j < 4; ++j) h[j] = a[j] / (1.f + __expf(-a[j])) * b[j];
                    u32x2 o; o.x = pk2(h[0], h[1]); o.y = pk2(h[2], h[3]); *(u32x2*)(rowp + n * 16) = o; } }
    }
};
struct EpiYE {
    bf16_t* YE; const float* gate;
    __device__ __forceinline__ void operator()(const f32x4 (&acc)[2][2][4][2], const Unit& u, int wr, int wc, int fr, int fq) const {
        const int row0 = u.pm * BM + wr * 64 + fr, col0 = u.pn * BM + wc * 32 + 4 * fq;
        float gts[2][4];
#pragma unroll
        for (int ai = 0; ai < 2; ++ai)
#pragma unroll
            for (int m = 0; m < 4; ++m) gts[ai][m] = gate[row0 + ai * HALF + m * 16];
#pragma unroll
        for (int ai = 0; ai < 2; ++ai) if (ai == 0 || !u.hf)
#pragma unroll
            for (int m = 0; m < 4; ++m) { const int row = row0 + ai * HALF + m * 16; const float gt = gts[ai][m]; bf16_t* rowp = YE + (size_t)row * DM + col0;
#pragma unroll
                for (int bj = 0; bj < 2; ++bj)
#pragma unroll
                    for (int n = 0; n < 2; ++n) { const f32x4 v = acc[ai][bj][m][n] * gt; u32x2 o; o.x = pk2(v[0], v[1]); o.y = pk2(v[2], v[3]); *(u32x2*)(rowp + bj * HALF + n * 16) = o; } }
    }
};
struct EpiLora {
    unsigned char* SCN; bf16_t* G; const float* decay0; const float* a0; const float* kalpha;
    __device__ __forceinline__ void operator()(const f32x4 (&acc)[2][2][4][2], const Unit& u, int wr, int wc, int fr, int fq) const {
        const int row0 = u.pm * BM + wr * 64 + fr;
        const int seg = u.pn / 3, cb = (u.pn % 3) * BM + wc * 32 + 4 * fq;
#pragma unroll
        for (int bj = 0; bj < 2; ++bj)
#pragma unroll
            for (int n = 0; n < 2; ++n) {
                const int col = cb + bj * HALF + n * 16, head = col >> 6, kx = col & 63;
                if (seg < 2) {
                    const f32x4 d0 = *(const f32x4*)(decay0 + seg * 768 + col);
#pragma unroll
                    for (int ai = 0; ai < 2; ++ai)
#pragma unroll
                        for (int m = 0; m < 4; ++m) { const int row = row0 + ai * HALF + m * 16; f32x4 w;
#pragma unroll
                            for (int j = 0; j < 4; ++j) { const float lw = -DECAY_SCALE * sigmoidf_(d0[j] + acc[ai][bj][m][n][j]); w[j] = CHUNKED_SCAN ? lw : __expf(lw); }
                            *(f32x4*)(SCN + (size_t)(row * 12 + head) * SC_REC + SC_W + seg * 256 + kx * 4) = w; __builtin_amdgcn_sched_barrier(0); }
                } else if (seg < 4) {
                    const int d = seg - 2;
                    const f32x4 a00 = *(const f32x4*)(a0 + d * 768 + col), kal = *(const f32x4*)(kalpha + col);
                    u32x2 kkr[2][4], ksr[2][4];
#pragma unroll
                    for (int ai = 0; ai < 2; ++ai)
#pragma unroll
                        for (int m = 0; m < 4; ++m) { const unsigned char* base = SCN + (size_t)((row0 + ai * HALF + m * 16) * 12 + head) * SC_REC + kx * 2;
                            kkr[ai][m] = *(const u32x2*)(base + SC_KK); ksr[ai][m] = *(const u32x2*)(base + SC_KR + 256 * d); }
#pragma unroll
                    for (int ai = 0; ai < 2; ++ai)
#pragma unroll
                        for (int m = 0; m < 4; ++m) { const int row = row0 + ai * HALF + m * 16; unsigned char* base = SCN + (size_t)(row * 12 + head) * SC_REC + kx * 2;
                            const f32x4 kk = {bflo(kkr[ai][m].x), bfhi(kkr[ai][m].x), bflo(kkr[ai][m].y), bfhi(kkr[ai][m].y)}; const f32x4 ks = {bflo(ksr[ai][m].x), bfhi(ksr[ai][m].x), bflo(ksr[ai][m].y), bfhi(ksr[ai][m].y)}; f32x4 bb, kr;
#pragma unroll
                            for (int j = 0; j < 4; ++j) { const float a = sigmoidf_(a00[j] + acc[ai][bj][m][n][j]); bb[j] = kk[j] * a; kr[j] = ks[j] * (1.f + (a - 1.f) * kal[j]); }
                            st4bf_(base + SC_B + 256 * d, bb); st4bf_(base + SC_KR + 256 * d, kr); __builtin_amdgcn_sched_barrier(0); }
                } else {
#pragma unroll
                    for (int ai = 0; ai < 2; ++ai)
#pragma unroll
                        for (int m = 0; m < 4; ++m) { const int row = row0 + ai * HALF + m * 16; const f32x4 v = acc[ai][bj][m][n]; u32x2 o; o.x = pk2(v[0], v[1]); o.y = pk2(v[2], v[3]);
                            *(u32x2*)(G + (size_t)row * 768 + col) = o; }
                }
            }
    }
};
}

struct Args { const float* in[37]; float* out; unsigned char* ws; int lo, hi; };
enum { I_X = 0, I_C, I_CTX, I_CCTX, I_WMOD, I_BMOD, I_LNG, I_LNB, I_EWIN, I_EWOUT, I_CONVW, I_MU, I_DUP, I_D0, I_AUP, I_A0, I_GUP, I_KXI, I_KAL, I_RBON, I_GNG, I_GNB,
       I_OWIN, I_OWOUT, I_LQ1, I_LK1, I_LQ2, I_LK2, I_SUBG, I_GLNG, I_GLNB, I_GWS, I_GBS, I_WR, I_WE1, I_WE3, I_WE2 };

struct Ctx {
    LAS unsigned char* lds;
    int tid, lane, wave, G, vcu, gw, NGW;
};
__device__ __forceinline__ void mkctx(Ctx& C, LAS unsigned char* lds) {
    int tid = threadIdx.x; asm volatile("" : "+v"(tid));
    C.lds = lds; C.tid = tid; C.lane = tid & 63; C.wave = __builtin_amdgcn_readfirstlane(tid >> 6);
    C.G = gridDim.x; { const int bx = blockIdx.x; C.vcu = (C.G % 8 == 0) ? (bx % 8) * (C.G / 8) + bx / 8 : bx; }
    C.gw = blockIdx.x * NWAVES + C.wave; C.NGW = C.G * NWAVES;
}
__device__ __forceinline__ void ldargs(Args& A, LAS unsigned char* lds) {
    LAS const u32x2* tb = (LAS const u32x2*)(lds + LDS_PTAB); asm volatile("" : "+v"(tb));
#pragma unroll
    for (int i = 0; i < 37; ++i) { const u32x2 v = tb[i]; A.in[i] = (const float*)(((unsigned long long)(unsigned)__builtin_amdgcn_readfirstlane((int)v.y) << 32) | (unsigned)__builtin_amdgcn_readfirstlane((int)v.x)); }
    { const u32x2 v = tb[37]; A.out = (float*)(((unsigned long long)(unsigned)__builtin_amdgcn_readfirstlane((int)v.y) << 32) | (unsigned)__builtin_amdgcn_readfirstlane((int)v.x)); }
    { const u32x2 v = tb[38]; A.ws = (unsigned char*)(((unsigned long long)(unsigned)__builtin_amdgcn_readfirstlane((int)v.y) << 32) | (unsigned)__builtin_amdgcn_readfirstlane((int)v.x)); }
    A.lo = 0; A.hi = 0;
}
__device__ __forceinline__ int row_mi(int row) { return row < NLAT ? (row >> 13) : 4; }

__device__ __forceinline__ void phase_init(const Ctx& C, const Args& A) {
    unsigned char* ws = A.ws;
    float* MOD = (float*)(ws + WS_MOD);
    LAS float* sv = (LAS float*)C.lds;
    LAS float* red = sv + 5 * 1024;
    for (int i = C.tid; i < 5 * 1024; i += NTHR) { const int v = i >> 10, k = i & 1023; const float c = (v < 4) ? A.in[I_C][v * DM + k] : A.in[I_CCTX][k]; sv[i] = c / (1.f + __expf(-c)); }
    __syncthreads();
    const int j = C.tid & 127, kp = C.tid >> 7;
    for (int it = blockIdx.x; it < DEPTH * 48; it += C.G) {
        const int l = it / 48, cg = it % 48, col = cg * 128 + j;
        const float* W = A.in[I_WMOD] + (size_t)l * DM * 6144 + col;
        float a0 = 0.f, a1 = 0.f, a2 = 0.f, a3 = 0.f, a4 = 0.f;
#pragma unroll 4
        for (int k = kp * 256; k < kp * 256 + 256; ++k) { const float w = W[(size_t)k * 6144]; a0 += sv[k] * w; a1 += sv[1024 + k] * w; a2 += sv[2048 + k] * w; a3 += sv[3072 + k] * w; a4 += sv[4096 + k] * w; }
        red[(kp * 5 + 0) * 128 + j] = a0; red[(kp * 5 + 1) * 128 + j] = a1; red[(kp * 5 + 2) * 128 + j] = a2; red[(kp * 5 + 3) * 128 + j] = a3; red[(kp * 5 + 4) * 128 + j] = a4;
        __syncthreads();
        for (int o = C.tid; o < 5 * 128; o += NTHR) { const int v = o >> 7, jj = o & 127; const int cc = cg * 128 + jj;
            const float s = red[(0 * 5 + v) * 128 + jj] + red[(1 * 5 + v) * 128 + jj] + red[(2 * 5 + v) * 128 + jj] + red[(3 * 5 + v) * 128 + jj];
            MOD[((size_t)l * 5 + v) * 6144 + cc] = s + A.in[I_BMOD][l * 6144 + cc]; }
        __syncthreads();
    }
    if (blockIdx.x == C.G - 1) { float* rope = (float*)(ws + WS_ROPE);
        for (int i = C.tid; i < 192 * 16; i += NTHR) { const int pos = i >> 4, j = i & 15; const float ang = (float)(pos < 128 ? pos : pos - 128) * powf(10000.f, -(float)j * (1.f / 16.f));
            rope[i] = cosf(ang); rope[192 * 16 + i] = sinf(ang); } }
    f32x4* X4 = (f32x4*)(ws + WS_X);
    const f32x4* x4 = (const f32x4*)A.in[I_X]; const f32x4* c4 = (const f32x4*)A.in[I_CTX];
    const size_t nl = (size_t)NLAT * DM / 4, nc = (size_t)NCTX * DM / 4;
    for (size_t i = (size_t)blockIdx.x * NTHR + C.tid; i < nl + nc; i += (size_t)C.G * NTHR) X4[i] = (i < nl) ? x4[i] : c4[i - nl];
}

__device__ __forceinline__ void transpose_item(const float* W, int ldw, int k0, int n0, bf16_t* WT, int ldt, int drow0, LAS float* scr, int lane) {
    { float v[64]; const float* src = W + (size_t)k0 * ldw + n0 + lane;
#pragma unroll
      for (int k = 0; k < 64; ++k) v[k] = __builtin_nontemporal_load(src + (size_t)k * ldw);
#pragma unroll
      for (int k = 0; k < 64; ++k) scr[k * 65 + lane] = v[k]; }
    asm volatile("s_waitcnt lgkmcnt(0)" ::: "memory");
    const int c = lane & 7;
#pragma unroll
    for (int j = 0; j < 8; ++j) { const int n = (lane >> 3) + 8 * j; const LAS float* s = scr + (8 * c) * 65 + n;
        u32x4 o; o.x = pk2(s[0 * 65], s[1 * 65]); o.y = pk2(s[2 * 65], s[3 * 65]); o.z = pk2(s[4 * 65], s[5 * 65]); o.w = pk2(s[6 * 65], s[7 * 65]);
        *(u32x4*)(WT + (size_t)(drow0 + n) * ldt + k0 + 8 * c) = o; }
    asm volatile("s_waitcnt lgkmcnt(0)" ::: "memory");
}
__device__ __forceinline__ void conv_items(const Ctx& C, const Args& A, int l, int gw, int NGW, bool do_in, bool do_out, bool do_exp) {
    unsigned char* ws = A.ws;
    const int i2 = l >> 1; const bool odd = (l & 1);
    LAS float* scr = (LAS float*)C.lds + C.wave * (64 * 65);
    bf16_t* WIN = (bf16_t*)(ws + WS_WIN); bf16_t* WOUT = (bf16_t*)(ws + WS_WOUT); bf16_t* WE13 = (bf16_t*)(ws + WS_WE13 + (size_t)(l & 1) * WE13_BYTES); bf16_t* WE2 = (bf16_t*)(ws + WS_WE2 + (size_t)(l & 1) * WE2_BYTES);
    const int nin = odd ? D_IN_ODD : D_IN_EVEN;
    const float* win = odd ? A.in[I_OWIN] + (size_t)i2 * DM * D_IN_ODD : A.in[I_EWIN] + (size_t)i2 * DM * D_IN_EVEN;
    const float* wout = odd ? A.in[I_OWOUT] + (size_t)i2 * DM * DM : A.in[I_EWOUT] + (size_t)i2 * DM * DM;
    const int n_in = do_in ? 16 * (nin / 64) : 0, n_out = do_out ? 16 * 16 : 0, n_e13 = do_exp ? NEXP * 2 * 16 * 32 : 0, n_e2 = do_exp ? NEXP * 32 * 16 : 0;
    const int total = n_in + n_out + n_e13 + n_e2;
    for (int it = gw; it < total; it += NGW) {
        int r = it;
        if (r < n_in) { const int nb = nin / 64, kb = r / nb, nn = r % nb; transpose_item(win, nin, kb * 64, nn * 64, WIN, DM, nn * 64, scr, C.lane); continue; } r -= n_in;
        if (r < n_out) { const int kb = r / 16, nn = r % 16; transpose_item(wout, DM, kb * 64, nn * 64, WOUT, DM, nn * 64, scr, C.lane); continue; } r -= n_out;
        if (r < n_e13) { const int e = r / 1024, q = r % 1024, mat = q / 512, q2 = q % 512, kb = q2 / 32, nn = q2 % 32;
            const float* W = (mat ? A.in[I_WE3] : A.in[I_WE1]) + ((size_t)l * NEXP + e) * DM * D_EXP;
            const int f0 = nn * 64; const int drow = (f0 >> 7) * 256 + mat * 128 + (f0 & 127);
            transpose_item(W, D_EXP, kb * 64, f0, WE13 + (size_t)e * 4096 * DM, DM, drow, scr, C.lane); continue; } r -= n_e13;
        { const int e = r / 512, q = r % 512, kb = q / 16, nn = q % 16;
            const float* W = A.in[I_WE2] + ((size_t)l * NEXP + e) * D_EXP * DM;
            transpose_item(W, DM, kb * 64, nn * 64, WE2 + (size_t)e * DM * D_EXP, D_EXP, nn * 64, scr, C.lane); }
    }
}
__device__ __forceinline__ void phase_conv(const Ctx& C, const Args& A, int l) {
    unsigned char* ws = A.ws;
    const int i2 = l >> 1; const bool odd = (l & 1);
    bf16_t* WIN = (bf16_t*)(ws + WS_WIN);
    const bool early = CHUNKED_SCAN && odd;
    if (l > 0) conv_items(C, A, l, C.gw, C.NGW, !early, true, !early);
    if (!odd) {
        u32x4* z = (u32x4*)(WIN + (size_t)D_IN_EVEN * DM);
        unsigned zz = 0u; asm volatile("" : "+v"(zz));
        for (int i = blockIdx.x * NTHR + C.tid; i < (D_IN_EVEN_PAD - D_IN_EVEN) * DM / 8; i += C.G * NTHR) z[i] = (u32x4){zz, zz, zz, zz};
        bf16_t* WL = (bf16_t*)(ws + WS_WLORA);
        const float* dup = A.in[I_DUP] + (size_t)i2 * 2 * 64 * 768; const float* aup = A.in[I_AUP] + (size_t)i2 * 2 * 64 * 768; const float* gup = A.in[I_GUP] + (size_t)i2 * 128 * 768;
        for (int i = blockIdx.x * NTHR + C.tid; i < LORA_N * LORA_K; i += C.G * NTHR) {
            const int kk = i / LORA_N, n = i % LORA_N, seg = n / 768, col = n % 768; float v = 0.f;
            if (seg == 0) { if (kk < 64) v = dup[(size_t)(0 * 64 + kk) * 768 + col]; }
            else if (seg == 1) { if (kk >= 64 && kk < 128) v = dup[(size_t)(1 * 64 + kk - 64) * 768 + col]; }
            else if (seg == 2) { if (kk >= 128 && kk < 192) v = aup[(size_t)(0 * 64 + kk - 128) * 768 + col]; }
            else if (seg == 3) { if (kk >= 192 && kk < 256) v = aup[(size_t)(1 * 64 + kk - 192) * 768 + col]; }
            else { if (kk >= 256) v = gup[(size_t)(kk - 256) * 768 + col]; }
            WL[(size_t)n * LORA_K + kk] = (bf16_t)f2bf(v);
        }
    }
}

__device__ __forceinline__ void phase_modh(const Ctx& C, const Args& A, int l) {
    const float* X = (const float*)(A.ws + WS_X); bf16_t* H = (bf16_t*)(A.ws + WS_H); const float* MOD = (const float*)(A.ws + WS_MOD) + (size_t)l * 5 * 6144;
    for (int row = C.gw; row < MROWS; row += C.NGW) {
        const float* md = MOD + row_mi(row) * 6144;
#pragma unroll
        for (int j = 0; j < 4; ++j) { const int col = 4 * C.lane + 256 * j; const f32x4 x = *(const f32x4*)(X + (size_t)row * DM + col), sh = *(const f32x4*)(md + col), sc = *(const f32x4*)(md + DM + col);
            const f32x4 h = x * (sc + 1.f) + sh; u32x2 o; o.x = pk2(h[0], h[1]); o.y = pk2(h[2], h[3]); *(u32x2*)(H + (size_t)row * DM + col) = o; }
    }
}

__device__ __forceinline__ f32x4 ld4bf(const bf16_t* p) { const u32x2 u = *(const u32x2*)p; return (f32x4){bflo(u.x), bfhi(u.x), bflo(u.y), bfhi(u.y)}; }
__device__ __forceinline__ void st4bf(bf16_t* p, f32x4 v) { u32x2 o; o.x = pk2(v[0], v[1]); o.y = pk2(v[2], v[3]); *(u32x2*)p = o; }
__device__ __forceinline__ void seq_info(int row, bool& hasp, bool& hasn) {
    if (row < NLAT) { const int t = row & (TT - 1); hasp = t > 0; hasn = t < TT - 1; }
    else { const int t = (row - NLAT) & (CTXL - 1); hasp = t > 0; hasn = t < CTXL - 1; }
}
__device__ __forceinline__ void phase_ef1(const Ctx& C, const Args& A, int l) {
    const int i2 = l >> 1; unsigned char* ws = A.ws;
    const bf16_t* P = (const bf16_t*)(ws + WS_P); bf16_t* A2 = (bf16_t*)(ws + WS_A2); unsigned char* SCN = ws + WS_SCN; bf16_t* LIN = (bf16_t*)(ws + WS_LIN);
    const float* cw = A.in[I_CONVW] + (size_t)i2 * 3 * 256; const float* mu = A.in[I_MU] + (size_t)i2 * RWKV_COLS; const float* kxi = A.in[I_KXI] + (size_t)i2 * 768;
    const f32x4 z4 = {0.f, 0.f, 0.f, 0.f};
    for (int row = C.gw; row < MROWS; row += C.NGW) {
        bool hasp, hasn; seq_info(row, hasp, hasn);
        const bf16_t* p0 = P + (size_t)row * P_LD; const bf16_t* pm = p0 - P_LD; const bf16_t* pp = p0 + P_LD;
        {
            const int j4 = 4 * C.lane;
            const f32x4 bg = ld4bf(p0 + j4), u0 = ld4bf(p0 + 256 + j4) * ld4bf(p0 + 512 + j4);
            const f32x4 um = hasp ? ld4bf(pm + 256 + j4) * ld4bf(pm + 512 + j4) : z4, up = hasn ? ld4bf(pp + 256 + j4) * ld4bf(pp + 512 + j4) : z4;
            const f32x4 w0 = *(const f32x4*)(cw + j4), w1 = *(const f32x4*)(cw + 256 + j4), w2 = *(const f32x4*)(cw + 512 + j4);
            st4bf(A2 + (size_t)row * DM + j4, bg * (w0 * um + w1 * u0 + w2 * up));
        }
#pragma unroll
        for (int it = 0; it < 11; ++it) {
            const int c = it * 256 + 4 * C.lane;
            if (c < RWKV_COLS) {
                const f32x4 x0 = ld4bf(p0 + 768 + c), xm = hasp ? ld4bf(pm + 768 + c) : z4, xp = hasn ? ld4bf(pp + 768 + c) : z4, m4 = *(const f32x4*)(mu + c);
                const f32x4 ps = x0 + m4 * ((xm + xp) * 0.5f - x0);
                if (it < 3) { const int head = c >> 6, kx = c & 63; st4bf_(SCN + (size_t)(row * 12 + head) * SC_REC + SC_R + kx * 2, ps); }
                else if (it < 6) { const int c1 = c - 768, head = c1 >> 6, kx = c1 & 63; const f32x4 kv = ps * *(const f32x4*)(kxi + c1);
                    const float ss = sum16(kv[0] * kv[0] + kv[1] * kv[1] + kv[2] * kv[2] + kv[3] * kv[3]); const float rn = rsqrtf(ss + 1e-12f);
                    unsigned char* base = SCN + (size_t)(row * 12 + head) * SC_REC + kx * 2;
                    st4bf_(base + SC_KK, kv * rn); st4bf_(base + SC_KR, ps); st4bf_(base + SC_KR + 256, ps); }
                else if (it < 9) { const int c1 = c - 1536, head = c1 >> 6, kx = c1 & 63; st4bf_(SCN + (size_t)(row * 12 + head) * SC_REC + SC_V + kx * 2, ps); }
                else { const int c1 = c - 2304; f32x4 o;
                    if (c1 < 128) { o = (f32x4){tanhf(ps[0]), tanhf(ps[1]), tanhf(ps[2]), tanhf(ps[3])}; }
                    else if (c1 < 256) { o = ps; }
                    else { o = (f32x4){sigmoidf_(ps[0]), sigmoidf_(ps[1]), sigmoidf_(ps[2]), sigmoidf_(ps[3])}; }
                    st4bf(LIN + (size_t)row * LORA_K + c1, o); }
            }
        }
    }
}

__device__ __forceinline__ int scan_row(int i, int b, int d) {
    if (d == 0) return i < CTXL ? NLAT + b * CTXL + i : b * TT + (i - CTXL);
    return i < CTXL ? NLAT + b * CTXL + (CTXL - 1 - i) : b * TT + (TT - 1 - (i - CTXL));
}
__device__ __forceinline__ float red8(float v) {
    v += __uint_as_float((unsigned)__builtin_amdgcn_update_dpp(0, (int)__float_as_uint(v), 0xB1, 0xF, 0xF, true));
    v += __uint_as_float((unsigned)__builtin_amdgcn_update_dpp(0, (int)__float_as_uint(v), 0x4E, 0xF, 0xF, true));
    v += __uint_as_float((unsigned)__builtin_amdgcn_update_dpp(0, (int)__float_as_uint(v), 0x141, 0xF, 0xF, true));
    return v;
}
__device__ __forceinline__ float red16(float v) {
    v += __uint_as_float((unsigned)__builtin_amdgcn_update_dpp(0, (int)__float_as_uint(v), 0xB1, 0xF, 0xF, true));
    v += __uint_as_float((unsigned)__builtin_amdgcn_update_dpp(0, (int)__float_as_uint(v), 0x4E, 0xF, 0xF, true));
    v += __uint_as_float((unsigned)__builtin_amdgcn_update_dpp(0, (int)__float_as_uint(v), 0x141, 0xF, 0xF, true));
    v += __uint_as_float((unsigned)__builtin_amdgcn_update_dpp(0, (int)__float_as_uint(v), 0x140, 0xF, 0xF, true));
    return v;
}
__device__ __forceinline__ void phase_scan(const Ctx& C, const Args& A) {
    for (int u = blockIdx.x; u < 192; u += C.G) {
    const int half = u & 1, d = (u >> 1) & 1, h = (u >> 2) % 12, b = u / 48;
    const unsigned char* SCN = A.ws + WS_SCN; float* Y = (float*)(A.ws + WS_Y) + (size_t)d * MROWS * 768;
    LAS float* buf = (LAS float*)C.lds; LAS float* ybuf = buf + 2 * 32 * 352;
    constexpr int NCH = LKEYS / 32;
    u32x4 st[4];
    int ps_[4], psrc[4], pdst[4]; bool pf32[4];
#pragma unroll
    for (int j = 0; j < 4; ++j) { const int p = C.tid + NTHR * j; const int s = p / 52, q = p % 52; ps_[j] = s;
        if (q < 16) { psrc[j] = SC_W + 256 * d + q * 16; pdst[j] = s * 352 + q * 4; pf32[j] = true; }
        else if (q < 48) { const int vec = (q - 16) >> 3, part = (q - 16) & 7; const int so = vec == 0 ? SC_KK : vec == 1 ? SC_B + 256 * d : vec == 2 ? SC_KR + 256 * d : SC_R;
            psrc[j] = so + part * 16; pdst[j] = s * 352 + 64 * (vec + 1) + part * 8; pf32[j] = false; }
        else { const int part = q - 48; psrc[j] = SC_V + half * 64 + part * 16; pdst[j] = s * 352 + 320 + part * 8; pf32[j] = false; } }
    const int sgn = d ? -1 : 1;
    const unsigned char* SCNh = SCN + (size_t)h * SC_REC;
#define SCAN_ROW0(c) (((c) * 32 < CTXL) ? (NLAT + b * CTXL + (d ? CTXL - 1 - (c) * 32 : (c) * 32)) : (b * TT + (d ? TT - 1 - ((c) * 32 - CTXL) : (c) * 32 - CTXL)))
#define SCAN_LOADG(c) do { const int row0_ = SCAN_ROW0(c); _Pragma("unroll") for (int j = 0; j < 4; ++j) if (j < 3 || C.tid < 1664 - 3 * NTHR) { \
        st[j] = *(const u32x4*)(SCNh + (size_t)(row0_ + sgn * ps_[j]) * SC_ROW + psrc[j]); } } while (0)
#define SCAN_STORE(bi) do { _Pragma("unroll") for (int j = 0; j < 4; ++j) if (j < 3 || C.tid < 1664 - 3 * NTHR) { LAS float* dp = buf + (bi) * (32 * 352) + pdst[j]; \
        if (pf32[j]) *(LAS u32x4*)dp = st[j]; \
        else { *(LAS f32x4*)dp = (f32x4){bflo(st[j].x), bfhi(st[j].x), bflo(st[j].y), bfhi(st[j].y)}; *(LAS f32x4*)(dp + 4) = (f32x4){bflo(st[j].z), bfhi(st[j].z), bflo(st[j].w), bfhi(st[j].w)}; } } } while (0)
    SCAN_LOADG(0); SCAN_STORE(0); __syncthreads();
    f32x2 Sa = {0.f, 0.f}, Sb = {0.f, 0.f};
    const int rl = C.lane >> 4, ks = C.lane & 15;
    float ycol = 0.f;
#define SC_LD(R, s) do { const LAS float* bp_ = cur + (s) * 352 + ks * 4; \
        R##w = *(const LAS f32x4*)(bp_); R##k = *(const LAS f32x4*)(bp_ + 64); R##b = *(const LAS f32x4*)(bp_ + 128); R##q = *(const LAS f32x4*)(bp_ + 192); R##r = *(const LAS f32x4*)(bp_ + 256); \
        R##vv = cur[(s) * 352 + 320 + C.wave * 4 + rl]; } while (0)
#define SC_LO(v) ((f32x2){v[0], v[1]})
#define SC_HI(v) ((f32x2){v[2], v[3]})
#define SC_DPP(x, ctrl) __uint_as_float((unsigned)__builtin_amdgcn_update_dpp(0, (int)__float_as_uint(x), ctrl, 0xF, 0xF, true))
#define SC_STEP(R, P, s) do { \
        f32x2 pa = __builtin_elementwise_fma(Sb, SC_HI(R##k), Sa * SC_LO(R##k)), py = __builtin_elementwise_fma(Sb, SC_HI(P##r), Sa * SC_LO(P##r)); \
        float a_ = pa.x + pa.y, y_ = py.x + py.y; \
        a_ += SC_DPP(a_, 0xB1); y_ += SC_DPP(y_, 0xB1); a_ += SC_DPP(a_, 0x4E); y_ += SC_DPP(y_, 0x4E); \
        a_ += SC_DPP(a_, 0x141); y_ += SC_DPP(y_, 0x141); a_ += SC_DPP(a_, 0x140); y_ += SC_DPP(y_, 0x140); \
        ycol = (ks == ((s) & 15)) ? y_ : ycol; \
        const f32x2 na = {-a_, -a_}, vv2 = {R##vv, R##vv}; \
        Sa = __builtin_elementwise_fma(Sa, SC_LO(R##w), __builtin_elementwise_fma(na, SC_LO(R##b), vv2 * SC_LO(R##q))); \
        Sb = __builtin_elementwise_fma(Sb, SC_HI(R##w), __builtin_elementwise_fma(na, SC_HI(R##b), vv2 * SC_HI(R##q))); } while (0)
    f32x4 Aw, Ak, Ab, Aq, Ar, Bw, Bk, Bb, Bq, Br, Cw, Ck, Cb, Cq, Cr, Dw, Dk, Db, Dq, Dr; float Avv, Bvv, Cvv, Dvv;
    Dr = (f32x4){0.f, 0.f, 0.f, 0.f};
    for (int c = 0; c < NCH; ++c) {
        if (c + 1 < NCH) SCAN_LOADG(c + 1);
        {
            const LAS float* cur = buf + (c & 1) * (32 * 352);
            LAS float* yb = ybuf + (c & 1) * 1024 + C.wave * 4 + rl + ks * 32;
            SC_LD(A, 0); SC_LD(B, 1);
#pragma unroll 1
            for (int s = 0; s < 32; s += 4) {
                SC_LD(C, s + 2); __builtin_amdgcn_sched_barrier(0); SC_STEP(A, D, s); __builtin_amdgcn_sched_barrier(0);
                SC_LD(D, s + 3); __builtin_amdgcn_sched_barrier(0); SC_STEP(B, A, s + 1); __builtin_amdgcn_sched_barrier(0);
                SC_LD(A, s + 4); __builtin_amdgcn_sched_barrier(0); SC_STEP(C, B, s + 2); __builtin_amdgcn_sched_barrier(0);
                SC_LD(B, s + 5); __builtin_amdgcn_sched_barrier(0); SC_STEP(D, C, s + 3); __builtin_amdgcn_sched_barrier(0);
                if ((s & 15) == 12) yb[(s & 16) * 32] = ycol;
            }
        }
        if (c + 1 < NCH) SCAN_STORE((c + 1) & 1);
        __syncthreads();
        { const int row0_ = SCAN_ROW0(c);
#pragma unroll
          for (int i = 0; i < 2; ++i) { const int e = C.tid + NTHR * i, s = e >> 5, r = e & 31;
            const int row = (s > 0) ? row0_ + sgn * (s - 1) : scan_row(c * 32 - 1, b, d);
            if (s > 0 || c > 0) Y[(size_t)row * 768 + h * 64 + half * 32 + r] = ybuf[(c & 1) * 1024 + e]; } }
    }
    {
        f32x2 py = __builtin_elementwise_fma(Sb, SC_HI(Dr), Sa * SC_LO(Dr)); float y_ = py.x + py.y;
        y_ += SC_DPP(y_, 0xB1); y_ += SC_DPP(y_, 0x4E); y_ += SC_DPP(y_, 0x141); y_ += SC_DPP(y_, 0x140);
        if (ks == 0) Y[(size_t)scan_row(LKEYS - 1, b, d) * 768 + h * 64 + half * 32 + C.wave * 4 + rl] = y_;
    }
    __syncthreads();
    }
#undef SCAN_LOADG
#undef SCAN_STORE
#undef SCAN_ROW0
#undef SC_LD
#undef SC_STEP
#undef SC_LO
#undef SC_HI
#undef SC_DPP
}

constexpr int CSP = 72;
constexpr int CS_MAT = 64 * CSP * 2;
constexpr int CS_WT = 0, CS_KB = CS_MAT, CS_BB = 2 * CS_MAT, CS_RT = 3 * CS_MAT, CS_BHT = 4 * CS_MAT, CS_KHT = 5 * CS_MAT, CS_VMT = 6 * CS_MAT;
constexpr int CS_M2F = 7 * CS_MAT;
constexpr int CS_M1T = CS_M2F + 16384;
constexpr int CS_N2 = CS_M1T + CS_MAT;
constexpr int CS_GT = CS_N2 + CS_MAT;
constexpr int CS_Z = CS_M2F, CS_U = CS_M2F + CS_MAT;
constexpr int CS_GL = CS_GT + 2 * CS_MAT;
static_assert(CS_GL + 256 <= LDS_MISC, "chunked-scan LDS map");
template <bool SWZB = false>
__device__ __forceinline__ void cs_mma(f32x16& acc, const LAS unsigned char* Am, const LAS unsigned char* Bm, int ti, int tj, int r32, int hi) {
    const LAS unsigned char* ap = Am + (ti * 32 + r32) * (CSP * 2) + hi * 16; const int brow = tj * 32 + r32; const LAS unsigned char* bp = Bm + brow * (CSP * 2);
    const int sw = SWZB ? ((brow >> 3) & 7) : 0;
#pragma unroll
    for (int ks = 0; ks < 4; ++ks) acc = __builtin_amdgcn_mfma_f32_32x32x16_bf16(*(const LAS bf16x8*)(ap + ks * 32), *(const LAS bf16x8*)(bp + (((ks * 2 + hi) ^ sw) * 16)), acc, 0, 0, 0);
}
__device__ __forceinline__ void cs_store_t(LAS unsigned char* Om, const f32x16& acc, int ti, int tj, int r32, int hi) {
    LAS unsigned char* op = Om + (tj * 32 + r32) * (CSP * 2) + (ti * 32 + 4 * hi) * 2;
#pragma unroll
    for (int g = 0; g < 4; ++g) { u32x2 o; o.x = pk2(acc[4 * g], acc[4 * g + 1]); o.y = pk2(acc[4 * g + 2], acc[4 * g + 3]); *(LAS u32x2*)(op + g * 16) = o; }
}
#define CS_BAR() asm volatile("s_waitcnt lgkmcnt(0)\n\ts_barrier" ::: "memory")
__device__ __forceinline__ void phase_csa(const Ctx& C, const Args& A) {
    const unsigned char* SCN = A.ws + WS_SCN; unsigned char* CHK = A.ws + WS_CHK;
    LAS unsigned char* L = C.lds;
    const int r32 = C.lane & 31, hi = C.lane >> 5;
    float lwv[8]; u32x4 ukk, ub, ukr, ur, uv;
#define CSA_GEOM(cu_) const int unit = (cu_) / CS_NCH, ch = (cu_) % CS_NCH; const int d = unit & 1, h = (unit >> 1) % 12, b = unit / 24; \
        const int step0 = ch * CS_L; const int sgn = d ? -1 : 1; \
        const int row0 = (step0 < CTXL) ? (NLAT + b * CTXL + (d ? CTXL - 1 - step0 : step0)) : (b * TT + (d ? TT - 1 - (step0 - CTXL) : step0 - CTXL)); \
        const unsigned char* rec0 = SCN + (size_t)row0 * SC_ROW + (size_t)h * SC_REC;
#define CSA_LOAD(cu_) do { CSA_GEOM(cu_); \
        { const int k = C.tid & 63, sg = C.tid >> 6; _Pragma("unroll") for (int j = 0; j < 8; ++j) lwv[j] = *(const float*)(rec0 + (long)sgn * (8 * sg + j) * SC_ROW + SC_W + 256 * d + k * 4); } \
        { const int t = C.tid >> 3, k0 = (C.tid & 7) * 8; const unsigned char* rp = rec0 + (long)sgn * t * SC_ROW; \
          ukk = *(const u32x4*)(rp + SC_KK + k0 * 2); ub = *(const u32x4*)(rp + SC_B + 256 * d + k0 * 2); ukr = *(const u32x4*)(rp + SC_KR + 256 * d + k0 * 2); ur = *(const u32x4*)(rp + SC_R + k0 * 2); uv = *(const u32x4*)(rp + SC_V + k0 * 2); } } while (0)
    if ((int)blockIdx.x < CS_UNITS * CS_NCH) CSA_LOAD((int)blockIdx.x);
    for (int cu = blockIdx.x; cu < CS_UNITS * CS_NCH; cu += C.G) {
        LAS float* csf = (LAS float*)(L + CS_M2F);
        LAS float* seg = (LAS float*)(L + CS_N2);
        { const int k = C.tid & 63, sg = C.tid >> 6;
#pragma unroll
          for (int j = 1; j < 8; ++j) lwv[j] += lwv[j - 1];
          seg[sg * 64 + k] = lwv[7];
          CS_BAR();
          float off = 0.f, tot = 0.f;
#pragma unroll
          for (int s2 = 0; s2 < 8; ++s2) { const float v = seg[s2 * 64 + k]; off += (s2 < sg) ? v : 0.f; tot += v; }
#pragma unroll
          for (int j = 0; j < 8; ++j) csf[(8 * sg + j) * 65 + k] = lwv[j] + off;
          if (sg == 7) ((LAS float*)(L + CS_GL))[k] = __expf(tot); }
        CS_BAR();
        { const int t = C.tid >> 3, k0 = (C.tid & 7) * 8;
          float wt[8], kb[8], bb[8], rt[8], bh[8], kh[8];
#pragma unroll
          for (int j = 0; j < 8; ++j) { const unsigned pkk = j < 2 ? ukk.x : j < 4 ? ukk.y : j < 6 ? ukk.z : ukk.w, pb = j < 2 ? ub.x : j < 4 ? ub.y : j < 6 ? ub.z : ub.w, pkr = j < 2 ? ukr.x : j < 4 ? ukr.y : j < 6 ? ukr.z : ukr.w, pr = j < 2 ? ur.x : j < 4 ? ur.y : j < 6 ? ur.z : ur.w;
              const float kkv = (j & 1) ? bfhi(pkk) : bflo(pkk), bv = (j & 1) ? bfhi(pb) : bflo(pb), krv = (j & 1) ? bfhi(pkr) : bflo(pkr), rv = (j & 1) ? bfhi(pr) : bflo(pr);
              const float cst = csf[t * 65 + k0 + j], csp = t > 0 ? csf[(t - 1) * 65 + k0 + j] : 0.f, csl = csf[63 * 65 + k0 + j];
              const float einv = __expf(-cst), el = __expf(csl - cst);
              wt[j] = kkv * __expf(csp); kb[j] = krv * einv; bb[j] = bv * einv; rt[j] = rv * __expf(cst); bh[j] = bv * el; kh[j] = krv * el; }
          u32x4 o;
          o.x = pk2(wt[0], wt[1]); o.y = pk2(wt[2], wt[3]); o.z = pk2(wt[4], wt[5]); o.w = pk2(wt[6], wt[7]); *(LAS u32x4*)(L + CS_WT + t * (CSP * 2) + k0 * 2) = o;
          o.x = pk2(kb[0], kb[1]); o.y = pk2(kb[2], kb[3]); o.z = pk2(kb[4], kb[5]); o.w = pk2(kb[6], kb[7]); *(LAS u32x4*)(L + CS_KB + t * (CSP * 2) + k0 * 2) = o;
          o.x = pk2(bb[0], bb[1]); o.y = pk2(bb[2], bb[3]); o.z = pk2(bb[4], bb[5]); o.w = pk2(bb[6], bb[7]); *(LAS u32x4*)(L + CS_BB + t * (CSP * 2) + k0 * 2) = o;
          o.x = pk2(rt[0], rt[1]); o.y = pk2(rt[2], rt[3]); o.z = pk2(rt[4], rt[5]); o.w = pk2(rt[6], rt[7]); *(LAS u32x4*)(L + CS_RT + t * (CSP * 2) + k0 * 2) = o;
#pragma unroll
          for (int j = 0; j < 8; ++j) { const int to = ((((t >> 3) ^ ((k0 >> 3) & 7)) * 8) + (t & 7)) * 2;
              *(LAS bf16_t*)(L + CS_BHT + (k0 + j) * (CSP * 2) + to) = (bf16_t)f2bf(bh[j]); *(LAS bf16_t*)(L + CS_KHT + (k0 + j) * (CSP * 2) + to) = (bf16_t)f2bf(kh[j]);
              const unsigned pv = j < 2 ? uv.x : j < 4 ? uv.y : j < 6 ? uv.z : uv.w; *(LAS bf16_t*)(L + CS_VMT + (k0 + j) * (CSP * 2) + to) = (bf16_t)((j & 1) ? (pv >> 16) : (pv & 0xffffu)); } }
        if (cu + C.G < CS_UNITS * CS_NCH) CSA_LOAD(cu + C.G);
        CS_BAR();
        for (int job = C.wave; job < 12; job += NWAVES) { const int p = job >> 2, ti = (job >> 1) & 1, tj = job & 1;
            f32x16 acc;
#pragma unroll
            for (int i = 0; i < 16; ++i) acc[i] = 0.f;
            if (p == 0) { cs_mma(acc, L + CS_WT, L + CS_BB, ti, tj, r32, hi);
                const int i = tj * 32 + r32; LAS float* mp = (LAS float*)(L + CS_M2F) + i * 64;
#pragma unroll
                for (int reg = 0; reg < 16; ++reg) { const int t = ti * 32 + crow(reg, hi); mp[(t & 3) * 16 + (t >> 2)] = (i < t) ? acc[reg] : 0.f; } }
            else if (p == 1) { cs_mma(acc, L + CS_WT, L + CS_KB, ti, tj, r32, hi);
                const int i = tj * 32 + r32;
#pragma unroll
                for (int reg = 0; reg < 16; ++reg) { const int t = ti * 32 + crow(reg, hi); acc[reg] = (i < t) ? acc[reg] : 0.f; }
                cs_store_t(L + CS_M1T, acc, ti, tj, r32, hi); }
            else { cs_mma(acc, L + CS_BB, L + CS_RT, ti, tj, r32, hi);
                const int t = tj * 32 + r32;
#pragma unroll
                for (int reg = 0; reg < 16; ++reg) { const int i = ti * 32 + crow(reg, hi); acc[reg] = (i <= t) ? acc[reg] : 0.f; }
                cs_store_t(L + CS_N2, acc, ti, tj, r32, hi); } }
        CS_BAR();
        { const int c = C.tid >> 2, q = C.tid & 3; float acc[16];
          { const LAS unsigned char* rcol = (c < 64) ? (L + CS_WT + c * 2) : (L + CS_M1T + (c - 64) * (CSP * 2)); const int rstride = (c < 64) ? CSP * 2 : 2;
#pragma unroll
            for (int j = 0; j < 16; ++j) acc[j] = bf2f(*(const LAS bf16_t*)(rcol + (4 * j + q) * rstride)); }
          const LAS float* m2c = (const LAS float*)(L + CS_M2F) + q * 16;
#pragma clang loop unroll(full)
          for (int i = 0; i < 64; ++i) {
              const float mine = -acc[i >> 2];
              float gi;
              switch (i & 3) { case 0: gi = __uint_as_float((unsigned)__builtin_amdgcn_update_dpp(0, (int)__float_as_uint(mine), 0x00, 0xF, 0xF, true)); break;
                               case 1: gi = __uint_as_float((unsigned)__builtin_amdgcn_update_dpp(0, (int)__float_as_uint(mine), 0x55, 0xF, 0xF, true)); break;
                               case 2: gi = __uint_as_float((unsigned)__builtin_amdgcn_update_dpp(0, (int)__float_as_uint(mine), 0xAA, 0xF, 0xF, true)); break;
                               default: gi = __uint_as_float((unsigned)__builtin_amdgcn_update_dpp(0, (int)__float_as_uint(mine), 0xFF, 0xF, 0xF, true)); break; }
#pragma unroll
              for (int j4 = (i >> 4); j4 < 4; ++j4) { const f32x4 m = *(const LAS f32x4*)(m2c + i * 64 + j4 * 4);
#pragma unroll
                  for (int e = 0; e < 4; ++e) if (4 * j4 + e >= (i >> 2)) acc[4 * j4 + e] += m[e] * gi; }
          }
#pragma unroll
          for (int j = 0; j < 16; ++j) *(LAS bf16_t*)(L + CS_GT + c * (CSP * 2) + (4 * j + q) * 2) = (bf16_t)f2bf(-acc[j]); }
        CS_BAR();
        unsigned char* outp = CHK + (size_t)cu * 32768;
        for (int job = C.wave; job < 16; job += NWAVES) { const int p = job >> 2, ti = (job >> 1) & 1, tj = job & 1;
            f32x16 acc;
            if (p == 0) {
                const LAS unsigned char* rp = L + CS_RT + (tj * 32 + r32) * (CSP * 2) + (ti * 32 + 4 * hi) * 2;
#pragma unroll
                for (int g = 0; g < 4; ++g) { const u32x2 u = *(const LAS u32x2*)(rp + g * 16); acc[4 * g] = bflo(u.x); acc[4 * g + 1] = bfhi(u.x); acc[4 * g + 2] = bflo(u.y); acc[4 * g + 3] = bfhi(u.y); }
                cs_mma(acc, L + CS_GT, L + CS_N2, ti, tj, r32, hi);
#pragma unroll
                for (int g = 0; g < 4; ++g) { u32x2 o; o.x = pk2(acc[4 * g], acc[4 * g + 1]); o.y = pk2(acc[4 * g + 2], acc[4 * g + 3]);
                    *(u32x2*)(outp + 8192 + (((tj * 4 + 2 * ti + (g >> 1)) * 64 + (g & 1) * 32 + r32) * 16) + hi * 8) = o; } }
            else if (p == 1) {
#pragma unroll
                for (int i = 0; i < 16; ++i) acc[i] = 0.f;
                cs_mma(acc, L + CS_KB, L + CS_RT, ti, tj, r32, hi);
                const int t = tj * 32 + r32;
#pragma unroll
                for (int reg = 0; reg < 16; ++reg) { const int i = ti * 32 + crow(reg, hi); acc[reg] = (i <= t) ? acc[reg] : 0.f; }
                cs_mma(acc, L + CS_GT + 64 * (CSP * 2), L + CS_N2, ti, tj, r32, hi);
                cs_store_t(L + CS_Z, acc, ti, tj, r32, hi); }
            else if (p == 2) {
#pragma unroll
                for (int i = 0; i < 16; ++i) acc[i] = 0.f;
                cs_mma<true>(acc, L + CS_GT, L + CS_BHT, ti, tj, r32, hi);
                const int k = tj * 32 + r32; const float gl = ((const LAS float*)(L + CS_GL))[k];
#pragma unroll
                for (int reg = 0; reg < 16; ++reg) { const int cc = ti * 32 + crow(reg, hi); acc[reg] += (cc == k) ? gl : 0.f; }
#pragma unroll
                for (int g = 0; g < 4; ++g) { u32x2 o; o.x = pk2(acc[4 * g], acc[4 * g + 1]); o.y = pk2(acc[4 * g + 2], acc[4 * g + 3]);
                    *(u32x2*)(outp + (((tj * 4 + 2 * ti + (g >> 1)) * 64 + (g & 1) * 32 + r32) * 16) + hi * 8) = o; } }
            else {
                const int krow = tj * 32 + r32; const LAS unsigned char* kp = L + CS_KHT + krow * (CSP * 2) + hi * 8;
#pragma unroll
                for (int g = 0; g < 4; ++g) { const u32x2 u = *(const LAS u32x2*)(kp + (((ti * 4 + g) ^ ((krow >> 3) & 7)) * 16)); acc[4 * g] = bflo(u.x); acc[4 * g + 1] = bfhi(u.x); acc[4 * g + 2] = bflo(u.y); acc[4 * g + 3] = bfhi(u.y); }
                cs_mma<true>(acc, L + CS_GT + 64 * (CSP * 2), L + CS_BHT, ti, tj, r32, hi);
                cs_store_t(L + CS_U, acc, ti, tj, r32, hi); } }
        CS_BAR();
        { const int p = C.wave >> 2, ti = (C.wave >> 1) & 1, tj = C.wave & 1;
          f32x16 acc;
#pragma unroll
          for (int i = 0; i < 16; ++i) acc[i] = 0.f;
          cs_mma<true>(acc, L + (p ? CS_U : CS_Z), L + CS_VMT, ti, tj, r32, hi);
          unsigned char* op = outp + (p ? 16384 : 24576) + ((ti * 2 + tj) * 64 + C.lane) * 32;
          u32x4 o0, o1; o0.x = pk2(acc[0], acc[1]); o0.y = pk2(acc[2], acc[3]); o0.z = pk2(acc[4], acc[5]); o0.w = pk2(acc[6], acc[7]);
          o1.x = pk2(acc[8], acc[9]); o1.y = pk2(acc[10], acc[11]); o1.z = pk2(acc[12], acc[13]); o1.w = pk2(acc[14], acc[15]);
          *(u32x4*)op = o0; *(u32x4*)(op + 16) = o1; }
        CS_BAR();
    }
}
__device__ __forceinline__ void phase_csb(const Ctx& C, const Args& A, int l) {
    if ((int)blockIdx.x >= CS_UNITS) { conv_items(C, A, l + 1, ((int)blockIdx.x - CS_UNITS) * NWAVES + C.wave, (C.G - CS_UNITS) * NWAVES, true, false, true); return; }
    const unsigned char* CHK = A.ws + WS_CHK;
    LAS unsigned char* L = C.lds;
    const int r32 = C.lane & 31, hi = C.lane >> 5;
    const bool isS = C.wave < 4; const int ti = (C.wave >> 1) & 1, tj = C.wave & 1;
    for (int unit = blockIdx.x; unit < CS_UNITS; unit += C.G) {
        const int d = unit & 1, h = (unit >> 1) % 12, b = unit / 24;
        float* Y = (float*)(A.ws + WS_Y) + (size_t)d * MROWS * 768;
        for (int i = C.tid; i < 2 * CS_MAT / 4; i += NTHR) ((LAS unsigned*)L)[i] = 0u;
        CS_BAR();
        bf16x8 afA[4], afB[4], afC[4]; u32x4 cA0, cA1, cB0, cB1, cC0, cC1;
#define CSB_LOAD(A4, C0, C1, ch_) do { const unsigned char* op_ = CHK + ((size_t)unit * CS_NCH + (ch_)) * 32768; \
            const unsigned char* am_ = op_ + (isS ? 0 : 8192) + (ti * 4 * 64 + C.lane) * 16;     \
            _Pragma("unroll") for (int ks = 0; ks < 4; ++ks) A4[ks] = *(const bf16x8*)(am_ + ks * 1024); \
            const unsigned char* cp_ = op_ + (isS ? 16384 : 24576) + ((ti * 2 + tj) * 64 + C.lane) * 32; C0 = *(const u32x4*)cp_; C1 = *(const u32x4*)(cp_ + 16); } while (0)
#define CSB_STEP(A4, C0, C1, ch_) do { \
            const LAS unsigned char* Sb = L + ((ch_) & 1) * CS_MAT; LAS unsigned char* Sn = L + (((ch_) + 1) & 1) * CS_MAT; \
            f32x16 acc; \
            acc[0] = bflo(C0.x); acc[1] = bfhi(C0.x); acc[2] = bflo(C0.y); acc[3] = bfhi(C0.y); acc[4] = bflo(C0.z); acc[5] = bfhi(C0.z); acc[6] = bflo(C0.w); acc[7] = bfhi(C0.w); \
            acc[8] = bflo(C1.x); acc[9] = bfhi(C1.x); acc[10] = bflo(C1.y); acc[11] = bfhi(C1.y); acc[12] = bflo(C1.z); acc[13] = bfhi(C1.z); acc[14] = bflo(C1.w); acc[15] = bfhi(C1.w); \
            const LAS unsigned char* bp = Sb + (tj * 32 + r32) * (CSP * 2) + hi * 16; \
            _Pragma("unroll") for (int ks = 0; ks < 4; ++ks) acc = __builtin_amdgcn_mfma_f32_32x32x16_bf16(A4[ks], *(const LAS bf16x8*)(bp + ks * 32), acc, 0, 0, 0); \
            if (isS) { cs_store_t(Sn, acc, ti, tj, r32, hi); }     \
            else {     \
                const int step0 = (ch_) * CS_L; const int sgn = d ? -1 : 1; \
                const int row0 = (step0 < CTXL) ? (NLAT + b * CTXL + (d ? CTXL - 1 - step0 : step0)) : (b * TT + (d ? TT - 1 - (step0 - CTXL) : step0 - CTXL)); \
                float* yp = Y + (size_t)(row0 + sgn * (ti * 32 + 4 * hi)) * 768 + h * 64 + tj * 32 + r32; const long ys = (long)sgn * 768; \
                _Pragma("unroll") for (int reg = 0; reg < 16; ++reg) yp[ys * ((reg & 3) + 8 * (reg >> 2))] = acc[reg]; } \
            CS_BAR(); } while (0)
        CSB_LOAD(afA, cA0, cA1, 0); CSB_LOAD(afB, cB0, cB1, 1);
        static_assert(CS_NCH % 3 == 0, "chunk loop is unrolled by three");
        for (int ch = 0; ch < CS_NCH; ch += 3) {
            if (ch == 0) CSB_LOAD(afC, cC0, cC1, 2);
            CSB_STEP(afA, cA0, cA1, ch);     if (ch + 3 < CS_NCH) CSB_LOAD(afA, cA0, cA1, ch + 3);
            CSB_STEP(afB, cB0, cB1, ch + 1); if (ch + 4 < CS_NCH) CSB_LOAD(afB, cB0, cB1, ch + 4);
            CSB_STEP(afC, cC0, cC1, ch + 2); if (ch + 5 < CS_NCH) CSB_LOAD(afC, cC0, cC1, ch + 5);
        }
        CS_BAR();
    }
#undef CSB_LOAD
#undef CSB_STEP
}

#undef CS_BAR
__device__ __forceinline__ void phase_ef2(const Ctx& C, const Args& A, int l) {
    const int i2 = l >> 1; unsigned char* ws = A.ws;
    const unsigned char* SCN = ws + WS_SCN; const float* Y0 = (const float*)(ws + WS_Y); const float* Y1 = Y0 + (size_t)MROWS * 768;
    const bf16_t* G = (const bf16_t*)(ws + WS_G); bf16_t* A2 = (bf16_t*)(ws + WS_A2);
    const float* rb = A.in[I_RBON] + (size_t)i2 * 768; const float* gg = A.in[I_GNG] + (size_t)i2 * 768; const float* gb = A.in[I_GNB] + (size_t)i2 * 768;
    for (int row = C.gw; row < MROWS; row += C.NGW) {
#pragma unroll
        for (int it = 0; it < 3; ++it) {
            const int c = it * 256 + 4 * C.lane, head = c >> 6, kx = c & 63;
            const f32x4 y = *(const f32x4*)(Y0 + (size_t)row * 768 + c) + *(const f32x4*)(Y1 + (size_t)row * 768 + c);
            const float mean = sum16((y[0] + y[1]) + (y[2] + y[3])) * (1.f / 64.f);
            const f32x4 dd = y - mean;
            const float var = sum16((dd[0] * dd[0] + dd[1] * dd[1]) + (dd[2] * dd[2] + dd[3] * dd[3])) * (1.f / 64.f);
            const float rstd = rsqrtf(var + GN_EPS);
            const unsigned char* base = SCN + (size_t)(row * 12 + head) * SC_REC + kx * 2;
            const f32x4 r = ld4bf_(base + SC_R), v = ld4bf_(base + SC_V), k0 = ld4bf_(base + SC_KR), k1 = ld4bf_(base + SC_KR + 256);
            const f32x4 rb4 = *(const f32x4*)(rb + c);
            const f32x4 t = r * (k0 + k1) * 0.5f * rb4;
            const float bs = sum16((t[0] + t[1]) + (t[2] + t[3]));
            const f32x4 yn = dd * rstd * *(const f32x4*)(gg + c) + *(const f32x4*)(gb + c);
            const f32x4 g = ld4bf(G + (size_t)row * 768 + c);
            st4bf(A2 + (size_t)row * DM + 256 + c, g * (yn + v * bs));
        }
    }
}

__device__ __forceinline__ void phase_of1(const Ctx& C, const Args& A, int l) {
    const int i2 = l >> 1; unsigned char* ws = A.ws;
    const bf16_t* P = (const bf16_t*)(ws + WS_P); bf16_t* A2 = (bf16_t*)(ws + WS_A2); bf16_t* VT = (bf16_t*)(ws + WS_VT);
    const float* lng = A.in[I_GLNG] + (size_t)i2 * 256; const float* lnb = A.in[I_GLNB] + (size_t)i2 * 256;
    const float* gws = A.in[I_GWS] + (size_t)i2 * 4 * 128 * 128; const float* gbs = A.in[I_GBS] + (size_t)i2 * 4 * 128;
    LAS bf16_t* vt = (LAS bf16_t*)C.lds;
    LAS bf16_t* uL = (LAS bf16_t*)C.lds;
    LAS bf16_t* vT = (LAS bf16_t*)(C.lds + 128 * 528);
    const int r32 = C.lane & 31, hi = C.lane >> 5;
    for (int it = blockIdx.x; it < 256 + 8 * 7; it += C.G) {
        const bool isctx = it >= 256; const int uc = isctx ? (it - 256) / 7 : 0, pc = isctx ? (it - 256) % 7 : 0; const int u = it;
        const int b = isctx ? (uc >> 1) : (u >> 6), pos0 = isctx ? (uc & 1) * 128 : (u & 63) * 128;
        const int row0 = isctx ? NLAT + b * CTXL + pos0 : b * TT + pos0, L0 = isctx ? pos0 : CTXL + pos0;
        const int hh0 = isctx ? pc : 0, hh1 = isctx ? (pc < 6 ? pc + 1 : 0) : 6; const bool doC = !isctx || pc == 6;
        for (int hh = hh0; hh < hh1; ++hh) {
#pragma unroll
            for (int i = 0; i < 4; ++i) { const int piece = C.tid + NTHR * i, r = piece >> 4, part = piece & 15;
                *(LAS u32x4*)(vt + r * 136 + part * 8) = *(const u32x4*)(P + (size_t)(row0 + r) * P_LD + 1536 + hh * 128 + part * 8); }
            __syncthreads();
#pragma unroll
            for (int i = 0; i < 4; ++i) { const int item = C.tid + NTHR * i, d = item >> 4, tg = item & 15; const LAS bf16_t* s = vt + (tg * 8) * 136 + d;
                u32x4 o; o.x = (unsigned)s[0] | ((unsigned)s[136] << 16); o.y = (unsigned)s[2 * 136] | ((unsigned)s[3 * 136] << 16);
                o.z = (unsigned)s[4 * 136] | ((unsigned)s[5 * 136] << 16); o.w = (unsigned)s[6 * 136] | ((unsigned)s[7 * 136] << 16);
                *(u32x4*)(VT + ((size_t)(b * 6 + hh) * 128 + d) * LKEYS + L0 + tg * 8) = o; }
            __syncthreads();
        }
        if (doC) {
        for (int r = C.wave; r < 128; r += NWAVES) {
            const int c4 = 4 * C.lane; const bf16_t* pr = P + (size_t)(row0 + r) * P_LD + 2304;
            const f32x4 ur = ld4bf(pr + c4), raw = ld4bf(pr + 256 + c4);
            { const f32x4 gu = {gelu_erf(ur[0]), gelu_erf(ur[1]), gelu_erf(ur[2]), gelu_erf(ur[3])}; u32x2 o; o.x = pk2(gu[0], gu[1]); o.y = pk2(gu[2], gu[3]); *(LAS u32x2*)(uL + r * 264 + c4) = o; }
            const f32x4 gv = {gelu_erf(raw[0]), gelu_erf(raw[1]), gelu_erf(raw[2]), gelu_erf(raw[3])};
            const float mean = wave_sum((gv[0] + gv[1]) + (gv[2] + gv[3])) * (1.f / 256.f); const f32x4 dd = gv - mean;
            const float var = wave_sum((dd[0] * dd[0] + dd[1] * dd[1]) + (dd[2] * dd[2] + dd[3] * dd[3])) * (1.f / 256.f); const float rstd = rsqrtf(var + LN_EPS);
            const f32x4 o = dd * rstd * *(const f32x4*)(lng + c4) + *(const f32x4*)(lnb + c4);
#pragma unroll
            for (int k = 0; k < 4; ++k) vT[(c4 + k) * 136 + r] = (bf16_t)f2bf(o[k]);
        }
        __syncthreads();
        {
            const int g = C.wave >> 1, cblk = C.wave & 1, cc = g * 64 + cblk * 32 + r32;
            for (int pblk = 0; pblk < 4; ++pblk) {
                f32x16 acc;
#pragma unroll
                for (int i = 0; i < 16; ++i) acc[i] = 0.f;
                const float* wrow = gws + ((size_t)g * 128 + pblk * 32 + r32) * 128 + 8 * hi;
#pragma unroll
                for (int ks = 0; ks < 8; ++ks) { const f32x4 w0 = *(const f32x4*)(wrow + ks * 16), w1 = *(const f32x4*)(wrow + ks * 16 + 4);
                    u32x4 au; au.x = pk2(w0[0], w0[1]); au.y = pk2(w0[2], w0[3]); au.z = pk2(w1[0], w1[1]); au.w = pk2(w1[2], w1[3]);
                    const bf16x8 bf = *(const LAS bf16x8*)(vT + cc * 136 + ks * 16 + 8 * hi);
                    acc = __builtin_amdgcn_mfma_f32_32x32x16_bf16(__builtin_bit_cast(bf16x8, au), bf, acc, 0, 0, 0); }
#pragma unroll
                for (int reg = 0; reg < 16; ++reg) { const int p = pblk * 32 + crow(reg, hi);
                    const float uu = bf2f(uL[p * 264 + cc]); const float mixed = acc[reg] + gbs[g * 128 + p];
                    uL[p * 264 + cc] = (bf16_t)f2bf(uu * mixed); }
            }
        }
        __syncthreads();
#pragma unroll
        for (int i = 0; i < 8; ++i) { const int piece = C.tid + NTHR * i, r = piece >> 5, part = piece & 31;
            *(u32x4*)(A2 + (size_t)(row0 + r) * DM + 768 + part * 8) = *(const LAS u32x4*)(uL + r * 264 + part * 8); }
        __syncthreads();
        }
    }
}

__device__ __forceinline__ void phase_attn(const Ctx& C, const Args& A, int l) {
    const int i2 = l >> 1; unsigned char* ws = A.ws;
    const bf16_t* Q = (const bf16_t*)(ws + WS_Q); const bf16_t* KA = (const bf16_t*)(ws + WS_KA); const bf16_t* VT = (const bf16_t*)(ws + WS_VT); bf16_t* A2 = (bf16_t*)(ws + WS_A2);
    const float lam_init = 0.8f - 0.6f * expf(-0.3f * (float)l);
    float s1 = 0.f, s2 = 0.f;
    for (int j = 0; j < 64; ++j) { s1 += A.in[I_LQ1][i2 * 64 + j] * A.in[I_LK1][i2 * 64 + j]; s2 += A.in[I_LQ2][i2 * 64 + j] * A.in[I_LK2][i2 * 64 + j]; }
    const float lam = expf(s1) - expf(s2) + lam_init;
    const float* subg = A.in[I_SUBG] + (size_t)i2 * 128;
    const int r32 = C.lane & 31, hi = C.lane >> 5, map = C.wave >> 2, qw = C.wave & 3;
    LAS unsigned char* Kt = C.lds; LAS unsigned char* Vt = C.lds + 2 * 16384; LAS float* xch = (LAS float*)C.lds;
    const int NU = 1536 + (l == 1 ? 48 : 0);
    for (int n = C.vcu; n < NU; n += C.G) {
        int bh, qt; bool isctx = false;
        if (n < 1536) { const int round = n >> 8, slot = n & 255; bh = (slot >> 5) * 3 + (round >> 1); qt = (round & 1) * 32 + (slot & 31); }
        else { isctx = true; bh = (n - 1536) >> 1; qt = (n - 1536) & 1; }
        const int b = bh / 6, h = bh % 6;
        const int qrow0 = isctx ? NLAT + b * CTXL + qt * 128 : b * TT + qt * 128;
        const int NT = isctx ? CTXL / 64 : LKEYS / 64;
        const bf16_t* Kb = KA + (size_t)b * LKEYS * 768 + h * 128;
        const bf16_t* Vb = VT + (size_t)(b * 6 + h) * 128 * LKEYS;
        bf16x8 qf[4];
        { const bf16_t* qp = Q + (size_t)(qrow0 + qw * 32 + r32) * 768 + h * 128 + map * 64 + 8 * hi;
#pragma unroll
          for (int ks = 0; ks < 4; ++ks) qf[ks] = *(const bf16x8*)(qp + ks * 16); }
        f32x16 O[4];
#pragma unroll
        for (int d = 0; d < 4; ++d)
#pragma unroll
            for (int i = 0; i < 16; ++i) O[d][i] = 0.f;
        float m = 0.f, lsum = 0.f;
        unsigned ksrc[2], vsrc[2];
#pragma unroll
        for (int i = 0; i < 2; ++i) { const int row = 4 * (2 * C.wave + i) + (C.lane >> 4), x = row & 15, pi = x < 4 ? x : x < 8 ? x + 4 : x < 12 ? x - 4 : x;
            ksrc[i] = (unsigned)(((row & ~15) + pi) * 768 + (((C.lane & 15) ^ x) * 8));
            const int d = 8 * (2 * C.wave + i) + (C.lane >> 3); vsrc[i] = (unsigned)(d * LKEYS + (((C.lane & 7) ^ ((d >> 1) & 7)) * 8)); }
#define AT_DMA_K(tt, slot) do { _Pragma("unroll") for (int i = 0; i < 2; ++i) __builtin_amdgcn_global_load_lds((const unsigned*)(Kb + (size_t)(tt) * 64 * 768 + ksrc[i]), (LAS unsigned*)(Kt + (slot) * 16384 + (2 * C.wave + i) * 1024), 16, 0, 0); } while (0)
#define AT_DMA_V(tt, slot) do { _Pragma("unroll") for (int i = 0; i < 2; ++i) __builtin_amdgcn_global_load_lds((const unsigned*)(Vb + (size_t)(tt) * 64 + vsrc[i]), (LAS unsigned*)(Vt + (slot) * 16384 + (2 * C.wave + i) * 1024), 16, 0, 0); } while (0)
#define AT_BAR() asm volatile("s_waitcnt vmcnt(0) lgkmcnt(0)\n\ts_barrier" ::: "memory")
#define AT_SB() __builtin_amdgcn_sched_barrier(0)
        const int ksw = r32 & 15, vsw = (r32 >> 1) & 7;
#define AT_QK(P0, P1, ks_) do { const float nm_ = -m; _Pragma("unroll") for (int i = 0; i < 16; ++i) { P0[i] = nm_; P1[i] = nm_; } \
            const LAS unsigned char* kbp_ = Kt + (ks_) * 16384 + r32 * 256; \
            _Pragma("unroll") for (int ks = 0; ks < 4; ++ks) { const int co_ = ((map * 8 + ks * 2 + hi) ^ ksw) * 16; \
                P0 = __builtin_amdgcn_mfma_f32_32x32x16_bf16(*(const LAS bf16x8*)(kbp_ + co_), qf[ks], P0, 0, 0, 0); P1 = __builtin_amdgcn_mfma_f32_32x32x16_bf16(*(const LAS bf16x8*)(kbp_ + 32 * 256 + co_), qf[ks], P1, 0, 0, 0); } } while (0)
#define AT_LDV(dst, vs_, d) do { _Pragma("unroll") for (int kst = 0; kst < 4; ++kst) dst[kst] = *(const LAS u32x4*)(Vt + (vs_) * 16384 + ((d) * 32 + r32) * 128 + (((kst * 2 + hi) ^ vsw) * 16)); } while (0)
#define AT_PV(src, d) do { _Pragma("unroll") for (int kst = 0; kst < 4; ++kst) O[d] = __builtin_amdgcn_mfma_f32_32x32x16_bf16(__builtin_bit_cast(bf16x8, src[kst]), pb[kst], O[d], 0, 0, 0); } while (0)
#define AT_SOFTPV(P0, P1, N0, N1, first, hasn, vs_) do { \
            asm volatile("s_nop 15\n\ts_nop 7" : "+v"(P0), "+v"(P1)); \
            float mx = max3f(P0[0], P0[1], P1[0]), mx2 = max3f(P0[2], P0[3], P1[1]); mx = max3f(mx, P1[2], P1[3]); \
            _Pragma("unroll") for (int i = 4; i < 16; i += 4) { mx = max3f(mx, P0[i], P0[i + 1]); mx2 = max3f(mx2, P0[i + 2], P0[i + 3]); mx = max3f(mx, P1[i], P1[i + 1]); mx2 = max3f(mx2, P1[i + 2], P1[i + 3]); } \
            mx = fmaxf(mx, mx2); \
            { auto rr = __builtin_amdgcn_permlane32_swap(__float_as_uint(mx), __float_as_uint(mx), false, false); mx = fmaxf(__uint_as_float(rr[0]), __uint_as_float(rr[1])); } \
            if ((first) || __any(mx > 8.f)) { const float dl = (first) ? mx : fmaxf(mx, 0.f); const float sc = __builtin_amdgcn_exp2f(-dl); lsum *= sc; \
                _Pragma("unroll") for (int d = 0; d < 4; ++d) _Pragma("unroll") for (int i = 0; i < 16; ++i) O[d][i] *= sc; \
                _Pragma("unroll") for (int i = 0; i < 16; ++i) { P0[i] -= dl; P1[i] -= dl; } \
                if (hasn) { asm volatile("s_nop 15\n\ts_nop 7" : "+v"(N0), "+v"(N1)); _Pragma("unroll") for (int i = 0; i < 16; ++i) { N0[i] -= dl; N1[i] -= dl; } } \
                m += dl; } \
            float ps = 0.f, ps2 = 0.f; \
            _Pragma("unroll") for (int i = 0; i < 16; ++i) { P0[i] = __builtin_amdgcn_exp2f(P0[i]); P1[i] = __builtin_amdgcn_exp2f(P1[i]); ps += P0[i]; ps2 += P1[i]; } \
            lsum += ps + ps2; \
            bf16x8 pb[4]; \
            { u32x4 w; w.x = pk2(P0[0], P0[1]); w.y = pk2(P0[2], P0[3]); w.z = pk2(P0[4], P0[5]); w.w = pk2(P0[6], P0[7]); pb[0] = __builtin_bit_cast(bf16x8, w); \
              w.x = pk2(P0[8], P0[9]); w.y = pk2(P0[10], P0[11]); w.z = pk2(P0[12], P0[13]); w.w = pk2(P0[14], P0[15]); pb[1] = __builtin_bit_cast(bf16x8, w); \
              w.x = pk2(P1[0], P1[1]); w.y = pk2(P1[2], P1[3]); w.z = pk2(P1[4], P1[5]); w.w = pk2(P1[6], P1[7]); pb[2] = __builtin_bit_cast(bf16x8, w); \
              w.x = pk2(P1[8], P1[9]); w.y = pk2(P1[10], P1[11]); w.z = pk2(P1[12], P1[13]); w.w = pk2(P1[14], P1[15]); pb[3] = __builtin_bit_cast(bf16x8, w); } \
            u32x4 va[4]; \
            AT_LDV(va, vs_, 0); AT_SB(); AT_PV(va, 0); AT_SB(); AT_LDV(va, vs_, 1); AT_SB(); AT_PV(va, 1); AT_SB(); AT_LDV(va, vs_, 2); AT_SB(); AT_PV(va, 2); AT_SB(); AT_LDV(va, vs_, 3); AT_SB(); AT_PV(va, 3); AT_SB(); } while (0)
        f32x16 pA0, pA1, pB0, pB1;
        AT_DMA_K(0, 0); AT_DMA_V(0, 0); AT_DMA_K(1, 1);
        AT_BAR();
        AT_QK(pA0, pA1, 0);
        asm volatile("s_waitcnt lgkmcnt(0)\n\ts_barrier" ::: "memory");
        for (int t = 0; t < NT; t += 2) {
            if (t + 2 < NT) AT_DMA_K(t + 2, 0);
            AT_DMA_V(t + 1, 1);
            AT_SB(); AT_QK(pB0, pB1, 1); AT_SB();
            AT_SOFTPV(pA0, pA1, pB0, pB1, t == 0, true, 0);
            AT_BAR();
            if (t + 3 < NT) AT_DMA_K(t + 3, 1);
            if (t + 2 < NT) AT_DMA_V(t + 2, 0);
            AT_SB(); if (t + 2 < NT) { AT_QK(pA0, pA1, 0); } AT_SB();
            AT_SOFTPV(pB0, pB1, pA0, pA1, false, t + 2 < NT, 1);
            AT_BAR();
        }
#undef AT_DMA_K
#undef AT_DMA_V
#undef AT_BAR
#undef AT_SB
#undef AT_QK
#undef AT_LDV
#undef AT_PV
#undef AT_SOFTPV
        const float ltot = lsum + __shfl_xor(lsum, 32);
        const float invl = 1.f / ltot;
        if (map == 1) { const float f = lam * invl;
#pragma unroll
            for (int d = 0; d < 4; ++d)
#pragma unroll
                for (int i = 0; i < 16; ++i) xch[(qw * 64 + d * 16 + i) * 64 + C.lane] = O[d][i] * f; }
        __syncthreads();
        if (map == 0) { float ss = 0.f;
#pragma unroll
            for (int d = 0; d < 4; ++d)
#pragma unroll
                for (int i = 0; i < 16; ++i) { const float o = O[d][i] * invl - xch[(qw * 64 + d * 16 + i) * 64 + C.lane]; O[d][i] = o; ss += o * o; }
            ss += __shfl_xor(ss, 32);
            const float rn = rsqrtf(ss * (1.f / 128.f) + RMS_EPS) * (1.f - lam_init);
            bf16_t* orow = A2 + (size_t)(qrow0 + qw * 32 + r32) * DM + h * 128;
#pragma unroll
            for (int d = 0; d < 4; ++d)
#pragma unroll
                for (int g4 = 0; g4 < 4; ++g4) { const int dd = 32 * d + 8 * g4 + 4 * hi; const f32x4 sg = *(const f32x4*)(subg + dd);
                    const f32x4 v = {O[d][4 * g4] * rn * sg[0], O[d][4 * g4 + 1] * rn * sg[1], O[d][4 * g4 + 2] * rn * sg[2], O[d][4 * g4 + 3] * rn * sg[3]};
                    st4bf(orow + dd, v); } }
        __syncthreads();
    }
}

__device__ __forceinline__ void phase_rt(const Ctx& C, const Args& A, int l) {
    unsigned char* ws = A.ws; float* X = (float*)(ws + WS_X); bf16_t* H = (bf16_t*)(ws + WS_H); float* AFF = (float*)(ws + WS_AFF);
    const float* MOD = (const float*)(ws + WS_MOD) + (size_t)l * 5 * 6144;
    const float* lng = A.in[I_LNG] + (size_t)(l * 2 + 0) * DM; const float* lnb = A.in[I_LNB] + (size_t)(l * 2 + 0) * DM;
    LAS float* wrs = (LAS float*)C.lds;
    { const float* wr = A.in[I_WR] + (size_t)l * DM * 16; for (int i = C.tid; i < DM * 16; i += NTHR) wrs[(i & 15) * 1024 + (i >> 4)] = wr[i]; }
    __syncthreads();
    for (int row = C.gw; row < MROWS; row += C.NGW) {
        const float* md = MOD + row_mi(row) * 6144;
        f32x4 x[4]; float s = 0.f;
#pragma unroll
        for (int j = 0; j < 4; ++j) { x[j] = *(const f32x4*)(X + (size_t)row * DM + 4 * C.lane + 256 * j); s += (x[j][0] + x[j][1]) + (x[j][2] + x[j][3]); }
        const float mean = wave_sum(s) * (1.f / DM); float s2 = 0.f;
#pragma unroll
        for (int j = 0; j < 4; ++j) { x[j] = x[j] - mean; s2 += (x[j][0] * x[j][0] + x[j][1] * x[j][1]) + (x[j][2] * x[j][2] + x[j][3] * x[j][3]); }
        const float rstd = rsqrtf(wave_sum(s2) * (1.f / DM) + LN_EPS);
        float v[16];
#pragma unroll
        for (int e = 0; e < 16; ++e) v[e] = 0.f;
#pragma unroll
        for (int j = 0; j < 4; ++j) { const int col = 4 * C.lane + 256 * j;
            const f32x4 x1 = x[j] * rstd * *(const f32x4*)(lng + col) + *(const f32x4*)(lnb + col);
            *(f32x4*)(X + (size_t)row * DM + col) = x1;
            const f32x4 h = x1 * (*(const f32x4*)(md + 4 * DM + col) + 1.f) + *(const f32x4*)(md + 3 * DM + col);
            st4bf(H + (size_t)row * DM + col, h);
#pragma unroll
            for (int e = 0; e < 16; ++e) { const f32x4 w = *(const LAS f32x4*)(wrs + e * 1024 + col); v[e] += (h[0] * w[0] + h[1] * w[1]) + (h[2] * w[2] + h[3] * w[3]); }
            __builtin_amdgcn_sched_barrier(0); }
#pragma unroll
        for (int i = 0; i < 8; ++i) { const float send = (C.lane & 32) ? v[i] : v[i + 8], keep = (C.lane & 32) ? v[i + 8] : v[i]; v[i] = keep + __shfl_xor(send, 32); }
#pragma unroll
        for (int i = 0; i < 4; ++i) { const float send = (C.lane & 16) ? v[i] : v[i + 4], keep = (C.lane & 16) ? v[i + 4] : v[i]; v[i] = keep + __shfl_xor(send, 16); }
#pragma unroll
        for (int i = 0; i < 2; ++i) { const float send = (C.lane & 8) ? v[i] : v[i + 2], keep = (C.lane & 8) ? v[i + 2] : v[i]; v[i] = keep + __shfl_xor(send, 8); }
        { const float send = (C.lane & 4) ? v[0] : v[1], keep = (C.lane & 4) ? v[1] : v[0]; v[0] = keep + __shfl_xor(send, 4); }
        float z = v[0]; z += __shfl_xor(z, 1); z += __shfl_xor(z, 2);
        float mx = z;
#pragma unroll
        for (int o = 4; o < 64; o <<= 1) mx = fmaxf(mx, __shfl_xor(mx, o));
        const float ex = expf(z - mx); float sm = ex;
#pragma unroll
        for (int o = 4; o < 64; o <<= 1) sm += __shfl_xor(sm, o);
        if ((C.lane & 3) == 0) AFF[(size_t)row * 16 + (C.lane >> 2)] = ex / sm;
    }
}

__device__ __forceinline__ void phase_tk(const Ctx& C, const Args& A) {
    unsigned char* ws = A.ws; const float* AFF = (const float*)(ws + WS_AFF); int* SLOT = (int*)(ws + WS_SLOT); int* IDX = (int*)(ws + WS_IDX); float* GATE = (float*)(ws + WS_GATE);
    LAS unsigned* key = (LAS unsigned*)C.lds;
    LAS unsigned* hist = key + 8192;
    LAS unsigned* scn = hist + 256;
    LAS unsigned* wtot = scn + 256;
    LAS unsigned* bc = wtot + 8;
    for (int u = blockIdx.x; u < 128; u += C.G) {
        const bool isctx = u >= 64; const int uu = u & 63, b = uu >> 4, e = uu & 15;
        const int n = isctx ? CTXL : TT, cap = isctx ? CAP_C : CAP_L;
        const int row0 = isctx ? NLAT + b * CTXL : b * TT;
        const int slot0 = e * ESLOTS + (isctx ? 4 * CAP_L + b * CAP_C : b * CAP_L);
        for (int i = C.tid; i < n; i += NTHR) key[i] = __float_as_uint(AFF[(size_t)(row0 + i) * 16 + e]);
        unsigned prefix = 0u, pmask = 0u; int need = cap;
        for (int pass = 0; pass < 4; ++pass) {
            const int shift = 24 - 8 * pass;
            if (C.tid < 256) hist[C.tid] = 0u;
            __syncthreads();
            for (int i = C.tid; i < n; i += NTHR) { const unsigned k = key[i]; if ((k & pmask) == prefix) __hip_atomic_fetch_add(&hist[(k >> shift) & 255u], 1u, __ATOMIC_RELAXED, __HIP_MEMORY_SCOPE_WORKGROUP); }
            __syncthreads();
            if (C.tid < 256) scn[C.tid] = hist[C.tid];
            __syncthreads();
            for (int off = 1; off < 256; off <<= 1) {
                unsigned a = 0u; if (C.tid < 256 && C.tid + off < 256) a = scn[C.tid + off];
                __syncthreads();
                if (C.tid < 256) scn[C.tid] += a;
                __syncthreads();
            }
            if (C.tid < 256) { const unsigned above = (C.tid < 255) ? scn[C.tid + 1] : 0u;
                if (scn[C.tid] >= (unsigned)need && above < (unsigned)need) { bc[0] = (unsigned)C.tid; bc[1] = (unsigned)need - above; } }
            __syncthreads();
            prefix |= bc[0] << shift; pmask |= 255u << shift; need = (int)bc[1];
            __syncthreads();
        }
        const int per = (n + NTHR - 1) / NTHR; const int i0 = C.tid * per;
        unsigned cg = 0u, ce = 0u;
        for (int j = 0; j < per; ++j) { const int i = i0 + j; if (i < n) { const unsigned k = key[i]; cg += (k > prefix); ce += (k == prefix); } }
        unsigned pk = cg | (ce << 16), inc = pk;
#pragma unroll
        for (int o = 1; o < 64; o <<= 1) { const unsigned t = __shfl_up(inc, o); if (C.lane >= o) inc += t; }
        if (C.lane == 63) wtot[C.wave] = inc;
        __syncthreads();
        unsigned wbase = 0u;
        for (int w = 0; w < C.wave; ++w) wbase += wtot[w];
        const unsigned excl = wbase + inc - pk;
        unsigned rg = excl & 0xffffu, re = excl >> 16;
        const int ngt = cap - need;
        for (int j = 0; j < per; ++j) { const int i = i0 + j; if (i < n) { const unsigned k = key[i]; int pos = -1;
            if (k > prefix) { pos = (int)rg; ++rg; } else if (k == prefix) { if ((int)re < need) pos = ngt + (int)re; ++re; }
            const int row = row0 + i;
            if (pos >= 0) { IDX[slot0 + pos] = row; GATE[slot0 + pos] = __uint_as_float(k); SLOT[(size_t)row * 16 + e] = slot0 + pos; }
            else SLOT[(size_t)row * 16 + e] = -1; } }
        if (isctx && b == 0 && C.tid < ESLOTS - 4224) { IDX[e * ESLOTS + 4224 + C.tid] = 0; GATE[e * ESLOTS + 4224 + C.tid] = 0.f; }
        __syncthreads();
    }
}

__device__ __forceinline__ void phase_cb(const Ctx& C, const Args& A, int l) {
    unsigned char* ws = A.ws; float* X = (float*)(ws + WS_X); bf16_t* H = (bf16_t*)(ws + WS_H); const int* SLOT = (const int*)(ws + WS_SLOT); const bf16_t* YE = (const bf16_t*)(ws + WS_YE);
    const float* MOD = (const float*)(ws + WS_MOD) + (size_t)l * 5 * 6144; const float* MODN = MOD + 5 * 6144;
    const float* lng = A.in[I_LNG] + (size_t)(l * 2 + 1) * DM; const float* lnb = A.in[I_LNB] + (size_t)(l * 2 + 1) * DM;
    for (int row = C.gw; row < MROWS; row += C.NGW) {
        const int mi = row_mi(row); const float* md = MOD + mi * 6144;
        f32x4 acc[4];
#pragma unroll
        for (int j = 0; j < 4; ++j) acc[j] = (f32x4){0.f, 0.f, 0.f, 0.f};
        for (int e = 0; e < 16; ++e) { const int s = __builtin_amdgcn_readfirstlane(SLOT[(size_t)row * 16 + e]);
            if (s >= 0) {
#pragma unroll
                for (int j = 0; j < 4; ++j) acc[j] += ld4bf(YE + (size_t)s * DM + 4 * C.lane + 256 * j); } }
        f32x4 x[4]; float sm = 0.f;
#pragma unroll
        for (int j = 0; j < 4; ++j) { const int col = 4 * C.lane + 256 * j; x[j] = *(const f32x4*)(X + (size_t)row * DM + col) * ALPHA_DN + *(const f32x4*)(md + 5 * DM + col) * acc[j];
            sm += (x[j][0] + x[j][1]) + (x[j][2] + x[j][3]); }
        const float mean = wave_sum(sm) * (1.f / DM); float s2 = 0.f;
#pragma unroll
        for (int j = 0; j < 4; ++j) { x[j] = x[j] - mean; s2 += (x[j][0] * x[j][0] + x[j][1] * x[j][1]) + (x[j][2] * x[j][2] + x[j][3] * x[j][3]); }
        const float rstd = rsqrtf(wave_sum(s2) * (1.f / DM) + LN_EPS);
#pragma unroll
        for (int j = 0; j < 4; ++j) { const int col = 4 * C.lane + 256 * j;
            const f32x4 x2 = x[j] * rstd * *(const f32x4*)(lng + col) + *(const f32x4*)(lnb + col);
            *(f32x4*)(X + (size_t)row * DM + col) = x2;
            if (l < DEPTH - 1) { const float* mn = MODN + mi * 6144; st4bf(H + (size_t)row * DM + col, x2 * (*(const f32x4*)(mn + DM + col) + 1.f) + *(const f32x4*)(mn + col)); }
            else if (row < NLAT) *(f32x4*)(A.out + (size_t)row * DM + col) = x2; }
    }
}


#ifndef GEMM_NOINLINE
#define GEMM_NOINLINE 0
#endif
#if GEMM_NOINLINE
#define GEMM_FN __device__ __noinline__
#else
#define GEMM_FN __device__ __forceinline__
#endif
GEMM_FN void gphase_in(LAS unsigned char* lds, unsigned char* ws, int nN, int G) {
    int bx = blockIdx.x; asm volatile("" : "+s"(bx), "+s"(G));
    pg8::Gemm g{(const bf16_t*)(ws + WS_H), (const bf16_t*)(ws + WS_WIN), DM}; pg8::Order<0> S; S.init(MROWS / 256, nN, G, bx, nullptr, 0);
    pg8::EpiBf16 E{(bf16_t*)(ws + WS_P), P_LD}; pg8::gemm_phase(lds, g, S, E); }
GEMM_FN void gphase_in_odd(LAS unsigned char* lds, unsigned char* ws, int G) {
    int bx = blockIdx.x; asm volatile("" : "+s"(bx), "+s"(G));
    pg8::Gemm g{(const bf16_t*)(ws + WS_H), (const bf16_t*)(ws + WS_WIN), DM}; pg8::Order<0> S; S.init(MROWS / 256, D_IN_ODD / 256, G, bx, nullptr, 0);
    pg8::EpiOdd E{(bf16_t*)(ws + WS_P), (bf16_t*)(ws + WS_Q), (bf16_t*)(ws + WS_KA), (const float*)(ws + WS_ROPE)}; pg8::gemm_phase(lds, g, S, E); }
GEMM_FN void gphase_lora(LAS unsigned char* lds, unsigned char* ws, const float* d0, const float* a0, const float* kal, int G) {
    int bx = blockIdx.x; asm volatile("" : "+s"(bx), "+s"(G));
    pg8::Gemm g{(const bf16_t*)(ws + WS_LIN), (const bf16_t*)(ws + WS_WLORA), LORA_K}; pg8::Order<0> S; S.init(MROWS / 256, LORA_N / 256, G, bx, nullptr, 0);
    pg8::EpiLora E{ws + WS_SCN, (bf16_t*)(ws + WS_G), d0, a0, kal}; pg8::gemm_phase(lds, g, S, E); }
GEMM_FN void gphase_out(LAS unsigned char* lds, unsigned char* ws, const float* modl, int G) {
    int bx = blockIdx.x; asm volatile("" : "+s"(bx), "+s"(G));
    pg8::Gemm g{(const bf16_t*)(ws + WS_A2), (const bf16_t*)(ws + WS_WOUT), DM}; pg8::Order<0> S; S.init(MROWS / 256, DM / 256, G, bx, nullptr, 0);
    pg8::EpiRes E{(float*)(ws + WS_X), modl}; pg8::gemm_phase(lds, g, S, E); }
GEMM_FN void gphase_e1(LAS unsigned char* lds, unsigned char* ws, int G, int l) {
    int bx = blockIdx.x; asm volatile("" : "+s"(bx), "+s"(G));
    pg8::Gemm g{(const bf16_t*)(ws + WS_H), (const bf16_t*)(ws + WS_WE13 + (size_t)(l & 1) * WE13_BYTES), DM}; pg8::EpiSwiGLU E{(bf16_t*)(ws + WS_HID)};
    pg8::OrderExp<1> S; S.init(4096 / 256, G, bx, (const int*)(ws + WS_IDX), (long)4096 * DM); pg8::gemm_phase(lds, g, S, E); }
GEMM_FN void gphase_e2(LAS unsigned char* lds, unsigned char* ws, int G, int l) {
    int bx = blockIdx.x; asm volatile("" : "+s"(bx), "+s"(G));
    pg8::Gemm g{(const bf16_t*)(ws + WS_HID), (const bf16_t*)(ws + WS_WE2 + (size_t)(l & 1) * WE2_BYTES), D_EXP}; pg8::EpiYE E{(bf16_t*)(ws + WS_YE), (const float*)(ws + WS_GATE)};
    pg8::OrderExp<2> S; S.init(DM / 256, G, bx, nullptr, (long)DM * D_EXP); pg8::gemm_phase(lds, g, S, E); }

constexpr int NSLOT = 13;
constexpr int NSTEP = 1 + DEPTH * NSLOT;
__global__ void __launch_bounds__(NTHR, 2) mk_fwd(Args KA) {
    extern __shared__ __attribute__((aligned(16))) unsigned char lds_raw[];
    volatile LAS unsigned* MISC = (volatile LAS unsigned*)((LAS unsigned char*)lds_raw + LDS_MISC);
    if (threadIdx.x < 16) MISC[threadIdx.x] = 0u;
    if (threadIdx.x == 0) { LAS unsigned long long* tb = (LAS unsigned long long*)((LAS unsigned char*)lds_raw + LDS_PTAB);
#pragma unroll
        for (int i = 0; i < 37; ++i) tb[i] = (unsigned long long)KA.in[i];
        tb[37] = (unsigned long long)KA.out; tb[38] = (unsigned long long)KA.ws; }
    __syncthreads();
    const int lo = KA.lo, hi = KA.hi;
    unsigned bar_x = 0;
    if (hi - lo > 1) { const XcdBarrier b0 = xcd_barrier_post((unsigned*)(KA.ws + WS_CTL), MISC); bar_x = b0.x; }
#ifndef PH_MASK
#define PH_MASK 0xFFFFFF
#endif
#ifndef REP_MASK
#define REP_MASK 0
#endif
#define PH_BIT(k) (((k) == 0) ? 0 : 1 + ((k) - 1) % NSLOT + (((k) - 1) % NSLOT >= 2 && ((k) - 1) % NSLOT <= 3 && odd ? 12 : 0))
#define RUN(k, ...) do { if (((PH_MASK >> PH_BIT(k)) & 1) && lo <= (k) && (k) < hi) { const int nrep = ((REP_MASK >> PH_BIT(k)) & 1) ? 2 : 1; \
        _Pragma("unroll 1") for (int rep = 0; rep < nrep; ++rep) { \
        Ctx C; mkctx(C, (LAS unsigned char*)lds_raw); Args A; ldargs(A, (LAS unsigned char*)lds_raw); unsigned char* ws = A.ws; \
        const float* MODL = (const float*)(ws + WS_MOD) + (size_t)l * 5 * 6144; (void)MODL; \
        __VA_ARGS__; if ((k) + 1 < hi || rep + 1 < nrep) { XcdBarrier bar; bar.bar = (unsigned*)(ws + WS_CTL); bar.x = bar_x; bar.st = MISC; xcd_barrier(bar); } } } } while (0)
    { const bool odd = false; const int l = 0; RUN(0, { phase_init(C, A); __syncthreads(); conv_items(C, A, 0, C.gw, C.NGW, true, true, true); }); }
#pragma unroll 1
    for (int l = 0; l < DEPTH; ++l) {
        const int sb = 1 + l * NSLOT; const bool odd = l & 1;
        if (!(CHUNKED_SCAN && odd)) { RUN(sb + 0, { phase_conv(C, A, l); if (l == 0) phase_modh(C, A, 0); }); }
        if (odd) { RUN(sb + 1, gphase_in_odd(C.lds, ws, C.G)); } else { RUN(sb + 1, gphase_in(C.lds, ws, D_IN_EVEN_PAD / 256, C.G)); }
        if (!odd) {
            RUN(sb + 2, phase_ef1(C, A, l));
            RUN(sb + 3, { const int i2 = l >> 1; gphase_lora(C.lds, ws, A.in[I_D0] + (size_t)i2 * 2 * 768, A.in[I_A0] + (size_t)i2 * 2 * 768, A.in[I_KAL] + (size_t)i2 * 768, C.G); });
#if CHUNKED_SCAN
            RUN(sb + 4, phase_csa(C, A));
            RUN(sb + 5, phase_csb(C, A, l));
#else
            RUN(sb + 4, phase_scan(C, A));
#endif
            RUN(sb + 6, phase_ef2(C, A, l));
        } else {
            RUN(sb + 2, phase_of1(C, A, l));
            RUN(sb + 3, phase_attn(C, A, l));
        }
        RUN(sb + 7, gphase_out(C.lds, ws, MODL, C.G));
        RUN(sb + 8, phase_rt(C, A, l));
        RUN(sb + 9, phase_tk(C, A));
        RUN(sb + 10, gphase_e1(C.lds, ws, C.G, l));
        RUN(sb + 11, gphase_e2(C.lds, ws, C.G, l));
        RUN(sb + 12, { phase_cb(C, A, l); if (CHUNKED_SCAN && !odd && l + 1 < DEPTH) { __syncthreads(); conv_items(C, A, l + 1, C.gw, C.NGW, false, true, false); } });
    }
#undef RUN
}

#ifdef PHASE_PROBE
#define PROBE_PRE extern __shared__ __attribute__((aligned(16))) unsigned char lds_raw[]; Ctx C; mkctx(C, (LAS unsigned char*)lds_raw); unsigned char* ws = A.ws; (void)ws;
__global__ void __launch_bounds__(NTHR, 2) pr_init(Args A) { PROBE_PRE phase_init(C, A); }
__global__ void __launch_bounds__(NTHR, 2) pr_conv(Args A) { PROBE_PRE phase_conv(C, A, A.lo); }
__global__ void __launch_bounds__(NTHR, 2) pr_modh(Args A) { PROBE_PRE phase_modh(C, A, A.lo); }
__global__ void __launch_bounds__(NTHR, 2) pr_ef1(Args A) { PROBE_PRE phase_ef1(C, A, A.lo); }
__global__ void __launch_bounds__(NTHR, 2) pr_scan(Args A) { PROBE_PRE phase_scan(C, A); }
__global__ void __launch_bounds__(NTHR, 2) pr_ef2(Args A) { PROBE_PRE phase_ef2(C, A, A.lo); }
__global__ void __launch_bounds__(NTHR, 2) pr_csa(Args A) { PROBE_PRE phase_csa(C, A); }
__global__ void __launch_bounds__(NTHR, 2) pr_csb(Args A) { PROBE_PRE phase_csb(C, A, A.lo); }
__global__ void __launch_bounds__(NTHR, 2) pr_of1(Args A) { PROBE_PRE phase_of1(C, A, A.lo); }
__global__ void __launch_bounds__(NTHR, 2) pr_attn(Args A) { PROBE_PRE phase_attn(C, A, A.lo); }
__global__ void __launch_bounds__(NTHR, 2) pr_rt(Args A) { PROBE_PRE phase_rt(C, A, A.lo); }
__global__ void __launch_bounds__(NTHR, 2) pr_tk(Args A) { PROBE_PRE phase_tk(C, A); }
__global__ void __launch_bounds__(NTHR, 2) pr_cb(Args A) { PROBE_PRE phase_cb(C, A, A.lo); }
__global__ void __launch_bounds__(NTHR, 2) pr_gemm_in(Args A) { PROBE_PRE pg8::Gemm g{(const bf16_t*)(ws + WS_H), (const bf16_t*)(ws + WS_WIN), DM}; pg8::Order<0> S; S.init(MROWS / 256, A.lo, C.G, (int)blockIdx.x, nullptr, 0);
                      pg8::EpiBf16 E{(bf16_t*)(ws + WS_P), P_LD}; pg8::gemm_phase(C.lds, g, S, E); }
__global__ void __launch_bounds__(NTHR, 2) pr_gemm_lora(Args A) { PROBE_PRE pg8::Gemm g{(const bf16_t*)(ws + WS_LIN), (const bf16_t*)(ws + WS_WLORA), LORA_K}; pg8::Order<0> S; S.init(MROWS / 256, LORA_N / 256, C.G, (int)blockIdx.x, nullptr, 0);
                          const int i2 = A.lo; pg8::EpiLora E{ws + WS_SCN, (bf16_t*)(ws + WS_G), A.in[I_D0] + (size_t)i2 * 2 * 768, A.in[I_A0] + (size_t)i2 * 2 * 768, A.in[I_KAL] + (size_t)i2 * 768};
                          pg8::gemm_phase(C.lds, g, S, E); }
__global__ void __launch_bounds__(NTHR, 2) pr_gemm_out(Args A) { PROBE_PRE pg8::Gemm g{(const bf16_t*)(ws + WS_A2), (const bf16_t*)(ws + WS_WOUT), DM}; pg8::Order<0> S; S.init(MROWS / 256, DM / 256, C.G, (int)blockIdx.x, nullptr, 0);
                      pg8::EpiRes E{(float*)(ws + WS_X), (const float*)(ws + WS_MOD)}; pg8::gemm_phase(C.lds, g, S, E); }
__global__ void __launch_bounds__(NTHR, 2) pr_gemm_e1(Args A) { PROBE_PRE pg8::Gemm g{(const bf16_t*)(ws + WS_H), (const bf16_t*)(ws + WS_WE13), DM}; pg8::Order<1> S; S.init(NEXP * 17, 4096 / 256, C.G, (int)blockIdx.x, (const int*)(ws + WS_IDX), (long)4096 * DM);
                      pg8::EpiSwiGLU E{(bf16_t*)(ws + WS_HID)}; pg8::gemm_phase(C.lds, g, S, E); }
__global__ void __launch_bounds__(NTHR, 2) pr_gemm_e2(Args A) { PROBE_PRE pg8::Gemm g{(const bf16_t*)(ws + WS_HID), (const bf16_t*)(ws + WS_WE2), D_EXP}; pg8::Order<2> S; S.init(NEXP * 17, DM / 256, C.G, (int)blockIdx.x, nullptr, (long)DM * D_EXP);
                       pg8::EpiYE E{(bf16_t*)(ws + WS_YE), (const float*)(ws + WS_GATE)}; pg8::gemm_phase(C.lds, g, S, E); }
#endif

extern "C" void kernel_launch(void* const* d_in, const int* in_sizes, int n_in, void* d_out, int out_size, void* d_ws, size_t ws_size, hipStream_t stream) {
    static int grid = 0;
    if (grid == 0) {
        if (n_in != 37 || out_size != NLAT * DM || ws_size < WS_END) { fprintf(stderr, "kernel_launch: unexpected shapes: n_in %d out %d ws %zu (need %zu)\n", n_in, out_size, ws_size, (size_t)WS_END); grid = -1; return; }
        int dev = 0, cus = 0, per_cu = 0;
        if (hipGetDevice(&dev) != hipSuccess || hipDeviceGetAttribute(&cus, hipDeviceAttributeMultiprocessorCount, dev) != hipSuccess) { grid = -1; return; }
        if (hipFuncSetAttribute((const void*)mk_fwd, hipFuncAttributeMaxDynamicSharedMemorySize, LDS_BYTES) != hipSuccess) { fprintf(stderr, "kernel_launch: hipFuncSetAttribute failed\n"); grid = -1; return; }
        if (hipOccupancyMaxActiveBlocksPerMultiprocessor(&per_cu, (const void*)mk_fwd, NTHR, LDS_BYTES) != hipSuccess || per_cu < 1) fprintf(stderr, "kernel_launch: occupancy query reports %d\n", per_cu);
        (void)hipGetLastError();
        grid = cus;
    }
    if (grid < 0) return;
    (void)hipMemsetAsync((char*)d_ws + WS_CTL, 0, CTL_BYTES, stream);
    Args a{};
    for (int i = 0; i < 37; ++i) a.in[i] = (const float*)d_in[i];
    a.out = (float*)d_out; a.ws = (unsigned char*)d_ws;
#if MK_MULTI
    for (int k = 0; k < NSTEP; ++k) {
        if (k >= 1) { const int l = (k - 1) / NSLOT, s = (k - 1) % NSLOT; if ((l & 1) && ((s >= 4 && s <= 6) || (CHUNKED_SCAN && s == 0))) continue; if (!(l & 1) && !CHUNKED_SCAN && s == 5) continue; }
        a.lo = k; a.hi = k + 1;
        hipLaunchKernelGGL(mk_fwd, dim3(grid), dim3(NTHR), LDS_BYTES, stream, a);
    }
#else
    a.lo = 0; a.hi = NSTEP;
    hipLaunchKernelGGL(mk_fwd, dim3(grid), dim3(NTHR), LDS_BYTES, stream, a);
#endif
    const hipError_t le = hipPeekAtLastError();
    if (le != hipSuccess) fprintf(stderr, "kernel_launch: launch failed: %s\n", hipGetErrorName(le));
}
```

```cpp
#include <hip/hip_runtime.h>
#include <cstdio>
#include <cstdint>
#include <cmath>

#ifndef MK_MULTI
#define MK_MULTI 0
#endif
#ifndef CHUNKED_SCAN
#define CHUNKED_SCAN 1
#endif

#define GAS __attribute__((address_space(1)))
#define LAS __attribute__((address_space(3)))
typedef unsigned short bf16_t;
typedef short bf16x8 __attribute__((ext_vector_type(8)));
typedef float f32x4 __attribute__((ext_vector_type(4)));
typedef float f32x2 __attribute__((ext_vector_type(2)));
typedef float f32x16 __attribute__((ext_vector_type(16)));
typedef unsigned u32x4 __attribute__((ext_vector_type(4)));
typedef unsigned u32x2 __attribute__((ext_vector_type(2)));
typedef __bf16 bf16x2_t __attribute__((ext_vector_type(2)));

constexpr int NB = 4, TT = 8192, DM = 1024, NLAT = NB * TT, CTXL = 256, NCTX = NB * CTXL, MROWS = NLAT + NCTX;
constexpr int DEPTH = 4;
constexpr int D_CONV = 256, RW_H = 12, RW_K = 64, D_RWKV = 768, RWKV_COLS = 2688, D_IN_EVEN = 3456, D_IN_EVEN_PAD = 3584;
constexpr int D_DIFF = 768, D_GMLP = 256, D_IN_ODD = 2816;
constexpr int NEXP = 16, D_EXP = 2048, CAP_L = 1024, CAP_C = 32, ESLOTS = 4352;
constexpr int P_LD = 3584;
constexpr int LORA_K = 384, LORA_N = 3840;
constexpr int LKEYS = CTXL + TT;
constexpr float ALPHA_DN = 1.6817928305074290f;
constexpr float DECAY_SCALE = 0.6065306597126334f;
constexpr float GN_EPS = 64e-5f, LN_EPS = 1e-5f, RMS_EPS = 1e-5f;
constexpr float QSCALE = 0.125f * 1.4426950408889634f;

constexpr size_t al256(size_t x) { return (x + 255) & ~(size_t)255; }
constexpr size_t WS_CTL = 0;
constexpr size_t CTL_BYTES = 65536;
constexpr size_t WS_MOD = WS_CTL + CTL_BYTES;
constexpr size_t WS_ROPE = WS_MOD + al256((size_t)DEPTH * 5 * 6144 * 4);
constexpr size_t WS_WIN = WS_ROPE + 32768;
constexpr size_t WS_WOUT = WS_WIN + (size_t)D_IN_EVEN_PAD * DM * 2;
constexpr size_t WS_WLORA = WS_WOUT + (size_t)DM * DM * 2;
constexpr size_t WS_WE13 = WS_WLORA + (size_t)LORA_N * LORA_K * 2;
constexpr size_t WE13_BYTES = (size_t)NEXP * 4096 * DM * 2, WE2_BYTES = (size_t)NEXP * DM * D_EXP * 2;
constexpr size_t WS_WE2 = WS_WE13 + 2 * WE13_BYTES;
constexpr size_t WS_X = WS_WE2 + 2 * WE2_BYTES;
constexpr size_t WS_H = WS_X + (size_t)MROWS * DM * 4;
constexpr size_t WS_A2 = WS_H + (size_t)MROWS * DM * 2;
constexpr size_t WS_P = WS_A2 + (size_t)MROWS * DM * 2;
constexpr size_t WS_AFF = WS_P + (size_t)MROWS * P_LD * 2;
constexpr size_t WS_SLOT = WS_AFF + (size_t)MROWS * 16 * 4;
constexpr size_t WS_IDX = WS_SLOT + (size_t)MROWS * 16 * 4;
constexpr size_t WS_GATE = WS_IDX + al256((size_t)NEXP * ESLOTS * 4);
constexpr size_t WS_R2 = WS_GATE + al256((size_t)NEXP * ESLOTS * 4);
constexpr int SC_REC = 1408, SC_ROW = 12 * SC_REC, SC_W = 0, SC_R = 512, SC_KK = 640, SC_V = 768, SC_B = 896, SC_KR = 1024;
constexpr size_t WS_SCN = WS_R2;
constexpr size_t WS_G = WS_SCN + (size_t)MROWS * SC_ROW;
constexpr size_t WS_LIN = WS_G + (size_t)MROWS * 768 * 2;
constexpr int CS_L = 64, CS_NCH = LKEYS / CS_L, CS_UNITS = NB * RW_H * 2;
constexpr size_t WS_CHK = WS_LIN + (size_t)MROWS * 384 * 2;
constexpr size_t WS_EVEN_END = WS_CHK + (size_t)CS_UNITS * CS_NCH * 32768;
constexpr size_t WS_Y = WS_P;
constexpr size_t WS_Q = WS_R2;
constexpr size_t WS_KA = WS_Q + (size_t)MROWS * 768 * 2;
constexpr size_t WS_VT = WS_KA + (size_t)NB * LKEYS * 768 * 2;
constexpr size_t WS_HID = WS_R2;
constexpr size_t WS_YE = WS_HID + (size_t)NEXP * ESLOTS * D_EXP * 2;
constexpr size_t WS_END = WS_EVEN_END;
static_assert(WS_END <= (size_t)2147483648ull, "workspace over 2 GiB");
static_assert((size_t)2 * MROWS * 768 * 4 <= (size_t)MROWS * P_LD * 2, "Y aliases P");
static_assert(WS_YE + (size_t)NEXP * ESLOTS * DM * 2 <= WS_END, "moe region");

constexpr int LDS_BYTES = 147456;
constexpr int LDS_MISC = 140 * 1024;
constexpr int LDS_PTAB = LDS_MISC + 256;
constexpr int NWAVES = 8, NTHR = 512;

__device__ __forceinline__ unsigned f2bf(float f) { unsigned u = __float_as_uint(f); return (u + 0x7fffu + ((u >> 16) & 1u)) >> 16; }
__device__ __forceinline__ unsigned pk2(float lo, float hi) { f32x2 v = {lo, hi}; bf16x2_t b = __builtin_convertvector(v, bf16x2_t); return __builtin_bit_cast(unsigned, b); }
__device__ __forceinline__ float bflo(unsigned u) { return __uint_as_float(u << 16); }
__device__ __forceinline__ float bfhi(unsigned u) { return __uint_as_float(u & 0xffff0000u); }
__device__ __forceinline__ float bf2f(bf16_t b) { return __uint_as_float((unsigned)b << 16); }
__device__ __forceinline__ float sigmoidf_(float x) { return 1.f / (1.f + __expf(-x)); }
__device__ __forceinline__ float wave_sum(float v) {
#pragma unroll
    for (int o = 1; o < 64; o <<= 1) v += __shfl_xor(v, o);
    return v;
}
__device__ __forceinline__ float sum16(float v) {
#pragma unroll
    for (int o = 1; o < 16; o <<= 1) v += __shfl_xor(v, o);
    return v;
}
__device__ __forceinline__ f32x4 ld4bf_(const void* p) { const u32x2 u = *(const u32x2*)p; return (f32x4){bflo(u.x), bfhi(u.x), bflo(u.y), bfhi(u.y)}; }
__device__ __forceinline__ void st4bf_(void* p, f32x4 v) { u32x2 o; o.x = pk2(v[0], v[1]); o.y = pk2(v[2], v[3]); *(u32x2*)p = o; }
__device__ __forceinline__ float max3f(float a, float b, float c) { float r; asm("v_max3_f32 %0, %1, %2, %3" : "=v"(r) : "v"(a), "v"(b), "v"(c)); return r; }
__device__ __forceinline__ int crow(int r, int hi) { return (r & 3) + 8 * (r >> 2) + 4 * hi; }
__device__ __forceinline__ float gelu_erf(float x) { return 0.5f * x * (1.f + erff(x * 0.70710678118654752f)); }

#define XB_TMO      128
#define XB_XCNT(j)  (256  + 64 * (j))
#define XB_XSUB(j)  (1280 + 64 * (j))
#define XB_XGEN(j)  (2304 + 64 * (j))
#define XB_TOP      3328
#define XB_TOPGEN   3392
#define XCD_BAR_WORDS 3456
#define XB_SPIN_CAP (1u << 20)

__device__ __forceinline__ unsigned xb_ld(unsigned* p)              { return __hip_atomic_load(p, __ATOMIC_RELAXED, __HIP_MEMORY_SCOPE_AGENT); }
__device__ __forceinline__ unsigned xb_add(unsigned* p, unsigned v) { return __hip_atomic_fetch_add(p, v, __ATOMIC_RELAXED, __HIP_MEMORY_SCOPE_AGENT); }
__device__ __forceinline__ unsigned xb_xcc_id() { return (unsigned)__builtin_amdgcn_s_getreg((3 << 11) | 20) & 0xFu; }
#define XB_SPIN(cond, bar) do { unsigned _sp = 0; while (cond) { __builtin_amdgcn_s_sleep(1); \
    if ((++_sp & 255u) == 0u) { if (xb_ld(&(bar)[XB_TMO])) break; if (_sp > XB_SPIN_CAP) { atomicAdd(&(bar)[XB_TMO], 1u); break; } } } } while (0)

struct XcdBarrier { unsigned* bar; unsigned x; volatile LAS unsigned* st; };

__device__ __forceinline__ XcdBarrier xcd_barrier_post(unsigned* bar, volatile LAS unsigned* st) {
    XcdBarrier b; b.bar = bar; b.x = xb_xcc_id(); b.st = st;
    if (threadIdx.x == 0) (void)xb_add(&bar[XB_XCNT(b.x)], 1u);
    return b;
}
__device__ __forceinline__ void xcd_barrier_complete(unsigned* bar, unsigned x, unsigned& nloc, unsigned& nx) {
    const unsigned G = gridDim.x * gridDim.y * gridDim.z;
    unsigned sum, cnt, mine, sp = 0u;
    for (;;) {
        sum = 0u; cnt = 0u; mine = 0u;
#pragma unroll
        for (unsigned j = 0; j < 16; ++j) { const unsigned c = xb_ld(&bar[XB_XCNT(j)]); sum += c; cnt += (c > 0u) ? 1u : 0u; mine = (j == x) ? c : mine; }
        if (sum == G) break;
        __builtin_amdgcn_s_sleep(1);
        if ((++sp & 255u) == 0u) { if (xb_ld(&bar[XB_TMO])) break; if (sp > XB_SPIN_CAP) { atomicAdd(&bar[XB_TMO], 1u); break; } }
    }
    nloc = mine > 0u ? mine : 1u; nx = cnt > 0u ? cnt : 1u;
}
__device__ __forceinline__ void xcd_barrier(const XcdBarrier& b) {
    asm volatile("s_waitcnt vmcnt(0)" ::: "memory");
    __syncthreads();
    if (threadIdx.x == 0) {
        unsigned* bar = b.bar;
        __builtin_amdgcn_s_waitcnt(0);
        unsigned nloc = b.st[0], nx = b.st[1];
        if (nloc == 0u) { xcd_barrier_complete(bar, b.x, nloc, nx); b.st[0] = nloc; b.st[1] = nx; }
        const unsigned old = xb_add(&bar[XB_XSUB(b.x)], 1u);
        const unsigned gen = old / nloc;
        if (old + 1u == (gen + 1u) * nloc) {
            __builtin_amdgcn_fence(__ATOMIC_RELEASE, "agent");
            asm volatile("s_waitcnt vmcnt(0)" ::: "memory");
            const unsigned og = xb_add(&bar[XB_TOP], 1u);
            const unsigned tg = og / nx;
            if (og + 1u == (tg + 1u) * nx) xb_add(&bar[XB_TOPGEN], 1u);
            else XB_SPIN(xb_ld(&bar[XB_TOPGEN]) == tg, bar);
            __builtin_amdgcn_fence(__ATOMIC_ACQUIRE, "agent");
            xb_add(&bar[XB_XGEN(b.x)], 1u);
            asm volatile("s_waitcnt vmcnt(0)" ::: "memory");
        } else {
            XB_SPIN(xb_ld(&bar[XB_XGEN(b.x)]) == gen, bar);
            __builtin_amdgcn_fence(__ATOMIC_ACQUIRE, "agent");
            asm volatile("s_waitcnt vmcnt(0)" ::: "memory");
        }
    }
    __syncthreads();
}

namespace pg8 {
constexpr int BM = 256, BK = 64, HALF = 128, HTB = HALF * BK * 2, STAGE_BYTES = 8 * HTB, NXCD = 8, WGM = 8;
__host__ __device__ __forceinline__ int lds_byte(int r, int c) { const int st = (r >> 4) * 2 + (c >> 5), rr = r & 15, cc = c & 31, ob = rr * 64 + cc * 2; return st * 1024 + (ob ^ (((ob >> 9) & 1) << 5)); }
__host__ __device__ __forceinline__ void stage_rc(int b, int& R, int& C) { const int st = b / 1024, sb = b % 1024, swz = sb ^ (((sb >> 9) & 1) << 5); R = (st >> 1) * 16 + swz / 64; C = (st & 1) * 32 + (swz % 64) / 2; }

struct Unit { int pm, pn, hf; };
struct Gemm { const bf16_t* A; const bf16_t* Bt; int K; };

template <int MODE> struct Order {
    static constexpr bool GATHER = (MODE == 1);
    int nM, nN, nwg, G, c; const int* idx; long bstride;
    __device__ __forceinline__ void init(int nM_, int nN_, int G_, int c_, const int* idx_, long bstride_) { nM = nM_; nN = nN_; nwg = nM * nN; G = G_; c = c_; idx = idx_; bstride = bstride_; }
    __device__ __forceinline__ bool next(int i, Unit& u) const {
        const long L = (long)i * G + c; if (L >= nwg) return false;
        int wgid = (int)L; { const int q = nwg / NXCD, r = nwg % NXCD, xcd = wgid % NXCD, off = wgid / NXCD; wgid = (xcd < r ? xcd * (q + 1) : r * (q + 1) + (xcd - r) * q) + off; }
        const int nig = WGM * nN, gid = wgid / nig, fm = gid * WGM, gsz = (nM - fm) < WGM ? (nM - fm) : WGM;
        u.pm = fm + ((wgid % nig) % gsz); u.pn = (wgid % nig) / gsz; u.hf = (MODE != 0 && (u.pm % 17) == 16) ? 1 : 0; return true;
    }
    __device__ __forceinline__ unsigned arow(const Unit& u, int r) const { if (MODE == 1) return (unsigned)idx[u.pm * BM + r]; return (unsigned)(u.pm * BM + r); }
    __device__ __forceinline__ long bbase(const Unit& u, int K) const { long o = (long)u.pn * BM * K; if (MODE != 0) o += (long)(u.pm / 17) * bstride; return o; }
};

template <int MODE> struct OrderExp {
    static constexpr bool GATHER = (MODE == 1);
    int nN, G, c0; const int* idx; long bstride;
    __device__ __forceinline__ void init(int nN_, int G_, int c_, const int* idx_, long bstride_) { nN = nN_; G = G_; c0 = c_; idx = idx_; bstride = bstride_; }
    __device__ __forceinline__ bool next(int i0, Unit& u) const {
        const int v = i0 * G + c0, i = v >> 8, c = v & 255;
        const int x = c & 7, slot = c >> 3, per = 32 / nN, nfull = 256 / (8 * per);
        if (i > nfull) return false;
        if (i < nfull) { u.pn = slot / per; const int f = (i * 8 + x) * per + (slot % per); u.pm = (f >> 4) * 17 + (f & 15); u.hf = 0; return true; }
        if (i == nfull && slot < 2 * nN) { u.pn = slot >> 1; u.pm = (x * 2 + (slot & 1)) * 17 + 16; u.hf = 1; return true; }
        return false;
    }
    __device__ __forceinline__ unsigned arow(const Unit& u, int r) const { if (MODE == 1) return (unsigned)idx[u.pm * BM + r]; return (unsigned)(u.pm * BM + r); }
    __device__ __forceinline__ long bbase(const Unit& u, int K) const { return (long)u.pn * BM * K + (long)(u.pm / 17) * bstride; }
};

template <class Epi, class Sched>
__device__ __forceinline__ void gemm_phase(LAS unsigned char* lds, const Gemm g, const Sched& S, const Epi& E) {
    int tid = threadIdx.x; asm volatile("" : "+v"(tid));
    const int wid = __builtin_amdgcn_readfirstlane(tid >> 6), wr = wid >> 2, wc = wid & 3;
    const int K = g.K, nt = K / BK;
    unsigned voffB[2];
    { const int lane = tid & 63, fr = lane & 15, fq = lane >> 4; (void)fr; (void)fq; }
#pragma unroll
    for (int i = 0; i < 2; ++i) { int R, Cc; stage_rc(tid * 16 + i * 8192, R, Cc); voffB[i] = (unsigned)(R * K + Cc) * 2u; }
    const size_t kstep = (size_t)(BK * 2);
    const size_t hstep = (size_t)HALF * K * 2;
    const unsigned ldsw = (unsigned)wid * 1024u;
    const int aoff = lds_byte(wr * 64 + (tid & 15), ((tid & 63) >> 4) * 8), boff = lds_byte(wc * 32 + (tid & 15), ((tid & 63) >> 4) * 8);
#define PG8_SA(b, h) (((b) * 2 + (h)) * HTB)
#define PG8_SB(b, h) ((4 + (b) * 2 + (h)) * HTB)
#define PG8_STAGE(bufoff, gbase, voff) do { _Pragma("unroll") for (int _i = 0; _i < 2; ++_i) \
        __builtin_amdgcn_global_load_lds((const unsigned*)((const char*)(gbase) + (voff)[_i]), (LAS unsigned*)(lds + (bufoff) + ldsw + _i * 8192), 16, 0, 0); } while (0)
#define PG8_LDA(dst, b, h) do { _Pragma("unroll") for (int m = 0; m < 4; ++m) _Pragma("unroll") for (int k = 0; k < 2; ++k) dst[m][k] = *(const LAS bf16x8*)(lds + PG8_SA(b, h) + aoff + m * 2048 + k * 1024); } while (0)
#define PG8_LDB(dst, b, h) do { _Pragma("unroll") for (int n = 0; n < 2; ++n) _Pragma("unroll") for (int k = 0; k < 2; ++k) dst[n][k] = *(const LAS bf16x8*)(lds + PG8_SB(b, h) + boff + n * 2048 + k * 1024); } while (0)
#define PG8_MMA(ai, bj, At, Bt) do { __builtin_amdgcn_s_setprio(1); _Pragma("unroll") for (int m = 0; m < 4; ++m) _Pragma("unroll") for (int n = 0; n < 2; ++n) _Pragma("unroll") for (int k = 0; k < 2; ++k) \
        acc[ai][bj][m][n] = __builtin_amdgcn_mfma_f32_16x16x32_bf16(Bt[n][k], At[m][k], acc[ai][bj][m][n], 0, 0, 0); __builtin_amdgcn_s_setprio(0); } while (0)
#define PG8_WAIT_V(n) asm volatile("s_waitcnt vmcnt(" #n ")" ::: "memory")
#define PG8_WAIT_L(n) asm volatile("s_waitcnt lgkmcnt(" #n ")" ::: "memory")
#define PG8_BAR __builtin_amdgcn_s_barrier()
#define PG8_SCHED __builtin_amdgcn_sched_barrier(0)
#define PG8_ROWOFFS(dst, u, tq) do { _Pragma("unroll") for (int _i = 0; _i < 2; ++_i) { int _R, _C; stage_rc((tq) * 16 + _i * 8192, _R, _C); _Pragma("unroll") for (int _h = 0; _h < 2; ++_h) dst[_h][_i] = (S.arow(u, _h * HALF + _R) * (unsigned)K + (unsigned)_C) * 2u; } } while (0)
    Unit cur, nxt; int ui = 0;
    if (!S.next(0, cur)) return;
    float zf = 0.f; asm volatile("" : "+v"(zf));
    f32x4 acc[2][2][4][2];
#pragma unroll
    for (int a = 0; a < 2; ++a)
#pragma unroll
        for (int b = 0; b < 2; ++b)
#pragma unroll
            for (int m = 0; m < 4; ++m)
#pragma unroll
                for (int n = 0; n < 2; ++n) acc[a][b][m][n] = (f32x4){zf, zf, zf, zf};
    bf16x8 At[4][2], B0[2][2], B1[2][2];
    unsigned vcur[2][2];
    if constexpr (Sched::GATHER) { PG8_ROWOFFS(vcur, cur, tid); }
    const char* const Ab = (const char*)g.A;
    const char* cA = Sched::GATHER ? Ab : Ab + (size_t)(unsigned)__builtin_amdgcn_readfirstlane((int)S.arow(cur, 0)) * K * 2;
#define PG8_STAGEA(bufoff, ptr, h) do { if constexpr (Sched::GATHER) { PG8_STAGE(bufoff, ptr, vcur[h]); } else { PG8_STAGE(bufoff, (ptr) + (h) * hstep, voffB); } } while (0)
    const char* cB = (const char*)g.Bt + (size_t)S.bbase(cur, K) * 2;
    PG8_STAGE(PG8_SB(0, 0), cB, voffB); PG8_STAGE(PG8_SB(0, 1), cB + hstep, voffB); PG8_STAGEA(PG8_SA(0, 0), cA, 0); PG8_STAGEA(PG8_SA(0, 1), cA, 1);
    if (wr == 1) PG8_BAR;
    PG8_WAIT_V(2); PG8_BAR;
    PG8_STAGE(PG8_SB(1, 0), cB + kstep, voffB); PG8_STAGEA(PG8_SA(1, 0), cA + kstep, 0); PG8_STAGE(PG8_SB(1, 1), cB + hstep + kstep, voffB);
    PG8_WAIT_V(6); PG8_BAR;
    for (;;) {
        const bool has_next = S.next(ui + 1, nxt);
        const char* nB = has_next ? (const char*)g.Bt + (size_t)S.bbase(nxt, K) * 2 : cB;
        const char* nA = (Sched::GATHER || !has_next) ? cA : Ab + (size_t)(unsigned)__builtin_amdgcn_readfirstlane((int)S.arow(nxt, 0)) * K * 2;
#pragma unroll 1
        for (int t = 0; t < nt; t += 2) {
            const bool last = (t == nt - 2);
            const char* a1 = cA + (size_t)(t + 1) * kstep;
            const char* a2 = last ? nA : cA + (size_t)(t + 2) * kstep; const char* b2 = last ? nB : cB + (size_t)(t + 2) * kstep;
            const char* a3 = a2 + kstep; const char* b3 = b2 + kstep;
            PG8_LDB(B0, 0, 0); PG8_LDB(B1, 0, 1); PG8_SCHED; PG8_LDA(At, 0, 0); PG8_STAGEA(PG8_SA(1, 1), a1, 1);
            PG8_WAIT_V(8); PG8_WAIT_L(0); PG8_BAR; PG8_MMA(0, 0, At, B0); PG8_MMA(0, 1, At, B1); PG8_BAR; PG8_SCHED;
            if constexpr (Sched::GATHER) { if (last && has_next) { int tq = tid; asm volatile("" : "+v"(tq)); PG8_ROWOFFS(vcur, nxt, tq); } }
            PG8_LDA(At, 0, 1); PG8_STAGE(PG8_SB(0, 0), b2, voffB); PG8_STAGE(PG8_SB(0, 1), b2 + hstep, voffB); PG8_STAGEA(PG8_SA(0, 0), a2, 0);
            PG8_WAIT_V(8); PG8_WAIT_L(0); PG8_BAR; if (!cur.hf) { PG8_MMA(1, 0, At, B0); PG8_MMA(1, 1, At, B1); } PG8_BAR; PG8_SCHED;
            PG8_LDB(B0, 1, 0); PG8_LDB(B1, 1, 1); PG8_SCHED; PG8_LDA(At, 1, 0); PG8_STAGEA(PG8_SA(0, 1), a2, 1);
            PG8_WAIT_V(8); PG8_WAIT_L(0); PG8_BAR; PG8_MMA(0, 0, At, B0); PG8_MMA(0, 1, At, B1); PG8_BAR; PG8_SCHED;
            PG8_LDA(At, 1, 1); PG8_STAGE(PG8_SB(1, 0), b3, voffB); PG8_STAGE(PG8_SB(1, 1), b3 + hstep, voffB); PG8_STAGEA(PG8_SA(1, 0), a3, 0);
            PG8_WAIT_V(8); PG8_WAIT_L(0); PG8_BAR; if (!cur.hf) { PG8_MMA(1, 0, At, B0); PG8_MMA(1, 1, At, B1); } PG8_BAR; PG8_SCHED;
        }
        if (wr == 0) PG8_BAR;
        { int tz = tid; asm volatile("" : "+v"(tz)); const int ln = tz & 63; E(acc, cur, wr, wc, ln & 15, ln >> 4); }
        if (!has_next) break;
#pragma unroll
        for (int a = 0; a < 2; ++a)
#pragma unroll
            for (int b = 0; b < 2; ++b)
#pragma unroll
                for (int m = 0; m < 4; ++m)
#pragma unroll
                    for (int n = 0; n < 2; ++n) acc[a][b][m][n] = (f32x4){zf, zf, zf, zf};
        cur = nxt; cB = nB; cA = nA; ++ui;
        if (wr == 1) PG8_BAR;
    }
    PG8_WAIT_V(0);
    PG8_BAR;
#undef PG8_SA
#undef PG8_SB
#undef PG8_STAGE
#undef PG8_LDA
#undef PG8_LDB
#undef PG8_MMA
#undef PG8_WAIT_V
#undef PG8_WAIT_L
#undef PG8_BAR
#undef PG8_SCHED
#undef PG8_ROWOFFS
#undef PG8_STAGEA
}

#define EPI_LOOP for (int ai = 0; ai < 2; ++ai) for (int m = 0; m < 4; ++m) for (int bj = 0; bj < 2; ++bj) for (int n = 0; n < 2; ++n)
struct EpiBf16 {
    bf16_t* O; int ldc;
    __device__ __forceinline__ void operator()(const f32x4 (&acc)[2][2][4][2], const Unit& u, int wr, int wc, int fr, int fq) const {
        const int row0 = u.pm * BM + wr * 64 + fr, col0 = u.pn * BM + wc * 32 + 4 * fq;
#pragma unroll
        for (int ai = 0; ai < 2; ++ai)
#pragma unroll
            for (int m = 0; m < 4; ++m) { bf16_t* rowp = O + (size_t)(row0 + ai * HALF + m * 16) * ldc + col0;
#pragma unroll
                for (int bj = 0; bj < 2; ++bj)
#pragma unroll
                    for (int n = 0; n < 2; ++n) { const f32x4 v = acc[ai][bj][m][n]; u32x2 o; o.x = pk2(v[0], v[1]); o.y = pk2(v[2], v[3]); *(u32x2*)(rowp + bj * HALF + n * 16) = o; } }
    }
};
struct EpiOdd {
    bf16_t* P; bf16_t* Q; bf16_t* KA; const float* rope;
    __device__ __forceinline__ void operator()(const f32x4 (&acc)[2][2][4][2], const Unit& u, int wr, int wc, int fr, int fq) const {
        const int row0 = u.pm * BM + wr * 64 + fr, col0 = u.pn * BM + wc * 32 + 4 * fq;
        if (u.pn >= 6) {
#pragma unroll
            for (int ai = 0; ai < 2; ++ai)
#pragma unroll
                for (int m = 0; m < 4; ++m) { bf16_t* rowp = P + (size_t)(row0 + ai * HALF + m * 16) * P_LD + col0;
#pragma unroll
                    for (int bj = 0; bj < 2; ++bj)
#pragma unroll
                        for (int n = 0; n < 2; ++n) { const f32x4 v = acc[ai][bj][m][n]; u32x2 o; o.x = pk2(v[0], v[1]); o.y = pk2(v[2], v[3]); *(u32x2*)(rowp + bj * HALF + n * 16) = o; } }
            return;
        }
        const bool isk = u.pn >= 3, isctx = u.pm >= NLAT / BM; const int axis = wc & 1;
        const int cq = col0 - (isk ? 768 : 0);
#pragma unroll
        for (int ai = 0; ai < 2; ++ai)
#pragma unroll
            for (int m = 0; m < 4; ++m) { const int row = row0 + ai * HALF + m * 16;
                f32x4 cs = {1.f, 1.f, 1.f, 1.f}, sn = {0.f, 0.f, 0.f, 0.f}; size_t orow;
                if (!isctx) { const int t = row & (TT - 1); const int pos = axis ? 128 + (t & 63) : (t >> 6);
                    cs = *(const f32x4*)(rope + pos * 16 + 4 * fq); sn = *(const f32x4*)(rope + 192 * 16 + pos * 16 + 4 * fq);
                    orow = isk ? (size_t)(row >> 13) * LKEYS + CTXL + t : (size_t)row; }
                else { const int rc = row - NLAT; orow = isk ? (size_t)(rc >> 8) * LKEYS + (rc & 255) : (size_t)row; }
                bf16_t* op = (isk ? KA : Q) + orow * 768 + cq; const float sc = isk ? 1.f : QSCALE;
#pragma unroll
                for (int bj = 0; bj < 2; ++bj) { const f32x4 x1 = acc[ai][bj][m][0], x2 = acc[ai][bj][m][1];
                    const f32x4 o1 = (x1 * cs - x2 * sn) * sc, o2 = (x1 * sn + x2 * cs) * sc;
                    u32x2 a; a.x = pk2(o1[0], o1[1]); a.y = pk2(o1[2], o1[3]); *(u32x2*)(op + bj * HALF) = a;
                    u32x2 b; b.x = pk2(o2[0], o2[1]); b.y = pk2(o2[2], o2[3]); *(u32x2*)(op + bj * HALF + 16) = b; } }
    }
};
struct EpiRes {
    float* X; const float* modl;
    __device__ __forceinline__ void operator()(const f32x4 (&acc)[2][2][4][2], const Unit& u, int wr, int wc, int fr, int fq) const {
        const int row0 = u.pm * BM + wr * 64 + fr, col0 = u.pn * BM + wc * 32 + 4 * fq;
        const int mi = (u.pm * BM < NLAT) ? (u.pm * BM) / TT : 4;
        const float* gate = modl + mi * 6144 + 2 * DM;
        f32x4 gv[2][2];
#pragma unroll
        for (int bj = 0; bj < 2; ++bj)
#pragma unroll
            for (int n = 0; n < 2; ++n) gv[bj][n] = *(const f32x4*)(gate + col0 + bj * HALF + n * 16);
#pragma unroll
        for (int ai = 0; ai < 2; ++ai)
#pragma unroll
            for (int m = 0; m < 4; ++m) { float* rowp = X + (size_t)(row0 + ai * HALF + m * 16) * DM + col0;
#pragma unroll
                for (int bj = 0; bj < 2; ++bj)
#pragma unroll
                    for (int n = 0; n < 2; ++n) { f32x4* p = (f32x4*)(rowp + bj * HALF + n * 16); const f32x4 x = *p; *p = x * ALPHA_DN + gv[bj][n] * acc[ai][bj][m][n]; } }
    }
};
struct EpiSwiGLU {
    bf16_t* HID;
    __device__ __forceinline__ void operator()(const f32x4 (&acc)[2][2][4][2], const Unit& u, int wr, int wc, int fr, int fq) const {
        const int row0 = u.pm * BM + wr * 64 + fr, f0 = u.pn * HALF + wc * 32 + 4 * fq;
#pragma unroll
        for (int ai = 0; ai < 2; ++ai) if (ai == 0 || !u.hf)
#pragma unroll
            for (int m = 0; m < 4; ++m) { bf16_t* rowp = HID + (size_t)(row0 + ai * HALF + m * 16) * D_EXP + f0;
#pragma unroll
                for (int n = 0; n < 2; ++n) { const f32x4 a = acc[ai][0][m][n], b = acc[ai][1][m][n]; float h[4];
#pragma unroll
                    for (int j = 0; j < 4; ++j) h[j] = a[j] / (1.f + __expf(-a[j])) * b[j];
                    u32x2 o; o.x = pk2(h[0], h[1]); o.y = pk2(h[2], h[3]); *(u32x2*)(rowp + n * 16) = o; } }
    }
};
struct EpiYE {
    bf16_t* YE; const float* gate;
    __device__ __forceinline__ void operator()(const f32x4 (&acc)[2][2][4][2], const Unit& u, int wr, int wc, int fr, int fq) const {
        const int row0 = u.pm * BM + wr * 64 + fr, col0 = u.pn * BM + wc * 32 + 4 * fq;
        float gts[2][4];
#pragma unroll
        for (int ai = 0; ai < 2; ++ai)
#pragma unroll
            for (int m = 0; m < 4; ++m) gts[ai][m] = gate[row0 + ai * HALF + m * 16];
#pragma unroll
        for (int ai = 0; ai < 2; ++ai) if (ai == 0 || !u.hf)
#pragma unroll
            for (int m = 0; m < 4; ++m) { const int row = row0 + ai * HALF + m * 16; const float gt = gts[ai][m]; bf16_t* rowp = YE + (size_t)row * DM + col0;
#pragma unroll
                for (int bj = 0; bj < 2; ++bj)
#pragma unroll
                    for (int n = 0; n < 2; ++n) { const f32x4 v = acc[ai][bj][m][n] * gt; u32x2 o; o.x = pk2(v[0], v[1]); o.y = pk2(v[2], v[3]); *(u32x2*)(rowp + bj * HALF + n * 16) = o; } }
    }
};
struct EpiLora {
    unsigned char* SCN; bf16_t* G; const float* decay0; const float* a0; const float* kalpha;
    __device__ __forceinline__ void operator()(const f32x4 (&acc)[2][2][4][2], const Unit& u, int wr, int wc, int fr, int fq) const {
        const int row0 = u.pm * BM + wr * 64 + fr;
        const int seg = u.pn / 3, cb = (u.pn % 3) * BM + wc * 32 + 4 * fq;
#pragma unroll
        for (int bj = 0; bj < 2; ++bj)
#pragma unroll
            for (int n = 0; n < 2; ++n) {
                const int col = cb + bj * HALF + n * 16, head = col >> 6, kx = col & 63;
                if (seg < 2) {
                    const f32x4 d0 = *(const f32x4*)(decay0 + seg * 768 + col);
#pragma unroll
                    for (int ai = 0; ai < 2; ++ai)
#pragma unroll
                        for (int m = 0; m < 4; ++m) { const int row = row0 + ai * HALF + m * 16; f32x4 w;
#pragma unroll
                            for (int j = 0; j < 4; ++j) { const float lw = -DECAY_SCALE * sigmoidf_(d0[j] + acc[ai][bj][m][n][j]); w[j] = CHUNKED_SCAN ? lw : __expf(lw); }
                            *(f32x4*)(SCN + (size_t)(row * 12 + head) * SC_REC + SC_W + seg * 256 + kx * 4) = w; __builtin_amdgcn_sched_barrier(0); }
                } else if (seg < 4) {
                    const int d = seg - 2;
                    const f32x4 a00 = *(const f32x4*)(a0 + d * 768 + col), kal = *(const f32x4*)(kalpha + col);
                    u32x2 kkr[2][4], ksr[2][4];
#pragma unroll
                    for (int ai = 0; ai < 2; ++ai)
#pragma unroll
                        for (int m = 0; m < 4; ++m) { const unsigned char* base = SCN + (size_t)((row0 + ai * HALF + m * 16) * 12 + head) * SC_REC + kx * 2;
                            kkr[ai][m] = *(const u32x2*)(base + SC_KK); ksr[ai][m] = *(const u32x2*)(base + SC_KR + 256 * d); }
#pragma unroll
                    for (int ai = 0; ai < 2; ++ai)
#pragma unroll
                        for (int m = 0; m < 4; ++m) { const int row = row0 + ai * HALF + m * 16; unsigned char* base = SCN + (size_t)(row * 12 + head) * SC_REC + kx * 2;
                            const f32x4 kk = {bflo(kkr[ai][m].x), bfhi(kkr[ai][m].x), bflo(kkr[ai][m].y), bfhi(kkr[ai][m].y)}; const f32x4 ks = {bflo(ksr[ai][m].x), bfhi(ksr[ai][m].x), bflo(ksr[ai][m].y), bfhi(ksr[ai][m].y)}; f32x4 bb, kr;
#pragma unroll
                            for (int j = 0; j < 4; ++j) { const float a = sigmoidf_(a00[j] + acc[ai][bj][m][n][j]); bb[j] = kk[j] * a; kr[j] = ks[j] * (1.f + (a - 1.f) * kal[j]); }
                            st4bf_(base + SC_B + 256 * d, bb); st4bf_(base + SC_KR + 256 * d, kr); __builtin_amdgcn_sched_barrier(0); }
                } else {
#pragma unroll
                    for (int ai = 0; ai < 2; ++ai)
#pragma unroll
                        for (int m = 0; m < 4; ++m) { const int row = row0 + ai * HALF + m * 16; const f32x4 v = acc[ai][bj][m][n]; u32x2 o; o.x = pk2(v[0], v[1]); o.y = pk2(v[2], v[3]);
                            *(u32x2*)(G + (size_t)row * 768 + col) = o; }
                }
            }
    }
};
}

struct Args { const float* in[37]; float* out; unsigned char* ws; int lo, hi; };
enum { I_X = 0, I_C, I_CTX, I_CCTX, I_WMOD, I_BMOD, I_LNG, I_LNB, I_EWIN, I_EWOUT, I_CONVW, I_MU, I_DUP, I_D0, I_AUP, I_A0, I_GUP, I_KXI, I_KAL, I_RBON, I_GNG, I_GNB,
       I_OWIN, I_OWOUT, I_LQ1, I_LK1, I_LQ2, I_LK2, I_SUBG, I_GLNG, I_GLNB, I_GWS, I_GBS, I_WR, I_WE1, I_WE3, I_WE2 };

struct Ctx {
    LAS unsigned char* lds;
    int tid, lane, wave, G, vcu, gw, NGW;
};
__device__ __forceinline__ void mkctx(Ctx& C, LAS unsigned char* lds) {
    int tid = threadIdx.x; asm volatile("" : "+v"(tid));
    C.lds = lds; C.tid = tid; C.lane = tid & 63; C.wave = __builtin_amdgcn_readfirstlane(tid >> 6);
    C.G = gridDim.x; { const int bx = blockIdx.x; C.vcu = (C.G % 8 == 0) ? (bx % 8) * (C.G / 8) + bx / 8 : bx; }
    C.gw = blockIdx.x * NWAVES + C.wave; C.NGW = C.G * NWAVES;
}
#define GLOBAL_PTR(T, v) ((T*)(__attribute__((address_space(1))) T*)(v))
__device__ __forceinline__ void ldargs(Args& A, LAS unsigned char* lds) {
    LAS const u32x2* tb = (LAS const u32x2*)(lds + LDS_PTAB); asm volatile("" : "+v"(tb));
#pragma unroll
    for (int i = 0; i < 37; ++i) { const u32x2 v = tb[i]; A.in[i] = GLOBAL_PTR(const float, ((unsigned long long)(unsigned)__builtin_amdgcn_readfirstlane((int)v.y) << 32) | (unsigned)__builtin_amdgcn_readfirstlane((int)v.x)); }
    { const u32x2 v = tb[37]; A.out = GLOBAL_PTR(float, ((unsigned long long)(unsigned)__builtin_amdgcn_readfirstlane((int)v.y) << 32) | (unsigned)__builtin_amdgcn_readfirstlane((int)v.x)); }
    { const u32x2 v = tb[38]; A.ws = GLOBAL_PTR(unsigned char, ((unsigned long long)(unsigned)__builtin_amdgcn_readfirstlane((int)v.y) << 32) | (unsigned)__builtin_amdgcn_readfirstlane((int)v.x)); }
    A.lo = 0; A.hi = 0;
}
__device__ __forceinline__ int row_mi(int row) { return row < NLAT ? (row >> 13) : 4; }

__device__ __forceinline__ void phase_init(const Ctx& C, const Args& A) {
    unsigned char* ws = A.ws;
    float* MOD = (float*)(ws + WS_MOD);
    LAS float* sv = (LAS float*)C.lds;
    LAS float* red = sv + 5 * 1024;
    for (int i = C.tid; i < 5 * 1024; i += NTHR) { const int v = i >> 10, k = i & 1023; const float c = (v < 4) ? A.in[I_C][v * DM + k] : A.in[I_CCTX][k]; sv[i] = c / (1.f + __expf(-c)); }
    __syncthreads();
    const int j = C.tid & 127, kp = C.tid >> 7;
    for (int it = blockIdx.x; it < DEPTH * 48; it += C.G) {
        const int l = it / 48, cg = it % 48, col = cg * 128 + j;
        const float* W = A.in[I_WMOD] + (size_t)l * DM * 6144 + col;
        float a0 = 0.f, a1 = 0.f, a2 = 0.f, a3 = 0.f, a4 = 0.f;
#pragma unroll 4
        for (int k = kp * 256; k < kp * 256 + 256; ++k) { const float w = W[(size_t)k * 6144]; a0 += sv[k] * w; a1 += sv[1024 + k] * w; a2 += sv[2048 + k] * w; a3 += sv[3072 + k] * w; a4 += sv[4096 + k] * w; }
        red[(kp * 5 + 0) * 128 + j] = a0; red[(kp * 5 + 1) * 128 + j] = a1; red[(kp * 5 + 2) * 128 + j] = a2; red[(kp * 5 + 3) * 128 + j] = a3; red[(kp * 5 + 4) * 128 + j] = a4;
        __syncthreads();
        for (int o = C.tid; o < 5 * 128; o += NTHR) { const int v = o >> 7, jj = o & 127; const int cc = cg * 128 + jj;
            const float s = red[(0 * 5 + v) * 128 + jj] + red[(1 * 5 + v) * 128 + jj] + red[(2 * 5 + v) * 128 + jj] + red[(3 * 5 + v) * 128 + jj];
            MOD[((size_t)l * 5 + v) * 6144 + cc] = s + A.in[I_BMOD][l * 6144 + cc]; }
        __syncthreads();
    }
    if (blockIdx.x == C.G - 1) { float* rope = (float*)(ws + WS_ROPE);
        for (int i = C.tid; i < 192 * 16; i += NTHR) { const int pos = i >> 4, j = i & 15; const float ang = (float)(pos < 128 ? pos : pos - 128) * powf(10000.f, -(float)j * (1.f / 16.f));
            rope[i] = cosf(ang); rope[192 * 16 + i] = sinf(ang); } }
    f32x4* X4 = (f32x4*)(ws + WS_X);
    const f32x4* x4 = (const f32x4*)A.in[I_X]; const f32x4* c4 = (const f32x4*)A.in[I_CTX];
    const size_t nl = (size_t)NLAT * DM / 4, nc = (size_t)NCTX * DM / 4;
    for (size_t i = (size_t)blockIdx.x * NTHR + C.tid; i < nl + nc; i += (size_t)C.G * NTHR) X4[i] = (i < nl) ? x4[i] : c4[i - nl];
}

__device__ __forceinline__ void transpose_item(const float* W, int ldw, int k0, int n0, bf16_t* WT, int ldt, int drow0, LAS float* scr, int lane) {
    { float v[64]; const float* src = W + (size_t)k0 * ldw + n0 + lane;
#pragma unroll
      for (int k = 0; k < 64; ++k) v[k] = __builtin_nontemporal_load(src + (size_t)k * ldw);
#pragma unroll
      for (int k = 0; k < 64; ++k) scr[k * 65 + lane] = v[k]; }
    asm volatile("s_waitcnt lgkmcnt(0)" ::: "memory");
    const int c = lane & 7;
#pragma unroll
    for (int j = 0; j < 8; ++j) { const int n = (lane >> 3) + 8 * j; const LAS float* s = scr + (8 * c) * 65 + n;
        u32x4 o; o.x = pk2(s[0 * 65], s[1 * 65]); o.y = pk2(s[2 * 65], s[3 * 65]); o.z = pk2(s[4 * 65], s[5 * 65]); o.w = pk2(s[6 * 65], s[7 * 65]);
        *(u32x4*)(WT + (size_t)(drow0 + n) * ldt + k0 + 8 * c) = o; }
    asm volatile("s_waitcnt lgkmcnt(0)" ::: "memory");
}
__device__ __forceinline__ void conv_items(const Ctx& C, const Args& A, int l, int gw, int NGW, bool do_in, bool do_out, bool do_exp) {
    unsigned char* ws = A.ws;
    const int i2 = l >> 1; const bool odd = (l & 1);
    LAS float* scr = (LAS float*)C.lds + C.wave * (64 * 65);
    bf16_t* WIN = (bf16_t*)(ws + WS_WIN); bf16_t* WOUT = (bf16_t*)(ws + WS_WOUT); bf16_t* WE13 = (bf16_t*)(ws + WS_WE13 + (size_t)(l & 1) * WE13_BYTES); bf16_t* WE2 = (bf16_t*)(ws + WS_WE2 + (size_t)(l & 1) * WE2_BYTES);
    const int nin = odd ? D_IN_ODD : D_IN_EVEN;
    const float* win = odd ? A.in[I_OWIN] + (size_t)i2 * DM * D_IN_ODD : A.in[I_EWIN] + (size_t)i2 * DM * D_IN_EVEN;
    const float* wout = odd ? A.in[I_OWOUT] + (size_t)i2 * DM * DM : A.in[I_EWOUT] + (size_t)i2 * DM * DM;
    const int n_in = do_in ? 16 * (nin / 64) : 0, n_out = do_out ? 16 * 16 : 0, n_e13 = do_exp ? NEXP * 2 * 16 * 32 : 0, n_e2 = do_exp ? NEXP * 32 * 16 : 0;
    const int total = n_in + n_out + n_e13 + n_e2;
    for (int it = gw; it < total; it += NGW) {
        int r = it;
        if (r < n_in) { const int nb = nin / 64, kb = r / nb, nn = r % nb; transpose_item(win, nin, kb * 64, nn * 64, WIN, DM, nn * 64, scr, C.lane); continue; } r -= n_in;
        if (r < n_out) { const int kb = r / 16, nn = r % 16; transpose_item(wout, DM, kb * 64, nn * 64, WOUT, DM, nn * 64, scr, C.lane); continue; } r -= n_out;
        if (r < n_e13) { const int e = r / 1024, q = r % 1024, mat = q / 512, q2 = q % 512, kb = q2 / 32, nn = q2 % 32;
            const float* W = (mat ? A.in[I_WE3] : A.in[I_WE1]) + ((size_t)l * NEXP + e) * DM * D_EXP;
            const int f0 = nn * 64; const int drow = (f0 >> 7) * 256 + mat * 128 + (f0 & 127);
            transpose_item(W, D_EXP, kb * 64, f0, WE13 + (size_t)e * 4096 * DM, DM, drow, scr, C.lane); continue; } r -= n_e13;
        { const int e = r / 512, q = r % 512, kb = q / 16, nn = q % 16;
            const float* W = A.in[I_WE2] + ((size_t)l * NEXP + e) * D_EXP * DM;
            transpose_item(W, DM, kb * 64, nn * 64, WE2 + (size_t)e * DM * D_EXP, D_EXP, nn * 64, scr, C.lane); }
    }
}
__device__ __forceinline__ void phase_conv(const Ctx& C, const Args& A, int l) {
    unsigned char* ws = A.ws;
    const int i2 = l >> 1; const bool odd = (l & 1);
    bf16_t* WIN = (bf16_t*)(ws + WS_WIN);
    const bool early = CHUNKED_SCAN && odd;
    if (l > 0) conv_items(C, A, l, C.gw, C.NGW, !early, true, !early);
    if (!odd) {
        u32x4* z = (u32x4*)(WIN + (size_t)D_IN_EVEN * DM);
        unsigned zz = 0u; asm volatile("" : "+v"(zz));
        for (int i = blockIdx.x * NTHR + C.tid; i < (D_IN_EVEN_PAD - D_IN_EVEN) * DM / 8; i += C.G * NTHR) z[i] = (u32x4){zz, zz, zz, zz};
        bf16_t* WL = (bf16_t*)(ws + WS_WLORA);
        const float* dup = A.in[I_DUP] + (size_t)i2 * 2 * 64 * 768; const float* aup = A.in[I_AUP] + (size_t)i2 * 2 * 64 * 768; const float* gup = A.in[I_GUP] + (size_t)i2 * 128 * 768;
        for (int i = blockIdx.x * NTHR + C.tid; i < LORA_N * LORA_K; i += C.G * NTHR) {
            const int kk = i / LORA_N, n = i % LORA_N, seg = n / 768, col = n % 768; float v = 0.f;
            if (seg == 0) { if (kk < 64) v = dup[(size_t)(0 * 64 + kk) * 768 + col]; }
            else if (seg == 1) { if (kk >= 64 && kk < 128) v = dup[(size_t)(1 * 64 + kk - 64) * 768 + col]; }
            else if (seg == 2) { if (kk >= 128 && kk < 192) v = aup[(size_t)(0 * 64 + kk - 128) * 768 + col]; }
            else if (seg == 3) { if (kk >= 192 && kk < 256) v = aup[(size_t)(1 * 64 + kk - 192) * 768 + col]; }
            else { if (kk >= 256) v = gup[(size_t)(kk - 256) * 768 + col]; }
            WL[(size_t)n * LORA_K + kk] = (bf16_t)f2bf(v);
        }
    }
}

__device__ __forceinline__ void phase_modh(const Ctx& C, const Args& A, int l) {
    const float* X = (const float*)(A.ws + WS_X); bf16_t* H = (bf16_t*)(A.ws + WS_H); const float* MOD = (const float*)(A.ws + WS_MOD) + (size_t)l * 5 * 6144;
    for (int row = C.gw; row < MROWS; row += C.NGW) {
        const float* md = MOD + row_mi(row) * 6144;
#pragma unroll
        for (int j = 0; j < 4; ++j) { const int col = 4 * C.lane + 256 * j; const f32x4 x = *(const f32x4*)(X + (size_t)row * DM + col), sh = *(const f32x4*)(md + col), sc = *(const f32x4*)(md + DM + col);
            const f32x4 h = x * (sc + 1.f) + sh; u32x2 o; o.x = pk2(h[0], h[1]); o.y = pk2(h[2], h[3]); *(u32x2*)(H + (size_t)row * DM + col) = o; }
    }
}

__device__ __forceinline__ f32x4 ld4bf(const bf16_t* p) { const u32x2 u = *(const u32x2*)p; return (f32x4){bflo(u.x), bfhi(u.x), bflo(u.y), bfhi(u.y)}; }
__device__ __forceinline__ void st4bf(bf16_t* p, f32x4 v) { u32x2 o; o.x = pk2(v[0], v[1]); o.y = pk2(v[2], v[3]); *(u32x2*)p = o; }
__device__ __forceinline__ void seq_info(int row, bool& hasp, bool& hasn) {
    if (row < NLAT) { const int t = row & (TT - 1); hasp = t > 0; hasn = t < TT - 1; }
    else { const int t = (row - NLAT) & (CTXL - 1); hasp = t > 0; hasn = t < CTXL - 1; }
}
__device__ __forceinline__ void phase_ef1(const Ctx& C, const Args& A, int l) {
    const int i2 = l >> 1; unsigned char* ws = A.ws;
    const bf16_t* P = (const bf16_t*)(ws + WS_P); bf16_t* A2 = (bf16_t*)(ws + WS_A2); unsigned char* SCN = ws + WS_SCN; bf16_t* LIN = (bf16_t*)(ws + WS_LIN);
    const float* cw = A.in[I_CONVW] + (size_t)i2 * 3 * 256; const float* mu = A.in[I_MU] + (size_t)i2 * RWKV_COLS; const float* kxi = A.in[I_KXI] + (size_t)i2 * 768;
    const f32x4 z4 = {0.f, 0.f, 0.f, 0.f};
    for (int row = C.gw; row < MROWS; row += C.NGW) {
        bool hasp, hasn; seq_info(row, hasp, hasn);
        const bf16_t* p0 = P + (size_t)row * P_LD; const bf16_t* pm = p0 - P_LD; const bf16_t* pp = p0 + P_LD;
        {
            const int j4 = 4 * C.lane;
            const f32x4 bg = ld4bf(p0 + j4), u0 = ld4bf(p0 + 256 + j4) * ld4bf(p0 + 512 + j4);
            const f32x4 um = hasp ? ld4bf(pm + 256 + j4) * ld4bf(pm + 512 + j4) : z4, up = hasn ? ld4bf(pp + 256 + j4) * ld4bf(pp + 512 + j4) : z4;
            const f32x4 w0 = *(const f32x4*)(cw + j4), w1 = *(const f32x4*)(cw + 256 + j4), w2 = *(const f32x4*)(cw + 512 + j4);
            st4bf(A2 + (size_t)row * DM + j4, bg * (w0 * um + w1 * u0 + w2 * up));
        }
#pragma unroll
        for (int it = 0; it < 11; ++it) {
            const int c = it * 256 + 4 * C.lane;
            if (c < RWKV_COLS) {
                const f32x4 x0 = ld4bf(p0 + 768 + c), xm = hasp ? ld4bf(pm + 768 + c) : z4, xp = hasn ? ld4bf(pp + 768 + c) : z4, m4 = *(const f32x4*)(mu + c);
                const f32x4 ps = x0 + m4 * ((xm + xp) * 0.5f - x0);
                if (it < 3) { const int head = c >> 6, kx = c & 63; st4bf_(SCN + (size_t)(row * 12 + head) * SC_REC + SC_R + kx * 2, ps); }
                else if (it < 6) { const int c1 = c - 768, head = c1 >> 6, kx = c1 & 63; const f32x4 kv = ps * *(const f32x4*)(kxi + c1);
                    const float ss = sum16(kv[0] * kv[0] + kv[1] * kv[1] + kv[2] * kv[2] + kv[3] * kv[3]); const float rn = rsqrtf(ss + 1e-12f);
                    unsigned char* base = SCN + (size_t)(row * 12 + head) * SC_REC + kx * 2;
                    st4bf_(base + SC_KK, kv * rn); st4bf_(base + SC_KR, ps); st4bf_(base + SC_KR + 256, ps); }
                else if (it < 9) { const int c1 = c - 1536, head = c1 >> 6, kx = c1 & 63; st4bf_(SCN + (size_t)(row * 12 + head) * SC_REC + SC_V + kx * 2, ps); }
                else { const int c1 = c - 2304; f32x4 o;
                    if (c1 < 128) { o = (f32x4){tanhf(ps[0]), tanhf(ps[1]), tanhf(ps[2]), tanhf(ps[3])}; }
                    else if (c1 < 256) { o = ps; }
                    else { o = (f32x4){sigmoidf_(ps[0]), sigmoidf_(ps[1]), sigmoidf_(ps[2]), sigmoidf_(ps[3])}; }
                    st4bf(LIN + (size_t)row * LORA_K + c1, o); }
            }
        }
    }
}

__device__ __forceinline__ int scan_row(int i, int b, int d) {
    if (d == 0) return i < CTXL ? NLAT + b * CTXL + i : b * TT + (i - CTXL);
    return i < CTXL ? NLAT + b * CTXL + (CTXL - 1 - i) : b * TT + (TT - 1 - (i - CTXL));
}
__device__ __forceinline__ float red8(float v) {
    v += __uint_as_float((unsigned)__builtin_amdgcn_update_dpp(0, (int)__float_as_uint(v), 0xB1, 0xF, 0xF, true));
    v += __uint_as_float((unsigned)__builtin_amdgcn_update_dpp(0, (int)__float_as_uint(v), 0x4E, 0xF, 0xF, true));
    v += __uint_as_float((unsigned)__builtin_amdgcn_update_dpp(0, (int)__float_as_uint(v), 0x141, 0xF, 0xF, true));
    return v;
}
__device__ __forceinline__ float red16(float v) {
    v += __uint_as_float((unsigned)__builtin_amdgcn_update_dpp(0, (int)__float_as_uint(v), 0xB1, 0xF, 0xF, true));
    v += __uint_as_float((unsigned)__builtin_amdgcn_update_dpp(0, (int)__float_as_uint(v), 0x4E, 0xF, 0xF, true));
    v += __uint_as_float((unsigned)__builtin_amdgcn_update_dpp(0, (int)__float_as_uint(v), 0x141, 0xF, 0xF, true));
    v += __uint_as_float((unsigned)__builtin_amdgcn_update_dpp(0, (int)__float_as_uint(v), 0x140, 0xF, 0xF, true));
    return v;
}
__device__ __forceinline__ void phase_scan(const Ctx& C, const Args& A) {
    for (int u = blockIdx.x; u < 192; u += C.G) {
    const int half = u & 1, d = (u >> 1) & 1, h = (u >> 2) % 12, b = u / 48;
    const unsigned char* SCN = A.ws + WS_SCN; float* Y = (float*)(A.ws + WS_Y) + (size_t)d * MROWS * 768;
    LAS float* buf = (LAS float*)C.lds; LAS float* ybuf = buf + 2 * 32 * 352;
    constexpr int NCH = LKEYS / 32;
    u32x4 st[4];
    int ps_[4], psrc[4], pdst[4]; bool pf32[4];
#pragma unroll
    for (int j = 0; j < 4; ++j) { const int p = C.tid + NTHR * j; const int s = p / 52, q = p % 52; ps_[j] = s;
        if (q < 16) { psrc[j] = SC_W + 256 * d + q * 16; pdst[j] = s * 352 + q * 4; pf32[j] = true; }
        else if (q < 48) { const int vec = (q - 16) >> 3, part = (q - 16) & 7; const int so = vec == 0 ? SC_KK : vec == 1 ? SC_B + 256 * d : vec == 2 ? SC_KR + 256 * d : SC_R;
            psrc[j] = so + part * 16; pdst[j] = s * 352 + 64 * (vec + 1) + part * 8; pf32[j] = false; }
        else { const int part = q - 48; psrc[j] = SC_V + half * 64 + part * 16; pdst[j] = s * 352 + 320 + part * 8; pf32[j] = false; } }
    const int sgn = d ? -1 : 1;
    const unsigned char* SCNh = SCN + (size_t)h * SC_REC;
#define SCAN_ROW0(c) (((c) * 32 < CTXL) ? (NLAT + b * CTXL + (d ? CTXL - 1 - (c) * 32 : (c) * 32)) : (b * TT + (d ? TT - 1 - ((c) * 32 - CTXL) : (c) * 32 - CTXL)))
#define SCAN_LOADG(c) do { const int row0_ = SCAN_ROW0(c); _Pragma("unroll") for (int j = 0; j < 4; ++j) if (j < 3 || C.tid < 1664 - 3 * NTHR) { \
        st[j] = *(const u32x4*)(SCNh + (size_t)(row0_ + sgn * ps_[j]) * SC_ROW + psrc[j]); } } while (0)
#define SCAN_STORE(bi) do { _Pragma("unroll") for (int j = 0; j < 4; ++j) if (j < 3 || C.tid < 1664 - 3 * NTHR) { LAS float* dp = buf + (bi) * (32 * 352) + pdst[j]; \
        if (pf32[j]) *(LAS u32x4*)dp = st[j]; \
        else { *(LAS f32x4*)dp = (f32x4){bflo(st[j].x), bfhi(st[j].x), bflo(st[j].y), bfhi(st[j].y)}; *(LAS f32x4*)(dp + 4) = (f32x4){bflo(st[j].z), bfhi(st[j].z), bflo(st[j].w), bfhi(st[j].w)}; } } } while (0)
    SCAN_LOADG(0); SCAN_STORE(0); __syncthreads();
    f32x2 Sa = {0.f, 0.f}, Sb = {0.f, 0.f};
    const int rl = C.lane >> 4, ks = C.lane & 15;
    float ycol = 0.f;
#define SC_LD(R, s) do { const LAS float* bp_ = cur + (s) * 352 + ks * 4; \
        R##w = *(const LAS f32x4*)(bp_); R##k = *(const LAS f32x4*)(bp_ + 64); R##b = *(const LAS f32x4*)(bp_ + 128); R##q = *(const LAS f32x4*)(bp_ + 192); R##r = *(const LAS f32x4*)(bp_ + 256); \
        R##vv = cur[(s) * 352 + 320 + C.wave * 4 + rl]; } while (0)
#define SC_LO(v) ((f32x2){v[0], v[1]})
#define SC_HI(v) ((f32x2){v[2], v[3]})
#define SC_DPP(x, ctrl) __uint_as_float((unsigned)__builtin_amdgcn_update_dpp(0, (int)__float_as_uint(x), ctrl, 0xF, 0xF, true))
#define SC_STEP(R, P, s) do { \
        f32x2 pa = __builtin_elementwise_fma(Sb, SC_HI(R##k), Sa * SC_LO(R##k)), py = __builtin_elementwise_fma(Sb, SC_HI(P##r), Sa * SC_LO(P##r)); \
        float a_ = pa.x + pa.y, y_ = py.x + py.y; \
        a_ += SC_DPP(a_, 0xB1); y_ += SC_DPP(y_, 0xB1); a_ += SC_DPP(a_, 0x4E); y_ += SC_DPP(y_, 0x4E); \
        a_ += SC_DPP(a_, 0x141); y_ += SC_DPP(y_, 0x141); a_ += SC_DPP(a_, 0x140); y_ += SC_DPP(y_, 0x140); \
        ycol = (ks == ((s) & 15)) ? y_ : ycol; \
        const f32x2 na = {-a_, -a_}, vv2 = {R##vv, R##vv}; \
        Sa = __builtin_elementwise_fma(Sa, SC_LO(R##w), __builtin_elementwise_fma(na, SC_LO(R##b), vv2 * SC_LO(R##q))); \
        Sb = __builtin_elementwise_fma(Sb, SC_HI(R##w), __builtin_elementwise_fma(na, SC_HI(R##b), vv2 * SC_HI(R##q))); } while (0)
    f32x4 Aw, Ak, Ab, Aq, Ar, Bw, Bk, Bb, Bq, Br, Cw, Ck, Cb, Cq, Cr, Dw, Dk, Db, Dq, Dr; float Avv, Bvv, Cvv, Dvv;
    Dr = (f32x4){0.f, 0.f, 0.f, 0.f};
    for (int c = 0; c < NCH; ++c) {
        if (c + 1 < NCH) SCAN_LOADG(c + 1);
        {
            const LAS float* cur = buf + (c & 1) * (32 * 352);
            LAS float* yb = ybuf + (c & 1) * 1024 + C.wave * 4 + rl + ks * 32;
            SC_LD(A, 0); SC_LD(B, 1);
#pragma unroll 1
            for (int s = 0; s < 32; s += 4) {
                SC_LD(C, s + 2); __builtin_amdgcn_sched_barrier(0); SC_STEP(A, D, s); __builtin_amdgcn_sched_barrier(0);
                SC_LD(D, s + 3); __builtin_amdgcn_sched_barrier(0); SC_STEP(B, A, s + 1); __builtin_amdgcn_sched_barrier(0);
                SC_LD(A, s + 4); __builtin_amdgcn_sched_barrier(0); SC_STEP(C, B, s + 2); __builtin_amdgcn_sched_barrier(0);
                SC_LD(B, s + 5); __builtin_amdgcn_sched_barrier(0); SC_STEP(D, C, s + 3); __builtin_amdgcn_sched_barrier(0);
                if ((s & 15) == 12) yb[(s & 16) * 32] = ycol;
            }
        }
        if (c + 1 < NCH) SCAN_STORE((c + 1) & 1);
        __syncthreads();
        { const int row0_ = SCAN_ROW0(c);
#pragma unroll
          for (int i = 0; i < 2; ++i) { const int e = C.tid + NTHR * i, s = e >> 5, r = e & 31;
            const int row = (s > 0) ? row0_ + sgn * (s - 1) : scan_row(c * 32 - 1, b, d);
            if (s > 0 || c > 0) Y[(size_t)row * 768 + h * 64 + half * 32 + r] = ybuf[(c & 1) * 1024 + e]; } }
    }
    {
        f32x2 py = __builtin_elementwise_fma(Sb, SC_HI(Dr), Sa * SC_LO(Dr)); float y_ = py.x + py.y;
        y_ += SC_DPP(y_, 0xB1); y_ += SC_DPP(y_, 0x4E); y_ += SC_DPP(y_, 0x141); y_ += SC_DPP(y_, 0x140);
        if (ks == 0) Y[(size_t)scan_row(LKEYS - 1, b, d) * 768 + h * 64 + half * 32 + C.wave * 4 + rl] = y_;
    }
    __syncthreads();
    }
#undef SCAN_LOADG
#undef SCAN_STORE
#undef SCAN_ROW0
#undef SC_LD
#undef SC_STEP
#undef SC_LO
#undef SC_HI
#undef SC_DPP
}

constexpr int CSP = 72;
constexpr int CS_MAT = 64 * CSP * 2;
constexpr int CS_WT = 0, CS_KB = CS_MAT, CS_BB = 2 * CS_MAT, CS_RT = 3 * CS_MAT, CS_BHT = 4 * CS_MAT, CS_KHT = 5 * CS_MAT, CS_VMT = 6 * CS_MAT;
constexpr int CS_M2F = 7 * CS_MAT;
constexpr int CS_M1T = CS_M2F + 16384;
constexpr int CS_N2 = CS_M1T + CS_MAT;
constexpr int CS_GT = CS_N2 + CS_MAT;
constexpr int CS_Z = CS_M2F, CS_U = CS_M2F + CS_MAT;
constexpr int CS_GL = CS_GT + 2 * CS_MAT;
static_assert(CS_GL + 256 <= LDS_MISC, "chunked-scan LDS map");
template <bool SWZB = false>
__device__ __forceinline__ void cs_mma(f32x16& acc, const LAS unsigned char* Am, const LAS unsigned char* Bm, int ti, int tj, int r32, int hi) {
    const LAS unsigned char* ap = Am + (ti * 32 + r32) * (CSP * 2) + hi * 16; const int brow = tj * 32 + r32; const LAS unsigned char* bp = Bm + brow * (CSP * 2);
    const int sw = SWZB ? ((brow >> 3) & 7) : 0;
#pragma unroll
    for (int ks = 0; ks < 4; ++ks) acc = __builtin_amdgcn_mfma_f32_32x32x16_bf16(*(const LAS bf16x8*)(ap + ks * 32), *(const LAS bf16x8*)(bp + (((ks * 2 + hi) ^ sw) * 16)), acc, 0, 0, 0);
}
__device__ __forceinline__ void cs_store_t(LAS unsigned char* Om, const f32x16& acc, int ti, int tj, int r32, int hi) {
    LAS unsigned char* op = Om + (tj * 32 + r32) * (CSP * 2) + (ti * 32 + 4 * hi) * 2;
#pragma unroll
    for (int g = 0; g < 4; ++g) { u32x2 o; o.x = pk2(acc[4 * g], acc[4 * g + 1]); o.y = pk2(acc[4 * g + 2], acc[4 * g + 3]); *(LAS u32x2*)(op + g * 16) = o; }
}
#define CS_BAR() asm volatile("s_waitcnt lgkmcnt(0)\n\ts_barrier" ::: "memory")
__device__ __forceinline__ void phase_csa(const Ctx& C, const Args& A) {
    const unsigned char* SCN = A.ws + WS_SCN; unsigned char* CHK = A.ws + WS_CHK;
    LAS unsigned char* L = C.lds;
    const int r32 = C.lane & 31, hi = C.lane >> 5;
    float lwv[8]; u32x4 ukk, ub, ukr, ur, uv;
#define CSA_GEOM(cu_) const int unit = (cu_) / CS_NCH, ch = (cu_) % CS_NCH; const int d = unit & 1, h = (unit >> 1) % 12, b = unit / 24; \
        const int step0 = ch * CS_L; const int sgn = d ? -1 : 1; \
        const int row0 = (step0 < CTXL) ? (NLAT + b * CTXL + (d ? CTXL - 1 - step0 : step0)) : (b * TT + (d ? TT - 1 - (step0 - CTXL) : step0 - CTXL)); \
        const unsigned char* rec0 = SCN + (size_t)row0 * SC_ROW + (size_t)h * SC_REC;
#define CSA_LOAD(cu_) do { CSA_GEOM(cu_); \
        { const int k = C.tid & 63, sg = C.tid >> 6; _Pragma("unroll") for (int j = 0; j < 8; ++j) lwv[j] = *(const float*)(rec0 + (long)sgn * (8 * sg + j) * SC_ROW + SC_W + 256 * d + k * 4); } \
        { const int t = C.tid >> 3, k0 = (C.tid & 7) * 8; const unsigned char* rp = rec0 + (long)sgn * t * SC_ROW; \
          ukk = *(const u32x4*)(rp + SC_KK + k0 * 2); ub = *(const u32x4*)(rp + SC_B + 256 * d + k0 * 2); ukr = *(const u32x4*)(rp + SC_KR + 256 * d + k0 * 2); ur = *(const u32x4*)(rp + SC_R + k0 * 2); uv = *(const u32x4*)(rp + SC_V + k0 * 2); } } while (0)
    if ((int)blockIdx.x < CS_UNITS * CS_NCH) CSA_LOAD((int)blockIdx.x);
    for (int cu = blockIdx.x; cu < CS_UNITS * CS_NCH; cu += C.G) {
        LAS float* csf = (LAS float*)(L + CS_M2F);
        LAS float* seg = (LAS float*)(L + CS_N2);
        { const int k = C.tid & 63, sg = C.tid >> 6;
#pragma unroll
          for (int j = 1; j < 8; ++j) lwv[j] += lwv[j - 1];
          seg[sg * 64 + k] = lwv[7];
          CS_BAR();
          float off = 0.f, tot = 0.f;
#pragma unroll
          for (int s2 = 0; s2 < 8; ++s2) { const float v = seg[s2 * 64 + k]; off += (s2 < sg) ? v : 0.f; tot += v; }
#pragma unroll
          for (int j = 0; j < 8; ++j) csf[(8 * sg + j) * 65 + k] = lwv[j] + off;
          if (sg == 7) ((LAS float*)(L + CS_GL))[k] = __expf(tot); }
        CS_BAR();
        { const int t = C.tid >> 3, k0 = (C.tid & 7) * 8;
          float wt[8], kb[8], bb[8], rt[8], bh[8], kh[8];
#pragma unroll
          for (int j = 0; j < 8; ++j) { const unsigned pkk = j < 2 ? ukk.x : j < 4 ? ukk.y : j < 6 ? ukk.z : ukk.w, pb = j < 2 ? ub.x : j < 4 ? ub.y : j < 6 ? ub.z : ub.w, pkr = j < 2 ? ukr.x : j < 4 ? ukr.y : j < 6 ? ukr.z : ukr.w, pr = j < 2 ? ur.x : j < 4 ? ur.y : j < 6 ? ur.z : ur.w;
              const float kkv = (j & 1) ? bfhi(pkk) : bflo(pkk), bv = (j & 1) ? bfhi(pb) : bflo(pb), krv = (j & 1) ? bfhi(pkr) : bflo(pkr), rv = (j & 1) ? bfhi(pr) : bflo(pr);
              const float cst = csf[t * 65 + k0 + j], csp = t > 0 ? csf[(t - 1) * 65 + k0 + j] : 0.f, csl = csf[63 * 65 + k0 + j];
              const float einv = __expf(-cst), el = __expf(csl - cst);
              wt[j] = kkv * __expf(csp); kb[j] = krv * einv; bb[j] = bv * einv; rt[j] = rv * __expf(cst); bh[j] = bv * el; kh[j] = krv * el; }
          u32x4 o;
          o.x = pk2(wt[0], wt[1]); o.y = pk2(wt[2], wt[3]); o.z = pk2(wt[4], wt[5]); o.w = pk2(wt[6], wt[7]); *(LAS u32x4*)(L + CS_WT + t * (CSP * 2) + k0 * 2) = o;
          o.x = pk2(kb[0], kb[1]); o.y = pk2(kb[2], kb[3]); o.z = pk2(kb[4], kb[5]); o.w = pk2(kb[6], kb[7]); *(LAS u32x4*)(L + CS_KB + t * (CSP * 2) + k0 * 2) = o;
          o.x = pk2(bb[0], bb[1]); o.y = pk2(bb[2], bb[3]); o.z = pk2(bb[4], bb[5]); o.w = pk2(bb[6], bb[7]); *(LAS u32x4*)(L + CS_BB + t * (CSP * 2) + k0 * 2) = o;
          o.x = pk2(rt[0], rt[1]); o.y = pk2(rt[2], rt[3]); o.z = pk2(rt[4], rt[5]); o.w = pk2(rt[6], rt[7]); *(LAS u32x4*)(L + CS_RT + t * (CSP * 2) + k0 * 2) = o;
#pragma unroll
          for (int j = 0; j < 8; ++j) { const int to = ((((t >> 3) ^ ((k0 >> 3) & 7)) * 8) + (t & 7)) * 2;
              *(LAS bf16_t*)(L + CS_BHT + (k0 + j) * (CSP * 2) + to) = (bf16_t)f2bf(bh[j]); *(LAS bf16_t*)(L + CS_KHT + (k0 + j) * (CSP * 2) + to) = (bf16_t)f2bf(kh[j]);
              const unsigned pv = j < 2 ? uv.x : j < 4 ? uv.y : j < 6 ? uv.z : uv.w; *(LAS bf16_t*)(L + CS_VMT + (k0 + j) * (CSP * 2) + to) = (bf16_t)((j & 1) ? (pv >> 16) : (pv & 0xffffu)); } }
        if (cu + C.G < CS_UNITS * CS_NCH) CSA_LOAD(cu + C.G);
        CS_BAR();
        for (int job = C.wave; job < 12; job += NWAVES) { const int p = job >> 2, ti = (job >> 1) & 1, tj = job & 1;
            f32x16 acc;
#pragma unroll
            for (int i = 0; i < 16; ++i) acc[i] = 0.f;
            if (p == 0) { cs_mma(acc, L + CS_WT, L + CS_BB, ti, tj, r32, hi);
                const int i = tj * 32 + r32; LAS float* mp = (LAS float*)(L + CS_M2F) + i * 64;
#pragma unroll
                for (int reg = 0; reg < 16; ++reg) { const int t = ti * 32 + crow(reg, hi); mp[(t & 3) * 16 + (t >> 2)] = (i < t) ? acc[reg] : 0.f; } }
            else if (p == 1) { cs_mma(acc, L + CS_WT, L + CS_KB, ti, tj, r32, hi);
                const int i = tj * 32 + r32;
#pragma unroll
                for (int reg = 0; reg < 16; ++reg) { const int t = ti * 32 + crow(reg, hi); acc[reg] = (i < t) ? acc[reg] : 0.f; }
                cs_store_t(L + CS_M1T, acc, ti, tj, r32, hi); }
            else { cs_mma(acc, L + CS_BB, L + CS_RT, ti, tj, r32, hi);
                const int t = tj * 32 + r32;
#pragma unroll
                for (int reg = 0; reg < 16; ++reg) { const int i = ti * 32 + crow(reg, hi); acc[reg] = (i <= t) ? acc[reg] : 0.f; }
                cs_store_t(L + CS_N2, acc, ti, tj, r32, hi); } }
        CS_BAR();
        { const int c = C.tid >> 2, q = C.tid & 3; float acc[16];
          { const LAS unsigned char* rcol = (c < 64) ? (L + CS_WT + c * 2) : (L + CS_M1T + (c - 64) * (CSP * 2)); const int rstride = (c < 64) ? CSP * 2 : 2;
#pragma unroll
            for (int j = 0; j < 16; ++j) acc[j] = bf2f(*(const LAS bf16_t*)(rcol + (4 * j + q) * rstride)); }
          const LAS float* m2c = (const LAS float*)(L + CS_M2F) + q * 16;
#pragma clang loop unroll(full)
          for (int i = 0; i < 64; ++i) {
              const float mine = -acc[i >> 2];
              float gi;
              switch (i & 3) { case 0: gi = __uint_as_float((unsigned)__builtin_amdgcn_update_dpp(0, (int)__float_as_uint(mine), 0x00, 0xF, 0xF, true)); break;
                               case 1: gi = __uint_as_float((unsigned)__builtin_amdgcn_update_dpp(0, (int)__float_as_uint(mine), 0x55, 0xF, 0xF, true)); break;
                               case 2: gi = __uint_as_float((unsigned)__builtin_amdgcn_update_dpp(0, (int)__float_as_uint(mine), 0xAA, 0xF, 0xF, true)); break;
                               default: gi = __uint_as_float((unsigned)__builtin_amdgcn_update_dpp(0, (int)__float_as_uint(mine), 0xFF, 0xF, 0xF, true)); break; }
#pragma unroll
              for (int j4 = (i >> 4); j4 < 4; ++j4) { const f32x4 m = *(const LAS f32x4*)(m2c + i * 64 + j4 * 4);
#pragma unroll
                  for (int e = 0; e < 4; ++e) if (4 * j4 + e >= (i >> 2)) acc[4 * j4 + e] += m[e] * gi; }
          }
#pragma unroll
          for (int j = 0; j < 16; ++j) *(LAS bf16_t*)(L + CS_GT + c * (CSP * 2) + (4 * j + q) * 2) = (bf16_t)f2bf(-acc[j]); }
        CS_BAR();
        unsigned char* outp = CHK + (size_t)cu * 32768;
        for (int job = C.wave; job < 16; job += NWAVES) { const int p = job >> 2, ti = (job >> 1) & 1, tj = job & 1;
            f32x16 acc;
            if (p == 0) {
                const LAS unsigned char* rp = L + CS_RT + (tj * 32 + r32) * (CSP * 2) + (ti * 32 + 4 * hi) * 2;
#pragma unroll
                for (int g = 0; g < 4; ++g) { const u32x2 u = *(const LAS u32x2*)(rp + g * 16); acc[4 * g] = bflo(u.x); acc[4 * g + 1] = bfhi(u.x); acc[4 * g + 2] = bflo(u.y); acc[4 * g + 3] = bfhi(u.y); }
                cs_mma(acc, L + CS_GT, L + CS_N2, ti, tj, r32, hi);
#pragma unroll
                for (int g = 0; g < 4; ++g) { u32x2 o; o.x = pk2(acc[4 * g], acc[4 * g + 1]); o.y = pk2(acc[4 * g + 2], acc[4 * g + 3]);
                    *(u32x2*)(outp + 8192 + (((tj * 4 + 2 * ti + (g >> 1)) * 64 + (g & 1) * 32 + r32) * 16) + hi * 8) = o; } }
            else if (p == 1) {
#pragma unroll
                for (int i = 0; i < 16; ++i) acc[i] = 0.f;
                cs_mma(acc, L + CS_KB, L + CS_RT, ti, tj, r32, hi);
                const int t = tj * 32 + r32;
#pragma unroll
                for (int reg = 0; reg < 16; ++reg) { const int i = ti * 32 + crow(reg, hi); acc[reg] = (i <= t) ? acc[reg] : 0.f; }
                cs_mma(acc, L + CS_GT + 64 * (CSP * 2), L + CS_N2, ti, tj, r32, hi);
                cs_store_t(L + CS_Z, acc, ti, tj, r32, hi); }
            else if (p == 2) {
#pragma unroll
                for (int i = 0; i < 16; ++i) acc[i] = 0.f;
                cs_mma<true>(acc, L + CS_GT, L + CS_BHT, ti, tj, r32, hi);
                const int k = tj * 32 + r32; const float gl = ((const LAS float*)(L + CS_GL))[k];
#pragma unroll
                for (int reg = 0; reg < 16; ++reg) { const int cc = ti * 32 + crow(reg, hi); acc[reg] += (cc == k) ? gl : 0.f; }
#pragma unroll
                for (int g = 0; g < 4; ++g) { u32x2 o; o.x = pk2(acc[4 * g], acc[4 * g + 1]); o.y = pk2(acc[4 * g + 2], acc[4 * g + 3]);
                    *(u32x2*)(outp + (((tj * 4 + 2 * ti + (g >> 1)) * 64 + (g & 1) * 32 + r32) * 16) + hi * 8) = o; } }
            else {
                const int krow = tj * 32 + r32; const LAS unsigned char* kp = L + CS_KHT + krow * (CSP * 2) + hi * 8;
#pragma unroll
                for (int g = 0; g < 4; ++g) { const u32x2 u = *(const LAS u32x2*)(kp + (((ti * 4 + g) ^ ((krow >> 3) & 7)) * 16)); acc[4 * g] = bflo(u.x); acc[4 * g + 1] = bfhi(u.x); acc[4 * g + 2] = bflo(u.y); acc[4 * g + 3] = bfhi(u.y); }
                cs_mma<true>(acc, L + CS_GT + 64 * (CSP * 2), L + CS_BHT, ti, tj, r32, hi);
                cs_store_t(L + CS_U, acc, ti, tj, r32, hi); } }
        CS_BAR();
        { const int p = C.wave >> 2, ti = (C.wave >> 1) & 1, tj = C.wave & 1;
          f32x16 acc;
#pragma unroll
          for (int i = 0; i < 16; ++i) acc[i] = 0.f;
          cs_mma<true>(acc, L + (p ? CS_U : CS_Z), L + CS_VMT, ti, tj, r32, hi);
          unsigned char* op = outp + (p ? 16384 : 24576) + ((ti * 2 + tj) * 64 + C.lane) * 32;
          u32x4 o0, o1; o0.x = pk2(acc[0], acc[1]); o0.y = pk2(acc[2], acc[3]); o0.z = pk2(acc[4], acc[5]); o0.w = pk2(acc[6], acc[7]);
          o1.x = pk2(acc[8], acc[9]); o1.y = pk2(acc[10], acc[11]); o1.z = pk2(acc[12], acc[13]); o1.w = pk2(acc[14], acc[15]);
          *(u32x4*)op = o0; *(u32x4*)(op + 16) = o1; }
        CS_BAR();
    }
}
__device__ __forceinline__ void phase_csb(const Ctx& C, const Args& A, int l) {
    if ((int)blockIdx.x >= CS_UNITS) { conv_items(C, A, l + 1, ((int)blockIdx.x - CS_UNITS) * NWAVES + C.wave, (C.G - CS_UNITS) * NWAVES, true, false, true); return; }
    const unsigned char* CHK = A.ws + WS_CHK;
    LAS unsigned char* L = C.lds;
    const int r32 = C.lane & 31, hi = C.lane >> 5;
    const bool isS = C.wave < 4; const int ti = (C.wave >> 1) & 1, tj = C.wave & 1;
    for (int unit = blockIdx.x; unit < CS_UNITS; unit += C.G) {
        const int d = unit & 1, h = (unit >> 1) % 12, b = unit / 24;
        float* Y = (float*)(A.ws + WS_Y) + (size_t)d * MROWS * 768;
        for (int i = C.tid; i < 2 * CS_MAT / 4; i += NTHR) ((LAS unsigned*)L)[i] = 0u;
        CS_BAR();
        bf16x8 afA[4], afB[4], afC[4]; u32x4 cA0, cA1, cB0, cB1, cC0, cC1;
#define CSB_LOAD(A4, C0, C1, ch_) do { const unsigned char* op_ = CHK + ((size_t)unit * CS_NCH + (ch_)) * 32768; \
            const unsigned char* am_ = op_ + (isS ? 0 : 8192) + (ti * 4 * 64 + C.lane) * 16;     \
            _Pragma("unroll") for (int ks = 0; ks < 4; ++ks) A4[ks] = *(const bf16x8*)(am_ + ks * 1024); \
            const unsigned char* cp_ = op_ + (isS ? 16384 : 24576) + ((ti * 2 + tj) * 64 + C.lane) * 32; C0 = *(const u32x4*)cp_; C1 = *(const u32x4*)(cp_ + 16); } while (0)
#define CSB_STEP(A4, C0, C1, ch_) do { \
            const LAS unsigned char* Sb = L + ((ch_) & 1) * CS_MAT; LAS unsigned char* Sn = L + (((ch_) + 1) & 1) * CS_MAT; \
            f32x16 acc; \
            acc[0] = bflo(C0.x); acc[1] = bfhi(C0.x); acc[2] = bflo(C0.y); acc[3] = bfhi(C0.y); acc[4] = bflo(C0.z); acc[5] = bfhi(C0.z); acc[6] = bflo(C0.w); acc[7] = bfhi(C0.w); \
            acc[8] = bflo(C1.x); acc[9] = bfhi(C1.x); acc[10] = bflo(C1.y); acc[11] = bfhi(C1.y); acc[12] = bflo(C1.z); acc[13] = bfhi(C1.z); acc[14] = bflo(C1.w); acc[15] = bfhi(C1.w); \
            const LAS unsigned char* bp = Sb + (tj * 32 + r32) * (CSP * 2) + hi * 16; \
            _Pragma("unroll") for (int ks = 0; ks < 4; ++ks) acc = __builtin_amdgcn_mfma_f32_32x32x16_bf16(A4[ks], *(const LAS bf16x8*)(bp + ks * 32), acc, 0, 0, 0); \
            if (isS) { cs_store_t(Sn, acc, ti, tj, r32, hi); }     \
            else {     \
                const int step0 = (ch_) * CS_L; const int sgn = d ? -1 : 1; \
                const int row0 = (step0 < CTXL) ? (NLAT + b * CTXL + (d ? CTXL - 1 - step0 : step0)) : (b * TT + (d ? TT - 1 - (step0 - CTXL) : step0 - CTXL)); \
                float* yp = Y + (size_t)(row0 + sgn * (ti * 32 + 4 * hi)) * 768 + h * 64 + tj * 32 + r32; const long ys = (long)sgn * 768; \
                _Pragma("unroll") for (int reg = 0; reg < 16; ++reg) yp[ys * ((reg & 3) + 8 * (reg >> 2))] = acc[reg]; } \
            CS_BAR(); } while (0)
        CSB_LOAD(afA, cA0, cA1, 0); CSB_LOAD(afB, cB0, cB1, 1);
        static_assert(CS_NCH % 3 == 0, "chunk loop is unrolled by three");
        for (int ch = 0; ch < CS_NCH; ch += 3) {
            if (ch == 0) CSB_LOAD(afC, cC0, cC1, 2);
            CSB_STEP(afA, cA0, cA1, ch);     if (ch + 3 < CS_NCH) CSB_LOAD(afA, cA0, cA1, ch + 3);
            CSB_STEP(afB, cB0, cB1, ch + 1); if (ch + 4 < CS_NCH) CSB_LOAD(afB, cB0, cB1, ch + 4);
            CSB_STEP(afC, cC0, cC1, ch + 2); if (ch + 5 < CS_NCH) CSB_LOAD(afC, cC0, cC1, ch + 5);
        }
        CS_BAR();
    }
#undef CSB_LOAD
#undef CSB_STEP
}

#undef CS_BAR
__device__ __forceinline__ void phase_ef2(const Ctx& C, const Args& A, int l) {
    const int i2 = l >> 1; unsigned char* ws = A.ws;
    const unsigned char* SCN = ws + WS_SCN; const float* Y0 = (const float*)(ws + WS_Y); const float* Y1 = Y0 + (size_t)MROWS * 768;
    const bf16_t* G = (const bf16_t*)(ws + WS_G); bf16_t* A2 = (bf16_t*)(ws + WS_A2);
    const float* rb = A.in[I_RBON] + (size_t)i2 * 768; const float* gg = A.in[I_GNG] + (size_t)i2 * 768; const float* gb = A.in[I_GNB] + (size_t)i2 * 768;
    for (int row = C.gw; row < MROWS; row += C.NGW) {
#pragma unroll
        for (int it = 0; it < 3; ++it) {
            const int c = it * 256 + 4 * C.lane, head = c >> 6, kx = c & 63;
            const f32x4 y = *(const f32x4*)(Y0 + (size_t)row * 768 + c) + *(const f32x4*)(Y1 + (size_t)row * 768 + c);
            const float mean = sum16((y[0] + y[1]) + (y[2] + y[3])) * (1.f / 64.f);
            const f32x4 dd = y - mean;
            const float var = sum16((dd[0] * dd[0] + dd[1] * dd[1]) + (dd[2] * dd[2] + dd[3] * dd[3])) * (1.f / 64.f);
            const float rstd = rsqrtf(var + GN_EPS);
            const unsigned char* base = SCN + (size_t)(row * 12 + head) * SC_REC + kx * 2;
            const f32x4 r = ld4bf_(base + SC_R), v = ld4bf_(base + SC_V), k0 = ld4bf_(base + SC_KR), k1 = ld4bf_(base + SC_KR + 256);
            const f32x4 rb4 = *(const f32x4*)(rb + c);
            const f32x4 t = r * (k0 + k1) * 0.5f * rb4;
            const float bs = sum16((t[0] + t[1]) + (t[2] + t[3]));
            const f32x4 yn = dd * rstd * *(const f32x4*)(gg + c) + *(const f32x4*)(gb + c);
            const f32x4 g = ld4bf(G + (size_t)row * 768 + c);
            st4bf(A2 + (size_t)row * DM + 256 + c, g * (yn + v * bs));
        }
    }
}

__device__ __forceinline__ void phase_of1(const Ctx& C, const Args& A, int l) {
    const int i2 = l >> 1; unsigned char* ws = A.ws;
    const bf16_t* P = (const bf16_t*)(ws + WS_P); bf16_t* A2 = (bf16_t*)(ws + WS_A2); bf16_t* VT = (bf16_t*)(ws + WS_VT);
    const float* lng = A.in[I_GLNG] + (size_t)i2 * 256; const float* lnb = A.in[I_GLNB] + (size_t)i2 * 256;
    const float* gws = A.in[I_GWS] + (size_t)i2 * 4 * 128 * 128; const float* gbs = A.in[I_GBS] + (size_t)i2 * 4 * 128;
    LAS bf16_t* vt = (LAS bf16_t*)C.lds;
    LAS bf16_t* uL = (LAS bf16_t*)C.lds;
    LAS bf16_t* vT = (LAS bf16_t*)(C.lds + 128 * 528);
    const int r32 = C.lane & 31, hi = C.lane >> 5;
    for (int it = blockIdx.x; it < 256 + 8 * 7; it += C.G) {
        const bool isctx = it >= 256; const int uc = isctx ? (it - 256) / 7 : 0, pc = isctx ? (it - 256) % 7 : 0; const int u = it;
        const int b = isctx ? (uc >> 1) : (u >> 6), pos0 = isctx ? (uc & 1) * 128 : (u & 63) * 128;
        const int row0 = isctx ? NLAT + b * CTXL + pos0 : b * TT + pos0, L0 = isctx ? pos0 : CTXL + pos0;
        const int hh0 = isctx ? pc : 0, hh1 = isctx ? (pc < 6 ? pc + 1 : 0) : 6; const bool doC = !isctx || pc == 6;
        for (int hh = hh0; hh < hh1; ++hh) {
#pragma unroll
            for (int i = 0; i < 4; ++i) { const int piece = C.tid + NTHR * i, r = piece >> 4, part = piece & 15;
                *(LAS u32x4*)(vt + r * 136 + part * 8) = *(const u32x4*)(P + (size_t)(row0 + r) * P_LD + 1536 + hh * 128 + part * 8); }
            __syncthreads();
#pragma unroll
            for (int i = 0; i < 4; ++i) { const int item = C.tid + NTHR * i, d = item >> 4, tg = item & 15; const LAS bf16_t* s = vt + (tg * 8) * 136 + d;
                u32x4 o; o.x = (unsigned)s[0] | ((unsigned)s[136] << 16); o.y = (unsigned)s[2 * 136] | ((unsigned)s[3 * 136] << 16);
                o.z = (unsigned)s[4 * 136] | ((unsigned)s[5 * 136] << 16); o.w = (unsigned)s[6 * 136] | ((unsigned)s[7 * 136] << 16);
                *(u32x4*)(VT + ((size_t)(b * 6 + hh) * 128 + d) * LKEYS + L0 + tg * 8) = o; }
            __syncthreads();
        }
        if (doC) {
        for (int r = C.wave; r < 128; r += NWAVES) {
            const int c4 = 4 * C.lane; const bf16_t* pr = P + (size_t)(row0 + r) * P_LD + 2304;
            const f32x4 ur = ld4bf(pr + c4), raw = ld4bf(pr + 256 + c4);
            { const f32x4 gu = {gelu_erf(ur[0]), gelu_erf(ur[1]), gelu_erf(ur[2]), gelu_erf(ur[3])}; u32x2 o; o.x = pk2(gu[0], gu[1]); o.y = pk2(gu[2], gu[3]); *(LAS u32x2*)(uL + r * 264 + c4) = o; }
            const f32x4 gv = {gelu_erf(raw[0]), gelu_erf(raw[1]), gelu_erf(raw[2]), gelu_erf(raw[3])};
            const float mean = wave_sum((gv[0] + gv[1]) + (gv[2] + gv[3])) * (1.f / 256.f); const f32x4 dd = gv - mean;
            const float var = wave_sum((dd[0] * dd[0] + dd[1] * dd[1]) + (dd[2] * dd[2] + dd[3] * dd[3])) * (1.f / 256.f); const float rstd = rsqrtf(var + LN_EPS);
            const f32x4 o = dd * rstd * *(const f32x4*)(lng + c4) + *(const f32x4*)(lnb + c4);
#pragma unroll
            for (int k = 0; k < 4; ++k) vT[(c4 + k) * 136 + r] = (bf16_t)f2bf(o[k]);
        }
        __syncthreads();
        {
            const int g = C.wave >> 1, cblk = C.wave & 1, cc = g * 64 + cblk * 32 + r32;
            for (int pblk = 0; pblk < 4; ++pblk) {
                f32x16 acc;
#pragma unroll
                for (int i = 0; i < 16; ++i) acc[i] = 0.f;
                const float* wrow = gws + ((size_t)g * 128 + pblk * 32 + r32) * 128 + 8 * hi;
#pragma unroll
                for (int ks = 0; ks < 8; ++ks) { const f32x4 w0 = *(const f32x4*)(wrow + ks * 16), w1 = *(const f32x4*)(wrow + ks * 16 + 4);
                    u32x4 au; au.x = pk2(w0[0], w0[1]); au.y = pk2(w0[2], w0[3]); au.z = pk2(w1[0], w1[1]); au.w = pk2(w1[2], w1[3]);
                    const bf16x8 bf = *(const LAS bf16x8*)(vT + cc * 136 + ks * 16 + 8 * hi);
                    acc = __builtin_amdgcn_mfma_f32_32x32x16_bf16(__builtin_bit_cast(bf16x8, au), bf, acc, 0, 0, 0); }
#pragma unroll
                for (int reg = 0; reg < 16; ++reg) { const int p = pblk * 32 + crow(reg, hi);
                    const float uu = bf2f(uL[p * 264 + cc]); const float mixed = acc[reg] + gbs[g * 128 + p];
                    uL[p * 264 + cc] = (bf16_t)f2bf(uu * mixed); }
            }
        }
        __syncthreads();
#pragma unroll
        for (int i = 0; i < 8; ++i) { const int piece = C.tid + NTHR * i, r = piece >> 5, part = piece & 31;
            *(u32x4*)(A2 + (size_t)(row0 + r) * DM + 768 + part * 8) = *(const LAS u32x4*)(uL + r * 264 + part * 8); }
        __syncthreads();
        }
    }
}

__device__ __forceinline__ void phase_attn(const Ctx& C, const Args& A, int l) {
    const int i2 = l >> 1; unsigned char* ws = A.ws;
    const bf16_t* Q = (const bf16_t*)(ws + WS_Q); const bf16_t* KA = (const bf16_t*)(ws + WS_KA); const bf16_t* VT = (const bf16_t*)(ws + WS_VT); bf16_t* A2 = (bf16_t*)(ws + WS_A2);
    const float lam_init = 0.8f - 0.6f * expf(-0.3f * (float)l);
    float s1 = 0.f, s2 = 0.f;
    for (int j = 0; j < 64; ++j) { s1 += A.in[I_LQ1][i2 * 64 + j] * A.in[I_LK1][i2 * 64 + j]; s2 += A.in[I_LQ2][i2 * 64 + j] * A.in[I_LK2][i2 * 64 + j]; }
    const float lam = expf(s1) - expf(s2) + lam_init;
    const float* subg = A.in[I_SUBG] + (size_t)i2 * 128;
    const int r32 = C.lane & 31, hi = C.lane >> 5, map = C.wave >> 2, qw = C.wave & 3;
    LAS unsigned char* Kt = C.lds; LAS unsigned char* Vt = C.lds + 2 * 16384; LAS float* xch = (LAS float*)C.lds;
    const int NU = 1536 + (l == 1 ? 48 : 0);
    for (int n = C.vcu; n < NU; n += C.G) {
        int bh, qt; bool isctx = false;
        if (n < 1536) { const int round = n >> 8, slot = n & 255; bh = (slot >> 5) * 3 + (round >> 1); qt = (round & 1) * 32 + (slot & 31); }
        else { isctx = true; bh = (n - 1536) >> 1; qt = (n - 1536) & 1; }
        const int b = bh / 6, h = bh % 6;
        const int qrow0 = isctx ? NLAT + b * CTXL + qt * 128 : b * TT + qt * 128;
        const int NT = isctx ? CTXL / 64 : LKEYS / 64;
        const bf16_t* Kb = KA + (size_t)b * LKEYS * 768 + h * 128;
        const bf16_t* Vb = VT + (size_t)(b * 6 + h) * 128 * LKEYS;
        bf16x8 qf[4];
        { const bf16_t* qp = Q + (size_t)(qrow0 + qw * 32 + r32) * 768 + h * 128 + map * 64 + 8 * hi;
#pragma unroll
          for (int ks = 0; ks < 4; ++ks) qf[ks] = *(const bf16x8*)(qp + ks * 16); }
        f32x16 O[4];
#pragma unroll
        for (int d = 0; d < 4; ++d)
#pragma unroll
            for (int i = 0; i < 16; ++i) O[d][i] = 0.f;
        float m = 0.f, lsum = 0.f;
        unsigned ksrc[2], vsrc[2];
#pragma unroll
        for (int i = 0; i < 2; ++i) { const int row = 4 * (2 * C.wave + i) + (C.lane >> 4), x = row & 15, pi = x < 4 ? x : x < 8 ? x + 4 : x < 12 ? x - 4 : x;
            ksrc[i] = (unsigned)(((row & ~15) + pi) * 768 + (((C.lane & 15) ^ x) * 8));
            const int d = 8 * (2 * C.wave + i) + (C.lane >> 3); vsrc[i] = (unsigned)(d * LKEYS + (((C.lane & 7) ^ ((d >> 1) & 7)) * 8)); }
#define AT_DMA_K(tt, slot) do { _Pragma("unroll") for (int i = 0; i < 2; ++i) __builtin_amdgcn_global_load_lds((const unsigned*)(Kb + (size_t)(tt) * 64 * 768 + ksrc[i]), (LAS unsigned*)(Kt + (slot) * 16384 + (2 * C.wave + i) * 1024), 16, 0, 0); } while (0)
#define AT_DMA_V(tt, slot) do { _Pragma("unroll") for (int i = 0; i < 2; ++i) __builtin_amdgcn_global_load_lds((const unsigned*)(Vb + (size_t)(tt) * 64 + vsrc[i]), (LAS unsigned*)(Vt + (slot) * 16384 + (2 * C.wave + i) * 1024), 16, 0, 0); } while (0)
#define AT_BAR() asm volatile("s_waitcnt vmcnt(0) lgkmcnt(0)\n\ts_barrier" ::: "memory")
#define AT_SB() __builtin_amdgcn_sched_barrier(0)
        const int ksw = r32 & 15, vsw = (r32 >> 1) & 7;
#define AT_QK(P0, P1, ks_) do { const float nm_ = -m; _Pragma("unroll") for (int i = 0; i < 16; ++i) { P0[i] = nm_; P1[i] = nm_; } \
            const LAS unsigned char* kbp_ = Kt + (ks_) * 16384 + r32 * 256; \
            _Pragma("unroll") for (int ks = 0; ks < 4; ++ks) { const int co_ = ((map * 8 + ks * 2 + hi) ^ ksw) * 16; \
                P0 = __builtin_amdgcn_mfma_f32_32x32x16_bf16(*(const LAS bf16x8*)(kbp_ + co_), qf[ks], P0, 0, 0, 0); P1 = __builtin_amdgcn_mfma_f32_32x32x16_bf16(*(const LAS bf16x8*)(kbp_ + 32 * 256 + co_), qf[ks], P1, 0, 0, 0); } } while (0)
#define AT_LDV(dst, vs_, d) do { _Pragma("unroll") for (int kst = 0; kst < 4; ++kst) dst[kst] = *(const LAS u32x4*)(Vt + (vs_) * 16384 + ((d) * 32 + r32) * 128 + (((kst * 2 + hi) ^ vsw) * 16)); } while (0)
#define AT_PV(src, d) do { _Pragma("unroll") for (int kst = 0; kst < 4; ++kst) O[d] = __builtin_amdgcn_mfma_f32_32x32x16_bf16(__builtin_bit_cast(bf16x8, src[kst]), pb[kst], O[d], 0, 0, 0); } while (0)
#define AT_SOFTPV(P0, P1, N0, N1, first, hasn, vs_) do { \
            asm volatile("s_nop 15\n\ts_nop 7" : "+v"(P0), "+v"(P1)); \
            float mx = max3f(P0[0], P0[1], P1[0]), mx2 = max3f(P0[2], P0[3], P1[1]); mx = max3f(mx, P1[2], P1[3]); \
            _Pragma("unroll") for (int i = 4; i < 16; i += 4) { mx = max3f(mx, P0[i], P0[i + 1]); mx2 = max3f(mx2, P0[i + 2], P0[i + 3]); mx = max3f(mx, P1[i], P1[i + 1]); mx2 = max3f(mx2, P1[i + 2], P1[i + 3]); } \
            mx = fmaxf(mx, mx2); \
            { auto rr = __builtin_amdgcn_permlane32_swap(__float_as_uint(mx), __float_as_uint(mx), false, false); mx = fmaxf(__uint_as_float(rr[0]), __uint_as_float(rr[1])); } \
            if ((first) || __any(mx > 8.f)) { const float dl = (first) ? mx : fmaxf(mx, 0.f); const float sc = __builtin_amdgcn_exp2f(-dl); lsum *= sc; \
                _Pragma("unroll") for (int d = 0; d < 4; ++d) _Pragma("unroll") for (int i = 0; i < 16; ++i) O[d][i] *= sc; \
                _Pragma("unroll") for (int i = 0; i < 16; ++i) { P0[i] -= dl; P1[i] -= dl; } \
                if (hasn) { asm volatile("s_nop 15\n\ts_nop 7" : "+v"(N0), "+v"(N1)); _Pragma("unroll") for (int i = 0; i < 16; ++i) { N0[i] -= dl; N1[i] -= dl; } } \
                m += dl; } \
            float ps = 0.f, ps2 = 0.f; \
            _Pragma("unroll") for (int i = 0; i < 16; ++i) { P0[i] = __builtin_amdgcn_exp2f(P0[i]); P1[i] = __builtin_amdgcn_exp2f(P1[i]); ps += P0[i]; ps2 += P1[i]; } \
            lsum += ps + ps2; \
            bf16x8 pb[4]; \
            { u32x4 w; w.x = pk2(P0[0], P0[1]); w.y = pk2(P0[2], P0[3]); w.z = pk2(P0[4], P0[5]); w.w = pk2(P0[6], P0[7]); pb[0] = __builtin_bit_cast(bf16x8, w); \
              w.x = pk2(P0[8], P0[9]); w.y = pk2(P0[10], P0[11]); w.z = pk2(P0[12], P0[13]); w.w = pk2(P0[14], P0[15]); pb[1] = __builtin_bit_cast(bf16x8, w); \
              w.x = pk2(P1[0], P1[1]); w.y = pk2(P1[2], P1[3]); w.z = pk2(P1[4], P1[5]); w.w = pk2(P1[6], P1[7]); pb[2] = __builtin_bit_cast(bf16x8, w); \
              w.x = pk2(P1[8], P1[9]); w.y = pk2(P1[10], P1[11]); w.z = pk2(P1[12], P1[13]); w.w = pk2(P1[14], P1[15]); pb[3] = __builtin_bit_cast(bf16x8, w); } \
            u32x4 va[4]; \
            AT_LDV(va, vs_, 0); AT_SB(); AT_PV(va, 0); AT_SB(); AT_LDV(va, vs_, 1); AT_SB(); AT_PV(va, 1); AT_SB(); AT_LDV(va, vs_, 2); AT_SB(); AT_PV(va, 2); AT_SB(); AT_LDV(va, vs_, 3); AT_SB(); AT_PV(va, 3); AT_SB(); } while (0)
        f32x16 pA0, pA1, pB0, pB1;
        AT_DMA_K(0, 0); AT_DMA_V(0, 0); AT_DMA_K(1, 1);
        AT_BAR();
        AT_QK(pA0, pA1, 0);
        asm volatile("s_waitcnt lgkmcnt(0)\n\ts_barrier" ::: "memory");
        for (int t = 0; t < NT; t += 2) {
            if (t + 2 < NT) AT_DMA_K(t + 2, 0);
            AT_DMA_V(t + 1, 1);
            AT_SB(); AT_QK(pB0, pB1, 1); AT_SB();
            AT_SOFTPV(pA0, pA1, pB0, pB1, t == 0, true, 0);
            AT_BAR();
            if (t + 3 < NT) AT_DMA_K(t + 3, 1);
            if (t + 2 < NT) AT_DMA_V(t + 2, 0);
            AT_SB(); if (t + 2 < NT) { AT_QK(pA0, pA1, 0); } AT_SB();
            AT_SOFTPV(pB0, pB1, pA0, pA1, false, t + 2 < NT, 1);
            AT_BAR();
        }
#undef AT_DMA_K
#undef AT_DMA_V
#undef AT_BAR
#undef AT_SB
#undef AT_QK
#undef AT_LDV
#undef AT_PV
#undef AT_SOFTPV
        const float ltot = lsum + __shfl_xor(lsum, 32);
        const float invl = 1.f / ltot;
        if (map == 1) { const float f = lam * invl;
#pragma unroll
            for (int d = 0; d < 4; ++d)
#pragma unroll
                for (int i = 0; i < 16; ++i) xch[(qw * 64 + d * 16 + i) * 64 + C.lane] = O[d][i] * f; }
        __syncthreads();
        if (map == 0) { float ss = 0.f;
#pragma unroll
            for (int d = 0; d < 4; ++d)
#pragma unroll
                for (int i = 0; i < 16; ++i) { const float o = O[d][i] * invl - xch[(qw * 64 + d * 16 + i) * 64 + C.lane]; O[d][i] = o; ss += o * o; }
            ss += __shfl_xor(ss, 32);
            const float rn = rsqrtf(ss * (1.f / 128.f) + RMS_EPS) * (1.f - lam_init);
            bf16_t* orow = A2 + (size_t)(qrow0 + qw * 32 + r32) * DM + h * 128;
#pragma unroll
            for (int d = 0; d < 4; ++d)
#pragma unroll
                for (int g4 = 0; g4 < 4; ++g4) { const int dd = 32 * d + 8 * g4 + 4 * hi; const f32x4 sg = *(const f32x4*)(subg + dd);
                    const f32x4 v = {O[d][4 * g4] * rn * sg[0], O[d][4 * g4 + 1] * rn * sg[1], O[d][4 * g4 + 2] * rn * sg[2], O[d][4 * g4 + 3] * rn * sg[3]};
                    st4bf(orow + dd, v); } }
        __syncthreads();
    }
}

__device__ __forceinline__ void phase_rt(const Ctx& C, const Args& A, int l) {
    unsigned char* ws = A.ws; float* X = (float*)(ws + WS_X); bf16_t* H = (bf16_t*)(ws + WS_H); float* AFF = (float*)(ws + WS_AFF);
    const float* MOD = (const float*)(ws + WS_MOD) + (size_t)l * 5 * 6144;
    const float* lng = A.in[I_LNG] + (size_t)(l * 2 + 0) * DM; const float* lnb = A.in[I_LNB] + (size_t)(l * 2 + 0) * DM;
    LAS float* wrs = (LAS float*)C.lds;
    { const float* wr = A.in[I_WR] + (size_t)l * DM * 16; for (int i = C.tid; i < DM * 16; i += NTHR) wrs[(i & 15) * 1024 + (i >> 4)] = wr[i]; }
    __syncthreads();
    for (int row = C.gw; row < MROWS; row += C.NGW) {
        const float* md = MOD + row_mi(row) * 6144;
        f32x4 x[4]; float s = 0.f;
#pragma unroll
        for (int j = 0; j < 4; ++j) { x[j] = *(const f32x4*)(X + (size_t)row * DM + 4 * C.lane + 256 * j); s += (x[j][0] + x[j][1]) + (x[j][2] + x[j][3]); }
        const float mean = wave_sum(s) * (1.f / DM); float s2 = 0.f;
#pragma unroll
        for (int j = 0; j < 4; ++j) { x[j] = x[j] - mean; s2 += (x[j][0] * x[j][0] + x[j][1] * x[j][1]) + (x[j][2] * x[j][2] + x[j][3] * x[j][3]); }
        const float rstd = rsqrtf(wave_sum(s2) * (1.f / DM) + LN_EPS);
        float v[16];
#pragma unroll
        for (int e = 0; e < 16; ++e) v[e] = 0.f;
#pragma unroll
        for (int j = 0; j < 4; ++j) { const int col = 4 * C.lane + 256 * j;
            const f32x4 x1 = x[j] * rstd * *(const f32x4*)(lng + col) + *(const f32x4*)(lnb + col);
            *(f32x4*)(X + (size_t)row * DM + col) = x1;
            const f32x4 h = x1 * (*(const f32x4*)(md + 4 * DM + col) + 1.f) + *(const f32x4*)(md + 3 * DM + col);
            st4bf(H + (size_t)row * DM + col, h);
#pragma unroll
            for (int e = 0; e < 16; ++e) { const f32x4 w = *(const LAS f32x4*)(wrs + e * 1024 + col); v[e] += (h[0] * w[0] + h[1] * w[1]) + (h[2] * w[2] + h[3] * w[3]); }
            __builtin_amdgcn_sched_barrier(0); }
#pragma unroll
        for (int i = 0; i < 8; ++i) { const float send = (C.lane & 32) ? v[i] : v[i + 8], keep = (C.lane & 32) ? v[i + 8] : v[i]; v[i] = keep + __shfl_xor(send, 32); }
#pragma unroll
        for (int i = 0; i < 4; ++i) { const float send = (C.lane & 16) ? v[i] : v[i + 4], keep = (C.lane & 16) ? v[i + 4] : v[i]; v[i] = keep + __shfl_xor(send, 16); }
#pragma unroll
        for (int i = 0; i < 2; ++i) { const float send = (C.lane & 8) ? v[i] : v[i + 2], keep = (C.lane & 8) ? v[i + 2] : v[i]; v[i] = keep + __shfl_xor(send, 8); }
        { const float send = (C.lane & 4) ? v[0] : v[1], keep = (C.lane & 4) ? v[1] : v[0]; v[0] = keep + __shfl_xor(send, 4); }
        float z = v[0]; z += __shfl_xor(z, 1); z += __shfl_xor(z, 2);
        float mx = z;
#pragma unroll
        for (int o = 4; o < 64; o <<= 1) mx = fmaxf(mx, __shfl_xor(mx, o));
        const float ex = expf(z - mx); float sm = ex;
#pragma unroll
        for (int o = 4; o < 64; o <<= 1) sm += __shfl_xor(sm, o);
        if ((C.lane & 3) == 0) AFF[(size_t)row * 16 + (C.lane >> 2)] = ex / sm;
    }
}

__device__ __forceinline__ void phase_tk(const Ctx& C, const Args& A) {
    unsigned char* ws = A.ws; const float* AFF = (const float*)(ws + WS_AFF); int* SLOT = (int*)(ws + WS_SLOT); int* IDX = (int*)(ws + WS_IDX); float* GATE = (float*)(ws + WS_GATE);
    LAS unsigned* key = (LAS unsigned*)C.lds;
    LAS unsigned* hist = key + 8192;
    LAS unsigned* scn = hist + 256;
    LAS unsigned* wtot = scn + 256;
    LAS unsigned* bc = wtot + 8;
    for (int u = blockIdx.x; u < 128; u += C.G) {
        const bool isctx = u >= 64; const int uu = u & 63, b = uu >> 4, e = uu & 15;
        const int n = isctx ? CTXL : TT, cap = isctx ? CAP_C : CAP_L;
        const int row0 = isctx ? NLAT + b * CTXL : b * TT;
        const int slot0 = e * ESLOTS + (isctx ? 4 * CAP_L + b * CAP_C : b * CAP_L);
        for (int i = C.tid; i < n; i += NTHR) key[i] = __float_as_uint(AFF[(size_t)(row0 + i) * 16 + e]);
        unsigned prefix = 0u, pmask = 0u; int need = cap;
        for (int pass = 0; pass < 4; ++pass) {
            const int shift = 24 - 8 * pass;
            if (C.tid < 256) hist[C.tid] = 0u;
            __syncthreads();
            for (int i = C.tid; i < n; i += NTHR) { const unsigned k = key[i]; if ((k & pmask) == prefix) __hip_atomic_fetch_add(&hist[(k >> shift) & 255u], 1u, __ATOMIC_RELAXED, __HIP_MEMORY_SCOPE_WORKGROUP); }
            __syncthreads();
            if (C.tid < 256) scn[C.tid] = hist[C.tid];
            __syncthreads();
            for (int off = 1; off < 256; off <<= 1) {
                unsigned a = 0u; if (C.tid < 256 && C.tid + off < 256) a = scn[C.tid + off];
                __syncthreads();
                if (C.tid < 256) scn[C.tid] += a;
                __syncthreads();
            }
            if (C.tid < 256) { const unsigned above = (C.tid < 255) ? scn[C.tid + 1] : 0u;
                if (scn[C.tid] >= (unsigned)need && above < (unsigned)need) { bc[0] = (unsigned)C.tid; bc[1] = (unsigned)need - above; } }
            __syncthreads();
            prefix |= bc[0] << shift; pmask |= 255u << shift; need = (int)bc[1];
            __syncthreads();
        }
        const int per = (n + NTHR - 1) / NTHR; const int i0 = C.tid * per;
        unsigned cg = 0u, ce = 0u;
        for (int j = 0; j < per; ++j) { const int i = i0 + j; if (i < n) { const unsigned k = key[i]; cg += (k > prefix); ce += (k == prefix); } }
        unsigned pk = cg | (ce << 16), inc = pk;
#pragma unroll
        for (int o = 1; o < 64; o <<= 1) { const unsigned t = __shfl_up(inc, o); if (C.lane >= o) inc += t; }
        if (C.lane == 63) wtot[C.wave] = inc;
        __syncthreads();
        unsigned wbase = 0u;
        for (int w = 0; w < C.wave; ++w) wbase += wtot[w];
        const unsigned excl = wbase + inc - pk;
        unsigned rg = excl & 0xffffu, re = excl >> 16;
        const int ngt = cap - need;
        for (int j = 0; j < per; ++j) { const int i = i0 + j; if (i < n) { const unsigned k = key[i]; int pos = -1;
            if (k > prefix) { pos = (int)rg; ++rg; } else if (k == prefix) { if ((int)re < need) pos = ngt + (int)re; ++re; }
            const int row = row0 + i;
            if (pos >= 0) { IDX[slot0 + pos] = row; GATE[slot0 + pos] = __uint_as_float(k); SLOT[(size_t)row * 16 + e] = slot0 + pos; }
            else SLOT[(size_t)row * 16 + e] = -1; } }
        if (isctx && b == 0 && C.tid < ESLOTS - 4224) { IDX[e * ESLOTS + 4224 + C.tid] = 0; GATE[e * ESLOTS + 4224 + C.tid] = 0.f; }
        __syncthreads();
    }
}

__device__ __forceinline__ void phase_cb(const Ctx& C, const Args& A, int l) {
    unsigned char* ws = A.ws; float* X = (float*)(ws + WS_X); bf16_t* H = (bf16_t*)(ws + WS_H); const int* SLOT = (const int*)(ws + WS_SLOT); const bf16_t* YE = (const bf16_t*)(ws + WS_YE);
    const float* MOD = (const float*)(ws + WS_MOD) + (size_t)l * 5 * 6144; const float* MODN = MOD + 5 * 6144;
    const float* lng = A.in[I_LNG] + (size_t)(l * 2 + 1) * DM; const float* lnb = A.in[I_LNB] + (size_t)(l * 2 + 1) * DM;
    for (int row = C.gw; row < MROWS; row += C.NGW) {
        const int mi = row_mi(row); const float* md = MOD + mi * 6144;
        f32x4 acc[4];
#pragma unroll
        for (int j = 0; j < 4; ++j) acc[j] = (f32x4){0.f, 0.f, 0.f, 0.f};
        for (int e = 0; e < 16; ++e) { const int s = __builtin_amdgcn_readfirstlane(SLOT[(size_t)row * 16 + e]);
            if (s >= 0) {
#pragma unroll
                for (int j = 0; j < 4; ++j) acc[j] += ld4bf(YE + (size_t)s * DM + 4 * C.lane + 256 * j); } }
        f32x4 x[4]; float sm = 0.f;
#pragma unroll
        for (int j = 0; j < 4; ++j) { const int col = 4 * C.lane + 256 * j; x[j] = *(const f32x4*)(X + (size_t)row * DM + col) * ALPHA_DN + *(const f32x4*)(md + 5 * DM + col) * acc[j];
            sm += (x[j][0] + x[j][1]) + (x[j][2] + x[j][3]); }
        const float mean = wave_sum(sm) * (1.f / DM); float s2 = 0.f;
#pragma unroll
        for (int j = 0; j < 4; ++j) { x[j] = x[j] - mean; s2 += (x[j][0] * x[j][0] + x[j][1] * x[j][1]) + (x[j][2] * x[j][2] + x[j][3] * x[j][3]); }
        const float rstd = rsqrtf(wave_sum(s2) * (1.f / DM) + LN_EPS);
#pragma unroll
        for (int j = 0; j < 4; ++j) { const int col = 4 * C.lane + 256 * j;
            const f32x4 x2 = x[j] * rstd * *(const f32x4*)(lng + col) + *(const f32x4*)(lnb + col);
            *(f32x4*)(X + (size_t)row * DM + col) = x2;
            if (l < DEPTH - 1) { const float* mn = MODN + mi * 6144; st4bf(H + (size_t)row * DM + col, x2 * (*(const f32x4*)(mn + DM + col) + 1.f) + *(const f32x4*)(mn + col)); }
            else if (row < NLAT) *(f32x4*)(A.out + (size_t)row * DM + col) = x2; }
    }
}


#ifndef GEMM_NOINLINE
#define GEMM_NOINLINE 0
#endif
#if GEMM_NOINLINE
#define GEMM_FN __device__ __noinline__
#else
#define GEMM_FN __device__ __forceinline__
#endif
GEMM_FN void gphase_in(LAS unsigned char* lds, unsigned char* ws, int nN, int G) {
    int bx = blockIdx.x; asm volatile("" : "+s"(bx), "+s"(G));
    pg8::Gemm g{(const bf16_t*)(ws + WS_H), (const bf16_t*)(ws + WS_WIN), DM}; pg8::Order<0> S; S.init(MROWS / 256, nN, G, bx, nullptr, 0);
    pg8::EpiBf16 E{(bf16_t*)(ws + WS_P), P_LD}; pg8::gemm_phase(lds, g, S, E); }
GEMM_FN void gphase_in_odd(LAS unsigned char* lds, unsigned char* ws, int G) {
    int bx = blockIdx.x; asm volatile("" : "+s"(bx), "+s"(G));
    pg8::Gemm g{(const bf16_t*)(ws + WS_H), (const bf16_t*)(ws + WS_WIN), DM}; pg8::Order<0> S; S.init(MROWS / 256, D_IN_ODD / 256, G, bx, nullptr, 0);
    pg8::EpiOdd E{(bf16_t*)(ws + WS_P), (bf16_t*)(ws + WS_Q), (bf16_t*)(ws + WS_KA), (const float*)(ws + WS_ROPE)}; pg8::gemm_phase(lds, g, S, E); }
GEMM_FN void gphase_lora(LAS unsigned char* lds, unsigned char* ws, const float* d0, const float* a0, const float* kal, int G) {
    int bx = blockIdx.x; asm volatile("" : "+s"(bx), "+s"(G));
    pg8::Gemm g{(const bf16_t*)(ws + WS_LIN), (const bf16_t*)(ws + WS_WLORA), LORA_K}; pg8::Order<0> S; S.init(MROWS / 256, LORA_N / 256, G, bx, nullptr, 0);
    pg8::EpiLora E{ws + WS_SCN, (bf16_t*)(ws + WS_G), d0, a0, kal}; pg8::gemm_phase(lds, g, S, E); }
GEMM_FN void gphase_out(LAS unsigned char* lds, unsigned char* ws, const float* modl, int G) {
    int bx = blockIdx.x; asm volatile("" : "+s"(bx), "+s"(G));
    pg8::Gemm g{(const bf16_t*)(ws + WS_A2), (const bf16_t*)(ws + WS_WOUT), DM}; pg8::Order<0> S; S.init(MROWS / 256, DM / 256, G, bx, nullptr, 0);
    pg8::EpiRes E{(float*)(ws + WS_X), modl}; pg8::gemm_phase(lds, g, S, E); }
GEMM_FN void gphase_e1(LAS unsigned char* lds, unsigned char* ws, int G, int l) {
    int bx = blockIdx.x; asm volatile("" : "+s"(bx), "+s"(G));
    pg8::Gemm g{(const bf16_t*)(ws + WS_H), (const bf16_t*)(ws + WS_WE13 + (size_t)(l & 1) * WE13_BYTES), DM}; pg8::EpiSwiGLU E{(bf16_t*)(ws + WS_HID)};
    pg8::OrderExp<1> S; S.init(4096 / 256, G, bx, (const int*)(ws + WS_IDX), (long)4096 * DM); pg8::gemm_phase(lds, g, S, E); }
GEMM_FN void gphase_e2(LAS unsigned char* lds, unsigned char* ws, int G, int l) {
    int bx = blockIdx.x; asm volatile("" : "+s"(bx), "+s"(G));
    pg8::Gemm g{(const bf16_t*)(ws + WS_HID), (const bf16_t*)(ws + WS_WE2 + (size_t)(l & 1) * WE2_BYTES), D_EXP}; pg8::EpiYE E{(bf16_t*)(ws + WS_YE), (const float*)(ws + WS_GATE)};
    pg8::OrderExp<2> S; S.init(DM / 256, G, bx, nullptr, (long)DM * D_EXP); pg8::gemm_phase(lds, g, S, E); }

constexpr int NSLOT = 13;
constexpr int NSTEP = 1 + DEPTH * NSLOT;
__global__ void __launch_bounds__(NTHR, 2) mk_fwd(Args KA) {
    extern __shared__ __attribute__((aligned(16))) unsigned char lds_raw[];
    volatile LAS unsigned* MISC = (volatile LAS unsigned*)((LAS unsigned char*)lds_raw + LDS_MISC);
    if (threadIdx.x < 16) MISC[threadIdx.x] = 0u;
    if (threadIdx.x == 0) { LAS unsigned long long* tb = (LAS unsigned long long*)((LAS unsigned char*)lds_raw + LDS_PTAB);
#pragma unroll
        for (int i = 0; i < 37; ++i) tb[i] = (unsigned long long)KA.in[i];
        tb[37] = (unsigned long long)KA.out; tb[38] = (unsigned long long)KA.ws; }
    __syncthreads();
    const int lo = KA.lo, hi = KA.hi;
    unsigned bar_x = 0;
    if (hi - lo > 1) { const XcdBarrier b0 = xcd_barrier_post((unsigned*)(KA.ws + WS_CTL), MISC); bar_x = b0.x; }
#ifndef PH_MASK
#define PH_MASK 0xFFFFFF
#endif
#ifndef REP_MASK
#define REP_MASK 0
#endif
#define PH_BIT(k) (((k) == 0) ? 0 : 1 + ((k) - 1) % NSLOT + (((k) - 1) % NSLOT >= 2 && ((k) - 1) % NSLOT <= 3 && odd ? 12 : 0))
#define RUN(k, ...) do { if (((PH_MASK >> PH_BIT(k)) & 1) && lo <= (k) && (k) < hi) { const int nrep = ((REP_MASK >> PH_BIT(k)) & 1) ? 2 : 1; \
        _Pragma("unroll 1") for (int rep = 0; rep < nrep; ++rep) { \
        Ctx C; mkctx(C, (LAS unsigned char*)lds_raw); Args A; ldargs(A, (LAS unsigned char*)lds_raw); unsigned char* ws = A.ws; \
        const float* MODL = (const float*)(ws + WS_MOD) + (size_t)l * 5 * 6144; (void)MODL; \
        __VA_ARGS__; if ((k) + 1 < hi || rep + 1 < nrep) { XcdBarrier bar; bar.bar = (unsigned*)(ws + WS_CTL); bar.x = bar_x; bar.st = MISC; xcd_barrier(bar); } } } } while (0)
    { const bool odd = false; const int l = 0; RUN(0, { phase_init(C, A); __syncthreads(); conv_items(C, A, 0, C.gw, C.NGW, true, true, true); }); }
#pragma unroll 1
    for (int l = 0; l < DEPTH; ++l) {
        const int sb = 1 + l * NSLOT; const bool odd = l & 1;
        if (!(CHUNKED_SCAN && odd)) { RUN(sb + 0, { phase_conv(C, A, l); if (l == 0) phase_modh(C, A, 0); }); }
        if (odd) { RUN(sb + 1, gphase_in_odd(C.lds, ws, C.G)); } else { RUN(sb + 1, gphase_in(C.lds, ws, D_IN_EVEN_PAD / 256, C.G)); }
        if (!odd) {
            RUN(sb + 2, phase_ef1(C, A, l));
            RUN(sb + 3, { const int i2 = l >> 1; gphase_lora(C.lds, ws, A.in[I_D0] + (size_t)i2 * 2 * 768, A.in[I_A0] + (size_t)i2 * 2 * 768, A.in[I_KAL] + (size_t)i2 * 768, C.G); });
#if CHUNKED_SCAN
            RUN(sb + 4, phase_csa(C, A));
            RUN(sb + 5, phase_csb(C, A, l));
#else
            RUN(sb + 4, phase_scan(C, A));
#endif
            RUN(sb + 6, phase_ef2(C, A, l));
        } else {
            RUN(sb + 2, phase_of1(C, A, l));
            RUN(sb + 3, phase_attn(C, A, l));
        }
        RUN(sb + 7, gphase_out(C.lds, ws, MODL, C.G));
        RUN(sb + 8, phase_rt(C, A, l));
        RUN(sb + 9, phase_tk(C, A));
        RUN(sb + 10, gphase_e1(C.lds, ws, C.G, l));
        RUN(sb + 11, gphase_e2(C.lds, ws, C.G, l));
        RUN(sb + 12, { phase_cb(C, A, l); if (CHUNKED_SCAN && !odd && l + 1 < DEPTH) { __syncthreads(); conv_items(C, A, l + 1, C.gw, C.NGW, false, true, false); } });
    }
#undef RUN
}

#ifdef PHASE_PROBE
#define PROBE_PRE extern __shared__ __attribute__((aligned(16))) unsigned char lds_raw[]; Ctx C; mkctx(C, (LAS unsigned char*)lds_raw); unsigned char* ws = A.ws; (void)ws;
__global__ void __launch_bounds__(NTHR, 2) pr_init(Args A) { PROBE_PRE phase_init(C, A); }
__global__ void __launch_bounds__(NTHR, 2) pr_conv(Args A) { PROBE_PRE phase_conv(C, A, A.lo); }
__global__ void __launch_bounds__(NTHR, 2) pr_modh(Args A) { PROBE_PRE phase_modh(C, A, A.lo); }
__global__ void __launch_bounds__(NTHR, 2) pr_ef1(Args A) { PROBE_PRE phase_ef1(C, A, A.lo); }
__global__ void __launch_bounds__(NTHR, 2) pr_scan(Args A) { PROBE_PRE phase_scan(C, A); }
__global__ void __launch_bounds__(NTHR, 2) pr_ef2(Args A) { PROBE_PRE phase_ef2(C, A, A.lo); }
__global__ void __launch_bounds__(NTHR, 2) pr_csa(Args A) { PROBE_PRE phase_csa(C, A); }
__global__ void __launch_bounds__(NTHR, 2) pr_csb(Args A) { PROBE_PRE phase_csb(C, A, A.lo); }
__global__ void __launch_bounds__(NTHR, 2) pr_of1(Args A) { PROBE_PRE phase_of1(C, A, A.lo); }
__global__ void __launch_bounds__(NTHR, 2) pr_attn(Args A) { PROBE_PRE phase_attn(C, A, A.lo); }
__global__ void __launch_bounds__(NTHR, 2) pr_rt(Args A) { PROBE_PRE phase_rt(C, A, A.lo); }
__global__ void __launch_bounds__(NTHR, 2) pr_tk(Args A) { PROBE_PRE phase_tk(C, A); }
__global__ void __launch_bounds__(NTHR, 2) pr_cb(Args A) { PROBE_PRE phase_cb(C, A, A.lo); }
__global__ void __launch_bounds__(NTHR, 2) pr_gemm_in(Args A) { PROBE_PRE pg8::Gemm g{(const bf16_t*)(ws + WS_H), (const bf16_t*)(ws + WS_WIN), DM}; pg8::Order<0> S; S.init(MROWS / 256, A.lo, C.G, (int)blockIdx.x, nullptr, 0);
                      pg8::EpiBf16 E{(bf16_t*)(ws + WS_P), P_LD}; pg8::gemm_phase(C.lds, g, S, E); }
__global__ void __launch_bounds__(NTHR, 2) pr_gemm_lora(Args A) { PROBE_PRE pg8::Gemm g{(const bf16_t*)(ws + WS_LIN), (const bf16_t*)(ws + WS_WLORA), LORA_K}; pg8::Order<0> S; S.init(MROWS / 256, LORA_N / 256, C.G, (int)blockIdx.x, nullptr, 0);
                          const int i2 = A.lo; pg8::EpiLora E{ws + WS_SCN, (bf16_t*)(ws + WS_G), A.in[I_D0] + (size_t)i2 * 2 * 768, A.in[I_A0] + (size_t)i2 * 2 * 768, A.in[I_KAL] + (size_t)i2 * 768};
                          pg8::gemm_phase(C.lds, g, S, E); }
__global__ void __launch_bounds__(NTHR, 2) pr_gemm_out(Args A) { PROBE_PRE pg8::Gemm g{(const bf16_t*)(ws + WS_A2), (const bf16_t*)(ws + WS_WOUT), DM}; pg8::Order<0> S; S.init(MROWS / 256, DM / 256, C.G, (int)blockIdx.x, nullptr, 0);
                      pg8::EpiRes E{(float*)(ws + WS_X), (const float*)(ws + WS_MOD)}; pg8::gemm_phase(C.lds, g, S, E); }
__global__ void __launch_bounds__(NTHR, 2) pr_gemm_e1(Args A) { PROBE_PRE pg8::Gemm g{(const bf16_t*)(ws + WS_H), (const bf16_t*)(ws + WS_WE13), DM}; pg8::Order<1> S; S.init(NEXP * 17, 4096 / 256, C.G, (int)blockIdx.x, (const int*)(ws + WS_IDX), (long)4096 * DM);
                      pg8::EpiSwiGLU E{(bf16_t*)(ws + WS_HID)}; pg8::gemm_phase(C.lds, g, S, E); }
__global__ void __launch_bounds__(NTHR, 2) pr_gemm_e2(Args A) { PROBE_PRE pg8::Gemm g{(const bf16_t*)(ws + WS_HID), (const bf16_t*)(ws + WS_WE2), D_EXP}; pg8::Order<2> S; S.init(NEXP * 17, DM / 256, C.G, (int)blockIdx.x, nullptr, (long)DM * D_EXP);
                       pg8::EpiYE E{(bf16_t*)(ws + WS_YE), (const float*)(ws + WS_GATE)}; pg8::gemm_phase(C.lds, g, S, E); }
#endif

extern "C" void kernel_launch(void* const* d_in, const int* in_sizes, int n_in, void* d_out, int out_size, void* d_ws, size_t ws_size, hipStream_t stream) {
    static int grid = 0;
    if (grid == 0) {
        if (n_in != 37 || out_size != NLAT * DM || ws_size < WS_END) { fprintf(stderr, "kernel_launch: unexpected shapes: n_in %d out %d ws %zu (need %zu)\n", n_in, out_size, ws_size, (size_t)WS_END); grid = -1; return; }
        int dev = 0, cus = 0, per_cu = 0;
        if (hipGetDevice(&dev) != hipSuccess || hipDeviceGetAttribute(&cus, hipDeviceAttributeMultiprocessorCount, dev) != hipSuccess) { grid = -1; return; }
        if (hipFuncSetAttribute((const void*)mk_fwd, hipFuncAttributeMaxDynamicSharedMemorySize, LDS_BYTES) != hipSuccess) { fprintf(stderr, "kernel_launch: hipFuncSetAttribute failed\n"); grid = -1; return; }
        if (hipOccupancyMaxActiveBlocksPerMultiprocessor(&per_cu, (const void*)mk_fwd, NTHR, LDS_BYTES) != hipSuccess || per_cu < 1) fprintf(stderr, "kernel_launch: occupancy query reports %d\n", per_cu);
        (void)hipGetLastError();
        grid = cus;
    }
    if (grid < 0) return;
    (void)hipMemsetAsync((char*)d_ws + WS_CTL, 0, CTL_BYTES, stream);
    Args a{};
    for (int i = 0; i < 37; ++i) a.in[i] = (const float*)d_in[i];
    a.out = (float*)d_out; a.ws = (unsigned char*)d_ws;
#if MK_MULTI
    for (int k = 0; k < NSTEP; ++k) {
        if (k >= 1) { const int l = (k - 1) / NSLOT, s = (k - 1) % NSLOT; if ((l & 1) && ((s >= 4 && s <= 6) || (CHUNKED_SCAN && s == 0))) continue; if (!(l & 1) && !CHUNKED_SCAN && s == 5) continue; }
        a.lo = k; a.hi = k + 1;
        hipLaunchKernelGGL(mk_fwd, dim3(grid), dim3(NTHR), LDS_BYTES, stream, a);
    }
#else
    a.lo = 0; a.hi = NSTEP;
    hipLaunchKernelGGL(mk_fwd, dim3(grid), dim3(NTHR), LDS_BYTES, stream, a);
#endif
    const hipError_t le = hipPeekAtLastError();
    if (le != hipSuccess) fprintf(stderr, "kernel_launch: launch failed: %s\n", hipGetErrorName(le));
}
```

```cpp
#include <hip/hip_runtime.h>
#include <cstdio>
#include <cstdint>
#include <cmath>

#ifndef MK_MULTI
#define MK_MULTI 0
#endif
#ifndef CHUNKED_SCAN
#define CHUNKED_SCAN 1
#endif

#define GAS __attribute__((address_space(1)))
#define LAS __attribute__((address_space(3)))
typedef unsigned short bf16_t;
typedef short bf16x8 __attribute__((ext_vector_type(8)));
typedef float f32x4 __attribute__((ext_vector_type(4)));
typedef float f32x2 __attribute__((ext_vector_type(2)));
typedef float f32x16 __attribute__((ext_vector_type(16)));
typedef unsigned u32x4 __attribute__((ext_vector_type(4)));
typedef unsigned u32x2 __attribute__((ext_vector_type(2)));
typedef __bf16 bf16x2_t __attribute__((ext_vector_type(2)));

constexpr int NB = 4, TT = 8192, DM = 1024, NLAT = NB * TT, CTXL = 256, NCTX = NB * CTXL, MROWS = NLAT + NCTX;
constexpr int DEPTH = 4;
constexpr int D_CONV = 256, RW_H = 12, RW_K = 64, D_RWKV = 768, RWKV_COLS = 2688, D_IN_EVEN = 3456, D_IN_EVEN_PAD = 3584;
constexpr int D_DIFF = 768, D_GMLP = 256, D_IN_ODD = 2816;
constexpr int NEXP = 16, D_EXP = 2048, CAP_L = 1024, CAP_C = 32, ESLOTS = 4352;
constexpr int P_LD = 3584;
constexpr int LORA_K = 384, LORA_N = 3840;
constexpr int LKEYS = CTXL + TT;
constexpr float ALPHA_DN = 1.6817928305074290f;
constexpr float DECAY_SCALE = 0.6065306597126334f;
constexpr float GN_EPS = 64e-5f, LN_EPS = 1e-5f, RMS_EPS = 1e-5f;
constexpr float QSCALE = 0.125f * 1.4426950408889634f;

constexpr size_t al256(size_t x) { return (x + 255) & ~(size_t)255; }
constexpr size_t WS_CTL = 0;
constexpr size_t CTL_BYTES = 65536;
constexpr size_t WS_MOD = WS_CTL + CTL_BYTES;
constexpr size_t WS_ROPE = WS_MOD + al256((size_t)DEPTH * 5 * 6144 * 4);
constexpr size_t WS_WIN = WS_ROPE + 32768;
constexpr size_t WS_WOUT = WS_WIN + (size_t)D_IN_EVEN_PAD * DM * 2;
constexpr size_t WS_WLORA = WS_WOUT + (size_t)DM * DM * 2;
constexpr size_t WS_WE13 = WS_WLORA + (size_t)LORA_N * LORA_K * 2;
constexpr size_t WE13_BYTES = (size_t)NEXP * 4096 * DM * 2, WE2_BYTES = (size_t)NEXP * DM * D_EXP * 2;
constexpr size_t WS_WE2 = WS_WE13 + 2 * WE13_BYTES;
constexpr size_t WS_X = WS_WE2 + 2 * WE2_BYTES;
constexpr size_t WS_H = WS_X + (size_t)MROWS * DM * 4;
constexpr size_t WS_A2 = WS_H + (size_t)MROWS * DM * 2;
constexpr size_t WS_P = WS_A2 + (size_t)MROWS * DM * 2;
constexpr size_t WS_AFF = WS_P + (size_t)MROWS * P_LD * 2;
constexpr size_t WS_SLOT = WS_AFF + (size_t)MROWS * 16 * 4;
constexpr size_t WS_IDX = WS_SLOT + (size_t)MROWS * 16 * 4;
constexpr size_t WS_GATE = WS_IDX + al256((size_t)NEXP * ESLOTS * 4);
constexpr size_t WS_R2 = WS_GATE + al256((size_t)NEXP * ESLOTS * 4);
constexpr int SC_REC = 1408, SC_ROW = 12 * SC_REC, SC_W = 0, SC_R = 512, SC_KK = 640, SC_V = 768, SC_B = 896, SC_KR = 1024;
constexpr size_t WS_SCN = WS_R2;
constexpr size_t WS_G = WS_SCN + (size_t)MROWS * SC_ROW;
constexpr size_t WS_LIN = WS_G + (size_t)MROWS * 768 * 2;
constexpr int CS_L = 64, CS_NCH = LKEYS / CS_L, CS_UNITS = NB * RW_H * 2;
constexpr size_t WS_CHK = WS_LIN + (size_t)MROWS * 384 * 2;
constexpr size_t WS_EVEN_END = WS_CHK + (size_t)CS_UNITS * CS_NCH * 32768;
constexpr size_t WS_Y = WS_P;
constexpr size_t WS_Q = WS_R2;
constexpr size_t WS_KA = WS_Q + (size_t)MROWS * 768 * 2;
constexpr size_t WS_VT = WS_KA + (size_t)NB * LKEYS * 768 * 2;
constexpr size_t WS_HID = WS_R2;
constexpr size_t WS_YE = WS_HID + (size_t)NEXP * ESLOTS * D_EXP * 2;
constexpr size_t WS_END = WS_EVEN_END;
static_assert(WS_END <= (size_t)2147483648ull, "workspace over 2 GiB");
static_assert((size_t)2 * MROWS * 768 * 4 <= (size_t)MROWS * P_LD * 2, "Y aliases P");
static_assert(WS_YE + (size_t)NEXP * ESLOTS * DM * 2 <= WS_END, "moe region");

constexpr int LDS_BYTES = 147456;
constexpr int LDS_MISC = 140 * 1024;
constexpr int LDS_PTAB = LDS_MISC + 256;
constexpr int NWAVES = 8, NTHR = 512;

__device__ __forceinline__ unsigned f2bf(float f) { unsigned u = __float_as_uint(f); return (u + 0x7fffu + ((u >> 16) & 1u)) >> 16; }
__device__ __forceinline__ unsigned pk2(float lo, float hi) { f32x2 v = {lo, hi}; bf16x2_t b = __builtin_convertvector(v, bf16x2_t); return __builtin_bit_cast(unsigned, b); }
__device__ __forceinline__ float bflo(unsigned u) { return __uint_as_float(u << 16); }
__device__ __forceinline__ float bfhi(unsigned u) { return __uint_as_float(u & 0xffff0000u); }
__device__ __forceinline__ float bf2f(bf16_t b) { return __uint_as_float((unsigned)b << 16); }
__device__ __forceinline__ float sigmoidf_(float x) { return 1.f / (1.f + __expf(-x)); }
__device__ __forceinline__ float wave_sum(float v) {
#pragma unroll
    for (int o = 1; o < 64; o <<= 1) v += __shfl_xor(v, o);
    return v;
}
__device__ __forceinline__ float sum16(float v) {
#pragma unroll
    for (int o = 1; o < 16; o <<= 1) v += __shfl_xor(v, o);
    return v;
}
__device__ __forceinline__ f32x4 ld4bf_(const void* p) { const u32x2 u = *(const u32x2*)p; return (f32x4){bflo(u.x), bfhi(u.x), bflo(u.y), bfhi(u.y)}; }
__device__ __forceinline__ void st4bf_(void* p, f32x4 v) { u32x2 o; o.x = pk2(v[0], v[1]); o.y = pk2(v[2], v[3]); *(u32x2*)p = o; }
__device__ __forceinline__ float max3f(float a, float b, float c) { float r; asm("v_max3_f32 %0, %1, %2, %3" : "=v"(r) : "v"(a), "v"(b), "v"(c)); return r; }
__device__ __forceinline__ int crow(int r, int hi) { return (r & 3) + 8 * (r >> 2) + 4 * hi; }
__device__ __forceinline__ float gelu_erf(float x) { return 0.5f * x * (1.f + erff(x * 0.70710678118654752f)); }

#define XB_TMO      128
#define XB_XCNT(j)  (256  + 64 * (j))
#define XB_XSUB(j)  (1280 + 64 * (j))
#define XB_XGEN(j)  (2304 + 64 * (j))
#define XB_TOP      3328
#define XB_TOPGEN   3392
#define XCD_BAR_WORDS 3456
#define XB_SPIN_CAP (1u << 20)

__device__ __forceinline__ unsigned xb_ld(unsigned* p)              { return __hip_atomic_load(p, __ATOMIC_RELAXED, __HIP_MEMORY_SCOPE_AGENT); }
__device__ __forceinline__ unsigned xb_add(unsigned* p, unsigned v) { return __hip_atomic_fetch_add(p, v, __ATOMIC_RELAXED, __HIP_MEMORY_SCOPE_AGENT); }
__device__ __forceinline__ unsigned xb_xcc_id() { return (unsigned)__builtin_amdgcn_s_getreg((3 << 11) | 20) & 0xFu; }
#define XB_SPIN(cond, bar) do { unsigned _sp = 0; while (cond) { __builtin_amdgcn_s_sleep(1); \
    if ((++_sp & 255u) == 0u) { if (xb_ld(&(bar)[XB_TMO])) break; if (_sp > XB_SPIN_CAP) { atomicAdd(&(bar)[XB_TMO], 1u); break; } } } } while (0)

struct XcdBarrier { unsigned* bar; unsigned x; volatile LAS unsigned* st; };

__device__ __forceinline__ XcdBarrier xcd_barrier_post(unsigned* bar, volatile LAS unsigned* st) {
    XcdBarrier b; b.bar = bar; b.x = xb_xcc_id(); b.st = st;
    if (threadIdx.x == 0) (void)xb_add(&bar[XB_XCNT(b.x)], 1u);
    return b;
}
__device__ __forceinline__ void xcd_barrier_complete(unsigned* bar, unsigned x, unsigned& nloc, unsigned& nx) {
    const unsigned G = gridDim.x * gridDim.y * gridDim.z;
    unsigned sum, cnt, mine, sp = 0u;
    for (;;) {
        sum = 0u; cnt = 0u; mine = 0u;
#pragma unroll
        for (unsigned j = 0; j < 16; ++j) { const unsigned c = xb_ld(&bar[XB_XCNT(j)]); sum += c; cnt += (c > 0u) ? 1u : 0u; mine = (j == x) ? c : mine; }
        if (sum == G) break;
        __builtin_amdgcn_s_sleep(1);
        if ((++sp & 255u) == 0u) { if (xb_ld(&bar[XB_TMO])) break; if (sp > XB_SPIN_CAP) { atomicAdd(&bar[XB_TMO], 1u); break; } }
    }
    nloc = mine > 0u ? mine : 1u; nx = cnt > 0u ? cnt : 1u;
}
__device__ __forceinline__ void xcd_barrier(const XcdBarrier& b) {
    asm volatile("s_waitcnt vmcnt(0)" ::: "memory");
    __syncthreads();
    if (threadIdx.x == 0) {
        unsigned* bar = b.bar;
        __builtin_amdgcn_s_waitcnt(0);
        unsigned nloc = b.st[0], nx = b.st[1];
        if (nloc == 0u) { xcd_barrier_complete(bar, b.x, nloc, nx); b.st[0] = nloc; b.st[1] = nx; }
        const unsigned old = xb_add(&bar[XB_XSUB(b.x)], 1u);
        const unsigned gen = old / nloc;
        if (old + 1u == (gen + 1u) * nloc) {
            __builtin_amdgcn_fence(__ATOMIC_RELEASE, "agent");
            asm volatile("s_waitcnt vmcnt(0)" ::: "memory");
            const unsigned og = xb_add(&bar[XB_TOP], 1u);
            const unsigned tg = og / nx;
            if (og + 1u == (tg + 1u) * nx) xb_add(&bar[XB_TOPGEN], 1u);
            else XB_SPIN(xb_ld(&bar[XB_TOPGEN]) == tg, bar);
            __builtin_amdgcn_fence(__ATOMIC_ACQUIRE, "agent");
            xb_add(&bar[XB_XGEN(b.x)], 1u);
            asm volatile("s_waitcnt vmcnt(0)" ::: "memory");
        } else {
            XB_SPIN(xb_ld(&bar[XB_XGEN(b.x)]) == gen, bar);
            __builtin_amdgcn_fence(__ATOMIC_ACQUIRE, "agent");
            asm volatile("s_waitcnt vmcnt(0)" ::: "memory");
        }
    }
    __syncthreads();
}

namespace pg8 {
constexpr int BM = 256, BK = 64, HALF = 128, HTB = HALF * BK * 2, STAGE_BYTES = 8 * HTB, NXCD = 8, WGM = 8;
__host__ __device__ __forceinline__ int lds_byte(int r, int c) { const int st = (r >> 4) * 2 + (c >> 5), rr = r & 15, cc = c & 31, ob = rr * 64 + cc * 2; return st * 1024 + (ob ^ (((ob >> 9) & 1) << 5)); }
__host__ __device__ __forceinline__ void stage_rc(int b, int& R, int& C) { const int st = b / 1024, sb = b % 1024, swz = sb ^ (((sb >> 9) & 1) << 5); R = (st >> 1) * 16 + swz / 64; C = (st & 1) * 32 + (swz % 64) / 2; }

struct Unit { int pm, pn, hf; };
struct Gemm { const bf16_t* A; const bf16_t* Bt; int K; };

template <int MODE> struct Order {
    static constexpr bool GATHER = (MODE == 1);
    int nM, nN, nwg, G, c; const int* idx; long bstride;
    __device__ __forceinline__ void init(int nM_, int nN_, int G_, int c_, const int* idx_, long bstride_) { nM = nM_; nN = nN_; nwg = nM * nN; G = G_; c = c_; idx = idx_; bstride = bstride_; }
    __device__ __forceinline__ bool next(int i, Unit& u) const {
        const long L = (long)i * G + c; if (L >= nwg) return false;
        int wgid = (int)L; { const int q = nwg / NXCD, r = nwg % NXCD, xcd = wgid % NXCD, off = wgid / NXCD; wgid = (xcd < r ? xcd * (q + 1) : r * (q + 1) + (xcd - r) * q) + off; }
        const int nig = WGM * nN, gid = wgid / nig, fm = gid * WGM, gsz = (nM - fm) < WGM ? (nM - fm) : WGM;
        u.pm = fm + ((wgid % nig) % gsz); u.pn = (wgid % nig) / gsz; u.hf = (MODE != 0 && (u.pm % 17) == 16) ? 1 : 0; return true;
    }
    __device__ __forceinline__ unsigned arow(const Unit& u, int r) const { if (MODE == 1) return (unsigned)idx[u.pm * BM + r]; return (unsigned)(u.pm * BM + r); }
    __device__ __forceinline__ long bbase(const Unit& u, int K) const { long o = (long)u.pn * BM * K; if (MODE != 0) o += (long)(u.pm / 17) * bstride; return o; }
};

template <int MODE> struct OrderExp {
    static constexpr bool GATHER = (MODE == 1);
    int nN, G, c0; const int* idx; long bstride;
    __device__ __forceinline__ void init(int nN_, int G_, int c_, const int* idx_, long bstride_) { nN = nN_; G = G_; c0 = c_; idx = idx_; bstride = bstride_; }
    __device__ __forceinline__ bool next(int i0, Unit& u) const {
        const int v = i0 * G + c0, i = v >> 8, c = v & 255;
        const int x = c & 7, slot = c >> 3, per = 32 / nN, nfull = 256 / (8 * per);
        if (i > nfull) return false;
        if (i < nfull) { u.pn = slot / per; const int f = (i * 8 + x) * per + (slot % per); u.pm = (f >> 4) * 17 + (f & 15); u.hf = 0; return true; }
        if (i == nfull && slot < 2 * nN) { u.pn = slot >> 1; u.pm = (x * 2 + (slot & 1)) * 17 + 16; u.hf = 1; return true; }
        return false;
    }
    __device__ __forceinline__ unsigned arow(const Unit& u, int r) const { if (MODE == 1) return (unsigned)idx[u.pm * BM + r]; return (unsigned)(u.pm * BM + r); }
    __device__ __forceinline__ long bbase(const Unit& u, int K) const { return (long)u.pn * BM * K + (long)(u.pm / 17) * bstride; }
};

template <class Epi, class Sched>
__device__ __forceinline__ void gemm_phase(LAS unsigned char* lds, const Gemm g, const Sched& S, const Epi& E) {
    int tid = threadIdx.x; asm volatile("" : "+v"(tid));
    const int wid = __builtin_amdgcn_readfirstlane(tid >> 6), wr = wid >> 2, wc = wid & 3;
    const int K = g.K, nt = K / BK;
    unsigned voffB[2];
    { const int lane = tid & 63, fr = lane & 15, fq = lane >> 4; (void)fr; (void)fq; }
#pragma unroll
    for (int i = 0; i < 2; ++i) { int R, Cc; stage_rc(tid * 16 + i * 8192, R, Cc); voffB[i] = (unsigned)(R * K + Cc) * 2u; }
    const size_t kstep = (size_t)(BK * 2);
    const size_t hstep = (size_t)HALF * K * 2;
    const unsigned ldsw = (unsigned)wid * 1024u;
    const int aoff = lds_byte(wr * 64 + (tid & 15), ((tid & 63) >> 4) * 8), boff = lds_byte(wc * 32 + (tid & 15), ((tid & 63) >> 4) * 8);
#define PG8_SA(b, h) (((b) * 2 + (h)) * HTB)
#define PG8_SB(b, h) ((4 + (b) * 2 + (h)) * HTB)
#define PG8_STAGE(bufoff, gbase, voff) do { _Pragma("unroll") for (int _i = 0; _i < 2; ++_i) \
        __builtin_amdgcn_global_load_lds((const unsigned*)((const char*)(gbase) + (voff)[_i]), (LAS unsigned*)(lds + (bufoff) + ldsw + _i * 8192), 16, 0, 0); } while (0)
#define PG8_LDA(dst, b, h) do { _Pragma("unroll") for (int m = 0; m < 4; ++m) _Pragma("unroll") for (int k = 0; k < 2; ++k) dst[m][k] = *(const LAS bf16x8*)(lds + PG8_SA(b, h) + aoff + m * 2048 + k * 1024); } while (0)
#define PG8_LDB(dst, b, h) do { _Pragma("unroll") for (int n = 0; n < 2; ++n) _Pragma("unroll") for (int k = 0; k < 2; ++k) dst[n][k] = *(const LAS bf16x8*)(lds + PG8_SB(b, h) + boff + n * 2048 + k * 1024); } while (0)
#define PG8_MMA(ai, bj, At, Bt) do { __builtin_amdgcn_s_setprio(1); _Pragma("unroll") for (int m = 0; m < 4; ++m) _Pragma("unroll") for (int n = 0; n < 2; ++n) _Pragma("unroll") for (int k = 0; k < 2; ++k) \
        acc[ai][bj][m][n] = __builtin_amdgcn_mfma_f32_16x16x32_bf16(Bt[n][k], At[m][k], acc[ai][bj][m][n], 0, 0, 0); __builtin_amdgcn_s_setprio(0); } while (0)
#define PG8_WAIT_V(n) asm volatile("s_waitcnt vmcnt(" #n ")" ::: "memory")
#define PG8_WAIT_L(n) asm volatile("s_waitcnt lgkmcnt(" #n ")" ::: "memory")
#define PG8_BAR __builtin_amdgcn_s_barrier()
#define PG8_SCHED __builtin_amdgcn_sched_barrier(0)
#define PG8_ROWOFFS(dst, u, tq) do { _Pragma("unroll") for (int _i = 0; _i < 2; ++_i) { int _R, _C; stage_rc((tq) * 16 + _i * 8192, _R, _C); _Pragma("unroll") for (int _h = 0; _h < 2; ++_h) dst[_h][_i] = (S.arow(u, _h * HALF + _R) * (unsigned)K + (unsigned)_C) * 2u; } } while (0)
    Unit cur, nxt; int ui = 0;
    if (!S.next(0, cur)) return;
    float zf = 0.f; asm volatile("" : "+v"(zf));
    f32x4 acc[2][2][4][2];
#pragma unroll
    for (int a = 0; a < 2; ++a)
#pragma unroll
        for (int b = 0; b < 2; ++b)
#pragma unroll
            for (int m = 0; m < 4; ++m)
#pragma unroll
                for (int n = 0; n < 2; ++n) acc[a][b][m][n] = (f32x4){zf, zf, zf, zf};
    bf16x8 At[4][2], B0[2][2], B1[2][2];
    unsigned vcur[2][2];
    if constexpr (Sched::GATHER) { PG8_ROWOFFS(vcur, cur, tid); }
    const char* const Ab = (const char*)g.A;
    const char* cA = Sched::GATHER ? Ab : Ab + (size_t)(unsigned)__builtin_amdgcn_readfirstlane((int)S.arow(cur, 0)) * K * 2;
#define PG8_STAGEA(bufoff, ptr, h) do { if constexpr (Sched::GATHER) { PG8_STAGE(bufoff, ptr, vcur[h]); } else { PG8_STAGE(bufoff, (ptr) + (h) * hstep, voffB); } } while (0)
    const char* cB = (const char*)g.Bt + (size_t)S.bbase(cur, K) * 2;
    PG8_STAGE(PG8_SB(0, 0), cB, voffB); PG8_STAGE(PG8_SB(0, 1), cB + hstep, voffB); PG8_STAGEA(PG8_SA(0, 0), cA, 0); PG8_STAGEA(PG8_SA(0, 1), cA, 1);
    if (wr == 1) PG8_BAR;
    PG8_WAIT_V(2); PG8_BAR;
    PG8_STAGE(PG8_SB(1, 0), cB + kstep, voffB); PG8_STAGEA(PG8_SA(1, 0), cA + kstep, 0); PG8_STAGE(PG8_SB(1, 1), cB + hstep + kstep, voffB);
    PG8_WAIT_V(6); PG8_BAR;
    for (;;) {
        const bool has_next = S.next(ui + 1, nxt);
        const char* nB = has_next ? (const char*)g.Bt + (size_t)S.bbase(nxt, K) * 2 : cB;
        const char* nA = (Sched::GATHER || !has_next) ? cA : Ab + (size_t)(unsigned)__builtin_amdgcn_readfirstlane((int)S.arow(nxt, 0)) * K * 2;
#pragma unroll 1
        for (int t = 0; t < nt; t += 2) {
            const bool last = (t == nt - 2);
            const char* a1 = cA + (size_t)(t + 1) * kstep;
            const char* a2 = last ? nA : cA + (size_t)(t + 2) * kstep; const char* b2 = last ? nB : cB + (size_t)(t + 2) * kstep;
            const char* a3 = a2 + kstep; const char* b3 = b2 + kstep;
            PG8_LDB(B0, 0, 0); PG8_LDB(B1, 0, 1); PG8_SCHED; PG8_LDA(At, 0, 0); PG8_STAGEA(PG8_SA(1, 1), a1, 1);
            PG8_WAIT_V(8); PG8_WAIT_L(0); PG8_BAR; PG8_MMA(0, 0, At, B0); PG8_MMA(0, 1, At, B1); PG8_BAR; PG8_SCHED;
            if constexpr (Sched::GATHER) { if (last && has_next) { int tq = tid; asm volatile("" : "+v"(tq)); PG8_ROWOFFS(vcur, nxt, tq); } }
            PG8_LDA(At, 0, 1); PG8_STAGE(PG8_SB(0, 0), b2, voffB); PG8_STAGE(PG8_SB(0, 1), b2 + hstep, voffB); PG8_STAGEA(PG8_SA(0, 0), a2, 0);
            PG8_WAIT_V(8); PG8_WAIT_L(0); PG8_BAR; if (!cur.hf) { PG8_MMA(1, 0, At, B0); PG8_MMA(1, 1, At, B1); } PG8_BAR; PG8_SCHED;
            PG8_LDB(B0, 1, 0); PG8_LDB(B1, 1, 1); PG8_SCHED; PG8_LDA(At, 1, 0); PG8_STAGEA(PG8_SA(0, 1), a2, 1);
            PG8_WAIT_V(8); PG8_WAIT_L(0); PG8_BAR; PG8_MMA(0, 0, At, B0); PG8_MMA(0, 1, At, B1); PG8_BAR; PG8_SCHED;
            PG8_LDA(At, 1, 1); PG8_STAGE(PG8_SB(1, 0), b3, voffB); PG8_STAGE(PG8_SB(1, 1), b3 + hstep, voffB); PG8_STAGEA(PG8_SA(1, 0), a3, 0);
            PG8_WAIT_V(8); PG8_WAIT_L(0); PG8_BAR; if (!cur.hf) { PG8_MMA(1, 0, At, B0); PG8_MMA(1, 1, At, B1); } PG8_BAR; PG8_SCHED;
        }
        if (wr == 0) PG8_BAR;
        { int tz = tid; asm volatile("" : "+v"(tz)); const int ln = tz & 63; E(acc, cur, wr, wc, ln & 15, ln >> 4); }
        if (!has_next) break;
#pragma unroll
        for (int a = 0; a < 2; ++a)
#pragma unroll
            for (int b = 0; b < 2; ++b)
#pragma unroll
                for (int m = 0; m < 4; ++m)
#pragma unroll
                    for (int n = 0; n < 2; ++n) acc[a][b][m][n] = (f32x4){zf, zf, zf, zf};
        cur = nxt; cB = nB; cA = nA; ++ui;
        if (wr == 1) PG8_BAR;
    }
    PG8_WAIT_V(0);
    PG8_BAR;
#undef PG8_SA
#undef PG8_SB
#undef PG8_STAGE
#undef PG8_LDA
#undef PG8_LDB
#undef PG8_MMA
#undef PG8_WAIT_V
#undef PG8_WAIT_L
#undef PG8_BAR
#undef PG8_SCHED
#undef PG8_ROWOFFS
#undef PG8_STAGEA
}

#define EPI_LOOP for (int ai = 0; ai < 2; ++ai) for (int m = 0; m < 4; ++m) for (int bj = 0; bj < 2; ++bj) for (int n = 0; n < 2; ++n)
struct EpiBf16 {
    bf16_t* O; int ldc;
    __device__ __forceinline__ void operator()(const f32x4 (&acc)[2][2][4][2], const Unit& u, int wr, int wc, int fr, int fq) const {
        const int row0 = u.pm * BM + wr * 64 + fr, col0 = u.pn * BM + wc * 32 + 4 * fq;
#pragma unroll
        for (int ai = 0; ai < 2; ++ai)
#pragma unroll
            for (int m = 0; m < 4; ++m) { bf16_t* rowp = O + (size_t)(row0 + ai * HALF + m * 16) * ldc + col0;
#pragma unroll
                for (int bj = 0; bj < 2; ++bj)
#pragma unroll
                    for (int n = 0; n < 2; ++n) { const f32x4 v = acc[ai][bj][m][n]; u32x2 o; o.x = pk2(v[0], v[1]); o.y = pk2(v[2], v[3]); *(u32x2*)(rowp + bj * HALF + n * 16) = o; } }
    }
};
struct EpiOdd {
    bf16_t* P; bf16_t* Q; bf16_t* KA; const float* rope;
    __device__ __forceinline__ void operator()(const f32x4 (&acc)[2][2][4][2], const Unit& u, int wr, int wc, int fr, int fq) const {
        const int row0 = u.pm * BM + wr * 64 + fr, col0 = u.pn * BM + wc * 32 + 4 * fq;
        if (u.pn >= 6) {
#pragma unroll
            for (int ai = 0; ai < 2; ++ai)
#pragma unroll
                for (int m = 0; m < 4; ++m) { bf16_t* rowp = P + (size_t)(row0 + ai * HALF + m * 16) * P_LD + col0;
#pragma unroll
                    for (int bj = 0; bj < 2; ++bj)
#pragma unroll
                        for (int n = 0; n < 2; ++n) { const f32x4 v = acc[ai][bj][m][n]; u32x2 o; o.x = pk2(v[0], v[1]); o.y = pk2(v[2], v[3]); *(u32x2*)(rowp + bj * HALF + n * 16) = o; } }
            return;
        }
        const bool isk = u.pn >= 3, isctx = u.pm >= NLAT / BM; const int axis = wc & 1;
        const int cq = col0 - (isk ? 768 : 0);
#pragma unroll
        for (int ai = 0; ai < 2; ++ai)
#pragma unroll
            for (int m = 0; m < 4; ++m) { const int row = row0 + ai * HALF + m * 16;
                f32x4 cs = {1.f, 1.f, 1.f, 1.f}, sn = {0.f, 0.f, 0.f, 0.f}; size_t orow;
                if (!isctx) { const int t = row & (TT - 1); const int pos = axis ? 128 + (t & 63) : (t >> 6);
                    cs = *(const f32x4*)(rope + pos * 16 + 4 * fq); sn = *(const f32x4*)(rope + 192 * 16 + pos * 16 + 4 * fq);
                    orow = isk ? (size_t)(row >> 13) * LKEYS + CTXL + t : (size_t)row; }
                else { const int rc = row - NLAT; orow = isk ? (size_t)(rc >> 8) * LKEYS + (rc & 255) : (size_t)row; }
                bf16_t* op = (isk ? KA : Q) + orow * 768 + cq; const float sc = isk ? 1.f : QSCALE;
#pragma unroll
                for (int bj = 0; bj < 2; ++bj) { const f32x4 x1 = acc[ai][bj][m][0], x2 = acc[ai][bj][m][1];
                    const f32x4 o1 = (x1 * cs - x2 * sn) * sc, o2 = (x1 * sn + x2 * cs) * sc;
                    u32x2 a; a.x = pk2(o1[0], o1[1]); a.y = pk2(o1[2], o1[3]); *(u32x2*)(op + bj * HALF) = a;
                    u32x2 b; b.x = pk2(o2[0], o2[1]); b.y = pk2(o2[2], o2[3]); *(u32x2*)(op + bj * HALF + 16) = b; } }
    }
};
struct EpiRes {
    float* X; const float* modl;
    __device__ __forceinline__ void operator()(const f32x4 (&acc)[2][2][4][2], const Unit& u, int wr, int wc, int fr, int fq) const {
        const int row0 = u.pm * BM + wr * 64 + fr, col0 = u.pn * BM + wc * 32 + 4 * fq;
        const int mi = (u.pm * BM < NLAT) ? (u.pm * BM) / TT : 4;
        const float* gate = modl + mi * 6144 + 2 * DM;
        f32x4 gv[2][2];
#pragma unroll
        for (int bj = 0; bj < 2; ++bj)
#pragma unroll
            for (int n = 0; n < 2; ++n) gv[bj][n] = *(const f32x4*)(gate + col0 + bj * HALF + n * 16);
#pragma unroll
        for (int ai = 0; ai < 2; ++ai)
#pragma unroll
            for (int m = 0; m < 4; ++m) { float* rowp = X + (size_t)(row0 + ai * HALF + m * 16) * DM + col0;
#pragma unroll
                for (int bj = 0; bj < 2; ++bj)
#pragma unroll
                    for (int n = 0; n < 2; ++n) { f32x4* p = (f32x4*)(rowp + bj * HALF + n * 16); const f32x4 x = *p; *p = x * ALPHA_DN + gv[bj][n] * acc[ai][bj][m][n]; } }
    }
};
struct EpiSwiGLU {
    bf16_t* HID;
    __device__ __forceinline__ void operator()(const f32x4 (&acc)[2][2][4][2], const Unit& u, int wr, int wc, int fr, int fq) const {
        const int row0 = u.pm * BM + wr * 64 + fr, f0 = u.pn * HALF + wc * 32 + 4 * fq;
#pragma unroll
        for (int ai = 0; ai < 2; ++ai) if (ai == 0 || !u.hf)
#pragma unroll
            for (int m = 0; m < 4; ++m) { bf16_t* rowp = HID + (size_t)(row0 + ai * HALF + m * 16) * D_EXP + f0;
#pragma unroll
                for (int n = 0; n < 2; ++n) { const f32x4 a = acc[ai][0][m][n], b = acc[ai][1][m][n]; float h[4];
#pragma unroll
                    for (int j = 0; j < 4; ++j) h[j] = a[j] / (1.f + __expf(-a[j])) * b[j];
                    u32x2 o; o.x = pk2(h[0], h[1]); o.y = pk2(h[2], h[3]); *(u32x2*)(rowp + n * 16) = o; } }
    }
};
struct EpiYE {
    bf16_t* YE; const float* gate;
    __device__ __forceinline__ void operator()(const f32x4 (&acc)[2][2][4][2], const Unit& u, int wr, int wc, int fr, int fq) const {
        const int row0 = u.pm * BM + wr * 64 + fr, col0 = u.pn * BM + wc * 32 + 4 * fq;
        float gts[2][4];
#pragma unroll
        for (int ai = 0; ai < 2; ++ai)
#pragma unroll
            for (int m = 0; m < 4; ++m) gts[ai][m] = gate[row0 + ai * HALF + m * 16];
#pragma unroll
        for (int ai = 0; ai < 2; ++ai) if (ai == 0 || !u.hf)
#pragma unroll
            for (int m = 0; m < 4; ++m) { const int row = row0 + ai * HALF + m * 16; const float gt = gts[ai][m]; bf16_t* rowp = YE + (size_t)row * DM + col0;
#pragma unroll
                for (int bj = 0; bj < 2; ++bj)
#pragma unroll
                    for (int n = 0; n < 2; ++n) { const f32x4 v = acc[ai][bj][m][n] * gt; u32x2 o; o.x = pk2(v[0], v[1]); o.y = pk2(v[2], v[3]); *(u32x2*)(rowp + bj * HALF + n * 16) = o; } }
    }
};
struct EpiLora {
    unsigned char* SCN; bf16_t* G; const float* decay0; const float* a0; const float* kalpha;
    __device__ __forceinline__ void operator()(const f32x4 (&acc)[2][2][4][2], const Unit& u, int wr, int wc, int fr, int fq) const {
        const int row0 = u.pm * BM + wr * 64 + fr;
        const int seg = u.pn / 3, cb = (u.pn % 3) * BM + wc * 32 + 4 * fq;
#pragma unroll
        for (int bj = 0; bj < 2; ++bj)
#pragma unroll
            for (int n = 0; n < 2; ++n) {
                const int col = cb + bj * HALF + n * 16, head = col >> 6, kx = col & 63;
                if (seg < 2) {
                    const f32x4 d0 = *(const f32x4*)(decay0 + seg * 768 + col);
#pragma unroll
                    for (int ai = 0; ai < 2; ++ai)
#pragma unroll
                        for (int m = 0; m < 4; ++m) { const int row = row0 + ai * HALF + m * 16; f32x4 w;
#pragma unroll
                            for (int j = 0; j < 4; ++j) { const float lw = -DECAY_SCALE * sigmoidf_(d0[j] + acc[ai][bj][m][n][j]); w[j] = CHUNKED_SCAN ? lw : __expf(lw); }
                            *(f32x4*)(SCN + (size_t)(row * 12 + head) * SC_REC + SC_W + seg * 256 + kx * 4) = w; __builtin_amdgcn_sched_barrier(0); }
                } else if (seg < 4) {
                    const int d = seg - 2;
                    const f32x4 a00 = *(const f32x4*)(a0 + d * 768 + col), kal = *(const f32x4*)(kalpha + col);
                    u32x2 kkr[2][4], ksr[2][4];
#pragma unroll
                    for (int ai = 0; ai < 2; ++ai)
#pragma unroll
                        for (int m = 0; m < 4; ++m) { const unsigned char* base = SCN + (size_t)((row0 + ai * HALF + m * 16) * 12 + head) * SC_REC + kx * 2;
                            kkr[ai][m] = *(const u32x2*)(base + SC_KK); ksr[ai][m] = *(const u32x2*)(base + SC_KR + 256 * d); }
#pragma unroll
                    for (int ai = 0; ai < 2; ++ai)
#pragma unroll
                        for (int m = 0; m < 4; ++m) { const int row = row0 + ai * HALF + m * 16; unsigned char* base = SCN + (size_t)(row * 12 + head) * SC_REC + kx * 2;
                            const f32x4 kk = {bflo(kkr[ai][m].x), bfhi(kkr[ai][m].x), bflo(kkr[ai][m].y), bfhi(kkr[ai][m].y)}; const f32x4 ks = {bflo(ksr[ai][m].x), bfhi(ksr[ai][m].x), bflo(ksr[ai][m].y), bfhi(ksr[ai][m].y)}; f32x4 bb, kr;
#pragma unroll
                            for (int j = 0; j < 4; ++j) { const float a = sigmoidf_(a00[j] + acc[ai][bj][m][n][j]); bb[j] = kk[j] * a; kr[j] = ks[j] * (1.f + (a - 1.f) * kal[j]); }
                            st4bf_(base + SC_B + 256 * d, bb); st4bf_(base + SC_KR + 256 * d, kr); __builtin_amdgcn_sched_barrier(0); }
                } else {
#pragma unroll
                    for (int ai = 0; ai < 2; ++ai)
#pragma unroll
                        for (int m = 0; m < 4; ++m) { const int row = row0 + ai * HALF + m * 16; const f32x4 v = acc[ai][bj][m][n]; u32x2 o; o.x = pk2(v[0], v[1]); o.y = pk2(v[2], v[3]);
                            *(u32x2*)(G + (size_t)row * 768 + col) = o; }
                }
            }
    }
};
}

struct Args { const float* in[37]; float* out; unsigned char* ws; int lo, hi; };
enum { I_X = 0, I_C, I_CTX, I_CCTX, I_WMOD, I_BMOD, I_LNG, I_LNB, I_EWIN, I_EWOUT, I_CONVW, I_MU, I_DUP, I_D0, I_AUP, I_A0, I_GUP, I_KXI, I_KAL, I_RBON, I_GNG, I_GNB,
       I_OWIN, I_OWOUT, I_LQ1, I_LK1, I_LQ2, I_LK2, I_SUBG, I_GLNG, I_GLNB, I_GWS, I_GBS, I_WR, I_WE1, I_WE3, I_WE2 };

struct Ctx {
    LAS unsigned char* lds;
    int tid, lane, wave, G, vcu, gw, NGW;
};
__device__ __forceinline__ void mkctx(Ctx& C, LAS unsigned char* lds) {
    int tid = threadIdx.x; asm volatile("" : "+v"(tid));
    C.lds = lds; C.tid = tid; C.lane = tid & 63; C.wave = __builtin_amdgcn_readfirstlane(tid >> 6);
    C.G = gridDim.x; { const int bx = blockIdx.x; C.vcu = (C.G % 8 == 0) ? (bx % 8) * (C.G / 8) + bx / 8 : bx; }
    C.gw = blockIdx.x * NWAVES + C.wave; C.NGW = C.G * NWAVES;
}
#define GLOBAL_PTR(T, v) ((T*)(__attribute__((address_space(1))) T*)(v))
__device__ __forceinline__ void ldargs(Args& A, LAS unsigned char* lds) {
    LAS const u32x2* tb = (LAS const u32x2*)(lds + LDS_PTAB); asm volatile("" : "+v"(tb));
#pragma unroll
    for (int i = 0; i < 37; ++i) { const u32x2 v = tb[i]; A.in[i] = GLOBAL_PTR(const float, ((unsigned long long)(unsigned)__builtin_amdgcn_readfirstlane((int)v.y) << 32) | (unsigned)__builtin_amdgcn_readfirstlane((int)v.x)); }
    { const u32x2 v = tb[37]; A.out = GLOBAL_PTR(float, ((unsigned long long)(unsigned)__builtin_amdgcn_readfirstlane((int)v.y) << 32) | (unsigned)__builtin_amdgcn_readfirstlane((int)v.x)); }
    { const u32x2 v = tb[38]; A.ws = GLOBAL_PTR(unsigned char, ((unsigned long long)(unsigned)__builtin_amdgcn_readfirstlane((int)v.y) << 32) | (unsigned)__builtin_amdgcn_readfirstlane((int)v.x)); }
    A.lo = 0; A.hi = 0;
}
__device__ __forceinline__ int row_mi(int row) { return row < NLAT ? (row >> 13) : 4; }

__device__ __forceinline__ void phase_init(const Ctx& C, const Args& A) {
    unsigned char* ws = A.ws;
    float* MOD = (float*)(ws + WS_MOD);
    LAS float* sv = (LAS float*)C.lds;
    LAS float* red = sv + 5 * 1024;
    for (int i = C.tid; i < 5 * 1024; i += NTHR) { const int v = i >> 10, k = i & 1023; const float c = (v < 4) ? A.in[I_C][v * DM + k] : A.in[I_CCTX][k]; sv[i] = c / (1.f + __expf(-c)); }
    __syncthreads();
    const int j = C.tid & 127, kp = C.tid >> 7;
    for (int it = blockIdx.x; it < DEPTH * 48; it += C.G) {
        const int l = it / 48, cg = it % 48, col = cg * 128 + j;
        const float* W = A.in[I_WMOD] + (size_t)l * DM * 6144 + col;
        float a0 = 0.f, a1 = 0.f, a2 = 0.f, a3 = 0.f, a4 = 0.f;
#pragma unroll 4
        for (int k = kp * 256; k < kp * 256 + 256; ++k) { const float w = W[(size_t)k * 6144]; a0 += sv[k] * w; a1 += sv[1024 + k] * w; a2 += sv[2048 + k] * w; a3 += sv[3072 + k] * w; a4 += sv[4096 + k] * w; }
        red[(kp * 5 + 0) * 128 + j] = a0; red[(kp * 5 + 1) * 128 + j] = a1; red[(kp * 5 + 2) * 128 + j] = a2; red[(kp * 5 + 3) * 128 + j] = a3; red[(kp * 5 + 4) * 128 + j] = a4;
        __syncthreads();
        for (int o = C.tid; o < 5 * 128; o += NTHR) { const int v = o >> 7, jj = o & 127; const int cc = cg * 128 + jj;
            const float s = red[(0 * 5 + v) * 128 + jj] + red[(1 * 5 + v) * 128 + jj] + red[(2 * 5 + v) * 128 + jj] + red[(3 * 5 + v) * 128 + jj];
            MOD[((size_t)l * 5 + v) * 6144 + cc] = s + A.in[I_BMOD][l * 6144 + cc]; }
        __syncthreads();
    }
    if (blockIdx.x == C.G - 1) { float* rope = (float*)(ws + WS_ROPE);
        for (int i = C.tid; i < 192 * 16; i += NTHR) { const int pos = i >> 4, j = i & 15; const float ang = (float)(pos < 128 ? pos : pos - 128) * powf(10000.f, -(float)j * (1.f / 16.f));
            rope[i] = cosf(ang); rope[192 * 16 + i] = sinf(ang); } }
    f32x4* X4 = (f32x4*)(ws + WS_X);
    const f32x4* x4 = (const f32x4*)A.in[I_X]; const f32x4* c4 = (const f32x4*)A.in[I_CTX];
    const size_t nl = (size_t)NLAT * DM / 4, nc = (size_t)NCTX * DM / 4;
    for (size_t i = (size_t)blockIdx.x * NTHR + C.tid; i < nl + nc; i += (size_t)C.G * NTHR) X4[i] = (i < nl) ? x4[i] : c4[i - nl];
}

__device__ __forceinline__ void transpose_item(const float* W, int ldw, int k0, int n0, bf16_t* WT, int ldt, int drow0, LAS float* scr, int lane) {
    { float v[64]; const float* src = W + (size_t)k0 * ldw + n0 + lane;
#pragma unroll
      for (int k = 0; k < 64; ++k) v[k] = __builtin_nontemporal_load(src + (size_t)k * ldw);
#pragma unroll
      for (int k = 0; k < 64; ++k) scr[k * 65 + lane] = v[k]; }
    asm volatile("s_waitcnt lgkmcnt(0)" ::: "memory");
    const int c = lane & 7;
#pragma unroll
    for (int j = 0; j < 8; ++j) { const int n = (lane >> 3) + 8 * j; const LAS float* s = scr + (8 * c) * 65 + n;
        u32x4 o; o.x = pk2(s[0 * 65], s[1 * 65]); o.y = pk2(s[2 * 65], s[3 * 65]); o.z = pk2(s[4 * 65], s[5 * 65]); o.w = pk2(s[6 * 65], s[7 * 65]);
        *(u32x4*)(WT + (size_t)(drow0 + n) * ldt + k0 + 8 * c) = o; }
    asm volatile("s_waitcnt lgkmcnt(0)" ::: "memory");
}
__device__ __forceinline__ void conv_items(const Ctx& C, const Args& A, int l, int gw, int NGW, bool do_in, bool do_out, bool do_exp) {
    unsigned char* ws = A.ws;
    const int i2 = l >> 1; const bool odd = (l & 1);
    LAS float* scr = (LAS float*)C.lds + C.wave * (64 * 65);
    bf16_t* WIN = (bf16_t*)(ws + WS_WIN); bf16_t* WOUT = (bf16_t*)(ws + WS_WOUT); bf16_t* WE13 = (bf16_t*)(ws + WS_WE13 + (size_t)(l & 1) * WE13_BYTES); bf16_t* WE2 = (bf16_t*)(ws + WS_WE2 + (size_t)(l & 1) * WE2_BYTES);
    const int nin = odd ? D_IN_ODD : D_IN_EVEN;
    const float* win = odd ? A.in[I_OWIN] + (size_t)i2 * DM * D_IN_ODD : A.in[I_EWIN] + (size_t)i2 * DM * D_IN_EVEN;
    const float* wout = odd ? A.in[I_OWOUT] + (size_t)i2 * DM * DM : A.in[I_EWOUT] + (size_t)i2 * DM * DM;
    const int n_in = do_in ? 16 * (nin / 64) : 0, n_out = do_out ? 16 * 16 : 0, n_e13 = do_exp ? NEXP * 2 * 16 * 32 : 0, n_e2 = do_exp ? NEXP * 32 * 16 : 0;
    const int total = n_in + n_out + n_e13 + n_e2;
    for (int it = gw; it < total; it += NGW) {
        int r = it;
        if (r < n_in) { const int nb = nin / 64, kb = r / nb, nn = r % nb; transpose_item(win, nin, kb * 64, nn * 64, WIN, DM, nn * 64, scr, C.lane); continue; } r -= n_in;
        if (r < n_out) { const int kb = r / 16, nn = r % 16; transpose_item(wout, DM, kb * 64, nn * 64, WOUT, DM, nn * 64, scr, C.lane); continue; } r -= n_out;
        if (r < n_e13) { const int e = r / 1024, q = r % 1024, mat = q / 512, q2 = q % 512, kb = q2 / 32, nn = q2 % 32;
            const float* W = (mat ? A.in[I_WE3] : A.in[I_WE1]) + ((size_t)l * NEXP + e) * DM * D_EXP;
            const int f0 = nn * 64; const int drow = (f0 >> 7) * 256 + mat * 128 + (f0 & 127);
            transpose_item(W, D_EXP, kb * 64, f0, WE13 + (size_t)e * 4096 * DM, DM, drow, scr, C.lane); continue; } r -= n_e13;
        { const int e = r / 512, q = r % 512, kb = q / 16, nn = q % 16;
            const float* W = A.in[I_WE2] + ((size_t)l * NEXP + e) * D_EXP * DM;
            transpose_item(W, DM, kb * 64, nn * 64, WE2 + (size_t)e * DM * D_EXP, D_EXP, nn * 64, scr, C.lane); }
    }
}
__device__ __forceinline__ void phase_conv(const Ctx& C, const Args& A, int l) {
    unsigned char* ws = A.ws;
    const int i2 = l >> 1; const bool odd = (l & 1);
    bf16_t* WIN = (bf16_t*)(ws + WS_WIN);
    const bool early = CHUNKED_SCAN && odd;
    if (l > 0) conv_items(C, A, l, C.gw, C.NGW, !early, true, !early);
    if (!odd) {
        u32x4* z = (u32x4*)(WIN + (size_t)D_IN_EVEN * DM);
        unsigned zz = 0u; asm volatile("" : "+v"(zz));
        for (int i = blockIdx.x * NTHR + C.tid; i < (D_IN_EVEN_PAD - D_IN_EVEN) * DM / 8; i += C.G * NTHR) z[i] = (u32x4){zz, zz, zz, zz};
        bf16_t* WL = (bf16_t*)(ws + WS_WLORA);
        const float* dup = A.in[I_DUP] + (size_t)i2 * 2 * 64 * 768; const float* aup = A.in[I_AUP] + (size_t)i2 * 2 * 64 * 768; const float* gup = A.in[I_GUP] + (size_t)i2 * 128 * 768;
        for (int i = blockIdx.x * NTHR + C.tid; i < LORA_N * LORA_K; i += C.G * NTHR) {
            const int kk = i / LORA_N, n = i % LORA_N, seg = n / 768, col = n % 768; float v = 0.f;
            if (seg == 0) { if (kk < 64) v = dup[(size_t)(0 * 64 + kk) * 768 + col]; }
            else if (seg == 1) { if (kk >= 64 && kk < 128) v = dup[(size_t)(1 * 64 + kk - 64) * 768 + col]; }
            else if (seg == 2) { if (kk >= 128 && kk < 192) v = aup[(size_t)(0 * 64 + kk - 128) * 768 + col]; }
            else if (seg == 3) { if (kk >= 192 && kk < 256) v = aup[(size_t)(1 * 64 + kk - 192) * 768 + col]; }
            else { if (kk >= 256) v = gup[(size_t)(kk - 256) * 768 + col]; }
            WL[(size_t)n * LORA_K + kk] = (bf16_t)f2bf(v);
        }
    }
}

__device__ __forceinline__ void phase_modh(const Ctx& C, const Args& A, int l) {
    const float* X = (const float*)(A.ws + WS_X); bf16_t* H = (bf16_t*)(A.ws + WS_H); const float* MOD = (const float*)(A.ws + WS_MOD) + (size_t)l * 5 * 6144;
    for (int row = C.gw; row < MROWS; row += C.NGW) {
        const float* md = MOD + row_mi(row) * 6144;
#pragma unroll
        for (int j = 0; j < 4; ++j) { const int col = 4 * C.lane + 256 * j; const f32x4 x = *(const f32x4*)(X + (size_t)row * DM + col), sh = *(const f32x4*)(md + col), sc = *(const f32x4*)(md + DM + col);
            const f32x4 h = x * (sc + 1.f) + sh; u32x2 o; o.x = pk2(h[0], h[1]); o.y = pk2(h[2], h[3]); *(u32x2*)(H + (size_t)row * DM + col) = o; }
    }
}

__device__ __forceinline__ f32x4 ld4bf(const bf16_t* p) { const u32x2 u = *(const u32x2*)p; return (f32x4){bflo(u.x), bfhi(u.x), bflo(u.y), bfhi(u.y)}; }
__device__ __forceinline__ void st4bf(bf16_t* p, f32x4 v) { u32x2 o; o.x = pk2(v[0], v[1]); o.y = pk2(v[2], v[3]); *(u32x2*)p = o; }
__device__ __forceinline__ void seq_info(int row, bool& hasp, bool& hasn) {
    if (row < NLAT) { const int t = row & (TT - 1); hasp = t > 0; hasn = t < TT - 1; }
    else { const int t = (row - NLAT) & (CTXL - 1); hasp = t > 0; hasn = t < CTXL - 1; }
}
__device__ __forceinline__ void phase_ef1(const Ctx& C, const Args& A, int l) {
    const int i2 = l >> 1; unsigned char* ws = A.ws;
    const bf16_t* P = (const bf16_t*)(ws + WS_P); bf16_t* A2 = (bf16_t*)(ws + WS_A2); unsigned char* SCN = ws + WS_SCN; bf16_t* LIN = (bf16_t*)(ws + WS_LIN);
    const float* cw = A.in[I_CONVW] + (size_t)i2 * 3 * 256; const float* mu = A.in[I_MU] + (size_t)i2 * RWKV_COLS; const float* kxi = A.in[I_KXI] + (size_t)i2 * 768;
    const f32x4 z4 = {0.f, 0.f, 0.f, 0.f};
    for (int row = C.gw; row < MROWS; row += C.NGW) {
        bool hasp, hasn; seq_info(row, hasp, hasn);
        const bf16_t* p0 = P + (size_t)row * P_LD; const bf16_t* pm = p0 - P_LD; const bf16_t* pp = p0 + P_LD;
        {
            const int j4 = 4 * C.lane;
            const f32x4 bg = ld4bf(p0 + j4), u0 = ld4bf(p0 + 256 + j4) * ld4bf(p0 + 512 + j4);
            const f32x4 um = hasp ? ld4bf(pm + 256 + j4) * ld4bf(pm + 512 + j4) : z4, up = hasn ? ld4bf(pp + 256 + j4) * ld4bf(pp + 512 + j4) : z4;
            const f32x4 w0 = *(const f32x4*)(cw + j4), w1 = *(const f32x4*)(cw + 256 + j4), w2 = *(const f32x4*)(cw + 512 + j4);
            st4bf(A2 + (size_t)row * DM + j4, bg * (w0 * um + w1 * u0 + w2 * up));
        }
#pragma unroll
        for (int it = 0; it < 11; ++it) {
            const int c = it * 256 + 4 * C.lane;
            if (c < RWKV_COLS) {
                const f32x4 x0 = ld4bf(p0 + 768 + c), xm = hasp ? ld4bf(pm + 768 + c) : z4, xp = hasn ? ld4bf(pp + 768 + c) : z4, m4 = *(const f32x4*)(mu + c);
                const f32x4 ps = x0 + m4 * ((xm + xp) * 0.5f - x0);
                if (it < 3) { const int head = c >> 6, kx = c & 63; st4bf_(SCN + (size_t)(row * 12 + head) * SC_REC + SC_R + kx * 2, ps); }
                else if (it < 6) { const int c1 = c - 768, head = c1 >> 6, kx = c1 & 63; const f32x4 kv = ps * *(const f32x4*)(kxi + c1);
                    const float ss = sum16(kv[0] * kv[0] + kv[1] * kv[1] + kv[2] * kv[2] + kv[3] * kv[3]); const float rn = rsqrtf(ss + 1e-12f);
                    unsigned char* base = SCN + (size_t)(row * 12 + head) * SC_REC + kx * 2;
                    st4bf_(base + SC_KK, kv * rn); st4bf_(base + SC_KR, ps); st4bf_(base + SC_KR + 256, ps); }
                else if (it < 9) { const int c1 = c - 1536, head = c1 >> 6, kx = c1 & 63; st4bf_(SCN + (size_t)(row * 12 + head) * SC_REC + SC_V + kx * 2, ps); }
                else { const int c1 = c - 2304; f32x4 o;
                    if (c1 < 128) { o = (f32x4){tanhf(ps[0]), tanhf(ps[1]), tanhf(ps[2]), tanhf(ps[3])}; }
                    else if (c1 < 256) { o = ps; }
                    else { o = (f32x4){sigmoidf_(ps[0]), sigmoidf_(ps[1]), sigmoidf_(ps[2]), sigmoidf_(ps[3])}; }
                    st4bf(LIN + (size_t)row * LORA_K + c1, o); }
            }
        }
    }
}

__device__ __forceinline__ int scan_row(int i, int b, int d) {
    if (d == 0) return i < CTXL ? NLAT + b * CTXL + i : b * TT + (i - CTXL);
    return i < CTXL ? NLAT + b * CTXL + (CTXL - 1 - i) : b * TT + (TT - 1 - (i - CTXL));
}
__device__ __forceinline__ float red8(float v) {
    v += __uint_as_float((unsigned)__builtin_amdgcn_update_dpp(0, (int)__float_as_uint(v), 0xB1, 0xF, 0xF, true));
    v += __uint_as_float((unsigned)__builtin_amdgcn_update_dpp(0, (int)__float_as_uint(v), 0x4E, 0xF, 0xF, true));
    v += __uint_as_float((unsigned)__builtin_amdgcn_update_dpp(0, (int)__float_as_uint(v), 0x141, 0xF, 0xF, true));
    return v;
}
__device__ __forceinline__ float red16(float v) {
    v += __uint_as_float((unsigned)__builtin_amdgcn_update_dpp(0, (int)__float_as_uint(v), 0xB1, 0xF, 0xF, true));
    v += __uint_as_float((unsigned)__builtin_amdgcn_update_dpp(0, (int)__float_as_uint(v), 0x4E, 0xF, 0xF, true));
    v += __uint_as_float((unsigned)__builtin_amdgcn_update_dpp(0, (int)__float_as_uint(v), 0x141, 0xF, 0xF, true));
    v += __uint_as_float((unsigned)__builtin_amdgcn_update_dpp(0, (int)__float_as_uint(v), 0x140, 0xF, 0xF, true));
    return v;
}
__device__ __forceinline__ void phase_scan(const Ctx& C, const Args& A) {
    for (int u = blockIdx.x; u < 192; u += C.G) {
    const int half = u & 1, d = (u >> 1) & 1, h = (u >> 2) % 12, b = u / 48;
    const unsigned char* SCN = A.ws + WS_SCN; float* Y = (float*)(A.ws + WS_Y) + (size_t)d * MROWS * 768;
    LAS float* buf = (LAS float*)C.lds; LAS float* ybuf = buf + 2 * 32 * 352;
    constexpr int NCH = LKEYS / 32;
    u32x4 st[4];
    int ps_[4], psrc[4], pdst[4]; bool pf32[4];
#pragma unroll
    for (int j = 0; j < 4; ++j) { const int p = C.tid + NTHR * j; const int s = p / 52, q = p % 52; ps_[j] = s;
        if (q < 16) { psrc[j] = SC_W + 256 * d + q * 16; pdst[j] = s * 352 + q * 4; pf32[j] = true; }
        else if (q < 48) { const int vec = (q - 16) >> 3, part = (q - 16) & 7; const int so = vec == 0 ? SC_KK : vec == 1 ? SC_B + 256 * d : vec == 2 ? SC_KR + 256 * d : SC_R;
            psrc[j] = so + part * 16; pdst[j] = s * 352 + 64 * (vec + 1) + part * 8; pf32[j] = false; }
        else { const int part = q - 48; psrc[j] = SC_V + half * 64 + part * 16; pdst[j] = s * 352 + 320 + part * 8; pf32[j] = false; } }
    const int sgn = d ? -1 : 1;
    const unsigned char* SCNh = SCN + (size_t)h * SC_REC;
#define SCAN_ROW0(c) (((c) * 32 < CTXL) ? (NLAT + b * CTXL + (d ? CTXL - 1 - (c) * 32 : (c) * 32)) : (b * TT + (d ? TT - 1 - ((c) * 32 - CTXL) : (c) * 32 - CTXL)))
#define SCAN_LOADG(c) do { const int row0_ = SCAN_ROW0(c); _Pragma("unroll") for (int j = 0; j < 4; ++j) if (j < 3 || C.tid < 1664 - 3 * NTHR) { \
        st[j] = *(const u32x4*)(SCNh + (size_t)(row0_ + sgn * ps_[j]) * SC_ROW + psrc[j]); } } while (0)
#define SCAN_STORE(bi) do { _Pragma("unroll") for (int j = 0; j < 4; ++j) if (j < 3 || C.tid < 1664 - 3 * NTHR) { LAS float* dp = buf + (bi) * (32 * 352) + pdst[j]; \
        if (pf32[j]) *(LAS u32x4*)dp = st[j]; \
        else { *(LAS f32x4*)dp = (f32x4){bflo(st[j].x), bfhi(st[j].x), bflo(st[j].y), bfhi(st[j].y)}; *(LAS f32x4*)(dp + 4) = (f32x4){bflo(st[j].z), bfhi(st[j].z), bflo(st[j].w), bfhi(st[j].w)}; } } } while (0)
    SCAN_LOADG(0); SCAN_STORE(0); __syncthreads();
    f32x2 Sa = {0.f, 0.f}, Sb = {0.f, 0.f};
    const int rl = C.lane >> 4, ks = C.lane & 15;
    float ycol = 0.f;
#define SC_LD(R, s) do { const LAS float* bp_ = cur + (s) * 352 + ks * 4; \
        R##w = *(const LAS f32x4*)(bp_); R##k = *(const LAS f32x4*)(bp_ + 64); R##b = *(const LAS f32x4*)(bp_ + 128); R##q = *(const LAS f32x4*)(bp_ + 192); R##r = *(const LAS f32x4*)(bp_ + 256); \
        R##vv = cur[(s) * 352 + 320 + C.wave * 4 + rl]; } while (0)
#define SC_LO(v) ((f32x2){v[0], v[1]})
#define SC_HI(v) ((f32x2){v[2], v[3]})
#define SC_DPP(x, ctrl) __uint_as_float((unsigned)__builtin_amdgcn_update_dpp(0, (int)__float_as_uint(x), ctrl, 0xF, 0xF, true))
#define SC_STEP(R, P, s) do { \
        f32x2 pa = __builtin_elementwise_fma(Sb, SC_HI(R##k), Sa * SC_LO(R##k)), py = __builtin_elementwise_fma(Sb, SC_HI(P##r), Sa * SC_LO(P##r)); \
        float a_ = pa.x + pa.y, y_ = py.x + py.y; \
        a_ += SC_DPP(a_, 0xB1); y_ += SC_DPP(y_, 0xB1); a_ += SC_DPP(a_, 0x4E); y_ += SC_DPP(y_, 0x4E); \
        a_ += SC_DPP(a_, 0x141); y_ += SC_DPP(y_, 0x141); a_ += SC_DPP(a_, 0x140); y_ += SC_DPP(y_, 0x140); \
        ycol = (ks == ((s) & 15)) ? y_ : ycol; \
        const f32x2 na = {-a_, -a_}, vv2 = {R##vv, R##vv}; \
        Sa = __builtin_elementwise_fma(Sa, SC_LO(R##w), __builtin_elementwise_fma(na, SC_LO(R##b), vv2 * SC_LO(R##q))); \
        Sb = __builtin_elementwise_fma(Sb, SC_HI(R##w), __builtin_elementwise_fma(na, SC_HI(R##b), vv2 * SC_HI(R##q))); } while (0)
    f32x4 Aw, Ak, Ab, Aq, Ar, Bw, Bk, Bb, Bq, Br, Cw, Ck, Cb, Cq, Cr, Dw, Dk, Db, Dq, Dr; float Avv, Bvv, Cvv, Dvv;
    Dr = (f32x4){0.f, 0.f, 0.f, 0.f};
    for (int c = 0; c < NCH; ++c) {
        if (c + 1 < NCH) SCAN_LOADG(c + 1);
        {
            const LAS float* cur = buf + (c & 1) * (32 * 352);
            LAS float* yb = ybuf + (c & 1) * 1024 + C.wave * 4 + rl + ks * 32;
            SC_LD(A, 0); SC_LD(B, 1);
#pragma unroll 1
            for (int s = 0; s < 32; s += 4) {
                SC_LD(C, s + 2); __builtin_amdgcn_sched_barrier(0); SC_STEP(A, D, s); __builtin_amdgcn_sched_barrier(0);
                SC_LD(D, s + 3); __builtin_amdgcn_sched_barrier(0); SC_STEP(B, A, s + 1); __builtin_amdgcn_sched_barrier(0);
                SC_LD(A, s + 4); __builtin_amdgcn_sched_barrier(0); SC_STEP(C, B, s + 2); __builtin_amdgcn_sched_barrier(0);
                SC_LD(B, s + 5); __builtin_amdgcn_sched_barrier(0); SC_STEP(D, C, s + 3); __builtin_amdgcn_sched_barrier(0);
                if ((s & 15) == 12) yb[(s & 16) * 32] = ycol;
            }
        }
        if (c + 1 < NCH) SCAN_STORE((c + 1) & 1);
        __syncthreads();
        { const int row0_ = SCAN_ROW0(c);
#pragma unroll
          for (int i = 0; i < 2; ++i) { const int e = C.tid + NTHR * i, s = e >> 5, r = e & 31;
            const int row = (s > 0) ? row0_ + sgn * (s - 1) : scan_row(c * 32 - 1, b, d);
            if (s > 0 || c > 0) Y[(size_t)row * 768 + h * 64 + half * 32 + r] = ybuf[(c & 1) * 1024 + e]; } }
    }
    {
        f32x2 py = __builtin_elementwise_fma(Sb, SC_HI(Dr), Sa * SC_LO(Dr)); float y_ = py.x + py.y;
        y_ += SC_DPP(y_, 0xB1); y_ += SC_DPP(y_, 0x4E); y_ += SC_DPP(y_, 0x141); y_ += SC_DPP(y_, 0x140);
        if (ks == 0) Y[(size_t)scan_row(LKEYS - 1, b, d) * 768 + h * 64 + half * 32 + C.wave * 4 + rl] = y_;
    }
    __syncthreads();
    }
#undef SCAN_LOADG
#undef SCAN_STORE
#undef SCAN_ROW0
#undef SC_LD
#undef SC_STEP
#undef SC_LO
#undef SC_HI
#undef SC_DPP
}

constexpr int CSP = 72;
constexpr int CS_MAT = 64 * CSP * 2;
constexpr int CS_WT = 0, CS_KB = CS_MAT, CS_BB = 2 * CS_MAT, CS_RT = 3 * CS_MAT, CS_BHT = 4 * CS_MAT, CS_KHT = 5 * CS_MAT, CS_VMT = 6 * CS_MAT;
constexpr int CS_M2F = 7 * CS_MAT;
constexpr int CS_M1T = CS_M2F + 16384;
constexpr int CS_N2 = CS_M1T + CS_MAT;
constexpr int CS_GT = CS_N2 + CS_MAT;
constexpr int CS_Z = CS_M2F, CS_U = CS_M2F + CS_MAT;
constexpr int CS_GL = CS_GT + 2 * CS_MAT;
static_assert(CS_GL + 256 <= LDS_MISC, "chunked-scan LDS map");
template <bool SWZB = false>
__device__ __forceinline__ void cs_mma(f32x16& acc, const LAS unsigned char* Am, const LAS unsigned char* Bm, int ti, int tj, int r32, int hi) {
    const LAS unsigned char* ap = Am + (ti * 32 + r32) * (CSP * 2) + hi * 16; const int brow = tj * 32 + r32; const LAS unsigned char* bp = Bm + brow * (CSP * 2);
    const int sw = SWZB ? ((brow >> 3) & 7) : 0;
#pragma unroll
    for (int ks = 0; ks < 4; ++ks) acc = __builtin_amdgcn_mfma_f32_32x32x16_bf16(*(const LAS bf16x8*)(ap + ks * 32), *(const LAS bf16x8*)(bp + (((ks * 2 + hi) ^ sw) * 16)), acc, 0, 0, 0);
}
__device__ __forceinline__ void cs_store_t(LAS unsigned char* Om, const f32x16& acc, int ti, int tj, int r32, int hi) {
    LAS unsigned char* op = Om + (tj * 32 + r32) * (CSP * 2) + (ti * 32 + 4 * hi) * 2;
#pragma unroll
    for (int g = 0; g < 4; ++g) { u32x2 o; o.x = pk2(acc[4 * g], acc[4 * g + 1]); o.y = pk2(acc[4 * g + 2], acc[4 * g + 3]); *(LAS u32x2*)(op + g * 16) = o; }
}
#define CS_BAR() asm volatile("s_waitcnt lgkmcnt(0)\n\ts_barrier" ::: "memory")
__device__ __forceinline__ void phase_csa(const Ctx& C, const Args& A) {
    const unsigned char* SCN = A.ws + WS_SCN; unsigned char* CHK = A.ws + WS_CHK;
    LAS unsigned char* L = C.lds;
    const int r32 = C.lane & 31, hi = C.lane >> 5;
    float lwv[8]; u32x4 ukk, ub, ukr, ur, uv;
#define CSA_GEOM(cu_) const int unit = (cu_) / CS_NCH, ch = (cu_) % CS_NCH; const int d = unit & 1, h = (unit >> 1) % 12, b = unit / 24; \
        const int step0 = ch * CS_L; const int sgn = d ? -1 : 1; \
        const int row0 = (step0 < CTXL) ? (NLAT + b * CTXL + (d ? CTXL - 1 - step0 : step0)) : (b * TT + (d ? TT - 1 - (step0 - CTXL) : step0 - CTXL)); \
        const unsigned char* rec0 = SCN + (size_t)row0 * SC_ROW + (size_t)h * SC_REC;
#define CSA_LOAD(cu_) do { CSA_GEOM(cu_); \
        { const int k = C.tid & 63, sg = C.tid >> 6; _Pragma("unroll") for (int j = 0; j < 8; ++j) lwv[j] = *(const float*)(rec0 + (long)sgn * (8 * sg + j) * SC_ROW + SC_W + 256 * d + k * 4); } \
        { const int t = C.tid >> 3, k0 = (C.tid & 7) * 8; const unsigned char* rp = rec0 + (long)sgn * t * SC_ROW; \
          ukk = *(const u32x4*)(rp + SC_KK + k0 * 2); ub = *(const u32x4*)(rp + SC_B + 256 * d + k0 * 2); ukr = *(const u32x4*)(rp + SC_KR + 256 * d + k0 * 2); ur = *(const u32x4*)(rp + SC_R + k0 * 2); uv = *(const u32x4*)(rp + SC_V + k0 * 2); } } while (0)
    if ((int)blockIdx.x < CS_UNITS * CS_NCH) CSA_LOAD((int)blockIdx.x);
    for (int cu = blockIdx.x; cu < CS_UNITS * CS_NCH; cu += C.G) {
        LAS float* csf = (LAS float*)(L + CS_M2F);
        LAS float* seg = (LAS float*)(L + CS_N2);
        { const int k = C.tid & 63, sg = C.tid >> 6;
#pragma unroll
          for (int j = 1; j < 8; ++j) lwv[j] += lwv[j - 1];
          seg[sg * 64 + k] = lwv[7];
          CS_BAR();
          float off = 0.f, tot = 0.f;
#pragma unroll
          for (int s2 = 0; s2 < 8; ++s2) { const float v = seg[s2 * 64 + k]; off += (s2 < sg) ? v : 0.f; tot += v; }
#pragma unroll
          for (int j = 0; j < 8; ++j) csf[(8 * sg + j) * 65 + k] = lwv[j] + off;
          if (sg == 7) ((LAS float*)(L + CS_GL))[k] = __expf(tot); }
        CS_BAR();
        { const int t = C.tid >> 3, k0 = (C.tid & 7) * 8;
          float wt[8], kb[8], bb[8], rt[8], bh[8], kh[8];
#pragma unroll
          for (int j = 0; j < 8; ++j) { const unsigned pkk = j < 2 ? ukk.x : j < 4 ? ukk.y : j < 6 ? ukk.z : ukk.w, pb = j < 2 ? ub.x : j < 4 ? ub.y : j < 6 ? ub.z : ub.w, pkr = j < 2 ? ukr.x : j < 4 ? ukr.y : j < 6 ? ukr.z : ukr.w, pr = j < 2 ? ur.x : j < 4 ? ur.y : j < 6 ? ur.z : ur.w;
              const float kkv = (j & 1) ? bfhi(pkk) : bflo(pkk), bv = (j & 1) ? bfhi(pb) : bflo(pb), krv = (j & 1) ? bfhi(pkr) : bflo(pkr), rv = (j & 1) ? bfhi(pr) : bflo(pr);
              const float cst = csf[t * 65 + k0 + j], csp = t > 0 ? csf[(t - 1) * 65 + k0 + j] : 0.f, csl = csf[63 * 65 + k0 + j];
              const float einv = __expf(-cst), el = __expf(csl - cst);
              wt[j] = kkv * __expf(csp); kb[j] = krv * einv; bb[j] = bv * einv; rt[j] = rv * __expf(cst); bh[j] = bv * el; kh[j] = krv * el; }
          u32x4 o;
          o.x = pk2(wt[0], wt[1]); o.y = pk2(wt[2], wt[3]); o.z = pk2(wt[4], wt[5]); o.w = pk2(wt[6], wt[7]); *(LAS u32x4*)(L + CS_WT + t * (CSP * 2) + k0 * 2) = o;
          o.x = pk2(kb[0], kb[1]); o.y = pk2(kb[2], kb[3]); o.z = pk2(kb[4], kb[5]); o.w = pk2(kb[6], kb[7]); *(LAS u32x4*)(L + CS_KB + t * (CSP * 2) + k0 * 2) = o;
          o.x = pk2(bb[0], bb[1]); o.y = pk2(bb[2], bb[3]); o.z = pk2(bb[4], bb[5]); o.w = pk2(bb[6], bb[7]); *(LAS u32x4*)(L + CS_BB + t * (CSP * 2) + k0 * 2) = o;
          o.x = pk2(rt[0], rt[1]); o.y = pk2(rt[2], rt[3]); o.z = pk2(rt[4], rt[5]); o.w = pk2(rt[6], rt[7]); *(LAS u32x4*)(L + CS_RT + t * (CSP * 2) + k0 * 2) = o;
#pragma unroll
          for (int j = 0; j < 8; ++j) { const int to = ((((t >> 3) ^ ((k0 >> 3) & 7)) * 8) + (t & 7)) * 2;
              *(LAS bf16_t*)(L + CS_BHT + (k0 + j) * (CSP * 2) + to) = (bf16_t)f2bf(bh[j]); *(LAS bf16_t*)(L + CS_KHT + (k0 + j) * (CSP * 2) + to) = (bf16_t)f2bf(kh[j]);
              const unsigned pv = j < 2 ? uv.x : j < 4 ? uv.y : j < 6 ? uv.z : uv.w; *(LAS bf16_t*)(L + CS_VMT + (k0 + j) * (CSP * 2) + to) = (bf16_t)((j & 1) ? (pv >> 16) : (pv & 0xffffu)); } }
        if (cu + C.G < CS_UNITS * CS_NCH) CSA_LOAD(cu + C.G);
        CS_BAR();
        for (int job = C.wave; job < 12; job += NWAVES) { const int p = job >> 2, ti = (job >> 1) & 1, tj = job & 1;
            f32x16 acc;
#pragma unroll
            for (int i = 0; i < 16; ++i) acc[i] = 0.f;
            if (p == 0) { cs_mma(acc, L + CS_WT, L + CS_BB, ti, tj, r32, hi);
                const int i = tj * 32 + r32; LAS float* mp = (LAS float*)(L + CS_M2F) + i * 64;
#pragma unroll
                for (int reg = 0; reg < 16; ++reg) { const int t = ti * 32 + crow(reg, hi); mp[(t & 3) * 16 + (t >> 2)] = (i < t) ? acc[reg] : 0.f; } }
            else if (p == 1) { cs_mma(acc, L + CS_WT, L + CS_KB, ti, tj, r32, hi);
                const int i = tj * 32 + r32;
#pragma unroll
                for (int reg = 0; reg < 16; ++reg) { const int t = ti * 32 + crow(reg, hi); acc[reg] = (i < t) ? acc[reg] : 0.f; }
                cs_store_t(L + CS_M1T, acc, ti, tj, r32, hi); }
            else { cs_mma(acc, L + CS_BB, L + CS_RT, ti, tj, r32, hi);
                const int t = tj * 32 + r32;
#pragma unroll
                for (int reg = 0; reg < 16; ++reg) { const int i = ti * 32 + crow(reg, hi); acc[reg] = (i <= t) ? acc[reg] : 0.f; }
                cs_store_t(L + CS_N2, acc, ti, tj, r32, hi); } }
        CS_BAR();
        { const int c = C.tid >> 2, q = C.tid & 3; float acc[16];
          { const LAS unsigned char* rcol = (c < 64) ? (L + CS_WT + c * 2) : (L + CS_M1T + (c - 64) * (CSP * 2)); const int rstride = (c < 64) ? CSP * 2 : 2;
#pragma unroll
            for (int j = 0; j < 16; ++j) acc[j] = bf2f(*(const LAS bf16_t*)(rcol + (4 * j + q) * rstride)); }
          const LAS float* m2c = (const LAS float*)(L + CS_M2F) + q * 16;
#pragma clang loop unroll(full)
          for (int i = 0; i < 64; ++i) {
              const float mine = -acc[i >> 2];
              float gi;
              switch (i & 3) { case 0: gi = __uint_as_float((unsigned)__builtin_amdgcn_update_dpp(0, (int)__float_as_uint(mine), 0x00, 0xF, 0xF, true)); break;
                               case 1: gi = __uint_as_float((unsigned)__builtin_amdgcn_update_dpp(0, (int)__float_as_uint(mine), 0x55, 0xF, 0xF, true)); break;
                               case 2: gi = __uint_as_float((unsigned)__builtin_amdgcn_update_dpp(0, (int)__float_as_uint(mine), 0xAA, 0xF, 0xF, true)); break;
                               default: gi = __uint_as_float((unsigned)__builtin_amdgcn_update_dpp(0, (int)__float_as_uint(mine), 0xFF, 0xF, 0xF, true)); break; }
#pragma unroll
              for (int j4 = (i >> 4); j4 < 4; ++j4) { const f32x4 m = *(const LAS f32x4*)(m2c + i * 64 + j4 * 4);
#pragma unroll
                  for (int e = 0; e < 4; ++e) if (4 * j4 + e >= (i >> 2)) acc[4 * j4 + e] += m[e] * gi; }
          }
#pragma unroll
          for (int j = 0; j < 16; ++j) *(LAS bf16_t*)(L + CS_GT + c * (CSP * 2) + (4 * j + q) * 2) = (bf16_t)f2bf(-acc[j]); }
        CS_BAR();
        unsigned char* outp = CHK + (size_t)cu * 32768;
        for (int job = C.wave; job < 16; job += NWAVES) { const int p = job >> 2, ti = (job >> 1) & 1, tj = job & 1;
            f32x16 acc;
            if (p == 0) {
                const LAS unsigned char* rp = L + CS_RT + (tj * 32 + r32) * (CSP * 2) + (ti * 32 + 4 * hi) * 2;
#pragma unroll
                for (int g = 0; g < 4; ++g) { const u32x2 u = *(const LAS u32x2*)(rp + g * 16); acc[4 * g] = bflo(u.x); acc[4 * g + 1] = bfhi(u.x); acc[4 * g + 2] = bflo(u.y); acc[4 * g + 3] = bfhi(u.y); }
                cs_mma(acc, L + CS_GT, L + CS_N2, ti, tj, r32, hi);
#pragma unroll
                for (int g = 0; g < 4; ++g) { u32x2 o; o.x = pk2(acc[4 * g], acc[4 * g + 1]); o.y = pk2(acc[4 * g + 2], acc[4 * g + 3]);
                    *(u32x2*)(outp + 8192 + (((tj * 4 + 2 * ti + (g >> 1)) * 64 + (g & 1) * 32 + r32) * 16) + hi * 8) = o; } }
            else if (p == 1) {
#pragma unroll
                for (int i = 0; i < 16; ++i) acc[i] = 0.f;
                cs_mma(acc, L + CS_KB, L + CS_RT, ti, tj, r32, hi);
                const int t = tj * 32 + r32;
#pragma unroll
                for (int reg = 0; reg < 16; ++reg) { const int i = ti * 32 + crow(reg, hi); acc[reg] = (i <= t) ? acc[reg] : 0.f; }
                cs_mma(acc, L + CS_GT + 64 * (CSP * 2), L + CS_N2, ti, tj, r32, hi);
                cs_store_t(L + CS_Z, acc, ti, tj, r32, hi); }
            else if (p == 2) {
#pragma unroll
                for (int i = 0; i < 16; ++i) acc[i] = 0.f;
                cs_mma<true>(acc, L + CS_GT, L + CS_BHT, ti, tj, r32, hi);
                const int k = tj * 32 + r32; const float gl = ((const LAS float*)(L + CS_GL))[k];
#pragma unroll
                for (int reg = 0; reg < 16; ++reg) { const int cc = ti * 32 + crow(reg, hi); acc[reg] += (cc == k) ? gl : 0.f; }
#pragma unroll
                for (int g = 0; g < 4; ++g) { u32x2 o; o.x = pk2(acc[4 * g], acc[4 * g + 1]); o.y = pk2(acc[4 * g + 2], acc[4 * g + 3]);
                    *(u32x2*)(outp + (((tj * 4 + 2 * ti + (g >> 1)) * 64 + (g & 1) * 32 + r32) * 16) + hi * 8) = o; } }
            else {
                const int krow = tj * 32 + r32; const LAS unsigned char* kp = L + CS_KHT + krow * (CSP * 2) + hi * 8;
#pragma unroll
                for (int g = 0; g < 4; ++g) { const u32x2 u = *(const LAS u32x2*)(kp + (((ti * 4 + g) ^ ((krow >> 3) & 7)) * 16)); acc[4 * g] = bflo(u.x); acc[4 * g + 1] = bfhi(u.x); acc[4 * g + 2] = bflo(u.y); acc[4 * g + 3] = bfhi(u.y); }
                cs_mma<true>(acc, L + CS_GT + 64 * (CSP * 2), L + CS_BHT, ti, tj, r32, hi);
                cs_store_t(L + CS_U, acc, ti, tj, r32, hi); } }
        CS_BAR();
        { const int p = C.wave >> 2, ti = (C.wave >> 1) & 1, tj = C.wave & 1;
          f32x16 acc;
#pragma unroll
          for (int i = 0; i < 16; ++i) acc[i] = 0.f;
          cs_mma<true>(acc, L + (p ? CS_U : CS_Z), L + CS_VMT, ti, tj, r32, hi);
          unsigned char* op = outp + (p ? 16384 : 24576) + ((ti * 2 + tj) * 64 + C.lane) * 32;
          u32x4 o0, o1; o0.x = pk2(acc[0], acc[1]); o0.y = pk2(acc[2], acc[3]); o0.z = pk2(acc[4], acc[5]); o0.w = pk2(acc[6], acc[7]);
          o1.x = pk2(acc[8], acc[9]); o1.y = pk2(acc[10], acc[11]); o1.z = pk2(acc[12], acc[13]); o1.w = pk2(acc[14], acc[15]);
          *(u32x4*)op = o0; *(u32x4*)(op + 16) = o1; }
        CS_BAR();
    }
}
__device__ __forceinline__ void phase_csb(const Ctx& C, const Args& A, int l) {
    if ((int)blockIdx.x >= CS_UNITS) { conv_items(C, A, l + 1, ((int)blockIdx.x - CS_UNITS) * NWAVES + C.wave, (C.G - CS_UNITS) * NWAVES, true, false, true); return; }
    const unsigned char* CHK = A.ws + WS_CHK;
    LAS unsigned char* L = C.lds;
    const int r32 = C.lane & 31, hi = C.lane >> 5;
    const bool isS = C.wave < 4; const int ti = (C.wave >> 1) & 1, tj = C.wave & 1;
    for (int unit = blockIdx.x; unit < CS_UNITS; unit += C.G) {
        const int d = unit & 1, h = (unit >> 1) % 12, b = unit / 24;
        float* Y = (float*)(A.ws + WS_Y) + (size_t)d * MROWS * 768;
        for (int i = C.tid; i < 2 * CS_MAT / 4; i += NTHR) ((LAS unsigned*)L)[i] = 0u;
        CS_BAR();
        bf16x8 afA[4], afB[4], afC[4]; u32x4 cA0, cA1, cB0, cB1, cC0, cC1;
#define CSB_LOAD(A4, C0, C1, ch_) do { const unsigned char* op_ = CHK + ((size_t)unit * CS_NCH + (ch_)) * 32768; \
            const unsigned char* am_ = op_ + (isS ? 0 : 8192) + (ti * 4 * 64 + C.lane) * 16;     \
            _Pragma("unroll") for (int ks = 0; ks < 4; ++ks) A4[ks] = *(const bf16x8*)(am_ + ks * 1024); \
            const unsigned char* cp_ = op_ + (isS ? 16384 : 24576) + ((ti * 2 + tj) * 64 + C.lane) * 32; C0 = *(const u32x4*)cp_; C1 = *(const u32x4*)(cp_ + 16); } while (0)
#define CSB_STEP(A4, C0, C1, ch_) do { \
            const LAS unsigned char* Sb = L + ((ch_) & 1) * CS_MAT; LAS unsigned char* Sn = L + (((ch_) + 1) & 1) * CS_MAT; \
            f32x16 acc; \
            acc[0] = bflo(C0.x); acc[1] = bfhi(C0.x); acc[2] = bflo(C0.y); acc[3] = bfhi(C0.y); acc[4] = bflo(C0.z); acc[5] = bfhi(C0.z); acc[6] = bflo(C0.w); acc[7] = bfhi(C0.w); \
            acc[8] = bflo(C1.x); acc[9] = bfhi(C1.x); acc[10] = bflo(C1.y); acc[11] = bfhi(C1.y); acc[12] = bflo(C1.z); acc[13] = bfhi(C1.z); acc[14] = bflo(C1.w); acc[15] = bfhi(C1.w); \
            const LAS unsigned char* bp = Sb + (tj * 32 + r32) * (CSP * 2) + hi * 16; \
            _Pragma("unroll") for (int ks = 0; ks < 4; ++ks) acc = __builtin_amdgcn_mfma_f32_32x32x16_bf16(A4[ks], *(const LAS bf16x8*)(bp + ks * 32), acc, 0, 0, 0); \
            if (isS) { cs_store_t(Sn, acc, ti, tj, r32, hi); }     \
            else {     \
                const int step0 = (ch_) * CS_L; const int sgn = d ? -1 : 1; \
                const int row0 = (step0 < CTXL) ? (NLAT + b * CTXL + (d ? CTXL - 1 - step0 : step0)) : (b * TT + (d ? TT - 1 - (step0 - CTXL) : step0 - CTXL)); \
                float* yp = Y + (size_t)(row0 + sgn * (ti * 32 + 4 * hi)) * 768 + h * 64 + tj * 32 + r32; const long ys = (long)sgn * 768; \
                _Pragma("unroll") for (int reg = 0; reg < 16; ++reg) yp[ys * ((reg & 3) + 8 * (reg >> 2))] = acc[reg]; } \
            CS_BAR(); } while (0)
        CSB_LOAD(afA, cA0, cA1, 0); CSB_LOAD(afB, cB0, cB1, 1);
        static_assert(CS_NCH % 3 == 0, "chunk loop is unrolled by three");
        for (int ch = 0; ch < CS_NCH; ch += 3) {
            if (ch == 0) CSB_LOAD(afC, cC0, cC1, 2);
            CSB_STEP(afA, cA0, cA1, ch);     if (ch + 3 < CS_NCH) CSB_LOAD(afA, cA0, cA1, ch + 3);
            CSB_STEP(afB, cB0, cB1, ch + 1); if (ch + 4 < CS_NCH) CSB_LOAD(afB, cB0, cB1, ch + 4);
            CSB_STEP(afC, cC0, cC1, ch + 2); if (ch + 5 < CS_NCH) CSB_LOAD(afC, cC0, cC1, ch + 5);
        }
        CS_BAR();
    }
#undef CSB_LOAD
#undef CSB_STEP
}

#undef CS_BAR
__device__ __forceinline__ void phase_ef2(const Ctx& C, const Args& A, int l) {
    const int i2 = l >> 1; unsigned char* ws = A.ws;
    const unsigned char* SCN = ws + WS_SCN; const float* Y0 = (const float*)(ws + WS_Y); const float* Y1 = Y0 + (size_t)MROWS * 768;
    const bf16_t* G = (const bf16_t*)(ws + WS_G); bf16_t* A2 = (bf16_t*)(ws + WS_A2);
    const float* rb = A.in[I_RBON] + (size_t)i2 * 768; const float* gg = A.in[I_GNG] + (size_t)i2 * 768; const float* gb = A.in[I_GNB] + (size_t)i2 * 768;
    for (int row = C.gw; row < MROWS; row += C.NGW) {
#pragma unroll
        for (int it = 0; it < 3; ++it) {
            const int c = it * 256 + 4 * C.lane, head = c >> 6, kx = c & 63;
            const f32x4 y = *(const f32x4*)(Y0 + (size_t)row * 768 + c) + *(const f32x4*)(Y1 + (size_t)row * 768 + c);
            const float mean = sum16((y[0] + y[1]) + (y[2] + y[3])) * (1.f / 64.f);
            const f32x4 dd = y - mean;
            const float var = sum16((dd[0] * dd[0] + dd[1] * dd[1]) + (dd[2] * dd[2] + dd[3] * dd[3])) * (1.f / 64.f);
            const float rstd = rsqrtf(var + GN_EPS);
            const unsigned char* base = SCN + (size_t)(row * 12 + head) * SC_REC + kx * 2;
            const f32x4 r = ld4bf_(base + SC_R), v = ld4bf_(base + SC_V), k0 = ld4bf_(base + SC_KR), k1 = ld4bf_(base + SC_KR + 256);
            const f32x4 rb4 = *(const f32x4*)(rb + c);
            const f32x4 t = r * (k0 + k1) * 0.5f * rb4;
            const float bs = sum16((t[0] + t[1]) + (t[2] + t[3]));
            const f32x4 yn = dd * rstd * *(const f32x4*)(gg + c) + *(const f32x4*)(gb + c);
            const f32x4 g = ld4bf(G + (size_t)row * 768 + c);
            st4bf(A2 + (size_t)row * DM + 256 + c, g * (yn + v * bs));
        }
    }
}

__device__ __forceinline__ void phase_of1(const Ctx& C, const Args& A, int l) {
    const int i2 = l >> 1; unsigned char* ws = A.ws;
    const bf16_t* P = (const bf16_t*)(ws + WS_P); bf16_t* A2 = (bf16_t*)(ws + WS_A2); bf16_t* VT = (bf16_t*)(ws + WS_VT);
    const float* lng = A.in[I_GLNG] + (size_t)i2 * 256; const float* lnb = A.in[I_GLNB] + (size_t)i2 * 256;
    const float* gws = A.in[I_GWS] + (size_t)i2 * 4 * 128 * 128; const float* gbs = A.in[I_GBS] + (size_t)i2 * 4 * 128;
    LAS bf16_t* vt = (LAS bf16_t*)C.lds;
    LAS bf16_t* uL = (LAS bf16_t*)C.lds;
    LAS bf16_t* vT = (LAS bf16_t*)(C.lds + 128 * 528);
    const int r32 = C.lane & 31, hi = C.lane >> 5;
    for (int it = blockIdx.x; it < 256 + 8 * 7; it += C.G) {
        const bool isctx = it >= 256; const int uc = isctx ? (it - 256) / 7 : 0, pc = isctx ? (it - 256) % 7 : 0; const int u = it;
        const int b = isctx ? (uc >> 1) : (u >> 6), pos0 = isctx ? (uc & 1) * 128 : (u & 63) * 128;
        const int row0 = isctx ? NLAT + b * CTXL + pos0 : b * TT + pos0, L0 = isctx ? pos0 : CTXL + pos0;
        const int hh0 = isctx ? pc : 0, hh1 = isctx ? (pc < 6 ? pc + 1 : 0) : 6; const bool doC = !isctx || pc == 6;
        for (int hh = hh0; hh < hh1; ++hh) {
#pragma unroll
            for (int i = 0; i < 4; ++i) { const int piece = C.tid + NTHR * i, r = piece >> 4, part = piece & 15;
                *(LAS u32x4*)(vt + r * 136 + part * 8) = *(const u32x4*)(P + (size_t)(row0 + r) * P_LD + 1536 + hh * 128 + part * 8); }
            __syncthreads();
#pragma unroll
            for (int i = 0; i < 4; ++i) { const int item = C.tid + NTHR * i, d = item >> 4, tg = item & 15; const LAS bf16_t* s = vt + (tg * 8) * 136 + d;
                u32x4 o; o.x = (unsigned)s[0] | ((unsigned)s[136] << 16); o.y = (unsigned)s[2 * 136] | ((unsigned)s[3 * 136] << 16);
                o.z = (unsigned)s[4 * 136] | ((unsigned)s[5 * 136] << 16); o.w = (unsigned)s[6 * 136] | ((unsigned)s[7 * 136] << 16);
                *(u32x4*)(VT + ((size_t)(b * 6 + hh) * 128 + d) * LKEYS + L0 + tg * 8) = o; }
            __syncthreads();
        }
        if (doC) {
        for (int r = C.wave; r < 128; r += NWAVES) {
            const int c4 = 4 * C.lane; const bf16_t* pr = P + (size_t)(row0 + r) * P_LD + 2304;
            const f32x4 ur = ld4bf(pr + c4), raw = ld4bf(pr + 256 + c4);
            { const f32x4 gu = {gelu_erf(ur[0]), gelu_erf(ur[1]), gelu_erf(ur[2]), gelu_erf(ur[3])}; u32x2 o; o.x = pk2(gu[0], gu[1]); o.y = pk2(gu[2], gu[3]); *(LAS u32x2*)(uL + r * 264 + c4) = o; }
            const f32x4 gv = {gelu_erf(raw[0]), gelu_erf(raw[1]), gelu_erf(raw[2]), gelu_erf(raw[3])};
            const float mean = wave_sum((gv[0] + gv[1]) + (gv[2] + gv[3])) * (1.f / 256.f); const f32x4 dd = gv - mean;
            const float var = wave_sum((dd[0] * dd[0] + dd[1] * dd[1]) + (dd[2] * dd[2] + dd[3] * dd[3])) * (1.f / 256.f); const float rstd = rsqrtf(var + LN_EPS);
            const f32x4 o = dd * rstd * *(const f32x4*)(lng + c4) + *(const f32x4*)(lnb + c4);
#pragma unroll
            for (int k = 0; k < 4; ++k) vT[(c4 + k) * 136 + r] = (bf16_t)f2bf(o[k]);
        }
        __syncthreads();
        {
            const int g = C.wave >> 1, cblk = C.wave & 1, cc = g * 64 + cblk * 32 + r32;
            for (int pblk = 0; pblk < 4; ++pblk) {
                f32x16 acc;
#pragma unroll
                for (int i = 0; i < 16; ++i) acc[i] = 0.f;
                const float* wrow = gws + ((size_t)g * 128 + pblk * 32 + r32) * 128 + 8 * hi;
#pragma unroll
                for (int ks = 0; ks < 8; ++ks) { const f32x4 w0 = *(const f32x4*)(wrow + ks * 16), w1 = *(const f32x4*)(wrow + ks * 16 + 4);
                    u32x4 au; au.x = pk2(w0[0], w0[1]); au.y = pk2(w0[2], w0[3]); au.z = pk2(w1[0], w1[1]); au.w = pk2(w1[2], w1[3]);
                    const bf16x8 bf = *(const LAS bf16x8*)(vT + cc * 136 + ks * 16 + 8 * hi);
                    acc = __builtin_amdgcn_mfma_f32_32x32x16_bf16(__builtin_bit_cast(bf16x8, au), bf, acc, 0, 0, 0); }
#pragma unroll
                for (int reg = 0; reg < 16; ++reg) { const int p = pblk * 32 + crow(reg, hi);
                    const float uu = bf2f(uL[p * 264 + cc]); const float mixed = acc[reg] + gbs[g * 128 + p];
                    uL[p * 264 + cc] = (bf16_t)f2bf(uu * mixed); }
            }
        }
        __syncthreads();
#pragma unroll
        for (int i = 0; i < 8; ++i) { const int piece = C.tid + NTHR * i, r = piece >> 5, part = piece & 31;
            *(u32x4*)(A2 + (size_t)(row0 + r) * DM + 768 + part * 8) = *(const LAS u32x4*)(uL + r * 264 + part * 8); }
        __syncthreads();
        }
    }
}

__device__ __forceinline__ void phase_attn(const Ctx& C, const Args& A, int l) {
    const int i2 = l >> 1; unsigned char* ws = A.ws;
    const bf16_t* Q = (const bf16_t*)(ws + WS_Q); const bf16_t* KA = (const bf16_t*)(ws + WS_KA); const bf16_t* VT = (const bf16_t*)(ws + WS_VT); bf16_t* A2 = (bf16_t*)(ws + WS_A2);
    const float lam_init = 0.8f - 0.6f * expf(-0.3f * (float)l);
    float s1 = 0.f, s2 = 0.f;
    for (int j = 0; j < 64; ++j) { s1 += A.in[I_LQ1][i2 * 64 + j] * A.in[I_LK1][i2 * 64 + j]; s2 += A.in[I_LQ2][i2 * 64 + j] * A.in[I_LK2][i2 * 64 + j]; }
    const float lam = expf(s1) - expf(s2) + lam_init;
    const float* subg = A.in[I_SUBG] + (size_t)i2 * 128;
    const int r32 = C.lane & 31, hi = C.lane >> 5, map = C.wave >> 2, qw = C.wave & 3;
    LAS unsigned char* Kt = C.lds; LAS unsigned char* Vt = C.lds + 2 * 16384; LAS float* xch = (LAS float*)C.lds;
    const int NU = 1536 + (l == 1 ? 48 : 0);
    for (int n = C.vcu; n < NU; n += C.G) {
        int bh, qt; bool isctx = false;
        if (n < 1536) { const int round = n >> 8, slot = n & 255; bh = (slot >> 5) * 3 + (round >> 1); qt = (round & 1) * 32 + (slot & 31); }
        else { isctx = true; bh = (n - 1536) >> 1; qt = (n - 1536) & 1; }
        const int b = bh / 6, h = bh % 6;
        const int qrow0 = isctx ? NLAT + b * CTXL + qt * 128 : b * TT + qt * 128;
        const int NT = isctx ? CTXL / 64 : LKEYS / 64;
        const bf16_t* Kb = KA + (size_t)b * LKEYS * 768 + h * 128;
        const bf16_t* Vb = VT + (size_t)(b * 6 + h) * 128 * LKEYS;
        bf16x8 qf[4];
        { const bf16_t* qp = Q + (size_t)(qrow0 + qw * 32 + r32) * 768 + h * 128 + map * 64 + 8 * hi;
#pragma unroll
          for (int ks = 0; ks < 4; ++ks) qf[ks] = *(const bf16x8*)(qp + ks * 16); }
        f32x16 O[4];
#pragma unroll
        for (int d = 0; d < 4; ++d)
#pragma unroll
            for (int i = 0; i < 16; ++i) O[d][i] = 0.f;
        float m = 0.f, lsum = 0.f;
        unsigned ksrc[2], vsrc[2];
#pragma unroll
        for (int i = 0; i < 2; ++i) { const int row = 4 * (2 * C.wave + i) + (C.lane >> 4), x = row & 15, pi = x < 4 ? x : x < 8 ? x + 4 : x < 12 ? x - 4 : x;
            ksrc[i] = (unsigned)(((row & ~15) + pi) * 768 + (((C.lane & 15) ^ x) * 8));
            const int d = 8 * (2 * C.wave + i) + (C.lane >> 3); vsrc[i] = (unsigned)(d * LKEYS + (((C.lane & 7) ^ ((d >> 1) & 7)) * 8)); }
#define AT_DMA_K(tt, slot) do { _Pragma("unroll") for (int i = 0; i < 2; ++i) __builtin_amdgcn_global_load_lds((const unsigned*)(Kb + (size_t)(tt) * 64 * 768 + ksrc[i]), (LAS unsigned*)(Kt + (slot) * 16384 + (2 * C.wave + i) * 1024), 16, 0, 0); } while (0)
#define AT_DMA_V(tt, slot) do { _Pragma("unroll") for (int i = 0; i < 2; ++i) __builtin_amdgcn_global_load_lds((const unsigned*)(Vb + (size_t)(tt) * 64 + vsrc[i]), (LAS unsigned*)(Vt + (slot) * 16384 + (2 * C.wave + i) * 1024), 16, 0, 0); } while (0)
#define AT_BAR() asm volatile("s_waitcnt vmcnt(0) lgkmcnt(0)\n\ts_barrier" ::: "memory")
#define AT_SB() __builtin_amdgcn_sched_barrier(0)
        const int ksw = r32 & 15, vsw = (r32 >> 1) & 7;
#define AT_QK(P0, P1, ks_) do { const float nm_ = -m; _Pragma("unroll") for (int i = 0; i < 16; ++i) { P0[i] = nm_; P1[i] = nm_; } \
            const LAS unsigned char* kbp_ = Kt + (ks_) * 16384 + r32 * 256; \
            _Pragma("unroll") for (int ks = 0; ks < 4; ++ks) { const int co_ = ((map * 8 + ks * 2 + hi) ^ ksw) * 16; \
                P0 = __builtin_amdgcn_mfma_f32_32x32x16_bf16(*(const LAS bf16x8*)(kbp_ + co_), qf[ks], P0, 0, 0, 0); P1 = __builtin_amdgcn_mfma_f32_32x32x16_bf16(*(const LAS bf16x8*)(kbp_ + 32 * 256 + co_), qf[ks], P1, 0, 0, 0); } } while (0)
#define AT_LDV(dst, vs_, d) do { _Pragma("unroll") for (int kst = 0; kst < 4; ++kst) dst[kst] = *(const LAS u32x4*)(Vt + (vs_) * 16384 + ((d) * 32 + r32) * 128 + (((kst * 2 + hi) ^ vsw) * 16)); } while (0)
#define AT_PV(src, d) do { _Pragma("unroll") for (int kst = 0; kst < 4; ++kst) O[d] = __builtin_amdgcn_mfma_f32_32x32x16_bf16(__builtin_bit_cast(bf16x8, src[kst]), pb[kst], O[d], 0, 0, 0); } while (0)
#define AT_SOFTPV(P0, P1, N0, N1, first, hasn, vs_) do { \
            asm volatile("s_nop 15\n\ts_nop 7" : "+v"(P0), "+v"(P1)); \
            float mx = max3f(P0[0], P0[1], P1[0]), mx2 = max3f(P0[2], P0[3], P1[1]); mx = max3f(mx, P1[2], P1[3]); \
            _Pragma("unroll") for (int i = 4; i < 16; i += 4) { mx = max3f(mx, P0[i], P0[i + 1]); mx2 = max3f(mx2, P0[i + 2], P0[i + 3]); mx = max3f(mx, P1[i], P1[i + 1]); mx2 = max3f(mx2, P1[i + 2], P1[i + 3]); } \
            mx = fmaxf(mx, mx2); \
            { auto rr = __builtin_amdgcn_permlane32_swap(__float_as_uint(mx), __float_as_uint(mx), false, false); mx = fmaxf(__uint_as_float(rr[0]), __uint_as_float(rr[1])); } \
            if ((first) || __any(mx > 8.f)) { const float dl = (first) ? mx : fmaxf(mx, 0.f); const float sc = __builtin_amdgcn_exp2f(-dl); lsum *= sc; \
                _Pragma("unroll") for (int d = 0; d < 4; ++d) _Pragma("unroll") for (int i = 0; i < 16; ++i) O[d][i] *= sc; \
                _Pragma("unroll") for (int i = 0; i < 16; ++i) { P0[i] -= dl; P1[i] -= dl; } \
                if (hasn) { asm volatile("s_nop 15\n\ts_nop 7" : "+v"(N0), "+v"(N1)); _Pragma("unroll") for (int i = 0; i < 16; ++i) { N0[i] -= dl; N1[i] -= dl; } } \
                m += dl; } \
            float ps = 0.f, ps2 = 0.f; \
            _Pragma("unroll") for (int i = 0; i < 16; ++i) { P0[i] = __builtin_amdgcn_exp2f(P0[i]); P1[i] = __builtin_amdgcn_exp2f(P1[i]); ps += P0[i]; ps2 += P1[i]; } \
            lsum += ps + ps2; \
            bf16x8 pb[4]; \
            { u32x4 w; w.x = pk2(P0[0], P0[1]); w.y = pk2(P0[2], P0[3]); w.z = pk2(P0[4], P0[5]); w.w = pk2(P0[6], P0[7]); pb[0] = __builtin_bit_cast(bf16x8, w); \
              w.x = pk2(P0[8], P0[9]); w.y = pk2(P0[10], P0[11]); w.z = pk2(P0[12], P0[13]); w.w = pk2(P0[14], P0[15]); pb[1] = __builtin_bit_cast(bf16x8, w); \
              w.x = pk2(P1[0], P1[1]); w.y = pk2(P1[2], P1[3]); w.z = pk2(P1[4], P1[5]); w.w = pk2(P1[6], P1[7]); pb[2] = __builtin_bit_cast(bf16x8, w); \
              w.x = pk2(P1[8], P1[9]); w.y = pk2(P1[10], P1[11]); w.z = pk2(P1[12], P1[13]); w.w = pk2(P1[14], P1[15]); pb[3] = __builtin_bit_cast(bf16x8, w); } \
            u32x4 va[4]; \
            AT_LDV(va, vs_, 0); AT_SB(); AT_PV(va, 0); AT_SB(); AT_LDV(va, vs_, 1); AT_SB(); AT_PV(va, 1); AT_SB(); AT_LDV(va, vs_, 2); AT_SB(); AT_PV(va, 2); AT_SB(); AT_LDV(va, vs_, 3); AT_SB(); AT_PV(va, 3); AT_SB(); } while (0)
        f32x16 pA0, pA1, pB0, pB1;
        AT_DMA_K(0, 0); AT_DMA_V(0, 0); AT_DMA_K(1, 1);
        AT_BAR();
        AT_QK(pA0, pA1, 0);
        asm volatile("s_waitcnt lgkmcnt(0)\n\ts_barrier" ::: "memory");
        for (int t = 0; t < NT; t += 2) {
            if (t + 2 < NT) AT_DMA_K(t + 2, 0);
            AT_DMA_V(t + 1, 1);
            AT_SB(); AT_QK(pB0, pB1, 1); AT_SB();
            AT_SOFTPV(pA0, pA1, pB0, pB1, t == 0, true, 0);
            AT_BAR();
            if (t + 3 < NT) AT_DMA_K(t + 3, 1);
            if (t + 2 < NT) AT_DMA_V(t + 2, 0);
            AT_SB(); if (t + 2 < NT) { AT_QK(pA0, pA1, 0); } AT_SB();
            AT_SOFTPV(pB0, pB1, pA0, pA1, false, t + 2 < NT, 1);
            AT_BAR();
        }
#undef AT_DMA_K
#undef AT_DMA_V
#undef AT_BAR
#undef AT_SB
#undef AT_QK
#undef AT_LDV
#undef AT_PV
#undef AT_SOFTPV
        const float ltot = lsum + __shfl_xor(lsum, 32);
        const float invl = 1.f / ltot;
        if (map == 1) { const float f = lam * invl;
#pragma unroll
            for (int d = 0; d < 4; ++d)
#pragma unroll
                for (int i = 0; i < 16; ++i) xch[(qw * 64 + d * 16 + i) * 64 + C.lane] = O[d][i] * f; }
        __syncthreads();
        if (map == 0) { float ss = 0.f;
#pragma unroll
            for (int d = 0; d < 4; ++d)
#pragma unroll
                for (int i = 0; i < 16; ++i) { const float o = O[d][i] * invl - xch[(qw * 64 + d * 16 + i) * 64 + C.lane]; O[d][i] = o; ss += o * o; }
            ss += __shfl_xor(ss, 32);
            const float rn = rsqrtf(ss * (1.f / 128.f) + RMS_EPS) * (1.f - lam_init);
            bf16_t* orow = A2 + (size_t)(qrow0 + qw * 32 + r32) * DM + h * 128;
#pragma unroll
            for (int d = 0; d < 4; ++d)
#pragma unroll
                for (int g4 = 0; g4 < 4; ++g4) { const int dd = 32 * d + 8 * g4 + 4 * hi; const f32x4 sg = *(const f32x4*)(subg + dd);
                    const f32x4 v = {O[d][4 * g4] * rn * sg[0], O[d][4 * g4 + 1] * rn * sg[1], O[d][4 * g4 + 2] * rn * sg[2], O[d][4 * g4 + 3] * rn * sg[3]};
                    st4bf(orow + dd, v); } }
        __syncthreads();
    }
}

__device__ __forceinline__ void phase_rt(const Ctx& C, const Args& A, int l) {
    unsigned char* ws = A.ws; float* X = (float*)(ws + WS_X); bf16_t* H = (bf16_t*)(ws + WS_H); float* AFF = (float*)(ws + WS_AFF);
    const float* MOD = (const float*)(ws + WS_MOD) + (size_t)l * 5 * 6144;
    const float* lng = A.in[I_LNG] + (size_t)(l * 2 + 0) * DM; const float* lnb = A.in[I_LNB] + (size_t)(l * 2 + 0) * DM;
    LAS float* wrs = (LAS float*)C.lds;
    { const float* wr = A.in[I_WR] + (size_t)l * DM * 16; for (int i = C.tid; i < DM * 16; i += NTHR) wrs[(i & 15) * 1024 + (i >> 4)] = wr[i]; }
    __syncthreads();
    f32x4 xn[4];
    if (C.gw < MROWS) {
#pragma unroll
        for (int j = 0; j < 4; ++j) xn[j] = *(const f32x4*)(X + (size_t)C.gw * DM + 4 * C.lane + 256 * j); }
    for (int row = C.gw; row < MROWS; row += C.NGW) {
        const float* md = MOD + row_mi(row) * 6144;
        f32x4 x[4]; float s = 0.f;
#pragma unroll
        for (int j = 0; j < 4; ++j) { x[j] = xn[j]; s += (x[j][0] + x[j][1]) + (x[j][2] + x[j][3]); }
        if (row + C.NGW < MROWS) {
#pragma unroll
            for (int j = 0; j < 4; ++j) xn[j] = *(const f32x4*)(X + (size_t)(row + C.NGW) * DM + 4 * C.lane + 256 * j); }
        const float mean = wave_sum(s) * (1.f / DM); float s2 = 0.f;
#pragma unroll
        for (int j = 0; j < 4; ++j) { x[j] = x[j] - mean; s2 += (x[j][0] * x[j][0] + x[j][1] * x[j][1]) + (x[j][2] * x[j][2] + x[j][3] * x[j][3]); }
        const float rstd = rsqrtf(wave_sum(s2) * (1.f / DM) + LN_EPS);
        float v[16];
#pragma unroll
        for (int e = 0; e < 16; ++e) v[e] = 0.f;
#pragma unroll
        for (int j = 0; j < 4; ++j) { const int col = 4 * C.lane + 256 * j;
            const f32x4 x1 = x[j] * rstd * *(const f32x4*)(lng + col) + *(const f32x4*)(lnb + col);
            *(f32x4*)(X + (size_t)row * DM + col) = x1;
            const f32x4 h = x1 * (*(const f32x4*)(md + 4 * DM + col) + 1.f) + *(const f32x4*)(md + 3 * DM + col);
            st4bf(H + (size_t)row * DM + col, h);
#pragma unroll
            for (int e = 0; e < 16; ++e) { const f32x4 w = *(const LAS f32x4*)(wrs + e * 1024 + col); v[e] += (h[0] * w[0] + h[1] * w[1]) + (h[2] * w[2] + h[3] * w[3]); }
            __builtin_amdgcn_sched_barrier(0); }
#pragma unroll
        for (int i = 0; i < 8; ++i) { const float send = (C.lane & 32) ? v[i] : v[i + 8], keep = (C.lane & 32) ? v[i + 8] : v[i]; v[i] = keep + __shfl_xor(send, 32); }
#pragma unroll
        for (int i = 0; i < 4; ++i) { const float send = (C.lane & 16) ? v[i] : v[i + 4], keep = (C.lane & 16) ? v[i + 4] : v[i]; v[i] = keep + __shfl_xor(send, 16); }
#pragma unroll
        for (int i = 0; i < 2; ++i) { const float send = (C.lane & 8) ? v[i] : v[i + 2], keep = (C.lane & 8) ? v[i + 2] : v[i]; v[i] = keep + __shfl_xor(send, 8); }
        { const float send = (C.lane & 4) ? v[0] : v[1], keep = (C.lane & 4) ? v[1] : v[0]; v[0] = keep + __shfl_xor(send, 4); }
        float z = v[0]; z += __shfl_xor(z, 1); z += __shfl_xor(z, 2);
        float mx = z;
#pragma unroll
        for (int o = 4; o < 64; o <<= 1) mx = fmaxf(mx, __shfl_xor(mx, o));
        const float ex = expf(z - mx); float sm = ex;
#pragma unroll
        for (int o = 4; o < 64; o <<= 1) sm += __shfl_xor(sm, o);
        if ((C.lane & 3) == 0) AFF[(size_t)row * 16 + (C.lane >> 2)] = ex / sm;
    }
}

__device__ __forceinline__ void phase_tk(const Ctx& C, const Args& A) {
    unsigned char* ws = A.ws; const float* AFF = (const float*)(ws + WS_AFF); int* SLOT = (int*)(ws + WS_SLOT); int* IDX = (int*)(ws + WS_IDX); float* GATE = (float*)(ws + WS_GATE);
    LAS unsigned* key = (LAS unsigned*)C.lds;
    LAS unsigned* hist = key + 8192;
    LAS unsigned* scn = hist + 256;
    LAS unsigned* wtot = scn + 256;
    LAS unsigned* bc = wtot + 8;
    for (int u = blockIdx.x; u < 128; u += C.G) {
        const bool isctx = u >= 64; const int uu = u & 63, b = uu >> 4, e = uu & 15;
        const int n = isctx ? CTXL : TT, cap = isctx ? CAP_C : CAP_L;
        const int row0 = isctx ? NLAT + b * CTXL : b * TT;
        const int slot0 = e * ESLOTS + (isctx ? 4 * CAP_L + b * CAP_C : b * CAP_L);
        for (int i = C.tid; i < n; i += NTHR) key[i] = __float_as_uint(AFF[(size_t)(row0 + i) * 16 + e]);
        unsigned prefix = 0u, pmask = 0u; int need = cap;
        for (int pass = 0; pass < 4; ++pass) {
            const int shift = 24 - 8 * pass;
            if (C.tid < 256) hist[C.tid] = 0u;
            __syncthreads();
            for (int i = C.tid; i < n; i += NTHR) { const unsigned k = key[i]; if ((k & pmask) == prefix) __hip_atomic_fetch_add(&hist[(k >> shift) & 255u], 1u, __ATOMIC_RELAXED, __HIP_MEMORY_SCOPE_WORKGROUP); }
            __syncthreads();
            if (C.tid < 256) scn[C.tid] = hist[C.tid];
            __syncthreads();
            for (int off = 1; off < 256; off <<= 1) {
                unsigned a = 0u; if (C.tid < 256 && C.tid + off < 256) a = scn[C.tid + off];
                __syncthreads();
                if (C.tid < 256) scn[C.tid] += a;
                __syncthreads();
            }
            if (C.tid < 256) { const unsigned above = (C.tid < 255) ? scn[C.tid + 1] : 0u;
                if (scn[C.tid] >= (unsigned)need && above < (unsigned)need) { bc[0] = (unsigned)C.tid; bc[1] = (unsigned)need - above; } }
            __syncthreads();
            prefix |= bc[0] << shift; pmask |= 255u << shift; need = (int)bc[1];
            __syncthreads();
        }
        const int per = (n + NTHR - 1) / NTHR; const int i0 = C.tid * per;
        unsigned cg = 0u, ce = 0u;
        for (int j = 0; j < per; ++j) { const int i = i0 + j; if (i < n) { const unsigned k = key[i]; cg += (k > prefix); ce += (k == prefix); } }
        unsigned pk = cg | (ce << 16), inc = pk;
#pragma unroll
        for (int o = 1; o < 64; o <<= 1) { const unsigned t = __shfl_up(inc, o); if (C.lane >= o) inc += t; }
        if (C.lane == 63) wtot[C.wave] = inc;
        __syncthreads();
        unsigned wbase = 0u;
        for (int w = 0; w < C.wave; ++w) wbase += wtot[w];
        const unsigned excl = wbase + inc - pk;
        unsigned rg = excl & 0xffffu, re = excl >> 16;
        const int ngt = cap - need;
        for (int j = 0; j < per; ++j) { const int i = i0 + j; if (i < n) { const unsigned k = key[i]; int pos = -1;
            if (k > prefix) { pos = (int)rg; ++rg; } else if (k == prefix) { if ((int)re < need) pos = ngt + (int)re; ++re; }
            const int row = row0 + i;
            if (pos >= 0) { IDX[slot0 + pos] = row; GATE[slot0 + pos] = __uint_as_float(k); SLOT[(size_t)row * 16 + e] = slot0 + pos; }
            else SLOT[(size_t)row * 16 + e] = -1; } }
        if (isctx && b == 0 && C.tid < ESLOTS - 4224) { IDX[e * ESLOTS + 4224 + C.tid] = 0; GATE[e * ESLOTS + 4224 + C.tid] = 0.f; }
        __syncthreads();
    }
}

__device__ __forceinline__ void phase_cb(const Ctx& C, const Args& A, int l) {
    unsigned char* ws = A.ws; float* X = (float*)(ws + WS_X); bf16_t* H = (bf16_t*)(ws + WS_H); const int* SLOT = (const int*)(ws + WS_SLOT); const bf16_t* YE = (const bf16_t*)(ws + WS_YE);
    const float* MOD = (const float*)(ws + WS_MOD) + (size_t)l * 5 * 6144; const float* MODN = MOD + 5 * 6144;
    const float* lng = A.in[I_LNG] + (size_t)(l * 2 + 1) * DM; const float* lnb = A.in[I_LNB] + (size_t)(l * 2 + 1) * DM;
    int svn = -1; f32x4 xn[4];
    if (C.gw < MROWS) { svn = SLOT[(size_t)C.gw * 16 + (C.lane & 15)];
#pragma unroll
        for (int j = 0; j < 4; ++j) xn[j] = *(const f32x4*)(X + (size_t)C.gw * DM + 4 * C.lane + 256 * j); }
    for (int row = C.gw; row < MROWS; row += C.NGW) {
        const int mi = row_mi(row); const float* md = MOD + mi * 6144;
        const int sv = svn;
        unsigned mask = (unsigned)__ballot(sv >= 0) & 0xffffu;
        f32x4 acc[4];
#pragma unroll
        for (int j = 0; j < 4; ++j) acc[j] = (f32x4){0.f, 0.f, 0.f, 0.f};
        u32x2 y0[4], y1[4]; bool h0 = false, h1 = false;
        if (mask) { const int e = __builtin_ctz(mask); mask &= mask - 1; h0 = true; const int sl = __builtin_amdgcn_readlane(sv, e);
#pragma unroll
            for (int j = 0; j < 4; ++j) y0[j] = *(const u32x2*)(YE + (size_t)sl * DM + 4 * C.lane + 256 * j); }
        if (mask) { const int e = __builtin_ctz(mask); mask &= mask - 1; h1 = true; const int sl = __builtin_amdgcn_readlane(sv, e);
#pragma unroll
            for (int j = 0; j < 4; ++j) y1[j] = *(const u32x2*)(YE + (size_t)sl * DM + 4 * C.lane + 256 * j); }
        f32x4 x[4];
#pragma unroll
        for (int j = 0; j < 4; ++j) x[j] = xn[j];
        if (row + C.NGW < MROWS) { svn = SLOT[(size_t)(row + C.NGW) * 16 + (C.lane & 15)];
#pragma unroll
            for (int j = 0; j < 4; ++j) xn[j] = *(const f32x4*)(X + (size_t)(row + C.NGW) * DM + 4 * C.lane + 256 * j); }
        if (h0) {
#pragma unroll
            for (int j = 0; j < 4; ++j) acc[j] += (f32x4){__uint_as_float(y0[j].x << 16), __uint_as_float(y0[j].x & 0xffff0000u), __uint_as_float(y0[j].y << 16), __uint_as_float(y0[j].y & 0xffff0000u)}; }
        if (h1) {
#pragma unroll
            for (int j = 0; j < 4; ++j) acc[j] += (f32x4){__uint_as_float(y1[j].x << 16), __uint_as_float(y1[j].x & 0xffff0000u), __uint_as_float(y1[j].y << 16), __uint_as_float(y1[j].y & 0xffff0000u)}; }
        while (mask) { const int e = __builtin_ctz(mask); mask &= mask - 1; const int sl = __builtin_amdgcn_readlane(sv, e);
#pragma unroll
            for (int j = 0; j < 4; ++j) acc[j] += ld4bf(YE + (size_t)sl * DM + 4 * C.lane + 256 * j); }
        float sm = 0.f;
#pragma unroll
        for (int j = 0; j < 4; ++j) { const int col = 4 * C.lane + 256 * j; x[j] = x[j] * ALPHA_DN + *(const f32x4*)(md + 5 * DM + col) * acc[j];
            sm += (x[j][0] + x[j][1]) + (x[j][2] + x[j][3]); }
        const float mean = wave_sum(sm) * (1.f / DM); float s2 = 0.f;
#pragma unroll
        for (int j = 0; j < 4; ++j) { x[j] = x[j] - mean; s2 += (x[j][0] * x[j][0] + x[j][1] * x[j][1]) + (x[j][2] * x[j][2] + x[j][3] * x[j][3]); }
        const float rstd = rsqrtf(wave_sum(s2) * (1.f / DM) + LN_EPS);
#pragma unroll
        for (int j = 0; j < 4; ++j) { const int col = 4 * C.lane + 256 * j;
            const f32x4 x2 = x[j] * rstd * *(const f32x4*)(lng + col) + *(const f32x4*)(lnb + col);
            *(f32x4*)(X + (size_t)row * DM + col) = x2;
            if (l < DEPTH - 1) { const float* mn = MODN + mi * 6144; st4bf(H + (size_t)row * DM + col, x2 * (*(const f32x4*)(mn + DM + col) + 1.f) + *(const f32x4*)(mn + col)); }
            else if (row < NLAT) *(f32x4*)(A.out + (size_t)row * DM + col) = x2; }
    }
}


#ifndef GEMM_NOINLINE
#define GEMM_NOINLINE 0
#endif
#if GEMM_NOINLINE
#define GEMM_FN __device__ __noinline__
#else
#define GEMM_FN __device__ __forceinline__
#endif
GEMM_FN void gphase_in(LAS unsigned char* lds, unsigned char* ws, int nN, int G) {
    int bx = blockIdx.x; asm volatile("" : "+s"(bx), "+s"(G));
    pg8::Gemm g{(const bf16_t*)(ws + WS_H), (const bf16_t*)(ws + WS_WIN), DM}; pg8::Order<0> S; S.init(MROWS / 256, nN, G, bx, nullptr, 0);
    pg8::EpiBf16 E{(bf16_t*)(ws + WS_P), P_LD}; pg8::gemm_phase(lds, g, S, E); }
GEMM_FN void gphase_in_odd(LAS unsigned char* lds, unsigned char* ws, int G) {
    int bx = blockIdx.x; asm volatile("" : "+s"(bx), "+s"(G));
    pg8::Gemm g{(const bf16_t*)(ws + WS_H), (const bf16_t*)(ws + WS_WIN), DM}; pg8::Order<0> S; S.init(MROWS / 256, D_IN_ODD / 256, G, bx, nullptr, 0);
    pg8::EpiOdd E{(bf16_t*)(ws + WS_P), (bf16_t*)(ws + WS_Q), (bf16_t*)(ws + WS_KA), (const float*)(ws + WS_ROPE)}; pg8::gemm_phase(lds, g, S, E); }
GEMM_FN void gphase_lora(LAS unsigned char* lds, unsigned char* ws, const float* d0, const float* a0, const float* kal, int G) {
    int bx = blockIdx.x; asm volatile("" : "+s"(bx), "+s"(G));
    pg8::Gemm g{(const bf16_t*)(ws + WS_LIN), (const bf16_t*)(ws + WS_WLORA), LORA_K}; pg8::Order<0> S; S.init(MROWS / 256, LORA_N / 256, G, bx, nullptr, 0);
    pg8::EpiLora E{ws + WS_SCN, (bf16_t*)(ws + WS_G), d0, a0, kal}; pg8::gemm_phase(lds, g, S, E); }
GEMM_FN void gphase_out(LAS unsigned char* lds, unsigned char* ws, const float* modl, int G) {
    int bx = blockIdx.x; asm volatile("" : "+s"(bx), "+s"(G));
    pg8::Gemm g{(const bf16_t*)(ws + WS_A2), (const bf16_t*)(ws + WS_WOUT), DM}; pg8::Order<0> S; S.init(MROWS / 256, DM / 256, G, bx, nullptr, 0);
    pg8::EpiRes E{(float*)(ws + WS_X), modl}; pg8::gemm_phase(lds, g, S, E); }
GEMM_FN void gphase_e1(LAS unsigned char* lds, unsigned char* ws, int G, int l) {
    int bx = blockIdx.x; asm volatile("" : "+s"(bx), "+s"(G));
    pg8::Gemm g{(const bf16_t*)(ws + WS_H), (const bf16_t*)(ws + WS_WE13 + (size_t)(l & 1) * WE13_BYTES), DM}; pg8::EpiSwiGLU E{(bf16_t*)(ws + WS_HID)};
    pg8::OrderExp<1> S; S.init(4096 / 256, G, bx, (const int*)(ws + WS_IDX), (long)4096 * DM); pg8::gemm_phase(lds, g, S, E); }
GEMM_FN void gphase_e2(LAS unsigned char* lds, unsigned char* ws, int G, int l) {
    int bx = blockIdx.x; asm volatile("" : "+s"(bx), "+s"(G));
    pg8::Gemm g{(const bf16_t*)(ws + WS_HID), (const bf16_t*)(ws + WS_WE2 + (size_t)(l & 1) * WE2_BYTES), D_EXP}; pg8::EpiYE E{(bf16_t*)(ws + WS_YE), (const float*)(ws + WS_GATE)};
    pg8::OrderExp<2> S; S.init(DM / 256, G, bx, nullptr, (long)DM * D_EXP); pg8::gemm_phase(lds, g, S, E); }

constexpr int NSLOT = 13;
constexpr int NSTEP = 1 + DEPTH * NSLOT;
__global__ void __launch_bounds__(NTHR, 2) mk_fwd(Args KA) {
    extern __shared__ __attribute__((aligned(16))) unsigned char lds_raw[];
    volatile LAS unsigned* MISC = (volatile LAS unsigned*)((LAS unsigned char*)lds_raw + LDS_MISC);
    if (threadIdx.x < 16) MISC[threadIdx.x] = 0u;
    if (threadIdx.x == 0) { LAS unsigned long long* tb = (LAS unsigned long long*)((LAS unsigned char*)lds_raw + LDS_PTAB);
#pragma unroll
        for (int i = 0; i < 37; ++i) tb[i] = (unsigned long long)KA.in[i];
        tb[37] = (unsigned long long)KA.out; tb[38] = (unsigned long long)KA.ws; }
    __syncthreads();
    const int lo = KA.lo, hi = KA.hi;
    unsigned bar_x = 0;
    if (hi - lo > 1) { const XcdBarrier b0 = xcd_barrier_post((unsigned*)(KA.ws + WS_CTL), MISC); bar_x = b0.x; }
#ifndef PH_MASK
#define PH_MASK 0xFFFFFF
#endif
#ifndef REP_MASK
#define REP_MASK 0
#endif
#define PH_BIT(k) (((k) == 0) ? 0 : 1 + ((k) - 1) % NSLOT + (((k) - 1) % NSLOT >= 2 && ((k) - 1) % NSLOT <= 3 && odd ? 12 : 0))
#define RUN(k, ...) do { if (((PH_MASK >> PH_BIT(k)) & 1) && lo <= (k) && (k) < hi) { const int nrep = ((REP_MASK >> PH_BIT(k)) & 1) ? 2 : 1; \
        _Pragma("unroll 1") for (int rep = 0; rep < nrep; ++rep) { \
        Ctx C; mkctx(C, (LAS unsigned char*)lds_raw); Args A; ldargs(A, (LAS unsigned char*)lds_raw); unsigned char* ws = A.ws; \
        const float* MODL = (const float*)(ws + WS_MOD) + (size_t)l * 5 * 6144; (void)MODL; \
        __VA_ARGS__; if ((k) + 1 < hi || rep + 1 < nrep) { XcdBarrier bar; bar.bar = (unsigned*)(ws + WS_CTL); bar.x = bar_x; bar.st = MISC; xcd_barrier(bar); } } } } while (0)
    { const bool odd = false; const int l = 0; RUN(0, { phase_init(C, A); __syncthreads(); conv_items(C, A, 0, C.gw, C.NGW, true, true, true); }); }
#pragma unroll 1
    for (int l = 0; l < DEPTH; ++l) {
        const int sb = 1 + l * NSLOT; const bool odd = l & 1;
        if (!(CHUNKED_SCAN && odd)) { RUN(sb + 0, { phase_conv(C, A, l); if (l == 0) phase_modh(C, A, 0); }); }
        if (odd) { RUN(sb + 1, gphase_in_odd(C.lds, ws, C.G)); } else { RUN(sb + 1, gphase_in(C.lds, ws, D_IN_EVEN_PAD / 256, C.G)); }
        if (!odd) {
            RUN(sb + 2, phase_ef1(C, A, l));
            RUN(sb + 3, { const int i2 = l >> 1; gphase_lora(C.lds, ws, A.in[I_D0] + (size_t)i2 * 2 * 768, A.in[I_A0] + (size_t)i2 * 2 * 768, A.in[I_KAL] + (size_t)i2 * 768, C.G); });
#if CHUNKED_SCAN
            RUN(sb + 4, phase_csa(C, A));
            RUN(sb + 5, phase_csb(C, A, l));
#else
            RUN(sb + 4, phase_scan(C, A));
#endif
            RUN(sb + 6, phase_ef2(C, A, l));
        } else {
            RUN(sb + 2, phase_of1(C, A, l));
            RUN(sb + 3, phase_attn(C, A, l));
        }
        RUN(sb + 7, gphase_out(C.lds, ws, MODL, C.G));
        RUN(sb + 8, phase_rt(C, A, l));
        RUN(sb + 9, phase_tk(C, A));
        RUN(sb + 10, gphase_e1(C.lds, ws, C.G, l));
        RUN(sb + 11, gphase_e2(C.lds, ws, C.G, l));
        RUN(sb + 12, { phase_cb(C, A, l); if (CHUNKED_SCAN && !odd && l + 1 < DEPTH) { __syncthreads(); conv_items(C, A, l + 1, C.gw, C.NGW, false, true, false); } });
    }
#undef RUN
}

#ifdef PHASE_PROBE
#define PROBE_PRE extern __shared__ __attribute__((aligned(16))) unsigned char lds_raw[]; Ctx C; mkctx(C, (LAS unsigned char*)lds_raw); unsigned char* ws = A.ws; (void)ws;
__global__ void __launch_bounds__(NTHR, 2) pr_init(Args A) { PROBE_PRE phase_init(C, A); }
__global__ void __launch_bounds__(NTHR, 2) pr_conv(Args A) { PROBE_PRE phase_conv(C, A, A.lo); }
__global__ void __launch_bounds__(NTHR, 2) pr_modh(Args A) { PROBE_PRE phase_modh(C, A, A.lo); }
__global__ void __launch_bounds__(NTHR, 2) pr_ef1(Args A) { PROBE_PRE phase_ef1(C, A, A.lo); }
__global__ void __launch_bounds__(NTHR, 2) pr_scan(Args A) { PROBE_PRE phase_scan(C, A); }
__global__ void __launch_bounds__(NTHR, 2) pr_ef2(Args A) { PROBE_PRE phase_ef2(C, A, A.lo); }
__global__ void __launch_bounds__(NTHR, 2) pr_csa(Args A) { PROBE_PRE phase_csa(C, A); }
__global__ void __launch_bounds__(NTHR, 2) pr_csb(Args A) { PROBE_PRE phase_csb(C, A, A.lo); }
__global__ void __launch_bounds__(NTHR, 2) pr_of1(Args A) { PROBE_PRE phase_of1(C, A, A.lo); }
__global__ void __launch_bounds__(NTHR, 2) pr_attn(Args A) { PROBE_PRE phase_attn(C, A, A.lo); }
__global__ void __launch_bounds__(NTHR, 2) pr_rt(Args A) { PROBE_PRE phase_rt(C, A, A.lo); }
__global__ void __launch_bounds__(NTHR, 2) pr_tk(Args A) { PROBE_PRE phase_tk(C, A); }
__global__ void __launch_bounds__(NTHR, 2) pr_cb(Args A) { PROBE_PRE phase_cb(C, A, A.lo); }
__global__ void __launch_bounds__(NTHR, 2) pr_gemm_in(Args A) { PROBE_PRE pg8::Gemm g{(const bf16_t*)(ws + WS_H), (const bf16_t*)(ws + WS_WIN), DM}; pg8::Order<0> S; S.init(MROWS / 256, A.lo, C.G, (int)blockIdx.x, nullptr, 0);
                      pg8::EpiBf16 E{(bf16_t*)(ws + WS_P), P_LD}; pg8::gemm_phase(C.lds, g, S, E); }
__global__ void __launch_bounds__(NTHR, 2) pr_gemm_lora(Args A) { PROBE_PRE pg8::Gemm g{(const bf16_t*)(ws + WS_LIN), (const bf16_t*)(ws + WS_WLORA), LORA_K}; pg8::Order<0> S; S.init(MROWS / 256, LORA_N / 256, C.G, (int)blockIdx.x, nullptr, 0);
                          const int i2 = A.lo; pg8::EpiLora E{ws + WS_SCN, (bf16_t*)(ws + WS_G), A.in[I_D0] + (size_t)i2 * 2 * 768, A.in[I_A0] + (size_t)i2 * 2 * 768, A.in[I_KAL] + (size_t)i2 * 768};
                          pg8::gemm_phase(C.lds, g, S, E); }
__global__ void __launch_bounds__(NTHR, 2) pr_gemm_out(Args A) { PROBE_PRE pg8::Gemm g{(const bf16_t*)(ws + WS_A2), (const bf16_t*)(ws + WS_WOUT), DM}; pg8::Order<0> S; S.init(MROWS / 256, DM / 256, C.G, (int)blockIdx.x, nullptr, 0);
                      pg8::EpiRes E{(float*)(ws + WS_X), (const float*)(ws + WS_MOD)}; pg8::gemm_phase(C.lds, g, S, E); }
__global__ void __launch_bounds__(NTHR, 2) pr_gemm_e1(Args A) { PROBE_PRE pg8::Gemm g{(const bf16_t*)(ws + WS_H), (const bf16_t*)(ws + WS_WE13), DM}; pg8::Order<1> S; S.init(NEXP * 17, 4096 / 256, C.G, (int)blockIdx.x, (const int*)(ws + WS_IDX), (long)4096 * DM);
                      pg8::EpiSwiGLU E{(bf16_t*)(ws + WS_HID)}; pg8::gemm_phase(C.lds, g, S, E); }
__global__ void __launch_bounds__(NTHR, 2) pr_gemm_e2(Args A) { PROBE_PRE pg8::Gemm g{(const bf16_t*)(ws + WS_HID), (const bf16_t*)(ws + WS_WE2), D_EXP}; pg8::Order<2> S; S.init(NEXP * 17, DM / 256, C.G, (int)blockIdx.x, nullptr, (long)DM * D_EXP);
                       pg8::EpiYE E{(bf16_t*)(ws + WS_YE), (const float*)(ws + WS_GATE)}; pg8::gemm_phase(C.lds, g, S, E); }
#endif

extern "C" void kernel_launch(void* const* d_in, const int* in_sizes, int n_in, void* d_out, int out_size, void* d_ws, size_t ws_size, hipStream_t stream) {
    static int grid = 0;
    if (grid == 0) {
        if (n_in != 37 || out_size != NLAT * DM || ws_size < WS_END) { fprintf(stderr, "kernel_launch: unexpected shapes: n_in %d out %d ws %zu (need %zu)\n", n_in, out_size, ws_size, (size_t)WS_END); grid = -1; return; }
        int dev = 0, cus = 0, per_cu = 0;
        if (hipGetDevice(&dev) != hipSuccess || hipDeviceGetAttribute(&cus, hipDeviceAttributeMultiprocessorCount, dev) != hipSuccess) { grid = -1; return; }
        if (hipFuncSetAttribute((const void*)mk_fwd, hipFuncAttributeMaxDynamicSharedMemorySize, LDS_BYTES) != hipSuccess) { fprintf(stderr, "kernel_launch: hipFuncSetAttribute failed\n"); grid = -1; return; }
        if (hipOccupancyMaxActiveBlocksPerMultiprocessor(&per_cu, (const void*)mk_fwd, NTHR, LDS_BYTES) != hipSuccess || per_cu < 1) fprintf(stderr, "kernel_launch: occupancy query reports %d\n", per_cu);
        (void)hipGetLastError();
        grid = cus;
    }
    if (grid < 0) return;
    (void)hipMemsetAsync((char*)d_ws + WS_CTL, 0, CTL_BYTES, stream);
    Args a{};
    for (int i = 0; i < 37; ++i) a.in[i] = (const float*)d_in[i];
    a.out = (float*)d_out; a.ws = (unsigned char*)d_ws;
#if MK_MULTI
    for (int k = 0; k < NSTEP; ++k) {
        if (k >= 1) { const int l = (k - 1) / NSLOT, s = (k - 1) % NSLOT; if ((l & 1) && ((s >= 4 && s <= 6) || (CHUNKED_SCAN && s == 0))) continue; if (!(l & 1) && !CHUNKED_SCAN && s == 5) continue; }
        a.lo = k; a.hi = k + 1;
        hipLaunchKernelGGL(mk_fwd, dim3(grid), dim3(NTHR), LDS_BYTES, stream, a);
    }
#else
    a.lo = 0; a.hi = NSTEP;
    hipLaunchKernelGGL(mk_fwd, dim3(grid), dim3(NTHR), LDS_BYTES, stream, a);
#endif
    const hipError_t le = hipPeekAtLastError();
    if (le != hipSuccess) fprintf(stderr, "kernel_launch: launch failed: %s\n", hipGetErrorName(le));
}
```

```cpp
#include <hip/hip_runtime.h>
#include <cstdio>
#include <cstdint>
#include <cmath>

#ifndef MK_MULTI
#define MK_MULTI 0
#endif
#ifndef CHUNKED_SCAN
#define CHUNKED_SCAN 1
#endif

#define GAS __attribute__((address_space(1)))
#define LAS __attribute__((address_space(3)))
typedef unsigned short bf16_t;
typedef short bf16x8 __attribute__((ext_vector_type(8)));
typedef float f32x4 __attribute__((ext_vector_type(4)));
typedef float f32x2 __attribute__((ext_vector_type(2)));
typedef float f32x16 __attribute__((ext_vector_type(16)));
typedef unsigned u32x4 __attribute__((ext_vector_type(4)));
typedef unsigned u32x2 __attribute__((ext_vector_type(2)));
typedef __bf16 bf16x2_t __attribute__((ext_vector_type(2)));

constexpr int NB = 4, TT = 8192, DM = 1024, NLAT = NB * TT, CTXL = 256, NCTX = NB * CTXL, MROWS = NLAT + NCTX;
constexpr int DEPTH = 4;
constexpr int D_CONV = 256, RW_H = 12, RW_K = 64, D_RWKV = 768, RWKV_COLS = 2688, D_IN_EVEN = 3456, D_IN_EVEN_PAD = 3584;
constexpr int D_DIFF = 768, D_GMLP = 256, D_IN_ODD = 2816;
constexpr int NEXP = 16, D_EXP = 2048, CAP_L = 1024, CAP_C = 32, ESLOTS = 4352;
constexpr int P_LD = 3584;
constexpr int LORA_K = 384, LORA_N = 3840;
constexpr int LKEYS = CTXL + TT;
constexpr float ALPHA_DN = 1.6817928305074290f;
constexpr float DECAY_SCALE = 0.6065306597126334f;
constexpr float GN_EPS = 64e-5f, LN_EPS = 1e-5f, RMS_EPS = 1e-5f;
constexpr float QSCALE = 0.125f * 1.4426950408889634f;

constexpr size_t al256(size_t x) { return (x + 255) & ~(size_t)255; }
constexpr size_t WS_CTL = 0;
constexpr size_t CTL_BYTES = 65536;
constexpr size_t WS_MOD = WS_CTL + CTL_BYTES;
constexpr size_t WS_ROPE = WS_MOD + al256((size_t)DEPTH * 5 * 6144 * 4);
constexpr size_t WS_WIN = WS_ROPE + 32768;
constexpr size_t WS_WOUT = WS_WIN + (size_t)D_IN_EVEN_PAD * DM * 2;
constexpr size_t WS_WLORA = WS_WOUT + (size_t)DM * DM * 2;
constexpr size_t WS_WE13 = WS_WLORA + (size_t)LORA_N * LORA_K * 2;
constexpr size_t WE13_BYTES = (size_t)NEXP * 4096 * DM * 2, WE2_BYTES = (size_t)NEXP * DM * D_EXP * 2;
constexpr size_t WS_WE2 = WS_WE13 + 2 * WE13_BYTES;
constexpr size_t WS_X = WS_WE2 + 2 * WE2_BYTES;
constexpr size_t WS_H = WS_X + (size_t)MROWS * DM * 4;
constexpr size_t WS_A2 = WS_H + (size_t)MROWS * DM * 2;
constexpr size_t WS_P = WS_A2 + (size_t)MROWS * DM * 2;
constexpr size_t WS_AFF = WS_P + (size_t)MROWS * P_LD * 2;
constexpr size_t WS_SLOT = WS_AFF + (size_t)MROWS * 16 * 4;
constexpr size_t WS_IDX = WS_SLOT + (size_t)MROWS * 16 * 4;
constexpr size_t WS_GATE = WS_IDX + al256((size_t)NEXP * ESLOTS * 4);
constexpr size_t WS_R2 = WS_GATE + al256((size_t)NEXP * ESLOTS * 4);
constexpr int SC_REC = 1408, SC_ROW = 12 * SC_REC, SC_W = 0, SC_R = 512, SC_KK = 640, SC_V = 768, SC_B = 896, SC_KR = 1024;
constexpr size_t WS_SCN = WS_R2;
constexpr size_t WS_G = WS_SCN + (size_t)MROWS * SC_ROW;
constexpr size_t WS_LIN = WS_G + (size_t)MROWS * 768 * 2;
constexpr int CS_L = 64, CS_NCH = LKEYS / CS_L, CS_UNITS = NB * RW_H * 2;
constexpr size_t WS_CHK = WS_LIN + (size_t)MROWS * 384 * 2;
constexpr size_t WS_EVEN_END = WS_CHK + (size_t)CS_UNITS * CS_NCH * 32768;
constexpr size_t WS_Y = WS_P;
constexpr size_t WS_Q = WS_R2;
constexpr size_t WS_KA = WS_Q + (size_t)MROWS * 768 * 2;
constexpr size_t WS_VT = WS_KA + (size_t)NB * LKEYS * 768 * 2;
constexpr size_t WS_HID = WS_R2;
constexpr size_t WS_YE = WS_HID + (size_t)NEXP * ESLOTS * D_EXP * 2;
constexpr size_t WS_END = WS_EVEN_END;
static_assert(WS_END <= (size_t)2147483648ull, "workspace over 2 GiB");
static_assert((size_t)2 * MROWS * 768 * 4 <= (size_t)MROWS * P_LD * 2, "Y aliases P");
static_assert(WS_YE + (size_t)NEXP * ESLOTS * DM * 2 <= WS_END, "moe region");

constexpr int LDS_BYTES = 147456;
constexpr int LDS_MISC = 140 * 1024;
constexpr int LDS_PTAB = LDS_MISC + 256;
constexpr int NWAVES = 8, NTHR = 512;

__device__ __forceinline__ unsigned f2bf(float f) { unsigned u = __float_as_uint(f); return (u + 0x7fffu + ((u >> 16) & 1u)) >> 16; }
__device__ __forceinline__ unsigned pk2(float lo, float hi) { f32x2 v = {lo, hi}; bf16x2_t b = __builtin_convertvector(v, bf16x2_t); return __builtin_bit_cast(unsigned, b); }
__device__ __forceinline__ float bflo(unsigned u) { return __uint_as_float(u << 16); }
__device__ __forceinline__ float bfhi(unsigned u) { return __uint_as_float(u & 0xffff0000u); }
__device__ __forceinline__ float bf2f(bf16_t b) { return __uint_as_float((unsigned)b << 16); }
__device__ __forceinline__ float sigmoidf_(float x) { return 1.f / (1.f + __expf(-x)); }
__device__ __forceinline__ float wave_sum(float v) {
#pragma unroll
    for (int o = 1; o < 64; o <<= 1) v += __shfl_xor(v, o);
    return v;
}
__device__ __forceinline__ float sum16(float v) {
#pragma unroll
    for (int o = 1; o < 16; o <<= 1) v += __shfl_xor(v, o);
    return v;
}
__device__ __forceinline__ f32x4 ld4bf_(const void* p) { const u32x2 u = *(const u32x2*)p; return (f32x4){bflo(u.x), bfhi(u.x), bflo(u.y), bfhi(u.y)}; }
__device__ __forceinline__ void st4bf_(void* p, f32x4 v) { u32x2 o; o.x = pk2(v[0], v[1]); o.y = pk2(v[2], v[3]); *(u32x2*)p = o; }
__device__ __forceinline__ float max3f(float a, float b, float c) { float r; asm("v_max3_f32 %0, %1, %2, %3" : "=v"(r) : "v"(a), "v"(b), "v"(c)); return r; }
__device__ __forceinline__ int crow(int r, int hi) { return (r & 3) + 8 * (r >> 2) + 4 * hi; }
__device__ __forceinline__ float gelu_erf(float x) { return 0.5f * x * (1.f + erff(x * 0.70710678118654752f)); }

#define XB_TMO      128
#define XB_XCNT(j)  (256  + 64 * (j))
#define XB_XSUB(j)  (1280 + 64 * (j))
#define XB_XGEN(j)  (2304 + 64 * (j))
#define XB_TOP      3328
#define XB_TOPGEN   3392
#define XCD_BAR_WORDS 3456
#define XB_SPIN_CAP (1u << 20)

__device__ __forceinline__ unsigned xb_ld(unsigned* p)              { return __hip_atomic_load(p, __ATOMIC_RELAXED, __HIP_MEMORY_SCOPE_AGENT); }
__device__ __forceinline__ unsigned xb_add(unsigned* p, unsigned v) { return __hip_atomic_fetch_add(p, v, __ATOMIC_RELAXED, __HIP_MEMORY_SCOPE_AGENT); }
__device__ __forceinline__ unsigned xb_xcc_id() { return (unsigned)__builtin_amdgcn_s_getreg((3 << 11) | 20) & 0xFu; }
#define XB_SPIN(cond, bar) do { unsigned _sp = 0; while (cond) { __builtin_amdgcn_s_sleep(1); \
    if ((++_sp & 255u) == 0u) { if (xb_ld(&(bar)[XB_TMO])) break; if (_sp > XB_SPIN_CAP) { atomicAdd(&(bar)[XB_TMO], 1u); break; } } } } while (0)

struct XcdBarrier { unsigned* bar; unsigned x; volatile LAS unsigned* st; };

__device__ __forceinline__ XcdBarrier xcd_barrier_post(unsigned* bar, volatile LAS unsigned* st) {
    XcdBarrier b; b.bar = bar; b.x = xb_xcc_id(); b.st = st;
    if (threadIdx.x == 0) (void)xb_add(&bar[XB_XCNT(b.x)], 1u);
    return b;
}
__device__ __forceinline__ void xcd_barrier_complete(unsigned* bar, unsigned x, unsigned& nloc, unsigned& nx) {
    const unsigned G = gridDim.x * gridDim.y * gridDim.z;
    unsigned sum, cnt, mine, sp = 0u;
    for (;;) {
        sum = 0u; cnt = 0u; mine = 0u;
#pragma unroll
        for (unsigned j = 0; j < 16; ++j) { const unsigned c = xb_ld(&bar[XB_XCNT(j)]); sum += c; cnt += (c > 0u) ? 1u : 0u; mine = (j == x) ? c : mine; }
        if (sum == G) break;
        __builtin_amdgcn_s_sleep(1);
        if ((++sp & 255u) == 0u) { if (xb_ld(&bar[XB_TMO])) break; if (sp > XB_SPIN_CAP) { atomicAdd(&bar[XB_TMO], 1u); break; } }
    }
    nloc = mine > 0u ? mine : 1u; nx = cnt > 0u ? cnt : 1u;
}
__device__ __forceinline__ void xcd_barrier(const XcdBarrier& b) {
    asm volatile("s_waitcnt vmcnt(0)" ::: "memory");
    __syncthreads();
    if (threadIdx.x == 0) {
        unsigned* bar = b.bar;
        __builtin_amdgcn_s_waitcnt(0);
        unsigned nloc = b.st[0], nx = b.st[1];
        if (nloc == 0u) { xcd_barrier_complete(bar, b.x, nloc, nx); b.st[0] = nloc; b.st[1] = nx; }
        const unsigned old = xb_add(&bar[XB_XSUB(b.x)], 1u);
        const unsigned gen = old / nloc;
        if (old + 1u == (gen + 1u) * nloc) {
            __builtin_amdgcn_fence(__ATOMIC_RELEASE, "agent");
            asm volatile("s_waitcnt vmcnt(0)" ::: "memory");
            const unsigned og = xb_add(&bar[XB_TOP], 1u);
            const unsigned tg = og / nx;
            if (og + 1u == (tg + 1u) * nx) xb_add(&bar[XB_TOPGEN], 1u);
            else XB_SPIN(xb_ld(&bar[XB_TOPGEN]) == tg, bar);
            __builtin_amdgcn_fence(__ATOMIC_ACQUIRE, "agent");
            xb_add(&bar[XB_XGEN(b.x)], 1u);
            asm volatile("s_waitcnt vmcnt(0)" ::: "memory");
        } else {
            XB_SPIN(xb_ld(&bar[XB_XGEN(b.x)]) == gen, bar);
            __builtin_amdgcn_fence(__ATOMIC_ACQUIRE, "agent");
            asm volatile("s_waitcnt vmcnt(0)" ::: "memory");
        }
    }
    __syncthreads();
}

namespace pg8 {
constexpr int BM = 256, BK = 64, HALF = 128, HTB = HALF * BK * 2, STAGE_BYTES = 8 * HTB, NXCD = 8, WGM = 8;
__host__ __device__ __forceinline__ int lds_byte(int r, int c) { const int st = (r >> 4) * 2 + (c >> 5), rr = r & 15, cc = c & 31, ob = rr * 64 + cc * 2; return st * 1024 + (ob ^ (((ob >> 9) & 1) << 5)); }
__host__ __device__ __forceinline__ void stage_rc(int b, int& R, int& C) { const int st = b / 1024, sb = b % 1024, swz = sb ^ (((sb >> 9) & 1) << 5); R = (st >> 1) * 16 + swz / 64; C = (st & 1) * 32 + (swz % 64) / 2; }

struct Unit { int pm, pn, hf; };
struct Gemm { const bf16_t* A; const bf16_t* Bt; int K; };

template <int MODE> struct Order {
    static constexpr bool GATHER = (MODE == 1);
    int nM, nN, nwg, G, c; const int* idx; long bstride;
    __device__ __forceinline__ void init(int nM_, int nN_, int G_, int c_, const int* idx_, long bstride_) { nM = nM_; nN = nN_; nwg = nM * nN; G = G_; c = c_; idx = idx_; bstride = bstride_; }
    __device__ __forceinline__ bool next(int i, Unit& u) const {
        const long L = (long)i * G + c; if (L >= nwg) return false;
        int wgid = (int)L; { const int q = nwg / NXCD, r = nwg % NXCD, xcd = wgid % NXCD, off = wgid / NXCD; wgid = (xcd < r ? xcd * (q + 1) : r * (q + 1) + (xcd - r) * q) + off; }
        const int nig = WGM * nN, gid = wgid / nig, fm = gid * WGM, gsz = (nM - fm) < WGM ? (nM - fm) : WGM;
        u.pm = fm + ((wgid % nig) % gsz); u.pn = (wgid % nig) / gsz; u.hf = (MODE != 0 && (u.pm % 17) == 16) ? 1 : 0; return true;
    }
    __device__ __forceinline__ unsigned arow(const Unit& u, int r) const { if (MODE == 1) return (unsigned)idx[u.pm * BM + r]; return (unsigned)(u.pm * BM + r); }
    __device__ __forceinline__ long bbase(const Unit& u, int K) const { long o = (long)u.pn * BM * K; if (MODE != 0) o += (long)(u.pm / 17) * bstride; return o; }
};

template <int MODE> struct OrderExp {
    static constexpr bool GATHER = (MODE == 1);
    int nN, G, c0; const int* idx; long bstride;
    __device__ __forceinline__ void init(int nN_, int G_, int c_, const int* idx_, long bstride_) { nN = nN_; G = G_; c0 = c_; idx = idx_; bstride = bstride_; }
    __device__ __forceinline__ bool next(int i0, Unit& u) const {
        const int v = i0 * G + c0, i = v >> 8, c = v & 255;
        const int x = c & 7, slot = c >> 3, per = 32 / nN, nfull = 256 / (8 * per);
        if (i > nfull) return false;
        if (i < nfull) { u.pn = slot / per; const int f = (i * 8 + x) * per + (slot % per); u.pm = (f >> 4) * 17 + (f & 15); u.hf = 0; return true; }
        if (i == nfull && slot < 2 * nN) { u.pn = slot >> 1; u.pm = (x * 2 + (slot & 1)) * 17 + 16; u.hf = 1; return true; }
        return false;
    }
    __device__ __forceinline__ unsigned arow(const Unit& u, int r) const { if (MODE == 1) return (unsigned)idx[u.pm * BM + r]; return (unsigned)(u.pm * BM + r); }
    __device__ __forceinline__ long bbase(const Unit& u, int K) const { return (long)u.pn * BM * K + (long)(u.pm / 17) * bstride; }
};

template <class Epi, class Sched>
__device__ __forceinline__ void gemm_phase(LAS unsigned char* lds, const Gemm g, const Sched& S, const Epi& E) {
    int tid = threadIdx.x; asm volatile("" : "+v"(tid));
    const int wid = __builtin_amdgcn_readfirstlane(tid >> 6), wr = wid >> 2, wc = wid & 3;
    const int K = g.K, nt = K / BK;
    unsigned voffB[2];
    { const int lane = tid & 63, fr = lane & 15, fq = lane >> 4; (void)fr; (void)fq; }
#pragma unroll
    for (int i = 0; i < 2; ++i) { int R, Cc; stage_rc(tid * 16 + i * 8192, R, Cc); voffB[i] = (unsigned)(R * K + Cc) * 2u; }
    const size_t kstep = (size_t)(BK * 2);
    const size_t hstep = (size_t)HALF * K * 2;
    const unsigned ldsw = (unsigned)wid * 1024u;
    const int aoff = lds_byte(wr * 64 + (tid & 15), ((tid & 63) >> 4) * 8), boff = lds_byte(wc * 32 + (tid & 15), ((tid & 63) >> 4) * 8);
#define PG8_SA(b, h) (((b) * 2 + (h)) * HTB)
#define PG8_SB(b, h) ((4 + (b) * 2 + (h)) * HTB)
#define PG8_STAGE(bufoff, gbase, voff) do { _Pragma("unroll") for (int _i = 0; _i < 2; ++_i) \
        __builtin_amdgcn_global_load_lds((const unsigned*)((const char*)(gbase) + (voff)[_i]), (LAS unsigned*)(lds + (bufoff) + ldsw + _i * 8192), 16, 0, 0); } while (0)
#define PG8_LDA(dst, b, h) do { _Pragma("unroll") for (int m = 0; m < 4; ++m) _Pragma("unroll") for (int k = 0; k < 2; ++k) dst[m][k] = *(const LAS bf16x8*)(lds + PG8_SA(b, h) + aoff + m * 2048 + k * 1024); } while (0)
#define PG8_LDB(dst, b, h) do { _Pragma("unroll") for (int n = 0; n < 2; ++n) _Pragma("unroll") for (int k = 0; k < 2; ++k) dst[n][k] = *(const LAS bf16x8*)(lds + PG8_SB(b, h) + boff + n * 2048 + k * 1024); } while (0)
#define PG8_MMA(ai, bj, At, Bt) do { __builtin_amdgcn_s_setprio(1); _Pragma("unroll") for (int m = 0; m < 4; ++m) _Pragma("unroll") for (int n = 0; n < 2; ++n) _Pragma("unroll") for (int k = 0; k < 2; ++k) \
        acc[ai][bj][m][n] = __builtin_amdgcn_mfma_f32_16x16x32_bf16(Bt[n][k], At[m][k], acc[ai][bj][m][n], 0, 0, 0); __builtin_amdgcn_s_setprio(0); } while (0)
#define PG8_WAIT_V(n) asm volatile("s_waitcnt vmcnt(" #n ")" ::: "memory")
#define PG8_WAIT_L(n) asm volatile("s_waitcnt lgkmcnt(" #n ")" ::: "memory")
#define PG8_BAR __builtin_amdgcn_s_barrier()
#define PG8_SCHED __builtin_amdgcn_sched_barrier(0)
#define PG8_ROWOFFS(dst, u, tq) do { _Pragma("unroll") for (int _i = 0; _i < 2; ++_i) { int _R, _C; stage_rc((tq) * 16 + _i * 8192, _R, _C); _Pragma("unroll") for (int _h = 0; _h < 2; ++_h) dst[_h][_i] = (S.arow(u, _h * HALF + _R) * (unsigned)K + (unsigned)_C) * 2u; } } while (0)
    Unit cur, nxt; int ui = 0;
    if (!S.next(0, cur)) return;
    float zf = 0.f; asm volatile("" : "+v"(zf));
    f32x4 acc[2][2][4][2];
#pragma unroll
    for (int a = 0; a < 2; ++a)
#pragma unroll
        for (int b = 0; b < 2; ++b)
#pragma unroll
            for (int m = 0; m < 4; ++m)
#pragma unroll
                for (int n = 0; n < 2; ++n) acc[a][b][m][n] = (f32x4){zf, zf, zf, zf};
    bf16x8 At[4][2], B0[2][2], B1[2][2];
    unsigned vcur[2][2];
    if constexpr (Sched::GATHER) { PG8_ROWOFFS(vcur, cur, tid); }
    const char* const Ab = (const char*)g.A;
    const char* cA = Sched::GATHER ? Ab : Ab + (size_t)(unsigned)__builtin_amdgcn_readfirstlane((int)S.arow(cur, 0)) * K * 2;
#define PG8_STAGEA(bufoff, ptr, h) do { if constexpr (Sched::GATHER) { PG8_STAGE(bufoff, ptr, vcur[h]); } else { PG8_STAGE(bufoff, (ptr) + (h) * hstep, voffB); } } while (0)
    const char* cB = (const char*)g.Bt + (size_t)S.bbase(cur, K) * 2;
    PG8_STAGE(PG8_SB(0, 0), cB, voffB); PG8_STAGE(PG8_SB(0, 1), cB + hstep, voffB); PG8_STAGEA(PG8_SA(0, 0), cA, 0); PG8_STAGEA(PG8_SA(0, 1), cA, 1);
    if (wr == 1) PG8_BAR;
    PG8_WAIT_V(2); PG8_BAR;
    PG8_STAGE(PG8_SB(1, 0), cB + kstep, voffB); PG8_STAGEA(PG8_SA(1, 0), cA + kstep, 0); PG8_STAGE(PG8_SB(1, 1), cB + hstep + kstep, voffB);
    PG8_WAIT_V(6); PG8_BAR;
    for (;;) {
        const bool has_next = S.next(ui + 1, nxt);
        const char* nB = has_next ? (const char*)g.Bt + (size_t)S.bbase(nxt, K) * 2 : cB;
        const char* nA = (Sched::GATHER || !has_next) ? cA : Ab + (size_t)(unsigned)__builtin_amdgcn_readfirstlane((int)S.arow(nxt, 0)) * K * 2;
#pragma unroll 1
        for (int t = 0; t < nt; t += 2) {
            const bool last = (t == nt - 2);
            const char* a1 = cA + (size_t)(t + 1) * kstep;
            const char* a2 = last ? nA : cA + (size_t)(t + 2) * kstep; const char* b2 = last ? nB : cB + (size_t)(t + 2) * kstep;
            const char* a3 = a2 + kstep; const char* b3 = b2 + kstep;
            PG8_LDB(B0, 0, 0); PG8_LDB(B1, 0, 1); PG8_SCHED; PG8_LDA(At, 0, 0); PG8_STAGEA(PG8_SA(1, 1), a1, 1);
            PG8_WAIT_V(8); PG8_WAIT_L(0); PG8_BAR; PG8_MMA(0, 0, At, B0); PG8_MMA(0, 1, At, B1); PG8_BAR; PG8_SCHED;
            if constexpr (Sched::GATHER) { if (last && has_next) { int tq = tid; asm volatile("" : "+v"(tq)); PG8_ROWOFFS(vcur, nxt, tq); } }
            PG8_LDA(At, 0, 1); PG8_STAGE(PG8_SB(0, 0), b2, voffB); PG8_STAGE(PG8_SB(0, 1), b2 + hstep, voffB); PG8_STAGEA(PG8_SA(0, 0), a2, 0);
            PG8_WAIT_V(8); PG8_WAIT_L(0); PG8_BAR; if (!cur.hf) { PG8_MMA(1, 0, At, B0); PG8_MMA(1, 1, At, B1); } PG8_BAR; PG8_SCHED;
            PG8_LDB(B0, 1, 0); PG8_LDB(B1, 1, 1); PG8_SCHED; PG8_LDA(At, 1, 0); PG8_STAGEA(PG8_SA(0, 1), a2, 1);
            PG8_WAIT_V(8); PG8_WAIT_L(0); PG8_BAR; PG8_MMA(0, 0, At, B0); PG8_MMA(0, 1, At, B1); PG8_BAR; PG8_SCHED;
            PG8_LDA(At, 1, 1); PG8_STAGE(PG8_SB(1, 0), b3, voffB); PG8_STAGE(PG8_SB(1, 1), b3 + hstep, voffB); PG8_STAGEA(PG8_SA(1, 0), a3, 0);
            PG8_WAIT_V(8); PG8_WAIT_L(0); PG8_BAR; if (!cur.hf) { PG8_MMA(1, 0, At, B0); PG8_MMA(1, 1, At, B1); } PG8_BAR; PG8_SCHED;
        }
        if (wr == 0) PG8_BAR;
        { int tz = tid; asm volatile("" : "+v"(tz)); const int ln = tz & 63; E(acc, cur, wr, wc, ln & 15, ln >> 4); }
        if (!has_next) break;
#pragma unroll
        for (int a = 0; a < 2; ++a)
#pragma unroll
            for (int b = 0; b < 2; ++b)
#pragma unroll
                for (int m = 0; m < 4; ++m)
#pragma unroll
                    for (int n = 0; n < 2; ++n) acc[a][b][m][n] = (f32x4){zf, zf, zf, zf};
        cur = nxt; cB = nB; cA = nA; ++ui;
        if (wr == 1) PG8_BAR;
    }
    PG8_WAIT_V(0);
    PG8_BAR;
#undef PG8_SA
#undef PG8_SB
#undef PG8_STAGE
#undef PG8_LDA
#undef PG8_LDB
#undef PG8_MMA
#undef PG8_WAIT_V
#undef PG8_WAIT_L
#undef PG8_BAR
#undef PG8_SCHED
#undef PG8_ROWOFFS
#undef PG8_STAGEA
}

#define EPI_LOOP for (int ai = 0; ai < 2; ++ai) for (int m = 0; m < 4; ++m) for (int bj = 0; bj < 2; ++bj) for (int n = 0; n < 2; ++n)
struct EpiBf16 {
    bf16_t* O; int ldc;
    __device__ __forceinline__ void operator()(const f32x4 (&acc)[2][2][4][2], const Unit& u, int wr, int wc, int fr, int fq) const {
        const int row0 = u.pm * BM + wr * 64 + fr, col0 = u.pn * BM + wc * 32 + 4 * fq;
#pragma unroll
        for (int ai = 0; ai < 2; ++ai)
#pragma unroll
            for (int m = 0; m < 4; ++m) { bf16_t* rowp = O + (size_t)(row0 + ai * HALF + m * 16) * ldc + col0;
#pragma unroll
                for (int bj = 0; bj < 2; ++bj)
#pragma unroll
                    for (int n = 0; n < 2; ++n) { const f32x4 v = acc[ai][bj][m][n]; u32x2 o; o.x = pk2(v[0], v[1]); o.y = pk2(v[2], v[3]); *(u32x2*)(rowp + bj * HALF + n * 16) = o; } }
    }
};
struct EpiOdd {
    bf16_t* P; bf16_t* Q; bf16_t* KA; const float* rope;
    __device__ __forceinline__ void operator()(const f32x4 (&acc)[2][2][4][2], const Unit& u, int wr, int wc, int fr, int fq) const {
        const int row0 = u.pm * BM + wr * 64 + fr, col0 = u.pn * BM + wc * 32 + 4 * fq;
        if (u.pn >= 6) {
#pragma unroll
            for (int ai = 0; ai < 2; ++ai)
#pragma unroll
                for (int m = 0; m < 4; ++m) { bf16_t* rowp = P + (size_t)(row0 + ai * HALF + m * 16) * P_LD + col0;
#pragma unroll
                    for (int bj = 0; bj < 2; ++bj)
#pragma unroll
                        for (int n = 0; n < 2; ++n) { const f32x4 v = acc[ai][bj][m][n]; u32x2 o; o.x = pk2(v[0], v[1]); o.y = pk2(v[2], v[3]); *(u32x2*)(rowp + bj * HALF + n * 16) = o; } }
            return;
        }
        const bool isk = u.pn >= 3, isctx = u.pm >= NLAT / BM; const int axis = wc & 1;
        const int cq = col0 - (isk ? 768 : 0);
        f32x4 csr[2][4], snr[2][4];
#pragma unroll
        for (int ai = 0; ai < 2; ++ai)
#pragma unroll
            for (int m = 0; m < 4; ++m) { const int row = row0 + ai * HALF + m * 16; csr[ai][m] = (f32x4){1.f, 1.f, 1.f, 1.f}; snr[ai][m] = (f32x4){0.f, 0.f, 0.f, 0.f};
                if (!isctx) { const int t = row & (TT - 1); const int pos = axis ? 128 + (t & 63) : (t >> 6);
                    csr[ai][m] = *(const f32x4*)(rope + pos * 16 + 4 * fq); snr[ai][m] = *(const f32x4*)(rope + 192 * 16 + pos * 16 + 4 * fq); } }
#pragma unroll
        for (int ai = 0; ai < 2; ++ai)
#pragma unroll
            for (int m = 0; m < 4; ++m) { const int row = row0 + ai * HALF + m * 16;
                const f32x4 cs = csr[ai][m], sn = snr[ai][m]; size_t orow;
                if (!isctx) { const int t = row & (TT - 1); orow = isk ? (size_t)(row >> 13) * LKEYS + CTXL + t : (size_t)row; }
                else { const int rc = row - NLAT; orow = isk ? (size_t)(rc >> 8) * LKEYS + (rc & 255) : (size_t)row; }
                bf16_t* op = (isk ? KA : Q) + orow * 768 + cq; const float sc = isk ? 1.f : QSCALE;
#pragma unroll
                for (int bj = 0; bj < 2; ++bj) { const f32x4 x1 = acc[ai][bj][m][0], x2 = acc[ai][bj][m][1];
                    const f32x4 o1 = (x1 * cs - x2 * sn) * sc, o2 = (x1 * sn + x2 * cs) * sc;
                    u32x2 a; a.x = pk2(o1[0], o1[1]); a.y = pk2(o1[2], o1[3]); *(u32x2*)(op + bj * HALF) = a;
                    u32x2 b; b.x = pk2(o2[0], o2[1]); b.y = pk2(o2[2], o2[3]); *(u32x2*)(op + bj * HALF + 16) = b; } }
    }
};
struct EpiRes {
    float* X; const float* modl;
    __device__ __forceinline__ void operator()(const f32x4 (&acc)[2][2][4][2], const Unit& u, int wr, int wc, int fr, int fq) const {
        const int row0 = u.pm * BM + wr * 64 + fr, col0 = u.pn * BM + wc * 32 + 4 * fq;
        const int mi = (u.pm * BM < NLAT) ? (u.pm * BM) / TT : 4;
        const float* gate = modl + mi * 6144 + 2 * DM;
        f32x4 gv[2][2];
#pragma unroll
        for (int bj = 0; bj < 2; ++bj)
#pragma unroll
            for (int n = 0; n < 2; ++n) gv[bj][n] = *(const f32x4*)(gate + col0 + bj * HALF + n * 16);
#pragma unroll
        for (int ai = 0; ai < 2; ++ai) { f32x4 xr[4][2][2];
#pragma unroll
            for (int m = 0; m < 4; ++m) { const float* rowp = X + (size_t)(row0 + ai * HALF + m * 16) * DM + col0;
#pragma unroll
                for (int bj = 0; bj < 2; ++bj)
#pragma unroll
                    for (int n = 0; n < 2; ++n) xr[m][bj][n] = *(const f32x4*)(rowp + bj * HALF + n * 16); }
#pragma unroll
            for (int m = 0; m < 4; ++m) { float* rowp = X + (size_t)(row0 + ai * HALF + m * 16) * DM + col0;
#pragma unroll
                for (int bj = 0; bj < 2; ++bj)
#pragma unroll
                    for (int n = 0; n < 2; ++n) *(f32x4*)(rowp + bj * HALF + n * 16) = xr[m][bj][n] * ALPHA_DN + gv[bj][n] * acc[ai][bj][m][n]; } }
    }
};
struct EpiSwiGLU {
    bf16_t* HID;
    __device__ __forceinline__ void operator()(const f32x4 (&acc)[2][2][4][2], const Unit& u, int wr, int wc, int fr, int fq) const {
        const int row0 = u.pm * BM + wr * 64 + fr, f0 = u.pn * HALF + wc * 32 + 4 * fq;
#pragma unroll
        for (int ai = 0; ai < 2; ++ai) if (ai == 0 || !u.hf)
#pragma unroll
            for (int m = 0; m < 4; ++m) { bf16_t* rowp = HID + (size_t)(row0 + ai * HALF + m * 16) * D_EXP + f0;
#pragma unroll
                for (int n = 0; n < 2; ++n) { const f32x4 a = acc[ai][0][m][n], b = acc[ai][1][m][n]; float h[4];
#pragma unroll
                    for (int j = 0; j < 4; ++j) h[j] = a[j] / (1.f + __expf(-a[j])) * b[j];
                    u32x2 o; o.x = pk2(h[0], h[1]); o.y = pk2(h[2], h[3]); *(u32x2*)(rowp + n * 16) = o; } }
    }
};
struct EpiYE {
    bf16_t* YE; const float* gate;
    __device__ __forceinline__ void operator()(const f32x4 (&acc)[2][2][4][2], const Unit& u, int wr, int wc, int fr, int fq) const {
        const int row0 = u.pm * BM + wr * 64 + fr, col0 = u.pn * BM + wc * 32 + 4 * fq;
        float gts[2][4];
#pragma unroll
        for (int ai = 0; ai < 2; ++ai)
#pragma unroll
            for (int m = 0; m < 4; ++m) gts[ai][m] = gate[row0 + ai * HALF + m * 16];
#pragma unroll
        for (int ai = 0; ai < 2; ++ai) if (ai == 0 || !u.hf)
#pragma unroll
            for (int m = 0; m < 4; ++m) { const int row = row0 + ai * HALF + m * 16; const float gt = gts[ai][m]; bf16_t* rowp = YE + (size_t)row * DM + col0;
#pragma unroll
                for (int bj = 0; bj < 2; ++bj)
#pragma unroll
                    for (int n = 0; n < 2; ++n) { const f32x4 v = acc[ai][bj][m][n] * gt; u32x2 o; o.x = pk2(v[0], v[1]); o.y = pk2(v[2], v[3]); *(u32x2*)(rowp + bj * HALF + n * 16) = o; } }
    }
};
struct EpiLora {
    unsigned char* SCN; bf16_t* G; const float* decay0; const float* a0; const float* kalpha;
    __device__ __forceinline__ void operator()(const f32x4 (&acc)[2][2][4][2], const Unit& u, int wr, int wc, int fr, int fq) const {
        const int row0 = u.pm * BM + wr * 64 + fr;
        const int seg = u.pn / 3, cb = (u.pn % 3) * BM + wc * 32 + 4 * fq;
#pragma unroll
        for (int bj = 0; bj < 2; ++bj)
#pragma unroll
            for (int n = 0; n < 2; ++n) {
                const int col = cb + bj * HALF + n * 16, head = col >> 6, kx = col & 63;
                if (seg < 2) {
                    const f32x4 d0 = *(const f32x4*)(decay0 + seg * 768 + col);
#pragma unroll
                    for (int ai = 0; ai < 2; ++ai)
#pragma unroll
                        for (int m = 0; m < 4; ++m) { const int row = row0 + ai * HALF + m * 16; f32x4 w;
#pragma unroll
                            for (int j = 0; j < 4; ++j) { const float lw = -DECAY_SCALE * sigmoidf_(d0[j] + acc[ai][bj][m][n][j]); w[j] = CHUNKED_SCAN ? lw : __expf(lw); }
                            *(f32x4*)(SCN + (size_t)(row * 12 + head) * SC_REC + SC_W + seg * 256 + kx * 4) = w; __builtin_amdgcn_sched_barrier(0); }
                } else if (seg < 4) {
                    const int d = seg - 2;
                    const f32x4 a00 = *(const f32x4*)(a0 + d * 768 + col), kal = *(const f32x4*)(kalpha + col);
                    u32x2 kkr[2][4], ksr[2][4];
#pragma unroll
                    for (int ai = 0; ai < 2; ++ai)
#pragma unroll
                        for (int m = 0; m < 4; ++m) { const unsigned char* base = SCN + (size_t)((row0 + ai * HALF + m * 16) * 12 + head) * SC_REC + kx * 2;
                            kkr[ai][m] = *(const u32x2*)(base + SC_KK); ksr[ai][m] = *(const u32x2*)(base + SC_KR + 256 * d); }
#pragma unroll
                    for (int ai = 0; ai < 2; ++ai)
#pragma unroll
                        for (int m = 0; m < 4; ++m) { const int row = row0 + ai * HALF + m * 16; unsigned char* base = SCN + (size_t)(row * 12 + head) * SC_REC + kx * 2;
                            const f32x4 kk = {bflo(kkr[ai][m].x), bfhi(kkr[ai][m].x), bflo(kkr[ai][m].y), bfhi(kkr[ai][m].y)}; const f32x4 ks = {bflo(ksr[ai][m].x), bfhi(ksr[ai][m].x), bflo(ksr[ai][m].y), bfhi(ksr[ai][m].y)}; f32x4 bb, kr;
#pragma unroll
                            for (int j = 0; j < 4; ++j) { const float a = sigmoidf_(a00[j] + acc[ai][bj][m][n][j]); bb[j] = kk[j] * a; kr[j] = ks[j] * (1.f + (a - 1.f) * kal[j]); }
                            st4bf_(base + SC_B + 256 * d, bb); st4bf_(base + SC_KR + 256 * d, kr); __builtin_amdgcn_sched_barrier(0); }
                } else {
#pragma unroll
                    for (int ai = 0; ai < 2; ++ai)
#pragma unroll
                        for (int m = 0; m < 4; ++m) { const int row = row0 + ai * HALF + m * 16; const f32x4 v = acc[ai][bj][m][n]; u32x2 o; o.x = pk2(v[0], v[1]); o.y = pk2(v[2], v[3]);
                            *(u32x2*)(G + (size_t)row * 768 + col) = o; }
                }
            }
    }
};
}

struct Args { const float* in[37]; float* out; unsigned char* ws; int lo, hi; };
enum { I_X = 0, I_C, I_CTX, I_CCTX, I_WMOD, I_BMOD, I_LNG, I_LNB, I_EWIN, I_EWOUT, I_CONVW, I_MU, I_DUP, I_D0, I_AUP, I_A0, I_GUP, I_KXI, I_KAL, I_RBON, I_GNG, I_GNB,
       I_OWIN, I_OWOUT, I_LQ1, I_LK1, I_LQ2, I_LK2, I_SUBG, I_GLNG, I_GLNB, I_GWS, I_GBS, I_WR, I_WE1, I_WE3, I_WE2 };

struct Ctx {
    LAS unsigned char* lds;
    int tid, lane, wave, G, vcu, gw, NGW;
};
__device__ __forceinline__ void mkctx(Ctx& C, LAS unsigned char* lds) {
    int tid = threadIdx.x; asm volatile("" : "+v"(tid));
    C.lds = lds; C.tid = tid; C.lane = tid & 63; C.wave = __builtin_amdgcn_readfirstlane(tid >> 6);
    C.G = gridDim.x; { const int bx = blockIdx.x; C.vcu = (C.G % 8 == 0) ? (bx % 8) * (C.G / 8) + bx / 8 : bx; }
    C.gw = blockIdx.x * NWAVES + C.wave; C.NGW = C.G * NWAVES;
}
#define GLOBAL_PTR(T, v) ((T*)(__attribute__((address_space(1))) T*)(v))
__device__ __forceinline__ void ldargs(Args& A, LAS unsigned char* lds) {
    LAS const u32x2* tb = (LAS const u32x2*)(lds + LDS_PTAB); asm volatile("" : "+v"(tb));
#pragma unroll
    for (int i = 0; i < 37; ++i) { const u32x2 v = tb[i]; A.in[i] = GLOBAL_PTR(const float, ((unsigned long long)(unsigned)__builtin_amdgcn_readfirstlane((int)v.y) << 32) | (unsigned)__builtin_amdgcn_readfirstlane((int)v.x)); }
    { const u32x2 v = tb[37]; A.out = GLOBAL_PTR(float, ((unsigned long long)(unsigned)__builtin_amdgcn_readfirstlane((int)v.y) << 32) | (unsigned)__builtin_amdgcn_readfirstlane((int)v.x)); }
    { const u32x2 v = tb[38]; A.ws = GLOBAL_PTR(unsigned char, ((unsigned long long)(unsigned)__builtin_amdgcn_readfirstlane((int)v.y) << 32) | (unsigned)__builtin_amdgcn_readfirstlane((int)v.x)); }
    A.lo = 0; A.hi = 0;
}
__device__ __forceinline__ int row_mi(int row) { return row < NLAT ? (row >> 13) : 4; }

__device__ __forceinline__ void phase_init(const Ctx& C, const Args& A) {
    unsigned char* ws = A.ws;
    float* MOD = (float*)(ws + WS_MOD);
    LAS float* sv = (LAS float*)C.lds;
    LAS float* red = sv + 5 * 1024;
    for (int i = C.tid; i < 5 * 1024; i += NTHR) { const int v = i >> 10, k = i & 1023; const float c = (v < 4) ? A.in[I_C][v * DM + k] : A.in[I_CCTX][k]; sv[i] = c / (1.f + __expf(-c)); }
    __syncthreads();
    const int j = C.tid & 127, kp = C.tid >> 7;
    for (int it = blockIdx.x; it < DEPTH * 48; it += C.G) {
        const int l = it / 48, cg = it % 48, col = cg * 128 + j;
        const float* W = A.in[I_WMOD] + (size_t)l * DM * 6144 + col;
        float a0 = 0.f, a1 = 0.f, a2 = 0.f, a3 = 0.f, a4 = 0.f;
#pragma unroll 4
        for (int k = kp * 256; k < kp * 256 + 256; ++k) { const float w = W[(size_t)k * 6144]; a0 += sv[k] * w; a1 += sv[1024 + k] * w; a2 += sv[2048 + k] * w; a3 += sv[3072 + k] * w; a4 += sv[4096 + k] * w; }
        red[(kp * 5 + 0) * 128 + j] = a0; red[(kp * 5 + 1) * 128 + j] = a1; red[(kp * 5 + 2) * 128 + j] = a2; red[(kp * 5 + 3) * 128 + j] = a3; red[(kp * 5 + 4) * 128 + j] = a4;
        __syncthreads();
        for (int o = C.tid; o < 5 * 128; o += NTHR) { const int v = o >> 7, jj = o & 127; const int cc = cg * 128 + jj;
            const float s = red[(0 * 5 + v) * 128 + jj] + red[(1 * 5 + v) * 128 + jj] + red[(2 * 5 + v) * 128 + jj] + red[(3 * 5 + v) * 128 + jj];
            MOD[((size_t)l * 5 + v) * 6144 + cc] = s + A.in[I_BMOD][l * 6144 + cc]; }
        __syncthreads();
    }
    if (blockIdx.x == C.G - 1) { float* rope = (float*)(ws + WS_ROPE);
        for (int i = C.tid; i < 192 * 16; i += NTHR) { const int pos = i >> 4, j = i & 15; const float ang = (float)(pos < 128 ? pos : pos - 128) * powf(10000.f, -(float)j * (1.f / 16.f));
            rope[i] = cosf(ang); rope[192 * 16 + i] = sinf(ang); } }
    f32x4* X4 = (f32x4*)(ws + WS_X);
    const f32x4* x4 = (const f32x4*)A.in[I_X]; const f32x4* c4 = (const f32x4*)A.in[I_CTX];
    const size_t nl = (size_t)NLAT * DM / 4, nc = (size_t)NCTX * DM / 4;
    for (size_t i = (size_t)blockIdx.x * NTHR + C.tid; i < nl + nc; i += (size_t)C.G * NTHR) X4[i] = (i < nl) ? x4[i] : c4[i - nl];
}

__device__ __forceinline__ void transpose_item(const float* W, int ldw, int k0, int n0, bf16_t* WT, int ldt, int drow0, LAS float* scr, int lane) {
    { float v[64]; const float* src = W + (size_t)k0 * ldw + n0 + lane;
#pragma unroll
      for (int k = 0; k < 64; ++k) v[k] = __builtin_nontemporal_load(src + (size_t)k * ldw);
#pragma unroll
      for (int k = 0; k < 64; ++k) scr[k * 65 + lane] = v[k]; }
    asm volatile("s_waitcnt lgkmcnt(0)" ::: "memory");
    const int c = lane & 7;
#pragma unroll
    for (int j = 0; j < 8; ++j) { const int n = (lane >> 3) + 8 * j; const LAS float* s = scr + (8 * c) * 65 + n;
        u32x4 o; o.x = pk2(s[0 * 65], s[1 * 65]); o.y = pk2(s[2 * 65], s[3 * 65]); o.z = pk2(s[4 * 65], s[5 * 65]); o.w = pk2(s[6 * 65], s[7 * 65]);
        *(u32x4*)(WT + (size_t)(drow0 + n) * ldt + k0 + 8 * c) = o; }
    asm volatile("s_waitcnt lgkmcnt(0)" ::: "memory");
}
__device__ __forceinline__ void conv_items(const Ctx& C, const Args& A, int l, int gw, int NGW, bool do_in, bool do_out, bool do_exp) {
    unsigned char* ws = A.ws;
    const int i2 = l >> 1; const bool odd = (l & 1);
    LAS float* scr = (LAS float*)C.lds + C.wave * (64 * 65);
    bf16_t* WIN = (bf16_t*)(ws + WS_WIN); bf16_t* WOUT = (bf16_t*)(ws + WS_WOUT); bf16_t* WE13 = (bf16_t*)(ws + WS_WE13 + (size_t)(l & 1) * WE13_BYTES); bf16_t* WE2 = (bf16_t*)(ws + WS_WE2 + (size_t)(l & 1) * WE2_BYTES);
    const int nin = odd ? D_IN_ODD : D_IN_EVEN;
    const float* win = odd ? A.in[I_OWIN] + (size_t)i2 * DM * D_IN_ODD : A.in[I_EWIN] + (size_t)i2 * DM * D_IN_EVEN;
    const float* wout = odd ? A.in[I_OWOUT] + (size_t)i2 * DM * DM : A.in[I_EWOUT] + (size_t)i2 * DM * DM;
    const int n_in = do_in ? 16 * (nin / 64) : 0, n_out = do_out ? 16 * 16 : 0, n_e13 = do_exp ? NEXP * 2 * 16 * 32 : 0, n_e2 = do_exp ? NEXP * 32 * 16 : 0;
    const int total = n_in + n_out + n_e13 + n_e2;
    for (int it = gw; it < total; it += NGW) {
        int r = it;
        if (r < n_in) { const int nb = nin / 64, kb = r / nb, nn = r % nb; transpose_item(win, nin, kb * 64, nn * 64, WIN, DM, nn * 64, scr, C.lane); continue; } r -= n_in;
        if (r < n_out) { const int kb = r / 16, nn = r % 16; transpose_item(wout, DM, kb * 64, nn * 64, WOUT, DM, nn * 64, scr, C.lane); continue; } r -= n_out;
        if (r < n_e13) { const int e = r / 1024, q = r % 1024, mat = q / 512, q2 = q % 512, kb = q2 / 32, nn = q2 % 32;
            const float* W = (mat ? A.in[I_WE3] : A.in[I_WE1]) + ((size_t)l * NEXP + e) * DM * D_EXP;
            const int f0 = nn * 64; const int drow = (f0 >> 7) * 256 + mat * 128 + (f0 & 127);
            transpose_item(W, D_EXP, kb * 64, f0, WE13 + (size_t)e * 4096 * DM, DM, drow, scr, C.lane); continue; } r -= n_e13;
        { const int e = r / 512, q = r % 512, kb = q / 16, nn = q % 16;
            const float* W = A.in[I_WE2] + ((size_t)l * NEXP + e) * D_EXP * DM;
            transpose_item(W, DM, kb * 64, nn * 64, WE2 + (size_t)e * DM * D_EXP, D_EXP, nn * 64, scr, C.lane); }
    }
}
__device__ __forceinline__ void phase_conv(const Ctx& C, const Args& A, int l) {
    unsigned char* ws = A.ws;
    const int i2 = l >> 1; const bool odd = (l & 1);
    bf16_t* WIN = (bf16_t*)(ws + WS_WIN);
    const bool early = CHUNKED_SCAN && odd;
    if (l > 0) conv_items(C, A, l, C.gw, C.NGW, !early, true, !early);
    if (!odd) {
        u32x4* z = (u32x4*)(WIN + (size_t)D_IN_EVEN * DM);
        unsigned zz = 0u; asm volatile("" : "+v"(zz));
        for (int i = blockIdx.x * NTHR + C.tid; i < (D_IN_EVEN_PAD - D_IN_EVEN) * DM / 8; i += C.G * NTHR) z[i] = (u32x4){zz, zz, zz, zz};
        bf16_t* WL = (bf16_t*)(ws + WS_WLORA);
        const float* dup = A.in[I_DUP] + (size_t)i2 * 2 * 64 * 768; const float* aup = A.in[I_AUP] + (size_t)i2 * 2 * 64 * 768; const float* gup = A.in[I_GUP] + (size_t)i2 * 128 * 768;
        for (int i = blockIdx.x * NTHR + C.tid; i < LORA_N * LORA_K; i += C.G * NTHR) {
            const int kk = i / LORA_N, n = i % LORA_N, seg = n / 768, col = n % 768; float v = 0.f;
            if (seg == 0) { if (kk < 64) v = dup[(size_t)(0 * 64 + kk) * 768 + col]; }
            else if (seg == 1) { if (kk >= 64 && kk < 128) v = dup[(size_t)(1 * 64 + kk - 64) * 768 + col]; }
            else if (seg == 2) { if (kk >= 128 && kk < 192) v = aup[(size_t)(0 * 64 + kk - 128) * 768 + col]; }
            else if (seg == 3) { if (kk >= 192 && kk < 256) v = aup[(size_t)(1 * 64 + kk - 192) * 768 + col]; }
            else { if (kk >= 256) v = gup[(size_t)(kk - 256) * 768 + col]; }
            WL[(size_t)n * LORA_K + kk] = (bf16_t)f2bf(v);
        }
    }
}

__device__ __forceinline__ void phase_modh(const Ctx& C, const Args& A, int l) {
    const float* X = (const float*)(A.ws + WS_X); bf16_t* H = (bf16_t*)(A.ws + WS_H); const float* MOD = (const float*)(A.ws + WS_MOD) + (size_t)l * 5 * 6144;
    for (int row = C.gw; row < MROWS; row += C.NGW) {
        const float* md = MOD + row_mi(row) * 6144;
#pragma unroll
        for (int j = 0; j < 4; ++j) { const int col = 4 * C.lane + 256 * j; const f32x4 x = *(const f32x4*)(X + (size_t)row * DM + col), sh = *(const f32x4*)(md + col), sc = *(const f32x4*)(md + DM + col);
            const f32x4 h = x * (sc + 1.f) + sh; u32x2 o; o.x = pk2(h[0], h[1]); o.y = pk2(h[2], h[3]); *(u32x2*)(H + (size_t)row * DM + col) = o; }
    }
}

__device__ __forceinline__ f32x4 ld4bf(const bf16_t* p) { const u32x2 u = *(const u32x2*)p; return (f32x4){bflo(u.x), bfhi(u.x), bflo(u.y), bfhi(u.y)}; }
__device__ __forceinline__ void st4bf(bf16_t* p, f32x4 v) { u32x2 o; o.x = pk2(v[0], v[1]); o.y = pk2(v[2], v[3]); *(u32x2*)p = o; }
__device__ __forceinline__ void seq_info(int row, bool& hasp, bool& hasn) {
    if (row < NLAT) { const int t = row & (TT - 1); hasp = t > 0; hasn = t < TT - 1; }
    else { const int t = (row - NLAT) & (CTXL - 1); hasp = t > 0; hasn = t < CTXL - 1; }
}
struct Ef1Row { u32x2 bg, ua, ub, m[11]; };
__device__ __forceinline__ f32x4 bf4(u32x2 u) { return (f32x4){bflo(u.x), bfhi(u.x), bflo(u.y), bfhi(u.y)}; }
__device__ __forceinline__ void ef1_load(Ef1Row& R, const bf16_t* P, int row, int lane) {
    row = row < 0 ? 0 : row > MROWS - 1 ? MROWS - 1 : row;
    const bf16_t* p = P + (size_t)row * P_LD + 4 * lane;
    R.bg = *(const u32x2*)p; R.ua = *(const u32x2*)(p + 256); R.ub = *(const u32x2*)(p + 512);
#pragma unroll
    for (int it = 0; it < 11; ++it) R.m[it] = *(const u32x2*)(p + 768 + it * 256);
}
__device__ __forceinline__ void phase_ef1(const Ctx& C, const Args& A, int l) {
    const int i2 = l >> 1; unsigned char* ws = A.ws;
    const bf16_t* P = (const bf16_t*)(ws + WS_P); bf16_t* A2 = (bf16_t*)(ws + WS_A2); unsigned char* SCN = ws + WS_SCN; bf16_t* LIN = (bf16_t*)(ws + WS_LIN);
    const float* cw = A.in[I_CONVW] + (size_t)i2 * 3 * 256; const float* mu = A.in[I_MU] + (size_t)i2 * RWKV_COLS; const float* kxi = A.in[I_KXI] + (size_t)i2 * 768;
    const int j4 = 4 * C.lane;
    const f32x4 w0 = *(const f32x4*)(cw + j4), w1 = *(const f32x4*)(cw + 256 + j4), w2 = *(const f32x4*)(cw + 512 + j4);
    f32x4 mur[11], kxr[3];
#pragma unroll
    for (int it = 0; it < 11; ++it) mur[it] = (it * 256 + j4 < RWKV_COLS) ? *(const f32x4*)(mu + it * 256 + j4) : (f32x4){0.f, 0.f, 0.f, 0.f};
#pragma unroll
    for (int it = 0; it < 3; ++it) kxr[it] = *(const f32x4*)(kxi + it * 256 + j4);
    const int row0 = (int)(((long)C.gw * MROWS) / C.NGW), row1 = (int)(((long)(C.gw + 1) * MROWS) / C.NGW);
    Ef1Row Ra, Rb, Rc, Rd;
    ef1_load(Ra, P, row0 - 1, C.lane); ef1_load(Rb, P, row0, C.lane); ef1_load(Rc, P, row0 + 1, C.lane);
    for (int row = row0; row < row1; ++row) {
        ef1_load(Rd, P, row + 2, C.lane);
        bool hasp, hasn; seq_info(row, hasp, hasn);
        const float fp = hasp ? 1.f : 0.f, fn = hasn ? 1.f : 0.f;
        {
            const f32x4 bg = bf4(Rb.bg), u0 = bf4(Rb.ua) * bf4(Rb.ub), um = bf4(Ra.ua) * bf4(Ra.ub) * fp, up = bf4(Rc.ua) * bf4(Rc.ub) * fn;
            st4bf(A2 + (size_t)row * DM + j4, bg * (w0 * um + w1 * u0 + w2 * up));
        }
#pragma unroll
        for (int it = 0; it < 11; ++it) {
            const int c = it * 256 + j4;
            if (c < RWKV_COLS) {
                const f32x4 x0 = bf4(Rb.m[it]), xm = bf4(Ra.m[it]) * fp, xp = bf4(Rc.m[it]) * fn, m4 = mur[it];
                const f32x4 ps = x0 + m4 * ((xm + xp) * 0.5f - x0);
                if (it < 3) { const int head = c >> 6, kx = c & 63; st4bf_(SCN + (size_t)(row * 12 + head) * SC_REC + SC_R + kx * 2, ps); }
                else if (it < 6) { const int c1 = c - 768, head = c1 >> 6, kx = c1 & 63; const f32x4 kv = ps * kxr[it < 6 ? (it >= 3 ? it - 3 : 0) : 0];
                    const float ss = sum16(kv[0] * kv[0] + kv[1] * kv[1] + kv[2] * kv[2] + kv[3] * kv[3]); const float rn = rsqrtf(ss + 1e-12f);
                    unsigned char* base = SCN + (size_t)(row * 12 + head) * SC_REC + kx * 2;
                    st4bf_(base + SC_KK, kv * rn); st4bf_(base + SC_KR, ps); st4bf_(base + SC_KR + 256, ps); }
                else if (it < 9) { const int c1 = c - 1536, head = c1 >> 6, kx = c1 & 63; st4bf_(SCN + (size_t)(row * 12 + head) * SC_REC + SC_V + kx * 2, ps); }
                else { const int c1 = c - 2304; f32x4 o;
                    if (c1 < 128) { o = (f32x4){tanhf(ps[0]), tanhf(ps[1]), tanhf(ps[2]), tanhf(ps[3])}; }
                    else if (c1 < 256) { o = ps; }
                    else { o = (f32x4){sigmoidf_(ps[0]), sigmoidf_(ps[1]), sigmoidf_(ps[2]), sigmoidf_(ps[3])}; }
                    st4bf(LIN + (size_t)row * LORA_K + c1, o); }
            }
        }
        Ra = Rb; Rb = Rc; Rc = Rd;
    }
}

__device__ __forceinline__ int scan_row(int i, int b, int d) {
    if (d == 0) return i < CTXL ? NLAT + b * CTXL + i : b * TT + (i - CTXL);
    return i < CTXL ? NLAT + b * CTXL + (CTXL - 1 - i) : b * TT + (TT - 1 - (i - CTXL));
}
__device__ __forceinline__ float red8(float v) {
    v += __uint_as_float((unsigned)__builtin_amdgcn_update_dpp(0, (int)__float_as_uint(v), 0xB1, 0xF, 0xF, true));
    v += __uint_as_float((unsigned)__builtin_amdgcn_update_dpp(0, (int)__float_as_uint(v), 0x4E, 0xF, 0xF, true));
    v += __uint_as_float((unsigned)__builtin_amdgcn_update_dpp(0, (int)__float_as_uint(v), 0x141, 0xF, 0xF, true));
    return v;
}
__device__ __forceinline__ float red16(float v) {
    v += __uint_as_float((unsigned)__builtin_amdgcn_update_dpp(0, (int)__float_as_uint(v), 0xB1, 0xF, 0xF, true));
    v += __uint_as_float((unsigned)__builtin_amdgcn_update_dpp(0, (int)__float_as_uint(v), 0x4E, 0xF, 0xF, true));
    v += __uint_as_float((unsigned)__builtin_amdgcn_update_dpp(0, (int)__float_as_uint(v), 0x141, 0xF, 0xF, true));
    v += __uint_as_float((unsigned)__builtin_amdgcn_update_dpp(0, (int)__float_as_uint(v), 0x140, 0xF, 0xF, true));
    return v;
}
__device__ __forceinline__ void phase_scan(const Ctx& C, const Args& A) {
    for (int u = blockIdx.x; u < 192; u += C.G) {
    const int half = u & 1, d = (u >> 1) & 1, h = (u >> 2) % 12, b = u / 48;
    const unsigned char* SCN = A.ws + WS_SCN; float* Y = (float*)(A.ws + WS_Y) + (size_t)d * MROWS * 768;
    LAS float* buf = (LAS float*)C.lds; LAS float* ybuf = buf + 2 * 32 * 352;
    constexpr int NCH = LKEYS / 32;
    u32x4 st[4];
    int ps_[4], psrc[4], pdst[4]; bool pf32[4];
#pragma unroll
    for (int j = 0; j < 4; ++j) { const int p = C.tid + NTHR * j; const int s = p / 52, q = p % 52; ps_[j] = s;
        if (q < 16) { psrc[j] = SC_W + 256 * d + q * 16; pdst[j] = s * 352 + q * 4; pf32[j] = true; }
        else if (q < 48) { const int vec = (q - 16) >> 3, part = (q - 16) & 7; const int so = vec == 0 ? SC_KK : vec == 1 ? SC_B + 256 * d : vec == 2 ? SC_KR + 256 * d : SC_R;
            psrc[j] = so + part * 16; pdst[j] = s * 352 + 64 * (vec + 1) + part * 8; pf32[j] = false; }
        else { const int part = q - 48; psrc[j] = SC_V + half * 64 + part * 16; pdst[j] = s * 352 + 320 + part * 8; pf32[j] = false; } }
    const int sgn = d ? -1 : 1;
    const unsigned char* SCNh = SCN + (size_t)h * SC_REC;
#define SCAN_ROW0(c) (((c) * 32 < CTXL) ? (NLAT + b * CTXL + (d ? CTXL - 1 - (c) * 32 : (c) * 32)) : (b * TT + (d ? TT - 1 - ((c) * 32 - CTXL) : (c) * 32 - CTXL)))
#define SCAN_LOADG(c) do { const int row0_ = SCAN_ROW0(c); _Pragma("unroll") for (int j = 0; j < 4; ++j) if (j < 3 || C.tid < 1664 - 3 * NTHR) { \
        st[j] = *(const u32x4*)(SCNh + (size_t)(row0_ + sgn * ps_[j]) * SC_ROW + psrc[j]); } } while (0)
#define SCAN_STORE(bi) do { _Pragma("unroll") for (int j = 0; j < 4; ++j) if (j < 3 || C.tid < 1664 - 3 * NTHR) { LAS float* dp = buf + (bi) * (32 * 352) + pdst[j]; \
        if (pf32[j]) *(LAS u32x4*)dp = st[j]; \
        else { *(LAS f32x4*)dp = (f32x4){bflo(st[j].x), bfhi(st[j].x), bflo(st[j].y), bfhi(st[j].y)}; *(LAS f32x4*)(dp + 4) = (f32x4){bflo(st[j].z), bfhi(st[j].z), bflo(st[j].w), bfhi(st[j].w)}; } } } while (0)
    SCAN_LOADG(0); SCAN_STORE(0); __syncthreads();
    f32x2 Sa = {0.f, 0.f}, Sb = {0.f, 0.f};
    const int rl = C.lane >> 4, ks = C.lane & 15;
    float ycol = 0.f;
#define SC_LD(R, s) do { const LAS float* bp_ = cur + (s) * 352 + ks * 4; \
        R##w = *(const LAS f32x4*)(bp_); R##k = *(const LAS f32x4*)(bp_ + 64); R##b = *(const LAS f32x4*)(bp_ + 128); R##q = *(const LAS f32x4*)(bp_ + 192); R##r = *(const LAS f32x4*)(bp_ + 256); \
        R##vv = cur[(s) * 352 + 320 + C.wave * 4 + rl]; } while (0)
#define SC_LO(v) ((f32x2){v[0], v[1]})
#define SC_HI(v) ((f32x2){v[2], v[3]})
#define SC_DPP(x, ctrl) __uint_as_float((unsigned)__builtin_amdgcn_update_dpp(0, (int)__float_as_uint(x), ctrl, 0xF, 0xF, true))
#define SC_STEP(R, P, s) do { \
        f32x2 pa = __builtin_elementwise_fma(Sb, SC_HI(R##k), Sa * SC_LO(R##k)), py = __builtin_elementwise_fma(Sb, SC_HI(P##r), Sa * SC_LO(P##r)); \
        float a_ = pa.x + pa.y, y_ = py.x + py.y; \
        a_ += SC_DPP(a_, 0xB1); y_ += SC_DPP(y_, 0xB1); a_ += SC_DPP(a_, 0x4E); y_ += SC_DPP(y_, 0x4E); \
        a_ += SC_DPP(a_, 0x141); y_ += SC_DPP(y_, 0x141); a_ += SC_DPP(a_, 0x140); y_ += SC_DPP(y_, 0x140); \
        ycol = (ks == ((s) & 15)) ? y_ : ycol; \
        const f32x2 na = {-a_, -a_}, vv2 = {R##vv, R##vv}; \
        Sa = __builtin_elementwise_fma(Sa, SC_LO(R##w), __builtin_elementwise_fma(na, SC_LO(R##b), vv2 * SC_LO(R##q))); \
        Sb = __builtin_elementwise_fma(Sb, SC_HI(R##w), __builtin_elementwise_fma(na, SC_HI(R##b), vv2 * SC_HI(R##q))); } while (0)
    f32x4 Aw, Ak, Ab, Aq, Ar, Bw, Bk, Bb, Bq, Br, Cw, Ck, Cb, Cq, Cr, Dw, Dk, Db, Dq, Dr; float Avv, Bvv, Cvv, Dvv;
    Dr = (f32x4){0.f, 0.f, 0.f, 0.f};
    for (int c = 0; c < NCH; ++c) {
        if (c + 1 < NCH) SCAN_LOADG(c + 1);
        {
            const LAS float* cur = buf + (c & 1) * (32 * 352);
            LAS float* yb = ybuf + (c & 1) * 1024 + C.wave * 4 + rl + ks * 32;
            SC_LD(A, 0); SC_LD(B, 1);
#pragma unroll 1
            for (int s = 0; s < 32; s += 4) {
                SC_LD(C, s + 2); __builtin_amdgcn_sched_barrier(0); SC_STEP(A, D, s); __builtin_amdgcn_sched_barrier(0);
                SC_LD(D, s + 3); __builtin_amdgcn_sched_barrier(0); SC_STEP(B, A, s + 1); __builtin_amdgcn_sched_barrier(0);
                SC_LD(A, s + 4); __builtin_amdgcn_sched_barrier(0); SC_STEP(C, B, s + 2); __builtin_amdgcn_sched_barrier(0);
                SC_LD(B, s + 5); __builtin_amdgcn_sched_barrier(0); SC_STEP(D, C, s + 3); __builtin_amdgcn_sched_barrier(0);
                if ((s & 15) == 12) yb[(s & 16) * 32] = ycol;
            }
        }
        if (c + 1 < NCH) SCAN_STORE((c + 1) & 1);
        __syncthreads();
        { const int row0_ = SCAN_ROW0(c);
#pragma unroll
          for (int i = 0; i < 2; ++i) { const int e = C.tid + NTHR * i, s = e >> 5, r = e & 31;
            const int row = (s > 0) ? row0_ + sgn * (s - 1) : scan_row(c * 32 - 1, b, d);
            if (s > 0 || c > 0) Y[(size_t)row * 768 + h * 64 + half * 32 + r] = ybuf[(c & 1) * 1024 + e]; } }
    }
    {
        f32x2 py = __builtin_elementwise_fma(Sb, SC_HI(Dr), Sa * SC_LO(Dr)); float y_ = py.x + py.y;
        y_ += SC_DPP(y_, 0xB1); y_ += SC_DPP(y_, 0x4E); y_ += SC_DPP(y_, 0x141); y_ += SC_DPP(y_, 0x140);
        if (ks == 0) Y[(size_t)scan_row(LKEYS - 1, b, d) * 768 + h * 64 + half * 32 + C.wave * 4 + rl] = y_;
    }
    __syncthreads();
    }
#undef SCAN_LOADG
#undef SCAN_STORE
#undef SCAN_ROW0
#undef SC_LD
#undef SC_STEP
#undef SC_LO
#undef SC_HI
#undef SC_DPP
}

constexpr int CSP = 72;
constexpr int CS_MAT = 64 * CSP * 2;
constexpr int CS_WT = 0, CS_KB = CS_MAT, CS_BB = 2 * CS_MAT, CS_RT = 3 * CS_MAT, CS_BHT = 4 * CS_MAT, CS_KHT = 5 * CS_MAT, CS_VMT = 6 * CS_MAT;
constexpr int CS_M2F = 7 * CS_MAT;
constexpr int CS_M1T = CS_M2F + 16384;
constexpr int CS_N2 = CS_M1T + CS_MAT;
constexpr int CS_GT = CS_N2 + CS_MAT;
constexpr int CS_Z = CS_M2F, CS_U = CS_M2F + CS_MAT;
constexpr int CS_GL = CS_GT + 2 * CS_MAT;
static_assert(CS_GL + 256 <= LDS_MISC, "chunked-scan LDS map");
template <bool SWZB = false>
__device__ __forceinline__ void cs_mma(f32x16& acc, const LAS unsigned char* Am, const LAS unsigned char* Bm, int ti, int tj, int r32, int hi) {
    const LAS unsigned char* ap = Am + (ti * 32 + r32) * (CSP * 2) + hi * 16; const int brow = tj * 32 + r32; const LAS unsigned char* bp = Bm + brow * (CSP * 2);
    const int sw = SWZB ? ((brow >> 3) & 7) : 0;
#pragma unroll
    for (int ks = 0; ks < 4; ++ks) acc = __builtin_amdgcn_mfma_f32_32x32x16_bf16(*(const LAS bf16x8*)(ap + ks * 32), *(const LAS bf16x8*)(bp + (((ks * 2 + hi) ^ sw) * 16)), acc, 0, 0, 0);
}
__device__ __forceinline__ void cs_store_t(LAS unsigned char* Om, const f32x16& acc, int ti, int tj, int r32, int hi) {
    LAS unsigned char* op = Om + (tj * 32 + r32) * (CSP * 2) + (ti * 32 + 4 * hi) * 2;
#pragma unroll
    for (int g = 0; g < 4; ++g) { u32x2 o; o.x = pk2(acc[4 * g], acc[4 * g + 1]); o.y = pk2(acc[4 * g + 2], acc[4 * g + 3]); *(LAS u32x2*)(op + g * 16) = o; }
}
#define CS_BAR() asm volatile("s_waitcnt lgkmcnt(0)\n\ts_barrier" ::: "memory")
__device__ __forceinline__ void phase_csa(const Ctx& C, const Args& A) {
    const unsigned char* SCN = A.ws + WS_SCN; unsigned char* CHK = A.ws + WS_CHK;
    LAS unsigned char* L = C.lds;
    const int r32 = C.lane & 31, hi = C.lane >> 5;
    float lwv[8]; u32x4 ukk, ub, ukr, ur, uv;
#define CSA_GEOM(cu_) const int unit = (cu_) / CS_NCH, ch = (cu_) % CS_NCH; const int d = unit & 1, h = (unit >> 1) % 12, b = unit / 24; \
        const int step0 = ch * CS_L; const int sgn = d ? -1 : 1; \
        const int row0 = (step0 < CTXL) ? (NLAT + b * CTXL + (d ? CTXL - 1 - step0 : step0)) : (b * TT + (d ? TT - 1 - (step0 - CTXL) : step0 - CTXL)); \
        const unsigned char* rec0 = SCN + (size_t)row0 * SC_ROW + (size_t)h * SC_REC;
#define CSA_LOAD(cu_) do { CSA_GEOM(cu_); \
        { const int k = C.tid & 63, sg = C.tid >> 6; _Pragma("unroll") for (int j = 0; j < 8; ++j) lwv[j] = *(const float*)(rec0 + (long)sgn * (8 * sg + j) * SC_ROW + SC_W + 256 * d + k * 4); } \
        { const int t = C.tid >> 3, k0 = (C.tid & 7) * 8; const unsigned char* rp = rec0 + (long)sgn * t * SC_ROW; \
          ukk = *(const u32x4*)(rp + SC_KK + k0 * 2); ub = *(const u32x4*)(rp + SC_B + 256 * d + k0 * 2); ukr = *(const u32x4*)(rp + SC_KR + 256 * d + k0 * 2); ur = *(const u32x4*)(rp + SC_R + k0 * 2); uv = *(const u32x4*)(rp + SC_V + k0 * 2); } } while (0)
    if ((int)blockIdx.x < CS_UNITS * CS_NCH) CSA_LOAD((int)blockIdx.x);
    for (int cu = blockIdx.x; cu < CS_UNITS * CS_NCH; cu += C.G) {
        LAS float* csf = (LAS float*)(L + CS_M2F);
        LAS float* seg = (LAS float*)(L + CS_N2);
        { const int k = C.tid & 63, sg = C.tid >> 6;
#pragma unroll
          for (int j = 1; j < 8; ++j) lwv[j] += lwv[j - 1];
          seg[sg * 64 + k] = lwv[7];
          CS_BAR();
          float off = 0.f, tot = 0.f;
#pragma unroll
          for (int s2 = 0; s2 < 8; ++s2) { const float v = seg[s2 * 64 + k]; off += (s2 < sg) ? v : 0.f; tot += v; }
#pragma unroll
          for (int j = 0; j < 8; ++j) csf[(8 * sg + j) * 65 + k] = lwv[j] + off;
          if (sg == 7) ((LAS float*)(L + CS_GL))[k] = __expf(tot); }
        CS_BAR();
        { const int t = C.tid >> 3, k0 = (C.tid & 7) * 8;
          float wt[8], kb[8], bb[8], rt[8], bh[8], kh[8];
#pragma unroll
          for (int j = 0; j < 8; ++j) { const unsigned pkk = j < 2 ? ukk.x : j < 4 ? ukk.y : j < 6 ? ukk.z : ukk.w, pb = j < 2 ? ub.x : j < 4 ? ub.y : j < 6 ? ub.z : ub.w, pkr = j < 2 ? ukr.x : j < 4 ? ukr.y : j < 6 ? ukr.z : ukr.w, pr = j < 2 ? ur.x : j < 4 ? ur.y : j < 6 ? ur.z : ur.w;
              const float kkv = (j & 1) ? bfhi(pkk) : bflo(pkk), bv = (j & 1) ? bfhi(pb) : bflo(pb), krv = (j & 1) ? bfhi(pkr) : bflo(pkr), rv = (j & 1) ? bfhi(pr) : bflo(pr);
              const float cst = csf[t * 65 + k0 + j], csp = t > 0 ? csf[(t - 1) * 65 + k0 + j] : 0.f, csl = csf[63 * 65 + k0 + j];
              const float einv = __expf(-cst), el = __expf(csl - cst);
              wt[j] = kkv * __expf(csp); kb[j] = krv * einv; bb[j] = bv * einv; rt[j] = rv * __expf(cst); bh[j] = bv * el; kh[j] = krv * el; }
          u32x4 o;
          o.x = pk2(wt[0], wt[1]); o.y = pk2(wt[2], wt[3]); o.z = pk2(wt[4], wt[5]); o.w = pk2(wt[6], wt[7]); *(LAS u32x4*)(L + CS_WT + t * (CSP * 2) + k0 * 2) = o;
          o.x = pk2(kb[0], kb[1]); o.y = pk2(kb[2], kb[3]); o.z = pk2(kb[4], kb[5]); o.w = pk2(kb[6], kb[7]); *(LAS u32x4*)(L + CS_KB + t * (CSP * 2) + k0 * 2) = o;
          o.x = pk2(bb[0], bb[1]); o.y = pk2(bb[2], bb[3]); o.z = pk2(bb[4], bb[5]); o.w = pk2(bb[6], bb[7]); *(LAS u32x4*)(L + CS_BB + t * (CSP * 2) + k0 * 2) = o;
          o.x = pk2(rt[0], rt[1]); o.y = pk2(rt[2], rt[3]); o.z = pk2(rt[4], rt[5]); o.w = pk2(rt[6], rt[7]); *(LAS u32x4*)(L + CS_RT + t * (CSP * 2) + k0 * 2) = o;
#pragma unroll
          for (int j = 0; j < 8; ++j) { const int to = ((((t >> 3) ^ ((k0 >> 3) & 7)) * 8) + (t & 7)) * 2;
              *(LAS bf16_t*)(L + CS_BHT + (k0 + j) * (CSP * 2) + to) = (bf16_t)f2bf(bh[j]); *(LAS bf16_t*)(L + CS_KHT + (k0 + j) * (CSP * 2) + to) = (bf16_t)f2bf(kh[j]);
              const unsigned pv = j < 2 ? uv.x : j < 4 ? uv.y : j < 6 ? uv.z : uv.w; *(LAS bf16_t*)(L + CS_VMT + (k0 + j) * (CSP * 2) + to) = (bf16_t)((j & 1) ? (pv >> 16) : (pv & 0xffffu)); } }
        if (cu + C.G < CS_UNITS * CS_NCH) CSA_LOAD(cu + C.G);
        CS_BAR();
        for (int job = C.wave; job < 12; job += NWAVES) { const int p = job >> 2, ti = (job >> 1) & 1, tj = job & 1;
            f32x16 acc;
#pragma unroll
            for (int i = 0; i < 16; ++i) acc[i] = 0.f;
            if (p == 0) { cs_mma(acc, L + CS_WT, L + CS_BB, ti, tj, r32, hi);
                const int i = tj * 32 + r32; LAS float* mp = (LAS float*)(L + CS_M2F) + i * 64;
#pragma unroll
                for (int reg = 0; reg < 16; ++reg) { const int t = ti * 32 + crow(reg, hi); mp[(t & 3) * 16 + (t >> 2)] = (i < t) ? acc[reg] : 0.f; } }
            else if (p == 1) { cs_mma(acc, L + CS_WT, L + CS_KB, ti, tj, r32, hi);
                const int i = tj * 32 + r32;
#pragma unroll
                for (int reg = 0; reg < 16; ++reg) { const int t = ti * 32 + crow(reg, hi); acc[reg] = (i < t) ? acc[reg] : 0.f; }
                cs_store_t(L + CS_M1T, acc, ti, tj, r32, hi); }
            else { cs_mma(acc, L + CS_BB, L + CS_RT, ti, tj, r32, hi);
                const int t = tj * 32 + r32;
#pragma unroll
                for (int reg = 0; reg < 16; ++reg) { const int i = ti * 32 + crow(reg, hi); acc[reg] = (i <= t) ? acc[reg] : 0.f; }
                cs_store_t(L + CS_N2, acc, ti, tj, r32, hi); } }
        CS_BAR();
        { const int c = C.tid >> 2, q = C.tid & 3; float acc[16];
          { const LAS unsigned char* rcol = (c < 64) ? (L + CS_WT + c * 2) : (L + CS_M1T + (c - 64) * (CSP * 2)); const int rstride = (c < 64) ? CSP * 2 : 2;
#pragma unroll
            for (int j = 0; j < 16; ++j) acc[j] = bf2f(*(const LAS bf16_t*)(rcol + (4 * j + q) * rstride)); }
          const LAS float* m2c = (const LAS float*)(L + CS_M2F) + q * 16;
#pragma clang loop unroll(full)
          for (int i = 0; i < 64; ++i) {
              const float mine = -acc[i >> 2];
              float gi;
              switch (i & 3) { case 0: gi = __uint_as_float((unsigned)__builtin_amdgcn_update_dpp(0, (int)__float_as_uint(mine), 0x00, 0xF, 0xF, true)); break;
                               case 1: gi = __uint_as_float((unsigned)__builtin_amdgcn_update_dpp(0, (int)__float_as_uint(mine), 0x55, 0xF, 0xF, true)); break;
                               case 2: gi = __uint_as_float((unsigned)__builtin_amdgcn_update_dpp(0, (int)__float_as_uint(mine), 0xAA, 0xF, 0xF, true)); break;
                               default: gi = __uint_as_float((unsigned)__builtin_amdgcn_update_dpp(0, (int)__float_as_uint(mine), 0xFF, 0xF, 0xF, true)); break; }
#pragma unroll
              for (int j4 = (i >> 4); j4 < 4; ++j4) { const f32x4 m = *(const LAS f32x4*)(m2c + i * 64 + j4 * 4);
#pragma unroll
                  for (int e = 0; e < 4; ++e) if (4 * j4 + e >= (i >> 2)) acc[4 * j4 + e] += m[e] * gi; }
          }
#pragma unroll
          for (int j = 0; j < 16; ++j) *(LAS bf16_t*)(L + CS_GT + c * (CSP * 2) + (4 * j + q) * 2) = (bf16_t)f2bf(-acc[j]); }
        CS_BAR();
        unsigned char* outp = CHK + (size_t)cu * 32768;
        for (int job = C.wave; job < 16; job += NWAVES) { const int p = job >> 2, ti = (job >> 1) & 1, tj = job & 1;
            f32x16 acc;
            if (p == 0) {
                const LAS unsigned char* rp = L + CS_RT + (tj * 32 + r32) * (CSP * 2) + (ti * 32 + 4 * hi) * 2;
#pragma unroll
                for (int g = 0; g < 4; ++g) { const u32x2 u = *(const LAS u32x2*)(rp + g * 16); acc[4 * g] = bflo(u.x); acc[4 * g + 1] = bfhi(u.x); acc[4 * g + 2] = bflo(u.y); acc[4 * g + 3] = bfhi(u.y); }
                cs_mma(acc, L + CS_GT, L + CS_N2, ti, tj, r32, hi);
#pragma unroll
                for (int g = 0; g < 4; ++g) { u32x2 o; o.x = pk2(acc[4 * g], acc[4 * g + 1]); o.y = pk2(acc[4 * g + 2], acc[4 * g + 3]);
                    *(u32x2*)(outp + 8192 + (((tj * 4 + 2 * ti + (g >> 1)) * 64 + (g & 1) * 32 + r32) * 16) + hi * 8) = o; } }
            else if (p == 1) {
#pragma unroll
                for (int i = 0; i < 16; ++i) acc[i] = 0.f;
                cs_mma(acc, L + CS_KB, L + CS_RT, ti, tj, r32, hi);
                const int t = tj * 32 + r32;
#pragma unroll
                for (int reg = 0; reg < 16; ++reg) { const int i = ti * 32 + crow(reg, hi); acc[reg] = (i <= t) ? acc[reg] : 0.f; }
                cs_mma(acc, L + CS_GT + 64 * (CSP * 2), L + CS_N2, ti, tj, r32, hi);
                cs_store_t(L + CS_Z, acc, ti, tj, r32, hi); }
            else if (p == 2) {
#pragma unroll
                for (int i = 0; i < 16; ++i) acc[i] = 0.f;
                cs_mma<true>(acc, L + CS_GT, L + CS_BHT, ti, tj, r32, hi);
                const int k = tj * 32 + r32; const float gl = ((const LAS float*)(L + CS_GL))[k];
#pragma unroll
                for (int reg = 0; reg < 16; ++reg) { const int cc = ti * 32 + crow(reg, hi); acc[reg] += (cc == k) ? gl : 0.f; }
#pragma unroll
                for (int g = 0; g < 4; ++g) { u32x2 o; o.x = pk2(acc[4 * g], acc[4 * g + 1]); o.y = pk2(acc[4 * g + 2], acc[4 * g + 3]);
                    *(u32x2*)(outp + (((tj * 4 + 2 * ti + (g >> 1)) * 64 + (g & 1) * 32 + r32) * 16) + hi * 8) = o; } }
            else {
                const int krow = tj * 32 + r32; const LAS unsigned char* kp = L + CS_KHT + krow * (CSP * 2) + hi * 8;
#pragma unroll
                for (int g = 0; g < 4; ++g) { const u32x2 u = *(const LAS u32x2*)(kp + (((ti * 4 + g) ^ ((krow >> 3) & 7)) * 16)); acc[4 * g] = bflo(u.x); acc[4 * g + 1] = bfhi(u.x); acc[4 * g + 2] = bflo(u.y); acc[4 * g + 3] = bfhi(u.y); }
                cs_mma<true>(acc, L + CS_GT + 64 * (CSP * 2), L + CS_BHT, ti, tj, r32, hi);
                cs_store_t(L + CS_U, acc, ti, tj, r32, hi); } }
        CS_BAR();
        { const int p = C.wave >> 2, ti = (C.wave >> 1) & 1, tj = C.wave & 1;
          f32x16 acc;
#pragma unroll
          for (int i = 0; i < 16; ++i) acc[i] = 0.f;
          cs_mma<true>(acc, L + (p ? CS_U : CS_Z), L + CS_VMT, ti, tj, r32, hi);
          unsigned char* op = outp + (p ? 16384 : 24576) + ((ti * 2 + tj) * 64 + C.lane) * 32;
          u32x4 o0, o1; o0.x = pk2(acc[0], acc[1]); o0.y = pk2(acc[2], acc[3]); o0.z = pk2(acc[4], acc[5]); o0.w = pk2(acc[6], acc[7]);
          o1.x = pk2(acc[8], acc[9]); o1.y = pk2(acc[10], acc[11]); o1.z = pk2(acc[12], acc[13]); o1.w = pk2(acc[14], acc[15]);
          *(u32x4*)op = o0; *(u32x4*)(op + 16) = o1; }
        CS_BAR();
    }
}
__device__ __forceinline__ void phase_csb(const Ctx& C, const Args& A, int l) {
    if ((int)blockIdx.x >= CS_UNITS) { conv_items(C, A, l + 1, ((int)blockIdx.x - CS_UNITS) * NWAVES + C.wave, (C.G - CS_UNITS) * NWAVES, true, false, true); return; }
    const unsigned char* CHK = A.ws + WS_CHK;
    LAS unsigned char* L = C.lds;
    const int r32 = C.lane & 31, hi = C.lane >> 5;
    const bool isS = C.wave < 4; const int ti = (C.wave >> 1) & 1, tj = C.wave & 1;
    for (int unit = blockIdx.x; unit < CS_UNITS; unit += C.G) {
        const int d = unit & 1, h = (unit >> 1) % 12, b = unit / 24;
        float* Y = (float*)(A.ws + WS_Y) + (size_t)d * MROWS * 768;
        for (int i = C.tid; i < 2 * CS_MAT / 4; i += NTHR) ((LAS unsigned*)L)[i] = 0u;
        CS_BAR();
        bf16x8 afA[4], afB[4], afC[4]; u32x4 cA0, cA1, cB0, cB1, cC0, cC1;
#define CSB_LOAD(A4, C0, C1, ch_) do { const unsigned char* op_ = CHK + ((size_t)unit * CS_NCH + (ch_)) * 32768; \
            const unsigned char* am_ = op_ + (isS ? 0 : 8192) + (ti * 4 * 64 + C.lane) * 16;     \
            _Pragma("unroll") for (int ks = 0; ks < 4; ++ks) A4[ks] = *(const bf16x8*)(am_ + ks * 1024); \
            const unsigned char* cp_ = op_ + (isS ? 16384 : 24576) + ((ti * 2 + tj) * 64 + C.lane) * 32; C0 = *(const u32x4*)cp_; C1 = *(const u32x4*)(cp_ + 16); } while (0)
#define CSB_STEP(A4, C0, C1, ch_) do { \
            const LAS unsigned char* Sb = L + ((ch_) & 1) * CS_MAT; LAS unsigned char* Sn = L + (((ch_) + 1) & 1) * CS_MAT; \
            f32x16 acc; \
            acc[0] = bflo(C0.x); acc[1] = bfhi(C0.x); acc[2] = bflo(C0.y); acc[3] = bfhi(C0.y); acc[4] = bflo(C0.z); acc[5] = bfhi(C0.z); acc[6] = bflo(C0.w); acc[7] = bfhi(C0.w); \
            acc[8] = bflo(C1.x); acc[9] = bfhi(C1.x); acc[10] = bflo(C1.y); acc[11] = bfhi(C1.y); acc[12] = bflo(C1.z); acc[13] = bfhi(C1.z); acc[14] = bflo(C1.w); acc[15] = bfhi(C1.w); \
            const LAS unsigned char* bp = Sb + (tj * 32 + r32) * (CSP * 2) + hi * 16; \
            _Pragma("unroll") for (int ks = 0; ks < 4; ++ks) acc = __builtin_amdgcn_mfma_f32_32x32x16_bf16(A4[ks], *(const LAS bf16x8*)(bp + ks * 32), acc, 0, 0, 0); \
            if (isS) { cs_store_t(Sn, acc, ti, tj, r32, hi); }     \
            else {     \
                const int step0 = (ch_) * CS_L; const int sgn = d ? -1 : 1; \
                const int row0 = (step0 < CTXL) ? (NLAT + b * CTXL + (d ? CTXL - 1 - step0 : step0)) : (b * TT + (d ? TT - 1 - (step0 - CTXL) : step0 - CTXL)); \
                float* yp = Y + (size_t)(row0 + sgn * (ti * 32 + 4 * hi)) * 768 + h * 64 + tj * 32 + r32; const long ys = (long)sgn * 768; \
                _Pragma("unroll") for (int reg = 0; reg < 16; ++reg) yp[ys * ((reg & 3) + 8 * (reg >> 2))] = acc[reg]; } \
            CS_BAR(); } while (0)
        CSB_LOAD(afA, cA0, cA1, 0); CSB_LOAD(afB, cB0, cB1, 1);
        static_assert(CS_NCH % 3 == 0, "chunk loop is unrolled by three");
        for (int ch = 0; ch < CS_NCH; ch += 3) {
            if (ch == 0) CSB_LOAD(afC, cC0, cC1, 2);
            CSB_STEP(afA, cA0, cA1, ch);     if (ch + 3 < CS_NCH) CSB_LOAD(afA, cA0, cA1, ch + 3);
            CSB_STEP(afB, cB0, cB1, ch + 1); if (ch + 4 < CS_NCH) CSB_LOAD(afB, cB0, cB1, ch + 4);
            CSB_STEP(afC, cC0, cC1, ch + 2); if (ch + 5 < CS_NCH) CSB_LOAD(afC, cC0, cC1, ch + 5);
        }
        CS_BAR();
    }
#undef CSB_LOAD
#undef CSB_STEP
}

#undef CS_BAR
struct Ef2Row { f32x4 y0[3], y1[3]; u32x2 r[3], v[3], k0[3], k1[3], g[3]; };
__device__ __forceinline__ void ef2_load(Ef2Row& R, const float* Y0, const float* Y1, const unsigned char* SCN, const bf16_t* G, int row, int lane) {
#pragma unroll
    for (int it = 0; it < 3; ++it) { const int c = it * 256 + 4 * lane, head = c >> 6, kx = c & 63;
        R.y0[it] = *(const f32x4*)(Y0 + (size_t)row * 768 + c); R.y1[it] = *(const f32x4*)(Y1 + (size_t)row * 768 + c);
        const unsigned char* base = SCN + (size_t)(row * 12 + head) * SC_REC + kx * 2;
        R.r[it] = *(const u32x2*)(base + SC_R); R.v[it] = *(const u32x2*)(base + SC_V); R.k0[it] = *(const u32x2*)(base + SC_KR); R.k1[it] = *(const u32x2*)(base + SC_KR + 256);
        R.g[it] = *(const u32x2*)(G + (size_t)row * 768 + c); }
}
__device__ __forceinline__ void phase_ef2(const Ctx& C, const Args& A, int l) {
    const int i2 = l >> 1; unsigned char* ws = A.ws;
    const unsigned char* SCN = ws + WS_SCN; const float* Y0 = (const float*)(ws + WS_Y); const float* Y1 = Y0 + (size_t)MROWS * 768;
    const bf16_t* G = (const bf16_t*)(ws + WS_G); bf16_t* A2 = (bf16_t*)(ws + WS_A2);
    const float* rb = A.in[I_RBON] + (size_t)i2 * 768; const float* gg = A.in[I_GNG] + (size_t)i2 * 768; const float* gb = A.in[I_GNB] + (size_t)i2 * 768;
    f32x4 rbr[3], ggr[3], gbr[3];
#pragma unroll
    for (int it = 0; it < 3; ++it) { const int c = it * 256 + 4 * C.lane; rbr[it] = *(const f32x4*)(rb + c); ggr[it] = *(const f32x4*)(gg + c); gbr[it] = *(const f32x4*)(gb + c); }
    Ef2Row Rn;
    if (C.gw < MROWS) ef2_load(Rn, Y0, Y1, SCN, G, C.gw, C.lane);
    for (int row = C.gw; row < MROWS; row += C.NGW) {
        const Ef2Row R = Rn;
        { const int nr = row + C.NGW < MROWS ? row + C.NGW : row; ef2_load(Rn, Y0, Y1, SCN, G, nr, C.lane); }
#pragma unroll
        for (int it = 0; it < 3; ++it) {
            const int c = it * 256 + 4 * C.lane;
            const f32x4 y = R.y0[it] + R.y1[it];
            const float mean = sum16((y[0] + y[1]) + (y[2] + y[3])) * (1.f / 64.f);
            const f32x4 dd = y - mean;
            const float var = sum16((dd[0] * dd[0] + dd[1] * dd[1]) + (dd[2] * dd[2] + dd[3] * dd[3])) * (1.f / 64.f);
            const float rstd = rsqrtf(var + GN_EPS);
            const f32x4 r = bf4(R.r[it]), v = bf4(R.v[it]), k0 = bf4(R.k0[it]), k1 = bf4(R.k1[it]);
            const f32x4 t = r * (k0 + k1) * 0.5f * rbr[it];
            const float bs = sum16((t[0] + t[1]) + (t[2] + t[3]));
            const f32x4 yn = dd * rstd * ggr[it] + gbr[it];
            const f32x4 g = bf4(R.g[it]);
            st4bf(A2 + (size_t)row * DM + 256 + c, g * (yn + v * bs));
        }
    }
}

__device__ __forceinline__ void phase_of1(const Ctx& C, const Args& A, int l) {
    const int i2 = l >> 1; unsigned char* ws = A.ws;
    const bf16_t* P = (const bf16_t*)(ws + WS_P); bf16_t* A2 = (bf16_t*)(ws + WS_A2); bf16_t* VT = (bf16_t*)(ws + WS_VT);
    const float* lng = A.in[I_GLNG] + (size_t)i2 * 256; const float* lnb = A.in[I_GLNB] + (size_t)i2 * 256;
    const float* gws = A.in[I_GWS] + (size_t)i2 * 4 * 128 * 128; const float* gbs = A.in[I_GBS] + (size_t)i2 * 4 * 128;
    LAS bf16_t* vt = (LAS bf16_t*)C.lds;
    LAS bf16_t* uL = (LAS bf16_t*)C.lds;
    LAS bf16_t* vT = (LAS bf16_t*)(C.lds + 128 * 528);
    const int r32 = C.lane & 31, hi = C.lane >> 5;
    for (int it = blockIdx.x; it < 256 + 8 * 7; it += C.G) {
        const bool isctx = it >= 256; const int uc = isctx ? (it - 256) / 7 : 0, pc = isctx ? (it - 256) % 7 : 0; const int u = it;
        const int b = isctx ? (uc >> 1) : (u >> 6), pos0 = isctx ? (uc & 1) * 128 : (u & 63) * 128;
        const int row0 = isctx ? NLAT + b * CTXL + pos0 : b * TT + pos0, L0 = isctx ? pos0 : CTXL + pos0;
        const int hh0 = isctx ? pc : 0, hh1 = isctx ? (pc < 6 ? pc + 1 : 0) : 6; const bool doC = !isctx || pc == 6;
        for (int hh = hh0; hh < hh1; ++hh) {
#pragma unroll
            for (int i = 0; i < 4; ++i) { const int piece = C.tid + NTHR * i, r = piece >> 4, part = piece & 15;
                *(LAS u32x4*)(vt + r * 136 + part * 8) = *(const u32x4*)(P + (size_t)(row0 + r) * P_LD + 1536 + hh * 128 + part * 8); }
            __syncthreads();
#pragma unroll
            for (int i = 0; i < 4; ++i) { const int item = C.tid + NTHR * i, d = item >> 4, tg = item & 15; const LAS bf16_t* s = vt + (tg * 8) * 136 + d;
                u32x4 o; o.x = (unsigned)s[0] | ((unsigned)s[136] << 16); o.y = (unsigned)s[2 * 136] | ((unsigned)s[3 * 136] << 16);
                o.z = (unsigned)s[4 * 136] | ((unsigned)s[5 * 136] << 16); o.w = (unsigned)s[6 * 136] | ((unsigned)s[7 * 136] << 16);
                *(u32x4*)(VT + ((size_t)(b * 6 + hh) * 128 + d) * LKEYS + L0 + tg * 8) = o; }
            __syncthreads();
        }
        if (doC) {
        for (int r = C.wave; r < 128; r += NWAVES) {
            const int c4 = 4 * C.lane; const bf16_t* pr = P + (size_t)(row0 + r) * P_LD + 2304;
            const f32x4 ur = ld4bf(pr + c4), raw = ld4bf(pr + 256 + c4);
            { const f32x4 gu = {gelu_erf(ur[0]), gelu_erf(ur[1]), gelu_erf(ur[2]), gelu_erf(ur[3])}; u32x2 o; o.x = pk2(gu[0], gu[1]); o.y = pk2(gu[2], gu[3]); *(LAS u32x2*)(uL + r * 264 + c4) = o; }
            const f32x4 gv = {gelu_erf(raw[0]), gelu_erf(raw[1]), gelu_erf(raw[2]), gelu_erf(raw[3])};
            const float mean = wave_sum((gv[0] + gv[1]) + (gv[2] + gv[3])) * (1.f / 256.f); const f32x4 dd = gv - mean;
            const float var = wave_sum((dd[0] * dd[0] + dd[1] * dd[1]) + (dd[2] * dd[2] + dd[3] * dd[3])) * (1.f / 256.f); const float rstd = rsqrtf(var + LN_EPS);
            const f32x4 o = dd * rstd * *(const f32x4*)(lng + c4) + *(const f32x4*)(lnb + c4);
#pragma unroll
            for (int k = 0; k < 4; ++k) vT[(c4 + k) * 136 + r] = (bf16_t)f2bf(o[k]);
        }
        __syncthreads();
        {
            const int g = C.wave >> 1, cblk = C.wave & 1, cc = g * 64 + cblk * 32 + r32;
            for (int pblk = 0; pblk < 4; ++pblk) {
                f32x16 acc;
#pragma unroll
                for (int i = 0; i < 16; ++i) acc[i] = 0.f;
                const float* wrow = gws + ((size_t)g * 128 + pblk * 32 + r32) * 128 + 8 * hi;
#pragma unroll
                for (int ks = 0; ks < 8; ++ks) { const f32x4 w0 = *(const f32x4*)(wrow + ks * 16), w1 = *(const f32x4*)(wrow + ks * 16 + 4);
                    u32x4 au; au.x = pk2(w0[0], w0[1]); au.y = pk2(w0[2], w0[3]); au.z = pk2(w1[0], w1[1]); au.w = pk2(w1[2], w1[3]);
                    const bf16x8 bf = *(const LAS bf16x8*)(vT + cc * 136 + ks * 16 + 8 * hi);
                    acc = __builtin_amdgcn_mfma_f32_32x32x16_bf16(__builtin_bit_cast(bf16x8, au), bf, acc, 0, 0, 0); }
#pragma unroll
                for (int reg = 0; reg < 16; ++reg) { const int p = pblk * 32 + crow(reg, hi);
                    const float uu = bf2f(uL[p * 264 + cc]); const float mixed = acc[reg] + gbs[g * 128 + p];
                    uL[p * 264 + cc] = (bf16_t)f2bf(uu * mixed); }
            }
        }
        __syncthreads();
#pragma unroll
        for (int i = 0; i < 8; ++i) { const int piece = C.tid + NTHR * i, r = piece >> 5, part = piece & 31;
            *(u32x4*)(A2 + (size_t)(row0 + r) * DM + 768 + part * 8) = *(const LAS u32x4*)(uL + r * 264 + part * 8); }
        __syncthreads();
        }
    }
}

__device__ __forceinline__ void phase_attn(const Ctx& C, const Args& A, int l) {
    const int i2 = l >> 1; unsigned char* ws = A.ws;
    const bf16_t* Q = (const bf16_t*)(ws + WS_Q); const bf16_t* KA = (const bf16_t*)(ws + WS_KA); const bf16_t* VT = (const bf16_t*)(ws + WS_VT); bf16_t* A2 = (bf16_t*)(ws + WS_A2);
    const float lam_init = 0.8f - 0.6f * expf(-0.3f * (float)l);
    float s1 = 0.f, s2 = 0.f;
    for (int j = 0; j < 64; ++j) { s1 += A.in[I_LQ1][i2 * 64 + j] * A.in[I_LK1][i2 * 64 + j]; s2 += A.in[I_LQ2][i2 * 64 + j] * A.in[I_LK2][i2 * 64 + j]; }
    const float lam = expf(s1) - expf(s2) + lam_init;
    const float* subg = A.in[I_SUBG] + (size_t)i2 * 128;
    const int r32 = C.lane & 31, hi = C.lane >> 5, map = C.wave >> 2, qw = C.wave & 3;
    LAS unsigned char* Kt = C.lds; LAS unsigned char* Vt = C.lds + 2 * 16384; LAS float* xch = (LAS float*)C.lds;
    const int NU = 1536 + (l == 1 ? 48 : 0);
    for (int n = C.vcu; n < NU; n += C.G) {
        int bh, qt; bool isctx = false;
        if (n < 1536) { const int round = n >> 8, slot = n & 255; bh = (slot >> 5) * 3 + (round >> 1); qt = (round & 1) * 32 + (slot & 31); }
        else { isctx = true; bh = (n - 1536) >> 1; qt = (n - 1536) & 1; }
        const int b = bh / 6, h = bh % 6;
        const int qrow0 = isctx ? NLAT + b * CTXL + qt * 128 : b * TT + qt * 128;
        const int NT = isctx ? CTXL / 64 : LKEYS / 64;
        const bf16_t* Kb = KA + (size_t)b * LKEYS * 768 + h * 128;
        const bf16_t* Vb = VT + (size_t)(b * 6 + h) * 128 * LKEYS;
        bf16x8 qf[4];
        { const bf16_t* qp = Q + (size_t)(qrow0 + qw * 32 + r32) * 768 + h * 128 + map * 64 + 8 * hi;
#pragma unroll
          for (int ks = 0; ks < 4; ++ks) qf[ks] = *(const bf16x8*)(qp + ks * 16); }
        f32x16 O[4];
#pragma unroll
        for (int d = 0; d < 4; ++d)
#pragma unroll
            for (int i = 0; i < 16; ++i) O[d][i] = 0.f;
        float m = 0.f, lsum = 0.f;
        unsigned ksrc[2], vsrc[2];
#pragma unroll
        for (int i = 0; i < 2; ++i) { const int row = 4 * (2 * C.wave + i) + (C.lane >> 4), x = row & 15, pi = x < 4 ? x : x < 8 ? x + 4 : x < 12 ? x - 4 : x;
            ksrc[i] = (unsigned)(((row & ~15) + pi) * 768 + (((C.lane & 15) ^ x) * 8));
            const int d = 8 * (2 * C.wave + i) + (C.lane >> 3); vsrc[i] = (unsigned)(d * LKEYS + (((C.lane & 7) ^ ((d >> 1) & 7)) * 8)); }
#define AT_DMA_K(tt, slot) do { _Pragma("unroll") for (int i = 0; i < 2; ++i) __builtin_amdgcn_global_load_lds((const unsigned*)(Kb + (size_t)(tt) * 64 * 768 + ksrc[i]), (LAS unsigned*)(Kt + (slot) * 16384 + (2 * C.wave + i) * 1024), 16, 0, 0); } while (0)
#define AT_DMA_V(tt, slot) do { _Pragma("unroll") for (int i = 0; i < 2; ++i) __builtin_amdgcn_global_load_lds((const unsigned*)(Vb + (size_t)(tt) * 64 + vsrc[i]), (LAS unsigned*)(Vt + (slot) * 16384 + (2 * C.wave + i) * 1024), 16, 0, 0); } while (0)
#define AT_BAR() asm volatile("s_waitcnt vmcnt(0) lgkmcnt(0)\n\ts_barrier" ::: "memory")
#define AT_SB() __builtin_amdgcn_sched_barrier(0)
        const int ksw = r32 & 15, vsw = (r32 >> 1) & 7;
#define AT_QK(P0, P1, ks_) do { const float nm_ = -m; _Pragma("unroll") for (int i = 0; i < 16; ++i) { P0[i] = nm_; P1[i] = nm_; } \
            const LAS unsigned char* kbp_ = Kt + (ks_) * 16384 + r32 * 256; \
            _Pragma("unroll") for (int ks = 0; ks < 4; ++ks) { const int co_ = ((map * 8 + ks * 2 + hi) ^ ksw) * 16; \
                P0 = __builtin_amdgcn_mfma_f32_32x32x16_bf16(*(const LAS bf16x8*)(kbp_ + co_), qf[ks], P0, 0, 0, 0); P1 = __builtin_amdgcn_mfma_f32_32x32x16_bf16(*(const LAS bf16x8*)(kbp_ + 32 * 256 + co_), qf[ks], P1, 0, 0, 0); } } while (0)
#define AT_LDV(dst, vs_, d) do { _Pragma("unroll") for (int kst = 0; kst < 4; ++kst) dst[kst] = *(const LAS u32x4*)(Vt + (vs_) * 16384 + ((d) * 32 + r32) * 128 + (((kst * 2 + hi) ^ vsw) * 16)); } while (0)
#define AT_PV(src, d) do { _Pragma("unroll") for (int kst = 0; kst < 4; ++kst) O[d] = __builtin_amdgcn_mfma_f32_32x32x16_bf16(__builtin_bit_cast(bf16x8, src[kst]), pb[kst], O[d], 0, 0, 0); } while (0)
#define AT_SOFTPV(P0, P1, N0, N1, first, hasn, vs_) do { \
            asm volatile("s_nop 15\n\ts_nop 7" : "+v"(P0), "+v"(P1)); \
            float mx = max3f(P0[0], P0[1], P1[0]), mx2 = max3f(P0[2], P0[3], P1[1]); mx = max3f(mx, P1[2], P1[3]); \
            _Pragma("unroll") for (int i = 4; i < 16; i += 4) { mx = max3f(mx, P0[i], P0[i + 1]); mx2 = max3f(mx2, P0[i + 2], P0[i + 3]); mx = max3f(mx, P1[i], P1[i + 1]); mx2 = max3f(mx2, P1[i + 2], P1[i + 3]); } \
            mx = fmaxf(mx, mx2); \
            { auto rr = __builtin_amdgcn_permlane32_swap(__float_as_uint(mx), __float_as_uint(mx), false, false); mx = fmaxf(__uint_as_float(rr[0]), __uint_as_float(rr[1])); } \
            if ((first) || __any(mx > 8.f)) { const float dl = (first) ? mx : fmaxf(mx, 0.f); const float sc = __builtin_amdgcn_exp2f(-dl); lsum *= sc; \
                _Pragma("unroll") for (int d = 0; d < 4; ++d) _Pragma("unroll") for (int i = 0; i < 16; ++i) O[d][i] *= sc; \
                _Pragma("unroll") for (int i = 0; i < 16; ++i) { P0[i] -= dl; P1[i] -= dl; } \
                if (hasn) { asm volatile("s_nop 15\n\ts_nop 7" : "+v"(N0), "+v"(N1)); _Pragma("unroll") for (int i = 0; i < 16; ++i) { N0[i] -= dl; N1[i] -= dl; } } \
                m += dl; } \
            float ps = 0.f, ps2 = 0.f; \
            _Pragma("unroll") for (int i = 0; i < 16; ++i) { P0[i] = __builtin_amdgcn_exp2f(P0[i]); P1[i] = __builtin_amdgcn_exp2f(P1[i]); ps += P0[i]; ps2 += P1[i]; } \
            lsum += ps + ps2; \
            bf16x8 pb[4]; \
            { u32x4 w; w.x = pk2(P0[0], P0[1]); w.y = pk2(P0[2], P0[3]); w.z = pk2(P0[4], P0[5]); w.w = pk2(P0[6], P0[7]); pb[0] = __builtin_bit_cast(bf16x8, w); \
              w.x = pk2(P0[8], P0[9]); w.y = pk2(P0[10], P0[11]); w.z = pk2(P0[12], P0[13]); w.w = pk2(P0[14], P0[15]); pb[1] = __builtin_bit_cast(bf16x8, w); \
              w.x = pk2(P1[0], P1[1]); w.y = pk2(P1[2], P1[3]); w.z = pk2(P1[4], P1[5]); w.w = pk2(P1[6], P1[7]); pb[2] = __builtin_bit_cast(bf16x8, w); \
              w.x = pk2(P1[8], P1[9]); w.y = pk2(P1[10], P1[11]); w.z = pk2(P1[12], P1[13]); w.w = pk2(P1[14], P1[15]); pb[3] = __builtin_bit_cast(bf16x8, w); } \
            u32x4 va[4]; \
            AT_LDV(va, vs_, 0); AT_SB(); AT_PV(va, 0); AT_SB(); AT_LDV(va, vs_, 1); AT_SB(); AT_PV(va, 1); AT_SB(); AT_LDV(va, vs_, 2); AT_SB(); AT_PV(va, 2); AT_SB(); AT_LDV(va, vs_, 3); AT_SB(); AT_PV(va, 3); AT_SB(); } while (0)
        f32x16 pA0, pA1, pB0, pB1;
        AT_DMA_K(0, 0); AT_DMA_V(0, 0); AT_DMA_K(1, 1);
        AT_BAR();
        AT_QK(pA0, pA1, 0);
        asm volatile("s_waitcnt lgkmcnt(0)\n\ts_barrier" ::: "memory");
        for (int t = 0; t < NT; t += 2) {
            if (t + 2 < NT) AT_DMA_K(t + 2, 0);
            AT_DMA_V(t + 1, 1);
            AT_SB(); AT_QK(pB0, pB1, 1); AT_SB();
            AT_SOFTPV(pA0, pA1, pB0, pB1, t == 0, true, 0);
            AT_BAR();
            if (t + 3 < NT) AT_DMA_K(t + 3, 1);
            if (t + 2 < NT) AT_DMA_V(t + 2, 0);
            AT_SB(); if (t + 2 < NT) { AT_QK(pA0, pA1, 0); } AT_SB();
            AT_SOFTPV(pB0, pB1, pA0, pA1, false, t + 2 < NT, 1);
            AT_BAR();
        }
#undef AT_DMA_K
#undef AT_DMA_V
#undef AT_BAR
#undef AT_SB
#undef AT_QK
#undef AT_LDV
#undef AT_PV
#undef AT_SOFTPV
        const float ltot = lsum + __shfl_xor(lsum, 32);
        const float invl = 1.f / ltot;
        if (map == 1) { const float f = lam * invl;
#pragma unroll
            for (int d = 0; d < 4; ++d)
#pragma unroll
                for (int i = 0; i < 16; ++i) xch[(qw * 64 + d * 16 + i) * 64 + C.lane] = O[d][i] * f; }
        __syncthreads();
        if (map == 0) { float ss = 0.f;
#pragma unroll
            for (int d = 0; d < 4; ++d)
#pragma unroll
                for (int i = 0; i < 16; ++i) { const float o = O[d][i] * invl - xch[(qw * 64 + d * 16 + i) * 64 + C.lane]; O[d][i] = o; ss += o * o; }
            ss += __shfl_xor(ss, 32);
            const float rn = rsqrtf(ss * (1.f / 128.f) + RMS_EPS) * (1.f - lam_init);
            bf16_t* orow = A2 + (size_t)(qrow0 + qw * 32 + r32) * DM + h * 128;
#pragma unroll
            for (int d = 0; d < 4; ++d)
#pragma unroll
                for (int g4 = 0; g4 < 4; ++g4) { const int dd = 32 * d + 8 * g4 + 4 * hi; const f32x4 sg = *(const f32x4*)(subg + dd);
                    const f32x4 v = {O[d][4 * g4] * rn * sg[0], O[d][4 * g4 + 1] * rn * sg[1], O[d][4 * g4 + 2] * rn * sg[2], O[d][4 * g4 + 3] * rn * sg[3]};
                    st4bf(orow + dd, v); } }
        __syncthreads();
    }
}

__device__ __forceinline__ void phase_rt(const Ctx& C, const Args& A, int l) {
    unsigned char* ws = A.ws; float* X = (float*)(ws + WS_X); bf16_t* H = (bf16_t*)(ws + WS_H); float* AFF = (float*)(ws + WS_AFF);
    const float* MOD = (const float*)(ws + WS_MOD) + (size_t)l * 5 * 6144;
    const float* lng = A.in[I_LNG] + (size_t)(l * 2 + 0) * DM; const float* lnb = A.in[I_LNB] + (size_t)(l * 2 + 0) * DM;
    LAS float* wrs = (LAS float*)C.lds;
    { const float* wr = A.in[I_WR] + (size_t)l * DM * 16; for (int i = C.tid; i < DM * 16; i += NTHR) wrs[(i & 15) * 1024 + (i >> 4)] = wr[i]; }
    __syncthreads();
    const int row0 = (int)(((long)C.gw * MROWS) / C.NGW), row1 = (int)(((long)(C.gw + 1) * MROWS) / C.NGW);
    f32x4 lngr[4], lnbr[4], scr[4], shr[4]; int cmi = -1;
#pragma unroll
    for (int j = 0; j < 4; ++j) { const int col = 4 * C.lane + 256 * j; lngr[j] = *(const f32x4*)(lng + col); lnbr[j] = *(const f32x4*)(lnb + col); scr[j] = lngr[j]; shr[j] = lngr[j]; }
    f32x4 xn[4];
    if (row0 < row1) {
#pragma unroll
        for (int j = 0; j < 4; ++j) xn[j] = *(const f32x4*)(X + (size_t)row0 * DM + 4 * C.lane + 256 * j); }
    for (int row = row0; row < row1; ++row) {
        const int mi = row_mi(row);
        if (mi != cmi) { cmi = mi; const float* md = MOD + mi * 6144;
#pragma unroll
            for (int j = 0; j < 4; ++j) { const int col = 4 * C.lane + 256 * j; scr[j] = *(const f32x4*)(md + 4 * DM + col) + 1.f; shr[j] = *(const f32x4*)(md + 3 * DM + col); } }
        f32x4 x[4]; float s = 0.f;
#pragma unroll
        for (int j = 0; j < 4; ++j) { x[j] = xn[j]; s += (x[j][0] + x[j][1]) + (x[j][2] + x[j][3]); }
        if (row + 1 < row1) {
#pragma unroll
            for (int j = 0; j < 4; ++j) xn[j] = *(const f32x4*)(X + (size_t)(row + 1) * DM + 4 * C.lane + 256 * j); }
        const float mean = wave_sum(s) * (1.f / DM); float s2 = 0.f;
#pragma unroll
        for (int j = 0; j < 4; ++j) { x[j] = x[j] - mean; s2 += (x[j][0] * x[j][0] + x[j][1] * x[j][1]) + (x[j][2] * x[j][2] + x[j][3] * x[j][3]); }
        const float rstd = rsqrtf(wave_sum(s2) * (1.f / DM) + LN_EPS);
        float v[16];
#pragma unroll
        for (int e = 0; e < 16; ++e) v[e] = 0.f;
#pragma unroll
        for (int j = 0; j < 4; ++j) { const int col = 4 * C.lane + 256 * j;
            const f32x4 x1 = x[j] * rstd * lngr[j] + lnbr[j];
            *(f32x4*)(X + (size_t)row * DM + col) = x1;
            const f32x4 h = x1 * scr[j] + shr[j];
            st4bf(H + (size_t)row * DM + col, h);
#pragma unroll
            for (int e = 0; e < 16; ++e) { const f32x4 w = *(const LAS f32x4*)(wrs + e * 1024 + col); v[e] += (h[0] * w[0] + h[1] * w[1]) + (h[2] * w[2] + h[3] * w[3]); }
            __builtin_amdgcn_sched_barrier(0); }
#pragma unroll
        for (int i = 0; i < 8; ++i) { const float send = (C.lane & 32) ? v[i] : v[i + 8], keep = (C.lane & 32) ? v[i + 8] : v[i]; v[i] = keep + __shfl_xor(send, 32); }
#pragma unroll
        for (int i = 0; i < 4; ++i) { const float send = (C.lane & 16) ? v[i] : v[i + 4], keep = (C.lane & 16) ? v[i + 4] : v[i]; v[i] = keep + __shfl_xor(send, 16); }
#pragma unroll
        for (int i = 0; i < 2; ++i) { const float send = (C.lane & 8) ? v[i] : v[i + 2], keep = (C.lane & 8) ? v[i + 2] : v[i]; v[i] = keep + __shfl_xor(send, 8); }
        { const float send = (C.lane & 4) ? v[0] : v[1], keep = (C.lane & 4) ? v[1] : v[0]; v[0] = keep + __shfl_xor(send, 4); }
        float z = v[0]; z += __shfl_xor(z, 1); z += __shfl_xor(z, 2);
        float mx = z;
#pragma unroll
        for (int o = 4; o < 64; o <<= 1) mx = fmaxf(mx, __shfl_xor(mx, o));
        const float ex = expf(z - mx); float sm = ex;
#pragma unroll
        for (int o = 4; o < 64; o <<= 1) sm += __shfl_xor(sm, o);
        if ((C.lane & 3) == 0) AFF[(size_t)row * 16 + (C.lane >> 2)] = ex / sm;
    }
}

__device__ __forceinline__ void phase_tk(const Ctx& C, const Args& A) {
    unsigned char* ws = A.ws; const float* AFF = (const float*)(ws + WS_AFF); int* SLOT = (int*)(ws + WS_SLOT); int* IDX = (int*)(ws + WS_IDX); float* GATE = (float*)(ws + WS_GATE);
    LAS unsigned* key = (LAS unsigned*)C.lds;
    LAS unsigned* hist = key + 8192;
    LAS unsigned* scn = hist + 256;
    LAS unsigned* wtot = scn + 256;
    LAS unsigned* bc = wtot + 8;
    for (int u = blockIdx.x; u < 128; u += C.G) {
        const bool isctx = u >= 64; const int uu = u & 63, b = uu >> 4, e = uu & 15;
        const int n = isctx ? CTXL : TT, cap = isctx ? CAP_C : CAP_L;
        const int row0 = isctx ? NLAT + b * CTXL : b * TT;
        const int slot0 = e * ESLOTS + (isctx ? 4 * CAP_L + b * CAP_C : b * CAP_L);
        for (int i = C.tid; i < n; i += NTHR) key[i] = __float_as_uint(AFF[(size_t)(row0 + i) * 16 + e]);
        unsigned prefix = 0u, pmask = 0u; int need = cap;
        for (int pass = 0; pass < 4; ++pass) {
            const int shift = 24 - 8 * pass;
            if (C.tid < 256) hist[C.tid] = 0u;
            __syncthreads();
            for (int i = C.tid; i < n; i += NTHR) { const unsigned k = key[i]; if ((k & pmask) == prefix) __hip_atomic_fetch_add(&hist[(k >> shift) & 255u], 1u, __ATOMIC_RELAXED, __HIP_MEMORY_SCOPE_WORKGROUP); }
            __syncthreads();
            if (C.tid < 256) scn[C.tid] = hist[C.tid];
            __syncthreads();
            for (int off = 1; off < 256; off <<= 1) {
                unsigned a = 0u; if (C.tid < 256 && C.tid + off < 256) a = scn[C.tid + off];
                __syncthreads();
                if (C.tid < 256) scn[C.tid] += a;
                __syncthreads();
            }
            if (C.tid < 256) { const unsigned above = (C.tid < 255) ? scn[C.tid + 1] : 0u;
                if (scn[C.tid] >= (unsigned)need && above < (unsigned)need) { bc[0] = (unsigned)C.tid; bc[1] = (unsigned)need - above; } }
            __syncthreads();
            prefix |= bc[0] << shift; pmask |= 255u << shift; need = (int)bc[1];
            __syncthreads();
        }
        const int per = (n + NTHR - 1) / NTHR; const int i0 = C.tid * per;
        unsigned cg = 0u, ce = 0u;
        for (int j = 0; j < per; ++j) { const int i = i0 + j; if (i < n) { const unsigned k = key[i]; cg += (k > prefix); ce += (k == prefix); } }
        unsigned pk = cg | (ce << 16), inc = pk;
#pragma unroll
        for (int o = 1; o < 64; o <<= 1) { const unsigned t = __shfl_up(inc, o); if (C.lane >= o) inc += t; }
        if (C.lane == 63) wtot[C.wave] = inc;
        __syncthreads();
        unsigned wbase = 0u;
        for (int w = 0; w < C.wave; ++w) wbase += wtot[w];
        const unsigned excl = wbase + inc - pk;
        unsigned rg = excl & 0xffffu, re = excl >> 16;
        const int ngt = cap - need;
        for (int j = 0; j < per; ++j) { const int i = i0 + j; if (i < n) { const unsigned k = key[i]; int pos = -1;
            if (k > prefix) { pos = (int)rg; ++rg; } else if (k == prefix) { if ((int)re < need) pos = ngt + (int)re; ++re; }
            const int row = row0 + i;
            if (pos >= 0) { IDX[slot0 + pos] = row; GATE[slot0 + pos] = __uint_as_float(k); SLOT[(size_t)row * 16 + e] = slot0 + pos; }
            else SLOT[(size_t)row * 16 + e] = -1; } }
        if (isctx && b == 0 && C.tid < ESLOTS - 4224) { IDX[e * ESLOTS + 4224 + C.tid] = 0; GATE[e * ESLOTS + 4224 + C.tid] = 0.f; }
        __syncthreads();
    }
}

__device__ __forceinline__ void phase_cb(const Ctx& C, const Args& A, int l) {
    unsigned char* ws = A.ws; float* X = (float*)(ws + WS_X); bf16_t* H = (bf16_t*)(ws + WS_H); const int* SLOT = (const int*)(ws + WS_SLOT); const bf16_t* YE = (const bf16_t*)(ws + WS_YE);
    const float* MOD = (const float*)(ws + WS_MOD) + (size_t)l * 5 * 6144; const float* MODN = MOD + 5 * 6144;
    const float* lng = A.in[I_LNG] + (size_t)(l * 2 + 1) * DM; const float* lnb = A.in[I_LNB] + (size_t)(l * 2 + 1) * DM;
    const int row0 = (int)(((long)C.gw * MROWS) / C.NGW), row1 = (int)(((long)(C.gw + 1) * MROWS) / C.NGW);
    f32x4 lngr[4], lnbr[4], gfr[4], nsc[4], nsh[4]; int cmi = -1;
#pragma unroll
    for (int j = 0; j < 4; ++j) { const int col = 4 * C.lane + 256 * j; lngr[j] = *(const f32x4*)(lng + col); lnbr[j] = *(const f32x4*)(lnb + col); gfr[j] = lngr[j]; nsc[j] = lngr[j]; nsh[j] = lngr[j]; }
    int svn = -1; f32x4 xn[4];
    if (row0 < row1) { svn = SLOT[(size_t)row0 * 16 + (C.lane & 15)];
#pragma unroll
        for (int j = 0; j < 4; ++j) xn[j] = *(const f32x4*)(X + (size_t)row0 * DM + 4 * C.lane + 256 * j); }
    for (int row = row0; row < row1; ++row) {
        const int mi = row_mi(row);
        if (mi != cmi) { cmi = mi; const float* md = MOD + mi * 6144; const float* mn = MODN + mi * 6144;
#pragma unroll
            for (int j = 0; j < 4; ++j) { const int col = 4 * C.lane + 256 * j; gfr[j] = *(const f32x4*)(md + 5 * DM + col);
                if (l < DEPTH - 1) { nsc[j] = *(const f32x4*)(mn + DM + col) + 1.f; nsh[j] = *(const f32x4*)(mn + col); } } }
        const int sv = svn;
        unsigned mask = (unsigned)__ballot(sv >= 0) & 0xffffu;
        f32x4 acc[4];
#pragma unroll
        for (int j = 0; j < 4; ++j) acc[j] = (f32x4){0.f, 0.f, 0.f, 0.f};
        u32x2 y0[4], y1[4]; bool h0 = false, h1 = false;
        if (mask) { const int e = __builtin_ctz(mask); mask &= mask - 1; h0 = true; const int sl = __builtin_amdgcn_readlane(sv, e);
#pragma unroll
            for (int j = 0; j < 4; ++j) y0[j] = *(const u32x2*)(YE + (size_t)sl * DM + 4 * C.lane + 256 * j); }
        if (mask) { const int e = __builtin_ctz(mask); mask &= mask - 1; h1 = true; const int sl = __builtin_amdgcn_readlane(sv, e);
#pragma unroll
            for (int j = 0; j < 4; ++j) y1[j] = *(const u32x2*)(YE + (size_t)sl * DM + 4 * C.lane + 256 * j); }
        f32x4 x[4];
#pragma unroll
        for (int j = 0; j < 4; ++j) x[j] = xn[j];
        if (row + 1 < row1) { svn = SLOT[(size_t)(row + 1) * 16 + (C.lane & 15)];
#pragma unroll
            for (int j = 0; j < 4; ++j) xn[j] = *(const f32x4*)(X + (size_t)(row + 1) * DM + 4 * C.lane + 256 * j); }
        if (h0) {
#pragma unroll
            for (int j = 0; j < 4; ++j) acc[j] += (f32x4){__uint_as_float(y0[j].x << 16), __uint_as_float(y0[j].x & 0xffff0000u), __uint_as_float(y0[j].y << 16), __uint_as_float(y0[j].y & 0xffff0000u)}; }
        if (h1) {
#pragma unroll
            for (int j = 0; j < 4; ++j) acc[j] += (f32x4){__uint_as_float(y1[j].x << 16), __uint_as_float(y1[j].x & 0xffff0000u), __uint_as_float(y1[j].y << 16), __uint_as_float(y1[j].y & 0xffff0000u)}; }
        while (mask) { const int e = __builtin_ctz(mask); mask &= mask - 1; const int sl = __builtin_amdgcn_readlane(sv, e);
#pragma unroll
            for (int j = 0; j < 4; ++j) acc[j] += ld4bf(YE + (size_t)sl * DM + 4 * C.lane + 256 * j); }
        float sm = 0.f;
#pragma unroll
        for (int j = 0; j < 4; ++j) { x[j] = x[j] * ALPHA_DN + gfr[j] * acc[j];
            sm += (x[j][0] + x[j][1]) + (x[j][2] + x[j][3]); }
        const float mean = wave_sum(sm) * (1.f / DM); float s2 = 0.f;
#pragma unroll
        for (int j = 0; j < 4; ++j) { x[j] = x[j] - mean; s2 += (x[j][0] * x[j][0] + x[j][1] * x[j][1]) + (x[j][2] * x[j][2] + x[j][3] * x[j][3]); }
        const float rstd = rsqrtf(wave_sum(s2) * (1.f / DM) + LN_EPS);
#pragma unroll
        for (int j = 0; j < 4; ++j) { const int col = 4 * C.lane + 256 * j;
            const f32x4 x2 = x[j] * rstd * lngr[j] + lnbr[j];
            *(f32x4*)(X + (size_t)row * DM + col) = x2;
            if (l < DEPTH - 1) { st4bf(H + (size_t)row * DM + col, x2 * nsc[j] + nsh[j]); }
            else if (row < NLAT) *(f32x4*)(A.out + (size_t)row * DM + col) = x2; }
    }
}


#ifndef GEMM_NOINLINE
#define GEMM_NOINLINE 0
#endif
#if GEMM_NOINLINE
#define GEMM_FN __device__ __noinline__
#else
#define GEMM_FN __device__ __forceinline__
#endif
GEMM_FN void gphase_in(LAS unsigned char* lds, unsigned char* ws, int nN, int G) {
    int bx = blockIdx.x; asm volatile("" : "+s"(bx), "+s"(G));
    pg8::Gemm g{(const bf16_t*)(ws + WS_H), (const bf16_t*)(ws + WS_WIN), DM}; pg8::Order<0> S; S.init(MROWS / 256, nN, G, bx, nullptr, 0);
    pg8::EpiBf16 E{(bf16_t*)(ws + WS_P), P_LD}; pg8::gemm_phase(lds, g, S, E); }
GEMM_FN void gphase_in_odd(LAS unsigned char* lds, unsigned char* ws, int G) {
    int bx = blockIdx.x; asm volatile("" : "+s"(bx), "+s"(G));
    pg8::Gemm g{(const bf16_t*)(ws + WS_H), (const bf16_t*)(ws + WS_WIN), DM}; pg8::Order<0> S; S.init(MROWS / 256, D_IN_ODD / 256, G, bx, nullptr, 0);
    pg8::EpiOdd E{(bf16_t*)(ws + WS_P), (bf16_t*)(ws + WS_Q), (bf16_t*)(ws + WS_KA), (const float*)(ws + WS_ROPE)}; pg8::gemm_phase(lds, g, S, E); }
GEMM_FN void gphase_lora(LAS unsigned char* lds, unsigned char* ws, const float* d0, const float* a0, const float* kal, int G) {
    int bx = blockIdx.x; asm volatile("" : "+s"(bx), "+s"(G));
    pg8::Gemm g{(const bf16_t*)(ws + WS_LIN), (const bf16_t*)(ws + WS_WLORA), LORA_K}; pg8::Order<0> S; S.init(MROWS / 256, LORA_N / 256, G, bx, nullptr, 0);
    pg8::EpiLora E{ws + WS_SCN, (bf16_t*)(ws + WS_G), d0, a0, kal}; pg8::gemm_phase(lds, g, S, E); }
GEMM_FN void gphase_out(LAS unsigned char* lds, unsigned char* ws, const float* modl, int G) {
    int bx = blockIdx.x; asm volatile("" : "+s"(bx), "+s"(G));
    pg8::Gemm g{(const bf16_t*)(ws + WS_A2), (const bf16_t*)(ws + WS_WOUT), DM}; pg8::Order<0> S; S.init(MROWS / 256, DM / 256, G, bx, nullptr, 0);
    pg8::EpiRes E{(float*)(ws + WS_X), modl}; pg8::gemm_phase(lds, g, S, E); }
GEMM_FN void gphase_e1(LAS unsigned char* lds, unsigned char* ws, int G, int l) {
    int bx = blockIdx.x; asm volatile("" : "+s"(bx), "+s"(G));
    pg8::Gemm g{(const bf16_t*)(ws + WS_H), (const bf16_t*)(ws + WS_WE13 + (size_t)(l & 1) * WE13_BYTES), DM}; pg8::EpiSwiGLU E{(bf16_t*)(ws + WS_HID)};
    pg8::OrderExp<1> S; S.init(4096 / 256, G, bx, (const int*)(ws + WS_IDX), (long)4096 * DM); pg8::gemm_phase(lds, g, S, E); }
GEMM_FN void gphase_e2(LAS unsigned char* lds, unsigned char* ws, int G, int l) {
    int bx = blockIdx.x; asm volatile("" : "+s"(bx), "+s"(G));
    pg8::Gemm g{(const bf16_t*)(ws + WS_HID), (const bf16_t*)(ws + WS_WE2 + (size_t)(l & 1) * WE2_BYTES), D_EXP}; pg8::EpiYE E{(bf16_t*)(ws + WS_YE), (const float*)(ws + WS_GATE)};
    pg8::OrderExp<2> S; S.init(DM / 256, G, bx, nullptr, (long)DM * D_EXP); pg8::gemm_phase(lds, g, S, E); }

constexpr int NSLOT = 13;
constexpr int NSTEP = 1 + DEPTH * NSLOT;
__global__ void __launch_bounds__(NTHR, 2) mk_fwd(Args KA) {
    extern __shared__ __attribute__((aligned(16))) unsigned char lds_raw[];
    volatile LAS unsigned* MISC = (volatile LAS unsigned*)((LAS unsigned char*)lds_raw + LDS_MISC);
    if (threadIdx.x < 16) MISC[threadIdx.x] = 0u;
    if (threadIdx.x == 0) { LAS unsigned long long* tb = (LAS unsigned long long*)((LAS unsigned char*)lds_raw + LDS_PTAB);
#pragma unroll
        for (int i = 0; i < 37; ++i) tb[i] = (unsigned long long)KA.in[i];
        tb[37] = (unsigned long long)KA.out; tb[38] = (unsigned long long)KA.ws; }
    __syncthreads();
    const int lo = KA.lo, hi = KA.hi;
    unsigned bar_x = 0;
    if (hi - lo > 1) { const XcdBarrier b0 = xcd_barrier_post((unsigned*)(KA.ws + WS_CTL), MISC); bar_x = b0.x; }
#ifndef PH_MASK
#define PH_MASK 0xFFFFFF
#endif
#ifndef REP_MASK
#define REP_MASK 0
#endif
#define PH_BIT(k) (((k) == 0) ? 0 : 1 + ((k) - 1) % NSLOT + (((k) - 1) % NSLOT >= 2 && ((k) - 1) % NSLOT <= 3 && odd ? 12 : 0))
#define RUN(k, ...) do { if (((PH_MASK >> PH_BIT(k)) & 1) && lo <= (k) && (k) < hi) { const int nrep = ((REP_MASK >> PH_BIT(k)) & 1) ? 2 : 1; \
        _Pragma("unroll 1") for (int rep = 0; rep < nrep; ++rep) { \
        Ctx C; mkctx(C, (LAS unsigned char*)lds_raw); Args A; ldargs(A, (LAS unsigned char*)lds_raw); unsigned char* ws = A.ws; \
        const float* MODL = (const float*)(ws + WS_MOD) + (size_t)l * 5 * 6144; (void)MODL; \
        __VA_ARGS__; if ((k) + 1 < hi || rep + 1 < nrep) { XcdBarrier bar; bar.bar = (unsigned*)(ws + WS_CTL); bar.x = bar_x; bar.st = MISC; xcd_barrier(bar); } } } } while (0)
    { const bool odd = false; const int l = 0; RUN(0, { phase_init(C, A); __syncthreads(); conv_items(C, A, 0, C.gw, C.NGW, true, true, true); }); }
#pragma unroll 1
    for (int l = 0; l < DEPTH; ++l) {
        const int sb = 1 + l * NSLOT; const bool odd = l & 1;
        if (!(CHUNKED_SCAN && odd)) { RUN(sb + 0, { phase_conv(C, A, l); if (l == 0) phase_modh(C, A, 0); }); }
        if (odd) { RUN(sb + 1, gphase_in_odd(C.lds, ws, C.G)); } else { RUN(sb + 1, gphase_in(C.lds, ws, D_IN_EVEN_PAD / 256, C.G)); }
        if (!odd) {
            RUN(sb + 2, phase_ef1(C, A, l));
            RUN(sb + 3, { const int i2 = l >> 1; gphase_lora(C.lds, ws, A.in[I_D0] + (size_t)i2 * 2 * 768, A.in[I_A0] + (size_t)i2 * 2 * 768, A.in[I_KAL] + (size_t)i2 * 768, C.G); });
#if CHUNKED_SCAN
            RUN(sb + 4, phase_csa(C, A));
            RUN(sb + 5, phase_csb(C, A, l));
#else
            RUN(sb + 4, phase_scan(C, A));
#endif
            RUN(sb + 6, phase_ef2(C, A, l));
        } else {
            RUN(sb + 2, phase_of1(C, A, l));
            RUN(sb + 3, phase_attn(C, A, l));
        }
        RUN(sb + 7, gphase_out(C.lds, ws, MODL, C.G));
        RUN(sb + 8, phase_rt(C, A, l));
        RUN(sb + 9, phase_tk(C, A));
        RUN(sb + 10, gphase_e1(C.lds, ws, C.G, l));
        RUN(sb + 11, gphase_e2(C.lds, ws, C.G, l));
        RUN(sb + 12, { phase_cb(C, A, l); if (CHUNKED_SCAN && !odd && l + 1 < DEPTH) { __syncthreads(); conv_items(C, A, l + 1, C.gw, C.NGW, false, true, false); } });
    }
#undef RUN
}

#ifdef PHASE_PROBE
#define PROBE_PRE extern __shared__ __attribute__((aligned(16))) unsigned char lds_raw[]; Ctx C; mkctx(C, (LAS unsigned char*)lds_raw); unsigned char* ws = A.ws; (void)ws;
__global__ void __launch_bounds__(NTHR, 2) pr_init(Args A) { PROBE_PRE phase_init(C, A); }
__global__ void __launch_bounds__(NTHR, 2) pr_conv(Args A) { PROBE_PRE phase_conv(C, A, A.lo); }
__global__ void __launch_bounds__(NTHR, 2) pr_modh(Args A) { PROBE_PRE phase_modh(C, A, A.lo); }
__global__ void __launch_bounds__(NTHR, 2) pr_ef1(Args A) { PROBE_PRE phase_ef1(C, A, A.lo); }
__global__ void __launch_bounds__(NTHR, 2) pr_scan(Args A) { PROBE_PRE phase_scan(C, A); }
__global__ void __launch_bounds__(NTHR, 2) pr_ef2(Args A) { PROBE_PRE phase_ef2(C, A, A.lo); }
__global__ void __launch_bounds__(NTHR, 2) pr_csa(Args A) { PROBE_PRE phase_csa(C, A); }
__global__ void __launch_bounds__(NTHR, 2) pr_csb(Args A) { PROBE_PRE phase_csb(C, A, A.lo); }
__global__ void __launch_bounds__(NTHR, 2) pr_of1(Args A) { PROBE_PRE phase_of1(C, A, A.lo); }
__global__ void __launch_bounds__(NTHR, 2) pr_attn(Args A) { PROBE_PRE phase_attn(C, A, A.lo); }
__global__ void __launch_bounds__(NTHR, 2) pr_rt(Args A) { PROBE_PRE phase_rt(C, A, A.lo); }
__global__ void __launch_bounds__(NTHR, 2) pr_tk(Args A) { PROBE_PRE phase_tk(C, A); }
__global__ void __launch_bounds__(NTHR, 2) pr_cb(Args A) { PROBE_PRE phase_cb(C, A, A.lo); }
__global__ void __launch_bounds__(NTHR, 2) pr_gemm_in(Args A) { PROBE_PRE pg8::Gemm g{(const bf16_t*)(ws + WS_H), (const bf16_t*)(ws + WS_WIN), DM}; pg8::Order<0> S; S.init(MROWS / 256, A.lo, C.G, (int)blockIdx.x, nullptr, 0);
                      pg8::EpiBf16 E{(bf16_t*)(ws + WS_P), P_LD}; pg8::gemm_phase(C.lds, g, S, E); }
__global__ void __launch_bounds__(NTHR, 2) pr_gemm_lora(Args A) { PROBE_PRE pg8::Gemm g{(const bf16_t*)(ws + WS_LIN), (const bf16_t*)(ws + WS_WLORA), LORA_K}; pg8::Order<0> S; S.init(MROWS / 256, LORA_N / 256, C.G, (int)blockIdx.x, nullptr, 0);
                          const int i2 = A.lo; pg8::EpiLora E{ws + WS_SCN, (bf16_t*)(ws + WS_G), A.in[I_D0] + (size_t)i2 * 2 * 768, A.in[I_A0] + (size_t)i2 * 2 * 768, A.in[I_KAL] + (size_t)i2 * 768};
                          pg8::gemm_phase(C.lds, g, S, E); }
__global__ void __launch_bounds__(NTHR, 2) pr_gemm_out(Args A) { PROBE_PRE pg8::Gemm g{(const bf16_t*)(ws + WS_A2), (const bf16_t*)(ws + WS_WOUT), DM}; pg8::Order<0> S; S.init(MROWS / 256, DM / 256, C.G, (int)blockIdx.x, nullptr, 0);
                      pg8::EpiRes E{(float*)(ws + WS_X), (const float*)(ws + WS_MOD)}; pg8::gemm_phase(C.lds, g, S, E); }
__global__ void __launch_bounds__(NTHR, 2) pr_gemm_e1(Args A) { PROBE_PRE pg8::Gemm g{(const bf16_t*)(ws + WS_H), (const bf16_t*)(ws + WS_WE13), DM}; pg8::Order<1> S; S.init(NEXP * 17, 4096 / 256, C.G, (int)blockIdx.x, (const int*)(ws + WS_IDX), (long)4096 * DM);
                      pg8::EpiSwiGLU E{(bf16_t*)(ws + WS_HID)}; pg8::gemm_phase(C.lds, g, S, E); }
__global__ void __launch_bounds__(NTHR, 2) pr_gemm_e2(Args A) { PROBE_PRE pg8::Gemm g{(const bf16_t*)(ws + WS_HID), (const bf16_t*)(ws + WS_WE2), D_EXP}; pg8::Order<2> S; S.init(NEXP * 17, DM / 256, C.G, (int)blockIdx.x, nullptr, (long)DM * D_EXP);
                       pg8::EpiYE E{(bf16_t*)(ws + WS_YE), (const float*)(ws + WS_GATE)}; pg8::gemm_phase(C.lds, g, S, E); }
#endif

extern "C" void kernel_launch(void* const* d_in, const int* in_sizes, int n_in, void* d_out, int out_size, void* d_ws, size_t ws_size, hipStream_t stream) {
    static int grid = 0;
    if (grid == 0) {
        if (n_in != 37 || out_size != NLAT * DM || ws_size < WS_END) { fprintf(stderr, "kernel_launch: unexpected shapes: n_in %d out %d ws %zu (need %zu)\n", n_in, out_size, ws_size, (size_t)WS_END); grid = -1; return; }
        int dev = 0, cus = 0, per_cu = 0;
        if (hipGetDevice(&dev) != hipSuccess || hipDeviceGetAttribute(&cus, hipDeviceAttributeMultiprocessorCount, dev) != hipSuccess) { grid = -1; return; }
        if (hipFuncSetAttribute((const void*)mk_fwd, hipFuncAttributeMaxDynamicSharedMemorySize, LDS_BYTES) != hipSuccess) { fprintf(stderr, "kernel_launch: hipFuncSetAttribute failed\n"); grid = -1; return; }
        if (hipOccupancyMaxActiveBlocksPerMultiprocessor(&per_cu, (const void*)mk_fwd, NTHR, LDS_BYTES) != hipSuccess || per_cu < 1) fprintf(stderr, "kernel_launch: occupancy query reports %d\n", per_cu);
        (void)hipGetLastError();
        grid = cus;
    }
    if (grid < 0) return;
    (void)hipMemsetAsync((char*)d_ws + WS_CTL, 0, CTL_BYTES, stream);
    Args a{};
    for (int i = 0; i < 37; ++i) a.in[i] = (const float*)d_in[i];
    a.out = (float*)d_out; a.ws = (unsigned char*)d_ws;
#if MK_MULTI
    for (int k = 0; k < NSTEP; ++k) {
        if (k >= 1) { const int l = (k - 1) / NSLOT, s = (k - 1) % NSLOT; if ((l & 1) && ((s >= 4 && s <= 6) || (CHUNKED_SCAN && s == 0))) continue; if (!(l & 1) && !CHUNKED_SCAN && s == 5) continue; }
        a.lo = k; a.hi = k + 1;
        hipLaunchKernelGGL(mk_fwd, dim3(grid), dim3(NTHR), LDS_BYTES, stream, a);
    }
#else
    a.lo = 0; a.hi = NSTEP;
    hipLaunchKernelGGL(mk_fwd, dim3(grid), dim3(NTHR), LDS_BYTES, stream, a);
#endif
    const hipError_t le = hipPeekAtLastError();
    if (le != hipSuccess) fprintf(stderr, "kernel_launch: launch failed: %s\n", hipGetErrorName(le));
}
```

```cpp
#include <hip/hip_runtime.h>
#include <cstdio>
#include <cstdint>
#include <cmath>

#ifndef MK_MULTI
#define MK_MULTI 0
#endif
#ifndef CHUNKED_SCAN
#define CHUNKED_SCAN 1
#endif

#define GAS __attribute__((address_space(1)))
#define LAS __attribute__((address_space(3)))
typedef unsigned short bf16_t;
typedef short bf16x8 __attribute__((ext_vector_type(8)));
typedef float f32x4 __attribute__((ext_vector_type(4)));
typedef float f32x2 __attribute__((ext_vector_type(2)));
typedef float f32x16 __attribute__((ext_vector_type(16)));
typedef unsigned u32x4 __attribute__((ext_vector_type(4)));
typedef unsigned u32x2 __attribute__((ext_vector_type(2)));
typedef __bf16 bf16x2_t __attribute__((ext_vector_type(2)));

constexpr int NB = 4, TT = 8192, DM = 1024, NLAT = NB * TT, CTXL = 256, NCTX = NB * CTXL, MROWS = NLAT + NCTX;
constexpr int DEPTH = 4;
constexpr int D_CONV = 256, RW_H = 12, RW_K = 64, D_RWKV = 768, RWKV_COLS = 2688, D_IN_EVEN = 3456, D_IN_EVEN_PAD = 3584;
constexpr int D_DIFF = 768, D_GMLP = 256, D_IN_ODD = 2816;
constexpr int NEXP = 16, D_EXP = 2048, CAP_L = 1024, CAP_C = 32, ESLOTS = 4352;
constexpr int P_LD = 3584;
constexpr int LORA_K = 384, LORA_N = 3840;
constexpr int LKEYS = CTXL + TT;
constexpr float ALPHA_DN = 1.6817928305074290f;
constexpr float DECAY_SCALE = 0.6065306597126334f;
constexpr float GN_EPS = 64e-5f, LN_EPS = 1e-5f, RMS_EPS = 1e-5f;
constexpr float QSCALE = 0.125f * 1.4426950408889634f;

constexpr size_t al256(size_t x) { return (x + 255) & ~(size_t)255; }
constexpr size_t WS_CTL = 0;
constexpr size_t CTL_BYTES = 65536;
constexpr size_t WS_MOD = WS_CTL + CTL_BYTES;
constexpr size_t WS_ROPE = WS_MOD + al256((size_t)DEPTH * 5 * 6144 * 4);
constexpr size_t WS_WIN = WS_ROPE + 32768;
constexpr size_t WS_WOUT = WS_WIN + (size_t)D_IN_EVEN_PAD * DM * 2;
constexpr size_t WS_WLORA = WS_WOUT + (size_t)DM * DM * 2;
constexpr size_t WS_WE13 = WS_WLORA + (size_t)LORA_N * LORA_K * 2;
constexpr size_t WE13_BYTES = (size_t)NEXP * 4096 * DM * 2, WE2_BYTES = (size_t)NEXP * DM * D_EXP * 2;
constexpr size_t WS_WE2 = WS_WE13 + 2 * WE13_BYTES;
constexpr size_t WS_X = WS_WE2 + 2 * WE2_BYTES;
constexpr size_t WS_H = WS_X + (size_t)MROWS * DM * 4;
constexpr size_t WS_A2 = WS_H + (size_t)MROWS * DM * 2;
constexpr size_t WS_P = WS_A2 + (size_t)MROWS * DM * 2;
constexpr size_t WS_AFF = WS_P + (size_t)MROWS * P_LD * 2;
constexpr size_t WS_SLOT = WS_AFF + (size_t)MROWS * 16 * 4;
constexpr size_t WS_IDX = WS_SLOT + (size_t)MROWS * 16 * 4;
constexpr size_t WS_GATE = WS_IDX + al256((size_t)NEXP * ESLOTS * 4);
constexpr size_t WS_R2 = WS_GATE + al256((size_t)NEXP * ESLOTS * 4);
constexpr int SC_REC = 1408, SC_ROW = 12 * SC_REC, SC_W = 0, SC_R = 512, SC_KK = 640, SC_V = 768, SC_B = 896, SC_KR = 1024;
constexpr size_t WS_SCN = WS_R2;
constexpr size_t WS_G = WS_SCN + (size_t)MROWS * SC_ROW;
constexpr size_t WS_LIN = WS_G + (size_t)MROWS * 768 * 2;
constexpr int CS_L = 64, CS_NCH = LKEYS / CS_L, CS_UNITS = NB * RW_H * 2;
constexpr size_t WS_CHK = WS_LIN + (size_t)MROWS * 384 * 2;
constexpr size_t WS_EVEN_END = WS_CHK + (size_t)CS_UNITS * CS_NCH * 32768;
constexpr size_t WS_Y = WS_P;
constexpr size_t WS_Q = WS_R2;
constexpr size_t WS_KA = WS_Q + (size_t)MROWS * 768 * 2;
constexpr size_t WS_VT = WS_KA + (size_t)NB * LKEYS * 768 * 2;
constexpr size_t WS_HID = WS_R2;
constexpr size_t WS_YE = WS_HID + (size_t)NEXP * ESLOTS * D_EXP * 2;
constexpr size_t WS_END = WS_EVEN_END;
static_assert(WS_END <= (size_t)2147483648ull, "workspace over 2 GiB");
static_assert((size_t)2 * MROWS * 768 * 4 <= (size_t)MROWS * P_LD * 2, "Y aliases P");
static_assert(WS_YE + (size_t)NEXP * ESLOTS * DM * 2 <= WS_END, "moe region");

constexpr int LDS_BYTES = 147456;
constexpr int LDS_MISC = 140 * 1024;
constexpr int LDS_PTAB = LDS_MISC + 256;
constexpr int NWAVES = 8, NTHR = 512;

__device__ __forceinline__ unsigned f2bf(float f) { unsigned u = __float_as_uint(f); return (u + 0x7fffu + ((u >> 16) & 1u)) >> 16; }
__device__ __forceinline__ unsigned pk2(float lo, float hi) { f32x2 v = {lo, hi}; bf16x2_t b = __builtin_convertvector(v, bf16x2_t); return __builtin_bit_cast(unsigned, b); }
__device__ __forceinline__ float bflo(unsigned u) { return __uint_as_float(u << 16); }
__device__ __forceinline__ float bfhi(unsigned u) { return __uint_as_float(u & 0xffff0000u); }
__device__ __forceinline__ float bf2f(bf16_t b) { return __uint_as_float((unsigned)b << 16); }
__device__ __forceinline__ float sigmoidf_(float x) { return 1.f / (1.f + __expf(-x)); }
__device__ __forceinline__ float wave_sum(float v) {
#pragma unroll
    for (int o = 1; o < 64; o <<= 1) v += __shfl_xor(v, o);
    return v;
}
__device__ __forceinline__ float sum16(float v) {
#pragma unroll
    for (int o = 1; o < 16; o <<= 1) v += __shfl_xor(v, o);
    return v;
}
__device__ __forceinline__ f32x4 ld4bf_(const void* p) { const u32x2 u = *(const u32x2*)p; return (f32x4){bflo(u.x), bfhi(u.x), bflo(u.y), bfhi(u.y)}; }
__device__ __forceinline__ void st4bf_(void* p, f32x4 v) { u32x2 o; o.x = pk2(v[0], v[1]); o.y = pk2(v[2], v[3]); *(u32x2*)p = o; }
__device__ __forceinline__ float max3f(float a, float b, float c) { float r; asm("v_max3_f32 %0, %1, %2, %3" : "=v"(r) : "v"(a), "v"(b), "v"(c)); return r; }
__device__ __forceinline__ int crow(int r, int hi) { return (r & 3) + 8 * (r >> 2) + 4 * hi; }
__device__ __forceinline__ float gelu_erf(float x) { return 0.5f * x * (1.f + erff(x * 0.70710678118654752f)); }

#define XB_TMO      128
#define XB_XCNT(j)  (256  + 64 * (j))
#define XB_XSUB(j)  (1280 + 64 * (j))
#define XB_XGEN(j)  (2304 + 64 * (j))
#define XB_TOP      3328
#define XB_TOPGEN   3392
#define XCD_BAR_WORDS 3456
#define XB_SPIN_CAP (1u << 20)

__device__ __forceinline__ unsigned xb_ld(unsigned* p)              { return __hip_atomic_load(p, __ATOMIC_RELAXED, __HIP_MEMORY_SCOPE_AGENT); }
__device__ __forceinline__ unsigned xb_add(unsigned* p, unsigned v) { return __hip_atomic_fetch_add(p, v, __ATOMIC_RELAXED, __HIP_MEMORY_SCOPE_AGENT); }
__device__ __forceinline__ unsigned xb_xcc_id() { return (unsigned)__builtin_amdgcn_s_getreg((3 << 11) | 20) & 0xFu; }
#define XB_SPIN(cond, bar) do { unsigned _sp = 0; while (cond) { __builtin_amdgcn_s_sleep(1); \
    if ((++_sp & 255u) == 0u) { if (xb_ld(&(bar)[XB_TMO])) break; if (_sp > XB_SPIN_CAP) { atomicAdd(&(bar)[XB_TMO], 1u); break; } } } } while (0)

struct XcdBarrier { unsigned* bar; unsigned x; volatile LAS unsigned* st; };

__device__ __forceinline__ XcdBarrier xcd_barrier_post(unsigned* bar, volatile LAS unsigned* st) {
    XcdBarrier b; b.bar = bar; b.x = xb_xcc_id(); b.st = st;
    if (threadIdx.x == 0) (void)xb_add(&bar[XB_XCNT(b.x)], 1u);
    return b;
}
__device__ __forceinline__ void xcd_barrier_complete(unsigned* bar, unsigned x, unsigned& nloc, unsigned& nx) {
    const unsigned G = gridDim.x * gridDim.y * gridDim.z;
    unsigned sum, cnt, mine, sp = 0u;
    for (;;) {
        sum = 0u; cnt = 0u; mine = 0u;
#pragma unroll
        for (unsigned j = 0; j < 16; ++j) { const unsigned c = xb_ld(&bar[XB_XCNT(j)]); sum += c; cnt += (c > 0u) ? 1u : 0u; mine = (j == x) ? c : mine; }
        if (sum == G) break;
        __builtin_amdgcn_s_sleep(1);
        if ((++sp & 255u) == 0u) { if (xb_ld(&bar[XB_TMO])) break; if (sp > XB_SPIN_CAP) { atomicAdd(&bar[XB_TMO], 1u); break; } }
    }
    nloc = mine > 0u ? mine : 1u; nx = cnt > 0u ? cnt : 1u;
}
__device__ __forceinline__ void xcd_barrier(const XcdBarrier& b) {
    asm volatile("s_waitcnt vmcnt(0)" ::: "memory");
    __syncthreads();
    if (threadIdx.x == 0) {
        unsigned* bar = b.bar;
        __builtin_amdgcn_s_waitcnt(0);
        unsigned nloc = b.st[0], nx = b.st[1];
        if (nloc == 0u) { xcd_barrier_complete(bar, b.x, nloc, nx); b.st[0] = nloc; b.st[1] = nx; }
        const unsigned old = xb_add(&bar[XB_XSUB(b.x)], 1u);
        const unsigned gen = old / nloc;
        if (old + 1u == (gen + 1u) * nloc) {
            __builtin_amdgcn_fence(__ATOMIC_RELEASE, "agent");
            asm volatile("s_waitcnt vmcnt(0)" ::: "memory");
            const unsigned og = xb_add(&bar[XB_TOP], 1u);
            const unsigned tg = og / nx;
            if (og + 1u == (tg + 1u) * nx) xb_add(&bar[XB_TOPGEN], 1u);
            else XB_SPIN(xb_ld(&bar[XB_TOPGEN]) == tg, bar);
            __builtin_amdgcn_fence(__ATOMIC_ACQUIRE, "agent");
            xb_add(&bar[XB_XGEN(b.x)], 1u);
            asm volatile("s_waitcnt vmcnt(0)" ::: "memory");
        } else {
            XB_SPIN(xb_ld(&bar[XB_XGEN(b.x)]) == gen, bar);
            __builtin_amdgcn_fence(__ATOMIC_ACQUIRE, "agent");
            asm volatile("s_waitcnt vmcnt(0)" ::: "memory");
        }
    }
    __syncthreads();
}

namespace pg8 {
constexpr int BM = 256, BK = 64, HALF = 128, HTB = HALF * BK * 2, STAGE_BYTES = 8 * HTB, NXCD = 8, WGM = 8;
__host__ __device__ __forceinline__ int lds_byte(int r, int c) { const int st = (r >> 4) * 2 + (c >> 5), rr = r & 15, cc = c & 31, ob = rr * 64 + cc * 2; return st * 1024 + (ob ^ (((ob >> 9) & 1) << 5)); }
__host__ __device__ __forceinline__ void stage_rc(int b, int& R, int& C) { const int st = b / 1024, sb = b % 1024, swz = sb ^ (((sb >> 9) & 1) << 5); R = (st >> 1) * 16 + swz / 64; C = (st & 1) * 32 + (swz % 64) / 2; }

struct Unit { int pm, pn, hf; };
struct Gemm { const bf16_t* A; const bf16_t* Bt; int K; };

template <int MODE> struct Order {
    static constexpr bool GATHER = (MODE == 1);
    int nM, nN, nwg, G, c; const int* idx; long bstride;
    __device__ __forceinline__ void init(int nM_, int nN_, int G_, int c_, const int* idx_, long bstride_) { nM = nM_; nN = nN_; nwg = nM * nN; G = G_; c = c_; idx = idx_; bstride = bstride_; }
    __device__ __forceinline__ bool next(int i, Unit& u) const {
        const long L = (long)i * G + c; if (L >= nwg) return false;
        int wgid = (int)L; { const int q = nwg / NXCD, r = nwg % NXCD, xcd = wgid % NXCD, off = wgid / NXCD; wgid = (xcd < r ? xcd * (q + 1) : r * (q + 1) + (xcd - r) * q) + off; }
        const int nig = WGM * nN, gid = wgid / nig, fm = gid * WGM, gsz = (nM - fm) < WGM ? (nM - fm) : WGM;
        u.pm = fm + ((wgid % nig) % gsz); u.pn = (wgid % nig) / gsz; u.hf = (MODE != 0 && (u.pm % 17) == 16) ? 1 : 0; return true;
    }
    __device__ __forceinline__ unsigned arow(const Unit& u, int r) const { if (MODE == 1) return (unsigned)idx[u.pm * BM + r]; return (unsigned)(u.pm * BM + r); }
    __device__ __forceinline__ long bbase(const Unit& u, int K) const { long o = (long)u.pn * BM * K; if (MODE != 0) o += (long)(u.pm / 17) * bstride; return o; }
};

template <int MODE> struct OrderExp {
    static constexpr bool GATHER = (MODE == 1);
    int nN, G, c0; const int* idx; long bstride;
    __device__ __forceinline__ void init(int nN_, int G_, int c_, const int* idx_, long bstride_) { nN = nN_; G = G_; c0 = c_; idx = idx_; bstride = bstride_; }
    __device__ __forceinline__ bool next(int i0, Unit& u) const {
        const int v = i0 * G + c0, i = v >> 8, c = v & 255;
        const int x = c & 7, slot = c >> 3, per = 32 / nN, nfull = 256 / (8 * per);
        if (i > nfull) return false;
        if (i < nfull) { u.pn = slot / per; const int f = (i * 8 + x) * per + (slot % per); u.pm = (f >> 4) * 17 + (f & 15); u.hf = 0; return true; }
        if (i == nfull && slot < 2 * nN) { u.pn = slot >> 1; u.pm = (x * 2 + (slot & 1)) * 17 + 16; u.hf = 1; return true; }
        return false;
    }
    __device__ __forceinline__ unsigned arow(const Unit& u, int r) const { if (MODE == 1) return (unsigned)idx[u.pm * BM + r]; return (unsigned)(u.pm * BM + r); }
    __device__ __forceinline__ long bbase(const Unit& u, int K) const { return (long)u.pn * BM * K + (long)(u.pm / 17) * bstride; }
};

template <class Epi, class Sched>
__device__ __forceinline__ void gemm_phase(LAS unsigned char* lds, const Gemm g, const Sched& S, const Epi& E) {
    int tid = threadIdx.x; asm volatile("" : "+v"(tid));
    const int wid = __builtin_amdgcn_readfirstlane(tid >> 6), wr = wid >> 2, wc = wid & 3;
    const int K = g.K, nt = K / BK;
    unsigned voffB[2];
    { const int lane = tid & 63, fr = lane & 15, fq = lane >> 4; (void)fr; (void)fq; }
#pragma unroll
    for (int i = 0; i < 2; ++i) { int R, Cc; stage_rc(tid * 16 + i * 8192, R, Cc); voffB[i] = (unsigned)(R * K + Cc) * 2u; }
    const size_t kstep = (size_t)(BK * 2);
    const size_t hstep = (size_t)HALF * K * 2;
    const unsigned ldsw = (unsigned)wid * 1024u;
    const int aoff = lds_byte(wr * 64 + (tid & 15), ((tid & 63) >> 4) * 8), boff = lds_byte(wc * 32 + (tid & 15), ((tid & 63) >> 4) * 8);
#define PG8_SA(b, h) (((b) * 2 + (h)) * HTB)
#define PG8_SB(b, h) ((4 + (b) * 2 + (h)) * HTB)
#define PG8_STAGE(bufoff, gbase, voff) do { _Pragma("unroll") for (int _i = 0; _i < 2; ++_i) \
        __builtin_amdgcn_global_load_lds((const unsigned*)((const char*)(gbase) + (voff)[_i]), (LAS unsigned*)(lds + (bufoff) + ldsw + _i * 8192), 16, 0, 0); } while (0)
#define PG8_LDA(dst, b, h) do { _Pragma("unroll") for (int m = 0; m < 4; ++m) _Pragma("unroll") for (int k = 0; k < 2; ++k) dst[m][k] = *(const LAS bf16x8*)(lds + PG8_SA(b, h) + aoff + m * 2048 + k * 1024); } while (0)
#define PG8_LDB(dst, b, h) do { _Pragma("unroll") for (int n = 0; n < 2; ++n) _Pragma("unroll") for (int k = 0; k < 2; ++k) dst[n][k] = *(const LAS bf16x8*)(lds + PG8_SB(b, h) + boff + n * 2048 + k * 1024); } while (0)
#define PG8_MMA(ai, bj, At, Bt) do { __builtin_amdgcn_s_setprio(1); _Pragma("unroll") for (int m = 0; m < 4; ++m) _Pragma("unroll") for (int n = 0; n < 2; ++n) _Pragma("unroll") for (int k = 0; k < 2; ++k) \
        acc[ai][bj][m][n] = __builtin_amdgcn_mfma_f32_16x16x32_bf16(Bt[n][k], At[m][k], acc[ai][bj][m][n], 0, 0, 0); __builtin_amdgcn_s_setprio(0); } while (0)
#define PG8_WAIT_V(n) asm volatile("s_waitcnt vmcnt(" #n ")" ::: "memory")
#define PG8_WAIT_L(n) asm volatile("s_waitcnt lgkmcnt(" #n ")" ::: "memory")
#define PG8_BAR __builtin_amdgcn_s_barrier()
#define PG8_SCHED __builtin_amdgcn_sched_barrier(0)
#define PG8_ROWOFFS(dst, u, tq) do { _Pragma("unroll") for (int _i = 0; _i < 2; ++_i) { int _R, _C; stage_rc((tq) * 16 + _i * 8192, _R, _C); _Pragma("unroll") for (int _h = 0; _h < 2; ++_h) dst[_h][_i] = (S.arow(u, _h * HALF + _R) * (unsigned)K + (unsigned)_C) * 2u; } } while (0)
    Unit cur, nxt; int ui = 0;
    if (!S.next(0, cur)) return;
    float zf = 0.f; asm volatile("" : "+v"(zf));
    f32x4 acc[2][2][4][2];
#pragma unroll
    for (int a = 0; a < 2; ++a)
#pragma unroll
        for (int b = 0; b < 2; ++b)
#pragma unroll
            for (int m = 0; m < 4; ++m)
#pragma unroll
                for (int n = 0; n < 2; ++n) acc[a][b][m][n] = (f32x4){zf, zf, zf, zf};
    bf16x8 At[4][2], B0[2][2], B1[2][2];
    unsigned vcur[2][2];
    if constexpr (Sched::GATHER) { PG8_ROWOFFS(vcur, cur, tid); }
    const char* const Ab = (const char*)g.A;
    const char* cA = Sched::GATHER ? Ab : Ab + (size_t)(unsigned)__builtin_amdgcn_readfirstlane((int)S.arow(cur, 0)) * K * 2;
#define PG8_STAGEA(bufoff, ptr, h) do { if constexpr (Sched::GATHER) { PG8_STAGE(bufoff, ptr, vcur[h]); } else { PG8_STAGE(bufoff, (ptr) + (h) * hstep, voffB); } } while (0)
    const char* cB = (const char*)g.Bt + (size_t)S.bbase(cur, K) * 2;
    PG8_STAGE(PG8_SB(0, 0), cB, voffB); PG8_STAGE(PG8_SB(0, 1), cB + hstep, voffB); PG8_STAGEA(PG8_SA(0, 0), cA, 0); PG8_STAGEA(PG8_SA(0, 1), cA, 1);
    if (wr == 1) PG8_BAR;
    PG8_WAIT_V(2); PG8_BAR;
    PG8_STAGE(PG8_SB(1, 0), cB + kstep, voffB); PG8_STAGEA(PG8_SA(1, 0), cA + kstep, 0); PG8_STAGE(PG8_SB(1, 1), cB + hstep + kstep, voffB);
    PG8_WAIT_V(6); PG8_BAR;
    for (;;) {
        const bool has_next = S.next(ui + 1, nxt);
        const char* nB = has_next ? (const char*)g.Bt + (size_t)S.bbase(nxt, K) * 2 : cB;
        const char* nA = (Sched::GATHER || !has_next) ? cA : Ab + (size_t)(unsigned)__builtin_amdgcn_readfirstlane((int)S.arow(nxt, 0)) * K * 2;
#pragma unroll 1
        for (int t = 0; t < nt; t += 2) {
            const bool last = (t == nt - 2);
            const char* a1 = cA + (size_t)(t + 1) * kstep;
            const char* a2 = last ? nA : cA + (size_t)(t + 2) * kstep; const char* b2 = last ? nB : cB + (size_t)(t + 2) * kstep;
            const char* a3 = a2 + kstep; const char* b3 = b2 + kstep;
            PG8_LDB(B0, 0, 0); PG8_LDB(B1, 0, 1); PG8_SCHED; PG8_LDA(At, 0, 0); PG8_STAGEA(PG8_SA(1, 1), a1, 1);
            PG8_WAIT_V(8); PG8_WAIT_L(0); PG8_BAR; PG8_MMA(0, 0, At, B0); PG8_MMA(0, 1, At, B1); PG8_BAR; PG8_SCHED;
            if constexpr (Sched::GATHER) { if (last && has_next) { int tq = tid; asm volatile("" : "+v"(tq)); PG8_ROWOFFS(vcur, nxt, tq); } }
            PG8_LDA(At, 0, 1); PG8_STAGE(PG8_SB(0, 0), b2, voffB); PG8_STAGE(PG8_SB(0, 1), b2 + hstep, voffB); PG8_STAGEA(PG8_SA(0, 0), a2, 0);
            PG8_WAIT_V(8); PG8_WAIT_L(0); PG8_BAR; if (!cur.hf) { PG8_MMA(1, 0, At, B0); PG8_MMA(1, 1, At, B1); } PG8_BAR; PG8_SCHED;
            PG8_LDB(B0, 1, 0); PG8_LDB(B1, 1, 1); PG8_SCHED; PG8_LDA(At, 1, 0); PG8_STAGEA(PG8_SA(0, 1), a2, 1);
            PG8_WAIT_V(8); PG8_WAIT_L(0); PG8_BAR; PG8_MMA(0, 0, At, B0); PG8_MMA(0, 1, At, B1); PG8_BAR; PG8_SCHED;
            PG8_LDA(At, 1, 1); PG8_STAGE(PG8_SB(1, 0), b3, voffB); PG8_STAGE(PG8_SB(1, 1), b3 + hstep, voffB); PG8_STAGEA(PG8_SA(1, 0), a3, 0);
            PG8_WAIT_V(8); PG8_WAIT_L(0); PG8_BAR; if (!cur.hf) { PG8_MMA(1, 0, At, B0); PG8_MMA(1, 1, At, B1); } PG8_BAR; PG8_SCHED;
        }
        if (wr == 0) PG8_BAR;
        { int tz = tid; asm volatile("" : "+v"(tz)); const int ln = tz & 63; E(acc, cur, wr, wc, ln & 15, ln >> 4); }
        if (!has_next) break;
#pragma unroll
        for (int a = 0; a < 2; ++a)
#pragma unroll
            for (int b = 0; b < 2; ++b)
#pragma unroll
                for (int m = 0; m < 4; ++m)
#pragma unroll
                    for (int n = 0; n < 2; ++n) acc[a][b][m][n] = (f32x4){zf, zf, zf, zf};
        cur = nxt; cB = nB; cA = nA; ++ui;
        if (wr == 1) PG8_BAR;
    }
    PG8_WAIT_V(0);
    PG8_BAR;
#undef PG8_SA
#undef PG8_SB
#undef PG8_STAGE
#undef PG8_LDA
#undef PG8_LDB
#undef PG8_MMA
#undef PG8_WAIT_V
#undef PG8_WAIT_L
#undef PG8_BAR
#undef PG8_SCHED
#undef PG8_ROWOFFS
#undef PG8_STAGEA
}

#define EPI_LOOP for (int ai = 0; ai < 2; ++ai) for (int m = 0; m < 4; ++m) for (int bj = 0; bj < 2; ++bj) for (int n = 0; n < 2; ++n)
struct EpiBf16 {
    bf16_t* O; int ldc;
    __device__ __forceinline__ void operator()(const f32x4 (&acc)[2][2][4][2], const Unit& u, int wr, int wc, int fr, int fq) const {
        const int row0 = u.pm * BM + wr * 64 + fr, col0 = u.pn * BM + wc * 32 + 4 * fq;
#pragma unroll
        for (int ai = 0; ai < 2; ++ai)
#pragma unroll
            for (int m = 0; m < 4; ++m) { bf16_t* rowp = O + (size_t)(row0 + ai * HALF + m * 16) * ldc + col0;
#pragma unroll
                for (int bj = 0; bj < 2; ++bj)
#pragma unroll
                    for (int n = 0; n < 2; ++n) { const f32x4 v = acc[ai][bj][m][n]; u32x2 o; o.x = pk2(v[0], v[1]); o.y = pk2(v[2], v[3]); *(u32x2*)(rowp + bj * HALF + n * 16) = o; } }
    }
};
struct EpiOdd {
    bf16_t* P; bf16_t* Q; bf16_t* KA; const float* rope;
    __device__ __forceinline__ void operator()(const f32x4 (&acc)[2][2][4][2], const Unit& u, int wr, int wc, int fr, int fq) const {
        const int row0 = u.pm * BM + wr * 64 + fr, col0 = u.pn * BM + wc * 32 + 4 * fq;
        if (u.pn >= 6) {
#pragma unroll
            for (int ai = 0; ai < 2; ++ai)
#pragma unroll
                for (int m = 0; m < 4; ++m) { bf16_t* rowp = P + (size_t)(row0 + ai * HALF + m * 16) * P_LD + col0;
#pragma unroll
                    for (int bj = 0; bj < 2; ++bj)
#pragma unroll
                        for (int n = 0; n < 2; ++n) { const f32x4 v = acc[ai][bj][m][n]; u32x2 o; o.x = pk2(v[0], v[1]); o.y = pk2(v[2], v[3]); *(u32x2*)(rowp + bj * HALF + n * 16) = o; } }
            return;
        }
        const bool isk = u.pn >= 3, isctx = u.pm >= NLAT / BM; const int axis = wc & 1;
        const int cq = col0 - (isk ? 768 : 0);
        f32x4 csr[2][4], snr[2][4];
#pragma unroll
        for (int ai = 0; ai < 2; ++ai)
#pragma unroll
            for (int m = 0; m < 4; ++m) { const int row = row0 + ai * HALF + m * 16; csr[ai][m] = (f32x4){1.f, 1.f, 1.f, 1.f}; snr[ai][m] = (f32x4){0.f, 0.f, 0.f, 0.f};
                if (!isctx) { const int t = row & (TT - 1); const int pos = axis ? 128 + (t & 63) : (t >> 6);
                    csr[ai][m] = *(const f32x4*)(rope + pos * 16 + 4 * fq); snr[ai][m] = *(const f32x4*)(rope + 192 * 16 + pos * 16 + 4 * fq); } }
#pragma unroll
        for (int ai = 0; ai < 2; ++ai)
#pragma unroll
            for (int m = 0; m < 4; ++m) { const int row = row0 + ai * HALF + m * 16;
                const f32x4 cs = csr[ai][m], sn = snr[ai][m]; size_t orow;
                if (!isctx) { const int t = row & (TT - 1); orow = isk ? (size_t)(row >> 13) * LKEYS + CTXL + t : (size_t)row; }
                else { const int rc = row - NLAT; orow = isk ? (size_t)(rc >> 8) * LKEYS + (rc & 255) : (size_t)row; }
                bf16_t* op = (isk ? KA : Q) + orow * 768 + cq; const float sc = isk ? 1.f : QSCALE;
#pragma unroll
                for (int bj = 0; bj < 2; ++bj) { const f32x4 x1 = acc[ai][bj][m][0], x2 = acc[ai][bj][m][1];
                    const f32x4 o1 = (x1 * cs - x2 * sn) * sc, o2 = (x1 * sn + x2 * cs) * sc;
                    u32x2 a; a.x = pk2(o1[0], o1[1]); a.y = pk2(o1[2], o1[3]); *(u32x2*)(op + bj * HALF) = a;
                    u32x2 b; b.x = pk2(o2[0], o2[1]); b.y = pk2(o2[2], o2[3]); *(u32x2*)(op + bj * HALF + 16) = b; } }
    }
};
struct EpiRes {
    float* X; const float* modl;
    __device__ __forceinline__ void operator()(const f32x4 (&acc)[2][2][4][2], const Unit& u, int wr, int wc, int fr, int fq) const {
        const int row0 = u.pm * BM + wr * 64 + fr, col0 = u.pn * BM + wc * 32 + 4 * fq;
        const int mi = (u.pm * BM < NLAT) ? (u.pm * BM) / TT : 4;
        const float* gate = modl + mi * 6144 + 2 * DM;
        f32x4 gv[2][2];
#pragma unroll
        for (int bj = 0; bj < 2; ++bj)
#pragma unroll
            for (int n = 0; n < 2; ++n) gv[bj][n] = *(const f32x4*)(gate + col0 + bj * HALF + n * 16);
#pragma unroll
        for (int ai = 0; ai < 2; ++ai) { f32x4 xr[4][2][2];
#pragma unroll
            for (int m = 0; m < 4; ++m) { const float* rowp = X + (size_t)(row0 + ai * HALF + m * 16) * DM + col0;
#pragma unroll
                for (int bj = 0; bj < 2; ++bj)
#pragma unroll
                    for (int n = 0; n < 2; ++n) xr[m][bj][n] = *(const f32x4*)(rowp + bj * HALF + n * 16); }
#pragma unroll
            for (int m = 0; m < 4; ++m) { float* rowp = X + (size_t)(row0 + ai * HALF + m * 16) * DM + col0;
#pragma unroll
                for (int bj = 0; bj < 2; ++bj)
#pragma unroll
                    for (int n = 0; n < 2; ++n) *(f32x4*)(rowp + bj * HALF + n * 16) = xr[m][bj][n] * ALPHA_DN + gv[bj][n] * acc[ai][bj][m][n]; } }
    }
};
struct EpiSwiGLU {
    bf16_t* HID;
    __device__ __forceinline__ void operator()(const f32x4 (&acc)[2][2][4][2], const Unit& u, int wr, int wc, int fr, int fq) const {
        const int row0 = u.pm * BM + wr * 64 + fr, f0 = u.pn * HALF + wc * 32 + 4 * fq;
#pragma unroll
        for (int ai = 0; ai < 2; ++ai) if (ai == 0 || !u.hf)
#pragma unroll
            for (int m = 0; m < 4; ++m) { bf16_t* rowp = HID + (size_t)(row0 + ai * HALF + m * 16) * D_EXP + f0;
#pragma unroll
                for (int n = 0; n < 2; ++n) { const f32x4 a = acc[ai][0][m][n], b = acc[ai][1][m][n]; float h[4];
#pragma unroll
                    for (int j = 0; j < 4; ++j) h[j] = a[j] / (1.f + __expf(-a[j])) * b[j];
                    u32x2 o; o.x = pk2(h[0], h[1]); o.y = pk2(h[2], h[3]); *(u32x2*)(rowp + n * 16) = o; } }
    }
};
struct EpiYE {
    bf16_t* YE; const float* gate;
    __device__ __forceinline__ void operator()(const f32x4 (&acc)[2][2][4][2], const Unit& u, int wr, int wc, int fr, int fq) const {
        const int row0 = u.pm * BM + wr * 64 + fr, col0 = u.pn * BM + wc * 32 + 4 * fq;
        float gts[2][4];
#pragma unroll
        for (int ai = 0; ai < 2; ++ai)
#pragma unroll
            for (int m = 0; m < 4; ++m) gts[ai][m] = gate[row0 + ai * HALF + m * 16];
#pragma unroll
        for (int ai = 0; ai < 2; ++ai) if (ai == 0 || !u.hf)
#pragma unroll
            for (int m = 0; m < 4; ++m) { const int row = row0 + ai * HALF + m * 16; const float gt = gts[ai][m]; bf16_t* rowp = YE + (size_t)row * DM + col0;
#pragma unroll
                for (int bj = 0; bj < 2; ++bj)
#pragma unroll
                    for (int n = 0; n < 2; ++n) { const f32x4 v = acc[ai][bj][m][n] * gt; u32x2 o; o.x = pk2(v[0], v[1]); o.y = pk2(v[2], v[3]); *(u32x2*)(rowp + bj * HALF + n * 16) = o; } }
    }
};
struct EpiLora {
    unsigned char* SCN; bf16_t* G; const float* decay0; const float* a0; const float* kalpha;
    __device__ __forceinline__ void operator()(const f32x4 (&acc)[2][2][4][2], const Unit& u, int wr, int wc, int fr, int fq) const {
        const int row0 = u.pm * BM + wr * 64 + fr;
        const int seg = u.pn / 3, cb = (u.pn % 3) * BM + wc * 32 + 4 * fq;
#pragma unroll
        for (int bj = 0; bj < 2; ++bj)
#pragma unroll
            for (int n = 0; n < 2; ++n) {
                const int col = cb + bj * HALF + n * 16, head = col >> 6, kx = col & 63;
                if (seg < 2) {
                    const f32x4 d0 = *(const f32x4*)(decay0 + seg * 768 + col);
#pragma unroll
                    for (int ai = 0; ai < 2; ++ai)
#pragma unroll
                        for (int m = 0; m < 4; ++m) { const int row = row0 + ai * HALF + m * 16; f32x4 w;
#pragma unroll
                            for (int j = 0; j < 4; ++j) { const float lw = -DECAY_SCALE * sigmoidf_(d0[j] + acc[ai][bj][m][n][j]); w[j] = CHUNKED_SCAN ? lw : __expf(lw); }
                            *(f32x4*)(SCN + (size_t)(row * 12 + head) * SC_REC + SC_W + seg * 256 + kx * 4) = w; __builtin_amdgcn_sched_barrier(0); }
                } else if (seg < 4) {
                    const int d = seg - 2;
                    const f32x4 a00 = *(const f32x4*)(a0 + d * 768 + col), kal = *(const f32x4*)(kalpha + col);
                    u32x2 kkr[2][4], ksr[2][4];
#pragma unroll
                    for (int ai = 0; ai < 2; ++ai)
#pragma unroll
                        for (int m = 0; m < 4; ++m) { const unsigned char* base = SCN + (size_t)((row0 + ai * HALF + m * 16) * 12 + head) * SC_REC + kx * 2;
                            kkr[ai][m] = *(const u32x2*)(base + SC_KK); ksr[ai][m] = *(const u32x2*)(base + SC_KR + 256 * d); }
#pragma unroll
                    for (int ai = 0; ai < 2; ++ai)
#pragma unroll
                        for (int m = 0; m < 4; ++m) { const int row = row0 + ai * HALF + m * 16; unsigned char* base = SCN + (size_t)(row * 12 + head) * SC_REC + kx * 2;
                            const f32x4 kk = {bflo(kkr[ai][m].x), bfhi(kkr[ai][m].x), bflo(kkr[ai][m].y), bfhi(kkr[ai][m].y)}; const f32x4 ks = {bflo(ksr[ai][m].x), bfhi(ksr[ai][m].x), bflo(ksr[ai][m].y), bfhi(ksr[ai][m].y)}; f32x4 bb, kr;
#pragma unroll
                            for (int j = 0; j < 4; ++j) { const float a = sigmoidf_(a00[j] + acc[ai][bj][m][n][j]); bb[j] = kk[j] * a; kr[j] = ks[j] * (1.f + (a - 1.f) * kal[j]); }
                            st4bf_(base + SC_B + 256 * d, bb); st4bf_(base + SC_KR + 256 * d, kr); __builtin_amdgcn_sched_barrier(0); }
                } else {
#pragma unroll
                    for (int ai = 0; ai < 2; ++ai)
#pragma unroll
                        for (int m = 0; m < 4; ++m) { const int row = row0 + ai * HALF + m * 16; const f32x4 v = acc[ai][bj][m][n]; u32x2 o; o.x = pk2(v[0], v[1]); o.y = pk2(v[2], v[3]);
                            *(u32x2*)(G + (size_t)row * 768 + col) = o; }
                }
            }
    }
};
}

struct Args { const float* in[37]; float* out; unsigned char* ws; int lo, hi; };
enum { I_X = 0, I_C, I_CTX, I_CCTX, I_WMOD, I_BMOD, I_LNG, I_LNB, I_EWIN, I_EWOUT, I_CONVW, I_MU, I_DUP, I_D0, I_AUP, I_A0, I_GUP, I_KXI, I_KAL, I_RBON, I_GNG, I_GNB,
       I_OWIN, I_OWOUT, I_LQ1, I_LK1, I_LQ2, I_LK2, I_SUBG, I_GLNG, I_GLNB, I_GWS, I_GBS, I_WR, I_WE1, I_WE3, I_WE2 };

struct Ctx {
    LAS unsigned char* lds;
    int tid, lane, wave, G, vcu, gw, NGW;
};
__device__ __forceinline__ void mkctx(Ctx& C, LAS unsigned char* lds) {
    int tid = threadIdx.x; asm volatile("" : "+v"(tid));
    C.lds = lds; C.tid = tid; C.lane = tid & 63; C.wave = __builtin_amdgcn_readfirstlane(tid >> 6);
    C.G = gridDim.x; { const int bx = blockIdx.x; C.vcu = (C.G % 8 == 0) ? (bx % 8) * (C.G / 8) + bx / 8 : bx; }
    C.gw = blockIdx.x * NWAVES + C.wave; C.NGW = C.G * NWAVES;
}
#define GLOBAL_PTR(T, v) ((T*)(__attribute__((address_space(1))) T*)(v))
__device__ __forceinline__ void ldargs(Args& A, LAS unsigned char* lds) {
    LAS const u32x2* tb = (LAS const u32x2*)(lds + LDS_PTAB); asm volatile("" : "+v"(tb));
#pragma unroll
    for (int i = 0; i < 37; ++i) { const u32x2 v = tb[i]; A.in[i] = GLOBAL_PTR(const float, ((unsigned long long)(unsigned)__builtin_amdgcn_readfirstlane((int)v.y) << 32) | (unsigned)__builtin_amdgcn_readfirstlane((int)v.x)); }
    { const u32x2 v = tb[37]; A.out = GLOBAL_PTR(float, ((unsigned long long)(unsigned)__builtin_amdgcn_readfirstlane((int)v.y) << 32) | (unsigned)__builtin_amdgcn_readfirstlane((int)v.x)); }
    { const u32x2 v = tb[38]; A.ws = GLOBAL_PTR(unsigned char, ((unsigned long long)(unsigned)__builtin_amdgcn_readfirstlane((int)v.y) << 32) | (unsigned)__builtin_amdgcn_readfirstlane((int)v.x)); }
    A.lo = 0; A.hi = 0;
}
__device__ __forceinline__ int row_mi(int row) { return row < NLAT ? (row >> 13) : 4; }

__device__ __forceinline__ void phase_init(const Ctx& C, const Args& A) {
    unsigned char* ws = A.ws;
    float* MOD = (float*)(ws + WS_MOD);
    LAS float* sv = (LAS float*)C.lds;
    LAS float* red = sv + 5 * 1024;
    for (int i = C.tid; i < 5 * 1024; i += NTHR) { const int v = i >> 10, k = i & 1023; const float c = (v < 4) ? A.in[I_C][v * DM + k] : A.in[I_CCTX][k]; sv[i] = c / (1.f + __expf(-c)); }
    __syncthreads();
    const int j = C.tid & 127, kp = C.tid >> 7;
    for (int it = blockIdx.x; it < DEPTH * 48; it += C.G) {
        const int l = it / 48, cg = it % 48, col = cg * 128 + j;
        const float* W = A.in[I_WMOD] + (size_t)l * DM * 6144 + col;
        float a0 = 0.f, a1 = 0.f, a2 = 0.f, a3 = 0.f, a4 = 0.f;
#pragma unroll 4
        for (int k = kp * 256; k < kp * 256 + 256; ++k) { const float w = W[(size_t)k * 6144]; a0 += sv[k] * w; a1 += sv[1024 + k] * w; a2 += sv[2048 + k] * w; a3 += sv[3072 + k] * w; a4 += sv[4096 + k] * w; }
        red[(kp * 5 + 0) * 128 + j] = a0; red[(kp * 5 + 1) * 128 + j] = a1; red[(kp * 5 + 2) * 128 + j] = a2; red[(kp * 5 + 3) * 128 + j] = a3; red[(kp * 5 + 4) * 128 + j] = a4;
        __syncthreads();
        for (int o = C.tid; o < 5 * 128; o += NTHR) { const int v = o >> 7, jj = o & 127; const int cc = cg * 128 + jj;
            const float s = red[(0 * 5 + v) * 128 + jj] + red[(1 * 5 + v) * 128 + jj] + red[(2 * 5 + v) * 128 + jj] + red[(3 * 5 + v) * 128 + jj];
            MOD[((size_t)l * 5 + v) * 6144 + cc] = s + A.in[I_BMOD][l * 6144 + cc]; }
        __syncthreads();
    }
    if (blockIdx.x == C.G - 1) { float* rope = (float*)(ws + WS_ROPE);
        for (int i = C.tid; i < 192 * 16; i += NTHR) { const int pos = i >> 4, j = i & 15; const float ang = (float)(pos < 128 ? pos : pos - 128) * powf(10000.f, -(float)j * (1.f / 16.f));
            rope[i] = cosf(ang); rope[192 * 16 + i] = sinf(ang); } }
    f32x4* X4 = (f32x4*)(ws + WS_X);
    const f32x4* x4 = (const f32x4*)A.in[I_X]; const f32x4* c4 = (const f32x4*)A.in[I_CTX];
    const size_t nl = (size_t)NLAT * DM / 4, nc = (size_t)NCTX * DM / 4;
    for (size_t i = (size_t)blockIdx.x * NTHR + C.tid; i < nl + nc; i += (size_t)C.G * NTHR) X4[i] = (i < nl) ? x4[i] : c4[i - nl];
}

__device__ __forceinline__ void transpose_item(const float* W, int ldw, int k0, int n0, bf16_t* WT, int ldt, int drow0, LAS float* scr, int lane) {
    { float v[64]; const float* src = W + (size_t)k0 * ldw + n0 + lane;
#pragma unroll
      for (int k = 0; k < 64; ++k) v[k] = __builtin_nontemporal_load(src + (size_t)k * ldw);
#pragma unroll
      for (int k = 0; k < 64; ++k) scr[k * 65 + lane] = v[k]; }
    asm volatile("s_waitcnt lgkmcnt(0)" ::: "memory");
    const int c = lane & 7;
#pragma unroll
    for (int j = 0; j < 8; ++j) { const int n = (lane >> 3) + 8 * j; const LAS float* s = scr + (8 * c) * 65 + n;
        u32x4 o; o.x = pk2(s[0 * 65], s[1 * 65]); o.y = pk2(s[2 * 65], s[3 * 65]); o.z = pk2(s[4 * 65], s[5 * 65]); o.w = pk2(s[6 * 65], s[7 * 65]);
        *(u32x4*)(WT + (size_t)(drow0 + n) * ldt + k0 + 8 * c) = o; }
    asm volatile("s_waitcnt lgkmcnt(0)" ::: "memory");
}
__device__ __forceinline__ void conv_items(const Ctx& C, const Args& A, int l, int gw, int NGW, bool do_in, bool do_out, bool do_exp) {
    unsigned char* ws = A.ws;
    const int i2 = l >> 1; const bool odd = (l & 1);
    LAS float* scr = (LAS float*)C.lds + C.wave * (64 * 65);
    bf16_t* WIN = (bf16_t*)(ws + WS_WIN); bf16_t* WOUT = (bf16_t*)(ws + WS_WOUT); bf16_t* WE13 = (bf16_t*)(ws + WS_WE13 + (size_t)(l & 1) * WE13_BYTES); bf16_t* WE2 = (bf16_t*)(ws + WS_WE2 + (size_t)(l & 1) * WE2_BYTES);
    const int nin = odd ? D_IN_ODD : D_IN_EVEN;
    const float* win = odd ? A.in[I_OWIN] + (size_t)i2 * DM * D_IN_ODD : A.in[I_EWIN] + (size_t)i2 * DM * D_IN_EVEN;
    const float* wout = odd ? A.in[I_OWOUT] + (size_t)i2 * DM * DM : A.in[I_EWOUT] + (size_t)i2 * DM * DM;
    const int n_in = do_in ? 16 * (nin / 64) : 0, n_out = do_out ? 16 * 16 : 0, n_e13 = do_exp ? NEXP * 2 * 16 * 32 : 0, n_e2 = do_exp ? NEXP * 32 * 16 : 0;
    const int total = n_in + n_out + n_e13 + n_e2;
    for (int it = gw; it < total; it += NGW) {
        int r = it;
        if (r < n_in) { const int nb = nin / 64, kb = r / nb, nn = r % nb; transpose_item(win, nin, kb * 64, nn * 64, WIN, DM, nn * 64, scr, C.lane); continue; } r -= n_in;
        if (r < n_out) { const int kb = r / 16, nn = r % 16; transpose_item(wout, DM, kb * 64, nn * 64, WOUT, DM, nn * 64, scr, C.lane); continue; } r -= n_out;
        if (r < n_e13) { const int e = r / 1024, q = r % 1024, mat = q / 512, q2 = q % 512, kb = q2 / 32, nn = q2 % 32;
            const float* W = (mat ? A.in[I_WE3] : A.in[I_WE1]) + ((size_t)l * NEXP + e) * DM * D_EXP;
            const int f0 = nn * 64; const int drow = (f0 >> 7) * 256 + mat * 128 + (f0 & 127);
            transpose_item(W, D_EXP, kb * 64, f0, WE13 + (size_t)e * 4096 * DM, DM, drow, scr, C.lane); continue; } r -= n_e13;
        { const int e = r / 512, q = r % 512, kb = q / 16, nn = q % 16;
            const float* W = A.in[I_WE2] + ((size_t)l * NEXP + e) * D_EXP * DM;
            transpose_item(W, DM, kb * 64, nn * 64, WE2 + (size_t)e * DM * D_EXP, D_EXP, nn * 64, scr, C.lane); }
    }
}
__device__ __forceinline__ void phase_conv(const Ctx& C, const Args& A, int l) {
    unsigned char* ws = A.ws;
    const int i2 = l >> 1; const bool odd = (l & 1);
    bf16_t* WIN = (bf16_t*)(ws + WS_WIN);
    const bool early = CHUNKED_SCAN && odd;
    if (l > 0) conv_items(C, A, l, C.gw, C.NGW, !early, true, !early);
    if (!odd) {
        u32x4* z = (u32x4*)(WIN + (size_t)D_IN_EVEN * DM);
        unsigned zz = 0u; asm volatile("" : "+v"(zz));
        for (int i = blockIdx.x * NTHR + C.tid; i < (D_IN_EVEN_PAD - D_IN_EVEN) * DM / 8; i += C.G * NTHR) z[i] = (u32x4){zz, zz, zz, zz};
        bf16_t* WL = (bf16_t*)(ws + WS_WLORA);
        const float* dup = A.in[I_DUP] + (size_t)i2 * 2 * 64 * 768; const float* aup = A.in[I_AUP] + (size_t)i2 * 2 * 64 * 768; const float* gup = A.in[I_GUP] + (size_t)i2 * 128 * 768;
        for (int i = blockIdx.x * NTHR + C.tid; i < LORA_N * LORA_K; i += C.G * NTHR) {
            const int kk = i / LORA_N, n = i % LORA_N, seg = n / 768, col = n % 768; float v = 0.f;
            if (seg == 0) { if (kk < 64) v = dup[(size_t)(0 * 64 + kk) * 768 + col]; }
            else if (seg == 1) { if (kk >= 64 && kk < 128) v = dup[(size_t)(1 * 64 + kk - 64) * 768 + col]; }
            else if (seg == 2) { if (kk >= 128 && kk < 192) v = aup[(size_t)(0 * 64 + kk - 128) * 768 + col]; }
            else if (seg == 3) { if (kk >= 192 && kk < 256) v = aup[(size_t)(1 * 64 + kk - 192) * 768 + col]; }
            else { if (kk >= 256) v = gup[(size_t)(kk - 256) * 768 + col]; }
            WL[(size_t)n * LORA_K + kk] = (bf16_t)f2bf(v);
        }
    }
}

__device__ __forceinline__ void phase_modh(const Ctx& C, const Args& A, int l) {
    const float* X = (const float*)(A.ws + WS_X); bf16_t* H = (bf16_t*)(A.ws + WS_H); const float* MOD = (const float*)(A.ws + WS_MOD) + (size_t)l * 5 * 6144;
    for (int row = C.gw; row < MROWS; row += C.NGW) {
        const float* md = MOD + row_mi(row) * 6144;
#pragma unroll
        for (int j = 0; j < 4; ++j) { const int col = 4 * C.lane + 256 * j; const f32x4 x = *(const f32x4*)(X + (size_t)row * DM + col), sh = *(const f32x4*)(md + col), sc = *(const f32x4*)(md + DM + col);
            const f32x4 h = x * (sc + 1.f) + sh; u32x2 o; o.x = pk2(h[0], h[1]); o.y = pk2(h[2], h[3]); *(u32x2*)(H + (size_t)row * DM + col) = o; }
    }
}

__device__ __forceinline__ f32x4 ld4bf(const bf16_t* p) { const u32x2 u = *(const u32x2*)p; return (f32x4){bflo(u.x), bfhi(u.x), bflo(u.y), bfhi(u.y)}; }
__device__ __forceinline__ void st4bf(bf16_t* p, f32x4 v) { u32x2 o; o.x = pk2(v[0], v[1]); o.y = pk2(v[2], v[3]); *(u32x2*)p = o; }
__device__ __forceinline__ void seq_info(int row, bool& hasp, bool& hasn) {
    if (row < NLAT) { const int t = row & (TT - 1); hasp = t > 0; hasn = t < TT - 1; }
    else { const int t = (row - NLAT) & (CTXL - 1); hasp = t > 0; hasn = t < CTXL - 1; }
}
struct Ef1Row { u32x2 bg, ua, ub, m[11]; };
__device__ __forceinline__ f32x4 bf4(u32x2 u) { return (f32x4){bflo(u.x), bfhi(u.x), bflo(u.y), bfhi(u.y)}; }
__device__ __forceinline__ void ef1_load(Ef1Row& R, const bf16_t* P, int row, int lane) {
    row = row < 0 ? 0 : row > MROWS - 1 ? MROWS - 1 : row;
    const bf16_t* p = P + (size_t)row * P_LD + 4 * lane;
    R.bg = *(const u32x2*)p; R.ua = *(const u32x2*)(p + 256); R.ub = *(const u32x2*)(p + 512);
#pragma unroll
    for (int it = 0; it < 11; ++it) R.m[it] = *(const u32x2*)(p + 768 + it * 256);
}
__device__ __forceinline__ void phase_ef1(const Ctx& C, const Args& A, int l) {
    const int i2 = l >> 1; unsigned char* ws = A.ws;
    const bf16_t* P = (const bf16_t*)(ws + WS_P); bf16_t* A2 = (bf16_t*)(ws + WS_A2); unsigned char* SCN = ws + WS_SCN; bf16_t* LIN = (bf16_t*)(ws + WS_LIN);
    const float* cw = A.in[I_CONVW] + (size_t)i2 * 3 * 256; const float* mu = A.in[I_MU] + (size_t)i2 * RWKV_COLS; const float* kxi = A.in[I_KXI] + (size_t)i2 * 768;
    const int j4 = 4 * C.lane;
    const f32x4 w0 = *(const f32x4*)(cw + j4), w1 = *(const f32x4*)(cw + 256 + j4), w2 = *(const f32x4*)(cw + 512 + j4);
    f32x4 mur[11], kxr[3];
#pragma unroll
    for (int it = 0; it < 11; ++it) mur[it] = (it * 256 + j4 < RWKV_COLS) ? *(const f32x4*)(mu + it * 256 + j4) : (f32x4){0.f, 0.f, 0.f, 0.f};
#pragma unroll
    for (int it = 0; it < 3; ++it) kxr[it] = *(const f32x4*)(kxi + it * 256 + j4);
    const int row0 = (int)(((long)C.gw * MROWS) / C.NGW), row1 = (int)(((long)(C.gw + 1) * MROWS) / C.NGW);
    Ef1Row Ra, Rb, Rc, Rd;
    ef1_load(Ra, P, row0 - 1, C.lane); ef1_load(Rb, P, row0, C.lane); ef1_load(Rc, P, row0 + 1, C.lane);
    for (int row = row0; row < row1; ++row) {
        ef1_load(Rd, P, row + 2, C.lane);
        bool hasp, hasn; seq_info(row, hasp, hasn);
        const float fp = hasp ? 1.f : 0.f, fn = hasn ? 1.f : 0.f;
        {
            const f32x4 bg = bf4(Rb.bg), u0 = bf4(Rb.ua) * bf4(Rb.ub), um = bf4(Ra.ua) * bf4(Ra.ub) * fp, up = bf4(Rc.ua) * bf4(Rc.ub) * fn;
            st4bf(A2 + (size_t)row * DM + j4, bg * (w0 * um + w1 * u0 + w2 * up));
        }
#pragma unroll
        for (int it = 0; it < 11; ++it) {
            const int c = it * 256 + j4;
            if (c < RWKV_COLS) {
                const f32x4 x0 = bf4(Rb.m[it]), xm = bf4(Ra.m[it]) * fp, xp = bf4(Rc.m[it]) * fn, m4 = mur[it];
                const f32x4 ps = x0 + m4 * ((xm + xp) * 0.5f - x0);
                if (it < 3) { const int head = c >> 6, kx = c & 63; st4bf_(SCN + (size_t)(row * 12 + head) * SC_REC + SC_R + kx * 2, ps); }
                else if (it < 6) { const int c1 = c - 768, head = c1 >> 6, kx = c1 & 63; const f32x4 kv = ps * kxr[it < 6 ? (it >= 3 ? it - 3 : 0) : 0];
                    const float ss = sum16(kv[0] * kv[0] + kv[1] * kv[1] + kv[2] * kv[2] + kv[3] * kv[3]); const float rn = rsqrtf(ss + 1e-12f);
                    unsigned char* base = SCN + (size_t)(row * 12 + head) * SC_REC + kx * 2;
                    st4bf_(base + SC_KK, kv * rn); st4bf_(base + SC_KR, ps); st4bf_(base + SC_KR + 256, ps); }
                else if (it < 9) { const int c1 = c - 1536, head = c1 >> 6, kx = c1 & 63; st4bf_(SCN + (size_t)(row * 12 + head) * SC_REC + SC_V + kx * 2, ps); }
                else { const int c1 = c - 2304; f32x4 o;
                    if (c1 < 128) { o = (f32x4){tanhf(ps[0]), tanhf(ps[1]), tanhf(ps[2]), tanhf(ps[3])}; }
                    else if (c1 < 256) { o = ps; }
                    else { o = (f32x4){sigmoidf_(ps[0]), sigmoidf_(ps[1]), sigmoidf_(ps[2]), sigmoidf_(ps[3])}; }
                    st4bf(LIN + (size_t)row * LORA_K + c1, o); }
            }
        }
        Ra = Rb; Rb = Rc; Rc = Rd;
    }
}

__device__ __forceinline__ int scan_row(int i, int b, int d) {
    if (d == 0) return i < CTXL ? NLAT + b * CTXL + i : b * TT + (i - CTXL);
    return i < CTXL ? NLAT + b * CTXL + (CTXL - 1 - i) : b * TT + (TT - 1 - (i - CTXL));
}
__device__ __forceinline__ float red8(float v) {
    v += __uint_as_float((unsigned)__builtin_amdgcn_update_dpp(0, (int)__float_as_uint(v), 0xB1, 0xF, 0xF, true));
    v += __uint_as_float((unsigned)__builtin_amdgcn_update_dpp(0, (int)__float_as_uint(v), 0x4E, 0xF, 0xF, true));
    v += __uint_as_float((unsigned)__builtin_amdgcn_update_dpp(0, (int)__float_as_uint(v), 0x141, 0xF, 0xF, true));
    return v;
}
__device__ __forceinline__ float red16(float v) {
    v += __uint_as_float((unsigned)__builtin_amdgcn_update_dpp(0, (int)__float_as_uint(v), 0xB1, 0xF, 0xF, true));
    v += __uint_as_float((unsigned)__builtin_amdgcn_update_dpp(0, (int)__float_as_uint(v), 0x4E, 0xF, 0xF, true));
    v += __uint_as_float((unsigned)__builtin_amdgcn_update_dpp(0, (int)__float_as_uint(v), 0x141, 0xF, 0xF, true));
    v += __uint_as_float((unsigned)__builtin_amdgcn_update_dpp(0, (int)__float_as_uint(v), 0x140, 0xF, 0xF, true));
    return v;
}
__device__ __forceinline__ void phase_scan(const Ctx& C, const Args& A) {
    for (int u = blockIdx.x; u < 192; u += C.G) {
    const int half = u & 1, d = (u >> 1) & 1, h = (u >> 2) % 12, b = u / 48;
    const unsigned char* SCN = A.ws + WS_SCN; float* Y = (float*)(A.ws + WS_Y) + (size_t)d * MROWS * 768;
    LAS float* buf = (LAS float*)C.lds; LAS float* ybuf = buf + 2 * 32 * 352;
    constexpr int NCH = LKEYS / 32;
    u32x4 st[4];
    int ps_[4], psrc[4], pdst[4]; bool pf32[4];
#pragma unroll
    for (int j = 0; j < 4; ++j) { const int p = C.tid + NTHR * j; const int s = p / 52, q = p % 52; ps_[j] = s;
        if (q < 16) { psrc[j] = SC_W + 256 * d + q * 16; pdst[j] = s * 352 + q * 4; pf32[j] = true; }
        else if (q < 48) { const int vec = (q - 16) >> 3, part = (q - 16) & 7; const int so = vec == 0 ? SC_KK : vec == 1 ? SC_B + 256 * d : vec == 2 ? SC_KR + 256 * d : SC_R;
            psrc[j] = so + part * 16; pdst[j] = s * 352 + 64 * (vec + 1) + part * 8; pf32[j] = false; }
        else { const int part = q - 48; psrc[j] = SC_V + half * 64 + part * 16; pdst[j] = s * 352 + 320 + part * 8; pf32[j] = false; } }
    const int sgn = d ? -1 : 1;
    const unsigned char* SCNh = SCN + (size_t)h * SC_REC;
#define SCAN_ROW0(c) (((c) * 32 < CTXL) ? (NLAT + b * CTXL + (d ? CTXL - 1 - (c) * 32 : (c) * 32)) : (b * TT + (d ? TT - 1 - ((c) * 32 - CTXL) : (c) * 32 - CTXL)))
#define SCAN_LOADG(c) do { const int row0_ = SCAN_ROW0(c); _Pragma("unroll") for (int j = 0; j < 4; ++j) if (j < 3 || C.tid < 1664 - 3 * NTHR) { \
        st[j] = *(const u32x4*)(SCNh + (size_t)(row0_ + sgn * ps_[j]) * SC_ROW + psrc[j]); } } while (0)
#define SCAN_STORE(bi) do { _Pragma("unroll") for (int j = 0; j < 4; ++j) if (j < 3 || C.tid < 1664 - 3 * NTHR) { LAS float* dp = buf + (bi) * (32 * 352) + pdst[j]; \
        if (pf32[j]) *(LAS u32x4*)dp = st[j]; \
        else { *(LAS f32x4*)dp = (f32x4){bflo(st[j].x), bfhi(st[j].x), bflo(st[j].y), bfhi(st[j].y)}; *(LAS f32x4*)(dp + 4) = (f32x4){bflo(st[j].z), bfhi(st[j].z), bflo(st[j].w), bfhi(st[j].w)}; } } } while (0)
    SCAN_LOADG(0); SCAN_STORE(0); __syncthreads();
    f32x2 Sa = {0.f, 0.f}, Sb = {0.f, 0.f};
    const int rl = C.lane >> 4, ks = C.lane & 15;
    float ycol = 0.f;
#define SC_LD(R, s) do { const LAS float* bp_ = cur + (s) * 352 + ks * 4; \
        R##w = *(const LAS f32x4*)(bp_); R##k = *(const LAS f32x4*)(bp_ + 64); R##b = *(const LAS f32x4*)(bp_ + 128); R##q = *(const LAS f32x4*)(bp_ + 192); R##r = *(const LAS f32x4*)(bp_ + 256); \
        R##vv = cur[(s) * 352 + 320 + C.wave * 4 + rl]; } while (0)
#define SC_LO(v) ((f32x2){v[0], v[1]})
#define SC_HI(v) ((f32x2){v[2], v[3]})
#define SC_DPP(x, ctrl) __uint_as_float((unsigned)__builtin_amdgcn_update_dpp(0, (int)__float_as_uint(x), ctrl, 0xF, 0xF, true))
#define SC_STEP(R, P, s) do { \
        f32x2 pa = __builtin_elementwise_fma(Sb, SC_HI(R##k), Sa * SC_LO(R##k)), py = __builtin_elementwise_fma(Sb, SC_HI(P##r), Sa * SC_LO(P##r)); \
        float a_ = pa.x + pa.y, y_ = py.x + py.y; \
        a_ += SC_DPP(a_, 0xB1); y_ += SC_DPP(y_, 0xB1); a_ += SC_DPP(a_, 0x4E); y_ += SC_DPP(y_, 0x4E); \
        a_ += SC_DPP(a_, 0x141); y_ += SC_DPP(y_, 0x141); a_ += SC_DPP(a_, 0x140); y_ += SC_DPP(y_, 0x140); \
        ycol = (ks == ((s) & 15)) ? y_ : ycol; \
        const f32x2 na = {-a_, -a_}, vv2 = {R##vv, R##vv}; \
        Sa = __builtin_elementwise_fma(Sa, SC_LO(R##w), __builtin_elementwise_fma(na, SC_LO(R##b), vv2 * SC_LO(R##q))); \
        Sb = __builtin_elementwise_fma(Sb, SC_HI(R##w), __builtin_elementwise_fma(na, SC_HI(R##b), vv2 * SC_HI(R##q))); } while (0)
    f32x4 Aw, Ak, Ab, Aq, Ar, Bw, Bk, Bb, Bq, Br, Cw, Ck, Cb, Cq, Cr, Dw, Dk, Db, Dq, Dr; float Avv, Bvv, Cvv, Dvv;
    Dr = (f32x4){0.f, 0.f, 0.f, 0.f};
    for (int c = 0; c < NCH; ++c) {
        if (c + 1 < NCH) SCAN_LOADG(c + 1);
        {
            const LAS float* cur = buf + (c & 1) * (32 * 352);
            LAS float* yb = ybuf + (c & 1) * 1024 + C.wave * 4 + rl + ks * 32;
            SC_LD(A, 0); SC_LD(B, 1);
#pragma unroll 1
            for (int s = 0; s < 32; s += 4) {
                SC_LD(C, s + 2); __builtin_amdgcn_sched_barrier(0); SC_STEP(A, D, s); __builtin_amdgcn_sched_barrier(0);
                SC_LD(D, s + 3); __builtin_amdgcn_sched_barrier(0); SC_STEP(B, A, s + 1); __builtin_amdgcn_sched_barrier(0);
                SC_LD(A, s + 4); __builtin_amdgcn_sched_barrier(0); SC_STEP(C, B, s + 2); __builtin_amdgcn_sched_barrier(0);
                SC_LD(B, s + 5); __builtin_amdgcn_sched_barrier(0); SC_STEP(D, C, s + 3); __builtin_amdgcn_sched_barrier(0);
                if ((s & 15) == 12) yb[(s & 16) * 32] = ycol;
            }
        }
        if (c + 1 < NCH) SCAN_STORE((c + 1) & 1);
        __syncthreads();
        { const int row0_ = SCAN_ROW0(c);
#pragma unroll
          for (int i = 0; i < 2; ++i) { const int e = C.tid + NTHR * i, s = e >> 5, r = e & 31;
            const int row = (s > 0) ? row0_ + sgn * (s - 1) : scan_row(c * 32 - 1, b, d);
            if (s > 0 || c > 0) Y[(size_t)row * 768 + h * 64 + half * 32 + r] = ybuf[(c & 1) * 1024 + e]; } }
    }
    {
        f32x2 py = __builtin_elementwise_fma(Sb, SC_HI(Dr), Sa * SC_LO(Dr)); float y_ = py.x + py.y;
        y_ += SC_DPP(y_, 0xB1); y_ += SC_DPP(y_, 0x4E); y_ += SC_DPP(y_, 0x141); y_ += SC_DPP(y_, 0x140);
        if (ks == 0) Y[(size_t)scan_row(LKEYS - 1, b, d) * 768 + h * 64 + half * 32 + C.wave * 4 + rl] = y_;
    }
    __syncthreads();
    }
#undef SCAN_LOADG
#undef SCAN_STORE
#undef SCAN_ROW0
#undef SC_LD
#undef SC_STEP
#undef SC_LO
#undef SC_HI
#undef SC_DPP
}

constexpr int CSP = 72;
constexpr int CS_MAT = 64 * CSP * 2;
constexpr int CS_WT = 0, CS_KB = CS_MAT, CS_BB = 2 * CS_MAT, CS_RT = 3 * CS_MAT, CS_BHT = 4 * CS_MAT, CS_KHT = 5 * CS_MAT, CS_VMT = 6 * CS_MAT;
constexpr int CS_M2F = 7 * CS_MAT;
constexpr int CS_M1T = CS_M2F + 16384;
constexpr int CS_N2 = CS_M1T + CS_MAT;
constexpr int CS_GT = CS_N2 + CS_MAT;
constexpr int CS_Z = CS_M2F, CS_U = CS_M2F + CS_MAT;
constexpr int CS_GL = CS_GT + 2 * CS_MAT;
static_assert(CS_GL + 256 <= LDS_MISC, "chunked-scan LDS map");
template <bool SWZB = false>
__device__ __forceinline__ void cs_mma(f32x16& acc, const LAS unsigned char* Am, const LAS unsigned char* Bm, int ti, int tj, int r32, int hi) {
    const LAS unsigned char* ap = Am + (ti * 32 + r32) * (CSP * 2) + hi * 16; const int brow = tj * 32 + r32; const LAS unsigned char* bp = Bm + brow * (CSP * 2);
    const int sw = SWZB ? ((brow >> 3) & 7) : 0;
#pragma unroll
    for (int ks = 0; ks < 4; ++ks) acc = __builtin_amdgcn_mfma_f32_32x32x16_bf16(*(const LAS bf16x8*)(ap + ks * 32), *(const LAS bf16x8*)(bp + (((ks * 2 + hi) ^ sw) * 16)), acc, 0, 0, 0);
}
__device__ __forceinline__ void cs_store_t(LAS unsigned char* Om, const f32x16& acc, int ti, int tj, int r32, int hi) {
    LAS unsigned char* op = Om + (tj * 32 + r32) * (CSP * 2) + (ti * 32 + 4 * hi) * 2;
#pragma unroll
    for (int g = 0; g < 4; ++g) { u32x2 o; o.x = pk2(acc[4 * g], acc[4 * g + 1]); o.y = pk2(acc[4 * g + 2], acc[4 * g + 3]); *(LAS u32x2*)(op + g * 16) = o; }
}
#define CS_BAR() asm volatile("s_waitcnt lgkmcnt(0)\n\ts_barrier" ::: "memory")
__device__ __forceinline__ void phase_csa(const Ctx& C, const Args& A) {
    const unsigned char* SCN = A.ws + WS_SCN; unsigned char* CHK = A.ws + WS_CHK;
    LAS unsigned char* L = C.lds;
    const int r32 = C.lane & 31, hi = C.lane >> 5;
    float lwv[8]; u32x4 ukk, ub, ukr, ur, uv;
#define CSA_GEOM(cu_) const int unit = (cu_) / CS_NCH, ch = (cu_) % CS_NCH; const int d = unit & 1, h = (unit >> 1) % 12, b = unit / 24; \
        const int step0 = ch * CS_L; const int sgn = d ? -1 : 1; \
        const int row0 = (step0 < CTXL) ? (NLAT + b * CTXL + (d ? CTXL - 1 - step0 : step0)) : (b * TT + (d ? TT - 1 - (step0 - CTXL) : step0 - CTXL)); \
        const unsigned char* rec0 = SCN + (size_t)row0 * SC_ROW + (size_t)h * SC_REC;
#define CSA_LOAD(cu_) do { CSA_GEOM(cu_); \
        { const int k = C.tid & 63, sg = C.tid >> 6; _Pragma("unroll") for (int j = 0; j < 8; ++j) lwv[j] = *(const float*)(rec0 + (long)sgn * (8 * sg + j) * SC_ROW + SC_W + 256 * d + k * 4); } \
        { const int t = C.tid >> 3, k0 = (C.tid & 7) * 8; const unsigned char* rp = rec0 + (long)sgn * t * SC_ROW; \
          ukk = *(const u32x4*)(rp + SC_KK + k0 * 2); ub = *(const u32x4*)(rp + SC_B + 256 * d + k0 * 2); ukr = *(const u32x4*)(rp + SC_KR + 256 * d + k0 * 2); ur = *(const u32x4*)(rp + SC_R + k0 * 2); uv = *(const u32x4*)(rp + SC_V + k0 * 2); } } while (0)
    if ((int)blockIdx.x < CS_UNITS * CS_NCH) CSA_LOAD((int)blockIdx.x);
    for (int cu = blockIdx.x; cu < CS_UNITS * CS_NCH; cu += C.G) {
        LAS float* csf = (LAS float*)(L + CS_M2F);
        LAS float* seg = (LAS float*)(L + CS_N2);
        { const int k = C.tid & 63, sg = C.tid >> 6;
#pragma unroll
          for (int j = 1; j < 8; ++j) lwv[j] += lwv[j - 1];
          seg[sg * 64 + k] = lwv[7];
          CS_BAR();
          float off = 0.f, tot = 0.f;
#pragma unroll
          for (int s2 = 0; s2 < 8; ++s2) { const float v = seg[s2 * 64 + k]; off += (s2 < sg) ? v : 0.f; tot += v; }
#pragma unroll
          for (int j = 0; j < 8; ++j) csf[(8 * sg + j) * 65 + k] = lwv[j] + off;
          if (sg == 7) ((LAS float*)(L + CS_GL))[k] = __expf(tot); }
        CS_BAR();
        { const int t = C.tid >> 3, k0 = (C.tid & 7) * 8;
          float wt[8], kb[8], bb[8], rt[8], bh[8], kh[8];
#pragma unroll
          for (int j = 0; j < 8; ++j) { const unsigned pkk = j < 2 ? ukk.x : j < 4 ? ukk.y : j < 6 ? ukk.z : ukk.w, pb = j < 2 ? ub.x : j < 4 ? ub.y : j < 6 ? ub.z : ub.w, pkr = j < 2 ? ukr.x : j < 4 ? ukr.y : j < 6 ? ukr.z : ukr.w, pr = j < 2 ? ur.x : j < 4 ? ur.y : j < 6 ? ur.z : ur.w;
              const float kkv = (j & 1) ? bfhi(pkk) : bflo(pkk), bv = (j & 1) ? bfhi(pb) : bflo(pb), krv = (j & 1) ? bfhi(pkr) : bflo(pkr), rv = (j & 1) ? bfhi(pr) : bflo(pr);
              const float cst = csf[t * 65 + k0 + j], csp = t > 0 ? csf[(t - 1) * 65 + k0 + j] : 0.f, csl = csf[63 * 65 + k0 + j];
              const float einv = __expf(-cst), el = __expf(csl - cst);
              wt[j] = kkv * __expf(csp); kb[j] = krv * einv; bb[j] = bv * einv; rt[j] = rv * __expf(cst); bh[j] = bv * el; kh[j] = krv * el; }
          u32x4 o;
          o.x = pk2(wt[0], wt[1]); o.y = pk2(wt[2], wt[3]); o.z = pk2(wt[4], wt[5]); o.w = pk2(wt[6], wt[7]); *(LAS u32x4*)(L + CS_WT + t * (CSP * 2) + k0 * 2) = o;
          o.x = pk2(kb[0], kb[1]); o.y = pk2(kb[2], kb[3]); o.z = pk2(kb[4], kb[5]); o.w = pk2(kb[6], kb[7]); *(LAS u32x4*)(L + CS_KB + t * (CSP * 2) + k0 * 2) = o;
          o.x = pk2(bb[0], bb[1]); o.y = pk2(bb[2], bb[3]); o.z = pk2(bb[4], bb[5]); o.w = pk2(bb[6], bb[7]); *(LAS u32x4*)(L + CS_BB + t * (CSP * 2) + k0 * 2) = o;
          o.x = pk2(rt[0], rt[1]); o.y = pk2(rt[2], rt[3]); o.z = pk2(rt[4], rt[5]); o.w = pk2(rt[6], rt[7]); *(LAS u32x4*)(L + CS_RT + t * (CSP * 2) + k0 * 2) = o;
#pragma unroll
          for (int j = 0; j < 8; ++j) { const int to = ((((t >> 3) ^ ((k0 >> 3) & 7)) * 8) + (t & 7)) * 2;
              *(LAS bf16_t*)(L + CS_BHT + (k0 + j) * (CSP * 2) + to) = (bf16_t)f2bf(bh[j]); *(LAS bf16_t*)(L + CS_KHT + (k0 + j) * (CSP * 2) + to) = (bf16_t)f2bf(kh[j]);
              const unsigned pv = j < 2 ? uv.x : j < 4 ? uv.y : j < 6 ? uv.z : uv.w; *(LAS bf16_t*)(L + CS_VMT + (k0 + j) * (CSP * 2) + to) = (bf16_t)((j & 1) ? (pv >> 16) : (pv & 0xffffu)); } }
        if (cu + C.G < CS_UNITS * CS_NCH) CSA_LOAD(cu + C.G);
        CS_BAR();
        for (int job = C.wave; job < 12; job += NWAVES) { const int p = job >> 2, ti = (job >> 1) & 1, tj = job & 1;
            f32x16 acc;
#pragma unroll
            for (int i = 0; i < 16; ++i) acc[i] = 0.f;
            if (p == 0) { cs_mma(acc, L + CS_WT, L + CS_BB, ti, tj, r32, hi);
                const int i = tj * 32 + r32; LAS float* mp = (LAS float*)(L + CS_M2F) + i * 64;
#pragma unroll
                for (int reg = 0; reg < 16; ++reg) { const int t = ti * 32 + crow(reg, hi); mp[(t & 3) * 16 + (t >> 2)] = (i < t) ? acc[reg] : 0.f; } }
            else if (p == 1) { cs_mma(acc, L + CS_WT, L + CS_KB, ti, tj, r32, hi);
                const int i = tj * 32 + r32;
#pragma unroll
                for (int reg = 0; reg < 16; ++reg) { const int t = ti * 32 + crow(reg, hi); acc[reg] = (i < t) ? acc[reg] : 0.f; }
                cs_store_t(L + CS_M1T, acc, ti, tj, r32, hi); }
            else { cs_mma(acc, L + CS_BB, L + CS_RT, ti, tj, r32, hi);
                const int t = tj * 32 + r32;
#pragma unroll
                for (int reg = 0; reg < 16; ++reg) { const int i = ti * 32 + crow(reg, hi); acc[reg] = (i <= t) ? acc[reg] : 0.f; }
                cs_store_t(L + CS_N2, acc, ti, tj, r32, hi); } }
        CS_BAR();
        { const int c = C.tid >> 2, q = C.tid & 3; f32x2 acc2[8];
          { const LAS unsigned char* rcol = (c < 64) ? (L + CS_WT + c * 2) : (L + CS_M1T + (c - 64) * (CSP * 2)); const int rstride = (c < 64) ? CSP * 2 : 2;
#pragma unroll
            for (int j = 0; j < 16; ++j) acc2[j >> 1][j & 1] = bf2f(*(const LAS bf16_t*)(rcol + (4 * j + q) * rstride)); }
          const LAS float* m2c = (const LAS float*)(L + CS_M2F) + q * 16;
#pragma clang loop unroll(full)
          for (int i = 0; i < 64; ++i) {
              const float mine = -acc2[i >> 3][(i >> 2) & 1];
              float gi;
              switch (i & 3) { case 0: gi = __uint_as_float((unsigned)__builtin_amdgcn_update_dpp(0, (int)__float_as_uint(mine), 0x00, 0xF, 0xF, true)); break;
                               case 1: gi = __uint_as_float((unsigned)__builtin_amdgcn_update_dpp(0, (int)__float_as_uint(mine), 0x55, 0xF, 0xF, true)); break;
                               case 2: gi = __uint_as_float((unsigned)__builtin_amdgcn_update_dpp(0, (int)__float_as_uint(mine), 0xAA, 0xF, 0xF, true)); break;
                               default: gi = __uint_as_float((unsigned)__builtin_amdgcn_update_dpp(0, (int)__float_as_uint(mine), 0xFF, 0xF, 0xF, true)); break; }
              const f32x2 g2 = {gi, gi};
#pragma unroll
              for (int j4 = (i >> 4); j4 < 4; ++j4) { const f32x4 m = *(const LAS f32x4*)(m2c + i * 64 + j4 * 4);
#pragma unroll
                  for (int h = 0; h < 2; ++h) { const int p = 2 * j4 + h;
                      if (2 * p >= (i >> 2)) acc2[p] += (f32x2){m[2 * h], m[2 * h + 1]} * g2;
                      else if (2 * p + 1 >= (i >> 2)) acc2[p][1] += m[2 * h + 1] * gi; } }
          }
#pragma unroll
          for (int j = 0; j < 16; ++j) *(LAS bf16_t*)(L + CS_GT + c * (CSP * 2) + (4 * j + q) * 2) = (bf16_t)f2bf(-acc2[j >> 1][j & 1]); }
        CS_BAR();
        unsigned char* outp = CHK + (size_t)cu * 32768;
        for (int job = C.wave; job < 16; job += NWAVES) { const int p = job >> 2, ti = (job >> 1) & 1, tj = job & 1;
            f32x16 acc;
            if (p == 0) {
                const LAS unsigned char* rp = L + CS_RT + (tj * 32 + r32) * (CSP * 2) + (ti * 32 + 4 * hi) * 2;
#pragma unroll
                for (int g = 0; g < 4; ++g) { const u32x2 u = *(const LAS u32x2*)(rp + g * 16); acc[4 * g] = bflo(u.x); acc[4 * g + 1] = bfhi(u.x); acc[4 * g + 2] = bflo(u.y); acc[4 * g + 3] = bfhi(u.y); }
                cs_mma(acc, L + CS_GT, L + CS_N2, ti, tj, r32, hi);
#pragma unroll
                for (int g = 0; g < 4; ++g) { u32x2 o; o.x = pk2(acc[4 * g], acc[4 * g + 1]); o.y = pk2(acc[4 * g + 2], acc[4 * g + 3]);
                    *(u32x2*)(outp + 8192 + (((tj * 4 + 2 * ti + (g >> 1)) * 64 + (g & 1) * 32 + r32) * 16) + hi * 8) = o; } }
            else if (p == 1) {
#pragma unroll
                for (int i = 0; i < 16; ++i) acc[i] = 0.f;
                cs_mma(acc, L + CS_KB, L + CS_RT, ti, tj, r32, hi);
                const int t = tj * 32 + r32;
#pragma unroll
                for (int reg = 0; reg < 16; ++reg) { const int i = ti * 32 + crow(reg, hi); acc[reg] = (i <= t) ? acc[reg] : 0.f; }
                cs_mma(acc, L + CS_GT + 64 * (CSP * 2), L + CS_N2, ti, tj, r32, hi);
                cs_store_t(L + CS_Z, acc, ti, tj, r32, hi); }
            else if (p == 2) {
#pragma unroll
                for (int i = 0; i < 16; ++i) acc[i] = 0.f;
                cs_mma<true>(acc, L + CS_GT, L + CS_BHT, ti, tj, r32, hi);
                const int k = tj * 32 + r32; const float gl = ((const LAS float*)(L + CS_GL))[k];
#pragma unroll
                for (int reg = 0; reg < 16; ++reg) { const int cc = ti * 32 + crow(reg, hi); acc[reg] += (cc == k) ? gl : 0.f; }
#pragma unroll
                for (int g = 0; g < 4; ++g) { u32x2 o; o.x = pk2(acc[4 * g], acc[4 * g + 1]); o.y = pk2(acc[4 * g + 2], acc[4 * g + 3]);
                    *(u32x2*)(outp + (((tj * 4 + 2 * ti + (g >> 1)) * 64 + (g & 1) * 32 + r32) * 16) + hi * 8) = o; } }
            else {
                const int krow = tj * 32 + r32; const LAS unsigned char* kp = L + CS_KHT + krow * (CSP * 2) + hi * 8;
#pragma unroll
                for (int g = 0; g < 4; ++g) { const u32x2 u = *(const LAS u32x2*)(kp + (((ti * 4 + g) ^ ((krow >> 3) & 7)) * 16)); acc[4 * g] = bflo(u.x); acc[4 * g + 1] = bfhi(u.x); acc[4 * g + 2] = bflo(u.y); acc[4 * g + 3] = bfhi(u.y); }
                cs_mma<true>(acc, L + CS_GT + 64 * (CSP * 2), L + CS_BHT, ti, tj, r32, hi);
                cs_store_t(L + CS_U, acc, ti, tj, r32, hi); } }
        CS_BAR();
        { const int p = C.wave >> 2, ti = (C.wave >> 1) & 1, tj = C.wave & 1;
          f32x16 acc;
#pragma unroll
          for (int i = 0; i < 16; ++i) acc[i] = 0.f;
          cs_mma<true>(acc, L + (p ? CS_U : CS_Z), L + CS_VMT, ti, tj, r32, hi);
          unsigned char* op = outp + (p ? 16384 : 24576) + ((ti * 2 + tj) * 64 + C.lane) * 32;
          u32x4 o0, o1; o0.x = pk2(acc[0], acc[1]); o0.y = pk2(acc[2], acc[3]); o0.z = pk2(acc[4], acc[5]); o0.w = pk2(acc[6], acc[7]);
          o1.x = pk2(acc[8], acc[9]); o1.y = pk2(acc[10], acc[11]); o1.z = pk2(acc[12], acc[13]); o1.w = pk2(acc[14], acc[15]);
          *(u32x4*)op = o0; *(u32x4*)(op + 16) = o1; }
        CS_BAR();
    }
}
__device__ __forceinline__ void phase_csb(const Ctx& C, const Args& A, int l) {
    if ((int)blockIdx.x >= CS_UNITS) { conv_items(C, A, l + 1, ((int)blockIdx.x - CS_UNITS) * NWAVES + C.wave, (C.G - CS_UNITS) * NWAVES, true, false, true); return; }
    const unsigned char* CHK = A.ws + WS_CHK;
    LAS unsigned char* L = C.lds;
    const int r32 = C.lane & 31, hi = C.lane >> 5;
    const bool isS = C.wave < 4; const int ti = (C.wave >> 1) & 1, tj = C.wave & 1;
    for (int unit = blockIdx.x; unit < CS_UNITS; unit += C.G) {
        const int d = unit & 1, h = (unit >> 1) % 12, b = unit / 24;
        float* Y = (float*)(A.ws + WS_Y) + (size_t)d * MROWS * 768;
        for (int i = C.tid; i < 2 * CS_MAT / 4; i += NTHR) ((LAS unsigned*)L)[i] = 0u;
        CS_BAR();
        bf16x8 afA[4], afB[4], afC[4]; u32x4 cA0, cA1, cB0, cB1, cC0, cC1;
#define CSB_LOAD(A4, C0, C1, ch_) do { const unsigned char* op_ = CHK + ((size_t)unit * CS_NCH + (ch_)) * 32768; \
            const unsigned char* am_ = op_ + (isS ? 0 : 8192) + (ti * 4 * 64 + C.lane) * 16;     \
            _Pragma("unroll") for (int ks = 0; ks < 4; ++ks) A4[ks] = *(const bf16x8*)(am_ + ks * 1024); \
            const unsigned char* cp_ = op_ + (isS ? 16384 : 24576) + ((ti * 2 + tj) * 64 + C.lane) * 32; C0 = *(const u32x4*)cp_; C1 = *(const u32x4*)(cp_ + 16); } while (0)
#define CSB_STEP(A4, C0, C1, ch_) do { \
            const LAS unsigned char* Sb = L + ((ch_) & 1) * CS_MAT; LAS unsigned char* Sn = L + (((ch_) + 1) & 1) * CS_MAT; \
            f32x16 acc; \
            acc[0] = bflo(C0.x); acc[1] = bfhi(C0.x); acc[2] = bflo(C0.y); acc[3] = bfhi(C0.y); acc[4] = bflo(C0.z); acc[5] = bfhi(C0.z); acc[6] = bflo(C0.w); acc[7] = bfhi(C0.w); \
            acc[8] = bflo(C1.x); acc[9] = bfhi(C1.x); acc[10] = bflo(C1.y); acc[11] = bfhi(C1.y); acc[12] = bflo(C1.z); acc[13] = bfhi(C1.z); acc[14] = bflo(C1.w); acc[15] = bfhi(C1.w); \
            const LAS unsigned char* bp = Sb + (tj * 32 + r32) * (CSP * 2) + hi * 16; \
            _Pragma("unroll") for (int ks = 0; ks < 4; ++ks) acc = __builtin_amdgcn_mfma_f32_32x32x16_bf16(A4[ks], *(const LAS bf16x8*)(bp + ks * 32), acc, 0, 0, 0); \
            if (isS) { cs_store_t(Sn, acc, ti, tj, r32, hi); }     \
            else {     \
                const int step0 = (ch_) * CS_L; const int sgn = d ? -1 : 1; \
                const int row0 = (step0 < CTXL) ? (NLAT + b * CTXL + (d ? CTXL - 1 - step0 : step0)) : (b * TT + (d ? TT - 1 - (step0 - CTXL) : step0 - CTXL)); \
                float* yp = Y + (size_t)(row0 + sgn * (ti * 32 + 4 * hi)) * 768 + h * 64 + tj * 32 + r32; const long ys = (long)sgn * 768; \
                _Pragma("unroll") for (int reg = 0; reg < 16; ++reg) yp[ys * ((reg & 3) + 8 * (reg >> 2))] = acc[reg]; } \
            CS_BAR(); } while (0)
        CSB_LOAD(afA, cA0, cA1, 0); CSB_LOAD(afB, cB0, cB1, 1);
        static_assert(CS_NCH % 3 == 0, "chunk loop is unrolled by three");
        for (int ch = 0; ch < CS_NCH; ch += 3) {
            if (ch == 0) CSB_LOAD(afC, cC0, cC1, 2);
            CSB_STEP(afA, cA0, cA1, ch);     if (ch + 3 < CS_NCH) CSB_LOAD(afA, cA0, cA1, ch + 3);
            CSB_STEP(afB, cB0, cB1, ch + 1); if (ch + 4 < CS_NCH) CSB_LOAD(afB, cB0, cB1, ch + 4);
            CSB_STEP(afC, cC0, cC1, ch + 2); if (ch + 5 < CS_NCH) CSB_LOAD(afC, cC0, cC1, ch + 5);
        }
        CS_BAR();
    }
#undef CSB_LOAD
#undef CSB_STEP
}

#undef CS_BAR
struct Ef2Row { f32x4 y0[3], y1[3]; u32x2 r[3], v[3], k0[3], k1[3], g[3]; };
__device__ __forceinline__ void ef2_load(Ef2Row& R, const float* Y0, const float* Y1, const unsigned char* SCN, const bf16_t* G, int row, int lane) {
#pragma unroll
    for (int it = 0; it < 3; ++it) { const int c = it * 256 + 4 * lane, head = c >> 6, kx = c & 63;
        R.y0[it] = *(const f32x4*)(Y0 + (size_t)row * 768 + c); R.y1[it] = *(const f32x4*)(Y1 + (size_t)row * 768 + c);
        const unsigned char* base = SCN + (size_t)(row * 12 + head) * SC_REC + kx * 2;
        R.r[it] = *(const u32x2*)(base + SC_R); R.v[it] = *(const u32x2*)(base + SC_V); R.k0[it] = *(const u32x2*)(base + SC_KR); R.k1[it] = *(const u32x2*)(base + SC_KR + 256);
        R.g[it] = *(const u32x2*)(G + (size_t)row * 768 + c); }
}
__device__ __forceinline__ void phase_ef2(const Ctx& C, const Args& A, int l) {
    const int i2 = l >> 1; unsigned char* ws = A.ws;
    const unsigned char* SCN = ws + WS_SCN; const float* Y0 = (const float*)(ws + WS_Y); const float* Y1 = Y0 + (size_t)MROWS * 768;
    const bf16_t* G = (const bf16_t*)(ws + WS_G); bf16_t* A2 = (bf16_t*)(ws + WS_A2);
    const float* rb = A.in[I_RBON] + (size_t)i2 * 768; const float* gg = A.in[I_GNG] + (size_t)i2 * 768; const float* gb = A.in[I_GNB] + (size_t)i2 * 768;
    f32x4 rbr[3], ggr[3], gbr[3];
#pragma unroll
    for (int it = 0; it < 3; ++it) { const int c = it * 256 + 4 * C.lane; rbr[it] = *(const f32x4*)(rb + c); ggr[it] = *(const f32x4*)(gg + c); gbr[it] = *(const f32x4*)(gb + c); }
    Ef2Row Rn;
    if (C.gw < MROWS) ef2_load(Rn, Y0, Y1, SCN, G, C.gw, C.lane);
    for (int row = C.gw; row < MROWS; row += C.NGW) {
        const Ef2Row R = Rn;
        { const int nr = row + C.NGW < MROWS ? row + C.NGW : row; ef2_load(Rn, Y0, Y1, SCN, G, nr, C.lane); }
#pragma unroll
        for (int it = 0; it < 3; ++it) {
            const int c = it * 256 + 4 * C.lane;
            const f32x4 y = R.y0[it] + R.y1[it];
            const float mean = sum16((y[0] + y[1]) + (y[2] + y[3])) * (1.f / 64.f);
            const f32x4 dd = y - mean;
            const float var = sum16((dd[0] * dd[0] + dd[1] * dd[1]) + (dd[2] * dd[2] + dd[3] * dd[3])) * (1.f / 64.f);
            const float rstd = rsqrtf(var + GN_EPS);
            const f32x4 r = bf4(R.r[it]), v = bf4(R.v[it]), k0 = bf4(R.k0[it]), k1 = bf4(R.k1[it]);
            const f32x4 t = r * (k0 + k1) * 0.5f * rbr[it];
            const float bs = sum16((t[0] + t[1]) + (t[2] + t[3]));
            const f32x4 yn = dd * rstd * ggr[it] + gbr[it];
            const f32x4 g = bf4(R.g[it]);
            st4bf(A2 + (size_t)row * DM + 256 + c, g * (yn + v * bs));
        }
    }
}

__device__ __forceinline__ void phase_of1(const Ctx& C, const Args& A, int l) {
    const int i2 = l >> 1; unsigned char* ws = A.ws;
    const bf16_t* P = (const bf16_t*)(ws + WS_P); bf16_t* A2 = (bf16_t*)(ws + WS_A2); bf16_t* VT = (bf16_t*)(ws + WS_VT);
    const float* lng = A.in[I_GLNG] + (size_t)i2 * 256; const float* lnb = A.in[I_GLNB] + (size_t)i2 * 256;
    const float* gws = A.in[I_GWS] + (size_t)i2 * 4 * 128 * 128; const float* gbs = A.in[I_GBS] + (size_t)i2 * 4 * 128;
    LAS bf16_t* vt = (LAS bf16_t*)C.lds;
    LAS bf16_t* uL = (LAS bf16_t*)C.lds;
    LAS bf16_t* vT = (LAS bf16_t*)(C.lds + 128 * 528);
    const int r32 = C.lane & 31, hi = C.lane >> 5;
    for (int it = blockIdx.x; it < 256 + 8 * 7; it += C.G) {
        const bool isctx = it >= 256; const int uc = isctx ? (it - 256) / 7 : 0, pc = isctx ? (it - 256) % 7 : 0; const int u = it;
        const int b = isctx ? (uc >> 1) : (u >> 6), pos0 = isctx ? (uc & 1) * 128 : (u & 63) * 128;
        const int row0 = isctx ? NLAT + b * CTXL + pos0 : b * TT + pos0, L0 = isctx ? pos0 : CTXL + pos0;
        const int hh0 = isctx ? pc : 0, hh1 = isctx ? (pc < 6 ? pc + 1 : 0) : 6; const bool doC = !isctx || pc == 6;
        u32x4 pv[4];
        if (hh0 < hh1) {
#pragma unroll
            for (int i = 0; i < 4; ++i) { const int piece = C.tid + NTHR * i, r = piece >> 4, part = piece & 15; pv[i] = *(const u32x4*)(P + (size_t)(row0 + r) * P_LD + 1536 + hh0 * 128 + part * 8); } }
        for (int hh = hh0; hh < hh1; ++hh) {
#pragma unroll
            for (int i = 0; i < 4; ++i) { const int piece = C.tid + NTHR * i, r = piece >> 4, part = piece & 15;
                *(LAS u32x4*)(vt + r * 136 + part * 8) = pv[i]; }
            __syncthreads();
            if (hh + 1 < hh1) {
#pragma unroll
                for (int i = 0; i < 4; ++i) { const int piece = C.tid + NTHR * i, r = piece >> 4, part = piece & 15; pv[i] = *(const u32x4*)(P + (size_t)(row0 + r) * P_LD + 1536 + (hh + 1) * 128 + part * 8); } }
#pragma unroll
            for (int i = 0; i < 4; ++i) { const int item = C.tid + NTHR * i, d = item >> 4, tg = item & 15; const LAS bf16_t* s = vt + (tg * 8) * 136 + d;
                u32x4 o; o.x = (unsigned)s[0] | ((unsigned)s[136] << 16); o.y = (unsigned)s[2 * 136] | ((unsigned)s[3 * 136] << 16);
                o.z = (unsigned)s[4 * 136] | ((unsigned)s[5 * 136] << 16); o.w = (unsigned)s[6 * 136] | ((unsigned)s[7 * 136] << 16);
                *(u32x4*)(VT + ((size_t)(b * 6 + hh) * 128 + d) * LKEYS + L0 + tg * 8) = o; }
            __syncthreads();
        }
        if (doC) {
        const f32x4 lngr = *(const f32x4*)(lng + 4 * C.lane), lnbr = *(const f32x4*)(lnb + 4 * C.lane);
        u32x2 nxu, nxr;
        { const bf16_t* pr = P + (size_t)(row0 + C.wave) * P_LD + 2304 + 4 * C.lane; nxu = *(const u32x2*)pr; nxr = *(const u32x2*)(pr + 256); }
        for (int r = C.wave; r < 128; r += NWAVES) {
            const int c4 = 4 * C.lane;
            const f32x4 ur = bf4(nxu), raw = bf4(nxr);
            if (r + NWAVES < 128) { const bf16_t* pr = P + (size_t)(row0 + r + NWAVES) * P_LD + 2304 + c4; nxu = *(const u32x2*)pr; nxr = *(const u32x2*)(pr + 256); }
            { const f32x4 gu = {gelu_erf(ur[0]), gelu_erf(ur[1]), gelu_erf(ur[2]), gelu_erf(ur[3])}; u32x2 o; o.x = pk2(gu[0], gu[1]); o.y = pk2(gu[2], gu[3]); *(LAS u32x2*)(uL + r * 264 + c4) = o; }
            const f32x4 gv = {gelu_erf(raw[0]), gelu_erf(raw[1]), gelu_erf(raw[2]), gelu_erf(raw[3])};
            const float mean = wave_sum((gv[0] + gv[1]) + (gv[2] + gv[3])) * (1.f / 256.f); const f32x4 dd = gv - mean;
            const float var = wave_sum((dd[0] * dd[0] + dd[1] * dd[1]) + (dd[2] * dd[2] + dd[3] * dd[3])) * (1.f / 256.f); const float rstd = rsqrtf(var + LN_EPS);
            const f32x4 o = dd * rstd * lngr + lnbr;
#pragma unroll
            for (int k = 0; k < 4; ++k) vT[(c4 + k) * 136 + r] = (bf16_t)f2bf(o[k]);
        }
        __syncthreads();
        {
            const int g = C.wave >> 1, cblk = C.wave & 1, cc = g * 64 + cblk * 32 + r32;
            for (int pblk = 0; pblk < 4; ++pblk) {
                f32x16 acc;
#pragma unroll
                for (int i = 0; i < 16; ++i) acc[i] = 0.f;
                const float* wrow = gws + ((size_t)g * 128 + pblk * 32 + r32) * 128 + 8 * hi;
#pragma unroll
                for (int ks = 0; ks < 8; ++ks) { const f32x4 w0 = *(const f32x4*)(wrow + ks * 16), w1 = *(const f32x4*)(wrow + ks * 16 + 4);
                    u32x4 au; au.x = pk2(w0[0], w0[1]); au.y = pk2(w0[2], w0[3]); au.z = pk2(w1[0], w1[1]); au.w = pk2(w1[2], w1[3]);
                    const bf16x8 bf = *(const LAS bf16x8*)(vT + cc * 136 + ks * 16 + 8 * hi);
                    acc = __builtin_amdgcn_mfma_f32_32x32x16_bf16(__builtin_bit_cast(bf16x8, au), bf, acc, 0, 0, 0); }
#pragma unroll
                for (int reg = 0; reg < 16; ++reg) { const int p = pblk * 32 + crow(reg, hi);
                    const float uu = bf2f(uL[p * 264 + cc]); const float mixed = acc[reg] + gbs[g * 128 + p];
                    uL[p * 264 + cc] = (bf16_t)f2bf(uu * mixed); }
            }
        }
        __syncthreads();
#pragma unroll
        for (int i = 0; i < 8; ++i) { const int piece = C.tid + NTHR * i, r = piece >> 5, part = piece & 31;
            *(u32x4*)(A2 + (size_t)(row0 + r) * DM + 768 + part * 8) = *(const LAS u32x4*)(uL + r * 264 + part * 8); }
        __syncthreads();
        }
    }
}

__device__ __forceinline__ void phase_attn(const Ctx& C, const Args& A, int l) {
    const int i2 = l >> 1; unsigned char* ws = A.ws;
    const bf16_t* Q = (const bf16_t*)(ws + WS_Q); const bf16_t* KA = (const bf16_t*)(ws + WS_KA); const bf16_t* VT = (const bf16_t*)(ws + WS_VT); bf16_t* A2 = (bf16_t*)(ws + WS_A2);
    const float lam_init = 0.8f - 0.6f * expf(-0.3f * (float)l);
    float s1 = 0.f, s2 = 0.f;
    for (int j = 0; j < 64; ++j) { s1 += A.in[I_LQ1][i2 * 64 + j] * A.in[I_LK1][i2 * 64 + j]; s2 += A.in[I_LQ2][i2 * 64 + j] * A.in[I_LK2][i2 * 64 + j]; }
    const float lam = expf(s1) - expf(s2) + lam_init;
    const float* subg = A.in[I_SUBG] + (size_t)i2 * 128;
    const int r32 = C.lane & 31, hi = C.lane >> 5, map = C.wave >> 2, qw = C.wave & 3;
    LAS unsigned char* Kt = C.lds; LAS unsigned char* Vt = C.lds + 2 * 16384; LAS float* xch = (LAS float*)C.lds;
    const int NU = 1536 + (l == 1 ? 48 : 0);
    for (int n = C.vcu; n < NU; n += C.G) {
        int bh, qt; bool isctx = false;
        if (n < 1536) { const int round = n >> 8, slot = n & 255; bh = (slot >> 5) * 3 + (round >> 1); qt = (round & 1) * 32 + (slot & 31); }
        else { isctx = true; bh = (n - 1536) >> 1; qt = (n - 1536) & 1; }
        const int b = bh / 6, h = bh % 6;
        const int qrow0 = isctx ? NLAT + b * CTXL + qt * 128 : b * TT + qt * 128;
        const int NT = isctx ? CTXL / 64 : LKEYS / 64;
        const bf16_t* Kb = KA + (size_t)b * LKEYS * 768 + h * 128;
        const bf16_t* Vb = VT + (size_t)(b * 6 + h) * 128 * LKEYS;
        bf16x8 qf[4];
        { const bf16_t* qp = Q + (size_t)(qrow0 + qw * 32 + r32) * 768 + h * 128 + map * 64 + 8 * hi;
#pragma unroll
          for (int ks = 0; ks < 4; ++ks) qf[ks] = *(const bf16x8*)(qp + ks * 16); }
        f32x16 O[4];
#pragma unroll
        for (int d = 0; d < 4; ++d)
#pragma unroll
            for (int i = 0; i < 16; ++i) O[d][i] = 0.f;
        float m = 0.f, lsum = 0.f;
        unsigned ksrc[2], vsrc[2];
#pragma unroll
        for (int i = 0; i < 2; ++i) { const int row = 4 * (2 * C.wave + i) + (C.lane >> 4), x = row & 15, pi = x < 4 ? x : x < 8 ? x + 4 : x < 12 ? x - 4 : x;
            ksrc[i] = (unsigned)(((row & ~15) + pi) * 768 + (((C.lane & 15) ^ x) * 8));
            const int d = 8 * (2 * C.wave + i) + (C.lane >> 3); vsrc[i] = (unsigned)(d * LKEYS + (((C.lane & 7) ^ ((d >> 1) & 7)) * 8)); }
#define AT_DMA_K(tt, slot) do { _Pragma("unroll") for (int i = 0; i < 2; ++i) __builtin_amdgcn_global_load_lds((const unsigned*)(Kb + (size_t)(tt) * 64 * 768 + ksrc[i]), (LAS unsigned*)(Kt + (slot) * 16384 + (2 * C.wave + i) * 1024), 16, 0, 0); } while (0)
#define AT_DMA_V(tt, slot) do { _Pragma("unroll") for (int i = 0; i < 2; ++i) __builtin_amdgcn_global_load_lds((const unsigned*)(Vb + (size_t)(tt) * 64 + vsrc[i]), (LAS unsigned*)(Vt + (slot) * 16384 + (2 * C.wave + i) * 1024), 16, 0, 0); } while (0)
#define AT_BAR() asm volatile("s_waitcnt vmcnt(0) lgkmcnt(0)\n\ts_barrier" ::: "memory")
#define AT_SB() __builtin_amdgcn_sched_barrier(0)
        const int ksw = r32 & 15, vsw = (r32 >> 1) & 7;
#define AT_QK(P0, P1, ks_) do { const float nm_ = -m; _Pragma("unroll") for (int i = 0; i < 16; ++i) { P0[i] = nm_; P1[i] = nm_; } \
            const LAS unsigned char* kbp_ = Kt + (ks_) * 16384 + r32 * 256; \
            _Pragma("unroll") for (int ks = 0; ks < 4; ++ks) { const int co_ = ((map * 8 + ks * 2 + hi) ^ ksw) * 16; \
                P0 = __builtin_amdgcn_mfma_f32_32x32x16_bf16(*(const LAS bf16x8*)(kbp_ + co_), qf[ks], P0, 0, 0, 0); P1 = __builtin_amdgcn_mfma_f32_32x32x16_bf16(*(const LAS bf16x8*)(kbp_ + 32 * 256 + co_), qf[ks], P1, 0, 0, 0); } } while (0)
#define AT_LDV(dst, vs_, d) do { _Pragma("unroll") for (int kst = 0; kst < 4; ++kst) dst[kst] = *(const LAS u32x4*)(Vt + (vs_) * 16384 + ((d) * 32 + r32) * 128 + (((kst * 2 + hi) ^ vsw) * 16)); } while (0)
#define AT_PV(src, d) do { _Pragma("unroll") for (int kst = 0; kst < 4; ++kst) O[d] = __builtin_amdgcn_mfma_f32_32x32x16_bf16(__builtin_bit_cast(bf16x8, src[kst]), pb[kst], O[d], 0, 0, 0); } while (0)
#define AT_SOFTPV(P0, P1, N0, N1, first, hasn, vs_) do { \
            asm volatile("s_nop 15\n\ts_nop 7" : "+v"(P0), "+v"(P1)); \
            float mx = max3f(P0[0], P0[1], P1[0]), mx2 = max3f(P0[2], P0[3], P1[1]); mx = max3f(mx, P1[2], P1[3]); \
            _Pragma("unroll") for (int i = 4; i < 16; i += 4) { mx = max3f(mx, P0[i], P0[i + 1]); mx2 = max3f(mx2, P0[i + 2], P0[i + 3]); mx = max3f(mx, P1[i], P1[i + 1]); mx2 = max3f(mx2, P1[i + 2], P1[i + 3]); } \
            mx = fmaxf(mx, mx2); \
            { auto rr = __builtin_amdgcn_permlane32_swap(__float_as_uint(mx), __float_as_uint(mx), false, false); mx = fmaxf(__uint_as_float(rr[0]), __uint_as_float(rr[1])); } \
            if ((first) || __any(mx > 8.f)) { const float dl = (first) ? mx : fmaxf(mx, 0.f); const float sc = __builtin_amdgcn_exp2f(-dl); lsum *= sc; \
                _Pragma("unroll") for (int d = 0; d < 4; ++d) _Pragma("unroll") for (int i = 0; i < 16; ++i) O[d][i] *= sc; \
                _Pragma("unroll") for (int i = 0; i < 16; ++i) { P0[i] -= dl; P1[i] -= dl; } \
                if (hasn) { asm volatile("s_nop 15\n\ts_nop 7" : "+v"(N0), "+v"(N1)); _Pragma("unroll") for (int i = 0; i < 16; ++i) { N0[i] -= dl; N1[i] -= dl; } } \
                m += dl; } \
            float ps = 0.f, ps2 = 0.f; \
            _Pragma("unroll") for (int i = 0; i < 16; ++i) { P0[i] = __builtin_amdgcn_exp2f(P0[i]); P1[i] = __builtin_amdgcn_exp2f(P1[i]); ps += P0[i]; ps2 += P1[i]; } \
            lsum += ps + ps2; \
            bf16x8 pb[4]; \
            { u32x4 w; w.x = pk2(P0[0], P0[1]); w.y = pk2(P0[2], P0[3]); w.z = pk2(P0[4], P0[5]); w.w = pk2(P0[6], P0[7]); pb[0] = __builtin_bit_cast(bf16x8, w); \
              w.x = pk2(P0[8], P0[9]); w.y = pk2(P0[10], P0[11]); w.z = pk2(P0[12], P0[13]); w.w = pk2(P0[14], P0[15]); pb[1] = __builtin_bit_cast(bf16x8, w); \
              w.x = pk2(P1[0], P1[1]); w.y = pk2(P1[2], P1[3]); w.z = pk2(P1[4], P1[5]); w.w = pk2(P1[6], P1[7]); pb[2] = __builtin_bit_cast(bf16x8, w); \
              w.x = pk2(P1[8], P1[9]); w.y = pk2(P1[10], P1[11]); w.z = pk2(P1[12], P1[13]); w.w = pk2(P1[14], P1[15]); pb[3] = __builtin_bit_cast(bf16x8, w); } \
            u32x4 va[4]; \
            AT_LDV(va, vs_, 0); AT_SB(); AT_PV(va, 0); AT_SB(); AT_LDV(va, vs_, 1); AT_SB(); AT_PV(va, 1); AT_SB(); AT_LDV(va, vs_, 2); AT_SB(); AT_PV(va, 2); AT_SB(); AT_LDV(va, vs_, 3); AT_SB(); AT_PV(va, 3); AT_SB(); } while (0)
        f32x16 pA0, pA1, pB0, pB1;
        AT_DMA_K(0, 0); AT_DMA_V(0, 0); AT_DMA_K(1, 1);
        AT_BAR();
        AT_QK(pA0, pA1, 0);
        asm volatile("s_waitcnt lgkmcnt(0)\n\ts_barrier" ::: "memory");
        for (int t = 0; t < NT; t += 2) {
            if (t + 2 < NT) AT_DMA_K(t + 2, 0);
            AT_DMA_V(t + 1, 1);
            AT_SB(); AT_QK(pB0, pB1, 1); AT_SB();
            AT_SOFTPV(pA0, pA1, pB0, pB1, t == 0, true, 0);
            AT_BAR();
            if (t + 3 < NT) AT_DMA_K(t + 3, 1);
            if (t + 2 < NT) AT_DMA_V(t + 2, 0);
            AT_SB(); if (t + 2 < NT) { AT_QK(pA0, pA1, 0); } AT_SB();
            AT_SOFTPV(pB0, pB1, pA0, pA1, false, t + 2 < NT, 1);
            AT_BAR();
        }
#undef AT_DMA_K
#undef AT_DMA_V
#undef AT_BAR
#undef AT_SB
#undef AT_QK
#undef AT_LDV
#undef AT_PV
#undef AT_SOFTPV
        const float ltot = lsum + __shfl_xor(lsum, 32);
        const float invl = 1.f / ltot;
        if (map == 1) { const float f = lam * invl;
#pragma unroll
            for (int d = 0; d < 4; ++d)
#pragma unroll
                for (int i = 0; i < 16; ++i) xch[(qw * 64 + d * 16 + i) * 64 + C.lane] = O[d][i] * f; }
        __syncthreads();
        if (map == 0) { float ss = 0.f;
#pragma unroll
            for (int d = 0; d < 4; ++d)
#pragma unroll
                for (int i = 0; i < 16; ++i) { const float o = O[d][i] * invl - xch[(qw * 64 + d * 16 + i) * 64 + C.lane]; O[d][i] = o; ss += o * o; }
            ss += __shfl_xor(ss, 32);
            const float rn = rsqrtf(ss * (1.f / 128.f) + RMS_EPS) * (1.f - lam_init);
            bf16_t* orow = A2 + (size_t)(qrow0 + qw * 32 + r32) * DM + h * 128;
#pragma unroll
            for (int d = 0; d < 4; ++d)
#pragma unroll
                for (int g4 = 0; g4 < 4; ++g4) { const int dd = 32 * d + 8 * g4 + 4 * hi; const f32x4 sg = *(const f32x4*)(subg + dd);
                    const f32x4 v = {O[d][4 * g4] * rn * sg[0], O[d][4 * g4 + 1] * rn * sg[1], O[d][4 * g4 + 2] * rn * sg[2], O[d][4 * g4 + 3] * rn * sg[3]};
                    st4bf(orow + dd, v); } }
        __syncthreads();
    }
}

__device__ __forceinline__ void phase_rt(const Ctx& C, const Args& A, int l) {
    unsigned char* ws = A.ws; float* X = (float*)(ws + WS_X); bf16_t* H = (bf16_t*)(ws + WS_H); float* AFF = (float*)(ws + WS_AFF);
    const float* MOD = (const float*)(ws + WS_MOD) + (size_t)l * 5 * 6144;
    const float* lng = A.in[I_LNG] + (size_t)(l * 2 + 0) * DM; const float* lnb = A.in[I_LNB] + (size_t)(l * 2 + 0) * DM;
    LAS float* wrs = (LAS float*)C.lds;
    { const float* wr = A.in[I_WR] + (size_t)l * DM * 16; for (int i = C.tid; i < DM * 16; i += NTHR) wrs[(i & 15) * 1024 + (i >> 4)] = wr[i]; }
    __syncthreads();
    const int row0 = (int)(((long)C.gw * MROWS) / C.NGW), row1 = (int)(((long)(C.gw + 1) * MROWS) / C.NGW);
    f32x4 lngr[4], lnbr[4], scr[4], shr[4]; int cmi = -1;
#pragma unroll
    for (int j = 0; j < 4; ++j) { const int col = 4 * C.lane + 256 * j; lngr[j] = *(const f32x4*)(lng + col); lnbr[j] = *(const f32x4*)(lnb + col); scr[j] = lngr[j]; shr[j] = lngr[j]; }
    f32x4 xn[4];
    if (row0 < row1) {
#pragma unroll
        for (int j = 0; j < 4; ++j) xn[j] = *(const f32x4*)(X + (size_t)row0 * DM + 4 * C.lane + 256 * j); }
    for (int row = row0; row < row1; ++row) {
        const int mi = row_mi(row);
        if (mi != cmi) { cmi = mi; const float* md = MOD + mi * 6144;
#pragma unroll
            for (int j = 0; j < 4; ++j) { const int col = 4 * C.lane + 256 * j; scr[j] = *(const f32x4*)(md + 4 * DM + col) + 1.f; shr[j] = *(const f32x4*)(md + 3 * DM + col); } }
        f32x4 x[4]; float s = 0.f;
#pragma unroll
        for (int j = 0; j < 4; ++j) { x[j] = xn[j]; s += (x[j][0] + x[j][1]) + (x[j][2] + x[j][3]); }
        if (row + 1 < row1) {
#pragma unroll
            for (int j = 0; j < 4; ++j) xn[j] = *(const f32x4*)(X + (size_t)(row + 1) * DM + 4 * C.lane + 256 * j); }
        const float mean = wave_sum(s) * (1.f / DM); float s2 = 0.f;
#pragma unroll
        for (int j = 0; j < 4; ++j) { x[j] = x[j] - mean; s2 += (x[j][0] * x[j][0] + x[j][1] * x[j][1]) + (x[j][2] * x[j][2] + x[j][3] * x[j][3]); }
        const float rstd = rsqrtf(wave_sum(s2) * (1.f / DM) + LN_EPS);
        float v[16];
#pragma unroll
        for (int e = 0; e < 16; ++e) v[e] = 0.f;
#pragma unroll
        for (int j = 0; j < 4; ++j) { const int col = 4 * C.lane + 256 * j;
            const f32x4 x1 = x[j] * rstd * lngr[j] + lnbr[j];
            *(f32x4*)(X + (size_t)row * DM + col) = x1;
            const f32x4 h = x1 * scr[j] + shr[j];
            st4bf(H + (size_t)row * DM + col, h);
#pragma unroll
            for (int e = 0; e < 16; ++e) { const f32x4 w = *(const LAS f32x4*)(wrs + e * 1024 + col); v[e] += (h[0] * w[0] + h[1] * w[1]) + (h[2] * w[2] + h[3] * w[3]); }
            __builtin_amdgcn_sched_barrier(0); }
#pragma unroll
        for (int i = 0; i < 8; ++i) { const float send = (C.lane & 32) ? v[i] : v[i + 8], keep = (C.lane & 32) ? v[i + 8] : v[i]; v[i] = keep + __shfl_xor(send, 32); }
#pragma unroll
        for (int i = 0; i < 4; ++i) { const float send = (C.lane & 16) ? v[i] : v[i + 4], keep = (C.lane & 16) ? v[i + 4] : v[i]; v[i] = keep + __shfl_xor(send, 16); }
#pragma unroll
        for (int i = 0; i < 2; ++i) { const float send = (C.lane & 8) ? v[i] : v[i + 2], keep = (C.lane & 8) ? v[i + 2] : v[i]; v[i] = keep + __shfl_xor(send, 8); }
        { const float send = (C.lane & 4) ? v[0] : v[1], keep = (C.lane & 4) ? v[1] : v[0]; v[0] = keep + __shfl_xor(send, 4); }
        float z = v[0]; z += __shfl_xor(z, 1); z += __shfl_xor(z, 2);
        float mx = z;
#pragma unroll
        for (int o = 4; o < 64; o <<= 1) mx = fmaxf(mx, __shfl_xor(mx, o));
        const float ex = expf(z - mx); float sm = ex;
#pragma unroll
        for (int o = 4; o < 64; o <<= 1) sm += __shfl_xor(sm, o);
        if ((C.lane & 3) == 0) AFF[(size_t)row * 16 + (C.lane >> 2)] = ex / sm;
    }
}

__device__ __forceinline__ void phase_tk(const Ctx& C, const Args& A) {
    unsigned char* ws = A.ws; const float* AFF = (const float*)(ws + WS_AFF); int* SLOT = (int*)(ws + WS_SLOT); int* IDX = (int*)(ws + WS_IDX); float* GATE = (float*)(ws + WS_GATE);
    LAS unsigned* key = (LAS unsigned*)C.lds;
    LAS unsigned* hist = key + 8192;
    LAS unsigned* scn = hist + 256;
    LAS unsigned* wtot = scn + 256;
    LAS unsigned* bc = wtot + 8;
    for (int u = blockIdx.x; u < 128; u += C.G) {
        const bool isctx = u >= 64; const int uu = u & 63, b = uu >> 4, e = uu & 15;
        const int n = isctx ? CTXL : TT, cap = isctx ? CAP_C : CAP_L;
        const int row0 = isctx ? NLAT + b * CTXL : b * TT;
        const int slot0 = e * ESLOTS + (isctx ? 4 * CAP_L + b * CAP_C : b * CAP_L);
        for (int i = C.tid; i < n; i += NTHR) key[i] = __float_as_uint(AFF[(size_t)(row0 + i) * 16 + e]);
        unsigned prefix = 0u, pmask = 0u; int need = cap;
        for (int pass = 0; pass < 4; ++pass) {
            const int shift = 24 - 8 * pass;
            if (C.tid < 256) hist[C.tid] = 0u;
            __syncthreads();
            for (int i = C.tid; i < n; i += NTHR) { const unsigned k = key[i]; if ((k & pmask) == prefix) __hip_atomic_fetch_add(&hist[(k >> shift) & 255u], 1u, __ATOMIC_RELAXED, __HIP_MEMORY_SCOPE_WORKGROUP); }
            __syncthreads();
            if (C.tid < 256) scn[C.tid] = hist[C.tid];
            __syncthreads();
            for (int off = 1; off < 256; off <<= 1) {
                unsigned a = 0u; if (C.tid < 256 && C.tid + off < 256) a = scn[C.tid + off];
                __syncthreads();
                if (C.tid < 256) scn[C.tid] += a;
                __syncthreads();
            }
            if (C.tid < 256) { const unsigned above = (C.tid < 255) ? scn[C.tid + 1] : 0u;
                if (scn[C.tid] >= (unsigned)need && above < (unsigned)need) { bc[0] = (unsigned)C.tid; bc[1] = (unsigned)need - above; } }
            __syncthreads();
            prefix |= bc[0] << shift; pmask |= 255u << shift; need = (int)bc[1];
            __syncthreads();
        }
        const int per = (n + NTHR - 1) / NTHR; const int i0 = C.tid * per;
        unsigned cg = 0u, ce = 0u;
        for (int j = 0; j < per; ++j) { const int i = i0 + j; if (i < n) { const unsigned k = key[i]; cg += (k > prefix); ce += (k == prefix); } }
        unsigned pk = cg | (ce << 16), inc = pk;
#pragma unroll
        for (int o = 1; o < 64; o <<= 1) { const unsigned t = __shfl_up(inc, o); if (C.lane >= o) inc += t; }
        if (C.lane == 63) wtot[C.wave] = inc;
        __syncthreads();
        unsigned wbase = 0u;
        for (int w = 0; w < C.wave; ++w) wbase += wtot[w];
        const unsigned excl = wbase + inc - pk;
        unsigned rg = excl & 0xffffu, re = excl >> 16;
        const int ngt = cap - need;
        for (int j = 0; j < per; ++j) { const int i = i0 + j; if (i < n) { const unsigned k = key[i]; int pos = -1;
            if (k > prefix) { pos = (int)rg; ++rg; } else if (k == prefix) { if ((int)re < need) pos = ngt + (int)re; ++re; }
            const int row = row0 + i;
            if (pos >= 0) { IDX[slot0 + pos] = row; GATE[slot0 + pos] = __uint_as_float(k); SLOT[(size_t)row * 16 + e] = slot0 + pos; }
            else SLOT[(size_t)row * 16 + e] = -1; } }
        if (isctx && b == 0 && C.tid < ESLOTS - 4224) { IDX[e * ESLOTS + 4224 + C.tid] = 0; GATE[e * ESLOTS + 4224 + C.tid] = 0.f; }
        __syncthreads();
    }
}

__device__ __forceinline__ void phase_cb(const Ctx& C, const Args& A, int l) {
    unsigned char* ws = A.ws; float* X = (float*)(ws + WS_X); bf16_t* H = (bf16_t*)(ws + WS_H); const int* SLOT = (const int*)(ws + WS_SLOT); const bf16_t* YE = (const bf16_t*)(ws + WS_YE);
    const float* MOD = (const float*)(ws + WS_MOD) + (size_t)l * 5 * 6144; const float* MODN = MOD + 5 * 6144;
    const float* lng = A.in[I_LNG] + (size_t)(l * 2 + 1) * DM; const float* lnb = A.in[I_LNB] + (size_t)(l * 2 + 1) * DM;
    const int row0 = (int)(((long)C.gw * MROWS) / C.NGW), row1 = (int)(((long)(C.gw + 1) * MROWS) / C.NGW);
    f32x4 lngr[4], lnbr[4], gfr[4], nsc[4], nsh[4]; int cmi = -1;
#pragma unroll
    for (int j = 0; j < 4; ++j) { const int col = 4 * C.lane + 256 * j; lngr[j] = *(const f32x4*)(lng + col); lnbr[j] = *(const f32x4*)(lnb + col); gfr[j] = lngr[j]; nsc[j] = lngr[j]; nsh[j] = lngr[j]; }
    int svn = -1; f32x4 xn[4];
    if (row0 < row1) { svn = SLOT[(size_t)row0 * 16 + (C.lane & 15)];
#pragma unroll
        for (int j = 0; j < 4; ++j) xn[j] = *(const f32x4*)(X + (size_t)row0 * DM + 4 * C.lane + 256 * j); }
    for (int row = row0; row < row1; ++row) {
        const int mi = row_mi(row);
        if (mi != cmi) { cmi = mi; const float* md = MOD + mi * 6144; const float* mn = MODN + mi * 6144;
#pragma unroll
            for (int j = 0; j < 4; ++j) { const int col = 4 * C.lane + 256 * j; gfr[j] = *(const f32x4*)(md + 5 * DM + col);
                if (l < DEPTH - 1) { nsc[j] = *(const f32x4*)(mn + DM + col) + 1.f; nsh[j] = *(const f32x4*)(mn + col); } } }
        const int sv = svn;
        unsigned mask = (unsigned)__ballot(sv >= 0) & 0xffffu;
        f32x4 acc[4];
#pragma unroll
        for (int j = 0; j < 4; ++j) acc[j] = (f32x4){0.f, 0.f, 0.f, 0.f};
        u32x2 y0[4], y1[4]; bool h0 = false, h1 = false;
        if (mask) { const int e = __builtin_ctz(mask); mask &= mask - 1; h0 = true; const int sl = __builtin_amdgcn_readlane(sv, e);
#pragma unroll
            for (int j = 0; j < 4; ++j) y0[j] = *(const u32x2*)(YE + (size_t)sl * DM + 4 * C.lane + 256 * j); }
        if (mask) { const int e = __builtin_ctz(mask); mask &= mask - 1; h1 = true; const int sl = __builtin_amdgcn_readlane(sv, e);
#pragma unroll
            for (int j = 0; j < 4; ++j) y1[j] = *(const u32x2*)(YE + (size_t)sl * DM + 4 * C.lane + 256 * j); }
        f32x4 x[4];
#pragma unroll
        for (int j = 0; j < 4; ++j) x[j] = xn[j];
        if (row + 1 < row1) { svn = SLOT[(size_t)(row + 1) * 16 + (C.lane & 15)];
#pragma unroll
            for (int j = 0; j < 4; ++j) xn[j] = *(const f32x4*)(X + (size_t)(row + 1) * DM + 4 * C.lane + 256 * j); }
        if (h0) {
#pragma unroll
            for (int j = 0; j < 4; ++j) acc[j] += (f32x4){__uint_as_float(y0[j].x << 16), __uint_as_float(y0[j].x & 0xffff0000u), __uint_as_float(y0[j].y << 16), __uint_as_float(y0[j].y & 0xffff0000u)}; }
        if (h1) {
#pragma unroll
            for (int j = 0; j < 4; ++j) acc[j] += (f32x4){__uint_as_float(y1[j].x << 16), __uint_as_float(y1[j].x & 0xffff0000u), __uint_as_float(y1[j].y << 16), __uint_as_float(y1[j].y & 0xffff0000u)}; }
        while (mask) { const int e = __builtin_ctz(mask); mask &= mask - 1; const int sl = __builtin_amdgcn_readlane(sv, e);
#pragma unroll
            for (int j = 0; j < 4; ++j) acc[j] += ld4bf(YE + (size_t)sl * DM + 4 * C.lane + 256 * j); }
        float sm = 0.f;
#pragma unroll
        for (int j = 0; j < 4; ++j) { x[j] = x[j] * ALPHA_DN + gfr[j] * acc[j];
            sm += (x[j][0] + x[j][1]) + (x[j][2] + x[j][3]); }
        const float mean = wave_sum(sm) * (1.f / DM); float s2 = 0.f;
#pragma unroll
        for (int j = 0; j < 4; ++j) { x[j] = x[j] - mean; s2 += (x[j][0] * x[j][0] + x[j][1] * x[j][1]) + (x[j][2] * x[j][2] + x[j][3] * x[j][3]); }
        const float rstd = rsqrtf(wave_sum(s2) * (1.f / DM) + LN_EPS);
#pragma unroll
        for (int j = 0; j < 4; ++j) { const int col = 4 * C.lane + 256 * j;
            const f32x4 x2 = x[j] * rstd * lngr[j] + lnbr[j];
            *(f32x4*)(X + (size_t)row * DM + col) = x2;
            if (l < DEPTH - 1) { st4bf(H + (size_t)row * DM + col, x2 * nsc[j] + nsh[j]); }
            else if (row < NLAT) *(f32x4*)(A.out + (size_t)row * DM + col) = x2; }
    }
}


#ifndef GEMM_NOINLINE
#define GEMM_NOINLINE 0
#endif
#if GEMM_NOINLINE
#define GEMM_FN __device__ __noinline__
#else
#define GEMM_FN __device__ __forceinline__
#endif
GEMM_FN void gphase_in(LAS unsigned char* lds, unsigned char* ws, int nN, int G) {
    int bx = blockIdx.x; asm volatile("" : "+s"(bx), "+s"(G));
    pg8::Gemm g{(const bf16_t*)(ws + WS_H), (const bf16_t*)(ws + WS_WIN), DM}; pg8::Order<0> S; S.init(MROWS / 256, nN, G, bx, nullptr, 0);
    pg8::EpiBf16 E{(bf16_t*)(ws + WS_P), P_LD}; pg8::gemm_phase(lds, g, S, E); }
GEMM_FN void gphase_in_odd(LAS unsigned char* lds, unsigned char* ws, int G) {
    int bx = blockIdx.x; asm volatile("" : "+s"(bx), "+s"(G));
    pg8::Gemm g{(const bf16_t*)(ws + WS_H), (const bf16_t*)(ws + WS_WIN), DM}; pg8::Order<0> S; S.init(MROWS / 256, D_IN_ODD / 256, G, bx, nullptr, 0);
    pg8::EpiOdd E{(bf16_t*)(ws + WS_P), (bf16_t*)(ws + WS_Q), (bf16_t*)(ws + WS_KA), (const float*)(ws + WS_ROPE)}; pg8::gemm_phase(lds, g, S, E); }
GEMM_FN void gphase_lora(LAS unsigned char* lds, unsigned char* ws, const float* d0, const float* a0, const float* kal, int G) {
    int bx = blockIdx.x; asm volatile("" : "+s"(bx), "+s"(G));
    pg8::Gemm g{(const bf16_t*)(ws + WS_LIN), (const bf16_t*)(ws + WS_WLORA), LORA_K}; pg8::Order<0> S; S.init(MROWS / 256, LORA_N / 256, G, bx, nullptr, 0);
    pg8::EpiLora E{ws + WS_SCN, (bf16_t*)(ws + WS_G), d0, a0, kal}; pg8::gemm_phase(lds, g, S, E); }
GEMM_FN void gphase_out(LAS unsigned char* lds, unsigned char* ws, const float* modl, int G) {
    int bx = blockIdx.x; asm volatile("" : "+s"(bx), "+s"(G));
    pg8::Gemm g{(const bf16_t*)(ws + WS_A2), (const bf16_t*)(ws + WS_WOUT), DM}; pg8::Order<0> S; S.init(MROWS / 256, DM / 256, G, bx, nullptr, 0);
    pg8::EpiRes E{(float*)(ws + WS_X), modl}; pg8::gemm_phase(lds, g, S, E); }
GEMM_FN void gphase_e1(LAS unsigned char* lds, unsigned char* ws, int G, int l) {
    int bx = blockIdx.x; asm volatile("" : "+s"(bx), "+s"(G));
    pg8::Gemm g{(const bf16_t*)(ws + WS_H), (const bf16_t*)(ws + WS_WE13 + (size_t)(l & 1) * WE13_BYTES), DM}; pg8::EpiSwiGLU E{(bf16_t*)(ws + WS_HID)};
    pg8::OrderExp<1> S; S.init(4096 / 256, G, bx, (const int*)(ws + WS_IDX), (long)4096 * DM); pg8::gemm_phase(lds, g, S, E); }
GEMM_FN void gphase_e2(LAS unsigned char* lds, unsigned char* ws, int G, int l) {
    int bx = blockIdx.x; asm volatile("" : "+s"(bx), "+s"(G));
    pg8::Gemm g{(const bf16_t*)(ws + WS_HID), (const bf16_t*)(ws + WS_WE2 + (size_t)(l & 1) * WE2_BYTES), D_EXP}; pg8::EpiYE E{(bf16_t*)(ws + WS_YE), (const float*)(ws + WS_GATE)};
    pg8::OrderExp<2> S; S.init(DM / 256, G, bx, nullptr, (long)DM * D_EXP); pg8::gemm_phase(lds, g, S, E); }

constexpr int NSLOT = 13;
constexpr int NSTEP = 1 + DEPTH * NSLOT;
__global__ void __launch_bounds__(NTHR, 2) mk_fwd(Args KA) {
    extern __shared__ __attribute__((aligned(16))) unsigned char lds_raw[];
    volatile LAS unsigned* MISC = (volatile LAS unsigned*)((LAS unsigned char*)lds_raw + LDS_MISC);
    if (threadIdx.x < 16) MISC[threadIdx.x] = 0u;
    if (threadIdx.x == 0) { LAS unsigned long long* tb = (LAS unsigned long long*)((LAS unsigned char*)lds_raw + LDS_PTAB);
#pragma unroll
        for (int i = 0; i < 37; ++i) tb[i] = (unsigned long long)KA.in[i];
        tb[37] = (unsigned long long)KA.out; tb[38] = (unsigned long long)KA.ws; }
    __syncthreads();
    const int lo = KA.lo, hi = KA.hi;
    unsigned bar_x = 0;
    if (hi - lo > 1) { const XcdBarrier b0 = xcd_barrier_post((unsigned*)(KA.ws + WS_CTL), MISC); bar_x = b0.x; }
#ifndef PH_MASK
#define PH_MASK 0xFFFFFF
#endif
#ifndef REP_MASK
#define REP_MASK 0
#endif
#define PH_BIT(k) (((k) == 0) ? 0 : 1 + ((k) - 1) % NSLOT + (((k) - 1) % NSLOT >= 2 && ((k) - 1) % NSLOT <= 3 && odd ? 12 : 0))
#define RUN(k, ...) do { if (((PH_MASK >> PH_BIT(k)) & 1) && lo <= (k) && (k) < hi) { const int nrep = ((REP_MASK >> PH_BIT(k)) & 1) ? 2 : 1; \
        _Pragma("unroll 1") for (int rep = 0; rep < nrep; ++rep) { \
        Ctx C; mkctx(C, (LAS unsigned char*)lds_raw); Args A; ldargs(A, (LAS unsigned char*)lds_raw); unsigned char* ws = A.ws; \
        const float* MODL = (const float*)(ws + WS_MOD) + (size_t)l * 5 * 6144; (void)MODL; \
        __VA_ARGS__; if ((k) + 1 < hi || rep + 1 < nrep) { XcdBarrier bar; bar.bar = (unsigned*)(ws + WS_CTL); bar.x = bar_x; bar.st = MISC; xcd_barrier(bar); } } } } while (0)
    { const bool odd = false; const int l = 0; RUN(0, { phase_init(C, A); __syncthreads(); conv_items(C, A, 0, C.gw, C.NGW, true, true, true); }); }
#pragma unroll 1
    for (int l = 0; l < DEPTH; ++l) {
        const int sb = 1 + l * NSLOT; const bool odd = l & 1;
        if (!(CHUNKED_SCAN && odd)) { RUN(sb + 0, { phase_conv(C, A, l); if (l == 0) phase_modh(C, A, 0); }); }
        if (odd) { RUN(sb + 1, gphase_in_odd(C.lds, ws, C.G)); } else { RUN(sb + 1, gphase_in(C.lds, ws, D_IN_EVEN_PAD / 256, C.G)); }
        if (!odd) {
            RUN(sb + 2, phase_ef1(C, A, l));
            RUN(sb + 3, { const int i2 = l >> 1; gphase_lora(C.lds, ws, A.in[I_D0] + (size_t)i2 * 2 * 768, A.in[I_A0] + (size_t)i2 * 2 * 768, A.in[I_KAL] + (size_t)i2 * 768, C.G); });
#if CHUNKED_SCAN
            RUN(sb + 4, phase_csa(C, A));
            RUN(sb + 5, phase_csb(C, A, l));
#else
            RUN(sb + 4, phase_scan(C, A));
#endif
            RUN(sb + 6, phase_ef2(C, A, l));
        } else {
            RUN(sb + 2, phase_of1(C, A, l));
            RUN(sb + 3, phase_attn(C, A, l));
        }
        RUN(sb + 7, gphase_out(C.lds, ws, MODL, C.G));
        RUN(sb + 8, phase_rt(C, A, l));
        RUN(sb + 9, phase_tk(C, A));
        RUN(sb + 10, gphase_e1(C.lds, ws, C.G, l));
        RUN(sb + 11, gphase_e2(C.lds, ws, C.G, l));
        RUN(sb + 12, { phase_cb(C, A, l); if (CHUNKED_SCAN && !odd && l + 1 < DEPTH) { __syncthreads(); conv_items(C, A, l + 1, C.gw, C.NGW, false, true, false); } });
    }
#undef RUN
}

#ifdef PHASE_PROBE
#define PROBE_PRE extern __shared__ __attribute__((aligned(16))) unsigned char lds_raw[]; Ctx C; mkctx(C, (LAS unsigned char*)lds_raw); unsigned char* ws = A.ws; (void)ws;
__global__ void __launch_bounds__(NTHR, 2) pr_init(Args A) { PROBE_PRE phase_init(C, A); }
__global__ void __launch_bounds__(NTHR, 2) pr_conv(Args A) { PROBE_PRE phase_conv(C, A, A.lo); }
__global__ void __launch_bounds__(NTHR, 2) pr_modh(Args A) { PROBE_PRE phase_modh(C, A, A.lo); }
__global__ void __launch_bounds__(NTHR, 2) pr_ef1(Args A) { PROBE_PRE phase_ef1(C, A, A.lo); }
__global__ void __launch_bounds__(NTHR, 2) pr_scan(Args A) { PROBE_PRE phase_scan(C, A); }
__global__ void __launch_bounds__(NTHR, 2) pr_ef2(Args A) { PROBE_PRE phase_ef2(C, A, A.lo); }
__global__ void __launch_bounds__(NTHR, 2) pr_csa(Args A) { PROBE_PRE phase_csa(C, A); }
__global__ void __launch_bounds__(NTHR, 2) pr_csb(Args A) { PROBE_PRE phase_csb(C, A, A.lo); }
__global__ void __launch_bounds__(NTHR, 2) pr_of1(Args A) { PROBE_PRE phase_of1(C, A, A.lo); }
__global__ void __launch_bounds__(NTHR, 2) pr_attn(Args A) { PROBE_PRE phase_attn(C, A, A.lo); }
__global__ void __launch_bounds__(NTHR, 2) pr_rt(Args A) { PROBE_PRE phase_rt(C, A, A.lo); }
__global__ void __launch_bounds__(NTHR, 2) pr_tk(Args A) { PROBE_PRE phase_tk(C, A); }
__global__ void __launch_bounds__(NTHR, 2) pr_cb(Args A) { PROBE_PRE phase_cb(C, A, A.lo); }
__global__ void __launch_bounds__(NTHR, 2) pr_gemm_in(Args A) { PROBE_PRE pg8::Gemm g{(const bf16_t*)(ws + WS_H), (const bf16_t*)(ws + WS_WIN), DM}; pg8::Order<0> S; S.init(MROWS / 256, A.lo, C.G, (int)blockIdx.x, nullptr, 0);
                      pg8::EpiBf16 E{(bf16_t*)(ws + WS_P), P_LD}; pg8::gemm_phase(C.lds, g, S, E); }
__global__ void __launch_bounds__(NTHR, 2) pr_gemm_lora(Args A) { PROBE_PRE pg8::Gemm g{(const bf16_t*)(ws + WS_LIN), (const bf16_t*)(ws + WS_WLORA), LORA_K}; pg8::Order<0> S; S.init(MROWS / 256, LORA_N / 256, C.G, (int)blockIdx.x, nullptr, 0);
                          const int i2 = A.lo; pg8::EpiLora E{ws + WS_SCN, (bf16_t*)(ws + WS_G), A.in[I_D0] + (size_t)i2 * 2 * 768, A.in[I_A0] + (size_t)i2 * 2 * 768, A.in[I_KAL] + (size_t)i2 * 768};
                          pg8::gemm_phase(C.lds, g, S, E); }
__global__ void __launch_bounds__(NTHR, 2) pr_gemm_out(Args A) { PROBE_PRE pg8::Gemm g{(const bf16_t*)(ws + WS_A2), (const bf16_t*)(ws + WS_WOUT), DM}; pg8::Order<0> S; S.init(MROWS / 256, DM / 256, C.G, (int)blockIdx.x, nullptr, 0);
                      pg8::EpiRes E{(float*)(ws + WS_X), (const float*)(ws + WS_MOD)}; pg8::gemm_phase(C.lds, g, S, E); }
__global__ void __launch_bounds__(NTHR, 2) pr_gemm_e1(Args A) { PROBE_PRE pg8::Gemm g{(const bf16_t*)(ws + WS_H), (const bf16_t*)(ws + WS_WE13), DM}; pg8::Order<1> S; S.init(NEXP * 17, 4096 / 256, C.G, (int)blockIdx.x, (const int*)(ws + WS_IDX), (long)4096 * DM);
                      pg8::EpiSwiGLU E{(bf16_t*)(ws + WS_HID)}; pg8::gemm_phase(C.lds, g, S, E); }
__global__ void __launch_bounds__(NTHR, 2) pr_gemm_e2(Args A) { PROBE_PRE pg8::Gemm g{(const bf16_t*)(ws + WS_HID), (const bf16_t*)(ws + WS_WE2), D_EXP}; pg8::Order<2> S; S.init(NEXP * 17, DM / 256, C.G, (int)blockIdx.x, nullptr, (long)DM * D_EXP);
                       pg8::EpiYE E{(bf16_t*)(ws + WS_YE), (const float*)(ws + WS_GATE)}; pg8::gemm_phase(C.lds, g, S, E); }
#endif

extern "C" void kernel_launch(void* const* d_in, const int* in_sizes, int n_in, void* d_out, int out_size, void* d_ws, size_t ws_size, hipStream_t stream) {
    static int grid = 0;
    if (grid == 0) {
        if (n_in != 37 || out_size != NLAT * DM || ws_size < WS_END) { fprintf(stderr, "kernel_launch: unexpected shapes: n_in %d out %d ws %zu (need %zu)\n", n_in, out_size, ws_size, (size_t)WS_END); grid = -1; return; }
        int dev = 0, cus = 0, per_cu = 0;
        if (hipGetDevice(&dev) != hipSuccess || hipDeviceGetAttribute(&cus, hipDeviceAttributeMultiprocessorCount, dev) != hipSuccess) { grid = -1; return; }
        if (hipFuncSetAttribute((const void*)mk_fwd, hipFuncAttributeMaxDynamicSharedMemorySize, LDS_BYTES) != hipSuccess) { fprintf(stderr, "kernel_launch: hipFuncSetAttribute failed\n"); grid = -1; return; }
        if (hipOccupancyMaxActiveBlocksPerMultiprocessor(&per_cu, (const void*)mk_fwd, NTHR, LDS_BYTES) != hipSuccess || per_cu < 1) fprintf(stderr, "kernel_launch: occupancy query reports %d\n", per_cu);
        (void)hipGetLastError();
        grid = cus;
    }
    if (grid < 0) return;
    (void)hipMemsetAsync((char*)d_ws + WS_CTL, 0, CTL_BYTES, stream);
    Args a{};
    for (int i = 0; i < 37; ++i) a.in[i] = (const float*)d_in[i];
    a.out = (float*)d_out; a.ws = (unsigned char*)d_ws;
#if MK_MULTI
    for (int k = 0; k < NSTEP; ++k) {
        if (k >= 1) { const int l = (k - 1) / NSLOT, s = (k - 1) % NSLOT; if ((l & 1) && ((s >= 4 && s <= 6) || (CHUNKED_SCAN && s == 0))) continue; if (!(l & 1) && !CHUNKED_SCAN && s == 5) continue; }
        a.lo = k; a.hi = k + 1;
        hipLaunchKernelGGL(mk_fwd, dim3(grid), dim3(NTHR), LDS_BYTES, stream, a);
    }
#else
    a.lo = 0; a.hi = NSTEP;
    hipLaunchKernelGGL(mk_fwd, dim3(grid), dim3(NTHR), LDS_BYTES, stream, a);
#endif
    const hipError_t le = hipPeekAtLastError();
    if (le != hipSuccess) fprintf(stderr, "kernel_launch: launch failed: %s\n", hipGetErrorName(le));
}
```

```cpp
#include <hip/hip_runtime.h>
#include <cstdio>
#include <cstdint>
#include <cmath>

#ifndef MK_MULTI
#define MK_MULTI 0
#endif
#ifndef CHUNKED_SCAN
#define CHUNKED_SCAN 1
#endif

#define GAS __attribute__((address_space(1)))
#define LAS __attribute__((address_space(3)))
typedef unsigned short bf16_t;
typedef short bf16x8 __attribute__((ext_vector_type(8)));
typedef float f32x4 __attribute__((ext_vector_type(4)));
typedef float f32x2 __attribute__((ext_vector_type(2)));
typedef float f32x16 __attribute__((ext_vector_type(16)));
typedef unsigned u32x4 __attribute__((ext_vector_type(4)));
typedef unsigned u32x2 __attribute__((ext_vector_type(2)));
typedef __bf16 bf16x2_t __attribute__((ext_vector_type(2)));

constexpr int NB = 4, TT = 8192, DM = 1024, NLAT = NB * TT, CTXL = 256, NCTX = NB * CTXL, MROWS = NLAT + NCTX;
constexpr int DEPTH = 4;
constexpr int D_CONV = 256, RW_H = 12, RW_K = 64, D_RWKV = 768, RWKV_COLS = 2688, D_IN_EVEN = 3456, D_IN_EVEN_PAD = 3584;
constexpr int D_DIFF = 768, D_GMLP = 256, D_IN_ODD = 2816;
constexpr int NEXP = 16, D_EXP = 2048, CAP_L = 1024, CAP_C = 32, ESLOTS = 4352;
constexpr int P_LD = 3584;
constexpr int LORA_K = 384, LORA_N = 3840;
constexpr int LKEYS = CTXL + TT;
constexpr float ALPHA_DN = 1.6817928305074290f;
constexpr float DECAY_SCALE = 0.6065306597126334f;
constexpr float GN_EPS = 64e-5f, LN_EPS = 1e-5f, RMS_EPS = 1e-5f;
constexpr float QSCALE = 0.125f * 1.4426950408889634f;

constexpr size_t al256(size_t x) { return (x + 255) & ~(size_t)255; }
constexpr size_t WS_CTL = 0;
constexpr size_t CTL_BYTES = 65536;
constexpr size_t WS_MOD = WS_CTL + CTL_BYTES;
constexpr size_t WS_ROPE = WS_MOD + al256((size_t)DEPTH * 5 * 6144 * 4);
constexpr size_t WS_WIN = WS_ROPE + 32768;
constexpr size_t WS_WOUT = WS_WIN + (size_t)D_IN_EVEN_PAD * DM * 2;
constexpr size_t WS_WLORA = WS_WOUT + (size_t)DM * DM * 2;
constexpr size_t WS_WE13 = WS_WLORA + (size_t)LORA_N * LORA_K * 2;
constexpr size_t WE13_BYTES = (size_t)NEXP * 4096 * DM * 2, WE2_BYTES = (size_t)NEXP * DM * D_EXP * 2;
constexpr size_t WS_WE2 = WS_WE13 + 2 * WE13_BYTES;
constexpr size_t WS_X = WS_WE2 + 2 * WE2_BYTES;
constexpr size_t WS_H = WS_X + (size_t)MROWS * DM * 4;
constexpr size_t WS_A2 = WS_H + (size_t)MROWS * DM * 2;
constexpr size_t WS_P = WS_A2 + (size_t)MROWS * DM * 2;
constexpr size_t WS_AFF = WS_P + (size_t)MROWS * P_LD * 2;
constexpr size_t WS_SLOT = WS_AFF + (size_t)MROWS * 16 * 4;
constexpr size_t WS_IDX = WS_SLOT + (size_t)MROWS * 16 * 4;
constexpr size_t WS_GATE = WS_IDX + al256((size_t)NEXP * ESLOTS * 4);
constexpr size_t WS_R2 = WS_GATE + al256((size_t)NEXP * ESLOTS * 4);
constexpr int SC_REC = 1408, SC_ROW = 12 * SC_REC, SC_W = 0, SC_R = 512, SC_KK = 640, SC_V = 768, SC_B = 896, SC_KR = 1024;
constexpr size_t WS_SCN = WS_R2;
constexpr size_t WS_G = WS_SCN + (size_t)MROWS * SC_ROW;
constexpr size_t WS_LIN = WS_G + (size_t)MROWS * 768 * 2;
constexpr int CS_L = 64, CS_NCH = LKEYS / CS_L, CS_UNITS = NB * RW_H * 2;
constexpr size_t WS_CHK = WS_LIN + (size_t)MROWS * 384 * 2;
constexpr size_t WS_EVEN_END = WS_CHK + (size_t)CS_UNITS * CS_NCH * 32768;
constexpr size_t WS_Y = WS_P;
constexpr size_t WS_Q = WS_R2;
constexpr size_t WS_KA = WS_Q + (size_t)MROWS * 768 * 2;
constexpr size_t WS_VT = WS_KA + (size_t)NB * LKEYS * 768 * 2;
constexpr size_t WS_HID = WS_R2;
constexpr size_t WS_YE = WS_HID + (size_t)NEXP * ESLOTS * D_EXP * 2;
constexpr size_t WS_END = WS_EVEN_END;
static_assert(WS_END <= (size_t)2147483648ull, "workspace over 2 GiB");
static_assert((size_t)2 * MROWS * 768 * 4 <= (size_t)MROWS * P_LD * 2, "Y aliases P");
static_assert(WS_YE + (size_t)NEXP * ESLOTS * DM * 2 <= WS_END, "moe region");

constexpr int LDS_BYTES = 147456;
constexpr int LDS_MISC = 140 * 1024;
constexpr int LDS_PTAB = LDS_MISC + 256;
constexpr int NWAVES = 8, NTHR = 512;

__device__ __forceinline__ unsigned f2bf(float f) { unsigned u = __float_as_uint(f); return (u + 0x7fffu + ((u >> 16) & 1u)) >> 16; }
__device__ __forceinline__ unsigned pk2(float lo, float hi) { f32x2 v = {lo, hi}; bf16x2_t b = __builtin_convertvector(v, bf16x2_t); return __builtin_bit_cast(unsigned, b); }
__device__ __forceinline__ float bflo(unsigned u) { return __uint_as_float(u << 16); }
__device__ __forceinline__ float bfhi(unsigned u) { return __uint_as_float(u & 0xffff0000u); }
__device__ __forceinline__ float bf2f(bf16_t b) { return __uint_as_float((unsigned)b << 16); }
__device__ __forceinline__ float sigmoidf_(float x) { return 1.f / (1.f + __expf(-x)); }
__device__ __forceinline__ float wave_sum(float v) {
#pragma unroll
    for (int o = 1; o < 64; o <<= 1) v += __shfl_xor(v, o);
    return v;
}
__device__ __forceinline__ float sum16(float v) {
#pragma unroll
    for (int o = 1; o < 16; o <<= 1) v += __shfl_xor(v, o);
    return v;
}
__device__ __forceinline__ f32x4 ld4bf_(const void* p) { const u32x2 u = *(const u32x2*)p; return (f32x4){bflo(u.x), bfhi(u.x), bflo(u.y), bfhi(u.y)}; }
__device__ __forceinline__ void st4bf_(void* p, f32x4 v) { u32x2 o; o.x = pk2(v[0], v[1]); o.y = pk2(v[2], v[3]); *(u32x2*)p = o; }
__device__ __forceinline__ float max3f(float a, float b, float c) { float r; asm("v_max3_f32 %0, %1, %2, %3" : "=v"(r) : "v"(a), "v"(b), "v"(c)); return r; }
__device__ __forceinline__ int crow(int r, int hi) { return (r & 3) + 8 * (r >> 2) + 4 * hi; }
__device__ __forceinline__ float gelu_erf(float x) { return 0.5f * x * (1.f + erff(x * 0.70710678118654752f)); }

#define XB_TMO      128
#define XB_XCNT(j)  (256  + 64 * (j))
#define XB_XSUB(j)  (1280 + 64 * (j))
#define XB_XGEN(j)  (2304 + 64 * (j))
#define XB_TOP      3328
#define XB_TOPGEN   3392
#define XCD_BAR_WORDS 3456
#define XB_SPIN_CAP (1u << 20)

__device__ __forceinline__ unsigned xb_ld(unsigned* p)              { return __hip_atomic_load(p, __ATOMIC_RELAXED, __HIP_MEMORY_SCOPE_AGENT); }
__device__ __forceinline__ unsigned xb_add(unsigned* p, unsigned v) { return __hip_atomic_fetch_add(p, v, __ATOMIC_RELAXED, __HIP_MEMORY_SCOPE_AGENT); }
__device__ __forceinline__ unsigned xb_xcc_id() { return (unsigned)__builtin_amdgcn_s_getreg((3 << 11) | 20) & 0xFu; }
#define XB_SPIN(cond, bar) do { unsigned _sp = 0; while (cond) { __builtin_amdgcn_s_sleep(1); \
    if ((++_sp & 255u) == 0u) { if (xb_ld(&(bar)[XB_TMO])) break; if (_sp > XB_SPIN_CAP) { atomicAdd(&(bar)[XB_TMO], 1u); break; } } } } while (0)

struct XcdBarrier { unsigned* bar; unsigned x; volatile LAS unsigned* st; };

__device__ __forceinline__ XcdBarrier xcd_barrier_post(unsigned* bar, volatile LAS unsigned* st) {
    XcdBarrier b; b.bar = bar; b.x = xb_xcc_id(); b.st = st;
    if (threadIdx.x == 0) (void)xb_add(&bar[XB_XCNT(b.x)], 1u);
    return b;
}
__device__ __forceinline__ void xcd_barrier_complete(unsigned* bar, unsigned x, unsigned& nloc, unsigned& nx) {
    const unsigned G = gridDim.x * gridDim.y * gridDim.z;
    unsigned sum, cnt, mine, sp = 0u;
    for (;;) {
        sum = 0u; cnt = 0u; mine = 0u;
#pragma unroll
        for (unsigned j = 0; j < 16; ++j) { const unsigned c = xb_ld(&bar[XB_XCNT(j)]); sum += c; cnt += (c > 0u) ? 1u : 0u; mine = (j == x) ? c : mine; }
        if (sum == G) break;
        __builtin_amdgcn_s_sleep(1);
        if ((++sp & 255u) == 0u) { if (xb_ld(&bar[XB_TMO])) break; if (sp > XB_SPIN_CAP) { atomicAdd(&bar[XB_TMO], 1u); break; } }
    }
    nloc = mine > 0u ? mine : 1u; nx = cnt > 0u ? cnt : 1u;
}
__device__ __forceinline__ void xcd_barrier(const XcdBarrier& b) {
    asm volatile("s_waitcnt vmcnt(0)" ::: "memory");
    __syncthreads();
    if (threadIdx.x == 0) {
        unsigned* bar = b.bar;
        __builtin_amdgcn_s_waitcnt(0);
        unsigned nloc = b.st[0], nx = b.st[1];
        if (nloc == 0u) { xcd_barrier_complete(bar, b.x, nloc, nx); b.st[0] = nloc; b.st[1] = nx; }
        const unsigned old = xb_add(&bar[XB_XSUB(b.x)], 1u);
        const unsigned gen = old / nloc;
        if (old + 1u == (gen + 1u) * nloc) {
            __builtin_amdgcn_fence(__ATOMIC_RELEASE, "agent");
            asm volatile("s_waitcnt vmcnt(0)" ::: "memory");
            const unsigned og = xb_add(&bar[XB_TOP], 1u);
            const unsigned tg = og / nx;
            if (og + 1u == (tg + 1u) * nx) xb_add(&bar[XB_TOPGEN], 1u);
            else XB_SPIN(xb_ld(&bar[XB_TOPGEN]) == tg, bar);
            __builtin_amdgcn_fence(__ATOMIC_ACQUIRE, "agent");
            xb_add(&bar[XB_XGEN(b.x)], 1u);
            asm volatile("s_waitcnt vmcnt(0)" ::: "memory");
        } else {
            XB_SPIN(xb_ld(&bar[XB_XGEN(b.x)]) == gen, bar);
            __builtin_amdgcn_fence(__ATOMIC_ACQUIRE, "agent");
            asm volatile("s_waitcnt vmcnt(0)" ::: "memory");
        }
    }
    __syncthreads();
}

namespace pg8 {
constexpr int BM = 256, BK = 64, HALF = 128, HTB = HALF * BK * 2, STAGE_BYTES = 8 * HTB, NXCD = 8, WGM = 8;
__host__ __device__ __forceinline__ int lds_byte(int r, int c) { const int st = (r >> 4) * 2 + (c >> 5), rr = r & 15, cc = c & 31, ob = rr * 64 + cc * 2; return st * 1024 + (ob ^ (((ob >> 9) & 1) << 5)); }
__host__ __device__ __forceinline__ void stage_rc(int b, int& R, int& C) { const int st = b / 1024, sb = b % 1024, swz = sb ^ (((sb >> 9) & 1) << 5); R = (st >> 1) * 16 + swz / 64; C = (st & 1) * 32 + (swz % 64) / 2; }

struct Unit { int pm, pn, hf; };
struct Gemm { const bf16_t* A; const bf16_t* Bt; int K; };

template <int MODE> struct Order {
    static constexpr bool GATHER = (MODE == 1);
    int nM, nN, nwg, G, c; const int* idx; long bstride;
    __device__ __forceinline__ void init(int nM_, int nN_, int G_, int c_, const int* idx_, long bstride_) { nM = nM_; nN = nN_; nwg = nM * nN; G = G_; c = c_; idx = idx_; bstride = bstride_; }
    __device__ __forceinline__ bool next(int i, Unit& u) const {
        const long L = (long)i * G + c; if (L >= nwg) return false;
        int wgid = (int)L; { const int q = nwg / NXCD, r = nwg % NXCD, xcd = wgid % NXCD, off = wgid / NXCD; wgid = (xcd < r ? xcd * (q + 1) : r * (q + 1) + (xcd - r) * q) + off; }
        const int nig = WGM * nN, gid = wgid / nig, fm = gid * WGM, gsz = (nM - fm) < WGM ? (nM - fm) : WGM;
        u.pm = fm + ((wgid % nig) % gsz); u.pn = (wgid % nig) / gsz; u.hf = (MODE != 0 && (u.pm % 17) == 16) ? 1 : 0; return true;
    }
    __device__ __forceinline__ unsigned arow(const Unit& u, int r) const { if (MODE == 1) return (unsigned)idx[u.pm * BM + r]; return (unsigned)(u.pm * BM + r); }
    __device__ __forceinline__ long bbase(const Unit& u, int K) const { long o = (long)u.pn * BM * K; if (MODE != 0) o += (long)(u.pm / 17) * bstride; return o; }
};

template <int MODE> struct OrderExp {
    static constexpr bool GATHER = (MODE == 1);
    int nN, G, c0; const int* idx; long bstride;
    __device__ __forceinline__ void init(int nN_, int G_, int c_, const int* idx_, long bstride_) { nN = nN_; G = G_; c0 = c_; idx = idx_; bstride = bstride_; }
    __device__ __forceinline__ bool next(int i0, Unit& u) const {
        const int v = i0 * G + c0, i = v >> 8, c = v & 255;
        const int x = c & 7, slot = c >> 3, per = 32 / nN, nfull = 256 / (8 * per);
        if (i > nfull) return false;
        if (i < nfull) { u.pn = slot / per; const int f = (i * 8 + x) * per + (slot % per); u.pm = (f >> 4) * 17 + (f & 15); u.hf = 0; return true; }
        if (i == nfull && slot < 2 * nN) { u.pn = slot >> 1; u.pm = (x * 2 + (slot & 1)) * 17 + 16; u.hf = 1; return true; }
        return false;
    }
    __device__ __forceinline__ unsigned arow(const Unit& u, int r) const { if (MODE == 1) return (unsigned)idx[u.pm * BM + r]; return (unsigned)(u.pm * BM + r); }
    __device__ __forceinline__ long bbase(const Unit& u, int K) const { return (long)u.pn * BM * K + (long)(u.pm / 17) * bstride; }
};

template <class Epi, class Sched>
__device__ __forceinline__ void gemm_phase(LAS unsigned char* lds, const Gemm g, const Sched& S, const Epi& E) {
    int tid = threadIdx.x; asm volatile("" : "+v"(tid));
    const int wid = __builtin_amdgcn_readfirstlane(tid >> 6), wr = wid >> 2, wc = wid & 3;
    const int K = g.K, nt = K / BK;
    unsigned voffB[2];
    { const int lane = tid & 63, fr = lane & 15, fq = lane >> 4; (void)fr; (void)fq; }
#pragma unroll
    for (int i = 0; i < 2; ++i) { int R, Cc; stage_rc(tid * 16 + i * 8192, R, Cc); voffB[i] = (unsigned)(R * K + Cc) * 2u; }
    const size_t kstep = (size_t)(BK * 2);
    const size_t hstep = (size_t)HALF * K * 2;
    const unsigned ldsw = (unsigned)wid * 1024u;
    const int aoff = lds_byte(wr * 64 + (tid & 15), ((tid & 63) >> 4) * 8), boff = lds_byte(wc * 32 + (tid & 15), ((tid & 63) >> 4) * 8);
#define PG8_SA(b, h) (((b) * 2 + (h)) * HTB)
#define PG8_SB(b, h) ((4 + (b) * 2 + (h)) * HTB)
#define PG8_STAGE(bufoff, gbase, voff) do { _Pragma("unroll") for (int _i = 0; _i < 2; ++_i) \
        __builtin_amdgcn_global_load_lds((const unsigned*)((const char*)(gbase) + (voff)[_i]), (LAS unsigned*)(lds + (bufoff) + ldsw + _i * 8192), 16, 0, 0); } while (0)
#define PG8_LDA(dst, b, h) do { _Pragma("unroll") for (int m = 0; m < 4; ++m) _Pragma("unroll") for (int k = 0; k < 2; ++k) dst[m][k] = *(const LAS bf16x8*)(lds + PG8_SA(b, h) + aoff + m * 2048 + k * 1024); } while (0)
#define PG8_LDB(dst, b, h) do { _Pragma("unroll") for (int n = 0; n < 2; ++n) _Pragma("unroll") for (int k = 0; k < 2; ++k) dst[n][k] = *(const LAS bf16x8*)(lds + PG8_SB(b, h) + boff + n * 2048 + k * 1024); } while (0)
#define PG8_MMA(ai, bj, At, Bt) do { __builtin_amdgcn_s_setprio(1); _Pragma("unroll") for (int m = 0; m < 4; ++m) _Pragma("unroll") for (int n = 0; n < 2; ++n) _Pragma("unroll") for (int k = 0; k < 2; ++k) \
        acc[ai][bj][m][n] = __builtin_amdgcn_mfma_f32_16x16x32_bf16(Bt[n][k], At[m][k], acc[ai][bj][m][n], 0, 0, 0); __builtin_amdgcn_s_setprio(0); } while (0)
#define PG8_WAIT_V(n) asm volatile("s_waitcnt vmcnt(" #n ")" ::: "memory")
#define PG8_WAIT_L(n) asm volatile("s_waitcnt lgkmcnt(" #n ")" ::: "memory")
#define PG8_BAR __builtin_amdgcn_s_barrier()
#define PG8_SCHED __builtin_amdgcn_sched_barrier(0)
#define PG8_ROWOFFS(dst, u, tq) do { _Pragma("unroll") for (int _i = 0; _i < 2; ++_i) { int _R, _C; stage_rc((tq) * 16 + _i * 8192, _R, _C); _Pragma("unroll") for (int _h = 0; _h < 2; ++_h) dst[_h][_i] = (S.arow(u, _h * HALF + _R) * (unsigned)K + (unsigned)_C) * 2u; } } while (0)
    Unit cur, nxt; int ui = 0;
    if (!S.next(0, cur)) return;
    float zf = 0.f; asm volatile("" : "+v"(zf));
    f32x4 acc[2][2][4][2];
#pragma unroll
    for (int a = 0; a < 2; ++a)
#pragma unroll
        for (int b = 0; b < 2; ++b)
#pragma unroll
            for (int m = 0; m < 4; ++m)
#pragma unroll
                for (int n = 0; n < 2; ++n) acc[a][b][m][n] = (f32x4){zf, zf, zf, zf};
    bf16x8 At[4][2], B0[2][2], B1[2][2];
    unsigned vcur[2][2];
    if constexpr (Sched::GATHER) { PG8_ROWOFFS(vcur, cur, tid); }
    const char* const Ab = (const char*)g.A;
    const char* cA = Sched::GATHER ? Ab : Ab + (size_t)(unsigned)__builtin_amdgcn_readfirstlane((int)S.arow(cur, 0)) * K * 2;
#define PG8_STAGEA(bufoff, ptr, h) do { if constexpr (Sched::GATHER) { PG8_STAGE(bufoff, ptr, vcur[h]); } else { PG8_STAGE(bufoff, (ptr) + (h) * hstep, voffB); } } while (0)
    const char* cB = (const char*)g.Bt + (size_t)S.bbase(cur, K) * 2;
    PG8_STAGE(PG8_SB(0, 0), cB, voffB); PG8_STAGE(PG8_SB(0, 1), cB + hstep, voffB); PG8_STAGEA(PG8_SA(0, 0), cA, 0); PG8_STAGEA(PG8_SA(0, 1), cA, 1);
    if (wr == 1) PG8_BAR;
    PG8_WAIT_V(2); PG8_BAR;
    PG8_STAGE(PG8_SB(1, 0), cB + kstep, voffB); PG8_STAGEA(PG8_SA(1, 0), cA + kstep, 0); PG8_STAGE(PG8_SB(1, 1), cB + hstep + kstep, voffB);
    PG8_WAIT_V(6); PG8_BAR;
    for (;;) {
        const bool has_next = S.next(ui + 1, nxt);
        const char* nB = has_next ? (const char*)g.Bt + (size_t)S.bbase(nxt, K) * 2 : cB;
        const char* nA = (Sched::GATHER || !has_next) ? cA : Ab + (size_t)(unsigned)__builtin_amdgcn_readfirstlane((int)S.arow(nxt, 0)) * K * 2;
#pragma unroll 1
        for (int t = 0; t < nt; t += 2) {
            const bool last = (t == nt - 2);
            const char* a1 = cA + (size_t)(t + 1) * kstep;
            const char* a2 = last ? nA : cA + (size_t)(t + 2) * kstep; const char* b2 = last ? nB : cB + (size_t)(t + 2) * kstep;
            const char* a3 = a2 + kstep; const char* b3 = b2 + kstep;
            PG8_LDB(B0, 0, 0); PG8_LDB(B1, 0, 1); PG8_SCHED; PG8_LDA(At, 0, 0); PG8_STAGEA(PG8_SA(1, 1), a1, 1);
            PG8_WAIT_V(8); PG8_WAIT_L(0); PG8_BAR; PG8_MMA(0, 0, At, B0); PG8_MMA(0, 1, At, B1); PG8_BAR; PG8_SCHED;
            if constexpr (Sched::GATHER) { if (last && has_next) { int tq = tid; asm volatile("" : "+v"(tq)); PG8_ROWOFFS(vcur, nxt, tq); } }
            PG8_LDA(At, 0, 1); PG8_STAGE(PG8_SB(0, 0), b2, voffB); PG8_STAGE(PG8_SB(0, 1), b2 + hstep, voffB); PG8_STAGEA(PG8_SA(0, 0), a2, 0);
            PG8_WAIT_V(8); PG8_WAIT_L(0); PG8_BAR; if (!cur.hf) { PG8_MMA(1, 0, At, B0); PG8_MMA(1, 1, At, B1); } PG8_BAR; PG8_SCHED;
            PG8_LDB(B0, 1, 0); PG8_LDB(B1, 1, 1); PG8_SCHED; PG8_LDA(At, 1, 0); PG8_STAGEA(PG8_SA(0, 1), a2, 1);
            PG8_WAIT_V(8); PG8_WAIT_L(0); PG8_BAR; PG8_MMA(0, 0, At, B0); PG8_MMA(0, 1, At, B1); PG8_BAR; PG8_SCHED;
            PG8_LDA(At, 1, 1); PG8_STAGE(PG8_SB(1, 0), b3, voffB); PG8_STAGE(PG8_SB(1, 1), b3 + hstep, voffB); PG8_STAGEA(PG8_SA(1, 0), a3, 0);
            PG8_WAIT_V(8); PG8_WAIT_L(0); PG8_BAR; if (!cur.hf) { PG8_MMA(1, 0, At, B0); PG8_MMA(1, 1, At, B1); } PG8_BAR; PG8_SCHED;
        }
        if (wr == 0) PG8_BAR;
        { int tz = tid; asm volatile("" : "+v"(tz)); const int ln = tz & 63; E(acc, cur, wr, wc, ln & 15, ln >> 4); }
        if (!has_next) break;
#pragma unroll
        for (int a = 0; a < 2; ++a)
#pragma unroll
            for (int b = 0; b < 2; ++b)
#pragma unroll
                for (int m = 0; m < 4; ++m)
#pragma unroll
                    for (int n = 0; n < 2; ++n) acc[a][b][m][n] = (f32x4){zf, zf, zf, zf};
        cur = nxt; cB = nB; cA = nA; ++ui;
        if (wr == 1) PG8_BAR;
    }
    PG8_WAIT_V(0);
    PG8_BAR;
#undef PG8_SA
#undef PG8_SB
#undef PG8_STAGE
#undef PG8_LDA
#undef PG8_LDB
#undef PG8_MMA
#undef PG8_WAIT_V
#undef PG8_WAIT_L
#undef PG8_BAR
#undef PG8_SCHED
#undef PG8_ROWOFFS
#undef PG8_STAGEA
}

#define EPI_LOOP for (int ai = 0; ai < 2; ++ai) for (int m = 0; m < 4; ++m) for (int bj = 0; bj < 2; ++bj) for (int n = 0; n < 2; ++n)
struct EpiBf16 {
    bf16_t* O; int ldc;
    __device__ __forceinline__ void operator()(const f32x4 (&acc)[2][2][4][2], const Unit& u, int wr, int wc, int fr, int fq) const {
        const int row0 = u.pm * BM + wr * 64 + fr, col0 = u.pn * BM + wc * 32 + 4 * fq;
#pragma unroll
        for (int ai = 0; ai < 2; ++ai)
#pragma unroll
            for (int m = 0; m < 4; ++m) { bf16_t* rowp = O + (size_t)(row0 + ai * HALF + m * 16) * ldc + col0;
#pragma unroll
                for (int bj = 0; bj < 2; ++bj)
#pragma unroll
                    for (int n = 0; n < 2; ++n) { const f32x4 v = acc[ai][bj][m][n]; u32x2 o; o.x = pk2(v[0], v[1]); o.y = pk2(v[2], v[3]); *(u32x2*)(rowp + bj * HALF + n * 16) = o; } }
    }
};
struct EpiOdd {
    bf16_t* P; bf16_t* Q; bf16_t* KA; const float* rope;
    __device__ __forceinline__ void operator()(const f32x4 (&acc)[2][2][4][2], const Unit& u, int wr, int wc, int fr, int fq) const {
        const int row0 = u.pm * BM + wr * 64 + fr, col0 = u.pn * BM + wc * 32 + 4 * fq;
        if (u.pn >= 6) {
#pragma unroll
            for (int ai = 0; ai < 2; ++ai)
#pragma unroll
                for (int m = 0; m < 4; ++m) { bf16_t* rowp = P + (size_t)(row0 + ai * HALF + m * 16) * P_LD + col0;
#pragma unroll
                    for (int bj = 0; bj < 2; ++bj)
#pragma unroll
                        for (int n = 0; n < 2; ++n) { const f32x4 v = acc[ai][bj][m][n]; u32x2 o; o.x = pk2(v[0], v[1]); o.y = pk2(v[2], v[3]); *(u32x2*)(rowp + bj * HALF + n * 16) = o; } }
            return;
        }
        const bool isk = u.pn >= 3, isctx = u.pm >= NLAT / BM; const int axis = wc & 1;
        const int cq = col0 - (isk ? 768 : 0);
        f32x4 csr[2][4], snr[2][4];
#pragma unroll
        for (int ai = 0; ai < 2; ++ai)
#pragma unroll
            for (int m = 0; m < 4; ++m) { const int row = row0 + ai * HALF + m * 16; csr[ai][m] = (f32x4){1.f, 1.f, 1.f, 1.f}; snr[ai][m] = (f32x4){0.f, 0.f, 0.f, 0.f};
                if (!isctx) { const int t = row & (TT - 1); const int pos = axis ? 128 + (t & 63) : (t >> 6);
                    csr[ai][m] = *(const f32x4*)(rope + pos * 16 + 4 * fq); snr[ai][m] = *(const f32x4*)(rope + 192 * 16 + pos * 16 + 4 * fq); } }
#pragma unroll
        for (int ai = 0; ai < 2; ++ai)
#pragma unroll
            for (int m = 0; m < 4; ++m) { const int row = row0 + ai * HALF + m * 16;
                const f32x4 cs = csr[ai][m], sn = snr[ai][m]; size_t orow;
                if (!isctx) { const int t = row & (TT - 1); orow = isk ? (size_t)(row >> 13) * LKEYS + CTXL + t : (size_t)row; }
                else { const int rc = row - NLAT; orow = isk ? (size_t)(rc >> 8) * LKEYS + (rc & 255) : (size_t)row; }
                bf16_t* op = (isk ? KA : Q) + orow * 768 + cq; const float sc = isk ? 1.f : QSCALE;
#pragma unroll
                for (int bj = 0; bj < 2; ++bj) { const f32x4 x1 = acc[ai][bj][m][0], x2 = acc[ai][bj][m][1];
                    const f32x4 o1 = (x1 * cs - x2 * sn) * sc, o2 = (x1 * sn + x2 * cs) * sc;
                    u32x2 a; a.x = pk2(o1[0], o1[1]); a.y = pk2(o1[2], o1[3]); *(u32x2*)(op + bj * HALF) = a;
                    u32x2 b; b.x = pk2(o2[0], o2[1]); b.y = pk2(o2[2], o2[3]); *(u32x2*)(op + bj * HALF + 16) = b; } }
    }
};
struct EpiRes {
    float* X; const float* modl; const float* xin; const float* cin;
    __device__ __forceinline__ void operator()(const f32x4 (&acc)[2][2][4][2], const Unit& u, int wr, int wc, int fr, int fq) const {
        const int row0 = u.pm * BM + wr * 64 + fr, col0 = u.pn * BM + wc * 32 + 4 * fq;
        const int mi = (u.pm * BM < NLAT) ? (u.pm * BM) / TT : 4;
        const float* gate = modl + mi * 6144 + 2 * DM;
        const float* rsrc = (u.pm * BM < NLAT) ? xin : cin - (size_t)NLAT * DM;
        f32x4 gv[2][2];
#pragma unroll
        for (int bj = 0; bj < 2; ++bj)
#pragma unroll
            for (int n = 0; n < 2; ++n) gv[bj][n] = *(const f32x4*)(gate + col0 + bj * HALF + n * 16);
#pragma unroll
        for (int ai = 0; ai < 2; ++ai) { f32x4 xr[4][2][2];
#pragma unroll
            for (int m = 0; m < 4; ++m) { const float* rowp = rsrc + (size_t)(row0 + ai * HALF + m * 16) * DM + col0;
#pragma unroll
                for (int bj = 0; bj < 2; ++bj)
#pragma unroll
                    for (int n = 0; n < 2; ++n) xr[m][bj][n] = *(const f32x4*)(rowp + bj * HALF + n * 16); }
#pragma unroll
            for (int m = 0; m < 4; ++m) { float* rowp = X + (size_t)(row0 + ai * HALF + m * 16) * DM + col0;
#pragma unroll
                for (int bj = 0; bj < 2; ++bj)
#pragma unroll
                    for (int n = 0; n < 2; ++n) *(f32x4*)(rowp + bj * HALF + n * 16) = xr[m][bj][n] * ALPHA_DN + gv[bj][n] * acc[ai][bj][m][n]; } }
    }
};
struct EpiSwiGLU {
    bf16_t* HID;
    __device__ __forceinline__ void operator()(const f32x4 (&acc)[2][2][4][2], const Unit& u, int wr, int wc, int fr, int fq) const {
        const int row0 = u.pm * BM + wr * 64 + fr, f0 = u.pn * HALF + wc * 32 + 4 * fq;
#pragma unroll
        for (int ai = 0; ai < 2; ++ai) if (ai == 0 || !u.hf)
#pragma unroll
            for (int m = 0; m < 4; ++m) { bf16_t* rowp = HID + (size_t)(row0 + ai * HALF + m * 16) * D_EXP + f0;
#pragma unroll
                for (int n = 0; n < 2; ++n) { const f32x4 a = acc[ai][0][m][n], b = acc[ai][1][m][n]; float h[4];
#pragma unroll
                    for (int j = 0; j < 4; ++j) h[j] = a[j] / (1.f + __expf(-a[j])) * b[j];
                    u32x2 o; o.x = pk2(h[0], h[1]); o.y = pk2(h[2], h[3]); *(u32x2*)(rowp + n * 16) = o; } }
    }
};
struct EpiYE {
    bf16_t* YE; const float* gate;
    __device__ __forceinline__ void operator()(const f32x4 (&acc)[2][2][4][2], const Unit& u, int wr, int wc, int fr, int fq) const {
        const int row0 = u.pm * BM + wr * 64 + fr, col0 = u.pn * BM + wc * 32 + 4 * fq;
        float gts[2][4];
#pragma unroll
        for (int ai = 0; ai < 2; ++ai)
#pragma unroll
            for (int m = 0; m < 4; ++m) gts[ai][m] = gate[row0 + ai * HALF + m * 16];
#pragma unroll
        for (int ai = 0; ai < 2; ++ai) if (ai == 0 || !u.hf)
#pragma unroll
            for (int m = 0; m < 4; ++m) { const int row = row0 + ai * HALF + m * 16; const float gt = gts[ai][m]; bf16_t* rowp = YE + (size_t)row * DM + col0;
#pragma unroll
                for (int bj = 0; bj < 2; ++bj)
#pragma unroll
                    for (int n = 0; n < 2; ++n) { const f32x4 v = acc[ai][bj][m][n] * gt; u32x2 o; o.x = pk2(v[0], v[1]); o.y = pk2(v[2], v[3]); *(u32x2*)(rowp + bj * HALF + n * 16) = o; } }
    }
};
struct EpiLora {
    unsigned char* SCN; bf16_t* G; const float* decay0; const float* a0; const float* kalpha;
    __device__ __forceinline__ void operator()(const f32x4 (&acc)[2][2][4][2], const Unit& u, int wr, int wc, int fr, int fq) const {
        const int row0 = u.pm * BM + wr * 64 + fr;
        const int seg = u.pn / 3, cb = (u.pn % 3) * BM + wc * 32 + 4 * fq;
        f32x4 par0[2][2], par1[2][2];
#pragma unroll
        for (int bj = 0; bj < 2; ++bj)
#pragma unroll
            for (int n = 0; n < 2; ++n) { const int col = cb + bj * HALF + n * 16; par0[bj][n] = (f32x4){0.f, 0.f, 0.f, 0.f}; par1[bj][n] = par0[bj][n];
                if (seg < 2) par0[bj][n] = *(const f32x4*)(decay0 + seg * 768 + col);
                else if (seg < 4) { par0[bj][n] = *(const f32x4*)(a0 + (seg - 2) * 768 + col); par1[bj][n] = *(const f32x4*)(kalpha + col); } }
#pragma unroll
        for (int bj = 0; bj < 2; ++bj)
#pragma unroll
            for (int n = 0; n < 2; ++n) {
                const int col = cb + bj * HALF + n * 16, head = col >> 6, kx = col & 63;
                if (seg < 2) {
                    const f32x4 d0 = par0[bj][n];
#pragma unroll
                    for (int ai = 0; ai < 2; ++ai)
#pragma unroll
                        for (int m = 0; m < 4; ++m) { const int row = row0 + ai * HALF + m * 16; f32x4 w;
#pragma unroll
                            for (int j = 0; j < 4; ++j) { const float lw = -DECAY_SCALE * sigmoidf_(d0[j] + acc[ai][bj][m][n][j]); w[j] = CHUNKED_SCAN ? lw : __expf(lw); }
                            *(f32x4*)(SCN + (size_t)(row * 12 + head) * SC_REC + SC_W + seg * 256 + kx * 4) = w; __builtin_amdgcn_sched_barrier(0); }
                } else if (seg < 4) {
                    const int d = seg - 2;
                    const f32x4 a00 = par0[bj][n], kal = par1[bj][n];
                    u32x2 kkr[2][4], ksr[2][4];
#pragma unroll
                    for (int ai = 0; ai < 2; ++ai)
#pragma unroll
                        for (int m = 0; m < 4; ++m) { const unsigned char* base = SCN + (size_t)((row0 + ai * HALF + m * 16) * 12 + head) * SC_REC + kx * 2;
                            kkr[ai][m] = *(const u32x2*)(base + SC_KK); ksr[ai][m] = *(const u32x2*)(base + SC_KR + 256 * d); }
#pragma unroll
                    for (int ai = 0; ai < 2; ++ai)
#pragma unroll
                        for (int m = 0; m < 4; ++m) { const int row = row0 + ai * HALF + m * 16; unsigned char* base = SCN + (size_t)(row * 12 + head) * SC_REC + kx * 2;
                            const f32x4 kk = {bflo(kkr[ai][m].x), bfhi(kkr[ai][m].x), bflo(kkr[ai][m].y), bfhi(kkr[ai][m].y)}; const f32x4 ks = {bflo(ksr[ai][m].x), bfhi(ksr[ai][m].x), bflo(ksr[ai][m].y), bfhi(ksr[ai][m].y)}; f32x4 bb, kr;
#pragma unroll
                            for (int j = 0; j < 4; ++j) { const float a = sigmoidf_(a00[j] + acc[ai][bj][m][n][j]); bb[j] = kk[j] * a; kr[j] = ks[j] * (1.f + (a - 1.f) * kal[j]); }
                            st4bf_(base + SC_B + 256 * d, bb); st4bf_(base + SC_KR + 256 * d, kr); __builtin_amdgcn_sched_barrier(0); }
                } else {
#pragma unroll
                    for (int ai = 0; ai < 2; ++ai)
#pragma unroll
                        for (int m = 0; m < 4; ++m) { const int row = row0 + ai * HALF + m * 16; const f32x4 v = acc[ai][bj][m][n]; u32x2 o; o.x = pk2(v[0], v[1]); o.y = pk2(v[2], v[3]);
                            *(u32x2*)(G + (size_t)row * 768 + col) = o; }
                }
            }
    }
};
}

struct Args { const float* in[37]; float* out; unsigned char* ws; int lo, hi; };
enum { I_X = 0, I_C, I_CTX, I_CCTX, I_WMOD, I_BMOD, I_LNG, I_LNB, I_EWIN, I_EWOUT, I_CONVW, I_MU, I_DUP, I_D0, I_AUP, I_A0, I_GUP, I_KXI, I_KAL, I_RBON, I_GNG, I_GNB,
       I_OWIN, I_OWOUT, I_LQ1, I_LK1, I_LQ2, I_LK2, I_SUBG, I_GLNG, I_GLNB, I_GWS, I_GBS, I_WR, I_WE1, I_WE3, I_WE2 };

struct Ctx {
    LAS unsigned char* lds;
    int tid, lane, wave, G, vcu, gw, NGW;
};
__device__ __forceinline__ void mkctx(Ctx& C, LAS unsigned char* lds) {
    int tid = threadIdx.x; asm volatile("" : "+v"(tid));
    C.lds = lds; C.tid = tid; C.lane = tid & 63; C.wave = __builtin_amdgcn_readfirstlane(tid >> 6);
    C.G = gridDim.x; { const int bx = blockIdx.x; C.vcu = (C.G % 8 == 0) ? (bx % 8) * (C.G / 8) + bx / 8 : bx; }
    C.gw = blockIdx.x * NWAVES + C.wave; C.NGW = C.G * NWAVES;
}
#define GLOBAL_PTR(T, v) ((T*)(__attribute__((address_space(1))) T*)(v))
__device__ __forceinline__ void ldargs(Args& A, LAS unsigned char* lds) {
    LAS const u32x2* tb = (LAS const u32x2*)(lds + LDS_PTAB); asm volatile("" : "+v"(tb));
#pragma unroll
    for (int i = 0; i < 37; ++i) { const u32x2 v = tb[i]; A.in[i] = GLOBAL_PTR(const float, ((unsigned long long)(unsigned)__builtin_amdgcn_readfirstlane((int)v.y) << 32) | (unsigned)__builtin_amdgcn_readfirstlane((int)v.x)); }
    { const u32x2 v = tb[37]; A.out = GLOBAL_PTR(float, ((unsigned long long)(unsigned)__builtin_amdgcn_readfirstlane((int)v.y) << 32) | (unsigned)__builtin_amdgcn_readfirstlane((int)v.x)); }
    { const u32x2 v = tb[38]; A.ws = GLOBAL_PTR(unsigned char, ((unsigned long long)(unsigned)__builtin_amdgcn_readfirstlane((int)v.y) << 32) | (unsigned)__builtin_amdgcn_readfirstlane((int)v.x)); }
    A.lo = 0; A.hi = 0;
}
__device__ __forceinline__ int row_mi(int row) { return row < NLAT ? (row >> 13) : 4; }

__device__ __forceinline__ void phase_init(const Ctx& C, const Args& A) {
    unsigned char* ws = A.ws;
    float* MOD = (float*)(ws + WS_MOD);
    LAS float* sv = (LAS float*)C.lds;
    LAS float* red = sv + 5 * 1024;
    for (int i = C.tid; i < 5 * 1024; i += NTHR) { const int v = i >> 10, k = i & 1023; const float c = (v < 4) ? A.in[I_C][v * DM + k] : A.in[I_CCTX][k]; sv[i] = c / (1.f + __expf(-c)); }
    __syncthreads();
    const int j = C.tid & 127, kp = C.tid >> 7;
    for (int it = blockIdx.x; it < DEPTH * 48; it += C.G) {
        const int l = it / 48, cg = it % 48, col = cg * 128 + j;
        const float* W = A.in[I_WMOD] + (size_t)l * DM * 6144 + col;
        float a0 = 0.f, a1 = 0.f, a2 = 0.f, a3 = 0.f, a4 = 0.f;
#pragma unroll 32
        for (int k = kp * 256; k < kp * 256 + 256; ++k) { const float w = W[(size_t)k * 6144];     a0 += sv[k] * w; a1 += sv[1024 + k] * w; a2 += sv[2048 + k] * w; a3 += sv[3072 + k] * w; a4 += sv[4096 + k] * w; }
        red[(kp * 5 + 0) * 128 + j] = a0; red[(kp * 5 + 1) * 128 + j] = a1; red[(kp * 5 + 2) * 128 + j] = a2; red[(kp * 5 + 3) * 128 + j] = a3; red[(kp * 5 + 4) * 128 + j] = a4;
        __syncthreads();
        for (int o = C.tid; o < 5 * 128; o += NTHR) { const int v = o >> 7, jj = o & 127; const int cc = cg * 128 + jj;
            const float s = red[(0 * 5 + v) * 128 + jj] + red[(1 * 5 + v) * 128 + jj] + red[(2 * 5 + v) * 128 + jj] + red[(3 * 5 + v) * 128 + jj];
            MOD[((size_t)l * 5 + v) * 6144 + cc] = s + A.in[I_BMOD][l * 6144 + cc]; }
        __syncthreads();
    }
    if (blockIdx.x == C.G - 1) { float* rope = (float*)(ws + WS_ROPE);
        for (int i = C.tid; i < 192 * 16; i += NTHR) { const int pos = i >> 4, j = i & 15; const float ang = (float)(pos < 128 ? pos : pos - 128) * powf(10000.f, -(float)j * (1.f / 16.f));
            rope[i] = cosf(ang); rope[192 * 16 + i] = sinf(ang); } }
}

__device__ __forceinline__ void transpose_item(const float* W, int ldw, int k0, int n0, bf16_t* WT, int ldt, int drow0, LAS float* scr, int lane) {
    { float v[64]; const float* src = W + (size_t)k0 * ldw + n0 + lane;
#pragma unroll
      for (int k = 0; k < 64; ++k) v[k] = __builtin_nontemporal_load(src + (size_t)k * ldw);
#pragma unroll
      for (int k = 0; k < 64; ++k) scr[k * 65 + lane] = v[k]; }
    asm volatile("s_waitcnt lgkmcnt(0)" ::: "memory");
    const int c = lane & 7;
#pragma unroll
    for (int j = 0; j < 8; ++j) { const int n = (lane >> 3) + 8 * j; const LAS float* s = scr + (8 * c) * 65 + n;
        u32x4 o; o.x = pk2(s[0 * 65], s[1 * 65]); o.y = pk2(s[2 * 65], s[3 * 65]); o.z = pk2(s[4 * 65], s[5 * 65]); o.w = pk2(s[6 * 65], s[7 * 65]);
        *(u32x4*)(WT + (size_t)(drow0 + n) * ldt + k0 + 8 * c) = o; }
    asm volatile("s_waitcnt lgkmcnt(0)" ::: "memory");
}
__device__ __forceinline__ void conv_items(const Ctx& C, const Args& A, int l, int gw, int NGW, bool do_in, bool do_out, bool do_exp) {
    unsigned char* ws = A.ws;
    const int i2 = l >> 1; const bool odd = (l & 1);
    LAS float* scr = (LAS float*)C.lds + C.wave * (64 * 65);
    bf16_t* WIN = (bf16_t*)(ws + WS_WIN); bf16_t* WOUT = (bf16_t*)(ws + WS_WOUT); bf16_t* WE13 = (bf16_t*)(ws + WS_WE13 + (size_t)(l & 1) * WE13_BYTES); bf16_t* WE2 = (bf16_t*)(ws + WS_WE2 + (size_t)(l & 1) * WE2_BYTES);
    const int nin = odd ? D_IN_ODD : D_IN_EVEN;
    const float* win = odd ? A.in[I_OWIN] + (size_t)i2 * DM * D_IN_ODD : A.in[I_EWIN] + (size_t)i2 * DM * D_IN_EVEN;
    const float* wout = odd ? A.in[I_OWOUT] + (size_t)i2 * DM * DM : A.in[I_EWOUT] + (size_t)i2 * DM * DM;
    const int n_in = do_in ? 16 * (nin / 64) : 0, n_out = do_out ? 16 * 16 : 0, n_e13 = do_exp ? NEXP * 2 * 16 * 32 : 0, n_e2 = do_exp ? NEXP * 32 * 16 : 0;
    const int total = n_in + n_out + n_e13 + n_e2;
    for (int it = gw; it < total; it += NGW) {
        int r = it;
        if (r < n_in) { const int nb = nin / 64, kb = r / nb, nn = r % nb; transpose_item(win, nin, kb * 64, nn * 64, WIN, DM, nn * 64, scr, C.lane); continue; } r -= n_in;
        if (r < n_out) { const int kb = r / 16, nn = r % 16; transpose_item(wout, DM, kb * 64, nn * 64, WOUT, DM, nn * 64, scr, C.lane); continue; } r -= n_out;
        if (r < n_e13) { const int e = r / 1024, q = r % 1024, mat = q / 512, q2 = q % 512, kb = q2 / 32, nn = q2 % 32;
            const float* W = (mat ? A.in[I_WE3] : A.in[I_WE1]) + ((size_t)l * NEXP + e) * DM * D_EXP;
            const int f0 = nn * 64; const int drow = (f0 >> 7) * 256 + mat * 128 + (f0 & 127);
            transpose_item(W, D_EXP, kb * 64, f0, WE13 + (size_t)e * 4096 * DM, DM, drow, scr, C.lane); continue; } r -= n_e13;
        { const int e = r / 512, q = r % 512, kb = q / 16, nn = q % 16;
            const float* W = A.in[I_WE2] + ((size_t)l * NEXP + e) * D_EXP * DM;
            transpose_item(W, DM, kb * 64, nn * 64, WE2 + (size_t)e * DM * D_EXP, D_EXP, nn * 64, scr, C.lane); }
    }
}
__device__ __forceinline__ void phase_conv(const Ctx& C, const Args& A, int l) {
    unsigned char* ws = A.ws;
    const int i2 = l >> 1; const bool odd = (l & 1);
    bf16_t* WIN = (bf16_t*)(ws + WS_WIN);
    const bool early = CHUNKED_SCAN && odd;
    if (l > 0) conv_items(C, A, l, C.gw, C.NGW, !early, true, !early);
    if (!odd) {
        u32x4* z = (u32x4*)(WIN + (size_t)D_IN_EVEN * DM);
        unsigned zz = 0u; asm volatile("" : "+v"(zz));
        for (int i = blockIdx.x * NTHR + C.tid; i < (D_IN_EVEN_PAD - D_IN_EVEN) * DM / 8; i += C.G * NTHR) z[i] = (u32x4){zz, zz, zz, zz};
        bf16_t* WL = (bf16_t*)(ws + WS_WLORA);
        const float* dup = A.in[I_DUP] + (size_t)i2 * 2 * 64 * 768; const float* aup = A.in[I_AUP] + (size_t)i2 * 2 * 64 * 768; const float* gup = A.in[I_GUP] + (size_t)i2 * 128 * 768;
        for (int i = blockIdx.x * NTHR + C.tid; i < LORA_N * LORA_K; i += C.G * NTHR) {
            const int kk = i / LORA_N, n = i % LORA_N, seg = n / 768, col = n % 768; float v = 0.f;
            if (seg == 0) { if (kk < 64) v = dup[(size_t)(0 * 64 + kk) * 768 + col]; }
            else if (seg == 1) { if (kk >= 64 && kk < 128) v = dup[(size_t)(1 * 64 + kk - 64) * 768 + col]; }
            else if (seg == 2) { if (kk >= 128 && kk < 192) v = aup[(size_t)(0 * 64 + kk - 128) * 768 + col]; }
            else if (seg == 3) { if (kk >= 192 && kk < 256) v = aup[(size_t)(1 * 64 + kk - 192) * 768 + col]; }
            else { if (kk >= 256) v = gup[(size_t)(kk - 256) * 768 + col]; }
            WL[(size_t)n * LORA_K + kk] = (bf16_t)f2bf(v);
        }
    }
}

__device__ __forceinline__ void phase_modh(const Ctx& C, const Args& A, int l) {
    bf16_t* H = (bf16_t*)(A.ws + WS_H); const float* MOD = (const float*)(A.ws + WS_MOD) + (size_t)l * 5 * 6144;
    const float* xin = A.in[I_X]; const float* cin = A.in[I_CTX] - (size_t)NLAT * DM;
#define MODH_SRC(row_) (((row_) < NLAT ? xin : cin) + (size_t)(row_) * DM)
    const int row0 = (int)(((long)C.gw * MROWS) / C.NGW), row1 = (int)(((long)(C.gw + 1) * MROWS) / C.NGW);
    f32x4 shr[4], scr_[4], xn[4]; int cmi = -1;
    if (row0 < row1) {
#pragma unroll
        for (int j = 0; j < 4; ++j) xn[j] = *(const f32x4*)(MODH_SRC(row0) + 4 * C.lane + 256 * j); }
#pragma unroll
    for (int j = 0; j < 4; ++j) { shr[j] = (f32x4){0.f, 0.f, 0.f, 0.f}; scr_[j] = shr[j]; }
    for (int row = row0; row < row1; ++row) {
        const int mi = row_mi(row);
        if (mi != cmi) { cmi = mi; const float* md = MOD + mi * 6144;
#pragma unroll
            for (int j = 0; j < 4; ++j) { const int col = 4 * C.lane + 256 * j; shr[j] = *(const f32x4*)(md + col); scr_[j] = *(const f32x4*)(md + DM + col) + 1.f; } }
        f32x4 x[4];
#pragma unroll
        for (int j = 0; j < 4; ++j) x[j] = xn[j];
        if (row + 1 < row1) {
#pragma unroll
            for (int j = 0; j < 4; ++j) xn[j] = *(const f32x4*)(MODH_SRC(row + 1) + 4 * C.lane + 256 * j); }
#pragma unroll
        for (int j = 0; j < 4; ++j) { const int col = 4 * C.lane + 256 * j; const f32x4 h = x[j] * scr_[j] + shr[j]; u32x2 o; o.x = pk2(h[0], h[1]); o.y = pk2(h[2], h[3]); *(u32x2*)(H + (size_t)row * DM + col) = o; }
    }
}

__device__ __forceinline__ f32x4 ld4bf(const bf16_t* p) { const u32x2 u = *(const u32x2*)p; return (f32x4){bflo(u.x), bfhi(u.x), bflo(u.y), bfhi(u.y)}; }
__device__ __forceinline__ void st4bf(bf16_t* p, f32x4 v) { u32x2 o; o.x = pk2(v[0], v[1]); o.y = pk2(v[2], v[3]); *(u32x2*)p = o; }
__device__ __forceinline__ void seq_info(int row, bool& hasp, bool& hasn) {
    if (row < NLAT) { const int t = row & (TT - 1); hasp = t > 0; hasn = t < TT - 1; }
    else { const int t = (row - NLAT) & (CTXL - 1); hasp = t > 0; hasn = t < CTXL - 1; }
}
struct Ef1Row { u32x2 bg, ua, ub, m[11]; };
__device__ __forceinline__ f32x4 bf4(u32x2 u) { return (f32x4){bflo(u.x), bfhi(u.x), bflo(u.y), bfhi(u.y)}; }
__device__ __forceinline__ void ef1_load(Ef1Row& R, const bf16_t* P, int row, int lane) {
    row = row < 0 ? 0 : row > MROWS - 1 ? MROWS - 1 : row;
    const bf16_t* p = P + (size_t)row * P_LD + 4 * lane;
    R.bg = *(const u32x2*)p; R.ua = *(const u32x2*)(p + 256); R.ub = *(const u32x2*)(p + 512);
#pragma unroll
    for (int it = 0; it < 11; ++it) R.m[it] = *(const u32x2*)(p + 768 + it * 256);
}
__device__ __forceinline__ void phase_ef1(const Ctx& C, const Args& A, int l) {
    const int i2 = l >> 1; unsigned char* ws = A.ws;
    const bf16_t* P = (const bf16_t*)(ws + WS_P); bf16_t* A2 = (bf16_t*)(ws + WS_A2); unsigned char* SCN = ws + WS_SCN; bf16_t* LIN = (bf16_t*)(ws + WS_LIN);
    const float* cw = A.in[I_CONVW] + (size_t)i2 * 3 * 256; const float* mu = A.in[I_MU] + (size_t)i2 * RWKV_COLS; const float* kxi = A.in[I_KXI] + (size_t)i2 * 768;
    const int j4 = 4 * C.lane;
    const f32x4 w0 = *(const f32x4*)(cw + j4), w1 = *(const f32x4*)(cw + 256 + j4), w2 = *(const f32x4*)(cw + 512 + j4);
    f32x4 mur[11], kxr[3];
#pragma unroll
    for (int it = 0; it < 11; ++it) mur[it] = (it * 256 + j4 < RWKV_COLS) ? *(const f32x4*)(mu + it * 256 + j4) : (f32x4){0.f, 0.f, 0.f, 0.f};
#pragma unroll
    for (int it = 0; it < 3; ++it) kxr[it] = *(const f32x4*)(kxi + it * 256 + j4);
    const int row0 = (int)(((long)C.gw * MROWS) / C.NGW), row1 = (int)(((long)(C.gw + 1) * MROWS) / C.NGW);
    Ef1Row Ra, Rb, Rc, Rd;
    ef1_load(Ra, P, row0 - 1, C.lane); ef1_load(Rb, P, row0, C.lane); ef1_load(Rc, P, row0 + 1, C.lane);
    for (int row = row0; row < row1; ++row) {
        ef1_load(Rd, P, row + 2, C.lane);
        bool hasp, hasn; seq_info(row, hasp, hasn);
        const float fp = hasp ? 1.f : 0.f, fn = hasn ? 1.f : 0.f;
        {
            const f32x4 bg = bf4(Rb.bg), u0 = bf4(Rb.ua) * bf4(Rb.ub), um = bf4(Ra.ua) * bf4(Ra.ub) * fp, up = bf4(Rc.ua) * bf4(Rc.ub) * fn;
            st4bf(A2 + (size_t)row * DM + j4, bg * (w0 * um + w1 * u0 + w2 * up));
        }
#pragma unroll
        for (int it = 0; it < 11; ++it) {
            const int c = it * 256 + j4;
            if (c < RWKV_COLS) {
                const f32x4 x0 = bf4(Rb.m[it]), xm = bf4(Ra.m[it]) * fp, xp = bf4(Rc.m[it]) * fn, m4 = mur[it];
                const f32x4 ps = x0 + m4 * ((xm + xp) * 0.5f - x0);
                if (it < 3) { const int head = c >> 6, kx = c & 63; st4bf_(SCN + (size_t)(row * 12 + head) * SC_REC + SC_R + kx * 2, ps); }
                else if (it < 6) { const int c1 = c - 768, head = c1 >> 6, kx = c1 & 63; const f32x4 kv = ps * kxr[it < 6 ? (it >= 3 ? it - 3 : 0) : 0];
                    const float ss = sum16(kv[0] * kv[0] + kv[1] * kv[1] + kv[2] * kv[2] + kv[3] * kv[3]); const float rn = rsqrtf(ss + 1e-12f);
                    unsigned char* base = SCN + (size_t)(row * 12 + head) * SC_REC + kx * 2;
                    st4bf_(base + SC_KK, kv * rn); st4bf_(base + SC_KR, ps); st4bf_(base + SC_KR + 256, ps); }
                else if (it < 9) { const int c1 = c - 1536, head = c1 >> 6, kx = c1 & 63; st4bf_(SCN + (size_t)(row * 12 + head) * SC_REC + SC_V + kx * 2, ps); }
                else { const int c1 = c - 2304; f32x4 o;
                    if (c1 < 128) { o = (f32x4){tanhf(ps[0]), tanhf(ps[1]), tanhf(ps[2]), tanhf(ps[3])}; }
                    else if (c1 < 256) { o = ps; }
                    else { o = (f32x4){sigmoidf_(ps[0]), sigmoidf_(ps[1]), sigmoidf_(ps[2]), sigmoidf_(ps[3])}; }
                    st4bf(LIN + (size_t)row * LORA_K + c1, o); }
            }
        }
        Ra = Rb; Rb = Rc; Rc = Rd;
    }
}

__device__ __forceinline__ int scan_row(int i, int b, int d) {
    if (d == 0) return i < CTXL ? NLAT + b * CTXL + i : b * TT + (i - CTXL);
    return i < CTXL ? NLAT + b * CTXL + (CTXL - 1 - i) : b * TT + (TT - 1 - (i - CTXL));
}
__device__ __forceinline__ float red8(float v) {
    v += __uint_as_float((unsigned)__builtin_amdgcn_update_dpp(0, (int)__float_as_uint(v), 0xB1, 0xF, 0xF, true));
    v += __uint_as_float((unsigned)__builtin_amdgcn_update_dpp(0, (int)__float_as_uint(v), 0x4E, 0xF, 0xF, true));
    v += __uint_as_float((unsigned)__builtin_amdgcn_update_dpp(0, (int)__float_as_uint(v), 0x141, 0xF, 0xF, true));
    return v;
}
__device__ __forceinline__ float red16(float v) {
    v += __uint_as_float((unsigned)__builtin_amdgcn_update_dpp(0, (int)__float_as_uint(v), 0xB1, 0xF, 0xF, true));
    v += __uint_as_float((unsigned)__builtin_amdgcn_update_dpp(0, (int)__float_as_uint(v), 0x4E, 0xF, 0xF, true));
    v += __uint_as_float((unsigned)__builtin_amdgcn_update_dpp(0, (int)__float_as_uint(v), 0x141, 0xF, 0xF, true));
    v += __uint_as_float((unsigned)__builtin_amdgcn_update_dpp(0, (int)__float_as_uint(v), 0x140, 0xF, 0xF, true));
    return v;
}
__device__ __forceinline__ void phase_scan(const Ctx& C, const Args& A) {
    for (int u = blockIdx.x; u < 192; u += C.G) {
    const int half = u & 1, d = (u >> 1) & 1, h = (u >> 2) % 12, b = u / 48;
    const unsigned char* SCN = A.ws + WS_SCN; float* Y = (float*)(A.ws + WS_Y) + (size_t)d * MROWS * 768;
    LAS float* buf = (LAS float*)C.lds; LAS float* ybuf = buf + 2 * 32 * 352;
    constexpr int NCH = LKEYS / 32;
    u32x4 st[4];
    int ps_[4], psrc[4], pdst[4]; bool pf32[4];
#pragma unroll
    for (int j = 0; j < 4; ++j) { const int p = C.tid + NTHR * j; const int s = p / 52, q = p % 52; ps_[j] = s;
        if (q < 16) { psrc[j] = SC_W + 256 * d + q * 16; pdst[j] = s * 352 + q * 4; pf32[j] = true; }
        else if (q < 48) { const int vec = (q - 16) >> 3, part = (q - 16) & 7; const int so = vec == 0 ? SC_KK : vec == 1 ? SC_B + 256 * d : vec == 2 ? SC_KR + 256 * d : SC_R;
            psrc[j] = so + part * 16; pdst[j] = s * 352 + 64 * (vec + 1) + part * 8; pf32[j] = false; }
        else { const int part = q - 48; psrc[j] = SC_V + half * 64 + part * 16; pdst[j] = s * 352 + 320 + part * 8; pf32[j] = false; } }
    const int sgn = d ? -1 : 1;
    const unsigned char* SCNh = SCN + (size_t)h * SC_REC;
#define SCAN_ROW0(c) (((c) * 32 < CTXL) ? (NLAT + b * CTXL + (d ? CTXL - 1 - (c) * 32 : (c) * 32)) : (b * TT + (d ? TT - 1 - ((c) * 32 - CTXL) : (c) * 32 - CTXL)))
#define SCAN_LOADG(c) do { const int row0_ = SCAN_ROW0(c); _Pragma("unroll") for (int j = 0; j < 4; ++j) if (j < 3 || C.tid < 1664 - 3 * NTHR) { \
        st[j] = *(const u32x4*)(SCNh + (size_t)(row0_ + sgn * ps_[j]) * SC_ROW + psrc[j]); } } while (0)
#define SCAN_STORE(bi) do { _Pragma("unroll") for (int j = 0; j < 4; ++j) if (j < 3 || C.tid < 1664 - 3 * NTHR) { LAS float* dp = buf + (bi) * (32 * 352) + pdst[j]; \
        if (pf32[j]) *(LAS u32x4*)dp = st[j]; \
        else { *(LAS f32x4*)dp = (f32x4){bflo(st[j].x), bfhi(st[j].x), bflo(st[j].y), bfhi(st[j].y)}; *(LAS f32x4*)(dp + 4) = (f32x4){bflo(st[j].z), bfhi(st[j].z), bflo(st[j].w), bfhi(st[j].w)}; } } } while (0)
    SCAN_LOADG(0); SCAN_STORE(0); __syncthreads();
    f32x2 Sa = {0.f, 0.f}, Sb = {0.f, 0.f};
    const int rl = C.lane >> 4, ks = C.lane & 15;
    float ycol = 0.f;
#define SC_LD(R, s) do { const LAS float* bp_ = cur + (s) * 352 + ks * 4; \
        R##w = *(const LAS f32x4*)(bp_); R##k = *(const LAS f32x4*)(bp_ + 64); R##b = *(const LAS f32x4*)(bp_ + 128); R##q = *(const LAS f32x4*)(bp_ + 192); R##r = *(const LAS f32x4*)(bp_ + 256); \
        R##vv = cur[(s) * 352 + 320 + C.wave * 4 + rl]; } while (0)
#define SC_LO(v) ((f32x2){v[0], v[1]})
#define SC_HI(v) ((f32x2){v[2], v[3]})
#define SC_DPP(x, ctrl) __uint_as_float((unsigned)__builtin_amdgcn_update_dpp(0, (int)__float_as_uint(x), ctrl, 0xF, 0xF, true))
#define SC_STEP(R, P, s) do { \
        f32x2 pa = __builtin_elementwise_fma(Sb, SC_HI(R##k), Sa * SC_LO(R##k)), py = __builtin_elementwise_fma(Sb, SC_HI(P##r), Sa * SC_LO(P##r)); \
        float a_ = pa.x + pa.y, y_ = py.x + py.y; \
        a_ += SC_DPP(a_, 0xB1); y_ += SC_DPP(y_, 0xB1); a_ += SC_DPP(a_, 0x4E); y_ += SC_DPP(y_, 0x4E); \
        a_ += SC_DPP(a_, 0x141); y_ += SC_DPP(y_, 0x141); a_ += SC_DPP(a_, 0x140); y_ += SC_DPP(y_, 0x140); \
        ycol = (ks == ((s) & 15)) ? y_ : ycol; \
        const f32x2 na = {-a_, -a_}, vv2 = {R##vv, R##vv}; \
        Sa = __builtin_elementwise_fma(Sa, SC_LO(R##w), __builtin_elementwise_fma(na, SC_LO(R##b), vv2 * SC_LO(R##q))); \
        Sb = __builtin_elementwise_fma(Sb, SC_HI(R##w), __builtin_elementwise_fma(na, SC_HI(R##b), vv2 * SC_HI(R##q))); } while (0)
    f32x4 Aw, Ak, Ab, Aq, Ar, Bw, Bk, Bb, Bq, Br, Cw, Ck, Cb, Cq, Cr, Dw, Dk, Db, Dq, Dr; float Avv, Bvv, Cvv, Dvv;
    Dr = (f32x4){0.f, 0.f, 0.f, 0.f};
    for (int c = 0; c < NCH; ++c) {
        if (c + 1 < NCH) SCAN_LOADG(c + 1);
        {
            const LAS float* cur = buf + (c & 1) * (32 * 352);
            LAS float* yb = ybuf + (c & 1) * 1024 + C.wave * 4 + rl + ks * 32;
            SC_LD(A, 0); SC_LD(B, 1);
#pragma unroll 1
            for (int s = 0; s < 32; s += 4) {
                SC_LD(C, s + 2); __builtin_amdgcn_sched_barrier(0); SC_STEP(A, D, s); __builtin_amdgcn_sched_barrier(0);
                SC_LD(D, s + 3); __builtin_amdgcn_sched_barrier(0); SC_STEP(B, A, s + 1); __builtin_amdgcn_sched_barrier(0);
                SC_LD(A, s + 4); __builtin_amdgcn_sched_barrier(0); SC_STEP(C, B, s + 2); __builtin_amdgcn_sched_barrier(0);
                SC_LD(B, s + 5); __builtin_amdgcn_sched_barrier(0); SC_STEP(D, C, s + 3); __builtin_amdgcn_sched_barrier(0);
                if ((s & 15) == 12) yb[(s & 16) * 32] = ycol;
            }
        }
        if (c + 1 < NCH) SCAN_STORE((c + 1) & 1);
        __syncthreads();
        { const int row0_ = SCAN_ROW0(c);
#pragma unroll
          for (int i = 0; i < 2; ++i) { const int e = C.tid + NTHR * i, s = e >> 5, r = e & 31;
            const int row = (s > 0) ? row0_ + sgn * (s - 1) : scan_row(c * 32 - 1, b, d);
            if (s > 0 || c > 0) Y[(size_t)row * 768 + h * 64 + half * 32 + r] = ybuf[(c & 1) * 1024 + e]; } }
    }
    {
        f32x2 py = __builtin_elementwise_fma(Sb, SC_HI(Dr), Sa * SC_LO(Dr)); float y_ = py.x + py.y;
        y_ += SC_DPP(y_, 0xB1); y_ += SC_DPP(y_, 0x4E); y_ += SC_DPP(y_, 0x141); y_ += SC_DPP(y_, 0x140);
        if (ks == 0) Y[(size_t)scan_row(LKEYS - 1, b, d) * 768 + h * 64 + half * 32 + C.wave * 4 + rl] = y_;
    }
    __syncthreads();
    }
#undef SCAN_LOADG
#undef SCAN_STORE
#undef SCAN_ROW0
#undef SC_LD
#undef SC_STEP
#undef SC_LO
#undef SC_HI
#undef SC_DPP
}

constexpr int CSP = 72;
constexpr int CS_MAT = 64 * CSP * 2;
constexpr int CS_WT = 0, CS_KB = CS_MAT, CS_BB = 2 * CS_MAT, CS_RT = 3 * CS_MAT, CS_BHT = 4 * CS_MAT, CS_KHT = 5 * CS_MAT, CS_VMT = 6 * CS_MAT;
constexpr int CS_M2F = 7 * CS_MAT;
constexpr int CS_M1T = CS_M2F + 16384;
constexpr int CS_N2 = CS_M1T + CS_MAT;
constexpr int CS_GT = CS_N2 + CS_MAT;
constexpr int CS_Z = CS_M2F, CS_U = CS_M2F + CS_MAT;
constexpr int CS_GL = CS_GT + 2 * CS_MAT;
static_assert(CS_GL + 256 <= LDS_MISC, "chunked-scan LDS map");
template <bool SWZB = false>
__device__ __forceinline__ void cs_mma(f32x16& acc, const LAS unsigned char* Am, const LAS unsigned char* Bm, int ti, int tj, int r32, int hi) {
    const LAS unsigned char* ap = Am + (ti * 32 + r32) * (CSP * 2) + hi * 16; const int brow = tj * 32 + r32; const LAS unsigned char* bp = Bm + brow * (CSP * 2);
    const int sw = SWZB ? ((brow >> 3) & 7) : 0;
#pragma unroll
    for (int ks = 0; ks < 4; ++ks) acc = __builtin_amdgcn_mfma_f32_32x32x16_bf16(*(const LAS bf16x8*)(ap + ks * 32), *(const LAS bf16x8*)(bp + (((ks * 2 + hi) ^ sw) * 16)), acc, 0, 0, 0);
}
__device__ __forceinline__ void cs_store_t(LAS unsigned char* Om, const f32x16& acc, int ti, int tj, int r32, int hi) {
    LAS unsigned char* op = Om + (tj * 32 + r32) * (CSP * 2) + (ti * 32 + 4 * hi) * 2;
#pragma unroll
    for (int g = 0; g < 4; ++g) { u32x2 o; o.x = pk2(acc[4 * g], acc[4 * g + 1]); o.y = pk2(acc[4 * g + 2], acc[4 * g + 3]); *(LAS u32x2*)(op + g * 16) = o; }
}
#define CS_BAR() asm volatile("s_waitcnt lgkmcnt(0)\n\ts_barrier" ::: "memory")
__device__ __forceinline__ void phase_csa(const Ctx& C, const Args& A) {
    const unsigned char* SCN = A.ws + WS_SCN; unsigned char* CHK = A.ws + WS_CHK;
    LAS unsigned char* L = C.lds;
    const int r32 = C.lane & 31, hi = C.lane >> 5;
    float lwv[8]; u32x4 ukk, ub, ukr, ur, uv;
#define CSA_GEOM(cu_) const int unit = (cu_) / CS_NCH, ch = (cu_) % CS_NCH; const int d = unit & 1, h = (unit >> 1) % 12, b = unit / 24; \
        const int step0 = ch * CS_L; const int sgn = d ? -1 : 1; \
        const int row0 = (step0 < CTXL) ? (NLAT + b * CTXL + (d ? CTXL - 1 - step0 : step0)) : (b * TT + (d ? TT - 1 - (step0 - CTXL) : step0 - CTXL)); \
        const unsigned char* rec0 = SCN + (size_t)row0 * SC_ROW + (size_t)h * SC_REC;
#define CSA_LOAD(cu_) do { CSA_GEOM(cu_); \
        { const int k = C.tid & 63, sg = C.tid >> 6; _Pragma("unroll") for (int j = 0; j < 8; ++j) lwv[j] = *(const float*)(rec0 + (long)sgn * (8 * sg + j) * SC_ROW + SC_W + 256 * d + k * 4); } \
        { const int t = C.tid >> 3, k0 = (C.tid & 7) * 8; const unsigned char* rp = rec0 + (long)sgn * t * SC_ROW; \
          ukk = *(const u32x4*)(rp + SC_KK + k0 * 2); ub = *(const u32x4*)(rp + SC_B + 256 * d + k0 * 2); ukr = *(const u32x4*)(rp + SC_KR + 256 * d + k0 * 2); ur = *(const u32x4*)(rp + SC_R + k0 * 2); uv = *(const u32x4*)(rp + SC_V + k0 * 2); } } while (0)
    if ((int)blockIdx.x < CS_UNITS * CS_NCH) CSA_LOAD((int)blockIdx.x);
    for (int cu = blockIdx.x; cu < CS_UNITS * CS_NCH; cu += C.G) {
        LAS float* csf = (LAS float*)(L + CS_M2F);
        LAS float* seg = (LAS float*)(L + CS_N2);
        { const int k = C.tid & 63, sg = C.tid >> 6;
#pragma unroll
          for (int j = 1; j < 8; ++j) lwv[j] += lwv[j - 1];
          seg[sg * 64 + k] = lwv[7];
          CS_BAR();
          float off = 0.f, tot = 0.f;
#pragma unroll
          for (int s2 = 0; s2 < 8; ++s2) { const float v = seg[s2 * 64 + k]; off += (s2 < sg) ? v : 0.f; tot += v; }
#pragma unroll
          for (int j = 0; j < 8; ++j) csf[(8 * sg + j) * 65 + k] = lwv[j] + off;
          if (sg == 7) ((LAS float*)(L + CS_GL))[k] = __expf(tot); }
        CS_BAR();
        { const int t = C.tid >> 3, k0 = (C.tid & 7) * 8;
          float wt[8], kb[8], bb[8], rt[8], bh[8], kh[8];
#pragma unroll
          for (int j = 0; j < 8; ++j) { const unsigned pkk = j < 2 ? ukk.x : j < 4 ? ukk.y : j < 6 ? ukk.z : ukk.w, pb = j < 2 ? ub.x : j < 4 ? ub.y : j < 6 ? ub.z : ub.w, pkr = j < 2 ? ukr.x : j < 4 ? ukr.y : j < 6 ? ukr.z : ukr.w, pr = j < 2 ? ur.x : j < 4 ? ur.y : j < 6 ? ur.z : ur.w;
              const float kkv = (j & 1) ? bfhi(pkk) : bflo(pkk), bv = (j & 1) ? bfhi(pb) : bflo(pb), krv = (j & 1) ? bfhi(pkr) : bflo(pkr), rv = (j & 1) ? bfhi(pr) : bflo(pr);
              const float cst = csf[t * 65 + k0 + j], csp = t > 0 ? csf[(t - 1) * 65 + k0 + j] : 0.f, csl = csf[63 * 65 + k0 + j];
              const float einv = __expf(-cst), el = __expf(csl - cst);
              wt[j] = kkv * __expf(csp); kb[j] = krv * einv; bb[j] = bv * einv; rt[j] = rv * __expf(cst); bh[j] = bv * el; kh[j] = krv * el; }
          u32x4 o;
          o.x = pk2(wt[0], wt[1]); o.y = pk2(wt[2], wt[3]); o.z = pk2(wt[4], wt[5]); o.w = pk2(wt[6], wt[7]); *(LAS u32x4*)(L + CS_WT + t * (CSP * 2) + k0 * 2) = o;
          o.x = pk2(kb[0], kb[1]); o.y = pk2(kb[2], kb[3]); o.z = pk2(kb[4], kb[5]); o.w = pk2(kb[6], kb[7]); *(LAS u32x4*)(L + CS_KB + t * (CSP * 2) + k0 * 2) = o;
          o.x = pk2(bb[0], bb[1]); o.y = pk2(bb[2], bb[3]); o.z = pk2(bb[4], bb[5]); o.w = pk2(bb[6], bb[7]); *(LAS u32x4*)(L + CS_BB + t * (CSP * 2) + k0 * 2) = o;
          o.x = pk2(rt[0], rt[1]); o.y = pk2(rt[2], rt[3]); o.z = pk2(rt[4], rt[5]); o.w = pk2(rt[6], rt[7]); *(LAS u32x4*)(L + CS_RT + t * (CSP * 2) + k0 * 2) = o;
#pragma unroll
          for (int j = 0; j < 8; ++j) { const int to = ((((t >> 3) ^ ((k0 >> 3) & 7)) * 8) + (t & 7)) * 2;
              *(LAS bf16_t*)(L + CS_BHT + (k0 + j) * (CSP * 2) + to) = (bf16_t)f2bf(bh[j]); *(LAS bf16_t*)(L + CS_KHT + (k0 + j) * (CSP * 2) + to) = (bf16_t)f2bf(kh[j]);
              const unsigned pv = j < 2 ? uv.x : j < 4 ? uv.y : j < 6 ? uv.z : uv.w; *(LAS bf16_t*)(L + CS_VMT + (k0 + j) * (CSP * 2) + to) = (bf16_t)((j & 1) ? (pv >> 16) : (pv & 0xffffu)); } }
        if (cu + C.G < CS_UNITS * CS_NCH) CSA_LOAD(cu + C.G);
        CS_BAR();
        for (int job = C.wave; job < 12; job += NWAVES) { const int p = job >> 2, ti = (job >> 1) & 1, tj = job & 1;
            f32x16 acc;
#pragma unroll
            for (int i = 0; i < 16; ++i) acc[i] = 0.f;
            if (p == 0) { cs_mma(acc, L + CS_WT, L + CS_BB, ti, tj, r32, hi);
                const int i = tj * 32 + r32; LAS float* mp = (LAS float*)(L + CS_M2F) + i * 64;
#pragma unroll
                for (int reg = 0; reg < 16; ++reg) { const int t = ti * 32 + crow(reg, hi); mp[(t & 3) * 16 + (t >> 2)] = (i < t) ? acc[reg] : 0.f; } }
            else if (p == 1) { cs_mma(acc, L + CS_WT, L + CS_KB, ti, tj, r32, hi);
                const int i = tj * 32 + r32;
#pragma unroll
                for (int reg = 0; reg < 16; ++reg) { const int t = ti * 32 + crow(reg, hi); acc[reg] = (i < t) ? acc[reg] : 0.f; }
                cs_store_t(L + CS_M1T, acc, ti, tj, r32, hi); }
            else { cs_mma(acc, L + CS_BB, L + CS_RT, ti, tj, r32, hi);
                const int t = tj * 32 + r32;
#pragma unroll
                for (int reg = 0; reg < 16; ++reg) { const int i = ti * 32 + crow(reg, hi); acc[reg] = (i <= t) ? acc[reg] : 0.f; }
                cs_store_t(L + CS_N2, acc, ti, tj, r32, hi); } }
        CS_BAR();
        { const int c = C.tid >> 2, q = C.tid & 3; f32x2 acc2[8];
          { const LAS unsigned char* rcol = (c < 64) ? (L + CS_WT + c * 2) : (L + CS_M1T + (c - 64) * (CSP * 2)); const int rstride = (c < 64) ? CSP * 2 : 2;
#pragma unroll
            for (int j = 0; j < 16; ++j) acc2[j >> 1][j & 1] = bf2f(*(const LAS bf16_t*)(rcol + (4 * j + q) * rstride)); }
          const LAS float* m2c = (const LAS float*)(L + CS_M2F) + q * 16;
#pragma clang loop unroll(full)
          for (int i = 0; i < 64; ++i) {
              const float mine = -acc2[i >> 3][(i >> 2) & 1];
              float gi;
              switch (i & 3) { case 0: gi = __uint_as_float((unsigned)__builtin_amdgcn_update_dpp(0, (int)__float_as_uint(mine), 0x00, 0xF, 0xF, true)); break;
                               case 1: gi = __uint_as_float((unsigned)__builtin_amdgcn_update_dpp(0, (int)__float_as_uint(mine), 0x55, 0xF, 0xF, true)); break;
                               case 2: gi = __uint_as_float((unsigned)__builtin_amdgcn_update_dpp(0, (int)__float_as_uint(mine), 0xAA, 0xF, 0xF, true)); break;
                               default: gi = __uint_as_float((unsigned)__builtin_amdgcn_update_dpp(0, (int)__float_as_uint(mine), 0xFF, 0xF, 0xF, true)); break; }
              const f32x2 g2 = {gi, gi};
#pragma unroll
              for (int j4 = (i >> 4); j4 < 4; ++j4) { const f32x4 m = *(const LAS f32x4*)(m2c + i * 64 + j4 * 4);
#pragma unroll
                  for (int h = 0; h < 2; ++h) { const int p = 2 * j4 + h;
                      if (2 * p >= (i >> 2)) acc2[p] += (f32x2){m[2 * h], m[2 * h + 1]} * g2;
                      else if (2 * p + 1 >= (i >> 2)) acc2[p][1] += m[2 * h + 1] * gi; } }
          }
#pragma unroll
          for (int j = 0; j < 16; ++j) *(LAS bf16_t*)(L + CS_GT + c * (CSP * 2) + (4 * j + q) * 2) = (bf16_t)f2bf(-acc2[j >> 1][j & 1]); }
        CS_BAR();
        unsigned char* outp = CHK + (size_t)cu * 32768;
        for (int job = C.wave; job < 16; job += NWAVES) { const int p = job >> 2, ti = (job >> 1) & 1, tj = job & 1;
            f32x16 acc;
            if (p == 0) {
                const LAS unsigned char* rp = L + CS_RT + (tj * 32 + r32) * (CSP * 2) + (ti * 32 + 4 * hi) * 2;
#pragma unroll
                for (int g = 0; g < 4; ++g) { const u32x2 u = *(const LAS u32x2*)(rp + g * 16); acc[4 * g] = bflo(u.x); acc[4 * g + 1] = bfhi(u.x); acc[4 * g + 2] = bflo(u.y); acc[4 * g + 3] = bfhi(u.y); }
                cs_mma(acc, L + CS_GT, L + CS_N2, ti, tj, r32, hi);
#pragma unroll
                for (int g = 0; g < 4; ++g) { u32x2 o; o.x = pk2(acc[4 * g], acc[4 * g + 1]); o.y = pk2(acc[4 * g + 2], acc[4 * g + 3]);
                    *(u32x2*)(outp + 8192 + (((tj * 4 + 2 * ti + (g >> 1)) * 64 + (g & 1) * 32 + r32) * 16) + hi * 8) = o; } }
            else if (p == 1) {
#pragma unroll
                for (int i = 0; i < 16; ++i) acc[i] = 0.f;
                cs_mma(acc, L + CS_KB, L + CS_RT, ti, tj, r32, hi);
                const int t = tj * 32 + r32;
#pragma unroll
                for (int reg = 0; reg < 16; ++reg) { const int i = ti * 32 + crow(reg, hi); acc[reg] = (i <= t) ? acc[reg] : 0.f; }
                cs_mma(acc, L + CS_GT + 64 * (CSP * 2), L + CS_N2, ti, tj, r32, hi);
                cs_store_t(L + CS_Z, acc, ti, tj, r32, hi); }
            else if (p == 2) {
#pragma unroll
                for (int i = 0; i < 16; ++i) acc[i] = 0.f;
                cs_mma<true>(acc, L + CS_GT, L + CS_BHT, ti, tj, r32, hi);
                const int k = tj * 32 + r32; const float gl = ((const LAS float*)(L + CS_GL))[k];
#pragma unroll
                for (int reg = 0; reg < 16; ++reg) { const int cc = ti * 32 + crow(reg, hi); acc[reg] += (cc == k) ? gl : 0.f; }
#pragma unroll
                for (int g = 0; g < 4; ++g) { u32x2 o; o.x = pk2(acc[4 * g], acc[4 * g + 1]); o.y = pk2(acc[4 * g + 2], acc[4 * g + 3]);
                    *(u32x2*)(outp + (((tj * 4 + 2 * ti + (g >> 1)) * 64 + (g & 1) * 32 + r32) * 16) + hi * 8) = o; } }
            else {
                const int krow = tj * 32 + r32; const LAS unsigned char* kp = L + CS_KHT + krow * (CSP * 2) + hi * 8;
#pragma unroll
                for (int g = 0; g < 4; ++g) { const u32x2 u = *(const LAS u32x2*)(kp + (((ti * 4 + g) ^ ((krow >> 3) & 7)) * 16)); acc[4 * g] = bflo(u.x); acc[4 * g + 1] = bfhi(u.x); acc[4 * g + 2] = bflo(u.y); acc[4 * g + 3] = bfhi(u.y); }
                cs_mma<true>(acc, L + CS_GT + 64 * (CSP * 2), L + CS_BHT, ti, tj, r32, hi);
                cs_store_t(L + CS_U, acc, ti, tj, r32, hi); } }
        CS_BAR();
        { const int p = C.wave >> 2, ti = (C.wave >> 1) & 1, tj = C.wave & 1;
          f32x16 acc;
#pragma unroll
          for (int i = 0; i < 16; ++i) acc[i] = 0.f;
          cs_mma<true>(acc, L + (p ? CS_U : CS_Z), L + CS_VMT, ti, tj, r32, hi);
          unsigned char* op = outp + (p ? 16384 : 24576) + ((ti * 2 + tj) * 64 + C.lane) * 32;
          u32x4 o0, o1; o0.x = pk2(acc[0], acc[1]); o0.y = pk2(acc[2], acc[3]); o0.z = pk2(acc[4], acc[5]); o0.w = pk2(acc[6], acc[7]);
          o1.x = pk2(acc[8], acc[9]); o1.y = pk2(acc[10], acc[11]); o1.z = pk2(acc[12], acc[13]); o1.w = pk2(acc[14], acc[15]);
          *(u32x4*)op = o0; *(u32x4*)(op + 16) = o1; }
        CS_BAR();
    }
}
__device__ __forceinline__ void phase_csb(const Ctx& C, const Args& A, int l) {
    if ((int)blockIdx.x >= CS_UNITS) { conv_items(C, A, l + 1, ((int)blockIdx.x - CS_UNITS) * NWAVES + C.wave, (C.G - CS_UNITS) * NWAVES, true, false, true); return; }
    const unsigned char* CHK = A.ws + WS_CHK;
    LAS unsigned char* L = C.lds;
    const int r32 = C.lane & 31, hi = C.lane >> 5;
    const bool isS = C.wave < 4; const int ti = (C.wave >> 1) & 1, tj = C.wave & 1;
    for (int unit = blockIdx.x; unit < CS_UNITS; unit += C.G) {
        const int d = unit & 1, h = (unit >> 1) % 12, b = unit / 24;
        float* Y = (float*)(A.ws + WS_Y) + (size_t)d * MROWS * 768;
        for (int i = C.tid; i < 2 * CS_MAT / 4; i += NTHR) ((LAS unsigned*)L)[i] = 0u;
        CS_BAR();
        bf16x8 afA[4], afB[4], afC[4]; u32x4 cA0, cA1, cB0, cB1, cC0, cC1;
#define CSB_LOAD(A4, C0, C1, ch_) do { const unsigned char* op_ = CHK + ((size_t)unit * CS_NCH + (ch_)) * 32768; \
            const unsigned char* am_ = op_ + (isS ? 0 : 8192) + (ti * 4 * 64 + C.lane) * 16;     \
            _Pragma("unroll") for (int ks = 0; ks < 4; ++ks) A4[ks] = *(const bf16x8*)(am_ + ks * 1024); \
            const unsigned char* cp_ = op_ + (isS ? 16384 : 24576) + ((ti * 2 + tj) * 64 + C.lane) * 32; C0 = *(const u32x4*)cp_; C1 = *(const u32x4*)(cp_ + 16); } while (0)
#define CSB_STEP(A4, C0, C1, ch_) do { \
            const LAS unsigned char* Sb = L + ((ch_) & 1) * CS_MAT; LAS unsigned char* Sn = L + (((ch_) + 1) & 1) * CS_MAT; \
            f32x16 acc; \
            acc[0] = bflo(C0.x); acc[1] = bfhi(C0.x); acc[2] = bflo(C0.y); acc[3] = bfhi(C0.y); acc[4] = bflo(C0.z); acc[5] = bfhi(C0.z); acc[6] = bflo(C0.w); acc[7] = bfhi(C0.w); \
            acc[8] = bflo(C1.x); acc[9] = bfhi(C1.x); acc[10] = bflo(C1.y); acc[11] = bfhi(C1.y); acc[12] = bflo(C1.z); acc[13] = bfhi(C1.z); acc[14] = bflo(C1.w); acc[15] = bfhi(C1.w); \
            const LAS unsigned char* bp = Sb + (tj * 32 + r32) * (CSP * 2) + hi * 16; \
            _Pragma("unroll") for (int ks = 0; ks < 4; ++ks) acc = __builtin_amdgcn_mfma_f32_32x32x16_bf16(A4[ks], *(const LAS bf16x8*)(bp + ks * 32), acc, 0, 0, 0); \
            if (isS) { cs_store_t(Sn, acc, ti, tj, r32, hi); }     \
            else {     \
                const int step0 = (ch_) * CS_L; const int sgn = d ? -1 : 1; \
                const int row0 = (step0 < CTXL) ? (NLAT + b * CTXL + (d ? CTXL - 1 - step0 : step0)) : (b * TT + (d ? TT - 1 - (step0 - CTXL) : step0 - CTXL)); \
                float* yp = Y + (size_t)(row0 + sgn * (ti * 32 + 4 * hi)) * 768 + h * 64 + tj * 32 + r32; const long ys = (long)sgn * 768; \
                _Pragma("unroll") for (int reg = 0; reg < 16; ++reg) yp[ys * ((reg & 3) + 8 * (reg >> 2))] = acc[reg]; } \
            CS_BAR(); } while (0)
        CSB_LOAD(afA, cA0, cA1, 0); CSB_LOAD(afB, cB0, cB1, 1);
        static_assert(CS_NCH % 3 == 0, "chunk loop is unrolled by three");
        for (int ch = 0; ch < CS_NCH; ch += 3) {
            if (ch == 0) CSB_LOAD(afC, cC0, cC1, 2);
            CSB_STEP(afA, cA0, cA1, ch);     if (ch + 3 < CS_NCH) CSB_LOAD(afA, cA0, cA1, ch + 3);
            CSB_STEP(afB, cB0, cB1, ch + 1); if (ch + 4 < CS_NCH) CSB_LOAD(afB, cB0, cB1, ch + 4);
            CSB_STEP(afC, cC0, cC1, ch + 2); if (ch + 5 < CS_NCH) CSB_LOAD(afC, cC0, cC1, ch + 5);
        }
        CS_BAR();
    }
#undef CSB_LOAD
#undef CSB_STEP
}

#undef CS_BAR
struct Ef2Row { f32x4 y0[3], y1[3]; u32x2 r[3], v[3], k0[3], k1[3], g[3]; };
__device__ __forceinline__ void ef2_load(Ef2Row& R, const float* Y0, const float* Y1, const unsigned char* SCN, const bf16_t* G, int row, int lane) {
#pragma unroll
    for (int it = 0; it < 3; ++it) { const int c = it * 256 + 4 * lane, head = c >> 6, kx = c & 63;
        R.y0[it] = *(const f32x4*)(Y0 + (size_t)row * 768 + c); R.y1[it] = *(const f32x4*)(Y1 + (size_t)row * 768 + c);
        const unsigned char* base = SCN + (size_t)(row * 12 + head) * SC_REC + kx * 2;
        R.r[it] = *(const u32x2*)(base + SC_R); R.v[it] = *(const u32x2*)(base + SC_V); R.k0[it] = *(const u32x2*)(base + SC_KR); R.k1[it] = *(const u32x2*)(base + SC_KR + 256);
        R.g[it] = *(const u32x2*)(G + (size_t)row * 768 + c); }
}
__device__ __forceinline__ void phase_ef2(const Ctx& C, const Args& A, int l) {
    const int i2 = l >> 1; unsigned char* ws = A.ws;
    const unsigned char* SCN = ws + WS_SCN; const float* Y0 = (const float*)(ws + WS_Y); const float* Y1 = Y0 + (size_t)MROWS * 768;
    const bf16_t* G = (const bf16_t*)(ws + WS_G); bf16_t* A2 = (bf16_t*)(ws + WS_A2);
    const float* rb = A.in[I_RBON] + (size_t)i2 * 768; const float* gg = A.in[I_GNG] + (size_t)i2 * 768; const float* gb = A.in[I_GNB] + (size_t)i2 * 768;
    f32x4 rbr[3], ggr[3], gbr[3];
#pragma unroll
    for (int it = 0; it < 3; ++it) { const int c = it * 256 + 4 * C.lane; rbr[it] = *(const f32x4*)(rb + c); ggr[it] = *(const f32x4*)(gg + c); gbr[it] = *(const f32x4*)(gb + c); }
    Ef2Row Rn;
    if (C.gw < MROWS) ef2_load(Rn, Y0, Y1, SCN, G, C.gw, C.lane);
    for (int row = C.gw; row < MROWS; row += C.NGW) {
        const Ef2Row R = Rn;
        { const int nr = row + C.NGW < MROWS ? row + C.NGW : row; ef2_load(Rn, Y0, Y1, SCN, G, nr, C.lane); }
#pragma unroll
        for (int it = 0; it < 3; ++it) {
            const int c = it * 256 + 4 * C.lane;
            const f32x4 y = R.y0[it] + R.y1[it];
            const float mean = sum16((y[0] + y[1]) + (y[2] + y[3])) * (1.f / 64.f);
            const f32x4 dd = y - mean;
            const float var = sum16((dd[0] * dd[0] + dd[1] * dd[1]) + (dd[2] * dd[2] + dd[3] * dd[3])) * (1.f / 64.f);
            const float rstd = rsqrtf(var + GN_EPS);
            const f32x4 r = bf4(R.r[it]), v = bf4(R.v[it]), k0 = bf4(R.k0[it]), k1 = bf4(R.k1[it]);
            const f32x4 t = r * (k0 + k1) * 0.5f * rbr[it];
            const float bs = sum16((t[0] + t[1]) + (t[2] + t[3]));
            const f32x4 yn = dd * rstd * ggr[it] + gbr[it];
            const f32x4 g = bf4(R.g[it]);
            st4bf(A2 + (size_t)row * DM + 256 + c, g * (yn + v * bs));
        }
    }
}

__device__ __forceinline__ void phase_of1(const Ctx& C, const Args& A, int l) {
    const int i2 = l >> 1; unsigned char* ws = A.ws;
    const bf16_t* P = (const bf16_t*)(ws + WS_P); bf16_t* A2 = (bf16_t*)(ws + WS_A2); bf16_t* VT = (bf16_t*)(ws + WS_VT);
    const float* lng = A.in[I_GLNG] + (size_t)i2 * 256; const float* lnb = A.in[I_GLNB] + (size_t)i2 * 256;
    const float* gws = A.in[I_GWS] + (size_t)i2 * 4 * 128 * 128; const float* gbs = A.in[I_GBS] + (size_t)i2 * 4 * 128;
    LAS bf16_t* vt = (LAS bf16_t*)C.lds;
    LAS bf16_t* uL = (LAS bf16_t*)C.lds;
    LAS bf16_t* vT = (LAS bf16_t*)(C.lds + 128 * 528);
    const int r32 = C.lane & 31, hi = C.lane >> 5;
    for (int it = blockIdx.x; it < 256 + 8 * 7; it += C.G) {
        const bool isctx = it >= 256; const int uc = isctx ? (it - 256) / 7 : 0, pc = isctx ? (it - 256) % 7 : 0; const int u = it;
        const int b = isctx ? (uc >> 1) : (u >> 6), pos0 = isctx ? (uc & 1) * 128 : (u & 63) * 128;
        const int row0 = isctx ? NLAT + b * CTXL + pos0 : b * TT + pos0, L0 = isctx ? pos0 : CTXL + pos0;
        const int hh0 = isctx ? pc : 0, hh1 = isctx ? (pc < 6 ? pc + 1 : 0) : 6; const bool doC = !isctx || pc == 6;
        u32x4 pv[4];
        if (hh0 < hh1) {
#pragma unroll
            for (int i = 0; i < 4; ++i) { const int piece = C.tid + NTHR * i, r = piece >> 4, part = piece & 15; pv[i] = *(const u32x4*)(P + (size_t)(row0 + r) * P_LD + 1536 + hh0 * 128 + part * 8); } }
        for (int hh = hh0; hh < hh1; ++hh) {
#pragma unroll
            for (int i = 0; i < 4; ++i) { const int piece = C.tid + NTHR * i, r = piece >> 4, part = piece & 15;
                *(LAS u32x4*)(vt + r * 136 + part * 8) = pv[i]; }
            __syncthreads();
            if (hh + 1 < hh1) {
#pragma unroll
                for (int i = 0; i < 4; ++i) { const int piece = C.tid + NTHR * i, r = piece >> 4, part = piece & 15; pv[i] = *(const u32x4*)(P + (size_t)(row0 + r) * P_LD + 1536 + (hh + 1) * 128 + part * 8); } }
#pragma unroll
            for (int i = 0; i < 4; ++i) { const int item = C.tid + NTHR * i, d = item >> 4, tg = item & 15; const LAS bf16_t* s = vt + (tg * 8) * 136 + d;
                u32x4 o; o.x = (unsigned)s[0] | ((unsigned)s[136] << 16); o.y = (unsigned)s[2 * 136] | ((unsigned)s[3 * 136] << 16);
                o.z = (unsigned)s[4 * 136] | ((unsigned)s[5 * 136] << 16); o.w = (unsigned)s[6 * 136] | ((unsigned)s[7 * 136] << 16);
                *(u32x4*)(VT + ((size_t)(b * 6 + hh) * 128 + d) * LKEYS + L0 + tg * 8) = o; }
            __syncthreads();
        }
        if (doC) {
        const f32x4 lngr = *(const f32x4*)(lng + 4 * C.lane), lnbr = *(const f32x4*)(lnb + 4 * C.lane);
        u32x2 nxu, nxr;
        { const bf16_t* pr = P + (size_t)(row0 + C.wave) * P_LD + 2304 + 4 * C.lane; nxu = *(const u32x2*)pr; nxr = *(const u32x2*)(pr + 256); }
        for (int r = C.wave; r < 128; r += NWAVES) {
            const int c4 = 4 * C.lane;
            const f32x4 ur = bf4(nxu), raw = bf4(nxr);
            if (r + NWAVES < 128) { const bf16_t* pr = P + (size_t)(row0 + r + NWAVES) * P_LD + 2304 + c4; nxu = *(const u32x2*)pr; nxr = *(const u32x2*)(pr + 256); }
            { const f32x4 gu = {gelu_erf(ur[0]), gelu_erf(ur[1]), gelu_erf(ur[2]), gelu_erf(ur[3])}; u32x2 o; o.x = pk2(gu[0], gu[1]); o.y = pk2(gu[2], gu[3]); *(LAS u32x2*)(uL + r * 264 + c4) = o; }
            const f32x4 gv = {gelu_erf(raw[0]), gelu_erf(raw[1]), gelu_erf(raw[2]), gelu_erf(raw[3])};
            const float mean = wave_sum((gv[0] + gv[1]) + (gv[2] + gv[3])) * (1.f / 256.f); const f32x4 dd = gv - mean;
            const float var = wave_sum((dd[0] * dd[0] + dd[1] * dd[1]) + (dd[2] * dd[2] + dd[3] * dd[3])) * (1.f / 256.f); const float rstd = rsqrtf(var + LN_EPS);
            const f32x4 o = dd * rstd * lngr + lnbr;
#pragma unroll
            for (int k = 0; k < 4; ++k) vT[(c4 + k) * 136 + r] = (bf16_t)f2bf(o[k]);
        }
        __syncthreads();
        {
            const int g = C.wave >> 1, cblk = C.wave & 1, cc = g * 64 + cblk * 32 + r32;
            for (int pblk = 0; pblk < 4; ++pblk) {
                f32x16 acc;
#pragma unroll
                for (int i = 0; i < 16; ++i) acc[i] = 0.f;
                const float* wrow = gws + ((size_t)g * 128 + pblk * 32 + r32) * 128 + 8 * hi;
#pragma unroll
                for (int ks = 0; ks < 8; ++ks) { const f32x4 w0 = *(const f32x4*)(wrow + ks * 16), w1 = *(const f32x4*)(wrow + ks * 16 + 4);
                    u32x4 au; au.x = pk2(w0[0], w0[1]); au.y = pk2(w0[2], w0[3]); au.z = pk2(w1[0], w1[1]); au.w = pk2(w1[2], w1[3]);
                    const bf16x8 bf = *(const LAS bf16x8*)(vT + cc * 136 + ks * 16 + 8 * hi);
                    acc = __builtin_amdgcn_mfma_f32_32x32x16_bf16(__builtin_bit_cast(bf16x8, au), bf, acc, 0, 0, 0); }
#pragma unroll
                for (int reg = 0; reg < 16; ++reg) { const int p = pblk * 32 + crow(reg, hi);
                    const float uu = bf2f(uL[p * 264 + cc]); const float mixed = acc[reg] + gbs[g * 128 + p];
                    uL[p * 264 + cc] = (bf16_t)f2bf(uu * mixed); }
            }
        }
        __syncthreads();
#pragma unroll
        for (int i = 0; i < 8; ++i) { const int piece = C.tid + NTHR * i, r = piece >> 5, part = piece & 31;
            *(u32x4*)(A2 + (size_t)(row0 + r) * DM + 768 + part * 8) = *(const LAS u32x4*)(uL + r * 264 + part * 8); }
        __syncthreads();
        }
    }
}

__device__ __forceinline__ void phase_attn(const Ctx& C, const Args& A, int l) {
    const int i2 = l >> 1; unsigned char* ws = A.ws;
    const bf16_t* Q = (const bf16_t*)(ws + WS_Q); const bf16_t* KA = (const bf16_t*)(ws + WS_KA); const bf16_t* VT = (const bf16_t*)(ws + WS_VT); bf16_t* A2 = (bf16_t*)(ws + WS_A2);
    const float lam_init = 0.8f - 0.6f * expf(-0.3f * (float)l);
    float s1 = 0.f, s2 = 0.f;
    for (int j = 0; j < 64; ++j) { s1 += A.in[I_LQ1][i2 * 64 + j] * A.in[I_LK1][i2 * 64 + j]; s2 += A.in[I_LQ2][i2 * 64 + j] * A.in[I_LK2][i2 * 64 + j]; }
    const float lam = expf(s1) - expf(s2) + lam_init;
    const float* subg = A.in[I_SUBG] + (size_t)i2 * 128;
    const int r32 = C.lane & 31, hi = C.lane >> 5, map = C.wave >> 2, qw = C.wave & 3;
    LAS unsigned char* Kt = C.lds; LAS unsigned char* Vt = C.lds + 2 * 16384; LAS float* xch = (LAS float*)C.lds;
    const int NU = 1536 + (l == 1 ? 48 : 0);
    for (int n = C.vcu; n < NU; n += C.G) {
        int bh, qt; bool isctx = false;
        if (n < 1536) { const int round = n >> 8, slot = n & 255; bh = (slot >> 5) * 3 + (round >> 1); qt = (round & 1) * 32 + (slot & 31); }
        else { isctx = true; bh = (n - 1536) >> 1; qt = (n - 1536) & 1; }
        const int b = bh / 6, h = bh % 6;
        const int qrow0 = isctx ? NLAT + b * CTXL + qt * 128 : b * TT + qt * 128;
        const int NT = isctx ? CTXL / 64 : LKEYS / 64;
        const bf16_t* Kb = KA + (size_t)b * LKEYS * 768 + h * 128;
        const bf16_t* Vb = VT + (size_t)(b * 6 + h) * 128 * LKEYS;
        bf16x8 qf[4];
        { const bf16_t* qp = Q + (size_t)(qrow0 + qw * 32 + r32) * 768 + h * 128 + map * 64 + 8 * hi;
#pragma unroll
          for (int ks = 0; ks < 4; ++ks) qf[ks] = *(const bf16x8*)(qp + ks * 16); }
        f32x16 O[4];
#pragma unroll
        for (int d = 0; d < 4; ++d)
#pragma unroll
            for (int i = 0; i < 16; ++i) O[d][i] = 0.f;
        float m = 0.f, lsum = 0.f;
        unsigned ksrc[2], vsrc[2];
#pragma unroll
        for (int i = 0; i < 2; ++i) { const int row = 4 * (2 * C.wave + i) + (C.lane >> 4), x = row & 15, pi = x < 4 ? x : x < 8 ? x + 4 : x < 12 ? x - 4 : x;
            ksrc[i] = (unsigned)(((row & ~15) + pi) * 768 + (((C.lane & 15) ^ x) * 8));
            const int d = 8 * (2 * C.wave + i) + (C.lane >> 3); vsrc[i] = (unsigned)(d * LKEYS + (((C.lane & 7) ^ ((d >> 1) & 7)) * 8)); }
#define AT_DMA_K(tt, slot) do { _Pragma("unroll") for (int i = 0; i < 2; ++i) __builtin_amdgcn_global_load_lds((const unsigned*)(Kb + (size_t)(tt) * 64 * 768 + ksrc[i]), (LAS unsigned*)(Kt + (slot) * 16384 + (2 * C.wave + i) * 1024), 16, 0, 0); } while (0)
#define AT_DMA_V(tt, slot) do { _Pragma("unroll") for (int i = 0; i < 2; ++i) __builtin_amdgcn_global_load_lds((const unsigned*)(Vb + (size_t)(tt) * 64 + vsrc[i]), (LAS unsigned*)(Vt + (slot) * 16384 + (2 * C.wave + i) * 1024), 16, 0, 0); } while (0)
#define AT_BAR() asm volatile("s_waitcnt vmcnt(0) lgkmcnt(0)\n\ts_barrier" ::: "memory")
#define AT_SB() __builtin_amdgcn_sched_barrier(0)
        const int ksw = r32 & 15, vsw = (r32 >> 1) & 7;
#define AT_QK(P0, P1, ks_) do { const float nm_ = -m; _Pragma("unroll") for (int i = 0; i < 16; ++i) { P0[i] = nm_; P1[i] = nm_; } \
            const LAS unsigned char* kbp_ = Kt + (ks_) * 16384 + r32 * 256; \
            _Pragma("unroll") for (int ks = 0; ks < 4; ++ks) { const int co_ = ((map * 8 + ks * 2 + hi) ^ ksw) * 16; \
                P0 = __builtin_amdgcn_mfma_f32_32x32x16_bf16(*(const LAS bf16x8*)(kbp_ + co_), qf[ks], P0, 0, 0, 0); P1 = __builtin_amdgcn_mfma_f32_32x32x16_bf16(*(const LAS bf16x8*)(kbp_ + 32 * 256 + co_), qf[ks], P1, 0, 0, 0); } } while (0)
#define AT_LDV(dst, vs_, d) do { _Pragma("unroll") for (int kst = 0; kst < 4; ++kst) dst[kst] = *(const LAS u32x4*)(Vt + (vs_) * 16384 + ((d) * 32 + r32) * 128 + (((kst * 2 + hi) ^ vsw) * 16)); } while (0)
#define AT_PV(src, d) do { _Pragma("unroll") for (int kst = 0; kst < 4; ++kst) O[d] = __builtin_amdgcn_mfma_f32_32x32x16_bf16(__builtin_bit_cast(bf16x8, src[kst]), pb[kst], O[d], 0, 0, 0); } while (0)
#define AT_SOFTPV(P0, P1, N0, N1, first, hasn, vs_) do { \
            asm volatile("s_nop 15\n\ts_nop 7" : "+v"(P0), "+v"(P1)); \
            float mx = max3f(P0[0], P0[1], P1[0]), mx2 = max3f(P0[2], P0[3], P1[1]); mx = max3f(mx, P1[2], P1[3]); \
            _Pragma("unroll") for (int i = 4; i < 16; i += 4) { mx = max3f(mx, P0[i], P0[i + 1]); mx2 = max3f(mx2, P0[i + 2], P0[i + 3]); mx = max3f(mx, P1[i], P1[i + 1]); mx2 = max3f(mx2, P1[i + 2], P1[i + 3]); } \
            mx = fmaxf(mx, mx2); \
            { auto rr = __builtin_amdgcn_permlane32_swap(__float_as_uint(mx), __float_as_uint(mx), false, false); mx = fmaxf(__uint_as_float(rr[0]), __uint_as_float(rr[1])); } \
            if ((first) || __any(mx > 8.f)) { const float dl = (first) ? mx : fmaxf(mx, 0.f); const float sc = __builtin_amdgcn_exp2f(-dl); lsum *= sc; \
                _Pragma("unroll") for (int d = 0; d < 4; ++d) _Pragma("unroll") for (int i = 0; i < 16; ++i) O[d][i] *= sc; \
                _Pragma("unroll") for (int i = 0; i < 16; ++i) { P0[i] -= dl; P1[i] -= dl; } \
                if (hasn) { asm volatile("s_nop 15\n\ts_nop 7" : "+v"(N0), "+v"(N1)); _Pragma("unroll") for (int i = 0; i < 16; ++i) { N0[i] -= dl; N1[i] -= dl; } } \
                m += dl; } \
            float ps = 0.f, ps2 = 0.f; \
            _Pragma("unroll") for (int i = 0; i < 16; ++i) { P0[i] = __builtin_amdgcn_exp2f(P0[i]); P1[i] = __builtin_amdgcn_exp2f(P1[i]); ps += P0[i]; ps2 += P1[i]; } \
            lsum += ps + ps2; \
            bf16x8 pb[4]; \
            { u32x4 w; w.x = pk2(P0[0], P0[1]); w.y = pk2(P0[2], P0[3]); w.z = pk2(P0[4], P0[5]); w.w = pk2(P0[6], P0[7]); pb[0] = __builtin_bit_cast(bf16x8, w); \
              w.x = pk2(P0[8], P0[9]); w.y = pk2(P0[10], P0[11]); w.z = pk2(P0[12], P0[13]); w.w = pk2(P0[14], P0[15]); pb[1] = __builtin_bit_cast(bf16x8, w); \
              w.x = pk2(P1[0], P1[1]); w.y = pk2(P1[2], P1[3]); w.z = pk2(P1[4], P1[5]); w.w = pk2(P1[6], P1[7]); pb[2] = __builtin_bit_cast(bf16x8, w); \
              w.x = pk2(P1[8], P1[9]); w.y = pk2(P1[10], P1[11]); w.z = pk2(P1[12], P1[13]); w.w = pk2(P1[14], P1[15]); pb[3] = __builtin_bit_cast(bf16x8, w); } \
            u32x4 va[4]; \
            AT_LDV(va, vs_, 0); AT_SB(); AT_PV(va, 0); AT_SB(); AT_LDV(va, vs_, 1); AT_SB(); AT_PV(va, 1); AT_SB(); AT_LDV(va, vs_, 2); AT_SB(); AT_PV(va, 2); AT_SB(); AT_LDV(va, vs_, 3); AT_SB(); AT_PV(va, 3); AT_SB(); } while (0)
        f32x16 pA0, pA1, pB0, pB1;
        AT_DMA_K(0, 0); AT_DMA_V(0, 0); AT_DMA_K(1, 1);
        AT_BAR();
        AT_QK(pA0, pA1, 0);
        asm volatile("s_waitcnt lgkmcnt(0)\n\ts_barrier" ::: "memory");
        for (int t = 0; t < NT; t += 2) {
            if (t + 2 < NT) AT_DMA_K(t + 2, 0);
            AT_DMA_V(t + 1, 1);
            AT_SB(); AT_QK(pB0, pB1, 1); AT_SB();
            AT_SOFTPV(pA0, pA1, pB0, pB1, t == 0, true, 0);
            AT_BAR();
            if (t + 3 < NT) AT_DMA_K(t + 3, 1);
            if (t + 2 < NT) AT_DMA_V(t + 2, 0);
            AT_SB(); if (t + 2 < NT) { AT_QK(pA0, pA1, 0); } AT_SB();
            AT_SOFTPV(pB0, pB1, pA0, pA1, false, t + 2 < NT, 1);
            AT_BAR();
        }
#undef AT_DMA_K
#undef AT_DMA_V
#undef AT_BAR
#undef AT_SB
#undef AT_QK
#undef AT_LDV
#undef AT_PV
#undef AT_SOFTPV
        const float ltot = lsum + __shfl_xor(lsum, 32);
        const float invl = 1.f / ltot;
        if (map == 1) { const float f = lam * invl;
#pragma unroll
            for (int d = 0; d < 4; ++d)
#pragma unroll
                for (int i = 0; i < 16; ++i) xch[(qw * 64 + d * 16 + i) * 64 + C.lane] = O[d][i] * f; }
        __syncthreads();
        if (map == 0) { float ss = 0.f;
#pragma unroll
            for (int d = 0; d < 4; ++d)
#pragma unroll
                for (int i = 0; i < 16; ++i) { const float o = O[d][i] * invl - xch[(qw * 64 + d * 16 + i) * 64 + C.lane]; O[d][i] = o; ss += o * o; }
            ss += __shfl_xor(ss, 32);
            const float rn = rsqrtf(ss * (1.f / 128.f) + RMS_EPS) * (1.f - lam_init);
            bf16_t* orow = A2 + (size_t)(qrow0 + qw * 32 + r32) * DM + h * 128;
#pragma unroll
            for (int d = 0; d < 4; ++d)
#pragma unroll
                for (int g4 = 0; g4 < 4; ++g4) { const int dd = 32 * d + 8 * g4 + 4 * hi; const f32x4 sg = *(const f32x4*)(subg + dd);
                    const f32x4 v = {O[d][4 * g4] * rn * sg[0], O[d][4 * g4 + 1] * rn * sg[1], O[d][4 * g4 + 2] * rn * sg[2], O[d][4 * g4 + 3] * rn * sg[3]};
                    st4bf(orow + dd, v); } }
        __syncthreads();
    }
}

__device__ __forceinline__ void phase_rt(const Ctx& C, const Args& A, int l) {
    unsigned char* ws = A.ws; float* X = (float*)(ws + WS_X); bf16_t* H = (bf16_t*)(ws + WS_H); float* AFF = (float*)(ws + WS_AFF); float* STAT = (float*)(ws + WS_P);
    const float* MOD = (const float*)(ws + WS_MOD) + (size_t)l * 5 * 6144;
    const float* lng = A.in[I_LNG] + (size_t)(l * 2 + 0) * DM; const float* lnb = A.in[I_LNB] + (size_t)(l * 2 + 0) * DM;
    LAS float* wrs = (LAS float*)C.lds;
    { const float* wr = A.in[I_WR] + (size_t)l * DM * 16; for (int i = C.tid; i < DM * 16; i += NTHR) wrs[(i & 15) * 1024 + (i >> 4)] = wr[i]; }
    __syncthreads();
    const int row0 = (int)(((long)C.gw * MROWS) / C.NGW), row1 = (int)(((long)(C.gw + 1) * MROWS) / C.NGW);
    f32x4 lngr[4], lnbr[4], scr[4], shr[4]; int cmi = -1;
#pragma unroll
    for (int j = 0; j < 4; ++j) { const int col = 4 * C.lane + 256 * j; lngr[j] = *(const f32x4*)(lng + col); lnbr[j] = *(const f32x4*)(lnb + col); scr[j] = lngr[j]; shr[j] = lngr[j]; }
    f32x4 xn[4];
    if (row0 < row1) {
#pragma unroll
        for (int j = 0; j < 4; ++j) xn[j] = *(const f32x4*)(X + (size_t)row0 * DM + 4 * C.lane + 256 * j); }
    for (int row = row0; row < row1; ++row) {
        const int mi = row_mi(row);
        if (mi != cmi) { cmi = mi; const float* md = MOD + mi * 6144;
#pragma unroll
            for (int j = 0; j < 4; ++j) { const int col = 4 * C.lane + 256 * j; scr[j] = *(const f32x4*)(md + 4 * DM + col) + 1.f; shr[j] = *(const f32x4*)(md + 3 * DM + col); } }
        f32x4 x[4]; float s = 0.f;
#pragma unroll
        for (int j = 0; j < 4; ++j) { x[j] = xn[j]; s += (x[j][0] + x[j][1]) + (x[j][2] + x[j][3]); }
        if (row + 1 < row1) {
#pragma unroll
            for (int j = 0; j < 4; ++j) xn[j] = *(const f32x4*)(X + (size_t)(row + 1) * DM + 4 * C.lane + 256 * j); }
        const float mean = wave_sum(s) * (1.f / DM); float s2 = 0.f;
#pragma unroll
        for (int j = 0; j < 4; ++j) { x[j] = x[j] - mean; s2 += (x[j][0] * x[j][0] + x[j][1] * x[j][1]) + (x[j][2] * x[j][2] + x[j][3] * x[j][3]); }
        const float rstd = rsqrtf(wave_sum(s2) * (1.f / DM) + LN_EPS);
        if (C.lane == 0) *(f32x2*)(STAT + (size_t)row * 2) = (f32x2){mean, rstd};
        float v[16];
#pragma unroll
        for (int e = 0; e < 16; ++e) v[e] = 0.f;
#pragma unroll
        for (int j = 0; j < 4; ++j) { const int col = 4 * C.lane + 256 * j;
            const f32x4 x1 = x[j] * rstd * lngr[j] + lnbr[j];
            const f32x4 h = x1 * scr[j] + shr[j];
            st4bf(H + (size_t)row * DM + col, h);
#pragma unroll
            for (int e = 0; e < 16; ++e) { const f32x4 w = *(const LAS f32x4*)(wrs + e * 1024 + col); v[e] += (h[0] * w[0] + h[1] * w[1]) + (h[2] * w[2] + h[3] * w[3]); }
            __builtin_amdgcn_sched_barrier(0); }
#pragma unroll
        for (int i = 0; i < 8; ++i) { const float send = (C.lane & 32) ? v[i] : v[i + 8], keep = (C.lane & 32) ? v[i + 8] : v[i]; v[i] = keep + __shfl_xor(send, 32); }
#pragma unroll
        for (int i = 0; i < 4; ++i) { const float send = (C.lane & 16) ? v[i] : v[i + 4], keep = (C.lane & 16) ? v[i + 4] : v[i]; v[i] = keep + __shfl_xor(send, 16); }
#pragma unroll
        for (int i = 0; i < 2; ++i) { const float send = (C.lane & 8) ? v[i] : v[i + 2], keep = (C.lane & 8) ? v[i + 2] : v[i]; v[i] = keep + __shfl_xor(send, 8); }
        { const float send = (C.lane & 4) ? v[0] : v[1], keep = (C.lane & 4) ? v[1] : v[0]; v[0] = keep + __shfl_xor(send, 4); }
        float z = v[0]; z += __shfl_xor(z, 1); z += __shfl_xor(z, 2);
        float mx = z;
#pragma unroll
        for (int o = 4; o < 64; o <<= 1) mx = fmaxf(mx, __shfl_xor(mx, o));
        const float ex = expf(z - mx); float sm = ex;
#pragma unroll
        for (int o = 4; o < 64; o <<= 1) sm += __shfl_xor(sm, o);
        if ((C.lane & 3) == 0) AFF[(size_t)row * 16 + (C.lane >> 2)] = ex / sm;
    }
}

__device__ __forceinline__ void phase_tk(const Ctx& C, const Args& A) {
    unsigned char* ws = A.ws; const float* AFF = (const float*)(ws + WS_AFF); int* SLOT = (int*)(ws + WS_SLOT); int* IDX = (int*)(ws + WS_IDX); float* GATE = (float*)(ws + WS_GATE);
    LAS unsigned* key = (LAS unsigned*)C.lds;
    LAS unsigned* hist = key + 8192;
    LAS unsigned* scn = hist + 256;
    LAS unsigned* wtot = scn + 256;
    LAS unsigned* bc = wtot + 8;
    for (int u = blockIdx.x; u < 128; u += C.G) {
        const bool isctx = u >= 64; const int uu = u & 63, b = uu >> 4, e = uu & 15;
        const int n = isctx ? CTXL : TT, cap = isctx ? CAP_C : CAP_L;
        const int row0 = isctx ? NLAT + b * CTXL : b * TT;
        const int slot0 = e * ESLOTS + (isctx ? 4 * CAP_L + b * CAP_C : b * CAP_L);
        for (int i = C.tid; i < n; i += NTHR) key[i] = __float_as_uint(AFF[(size_t)(row0 + i) * 16 + e]);
        unsigned prefix = 0u, pmask = 0u; int need = cap;
        for (int pass = 0; pass < 4; ++pass) {
            const int shift = 24 - 8 * pass;
            if (C.tid < 256) hist[C.tid] = 0u;
            __syncthreads();
            for (int i = C.tid; i < n; i += NTHR) { const unsigned k = key[i]; if ((k & pmask) == prefix) __hip_atomic_fetch_add(&hist[(k >> shift) & 255u], 1u, __ATOMIC_RELAXED, __HIP_MEMORY_SCOPE_WORKGROUP); }
            __syncthreads();
            {
                const unsigned hd = (C.tid < 256) ? hist[255 - C.tid] : 0u; unsigned inc = hd;
#pragma unroll
                for (int o = 1; o < 64; o <<= 1) { const unsigned t = __shfl_up(inc, o); if (C.lane >= o) inc += t; }
                if (C.tid < 256 && C.lane == 63) wtot[C.wave] = inc;
                __syncthreads();
                if (C.tid < 256) { unsigned base = 0u; for (int w = 0; w < C.wave; ++w) base += wtot[w];
                    const unsigned incl = base + inc, above = incl - hd;
                    if (incl >= (unsigned)need && above < (unsigned)need) { bc[0] = (unsigned)(255 - C.tid); bc[1] = (unsigned)need - above; } }
            }
            __syncthreads();
            prefix |= bc[0] << shift; pmask |= 255u << shift; need = (int)bc[1];
            __syncthreads();
        }
        const int per = (n + NTHR - 1) / NTHR; const int i0 = C.tid * per;
        unsigned cg = 0u, ce = 0u;
        for (int j = 0; j < per; ++j) { const int i = i0 + j; if (i < n) { const unsigned k = key[i]; cg += (k > prefix); ce += (k == prefix); } }
        unsigned pk = cg | (ce << 16), inc = pk;
#pragma unroll
        for (int o = 1; o < 64; o <<= 1) { const unsigned t = __shfl_up(inc, o); if (C.lane >= o) inc += t; }
        if (C.lane == 63) wtot[C.wave] = inc;
        __syncthreads();
        unsigned wbase = 0u;
        for (int w = 0; w < C.wave; ++w) wbase += wtot[w];
        const unsigned excl = wbase + inc - pk;
        unsigned rg = excl & 0xffffu, re = excl >> 16;
        const int ngt = cap - need;
        for (int j = 0; j < per; ++j) { const int i = i0 + j; if (i < n) { const unsigned k = key[i]; int pos = -1;
            if (k > prefix) { pos = (int)rg; ++rg; } else if (k == prefix) { if ((int)re < need) pos = ngt + (int)re; ++re; }
            const int row = row0 + i;
            if (pos >= 0) { IDX[slot0 + pos] = row; GATE[slot0 + pos] = __uint_as_float(k); SLOT[(size_t)row * 16 + e] = slot0 + pos; }
            else SLOT[(size_t)row * 16 + e] = -1; } }
        if (isctx && b == 0 && C.tid < ESLOTS - 4224) { IDX[e * ESLOTS + 4224 + C.tid] = 0; GATE[e * ESLOTS + 4224 + C.tid] = 0.f; }
        __syncthreads();
    }
}

__device__ __forceinline__ void phase_cb(const Ctx& C, const Args& A, int l) {
    unsigned char* ws = A.ws; float* X = (float*)(ws + WS_X); bf16_t* H = (bf16_t*)(ws + WS_H); const int* SLOT = (const int*)(ws + WS_SLOT); const bf16_t* YE = (const bf16_t*)(ws + WS_YE);
    const float* MOD = (const float*)(ws + WS_MOD) + (size_t)l * 5 * 6144; const float* MODN = MOD + 5 * 6144;
    const float* lng = A.in[I_LNG] + (size_t)(l * 2 + 1) * DM; const float* lnb = A.in[I_LNB] + (size_t)(l * 2 + 1) * DM;
    const float* lng1 = A.in[I_LNG] + (size_t)(l * 2 + 0) * DM; const float* lnb1 = A.in[I_LNB] + (size_t)(l * 2 + 0) * DM; const float* STAT = (const float*)(ws + WS_P);
    const int row0 = (int)(((long)C.gw * MROWS) / C.NGW), row1 = (int)(((long)(C.gw + 1) * MROWS) / C.NGW);
    f32x4 lngr[4], lnbr[4], gfr[4], nsc[4], nsh[4], l1g[4], l1b[4]; int cmi = -1;
#pragma unroll
    for (int j = 0; j < 4; ++j) { const int col = 4 * C.lane + 256 * j; lngr[j] = *(const f32x4*)(lng + col); lnbr[j] = *(const f32x4*)(lnb + col); gfr[j] = lngr[j]; nsc[j] = lngr[j]; nsh[j] = lngr[j];
        l1g[j] = *(const f32x4*)(lng1 + col); l1b[j] = *(const f32x4*)(lnb1 + col); }
    int svn = -1; f32x4 xn[4]; f32x2 stn = {0.f, 0.f};
    if (row0 < row1) { svn = SLOT[(size_t)row0 * 16 + (C.lane & 15)]; stn = *(const f32x2*)(STAT + (size_t)row0 * 2);
#pragma unroll
        for (int j = 0; j < 4; ++j) xn[j] = *(const f32x4*)(X + (size_t)row0 * DM + 4 * C.lane + 256 * j); }
    for (int row = row0; row < row1; ++row) {
        const int mi = row_mi(row);
        if (mi != cmi) { cmi = mi; const float* md = MOD + mi * 6144; const float* mn = MODN + mi * 6144;
#pragma unroll
            for (int j = 0; j < 4; ++j) { const int col = 4 * C.lane + 256 * j; gfr[j] = *(const f32x4*)(md + 5 * DM + col);
                if (l < DEPTH - 1) { nsc[j] = *(const f32x4*)(mn + DM + col) + 1.f; nsh[j] = *(const f32x4*)(mn + col); } } }
        const int sv = svn;
        unsigned mask = (unsigned)__ballot(sv >= 0) & 0xffffu;
        f32x4 acc[4];
#pragma unroll
        for (int j = 0; j < 4; ++j) acc[j] = (f32x4){0.f, 0.f, 0.f, 0.f};
        u32x2 y0[4], y1[4]; bool h0 = false, h1 = false;
        if (mask) { const int e = __builtin_ctz(mask); mask &= mask - 1; h0 = true; const int sl = __builtin_amdgcn_readlane(sv, e);
#pragma unroll
            for (int j = 0; j < 4; ++j) y0[j] = *(const u32x2*)(YE + (size_t)sl * DM + 4 * C.lane + 256 * j); }
        if (mask) { const int e = __builtin_ctz(mask); mask &= mask - 1; h1 = true; const int sl = __builtin_amdgcn_readlane(sv, e);
#pragma unroll
            for (int j = 0; j < 4; ++j) y1[j] = *(const u32x2*)(YE + (size_t)sl * DM + 4 * C.lane + 256 * j); }
        f32x4 x[4]; const f32x2 st = stn;
#pragma unroll
        for (int j = 0; j < 4; ++j) x[j] = xn[j];
        if (row + 1 < row1) { svn = SLOT[(size_t)(row + 1) * 16 + (C.lane & 15)]; stn = *(const f32x2*)(STAT + (size_t)(row + 1) * 2);
#pragma unroll
            for (int j = 0; j < 4; ++j) xn[j] = *(const f32x4*)(X + (size_t)(row + 1) * DM + 4 * C.lane + 256 * j); }
        if (h0) {
#pragma unroll
            for (int j = 0; j < 4; ++j) acc[j] += (f32x4){__uint_as_float(y0[j].x << 16), __uint_as_float(y0[j].x & 0xffff0000u), __uint_as_float(y0[j].y << 16), __uint_as_float(y0[j].y & 0xffff0000u)}; }
        if (h1) {
#pragma unroll
            for (int j = 0; j < 4; ++j) acc[j] += (f32x4){__uint_as_float(y1[j].x << 16), __uint_as_float(y1[j].x & 0xffff0000u), __uint_as_float(y1[j].y << 16), __uint_as_float(y1[j].y & 0xffff0000u)}; }
        while (mask) { const int e = __builtin_ctz(mask); mask &= mask - 1; const int sl = __builtin_amdgcn_readlane(sv, e);
#pragma unroll
            for (int j = 0; j < 4; ++j) acc[j] += ld4bf(YE + (size_t)sl * DM + 4 * C.lane + 256 * j); }
        float sm = 0.f;
#pragma unroll
        for (int j = 0; j < 4; ++j) { x[j] = ((x[j] - st[0]) * st[1] * l1g[j] + l1b[j]) * ALPHA_DN + gfr[j] * acc[j];
            sm += (x[j][0] + x[j][1]) + (x[j][2] + x[j][3]); }
        const float mean = wave_sum(sm) * (1.f / DM); float s2 = 0.f;
#pragma unroll
        for (int j = 0; j < 4; ++j) { x[j] = x[j] - mean; s2 += (x[j][0] * x[j][0] + x[j][1] * x[j][1]) + (x[j][2] * x[j][2] + x[j][3] * x[j][3]); }
        const float rstd = rsqrtf(wave_sum(s2) * (1.f / DM) + LN_EPS);
#pragma unroll
        for (int j = 0; j < 4; ++j) { const int col = 4 * C.lane + 256 * j;
            const f32x4 x2 = x[j] * rstd * lngr[j] + lnbr[j];
            if (l < DEPTH - 1) { *(f32x4*)(X + (size_t)row * DM + col) = x2; st4bf(H + (size_t)row * DM + col, x2 * nsc[j] + nsh[j]); }
            else if (row < NLAT) *(f32x4*)(A.out + (size_t)row * DM + col) = x2; }
    }
}


#ifndef GEMM_NOINLINE
#define GEMM_NOINLINE 0
#endif
#if GEMM_NOINLINE
#define GEMM_FN __device__ __noinline__
#else
#define GEMM_FN __device__ __forceinline__
#endif
GEMM_FN void gphase_in(LAS unsigned char* lds, unsigned char* ws, int nN, int G) {
    int bx = blockIdx.x; asm volatile("" : "+s"(bx), "+s"(G));
    pg8::Gemm g{(const bf16_t*)(ws + WS_H), (const bf16_t*)(ws + WS_WIN), DM}; pg8::Order<0> S; S.init(MROWS / 256, nN, G, bx, nullptr, 0);
    pg8::EpiBf16 E{(bf16_t*)(ws + WS_P), P_LD}; pg8::gemm_phase(lds, g, S, E); }
GEMM_FN void gphase_in_odd(LAS unsigned char* lds, unsigned char* ws, int G) {
    int bx = blockIdx.x; asm volatile("" : "+s"(bx), "+s"(G));
    pg8::Gemm g{(const bf16_t*)(ws + WS_H), (const bf16_t*)(ws + WS_WIN), DM}; pg8::Order<0> S; S.init(MROWS / 256, D_IN_ODD / 256, G, bx, nullptr, 0);
    pg8::EpiOdd E{(bf16_t*)(ws + WS_P), (bf16_t*)(ws + WS_Q), (bf16_t*)(ws + WS_KA), (const float*)(ws + WS_ROPE)}; pg8::gemm_phase(lds, g, S, E); }
GEMM_FN void gphase_lora(LAS unsigned char* lds, unsigned char* ws, const float* d0, const float* a0, const float* kal, int G) {
    int bx = blockIdx.x; asm volatile("" : "+s"(bx), "+s"(G));
    pg8::Gemm g{(const bf16_t*)(ws + WS_LIN), (const bf16_t*)(ws + WS_WLORA), LORA_K}; pg8::Order<0> S; S.init(MROWS / 256, LORA_N / 256, G, bx, nullptr, 0);
    pg8::EpiLora E{ws + WS_SCN, (bf16_t*)(ws + WS_G), d0, a0, kal}; pg8::gemm_phase(lds, g, S, E); }
GEMM_FN void gphase_out(LAS unsigned char* lds, unsigned char* ws, const float* modl, int G, const float* xin, const float* cin) {
    int bx = blockIdx.x; asm volatile("" : "+s"(bx), "+s"(G));
    pg8::Gemm g{(const bf16_t*)(ws + WS_A2), (const bf16_t*)(ws + WS_WOUT), DM}; pg8::Order<0> S; S.init(MROWS / 256, DM / 256, G, bx, nullptr, 0);
    pg8::EpiRes E{(float*)(ws + WS_X), modl, xin, cin}; pg8::gemm_phase(lds, g, S, E); }
GEMM_FN void gphase_e1(LAS unsigned char* lds, unsigned char* ws, int G, int l) {
    int bx = blockIdx.x; asm volatile("" : "+s"(bx), "+s"(G));
    pg8::Gemm g{(const bf16_t*)(ws + WS_H), (const bf16_t*)(ws + WS_WE13 + (size_t)(l & 1) * WE13_BYTES), DM}; pg8::EpiSwiGLU E{(bf16_t*)(ws + WS_HID)};
    pg8::OrderExp<1> S; S.init(4096 / 256, G, bx, (const int*)(ws + WS_IDX), (long)4096 * DM); pg8::gemm_phase(lds, g, S, E); }
GEMM_FN void gphase_e2(LAS unsigned char* lds, unsigned char* ws, int G, int l) {
    int bx = blockIdx.x; asm volatile("" : "+s"(bx), "+s"(G));
    pg8::Gemm g{(const bf16_t*)(ws + WS_HID), (const bf16_t*)(ws + WS_WE2 + (size_t)(l & 1) * WE2_BYTES), D_EXP}; pg8::EpiYE E{(bf16_t*)(ws + WS_YE), (const float*)(ws + WS_GATE)};
    pg8::OrderExp<2> S; S.init(DM / 256, G, bx, nullptr, (long)DM * D_EXP); pg8::gemm_phase(lds, g, S, E); }

constexpr int NSLOT = 13;
constexpr int NSTEP = 1 + DEPTH * NSLOT;
__global__ void __launch_bounds__(NTHR, 2) mk_fwd(Args KA) {
    extern __shared__ __attribute__((aligned(16))) unsigned char lds_raw[];
    volatile LAS unsigned* MISC = (volatile LAS unsigned*)((LAS unsigned char*)lds_raw + LDS_MISC);
    if (threadIdx.x < 16) MISC[threadIdx.x] = 0u;
    if (threadIdx.x == 0) { LAS unsigned long long* tb = (LAS unsigned long long*)((LAS unsigned char*)lds_raw + LDS_PTAB);
#pragma unroll
        for (int i = 0; i < 37; ++i) tb[i] = (unsigned long long)KA.in[i];
        tb[37] = (unsigned long long)KA.out; tb[38] = (unsigned long long)KA.ws; }
    __syncthreads();
    const int lo = KA.lo, hi = KA.hi;
    unsigned bar_x = 0;
    if (hi - lo > 1) { const XcdBarrier b0 = xcd_barrier_post((unsigned*)(KA.ws + WS_CTL), MISC); bar_x = b0.x; }
#ifndef PH_MASK
#define PH_MASK 0xFFFFFF
#endif
#ifndef REP_MASK
#define REP_MASK 0
#endif
#define PH_BIT(k) (((k) == 0) ? 0 : 1 + ((k) - 1) % NSLOT + (((k) - 1) % NSLOT >= 2 && ((k) - 1) % NSLOT <= 3 && odd ? 12 : 0))
#define RUN(k, ...) do { if (((PH_MASK >> PH_BIT(k)) & 1) && lo <= (k) && (k) < hi) { const int nrep = ((REP_MASK >> PH_BIT(k)) & 1) ? 2 : 1; \
        _Pragma("unroll 1") for (int rep = 0; rep < nrep; ++rep) { \
        Ctx C; mkctx(C, (LAS unsigned char*)lds_raw); Args A; ldargs(A, (LAS unsigned char*)lds_raw); unsigned char* ws = A.ws; \
        const float* MODL = (const float*)(ws + WS_MOD) + (size_t)l * 5 * 6144; (void)MODL; \
        __VA_ARGS__; if ((k) + 1 < hi || rep + 1 < nrep) { XcdBarrier bar; bar.bar = (unsigned*)(ws + WS_CTL); bar.x = bar_x; bar.st = MISC; xcd_barrier(bar); } } } } while (0)
    { const bool odd = false; const int l = 0; RUN(0, { phase_init(C, A); __syncthreads(); conv_items(C, A, 0, C.gw, C.NGW, true, true, true); }); }
#pragma unroll 1
    for (int l = 0; l < DEPTH; ++l) {
        const int sb = 1 + l * NSLOT; const bool odd = l & 1;
        if (!(CHUNKED_SCAN && odd)) { RUN(sb + 0, { phase_conv(C, A, l); if (l == 0) phase_modh(C, A, 0); }); }
        if (odd) { RUN(sb + 1, gphase_in_odd(C.lds, ws, C.G)); } else { RUN(sb + 1, gphase_in(C.lds, ws, D_IN_EVEN_PAD / 256, C.G)); }
        if (!odd) {
            RUN(sb + 2, phase_ef1(C, A, l));
            RUN(sb + 3, { const int i2 = l >> 1; gphase_lora(C.lds, ws, A.in[I_D0] + (size_t)i2 * 2 * 768, A.in[I_A0] + (size_t)i2 * 2 * 768, A.in[I_KAL] + (size_t)i2 * 768, C.G); });
#if CHUNKED_SCAN
            RUN(sb + 4, phase_csa(C, A));
            RUN(sb + 5, phase_csb(C, A, l));
#else
            RUN(sb + 4, phase_scan(C, A));
#endif
            RUN(sb + 6, phase_ef2(C, A, l));
        } else {
            RUN(sb + 2, phase_of1(C, A, l));
            RUN(sb + 3, phase_attn(C, A, l));
        }
        RUN(sb + 7, gphase_out(C.lds, ws, MODL, C.G, l == 0 ? A.in[I_X] : (const float*)(ws + WS_X), l == 0 ? A.in[I_CTX] : (const float*)(ws + WS_X) + (size_t)NLAT * DM));
        RUN(sb + 8, phase_rt(C, A, l));
        RUN(sb + 9, phase_tk(C, A));
        RUN(sb + 10, gphase_e1(C.lds, ws, C.G, l));
        RUN(sb + 11, gphase_e2(C.lds, ws, C.G, l));
        RUN(sb + 12, { phase_cb(C, A, l); if (CHUNKED_SCAN && !odd && l + 1 < DEPTH) { __syncthreads(); conv_items(C, A, l + 1, C.gw, C.NGW, false, true, false); } });
    }
#undef RUN
}

#ifdef PHASE_PROBE
#define PROBE_PRE extern __shared__ __attribute__((aligned(16))) unsigned char lds_raw[]; Ctx C; mkctx(C, (LAS unsigned char*)lds_raw); unsigned char* ws = A.ws; (void)ws;
__global__ void __launch_bounds__(NTHR, 2) pr_init(Args A) { PROBE_PRE phase_init(C, A); }
__global__ void __launch_bounds__(NTHR, 2) pr_conv(Args A) { PROBE_PRE phase_conv(C, A, A.lo); }
__global__ void __launch_bounds__(NTHR, 2) pr_modh(Args A) { PROBE_PRE phase_modh(C, A, A.lo); }
__global__ void __launch_bounds__(NTHR, 2) pr_ef1(Args A) { PROBE_PRE phase_ef1(C, A, A.lo); }
__global__ void __launch_bounds__(NTHR, 2) pr_scan(Args A) { PROBE_PRE phase_scan(C, A); }
__global__ void __launch_bounds__(NTHR, 2) pr_ef2(Args A) { PROBE_PRE phase_ef2(C, A, A.lo); }
__global__ void __launch_bounds__(NTHR, 2) pr_csa(Args A) { PROBE_PRE phase_csa(C, A); }
__global__ void __launch_bounds__(NTHR, 2) pr_csb(Args A) { PROBE_PRE phase_csb(C, A, A.lo); }
__global__ void __launch_bounds__(NTHR, 2) pr_of1(Args A) { PROBE_PRE phase_of1(C, A, A.lo); }
__global__ void __launch_bounds__(NTHR, 2) pr_attn(Args A) { PROBE_PRE phase_attn(C, A, A.lo); }
__global__ void __launch_bounds__(NTHR, 2) pr_rt(Args A) { PROBE_PRE phase_rt(C, A, A.lo); }
__global__ void __launch_bounds__(NTHR, 2) pr_tk(Args A) { PROBE_PRE phase_tk(C, A); }
__global__ void __launch_bounds__(NTHR, 2) pr_cb(Args A) { PROBE_PRE phase_cb(C, A, A.lo); }
__global__ void __launch_bounds__(NTHR, 2) pr_gemm_in(Args A) { PROBE_PRE pg8::Gemm g{(const bf16_t*)(ws + WS_H), (const bf16_t*)(ws + WS_WIN), DM}; pg8::Order<0> S; S.init(MROWS / 256, A.lo, C.G, (int)blockIdx.x, nullptr, 0);
                      pg8::EpiBf16 E{(bf16_t*)(ws + WS_P), P_LD}; pg8::gemm_phase(C.lds, g, S, E); }
__global__ void __launch_bounds__(NTHR, 2) pr_gemm_lora(Args A) { PROBE_PRE pg8::Gemm g{(const bf16_t*)(ws + WS_LIN), (const bf16_t*)(ws + WS_WLORA), LORA_K}; pg8::Order<0> S; S.init(MROWS / 256, LORA_N / 256, C.G, (int)blockIdx.x, nullptr, 0);
                          const int i2 = A.lo; pg8::EpiLora E{ws + WS_SCN, (bf16_t*)(ws + WS_G), A.in[I_D0] + (size_t)i2 * 2 * 768, A.in[I_A0] + (size_t)i2 * 2 * 768, A.in[I_KAL] + (size_t)i2 * 768};
                          pg8::gemm_phase(C.lds, g, S, E); }
__global__ void __launch_bounds__(NTHR, 2) pr_gemm_out(Args A) { PROBE_PRE pg8::Gemm g{(const bf16_t*)(ws + WS_A2), (const bf16_t*)(ws + WS_WOUT), DM}; pg8::Order<0> S; S.init(MROWS / 256, DM / 256, C.G, (int)blockIdx.x, nullptr, 0);
                      pg8::EpiRes E{(float*)(ws + WS_X), (const float*)(ws + WS_MOD), (const float*)(ws + WS_X), (const float*)(ws + WS_X) + (size_t)NLAT * DM}; pg8::gemm_phase(C.lds, g, S, E); }
__global__ void __launch_bounds__(NTHR, 2) pr_gemm_e1(Args A) { PROBE_PRE pg8::Gemm g{(const bf16_t*)(ws + WS_H), (const bf16_t*)(ws + WS_WE13), DM}; pg8::Order<1> S; S.init(NEXP * 17, 4096 / 256, C.G, (int)blockIdx.x, (const int*)(ws + WS_IDX), (long)4096 * DM);
                      pg8::EpiSwiGLU E{(bf16_t*)(ws + WS_HID)}; pg8::gemm_phase(C.lds, g, S, E); }
__global__ void __launch_bounds__(NTHR, 2) pr_gemm_e2(Args A) { PROBE_PRE pg8::Gemm g{(const bf16_t*)(ws + WS_HID), (const bf16_t*)(ws + WS_WE2), D_EXP}; pg8::Order<2> S; S.init(NEXP * 17, DM / 256, C.G, (int)blockIdx.x, nullptr, (long)DM * D_EXP);
                       pg8::EpiYE E{(bf16_t*)(ws + WS_YE), (const float*)(ws + WS_GATE)}; pg8::gemm_phase(C.lds, g, S, E); }
#endif

extern "C" void kernel_launch(void* const* d_in, const int* in_sizes, int n_in, void* d_out, int out_size, void* d_ws, size_t ws_size, hipStream_t stream) {
    static int grid = 0;
    if (grid == 0) {
        if (n_in != 37 || out_size != NLAT * DM || ws_size < WS_END) { fprintf(stderr, "kernel_launch: unexpected shapes: n_in %d out %d ws %zu (need %zu)\n", n_in, out_size, ws_size, (size_t)WS_END); grid = -1; return; }
        int dev = 0, cus = 0, per_cu = 0;
        if (hipGetDevice(&dev) != hipSuccess || hipDeviceGetAttribute(&cus, hipDeviceAttributeMultiprocessorCount, dev) != hipSuccess) { grid = -1; return; }
        if (hipFuncSetAttribute((const void*)mk_fwd, hipFuncAttributeMaxDynamicSharedMemorySize, LDS_BYTES) != hipSuccess) { fprintf(stderr, "kernel_launch: hipFuncSetAttribute failed\n"); grid = -1; return; }
        if (hipOccupancyMaxActiveBlocksPerMultiprocessor(&per_cu, (const void*)mk_fwd, NTHR, LDS_BYTES) != hipSuccess || per_cu < 1) fprintf(stderr, "kernel_launch: occupancy query reports %d\n", per_cu);
        (void)hipGetLastError();
        grid = cus;
    }
    if (grid < 0) return;
    (void)hipMemsetAsync((char*)d_ws + WS_CTL, 0, CTL_BYTES, stream);
    Args a{};
    for (int i = 0; i < 37; ++i) a.in[i] = (const float*)d_in[i];
    a.out = (float*)d_out; a.ws = (unsigned char*)d_ws;
#if MK_MULTI
    for (int k = 0; k < NSTEP; ++k) {
        if (k >= 1) { const int l = (k - 1) / NSLOT, s = (k - 1) % NSLOT; if ((l & 1) && ((s >= 4 && s <= 6) || (CHUNKED_SCAN && s == 0))) continue; if (!(l & 1) && !CHUNKED_SCAN && s == 5) continue; }
        a.lo = k; a.hi = k + 1;
        hipLaunchKernelGGL(mk_fwd, dim3(grid), dim3(NTHR), LDS_BYTES, stream, a);
    }
#else
    a.lo = 0; a.hi = NSTEP;
    hipLaunchKernelGGL(mk_fwd, dim3(grid), dim3(NTHR), LDS_BYTES, stream, a);
#endif
    const hipError_t le = hipPeekAtLastError();
    if (le != hipSuccess) fprintf(stderr, "kernel_launch: launch failed: %s\n", hipGetErrorName(le));
}
```

```cpp
#include <hip/hip_runtime.h>
#include <cstdio>
#include <cstdint>
#include <cmath>

#ifndef MK_MULTI
#define MK_MULTI 0
#endif
#ifndef CHUNKED_SCAN
#define CHUNKED_SCAN 1
#endif

#define GAS __attribute__((address_space(1)))
#define LAS __attribute__((address_space(3)))
typedef unsigned short bf16_t;
typedef short bf16x8 __attribute__((ext_vector_type(8)));
typedef float f32x4 __attribute__((ext_vector_type(4)));
typedef float f32x2 __attribute__((ext_vector_type(2)));
typedef float f32x16 __attribute__((ext_vector_type(16)));
typedef unsigned u32x4 __attribute__((ext_vector_type(4)));
typedef unsigned u32x2 __attribute__((ext_vector_type(2)));
typedef __bf16 bf16x2_t __attribute__((ext_vector_type(2)));

constexpr int NB = 4, TT = 8192, DM = 1024, NLAT = NB * TT, CTXL = 256, NCTX = NB * CTXL, MROWS = NLAT + NCTX;
constexpr int DEPTH = 4;
constexpr int D_CONV = 256, RW_H = 12, RW_K = 64, D_RWKV = 768, RWKV_COLS = 2688, D_IN_EVEN = 3456, D_IN_EVEN_PAD = 3584;
constexpr int D_DIFF = 768, D_GMLP = 256, D_IN_ODD = 2816;
constexpr int NEXP = 16, D_EXP = 2048, CAP_L = 1024, CAP_C = 32, ESLOTS = 4352;
constexpr int P_LD = 3584;
constexpr int LORA_K = 384, LORA_N = 3840;
constexpr int LKEYS = CTXL + TT;
constexpr float ALPHA_DN = 1.6817928305074290f;
constexpr float DECAY_SCALE = 0.6065306597126334f;
constexpr float GN_EPS = 64e-5f, LN_EPS = 1e-5f, RMS_EPS = 1e-5f;
constexpr float QSCALE = 0.125f * 1.4426950408889634f;

constexpr size_t al256(size_t x) { return (x + 255) & ~(size_t)255; }
constexpr size_t WS_CTL = 0;
constexpr size_t CTL_BYTES = 65536;
constexpr size_t WS_MOD = WS_CTL + CTL_BYTES;
constexpr size_t WS_ROPE = WS_MOD + al256((size_t)DEPTH * 5 * 6144 * 4);
constexpr size_t WS_WIN = WS_ROPE + 32768;
constexpr size_t WS_WOUT = WS_WIN + (size_t)D_IN_EVEN_PAD * DM * 2;
constexpr size_t WS_WLORA = WS_WOUT + (size_t)DM * DM * 2;
constexpr size_t WS_WE13 = WS_WLORA + (size_t)LORA_N * LORA_K * 2;
constexpr size_t WE13_BYTES = (size_t)NEXP * 4096 * DM * 2, WE2_BYTES = (size_t)NEXP * DM * D_EXP * 2;
constexpr size_t WS_WE2 = WS_WE13 + 2 * WE13_BYTES;
constexpr size_t WS_X = WS_WE2 + 2 * WE2_BYTES;
constexpr size_t WS_H = WS_X + (size_t)MROWS * DM * 4;
constexpr size_t WS_A2 = WS_H + (size_t)MROWS * DM * 2;
constexpr size_t WS_P = WS_A2 + (size_t)MROWS * DM * 2;
constexpr size_t WS_AFF = WS_P + (size_t)MROWS * P_LD * 2;
constexpr size_t WS_SLOT = WS_AFF + (size_t)MROWS * 16 * 4;
constexpr size_t WS_IDX = WS_SLOT + (size_t)MROWS * 16 * 4;
constexpr size_t WS_GATE = WS_IDX + al256((size_t)NEXP * ESLOTS * 4);
constexpr size_t WS_R2 = WS_GATE + al256((size_t)NEXP * ESLOTS * 4);
constexpr int SC_REC = 1408, SC_ROW = 12 * SC_REC, SC_W = 0, SC_R = 512, SC_KK = 640, SC_V = 768, SC_B = 896, SC_KR = 1024;
constexpr size_t WS_SCN = WS_R2;
constexpr size_t WS_G = WS_SCN + (size_t)MROWS * SC_ROW;
constexpr size_t WS_LIN = WS_G + (size_t)MROWS * 768 * 2;
constexpr int CS_L = 64, CS_NCH = LKEYS / CS_L, CS_UNITS = NB * RW_H * 2;
constexpr size_t WS_CHK = WS_LIN + (size_t)MROWS * 384 * 2;
constexpr size_t WS_EVEN_END = WS_CHK + (size_t)CS_UNITS * CS_NCH * 32768;
constexpr size_t WS_Y = WS_P;
constexpr size_t WS_Q = WS_R2;
constexpr size_t WS_KA = WS_Q + (size_t)MROWS * 768 * 2;
constexpr size_t WS_VT = WS_KA + (size_t)NB * LKEYS * 768 * 2;
constexpr size_t WS_HID = WS_R2;
constexpr size_t WS_YE = WS_HID + (size_t)NEXP * ESLOTS * D_EXP * 2;
constexpr size_t WS_END = WS_EVEN_END;
static_assert(WS_END <= (size_t)2147483648ull, "workspace over 2 GiB");
static_assert((size_t)2 * MROWS * 768 * 4 <= (size_t)MROWS * P_LD * 2, "Y aliases P");
static_assert(WS_YE + (size_t)NEXP * ESLOTS * DM * 2 <= WS_END, "moe region");

constexpr int LDS_BYTES = 147456;
constexpr int LDS_MISC = 140 * 1024;
constexpr int LDS_PTAB = LDS_MISC + 256;
constexpr int NWAVES = 8, NTHR = 512;

__device__ __forceinline__ unsigned f2bf(float f) { unsigned u = __float_as_uint(f); return (u + 0x7fffu + ((u >> 16) & 1u)) >> 16; }
__device__ __forceinline__ unsigned pk2(float lo, float hi) { f32x2 v = {lo, hi}; bf16x2_t b = __builtin_convertvector(v, bf16x2_t); return __builtin_bit_cast(unsigned, b); }
__device__ __forceinline__ float bflo(unsigned u) { return __uint_as_float(u << 16); }
__device__ __forceinline__ float bfhi(unsigned u) { return __uint_as_float(u & 0xffff0000u); }
__device__ __forceinline__ float bf2f(bf16_t b) { return __uint_as_float((unsigned)b << 16); }
__device__ __forceinline__ float sigmoidf_(float x) { return 1.f / (1.f + __expf(-x)); }
__device__ __forceinline__ float wave_sum(float v) {
#pragma unroll
    for (int o = 1; o < 64; o <<= 1) v += __shfl_xor(v, o);
    return v;
}
__device__ __forceinline__ float sum16(float v) {
#pragma unroll
    for (int o = 1; o < 16; o <<= 1) v += __shfl_xor(v, o);
    return v;
}
__device__ __forceinline__ f32x4 ld4bf_(const void* p) { const u32x2 u = *(const u32x2*)p; return (f32x4){bflo(u.x), bfhi(u.x), bflo(u.y), bfhi(u.y)}; }
__device__ __forceinline__ void st4bf_(void* p, f32x4 v) { u32x2 o; o.x = pk2(v[0], v[1]); o.y = pk2(v[2], v[3]); *(u32x2*)p = o; }
__device__ __forceinline__ float max3f(float a, float b, float c) { float r; asm("v_max3_f32 %0, %1, %2, %3" : "=v"(r) : "v"(a), "v"(b), "v"(c)); return r; }
__device__ __forceinline__ int crow(int r, int hi) { return (r & 3) + 8 * (r >> 2) + 4 * hi; }
__device__ __forceinline__ float gelu_erf(float x) { return 0.5f * x * (1.f + erff(x * 0.70710678118654752f)); }

#define XB_TMO      128
#define XB_XCNT(j)  (256  + 64 * (j))
#define XB_XSUB(j)  (1280 + 64 * (j))
#define XB_XGEN(j)  (2304 + 64 * (j))
#define XB_TOP      3328
#define XB_TOPGEN   3392
#define XCD_BAR_WORDS 3456
#define XB_SPIN_CAP (1u << 20)

__device__ __forceinline__ unsigned xb_ld(unsigned* p)              { return __hip_atomic_load(p, __ATOMIC_RELAXED, __HIP_MEMORY_SCOPE_AGENT); }
__device__ __forceinline__ unsigned xb_add(unsigned* p, unsigned v) { return __hip_atomic_fetch_add(p, v, __ATOMIC_RELAXED, __HIP_MEMORY_SCOPE_AGENT); }
__device__ __forceinline__ unsigned xb_xcc_id() { return (unsigned)__builtin_amdgcn_s_getreg((3 << 11) | 20) & 0xFu; }
#define XB_SPIN(cond, bar) do { unsigned _sp = 0; while (cond) { __builtin_amdgcn_s_sleep(1); \
    if ((++_sp & 255u) == 0u) { if (xb_ld(&(bar)[XB_TMO])) break; if (_sp > XB_SPIN_CAP) { atomicAdd(&(bar)[XB_TMO], 1u); break; } } } } while (0)

struct XcdBarrier { unsigned* bar; unsigned x; volatile LAS unsigned* st; };

__device__ __forceinline__ XcdBarrier xcd_barrier_post(unsigned* bar, volatile LAS unsigned* st) {
    XcdBarrier b; b.bar = bar; b.x = xb_xcc_id(); b.st = st;
    if (threadIdx.x == 0) (void)xb_add(&bar[XB_XCNT(b.x)], 1u);
    return b;
}
__device__ __forceinline__ void xcd_barrier_complete(unsigned* bar, unsigned x, unsigned& nloc, unsigned& nx) {
    const unsigned G = gridDim.x * gridDim.y * gridDim.z;
    unsigned sum, cnt, mine, sp = 0u;
    for (;;) {
        sum = 0u; cnt = 0u; mine = 0u;
#pragma unroll
        for (unsigned j = 0; j < 16; ++j) { const unsigned c = xb_ld(&bar[XB_XCNT(j)]); sum += c; cnt += (c > 0u) ? 1u : 0u; mine = (j == x) ? c : mine; }
        if (sum == G) break;
        __builtin_amdgcn_s_sleep(1);
        if ((++sp & 255u) == 0u) { if (xb_ld(&bar[XB_TMO])) break; if (sp > XB_SPIN_CAP) { atomicAdd(&bar[XB_TMO], 1u); break; } }
    }
    nloc = mine > 0u ? mine : 1u; nx = cnt > 0u ? cnt : 1u;
}
__device__ __forceinline__ void xcd_barrier(const XcdBarrier& b) {
    asm volatile("s_waitcnt vmcnt(0)" ::: "memory");
    __syncthreads();
    if (threadIdx.x == 0) {
        unsigned* bar = b.bar;
        __builtin_amdgcn_s_waitcnt(0);
        unsigned nloc = b.st[0], nx = b.st[1];
        if (nloc == 0u) { xcd_barrier_complete(bar, b.x, nloc, nx); b.st[0] = nloc; b.st[1] = nx; }
        const unsigned old = xb_add(&bar[XB_XSUB(b.x)], 1u);
        const unsigned gen = old / nloc;
        if (old + 1u == (gen + 1u) * nloc) {
            __builtin_amdgcn_fence(__ATOMIC_RELEASE, "agent");
            asm volatile("s_waitcnt vmcnt(0)" ::: "memory");
            const unsigned og = xb_add(&bar[XB_TOP], 1u);
            const unsigned tg = og / nx;
            if (og + 1u == (tg + 1u) * nx) xb_add(&bar[XB_TOPGEN], 1u);
            else XB_SPIN(xb_ld(&bar[XB_TOPGEN]) == tg, bar);
            __builtin_amdgcn_fence(__ATOMIC_ACQUIRE, "agent");
            xb_add(&bar[XB_XGEN(b.x)], 1u);
            asm volatile("s_waitcnt vmcnt(0)" ::: "memory");
        } else {
            XB_SPIN(xb_ld(&bar[XB_XGEN(b.x)]) == gen, bar);
            __builtin_amdgcn_fence(__ATOMIC_ACQUIRE, "agent");
            asm volatile("s_waitcnt vmcnt(0)" ::: "memory");
        }
    }
    __syncthreads();
}

namespace pg8 {
constexpr int BM = 256, BK = 64, HALF = 128, HTB = HALF * BK * 2, STAGE_BYTES = 8 * HTB, NXCD = 8, WGM = 8;
__host__ __device__ __forceinline__ int lds_byte(int r, int c) { const int st = (r >> 4) * 2 + (c >> 5), rr = r & 15, cc = c & 31, ob = rr * 64 + cc * 2; return st * 1024 + (ob ^ (((ob >> 9) & 1) << 5)); }
__host__ __device__ __forceinline__ void stage_rc(int b, int& R, int& C) { const int st = b / 1024, sb = b % 1024, swz = sb ^ (((sb >> 9) & 1) << 5); R = (st >> 1) * 16 + swz / 64; C = (st & 1) * 32 + (swz % 64) / 2; }

struct Unit { int pm, pn, hf; };
struct Gemm { const bf16_t* A; const bf16_t* Bt; int K; };

template <int MODE> struct Order {
    static constexpr bool GATHER = (MODE == 1);
    int nM, nN, nwg, G, c; const int* idx; long bstride;
    __device__ __forceinline__ void init(int nM_, int nN_, int G_, int c_, const int* idx_, long bstride_) { nM = nM_; nN = nN_; nwg = nM * nN; G = G_; c = c_; idx = idx_; bstride = bstride_; }
    __device__ __forceinline__ bool next(int i, Unit& u) const {
        const long L = (long)i * G + c; if (L >= nwg) return false;
        int wgid = (int)L; { const int q = nwg / NXCD, r = nwg % NXCD, xcd = wgid % NXCD, off = wgid / NXCD; wgid = (xcd < r ? xcd * (q + 1) : r * (q + 1) + (xcd - r) * q) + off; }
        const int nig = WGM * nN, gid = wgid / nig, fm = gid * WGM, gsz = (nM - fm) < WGM ? (nM - fm) : WGM;
        u.pm = fm + ((wgid % nig) % gsz); u.pn = (wgid % nig) / gsz; u.hf = (MODE != 0 && (u.pm % 17) == 16) ? 1 : 0; return true;
    }
    __device__ __forceinline__ unsigned arow(const Unit& u, int r) const { if (MODE == 1) return (unsigned)idx[u.pm * BM + r]; return (unsigned)(u.pm * BM + r); }
    __device__ __forceinline__ long bbase(const Unit& u, int K) const { long o = (long)u.pn * BM * K; if (MODE != 0) o += (long)(u.pm / 17) * bstride; return o; }
};

template <int MODE> struct OrderExp {
    static constexpr bool GATHER = (MODE == 1);
    int nN, G, c0; const int* idx; long bstride;
    __device__ __forceinline__ void init(int nN_, int G_, int c_, const int* idx_, long bstride_) { nN = nN_; G = G_; c0 = c_; idx = idx_; bstride = bstride_; }
    __device__ __forceinline__ bool next(int i0, Unit& u) const {
        const int v = i0 * G + c0, i = v >> 8, c = v & 255;
        const int x = c & 7, slot = c >> 3, per = 32 / nN, nfull = 256 / (8 * per);
        if (i > nfull) return false;
        if (i < nfull) { u.pn = slot / per; const int f = (i * 8 + x) * per + (slot % per); u.pm = (f >> 4) * 17 + (f & 15); u.hf = 0; return true; }
        if (i == nfull && slot < 2 * nN) { u.pn = slot >> 1; u.pm = (x * 2 + (slot & 1)) * 17 + 16; u.hf = 1; return true; }
        return false;
    }
    __device__ __forceinline__ unsigned arow(const Unit& u, int r) const { if (MODE == 1) return (unsigned)idx[u.pm * BM + r]; return (unsigned)(u.pm * BM + r); }
    __device__ __forceinline__ long bbase(const Unit& u, int K) const { return (long)u.pn * BM * K + (long)(u.pm / 17) * bstride; }
};

template <class Epi, class Sched>
__device__ __forceinline__ void gemm_phase(LAS unsigned char* lds, const Gemm g, const Sched& S, const Epi& E) {
    int tid = threadIdx.x; asm volatile("" : "+v"(tid));
    const int wid = __builtin_amdgcn_readfirstlane(tid >> 6), wr = wid >> 2, wc = wid & 3;
    const int K = g.K, nt = K / BK;
    unsigned voffB[2];
    { const int lane = tid & 63, fr = lane & 15, fq = lane >> 4; (void)fr; (void)fq; }
#pragma unroll
    for (int i = 0; i < 2; ++i) { int R, Cc; stage_rc(tid * 16 + i * 8192, R, Cc); voffB[i] = (unsigned)(R * K + Cc) * 2u; }
    const size_t kstep = (size_t)(BK * 2);
    const size_t hstep = (size_t)HALF * K * 2;
    const unsigned ldsw = (unsigned)wid * 1024u;
    const int aoff = lds_byte(wr * 64 + (tid & 15), ((tid & 63) >> 4) * 8), boff = lds_byte(wc * 32 + (tid & 15), ((tid & 63) >> 4) * 8);
#define PG8_SA(b, h) (((b) * 2 + (h)) * HTB)
#define PG8_SB(b, h) ((4 + (b) * 2 + (h)) * HTB)
#define PG8_STAGE(bufoff, gbase, voff) do { _Pragma("unroll") for (int _i = 0; _i < 2; ++_i) \
        __builtin_amdgcn_global_load_lds((const unsigned*)((const char*)(gbase) + (voff)[_i]), (LAS unsigned*)(lds + (bufoff) + ldsw + _i * 8192), 16, 0, 0); } while (0)
#define PG8_LDA(dst, b, h) do { _Pragma("unroll") for (int m = 0; m < 4; ++m) _Pragma("unroll") for (int k = 0; k < 2; ++k) dst[m][k] = *(const LAS bf16x8*)(lds + PG8_SA(b, h) + aoff + m * 2048 + k * 1024); } while (0)
#define PG8_LDB(dst, b, h) do { _Pragma("unroll") for (int n = 0; n < 2; ++n) _Pragma("unroll") for (int k = 0; k < 2; ++k) dst[n][k] = *(const LAS bf16x8*)(lds + PG8_SB(b, h) + boff + n * 2048 + k * 1024); } while (0)
#define PG8_MMA(ai, bj, At, Bt) do { __builtin_amdgcn_s_setprio(1); _Pragma("unroll") for (int m = 0; m < 4; ++m) _Pragma("unroll") for (int n = 0; n < 2; ++n) _Pragma("unroll") for (int k = 0; k < 2; ++k) \
        acc[ai][bj][m][n] = __builtin_amdgcn_mfma_f32_16x16x32_bf16(Bt[n][k], At[m][k], acc[ai][bj][m][n], 0, 0, 0); __builtin_amdgcn_s_setprio(0); } while (0)
#define PG8_WAIT_V(n) asm volatile("s_waitcnt vmcnt(" #n ")" ::: "memory")
#define PG8_WAIT_L(n) asm volatile("s_waitcnt lgkmcnt(" #n ")" ::: "memory")
#define PG8_BAR __builtin_amdgcn_s_barrier()
#define PG8_SCHED __builtin_amdgcn_sched_barrier(0)
#define PG8_ROWOFFS(dst, u, tq) do { _Pragma("unroll") for (int _i = 0; _i < 2; ++_i) { int _R, _C; stage_rc((tq) * 16 + _i * 8192, _R, _C); _Pragma("unroll") for (int _h = 0; _h < 2; ++_h) dst[_h][_i] = (S.arow(u, _h * HALF + _R) * (unsigned)K + (unsigned)_C) * 2u; } } while (0)
    Unit cur, nxt; int ui = 0;
    if (!S.next(0, cur)) return;
    float zf = 0.f; asm volatile("" : "+v"(zf));
    f32x4 acc[2][2][4][2];
#pragma unroll
    for (int a = 0; a < 2; ++a)
#pragma unroll
        for (int b = 0; b < 2; ++b)
#pragma unroll
            for (int m = 0; m < 4; ++m)
#pragma unroll
                for (int n = 0; n < 2; ++n) acc[a][b][m][n] = (f32x4){zf, zf, zf, zf};
    bf16x8 At[4][2], B0[2][2], B1[2][2];
    unsigned vcur[2][2];
    if constexpr (Sched::GATHER) { PG8_ROWOFFS(vcur, cur, tid); }
    const char* const Ab = (const char*)g.A;
    const char* cA = Sched::GATHER ? Ab : Ab + (size_t)(unsigned)__builtin_amdgcn_readfirstlane((int)S.arow(cur, 0)) * K * 2;
#define PG8_STAGEA(bufoff, ptr, h) do { if constexpr (Sched::GATHER) { PG8_STAGE(bufoff, ptr, vcur[h]); } else { PG8_STAGE(bufoff, (ptr) + (h) * hstep, voffB); } } while (0)
    const char* cB = (const char*)g.Bt + (size_t)S.bbase(cur, K) * 2;
    PG8_STAGE(PG8_SB(0, 0), cB, voffB); PG8_STAGE(PG8_SB(0, 1), cB + hstep, voffB); PG8_STAGEA(PG8_SA(0, 0), cA, 0); PG8_STAGEA(PG8_SA(0, 1), cA, 1);
    if (wr == 1) PG8_BAR;
    PG8_WAIT_V(2); PG8_BAR;
    PG8_STAGE(PG8_SB(1, 0), cB + kstep, voffB); PG8_STAGEA(PG8_SA(1, 0), cA + kstep, 0); PG8_STAGE(PG8_SB(1, 1), cB + hstep + kstep, voffB);
    PG8_WAIT_V(6); PG8_BAR;
    for (;;) {
        const bool has_next = S.next(ui + 1, nxt);
        const char* nB = has_next ? (const char*)g.Bt + (size_t)S.bbase(nxt, K) * 2 : cB;
        const char* nA = (Sched::GATHER || !has_next) ? cA : Ab + (size_t)(unsigned)__builtin_amdgcn_readfirstlane((int)S.arow(nxt, 0)) * K * 2;
#pragma unroll 1
        for (int t = 0; t < nt; t += 2) {
            const bool last = (t == nt - 2);
            const char* a1 = cA + (size_t)(t + 1) * kstep;
            const char* a2 = last ? nA : cA + (size_t)(t + 2) * kstep; const char* b2 = last ? nB : cB + (size_t)(t + 2) * kstep;
            const char* a3 = a2 + kstep; const char* b3 = b2 + kstep;
            PG8_LDB(B0, 0, 0); PG8_LDB(B1, 0, 1); PG8_SCHED; PG8_LDA(At, 0, 0); PG8_STAGEA(PG8_SA(1, 1), a1, 1);
            PG8_WAIT_V(8); PG8_WAIT_L(0); PG8_BAR; PG8_MMA(0, 0, At, B0); PG8_MMA(0, 1, At, B1); PG8_BAR; PG8_SCHED;
            if constexpr (Sched::GATHER) { if (last && has_next) { int tq = tid; asm volatile("" : "+v"(tq)); PG8_ROWOFFS(vcur, nxt, tq); } }
            PG8_LDA(At, 0, 1); PG8_STAGE(PG8_SB(0, 0), b2, voffB); PG8_STAGE(PG8_SB(0, 1), b2 + hstep, voffB); PG8_STAGEA(PG8_SA(0, 0), a2, 0);
            PG8_WAIT_V(8); PG8_WAIT_L(0); PG8_BAR; if (!cur.hf) { PG8_MMA(1, 0, At, B0); PG8_MMA(1, 1, At, B1); } PG8_BAR; PG8_SCHED;
            PG8_LDB(B0, 1, 0); PG8_LDB(B1, 1, 1); PG8_SCHED; PG8_LDA(At, 1, 0); PG8_STAGEA(PG8_SA(0, 1), a2, 1);
            PG8_WAIT_V(8); PG8_WAIT_L(0); PG8_BAR; PG8_MMA(0, 0, At, B0); PG8_MMA(0, 1, At, B1); PG8_BAR; PG8_SCHED;
            PG8_LDA(At, 1, 1); PG8_STAGE(PG8_SB(1, 0), b3, voffB); PG8_STAGE(PG8_SB(1, 1), b3 + hstep, voffB); PG8_STAGEA(PG8_SA(1, 0), a3, 0);
            PG8_WAIT_V(8); PG8_WAIT_L(0); PG8_BAR; if (!cur.hf) { PG8_MMA(1, 0, At, B0); PG8_MMA(1, 1, At, B1); } PG8_BAR; PG8_SCHED;
        }
        if (wr == 0) PG8_BAR;
        { int tz = tid; asm volatile("" : "+v"(tz)); const int ln = tz & 63; E(acc, cur, wr, wc, ln & 15, ln >> 4); }
        if (!has_next) break;
#pragma unroll
        for (int a = 0; a < 2; ++a)
#pragma unroll
            for (int b = 0; b < 2; ++b)
#pragma unroll
                for (int m = 0; m < 4; ++m)
#pragma unroll
                    for (int n = 0; n < 2; ++n) acc[a][b][m][n] = (f32x4){zf, zf, zf, zf};
        cur = nxt; cB = nB; cA = nA; ++ui;
        if (wr == 1) PG8_BAR;
    }
    PG8_WAIT_V(0);
    PG8_BAR;
#undef PG8_SA
#undef PG8_SB
#undef PG8_STAGE
#undef PG8_LDA
#undef PG8_LDB
#undef PG8_MMA
#undef PG8_WAIT_V
#undef PG8_WAIT_L
#undef PG8_BAR
#undef PG8_SCHED
#undef PG8_ROWOFFS
#undef PG8_STAGEA
}

#define EPI_LOOP for (int ai = 0; ai < 2; ++ai) for (int m = 0; m < 4; ++m) for (int bj = 0; bj < 2; ++bj) for (int n = 0; n < 2; ++n)
struct EpiBf16 {
    bf16_t* O; int ldc;
    __device__ __forceinline__ void operator()(const f32x4 (&acc)[2][2][4][2], const Unit& u, int wr, int wc, int fr, int fq) const {
        const int row0 = u.pm * BM + wr * 64 + fr, col0 = u.pn * BM + wc * 32 + 4 * fq;
#pragma unroll
        for (int ai = 0; ai < 2; ++ai)
#pragma unroll
            for (int m = 0; m < 4; ++m) { bf16_t* rowp = O + (size_t)(row0 + ai * HALF + m * 16) * ldc + col0;
#pragma unroll
                for (int bj = 0; bj < 2; ++bj)
#pragma unroll
                    for (int n = 0; n < 2; ++n) { const f32x4 v = acc[ai][bj][m][n]; u32x2 o; o.x = pk2(v[0], v[1]); o.y = pk2(v[2], v[3]); *(u32x2*)(rowp + bj * HALF + n * 16) = o; } }
    }
};
struct EpiOdd {
    bf16_t* P; bf16_t* Q; bf16_t* KA; const float* rope;
    __device__ __forceinline__ void operator()(const f32x4 (&acc)[2][2][4][2], const Unit& u, int wr, int wc, int fr, int fq) const {
        const int row0 = u.pm * BM + wr * 64 + fr, col0 = u.pn * BM + wc * 32 + 4 * fq;
        if (u.pn >= 6) {
#pragma unroll
            for (int ai = 0; ai < 2; ++ai)
#pragma unroll
                for (int m = 0; m < 4; ++m) { bf16_t* rowp = P + (size_t)(row0 + ai * HALF + m * 16) * P_LD + col0;
#pragma unroll
                    for (int bj = 0; bj < 2; ++bj)
#pragma unroll
                        for (int n = 0; n < 2; ++n) { const f32x4 v = acc[ai][bj][m][n]; u32x2 o; o.x = pk2(v[0], v[1]); o.y = pk2(v[2], v[3]); *(u32x2*)(rowp + bj * HALF + n * 16) = o; } }
            return;
        }
        const bool isk = u.pn >= 3, isctx = u.pm >= NLAT / BM; const int axis = wc & 1;
        const int cq = col0 - (isk ? 768 : 0);
        f32x4 csr[2][4], snr[2][4];
#pragma unroll
        for (int ai = 0; ai < 2; ++ai)
#pragma unroll
            for (int m = 0; m < 4; ++m) { const int row = row0 + ai * HALF + m * 16; csr[ai][m] = (f32x4){1.f, 1.f, 1.f, 1.f}; snr[ai][m] = (f32x4){0.f, 0.f, 0.f, 0.f};
                if (!isctx) { const int t = row & (TT - 1); const int pos = axis ? 128 + (t & 63) : (t >> 6);
                    csr[ai][m] = *(const f32x4*)(rope + pos * 16 + 4 * fq); snr[ai][m] = *(const f32x4*)(rope + 192 * 16 + pos * 16 + 4 * fq); } }
#pragma unroll
        for (int ai = 0; ai < 2; ++ai)
#pragma unroll
            for (int m = 0; m < 4; ++m) { const int row = row0 + ai * HALF + m * 16;
                const f32x4 cs = csr[ai][m], sn = snr[ai][m]; size_t orow;
                if (!isctx) { const int t = row & (TT - 1); orow = isk ? (size_t)(row >> 13) * LKEYS + CTXL + t : (size_t)row; }
                else { const int rc = row - NLAT; orow = isk ? (size_t)(rc >> 8) * LKEYS + (rc & 255) : (size_t)row; }
                bf16_t* op = (isk ? KA : Q) + orow * 768 + cq; const float sc = isk ? 1.f : QSCALE;
#pragma unroll
                for (int bj = 0; bj < 2; ++bj) { const f32x4 x1 = acc[ai][bj][m][0], x2 = acc[ai][bj][m][1];
                    const f32x4 o1 = (x1 * cs - x2 * sn) * sc, o2 = (x1 * sn + x2 * cs) * sc;
                    u32x2 a; a.x = pk2(o1[0], o1[1]); a.y = pk2(o1[2], o1[3]); *(u32x2*)(op + bj * HALF) = a;
                    u32x2 b; b.x = pk2(o2[0], o2[1]); b.y = pk2(o2[2], o2[3]); *(u32x2*)(op + bj * HALF + 16) = b; } }
    }
};
struct EpiRes {
    float* X; const float* modl; const float* xin; const float* cin;
    __device__ __forceinline__ void operator()(const f32x4 (&acc)[2][2][4][2], const Unit& u, int wr, int wc, int fr, int fq) const {
        const int row0 = u.pm * BM + wr * 64 + fr, col0 = u.pn * BM + wc * 32 + 4 * fq;
        const int mi = (u.pm * BM < NLAT) ? (u.pm * BM) / TT : 4;
        const float* gate = modl + mi * 6144 + 2 * DM;
        const float* rsrc = (u.pm * BM < NLAT) ? xin : cin - (size_t)NLAT * DM;
        f32x4 gv[2][2];
#pragma unroll
        for (int bj = 0; bj < 2; ++bj)
#pragma unroll
            for (int n = 0; n < 2; ++n) gv[bj][n] = *(const f32x4*)(gate + col0 + bj * HALF + n * 16);
#pragma unroll
        for (int ai = 0; ai < 2; ++ai) { f32x4 xr[4][2][2];
#pragma unroll
            for (int m = 0; m < 4; ++m) { const float* rowp = rsrc + (size_t)(row0 + ai * HALF + m * 16) * DM + col0;
#pragma unroll
                for (int bj = 0; bj < 2; ++bj)
#pragma unroll
                    for (int n = 0; n < 2; ++n) xr[m][bj][n] = *(const f32x4*)(rowp + bj * HALF + n * 16); }
#pragma unroll
            for (int m = 0; m < 4; ++m) { float* rowp = X + (size_t)(row0 + ai * HALF + m * 16) * DM + col0;
#pragma unroll
                for (int bj = 0; bj < 2; ++bj)
#pragma unroll
                    for (int n = 0; n < 2; ++n) *(f32x4*)(rowp + bj * HALF + n * 16) = xr[m][bj][n] * ALPHA_DN + gv[bj][n] * acc[ai][bj][m][n]; } }
    }
};
struct EpiSwiGLU {
    bf16_t* HID;
    __device__ __forceinline__ void operator()(const f32x4 (&acc)[2][2][4][2], const Unit& u, int wr, int wc, int fr, int fq) const {
        const int row0 = u.pm * BM + wr * 64 + fr, f0 = u.pn * HALF + wc * 32 + 4 * fq;
#pragma unroll
        for (int ai = 0; ai < 2; ++ai) if (ai == 0 || !u.hf)
#pragma unroll
            for (int m = 0; m < 4; ++m) { bf16_t* rowp = HID + (size_t)(row0 + ai * HALF + m * 16) * D_EXP + f0;
#pragma unroll
                for (int n = 0; n < 2; ++n) { const f32x4 a = acc[ai][0][m][n], b = acc[ai][1][m][n]; float h[4];
#pragma unroll
                    for (int j = 0; j < 4; ++j) h[j] = a[j] / (1.f + __expf(-a[j])) * b[j];
                    u32x2 o; o.x = pk2(h[0], h[1]); o.y = pk2(h[2], h[3]); *(u32x2*)(rowp + n * 16) = o; } }
    }
};
struct EpiYE {
    bf16_t* YE; const float* gate;
    __device__ __forceinline__ void operator()(const f32x4 (&acc)[2][2][4][2], const Unit& u, int wr, int wc, int fr, int fq) const {
        const int row0 = u.pm * BM + wr * 64 + fr, col0 = u.pn * BM + wc * 32 + 4 * fq;
        float gts[2][4];
#pragma unroll
        for (int ai = 0; ai < 2; ++ai)
#pragma unroll
            for (int m = 0; m < 4; ++m) gts[ai][m] = gate[row0 + ai * HALF + m * 16];
#pragma unroll
        for (int ai = 0; ai < 2; ++ai) if (ai == 0 || !u.hf)
#pragma unroll
            for (int m = 0; m < 4; ++m) { const int row = row0 + ai * HALF + m * 16; const float gt = gts[ai][m]; bf16_t* rowp = YE + (size_t)row * DM + col0;
#pragma unroll
                for (int bj = 0; bj < 2; ++bj)
#pragma unroll
                    for (int n = 0; n < 2; ++n) { const f32x4 v = acc[ai][bj][m][n] * gt; u32x2 o; o.x = pk2(v[0], v[1]); o.y = pk2(v[2], v[3]); *(u32x2*)(rowp + bj * HALF + n * 16) = o; } }
    }
};
struct EpiLora {
    unsigned char* SCN; bf16_t* G; const float* decay0; const float* a0; const float* kalpha;
    __device__ __forceinline__ void operator()(const f32x4 (&acc)[2][2][4][2], const Unit& u, int wr, int wc, int fr, int fq) const {
        const int row0 = u.pm * BM + wr * 64 + fr;
        const int seg = u.pn / 3, cb = (u.pn % 3) * BM + wc * 32 + 4 * fq;
        f32x4 par0[2][2], par1[2][2];
#pragma unroll
        for (int bj = 0; bj < 2; ++bj)
#pragma unroll
            for (int n = 0; n < 2; ++n) { const int col = cb + bj * HALF + n * 16; par0[bj][n] = (f32x4){0.f, 0.f, 0.f, 0.f}; par1[bj][n] = par0[bj][n];
                if (seg < 2) par0[bj][n] = *(const f32x4*)(decay0 + seg * 768 + col);
                else if (seg < 4) { par0[bj][n] = *(const f32x4*)(a0 + (seg - 2) * 768 + col); par1[bj][n] = *(const f32x4*)(kalpha + col); } }
#pragma unroll
        for (int bj = 0; bj < 2; ++bj)
#pragma unroll
            for (int n = 0; n < 2; ++n) {
                const int col = cb + bj * HALF + n * 16, head = col >> 6, kx = col & 63;
                if (seg < 2) {
                    const f32x4 d0 = par0[bj][n];
#pragma unroll
                    for (int ai = 0; ai < 2; ++ai)
#pragma unroll
                        for (int m = 0; m < 4; ++m) { const int row = row0 + ai * HALF + m * 16; f32x4 w;
#pragma unroll
                            for (int j = 0; j < 4; ++j) { const float lw = -DECAY_SCALE * sigmoidf_(d0[j] + acc[ai][bj][m][n][j]); w[j] = CHUNKED_SCAN ? lw : __expf(lw); }
                            *(f32x4*)(SCN + (size_t)(row * 12 + head) * SC_REC + SC_W + seg * 256 + kx * 4) = w; __builtin_amdgcn_sched_barrier(0); }
                } else if (seg < 4) {
                    const int d = seg - 2;
                    const f32x4 a00 = par0[bj][n], kal = par1[bj][n];
                    u32x2 kkr[2][4], ksr[2][4];
#pragma unroll
                    for (int ai = 0; ai < 2; ++ai)
#pragma unroll
                        for (int m = 0; m < 4; ++m) { const unsigned char* base = SCN + (size_t)((row0 + ai * HALF + m * 16) * 12 + head) * SC_REC + kx * 2;
                            kkr[ai][m] = *(const u32x2*)(base + SC_KK); ksr[ai][m] = *(const u32x2*)(base + SC_KR + 256 * d); }
#pragma unroll
                    for (int ai = 0; ai < 2; ++ai)
#pragma unroll
                        for (int m = 0; m < 4; ++m) { const int row = row0 + ai * HALF + m * 16; unsigned char* base = SCN + (size_t)(row * 12 + head) * SC_REC + kx * 2;
                            const f32x4 kk = {bflo(kkr[ai][m].x), bfhi(kkr[ai][m].x), bflo(kkr[ai][m].y), bfhi(kkr[ai][m].y)}; const f32x4 ks = {bflo(ksr[ai][m].x), bfhi(ksr[ai][m].x), bflo(ksr[ai][m].y), bfhi(ksr[ai][m].y)}; f32x4 bb, kr;
#pragma unroll
                            for (int j = 0; j < 4; ++j) { const float a = sigmoidf_(a00[j] + acc[ai][bj][m][n][j]); bb[j] = kk[j] * a; kr[j] = ks[j] * (1.f + (a - 1.f) * kal[j]); }
                            st4bf_(base + SC_B + 256 * d, bb); st4bf_(base + SC_KR + 256 * d, kr); __builtin_amdgcn_sched_barrier(0); }
                } else {
#pragma unroll
                    for (int ai = 0; ai < 2; ++ai)
#pragma unroll
                        for (int m = 0; m < 4; ++m) { const int row = row0 + ai * HALF + m * 16; const f32x4 v = acc[ai][bj][m][n]; u32x2 o; o.x = pk2(v[0], v[1]); o.y = pk2(v[2], v[3]);
                            *(u32x2*)(G + (size_t)row * 768 + col) = o; }
                }
            }
    }
};
}

struct Args { const float* in[37]; float* out; unsigned char* ws; int lo, hi; };
enum { I_X = 0, I_C, I_CTX, I_CCTX, I_WMOD, I_BMOD, I_LNG, I_LNB, I_EWIN, I_EWOUT, I_CONVW, I_MU, I_DUP, I_D0, I_AUP, I_A0, I_GUP, I_KXI, I_KAL, I_RBON, I_GNG, I_GNB,
       I_OWIN, I_OWOUT, I_LQ1, I_LK1, I_LQ2, I_LK2, I_SUBG, I_GLNG, I_GLNB, I_GWS, I_GBS, I_WR, I_WE1, I_WE3, I_WE2 };

struct Ctx {
    LAS unsigned char* lds;
    int tid, lane, wave, G, vcu, gw, NGW;
};
__device__ __forceinline__ void mkctx(Ctx& C, LAS unsigned char* lds) {
    int tid = threadIdx.x; asm volatile("" : "+v"(tid));
    C.lds = lds; C.tid = tid; C.lane = tid & 63; C.wave = __builtin_amdgcn_readfirstlane(tid >> 6);
    C.G = gridDim.x; { const int bx = blockIdx.x; C.vcu = (C.G % 8 == 0) ? (bx % 8) * (C.G / 8) + bx / 8 : bx; }
    C.gw = blockIdx.x * NWAVES + C.wave; C.NGW = C.G * NWAVES;
}
#define GLOBAL_PTR(T, v) ((T*)(__attribute__((address_space(1))) T*)(v))
__device__ __forceinline__ void ldargs(Args& A, LAS unsigned char* lds) {
    LAS const u32x2* tb = (LAS const u32x2*)(lds + LDS_PTAB); asm volatile("" : "+v"(tb));
#pragma unroll
    for (int i = 0; i < 37; ++i) { const u32x2 v = tb[i]; A.in[i] = GLOBAL_PTR(const float, ((unsigned long long)(unsigned)__builtin_amdgcn_readfirstlane((int)v.y) << 32) | (unsigned)__builtin_amdgcn_readfirstlane((int)v.x)); }
    { const u32x2 v = tb[37]; A.out = GLOBAL_PTR(float, ((unsigned long long)(unsigned)__builtin_amdgcn_readfirstlane((int)v.y) << 32) | (unsigned)__builtin_amdgcn_readfirstlane((int)v.x)); }
    { const u32x2 v = tb[38]; A.ws = GLOBAL_PTR(unsigned char, ((unsigned long long)(unsigned)__builtin_amdgcn_readfirstlane((int)v.y) << 32) | (unsigned)__builtin_amdgcn_readfirstlane((int)v.x)); }
    A.lo = 0; A.hi = 0;
}
__device__ __forceinline__ int row_mi(int row) { return row < NLAT ? (row >> 13) : 4; }

__device__ __forceinline__ void phase_init(const Ctx& C, const Args& A) {
    unsigned char* ws = A.ws;
    float* MOD = (float*)(ws + WS_MOD);
    LAS float* sv = (LAS float*)C.lds;
    LAS float* red = sv + 5 * 1024;
    for (int i = C.tid; i < 5 * 1024; i += NTHR) { const int v = i >> 10, k = i & 1023; const float c = (v < 4) ? A.in[I_C][v * DM + k] : A.in[I_CCTX][k]; sv[i] = c / (1.f + __expf(-c)); }
    __syncthreads();
    const int j = C.tid & 127, kp = C.tid >> 7;
    for (int it = blockIdx.x; it < DEPTH * 48; it += C.G) {
        const int l = it / 48, cg = it % 48, col = cg * 128 + j;
        const float* W = A.in[I_WMOD] + (size_t)l * DM * 6144 + col;
        float a0 = 0.f, a1 = 0.f, a2 = 0.f, a3 = 0.f, a4 = 0.f;
#pragma unroll 32
        for (int k = kp * 256; k < kp * 256 + 256; ++k) { const float w = W[(size_t)k * 6144];     a0 += sv[k] * w; a1 += sv[1024 + k] * w; a2 += sv[2048 + k] * w; a3 += sv[3072 + k] * w; a4 += sv[4096 + k] * w; }
        red[(kp * 5 + 0) * 128 + j] = a0; red[(kp * 5 + 1) * 128 + j] = a1; red[(kp * 5 + 2) * 128 + j] = a2; red[(kp * 5 + 3) * 128 + j] = a3; red[(kp * 5 + 4) * 128 + j] = a4;
        __syncthreads();
        for (int o = C.tid; o < 5 * 128; o += NTHR) { const int v = o >> 7, jj = o & 127; const int cc = cg * 128 + jj;
            const float s = red[(0 * 5 + v) * 128 + jj] + red[(1 * 5 + v) * 128 + jj] + red[(2 * 5 + v) * 128 + jj] + red[(3 * 5 + v) * 128 + jj];
            MOD[((size_t)l * 5 + v) * 6144 + cc] = s + A.in[I_BMOD][l * 6144 + cc]; }
        __syncthreads();
    }
    if (blockIdx.x == C.G - 1) { float* rope = (float*)(ws + WS_ROPE);
        for (int i = C.tid; i < 192 * 16; i += NTHR) { const int pos = i >> 4, j = i & 15; const float ang = (float)(pos < 128 ? pos : pos - 128) * powf(10000.f, -(float)j * (1.f / 16.f));
            rope[i] = cosf(ang); rope[192 * 16 + i] = sinf(ang); } }
}

__device__ __forceinline__ void transpose_item(const float* W, int ldw, int k0, int n0, bf16_t* WT, int ldt, int drow0, LAS float* scr, int lane) {
    { float v[64]; const float* src = W + (size_t)k0 * ldw + n0 + lane;
#pragma unroll
      for (int k = 0; k < 64; ++k) v[k] = __builtin_nontemporal_load(src + (size_t)k * ldw);
#pragma unroll
      for (int k = 0; k < 64; ++k) scr[k * 65 + lane] = v[k]; }
    asm volatile("s_waitcnt lgkmcnt(0)" ::: "memory");
    const int c = lane & 7;
#pragma unroll
    for (int j = 0; j < 8; ++j) { const int n = (lane >> 3) + 8 * j; const LAS float* s = scr + (8 * c) * 65 + n;
        u32x4 o; o.x = pk2(s[0 * 65], s[1 * 65]); o.y = pk2(s[2 * 65], s[3 * 65]); o.z = pk2(s[4 * 65], s[5 * 65]); o.w = pk2(s[6 * 65], s[7 * 65]);
        *(u32x4*)(WT + (size_t)(drow0 + n) * ldt + k0 + 8 * c) = o; }
    asm volatile("s_waitcnt lgkmcnt(0)" ::: "memory");
}
constexpr int XW_IN_HI = 3200, XW_OUT_HI = 7040, XW_TK_HI = 9088;
constexpr int YW_IN_HI = 1344, YW_OF_HI = 6144, YW_OUT_HI = 9984, YW_TK_HI = 12032;
__device__ __forceinline__ void conv_items(const Ctx& C, const Args& A, int l, int gw, int NGW, bool do_in, bool do_out, bool do_exp, int lo = 0, int hi = 1 << 30) {
    unsigned char* ws = A.ws;
    const int i2 = l >> 1; const bool odd = (l & 1);
    LAS float* scr = (LAS float*)C.lds + C.wave * (64 * 65);
    bf16_t* WIN = (bf16_t*)(ws + WS_WIN); bf16_t* WOUT = (bf16_t*)(ws + WS_WOUT); bf16_t* WE13 = (bf16_t*)(ws + WS_WE13 + (size_t)(l & 1) * WE13_BYTES); bf16_t* WE2 = (bf16_t*)(ws + WS_WE2 + (size_t)(l & 1) * WE2_BYTES);
    const int nin = odd ? D_IN_ODD : D_IN_EVEN;
    const float* win = odd ? A.in[I_OWIN] + (size_t)i2 * DM * D_IN_ODD : A.in[I_EWIN] + (size_t)i2 * DM * D_IN_EVEN;
    const float* wout = odd ? A.in[I_OWOUT] + (size_t)i2 * DM * DM : A.in[I_EWOUT] + (size_t)i2 * DM * DM;
    const int n_in = do_in ? 16 * (nin / 64) : 0, n_out = do_out ? 16 * 16 : 0, n_e13 = do_exp ? NEXP * 2 * 16 * 32 : 0, n_e2 = do_exp ? NEXP * 32 * 16 : 0;
    const int total = (n_in + n_out + n_e13 + n_e2) < hi ? (n_in + n_out + n_e13 + n_e2) : hi;
    for (int it = lo + gw; it < total; it += NGW) {
        int r = it;
        if (r < n_in) { const int nb = nin / 64, kb = r / nb, nn = r % nb; transpose_item(win, nin, kb * 64, nn * 64, WIN, DM, nn * 64, scr, C.lane); continue; } r -= n_in;
        if (r < n_out) { const int kb = r / 16, nn = r % 16; transpose_item(wout, DM, kb * 64, nn * 64, WOUT, DM, nn * 64, scr, C.lane); continue; } r -= n_out;
        if (r < n_e13) { const int e = r / 1024, q = r % 1024, mat = q / 512, q2 = q % 512, kb = q2 / 32, nn = q2 % 32;
            const float* W = (mat ? A.in[I_WE3] : A.in[I_WE1]) + ((size_t)l * NEXP + e) * DM * D_EXP;
            const int f0 = nn * 64; const int drow = (f0 >> 7) * 256 + mat * 128 + (f0 & 127);
            transpose_item(W, D_EXP, kb * 64, f0, WE13 + (size_t)e * 4096 * DM, DM, drow, scr, C.lane); continue; } r -= n_e13;
        { const int e = r / 512, q = r % 512, kb = q / 16, nn = q % 16;
            const float* W = A.in[I_WE2] + ((size_t)l * NEXP + e) * D_EXP * DM;
            transpose_item(W, DM, kb * 64, nn * 64, WE2 + (size_t)e * DM * D_EXP, D_EXP, nn * 64, scr, C.lane); }
    }
}
__device__ __forceinline__ void phase_conv(const Ctx& C, const Args& A, int l) {
    unsigned char* ws = A.ws;
    const int i2 = l >> 1; const bool odd = (l & 1);
    bf16_t* WIN = (bf16_t*)(ws + WS_WIN);
    const bool early = CHUNKED_SCAN && odd;
    if (l > 0) { if (early || !CHUNKED_SCAN) conv_items(C, A, l, C.gw, C.NGW, !early, true, !early);
                 else { conv_items(C, A, l, C.gw, C.NGW, true, true, false); conv_items(C, A, l, C.gw, C.NGW, false, false, true, YW_TK_HI); } }
    if (!odd) {
        u32x4* z = (u32x4*)(WIN + (size_t)D_IN_EVEN * DM);
        unsigned zz = 0u; asm volatile("" : "+v"(zz));
        for (int i = blockIdx.x * NTHR + C.tid; i < (D_IN_EVEN_PAD - D_IN_EVEN) * DM / 8; i += C.G * NTHR) z[i] = (u32x4){zz, zz, zz, zz};
        bf16_t* WL = (bf16_t*)(ws + WS_WLORA);
        const float* dup = A.in[I_DUP] + (size_t)i2 * 2 * 64 * 768; const float* aup = A.in[I_AUP] + (size_t)i2 * 2 * 64 * 768; const float* gup = A.in[I_GUP] + (size_t)i2 * 128 * 768;
        for (int i = blockIdx.x * NTHR + C.tid; i < LORA_N * LORA_K; i += C.G * NTHR) {
            const int kk = i / LORA_N, n = i % LORA_N, seg = n / 768, col = n % 768; float v = 0.f;
            if (seg == 0) { if (kk < 64) v = dup[(size_t)(0 * 64 + kk) * 768 + col]; }
            else if (seg == 1) { if (kk >= 64 && kk < 128) v = dup[(size_t)(1 * 64 + kk - 64) * 768 + col]; }
            else if (seg == 2) { if (kk >= 128 && kk < 192) v = aup[(size_t)(0 * 64 + kk - 128) * 768 + col]; }
            else if (seg == 3) { if (kk >= 192 && kk < 256) v = aup[(size_t)(1 * 64 + kk - 192) * 768 + col]; }
            else { if (kk >= 256) v = gup[(size_t)(kk - 256) * 768 + col]; }
            WL[(size_t)n * LORA_K + kk] = (bf16_t)f2bf(v);
        }
    }
}

__device__ __forceinline__ void phase_modh(const Ctx& C, const Args& A, int l) {
    bf16_t* H = (bf16_t*)(A.ws + WS_H); const float* MOD = (const float*)(A.ws + WS_MOD) + (size_t)l * 5 * 6144;
    const float* xin = A.in[I_X]; const float* cin = A.in[I_CTX] - (size_t)NLAT * DM;
#define MODH_SRC(row_) (((row_) < NLAT ? xin : cin) + (size_t)(row_) * DM)
    const int row0 = (int)(((long)C.gw * MROWS) / C.NGW), row1 = (int)(((long)(C.gw + 1) * MROWS) / C.NGW);
    f32x4 shr[4], scr_[4], xn[4]; int cmi = -1;
    if (row0 < row1) {
#pragma unroll
        for (int j = 0; j < 4; ++j) xn[j] = *(const f32x4*)(MODH_SRC(row0) + 4 * C.lane + 256 * j); }
#pragma unroll
    for (int j = 0; j < 4; ++j) { shr[j] = (f32x4){0.f, 0.f, 0.f, 0.f}; scr_[j] = shr[j]; }
    for (int row = row0; row < row1; ++row) {
        const int mi = row_mi(row);
        if (mi != cmi) { cmi = mi; const float* md = MOD + mi * 6144;
#pragma unroll
            for (int j = 0; j < 4; ++j) { const int col = 4 * C.lane + 256 * j; shr[j] = *(const f32x4*)(md + col); scr_[j] = *(const f32x4*)(md + DM + col) + 1.f; } }
        f32x4 x[4];
#pragma unroll
        for (int j = 0; j < 4; ++j) x[j] = xn[j];
        if (row + 1 < row1) {
#pragma unroll
            for (int j = 0; j < 4; ++j) xn[j] = *(const f32x4*)(MODH_SRC(row + 1) + 4 * C.lane + 256 * j); }
#pragma unroll
        for (int j = 0; j < 4; ++j) { const int col = 4 * C.lane + 256 * j; const f32x4 h = x[j] * scr_[j] + shr[j]; u32x2 o; o.x = pk2(h[0], h[1]); o.y = pk2(h[2], h[3]); *(u32x2*)(H + (size_t)row * DM + col) = o; }
    }
}

__device__ __forceinline__ f32x4 ld4bf(const bf16_t* p) { const u32x2 u = *(const u32x2*)p; return (f32x4){bflo(u.x), bfhi(u.x), bflo(u.y), bfhi(u.y)}; }
__device__ __forceinline__ void st4bf(bf16_t* p, f32x4 v) { u32x2 o; o.x = pk2(v[0], v[1]); o.y = pk2(v[2], v[3]); *(u32x2*)p = o; }
__device__ __forceinline__ void seq_info(int row, bool& hasp, bool& hasn) {
    if (row < NLAT) { const int t = row & (TT - 1); hasp = t > 0; hasn = t < TT - 1; }
    else { const int t = (row - NLAT) & (CTXL - 1); hasp = t > 0; hasn = t < CTXL - 1; }
}
struct Ef1Row { u32x2 bg, ua, ub, m[11]; };
__device__ __forceinline__ f32x4 bf4(u32x2 u) { return (f32x4){bflo(u.x), bfhi(u.x), bflo(u.y), bfhi(u.y)}; }
__device__ __forceinline__ void ef1_load(Ef1Row& R, const bf16_t* P, int row, int lane) {
    row = row < 0 ? 0 : row > MROWS - 1 ? MROWS - 1 : row;
    const bf16_t* p = P + (size_t)row * P_LD + 4 * lane;
    R.bg = *(const u32x2*)p; R.ua = *(const u32x2*)(p + 256); R.ub = *(const u32x2*)(p + 512);
#pragma unroll
    for (int it = 0; it < 11; ++it) R.m[it] = *(const u32x2*)(p + 768 + it * 256);
}
__device__ __forceinline__ void phase_ef1(const Ctx& C, const Args& A, int l) {
    const int i2 = l >> 1; unsigned char* ws = A.ws;
    const bf16_t* P = (const bf16_t*)(ws + WS_P); bf16_t* A2 = (bf16_t*)(ws + WS_A2); unsigned char* SCN = ws + WS_SCN; bf16_t* LIN = (bf16_t*)(ws + WS_LIN);
    const float* cw = A.in[I_CONVW] + (size_t)i2 * 3 * 256; const float* mu = A.in[I_MU] + (size_t)i2 * RWKV_COLS; const float* kxi = A.in[I_KXI] + (size_t)i2 * 768;
    const int j4 = 4 * C.lane;
    const f32x4 w0 = *(const f32x4*)(cw + j4), w1 = *(const f32x4*)(cw + 256 + j4), w2 = *(const f32x4*)(cw + 512 + j4);
    f32x4 mur[11], kxr[3];
#pragma unroll
    for (int it = 0; it < 11; ++it) mur[it] = (it * 256 + j4 < RWKV_COLS) ? *(const f32x4*)(mu + it * 256 + j4) : (f32x4){0.f, 0.f, 0.f, 0.f};
#pragma unroll
    for (int it = 0; it < 3; ++it) kxr[it] = *(const f32x4*)(kxi + it * 256 + j4);
    const int row0 = (int)(((long)C.gw * MROWS) / C.NGW), row1 = (int)(((long)(C.gw + 1) * MROWS) / C.NGW);
    Ef1Row Ra, Rb, Rc, Rd;
    ef1_load(Ra, P, row0 - 1, C.lane); ef1_load(Rb, P, row0, C.lane); ef1_load(Rc, P, row0 + 1, C.lane);
    for (int row = row0; row < row1; ++row) {
        ef1_load(Rd, P, row + 2, C.lane);
        bool hasp, hasn; seq_info(row, hasp, hasn);
        const float fp = hasp ? 1.f : 0.f, fn = hasn ? 1.f : 0.f;
        {
            const f32x4 bg = bf4(Rb.bg), u0 = bf4(Rb.ua) * bf4(Rb.ub), um = bf4(Ra.ua) * bf4(Ra.ub) * fp, up = bf4(Rc.ua) * bf4(Rc.ub) * fn;
            st4bf(A2 + (size_t)row * DM + j4, bg * (w0 * um + w1 * u0 + w2 * up));
        }
#pragma unroll
        for (int it = 0; it < 11; ++it) {
            const int c = it * 256 + j4;
            if (c < RWKV_COLS) {
                const f32x4 x0 = bf4(Rb.m[it]), xm = bf4(Ra.m[it]) * fp, xp = bf4(Rc.m[it]) * fn, m4 = mur[it];
                const f32x4 ps = x0 + m4 * ((xm + xp) * 0.5f - x0);
                if (it < 3) { const int head = c >> 6, kx = c & 63; st4bf_(SCN + (size_t)(row * 12 + head) * SC_REC + SC_R + kx * 2, ps); }
                else if (it < 6) { const int c1 = c - 768, head = c1 >> 6, kx = c1 & 63; const f32x4 kv = ps * kxr[it < 6 ? (it >= 3 ? it - 3 : 0) : 0];
                    const float ss = sum16(kv[0] * kv[0] + kv[1] * kv[1] + kv[2] * kv[2] + kv[3] * kv[3]); const float rn = rsqrtf(ss + 1e-12f);
                    unsigned char* base = SCN + (size_t)(row * 12 + head) * SC_REC + kx * 2;
                    st4bf_(base + SC_KK, kv * rn); st4bf_(base + SC_KR, ps); st4bf_(base + SC_KR + 256, ps); }
                else if (it < 9) { const int c1 = c - 1536, head = c1 >> 6, kx = c1 & 63; st4bf_(SCN + (size_t)(row * 12 + head) * SC_REC + SC_V + kx * 2, ps); }
                else { const int c1 = c - 2304; f32x4 o;
                    if (c1 < 128) { o = (f32x4){tanhf(ps[0]), tanhf(ps[1]), tanhf(ps[2]), tanhf(ps[3])}; }
                    else if (c1 < 256) { o = ps; }
                    else { o = (f32x4){sigmoidf_(ps[0]), sigmoidf_(ps[1]), sigmoidf_(ps[2]), sigmoidf_(ps[3])}; }
                    st4bf(LIN + (size_t)row * LORA_K + c1, o); }
            }
        }
        Ra = Rb; Rb = Rc; Rc = Rd;
    }
}

__device__ __forceinline__ int scan_row(int i, int b, int d) {
    if (d == 0) return i < CTXL ? NLAT + b * CTXL + i : b * TT + (i - CTXL);
    return i < CTXL ? NLAT + b * CTXL + (CTXL - 1 - i) : b * TT + (TT - 1 - (i - CTXL));
}
__device__ __forceinline__ float red8(float v) {
    v += __uint_as_float((unsigned)__builtin_amdgcn_update_dpp(0, (int)__float_as_uint(v), 0xB1, 0xF, 0xF, true));
    v += __uint_as_float((unsigned)__builtin_amdgcn_update_dpp(0, (int)__float_as_uint(v), 0x4E, 0xF, 0xF, true));
    v += __uint_as_float((unsigned)__builtin_amdgcn_update_dpp(0, (int)__float_as_uint(v), 0x141, 0xF, 0xF, true));
    return v;
}
__device__ __forceinline__ float red16(float v) {
    v += __uint_as_float((unsigned)__builtin_amdgcn_update_dpp(0, (int)__float_as_uint(v), 0xB1, 0xF, 0xF, true));
    v += __uint_as_float((unsigned)__builtin_amdgcn_update_dpp(0, (int)__float_as_uint(v), 0x4E, 0xF, 0xF, true));
    v += __uint_as_float((unsigned)__builtin_amdgcn_update_dpp(0, (int)__float_as_uint(v), 0x141, 0xF, 0xF, true));
    v += __uint_as_float((unsigned)__builtin_amdgcn_update_dpp(0, (int)__float_as_uint(v), 0x140, 0xF, 0xF, true));
    return v;
}
__device__ __forceinline__ void phase_scan(const Ctx& C, const Args& A) {
    for (int u = blockIdx.x; u < 192; u += C.G) {
    const int half = u & 1, d = (u >> 1) & 1, h = (u >> 2) % 12, b = u / 48;
    const unsigned char* SCN = A.ws + WS_SCN; float* Y = (float*)(A.ws + WS_Y) + (size_t)d * MROWS * 768;
    LAS float* buf = (LAS float*)C.lds; LAS float* ybuf = buf + 2 * 32 * 352;
    constexpr int NCH = LKEYS / 32;
    u32x4 st[4];
    int ps_[4], psrc[4], pdst[4]; bool pf32[4];
#pragma unroll
    for (int j = 0; j < 4; ++j) { const int p = C.tid + NTHR * j; const int s = p / 52, q = p % 52; ps_[j] = s;
        if (q < 16) { psrc[j] = SC_W + 256 * d + q * 16; pdst[j] = s * 352 + q * 4; pf32[j] = true; }
        else if (q < 48) { const int vec = (q - 16) >> 3, part = (q - 16) & 7; const int so = vec == 0 ? SC_KK : vec == 1 ? SC_B + 256 * d : vec == 2 ? SC_KR + 256 * d : SC_R;
            psrc[j] = so + part * 16; pdst[j] = s * 352 + 64 * (vec + 1) + part * 8; pf32[j] = false; }
        else { const int part = q - 48; psrc[j] = SC_V + half * 64 + part * 16; pdst[j] = s * 352 + 320 + part * 8; pf32[j] = false; } }
    const int sgn = d ? -1 : 1;
    const unsigned char* SCNh = SCN + (size_t)h * SC_REC;
#define SCAN_ROW0(c) (((c) * 32 < CTXL) ? (NLAT + b * CTXL + (d ? CTXL - 1 - (c) * 32 : (c) * 32)) : (b * TT + (d ? TT - 1 - ((c) * 32 - CTXL) : (c) * 32 - CTXL)))
#define SCAN_LOADG(c) do { const int row0_ = SCAN_ROW0(c); _Pragma("unroll") for (int j = 0; j < 4; ++j) if (j < 3 || C.tid < 1664 - 3 * NTHR) { \
        st[j] = *(const u32x4*)(SCNh + (size_t)(row0_ + sgn * ps_[j]) * SC_ROW + psrc[j]); } } while (0)
#define SCAN_STORE(bi) do { _Pragma("unroll") for (int j = 0; j < 4; ++j) if (j < 3 || C.tid < 1664 - 3 * NTHR) { LAS float* dp = buf + (bi) * (32 * 352) + pdst[j]; \
        if (pf32[j]) *(LAS u32x4*)dp = st[j]; \
        else { *(LAS f32x4*)dp = (f32x4){bflo(st[j].x), bfhi(st[j].x), bflo(st[j].y), bfhi(st[j].y)}; *(LAS f32x4*)(dp + 4) = (f32x4){bflo(st[j].z), bfhi(st[j].z), bflo(st[j].w), bfhi(st[j].w)}; } } } while (0)
    SCAN_LOADG(0); SCAN_STORE(0); __syncthreads();
    f32x2 Sa = {0.f, 0.f}, Sb = {0.f, 0.f};
    const int rl = C.lane >> 4, ks = C.lane & 15;
    float ycol = 0.f;
#define SC_LD(R, s) do { const LAS float* bp_ = cur + (s) * 352 + ks * 4; \
        R##w = *(const LAS f32x4*)(bp_); R##k = *(const LAS f32x4*)(bp_ + 64); R##b = *(const LAS f32x4*)(bp_ + 128); R##q = *(const LAS f32x4*)(bp_ + 192); R##r = *(const LAS f32x4*)(bp_ + 256); \
        R##vv = cur[(s) * 352 + 320 + C.wave * 4 + rl]; } while (0)
#define SC_LO(v) ((f32x2){v[0], v[1]})
#define SC_HI(v) ((f32x2){v[2], v[3]})
#define SC_DPP(x, ctrl) __uint_as_float((unsigned)__builtin_amdgcn_update_dpp(0, (int)__float_as_uint(x), ctrl, 0xF, 0xF, true))
#define SC_STEP(R, P, s) do { \
        f32x2 pa = __builtin_elementwise_fma(Sb, SC_HI(R##k), Sa * SC_LO(R##k)), py = __builtin_elementwise_fma(Sb, SC_HI(P##r), Sa * SC_LO(P##r)); \
        float a_ = pa.x + pa.y, y_ = py.x + py.y; \
        a_ += SC_DPP(a_, 0xB1); y_ += SC_DPP(y_, 0xB1); a_ += SC_DPP(a_, 0x4E); y_ += SC_DPP(y_, 0x4E); \
        a_ += SC_DPP(a_, 0x141); y_ += SC_DPP(y_, 0x141); a_ += SC_DPP(a_, 0x140); y_ += SC_DPP(y_, 0x140); \
        ycol = (ks == ((s) & 15)) ? y_ : ycol; \
        const f32x2 na = {-a_, -a_}, vv2 = {R##vv, R##vv}; \
        Sa = __builtin_elementwise_fma(Sa, SC_LO(R##w), __builtin_elementwise_fma(na, SC_LO(R##b), vv2 * SC_LO(R##q))); \
        Sb = __builtin_elementwise_fma(Sb, SC_HI(R##w), __builtin_elementwise_fma(na, SC_HI(R##b), vv2 * SC_HI(R##q))); } while (0)
    f32x4 Aw, Ak, Ab, Aq, Ar, Bw, Bk, Bb, Bq, Br, Cw, Ck, Cb, Cq, Cr, Dw, Dk, Db, Dq, Dr; float Avv, Bvv, Cvv, Dvv;
    Dr = (f32x4){0.f, 0.f, 0.f, 0.f};
    for (int c = 0; c < NCH; ++c) {
        if (c + 1 < NCH) SCAN_LOADG(c + 1);
        {
            const LAS float* cur = buf + (c & 1) * (32 * 352);
            LAS float* yb = ybuf + (c & 1) * 1024 + C.wave * 4 + rl + ks * 32;
            SC_LD(A, 0); SC_LD(B, 1);
#pragma unroll 1
            for (int s = 0; s < 32; s += 4) {
                SC_LD(C, s + 2); __builtin_amdgcn_sched_barrier(0); SC_STEP(A, D, s); __builtin_amdgcn_sched_barrier(0);
                SC_LD(D, s + 3); __builtin_amdgcn_sched_barrier(0); SC_STEP(B, A, s + 1); __builtin_amdgcn_sched_barrier(0);
                SC_LD(A, s + 4); __builtin_amdgcn_sched_barrier(0); SC_STEP(C, B, s + 2); __builtin_amdgcn_sched_barrier(0);
                SC_LD(B, s + 5); __builtin_amdgcn_sched_barrier(0); SC_STEP(D, C, s + 3); __builtin_amdgcn_sched_barrier(0);
                if ((s & 15) == 12) yb[(s & 16) * 32] = ycol;
            }
        }
        if (c + 1 < NCH) SCAN_STORE((c + 1) & 1);
        __syncthreads();
        { const int row0_ = SCAN_ROW0(c);
#pragma unroll
          for (int i = 0; i < 2; ++i) { const int e = C.tid + NTHR * i, s = e >> 5, r = e & 31;
            const int row = (s > 0) ? row0_ + sgn * (s - 1) : scan_row(c * 32 - 1, b, d);
            if (s > 0 || c > 0) Y[(size_t)row * 768 + h * 64 + half * 32 + r] = ybuf[(c & 1) * 1024 + e]; } }
    }
    {
        f32x2 py = __builtin_elementwise_fma(Sb, SC_HI(Dr), Sa * SC_LO(Dr)); float y_ = py.x + py.y;
        y_ += SC_DPP(y_, 0xB1); y_ += SC_DPP(y_, 0x4E); y_ += SC_DPP(y_, 0x141); y_ += SC_DPP(y_, 0x140);
        if (ks == 0) Y[(size_t)scan_row(LKEYS - 1, b, d) * 768 + h * 64 + half * 32 + C.wave * 4 + rl] = y_;
    }
    __syncthreads();
    }
#undef SCAN_LOADG
#undef SCAN_STORE
#undef SCAN_ROW0
#undef SC_LD
#undef SC_STEP
#undef SC_LO
#undef SC_HI
#undef SC_DPP
}

constexpr int CSP = 72;
constexpr int CS_MAT = 64 * CSP * 2;
constexpr int CS_WT = 0, CS_KB = CS_MAT, CS_BB = 2 * CS_MAT, CS_RT = 3 * CS_MAT, CS_BHT = 4 * CS_MAT, CS_KHT = 5 * CS_MAT, CS_VMT = 6 * CS_MAT;
constexpr int CS_M2F = 7 * CS_MAT;
constexpr int CS_M1T = CS_M2F + 16384;
constexpr int CS_N2 = CS_M1T + CS_MAT;
constexpr int CS_GT = CS_N2 + CS_MAT;
constexpr int CS_Z = CS_M2F, CS_U = CS_M2F + CS_MAT;
constexpr int CS_GL = CS_GT + 2 * CS_MAT;
static_assert(CS_GL + 256 <= LDS_MISC, "chunked-scan LDS map");
template <bool SWZB = false>
__device__ __forceinline__ void cs_mma(f32x16& acc, const LAS unsigned char* Am, const LAS unsigned char* Bm, int ti, int tj, int r32, int hi) {
    const LAS unsigned char* ap = Am + (ti * 32 + r32) * (CSP * 2) + hi * 16; const int brow = tj * 32 + r32; const LAS unsigned char* bp = Bm + brow * (CSP * 2);
    const int sw = SWZB ? ((brow >> 3) & 7) : 0;
#pragma unroll
    for (int ks = 0; ks < 4; ++ks) acc = __builtin_amdgcn_mfma_f32_32x32x16_bf16(*(const LAS bf16x8*)(ap + ks * 32), *(const LAS bf16x8*)(bp + (((ks * 2 + hi) ^ sw) * 16)), acc, 0, 0, 0);
}
__device__ __forceinline__ void cs_store_t(LAS unsigned char* Om, const f32x16& acc, int ti, int tj, int r32, int hi) {
    LAS unsigned char* op = Om + (tj * 32 + r32) * (CSP * 2) + (ti * 32 + 4 * hi) * 2;
#pragma unroll
    for (int g = 0; g < 4; ++g) { u32x2 o; o.x = pk2(acc[4 * g], acc[4 * g + 1]); o.y = pk2(acc[4 * g + 2], acc[4 * g + 3]); *(LAS u32x2*)(op + g * 16) = o; }
}
#define CS_BAR() asm volatile("s_waitcnt lgkmcnt(0)\n\ts_barrier" ::: "memory")
__device__ __forceinline__ void phase_csa(const Ctx& C, const Args& A) {
    const unsigned char* SCN = A.ws + WS_SCN; unsigned char* CHK = A.ws + WS_CHK;
    LAS unsigned char* L = C.lds;
    const int r32 = C.lane & 31, hi = C.lane >> 5;
    float lwv[8]; u32x4 ukk, ub, ukr, ur, uv;
#define CSA_GEOM(cu_) const int unit = (cu_) / CS_NCH, ch = (cu_) % CS_NCH; const int d = unit & 1, h = (unit >> 1) % 12, b = unit / 24; \
        const int step0 = ch * CS_L; const int sgn = d ? -1 : 1; \
        const int row0 = (step0 < CTXL) ? (NLAT + b * CTXL + (d ? CTXL - 1 - step0 : step0)) : (b * TT + (d ? TT - 1 - (step0 - CTXL) : step0 - CTXL)); \
        const unsigned char* rec0 = SCN + (size_t)row0 * SC_ROW + (size_t)h * SC_REC;
#define CSA_LOAD(cu_) do { CSA_GEOM(cu_); \
        { const int k = C.tid & 63, sg = C.tid >> 6; _Pragma("unroll") for (int j = 0; j < 8; ++j) lwv[j] = *(const float*)(rec0 + (long)sgn * (8 * sg + j) * SC_ROW + SC_W + 256 * d + k * 4); } \
        { const int t = C.tid >> 3, k0 = (C.tid & 7) * 8; const unsigned char* rp = rec0 + (long)sgn * t * SC_ROW; \
          ukk = *(const u32x4*)(rp + SC_KK + k0 * 2); ub = *(const u32x4*)(rp + SC_B + 256 * d + k0 * 2); ukr = *(const u32x4*)(rp + SC_KR + 256 * d + k0 * 2); ur = *(const u32x4*)(rp + SC_R + k0 * 2); uv = *(const u32x4*)(rp + SC_V + k0 * 2); } } while (0)
    if ((int)blockIdx.x < CS_UNITS * CS_NCH) CSA_LOAD((int)blockIdx.x);
    for (int cu = blockIdx.x; cu < CS_UNITS * CS_NCH; cu += C.G) {
        LAS float* csf = (LAS float*)(L + CS_M2F);
        LAS float* seg = (LAS float*)(L + CS_N2);
        { const int k = C.tid & 63, sg = C.tid >> 6;
#pragma unroll
          for (int j = 1; j < 8; ++j) lwv[j] += lwv[j - 1];
          seg[sg * 64 + k] = lwv[7];
          CS_BAR();
          float off = 0.f, tot = 0.f;
#pragma unroll
          for (int s2 = 0; s2 < 8; ++s2) { const float v = seg[s2 * 64 + k]; off += (s2 < sg) ? v : 0.f; tot += v; }
#pragma unroll
          for (int j = 0; j < 8; ++j) csf[(8 * sg + j) * 65 + k] = lwv[j] + off;
          if (sg == 7) ((LAS float*)(L + CS_GL))[k] = __expf(tot); }
        CS_BAR();
        { const int t = C.tid >> 3, k0 = (C.tid & 7) * 8;
          float wt[8], kb[8], bb[8], rt[8], bh[8], kh[8];
#pragma unroll
          for (int j = 0; j < 8; ++j) { const unsigned pkk = j < 2 ? ukk.x : j < 4 ? ukk.y : j < 6 ? ukk.z : ukk.w, pb = j < 2 ? ub.x : j < 4 ? ub.y : j < 6 ? ub.z : ub.w, pkr = j < 2 ? ukr.x : j < 4 ? ukr.y : j < 6 ? ukr.z : ukr.w, pr = j < 2 ? ur.x : j < 4 ? ur.y : j < 6 ? ur.z : ur.w;
              const float kkv = (j & 1) ? bfhi(pkk) : bflo(pkk), bv = (j & 1) ? bfhi(pb) : bflo(pb), krv = (j & 1) ? bfhi(pkr) : bflo(pkr), rv = (j & 1) ? bfhi(pr) : bflo(pr);
              const float cst = csf[t * 65 + k0 + j], csp = t > 0 ? csf[(t - 1) * 65 + k0 + j] : 0.f, csl = csf[63 * 65 + k0 + j];
              const float einv = __expf(-cst), el = __expf(csl - cst);
              wt[j] = kkv * __expf(csp); kb[j] = krv * einv; bb[j] = bv * einv; rt[j] = rv * __expf(cst); bh[j] = bv * el; kh[j] = krv * el; }
          u32x4 o;
          o.x = pk2(wt[0], wt[1]); o.y = pk2(wt[2], wt[3]); o.z = pk2(wt[4], wt[5]); o.w = pk2(wt[6], wt[7]); *(LAS u32x4*)(L + CS_WT + t * (CSP * 2) + k0 * 2) = o;
          o.x = pk2(kb[0], kb[1]); o.y = pk2(kb[2], kb[3]); o.z = pk2(kb[4], kb[5]); o.w = pk2(kb[6], kb[7]); *(LAS u32x4*)(L + CS_KB + t * (CSP * 2) + k0 * 2) = o;
          o.x = pk2(bb[0], bb[1]); o.y = pk2(bb[2], bb[3]); o.z = pk2(bb[4], bb[5]); o.w = pk2(bb[6], bb[7]); *(LAS u32x4*)(L + CS_BB + t * (CSP * 2) + k0 * 2) = o;
          o.x = pk2(rt[0], rt[1]); o.y = pk2(rt[2], rt[3]); o.z = pk2(rt[4], rt[5]); o.w = pk2(rt[6], rt[7]); *(LAS u32x4*)(L + CS_RT + t * (CSP * 2) + k0 * 2) = o;
#pragma unroll
          for (int j = 0; j < 8; ++j) { const int to = ((((t >> 3) ^ ((k0 >> 3) & 7)) * 8) + (t & 7)) * 2;
              *(LAS bf16_t*)(L + CS_BHT + (k0 + j) * (CSP * 2) + to) = (bf16_t)f2bf(bh[j]); *(LAS bf16_t*)(L + CS_KHT + (k0 + j) * (CSP * 2) + to) = (bf16_t)f2bf(kh[j]);
              const unsigned pv = j < 2 ? uv.x : j < 4 ? uv.y : j < 6 ? uv.z : uv.w; *(LAS bf16_t*)(L + CS_VMT + (k0 + j) * (CSP * 2) + to) = (bf16_t)((j & 1) ? (pv >> 16) : (pv & 0xffffu)); } }
        if (cu + C.G < CS_UNITS * CS_NCH) CSA_LOAD(cu + C.G);
        CS_BAR();
        for (int job = C.wave; job < 12; job += NWAVES) { const int p = job >> 2, ti = (job >> 1) & 1, tj = job & 1;
            f32x16 acc;
#pragma unroll
            for (int i = 0; i < 16; ++i) acc[i] = 0.f;
            if (p == 0) { cs_mma(acc, L + CS_WT, L + CS_BB, ti, tj, r32, hi);
                const int i = tj * 32 + r32; LAS float* mp = (LAS float*)(L + CS_M2F) + i * 64;
#pragma unroll
                for (int reg = 0; reg < 16; ++reg) { const int t = ti * 32 + crow(reg, hi); mp[(t & 3) * 16 + (t >> 2)] = (i < t) ? acc[reg] : 0.f; } }
            else if (p == 1) { cs_mma(acc, L + CS_WT, L + CS_KB, ti, tj, r32, hi);
                const int i = tj * 32 + r32;
#pragma unroll
                for (int reg = 0; reg < 16; ++reg) { const int t = ti * 32 + crow(reg, hi); acc[reg] = (i < t) ? acc[reg] : 0.f; }
                cs_store_t(L + CS_M1T, acc, ti, tj, r32, hi); }
            else { cs_mma(acc, L + CS_BB, L + CS_RT, ti, tj, r32, hi);
                const int t = tj * 32 + r32;
#pragma unroll
                for (int reg = 0; reg < 16; ++reg) { const int i = ti * 32 + crow(reg, hi); acc[reg] = (i <= t) ? acc[reg] : 0.f; }
                cs_store_t(L + CS_N2, acc, ti, tj, r32, hi); } }
        CS_BAR();
        { const int c = C.tid >> 2, q = C.tid & 3; f32x2 acc2[8];
          { const LAS unsigned char* rcol = (c < 64) ? (L + CS_WT + c * 2) : (L + CS_M1T + (c - 64) * (CSP * 2)); const int rstride = (c < 64) ? CSP * 2 : 2;
#pragma unroll
            for (int j = 0; j < 16; ++j) acc2[j >> 1][j & 1] = bf2f(*(const LAS bf16_t*)(rcol + (4 * j + q) * rstride)); }
          const LAS float* m2c = (const LAS float*)(L + CS_M2F) + q * 16;
#pragma clang loop unroll(full)
          for (int i = 0; i < 64; ++i) {
              const float mine = -acc2[i >> 3][(i >> 2) & 1];
              float gi;
              switch (i & 3) { case 0: gi = __uint_as_float((unsigned)__builtin_amdgcn_update_dpp(0, (int)__float_as_uint(mine), 0x00, 0xF, 0xF, true)); break;
                               case 1: gi = __uint_as_float((unsigned)__builtin_amdgcn_update_dpp(0, (int)__float_as_uint(mine), 0x55, 0xF, 0xF, true)); break;
                               case 2: gi = __uint_as_float((unsigned)__builtin_amdgcn_update_dpp(0, (int)__float_as_uint(mine), 0xAA, 0xF, 0xF, true)); break;
                               default: gi = __uint_as_float((unsigned)__builtin_amdgcn_update_dpp(0, (int)__float_as_uint(mine), 0xFF, 0xF, 0xF, true)); break; }
              const f32x2 g2 = {gi, gi};
#pragma unroll
              for (int j4 = (i >> 4); j4 < 4; ++j4) { const f32x4 m = *(const LAS f32x4*)(m2c + i * 64 + j4 * 4);
#pragma unroll
                  for (int h = 0; h < 2; ++h) { const int p = 2 * j4 + h;
                      if (2 * p >= (i >> 2)) acc2[p] += (f32x2){m[2 * h], m[2 * h + 1]} * g2;
                      else if (2 * p + 1 >= (i >> 2)) acc2[p][1] += m[2 * h + 1] * gi; } }
          }
#pragma unroll
          for (int j = 0; j < 16; ++j) *(LAS bf16_t*)(L + CS_GT + c * (CSP * 2) + (4 * j + q) * 2) = (bf16_t)f2bf(-acc2[j >> 1][j & 1]); }
        CS_BAR();
        unsigned char* outp = CHK + (size_t)cu * 32768;
        for (int job = C.wave; job < 16; job += NWAVES) { const int p = job >> 2, ti = (job >> 1) & 1, tj = job & 1;
            f32x16 acc;
            if (p == 0) {
                const LAS unsigned char* rp = L + CS_RT + (tj * 32 + r32) * (CSP * 2) + (ti * 32 + 4 * hi) * 2;
#pragma unroll
                for (int g = 0; g < 4; ++g) { const u32x2 u = *(const LAS u32x2*)(rp + g * 16); acc[4 * g] = bflo(u.x); acc[4 * g + 1] = bfhi(u.x); acc[4 * g + 2] = bflo(u.y); acc[4 * g + 3] = bfhi(u.y); }
                cs_mma(acc, L + CS_GT, L + CS_N2, ti, tj, r32, hi);
#pragma unroll
                for (int g = 0; g < 4; ++g) { u32x2 o; o.x = pk2(acc[4 * g], acc[4 * g + 1]); o.y = pk2(acc[4 * g + 2], acc[4 * g + 3]);
                    *(u32x2*)(outp + 8192 + (((tj * 4 + 2 * ti + (g >> 1)) * 64 + (g & 1) * 32 + r32) * 16) + hi * 8) = o; } }
            else if (p == 1) {
#pragma unroll
                for (int i = 0; i < 16; ++i) acc[i] = 0.f;
                cs_mma(acc, L + CS_KB, L + CS_RT, ti, tj, r32, hi);
                const int t = tj * 32 + r32;
#pragma unroll
                for (int reg = 0; reg < 16; ++reg) { const int i = ti * 32 + crow(reg, hi); acc[reg] = (i <= t) ? acc[reg] : 0.f; }
                cs_mma(acc, L + CS_GT + 64 * (CSP * 2), L + CS_N2, ti, tj, r32, hi);
                cs_store_t(L + CS_Z, acc, ti, tj, r32, hi); }
            else if (p == 2) {
#pragma unroll
                for (int i = 0; i < 16; ++i) acc[i] = 0.f;
                cs_mma<true>(acc, L + CS_GT, L + CS_BHT, ti, tj, r32, hi);
                const int k = tj * 32 + r32; const float gl = ((const LAS float*)(L + CS_GL))[k];
#pragma unroll
                for (int reg = 0; reg < 16; ++reg) { const int cc = ti * 32 + crow(reg, hi); acc[reg] += (cc == k) ? gl : 0.f; }
#pragma unroll
                for (int g = 0; g < 4; ++g) { u32x2 o; o.x = pk2(acc[4 * g], acc[4 * g + 1]); o.y = pk2(acc[4 * g + 2], acc[4 * g + 3]);
                    *(u32x2*)(outp + (((tj * 4 + 2 * ti + (g >> 1)) * 64 + (g & 1) * 32 + r32) * 16) + hi * 8) = o; } }
            else {
                const int krow = tj * 32 + r32; const LAS unsigned char* kp = L + CS_KHT + krow * (CSP * 2) + hi * 8;
#pragma unroll
                for (int g = 0; g < 4; ++g) { const u32x2 u = *(const LAS u32x2*)(kp + (((ti * 4 + g) ^ ((krow >> 3) & 7)) * 16)); acc[4 * g] = bflo(u.x); acc[4 * g + 1] = bfhi(u.x); acc[4 * g + 2] = bflo(u.y); acc[4 * g + 3] = bfhi(u.y); }
                cs_mma<true>(acc, L + CS_GT + 64 * (CSP * 2), L + CS_BHT, ti, tj, r32, hi);
                cs_store_t(L + CS_U, acc, ti, tj, r32, hi); } }
        CS_BAR();
        { const int p = C.wave >> 2, ti = (C.wave >> 1) & 1, tj = C.wave & 1;
          f32x16 acc;
#pragma unroll
          for (int i = 0; i < 16; ++i) acc[i] = 0.f;
          cs_mma<true>(acc, L + (p ? CS_U : CS_Z), L + CS_VMT, ti, tj, r32, hi);
          unsigned char* op = outp + (p ? 16384 : 24576) + ((ti * 2 + tj) * 64 + C.lane) * 32;
          u32x4 o0, o1; o0.x = pk2(acc[0], acc[1]); o0.y = pk2(acc[2], acc[3]); o0.z = pk2(acc[4], acc[5]); o0.w = pk2(acc[6], acc[7]);
          o1.x = pk2(acc[8], acc[9]); o1.y = pk2(acc[10], acc[11]); o1.z = pk2(acc[12], acc[13]); o1.w = pk2(acc[14], acc[15]);
          *(u32x4*)op = o0; *(u32x4*)(op + 16) = o1; }
        CS_BAR();
    }
}
__device__ __forceinline__ void phase_csb(const Ctx& C, const Args& A, int l) {
    if ((int)blockIdx.x >= CS_UNITS) { const int gwf = ((int)blockIdx.x - CS_UNITS) * NWAVES + C.wave, ngwf = (C.G - CS_UNITS) * NWAVES;
        conv_items(C, A, l + 1, gwf, ngwf, true, false, false); conv_items(C, A, l + 1, gwf, ngwf, false, false, true, XW_TK_HI); return; }
    const unsigned char* CHK = A.ws + WS_CHK;
    LAS unsigned char* L = C.lds;
    const int r32 = C.lane & 31, hi = C.lane >> 5;
    const bool isS = C.wave < 4; const int ti = (C.wave >> 1) & 1, tj = C.wave & 1;
    for (int unit = blockIdx.x; unit < CS_UNITS; unit += C.G) {
        const int d = unit & 1, h = (unit >> 1) % 12, b = unit / 24;
        float* Y = (float*)(A.ws + WS_Y) + (size_t)d * MROWS * 768;
        for (int i = C.tid; i < 2 * CS_MAT / 4; i += NTHR) ((LAS unsigned*)L)[i] = 0u;
        CS_BAR();
        bf16x8 afA[4], afB[4], afC[4]; u32x4 cA0, cA1, cB0, cB1, cC0, cC1;
#define CSB_LOAD(A4, C0, C1, ch_) do { const unsigned char* op_ = CHK + ((size_t)unit * CS_NCH + (ch_)) * 32768; \
            const unsigned char* am_ = op_ + (isS ? 0 : 8192) + (ti * 4 * 64 + C.lane) * 16;     \
            _Pragma("unroll") for (int ks = 0; ks < 4; ++ks) A4[ks] = *(const bf16x8*)(am_ + ks * 1024); \
            const unsigned char* cp_ = op_ + (isS ? 16384 : 24576) + ((ti * 2 + tj) * 64 + C.lane) * 32; C0 = *(const u32x4*)cp_; C1 = *(const u32x4*)(cp_ + 16); } while (0)
#define CSB_STEP(A4, C0, C1, ch_) do { \
            const LAS unsigned char* Sb = L + ((ch_) & 1) * CS_MAT; LAS unsigned char* Sn = L + (((ch_) + 1) & 1) * CS_MAT; \
            f32x16 acc; \
            acc[0] = bflo(C0.x); acc[1] = bfhi(C0.x); acc[2] = bflo(C0.y); acc[3] = bfhi(C0.y); acc[4] = bflo(C0.z); acc[5] = bfhi(C0.z); acc[6] = bflo(C0.w); acc[7] = bfhi(C0.w); \
            acc[8] = bflo(C1.x); acc[9] = bfhi(C1.x); acc[10] = bflo(C1.y); acc[11] = bfhi(C1.y); acc[12] = bflo(C1.z); acc[13] = bfhi(C1.z); acc[14] = bflo(C1.w); acc[15] = bfhi(C1.w); \
            const LAS unsigned char* bp = Sb + (tj * 32 + r32) * (CSP * 2) + hi * 16; \
            _Pragma("unroll") for (int ks = 0; ks < 4; ++ks) acc = __builtin_amdgcn_mfma_f32_32x32x16_bf16(A4[ks], *(const LAS bf16x8*)(bp + ks * 32), acc, 0, 0, 0); \
            if (isS) { cs_store_t(Sn, acc, ti, tj, r32, hi); }     \
            else {     \
                const int step0 = (ch_) * CS_L; const int sgn = d ? -1 : 1; \
                const int row0 = (step0 < CTXL) ? (NLAT + b * CTXL + (d ? CTXL - 1 - step0 : step0)) : (b * TT + (d ? TT - 1 - (step0 - CTXL) : step0 - CTXL)); \
                float* yp = Y + (size_t)(row0 + sgn * (ti * 32 + 4 * hi)) * 768 + h * 64 + tj * 32 + r32; const long ys = (long)sgn * 768; \
                _Pragma("unroll") for (int reg = 0; reg < 16; ++reg) yp[ys * ((reg & 3) + 8 * (reg >> 2))] = acc[reg]; } \
            CS_BAR(); } while (0)
        CSB_LOAD(afA, cA0, cA1, 0); CSB_LOAD(afB, cB0, cB1, 1);
        static_assert(CS_NCH % 3 == 0, "chunk loop is unrolled by three");
        for (int ch = 0; ch < CS_NCH; ch += 3) {
            if (ch == 0) CSB_LOAD(afC, cC0, cC1, 2);
            CSB_STEP(afA, cA0, cA1, ch);     if (ch + 3 < CS_NCH) CSB_LOAD(afA, cA0, cA1, ch + 3);
            CSB_STEP(afB, cB0, cB1, ch + 1); if (ch + 4 < CS_NCH) CSB_LOAD(afB, cB0, cB1, ch + 4);
            CSB_STEP(afC, cC0, cC1, ch + 2); if (ch + 5 < CS_NCH) CSB_LOAD(afC, cC0, cC1, ch + 5);
        }
        CS_BAR();
    }
#undef CSB_LOAD
#undef CSB_STEP
}

#undef CS_BAR
struct Ef2Row { f32x4 y0[3], y1[3]; u32x2 r[3], v[3], k0[3], k1[3], g[3]; };
__device__ __forceinline__ void ef2_load(Ef2Row& R, const float* Y0, const float* Y1, const unsigned char* SCN, const bf16_t* G, int row, int lane) {
#pragma unroll
    for (int it = 0; it < 3; ++it) { const int c = it * 256 + 4 * lane, head = c >> 6, kx = c & 63;
        R.y0[it] = *(const f32x4*)(Y0 + (size_t)row * 768 + c); R.y1[it] = *(const f32x4*)(Y1 + (size_t)row * 768 + c);
        const unsigned char* base = SCN + (size_t)(row * 12 + head) * SC_REC + kx * 2;
        R.r[it] = *(const u32x2*)(base + SC_R); R.v[it] = *(const u32x2*)(base + SC_V); R.k0[it] = *(const u32x2*)(base + SC_KR); R.k1[it] = *(const u32x2*)(base + SC_KR + 256);
        R.g[it] = *(const u32x2*)(G + (size_t)row * 768 + c); }
}
__device__ __forceinline__ void phase_ef2(const Ctx& C, const Args& A, int l) {
    const int i2 = l >> 1; unsigned char* ws = A.ws;
    const unsigned char* SCN = ws + WS_SCN; const float* Y0 = (const float*)(ws + WS_Y); const float* Y1 = Y0 + (size_t)MROWS * 768;
    const bf16_t* G = (const bf16_t*)(ws + WS_G); bf16_t* A2 = (bf16_t*)(ws + WS_A2);
    const float* rb = A.in[I_RBON] + (size_t)i2 * 768; const float* gg = A.in[I_GNG] + (size_t)i2 * 768; const float* gb = A.in[I_GNB] + (size_t)i2 * 768;
    f32x4 rbr[3], ggr[3], gbr[3];
#pragma unroll
    for (int it = 0; it < 3; ++it) { const int c = it * 256 + 4 * C.lane; rbr[it] = *(const f32x4*)(rb + c); ggr[it] = *(const f32x4*)(gg + c); gbr[it] = *(const f32x4*)(gb + c); }
    Ef2Row Rn;
    if (C.gw < MROWS) ef2_load(Rn, Y0, Y1, SCN, G, C.gw, C.lane);
    for (int row = C.gw; row < MROWS; row += C.NGW) {
        const Ef2Row R = Rn;
        { const int nr = row + C.NGW < MROWS ? row + C.NGW : row; ef2_load(Rn, Y0, Y1, SCN, G, nr, C.lane); }
#pragma unroll
        for (int it = 0; it < 3; ++it) {
            const int c = it * 256 + 4 * C.lane;
            const f32x4 y = R.y0[it] + R.y1[it];
            const float mean = sum16((y[0] + y[1]) + (y[2] + y[3])) * (1.f / 64.f);
            const f32x4 dd = y - mean;
            const float var = sum16((dd[0] * dd[0] + dd[1] * dd[1]) + (dd[2] * dd[2] + dd[3] * dd[3])) * (1.f / 64.f);
            const float rstd = rsqrtf(var + GN_EPS);
            const f32x4 r = bf4(R.r[it]), v = bf4(R.v[it]), k0 = bf4(R.k0[it]), k1 = bf4(R.k1[it]);
            const f32x4 t = r * (k0 + k1) * 0.5f * rbr[it];
            const float bs = sum16((t[0] + t[1]) + (t[2] + t[3]));
            const f32x4 yn = dd * rstd * ggr[it] + gbr[it];
            const f32x4 g = bf4(R.g[it]);
            st4bf(A2 + (size_t)row * DM + 256 + c, g * (yn + v * bs));
        }
    }
}

__device__ __forceinline__ void phase_of1(const Ctx& C, const Args& A, int l) {
    const int i2 = l >> 1; unsigned char* ws = A.ws;
    const bf16_t* P = (const bf16_t*)(ws + WS_P); bf16_t* A2 = (bf16_t*)(ws + WS_A2); bf16_t* VT = (bf16_t*)(ws + WS_VT);
    const float* lng = A.in[I_GLNG] + (size_t)i2 * 256; const float* lnb = A.in[I_GLNB] + (size_t)i2 * 256;
    const float* gws = A.in[I_GWS] + (size_t)i2 * 4 * 128 * 128; const float* gbs = A.in[I_GBS] + (size_t)i2 * 4 * 128;
    LAS bf16_t* vt = (LAS bf16_t*)C.lds;
    LAS bf16_t* uL = (LAS bf16_t*)C.lds;
    LAS bf16_t* vT = (LAS bf16_t*)(C.lds + 128 * 528);
    const int r32 = C.lane & 31, hi = C.lane >> 5;
    for (int it = blockIdx.x; it < 256 + 8 * 7; it += C.G) {
        const bool isctx = it >= 256; const int uc = isctx ? (it - 256) / 7 : 0, pc = isctx ? (it - 256) % 7 : 0; const int u = it;
        const int b = isctx ? (uc >> 1) : (u >> 6), pos0 = isctx ? (uc & 1) * 128 : (u & 63) * 128;
        const int row0 = isctx ? NLAT + b * CTXL + pos0 : b * TT + pos0, L0 = isctx ? pos0 : CTXL + pos0;
        const int hh0 = isctx ? pc : 0, hh1 = isctx ? (pc < 6 ? pc + 1 : 0) : 6; const bool doC = !isctx || pc == 6;
        u32x4 pv[4];
        if (hh0 < hh1) {
#pragma unroll
            for (int i = 0; i < 4; ++i) { const int piece = C.tid + NTHR * i, r = piece >> 4, part = piece & 15; pv[i] = *(const u32x4*)(P + (size_t)(row0 + r) * P_LD + 1536 + hh0 * 128 + part * 8); } }
        for (int hh = hh0; hh < hh1; ++hh) {
#pragma unroll
            for (int i = 0; i < 4; ++i) { const int piece = C.tid + NTHR * i, r = piece >> 4, part = piece & 15;
                *(LAS u32x4*)(vt + r * 136 + part * 8) = pv[i]; }
            __syncthreads();
            if (hh + 1 < hh1) {
#pragma unroll
                for (int i = 0; i < 4; ++i) { const int piece = C.tid + NTHR * i, r = piece >> 4, part = piece & 15; pv[i] = *(const u32x4*)(P + (size_t)(row0 + r) * P_LD + 1536 + (hh + 1) * 128 + part * 8); } }
#pragma unroll
            for (int i = 0; i < 4; ++i) { const int item = C.tid + NTHR * i, d = item >> 4, tg = item & 15; const LAS bf16_t* s = vt + (tg * 8) * 136 + d;
                u32x4 o; o.x = (unsigned)s[0] | ((unsigned)s[136] << 16); o.y = (unsigned)s[2 * 136] | ((unsigned)s[3 * 136] << 16);
                o.z = (unsigned)s[4 * 136] | ((unsigned)s[5 * 136] << 16); o.w = (unsigned)s[6 * 136] | ((unsigned)s[7 * 136] << 16);
                *(u32x4*)(VT + ((size_t)(b * 6 + hh) * 128 + d) * LKEYS + L0 + tg * 8) = o; }
            __syncthreads();
        }
        if (doC) {
        const f32x4 lngr = *(const f32x4*)(lng + 4 * C.lane), lnbr = *(const f32x4*)(lnb + 4 * C.lane);
        u32x2 nxu, nxr;
        { const bf16_t* pr = P + (size_t)(row0 + C.wave) * P_LD + 2304 + 4 * C.lane; nxu = *(const u32x2*)pr; nxr = *(const u32x2*)(pr + 256); }
        for (int r = C.wave; r < 128; r += NWAVES) {
            const int c4 = 4 * C.lane;
            const f32x4 ur = bf4(nxu), raw = bf4(nxr);
            if (r + NWAVES < 128) { const bf16_t* pr = P + (size_t)(row0 + r + NWAVES) * P_LD + 2304 + c4; nxu = *(const u32x2*)pr; nxr = *(const u32x2*)(pr + 256); }
            { const f32x4 gu = {gelu_erf(ur[0]), gelu_erf(ur[1]), gelu_erf(ur[2]), gelu_erf(ur[3])}; u32x2 o; o.x = pk2(gu[0], gu[1]); o.y = pk2(gu[2], gu[3]); *(LAS u32x2*)(uL + r * 264 + c4) = o; }
            const f32x4 gv = {gelu_erf(raw[0]), gelu_erf(raw[1]), gelu_erf(raw[2]), gelu_erf(raw[3])};
            const float mean = wave_sum((gv[0] + gv[1]) + (gv[2] + gv[3])) * (1.f / 256.f); const f32x4 dd = gv - mean;
            const float var = wave_sum((dd[0] * dd[0] + dd[1] * dd[1]) + (dd[2] * dd[2] + dd[3] * dd[3])) * (1.f / 256.f); const float rstd = rsqrtf(var + LN_EPS);
            const f32x4 o = dd * rstd * lngr + lnbr;
#pragma unroll
            for (int k = 0; k < 4; ++k) vT[(c4 + k) * 136 + r] = (bf16_t)f2bf(o[k]);
        }
        __syncthreads();
        {
            const int g = C.wave >> 1, cblk = C.wave & 1, cc = g * 64 + cblk * 32 + r32;
            for (int pblk = 0; pblk < 4; ++pblk) {
                f32x16 acc;
#pragma unroll
                for (int i = 0; i < 16; ++i) acc[i] = 0.f;
                const float* wrow = gws + ((size_t)g * 128 + pblk * 32 + r32) * 128 + 8 * hi;
#pragma unroll
                for (int ks = 0; ks < 8; ++ks) { const f32x4 w0 = *(const f32x4*)(wrow + ks * 16), w1 = *(const f32x4*)(wrow + ks * 16 + 4);
                    u32x4 au; au.x = pk2(w0[0], w0[1]); au.y = pk2(w0[2], w0[3]); au.z = pk2(w1[0], w1[1]); au.w = pk2(w1[2], w1[3]);
                    const bf16x8 bf = *(const LAS bf16x8*)(vT + cc * 136 + ks * 16 + 8 * hi);
                    acc = __builtin_amdgcn_mfma_f32_32x32x16_bf16(__builtin_bit_cast(bf16x8, au), bf, acc, 0, 0, 0); }
#pragma unroll
                for (int reg = 0; reg < 16; ++reg) { const int p = pblk * 32 + crow(reg, hi);
                    const float uu = bf2f(uL[p * 264 + cc]); const float mixed = acc[reg] + gbs[g * 128 + p];
                    uL[p * 264 + cc] = (bf16_t)f2bf(uu * mixed); }
            }
        }
        __syncthreads();
#pragma unroll
        for (int i = 0; i < 8; ++i) { const int piece = C.tid + NTHR * i, r = piece >> 5, part = piece & 31;
            *(u32x4*)(A2 + (size_t)(row0 + r) * DM + 768 + part * 8) = *(const LAS u32x4*)(uL + r * 264 + part * 8); }
        __syncthreads();
        }
    }
}

__device__ __forceinline__ void phase_attn(const Ctx& C, const Args& A, int l) {
    const int i2 = l >> 1; unsigned char* ws = A.ws;
    const bf16_t* Q = (const bf16_t*)(ws + WS_Q); const bf16_t* KA = (const bf16_t*)(ws + WS_KA); const bf16_t* VT = (const bf16_t*)(ws + WS_VT); bf16_t* A2 = (bf16_t*)(ws + WS_A2);
    const float lam_init = 0.8f - 0.6f * expf(-0.3f * (float)l);
    float s1 = 0.f, s2 = 0.f;
    for (int j = 0; j < 64; ++j) { s1 += A.in[I_LQ1][i2 * 64 + j] * A.in[I_LK1][i2 * 64 + j]; s2 += A.in[I_LQ2][i2 * 64 + j] * A.in[I_LK2][i2 * 64 + j]; }
    const float lam = expf(s1) - expf(s2) + lam_init;
    const float* subg = A.in[I_SUBG] + (size_t)i2 * 128;
    const int r32 = C.lane & 31, hi = C.lane >> 5, map = C.wave >> 2, qw = C.wave & 3;
    LAS unsigned char* Kt = C.lds; LAS unsigned char* Vt = C.lds + 2 * 16384; LAS float* xch = (LAS float*)C.lds;
    const int NU = 1536 + (l == 1 ? 48 : 0);
    for (int n = C.vcu; n < NU; n += C.G) {
        int bh, qt; bool isctx = false;
        if (n < 1536) { const int round = n >> 8, slot = n & 255; bh = (slot >> 5) * 3 + (round >> 1); qt = (round & 1) * 32 + (slot & 31); }
        else { isctx = true; bh = (n - 1536) >> 1; qt = (n - 1536) & 1; }
        const int b = bh / 6, h = bh % 6;
        const int qrow0 = isctx ? NLAT + b * CTXL + qt * 128 : b * TT + qt * 128;
        const int NT = isctx ? CTXL / 64 : LKEYS / 64;
        const bf16_t* Kb = KA + (size_t)b * LKEYS * 768 + h * 128;
        const bf16_t* Vb = VT + (size_t)(b * 6 + h) * 128 * LKEYS;
        bf16x8 qf[4];
        { const bf16_t* qp = Q + (size_t)(qrow0 + qw * 32 + r32) * 768 + h * 128 + map * 64 + 8 * hi;
#pragma unroll
          for (int ks = 0; ks < 4; ++ks) qf[ks] = *(const bf16x8*)(qp + ks * 16); }
        f32x16 O[4];
#pragma unroll
        for (int d = 0; d < 4; ++d)
#pragma unroll
            for (int i = 0; i < 16; ++i) O[d][i] = 0.f;
        float m = 0.f, lsum = 0.f;
        unsigned ksrc[2], vsrc[2];
#pragma unroll
        for (int i = 0; i < 2; ++i) { const int row = 4 * (2 * C.wave + i) + (C.lane >> 4), x = row & 15, pi = x < 4 ? x : x < 8 ? x + 4 : x < 12 ? x - 4 : x;
            ksrc[i] = (unsigned)(((row & ~15) + pi) * 768 + (((C.lane & 15) ^ x) * 8));
            const int d = 8 * (2 * C.wave + i) + (C.lane >> 3); vsrc[i] = (unsigned)(d * LKEYS + (((C.lane & 7) ^ ((d >> 1) & 7)) * 8)); }
#define AT_DMA_K(tt, slot) do { _Pragma("unroll") for (int i = 0; i < 2; ++i) __builtin_amdgcn_global_load_lds((const unsigned*)(Kb + (size_t)(tt) * 64 * 768 + ksrc[i]), (LAS unsigned*)(Kt + (slot) * 16384 + (2 * C.wave + i) * 1024), 16, 0, 0); } while (0)
#define AT_DMA_V(tt, slot) do { _Pragma("unroll") for (int i = 0; i < 2; ++i) __builtin_amdgcn_global_load_lds((const unsigned*)(Vb + (size_t)(tt) * 64 + vsrc[i]), (LAS unsigned*)(Vt + (slot) * 16384 + (2 * C.wave + i) * 1024), 16, 0, 0); } while (0)
#define AT_BAR() asm volatile("s_waitcnt vmcnt(0) lgkmcnt(0)\n\ts_barrier" ::: "memory")
#define AT_SB() __builtin_amdgcn_sched_barrier(0)
        const int ksw = r32 & 15, vsw = (r32 >> 1) & 7;
#define AT_QK(P0, P1, ks_) do { const float nm_ = -m; _Pragma("unroll") for (int i = 0; i < 16; ++i) { P0[i] = nm_; P1[i] = nm_; } \
            const LAS unsigned char* kbp_ = Kt + (ks_) * 16384 + r32 * 256; \
            _Pragma("unroll") for (int ks = 0; ks < 4; ++ks) { const int co_ = ((map * 8 + ks * 2 + hi) ^ ksw) * 16; \
                P0 = __builtin_amdgcn_mfma_f32_32x32x16_bf16(*(const LAS bf16x8*)(kbp_ + co_), qf[ks], P0, 0, 0, 0); P1 = __builtin_amdgcn_mfma_f32_32x32x16_bf16(*(const LAS bf16x8*)(kbp_ + 32 * 256 + co_), qf[ks], P1, 0, 0, 0); } } while (0)
#define AT_LDV(dst, vs_, d) do { _Pragma("unroll") for (int kst = 0; kst < 4; ++kst) dst[kst] = *(const LAS u32x4*)(Vt + (vs_) * 16384 + ((d) * 32 + r32) * 128 + (((kst * 2 + hi) ^ vsw) * 16)); } while (0)
#define AT_PV(src, d) do { _Pragma("unroll") for (int kst = 0; kst < 4; ++kst) O[d] = __builtin_amdgcn_mfma_f32_32x32x16_bf16(__builtin_bit_cast(bf16x8, src[kst]), pb[kst], O[d], 0, 0, 0); } while (0)
#define AT_SOFTPV(P0, P1, N0, N1, first, hasn, vs_) do { \
            asm volatile("s_nop 15\n\ts_nop 7" : "+v"(P0), "+v"(P1)); \
            float mx = max3f(P0[0], P0[1], P1[0]), mx2 = max3f(P0[2], P0[3], P1[1]); mx = max3f(mx, P1[2], P1[3]); \
            _Pragma("unroll") for (int i = 4; i < 16; i += 4) { mx = max3f(mx, P0[i], P0[i + 1]); mx2 = max3f(mx2, P0[i + 2], P0[i + 3]); mx = max3f(mx, P1[i], P1[i + 1]); mx2 = max3f(mx2, P1[i + 2], P1[i + 3]); } \
            mx = fmaxf(mx, mx2); \
            { auto rr = __builtin_amdgcn_permlane32_swap(__float_as_uint(mx), __float_as_uint(mx), false, false); mx = fmaxf(__uint_as_float(rr[0]), __uint_as_float(rr[1])); } \
            if ((first) || __any(mx > 8.f)) { const float dl = (first) ? mx : fmaxf(mx, 0.f); const float sc = __builtin_amdgcn_exp2f(-dl); lsum *= sc; \
                _Pragma("unroll") for (int d = 0; d < 4; ++d) _Pragma("unroll") for (int i = 0; i < 16; ++i) O[d][i] *= sc; \
                _Pragma("unroll") for (int i = 0; i < 16; ++i) { P0[i] -= dl; P1[i] -= dl; } \
                if (hasn) { asm volatile("s_nop 15\n\ts_nop 7" : "+v"(N0), "+v"(N1)); _Pragma("unroll") for (int i = 0; i < 16; ++i) { N0[i] -= dl; N1[i] -= dl; } } \
                m += dl; } \
            float ps = 0.f, ps2 = 0.f; \
            _Pragma("unroll") for (int i = 0; i < 16; ++i) { P0[i] = __builtin_amdgcn_exp2f(P0[i]); P1[i] = __builtin_amdgcn_exp2f(P1[i]); ps += P0[i]; ps2 += P1[i]; } \
            lsum += ps + ps2; \
            bf16x8 pb[4]; \
            { u32x4 w; w.x = pk2(P0[0], P0[1]); w.y = pk2(P0[2], P0[3]); w.z = pk2(P0[4], P0[5]); w.w = pk2(P0[6], P0[7]); pb[0] = __builtin_bit_cast(bf16x8, w); \
              w.x = pk2(P0[8], P0[9]); w.y = pk2(P0[10], P0[11]); w.z = pk2(P0[12], P0[13]); w.w = pk2(P0[14], P0[15]); pb[1] = __builtin_bit_cast(bf16x8, w); \
              w.x = pk2(P1[0], P1[1]); w.y = pk2(P1[2], P1[3]); w.z = pk2(P1[4], P1[5]); w.w = pk2(P1[6], P1[7]); pb[2] = __builtin_bit_cast(bf16x8, w); \
              w.x = pk2(P1[8], P1[9]); w.y = pk2(P1[10], P1[11]); w.z = pk2(P1[12], P1[13]); w.w = pk2(P1[14], P1[15]); pb[3] = __builtin_bit_cast(bf16x8, w); } \
            u32x4 va[4]; \
            AT_LDV(va, vs_, 0); AT_SB(); AT_PV(va, 0); AT_SB(); AT_LDV(va, vs_, 1); AT_SB(); AT_PV(va, 1); AT_SB(); AT_LDV(va, vs_, 2); AT_SB(); AT_PV(va, 2); AT_SB(); AT_LDV(va, vs_, 3); AT_SB(); AT_PV(va, 3); AT_SB(); } while (0)
        f32x16 pA0, pA1, pB0, pB1;
        AT_DMA_K(0, 0); AT_DMA_V(0, 0); AT_DMA_K(1, 1);
        AT_BAR();
        AT_QK(pA0, pA1, 0);
        asm volatile("s_waitcnt lgkmcnt(0)\n\ts_barrier" ::: "memory");
        for (int t = 0; t < NT; t += 2) {
            if (t + 2 < NT) AT_DMA_K(t + 2, 0);
            AT_DMA_V(t + 1, 1);
            AT_SB(); AT_QK(pB0, pB1, 1); AT_SB();
            AT_SOFTPV(pA0, pA1, pB0, pB1, t == 0, true, 0);
            AT_BAR();
            if (t + 3 < NT) AT_DMA_K(t + 3, 1);
            if (t + 2 < NT) AT_DMA_V(t + 2, 0);
            AT_SB(); if (t + 2 < NT) { AT_QK(pA0, pA1, 0); } AT_SB();
            AT_SOFTPV(pB0, pB1, pA0, pA1, false, t + 2 < NT, 1);
            AT_BAR();
        }
#undef AT_DMA_K
#undef AT_DMA_V
#undef AT_BAR
#undef AT_SB
#undef AT_QK
#undef AT_LDV
#undef AT_PV
#undef AT_SOFTPV
        const float ltot = lsum + __shfl_xor(lsum, 32);
        const float invl = 1.f / ltot;
        if (map == 1) { const float f = lam * invl;
#pragma unroll
            for (int d = 0; d < 4; ++d)
#pragma unroll
                for (int i = 0; i < 16; ++i) xch[(qw * 64 + d * 16 + i) * 64 + C.lane] = O[d][i] * f; }
        __syncthreads();
        if (map == 0) { float ss = 0.f;
#pragma unroll
            for (int d = 0; d < 4; ++d)
#pragma unroll
                for (int i = 0; i < 16; ++i) { const float o = O[d][i] * invl - xch[(qw * 64 + d * 16 + i) * 64 + C.lane]; O[d][i] = o; ss += o * o; }
            ss += __shfl_xor(ss, 32);
            const float rn = rsqrtf(ss * (1.f / 128.f) + RMS_EPS) * (1.f - lam_init);
            bf16_t* orow = A2 + (size_t)(qrow0 + qw * 32 + r32) * DM + h * 128;
#pragma unroll
            for (int d = 0; d < 4; ++d)
#pragma unroll
                for (int g4 = 0; g4 < 4; ++g4) { const int dd = 32 * d + 8 * g4 + 4 * hi; const f32x4 sg = *(const f32x4*)(subg + dd);
                    const f32x4 v = {O[d][4 * g4] * rn * sg[0], O[d][4 * g4 + 1] * rn * sg[1], O[d][4 * g4 + 2] * rn * sg[2], O[d][4 * g4 + 3] * rn * sg[3]};
                    st4bf(orow + dd, v); } }
        __syncthreads();
    }
}

__device__ __forceinline__ void phase_rt(const Ctx& C, const Args& A, int l) {
    unsigned char* ws = A.ws; float* X = (float*)(ws + WS_X); bf16_t* H = (bf16_t*)(ws + WS_H); float* AFF = (float*)(ws + WS_AFF); float* STAT = (float*)(ws + WS_P);
    const float* MOD = (const float*)(ws + WS_MOD) + (size_t)l * 5 * 6144;
    const float* lng = A.in[I_LNG] + (size_t)(l * 2 + 0) * DM; const float* lnb = A.in[I_LNB] + (size_t)(l * 2 + 0) * DM;
    LAS float* wrs = (LAS float*)C.lds;
    { const float* wr = A.in[I_WR] + (size_t)l * DM * 16; for (int i = C.tid; i < DM * 16; i += NTHR) wrs[(i & 15) * 1024 + (i >> 4)] = wr[i]; }
    __syncthreads();
    const int row0 = (int)(((long)C.gw * MROWS) / C.NGW), row1 = (int)(((long)(C.gw + 1) * MROWS) / C.NGW);
    f32x4 lngr[4], lnbr[4], scr[4], shr[4]; int cmi = -1;
#pragma unroll
    for (int j = 0; j < 4; ++j) { const int col = 4 * C.lane + 256 * j; lngr[j] = *(const f32x4*)(lng + col); lnbr[j] = *(const f32x4*)(lnb + col); scr[j] = lngr[j]; shr[j] = lngr[j]; }
    f32x4 xn[4];
    if (row0 < row1) {
#pragma unroll
        for (int j = 0; j < 4; ++j) xn[j] = *(const f32x4*)(X + (size_t)row0 * DM + 4 * C.lane + 256 * j); }
    for (int row = row0; row < row1; ++row) {
        const int mi = row_mi(row);
        if (mi != cmi) { cmi = mi; const float* md = MOD + mi * 6144;
#pragma unroll
            for (int j = 0; j < 4; ++j) { const int col = 4 * C.lane + 256 * j; scr[j] = *(const f32x4*)(md + 4 * DM + col) + 1.f; shr[j] = *(const f32x4*)(md + 3 * DM + col); } }
        f32x4 x[4]; float s = 0.f;
#pragma unroll
        for (int j = 0; j < 4; ++j) { x[j] = xn[j]; s += (x[j][0] + x[j][1]) + (x[j][2] + x[j][3]); }
        if (row + 1 < row1) {
#pragma unroll
            for (int j = 0; j < 4; ++j) xn[j] = *(const f32x4*)(X + (size_t)(row + 1) * DM + 4 * C.lane + 256 * j); }
        const float mean = wave_sum(s) * (1.f / DM); float s2 = 0.f;
#pragma unroll
        for (int j = 0; j < 4; ++j) { x[j] = x[j] - mean; s2 += (x[j][0] * x[j][0] + x[j][1] * x[j][1]) + (x[j][2] * x[j][2] + x[j][3] * x[j][3]); }
        const float rstd = rsqrtf(wave_sum(s2) * (1.f / DM) + LN_EPS);
        if (C.lane == 0) *(f32x2*)(STAT + (size_t)row * 2) = (f32x2){mean, rstd};
        float v[16];
#pragma unroll
        for (int e = 0; e < 16; ++e) v[e] = 0.f;
#pragma unroll
        for (int j = 0; j < 4; ++j) { const int col = 4 * C.lane + 256 * j;
            const f32x4 x1 = x[j] * rstd * lngr[j] + lnbr[j];
            const f32x4 h = x1 * scr[j] + shr[j];
            st4bf(H + (size_t)row * DM + col, h);
#pragma unroll
            for (int e = 0; e < 16; ++e) { const f32x4 w = *(const LAS f32x4*)(wrs + e * 1024 + col); v[e] += (h[0] * w[0] + h[1] * w[1]) + (h[2] * w[2] + h[3] * w[3]); }
            __builtin_amdgcn_sched_barrier(0); }
#pragma unroll
        for (int i = 0; i < 8; ++i) { const float send = (C.lane & 32) ? v[i] : v[i + 8], keep = (C.lane & 32) ? v[i + 8] : v[i]; v[i] = keep + __shfl_xor(send, 32); }
#pragma unroll
        for (int i = 0; i < 4; ++i) { const float send = (C.lane & 16) ? v[i] : v[i + 4], keep = (C.lane & 16) ? v[i + 4] : v[i]; v[i] = keep + __shfl_xor(send, 16); }
#pragma unroll
        for (int i = 0; i < 2; ++i) { const float send = (C.lane & 8) ? v[i] : v[i + 2], keep = (C.lane & 8) ? v[i + 2] : v[i]; v[i] = keep + __shfl_xor(send, 8); }
        { const float send = (C.lane & 4) ? v[0] : v[1], keep = (C.lane & 4) ? v[1] : v[0]; v[0] = keep + __shfl_xor(send, 4); }
        float z = v[0]; z += __shfl_xor(z, 1); z += __shfl_xor(z, 2);
        float mx = z;
#pragma unroll
        for (int o = 4; o < 64; o <<= 1) mx = fmaxf(mx, __shfl_xor(mx, o));
        const float ex = expf(z - mx); float sm = ex;
#pragma unroll
        for (int o = 4; o < 64; o <<= 1) sm += __shfl_xor(sm, o);
        if ((C.lane & 3) == 0) AFF[(size_t)row * 16 + (C.lane >> 2)] = ex / sm;
    }
}

__device__ __forceinline__ void phase_tk(const Ctx& C, const Args& A) {
    unsigned char* ws = A.ws; const float* AFF = (const float*)(ws + WS_AFF); int* SLOT = (int*)(ws + WS_SLOT); int* IDX = (int*)(ws + WS_IDX); float* GATE = (float*)(ws + WS_GATE);
    LAS unsigned* key = (LAS unsigned*)C.lds;
    LAS unsigned* hist = key + 8192;
    LAS unsigned* scn = hist + 256;
    LAS unsigned* wtot = scn + 256;
    LAS unsigned* bc = wtot + 8;
    for (int u = blockIdx.x; u < 128; u += C.G) {
        const bool isctx = u >= 64; const int uu = u & 63, b = uu >> 4, e = uu & 15;
        const int n = isctx ? CTXL : TT, cap = isctx ? CAP_C : CAP_L;
        const int row0 = isctx ? NLAT + b * CTXL : b * TT;
        const int slot0 = e * ESLOTS + (isctx ? 4 * CAP_L + b * CAP_C : b * CAP_L);
        for (int i = C.tid; i < n; i += NTHR) key[i] = __float_as_uint(AFF[(size_t)(row0 + i) * 16 + e]);
        unsigned prefix = 0u, pmask = 0u; int need = cap;
        for (int pass = 0; pass < 4; ++pass) {
            const int shift = 24 - 8 * pass;
            if (C.tid < 256) hist[C.tid] = 0u;
            __syncthreads();
            for (int i = C.tid; i < n; i += NTHR) { const unsigned k = key[i]; if ((k & pmask) == prefix) __hip_atomic_fetch_add(&hist[(k >> shift) & 255u], 1u, __ATOMIC_RELAXED, __HIP_MEMORY_SCOPE_WORKGROUP); }
            __syncthreads();
            {
                const unsigned hd = (C.tid < 256) ? hist[255 - C.tid] : 0u; unsigned inc = hd;
#pragma unroll
                for (int o = 1; o < 64; o <<= 1) { const unsigned t = __shfl_up(inc, o); if (C.lane >= o) inc += t; }
                if (C.tid < 256 && C.lane == 63) wtot[C.wave] = inc;
                __syncthreads();
                if (C.tid < 256) { unsigned base = 0u; for (int w = 0; w < C.wave; ++w) base += wtot[w];
                    const unsigned incl = base + inc, above = incl - hd;
                    if (incl >= (unsigned)need && above < (unsigned)need) { bc[0] = (unsigned)(255 - C.tid); bc[1] = (unsigned)need - above; } }
            }
            __syncthreads();
            prefix |= bc[0] << shift; pmask |= 255u << shift; need = (int)bc[1];
            __syncthreads();
        }
        const int per = (n + NTHR - 1) / NTHR; const int i0 = C.tid * per;
        unsigned cg = 0u, ce = 0u;
        for (int j = 0; j < per; ++j) { const int i = i0 + j; if (i < n) { const unsigned k = key[i]; cg += (k > prefix); ce += (k == prefix); } }
        unsigned pk = cg | (ce << 16), inc = pk;
#pragma unroll
        for (int o = 1; o < 64; o <<= 1) { const unsigned t = __shfl_up(inc, o); if (C.lane >= o) inc += t; }
        if (C.lane == 63) wtot[C.wave] = inc;
        __syncthreads();
        unsigned wbase = 0u;
        for (int w = 0; w < C.wave; ++w) wbase += wtot[w];
        const unsigned excl = wbase + inc - pk;
        unsigned rg = excl & 0xffffu, re = excl >> 16;
        const int ngt = cap - need;
        for (int j = 0; j < per; ++j) { const int i = i0 + j; if (i < n) { const unsigned k = key[i]; int pos = -1;
            if (k > prefix) { pos = (int)rg; ++rg; } else if (k == prefix) { if ((int)re < need) pos = ngt + (int)re; ++re; }
            const int row = row0 + i;
            if (pos >= 0) { IDX[slot0 + pos] = row; GATE[slot0 + pos] = __uint_as_float(k); SLOT[(size_t)row * 16 + e] = slot0 + pos; }
            else SLOT[(size_t)row * 16 + e] = -1; } }
        if (isctx && b == 0 && C.tid < ESLOTS - 4224) { IDX[e * ESLOTS + 4224 + C.tid] = 0; GATE[e * ESLOTS + 4224 + C.tid] = 0.f; }
        __syncthreads();
    }
}

__device__ __forceinline__ void phase_cb(const Ctx& C, const Args& A, int l) {
    unsigned char* ws = A.ws; float* X = (float*)(ws + WS_X); bf16_t* H = (bf16_t*)(ws + WS_H); const int* SLOT = (const int*)(ws + WS_SLOT); const bf16_t* YE = (const bf16_t*)(ws + WS_YE);
    const float* MOD = (const float*)(ws + WS_MOD) + (size_t)l * 5 * 6144; const float* MODN = MOD + 5 * 6144;
    const float* lng = A.in[I_LNG] + (size_t)(l * 2 + 1) * DM; const float* lnb = A.in[I_LNB] + (size_t)(l * 2 + 1) * DM;
    const float* lng1 = A.in[I_LNG] + (size_t)(l * 2 + 0) * DM; const float* lnb1 = A.in[I_LNB] + (size_t)(l * 2 + 0) * DM; const float* STAT = (const float*)(ws + WS_P);
    const int row0 = (int)(((long)C.gw * MROWS) / C.NGW), row1 = (int)(((long)(C.gw + 1) * MROWS) / C.NGW);
    f32x4 lngr[4], lnbr[4], gfr[4], nsc[4], nsh[4], l1g[4], l1b[4]; int cmi = -1;
#pragma unroll
    for (int j = 0; j < 4; ++j) { const int col = 4 * C.lane + 256 * j; lngr[j] = *(const f32x4*)(lng + col); lnbr[j] = *(const f32x4*)(lnb + col); gfr[j] = lngr[j]; nsc[j] = lngr[j]; nsh[j] = lngr[j];
        l1g[j] = *(const f32x4*)(lng1 + col); l1b[j] = *(const f32x4*)(lnb1 + col); }
    int svn = -1; f32x4 xn[4]; f32x2 stn = {0.f, 0.f};
    if (row0 < row1) { svn = SLOT[(size_t)row0 * 16 + (C.lane & 15)]; stn = *(const f32x2*)(STAT + (size_t)row0 * 2);
#pragma unroll
        for (int j = 0; j < 4; ++j) xn[j] = *(const f32x4*)(X + (size_t)row0 * DM + 4 * C.lane + 256 * j); }
    for (int row = row0; row < row1; ++row) {
        const int mi = row_mi(row);
        if (mi != cmi) { cmi = mi; const float* md = MOD + mi * 6144; const float* mn = MODN + mi * 6144;
#pragma unroll
            for (int j = 0; j < 4; ++j) { const int col = 4 * C.lane + 256 * j; gfr[j] = *(const f32x4*)(md + 5 * DM + col);
                if (l < DEPTH - 1) { nsc[j] = *(const f32x4*)(mn + DM + col) + 1.f; nsh[j] = *(const f32x4*)(mn + col); } } }
        const int sv = svn;
        unsigned mask = (unsigned)__ballot(sv >= 0) & 0xffffu;
        f32x4 acc[4];
#pragma unroll
        for (int j = 0; j < 4; ++j) acc[j] = (f32x4){0.f, 0.f, 0.f, 0.f};
        u32x2 y0[4], y1[4]; bool h0 = false, h1 = false;
        if (mask) { const int e = __builtin_ctz(mask); mask &= mask - 1; h0 = true; const int sl = __builtin_amdgcn_readlane(sv, e);
#pragma unroll
            for (int j = 0; j < 4; ++j) y0[j] = *(const u32x2*)(YE + (size_t)sl * DM + 4 * C.lane + 256 * j); }
        if (mask) { const int e = __builtin_ctz(mask); mask &= mask - 1; h1 = true; const int sl = __builtin_amdgcn_readlane(sv, e);
#pragma unroll
            for (int j = 0; j < 4; ++j) y1[j] = *(const u32x2*)(YE + (size_t)sl * DM + 4 * C.lane + 256 * j); }
        f32x4 x[4]; const f32x2 st = stn;
#pragma unroll
        for (int j = 0; j < 4; ++j) x[j] = xn[j];
        if (row + 1 < row1) { svn = SLOT[(size_t)(row + 1) * 16 + (C.lane & 15)]; stn = *(const f32x2*)(STAT + (size_t)(row + 1) * 2);
#pragma unroll
            for (int j = 0; j < 4; ++j) xn[j] = *(const f32x4*)(X + (size_t)(row + 1) * DM + 4 * C.lane + 256 * j); }
        if (h0) {
#pragma unroll
            for (int j = 0; j < 4; ++j) acc[j] += (f32x4){__uint_as_float(y0[j].x << 16), __uint_as_float(y0[j].x & 0xffff0000u), __uint_as_float(y0[j].y << 16), __uint_as_float(y0[j].y & 0xffff0000u)}; }
        if (h1) {
#pragma unroll
            for (int j = 0; j < 4; ++j) acc[j] += (f32x4){__uint_as_float(y1[j].x << 16), __uint_as_float(y1[j].x & 0xffff0000u), __uint_as_float(y1[j].y << 16), __uint_as_float(y1[j].y & 0xffff0000u)}; }
        while (mask) { const int e = __builtin_ctz(mask); mask &= mask - 1; const int sl = __builtin_amdgcn_readlane(sv, e);
#pragma unroll
            for (int j = 0; j < 4; ++j) acc[j] += ld4bf(YE + (size_t)sl * DM + 4 * C.lane + 256 * j); }
        float sm = 0.f;
#pragma unroll
        for (int j = 0; j < 4; ++j) { x[j] = ((x[j] - st[0]) * st[1] * l1g[j] + l1b[j]) * ALPHA_DN + gfr[j] * acc[j];
            sm += (x[j][0] + x[j][1]) + (x[j][2] + x[j][3]); }
        const float mean = wave_sum(sm) * (1.f / DM); float s2 = 0.f;
#pragma unroll
        for (int j = 0; j < 4; ++j) { x[j] = x[j] - mean; s2 += (x[j][0] * x[j][0] + x[j][1] * x[j][1]) + (x[j][2] * x[j][2] + x[j][3] * x[j][3]); }
        const float rstd = rsqrtf(wave_sum(s2) * (1.f / DM) + LN_EPS);
#pragma unroll
        for (int j = 0; j < 4; ++j) { const int col = 4 * C.lane + 256 * j;
            const f32x4 x2 = x[j] * rstd * lngr[j] + lnbr[j];
            if (l < DEPTH - 1) { *(f32x4*)(X + (size_t)row * DM + col) = x2; st4bf(H + (size_t)row * DM + col, x2 * nsc[j] + nsh[j]); }
            else if (row < NLAT) *(f32x4*)(A.out + (size_t)row * DM + col) = x2; }
    }
}


#ifndef GEMM_NOINLINE
#define GEMM_NOINLINE 0
#endif
#if GEMM_NOINLINE
#define GEMM_FN __device__ __noinline__
#else
#define GEMM_FN __device__ __forceinline__
#endif
GEMM_FN void gphase_in(LAS unsigned char* lds, unsigned char* ws, int nN, int G) {
    int bx = blockIdx.x; asm volatile("" : "+s"(bx), "+s"(G));
    pg8::Gemm g{(const bf16_t*)(ws + WS_H), (const bf16_t*)(ws + WS_WIN), DM}; pg8::Order<0> S; S.init(MROWS / 256, nN, G, bx, nullptr, 0);
    pg8::EpiBf16 E{(bf16_t*)(ws + WS_P), P_LD}; pg8::gemm_phase(lds, g, S, E); }
GEMM_FN void gphase_in_odd(LAS unsigned char* lds, unsigned char* ws, int G) {
    int bx = blockIdx.x; asm volatile("" : "+s"(bx), "+s"(G));
    pg8::Gemm g{(const bf16_t*)(ws + WS_H), (const bf16_t*)(ws + WS_WIN), DM}; pg8::Order<0> S; S.init(MROWS / 256, D_IN_ODD / 256, G, bx, nullptr, 0);
    pg8::EpiOdd E{(bf16_t*)(ws + WS_P), (bf16_t*)(ws + WS_Q), (bf16_t*)(ws + WS_KA), (const float*)(ws + WS_ROPE)}; pg8::gemm_phase(lds, g, S, E); }
GEMM_FN void gphase_lora(LAS unsigned char* lds, unsigned char* ws, const float* d0, const float* a0, const float* kal, int G) {
    int bx = blockIdx.x; asm volatile("" : "+s"(bx), "+s"(G));
    pg8::Gemm g{(const bf16_t*)(ws + WS_LIN), (const bf16_t*)(ws + WS_WLORA), LORA_K}; pg8::Order<0> S; S.init(MROWS / 256, LORA_N / 256, G, bx, nullptr, 0);
    pg8::EpiLora E{ws + WS_SCN, (bf16_t*)(ws + WS_G), d0, a0, kal}; pg8::gemm_phase(lds, g, S, E); }
GEMM_FN void gphase_out(LAS unsigned char* lds, unsigned char* ws, const float* modl, int G, const float* xin, const float* cin) {
    int bx = blockIdx.x; asm volatile("" : "+s"(bx), "+s"(G));
    pg8::Gemm g{(const bf16_t*)(ws + WS_A2), (const bf16_t*)(ws + WS_WOUT), DM}; pg8::Order<0> S; S.init(MROWS / 256, DM / 256, G, bx, nullptr, 0);
    pg8::EpiRes E{(float*)(ws + WS_X), modl, xin, cin}; pg8::gemm_phase(lds, g, S, E); }
GEMM_FN void gphase_e1(LAS unsigned char* lds, unsigned char* ws, int G, int l) {
    int bx = blockIdx.x; asm volatile("" : "+s"(bx), "+s"(G));
    pg8::Gemm g{(const bf16_t*)(ws + WS_H), (const bf16_t*)(ws + WS_WE13 + (size_t)(l & 1) * WE13_BYTES), DM}; pg8::EpiSwiGLU E{(bf16_t*)(ws + WS_HID)};
    pg8::OrderExp<1> S; S.init(4096 / 256, G, bx, (const int*)(ws + WS_IDX), (long)4096 * DM); pg8::gemm_phase(lds, g, S, E); }
GEMM_FN void gphase_e2(LAS unsigned char* lds, unsigned char* ws, int G, int l) {
    int bx = blockIdx.x; asm volatile("" : "+s"(bx), "+s"(G));
    pg8::Gemm g{(const bf16_t*)(ws + WS_HID), (const bf16_t*)(ws + WS_WE2 + (size_t)(l & 1) * WE2_BYTES), D_EXP}; pg8::EpiYE E{(bf16_t*)(ws + WS_YE), (const float*)(ws + WS_GATE)};
    pg8::OrderExp<2> S; S.init(DM / 256, G, bx, nullptr, (long)DM * D_EXP); pg8::gemm_phase(lds, g, S, E); }

constexpr int NSLOT = 13;
constexpr int NSTEP = 1 + DEPTH * NSLOT;
__global__ void __launch_bounds__(NTHR, 2) mk_fwd(Args KA) {
    extern __shared__ __attribute__((aligned(16))) unsigned char lds_raw[];
    volatile LAS unsigned* MISC = (volatile LAS unsigned*)((LAS unsigned char*)lds_raw + LDS_MISC);
    if (threadIdx.x < 16) MISC[threadIdx.x] = 0u;
    if (threadIdx.x == 0) { LAS unsigned long long* tb = (LAS unsigned long long*)((LAS unsigned char*)lds_raw + LDS_PTAB);
#pragma unroll
        for (int i = 0; i < 37; ++i) tb[i] = (unsigned long long)KA.in[i];
        tb[37] = (unsigned long long)KA.out; tb[38] = (unsigned long long)KA.ws; }
    __syncthreads();
    const int lo = KA.lo, hi = KA.hi;
    unsigned bar_x = 0;
    if (hi - lo > 1) { const XcdBarrier b0 = xcd_barrier_post((unsigned*)(KA.ws + WS_CTL), MISC); bar_x = b0.x; }
#ifndef PH_MASK
#define PH_MASK 0xFFFFFF
#endif
#ifndef REP_MASK
#define REP_MASK 0
#endif
#define PH_BIT(k) (((k) == 0) ? 0 : 1 + ((k) - 1) % NSLOT + (((k) - 1) % NSLOT >= 2 && ((k) - 1) % NSLOT <= 3 && odd ? 12 : 0))
#define RUN(k, ...) do { if (((PH_MASK >> PH_BIT(k)) & 1) && lo <= (k) && (k) < hi) { const int nrep = ((REP_MASK >> PH_BIT(k)) & 1) ? 2 : 1; \
        _Pragma("unroll 1") for (int rep = 0; rep < nrep; ++rep) { \
        Ctx C; mkctx(C, (LAS unsigned char*)lds_raw); Args A; ldargs(A, (LAS unsigned char*)lds_raw); unsigned char* ws = A.ws; \
        const float* MODL = (const float*)(ws + WS_MOD) + (size_t)l * 5 * 6144; (void)MODL; \
        __VA_ARGS__; if ((k) + 1 < hi || rep + 1 < nrep) { XcdBarrier bar; bar.bar = (unsigned*)(ws + WS_CTL); bar.x = bar_x; bar.st = MISC; xcd_barrier(bar); } } } } while (0)
    { const bool odd = false; const int l = 0; RUN(0, { phase_init(C, A); __syncthreads(); conv_items(C, A, 0, C.gw, C.NGW, true, true, true); }); }
#pragma unroll 1
    for (int l = 0; l < DEPTH; ++l) {
        const int sb = 1 + l * NSLOT; const bool odd = l & 1;
        if (!(CHUNKED_SCAN && odd)) { RUN(sb + 0, { phase_conv(C, A, l); if (l == 0) phase_modh(C, A, 0); }); }
        if (odd) { RUN(sb + 1, { gphase_in_odd(C.lds, ws, C.G);
                   const int tail = ((MROWS / 256) * (D_IN_ODD / 256)) % C.G;
                   if (CHUNKED_SCAN && l + 1 < DEPTH && tail > 0 && (int)blockIdx.x >= tail) conv_items(C, A, l + 1, ((int)blockIdx.x - tail) * NWAVES + C.wave, (C.G - tail) * NWAVES, false, false, true, 0, YW_IN_HI); }); }
        else { RUN(sb + 1, { gphase_in(C.lds, ws, D_IN_EVEN_PAD / 256, C.G);
                   const int tail = ((MROWS / 256) * (D_IN_EVEN_PAD / 256)) % C.G;
                   if (CHUNKED_SCAN && l + 1 < DEPTH && tail > 0 && (int)blockIdx.x >= tail) conv_items(C, A, l + 1, ((int)blockIdx.x - tail) * NWAVES + C.wave, (C.G - tail) * NWAVES, false, false, true, 0, XW_IN_HI); }); }
        if (!odd) {
            RUN(sb + 2, phase_ef1(C, A, l));
            RUN(sb + 3, { const int i2 = l >> 1; gphase_lora(C.lds, ws, A.in[I_D0] + (size_t)i2 * 2 * 768, A.in[I_A0] + (size_t)i2 * 2 * 768, A.in[I_KAL] + (size_t)i2 * 768, C.G); });
#if CHUNKED_SCAN
            RUN(sb + 4, phase_csa(C, A));
            RUN(sb + 5, phase_csb(C, A, l));
#else
            RUN(sb + 4, phase_scan(C, A));
#endif
            RUN(sb + 6, phase_ef2(C, A, l));
        } else {
            RUN(sb + 2, { phase_of1(C, A, l);
                   const int busy2 = 256 + 8 * 7 - C.G;
                   if (CHUNKED_SCAN && l + 1 < DEPTH && busy2 > 0 && (int)blockIdx.x >= busy2) conv_items(C, A, l + 1, ((int)blockIdx.x - busy2) * NWAVES + C.wave, (C.G - busy2) * NWAVES, false, false, true, YW_IN_HI, YW_OF_HI); });
            RUN(sb + 3, phase_attn(C, A, l));
        }
        RUN(sb + 7, { gphase_out(C.lds, ws, MODL, C.G, l == 0 ? A.in[I_X] : (const float*)(ws + WS_X), l == 0 ? A.in[I_CTX] : (const float*)(ws + WS_X) + (size_t)NLAT * DM);
                   const int tail = ((MROWS / 256) * (DM / 256)) % C.G;
                   if (CHUNKED_SCAN && l + 1 < DEPTH && tail > 0 && (int)blockIdx.x >= tail) conv_items(C, A, l + 1, ((int)blockIdx.x - tail) * NWAVES + C.wave, (C.G - tail) * NWAVES, false, false, true, odd ? YW_OF_HI : XW_IN_HI, odd ? YW_OUT_HI : XW_OUT_HI); });
        RUN(sb + 8, phase_rt(C, A, l));
        RUN(sb + 9, { phase_tk(C, A);
                   if (CHUNKED_SCAN && l + 1 < DEPTH && (int)blockIdx.x >= 128) conv_items(C, A, l + 1, ((int)blockIdx.x - 128) * NWAVES + C.wave, (C.G - 128) * NWAVES, false, false, true, odd ? YW_OUT_HI : XW_OUT_HI, odd ? YW_TK_HI : XW_TK_HI); });
        RUN(sb + 10, gphase_e1(C.lds, ws, C.G, l));
        RUN(sb + 11, gphase_e2(C.lds, ws, C.G, l));
        RUN(sb + 12, { phase_cb(C, A, l); if (CHUNKED_SCAN && !odd && l + 1 < DEPTH) { __syncthreads(); conv_items(C, A, l + 1, C.gw, C.NGW, false, true, false); } });
    }
#undef RUN
}

#ifdef PHASE_PROBE
#define PROBE_PRE extern __shared__ __attribute__((aligned(16))) unsigned char lds_raw[]; Ctx C; mkctx(C, (LAS unsigned char*)lds_raw); unsigned char* ws = A.ws; (void)ws;
__global__ void __launch_bounds__(NTHR, 2) pr_init(Args A) { PROBE_PRE phase_init(C, A); }
__global__ void __launch_bounds__(NTHR, 2) pr_conv(Args A) { PROBE_PRE phase_conv(C, A, A.lo); }
__global__ void __launch_bounds__(NTHR, 2) pr_modh(Args A) { PROBE_PRE phase_modh(C, A, A.lo); }
__global__ void __launch_bounds__(NTHR, 2) pr_ef1(Args A) { PROBE_PRE phase_ef1(C, A, A.lo); }
__global__ void __launch_bounds__(NTHR, 2) pr_scan(Args A) { PROBE_PRE phase_scan(C, A); }
__global__ void __launch_bounds__(NTHR, 2) pr_ef2(Args A) { PROBE_PRE phase_ef2(C, A, A.lo); }
__global__ void __launch_bounds__(NTHR, 2) pr_csa(Args A) { PROBE_PRE phase_csa(C, A); }
__global__ void __launch_bounds__(NTHR, 2) pr_csb(Args A) { PROBE_PRE phase_csb(C, A, A.lo); }
__global__ void __launch_bounds__(NTHR, 2) pr_of1(Args A) { PROBE_PRE phase_of1(C, A, A.lo); }
__global__ void __launch_bounds__(NTHR, 2) pr_attn(Args A) { PROBE_PRE phase_attn(C, A, A.lo); }
__global__ void __launch_bounds__(NTHR, 2) pr_rt(Args A) { PROBE_PRE phase_rt(C, A, A.lo); }
__global__ void __launch_bounds__(NTHR, 2) pr_tk(Args A) { PROBE_PRE phase_tk(C, A); }
__global__ void __launch_bounds__(NTHR, 2) pr_cb(Args A) { PROBE_PRE phase_cb(C, A, A.lo); }
__global__ void __launch_bounds__(NTHR, 2) pr_gemm_in(Args A) { PROBE_PRE pg8::Gemm g{(const bf16_t*)(ws + WS_H), (const bf16_t*)(ws + WS_WIN), DM}; pg8::Order<0> S; S.init(MROWS / 256, A.lo, C.G, (int)blockIdx.x, nullptr, 0);
                      pg8::EpiBf16 E{(bf16_t*)(ws + WS_P), P_LD}; pg8::gemm_phase(C.lds, g, S, E); }
__global__ void __launch_bounds__(NTHR, 2) pr_gemm_lora(Args A) { PROBE_PRE pg8::Gemm g{(const bf16_t*)(ws + WS_LIN), (const bf16_t*)(ws + WS_WLORA), LORA_K}; pg8::Order<0> S; S.init(MROWS / 256, LORA_N / 256, C.G, (int)blockIdx.x, nullptr, 0);
                          const int i2 = A.lo; pg8::EpiLora E{ws + WS_SCN, (bf16_t*)(ws + WS_G), A.in[I_D0] + (size_t)i2 * 2 * 768, A.in[I_A0] + (size_t)i2 * 2 * 768, A.in[I_KAL] + (size_t)i2 * 768};
                          pg8::gemm_phase(C.lds, g, S, E); }
__global__ void __launch_bounds__(NTHR, 2) pr_gemm_out(Args A) { PROBE_PRE pg8::Gemm g{(const bf16_t*)(ws + WS_A2), (const bf16_t*)(ws + WS_WOUT), DM}; pg8::Order<0> S; S.init(MROWS / 256, DM / 256, C.G, (int)blockIdx.x, nullptr, 0);
                      pg8::EpiRes E{(float*)(ws + WS_X), (const float*)(ws + WS_MOD), (const float*)(ws + WS_X), (const float*)(ws + WS_X) + (size_t)NLAT * DM}; pg8::gemm_phase(C.lds, g, S, E); }
__global__ void __launch_bounds__(NTHR, 2) pr_gemm_e1(Args A) { PROBE_PRE pg8::Gemm g{(const bf16_t*)(ws + WS_H), (const bf16_t*)(ws + WS_WE13), DM}; pg8::Order<1> S; S.init(NEXP * 17, 4096 / 256, C.G, (int)blockIdx.x, (const int*)(ws + WS_IDX), (long)4096 * DM);
                      pg8::EpiSwiGLU E{(bf16_t*)(ws + WS_HID)}; pg8::gemm_phase(C.lds, g, S, E); }
__global__ void __launch_bounds__(NTHR, 2) pr_gemm_e2(Args A) { PROBE_PRE pg8::Gemm g{(const bf16_t*)(ws + WS_HID), (const bf16_t*)(ws + WS_WE2), D_EXP}; pg8::Order<2> S; S.init(NEXP * 17, DM / 256, C.G, (int)blockIdx.x, nullptr, (long)DM * D_EXP);
                       pg8::EpiYE E{(bf16_t*)(ws + WS_YE), (const float*)(ws + WS_GATE)}; pg8::gemm_phase(C.lds, g, S, E); }
#endif

extern "C" void kernel_launch(void* const* d_in, const int* in_sizes, int n_in, void* d_out, int out_size, void* d_ws, size_t ws_size, hipStream_t stream) {
    static int grid = 0;
    if (grid == 0) {
        if (n_in != 37 || out_size != NLAT * DM || ws_size < WS_END) { fprintf(stderr, "kernel_launch: unexpected shapes: n_in %d out %d ws %zu (need %zu)\n", n_in, out_size, ws_size, (size_t)WS_END); grid = -1; return; }
        int dev = 0, cus = 0, per_cu = 0;
        if (hipGetDevice(&dev) != hipSuccess || hipDeviceGetAttribute(&cus, hipDeviceAttributeMultiprocessorCount, dev) != hipSuccess) { grid = -1; return; }
        if (hipFuncSetAttribute((const void*)mk_fwd, hipFuncAttributeMaxDynamicSharedMemorySize, LDS_BYTES) != hipSuccess) { fprintf(stderr, "kernel_launch: hipFuncSetAttribute failed\n"); grid = -1; return; }
        if (hipOccupancyMaxActiveBlocksPerMultiprocessor(&per_cu, (const void*)mk_fwd, NTHR, LDS_BYTES) != hipSuccess || per_cu < 1) fprintf(stderr, "kernel_launch: occupancy query reports %d\n", per_cu);
        (void)hipGetLastError();
        grid = cus;
    }
    if (grid < 0) return;
    (void)hipMemsetAsync((char*)d_ws + WS_CTL, 0, CTL_BYTES, stream);
    Args a{};
    for (int i = 0; i < 37; ++i) a.in[i] = (const float*)d_in[i];
    a.out = (float*)d_out; a.ws = (unsigned char*)d_ws;
#if MK_MULTI
    for (int k = 0; k < NSTEP; ++k) {
        if (k >= 1) { const int l = (k - 1) / NSLOT, s = (k - 1) % NSLOT; if ((l & 1) && ((s >= 4 && s <= 6) || (CHUNKED_SCAN && s == 0))) continue; if (!(l & 1) && !CHUNKED_SCAN && s == 5) continue; }
        a.lo = k; a.hi = k + 1;
        hipLaunchKernelGGL(mk_fwd, dim3(grid), dim3(NTHR), LDS_BYTES, stream, a);
    }
#else
    a.lo = 0; a.hi = NSTEP;
    hipLaunchKernelGGL(mk_fwd, dim3(grid), dim3(NTHR), LDS_BYTES, stream, a);
#endif
    const hipError_t le = hipPeekAtLastError();
    if (le != hipSuccess) fprintf(stderr, "kernel_launch: launch failed: %s\n", hipGetErrorName(le));
}
```

```cpp
#include <hip/hip_runtime.h>
#include <cstdio>
#include <cstdint>
#include <cmath>

#ifndef MK_MULTI
#define MK_MULTI 0
#endif
#ifndef CHUNKED_SCAN
#define CHUNKED_SCAN 1
#endif

#define GAS __attribute__((address_space(1)))
#define LAS __attribute__((address_space(3)))
typedef unsigned short bf16_t;
typedef short bf16x8 __attribute__((ext_vector_type(8)));
typedef float f32x4 __attribute__((ext_vector_type(4)));
typedef float f32x2 __attribute__((ext_vector_type(2)));
typedef float f32x16 __attribute__((ext_vector_type(16)));
typedef unsigned u32x4 __attribute__((ext_vector_type(4)));
typedef unsigned u32x2 __attribute__((ext_vector_type(2)));
typedef __bf16 bf16x2_t __attribute__((ext_vector_type(2)));

constexpr int NB = 4, TT = 8192, DM = 1024, NLAT = NB * TT, CTXL = 256, NCTX = NB * CTXL, MROWS = NLAT + NCTX;
constexpr int DEPTH = 4;
constexpr int D_CONV = 256, RW_H = 12, RW_K = 64, D_RWKV = 768, RWKV_COLS = 2688, D_IN_EVEN = 3456, D_IN_EVEN_PAD = 3584;
constexpr int D_DIFF = 768, D_GMLP = 256, D_IN_ODD = 2816;
constexpr int NEXP = 16, D_EXP = 2048, CAP_L = 1024, CAP_C = 32, ESLOTS = 4352;
constexpr int P_LD = 3584;
constexpr int LORA_K = 384, LORA_N = 3840;
constexpr int LKEYS = CTXL + TT;
constexpr float ALPHA_DN = 1.6817928305074290f;
constexpr float DECAY_SCALE = 0.6065306597126334f;
constexpr float GN_EPS = 64e-5f, LN_EPS = 1e-5f, RMS_EPS = 1e-5f;
constexpr float QSCALE = 0.125f * 1.4426950408889634f;

constexpr size_t al256(size_t x) { return (x + 255) & ~(size_t)255; }
constexpr size_t WS_CTL = 0;
constexpr size_t CTL_BYTES = 65536;
constexpr size_t WS_MOD = WS_CTL + CTL_BYTES;
constexpr size_t WS_ROPE = WS_MOD + al256((size_t)DEPTH * 5 * 6144 * 4);
constexpr size_t WS_WIN = WS_ROPE + 32768;
constexpr size_t WS_WOUT = WS_WIN + (size_t)D_IN_EVEN_PAD * DM * 2;
constexpr size_t WS_WLORA = WS_WOUT + (size_t)DM * DM * 2;
constexpr size_t WS_WE13 = WS_WLORA + (size_t)LORA_N * LORA_K * 2;
constexpr size_t WE13_BYTES = (size_t)NEXP * 4096 * DM * 2, WE2_BYTES = (size_t)NEXP * DM * D_EXP * 2;
constexpr size_t WS_WE2 = WS_WE13 + 2 * WE13_BYTES;
constexpr size_t WS_X = WS_WE2 + 2 * WE2_BYTES;
constexpr size_t WS_H = WS_X + (size_t)MROWS * DM * 4;
constexpr size_t WS_A2 = WS_H + (size_t)MROWS * DM * 2;
constexpr size_t WS_P = WS_A2 + (size_t)MROWS * DM * 2;
constexpr size_t WS_AFF = WS_P + (size_t)MROWS * P_LD * 2;
constexpr size_t WS_SLOT = WS_AFF + (size_t)MROWS * 16 * 4;
constexpr size_t WS_IDX = WS_SLOT + (size_t)MROWS * 16 * 4;
constexpr size_t WS_GATE = WS_IDX + al256((size_t)NEXP * ESLOTS * 4);
constexpr size_t WS_R2 = WS_GATE + al256((size_t)NEXP * ESLOTS * 4);
constexpr int SC_REC = 1408, SC_ROW = 12 * SC_REC, SC_W = 0, SC_R = 512, SC_KK = 640, SC_V = 768, SC_B = 896, SC_KR = 1024;
constexpr size_t WS_SCN = WS_R2;
constexpr size_t WS_G = WS_SCN + (size_t)MROWS * SC_ROW;
constexpr size_t WS_LIN = WS_G + (size_t)MROWS * 768 * 2;
constexpr int CS_L = 64, CS_NCH = LKEYS / CS_L, CS_UNITS = NB * RW_H * 2;
constexpr size_t WS_CHK = WS_LIN + (size_t)MROWS * 384 * 2;
constexpr size_t WS_EVEN_END = WS_CHK + (size_t)CS_UNITS * CS_NCH * 32768;
constexpr size_t WS_Y = WS_P;
constexpr size_t WS_Q = WS_R2;
constexpr size_t WS_KA = WS_Q + (size_t)MROWS * 768 * 2;
constexpr size_t WS_VT = WS_KA + (size_t)NB * LKEYS * 768 * 2;
constexpr size_t WS_HID = WS_R2;
constexpr size_t WS_YE = WS_HID + (size_t)NEXP * ESLOTS * D_EXP * 2;
constexpr size_t WS_END = WS_EVEN_END;
static_assert(WS_END <= (size_t)2147483648ull, "workspace over 2 GiB");
static_assert((size_t)2 * MROWS * 768 * 4 <= (size_t)MROWS * P_LD * 2, "Y aliases P");
static_assert(WS_YE + (size_t)NEXP * ESLOTS * DM * 2 <= WS_END, "moe region");

constexpr int LDS_BYTES = 147456;
constexpr int LDS_MISC = 140 * 1024;
constexpr int LDS_PTAB = LDS_MISC + 256;
constexpr int NWAVES = 8, NTHR = 512;

__device__ __forceinline__ unsigned f2bf(float f) { unsigned u = __float_as_uint(f); return (u + 0x7fffu + ((u >> 16) & 1u)) >> 16; }
__device__ __forceinline__ unsigned pk2(float lo, float hi) { f32x2 v = {lo, hi}; bf16x2_t b = __builtin_convertvector(v, bf16x2_t); return __builtin_bit_cast(unsigned, b); }
__device__ __forceinline__ float bflo(unsigned u) { return __uint_as_float(u << 16); }
__device__ __forceinline__ float bfhi(unsigned u) { return __uint_as_float(u & 0xffff0000u); }
__device__ __forceinline__ float bf2f(bf16_t b) { return __uint_as_float((unsigned)b << 16); }
__device__ __forceinline__ float sigmoidf_(float x) { return __builtin_amdgcn_rcpf(1.f + __expf(-x)); }
__device__ __forceinline__ float wave_sum(float v) {
#pragma unroll
    for (int o = 1; o < 64; o <<= 1) v += __shfl_xor(v, o);
    return v;
}
__device__ __forceinline__ float sum16(float v) {
#pragma unroll
    for (int o = 1; o < 16; o <<= 1) v += __shfl_xor(v, o);
    return v;
}
__device__ __forceinline__ f32x4 ld4bf_(const void* p) { const u32x2 u = *(const u32x2*)p; return (f32x4){bflo(u.x), bfhi(u.x), bflo(u.y), bfhi(u.y)}; }
__device__ __forceinline__ void st4bf_(void* p, f32x4 v) { u32x2 o; o.x = pk2(v[0], v[1]); o.y = pk2(v[2], v[3]); *(u32x2*)p = o; }
__device__ __forceinline__ float max3f(float a, float b, float c) { float r; asm("v_max3_f32 %0, %1, %2, %3" : "=v"(r) : "v"(a), "v"(b), "v"(c)); return r; }
__device__ __forceinline__ int crow(int r, int hi) { return (r & 3) + 8 * (r >> 2) + 4 * hi; }
__device__ __forceinline__ f32x2 gelu_pk(f32x2 v) {
    const f32x2 av = __builtin_elementwise_abs(v), d = av * 0.2316418882f + 1.0f;
    f32x2 t; t.x = __builtin_amdgcn_rcpf(d.x); t.y = __builtin_amdgcn_rcpf(d.y);
    f32x2 q = t * 0.5307027145f + (-0.7265760135f); q = q * t + 0.7107068705f; q = q * t + (-0.142248368f); q = q * t + 0.127414796f; q = q * t;
    const f32x2 s = (v * v) * (-0.72134752044f);
    f32x2 e; e.x = __builtin_amdgcn_exp2f(s.x); e.y = __builtin_amdgcn_exp2f(s.y);
    const f32x2 m = v * (q * e), r = v - m;
    f32x2 o; o.x = v.x < 0.f ? m.x : r.x; o.y = v.y < 0.f ? m.y : r.y; return o;
}
__device__ __forceinline__ f32x4 gelu4(f32x4 v) { const f32x2 a = gelu_pk((f32x2){v[0], v[1]}), b = gelu_pk((f32x2){v[2], v[3]}); return (f32x4){a.x, a.y, b.x, b.y}; }
__device__ __forceinline__ float tanh_fast(float x) { return 1.f - 2.f * __builtin_amdgcn_rcpf(1.f + __expf(2.f * x)); }

#define XB_TMO      128
#define XB_XCNT(j)  (256  + 64 * (j))
#define XB_XSUB(j)  (1280 + 64 * (j))
#define XB_XGEN(j)  (2304 + 64 * (j))
#define XB_TOP      3328
#define XB_TOPGEN   3392
#define XCD_BAR_WORDS 3456
#define XB_SPIN_CAP (1u << 20)

__device__ __forceinline__ unsigned xb_ld(unsigned* p)              { return __hip_atomic_load(p, __ATOMIC_RELAXED, __HIP_MEMORY_SCOPE_AGENT); }
__device__ __forceinline__ unsigned xb_add(unsigned* p, unsigned v) { return __hip_atomic_fetch_add(p, v, __ATOMIC_RELAXED, __HIP_MEMORY_SCOPE_AGENT); }
__device__ __forceinline__ unsigned xb_xcc_id() { return (unsigned)__builtin_amdgcn_s_getreg((3 << 11) | 20) & 0xFu; }
#define XB_SPIN(cond, bar) do { unsigned _sp = 0; while (cond) { __builtin_amdgcn_s_sleep(1); \
    if ((++_sp & 255u) == 0u) { if (xb_ld(&(bar)[XB_TMO])) break; if (_sp > XB_SPIN_CAP) { atomicAdd(&(bar)[XB_TMO], 1u); break; } } } } while (0)

struct XcdBarrier { unsigned* bar; unsigned x; volatile LAS unsigned* st; };

__device__ __forceinline__ XcdBarrier xcd_barrier_post(unsigned* bar, volatile LAS unsigned* st) {
    XcdBarrier b; b.bar = bar; b.x = xb_xcc_id(); b.st = st;
    if (threadIdx.x == 0) (void)xb_add(&bar[XB_XCNT(b.x)], 1u);
    return b;
}
__device__ __forceinline__ void xcd_barrier_complete(unsigned* bar, unsigned x, unsigned& nloc, unsigned& nx) {
    const unsigned G = gridDim.x * gridDim.y * gridDim.z;
    unsigned sum, cnt, mine, sp = 0u;
    for (;;) {
        sum = 0u; cnt = 0u; mine = 0u;
#pragma unroll
        for (unsigned j = 0; j < 16; ++j) { const unsigned c = xb_ld(&bar[XB_XCNT(j)]); sum += c; cnt += (c > 0u) ? 1u : 0u; mine = (j == x) ? c : mine; }
        if (sum == G) break;
        __builtin_amdgcn_s_sleep(1);
        if ((++sp & 255u) == 0u) { if (xb_ld(&bar[XB_TMO])) break; if (sp > XB_SPIN_CAP) { atomicAdd(&bar[XB_TMO], 1u); break; } }
    }
    nloc = mine > 0u ? mine : 1u; nx = cnt > 0u ? cnt : 1u;
}
__device__ __forceinline__ void xcd_barrier(const XcdBarrier& b) {
    asm volatile("s_waitcnt vmcnt(0)" ::: "memory");
    __syncthreads();
    if (threadIdx.x == 0) {
        unsigned* bar = b.bar;
        __builtin_amdgcn_s_waitcnt(0);
        unsigned nloc = b.st[0], nx = b.st[1];
        if (nloc == 0u) { xcd_barrier_complete(bar, b.x, nloc, nx); b.st[0] = nloc; b.st[1] = nx; }
        const unsigned old = xb_add(&bar[XB_XSUB(b.x)], 1u);
        const unsigned gen = old / nloc;
        if (old + 1u == (gen + 1u) * nloc) {
            __builtin_amdgcn_fence(__ATOMIC_RELEASE, "agent");
            asm volatile("s_waitcnt vmcnt(0)" ::: "memory");
            const unsigned og = xb_add(&bar[XB_TOP], 1u);
            const unsigned tg = og / nx;
            if (og + 1u == (tg + 1u) * nx) xb_add(&bar[XB_TOPGEN], 1u);
            else XB_SPIN(xb_ld(&bar[XB_TOPGEN]) == tg, bar);
            __builtin_amdgcn_fence(__ATOMIC_ACQUIRE, "agent");
            xb_add(&bar[XB_XGEN(b.x)], 1u);
            asm volatile("s_waitcnt vmcnt(0)" ::: "memory");
        } else {
            XB_SPIN(xb_ld(&bar[XB_XGEN(b.x)]) == gen, bar);
            __builtin_amdgcn_fence(__ATOMIC_ACQUIRE, "agent");
            asm volatile("s_waitcnt vmcnt(0)" ::: "memory");
        }
    }
    __syncthreads();
}

namespace pg8 {
constexpr int BM = 256, BK = 64, HALF = 128, HTB = HALF * BK * 2, STAGE_BYTES = 8 * HTB, NXCD = 8, WGM = 8;
__host__ __device__ __forceinline__ int lds_byte(int r, int c) { const int st = (r >> 4) * 2 + (c >> 5), rr = r & 15, cc = c & 31, ob = rr * 64 + cc * 2; return st * 1024 + (ob ^ (((ob >> 9) & 1) << 5)); }
__host__ __device__ __forceinline__ void stage_rc(int b, int& R, int& C) { const int st = b / 1024, sb = b % 1024, swz = sb ^ (((sb >> 9) & 1) << 5); R = (st >> 1) * 16 + swz / 64; C = (st & 1) * 32 + (swz % 64) / 2; }

struct Unit { int pm, pn, hf; };
struct Gemm { const bf16_t* A; const bf16_t* Bt; int K; };

template <int MODE> struct Order {
    static constexpr bool GATHER = (MODE == 1);
    int nM, nN, nwg, G, c; const int* idx; long bstride;
    __device__ __forceinline__ void init(int nM_, int nN_, int G_, int c_, const int* idx_, long bstride_) { nM = nM_; nN = nN_; nwg = nM * nN; G = G_; c = c_; idx = idx_; bstride = bstride_; }
    __device__ __forceinline__ bool next(int i, Unit& u) const {
        const long L = (long)i * G + c; if (L >= nwg) return false;
        int wgid = (int)L; { const int q = nwg / NXCD, r = nwg % NXCD, xcd = wgid % NXCD, off = wgid / NXCD; wgid = (xcd < r ? xcd * (q + 1) : r * (q + 1) + (xcd - r) * q) + off; }
        const int nig = WGM * nN, gid = wgid / nig, fm = gid * WGM, gsz = (nM - fm) < WGM ? (nM - fm) : WGM;
        u.pm = fm + ((wgid % nig) % gsz); u.pn = (wgid % nig) / gsz; u.hf = (MODE != 0 && (u.pm % 17) == 16) ? 1 : 0; return true;
    }
    __device__ __forceinline__ unsigned arow(const Unit& u, int r) const { if (MODE == 1) return (unsigned)idx[u.pm * BM + r]; return (unsigned)(u.pm * BM + r); }
    __device__ __forceinline__ long bbase(const Unit& u, int K) const { long o = (long)u.pn * BM * K; if (MODE != 0) o += (long)(u.pm / 17) * bstride; return o; }
};

template <int MODE> struct OrderExp {
    static constexpr bool GATHER = (MODE == 1);
    int nN, G, c0; const int* idx; long bstride;
    __device__ __forceinline__ void init(int nN_, int G_, int c_, const int* idx_, long bstride_) { nN = nN_; G = G_; c0 = c_; idx = idx_; bstride = bstride_; }
    __device__ __forceinline__ bool next(int i0, Unit& u) const {
        const int v = i0 * G + c0, i = v >> 8, c = v & 255;
        const int x = c & 7, slot = c >> 3, per = 32 / nN, nfull = 256 / (8 * per);
        if (i > nfull) return false;
        if (i < nfull) { u.pn = slot / per; const int f = (i * 8 + x) * per + (slot % per); u.pm = (f >> 4) * 17 + (f & 15); u.hf = 0; return true; }
        if (i == nfull && slot < 2 * nN) { u.pn = slot >> 1; u.pm = (x * 2 + (slot & 1)) * 17 + 16; u.hf = 1; return true; }
        return false;
    }
    __device__ __forceinline__ unsigned arow(const Unit& u, int r) const { if (MODE == 1) return (unsigned)idx[u.pm * BM + r]; return (unsigned)(u.pm * BM + r); }
    __device__ __forceinline__ long bbase(const Unit& u, int K) const { return (long)u.pn * BM * K + (long)(u.pm / 17) * bstride; }
};

template <class Epi, class Sched>
__device__ __forceinline__ void gemm_phase(LAS unsigned char* lds, const Gemm g, const Sched& S, const Epi& E) {
    int tid = threadIdx.x; asm volatile("" : "+v"(tid));
    const int wid = __builtin_amdgcn_readfirstlane(tid >> 6), wr = wid >> 2, wc = wid & 3;
    const int K = g.K, nt = K / BK;
    unsigned voffB[2];
    { const int lane = tid & 63, fr = lane & 15, fq = lane >> 4; (void)fr; (void)fq; }
#pragma unroll
    for (int i = 0; i < 2; ++i) { int R, Cc; stage_rc(tid * 16 + i * 8192, R, Cc); voffB[i] = (unsigned)(R * K + Cc) * 2u; }
    const size_t kstep = (size_t)(BK * 2);
    const size_t hstep = (size_t)HALF * K * 2;
    const unsigned ldsw = (unsigned)wid * 1024u;
    const int aoff = lds_byte(wr * 64 + (tid & 15), ((tid & 63) >> 4) * 8), boff = lds_byte(wc * 32 + (tid & 15), ((tid & 63) >> 4) * 8);
#define PG8_SA(b, h) (((b) * 2 + (h)) * HTB)
#define PG8_SB(b, h) ((4 + (b) * 2 + (h)) * HTB)
#define PG8_STAGE(bufoff, gbase, voff) do { _Pragma("unroll") for (int _i = 0; _i < 2; ++_i) \
        __builtin_amdgcn_global_load_lds((const unsigned*)((const char*)(gbase) + (voff)[_i]), (LAS unsigned*)(lds + (bufoff) + ldsw + _i * 8192), 16, 0, 0); } while (0)
#define PG8_LDA(dst, b, h) do { _Pragma("unroll") for (int m = 0; m < 4; ++m) _Pragma("unroll") for (int k = 0; k < 2; ++k) dst[m][k] = *(const LAS bf16x8*)(lds + PG8_SA(b, h) + aoff + m * 2048 + k * 1024); } while (0)
#define PG8_LDB(dst, b, h) do { _Pragma("unroll") for (int n = 0; n < 2; ++n) _Pragma("unroll") for (int k = 0; k < 2; ++k) dst[n][k] = *(const LAS bf16x8*)(lds + PG8_SB(b, h) + boff + n * 2048 + k * 1024); } while (0)
#define PG8_MMA(ai, bj, At, Bt) do { __builtin_amdgcn_s_setprio(1); _Pragma("unroll") for (int m = 0; m < 4; ++m) _Pragma("unroll") for (int n = 0; n < 2; ++n) _Pragma("unroll") for (int k = 0; k < 2; ++k) \
        acc[ai][bj][m][n] = __builtin_amdgcn_mfma_f32_16x16x32_bf16(Bt[n][k], At[m][k], acc[ai][bj][m][n], 0, 0, 0); __builtin_amdgcn_s_setprio(0); } while (0)
#define PG8_WAIT_V(n) asm volatile("s_waitcnt vmcnt(" #n ")" ::: "memory")
#define PG8_WAIT_L(n) asm volatile("s_waitcnt lgkmcnt(" #n ")" ::: "memory")
#define PG8_BAR __builtin_amdgcn_s_barrier()
#define PG8_SCHED __builtin_amdgcn_sched_barrier(0)
#define PG8_ROWOFFS(dst, u, tq) do { _Pragma("unroll") for (int _i = 0; _i < 2; ++_i) { int _R, _C; stage_rc((tq) * 16 + _i * 8192, _R, _C); _Pragma("unroll") for (int _h = 0; _h < 2; ++_h) dst[_h][_i] = (S.arow(u, _h * HALF + _R) * (unsigned)K + (unsigned)_C) * 2u; } } while (0)
    Unit cur, nxt; int ui = 0;
    if (!S.next(0, cur)) return;
    float zf = 0.f; asm volatile("" : "+v"(zf));
    f32x4 acc[2][2][4][2];
#pragma unroll
    for (int a = 0; a < 2; ++a)
#pragma unroll
        for (int b = 0; b < 2; ++b)
#pragma unroll
            for (int m = 0; m < 4; ++m)
#pragma unroll
                for (int n = 0; n < 2; ++n) acc[a][b][m][n] = (f32x4){zf, zf, zf, zf};
    bf16x8 At[4][2], B0[2][2], B1[2][2];
    unsigned vcur[2][2];
    if constexpr (Sched::GATHER) { PG8_ROWOFFS(vcur, cur, tid); }
    const char* const Ab = (const char*)g.A;
    const char* cA = Sched::GATHER ? Ab : Ab + (size_t)(unsigned)__builtin_amdgcn_readfirstlane((int)S.arow(cur, 0)) * K * 2;
#define PG8_STAGEA(bufoff, ptr, h) do { if constexpr (Sched::GATHER) { PG8_STAGE(bufoff, ptr, vcur[h]); } else { PG8_STAGE(bufoff, (ptr) + (h) * hstep, voffB); } } while (0)
    const char* cB = (const char*)g.Bt + (size_t)S.bbase(cur, K) * 2;
    PG8_STAGE(PG8_SB(0, 0), cB, voffB); PG8_STAGE(PG8_SB(0, 1), cB + hstep, voffB); PG8_STAGEA(PG8_SA(0, 0), cA, 0); PG8_STAGEA(PG8_SA(0, 1), cA, 1);
    if (wr == 1) PG8_BAR;
    PG8_WAIT_V(2); PG8_BAR;
    PG8_STAGE(PG8_SB(1, 0), cB + kstep, voffB); PG8_STAGEA(PG8_SA(1, 0), cA + kstep, 0); PG8_STAGE(PG8_SB(1, 1), cB + hstep + kstep, voffB);
    PG8_WAIT_V(6); PG8_BAR;
    for (;;) {
        const bool has_next = S.next(ui + 1, nxt);
        const char* nB = has_next ? (const char*)g.Bt + (size_t)S.bbase(nxt, K) * 2 : cB;
        const char* nA = (Sched::GATHER || !has_next) ? cA : Ab + (size_t)(unsigned)__builtin_amdgcn_readfirstlane((int)S.arow(nxt, 0)) * K * 2;
#pragma unroll 1
        for (int t = 0; t < nt; t += 2) {
            const bool last = (t == nt - 2);
            const char* a1 = cA + (size_t)(t + 1) * kstep;
            const char* a2 = last ? nA : cA + (size_t)(t + 2) * kstep; const char* b2 = last ? nB : cB + (size_t)(t + 2) * kstep;
            const char* a3 = a2 + kstep; const char* b3 = b2 + kstep;
            PG8_LDB(B0, 0, 0); PG8_LDB(B1, 0, 1); PG8_SCHED; PG8_LDA(At, 0, 0); PG8_STAGEA(PG8_SA(1, 1), a1, 1);
            PG8_WAIT_V(8); PG8_WAIT_L(0); PG8_BAR; PG8_MMA(0, 0, At, B0); PG8_MMA(0, 1, At, B1); PG8_BAR; PG8_SCHED;
            if constexpr (Sched::GATHER) { if (last && has_next) { int tq = tid; asm volatile("" : "+v"(tq)); PG8_ROWOFFS(vcur, nxt, tq); } }
            PG8_LDA(At, 0, 1); PG8_STAGE(PG8_SB(0, 0), b2, voffB); PG8_STAGE(PG8_SB(0, 1), b2 + hstep, voffB); PG8_STAGEA(PG8_SA(0, 0), a2, 0);
            PG8_WAIT_V(8); PG8_WAIT_L(0); PG8_BAR; if (!cur.hf) { PG8_MMA(1, 0, At, B0); PG8_MMA(1, 1, At, B1); } PG8_BAR; PG8_SCHED;
            PG8_LDB(B0, 1, 0); PG8_LDB(B1, 1, 1); PG8_SCHED; PG8_LDA(At, 1, 0); PG8_STAGEA(PG8_SA(0, 1), a2, 1);
            PG8_WAIT_V(8); PG8_WAIT_L(0); PG8_BAR; PG8_MMA(0, 0, At, B0); PG8_MMA(0, 1, At, B1); PG8_BAR; PG8_SCHED;
            PG8_LDA(At, 1, 1); PG8_STAGE(PG8_SB(1, 0), b3, voffB); PG8_STAGE(PG8_SB(1, 1), b3 + hstep, voffB); PG8_STAGEA(PG8_SA(1, 0), a3, 0);
            PG8_WAIT_V(8); PG8_WAIT_L(0); PG8_BAR; if (!cur.hf) { PG8_MMA(1, 0, At, B0); PG8_MMA(1, 1, At, B1); } PG8_BAR; PG8_SCHED;
        }
        if (wr == 0) PG8_BAR;
        { int tz = tid; asm volatile("" : "+v"(tz)); const int ln = tz & 63; E(acc, cur, wr, wc, ln & 15, ln >> 4); }
        if (!has_next) break;
#pragma unroll
        for (int a = 0; a < 2; ++a)
#pragma unroll
            for (int b = 0; b < 2; ++b)
#pragma unroll
                for (int m = 0; m < 4; ++m)
#pragma unroll
                    for (int n = 0; n < 2; ++n) acc[a][b][m][n] = (f32x4){zf, zf, zf, zf};
        cur = nxt; cB = nB; cA = nA; ++ui;
        if (wr == 1) PG8_BAR;
    }
    PG8_WAIT_V(0);
    PG8_BAR;
#undef PG8_SA
#undef PG8_SB
#undef PG8_STAGE
#undef PG8_LDA
#undef PG8_LDB
#undef PG8_MMA
#undef PG8_WAIT_V
#undef PG8_WAIT_L
#undef PG8_BAR
#undef PG8_SCHED
#undef PG8_ROWOFFS
#undef PG8_STAGEA
}

#define EPI_LOOP for (int ai = 0; ai < 2; ++ai) for (int m = 0; m < 4; ++m) for (int bj = 0; bj < 2; ++bj) for (int n = 0; n < 2; ++n)
struct EpiBf16 {
    bf16_t* O; int ldc;
    __device__ __forceinline__ void operator()(const f32x4 (&acc)[2][2][4][2], const Unit& u, int wr, int wc, int fr, int fq) const {
        const int row0 = u.pm * BM + wr * 64 + fr, col0 = u.pn * BM + wc * 32 + 4 * fq;
#pragma unroll
        for (int ai = 0; ai < 2; ++ai)
#pragma unroll
            for (int m = 0; m < 4; ++m) { bf16_t* rowp = O + (size_t)(row0 + ai * HALF + m * 16) * ldc + col0;
#pragma unroll
                for (int bj = 0; bj < 2; ++bj)
#pragma unroll
                    for (int n = 0; n < 2; ++n) { const f32x4 v = acc[ai][bj][m][n]; u32x2 o; o.x = pk2(v[0], v[1]); o.y = pk2(v[2], v[3]); *(u32x2*)(rowp + bj * HALF + n * 16) = o; } }
    }
};
struct EpiOdd {
    bf16_t* P; bf16_t* Q; bf16_t* KA; const float* rope;
    __device__ __forceinline__ void operator()(const f32x4 (&acc)[2][2][4][2], const Unit& u, int wr, int wc, int fr, int fq) const {
        const int row0 = u.pm * BM + wr * 64 + fr, col0 = u.pn * BM + wc * 32 + 4 * fq;
        if (u.pn >= 6) {
#pragma unroll
            for (int ai = 0; ai < 2; ++ai)
#pragma unroll
                for (int m = 0; m < 4; ++m) { bf16_t* rowp = P + (size_t)(row0 + ai * HALF + m * 16) * P_LD + col0;
#pragma unroll
                    for (int bj = 0; bj < 2; ++bj)
#pragma unroll
                        for (int n = 0; n < 2; ++n) { const f32x4 v = acc[ai][bj][m][n]; u32x2 o; o.x = pk2(v[0], v[1]); o.y = pk2(v[2], v[3]); *(u32x2*)(rowp + bj * HALF + n * 16) = o; } }
            return;
        }
        const bool isk = u.pn >= 3, isctx = u.pm >= NLAT / BM; const int axis = wc & 1;
        const int cq = col0 - (isk ? 768 : 0);
        f32x4 csr[2][4], snr[2][4];
#pragma unroll
        for (int ai = 0; ai < 2; ++ai)
#pragma unroll
            for (int m = 0; m < 4; ++m) { const int row = row0 + ai * HALF + m * 16; csr[ai][m] = (f32x4){1.f, 1.f, 1.f, 1.f}; snr[ai][m] = (f32x4){0.f, 0.f, 0.f, 0.f};
                if (!isctx) { const int t = row & (TT - 1); const int pos = axis ? 128 + (t & 63) : (t >> 6);
                    csr[ai][m] = *(const f32x4*)(rope + pos * 16 + 4 * fq); snr[ai][m] = *(const f32x4*)(rope + 192 * 16 + pos * 16 + 4 * fq); } }
#pragma unroll
        for (int ai = 0; ai < 2; ++ai)
#pragma unroll
            for (int m = 0; m < 4; ++m) { const int row = row0 + ai * HALF + m * 16;
                const f32x4 cs = csr[ai][m], sn = snr[ai][m]; size_t orow;
                if (!isctx) { const int t = row & (TT - 1); orow = isk ? (size_t)(row >> 13) * LKEYS + CTXL + t : (size_t)row; }
                else { const int rc = row - NLAT; orow = isk ? (size_t)(rc >> 8) * LKEYS + (rc & 255) : (size_t)row; }
                bf16_t* op = (isk ? KA : Q) + orow * 768 + cq; const float sc = isk ? 1.f : QSCALE;
#pragma unroll
                for (int bj = 0; bj < 2; ++bj) { const f32x4 x1 = acc[ai][bj][m][0], x2 = acc[ai][bj][m][1];
                    const f32x4 o1 = (x1 * cs - x2 * sn) * sc, o2 = (x1 * sn + x2 * cs) * sc;
                    u32x2 a; a.x = pk2(o1[0], o1[1]); a.y = pk2(o1[2], o1[3]); *(u32x2*)(op + bj * HALF) = a;
                    u32x2 b; b.x = pk2(o2[0], o2[1]); b.y = pk2(o2[2], o2[3]); *(u32x2*)(op + bj * HALF + 16) = b; } }
    }
};
struct EpiRes {
    float* X; const float* modl; const float* xin; const float* cin;
    __device__ __forceinline__ void operator()(const f32x4 (&acc)[2][2][4][2], const Unit& u, int wr, int wc, int fr, int fq) const {
        const int row0 = u.pm * BM + wr * 64 + fr, col0 = u.pn * BM + wc * 32 + 4 * fq;
        const int mi = (u.pm * BM < NLAT) ? (u.pm * BM) / TT : 4;
        const float* gate = modl + mi * 6144 + 2 * DM;
        const float* rsrc = (u.pm * BM < NLAT) ? xin : cin - (size_t)NLAT * DM;
        f32x4 gv[2][2];
#pragma unroll
        for (int bj = 0; bj < 2; ++bj)
#pragma unroll
            for (int n = 0; n < 2; ++n) gv[bj][n] = *(const f32x4*)(gate + col0 + bj * HALF + n * 16);
#pragma unroll
        for (int ai = 0; ai < 2; ++ai) { f32x4 xr[4][2][2];
#pragma unroll
            for (int m = 0; m < 4; ++m) { const float* rowp = rsrc + (size_t)(row0 + ai * HALF + m * 16) * DM + col0;
#pragma unroll
                for (int bj = 0; bj < 2; ++bj)
#pragma unroll
                    for (int n = 0; n < 2; ++n) xr[m][bj][n] = *(const f32x4*)(rowp + bj * HALF + n * 16); }
#pragma unroll
            for (int m = 0; m < 4; ++m) { float* rowp = X + (size_t)(row0 + ai * HALF + m * 16) * DM + col0;
#pragma unroll
                for (int bj = 0; bj < 2; ++bj)
#pragma unroll
                    for (int n = 0; n < 2; ++n) *(f32x4*)(rowp + bj * HALF + n * 16) = xr[m][bj][n] * ALPHA_DN + gv[bj][n] * acc[ai][bj][m][n]; } }
    }
};
struct EpiSwiGLU {
    bf16_t* HID;
    __device__ __forceinline__ void operator()(const f32x4 (&acc)[2][2][4][2], const Unit& u, int wr, int wc, int fr, int fq) const {
        const int row0 = u.pm * BM + wr * 64 + fr, f0 = u.pn * HALF + wc * 32 + 4 * fq;
#pragma unroll
        for (int ai = 0; ai < 2; ++ai) if (ai == 0 || !u.hf)
#pragma unroll
            for (int m = 0; m < 4; ++m) { bf16_t* rowp = HID + (size_t)(row0 + ai * HALF + m * 16) * D_EXP + f0;
#pragma unroll
                for (int n = 0; n < 2; ++n) { const f32x4 a = acc[ai][0][m][n], b = acc[ai][1][m][n]; float h[4];
#pragma unroll
                    for (int j = 0; j < 4; ++j) h[j] = a[j] * __builtin_amdgcn_rcpf(1.f + __expf(-a[j])) * b[j];
                    u32x2 o; o.x = pk2(h[0], h[1]); o.y = pk2(h[2], h[3]); *(u32x2*)(rowp + n * 16) = o; } }
    }
};
struct EpiYE {
    bf16_t* YE; const float* gate;
    __device__ __forceinline__ void operator()(const f32x4 (&acc)[2][2][4][2], const Unit& u, int wr, int wc, int fr, int fq) const {
        const int row0 = u.pm * BM + wr * 64 + fr, col0 = u.pn * BM + wc * 32 + 4 * fq;
        float gts[2][4];
#pragma unroll
        for (int ai = 0; ai < 2; ++ai)
#pragma unroll
            for (int m = 0; m < 4; ++m) gts[ai][m] = gate[row0 + ai * HALF + m * 16];
#pragma unroll
        for (int ai = 0; ai < 2; ++ai) if (ai == 0 || !u.hf)
#pragma unroll
            for (int m = 0; m < 4; ++m) { const int row = row0 + ai * HALF + m * 16; const float gt = gts[ai][m]; bf16_t* rowp = YE + (size_t)row * DM + col0;
#pragma unroll
                for (int bj = 0; bj < 2; ++bj)
#pragma unroll
                    for (int n = 0; n < 2; ++n) { const f32x4 v = acc[ai][bj][m][n] * gt; u32x2 o; o.x = pk2(v[0], v[1]); o.y = pk2(v[2], v[3]); *(u32x2*)(rowp + bj * HALF + n * 16) = o; } }
    }
};
struct EpiLora {
    unsigned char* SCN; bf16_t* G; const float* decay0; const float* a0; const float* kalpha;
    __device__ __forceinline__ void operator()(const f32x4 (&acc)[2][2][4][2], const Unit& u, int wr, int wc, int fr, int fq) const {
        const int row0 = u.pm * BM + wr * 64 + fr;
        const int seg = u.pn / 3, cb = (u.pn % 3) * BM + wc * 32 + 4 * fq;
        f32x4 par0[2][2], par1[2][2];
#pragma unroll
        for (int bj = 0; bj < 2; ++bj)
#pragma unroll
            for (int n = 0; n < 2; ++n) { const int col = cb + bj * HALF + n * 16; par0[bj][n] = (f32x4){0.f, 0.f, 0.f, 0.f}; par1[bj][n] = par0[bj][n];
                if (seg < 2) par0[bj][n] = *(const f32x4*)(decay0 + seg * 768 + col);
                else if (seg < 4) { par0[bj][n] = *(const f32x4*)(a0 + (seg - 2) * 768 + col); par1[bj][n] = *(const f32x4*)(kalpha + col); } }
#pragma unroll
        for (int bj = 0; bj < 2; ++bj)
#pragma unroll
            for (int n = 0; n < 2; ++n) {
                const int col = cb + bj * HALF + n * 16, head = col >> 6, kx = col & 63;
                if (seg < 2) {
                    const f32x4 d0 = par0[bj][n];
#pragma unroll
                    for (int ai = 0; ai < 2; ++ai)
#pragma unroll
                        for (int m = 0; m < 4; ++m) { const int row = row0 + ai * HALF + m * 16; f32x4 w;
#pragma unroll
                            for (int j = 0; j < 4; ++j) { const float lw = -DECAY_SCALE * sigmoidf_(d0[j] + acc[ai][bj][m][n][j]); w[j] = CHUNKED_SCAN ? lw : __expf(lw); }
                            *(f32x4*)(SCN + (size_t)(row * 12 + head) * SC_REC + SC_W + seg * 256 + kx * 4) = w; __builtin_amdgcn_sched_barrier(0); }
                } else if (seg < 4) {
                    const int d = seg - 2;
                    const f32x4 a00 = par0[bj][n], kal = par1[bj][n];
                    u32x2 kkr[2][4], ksr[2][4];
#pragma unroll
                    for (int ai = 0; ai < 2; ++ai)
#pragma unroll
                        for (int m = 0; m < 4; ++m) { const unsigned char* base = SCN + (size_t)((row0 + ai * HALF + m * 16) * 12 + head) * SC_REC + kx * 2;
                            kkr[ai][m] = *(const u32x2*)(base + SC_KK); ksr[ai][m] = *(const u32x2*)(base + SC_KR + 256 * d); }
#pragma unroll
                    for (int ai = 0; ai < 2; ++ai)
#pragma unroll
                        for (int m = 0; m < 4; ++m) { const int row = row0 + ai * HALF + m * 16; unsigned char* base = SCN + (size_t)(row * 12 + head) * SC_REC + kx * 2;
                            const f32x4 kk = {bflo(kkr[ai][m].x), bfhi(kkr[ai][m].x), bflo(kkr[ai][m].y), bfhi(kkr[ai][m].y)}; const f32x4 ks = {bflo(ksr[ai][m].x), bfhi(ksr[ai][m].x), bflo(ksr[ai][m].y), bfhi(ksr[ai][m].y)}; f32x4 bb, kr;
#pragma unroll
                            for (int j = 0; j < 4; ++j) { const float a = sigmoidf_(a00[j] + acc[ai][bj][m][n][j]); bb[j] = kk[j] * a; kr[j] = ks[j] * (1.f + (a - 1.f) * kal[j]); }
                            st4bf_(base + SC_B + 256 * d, bb); st4bf_(base + SC_KR + 256 * d, kr); __builtin_amdgcn_sched_barrier(0); }
                } else {
#pragma unroll
                    for (int ai = 0; ai < 2; ++ai)
#pragma unroll
                        for (int m = 0; m < 4; ++m) { const int row = row0 + ai * HALF + m * 16; const f32x4 v = acc[ai][bj][m][n]; u32x2 o; o.x = pk2(v[0], v[1]); o.y = pk2(v[2], v[3]);
                            *(u32x2*)(G + (size_t)row * 768 + col) = o; }
                }
            }
    }
};
}

struct Args { const float* in[37]; float* out; unsigned char* ws; int lo, hi; };
enum { I_X = 0, I_C, I_CTX, I_CCTX, I_WMOD, I_BMOD, I_LNG, I_LNB, I_EWIN, I_EWOUT, I_CONVW, I_MU, I_DUP, I_D0, I_AUP, I_A0, I_GUP, I_KXI, I_KAL, I_RBON, I_GNG, I_GNB,
       I_OWIN, I_OWOUT, I_LQ1, I_LK1, I_LQ2, I_LK2, I_SUBG, I_GLNG, I_GLNB, I_GWS, I_GBS, I_WR, I_WE1, I_WE3, I_WE2 };

struct Ctx {
    LAS unsigned char* lds;
    int tid, lane, wave, G, vcu, gw, NGW;
};
__device__ __forceinline__ void mkctx(Ctx& C, LAS unsigned char* lds) {
    int tid = threadIdx.x; asm volatile("" : "+v"(tid));
    C.lds = lds; C.tid = tid; C.lane = tid & 63; C.wave = __builtin_amdgcn_readfirstlane(tid >> 6);
    C.G = gridDim.x; { const int bx = blockIdx.x; C.vcu = (C.G % 8 == 0) ? (bx % 8) * (C.G / 8) + bx / 8 : bx; }
    C.gw = blockIdx.x * NWAVES + C.wave; C.NGW = C.G * NWAVES;
}
#define GLOBAL_PTR(T, v) ((T*)(__attribute__((address_space(1))) T*)(v))
__device__ __forceinline__ void ldargs(Args& A, LAS unsigned char* lds) {
    LAS const u32x2* tb = (LAS const u32x2*)(lds + LDS_PTAB); asm volatile("" : "+v"(tb));
#pragma unroll
    for (int i = 0; i < 37; ++i) { const u32x2 v = tb[i]; A.in[i] = GLOBAL_PTR(const float, ((unsigned long long)(unsigned)__builtin_amdgcn_readfirstlane((int)v.y) << 32) | (unsigned)__builtin_amdgcn_readfirstlane((int)v.x)); }
    { const u32x2 v = tb[37]; A.out = GLOBAL_PTR(float, ((unsigned long long)(unsigned)__builtin_amdgcn_readfirstlane((int)v.y) << 32) | (unsigned)__builtin_amdgcn_readfirstlane((int)v.x)); }
    { const u32x2 v = tb[38]; A.ws = GLOBAL_PTR(unsigned char, ((unsigned long long)(unsigned)__builtin_amdgcn_readfirstlane((int)v.y) << 32) | (unsigned)__builtin_amdgcn_readfirstlane((int)v.x)); }
    A.lo = 0; A.hi = 0;
}
__device__ __forceinline__ int row_mi(int row) { return row < NLAT ? (row >> 13) : 4; }

__device__ __forceinline__ void phase_init(const Ctx& C, const Args& A) {
    unsigned char* ws = A.ws;
    float* MOD = (float*)(ws + WS_MOD);
    LAS float* sv = (LAS float*)C.lds;
    LAS float* red = sv + 5 * 1024;
    for (int i = C.tid; i < 5 * 1024; i += NTHR) { const int v = i >> 10, k = i & 1023; const float c = (v < 4) ? A.in[I_C][v * DM + k] : A.in[I_CCTX][k]; sv[i] = c / (1.f + __expf(-c)); }
    __syncthreads();
    const int j = C.tid & 127, kp = C.tid >> 7;
    for (int it = blockIdx.x; it < DEPTH * 48; it += C.G) {
        const int l = it / 48, cg = it % 48, col = cg * 128 + j;
        const float* W = A.in[I_WMOD] + (size_t)l * DM * 6144 + col;
        float a0 = 0.f, a1 = 0.f, a2 = 0.f, a3 = 0.f, a4 = 0.f;
#pragma unroll 32
        for (int k = kp * 256; k < kp * 256 + 256; ++k) { const float w = W[(size_t)k * 6144];     a0 += sv[k] * w; a1 += sv[1024 + k] * w; a2 += sv[2048 + k] * w; a3 += sv[3072 + k] * w; a4 += sv[4096 + k] * w; }
        red[(kp * 5 + 0) * 128 + j] = a0; red[(kp * 5 + 1) * 128 + j] = a1; red[(kp * 5 + 2) * 128 + j] = a2; red[(kp * 5 + 3) * 128 + j] = a3; red[(kp * 5 + 4) * 128 + j] = a4;
        __syncthreads();
        for (int o = C.tid; o < 5 * 128; o += NTHR) { const int v = o >> 7, jj = o & 127; const int cc = cg * 128 + jj;
            const float s = red[(0 * 5 + v) * 128 + jj] + red[(1 * 5 + v) * 128 + jj] + red[(2 * 5 + v) * 128 + jj] + red[(3 * 5 + v) * 128 + jj];
            MOD[((size_t)l * 5 + v) * 6144 + cc] = s + A.in[I_BMOD][l * 6144 + cc]; }
        __syncthreads();
    }
    if (blockIdx.x == C.G - 1) { float* rope = (float*)(ws + WS_ROPE);
        for (int i = C.tid; i < 192 * 16; i += NTHR) { const int pos = i >> 4, j = i & 15; const float ang = (float)(pos < 128 ? pos : pos - 128) * powf(10000.f, -(float)j * (1.f / 16.f));
            rope[i] = cosf(ang); rope[192 * 16 + i] = sinf(ang); } }
}

__device__ __forceinline__ void transpose_item(const float* W, int ldw, int k0, int n0, bf16_t* WT, int ldt, int drow0, LAS float* scr, int lane) {
    { float v[64]; const float* src = W + (size_t)k0 * ldw + n0 + lane;
#pragma unroll
      for (int k = 0; k < 64; ++k) v[k] = __builtin_nontemporal_load(src + (size_t)k * ldw);
#pragma unroll
      for (int k = 0; k < 64; ++k) scr[k * 65 + lane] = v[k]; }
    asm volatile("s_waitcnt lgkmcnt(0)" ::: "memory");
    const int c = lane & 7;
#pragma unroll
    for (int j = 0; j < 8; ++j) { const int n = (lane >> 3) + 8 * j; const LAS float* s = scr + (8 * c) * 65 + n;
        u32x4 o; o.x = pk2(s[0 * 65], s[1 * 65]); o.y = pk2(s[2 * 65], s[3 * 65]); o.z = pk2(s[4 * 65], s[5 * 65]); o.w = pk2(s[6 * 65], s[7 * 65]);
        *(u32x4*)(WT + (size_t)(drow0 + n) * ldt + k0 + 8 * c) = o; }
    asm volatile("s_waitcnt lgkmcnt(0)" ::: "memory");
}
constexpr int XW_IN_HI = 3200, XW_OUT_HI = 7040, XW_TK_HI = 9088;
constexpr int YW_IN_HI = 1344, YW_OF_HI = 6144, YW_OUT_HI = 9984, YW_TK_HI = 12032;
__device__ __forceinline__ void conv_items(const Ctx& C, const Args& A, int l, int gw, int NGW, bool do_in, bool do_out, bool do_exp, int lo = 0, int hi = 1 << 30) {
    unsigned char* ws = A.ws;
    const int i2 = l >> 1; const bool odd = (l & 1);
    LAS float* scr = (LAS float*)C.lds + C.wave * (64 * 65);
    bf16_t* WIN = (bf16_t*)(ws + WS_WIN); bf16_t* WOUT = (bf16_t*)(ws + WS_WOUT); bf16_t* WE13 = (bf16_t*)(ws + WS_WE13 + (size_t)(l & 1) * WE13_BYTES); bf16_t* WE2 = (bf16_t*)(ws + WS_WE2 + (size_t)(l & 1) * WE2_BYTES);
    const int nin = odd ? D_IN_ODD : D_IN_EVEN;
    const float* win = odd ? A.in[I_OWIN] + (size_t)i2 * DM * D_IN_ODD : A.in[I_EWIN] + (size_t)i2 * DM * D_IN_EVEN;
    const float* wout = odd ? A.in[I_OWOUT] + (size_t)i2 * DM * DM : A.in[I_EWOUT] + (size_t)i2 * DM * DM;
    const int n_in = do_in ? 16 * (nin / 64) : 0, n_out = do_out ? 16 * 16 : 0, n_e13 = do_exp ? NEXP * 2 * 16 * 32 : 0, n_e2 = do_exp ? NEXP * 32 * 16 : 0;
    const int total = (n_in + n_out + n_e13 + n_e2) < hi ? (n_in + n_out + n_e13 + n_e2) : hi;
    for (int it = lo + gw; it < total; it += NGW) {
        int r = it;
        if (r < n_in) { const int nb = nin / 64, kb = r / nb, nn = r % nb; transpose_item(win, nin, kb * 64, nn * 64, WIN, DM, nn * 64, scr, C.lane); continue; } r -= n_in;
        if (r < n_out) { const int kb = r / 16, nn = r % 16; transpose_item(wout, DM, kb * 64, nn * 64, WOUT, DM, nn * 64, scr, C.lane); continue; } r -= n_out;
        if (r < n_e13) { const int e = r / 1024, q = r % 1024, mat = q / 512, q2 = q % 512, kb = q2 / 32, nn = q2 % 32;
            const float* W = (mat ? A.in[I_WE3] : A.in[I_WE1]) + ((size_t)l * NEXP + e) * DM * D_EXP;
            const int f0 = nn * 64; const int drow = (f0 >> 7) * 256 + mat * 128 + (f0 & 127);
            transpose_item(W, D_EXP, kb * 64, f0, WE13 + (size_t)e * 4096 * DM, DM, drow, scr, C.lane); continue; } r -= n_e13;
        { const int e = r / 512, q = r % 512, kb = q / 16, nn = q % 16;
            const float* W = A.in[I_WE2] + ((size_t)l * NEXP + e) * D_EXP * DM;
            transpose_item(W, DM, kb * 64, nn * 64, WE2 + (size_t)e * DM * D_EXP, D_EXP, nn * 64, scr, C.lane); }
    }
}
__device__ __forceinline__ void phase_conv(const Ctx& C, const Args& A, int l) {
    unsigned char* ws = A.ws;
    const int i2 = l >> 1; const bool odd = (l & 1);
    bf16_t* WIN = (bf16_t*)(ws + WS_WIN);
    const bool early = CHUNKED_SCAN && odd;
    if (l > 0) { if (early || !CHUNKED_SCAN) conv_items(C, A, l, C.gw, C.NGW, !early, true, !early);
                 else { conv_items(C, A, l, C.gw, C.NGW, true, true, false); conv_items(C, A, l, C.gw, C.NGW, false, false, true, YW_TK_HI); } }
    if (!odd) {
        u32x4* z = (u32x4*)(WIN + (size_t)D_IN_EVEN * DM);
        unsigned zz = 0u; asm volatile("" : "+v"(zz));
        for (int i = blockIdx.x * NTHR + C.tid; i < (D_IN_EVEN_PAD - D_IN_EVEN) * DM / 8; i += C.G * NTHR) z[i] = (u32x4){zz, zz, zz, zz};
        bf16_t* WL = (bf16_t*)(ws + WS_WLORA);
        const float* dup = A.in[I_DUP] + (size_t)i2 * 2 * 64 * 768; const float* aup = A.in[I_AUP] + (size_t)i2 * 2 * 64 * 768; const float* gup = A.in[I_GUP] + (size_t)i2 * 128 * 768;
        for (int i = blockIdx.x * NTHR + C.tid; i < LORA_N * LORA_K; i += C.G * NTHR) {
            const int kk = i / LORA_N, n = i % LORA_N, seg = n / 768, col = n % 768; float v = 0.f;
            if (seg == 0) { if (kk < 64) v = dup[(size_t)(0 * 64 + kk) * 768 + col]; }
            else if (seg == 1) { if (kk >= 64 && kk < 128) v = dup[(size_t)(1 * 64 + kk - 64) * 768 + col]; }
            else if (seg == 2) { if (kk >= 128 && kk < 192) v = aup[(size_t)(0 * 64 + kk - 128) * 768 + col]; }
            else if (seg == 3) { if (kk >= 192 && kk < 256) v = aup[(size_t)(1 * 64 + kk - 192) * 768 + col]; }
            else { if (kk >= 256) v = gup[(size_t)(kk - 256) * 768 + col]; }
            WL[(size_t)n * LORA_K + kk] = (bf16_t)f2bf(v);
        }
    }
}

__device__ __forceinline__ void phase_modh(const Ctx& C, const Args& A, int l) {
    bf16_t* H = (bf16_t*)(A.ws + WS_H); const float* MOD = (const float*)(A.ws + WS_MOD) + (size_t)l * 5 * 6144;
    const float* xin = A.in[I_X]; const float* cin = A.in[I_CTX] - (size_t)NLAT * DM;
#define MODH_SRC(row_) (((row_) < NLAT ? xin : cin) + (size_t)(row_) * DM)
    const int row0 = (int)(((long)C.gw * MROWS) / C.NGW), row1 = (int)(((long)(C.gw + 1) * MROWS) / C.NGW);
    f32x4 shr[4], scr_[4], xn[4]; int cmi = -1;
    if (row0 < row1) {
#pragma unroll
        for (int j = 0; j < 4; ++j) xn[j] = *(const f32x4*)(MODH_SRC(row0) + 4 * C.lane + 256 * j); }
#pragma unroll
    for (int j = 0; j < 4; ++j) { shr[j] = (f32x4){0.f, 0.f, 0.f, 0.f}; scr_[j] = shr[j]; }
    for (int row = row0; row < row1; ++row) {
        const int mi = row_mi(row);
        if (mi != cmi) { cmi = mi; const float* md = MOD + mi * 6144;
#pragma unroll
            for (int j = 0; j < 4; ++j) { const int col = 4 * C.lane + 256 * j; shr[j] = *(const f32x4*)(md + col); scr_[j] = *(const f32x4*)(md + DM + col) + 1.f; } }
        f32x4 x[4];
#pragma unroll
        for (int j = 0; j < 4; ++j) x[j] = xn[j];
        if (row + 1 < row1) {
#pragma unroll
            for (int j = 0; j < 4; ++j) xn[j] = *(const f32x4*)(MODH_SRC(row + 1) + 4 * C.lane + 256 * j); }
#pragma unroll
        for (int j = 0; j < 4; ++j) { const int col = 4 * C.lane + 256 * j; const f32x4 h = x[j] * scr_[j] + shr[j]; u32x2 o; o.x = pk2(h[0], h[1]); o.y = pk2(h[2], h[3]); *(u32x2*)(H + (size_t)row * DM + col) = o; }
    }
}

__device__ __forceinline__ f32x4 ld4bf(const bf16_t* p) { const u32x2 u = *(const u32x2*)p; return (f32x4){bflo(u.x), bfhi(u.x), bflo(u.y), bfhi(u.y)}; }
__device__ __forceinline__ void st4bf(bf16_t* p, f32x4 v) { u32x2 o; o.x = pk2(v[0], v[1]); o.y = pk2(v[2], v[3]); *(u32x2*)p = o; }
__device__ __forceinline__ void seq_info(int row, bool& hasp, bool& hasn) {
    if (row < NLAT) { const int t = row & (TT - 1); hasp = t > 0; hasn = t < TT - 1; }
    else { const int t = (row - NLAT) & (CTXL - 1); hasp = t > 0; hasn = t < CTXL - 1; }
}
struct Ef1Row { u32x2 bg, ua, ub, m[11]; };
__device__ __forceinline__ f32x4 bf4(u32x2 u) { return (f32x4){bflo(u.x), bfhi(u.x), bflo(u.y), bfhi(u.y)}; }
__device__ __forceinline__ void ef1_load(Ef1Row& R, const bf16_t* P, int row, int lane) {
    row = row < 0 ? 0 : row > MROWS - 1 ? MROWS - 1 : row;
    const bf16_t* p = P + (size_t)row * P_LD + 4 * lane;
    R.bg = *(const u32x2*)p; R.ua = *(const u32x2*)(p + 256); R.ub = *(const u32x2*)(p + 512);
#pragma unroll
    for (int it = 0; it < 11; ++it) R.m[it] = *(const u32x2*)(p + 768 + it * 256);
}
__device__ __forceinline__ void phase_ef1(const Ctx& C, const Args& A, int l) {
    const int i2 = l >> 1; unsigned char* ws = A.ws;
    const bf16_t* P = (const bf16_t*)(ws + WS_P); bf16_t* A2 = (bf16_t*)(ws + WS_A2); unsigned char* SCN = ws + WS_SCN; bf16_t* LIN = (bf16_t*)(ws + WS_LIN);
    const float* cw = A.in[I_CONVW] + (size_t)i2 * 3 * 256; const float* mu = A.in[I_MU] + (size_t)i2 * RWKV_COLS; const float* kxi = A.in[I_KXI] + (size_t)i2 * 768;
    const int j4 = 4 * C.lane;
    const f32x4 w0 = *(const f32x4*)(cw + j4), w1 = *(const f32x4*)(cw + 256 + j4), w2 = *(const f32x4*)(cw + 512 + j4);
    f32x4 mur[11], kxr[3];
#pragma unroll
    for (int it = 0; it < 11; ++it) mur[it] = (it * 256 + j4 < RWKV_COLS) ? *(const f32x4*)(mu + it * 256 + j4) : (f32x4){0.f, 0.f, 0.f, 0.f};
#pragma unroll
    for (int it = 0; it < 3; ++it) kxr[it] = *(const f32x4*)(kxi + it * 256 + j4);
    const int row0 = (int)(((long)C.gw * MROWS) / C.NGW), row1 = (int)(((long)(C.gw + 1) * MROWS) / C.NGW);
    Ef1Row Ra, Rb, Rc, Rd;
    ef1_load(Ra, P, row0 - 1, C.lane); ef1_load(Rb, P, row0, C.lane); ef1_load(Rc, P, row0 + 1, C.lane);
    for (int row = row0; row < row1; ++row) {
        ef1_load(Rd, P, row + 2, C.lane);
        bool hasp, hasn; seq_info(row, hasp, hasn);
        const float fp = hasp ? 1.f : 0.f, fn = hasn ? 1.f : 0.f;
        {
            const f32x4 bg = bf4(Rb.bg), u0 = bf4(Rb.ua) * bf4(Rb.ub), um = bf4(Ra.ua) * bf4(Ra.ub) * fp, up = bf4(Rc.ua) * bf4(Rc.ub) * fn;
            st4bf(A2 + (size_t)row * DM + j4, bg * (w0 * um + w1 * u0 + w2 * up));
        }
#pragma unroll
        for (int it = 0; it < 11; ++it) {
            const int c = it * 256 + j4;
            if (c < RWKV_COLS) {
                const f32x4 x0 = bf4(Rb.m[it]), xm = bf4(Ra.m[it]) * fp, xp = bf4(Rc.m[it]) * fn, m4 = mur[it];
                const f32x4 ps = x0 + m4 * ((xm + xp) * 0.5f - x0);
                if (it < 3) { const int head = c >> 6, kx = c & 63; st4bf_(SCN + (size_t)(row * 12 + head) * SC_REC + SC_R + kx * 2, ps); }
                else if (it < 6) { const int c1 = c - 768, head = c1 >> 6, kx = c1 & 63; const f32x4 kv = ps * kxr[it < 6 ? (it >= 3 ? it - 3 : 0) : 0];
                    const float ss = sum16(kv[0] * kv[0] + kv[1] * kv[1] + kv[2] * kv[2] + kv[3] * kv[3]); const float rn = rsqrtf(ss + 1e-12f);
                    unsigned char* base = SCN + (size_t)(row * 12 + head) * SC_REC + kx * 2;
                    st4bf_(base + SC_KK, kv * rn); st4bf_(base + SC_KR, ps); st4bf_(base + SC_KR + 256, ps); }
                else if (it < 9) { const int c1 = c - 1536, head = c1 >> 6, kx = c1 & 63; st4bf_(SCN + (size_t)(row * 12 + head) * SC_REC + SC_V + kx * 2, ps); }
                else { const int c1 = c - 2304; f32x4 o;
                    if (c1 < 128) { o = (f32x4){tanh_fast(ps[0]), tanh_fast(ps[1]), tanh_fast(ps[2]), tanh_fast(ps[3])}; }
                    else if (c1 < 256) { o = ps; }
                    else { o = (f32x4){sigmoidf_(ps[0]), sigmoidf_(ps[1]), sigmoidf_(ps[2]), sigmoidf_(ps[3])}; }
                    st4bf(LIN + (size_t)row * LORA_K + c1, o); }
            }
        }
        Ra = Rb; Rb = Rc; Rc = Rd;
    }
}

__device__ __forceinline__ int scan_row(int i, int b, int d) {
    if (d == 0) return i < CTXL ? NLAT + b * CTXL + i : b * TT + (i - CTXL);
    return i < CTXL ? NLAT + b * CTXL + (CTXL - 1 - i) : b * TT + (TT - 1 - (i - CTXL));
}
__device__ __forceinline__ float red8(float v) {
    v += __uint_as_float((unsigned)__builtin_amdgcn_update_dpp(0, (int)__float_as_uint(v), 0xB1, 0xF, 0xF, true));
    v += __uint_as_float((unsigned)__builtin_amdgcn_update_dpp(0, (int)__float_as_uint(v), 0x4E, 0xF, 0xF, true));
    v += __uint_as_float((unsigned)__builtin_amdgcn_update_dpp(0, (int)__float_as_uint(v), 0x141, 0xF, 0xF, true));
    return v;
}
__device__ __forceinline__ float red16(float v) {
    v += __uint_as_float((unsigned)__builtin_amdgcn_update_dpp(0, (int)__float_as_uint(v), 0xB1, 0xF, 0xF, true));
    v += __uint_as_float((unsigned)__builtin_amdgcn_update_dpp(0, (int)__float_as_uint(v), 0x4E, 0xF, 0xF, true));
    v += __uint_as_float((unsigned)__builtin_amdgcn_update_dpp(0, (int)__float_as_uint(v), 0x141, 0xF, 0xF, true));
    v += __uint_as_float((unsigned)__builtin_amdgcn_update_dpp(0, (int)__float_as_uint(v), 0x140, 0xF, 0xF, true));
    return v;
}
__device__ __forceinline__ void phase_scan(const Ctx& C, const Args& A) {
    for (int u = blockIdx.x; u < 192; u += C.G) {
    const int half = u & 1, d = (u >> 1) & 1, h = (u >> 2) % 12, b = u / 48;
    const unsigned char* SCN = A.ws + WS_SCN; float* Y = (float*)(A.ws + WS_Y) + (size_t)d * MROWS * 768;
    LAS float* buf = (LAS float*)C.lds; LAS float* ybuf = buf + 2 * 32 * 352;
    constexpr int NCH = LKEYS / 32;
    u32x4 st[4];
    int ps_[4], psrc[4], pdst[4]; bool pf32[4];
#pragma unroll
    for (int j = 0; j < 4; ++j) { const int p = C.tid + NTHR * j; const int s = p / 52, q = p % 52; ps_[j] = s;
        if (q < 16) { psrc[j] = SC_W + 256 * d + q * 16; pdst[j] = s * 352 + q * 4; pf32[j] = true; }
        else if (q < 48) { const int vec = (q - 16) >> 3, part = (q - 16) & 7; const int so = vec == 0 ? SC_KK : vec == 1 ? SC_B + 256 * d : vec == 2 ? SC_KR + 256 * d : SC_R;
            psrc[j] = so + part * 16; pdst[j] = s * 352 + 64 * (vec + 1) + part * 8; pf32[j] = false; }
        else { const int part = q - 48; psrc[j] = SC_V + half * 64 + part * 16; pdst[j] = s * 352 + 320 + part * 8; pf32[j] = false; } }
    const int sgn = d ? -1 : 1;
    const unsigned char* SCNh = SCN + (size_t)h * SC_REC;
#define SCAN_ROW0(c) (((c) * 32 < CTXL) ? (NLAT + b * CTXL + (d ? CTXL - 1 - (c) * 32 : (c) * 32)) : (b * TT + (d ? TT - 1 - ((c) * 32 - CTXL) : (c) * 32 - CTXL)))
#define SCAN_LOADG(c) do { const int row0_ = SCAN_ROW0(c); _Pragma("unroll") for (int j = 0; j < 4; ++j) if (j < 3 || C.tid < 1664 - 3 * NTHR) { \
        st[j] = *(const u32x4*)(SCNh + (size_t)(row0_ + sgn * ps_[j]) * SC_ROW + psrc[j]); } } while (0)
#define SCAN_STORE(bi) do { _Pragma("unroll") for (int j = 0; j < 4; ++j) if (j < 3 || C.tid < 1664 - 3 * NTHR) { LAS float* dp = buf + (bi) * (32 * 352) + pdst[j]; \
        if (pf32[j]) *(LAS u32x4*)dp = st[j]; \
        else { *(LAS f32x4*)dp = (f32x4){bflo(st[j].x), bfhi(st[j].x), bflo(st[j].y), bfhi(st[j].y)}; *(LAS f32x4*)(dp + 4) = (f32x4){bflo(st[j].z), bfhi(st[j].z), bflo(st[j].w), bfhi(st[j].w)}; } } } while (0)
    SCAN_LOADG(0); SCAN_STORE(0); __syncthreads();
    f32x2 Sa = {0.f, 0.f}, Sb = {0.f, 0.f};
    const int rl = C.lane >> 4, ks = C.lane & 15;
    float ycol = 0.f;
#define SC_LD(R, s) do { const LAS float* bp_ = cur + (s) * 352 + ks * 4; \
        R##w = *(const LAS f32x4*)(bp_); R##k = *(const LAS f32x4*)(bp_ + 64); R##b = *(const LAS f32x4*)(bp_ + 128); R##q = *(const LAS f32x4*)(bp_ + 192); R##r = *(const LAS f32x4*)(bp_ + 256); \
        R##vv = cur[(s) * 352 + 320 + C.wave * 4 + rl]; } while (0)
#define SC_LO(v) ((f32x2){v[0], v[1]})
#define SC_HI(v) ((f32x2){v[2], v[3]})
#define SC_DPP(x, ctrl) __uint_as_float((unsigned)__builtin_amdgcn_update_dpp(0, (int)__float_as_uint(x), ctrl, 0xF, 0xF, true))
#define SC_STEP(R, P, s) do { \
        f32x2 pa = __builtin_elementwise_fma(Sb, SC_HI(R##k), Sa * SC_LO(R##k)), py = __builtin_elementwise_fma(Sb, SC_HI(P##r), Sa * SC_LO(P##r)); \
        float a_ = pa.x + pa.y, y_ = py.x + py.y; \
        a_ += SC_DPP(a_, 0xB1); y_ += SC_DPP(y_, 0xB1); a_ += SC_DPP(a_, 0x4E); y_ += SC_DPP(y_, 0x4E); \
        a_ += SC_DPP(a_, 0x141); y_ += SC_DPP(y_, 0x141); a_ += SC_DPP(a_, 0x140); y_ += SC_DPP(y_, 0x140); \
        ycol = (ks == ((s) & 15)) ? y_ : ycol; \
        const f32x2 na = {-a_, -a_}, vv2 = {R##vv, R##vv}; \
        Sa = __builtin_elementwise_fma(Sa, SC_LO(R##w), __builtin_elementwise_fma(na, SC_LO(R##b), vv2 * SC_LO(R##q))); \
        Sb = __builtin_elementwise_fma(Sb, SC_HI(R##w), __builtin_elementwise_fma(na, SC_HI(R##b), vv2 * SC_HI(R##q))); } while (0)
    f32x4 Aw, Ak, Ab, Aq, Ar, Bw, Bk, Bb, Bq, Br, Cw, Ck, Cb, Cq, Cr, Dw, Dk, Db, Dq, Dr; float Avv, Bvv, Cvv, Dvv;
    Dr = (f32x4){0.f, 0.f, 0.f, 0.f};
    for (int c = 0; c < NCH; ++c) {
        if (c + 1 < NCH) SCAN_LOADG(c + 1);
        {
            const LAS float* cur = buf + (c & 1) * (32 * 352);
            LAS float* yb = ybuf + (c & 1) * 1024 + C.wave * 4 + rl + ks * 32;
            SC_LD(A, 0); SC_LD(B, 1);
#pragma unroll 1
            for (int s = 0; s < 32; s += 4) {
                SC_LD(C, s + 2); __builtin_amdgcn_sched_barrier(0); SC_STEP(A, D, s); __builtin_amdgcn_sched_barrier(0);
                SC_LD(D, s + 3); __builtin_amdgcn_sched_barrier(0); SC_STEP(B, A, s + 1); __builtin_amdgcn_sched_barrier(0);
                SC_LD(A, s + 4); __builtin_amdgcn_sched_barrier(0); SC_STEP(C, B, s + 2); __builtin_amdgcn_sched_barrier(0);
                SC_LD(B, s + 5); __builtin_amdgcn_sched_barrier(0); SC_STEP(D, C, s + 3); __builtin_amdgcn_sched_barrier(0);
                if ((s & 15) == 12) yb[(s & 16) * 32] = ycol;
            }
        }
        if (c + 1 < NCH) SCAN_STORE((c + 1) & 1);
        __syncthreads();
        { const int row0_ = SCAN_ROW0(c);
#pragma unroll
          for (int i = 0; i < 2; ++i) { const int e = C.tid + NTHR * i, s = e >> 5, r = e & 31;
            const int row = (s > 0) ? row0_ + sgn * (s - 1) : scan_row(c * 32 - 1, b, d);
            if (s > 0 || c > 0) Y[(size_t)row * 768 + h * 64 + half * 32 + r] = ybuf[(c & 1) * 1024 + e]; } }
    }
    {
        f32x2 py = __builtin_elementwise_fma(Sb, SC_HI(Dr), Sa * SC_LO(Dr)); float y_ = py.x + py.y;
        y_ += SC_DPP(y_, 0xB1); y_ += SC_DPP(y_, 0x4E); y_ += SC_DPP(y_, 0x141); y_ += SC_DPP(y_, 0x140);
        if (ks == 0) Y[(size_t)scan_row(LKEYS - 1, b, d) * 768 + h * 64 + half * 32 + C.wave * 4 + rl] = y_;
    }
    __syncthreads();
    }
#undef SCAN_LOADG
#undef SCAN_STORE
#undef SCAN_ROW0
#undef SC_LD
#undef SC_STEP
#undef SC_LO
#undef SC_HI
#undef SC_DPP
}

constexpr int CSP = 72;
constexpr int CS_MAT = 64 * CSP * 2;
constexpr int CS_WT = 0, CS_KB = CS_MAT, CS_BB = 2 * CS_MAT, CS_RT = 3 * CS_MAT, CS_BHT = 4 * CS_MAT, CS_KHT = 5 * CS_MAT, CS_VMT = 6 * CS_MAT;
constexpr int CS_M2F = 7 * CS_MAT;
constexpr int CS_M1T = CS_M2F + 16384;
constexpr int CS_N2 = CS_M1T + CS_MAT;
constexpr int CS_GT = CS_N2 + CS_MAT;
constexpr int CS_Z = CS_M2F, CS_U = CS_M2F + CS_MAT;
constexpr int CS_GL = CS_GT + 2 * CS_MAT;
static_assert(CS_GL + 256 <= LDS_MISC, "chunked-scan LDS map");
template <bool SWZB = false>
__device__ __forceinline__ void cs_mma(f32x16& acc, const LAS unsigned char* Am, const LAS unsigned char* Bm, int ti, int tj, int r32, int hi) {
    const LAS unsigned char* ap = Am + (ti * 32 + r32) * (CSP * 2) + hi * 16; const int brow = tj * 32 + r32; const LAS unsigned char* bp = Bm + brow * (CSP * 2);
    const int sw = SWZB ? ((brow >> 3) & 7) : 0;
#pragma unroll
    for (int ks = 0; ks < 4; ++ks) acc = __builtin_amdgcn_mfma_f32_32x32x16_bf16(*(const LAS bf16x8*)(ap + ks * 32), *(const LAS bf16x8*)(bp + (((ks * 2 + hi) ^ sw) * 16)), acc, 0, 0, 0);
}
__device__ __forceinline__ void cs_store_t(LAS unsigned char* Om, const f32x16& acc, int ti, int tj, int r32, int hi) {
    LAS unsigned char* op = Om + (tj * 32 + r32) * (CSP * 2) + (ti * 32 + 4 * hi) * 2;
#pragma unroll
    for (int g = 0; g < 4; ++g) { u32x2 o; o.x = pk2(acc[4 * g], acc[4 * g + 1]); o.y = pk2(acc[4 * g + 2], acc[4 * g + 3]); *(LAS u32x2*)(op + g * 16) = o; }
}
#define CS_BAR() asm volatile("s_waitcnt lgkmcnt(0)\n\ts_barrier" ::: "memory")
__device__ __forceinline__ void phase_csa(const Ctx& C, const Args& A) {
    const unsigned char* SCN = A.ws + WS_SCN; unsigned char* CHK = A.ws + WS_CHK;
    LAS unsigned char* L = C.lds;
    const int r32 = C.lane & 31, hi = C.lane >> 5;
    float lwv[8]; u32x4 ukk, ub, ukr, ur, uv;
#define CSA_GEOM(cu_) const int unit = (cu_) / CS_NCH, ch = (cu_) % CS_NCH; const int d = unit & 1, h = (unit >> 1) % 12, b = unit / 24; \
        const int step0 = ch * CS_L; const int sgn = d ? -1 : 1; \
        const int row0 = (step0 < CTXL) ? (NLAT + b * CTXL + (d ? CTXL - 1 - step0 : step0)) : (b * TT + (d ? TT - 1 - (step0 - CTXL) : step0 - CTXL)); \
        const unsigned char* rec0 = SCN + (size_t)row0 * SC_ROW + (size_t)h * SC_REC;
#define CSA_LOAD(cu_) do { CSA_GEOM(cu_); \
        { const int k = C.tid & 63, sg = C.tid >> 6; _Pragma("unroll") for (int j = 0; j < 8; ++j) lwv[j] = *(const float*)(rec0 + (long)sgn * (8 * sg + j) * SC_ROW + SC_W + 256 * d + k * 4); } \
        { const int t = C.tid >> 3, k0 = (C.tid & 7) * 8; const unsigned char* rp = rec0 + (long)sgn * t * SC_ROW; \
          ukk = *(const u32x4*)(rp + SC_KK + k0 * 2); ub = *(const u32x4*)(rp + SC_B + 256 * d + k0 * 2); ukr = *(const u32x4*)(rp + SC_KR + 256 * d + k0 * 2); ur = *(const u32x4*)(rp + SC_R + k0 * 2); uv = *(const u32x4*)(rp + SC_V + k0 * 2); } } while (0)
    if ((int)blockIdx.x < CS_UNITS * CS_NCH) CSA_LOAD((int)blockIdx.x);
    for (int cu = blockIdx.x; cu < CS_UNITS * CS_NCH; cu += C.G) {
        LAS float* csf = (LAS float*)(L + CS_M2F);
        LAS float* seg = (LAS float*)(L + CS_N2);
        { const int k = C.tid & 63, sg = C.tid >> 6;
#pragma unroll
          for (int j = 1; j < 8; ++j) lwv[j] += lwv[j - 1];
          seg[sg * 64 + k] = lwv[7];
          CS_BAR();
          float off = 0.f, tot = 0.f;
#pragma unroll
          for (int s2 = 0; s2 < 8; ++s2) { const float v = seg[s2 * 64 + k]; off += (s2 < sg) ? v : 0.f; tot += v; }
#pragma unroll
          for (int j = 0; j < 8; ++j) csf[(8 * sg + j) * 65 + k] = lwv[j] + off;
          if (sg == 7) ((LAS float*)(L + CS_GL))[k] = __expf(tot); }
        CS_BAR();
        { const int t = C.tid >> 3, k0 = (C.tid & 7) * 8;
          float wt[8], kb[8], bb[8], rt[8], bh[8], kh[8];
#pragma unroll
          for (int j = 0; j < 8; ++j) { const unsigned pkk = j < 2 ? ukk.x : j < 4 ? ukk.y : j < 6 ? ukk.z : ukk.w, pb = j < 2 ? ub.x : j < 4 ? ub.y : j < 6 ? ub.z : ub.w, pkr = j < 2 ? ukr.x : j < 4 ? ukr.y : j < 6 ? ukr.z : ukr.w, pr = j < 2 ? ur.x : j < 4 ? ur.y : j < 6 ? ur.z : ur.w;
              const float kkv = (j & 1) ? bfhi(pkk) : bflo(pkk), bv = (j & 1) ? bfhi(pb) : bflo(pb), krv = (j & 1) ? bfhi(pkr) : bflo(pkr), rv = (j & 1) ? bfhi(pr) : bflo(pr);
              const float cst = csf[t * 65 + k0 + j], csp = t > 0 ? csf[(t - 1) * 65 + k0 + j] : 0.f, csl = csf[63 * 65 + k0 + j];
              const float einv = __expf(-cst), el = __expf(csl - cst);
              wt[j] = kkv * __expf(csp); kb[j] = krv * einv; bb[j] = bv * einv; rt[j] = rv * __expf(cst); bh[j] = bv * el; kh[j] = krv * el; }
          u32x4 o;
          o.x = pk2(wt[0], wt[1]); o.y = pk2(wt[2], wt[3]); o.z = pk2(wt[4], wt[5]); o.w = pk2(wt[6], wt[7]); *(LAS u32x4*)(L + CS_WT + t * (CSP * 2) + k0 * 2) = o;
          o.x = pk2(kb[0], kb[1]); o.y = pk2(kb[2], kb[3]); o.z = pk2(kb[4], kb[5]); o.w = pk2(kb[6], kb[7]); *(LAS u32x4*)(L + CS_KB + t * (CSP * 2) + k0 * 2) = o;
          o.x = pk2(bb[0], bb[1]); o.y = pk2(bb[2], bb[3]); o.z = pk2(bb[4], bb[5]); o.w = pk2(bb[6], bb[7]); *(LAS u32x4*)(L + CS_BB + t * (CSP * 2) + k0 * 2) = o;
          o.x = pk2(rt[0], rt[1]); o.y = pk2(rt[2], rt[3]); o.z = pk2(rt[4], rt[5]); o.w = pk2(rt[6], rt[7]); *(LAS u32x4*)(L + CS_RT + t * (CSP * 2) + k0 * 2) = o;
#pragma unroll
          for (int j = 0; j < 8; ++j) { const int to = ((((t >> 3) ^ ((k0 >> 3) & 7)) * 8) + (t & 7)) * 2;
              *(LAS bf16_t*)(L + CS_BHT + (k0 + j) * (CSP * 2) + to) = (bf16_t)f2bf(bh[j]); *(LAS bf16_t*)(L + CS_KHT + (k0 + j) * (CSP * 2) + to) = (bf16_t)f2bf(kh[j]);
              const unsigned pv = j < 2 ? uv.x : j < 4 ? uv.y : j < 6 ? uv.z : uv.w; *(LAS bf16_t*)(L + CS_VMT + (k0 + j) * (CSP * 2) + to) = (bf16_t)((j & 1) ? (pv >> 16) : (pv & 0xffffu)); } }
        if (cu + C.G < CS_UNITS * CS_NCH) CSA_LOAD(cu + C.G);
        CS_BAR();
        for (int job = C.wave; job < 12; job += NWAVES) { const int p = job >> 2, ti = (job >> 1) & 1, tj = job & 1;
            f32x16 acc;
#pragma unroll
            for (int i = 0; i < 16; ++i) acc[i] = 0.f;
            if (p == 0) { cs_mma(acc, L + CS_WT, L + CS_BB, ti, tj, r32, hi);
                const int i = tj * 32 + r32; LAS float* mp = (LAS float*)(L + CS_M2F) + i * 64;
#pragma unroll
                for (int reg = 0; reg < 16; ++reg) { const int t = ti * 32 + crow(reg, hi); mp[(t & 3) * 16 + (t >> 2)] = (i < t) ? acc[reg] : 0.f; } }
            else if (p == 1) { cs_mma(acc, L + CS_WT, L + CS_KB, ti, tj, r32, hi);
                const int i = tj * 32 + r32;
#pragma unroll
                for (int reg = 0; reg < 16; ++reg) { const int t = ti * 32 + crow(reg, hi); acc[reg] = (i < t) ? acc[reg] : 0.f; }
                cs_store_t(L + CS_M1T, acc, ti, tj, r32, hi); }
            else { cs_mma(acc, L + CS_BB, L + CS_RT, ti, tj, r32, hi);
                const int t = tj * 32 + r32;
#pragma unroll
                for (int reg = 0; reg < 16; ++reg) { const int i = ti * 32 + crow(reg, hi); acc[reg] = (i <= t) ? acc[reg] : 0.f; }
                cs_store_t(L + CS_N2, acc, ti, tj, r32, hi); } }
        CS_BAR();
        { const int c = C.tid >> 2, q = C.tid & 3; f32x2 acc2[8];
          { const LAS unsigned char* rcol = (c < 64) ? (L + CS_WT + c * 2) : (L + CS_M1T + (c - 64) * (CSP * 2)); const int rstride = (c < 64) ? CSP * 2 : 2;
#pragma unroll
            for (int j = 0; j < 16; ++j) acc2[j >> 1][j & 1] = bf2f(*(const LAS bf16_t*)(rcol + (4 * j + q) * rstride)); }
          const LAS float* m2c = (const LAS float*)(L + CS_M2F) + q * 16;
#pragma clang loop unroll(full)
          for (int i = 0; i < 64; ++i) {
              const float mine = -acc2[i >> 3][(i >> 2) & 1];
              float gi;
              switch (i & 3) { case 0: gi = __uint_as_float((unsigned)__builtin_amdgcn_update_dpp(0, (int)__float_as_uint(mine), 0x00, 0xF, 0xF, true)); break;
                               case 1: gi = __uint_as_float((unsigned)__builtin_amdgcn_update_dpp(0, (int)__float_as_uint(mine), 0x55, 0xF, 0xF, true)); break;
                               case 2: gi = __uint_as_float((unsigned)__builtin_amdgcn_update_dpp(0, (int)__float_as_uint(mine), 0xAA, 0xF, 0xF, true)); break;
                               default: gi = __uint_as_float((unsigned)__builtin_amdgcn_update_dpp(0, (int)__float_as_uint(mine), 0xFF, 0xF, 0xF, true)); break; }
              const f32x2 g2 = {gi, gi};
#pragma unroll
              for (int j4 = (i >> 4); j4 < 4; ++j4) { const f32x4 m = *(const LAS f32x4*)(m2c + i * 64 + j4 * 4);
#pragma unroll
                  for (int h = 0; h < 2; ++h) { const int p = 2 * j4 + h;
                      if (2 * p >= (i >> 2)) acc2[p] += (f32x2){m[2 * h], m[2 * h + 1]} * g2;
                      else if (2 * p + 1 >= (i >> 2)) acc2[p][1] += m[2 * h + 1] * gi; } }
          }
#pragma unroll
          for (int j = 0; j < 16; ++j) *(LAS bf16_t*)(L + CS_GT + c * (CSP * 2) + (4 * j + q) * 2) = (bf16_t)f2bf(-acc2[j >> 1][j & 1]); }
        CS_BAR();
        unsigned char* outp = CHK + (size_t)cu * 32768;
        for (int job = C.wave; job < 16; job += NWAVES) { const int p = job >> 2, ti = (job >> 1) & 1, tj = job & 1;
            f32x16 acc;
            if (p == 0) {
                const LAS unsigned char* rp = L + CS_RT + (tj * 32 + r32) * (CSP * 2) + (ti * 32 + 4 * hi) * 2;
#pragma unroll
                for (int g = 0; g < 4; ++g) { const u32x2 u = *(const LAS u32x2*)(rp + g * 16); acc[4 * g] = bflo(u.x); acc[4 * g + 1] = bfhi(u.x); acc[4 * g + 2] = bflo(u.y); acc[4 * g + 3] = bfhi(u.y); }
                cs_mma(acc, L + CS_GT, L + CS_N2, ti, tj, r32, hi);
#pragma unroll
                for (int g = 0; g < 4; ++g) { u32x2 o; o.x = pk2(acc[4 * g], acc[4 * g + 1]); o.y = pk2(acc[4 * g + 2], acc[4 * g + 3]);
                    *(u32x2*)(outp + 8192 + (((tj * 4 + 2 * ti + (g >> 1)) * 64 + (g & 1) * 32 + r32) * 16) + hi * 8) = o; } }
            else if (p == 1) {
#pragma unroll
                for (int i = 0; i < 16; ++i) acc[i] = 0.f;
                cs_mma(acc, L + CS_KB, L + CS_RT, ti, tj, r32, hi);
                const int t = tj * 32 + r32;
#pragma unroll
                for (int reg = 0; reg < 16; ++reg) { const int i = ti * 32 + crow(reg, hi); acc[reg] = (i <= t) ? acc[reg] : 0.f; }
                cs_mma(acc, L + CS_GT + 64 * (CSP * 2), L + CS_N2, ti, tj, r32, hi);
                cs_store_t(L + CS_Z, acc, ti, tj, r32, hi); }
            else if (p == 2) {
#pragma unroll
                for (int i = 0; i < 16; ++i) acc[i] = 0.f;
                cs_mma<true>(acc, L + CS_GT, L + CS_BHT, ti, tj, r32, hi);
                const int k = tj * 32 + r32; const float gl = ((const LAS float*)(L + CS_GL))[k];
#pragma unroll
                for (int reg = 0; reg < 16; ++reg) { const int cc = ti * 32 + crow(reg, hi); acc[reg] += (cc == k) ? gl : 0.f; }
#pragma unroll
                for (int g = 0; g < 4; ++g) { u32x2 o; o.x = pk2(acc[4 * g], acc[4 * g + 1]); o.y = pk2(acc[4 * g + 2], acc[4 * g + 3]);
                    *(u32x2*)(outp + (((tj * 4 + 2 * ti + (g >> 1)) * 64 + (g & 1) * 32 + r32) * 16) + hi * 8) = o; } }
            else {
                const int krow = tj * 32 + r32; const LAS unsigned char* kp = L + CS_KHT + krow * (CSP * 2) + hi * 8;
#pragma unroll
                for (int g = 0; g < 4; ++g) { const u32x2 u = *(const LAS u32x2*)(kp + (((ti * 4 + g) ^ ((krow >> 3) & 7)) * 16)); acc[4 * g] = bflo(u.x); acc[4 * g + 1] = bfhi(u.x); acc[4 * g + 2] = bflo(u.y); acc[4 * g + 3] = bfhi(u.y); }
                cs_mma<true>(acc, L + CS_GT + 64 * (CSP * 2), L + CS_BHT, ti, tj, r32, hi);
                cs_store_t(L + CS_U, acc, ti, tj, r32, hi); } }
        CS_BAR();
        { const int p = C.wave >> 2, ti = (C.wave >> 1) & 1, tj = C.wave & 1;
          f32x16 acc;
#pragma unroll
          for (int i = 0; i < 16; ++i) acc[i] = 0.f;
          cs_mma<true>(acc, L + (p ? CS_U : CS_Z), L + CS_VMT, ti, tj, r32, hi);
          unsigned char* op = outp + (p ? 16384 : 24576) + ((ti * 2 + tj) * 64 + C.lane) * 32;
          u32x4 o0, o1; o0.x = pk2(acc[0], acc[1]); o0.y = pk2(acc[2], acc[3]); o0.z = pk2(acc[4], acc[5]); o0.w = pk2(acc[6], acc[7]);
          o1.x = pk2(acc[8], acc[9]); o1.y = pk2(acc[10], acc[11]); o1.z = pk2(acc[12], acc[13]); o1.w = pk2(acc[14], acc[15]);
          *(u32x4*)op = o0; *(u32x4*)(op + 16) = o1; }
        CS_BAR();
    }
}
__device__ __forceinline__ void phase_csb(const Ctx& C, const Args& A, int l) {
    if ((int)blockIdx.x >= CS_UNITS) { const int gwf = ((int)blockIdx.x - CS_UNITS) * NWAVES + C.wave, ngwf = (C.G - CS_UNITS) * NWAVES;
        conv_items(C, A, l + 1, gwf, ngwf, true, false, false); conv_items(C, A, l + 1, gwf, ngwf, false, false, true, XW_TK_HI); return; }
    const unsigned char* CHK = A.ws + WS_CHK;
    LAS unsigned char* L = C.lds;
    const int r32 = C.lane & 31, hi = C.lane >> 5;
    const bool isS = C.wave < 4; const int ti = (C.wave >> 1) & 1, tj = C.wave & 1;
    for (int unit = blockIdx.x; unit < CS_UNITS; unit += C.G) {
        const int d = unit & 1, h = (unit >> 1) % 12, b = unit / 24;
        float* Y = (float*)(A.ws + WS_Y) + (size_t)d * MROWS * 768;
        for (int i = C.tid; i < 2 * CS_MAT / 4; i += NTHR) ((LAS unsigned*)L)[i] = 0u;
        CS_BAR();
        bf16x8 afA[4], afB[4], afC[4]; u32x4 cA0, cA1, cB0, cB1, cC0, cC1;
#define CSB_LOAD(A4, C0, C1, ch_) do { const unsigned char* op_ = CHK + ((size_t)unit * CS_NCH + (ch_)) * 32768; \
            const unsigned char* am_ = op_ + (isS ? 0 : 8192) + (ti * 4 * 64 + C.lane) * 16;     \
            _Pragma("unroll") for (int ks = 0; ks < 4; ++ks) A4[ks] = *(const bf16x8*)(am_ + ks * 1024); \
            const unsigned char* cp_ = op_ + (isS ? 16384 : 24576) + ((ti * 2 + tj) * 64 + C.lane) * 32; C0 = *(const u32x4*)cp_; C1 = *(const u32x4*)(cp_ + 16); } while (0)
#define CSB_STEP(A4, C0, C1, ch_) do { \
            const LAS unsigned char* Sb = L + ((ch_) & 1) * CS_MAT; LAS unsigned char* Sn = L + (((ch_) + 1) & 1) * CS_MAT; \
            f32x16 acc; \
            acc[0] = bflo(C0.x); acc[1] = bfhi(C0.x); acc[2] = bflo(C0.y); acc[3] = bfhi(C0.y); acc[4] = bflo(C0.z); acc[5] = bfhi(C0.z); acc[6] = bflo(C0.w); acc[7] = bfhi(C0.w); \
            acc[8] = bflo(C1.x); acc[9] = bfhi(C1.x); acc[10] = bflo(C1.y); acc[11] = bfhi(C1.y); acc[12] = bflo(C1.z); acc[13] = bfhi(C1.z); acc[14] = bflo(C1.w); acc[15] = bfhi(C1.w); \
            const LAS unsigned char* bp = Sb + (tj * 32 + r32) * (CSP * 2) + hi * 16; \
            _Pragma("unroll") for (int ks = 0; ks < 4; ++ks) acc = __builtin_amdgcn_mfma_f32_32x32x16_bf16(A4[ks], *(const LAS bf16x8*)(bp + ks * 32), acc, 0, 0, 0); \
            if (isS) { cs_store_t(Sn, acc, ti, tj, r32, hi); }     \
            else {     \
                const int step0 = (ch_) * CS_L; const int sgn = d ? -1 : 1; \
                const int row0 = (step0 < CTXL) ? (NLAT + b * CTXL + (d ? CTXL - 1 - step0 : step0)) : (b * TT + (d ? TT - 1 - (step0 - CTXL) : step0 - CTXL)); \
                float* yp = Y + (size_t)(row0 + sgn * (ti * 32 + 4 * hi)) * 768 + h * 64 + tj * 32 + r32; const long ys = (long)sgn * 768; \
                _Pragma("unroll") for (int reg = 0; reg < 16; ++reg) yp[ys * ((reg & 3) + 8 * (reg >> 2))] = acc[reg]; } \
            CS_BAR(); } while (0)
        CSB_LOAD(afA, cA0, cA1, 0); CSB_LOAD(afB, cB0, cB1, 1);
        static_assert(CS_NCH % 3 == 0, "chunk loop is unrolled by three");
        for (int ch = 0; ch < CS_NCH; ch += 3) {
            if (ch == 0) CSB_LOAD(afC, cC0, cC1, 2);
            CSB_STEP(afA, cA0, cA1, ch);     if (ch + 3 < CS_NCH) CSB_LOAD(afA, cA0, cA1, ch + 3);
            CSB_STEP(afB, cB0, cB1, ch + 1); if (ch + 4 < CS_NCH) CSB_LOAD(afB, cB0, cB1, ch + 4);
            CSB_STEP(afC, cC0, cC1, ch + 2); if (ch + 5 < CS_NCH) CSB_LOAD(afC, cC0, cC1, ch + 5);
        }
        CS_BAR();
    }
#undef CSB_LOAD
#undef CSB_STEP
}

#undef CS_BAR
struct Ef2Row { f32x4 y0[3], y1[3]; u32x2 r[3], v[3], k0[3], k1[3], g[3]; };
__device__ __forceinline__ void ef2_load(Ef2Row& R, const float* Y0, const float* Y1, const unsigned char* SCN, const bf16_t* G, int row, int lane) {
#pragma unroll
    for (int it = 0; it < 3; ++it) { const int c = it * 256 + 4 * lane, head = c >> 6, kx = c & 63;
        R.y0[it] = *(const f32x4*)(Y0 + (size_t)row * 768 + c); R.y1[it] = *(const f32x4*)(Y1 + (size_t)row * 768 + c);
        const unsigned char* base = SCN + (size_t)(row * 12 + head) * SC_REC + kx * 2;
        R.r[it] = *(const u32x2*)(base + SC_R); R.v[it] = *(const u32x2*)(base + SC_V); R.k0[it] = *(const u32x2*)(base + SC_KR); R.k1[it] = *(const u32x2*)(base + SC_KR + 256);
        R.g[it] = *(const u32x2*)(G + (size_t)row * 768 + c); }
}
__device__ __forceinline__ void phase_ef2(const Ctx& C, const Args& A, int l) {
    const int i2 = l >> 1; unsigned char* ws = A.ws;
    const unsigned char* SCN = ws + WS_SCN; const float* Y0 = (const float*)(ws + WS_Y); const float* Y1 = Y0 + (size_t)MROWS * 768;
    const bf16_t* G = (const bf16_t*)(ws + WS_G); bf16_t* A2 = (bf16_t*)(ws + WS_A2);
    const float* rb = A.in[I_RBON] + (size_t)i2 * 768; const float* gg = A.in[I_GNG] + (size_t)i2 * 768; const float* gb = A.in[I_GNB] + (size_t)i2 * 768;
    f32x4 rbr[3], ggr[3], gbr[3];
#pragma unroll
    for (int it = 0; it < 3; ++it) { const int c = it * 256 + 4 * C.lane; rbr[it] = *(const f32x4*)(rb + c); ggr[it] = *(const f32x4*)(gg + c); gbr[it] = *(const f32x4*)(gb + c); }
    Ef2Row Rn;
    if (C.gw < MROWS) ef2_load(Rn, Y0, Y1, SCN, G, C.gw, C.lane);
    for (int row = C.gw; row < MROWS; row += C.NGW) {
        const Ef2Row R = Rn;
        { const int nr = row + C.NGW < MROWS ? row + C.NGW : row; ef2_load(Rn, Y0, Y1, SCN, G, nr, C.lane); }
#pragma unroll
        for (int it = 0; it < 3; ++it) {
            const int c = it * 256 + 4 * C.lane;
            const f32x4 y = R.y0[it] + R.y1[it];
            const float mean = sum16((y[0] + y[1]) + (y[2] + y[3])) * (1.f / 64.f);
            const f32x4 dd = y - mean;
            const float var = sum16((dd[0] * dd[0] + dd[1] * dd[1]) + (dd[2] * dd[2] + dd[3] * dd[3])) * (1.f / 64.f);
            const float rstd = rsqrtf(var + GN_EPS);
            const f32x4 r = bf4(R.r[it]), v = bf4(R.v[it]), k0 = bf4(R.k0[it]), k1 = bf4(R.k1[it]);
            const f32x4 t = r * (k0 + k1) * 0.5f * rbr[it];
            const float bs = sum16((t[0] + t[1]) + (t[2] + t[3]));
            const f32x4 yn = dd * rstd * ggr[it] + gbr[it];
            const f32x4 g = bf4(R.g[it]);
            st4bf(A2 + (size_t)row * DM + 256 + c, g * (yn + v * bs));
        }
    }
}

__device__ __forceinline__ void phase_of1(const Ctx& C, const Args& A, int l) {
    const int i2 = l >> 1; unsigned char* ws = A.ws;
    const bf16_t* P = (const bf16_t*)(ws + WS_P); bf16_t* A2 = (bf16_t*)(ws + WS_A2); bf16_t* VT = (bf16_t*)(ws + WS_VT);
    const float* lng = A.in[I_GLNG] + (size_t)i2 * 256; const float* lnb = A.in[I_GLNB] + (size_t)i2 * 256;
    const float* gws = A.in[I_GWS] + (size_t)i2 * 4 * 128 * 128; const float* gbs = A.in[I_GBS] + (size_t)i2 * 4 * 128;
    LAS bf16_t* vt = (LAS bf16_t*)C.lds;
    LAS bf16_t* uL = (LAS bf16_t*)C.lds;
    LAS bf16_t* vT = (LAS bf16_t*)(C.lds + 128 * 528);
    const int r32 = C.lane & 31, hi = C.lane >> 5;
    for (int it = blockIdx.x; it < 256 + 8 * 7; it += C.G) {
        const bool isctx = it >= 256; const int uc = isctx ? (it - 256) / 7 : 0, pc = isctx ? (it - 256) % 7 : 0; const int u = it;
        const int b = isctx ? (uc >> 1) : (u >> 6), pos0 = isctx ? (uc & 1) * 128 : (u & 63) * 128;
        const int row0 = isctx ? NLAT + b * CTXL + pos0 : b * TT + pos0, L0 = isctx ? pos0 : CTXL + pos0;
        const int hh0 = isctx ? pc : 0, hh1 = isctx ? (pc < 6 ? pc + 1 : 0) : 6; const bool doC = !isctx || pc == 6;
        u32x4 pv[4];
        if (hh0 < hh1) {
#pragma unroll
            for (int i = 0; i < 4; ++i) { const int piece = C.tid + NTHR * i, r = piece >> 4, part = piece & 15; pv[i] = *(const u32x4*)(P + (size_t)(row0 + r) * P_LD + 1536 + hh0 * 128 + part * 8); } }
        for (int hh = hh0; hh < hh1; ++hh) {
#pragma unroll
            for (int i = 0; i < 4; ++i) { const int piece = C.tid + NTHR * i, r = piece >> 4, part = piece & 15;
                *(LAS u32x4*)(vt + r * 136 + part * 8) = pv[i]; }
            __syncthreads();
            if (hh + 1 < hh1) {
#pragma unroll
                for (int i = 0; i < 4; ++i) { const int piece = C.tid + NTHR * i, r = piece >> 4, part = piece & 15; pv[i] = *(const u32x4*)(P + (size_t)(row0 + r) * P_LD + 1536 + (hh + 1) * 128 + part * 8); } }
#pragma unroll
            for (int i = 0; i < 4; ++i) { const int item = C.tid + NTHR * i, d = item >> 4, tg = item & 15; const LAS bf16_t* s = vt + (tg * 8) * 136 + d;
                u32x4 o; o.x = (unsigned)s[0] | ((unsigned)s[136] << 16); o.y = (unsigned)s[2 * 136] | ((unsigned)s[3 * 136] << 16);
                o.z = (unsigned)s[4 * 136] | ((unsigned)s[5 * 136] << 16); o.w = (unsigned)s[6 * 136] | ((unsigned)s[7 * 136] << 16);
                *(u32x4*)(VT + ((size_t)(b * 6 + hh) * 128 + d) * LKEYS + L0 + tg * 8) = o; }
            __syncthreads();
        }
        if (doC) {
        const f32x4 lngr = *(const f32x4*)(lng + 4 * C.lane), lnbr = *(const f32x4*)(lnb + 4 * C.lane);
        u32x2 nxu, nxr;
        { const bf16_t* pr = P + (size_t)(row0 + C.wave) * P_LD + 2304 + 4 * C.lane; nxu = *(const u32x2*)pr; nxr = *(const u32x2*)(pr + 256); }
        for (int r = C.wave; r < 128; r += NWAVES) {
            const int c4 = 4 * C.lane;
            const f32x4 ur = bf4(nxu), raw = bf4(nxr);
            if (r + NWAVES < 128) { const bf16_t* pr = P + (size_t)(row0 + r + NWAVES) * P_LD + 2304 + c4; nxu = *(const u32x2*)pr; nxr = *(const u32x2*)(pr + 256); }
            { const f32x4 gu = gelu4(ur); u32x2 o; o.x = pk2(gu[0], gu[1]); o.y = pk2(gu[2], gu[3]); *(LAS u32x2*)(uL + r * 264 + c4) = o; }
            const f32x4 gv = gelu4(raw);
            const float mean = wave_sum((gv[0] + gv[1]) + (gv[2] + gv[3])) * (1.f / 256.f); const f32x4 dd = gv - mean;
            const float var = wave_sum((dd[0] * dd[0] + dd[1] * dd[1]) + (dd[2] * dd[2] + dd[3] * dd[3])) * (1.f / 256.f); const float rstd = rsqrtf(var + LN_EPS);
            const f32x4 o = dd * rstd * lngr + lnbr;
#pragma unroll
            for (int k = 0; k < 4; ++k) vT[(c4 + k) * 136 + r] = (bf16_t)f2bf(o[k]);
        }
        __syncthreads();
        {
            const int g = C.wave >> 1, cblk = C.wave & 1, cc = g * 64 + cblk * 32 + r32;
            for (int pblk = 0; pblk < 4; ++pblk) {
                f32x16 acc;
#pragma unroll
                for (int i = 0; i < 16; ++i) acc[i] = 0.f;
                const float* wrow = gws + ((size_t)g * 128 + pblk * 32 + r32) * 128 + 8 * hi;
#pragma unroll
                for (int ks = 0; ks < 8; ++ks) { const f32x4 w0 = *(const f32x4*)(wrow + ks * 16), w1 = *(const f32x4*)(wrow + ks * 16 + 4);
                    u32x4 au; au.x = pk2(w0[0], w0[1]); au.y = pk2(w0[2], w0[3]); au.z = pk2(w1[0], w1[1]); au.w = pk2(w1[2], w1[3]);
                    const bf16x8 bf = *(const LAS bf16x8*)(vT + cc * 136 + ks * 16 + 8 * hi);
                    acc = __builtin_amdgcn_mfma_f32_32x32x16_bf16(__builtin_bit_cast(bf16x8, au), bf, acc, 0, 0, 0); }
#pragma unroll
                for (int reg = 0; reg < 16; ++reg) { const int p = pblk * 32 + crow(reg, hi);
                    const float uu = bf2f(uL[p * 264 + cc]); const float mixed = acc[reg] + gbs[g * 128 + p];
                    uL[p * 264 + cc] = (bf16_t)f2bf(uu * mixed); }
            }
        }
        __syncthreads();
#pragma unroll
        for (int i = 0; i < 8; ++i) { const int piece = C.tid + NTHR * i, r = piece >> 5, part = piece & 31;
            *(u32x4*)(A2 + (size_t)(row0 + r) * DM + 768 + part * 8) = *(const LAS u32x4*)(uL + r * 264 + part * 8); }
        __syncthreads();
        }
    }
}

__device__ __forceinline__ void phase_attn(const Ctx& C, const Args& A, int l) {
    const int i2 = l >> 1; unsigned char* ws = A.ws;
    const bf16_t* Q = (const bf16_t*)(ws + WS_Q); const bf16_t* KA = (const bf16_t*)(ws + WS_KA); const bf16_t* VT = (const bf16_t*)(ws + WS_VT); bf16_t* A2 = (bf16_t*)(ws + WS_A2);
    const float lam_init = 0.8f - 0.6f * expf(-0.3f * (float)l);
    float s1 = 0.f, s2 = 0.f;
    for (int j = 0; j < 64; ++j) { s1 += A.in[I_LQ1][i2 * 64 + j] * A.in[I_LK1][i2 * 64 + j]; s2 += A.in[I_LQ2][i2 * 64 + j] * A.in[I_LK2][i2 * 64 + j]; }
    const float lam = expf(s1) - expf(s2) + lam_init;
    const float* subg = A.in[I_SUBG] + (size_t)i2 * 128;
    const int r32 = C.lane & 31, hi = C.lane >> 5, map = C.wave >> 2, qw = C.wave & 3;
    LAS unsigned char* Kt = C.lds; LAS unsigned char* Vt = C.lds + 2 * 16384; LAS float* xch = (LAS float*)C.lds;
    const int NU = 1536 + (l == 1 ? 48 : 0);
    for (int n = C.vcu; n < NU; n += C.G) {
        int bh, qt; bool isctx = false;
        if (n < 1536) { const int round = n >> 8, slot = n & 255; bh = (slot >> 5) * 3 + (round >> 1); qt = (round & 1) * 32 + (slot & 31); }
        else { isctx = true; bh = (n - 1536) >> 1; qt = (n - 1536) & 1; }
        const int b = bh / 6, h = bh % 6;
        const int qrow0 = isctx ? NLAT + b * CTXL + qt * 128 : b * TT + qt * 128;
        const int NT = isctx ? CTXL / 64 : LKEYS / 64;
        const bf16_t* Kb = KA + (size_t)b * LKEYS * 768 + h * 128;
        const bf16_t* Vb = VT + (size_t)(b * 6 + h) * 128 * LKEYS;
        bf16x8 qf[4];
        { const bf16_t* qp = Q + (size_t)(qrow0 + qw * 32 + r32) * 768 + h * 128 + map * 64 + 8 * hi;
#pragma unroll
          for (int ks = 0; ks < 4; ++ks) qf[ks] = *(const bf16x8*)(qp + ks * 16); }
        f32x16 O[4];
#pragma unroll
        for (int d = 0; d < 4; ++d)
#pragma unroll
            for (int i = 0; i < 16; ++i) O[d][i] = 0.f;
        float m = 0.f, lsum = 0.f;
        unsigned ksrc[2], vsrc[2];
#pragma unroll
        for (int i = 0; i < 2; ++i) { const int row = 4 * (2 * C.wave + i) + (C.lane >> 4), x = row & 15, pi = x < 4 ? x : x < 8 ? x + 4 : x < 12 ? x - 4 : x;
            ksrc[i] = (unsigned)(((row & ~15) + pi) * 768 + (((C.lane & 15) ^ x) * 8));
            const int d = 8 * (2 * C.wave + i) + (C.lane >> 3); vsrc[i] = (unsigned)(d * LKEYS + (((C.lane & 7) ^ ((d >> 1) & 7)) * 8)); }
#define AT_DMA_K(tt, slot) do { _Pragma("unroll") for (int i = 0; i < 2; ++i) __builtin_amdgcn_global_load_lds((const unsigned*)(Kb + (size_t)(tt) * 64 * 768 + ksrc[i]), (LAS unsigned*)(Kt + (slot) * 16384 + (2 * C.wave + i) * 1024), 16, 0, 0); } while (0)
#define AT_DMA_V(tt, slot) do { _Pragma("unroll") for (int i = 0; i < 2; ++i) __builtin_amdgcn_global_load_lds((const unsigned*)(Vb + (size_t)(tt) * 64 + vsrc[i]), (LAS unsigned*)(Vt + (slot) * 16384 + (2 * C.wave + i) * 1024), 16, 0, 0); } while (0)
#define AT_BAR() asm volatile("s_waitcnt vmcnt(0) lgkmcnt(0)\n\ts_barrier" ::: "memory")
#define AT_SB() __builtin_amdgcn_sched_barrier(0)
        const int ksw = r32 & 15, vsw = (r32 >> 1) & 7;
#define AT_QK(P0, P1, ks_) do { const float nm_ = -m; _Pragma("unroll") for (int i = 0; i < 16; ++i) { P0[i] = nm_; P1[i] = nm_; } \
            const LAS unsigned char* kbp_ = Kt + (ks_) * 16384 + r32 * 256; \
            _Pragma("unroll") for (int ks = 0; ks < 4; ++ks) { const int co_ = ((map * 8 + ks * 2 + hi) ^ ksw) * 16; \
                P0 = __builtin_amdgcn_mfma_f32_32x32x16_bf16(*(const LAS bf16x8*)(kbp_ + co_), qf[ks], P0, 0, 0, 0); P1 = __builtin_amdgcn_mfma_f32_32x32x16_bf16(*(const LAS bf16x8*)(kbp_ + 32 * 256 + co_), qf[ks], P1, 0, 0, 0); } } while (0)
#define AT_LDV(dst, vs_, d) do { _Pragma("unroll") for (int kst = 0; kst < 4; ++kst) dst[kst] = *(const LAS u32x4*)(Vt + (vs_) * 16384 + ((d) * 32 + r32) * 128 + (((kst * 2 + hi) ^ vsw) * 16)); } while (0)
#define AT_PV(src, d) do { _Pragma("unroll") for (int kst = 0; kst < 4; ++kst) O[d] = __builtin_amdgcn_mfma_f32_32x32x16_bf16(__builtin_bit_cast(bf16x8, src[kst]), pb[kst], O[d], 0, 0, 0); } while (0)
#define AT_SOFTPV(P0, P1, N0, N1, first, hasn, vs_) do { \
            asm volatile("s_nop 15\n\ts_nop 7" : "+v"(P0), "+v"(P1)); \
            float mx = max3f(P0[0], P0[1], P1[0]), mx2 = max3f(P0[2], P0[3], P1[1]); mx = max3f(mx, P1[2], P1[3]); \
            _Pragma("unroll") for (int i = 4; i < 16; i += 4) { mx = max3f(mx, P0[i], P0[i + 1]); mx2 = max3f(mx2, P0[i + 2], P0[i + 3]); mx = max3f(mx, P1[i], P1[i + 1]); mx2 = max3f(mx2, P1[i + 2], P1[i + 3]); } \
            mx = fmaxf(mx, mx2); \
            { auto rr = __builtin_amdgcn_permlane32_swap(__float_as_uint(mx), __float_as_uint(mx), false, false); mx = fmaxf(__uint_as_float(rr[0]), __uint_as_float(rr[1])); } \
            if ((first) || __any(mx > 8.f)) { const float dl = (first) ? mx : fmaxf(mx, 0.f); const float sc = __builtin_amdgcn_exp2f(-dl); lsum *= sc; \
                _Pragma("unroll") for (int d = 0; d < 4; ++d) _Pragma("unroll") for (int i = 0; i < 16; ++i) O[d][i] *= sc; \
                _Pragma("unroll") for (int i = 0; i < 16; ++i) { P0[i] -= dl; P1[i] -= dl; } \
                if (hasn) { asm volatile("s_nop 15\n\ts_nop 7" : "+v"(N0), "+v"(N1)); _Pragma("unroll") for (int i = 0; i < 16; ++i) { N0[i] -= dl; N1[i] -= dl; } } \
                m += dl; } \
            float ps = 0.f, ps2 = 0.f; \
            _Pragma("unroll") for (int i = 0; i < 16; ++i) { P0[i] = __builtin_amdgcn_exp2f(P0[i]); P1[i] = __builtin_amdgcn_exp2f(P1[i]); ps += P0[i]; ps2 += P1[i]; } \
            lsum += ps + ps2; \
            bf16x8 pb[4]; \
            { u32x4 w; w.x = pk2(P0[0], P0[1]); w.y = pk2(P0[2], P0[3]); w.z = pk2(P0[4], P0[5]); w.w = pk2(P0[6], P0[7]); pb[0] = __builtin_bit_cast(bf16x8, w); \
              w.x = pk2(P0[8], P0[9]); w.y = pk2(P0[10], P0[11]); w.z = pk2(P0[12], P0[13]); w.w = pk2(P0[14], P0[15]); pb[1] = __builtin_bit_cast(bf16x8, w); \
              w.x = pk2(P1[0], P1[1]); w.y = pk2(P1[2], P1[3]); w.z = pk2(P1[4], P1[5]); w.w = pk2(P1[6], P1[7]); pb[2] = __builtin_bit_cast(bf16x8, w); \
              w.x = pk2(P1[8], P1[9]); w.y = pk2(P1[10], P1[11]); w.z = pk2(P1[12], P1[13]); w.w = pk2(P1[14], P1[15]); pb[3] = __builtin_bit_cast(bf16x8, w); } \
            u32x4 va[4]; \
            AT_LDV(va, vs_, 0); AT_SB(); AT_PV(va, 0); AT_SB(); AT_LDV(va, vs_, 1); AT_SB(); AT_PV(va, 1); AT_SB(); AT_LDV(va, vs_, 2); AT_SB(); AT_PV(va, 2); AT_SB(); AT_LDV(va, vs_, 3); AT_SB(); AT_PV(va, 3); AT_SB(); } while (0)
        f32x16 pA0, pA1, pB0, pB1;
        AT_DMA_K(0, 0); AT_DMA_V(0, 0); AT_DMA_K(1, 1);
        AT_BAR();
        AT_QK(pA0, pA1, 0);
        asm volatile("s_waitcnt lgkmcnt(0)\n\ts_barrier" ::: "memory");
        for (int t = 0; t < NT; t += 2) {
            if (t + 2 < NT) AT_DMA_K(t + 2, 0);
            AT_DMA_V(t + 1, 1);
            AT_SB(); AT_QK(pB0, pB1, 1); AT_SB();
            AT_SOFTPV(pA0, pA1, pB0, pB1, t == 0, true, 0);
            AT_BAR();
            if (t + 3 < NT) AT_DMA_K(t + 3, 1);
            if (t + 2 < NT) AT_DMA_V(t + 2, 0);
            AT_SB(); if (t + 2 < NT) { AT_QK(pA0, pA1, 0); } AT_SB();
            AT_SOFTPV(pB0, pB1, pA0, pA1, false, t + 2 < NT, 1);
            AT_BAR();
        }
#undef AT_DMA_K
#undef AT_DMA_V
#undef AT_BAR
#undef AT_SB
#undef AT_QK
#undef AT_LDV
#undef AT_PV
#undef AT_SOFTPV
        const float ltot = lsum + __shfl_xor(lsum, 32);
        const float invl = 1.f / ltot;
        if (map == 1) { const float f = lam * invl;
#pragma unroll
            for (int d = 0; d < 4; ++d)
#pragma unroll
                for (int i = 0; i < 16; ++i) xch[(qw * 64 + d * 16 + i) * 64 + C.lane] = O[d][i] * f; }
        __syncthreads();
        if (map == 0) { float ss = 0.f;
#pragma unroll
            for (int d = 0; d < 4; ++d)
#pragma unroll
                for (int i = 0; i < 16; ++i) { const float o = O[d][i] * invl - xch[(qw * 64 + d * 16 + i) * 64 + C.lane]; O[d][i] = o; ss += o * o; }
            ss += __shfl_xor(ss, 32);
            const float rn = rsqrtf(ss * (1.f / 128.f) + RMS_EPS) * (1.f - lam_init);
            bf16_t* orow = A2 + (size_t)(qrow0 + qw * 32 + r32) * DM + h * 128;
#pragma unroll
            for (int d = 0; d < 4; ++d)
#pragma unroll
                for (int g4 = 0; g4 < 4; ++g4) { const int dd = 32 * d + 8 * g4 + 4 * hi; const f32x4 sg = *(const f32x4*)(subg + dd);
                    const f32x4 v = {O[d][4 * g4] * rn * sg[0], O[d][4 * g4 + 1] * rn * sg[1], O[d][4 * g4 + 2] * rn * sg[2], O[d][4 * g4 + 3] * rn * sg[3]};
                    st4bf(orow + dd, v); } }
        __syncthreads();
    }
}

__device__ __forceinline__ void phase_rt(const Ctx& C, const Args& A, int l) {
    unsigned char* ws = A.ws; float* X = (float*)(ws + WS_X); bf16_t* H = (bf16_t*)(ws + WS_H); float* AFF = (float*)(ws + WS_AFF); float* STAT = (float*)(ws + WS_P);
    const float* MOD = (const float*)(ws + WS_MOD) + (size_t)l * 5 * 6144;
    const float* lng = A.in[I_LNG] + (size_t)(l * 2 + 0) * DM; const float* lnb = A.in[I_LNB] + (size_t)(l * 2 + 0) * DM;
    LAS float* wrs = (LAS float*)C.lds;
    { const float* wr = A.in[I_WR] + (size_t)l * DM * 16; for (int i = C.tid; i < DM * 16; i += NTHR) wrs[(i & 15) * 1024 + (i >> 4)] = wr[i]; }
    __syncthreads();
    const int row0 = (int)(((long)C.gw * MROWS) / C.NGW), row1 = (int)(((long)(C.gw + 1) * MROWS) / C.NGW);
    f32x4 lngr[4], lnbr[4], scr[4], shr[4]; int cmi = -1;
#pragma unroll
    for (int j = 0; j < 4; ++j) { const int col = 4 * C.lane + 256 * j; lngr[j] = *(const f32x4*)(lng + col); lnbr[j] = *(const f32x4*)(lnb + col); scr[j] = lngr[j]; shr[j] = lngr[j]; }
    f32x4 xn[4];
    if (row0 < row1) {
#pragma unroll
        for (int j = 0; j < 4; ++j) xn[j] = *(const f32x4*)(X + (size_t)row0 * DM + 4 * C.lane + 256 * j); }
    for (int row = row0; row < row1; ++row) {
        const int mi = row_mi(row);
        if (mi != cmi) { cmi = mi; const float* md = MOD + mi * 6144;
#pragma unroll
            for (int j = 0; j < 4; ++j) { const int col = 4 * C.lane + 256 * j; scr[j] = *(const f32x4*)(md + 4 * DM + col) + 1.f; shr[j] = *(const f32x4*)(md + 3 * DM + col); } }
        f32x4 x[4]; float s = 0.f;
#pragma unroll
        for (int j = 0; j < 4; ++j) { x[j] = xn[j]; s += (x[j][0] + x[j][1]) + (x[j][2] + x[j][3]); }
        if (row + 1 < row1) {
#pragma unroll
            for (int j = 0; j < 4; ++j) xn[j] = *(const f32x4*)(X + (size_t)(row + 1) * DM + 4 * C.lane + 256 * j); }
        const float mean = wave_sum(s) * (1.f / DM); float s2 = 0.f;
#pragma unroll
        for (int j = 0; j < 4; ++j) { x[j] = x[j] - mean; s2 += (x[j][0] * x[j][0] + x[j][1] * x[j][1]) + (x[j][2] * x[j][2] + x[j][3] * x[j][3]); }
        const float rstd = rsqrtf(wave_sum(s2) * (1.f / DM) + LN_EPS);
        if (C.lane == 0) *(f32x2*)(STAT + (size_t)row * 2) = (f32x2){mean, rstd};
        float v[16];
#pragma unroll
        for (int e = 0; e < 16; ++e) v[e] = 0.f;
#pragma unroll
        for (int j = 0; j < 4; ++j) { const int col = 4 * C.lane + 256 * j;
            const f32x4 x1 = x[j] * rstd * lngr[j] + lnbr[j];
            const f32x4 h = x1 * scr[j] + shr[j];
            st4bf(H + (size_t)row * DM + col, h);
#pragma unroll
            for (int e = 0; e < 16; ++e) { const f32x4 w = *(const LAS f32x4*)(wrs + e * 1024 + col); v[e] += (h[0] * w[0] + h[1] * w[1]) + (h[2] * w[2] + h[3] * w[3]); }
            __builtin_amdgcn_sched_barrier(0); }
#pragma unroll
        for (int i = 0; i < 8; ++i) { const float send = (C.lane & 32) ? v[i] : v[i + 8], keep = (C.lane & 32) ? v[i + 8] : v[i]; v[i] = keep + __shfl_xor(send, 32); }
#pragma unroll
        for (int i = 0; i < 4; ++i) { const float send = (C.lane & 16) ? v[i] : v[i + 4], keep = (C.lane & 16) ? v[i + 4] : v[i]; v[i] = keep + __shfl_xor(send, 16); }
#pragma unroll
        for (int i = 0; i < 2; ++i) { const float send = (C.lane & 8) ? v[i] : v[i + 2], keep = (C.lane & 8) ? v[i + 2] : v[i]; v[i] = keep + __shfl_xor(send, 8); }
        { const float send = (C.lane & 4) ? v[0] : v[1], keep = (C.lane & 4) ? v[1] : v[0]; v[0] = keep + __shfl_xor(send, 4); }
        float z = v[0]; z += __shfl_xor(z, 1); z += __shfl_xor(z, 2);
        float mx = z;
#pragma unroll
        for (int o = 4; o < 64; o <<= 1) mx = fmaxf(mx, __shfl_xor(mx, o));
        const float ex = expf(z - mx); float sm = ex;
#pragma unroll
        for (int o = 4; o < 64; o <<= 1) sm += __shfl_xor(sm, o);
        if ((C.lane & 3) == 0) AFF[(size_t)row * 16 + (C.lane >> 2)] = ex / sm;
    }
}

__device__ __forceinline__ void phase_tk(const Ctx& C, const Args& A) {
    unsigned char* ws = A.ws; const float* AFF = (const float*)(ws + WS_AFF); int* SLOT = (int*)(ws + WS_SLOT); int* IDX = (int*)(ws + WS_IDX); float* GATE = (float*)(ws + WS_GATE);
    LAS unsigned* key = (LAS unsigned*)C.lds;
    LAS unsigned* hist = key + 8192;
    LAS unsigned* scn = hist + 256;
    LAS unsigned* wtot = scn + 256;
    LAS unsigned* bc = wtot + 8;
    for (int u = blockIdx.x; u < 128; u += C.G) {
        const bool isctx = u >= 64; const int uu = u & 63, b = uu >> 4, e = uu & 15;
        const int n = isctx ? CTXL : TT, cap = isctx ? CAP_C : CAP_L;
        const int row0 = isctx ? NLAT + b * CTXL : b * TT;
        const int slot0 = e * ESLOTS + (isctx ? 4 * CAP_L + b * CAP_C : b * CAP_L);
        for (int i = C.tid; i < n; i += NTHR) key[i] = __float_as_uint(AFF[(size_t)(row0 + i) * 16 + e]);
        unsigned prefix = 0u, pmask = 0u; int need = cap;
        for (int pass = 0; pass < 4; ++pass) {
            const int shift = 24 - 8 * pass;
            if (C.tid < 256) hist[C.tid] = 0u;
            __syncthreads();
            for (int i = C.tid; i < n; i += NTHR) { const unsigned k = key[i]; if ((k & pmask) == prefix) __hip_atomic_fetch_add(&hist[(k >> shift) & 255u], 1u, __ATOMIC_RELAXED, __HIP_MEMORY_SCOPE_WORKGROUP); }
            __syncthreads();
            {
                const unsigned hd = (C.tid < 256) ? hist[255 - C.tid] : 0u; unsigned inc = hd;
#pragma unroll
                for (int o = 1; o < 64; o <<= 1) { const unsigned t = __shfl_up(inc, o); if (C.lane >= o) inc += t; }
                if (C.tid < 256 && C.lane == 63) wtot[C.wave] = inc;
                __syncthreads();
                if (C.tid < 256) { unsigned base = 0u; for (int w = 0; w < C.wave; ++w) base += wtot[w];
                    const unsigned incl = base + inc, above = incl - hd;
                    if (incl >= (unsigned)need && above < (unsigned)need) { bc[0] = (unsigned)(255 - C.tid); bc[1] = (unsigned)need - above; } }
            }
            __syncthreads();
            prefix |= bc[0] << shift; pmask |= 255u << shift; need = (int)bc[1];
            __syncthreads();
        }
        const int per = (n + NTHR - 1) / NTHR; const int i0 = C.tid * per;
        unsigned cg = 0u, ce = 0u;
        for (int j = 0; j < per; ++j) { const int i = i0 + j; if (i < n) { const unsigned k = key[i]; cg += (k > prefix); ce += (k == prefix); } }
        unsigned pk = cg | (ce << 16), inc = pk;
#pragma unroll
        for (int o = 1; o < 64; o <<= 1) { const unsigned t = __shfl_up(inc, o); if (C.lane >= o) inc += t; }
        if (C.lane == 63) wtot[C.wave] = inc;
        __syncthreads();
        unsigned wbase = 0u;
        for (int w = 0; w < C.wave; ++w) wbase += wtot[w];
        const unsigned excl = wbase + inc - pk;
        unsigned rg = excl & 0xffffu, re = excl >> 16;
        const int ngt = cap - need;
        for (int j = 0; j < per; ++j) { const int i = i0 + j; if (i < n) { const unsigned k = key[i]; int pos = -1;
            if (k > prefix) { pos = (int)rg; ++rg; } else if (k == prefix) { if ((int)re < need) pos = ngt + (int)re; ++re; }
            const int row = row0 + i;
            if (pos >= 0) { IDX[slot0 + pos] = row; GATE[slot0 + pos] = __uint_as_float(k); SLOT[(size_t)row * 16 + e] = slot0 + pos; }
            else SLOT[(size_t)row * 16 + e] = -1; } }
        if (isctx && b == 0 && C.tid < ESLOTS - 4224) { IDX[e * ESLOTS + 4224 + C.tid] = 0; GATE[e * ESLOTS + 4224 + C.tid] = 0.f; }
        __syncthreads();
    }
}

__device__ __forceinline__ void phase_cb(const Ctx& C, const Args& A, int l) {
    unsigned char* ws = A.ws; float* X = (float*)(ws + WS_X); bf16_t* H = (bf16_t*)(ws + WS_H); const int* SLOT = (const int*)(ws + WS_SLOT); const bf16_t* YE = (const bf16_t*)(ws + WS_YE);
    const float* MOD = (const float*)(ws + WS_MOD) + (size_t)l * 5 * 6144; const float* MODN = MOD + 5 * 6144;
    const float* lng = A.in[I_LNG] + (size_t)(l * 2 + 1) * DM; const float* lnb = A.in[I_LNB] + (size_t)(l * 2 + 1) * DM;
    const float* lng1 = A.in[I_LNG] + (size_t)(l * 2 + 0) * DM; const float* lnb1 = A.in[I_LNB] + (size_t)(l * 2 + 0) * DM; const float* STAT = (const float*)(ws + WS_P);
    const int row0 = (int)(((long)C.gw * MROWS) / C.NGW), row1 = (int)(((long)(C.gw + 1) * MROWS) / C.NGW);
    f32x4 lngr[4], lnbr[4], gfr[4], nsc[4], nsh[4], l1g[4], l1b[4]; int cmi = -1;
#pragma unroll
    for (int j = 0; j < 4; ++j) { const int col = 4 * C.lane + 256 * j; lngr[j] = *(const f32x4*)(lng + col); lnbr[j] = *(const f32x4*)(lnb + col); gfr[j] = lngr[j]; nsc[j] = lngr[j]; nsh[j] = lngr[j];
        l1g[j] = *(const f32x4*)(lng1 + col); l1b[j] = *(const f32x4*)(lnb1 + col); }
    int svn = -1; f32x4 xn[4]; f32x2 stn = {0.f, 0.f};
    if (row0 < row1) { svn = SLOT[(size_t)row0 * 16 + (C.lane & 15)]; stn = *(const f32x2*)(STAT + (size_t)row0 * 2);
#pragma unroll
        for (int j = 0; j < 4; ++j) xn[j] = *(const f32x4*)(X + (size_t)row0 * DM + 4 * C.lane + 256 * j); }
    for (int row = row0; row < row1; ++row) {
        const int mi = row_mi(row);
        if (mi != cmi) { cmi = mi; const float* md = MOD + mi * 6144; const float* mn = MODN + mi * 6144;
#pragma unroll
            for (int j = 0; j < 4; ++j) { const int col = 4 * C.lane + 256 * j; gfr[j] = *(const f32x4*)(md + 5 * DM + col);
                if (l < DEPTH - 1) { nsc[j] = *(const f32x4*)(mn + DM + col) + 1.f; nsh[j] = *(const f32x4*)(mn + col); } } }
        const int sv = svn;
        unsigned mask = (unsigned)__ballot(sv >= 0) & 0xffffu;
        f32x4 acc[4];
#pragma unroll
        for (int j = 0; j < 4; ++j) acc[j] = (f32x4){0.f, 0.f, 0.f, 0.f};
        u32x2 y0[4], y1[4]; bool h0 = false, h1 = false;
        if (mask) { const int e = __builtin_ctz(mask); mask &= mask - 1; h0 = true; const int sl = __builtin_amdgcn_readlane(sv, e);
#pragma unroll
            for (int j = 0; j < 4; ++j) y0[j] = *(const u32x2*)(YE + (size_t)sl * DM + 4 * C.lane + 256 * j); }
        if (mask) { const int e = __builtin_ctz(mask); mask &= mask - 1; h1 = true; const int sl = __builtin_amdgcn_readlane(sv, e);
#pragma unroll
            for (int j = 0; j < 4; ++j) y1[j] = *(const u32x2*)(YE + (size_t)sl * DM + 4 * C.lane + 256 * j); }
        f32x4 x[4]; const f32x2 st = stn;
#pragma unroll
        for (int j = 0; j < 4; ++j) x[j] = xn[j];
        if (row + 1 < row1) { svn = SLOT[(size_t)(row + 1) * 16 + (C.lane & 15)]; stn = *(const f32x2*)(STAT + (size_t)(row + 1) * 2);
#pragma unroll
            for (int j = 0; j < 4; ++j) xn[j] = *(const f32x4*)(X + (size_t)(row + 1) * DM + 4 * C.lane + 256 * j); }
        if (h0) {
#pragma unroll
            for (int j = 0; j < 4; ++j) acc[j] += (f32x4){__uint_as_float(y0[j].x << 16), __uint_as_float(y0[j].x & 0xffff0000u), __uint_as_float(y0[j].y << 16), __uint_as_float(y0[j].y & 0xffff0000u)}; }
        if (h1) {
#pragma unroll
            for (int j = 0; j < 4; ++j) acc[j] += (f32x4){__uint_as_float(y1[j].x << 16), __uint_as_float(y1[j].x & 0xffff0000u), __uint_as_float(y1[j].y << 16), __uint_as_float(y1[j].y & 0xffff0000u)}; }
        while (mask) { const int e = __builtin_ctz(mask); mask &= mask - 1; const int sl = __builtin_amdgcn_readlane(sv, e);
#pragma unroll
            for (int j = 0; j < 4; ++j) acc[j] += ld4bf(YE + (size_t)sl * DM + 4 * C.lane + 256 * j); }
        float sm = 0.f;
#pragma unroll
        for (int j = 0; j < 4; ++j) { x[j] = ((x[j] - st[0]) * st[1] * l1g[j] + l1b[j]) * ALPHA_DN + gfr[j] * acc[j];
            sm += (x[j][0] + x[j][1]) + (x[j][2] + x[j][3]); }
        const float mean = wave_sum(sm) * (1.f / DM); float s2 = 0.f;
#pragma unroll
        for (int j = 0; j < 4; ++j) { x[j] = x[j] - mean; s2 += (x[j][0] * x[j][0] + x[j][1] * x[j][1]) + (x[j][2] * x[j][2] + x[j][3] * x[j][3]); }
        const float rstd = rsqrtf(wave_sum(s2) * (1.f / DM) + LN_EPS);
#pragma unroll
        for (int j = 0; j < 4; ++j) { const int col = 4 * C.lane + 256 * j;
            const f32x4 x2 = x[j] * rstd * lngr[j] + lnbr[j];
            if (l < DEPTH - 1) { *(f32x4*)(X + (size_t)row * DM + col) = x2; st4bf(H + (size_t)row * DM + col, x2 * nsc[j] + nsh[j]); }
            else if (row < NLAT) *(f32x4*)(A.out + (size_t)row * DM + col) = x2; }
    }
}


#ifndef GEMM_NOINLINE
#define GEMM_NOINLINE 0
#endif
#if GEMM_NOINLINE
#define GEMM_FN __device__ __noinline__
#else
#define GEMM_FN __device__ __forceinline__
#endif
GEMM_FN void gphase_in(LAS unsigned char* lds, unsigned char* ws, int nN, int G) {
    int bx = blockIdx.x; asm volatile("" : "+s"(bx), "+s"(G));
    pg8::Gemm g{(const bf16_t*)(ws + WS_H), (const bf16_t*)(ws + WS_WIN), DM}; pg8::Order<0> S; S.init(MROWS / 256, nN, G, bx, nullptr, 0);
    pg8::EpiBf16 E{(bf16_t*)(ws + WS_P), P_LD}; pg8::gemm_phase(lds, g, S, E); }
GEMM_FN void gphase_in_odd(LAS unsigned char* lds, unsigned char* ws, int G) {
    int bx = blockIdx.x; asm volatile("" : "+s"(bx), "+s"(G));
    pg8::Gemm g{(const bf16_t*)(ws + WS_H), (const bf16_t*)(ws + WS_WIN), DM}; pg8::Order<0> S; S.init(MROWS / 256, D_IN_ODD / 256, G, bx, nullptr, 0);
    pg8::EpiOdd E{(bf16_t*)(ws + WS_P), (bf16_t*)(ws + WS_Q), (bf16_t*)(ws + WS_KA), (const float*)(ws + WS_ROPE)}; pg8::gemm_phase(lds, g, S, E); }
GEMM_FN void gphase_lora(LAS unsigned char* lds, unsigned char* ws, const float* d0, const float* a0, const float* kal, int G) {
    int bx = blockIdx.x; asm volatile("" : "+s"(bx), "+s"(G));
    pg8::Gemm g{(const bf16_t*)(ws + WS_LIN), (const bf16_t*)(ws + WS_WLORA), LORA_K}; pg8::Order<0> S; S.init(MROWS / 256, LORA_N / 256, G, bx, nullptr, 0);
    pg8::EpiLora E{ws + WS_SCN, (bf16_t*)(ws + WS_G), d0, a0, kal}; pg8::gemm_phase(lds, g, S, E); }
GEMM_FN void gphase_out(LAS unsigned char* lds, unsigned char* ws, const float* modl, int G, const float* xin, const float* cin) {
    int bx = blockIdx.x; asm volatile("" : "+s"(bx), "+s"(G));
    pg8::Gemm g{(const bf16_t*)(ws + WS_A2), (const bf16_t*)(ws + WS_WOUT), DM}; pg8::Order<0> S; S.init(MROWS / 256, DM / 256, G, bx, nullptr, 0);
    pg8::EpiRes E{(float*)(ws + WS_X), modl, xin, cin}; pg8::gemm_phase(lds, g, S, E); }
GEMM_FN void gphase_e1(LAS unsigned char* lds, unsigned char* ws, int G, int l) {
    int bx = blockIdx.x; asm volatile("" : "+s"(bx), "+s"(G));
    pg8::Gemm g{(const bf16_t*)(ws + WS_H), (const bf16_t*)(ws + WS_WE13 + (size_t)(l & 1) * WE13_BYTES), DM}; pg8::EpiSwiGLU E{(bf16_t*)(ws + WS_HID)};
    pg8::OrderExp<1> S; S.init(4096 / 256, G, bx, (const int*)(ws + WS_IDX), (long)4096 * DM); pg8::gemm_phase(lds, g, S, E); }
GEMM_FN void gphase_e2(LAS unsigned char* lds, unsigned char* ws, int G, int l) {
    int bx = blockIdx.x; asm volatile("" : "+s"(bx), "+s"(G));
    pg8::Gemm g{(const bf16_t*)(ws + WS_HID), (const bf16_t*)(ws + WS_WE2 + (size_t)(l & 1) * WE2_BYTES), D_EXP}; pg8::EpiYE E{(bf16_t*)(ws + WS_YE), (const float*)(ws + WS_GATE)};
    pg8::OrderExp<2> S; S.init(DM / 256, G, bx, nullptr, (long)DM * D_EXP); pg8::gemm_phase(lds, g, S, E); }

constexpr int NSLOT = 13;
constexpr int NSTEP = 1 + DEPTH * NSLOT;
__global__ void __launch_bounds__(NTHR, 2) mk_fwd(Args KA) {
    extern __shared__ __attribute__((aligned(16))) unsigned char lds_raw[];
    volatile LAS unsigned* MISC = (volatile LAS unsigned*)((LAS unsigned char*)lds_raw + LDS_MISC);
    if (threadIdx.x < 16) MISC[threadIdx.x] = 0u;
    if (threadIdx.x == 0) { LAS unsigned long long* tb = (LAS unsigned long long*)((LAS unsigned char*)lds_raw + LDS_PTAB);
#pragma unroll
        for (int i = 0; i < 37; ++i) tb[i] = (unsigned long long)KA.in[i];
        tb[37] = (unsigned long long)KA.out; tb[38] = (unsigned long long)KA.ws; }
    __syncthreads();
    const int lo = KA.lo, hi = KA.hi;
    unsigned bar_x = 0;
    if (hi - lo > 1) { const XcdBarrier b0 = xcd_barrier_post((unsigned*)(KA.ws + WS_CTL), MISC); bar_x = b0.x; }
#ifndef PH_MASK
#define PH_MASK 0xFFFFFF
#endif
#ifndef REP_MASK
#define REP_MASK 0
#endif
#define PH_BIT(k) (((k) == 0) ? 0 : 1 + ((k) - 1) % NSLOT + (((k) - 1) % NSLOT >= 2 && ((k) - 1) % NSLOT <= 3 && odd ? 12 : 0))
#define RUN(k, ...) do { if (((PH_MASK >> PH_BIT(k)) & 1) && lo <= (k) && (k) < hi) { const int nrep = ((REP_MASK >> PH_BIT(k)) & 1) ? 2 : 1; \
        _Pragma("unroll 1") for (int rep = 0; rep < nrep; ++rep) { \
        Ctx C; mkctx(C, (LAS unsigned char*)lds_raw); Args A; ldargs(A, (LAS unsigned char*)lds_raw); unsigned char* ws = A.ws; \
        const float* MODL = (const float*)(ws + WS_MOD) + (size_t)l * 5 * 6144; (void)MODL; \
        __VA_ARGS__; if ((k) + 1 < hi || rep + 1 < nrep) { XcdBarrier bar; bar.bar = (unsigned*)(ws + WS_CTL); bar.x = bar_x; bar.st = MISC; xcd_barrier(bar); } } } } while (0)
    { const bool odd = false; const int l = 0; RUN(0, { phase_init(C, A); __syncthreads(); conv_items(C, A, 0, C.gw, C.NGW, true, true, true); }); }
#pragma unroll 1
    for (int l = 0; l < DEPTH; ++l) {
        const int sb = 1 + l * NSLOT; const bool odd = l & 1;
        if (!(CHUNKED_SCAN && odd)) { RUN(sb + 0, { phase_conv(C, A, l); if (l == 0) phase_modh(C, A, 0); }); }
        if (odd) { RUN(sb + 1, { gphase_in_odd(C.lds, ws, C.G);
                   const int tail = ((MROWS / 256) * (D_IN_ODD / 256)) % C.G;
                   if (CHUNKED_SCAN && l + 1 < DEPTH && tail > 0 && (int)blockIdx.x >= tail) conv_items(C, A, l + 1, ((int)blockIdx.x - tail) * NWAVES + C.wave, (C.G - tail) * NWAVES, false, false, true, 0, YW_IN_HI); }); }
        else { RUN(sb + 1, { gphase_in(C.lds, ws, D_IN_EVEN_PAD / 256, C.G);
                   const int tail = ((MROWS / 256) * (D_IN_EVEN_PAD / 256)) % C.G;
                   if (CHUNKED_SCAN && l + 1 < DEPTH && tail > 0 && (int)blockIdx.x >= tail) conv_items(C, A, l + 1, ((int)blockIdx.x - tail) * NWAVES + C.wave, (C.G - tail) * NWAVES, false, false, true, 0, XW_IN_HI); }); }
        if (!odd) {
            RUN(sb + 2, phase_ef1(C, A, l));
            RUN(sb + 3, { const int i2 = l >> 1; gphase_lora(C.lds, ws, A.in[I_D0] + (size_t)i2 * 2 * 768, A.in[I_A0] + (size_t)i2 * 2 * 768, A.in[I_KAL] + (size_t)i2 * 768, C.G); });
#if CHUNKED_SCAN
            RUN(sb + 4, phase_csa(C, A));
            RUN(sb + 5, phase_csb(C, A, l));
#else
            RUN(sb + 4, phase_scan(C, A));
#endif
            RUN(sb + 6, phase_ef2(C, A, l));
        } else {
            RUN(sb + 2, { phase_of1(C, A, l);
                   const int busy2 = 256 + 8 * 7 - C.G;
                   if (CHUNKED_SCAN && l + 1 < DEPTH && busy2 > 0 && (int)blockIdx.x >= busy2) conv_items(C, A, l + 1, ((int)blockIdx.x - busy2) * NWAVES + C.wave, (C.G - busy2) * NWAVES, false, false, true, YW_IN_HI, YW_OF_HI); });
            RUN(sb + 3, phase_attn(C, A, l));
        }
        RUN(sb + 7, { gphase_out(C.lds, ws, MODL, C.G, l == 0 ? A.in[I_X] : (const float*)(ws + WS_X), l == 0 ? A.in[I_CTX] : (const float*)(ws + WS_X) + (size_t)NLAT * DM);
                   const int tail = ((MROWS / 256) * (DM / 256)) % C.G;
                   if (CHUNKED_SCAN && l + 1 < DEPTH && tail > 0 && (int)blockIdx.x >= tail) conv_items(C, A, l + 1, ((int)blockIdx.x - tail) * NWAVES + C.wave, (C.G - tail) * NWAVES, false, false, true, odd ? YW_OF_HI : XW_IN_HI, odd ? YW_OUT_HI : XW_OUT_HI); });
        RUN(sb + 8, phase_rt(C, A, l));
        RUN(sb + 9, { phase_tk(C, A);
                   if (CHUNKED_SCAN && l + 1 < DEPTH && (int)blockIdx.x >= 128) conv_items(C, A, l + 1, ((int)blockIdx.x - 128) * NWAVES + C.wave, (C.G - 128) * NWAVES, false, false, true, odd ? YW_OUT_HI : XW_OUT_HI, odd ? YW_TK_HI : XW_TK_HI); });
        RUN(sb + 10, gphase_e1(C.lds, ws, C.G, l));
        RUN(sb + 11, gphase_e2(C.lds, ws, C.G, l));
        RUN(sb + 12, { phase_cb(C, A, l); if (CHUNKED_SCAN && !odd && l + 1 < DEPTH) { __syncthreads(); conv_items(C, A, l + 1, C.gw, C.NGW, false, true, false); } });
    }
#undef RUN
}

#ifdef PHASE_PROBE
#define PROBE_PRE extern __shared__ __attribute__((aligned(16))) unsigned char lds_raw[]; Ctx C; mkctx(C, (LAS unsigned char*)lds_raw); unsigned char* ws = A.ws; (void)ws;
__global__ void __launch_bounds__(NTHR, 2) pr_init(Args A) { PROBE_PRE phase_init(C, A); }
__global__ void __launch_bounds__(NTHR, 2) pr_conv(Args A) { PROBE_PRE phase_conv(C, A, A.lo); }
__global__ void __launch_bounds__(NTHR, 2) pr_modh(Args A) { PROBE_PRE phase_modh(C, A, A.lo); }
__global__ void __launch_bounds__(NTHR, 2) pr_ef1(Args A) { PROBE_PRE phase_ef1(C, A, A.lo); }
__global__ void __launch_bounds__(NTHR, 2) pr_scan(Args A) { PROBE_PRE phase_scan(C, A); }
__global__ void __launch_bounds__(NTHR, 2) pr_ef2(Args A) { PROBE_PRE phase_ef2(C, A, A.lo); }
__global__ void __launch_bounds__(NTHR, 2) pr_csa(Args A) { PROBE_PRE phase_csa(C, A); }
__global__ void __launch_bounds__(NTHR, 2) pr_csb(Args A) { PROBE_PRE phase_csb(C, A, A.lo); }
__global__ void __launch_bounds__(NTHR, 2) pr_of1(Args A) { PROBE_PRE phase_of1(C, A, A.lo); }
__global__ void __launch_bounds__(NTHR, 2) pr_attn(Args A) { PROBE_PRE phase_attn(C, A, A.lo); }
__global__ void __launch_bounds__(NTHR, 2) pr_rt(Args A) { PROBE_PRE phase_rt(C, A, A.lo); }
__global__ void __launch_bounds__(NTHR, 2) pr_tk(Args A) { PROBE_PRE phase_tk(C, A); }
__global__ void __launch_bounds__(NTHR, 2) pr_cb(Args A) { PROBE_PRE phase_cb(C, A, A.lo); }
__global__ void __launch_bounds__(NTHR, 2) pr_gemm_in(Args A) { PROBE_PRE pg8::Gemm g{(const bf16_t*)(ws + WS_H), (const bf16_t*)(ws + WS_WIN), DM}; pg8::Order<0> S; S.init(MROWS / 256, A.lo, C.G, (int)blockIdx.x, nullptr, 0);
                      pg8::EpiBf16 E{(bf16_t*)(ws + WS_P), P_LD}; pg8::gemm_phase(C.lds, g, S, E); }
__global__ void __launch_bounds__(NTHR, 2) pr_gemm_lora(Args A) { PROBE_PRE pg8::Gemm g{(const bf16_t*)(ws + WS_LIN), (const bf16_t*)(ws + WS_WLORA), LORA_K}; pg8::Order<0> S; S.init(MROWS / 256, LORA_N / 256, C.G, (int)blockIdx.x, nullptr, 0);
                          const int i2 = A.lo; pg8::EpiLora E{ws + WS_SCN, (bf16_t*)(ws + WS_G), A.in[I_D0] + (size_t)i2 * 2 * 768, A.in[I_A0] + (size_t)i2 * 2 * 768, A.in[I_KAL] + (size_t)i2 * 768};
                          pg8::gemm_phase(C.lds, g, S, E); }
__global__ void __launch_bounds__(NTHR, 2) pr_gemm_out(Args A) { PROBE_PRE pg8::Gemm g{(const bf16_t*)(ws + WS_A2), (const bf16_t*)(ws + WS_WOUT), DM}; pg8::Order<0> S; S.init(MROWS / 256, DM / 256, C.G, (int)blockIdx.x, nullptr, 0);
                      pg8::EpiRes E{(float*)(ws + WS_X), (const float*)(ws + WS_MOD), (const float*)(ws + WS_X), (const float*)(ws + WS_X) + (size_t)NLAT * DM}; pg8::gemm_phase(C.lds, g, S, E); }
__global__ void __launch_bounds__(NTHR, 2) pr_gemm_e1(Args A) { PROBE_PRE pg8::Gemm g{(const bf16_t*)(ws + WS_H), (const bf16_t*)(ws + WS_WE13), DM}; pg8::Order<1> S; S.init(NEXP * 17, 4096 / 256, C.G, (int)blockIdx.x, (const int*)(ws + WS_IDX), (long)4096 * DM);
                      pg8::EpiSwiGLU E{(bf16_t*)(ws + WS_HID)}; pg8::gemm_phase(C.lds, g, S, E); }
__global__ void __launch_bounds__(NTHR, 2) pr_gemm_e2(Args A) { PROBE_PRE pg8::Gemm g{(const bf16_t*)(ws + WS_HID), (const bf16_t*)(ws + WS_WE2), D_EXP}; pg8::Order<2> S; S.init(NEXP * 17, DM / 256, C.G, (int)blockIdx.x, nullptr, (long)DM * D_EXP);
                       pg8::EpiYE E{(bf16_t*)(ws + WS_YE), (const float*)(ws + WS_GATE)}; pg8::gemm_phase(C.lds, g, S, E); }
#endif

extern "C" void kernel_launch(void* const* d_in, const int* in_sizes, int n_in, void* d_out, int out_size, void* d_ws, size_t ws_size, hipStream_t stream) {
    static int grid = 0;
    if (grid == 0) {
        if (n_in != 37 || out_size != NLAT * DM || ws_size < WS_END) { fprintf(stderr, "kernel_launch: unexpected shapes: n_in %d out %d ws %zu (need %zu)\n", n_in, out_size, ws_size, (size_t)WS_END); grid = -1; return; }
        int dev = 0, cus = 0, per_cu = 0;
        if (hipGetDevice(&dev) != hipSuccess || hipDeviceGetAttribute(&cus, hipDeviceAttributeMultiprocessorCount, dev) != hipSuccess) { grid = -1; return; }
        if (hipFuncSetAttribute((const void*)mk_fwd, hipFuncAttributeMaxDynamicSharedMemorySize, LDS_BYTES) != hipSuccess) { fprintf(stderr, "kernel_launch: hipFuncSetAttribute failed\n"); grid = -1; return; }
        if (hipOccupancyMaxActiveBlocksPerMultiprocessor(&per_cu, (const void*)mk_fwd, NTHR, LDS_BYTES) != hipSuccess || per_cu < 1) fprintf(stderr, "kernel_launch: occupancy query reports %d\n", per_cu);
        (void)hipGetLastError();
        grid = cus;
    }
    if (grid < 0) return;
    (void)hipMemsetAsync((char*)d_ws + WS_CTL, 0, CTL_BYTES, stream);
    Args a{};
    for (int i = 0; i < 37; ++i) a.in[i] = (const float*)d_in[i];
    a.out = (float*)d_out; a.ws = (unsigned char*)d_ws;
#if MK_MULTI
    for (int k = 0; k < NSTEP; ++k) {
        if (k >= 1) { const int l = (k - 1) / NSLOT, s = (k - 1) % NSLOT; if ((l & 1) && ((s >= 4 && s <= 6) || (CHUNKED_SCAN && s == 0))) continue; if (!(l & 1) && !CHUNKED_SCAN && s == 5) continue; }
        a.lo = k; a.hi = k + 1;
        hipLaunchKernelGGL(mk_fwd, dim3(grid), dim3(NTHR), LDS_BYTES, stream, a);
    }
#else
    a.lo = 0; a.hi = NSTEP;
    hipLaunchKernelGGL(mk_fwd, dim3(grid), dim3(NTHR), LDS_BYTES, stream, a);
#endif
    const hipError_t le = hipPeekAtLastError();
    if (le != hipSuccess) fprintf(stderr, "kernel_launch: launch failed: %s\n", hipGetErrorName(le));
}
```

```cpp
#include <hip/hip_runtime.h>
#include <cstdio>
#include <cstdint>
#include <cmath>

#ifndef MK_MULTI
#define MK_MULTI 0
#endif
#ifndef CHUNKED_SCAN
#define CHUNKED_SCAN 1
#endif

#define GAS __attribute__((address_space(1)))
#define LAS __attribute__((address_space(3)))
typedef unsigned short bf16_t;
typedef short bf16x8 __attribute__((ext_vector_type(8)));
typedef float f32x4 __attribute__((ext_vector_type(4)));
typedef float f32x2 __attribute__((ext_vector_type(2)));
typedef float f32x16 __attribute__((ext_vector_type(16)));
typedef unsigned u32x4 __attribute__((ext_vector_type(4)));
typedef unsigned u32x2 __attribute__((ext_vector_type(2)));
typedef __bf16 bf16x2_t __attribute__((ext_vector_type(2)));

constexpr int NB = 4, TT = 8192, DM = 1024, NLAT = NB * TT, CTXL = 256, NCTX = NB * CTXL, MROWS = NLAT + NCTX;
constexpr int DEPTH = 4;
constexpr int D_CONV = 256, RW_H = 12, RW_K = 64, D_RWKV = 768, RWKV_COLS = 2688, D_IN_EVEN = 3456, D_IN_EVEN_PAD = 3584;
constexpr int D_DIFF = 768, D_GMLP = 256, D_IN_ODD = 2816;
constexpr int NEXP = 16, D_EXP = 2048, CAP_L = 1024, CAP_C = 32, ESLOTS = 4352;
constexpr int P_LD = 3584;
constexpr int LORA_K = 384, LORA_N = 3840;
constexpr int LKEYS = CTXL + TT;
constexpr float ALPHA_DN = 1.6817928305074290f;
constexpr float DECAY_SCALE = 0.6065306597126334f;
constexpr float GN_EPS = 64e-5f, LN_EPS = 1e-5f, RMS_EPS = 1e-5f;
constexpr float QSCALE = 0.125f * 1.4426950408889634f;

constexpr size_t al256(size_t x) { return (x + 255) & ~(size_t)255; }
constexpr size_t WS_CTL = 0;
constexpr size_t CTL_BYTES = 65536;
constexpr size_t WS_MOD = WS_CTL + CTL_BYTES;
constexpr size_t WS_ROPE = WS_MOD + al256((size_t)DEPTH * 5 * 6144 * 4);
constexpr size_t WS_WIN = WS_ROPE + 32768;
constexpr size_t WS_WOUT = WS_WIN + (size_t)D_IN_EVEN_PAD * DM * 2;
constexpr size_t WS_WLORA = WS_WOUT + (size_t)DM * DM * 2;
constexpr size_t WS_WE13 = WS_WLORA + (size_t)LORA_N * LORA_K * 2;
constexpr size_t WE13_BYTES = (size_t)NEXP * 4096 * DM * 2, WE2_BYTES = (size_t)NEXP * DM * D_EXP * 2;
constexpr size_t WS_WE2 = WS_WE13 + 2 * WE13_BYTES;
constexpr size_t WS_X = WS_WE2 + 2 * WE2_BYTES;
constexpr size_t WS_H = WS_X + (size_t)MROWS * DM * 4;
constexpr size_t WS_A2 = WS_H + (size_t)MROWS * DM * 2;
constexpr size_t WS_P = WS_A2 + (size_t)MROWS * DM * 2;
constexpr size_t WS_AFF = WS_P + (size_t)MROWS * P_LD * 2;
constexpr size_t WS_SLOT = WS_AFF + (size_t)MROWS * 16 * 4;
constexpr size_t WS_IDX = WS_SLOT + (size_t)MROWS * 16 * 4;
constexpr size_t WS_GATE = WS_IDX + al256((size_t)NEXP * ESLOTS * 4);
constexpr size_t WS_R2 = WS_GATE + al256((size_t)NEXP * ESLOTS * 4);
constexpr int SC_REC = 1408, SC_ROW = 12 * SC_REC, SC_W = 0, SC_R = 512, SC_KK = 640, SC_V = 768, SC_B = 896, SC_KR = 1024;
constexpr size_t WS_SCN = WS_R2;
constexpr size_t WS_G = WS_SCN + (size_t)MROWS * SC_ROW;
constexpr size_t WS_LIN = WS_G + (size_t)MROWS * 768 * 2;
constexpr int CS_L = 64, CS_NCH = LKEYS / CS_L, CS_UNITS = NB * RW_H * 2;
constexpr size_t WS_CHK = WS_LIN + (size_t)MROWS * 384 * 2;
constexpr size_t WS_EVEN_END = WS_CHK + (size_t)CS_UNITS * CS_NCH * 32768;
constexpr size_t WS_Y = WS_P;
constexpr size_t WS_Q = WS_R2;
constexpr size_t WS_KA = WS_Q + (size_t)MROWS * 768 * 2;
constexpr size_t WS_VT = WS_KA + (size_t)NB * LKEYS * 768 * 2;
constexpr size_t WS_HID = WS_R2;
constexpr size_t WS_YE = WS_HID + (size_t)NEXP * ESLOTS * D_EXP * 2;
constexpr size_t WS_END = WS_EVEN_END;
static_assert(WS_END <= (size_t)2147483648ull, "workspace over 2 GiB");
static_assert((size_t)2 * MROWS * 768 * 4 <= (size_t)MROWS * P_LD * 2, "Y aliases P");
static_assert(WS_YE + (size_t)NEXP * ESLOTS * DM * 2 <= WS_END, "moe region");

constexpr int LDS_BYTES = 147456;
constexpr int LDS_MISC = 140 * 1024;
constexpr int LDS_PTAB = LDS_MISC + 256;
constexpr int NWAVES = 8, NTHR = 512;

__device__ __forceinline__ unsigned f2bf(float f) { unsigned u = __float_as_uint(f); return (u + 0x7fffu + ((u >> 16) & 1u)) >> 16; }
__device__ __forceinline__ unsigned pk2(float lo, float hi) { f32x2 v = {lo, hi}; bf16x2_t b = __builtin_convertvector(v, bf16x2_t); return __builtin_bit_cast(unsigned, b); }
__device__ __forceinline__ float bflo(unsigned u) { return __uint_as_float(u << 16); }
__device__ __forceinline__ float bfhi(unsigned u) { return __uint_as_float(u & 0xffff0000u); }
__device__ __forceinline__ float bf2f(bf16_t b) { return __uint_as_float((unsigned)b << 16); }
__device__ __forceinline__ float sigmoidf_(float x) { return __builtin_amdgcn_rcpf(1.f + __expf(-x)); }
__device__ __forceinline__ float wave_sum(float v) {
#pragma unroll
    for (int o = 1; o < 64; o <<= 1) v += __shfl_xor(v, o);
    return v;
}
__device__ __forceinline__ float sum16(float v) {
#pragma unroll
    for (int o = 1; o < 16; o <<= 1) v += __shfl_xor(v, o);
    return v;
}
__device__ __forceinline__ f32x4 ld4bf_(const void* p) { const u32x2 u = *(const u32x2*)p; return (f32x4){bflo(u.x), bfhi(u.x), bflo(u.y), bfhi(u.y)}; }
__device__ __forceinline__ void st4bf_(void* p, f32x4 v) { u32x2 o; o.x = pk2(v[0], v[1]); o.y = pk2(v[2], v[3]); *(u32x2*)p = o; }
__device__ __forceinline__ float max3f(float a, float b, float c) { float r; asm("v_max3_f32 %0, %1, %2, %3" : "=v"(r) : "v"(a), "v"(b), "v"(c)); return r; }
__device__ __forceinline__ int crow(int r, int hi) { return (r & 3) + 8 * (r >> 2) + 4 * hi; }
__device__ __forceinline__ f32x2 gelu_pk(f32x2 v) {
    const f32x2 av = __builtin_elementwise_abs(v), d = av * 0.2316418882f + 1.0f;
    f32x2 t; t.x = __builtin_amdgcn_rcpf(d.x); t.y = __builtin_amdgcn_rcpf(d.y);
    f32x2 q = t * 0.5307027145f + (-0.7265760135f); q = q * t + 0.7107068705f; q = q * t + (-0.142248368f); q = q * t + 0.127414796f; q = q * t;
    const f32x2 s = (v * v) * (-0.72134752044f);
    f32x2 e; e.x = __builtin_amdgcn_exp2f(s.x); e.y = __builtin_amdgcn_exp2f(s.y);
    const f32x2 m = v * (q * e), r = v - m;
    f32x2 o; o.x = v.x < 0.f ? m.x : r.x; o.y = v.y < 0.f ? m.y : r.y; return o;
}
__device__ __forceinline__ f32x4 gelu4(f32x4 v) { const f32x2 a = gelu_pk((f32x2){v[0], v[1]}), b = gelu_pk((f32x2){v[2], v[3]}); return (f32x4){a.x, a.y, b.x, b.y}; }
__device__ __forceinline__ float tanh_fast(float x) { return 1.f - 2.f * __builtin_amdgcn_rcpf(1.f + __expf(2.f * x)); }

#define XB_TMO      128
#define XB_XCNT(j)  (256  + 64 * (j))
#define XB_XSUB(j)  (1280 + 64 * (j))
#define XB_XGEN(j)  (2304 + 64 * (j))
#define XB_TOP      3328
#define XB_TOPGEN   3392
#define XCD_BAR_WORDS 3456
#define XB_SPIN_CAP (1u << 20)

__device__ __forceinline__ unsigned xb_ld(unsigned* p)              { return __hip_atomic_load(p, __ATOMIC_RELAXED, __HIP_MEMORY_SCOPE_AGENT); }
__device__ __forceinline__ unsigned xb_add(unsigned* p, unsigned v) { return __hip_atomic_fetch_add(p, v, __ATOMIC_RELAXED, __HIP_MEMORY_SCOPE_AGENT); }
__device__ __forceinline__ unsigned xb_xcc_id() { return (unsigned)__builtin_amdgcn_s_getreg((3 << 11) | 20) & 0xFu; }
#define XB_SPIN(cond, bar) do { unsigned _sp = 0; while (cond) { __builtin_amdgcn_s_sleep(1); \
    if ((++_sp & 255u) == 0u) { if (xb_ld(&(bar)[XB_TMO])) break; if (_sp > XB_SPIN_CAP) { atomicAdd(&(bar)[XB_TMO], 1u); break; } } } } while (0)

struct XcdBarrier { unsigned* bar; unsigned x; volatile LAS unsigned* st; };

__device__ __forceinline__ XcdBarrier xcd_barrier_post(unsigned* bar, volatile LAS unsigned* st) {
    XcdBarrier b; b.bar = bar; b.x = xb_xcc_id(); b.st = st;
    if (threadIdx.x == 0) (void)xb_add(&bar[XB_XCNT(b.x)], 1u);
    return b;
}
__device__ __forceinline__ void xcd_barrier_complete(unsigned* bar, unsigned x, unsigned& nloc, unsigned& nx) {
    const unsigned G = gridDim.x * gridDim.y * gridDim.z;
    unsigned sum, cnt, mine, sp = 0u;
    for (;;) {
        sum = 0u; cnt = 0u; mine = 0u;
#pragma unroll
        for (unsigned j = 0; j < 16; ++j) { const unsigned c = xb_ld(&bar[XB_XCNT(j)]); sum += c; cnt += (c > 0u) ? 1u : 0u; mine = (j == x) ? c : mine; }
        if (sum == G) break;
        __builtin_amdgcn_s_sleep(1);
        if ((++sp & 255u) == 0u) { if (xb_ld(&bar[XB_TMO])) break; if (sp > XB_SPIN_CAP) { atomicAdd(&bar[XB_TMO], 1u); break; } }
    }
    nloc = mine > 0u ? mine : 1u; nx = cnt > 0u ? cnt : 1u;
}
__device__ __forceinline__ void xcd_barrier(const XcdBarrier& b) {
    asm volatile("s_waitcnt vmcnt(0)" ::: "memory");
    __syncthreads();
    if (threadIdx.x == 0) {
        unsigned* bar = b.bar;
        __builtin_amdgcn_s_waitcnt(0);
        unsigned nloc = b.st[0], nx = b.st[1];
        if (nloc == 0u) { xcd_barrier_complete(bar, b.x, nloc, nx); b.st[0] = nloc; b.st[1] = nx; }
        const unsigned old = xb_add(&bar[XB_XSUB(b.x)], 1u);
        const unsigned gen = old / nloc;
        if (old + 1u == (gen + 1u) * nloc) {
            __builtin_amdgcn_fence(__ATOMIC_RELEASE, "agent");
            asm volatile("s_waitcnt vmcnt(0)" ::: "memory");
            const unsigned og = xb_add(&bar[XB_TOP], 1u);
            const unsigned tg = og / nx;
            if (og + 1u == (tg + 1u) * nx) xb_add(&bar[XB_TOPGEN], 1u);
            else XB_SPIN(xb_ld(&bar[XB_TOPGEN]) == tg, bar);
            __builtin_amdgcn_fence(__ATOMIC_ACQUIRE, "agent");
            xb_add(&bar[XB_XGEN(b.x)], 1u);
            asm volatile("s_waitcnt vmcnt(0)" ::: "memory");
        } else {
            XB_SPIN(xb_ld(&bar[XB_XGEN(b.x)]) == gen, bar);
            __builtin_amdgcn_fence(__ATOMIC_ACQUIRE, "agent");
            asm volatile("s_waitcnt vmcnt(0)" ::: "memory");
        }
    }
    __syncthreads();
}

namespace pg8 {
constexpr int BM = 256, BK = 64, HALF = 128, HTB = HALF * BK * 2, STAGE_BYTES = 8 * HTB, NXCD = 8, WGM = 8;
__host__ __device__ __forceinline__ int lds_byte(int r, int c) { const int st = (r >> 4) * 2 + (c >> 5), rr = r & 15, cc = c & 31, ob = rr * 64 + cc * 2; return st * 1024 + (ob ^ (((ob >> 9) & 1) << 5)); }
__host__ __device__ __forceinline__ void stage_rc(int b, int& R, int& C) { const int st = b / 1024, sb = b % 1024, swz = sb ^ (((sb >> 9) & 1) << 5); R = (st >> 1) * 16 + swz / 64; C = (st & 1) * 32 + (swz % 64) / 2; }

struct Unit { int pm, pn, hf; };
struct Gemm { const bf16_t* A; const bf16_t* Bt; int K; };

template <int MODE> struct Order {
    static constexpr bool GATHER = (MODE == 1);
    int nM, nN, nwg, G, c; const int* idx; long bstride;
    __device__ __forceinline__ void init(int nM_, int nN_, int G_, int c_, const int* idx_, long bstride_) { nM = nM_; nN = nN_; nwg = nM * nN; G = G_; c = c_; idx = idx_; bstride = bstride_; }
    __device__ __forceinline__ bool next(int i, Unit& u) const {
        const long L = (long)i * G + c; if (L >= nwg) return false;
        int wgid = (int)L; { const int q = nwg / NXCD, r = nwg % NXCD, xcd = wgid % NXCD, off = wgid / NXCD; wgid = (xcd < r ? xcd * (q + 1) : r * (q + 1) + (xcd - r) * q) + off; }
        const int nig = WGM * nN, gid = wgid / nig, fm = gid * WGM, gsz = (nM - fm) < WGM ? (nM - fm) : WGM;
        u.pm = fm + ((wgid % nig) % gsz); u.pn = (wgid % nig) / gsz; u.hf = (MODE != 0 && (u.pm % 17) == 16) ? 1 : 0; return true;
    }
    __device__ __forceinline__ unsigned arow(const Unit& u, int r) const { if (MODE == 1) return (unsigned)idx[u.pm * BM + r]; return (unsigned)(u.pm * BM + r); }
    __device__ __forceinline__ long bbase(const Unit& u, int K) const { long o = (long)u.pn * BM * K; if (MODE != 0) o += (long)(u.pm / 17) * bstride; return o; }
};

template <int MODE> struct OrderExp {
    static constexpr bool GATHER = (MODE == 1);
    int nN, G, c0; const int* idx; long bstride;
    __device__ __forceinline__ void init(int nN_, int G_, int c_, const int* idx_, long bstride_) { nN = nN_; G = G_; c0 = c_; idx = idx_; bstride = bstride_; }
    __device__ __forceinline__ bool next(int i0, Unit& u) const {
        const int v = i0 * G + c0, i = v >> 8, c = v & 255;
        const int x = c & 7, slot = c >> 3, per = 32 / nN, nfull = 256 / (8 * per);
        if (i > nfull) return false;
        if (i < nfull) { u.pn = slot / per; const int f = (i * 8 + x) * per + (slot % per); u.pm = (f >> 4) * 17 + (f & 15); u.hf = 0; return true; }
        if (i == nfull && slot < 2 * nN) { u.pn = slot >> 1; u.pm = (x * 2 + (slot & 1)) * 17 + 16; u.hf = 1; return true; }
        return false;
    }
    __device__ __forceinline__ unsigned arow(const Unit& u, int r) const { if (MODE == 1) return (unsigned)idx[u.pm * BM + r]; return (unsigned)(u.pm * BM + r); }
    __device__ __forceinline__ long bbase(const Unit& u, int K) const { return (long)u.pn * BM * K + (long)(u.pm / 17) * bstride; }
};

template <class Epi, class Sched>
__device__ __forceinline__ void gemm_phase(LAS unsigned char* lds, const Gemm g, const Sched& S, const Epi& E) {
    int tid = threadIdx.x; asm volatile("" : "+v"(tid));
    const int wid = __builtin_amdgcn_readfirstlane(tid >> 6), wr = wid >> 2, wc = wid & 3;
    const int K = g.K, nt = K / BK;
    unsigned voffB[2];
    { const int lane = tid & 63, fr = lane & 15, fq = lane >> 4; (void)fr; (void)fq; }
#pragma unroll
    for (int i = 0; i < 2; ++i) { int R, Cc; stage_rc(tid * 16 + i * 8192, R, Cc); voffB[i] = (unsigned)(R * K + Cc) * 2u; }
    const size_t kstep = (size_t)(BK * 2);
    const size_t hstep = (size_t)HALF * K * 2;
    const unsigned ldsw = (unsigned)wid * 1024u;
    const int aoff = lds_byte(wr * 64 + (tid & 15), ((tid & 63) >> 4) * 8), boff = lds_byte(wc * 32 + (tid & 15), ((tid & 63) >> 4) * 8);
#define PG8_SA(b, h) (((b) * 2 + (h)) * HTB)
#define PG8_SB(b, h) ((4 + (b) * 2 + (h)) * HTB)
#define PG8_STAGE(bufoff, gbase, voff) do { _Pragma("unroll") for (int _i = 0; _i < 2; ++_i) \
        __builtin_amdgcn_global_load_lds((const unsigned*)((const char*)(gbase) + (voff)[_i]), (LAS unsigned*)(lds + (bufoff) + ldsw + _i * 8192), 16, 0, 0); } while (0)
#define PG8_LDA(dst, b, h) do { _Pragma("unroll") for (int m = 0; m < 4; ++m) _Pragma("unroll") for (int k = 0; k < 2; ++k) dst[m][k] = *(const LAS bf16x8*)(lds + PG8_SA(b, h) + aoff + m * 2048 + k * 1024); } while (0)
#define PG8_LDB(dst, b, h) do { _Pragma("unroll") for (int n = 0; n < 2; ++n) _Pragma("unroll") for (int k = 0; k < 2; ++k) dst[n][k] = *(const LAS bf16x8*)(lds + PG8_SB(b, h) + boff + n * 2048 + k * 1024); } while (0)
#define PG8_MMA(ai, bj, At, Bt) do { __builtin_amdgcn_s_setprio(1); _Pragma("unroll") for (int m = 0; m < 4; ++m) _Pragma("unroll") for (int n = 0; n < 2; ++n) _Pragma("unroll") for (int k = 0; k < 2; ++k) \
        acc[ai][bj][m][n] = __builtin_amdgcn_mfma_f32_16x16x32_bf16(Bt[n][k], At[m][k], acc[ai][bj][m][n], 0, 0, 0); __builtin_amdgcn_s_setprio(0); } while (0)
#define PG8_WAIT_V(n) asm volatile("s_waitcnt vmcnt(" #n ")" ::: "memory")
#define PG8_WAIT_L(n) asm volatile("s_waitcnt lgkmcnt(" #n ")" ::: "memory")
#define PG8_BAR __builtin_amdgcn_s_barrier()
#define PG8_SCHED __builtin_amdgcn_sched_barrier(0)
#define PG8_ROWOFFS(dst, u, tq) do { _Pragma("unroll") for (int _i = 0; _i < 2; ++_i) { int _R, _C; stage_rc((tq) * 16 + _i * 8192, _R, _C); _Pragma("unroll") for (int _h = 0; _h < 2; ++_h) dst[_h][_i] = (S.arow(u, _h * HALF + _R) * (unsigned)K + (unsigned)_C) * 2u; } } while (0)
    Unit cur, nxt; int ui = 0;
    if (!S.next(0, cur)) return;
    float zf = 0.f; asm volatile("" : "+v"(zf));
    f32x4 acc[2][2][4][2];
#pragma unroll
    for (int a = 0; a < 2; ++a)
#pragma unroll
        for (int b = 0; b < 2; ++b)
#pragma unroll
            for (int m = 0; m < 4; ++m)
#pragma unroll
                for (int n = 0; n < 2; ++n) acc[a][b][m][n] = (f32x4){zf, zf, zf, zf};
    bf16x8 At[4][2], B0[2][2], B1[2][2];
    unsigned vcur[2][2];
    if constexpr (Sched::GATHER) { PG8_ROWOFFS(vcur, cur, tid); }
    const char* const Ab = (const char*)g.A;
    const char* cA = Sched::GATHER ? Ab : Ab + (size_t)(unsigned)__builtin_amdgcn_readfirstlane((int)S.arow(cur, 0)) * K * 2;
#define PG8_STAGEA(bufoff, ptr, h) do { if constexpr (Sched::GATHER) { PG8_STAGE(bufoff, ptr, vcur[h]); } else { PG8_STAGE(bufoff, (ptr) + (h) * hstep, voffB); } } while (0)
    const char* cB = (const char*)g.Bt + (size_t)S.bbase(cur, K) * 2;
    PG8_STAGE(PG8_SB(0, 0), cB, voffB); PG8_STAGE(PG8_SB(0, 1), cB + hstep, voffB); PG8_STAGEA(PG8_SA(0, 0), cA, 0); PG8_STAGEA(PG8_SA(0, 1), cA, 1);
    if (wr == 1) PG8_BAR;
    PG8_WAIT_V(2); PG8_BAR;
    PG8_STAGE(PG8_SB(1, 0), cB + kstep, voffB); PG8_STAGEA(PG8_SA(1, 0), cA + kstep, 0); PG8_STAGE(PG8_SB(1, 1), cB + hstep + kstep, voffB);
    PG8_WAIT_V(6); PG8_BAR;
    for (;;) {
        const bool has_next = S.next(ui + 1, nxt);
        const char* nB = has_next ? (const char*)g.Bt + (size_t)S.bbase(nxt, K) * 2 : cB;
        const char* nA = (Sched::GATHER || !has_next) ? cA : Ab + (size_t)(unsigned)__builtin_amdgcn_readfirstlane((int)S.arow(nxt, 0)) * K * 2;
#pragma unroll 1
        for (int t = 0; t < nt; t += 2) {
            const bool last = (t == nt - 2);
            const char* a1 = cA + (size_t)(t + 1) * kstep;
            const char* a2 = last ? nA : cA + (size_t)(t + 2) * kstep; const char* b2 = last ? nB : cB + (size_t)(t + 2) * kstep;
            const char* a3 = a2 + kstep; const char* b3 = b2 + kstep;
            PG8_LDB(B0, 0, 0); PG8_LDB(B1, 0, 1); PG8_SCHED; PG8_LDA(At, 0, 0); PG8_STAGEA(PG8_SA(1, 1), a1, 1);
            PG8_WAIT_V(8); PG8_WAIT_L(0); PG8_BAR; PG8_MMA(0, 0, At, B0); PG8_MMA(0, 1, At, B1); PG8_BAR; PG8_SCHED;
            if constexpr (Sched::GATHER) { if (last && has_next) { int tq = tid; asm volatile("" : "+v"(tq)); PG8_ROWOFFS(vcur, nxt, tq); } }
            PG8_LDA(At, 0, 1); PG8_STAGE(PG8_SB(0, 0), b2, voffB); PG8_STAGE(PG8_SB(0, 1), b2 + hstep, voffB); PG8_STAGEA(PG8_SA(0, 0), a2, 0);
            PG8_WAIT_V(8); PG8_WAIT_L(0); PG8_BAR; if (!cur.hf) { PG8_MMA(1, 0, At, B0); PG8_MMA(1, 1, At, B1); } PG8_BAR; PG8_SCHED;
            PG8_LDB(B0, 1, 0); PG8_LDB(B1, 1, 1); PG8_SCHED; PG8_LDA(At, 1, 0); PG8_STAGEA(PG8_SA(0, 1), a2, 1);
            PG8_WAIT_V(8); PG8_WAIT_L(0); PG8_BAR; PG8_MMA(0, 0, At, B0); PG8_MMA(0, 1, At, B1); PG8_BAR; PG8_SCHED;
            PG8_LDA(At, 1, 1); PG8_STAGE(PG8_SB(1, 0), b3, voffB); PG8_STAGE(PG8_SB(1, 1), b3 + hstep, voffB); PG8_STAGEA(PG8_SA(1, 0), a3, 0);
            PG8_WAIT_V(8); PG8_WAIT_L(0); PG8_BAR; if (!cur.hf) { PG8_MMA(1, 0, At, B0); PG8_MMA(1, 1, At, B1); } PG8_BAR; PG8_SCHED;
        }
        if (wr == 0) PG8_BAR;
        { int tz = tid; asm volatile("" : "+v"(tz)); const int ln = tz & 63; E(acc, cur, wr, wc, ln & 15, ln >> 4); }
        if (!has_next) break;
#pragma unroll
        for (int a = 0; a < 2; ++a)
#pragma unroll
            for (int b = 0; b < 2; ++b)
#pragma unroll
                for (int m = 0; m < 4; ++m)
#pragma unroll
                    for (int n = 0; n < 2; ++n) acc[a][b][m][n] = (f32x4){zf, zf, zf, zf};
        cur = nxt; cB = nB; cA = nA; ++ui;
        if (wr == 1) PG8_BAR;
    }
    PG8_WAIT_V(0);
    PG8_BAR;
#undef PG8_SA
#undef PG8_SB
#undef PG8_STAGE
#undef PG8_LDA
#undef PG8_LDB
#undef PG8_MMA
#undef PG8_WAIT_V
#undef PG8_WAIT_L
#undef PG8_BAR
#undef PG8_SCHED
#undef PG8_ROWOFFS
#undef PG8_STAGEA
}

#define EPI_LOOP for (int ai = 0; ai < 2; ++ai) for (int m = 0; m < 4; ++m) for (int bj = 0; bj < 2; ++bj) for (int n = 0; n < 2; ++n)
__device__ __forceinline__ int colw_of(int fq) { return (fq & 1) * 16 + (fq >> 1) * 8; }
__device__ __forceinline__ void st_pair_bf16(bf16_t* p  , f32x4 v0, f32x4 v1) {
    const unsigned a0 = pk2(v0[0], v0[1]), a1 = pk2(v0[2], v0[3]), b0 = pk2(v1[0], v1[1]), b1 = pk2(v1[2], v1[3]);
    const auto r0 = __builtin_amdgcn_permlane16_swap(a0, b0, false, false); const auto r1 = __builtin_amdgcn_permlane16_swap(a1, b1, false, false);
    u32x4 o; o.x = r0[0]; o.y = r1[0]; o.z = r0[1]; o.w = r1[1]; *(u32x4*)p = o;
}
struct EpiBf16 {
    bf16_t* O; int ldc;
    __device__ __forceinline__ void operator()(const f32x4 (&acc)[2][2][4][2], const Unit& u, int wr, int wc, int fr, int fq) const {
        const int row0 = u.pm * BM + wr * 64 + fr, colg = u.pn * BM + wc * 32 + colw_of(fq);
#pragma unroll
        for (int ai = 0; ai < 2; ++ai)
#pragma unroll
            for (int m = 0; m < 4; ++m) { bf16_t* rowp = O + (size_t)(row0 + ai * HALF + m * 16) * ldc + colg;
#pragma unroll
                for (int bj = 0; bj < 2; ++bj) st_pair_bf16(rowp + bj * HALF, acc[ai][bj][m][0], acc[ai][bj][m][1]); }
    }
};
struct EpiOdd {
    bf16_t* P; bf16_t* Q; bf16_t* KA; const float* rope;
    __device__ __forceinline__ void operator()(const f32x4 (&acc)[2][2][4][2], const Unit& u, int wr, int wc, int fr, int fq) const {
        const int row0 = u.pm * BM + wr * 64 + fr, col0 = u.pn * BM + wc * 32 + 4 * fq;
        if (u.pn >= 6) {
#pragma unroll
            for (int ai = 0; ai < 2; ++ai)
#pragma unroll
                for (int m = 0; m < 4; ++m) { bf16_t* rowp = P + (size_t)(row0 + ai * HALF + m * 16) * P_LD + col0;
#pragma unroll
                    for (int bj = 0; bj < 2; ++bj)
#pragma unroll
                        for (int n = 0; n < 2; ++n) { const f32x4 v = acc[ai][bj][m][n]; u32x2 o; o.x = pk2(v[0], v[1]); o.y = pk2(v[2], v[3]); *(u32x2*)(rowp + bj * HALF + n * 16) = o; } }
            return;
        }
        const bool isk = u.pn >= 3, isctx = u.pm >= NLAT / BM; const int axis = wc & 1;
        const int cq = col0 - (isk ? 768 : 0);
        f32x4 csr[2][4], snr[2][4];
#pragma unroll
        for (int ai = 0; ai < 2; ++ai)
#pragma unroll
            for (int m = 0; m < 4; ++m) { const int row = row0 + ai * HALF + m * 16; csr[ai][m] = (f32x4){1.f, 1.f, 1.f, 1.f}; snr[ai][m] = (f32x4){0.f, 0.f, 0.f, 0.f};
                if (!isctx) { const int t = row & (TT - 1); const int pos = axis ? 128 + (t & 63) : (t >> 6);
                    csr[ai][m] = *(const f32x4*)(rope + pos * 16 + 4 * fq); snr[ai][m] = *(const f32x4*)(rope + 192 * 16 + pos * 16 + 4 * fq); } }
#pragma unroll
        for (int ai = 0; ai < 2; ++ai)
#pragma unroll
            for (int m = 0; m < 4; ++m) { const int row = row0 + ai * HALF + m * 16;
                const f32x4 cs = csr[ai][m], sn = snr[ai][m]; size_t orow;
                if (!isctx) { const int t = row & (TT - 1); orow = isk ? (size_t)(row >> 13) * LKEYS + CTXL + t : (size_t)row; }
                else { const int rc = row - NLAT; orow = isk ? (size_t)(rc >> 8) * LKEYS + (rc & 255) : (size_t)row; }
                bf16_t* op = (isk ? KA : Q) + orow * 768 + cq; const float sc = isk ? 1.f : QSCALE;
#pragma unroll
                for (int bj = 0; bj < 2; ++bj) { const f32x4 x1 = acc[ai][bj][m][0], x2 = acc[ai][bj][m][1];
                    const f32x4 o1 = (x1 * cs - x2 * sn) * sc, o2 = (x1 * sn + x2 * cs) * sc;
                    u32x2 a; a.x = pk2(o1[0], o1[1]); a.y = pk2(o1[2], o1[3]); *(u32x2*)(op + bj * HALF) = a;
                    u32x2 b; b.x = pk2(o2[0], o2[1]); b.y = pk2(o2[2], o2[3]); *(u32x2*)(op + bj * HALF + 16) = b; } }
    }
};
struct EpiRes {
    float* X; const float* modl; const float* xin; const float* cin;
    __device__ __forceinline__ void operator()(const f32x4 (&acc)[2][2][4][2], const Unit& u, int wr, int wc, int fr, int fq) const {
        const int row0 = u.pm * BM + wr * 64 + fr, col0 = u.pn * BM + wc * 32 + 4 * fq;
        const int mi = (u.pm * BM < NLAT) ? (u.pm * BM) / TT : 4;
        const float* gate = modl + mi * 6144 + 2 * DM;
        const float* rsrc = (u.pm * BM < NLAT) ? xin : cin - (size_t)NLAT * DM;
        f32x4 gv[2][2];
#pragma unroll
        for (int bj = 0; bj < 2; ++bj)
#pragma unroll
            for (int n = 0; n < 2; ++n) gv[bj][n] = *(const f32x4*)(gate + col0 + bj * HALF + n * 16);
#pragma unroll
        for (int ai = 0; ai < 2; ++ai) { f32x4 xr[4][2][2];
#pragma unroll
            for (int m = 0; m < 4; ++m) { const float* rowp = rsrc + (size_t)(row0 + ai * HALF + m * 16) * DM + col0;
#pragma unroll
                for (int bj = 0; bj < 2; ++bj)
#pragma unroll
                    for (int n = 0; n < 2; ++n) xr[m][bj][n] = *(const f32x4*)(rowp + bj * HALF + n * 16); }
#pragma unroll
            for (int m = 0; m < 4; ++m) { float* rowp = X + (size_t)(row0 + ai * HALF + m * 16) * DM + col0;
#pragma unroll
                for (int bj = 0; bj < 2; ++bj)
#pragma unroll
                    for (int n = 0; n < 2; ++n) *(f32x4*)(rowp + bj * HALF + n * 16) = xr[m][bj][n] * ALPHA_DN + gv[bj][n] * acc[ai][bj][m][n]; } }
    }
};
struct EpiSwiGLU {
    bf16_t* HID;
    __device__ __forceinline__ void operator()(const f32x4 (&acc)[2][2][4][2], const Unit& u, int wr, int wc, int fr, int fq) const {
        const int row0 = u.pm * BM + wr * 64 + fr, f0 = u.pn * HALF + wc * 32 + 4 * fq;
#pragma unroll
        for (int ai = 0; ai < 2; ++ai) if (ai == 0 || !u.hf)
#pragma unroll
            for (int m = 0; m < 4; ++m) { bf16_t* rowp = HID + (size_t)(row0 + ai * HALF + m * 16) * D_EXP + u.pn * HALF + wc * 32 + colw_of(fq); f32x4 hh[2];
#pragma unroll
                for (int n = 0; n < 2; ++n) { const f32x4 a = acc[ai][0][m][n], b = acc[ai][1][m][n];
#pragma unroll
                    for (int j = 0; j < 4; ++j) hh[n][j] = a[j] * __builtin_amdgcn_rcpf(1.f + __expf(-a[j])) * b[j]; }
                st_pair_bf16(rowp, hh[0], hh[1]); }
    }
};
struct EpiYE {
    bf16_t* YE; const float* gate;
    __device__ __forceinline__ void operator()(const f32x4 (&acc)[2][2][4][2], const Unit& u, int wr, int wc, int fr, int fq) const {
        const int row0 = u.pm * BM + wr * 64 + fr, col0 = u.pn * BM + wc * 32 + 4 * fq;
        float gts[2][4];
#pragma unroll
        for (int ai = 0; ai < 2; ++ai)
#pragma unroll
            for (int m = 0; m < 4; ++m) gts[ai][m] = gate[row0 + ai * HALF + m * 16];
#pragma unroll
        for (int ai = 0; ai < 2; ++ai) if (ai == 0 || !u.hf)
#pragma unroll
            for (int m = 0; m < 4; ++m) { const int row = row0 + ai * HALF + m * 16; const float gt = gts[ai][m]; bf16_t* rowp = YE + (size_t)row * DM + (col0 - 4 * fq + colw_of(fq));
#pragma unroll
                for (int bj = 0; bj < 2; ++bj) st_pair_bf16(rowp + bj * HALF, acc[ai][bj][m][0] * gt, acc[ai][bj][m][1] * gt); }
    }
};
struct EpiLora {
    unsigned char* SCN; bf16_t* G; const float* decay0; const float* a0; const float* kalpha;
    __device__ __forceinline__ void operator()(const f32x4 (&acc)[2][2][4][2], const Unit& u, int wr, int wc, int fr, int fq) const {
        const int row0 = u.pm * BM + wr * 64 + fr;
        const int seg = u.pn / 3, cb = (u.pn % 3) * BM + wc * 32 + 4 * fq;
        f32x4 par0[2][2], par1[2][2];
#pragma unroll
        for (int bj = 0; bj < 2; ++bj)
#pragma unroll
            for (int n = 0; n < 2; ++n) { const int col = cb + bj * HALF + n * 16; par0[bj][n] = (f32x4){0.f, 0.f, 0.f, 0.f}; par1[bj][n] = par0[bj][n];
                if (seg < 2) par0[bj][n] = *(const f32x4*)(decay0 + seg * 768 + col);
                else if (seg < 4) { par0[bj][n] = *(const f32x4*)(a0 + (seg - 2) * 768 + col); par1[bj][n] = *(const f32x4*)(kalpha + col); } }
#pragma unroll
        for (int bj = 0; bj < 2; ++bj)
#pragma unroll
            for (int n = 0; n < 2; ++n) {
                const int col = cb + bj * HALF + n * 16, head = col >> 6, kx = col & 63;
                if (seg < 2) {
                    const f32x4 d0 = par0[bj][n];
#pragma unroll
                    for (int ai = 0; ai < 2; ++ai)
#pragma unroll
                        for (int m = 0; m < 4; ++m) { const int row = row0 + ai * HALF + m * 16; f32x4 w;
#pragma unroll
                            for (int j = 0; j < 4; ++j) { const float lw = -DECAY_SCALE * sigmoidf_(d0[j] + acc[ai][bj][m][n][j]); w[j] = CHUNKED_SCAN ? lw : __expf(lw); }
                            *(f32x4*)(SCN + (size_t)(row * 12 + head) * SC_REC + SC_W + seg * 256 + kx * 4) = w; __builtin_amdgcn_sched_barrier(0); }
                } else if (seg < 4) {
                    const int d = seg - 2;
                    const f32x4 a00 = par0[bj][n], kal = par1[bj][n];
                    u32x2 kkr[2][4], ksr[2][4];
#pragma unroll
                    for (int ai = 0; ai < 2; ++ai)
#pragma unroll
                        for (int m = 0; m < 4; ++m) { const unsigned char* base = SCN + (size_t)((row0 + ai * HALF + m * 16) * 12 + head) * SC_REC + kx * 2;
                            kkr[ai][m] = *(const u32x2*)(base + SC_KK); ksr[ai][m] = *(const u32x2*)(base + SC_KR + 256 * d); }
#pragma unroll
                    for (int ai = 0; ai < 2; ++ai)
#pragma unroll
                        for (int m = 0; m < 4; ++m) { const int row = row0 + ai * HALF + m * 16; unsigned char* base = SCN + (size_t)(row * 12 + head) * SC_REC + kx * 2;
                            const f32x4 kk = {bflo(kkr[ai][m].x), bfhi(kkr[ai][m].x), bflo(kkr[ai][m].y), bfhi(kkr[ai][m].y)}; const f32x4 ks = {bflo(ksr[ai][m].x), bfhi(ksr[ai][m].x), bflo(ksr[ai][m].y), bfhi(ksr[ai][m].y)}; f32x4 bb, kr;
#pragma unroll
                            for (int j = 0; j < 4; ++j) { const float a = sigmoidf_(a00[j] + acc[ai][bj][m][n][j]); bb[j] = kk[j] * a; kr[j] = ks[j] * (1.f + (a - 1.f) * kal[j]); }
                            st4bf_(base + SC_B + 256 * d, bb); st4bf_(base + SC_KR + 256 * d, kr); __builtin_amdgcn_sched_barrier(0); }
                } else {
#pragma unroll
                    for (int ai = 0; ai < 2; ++ai)
#pragma unroll
                        for (int m = 0; m < 4; ++m) { const int row = row0 + ai * HALF + m * 16; const f32x4 v = acc[ai][bj][m][n]; u32x2 o; o.x = pk2(v[0], v[1]); o.y = pk2(v[2], v[3]);
                            *(u32x2*)(G + (size_t)row * 768 + col) = o; }
                }
            }
    }
};
}

struct Args { const float* in[37]; float* out; unsigned char* ws; int lo, hi; };
enum { I_X = 0, I_C, I_CTX, I_CCTX, I_WMOD, I_BMOD, I_LNG, I_LNB, I_EWIN, I_EWOUT, I_CONVW, I_MU, I_DUP, I_D0, I_AUP, I_A0, I_GUP, I_KXI, I_KAL, I_RBON, I_GNG, I_GNB,
       I_OWIN, I_OWOUT, I_LQ1, I_LK1, I_LQ2, I_LK2, I_SUBG, I_GLNG, I_GLNB, I_GWS, I_GBS, I_WR, I_WE1, I_WE3, I_WE2 };

struct Ctx {
    LAS unsigned char* lds;
    int tid, lane, wave, G, vcu, gw, NGW;
};
__device__ __forceinline__ void mkctx(Ctx& C, LAS unsigned char* lds) {
    int tid = threadIdx.x; asm volatile("" : "+v"(tid));
    C.lds = lds; C.tid = tid; C.lane = tid & 63; C.wave = __builtin_amdgcn_readfirstlane(tid >> 6);
    C.G = gridDim.x; { const int bx = blockIdx.x; C.vcu = (C.G % 8 == 0) ? (bx % 8) * (C.G / 8) + bx / 8 : bx; }
    C.gw = blockIdx.x * NWAVES + C.wave; C.NGW = C.G * NWAVES;
}
#define GLOBAL_PTR(T, v) ((T*)(__attribute__((address_space(1))) T*)(v))
__device__ __forceinline__ void ldargs(Args& A, LAS unsigned char* lds) {
    LAS const u32x2* tb = (LAS const u32x2*)(lds + LDS_PTAB); asm volatile("" : "+v"(tb));
#pragma unroll
    for (int i = 0; i < 37; ++i) { const u32x2 v = tb[i]; A.in[i] = GLOBAL_PTR(const float, ((unsigned long long)(unsigned)__builtin_amdgcn_readfirstlane((int)v.y) << 32) | (unsigned)__builtin_amdgcn_readfirstlane((int)v.x)); }
    { const u32x2 v = tb[37]; A.out = GLOBAL_PTR(float, ((unsigned long long)(unsigned)__builtin_amdgcn_readfirstlane((int)v.y) << 32) | (unsigned)__builtin_amdgcn_readfirstlane((int)v.x)); }
    { const u32x2 v = tb[38]; A.ws = GLOBAL_PTR(unsigned char, ((unsigned long long)(unsigned)__builtin_amdgcn_readfirstlane((int)v.y) << 32) | (unsigned)__builtin_amdgcn_readfirstlane((int)v.x)); }
    A.lo = 0; A.hi = 0;
}
__device__ __forceinline__ int row_mi(int row) { return row < NLAT ? (row >> 13) : 4; }

__device__ __forceinline__ void phase_init(const Ctx& C, const Args& A) {
    unsigned char* ws = A.ws;
    float* MOD = (float*)(ws + WS_MOD);
    LAS float* sv = (LAS float*)C.lds;
    LAS float* red = sv + 5 * 1024;
    for (int i = C.tid; i < 5 * 1024; i += NTHR) { const int v = i >> 10, k = i & 1023; const float c = (v < 4) ? A.in[I_C][v * DM + k] : A.in[I_CCTX][k]; sv[i] = c / (1.f + __expf(-c)); }
    __syncthreads();
    const int j = C.tid & 127, kp = C.tid >> 7;
    for (int it = blockIdx.x; it < DEPTH * 48; it += C.G) {
        const int l = it / 48, cg = it % 48, col = cg * 128 + j;
        const float* W = A.in[I_WMOD] + (size_t)l * DM * 6144 + col;
        float a0 = 0.f, a1 = 0.f, a2 = 0.f, a3 = 0.f, a4 = 0.f;
#pragma unroll 32
        for (int k = kp * 256; k < kp * 256 + 256; ++k) { const float w = W[(size_t)k * 6144];     a0 += sv[k] * w; a1 += sv[1024 + k] * w; a2 += sv[2048 + k] * w; a3 += sv[3072 + k] * w; a4 += sv[4096 + k] * w; }
        red[(kp * 5 + 0) * 128 + j] = a0; red[(kp * 5 + 1) * 128 + j] = a1; red[(kp * 5 + 2) * 128 + j] = a2; red[(kp * 5 + 3) * 128 + j] = a3; red[(kp * 5 + 4) * 128 + j] = a4;
        __syncthreads();
        for (int o = C.tid; o < 5 * 128; o += NTHR) { const int v = o >> 7, jj = o & 127; const int cc = cg * 128 + jj;
            const float s = red[(0 * 5 + v) * 128 + jj] + red[(1 * 5 + v) * 128 + jj] + red[(2 * 5 + v) * 128 + jj] + red[(3 * 5 + v) * 128 + jj];
            MOD[((size_t)l * 5 + v) * 6144 + cc] = s + A.in[I_BMOD][l * 6144 + cc]; }
        __syncthreads();
    }
    if (blockIdx.x == C.G - 1) { float* rope = (float*)(ws + WS_ROPE);
        for (int i = C.tid; i < 192 * 16; i += NTHR) { const int pos = i >> 4, j = i & 15; const float ang = (float)(pos < 128 ? pos : pos - 128) * powf(10000.f, -(float)j * (1.f / 16.f));
            rope[i] = cosf(ang); rope[192 * 16 + i] = sinf(ang); } }
}

__device__ __forceinline__ void transpose_item(const float* W, int ldw, int k0, int n0, bf16_t* WT, int ldt, int drow0, LAS float* scr, int lane) {
    { float v[64]; const float* src = W + (size_t)k0 * ldw + n0 + lane;
#pragma unroll
      for (int k = 0; k < 64; ++k) v[k] = __builtin_nontemporal_load(src + (size_t)k * ldw);
#pragma unroll
      for (int k = 0; k < 64; ++k) scr[k * 65 + lane] = v[k]; }
    asm volatile("s_waitcnt lgkmcnt(0)" ::: "memory");
    const int c = lane & 7;
#pragma unroll
    for (int j = 0; j < 8; ++j) { const int n = (lane >> 3) + 8 * j; const LAS float* s = scr + (8 * c) * 65 + n;
        u32x4 o; o.x = pk2(s[0 * 65], s[1 * 65]); o.y = pk2(s[2 * 65], s[3 * 65]); o.z = pk2(s[4 * 65], s[5 * 65]); o.w = pk2(s[6 * 65], s[7 * 65]);
        *(u32x4*)(WT + (size_t)(drow0 + n) * ldt + k0 + 8 * c) = o; }
    asm volatile("s_waitcnt lgkmcnt(0)" ::: "memory");
}
constexpr int XW_IN_HI = 3200, XW_OUT_HI = 7040, XW_TK_HI = 9088;
constexpr int YW_IN_HI = 1344, YW_OF_HI = 6144, YW_OUT_HI = 9984, YW_TK_HI = 12032;
__device__ __forceinline__ void conv_items(const Ctx& C, const Args& A, int l, int gw, int NGW, bool do_in, bool do_out, bool do_exp, int lo = 0, int hi = 1 << 30) {
    unsigned char* ws = A.ws;
    const int i2 = l >> 1; const bool odd = (l & 1);
    LAS float* scr = (LAS float*)C.lds + C.wave * (64 * 65);
    bf16_t* WIN = (bf16_t*)(ws + WS_WIN); bf16_t* WOUT = (bf16_t*)(ws + WS_WOUT); bf16_t* WE13 = (bf16_t*)(ws + WS_WE13 + (size_t)(l & 1) * WE13_BYTES); bf16_t* WE2 = (bf16_t*)(ws + WS_WE2 + (size_t)(l & 1) * WE2_BYTES);
    const int nin = odd ? D_IN_ODD : D_IN_EVEN;
    const float* win = odd ? A.in[I_OWIN] + (size_t)i2 * DM * D_IN_ODD : A.in[I_EWIN] + (size_t)i2 * DM * D_IN_EVEN;
    const float* wout = odd ? A.in[I_OWOUT] + (size_t)i2 * DM * DM : A.in[I_EWOUT] + (size_t)i2 * DM * DM;
    const int n_in = do_in ? 16 * (nin / 64) : 0, n_out = do_out ? 16 * 16 : 0, n_e13 = do_exp ? NEXP * 2 * 16 * 32 : 0, n_e2 = do_exp ? NEXP * 32 * 16 : 0;
    const int total = (n_in + n_out + n_e13 + n_e2) < hi ? (n_in + n_out + n_e13 + n_e2) : hi;
    for (int it = lo + gw; it < total; it += NGW) {
        int r = it;
        if (r < n_in) { const int nb = nin / 64, kb = r / nb, nn = r % nb; transpose_item(win, nin, kb * 64, nn * 64, WIN, DM, nn * 64, scr, C.lane); continue; } r -= n_in;
        if (r < n_out) { const int kb = r / 16, nn = r % 16; transpose_item(wout, DM, kb * 64, nn * 64, WOUT, DM, nn * 64, scr, C.lane); continue; } r -= n_out;
        if (r < n_e13) { const int e = r / 1024, q = r % 1024, mat = q / 512, q2 = q % 512, kb = q2 / 32, nn = q2 % 32;
            const float* W = (mat ? A.in[I_WE3] : A.in[I_WE1]) + ((size_t)l * NEXP + e) * DM * D_EXP;
            const int f0 = nn * 64; const int drow = (f0 >> 7) * 256 + mat * 128 + (f0 & 127);
            transpose_item(W, D_EXP, kb * 64, f0, WE13 + (size_t)e * 4096 * DM, DM, drow, scr, C.lane); continue; } r -= n_e13;
        { const int e = r / 512, q = r % 512, kb = q / 16, nn = q % 16;
            const float* W = A.in[I_WE2] + ((size_t)l * NEXP + e) * D_EXP * DM;
            transpose_item(W, DM, kb * 64, nn * 64, WE2 + (size_t)e * DM * D_EXP, D_EXP, nn * 64, scr, C.lane); }
    }
}
__device__ __forceinline__ void phase_conv(const Ctx& C, const Args& A, int l) {
    unsigned char* ws = A.ws;
    const int i2 = l >> 1; const bool odd = (l & 1);
    bf16_t* WIN = (bf16_t*)(ws + WS_WIN);
    const bool early = CHUNKED_SCAN && odd;
    if (l > 0) { if (early || !CHUNKED_SCAN) conv_items(C, A, l, C.gw, C.NGW, !early, true, !early);
                 else { conv_items(C, A, l, C.gw, C.NGW, true, true, false); conv_items(C, A, l, C.gw, C.NGW, false, false, true, YW_TK_HI); } }
    if (!odd) {
        u32x4* z = (u32x4*)(WIN + (size_t)D_IN_EVEN * DM);
        unsigned zz = 0u; asm volatile("" : "+v"(zz));
        for (int i = blockIdx.x * NTHR + C.tid; i < (D_IN_EVEN_PAD - D_IN_EVEN) * DM / 8; i += C.G * NTHR) z[i] = (u32x4){zz, zz, zz, zz};
        bf16_t* WL = (bf16_t*)(ws + WS_WLORA);
        const float* dup = A.in[I_DUP] + (size_t)i2 * 2 * 64 * 768; const float* aup = A.in[I_AUP] + (size_t)i2 * 2 * 64 * 768; const float* gup = A.in[I_GUP] + (size_t)i2 * 128 * 768;
        for (int i = blockIdx.x * NTHR + C.tid; i < LORA_N * LORA_K; i += C.G * NTHR) {
            const int kk = i / LORA_N, n = i % LORA_N, seg = n / 768, col = n % 768; float v = 0.f;
            if (seg == 0) { if (kk < 64) v = dup[(size_t)(0 * 64 + kk) * 768 + col]; }
            else if (seg == 1) { if (kk >= 64 && kk < 128) v = dup[(size_t)(1 * 64 + kk - 64) * 768 + col]; }
            else if (seg == 2) { if (kk >= 128 && kk < 192) v = aup[(size_t)(0 * 64 + kk - 128) * 768 + col]; }
            else if (seg == 3) { if (kk >= 192 && kk < 256) v = aup[(size_t)(1 * 64 + kk - 192) * 768 + col]; }
            else { if (kk >= 256) v = gup[(size_t)(kk - 256) * 768 + col]; }
            WL[(size_t)n * LORA_K + kk] = (bf16_t)f2bf(v);
        }
    }
}

__device__ __forceinline__ void phase_modh(const Ctx& C, const Args& A, int l) {
    bf16_t* H = (bf16_t*)(A.ws + WS_H); const float* MOD = (const float*)(A.ws + WS_MOD) + (size_t)l * 5 * 6144;
    const float* xin = A.in[I_X]; const float* cin = A.in[I_CTX] - (size_t)NLAT * DM;
#define MODH_SRC(row_) (((row_) < NLAT ? xin : cin) + (size_t)(row_) * DM)
    const int row0 = (int)(((long)C.gw * MROWS) / C.NGW), row1 = (int)(((long)(C.gw + 1) * MROWS) / C.NGW);
    f32x4 shr[4], scr_[4], xn[4]; int cmi = -1;
    if (row0 < row1) {
#pragma unroll
        for (int j = 0; j < 4; ++j) xn[j] = *(const f32x4*)(MODH_SRC(row0) + 4 * C.lane + 256 * j); }
#pragma unroll
    for (int j = 0; j < 4; ++j) { shr[j] = (f32x4){0.f, 0.f, 0.f, 0.f}; scr_[j] = shr[j]; }
    for (int row = row0; row < row1; ++row) {
        const int mi = row_mi(row);
        if (mi != cmi) { cmi = mi; const float* md = MOD + mi * 6144;
#pragma unroll
            for (int j = 0; j < 4; ++j) { const int col = 4 * C.lane + 256 * j; shr[j] = *(const f32x4*)(md + col); scr_[j] = *(const f32x4*)(md + DM + col) + 1.f; } }
        f32x4 x[4];
#pragma unroll
        for (int j = 0; j < 4; ++j) x[j] = xn[j];
        if (row + 1 < row1) {
#pragma unroll
            for (int j = 0; j < 4; ++j) xn[j] = *(const f32x4*)(MODH_SRC(row + 1) + 4 * C.lane + 256 * j); }
#pragma unroll
        for (int j = 0; j < 4; ++j) { const int col = 4 * C.lane + 256 * j; const f32x4 h = x[j] * scr_[j] + shr[j]; u32x2 o; o.x = pk2(h[0], h[1]); o.y = pk2(h[2], h[3]); *(u32x2*)(H + (size_t)row * DM + col) = o; }
    }
}

__device__ __forceinline__ f32x4 ld4bf(const bf16_t* p) { const u32x2 u = *(const u32x2*)p; return (f32x4){bflo(u.x), bfhi(u.x), bflo(u.y), bfhi(u.y)}; }
__device__ __forceinline__ void st4bf(bf16_t* p, f32x4 v) { u32x2 o; o.x = pk2(v[0], v[1]); o.y = pk2(v[2], v[3]); *(u32x2*)p = o; }
__device__ __forceinline__ void seq_info(int row, bool& hasp, bool& hasn) {
    if (row < NLAT) { const int t = row & (TT - 1); hasp = t > 0; hasn = t < TT - 1; }
    else { const int t = (row - NLAT) & (CTXL - 1); hasp = t > 0; hasn = t < CTXL - 1; }
}
struct Ef1Row { u32x2 bg, ua, ub, m[11]; };
__device__ __forceinline__ f32x4 bf4(u32x2 u) { return (f32x4){bflo(u.x), bfhi(u.x), bflo(u.y), bfhi(u.y)}; }
__device__ __forceinline__ void ef1_load(Ef1Row& R, const bf16_t* P, int row, int lane) {
    row = row < 0 ? 0 : row > MROWS - 1 ? MROWS - 1 : row;
    const bf16_t* p = P + (size_t)row * P_LD + 4 * lane;
    R.bg = *(const u32x2*)p; R.ua = *(const u32x2*)(p + 256); R.ub = *(const u32x2*)(p + 512);
#pragma unroll
    for (int it = 0; it < 11; ++it) R.m[it] = *(const u32x2*)(p + 768 + it * 256);
}
__device__ __forceinline__ void phase_ef1(const Ctx& C, const Args& A, int l) {
    const int i2 = l >> 1; unsigned char* ws = A.ws;
    const bf16_t* P = (const bf16_t*)(ws + WS_P); bf16_t* A2 = (bf16_t*)(ws + WS_A2); unsigned char* SCN = ws + WS_SCN; bf16_t* LIN = (bf16_t*)(ws + WS_LIN);
    const float* cw = A.in[I_CONVW] + (size_t)i2 * 3 * 256; const float* mu = A.in[I_MU] + (size_t)i2 * RWKV_COLS; const float* kxi = A.in[I_KXI] + (size_t)i2 * 768;
    const int j4 = 4 * C.lane;
    const f32x4 w0 = *(const f32x4*)(cw + j4), w1 = *(const f32x4*)(cw + 256 + j4), w2 = *(const f32x4*)(cw + 512 + j4);
    f32x4 mur[11], kxr[3];
#pragma unroll
    for (int it = 0; it < 11; ++it) mur[it] = (it * 256 + j4 < RWKV_COLS) ? *(const f32x4*)(mu + it * 256 + j4) : (f32x4){0.f, 0.f, 0.f, 0.f};
#pragma unroll
    for (int it = 0; it < 3; ++it) kxr[it] = *(const f32x4*)(kxi + it * 256 + j4);
    const int row0 = (int)(((long)C.gw * MROWS) / C.NGW), row1 = (int)(((long)(C.gw + 1) * MROWS) / C.NGW);
    Ef1Row Ra, Rb, Rc, Rd;
    ef1_load(Ra, P, row0 - 1, C.lane); ef1_load(Rb, P, row0, C.lane); ef1_load(Rc, P, row0 + 1, C.lane);
    for (int row = row0; row < row1; ++row) {
        ef1_load(Rd, P, row + 2, C.lane);
        bool hasp, hasn; seq_info(row, hasp, hasn);
        const float fp = hasp ? 1.f : 0.f, fn = hasn ? 1.f : 0.f;
        {
            const f32x4 bg = bf4(Rb.bg), u0 = bf4(Rb.ua) * bf4(Rb.ub), um = bf4(Ra.ua) * bf4(Ra.ub) * fp, up = bf4(Rc.ua) * bf4(Rc.ub) * fn;
            st4bf(A2 + (size_t)row * DM + j4, bg * (w0 * um + w1 * u0 + w2 * up));
        }
#pragma unroll
        for (int it = 0; it < 11; ++it) {
            const int c = it * 256 + j4;
            if (c < RWKV_COLS) {
                const f32x4 x0 = bf4(Rb.m[it]), xm = bf4(Ra.m[it]) * fp, xp = bf4(Rc.m[it]) * fn, m4 = mur[it];
                const f32x4 ps = x0 + m4 * ((xm + xp) * 0.5f - x0);
                if (it < 3) { const int head = c >> 6, kx = c & 63; st4bf_(SCN + (size_t)(row * 12 + head) * SC_REC + SC_R + kx * 2, ps); }
                else if (it < 6) { const int c1 = c - 768, head = c1 >> 6, kx = c1 & 63; const f32x4 kv = ps * kxr[it < 6 ? (it >= 3 ? it - 3 : 0) : 0];
                    const float ss = sum16(kv[0] * kv[0] + kv[1] * kv[1] + kv[2] * kv[2] + kv[3] * kv[3]); const float rn = rsqrtf(ss + 1e-12f);
                    unsigned char* base = SCN + (size_t)(row * 12 + head) * SC_REC + kx * 2;
                    st4bf_(base + SC_KK, kv * rn); st4bf_(base + SC_KR, ps); st4bf_(base + SC_KR + 256, ps); }
                else if (it < 9) { const int c1 = c - 1536, head = c1 >> 6, kx = c1 & 63; st4bf_(SCN + (size_t)(row * 12 + head) * SC_REC + SC_V + kx * 2, ps); }
                else { const int c1 = c - 2304; f32x4 o;
                    if (c1 < 128) { o = (f32x4){tanh_fast(ps[0]), tanh_fast(ps[1]), tanh_fast(ps[2]), tanh_fast(ps[3])}; }
                    else if (c1 < 256) { o = ps; }
                    else { o = (f32x4){sigmoidf_(ps[0]), sigmoidf_(ps[1]), sigmoidf_(ps[2]), sigmoidf_(ps[3])}; }
                    st4bf(LIN + (size_t)row * LORA_K + c1, o); }
            }
        }
        Ra = Rb; Rb = Rc; Rc = Rd;
    }
}

__device__ __forceinline__ int scan_row(int i, int b, int d) {
    if (d == 0) return i < CTXL ? NLAT + b * CTXL + i : b * TT + (i - CTXL);
    return i < CTXL ? NLAT + b * CTXL + (CTXL - 1 - i) : b * TT + (TT - 1 - (i - CTXL));
}
__device__ __forceinline__ float red8(float v) {
    v += __uint_as_float((unsigned)__builtin_amdgcn_update_dpp(0, (int)__float_as_uint(v), 0xB1, 0xF, 0xF, true));
    v += __uint_as_float((unsigned)__builtin_amdgcn_update_dpp(0, (int)__float_as_uint(v), 0x4E, 0xF, 0xF, true));
    v += __uint_as_float((unsigned)__builtin_amdgcn_update_dpp(0, (int)__float_as_uint(v), 0x141, 0xF, 0xF, true));
    return v;
}
__device__ __forceinline__ float red16(float v) {
    v += __uint_as_float((unsigned)__builtin_amdgcn_update_dpp(0, (int)__float_as_uint(v), 0xB1, 0xF, 0xF, true));
    v += __uint_as_float((unsigned)__builtin_amdgcn_update_dpp(0, (int)__float_as_uint(v), 0x4E, 0xF, 0xF, true));
    v += __uint_as_float((unsigned)__builtin_amdgcn_update_dpp(0, (int)__float_as_uint(v), 0x141, 0xF, 0xF, true));
    v += __uint_as_float((unsigned)__builtin_amdgcn_update_dpp(0, (int)__float_as_uint(v), 0x140, 0xF, 0xF, true));
    return v;
}
__device__ __forceinline__ void phase_scan(const Ctx& C, const Args& A) {
    for (int u = blockIdx.x; u < 192; u += C.G) {
    const int half = u & 1, d = (u >> 1) & 1, h = (u >> 2) % 12, b = u / 48;
    const unsigned char* SCN = A.ws + WS_SCN; float* Y = (float*)(A.ws + WS_Y) + (size_t)d * MROWS * 768;
    LAS float* buf = (LAS float*)C.lds; LAS float* ybuf = buf + 2 * 32 * 352;
    constexpr int NCH = LKEYS / 32;
    u32x4 st[4];
    int ps_[4], psrc[4], pdst[4]; bool pf32[4];
#pragma unroll
    for (int j = 0; j < 4; ++j) { const int p = C.tid + NTHR * j; const int s = p / 52, q = p % 52; ps_[j] = s;
        if (q < 16) { psrc[j] = SC_W + 256 * d + q * 16; pdst[j] = s * 352 + q * 4; pf32[j] = true; }
        else if (q < 48) { const int vec = (q - 16) >> 3, part = (q - 16) & 7; const int so = vec == 0 ? SC_KK : vec == 1 ? SC_B + 256 * d : vec == 2 ? SC_KR + 256 * d : SC_R;
            psrc[j] = so + part * 16; pdst[j] = s * 352 + 64 * (vec + 1) + part * 8; pf32[j] = false; }
        else { const int part = q - 48; psrc[j] = SC_V + half * 64 + part * 16; pdst[j] = s * 352 + 320 + part * 8; pf32[j] = false; } }
    const int sgn = d ? -1 : 1;
    const unsigned char* SCNh = SCN + (size_t)h * SC_REC;
#define SCAN_ROW0(c) (((c) * 32 < CTXL) ? (NLAT + b * CTXL + (d ? CTXL - 1 - (c) * 32 : (c) * 32)) : (b * TT + (d ? TT - 1 - ((c) * 32 - CTXL) : (c) * 32 - CTXL)))
#define SCAN_LOADG(c) do { const int row0_ = SCAN_ROW0(c); _Pragma("unroll") for (int j = 0; j < 4; ++j) if (j < 3 || C.tid < 1664 - 3 * NTHR) { \
        st[j] = *(const u32x4*)(SCNh + (size_t)(row0_ + sgn * ps_[j]) * SC_ROW + psrc[j]); } } while (0)
#define SCAN_STORE(bi) do { _Pragma("unroll") for (int j = 0; j < 4; ++j) if (j < 3 || C.tid < 1664 - 3 * NTHR) { LAS float* dp = buf + (bi) * (32 * 352) + pdst[j]; \
        if (pf32[j]) *(LAS u32x4*)dp = st[j]; \
        else { *(LAS f32x4*)dp = (f32x4){bflo(st[j].x), bfhi(st[j].x), bflo(st[j].y), bfhi(st[j].y)}; *(LAS f32x4*)(dp + 4) = (f32x4){bflo(st[j].z), bfhi(st[j].z), bflo(st[j].w), bfhi(st[j].w)}; } } } while (0)
    SCAN_LOADG(0); SCAN_STORE(0); __syncthreads();
    f32x2 Sa = {0.f, 0.f}, Sb = {0.f, 0.f};
    const int rl = C.lane >> 4, ks = C.lane & 15;
    float ycol = 0.f;
#define SC_LD(R, s) do { const LAS float* bp_ = cur + (s) * 352 + ks * 4; \
        R##w = *(const LAS f32x4*)(bp_); R##k = *(const LAS f32x4*)(bp_ + 64); R##b = *(const LAS f32x4*)(bp_ + 128); R##q = *(const LAS f32x4*)(bp_ + 192); R##r = *(const LAS f32x4*)(bp_ + 256); \
        R##vv = cur[(s) * 352 + 320 + C.wave * 4 + rl]; } while (0)
#define SC_LO(v) ((f32x2){v[0], v[1]})
#define SC_HI(v) ((f32x2){v[2], v[3]})
#define SC_DPP(x, ctrl) __uint_as_float((unsigned)__builtin_amdgcn_update_dpp(0, (int)__float_as_uint(x), ctrl, 0xF, 0xF, true))
#define SC_STEP(R, P, s) do { \
        f32x2 pa = __builtin_elementwise_fma(Sb, SC_HI(R##k), Sa * SC_LO(R##k)), py = __builtin_elementwise_fma(Sb, SC_HI(P##r), Sa * SC_LO(P##r)); \
        float a_ = pa.x + pa.y, y_ = py.x + py.y; \
        a_ += SC_DPP(a_, 0xB1); y_ += SC_DPP(y_, 0xB1); a_ += SC_DPP(a_, 0x4E); y_ += SC_DPP(y_, 0x4E); \
        a_ += SC_DPP(a_, 0x141); y_ += SC_DPP(y_, 0x141); a_ += SC_DPP(a_, 0x140); y_ += SC_DPP(y_, 0x140); \
        ycol = (ks == ((s) & 15)) ? y_ : ycol; \
        const f32x2 na = {-a_, -a_}, vv2 = {R##vv, R##vv}; \
        Sa = __builtin_elementwise_fma(Sa, SC_LO(R##w), __builtin_elementwise_fma(na, SC_LO(R##b), vv2 * SC_LO(R##q))); \
        Sb = __builtin_elementwise_fma(Sb, SC_HI(R##w), __builtin_elementwise_fma(na, SC_HI(R##b), vv2 * SC_HI(R##q))); } while (0)
    f32x4 Aw, Ak, Ab, Aq, Ar, Bw, Bk, Bb, Bq, Br, Cw, Ck, Cb, Cq, Cr, Dw, Dk, Db, Dq, Dr; float Avv, Bvv, Cvv, Dvv;
    Dr = (f32x4){0.f, 0.f, 0.f, 0.f};
    for (int c = 0; c < NCH; ++c) {
        if (c + 1 < NCH) SCAN_LOADG(c + 1);
        {
            const LAS float* cur = buf + (c & 1) * (32 * 352);
            LAS float* yb = ybuf + (c & 1) * 1024 + C.wave * 4 + rl + ks * 32;
            SC_LD(A, 0); SC_LD(B, 1);
#pragma unroll 1
            for (int s = 0; s < 32; s += 4) {
                SC_LD(C, s + 2); __builtin_amdgcn_sched_barrier(0); SC_STEP(A, D, s); __builtin_amdgcn_sched_barrier(0);
                SC_LD(D, s + 3); __builtin_amdgcn_sched_barrier(0); SC_STEP(B, A, s + 1); __builtin_amdgcn_sched_barrier(0);
                SC_LD(A, s + 4); __builtin_amdgcn_sched_barrier(0); SC_STEP(C, B, s + 2); __builtin_amdgcn_sched_barrier(0);
                SC_LD(B, s + 5); __builtin_amdgcn_sched_barrier(0); SC_STEP(D, C, s + 3); __builtin_amdgcn_sched_barrier(0);
                if ((s & 15) == 12) yb[(s & 16) * 32] = ycol;
            }
        }
        if (c + 1 < NCH) SCAN_STORE((c + 1) & 1);
        __syncthreads();
        { const int row0_ = SCAN_ROW0(c);
#pragma unroll
          for (int i = 0; i < 2; ++i) { const int e = C.tid + NTHR * i, s = e >> 5, r = e & 31;
            const int row = (s > 0) ? row0_ + sgn * (s - 1) : scan_row(c * 32 - 1, b, d);
            if (s > 0 || c > 0) Y[(size_t)row * 768 + h * 64 + half * 32 + r] = ybuf[(c & 1) * 1024 + e]; } }
    }
    {
        f32x2 py = __builtin_elementwise_fma(Sb, SC_HI(Dr), Sa * SC_LO(Dr)); float y_ = py.x + py.y;
        y_ += SC_DPP(y_, 0xB1); y_ += SC_DPP(y_, 0x4E); y_ += SC_DPP(y_, 0x141); y_ += SC_DPP(y_, 0x140);
        if (ks == 0) Y[(size_t)scan_row(LKEYS - 1, b, d) * 768 + h * 64 + half * 32 + C.wave * 4 + rl] = y_;
    }
    __syncthreads();
    }
#undef SCAN_LOADG
#undef SCAN_STORE
#undef SCAN_ROW0
#undef SC_LD
#undef SC_STEP
#undef SC_LO
#undef SC_HI
#undef SC_DPP
}

constexpr int CSP = 72;
constexpr int CS_MAT = 64 * CSP * 2;
constexpr int CS_WT = 0, CS_KB = CS_MAT, CS_BB = 2 * CS_MAT, CS_RT = 3 * CS_MAT, CS_BHT = 4 * CS_MAT, CS_KHT = 5 * CS_MAT, CS_VMT = 6 * CS_MAT;
constexpr int CS_M2F = 7 * CS_MAT;
constexpr int CS_M1T = CS_M2F + 16384;
constexpr int CS_N2 = CS_M1T + CS_MAT;
constexpr int CS_GT = CS_N2 + CS_MAT;
constexpr int CS_Z = CS_M2F, CS_U = CS_M2F + CS_MAT;
constexpr int CS_GL = CS_GT + 2 * CS_MAT;
static_assert(CS_GL + 256 <= LDS_MISC, "chunked-scan LDS map");
template <bool SWZB = false>
__device__ __forceinline__ void cs_mma(f32x16& acc, const LAS unsigned char* Am, const LAS unsigned char* Bm, int ti, int tj, int r32, int hi) {
    const LAS unsigned char* ap = Am + (ti * 32 + r32) * (CSP * 2) + hi * 16; const int brow = tj * 32 + r32; const LAS unsigned char* bp = Bm + brow * (CSP * 2);
    const int sw = SWZB ? ((brow >> 3) & 7) : 0;
#pragma unroll
    for (int ks = 0; ks < 4; ++ks) acc = __builtin_amdgcn_mfma_f32_32x32x16_bf16(*(const LAS bf16x8*)(ap + ks * 32), *(const LAS bf16x8*)(bp + (((ks * 2 + hi) ^ sw) * 16)), acc, 0, 0, 0);
}
__device__ __forceinline__ void cs_store_t(LAS unsigned char* Om, const f32x16& acc, int ti, int tj, int r32, int hi) {
    LAS unsigned char* op = Om + (tj * 32 + r32) * (CSP * 2) + (ti * 32 + 4 * hi) * 2;
#pragma unroll
    for (int g = 0; g < 4; ++g) { u32x2 o; o.x = pk2(acc[4 * g], acc[4 * g + 1]); o.y = pk2(acc[4 * g + 2], acc[4 * g + 3]); *(LAS u32x2*)(op + g * 16) = o; }
}
#define CS_BAR() asm volatile("s_waitcnt lgkmcnt(0)\n\ts_barrier" ::: "memory")
__device__ __forceinline__ void phase_csa(const Ctx& C, const Args& A) {
    const unsigned char* SCN = A.ws + WS_SCN; unsigned char* CHK = A.ws + WS_CHK;
    LAS unsigned char* L = C.lds;
    const int r32 = C.lane & 31, hi = C.lane >> 5;
    float lwv[8]; u32x4 ukk, ub, ukr, ur, uv;
#define CSA_GEOM(cu_) const int unit = (cu_) / CS_NCH, ch = (cu_) % CS_NCH; const int d = unit & 1, h = (unit >> 1) % 12, b = unit / 24; \
        const int step0 = ch * CS_L; const int sgn = d ? -1 : 1; \
        const int row0 = (step0 < CTXL) ? (NLAT + b * CTXL + (d ? CTXL - 1 - step0 : step0)) : (b * TT + (d ? TT - 1 - (step0 - CTXL) : step0 - CTXL)); \
        const unsigned char* rec0 = SCN + (size_t)row0 * SC_ROW + (size_t)h * SC_REC;
#define CSA_LOAD(cu_) do { CSA_GEOM(cu_); \
        { const int k = C.tid & 63, sg = C.tid >> 6; _Pragma("unroll") for (int j = 0; j < 8; ++j) lwv[j] = *(const float*)(rec0 + (long)sgn * (8 * sg + j) * SC_ROW + SC_W + 256 * d + k * 4); } \
        { const int t = C.tid >> 3, k0 = (C.tid & 7) * 8; const unsigned char* rp = rec0 + (long)sgn * t * SC_ROW; \
          ukk = *(const u32x4*)(rp + SC_KK + k0 * 2); ub = *(const u32x4*)(rp + SC_B + 256 * d + k0 * 2); ukr = *(const u32x4*)(rp + SC_KR + 256 * d + k0 * 2); ur = *(const u32x4*)(rp + SC_R + k0 * 2); uv = *(const u32x4*)(rp + SC_V + k0 * 2); } } while (0)
    if ((int)blockIdx.x < CS_UNITS * CS_NCH) CSA_LOAD((int)blockIdx.x);
    for (int cu = blockIdx.x; cu < CS_UNITS * CS_NCH; cu += C.G) {
        LAS float* csf = (LAS float*)(L + CS_M2F);
        LAS float* seg = (LAS float*)(L + CS_N2);
        { const int k = C.tid & 63, sg = C.tid >> 6;
#pragma unroll
          for (int j = 1; j < 8; ++j) lwv[j] += lwv[j - 1];
          seg[sg * 64 + k] = lwv[7];
          CS_BAR();
          float off = 0.f, tot = 0.f;
#pragma unroll
          for (int s2 = 0; s2 < 8; ++s2) { const float v = seg[s2 * 64 + k]; off += (s2 < sg) ? v : 0.f; tot += v; }
#pragma unroll
          for (int j = 0; j < 8; ++j) csf[(8 * sg + j) * 65 + k] = lwv[j] + off;
          if (sg == 7) ((LAS float*)(L + CS_GL))[k] = __expf(tot); }
        CS_BAR();
        { const int t = C.tid >> 3, k0 = (C.tid & 7) * 8;
          float wt[8], kb[8], bb[8], rt[8], bh[8], kh[8];
#pragma unroll
          for (int j = 0; j < 8; ++j) { const unsigned pkk = j < 2 ? ukk.x : j < 4 ? ukk.y : j < 6 ? ukk.z : ukk.w, pb = j < 2 ? ub.x : j < 4 ? ub.y : j < 6 ? ub.z : ub.w, pkr = j < 2 ? ukr.x : j < 4 ? ukr.y : j < 6 ? ukr.z : ukr.w, pr = j < 2 ? ur.x : j < 4 ? ur.y : j < 6 ? ur.z : ur.w;
              const float kkv = (j & 1) ? bfhi(pkk) : bflo(pkk), bv = (j & 1) ? bfhi(pb) : bflo(pb), krv = (j & 1) ? bfhi(pkr) : bflo(pkr), rv = (j & 1) ? bfhi(pr) : bflo(pr);
              const float cst = csf[t * 65 + k0 + j], csp = t > 0 ? csf[(t - 1) * 65 + k0 + j] : 0.f, csl = csf[63 * 65 + k0 + j];
              const float einv = __expf(-cst), el = __expf(csl - cst);
              wt[j] = kkv * __expf(csp); kb[j] = krv * einv; bb[j] = bv * einv; rt[j] = rv * __expf(cst); bh[j] = bv * el; kh[j] = krv * el; }
          u32x4 o;
          o.x = pk2(wt[0], wt[1]); o.y = pk2(wt[2], wt[3]); o.z = pk2(wt[4], wt[5]); o.w = pk2(wt[6], wt[7]); *(LAS u32x4*)(L + CS_WT + t * (CSP * 2) + k0 * 2) = o;
          o.x = pk2(kb[0], kb[1]); o.y = pk2(kb[2], kb[3]); o.z = pk2(kb[4], kb[5]); o.w = pk2(kb[6], kb[7]); *(LAS u32x4*)(L + CS_KB + t * (CSP * 2) + k0 * 2) = o;
          o.x = pk2(bb[0], bb[1]); o.y = pk2(bb[2], bb[3]); o.z = pk2(bb[4], bb[5]); o.w = pk2(bb[6], bb[7]); *(LAS u32x4*)(L + CS_BB + t * (CSP * 2) + k0 * 2) = o;
          o.x = pk2(rt[0], rt[1]); o.y = pk2(rt[2], rt[3]); o.z = pk2(rt[4], rt[5]); o.w = pk2(rt[6], rt[7]); *(LAS u32x4*)(L + CS_RT + t * (CSP * 2) + k0 * 2) = o;
#pragma unroll
          for (int j = 0; j < 8; ++j) { const int to = ((((t >> 3) ^ ((k0 >> 3) & 7)) * 8) + (t & 7)) * 2;
              *(LAS bf16_t*)(L + CS_BHT + (k0 + j) * (CSP * 2) + to) = (bf16_t)f2bf(bh[j]); *(LAS bf16_t*)(L + CS_KHT + (k0 + j) * (CSP * 2) + to) = (bf16_t)f2bf(kh[j]);
              const unsigned pv = j < 2 ? uv.x : j < 4 ? uv.y : j < 6 ? uv.z : uv.w; *(LAS bf16_t*)(L + CS_VMT + (k0 + j) * (CSP * 2) + to) = (bf16_t)((j & 1) ? (pv >> 16) : (pv & 0xffffu)); } }
        if (cu + C.G < CS_UNITS * CS_NCH) CSA_LOAD(cu + C.G);
        CS_BAR();
        for (int job = C.wave; job < 12; job += NWAVES) { const int p = job >> 2, ti = (job >> 1) & 1, tj = job & 1;
            f32x16 acc;
#pragma unroll
            for (int i = 0; i < 16; ++i) acc[i] = 0.f;
            if (p == 0) { cs_mma(acc, L + CS_WT, L + CS_BB, ti, tj, r32, hi);
                const int i = tj * 32 + r32; LAS float* mp = (LAS float*)(L + CS_M2F) + i * 64;
#pragma unroll
                for (int reg = 0; reg < 16; ++reg) { const int t = ti * 32 + crow(reg, hi); mp[(t & 3) * 16 + (t >> 2)] = (i < t) ? acc[reg] : 0.f; } }
            else if (p == 1) { cs_mma(acc, L + CS_WT, L + CS_KB, ti, tj, r32, hi);
                const int i = tj * 32 + r32;
#pragma unroll
                for (int reg = 0; reg < 16; ++reg) { const int t = ti * 32 + crow(reg, hi); acc[reg] = (i < t) ? acc[reg] : 0.f; }
                cs_store_t(L + CS_M1T, acc, ti, tj, r32, hi); }
            else { cs_mma(acc, L + CS_BB, L + CS_RT, ti, tj, r32, hi);
                const int t = tj * 32 + r32;
#pragma unroll
                for (int reg = 0; reg < 16; ++reg) { const int i = ti * 32 + crow(reg, hi); acc[reg] = (i <= t) ? acc[reg] : 0.f; }
                cs_store_t(L + CS_N2, acc, ti, tj, r32, hi); } }
        CS_BAR();
        { const int c = C.tid >> 2, q = C.tid & 3; f32x2 acc2[8];
          { const LAS unsigned char* rcol = (c < 64) ? (L + CS_WT + c * 2) : (L + CS_M1T + (c - 64) * (CSP * 2)); const int rstride = (c < 64) ? CSP * 2 : 2;
#pragma unroll
            for (int j = 0; j < 16; ++j) acc2[j >> 1][j & 1] = bf2f(*(const LAS bf16_t*)(rcol + (4 * j + q) * rstride)); }
          const LAS float* m2c = (const LAS float*)(L + CS_M2F) + q * 16;
#pragma clang loop unroll(full)
          for (int i = 0; i < 64; ++i) {
              const float mine = -acc2[i >> 3][(i >> 2) & 1];
              float gi;
              switch (i & 3) { case 0: gi = __uint_as_float((unsigned)__builtin_amdgcn_update_dpp(0, (int)__float_as_uint(mine), 0x00, 0xF, 0xF, true)); break;
                               case 1: gi = __uint_as_float((unsigned)__builtin_amdgcn_update_dpp(0, (int)__float_as_uint(mine), 0x55, 0xF, 0xF, true)); break;
                               case 2: gi = __uint_as_float((unsigned)__builtin_amdgcn_update_dpp(0, (int)__float_as_uint(mine), 0xAA, 0xF, 0xF, true)); break;
                               default: gi = __uint_as_float((unsigned)__builtin_amdgcn_update_dpp(0, (int)__float_as_uint(mine), 0xFF, 0xF, 0xF, true)); break; }
              const f32x2 g2 = {gi, gi};
#pragma unroll
              for (int j4 = (i >> 4); j4 < 4; ++j4) { const f32x4 m = *(const LAS f32x4*)(m2c + i * 64 + j4 * 4);
#pragma unroll
                  for (int h = 0; h < 2; ++h) { const int p = 2 * j4 + h;
                      if (2 * p >= (i >> 2)) acc2[p] += (f32x2){m[2 * h], m[2 * h + 1]} * g2;
                      else if (2 * p + 1 >= (i >> 2)) acc2[p][1] += m[2 * h + 1] * gi; } }
          }
#pragma unroll
          for (int j = 0; j < 16; ++j) *(LAS bf16_t*)(L + CS_GT + c * (CSP * 2) + (4 * j + q) * 2) = (bf16_t)f2bf(-acc2[j >> 1][j & 1]); }
        CS_BAR();
        unsigned char* outp = CHK + (size_t)cu * 32768;
        for (int job = C.wave; job < 16; job += NWAVES) { const int p = job >> 2, ti = (job >> 1) & 1, tj = job & 1;
            f32x16 acc;
            if (p == 0) {
                const LAS unsigned char* rp = L + CS_RT + (tj * 32 + r32) * (CSP * 2) + (ti * 32 + 4 * hi) * 2;
#pragma unroll
                for (int g = 0; g < 4; ++g) { const u32x2 u = *(const LAS u32x2*)(rp + g * 16); acc[4 * g] = bflo(u.x); acc[4 * g + 1] = bfhi(u.x); acc[4 * g + 2] = bflo(u.y); acc[4 * g + 3] = bfhi(u.y); }
                cs_mma(acc, L + CS_GT, L + CS_N2, ti, tj, r32, hi);
#pragma unroll
                for (int g = 0; g < 4; ++g) { u32x2 o; o.x = pk2(acc[4 * g], acc[4 * g + 1]); o.y = pk2(acc[4 * g + 2], acc[4 * g + 3]);
                    *(u32x2*)(outp + 8192 + (((tj * 4 + 2 * ti + (g >> 1)) * 64 + (g & 1) * 32 + r32) * 16) + hi * 8) = o; } }
            else if (p == 1) {
#pragma unroll
                for (int i = 0; i < 16; ++i) acc[i] = 0.f;
                cs_mma(acc, L + CS_KB, L + CS_RT, ti, tj, r32, hi);
                const int t = tj * 32 + r32;
#pragma unroll
                for (int reg = 0; reg < 16; ++reg) { const int i = ti * 32 + crow(reg, hi); acc[reg] = (i <= t) ? acc[reg] : 0.f; }
                cs_mma(acc, L + CS_GT + 64 * (CSP * 2), L + CS_N2, ti, tj, r32, hi);
                cs_store_t(L + CS_Z, acc, ti, tj, r32, hi); }
            else if (p == 2) {
#pragma unroll
                for (int i = 0; i < 16; ++i) acc[i] = 0.f;
                cs_mma<true>(acc, L + CS_GT, L + CS_BHT, ti, tj, r32, hi);
                const int k = tj * 32 + r32; const float gl = ((const LAS float*)(L + CS_GL))[k];
#pragma unroll
                for (int reg = 0; reg < 16; ++reg) { const int cc = ti * 32 + crow(reg, hi); acc[reg] += (cc == k) ? gl : 0.f; }
#pragma unroll
                for (int g = 0; g < 4; ++g) { u32x2 o; o.x = pk2(acc[4 * g], acc[4 * g + 1]); o.y = pk2(acc[4 * g + 2], acc[4 * g + 3]);
                    *(u32x2*)(outp + (((tj * 4 + 2 * ti + (g >> 1)) * 64 + (g & 1) * 32 + r32) * 16) + hi * 8) = o; } }
            else {
                const int krow = tj * 32 + r32; const LAS unsigned char* kp = L + CS_KHT + krow * (CSP * 2) + hi * 8;
#pragma unroll
                for (int g = 0; g < 4; ++g) { const u32x2 u = *(const LAS u32x2*)(kp + (((ti * 4 + g) ^ ((krow >> 3) & 7)) * 16)); acc[4 * g] = bflo(u.x); acc[4 * g + 1] = bfhi(u.x); acc[4 * g + 2] = bflo(u.y); acc[4 * g + 3] = bfhi(u.y); }
                cs_mma<true>(acc, L + CS_GT + 64 * (CSP * 2), L + CS_BHT, ti, tj, r32, hi);
                cs_store_t(L + CS_U, acc, ti, tj, r32, hi); } }
        CS_BAR();
        { const int p = C.wave >> 2, ti = (C.wave >> 1) & 1, tj = C.wave & 1;
          f32x16 acc;
#pragma unroll
          for (int i = 0; i < 16; ++i) acc[i] = 0.f;
          cs_mma<true>(acc, L + (p ? CS_U : CS_Z), L + CS_VMT, ti, tj, r32, hi);
          unsigned char* op = outp + (p ? 16384 : 24576) + ((ti * 2 + tj) * 64 + C.lane) * 32;
          u32x4 o0, o1; o0.x = pk2(acc[0], acc[1]); o0.y = pk2(acc[2], acc[3]); o0.z = pk2(acc[4], acc[5]); o0.w = pk2(acc[6], acc[7]);
          o1.x = pk2(acc[8], acc[9]); o1.y = pk2(acc[10], acc[11]); o1.z = pk2(acc[12], acc[13]); o1.w = pk2(acc[14], acc[15]);
          *(u32x4*)op = o0; *(u32x4*)(op + 16) = o1; }
        CS_BAR();
    }
}
__device__ __forceinline__ void phase_csb(const Ctx& C, const Args& A, int l) {
    if ((int)blockIdx.x >= CS_UNITS) { const int gwf = ((int)blockIdx.x - CS_UNITS) * NWAVES + C.wave, ngwf = (C.G - CS_UNITS) * NWAVES;
        conv_items(C, A, l + 1, gwf, ngwf, true, false, false); conv_items(C, A, l + 1, gwf, ngwf, false, false, true, XW_TK_HI); return; }
    const unsigned char* CHK = A.ws + WS_CHK;
    LAS unsigned char* L = C.lds;
    const int r32 = C.lane & 31, hi = C.lane >> 5;
    const bool isS = C.wave < 4; const int ti = (C.wave >> 1) & 1, tj = C.wave & 1;
    for (int unit = blockIdx.x; unit < CS_UNITS; unit += C.G) {
        const int d = unit & 1, h = (unit >> 1) % 12, b = unit / 24;
        float* Y = (float*)(A.ws + WS_Y) + (size_t)d * MROWS * 768;
        for (int i = C.tid; i < 2 * CS_MAT / 4; i += NTHR) ((LAS unsigned*)L)[i] = 0u;
        CS_BAR();
        bf16x8 afA[4], afB[4], afC[4]; u32x4 cA0, cA1, cB0, cB1, cC0, cC1;
#define CSB_LOAD(A4, C0, C1, ch_) do { const unsigned char* op_ = CHK + ((size_t)unit * CS_NCH + (ch_)) * 32768; \
            const unsigned char* am_ = op_ + (isS ? 0 : 8192) + (ti * 4 * 64 + C.lane) * 16;     \
            _Pragma("unroll") for (int ks = 0; ks < 4; ++ks) A4[ks] = *(const bf16x8*)(am_ + ks * 1024); \
            const unsigned char* cp_ = op_ + (isS ? 16384 : 24576) + ((ti * 2 + tj) * 64 + C.lane) * 32; C0 = *(const u32x4*)cp_; C1 = *(const u32x4*)(cp_ + 16); } while (0)
#define CSB_STEP(A4, C0, C1, ch_) do { \
            const LAS unsigned char* Sb = L + ((ch_) & 1) * CS_MAT; LAS unsigned char* Sn = L + (((ch_) + 1) & 1) * CS_MAT; \
            f32x16 acc; \
            acc[0] = bflo(C0.x); acc[1] = bfhi(C0.x); acc[2] = bflo(C0.y); acc[3] = bfhi(C0.y); acc[4] = bflo(C0.z); acc[5] = bfhi(C0.z); acc[6] = bflo(C0.w); acc[7] = bfhi(C0.w); \
            acc[8] = bflo(C1.x); acc[9] = bfhi(C1.x); acc[10] = bflo(C1.y); acc[11] = bfhi(C1.y); acc[12] = bflo(C1.z); acc[13] = bfhi(C1.z); acc[14] = bflo(C1.w); acc[15] = bfhi(C1.w); \
            const LAS unsigned char* bp = Sb + (tj * 32 + r32) * (CSP * 2) + hi * 16; \
            _Pragma("unroll") for (int ks = 0; ks < 4; ++ks) acc = __builtin_amdgcn_mfma_f32_32x32x16_bf16(A4[ks], *(const LAS bf16x8*)(bp + ks * 32), acc, 0, 0, 0); \
            if (isS) { cs_store_t(Sn, acc, ti, tj, r32, hi); }     \
            else {     \
                const int step0 = (ch_) * CS_L; const int sgn = d ? -1 : 1; \
                const int row0 = (step0 < CTXL) ? (NLAT + b * CTXL + (d ? CTXL - 1 - step0 : step0)) : (b * TT + (d ? TT - 1 - (step0 - CTXL) : step0 - CTXL)); \
                float* yp = Y + (size_t)(row0 + sgn * (ti * 32 + 4 * hi)) * 768 + h * 64 + tj * 32 + r32; const long ys = (long)sgn * 768; \
                _Pragma("unroll") for (int reg = 0; reg < 16; ++reg) yp[ys * ((reg & 3) + 8 * (reg >> 2))] = acc[reg]; } \
            CS_BAR(); } while (0)
        CSB_LOAD(afA, cA0, cA1, 0); CSB_LOAD(afB, cB0, cB1, 1);
        static_assert(CS_NCH % 3 == 0, "chunk loop is unrolled by three");
        for (int ch = 0; ch < CS_NCH; ch += 3) {
            if (ch == 0) CSB_LOAD(afC, cC0, cC1, 2);
            CSB_STEP(afA, cA0, cA1, ch);     if (ch + 3 < CS_NCH) CSB_LOAD(afA, cA0, cA1, ch + 3);
            CSB_STEP(afB, cB0, cB1, ch + 1); if (ch + 4 < CS_NCH) CSB_LOAD(afB, cB0, cB1, ch + 4);
            CSB_STEP(afC, cC0, cC1, ch + 2); if (ch + 5 < CS_NCH) CSB_LOAD(afC, cC0, cC1, ch + 5);
        }
        CS_BAR();
    }
#undef CSB_LOAD
#undef CSB_STEP
}

#undef CS_BAR
struct Ef2Row { f32x4 y0[3], y1[3]; u32x2 r[3], v[3], k0[3], k1[3], g[3]; };
__device__ __forceinline__ void ef2_load(Ef2Row& R, const float* Y0, const float* Y1, const unsigned char* SCN, const bf16_t* G, int row, int lane) {
#pragma unroll
    for (int it = 0; it < 3; ++it) { const int c = it * 256 + 4 * lane, head = c >> 6, kx = c & 63;
        R.y0[it] = *(const f32x4*)(Y0 + (size_t)row * 768 + c); R.y1[it] = *(const f32x4*)(Y1 + (size_t)row * 768 + c);
        const unsigned char* base = SCN + (size_t)(row * 12 + head) * SC_REC + kx * 2;
        R.r[it] = *(const u32x2*)(base + SC_R); R.v[it] = *(const u32x2*)(base + SC_V); R.k0[it] = *(const u32x2*)(base + SC_KR); R.k1[it] = *(const u32x2*)(base + SC_KR + 256);
        R.g[it] = *(const u32x2*)(G + (size_t)row * 768 + c); }
}
__device__ __forceinline__ void phase_ef2(const Ctx& C, const Args& A, int l) {
    const int i2 = l >> 1; unsigned char* ws = A.ws;
    const unsigned char* SCN = ws + WS_SCN; const float* Y0 = (const float*)(ws + WS_Y); const float* Y1 = Y0 + (size_t)MROWS * 768;
    const bf16_t* G = (const bf16_t*)(ws + WS_G); bf16_t* A2 = (bf16_t*)(ws + WS_A2);
    const float* rb = A.in[I_RBON] + (size_t)i2 * 768; const float* gg = A.in[I_GNG] + (size_t)i2 * 768; const float* gb = A.in[I_GNB] + (size_t)i2 * 768;
    f32x4 rbr[3], ggr[3], gbr[3];
#pragma unroll
    for (int it = 0; it < 3; ++it) { const int c = it * 256 + 4 * C.lane; rbr[it] = *(const f32x4*)(rb + c); ggr[it] = *(const f32x4*)(gg + c); gbr[it] = *(const f32x4*)(gb + c); }
    Ef2Row Rn;
    if (C.gw < MROWS) ef2_load(Rn, Y0, Y1, SCN, G, C.gw, C.lane);
    for (int row = C.gw; row < MROWS; row += C.NGW) {
        const Ef2Row R = Rn;
        { const int nr = row + C.NGW < MROWS ? row + C.NGW : row; ef2_load(Rn, Y0, Y1, SCN, G, nr, C.lane); }
#pragma unroll
        for (int it = 0; it < 3; ++it) {
            const int c = it * 256 + 4 * C.lane;
            const f32x4 y = R.y0[it] + R.y1[it];
            const float mean = sum16((y[0] + y[1]) + (y[2] + y[3])) * (1.f / 64.f);
            const f32x4 dd = y - mean;
            const float var = sum16((dd[0] * dd[0] + dd[1] * dd[1]) + (dd[2] * dd[2] + dd[3] * dd[3])) * (1.f / 64.f);
            const float rstd = rsqrtf(var + GN_EPS);
            const f32x4 r = bf4(R.r[it]), v = bf4(R.v[it]), k0 = bf4(R.k0[it]), k1 = bf4(R.k1[it]);
            const f32x4 t = r * (k0 + k1) * 0.5f * rbr[it];
            const float bs = sum16((t[0] + t[1]) + (t[2] + t[3]));
            const f32x4 yn = dd * rstd * ggr[it] + gbr[it];
            const f32x4 g = bf4(R.g[it]);
            st4bf(A2 + (size_t)row * DM + 256 + c, g * (yn + v * bs));
        }
    }
}

__device__ __forceinline__ void phase_of1(const Ctx& C, const Args& A, int l) {
    const int i2 = l >> 1; unsigned char* ws = A.ws;
    const bf16_t* P = (const bf16_t*)(ws + WS_P); bf16_t* A2 = (bf16_t*)(ws + WS_A2); bf16_t* VT = (bf16_t*)(ws + WS_VT);
    const float* lng = A.in[I_GLNG] + (size_t)i2 * 256; const float* lnb = A.in[I_GLNB] + (size_t)i2 * 256;
    const float* gws = A.in[I_GWS] + (size_t)i2 * 4 * 128 * 128; const float* gbs = A.in[I_GBS] + (size_t)i2 * 4 * 128;
    LAS bf16_t* vt = (LAS bf16_t*)C.lds;
    LAS bf16_t* uL = (LAS bf16_t*)C.lds;
    LAS bf16_t* vT = (LAS bf16_t*)(C.lds + 128 * 528);
    const int r32 = C.lane & 31, hi = C.lane >> 5;
    for (int it = blockIdx.x; it < 256 + 8 * 7; it += C.G) {
        const bool isctx = it >= 256; const int uc = isctx ? (it - 256) / 7 : 0, pc = isctx ? (it - 256) % 7 : 0; const int u = it;
        const int b = isctx ? (uc >> 1) : (u >> 6), pos0 = isctx ? (uc & 1) * 128 : (u & 63) * 128;
        const int row0 = isctx ? NLAT + b * CTXL + pos0 : b * TT + pos0, L0 = isctx ? pos0 : CTXL + pos0;
        const int hh0 = isctx ? pc : 0, hh1 = isctx ? (pc < 6 ? pc + 1 : 0) : 6; const bool doC = !isctx || pc == 6;
        u32x4 pv[4];
        if (hh0 < hh1) {
#pragma unroll
            for (int i = 0; i < 4; ++i) { const int piece = C.tid + NTHR * i, r = piece >> 4, part = piece & 15; pv[i] = *(const u32x4*)(P + (size_t)(row0 + r) * P_LD + 1536 + hh0 * 128 + part * 8); } }
        for (int hh = hh0; hh < hh1; ++hh) {
#pragma unroll
            for (int i = 0; i < 4; ++i) { const int piece = C.tid + NTHR * i, r = piece >> 4, part = piece & 15;
                *(LAS u32x4*)(vt + r * 136 + part * 8) = pv[i]; }
            __syncthreads();
            if (hh + 1 < hh1) {
#pragma unroll
                for (int i = 0; i < 4; ++i) { const int piece = C.tid + NTHR * i, r = piece >> 4, part = piece & 15; pv[i] = *(const u32x4*)(P + (size_t)(row0 + r) * P_LD + 1536 + (hh + 1) * 128 + part * 8); } }
#pragma unroll
            for (int i = 0; i < 4; ++i) { const int item = C.tid + NTHR * i, d = item >> 4, tg = item & 15; const LAS bf16_t* s = vt + (tg * 8) * 136 + d;
                u32x4 o; o.x = (unsigned)s[0] | ((unsigned)s[136] << 16); o.y = (unsigned)s[2 * 136] | ((unsigned)s[3 * 136] << 16);
                o.z = (unsigned)s[4 * 136] | ((unsigned)s[5 * 136] << 16); o.w = (unsigned)s[6 * 136] | ((unsigned)s[7 * 136] << 16);
                *(u32x4*)(VT + ((size_t)(b * 6 + hh) * 128 + d) * LKEYS + L0 + tg * 8) = o; }
            __syncthreads();
        }
        if (doC) {
        const f32x4 lngr = *(const f32x4*)(lng + 4 * C.lane), lnbr = *(const f32x4*)(lnb + 4 * C.lane);
        u32x2 nxu, nxr;
        { const bf16_t* pr = P + (size_t)(row0 + C.wave) * P_LD + 2304 + 4 * C.lane; nxu = *(const u32x2*)pr; nxr = *(const u32x2*)(pr + 256); }
        for (int r = C.wave; r < 128; r += NWAVES) {
            const int c4 = 4 * C.lane;
            const f32x4 ur = bf4(nxu), raw = bf4(nxr);
            if (r + NWAVES < 128) { const bf16_t* pr = P + (size_t)(row0 + r + NWAVES) * P_LD + 2304 + c4; nxu = *(const u32x2*)pr; nxr = *(const u32x2*)(pr + 256); }
            { const f32x4 gu = gelu4(ur); u32x2 o; o.x = pk2(gu[0], gu[1]); o.y = pk2(gu[2], gu[3]); *(LAS u32x2*)(uL + r * 264 + c4) = o; }
            const f32x4 gv = gelu4(raw);
            const float mean = wave_sum((gv[0] + gv[1]) + (gv[2] + gv[3])) * (1.f / 256.f); const f32x4 dd = gv - mean;
            const float var = wave_sum((dd[0] * dd[0] + dd[1] * dd[1]) + (dd[2] * dd[2] + dd[3] * dd[3])) * (1.f / 256.f); const float rstd = rsqrtf(var + LN_EPS);
            const f32x4 o = dd * rstd * lngr + lnbr;
#pragma unroll
            for (int k = 0; k < 4; ++k) vT[(c4 + k) * 136 + r] = (bf16_t)f2bf(o[k]);
        }
        __syncthreads();
        {
            const int g = C.wave >> 1, cblk = C.wave & 1, cc = g * 64 + cblk * 32 + r32;
            for (int pblk = 0; pblk < 4; ++pblk) {
                f32x16 acc;
#pragma unroll
                for (int i = 0; i < 16; ++i) acc[i] = 0.f;
                const float* wrow = gws + ((size_t)g * 128 + pblk * 32 + r32) * 128 + 8 * hi;
#pragma unroll
                for (int ks = 0; ks < 8; ++ks) { const f32x4 w0 = *(const f32x4*)(wrow + ks * 16), w1 = *(const f32x4*)(wrow + ks * 16 + 4);
                    u32x4 au; au.x = pk2(w0[0], w0[1]); au.y = pk2(w0[2], w0[3]); au.z = pk2(w1[0], w1[1]); au.w = pk2(w1[2], w1[3]);
                    const bf16x8 bf = *(const LAS bf16x8*)(vT + cc * 136 + ks * 16 + 8 * hi);
                    acc = __builtin_amdgcn_mfma_f32_32x32x16_bf16(__builtin_bit_cast(bf16x8, au), bf, acc, 0, 0, 0); }
#pragma unroll
                for (int reg = 0; reg < 16; ++reg) { const int p = pblk * 32 + crow(reg, hi);
                    const float uu = bf2f(uL[p * 264 + cc]); const float mixed = acc[reg] + gbs[g * 128 + p];
                    uL[p * 264 + cc] = (bf16_t)f2bf(uu * mixed); }
            }
        }
        __syncthreads();
#pragma unroll
        for (int i = 0; i < 8; ++i) { const int piece = C.tid + NTHR * i, r = piece >> 5, part = piece & 31;
            *(u32x4*)(A2 + (size_t)(row0 + r) * DM + 768 + part * 8) = *(const LAS u32x4*)(uL + r * 264 + part * 8); }
        __syncthreads();
        }
    }
}

__device__ __forceinline__ void phase_attn(const Ctx& C, const Args& A, int l) {
    const int i2 = l >> 1; unsigned char* ws = A.ws;
    const bf16_t* Q = (const bf16_t*)(ws + WS_Q); const bf16_t* KA = (const bf16_t*)(ws + WS_KA); const bf16_t* VT = (const bf16_t*)(ws + WS_VT); bf16_t* A2 = (bf16_t*)(ws + WS_A2);
    const float lam_init = 0.8f - 0.6f * expf(-0.3f * (float)l);
    float s1 = 0.f, s2 = 0.f;
    for (int j = 0; j < 64; ++j) { s1 += A.in[I_LQ1][i2 * 64 + j] * A.in[I_LK1][i2 * 64 + j]; s2 += A.in[I_LQ2][i2 * 64 + j] * A.in[I_LK2][i2 * 64 + j]; }
    const float lam = expf(s1) - expf(s2) + lam_init;
    const float* subg = A.in[I_SUBG] + (size_t)i2 * 128;
    const int r32 = C.lane & 31, hi = C.lane >> 5, map = C.wave >> 2, qw = C.wave & 3;
    LAS unsigned char* Kt = C.lds; LAS unsigned char* Vt = C.lds + 2 * 16384; LAS float* xch = (LAS float*)C.lds;
    const int NU = 1536 + (l == 1 ? 48 : 0);
    for (int n = C.vcu; n < NU; n += C.G) {
        int bh, qt; bool isctx = false;
        if (n < 1536) { const int round = n >> 8, slot = n & 255; bh = (slot >> 5) * 3 + (round >> 1); qt = (round & 1) * 32 + (slot & 31); }
        else { isctx = true; bh = (n - 1536) >> 1; qt = (n - 1536) & 1; }
        const int b = bh / 6, h = bh % 6;
        const int qrow0 = isctx ? NLAT + b * CTXL + qt * 128 : b * TT + qt * 128;
        const int NT = isctx ? CTXL / 64 : LKEYS / 64;
        const bf16_t* Kb = KA + (size_t)b * LKEYS * 768 + h * 128;
        const bf16_t* Vb = VT + (size_t)(b * 6 + h) * 128 * LKEYS;
        bf16x8 qf[4];
        { const bf16_t* qp = Q + (size_t)(qrow0 + qw * 32 + r32) * 768 + h * 128 + map * 64 + 8 * hi;
#pragma unroll
          for (int ks = 0; ks < 4; ++ks) qf[ks] = *(const bf16x8*)(qp + ks * 16); }
        f32x16 O[4];
#pragma unroll
        for (int d = 0; d < 4; ++d)
#pragma unroll
            for (int i = 0; i < 16; ++i) O[d][i] = 0.f;
        float m = 0.f, lsum = 0.f;
        unsigned ksrc[2], vsrc[2];
#pragma unroll
        for (int i = 0; i < 2; ++i) { const int row = 4 * (2 * C.wave + i) + (C.lane >> 4), x = row & 15, pi = x < 4 ? x : x < 8 ? x + 4 : x < 12 ? x - 4 : x;
            ksrc[i] = (unsigned)(((row & ~15) + pi) * 768 + (((C.lane & 15) ^ x) * 8));
            const int d = 8 * (2 * C.wave + i) + (C.lane >> 3); vsrc[i] = (unsigned)(d * LKEYS + (((C.lane & 7) ^ ((d >> 1) & 7)) * 8)); }
#define AT_DMA_K(tt, slot) do { _Pragma("unroll") for (int i = 0; i < 2; ++i) __builtin_amdgcn_global_load_lds((const unsigned*)(Kb + (size_t)(tt) * 64 * 768 + ksrc[i]), (LAS unsigned*)(Kt + (slot) * 16384 + (2 * C.wave + i) * 1024), 16, 0, 0); } while (0)
#define AT_DMA_V(tt, slot) do { _Pragma("unroll") for (int i = 0; i < 2; ++i) __builtin_amdgcn_global_load_lds((const unsigned*)(Vb + (size_t)(tt) * 64 + vsrc[i]), (LAS unsigned*)(Vt + (slot) * 16384 + (2 * C.wave + i) * 1024), 16, 0, 0); } while (0)
#define AT_BAR() asm volatile("s_waitcnt vmcnt(0) lgkmcnt(0)\n\ts_barrier" ::: "memory")
#define AT_SB() __builtin_amdgcn_sched_barrier(0)
        const int ksw = r32 & 15, vsw = (r32 >> 1) & 7;
#define AT_QK(P0, P1, ks_) do { const float nm_ = -m; _Pragma("unroll") for (int i = 0; i < 16; ++i) { P0[i] = nm_; P1[i] = nm_; } \
            const LAS unsigned char* kbp_ = Kt + (ks_) * 16384 + r32 * 256; \
            _Pragma("unroll") for (int ks = 0; ks < 4; ++ks) { const int co_ = ((map * 8 + ks * 2 + hi) ^ ksw) * 16; \
                P0 = __builtin_amdgcn_mfma_f32_32x32x16_bf16(*(const LAS bf16x8*)(kbp_ + co_), qf[ks], P0, 0, 0, 0); P1 = __builtin_amdgcn_mfma_f32_32x32x16_bf16(*(const LAS bf16x8*)(kbp_ + 32 * 256 + co_), qf[ks], P1, 0, 0, 0); } } while (0)
#define AT_LDV(dst, vs_, d) do { _Pragma("unroll") for (int kst = 0; kst < 4; ++kst) dst[kst] = *(const LAS u32x4*)(Vt + (vs_) * 16384 + ((d) * 32 + r32) * 128 + (((kst * 2 + hi) ^ vsw) * 16)); } while (0)
#define AT_PV(src, d) do { _Pragma("unroll") for (int kst = 0; kst < 4; ++kst) O[d] = __builtin_amdgcn_mfma_f32_32x32x16_bf16(__builtin_bit_cast(bf16x8, src[kst]), pb[kst], O[d], 0, 0, 0); } while (0)
#define AT_SOFTPV(P0, P1, N0, N1, first, hasn, vs_) do { \
            asm volatile("s_nop 15\n\ts_nop 7" : "+v"(P0), "+v"(P1)); \
            float mx = max3f(P0[0], P0[1], P1[0]), mx2 = max3f(P0[2], P0[3], P1[1]); mx = max3f(mx, P1[2], P1[3]); \
            _Pragma("unroll") for (int i = 4; i < 16; i += 4) { mx = max3f(mx, P0[i], P0[i + 1]); mx2 = max3f(mx2, P0[i + 2], P0[i + 3]); mx = max3f(mx, P1[i], P1[i + 1]); mx2 = max3f(mx2, P1[i + 2], P1[i + 3]); } \
            mx = fmaxf(mx, mx2); \
            { auto rr = __builtin_amdgcn_permlane32_swap(__float_as_uint(mx), __float_as_uint(mx), false, false); mx = fmaxf(__uint_as_float(rr[0]), __uint_as_float(rr[1])); } \
            if ((first) || __any(mx > 8.f)) { const float dl = (first) ? mx : fmaxf(mx, 0.f); const float sc = __builtin_amdgcn_exp2f(-dl); lsum *= sc; \
                _Pragma("unroll") for (int d = 0; d < 4; ++d) _Pragma("unroll") for (int i = 0; i < 16; ++i) O[d][i] *= sc; \
                _Pragma("unroll") for (int i = 0; i < 16; ++i) { P0[i] -= dl; P1[i] -= dl; } \
                if (hasn) { asm volatile("s_nop 15\n\ts_nop 7" : "+v"(N0), "+v"(N1)); _Pragma("unroll") for (int i = 0; i < 16; ++i) { N0[i] -= dl; N1[i] -= dl; } } \
                m += dl; } \
            float ps = 0.f, ps2 = 0.f; \
            _Pragma("unroll") for (int i = 0; i < 16; ++i) { P0[i] = __builtin_amdgcn_exp2f(P0[i]); P1[i] = __builtin_amdgcn_exp2f(P1[i]); ps += P0[i]; ps2 += P1[i]; } \
            lsum += ps + ps2; \
            bf16x8 pb[4]; \
            { u32x4 w; w.x = pk2(P0[0], P0[1]); w.y = pk2(P0[2], P0[3]); w.z = pk2(P0[4], P0[5]); w.w = pk2(P0[6], P0[7]); pb[0] = __builtin_bit_cast(bf16x8, w); \
              w.x = pk2(P0[8], P0[9]); w.y = pk2(P0[10], P0[11]); w.z = pk2(P0[12], P0[13]); w.w = pk2(P0[14], P0[15]); pb[1] = __builtin_bit_cast(bf16x8, w); \
              w.x = pk2(P1[0], P1[1]); w.y = pk2(P1[2], P1[3]); w.z = pk2(P1[4], P1[5]); w.w = pk2(P1[6], P1[7]); pb[2] = __builtin_bit_cast(bf16x8, w); \
              w.x = pk2(P1[8], P1[9]); w.y = pk2(P1[10], P1[11]); w.z = pk2(P1[12], P1[13]); w.w = pk2(P1[14], P1[15]); pb[3] = __builtin_bit_cast(bf16x8, w); } \
            u32x4 va[4]; \
            AT_LDV(va, vs_, 0); AT_SB(); AT_PV(va, 0); AT_SB(); AT_LDV(va, vs_, 1); AT_SB(); AT_PV(va, 1); AT_SB(); AT_LDV(va, vs_, 2); AT_SB(); AT_PV(va, 2); AT_SB(); AT_LDV(va, vs_, 3); AT_SB(); AT_PV(va, 3); AT_SB(); } while (0)
        f32x16 pA0, pA1, pB0, pB1;
        AT_DMA_K(0, 0); AT_DMA_V(0, 0); AT_DMA_K(1, 1);
        AT_BAR();
        AT_QK(pA0, pA1, 0);
        asm volatile("s_waitcnt lgkmcnt(0)\n\ts_barrier" ::: "memory");
        for (int t = 0; t < NT; t += 2) {
            if (t + 2 < NT) AT_DMA_K(t + 2, 0);
            AT_DMA_V(t + 1, 1);
            AT_SB(); AT_QK(pB0, pB1, 1); AT_SB();
            AT_SOFTPV(pA0, pA1, pB0, pB1, t == 0, true, 0);
            AT_BAR();
            if (t + 3 < NT) AT_DMA_K(t + 3, 1);
            if (t + 2 < NT) AT_DMA_V(t + 2, 0);
            AT_SB(); if (t + 2 < NT) { AT_QK(pA0, pA1, 0); } AT_SB();
            AT_SOFTPV(pB0, pB1, pA0, pA1, false, t + 2 < NT, 1);
            AT_BAR();
        }
#undef AT_DMA_K
#undef AT_DMA_V
#undef AT_BAR
#undef AT_SB
#undef AT_QK
#undef AT_LDV
#undef AT_PV
#undef AT_SOFTPV
        const float ltot = lsum + __shfl_xor(lsum, 32);
        const float invl = 1.f / ltot;
        if (map == 1) { const float f = lam * invl;
#pragma unroll
            for (int d = 0; d < 4; ++d)
#pragma unroll
                for (int i = 0; i < 16; ++i) xch[(qw * 64 + d * 16 + i) * 64 + C.lane] = O[d][i] * f; }
        __syncthreads();
        if (map == 0) { float ss = 0.f;
#pragma unroll
            for (int d = 0; d < 4; ++d)
#pragma unroll
                for (int i = 0; i < 16; ++i) { const float o = O[d][i] * invl - xch[(qw * 64 + d * 16 + i) * 64 + C.lane]; O[d][i] = o; ss += o * o; }
            ss += __shfl_xor(ss, 32);
            const float rn = rsqrtf(ss * (1.f / 128.f) + RMS_EPS) * (1.f - lam_init);
            bf16_t* orow = A2 + (size_t)(qrow0 + qw * 32 + r32) * DM + h * 128;
#pragma unroll
            for (int d = 0; d < 4; ++d)
#pragma unroll
                for (int g4 = 0; g4 < 4; ++g4) { const int dd = 32 * d + 8 * g4 + 4 * hi; const f32x4 sg = *(const f32x4*)(subg + dd);
                    const f32x4 v = {O[d][4 * g4] * rn * sg[0], O[d][4 * g4 + 1] * rn * sg[1], O[d][4 * g4 + 2] * rn * sg[2], O[d][4 * g4 + 3] * rn * sg[3]};
                    st4bf(orow + dd, v); } }
        __syncthreads();
    }
}

__device__ __forceinline__ void phase_rt(const Ctx& C, const Args& A, int l) {
    unsigned char* ws = A.ws; float* X = (float*)(ws + WS_X); bf16_t* H = (bf16_t*)(ws + WS_H); float* AFF = (float*)(ws + WS_AFF); float* STAT = (float*)(ws + WS_P);
    const float* MOD = (const float*)(ws + WS_MOD) + (size_t)l * 5 * 6144;
    const float* lng = A.in[I_LNG] + (size_t)(l * 2 + 0) * DM; const float* lnb = A.in[I_LNB] + (size_t)(l * 2 + 0) * DM;
    LAS float* wrs = (LAS float*)C.lds;
    { const float* wr = A.in[I_WR] + (size_t)l * DM * 16; for (int i = C.tid; i < DM * 16; i += NTHR) wrs[(i & 15) * 1024 + (i >> 4)] = wr[i]; }
    __syncthreads();
    const int row0 = (int)(((long)C.gw * MROWS) / C.NGW), row1 = (int)(((long)(C.gw + 1) * MROWS) / C.NGW);
    f32x4 lngr[4], lnbr[4], scr[4], shr[4]; int cmi = -1;
#pragma unroll
    for (int j = 0; j < 4; ++j) { const int col = 4 * C.lane + 256 * j; lngr[j] = *(const f32x4*)(lng + col); lnbr[j] = *(const f32x4*)(lnb + col); scr[j] = lngr[j]; shr[j] = lngr[j]; }
    f32x4 xn[4];
    if (row0 < row1) {
#pragma unroll
        for (int j = 0; j < 4; ++j) xn[j] = *(const f32x4*)(X + (size_t)row0 * DM + 4 * C.lane + 256 * j); }
    for (int row = row0; row < row1; ++row) {
        const int mi = row_mi(row);
        if (mi != cmi) { cmi = mi; const float* md = MOD + mi * 6144;
#pragma unroll
            for (int j = 0; j < 4; ++j) { const int col = 4 * C.lane + 256 * j; scr[j] = *(const f32x4*)(md + 4 * DM + col) + 1.f; shr[j] = *(const f32x4*)(md + 3 * DM + col); } }
        f32x4 x[4]; float s = 0.f;
#pragma unroll
        for (int j = 0; j < 4; ++j) { x[j] = xn[j]; s += (x[j][0] + x[j][1]) + (x[j][2] + x[j][3]); }
        if (row + 1 < row1) {
#pragma unroll
            for (int j = 0; j < 4; ++j) xn[j] = *(const f32x4*)(X + (size_t)(row + 1) * DM + 4 * C.lane + 256 * j); }
        const float mean = wave_sum(s) * (1.f / DM); float s2 = 0.f;
#pragma unroll
        for (int j = 0; j < 4; ++j) { x[j] = x[j] - mean; s2 += (x[j][0] * x[j][0] + x[j][1] * x[j][1]) + (x[j][2] * x[j][2] + x[j][3] * x[j][3]); }
        const float rstd = rsqrtf(wave_sum(s2) * (1.f / DM) + LN_EPS);
        if (C.lane == 0) *(f32x2*)(STAT + (size_t)row * 2) = (f32x2){mean, rstd};
        float v[16];
#pragma unroll
        for (int e = 0; e < 16; ++e) v[e] = 0.f;
#pragma unroll
        for (int j = 0; j < 4; ++j) { const int col = 4 * C.lane + 256 * j;
            const f32x4 x1 = x[j] * rstd * lngr[j] + lnbr[j];
            const f32x4 h = x1 * scr[j] + shr[j];
            st4bf(H + (size_t)row * DM + col, h);
#pragma unroll
            for (int e = 0; e < 16; ++e) { const f32x4 w = *(const LAS f32x4*)(wrs + e * 1024 + col); v[e] += (h[0] * w[0] + h[1] * w[1]) + (h[2] * w[2] + h[3] * w[3]); }
            __builtin_amdgcn_sched_barrier(0); }
#pragma unroll
        for (int i = 0; i < 8; ++i) { const float send = (C.lane & 32) ? v[i] : v[i + 8], keep = (C.lane & 32) ? v[i + 8] : v[i]; v[i] = keep + __shfl_xor(send, 32); }
#pragma unroll
        for (int i = 0; i < 4; ++i) { const float send = (C.lane & 16) ? v[i] : v[i + 4], keep = (C.lane & 16) ? v[i + 4] : v[i]; v[i] = keep + __shfl_xor(send, 16); }
#pragma unroll
        for (int i = 0; i < 2; ++i) { const float send = (C.lane & 8) ? v[i] : v[i + 2], keep = (C.lane & 8) ? v[i + 2] : v[i]; v[i] = keep + __shfl_xor(send, 8); }
        { const float send = (C.lane & 4) ? v[0] : v[1], keep = (C.lane & 4) ? v[1] : v[0]; v[0] = keep + __shfl_xor(send, 4); }
        float z = v[0]; z += __shfl_xor(z, 1); z += __shfl_xor(z, 2);
        float mx = z;
#pragma unroll
        for (int o = 4; o < 64; o <<= 1) mx = fmaxf(mx, __shfl_xor(mx, o));
        const float ex = expf(z - mx); float sm = ex;
#pragma unroll
        for (int o = 4; o < 64; o <<= 1) sm += __shfl_xor(sm, o);
        if ((C.lane & 3) == 0) AFF[(size_t)row * 16 + (C.lane >> 2)] = ex / sm;
    }
}

__device__ __forceinline__ void phase_tk(const Ctx& C, const Args& A) {
    unsigned char* ws = A.ws; const float* AFF = (const float*)(ws + WS_AFF); int* SLOT = (int*)(ws + WS_SLOT); int* IDX = (int*)(ws + WS_IDX); float* GATE = (float*)(ws + WS_GATE);
    LAS unsigned* key = (LAS unsigned*)C.lds;
    LAS unsigned* hist = key + 8192;
    LAS unsigned* scn = hist + 256;
    LAS unsigned* wtot = scn + 256;
    LAS unsigned* bc = wtot + 8;
    for (int u = blockIdx.x; u < 128; u += C.G) {
        const bool isctx = u >= 64; const int uu = u & 63, b = uu >> 4, e = uu & 15;
        const int n = isctx ? CTXL : TT, cap = isctx ? CAP_C : CAP_L;
        const int row0 = isctx ? NLAT + b * CTXL : b * TT;
        const int slot0 = e * ESLOTS + (isctx ? 4 * CAP_L + b * CAP_C : b * CAP_L);
        for (int i = C.tid; i < n; i += NTHR) key[i] = __float_as_uint(AFF[(size_t)(row0 + i) * 16 + e]);
        unsigned prefix = 0u, pmask = 0u; int need = cap;
        for (int pass = 0; pass < 4; ++pass) {
            const int shift = 24 - 8 * pass;
            if (C.tid < 256) hist[C.tid] = 0u;
            __syncthreads();
            for (int i = C.tid; i < n; i += NTHR) { const unsigned k = key[i]; if ((k & pmask) == prefix) __hip_atomic_fetch_add(&hist[(k >> shift) & 255u], 1u, __ATOMIC_RELAXED, __HIP_MEMORY_SCOPE_WORKGROUP); }
            __syncthreads();
            {
                const unsigned hd = (C.tid < 256) ? hist[255 - C.tid] : 0u; unsigned inc = hd;
#pragma unroll
                for (int o = 1; o < 64; o <<= 1) { const unsigned t = __shfl_up(inc, o); if (C.lane >= o) inc += t; }
                if (C.tid < 256 && C.lane == 63) wtot[C.wave] = inc;
                __syncthreads();
                if (C.tid < 256) { unsigned base = 0u; for (int w = 0; w < C.wave; ++w) base += wtot[w];
                    const unsigned incl = base + inc, above = incl - hd;
                    if (incl >= (unsigned)need && above < (unsigned)need) { bc[0] = (unsigned)(255 - C.tid); bc[1] = (unsigned)need - above; } }
            }
            __syncthreads();
            prefix |= bc[0] << shift; pmask |= 255u << shift; need = (int)bc[1];
            __syncthreads();
        }
        const int per = (n + NTHR - 1) / NTHR; const int i0 = C.tid * per;
        unsigned cg = 0u, ce = 0u;
        for (int j = 0; j < per; ++j) { const int i = i0 + j; if (i < n) { const unsigned k = key[i]; cg += (k > prefix); ce += (k == prefix); } }
        unsigned pk = cg | (ce << 16), inc = pk;
#pragma unroll
        for (int o = 1; o < 64; o <<= 1) { const unsigned t = __shfl_up(inc, o); if (C.lane >= o) inc += t; }
        if (C.lane == 63) wtot[C.wave] = inc;
        __syncthreads();
        unsigned wbase = 0u;
        for (int w = 0; w < C.wave; ++w) wbase += wtot[w];
        const unsigned excl = wbase + inc - pk;
        unsigned rg = excl & 0xffffu, re = excl >> 16;
        const int ngt = cap - need;
        for (int j = 0; j < per; ++j) { const int i = i0 + j; if (i < n) { const unsigned k = key[i]; int pos = -1;
            if (k > prefix) { pos = (int)rg; ++rg; } else if (k == prefix) { if ((int)re < need) pos = ngt + (int)re; ++re; }
            const int row = row0 + i;
            if (pos >= 0) { IDX[slot0 + pos] = row; GATE[slot0 + pos] = __uint_as_float(k); SLOT[(size_t)row * 16 + e] = slot0 + pos; }
            else SLOT[(size_t)row * 16 + e] = -1; } }
        if (isctx && b == 0 && C.tid < ESLOTS - 4224) { IDX[e * ESLOTS + 4224 + C.tid] = 0; GATE[e * ESLOTS + 4224 + C.tid] = 0.f; }
        __syncthreads();
    }
}

__device__ __forceinline__ void phase_cb(const Ctx& C, const Args& A, int l) {
    unsigned char* ws = A.ws; float* X = (float*)(ws + WS_X); bf16_t* H = (bf16_t*)(ws + WS_H); const int* SLOT = (const int*)(ws + WS_SLOT); const bf16_t* YE = (const bf16_t*)(ws + WS_YE);
    const float* MOD = (const float*)(ws + WS_MOD) + (size_t)l * 5 * 6144; const float* MODN = MOD + 5 * 6144;
    const float* lng = A.in[I_LNG] + (size_t)(l * 2 + 1) * DM; const float* lnb = A.in[I_LNB] + (size_t)(l * 2 + 1) * DM;
    const float* lng1 = A.in[I_LNG] + (size_t)(l * 2 + 0) * DM; const float* lnb1 = A.in[I_LNB] + (size_t)(l * 2 + 0) * DM; const float* STAT = (const float*)(ws + WS_P);
    const int row0 = (int)(((long)C.gw * MROWS) / C.NGW), row1 = (int)(((long)(C.gw + 1) * MROWS) / C.NGW);
    f32x4 lngr[4], lnbr[4], gfr[4], nsc[4], nsh[4], l1g[4], l1b[4]; int cmi = -1;
#pragma unroll
    for (int j = 0; j < 4; ++j) { const int col = 4 * C.lane + 256 * j; lngr[j] = *(const f32x4*)(lng + col); lnbr[j] = *(const f32x4*)(lnb + col); gfr[j] = lngr[j]; nsc[j] = lngr[j]; nsh[j] = lngr[j];
        l1g[j] = *(const f32x4*)(lng1 + col); l1b[j] = *(const f32x4*)(lnb1 + col); }
    int svn = -1; f32x4 xn[4]; f32x2 stn = {0.f, 0.f};
    if (row0 < row1) { svn = SLOT[(size_t)row0 * 16 + (C.lane & 15)]; stn = *(const f32x2*)(STAT + (size_t)row0 * 2);
#pragma unroll
        for (int j = 0; j < 4; ++j) xn[j] = *(const f32x4*)(X + (size_t)row0 * DM + 4 * C.lane + 256 * j); }
    for (int row = row0; row < row1; ++row) {
        const int mi = row_mi(row);
        if (mi != cmi) { cmi = mi; const float* md = MOD + mi * 6144; const float* mn = MODN + mi * 6144;
#pragma unroll
            for (int j = 0; j < 4; ++j) { const int col = 4 * C.lane + 256 * j; gfr[j] = *(const f32x4*)(md + 5 * DM + col);
                if (l < DEPTH - 1) { nsc[j] = *(const f32x4*)(mn + DM + col) + 1.f; nsh[j] = *(const f32x4*)(mn + col); } } }
        const int sv = svn;
        unsigned mask = (unsigned)__ballot(sv >= 0) & 0xffffu;
        f32x4 acc[4];
#pragma unroll
        for (int j = 0; j < 4; ++j) acc[j] = (f32x4){0.f, 0.f, 0.f, 0.f};
        u32x2 y0[4], y1[4]; bool h0 = false, h1 = false;
        if (mask) { const int e = __builtin_ctz(mask); mask &= mask - 1; h0 = true; const int sl = __builtin_amdgcn_readlane(sv, e);
#pragma unroll
            for (int j = 0; j < 4; ++j) y0[j] = *(const u32x2*)(YE + (size_t)sl * DM + 4 * C.lane + 256 * j); }
        if (mask) { const int e = __builtin_ctz(mask); mask &= mask - 1; h1 = true; const int sl = __builtin_amdgcn_readlane(sv, e);
#pragma unroll
            for (int j = 0; j < 4; ++j) y1[j] = *(const u32x2*)(YE + (size_t)sl * DM + 4 * C.lane + 256 * j); }
        f32x4 x[4]; const f32x2 st = stn;
#pragma unroll
        for (int j = 0; j < 4; ++j) x[j] = xn[j];
        if (row + 1 < row1) { svn = SLOT[(size_t)(row + 1) * 16 + (C.lane & 15)]; stn = *(const f32x2*)(STAT + (size_t)(row + 1) * 2);
#pragma unroll
            for (int j = 0; j < 4; ++j) xn[j] = *(const f32x4*)(X + (size_t)(row + 1) * DM + 4 * C.lane + 256 * j); }
        if (h0) {
#pragma unroll
            for (int j = 0; j < 4; ++j) acc[j] += (f32x4){__uint_as_float(y0[j].x << 16), __uint_as_float(y0[j].x & 0xffff0000u), __uint_as_float(y0[j].y << 16), __uint_as_float(y0[j].y & 0xffff0000u)}; }
        if (h1) {
#pragma unroll
            for (int j = 0; j < 4; ++j) acc[j] += (f32x4){__uint_as_float(y1[j].x << 16), __uint_as_float(y1[j].x & 0xffff0000u), __uint_as_float(y1[j].y << 16), __uint_as_float(y1[j].y & 0xffff0000u)}; }
        while (mask) { const int e = __builtin_ctz(mask); mask &= mask - 1; const int sl = __builtin_amdgcn_readlane(sv, e);
#pragma unroll
            for (int j = 0; j < 4; ++j) acc[j] += ld4bf(YE + (size_t)sl * DM + 4 * C.lane + 256 * j); }
        float sm = 0.f;
#pragma unroll
        for (int j = 0; j < 4; ++j) { x[j] = ((x[j] - st[0]) * st[1] * l1g[j] + l1b[j]) * ALPHA_DN + gfr[j] * acc[j];
            sm += (x[j][0] + x[j][1]) + (x[j][2] + x[j][3]); }
        const float mean = wave_sum(sm) * (1.f / DM); float s2 = 0.f;
#pragma unroll
        for (int j = 0; j < 4; ++j) { x[j] = x[j] - mean; s2 += (x[j][0] * x[j][0] + x[j][1] * x[j][1]) + (x[j][2] * x[j][2] + x[j][3] * x[j][3]); }
        const float rstd = rsqrtf(wave_sum(s2) * (1.f / DM) + LN_EPS);
#pragma unroll
        for (int j = 0; j < 4; ++j) { const int col = 4 * C.lane + 256 * j;
            const f32x4 x2 = x[j] * rstd * lngr[j] + lnbr[j];
            if (l < DEPTH - 1) { *(f32x4*)(X + (size_t)row * DM + col) = x2; st4bf(H + (size_t)row * DM + col, x2 * nsc[j] + nsh[j]); }
            else if (row < NLAT) *(f32x4*)(A.out + (size_t)row * DM + col) = x2; }
    }
}


#ifndef GEMM_NOINLINE
#define GEMM_NOINLINE 0
#endif
#if GEMM_NOINLINE
#define GEMM_FN __device__ __noinline__
#else
#define GEMM_FN __device__ __forceinline__
#endif
GEMM_FN void gphase_in(LAS unsigned char* lds, unsigned char* ws, int nN, int G) {
    int bx = blockIdx.x; asm volatile("" : "+s"(bx), "+s"(G));
    pg8::Gemm g{(const bf16_t*)(ws + WS_H), (const bf16_t*)(ws + WS_WIN), DM}; pg8::Order<0> S; S.init(MROWS / 256, nN, G, bx, nullptr, 0);
    pg8::EpiBf16 E{(bf16_t*)(ws + WS_P), P_LD}; pg8::gemm_phase(lds, g, S, E); }
GEMM_FN void gphase_in_odd(LAS unsigned char* lds, unsigned char* ws, int G) {
    int bx = blockIdx.x; asm volatile("" : "+s"(bx), "+s"(G));
    pg8::Gemm g{(const bf16_t*)(ws + WS_H), (const bf16_t*)(ws + WS_WIN), DM}; pg8::Order<0> S; S.init(MROWS / 256, D_IN_ODD / 256, G, bx, nullptr, 0);
    pg8::EpiOdd E{(bf16_t*)(ws + WS_P), (bf16_t*)(ws + WS_Q), (bf16_t*)(ws + WS_KA), (const float*)(ws + WS_ROPE)}; pg8::gemm_phase(lds, g, S, E); }
GEMM_FN void gphase_lora(LAS unsigned char* lds, unsigned char* ws, const float* d0, const float* a0, const float* kal, int G) {
    int bx = blockIdx.x; asm volatile("" : "+s"(bx), "+s"(G));
    pg8::Gemm g{(const bf16_t*)(ws + WS_LIN), (const bf16_t*)(ws + WS_WLORA), LORA_K}; pg8::Order<0> S; S.init(MROWS / 256, LORA_N / 256, G, bx, nullptr, 0);
    pg8::EpiLora E{ws + WS_SCN, (bf16_t*)(ws + WS_G), d0, a0, kal}; pg8::gemm_phase(lds, g, S, E); }
GEMM_FN void gphase_out(LAS unsigned char* lds, unsigned char* ws, const float* modl, int G, const float* xin, const float* cin) {
    int bx = blockIdx.x; asm volatile("" : "+s"(bx), "+s"(G));
    pg8::Gemm g{(const bf16_t*)(ws + WS_A2), (const bf16_t*)(ws + WS_WOUT), DM}; pg8::Order<0> S; S.init(MROWS / 256, DM / 256, G, bx, nullptr, 0);
    pg8::EpiRes E{(float*)(ws + WS_X), modl, xin, cin}; pg8::gemm_phase(lds, g, S, E); }
GEMM_FN void gphase_e1(LAS unsigned char* lds, unsigned char* ws, int G, int l) {
    int bx = blockIdx.x; asm volatile("" : "+s"(bx), "+s"(G));
    pg8::Gemm g{(const bf16_t*)(ws + WS_H), (const bf16_t*)(ws + WS_WE13 + (size_t)(l & 1) * WE13_BYTES), DM}; pg8::EpiSwiGLU E{(bf16_t*)(ws + WS_HID)};
    pg8::OrderExp<1> S; S.init(4096 / 256, G, bx, (const int*)(ws + WS_IDX), (long)4096 * DM); pg8::gemm_phase(lds, g, S, E); }
GEMM_FN void gphase_e2(LAS unsigned char* lds, unsigned char* ws, int G, int l) {
    int bx = blockIdx.x; asm volatile("" : "+s"(bx), "+s"(G));
    pg8::Gemm g{(const bf16_t*)(ws + WS_HID), (const bf16_t*)(ws + WS_WE2 + (size_t)(l & 1) * WE2_BYTES), D_EXP}; pg8::EpiYE E{(bf16_t*)(ws + WS_YE), (const float*)(ws + WS_GATE)};
    pg8::OrderExp<2> S; S.init(DM / 256, G, bx, nullptr, (long)DM * D_EXP); pg8::gemm_phase(lds, g, S, E); }

constexpr int NSLOT = 13;
constexpr int NSTEP = 1 + DEPTH * NSLOT;
__global__ void __launch_bounds__(NTHR, 2) mk_fwd(Args KA) {
    extern __shared__ __attribute__((aligned(16))) unsigned char lds_raw[];
    volatile LAS unsigned* MISC = (volatile LAS unsigned*)((LAS unsigned char*)lds_raw + LDS_MISC);
    if (threadIdx.x < 16) MISC[threadIdx.x] = 0u;
    if (threadIdx.x == 0) { LAS unsigned long long* tb = (LAS unsigned long long*)((LAS unsigned char*)lds_raw + LDS_PTAB);
#pragma unroll
        for (int i = 0; i < 37; ++i) tb[i] = (unsigned long long)KA.in[i];
        tb[37] = (unsigned long long)KA.out; tb[38] = (unsigned long long)KA.ws; }
    __syncthreads();
    const int lo = KA.lo, hi = KA.hi;
    unsigned bar_x = 0;
    if (hi - lo > 1) { const XcdBarrier b0 = xcd_barrier_post((unsigned*)(KA.ws + WS_CTL), MISC); bar_x = b0.x; }
#ifndef PH_MASK
#define PH_MASK 0xFFFFFF
#endif
#ifndef REP_MASK
#define REP_MASK 0
#endif
#define PH_BIT(k) (((k) == 0) ? 0 : 1 + ((k) - 1) % NSLOT + (((k) - 1) % NSLOT >= 2 && ((k) - 1) % NSLOT <= 3 && odd ? 12 : 0))
#define RUN(k, ...) do { if (((PH_MASK >> PH_BIT(k)) & 1) && lo <= (k) && (k) < hi) { const int nrep = ((REP_MASK >> PH_BIT(k)) & 1) ? 2 : 1; \
        _Pragma("unroll 1") for (int rep = 0; rep < nrep; ++rep) { \
        Ctx C; mkctx(C, (LAS unsigned char*)lds_raw); Args A; ldargs(A, (LAS unsigned char*)lds_raw); unsigned char* ws = A.ws; \
        const float* MODL = (const float*)(ws + WS_MOD) + (size_t)l * 5 * 6144; (void)MODL; \
        __VA_ARGS__; if ((k) + 1 < hi || rep + 1 < nrep) { XcdBarrier bar; bar.bar = (unsigned*)(ws + WS_CTL); bar.x = bar_x; bar.st = MISC; xcd_barrier(bar); } } } } while (0)
    { const bool odd = false; const int l = 0; RUN(0, { phase_init(C, A); __syncthreads(); conv_items(C, A, 0, C.gw, C.NGW, true, true, true); }); }
#pragma unroll 1
    for (int l = 0; l < DEPTH; ++l) {
        const int sb = 1 + l * NSLOT; const bool odd = l & 1;
        if (!(CHUNKED_SCAN && odd)) { RUN(sb + 0, { phase_conv(C, A, l); if (l == 0) phase_modh(C, A, 0); }); }
        if (odd) { RUN(sb + 1, { gphase_in_odd(C.lds, ws, C.G);
                   const int tail = ((MROWS / 256) * (D_IN_ODD / 256)) % C.G;
                   if (CHUNKED_SCAN && l + 1 < DEPTH && tail > 0 && (int)blockIdx.x >= tail) conv_items(C, A, l + 1, ((int)blockIdx.x - tail) * NWAVES + C.wave, (C.G - tail) * NWAVES, false, false, true, 0, YW_IN_HI); }); }
        else { RUN(sb + 1, { gphase_in(C.lds, ws, D_IN_EVEN_PAD / 256, C.G);
                   const int tail = ((MROWS / 256) * (D_IN_EVEN_PAD / 256)) % C.G;
                   if (CHUNKED_SCAN && l + 1 < DEPTH && tail > 0 && (int)blockIdx.x >= tail) conv_items(C, A, l + 1, ((int)blockIdx.x - tail) * NWAVES + C.wave, (C.G - tail) * NWAVES, false, false, true, 0, XW_IN_HI); }); }
        if (!odd) {
            RUN(sb + 2, phase_ef1(C, A, l));
            RUN(sb + 3, { const int i2 = l >> 1; gphase_lora(C.lds, ws, A.in[I_D0] + (size_t)i2 * 2 * 768, A.in[I_A0] + (size_t)i2 * 2 * 768, A.in[I_KAL] + (size_t)i2 * 768, C.G); });
#if CHUNKED_SCAN
            RUN(sb + 4, phase_csa(C, A));
            RUN(sb + 5, phase_csb(C, A, l));
#else
            RUN(sb + 4, phase_scan(C, A));
#endif
            RUN(sb + 6, phase_ef2(C, A, l));
        } else {
            RUN(sb + 2, { phase_of1(C, A, l);
                   const int busy2 = 256 + 8 * 7 - C.G;
                   if (CHUNKED_SCAN && l + 1 < DEPTH && busy2 > 0 && (int)blockIdx.x >= busy2) conv_items(C, A, l + 1, ((int)blockIdx.x - busy2) * NWAVES + C.wave, (C.G - busy2) * NWAVES, false, false, true, YW_IN_HI, YW_OF_HI); });
            RUN(sb + 3, phase_attn(C, A, l));
        }
        RUN(sb + 7, { gphase_out(C.lds, ws, MODL, C.G, l == 0 ? A.in[I_X] : (const float*)(ws + WS_X), l == 0 ? A.in[I_CTX] : (const float*)(ws + WS_X) + (size_t)NLAT * DM);
                   const int tail = ((MROWS / 256) * (DM / 256)) % C.G;
                   if (CHUNKED_SCAN && l + 1 < DEPTH && tail > 0 && (int)blockIdx.x >= tail) conv_items(C, A, l + 1, ((int)blockIdx.x - tail) * NWAVES + C.wave, (C.G - tail) * NWAVES, false, false, true, odd ? YW_OF_HI : XW_IN_HI, odd ? YW_OUT_HI : XW_OUT_HI); });
        RUN(sb + 8, phase_rt(C, A, l));
        RUN(sb + 9, { phase_tk(C, A);
                   if (CHUNKED_SCAN && l + 1 < DEPTH && (int)blockIdx.x >= 128) conv_items(C, A, l + 1, ((int)blockIdx.x - 128) * NWAVES + C.wave, (C.G - 128) * NWAVES, false, false, true, odd ? YW_OUT_HI : XW_OUT_HI, odd ? YW_TK_HI : XW_TK_HI); });
        RUN(sb + 10, gphase_e1(C.lds, ws, C.G, l));
        RUN(sb + 11, gphase_e2(C.lds, ws, C.G, l));
        RUN(sb + 12, { phase_cb(C, A, l); if (CHUNKED_SCAN && !odd && l + 1 < DEPTH) { __syncthreads(); conv_items(C, A, l + 1, C.gw, C.NGW, false, true, false); } });
    }
#undef RUN
}

#ifdef PHASE_PROBE
#define PROBE_PRE extern __shared__ __attribute__((aligned(16))) unsigned char lds_raw[]; Ctx C; mkctx(C, (LAS unsigned char*)lds_raw); unsigned char* ws = A.ws; (void)ws;
__global__ void __launch_bounds__(NTHR, 2) pr_init(Args A) { PROBE_PRE phase_init(C, A); }
__global__ void __launch_bounds__(NTHR, 2) pr_conv(Args A) { PROBE_PRE phase_conv(C, A, A.lo); }
__global__ void __launch_bounds__(NTHR, 2) pr_modh(Args A) { PROBE_PRE phase_modh(C, A, A.lo); }
__global__ void __launch_bounds__(NTHR, 2) pr_ef1(Args A) { PROBE_PRE phase_ef1(C, A, A.lo); }
__global__ void __launch_bounds__(NTHR, 2) pr_scan(Args A) { PROBE_PRE phase_scan(C, A); }
__global__ void __launch_bounds__(NTHR, 2) pr_ef2(Args A) { PROBE_PRE phase_ef2(C, A, A.lo); }
__global__ void __launch_bounds__(NTHR, 2) pr_csa(Args A) { PROBE_PRE phase_csa(C, A); }
__global__ void __launch_bounds__(NTHR, 2) pr_csb(Args A) { PROBE_PRE phase_csb(C, A, A.lo); }
__global__ void __launch_bounds__(NTHR, 2) pr_of1(Args A) { PROBE_PRE phase_of1(C, A, A.lo); }
__global__ void __launch_bounds__(NTHR, 2) pr_attn(Args A) { PROBE_PRE phase_attn(C, A, A.lo); }
__global__ void __launch_bounds__(NTHR, 2) pr_rt(Args A) { PROBE_PRE phase_rt(C, A, A.lo); }
__global__ void __launch_bounds__(NTHR, 2) pr_tk(Args A) { PROBE_PRE phase_tk(C, A); }
__global__ void __launch_bounds__(NTHR, 2) pr_cb(Args A) { PROBE_PRE phase_cb(C, A, A.lo); }
__global__ void __launch_bounds__(NTHR, 2) pr_gemm_in(Args A) { PROBE_PRE pg8::Gemm g{(const bf16_t*)(ws + WS_H), (const bf16_t*)(ws + WS_WIN), DM}; pg8::Order<0> S; S.init(MROWS / 256, A.lo, C.G, (int)blockIdx.x, nullptr, 0);
                      pg8::EpiBf16 E{(bf16_t*)(ws + WS_P), P_LD}; pg8::gemm_phase(C.lds, g, S, E); }
__global__ void __launch_bounds__(NTHR, 2) pr_gemm_lora(Args A) { PROBE_PRE pg8::Gemm g{(const bf16_t*)(ws + WS_LIN), (const bf16_t*)(ws + WS_WLORA), LORA_K}; pg8::Order<0> S; S.init(MROWS / 256, LORA_N / 256, C.G, (int)blockIdx.x, nullptr, 0);
                          const int i2 = A.lo; pg8::EpiLora E{ws + WS_SCN, (bf16_t*)(ws + WS_G), A.in[I_D0] + (size_t)i2 * 2 * 768, A.in[I_A0] + (size_t)i2 * 2 * 768, A.in[I_KAL] + (size_t)i2 * 768};
                          pg8::gemm_phase(C.lds, g, S, E); }
__global__ void __launch_bounds__(NTHR, 2) pr_gemm_out(Args A) { PROBE_PRE pg8::Gemm g{(const bf16_t*)(ws + WS_A2), (const bf16_t*)(ws + WS_WOUT), DM}; pg8::Order<0> S; S.init(MROWS / 256, DM / 256, C.G, (int)blockIdx.x, nullptr, 0);
                      pg8::EpiRes E{(float*)(ws + WS_X), (const float*)(ws + WS_MOD), (const float*)(ws + WS_X), (const float*)(ws + WS_X) + (size_t)NLAT * DM}; pg8::gemm_phase(C.lds, g, S, E); }
__global__ void __launch_bounds__(NTHR, 2) pr_gemm_e1(Args A) { PROBE_PRE pg8::Gemm g{(const bf16_t*)(ws + WS_H), (const bf16_t*)(ws + WS_WE13), DM}; pg8::Order<1> S; S.init(NEXP * 17, 4096 / 256, C.G, (int)blockIdx.x, (const int*)(ws + WS_IDX), (long)4096 * DM);
                      pg8::EpiSwiGLU E{(bf16_t*)(ws + WS_HID)}; pg8::gemm_phase(C.lds, g, S, E); }
__global__ void __launch_bounds__(NTHR, 2) pr_gemm_e2(Args A) { PROBE_PRE pg8::Gemm g{(const bf16_t*)(ws + WS_HID), (const bf16_t*)(ws + WS_WE2), D_EXP}; pg8::Order<2> S; S.init(NEXP * 17, DM / 256, C.G, (int)blockIdx.x, nullptr, (long)DM * D_EXP);
                       pg8::EpiYE E{(bf16_t*)(ws + WS_YE), (const float*)(ws + WS_GATE)}; pg8::gemm_phase(C.lds, g, S, E); }
#endif

extern "C" void kernel_launch(void* const* d_in, const int* in_sizes, int n_in, void* d_out, int out_size, void* d_ws, size_t ws_size, hipStream_t stream) {
    static int grid = 0;
    if (grid == 0) {
        if (n_in != 37 || out_size != NLAT * DM || ws_size < WS_END) { fprintf(stderr, "kernel_launch: unexpected shapes: n_in %d out %d ws %zu (need %zu)\n", n_in, out_size, ws_size, (size_t)WS_END); grid = -1; return; }
        int dev = 0, cus = 0, per_cu = 0;
        if (hipGetDevice(&dev) != hipSuccess || hipDeviceGetAttribute(&cus, hipDeviceAttributeMultiprocessorCount, dev) != hipSuccess) { grid = -1; return; }
        if (hipFuncSetAttribute((const void*)mk_fwd, hipFuncAttributeMaxDynamicSharedMemorySize, LDS_BYTES) != hipSuccess) { fprintf(stderr, "kernel_launch: hipFuncSetAttribute failed\n"); grid = -1; return; }
        if (hipOccupancyMaxActiveBlocksPerMultiprocessor(&per_cu, (const void*)mk_fwd, NTHR, LDS_BYTES) != hipSuccess || per_cu < 1) fprintf(stderr, "kernel_launch: occupancy query reports %d\n", per_cu);
        (void)hipGetLastError();
        grid = cus;
    }
    if (grid < 0) return;
    (void)hipMemsetAsync((char*)d_ws + WS_CTL, 0, CTL_BYTES, stream);
    Args a{};
    for (int i = 0; i < 37; ++i) a.in[i] = (const float*)d_in[i];
    a.out = (float*)d_out; a.ws = (unsigned char*)d_ws;
#if MK_MULTI
    for (int k = 0; k < NSTEP; ++k) {
        if (k >= 1) { const int l = (k - 1) / NSLOT, s = (k - 1) % NSLOT; if ((l & 1) && ((s >= 4 && s <= 6) || (CHUNKED_SCAN && s == 0))) continue; if (!(l & 1) && !CHUNKED_SCAN && s == 5) continue; }
        a.lo = k; a.hi = k + 1;
        hipLaunchKernelGGL(mk_fwd, dim3(grid), dim3(NTHR), LDS_BYTES, stream, a);
    }
#else
    a.lo = 0; a.hi = NSTEP;
    hipLaunchKernelGGL(mk_fwd, dim3(grid), dim3(NTHR), LDS_BYTES, stream, a);
#endif
    const hipError_t le = hipPeekAtLastError();
    if (le != hipSuccess) fprintf(stderr, "kernel_launch: launch failed: %s\n", hipGetErrorName(le));
}
```

```cpp
#include <hip/hip_runtime.h>
#include <cstdio>
#include <cstdint>
#include <cmath>

#ifndef MK_MULTI
#define MK_MULTI 0
#endif
#ifndef CHUNKED_SCAN
#define CHUNKED_SCAN 1
#endif

#define GAS __attribute__((address_space(1)))
#define LAS __attribute__((address_space(3)))
typedef unsigned short bf16_t;
typedef short bf16x8 __attribute__((ext_vector_type(8)));
typedef float f32x4 __attribute__((ext_vector_type(4)));
typedef float f32x2 __attribute__((ext_vector_type(2)));
typedef float f32x16 __attribute__((ext_vector_type(16)));
typedef unsigned u32x4 __attribute__((ext_vector_type(4)));
typedef unsigned u32x2 __attribute__((ext_vector_type(2)));
typedef __bf16 bf16x2_t __attribute__((ext_vector_type(2)));

constexpr int NB = 4, TT = 8192, DM = 1024, NLAT = NB * TT, CTXL = 256, NCTX = NB * CTXL, MROWS = NLAT + NCTX;
constexpr int DEPTH = 4;
constexpr int D_CONV = 256, RW_H = 12, RW_K = 64, D_RWKV = 768, RWKV_COLS = 2688, D_IN_EVEN = 3456, D_IN_EVEN_PAD = 3584;
constexpr int D_DIFF = 768, D_GMLP = 256, D_IN_ODD = 2816;
constexpr int NEXP = 16, D_EXP = 2048, CAP_L = 1024, CAP_C = 32, ESLOTS = 4352;
constexpr int P_LD = 3584;
constexpr int LORA_K = 384, LORA_N = 3840;
constexpr int LKEYS = CTXL + TT;
constexpr float ALPHA_DN = 1.6817928305074290f;
constexpr float DECAY_SCALE = 0.6065306597126334f;
constexpr float GN_EPS = 64e-5f, LN_EPS = 1e-5f, RMS_EPS = 1e-5f;
constexpr float QSCALE = 0.125f * 1.4426950408889634f;

constexpr size_t al256(size_t x) { return (x + 255) & ~(size_t)255; }
constexpr size_t WS_CTL = 0;
constexpr size_t CTL_BYTES = 65536;
constexpr size_t WS_MOD = WS_CTL + CTL_BYTES;
constexpr size_t WS_ROPE = WS_MOD + al256((size_t)DEPTH * 5 * 6144 * 4);
constexpr size_t WS_WIN = WS_ROPE + 32768;
constexpr size_t WS_WOUT = WS_WIN + (size_t)D_IN_EVEN_PAD * DM * 2;
constexpr size_t WS_WLORA = WS_WOUT + (size_t)DM * DM * 2;
constexpr size_t WS_WE13 = WS_WLORA + (size_t)LORA_N * LORA_K * 2;
constexpr size_t WE13_BYTES = (size_t)NEXP * 4096 * DM * 2, WE2_BYTES = (size_t)NEXP * DM * D_EXP * 2;
constexpr size_t WS_WE2 = WS_WE13 + 2 * WE13_BYTES;
constexpr size_t WS_X = WS_WE2 + 2 * WE2_BYTES;
constexpr size_t WS_H = WS_X + (size_t)MROWS * DM * 4;
constexpr size_t WS_A2 = WS_H + (size_t)MROWS * DM * 2;
constexpr size_t WS_P = WS_A2 + (size_t)MROWS * DM * 2;
constexpr size_t WS_AFF = WS_P + (size_t)MROWS * P_LD * 2;
constexpr size_t WS_SLOT = WS_AFF + (size_t)MROWS * 16 * 4;
constexpr size_t WS_IDX = WS_SLOT + (size_t)MROWS * 16 * 4;
constexpr size_t WS_GATE = WS_IDX + al256((size_t)NEXP * ESLOTS * 4);
constexpr size_t WS_R2 = WS_GATE + al256((size_t)NEXP * ESLOTS * 4);
constexpr int SC_REC = 1408, SC_ROW = 12 * SC_REC, SC_W = 0, SC_R = 512, SC_KK = 640, SC_V = 768, SC_B = 896, SC_KR = 1024;
constexpr size_t WS_SCN = WS_R2;
constexpr size_t WS_G = WS_SCN + (size_t)MROWS * SC_ROW;
constexpr size_t WS_LIN = WS_G + (size_t)MROWS * 768 * 2;
constexpr int CS_L = 64, CS_NCH = LKEYS / CS_L, CS_UNITS = NB * RW_H * 2;
constexpr size_t WS_CHK = WS_LIN + (size_t)MROWS * 384 * 2;
constexpr size_t WS_EVEN_END = WS_CHK + (size_t)CS_UNITS * CS_NCH * 32768;
constexpr size_t WS_Y = WS_P;
constexpr size_t WS_Q = WS_R2;
constexpr size_t WS_KA = WS_Q + (size_t)MROWS * 768 * 2;
constexpr size_t WS_VT = WS_KA + (size_t)NB * LKEYS * 768 * 2;
constexpr size_t WS_HID = WS_R2;
constexpr size_t WS_YE = WS_HID + (size_t)NEXP * ESLOTS * D_EXP * 2;
constexpr size_t WS_END = WS_EVEN_END;
static_assert(WS_END <= (size_t)2147483648ull, "workspace over 2 GiB");
static_assert((size_t)2 * MROWS * 768 * 4 <= (size_t)MROWS * P_LD * 2, "Y aliases P");
static_assert(WS_YE + (size_t)NEXP * ESLOTS * DM * 2 <= WS_END, "moe region");

constexpr int LDS_BYTES = 147456;
constexpr int LDS_MISC = 140 * 1024;
constexpr int LDS_PTAB = LDS_MISC + 256;
constexpr int NWAVES = 8, NTHR = 512;

__device__ __forceinline__ unsigned f2bf(float f) { unsigned u = __float_as_uint(f); return (u + 0x7fffu + ((u >> 16) & 1u)) >> 16; }
__device__ __forceinline__ unsigned pk2(float lo, float hi) { f32x2 v = {lo, hi}; bf16x2_t b = __builtin_convertvector(v, bf16x2_t); return __builtin_bit_cast(unsigned, b); }
__device__ __forceinline__ float bflo(unsigned u) { return __uint_as_float(u << 16); }
__device__ __forceinline__ float bfhi(unsigned u) { return __uint_as_float(u & 0xffff0000u); }
__device__ __forceinline__ float bf2f(bf16_t b) { return __uint_as_float((unsigned)b << 16); }
__device__ __forceinline__ float sigmoidf_(float x) { return __builtin_amdgcn_rcpf(1.f + __expf(-x)); }
__device__ __forceinline__ float wave_sum(float v) {
#pragma unroll
    for (int o = 1; o < 64; o <<= 1) v += __shfl_xor(v, o);
    return v;
}
__device__ __forceinline__ float sum16(float v) {
#pragma unroll
    for (int o = 1; o < 16; o <<= 1) v += __shfl_xor(v, o);
    return v;
}
__device__ __forceinline__ f32x4 ld4bf_(const void* p) { const u32x2 u = *(const u32x2*)p; return (f32x4){bflo(u.x), bfhi(u.x), bflo(u.y), bfhi(u.y)}; }
__device__ __forceinline__ void st4bf_(void* p, f32x4 v) { u32x2 o; o.x = pk2(v[0], v[1]); o.y = pk2(v[2], v[3]); *(u32x2*)p = o; }
__device__ __forceinline__ float max3f(float a, float b, float c) { float r; asm("v_max3_f32 %0, %1, %2, %3" : "=v"(r) : "v"(a), "v"(b), "v"(c)); return r; }
__device__ __forceinline__ int crow(int r, int hi) { return (r & 3) + 8 * (r >> 2) + 4 * hi; }
__device__ __forceinline__ f32x2 gelu_pk(f32x2 v) {
    const f32x2 av = __builtin_elementwise_abs(v), d = av * 0.2316418882f + 1.0f;
    f32x2 t; t.x = __builtin_amdgcn_rcpf(d.x); t.y = __builtin_amdgcn_rcpf(d.y);
    f32x2 q = t * 0.5307027145f + (-0.7265760135f); q = q * t + 0.7107068705f; q = q * t + (-0.142248368f); q = q * t + 0.127414796f; q = q * t;
    const f32x2 s = (v * v) * (-0.72134752044f);
    f32x2 e; e.x = __builtin_amdgcn_exp2f(s.x); e.y = __builtin_amdgcn_exp2f(s.y);
    const f32x2 m = v * (q * e), r = v - m;
    f32x2 o; o.x = v.x < 0.f ? m.x : r.x; o.y = v.y < 0.f ? m.y : r.y; return o;
}
__device__ __forceinline__ f32x4 gelu4(f32x4 v) { const f32x2 a = gelu_pk((f32x2){v[0], v[1]}), b = gelu_pk((f32x2){v[2], v[3]}); return (f32x4){a.x, a.y, b.x, b.y}; }
__device__ __forceinline__ float tanh_fast(float x) { return 1.f - 2.f * __builtin_amdgcn_rcpf(1.f + __expf(2.f * x)); }

#define XB_TMO      128
#define XB_XCNT(j)  (256  + 64 * (j))
#define XB_XSUB(j)  (1280 + 64 * (j))
#define XB_XGEN(j)  (2304 + 64 * (j))
#define XB_TOP      3328
#define XB_TOPGEN   3392
#define XCD_BAR_WORDS 3456
#define XB_SPIN_CAP (1u << 20)

__device__ __forceinline__ unsigned xb_ld(unsigned* p)              { return __hip_atomic_load(p, __ATOMIC_RELAXED, __HIP_MEMORY_SCOPE_AGENT); }
__device__ __forceinline__ unsigned xb_add(unsigned* p, unsigned v) { return __hip_atomic_fetch_add(p, v, __ATOMIC_RELAXED, __HIP_MEMORY_SCOPE_AGENT); }
__device__ __forceinline__ unsigned xb_xcc_id() { return (unsigned)__builtin_amdgcn_s_getreg((3 << 11) | 20) & 0xFu; }
#define XB_SPIN(cond, bar) do { unsigned _sp = 0; while (cond) { __builtin_amdgcn_s_sleep(1); \
    if ((++_sp & 255u) == 0u) { if (xb_ld(&(bar)[XB_TMO])) break; if (_sp > XB_SPIN_CAP) { atomicAdd(&(bar)[XB_TMO], 1u); break; } } } } while (0)

struct XcdBarrier { unsigned* bar; unsigned x; volatile LAS unsigned* st; };

__device__ __forceinline__ XcdBarrier xcd_barrier_post(unsigned* bar, volatile LAS unsigned* st) {
    XcdBarrier b; b.bar = bar; b.x = xb_xcc_id(); b.st = st;
    if (threadIdx.x == 0) (void)xb_add(&bar[XB_XCNT(b.x)], 1u);
    return b;
}
__device__ __forceinline__ void xcd_barrier_complete(unsigned* bar, unsigned x, unsigned& nloc, unsigned& nx) {
    const unsigned G = gridDim.x * gridDim.y * gridDim.z;
    unsigned sum, cnt, mine, sp = 0u;
    for (;;) {
        sum = 0u; cnt = 0u; mine = 0u;
#pragma unroll
        for (unsigned j = 0; j < 16; ++j) { const unsigned c = xb_ld(&bar[XB_XCNT(j)]); sum += c; cnt += (c > 0u) ? 1u : 0u; mine = (j == x) ? c : mine; }
        if (sum == G) break;
        __builtin_amdgcn_s_sleep(1);
        if ((++sp & 255u) == 0u) { if (xb_ld(&bar[XB_TMO])) break; if (sp > XB_SPIN_CAP) { atomicAdd(&bar[XB_TMO], 1u); break; } }
    }
    nloc = mine > 0u ? mine : 1u; nx = cnt > 0u ? cnt : 1u;
}
__device__ __forceinline__ void xcd_barrier(const XcdBarrier& b) {
    asm volatile("s_waitcnt vmcnt(0)" ::: "memory");
    __syncthreads();
    if (threadIdx.x == 0) {
        unsigned* bar = b.bar;
        __builtin_amdgcn_s_waitcnt(0);
        unsigned nloc = b.st[0], nx = b.st[1];
        if (nloc == 0u) { xcd_barrier_complete(bar, b.x, nloc, nx); b.st[0] = nloc; b.st[1] = nx; }
        const unsigned old = xb_add(&bar[XB_XSUB(b.x)], 1u);
        const unsigned gen = old / nloc;
        if (old + 1u == (gen + 1u) * nloc) {
            __builtin_amdgcn_fence(__ATOMIC_RELEASE, "agent");
            asm volatile("s_waitcnt vmcnt(0)" ::: "memory");
            const unsigned og = xb_add(&bar[XB_TOP], 1u);
            const unsigned tg = og / nx;
            if (og + 1u == (tg + 1u) * nx) xb_add(&bar[XB_TOPGEN], 1u);
            else XB_SPIN(xb_ld(&bar[XB_TOPGEN]) == tg, bar);
            __builtin_amdgcn_fence(__ATOMIC_ACQUIRE, "agent");
            xb_add(&bar[XB_XGEN(b.x)], 1u);
            asm volatile("s_waitcnt vmcnt(0)" ::: "memory");
        } else {
            XB_SPIN(xb_ld(&bar[XB_XGEN(b.x)]) == gen, bar);
            __builtin_amdgcn_fence(__ATOMIC_ACQUIRE, "agent");
            asm volatile("s_waitcnt vmcnt(0)" ::: "memory");
        }
    }
    __syncthreads();
}

namespace pg8 {
constexpr int BM = 256, BK = 64, HALF = 128, HTB = HALF * BK * 2, STAGE_BYTES = 8 * HTB, NXCD = 8, WGM = 8;
__host__ __device__ __forceinline__ int lds_byte(int r, int c) { const int st = (r >> 4) * 2 + (c >> 5), rr = r & 15, cc = c & 31, ob = rr * 64 + cc * 2; return st * 1024 + (ob ^ (((ob >> 9) & 1) << 5)); }
__host__ __device__ __forceinline__ void stage_rc(int b, int& R, int& C) { const int st = b / 1024, sb = b % 1024, swz = sb ^ (((sb >> 9) & 1) << 5); R = (st >> 1) * 16 + swz / 64; C = (st & 1) * 32 + (swz % 64) / 2; }

struct Unit { int pm, pn, hf; };
struct Gemm { const bf16_t* A; const bf16_t* Bt; int K; };

template <int MODE> struct Order {
    static constexpr bool GATHER = (MODE == 1);
    int nM, nN, nwg, G, c; const int* idx; long bstride;
    __device__ __forceinline__ void init(int nM_, int nN_, int G_, int c_, const int* idx_, long bstride_) { nM = nM_; nN = nN_; nwg = nM * nN; G = G_; c = c_; idx = idx_; bstride = bstride_; }
    __device__ __forceinline__ bool next(int i, Unit& u) const {
        const long L = (long)i * G + c; if (L >= nwg) return false;
        int wgid = (int)L; { const int q = nwg / NXCD, r = nwg % NXCD, xcd = wgid % NXCD, off = wgid / NXCD; wgid = (xcd < r ? xcd * (q + 1) : r * (q + 1) + (xcd - r) * q) + off; }
        const int nig = WGM * nN, gid = wgid / nig, fm = gid * WGM, gsz = (nM - fm) < WGM ? (nM - fm) : WGM;
        u.pm = fm + ((wgid % nig) % gsz); u.pn = (wgid % nig) / gsz; u.hf = (MODE != 0 && (u.pm % 17) == 16) ? 1 : 0; return true;
    }
    __device__ __forceinline__ unsigned arow(const Unit& u, int r) const { if (MODE == 1) return (unsigned)idx[u.pm * BM + r]; return (unsigned)(u.pm * BM + r); }
    __device__ __forceinline__ long bbase(const Unit& u, int K) const { long o = (long)u.pn * BM * K; if (MODE != 0) o += (long)(u.pm / 17) * bstride; return o; }
};

template <int MODE> struct OrderExp {
    static constexpr bool GATHER = (MODE == 1);
    int nN, G, c0; const int* idx; long bstride;
    __device__ __forceinline__ void init(int nN_, int G_, int c_, const int* idx_, long bstride_) { nN = nN_; G = G_; c0 = c_; idx = idx_; bstride = bstride_; }
    __device__ __forceinline__ bool next(int i0, Unit& u) const {
        const int v = i0 * G + c0, i = v >> 8, c = v & 255;
        const int x = c & 7, slot = c >> 3, per = 32 / nN, nfull = 256 / (8 * per);
        if (i > nfull) return false;
        if (i < nfull) { u.pn = slot / per; const int f = (i * 8 + x) * per + (slot % per); u.pm = (f >> 4) * 17 + (f & 15); u.hf = 0; return true; }
        if (i == nfull && slot < 2 * nN) { u.pn = slot >> 1; u.pm = (x * 2 + (slot & 1)) * 17 + 16; u.hf = 1; return true; }
        return false;
    }
    __device__ __forceinline__ unsigned arow(const Unit& u, int r) const { if (MODE == 1) return (unsigned)idx[u.pm * BM + r]; return (unsigned)(u.pm * BM + r); }
    __device__ __forceinline__ long bbase(const Unit& u, int K) const { return (long)u.pn * BM * K + (long)(u.pm / 17) * bstride; }
};

template <class Epi, class Sched>
__device__ __forceinline__ void gemm_phase(LAS unsigned char* lds, const Gemm g, const Sched& S, const Epi& E) {
    int tid = threadIdx.x; asm volatile("" : "+v"(tid));
    const int wid = __builtin_amdgcn_readfirstlane(tid >> 6), wr = wid >> 2, wc = wid & 3;
    const int K = g.K, nt = K / BK;
    unsigned voffB[2];
    { const int lane = tid & 63, fr = lane & 15, fq = lane >> 4; (void)fr; (void)fq; }
#pragma unroll
    for (int i = 0; i < 2; ++i) { int R, Cc; stage_rc(tid * 16 + i * 8192, R, Cc); voffB[i] = (unsigned)(R * K + Cc) * 2u; }
    const size_t kstep = (size_t)(BK * 2);
    const size_t hstep = (size_t)HALF * K * 2;
    const unsigned ldsw = (unsigned)wid * 1024u;
    const int aoff = lds_byte(wr * 64 + (tid & 15), ((tid & 63) >> 4) * 8), boff = lds_byte(wc * 32 + (tid & 15), ((tid & 63) >> 4) * 8);
#define PG8_SA(b, h) (((b) * 2 + (h)) * HTB)
#define PG8_SB(b, h) ((4 + (b) * 2 + (h)) * HTB)
#define PG8_STAGE(bufoff, gbase, voff) do { _Pragma("unroll") for (int _i = 0; _i < 2; ++_i) \
        __builtin_amdgcn_global_load_lds((const unsigned*)((const char*)(gbase) + (voff)[_i]), (LAS unsigned*)(lds + (bufoff) + ldsw + _i * 8192), 16, 0, 0); } while (0)
#define PG8_LDA(dst, b, h) do { _Pragma("unroll") for (int m = 0; m < 4; ++m) _Pragma("unroll") for (int k = 0; k < 2; ++k) dst[m][k] = *(const LAS bf16x8*)(lds + PG8_SA(b, h) + aoff + m * 2048 + k * 1024); } while (0)
#define PG8_LDB(dst, b, h) do { _Pragma("unroll") for (int n = 0; n < 2; ++n) _Pragma("unroll") for (int k = 0; k < 2; ++k) dst[n][k] = *(const LAS bf16x8*)(lds + PG8_SB(b, h) + boff + n * 2048 + k * 1024); } while (0)
#define PG8_MMA(ai, bj, At, Bt) do { __builtin_amdgcn_s_setprio(1); _Pragma("unroll") for (int m = 0; m < 4; ++m) _Pragma("unroll") for (int n = 0; n < 2; ++n) _Pragma("unroll") for (int k = 0; k < 2; ++k) \
        acc[ai][bj][m][n] = __builtin_amdgcn_mfma_f32_16x16x32_bf16(Bt[n][k], At[m][k], acc[ai][bj][m][n], 0, 0, 0); __builtin_amdgcn_s_setprio(0); } while (0)
#define PG8_WAIT_V(n) asm volatile("s_waitcnt vmcnt(" #n ")" ::: "memory")
#define PG8_WAIT_L(n) asm volatile("s_waitcnt lgkmcnt(" #n ")" ::: "memory")
#define PG8_BAR __builtin_amdgcn_s_barrier()
#define PG8_SCHED __builtin_amdgcn_sched_barrier(0)
#define PG8_ROWOFFS(dst, u, tq) do { _Pragma("unroll") for (int _i = 0; _i < 2; ++_i) { int _R, _C; stage_rc((tq) * 16 + _i * 8192, _R, _C); _Pragma("unroll") for (int _h = 0; _h < 2; ++_h) dst[_h][_i] = (S.arow(u, _h * HALF + _R) * (unsigned)K + (unsigned)_C) * 2u; } } while (0)
    Unit cur, nxt; int ui = 0;
    if (!S.next(0, cur)) return;
    float zf = 0.f; asm volatile("" : "+v"(zf));
    f32x4 acc[2][2][4][2];
#pragma unroll
    for (int a = 0; a < 2; ++a)
#pragma unroll
        for (int b = 0; b < 2; ++b)
#pragma unroll
            for (int m = 0; m < 4; ++m)
#pragma unroll
                for (int n = 0; n < 2; ++n) acc[a][b][m][n] = (f32x4){zf, zf, zf, zf};
    bf16x8 At[4][2], B0[2][2], B1[2][2];
    unsigned vcur[2][2];
    if constexpr (Sched::GATHER) { PG8_ROWOFFS(vcur, cur, tid); }
    const char* const Ab = (const char*)g.A;
    const char* cA = Sched::GATHER ? Ab : Ab + (size_t)(unsigned)__builtin_amdgcn_readfirstlane((int)S.arow(cur, 0)) * K * 2;
#define PG8_STAGEA(bufoff, ptr, h) do { if constexpr (Sched::GATHER) { PG8_STAGE(bufoff, ptr, vcur[h]); } else { PG8_STAGE(bufoff, (ptr) + (h) * hstep, voffB); } } while (0)
    const char* cB = (const char*)g.Bt + (size_t)S.bbase(cur, K) * 2;
    PG8_STAGE(PG8_SB(0, 0), cB, voffB); PG8_STAGE(PG8_SB(0, 1), cB + hstep, voffB); PG8_STAGEA(PG8_SA(0, 0), cA, 0); PG8_STAGEA(PG8_SA(0, 1), cA, 1);
    if (wr == 1) PG8_BAR;
    PG8_WAIT_V(2); PG8_BAR;
    PG8_STAGE(PG8_SB(1, 0), cB + kstep, voffB); PG8_STAGEA(PG8_SA(1, 0), cA + kstep, 0); PG8_STAGE(PG8_SB(1, 1), cB + hstep + kstep, voffB);
    PG8_WAIT_V(6); PG8_BAR;
    for (;;) {
        const bool has_next = S.next(ui + 1, nxt);
        const char* nB = has_next ? (const char*)g.Bt + (size_t)S.bbase(nxt, K) * 2 : cB;
        const char* nA = (Sched::GATHER || !has_next) ? cA : Ab + (size_t)(unsigned)__builtin_amdgcn_readfirstlane((int)S.arow(nxt, 0)) * K * 2;
#pragma unroll 1
        for (int t = 0; t < nt; t += 2) {
            const bool last = (t == nt - 2);
            const char* a1 = cA + (size_t)(t + 1) * kstep;
            const char* a2 = last ? nA : cA + (size_t)(t + 2) * kstep; const char* b2 = last ? nB : cB + (size_t)(t + 2) * kstep;
            const char* a3 = a2 + kstep; const char* b3 = b2 + kstep;
            PG8_LDB(B0, 0, 0); PG8_LDB(B1, 0, 1); PG8_SCHED; PG8_LDA(At, 0, 0); PG8_STAGEA(PG8_SA(1, 1), a1, 1);
            PG8_WAIT_V(8); PG8_WAIT_L(0); PG8_BAR; PG8_MMA(0, 0, At, B0); PG8_MMA(0, 1, At, B1); PG8_BAR; PG8_SCHED;
            if constexpr (Sched::GATHER) { if (last && has_next) { int tq = tid; asm volatile("" : "+v"(tq)); PG8_ROWOFFS(vcur, nxt, tq); } }
            PG8_LDA(At, 0, 1); PG8_STAGE(PG8_SB(0, 0), b2, voffB); PG8_STAGE(PG8_SB(0, 1), b2 + hstep, voffB); PG8_STAGEA(PG8_SA(0, 0), a2, 0);
            PG8_WAIT_V(8); PG8_WAIT_L(0); PG8_BAR; if (!cur.hf) { PG8_MMA(1, 0, At, B0); PG8_MMA(1, 1, At, B1); } PG8_BAR; PG8_SCHED;
            PG8_LDB(B0, 1, 0); PG8_LDB(B1, 1, 1); PG8_SCHED; PG8_LDA(At, 1, 0); PG8_STAGEA(PG8_SA(0, 1), a2, 1);
            PG8_WAIT_V(8); PG8_WAIT_L(0); PG8_BAR; PG8_MMA(0, 0, At, B0); PG8_MMA(0, 1, At, B1); PG8_BAR; PG8_SCHED;
            PG8_LDA(At, 1, 1); PG8_STAGE(PG8_SB(1, 0), b3, voffB); PG8_STAGE(PG8_SB(1, 1), b3 + hstep, voffB); PG8_STAGEA(PG8_SA(1, 0), a3, 0);
            PG8_WAIT_V(8); PG8_WAIT_L(0); PG8_BAR; if (!cur.hf) { PG8_MMA(1, 0, At, B0); PG8_MMA(1, 1, At, B1); } PG8_BAR; PG8_SCHED;
        }
        if (wr == 0) PG8_BAR;
        { int tz = tid; asm volatile("" : "+v"(tz)); const int ln = tz & 63; E(acc, cur, wr, wc, ln & 15, ln >> 4); }
        if (!has_next) break;
#pragma unroll
        for (int a = 0; a < 2; ++a)
#pragma unroll
            for (int b = 0; b < 2; ++b)
#pragma unroll
                for (int m = 0; m < 4; ++m)
#pragma unroll
                    for (int n = 0; n < 2; ++n) acc[a][b][m][n] = (f32x4){zf, zf, zf, zf};
        cur = nxt; cB = nB; cA = nA; ++ui;
        if (wr == 1) PG8_BAR;
    }
    PG8_WAIT_V(0);
    PG8_BAR;
#undef PG8_SA
#undef PG8_SB
#undef PG8_STAGE
#undef PG8_LDA
#undef PG8_LDB
#undef PG8_MMA
#undef PG8_WAIT_V
#undef PG8_WAIT_L
#undef PG8_BAR
#undef PG8_SCHED
#undef PG8_ROWOFFS
#undef PG8_STAGEA
}

#define EPI_LOOP for (int ai = 0; ai < 2; ++ai) for (int m = 0; m < 4; ++m) for (int bj = 0; bj < 2; ++bj) for (int n = 0; n < 2; ++n)
__device__ __forceinline__ int colw_of(int fq) { return (fq & 1) * 16 + (fq >> 1) * 8; }
__device__ __forceinline__ void st_pair_bf16(bf16_t* p  , f32x4 v0, f32x4 v1) {
    const unsigned a0 = pk2(v0[0], v0[1]), a1 = pk2(v0[2], v0[3]), b0 = pk2(v1[0], v1[1]), b1 = pk2(v1[2], v1[3]);
    const auto r0 = __builtin_amdgcn_permlane16_swap(a0, b0, false, false); const auto r1 = __builtin_amdgcn_permlane16_swap(a1, b1, false, false);
    u32x4 o; o.x = r0[0]; o.y = r1[0]; o.z = r0[1]; o.w = r1[1]; *(u32x4*)p = o;
}
struct EpiBf16 {
    bf16_t* O; int ldc;
    __device__ __forceinline__ void operator()(const f32x4 (&acc)[2][2][4][2], const Unit& u, int wr, int wc, int fr, int fq) const {
        const int row0 = u.pm * BM + wr * 64 + fr, colg = u.pn * BM + wc * 32 + colw_of(fq);
#pragma unroll
        for (int ai = 0; ai < 2; ++ai)
#pragma unroll
            for (int m = 0; m < 4; ++m) { bf16_t* rowp = O + (size_t)(row0 + ai * HALF + m * 16) * ldc + colg;
#pragma unroll
                for (int bj = 0; bj < 2; ++bj) st_pair_bf16(rowp + bj * HALF, acc[ai][bj][m][0], acc[ai][bj][m][1]); }
    }
};
struct EpiOdd {
    bf16_t* P; bf16_t* Q; bf16_t* KA; const float* rope;
    __device__ __forceinline__ void operator()(const f32x4 (&acc)[2][2][4][2], const Unit& u, int wr, int wc, int fr, int fq) const {
        const int row0 = u.pm * BM + wr * 64 + fr, col0 = u.pn * BM + wc * 32 + 4 * fq;
        if (u.pn >= 6) {
#pragma unroll
            for (int ai = 0; ai < 2; ++ai)
#pragma unroll
                for (int m = 0; m < 4; ++m) { bf16_t* rowp = P + (size_t)(row0 + ai * HALF + m * 16) * P_LD + (col0 - 4 * fq + colw_of(fq));
#pragma unroll
                    for (int bj = 0; bj < 2; ++bj) st_pair_bf16(rowp + bj * HALF, acc[ai][bj][m][0], acc[ai][bj][m][1]); }
            return;
        }
        const bool isk = u.pn >= 3, isctx = u.pm >= NLAT / BM; const int axis = wc & 1;
        const int cq = col0 - (isk ? 768 : 0);
        f32x4 csr[2][4], snr[2][4];
#pragma unroll
        for (int ai = 0; ai < 2; ++ai)
#pragma unroll
            for (int m = 0; m < 4; ++m) { const int row = row0 + ai * HALF + m * 16; csr[ai][m] = (f32x4){1.f, 1.f, 1.f, 1.f}; snr[ai][m] = (f32x4){0.f, 0.f, 0.f, 0.f};
                if (!isctx) { const int t = row & (TT - 1); const int pos = axis ? 128 + (t & 63) : (t >> 6);
                    csr[ai][m] = *(const f32x4*)(rope + pos * 16 + 4 * fq); snr[ai][m] = *(const f32x4*)(rope + 192 * 16 + pos * 16 + 4 * fq); } }
#pragma unroll
        for (int ai = 0; ai < 2; ++ai)
#pragma unroll
            for (int m = 0; m < 4; ++m) { const int row = row0 + ai * HALF + m * 16;
                const f32x4 cs = csr[ai][m], sn = snr[ai][m]; size_t orow;
                if (!isctx) { const int t = row & (TT - 1); orow = isk ? (size_t)(row >> 13) * LKEYS + CTXL + t : (size_t)row; }
                else { const int rc = row - NLAT; orow = isk ? (size_t)(rc >> 8) * LKEYS + (rc & 255) : (size_t)row; }
                bf16_t* op = (isk ? KA : Q) + orow * 768 + cq; const float sc = isk ? 1.f : QSCALE;
#pragma unroll
                for (int bj = 0; bj < 2; ++bj) { const f32x4 x1 = acc[ai][bj][m][0], x2 = acc[ai][bj][m][1];
                    const f32x4 o1 = (x1 * cs - x2 * sn) * sc, o2 = (x1 * sn + x2 * cs) * sc;
                    st_pair_bf16(op + bj * HALF - 4 * fq + colw_of(fq), o1, o2); } }
    }
};
struct EpiRes {
    float* X; const float* modl; const float* xin; const float* cin;
    __device__ __forceinline__ void operator()(const f32x4 (&acc)[2][2][4][2], const Unit& u, int wr, int wc, int fr, int fq) const {
        const int row0 = u.pm * BM + wr * 64 + fr, col0 = u.pn * BM + wc * 32 + 4 * fq;
        const int mi = (u.pm * BM < NLAT) ? (u.pm * BM) / TT : 4;
        const float* gate = modl + mi * 6144 + 2 * DM;
        const float* rsrc = (u.pm * BM < NLAT) ? xin : cin - (size_t)NLAT * DM;
        f32x4 gv[2][2];
#pragma unroll
        for (int bj = 0; bj < 2; ++bj)
#pragma unroll
            for (int n = 0; n < 2; ++n) gv[bj][n] = *(const f32x4*)(gate + col0 + bj * HALF + n * 16);
#pragma unroll
        for (int ai = 0; ai < 2; ++ai) { f32x4 xr[4][2][2];
#pragma unroll
            for (int m = 0; m < 4; ++m) { const float* rowp = rsrc + (size_t)(row0 + ai * HALF + m * 16) * DM + col0;
#pragma unroll
                for (int bj = 0; bj < 2; ++bj)
#pragma unroll
                    for (int n = 0; n < 2; ++n) xr[m][bj][n] = *(const f32x4*)(rowp + bj * HALF + n * 16); }
#pragma unroll
            for (int m = 0; m < 4; ++m) { float* rowp = X + (size_t)(row0 + ai * HALF + m * 16) * DM + col0;
#pragma unroll
                for (int bj = 0; bj < 2; ++bj)
#pragma unroll
                    for (int n = 0; n < 2; ++n) *(f32x4*)(rowp + bj * HALF + n * 16) = xr[m][bj][n] * ALPHA_DN + gv[bj][n] * acc[ai][bj][m][n]; } }
    }
};
struct EpiSwiGLU {
    bf16_t* HID;
    __device__ __forceinline__ void operator()(const f32x4 (&acc)[2][2][4][2], const Unit& u, int wr, int wc, int fr, int fq) const {
        const int row0 = u.pm * BM + wr * 64 + fr, f0 = u.pn * HALF + wc * 32 + 4 * fq;
#pragma unroll
        for (int ai = 0; ai < 2; ++ai) if (ai == 0 || !u.hf)
#pragma unroll
            for (int m = 0; m < 4; ++m) { bf16_t* rowp = HID + (size_t)(row0 + ai * HALF + m * 16) * D_EXP + u.pn * HALF + wc * 32 + colw_of(fq); f32x4 hh[2];
#pragma unroll
                for (int n = 0; n < 2; ++n) { const f32x4 a = acc[ai][0][m][n], b = acc[ai][1][m][n];
#pragma unroll
                    for (int j = 0; j < 4; ++j) hh[n][j] = a[j] * __builtin_amdgcn_rcpf(1.f + __expf(-a[j])) * b[j]; }
                st_pair_bf16(rowp, hh[0], hh[1]); }
    }
};
struct EpiYE {
    bf16_t* YE; const float* gate;
    __device__ __forceinline__ void operator()(const f32x4 (&acc)[2][2][4][2], const Unit& u, int wr, int wc, int fr, int fq) const {
        const int row0 = u.pm * BM + wr * 64 + fr, col0 = u.pn * BM + wc * 32 + 4 * fq;
        float gts[2][4];
#pragma unroll
        for (int ai = 0; ai < 2; ++ai)
#pragma unroll
            for (int m = 0; m < 4; ++m) gts[ai][m] = gate[row0 + ai * HALF + m * 16];
#pragma unroll
        for (int ai = 0; ai < 2; ++ai) if (ai == 0 || !u.hf)
#pragma unroll
            for (int m = 0; m < 4; ++m) { const int row = row0 + ai * HALF + m * 16; const float gt = gts[ai][m]; bf16_t* rowp = YE + (size_t)row * DM + (col0 - 4 * fq + colw_of(fq));
#pragma unroll
                for (int bj = 0; bj < 2; ++bj) st_pair_bf16(rowp + bj * HALF, acc[ai][bj][m][0] * gt, acc[ai][bj][m][1] * gt); }
    }
};
struct EpiLora {
    unsigned char* SCN; bf16_t* G; const float* decay0; const float* a0; const float* kalpha;
    __device__ __forceinline__ void operator()(const f32x4 (&acc)[2][2][4][2], const Unit& u, int wr, int wc, int fr, int fq) const {
        const int row0 = u.pm * BM + wr * 64 + fr;
        const int seg = u.pn / 3, cb = (u.pn % 3) * BM + wc * 32 + 4 * fq, cw = colw_of(fq) - 4 * fq;
        f32x4 par0[2][2], par1[2][2];
#pragma unroll
        for (int bj = 0; bj < 2; ++bj)
#pragma unroll
            for (int n = 0; n < 2; ++n) { const int col = cb + bj * HALF + n * 16; par0[bj][n] = (f32x4){0.f, 0.f, 0.f, 0.f}; par1[bj][n] = par0[bj][n];
                if (seg < 2) par0[bj][n] = *(const f32x4*)(decay0 + seg * 768 + col);
                else if (seg < 4) { par0[bj][n] = *(const f32x4*)(a0 + (seg - 2) * 768 + col); par1[bj][n] = *(const f32x4*)(kalpha + col); } }
#pragma unroll
        for (int bj = 0; bj < 2; ++bj) {
            const int colA = cb + bj * HALF, head = colA >> 6, kx0 = colA & 63;
            if (seg < 2) {
#pragma unroll
                for (int n = 0; n < 2; ++n) { const f32x4 d0 = par0[bj][n]; const int kx = kx0 + n * 16;
#pragma unroll
                    for (int ai = 0; ai < 2; ++ai)
#pragma unroll
                        for (int m = 0; m < 4; ++m) { const int row = row0 + ai * HALF + m * 16; f32x4 w;
#pragma unroll
                            for (int j = 0; j < 4; ++j) { const float lw = -DECAY_SCALE * sigmoidf_(d0[j] + acc[ai][bj][m][n][j]); w[j] = CHUNKED_SCAN ? lw : __expf(lw); }
                            *(f32x4*)(SCN + (size_t)(row * 12 + head) * SC_REC + SC_W + seg * 256 + kx * 4) = w; __builtin_amdgcn_sched_barrier(0); } }
            } else if (seg < 4) {
                const int d = seg - 2;
#pragma unroll
                for (int ai = 0; ai < 2; ++ai) {
                    u32x2 kkr[2][4], ksr[2][4];
#pragma unroll
                    for (int n = 0; n < 2; ++n)
#pragma unroll
                        for (int m = 0; m < 4; ++m) { const unsigned char* base = SCN + (size_t)((row0 + ai * HALF + m * 16) * 12 + head) * SC_REC + (kx0 + n * 16) * 2;
                            kkr[n][m] = *(const u32x2*)(base + SC_KK); ksr[n][m] = *(const u32x2*)(base + SC_KR + 256 * d); }
#pragma unroll
                    for (int m = 0; m < 4; ++m) { const int row = row0 + ai * HALF + m * 16; unsigned char* base = SCN + (size_t)(row * 12 + head) * SC_REC + (kx0 + cw) * 2; f32x4 bb[2], kr[2];
#pragma unroll
                        for (int n = 0; n < 2; ++n) { const f32x4 a00 = par0[bj][n], kal = par1[bj][n];
                            const f32x4 kk = {bflo(kkr[n][m].x), bfhi(kkr[n][m].x), bflo(kkr[n][m].y), bfhi(kkr[n][m].y)}; const f32x4 ks = {bflo(ksr[n][m].x), bfhi(ksr[n][m].x), bflo(ksr[n][m].y), bfhi(ksr[n][m].y)};
#pragma unroll
                            for (int j = 0; j < 4; ++j) { const float a = sigmoidf_(a00[j] + acc[ai][bj][m][n][j]); bb[n][j] = kk[j] * a; kr[n][j] = ks[j] * (1.f + (a - 1.f) * kal[j]); } }
                        st_pair_bf16((bf16_t*)(base + SC_B + 256 * d), bb[0], bb[1]); st_pair_bf16((bf16_t*)(base + SC_KR + 256 * d), kr[0], kr[1]); __builtin_amdgcn_sched_barrier(0); } }
            } else {
#pragma unroll
                for (int ai = 0; ai < 2; ++ai)
#pragma unroll
                    for (int m = 0; m < 4; ++m) { const int row = row0 + ai * HALF + m * 16; st_pair_bf16(G + (size_t)row * 768 + colA + cw, acc[ai][bj][m][0], acc[ai][bj][m][1]); }
            }
        }
    }
};
}

struct Args { const float* in[37]; float* out; unsigned char* ws; int lo, hi; };
enum { I_X = 0, I_C, I_CTX, I_CCTX, I_WMOD, I_BMOD, I_LNG, I_LNB, I_EWIN, I_EWOUT, I_CONVW, I_MU, I_DUP, I_D0, I_AUP, I_A0, I_GUP, I_KXI, I_KAL, I_RBON, I_GNG, I_GNB,
       I_OWIN, I_OWOUT, I_LQ1, I_LK1, I_LQ2, I_LK2, I_SUBG, I_GLNG, I_GLNB, I_GWS, I_GBS, I_WR, I_WE1, I_WE3, I_WE2 };

struct Ctx {
    LAS unsigned char* lds;
    int tid, lane, wave, G, vcu, gw, NGW;
};
__device__ __forceinline__ void mkctx(Ctx& C, LAS unsigned char* lds) {
    int tid = threadIdx.x; asm volatile("" : "+v"(tid));
    C.lds = lds; C.tid = tid; C.lane = tid & 63; C.wave = __builtin_amdgcn_readfirstlane(tid >> 6);
    C.G = gridDim.x; { const int bx = blockIdx.x; C.vcu = (C.G % 8 == 0) ? (bx % 8) * (C.G / 8) + bx / 8 : bx; }
    C.gw = blockIdx.x * NWAVES + C.wave; C.NGW = C.G * NWAVES;
}
#define GLOBAL_PTR(T, v) ((T*)(__attribute__((address_space(1))) T*)(v))
__device__ __forceinline__ void ldargs(Args& A, LAS unsigned char* lds) {
    LAS const u32x2* tb = (LAS const u32x2*)(lds + LDS_PTAB); asm volatile("" : "+v"(tb));
#pragma unroll
    for (int i = 0; i < 37; ++i) { const u32x2 v = tb[i]; A.in[i] = GLOBAL_PTR(const float, ((unsigned long long)(unsigned)__builtin_amdgcn_readfirstlane((int)v.y) << 32) | (unsigned)__builtin_amdgcn_readfirstlane((int)v.x)); }
    { const u32x2 v = tb[37]; A.out = GLOBAL_PTR(float, ((unsigned long long)(unsigned)__builtin_amdgcn_readfirstlane((int)v.y) << 32) | (unsigned)__builtin_amdgcn_readfirstlane((int)v.x)); }
    { const u32x2 v = tb[38]; A.ws = GLOBAL_PTR(unsigned char, ((unsigned long long)(unsigned)__builtin_amdgcn_readfirstlane((int)v.y) << 32) | (unsigned)__builtin_amdgcn_readfirstlane((int)v.x)); }
    A.lo = 0; A.hi = 0;
}
__device__ __forceinline__ int row_mi(int row) { return row < NLAT ? (row >> 13) : 4; }

__device__ __forceinline__ void phase_init(const Ctx& C, const Args& A) {
    unsigned char* ws = A.ws;
    float* MOD = (float*)(ws + WS_MOD);
    LAS float* sv = (LAS float*)C.lds;
    LAS float* red = sv + 5 * 1024;
    for (int i = C.tid; i < 5 * 1024; i += NTHR) { const int v = i >> 10, k = i & 1023; const float c = (v < 4) ? A.in[I_C][v * DM + k] : A.in[I_CCTX][k]; sv[i] = c / (1.f + __expf(-c)); }
    __syncthreads();
    const int j = C.tid & 127, kp = C.tid >> 7;
    for (int it = blockIdx.x; it < DEPTH * 48; it += C.G) {
        const int l = it / 48, cg = it % 48, col = cg * 128 + j;
        const float* W = A.in[I_WMOD] + (size_t)l * DM * 6144 + col;
        float a0 = 0.f, a1 = 0.f, a2 = 0.f, a3 = 0.f, a4 = 0.f;
#pragma unroll 32
        for (int k = kp * 256; k < kp * 256 + 256; ++k) { const float w = W[(size_t)k * 6144];     a0 += sv[k] * w; a1 += sv[1024 + k] * w; a2 += sv[2048 + k] * w; a3 += sv[3072 + k] * w; a4 += sv[4096 + k] * w; }
        red[(kp * 5 + 0) * 128 + j] = a0; red[(kp * 5 + 1) * 128 + j] = a1; red[(kp * 5 + 2) * 128 + j] = a2; red[(kp * 5 + 3) * 128 + j] = a3; red[(kp * 5 + 4) * 128 + j] = a4;
        __syncthreads();
        for (int o = C.tid; o < 5 * 128; o += NTHR) { const int v = o >> 7, jj = o & 127; const int cc = cg * 128 + jj;
            const float s = red[(0 * 5 + v) * 128 + jj] + red[(1 * 5 + v) * 128 + jj] + red[(2 * 5 + v) * 128 + jj] + red[(3 * 5 + v) * 128 + jj];
            MOD[((size_t)l * 5 + v) * 6144 + cc] = s + A.in[I_BMOD][l * 6144 + cc]; }
        __syncthreads();
    }
    if (blockIdx.x == C.G - 1) { float* rope = (float*)(ws + WS_ROPE);
        for (int i = C.tid; i < 192 * 16; i += NTHR) { const int pos = i >> 4, j = i & 15; const float ang = (float)(pos < 128 ? pos : pos - 128) * powf(10000.f, -(float)j * (1.f / 16.f));
            rope[i] = cosf(ang); rope[192 * 16 + i] = sinf(ang); } }
}

__device__ __forceinline__ void transpose_item(const float* W, int ldw, int k0, int n0, bf16_t* WT, int ldt, int drow0, LAS float* scr, int lane) {
    { float v[64]; const float* src = W + (size_t)k0 * ldw + n0 + lane;
#pragma unroll
      for (int k = 0; k < 64; ++k) v[k] = __builtin_nontemporal_load(src + (size_t)k * ldw);
#pragma unroll
      for (int k = 0; k < 64; ++k) scr[k * 65 + lane] = v[k]; }
    asm volatile("s_waitcnt lgkmcnt(0)" ::: "memory");
    const int c = lane & 7;
#pragma unroll
    for (int j = 0; j < 8; ++j) { const int n = (lane >> 3) + 8 * j; const LAS float* s = scr + (8 * c) * 65 + n;
        u32x4 o; o.x = pk2(s[0 * 65], s[1 * 65]); o.y = pk2(s[2 * 65], s[3 * 65]); o.z = pk2(s[4 * 65], s[5 * 65]); o.w = pk2(s[6 * 65], s[7 * 65]);
        *(u32x4*)(WT + (size_t)(drow0 + n) * ldt + k0 + 8 * c) = o; }
    asm volatile("s_waitcnt lgkmcnt(0)" ::: "memory");
}
constexpr int XW_IN_HI = 3200, XW_OUT_HI = 7040, XW_TK_HI = 9088;
constexpr int YW_IN_HI = 1344, YW_OF_HI = 6144, YW_OUT_HI = 9984, YW_TK_HI = 12032;
__device__ __forceinline__ void conv_items(const Ctx& C, const Args& A, int l, int gw, int NGW, bool do_in, bool do_out, bool do_exp, int lo = 0, int hi = 1 << 30) {
    unsigned char* ws = A.ws;
    const int i2 = l >> 1; const bool odd = (l & 1);
    LAS float* scr = (LAS float*)C.lds + C.wave * (64 * 65);
    bf16_t* WIN = (bf16_t*)(ws + WS_WIN); bf16_t* WOUT = (bf16_t*)(ws + WS_WOUT); bf16_t* WE13 = (bf16_t*)(ws + WS_WE13 + (size_t)(l & 1) * WE13_BYTES); bf16_t* WE2 = (bf16_t*)(ws + WS_WE2 + (size_t)(l & 1) * WE2_BYTES);
    const int nin = odd ? D_IN_ODD : D_IN_EVEN;
    const float* win = odd ? A.in[I_OWIN] + (size_t)i2 * DM * D_IN_ODD : A.in[I_EWIN] + (size_t)i2 * DM * D_IN_EVEN;
    const float* wout = odd ? A.in[I_OWOUT] + (size_t)i2 * DM * DM : A.in[I_EWOUT] + (size_t)i2 * DM * DM;
    const int n_in = do_in ? 16 * (nin / 64) : 0, n_out = do_out ? 16 * 16 : 0, n_e13 = do_exp ? NEXP * 2 * 16 * 32 : 0, n_e2 = do_exp ? NEXP * 32 * 16 : 0;
    const int total = (n_in + n_out + n_e13 + n_e2) < hi ? (n_in + n_out + n_e13 + n_e2) : hi;
    for (int it = lo + gw; it < total; it += NGW) {
        int r = it;
        if (r < n_in) { const int nb = nin / 64, kb = r / nb, nn = r % nb; transpose_item(win, nin, kb * 64, nn * 64, WIN, DM, nn * 64, scr, C.lane); continue; } r -= n_in;
        if (r < n_out) { const int kb = r / 16, nn = r % 16; transpose_item(wout, DM, kb * 64, nn * 64, WOUT, DM, nn * 64, scr, C.lane); continue; } r -= n_out;
        if (r < n_e13) { const int e = r / 1024, q = r % 1024, mat = q / 512, q2 = q % 512, kb = q2 / 32, nn = q2 % 32;
            const float* W = (mat ? A.in[I_WE3] : A.in[I_WE1]) + ((size_t)l * NEXP + e) * DM * D_EXP;
            const int f0 = nn * 64; const int drow = (f0 >> 7) * 256 + mat * 128 + (f0 & 127);
            transpose_item(W, D_EXP, kb * 64, f0, WE13 + (size_t)e * 4096 * DM, DM, drow, scr, C.lane); continue; } r -= n_e13;
        { const int e = r / 512, q = r % 512, kb = q / 16, nn = q % 16;
            const float* W = A.in[I_WE2] + ((size_t)l * NEXP + e) * D_EXP * DM;
            transpose_item(W, DM, kb * 64, nn * 64, WE2 + (size_t)e * DM * D_EXP, D_EXP, nn * 64, scr, C.lane); }
    }
}
__device__ __forceinline__ void phase_conv(const Ctx& C, const Args& A, int l) {
    unsigned char* ws = A.ws;
    const int i2 = l >> 1; const bool odd = (l & 1);
    bf16_t* WIN = (bf16_t*)(ws + WS_WIN);
    const bool early = CHUNKED_SCAN && odd;
    if (l > 0) { if (early || !CHUNKED_SCAN) conv_items(C, A, l, C.gw, C.NGW, !early, true, !early);
                 else { conv_items(C, A, l, C.gw, C.NGW, true, true, false); conv_items(C, A, l, C.gw, C.NGW, false, false, true, YW_TK_HI); } }
    if (!odd) {
        u32x4* z = (u32x4*)(WIN + (size_t)D_IN_EVEN * DM);
        unsigned zz = 0u; asm volatile("" : "+v"(zz));
        for (int i = blockIdx.x * NTHR + C.tid; i < (D_IN_EVEN_PAD - D_IN_EVEN) * DM / 8; i += C.G * NTHR) z[i] = (u32x4){zz, zz, zz, zz};
        bf16_t* WL = (bf16_t*)(ws + WS_WLORA);
        const float* dup = A.in[I_DUP] + (size_t)i2 * 2 * 64 * 768; const float* aup = A.in[I_AUP] + (size_t)i2 * 2 * 64 * 768; const float* gup = A.in[I_GUP] + (size_t)i2 * 128 * 768;
        for (int i = blockIdx.x * NTHR + C.tid; i < LORA_N * LORA_K; i += C.G * NTHR) {
            const int kk = i / LORA_N, n = i % LORA_N, seg = n / 768, col = n % 768; float v = 0.f;
            if (seg == 0) { if (kk < 64) v = dup[(size_t)(0 * 64 + kk) * 768 + col]; }
            else if (seg == 1) { if (kk >= 64 && kk < 128) v = dup[(size_t)(1 * 64 + kk - 64) * 768 + col]; }
            else if (seg == 2) { if (kk >= 128 && kk < 192) v = aup[(size_t)(0 * 64 + kk - 128) * 768 + col]; }
            else if (seg == 3) { if (kk >= 192 && kk < 256) v = aup[(size_t)(1 * 64 + kk - 192) * 768 + col]; }
            else { if (kk >= 256) v = gup[(size_t)(kk - 256) * 768 + col]; }
            WL[(size_t)n * LORA_K + kk] = (bf16_t)f2bf(v);
        }
    }
}

__device__ __forceinline__ void phase_modh(const Ctx& C, const Args& A, int l) {
    bf16_t* H = (bf16_t*)(A.ws + WS_H); const float* MOD = (const float*)(A.ws + WS_MOD) + (size_t)l * 5 * 6144;
    const float* xin = A.in[I_X]; const float* cin = A.in[I_CTX] - (size_t)NLAT * DM;
#define MODH_SRC(row_) (((row_) < NLAT ? xin : cin) + (size_t)(row_) * DM)
    const int row0 = (int)(((long)C.gw * MROWS) / C.NGW), row1 = (int)(((long)(C.gw + 1) * MROWS) / C.NGW);
    f32x4 shr[4], scr_[4], xn[4]; int cmi = -1;
    if (row0 < row1) {
#pragma unroll
        for (int j = 0; j < 4; ++j) xn[j] = *(const f32x4*)(MODH_SRC(row0) + 4 * C.lane + 256 * j); }
#pragma unroll
    for (int j = 0; j < 4; ++j) { shr[j] = (f32x4){0.f, 0.f, 0.f, 0.f}; scr_[j] = shr[j]; }
    for (int row = row0; row < row1; ++row) {
        const int mi = row_mi(row);
        if (mi != cmi) { cmi = mi; const float* md = MOD + mi * 6144;
#pragma unroll
            for (int j = 0; j < 4; ++j) { const int col = 4 * C.lane + 256 * j; shr[j] = *(const f32x4*)(md + col); scr_[j] = *(const f32x4*)(md + DM + col) + 1.f; } }
        f32x4 x[4];
#pragma unroll
        for (int j = 0; j < 4; ++j) x[j] = xn[j];
        if (row + 1 < row1) {
#pragma unroll
            for (int j = 0; j < 4; ++j) xn[j] = *(const f32x4*)(MODH_SRC(row + 1) + 4 * C.lane + 256 * j); }
#pragma unroll
        for (int j = 0; j < 4; ++j) { const int col = 4 * C.lane + 256 * j; const f32x4 h = x[j] * scr_[j] + shr[j]; u32x2 o; o.x = pk2(h[0], h[1]); o.y = pk2(h[2], h[3]); *(u32x2*)(H + (size_t)row * DM + col) = o; }
    }
}

__device__ __forceinline__ f32x4 ld4bf(const bf16_t* p) { const u32x2 u = *(const u32x2*)p; return (f32x4){bflo(u.x), bfhi(u.x), bflo(u.y), bfhi(u.y)}; }
__device__ __forceinline__ void st4bf(bf16_t* p, f32x4 v) { u32x2 o; o.x = pk2(v[0], v[1]); o.y = pk2(v[2], v[3]); *(u32x2*)p = o; }
__device__ __forceinline__ void seq_info(int row, bool& hasp, bool& hasn) {
    if (row < NLAT) { const int t = row & (TT - 1); hasp = t > 0; hasn = t < TT - 1; }
    else { const int t = (row - NLAT) & (CTXL - 1); hasp = t > 0; hasn = t < CTXL - 1; }
}
struct Ef1Row { u32x2 bg, ua, ub, m[11]; };
__device__ __forceinline__ f32x4 bf4(u32x2 u) { return (f32x4){bflo(u.x), bfhi(u.x), bflo(u.y), bfhi(u.y)}; }
__device__ __forceinline__ void ef1_load(Ef1Row& R, const bf16_t* P, int row, int lane) {
    row = row < 0 ? 0 : row > MROWS - 1 ? MROWS - 1 : row;
    const bf16_t* p = P + (size_t)row * P_LD + 4 * lane;
    R.bg = *(const u32x2*)p; R.ua = *(const u32x2*)(p + 256); R.ub = *(const u32x2*)(p + 512);
#pragma unroll
    for (int it = 0; it < 11; ++it) R.m[it] = *(const u32x2*)(p + 768 + it * 256);
}
__device__ __forceinline__ void phase_ef1(const Ctx& C, const Args& A, int l) {
    const int i2 = l >> 1; unsigned char* ws = A.ws;
    const bf16_t* P = (const bf16_t*)(ws + WS_P); bf16_t* A2 = (bf16_t*)(ws + WS_A2); unsigned char* SCN = ws + WS_SCN; bf16_t* LIN = (bf16_t*)(ws + WS_LIN);
    const float* cw = A.in[I_CONVW] + (size_t)i2 * 3 * 256; const float* mu = A.in[I_MU] + (size_t)i2 * RWKV_COLS; const float* kxi = A.in[I_KXI] + (size_t)i2 * 768;
    const int j4 = 4 * C.lane;
    const f32x4 w0 = *(const f32x4*)(cw + j4), w1 = *(const f32x4*)(cw + 256 + j4), w2 = *(const f32x4*)(cw + 512 + j4);
    f32x4 mur[11], kxr[3];
#pragma unroll
    for (int it = 0; it < 11; ++it) mur[it] = (it * 256 + j4 < RWKV_COLS) ? *(const f32x4*)(mu + it * 256 + j4) : (f32x4){0.f, 0.f, 0.f, 0.f};
#pragma unroll
    for (int it = 0; it < 3; ++it) kxr[it] = *(const f32x4*)(kxi + it * 256 + j4);
    const int row0 = (int)(((long)C.gw * MROWS) / C.NGW), row1 = (int)(((long)(C.gw + 1) * MROWS) / C.NGW);
    Ef1Row Ra, Rb, Rc, Rd;
    ef1_load(Ra, P, row0 - 1, C.lane); ef1_load(Rb, P, row0, C.lane); ef1_load(Rc, P, row0 + 1, C.lane);
    for (int row = row0; row < row1; ++row) {
        ef1_load(Rd, P, row + 2, C.lane);
        bool hasp, hasn; seq_info(row, hasp, hasn);
        const float fp = hasp ? 1.f : 0.f, fn = hasn ? 1.f : 0.f;
        {
            const f32x4 bg = bf4(Rb.bg), u0 = bf4(Rb.ua) * bf4(Rb.ub), um = bf4(Ra.ua) * bf4(Ra.ub) * fp, up = bf4(Rc.ua) * bf4(Rc.ub) * fn;
            st4bf(A2 + (size_t)row * DM + j4, bg * (w0 * um + w1 * u0 + w2 * up));
        }
#pragma unroll
        for (int it = 0; it < 11; ++it) {
            const int c = it * 256 + j4;
            if (c < RWKV_COLS) {
                const f32x4 x0 = bf4(Rb.m[it]), xm = bf4(Ra.m[it]) * fp, xp = bf4(Rc.m[it]) * fn, m4 = mur[it];
                const f32x4 ps = x0 + m4 * ((xm + xp) * 0.5f - x0);
                if (it < 3) { const int head = c >> 6, kx = c & 63; st4bf_(SCN + (size_t)(row * 12 + head) * SC_REC + SC_R + kx * 2, ps); }
                else if (it < 6) { const int c1 = c - 768, head = c1 >> 6, kx = c1 & 63; const f32x4 kv = ps * kxr[it < 6 ? (it >= 3 ? it - 3 : 0) : 0];
                    const float ss = sum16(kv[0] * kv[0] + kv[1] * kv[1] + kv[2] * kv[2] + kv[3] * kv[3]); const float rn = rsqrtf(ss + 1e-12f);
                    unsigned char* base = SCN + (size_t)(row * 12 + head) * SC_REC + kx * 2;
                    st4bf_(base + SC_KK, kv * rn); st4bf_(base + SC_KR, ps); st4bf_(base + SC_KR + 256, ps); }
                else if (it < 9) { const int c1 = c - 1536, head = c1 >> 6, kx = c1 & 63; st4bf_(SCN + (size_t)(row * 12 + head) * SC_REC + SC_V + kx * 2, ps); }
                else { const int c1 = c - 2304; f32x4 o;
                    if (c1 < 128) { o = (f32x4){tanh_fast(ps[0]), tanh_fast(ps[1]), tanh_fast(ps[2]), tanh_fast(ps[3])}; }
                    else if (c1 < 256) { o = ps; }
                    else { o = (f32x4){sigmoidf_(ps[0]), sigmoidf_(ps[1]), sigmoidf_(ps[2]), sigmoidf_(ps[3])}; }
                    st4bf(LIN + (size_t)row * LORA_K + c1, o); }
            }
        }
        Ra = Rb; Rb = Rc; Rc = Rd;
    }
}

__device__ __forceinline__ int scan_row(int i, int b, int d) {
    if (d == 0) return i < CTXL ? NLAT + b * CTXL + i : b * TT + (i - CTXL);
    return i < CTXL ? NLAT + b * CTXL + (CTXL - 1 - i) : b * TT + (TT - 1 - (i - CTXL));
}
__device__ __forceinline__ float red8(float v) {
    v += __uint_as_float((unsigned)__builtin_amdgcn_update_dpp(0, (int)__float_as_uint(v), 0xB1, 0xF, 0xF, true));
    v += __uint_as_float((unsigned)__builtin_amdgcn_update_dpp(0, (int)__float_as_uint(v), 0x4E, 0xF, 0xF, true));
    v += __uint_as_float((unsigned)__builtin_amdgcn_update_dpp(0, (int)__float_as_uint(v), 0x141, 0xF, 0xF, true));
    return v;
}
__device__ __forceinline__ float red16(float v) {
    v += __uint_as_float((unsigned)__builtin_amdgcn_update_dpp(0, (int)__float_as_uint(v), 0xB1, 0xF, 0xF, true));
    v += __uint_as_float((unsigned)__builtin_amdgcn_update_dpp(0, (int)__float_as_uint(v), 0x4E, 0xF, 0xF, true));
    v += __uint_as_float((unsigned)__builtin_amdgcn_update_dpp(0, (int)__float_as_uint(v), 0x141, 0xF, 0xF, true));
    v += __uint_as_float((unsigned)__builtin_amdgcn_update_dpp(0, (int)__float_as_uint(v), 0x140, 0xF, 0xF, true));
    return v;
}
__device__ __forceinline__ void phase_scan(const Ctx& C, const Args& A) {
    for (int u = blockIdx.x; u < 192; u += C.G) {
    const int half = u & 1, d = (u >> 1) & 1, h = (u >> 2) % 12, b = u / 48;
    const unsigned char* SCN = A.ws + WS_SCN; float* Y = (float*)(A.ws + WS_Y) + (size_t)d * MROWS * 768;
    LAS float* buf = (LAS float*)C.lds; LAS float* ybuf = buf + 2 * 32 * 352;
    constexpr int NCH = LKEYS / 32;
    u32x4 st[4];
    int ps_[4], psrc[4], pdst[4]; bool pf32[4];
#pragma unroll
    for (int j = 0; j < 4; ++j) { const int p = C.tid + NTHR * j; const int s = p / 52, q = p % 52; ps_[j] = s;
        if (q < 16) { psrc[j] = SC_W + 256 * d + q * 16; pdst[j] = s * 352 + q * 4; pf32[j] = true; }
        else if (q < 48) { const int vec = (q - 16) >> 3, part = (q - 16) & 7; const int so = vec == 0 ? SC_KK : vec == 1 ? SC_B + 256 * d : vec == 2 ? SC_KR + 256 * d : SC_R;
            psrc[j] = so + part * 16; pdst[j] = s * 352 + 64 * (vec + 1) + part * 8; pf32[j] = false; }
        else { const int part = q - 48; psrc[j] = SC_V + half * 64 + part * 16; pdst[j] = s * 352 + 320 + part * 8; pf32[j] = false; } }
    const int sgn = d ? -1 : 1;
    const unsigned char* SCNh = SCN + (size_t)h * SC_REC;
#define SCAN_ROW0(c) (((c) * 32 < CTXL) ? (NLAT + b * CTXL + (d ? CTXL - 1 - (c) * 32 : (c) * 32)) : (b * TT + (d ? TT - 1 - ((c) * 32 - CTXL) : (c) * 32 - CTXL)))
#define SCAN_LOADG(c) do { const int row0_ = SCAN_ROW0(c); _Pragma("unroll") for (int j = 0; j < 4; ++j) if (j < 3 || C.tid < 1664 - 3 * NTHR) { \
        st[j] = *(const u32x4*)(SCNh + (size_t)(row0_ + sgn * ps_[j]) * SC_ROW + psrc[j]); } } while (0)
#define SCAN_STORE(bi) do { _Pragma("unroll") for (int j = 0; j < 4; ++j) if (j < 3 || C.tid < 1664 - 3 * NTHR) { LAS float* dp = buf + (bi) * (32 * 352) + pdst[j]; \
        if (pf32[j]) *(LAS u32x4*)dp = st[j]; \
        else { *(LAS f32x4*)dp = (f32x4){bflo(st[j].x), bfhi(st[j].x), bflo(st[j].y), bfhi(st[j].y)}; *(LAS f32x4*)(dp + 4) = (f32x4){bflo(st[j].z), bfhi(st[j].z), bflo(st[j].w), bfhi(st[j].w)}; } } } while (0)
    SCAN_LOADG(0); SCAN_STORE(0); __syncthreads();
    f32x2 Sa = {0.f, 0.f}, Sb = {0.f, 0.f};
    const int rl = C.lane >> 4, ks = C.lane & 15;
    float ycol = 0.f;
#define SC_LD(R, s) do { const LAS float* bp_ = cur + (s) * 352 + ks * 4; \
        R##w = *(const LAS f32x4*)(bp_); R##k = *(const LAS f32x4*)(bp_ + 64); R##b = *(const LAS f32x4*)(bp_ + 128); R##q = *(const LAS f32x4*)(bp_ + 192); R##r = *(const LAS f32x4*)(bp_ + 256); \
        R##vv = cur[(s) * 352 + 320 + C.wave * 4 + rl]; } while (0)
#define SC_LO(v) ((f32x2){v[0], v[1]})
#define SC_HI(v) ((f32x2){v[2], v[3]})
#define SC_DPP(x, ctrl) __uint_as_float((unsigned)__builtin_amdgcn_update_dpp(0, (int)__float_as_uint(x), ctrl, 0xF, 0xF, true))
#define SC_STEP(R, P, s) do { \
        f32x2 pa = __builtin_elementwise_fma(Sb, SC_HI(R##k), Sa * SC_LO(R##k)), py = __builtin_elementwise_fma(Sb, SC_HI(P##r), Sa * SC_LO(P##r)); \
        float a_ = pa.x + pa.y, y_ = py.x + py.y; \
        a_ += SC_DPP(a_, 0xB1); y_ += SC_DPP(y_, 0xB1); a_ += SC_DPP(a_, 0x4E); y_ += SC_DPP(y_, 0x4E); \
        a_ += SC_DPP(a_, 0x141); y_ += SC_DPP(y_, 0x141); a_ += SC_DPP(a_, 0x140); y_ += SC_DPP(y_, 0x140); \
        ycol = (ks == ((s) & 15)) ? y_ : ycol; \
        const f32x2 na = {-a_, -a_}, vv2 = {R##vv, R##vv}; \
        Sa = __builtin_elementwise_fma(Sa, SC_LO(R##w), __builtin_elementwise_fma(na, SC_LO(R##b), vv2 * SC_LO(R##q))); \
        Sb = __builtin_elementwise_fma(Sb, SC_HI(R##w), __builtin_elementwise_fma(na, SC_HI(R##b), vv2 * SC_HI(R##q))); } while (0)
    f32x4 Aw, Ak, Ab, Aq, Ar, Bw, Bk, Bb, Bq, Br, Cw, Ck, Cb, Cq, Cr, Dw, Dk, Db, Dq, Dr; float Avv, Bvv, Cvv, Dvv;
    Dr = (f32x4){0.f, 0.f, 0.f, 0.f};
    for (int c = 0; c < NCH; ++c) {
        if (c + 1 < NCH) SCAN_LOADG(c + 1);
        {
            const LAS float* cur = buf + (c & 1) * (32 * 352);
            LAS float* yb = ybuf + (c & 1) * 1024 + C.wave * 4 + rl + ks * 32;
            SC_LD(A, 0); SC_LD(B, 1);
#pragma unroll 1
            for (int s = 0; s < 32; s += 4) {
                SC_LD(C, s + 2); __builtin_amdgcn_sched_barrier(0); SC_STEP(A, D, s); __builtin_amdgcn_sched_barrier(0);
                SC_LD(D, s + 3); __builtin_amdgcn_sched_barrier(0); SC_STEP(B, A, s + 1); __builtin_amdgcn_sched_barrier(0);
                SC_LD(A, s + 4); __builtin_amdgcn_sched_barrier(0); SC_STEP(C, B, s + 2); __builtin_amdgcn_sched_barrier(0);
                SC_LD(B, s + 5); __builtin_amdgcn_sched_barrier(0); SC_STEP(D, C, s + 3); __builtin_amdgcn_sched_barrier(0);
                if ((s & 15) == 12) yb[(s & 16) * 32] = ycol;
            }
        }
        if (c + 1 < NCH) SCAN_STORE((c + 1) & 1);
        __syncthreads();
        { const int row0_ = SCAN_ROW0(c);
#pragma unroll
          for (int i = 0; i < 2; ++i) { const int e = C.tid + NTHR * i, s = e >> 5, r = e & 31;
            const int row = (s > 0) ? row0_ + sgn * (s - 1) : scan_row(c * 32 - 1, b, d);
            if (s > 0 || c > 0) Y[(size_t)row * 768 + h * 64 + half * 32 + r] = ybuf[(c & 1) * 1024 + e]; } }
    }
    {
        f32x2 py = __builtin_elementwise_fma(Sb, SC_HI(Dr), Sa * SC_LO(Dr)); float y_ = py.x + py.y;
        y_ += SC_DPP(y_, 0xB1); y_ += SC_DPP(y_, 0x4E); y_ += SC_DPP(y_, 0x141); y_ += SC_DPP(y_, 0x140);
        if (ks == 0) Y[(size_t)scan_row(LKEYS - 1, b, d) * 768 + h * 64 + half * 32 + C.wave * 4 + rl] = y_;
    }
    __syncthreads();
    }
#undef SCAN_LOADG
#undef SCAN_STORE
#undef SCAN_ROW0
#undef SC_LD
#undef SC_STEP
#undef SC_LO
#undef SC_HI
#undef SC_DPP
}

constexpr int CSP = 72;
constexpr int CS_MAT = 64 * CSP * 2;
constexpr int CS_WT = 0, CS_KB = CS_MAT, CS_BB = 2 * CS_MAT, CS_RT = 3 * CS_MAT, CS_BHT = 4 * CS_MAT, CS_KHT = 5 * CS_MAT, CS_VMT = 6 * CS_MAT;
constexpr int CS_M2F = 7 * CS_MAT;
constexpr int CS_M1T = CS_M2F + 16384;
constexpr int CS_N2 = CS_M1T + CS_MAT;
constexpr int CS_GT = CS_N2 + CS_MAT;
constexpr int CS_Z = CS_M2F, CS_U = CS_M2F + CS_MAT;
constexpr int CS_GL = CS_GT + 2 * CS_MAT;
static_assert(CS_GL + 256 <= LDS_MISC, "chunked-scan LDS map");
template <bool SWZB = false>
__device__ __forceinline__ void cs_mma(f32x16& acc, const LAS unsigned char* Am, const LAS unsigned char* Bm, int ti, int tj, int r32, int hi) {
    const LAS unsigned char* ap = Am + (ti * 32 + r32) * (CSP * 2) + hi * 16; const int brow = tj * 32 + r32; const LAS unsigned char* bp = Bm + brow * (CSP * 2);
    const int sw = SWZB ? ((brow >> 3) & 7) : 0;
#pragma unroll
    for (int ks = 0; ks < 4; ++ks) acc = __builtin_amdgcn_mfma_f32_32x32x16_bf16(*(const LAS bf16x8*)(ap + ks * 32), *(const LAS bf16x8*)(bp + (((ks * 2 + hi) ^ sw) * 16)), acc, 0, 0, 0);
}
__device__ __forceinline__ void cs_store_t(LAS unsigned char* Om, const f32x16& acc, int ti, int tj, int r32, int hi) {
    LAS unsigned char* op = Om + (tj * 32 + r32) * (CSP * 2) + (ti * 32 + 4 * hi) * 2;
#pragma unroll
    for (int g = 0; g < 4; ++g) { u32x2 o; o.x = pk2(acc[4 * g], acc[4 * g + 1]); o.y = pk2(acc[4 * g + 2], acc[4 * g + 3]); *(LAS u32x2*)(op + g * 16) = o; }
}
#define CS_BAR() asm volatile("s_waitcnt lgkmcnt(0)\n\ts_barrier" ::: "memory")
__device__ __forceinline__ void phase_csa(const Ctx& C, const Args& A) {
    const unsigned char* SCN = A.ws + WS_SCN; unsigned char* CHK = A.ws + WS_CHK;
    LAS unsigned char* L = C.lds;
    const int r32 = C.lane & 31, hi = C.lane >> 5;
    float lwv[8]; u32x4 ukk, ub, ukr, ur, uv;
#define CSA_GEOM(cu_) const int unit = (cu_) / CS_NCH, ch = (cu_) % CS_NCH; const int d = unit & 1, h = (unit >> 1) % 12, b = unit / 24; \
        const int step0 = ch * CS_L; const int sgn = d ? -1 : 1; \
        const int row0 = (step0 < CTXL) ? (NLAT + b * CTXL + (d ? CTXL - 1 - step0 : step0)) : (b * TT + (d ? TT - 1 - (step0 - CTXL) : step0 - CTXL)); \
        const unsigned char* rec0 = SCN + (size_t)row0 * SC_ROW + (size_t)h * SC_REC;
#define CSA_LOAD(cu_) do { CSA_GEOM(cu_); \
        { const int k = C.tid & 63, sg = C.tid >> 6; _Pragma("unroll") for (int j = 0; j < 8; ++j) lwv[j] = *(const float*)(rec0 + (long)sgn * (8 * sg + j) * SC_ROW + SC_W + 256 * d + k * 4); } \
        { const int t = C.tid >> 3, k0 = (C.tid & 7) * 8; const unsigned char* rp = rec0 + (long)sgn * t * SC_ROW; \
          ukk = *(const u32x4*)(rp + SC_KK + k0 * 2); ub = *(const u32x4*)(rp + SC_B + 256 * d + k0 * 2); ukr = *(const u32x4*)(rp + SC_KR + 256 * d + k0 * 2); ur = *(const u32x4*)(rp + SC_R + k0 * 2); uv = *(const u32x4*)(rp + SC_V + k0 * 2); } } while (0)
    if ((int)blockIdx.x < CS_UNITS * CS_NCH) CSA_LOAD((int)blockIdx.x);
    for (int cu = blockIdx.x; cu < CS_UNITS * CS_NCH; cu += C.G) {
        LAS float* csf = (LAS float*)(L + CS_M2F);
        LAS float* seg = (LAS float*)(L + CS_N2);
        { const int k = C.tid & 63, sg = C.tid >> 6;
#pragma unroll
          for (int j = 1; j < 8; ++j) lwv[j] += lwv[j - 1];
          seg[sg * 64 + k] = lwv[7];
          CS_BAR();
          float off = 0.f, tot = 0.f;
#pragma unroll
          for (int s2 = 0; s2 < 8; ++s2) { const float v = seg[s2 * 64 + k]; off += (s2 < sg) ? v : 0.f; tot += v; }
#pragma unroll
          for (int j = 0; j < 8; ++j) csf[(8 * sg + j) * 65 + k] = lwv[j] + off;
          if (sg == 7) ((LAS float*)(L + CS_GL))[k] = __expf(tot); }
        CS_BAR();
        { const int t = C.tid >> 3, k0 = (C.tid & 7) * 8;
          float wt[8], kb[8], bb[8], rt[8], bh[8], kh[8];
#pragma unroll
          for (int j = 0; j < 8; ++j) { const unsigned pkk = j < 2 ? ukk.x : j < 4 ? ukk.y : j < 6 ? ukk.z : ukk.w, pb = j < 2 ? ub.x : j < 4 ? ub.y : j < 6 ? ub.z : ub.w, pkr = j < 2 ? ukr.x : j < 4 ? ukr.y : j < 6 ? ukr.z : ukr.w, pr = j < 2 ? ur.x : j < 4 ? ur.y : j < 6 ? ur.z : ur.w;
              const float kkv = (j & 1) ? bfhi(pkk) : bflo(pkk), bv = (j & 1) ? bfhi(pb) : bflo(pb), krv = (j & 1) ? bfhi(pkr) : bflo(pkr), rv = (j & 1) ? bfhi(pr) : bflo(pr);
              const float cst = csf[t * 65 + k0 + j], csp = t > 0 ? csf[(t - 1) * 65 + k0 + j] : 0.f, csl = csf[63 * 65 + k0 + j];
              const float einv = __expf(-cst), el = __expf(csl - cst);
              wt[j] = kkv * __expf(csp); kb[j] = krv * einv; bb[j] = bv * einv; rt[j] = rv * __expf(cst); bh[j] = bv * el; kh[j] = krv * el; }
          u32x4 o;
          o.x = pk2(wt[0], wt[1]); o.y = pk2(wt[2], wt[3]); o.z = pk2(wt[4], wt[5]); o.w = pk2(wt[6], wt[7]); *(LAS u32x4*)(L + CS_WT + t * (CSP * 2) + k0 * 2) = o;
          o.x = pk2(kb[0], kb[1]); o.y = pk2(kb[2], kb[3]); o.z = pk2(kb[4], kb[5]); o.w = pk2(kb[6], kb[7]); *(LAS u32x4*)(L + CS_KB + t * (CSP * 2) + k0 * 2) = o;
          o.x = pk2(bb[0], bb[1]); o.y = pk2(bb[2], bb[3]); o.z = pk2(bb[4], bb[5]); o.w = pk2(bb[6], bb[7]); *(LAS u32x4*)(L + CS_BB + t * (CSP * 2) + k0 * 2) = o;
          o.x = pk2(rt[0], rt[1]); o.y = pk2(rt[2], rt[3]); o.z = pk2(rt[4], rt[5]); o.w = pk2(rt[6], rt[7]); *(LAS u32x4*)(L + CS_RT + t * (CSP * 2) + k0 * 2) = o;
#pragma unroll
          for (int j = 0; j < 8; ++j) { const int to = ((((t >> 3) ^ ((k0 >> 3) & 7)) * 8) + (t & 7)) * 2;
              *(LAS bf16_t*)(L + CS_BHT + (k0 + j) * (CSP * 2) + to) = (bf16_t)f2bf(bh[j]); *(LAS bf16_t*)(L + CS_KHT + (k0 + j) * (CSP * 2) + to) = (bf16_t)f2bf(kh[j]);
              const unsigned pv = j < 2 ? uv.x : j < 4 ? uv.y : j < 6 ? uv.z : uv.w; *(LAS bf16_t*)(L + CS_VMT + (k0 + j) * (CSP * 2) + to) = (bf16_t)((j & 1) ? (pv >> 16) : (pv & 0xffffu)); } }
        if (cu + C.G < CS_UNITS * CS_NCH) CSA_LOAD(cu + C.G);
        CS_BAR();
        for (int job = C.wave; job < 12; job += NWAVES) { const int p = job >> 2, ti = (job >> 1) & 1, tj = job & 1;
            f32x16 acc;
#pragma unroll
            for (int i = 0; i < 16; ++i) acc[i] = 0.f;
            if (p == 0) { cs_mma(acc, L + CS_WT, L + CS_BB, ti, tj, r32, hi);
                const int i = tj * 32 + r32; LAS float* mp = (LAS float*)(L + CS_M2F) + i * 64;
#pragma unroll
                for (int reg = 0; reg < 16; ++reg) { const int t = ti * 32 + crow(reg, hi); mp[(t & 3) * 16 + (t >> 2)] = (i < t) ? acc[reg] : 0.f; } }
            else if (p == 1) { cs_mma(acc, L + CS_WT, L + CS_KB, ti, tj, r32, hi);
                const int i = tj * 32 + r32;
#pragma unroll
                for (int reg = 0; reg < 16; ++reg) { const int t = ti * 32 + crow(reg, hi); acc[reg] = (i < t) ? acc[reg] : 0.f; }
                cs_store_t(L + CS_M1T, acc, ti, tj, r32, hi); }
            else { cs_mma(acc, L + CS_BB, L + CS_RT, ti, tj, r32, hi);
                const int t = tj * 32 + r32;
#pragma unroll
                for (int reg = 0; reg < 16; ++reg) { const int i = ti * 32 + crow(reg, hi); acc[reg] = (i <= t) ? acc[reg] : 0.f; }
                cs_store_t(L + CS_N2, acc, ti, tj, r32, hi); } }
        CS_BAR();
        { const int c = C.tid >> 2, q = C.tid & 3; f32x2 acc2[8];
          { const LAS unsigned char* rcol = (c < 64) ? (L + CS_WT + c * 2) : (L + CS_M1T + (c - 64) * (CSP * 2)); const int rstride = (c < 64) ? CSP * 2 : 2;
#pragma unroll
            for (int j = 0; j < 16; ++j) acc2[j >> 1][j & 1] = bf2f(*(const LAS bf16_t*)(rcol + (4 * j + q) * rstride)); }
          const LAS float* m2c = (const LAS float*)(L + CS_M2F) + q * 16;
#pragma clang loop unroll(full)
          for (int i = 0; i < 64; ++i) {
              const float mine = -acc2[i >> 3][(i >> 2) & 1];
              float gi;
              switch (i & 3) { case 0: gi = __uint_as_float((unsigned)__builtin_amdgcn_update_dpp(0, (int)__float_as_uint(mine), 0x00, 0xF, 0xF, true)); break;
                               case 1: gi = __uint_as_float((unsigned)__builtin_amdgcn_update_dpp(0, (int)__float_as_uint(mine), 0x55, 0xF, 0xF, true)); break;
                               case 2: gi = __uint_as_float((unsigned)__builtin_amdgcn_update_dpp(0, (int)__float_as_uint(mine), 0xAA, 0xF, 0xF, true)); break;
                               default: gi = __uint_as_float((unsigned)__builtin_amdgcn_update_dpp(0, (int)__float_as_uint(mine), 0xFF, 0xF, 0xF, true)); break; }
              const f32x2 g2 = {gi, gi};
#pragma unroll
              for (int j4 = (i >> 4); j4 < 4; ++j4) { const f32x4 m = *(const LAS f32x4*)(m2c + i * 64 + j4 * 4);
#pragma unroll
                  for (int h = 0; h < 2; ++h) { const int p = 2 * j4 + h;
                      if (2 * p >= (i >> 2)) acc2[p] += (f32x2){m[2 * h], m[2 * h + 1]} * g2;
                      else if (2 * p + 1 >= (i >> 2)) acc2[p][1] += m[2 * h + 1] * gi; } }
          }
#pragma unroll
          for (int j = 0; j < 16; ++j) *(LAS bf16_t*)(L + CS_GT + c * (CSP * 2) + (4 * j + q) * 2) = (bf16_t)f2bf(-acc2[j >> 1][j & 1]); }
        CS_BAR();
        unsigned char* outp = CHK + (size_t)cu * 32768;
        for (int job = C.wave; job < 16; job += NWAVES) { const int p = job >> 2, ti = (job >> 1) & 1, tj = job & 1;
            f32x16 acc;
            if (p == 0) {
                const LAS unsigned char* rp = L + CS_RT + (tj * 32 + r32) * (CSP * 2) + (ti * 32 + 4 * hi) * 2;
#pragma unroll
                for (int g = 0; g < 4; ++g) { const u32x2 u = *(const LAS u32x2*)(rp + g * 16); acc[4 * g] = bflo(u.x); acc[4 * g + 1] = bfhi(u.x); acc[4 * g + 2] = bflo(u.y); acc[4 * g + 3] = bfhi(u.y); }
                cs_mma(acc, L + CS_GT, L + CS_N2, ti, tj, r32, hi);
#pragma unroll
                for (int g = 0; g < 4; ++g) { u32x2 o; o.x = pk2(acc[4 * g], acc[4 * g + 1]); o.y = pk2(acc[4 * g + 2], acc[4 * g + 3]);
                    *(u32x2*)(outp + 8192 + (((tj * 4 + 2 * ti + (g >> 1)) * 64 + (g & 1) * 32 + r32) * 16) + hi * 8) = o; } }
            else if (p == 1) {
#pragma unroll
                for (int i = 0; i < 16; ++i) acc[i] = 0.f;
                cs_mma(acc, L + CS_KB, L + CS_RT, ti, tj, r32, hi);
                const int t = tj * 32 + r32;
#pragma unroll
                for (int reg = 0; reg < 16; ++reg) { const int i = ti * 32 + crow(reg, hi); acc[reg] = (i <= t) ? acc[reg] : 0.f; }
                cs_mma(acc, L + CS_GT + 64 * (CSP * 2), L + CS_N2, ti, tj, r32, hi);
                cs_store_t(L + CS_Z, acc, ti, tj, r32, hi); }
            else if (p == 2) {
#pragma unroll
                for (int i = 0; i < 16; ++i) acc[i] = 0.f;
                cs_mma<true>(acc, L + CS_GT, L + CS_BHT, ti, tj, r32, hi);
                const int k = tj * 32 + r32; const float gl = ((const LAS float*)(L + CS_GL))[k];
#pragma unroll
                for (int reg = 0; reg < 16; ++reg) { const int cc = ti * 32 + crow(reg, hi); acc[reg] += (cc == k) ? gl : 0.f; }
#pragma unroll
                for (int g = 0; g < 4; ++g) { u32x2 o; o.x = pk2(acc[4 * g], acc[4 * g + 1]); o.y = pk2(acc[4 * g + 2], acc[4 * g + 3]);
                    *(u32x2*)(outp + (((tj * 4 + 2 * ti + (g >> 1)) * 64 + (g & 1) * 32 + r32) * 16) + hi * 8) = o; } }
            else {
                const int krow = tj * 32 + r32; const LAS unsigned char* kp = L + CS_KHT + krow * (CSP * 2) + hi * 8;
#pragma unroll
                for (int g = 0; g < 4; ++g) { const u32x2 u = *(const LAS u32x2*)(kp + (((ti * 4 + g) ^ ((krow >> 3) & 7)) * 16)); acc[4 * g] = bflo(u.x); acc[4 * g + 1] = bfhi(u.x); acc[4 * g + 2] = bflo(u.y); acc[4 * g + 3] = bfhi(u.y); }
                cs_mma<true>(acc, L + CS_GT + 64 * (CSP * 2), L + CS_BHT, ti, tj, r32, hi);
                cs_store_t(L + CS_U, acc, ti, tj, r32, hi); } }
        CS_BAR();
        { const int p = C.wave >> 2, ti = (C.wave >> 1) & 1, tj = C.wave & 1;
          f32x16 acc;
#pragma unroll
          for (int i = 0; i < 16; ++i) acc[i] = 0.f;
          cs_mma<true>(acc, L + (p ? CS_U : CS_Z), L + CS_VMT, ti, tj, r32, hi);
          unsigned char* op = outp + (p ? 16384 : 24576) + ((ti * 2 + tj) * 64 + C.lane) * 32;
          u32x4 o0, o1; o0.x = pk2(acc[0], acc[1]); o0.y = pk2(acc[2], acc[3]); o0.z = pk2(acc[4], acc[5]); o0.w = pk2(acc[6], acc[7]);
          o1.x = pk2(acc[8], acc[9]); o1.y = pk2(acc[10], acc[11]); o1.z = pk2(acc[12], acc[13]); o1.w = pk2(acc[14], acc[15]);
          *(u32x4*)op = o0; *(u32x4*)(op + 16) = o1; }
        CS_BAR();
    }
}
__device__ __forceinline__ void phase_csb(const Ctx& C, const Args& A, int l) {
    if ((int)blockIdx.x >= CS_UNITS) { const int gwf = ((int)blockIdx.x - CS_UNITS) * NWAVES + C.wave, ngwf = (C.G - CS_UNITS) * NWAVES;
        conv_items(C, A, l + 1, gwf, ngwf, true, false, false); conv_items(C, A, l + 1, gwf, ngwf, false, false, true, XW_TK_HI); return; }
    const unsigned char* CHK = A.ws + WS_CHK;
    LAS unsigned char* L = C.lds;
    const int r32 = C.lane & 31, hi = C.lane >> 5;
    const bool isS = C.wave < 4; const int ti = (C.wave >> 1) & 1, tj = C.wave & 1;
    for (int unit = blockIdx.x; unit < CS_UNITS; unit += C.G) {
        const int d = unit & 1, h = (unit >> 1) % 12, b = unit / 24;
        float* Y = (float*)(A.ws + WS_Y) + (size_t)d * MROWS * 768;
        for (int i = C.tid; i < 2 * CS_MAT / 4; i += NTHR) ((LAS unsigned*)L)[i] = 0u;
        CS_BAR();
        bf16x8 afA[4], afB[4], afC[4]; u32x4 cA0, cA1, cB0, cB1, cC0, cC1;
#define CSB_LOAD(A4, C0, C1, ch_) do { const unsigned char* op_ = CHK + ((size_t)unit * CS_NCH + (ch_)) * 32768; \
            const unsigned char* am_ = op_ + (isS ? 0 : 8192) + (ti * 4 * 64 + C.lane) * 16;     \
            _Pragma("unroll") for (int ks = 0; ks < 4; ++ks) A4[ks] = *(const bf16x8*)(am_ + ks * 1024); \
            const unsigned char* cp_ = op_ + (isS ? 16384 : 24576) + ((ti * 2 + tj) * 64 + C.lane) * 32; C0 = *(const u32x4*)cp_; C1 = *(const u32x4*)(cp_ + 16); } while (0)
#define CSB_STEP(A4, C0, C1, ch_) do { \
            const LAS unsigned char* Sb = L + ((ch_) & 1) * CS_MAT; LAS unsigned char* Sn = L + (((ch_) + 1) & 1) * CS_MAT; \
            f32x16 acc; \
            acc[0] = bflo(C0.x); acc[1] = bfhi(C0.x); acc[2] = bflo(C0.y); acc[3] = bfhi(C0.y); acc[4] = bflo(C0.z); acc[5] = bfhi(C0.z); acc[6] = bflo(C0.w); acc[7] = bfhi(C0.w); \
            acc[8] = bflo(C1.x); acc[9] = bfhi(C1.x); acc[10] = bflo(C1.y); acc[11] = bfhi(C1.y); acc[12] = bflo(C1.z); acc[13] = bfhi(C1.z); acc[14] = bflo(C1.w); acc[15] = bfhi(C1.w); \
            const LAS unsigned char* bp = Sb + (tj * 32 + r32) * (CSP * 2) + hi * 16; \
            _Pragma("unroll") for (int ks = 0; ks < 4; ++ks) acc = __builtin_amdgcn_mfma_f32_32x32x16_bf16(A4[ks], *(const LAS bf16x8*)(bp + ks * 32), acc, 0, 0, 0); \
            if (isS) { cs_store_t(Sn, acc, ti, tj, r32, hi); }     \
            else {     \
                const int step0 = (ch_) * CS_L; const int sgn = d ? -1 : 1; \
                const int row0 = (step0 < CTXL) ? (NLAT + b * CTXL + (d ? CTXL - 1 - step0 : step0)) : (b * TT + (d ? TT - 1 - (step0 - CTXL) : step0 - CTXL)); \
                float* yp = Y + (size_t)(row0 + sgn * (ti * 32 + 4 * hi)) * 768 + h * 64 + tj * 32 + r32; const long ys = (long)sgn * 768; \
                _Pragma("unroll") for (int reg = 0; reg < 16; ++reg) yp[ys * ((reg & 3) + 8 * (reg >> 2))] = acc[reg]; } \
            CS_BAR(); } while (0)
        CSB_LOAD(afA, cA0, cA1, 0); CSB_LOAD(afB, cB0, cB1, 1);
        static_assert(CS_NCH % 3 == 0, "chunk loop is unrolled by three");
        for (int ch = 0; ch < CS_NCH; ch += 3) {
            if (ch == 0) CSB_LOAD(afC, cC0, cC1, 2);
            CSB_STEP(afA, cA0, cA1, ch);     if (ch + 3 < CS_NCH) CSB_LOAD(afA, cA0, cA1, ch + 3);
            CSB_STEP(afB, cB0, cB1, ch + 1); if (ch + 4 < CS_NCH) CSB_LOAD(afB, cB0, cB1, ch + 4);
            CSB_STEP(afC, cC0, cC1, ch + 2); if (ch + 5 < CS_NCH) CSB_LOAD(afC, cC0, cC1, ch + 5);
        }
        CS_BAR();
    }
#undef CSB_LOAD
#undef CSB_STEP
}

#undef CS_BAR
struct Ef2Row { f32x4 y0[3], y1[3]; u32x2 r[3], v[3], k0[3], k1[3], g[3]; };
__device__ __forceinline__ void ef2_load(Ef2Row& R, const float* Y0, const float* Y1, const unsigned char* SCN, const bf16_t* G, int row, int lane) {
#pragma unroll
    for (int it = 0; it < 3; ++it) { const int c = it * 256 + 4 * lane, head = c >> 6, kx = c & 63;
        R.y0[it] = *(const f32x4*)(Y0 + (size_t)row * 768 + c); R.y1[it] = *(const f32x4*)(Y1 + (size_t)row * 768 + c);
        const unsigned char* base = SCN + (size_t)(row * 12 + head) * SC_REC + kx * 2;
        R.r[it] = *(const u32x2*)(base + SC_R); R.v[it] = *(const u32x2*)(base + SC_V); R.k0[it] = *(const u32x2*)(base + SC_KR); R.k1[it] = *(const u32x2*)(base + SC_KR + 256);
        R.g[it] = *(const u32x2*)(G + (size_t)row * 768 + c); }
}
__device__ __forceinline__ void phase_ef2(const Ctx& C, const Args& A, int l) {
    const int i2 = l >> 1; unsigned char* ws = A.ws;
    const unsigned char* SCN = ws + WS_SCN; const float* Y0 = (const float*)(ws + WS_Y); const float* Y1 = Y0 + (size_t)MROWS * 768;
    const bf16_t* G = (const bf16_t*)(ws + WS_G); bf16_t* A2 = (bf16_t*)(ws + WS_A2);
    const float* rb = A.in[I_RBON] + (size_t)i2 * 768; const float* gg = A.in[I_GNG] + (size_t)i2 * 768; const float* gb = A.in[I_GNB] + (size_t)i2 * 768;
    f32x4 rbr[3], ggr[3], gbr[3];
#pragma unroll
    for (int it = 0; it < 3; ++it) { const int c = it * 256 + 4 * C.lane; rbr[it] = *(const f32x4*)(rb + c); ggr[it] = *(const f32x4*)(gg + c); gbr[it] = *(const f32x4*)(gb + c); }
    Ef2Row Rn;
    if (C.gw < MROWS) ef2_load(Rn, Y0, Y1, SCN, G, C.gw, C.lane);
    for (int row = C.gw; row < MROWS; row += C.NGW) {
        const Ef2Row R = Rn;
        { const int nr = row + C.NGW < MROWS ? row + C.NGW : row; ef2_load(Rn, Y0, Y1, SCN, G, nr, C.lane); }
#pragma unroll
        for (int it = 0; it < 3; ++it) {
            const int c = it * 256 + 4 * C.lane;
            const f32x4 y = R.y0[it] + R.y1[it];
            const float mean = sum16((y[0] + y[1]) + (y[2] + y[3])) * (1.f / 64.f);
            const f32x4 dd = y - mean;
            const float var = sum16((dd[0] * dd[0] + dd[1] * dd[1]) + (dd[2] * dd[2] + dd[3] * dd[3])) * (1.f / 64.f);
            const float rstd = rsqrtf(var + GN_EPS);
            const f32x4 r = bf4(R.r[it]), v = bf4(R.v[it]), k0 = bf4(R.k0[it]), k1 = bf4(R.k1[it]);
            const f32x4 t = r * (k0 + k1) * 0.5f * rbr[it];
            const float bs = sum16((t[0] + t[1]) + (t[2] + t[3]));
            const f32x4 yn = dd * rstd * ggr[it] + gbr[it];
            const f32x4 g = bf4(R.g[it]);
            st4bf(A2 + (size_t)row * DM + 256 + c, g * (yn + v * bs));
        }
    }
}

__device__ __forceinline__ void phase_of1(const Ctx& C, const Args& A, int l) {
    const int i2 = l >> 1; unsigned char* ws = A.ws;
    const bf16_t* P = (const bf16_t*)(ws + WS_P); bf16_t* A2 = (bf16_t*)(ws + WS_A2); bf16_t* VT = (bf16_t*)(ws + WS_VT);
    const float* lng = A.in[I_GLNG] + (size_t)i2 * 256; const float* lnb = A.in[I_GLNB] + (size_t)i2 * 256;
    const float* gws = A.in[I_GWS] + (size_t)i2 * 4 * 128 * 128; const float* gbs = A.in[I_GBS] + (size_t)i2 * 4 * 128;
    LAS bf16_t* vt = (LAS bf16_t*)C.lds;
    LAS bf16_t* uL = (LAS bf16_t*)C.lds;
    LAS bf16_t* vT = (LAS bf16_t*)(C.lds + 128 * 528);
    const int r32 = C.lane & 31, hi = C.lane >> 5;
    for (int it = blockIdx.x; it < 256 + 8 * 7; it += C.G) {
        const bool isctx = it >= 256; const int uc = isctx ? (it - 256) / 7 : 0, pc = isctx ? (it - 256) % 7 : 0; const int u = it;
        const int b = isctx ? (uc >> 1) : (u >> 6), pos0 = isctx ? (uc & 1) * 128 : (u & 63) * 128;
        const int row0 = isctx ? NLAT + b * CTXL + pos0 : b * TT + pos0, L0 = isctx ? pos0 : CTXL + pos0;
        const int hh0 = isctx ? pc : 0, hh1 = isctx ? (pc < 6 ? pc + 1 : 0) : 6; const bool doC = !isctx || pc == 6;
        u32x4 pv[4];
        if (hh0 < hh1) {
#pragma unroll
            for (int i = 0; i < 4; ++i) { const int piece = C.tid + NTHR * i, r = piece >> 4, part = piece & 15; pv[i] = *(const u32x4*)(P + (size_t)(row0 + r) * P_LD + 1536 + hh0 * 128 + part * 8); } }
        for (int hh = hh0; hh < hh1; ++hh) {
#pragma unroll
            for (int i = 0; i < 4; ++i) { const int piece = C.tid + NTHR * i, r = piece >> 4, part = piece & 15;
                *(LAS u32x4*)(vt + r * 136 + part * 8) = pv[i]; }
            __syncthreads();
            if (hh + 1 < hh1) {
#pragma unroll
                for (int i = 0; i < 4; ++i) { const int piece = C.tid + NTHR * i, r = piece >> 4, part = piece & 15; pv[i] = *(const u32x4*)(P + (size_t)(row0 + r) * P_LD + 1536 + (hh + 1) * 128 + part * 8); } }
#pragma unroll
            for (int i = 0; i < 4; ++i) { const int item = C.tid + NTHR * i, d = item >> 4, tg = item & 15; const LAS bf16_t* s = vt + (tg * 8) * 136 + d;
                u32x4 o; o.x = (unsigned)s[0] | ((unsigned)s[136] << 16); o.y = (unsigned)s[2 * 136] | ((unsigned)s[3 * 136] << 16);
                o.z = (unsigned)s[4 * 136] | ((unsigned)s[5 * 136] << 16); o.w = (unsigned)s[6 * 136] | ((unsigned)s[7 * 136] << 16);
                *(u32x4*)(VT + ((size_t)(b * 6 + hh) * 128 + d) * LKEYS + L0 + tg * 8) = o; }
            __syncthreads();
        }
        if (doC) {
        const f32x4 lngr = *(const f32x4*)(lng + 4 * C.lane), lnbr = *(const f32x4*)(lnb + 4 * C.lane);
        u32x2 nxu, nxr;
        { const bf16_t* pr = P + (size_t)(row0 + C.wave) * P_LD + 2304 + 4 * C.lane; nxu = *(const u32x2*)pr; nxr = *(const u32x2*)(pr + 256); }
        for (int r = C.wave; r < 128; r += NWAVES) {
            const int c4 = 4 * C.lane;
            const f32x4 ur = bf4(nxu), raw = bf4(nxr);
            if (r + NWAVES < 128) { const bf16_t* pr = P + (size_t)(row0 + r + NWAVES) * P_LD + 2304 + c4; nxu = *(const u32x2*)pr; nxr = *(const u32x2*)(pr + 256); }
            { const f32x4 gu = gelu4(ur); u32x2 o; o.x = pk2(gu[0], gu[1]); o.y = pk2(gu[2], gu[3]); *(LAS u32x2*)(uL + r * 264 + c4) = o; }
            const f32x4 gv = gelu4(raw);
            const float mean = wave_sum((gv[0] + gv[1]) + (gv[2] + gv[3])) * (1.f / 256.f); const f32x4 dd = gv - mean;
            const float var = wave_sum((dd[0] * dd[0] + dd[1] * dd[1]) + (dd[2] * dd[2] + dd[3] * dd[3])) * (1.f / 256.f); const float rstd = rsqrtf(var + LN_EPS);
            const f32x4 o = dd * rstd * lngr + lnbr;
#pragma unroll
            for (int k = 0; k < 4; ++k) vT[(c4 + k) * 136 + r] = (bf16_t)f2bf(o[k]);
        }
        __syncthreads();
        {
            const int g = C.wave >> 1, cblk = C.wave & 1, cc = g * 64 + cblk * 32 + r32;
            for (int pblk = 0; pblk < 4; ++pblk) {
                f32x16 acc;
#pragma unroll
                for (int i = 0; i < 16; ++i) acc[i] = 0.f;
                const float* wrow = gws + ((size_t)g * 128 + pblk * 32 + r32) * 128 + 8 * hi;
#pragma unroll
                for (int ks = 0; ks < 8; ++ks) { const f32x4 w0 = *(const f32x4*)(wrow + ks * 16), w1 = *(const f32x4*)(wrow + ks * 16 + 4);
                    u32x4 au; au.x = pk2(w0[0], w0[1]); au.y = pk2(w0[2], w0[3]); au.z = pk2(w1[0], w1[1]); au.w = pk2(w1[2], w1[3]);
                    const bf16x8 bf = *(const LAS bf16x8*)(vT + cc * 136 + ks * 16 + 8 * hi);
                    acc = __builtin_amdgcn_mfma_f32_32x32x16_bf16(__builtin_bit_cast(bf16x8, au), bf, acc, 0, 0, 0); }
#pragma unroll
                for (int reg = 0; reg < 16; ++reg) { const int p = pblk * 32 + crow(reg, hi);
                    const float uu = bf2f(uL[p * 264 + cc]); const float mixed = acc[reg] + gbs[g * 128 + p];
                    uL[p * 264 + cc] = (bf16_t)f2bf(uu * mixed); }
            }
        }
        __syncthreads();
#pragma unroll
        for (int i = 0; i < 8; ++i) { const int piece = C.tid + NTHR * i, r = piece >> 5, part = piece & 31;
            *(u32x4*)(A2 + (size_t)(row0 + r) * DM + 768 + part * 8) = *(const LAS u32x4*)(uL + r * 264 + part * 8); }
        __syncthreads();
        }
    }
}

__device__ __forceinline__ void phase_attn(const Ctx& C, const Args& A, int l) {
    const int i2 = l >> 1; unsigned char* ws = A.ws;
    const bf16_t* Q = (const bf16_t*)(ws + WS_Q); const bf16_t* KA = (const bf16_t*)(ws + WS_KA); const bf16_t* VT = (const bf16_t*)(ws + WS_VT); bf16_t* A2 = (bf16_t*)(ws + WS_A2);
    const float lam_init = 0.8f - 0.6f * expf(-0.3f * (float)l);
    float s1 = 0.f, s2 = 0.f;
    for (int j = 0; j < 64; ++j) { s1 += A.in[I_LQ1][i2 * 64 + j] * A.in[I_LK1][i2 * 64 + j]; s2 += A.in[I_LQ2][i2 * 64 + j] * A.in[I_LK2][i2 * 64 + j]; }
    const float lam = expf(s1) - expf(s2) + lam_init;
    const float* subg = A.in[I_SUBG] + (size_t)i2 * 128;
    const int r32 = C.lane & 31, hi = C.lane >> 5, map = C.wave >> 2, qw = C.wave & 3;
    LAS unsigned char* Kt = C.lds; LAS unsigned char* Vt = C.lds + 2 * 16384; LAS float* xch = (LAS float*)C.lds;
    const int NU = 1536 + (l == 1 ? 48 : 0);
    for (int n = C.vcu; n < NU; n += C.G) {
        int bh, qt; bool isctx = false;
        if (n < 1536) { const int round = n >> 8, slot = n & 255; bh = (slot >> 5) * 3 + (round >> 1); qt = (round & 1) * 32 + (slot & 31); }
        else { isctx = true; bh = (n - 1536) >> 1; qt = (n - 1536) & 1; }
        const int b = bh / 6, h = bh % 6;
        const int qrow0 = isctx ? NLAT + b * CTXL + qt * 128 : b * TT + qt * 128;
        const int NT = isctx ? CTXL / 64 : LKEYS / 64;
        const bf16_t* Kb = KA + (size_t)b * LKEYS * 768 + h * 128;
        const bf16_t* Vb = VT + (size_t)(b * 6 + h) * 128 * LKEYS;
        bf16x8 qf[4];
        { const bf16_t* qp = Q + (size_t)(qrow0 + qw * 32 + r32) * 768 + h * 128 + map * 64 + 8 * hi;
#pragma unroll
          for (int ks = 0; ks < 4; ++ks) qf[ks] = *(const bf16x8*)(qp + ks * 16); }
        f32x16 O[4];
#pragma unroll
        for (int d = 0; d < 4; ++d)
#pragma unroll
            for (int i = 0; i < 16; ++i) O[d][i] = 0.f;
        float m = 0.f, lsum = 0.f;
        unsigned ksrc[2], vsrc[2];
#pragma unroll
        for (int i = 0; i < 2; ++i) { const int row = 4 * (2 * C.wave + i) + (C.lane >> 4), x = row & 15, pi = x < 4 ? x : x < 8 ? x + 4 : x < 12 ? x - 4 : x;
            ksrc[i] = (unsigned)(((row & ~15) + pi) * 768 + (((C.lane & 15) ^ x) * 8));
            const int d = 8 * (2 * C.wave + i) + (C.lane >> 3); vsrc[i] = (unsigned)(d * LKEYS + (((C.lane & 7) ^ ((d >> 1) & 7)) * 8)); }
#define AT_DMA_K(tt, slot) do { _Pragma("unroll") for (int i = 0; i < 2; ++i) __builtin_amdgcn_global_load_lds((const unsigned*)(Kb + (size_t)(tt) * 64 * 768 + ksrc[i]), (LAS unsigned*)(Kt + (slot) * 16384 + (2 * C.wave + i) * 1024), 16, 0, 0); } while (0)
#define AT_DMA_V(tt, slot) do { _Pragma("unroll") for (int i = 0; i < 2; ++i) __builtin_amdgcn_global_load_lds((const unsigned*)(Vb + (size_t)(tt) * 64 + vsrc[i]), (LAS unsigned*)(Vt + (slot) * 16384 + (2 * C.wave + i) * 1024), 16, 0, 0); } while (0)
#define AT_BAR() asm volatile("s_waitcnt vmcnt(0) lgkmcnt(0)\n\ts_barrier" ::: "memory")
#define AT_SB() __builtin_amdgcn_sched_barrier(0)
        const int ksw = r32 & 15, vsw = (r32 >> 1) & 7;
#define AT_QK(P0, P1, ks_) do { const float nm_ = -m; _Pragma("unroll") for (int i = 0; i < 16; ++i) { P0[i] = nm_; P1[i] = nm_; } \
            const LAS unsigned char* kbp_ = Kt + (ks_) * 16384 + r32 * 256; \
            _Pragma("unroll") for (int ks = 0; ks < 4; ++ks) { const int co_ = ((map * 8 + ks * 2 + hi) ^ ksw) * 16; \
                P0 = __builtin_amdgcn_mfma_f32_32x32x16_bf16(*(const LAS bf16x8*)(kbp_ + co_), qf[ks], P0, 0, 0, 0); P1 = __builtin_amdgcn_mfma_f32_32x32x16_bf16(*(const LAS bf16x8*)(kbp_ + 32 * 256 + co_), qf[ks], P1, 0, 0, 0); } } while (0)
#define AT_LDV(dst, vs_, d) do { _Pragma("unroll") for (int kst = 0; kst < 4; ++kst) dst[kst] = *(const LAS u32x4*)(Vt + (vs_) * 16384 + ((d) * 32 + r32) * 128 + (((kst * 2 + hi) ^ vsw) * 16)); } while (0)
#define AT_PV(src, d) do { _Pragma("unroll") for (int kst = 0; kst < 4; ++kst) O[d] = __builtin_amdgcn_mfma_f32_32x32x16_bf16(__builtin_bit_cast(bf16x8, src[kst]), pb[kst], O[d], 0, 0, 0); } while (0)
#define AT_SOFTPV(P0, P1, N0, N1, first, hasn, vs_) do { \
            asm volatile("s_nop 15\n\ts_nop 7" : "+v"(P0), "+v"(P1)); \
            float mx = max3f(P0[0], P0[1], P1[0]), mx2 = max3f(P0[2], P0[3], P1[1]); mx = max3f(mx, P1[2], P1[3]); \
            _Pragma("unroll") for (int i = 4; i < 16; i += 4) { mx = max3f(mx, P0[i], P0[i + 1]); mx2 = max3f(mx2, P0[i + 2], P0[i + 3]); mx = max3f(mx, P1[i], P1[i + 1]); mx2 = max3f(mx2, P1[i + 2], P1[i + 3]); } \
            mx = fmaxf(mx, mx2); \
            { auto rr = __builtin_amdgcn_permlane32_swap(__float_as_uint(mx), __float_as_uint(mx), false, false); mx = fmaxf(__uint_as_float(rr[0]), __uint_as_float(rr[1])); } \
            if ((first) || __any(mx > 8.f)) { const float dl = (first) ? mx : fmaxf(mx, 0.f); const float sc = __builtin_amdgcn_exp2f(-dl); lsum *= sc; \
                _Pragma("unroll") for (int d = 0; d < 4; ++d) _Pragma("unroll") for (int i = 0; i < 16; ++i) O[d][i] *= sc; \
                _Pragma("unroll") for (int i = 0; i < 16; ++i) { P0[i] -= dl; P1[i] -= dl; } \
                if (hasn) { asm volatile("s_nop 15\n\ts_nop 7" : "+v"(N0), "+v"(N1)); _Pragma("unroll") for (int i = 0; i < 16; ++i) { N0[i] -= dl; N1[i] -= dl; } } \
                m += dl; } \
            float ps = 0.f, ps2 = 0.f; \
            _Pragma("unroll") for (int i = 0; i < 16; ++i) { P0[i] = __builtin_amdgcn_exp2f(P0[i]); P1[i] = __builtin_amdgcn_exp2f(P1[i]); ps += P0[i]; ps2 += P1[i]; } \
            lsum += ps + ps2; \
            bf16x8 pb[4]; \
            { u32x4 w; w.x = pk2(P0[0], P0[1]); w.y = pk2(P0[2], P0[3]); w.z = pk2(P0[4], P0[5]); w.w = pk2(P0[6], P0[7]); pb[0] = __builtin_bit_cast(bf16x8, w); \
              w.x = pk2(P0[8], P0[9]); w.y = pk2(P0[10], P0[11]); w.z = pk2(P0[12], P0[13]); w.w = pk2(P0[14], P0[15]); pb[1] = __builtin_bit_cast(bf16x8, w); \
              w.x = pk2(P1[0], P1[1]); w.y = pk2(P1[2], P1[3]); w.z = pk2(P1[4], P1[5]); w.w = pk2(P1[6], P1[7]); pb[2] = __builtin_bit_cast(bf16x8, w); \
              w.x = pk2(P1[8], P1[9]); w.y = pk2(P1[10], P1[11]); w.z = pk2(P1[12], P1[13]); w.w = pk2(P1[14], P1[15]); pb[3] = __builtin_bit_cast(bf16x8, w); } \
            u32x4 va[4]; \
            AT_LDV(va, vs_, 0); AT_SB(); AT_PV(va, 0); AT_SB(); AT_LDV(va, vs_, 1); AT_SB(); AT_PV(va, 1); AT_SB(); AT_LDV(va, vs_, 2); AT_SB(); AT_PV(va, 2); AT_SB(); AT_LDV(va, vs_, 3); AT_SB(); AT_PV(va, 3); AT_SB(); } while (0)
        f32x16 pA0, pA1, pB0, pB1;
        AT_DMA_K(0, 0); AT_DMA_V(0, 0); AT_DMA_K(1, 1);
        AT_BAR();
        AT_QK(pA0, pA1, 0);
        asm volatile("s_waitcnt lgkmcnt(0)\n\ts_barrier" ::: "memory");
        for (int t = 0; t < NT; t += 2) {
            if (t + 2 < NT) AT_DMA_K(t + 2, 0);
            AT_DMA_V(t + 1, 1);
            AT_SB(); AT_QK(pB0, pB1, 1); AT_SB();
            AT_SOFTPV(pA0, pA1, pB0, pB1, t == 0, true, 0);
            AT_BAR();
            if (t + 3 < NT) AT_DMA_K(t + 3, 1);
            if (t + 2 < NT) AT_DMA_V(t + 2, 0);
            AT_SB(); if (t + 2 < NT) { AT_QK(pA0, pA1, 0); } AT_SB();
            AT_SOFTPV(pB0, pB1, pA0, pA1, false, t + 2 < NT, 1);
            AT_BAR();
        }
#undef AT_DMA_K
#undef AT_DMA_V
#undef AT_BAR
#undef AT_SB
#undef AT_QK
#undef AT_LDV
#undef AT_PV
#undef AT_SOFTPV
        const float ltot = lsum + __shfl_xor(lsum, 32);
        const float invl = 1.f / ltot;
        if (map == 1) { const float f = lam * invl;
#pragma unroll
            for (int d = 0; d < 4; ++d)
#pragma unroll
                for (int i = 0; i < 16; ++i) xch[(qw * 64 + d * 16 + i) * 64 + C.lane] = O[d][i] * f; }
        __syncthreads();
        if (map == 0) { float ss = 0.f;
#pragma unroll
            for (int d = 0; d < 4; ++d)
#pragma unroll
                for (int i = 0; i < 16; ++i) { const float o = O[d][i] * invl - xch[(qw * 64 + d * 16 + i) * 64 + C.lane]; O[d][i] = o; ss += o * o; }
            ss += __shfl_xor(ss, 32);
            const float rn = rsqrtf(ss * (1.f / 128.f) + RMS_EPS) * (1.f - lam_init);
            bf16_t* orow = A2 + (size_t)(qrow0 + qw * 32 + r32) * DM + h * 128;
#pragma unroll
            for (int d = 0; d < 4; ++d)
#pragma unroll
                for (int g4 = 0; g4 < 4; ++g4) { const int dd = 32 * d + 8 * g4 + 4 * hi; const f32x4 sg = *(const f32x4*)(subg + dd);
                    const f32x4 v = {O[d][4 * g4] * rn * sg[0], O[d][4 * g4 + 1] * rn * sg[1], O[d][4 * g4 + 2] * rn * sg[2], O[d][4 * g4 + 3] * rn * sg[3]};
                    st4bf(orow + dd, v); } }
        __syncthreads();
    }
}

__device__ __forceinline__ void phase_rt(const Ctx& C, const Args& A, int l) {
    unsigned char* ws = A.ws; float* X = (float*)(ws + WS_X); bf16_t* H = (bf16_t*)(ws + WS_H); float* AFF = (float*)(ws + WS_AFF); float* STAT = (float*)(ws + WS_P);
    const float* MOD = (const float*)(ws + WS_MOD) + (size_t)l * 5 * 6144;
    const float* lng = A.in[I_LNG] + (size_t)(l * 2 + 0) * DM; const float* lnb = A.in[I_LNB] + (size_t)(l * 2 + 0) * DM;
    LAS float* wrs = (LAS float*)C.lds;
    { const float* wr = A.in[I_WR] + (size_t)l * DM * 16; for (int i = C.tid; i < DM * 16; i += NTHR) wrs[(i & 15) * 1024 + (i >> 4)] = wr[i]; }
    __syncthreads();
    const int row0 = (int)(((long)C.gw * MROWS) / C.NGW), row1 = (int)(((long)(C.gw + 1) * MROWS) / C.NGW);
    f32x4 lngr[4], lnbr[4], scr[4], shr[4]; int cmi = -1;
#pragma unroll
    for (int j = 0; j < 4; ++j) { const int col = 4 * C.lane + 256 * j; lngr[j] = *(const f32x4*)(lng + col); lnbr[j] = *(const f32x4*)(lnb + col); scr[j] = lngr[j]; shr[j] = lngr[j]; }
    f32x4 xn[4];
    if (row0 < row1) {
#pragma unroll
        for (int j = 0; j < 4; ++j) xn[j] = *(const f32x4*)(X + (size_t)row0 * DM + 4 * C.lane + 256 * j); }
    for (int row = row0; row < row1; ++row) {
        const int mi = row_mi(row);
        if (mi != cmi) { cmi = mi; const float* md = MOD + mi * 6144;
#pragma unroll
            for (int j = 0; j < 4; ++j) { const int col = 4 * C.lane + 256 * j; scr[j] = *(const f32x4*)(md + 4 * DM + col) + 1.f; shr[j] = *(const f32x4*)(md + 3 * DM + col); } }
        f32x4 x[4]; float s = 0.f;
#pragma unroll
        for (int j = 0; j < 4; ++j) { x[j] = xn[j]; s += (x[j][0] + x[j][1]) + (x[j][2] + x[j][3]); }
        if (row + 1 < row1) {
#pragma unroll
            for (int j = 0; j < 4; ++j) xn[j] = *(const f32x4*)(X + (size_t)(row + 1) * DM + 4 * C.lane + 256 * j); }
        const float mean = wave_sum(s) * (1.f / DM); float s2 = 0.f;
#pragma unroll
        for (int j = 0; j < 4; ++j) { x[j] = x[j] - mean; s2 += (x[j][0] * x[j][0] + x[j][1] * x[j][1]) + (x[j][2] * x[j][2] + x[j][3] * x[j][3]); }
        const float rstd = rsqrtf(wave_sum(s2) * (1.f / DM) + LN_EPS);
        if (C.lane == 0) *(f32x2*)(STAT + (size_t)row * 2) = (f32x2){mean, rstd};
        float v[16];
#pragma unroll
        for (int e = 0; e < 16; ++e) v[e] = 0.f;
#pragma unroll
        for (int j = 0; j < 4; ++j) { const int col = 4 * C.lane + 256 * j;
            const f32x4 x1 = x[j] * rstd * lngr[j] + lnbr[j];
            const f32x4 h = x1 * scr[j] + shr[j];
            st4bf(H + (size_t)row * DM + col, h);
#pragma unroll
            for (int e = 0; e < 16; ++e) { const f32x4 w = *(const LAS f32x4*)(wrs + e * 1024 + col); v[e] += (h[0] * w[0] + h[1] * w[1]) + (h[2] * w[2] + h[3] * w[3]); }
            __builtin_amdgcn_sched_barrier(0); }
#pragma unroll
        for (int i = 0; i < 8; ++i) { const float send = (C.lane & 32) ? v[i] : v[i + 8], keep = (C.lane & 32) ? v[i + 8] : v[i]; v[i] = keep + __shfl_xor(send, 32); }
#pragma unroll
        for (int i = 0; i < 4; ++i) { const float send = (C.lane & 16) ? v[i] : v[i + 4], keep = (C.lane & 16) ? v[i + 4] : v[i]; v[i] = keep + __shfl_xor(send, 16); }
#pragma unroll
        for (int i = 0; i < 2; ++i) { const float send = (C.lane & 8) ? v[i] : v[i + 2], keep = (C.lane & 8) ? v[i + 2] : v[i]; v[i] = keep + __shfl_xor(send, 8); }
        { const float send = (C.lane & 4) ? v[0] : v[1], keep = (C.lane & 4) ? v[1] : v[0]; v[0] = keep + __shfl_xor(send, 4); }
        float z = v[0]; z += __shfl_xor(z, 1); z += __shfl_xor(z, 2);
        float mx = z;
#pragma unroll
        for (int o = 4; o < 64; o <<= 1) mx = fmaxf(mx, __shfl_xor(mx, o));
        const float ex = expf(z - mx); float sm = ex;
#pragma unroll
        for (int o = 4; o < 64; o <<= 1) sm += __shfl_xor(sm, o);
        if ((C.lane & 3) == 0) AFF[(size_t)row * 16 + (C.lane >> 2)] = ex / sm;
    }
}

__device__ __forceinline__ void phase_tk(const Ctx& C, const Args& A) {
    unsigned char* ws = A.ws; const float* AFF = (const float*)(ws + WS_AFF); int* SLOT = (int*)(ws + WS_SLOT); int* IDX = (int*)(ws + WS_IDX); float* GATE = (float*)(ws + WS_GATE);
    LAS unsigned* key = (LAS unsigned*)C.lds;
    LAS unsigned* hist = key + 8192;
    LAS unsigned* scn = hist + 256;
    LAS unsigned* wtot = scn + 256;
    LAS unsigned* bc = wtot + 8;
    for (int u = blockIdx.x; u < 128; u += C.G) {
        const bool isctx = u >= 64; const int uu = u & 63, b = uu >> 4, e = uu & 15;
        const int n = isctx ? CTXL : TT, cap = isctx ? CAP_C : CAP_L;
        const int row0 = isctx ? NLAT + b * CTXL : b * TT;
        const int slot0 = e * ESLOTS + (isctx ? 4 * CAP_L + b * CAP_C : b * CAP_L);
        for (int i = C.tid; i < n; i += NTHR) key[i] = __float_as_uint(AFF[(size_t)(row0 + i) * 16 + e]);
        unsigned prefix = 0u, pmask = 0u; int need = cap;
        for (int pass = 0; pass < 4; ++pass) {
            const int shift = 24 - 8 * pass;
            if (C.tid < 256) hist[C.tid] = 0u;
            __syncthreads();
            for (int i = C.tid; i < n; i += NTHR) { const unsigned k = key[i]; if ((k & pmask) == prefix) __hip_atomic_fetch_add(&hist[(k >> shift) & 255u], 1u, __ATOMIC_RELAXED, __HIP_MEMORY_SCOPE_WORKGROUP); }
            __syncthreads();
            {
                const unsigned hd = (C.tid < 256) ? hist[255 - C.tid] : 0u; unsigned inc = hd;
#pragma unroll
                for (int o = 1; o < 64; o <<= 1) { const unsigned t = __shfl_up(inc, o); if (C.lane >= o) inc += t; }
                if (C.tid < 256 && C.lane == 63) wtot[C.wave] = inc;
                __syncthreads();
                if (C.tid < 256) { unsigned base = 0u; for (int w = 0; w < C.wave; ++w) base += wtot[w];
                    const unsigned incl = base + inc, above = incl - hd;
                    if (incl >= (unsigned)need && above < (unsigned)need) { bc[0] = (unsigned)(255 - C.tid); bc[1] = (unsigned)need - above; } }
            }
            __syncthreads();
            prefix |= bc[0] << shift; pmask |= 255u << shift; need = (int)bc[1];
            __syncthreads();
        }
        const int per = (n + NTHR - 1) / NTHR; const int i0 = C.tid * per;
        unsigned cg = 0u, ce = 0u;
        for (int j = 0; j < per; ++j) { const int i = i0 + j; if (i < n) { const unsigned k = key[i]; cg += (k > prefix); ce += (k == prefix); } }
        unsigned pk = cg | (ce << 16), inc = pk;
#pragma unroll
        for (int o = 1; o < 64; o <<= 1) { const unsigned t = __shfl_up(inc, o); if (C.lane >= o) inc += t; }
        if (C.lane == 63) wtot[C.wave] = inc;
        __syncthreads();
        unsigned wbase = 0u;
        for (int w = 0; w < C.wave; ++w) wbase += wtot[w];
        const unsigned excl = wbase + inc - pk;
        unsigned rg = excl & 0xffffu, re = excl >> 16;
        const int ngt = cap - need;
        for (int j = 0; j < per; ++j) { const int i = i0 + j; if (i < n) { const unsigned k = key[i]; int pos = -1;
            if (k > prefix) { pos = (int)rg; ++rg; } else if (k == prefix) { if ((int)re < need) pos = ngt + (int)re; ++re; }
            const int row = row0 + i;
            if (pos >= 0) { IDX[slot0 + pos] = row; GATE[slot0 + pos] = __uint_as_float(k); SLOT[(size_t)row * 16 + e] = slot0 + pos; }
            else SLOT[(size_t)row * 16 + e] = -1; } }
        if (isctx && b == 0 && C.tid < ESLOTS - 4224) { IDX[e * ESLOTS + 4224 + C.tid] = 0; GATE[e * ESLOTS + 4224 + C.tid] = 0.f; }
        __syncthreads();
    }
}

__device__ __forceinline__ void phase_cb(const Ctx& C, const Args& A, int l) {
    unsigned char* ws = A.ws; float* X = (float*)(ws + WS_X); bf16_t* H = (bf16_t*)(ws + WS_H); const int* SLOT = (const int*)(ws + WS_SLOT); const bf16_t* YE = (const bf16_t*)(ws + WS_YE);
    const float* MOD = (const float*)(ws + WS_MOD) + (size_t)l * 5 * 6144; const float* MODN = MOD + 5 * 6144;
    const float* lng = A.in[I_LNG] + (size_t)(l * 2 + 1) * DM; const float* lnb = A.in[I_LNB] + (size_t)(l * 2 + 1) * DM;
    const float* lng1 = A.in[I_LNG] + (size_t)(l * 2 + 0) * DM; const float* lnb1 = A.in[I_LNB] + (size_t)(l * 2 + 0) * DM; const float* STAT = (const float*)(ws + WS_P);
    const int row0 = (int)(((long)C.gw * MROWS) / C.NGW), row1 = (int)(((long)(C.gw + 1) * MROWS) / C.NGW);
    f32x4 lngr[4], lnbr[4], gfr[4], nsc[4], nsh[4], l1g[4], l1b[4]; int cmi = -1;
#pragma unroll
    for (int j = 0; j < 4; ++j) { const int col = 4 * C.lane + 256 * j; lngr[j] = *(const f32x4*)(lng + col); lnbr[j] = *(const f32x4*)(lnb + col); gfr[j] = lngr[j]; nsc[j] = lngr[j]; nsh[j] = lngr[j];
        l1g[j] = *(const f32x4*)(lng1 + col); l1b[j] = *(const f32x4*)(lnb1 + col); }
    int svn = -1; f32x4 xn[4]; f32x2 stn = {0.f, 0.f};
    if (row0 < row1) { svn = SLOT[(size_t)row0 * 16 + (C.lane & 15)]; stn = *(const f32x2*)(STAT + (size_t)row0 * 2);
#pragma unroll
        for (int j = 0; j < 4; ++j) xn[j] = *(const f32x4*)(X + (size_t)row0 * DM + 4 * C.lane + 256 * j); }
    for (int row = row0; row < row1; ++row) {
        const int mi = row_mi(row);
        if (mi != cmi) { cmi = mi; const float* md = MOD + mi * 6144; const float* mn = MODN + mi * 6144;
#pragma unroll
            for (int j = 0; j < 4; ++j) { const int col = 4 * C.lane + 256 * j; gfr[j] = *(const f32x4*)(md + 5 * DM + col);
                if (l < DEPTH - 1) { nsc[j] = *(const f32x4*)(mn + DM + col) + 1.f; nsh[j] = *(const f32x4*)(mn + col); } } }
        const int sv = svn;
        unsigned mask = (unsigned)__ballot(sv >= 0) & 0xffffu;
        f32x4 acc[4];
#pragma unroll
        for (int j = 0; j < 4; ++j) acc[j] = (f32x4){0.f, 0.f, 0.f, 0.f};
        u32x2 y0[4], y1[4]; bool h0 = false, h1 = false;
        if (mask) { const int e = __builtin_ctz(mask); mask &= mask - 1; h0 = true; const int sl = __builtin_amdgcn_readlane(sv, e);
#pragma unroll
            for (int j = 0; j < 4; ++j) y0[j] = *(const u32x2*)(YE + (size_t)sl * DM + 4 * C.lane + 256 * j); }
        if (mask) { const int e = __builtin_ctz(mask); mask &= mask - 1; h1 = true; const int sl = __builtin_amdgcn_readlane(sv, e);
#pragma unroll
            for (int j = 0; j < 4; ++j) y1[j] = *(const u32x2*)(YE + (size_t)sl * DM + 4 * C.lane + 256 * j); }
        f32x4 x[4]; const f32x2 st = stn;
#pragma unroll
        for (int j = 0; j < 4; ++j) x[j] = xn[j];
        if (row + 1 < row1) { svn = SLOT[(size_t)(row + 1) * 16 + (C.lane & 15)]; stn = *(const f32x2*)(STAT + (size_t)(row + 1) * 2);
#pragma unroll
            for (int j = 0; j < 4; ++j) xn[j] = *(const f32x4*)(X + (size_t)(row + 1) * DM + 4 * C.lane + 256 * j); }
        if (h0) {
#pragma unroll
            for (int j = 0; j < 4; ++j) acc[j] += (f32x4){__uint_as_float(y0[j].x << 16), __uint_as_float(y0[j].x & 0xffff0000u), __uint_as_float(y0[j].y << 16), __uint_as_float(y0[j].y & 0xffff0000u)}; }
        if (h1) {
#pragma unroll
            for (int j = 0; j < 4; ++j) acc[j] += (f32x4){__uint_as_float(y1[j].x << 16), __uint_as_float(y1[j].x & 0xffff0000u), __uint_as_float(y1[j].y << 16), __uint_as_float(y1[j].y & 0xffff0000u)}; }
        while (mask) { const int e = __builtin_ctz(mask); mask &= mask - 1; const int sl = __builtin_amdgcn_readlane(sv, e);
#pragma unroll
            for (int j = 0; j < 4; ++j) acc[j] += ld4bf(YE + (size_t)sl * DM + 4 * C.lane + 256 * j); }
        float sm = 0.f;
#pragma unroll
        for (int j = 0; j < 4; ++j) { x[j] = ((x[j] - st[0]) * st[1] * l1g[j] + l1b[j]) * ALPHA_DN + gfr[j] * acc[j];
            sm += (x[j][0] + x[j][1]) + (x[j][2] + x[j][3]); }
        const float mean = wave_sum(sm) * (1.f / DM); float s2 = 0.f;
#pragma unroll
        for (int j = 0; j < 4; ++j) { x[j] = x[j] - mean; s2 += (x[j][0] * x[j][0] + x[j][1] * x[j][1]) + (x[j][2] * x[j][2] + x[j][3] * x[j][3]); }
        const float rstd = rsqrtf(wave_sum(s2) * (1.f / DM) + LN_EPS);
#pragma unroll
        for (int j = 0; j < 4; ++j) { const int col = 4 * C.lane + 256 * j;
            const f32x4 x2 = x[j] * rstd * lngr[j] + lnbr[j];
            if (l < DEPTH - 1) { *(f32x4*)(X + (size_t)row * DM + col) = x2; st4bf(H + (size_t)row * DM + col, x2 * nsc[j] + nsh[j]); }
            else if (row < NLAT) *(f32x4*)(A.out + (size_t)row * DM + col) = x2; }
    }
}


#ifndef GEMM_NOINLINE
#define GEMM_NOINLINE 0
#endif
#if GEMM_NOINLINE
#define GEMM_FN __device__ __noinline__
#else
#define GEMM_FN __device__ __forceinline__
#endif
GEMM_FN void gphase_in(LAS unsigned char* lds, unsigned char* ws, int nN, int G) {
    int bx = blockIdx.x; asm volatile("" : "+s"(bx), "+s"(G));
    pg8::Gemm g{(const bf16_t*)(ws + WS_H), (const bf16_t*)(ws + WS_WIN), DM}; pg8::Order<0> S; S.init(MROWS / 256, nN, G, bx, nullptr, 0);
    pg8::EpiBf16 E{(bf16_t*)(ws + WS_P), P_LD}; pg8::gemm_phase(lds, g, S, E); }
GEMM_FN void gphase_in_odd(LAS unsigned char* lds, unsigned char* ws, int G) {
    int bx = blockIdx.x; asm volatile("" : "+s"(bx), "+s"(G));
    pg8::Gemm g{(const bf16_t*)(ws + WS_H), (const bf16_t*)(ws + WS_WIN), DM}; pg8::Order<0> S; S.init(MROWS / 256, D_IN_ODD / 256, G, bx, nullptr, 0);
    pg8::EpiOdd E{(bf16_t*)(ws + WS_P), (bf16_t*)(ws + WS_Q), (bf16_t*)(ws + WS_KA), (const float*)(ws + WS_ROPE)}; pg8::gemm_phase(lds, g, S, E); }
GEMM_FN void gphase_lora(LAS unsigned char* lds, unsigned char* ws, const float* d0, const float* a0, const float* kal, int G) {
    int bx = blockIdx.x; asm volatile("" : "+s"(bx), "+s"(G));
    pg8::Gemm g{(const bf16_t*)(ws + WS_LIN), (const bf16_t*)(ws + WS_WLORA), LORA_K}; pg8::Order<0> S; S.init(MROWS / 256, LORA_N / 256, G, bx, nullptr, 0);
    pg8::EpiLora E{ws + WS_SCN, (bf16_t*)(ws + WS_G), d0, a0, kal}; pg8::gemm_phase(lds, g, S, E); }
GEMM_FN void gphase_out(LAS unsigned char* lds, unsigned char* ws, const float* modl, int G, const float* xin, const float* cin) {
    int bx = blockIdx.x; asm volatile("" : "+s"(bx), "+s"(G));
    pg8::Gemm g{(const bf16_t*)(ws + WS_A2), (const bf16_t*)(ws + WS_WOUT), DM}; pg8::Order<0> S; S.init(MROWS / 256, DM / 256, G, bx, nullptr, 0);
    pg8::EpiRes E{(float*)(ws + WS_X), modl, xin, cin}; pg8::gemm_phase(lds, g, S, E); }
GEMM_FN void gphase_e1(LAS unsigned char* lds, unsigned char* ws, int G, int l) {
    int bx = blockIdx.x; asm volatile("" : "+s"(bx), "+s"(G));
    pg8::Gemm g{(const bf16_t*)(ws + WS_H), (const bf16_t*)(ws + WS_WE13 + (size_t)(l & 1) * WE13_BYTES), DM}; pg8::EpiSwiGLU E{(bf16_t*)(ws + WS_HID)};
    pg8::OrderExp<1> S; S.init(4096 / 256, G, bx, (const int*)(ws + WS_IDX), (long)4096 * DM); pg8::gemm_phase(lds, g, S, E); }
GEMM_FN void gphase_e2(LAS unsigned char* lds, unsigned char* ws, int G, int l) {
    int bx = blockIdx.x; asm volatile("" : "+s"(bx), "+s"(G));
    pg8::Gemm g{(const bf16_t*)(ws + WS_HID), (const bf16_t*)(ws + WS_WE2 + (size_t)(l & 1) * WE2_BYTES), D_EXP}; pg8::EpiYE E{(bf16_t*)(ws + WS_YE), (const float*)(ws + WS_GATE)};
    pg8::OrderExp<2> S; S.init(DM / 256, G, bx, nullptr, (long)DM * D_EXP); pg8::gemm_phase(lds, g, S, E); }

constexpr int NSLOT = 13;
constexpr int NSTEP = 1 + DEPTH * NSLOT;
__global__ void __launch_bounds__(NTHR, 2) mk_fwd(Args KA) {
    extern __shared__ __attribute__((aligned(16))) unsigned char lds_raw[];
    volatile LAS unsigned* MISC = (volatile LAS unsigned*)((LAS unsigned char*)lds_raw + LDS_MISC);
    if (threadIdx.x < 16) MISC[threadIdx.x] = 0u;
    if (threadIdx.x == 0) { LAS unsigned long long* tb = (LAS unsigned long long*)((LAS unsigned char*)lds_raw + LDS_PTAB);
#pragma unroll
        for (int i = 0; i < 37; ++i) tb[i] = (unsigned long long)KA.in[i];
        tb[37] = (unsigned long long)KA.out; tb[38] = (unsigned long long)KA.ws; }
    __syncthreads();
    const int lo = KA.lo, hi = KA.hi;
    unsigned bar_x = 0;
    if (hi - lo > 1) { const XcdBarrier b0 = xcd_barrier_post((unsigned*)(KA.ws + WS_CTL), MISC); bar_x = b0.x; }
#ifndef PH_MASK
#define PH_MASK 0xFFFFFF
#endif
#ifndef REP_MASK
#define REP_MASK 0
#endif
#define PH_BIT(k) (((k) == 0) ? 0 : 1 + ((k) - 1) % NSLOT + (((k) - 1) % NSLOT >= 2 && ((k) - 1) % NSLOT <= 3 && odd ? 12 : 0))
#define RUN(k, ...) do { if (((PH_MASK >> PH_BIT(k)) & 1) && lo <= (k) && (k) < hi) { const int nrep = ((REP_MASK >> PH_BIT(k)) & 1) ? 2 : 1; \
        _Pragma("unroll 1") for (int rep = 0; rep < nrep; ++rep) { \
        Ctx C; mkctx(C, (LAS unsigned char*)lds_raw); Args A; ldargs(A, (LAS unsigned char*)lds_raw); unsigned char* ws = A.ws; \
        const float* MODL = (const float*)(ws + WS_MOD) + (size_t)l * 5 * 6144; (void)MODL; \
        __VA_ARGS__; if ((k) + 1 < hi || rep + 1 < nrep) { XcdBarrier bar; bar.bar = (unsigned*)(ws + WS_CTL); bar.x = bar_x; bar.st = MISC; xcd_barrier(bar); } } } } while (0)
    { const bool odd = false; const int l = 0; RUN(0, { phase_init(C, A); __syncthreads(); conv_items(C, A, 0, C.gw, C.NGW, true, true, true); }); }
#pragma unroll 1
    for (int l = 0; l < DEPTH; ++l) {
        const int sb = 1 + l * NSLOT; const bool odd = l & 1;
        if (!(CHUNKED_SCAN && odd)) { RUN(sb + 0, { phase_conv(C, A, l); if (l == 0) phase_modh(C, A, 0); }); }
        if (odd) { RUN(sb + 1, { gphase_in_odd(C.lds, ws, C.G);
                   const int tail = ((MROWS / 256) * (D_IN_ODD / 256)) % C.G;
                   if (CHUNKED_SCAN && l + 1 < DEPTH && tail > 0 && (int)blockIdx.x >= tail) conv_items(C, A, l + 1, ((int)blockIdx.x - tail) * NWAVES + C.wave, (C.G - tail) * NWAVES, false, false, true, 0, YW_IN_HI); }); }
        else { RUN(sb + 1, { gphase_in(C.lds, ws, D_IN_EVEN_PAD / 256, C.G);
                   const int tail = ((MROWS / 256) * (D_IN_EVEN_PAD / 256)) % C.G;
                   if (CHUNKED_SCAN && l + 1 < DEPTH && tail > 0 && (int)blockIdx.x >= tail) conv_items(C, A, l + 1, ((int)blockIdx.x - tail) * NWAVES + C.wave, (C.G - tail) * NWAVES, false, false, true, 0, XW_IN_HI); }); }
        if (!odd) {
            RUN(sb + 2, phase_ef1(C, A, l));
            RUN(sb + 3, { const int i2 = l >> 1; gphase_lora(C.lds, ws, A.in[I_D0] + (size_t)i2 * 2 * 768, A.in[I_A0] + (size_t)i2 * 2 * 768, A.in[I_KAL] + (size_t)i2 * 768, C.G); });
#if CHUNKED_SCAN
            RUN(sb + 4, phase_csa(C, A));
            RUN(sb + 5, phase_csb(C, A, l));
#else
            RUN(sb + 4, phase_scan(C, A));
#endif
            RUN(sb + 6, phase_ef2(C, A, l));
        } else {
            RUN(sb + 2, { phase_of1(C, A, l);
                   const int busy2 = 256 + 8 * 7 - C.G;
                   if (CHUNKED_SCAN && l + 1 < DEPTH && busy2 > 0 && (int)blockIdx.x >= busy2) conv_items(C, A, l + 1, ((int)blockIdx.x - busy2) * NWAVES + C.wave, (C.G - busy2) * NWAVES, false, false, true, YW_IN_HI, YW_OF_HI); });
            RUN(sb + 3, phase_attn(C, A, l));
        }
        RUN(sb + 7, { gphase_out(C.lds, ws, MODL, C.G, l == 0 ? A.in[I_X] : (const float*)(ws + WS_X), l == 0 ? A.in[I_CTX] : (const float*)(ws + WS_X) + (size_t)NLAT * DM);
                   const int tail = ((MROWS / 256) * (DM / 256)) % C.G;
                   if (CHUNKED_SCAN && l + 1 < DEPTH && tail > 0 && (int)blockIdx.x >= tail) conv_items(C, A, l + 1, ((int)blockIdx.x - tail) * NWAVES + C.wave, (C.G - tail) * NWAVES, false, false, true, odd ? YW_OF_HI : XW_IN_HI, odd ? YW_OUT_HI : XW_OUT_HI); });
        RUN(sb + 8, phase_rt(C, A, l));
        RUN(sb + 9, { phase_tk(C, A);
                   if (CHUNKED_SCAN && l + 1 < DEPTH && (int)blockIdx.x >= 128) conv_items(C, A, l + 1, ((int)blockIdx.x - 128) * NWAVES + C.wave, (C.G - 128) * NWAVES, false, false, true, odd ? YW_OUT_HI : XW_OUT_HI, odd ? YW_TK_HI : XW_TK_HI); });
        RUN(sb + 10, gphase_e1(C.lds, ws, C.G, l));
        RUN(sb + 11, gphase_e2(C.lds, ws, C.G, l));
        RUN(sb + 12, { phase_cb(C, A, l); if (CHUNKED_SCAN && !odd && l + 1 < DEPTH) { __syncthreads(); conv_items(C, A, l + 1, C.gw, C.NGW, false, true, false); } });
    }
#undef RUN
}

#ifdef PHASE_PROBE
#define PROBE_PRE extern __shared__ __attribute__((aligned(16))) unsigned char lds_raw[]; Ctx C; mkctx(C, (LAS unsigned char*)lds_raw); unsigned char* ws = A.ws; (void)ws;
__global__ void __launch_bounds__(NTHR, 2) pr_init(Args A) { PROBE_PRE phase_init(C, A); }
__global__ void __launch_bounds__(NTHR, 2) pr_conv(Args A) { PROBE_PRE phase_conv(C, A, A.lo); }
__global__ void __launch_bounds__(NTHR, 2) pr_modh(Args A) { PROBE_PRE phase_modh(C, A, A.lo); }
__global__ void __launch_bounds__(NTHR, 2) pr_ef1(Args A) { PROBE_PRE phase_ef1(C, A, A.lo); }
__global__ void __launch_bounds__(NTHR, 2) pr_scan(Args A) { PROBE_PRE phase_scan(C, A); }
__global__ void __launch_bounds__(NTHR, 2) pr_ef2(Args A) { PROBE_PRE phase_ef2(C, A, A.lo); }
__global__ void __launch_bounds__(NTHR, 2) pr_csa(Args A) { PROBE_PRE phase_csa(C, A); }
__global__ void __launch_bounds__(NTHR, 2) pr_csb(Args A) { PROBE_PRE phase_csb(C, A, A.lo); }
__global__ void __launch_bounds__(NTHR, 2) pr_of1(Args A) { PROBE_PRE phase_of1(C, A, A.lo); }
__global__ void __launch_bounds__(NTHR, 2) pr_attn(Args A) { PROBE_PRE phase_attn(C, A, A.lo); }
__global__ void __launch_bounds__(NTHR, 2) pr_rt(Args A) { PROBE_PRE phase_rt(C, A, A.lo); }
__global__ void __launch_bounds__(NTHR, 2) pr_tk(Args A) { PROBE_PRE phase_tk(C, A); }
__global__ void __launch_bounds__(NTHR, 2) pr_cb(Args A) { PROBE_PRE phase_cb(C, A, A.lo); }
__global__ void __launch_bounds__(NTHR, 2) pr_gemm_in(Args A) { PROBE_PRE pg8::Gemm g{(const bf16_t*)(ws + WS_H), (const bf16_t*)(ws + WS_WIN), DM}; pg8::Order<0> S; S.init(MROWS / 256, A.lo, C.G, (int)blockIdx.x, nullptr, 0);
                      pg8::EpiBf16 E{(bf16_t*)(ws + WS_P), P_LD}; pg8::gemm_phase(C.lds, g, S, E); }
__global__ void __launch_bounds__(NTHR, 2) pr_gemm_lora(Args A) { PROBE_PRE pg8::Gemm g{(const bf16_t*)(ws + WS_LIN), (const bf16_t*)(ws + WS_WLORA), LORA_K}; pg8::Order<0> S; S.init(MROWS / 256, LORA_N / 256, C.G, (int)blockIdx.x, nullptr, 0);
                          const int i2 = A.lo; pg8::EpiLora E{ws + WS_SCN, (bf16_t*)(ws + WS_G), A.in[I_D0] + (size_t)i2 * 2 * 768, A.in[I_A0] + (size_t)i2 * 2 * 768, A.in[I_KAL] + (size_t)i2 * 768};
                          pg8::gemm_phase(C.lds, g, S, E); }
__global__ void __launch_bounds__(NTHR, 2) pr_gemm_out(Args A) { PROBE_PRE pg8::Gemm g{(const bf16_t*)(ws + WS_A2), (const bf16_t*)(ws + WS_WOUT), DM}; pg8::Order<0> S; S.init(MROWS / 256, DM / 256, C.G, (int)blockIdx.x, nullptr, 0);
                      pg8::EpiRes E{(float*)(ws + WS_X), (const float*)(ws + WS_MOD), (const float*)(ws + WS_X), (const float*)(ws + WS_X) + (size_t)NLAT * DM}; pg8::gemm_phase(C.lds, g, S, E); }
__global__ void __launch_bounds__(NTHR, 2) pr_gemm_e1(Args A) { PROBE_PRE pg8::Gemm g{(const bf16_t*)(ws + WS_H), (const bf16_t*)(ws + WS_WE13), DM}; pg8::Order<1> S; S.init(NEXP * 17, 4096 / 256, C.G, (int)blockIdx.x, (const int*)(ws + WS_IDX), (long)4096 * DM);
                      pg8::EpiSwiGLU E{(bf16_t*)(ws + WS_HID)}; pg8::gemm_phase(C.lds, g, S, E); }
__global__ void __launch_bounds__(NTHR, 2) pr_gemm_e2(Args A) { PROBE_PRE pg8::Gemm g{(const bf16_t*)(ws + WS_HID), (const bf16_t*)(ws + WS_WE2), D_EXP}; pg8::Order<2> S; S.init(NEXP * 17, DM / 256, C.G, (int)blockIdx.x, nullptr, (long)DM * D_EXP);
                       pg8::EpiYE E{(bf16_t*)(ws + WS_YE), (const float*)(ws + WS_GATE)}; pg8::gemm_phase(C.lds, g, S, E); }
#endif

extern "C" void kernel_launch(void* const* d_in, const int* in_sizes, int n_in, void* d_out, int out_size, void* d_ws, size_t ws_size, hipStream_t stream) {
    static int grid = 0;
    if (grid == 0) {
        if (n_in != 37 || out_size != NLAT * DM || ws_size < WS_END) { fprintf(stderr, "kernel_launch: unexpected shapes: n_in %d out %d ws %zu (need %zu)\n", n_in, out_size, ws_size, (size_t)WS_END); grid = -1; return; }
        int dev = 0, cus = 0, per_cu = 0;
        if (hipGetDevice(&dev) != hipSuccess || hipDeviceGetAttribute(&cus, hipDeviceAttributeMultiprocessorCount, dev) != hipSuccess) { grid = -1; return; }
        if (hipFuncSetAttribute((const void*)mk_fwd, hipFuncAttributeMaxDynamicSharedMemorySize, LDS_BYTES) != hipSuccess) { fprintf(stderr, "kernel_launch: hipFuncSetAttribute failed\n"); grid = -1; return; }
        if (hipOccupancyMaxActiveBlocksPerMultiprocessor(&per_cu, (const void*)mk_fwd, NTHR, LDS_BYTES) != hipSuccess || per_cu < 1) fprintf(stderr, "kernel_launch: occupancy query reports %d\n", per_cu);
        (void)hipGetLastError();
        grid = cus;
    }
    if (grid < 0) return;
    (void)hipMemsetAsync((char*)d_ws + WS_CTL, 0, CTL_BYTES, stream);
    Args a{};
    for (int i = 0; i < 37; ++i) a.in[i] = (const float*)d_in[i];
    a.out = (float*)d_out; a.ws = (unsigned char*)d_ws;
#if MK_MULTI
    for (int k = 0; k < NSTEP; ++k) {
        if (k >= 1) { const int l = (k - 1) / NSLOT, s = (k - 1) % NSLOT; if ((l & 1) && ((s >= 4 && s <= 6) || (CHUNKED_SCAN && s == 0))) continue; if (!(l & 1) && !CHUNKED_SCAN && s == 5) continue; }
        a.lo = k; a.hi = k + 1;
        hipLaunchKernelGGL(mk_fwd, dim3(grid), dim3(NTHR), LDS_BYTES, stream, a);
    }
#else
    a.lo = 0; a.hi = NSTEP;
    hipLaunchKernelGGL(mk_fwd, dim3(grid), dim3(NTHR), LDS_BYTES, stream, a);
#endif
    const hipError_t le = hipPeekAtLastError();
    if (le != hipSuccess) fprintf(stderr, "kernel_launch: launch failed: %s\n", hipGetErrorName(le));
}
```

```cpp
#include <hip/hip_runtime.h>
#include <cstdio>
#include <cstdint>
#include <cmath>

#ifndef MK_MULTI
#define MK_MULTI 0
#endif
#ifndef CHUNKED_SCAN
#define CHUNKED_SCAN 1
#endif

#define GAS __attribute__((address_space(1)))
#define LAS __attribute__((address_space(3)))
typedef unsigned short bf16_t;
typedef short bf16x8 __attribute__((ext_vector_type(8)));
typedef float f32x4 __attribute__((ext_vector_type(4)));
typedef float f32x2 __attribute__((ext_vector_type(2)));
typedef float f32x16 __attribute__((ext_vector_type(16)));
typedef unsigned u32x4 __attribute__((ext_vector_type(4)));
typedef unsigned u32x2 __attribute__((ext_vector_type(2)));
typedef __bf16 bf16x2_t __attribute__((ext_vector_type(2)));

constexpr int NB = 4, TT = 8192, DM = 1024, NLAT = NB * TT, CTXL = 256, NCTX = NB * CTXL, MROWS = NLAT + NCTX;
constexpr int DEPTH = 4;
constexpr int D_CONV = 256, RW_H = 12, RW_K = 64, D_RWKV = 768, RWKV_COLS = 2688, D_IN_EVEN = 3456, D_IN_EVEN_PAD = 3584;
constexpr int D_DIFF = 768, D_GMLP = 256, D_IN_ODD = 2816;
constexpr int NEXP = 16, D_EXP = 2048, CAP_L = 1024, CAP_C = 32, ESLOTS = 4352;
constexpr int P_LD = 3584;
constexpr int LORA_K = 384, LORA_N = 3840;
constexpr int LKEYS = CTXL + TT;
constexpr float ALPHA_DN = 1.6817928305074290f;
constexpr float DECAY_SCALE = 0.6065306597126334f;
constexpr float GN_EPS = 64e-5f, LN_EPS = 1e-5f, RMS_EPS = 1e-5f;
constexpr float QSCALE = 0.125f * 1.4426950408889634f;

constexpr size_t al256(size_t x) { return (x + 255) & ~(size_t)255; }
constexpr size_t WS_CTL = 0;
constexpr size_t CTL_BYTES = 65536;
constexpr size_t WS_MOD = WS_CTL + CTL_BYTES;
constexpr size_t WS_ROPE = WS_MOD + al256((size_t)DEPTH * 5 * 6144 * 4);
constexpr size_t WS_WIN = WS_ROPE + 32768;
constexpr size_t WS_WOUT = WS_WIN + (size_t)D_IN_EVEN_PAD * DM * 2;
constexpr size_t WS_WLORA = WS_WOUT + (size_t)DM * DM * 2;
constexpr size_t WS_WE13 = WS_WLORA + (size_t)LORA_N * LORA_K * 2;
constexpr size_t WE13_BYTES = (size_t)NEXP * 4096 * DM * 2, WE2_BYTES = (size_t)NEXP * DM * D_EXP * 2;
constexpr size_t WS_WE2 = WS_WE13 + 2 * WE13_BYTES;
constexpr size_t WS_X = WS_WE2 + 2 * WE2_BYTES;
constexpr size_t WS_H = WS_X + (size_t)MROWS * DM * 4;
constexpr size_t WS_A2 = WS_H + (size_t)MROWS * DM * 2;
constexpr size_t WS_P = WS_A2 + (size_t)MROWS * DM * 2;
constexpr size_t WS_AFF = WS_P + (size_t)MROWS * P_LD * 2;
constexpr size_t WS_SLOT = WS_AFF + (size_t)MROWS * 16 * 4;
constexpr size_t WS_IDX = WS_SLOT + (size_t)MROWS * 16 * 4;
constexpr size_t WS_GATE = WS_IDX + al256((size_t)NEXP * ESLOTS * 4);
constexpr size_t WS_R2 = WS_GATE + al256((size_t)NEXP * ESLOTS * 4);
constexpr int SC_REC = 1408, SC_ROW = 12 * SC_REC, SC_W = 0, SC_R = 512, SC_KK = 640, SC_V = 768, SC_B = 896, SC_KR = 1024;
constexpr size_t WS_SCN = WS_R2;
constexpr size_t WS_G = WS_SCN + (size_t)MROWS * SC_ROW;
constexpr size_t WS_LIN = WS_G + (size_t)MROWS * 768 * 2;
constexpr int CS_L = 64, CS_NCH = LKEYS / CS_L, CS_UNITS = NB * RW_H * 2;
constexpr size_t WS_CHK = WS_LIN + (size_t)MROWS * 384 * 2;
constexpr size_t WS_EVEN_END = WS_CHK + (size_t)CS_UNITS * CS_NCH * 32768;
constexpr size_t WS_Y = WS_P;
constexpr size_t WS_Q = WS_R2;
constexpr size_t WS_KA = WS_Q + (size_t)MROWS * 768 * 2;
constexpr size_t WS_VT = WS_KA + (size_t)NB * LKEYS * 768 * 2;
constexpr size_t WS_HID = WS_R2;
constexpr size_t WS_YE = WS_HID + (size_t)NEXP * ESLOTS * D_EXP * 2;
constexpr size_t WS_END = WS_EVEN_END;
static_assert(WS_END <= (size_t)2147483648ull, "workspace over 2 GiB");
static_assert((size_t)2 * MROWS * 768 * 4 <= (size_t)MROWS * P_LD * 2, "Y aliases P");
static_assert(WS_YE + (size_t)NEXP * ESLOTS * DM * 2 <= WS_END, "moe region");

constexpr int LDS_BYTES = 147456;
constexpr int LDS_MISC = 140 * 1024;
constexpr int LDS_PTAB = LDS_MISC + 256;
constexpr int NWAVES = 8, NTHR = 512;

__device__ __forceinline__ unsigned f2bf(float f) { unsigned u = __float_as_uint(f); return (u + 0x7fffu + ((u >> 16) & 1u)) >> 16; }
__device__ __forceinline__ unsigned pk2(float lo, float hi) { f32x2 v = {lo, hi}; bf16x2_t b = __builtin_convertvector(v, bf16x2_t); return __builtin_bit_cast(unsigned, b); }
__device__ __forceinline__ float bflo(unsigned u) { return __uint_as_float(u << 16); }
__device__ __forceinline__ float bfhi(unsigned u) { return __uint_as_float(u & 0xffff0000u); }
__device__ __forceinline__ float bf2f(bf16_t b) { return __uint_as_float((unsigned)b << 16); }
__device__ __forceinline__ float sigmoidf_(float x) { return __builtin_amdgcn_rcpf(1.f + __expf(-x)); }
__device__ __forceinline__ float wave_sum(float v) {
#pragma unroll
    for (int o = 1; o < 64; o <<= 1) v += __shfl_xor(v, o);
    return v;
}
__device__ __forceinline__ float sum16(float v) {
#pragma unroll
    for (int o = 1; o < 16; o <<= 1) v += __shfl_xor(v, o);
    return v;
}
__device__ __forceinline__ f32x4 ld4bf_(const void* p) { const u32x2 u = *(const u32x2*)p; return (f32x4){bflo(u.x), bfhi(u.x), bflo(u.y), bfhi(u.y)}; }
__device__ __forceinline__ void st4bf_(void* p, f32x4 v) { u32x2 o; o.x = pk2(v[0], v[1]); o.y = pk2(v[2], v[3]); *(u32x2*)p = o; }
__device__ __forceinline__ float max3f(float a, float b, float c) { float r; asm("v_max3_f32 %0, %1, %2, %3" : "=v"(r) : "v"(a), "v"(b), "v"(c)); return r; }
__device__ __forceinline__ int crow(int r, int hi) { return (r & 3) + 8 * (r >> 2) + 4 * hi; }
__device__ __forceinline__ f32x2 gelu_pk(f32x2 v) {
    const f32x2 av = __builtin_elementwise_abs(v), d = av * 0.2316418882f + 1.0f;
    f32x2 t; t.x = __builtin_amdgcn_rcpf(d.x); t.y = __builtin_amdgcn_rcpf(d.y);
    f32x2 q = t * 0.5307027145f + (-0.7265760135f); q = q * t + 0.7107068705f; q = q * t + (-0.142248368f); q = q * t + 0.127414796f; q = q * t;
    const f32x2 s = (v * v) * (-0.72134752044f);
    f32x2 e; e.x = __builtin_amdgcn_exp2f(s.x); e.y = __builtin_amdgcn_exp2f(s.y);
    const f32x2 m = v * (q * e), r = v - m;
    f32x2 o; o.x = v.x < 0.f ? m.x : r.x; o.y = v.y < 0.f ? m.y : r.y; return o;
}
__device__ __forceinline__ f32x4 gelu4(f32x4 v) { const f32x2 a = gelu_pk((f32x2){v[0], v[1]}), b = gelu_pk((f32x2){v[2], v[3]}); return (f32x4){a.x, a.y, b.x, b.y}; }
__device__ __forceinline__ float tanh_fast(float x) { return 1.f - 2.f * __builtin_amdgcn_rcpf(1.f + __expf(2.f * x)); }

#define XB_TMO      128
#define XB_XCNT(j)  (256  + 64 * (j))
#define XB_XSUB(j)  (1280 + 64 * (j))
#define XB_XGEN(j)  (2304 + 64 * (j))
#define XB_TOP      3328
#define XB_TOPGEN   3392
#define XCD_BAR_WORDS 3456
#define XB_SPIN_CAP (1u << 20)

__device__ __forceinline__ unsigned xb_ld(unsigned* p)              { return __hip_atomic_load(p, __ATOMIC_RELAXED, __HIP_MEMORY_SCOPE_AGENT); }
__device__ __forceinline__ unsigned xb_add(unsigned* p, unsigned v) { return __hip_atomic_fetch_add(p, v, __ATOMIC_RELAXED, __HIP_MEMORY_SCOPE_AGENT); }
__device__ __forceinline__ unsigned xb_xcc_id() { return (unsigned)__builtin_amdgcn_s_getreg((3 << 11) | 20) & 0xFu; }
#define XB_SPIN(cond, bar) do { unsigned _sp = 0; while (cond) { __builtin_amdgcn_s_sleep(1); \
    if ((++_sp & 255u) == 0u) { if (xb_ld(&(bar)[XB_TMO])) break; if (_sp > XB_SPIN_CAP) { atomicAdd(&(bar)[XB_TMO], 1u); break; } } } } while (0)

struct XcdBarrier { unsigned* bar; unsigned x; volatile LAS unsigned* st; };

__device__ __forceinline__ XcdBarrier xcd_barrier_post(unsigned* bar, volatile LAS unsigned* st) {
    XcdBarrier b; b.bar = bar; b.x = xb_xcc_id(); b.st = st;
    if (threadIdx.x == 0) (void)xb_add(&bar[XB_XCNT(b.x)], 1u);
    return b;
}
__device__ __forceinline__ void xcd_barrier_complete(unsigned* bar, unsigned x, unsigned& nloc, unsigned& nx) {
    const unsigned G = gridDim.x * gridDim.y * gridDim.z;
    unsigned sum, cnt, mine, sp = 0u;
    for (;;) {
        sum = 0u; cnt = 0u; mine = 0u;
#pragma unroll
        for (unsigned j = 0; j < 16; ++j) { const unsigned c = xb_ld(&bar[XB_XCNT(j)]); sum += c; cnt += (c > 0u) ? 1u : 0u; mine = (j == x) ? c : mine; }
        if (sum == G) break;
        __builtin_amdgcn_s_sleep(1);
        if ((++sp & 255u) == 0u) { if (xb_ld(&bar[XB_TMO])) break; if (sp > XB_SPIN_CAP) { atomicAdd(&bar[XB_TMO], 1u); break; } }
    }
    nloc = mine > 0u ? mine : 1u; nx = cnt > 0u ? cnt : 1u;
}
__device__ __forceinline__ void xcd_barrier(const XcdBarrier& b) {
    asm volatile("s_waitcnt vmcnt(0)" ::: "memory");
    __syncthreads();
    if (threadIdx.x == 0) {
        unsigned* bar = b.bar;
        __builtin_amdgcn_s_waitcnt(0);
        unsigned nloc = b.st[0], nx = b.st[1];
        if (nloc == 0u) { xcd_barrier_complete(bar, b.x, nloc, nx); b.st[0] = nloc; b.st[1] = nx; }
        const unsigned old = xb_add(&bar[XB_XSUB(b.x)], 1u);
        const unsigned gen = old / nloc;
        if (old + 1u == (gen + 1u) * nloc) {
            __builtin_amdgcn_fence(__ATOMIC_RELEASE, "agent");
            asm volatile("s_waitcnt vmcnt(0)" ::: "memory");
            const unsigned og = xb_add(&bar[XB_TOP], 1u);
            const unsigned tg = og / nx;
            if (og + 1u == (tg + 1u) * nx) xb_add(&bar[XB_TOPGEN], 1u);
            else XB_SPIN(xb_ld(&bar[XB_TOPGEN]) == tg, bar);
            __builtin_amdgcn_fence(__ATOMIC_ACQUIRE, "agent");
            xb_add(&bar[XB_XGEN(b.x)], 1u);
            asm volatile("s_waitcnt vmcnt(0)" ::: "memory");
        } else {
            XB_SPIN(xb_ld(&bar[XB_XGEN(b.x)]) == gen, bar);
            __builtin_amdgcn_fence(__ATOMIC_ACQUIRE, "agent");
            asm volatile("s_waitcnt vmcnt(0)" ::: "memory");
        }
    }
    __syncthreads();
}

namespace pg8 {
constexpr int BM = 256, BK = 64, HALF = 128, HTB = HALF * BK * 2, STAGE_BYTES = 8 * HTB, NXCD = 8, WGM = 8;
__host__ __device__ __forceinline__ int lds_byte(int r, int c) { const int st = (r >> 4) * 2 + (c >> 5), rr = r & 15, cc = c & 31, ob = rr * 64 + cc * 2; return st * 1024 + (ob ^ (((ob >> 9) & 1) << 5)); }
__host__ __device__ __forceinline__ void stage_rc(int b, int& R, int& C) { const int st = b / 1024, sb = b % 1024, swz = sb ^ (((sb >> 9) & 1) << 5); R = (st >> 1) * 16 + swz / 64; C = (st & 1) * 32 + (swz % 64) / 2; }

struct Unit { int pm, pn, hf; };
struct Gemm { const bf16_t* A; const bf16_t* Bt; int K; };

template <int MODE> struct Order {
    static constexpr bool GATHER = (MODE == 1);
    int nM, nN, nwg, G, c; const int* idx; long bstride;
    __device__ __forceinline__ void init(int nM_, int nN_, int G_, int c_, const int* idx_, long bstride_) { nM = nM_; nN = nN_; nwg = nM * nN; G = G_; c = c_; idx = idx_; bstride = bstride_; }
    __device__ __forceinline__ bool next(int i, Unit& u) const {
        const long L = (long)i * G + c; if (L >= nwg) return false;
        int wgid = (int)L; { const int q = nwg / NXCD, r = nwg % NXCD, xcd = wgid % NXCD, off = wgid / NXCD; wgid = (xcd < r ? xcd * (q + 1) : r * (q + 1) + (xcd - r) * q) + off; }
        const int nig = WGM * nN, gid = wgid / nig, fm = gid * WGM, gsz = (nM - fm) < WGM ? (nM - fm) : WGM;
        u.pm = fm + ((wgid % nig) % gsz); u.pn = (wgid % nig) / gsz; u.hf = (MODE != 0 && (u.pm % 17) == 16) ? 1 : 0; return true;
    }
    __device__ __forceinline__ unsigned arow(const Unit& u, int r) const { if (MODE == 1) return (unsigned)idx[u.pm * BM + r]; return (unsigned)(u.pm * BM + r); }
    __device__ __forceinline__ long bbase(const Unit& u, int K) const { long o = (long)u.pn * BM * K; if (MODE != 0) o += (long)(u.pm / 17) * bstride; return o; }
};

template <int MODE> struct OrderExp {
    static constexpr bool GATHER = (MODE == 1);
    int nN, G, c0; const int* idx; long bstride;
    __device__ __forceinline__ void init(int nN_, int G_, int c_, const int* idx_, long bstride_) { nN = nN_; G = G_; c0 = c_; idx = idx_; bstride = bstride_; }
    __device__ __forceinline__ bool next(int i0, Unit& u) const {
        const int v = i0 * G + c0, i = v >> 8, c = v & 255;
        const int x = c & 7, slot = c >> 3, per = 32 / nN, nfull = 256 / (8 * per);
        if (i > nfull) return false;
        if (i < nfull) { u.pn = slot / per; const int f = (i * 8 + x) * per + (slot % per); u.pm = (f >> 4) * 17 + (f & 15); u.hf = 0; return true; }
        if (i == nfull && slot < 2 * nN) { u.pn = slot >> 1; u.pm = (x * 2 + (slot & 1)) * 17 + 16; u.hf = 1; return true; }
        return false;
    }
    __device__ __forceinline__ unsigned arow(const Unit& u, int r) const { if (MODE == 1) return (unsigned)idx[u.pm * BM + r]; return (unsigned)(u.pm * BM + r); }
    __device__ __forceinline__ long bbase(const Unit& u, int K) const { return (long)u.pn * BM * K + (long)(u.pm / 17) * bstride; }
};

template <class Epi, class Sched>
__device__ __forceinline__ void gemm_phase(LAS unsigned char* lds, const Gemm g, const Sched& S, const Epi& E) {
    int tid = threadIdx.x; asm volatile("" : "+v"(tid));
    const int wid = __builtin_amdgcn_readfirstlane(tid >> 6), wr = wid >> 2, wc = wid & 3;
    const int K = g.K, nt = K / BK;
    unsigned voffB[2];
    { const int lane = tid & 63, fr = lane & 15, fq = lane >> 4; (void)fr; (void)fq; }
#pragma unroll
    for (int i = 0; i < 2; ++i) { int R, Cc; stage_rc(tid * 16 + i * 8192, R, Cc); voffB[i] = (unsigned)(R * K + Cc) * 2u; }
    const size_t kstep = (size_t)(BK * 2);
    const size_t hstep = (size_t)HALF * K * 2;
    const unsigned ldsw = (unsigned)wid * 1024u;
    const int aoff = lds_byte(wr * 64 + (tid & 15), ((tid & 63) >> 4) * 8), boff = lds_byte(wc * 32 + (tid & 15), ((tid & 63) >> 4) * 8);
#define PG8_SA(b, h) (((b) * 2 + (h)) * HTB)
#define PG8_SB(b, h) ((4 + (b) * 2 + (h)) * HTB)
#define PG8_STAGE(bufoff, gbase, voff) do { _Pragma("unroll") for (int _i = 0; _i < 2; ++_i) \
        __builtin_amdgcn_global_load_lds((const unsigned*)((const char*)(gbase) + (voff)[_i]), (LAS unsigned*)(lds + (bufoff) + ldsw + _i * 8192), 16, 0, 0); } while (0)
#define PG8_LDA(dst, b, h) do { _Pragma("unroll") for (int m = 0; m < 4; ++m) _Pragma("unroll") for (int k = 0; k < 2; ++k) dst[m][k] = *(const LAS bf16x8*)(lds + PG8_SA(b, h) + aoff + m * 2048 + k * 1024); } while (0)
#define PG8_LDB(dst, b, h) do { _Pragma("unroll") for (int n = 0; n < 2; ++n) _Pragma("unroll") for (int k = 0; k < 2; ++k) dst[n][k] = *(const LAS bf16x8*)(lds + PG8_SB(b, h) + boff + n * 2048 + k * 1024); } while (0)
#define PG8_MMA(ai, bj, At, Bt) do { __builtin_amdgcn_s_setprio(1); _Pragma("unroll") for (int m = 0; m < 4; ++m) _Pragma("unroll") for (int n = 0; n < 2; ++n) _Pragma("unroll") for (int k = 0; k < 2; ++k) \
        acc[ai][bj][m][n] = __builtin_amdgcn_mfma_f32_16x16x32_bf16(Bt[n][k], At[m][k], acc[ai][bj][m][n], 0, 0, 0); __builtin_amdgcn_s_setprio(0); } while (0)
#define PG8_WAIT_V(n) asm volatile("s_waitcnt vmcnt(" #n ")" ::: "memory")
#define PG8_WAIT_L(n) asm volatile("s_waitcnt lgkmcnt(" #n ")" ::: "memory")
#define PG8_BAR __builtin_amdgcn_s_barrier()
#define PG8_SCHED __builtin_amdgcn_sched_barrier(0)
#define PG8_ROWOFFS(dst, u, tq) do { _Pragma("unroll") for (int _i = 0; _i < 2; ++_i) { int _R, _C; stage_rc((tq) * 16 + _i * 8192, _R, _C); _Pragma("unroll") for (int _h = 0; _h < 2; ++_h) dst[_h][_i] = (S.arow(u, _h * HALF + _R) * (unsigned)K + (unsigned)_C) * 2u; } } while (0)
    Unit cur, nxt; int ui = 0;
    if (!S.next(0, cur)) return;
    float zf = 0.f; asm volatile("" : "+v"(zf));
    f32x4 acc[2][2][4][2];
#pragma unroll
    for (int a = 0; a < 2; ++a)
#pragma unroll
        for (int b = 0; b < 2; ++b)
#pragma unroll
            for (int m = 0; m < 4; ++m)
#pragma unroll
                for (int n = 0; n < 2; ++n) acc[a][b][m][n] = (f32x4){zf, zf, zf, zf};
    bf16x8 At[4][2], B0[2][2], B1[2][2];
    unsigned vcur[2][2];
    if constexpr (Sched::GATHER) { PG8_ROWOFFS(vcur, cur, tid); }
    const char* const Ab = (const char*)g.A;
    const char* cA = Sched::GATHER ? Ab : Ab + (size_t)(unsigned)__builtin_amdgcn_readfirstlane((int)S.arow(cur, 0)) * K * 2;
#define PG8_STAGEA(bufoff, ptr, h) do { if constexpr (Sched::GATHER) { PG8_STAGE(bufoff, ptr, vcur[h]); } else { PG8_STAGE(bufoff, (ptr) + (h) * hstep, voffB); } } while (0)
    const char* cB = (const char*)g.Bt + (size_t)S.bbase(cur, K) * 2;
    PG8_STAGE(PG8_SB(0, 0), cB, voffB); PG8_STAGE(PG8_SB(0, 1), cB + hstep, voffB); PG8_STAGEA(PG8_SA(0, 0), cA, 0); PG8_STAGEA(PG8_SA(0, 1), cA, 1);
    if (wr == 1) PG8_BAR;
    PG8_WAIT_V(2); PG8_BAR;
    PG8_STAGE(PG8_SB(1, 0), cB + kstep, voffB); PG8_STAGEA(PG8_SA(1, 0), cA + kstep, 0); PG8_STAGE(PG8_SB(1, 1), cB + hstep + kstep, voffB);
    PG8_WAIT_V(6); PG8_BAR;
    for (;;) {
        const bool has_next = S.next(ui + 1, nxt);
        const char* nB = has_next ? (const char*)g.Bt + (size_t)S.bbase(nxt, K) * 2 : cB;
        const char* nA = (Sched::GATHER || !has_next) ? cA : Ab + (size_t)(unsigned)__builtin_amdgcn_readfirstlane((int)S.arow(nxt, 0)) * K * 2;
#pragma unroll 1
        for (int t = 0; t < nt; t += 2) {
            const bool last = (t == nt - 2);
            const char* a1 = cA + (size_t)(t + 1) * kstep;
            const char* a2 = last ? nA : cA + (size_t)(t + 2) * kstep; const char* b2 = last ? nB : cB + (size_t)(t + 2) * kstep;
            const char* a3 = a2 + kstep; const char* b3 = b2 + kstep;
            PG8_LDB(B0, 0, 0); PG8_LDB(B1, 0, 1); PG8_SCHED; PG8_LDA(At, 0, 0); PG8_STAGEA(PG8_SA(1, 1), a1, 1);
            PG8_WAIT_V(8); PG8_WAIT_L(0); PG8_BAR; PG8_MMA(0, 0, At, B0); PG8_MMA(0, 1, At, B1); PG8_BAR; PG8_SCHED;
            if constexpr (Sched::GATHER) { if (last && has_next) { int tq = tid; asm volatile("" : "+v"(tq)); PG8_ROWOFFS(vcur, nxt, tq); } }
            PG8_LDA(At, 0, 1); PG8_STAGE(PG8_SB(0, 0), b2, voffB); PG8_STAGE(PG8_SB(0, 1), b2 + hstep, voffB); PG8_STAGEA(PG8_SA(0, 0), a2, 0);
            PG8_WAIT_V(8); PG8_WAIT_L(0); PG8_BAR; if (!cur.hf) { PG8_MMA(1, 0, At, B0); PG8_MMA(1, 1, At, B1); } PG8_BAR; PG8_SCHED;
            PG8_LDB(B0, 1, 0); PG8_LDB(B1, 1, 1); PG8_SCHED; PG8_LDA(At, 1, 0); PG8_STAGEA(PG8_SA(0, 1), a2, 1);
            PG8_WAIT_V(8); PG8_WAIT_L(0); PG8_BAR; PG8_MMA(0, 0, At, B0); PG8_MMA(0, 1, At, B1); PG8_BAR; PG8_SCHED;
            PG8_LDA(At, 1, 1); PG8_STAGE(PG8_SB(1, 0), b3, voffB); PG8_STAGE(PG8_SB(1, 1), b3 + hstep, voffB); PG8_STAGEA(PG8_SA(1, 0), a3, 0);
            PG8_WAIT_V(8); PG8_WAIT_L(0); PG8_BAR; if (!cur.hf) { PG8_MMA(1, 0, At, B0); PG8_MMA(1, 1, At, B1); } PG8_BAR; PG8_SCHED;
        }
        if (wr == 0) PG8_BAR;
        { int tz = tid; asm volatile("" : "+v"(tz)); const int ln = tz & 63; E(acc, cur, wr, wc, ln & 15, ln >> 4); }
        if (!has_next) break;
#pragma unroll
        for (int a = 0; a < 2; ++a)
#pragma unroll
            for (int b = 0; b < 2; ++b)
#pragma unroll
                for (int m = 0; m < 4; ++m)
#pragma unroll
                    for (int n = 0; n < 2; ++n) acc[a][b][m][n] = (f32x4){zf, zf, zf, zf};
        cur = nxt; cB = nB; cA = nA; ++ui;
        if (wr == 1) PG8_BAR;
    }
    PG8_WAIT_V(0);
    PG8_BAR;
#undef PG8_SA
#undef PG8_SB
#undef PG8_STAGE
#undef PG8_LDA
#undef PG8_LDB
#undef PG8_MMA
#undef PG8_WAIT_V
#undef PG8_WAIT_L
#undef PG8_BAR
#undef PG8_SCHED
#undef PG8_ROWOFFS
#undef PG8_STAGEA
}

#define EPI_LOOP for (int ai = 0; ai < 2; ++ai) for (int m = 0; m < 4; ++m) for (int bj = 0; bj < 2; ++bj) for (int n = 0; n < 2; ++n)
__device__ __forceinline__ int colw_of(int fq) { return (fq & 1) * 16 + (fq >> 1) * 8; }
__device__ __forceinline__ void st_pair_bf16(bf16_t* p  , f32x4 v0, f32x4 v1) {
    const unsigned a0 = pk2(v0[0], v0[1]), a1 = pk2(v0[2], v0[3]), b0 = pk2(v1[0], v1[1]), b1 = pk2(v1[2], v1[3]);
    const auto r0 = __builtin_amdgcn_permlane16_swap(a0, b0, false, false); const auto r1 = __builtin_amdgcn_permlane16_swap(a1, b1, false, false);
    u32x4 o; o.x = r0[0]; o.y = r1[0]; o.z = r0[1]; o.w = r1[1]; *(u32x4*)p = o;
}
__device__ __forceinline__ void ld_pair_bf16(const void* p, u32x2& n0, u32x2& n1) {
    const u32x4 w = *(const u32x4*)p;
    const auto r0 = __builtin_amdgcn_permlane16_swap(w.x, w.z, false, false); const auto r1 = __builtin_amdgcn_permlane16_swap(w.y, w.w, false, false);
    n0.x = r0[0]; n0.y = r1[0]; n1.x = r0[1]; n1.y = r1[1];
}
struct EpiBf16 {
    bf16_t* O; int ldc;
    __device__ __forceinline__ void operator()(const f32x4 (&acc)[2][2][4][2], const Unit& u, int wr, int wc, int fr, int fq) const {
        const int row0 = u.pm * BM + wr * 64 + fr, colg = u.pn * BM + wc * 32 + colw_of(fq);
#pragma unroll
        for (int ai = 0; ai < 2; ++ai)
#pragma unroll
            for (int m = 0; m < 4; ++m) { bf16_t* rowp = O + (size_t)(row0 + ai * HALF + m * 16) * ldc + colg;
#pragma unroll
                for (int bj = 0; bj < 2; ++bj) st_pair_bf16(rowp + bj * HALF, acc[ai][bj][m][0], acc[ai][bj][m][1]); }
    }
};
struct EpiOdd {
    bf16_t* P; bf16_t* Q; bf16_t* KA; const float* rope;
    __device__ __forceinline__ void operator()(const f32x4 (&acc)[2][2][4][2], const Unit& u, int wr, int wc, int fr, int fq) const {
        const int row0 = u.pm * BM + wr * 64 + fr, col0 = u.pn * BM + wc * 32 + 4 * fq;
        if (u.pn >= 6) {
#pragma unroll
            for (int ai = 0; ai < 2; ++ai)
#pragma unroll
                for (int m = 0; m < 4; ++m) { bf16_t* rowp = P + (size_t)(row0 + ai * HALF + m * 16) * P_LD + (col0 - 4 * fq + colw_of(fq));
#pragma unroll
                    for (int bj = 0; bj < 2; ++bj) st_pair_bf16(rowp + bj * HALF, acc[ai][bj][m][0], acc[ai][bj][m][1]); }
            return;
        }
        const bool isk = u.pn >= 3, isctx = u.pm >= NLAT / BM; const int axis = wc & 1;
        const int cq = col0 - (isk ? 768 : 0);
        f32x4 csr[2][4], snr[2][4];
#pragma unroll
        for (int ai = 0; ai < 2; ++ai)
#pragma unroll
            for (int m = 0; m < 4; ++m) { const int row = row0 + ai * HALF + m * 16; csr[ai][m] = (f32x4){1.f, 1.f, 1.f, 1.f}; snr[ai][m] = (f32x4){0.f, 0.f, 0.f, 0.f};
                if (!isctx) { const int t = row & (TT - 1); const int pos = axis ? 128 + (t & 63) : (t >> 6);
                    csr[ai][m] = *(const f32x4*)(rope + pos * 16 + 4 * fq); snr[ai][m] = *(const f32x4*)(rope + 192 * 16 + pos * 16 + 4 * fq); } }
#pragma unroll
        for (int ai = 0; ai < 2; ++ai)
#pragma unroll
            for (int m = 0; m < 4; ++m) { const int row = row0 + ai * HALF + m * 16;
                const f32x4 cs = csr[ai][m], sn = snr[ai][m]; size_t orow;
                if (!isctx) { const int t = row & (TT - 1); orow = isk ? (size_t)(row >> 13) * LKEYS + CTXL + t : (size_t)row; }
                else { const int rc = row - NLAT; orow = isk ? (size_t)(rc >> 8) * LKEYS + (rc & 255) : (size_t)row; }
                bf16_t* op = (isk ? KA : Q) + orow * 768 + cq; const float sc = isk ? 1.f : QSCALE;
#pragma unroll
                for (int bj = 0; bj < 2; ++bj) { const f32x4 x1 = acc[ai][bj][m][0], x2 = acc[ai][bj][m][1];
                    const f32x4 o1 = (x1 * cs - x2 * sn) * sc, o2 = (x1 * sn + x2 * cs) * sc;
                    st_pair_bf16(op + bj * HALF - 4 * fq + colw_of(fq), o1, o2); } }
    }
};
struct EpiRes {
    float* X; const float* modl; const float* xin; const float* cin;
    __device__ __forceinline__ void operator()(const f32x4 (&acc)[2][2][4][2], const Unit& u, int wr, int wc, int fr, int fq) const {
        const int row0 = u.pm * BM + wr * 64 + fr, col0 = u.pn * BM + wc * 32 + 4 * fq;
        const int mi = (u.pm * BM < NLAT) ? (u.pm * BM) / TT : 4;
        const float* gate = modl + mi * 6144 + 2 * DM;
        const float* rsrc = (u.pm * BM < NLAT) ? xin : cin - (size_t)NLAT * DM;
        f32x4 gv[2][2];
#pragma unroll
        for (int bj = 0; bj < 2; ++bj)
#pragma unroll
            for (int n = 0; n < 2; ++n) gv[bj][n] = *(const f32x4*)(gate + col0 + bj * HALF + n * 16);
#pragma unroll
        for (int ai = 0; ai < 2; ++ai) { f32x4 xr[4][2][2];
#pragma unroll
            for (int m = 0; m < 4; ++m) { const float* rowp = rsrc + (size_t)(row0 + ai * HALF + m * 16) * DM + col0;
#pragma unroll
                for (int bj = 0; bj < 2; ++bj)
#pragma unroll
                    for (int n = 0; n < 2; ++n) xr[m][bj][n] = *(const f32x4*)(rowp + bj * HALF + n * 16); }
#pragma unroll
            for (int m = 0; m < 4; ++m) { float* rowp = X + (size_t)(row0 + ai * HALF + m * 16) * DM + col0;
#pragma unroll
                for (int bj = 0; bj < 2; ++bj)
#pragma unroll
                    for (int n = 0; n < 2; ++n) *(f32x4*)(rowp + bj * HALF + n * 16) = xr[m][bj][n] * ALPHA_DN + gv[bj][n] * acc[ai][bj][m][n]; } }
    }
};
struct EpiSwiGLU {
    bf16_t* HID;
    __device__ __forceinline__ void operator()(const f32x4 (&acc)[2][2][4][2], const Unit& u, int wr, int wc, int fr, int fq) const {
        const int row0 = u.pm * BM + wr * 64 + fr, f0 = u.pn * HALF + wc * 32 + 4 * fq;
#pragma unroll
        for (int ai = 0; ai < 2; ++ai) if (ai == 0 || !u.hf)
#pragma unroll
            for (int m = 0; m < 4; ++m) { bf16_t* rowp = HID + (size_t)(row0 + ai * HALF + m * 16) * D_EXP + u.pn * HALF + wc * 32 + colw_of(fq); f32x4 hh[2];
#pragma unroll
                for (int n = 0; n < 2; ++n) { const f32x4 a = acc[ai][0][m][n], b = acc[ai][1][m][n];
#pragma unroll
                    for (int j = 0; j < 4; ++j) hh[n][j] = a[j] * __builtin_amdgcn_rcpf(1.f + __expf(-a[j])) * b[j]; }
                st_pair_bf16(rowp, hh[0], hh[1]); }
    }
};
struct EpiYE {
    bf16_t* YE; const float* gate;
    __device__ __forceinline__ void operator()(const f32x4 (&acc)[2][2][4][2], const Unit& u, int wr, int wc, int fr, int fq) const {
        const int row0 = u.pm * BM + wr * 64 + fr, col0 = u.pn * BM + wc * 32 + 4 * fq;
        float gts[2][4];
#pragma unroll
        for (int ai = 0; ai < 2; ++ai)
#pragma unroll
            for (int m = 0; m < 4; ++m) gts[ai][m] = gate[row0 + ai * HALF + m * 16];
#pragma unroll
        for (int ai = 0; ai < 2; ++ai) if (ai == 0 || !u.hf)
#pragma unroll
            for (int m = 0; m < 4; ++m) { const int row = row0 + ai * HALF + m * 16; const float gt = gts[ai][m]; bf16_t* rowp = YE + (size_t)row * DM + (col0 - 4 * fq + colw_of(fq));
#pragma unroll
                for (int bj = 0; bj < 2; ++bj) st_pair_bf16(rowp + bj * HALF, acc[ai][bj][m][0] * gt, acc[ai][bj][m][1] * gt); }
    }
};
struct EpiLora {
    unsigned char* SCN; bf16_t* G; const float* decay0; const float* a0; const float* kalpha;
    __device__ __forceinline__ void operator()(const f32x4 (&acc)[2][2][4][2], const Unit& u, int wr, int wc, int fr, int fq) const {
        const int row0 = u.pm * BM + wr * 64 + fr;
        const int seg = u.pn / 3, cb = (u.pn % 3) * BM + wc * 32 + 4 * fq, cw = colw_of(fq) - 4 * fq;
        f32x4 par0[2][2], par1[2][2];
#pragma unroll
        for (int bj = 0; bj < 2; ++bj)
#pragma unroll
            for (int n = 0; n < 2; ++n) { const int col = cb + bj * HALF + n * 16; par0[bj][n] = (f32x4){0.f, 0.f, 0.f, 0.f}; par1[bj][n] = par0[bj][n];
                if (seg < 2) par0[bj][n] = *(const f32x4*)(decay0 + seg * 768 + col);
                else if (seg < 4) { par0[bj][n] = *(const f32x4*)(a0 + (seg - 2) * 768 + col); par1[bj][n] = *(const f32x4*)(kalpha + col); } }
#pragma unroll
        for (int bj = 0; bj < 2; ++bj) {
            const int colA = cb + bj * HALF, head = colA >> 6, kx0 = colA & 63;
            if (seg < 2) {
#pragma unroll
                for (int n = 0; n < 2; ++n) { const f32x4 d0 = par0[bj][n]; const int kx = kx0 + n * 16;
#pragma unroll
                    for (int ai = 0; ai < 2; ++ai)
#pragma unroll
                        for (int m = 0; m < 4; ++m) { const int row = row0 + ai * HALF + m * 16; f32x4 w;
#pragma unroll
                            for (int j = 0; j < 4; ++j) { const float lw = -DECAY_SCALE * sigmoidf_(d0[j] + acc[ai][bj][m][n][j]); w[j] = CHUNKED_SCAN ? lw : __expf(lw); }
                            *(f32x4*)(SCN + (size_t)(row * 12 + head) * SC_REC + SC_W + seg * 256 + kx * 4) = w; __builtin_amdgcn_sched_barrier(0); } }
            } else if (seg < 4) {
                const int d = seg - 2;
#pragma unroll
                for (int ai = 0; ai < 2; ++ai) {
                    u32x2 kkr[2][4], ksr[2][4];
                    u32x4 wk[4], ws_[4];
#pragma unroll
                    for (int m = 0; m < 4; ++m) { const unsigned char* base = SCN + (size_t)((row0 + ai * HALF + m * 16) * 12 + head) * SC_REC + (kx0 + cw) * 2;
                        wk[m] = *(const u32x4*)(base + SC_KK); ws_[m] = *(const u32x4*)(base + SC_KR + 256 * d); }
#pragma unroll
                    for (int m = 0; m < 4; ++m) {
                        { const auto r0 = __builtin_amdgcn_permlane16_swap(wk[m].x, wk[m].z, false, false); const auto r1 = __builtin_amdgcn_permlane16_swap(wk[m].y, wk[m].w, false, false);
                          kkr[0][m].x = r0[0]; kkr[0][m].y = r1[0]; kkr[1][m].x = r0[1]; kkr[1][m].y = r1[1]; }
                        { const auto r0 = __builtin_amdgcn_permlane16_swap(ws_[m].x, ws_[m].z, false, false); const auto r1 = __builtin_amdgcn_permlane16_swap(ws_[m].y, ws_[m].w, false, false);
                          ksr[0][m].x = r0[0]; ksr[0][m].y = r1[0]; ksr[1][m].x = r0[1]; ksr[1][m].y = r1[1]; } }
#pragma unroll
                    for (int m = 0; m < 4; ++m) { const int row = row0 + ai * HALF + m * 16; unsigned char* base = SCN + (size_t)(row * 12 + head) * SC_REC + (kx0 + cw) * 2; f32x4 bb[2], kr[2];
#pragma unroll
                        for (int n = 0; n < 2; ++n) { const f32x4 a00 = par0[bj][n], kal = par1[bj][n];
                            const f32x4 kk = {bflo(kkr[n][m].x), bfhi(kkr[n][m].x), bflo(kkr[n][m].y), bfhi(kkr[n][m].y)}; const f32x4 ks = {bflo(ksr[n][m].x), bfhi(ksr[n][m].x), bflo(ksr[n][m].y), bfhi(ksr[n][m].y)};
#pragma unroll
                            for (int j = 0; j < 4; ++j) { const float a = sigmoidf_(a00[j] + acc[ai][bj][m][n][j]); bb[n][j] = kk[j] * a; kr[n][j] = ks[j] * (1.f + (a - 1.f) * kal[j]); } }
                        st_pair_bf16((bf16_t*)(base + SC_B + 256 * d), bb[0], bb[1]); st_pair_bf16((bf16_t*)(base + SC_KR + 256 * d), kr[0], kr[1]); __builtin_amdgcn_sched_barrier(0); } }
            } else {
#pragma unroll
                for (int ai = 0; ai < 2; ++ai)
#pragma unroll
                    for (int m = 0; m < 4; ++m) { const int row = row0 + ai * HALF + m * 16; st_pair_bf16(G + (size_t)row * 768 + colA + cw, acc[ai][bj][m][0], acc[ai][bj][m][1]); }
            }
        }
    }
};
}

struct Args { const float* in[37]; float* out; unsigned char* ws; int lo, hi; };
enum { I_X = 0, I_C, I_CTX, I_CCTX, I_WMOD, I_BMOD, I_LNG, I_LNB, I_EWIN, I_EWOUT, I_CONVW, I_MU, I_DUP, I_D0, I_AUP, I_A0, I_GUP, I_KXI, I_KAL, I_RBON, I_GNG, I_GNB,
       I_OWIN, I_OWOUT, I_LQ1, I_LK1, I_LQ2, I_LK2, I_SUBG, I_GLNG, I_GLNB, I_GWS, I_GBS, I_WR, I_WE1, I_WE3, I_WE2 };

struct Ctx {
    LAS unsigned char* lds;
    int tid, lane, wave, G, vcu, gw, NGW;
};
__device__ __forceinline__ void mkctx(Ctx& C, LAS unsigned char* lds) {
    int tid = threadIdx.x; asm volatile("" : "+v"(tid));
    C.lds = lds; C.tid = tid; C.lane = tid & 63; C.wave = __builtin_amdgcn_readfirstlane(tid >> 6);
    C.G = gridDim.x; { const int bx = blockIdx.x; C.vcu = (C.G % 8 == 0) ? (bx % 8) * (C.G / 8) + bx / 8 : bx; }
    C.gw = blockIdx.x * NWAVES + C.wave; C.NGW = C.G * NWAVES;
}
#define GLOBAL_PTR(T, v) ((T*)(__attribute__((address_space(1))) T*)(v))
__device__ __forceinline__ void ldargs(Args& A, LAS unsigned char* lds) {
    LAS const u32x2* tb = (LAS const u32x2*)(lds + LDS_PTAB); asm volatile("" : "+v"(tb));
#pragma unroll
    for (int i = 0; i < 37; ++i) { const u32x2 v = tb[i]; A.in[i] = GLOBAL_PTR(const float, ((unsigned long long)(unsigned)__builtin_amdgcn_readfirstlane((int)v.y) << 32) | (unsigned)__builtin_amdgcn_readfirstlane((int)v.x)); }
    { const u32x2 v = tb[37]; A.out = GLOBAL_PTR(float, ((unsigned long long)(unsigned)__builtin_amdgcn_readfirstlane((int)v.y) << 32) | (unsigned)__builtin_amdgcn_readfirstlane((int)v.x)); }
    { const u32x2 v = tb[38]; A.ws = GLOBAL_PTR(unsigned char, ((unsigned long long)(unsigned)__builtin_amdgcn_readfirstlane((int)v.y) << 32) | (unsigned)__builtin_amdgcn_readfirstlane((int)v.x)); }
    A.lo = 0; A.hi = 0;
}
__device__ __forceinline__ int row_mi(int row) { return row < NLAT ? (row >> 13) : 4; }

__device__ __forceinline__ void phase_init(const Ctx& C, const Args& A) {
    unsigned char* ws = A.ws;
    float* MOD = (float*)(ws + WS_MOD);
    LAS float* sv = (LAS float*)C.lds;
    LAS float* red = sv + 5 * 1024;
    for (int i = C.tid; i < 5 * 1024; i += NTHR) { const int v = i >> 10, k = i & 1023; const float c = (v < 4) ? A.in[I_C][v * DM + k] : A.in[I_CCTX][k]; sv[i] = c / (1.f + __expf(-c)); }
    __syncthreads();
    const int j = C.tid & 127, kp = C.tid >> 7;
    for (int it = blockIdx.x; it < DEPTH * 48; it += C.G) {
        const int l = it / 48, cg = it % 48, col = cg * 128 + j;
        const float* W = A.in[I_WMOD] + (size_t)l * DM * 6144 + col;
        float a0 = 0.f, a1 = 0.f, a2 = 0.f, a3 = 0.f, a4 = 0.f;
#pragma unroll 32
        for (int k = kp * 256; k < kp * 256 + 256; ++k) { const float w = W[(size_t)k * 6144];     a0 += sv[k] * w; a1 += sv[1024 + k] * w; a2 += sv[2048 + k] * w; a3 += sv[3072 + k] * w; a4 += sv[4096 + k] * w; }
        red[(kp * 5 + 0) * 128 + j] = a0; red[(kp * 5 + 1) * 128 + j] = a1; red[(kp * 5 + 2) * 128 + j] = a2; red[(kp * 5 + 3) * 128 + j] = a3; red[(kp * 5 + 4) * 128 + j] = a4;
        __syncthreads();
        for (int o = C.tid; o < 5 * 128; o += NTHR) { const int v = o >> 7, jj = o & 127; const int cc = cg * 128 + jj;
            const float s = red[(0 * 5 + v) * 128 + jj] + red[(1 * 5 + v) * 128 + jj] + red[(2 * 5 + v) * 128 + jj] + red[(3 * 5 + v) * 128 + jj];
            MOD[((size_t)l * 5 + v) * 6144 + cc] = s + A.in[I_BMOD][l * 6144 + cc]; }
        __syncthreads();
    }
    if (blockIdx.x == C.G - 1) { float* rope = (float*)(ws + WS_ROPE);
        for (int i = C.tid; i < 192 * 16; i += NTHR) { const int pos = i >> 4, j = i & 15; const float ang = (float)(pos < 128 ? pos : pos - 128) * powf(10000.f, -(float)j * (1.f / 16.f));
            rope[i] = cosf(ang); rope[192 * 16 + i] = sinf(ang); } }
}

__device__ __forceinline__ void transpose_item(const float* W, int ldw, int k0, int n0, bf16_t* WT, int ldt, int drow0, LAS float* scr, int lane) {
    { float v[64]; const float* src = W + (size_t)k0 * ldw + n0 + lane;
#pragma unroll
      for (int k = 0; k < 64; ++k) v[k] = __builtin_nontemporal_load(src + (size_t)k * ldw);
#pragma unroll
      for (int k = 0; k < 64; ++k) scr[k * 65 + lane] = v[k]; }
    asm volatile("s_waitcnt lgkmcnt(0)" ::: "memory");
    const int c = lane & 7;
#pragma unroll
    for (int j = 0; j < 8; ++j) { const int n = (lane >> 3) + 8 * j; const LAS float* s = scr + (8 * c) * 65 + n;
        u32x4 o; o.x = pk2(s[0 * 65], s[1 * 65]); o.y = pk2(s[2 * 65], s[3 * 65]); o.z = pk2(s[4 * 65], s[5 * 65]); o.w = pk2(s[6 * 65], s[7 * 65]);
        *(u32x4*)(WT + (size_t)(drow0 + n) * ldt + k0 + 8 * c) = o; }
    asm volatile("s_waitcnt lgkmcnt(0)" ::: "memory");
}
constexpr int XW_IN_HI = 3200, XW_OUT_HI = 7040, XW_TK_HI = 9088;
constexpr int YW_IN_HI = 1344, YW_OF_HI = 6144, YW_OUT_HI = 9984, YW_TK_HI = 12032;
__device__ __forceinline__ void conv_items(const Ctx& C, const Args& A, int l, int gw, int NGW, bool do_in, bool do_out, bool do_exp, int lo = 0, int hi = 1 << 30) {
    unsigned char* ws = A.ws;
    const int i2 = l >> 1; const bool odd = (l & 1);
    LAS float* scr = (LAS float*)C.lds + C.wave * (64 * 65);
    bf16_t* WIN = (bf16_t*)(ws + WS_WIN); bf16_t* WOUT = (bf16_t*)(ws + WS_WOUT); bf16_t* WE13 = (bf16_t*)(ws + WS_WE13 + (size_t)(l & 1) * WE13_BYTES); bf16_t* WE2 = (bf16_t*)(ws + WS_WE2 + (size_t)(l & 1) * WE2_BYTES);
    const int nin = odd ? D_IN_ODD : D_IN_EVEN;
    const float* win = odd ? A.in[I_OWIN] + (size_t)i2 * DM * D_IN_ODD : A.in[I_EWIN] + (size_t)i2 * DM * D_IN_EVEN;
    const float* wout = odd ? A.in[I_OWOUT] + (size_t)i2 * DM * DM : A.in[I_EWOUT] + (size_t)i2 * DM * DM;
    const int n_in = do_in ? 16 * (nin / 64) : 0, n_out = do_out ? 16 * 16 : 0, n_e13 = do_exp ? NEXP * 2 * 16 * 32 : 0, n_e2 = do_exp ? NEXP * 32 * 16 : 0;
    const int total = (n_in + n_out + n_e13 + n_e2) < hi ? (n_in + n_out + n_e13 + n_e2) : hi;
    for (int it = lo + gw; it < total; it += NGW) {
        int r = it;
        if (r < n_in) { const int nb = nin / 64, kb = r / nb, nn = r % nb; transpose_item(win, nin, kb * 64, nn * 64, WIN, DM, nn * 64, scr, C.lane); continue; } r -= n_in;
        if (r < n_out) { const int kb = r / 16, nn = r % 16; transpose_item(wout, DM, kb * 64, nn * 64, WOUT, DM, nn * 64, scr, C.lane); continue; } r -= n_out;
        if (r < n_e13) { const int e = r / 1024, q = r % 1024, mat = q / 512, q2 = q % 512, kb = q2 / 32, nn = q2 % 32;
            const float* W = (mat ? A.in[I_WE3] : A.in[I_WE1]) + ((size_t)l * NEXP + e) * DM * D_EXP;
            const int f0 = nn * 64; const int drow = (f0 >> 7) * 256 + mat * 128 + (f0 & 127);
            transpose_item(W, D_EXP, kb * 64, f0, WE13 + (size_t)e * 4096 * DM, DM, drow, scr, C.lane); continue; } r -= n_e13;
        { const int e = r / 512, q = r % 512, kb = q / 16, nn = q % 16;
            const float* W = A.in[I_WE2] + ((size_t)l * NEXP + e) * D_EXP * DM;
            transpose_item(W, DM, kb * 64, nn * 64, WE2 + (size_t)e * DM * D_EXP, D_EXP, nn * 64, scr, C.lane); }
    }
}
__device__ __forceinline__ void phase_conv(const Ctx& C, const Args& A, int l) {
    unsigned char* ws = A.ws;
    const int i2 = l >> 1; const bool odd = (l & 1);
    bf16_t* WIN = (bf16_t*)(ws + WS_WIN);
    const bool early = CHUNKED_SCAN && odd;
    if (l > 0) { if (early || !CHUNKED_SCAN) conv_items(C, A, l, C.gw, C.NGW, !early, true, !early);
                 else { conv_items(C, A, l, C.gw, C.NGW, true, true, false); conv_items(C, A, l, C.gw, C.NGW, false, false, true, YW_TK_HI); } }
    if (!odd) {
        u32x4* z = (u32x4*)(WIN + (size_t)D_IN_EVEN * DM);
        unsigned zz = 0u; asm volatile("" : "+v"(zz));
        for (int i = blockIdx.x * NTHR + C.tid; i < (D_IN_EVEN_PAD - D_IN_EVEN) * DM / 8; i += C.G * NTHR) z[i] = (u32x4){zz, zz, zz, zz};
        bf16_t* WL = (bf16_t*)(ws + WS_WLORA);
        const float* dup = A.in[I_DUP] + (size_t)i2 * 2 * 64 * 768; const float* aup = A.in[I_AUP] + (size_t)i2 * 2 * 64 * 768; const float* gup = A.in[I_GUP] + (size_t)i2 * 128 * 768;
        for (int i = blockIdx.x * NTHR + C.tid; i < LORA_N * LORA_K; i += C.G * NTHR) {
            const int kk = i / LORA_N, n = i % LORA_N, seg = n / 768, col = n % 768; float v = 0.f;
            if (seg == 0) { if (kk < 64) v = dup[(size_t)(0 * 64 + kk) * 768 + col]; }
            else if (seg == 1) { if (kk >= 64 && kk < 128) v = dup[(size_t)(1 * 64 + kk - 64) * 768 + col]; }
            else if (seg == 2) { if (kk >= 128 && kk < 192) v = aup[(size_t)(0 * 64 + kk - 128) * 768 + col]; }
            else if (seg == 3) { if (kk >= 192 && kk < 256) v = aup[(size_t)(1 * 64 + kk - 192) * 768 + col]; }
            else { if (kk >= 256) v = gup[(size_t)(kk - 256) * 768 + col]; }
            WL[(size_t)n * LORA_K + kk] = (bf16_t)f2bf(v);
        }
    }
}

__device__ __forceinline__ void phase_modh(const Ctx& C, const Args& A, int l) {
    bf16_t* H = (bf16_t*)(A.ws + WS_H); const float* MOD = (const float*)(A.ws + WS_MOD) + (size_t)l * 5 * 6144;
    const float* xin = A.in[I_X]; const float* cin = A.in[I_CTX] - (size_t)NLAT * DM;
#define MODH_SRC(row_) (((row_) < NLAT ? xin : cin) + (size_t)(row_) * DM)
    const int row0 = (int)(((long)C.gw * MROWS) / C.NGW), row1 = (int)(((long)(C.gw + 1) * MROWS) / C.NGW);
    f32x4 shr[4], scr_[4], xn[4]; int cmi = -1;
    if (row0 < row1) {
#pragma unroll
        for (int j = 0; j < 4; ++j) xn[j] = *(const f32x4*)(MODH_SRC(row0) + 4 * C.lane + 256 * j); }
#pragma unroll
    for (int j = 0; j < 4; ++j) { shr[j] = (f32x4){0.f, 0.f, 0.f, 0.f}; scr_[j] = shr[j]; }
    for (int row = row0; row < row1; ++row) {
        const int mi = row_mi(row);
        if (mi != cmi) { cmi = mi; const float* md = MOD + mi * 6144;
#pragma unroll
            for (int j = 0; j < 4; ++j) { const int col = 4 * C.lane + 256 * j; shr[j] = *(const f32x4*)(md + col); scr_[j] = *(const f32x4*)(md + DM + col) + 1.f; } }
        f32x4 x[4];
#pragma unroll
        for (int j = 0; j < 4; ++j) x[j] = xn[j];
        if (row + 1 < row1) {
#pragma unroll
            for (int j = 0; j < 4; ++j) xn[j] = *(const f32x4*)(MODH_SRC(row + 1) + 4 * C.lane + 256 * j); }
#pragma unroll
        for (int j = 0; j < 4; ++j) { const int col = 4 * C.lane + 256 * j; const f32x4 h = x[j] * scr_[j] + shr[j]; u32x2 o; o.x = pk2(h[0], h[1]); o.y = pk2(h[2], h[3]); *(u32x2*)(H + (size_t)row * DM + col) = o; }
    }
}

__device__ __forceinline__ f32x4 ld4bf(const bf16_t* p) { const u32x2 u = *(const u32x2*)p; return (f32x4){bflo(u.x), bfhi(u.x), bflo(u.y), bfhi(u.y)}; }
__device__ __forceinline__ void st4bf(bf16_t* p, f32x4 v) { u32x2 o; o.x = pk2(v[0], v[1]); o.y = pk2(v[2], v[3]); *(u32x2*)p = o; }
__device__ __forceinline__ void seq_info(int row, bool& hasp, bool& hasn) {
    if (row < NLAT) { const int t = row & (TT - 1); hasp = t > 0; hasn = t < TT - 1; }
    else { const int t = (row - NLAT) & (CTXL - 1); hasp = t > 0; hasn = t < CTXL - 1; }
}
struct Ef1Row { u32x2 bg, ua, ub, m[11]; };
__device__ __forceinline__ f32x4 bf4(u32x2 u) { return (f32x4){bflo(u.x), bfhi(u.x), bflo(u.y), bfhi(u.y)}; }
__device__ __forceinline__ void ef1_load(Ef1Row& R, const bf16_t* P, int row, int lane) {
    row = row < 0 ? 0 : row > MROWS - 1 ? MROWS - 1 : row;
    const bf16_t* p = P + (size_t)row * P_LD + 4 * lane;
    R.bg = *(const u32x2*)p; R.ua = *(const u32x2*)(p + 256); R.ub = *(const u32x2*)(p + 512);
#pragma unroll
    for (int it = 0; it < 11; ++it) R.m[it] = *(const u32x2*)(p + 768 + it * 256);
}
__device__ __forceinline__ void phase_ef1(const Ctx& C, const Args& A, int l) {
    const int i2 = l >> 1; unsigned char* ws = A.ws;
    const bf16_t* P = (const bf16_t*)(ws + WS_P); bf16_t* A2 = (bf16_t*)(ws + WS_A2); unsigned char* SCN = ws + WS_SCN; bf16_t* LIN = (bf16_t*)(ws + WS_LIN);
    const float* cw = A.in[I_CONVW] + (size_t)i2 * 3 * 256; const float* mu = A.in[I_MU] + (size_t)i2 * RWKV_COLS; const float* kxi = A.in[I_KXI] + (size_t)i2 * 768;
    const int j4 = 4 * C.lane;
    const f32x4 w0 = *(const f32x4*)(cw + j4), w1 = *(const f32x4*)(cw + 256 + j4), w2 = *(const f32x4*)(cw + 512 + j4);
    f32x4 mur[11], kxr[3];
#pragma unroll
    for (int it = 0; it < 11; ++it) mur[it] = (it * 256 + j4 < RWKV_COLS) ? *(const f32x4*)(mu + it * 256 + j4) : (f32x4){0.f, 0.f, 0.f, 0.f};
#pragma unroll
    for (int it = 0; it < 3; ++it) kxr[it] = *(const f32x4*)(kxi + it * 256 + j4);
    const int row0 = (int)(((long)C.gw * MROWS) / C.NGW), row1 = (int)(((long)(C.gw + 1) * MROWS) / C.NGW);
    Ef1Row Ra, Rb, Rc, Rd;
    ef1_load(Ra, P, row0 - 1, C.lane); ef1_load(Rb, P, row0, C.lane); ef1_load(Rc, P, row0 + 1, C.lane);
    for (int row = row0; row < row1; ++row) {
        ef1_load(Rd, P, row + 2, C.lane);
        bool hasp, hasn; seq_info(row, hasp, hasn);
        const float fp = hasp ? 1.f : 0.f, fn = hasn ? 1.f : 0.f;
        {
            const f32x4 bg = bf4(Rb.bg), u0 = bf4(Rb.ua) * bf4(Rb.ub), um = bf4(Ra.ua) * bf4(Ra.ub) * fp, up = bf4(Rc.ua) * bf4(Rc.ub) * fn;
            st4bf(A2 + (size_t)row * DM + j4, bg * (w0 * um + w1 * u0 + w2 * up));
        }
#pragma unroll
        for (int it = 0; it < 11; ++it) {
            const int c = it * 256 + j4;
            if (c < RWKV_COLS) {
                const f32x4 x0 = bf4(Rb.m[it]), xm = bf4(Ra.m[it]) * fp, xp = bf4(Rc.m[it]) * fn, m4 = mur[it];
                const f32x4 ps = x0 + m4 * ((xm + xp) * 0.5f - x0);
                if (it < 3) { const int head = c >> 6, kx = c & 63; st4bf_(SCN + (size_t)(row * 12 + head) * SC_REC + SC_R + kx * 2, ps); }
                else if (it < 6) { const int c1 = c - 768, head = c1 >> 6, kx = c1 & 63; const f32x4 kv = ps * kxr[it < 6 ? (it >= 3 ? it - 3 : 0) : 0];
                    const float ss = sum16(kv[0] * kv[0] + kv[1] * kv[1] + kv[2] * kv[2] + kv[3] * kv[3]); const float rn = rsqrtf(ss + 1e-12f);
                    unsigned char* base = SCN + (size_t)(row * 12 + head) * SC_REC + kx * 2;
                    st4bf_(base + SC_KK, kv * rn); st4bf_(base + SC_KR, ps); st4bf_(base + SC_KR + 256, ps); }
                else if (it < 9) { const int c1 = c - 1536, head = c1 >> 6, kx = c1 & 63; st4bf_(SCN + (size_t)(row * 12 + head) * SC_REC + SC_V + kx * 2, ps); }
                else { const int c1 = c - 2304; f32x4 o;
                    if (c1 < 128) { o = (f32x4){tanh_fast(ps[0]), tanh_fast(ps[1]), tanh_fast(ps[2]), tanh_fast(ps[3])}; }
                    else if (c1 < 256) { o = ps; }
                    else { o = (f32x4){sigmoidf_(ps[0]), sigmoidf_(ps[1]), sigmoidf_(ps[2]), sigmoidf_(ps[3])}; }
                    st4bf(LIN + (size_t)row * LORA_K + c1, o); }
            }
        }
        Ra = Rb; Rb = Rc; Rc = Rd;
    }
}

__device__ __forceinline__ int scan_row(int i, int b, int d) {
    if (d == 0) return i < CTXL ? NLAT + b * CTXL + i : b * TT + (i - CTXL);
    return i < CTXL ? NLAT + b * CTXL + (CTXL - 1 - i) : b * TT + (TT - 1 - (i - CTXL));
}
__device__ __forceinline__ float red8(float v) {
    v += __uint_as_float((unsigned)__builtin_amdgcn_update_dpp(0, (int)__float_as_uint(v), 0xB1, 0xF, 0xF, true));
    v += __uint_as_float((unsigned)__builtin_amdgcn_update_dpp(0, (int)__float_as_uint(v), 0x4E, 0xF, 0xF, true));
    v += __uint_as_float((unsigned)__builtin_amdgcn_update_dpp(0, (int)__float_as_uint(v), 0x141, 0xF, 0xF, true));
    return v;
}
__device__ __forceinline__ float red16(float v) {
    v += __uint_as_float((unsigned)__builtin_amdgcn_update_dpp(0, (int)__float_as_uint(v), 0xB1, 0xF, 0xF, true));
    v += __uint_as_float((unsigned)__builtin_amdgcn_update_dpp(0, (int)__float_as_uint(v), 0x4E, 0xF, 0xF, true));
    v += __uint_as_float((unsigned)__builtin_amdgcn_update_dpp(0, (int)__float_as_uint(v), 0x141, 0xF, 0xF, true));
    v += __uint_as_float((unsigned)__builtin_amdgcn_update_dpp(0, (int)__float_as_uint(v), 0x140, 0xF, 0xF, true));
    return v;
}
__device__ __forceinline__ void phase_scan(const Ctx& C, const Args& A) {
    for (int u = blockIdx.x; u < 192; u += C.G) {
    const int half = u & 1, d = (u >> 1) & 1, h = (u >> 2) % 12, b = u / 48;
    const unsigned char* SCN = A.ws + WS_SCN; float* Y = (float*)(A.ws + WS_Y) + (size_t)d * MROWS * 768;
    LAS float* buf = (LAS float*)C.lds; LAS float* ybuf = buf + 2 * 32 * 352;
    constexpr int NCH = LKEYS / 32;
    u32x4 st[4];
    int ps_[4], psrc[4], pdst[4]; bool pf32[4];
#pragma unroll
    for (int j = 0; j < 4; ++j) { const int p = C.tid + NTHR * j; const int s = p / 52, q = p % 52; ps_[j] = s;
        if (q < 16) { psrc[j] = SC_W + 256 * d + q * 16; pdst[j] = s * 352 + q * 4; pf32[j] = true; }
        else if (q < 48) { const int vec = (q - 16) >> 3, part = (q - 16) & 7; const int so = vec == 0 ? SC_KK : vec == 1 ? SC_B + 256 * d : vec == 2 ? SC_KR + 256 * d : SC_R;
            psrc[j] = so + part * 16; pdst[j] = s * 352 + 64 * (vec + 1) + part * 8; pf32[j] = false; }
        else { const int part = q - 48; psrc[j] = SC_V + half * 64 + part * 16; pdst[j] = s * 352 + 320 + part * 8; pf32[j] = false; } }
    const int sgn = d ? -1 : 1;
    const unsigned char* SCNh = SCN + (size_t)h * SC_REC;
#define SCAN_ROW0(c) (((c) * 32 < CTXL) ? (NLAT + b * CTXL + (d ? CTXL - 1 - (c) * 32 : (c) * 32)) : (b * TT + (d ? TT - 1 - ((c) * 32 - CTXL) : (c) * 32 - CTXL)))
#define SCAN_LOADG(c) do { const int row0_ = SCAN_ROW0(c); _Pragma("unroll") for (int j = 0; j < 4; ++j) if (j < 3 || C.tid < 1664 - 3 * NTHR) { \
        st[j] = *(const u32x4*)(SCNh + (size_t)(row0_ + sgn * ps_[j]) * SC_ROW + psrc[j]); } } while (0)
#define SCAN_STORE(bi) do { _Pragma("unroll") for (int j = 0; j < 4; ++j) if (j < 3 || C.tid < 1664 - 3 * NTHR) { LAS float* dp = buf + (bi) * (32 * 352) + pdst[j]; \
        if (pf32[j]) *(LAS u32x4*)dp = st[j]; \
        else { *(LAS f32x4*)dp = (f32x4){bflo(st[j].x), bfhi(st[j].x), bflo(st[j].y), bfhi(st[j].y)}; *(LAS f32x4*)(dp + 4) = (f32x4){bflo(st[j].z), bfhi(st[j].z), bflo(st[j].w), bfhi(st[j].w)}; } } } while (0)
    SCAN_LOADG(0); SCAN_STORE(0); __syncthreads();
    f32x2 Sa = {0.f, 0.f}, Sb = {0.f, 0.f};
    const int rl = C.lane >> 4, ks = C.lane & 15;
    float ycol = 0.f;
#define SC_LD(R, s) do { const LAS float* bp_ = cur + (s) * 352 + ks * 4; \
        R##w = *(const LAS f32x4*)(bp_); R##k = *(const LAS f32x4*)(bp_ + 64); R##b = *(const LAS f32x4*)(bp_ + 128); R##q = *(const LAS f32x4*)(bp_ + 192); R##r = *(const LAS f32x4*)(bp_ + 256); \
        R##vv = cur[(s) * 352 + 320 + C.wave * 4 + rl]; } while (0)
#define SC_LO(v) ((f32x2){v[0], v[1]})
#define SC_HI(v) ((f32x2){v[2], v[3]})
#define SC_DPP(x, ctrl) __uint_as_float((unsigned)__builtin_amdgcn_update_dpp(0, (int)__float_as_uint(x), ctrl, 0xF, 0xF, true))
#define SC_STEP(R, P, s) do { \
        f32x2 pa = __builtin_elementwise_fma(Sb, SC_HI(R##k), Sa * SC_LO(R##k)), py = __builtin_elementwise_fma(Sb, SC_HI(P##r), Sa * SC_LO(P##r)); \
        float a_ = pa.x + pa.y, y_ = py.x + py.y; \
        a_ += SC_DPP(a_, 0xB1); y_ += SC_DPP(y_, 0xB1); a_ += SC_DPP(a_, 0x4E); y_ += SC_DPP(y_, 0x4E); \
        a_ += SC_DPP(a_, 0x141); y_ += SC_DPP(y_, 0x141); a_ += SC_DPP(a_, 0x140); y_ += SC_DPP(y_, 0x140); \
        ycol = (ks == ((s) & 15)) ? y_ : ycol; \
        const f32x2 na = {-a_, -a_}, vv2 = {R##vv, R##vv}; \
        Sa = __builtin_elementwise_fma(Sa, SC_LO(R##w), __builtin_elementwise_fma(na, SC_LO(R##b), vv2 * SC_LO(R##q))); \
        Sb = __builtin_elementwise_fma(Sb, SC_HI(R##w), __builtin_elementwise_fma(na, SC_HI(R##b), vv2 * SC_HI(R##q))); } while (0)
    f32x4 Aw, Ak, Ab, Aq, Ar, Bw, Bk, Bb, Bq, Br, Cw, Ck, Cb, Cq, Cr, Dw, Dk, Db, Dq, Dr; float Avv, Bvv, Cvv, Dvv;
    Dr = (f32x4){0.f, 0.f, 0.f, 0.f};
    for (int c = 0; c < NCH; ++c) {
        if (c + 1 < NCH) SCAN_LOADG(c + 1);
        {
            const LAS float* cur = buf + (c & 1) * (32 * 352);
            LAS float* yb = ybuf + (c & 1) * 1024 + C.wave * 4 + rl + ks * 32;
            SC_LD(A, 0); SC_LD(B, 1);
#pragma unroll 1
            for (int s = 0; s < 32; s += 4) {
                SC_LD(C, s + 2); __builtin_amdgcn_sched_barrier(0); SC_STEP(A, D, s); __builtin_amdgcn_sched_barrier(0);
                SC_LD(D, s + 3); __builtin_amdgcn_sched_barrier(0); SC_STEP(B, A, s + 1); __builtin_amdgcn_sched_barrier(0);
                SC_LD(A, s + 4); __builtin_amdgcn_sched_barrier(0); SC_STEP(C, B, s + 2); __builtin_amdgcn_sched_barrier(0);
                SC_LD(B, s + 5); __builtin_amdgcn_sched_barrier(0); SC_STEP(D, C, s + 3); __builtin_amdgcn_sched_barrier(0);
                if ((s & 15) == 12) yb[(s & 16) * 32] = ycol;
            }
        }
        if (c + 1 < NCH) SCAN_STORE((c + 1) & 1);
        __syncthreads();
        { const int row0_ = SCAN_ROW0(c);
#pragma unroll
          for (int i = 0; i < 2; ++i) { const int e = C.tid + NTHR * i, s = e >> 5, r = e & 31;
            const int row = (s > 0) ? row0_ + sgn * (s - 1) : scan_row(c * 32 - 1, b, d);
            if (s > 0 || c > 0) Y[(size_t)row * 768 + h * 64 + half * 32 + r] = ybuf[(c & 1) * 1024 + e]; } }
    }
    {
        f32x2 py = __builtin_elementwise_fma(Sb, SC_HI(Dr), Sa * SC_LO(Dr)); float y_ = py.x + py.y;
        y_ += SC_DPP(y_, 0xB1); y_ += SC_DPP(y_, 0x4E); y_ += SC_DPP(y_, 0x141); y_ += SC_DPP(y_, 0x140);
        if (ks == 0) Y[(size_t)scan_row(LKEYS - 1, b, d) * 768 + h * 64 + half * 32 + C.wave * 4 + rl] = y_;
    }
    __syncthreads();
    }
#undef SCAN_LOADG
#undef SCAN_STORE
#undef SCAN_ROW0
#undef SC_LD
#undef SC_STEP
#undef SC_LO
#undef SC_HI
#undef SC_DPP
}

constexpr int CSP = 72;
constexpr int CS_MAT = 64 * CSP * 2;
constexpr int CS_WT = 0, CS_KB = CS_MAT, CS_BB = 2 * CS_MAT, CS_RT = 3 * CS_MAT, CS_BHT = 4 * CS_MAT, CS_KHT = 5 * CS_MAT, CS_VMT = 6 * CS_MAT;
constexpr int CS_M2F = 7 * CS_MAT;
constexpr int CS_M1T = CS_M2F + 16384;
constexpr int CS_N2 = CS_M1T + CS_MAT;
constexpr int CS_GT = CS_N2 + CS_MAT;
constexpr int CS_Z = CS_M2F, CS_U = CS_M2F + CS_MAT;
constexpr int CS_GL = CS_GT + 2 * CS_MAT;
static_assert(CS_GL + 256 <= LDS_MISC, "chunked-scan LDS map");
template <bool SWZB = false>
__device__ __forceinline__ void cs_mma(f32x16& acc, const LAS unsigned char* Am, const LAS unsigned char* Bm, int ti, int tj, int r32, int hi) {
    const LAS unsigned char* ap = Am + (ti * 32 + r32) * (CSP * 2) + hi * 16; const int brow = tj * 32 + r32; const LAS unsigned char* bp = Bm + brow * (CSP * 2);
    const int sw = SWZB ? ((brow >> 3) & 7) : 0;
#pragma unroll
    for (int ks = 0; ks < 4; ++ks) acc = __builtin_amdgcn_mfma_f32_32x32x16_bf16(*(const LAS bf16x8*)(ap + ks * 32), *(const LAS bf16x8*)(bp + (((ks * 2 + hi) ^ sw) * 16)), acc, 0, 0, 0);
}
__device__ __forceinline__ void cs_store_t(LAS unsigned char* Om, const f32x16& acc, int ti, int tj, int r32, int hi) {
    LAS unsigned char* op = Om + (tj * 32 + r32) * (CSP * 2) + (ti * 32 + 4 * hi) * 2;
#pragma unroll
    for (int g = 0; g < 4; ++g) { u32x2 o; o.x = pk2(acc[4 * g], acc[4 * g + 1]); o.y = pk2(acc[4 * g + 2], acc[4 * g + 3]); *(LAS u32x2*)(op + g * 16) = o; }
}
#define CS_BAR() asm volatile("s_waitcnt lgkmcnt(0)\n\ts_barrier" ::: "memory")
__device__ __forceinline__ void phase_csa(const Ctx& C, const Args& A) {
    const unsigned char* SCN = A.ws + WS_SCN; unsigned char* CHK = A.ws + WS_CHK;
    LAS unsigned char* L = C.lds;
    const int r32 = C.lane & 31, hi = C.lane >> 5;
    float lwv[8]; u32x4 ukk, ub, ukr, ur, uv;
#define CSA_GEOM(cu_) const int unit = (cu_) / CS_NCH, ch = (cu_) % CS_NCH; const int d = unit & 1, h = (unit >> 1) % 12, b = unit / 24; \
        const int step0 = ch * CS_L; const int sgn = d ? -1 : 1; \
        const int row0 = (step0 < CTXL) ? (NLAT + b * CTXL + (d ? CTXL - 1 - step0 : step0)) : (b * TT + (d ? TT - 1 - (step0 - CTXL) : step0 - CTXL)); \
        const unsigned char* rec0 = SCN + (size_t)row0 * SC_ROW + (size_t)h * SC_REC;
#define CSA_LOAD(cu_) do { CSA_GEOM(cu_); \
        { const int k = C.tid & 63, sg = C.tid >> 6; _Pragma("unroll") for (int j = 0; j < 8; ++j) lwv[j] = *(const float*)(rec0 + (long)sgn * (8 * sg + j) * SC_ROW + SC_W + 256 * d + k * 4); } \
        { const int t = C.tid >> 3, k0 = (C.tid & 7) * 8; const unsigned char* rp = rec0 + (long)sgn * t * SC_ROW; \
          ukk = *(const u32x4*)(rp + SC_KK + k0 * 2); ub = *(const u32x4*)(rp + SC_B + 256 * d + k0 * 2); ukr = *(const u32x4*)(rp + SC_KR + 256 * d + k0 * 2); ur = *(const u32x4*)(rp + SC_R + k0 * 2); uv = *(const u32x4*)(rp + SC_V + k0 * 2); } } while (0)
    if ((int)blockIdx.x < CS_UNITS * CS_NCH) CSA_LOAD((int)blockIdx.x);
    for (int cu = blockIdx.x; cu < CS_UNITS * CS_NCH; cu += C.G) {
        LAS float* csf = (LAS float*)(L + CS_M2F);
        LAS float* seg = (LAS float*)(L + CS_N2);
        { const int k = C.tid & 63, sg = C.tid >> 6;
#pragma unroll
          for (int j = 1; j < 8; ++j) lwv[j] += lwv[j - 1];
          seg[sg * 64 + k] = lwv[7];
          CS_BAR();
          float off = 0.f, tot = 0.f;
#pragma unroll
          for (int s2 = 0; s2 < 8; ++s2) { const float v = seg[s2 * 64 + k]; off += (s2 < sg) ? v : 0.f; tot += v; }
#pragma unroll
          for (int j = 0; j < 8; ++j) csf[(8 * sg + j) * 65 + k] = lwv[j] + off;
          if (sg == 7) ((LAS float*)(L + CS_GL))[k] = __expf(tot); }
        CS_BAR();
        { const int t = C.tid >> 3, k0 = (C.tid & 7) * 8;
          float wt[8], kb[8], bb[8], rt[8], bh[8], kh[8];
#pragma unroll
          for (int j = 0; j < 8; ++j) { const unsigned pkk = j < 2 ? ukk.x : j < 4 ? ukk.y : j < 6 ? ukk.z : ukk.w, pb = j < 2 ? ub.x : j < 4 ? ub.y : j < 6 ? ub.z : ub.w, pkr = j < 2 ? ukr.x : j < 4 ? ukr.y : j < 6 ? ukr.z : ukr.w, pr = j < 2 ? ur.x : j < 4 ? ur.y : j < 6 ? ur.z : ur.w;
              const float kkv = (j & 1) ? bfhi(pkk) : bflo(pkk), bv = (j & 1) ? bfhi(pb) : bflo(pb), krv = (j & 1) ? bfhi(pkr) : bflo(pkr), rv = (j & 1) ? bfhi(pr) : bflo(pr);
              const float cst = csf[t * 65 + k0 + j], csp = t > 0 ? csf[(t - 1) * 65 + k0 + j] : 0.f, csl = csf[63 * 65 + k0 + j];
              const float einv = __expf(-cst), el = __expf(csl - cst);
              wt[j] = kkv * __expf(csp); kb[j] = krv * einv; bb[j] = bv * einv; rt[j] = rv * __expf(cst); bh[j] = bv * el; kh[j] = krv * el; }
          u32x4 o;
          o.x = pk2(wt[0], wt[1]); o.y = pk2(wt[2], wt[3]); o.z = pk2(wt[4], wt[5]); o.w = pk2(wt[6], wt[7]); *(LAS u32x4*)(L + CS_WT + t * (CSP * 2) + k0 * 2) = o;
          o.x = pk2(kb[0], kb[1]); o.y = pk2(kb[2], kb[3]); o.z = pk2(kb[4], kb[5]); o.w = pk2(kb[6], kb[7]); *(LAS u32x4*)(L + CS_KB + t * (CSP * 2) + k0 * 2) = o;
          o.x = pk2(bb[0], bb[1]); o.y = pk2(bb[2], bb[3]); o.z = pk2(bb[4], bb[5]); o.w = pk2(bb[6], bb[7]); *(LAS u32x4*)(L + CS_BB + t * (CSP * 2) + k0 * 2) = o;
          o.x = pk2(rt[0], rt[1]); o.y = pk2(rt[2], rt[3]); o.z = pk2(rt[4], rt[5]); o.w = pk2(rt[6], rt[7]); *(LAS u32x4*)(L + CS_RT + t * (CSP * 2) + k0 * 2) = o;
#pragma unroll
          for (int j = 0; j < 8; ++j) { const int to = ((((t >> 3) ^ ((k0 >> 3) & 7)) * 8) + (t & 7)) * 2;
              *(LAS bf16_t*)(L + CS_BHT + (k0 + j) * (CSP * 2) + to) = (bf16_t)f2bf(bh[j]); *(LAS bf16_t*)(L + CS_KHT + (k0 + j) * (CSP * 2) + to) = (bf16_t)f2bf(kh[j]);
              const unsigned pv = j < 2 ? uv.x : j < 4 ? uv.y : j < 6 ? uv.z : uv.w; *(LAS bf16_t*)(L + CS_VMT + (k0 + j) * (CSP * 2) + to) = (bf16_t)((j & 1) ? (pv >> 16) : (pv & 0xffffu)); } }
        if (cu + C.G < CS_UNITS * CS_NCH) CSA_LOAD(cu + C.G);
        CS_BAR();
        for (int job = C.wave; job < 12; job += NWAVES) { const int p = job >> 2, ti = (job >> 1) & 1, tj = job & 1;
            f32x16 acc;
#pragma unroll
            for (int i = 0; i < 16; ++i) acc[i] = 0.f;
            if (p == 0) { cs_mma(acc, L + CS_WT, L + CS_BB, ti, tj, r32, hi);
                const int i = tj * 32 + r32; LAS float* mp = (LAS float*)(L + CS_M2F) + i * 64;
#pragma unroll
                for (int reg = 0; reg < 16; ++reg) { const int t = ti * 32 + crow(reg, hi); mp[(t & 3) * 16 + (t >> 2)] = (i < t) ? acc[reg] : 0.f; } }
            else if (p == 1) { cs_mma(acc, L + CS_WT, L + CS_KB, ti, tj, r32, hi);
                const int i = tj * 32 + r32;
#pragma unroll
                for (int reg = 0; reg < 16; ++reg) { const int t = ti * 32 + crow(reg, hi); acc[reg] = (i < t) ? acc[reg] : 0.f; }
                cs_store_t(L + CS_M1T, acc, ti, tj, r32, hi); }
            else { cs_mma(acc, L + CS_BB, L + CS_RT, ti, tj, r32, hi);
                const int t = tj * 32 + r32;
#pragma unroll
                for (int reg = 0; reg < 16; ++reg) { const int i = ti * 32 + crow(reg, hi); acc[reg] = (i <= t) ? acc[reg] : 0.f; }
                cs_store_t(L + CS_N2, acc, ti, tj, r32, hi); } }
        CS_BAR();
        { const int c = C.tid >> 2, q = C.tid & 3; f32x2 acc2[8];
          { const LAS unsigned char* rcol = (c < 64) ? (L + CS_WT + c * 2) : (L + CS_M1T + (c - 64) * (CSP * 2)); const int rstride = (c < 64) ? CSP * 2 : 2;
#pragma unroll
            for (int j = 0; j < 16; ++j) acc2[j >> 1][j & 1] = bf2f(*(const LAS bf16_t*)(rcol + (4 * j + q) * rstride)); }
          const LAS float* m2c = (const LAS float*)(L + CS_M2F) + q * 16;
#pragma clang loop unroll(full)
          for (int i = 0; i < 64; ++i) {
              const float mine = -acc2[i >> 3][(i >> 2) & 1];
              float gi;
              switch (i & 3) { case 0: gi = __uint_as_float((unsigned)__builtin_amdgcn_update_dpp(0, (int)__float_as_uint(mine), 0x00, 0xF, 0xF, true)); break;
                               case 1: gi = __uint_as_float((unsigned)__builtin_amdgcn_update_dpp(0, (int)__float_as_uint(mine), 0x55, 0xF, 0xF, true)); break;
                               case 2: gi = __uint_as_float((unsigned)__builtin_amdgcn_update_dpp(0, (int)__float_as_uint(mine), 0xAA, 0xF, 0xF, true)); break;
                               default: gi = __uint_as_float((unsigned)__builtin_amdgcn_update_dpp(0, (int)__float_as_uint(mine), 0xFF, 0xF, 0xF, true)); break; }
              const f32x2 g2 = {gi, gi};
#pragma unroll
              for (int j4 = (i >> 4); j4 < 4; ++j4) { const f32x4 m = *(const LAS f32x4*)(m2c + i * 64 + j4 * 4);
#pragma unroll
                  for (int h = 0; h < 2; ++h) { const int p = 2 * j4 + h;
                      if (2 * p >= (i >> 2)) acc2[p] += (f32x2){m[2 * h], m[2 * h + 1]} * g2;
                      else if (2 * p + 1 >= (i >> 2)) acc2[p][1] += m[2 * h + 1] * gi; } }
          }
#pragma unroll
          for (int j = 0; j < 16; ++j) *(LAS bf16_t*)(L + CS_GT + c * (CSP * 2) + (4 * j + q) * 2) = (bf16_t)f2bf(-acc2[j >> 1][j & 1]); }
        CS_BAR();
        unsigned char* outp = CHK + (size_t)cu * 32768;
        for (int job = C.wave; job < 16; job += NWAVES) { const int p = job >> 2, ti = (job >> 1) & 1, tj = job & 1;
            f32x16 acc;
            if (p == 0) {
                const LAS unsigned char* rp = L + CS_RT + (tj * 32 + r32) * (CSP * 2) + (ti * 32 + 4 * hi) * 2;
#pragma unroll
                for (int g = 0; g < 4; ++g) { const u32x2 u = *(const LAS u32x2*)(rp + g * 16); acc[4 * g] = bflo(u.x); acc[4 * g + 1] = bfhi(u.x); acc[4 * g + 2] = bflo(u.y); acc[4 * g + 3] = bfhi(u.y); }
                cs_mma(acc, L + CS_GT, L + CS_N2, ti, tj, r32, hi);
#pragma unroll
                for (int g = 0; g < 4; ++g) { u32x2 o; o.x = pk2(acc[4 * g], acc[4 * g + 1]); o.y = pk2(acc[4 * g + 2], acc[4 * g + 3]);
                    *(u32x2*)(outp + 8192 + (((tj * 4 + 2 * ti + (g >> 1)) * 64 + (g & 1) * 32 + r32) * 16) + hi * 8) = o; } }
            else if (p == 1) {
#pragma unroll
                for (int i = 0; i < 16; ++i) acc[i] = 0.f;
                cs_mma(acc, L + CS_KB, L + CS_RT, ti, tj, r32, hi);
                const int t = tj * 32 + r32;
#pragma unroll
                for (int reg = 0; reg < 16; ++reg) { const int i = ti * 32 + crow(reg, hi); acc[reg] = (i <= t) ? acc[reg] : 0.f; }
                cs_mma(acc, L + CS_GT + 64 * (CSP * 2), L + CS_N2, ti, tj, r32, hi);
                cs_store_t(L + CS_Z, acc, ti, tj, r32, hi); }
            else if (p == 2) {
#pragma unroll
                for (int i = 0; i < 16; ++i) acc[i] = 0.f;
                cs_mma<true>(acc, L + CS_GT, L + CS_BHT, ti, tj, r32, hi);
                const int k = tj * 32 + r32; const float gl = ((const LAS float*)(L + CS_GL))[k];
#pragma unroll
                for (int reg = 0; reg < 16; ++reg) { const int cc = ti * 32 + crow(reg, hi); acc[reg] += (cc == k) ? gl : 0.f; }
#pragma unroll
                for (int g = 0; g < 4; ++g) { u32x2 o; o.x = pk2(acc[4 * g], acc[4 * g + 1]); o.y = pk2(acc[4 * g + 2], acc[4 * g + 3]);
                    *(u32x2*)(outp + (((tj * 4 + 2 * ti + (g >> 1)) * 64 + (g & 1) * 32 + r32) * 16) + hi * 8) = o; } }
            else {
                const int krow = tj * 32 + r32; const LAS unsigned char* kp = L + CS_KHT + krow * (CSP * 2) + hi * 8;
#pragma unroll
                for (int g = 0; g < 4; ++g) { const u32x2 u = *(const LAS u32x2*)(kp + (((ti * 4 + g) ^ ((krow >> 3) & 7)) * 16)); acc[4 * g] = bflo(u.x); acc[4 * g + 1] = bfhi(u.x); acc[4 * g + 2] = bflo(u.y); acc[4 * g + 3] = bfhi(u.y); }
                cs_mma<true>(acc, L + CS_GT + 64 * (CSP * 2), L + CS_BHT, ti, tj, r32, hi);
                cs_store_t(L + CS_U, acc, ti, tj, r32, hi); } }
        CS_BAR();
        { const int p = C.wave >> 2, ti = (C.wave >> 1) & 1, tj = C.wave & 1;
          f32x16 acc;
#pragma unroll
          for (int i = 0; i < 16; ++i) acc[i] = 0.f;
          cs_mma<true>(acc, L + (p ? CS_U : CS_Z), L + CS_VMT, ti, tj, r32, hi);
          unsigned char* op = outp + (p ? 16384 : 24576) + ((ti * 2 + tj) * 64 + C.lane) * 32;
          u32x4 o0, o1; o0.x = pk2(acc[0], acc[1]); o0.y = pk2(acc[2], acc[3]); o0.z = pk2(acc[4], acc[5]); o0.w = pk2(acc[6], acc[7]);
          o1.x = pk2(acc[8], acc[9]); o1.y = pk2(acc[10], acc[11]); o1.z = pk2(acc[12], acc[13]); o1.w = pk2(acc[14], acc[15]);
          *(u32x4*)op = o0; *(u32x4*)(op + 16) = o1; }
        CS_BAR();
    }
}
__device__ __forceinline__ void phase_csb(const Ctx& C, const Args& A, int l) {
    if ((int)blockIdx.x >= CS_UNITS) { const int gwf = ((int)blockIdx.x - CS_UNITS) * NWAVES + C.wave, ngwf = (C.G - CS_UNITS) * NWAVES;
        conv_items(C, A, l + 1, gwf, ngwf, true, false, false); conv_items(C, A, l + 1, gwf, ngwf, false, false, true, XW_TK_HI); return; }
    const unsigned char* CHK = A.ws + WS_CHK;
    LAS unsigned char* L = C.lds;
    const int r32 = C.lane & 31, hi = C.lane >> 5;
    const bool isS = C.wave < 4; const int ti = (C.wave >> 1) & 1, tj = C.wave & 1;
    for (int unit = blockIdx.x; unit < CS_UNITS; unit += C.G) {
        const int d = unit & 1, h = (unit >> 1) % 12, b = unit / 24;
        float* Y = (float*)(A.ws + WS_Y) + (size_t)d * MROWS * 768;
        for (int i = C.tid; i < 2 * CS_MAT / 4; i += NTHR) ((LAS unsigned*)L)[i] = 0u;
        CS_BAR();
        bf16x8 afA[4], afB[4], afC[4]; u32x4 cA0, cA1, cB0, cB1, cC0, cC1;
#define CSB_LOAD(A4, C0, C1, ch_) do { const unsigned char* op_ = CHK + ((size_t)unit * CS_NCH + (ch_)) * 32768; \
            const unsigned char* am_ = op_ + (isS ? 0 : 8192) + (ti * 4 * 64 + C.lane) * 16;     \
            _Pragma("unroll") for (int ks = 0; ks < 4; ++ks) A4[ks] = *(const bf16x8*)(am_ + ks * 1024); \
            const unsigned char* cp_ = op_ + (isS ? 16384 : 24576) + ((ti * 2 + tj) * 64 + C.lane) * 32; C0 = *(const u32x4*)cp_; C1 = *(const u32x4*)(cp_ + 16); } while (0)
#define CSB_STEP(A4, C0, C1, ch_) do { \
            const LAS unsigned char* Sb = L + ((ch_) & 1) * CS_MAT; LAS unsigned char* Sn = L + (((ch_) + 1) & 1) * CS_MAT; \
            f32x16 acc; \
            acc[0] = bflo(C0.x); acc[1] = bfhi(C0.x); acc[2] = bflo(C0.y); acc[3] = bfhi(C0.y); acc[4] = bflo(C0.z); acc[5] = bfhi(C0.z); acc[6] = bflo(C0.w); acc[7] = bfhi(C0.w); \
            acc[8] = bflo(C1.x); acc[9] = bfhi(C1.x); acc[10] = bflo(C1.y); acc[11] = bfhi(C1.y); acc[12] = bflo(C1.z); acc[13] = bfhi(C1.z); acc[14] = bflo(C1.w); acc[15] = bfhi(C1.w); \
            const LAS unsigned char* bp = Sb + (tj * 32 + r32) * (CSP * 2) + hi * 16; \
            _Pragma("unroll") for (int ks = 0; ks < 4; ++ks) acc = __builtin_amdgcn_mfma_f32_32x32x16_bf16(A4[ks], *(const LAS bf16x8*)(bp + ks * 32), acc, 0, 0, 0); \
            if (isS) { cs_store_t(Sn, acc, ti, tj, r32, hi); }     \
            else {     \
                const int step0 = (ch_) * CS_L; const int sgn = d ? -1 : 1; \
                const int row0 = (step0 < CTXL) ? (NLAT + b * CTXL + (d ? CTXL - 1 - step0 : step0)) : (b * TT + (d ? TT - 1 - (step0 - CTXL) : step0 - CTXL)); \
                float* yp = Y + (size_t)(row0 + sgn * (ti * 32 + 4 * hi)) * 768 + h * 64 + tj * 32 + r32; const long ys = (long)sgn * 768; \
                _Pragma("unroll") for (int reg = 0; reg < 16; ++reg) yp[ys * ((reg & 3) + 8 * (reg >> 2))] = acc[reg]; } \
            CS_BAR(); } while (0)
        CSB_LOAD(afA, cA0, cA1, 0); CSB_LOAD(afB, cB0, cB1, 1);
        static_assert(CS_NCH % 3 == 0, "chunk loop is unrolled by three");
        for (int ch = 0; ch < CS_NCH; ch += 3) {
            if (ch == 0) CSB_LOAD(afC, cC0, cC1, 2);
            CSB_STEP(afA, cA0, cA1, ch);     if (ch + 3 < CS_NCH) CSB_LOAD(afA, cA0, cA1, ch + 3);
            CSB_STEP(afB, cB0, cB1, ch + 1); if (ch + 4 < CS_NCH) CSB_LOAD(afB, cB0, cB1, ch + 4);
            CSB_STEP(afC, cC0, cC1, ch + 2); if (ch + 5 < CS_NCH) CSB_LOAD(afC, cC0, cC1, ch + 5);
        }
        CS_BAR();
    }
#undef CSB_LOAD
#undef CSB_STEP
}

#undef CS_BAR
struct Ef2Row { f32x4 y0[3], y1[3]; u32x2 r[3], v[3], k0[3], k1[3], g[3]; };
__device__ __forceinline__ void ef2_load(Ef2Row& R, const float* Y0, const float* Y1, const unsigned char* SCN, const bf16_t* G, int row, int lane) {
#pragma unroll
    for (int it = 0; it < 3; ++it) { const int c = it * 256 + 4 * lane, head = c >> 6, kx = c & 63;
        R.y0[it] = *(const f32x4*)(Y0 + (size_t)row * 768 + c); R.y1[it] = *(const f32x4*)(Y1 + (size_t)row * 768 + c);
        const unsigned char* base = SCN + (size_t)(row * 12 + head) * SC_REC + kx * 2;
        R.r[it] = *(const u32x2*)(base + SC_R); R.v[it] = *(const u32x2*)(base + SC_V); R.k0[it] = *(const u32x2*)(base + SC_KR); R.k1[it] = *(const u32x2*)(base + SC_KR + 256);
        R.g[it] = *(const u32x2*)(G + (size_t)row * 768 + c); }
}
__device__ __forceinline__ void phase_ef2(const Ctx& C, const Args& A, int l) {
    const int i2 = l >> 1; unsigned char* ws = A.ws;
    const unsigned char* SCN = ws + WS_SCN; const float* Y0 = (const float*)(ws + WS_Y); const float* Y1 = Y0 + (size_t)MROWS * 768;
    const bf16_t* G = (const bf16_t*)(ws + WS_G); bf16_t* A2 = (bf16_t*)(ws + WS_A2);
    const float* rb = A.in[I_RBON] + (size_t)i2 * 768; const float* gg = A.in[I_GNG] + (size_t)i2 * 768; const float* gb = A.in[I_GNB] + (size_t)i2 * 768;
    f32x4 rbr[3], ggr[3], gbr[3];
#pragma unroll
    for (int it = 0; it < 3; ++it) { const int c = it * 256 + 4 * C.lane; rbr[it] = *(const f32x4*)(rb + c); ggr[it] = *(const f32x4*)(gg + c); gbr[it] = *(const f32x4*)(gb + c); }
    Ef2Row Rn;
    if (C.gw < MROWS) ef2_load(Rn, Y0, Y1, SCN, G, C.gw, C.lane);
    for (int row = C.gw; row < MROWS; row += C.NGW) {
        const Ef2Row R = Rn;
        { const int nr = row + C.NGW < MROWS ? row + C.NGW : row; ef2_load(Rn, Y0, Y1, SCN, G, nr, C.lane); }
#pragma unroll
        for (int it = 0; it < 3; ++it) {
            const int c = it * 256 + 4 * C.lane;
            const f32x4 y = R.y0[it] + R.y1[it];
            const float mean = sum16((y[0] + y[1]) + (y[2] + y[3])) * (1.f / 64.f);
            const f32x4 dd = y - mean;
            const float var = sum16((dd[0] * dd[0] + dd[1] * dd[1]) + (dd[2] * dd[2] + dd[3] * dd[3])) * (1.f / 64.f);
            const float rstd = rsqrtf(var + GN_EPS);
            const f32x4 r = bf4(R.r[it]), v = bf4(R.v[it]), k0 = bf4(R.k0[it]), k1 = bf4(R.k1[it]);
            const f32x4 t = r * (k0 + k1) * 0.5f * rbr[it];
            const float bs = sum16((t[0] + t[1]) + (t[2] + t[3]));
            const f32x4 yn = dd * rstd * ggr[it] + gbr[it];
            const f32x4 g = bf4(R.g[it]);
            st4bf(A2 + (size_t)row * DM + 256 + c, g * (yn + v * bs));
        }
    }
}

__device__ __forceinline__ void phase_of1(const Ctx& C, const Args& A, int l) {
    const int i2 = l >> 1; unsigned char* ws = A.ws;
    const bf16_t* P = (const bf16_t*)(ws + WS_P); bf16_t* A2 = (bf16_t*)(ws + WS_A2); bf16_t* VT = (bf16_t*)(ws + WS_VT);
    const float* lng = A.in[I_GLNG] + (size_t)i2 * 256; const float* lnb = A.in[I_GLNB] + (size_t)i2 * 256;
    const float* gws = A.in[I_GWS] + (size_t)i2 * 4 * 128 * 128; const float* gbs = A.in[I_GBS] + (size_t)i2 * 4 * 128;
    LAS bf16_t* vt = (LAS bf16_t*)C.lds;
    LAS bf16_t* uL = (LAS bf16_t*)C.lds;
    LAS bf16_t* vT = (LAS bf16_t*)(C.lds + 128 * 528);
    const int r32 = C.lane & 31, hi = C.lane >> 5;
    for (int it = blockIdx.x; it < 256 + 8 * 7; it += C.G) {
        const bool isctx = it >= 256; const int uc = isctx ? (it - 256) / 7 : 0, pc = isctx ? (it - 256) % 7 : 0; const int u = it;
        const int b = isctx ? (uc >> 1) : (u >> 6), pos0 = isctx ? (uc & 1) * 128 : (u & 63) * 128;
        const int row0 = isctx ? NLAT + b * CTXL + pos0 : b * TT + pos0, L0 = isctx ? pos0 : CTXL + pos0;
        const int hh0 = isctx ? pc : 0, hh1 = isctx ? (pc < 6 ? pc + 1 : 0) : 6; const bool doC = !isctx || pc == 6;
        u32x4 pv[4];
        if (hh0 < hh1) {
#pragma unroll
            for (int i = 0; i < 4; ++i) { const int piece = C.tid + NTHR * i, r = piece >> 4, part = piece & 15; pv[i] = *(const u32x4*)(P + (size_t)(row0 + r) * P_LD + 1536 + hh0 * 128 + part * 8); } }
        for (int hh = hh0; hh < hh1; ++hh) {
#pragma unroll
            for (int i = 0; i < 4; ++i) { const int piece = C.tid + NTHR * i, r = piece >> 4, part = piece & 15;
                *(LAS u32x4*)(vt + r * 136 + part * 8) = pv[i]; }
            __syncthreads();
            if (hh + 1 < hh1) {
#pragma unroll
                for (int i = 0; i < 4; ++i) { const int piece = C.tid + NTHR * i, r = piece >> 4, part = piece & 15; pv[i] = *(const u32x4*)(P + (size_t)(row0 + r) * P_LD + 1536 + (hh + 1) * 128 + part * 8); } }
#pragma unroll
            for (int i = 0; i < 4; ++i) { const int item = C.tid + NTHR * i, d = item >> 4, tg = item & 15; const LAS bf16_t* s = vt + (tg * 8) * 136 + d;
                u32x4 o; o.x = (unsigned)s[0] | ((unsigned)s[136] << 16); o.y = (unsigned)s[2 * 136] | ((unsigned)s[3 * 136] << 16);
                o.z = (unsigned)s[4 * 136] | ((unsigned)s[5 * 136] << 16); o.w = (unsigned)s[6 * 136] | ((unsigned)s[7 * 136] << 16);
                *(u32x4*)(VT + ((size_t)(b * 6 + hh) * 128 + d) * LKEYS + L0 + tg * 8) = o; }
            __syncthreads();
        }
        if (doC) {
        const f32x4 lngr = *(const f32x4*)(lng + 4 * C.lane), lnbr = *(const f32x4*)(lnb + 4 * C.lane);
        u32x2 nxu, nxr;
        { const bf16_t* pr = P + (size_t)(row0 + C.wave) * P_LD + 2304 + 4 * C.lane; nxu = *(const u32x2*)pr; nxr = *(const u32x2*)(pr + 256); }
        for (int r = C.wave; r < 128; r += NWAVES) {
            const int c4 = 4 * C.lane;
            const f32x4 ur = bf4(nxu), raw = bf4(nxr);
            if (r + NWAVES < 128) { const bf16_t* pr = P + (size_t)(row0 + r + NWAVES) * P_LD + 2304 + c4; nxu = *(const u32x2*)pr; nxr = *(const u32x2*)(pr + 256); }
            { const f32x4 gu = gelu4(ur); u32x2 o; o.x = pk2(gu[0], gu[1]); o.y = pk2(gu[2], gu[3]); *(LAS u32x2*)(uL + r * 264 + c4) = o; }
            const f32x4 gv = gelu4(raw);
            const float mean = wave_sum((gv[0] + gv[1]) + (gv[2] + gv[3])) * (1.f / 256.f); const f32x4 dd = gv - mean;
            const float var = wave_sum((dd[0] * dd[0] + dd[1] * dd[1]) + (dd[2] * dd[2] + dd[3] * dd[3])) * (1.f / 256.f); const float rstd = rsqrtf(var + LN_EPS);
            const f32x4 o = dd * rstd * lngr + lnbr;
#pragma unroll
            for (int k = 0; k < 4; ++k) vT[(c4 + k) * 136 + r] = (bf16_t)f2bf(o[k]);
        }
        __syncthreads();
        {
            const int g = C.wave >> 1, cblk = C.wave & 1, cc = g * 64 + cblk * 32 + r32;
            for (int pblk = 0; pblk < 4; ++pblk) {
                f32x16 acc;
#pragma unroll
                for (int i = 0; i < 16; ++i) acc[i] = 0.f;
                const float* wrow = gws + ((size_t)g * 128 + pblk * 32 + r32) * 128 + 8 * hi;
#pragma unroll
                for (int ks = 0; ks < 8; ++ks) { const f32x4 w0 = *(const f32x4*)(wrow + ks * 16), w1 = *(const f32x4*)(wrow + ks * 16 + 4);
                    u32x4 au; au.x = pk2(w0[0], w0[1]); au.y = pk2(w0[2], w0[3]); au.z = pk2(w1[0], w1[1]); au.w = pk2(w1[2], w1[3]);
                    const bf16x8 bf = *(const LAS bf16x8*)(vT + cc * 136 + ks * 16 + 8 * hi);
                    acc = __builtin_amdgcn_mfma_f32_32x32x16_bf16(__builtin_bit_cast(bf16x8, au), bf, acc, 0, 0, 0); }
#pragma unroll
                for (int reg = 0; reg < 16; ++reg) { const int p = pblk * 32 + crow(reg, hi);
                    const float uu = bf2f(uL[p * 264 + cc]); const float mixed = acc[reg] + gbs[g * 128 + p];
                    uL[p * 264 + cc] = (bf16_t)f2bf(uu * mixed); }
            }
        }
        __syncthreads();
#pragma unroll
        for (int i = 0; i < 8; ++i) { const int piece = C.tid + NTHR * i, r = piece >> 5, part = piece & 31;
            *(u32x4*)(A2 + (size_t)(row0 + r) * DM + 768 + part * 8) = *(const LAS u32x4*)(uL + r * 264 + part * 8); }
        __syncthreads();
        }
    }
}

__device__ __forceinline__ void phase_attn(const Ctx& C, const Args& A, int l) {
    const int i2 = l >> 1; unsigned char* ws = A.ws;
    const bf16_t* Q = (const bf16_t*)(ws + WS_Q); const bf16_t* KA = (const bf16_t*)(ws + WS_KA); const bf16_t* VT = (const bf16_t*)(ws + WS_VT); bf16_t* A2 = (bf16_t*)(ws + WS_A2);
    const float lam_init = 0.8f - 0.6f * expf(-0.3f * (float)l);
    float s1 = 0.f, s2 = 0.f;
    for (int j = 0; j < 64; ++j) { s1 += A.in[I_LQ1][i2 * 64 + j] * A.in[I_LK1][i2 * 64 + j]; s2 += A.in[I_LQ2][i2 * 64 + j] * A.in[I_LK2][i2 * 64 + j]; }
    const float lam = expf(s1) - expf(s2) + lam_init;
    const float* subg = A.in[I_SUBG] + (size_t)i2 * 128;
    const int r32 = C.lane & 31, hi = C.lane >> 5, map = C.wave >> 2, qw = C.wave & 3;
    LAS unsigned char* Kt = C.lds; LAS unsigned char* Vt = C.lds + 2 * 16384; LAS float* xch = (LAS float*)C.lds;
    const int NU = 1536 + (l == 1 ? 48 : 0);
    for (int n = C.vcu; n < NU; n += C.G) {
        int bh, qt; bool isctx = false;
        if (n < 1536) { const int round = n >> 8, slot = n & 255; bh = (slot >> 5) * 3 + (round >> 1); qt = (round & 1) * 32 + (slot & 31); }
        else { isctx = true; bh = (n - 1536) >> 1; qt = (n - 1536) & 1; }
        const int b = bh / 6, h = bh % 6;
        const int qrow0 = isctx ? NLAT + b * CTXL + qt * 128 : b * TT + qt * 128;
        const int NT = isctx ? CTXL / 64 : LKEYS / 64;
        const bf16_t* Kb = KA + (size_t)b * LKEYS * 768 + h * 128;
        const bf16_t* Vb = VT + (size_t)(b * 6 + h) * 128 * LKEYS;
        bf16x8 qf[4];
        { const bf16_t* qp = Q + (size_t)(qrow0 + qw * 32 + r32) * 768 + h * 128 + map * 64 + 8 * hi;
#pragma unroll
          for (int ks = 0; ks < 4; ++ks) qf[ks] = *(const bf16x8*)(qp + ks * 16); }
        f32x16 O[4];
#pragma unroll
        for (int d = 0; d < 4; ++d)
#pragma unroll
            for (int i = 0; i < 16; ++i) O[d][i] = 0.f;
        float m = 0.f, lsum = 0.f;
        unsigned ksrc[2], vsrc[2];
#pragma unroll
        for (int i = 0; i < 2; ++i) { const int row = 4 * (2 * C.wave + i) + (C.lane >> 4), x = row & 15, pi = x < 4 ? x : x < 8 ? x + 4 : x < 12 ? x - 4 : x;
            ksrc[i] = (unsigned)(((row & ~15) + pi) * 768 + (((C.lane & 15) ^ x) * 8));
            const int d = 8 * (2 * C.wave + i) + (C.lane >> 3); vsrc[i] = (unsigned)(d * LKEYS + (((C.lane & 7) ^ ((d >> 1) & 7)) * 8)); }
#define AT_DMA_K(tt, slot) do { _Pragma("unroll") for (int i = 0; i < 2; ++i) __builtin_amdgcn_global_load_lds((const unsigned*)(Kb + (size_t)(tt) * 64 * 768 + ksrc[i]), (LAS unsigned*)(Kt + (slot) * 16384 + (2 * C.wave + i) * 1024), 16, 0, 0); } while (0)
#define AT_DMA_V(tt, slot) do { _Pragma("unroll") for (int i = 0; i < 2; ++i) __builtin_amdgcn_global_load_lds((const unsigned*)(Vb + (size_t)(tt) * 64 + vsrc[i]), (LAS unsigned*)(Vt + (slot) * 16384 + (2 * C.wave + i) * 1024), 16, 0, 0); } while (0)
#define AT_BAR() asm volatile("s_waitcnt vmcnt(0) lgkmcnt(0)\n\ts_barrier" ::: "memory")
#define AT_SB() __builtin_amdgcn_sched_barrier(0)
        const int ksw = r32 & 15, vsw = (r32 >> 1) & 7;
#define AT_QK(P0, P1, ks_) do { const float nm_ = -m; _Pragma("unroll") for (int i = 0; i < 16; ++i) { P0[i] = nm_; P1[i] = nm_; } \
            const LAS unsigned char* kbp_ = Kt + (ks_) * 16384 + r32 * 256; \
            _Pragma("unroll") for (int ks = 0; ks < 4; ++ks) { const int co_ = ((map * 8 + ks * 2 + hi) ^ ksw) * 16; \
                P0 = __builtin_amdgcn_mfma_f32_32x32x16_bf16(*(const LAS bf16x8*)(kbp_ + co_), qf[ks], P0, 0, 0, 0); P1 = __builtin_amdgcn_mfma_f32_32x32x16_bf16(*(const LAS bf16x8*)(kbp_ + 32 * 256 + co_), qf[ks], P1, 0, 0, 0); } } while (0)
#define AT_LDV(dst, vs_, d) do { _Pragma("unroll") for (int kst = 0; kst < 4; ++kst) dst[kst] = *(const LAS u32x4*)(Vt + (vs_) * 16384 + ((d) * 32 + r32) * 128 + (((kst * 2 + hi) ^ vsw) * 16)); } while (0)
#define AT_PV(src, d) do { _Pragma("unroll") for (int kst = 0; kst < 4; ++kst) O[d] = __builtin_amdgcn_mfma_f32_32x32x16_bf16(__builtin_bit_cast(bf16x8, src[kst]), pb[kst], O[d], 0, 0, 0); } while (0)
#define AT_SOFTPV(P0, P1, N0, N1, first, hasn, vs_) do { \
            asm volatile("s_nop 15\n\ts_nop 7" : "+v"(P0), "+v"(P1)); \
            float mx = max3f(P0[0], P0[1], P1[0]), mx2 = max3f(P0[2], P0[3], P1[1]); mx = max3f(mx, P1[2], P1[3]); \
            _Pragma("unroll") for (int i = 4; i < 16; i += 4) { mx = max3f(mx, P0[i], P0[i + 1]); mx2 = max3f(mx2, P0[i + 2], P0[i + 3]); mx = max3f(mx, P1[i], P1[i + 1]); mx2 = max3f(mx2, P1[i + 2], P1[i + 3]); } \
            mx = fmaxf(mx, mx2); \
            { auto rr = __builtin_amdgcn_permlane32_swap(__float_as_uint(mx), __float_as_uint(mx), false, false); mx = fmaxf(__uint_as_float(rr[0]), __uint_as_float(rr[1])); } \
            if ((first) || __any(mx > 8.f)) { const float dl = (first) ? mx : fmaxf(mx, 0.f); const float sc = __builtin_amdgcn_exp2f(-dl); lsum *= sc; \
                _Pragma("unroll") for (int d = 0; d < 4; ++d) _Pragma("unroll") for (int i = 0; i < 16; ++i) O[d][i] *= sc; \
                _Pragma("unroll") for (int i = 0; i < 16; ++i) { P0[i] -= dl; P1[i] -= dl; } \
                if (hasn) { asm volatile("s_nop 15\n\ts_nop 7" : "+v"(N0), "+v"(N1)); _Pragma("unroll") for (int i = 0; i < 16; ++i) { N0[i] -= dl; N1[i] -= dl; } } \
                m += dl; } \
            float ps = 0.f, ps2 = 0.f; \
            _Pragma("unroll") for (int i = 0; i < 16; ++i) { P0[i] = __builtin_amdgcn_exp2f(P0[i]); P1[i] = __builtin_amdgcn_exp2f(P1[i]); ps += P0[i]; ps2 += P1[i]; } \
            lsum += ps + ps2; \
            bf16x8 pb[4]; \
            { u32x4 w; w.x = pk2(P0[0], P0[1]); w.y = pk2(P0[2], P0[3]); w.z = pk2(P0[4], P0[5]); w.w = pk2(P0[6], P0[7]); pb[0] = __builtin_bit_cast(bf16x8, w); \
              w.x = pk2(P0[8], P0[9]); w.y = pk2(P0[10], P0[11]); w.z = pk2(P0[12], P0[13]); w.w = pk2(P0[14], P0[15]); pb[1] = __builtin_bit_cast(bf16x8, w); \
              w.x = pk2(P1[0], P1[1]); w.y = pk2(P1[2], P1[3]); w.z = pk2(P1[4], P1[5]); w.w = pk2(P1[6], P1[7]); pb[2] = __builtin_bit_cast(bf16x8, w); \
              w.x = pk2(P1[8], P1[9]); w.y = pk2(P1[10], P1[11]); w.z = pk2(P1[12], P1[13]); w.w = pk2(P1[14], P1[15]); pb[3] = __builtin_bit_cast(bf16x8, w); } \
            u32x4 va[4]; \
            AT_LDV(va, vs_, 0); AT_SB(); AT_PV(va, 0); AT_SB(); AT_LDV(va, vs_, 1); AT_SB(); AT_PV(va, 1); AT_SB(); AT_LDV(va, vs_, 2); AT_SB(); AT_PV(va, 2); AT_SB(); AT_LDV(va, vs_, 3); AT_SB(); AT_PV(va, 3); AT_SB(); } while (0)
        f32x16 pA0, pA1, pB0, pB1;
        AT_DMA_K(0, 0); AT_DMA_V(0, 0); AT_DMA_K(1, 1);
        AT_BAR();
        AT_QK(pA0, pA1, 0);
        asm volatile("s_waitcnt lgkmcnt(0)\n\ts_barrier" ::: "memory");
        for (int t = 0; t < NT; t += 2) {
            if (t + 2 < NT) AT_DMA_K(t + 2, 0);
            AT_DMA_V(t + 1, 1);
            AT_SB(); AT_QK(pB0, pB1, 1); AT_SB();
            AT_SOFTPV(pA0, pA1, pB0, pB1, t == 0, true, 0);
            AT_BAR();
            if (t + 3 < NT) AT_DMA_K(t + 3, 1);
            if (t + 2 < NT) AT_DMA_V(t + 2, 0);
            AT_SB(); if (t + 2 < NT) { AT_QK(pA0, pA1, 0); } AT_SB();
            AT_SOFTPV(pB0, pB1, pA0, pA1, false, t + 2 < NT, 1);
            AT_BAR();
        }
#undef AT_DMA_K
#undef AT_DMA_V
#undef AT_BAR
#undef AT_SB
#undef AT_QK
#undef AT_LDV
#undef AT_PV
#undef AT_SOFTPV
        const float ltot = lsum + __shfl_xor(lsum, 32);
        const float invl = 1.f / ltot;
        if (map == 1) { const float f = lam * invl;
#pragma unroll
            for (int d = 0; d < 4; ++d)
#pragma unroll
                for (int i = 0; i < 16; ++i) xch[(qw * 64 + d * 16 + i) * 64 + C.lane] = O[d][i] * f; }
        __syncthreads();
        if (map == 0) { float ss = 0.f;
#pragma unroll
            for (int d = 0; d < 4; ++d)
#pragma unroll
                for (int i = 0; i < 16; ++i) { const float o = O[d][i] * invl - xch[(qw * 64 + d * 16 + i) * 64 + C.lane]; O[d][i] = o; ss += o * o; }
            ss += __shfl_xor(ss, 32);
            const float rn = rsqrtf(ss * (1.f / 128.f) + RMS_EPS) * (1.f - lam_init);
            bf16_t* orow = A2 + (size_t)(qrow0 + qw * 32 + r32) * DM + h * 128;
#pragma unroll
            for (int d = 0; d < 4; ++d)
#pragma unroll
                for (int g4 = 0; g4 < 4; ++g4) { const int dd = 32 * d + 8 * g4 + 4 * hi; const f32x4 sg = *(const f32x4*)(subg + dd);
                    const f32x4 v = {O[d][4 * g4] * rn * sg[0], O[d][4 * g4 + 1] * rn * sg[1], O[d][4 * g4 + 2] * rn * sg[2], O[d][4 * g4 + 3] * rn * sg[3]};
                    st4bf(orow + dd, v); } }
        __syncthreads();
    }
}

__device__ __forceinline__ void phase_rt(const Ctx& C, const Args& A, int l) {
    unsigned char* ws = A.ws; float* X = (float*)(ws + WS_X); bf16_t* H = (bf16_t*)(ws + WS_H); float* AFF = (float*)(ws + WS_AFF); float* STAT = (float*)(ws + WS_P);
    const float* MOD = (const float*)(ws + WS_MOD) + (size_t)l * 5 * 6144;
    const float* lng = A.in[I_LNG] + (size_t)(l * 2 + 0) * DM; const float* lnb = A.in[I_LNB] + (size_t)(l * 2 + 0) * DM;
    LAS float* wrs = (LAS float*)C.lds;
    { const float* wr = A.in[I_WR] + (size_t)l * DM * 16; for (int i = C.tid; i < DM * 16; i += NTHR) wrs[(i & 15) * 1024 + (i >> 4)] = wr[i]; }
    __syncthreads();
    const int row0 = (int)(((long)C.gw * MROWS) / C.NGW), row1 = (int)(((long)(C.gw + 1) * MROWS) / C.NGW);
    f32x4 lngr[4], lnbr[4], scr[4], shr[4]; int cmi = -1;
#pragma unroll
    for (int j = 0; j < 4; ++j) { const int col = 4 * C.lane + 256 * j; lngr[j] = *(const f32x4*)(lng + col); lnbr[j] = *(const f32x4*)(lnb + col); scr[j] = lngr[j]; shr[j] = lngr[j]; }
    f32x4 xn[4];
    if (row0 < row1) {
#pragma unroll
        for (int j = 0; j < 4; ++j) xn[j] = *(const f32x4*)(X + (size_t)row0 * DM + 4 * C.lane + 256 * j); }
    for (int row = row0; row < row1; ++row) {
        const int mi = row_mi(row);
        if (mi != cmi) { cmi = mi; const float* md = MOD + mi * 6144;
#pragma unroll
            for (int j = 0; j < 4; ++j) { const int col = 4 * C.lane + 256 * j; scr[j] = *(const f32x4*)(md + 4 * DM + col) + 1.f; shr[j] = *(const f32x4*)(md + 3 * DM + col); } }
        f32x4 x[4]; float s = 0.f;
#pragma unroll
        for (int j = 0; j < 4; ++j) { x[j] = xn[j]; s += (x[j][0] + x[j][1]) + (x[j][2] + x[j][3]); }
        if (row + 1 < row1) {
#pragma unroll
            for (int j = 0; j < 4; ++j) xn[j] = *(const f32x4*)(X + (size_t)(row + 1) * DM + 4 * C.lane + 256 * j); }
        const float mean = wave_sum(s) * (1.f / DM); float s2 = 0.f;
#pragma unroll
        for (int j = 0; j < 4; ++j) { x[j] = x[j] - mean; s2 += (x[j][0] * x[j][0] + x[j][1] * x[j][1]) + (x[j][2] * x[j][2] + x[j][3] * x[j][3]); }
        const float rstd = rsqrtf(wave_sum(s2) * (1.f / DM) + LN_EPS);
        if (C.lane == 0) *(f32x2*)(STAT + (size_t)row * 2) = (f32x2){mean, rstd};
        float v[16];
#pragma unroll
        for (int e = 0; e < 16; ++e) v[e] = 0.f;
#pragma unroll
        for (int j = 0; j < 4; ++j) { const int col = 4 * C.lane + 256 * j;
            const f32x4 x1 = x[j] * rstd * lngr[j] + lnbr[j];
            const f32x4 h = x1 * scr[j] + shr[j];
            st4bf(H + (size_t)row * DM + col, h);
#pragma unroll
            for (int e = 0; e < 16; ++e) { const f32x4 w = *(const LAS f32x4*)(wrs + e * 1024 + col); v[e] += (h[0] * w[0] + h[1] * w[1]) + (h[2] * w[2] + h[3] * w[3]); }
            __builtin_amdgcn_sched_barrier(0); }
#pragma unroll
        for (int i = 0; i < 8; ++i) { const float send = (C.lane & 32) ? v[i] : v[i + 8], keep = (C.lane & 32) ? v[i + 8] : v[i]; v[i] = keep + __shfl_xor(send, 32); }
#pragma unroll
        for (int i = 0; i < 4; ++i) { const float send = (C.lane & 16) ? v[i] : v[i + 4], keep = (C.lane & 16) ? v[i + 4] : v[i]; v[i] = keep + __shfl_xor(send, 16); }
#pragma unroll
        for (int i = 0; i < 2; ++i) { const float send = (C.lane & 8) ? v[i] : v[i + 2], keep = (C.lane & 8) ? v[i + 2] : v[i]; v[i] = keep + __shfl_xor(send, 8); }
        { const float send = (C.lane & 4) ? v[0] : v[1], keep = (C.lane & 4) ? v[1] : v[0]; v[0] = keep + __shfl_xor(send, 4); }
        float z = v[0]; z += __shfl_xor(z, 1); z += __shfl_xor(z, 2);
        float mx = z;
#pragma unroll
        for (int o = 4; o < 64; o <<= 1) mx = fmaxf(mx, __shfl_xor(mx, o));
        const float ex = expf(z - mx); float sm = ex;
#pragma unroll
        for (int o = 4; o < 64; o <<= 1) sm += __shfl_xor(sm, o);
        if ((C.lane & 3) == 0) AFF[(size_t)row * 16 + (C.lane >> 2)] = ex / sm;
    }
}

__device__ __forceinline__ void phase_tk(const Ctx& C, const Args& A) {
    unsigned char* ws = A.ws; const float* AFF = (const float*)(ws + WS_AFF); int* SLOT = (int*)(ws + WS_SLOT); int* IDX = (int*)(ws + WS_IDX); float* GATE = (float*)(ws + WS_GATE);
    LAS unsigned* key = (LAS unsigned*)C.lds;
    LAS unsigned* hist = key + 8192;
    LAS unsigned* scn = hist + 256;
    LAS unsigned* wtot = scn + 256;
    LAS unsigned* bc = wtot + 8;
    for (int u = blockIdx.x; u < 128; u += C.G) {
        const bool isctx = u >= 64; const int uu = u & 63, b = uu >> 4, e = uu & 15;
        const int n = isctx ? CTXL : TT, cap = isctx ? CAP_C : CAP_L;
        const int row0 = isctx ? NLAT + b * CTXL : b * TT;
        const int slot0 = e * ESLOTS + (isctx ? 4 * CAP_L + b * CAP_C : b * CAP_L);
        for (int i = C.tid; i < n; i += NTHR) key[i] = __float_as_uint(AFF[(size_t)(row0 + i) * 16 + e]);
        unsigned prefix = 0u, pmask = 0u; int need = cap;
        for (int pass = 0; pass < 4; ++pass) {
            const int shift = 24 - 8 * pass;
            if (C.tid < 256) hist[C.tid] = 0u;
            __syncthreads();
            for (int i = C.tid; i < n; i += NTHR) { const unsigned k = key[i]; if ((k & pmask) == prefix) __hip_atomic_fetch_add(&hist[(k >> shift) & 255u], 1u, __ATOMIC_RELAXED, __HIP_MEMORY_SCOPE_WORKGROUP); }
            __syncthreads();
            {
                const unsigned hd = (C.tid < 256) ? hist[255 - C.tid] : 0u; unsigned inc = hd;
#pragma unroll
                for (int o = 1; o < 64; o <<= 1) { const unsigned t = __shfl_up(inc, o); if (C.lane >= o) inc += t; }
                if (C.tid < 256 && C.lane == 63) wtot[C.wave] = inc;
                __syncthreads();
                if (C.tid < 256) { unsigned base = 0u; for (int w = 0; w < C.wave; ++w) base += wtot[w];
                    const unsigned incl = base + inc, above = incl - hd;
                    if (incl >= (unsigned)need && above < (unsigned)need) { bc[0] = (unsigned)(255 - C.tid); bc[1] = (unsigned)need - above; } }
            }
            __syncthreads();
            prefix |= bc[0] << shift; pmask |= 255u << shift; need = (int)bc[1];
            __syncthreads();
        }
        const int per = (n + NTHR - 1) / NTHR; const int i0 = C.tid * per;
        unsigned cg = 0u, ce = 0u;
        for (int j = 0; j < per; ++j) { const int i = i0 + j; if (i < n) { const unsigned k = key[i]; cg += (k > prefix); ce += (k == prefix); } }
        unsigned pk = cg | (ce << 16), inc = pk;
#pragma unroll
        for (int o = 1; o < 64; o <<= 1) { const unsigned t = __shfl_up(inc, o); if (C.lane >= o) inc += t; }
        if (C.lane == 63) wtot[C.wave] = inc;
        __syncthreads();
        unsigned wbase = 0u;
        for (int w = 0; w < C.wave; ++w) wbase += wtot[w];
        const unsigned excl = wbase + inc - pk;
        unsigned rg = excl & 0xffffu, re = excl >> 16;
        const int ngt = cap - need;
        for (int j = 0; j < per; ++j) { const int i = i0 + j; if (i < n) { const unsigned k = key[i]; int pos = -1;
            if (k > prefix) { pos = (int)rg; ++rg; } else if (k == prefix) { if ((int)re < need) pos = ngt + (int)re; ++re; }
            const int row = row0 + i;
            if (pos >= 0) { IDX[slot0 + pos] = row; GATE[slot0 + pos] = __uint_as_float(k); SLOT[(size_t)row * 16 + e] = slot0 + pos; }
            else SLOT[(size_t)row * 16 + e] = -1; } }
        if (isctx && b == 0 && C.tid < ESLOTS - 4224) { IDX[e * ESLOTS + 4224 + C.tid] = 0; GATE[e * ESLOTS + 4224 + C.tid] = 0.f; }
        __syncthreads();
    }
}

__device__ __forceinline__ void phase_cb(const Ctx& C, const Args& A, int l) {
    unsigned char* ws = A.ws; float* X = (float*)(ws + WS_X); bf16_t* H = (bf16_t*)(ws + WS_H); const int* SLOT = (const int*)(ws + WS_SLOT); const bf16_t* YE = (const bf16_t*)(ws + WS_YE);
    const float* MOD = (const float*)(ws + WS_MOD) + (size_t)l * 5 * 6144; const float* MODN = MOD + 5 * 6144;
    const float* lng = A.in[I_LNG] + (size_t)(l * 2 + 1) * DM; const float* lnb = A.in[I_LNB] + (size_t)(l * 2 + 1) * DM;
    const float* lng1 = A.in[I_LNG] + (size_t)(l * 2 + 0) * DM; const float* lnb1 = A.in[I_LNB] + (size_t)(l * 2 + 0) * DM; const float* STAT = (const float*)(ws + WS_P);
    const int row0 = (int)(((long)C.gw * MROWS) / C.NGW), row1 = (int)(((long)(C.gw + 1) * MROWS) / C.NGW);
    f32x4 lngr[4], lnbr[4], gfr[4], nsc[4], nsh[4], l1g[4], l1b[4]; int cmi = -1;
#pragma unroll
    for (int j = 0; j < 4; ++j) { const int col = 4 * C.lane + 256 * j; lngr[j] = *(const f32x4*)(lng + col); lnbr[j] = *(const f32x4*)(lnb + col); gfr[j] = lngr[j]; nsc[j] = lngr[j]; nsh[j] = lngr[j];
        l1g[j] = *(const f32x4*)(lng1 + col); l1b[j] = *(const f32x4*)(lnb1 + col); }
    int svn = -1; f32x4 xn[4]; f32x2 stn = {0.f, 0.f};
    if (row0 < row1) { svn = SLOT[(size_t)row0 * 16 + (C.lane & 15)]; stn = *(const f32x2*)(STAT + (size_t)row0 * 2);
#pragma unroll
        for (int j = 0; j < 4; ++j) xn[j] = *(const f32x4*)(X + (size_t)row0 * DM + 4 * C.lane + 256 * j); }
    for (int row = row0; row < row1; ++row) {
        const int mi = row_mi(row);
        if (mi != cmi) { cmi = mi; const float* md = MOD + mi * 6144; const float* mn = MODN + mi * 6144;
#pragma unroll
            for (int j = 0; j < 4; ++j) { const int col = 4 * C.lane + 256 * j; gfr[j] = *(const f32x4*)(md + 5 * DM + col);
                if (l < DEPTH - 1) { nsc[j] = *(const f32x4*)(mn + DM + col) + 1.f; nsh[j] = *(const f32x4*)(mn + col); } } }
        const int sv = svn;
        unsigned mask = (unsigned)__ballot(sv >= 0) & 0xffffu;
        f32x4 acc[4];
#pragma unroll
        for (int j = 0; j < 4; ++j) acc[j] = (f32x4){0.f, 0.f, 0.f, 0.f};
        u32x2 y0[4], y1[4]; bool h0 = false, h1 = false;
        if (mask) { const int e = __builtin_ctz(mask); mask &= mask - 1; h0 = true; const int sl = __builtin_amdgcn_readlane(sv, e);
#pragma unroll
            for (int j = 0; j < 4; ++j) y0[j] = *(const u32x2*)(YE + (size_t)sl * DM + 4 * C.lane + 256 * j); }
        if (mask) { const int e = __builtin_ctz(mask); mask &= mask - 1; h1 = true; const int sl = __builtin_amdgcn_readlane(sv, e);
#pragma unroll
            for (int j = 0; j < 4; ++j) y1[j] = *(const u32x2*)(YE + (size_t)sl * DM + 4 * C.lane + 256 * j); }
        f32x4 x[4]; const f32x2 st = stn;
#pragma unroll
        for (int j = 0; j < 4; ++j) x[j] = xn[j];
        if (row + 1 < row1) { svn = SLOT[(size_t)(row + 1) * 16 + (C.lane & 15)]; stn = *(const f32x2*)(STAT + (size_t)(row + 1) * 2);
#pragma unroll
            for (int j = 0; j < 4; ++j) xn[j] = *(const f32x4*)(X + (size_t)(row + 1) * DM + 4 * C.lane + 256 * j); }
        if (h0) {
#pragma unroll
            for (int j = 0; j < 4; ++j) acc[j] += (f32x4){__uint_as_float(y0[j].x << 16), __uint_as_float(y0[j].x & 0xffff0000u), __uint_as_float(y0[j].y << 16), __uint_as_float(y0[j].y & 0xffff0000u)}; }
        if (h1) {
#pragma unroll
            for (int j = 0; j < 4; ++j) acc[j] += (f32x4){__uint_as_float(y1[j].x << 16), __uint_as_float(y1[j].x & 0xffff0000u), __uint_as_float(y1[j].y << 16), __uint_as_float(y1[j].y & 0xffff0000u)}; }
        while (mask) { const int e = __builtin_ctz(mask); mask &= mask - 1; const int sl = __builtin_amdgcn_readlane(sv, e);
#pragma unroll
            for (int j = 0; j < 4; ++j) acc[j] += ld4bf(YE + (size_t)sl * DM + 4 * C.lane + 256 * j); }
        float sm = 0.f;
#pragma unroll
        for (int j = 0; j < 4; ++j) { x[j] = ((x[j] - st[0]) * st[1] * l1g[j] + l1b[j]) * ALPHA_DN + gfr[j] * acc[j];
            sm += (x[j][0] + x[j][1]) + (x[j][2] + x[j][3]); }
        const float mean = wave_sum(sm) * (1.f / DM); float s2 = 0.f;
#pragma unroll
        for (int j = 0; j < 4; ++j) { x[j] = x[j] - mean; s2 += (x[j][0] * x[j][0] + x[j][1] * x[j][1]) + (x[j][2] * x[j][2] + x[j][3] * x[j][3]); }
        const float rstd = rsqrtf(wave_sum(s2) * (1.f / DM) + LN_EPS);
#pragma unroll
        for (int j = 0; j < 4; ++j) { const int col = 4 * C.lane + 256 * j;
            const f32x4 x2 = x[j] * rstd * lngr[j] + lnbr[j];
            if (l < DEPTH - 1) { *(f32x4*)(X + (size_t)row * DM + col) = x2; st4bf(H + (size_t)row * DM + col, x2 * nsc[j] + nsh[j]); }
            else if (row < NLAT) *(f32x4*)(A.out + (size_t)row * DM + col) = x2; }
    }
}


#ifndef GEMM_NOINLINE
#define GEMM_NOINLINE 0
#endif
#if GEMM_NOINLINE
#define GEMM_FN __device__ __noinline__
#else
#define GEMM_FN __device__ __forceinline__
#endif
GEMM_FN void gphase_in(LAS unsigned char* lds, unsigned char* ws, int nN, int G) {
    int bx = blockIdx.x; asm volatile("" : "+s"(bx), "+s"(G));
    pg8::Gemm g{(const bf16_t*)(ws + WS_H), (const bf16_t*)(ws + WS_WIN), DM}; pg8::Order<0> S; S.init(MROWS / 256, nN, G, bx, nullptr, 0);
    pg8::EpiBf16 E{(bf16_t*)(ws + WS_P), P_LD}; pg8::gemm_phase(lds, g, S, E); }
GEMM_FN void gphase_in_odd(LAS unsigned char* lds, unsigned char* ws, int G) {
    int bx = blockIdx.x; asm volatile("" : "+s"(bx), "+s"(G));
    pg8::Gemm g{(const bf16_t*)(ws + WS_H), (const bf16_t*)(ws + WS_WIN), DM}; pg8::Order<0> S; S.init(MROWS / 256, D_IN_ODD / 256, G, bx, nullptr, 0);
    pg8::EpiOdd E{(bf16_t*)(ws + WS_P), (bf16_t*)(ws + WS_Q), (bf16_t*)(ws + WS_KA), (const float*)(ws + WS_ROPE)}; pg8::gemm_phase(lds, g, S, E); }
GEMM_FN void gphase_lora(LAS unsigned char* lds, unsigned char* ws, const float* d0, const float* a0, const float* kal, int G) {
    int bx = blockIdx.x; asm volatile("" : "+s"(bx), "+s"(G));
    pg8::Gemm g{(const bf16_t*)(ws + WS_LIN), (const bf16_t*)(ws + WS_WLORA), LORA_K}; pg8::Order<0> S; S.init(MROWS / 256, LORA_N / 256, G, bx, nullptr, 0);
    pg8::EpiLora E{ws + WS_SCN, (bf16_t*)(ws + WS_G), d0, a0, kal}; pg8::gemm_phase(lds, g, S, E); }
GEMM_FN void gphase_out(LAS unsigned char* lds, unsigned char* ws, const float* modl, int G, const float* xin, const float* cin) {
    int bx = blockIdx.x; asm volatile("" : "+s"(bx), "+s"(G));
    pg8::Gemm g{(const bf16_t*)(ws + WS_A2), (const bf16_t*)(ws + WS_WOUT), DM}; pg8::Order<0> S; S.init(MROWS / 256, DM / 256, G, bx, nullptr, 0);
    pg8::EpiRes E{(float*)(ws + WS_X), modl, xin, cin}; pg8::gemm_phase(lds, g, S, E); }
GEMM_FN void gphase_e1(LAS unsigned char* lds, unsigned char* ws, int G, int l) {
    int bx = blockIdx.x; asm volatile("" : "+s"(bx), "+s"(G));
    pg8::Gemm g{(const bf16_t*)(ws + WS_H), (const bf16_t*)(ws + WS_WE13 + (size_t)(l & 1) * WE13_BYTES), DM}; pg8::EpiSwiGLU E{(bf16_t*)(ws + WS_HID)};
    pg8::OrderExp<1> S; S.init(4096 / 256, G, bx, (const int*)(ws + WS_IDX), (long)4096 * DM); pg8::gemm_phase(lds, g, S, E); }
GEMM_FN void gphase_e2(LAS unsigned char* lds, unsigned char* ws, int G, int l) {
    int bx = blockIdx.x; asm volatile("" : "+s"(bx), "+s"(G));
    pg8::Gemm g{(const bf16_t*)(ws + WS_HID), (const bf16_t*)(ws + WS_WE2 + (size_t)(l & 1) * WE2_BYTES), D_EXP}; pg8::EpiYE E{(bf16_t*)(ws + WS_YE), (const float*)(ws + WS_GATE)};
    pg8::OrderExp<2> S; S.init(DM / 256, G, bx, nullptr, (long)DM * D_EXP); pg8::gemm_phase(lds, g, S, E); }

constexpr int NSLOT = 13;
constexpr int NSTEP = 1 + DEPTH * NSLOT;
__global__ void __launch_bounds__(NTHR, 2) mk_fwd(Args KA) {
    extern __shared__ __attribute__((aligned(16))) unsigned char lds_raw[];
    volatile LAS unsigned* MISC = (volatile LAS unsigned*)((LAS unsigned char*)lds_raw + LDS_MISC);
    if (threadIdx.x < 16) MISC[threadIdx.x] = 0u;
    if (threadIdx.x == 0) { LAS unsigned long long* tb = (LAS unsigned long long*)((LAS unsigned char*)lds_raw + LDS_PTAB);
#pragma unroll
        for (int i = 0; i < 37; ++i) tb[i] = (unsigned long long)KA.in[i];
        tb[37] = (unsigned long long)KA.out; tb[38] = (unsigned long long)KA.ws; }
    __syncthreads();
    const int lo = KA.lo, hi = KA.hi;
    unsigned bar_x = 0;
    if (hi - lo > 1) { const XcdBarrier b0 = xcd_barrier_post((unsigned*)(KA.ws + WS_CTL), MISC); bar_x = b0.x; }
#ifndef PH_MASK
#define PH_MASK 0xFFFFFF
#endif
#ifndef REP_MASK
#define REP_MASK 0
#endif
#define PH_BIT(k) (((k) == 0) ? 0 : 1 + ((k) - 1) % NSLOT + (((k) - 1) % NSLOT >= 2 && ((k) - 1) % NSLOT <= 3 && odd ? 12 : 0))
#define RUN(k, ...) do { if (((PH_MASK >> PH_BIT(k)) & 1) && lo <= (k) && (k) < hi) { const int nrep = ((REP_MASK >> PH_BIT(k)) & 1) ? 2 : 1; \
        _Pragma("unroll 1") for (int rep = 0; rep < nrep; ++rep) { \
        Ctx C; mkctx(C, (LAS unsigned char*)lds_raw); Args A; ldargs(A, (LAS unsigned char*)lds_raw); unsigned char* ws = A.ws; \
        const float* MODL = (const float*)(ws + WS_MOD) + (size_t)l * 5 * 6144; (void)MODL; \
        __VA_ARGS__; if ((k) + 1 < hi || rep + 1 < nrep) { XcdBarrier bar; bar.bar = (unsigned*)(ws + WS_CTL); bar.x = bar_x; bar.st = MISC; xcd_barrier(bar); } } } } while (0)
    { const bool odd = false; const int l = 0; RUN(0, { phase_init(C, A); __syncthreads(); conv_items(C, A, 0, C.gw, C.NGW, true, true, true); }); }
#pragma unroll 1
    for (int l = 0; l < DEPTH; ++l) {
        const int sb = 1 + l * NSLOT; const bool odd = l & 1;
        if (!(CHUNKED_SCAN && odd)) { RUN(sb + 0, { phase_conv(C, A, l); if (l == 0) phase_modh(C, A, 0); }); }
        if (odd) { RUN(sb + 1, { gphase_in_odd(C.lds, ws, C.G);
                   const int tail = ((MROWS / 256) * (D_IN_ODD / 256)) % C.G;
                   if (CHUNKED_SCAN && l + 1 < DEPTH && tail > 0 && (int)blockIdx.x >= tail) conv_items(C, A, l + 1, ((int)blockIdx.x - tail) * NWAVES + C.wave, (C.G - tail) * NWAVES, false, false, true, 0, YW_IN_HI); }); }
        else { RUN(sb + 1, { gphase_in(C.lds, ws, D_IN_EVEN_PAD / 256, C.G);
                   const int tail = ((MROWS / 256) * (D_IN_EVEN_PAD / 256)) % C.G;
                   if (CHUNKED_SCAN && l + 1 < DEPTH && tail > 0 && (int)blockIdx.x >= tail) conv_items(C, A, l + 1, ((int)blockIdx.x - tail) * NWAVES + C.wave, (C.G - tail) * NWAVES, false, false, true, 0, XW_IN_HI); }); }
        if (!odd) {
            RUN(sb + 2, phase_ef1(C, A, l));
            RUN(sb + 3, { const int i2 = l >> 1; gphase_lora(C.lds, ws, A.in[I_D0] + (size_t)i2 * 2 * 768, A.in[I_A0] + (size_t)i2 * 2 * 768, A.in[I_KAL] + (size_t)i2 * 768, C.G); });
#if CHUNKED_SCAN
            RUN(sb + 4, phase_csa(C, A));
            RUN(sb + 5, phase_csb(C, A, l));
#else
            RUN(sb + 4, phase_scan(C, A));
#endif
            RUN(sb + 6, phase_ef2(C, A, l));
        } else {
            RUN(sb + 2, { phase_of1(C, A, l);
                   const int busy2 = 256 + 8 * 7 - C.G;
                   if (CHUNKED_SCAN && l + 1 < DEPTH && busy2 > 0 && (int)blockIdx.x >= busy2) conv_items(C, A, l + 1, ((int)blockIdx.x - busy2) * NWAVES + C.wave, (C.G - busy2) * NWAVES, false, false, true, YW_IN_HI, YW_OF_HI); });
            RUN(sb + 3, phase_attn(C, A, l));
        }
        RUN(sb + 7, { gphase_out(C.lds, ws, MODL, C.G, l == 0 ? A.in[I_X] : (const float*)(ws + WS_X), l == 0 ? A.in[I_CTX] : (const float*)(ws + WS_X) + (size_t)NLAT * DM);
                   const int tail = ((MROWS / 256) * (DM / 256)) % C.G;
                   if (CHUNKED_SCAN && l + 1 < DEPTH && tail > 0 && (int)blockIdx.x >= tail) conv_items(C, A, l + 1, ((int)blockIdx.x - tail) * NWAVES + C.wave, (C.G - tail) * NWAVES, false, false, true, odd ? YW_OF_HI : XW_IN_HI, odd ? YW_OUT_HI : XW_OUT_HI); });
        RUN(sb + 8, phase_rt(C, A, l));
        RUN(sb + 9, { phase_tk(C, A);
                   if (CHUNKED_SCAN && l + 1 < DEPTH && (int)blockIdx.x >= 128) conv_items(C, A, l + 1, ((int)blockIdx.x - 128) * NWAVES + C.wave, (C.G - 128) * NWAVES, false, false, true, odd ? YW_OUT_HI : XW_OUT_HI, odd ? YW_TK_HI : XW_TK_HI); });
        RUN(sb + 10, gphase_e1(C.lds, ws, C.G, l));
        RUN(sb + 11, gphase_e2(C.lds, ws, C.G, l));
        RUN(sb + 12, { phase_cb(C, A, l); if (CHUNKED_SCAN && !odd && l + 1 < DEPTH) { __syncthreads(); conv_items(C, A, l + 1, C.gw, C.NGW, false, true, false); } });
    }
#undef RUN
}

#ifdef PHASE_PROBE
#define PROBE_PRE extern __shared__ __attribute__((aligned(16))) unsigned char lds_raw[]; Ctx C; mkctx(C, (LAS unsigned char*)lds_raw); unsigned char* ws = A.ws; (void)ws;
__global__ void __launch_bounds__(NTHR, 2) pr_init(Args A) { PROBE_PRE phase_init(C, A); }
__global__ void __launch_bounds__(NTHR, 2) pr_conv(Args A) { PROBE_PRE phase_conv(C, A, A.lo); }
__global__ void __launch_bounds__(NTHR, 2) pr_modh(Args A) { PROBE_PRE phase_modh(C, A, A.lo); }
__global__ void __launch_bounds__(NTHR, 2) pr_ef1(Args A) { PROBE_PRE phase_ef1(C, A, A.lo); }
__global__ void __launch_bounds__(NTHR, 2) pr_scan(Args A) { PROBE_PRE phase_scan(C, A); }
__global__ void __launch_bounds__(NTHR, 2) pr_ef2(Args A) { PROBE_PRE phase_ef2(C, A, A.lo); }
__global__ void __launch_bounds__(NTHR, 2) pr_csa(Args A) { PROBE_PRE phase_csa(C, A); }
__global__ void __launch_bounds__(NTHR, 2) pr_csb(Args A) { PROBE_PRE phase_csb(C, A, A.lo); }
__global__ void __launch_bounds__(NTHR, 2) pr_of1(Args A) { PROBE_PRE phase_of1(C, A, A.lo); }
__global__ void __launch_bounds__(NTHR, 2) pr_attn(Args A) { PROBE_PRE phase_attn(C, A, A.lo); }
__global__ void __launch_bounds__(NTHR, 2) pr_rt(Args A) { PROBE_PRE phase_rt(C, A, A.lo); }
__global__ void __launch_bounds__(NTHR, 2) pr_tk(Args A) { PROBE_PRE phase_tk(C, A); }
__global__ void __launch_bounds__(NTHR, 2) pr_cb(Args A) { PROBE_PRE phase_cb(C, A, A.lo); }
__global__ void __launch_bounds__(NTHR, 2) pr_gemm_in(Args A) { PROBE_PRE pg8::Gemm g{(const bf16_t*)(ws + WS_H), (const bf16_t*)(ws + WS_WIN), DM}; pg8::Order<0> S; S.init(MROWS / 256, A.lo, C.G, (int)blockIdx.x, nullptr, 0);
                      pg8::EpiBf16 E{(bf16_t*)(ws + WS_P), P_LD}; pg8::gemm_phase(C.lds, g, S, E); }
__global__ void __launch_bounds__(NTHR, 2) pr_gemm_lora(Args A) { PROBE_PRE pg8::Gemm g{(const bf16_t*)(ws + WS_LIN), (const bf16_t*)(ws + WS_WLORA), LORA_K}; pg8::Order<0> S; S.init(MROWS / 256, LORA_N / 256, C.G, (int)blockIdx.x, nullptr, 0);
                          const int i2 = A.lo; pg8::EpiLora E{ws + WS_SCN, (bf16_t*)(ws + WS_G), A.in[I_D0] + (size_t)i2 * 2 * 768, A.in[I_A0] + (size_t)i2 * 2 * 768, A.in[I_KAL] + (size_t)i2 * 768};
                          pg8::gemm_phase(C.lds, g, S, E); }
__global__ void __launch_bounds__(NTHR, 2) pr_gemm_out(Args A) { PROBE_PRE pg8::Gemm g{(const bf16_t*)(ws + WS_A2), (const bf16_t*)(ws + WS_WOUT), DM}; pg8::Order<0> S; S.init(MROWS / 256, DM / 256, C.G, (int)blockIdx.x, nullptr, 0);
                      pg8::EpiRes E{(float*)(ws + WS_X), (const float*)(ws + WS_MOD), (const float*)(ws + WS_X), (const float*)(ws + WS_X) + (size_t)NLAT * DM}; pg8::gemm_phase(C.lds, g, S, E); }
__global__ void __launch_bounds__(NTHR, 2) pr_gemm_e1(Args A) { PROBE_PRE pg8::Gemm g{(const bf16_t*)(ws + WS_H), (const bf16_t*)(ws + WS_WE13), DM}; pg8::Order<1> S; S.init(NEXP * 17, 4096 / 256, C.G, (int)blockIdx.x, (const int*)(ws + WS_IDX), (long)4096 * DM);
                      pg8::EpiSwiGLU E{(bf16_t*)(ws + WS_HID)}; pg8::gemm_phase(C.lds, g, S, E); }
__global__ void __launch_bounds__(NTHR, 2) pr_gemm_e2(Args A) { PROBE_PRE pg8::Gemm g{(const bf16_t*)(ws + WS_HID), (const bf16_t*)(ws + WS_WE2), D_EXP}; pg8::Order<2> S; S.init(NEXP * 17, DM / 256, C.G, (int)blockIdx.x, nullptr, (long)DM * D_EXP);
                       pg8::EpiYE E{(bf16_t*)(ws + WS_YE), (const float*)(ws + WS_GATE)}; pg8::gemm_phase(C.lds, g, S, E); }
#endif

extern "C" void kernel_launch(void* const* d_in, const int* in_sizes, int n_in, void* d_out, int out_size, void* d_ws, size_t ws_size, hipStream_t stream) {
    static int grid = 0;
    if (grid == 0) {
        if (n_in != 37 || out_size != NLAT * DM || ws_size < WS_END) { fprintf(stderr, "kernel_launch: unexpected shapes: n_in %d out %d ws %zu (need %zu)\n", n_in, out_size, ws_size, (size_t)WS_END); grid = -1; return; }
        int dev = 0, cus = 0, per_cu = 0;
        if (hipGetDevice(&dev) != hipSuccess || hipDeviceGetAttribute(&cus, hipDeviceAttributeMultiprocessorCount, dev) != hipSuccess) { grid = -1; return; }
        if (hipFuncSetAttribute((const void*)mk_fwd, hipFuncAttributeMaxDynamicSharedMemorySize, LDS_BYTES) != hipSuccess) { fprintf(stderr, "kernel_launch: hipFuncSetAttribute failed\n"); grid = -1; return; }
        if (hipOccupancyMaxActiveBlocksPerMultiprocessor(&per_cu, (const void*)mk_fwd, NTHR, LDS_BYTES) != hipSuccess || per_cu < 1) fprintf(stderr, "kernel_launch: occupancy query reports %d\n", per_cu);
        (void)hipGetLastError();
        grid = cus;
    }
    if (grid < 0) return;
    (void)hipMemsetAsync((char*)d_ws + WS_CTL, 0, CTL_BYTES, stream);
    Args a{};
    for (int i = 0; i < 37; ++i) a.in[i] = (const float*)d_in[i];
    a.out = (float*)d_out; a.ws = (unsigned char*)d_ws;
#if MK_MULTI
    for (int k = 0; k < NSTEP; ++k) {
        if (k >= 1) { const int l = (k - 1) / NSLOT, s = (k - 1) % NSLOT; if ((l & 1) && ((s >= 4 && s <= 6) || (CHUNKED_SCAN && s == 0))) continue; if (!(l & 1) && !CHUNKED_SCAN && s == 5) continue; }
        a.lo = k; a.hi = k + 1;
        hipLaunchKernelGGL(mk_fwd, dim3(grid), dim3(NTHR), LDS_BYTES, stream, a);
    }
#else
    a.lo = 0; a.hi = NSTEP;
    hipLaunchKernelGGL(mk_fwd, dim3(grid), dim3(NTHR), LDS_BYTES, stream, a);
#endif
    const hipError_t le = hipPeekAtLastError();
    if (le != hipSuccess) fprintf(stderr, "kernel_launch: launch failed: %s\n", hipGetErrorName(le));
}
```

```cpp
#include <hip/hip_runtime.h>
#include <cstdio>
#include <cstdint>
#include <cmath>

#ifndef MK_MULTI
#define MK_MULTI 0
#endif
#ifndef CHUNKED_SCAN
#define CHUNKED_SCAN 1
#endif

#define GAS __attribute__((address_space(1)))
#define LAS __attribute__((address_space(3)))
typedef unsigned short bf16_t;
typedef short bf16x8 __attribute__((ext_vector_type(8)));
typedef float f32x4 __attribute__((ext_vector_type(4)));
typedef float f32x2 __attribute__((ext_vector_type(2)));
typedef float f32x16 __attribute__((ext_vector_type(16)));
typedef unsigned u32x4 __attribute__((ext_vector_type(4)));
typedef unsigned u32x2 __attribute__((ext_vector_type(2)));
typedef __bf16 bf16x2_t __attribute__((ext_vector_type(2)));

constexpr int NB = 4, TT = 8192, DM = 1024, NLAT = NB * TT, CTXL = 256, NCTX = NB * CTXL, MROWS = NLAT + NCTX;
constexpr int DEPTH = 4;
constexpr int D_CONV = 256, RW_H = 12, RW_K = 64, D_RWKV = 768, RWKV_COLS = 2688, D_IN_EVEN = 3456, D_IN_EVEN_PAD = 3584;
constexpr int D_DIFF = 768, D_GMLP = 256, D_IN_ODD = 2816;
constexpr int NEXP = 16, D_EXP = 2048, CAP_L = 1024, CAP_C = 32, ESLOTS = 4352;
constexpr int P_LD = 3584;
constexpr int LORA_K = 384, LORA_N = 3840;
constexpr int LKEYS = CTXL + TT;
constexpr float ALPHA_DN = 1.6817928305074290f;
constexpr float DECAY_SCALE = 0.6065306597126334f;
constexpr float GN_EPS = 64e-5f, LN_EPS = 1e-5f, RMS_EPS = 1e-5f;
constexpr float QSCALE = 0.125f * 1.4426950408889634f;

constexpr size_t al256(size_t x) { return (x + 255) & ~(size_t)255; }
constexpr size_t WS_CTL = 0;
constexpr size_t CTL_BYTES = 65536;
constexpr size_t WS_MOD = WS_CTL + CTL_BYTES;
constexpr size_t WS_ROPE = WS_MOD + al256((size_t)DEPTH * 5 * 6144 * 4);
constexpr size_t WS_WIN = WS_ROPE + 32768;
constexpr size_t WS_WOUT = WS_WIN + (size_t)D_IN_EVEN_PAD * DM * 2;
constexpr size_t WS_WLORA = WS_WOUT + (size_t)DM * DM * 2;
constexpr size_t WS_WE13 = WS_WLORA + (size_t)LORA_N * LORA_K * 2;
constexpr size_t WE13_BYTES = (size_t)NEXP * 4096 * DM * 2, WE2_BYTES = (size_t)NEXP * DM * D_EXP * 2;
constexpr size_t WS_WE2 = WS_WE13 + 2 * WE13_BYTES;
constexpr size_t WS_X = WS_WE2 + 2 * WE2_BYTES;
constexpr size_t WS_H = WS_X + (size_t)MROWS * DM * 4;
constexpr size_t WS_A2 = WS_H + (size_t)MROWS * DM * 2;
constexpr size_t WS_P = WS_A2 + (size_t)MROWS * DM * 2;
constexpr size_t WS_AFF = WS_P + (size_t)MROWS * P_LD * 2;
constexpr size_t WS_SLOT = WS_AFF + (size_t)MROWS * 16 * 4;
constexpr size_t WS_IDX = WS_SLOT + (size_t)MROWS * 16 * 4;
constexpr size_t WS_GATE = WS_IDX + al256((size_t)NEXP * ESLOTS * 4);
constexpr size_t WS_R2 = WS_GATE + al256((size_t)NEXP * ESLOTS * 4);
constexpr int SC_REC = 1408, SC_ROW = 12 * SC_REC, SC_W = 0, SC_R = 512, SC_KK = 640, SC_V = 768, SC_B = 896, SC_KR = 1024;
constexpr size_t WS_SCN = WS_R2;
constexpr size_t WS_G = WS_SCN + (size_t)MROWS * SC_ROW;
constexpr size_t WS_LIN = WS_G + (size_t)MROWS * 768 * 2;
constexpr int CS_L = 64, CS_NCH = LKEYS / CS_L, CS_UNITS = NB * RW_H * 2;
constexpr size_t WS_CHK = WS_LIN + (size_t)MROWS * 384 * 2;
constexpr size_t WS_EVEN_END = WS_CHK + (size_t)CS_UNITS * CS_NCH * 32768;
constexpr size_t WS_Y = WS_P;
constexpr size_t WS_Q = WS_R2;
constexpr size_t WS_KA = WS_Q + (size_t)MROWS * 768 * 2;
constexpr size_t WS_VT = WS_KA + (size_t)NB * LKEYS * 768 * 2;
constexpr size_t WS_HID = WS_R2;
constexpr size_t WS_YE = WS_HID + (size_t)NEXP * ESLOTS * D_EXP * 2;
constexpr size_t WS_END = WS_EVEN_END;
static_assert(WS_END <= (size_t)2147483648ull, "workspace over 2 GiB");
static_assert((size_t)2 * MROWS * 768 * 4 <= (size_t)MROWS * P_LD * 2, "Y aliases P");
static_assert(WS_YE + (size_t)NEXP * ESLOTS * DM * 2 <= WS_END, "moe region");

constexpr int LDS_BYTES = 147456;
constexpr int LDS_MISC = 140 * 1024;
constexpr int LDS_PTAB = LDS_MISC + 256;
constexpr int NWAVES = 8, NTHR = 512;

__device__ __forceinline__ unsigned f2bf(float f) { unsigned u = __float_as_uint(f); return (u + 0x7fffu + ((u >> 16) & 1u)) >> 16; }
__device__ __forceinline__ unsigned pk2(float lo, float hi) { f32x2 v = {lo, hi}; bf16x2_t b = __builtin_convertvector(v, bf16x2_t); return __builtin_bit_cast(unsigned, b); }
__device__ __forceinline__ float bflo(unsigned u) { return __uint_as_float(u << 16); }
__device__ __forceinline__ float bfhi(unsigned u) { return __uint_as_float(u & 0xffff0000u); }
__device__ __forceinline__ float bf2f(bf16_t b) { return __uint_as_float((unsigned)b << 16); }
__device__ __forceinline__ float sigmoidf_(float x) { return __builtin_amdgcn_rcpf(1.f + __expf(-x)); }
__device__ __forceinline__ float wave_sum(float v) {
#pragma unroll
    for (int o = 1; o < 64; o <<= 1) v += __shfl_xor(v, o);
    return v;
}
__device__ __forceinline__ float sum16(float v) {
#pragma unroll
    for (int o = 1; o < 16; o <<= 1) v += __shfl_xor(v, o);
    return v;
}
__device__ __forceinline__ f32x4 ld4bf_(const void* p) { const u32x2 u = *(const u32x2*)p; return (f32x4){bflo(u.x), bfhi(u.x), bflo(u.y), bfhi(u.y)}; }
__device__ __forceinline__ void st4bf_(void* p, f32x4 v) { u32x2 o; o.x = pk2(v[0], v[1]); o.y = pk2(v[2], v[3]); *(u32x2*)p = o; }
__device__ __forceinline__ float max3f(float a, float b, float c) { float r; asm("v_max3_f32 %0, %1, %2, %3" : "=v"(r) : "v"(a), "v"(b), "v"(c)); return r; }
__device__ __forceinline__ int crow(int r, int hi) { return (r & 3) + 8 * (r >> 2) + 4 * hi; }
__device__ __forceinline__ f32x2 gelu_pk(f32x2 v) {
    const f32x2 av = __builtin_elementwise_abs(v), d = av * 0.2316418882f + 1.0f;
    f32x2 t; t.x = __builtin_amdgcn_rcpf(d.x); t.y = __builtin_amdgcn_rcpf(d.y);
    f32x2 q = t * 0.5307027145f + (-0.7265760135f); q = q * t + 0.7107068705f; q = q * t + (-0.142248368f); q = q * t + 0.127414796f; q = q * t;
    const f32x2 s = (v * v) * (-0.72134752044f);
    f32x2 e; e.x = __builtin_amdgcn_exp2f(s.x); e.y = __builtin_amdgcn_exp2f(s.y);
    const f32x2 m = v * (q * e), r = v - m;
    f32x2 o; o.x = v.x < 0.f ? m.x : r.x; o.y = v.y < 0.f ? m.y : r.y; return o;
}
__device__ __forceinline__ f32x4 gelu4(f32x4 v) { const f32x2 a = gelu_pk((f32x2){v[0], v[1]}), b = gelu_pk((f32x2){v[2], v[3]}); return (f32x4){a.x, a.y, b.x, b.y}; }
__device__ __forceinline__ float tanh_fast(float x) { return 1.f - 2.f * __builtin_amdgcn_rcpf(1.f + __expf(2.f * x)); }

#define XB_TMO      128
#define XB_XCNT(j)  (256  + 64 * (j))
#define XB_XSUB(j)  (1280 + 64 * (j))
#define XB_XGEN(j)  (2304 + 64 * (j))
#define XB_TOP      3328
#define XB_TOPGEN   3392
#define XCD_BAR_WORDS 3456
#define XB_SPIN_CAP (1u << 20)

__device__ __forceinline__ unsigned xb_ld(unsigned* p)              { return __hip_atomic_load(p, __ATOMIC_RELAXED, __HIP_MEMORY_SCOPE_AGENT); }
__device__ __forceinline__ unsigned xb_add(unsigned* p, unsigned v) { return __hip_atomic_fetch_add(p, v, __ATOMIC_RELAXED, __HIP_MEMORY_SCOPE_AGENT); }
__device__ __forceinline__ unsigned xb_xcc_id() { return (unsigned)__builtin_amdgcn_s_getreg((3 << 11) | 20) & 0xFu; }
#define XB_SPIN(cond, bar) do { unsigned _sp = 0; while (cond) { __builtin_amdgcn_s_sleep(1); \
    if ((++_sp & 255u) == 0u) { if (xb_ld(&(bar)[XB_TMO])) break; if (_sp > XB_SPIN_CAP) { atomicAdd(&(bar)[XB_TMO], 1u); break; } } } } while (0)

struct XcdBarrier { unsigned* bar; unsigned x; volatile LAS unsigned* st; };

__device__ __forceinline__ XcdBarrier xcd_barrier_post(unsigned* bar, volatile LAS unsigned* st) {
    XcdBarrier b; b.bar = bar; b.x = xb_xcc_id(); b.st = st;
    if (threadIdx.x == 0) (void)xb_add(&bar[XB_XCNT(b.x)], 1u);
    return b;
}
__device__ __forceinline__ void xcd_barrier_complete(unsigned* bar, unsigned x, unsigned& nloc, unsigned& nx) {
    const unsigned G = gridDim.x * gridDim.y * gridDim.z;
    unsigned sum, cnt, mine, sp = 0u;
    for (;;) {
        sum = 0u; cnt = 0u; mine = 0u;
#pragma unroll
        for (unsigned j = 0; j < 16; ++j) { const unsigned c = xb_ld(&bar[XB_XCNT(j)]); sum += c; cnt += (c > 0u) ? 1u : 0u; mine = (j == x) ? c : mine; }
        if (sum == G) break;
        __builtin_amdgcn_s_sleep(1);
        if ((++sp & 255u) == 0u) { if (xb_ld(&bar[XB_TMO])) break; if (sp > XB_SPIN_CAP) { atomicAdd(&bar[XB_TMO], 1u); break; } }
    }
    nloc = mine > 0u ? mine : 1u; nx = cnt > 0u ? cnt : 1u;
}
__device__ __forceinline__ void xcd_barrier(const XcdBarrier& b) {
    asm volatile("s_waitcnt vmcnt(0)" ::: "memory");
    __syncthreads();
    if (threadIdx.x == 0) {
        unsigned* bar = b.bar;
        __builtin_amdgcn_s_waitcnt(0);
        unsigned nloc = b.st[0], nx = b.st[1];
        if (nloc == 0u) { xcd_barrier_complete(bar, b.x, nloc, nx); b.st[0] = nloc; b.st[1] = nx; }
        const unsigned old = xb_add(&bar[XB_XSUB(b.x)], 1u);
        const unsigned gen = old / nloc;
        if (old + 1u == (gen + 1u) * nloc) {
            __builtin_amdgcn_fence(__ATOMIC_RELEASE, "agent");
            asm volatile("s_waitcnt vmcnt(0)" ::: "memory");
            const unsigned og = xb_add(&bar[XB_TOP], 1u);
            const unsigned tg = og / nx;
            if (og + 1u == (tg + 1u) * nx) xb_add(&bar[XB_TOPGEN], 1u);
            else XB_SPIN(xb_ld(&bar[XB_TOPGEN]) == tg, bar);
            __builtin_amdgcn_fence(__ATOMIC_ACQUIRE, "agent");
            xb_add(&bar[XB_XGEN(b.x)], 1u);
            asm volatile("s_waitcnt vmcnt(0)" ::: "memory");
        } else {
            XB_SPIN(xb_ld(&bar[XB_XGEN(b.x)]) == gen, bar);
            __builtin_amdgcn_fence(__ATOMIC_ACQUIRE, "agent");
            asm volatile("s_waitcnt vmcnt(0)" ::: "memory");
        }
    }
    __syncthreads();
}

namespace pg8 {
constexpr int BM = 256, BK = 64, HALF = 128, HTB = HALF * BK * 2, STAGE_BYTES = 8 * HTB, NXCD = 8, WGM = 8;
__host__ __device__ __forceinline__ int lds_byte(int r, int c) { const int st = (r >> 4) * 2 + (c >> 5), rr = r & 15, cc = c & 31, ob = rr * 64 + cc * 2; return st * 1024 + (ob ^ (((ob >> 9) & 1) << 5)); }
__host__ __device__ __forceinline__ void stage_rc(int b, int& R, int& C) { const int st = b / 1024, sb = b % 1024, swz = sb ^ (((sb >> 9) & 1) << 5); R = (st >> 1) * 16 + swz / 64; C = (st & 1) * 32 + (swz % 64) / 2; }

struct Unit { int pm, pn, hf; };
struct Gemm { const bf16_t* A; const bf16_t* Bt; int K; };

template <int MODE> struct Order {
    static constexpr bool GATHER = (MODE == 1);
    int nM, nN, nwg, G, c; const int* idx; long bstride;
    __device__ __forceinline__ void init(int nM_, int nN_, int G_, int c_, const int* idx_, long bstride_) { nM = nM_; nN = nN_; nwg = nM * nN; G = G_; c = c_; idx = idx_; bstride = bstride_; }
    __device__ __forceinline__ bool next(int i, Unit& u) const {
        const long L = (long)i * G + c; if (L >= nwg) return false;
        int wgid = (int)L; { const int q = nwg / NXCD, r = nwg % NXCD, xcd = wgid % NXCD, off = wgid / NXCD; wgid = (xcd < r ? xcd * (q + 1) : r * (q + 1) + (xcd - r) * q) + off; }
        const int nig = WGM * nN, gid = wgid / nig, fm = gid * WGM, gsz = (nM - fm) < WGM ? (nM - fm) : WGM;
        u.pm = fm + ((wgid % nig) % gsz); u.pn = (wgid % nig) / gsz; u.hf = (MODE != 0 && (u.pm % 17) == 16) ? 1 : 0; return true;
    }
    __device__ __forceinline__ unsigned arow(const Unit& u, int r) const { if (MODE == 1) return (unsigned)idx[u.pm * BM + r]; return (unsigned)(u.pm * BM + r); }
    __device__ __forceinline__ long bbase(const Unit& u, int K) const { long o = (long)u.pn * BM * K; if (MODE != 0) o += (long)(u.pm / 17) * bstride; return o; }
};

template <int MODE> struct OrderExp {
    static constexpr bool GATHER = (MODE == 1);
    int nN, G, c0; const int* idx; long bstride;
    __device__ __forceinline__ void init(int nN_, int G_, int c_, const int* idx_, long bstride_) { nN = nN_; G = G_; c0 = c_; idx = idx_; bstride = bstride_; }
    __device__ __forceinline__ bool next(int i0, Unit& u) const {
        const int v = i0 * G + c0, i = v >> 8, c = v & 255;
        const int x = c & 7, slot = c >> 3, per = 32 / nN, nfull = 256 / (8 * per);
        if (i > nfull) return false;
        if (i < nfull) { u.pn = slot / per; const int f = (i * 8 + x) * per + (slot % per); u.pm = (f >> 4) * 17 + (f & 15); u.hf = 0; return true; }
        if (i == nfull && slot < 2 * nN) { u.pn = slot >> 1; u.pm = (x * 2 + (slot & 1)) * 17 + 16; u.hf = 1; return true; }
        return false;
    }
    __device__ __forceinline__ unsigned arow(const Unit& u, int r) const { if (MODE == 1) return (unsigned)idx[u.pm * BM + r]; return (unsigned)(u.pm * BM + r); }
    __device__ __forceinline__ long bbase(const Unit& u, int K) const { return (long)u.pn * BM * K + (long)(u.pm / 17) * bstride; }
};

template <class Epi, class Sched>
__device__ __forceinline__ void gemm_phase(LAS unsigned char* lds, const Gemm g, const Sched& S, const Epi& E) {
    int tid = threadIdx.x; asm volatile("" : "+v"(tid));
    const int wid = __builtin_amdgcn_readfirstlane(tid >> 6), wr = wid >> 2, wc = wid & 3;
    const int K = g.K, nt = K / BK;
    unsigned voffB[2];
    { const int lane = tid & 63, fr = lane & 15, fq = lane >> 4; (void)fr; (void)fq; }
#pragma unroll
    for (int i = 0; i < 2; ++i) { int R, Cc; stage_rc(tid * 16 + i * 8192, R, Cc); voffB[i] = (unsigned)(R * K + Cc) * 2u; }
    const size_t kstep = (size_t)(BK * 2);
    const size_t hstep = (size_t)HALF * K * 2;
    const unsigned ldsw = (unsigned)wid * 1024u;
    const int aoff = lds_byte(wr * 64 + (tid & 15), ((tid & 63) >> 4) * 8), boff = lds_byte(wc * 32 + (tid & 15), ((tid & 63) >> 4) * 8);
#define PG8_SA(b, h) (((b) * 2 + (h)) * HTB)
#define PG8_SB(b, h) ((4 + (b) * 2 + (h)) * HTB)
#define PG8_STAGE(bufoff, gbase, voff) do { _Pragma("unroll") for (int _i = 0; _i < 2; ++_i) \
        __builtin_amdgcn_global_load_lds((const unsigned*)((const char*)(gbase) + (voff)[_i]), (LAS unsigned*)(lds + (bufoff) + ldsw + _i * 8192), 16, 0, 0); } while (0)
#define PG8_LDA(dst, b, h) do { _Pragma("unroll") for (int m = 0; m < 4; ++m) _Pragma("unroll") for (int k = 0; k < 2; ++k) dst[m][k] = *(const LAS bf16x8*)(lds + PG8_SA(b, h) + aoff + m * 2048 + k * 1024); } while (0)
#define PG8_LDB(dst, b, h) do { _Pragma("unroll") for (int n = 0; n < 2; ++n) _Pragma("unroll") for (int k = 0; k < 2; ++k) dst[n][k] = *(const LAS bf16x8*)(lds + PG8_SB(b, h) + boff + n * 2048 + k * 1024); } while (0)
#define PG8_MMA(ai, bj, At, Bt) do { __builtin_amdgcn_s_setprio(1); _Pragma("unroll") for (int m = 0; m < 4; ++m) _Pragma("unroll") for (int n = 0; n < 2; ++n) _Pragma("unroll") for (int k = 0; k < 2; ++k) \
        acc[ai][bj][m][n] = __builtin_amdgcn_mfma_f32_16x16x32_bf16(Bt[n][k], At[m][k], acc[ai][bj][m][n], 0, 0, 0); __builtin_amdgcn_s_setprio(0); } while (0)
#define PG8_WAIT_V(n) asm volatile("s_waitcnt vmcnt(" #n ")" ::: "memory")
#define PG8_WAIT_L(n) asm volatile("s_waitcnt lgkmcnt(" #n ")" ::: "memory")
#define PG8_BAR __builtin_amdgcn_s_barrier()
#define PG8_SCHED __builtin_amdgcn_sched_barrier(0)
#define PG8_ROWOFFS(dst, u, tq) do { _Pragma("unroll") for (int _i = 0; _i < 2; ++_i) { int _R, _C; stage_rc((tq) * 16 + _i * 8192, _R, _C); _Pragma("unroll") for (int _h = 0; _h < 2; ++_h) dst[_h][_i] = (S.arow(u, _h * HALF + _R) * (unsigned)K + (unsigned)_C) * 2u; } } while (0)
    Unit cur, nxt; int ui = 0;
    if (!S.next(0, cur)) return;
    float zf = 0.f; asm volatile("" : "+v"(zf));
    f32x4 acc[2][2][4][2];
#pragma unroll
    for (int a = 0; a < 2; ++a)
#pragma unroll
        for (int b = 0; b < 2; ++b)
#pragma unroll
            for (int m = 0; m < 4; ++m)
#pragma unroll
                for (int n = 0; n < 2; ++n) acc[a][b][m][n] = (f32x4){zf, zf, zf, zf};
    bf16x8 At[4][2], B0[2][2], B1[2][2];
    unsigned vcur[2][2];
    if constexpr (Sched::GATHER) { PG8_ROWOFFS(vcur, cur, tid); }
    const char* const Ab = (const char*)g.A;
    const char* cA = Sched::GATHER ? Ab : Ab + (size_t)(unsigned)__builtin_amdgcn_readfirstlane((int)S.arow(cur, 0)) * K * 2;
#define PG8_STAGEA(bufoff, ptr, h) do { if constexpr (Sched::GATHER) { PG8_STAGE(bufoff, ptr, vcur[h]); } else { PG8_STAGE(bufoff, (ptr) + (h) * hstep, voffB); } } while (0)
    const char* cB = (const char*)g.Bt + (size_t)S.bbase(cur, K) * 2;
    PG8_STAGE(PG8_SB(0, 0), cB, voffB); PG8_STAGE(PG8_SB(0, 1), cB + hstep, voffB); PG8_STAGEA(PG8_SA(0, 0), cA, 0); PG8_STAGEA(PG8_SA(0, 1), cA, 1);
    if (wr == 1) PG8_BAR;
    PG8_WAIT_V(2); PG8_BAR;
    PG8_STAGE(PG8_SB(1, 0), cB + kstep, voffB); PG8_STAGEA(PG8_SA(1, 0), cA + kstep, 0); PG8_STAGE(PG8_SB(1, 1), cB + hstep + kstep, voffB);
    PG8_WAIT_V(6); PG8_BAR;
    for (;;) {
        const bool has_next = S.next(ui + 1, nxt);
        const char* nB = has_next ? (const char*)g.Bt + (size_t)S.bbase(nxt, K) * 2 : cB;
        const char* nA = (Sched::GATHER || !has_next) ? cA : Ab + (size_t)(unsigned)__builtin_amdgcn_readfirstlane((int)S.arow(nxt, 0)) * K * 2;
#pragma unroll 1
        for (int t = 0; t < nt; t += 2) {
            const bool last = (t == nt - 2);
            const char* a1 = cA + (size_t)(t + 1) * kstep;
            const char* a2 = last ? nA : cA + (size_t)(t + 2) * kstep; const char* b2 = last ? nB : cB + (size_t)(t + 2) * kstep;
            const char* a3 = a2 + kstep; const char* b3 = b2 + kstep;
            PG8_LDB(B0, 0, 0); PG8_LDB(B1, 0, 1); PG8_SCHED; PG8_LDA(At, 0, 0); PG8_STAGEA(PG8_SA(1, 1), a1, 1);
            PG8_WAIT_V(8); PG8_WAIT_L(0); PG8_BAR; PG8_MMA(0, 0, At, B0); PG8_MMA(0, 1, At, B1); PG8_BAR; PG8_SCHED;
            if constexpr (Sched::GATHER) { if (last && has_next) { int tq = tid; asm volatile("" : "+v"(tq)); PG8_ROWOFFS(vcur, nxt, tq); } }
            PG8_LDA(At, 0, 1); PG8_STAGE(PG8_SB(0, 0), b2, voffB); PG8_STAGE(PG8_SB(0, 1), b2 + hstep, voffB); PG8_STAGEA(PG8_SA(0, 0), a2, 0);
            PG8_WAIT_V(8); PG8_WAIT_L(0); PG8_BAR; if (!cur.hf) { PG8_MMA(1, 0, At, B0); PG8_MMA(1, 1, At, B1); } PG8_BAR; PG8_SCHED;
            PG8_LDB(B0, 1, 0); PG8_LDB(B1, 1, 1); PG8_SCHED; PG8_LDA(At, 1, 0); PG8_STAGEA(PG8_SA(0, 1), a2, 1);
            PG8_WAIT_V(8); PG8_WAIT_L(0); PG8_BAR; PG8_MMA(0, 0, At, B0); PG8_MMA(0, 1, At, B1); PG8_BAR; PG8_SCHED;
            PG8_LDA(At, 1, 1); PG8_STAGE(PG8_SB(1, 0), b3, voffB); PG8_STAGE(PG8_SB(1, 1), b3 + hstep, voffB); PG8_STAGEA(PG8_SA(1, 0), a3, 0);
            PG8_WAIT_V(8); PG8_WAIT_L(0); PG8_BAR; if (!cur.hf) { PG8_MMA(1, 0, At, B0); PG8_MMA(1, 1, At, B1); } PG8_BAR; PG8_SCHED;
        }
        if (wr == 0) PG8_BAR;
        { int tz = tid; asm volatile("" : "+v"(tz)); const int ln = tz & 63; E(acc, cur, wr, wc, ln & 15, ln >> 4); }
        if (!has_next) break;
#pragma unroll
        for (int a = 0; a < 2; ++a)
#pragma unroll
            for (int b = 0; b < 2; ++b)
#pragma unroll
                for (int m = 0; m < 4; ++m)
#pragma unroll
                    for (int n = 0; n < 2; ++n) acc[a][b][m][n] = (f32x4){zf, zf, zf, zf};
        cur = nxt; cB = nB; cA = nA; ++ui;
        if (wr == 1) PG8_BAR;
    }
    PG8_WAIT_V(0);
    PG8_BAR;
#undef PG8_SA
#undef PG8_SB
#undef PG8_STAGE
#undef PG8_LDA
#undef PG8_LDB
#undef PG8_MMA
#undef PG8_WAIT_V
#undef PG8_WAIT_L
#undef PG8_BAR
#undef PG8_SCHED
#undef PG8_ROWOFFS
#undef PG8_STAGEA
}

#define EPI_LOOP for (int ai = 0; ai < 2; ++ai) for (int m = 0; m < 4; ++m) for (int bj = 0; bj < 2; ++bj) for (int n = 0; n < 2; ++n)
__device__ __forceinline__ int colw_of(int fq) { return (fq & 1) * 16 + (fq >> 1) * 8; }
__device__ __forceinline__ void st_pair_bf16(bf16_t* p  , f32x4 v0, f32x4 v1) {
    const unsigned a0 = pk2(v0[0], v0[1]), a1 = pk2(v0[2], v0[3]), b0 = pk2(v1[0], v1[1]), b1 = pk2(v1[2], v1[3]);
    const auto r0 = __builtin_amdgcn_permlane16_swap(a0, b0, false, false); const auto r1 = __builtin_amdgcn_permlane16_swap(a1, b1, false, false);
    u32x4 o; o.x = r0[0]; o.y = r1[0]; o.z = r0[1]; o.w = r1[1]; *(u32x4*)p = o;
}
__device__ __forceinline__ void ld_pair_bf16(const void* p, u32x2& n0, u32x2& n1) {
    const u32x4 w = *(const u32x4*)p;
    const auto r0 = __builtin_amdgcn_permlane16_swap(w.x, w.z, false, false); const auto r1 = __builtin_amdgcn_permlane16_swap(w.y, w.w, false, false);
    n0.x = r0[0]; n0.y = r1[0]; n1.x = r0[1]; n1.y = r1[1];
}
struct EpiBf16 {
    bf16_t* O; int ldc;
    __device__ __forceinline__ void operator()(const f32x4 (&acc)[2][2][4][2], const Unit& u, int wr, int wc, int fr, int fq) const {
        const int row0 = u.pm * BM + wr * 64 + fr, colg = u.pn * BM + wc * 32 + colw_of(fq);
#pragma unroll
        for (int ai = 0; ai < 2; ++ai)
#pragma unroll
            for (int m = 0; m < 4; ++m) { bf16_t* rowp = O + (size_t)(row0 + ai * HALF + m * 16) * ldc + colg;
#pragma unroll
                for (int bj = 0; bj < 2; ++bj) st_pair_bf16(rowp + bj * HALF, acc[ai][bj][m][0], acc[ai][bj][m][1]); }
    }
};
struct EpiOdd {
    bf16_t* P; bf16_t* Q; bf16_t* KA; const float* rope;
    __device__ __forceinline__ void operator()(const f32x4 (&acc)[2][2][4][2], const Unit& u, int wr, int wc, int fr, int fq) const {
        const int row0 = u.pm * BM + wr * 64 + fr, col0 = u.pn * BM + wc * 32 + 4 * fq;
        if (u.pn >= 6) {
#pragma unroll
            for (int ai = 0; ai < 2; ++ai)
#pragma unroll
                for (int m = 0; m < 4; ++m) { bf16_t* rowp = P + (size_t)(row0 + ai * HALF + m * 16) * P_LD + (col0 - 4 * fq + colw_of(fq));
#pragma unroll
                    for (int bj = 0; bj < 2; ++bj) st_pair_bf16(rowp + bj * HALF, acc[ai][bj][m][0], acc[ai][bj][m][1]); }
            return;
        }
        const bool isk = u.pn >= 3, isctx = u.pm >= NLAT / BM; const int axis = wc & 1;
        const int cq = col0 - (isk ? 768 : 0);
        f32x4 csr[2][4], snr[2][4];
#pragma unroll
        for (int ai = 0; ai < 2; ++ai)
#pragma unroll
            for (int m = 0; m < 4; ++m) { const int row = row0 + ai * HALF + m * 16; csr[ai][m] = (f32x4){1.f, 1.f, 1.f, 1.f}; snr[ai][m] = (f32x4){0.f, 0.f, 0.f, 0.f};
                if (!isctx) { const int t = row & (TT - 1); const int pos = axis ? 128 + (t & 63) : (t >> 6);
                    csr[ai][m] = *(const f32x4*)(rope + pos * 16 + 4 * fq); snr[ai][m] = *(const f32x4*)(rope + 192 * 16 + pos * 16 + 4 * fq); } }
#pragma unroll
        for (int ai = 0; ai < 2; ++ai)
#pragma unroll
            for (int m = 0; m < 4; ++m) { const int row = row0 + ai * HALF + m * 16;
                const f32x4 cs = csr[ai][m], sn = snr[ai][m]; size_t orow;
                if (!isctx) { const int t = row & (TT - 1); orow = isk ? (size_t)(row >> 13) * LKEYS + CTXL + t : (size_t)row; }
                else { const int rc = row - NLAT; orow = isk ? (size_t)(rc >> 8) * LKEYS + (rc & 255) : (size_t)row; }
                bf16_t* op = (isk ? KA : Q) + orow * 768 + cq; const float sc = isk ? 1.f : QSCALE;
#pragma unroll
                for (int bj = 0; bj < 2; ++bj) { const f32x4 x1 = acc[ai][bj][m][0], x2 = acc[ai][bj][m][1];
                    const f32x4 o1 = (x1 * cs - x2 * sn) * sc, o2 = (x1 * sn + x2 * cs) * sc;
                    st_pair_bf16(op + bj * HALF - 4 * fq + colw_of(fq), o1, o2); } }
    }
};
struct EpiRes {
    float* X; const float* modl; const float* xin; const float* cin;
    __device__ __forceinline__ void operator()(const f32x4 (&acc)[2][2][4][2], const Unit& u, int wr, int wc, int fr, int fq) const {
        const int row0 = u.pm * BM + wr * 64 + fr, col0 = u.pn * BM + wc * 32 + 4 * fq;
        const int mi = (u.pm * BM < NLAT) ? (u.pm * BM) / TT : 4;
        const float* gate = modl + mi * 6144 + 2 * DM;
        const float* rsrc = (u.pm * BM < NLAT) ? xin : cin - (size_t)NLAT * DM;
        f32x4 gv[2][2];
#pragma unroll
        for (int bj = 0; bj < 2; ++bj)
#pragma unroll
            for (int n = 0; n < 2; ++n) gv[bj][n] = *(const f32x4*)(gate + col0 + bj * HALF + n * 16);
#pragma unroll
        for (int ai = 0; ai < 2; ++ai) { f32x4 xr[4][2][2];
#pragma unroll
            for (int m = 0; m < 4; ++m) { const float* rowp = rsrc + (size_t)(row0 + ai * HALF + m * 16) * DM + col0;
#pragma unroll
                for (int bj = 0; bj < 2; ++bj)
#pragma unroll
                    for (int n = 0; n < 2; ++n) xr[m][bj][n] = *(const f32x4*)(rowp + bj * HALF + n * 16); }
#pragma unroll
            for (int m = 0; m < 4; ++m) { float* rowp = X + (size_t)(row0 + ai * HALF + m * 16) * DM + col0;
#pragma unroll
                for (int bj = 0; bj < 2; ++bj)
#pragma unroll
                    for (int n = 0; n < 2; ++n) *(f32x4*)(rowp + bj * HALF + n * 16) = xr[m][bj][n] * ALPHA_DN + gv[bj][n] * acc[ai][bj][m][n]; } }
    }
};
struct EpiSwiGLU {
    bf16_t* HID;
    __device__ __forceinline__ void operator()(const f32x4 (&acc)[2][2][4][2], const Unit& u, int wr, int wc, int fr, int fq) const {
        const int row0 = u.pm * BM + wr * 64 + fr, f0 = u.pn * HALF + wc * 32 + 4 * fq;
#pragma unroll
        for (int ai = 0; ai < 2; ++ai) if (ai == 0 || !u.hf)
#pragma unroll
            for (int m = 0; m < 4; ++m) { bf16_t* rowp = HID + (size_t)(row0 + ai * HALF + m * 16) * D_EXP + u.pn * HALF + wc * 32 + colw_of(fq); f32x4 hh[2];
#pragma unroll
                for (int n = 0; n < 2; ++n) { const f32x4 a = acc[ai][0][m][n], b = acc[ai][1][m][n];
#pragma unroll
                    for (int j = 0; j < 4; ++j) hh[n][j] = a[j] * __builtin_amdgcn_rcpf(1.f + __expf(-a[j])) * b[j]; }
                st_pair_bf16(rowp, hh[0], hh[1]); }
    }
};
struct EpiYE {
    bf16_t* YE; const float* gate;
    __device__ __forceinline__ void operator()(const f32x4 (&acc)[2][2][4][2], const Unit& u, int wr, int wc, int fr, int fq) const {
        const int row0 = u.pm * BM + wr * 64 + fr, col0 = u.pn * BM + wc * 32 + 4 * fq;
        float gts[2][4];
#pragma unroll
        for (int ai = 0; ai < 2; ++ai)
#pragma unroll
            for (int m = 0; m < 4; ++m) gts[ai][m] = gate[row0 + ai * HALF + m * 16];
#pragma unroll
        for (int ai = 0; ai < 2; ++ai) if (ai == 0 || !u.hf)
#pragma unroll
            for (int m = 0; m < 4; ++m) { const int row = row0 + ai * HALF + m * 16; const float gt = gts[ai][m]; bf16_t* rowp = YE + (size_t)row * DM + (col0 - 4 * fq + colw_of(fq));
#pragma unroll
                for (int bj = 0; bj < 2; ++bj) st_pair_bf16(rowp + bj * HALF, acc[ai][bj][m][0] * gt, acc[ai][bj][m][1] * gt); }
    }
};
struct EpiLora {
    unsigned char* SCN; bf16_t* G; const float* decay0; const float* a0; const float* kalpha;
    __device__ __forceinline__ void operator()(const f32x4 (&acc)[2][2][4][2], const Unit& u, int wr, int wc, int fr, int fq) const {
        const int row0 = u.pm * BM + wr * 64 + fr;
        const int seg = u.pn / 3, cb = (u.pn % 3) * BM + wc * 32 + 4 * fq, cw = colw_of(fq) - 4 * fq;
        f32x4 par0[2][2], par1[2][2];
#pragma unroll
        for (int bj = 0; bj < 2; ++bj)
#pragma unroll
            for (int n = 0; n < 2; ++n) { const int col = cb + bj * HALF + n * 16; par0[bj][n] = (f32x4){0.f, 0.f, 0.f, 0.f}; par1[bj][n] = par0[bj][n];
                if (seg < 2) par0[bj][n] = *(const f32x4*)(decay0 + seg * 768 + col);
                else if (seg < 4) { par0[bj][n] = *(const f32x4*)(a0 + (seg - 2) * 768 + col); par1[bj][n] = *(const f32x4*)(kalpha + col); } }
#pragma unroll
        for (int bj = 0; bj < 2; ++bj) {
            const int colA = cb + bj * HALF, head = colA >> 6, kx0 = colA & 63;
            if (seg < 2) {
#pragma unroll
                for (int n = 0; n < 2; ++n) { const f32x4 d0 = par0[bj][n]; const int kx = kx0 + n * 16;
#pragma unroll
                    for (int ai = 0; ai < 2; ++ai)
#pragma unroll
                        for (int m = 0; m < 4; ++m) { const int row = row0 + ai * HALF + m * 16; f32x4 w;
#pragma unroll
                            for (int j = 0; j < 4; ++j) { const float lw = -DECAY_SCALE * sigmoidf_(d0[j] + acc[ai][bj][m][n][j]); w[j] = CHUNKED_SCAN ? lw : __expf(lw); }
                            *(f32x4*)(SCN + (size_t)(row * 12 + head) * SC_REC + SC_W + seg * 256 + kx * 4) = w; __builtin_amdgcn_sched_barrier(0); } }
            } else if (seg < 4) {
                const int d = seg - 2;
#pragma unroll
                for (int ai = 0; ai < 2; ++ai) {
                    u32x2 kkr[2][4], ksr[2][4];
                    u32x4 wk[4], ws_[4];
#pragma unroll
                    for (int m = 0; m < 4; ++m) { const unsigned char* base = SCN + (size_t)((row0 + ai * HALF + m * 16) * 12 + head) * SC_REC + (kx0 + cw) * 2;
                        wk[m] = *(const u32x4*)(base + SC_KK); ws_[m] = *(const u32x4*)(base + SC_KR + 256 * d); }
#pragma unroll
                    for (int m = 0; m < 4; ++m) {
                        { const auto r0 = __builtin_amdgcn_permlane16_swap(wk[m].x, wk[m].z, false, false); const auto r1 = __builtin_amdgcn_permlane16_swap(wk[m].y, wk[m].w, false, false);
                          kkr[0][m].x = r0[0]; kkr[0][m].y = r1[0]; kkr[1][m].x = r0[1]; kkr[1][m].y = r1[1]; }
                        { const auto r0 = __builtin_amdgcn_permlane16_swap(ws_[m].x, ws_[m].z, false, false); const auto r1 = __builtin_amdgcn_permlane16_swap(ws_[m].y, ws_[m].w, false, false);
                          ksr[0][m].x = r0[0]; ksr[0][m].y = r1[0]; ksr[1][m].x = r0[1]; ksr[1][m].y = r1[1]; } }
#pragma unroll
                    for (int m = 0; m < 4; ++m) { const int row = row0 + ai * HALF + m * 16; unsigned char* base = SCN + (size_t)(row * 12 + head) * SC_REC + (kx0 + cw) * 2; f32x4 bb[2], kr[2];
#pragma unroll
                        for (int n = 0; n < 2; ++n) { const f32x4 a00 = par0[bj][n], kal = par1[bj][n];
                            const f32x4 kk = {bflo(kkr[n][m].x), bfhi(kkr[n][m].x), bflo(kkr[n][m].y), bfhi(kkr[n][m].y)}; const f32x4 ks = {bflo(ksr[n][m].x), bfhi(ksr[n][m].x), bflo(ksr[n][m].y), bfhi(ksr[n][m].y)};
#pragma unroll
                            for (int j = 0; j < 4; ++j) { const float a = sigmoidf_(a00[j] + acc[ai][bj][m][n][j]); bb[n][j] = kk[j] * a; kr[n][j] = ks[j] * (1.f + (a - 1.f) * kal[j]); } }
                        st_pair_bf16((bf16_t*)(base + SC_B + 256 * d), bb[0], bb[1]); st_pair_bf16((bf16_t*)(base + SC_KR + 256 * d), kr[0], kr[1]); __builtin_amdgcn_sched_barrier(0); } }
            } else {
#pragma unroll
                for (int ai = 0; ai < 2; ++ai)
#pragma unroll
                    for (int m = 0; m < 4; ++m) { const int row = row0 + ai * HALF + m * 16; st_pair_bf16(G + (size_t)row * 768 + colA + cw, acc[ai][bj][m][0], acc[ai][bj][m][1]); }
            }
        }
    }
};
}

struct Args { const float* in[37]; float* out; unsigned char* ws; int lo, hi; };
enum { I_X = 0, I_C, I_CTX, I_CCTX, I_WMOD, I_BMOD, I_LNG, I_LNB, I_EWIN, I_EWOUT, I_CONVW, I_MU, I_DUP, I_D0, I_AUP, I_A0, I_GUP, I_KXI, I_KAL, I_RBON, I_GNG, I_GNB,
       I_OWIN, I_OWOUT, I_LQ1, I_LK1, I_LQ2, I_LK2, I_SUBG, I_GLNG, I_GLNB, I_GWS, I_GBS, I_WR, I_WE1, I_WE3, I_WE2 };

struct Ctx {
    LAS unsigned char* lds;
    int tid, lane, wave, G, vcu, gw, NGW;
};
__device__ __forceinline__ void mkctx(Ctx& C, LAS unsigned char* lds) {
    int tid = threadIdx.x; asm volatile("" : "+v"(tid));
    C.lds = lds; C.tid = tid; C.lane = tid & 63; C.wave = __builtin_amdgcn_readfirstlane(tid >> 6);
    C.G = gridDim.x; { const int bx = blockIdx.x; C.vcu = (C.G % 8 == 0) ? (bx % 8) * (C.G / 8) + bx / 8 : bx; }
    C.gw = blockIdx.x * NWAVES + C.wave; C.NGW = C.G * NWAVES;
}
#define GLOBAL_PTR(T, v) ((T*)(__attribute__((address_space(1))) T*)(v))
__device__ __forceinline__ void ldargs(Args& A, LAS unsigned char* lds) {
    LAS const u32x2* tb = (LAS const u32x2*)(lds + LDS_PTAB); asm volatile("" : "+v"(tb));
#pragma unroll
    for (int i = 0; i < 37; ++i) { const u32x2 v = tb[i]; A.in[i] = GLOBAL_PTR(const float, ((unsigned long long)(unsigned)__builtin_amdgcn_readfirstlane((int)v.y) << 32) | (unsigned)__builtin_amdgcn_readfirstlane((int)v.x)); }
    { const u32x2 v = tb[37]; A.out = GLOBAL_PTR(float, ((unsigned long long)(unsigned)__builtin_amdgcn_readfirstlane((int)v.y) << 32) | (unsigned)__builtin_amdgcn_readfirstlane((int)v.x)); }
    { const u32x2 v = tb[38]; A.ws = GLOBAL_PTR(unsigned char, ((unsigned long long)(unsigned)__builtin_amdgcn_readfirstlane((int)v.y) << 32) | (unsigned)__builtin_amdgcn_readfirstlane((int)v.x)); }
    A.lo = 0; A.hi = 0;
}
__device__ __forceinline__ int row_mi(int row) { return row < NLAT ? (row >> 13) : 4; }

__device__ __forceinline__ void phase_init(const Ctx& C, const Args& A) {
    unsigned char* ws = A.ws;
    float* MOD = (float*)(ws + WS_MOD);
    LAS float* sv = (LAS float*)C.lds;
    LAS float* red = sv + 5 * 1024;
    for (int i = C.tid; i < 5 * 1024; i += NTHR) { const int v = i >> 10, k = i & 1023; const float c = (v < 4) ? A.in[I_C][v * DM + k] : A.in[I_CCTX][k]; sv[i] = c / (1.f + __expf(-c)); }
    __syncthreads();
    const int j = C.tid & 127, kp = C.tid >> 7;
    for (int it = blockIdx.x; it < DEPTH * 48; it += C.G) {
        const int l = it / 48, cg = it % 48, col = cg * 128 + j;
        const float* W = A.in[I_WMOD] + (size_t)l * DM * 6144 + col;
        float a0 = 0.f, a1 = 0.f, a2 = 0.f, a3 = 0.f, a4 = 0.f;
#pragma unroll 32
        for (int k = kp * 256; k < kp * 256 + 256; ++k) { const float w = W[(size_t)k * 6144];     a0 += sv[k] * w; a1 += sv[1024 + k] * w; a2 += sv[2048 + k] * w; a3 += sv[3072 + k] * w; a4 += sv[4096 + k] * w; }
        red[(kp * 5 + 0) * 128 + j] = a0; red[(kp * 5 + 1) * 128 + j] = a1; red[(kp * 5 + 2) * 128 + j] = a2; red[(kp * 5 + 3) * 128 + j] = a3; red[(kp * 5 + 4) * 128 + j] = a4;
        __syncthreads();
        for (int o = C.tid; o < 5 * 128; o += NTHR) { const int v = o >> 7, jj = o & 127; const int cc = cg * 128 + jj;
            const float s = red[(0 * 5 + v) * 128 + jj] + red[(1 * 5 + v) * 128 + jj] + red[(2 * 5 + v) * 128 + jj] + red[(3 * 5 + v) * 128 + jj];
            MOD[((size_t)l * 5 + v) * 6144 + cc] = s + A.in[I_BMOD][l * 6144 + cc]; }
        __syncthreads();
    }
    if (blockIdx.x == C.G - 1) { float* rope = (float*)(ws + WS_ROPE);
        for (int i = C.tid; i < 192 * 16; i += NTHR) { const int pos = i >> 4, j = i & 15; const float ang = (float)(pos < 128 ? pos : pos - 128) * powf(10000.f, -(float)j * (1.f / 16.f));
            rope[i] = cosf(ang); rope[192 * 16 + i] = sinf(ang); } }
}

__device__ __forceinline__ void transpose_item(const float* W, int ldw, int k0, int n0, bf16_t* WT, int ldt, int drow0, LAS float* scr, int lane) {
    { float v[64]; const float* src = W + (size_t)k0 * ldw + n0 + lane;
#pragma unroll
      for (int k = 0; k < 64; ++k) v[k] = __builtin_nontemporal_load(src + (size_t)k * ldw);
#pragma unroll
      for (int k = 0; k < 64; ++k) scr[k * 65 + lane] = v[k]; }
    asm volatile("s_waitcnt lgkmcnt(0)" ::: "memory");
    const int c = lane & 7;
#pragma unroll
    for (int j = 0; j < 8; ++j) { const int n = (lane >> 3) + 8 * j; const LAS float* s = scr + (8 * c) * 65 + n;
        u32x4 o; o.x = pk2(s[0 * 65], s[1 * 65]); o.y = pk2(s[2 * 65], s[3 * 65]); o.z = pk2(s[4 * 65], s[5 * 65]); o.w = pk2(s[6 * 65], s[7 * 65]);
        *(u32x4*)(WT + (size_t)(drow0 + n) * ldt + k0 + 8 * c) = o; }
    asm volatile("s_waitcnt lgkmcnt(0)" ::: "memory");
}
constexpr int XW_IN_HI = 3200, XW_OUT_HI = 7040, XW_TK_HI = 9088;
constexpr int YW_IN_HI = 1344, YW_OF_HI = 6144, YW_OUT_HI = 9984, YW_TK_HI = 12032;
__device__ __forceinline__ void conv_items(const Ctx& C, const Args& A, int l, int gw, int NGW, bool do_in, bool do_out, bool do_exp, int lo = 0, int hi = 1 << 30) {
    unsigned char* ws = A.ws;
    const int i2 = l >> 1; const bool odd = (l & 1);
    LAS float* scr = (LAS float*)C.lds + C.wave * (64 * 65);
    bf16_t* WIN = (bf16_t*)(ws + WS_WIN); bf16_t* WOUT = (bf16_t*)(ws + WS_WOUT); bf16_t* WE13 = (bf16_t*)(ws + WS_WE13 + (size_t)(l & 1) * WE13_BYTES); bf16_t* WE2 = (bf16_t*)(ws + WS_WE2 + (size_t)(l & 1) * WE2_BYTES);
    const int nin = odd ? D_IN_ODD : D_IN_EVEN;
    const float* win = odd ? A.in[I_OWIN] + (size_t)i2 * DM * D_IN_ODD : A.in[I_EWIN] + (size_t)i2 * DM * D_IN_EVEN;
    const float* wout = odd ? A.in[I_OWOUT] + (size_t)i2 * DM * DM : A.in[I_EWOUT] + (size_t)i2 * DM * DM;
    const int n_in = do_in ? 16 * (nin / 64) : 0, n_out = do_out ? 16 * 16 : 0, n_e13 = do_exp ? NEXP * 2 * 16 * 32 : 0, n_e2 = do_exp ? NEXP * 32 * 16 : 0;
    const int total = (n_in + n_out + n_e13 + n_e2) < hi ? (n_in + n_out + n_e13 + n_e2) : hi;
    for (int it = lo + gw; it < total; it += NGW) {
        int r = it;
        if (r < n_in) { const int nb = nin / 64, kb = r / nb, nn = r % nb; transpose_item(win, nin, kb * 64, nn * 64, WIN, DM, nn * 64, scr, C.lane); continue; } r -= n_in;
        if (r < n_out) { const int kb = r / 16, nn = r % 16; transpose_item(wout, DM, kb * 64, nn * 64, WOUT, DM, nn * 64, scr, C.lane); continue; } r -= n_out;
        if (r < n_e13) { const int e = r / 1024, q = r % 1024, mat = q / 512, q2 = q % 512, kb = q2 / 32, nn = q2 % 32;
            const float* W = (mat ? A.in[I_WE3] : A.in[I_WE1]) + ((size_t)l * NEXP + e) * DM * D_EXP;
            const int f0 = nn * 64; const int drow = (f0 >> 7) * 256 + mat * 128 + (f0 & 127);
            transpose_item(W, D_EXP, kb * 64, f0, WE13 + (size_t)e * 4096 * DM, DM, drow, scr, C.lane); continue; } r -= n_e13;
        { const int e = r / 512, q = r % 512, kb = q / 16, nn = q % 16;
            const float* W = A.in[I_WE2] + ((size_t)l * NEXP + e) * D_EXP * DM;
            transpose_item(W, DM, kb * 64, nn * 64, WE2 + (size_t)e * DM * D_EXP, D_EXP, nn * 64, scr, C.lane); }
    }
}
__device__ __forceinline__ void phase_conv(const Ctx& C, const Args& A, int l) {
    unsigned char* ws = A.ws;
    const int i2 = l >> 1; const bool odd = (l & 1);
    bf16_t* WIN = (bf16_t*)(ws + WS_WIN);
    const bool early = CHUNKED_SCAN && odd;
    if (l > 0) { if (early || !CHUNKED_SCAN) conv_items(C, A, l, C.gw, C.NGW, !early, true, !early);
                 else { conv_items(C, A, l, C.gw, C.NGW, true, true, false); conv_items(C, A, l, C.gw, C.NGW, false, false, true, YW_TK_HI); } }
    if (!odd) {
        u32x4* z = (u32x4*)(WIN + (size_t)D_IN_EVEN * DM);
        unsigned zz = 0u; asm volatile("" : "+v"(zz));
        for (int i = blockIdx.x * NTHR + C.tid; i < (D_IN_EVEN_PAD - D_IN_EVEN) * DM / 8; i += C.G * NTHR) z[i] = (u32x4){zz, zz, zz, zz};
        bf16_t* WL = (bf16_t*)(ws + WS_WLORA);
        const float* dup = A.in[I_DUP] + (size_t)i2 * 2 * 64 * 768; const float* aup = A.in[I_AUP] + (size_t)i2 * 2 * 64 * 768; const float* gup = A.in[I_GUP] + (size_t)i2 * 128 * 768;
        for (int i = blockIdx.x * NTHR + C.tid; i < LORA_N * LORA_K; i += C.G * NTHR) {
            const int kk = i / LORA_N, n = i % LORA_N, seg = n / 768, col = n % 768; float v = 0.f;
            if (seg == 0) { if (kk < 64) v = dup[(size_t)(0 * 64 + kk) * 768 + col]; }
            else if (seg == 1) { if (kk >= 64 && kk < 128) v = dup[(size_t)(1 * 64 + kk - 64) * 768 + col]; }
            else if (seg == 2) { if (kk >= 128 && kk < 192) v = aup[(size_t)(0 * 64 + kk - 128) * 768 + col]; }
            else if (seg == 3) { if (kk >= 192 && kk < 256) v = aup[(size_t)(1 * 64 + kk - 192) * 768 + col]; }
            else { if (kk >= 256) v = gup[(size_t)(kk - 256) * 768 + col]; }
            WL[(size_t)n * LORA_K + kk] = (bf16_t)f2bf(v);
        }
    }
}

__device__ __forceinline__ void phase_modh(const Ctx& C, const Args& A, int l) {
    bf16_t* H = (bf16_t*)(A.ws + WS_H); const float* MOD = (const float*)(A.ws + WS_MOD) + (size_t)l * 5 * 6144;
    const float* xin = A.in[I_X]; const float* cin = A.in[I_CTX] - (size_t)NLAT * DM;
#define MODH_SRC(row_) (((row_) < NLAT ? xin : cin) + (size_t)(row_) * DM)
    const int row0 = (int)(((long)C.gw * MROWS) / C.NGW), row1 = (int)(((long)(C.gw + 1) * MROWS) / C.NGW);
    f32x4 shr[4], scr_[4], xn[4]; int cmi = -1;
    if (row0 < row1) {
#pragma unroll
        for (int j = 0; j < 4; ++j) xn[j] = *(const f32x4*)(MODH_SRC(row0) + 4 * C.lane + 256 * j); }
#pragma unroll
    for (int j = 0; j < 4; ++j) { shr[j] = (f32x4){0.f, 0.f, 0.f, 0.f}; scr_[j] = shr[j]; }
    for (int row = row0; row < row1; ++row) {
        const int mi = row_mi(row);
        if (mi != cmi) { cmi = mi; const float* md = MOD + mi * 6144;
#pragma unroll
            for (int j = 0; j < 4; ++j) { const int col = 4 * C.lane + 256 * j; shr[j] = *(const f32x4*)(md + col); scr_[j] = *(const f32x4*)(md + DM + col) + 1.f; } }
        f32x4 x[4];
#pragma unroll
        for (int j = 0; j < 4; ++j) x[j] = xn[j];
        if (row + 1 < row1) {
#pragma unroll
            for (int j = 0; j < 4; ++j) xn[j] = *(const f32x4*)(MODH_SRC(row + 1) + 4 * C.lane + 256 * j); }
#pragma unroll
        for (int j = 0; j < 4; ++j) { const int col = 4 * C.lane + 256 * j; const f32x4 h = x[j] * scr_[j] + shr[j]; u32x2 o; o.x = pk2(h[0], h[1]); o.y = pk2(h[2], h[3]); *(u32x2*)(H + (size_t)row * DM + col) = o; }
    }
}

__device__ __forceinline__ f32x4 ld4bf(const bf16_t* p) { const u32x2 u = *(const u32x2*)p; return (f32x4){bflo(u.x), bfhi(u.x), bflo(u.y), bfhi(u.y)}; }
__device__ __forceinline__ void st4bf(bf16_t* p, f32x4 v) { u32x2 o; o.x = pk2(v[0], v[1]); o.y = pk2(v[2], v[3]); *(u32x2*)p = o; }
__device__ __forceinline__ void seq_info(int row, bool& hasp, bool& hasn) {
    if (row < NLAT) { const int t = row & (TT - 1); hasp = t > 0; hasn = t < TT - 1; }
    else { const int t = (row - NLAT) & (CTXL - 1); hasp = t > 0; hasn = t < CTXL - 1; }
}
struct Ef1Row { u32x2 bg, ua, ub, m[11]; };
__device__ __forceinline__ f32x4 bf4(u32x2 u) { return (f32x4){bflo(u.x), bfhi(u.x), bflo(u.y), bfhi(u.y)}; }
__device__ __forceinline__ void ef1_load(Ef1Row& R, const bf16_t* P, int row, int lane) {
    row = row < 0 ? 0 : row > MROWS - 1 ? MROWS - 1 : row;
    const bf16_t* p = P + (size_t)row * P_LD + 4 * lane;
    R.bg = *(const u32x2*)p; R.ua = *(const u32x2*)(p + 256); R.ub = *(const u32x2*)(p + 512);
#pragma unroll
    for (int it = 0; it < 11; ++it) R.m[it] = *(const u32x2*)(p + 768 + it * 256);
}
__device__ __forceinline__ void phase_ef1(const Ctx& C, const Args& A, int l) {
    const int i2 = l >> 1; unsigned char* ws = A.ws;
    const bf16_t* P = (const bf16_t*)(ws + WS_P); bf16_t* A2 = (bf16_t*)(ws + WS_A2); unsigned char* SCN = ws + WS_SCN; bf16_t* LIN = (bf16_t*)(ws + WS_LIN);
    const float* cw = A.in[I_CONVW] + (size_t)i2 * 3 * 256; const float* mu = A.in[I_MU] + (size_t)i2 * RWKV_COLS; const float* kxi = A.in[I_KXI] + (size_t)i2 * 768;
    const int j4 = 4 * C.lane;
    const f32x4 w0 = *(const f32x4*)(cw + j4), w1 = *(const f32x4*)(cw + 256 + j4), w2 = *(const f32x4*)(cw + 512 + j4);
    f32x4 mur[11], kxr[3];
#pragma unroll
    for (int it = 0; it < 11; ++it) mur[it] = (it * 256 + j4 < RWKV_COLS) ? *(const f32x4*)(mu + it * 256 + j4) : (f32x4){0.f, 0.f, 0.f, 0.f};
#pragma unroll
    for (int it = 0; it < 3; ++it) kxr[it] = *(const f32x4*)(kxi + it * 256 + j4);
    const int row0 = (int)(((long)C.gw * MROWS) / C.NGW), row1 = (int)(((long)(C.gw + 1) * MROWS) / C.NGW);
    Ef1Row Ra, Rb, Rc, Rd;
    ef1_load(Ra, P, row0 - 1, C.lane); ef1_load(Rb, P, row0, C.lane); ef1_load(Rc, P, row0 + 1, C.lane);
    for (int row = row0; row < row1; ++row) {
        ef1_load(Rd, P, row + 2, C.lane);
        bool hasp, hasn; seq_info(row, hasp, hasn);
        const float fp = hasp ? 1.f : 0.f, fn = hasn ? 1.f : 0.f;
        {
            const f32x4 bg = bf4(Rb.bg), u0 = bf4(Rb.ua) * bf4(Rb.ub), um = bf4(Ra.ua) * bf4(Ra.ub) * fp, up = bf4(Rc.ua) * bf4(Rc.ub) * fn;
            st4bf(A2 + (size_t)row * DM + j4, bg * (w0 * um + w1 * u0 + w2 * up));
        }
#pragma unroll
        for (int it = 0; it < 11; ++it) {
            const int c = it * 256 + j4;
            if (c < RWKV_COLS) {
                const f32x4 x0 = bf4(Rb.m[it]), xm = bf4(Ra.m[it]) * fp, xp = bf4(Rc.m[it]) * fn, m4 = mur[it];
                const f32x4 ps = x0 + m4 * ((xm + xp) * 0.5f - x0);
                if (it < 3) { const int head = c >> 6, kx = c & 63; st4bf_(SCN + (size_t)(row * 12 + head) * SC_REC + SC_R + kx * 2, ps); }
                else if (it < 6) { const int c1 = c - 768, head = c1 >> 6, kx = c1 & 63; const f32x4 kv = ps * kxr[it < 6 ? (it >= 3 ? it - 3 : 0) : 0];
                    const float ss = sum16(kv[0] * kv[0] + kv[1] * kv[1] + kv[2] * kv[2] + kv[3] * kv[3]); const float rn = rsqrtf(ss + 1e-12f);
                    unsigned char* base = SCN + (size_t)(row * 12 + head) * SC_REC + kx * 2;
                    st4bf_(base + SC_KK, kv * rn); st4bf_(base + SC_KR, ps); st4bf_(base + SC_KR + 256, ps); }
                else if (it < 9) { const int c1 = c - 1536, head = c1 >> 6, kx = c1 & 63; st4bf_(SCN + (size_t)(row * 12 + head) * SC_REC + SC_V + kx * 2, ps); }
                else { const int c1 = c - 2304; f32x4 o;
                    if (c1 < 128) { o = (f32x4){tanh_fast(ps[0]), tanh_fast(ps[1]), tanh_fast(ps[2]), tanh_fast(ps[3])}; }
                    else if (c1 < 256) { o = ps; }
                    else { o = (f32x4){sigmoidf_(ps[0]), sigmoidf_(ps[1]), sigmoidf_(ps[2]), sigmoidf_(ps[3])}; }
                    st4bf(LIN + (size_t)row * LORA_K + c1, o); }
            }
        }
        Ra = Rb; Rb = Rc; Rc = Rd;
    }
}

__device__ __forceinline__ int scan_row(int i, int b, int d) {
    if (d == 0) return i < CTXL ? NLAT + b * CTXL + i : b * TT + (i - CTXL);
    return i < CTXL ? NLAT + b * CTXL + (CTXL - 1 - i) : b * TT + (TT - 1 - (i - CTXL));
}
__device__ __forceinline__ float red8(float v) {
    v += __uint_as_float((unsigned)__builtin_amdgcn_update_dpp(0, (int)__float_as_uint(v), 0xB1, 0xF, 0xF, true));
    v += __uint_as_float((unsigned)__builtin_amdgcn_update_dpp(0, (int)__float_as_uint(v), 0x4E, 0xF, 0xF, true));
    v += __uint_as_float((unsigned)__builtin_amdgcn_update_dpp(0, (int)__float_as_uint(v), 0x141, 0xF, 0xF, true));
    return v;
}
__device__ __forceinline__ float red16(float v) {
    v += __uint_as_float((unsigned)__builtin_amdgcn_update_dpp(0, (int)__float_as_uint(v), 0xB1, 0xF, 0xF, true));
    v += __uint_as_float((unsigned)__builtin_amdgcn_update_dpp(0, (int)__float_as_uint(v), 0x4E, 0xF, 0xF, true));
    v += __uint_as_float((unsigned)__builtin_amdgcn_update_dpp(0, (int)__float_as_uint(v), 0x141, 0xF, 0xF, true));
    v += __uint_as_float((unsigned)__builtin_amdgcn_update_dpp(0, (int)__float_as_uint(v), 0x140, 0xF, 0xF, true));
    return v;
}
__device__ __forceinline__ void phase_scan(const Ctx& C, const Args& A) {
    for (int u = blockIdx.x; u < 192; u += C.G) {
    const int half = u & 1, d = (u >> 1) & 1, h = (u >> 2) % 12, b = u / 48;
    const unsigned char* SCN = A.ws + WS_SCN; float* Y = (float*)(A.ws + WS_Y) + (size_t)d * MROWS * 768;
    LAS float* buf = (LAS float*)C.lds; LAS float* ybuf = buf + 2 * 32 * 352;
    constexpr int NCH = LKEYS / 32;
    u32x4 st[4];
    int ps_[4], psrc[4], pdst[4]; bool pf32[4];
#pragma unroll
    for (int j = 0; j < 4; ++j) { const int p = C.tid + NTHR * j; const int s = p / 52, q = p % 52; ps_[j] = s;
        if (q < 16) { psrc[j] = SC_W + 256 * d + q * 16; pdst[j] = s * 352 + q * 4; pf32[j] = true; }
        else if (q < 48) { const int vec = (q - 16) >> 3, part = (q - 16) & 7; const int so = vec == 0 ? SC_KK : vec == 1 ? SC_B + 256 * d : vec == 2 ? SC_KR + 256 * d : SC_R;
            psrc[j] = so + part * 16; pdst[j] = s * 352 + 64 * (vec + 1) + part * 8; pf32[j] = false; }
        else { const int part = q - 48; psrc[j] = SC_V + half * 64 + part * 16; pdst[j] = s * 352 + 320 + part * 8; pf32[j] = false; } }
    const int sgn = d ? -1 : 1;
    const unsigned char* SCNh = SCN + (size_t)h * SC_REC;
#define SCAN_ROW0(c) (((c) * 32 < CTXL) ? (NLAT + b * CTXL + (d ? CTXL - 1 - (c) * 32 : (c) * 32)) : (b * TT + (d ? TT - 1 - ((c) * 32 - CTXL) : (c) * 32 - CTXL)))
#define SCAN_LOADG(c) do { const int row0_ = SCAN_ROW0(c); _Pragma("unroll") for (int j = 0; j < 4; ++j) if (j < 3 || C.tid < 1664 - 3 * NTHR) { \
        st[j] = *(const u32x4*)(SCNh + (size_t)(row0_ + sgn * ps_[j]) * SC_ROW + psrc[j]); } } while (0)
#define SCAN_STORE(bi) do { _Pragma("unroll") for (int j = 0; j < 4; ++j) if (j < 3 || C.tid < 1664 - 3 * NTHR) { LAS float* dp = buf + (bi) * (32 * 352) + pdst[j]; \
        if (pf32[j]) *(LAS u32x4*)dp = st[j]; \
        else { *(LAS f32x4*)dp = (f32x4){bflo(st[j].x), bfhi(st[j].x), bflo(st[j].y), bfhi(st[j].y)}; *(LAS f32x4*)(dp + 4) = (f32x4){bflo(st[j].z), bfhi(st[j].z), bflo(st[j].w), bfhi(st[j].w)}; } } } while (0)
    SCAN_LOADG(0); SCAN_STORE(0); __syncthreads();
    f32x2 Sa = {0.f, 0.f}, Sb = {0.f, 0.f};
    const int rl = C.lane >> 4, ks = C.lane & 15;
    float ycol = 0.f;
#define SC_LD(R, s) do { const LAS float* bp_ = cur + (s) * 352 + ks * 4; \
        R##w = *(const LAS f32x4*)(bp_); R##k = *(const LAS f32x4*)(bp_ + 64); R##b = *(const LAS f32x4*)(bp_ + 128); R##q = *(const LAS f32x4*)(bp_ + 192); R##r = *(const LAS f32x4*)(bp_ + 256); \
        R##vv = cur[(s) * 352 + 320 + C.wave * 4 + rl]; } while (0)
#define SC_LO(v) ((f32x2){v[0], v[1]})
#define SC_HI(v) ((f32x2){v[2], v[3]})
#define SC_DPP(x, ctrl) __uint_as_float((unsigned)__builtin_amdgcn_update_dpp(0, (int)__float_as_uint(x), ctrl, 0xF, 0xF, true))
#define SC_STEP(R, P, s) do { \
        f32x2 pa = __builtin_elementwise_fma(Sb, SC_HI(R##k), Sa * SC_LO(R##k)), py = __builtin_elementwise_fma(Sb, SC_HI(P##r), Sa * SC_LO(P##r)); \
        float a_ = pa.x + pa.y, y_ = py.x + py.y; \
        a_ += SC_DPP(a_, 0xB1); y_ += SC_DPP(y_, 0xB1); a_ += SC_DPP(a_, 0x4E); y_ += SC_DPP(y_, 0x4E); \
        a_ += SC_DPP(a_, 0x141); y_ += SC_DPP(y_, 0x141); a_ += SC_DPP(a_, 0x140); y_ += SC_DPP(y_, 0x140); \
        ycol = (ks == ((s) & 15)) ? y_ : ycol; \
        const f32x2 na = {-a_, -a_}, vv2 = {R##vv, R##vv}; \
        Sa = __builtin_elementwise_fma(Sa, SC_LO(R##w), __builtin_elementwise_fma(na, SC_LO(R##b), vv2 * SC_LO(R##q))); \
        Sb = __builtin_elementwise_fma(Sb, SC_HI(R##w), __builtin_elementwise_fma(na, SC_HI(R##b), vv2 * SC_HI(R##q))); } while (0)
    f32x4 Aw, Ak, Ab, Aq, Ar, Bw, Bk, Bb, Bq, Br, Cw, Ck, Cb, Cq, Cr, Dw, Dk, Db, Dq, Dr; float Avv, Bvv, Cvv, Dvv;
    Dr = (f32x4){0.f, 0.f, 0.f, 0.f};
    for (int c = 0; c < NCH; ++c) {
        if (c + 1 < NCH) SCAN_LOADG(c + 1);
        {
            const LAS float* cur = buf + (c & 1) * (32 * 352);
            LAS float* yb = ybuf + (c & 1) * 1024 + C.wave * 4 + rl + ks * 32;
            SC_LD(A, 0); SC_LD(B, 1);
#pragma unroll 1
            for (int s = 0; s < 32; s += 4) {
                SC_LD(C, s + 2); __builtin_amdgcn_sched_barrier(0); SC_STEP(A, D, s); __builtin_amdgcn_sched_barrier(0);
                SC_LD(D, s + 3); __builtin_amdgcn_sched_barrier(0); SC_STEP(B, A, s + 1); __builtin_amdgcn_sched_barrier(0);
                SC_LD(A, s + 4); __builtin_amdgcn_sched_barrier(0); SC_STEP(C, B, s + 2); __builtin_amdgcn_sched_barrier(0);
                SC_LD(B, s + 5); __builtin_amdgcn_sched_barrier(0); SC_STEP(D, C, s + 3); __builtin_amdgcn_sched_barrier(0);
                if ((s & 15) == 12) yb[(s & 16) * 32] = ycol;
            }
        }
        if (c + 1 < NCH) SCAN_STORE((c + 1) & 1);
        __syncthreads();
        { const int row0_ = SCAN_ROW0(c);
#pragma unroll
          for (int i = 0; i < 2; ++i) { const int e = C.tid + NTHR * i, s = e >> 5, r = e & 31;
            const int row = (s > 0) ? row0_ + sgn * (s - 1) : scan_row(c * 32 - 1, b, d);
            if (s > 0 || c > 0) Y[(size_t)row * 768 + h * 64 + half * 32 + r] = ybuf[(c & 1) * 1024 + e]; } }
    }
    {
        f32x2 py = __builtin_elementwise_fma(Sb, SC_HI(Dr), Sa * SC_LO(Dr)); float y_ = py.x + py.y;
        y_ += SC_DPP(y_, 0xB1); y_ += SC_DPP(y_, 0x4E); y_ += SC_DPP(y_, 0x141); y_ += SC_DPP(y_, 0x140);
        if (ks == 0) Y[(size_t)scan_row(LKEYS - 1, b, d) * 768 + h * 64 + half * 32 + C.wave * 4 + rl] = y_;
    }
    __syncthreads();
    }
#undef SCAN_LOADG
#undef SCAN_STORE
#undef SCAN_ROW0
#undef SC_LD
#undef SC_STEP
#undef SC_LO
#undef SC_HI
#undef SC_DPP
}

constexpr int CSP = 72;
constexpr int CS_MAT = 64 * CSP * 2;
constexpr int CS_WT = 0, CS_KB = CS_MAT, CS_BB = 2 * CS_MAT, CS_RT = 3 * CS_MAT, CS_BHT = 4 * CS_MAT, CS_KHT = 5 * CS_MAT, CS_VMT = 6 * CS_MAT;
constexpr int CS_M2F = 7 * CS_MAT;
constexpr int CS_M1T = CS_M2F + 16384;
constexpr int CS_N2 = CS_M1T + CS_MAT;
constexpr int CS_GT = CS_N2 + CS_MAT;
constexpr int CS_Z = CS_M2F, CS_U = CS_M2F + CS_MAT;
constexpr int CS_GL = CS_GT + 2 * CS_MAT;
static_assert(CS_GL + 256 <= LDS_MISC, "chunked-scan LDS map");
template <bool SWZB = false>
__device__ __forceinline__ void cs_mma(f32x16& acc, const LAS unsigned char* Am, const LAS unsigned char* Bm, int ti, int tj, int r32, int hi) {
    const LAS unsigned char* ap = Am + (ti * 32 + r32) * (CSP * 2) + hi * 16; const int brow = tj * 32 + r32; const LAS unsigned char* bp = Bm + brow * (CSP * 2);
    const int sw = SWZB ? ((brow >> 3) & 7) : 0;
#pragma unroll
    for (int ks = 0; ks < 4; ++ks) acc = __builtin_amdgcn_mfma_f32_32x32x16_bf16(*(const LAS bf16x8*)(ap + ks * 32), *(const LAS bf16x8*)(bp + (((ks * 2 + hi) ^ sw) * 16)), acc, 0, 0, 0);
}
__device__ __forceinline__ void cs_store_t(LAS unsigned char* Om, const f32x16& acc, int ti, int tj, int r32, int hi) {
    LAS unsigned char* op = Om + (tj * 32 + r32) * (CSP * 2) + (ti * 32 + 4 * hi) * 2;
#pragma unroll
    for (int g = 0; g < 4; ++g) { u32x2 o; o.x = pk2(acc[4 * g], acc[4 * g + 1]); o.y = pk2(acc[4 * g + 2], acc[4 * g + 3]); *(LAS u32x2*)(op + g * 16) = o; }
}
#define CS_BAR() asm volatile("s_waitcnt lgkmcnt(0)\n\ts_barrier" ::: "memory")
__device__ __forceinline__ void phase_csa(const Ctx& C, const Args& A) {
    const unsigned char* SCN = A.ws + WS_SCN; unsigned char* CHK = A.ws + WS_CHK;
    LAS unsigned char* L = C.lds;
    const int r32 = C.lane & 31, hi = C.lane >> 5;
    float lwv[8]; u32x4 ukk, ub, ukr, ur, uv;
#define CSA_GEOM(cu_) const int unit = (cu_) / CS_NCH, ch = (cu_) % CS_NCH; const int d = unit & 1, h = (unit >> 1) % 12, b = unit / 24; \
        const int step0 = ch * CS_L; const int sgn = d ? -1 : 1; \
        const int row0 = (step0 < CTXL) ? (NLAT + b * CTXL + (d ? CTXL - 1 - step0 : step0)) : (b * TT + (d ? TT - 1 - (step0 - CTXL) : step0 - CTXL)); \
        const unsigned char* rec0 = SCN + (size_t)row0 * SC_ROW + (size_t)h * SC_REC;
#define CSA_LOAD(cu_) do { CSA_GEOM(cu_); \
        { const int k = C.tid & 63, sg = C.tid >> 6; _Pragma("unroll") for (int j = 0; j < 8; ++j) lwv[j] = *(const float*)(rec0 + (long)sgn * (8 * sg + j) * SC_ROW + SC_W + 256 * d + k * 4); } \
        { const int t = C.tid >> 3, k0 = (C.tid & 7) * 8; const unsigned char* rp = rec0 + (long)sgn * t * SC_ROW; \
          ukk = *(const u32x4*)(rp + SC_KK + k0 * 2); ub = *(const u32x4*)(rp + SC_B + 256 * d + k0 * 2); ukr = *(const u32x4*)(rp + SC_KR + 256 * d + k0 * 2); ur = *(const u32x4*)(rp + SC_R + k0 * 2); uv = *(const u32x4*)(rp + SC_V + k0 * 2); } } while (0)
    if ((int)blockIdx.x < CS_UNITS * CS_NCH) CSA_LOAD((int)blockIdx.x);
    for (int cu = blockIdx.x; cu < CS_UNITS * CS_NCH; cu += C.G) {
        LAS float* csf = (LAS float*)(L + CS_M2F);
        LAS float* seg = (LAS float*)(L + CS_N2);
        { const int k = C.tid & 63, sg = C.tid >> 6;
#pragma unroll
          for (int j = 1; j < 8; ++j) lwv[j] += lwv[j - 1];
          seg[sg * 64 + k] = lwv[7];
          CS_BAR();
          float off = 0.f, tot = 0.f;
#pragma unroll
          for (int s2 = 0; s2 < 8; ++s2) { const float v = seg[s2 * 64 + k]; off += (s2 < sg) ? v : 0.f; tot += v; }
#pragma unroll
          for (int j = 0; j < 8; ++j) csf[(8 * sg + j) * 65 + k] = lwv[j] + off;
          if (sg == 7) ((LAS float*)(L + CS_GL))[k] = __expf(tot); }
        CS_BAR();
        { const int t = C.tid >> 3, k0 = (C.tid & 7) * 8;
          float wt[8], kb[8], bb[8], rt[8], bh[8], kh[8];
#pragma unroll
          for (int j = 0; j < 8; ++j) { const unsigned pkk = j < 2 ? ukk.x : j < 4 ? ukk.y : j < 6 ? ukk.z : ukk.w, pb = j < 2 ? ub.x : j < 4 ? ub.y : j < 6 ? ub.z : ub.w, pkr = j < 2 ? ukr.x : j < 4 ? ukr.y : j < 6 ? ukr.z : ukr.w, pr = j < 2 ? ur.x : j < 4 ? ur.y : j < 6 ? ur.z : ur.w;
              const float kkv = (j & 1) ? bfhi(pkk) : bflo(pkk), bv = (j & 1) ? bfhi(pb) : bflo(pb), krv = (j & 1) ? bfhi(pkr) : bflo(pkr), rv = (j & 1) ? bfhi(pr) : bflo(pr);
              const float cst = csf[t * 65 + k0 + j], csp = t > 0 ? csf[(t - 1) * 65 + k0 + j] : 0.f, csl = csf[63 * 65 + k0 + j];
              const float einv = __expf(-cst), el = __expf(csl - cst);
              wt[j] = kkv * __expf(csp); kb[j] = krv * einv; bb[j] = bv * einv; rt[j] = rv * __expf(cst); bh[j] = bv * el; kh[j] = krv * el; }
          u32x4 o;
          o.x = pk2(wt[0], wt[1]); o.y = pk2(wt[2], wt[3]); o.z = pk2(wt[4], wt[5]); o.w = pk2(wt[6], wt[7]); *(LAS u32x4*)(L + CS_WT + t * (CSP * 2) + k0 * 2) = o;
          o.x = pk2(kb[0], kb[1]); o.y = pk2(kb[2], kb[3]); o.z = pk2(kb[4], kb[5]); o.w = pk2(kb[6], kb[7]); *(LAS u32x4*)(L + CS_KB + t * (CSP * 2) + k0 * 2) = o;
          o.x = pk2(bb[0], bb[1]); o.y = pk2(bb[2], bb[3]); o.z = pk2(bb[4], bb[5]); o.w = pk2(bb[6], bb[7]); *(LAS u32x4*)(L + CS_BB + t * (CSP * 2) + k0 * 2) = o;
          o.x = pk2(rt[0], rt[1]); o.y = pk2(rt[2], rt[3]); o.z = pk2(rt[4], rt[5]); o.w = pk2(rt[6], rt[7]); *(LAS u32x4*)(L + CS_RT + t * (CSP * 2) + k0 * 2) = o;
#pragma unroll
          for (int j = 0; j < 8; ++j) { const int to = ((((t >> 3) ^ ((k0 >> 3) & 7)) * 8) + (t & 7)) * 2;
              *(LAS bf16_t*)(L + CS_BHT + (k0 + j) * (CSP * 2) + to) = (bf16_t)f2bf(bh[j]); *(LAS bf16_t*)(L + CS_KHT + (k0 + j) * (CSP * 2) + to) = (bf16_t)f2bf(kh[j]);
              const unsigned pv = j < 2 ? uv.x : j < 4 ? uv.y : j < 6 ? uv.z : uv.w; *(LAS bf16_t*)(L + CS_VMT + (k0 + j) * (CSP * 2) + to) = (bf16_t)((j & 1) ? (pv >> 16) : (pv & 0xffffu)); } }
        if (cu + C.G < CS_UNITS * CS_NCH) CSA_LOAD(cu + C.G);
        CS_BAR();
        for (int job = C.wave; job < 12; job += NWAVES) { const int p = job >> 2, ti = (job >> 1) & 1, tj = job & 1;
            f32x16 acc;
#pragma unroll
            for (int i = 0; i < 16; ++i) acc[i] = 0.f;
            if (p == 0) { cs_mma(acc, L + CS_WT, L + CS_BB, ti, tj, r32, hi);
                const int i = tj * 32 + r32; LAS float* mp = (LAS float*)(L + CS_M2F) + i * 64;
#pragma unroll
                for (int reg = 0; reg < 16; ++reg) { const int t = ti * 32 + crow(reg, hi); mp[(t & 3) * 16 + (t >> 2)] = (i < t) ? acc[reg] : 0.f; } }
            else if (p == 1) { cs_mma(acc, L + CS_WT, L + CS_KB, ti, tj, r32, hi);
                const int i = tj * 32 + r32;
#pragma unroll
                for (int reg = 0; reg < 16; ++reg) { const int t = ti * 32 + crow(reg, hi); acc[reg] = (i < t) ? acc[reg] : 0.f; }
                cs_store_t(L + CS_M1T, acc, ti, tj, r32, hi); }
            else { cs_mma(acc, L + CS_BB, L + CS_RT, ti, tj, r32, hi);
                const int t = tj * 32 + r32;
#pragma unroll
                for (int reg = 0; reg < 16; ++reg) { const int i = ti * 32 + crow(reg, hi); acc[reg] = (i <= t) ? acc[reg] : 0.f; }
                cs_store_t(L + CS_N2, acc, ti, tj, r32, hi); } }
        CS_BAR();
        { const int c = C.tid >> 2, q = C.tid & 3; f32x2 acc2[8];
          { const LAS unsigned char* rcol = (c < 64) ? (L + CS_WT + c * 2) : (L + CS_M1T + (c - 64) * (CSP * 2)); const int rstride = (c < 64) ? CSP * 2 : 2;
#pragma unroll
            for (int j = 0; j < 16; ++j) acc2[j >> 1][j & 1] = bf2f(*(const LAS bf16_t*)(rcol + (4 * j + q) * rstride)); }
          const LAS float* m2c = (const LAS float*)(L + CS_M2F) + q * 16;
#pragma clang loop unroll(full)
          for (int i = 0; i < 64; ++i) {
              const float mine = -acc2[i >> 3][(i >> 2) & 1];
              float gi;
              switch (i & 3) { case 0: gi = __uint_as_float((unsigned)__builtin_amdgcn_update_dpp(0, (int)__float_as_uint(mine), 0x00, 0xF, 0xF, true)); break;
                               case 1: gi = __uint_as_float((unsigned)__builtin_amdgcn_update_dpp(0, (int)__float_as_uint(mine), 0x55, 0xF, 0xF, true)); break;
                               case 2: gi = __uint_as_float((unsigned)__builtin_amdgcn_update_dpp(0, (int)__float_as_uint(mine), 0xAA, 0xF, 0xF, true)); break;
                               default: gi = __uint_as_float((unsigned)__builtin_amdgcn_update_dpp(0, (int)__float_as_uint(mine), 0xFF, 0xF, 0xF, true)); break; }
              const f32x2 g2 = {gi, gi};
#pragma unroll
              for (int j4 = (i >> 4); j4 < 4; ++j4) { const f32x4 m = *(const LAS f32x4*)(m2c + i * 64 + j4 * 4);
#pragma unroll
                  for (int h = 0; h < 2; ++h) { const int p = 2 * j4 + h;
                      if (2 * p >= (i >> 2)) acc2[p] += (f32x2){m[2 * h], m[2 * h + 1]} * g2;
                      else if (2 * p + 1 >= (i >> 2)) acc2[p][1] += m[2 * h + 1] * gi; } }
          }
#pragma unroll
          for (int j = 0; j < 16; ++j) *(LAS bf16_t*)(L + CS_GT + c * (CSP * 2) + (4 * j + q) * 2) = (bf16_t)f2bf(-acc2[j >> 1][j & 1]); }
        CS_BAR();
        unsigned char* outp = CHK + (size_t)cu * 32768;
        for (int job = C.wave; job < 16; job += NWAVES) { const int p = job >> 2, ti = (job >> 1) & 1, tj = job & 1;
            f32x16 acc;
            if (p == 0) {
                const LAS unsigned char* rp = L + CS_RT + (tj * 32 + r32) * (CSP * 2) + (ti * 32 + 4 * hi) * 2;
#pragma unroll
                for (int g = 0; g < 4; ++g) { const u32x2 u = *(const LAS u32x2*)(rp + g * 16); acc[4 * g] = bflo(u.x); acc[4 * g + 1] = bfhi(u.x); acc[4 * g + 2] = bflo(u.y); acc[4 * g + 3] = bfhi(u.y); }
                cs_mma(acc, L + CS_GT, L + CS_N2, ti, tj, r32, hi);
#pragma unroll
                for (int g = 0; g < 4; ++g) { u32x2 o; o.x = pk2(acc[4 * g], acc[4 * g + 1]); o.y = pk2(acc[4 * g + 2], acc[4 * g + 3]);
                    *(u32x2*)(outp + 8192 + (((tj * 4 + 2 * ti + (g >> 1)) * 64 + (g & 1) * 32 + r32) * 16) + hi * 8) = o; } }
            else if (p == 1) {
#pragma unroll
                for (int i = 0; i < 16; ++i) acc[i] = 0.f;
                cs_mma(acc, L + CS_KB, L + CS_RT, ti, tj, r32, hi);
                const int t = tj * 32 + r32;
#pragma unroll
                for (int reg = 0; reg < 16; ++reg) { const int i = ti * 32 + crow(reg, hi); acc[reg] = (i <= t) ? acc[reg] : 0.f; }
                cs_mma(acc, L + CS_GT + 64 * (CSP * 2), L + CS_N2, ti, tj, r32, hi);
                cs_store_t(L + CS_Z, acc, ti, tj, r32, hi); }
            else if (p == 2) {
#pragma unroll
                for (int i = 0; i < 16; ++i) acc[i] = 0.f;
                cs_mma<true>(acc, L + CS_GT, L + CS_BHT, ti, tj, r32, hi);
                const int k = tj * 32 + r32; const float gl = ((const LAS float*)(L + CS_GL))[k];
#pragma unroll
                for (int reg = 0; reg < 16; ++reg) { const int cc = ti * 32 + crow(reg, hi); acc[reg] += (cc == k) ? gl : 0.f; }
#pragma unroll
                for (int g = 0; g < 4; ++g) { u32x2 o; o.x = pk2(acc[4 * g], acc[4 * g + 1]); o.y = pk2(acc[4 * g + 2], acc[4 * g + 3]);
                    *(u32x2*)(outp + (((tj * 4 + 2 * ti + (g >> 1)) * 64 + (g & 1) * 32 + r32) * 16) + hi * 8) = o; } }
            else {
                const int krow = tj * 32 + r32; const LAS unsigned char* kp = L + CS_KHT + krow * (CSP * 2) + hi * 8;
#pragma unroll
                for (int g = 0; g < 4; ++g) { const u32x2 u = *(const LAS u32x2*)(kp + (((ti * 4 + g) ^ ((krow >> 3) & 7)) * 16)); acc[4 * g] = bflo(u.x); acc[4 * g + 1] = bfhi(u.x); acc[4 * g + 2] = bflo(u.y); acc[4 * g + 3] = bfhi(u.y); }
                cs_mma<true>(acc, L + CS_GT + 64 * (CSP * 2), L + CS_BHT, ti, tj, r32, hi);
                cs_store_t(L + CS_U, acc, ti, tj, r32, hi); } }
        CS_BAR();
        { const int p = C.wave >> 2, ti = (C.wave >> 1) & 1, tj = C.wave & 1;
          f32x16 acc;
#pragma unroll
          for (int i = 0; i < 16; ++i) acc[i] = 0.f;
          cs_mma<true>(acc, L + (p ? CS_U : CS_Z), L + CS_VMT, ti, tj, r32, hi);
          unsigned char* op = outp + (p ? 16384 : 24576) + ((ti * 2 + tj) * 64 + C.lane) * 32;
          u32x4 o0, o1; o0.x = pk2(acc[0], acc[1]); o0.y = pk2(acc[2], acc[3]); o0.z = pk2(acc[4], acc[5]); o0.w = pk2(acc[6], acc[7]);
          o1.x = pk2(acc[8], acc[9]); o1.y = pk2(acc[10], acc[11]); o1.z = pk2(acc[12], acc[13]); o1.w = pk2(acc[14], acc[15]);
          *(u32x4*)op = o0; *(u32x4*)(op + 16) = o1; }
        CS_BAR();
    }
}
__device__ __forceinline__ void phase_csb(const Ctx& C, const Args& A, int l) {
    if ((int)blockIdx.x >= CS_UNITS) { const int gwf = ((int)blockIdx.x - CS_UNITS) * NWAVES + C.wave, ngwf = (C.G - CS_UNITS) * NWAVES;
        conv_items(C, A, l + 1, gwf, ngwf, true, false, false); conv_items(C, A, l + 1, gwf, ngwf, false, false, true, XW_TK_HI); return; }
    const unsigned char* CHK = A.ws + WS_CHK;
    LAS unsigned char* L = C.lds;
    const int r32 = C.lane & 31, hi = C.lane >> 5;
    const bool isS = C.wave < 4; const int ti = (C.wave >> 1) & 1, tj = C.wave & 1;
    for (int unit = blockIdx.x; unit < CS_UNITS; unit += C.G) {
        const int d = unit & 1, h = (unit >> 1) % 12, b = unit / 24;
        float* Y = (float*)(A.ws + WS_Y) + (size_t)d * MROWS * 768;
        for (int i = C.tid; i < 2 * CS_MAT / 4; i += NTHR) ((LAS unsigned*)L)[i] = 0u;
        CS_BAR();
        bf16x8 afA[4], afB[4], afC[4]; u32x4 cA0, cA1, cB0, cB1, cC0, cC1;
#define CSB_LOAD(A4, C0, C1, ch_) do { const unsigned char* op_ = CHK + ((size_t)unit * CS_NCH + (ch_)) * 32768; \
            const unsigned char* am_ = op_ + (isS ? 0 : 8192) + (ti * 4 * 64 + C.lane) * 16;     \
            _Pragma("unroll") for (int ks = 0; ks < 4; ++ks) A4[ks] = *(const bf16x8*)(am_ + ks * 1024); \
            const unsigned char* cp_ = op_ + (isS ? 16384 : 24576) + ((ti * 2 + tj) * 64 + C.lane) * 32; C0 = *(const u32x4*)cp_; C1 = *(const u32x4*)(cp_ + 16); } while (0)
#define CSB_STEP(A4, C0, C1, ch_) do { \
            const LAS unsigned char* Sb = L + ((ch_) & 1) * CS_MAT; LAS unsigned char* Sn = L + (((ch_) + 1) & 1) * CS_MAT; \
            f32x16 acc; \
            acc[0] = bflo(C0.x); acc[1] = bfhi(C0.x); acc[2] = bflo(C0.y); acc[3] = bfhi(C0.y); acc[4] = bflo(C0.z); acc[5] = bfhi(C0.z); acc[6] = bflo(C0.w); acc[7] = bfhi(C0.w); \
            acc[8] = bflo(C1.x); acc[9] = bfhi(C1.x); acc[10] = bflo(C1.y); acc[11] = bfhi(C1.y); acc[12] = bflo(C1.z); acc[13] = bfhi(C1.z); acc[14] = bflo(C1.w); acc[15] = bfhi(C1.w); \
            const LAS unsigned char* bp = Sb + (tj * 32 + r32) * (CSP * 2) + hi * 16; \
            _Pragma("unroll") for (int ks = 0; ks < 4; ++ks) acc = __builtin_amdgcn_mfma_f32_32x32x16_bf16(A4[ks], *(const LAS bf16x8*)(bp + ks * 32), acc, 0, 0, 0); \
            if (isS) { cs_store_t(Sn, acc, ti, tj, r32, hi); }     \
            else {     \
                const int step0 = (ch_) * CS_L; const int sgn = d ? -1 : 1; \
                const int row0 = (step0 < CTXL) ? (NLAT + b * CTXL + (d ? CTXL - 1 - step0 : step0)) : (b * TT + (d ? TT - 1 - (step0 - CTXL) : step0 - CTXL)); \
                float* yp = Y + (size_t)(row0 + sgn * (ti * 32 + 4 * hi)) * 768 + h * 64 + tj * 32 + r32; const long ys = (long)sgn * 768; \
                _Pragma("unroll") for (int reg = 0; reg < 16; ++reg) yp[ys * ((reg & 3) + 8 * (reg >> 2))] = acc[reg]; } \
            CS_BAR(); } while (0)
        CSB_LOAD(afA, cA0, cA1, 0); CSB_LOAD(afB, cB0, cB1, 1);
        static_assert(CS_NCH % 3 == 0, "chunk loop is unrolled by three");
        for (int ch = 0; ch < CS_NCH; ch += 3) {
            if (ch == 0) CSB_LOAD(afC, cC0, cC1, 2);
            CSB_STEP(afA, cA0, cA1, ch);     if (ch + 3 < CS_NCH) CSB_LOAD(afA, cA0, cA1, ch + 3);
            CSB_STEP(afB, cB0, cB1, ch + 1); if (ch + 4 < CS_NCH) CSB_LOAD(afB, cB0, cB1, ch + 4);
            CSB_STEP(afC, cC0, cC1, ch + 2); if (ch + 5 < CS_NCH) CSB_LOAD(afC, cC0, cC1, ch + 5);
        }
        CS_BAR();
    }
#undef CSB_LOAD
#undef CSB_STEP
}

#undef CS_BAR
struct Ef2Row { f32x4 y0[3], y1[3]; u32x2 r[3], v[3], k0[3], k1[3], g[3]; };
__device__ __forceinline__ void ef2_load(Ef2Row& R, const float* Y0, const float* Y1, const unsigned char* SCN, const bf16_t* G, int row, int lane) {
#pragma unroll
    for (int it = 0; it < 3; ++it) { const int c = it * 256 + 4 * lane, head = c >> 6, kx = c & 63;
        R.y0[it] = *(const f32x4*)(Y0 + (size_t)row * 768 + c); R.y1[it] = *(const f32x4*)(Y1 + (size_t)row * 768 + c);
        const unsigned char* base = SCN + (size_t)(row * 12 + head) * SC_REC + kx * 2;
        R.r[it] = *(const u32x2*)(base + SC_R); R.v[it] = *(const u32x2*)(base + SC_V); R.k0[it] = *(const u32x2*)(base + SC_KR); R.k1[it] = *(const u32x2*)(base + SC_KR + 256);
        R.g[it] = *(const u32x2*)(G + (size_t)row * 768 + c); }
}
__device__ __forceinline__ void phase_ef2(const Ctx& C, const Args& A, int l) {
    const int i2 = l >> 1; unsigned char* ws = A.ws;
    const unsigned char* SCN = ws + WS_SCN; const float* Y0 = (const float*)(ws + WS_Y); const float* Y1 = Y0 + (size_t)MROWS * 768;
    const bf16_t* G = (const bf16_t*)(ws + WS_G); bf16_t* A2 = (bf16_t*)(ws + WS_A2);
    const float* rb = A.in[I_RBON] + (size_t)i2 * 768; const float* gg = A.in[I_GNG] + (size_t)i2 * 768; const float* gb = A.in[I_GNB] + (size_t)i2 * 768;
    f32x4 rbr[3], ggr[3], gbr[3];
#pragma unroll
    for (int it = 0; it < 3; ++it) { const int c = it * 256 + 4 * C.lane; rbr[it] = *(const f32x4*)(rb + c); ggr[it] = *(const f32x4*)(gg + c); gbr[it] = *(const f32x4*)(gb + c); }
    Ef2Row Rn;
    if (C.gw < MROWS) ef2_load(Rn, Y0, Y1, SCN, G, C.gw, C.lane);
    for (int row = C.gw; row < MROWS; row += C.NGW) {
        const Ef2Row R = Rn;
        { const int nr = row + C.NGW < MROWS ? row + C.NGW : row; ef2_load(Rn, Y0, Y1, SCN, G, nr, C.lane); }
#pragma unroll
        for (int it = 0; it < 3; ++it) {
            const int c = it * 256 + 4 * C.lane;
            const f32x4 y = R.y0[it] + R.y1[it];
            const float mean = sum16((y[0] + y[1]) + (y[2] + y[3])) * (1.f / 64.f);
            const f32x4 dd = y - mean;
            const float var = sum16((dd[0] * dd[0] + dd[1] * dd[1]) + (dd[2] * dd[2] + dd[3] * dd[3])) * (1.f / 64.f);
            const float rstd = rsqrtf(var + GN_EPS);
            const f32x4 r = bf4(R.r[it]), v = bf4(R.v[it]), k0 = bf4(R.k0[it]), k1 = bf4(R.k1[it]);
            const f32x4 t = r * (k0 + k1) * 0.5f * rbr[it];
            const float bs = sum16((t[0] + t[1]) + (t[2] + t[3]));
            const f32x4 yn = dd * rstd * ggr[it] + gbr[it];
            const f32x4 g = bf4(R.g[it]);
            st4bf(A2 + (size_t)row * DM + 256 + c, g * (yn + v * bs));
        }
    }
}

__device__ __forceinline__ void phase_of1(const Ctx& C, const Args& A, int l) {
    const int i2 = l >> 1; unsigned char* ws = A.ws;
    const bf16_t* P = (const bf16_t*)(ws + WS_P); bf16_t* A2 = (bf16_t*)(ws + WS_A2); bf16_t* VT = (bf16_t*)(ws + WS_VT);
    const float* lng = A.in[I_GLNG] + (size_t)i2 * 256; const float* lnb = A.in[I_GLNB] + (size_t)i2 * 256;
    const float* gws = A.in[I_GWS] + (size_t)i2 * 4 * 128 * 128; const float* gbs = A.in[I_GBS] + (size_t)i2 * 4 * 128;
    LAS bf16_t* vt = (LAS bf16_t*)C.lds;
    LAS bf16_t* uL = (LAS bf16_t*)C.lds;
    LAS bf16_t* vT = (LAS bf16_t*)(C.lds + 128 * 528);
    const int r32 = C.lane & 31, hi = C.lane >> 5;
    for (int it = blockIdx.x; it < 256 + 8 * 7; it += C.G) {
        const bool isctx = it >= 256; const int uc = isctx ? (it - 256) / 7 : 0, pc = isctx ? (it - 256) % 7 : 0; const int u = it;
        const int b = isctx ? (uc >> 1) : (u >> 6), pos0 = isctx ? (uc & 1) * 128 : (u & 63) * 128;
        const int row0 = isctx ? NLAT + b * CTXL + pos0 : b * TT + pos0, L0 = isctx ? pos0 : CTXL + pos0;
        const int hh0 = isctx ? pc : 0, hh1 = isctx ? (pc < 6 ? pc + 1 : 0) : 6; const bool doC = !isctx || pc == 6;
        u32x4 pv[4];
        if (hh0 < hh1) {
#pragma unroll
            for (int i = 0; i < 4; ++i) { const int piece = C.tid + NTHR * i, r = piece >> 4, part = piece & 15; pv[i] = *(const u32x4*)(P + (size_t)(row0 + r) * P_LD + 1536 + hh0 * 128 + part * 8); } }
        for (int hh = hh0; hh < hh1; ++hh) {
#pragma unroll
            for (int i = 0; i < 4; ++i) { const int piece = C.tid + NTHR * i, r = piece >> 4, part = piece & 15;
                *(LAS u32x4*)(vt + r * 136 + part * 8) = pv[i]; }
            __syncthreads();
            if (hh + 1 < hh1) {
#pragma unroll
                for (int i = 0; i < 4; ++i) { const int piece = C.tid + NTHR * i, r = piece >> 4, part = piece & 15; pv[i] = *(const u32x4*)(P + (size_t)(row0 + r) * P_LD + 1536 + (hh + 1) * 128 + part * 8); } }
#pragma unroll
            for (int i = 0; i < 4; ++i) { const int item = C.tid + NTHR * i, d = item >> 4, tg = item & 15; const LAS bf16_t* s = vt + (tg * 8) * 136 + d;
                u32x4 o; o.x = (unsigned)s[0] | ((unsigned)s[136] << 16); o.y = (unsigned)s[2 * 136] | ((unsigned)s[3 * 136] << 16);
                o.z = (unsigned)s[4 * 136] | ((unsigned)s[5 * 136] << 16); o.w = (unsigned)s[6 * 136] | ((unsigned)s[7 * 136] << 16);
                *(u32x4*)(VT + ((size_t)(b * 6 + hh) * 128 + d) * LKEYS + L0 + tg * 8) = o; }
            __syncthreads();
        }
        if (doC) {
        const f32x4 lngr = *(const f32x4*)(lng + 4 * C.lane), lnbr = *(const f32x4*)(lnb + 4 * C.lane);
        u32x2 nxu, nxr;
        { const bf16_t* pr = P + (size_t)(row0 + C.wave) * P_LD + 2304 + 4 * C.lane; nxu = *(const u32x2*)pr; nxr = *(const u32x2*)(pr + 256); }
        for (int r = C.wave; r < 128; r += NWAVES) {
            const int c4 = 4 * C.lane;
            const f32x4 ur = bf4(nxu), raw = bf4(nxr);
            if (r + NWAVES < 128) { const bf16_t* pr = P + (size_t)(row0 + r + NWAVES) * P_LD + 2304 + c4; nxu = *(const u32x2*)pr; nxr = *(const u32x2*)(pr + 256); }
            { const f32x4 gu = gelu4(ur); u32x2 o; o.x = pk2(gu[0], gu[1]); o.y = pk2(gu[2], gu[3]); *(LAS u32x2*)(uL + r * 264 + c4) = o; }
            const f32x4 gv = gelu4(raw);
            const float mean = wave_sum((gv[0] + gv[1]) + (gv[2] + gv[3])) * (1.f / 256.f); const f32x4 dd = gv - mean;
            const float var = wave_sum((dd[0] * dd[0] + dd[1] * dd[1]) + (dd[2] * dd[2] + dd[3] * dd[3])) * (1.f / 256.f); const float rstd = rsqrtf(var + LN_EPS);
            const f32x4 o = dd * rstd * lngr + lnbr;
#pragma unroll
            for (int k = 0; k < 4; ++k) vT[(c4 + k) * 136 + r] = (bf16_t)f2bf(o[k]);
        }
        __syncthreads();
        {
            const int g = C.wave >> 1, cblk = C.wave & 1, cc = g * 64 + cblk * 32 + r32;
            for (int pblk = 0; pblk < 4; ++pblk) {
                f32x16 acc;
#pragma unroll
                for (int i = 0; i < 16; ++i) acc[i] = 0.f;
                const float* wrow = gws + ((size_t)g * 128 + pblk * 32 + r32) * 128 + 8 * hi;
#pragma unroll
                for (int ks = 0; ks < 8; ++ks) { const f32x4 w0 = *(const f32x4*)(wrow + ks * 16), w1 = *(const f32x4*)(wrow + ks * 16 + 4);
                    u32x4 au; au.x = pk2(w0[0], w0[1]); au.y = pk2(w0[2], w0[3]); au.z = pk2(w1[0], w1[1]); au.w = pk2(w1[2], w1[3]);
                    const bf16x8 bf = *(const LAS bf16x8*)(vT + cc * 136 + ks * 16 + 8 * hi);
                    acc = __builtin_amdgcn_mfma_f32_32x32x16_bf16(__builtin_bit_cast(bf16x8, au), bf, acc, 0, 0, 0); }
#pragma unroll
                for (int reg = 0; reg < 16; ++reg) { const int p = pblk * 32 + crow(reg, hi);
                    const float uu = bf2f(uL[p * 264 + cc]); const float mixed = acc[reg] + gbs[g * 128 + p];
                    uL[p * 264 + cc] = (bf16_t)f2bf(uu * mixed); }
            }
        }
        __syncthreads();
#pragma unroll
        for (int i = 0; i < 8; ++i) { const int piece = C.tid + NTHR * i, r = piece >> 5, part = piece & 31;
            *(u32x4*)(A2 + (size_t)(row0 + r) * DM + 768 + part * 8) = *(const LAS u32x4*)(uL + r * 264 + part * 8); }
        __syncthreads();
        }
    }
}

__device__ __forceinline__ void phase_attn(const Ctx& C, const Args& A, int l) {
    const int i2 = l >> 1; unsigned char* ws = A.ws;
    const bf16_t* Q = (const bf16_t*)(ws + WS_Q); const bf16_t* KA = (const bf16_t*)(ws + WS_KA); const bf16_t* VT = (const bf16_t*)(ws + WS_VT); bf16_t* A2 = (bf16_t*)(ws + WS_A2);
    const float lam_init = 0.8f - 0.6f * expf(-0.3f * (float)l);
    float s1 = 0.f, s2 = 0.f;
    for (int j = 0; j < 64; ++j) { s1 += A.in[I_LQ1][i2 * 64 + j] * A.in[I_LK1][i2 * 64 + j]; s2 += A.in[I_LQ2][i2 * 64 + j] * A.in[I_LK2][i2 * 64 + j]; }
    const float lam = expf(s1) - expf(s2) + lam_init;
    const float* subg = A.in[I_SUBG] + (size_t)i2 * 128;
    const int r32 = C.lane & 31, hi = C.lane >> 5, map = C.wave >> 2, qw = C.wave & 3;
    LAS unsigned char* Kt = C.lds; LAS unsigned char* Vt = C.lds + 2 * 16384; LAS float* xch = (LAS float*)C.lds;
    const int NU = 1536 + (l == 1 ? 48 : 0);
    for (int n = C.vcu; n < NU; n += C.G) {
        int bh, qt; bool isctx = false;
        if (n < 1536) { const int round = n >> 8, slot = n & 255; bh = (slot >> 5) * 3 + (round >> 1); qt = (round & 1) * 32 + (slot & 31); }
        else { isctx = true; bh = (n - 1536) >> 1; qt = (n - 1536) & 1; }
        const int b = bh / 6, h = bh % 6;
        const int qrow0 = isctx ? NLAT + b * CTXL + qt * 128 : b * TT + qt * 128;
        const int NT = isctx ? CTXL / 64 : LKEYS / 64;
        const bf16_t* Kb = KA + (size_t)b * LKEYS * 768 + h * 128;
        const bf16_t* Vb = VT + (size_t)(b * 6 + h) * 128 * LKEYS;
        bf16x8 qf[4];
        { const bf16_t* qp = Q + (size_t)(qrow0 + qw * 32 + r32) * 768 + h * 128 + map * 64 + 8 * hi;
#pragma unroll
          for (int ks = 0; ks < 4; ++ks) qf[ks] = *(const bf16x8*)(qp + ks * 16); }
        f32x16 O[4];
#pragma unroll
        for (int d = 0; d < 4; ++d)
#pragma unroll
            for (int i = 0; i < 16; ++i) O[d][i] = 0.f;
        float m = 0.f, lsum = 0.f;
        unsigned ksrc[2], vsrc[2];
#pragma unroll
        for (int i = 0; i < 2; ++i) { const int row = 4 * (2 * C.wave + i) + (C.lane >> 4), x = row & 15, pi = x < 4 ? x : x < 8 ? x + 4 : x < 12 ? x - 4 : x;
            ksrc[i] = (unsigned)(((row & ~15) + pi) * 768 + (((C.lane & 15) ^ x) * 8));
            const int d = 8 * (2 * C.wave + i) + (C.lane >> 3); vsrc[i] = (unsigned)(d * LKEYS + (((C.lane & 7) ^ ((d >> 1) & 7)) * 8)); }
#define AT_DMA_K(tt, slot) do { _Pragma("unroll") for (int i = 0; i < 2; ++i) __builtin_amdgcn_global_load_lds((const unsigned*)(Kb + (size_t)(tt) * 64 * 768 + ksrc[i]), (LAS unsigned*)(Kt + (slot) * 16384 + (2 * C.wave + i) * 1024), 16, 0, 0); } while (0)
#define AT_DMA_V(tt, slot) do { _Pragma("unroll") for (int i = 0; i < 2; ++i) __builtin_amdgcn_global_load_lds((const unsigned*)(Vb + (size_t)(tt) * 64 + vsrc[i]), (LAS unsigned*)(Vt + (slot) * 16384 + (2 * C.wave + i) * 1024), 16, 0, 0); } while (0)
#define AT_BAR() asm volatile("s_waitcnt vmcnt(0) lgkmcnt(0)\n\ts_barrier" ::: "memory")
#define AT_SB() __builtin_amdgcn_sched_barrier(0)
        const int ksw = r32 & 15, vsw = (r32 >> 1) & 7;
#define AT_QK(P0, P1, ks_) do { const float nm_ = -m; _Pragma("unroll") for (int i = 0; i < 16; ++i) { P0[i] = nm_; P1[i] = nm_; } \
            const LAS unsigned char* kbp_ = Kt + (ks_) * 16384 + r32 * 256; \
            _Pragma("unroll") for (int ks = 0; ks < 4; ++ks) { const int co_ = ((map * 8 + ks * 2 + hi) ^ ksw) * 16; \
                P0 = __builtin_amdgcn_mfma_f32_32x32x16_bf16(*(const LAS bf16x8*)(kbp_ + co_), qf[ks], P0, 0, 0, 0); P1 = __builtin_amdgcn_mfma_f32_32x32x16_bf16(*(const LAS bf16x8*)(kbp_ + 32 * 256 + co_), qf[ks], P1, 0, 0, 0); } } while (0)
#define AT_LDV(dst, vs_, d) do { _Pragma("unroll") for (int kst = 0; kst < 4; ++kst) dst[kst] = *(const LAS u32x4*)(Vt + (vs_) * 16384 + ((d) * 32 + r32) * 128 + (((kst * 2 + hi) ^ vsw) * 16)); } while (0)
#define AT_PV(src, d) do { _Pragma("unroll") for (int kst = 0; kst < 4; ++kst) O[d] = __builtin_amdgcn_mfma_f32_32x32x16_bf16(__builtin_bit_cast(bf16x8, src[kst]), pb[kst], O[d], 0, 0, 0); } while (0)
#define AT_SOFTPV(P0, P1, N0, N1, first, hasn, vs_) do { \
            asm volatile("s_nop 15\n\ts_nop 7" : "+v"(P0), "+v"(P1)); \
            float mx = max3f(P0[0], P0[1], P1[0]), mx2 = max3f(P0[2], P0[3], P1[1]); mx = max3f(mx, P1[2], P1[3]); \
            _Pragma("unroll") for (int i = 4; i < 16; i += 4) { mx = max3f(mx, P0[i], P0[i + 1]); mx2 = max3f(mx2, P0[i + 2], P0[i + 3]); mx = max3f(mx, P1[i], P1[i + 1]); mx2 = max3f(mx2, P1[i + 2], P1[i + 3]); } \
            mx = fmaxf(mx, mx2); \
            { auto rr = __builtin_amdgcn_permlane32_swap(__float_as_uint(mx), __float_as_uint(mx), false, false); mx = fmaxf(__uint_as_float(rr[0]), __uint_as_float(rr[1])); } \
            if ((first) || __any(mx > 8.f)) { const float dl = (first) ? mx : fmaxf(mx, 0.f); const float sc = __builtin_amdgcn_exp2f(-dl); lsum *= sc; \
                _Pragma("unroll") for (int d = 0; d < 4; ++d) _Pragma("unroll") for (int i = 0; i < 16; ++i) O[d][i] *= sc; \
                _Pragma("unroll") for (int i = 0; i < 16; ++i) { P0[i] -= dl; P1[i] -= dl; } \
                if (hasn) { asm volatile("s_nop 15\n\ts_nop 7" : "+v"(N0), "+v"(N1)); _Pragma("unroll") for (int i = 0; i < 16; ++i) { N0[i] -= dl; N1[i] -= dl; } } \
                m += dl; } \
            float ps = 0.f, ps2 = 0.f; \
            _Pragma("unroll") for (int i = 0; i < 16; ++i) { P0[i] = __builtin_amdgcn_exp2f(P0[i]); P1[i] = __builtin_amdgcn_exp2f(P1[i]); ps += P0[i]; ps2 += P1[i]; } \
            lsum += ps + ps2; \
            bf16x8 pb[4]; \
            { u32x4 w; w.x = pk2(P0[0], P0[1]); w.y = pk2(P0[2], P0[3]); w.z = pk2(P0[4], P0[5]); w.w = pk2(P0[6], P0[7]); pb[0] = __builtin_bit_cast(bf16x8, w); \
              w.x = pk2(P0[8], P0[9]); w.y = pk2(P0[10], P0[11]); w.z = pk2(P0[12], P0[13]); w.w = pk2(P0[14], P0[15]); pb[1] = __builtin_bit_cast(bf16x8, w); \
              w.x = pk2(P1[0], P1[1]); w.y = pk2(P1[2], P1[3]); w.z = pk2(P1[4], P1[5]); w.w = pk2(P1[6], P1[7]); pb[2] = __builtin_bit_cast(bf16x8, w); \
              w.x = pk2(P1[8], P1[9]); w.y = pk2(P1[10], P1[11]); w.z = pk2(P1[12], P1[13]); w.w = pk2(P1[14], P1[15]); pb[3] = __builtin_bit_cast(bf16x8, w); } \
            u32x4 va[4]; \
            AT_LDV(va, vs_, 0); AT_SB(); AT_PV(va, 0); AT_SB(); AT_LDV(va, vs_, 1); AT_SB(); AT_PV(va, 1); AT_SB(); AT_LDV(va, vs_, 2); AT_SB(); AT_PV(va, 2); AT_SB(); AT_LDV(va, vs_, 3); AT_SB(); AT_PV(va, 3); AT_SB(); } while (0)
        f32x16 pA0, pA1, pB0, pB1;
        AT_DMA_K(0, 0); AT_DMA_V(0, 0); AT_DMA_K(1, 1);
        AT_BAR();
        AT_QK(pA0, pA1, 0);
        asm volatile("s_waitcnt lgkmcnt(0)\n\ts_barrier" ::: "memory");
        for (int t = 0; t < NT; t += 2) {
            if (t + 2 < NT) AT_DMA_K(t + 2, 0);
            AT_DMA_V(t + 1, 1);
            AT_SB(); AT_QK(pB0, pB1, 1); AT_SB();
            AT_SOFTPV(pA0, pA1, pB0, pB1, t == 0, true, 0);
            AT_BAR();
            if (t + 3 < NT) AT_DMA_K(t + 3, 1);
            if (t + 2 < NT) AT_DMA_V(t + 2, 0);
            AT_SB(); if (t + 2 < NT) { AT_QK(pA0, pA1, 0); } AT_SB();
            AT_SOFTPV(pB0, pB1, pA0, pA1, false, t + 2 < NT, 1);
            AT_BAR();
        }
#undef AT_DMA_K
#undef AT_DMA_V
#undef AT_BAR
#undef AT_SB
#undef AT_QK
#undef AT_LDV
#undef AT_PV
#undef AT_SOFTPV
        const float ltot = lsum + __shfl_xor(lsum, 32);
        const float invl = 1.f / ltot;
        if (map == 1) { const float f = lam * invl;
#pragma unroll
            for (int d = 0; d < 4; ++d)
#pragma unroll
                for (int i = 0; i < 16; ++i) xch[(qw * 64 + d * 16 + i) * 64 + C.lane] = O[d][i] * f; }
        __syncthreads();
        if (map == 0) { float ss = 0.f;
#pragma unroll
            for (int d = 0; d < 4; ++d)
#pragma unroll
                for (int i = 0; i < 16; ++i) { const float o = O[d][i] * invl - xch[(qw * 64 + d * 16 + i) * 64 + C.lane]; O[d][i] = o; ss += o * o; }
            ss += __shfl_xor(ss, 32);
            const float rn = rsqrtf(ss * (1.f / 128.f) + RMS_EPS) * (1.f - lam_init);
            bf16_t* orow = A2 + (size_t)(qrow0 + qw * 32 + r32) * DM + h * 128;
#pragma unroll
            for (int d = 0; d < 4; ++d)
#pragma unroll
                for (int gp = 0; gp < 4; gp += 2) {
                    unsigned pk_[2][2];
#pragma unroll
                    for (int q = 0; q < 2; ++q) { const int g4 = gp + q, dd = 32 * d + 8 * g4 + 4 * hi; const f32x4 sg = *(const f32x4*)(subg + dd);
                        pk_[q][0] = pk2(O[d][4 * g4] * rn * sg[0], O[d][4 * g4 + 1] * rn * sg[1]); pk_[q][1] = pk2(O[d][4 * g4 + 2] * rn * sg[2], O[d][4 * g4 + 3] * rn * sg[3]); }
                    const auto r0 = __builtin_amdgcn_permlane32_swap(pk_[0][0], pk_[1][0], false, false); const auto r1 = __builtin_amdgcn_permlane32_swap(pk_[0][1], pk_[1][1], false, false);
                    u32x4 o; o.x = r0[0]; o.y = r1[0]; o.z = r0[1]; o.w = r1[1];
                    *(u32x4*)(orow + 32 * d + 8 * (gp + hi)) = o; } }
        __syncthreads();
    }
}

__device__ __forceinline__ void phase_rt(const Ctx& C, const Args& A, int l) {
    unsigned char* ws = A.ws; float* X = (float*)(ws + WS_X); bf16_t* H = (bf16_t*)(ws + WS_H); float* AFF = (float*)(ws + WS_AFF); float* STAT = (float*)(ws + WS_P);
    const float* MOD = (const float*)(ws + WS_MOD) + (size_t)l * 5 * 6144;
    const float* lng = A.in[I_LNG] + (size_t)(l * 2 + 0) * DM; const float* lnb = A.in[I_LNB] + (size_t)(l * 2 + 0) * DM;
    LAS float* wrs = (LAS float*)C.lds;
    { const float* wr = A.in[I_WR] + (size_t)l * DM * 16; for (int i = C.tid; i < DM * 16; i += NTHR) wrs[(i & 15) * 1024 + (i >> 4)] = wr[i]; }
    __syncthreads();
    const int row0 = (int)(((long)C.gw * MROWS) / C.NGW), row1 = (int)(((long)(C.gw + 1) * MROWS) / C.NGW);
    f32x4 lngr[4], lnbr[4], scr[4], shr[4]; int cmi = -1;
#pragma unroll
    for (int j = 0; j < 4; ++j) { const int col = 4 * C.lane + 256 * j; lngr[j] = *(const f32x4*)(lng + col); lnbr[j] = *(const f32x4*)(lnb + col); scr[j] = lngr[j]; shr[j] = lngr[j]; }
    f32x4 xn[4];
    if (row0 < row1) {
#pragma unroll
        for (int j = 0; j < 4; ++j) xn[j] = *(const f32x4*)(X + (size_t)row0 * DM + 4 * C.lane + 256 * j); }
    for (int row = row0; row < row1; ++row) {
        const int mi = row_mi(row);
        if (mi != cmi) { cmi = mi; const float* md = MOD + mi * 6144;
#pragma unroll
            for (int j = 0; j < 4; ++j) { const int col = 4 * C.lane + 256 * j; scr[j] = *(const f32x4*)(md + 4 * DM + col) + 1.f; shr[j] = *(const f32x4*)(md + 3 * DM + col); } }
        f32x4 x[4]; float s = 0.f;
#pragma unroll
        for (int j = 0; j < 4; ++j) { x[j] = xn[j]; s += (x[j][0] + x[j][1]) + (x[j][2] + x[j][3]); }
        if (row + 1 < row1) {
#pragma unroll
            for (int j = 0; j < 4; ++j) xn[j] = *(const f32x4*)(X + (size_t)(row + 1) * DM + 4 * C.lane + 256 * j); }
        const float mean = wave_sum(s) * (1.f / DM); float s2 = 0.f;
#pragma unroll
        for (int j = 0; j < 4; ++j) { x[j] = x[j] - mean; s2 += (x[j][0] * x[j][0] + x[j][1] * x[j][1]) + (x[j][2] * x[j][2] + x[j][3] * x[j][3]); }
        const float rstd = rsqrtf(wave_sum(s2) * (1.f / DM) + LN_EPS);
        if (C.lane == 0) *(f32x2*)(STAT + (size_t)row * 2) = (f32x2){mean, rstd};
        float v[16];
#pragma unroll
        for (int e = 0; e < 16; ++e) v[e] = 0.f;
#pragma unroll
        for (int j = 0; j < 4; ++j) { const int col = 4 * C.lane + 256 * j;
            const f32x4 x1 = x[j] * rstd * lngr[j] + lnbr[j];
            const f32x4 h = x1 * scr[j] + shr[j];
            st4bf(H + (size_t)row * DM + col, h);
#pragma unroll
            for (int e = 0; e < 16; ++e) { const f32x4 w = *(const LAS f32x4*)(wrs + e * 1024 + col); v[e] += (h[0] * w[0] + h[1] * w[1]) + (h[2] * w[2] + h[3] * w[3]); }
            __builtin_amdgcn_sched_barrier(0); }
#pragma unroll
        for (int i = 0; i < 8; ++i) { const float send = (C.lane & 32) ? v[i] : v[i + 8], keep = (C.lane & 32) ? v[i + 8] : v[i]; v[i] = keep + __shfl_xor(send, 32); }
#pragma unroll
        for (int i = 0; i < 4; ++i) { const float send = (C.lane & 16) ? v[i] : v[i + 4], keep = (C.lane & 16) ? v[i + 4] : v[i]; v[i] = keep + __shfl_xor(send, 16); }
#pragma unroll
        for (int i = 0; i < 2; ++i) { const float send = (C.lane & 8) ? v[i] : v[i + 2], keep = (C.lane & 8) ? v[i + 2] : v[i]; v[i] = keep + __shfl_xor(send, 8); }
        { const float send = (C.lane & 4) ? v[0] : v[1], keep = (C.lane & 4) ? v[1] : v[0]; v[0] = keep + __shfl_xor(send, 4); }
        float z = v[0]; z += __shfl_xor(z, 1); z += __shfl_xor(z, 2);
        float mx = z;
#pragma unroll
        for (int o = 4; o < 64; o <<= 1) mx = fmaxf(mx, __shfl_xor(mx, o));
        const float ex = expf(z - mx); float sm = ex;
#pragma unroll
        for (int o = 4; o < 64; o <<= 1) sm += __shfl_xor(sm, o);
        if ((C.lane & 3) == 0) AFF[(size_t)row * 16 + (C.lane >> 2)] = ex / sm;
    }
}

__device__ __forceinline__ void phase_tk(const Ctx& C, const Args& A) {
    unsigned char* ws = A.ws; const float* AFF = (const float*)(ws + WS_AFF); int* SLOT = (int*)(ws + WS_SLOT); int* IDX = (int*)(ws + WS_IDX); float* GATE = (float*)(ws + WS_GATE);
    LAS unsigned* key = (LAS unsigned*)C.lds;
    LAS unsigned* hist = key + 8192;
    LAS unsigned* scn = hist + 256;
    LAS unsigned* wtot = scn + 256;
    LAS unsigned* bc = wtot + 8;
    for (int u = blockIdx.x; u < 128; u += C.G) {
        const bool isctx = u >= 64; const int uu = u & 63, b = uu >> 4, e = uu & 15;
        const int n = isctx ? CTXL : TT, cap = isctx ? CAP_C : CAP_L;
        const int row0 = isctx ? NLAT + b * CTXL : b * TT;
        const int slot0 = e * ESLOTS + (isctx ? 4 * CAP_L + b * CAP_C : b * CAP_L);
        for (int i = C.tid; i < n; i += NTHR) key[i] = __float_as_uint(AFF[(size_t)(row0 + i) * 16 + e]);
        unsigned prefix = 0u, pmask = 0u; int need = cap;
        for (int pass = 0; pass < 4; ++pass) {
            const int shift = 24 - 8 * pass;
            if (C.tid < 256) hist[C.tid] = 0u;
            __syncthreads();
            for (int i = C.tid; i < n; i += NTHR) { const unsigned k = key[i]; if ((k & pmask) == prefix) __hip_atomic_fetch_add(&hist[(k >> shift) & 255u], 1u, __ATOMIC_RELAXED, __HIP_MEMORY_SCOPE_WORKGROUP); }
            __syncthreads();
            {
                const unsigned hd = (C.tid < 256) ? hist[255 - C.tid] : 0u; unsigned inc = hd;
#pragma unroll
                for (int o = 1; o < 64; o <<= 1) { const unsigned t = __shfl_up(inc, o); if (C.lane >= o) inc += t; }
                if (C.tid < 256 && C.lane == 63) wtot[C.wave] = inc;
                __syncthreads();
                if (C.tid < 256) { unsigned base = 0u; for (int w = 0; w < C.wave; ++w) base += wtot[w];
                    const unsigned incl = base + inc, above = incl - hd;
                    if (incl >= (unsigned)need && above < (unsigned)need) { bc[0] = (unsigned)(255 - C.tid); bc[1] = (unsigned)need - above; } }
            }
            __syncthreads();
            prefix |= bc[0] << shift; pmask |= 255u << shift; need = (int)bc[1];
            __syncthreads();
        }
        const int per = (n + NTHR - 1) / NTHR; const int i0 = C.tid * per;
        unsigned cg = 0u, ce = 0u;
        for (int j = 0; j < per; ++j) { const int i = i0 + j; if (i < n) { const unsigned k = key[i]; cg += (k > prefix); ce += (k == prefix); } }
        unsigned pk = cg | (ce << 16), inc = pk;
#pragma unroll
        for (int o = 1; o < 64; o <<= 1) { const unsigned t = __shfl_up(inc, o); if (C.lane >= o) inc += t; }
        if (C.lane == 63) wtot[C.wave] = inc;
        __syncthreads();
        unsigned wbase = 0u;
        for (int w = 0; w < C.wave; ++w) wbase += wtot[w];
        const unsigned excl = wbase + inc - pk;
        unsigned rg = excl & 0xffffu, re = excl >> 16;
        const int ngt = cap - need;
        for (int j = 0; j < per; ++j) { const int i = i0 + j; if (i < n) { const unsigned k = key[i]; int pos = -1;
            if (k > prefix) { pos = (int)rg; ++rg; } else if (k == prefix) { if ((int)re < need) pos = ngt + (int)re; ++re; }
            const int row = row0 + i;
            if (pos >= 0) { IDX[slot0 + pos] = row; GATE[slot0 + pos] = __uint_as_float(k); SLOT[(size_t)row * 16 + e] = slot0 + pos; }
            else SLOT[(size_t)row * 16 + e] = -1; } }
        if (isctx && b == 0 && C.tid < ESLOTS - 4224) { IDX[e * ESLOTS + 4224 + C.tid] = 0; GATE[e * ESLOTS + 4224 + C.tid] = 0.f; }
        __syncthreads();
    }
}

__device__ __forceinline__ void phase_cb(const Ctx& C, const Args& A, int l) {
    unsigned char* ws = A.ws; float* X = (float*)(ws + WS_X); bf16_t* H = (bf16_t*)(ws + WS_H); const int* SLOT = (const int*)(ws + WS_SLOT); const bf16_t* YE = (const bf16_t*)(ws + WS_YE);
    const float* MOD = (const float*)(ws + WS_MOD) + (size_t)l * 5 * 6144; const float* MODN = MOD + 5 * 6144;
    const float* lng = A.in[I_LNG] + (size_t)(l * 2 + 1) * DM; const float* lnb = A.in[I_LNB] + (size_t)(l * 2 + 1) * DM;
    const float* lng1 = A.in[I_LNG] + (size_t)(l * 2 + 0) * DM; const float* lnb1 = A.in[I_LNB] + (size_t)(l * 2 + 0) * DM; const float* STAT = (const float*)(ws + WS_P);
    const int row0 = (int)(((long)C.gw * MROWS) / C.NGW), row1 = (int)(((long)(C.gw + 1) * MROWS) / C.NGW);
    f32x4 lngr[4], lnbr[4], gfr[4], nsc[4], nsh[4], l1g[4], l1b[4]; int cmi = -1;
#pragma unroll
    for (int j = 0; j < 4; ++j) { const int col = 4 * C.lane + 256 * j; lngr[j] = *(const f32x4*)(lng + col); lnbr[j] = *(const f32x4*)(lnb + col); gfr[j] = lngr[j]; nsc[j] = lngr[j]; nsh[j] = lngr[j];
        l1g[j] = *(const f32x4*)(lng1 + col); l1b[j] = *(const f32x4*)(lnb1 + col); }
    int svn = -1; f32x4 xn[4]; f32x2 stn = {0.f, 0.f};
    if (row0 < row1) { svn = SLOT[(size_t)row0 * 16 + (C.lane & 15)]; stn = *(const f32x2*)(STAT + (size_t)row0 * 2);
#pragma unroll
        for (int j = 0; j < 4; ++j) xn[j] = *(const f32x4*)(X + (size_t)row0 * DM + 4 * C.lane + 256 * j); }
    for (int row = row0; row < row1; ++row) {
        const int mi = row_mi(row);
        if (mi != cmi) { cmi = mi; const float* md = MOD + mi * 6144; const float* mn = MODN + mi * 6144;
#pragma unroll
            for (int j = 0; j < 4; ++j) { const int col = 4 * C.lane + 256 * j; gfr[j] = *(const f32x4*)(md + 5 * DM + col);
                if (l < DEPTH - 1) { nsc[j] = *(const f32x4*)(mn + DM + col) + 1.f; nsh[j] = *(const f32x4*)(mn + col); } } }
        const int sv = svn;
        unsigned mask = (unsigned)__ballot(sv >= 0) & 0xffffu;
        f32x4 acc[4];
#pragma unroll
        for (int j = 0; j < 4; ++j) acc[j] = (f32x4){0.f, 0.f, 0.f, 0.f};
        u32x2 y0[4], y1[4]; bool h0 = false, h1 = false;
        if (mask) { const int e = __builtin_ctz(mask); mask &= mask - 1; h0 = true; const int sl = __builtin_amdgcn_readlane(sv, e);
#pragma unroll
            for (int j = 0; j < 4; ++j) y0[j] = *(const u32x2*)(YE + (size_t)sl * DM + 4 * C.lane + 256 * j); }
        if (mask) { const int e = __builtin_ctz(mask); mask &= mask - 1; h1 = true; const int sl = __builtin_amdgcn_readlane(sv, e);
#pragma unroll
            for (int j = 0; j < 4; ++j) y1[j] = *(const u32x2*)(YE + (size_t)sl * DM + 4 * C.lane + 256 * j); }
        f32x4 x[4]; const f32x2 st = stn;
#pragma unroll
        for (int j = 0; j < 4; ++j) x[j] = xn[j];
        if (row + 1 < row1) { svn = SLOT[(size_t)(row + 1) * 16 + (C.lane & 15)]; stn = *(const f32x2*)(STAT + (size_t)(row + 1) * 2);
#pragma unroll
            for (int j = 0; j < 4; ++j) xn[j] = *(const f32x4*)(X + (size_t)(row + 1) * DM + 4 * C.lane + 256 * j); }
        if (h0) {
#pragma unroll
            for (int j = 0; j < 4; ++j) acc[j] += (f32x4){__uint_as_float(y0[j].x << 16), __uint_as_float(y0[j].x & 0xffff0000u), __uint_as_float(y0[j].y << 16), __uint_as_float(y0[j].y & 0xffff0000u)}; }
        if (h1) {
#pragma unroll
            for (int j = 0; j < 4; ++j) acc[j] += (f32x4){__uint_as_float(y1[j].x << 16), __uint_as_float(y1[j].x & 0xffff0000u), __uint_as_float(y1[j].y << 16), __uint_as_float(y1[j].y & 0xffff0000u)}; }
        while (mask) { const int e = __builtin_ctz(mask); mask &= mask - 1; const int sl = __builtin_amdgcn_readlane(sv, e);
#pragma unroll
            for (int j = 0; j < 4; ++j) acc[j] += ld4bf(YE + (size_t)sl * DM + 4 * C.lane + 256 * j); }
        float sm = 0.f;
#pragma unroll
        for (int j = 0; j < 4; ++j) { x[j] = ((x[j] - st[0]) * st[1] * l1g[j] + l1b[j]) * ALPHA_DN + gfr[j] * acc[j];
            sm += (x[j][0] + x[j][1]) + (x[j][2] + x[j][3]); }
        const float mean = wave_sum(sm) * (1.f / DM); float s2 = 0.f;
#pragma unroll
        for (int j = 0; j < 4; ++j) { x[j] = x[j] - mean; s2 += (x[j][0] * x[j][0] + x[j][1] * x[j][1]) + (x[j][2] * x[j][2] + x[j][3] * x[j][3]); }
        const float rstd = rsqrtf(wave_sum(s2) * (1.f / DM) + LN_EPS);
#pragma unroll
        for (int j = 0; j < 4; ++j) { const int col = 4 * C.lane + 256 * j;
            const f32x4 x2 = x[j] * rstd * lngr[j] + lnbr[j];
            if (l < DEPTH - 1) { *(f32x4*)(X + (size_t)row * DM + col) = x2; st4bf(H + (size_t)row * DM + col, x2 * nsc[j] + nsh[j]); }
            else if (row < NLAT) *(f32x4*)(A.out + (size_t)row * DM + col) = x2; }
    }
}


#ifndef GEMM_NOINLINE
#define GEMM_NOINLINE 0
#endif
#if GEMM_NOINLINE
#define GEMM_FN __device__ __noinline__
#else
#define GEMM_FN __device__ __forceinline__
#endif
GEMM_FN void gphase_in(LAS unsigned char* lds, unsigned char* ws, int nN, int G) {
    int bx = blockIdx.x; asm volatile("" : "+s"(bx), "+s"(G));
    pg8::Gemm g{(const bf16_t*)(ws + WS_H), (const bf16_t*)(ws + WS_WIN), DM}; pg8::Order<0> S; S.init(MROWS / 256, nN, G, bx, nullptr, 0);
    pg8::EpiBf16 E{(bf16_t*)(ws + WS_P), P_LD}; pg8::gemm_phase(lds, g, S, E); }
GEMM_FN void gphase_in_odd(LAS unsigned char* lds, unsigned char* ws, int G) {
    int bx = blockIdx.x; asm volatile("" : "+s"(bx), "+s"(G));
    pg8::Gemm g{(const bf16_t*)(ws + WS_H), (const bf16_t*)(ws + WS_WIN), DM}; pg8::Order<0> S; S.init(MROWS / 256, D_IN_ODD / 256, G, bx, nullptr, 0);
    pg8::EpiOdd E{(bf16_t*)(ws + WS_P), (bf16_t*)(ws + WS_Q), (bf16_t*)(ws + WS_KA), (const float*)(ws + WS_ROPE)}; pg8::gemm_phase(lds, g, S, E); }
GEMM_FN void gphase_lora(LAS unsigned char* lds, unsigned char* ws, const float* d0, const float* a0, const float* kal, int G) {
    int bx = blockIdx.x; asm volatile("" : "+s"(bx), "+s"(G));
    pg8::Gemm g{(const bf16_t*)(ws + WS_LIN), (const bf16_t*)(ws + WS_WLORA), LORA_K}; pg8::Order<0> S; S.init(MROWS / 256, LORA_N / 256, G, bx, nullptr, 0);
    pg8::EpiLora E{ws + WS_SCN, (bf16_t*)(ws + WS_G), d0, a0, kal}; pg8::gemm_phase(lds, g, S, E); }
GEMM_FN void gphase_out(LAS unsigned char* lds, unsigned char* ws, const float* modl, int G, const float* xin, const float* cin) {
    int bx = blockIdx.x; asm volatile("" : "+s"(bx), "+s"(G));
    pg8::Gemm g{(const bf16_t*)(ws + WS_A2), (const bf16_t*)(ws + WS_WOUT), DM}; pg8::Order<0> S; S.init(MROWS / 256, DM / 256, G, bx, nullptr, 0);
    pg8::EpiRes E{(float*)(ws + WS_X), modl, xin, cin}; pg8::gemm_phase(lds, g, S, E); }
GEMM_FN void gphase_e1(LAS unsigned char* lds, unsigned char* ws, int G, int l) {
    int bx = blockIdx.x; asm volatile("" : "+s"(bx), "+s"(G));
    pg8::Gemm g{(const bf16_t*)(ws + WS_H), (const bf16_t*)(ws + WS_WE13 + (size_t)(l & 1) * WE13_BYTES), DM}; pg8::EpiSwiGLU E{(bf16_t*)(ws + WS_HID)};
    pg8::OrderExp<1> S; S.init(4096 / 256, G, bx, (const int*)(ws + WS_IDX), (long)4096 * DM); pg8::gemm_phase(lds, g, S, E); }
GEMM_FN void gphase_e2(LAS unsigned char* lds, unsigned char* ws, int G, int l) {
    int bx = blockIdx.x; asm volatile("" : "+s"(bx), "+s"(G));
    pg8::Gemm g{(const bf16_t*)(ws + WS_HID), (const bf16_t*)(ws + WS_WE2 + (size_t)(l & 1) * WE2_BYTES), D_EXP}; pg8::EpiYE E{(bf16_t*)(ws + WS_YE), (const float*)(ws + WS_GATE)};
    pg8::OrderExp<2> S; S.init(DM / 256, G, bx, nullptr, (long)DM * D_EXP); pg8::gemm_phase(lds, g, S, E); }

constexpr int NSLOT = 13;
constexpr int NSTEP = 1 + DEPTH * NSLOT;
__global__ void __launch_bounds__(NTHR, 2) mk_fwd(Args KA) {
    extern __shared__ __attribute__((aligned(16))) unsigned char lds_raw[];
    volatile LAS unsigned* MISC = (volatile LAS unsigned*)((LAS unsigned char*)lds_raw + LDS_MISC);
    if (threadIdx.x < 16) MISC[threadIdx.x] = 0u;
    if (threadIdx.x == 0) { LAS unsigned long long* tb = (LAS unsigned long long*)((LAS unsigned char*)lds_raw + LDS_PTAB);
#pragma unroll
        for (int i = 0; i < 37; ++i) tb[i] = (unsigned long long)KA.in[i];
        tb[37] = (unsigned long long)KA.out; tb[38] = (unsigned long long)KA.ws; }
    __syncthreads();
    const int lo = KA.lo, hi = KA.hi;
    unsigned bar_x = 0;
    if (hi - lo > 1) { const XcdBarrier b0 = xcd_barrier_post((unsigned*)(KA.ws + WS_CTL), MISC); bar_x = b0.x; }
#ifndef PH_MASK
#define PH_MASK 0xFFFFFF
#endif
#ifndef REP_MASK
#define REP_MASK 0
#endif
#define PH_BIT(k) (((k) == 0) ? 0 : 1 + ((k) - 1) % NSLOT + (((k) - 1) % NSLOT >= 2 && ((k) - 1) % NSLOT <= 3 && odd ? 12 : 0))
#define RUN(k, ...) do { if (((PH_MASK >> PH_BIT(k)) & 1) && lo <= (k) && (k) < hi) { const int nrep = ((REP_MASK >> PH_BIT(k)) & 1) ? 2 : 1; \
        _Pragma("unroll 1") for (int rep = 0; rep < nrep; ++rep) { \
        Ctx C; mkctx(C, (LAS unsigned char*)lds_raw); Args A; ldargs(A, (LAS unsigned char*)lds_raw); unsigned char* ws = A.ws; \
        const float* MODL = (const float*)(ws + WS_MOD) + (size_t)l * 5 * 6144; (void)MODL; \
        __VA_ARGS__; if ((k) + 1 < hi || rep + 1 < nrep) { XcdBarrier bar; bar.bar = (unsigned*)(ws + WS_CTL); bar.x = bar_x; bar.st = MISC; xcd_barrier(bar); } } } } while (0)
    { const bool odd = false; const int l = 0; RUN(0, { phase_init(C, A); __syncthreads(); conv_items(C, A, 0, C.gw, C.NGW, true, true, true); }); }
#pragma unroll 1
    for (int l = 0; l < DEPTH; ++l) {
        const int sb = 1 + l * NSLOT; const bool odd = l & 1;
        if (!(CHUNKED_SCAN && odd)) { RUN(sb + 0, { phase_conv(C, A, l); if (l == 0) phase_modh(C, A, 0); }); }
        if (odd) { RUN(sb + 1, { gphase_in_odd(C.lds, ws, C.G);
                   const int tail = ((MROWS / 256) * (D_IN_ODD / 256)) % C.G;
                   if (CHUNKED_SCAN && l + 1 < DEPTH && tail > 0 && (int)blockIdx.x >= tail) conv_items(C, A, l + 1, ((int)blockIdx.x - tail) * NWAVES + C.wave, (C.G - tail) * NWAVES, false, false, true, 0, YW_IN_HI); }); }
        else { RUN(sb + 1, { gphase_in(C.lds, ws, D_IN_EVEN_PAD / 256, C.G);
                   const int tail = ((MROWS / 256) * (D_IN_EVEN_PAD / 256)) % C.G;
                   if (CHUNKED_SCAN && l + 1 < DEPTH && tail > 0 && (int)blockIdx.x >= tail) conv_items(C, A, l + 1, ((int)blockIdx.x - tail) * NWAVES + C.wave, (C.G - tail) * NWAVES, false, false, true, 0, XW_IN_HI); }); }
        if (!odd) {
            RUN(sb + 2, phase_ef1(C, A, l));
            RUN(sb + 3, { const int i2 = l >> 1; gphase_lora(C.lds, ws, A.in[I_D0] + (size_t)i2 * 2 * 768, A.in[I_A0] + (size_t)i2 * 2 * 768, A.in[I_KAL] + (size_t)i2 * 768, C.G); });
#if CHUNKED_SCAN
            RUN(sb + 4, phase_csa(C, A));
            RUN(sb + 5, phase_csb(C, A, l));
#else
            RUN(sb + 4, phase_scan(C, A));
#endif
            RUN(sb + 6, phase_ef2(C, A, l));
        } else {
            RUN(sb + 2, { phase_of1(C, A, l);
                   const int busy2 = 256 + 8 * 7 - C.G;
                   if (CHUNKED_SCAN && l + 1 < DEPTH && busy2 > 0 && (int)blockIdx.x >= busy2) conv_items(C, A, l + 1, ((int)blockIdx.x - busy2) * NWAVES + C.wave, (C.G - busy2) * NWAVES, false, false, true, YW_IN_HI, YW_OF_HI); });
            RUN(sb + 3, phase_attn(C, A, l));
        }
        RUN(sb + 7, { gphase_out(C.lds, ws, MODL, C.G, l == 0 ? A.in[I_X] : (const float*)(ws + WS_X), l == 0 ? A.in[I_CTX] : (const float*)(ws + WS_X) + (size_t)NLAT * DM);
                   const int tail = ((MROWS / 256) * (DM / 256)) % C.G;
                   if (CHUNKED_SCAN && l + 1 < DEPTH && tail > 0 && (int)blockIdx.x >= tail) conv_items(C, A, l + 1, ((int)blockIdx.x - tail) * NWAVES + C.wave, (C.G - tail) * NWAVES, false, false, true, odd ? YW_OF_HI : XW_IN_HI, odd ? YW_OUT_HI : XW_OUT_HI); });
        RUN(sb + 8, phase_rt(C, A, l));
        RUN(sb + 9, { phase_tk(C, A);
                   if (CHUNKED_SCAN && l + 1 < DEPTH && (int)blockIdx.x >= 128) conv_items(C, A, l + 1, ((int)blockIdx.x - 128) * NWAVES + C.wave, (C.G - 128) * NWAVES, false, false, true, odd ? YW_OUT_HI : XW_OUT_HI, odd ? YW_TK_HI : XW_TK_HI); });
        RUN(sb + 10, gphase_e1(C.lds, ws, C.G, l));
        RUN(sb + 11, gphase_e2(C.lds, ws, C.G, l));
        RUN(sb + 12, { phase_cb(C, A, l); if (CHUNKED_SCAN && !odd && l + 1 < DEPTH) { __syncthreads(); conv_items(C, A, l + 1, C.gw, C.NGW, false, true, false); } });
    }
#undef RUN
}

#ifdef PHASE_PROBE
#define PROBE_PRE extern __shared__ __attribute__((aligned(16))) unsigned char lds_raw[]; Ctx C; mkctx(C, (LAS unsigned char*)lds_raw); unsigned char* ws = A.ws; (void)ws;
__global__ void __launch_bounds__(NTHR, 2) pr_init(Args A) { PROBE_PRE phase_init(C, A); }
__global__ void __launch_bounds__(NTHR, 2) pr_conv(Args A) { PROBE_PRE phase_conv(C, A, A.lo); }
__global__ void __launch_bounds__(NTHR, 2) pr_modh(Args A) { PROBE_PRE phase_modh(C, A, A.lo); }
__global__ void __launch_bounds__(NTHR, 2) pr_ef1(Args A) { PROBE_PRE phase_ef1(C, A, A.lo); }
__global__ void __launch_bounds__(NTHR, 2) pr_scan(Args A) { PROBE_PRE phase_scan(C, A); }
__global__ void __launch_bounds__(NTHR, 2) pr_ef2(Args A) { PROBE_PRE phase_ef2(C, A, A.lo); }
__global__ void __launch_bounds__(NTHR, 2) pr_csa(Args A) { PROBE_PRE phase_csa(C, A); }
__global__ void __launch_bounds__(NTHR, 2) pr_csb(Args A) { PROBE_PRE phase_csb(C, A, A.lo); }
__global__ void __launch_bounds__(NTHR, 2) pr_of1(Args A) { PROBE_PRE phase_of1(C, A, A.lo); }
__global__ void __launch_bounds__(NTHR, 2) pr_attn(Args A) { PROBE_PRE phase_attn(C, A, A.lo); }
__global__ void __launch_bounds__(NTHR, 2) pr_rt(Args A) { PROBE_PRE phase_rt(C, A, A.lo); }
__global__ void __launch_bounds__(NTHR, 2) pr_tk(Args A) { PROBE_PRE phase_tk(C, A); }
__global__ void __launch_bounds__(NTHR, 2) pr_cb(Args A) { PROBE_PRE phase_cb(C, A, A.lo); }
__global__ void __launch_bounds__(NTHR, 2) pr_gemm_in(Args A) { PROBE_PRE pg8::Gemm g{(const bf16_t*)(ws + WS_H), (const bf16_t*)(ws + WS_WIN), DM}; pg8::Order<0> S; S.init(MROWS / 256, A.lo, C.G, (int)blockIdx.x, nullptr, 0);
                      pg8::EpiBf16 E{(bf16_t*)(ws + WS_P), P_LD}; pg8::gemm_phase(C.lds, g, S, E); }
__global__ void __launch_bounds__(NTHR, 2) pr_gemm_lora(Args A) { PROBE_PRE pg8::Gemm g{(const bf16_t*)(ws + WS_LIN), (const bf16_t*)(ws + WS_WLORA), LORA_K}; pg8::Order<0> S; S.init(MROWS / 256, LORA_N / 256, C.G, (int)blockIdx.x, nullptr, 0);
                          const int i2 = A.lo; pg8::EpiLora E{ws + WS_SCN, (bf16_t*)(ws + WS_G), A.in[I_D0] + (size_t)i2 * 2 * 768, A.in[I_A0] + (size_t)i2 * 2 * 768, A.in[I_KAL] + (size_t)i2 * 768};
                          pg8::gemm_phase(C.lds, g, S, E); }
__global__ void __launch_bounds__(NTHR, 2) pr_gemm_out(Args A) { PROBE_PRE pg8::Gemm g{(const bf16_t*)(ws + WS_A2), (const bf16_t*)(ws + WS_WOUT), DM}; pg8::Order<0> S; S.init(MROWS / 256, DM / 256, C.G, (int)blockIdx.x, nullptr, 0);
                      pg8::EpiRes E{(float*)(ws + WS_X), (const float*)(ws + WS_MOD), (const float*)(ws + WS_X), (const float*)(ws + WS_X) + (size_t)NLAT * DM}; pg8::gemm_phase(C.lds, g, S, E); }
__global__ void __launch_bounds__(NTHR, 2) pr_gemm_e1(Args A) { PROBE_PRE pg8::Gemm g{(const bf16_t*)(ws + WS_H), (const bf16_t*)(ws + WS_WE13), DM}; pg8::Order<1> S; S.init(NEXP * 17, 4096 / 256, C.G, (int)blockIdx.x, (const int*)(ws + WS_IDX), (long)4096 * DM);
                      pg8::EpiSwiGLU E{(bf16_t*)(ws + WS_HID)}; pg8::gemm_phase(C.lds, g, S, E); }
__global__ void __launch_bounds__(NTHR, 2) pr_gemm_e2(Args A) { PROBE_PRE pg8::Gemm g{(const bf16_t*)(ws + WS_HID), (const bf16_t*)(ws + WS_WE2), D_EXP}; pg8::Order<2> S; S.init(NEXP * 17, DM / 256, C.G, (int)blockIdx.x, nullptr, (long)DM * D_EXP);
                       pg8::EpiYE E{(bf16_t*)(ws + WS_YE), (const float*)(ws + WS_GATE)}; pg8::gemm_phase(C.lds, g, S, E); }
#endif

extern "C" void kernel_launch(void* const* d_in, const int* in_sizes, int n_in, void* d_out, int out_size, void* d_ws, size_t ws_size, hipStream_t stream) {
    static int grid = 0;
    if (grid == 0) {
        if (n_in != 37 || out_size != NLAT * DM || ws_size < WS_END) { fprintf(stderr, "kernel_launch: unexpected shapes: n_in %d out %d ws %zu (need %zu)\n", n_in, out_size, ws_size, (size_t)WS_END); grid = -1; return; }
        int dev = 0, cus = 0, per_cu = 0;
        if (hipGetDevice(&dev) != hipSuccess || hipDeviceGetAttribute(&cus, hipDeviceAttributeMultiprocessorCount, dev) != hipSuccess) { grid = -1; return; }
        if (hipFuncSetAttribute((const void*)mk_fwd, hipFuncAttributeMaxDynamicSharedMemorySize, LDS_BYTES) != hipSuccess) { fprintf(stderr, "kernel_launch: hipFuncSetAttribute failed\n"); grid = -1; return; }
        if (hipOccupancyMaxActiveBlocksPerMultiprocessor(&per_cu, (const void*)mk_fwd, NTHR, LDS_BYTES) != hipSuccess || per_cu < 1) fprintf(stderr, "kernel_launch: occupancy query reports %d\n", per_cu);
        (void)hipGetLastError();
        grid = cus;
    }
    if (grid < 0) return;
    (void)hipMemsetAsync((char*)d_ws + WS_CTL, 0, CTL_BYTES, stream);
    Args a{};
    for (int i = 0; i < 37; ++i) a.in[i] = (const float*)d_in[i];
    a.out = (float*)d_out; a.ws = (unsigned char*)d_ws;
#if MK_MULTI
    for (int k = 0; k < NSTEP; ++k) {
        if (k >= 1) { const int l = (k - 1) / NSLOT, s = (k - 1) % NSLOT; if ((l & 1) && ((s >= 4 && s <= 6) || (CHUNKED_SCAN && s == 0))) continue; if (!(l & 1) && !CHUNKED_SCAN && s == 5) continue; }
        a.lo = k; a.hi = k + 1;
        hipLaunchKernelGGL(mk_fwd, dim3(grid), dim3(NTHR), LDS_BYTES, stream, a);
    }
#else
    a.lo = 0; a.hi = NSTEP;
    hipLaunchKernelGGL(mk_fwd, dim3(grid), dim3(NTHR), LDS_BYTES, stream, a);
#endif
    const hipError_t le = hipPeekAtLastError();
    if (le != hipSuccess) fprintf(stderr, "kernel_launch: launch failed: %s\n", hipGetErrorName(le));
}
```

```cpp
#include <hip/hip_runtime.h>
#include <cstdio>
#include <cstdint>
#include <cmath>

#ifndef MK_MULTI
#define MK_MULTI 0
#endif
#ifndef CHUNKED_SCAN
#define CHUNKED_SCAN 1
#endif

#define GAS __attribute__((address_space(1)))
#define LAS __attribute__((address_space(3)))
typedef unsigned short bf16_t;
typedef short bf16x8 __attribute__((ext_vector_type(8)));
typedef float f32x4 __attribute__((ext_vector_type(4)));
typedef float f32x2 __attribute__((ext_vector_type(2)));
typedef float f32x16 __attribute__((ext_vector_type(16)));
typedef unsigned u32x4 __attribute__((ext_vector_type(4)));
typedef unsigned u32x2 __attribute__((ext_vector_type(2)));
typedef __bf16 bf16x2_t __attribute__((ext_vector_type(2)));

constexpr int NB = 4, TT = 8192, DM = 1024, NLAT = NB * TT, CTXL = 256, NCTX = NB * CTXL, MROWS = NLAT + NCTX;
constexpr int DEPTH = 4;
constexpr int D_CONV = 256, RW_H = 12, RW_K = 64, D_RWKV = 768, RWKV_COLS = 2688, D_IN_EVEN = 3456, D_IN_EVEN_PAD = 3584;
constexpr int D_DIFF = 768, D_GMLP = 256, D_IN_ODD = 2816;
constexpr int NEXP = 16, D_EXP = 2048, CAP_L = 1024, CAP_C = 32, ESLOTS = 4352;
constexpr int P_LD = 3584;
constexpr int LORA_K = 384, LORA_N = 3840;
constexpr int LKEYS = CTXL + TT;
constexpr float ALPHA_DN = 1.6817928305074290f;
constexpr float DECAY_SCALE = 0.6065306597126334f;
constexpr float GN_EPS = 64e-5f, LN_EPS = 1e-5f, RMS_EPS = 1e-5f;
constexpr float QSCALE = 0.125f * 1.4426950408889634f;

constexpr size_t al256(size_t x) { return (x + 255) & ~(size_t)255; }
constexpr size_t WS_CTL = 0;
constexpr size_t CTL_BYTES = 65536;
constexpr size_t WS_MOD = WS_CTL + CTL_BYTES;
constexpr size_t WS_ROPE = WS_MOD + al256((size_t)DEPTH * 5 * 6144 * 4);
constexpr size_t WS_WIN = WS_ROPE + 32768;
constexpr size_t WS_WOUT = WS_WIN + (size_t)D_IN_EVEN_PAD * DM * 2;
constexpr size_t WS_WLORA = WS_WOUT + (size_t)DM * DM * 2;
constexpr size_t WS_WE13 = WS_WLORA + (size_t)LORA_N * LORA_K * 2;
constexpr size_t WE13_BYTES = (size_t)NEXP * 4096 * DM * 2, WE2_BYTES = (size_t)NEXP * DM * D_EXP * 2;
constexpr size_t WS_WE2 = WS_WE13 + 2 * WE13_BYTES;
constexpr size_t WS_X = WS_WE2 + 2 * WE2_BYTES;
constexpr size_t WS_H = WS_X + (size_t)MROWS * DM * 4;
constexpr size_t WS_A2 = WS_H + (size_t)MROWS * DM * 2;
constexpr size_t WS_P = WS_A2 + (size_t)MROWS * DM * 2;
constexpr size_t WS_AFF = WS_P + (size_t)MROWS * P_LD * 2;
constexpr size_t WS_SLOT = WS_AFF + (size_t)MROWS * 16 * 4;
constexpr size_t WS_IDX = WS_SLOT + (size_t)MROWS * 16 * 4;
constexpr size_t WS_GATE = WS_IDX + al256((size_t)NEXP * ESLOTS * 4);
constexpr size_t WS_R2 = WS_GATE + al256((size_t)NEXP * ESLOTS * 4);
constexpr int SC_REC = 1408, SC_ROW = 12 * SC_REC, SC_W = 0, SC_R = 512, SC_KK = 640, SC_V = 768, SC_B = 896, SC_KR = 1024;
constexpr size_t WS_SCN = WS_R2;
constexpr size_t WS_G = WS_SCN + (size_t)MROWS * SC_ROW;
constexpr size_t WS_LIN = WS_G + (size_t)MROWS * 768 * 2;
constexpr int CS_L = 64, CS_NCH = LKEYS / CS_L, CS_UNITS = NB * RW_H * 2;
constexpr size_t WS_CHK = WS_LIN + (size_t)MROWS * 384 * 2;
constexpr size_t WS_EVEN_END = WS_CHK + (size_t)CS_UNITS * CS_NCH * 32768;
constexpr size_t WS_Y = WS_P;
constexpr size_t WS_Q = WS_R2;
constexpr size_t WS_KA = WS_Q + (size_t)MROWS * 768 * 2;
constexpr size_t WS_VT = WS_KA + (size_t)NB * LKEYS * 768 * 2;
constexpr size_t WS_HID = WS_R2;
constexpr size_t WS_YE = WS_HID + (size_t)NEXP * ESLOTS * D_EXP * 2;
constexpr size_t WS_END = WS_EVEN_END;
static_assert(WS_END <= (size_t)2147483648ull, "workspace over 2 GiB");
static_assert((size_t)2 * MROWS * 768 * 4 <= (size_t)MROWS * P_LD * 2, "Y aliases P");
static_assert(WS_YE + (size_t)NEXP * ESLOTS * DM * 2 <= WS_END, "moe region");

constexpr int LDS_BYTES = 147456;
constexpr int LDS_MISC = 140 * 1024;
constexpr int LDS_PTAB = LDS_MISC + 256;
constexpr int NWAVES = 8, NTHR = 512;

__device__ __forceinline__ unsigned f2bf(float f) { unsigned u = __float_as_uint(f); return (u + 0x7fffu + ((u >> 16) & 1u)) >> 16; }
__device__ __forceinline__ unsigned pk2(float lo, float hi) { f32x2 v = {lo, hi}; bf16x2_t b = __builtin_convertvector(v, bf16x2_t); return __builtin_bit_cast(unsigned, b); }
__device__ __forceinline__ float bflo(unsigned u) { return __uint_as_float(u << 16); }
__device__ __forceinline__ float bfhi(unsigned u) { return __uint_as_float(u & 0xffff0000u); }
__device__ __forceinline__ float bf2f(bf16_t b) { return __uint_as_float((unsigned)b << 16); }
__device__ __forceinline__ float sigmoidf_(float x) { return __builtin_amdgcn_rcpf(1.f + __expf(-x)); }
#define DPP_MOV_F(v, ctrl) __uint_as_float((unsigned)__builtin_amdgcn_update_dpp(0, (int)__float_as_uint(v), (ctrl), 0xF, 0xF, true))
__device__ __forceinline__ float lx1(float v) { return DPP_MOV_F(v, 0xB1); }
__device__ __forceinline__ float lx2(float v) { return DPP_MOV_F(v, 0x4E); }
__device__ __forceinline__ float lx4(float v) { const float t = DPP_MOV_F(v, 0x141); return DPP_MOV_F(t, 0x1B); }
__device__ __forceinline__ float lx8(float v) { return DPP_MOV_F(v, 0x128); }
__device__ __forceinline__ float lx16(float v, int lane) { const auto r = __builtin_amdgcn_permlane16_swap(__float_as_uint(v), __float_as_uint(v), false, false); return __uint_as_float((lane & 16) ? r[0] : r[1]); }
__device__ __forceinline__ float lx32(float v, int lane) { const auto r = __builtin_amdgcn_permlane32_swap(__float_as_uint(v), __float_as_uint(v), false, false); return __uint_as_float((lane & 32) ? r[0] : r[1]); }
__device__ __forceinline__ float sum16(float v) {
    v += DPP_MOV_F(v, 0xB1); v += DPP_MOV_F(v, 0x4E); v += DPP_MOV_F(v, 0x141); v += DPP_MOV_F(v, 0x140);
    return v;
}
__device__ __forceinline__ float wave_sum(float v) {
    v = sum16(v);
    { const auto r = __builtin_amdgcn_permlane16_swap(__float_as_uint(v), __float_as_uint(v), false, false); v = __uint_as_float(r[0]) + __uint_as_float(r[1]); }
    { const auto r = __builtin_amdgcn_permlane32_swap(__float_as_uint(v), __float_as_uint(v), false, false); v = __uint_as_float(r[0]) + __uint_as_float(r[1]); }
    return v;
}
__device__ __forceinline__ f32x4 ld4bf_(const void* p) { const u32x2 u = *(const u32x2*)p; return (f32x4){bflo(u.x), bfhi(u.x), bflo(u.y), bfhi(u.y)}; }
__device__ __forceinline__ void st4bf_(void* p, f32x4 v) { u32x2 o; o.x = pk2(v[0], v[1]); o.y = pk2(v[2], v[3]); *(u32x2*)p = o; }
__device__ __forceinline__ float max3f(float a, float b, float c) { float r; asm("v_max3_f32 %0, %1, %2, %3" : "=v"(r) : "v"(a), "v"(b), "v"(c)); return r; }
__device__ __forceinline__ int crow(int r, int hi) { return (r & 3) + 8 * (r >> 2) + 4 * hi; }
__device__ __forceinline__ f32x2 gelu_pk(f32x2 v) {
    const f32x2 av = __builtin_elementwise_abs(v), d = av * 0.2316418882f + 1.0f;
    f32x2 t; t.x = __builtin_amdgcn_rcpf(d.x); t.y = __builtin_amdgcn_rcpf(d.y);
    f32x2 q = t * 0.5307027145f + (-0.7265760135f); q = q * t + 0.7107068705f; q = q * t + (-0.142248368f); q = q * t + 0.127414796f; q = q * t;
    const f32x2 s = (v * v) * (-0.72134752044f);
    f32x2 e; e.x = __builtin_amdgcn_exp2f(s.x); e.y = __builtin_amdgcn_exp2f(s.y);
    const f32x2 m = v * (q * e), r = v - m;
    f32x2 o; o.x = v.x < 0.f ? m.x : r.x; o.y = v.y < 0.f ? m.y : r.y; return o;
}
__device__ __forceinline__ f32x4 gelu4(f32x4 v) { const f32x2 a = gelu_pk((f32x2){v[0], v[1]}), b = gelu_pk((f32x2){v[2], v[3]}); return (f32x4){a.x, a.y, b.x, b.y}; }
__device__ __forceinline__ float tanh_fast(float x) { return 1.f - 2.f * __builtin_amdgcn_rcpf(1.f + __expf(2.f * x)); }

#define XB_TMO      128
#define XB_XCNT(j)  (256  + 64 * (j))
#define XB_XSUB(j)  (1280 + 64 * (j))
#define XB_XGEN(j)  (2304 + 64 * (j))
#define XB_TOP      3328
#define XB_TOPGEN   3392
#define XCD_BAR_WORDS 3456
#define XB_SPIN_CAP (1u << 20)

__device__ __forceinline__ unsigned xb_ld(unsigned* p)              { return __hip_atomic_load(p, __ATOMIC_RELAXED, __HIP_MEMORY_SCOPE_AGENT); }
__device__ __forceinline__ unsigned xb_add(unsigned* p, unsigned v) { return __hip_atomic_fetch_add(p, v, __ATOMIC_RELAXED, __HIP_MEMORY_SCOPE_AGENT); }
__device__ __forceinline__ unsigned xb_xcc_id() { return (unsigned)__builtin_amdgcn_s_getreg((3 << 11) | 20) & 0xFu; }
#define XB_SPIN(cond, bar) do { unsigned _sp = 0; while (cond) { __builtin_amdgcn_s_sleep(1); \
    if ((++_sp & 255u) == 0u) { if (xb_ld(&(bar)[XB_TMO])) break; if (_sp > XB_SPIN_CAP) { atomicAdd(&(bar)[XB_TMO], 1u); break; } } } } while (0)

struct XcdBarrier { unsigned* bar; unsigned x; volatile LAS unsigned* st; };

__device__ __forceinline__ XcdBarrier xcd_barrier_post(unsigned* bar, volatile LAS unsigned* st) {
    XcdBarrier b; b.bar = bar; b.x = xb_xcc_id(); b.st = st;
    if (threadIdx.x == 0) (void)xb_add(&bar[XB_XCNT(b.x)], 1u);
    return b;
}
__device__ __forceinline__ void xcd_barrier_complete(unsigned* bar, unsigned x, unsigned& nloc, unsigned& nx) {
    const unsigned G = gridDim.x * gridDim.y * gridDim.z;
    unsigned sum, cnt, mine, sp = 0u;
    for (;;) {
        sum = 0u; cnt = 0u; mine = 0u;
#pragma unroll
        for (unsigned j = 0; j < 16; ++j) { const unsigned c = xb_ld(&bar[XB_XCNT(j)]); sum += c; cnt += (c > 0u) ? 1u : 0u; mine = (j == x) ? c : mine; }
        if (sum == G) break;
        __builtin_amdgcn_s_sleep(1);
        if ((++sp & 255u) == 0u) { if (xb_ld(&bar[XB_TMO])) break; if (sp > XB_SPIN_CAP) { atomicAdd(&bar[XB_TMO], 1u); break; } }
    }
    nloc = mine > 0u ? mine : 1u; nx = cnt > 0u ? cnt : 1u;
}
__device__ __forceinline__ void xcd_barrier(const XcdBarrier& b) {
    asm volatile("s_waitcnt vmcnt(0)" ::: "memory");
    __syncthreads();
    if (threadIdx.x == 0) {
        unsigned* bar = b.bar;
        __builtin_amdgcn_s_waitcnt(0);
        unsigned nloc = b.st[0], nx = b.st[1];
        if (nloc == 0u) { xcd_barrier_complete(bar, b.x, nloc, nx); b.st[0] = nloc; b.st[1] = nx; }
        const unsigned old = xb_add(&bar[XB_XSUB(b.x)], 1u);
        const unsigned gen = old / nloc;
        if (old + 1u == (gen + 1u) * nloc) {
            __builtin_amdgcn_fence(__ATOMIC_RELEASE, "agent");
            asm volatile("s_waitcnt vmcnt(0)" ::: "memory");
            const unsigned og = xb_add(&bar[XB_TOP], 1u);
            const unsigned tg = og / nx;
            if (og + 1u == (tg + 1u) * nx) xb_add(&bar[XB_TOPGEN], 1u);
            else XB_SPIN(xb_ld(&bar[XB_TOPGEN]) == tg, bar);
            __builtin_amdgcn_fence(__ATOMIC_ACQUIRE, "agent");
            xb_add(&bar[XB_XGEN(b.x)], 1u);
            asm volatile("s_waitcnt vmcnt(0)" ::: "memory");
        } else {
            XB_SPIN(xb_ld(&bar[XB_XGEN(b.x)]) == gen, bar);
            __builtin_amdgcn_fence(__ATOMIC_ACQUIRE, "agent");
            asm volatile("s_waitcnt vmcnt(0)" ::: "memory");
        }
    }
    __syncthreads();
}

namespace pg8 {
constexpr int BM = 256, BK = 64, HALF = 128, HTB = HALF * BK * 2, STAGE_BYTES = 8 * HTB, NXCD = 8, WGM = 8;
__host__ __device__ __forceinline__ int lds_byte(int r, int c) { const int st = (r >> 4) * 2 + (c >> 5), rr = r & 15, cc = c & 31, ob = rr * 64 + cc * 2; return st * 1024 + (ob ^ (((ob >> 9) & 1) << 5)); }
__host__ __device__ __forceinline__ void stage_rc(int b, int& R, int& C) { const int st = b / 1024, sb = b % 1024, swz = sb ^ (((sb >> 9) & 1) << 5); R = (st >> 1) * 16 + swz / 64; C = (st & 1) * 32 + (swz % 64) / 2; }

struct Unit { int pm, pn, hf; };
struct Gemm { const bf16_t* A; const bf16_t* Bt; int K; };

template <int MODE> struct Order {
    static constexpr bool GATHER = (MODE == 1);
    int nM, nN, nwg, G, c; const int* idx; long bstride;
    __device__ __forceinline__ void init(int nM_, int nN_, int G_, int c_, const int* idx_, long bstride_) { nM = nM_; nN = nN_; nwg = nM * nN; G = G_; c = c_; idx = idx_; bstride = bstride_; }
    __device__ __forceinline__ bool next(int i, Unit& u) const {
        const long L = (long)i * G + c; if (L >= nwg) return false;
        int wgid = (int)L; { const int q = nwg / NXCD, r = nwg % NXCD, xcd = wgid % NXCD, off = wgid / NXCD; wgid = (xcd < r ? xcd * (q + 1) : r * (q + 1) + (xcd - r) * q) + off; }
        const int nig = WGM * nN, gid = wgid / nig, fm = gid * WGM, gsz = (nM - fm) < WGM ? (nM - fm) : WGM;
        u.pm = fm + ((wgid % nig) % gsz); u.pn = (wgid % nig) / gsz; u.hf = (MODE != 0 && (u.pm % 17) == 16) ? 1 : 0; return true;
    }
    __device__ __forceinline__ unsigned arow(const Unit& u, int r) const { if (MODE == 1) return (unsigned)idx[u.pm * BM + r]; return (unsigned)(u.pm * BM + r); }
    __device__ __forceinline__ long bbase(const Unit& u, int K) const { long o = (long)u.pn * BM * K; if (MODE != 0) o += (long)(u.pm / 17) * bstride; return o; }
};

template <int MODE> struct OrderExp {
    static constexpr bool GATHER = (MODE == 1);
    int nN, G, c0; const int* idx; long bstride;
    __device__ __forceinline__ void init(int nN_, int G_, int c_, const int* idx_, long bstride_) { nN = nN_; G = G_; c0 = c_; idx = idx_; bstride = bstride_; }
    __device__ __forceinline__ bool next(int i0, Unit& u) const {
        const int v = i0 * G + c0, i = v >> 8, c = v & 255;
        const int x = c & 7, slot = c >> 3, per = 32 / nN, nfull = 256 / (8 * per);
        if (i > nfull) return false;
        if (i < nfull) { u.pn = slot / per; const int f = (i * 8 + x) * per + (slot % per); u.pm = (f >> 4) * 17 + (f & 15); u.hf = 0; return true; }
        if (i == nfull && slot < 2 * nN) { u.pn = slot >> 1; u.pm = (x * 2 + (slot & 1)) * 17 + 16; u.hf = 1; return true; }
        return false;
    }
    __device__ __forceinline__ unsigned arow(const Unit& u, int r) const { if (MODE == 1) return (unsigned)idx[u.pm * BM + r]; return (unsigned)(u.pm * BM + r); }
    __device__ __forceinline__ long bbase(const Unit& u, int K) const { return (long)u.pn * BM * K + (long)(u.pm / 17) * bstride; }
};

template <class Epi, class Sched>
__device__ __forceinline__ void gemm_phase(LAS unsigned char* lds, const Gemm g, const Sched& S, const Epi& E) {
    int tid = threadIdx.x; asm volatile("" : "+v"(tid));
    const int wid = __builtin_amdgcn_readfirstlane(tid >> 6), wr = wid >> 2, wc = wid & 3;
    const int K = g.K, nt = K / BK;
    unsigned voffB[2];
    { const int lane = tid & 63, fr = lane & 15, fq = lane >> 4; (void)fr; (void)fq; }
#pragma unroll
    for (int i = 0; i < 2; ++i) { int R, Cc; stage_rc(tid * 16 + i * 8192, R, Cc); voffB[i] = (unsigned)(R * K + Cc) * 2u; }
    const size_t kstep = (size_t)(BK * 2);
    const size_t hstep = (size_t)HALF * K * 2;
    const unsigned ldsw = (unsigned)wid * 1024u;
    const int aoff = lds_byte(wr * 64 + (tid & 15), ((tid & 63) >> 4) * 8), boff = lds_byte(wc * 32 + (tid & 15), ((tid & 63) >> 4) * 8);
#define PG8_SA(b, h) (((b) * 2 + (h)) * HTB)
#define PG8_SB(b, h) ((4 + (b) * 2 + (h)) * HTB)
#define PG8_STAGE(bufoff, gbase, voff) do { _Pragma("unroll") for (int _i = 0; _i < 2; ++_i) \
        __builtin_amdgcn_global_load_lds((const unsigned*)((const char*)(gbase) + (voff)[_i]), (LAS unsigned*)(lds + (bufoff) + ldsw + _i * 8192), 16, 0, 0); } while (0)
#define PG8_LDA(dst, b, h) do { _Pragma("unroll") for (int m = 0; m < 4; ++m) _Pragma("unroll") for (int k = 0; k < 2; ++k) dst[m][k] = *(const LAS bf16x8*)(lds + PG8_SA(b, h) + aoff + m * 2048 + k * 1024); } while (0)
#define PG8_LDB(dst, b, h) do { _Pragma("unroll") for (int n = 0; n < 2; ++n) _Pragma("unroll") for (int k = 0; k < 2; ++k) dst[n][k] = *(const LAS bf16x8*)(lds + PG8_SB(b, h) + boff + n * 2048 + k * 1024); } while (0)
#define PG8_MMA(ai, bj, At, Bt) do { __builtin_amdgcn_s_setprio(1); _Pragma("unroll") for (int m = 0; m < 4; ++m) _Pragma("unroll") for (int n = 0; n < 2; ++n) _Pragma("unroll") for (int k = 0; k < 2; ++k) \
        acc[ai][bj][m][n] = __builtin_amdgcn_mfma_f32_16x16x32_bf16(Bt[n][k], At[m][k], acc[ai][bj][m][n], 0, 0, 0); __builtin_amdgcn_s_setprio(0); } while (0)
#define PG8_WAIT_V(n) asm volatile("s_waitcnt vmcnt(" #n ")" ::: "memory")
#define PG8_WAIT_L(n) asm volatile("s_waitcnt lgkmcnt(" #n ")" ::: "memory")
#define PG8_BAR __builtin_amdgcn_s_barrier()
#define PG8_SCHED __builtin_amdgcn_sched_barrier(0)
#define PG8_ROWOFFS(dst, u, tq) do { _Pragma("unroll") for (int _i = 0; _i < 2; ++_i) { int _R, _C; stage_rc((tq) * 16 + _i * 8192, _R, _C); _Pragma("unroll") for (int _h = 0; _h < 2; ++_h) dst[_h][_i] = (S.arow(u, _h * HALF + _R) * (unsigned)K + (unsigned)_C) * 2u; } } while (0)
    Unit cur, nxt; int ui = 0;
    if (!S.next(0, cur)) return;
    float zf = 0.f; asm volatile("" : "+v"(zf));
    f32x4 acc[2][2][4][2];
#pragma unroll
    for (int a = 0; a < 2; ++a)
#pragma unroll
        for (int b = 0; b < 2; ++b)
#pragma unroll
            for (int m = 0; m < 4; ++m)
#pragma unroll
                for (int n = 0; n < 2; ++n) acc[a][b][m][n] = (f32x4){zf, zf, zf, zf};
    bf16x8 At[4][2], B0[2][2], B1[2][2];
    unsigned vcur[2][2];
    if constexpr (Sched::GATHER) { PG8_ROWOFFS(vcur, cur, tid); }
    const char* const Ab = (const char*)g.A;
    const char* cA = Sched::GATHER ? Ab : Ab + (size_t)(unsigned)__builtin_amdgcn_readfirstlane((int)S.arow(cur, 0)) * K * 2;
#define PG8_STAGEA(bufoff, ptr, h) do { if constexpr (Sched::GATHER) { PG8_STAGE(bufoff, ptr, vcur[h]); } else { PG8_STAGE(bufoff, (ptr) + (h) * hstep, voffB); } } while (0)
    const char* cB = (const char*)g.Bt + (size_t)S.bbase(cur, K) * 2;
    PG8_STAGE(PG8_SB(0, 0), cB, voffB); PG8_STAGE(PG8_SB(0, 1), cB + hstep, voffB); PG8_STAGEA(PG8_SA(0, 0), cA, 0); PG8_STAGEA(PG8_SA(0, 1), cA, 1);
    if (wr == 1) PG8_BAR;
    PG8_WAIT_V(2); PG8_BAR;
    PG8_STAGE(PG8_SB(1, 0), cB + kstep, voffB); PG8_STAGEA(PG8_SA(1, 0), cA + kstep, 0); PG8_STAGE(PG8_SB(1, 1), cB + hstep + kstep, voffB);
    PG8_WAIT_V(6); PG8_BAR;
    for (;;) {
        const bool has_next = S.next(ui + 1, nxt);
        const char* nB = has_next ? (const char*)g.Bt + (size_t)S.bbase(nxt, K) * 2 : cB;
        const char* nA = (Sched::GATHER || !has_next) ? cA : Ab + (size_t)(unsigned)__builtin_amdgcn_readfirstlane((int)S.arow(nxt, 0)) * K * 2;
#pragma unroll 1
        for (int t = 0; t < nt; t += 2) {
            const bool last = (t == nt - 2);
            const char* a1 = cA + (size_t)(t + 1) * kstep;
            const char* a2 = last ? nA : cA + (size_t)(t + 2) * kstep; const char* b2 = last ? nB : cB + (size_t)(t + 2) * kstep;
            const char* a3 = a2 + kstep; const char* b3 = b2 + kstep;
            PG8_LDB(B0, 0, 0); PG8_LDB(B1, 0, 1); PG8_SCHED; PG8_LDA(At, 0, 0); PG8_STAGEA(PG8_SA(1, 1), a1, 1);
            PG8_WAIT_V(8); PG8_WAIT_L(0); PG8_BAR; PG8_MMA(0, 0, At, B0); PG8_MMA(0, 1, At, B1); PG8_BAR; PG8_SCHED;
            if constexpr (Sched::GATHER) { if (last && has_next) { int tq = tid; asm volatile("" : "+v"(tq)); PG8_ROWOFFS(vcur, nxt, tq); } }
            PG8_LDA(At, 0, 1); PG8_STAGE(PG8_SB(0, 0), b2, voffB); PG8_STAGE(PG8_SB(0, 1), b2 + hstep, voffB); PG8_STAGEA(PG8_SA(0, 0), a2, 0);
            PG8_WAIT_V(8); PG8_WAIT_L(0); PG8_BAR; if (!cur.hf) { PG8_MMA(1, 0, At, B0); PG8_MMA(1, 1, At, B1); } PG8_BAR; PG8_SCHED;
            PG8_LDB(B0, 1, 0); PG8_LDB(B1, 1, 1); PG8_SCHED; PG8_LDA(At, 1, 0); PG8_STAGEA(PG8_SA(0, 1), a2, 1);
            PG8_WAIT_V(8); PG8_WAIT_L(0); PG8_BAR; PG8_MMA(0, 0, At, B0); PG8_MMA(0, 1, At, B1); PG8_BAR; PG8_SCHED;
            PG8_LDA(At, 1, 1); PG8_STAGE(PG8_SB(1, 0), b3, voffB); PG8_STAGE(PG8_SB(1, 1), b3 + hstep, voffB); PG8_STAGEA(PG8_SA(1, 0), a3, 0);
            PG8_WAIT_V(8); PG8_WAIT_L(0); PG8_BAR; if (!cur.hf) { PG8_MMA(1, 0, At, B0); PG8_MMA(1, 1, At, B1); } PG8_BAR; PG8_SCHED;
        }
        if (wr == 0) PG8_BAR;
        { int tz = tid; asm volatile("" : "+v"(tz)); const int ln = tz & 63; E(acc, cur, wr, wc, ln & 15, ln >> 4); }
        if (!has_next) break;
#pragma unroll
        for (int a = 0; a < 2; ++a)
#pragma unroll
            for (int b = 0; b < 2; ++b)
#pragma unroll
                for (int m = 0; m < 4; ++m)
#pragma unroll
                    for (int n = 0; n < 2; ++n) acc[a][b][m][n] = (f32x4){zf, zf, zf, zf};
        cur = nxt; cB = nB; cA = nA; ++ui;
        if (wr == 1) PG8_BAR;
    }
    PG8_WAIT_V(0);
    PG8_BAR;
#undef PG8_SA
#undef PG8_SB
#undef PG8_STAGE
#undef PG8_LDA
#undef PG8_LDB
#undef PG8_MMA
#undef PG8_WAIT_V
#undef PG8_WAIT_L
#undef PG8_BAR
#undef PG8_SCHED
#undef PG8_ROWOFFS
#undef PG8_STAGEA
}

#define EPI_LOOP for (int ai = 0; ai < 2; ++ai) for (int m = 0; m < 4; ++m) for (int bj = 0; bj < 2; ++bj) for (int n = 0; n < 2; ++n)
__device__ __forceinline__ int colw_of(int fq) { return (fq & 1) * 16 + (fq >> 1) * 8; }
__device__ __forceinline__ void st_pair_bf16(bf16_t* p  , f32x4 v0, f32x4 v1) {
    const unsigned a0 = pk2(v0[0], v0[1]), a1 = pk2(v0[2], v0[3]), b0 = pk2(v1[0], v1[1]), b1 = pk2(v1[2], v1[3]);
    const auto r0 = __builtin_amdgcn_permlane16_swap(a0, b0, false, false); const auto r1 = __builtin_amdgcn_permlane16_swap(a1, b1, false, false);
    u32x4 o; o.x = r0[0]; o.y = r1[0]; o.z = r0[1]; o.w = r1[1]; *(u32x4*)p = o;
}
__device__ __forceinline__ void ld_pair_bf16(const void* p, u32x2& n0, u32x2& n1) {
    const u32x4 w = *(const u32x4*)p;
    const auto r0 = __builtin_amdgcn_permlane16_swap(w.x, w.z, false, false); const auto r1 = __builtin_amdgcn_permlane16_swap(w.y, w.w, false, false);
    n0.x = r0[0]; n0.y = r1[0]; n1.x = r0[1]; n1.y = r1[1];
}
struct EpiBf16 {
    bf16_t* O; int ldc;
    __device__ __forceinline__ void operator()(const f32x4 (&acc)[2][2][4][2], const Unit& u, int wr, int wc, int fr, int fq) const {
        const int row0 = u.pm * BM + wr * 64 + fr, colg = u.pn * BM + wc * 32 + colw_of(fq);
#pragma unroll
        for (int ai = 0; ai < 2; ++ai)
#pragma unroll
            for (int m = 0; m < 4; ++m) { bf16_t* rowp = O + (size_t)(row0 + ai * HALF + m * 16) * ldc + colg;
#pragma unroll
                for (int bj = 0; bj < 2; ++bj) st_pair_bf16(rowp + bj * HALF, acc[ai][bj][m][0], acc[ai][bj][m][1]); }
    }
};
struct EpiOdd {
    bf16_t* P; bf16_t* Q; bf16_t* KA; const float* rope;
    __device__ __forceinline__ void operator()(const f32x4 (&acc)[2][2][4][2], const Unit& u, int wr, int wc, int fr, int fq) const {
        const int row0 = u.pm * BM + wr * 64 + fr, col0 = u.pn * BM + wc * 32 + 4 * fq;
        if (u.pn >= 6) {
#pragma unroll
            for (int ai = 0; ai < 2; ++ai)
#pragma unroll
                for (int m = 0; m < 4; ++m) { bf16_t* rowp = P + (size_t)(row0 + ai * HALF + m * 16) * P_LD + (col0 - 4 * fq + colw_of(fq));
#pragma unroll
                    for (int bj = 0; bj < 2; ++bj) st_pair_bf16(rowp + bj * HALF, acc[ai][bj][m][0], acc[ai][bj][m][1]); }
            return;
        }
        const bool isk = u.pn >= 3, isctx = u.pm >= NLAT / BM; const int axis = wc & 1;
        const int cq = col0 - (isk ? 768 : 0);
        f32x4 csr[2][4], snr[2][4];
#pragma unroll
        for (int ai = 0; ai < 2; ++ai)
#pragma unroll
            for (int m = 0; m < 4; ++m) { const int row = row0 + ai * HALF + m * 16; csr[ai][m] = (f32x4){1.f, 1.f, 1.f, 1.f}; snr[ai][m] = (f32x4){0.f, 0.f, 0.f, 0.f};
                if (!isctx) { const int t = row & (TT - 1); const int pos = axis ? 128 + (t & 63) : (t >> 6);
                    csr[ai][m] = *(const f32x4*)(rope + pos * 16 + 4 * fq); snr[ai][m] = *(const f32x4*)(rope + 192 * 16 + pos * 16 + 4 * fq); } }
#pragma unroll
        for (int ai = 0; ai < 2; ++ai)
#pragma unroll
            for (int m = 0; m < 4; ++m) { const int row = row0 + ai * HALF + m * 16;
                const f32x4 cs = csr[ai][m], sn = snr[ai][m]; size_t orow;
                if (!isctx) { const int t = row & (TT - 1); orow = isk ? (size_t)(row >> 13) * LKEYS + CTXL + t : (size_t)row; }
                else { const int rc = row - NLAT; orow = isk ? (size_t)(rc >> 8) * LKEYS + (rc & 255) : (size_t)row; }
                bf16_t* op = (isk ? KA : Q) + orow * 768 + cq; const float sc = isk ? 1.f : QSCALE;
#pragma unroll
                for (int bj = 0; bj < 2; ++bj) { const f32x4 x1 = acc[ai][bj][m][0], x2 = acc[ai][bj][m][1];
                    const f32x4 o1 = (x1 * cs - x2 * sn) * sc, o2 = (x1 * sn + x2 * cs) * sc;
                    st_pair_bf16(op + bj * HALF - 4 * fq + colw_of(fq), o1, o2); } }
    }
};
struct EpiRes {
    float* X; const float* modl; const float* xin; const float* cin;
    __device__ __forceinline__ void operator()(const f32x4 (&acc)[2][2][4][2], const Unit& u, int wr, int wc, int fr, int fq) const {
        const int row0 = u.pm * BM + wr * 64 + fr, col0 = u.pn * BM + wc * 32 + 4 * fq;
        const int mi = (u.pm * BM < NLAT) ? (u.pm * BM) / TT : 4;
        const float* gate = modl + mi * 6144 + 2 * DM;
        const float* rsrc = (u.pm * BM < NLAT) ? xin : cin - (size_t)NLAT * DM;
        f32x4 gv[2][2];
#pragma unroll
        for (int bj = 0; bj < 2; ++bj)
#pragma unroll
            for (int n = 0; n < 2; ++n) gv[bj][n] = *(const f32x4*)(gate + col0 + bj * HALF + n * 16);
#pragma unroll
        for (int ai = 0; ai < 2; ++ai) { f32x4 xr[4][2][2];
#pragma unroll
            for (int m = 0; m < 4; ++m) { const float* rowp = rsrc + (size_t)(row0 + ai * HALF + m * 16) * DM + col0;
#pragma unroll
                for (int bj = 0; bj < 2; ++bj)
#pragma unroll
                    for (int n = 0; n < 2; ++n) xr[m][bj][n] = *(const f32x4*)(rowp + bj * HALF + n * 16); }
#pragma unroll
            for (int m = 0; m < 4; ++m) { float* rowp = X + (size_t)(row0 + ai * HALF + m * 16) * DM + col0;
#pragma unroll
                for (int bj = 0; bj < 2; ++bj)
#pragma unroll
                    for (int n = 0; n < 2; ++n) *(f32x4*)(rowp + bj * HALF + n * 16) = xr[m][bj][n] * ALPHA_DN + gv[bj][n] * acc[ai][bj][m][n]; } }
    }
};
struct EpiSwiGLU {
    bf16_t* HID;
    __device__ __forceinline__ void operator()(const f32x4 (&acc)[2][2][4][2], const Unit& u, int wr, int wc, int fr, int fq) const {
        const int row0 = u.pm * BM + wr * 64 + fr, f0 = u.pn * HALF + wc * 32 + 4 * fq;
#pragma unroll
        for (int ai = 0; ai < 2; ++ai) if (ai == 0 || !u.hf)
#pragma unroll
            for (int m = 0; m < 4; ++m) { bf16_t* rowp = HID + (size_t)(row0 + ai * HALF + m * 16) * D_EXP + u.pn * HALF + wc * 32 + colw_of(fq); f32x4 hh[2];
#pragma unroll
                for (int n = 0; n < 2; ++n) { const f32x4 a = acc[ai][0][m][n], b = acc[ai][1][m][n];
#pragma unroll
                    for (int j = 0; j < 4; ++j) hh[n][j] = a[j] * __builtin_amdgcn_rcpf(1.f + __expf(-a[j])) * b[j]; }
                st_pair_bf16(rowp, hh[0], hh[1]); }
    }
};
struct EpiYE {
    bf16_t* YE; const float* gate;
    __device__ __forceinline__ void operator()(const f32x4 (&acc)[2][2][4][2], const Unit& u, int wr, int wc, int fr, int fq) const {
        const int row0 = u.pm * BM + wr * 64 + fr, col0 = u.pn * BM + wc * 32 + 4 * fq;
        float gts[2][4];
#pragma unroll
        for (int ai = 0; ai < 2; ++ai)
#pragma unroll
            for (int m = 0; m < 4; ++m) gts[ai][m] = gate[row0 + ai * HALF + m * 16];
#pragma unroll
        for (int ai = 0; ai < 2; ++ai) if (ai == 0 || !u.hf)
#pragma unroll
            for (int m = 0; m < 4; ++m) { const int row = row0 + ai * HALF + m * 16; const float gt = gts[ai][m]; bf16_t* rowp = YE + (size_t)row * DM + (col0 - 4 * fq + colw_of(fq));
#pragma unroll
                for (int bj = 0; bj < 2; ++bj) st_pair_bf16(rowp + bj * HALF, acc[ai][bj][m][0] * gt, acc[ai][bj][m][1] * gt); }
    }
};
struct EpiLora {
    unsigned char* SCN; bf16_t* G; const float* decay0; const float* a0; const float* kalpha;
    __device__ __forceinline__ void operator()(const f32x4 (&acc)[2][2][4][2], const Unit& u, int wr, int wc, int fr, int fq) const {
        const int row0 = u.pm * BM + wr * 64 + fr;
        const int seg = u.pn / 3, cb = (u.pn % 3) * BM + wc * 32 + 4 * fq, cw = colw_of(fq) - 4 * fq;
        f32x4 par0[2][2], par1[2][2];
#pragma unroll
        for (int bj = 0; bj < 2; ++bj)
#pragma unroll
            for (int n = 0; n < 2; ++n) { const int col = cb + bj * HALF + n * 16; par0[bj][n] = (f32x4){0.f, 0.f, 0.f, 0.f}; par1[bj][n] = par0[bj][n];
                if (seg < 2) par0[bj][n] = *(const f32x4*)(decay0 + seg * 768 + col);
                else if (seg < 4) { par0[bj][n] = *(const f32x4*)(a0 + (seg - 2) * 768 + col); par1[bj][n] = *(const f32x4*)(kalpha + col); } }
#pragma unroll
        for (int bj = 0; bj < 2; ++bj) {
            const int colA = cb + bj * HALF, head = colA >> 6, kx0 = colA & 63;
            if (seg < 2) {
#pragma unroll
                for (int n = 0; n < 2; ++n) { const f32x4 d0 = par0[bj][n]; const int kx = kx0 + n * 16;
#pragma unroll
                    for (int ai = 0; ai < 2; ++ai)
#pragma unroll
                        for (int m = 0; m < 4; ++m) { const int row = row0 + ai * HALF + m * 16; f32x4 w;
#pragma unroll
                            for (int j = 0; j < 4; ++j) { const float lw = -DECAY_SCALE * sigmoidf_(d0[j] + acc[ai][bj][m][n][j]); w[j] = CHUNKED_SCAN ? lw : __expf(lw); }
                            *(f32x4*)(SCN + (size_t)(row * 12 + head) * SC_REC + SC_W + seg * 256 + kx * 4) = w; __builtin_amdgcn_sched_barrier(0); } }
            } else if (seg < 4) {
                const int d = seg - 2;
#pragma unroll
                for (int ai = 0; ai < 2; ++ai) {
                    u32x2 kkr[2][4], ksr[2][4];
                    u32x4 wk[4], ws_[4];
#pragma unroll
                    for (int m = 0; m < 4; ++m) { const unsigned char* base = SCN + (size_t)((row0 + ai * HALF + m * 16) * 12 + head) * SC_REC + (kx0 + cw) * 2;
                        wk[m] = *(const u32x4*)(base + SC_KK); ws_[m] = *(const u32x4*)(base + SC_KR + 256 * d); }
#pragma unroll
                    for (int m = 0; m < 4; ++m) {
                        { const auto r0 = __builtin_amdgcn_permlane16_swap(wk[m].x, wk[m].z, false, false); const auto r1 = __builtin_amdgcn_permlane16_swap(wk[m].y, wk[m].w, false, false);
                          kkr[0][m].x = r0[0]; kkr[0][m].y = r1[0]; kkr[1][m].x = r0[1]; kkr[1][m].y = r1[1]; }
                        { const auto r0 = __builtin_amdgcn_permlane16_swap(ws_[m].x, ws_[m].z, false, false); const auto r1 = __builtin_amdgcn_permlane16_swap(ws_[m].y, ws_[m].w, false, false);
                          ksr[0][m].x = r0[0]; ksr[0][m].y = r1[0]; ksr[1][m].x = r0[1]; ksr[1][m].y = r1[1]; } }
#pragma unroll
                    for (int m = 0; m < 4; ++m) { const int row = row0 + ai * HALF + m * 16; unsigned char* base = SCN + (size_t)(row * 12 + head) * SC_REC + (kx0 + cw) * 2; f32x4 bb[2], kr[2];
#pragma unroll
                        for (int n = 0; n < 2; ++n) { const f32x4 a00 = par0[bj][n], kal = par1[bj][n];
                            const f32x4 kk = {bflo(kkr[n][m].x), bfhi(kkr[n][m].x), bflo(kkr[n][m].y), bfhi(kkr[n][m].y)}; const f32x4 ks = {bflo(ksr[n][m].x), bfhi(ksr[n][m].x), bflo(ksr[n][m].y), bfhi(ksr[n][m].y)};
#pragma unroll
                            for (int j = 0; j < 4; ++j) { const float a = sigmoidf_(a00[j] + acc[ai][bj][m][n][j]); bb[n][j] = kk[j] * a; kr[n][j] = ks[j] * (1.f + (a - 1.f) * kal[j]); } }
                        st_pair_bf16((bf16_t*)(base + SC_B + 256 * d), bb[0], bb[1]); st_pair_bf16((bf16_t*)(base + SC_KR + 256 * d), kr[0], kr[1]); __builtin_amdgcn_sched_barrier(0); } }
            } else {
#pragma unroll
                for (int ai = 0; ai < 2; ++ai)
#pragma unroll
                    for (int m = 0; m < 4; ++m) { const int row = row0 + ai * HALF + m * 16; st_pair_bf16(G + (size_t)row * 768 + colA + cw, acc[ai][bj][m][0], acc[ai][bj][m][1]); }
            }
        }
    }
};
}

struct Args { const float* in[37]; float* out; unsigned char* ws; int lo, hi; };
enum { I_X = 0, I_C, I_CTX, I_CCTX, I_WMOD, I_BMOD, I_LNG, I_LNB, I_EWIN, I_EWOUT, I_CONVW, I_MU, I_DUP, I_D0, I_AUP, I_A0, I_GUP, I_KXI, I_KAL, I_RBON, I_GNG, I_GNB,
       I_OWIN, I_OWOUT, I_LQ1, I_LK1, I_LQ2, I_LK2, I_SUBG, I_GLNG, I_GLNB, I_GWS, I_GBS, I_WR, I_WE1, I_WE3, I_WE2 };

struct Ctx {
    LAS unsigned char* lds;
    int tid, lane, wave, G, vcu, gw, NGW;
};
__device__ __forceinline__ void mkctx(Ctx& C, LAS unsigned char* lds) {
    int tid = threadIdx.x; asm volatile("" : "+v"(tid));
    C.lds = lds; C.tid = tid; C.lane = tid & 63; C.wave = __builtin_amdgcn_readfirstlane(tid >> 6);
    C.G = gridDim.x; { const int bx = blockIdx.x; C.vcu = (C.G % 8 == 0) ? (bx % 8) * (C.G / 8) + bx / 8 : bx; }
    C.gw = blockIdx.x * NWAVES + C.wave; C.NGW = C.G * NWAVES;
}
#define GLOBAL_PTR(T, v) ((T*)(__attribute__((address_space(1))) T*)(v))
__device__ __forceinline__ void ldargs(Args& A, LAS unsigned char* lds) {
    LAS const u32x2* tb = (LAS const u32x2*)(lds + LDS_PTAB); asm volatile("" : "+v"(tb));
#pragma unroll
    for (int i = 0; i < 37; ++i) { const u32x2 v = tb[i]; A.in[i] = GLOBAL_PTR(const float, ((unsigned long long)(unsigned)__builtin_amdgcn_readfirstlane((int)v.y) << 32) | (unsigned)__builtin_amdgcn_readfirstlane((int)v.x)); }
    { const u32x2 v = tb[37]; A.out = GLOBAL_PTR(float, ((unsigned long long)(unsigned)__builtin_amdgcn_readfirstlane((int)v.y) << 32) | (unsigned)__builtin_amdgcn_readfirstlane((int)v.x)); }
    { const u32x2 v = tb[38]; A.ws = GLOBAL_PTR(unsigned char, ((unsigned long long)(unsigned)__builtin_amdgcn_readfirstlane((int)v.y) << 32) | (unsigned)__builtin_amdgcn_readfirstlane((int)v.x)); }
    A.lo = 0; A.hi = 0;
}
__device__ __forceinline__ int row_mi(int row) { return row < NLAT ? (row >> 13) : 4; }

__device__ __forceinline__ void phase_init(const Ctx& C, const Args& A) {
    unsigned char* ws = A.ws;
    float* MOD = (float*)(ws + WS_MOD);
    LAS float* sv = (LAS float*)C.lds;
    LAS float* red = sv + 5 * 1024;
    for (int i = C.tid; i < 5 * 1024; i += NTHR) { const int v = i >> 10, k = i & 1023; const float c = (v < 4) ? A.in[I_C][v * DM + k] : A.in[I_CCTX][k]; sv[i] = c / (1.f + __expf(-c)); }
    __syncthreads();
    const int j = C.tid & 127, kp = C.tid >> 7;
    for (int it = blockIdx.x; it < DEPTH * 48; it += C.G) {
        const int l = it / 48, cg = it % 48, col = cg * 128 + j;
        const float* W = A.in[I_WMOD] + (size_t)l * DM * 6144 + col;
        float a0 = 0.f, a1 = 0.f, a2 = 0.f, a3 = 0.f, a4 = 0.f;
#pragma unroll 32
        for (int k = kp * 256; k < kp * 256 + 256; ++k) { const float w = W[(size_t)k * 6144];     a0 += sv[k] * w; a1 += sv[1024 + k] * w; a2 += sv[2048 + k] * w; a3 += sv[3072 + k] * w; a4 += sv[4096 + k] * w; }
        red[(kp * 5 + 0) * 128 + j] = a0; red[(kp * 5 + 1) * 128 + j] = a1; red[(kp * 5 + 2) * 128 + j] = a2; red[(kp * 5 + 3) * 128 + j] = a3; red[(kp * 5 + 4) * 128 + j] = a4;
        __syncthreads();
        for (int o = C.tid; o < 5 * 128; o += NTHR) { const int v = o >> 7, jj = o & 127; const int cc = cg * 128 + jj;
            const float s = red[(0 * 5 + v) * 128 + jj] + red[(1 * 5 + v) * 128 + jj] + red[(2 * 5 + v) * 128 + jj] + red[(3 * 5 + v) * 128 + jj];
            MOD[((size_t)l * 5 + v) * 6144 + cc] = s + A.in[I_BMOD][l * 6144 + cc]; }
        __syncthreads();
    }
    if (blockIdx.x == C.G - 1) { float* rope = (float*)(ws + WS_ROPE);
        for (int i = C.tid; i < 192 * 16; i += NTHR) { const int pos = i >> 4, j = i & 15; const float ang = (float)(pos < 128 ? pos : pos - 128) * powf(10000.f, -(float)j * (1.f / 16.f));
            rope[i] = cosf(ang); rope[192 * 16 + i] = sinf(ang); } }
}

__device__ __forceinline__ void transpose_item(const float* W, int ldw, int k0, int n0, bf16_t* WT, int ldt, int drow0, LAS float* scr, int lane) {
    { float v[64]; const float* src = W + (size_t)k0 * ldw + n0 + lane;
#pragma unroll
      for (int k = 0; k < 64; ++k) v[k] = __builtin_nontemporal_load(src + (size_t)k * ldw);
#pragma unroll
      for (int k = 0; k < 64; ++k) scr[k * 65 + lane] = v[k]; }
    asm volatile("s_waitcnt lgkmcnt(0)" ::: "memory");
    const int c = lane & 7;
#pragma unroll
    for (int j = 0; j < 8; ++j) { const int n = (lane >> 3) + 8 * j; const LAS float* s = scr + (8 * c) * 65 + n;
        u32x4 o; o.x = pk2(s[0 * 65], s[1 * 65]); o.y = pk2(s[2 * 65], s[3 * 65]); o.z = pk2(s[4 * 65], s[5 * 65]); o.w = pk2(s[6 * 65], s[7 * 65]);
        *(u32x4*)(WT + (size_t)(drow0 + n) * ldt + k0 + 8 * c) = o; }
    asm volatile("s_waitcnt lgkmcnt(0)" ::: "memory");
}
constexpr int XW_IN_HI = 3200, XW_OUT_HI = 7040, XW_TK_HI = 9088;
constexpr int YW_IN_HI = 1344, YW_OF_HI = 6144, YW_OUT_HI = 9984, YW_TK_HI = 12032;
__device__ __forceinline__ void conv_items(const Ctx& C, const Args& A, int l, int gw, int NGW, bool do_in, bool do_out, bool do_exp, int lo = 0, int hi = 1 << 30) {
    unsigned char* ws = A.ws;
    const int i2 = l >> 1; const bool odd = (l & 1);
    LAS float* scr = (LAS float*)C.lds + C.wave * (64 * 65);
    bf16_t* WIN = (bf16_t*)(ws + WS_WIN); bf16_t* WOUT = (bf16_t*)(ws + WS_WOUT); bf16_t* WE13 = (bf16_t*)(ws + WS_WE13 + (size_t)(l & 1) * WE13_BYTES); bf16_t* WE2 = (bf16_t*)(ws + WS_WE2 + (size_t)(l & 1) * WE2_BYTES);
    const int nin = odd ? D_IN_ODD : D_IN_EVEN;
    const float* win = odd ? A.in[I_OWIN] + (size_t)i2 * DM * D_IN_ODD : A.in[I_EWIN] + (size_t)i2 * DM * D_IN_EVEN;
    const float* wout = odd ? A.in[I_OWOUT] + (size_t)i2 * DM * DM : A.in[I_EWOUT] + (size_t)i2 * DM * DM;
    const int n_in = do_in ? 16 * (nin / 64) : 0, n_out = do_out ? 16 * 16 : 0, n_e13 = do_exp ? NEXP * 2 * 16 * 32 : 0, n_e2 = do_exp ? NEXP * 32 * 16 : 0;
    const int total = (n_in + n_out + n_e13 + n_e2) < hi ? (n_in + n_out + n_e13 + n_e2) : hi;
    for (int it = lo + gw; it < total; it += NGW) {
        int r = it;
        if (r < n_in) { const int nb = nin / 64, kb = r / nb, nn = r % nb; transpose_item(win, nin, kb * 64, nn * 64, WIN, DM, nn * 64, scr, C.lane); continue; } r -= n_in;
        if (r < n_out) { const int kb = r / 16, nn = r % 16; transpose_item(wout, DM, kb * 64, nn * 64, WOUT, DM, nn * 64, scr, C.lane); continue; } r -= n_out;
        if (r < n_e13) { const int e = r / 1024, q = r % 1024, mat = q / 512, q2 = q % 512, kb = q2 / 32, nn = q2 % 32;
            const float* W = (mat ? A.in[I_WE3] : A.in[I_WE1]) + ((size_t)l * NEXP + e) * DM * D_EXP;
            const int f0 = nn * 64; const int drow = (f0 >> 7) * 256 + mat * 128 + (f0 & 127);
            transpose_item(W, D_EXP, kb * 64, f0, WE13 + (size_t)e * 4096 * DM, DM, drow, scr, C.lane); continue; } r -= n_e13;
        { const int e = r / 512, q = r % 512, kb = q / 16, nn = q % 16;
            const float* W = A.in[I_WE2] + ((size_t)l * NEXP + e) * D_EXP * DM;
            transpose_item(W, DM, kb * 64, nn * 64, WE2 + (size_t)e * DM * D_EXP, D_EXP, nn * 64, scr, C.lane); }
    }
}
__device__ __forceinline__ void phase_conv(const Ctx& C, const Args& A, int l) {
    unsigned char* ws = A.ws;
    const int i2 = l >> 1; const bool odd = (l & 1);
    bf16_t* WIN = (bf16_t*)(ws + WS_WIN);
    const bool early = CHUNKED_SCAN && odd;
    if (l > 0) { if (early || !CHUNKED_SCAN) conv_items(C, A, l, C.gw, C.NGW, !early, true, !early);
                 else { conv_items(C, A, l, C.gw, C.NGW, true, true, false); conv_items(C, A, l, C.gw, C.NGW, false, false, true, YW_TK_HI); } }
    if (!odd) {
        u32x4* z = (u32x4*)(WIN + (size_t)D_IN_EVEN * DM);
        unsigned zz = 0u; asm volatile("" : "+v"(zz));
        for (int i = blockIdx.x * NTHR + C.tid; i < (D_IN_EVEN_PAD - D_IN_EVEN) * DM / 8; i += C.G * NTHR) z[i] = (u32x4){zz, zz, zz, zz};
        bf16_t* WL = (bf16_t*)(ws + WS_WLORA);
        const float* dup = A.in[I_DUP] + (size_t)i2 * 2 * 64 * 768; const float* aup = A.in[I_AUP] + (size_t)i2 * 2 * 64 * 768; const float* gup = A.in[I_GUP] + (size_t)i2 * 128 * 768;
        for (int i = blockIdx.x * NTHR + C.tid; i < LORA_N * LORA_K; i += C.G * NTHR) {
            const int kk = i / LORA_N, n = i % LORA_N, seg = n / 768, col = n % 768; float v = 0.f;
            if (seg == 0) { if (kk < 64) v = dup[(size_t)(0 * 64 + kk) * 768 + col]; }
            else if (seg == 1) { if (kk >= 64 && kk < 128) v = dup[(size_t)(1 * 64 + kk - 64) * 768 + col]; }
            else if (seg == 2) { if (kk >= 128 && kk < 192) v = aup[(size_t)(0 * 64 + kk - 128) * 768 + col]; }
            else if (seg == 3) { if (kk >= 192 && kk < 256) v = aup[(size_t)(1 * 64 + kk - 192) * 768 + col]; }
            else { if (kk >= 256) v = gup[(size_t)(kk - 256) * 768 + col]; }
            WL[(size_t)n * LORA_K + kk] = (bf16_t)f2bf(v);
        }
    }
}

__device__ __forceinline__ void phase_modh(const Ctx& C, const Args& A, int l) {
    bf16_t* H = (bf16_t*)(A.ws + WS_H); const float* MOD = (const float*)(A.ws + WS_MOD) + (size_t)l * 5 * 6144;
    const float* xin = A.in[I_X]; const float* cin = A.in[I_CTX] - (size_t)NLAT * DM;
#define MODH_SRC(row_) (((row_) < NLAT ? xin : cin) + (size_t)(row_) * DM)
    const int row0 = (int)(((long)C.gw * MROWS) / C.NGW), row1 = (int)(((long)(C.gw + 1) * MROWS) / C.NGW);
    f32x4 shr[4], scr_[4], xn[4]; int cmi = -1;
    if (row0 < row1) {
#pragma unroll
        for (int j = 0; j < 4; ++j) xn[j] = *(const f32x4*)(MODH_SRC(row0) + 4 * C.lane + 256 * j); }
#pragma unroll
    for (int j = 0; j < 4; ++j) { shr[j] = (f32x4){0.f, 0.f, 0.f, 0.f}; scr_[j] = shr[j]; }
    for (int row = row0; row < row1; ++row) {
        const int mi = row_mi(row);
        if (mi != cmi) { cmi = mi; const float* md = MOD + mi * 6144;
#pragma unroll
            for (int j = 0; j < 4; ++j) { const int col = 4 * C.lane + 256 * j; shr[j] = *(const f32x4*)(md + col); scr_[j] = *(const f32x4*)(md + DM + col) + 1.f; } }
        f32x4 x[4];
#pragma unroll
        for (int j = 0; j < 4; ++j) x[j] = xn[j];
        if (row + 1 < row1) {
#pragma unroll
            for (int j = 0; j < 4; ++j) xn[j] = *(const f32x4*)(MODH_SRC(row + 1) + 4 * C.lane + 256 * j); }
#pragma unroll
        for (int j = 0; j < 4; ++j) { const int col = 4 * C.lane + 256 * j; const f32x4 h = x[j] * scr_[j] + shr[j]; u32x2 o; o.x = pk2(h[0], h[1]); o.y = pk2(h[2], h[3]); *(u32x2*)(H + (size_t)row * DM + col) = o; }
    }
}

__device__ __forceinline__ f32x4 ld4bf(const bf16_t* p) { const u32x2 u = *(const u32x2*)p; return (f32x4){bflo(u.x), bfhi(u.x), bflo(u.y), bfhi(u.y)}; }
__device__ __forceinline__ void st4bf(bf16_t* p, f32x4 v) { u32x2 o; o.x = pk2(v[0], v[1]); o.y = pk2(v[2], v[3]); *(u32x2*)p = o; }
__device__ __forceinline__ void seq_info(int row, bool& hasp, bool& hasn) {
    if (row < NLAT) { const int t = row & (TT - 1); hasp = t > 0; hasn = t < TT - 1; }
    else { const int t = (row - NLAT) & (CTXL - 1); hasp = t > 0; hasn = t < CTXL - 1; }
}
struct Ef1Row { u32x2 bg, ua, ub, m[11]; };
__device__ __forceinline__ f32x4 bf4(u32x2 u) { return (f32x4){bflo(u.x), bfhi(u.x), bflo(u.y), bfhi(u.y)}; }
__device__ __forceinline__ void ef1_load(Ef1Row& R, const bf16_t* P, int row, int lane) {
    row = row < 0 ? 0 : row > MROWS - 1 ? MROWS - 1 : row;
    const bf16_t* p = P + (size_t)row * P_LD + 4 * lane;
    R.bg = *(const u32x2*)p; R.ua = *(const u32x2*)(p + 256); R.ub = *(const u32x2*)(p + 512);
#pragma unroll
    for (int it = 0; it < 11; ++it) R.m[it] = *(const u32x2*)(p + 768 + it * 256);
}
__device__ __forceinline__ void phase_ef1(const Ctx& C, const Args& A, int l) {
    const int i2 = l >> 1; unsigned char* ws = A.ws;
    const bf16_t* P = (const bf16_t*)(ws + WS_P); bf16_t* A2 = (bf16_t*)(ws + WS_A2); unsigned char* SCN = ws + WS_SCN; bf16_t* LIN = (bf16_t*)(ws + WS_LIN);
    const float* cw = A.in[I_CONVW] + (size_t)i2 * 3 * 256; const float* mu = A.in[I_MU] + (size_t)i2 * RWKV_COLS; const float* kxi = A.in[I_KXI] + (size_t)i2 * 768;
    const int j4 = 4 * C.lane;
    const f32x4 w0 = *(const f32x4*)(cw + j4), w1 = *(const f32x4*)(cw + 256 + j4), w2 = *(const f32x4*)(cw + 512 + j4);
    f32x4 mur[11], kxr[3];
#pragma unroll
    for (int it = 0; it < 11; ++it) mur[it] = (it * 256 + j4 < RWKV_COLS) ? *(const f32x4*)(mu + it * 256 + j4) : (f32x4){0.f, 0.f, 0.f, 0.f};
#pragma unroll
    for (int it = 0; it < 3; ++it) kxr[it] = *(const f32x4*)(kxi + it * 256 + j4);
    const int row0 = (int)(((long)C.gw * MROWS) / C.NGW), row1 = (int)(((long)(C.gw + 1) * MROWS) / C.NGW);
    Ef1Row Ra, Rb, Rc, Rd;
    ef1_load(Ra, P, row0 - 1, C.lane); ef1_load(Rb, P, row0, C.lane); ef1_load(Rc, P, row0 + 1, C.lane);
    for (int row = row0; row < row1; ++row) {
        ef1_load(Rd, P, row + 2, C.lane);
        bool hasp, hasn; seq_info(row, hasp, hasn);
        const float fp = hasp ? 1.f : 0.f, fn = hasn ? 1.f : 0.f;
        {
            const f32x4 bg = bf4(Rb.bg), u0 = bf4(Rb.ua) * bf4(Rb.ub), um = bf4(Ra.ua) * bf4(Ra.ub) * fp, up = bf4(Rc.ua) * bf4(Rc.ub) * fn;
            st4bf(A2 + (size_t)row * DM + j4, bg * (w0 * um + w1 * u0 + w2 * up));
        }
#pragma unroll
        for (int it = 0; it < 11; ++it) {
            const int c = it * 256 + j4;
            if (c < RWKV_COLS) {
                const f32x4 x0 = bf4(Rb.m[it]), xm = bf4(Ra.m[it]) * fp, xp = bf4(Rc.m[it]) * fn, m4 = mur[it];
                const f32x4 ps = x0 + m4 * ((xm + xp) * 0.5f - x0);
                if (it < 3) { const int head = c >> 6, kx = c & 63; st4bf_(SCN + (size_t)(row * 12 + head) * SC_REC + SC_R + kx * 2, ps); }
                else if (it < 6) { const int c1 = c - 768, head = c1 >> 6, kx = c1 & 63; const f32x4 kv = ps * kxr[it < 6 ? (it >= 3 ? it - 3 : 0) : 0];
                    const float ss = sum16(kv[0] * kv[0] + kv[1] * kv[1] + kv[2] * kv[2] + kv[3] * kv[3]); const float rn = rsqrtf(ss + 1e-12f);
                    unsigned char* base = SCN + (size_t)(row * 12 + head) * SC_REC + kx * 2;
                    st4bf_(base + SC_KK, kv * rn); st4bf_(base + SC_KR, ps); st4bf_(base + SC_KR + 256, ps); }
                else if (it < 9) { const int c1 = c - 1536, head = c1 >> 6, kx = c1 & 63; st4bf_(SCN + (size_t)(row * 12 + head) * SC_REC + SC_V + kx * 2, ps); }
                else { const int c1 = c - 2304; f32x4 o;
                    if (c1 < 128) { o = (f32x4){tanh_fast(ps[0]), tanh_fast(ps[1]), tanh_fast(ps[2]), tanh_fast(ps[3])}; }
                    else if (c1 < 256) { o = ps; }
                    else { o = (f32x4){sigmoidf_(ps[0]), sigmoidf_(ps[1]), sigmoidf_(ps[2]), sigmoidf_(ps[3])}; }
                    st4bf(LIN + (size_t)row * LORA_K + c1, o); }
            }
        }
        Ra = Rb; Rb = Rc; Rc = Rd;
    }
}

__device__ __forceinline__ int scan_row(int i, int b, int d) {
    if (d == 0) return i < CTXL ? NLAT + b * CTXL + i : b * TT + (i - CTXL);
    return i < CTXL ? NLAT + b * CTXL + (CTXL - 1 - i) : b * TT + (TT - 1 - (i - CTXL));
}
__device__ __forceinline__ float red8(float v) {
    v += __uint_as_float((unsigned)__builtin_amdgcn_update_dpp(0, (int)__float_as_uint(v), 0xB1, 0xF, 0xF, true));
    v += __uint_as_float((unsigned)__builtin_amdgcn_update_dpp(0, (int)__float_as_uint(v), 0x4E, 0xF, 0xF, true));
    v += __uint_as_float((unsigned)__builtin_amdgcn_update_dpp(0, (int)__float_as_uint(v), 0x141, 0xF, 0xF, true));
    return v;
}
__device__ __forceinline__ float red16(float v) {
    v += __uint_as_float((unsigned)__builtin_amdgcn_update_dpp(0, (int)__float_as_uint(v), 0xB1, 0xF, 0xF, true));
    v += __uint_as_float((unsigned)__builtin_amdgcn_update_dpp(0, (int)__float_as_uint(v), 0x4E, 0xF, 0xF, true));
    v += __uint_as_float((unsigned)__builtin_amdgcn_update_dpp(0, (int)__float_as_uint(v), 0x141, 0xF, 0xF, true));
    v += __uint_as_float((unsigned)__builtin_amdgcn_update_dpp(0, (int)__float_as_uint(v), 0x140, 0xF, 0xF, true));
    return v;
}
__device__ __forceinline__ void phase_scan(const Ctx& C, const Args& A) {
    for (int u = blockIdx.x; u < 192; u += C.G) {
    const int half = u & 1, d = (u >> 1) & 1, h = (u >> 2) % 12, b = u / 48;
    const unsigned char* SCN = A.ws + WS_SCN; float* Y = (float*)(A.ws + WS_Y) + (size_t)d * MROWS * 768;
    LAS float* buf = (LAS float*)C.lds; LAS float* ybuf = buf + 2 * 32 * 352;
    constexpr int NCH = LKEYS / 32;
    u32x4 st[4];
    int ps_[4], psrc[4], pdst[4]; bool pf32[4];
#pragma unroll
    for (int j = 0; j < 4; ++j) { const int p = C.tid + NTHR * j; const int s = p / 52, q = p % 52; ps_[j] = s;
        if (q < 16) { psrc[j] = SC_W + 256 * d + q * 16; pdst[j] = s * 352 + q * 4; pf32[j] = true; }
        else if (q < 48) { const int vec = (q - 16) >> 3, part = (q - 16) & 7; const int so = vec == 0 ? SC_KK : vec == 1 ? SC_B + 256 * d : vec == 2 ? SC_KR + 256 * d : SC_R;
            psrc[j] = so + part * 16; pdst[j] = s * 352 + 64 * (vec + 1) + part * 8; pf32[j] = false; }
        else { const int part = q - 48; psrc[j] = SC_V + half * 64 + part * 16; pdst[j] = s * 352 + 320 + part * 8; pf32[j] = false; } }
    const int sgn = d ? -1 : 1;
    const unsigned char* SCNh = SCN + (size_t)h * SC_REC;
#define SCAN_ROW0(c) (((c) * 32 < CTXL) ? (NLAT + b * CTXL + (d ? CTXL - 1 - (c) * 32 : (c) * 32)) : (b * TT + (d ? TT - 1 - ((c) * 32 - CTXL) : (c) * 32 - CTXL)))
#define SCAN_LOADG(c) do { const int row0_ = SCAN_ROW0(c); _Pragma("unroll") for (int j = 0; j < 4; ++j) if (j < 3 || C.tid < 1664 - 3 * NTHR) { \
        st[j] = *(const u32x4*)(SCNh + (size_t)(row0_ + sgn * ps_[j]) * SC_ROW + psrc[j]); } } while (0)
#define SCAN_STORE(bi) do { _Pragma("unroll") for (int j = 0; j < 4; ++j) if (j < 3 || C.tid < 1664 - 3 * NTHR) { LAS float* dp = buf + (bi) * (32 * 352) + pdst[j]; \
        if (pf32[j]) *(LAS u32x4*)dp = st[j]; \
        else { *(LAS f32x4*)dp = (f32x4){bflo(st[j].x), bfhi(st[j].x), bflo(st[j].y), bfhi(st[j].y)}; *(LAS f32x4*)(dp + 4) = (f32x4){bflo(st[j].z), bfhi(st[j].z), bflo(st[j].w), bfhi(st[j].w)}; } } } while (0)
    SCAN_LOADG(0); SCAN_STORE(0); __syncthreads();
    f32x2 Sa = {0.f, 0.f}, Sb = {0.f, 0.f};
    const int rl = C.lane >> 4, ks = C.lane & 15;
    float ycol = 0.f;
#define SC_LD(R, s) do { const LAS float* bp_ = cur + (s) * 352 + ks * 4; \
        R##w = *(const LAS f32x4*)(bp_); R##k = *(const LAS f32x4*)(bp_ + 64); R##b = *(const LAS f32x4*)(bp_ + 128); R##q = *(const LAS f32x4*)(bp_ + 192); R##r = *(const LAS f32x4*)(bp_ + 256); \
        R##vv = cur[(s) * 352 + 320 + C.wave * 4 + rl]; } while (0)
#define SC_LO(v) ((f32x2){v[0], v[1]})
#define SC_HI(v) ((f32x2){v[2], v[3]})
#define SC_DPP(x, ctrl) __uint_as_float((unsigned)__builtin_amdgcn_update_dpp(0, (int)__float_as_uint(x), ctrl, 0xF, 0xF, true))
#define SC_STEP(R, P, s) do { \
        f32x2 pa = __builtin_elementwise_fma(Sb, SC_HI(R##k), Sa * SC_LO(R##k)), py = __builtin_elementwise_fma(Sb, SC_HI(P##r), Sa * SC_LO(P##r)); \
        float a_ = pa.x + pa.y, y_ = py.x + py.y; \
        a_ += SC_DPP(a_, 0xB1); y_ += SC_DPP(y_, 0xB1); a_ += SC_DPP(a_, 0x4E); y_ += SC_DPP(y_, 0x4E); \
        a_ += SC_DPP(a_, 0x141); y_ += SC_DPP(y_, 0x141); a_ += SC_DPP(a_, 0x140); y_ += SC_DPP(y_, 0x140); \
        ycol = (ks == ((s) & 15)) ? y_ : ycol; \
        const f32x2 na = {-a_, -a_}, vv2 = {R##vv, R##vv}; \
        Sa = __builtin_elementwise_fma(Sa, SC_LO(R##w), __builtin_elementwise_fma(na, SC_LO(R##b), vv2 * SC_LO(R##q))); \
        Sb = __builtin_elementwise_fma(Sb, SC_HI(R##w), __builtin_elementwise_fma(na, SC_HI(R##b), vv2 * SC_HI(R##q))); } while (0)
    f32x4 Aw, Ak, Ab, Aq, Ar, Bw, Bk, Bb, Bq, Br, Cw, Ck, Cb, Cq, Cr, Dw, Dk, Db, Dq, Dr; float Avv, Bvv, Cvv, Dvv;
    Dr = (f32x4){0.f, 0.f, 0.f, 0.f};
    for (int c = 0; c < NCH; ++c) {
        if (c + 1 < NCH) SCAN_LOADG(c + 1);
        {
            const LAS float* cur = buf + (c & 1) * (32 * 352);
            LAS float* yb = ybuf + (c & 1) * 1024 + C.wave * 4 + rl + ks * 32;
            SC_LD(A, 0); SC_LD(B, 1);
#pragma unroll 1
            for (int s = 0; s < 32; s += 4) {
                SC_LD(C, s + 2); __builtin_amdgcn_sched_barrier(0); SC_STEP(A, D, s); __builtin_amdgcn_sched_barrier(0);
                SC_LD(D, s + 3); __builtin_amdgcn_sched_barrier(0); SC_STEP(B, A, s + 1); __builtin_amdgcn_sched_barrier(0);
                SC_LD(A, s + 4); __builtin_amdgcn_sched_barrier(0); SC_STEP(C, B, s + 2); __builtin_amdgcn_sched_barrier(0);
                SC_LD(B, s + 5); __builtin_amdgcn_sched_barrier(0); SC_STEP(D, C, s + 3); __builtin_amdgcn_sched_barrier(0);
                if ((s & 15) == 12) yb[(s & 16) * 32] = ycol;
            }
        }
        if (c + 1 < NCH) SCAN_STORE((c + 1) & 1);
        __syncthreads();
        { const int row0_ = SCAN_ROW0(c);
#pragma unroll
          for (int i = 0; i < 2; ++i) { const int e = C.tid + NTHR * i, s = e >> 5, r = e & 31;
            const int row = (s > 0) ? row0_ + sgn * (s - 1) : scan_row(c * 32 - 1, b, d);
            if (s > 0 || c > 0) Y[(size_t)row * 768 + h * 64 + half * 32 + r] = ybuf[(c & 1) * 1024 + e]; } }
    }
    {
        f32x2 py = __builtin_elementwise_fma(Sb, SC_HI(Dr), Sa * SC_LO(Dr)); float y_ = py.x + py.y;
        y_ += SC_DPP(y_, 0xB1); y_ += SC_DPP(y_, 0x4E); y_ += SC_DPP(y_, 0x141); y_ += SC_DPP(y_, 0x140);
        if (ks == 0) Y[(size_t)scan_row(LKEYS - 1, b, d) * 768 + h * 64 + half * 32 + C.wave * 4 + rl] = y_;
    }
    __syncthreads();
    }
#undef SCAN_LOADG
#undef SCAN_STORE
#undef SCAN_ROW0
#undef SC_LD
#undef SC_STEP
#undef SC_LO
#undef SC_HI
#undef SC_DPP
}

constexpr int CSP = 72;
constexpr int CS_MAT = 64 * CSP * 2;
constexpr int CS_WT = 0, CS_KB = CS_MAT, CS_BB = 2 * CS_MAT, CS_RT = 3 * CS_MAT, CS_BHT = 4 * CS_MAT, CS_KHT = 5 * CS_MAT, CS_VMT = 6 * CS_MAT;
constexpr int CS_M2F = 7 * CS_MAT;
constexpr int CS_M1T = CS_M2F + 16384;
constexpr int CS_N2 = CS_M1T + CS_MAT;
constexpr int CS_GT = CS_N2 + CS_MAT;
constexpr int CS_Z = CS_M2F, CS_U = CS_M2F + CS_MAT;
constexpr int CS_GL = CS_GT + 2 * CS_MAT;
static_assert(CS_GL + 256 <= LDS_MISC, "chunked-scan LDS map");
template <bool SWZB = false>
__device__ __forceinline__ void cs_mma(f32x16& acc, const LAS unsigned char* Am, const LAS unsigned char* Bm, int ti, int tj, int r32, int hi) {
    const LAS unsigned char* ap = Am + (ti * 32 + r32) * (CSP * 2) + hi * 16; const int brow = tj * 32 + r32; const LAS unsigned char* bp = Bm + brow * (CSP * 2);
    const int sw = SWZB ? ((brow >> 3) & 7) : 0;
#pragma unroll
    for (int ks = 0; ks < 4; ++ks) acc = __builtin_amdgcn_mfma_f32_32x32x16_bf16(*(const LAS bf16x8*)(ap + ks * 32), *(const LAS bf16x8*)(bp + (((ks * 2 + hi) ^ sw) * 16)), acc, 0, 0, 0);
}
__device__ __forceinline__ void cs_store_t(LAS unsigned char* Om, const f32x16& acc, int ti, int tj, int r32, int hi) {
    LAS unsigned char* op = Om + (tj * 32 + r32) * (CSP * 2) + (ti * 32 + 4 * hi) * 2;
#pragma unroll
    for (int g = 0; g < 4; ++g) { u32x2 o; o.x = pk2(acc[4 * g], acc[4 * g + 1]); o.y = pk2(acc[4 * g + 2], acc[4 * g + 3]); *(LAS u32x2*)(op + g * 16) = o; }
}
#define CS_BAR() asm volatile("s_waitcnt lgkmcnt(0)\n\ts_barrier" ::: "memory")
__device__ __forceinline__ void phase_csa(const Ctx& C, const Args& A) {
    const unsigned char* SCN = A.ws + WS_SCN; unsigned char* CHK = A.ws + WS_CHK;
    LAS unsigned char* L = C.lds;
    const int r32 = C.lane & 31, hi = C.lane >> 5;
    float lwv[8]; u32x4 ukk, ub, ukr, ur, uv;
#define CSA_GEOM(cu_) const int unit = (cu_) / CS_NCH, ch = (cu_) % CS_NCH; const int d = unit & 1, h = (unit >> 1) % 12, b = unit / 24; \
        const int step0 = ch * CS_L; const int sgn = d ? -1 : 1; \
        const int row0 = (step0 < CTXL) ? (NLAT + b * CTXL + (d ? CTXL - 1 - step0 : step0)) : (b * TT + (d ? TT - 1 - (step0 - CTXL) : step0 - CTXL)); \
        const unsigned char* rec0 = SCN + (size_t)row0 * SC_ROW + (size_t)h * SC_REC;
#define CSA_LOAD(cu_) do { CSA_GEOM(cu_); \
        { const int k = C.tid & 63, sg = C.tid >> 6; _Pragma("unroll") for (int j = 0; j < 8; ++j) lwv[j] = *(const float*)(rec0 + (long)sgn * (8 * sg + j) * SC_ROW + SC_W + 256 * d + k * 4); } \
        { const int t = C.tid >> 3, k0 = (C.tid & 7) * 8; const unsigned char* rp = rec0 + (long)sgn * t * SC_ROW; \
          ukk = *(const u32x4*)(rp + SC_KK + k0 * 2); ub = *(const u32x4*)(rp + SC_B + 256 * d + k0 * 2); ukr = *(const u32x4*)(rp + SC_KR + 256 * d + k0 * 2); ur = *(const u32x4*)(rp + SC_R + k0 * 2); uv = *(const u32x4*)(rp + SC_V + k0 * 2); } } while (0)
    if ((int)blockIdx.x < CS_UNITS * CS_NCH) CSA_LOAD((int)blockIdx.x);
    for (int cu = blockIdx.x; cu < CS_UNITS * CS_NCH; cu += C.G) {
        LAS float* csf = (LAS float*)(L + CS_M2F);
        LAS float* seg = (LAS float*)(L + CS_N2);
        { const int k = C.tid & 63, sg = C.tid >> 6;
#pragma unroll
          for (int j = 1; j < 8; ++j) lwv[j] += lwv[j - 1];
          seg[sg * 64 + k] = lwv[7];
          CS_BAR();
          float off = 0.f, tot = 0.f;
#pragma unroll
          for (int s2 = 0; s2 < 8; ++s2) { const float v = seg[s2 * 64 + k]; off += (s2 < sg) ? v : 0.f; tot += v; }
#pragma unroll
          for (int j = 0; j < 8; ++j) csf[(8 * sg + j) * 65 + k] = lwv[j] + off;
          if (sg == 7) ((LAS float*)(L + CS_GL))[k] = __expf(tot); }
        CS_BAR();
        { const int t = C.tid >> 3, k0 = (C.tid & 7) * 8;
          float wt[8], kb[8], bb[8], rt[8], bh[8], kh[8];
#pragma unroll
          for (int j = 0; j < 8; ++j) { const unsigned pkk = j < 2 ? ukk.x : j < 4 ? ukk.y : j < 6 ? ukk.z : ukk.w, pb = j < 2 ? ub.x : j < 4 ? ub.y : j < 6 ? ub.z : ub.w, pkr = j < 2 ? ukr.x : j < 4 ? ukr.y : j < 6 ? ukr.z : ukr.w, pr = j < 2 ? ur.x : j < 4 ? ur.y : j < 6 ? ur.z : ur.w;
              const float kkv = (j & 1) ? bfhi(pkk) : bflo(pkk), bv = (j & 1) ? bfhi(pb) : bflo(pb), krv = (j & 1) ? bfhi(pkr) : bflo(pkr), rv = (j & 1) ? bfhi(pr) : bflo(pr);
              const float cst = csf[t * 65 + k0 + j], csp = t > 0 ? csf[(t - 1) * 65 + k0 + j] : 0.f, csl = csf[63 * 65 + k0 + j];
              const float einv = __expf(-cst), el = __expf(csl - cst);
              wt[j] = kkv * __expf(csp); kb[j] = krv * einv; bb[j] = bv * einv; rt[j] = rv * __expf(cst); bh[j] = bv * el; kh[j] = krv * el; }
          u32x4 o;
          o.x = pk2(wt[0], wt[1]); o.y = pk2(wt[2], wt[3]); o.z = pk2(wt[4], wt[5]); o.w = pk2(wt[6], wt[7]); *(LAS u32x4*)(L + CS_WT + t * (CSP * 2) + k0 * 2) = o;
          o.x = pk2(kb[0], kb[1]); o.y = pk2(kb[2], kb[3]); o.z = pk2(kb[4], kb[5]); o.w = pk2(kb[6], kb[7]); *(LAS u32x4*)(L + CS_KB + t * (CSP * 2) + k0 * 2) = o;
          o.x = pk2(bb[0], bb[1]); o.y = pk2(bb[2], bb[3]); o.z = pk2(bb[4], bb[5]); o.w = pk2(bb[6], bb[7]); *(LAS u32x4*)(L + CS_BB + t * (CSP * 2) + k0 * 2) = o;
          o.x = pk2(rt[0], rt[1]); o.y = pk2(rt[2], rt[3]); o.z = pk2(rt[4], rt[5]); o.w = pk2(rt[6], rt[7]); *(LAS u32x4*)(L + CS_RT + t * (CSP * 2) + k0 * 2) = o;
#pragma unroll
          for (int j = 0; j < 8; ++j) { const int to = ((((t >> 3) ^ ((k0 >> 3) & 7)) * 8) + (t & 7)) * 2;
              *(LAS bf16_t*)(L + CS_BHT + (k0 + j) * (CSP * 2) + to) = (bf16_t)f2bf(bh[j]); *(LAS bf16_t*)(L + CS_KHT + (k0 + j) * (CSP * 2) + to) = (bf16_t)f2bf(kh[j]);
              const unsigned pv = j < 2 ? uv.x : j < 4 ? uv.y : j < 6 ? uv.z : uv.w; *(LAS bf16_t*)(L + CS_VMT + (k0 + j) * (CSP * 2) + to) = (bf16_t)((j & 1) ? (pv >> 16) : (pv & 0xffffu)); } }
        if (cu + C.G < CS_UNITS * CS_NCH) CSA_LOAD(cu + C.G);
        CS_BAR();
        for (int job = C.wave; job < 12; job += NWAVES) { const int p = job >> 2, ti = (job >> 1) & 1, tj = job & 1;
            f32x16 acc;
#pragma unroll
            for (int i = 0; i < 16; ++i) acc[i] = 0.f;
            if (p == 0) { cs_mma(acc, L + CS_WT, L + CS_BB, ti, tj, r32, hi);
                const int i = tj * 32 + r32; LAS float* mp = (LAS float*)(L + CS_M2F) + i * 64;
#pragma unroll
                for (int reg = 0; reg < 16; ++reg) { const int t = ti * 32 + crow(reg, hi); mp[(t & 3) * 16 + (t >> 2)] = (i < t) ? acc[reg] : 0.f; } }
            else if (p == 1) { cs_mma(acc, L + CS_WT, L + CS_KB, ti, tj, r32, hi);
                const int i = tj * 32 + r32;
#pragma unroll
                for (int reg = 0; reg < 16; ++reg) { const int t = ti * 32 + crow(reg, hi); acc[reg] = (i < t) ? acc[reg] : 0.f; }
                cs_store_t(L + CS_M1T, acc, ti, tj, r32, hi); }
            else { cs_mma(acc, L + CS_BB, L + CS_RT, ti, tj, r32, hi);
                const int t = tj * 32 + r32;
#pragma unroll
                for (int reg = 0; reg < 16; ++reg) { const int i = ti * 32 + crow(reg, hi); acc[reg] = (i <= t) ? acc[reg] : 0.f; }
                cs_store_t(L + CS_N2, acc, ti, tj, r32, hi); } }
        CS_BAR();
        { const int c = C.tid >> 2, q = C.tid & 3; f32x2 acc2[8];
          { const LAS unsigned char* rcol = (c < 64) ? (L + CS_WT + c * 2) : (L + CS_M1T + (c - 64) * (CSP * 2)); const int rstride = (c < 64) ? CSP * 2 : 2;
#pragma unroll
            for (int j = 0; j < 16; ++j) acc2[j >> 1][j & 1] = bf2f(*(const LAS bf16_t*)(rcol + (4 * j + q) * rstride)); }
          const LAS float* m2c = (const LAS float*)(L + CS_M2F) + q * 16;
#pragma clang loop unroll(full)
          for (int i = 0; i < 64; ++i) {
              const float mine = -acc2[i >> 3][(i >> 2) & 1];
              float gi;
              switch (i & 3) { case 0: gi = __uint_as_float((unsigned)__builtin_amdgcn_update_dpp(0, (int)__float_as_uint(mine), 0x00, 0xF, 0xF, true)); break;
                               case 1: gi = __uint_as_float((unsigned)__builtin_amdgcn_update_dpp(0, (int)__float_as_uint(mine), 0x55, 0xF, 0xF, true)); break;
                               case 2: gi = __uint_as_float((unsigned)__builtin_amdgcn_update_dpp(0, (int)__float_as_uint(mine), 0xAA, 0xF, 0xF, true)); break;
                               default: gi = __uint_as_float((unsigned)__builtin_amdgcn_update_dpp(0, (int)__float_as_uint(mine), 0xFF, 0xF, 0xF, true)); break; }
              const f32x2 g2 = {gi, gi};
#pragma unroll
              for (int j4 = (i >> 4); j4 < 4; ++j4) { const f32x4 m = *(const LAS f32x4*)(m2c + i * 64 + j4 * 4);
#pragma unroll
                  for (int h = 0; h < 2; ++h) { const int p = 2 * j4 + h;
                      if (2 * p >= (i >> 2)) acc2[p] += (f32x2){m[2 * h], m[2 * h + 1]} * g2;
                      else if (2 * p + 1 >= (i >> 2)) acc2[p][1] += m[2 * h + 1] * gi; } }
          }
#pragma unroll
          for (int j = 0; j < 16; ++j) *(LAS bf16_t*)(L + CS_GT + c * (CSP * 2) + (4 * j + q) * 2) = (bf16_t)f2bf(-acc2[j >> 1][j & 1]); }
        CS_BAR();
        unsigned char* outp = CHK + (size_t)cu * 32768;
        for (int job = C.wave; job < 16; job += NWAVES) { const int p = job >> 2, ti = (job >> 1) & 1, tj = job & 1;
            f32x16 acc;
            if (p == 0) {
                const LAS unsigned char* rp = L + CS_RT + (tj * 32 + r32) * (CSP * 2) + (ti * 32 + 4 * hi) * 2;
#pragma unroll
                for (int g = 0; g < 4; ++g) { const u32x2 u = *(const LAS u32x2*)(rp + g * 16); acc[4 * g] = bflo(u.x); acc[4 * g + 1] = bfhi(u.x); acc[4 * g + 2] = bflo(u.y); acc[4 * g + 3] = bfhi(u.y); }
                cs_mma(acc, L + CS_GT, L + CS_N2, ti, tj, r32, hi);
#pragma unroll
                for (int g = 0; g < 4; ++g) { u32x2 o; o.x = pk2(acc[4 * g], acc[4 * g + 1]); o.y = pk2(acc[4 * g + 2], acc[4 * g + 3]);
                    *(u32x2*)(outp + 8192 + (((tj * 4 + 2 * ti + (g >> 1)) * 64 + (g & 1) * 32 + r32) * 16) + hi * 8) = o; } }
            else if (p == 1) {
#pragma unroll
                for (int i = 0; i < 16; ++i) acc[i] = 0.f;
                cs_mma(acc, L + CS_KB, L + CS_RT, ti, tj, r32, hi);
                const int t = tj * 32 + r32;
#pragma unroll
                for (int reg = 0; reg < 16; ++reg) { const int i = ti * 32 + crow(reg, hi); acc[reg] = (i <= t) ? acc[reg] : 0.f; }
                cs_mma(acc, L + CS_GT + 64 * (CSP * 2), L + CS_N2, ti, tj, r32, hi);
                cs_store_t(L + CS_Z, acc, ti, tj, r32, hi); }
            else if (p == 2) {
#pragma unroll
                for (int i = 0; i < 16; ++i) acc[i] = 0.f;
                cs_mma<true>(acc, L + CS_GT, L + CS_BHT, ti, tj, r32, hi);
                const int k = tj * 32 + r32; const float gl = ((const LAS float*)(L + CS_GL))[k];
#pragma unroll
                for (int reg = 0; reg < 16; ++reg) { const int cc = ti * 32 + crow(reg, hi); acc[reg] += (cc == k) ? gl : 0.f; }
#pragma unroll
                for (int g = 0; g < 4; ++g) { u32x2 o; o.x = pk2(acc[4 * g], acc[4 * g + 1]); o.y = pk2(acc[4 * g + 2], acc[4 * g + 3]);
                    *(u32x2*)(outp + (((tj * 4 + 2 * ti + (g >> 1)) * 64 + (g & 1) * 32 + r32) * 16) + hi * 8) = o; } }
            else {
                const int krow = tj * 32 + r32; const LAS unsigned char* kp = L + CS_KHT + krow * (CSP * 2) + hi * 8;
#pragma unroll
                for (int g = 0; g < 4; ++g) { const u32x2 u = *(const LAS u32x2*)(kp + (((ti * 4 + g) ^ ((krow >> 3) & 7)) * 16)); acc[4 * g] = bflo(u.x); acc[4 * g + 1] = bfhi(u.x); acc[4 * g + 2] = bflo(u.y); acc[4 * g + 3] = bfhi(u.y); }
                cs_mma<true>(acc, L + CS_GT + 64 * (CSP * 2), L + CS_BHT, ti, tj, r32, hi);
                cs_store_t(L + CS_U, acc, ti, tj, r32, hi); } }
        CS_BAR();
        { const int p = C.wave >> 2, ti = (C.wave >> 1) & 1, tj = C.wave & 1;
          f32x16 acc;
#pragma unroll
          for (int i = 0; i < 16; ++i) acc[i] = 0.f;
          cs_mma<true>(acc, L + (p ? CS_U : CS_Z), L + CS_VMT, ti, tj, r32, hi);
          unsigned char* op = outp + (p ? 16384 : 24576) + ((ti * 2 + tj) * 64 + C.lane) * 32;
          u32x4 o0, o1; o0.x = pk2(acc[0], acc[1]); o0.y = pk2(acc[2], acc[3]); o0.z = pk2(acc[4], acc[5]); o0.w = pk2(acc[6], acc[7]);
          o1.x = pk2(acc[8], acc[9]); o1.y = pk2(acc[10], acc[11]); o1.z = pk2(acc[12], acc[13]); o1.w = pk2(acc[14], acc[15]);
          *(u32x4*)op = o0; *(u32x4*)(op + 16) = o1; }
        CS_BAR();
    }
}
__device__ __forceinline__ void phase_csb(const Ctx& C, const Args& A, int l) {
    if ((int)blockIdx.x >= CS_UNITS) { const int gwf = ((int)blockIdx.x - CS_UNITS) * NWAVES + C.wave, ngwf = (C.G - CS_UNITS) * NWAVES;
        conv_items(C, A, l + 1, gwf, ngwf, true, false, false); conv_items(C, A, l + 1, gwf, ngwf, false, false, true, XW_TK_HI); return; }
    const unsigned char* CHK = A.ws + WS_CHK;
    LAS unsigned char* L = C.lds;
    const int r32 = C.lane & 31, hi = C.lane >> 5;
    const bool isS = C.wave < 4; const int ti = (C.wave >> 1) & 1, tj = C.wave & 1;
    for (int unit = blockIdx.x; unit < CS_UNITS; unit += C.G) {
        const int d = unit & 1, h = (unit >> 1) % 12, b = unit / 24;
        float* Y = (float*)(A.ws + WS_Y) + (size_t)d * MROWS * 768;
        for (int i = C.tid; i < 2 * CS_MAT / 4; i += NTHR) ((LAS unsigned*)L)[i] = 0u;
        CS_BAR();
        bf16x8 afA[4], afB[4], afC[4]; u32x4 cA0, cA1, cB0, cB1, cC0, cC1;
#define CSB_LOAD(A4, C0, C1, ch_) do { const unsigned char* op_ = CHK + ((size_t)unit * CS_NCH + (ch_)) * 32768; \
            const unsigned char* am_ = op_ + (isS ? 0 : 8192) + (ti * 4 * 64 + C.lane) * 16;     \
            _Pragma("unroll") for (int ks = 0; ks < 4; ++ks) A4[ks] = *(const bf16x8*)(am_ + ks * 1024); \
            const unsigned char* cp_ = op_ + (isS ? 16384 : 24576) + ((ti * 2 + tj) * 64 + C.lane) * 32; C0 = *(const u32x4*)cp_; C1 = *(const u32x4*)(cp_ + 16); } while (0)
#define CSB_STEP(A4, C0, C1, ch_) do { \
            const LAS unsigned char* Sb = L + ((ch_) & 1) * CS_MAT; LAS unsigned char* Sn = L + (((ch_) + 1) & 1) * CS_MAT; \
            f32x16 acc; \
            acc[0] = bflo(C0.x); acc[1] = bfhi(C0.x); acc[2] = bflo(C0.y); acc[3] = bfhi(C0.y); acc[4] = bflo(C0.z); acc[5] = bfhi(C0.z); acc[6] = bflo(C0.w); acc[7] = bfhi(C0.w); \
            acc[8] = bflo(C1.x); acc[9] = bfhi(C1.x); acc[10] = bflo(C1.y); acc[11] = bfhi(C1.y); acc[12] = bflo(C1.z); acc[13] = bfhi(C1.z); acc[14] = bflo(C1.w); acc[15] = bfhi(C1.w); \
            const LAS unsigned char* bp = Sb + (tj * 32 + r32) * (CSP * 2) + hi * 16; \
            _Pragma("unroll") for (int ks = 0; ks < 4; ++ks) acc = __builtin_amdgcn_mfma_f32_32x32x16_bf16(A4[ks], *(const LAS bf16x8*)(bp + ks * 32), acc, 0, 0, 0); \
            if (isS) { cs_store_t(Sn, acc, ti, tj, r32, hi); }     \
            else {     \
                const int step0 = (ch_) * CS_L; const int sgn = d ? -1 : 1; \
                const int row0 = (step0 < CTXL) ? (NLAT + b * CTXL + (d ? CTXL - 1 - step0 : step0)) : (b * TT + (d ? TT - 1 - (step0 - CTXL) : step0 - CTXL)); \
                float* yp = Y + (size_t)(row0 + sgn * (ti * 32 + 4 * hi)) * 768 + h * 64 + tj * 32 + r32; const long ys = (long)sgn * 768; \
                _Pragma("unroll") for (int reg = 0; reg < 16; ++reg) yp[ys * ((reg & 3) + 8 * (reg >> 2))] = acc[reg]; } \
            CS_BAR(); } while (0)
        CSB_LOAD(afA, cA0, cA1, 0); CSB_LOAD(afB, cB0, cB1, 1);
        static_assert(CS_NCH % 3 == 0, "chunk loop is unrolled by three");
        for (int ch = 0; ch < CS_NCH; ch += 3) {
            if (ch == 0) CSB_LOAD(afC, cC0, cC1, 2);
            CSB_STEP(afA, cA0, cA1, ch);     if (ch + 3 < CS_NCH) CSB_LOAD(afA, cA0, cA1, ch + 3);
            CSB_STEP(afB, cB0, cB1, ch + 1); if (ch + 4 < CS_NCH) CSB_LOAD(afB, cB0, cB1, ch + 4);
            CSB_STEP(afC, cC0, cC1, ch + 2); if (ch + 5 < CS_NCH) CSB_LOAD(afC, cC0, cC1, ch + 5);
        }
        CS_BAR();
    }
#undef CSB_LOAD
#undef CSB_STEP
}

#undef CS_BAR
struct Ef2Row { f32x4 y0[3], y1[3]; u32x2 r[3], v[3], k0[3], k1[3], g[3]; };
__device__ __forceinline__ void ef2_load(Ef2Row& R, const float* Y0, const float* Y1, const unsigned char* SCN, const bf16_t* G, int row, int lane) {
#pragma unroll
    for (int it = 0; it < 3; ++it) { const int c = it * 256 + 4 * lane, head = c >> 6, kx = c & 63;
        R.y0[it] = *(const f32x4*)(Y0 + (size_t)row * 768 + c); R.y1[it] = *(const f32x4*)(Y1 + (size_t)row * 768 + c);
        const unsigned char* base = SCN + (size_t)(row * 12 + head) * SC_REC + kx * 2;
        R.r[it] = *(const u32x2*)(base + SC_R); R.v[it] = *(const u32x2*)(base + SC_V); R.k0[it] = *(const u32x2*)(base + SC_KR); R.k1[it] = *(const u32x2*)(base + SC_KR + 256);
        R.g[it] = *(const u32x2*)(G + (size_t)row * 768 + c); }
}
__device__ __forceinline__ void phase_ef2(const Ctx& C, const Args& A, int l) {
    const int i2 = l >> 1; unsigned char* ws = A.ws;
    const unsigned char* SCN = ws + WS_SCN; const float* Y0 = (const float*)(ws + WS_Y); const float* Y1 = Y0 + (size_t)MROWS * 768;
    const bf16_t* G = (const bf16_t*)(ws + WS_G); bf16_t* A2 = (bf16_t*)(ws + WS_A2);
    const float* rb = A.in[I_RBON] + (size_t)i2 * 768; const float* gg = A.in[I_GNG] + (size_t)i2 * 768; const float* gb = A.in[I_GNB] + (size_t)i2 * 768;
    f32x4 rbr[3], ggr[3], gbr[3];
#pragma unroll
    for (int it = 0; it < 3; ++it) { const int c = it * 256 + 4 * C.lane; rbr[it] = *(const f32x4*)(rb + c); ggr[it] = *(const f32x4*)(gg + c); gbr[it] = *(const f32x4*)(gb + c); }
    Ef2Row Rn;
    if (C.gw < MROWS) ef2_load(Rn, Y0, Y1, SCN, G, C.gw, C.lane);
    for (int row = C.gw; row < MROWS; row += C.NGW) {
        const Ef2Row R = Rn;
        { const int nr = row + C.NGW < MROWS ? row + C.NGW : row; ef2_load(Rn, Y0, Y1, SCN, G, nr, C.lane); }
#pragma unroll
        for (int it = 0; it < 3; ++it) {
            const int c = it * 256 + 4 * C.lane;
            const f32x4 y = R.y0[it] + R.y1[it];
            const float mean = sum16((y[0] + y[1]) + (y[2] + y[3])) * (1.f / 64.f);
            const f32x4 dd = y - mean;
            const float var = sum16((dd[0] * dd[0] + dd[1] * dd[1]) + (dd[2] * dd[2] + dd[3] * dd[3])) * (1.f / 64.f);
            const float rstd = rsqrtf(var + GN_EPS);
            const f32x4 r = bf4(R.r[it]), v = bf4(R.v[it]), k0 = bf4(R.k0[it]), k1 = bf4(R.k1[it]);
            const f32x4 t = r * (k0 + k1) * 0.5f * rbr[it];
            const float bs = sum16((t[0] + t[1]) + (t[2] + t[3]));
            const f32x4 yn = dd * rstd * ggr[it] + gbr[it];
            const f32x4 g = bf4(R.g[it]);
            st4bf(A2 + (size_t)row * DM + 256 + c, g * (yn + v * bs));
        }
    }
}

__device__ __forceinline__ void phase_of1(const Ctx& C, const Args& A, int l) {
    const int i2 = l >> 1; unsigned char* ws = A.ws;
    const bf16_t* P = (const bf16_t*)(ws + WS_P); bf16_t* A2 = (bf16_t*)(ws + WS_A2); bf16_t* VT = (bf16_t*)(ws + WS_VT);
    const float* lng = A.in[I_GLNG] + (size_t)i2 * 256; const float* lnb = A.in[I_GLNB] + (size_t)i2 * 256;
    const float* gws = A.in[I_GWS] + (size_t)i2 * 4 * 128 * 128; const float* gbs = A.in[I_GBS] + (size_t)i2 * 4 * 128;
    LAS bf16_t* vt = (LAS bf16_t*)C.lds;
    LAS bf16_t* uL = (LAS bf16_t*)C.lds;
    LAS bf16_t* vT = (LAS bf16_t*)(C.lds + 128 * 528);
    const int r32 = C.lane & 31, hi = C.lane >> 5;
    for (int it = blockIdx.x; it < 256 + 8 * 7; it += C.G) {
        const bool isctx = it >= 256; const int uc = isctx ? (it - 256) / 7 : 0, pc = isctx ? (it - 256) % 7 : 0; const int u = it;
        const int b = isctx ? (uc >> 1) : (u >> 6), pos0 = isctx ? (uc & 1) * 128 : (u & 63) * 128;
        const int row0 = isctx ? NLAT + b * CTXL + pos0 : b * TT + pos0, L0 = isctx ? pos0 : CTXL + pos0;
        const int hh0 = isctx ? pc : 0, hh1 = isctx ? (pc < 6 ? pc + 1 : 0) : 6; const bool doC = !isctx || pc == 6;
        u32x4 pv[4];
        if (hh0 < hh1) {
#pragma unroll
            for (int i = 0; i < 4; ++i) { const int piece = C.tid + NTHR * i, r = piece >> 4, part = piece & 15; pv[i] = *(const u32x4*)(P + (size_t)(row0 + r) * P_LD + 1536 + hh0 * 128 + part * 8); } }
        for (int hh = hh0; hh < hh1; ++hh) {
#pragma unroll
            for (int i = 0; i < 4; ++i) { const int piece = C.tid + NTHR * i, r = piece >> 4, part = piece & 15;
                *(LAS u32x4*)(vt + r * 136 + part * 8) = pv[i]; }
            __syncthreads();
            if (hh + 1 < hh1) {
#pragma unroll
                for (int i = 0; i < 4; ++i) { const int piece = C.tid + NTHR * i, r = piece >> 4, part = piece & 15; pv[i] = *(const u32x4*)(P + (size_t)(row0 + r) * P_LD + 1536 + (hh + 1) * 128 + part * 8); } }
#pragma unroll
            for (int i = 0; i < 4; ++i) { const int item = C.tid + NTHR * i, d = item >> 4, tg = item & 15; const LAS bf16_t* s = vt + (tg * 8) * 136 + d;
                u32x4 o; o.x = (unsigned)s[0] | ((unsigned)s[136] << 16); o.y = (unsigned)s[2 * 136] | ((unsigned)s[3 * 136] << 16);
                o.z = (unsigned)s[4 * 136] | ((unsigned)s[5 * 136] << 16); o.w = (unsigned)s[6 * 136] | ((unsigned)s[7 * 136] << 16);
                *(u32x4*)(VT + ((size_t)(b * 6 + hh) * 128 + d) * LKEYS + L0 + tg * 8) = o; }
            __syncthreads();
        }
        if (doC) {
        const f32x4 lngr = *(const f32x4*)(lng + 4 * C.lane), lnbr = *(const f32x4*)(lnb + 4 * C.lane);
        u32x2 nxu, nxr;
        { const bf16_t* pr = P + (size_t)(row0 + C.wave) * P_LD + 2304 + 4 * C.lane; nxu = *(const u32x2*)pr; nxr = *(const u32x2*)(pr + 256); }
        for (int r = C.wave; r < 128; r += NWAVES) {
            const int c4 = 4 * C.lane;
            const f32x4 ur = bf4(nxu), raw = bf4(nxr);
            if (r + NWAVES < 128) { const bf16_t* pr = P + (size_t)(row0 + r + NWAVES) * P_LD + 2304 + c4; nxu = *(const u32x2*)pr; nxr = *(const u32x2*)(pr + 256); }
            { const f32x4 gu = gelu4(ur); u32x2 o; o.x = pk2(gu[0], gu[1]); o.y = pk2(gu[2], gu[3]); *(LAS u32x2*)(uL + r * 264 + c4) = o; }
            const f32x4 gv = gelu4(raw);
            const float mean = wave_sum((gv[0] + gv[1]) + (gv[2] + gv[3])) * (1.f / 256.f); const f32x4 dd = gv - mean;
            const float var = wave_sum((dd[0] * dd[0] + dd[1] * dd[1]) + (dd[2] * dd[2] + dd[3] * dd[3])) * (1.f / 256.f); const float rstd = rsqrtf(var + LN_EPS);
            const f32x4 o = dd * rstd * lngr + lnbr;
#pragma unroll
            for (int k = 0; k < 4; ++k) vT[(c4 + k) * 136 + r] = (bf16_t)f2bf(o[k]);
        }
        __syncthreads();
        {
            const int g = C.wave >> 1, cblk = C.wave & 1, cc = g * 64 + cblk * 32 + r32;
            for (int pblk = 0; pblk < 4; ++pblk) {
                f32x16 acc;
#pragma unroll
                for (int i = 0; i < 16; ++i) acc[i] = 0.f;
                const float* wrow = gws + ((size_t)g * 128 + pblk * 32 + r32) * 128 + 8 * hi;
#pragma unroll
                for (int ks = 0; ks < 8; ++ks) { const f32x4 w0 = *(const f32x4*)(wrow + ks * 16), w1 = *(const f32x4*)(wrow + ks * 16 + 4);
                    u32x4 au; au.x = pk2(w0[0], w0[1]); au.y = pk2(w0[2], w0[3]); au.z = pk2(w1[0], w1[1]); au.w = pk2(w1[2], w1[3]);
                    const bf16x8 bf = *(const LAS bf16x8*)(vT + cc * 136 + ks * 16 + 8 * hi);
                    acc = __builtin_amdgcn_mfma_f32_32x32x16_bf16(__builtin_bit_cast(bf16x8, au), bf, acc, 0, 0, 0); }
#pragma unroll
                for (int reg = 0; reg < 16; ++reg) { const int p = pblk * 32 + crow(reg, hi);
                    const float uu = bf2f(uL[p * 264 + cc]); const float mixed = acc[reg] + gbs[g * 128 + p];
                    uL[p * 264 + cc] = (bf16_t)f2bf(uu * mixed); }
            }
        }
        __syncthreads();
#pragma unroll
        for (int i = 0; i < 8; ++i) { const int piece = C.tid + NTHR * i, r = piece >> 5, part = piece & 31;
            *(u32x4*)(A2 + (size_t)(row0 + r) * DM + 768 + part * 8) = *(const LAS u32x4*)(uL + r * 264 + part * 8); }
        __syncthreads();
        }
    }
}

__device__ __forceinline__ void phase_attn(const Ctx& C, const Args& A, int l) {
    const int i2 = l >> 1; unsigned char* ws = A.ws;
    const bf16_t* Q = (const bf16_t*)(ws + WS_Q); const bf16_t* KA = (const bf16_t*)(ws + WS_KA); const bf16_t* VT = (const bf16_t*)(ws + WS_VT); bf16_t* A2 = (bf16_t*)(ws + WS_A2);
    const float lam_init = 0.8f - 0.6f * expf(-0.3f * (float)l);
    float s1 = 0.f, s2 = 0.f;
    for (int j = 0; j < 64; ++j) { s1 += A.in[I_LQ1][i2 * 64 + j] * A.in[I_LK1][i2 * 64 + j]; s2 += A.in[I_LQ2][i2 * 64 + j] * A.in[I_LK2][i2 * 64 + j]; }
    const float lam = expf(s1) - expf(s2) + lam_init;
    const float* subg = A.in[I_SUBG] + (size_t)i2 * 128;
    const int r32 = C.lane & 31, hi = C.lane >> 5, map = C.wave >> 2, qw = C.wave & 3;
    LAS unsigned char* Kt = C.lds; LAS unsigned char* Vt = C.lds + 2 * 16384; LAS float* xch = (LAS float*)C.lds;
    const int NU = 1536 + (l == 1 ? 48 : 0);
    for (int n = C.vcu; n < NU; n += C.G) {
        int bh, qt; bool isctx = false;
        if (n < 1536) { const int round = n >> 8, slot = n & 255; bh = (slot >> 5) * 3 + (round >> 1); qt = (round & 1) * 32 + (slot & 31); }
        else { isctx = true; bh = (n - 1536) >> 1; qt = (n - 1536) & 1; }
        const int b = bh / 6, h = bh % 6;
        const int qrow0 = isctx ? NLAT + b * CTXL + qt * 128 : b * TT + qt * 128;
        const int NT = isctx ? CTXL / 64 : LKEYS / 64;
        const bf16_t* Kb = KA + (size_t)b * LKEYS * 768 + h * 128;
        const bf16_t* Vb = VT + (size_t)(b * 6 + h) * 128 * LKEYS;
        bf16x8 qf[4];
        { const bf16_t* qp = Q + (size_t)(qrow0 + qw * 32 + r32) * 768 + h * 128 + map * 64 + 8 * hi;
#pragma unroll
          for (int ks = 0; ks < 4; ++ks) qf[ks] = *(const bf16x8*)(qp + ks * 16); }
        f32x16 O[4];
#pragma unroll
        for (int d = 0; d < 4; ++d)
#pragma unroll
            for (int i = 0; i < 16; ++i) O[d][i] = 0.f;
        float m = 0.f, lsum = 0.f;
        unsigned ksrc[2], vsrc[2];
#pragma unroll
        for (int i = 0; i < 2; ++i) { const int row = 4 * (2 * C.wave + i) + (C.lane >> 4), x = row & 15, pi = x < 4 ? x : x < 8 ? x + 4 : x < 12 ? x - 4 : x;
            ksrc[i] = (unsigned)(((row & ~15) + pi) * 768 + (((C.lane & 15) ^ x) * 8));
            const int d = 8 * (2 * C.wave + i) + (C.lane >> 3); vsrc[i] = (unsigned)(d * LKEYS + (((C.lane & 7) ^ ((d >> 1) & 7)) * 8)); }
#define AT_DMA_K(tt, slot) do { _Pragma("unroll") for (int i = 0; i < 2; ++i) __builtin_amdgcn_global_load_lds((const unsigned*)(Kb + (size_t)(tt) * 64 * 768 + ksrc[i]), (LAS unsigned*)(Kt + (slot) * 16384 + (2 * C.wave + i) * 1024), 16, 0, 0); } while (0)
#define AT_DMA_V(tt, slot) do { _Pragma("unroll") for (int i = 0; i < 2; ++i) __builtin_amdgcn_global_load_lds((const unsigned*)(Vb + (size_t)(tt) * 64 + vsrc[i]), (LAS unsigned*)(Vt + (slot) * 16384 + (2 * C.wave + i) * 1024), 16, 0, 0); } while (0)
#define AT_BAR() asm volatile("s_waitcnt vmcnt(0) lgkmcnt(0)\n\ts_barrier" ::: "memory")
#define AT_SB() __builtin_amdgcn_sched_barrier(0)
        const int ksw = r32 & 15, vsw = (r32 >> 1) & 7;
#define AT_QK(P0, P1, ks_) do { const float nm_ = -m; _Pragma("unroll") for (int i = 0; i < 16; ++i) { P0[i] = nm_; P1[i] = nm_; } \
            const LAS unsigned char* kbp_ = Kt + (ks_) * 16384 + r32 * 256; \
            _Pragma("unroll") for (int ks = 0; ks < 4; ++ks) { const int co_ = ((map * 8 + ks * 2 + hi) ^ ksw) * 16; \
                P0 = __builtin_amdgcn_mfma_f32_32x32x16_bf16(*(const LAS bf16x8*)(kbp_ + co_), qf[ks], P0, 0, 0, 0); P1 = __builtin_amdgcn_mfma_f32_32x32x16_bf16(*(const LAS bf16x8*)(kbp_ + 32 * 256 + co_), qf[ks], P1, 0, 0, 0); } } while (0)
#define AT_LDV(dst, vs_, d) do { _Pragma("unroll") for (int kst = 0; kst < 4; ++kst) dst[kst] = *(const LAS u32x4*)(Vt + (vs_) * 16384 + ((d) * 32 + r32) * 128 + (((kst * 2 + hi) ^ vsw) * 16)); } while (0)
#define AT_PV(src, d) do { _Pragma("unroll") for (int kst = 0; kst < 4; ++kst) O[d] = __builtin_amdgcn_mfma_f32_32x32x16_bf16(__builtin_bit_cast(bf16x8, src[kst]), pb[kst], O[d], 0, 0, 0); } while (0)
#define AT_SOFTPV(P0, P1, N0, N1, first, hasn, vs_) do { \
            asm volatile("" : "+v"(P0), "+v"(P1));     \
            float mx = max3f(P0[0], P0[1], P1[0]), mx2 = max3f(P0[2], P0[3], P1[1]); mx = max3f(mx, P1[2], P1[3]); \
            _Pragma("unroll") for (int i = 4; i < 16; i += 4) { mx = max3f(mx, P0[i], P0[i + 1]); mx2 = max3f(mx2, P0[i + 2], P0[i + 3]); mx = max3f(mx, P1[i], P1[i + 1]); mx2 = max3f(mx2, P1[i + 2], P1[i + 3]); } \
            mx = fmaxf(mx, mx2); \
            { auto rr = __builtin_amdgcn_permlane32_swap(__float_as_uint(mx), __float_as_uint(mx), false, false); mx = fmaxf(__uint_as_float(rr[0]), __uint_as_float(rr[1])); } \
            if ((first) || __any(mx > 8.f)) { const float dl = (first) ? mx : fmaxf(mx, 0.f); const float sc = __builtin_amdgcn_exp2f(-dl); lsum *= sc; \
                _Pragma("unroll") for (int d = 0; d < 4; ++d) _Pragma("unroll") for (int i = 0; i < 16; ++i) O[d][i] *= sc; \
                _Pragma("unroll") for (int i = 0; i < 16; ++i) { P0[i] -= dl; P1[i] -= dl; } \
                if (hasn) { asm volatile("s_nop 15\n\ts_nop 7" : "+v"(N0), "+v"(N1)); _Pragma("unroll") for (int i = 0; i < 16; ++i) { N0[i] -= dl; N1[i] -= dl; } } \
                m += dl; } \
            float ps = 0.f, ps2 = 0.f; \
            _Pragma("unroll") for (int i = 0; i < 16; ++i) { P0[i] = __builtin_amdgcn_exp2f(P0[i]); P1[i] = __builtin_amdgcn_exp2f(P1[i]); ps += P0[i]; ps2 += P1[i]; } \
            lsum += ps + ps2; \
            bf16x8 pb[4]; \
            { u32x4 w; w.x = pk2(P0[0], P0[1]); w.y = pk2(P0[2], P0[3]); w.z = pk2(P0[4], P0[5]); w.w = pk2(P0[6], P0[7]); pb[0] = __builtin_bit_cast(bf16x8, w); \
              w.x = pk2(P0[8], P0[9]); w.y = pk2(P0[10], P0[11]); w.z = pk2(P0[12], P0[13]); w.w = pk2(P0[14], P0[15]); pb[1] = __builtin_bit_cast(bf16x8, w); \
              w.x = pk2(P1[0], P1[1]); w.y = pk2(P1[2], P1[3]); w.z = pk2(P1[4], P1[5]); w.w = pk2(P1[6], P1[7]); pb[2] = __builtin_bit_cast(bf16x8, w); \
              w.x = pk2(P1[8], P1[9]); w.y = pk2(P1[10], P1[11]); w.z = pk2(P1[12], P1[13]); w.w = pk2(P1[14], P1[15]); pb[3] = __builtin_bit_cast(bf16x8, w); } \
            u32x4 va[4]; \
            AT_LDV(va, vs_, 0); AT_SB(); AT_PV(va, 0); AT_SB(); AT_LDV(va, vs_, 1); AT_SB(); AT_PV(va, 1); AT_SB(); AT_LDV(va, vs_, 2); AT_SB(); AT_PV(va, 2); AT_SB(); AT_LDV(va, vs_, 3); AT_SB(); AT_PV(va, 3); AT_SB(); } while (0)
        f32x16 pA0, pA1, pB0, pB1;
        AT_DMA_K(0, 0); AT_DMA_V(0, 0); AT_DMA_K(1, 1);
        AT_BAR();
        AT_QK(pA0, pA1, 0);
        asm volatile("s_waitcnt lgkmcnt(0)\n\ts_barrier" ::: "memory");
        for (int t = 0; t < NT; t += 2) {
            if (t + 2 < NT) AT_DMA_K(t + 2, 0);
            AT_DMA_V(t + 1, 1);
            AT_SB(); AT_QK(pB0, pB1, 1); AT_SB();
            AT_SOFTPV(pA0, pA1, pB0, pB1, t == 0, true, 0);
            AT_BAR();
            if (t + 3 < NT) AT_DMA_K(t + 3, 1);
            if (t + 2 < NT) AT_DMA_V(t + 2, 0);
            AT_SB(); if (t + 2 < NT) { AT_QK(pA0, pA1, 0); } AT_SB();
            AT_SOFTPV(pB0, pB1, pA0, pA1, false, t + 2 < NT, 1);
            AT_BAR();
        }
#undef AT_DMA_K
#undef AT_DMA_V
#undef AT_BAR
#undef AT_SB
#undef AT_QK
#undef AT_LDV
#undef AT_PV
#undef AT_SOFTPV
        const float ltot = lsum + lx32(lsum, C.lane);
        const float invl = 1.f / ltot;
        if (map == 1) { const float f = lam * invl;
#pragma unroll
            for (int d = 0; d < 4; ++d)
#pragma unroll
                for (int i = 0; i < 16; ++i) xch[(qw * 64 + d * 16 + i) * 64 + C.lane] = O[d][i] * f; }
        __syncthreads();
        if (map == 0) { float ss = 0.f;
#pragma unroll
            for (int d = 0; d < 4; ++d)
#pragma unroll
                for (int i = 0; i < 16; ++i) { const float o = O[d][i] * invl - xch[(qw * 64 + d * 16 + i) * 64 + C.lane]; O[d][i] = o; ss += o * o; }
            ss += lx32(ss, C.lane);
            const float rn = rsqrtf(ss * (1.f / 128.f) + RMS_EPS) * (1.f - lam_init);
            bf16_t* orow = A2 + (size_t)(qrow0 + qw * 32 + r32) * DM + h * 128;
#pragma unroll
            for (int d = 0; d < 4; ++d)
#pragma unroll
                for (int gp = 0; gp < 4; gp += 2) {
                    unsigned pk_[2][2];
#pragma unroll
                    for (int q = 0; q < 2; ++q) { const int g4 = gp + q, dd = 32 * d + 8 * g4 + 4 * hi; const f32x4 sg = *(const f32x4*)(subg + dd);
                        pk_[q][0] = pk2(O[d][4 * g4] * rn * sg[0], O[d][4 * g4 + 1] * rn * sg[1]); pk_[q][1] = pk2(O[d][4 * g4 + 2] * rn * sg[2], O[d][4 * g4 + 3] * rn * sg[3]); }
                    const auto r0 = __builtin_amdgcn_permlane32_swap(pk_[0][0], pk_[1][0], false, false); const auto r1 = __builtin_amdgcn_permlane32_swap(pk_[0][1], pk_[1][1], false, false);
                    u32x4 o; o.x = r0[0]; o.y = r1[0]; o.z = r0[1]; o.w = r1[1];
                    *(u32x4*)(orow + 32 * d + 8 * (gp + hi)) = o; } }
        __syncthreads();
    }
}

__device__ __forceinline__ void phase_rt(const Ctx& C, const Args& A, int l) {
    unsigned char* ws = A.ws; float* X = (float*)(ws + WS_X); bf16_t* H = (bf16_t*)(ws + WS_H); float* AFF = (float*)(ws + WS_AFF); float* STAT = (float*)(ws + WS_P);
    const float* MOD = (const float*)(ws + WS_MOD) + (size_t)l * 5 * 6144;
    const float* lng = A.in[I_LNG] + (size_t)(l * 2 + 0) * DM; const float* lnb = A.in[I_LNB] + (size_t)(l * 2 + 0) * DM;
    LAS float* wrs = (LAS float*)C.lds;
    { const float* wr = A.in[I_WR] + (size_t)l * DM * 16; for (int i = C.tid; i < DM * 16; i += NTHR) wrs[(i & 15) * 1024 + (i >> 4)] = wr[i]; }
    __syncthreads();
    const int row0 = (int)(((long)C.gw * MROWS) / C.NGW), row1 = (int)(((long)(C.gw + 1) * MROWS) / C.NGW);
    f32x4 lngr[4], lnbr[4], scr[4], shr[4]; int cmi = -1;
#pragma unroll
    for (int j = 0; j < 4; ++j) { const int col = 4 * C.lane + 256 * j; lngr[j] = *(const f32x4*)(lng + col); lnbr[j] = *(const f32x4*)(lnb + col); scr[j] = lngr[j]; shr[j] = lngr[j]; }
    f32x4 xn[4];
    if (row0 < row1) {
#pragma unroll
        for (int j = 0; j < 4; ++j) xn[j] = *(const f32x4*)(X + (size_t)row0 * DM + 4 * C.lane + 256 * j); }
    for (int row = row0; row < row1; ++row) {
        const int mi = row_mi(row);
        if (mi != cmi) { cmi = mi; const float* md = MOD + mi * 6144;
#pragma unroll
            for (int j = 0; j < 4; ++j) { const int col = 4 * C.lane + 256 * j; scr[j] = *(const f32x4*)(md + 4 * DM + col) + 1.f; shr[j] = *(const f32x4*)(md + 3 * DM + col); } }
        f32x4 x[4]; float s = 0.f;
#pragma unroll
        for (int j = 0; j < 4; ++j) { x[j] = xn[j]; s += (x[j][0] + x[j][1]) + (x[j][2] + x[j][3]); }
        if (row + 1 < row1) {
#pragma unroll
            for (int j = 0; j < 4; ++j) xn[j] = *(const f32x4*)(X + (size_t)(row + 1) * DM + 4 * C.lane + 256 * j); }
        const float mean = wave_sum(s) * (1.f / DM); float s2 = 0.f;
#pragma unroll
        for (int j = 0; j < 4; ++j) { x[j] = x[j] - mean; s2 += (x[j][0] * x[j][0] + x[j][1] * x[j][1]) + (x[j][2] * x[j][2] + x[j][3] * x[j][3]); }
        const float rstd = rsqrtf(wave_sum(s2) * (1.f / DM) + LN_EPS);
        if (C.lane == 0) *(f32x2*)(STAT + (size_t)row * 2) = (f32x2){mean, rstd};
        float v[16];
#pragma unroll
        for (int e = 0; e < 16; ++e) v[e] = 0.f;
#pragma unroll
        for (int j = 0; j < 4; ++j) { const int col = 4 * C.lane + 256 * j;
            const f32x4 x1 = x[j] * rstd * lngr[j] + lnbr[j];
            const f32x4 h = x1 * scr[j] + shr[j];
            st4bf(H + (size_t)row * DM + col, h);
#pragma unroll
            for (int e = 0; e < 16; ++e) { const f32x4 w = *(const LAS f32x4*)(wrs + e * 1024 + col); v[e] += (h[0] * w[0] + h[1] * w[1]) + (h[2] * w[2] + h[3] * w[3]); }
            __builtin_amdgcn_sched_barrier(0); }
#pragma unroll
        for (int i = 0; i < 8; ++i) { const float send = (C.lane & 32) ? v[i] : v[i + 8], keep = (C.lane & 32) ? v[i + 8] : v[i]; v[i] = keep + lx32(send, C.lane); }
#pragma unroll
        for (int i = 0; i < 4; ++i) { const float send = (C.lane & 16) ? v[i] : v[i + 4], keep = (C.lane & 16) ? v[i + 4] : v[i]; v[i] = keep + lx16(send, C.lane); }
#pragma unroll
        for (int i = 0; i < 2; ++i) { const float send = (C.lane & 8) ? v[i] : v[i + 2], keep = (C.lane & 8) ? v[i + 2] : v[i]; v[i] = keep + lx8(send); }
        { const float send = (C.lane & 4) ? v[0] : v[1], keep = (C.lane & 4) ? v[1] : v[0]; v[0] = keep + lx4(send); }
        float z = v[0]; z += lx1(z); z += lx2(z);
        float mx = z;
#pragma unroll
        for (int o = 4; o < 64; o <<= 1) mx = fmaxf(mx, o == 4 ? lx4(mx) : o == 8 ? lx8(mx) : o == 16 ? lx16(mx, C.lane) : lx32(mx, C.lane));
        const float ex = expf(z - mx); float sm = ex;
#pragma unroll
        for (int o = 4; o < 64; o <<= 1) sm += (o == 4 ? lx4(sm) : o == 8 ? lx8(sm) : o == 16 ? lx16(sm, C.lane) : lx32(sm, C.lane));
        if ((C.lane & 3) == 0) AFF[(size_t)row * 16 + (C.lane >> 2)] = ex / sm;
    }
}

__device__ __forceinline__ void phase_tk(const Ctx& C, const Args& A) {
    unsigned char* ws = A.ws; const float* AFF = (const float*)(ws + WS_AFF); int* SLOT = (int*)(ws + WS_SLOT); int* IDX = (int*)(ws + WS_IDX); float* GATE = (float*)(ws + WS_GATE);
    LAS unsigned* key = (LAS unsigned*)C.lds;
    LAS unsigned* hist = key + 8192;
    LAS unsigned* scn = hist + 256;
    LAS unsigned* wtot = scn + 256;
    LAS unsigned* bc = wtot + 8;
    for (int u = blockIdx.x; u < 128; u += C.G) {
        const bool isctx = u >= 64; const int uu = u & 63, b = uu >> 4, e = uu & 15;
        const int n = isctx ? CTXL : TT, cap = isctx ? CAP_C : CAP_L;
        const int row0 = isctx ? NLAT + b * CTXL : b * TT;
        const int slot0 = e * ESLOTS + (isctx ? 4 * CAP_L + b * CAP_C : b * CAP_L);
        for (int i = C.tid; i < n; i += NTHR) key[i] = __float_as_uint(AFF[(size_t)(row0 + i) * 16 + e]);
        unsigned prefix = 0u, pmask = 0u; int need = cap;
        for (int pass = 0; pass < 4; ++pass) {
            const int shift = 24 - 8 * pass;
            if (C.tid < 256) hist[C.tid] = 0u;
            __syncthreads();
            for (int i = C.tid; i < n; i += NTHR) { const unsigned k = key[i]; if ((k & pmask) == prefix) __hip_atomic_fetch_add(&hist[(k >> shift) & 255u], 1u, __ATOMIC_RELAXED, __HIP_MEMORY_SCOPE_WORKGROUP); }
            __syncthreads();
            {
                const unsigned hd = (C.tid < 256) ? hist[255 - C.tid] : 0u; unsigned inc = hd;
#pragma unroll
                for (int o = 1; o < 64; o <<= 1) { const unsigned t = __shfl_up(inc, o); if (C.lane >= o) inc += t; }
                if (C.tid < 256 && C.lane == 63) wtot[C.wave] = inc;
                __syncthreads();
                if (C.tid < 256) { unsigned base = 0u; for (int w = 0; w < C.wave; ++w) base += wtot[w];
                    const unsigned incl = base + inc, above = incl - hd;
                    if (incl >= (unsigned)need && above < (unsigned)need) { bc[0] = (unsigned)(255 - C.tid); bc[1] = (unsigned)need - above; } }
            }
            __syncthreads();
            prefix |= bc[0] << shift; pmask |= 255u << shift; need = (int)bc[1];
            __syncthreads();
        }
        const int per = (n + NTHR - 1) / NTHR; const int i0 = C.tid * per;
        unsigned cg = 0u, ce = 0u;
        for (int j = 0; j < per; ++j) { const int i = i0 + j; if (i < n) { const unsigned k = key[i]; cg += (k > prefix); ce += (k == prefix); } }
        unsigned pk = cg | (ce << 16), inc = pk;
#pragma unroll
        for (int o = 1; o < 64; o <<= 1) { const unsigned t = __shfl_up(inc, o); if (C.lane >= o) inc += t; }
        if (C.lane == 63) wtot[C.wave] = inc;
        __syncthreads();
        unsigned wbase = 0u;
        for (int w = 0; w < C.wave; ++w) wbase += wtot[w];
        const unsigned excl = wbase + inc - pk;
        unsigned rg = excl & 0xffffu, re = excl >> 16;
        const int ngt = cap - need;
        for (int j = 0; j < per; ++j) { const int i = i0 + j; if (i < n) { const unsigned k = key[i]; int pos = -1;
            if (k > prefix) { pos = (int)rg; ++rg; } else if (k == prefix) { if ((int)re < need) pos = ngt + (int)re; ++re; }
            const int row = row0 + i;
            if (pos >= 0) { IDX[slot0 + pos] = row; GATE[slot0 + pos] = __uint_as_float(k); SLOT[(size_t)row * 16 + e] = slot0 + pos; }
            else SLOT[(size_t)row * 16 + e] = -1; } }
        if (isctx && b == 0 && C.tid < ESLOTS - 4224) { IDX[e * ESLOTS + 4224 + C.tid] = 0; GATE[e * ESLOTS + 4224 + C.tid] = 0.f; }
        __syncthreads();
    }
}

__device__ __forceinline__ void phase_cb(const Ctx& C, const Args& A, int l) {
    unsigned char* ws = A.ws; float* X = (float*)(ws + WS_X); bf16_t* H = (bf16_t*)(ws + WS_H); const int* SLOT = (const int*)(ws + WS_SLOT); const bf16_t* YE = (const bf16_t*)(ws + WS_YE);
    const float* MOD = (const float*)(ws + WS_MOD) + (size_t)l * 5 * 6144; const float* MODN = MOD + 5 * 6144;
    const float* lng = A.in[I_LNG] + (size_t)(l * 2 + 1) * DM; const float* lnb = A.in[I_LNB] + (size_t)(l * 2 + 1) * DM;
    const float* lng1 = A.in[I_LNG] + (size_t)(l * 2 + 0) * DM; const float* lnb1 = A.in[I_LNB] + (size_t)(l * 2 + 0) * DM; const float* STAT = (const float*)(ws + WS_P);
    const int row0 = (int)(((long)C.gw * MROWS) / C.NGW), row1 = (int)(((long)(C.gw + 1) * MROWS) / C.NGW);
    f32x4 lngr[4], lnbr[4], gfr[4], nsc[4], nsh[4], l1g[4], l1b[4]; int cmi = -1;
#pragma unroll
    for (int j = 0; j < 4; ++j) { const int col = 4 * C.lane + 256 * j; lngr[j] = *(const f32x4*)(lng + col); lnbr[j] = *(const f32x4*)(lnb + col); gfr[j] = lngr[j]; nsc[j] = lngr[j]; nsh[j] = lngr[j];
        l1g[j] = *(const f32x4*)(lng1 + col); l1b[j] = *(const f32x4*)(lnb1 + col); }
    int svn = -1; f32x4 xn[4]; f32x2 stn = {0.f, 0.f};
    if (row0 < row1) { svn = SLOT[(size_t)row0 * 16 + (C.lane & 15)]; stn = *(const f32x2*)(STAT + (size_t)row0 * 2);
#pragma unroll
        for (int j = 0; j < 4; ++j) xn[j] = *(const f32x4*)(X + (size_t)row0 * DM + 4 * C.lane + 256 * j); }
    for (int row = row0; row < row1; ++row) {
        const int mi = row_mi(row);
        if (mi != cmi) { cmi = mi; const float* md = MOD + mi * 6144; const float* mn = MODN + mi * 6144;
#pragma unroll
            for (int j = 0; j < 4; ++j) { const int col = 4 * C.lane + 256 * j; gfr[j] = *(const f32x4*)(md + 5 * DM + col);
                if (l < DEPTH - 1) { nsc[j] = *(const f32x4*)(mn + DM + col) + 1.f; nsh[j] = *(const f32x4*)(mn + col); } } }
        const int sv = svn;
        unsigned mask = (unsigned)__ballot(sv >= 0) & 0xffffu;
        f32x4 acc[4];
#pragma unroll
        for (int j = 0; j < 4; ++j) acc[j] = (f32x4){0.f, 0.f, 0.f, 0.f};
        u32x2 y0[4], y1[4]; bool h0 = false, h1 = false;
        if (mask) { const int e = __builtin_ctz(mask); mask &= mask - 1; h0 = true; const int sl = __builtin_amdgcn_readlane(sv, e);
#pragma unroll
            for (int j = 0; j < 4; ++j) y0[j] = *(const u32x2*)(YE + (size_t)sl * DM + 4 * C.lane + 256 * j); }
        if (mask) { const int e = __builtin_ctz(mask); mask &= mask - 1; h1 = true; const int sl = __builtin_amdgcn_readlane(sv, e);
#pragma unroll
            for (int j = 0; j < 4; ++j) y1[j] = *(const u32x2*)(YE + (size_t)sl * DM + 4 * C.lane + 256 * j); }
        f32x4 x[4]; const f32x2 st = stn;
#pragma unroll
        for (int j = 0; j < 4; ++j) x[j] = xn[j];
        if (row + 1 < row1) { svn = SLOT[(size_t)(row + 1) * 16 + (C.lane & 15)]; stn = *(const f32x2*)(STAT + (size_t)(row + 1) * 2);
#pragma unroll
            for (int j = 0; j < 4; ++j) xn[j] = *(const f32x4*)(X + (size_t)(row + 1) * DM + 4 * C.lane + 256 * j); }
        if (h0) {
#pragma unroll
            for (int j = 0; j < 4; ++j) acc[j] += (f32x4){__uint_as_float(y0[j].x << 16), __uint_as_float(y0[j].x & 0xffff0000u), __uint_as_float(y0[j].y << 16), __uint_as_float(y0[j].y & 0xffff0000u)}; }
        if (h1) {
#pragma unroll
            for (int j = 0; j < 4; ++j) acc[j] += (f32x4){__uint_as_float(y1[j].x << 16), __uint_as_float(y1[j].x & 0xffff0000u), __uint_as_float(y1[j].y << 16), __uint_as_float(y1[j].y & 0xffff0000u)}; }
        while (mask) { const int e = __builtin_ctz(mask); mask &= mask - 1; const int sl = __builtin_amdgcn_readlane(sv, e);
#pragma unroll
            for (int j = 0; j < 4; ++j) acc[j] += ld4bf(YE + (size_t)sl * DM + 4 * C.lane + 256 * j); }
        float sm = 0.f;
#pragma unroll
        for (int j = 0; j < 4; ++j) { x[j] = ((x[j] - st[0]) * st[1] * l1g[j] + l1b[j]) * ALPHA_DN + gfr[j] * acc[j];
            sm += (x[j][0] + x[j][1]) + (x[j][2] + x[j][3]); }
        const float mean = wave_sum(sm) * (1.f / DM); float s2 = 0.f;
#pragma unroll
        for (int j = 0; j < 4; ++j) { x[j] = x[j] - mean; s2 += (x[j][0] * x[j][0] + x[j][1] * x[j][1]) + (x[j][2] * x[j][2] + x[j][3] * x[j][3]); }
        const float rstd = rsqrtf(wave_sum(s2) * (1.f / DM) + LN_EPS);
#pragma unroll
        for (int j = 0; j < 4; ++j) { const int col = 4 * C.lane + 256 * j;
            const f32x4 x2 = x[j] * rstd * lngr[j] + lnbr[j];
            if (l < DEPTH - 1) { *(f32x4*)(X + (size_t)row * DM + col) = x2; st4bf(H + (size_t)row * DM + col, x2 * nsc[j] + nsh[j]); }
            else if (row < NLAT) *(f32x4*)(A.out + (size_t)row * DM + col) = x2; }
    }
}


#ifndef GEMM_NOINLINE
#define GEMM_NOINLINE 0
#endif
#if GEMM_NOINLINE
#define GEMM_FN __device__ __noinline__
#else
#define GEMM_FN __device__ __forceinline__
#endif
GEMM_FN void gphase_in(LAS unsigned char* lds, unsigned char* ws, int nN, int G) {
    int bx = blockIdx.x; asm volatile("" : "+s"(bx), "+s"(G));
    pg8::Gemm g{(const bf16_t*)(ws + WS_H), (const bf16_t*)(ws + WS_WIN), DM}; pg8::Order<0> S; S.init(MROWS / 256, nN, G, bx, nullptr, 0);
    pg8::EpiBf16 E{(bf16_t*)(ws + WS_P), P_LD}; pg8::gemm_phase(lds, g, S, E); }
GEMM_FN void gphase_in_odd(LAS unsigned char* lds, unsigned char* ws, int G) {
    int bx = blockIdx.x; asm volatile("" : "+s"(bx), "+s"(G));
    pg8::Gemm g{(const bf16_t*)(ws + WS_H), (const bf16_t*)(ws + WS_WIN), DM}; pg8::Order<0> S; S.init(MROWS / 256, D_IN_ODD / 256, G, bx, nullptr, 0);
    pg8::EpiOdd E{(bf16_t*)(ws + WS_P), (bf16_t*)(ws + WS_Q), (bf16_t*)(ws + WS_KA), (const float*)(ws + WS_ROPE)}; pg8::gemm_phase(lds, g, S, E); }
GEMM_FN void gphase_lora(LAS unsigned char* lds, unsigned char* ws, const float* d0, const float* a0, const float* kal, int G) {
    int bx = blockIdx.x; asm volatile("" : "+s"(bx), "+s"(G));
    pg8::Gemm g{(const bf16_t*)(ws + WS_LIN), (const bf16_t*)(ws + WS_WLORA), LORA_K}; pg8::Order<0> S; S.init(MROWS / 256, LORA_N / 256, G, bx, nullptr, 0);
    pg8::EpiLora E{ws + WS_SCN, (bf16_t*)(ws + WS_G), d0, a0, kal}; pg8::gemm_phase(lds, g, S, E); }
GEMM_FN void gphase_out(LAS unsigned char* lds, unsigned char* ws, const float* modl, int G, const float* xin, const float* cin) {
    int bx = blockIdx.x; asm volatile("" : "+s"(bx), "+s"(G));
    pg8::Gemm g{(const bf16_t*)(ws + WS_A2), (const bf16_t*)(ws + WS_WOUT), DM}; pg8::Order<0> S; S.init(MROWS / 256, DM / 256, G, bx, nullptr, 0);
    pg8::EpiRes E{(float*)(ws + WS_X), modl, xin, cin}; pg8::gemm_phase(lds, g, S, E); }
GEMM_FN void gphase_e1(LAS unsigned char* lds, unsigned char* ws, int G, int l) {
    int bx = blockIdx.x; asm volatile("" : "+s"(bx), "+s"(G));
    pg8::Gemm g{(const bf16_t*)(ws + WS_H), (const bf16_t*)(ws + WS_WE13 + (size_t)(l & 1) * WE13_BYTES), DM}; pg8::EpiSwiGLU E{(bf16_t*)(ws + WS_HID)};
    pg8::OrderExp<1> S; S.init(4096 / 256, G, bx, (const int*)(ws + WS_IDX), (long)4096 * DM); pg8::gemm_phase(lds, g, S, E); }
GEMM_FN void gphase_e2(LAS unsigned char* lds, unsigned char* ws, int G, int l) {
    int bx = blockIdx.x; asm volatile("" : "+s"(bx), "+s"(G));
    pg8::Gemm g{(const bf16_t*)(ws + WS_HID), (const bf16_t*)(ws + WS_WE2 + (size_t)(l & 1) * WE2_BYTES), D_EXP}; pg8::EpiYE E{(bf16_t*)(ws + WS_YE), (const float*)(ws + WS_GATE)};
    pg8::OrderExp<2> S; S.init(DM / 256, G, bx, nullptr, (long)DM * D_EXP); pg8::gemm_phase(lds, g, S, E); }

constexpr int NSLOT = 13;
constexpr int NSTEP = 1 + DEPTH * NSLOT;
__global__ void __launch_bounds__(NTHR, 2) mk_fwd(Args KA) {
    extern __shared__ __attribute__((aligned(16))) unsigned char lds_raw[];
    volatile LAS unsigned* MISC = (volatile LAS unsigned*)((LAS unsigned char*)lds_raw + LDS_MISC);
    if (threadIdx.x < 16) MISC[threadIdx.x] = 0u;
    if (threadIdx.x == 0) { LAS unsigned long long* tb = (LAS unsigned long long*)((LAS unsigned char*)lds_raw + LDS_PTAB);
#pragma unroll
        for (int i = 0; i < 37; ++i) tb[i] = (unsigned long long)KA.in[i];
        tb[37] = (unsigned long long)KA.out; tb[38] = (unsigned long long)KA.ws; }
    __syncthreads();
    const int lo = KA.lo, hi = KA.hi;
    unsigned bar_x = 0;
    if (hi - lo > 1) { const XcdBarrier b0 = xcd_barrier_post((unsigned*)(KA.ws + WS_CTL), MISC); bar_x = b0.x; }
#ifndef PH_MASK
#define PH_MASK 0xFFFFFF
#endif
#ifndef REP_MASK
#define REP_MASK 0
#endif
#define PH_BIT(k) (((k) == 0) ? 0 : 1 + ((k) - 1) % NSLOT + (((k) - 1) % NSLOT >= 2 && ((k) - 1) % NSLOT <= 3 && odd ? 12 : 0))
#define RUN(k, ...) do { if (((PH_MASK >> PH_BIT(k)) & 1) && lo <= (k) && (k) < hi) { const int nrep = ((REP_MASK >> PH_BIT(k)) & 1) ? 2 : 1; \
        _Pragma("unroll 1") for (int rep = 0; rep < nrep; ++rep) { \
        Ctx C; mkctx(C, (LAS unsigned char*)lds_raw); Args A; ldargs(A, (LAS unsigned char*)lds_raw); unsigned char* ws = A.ws; \
        const float* MODL = (const float*)(ws + WS_MOD) + (size_t)l * 5 * 6144; (void)MODL; \
        __VA_ARGS__; if ((k) + 1 < hi || rep + 1 < nrep) { XcdBarrier bar; bar.bar = (unsigned*)(ws + WS_CTL); bar.x = bar_x; bar.st = MISC; xcd_barrier(bar); } } } } while (0)
    { const bool odd = false; const int l = 0; RUN(0, { phase_init(C, A); __syncthreads(); conv_items(C, A, 0, C.gw, C.NGW, true, true, true); }); }
#pragma unroll 1
    for (int l = 0; l < DEPTH; ++l) {
        const int sb = 1 + l * NSLOT; const bool odd = l & 1;
        if (!(CHUNKED_SCAN && odd)) { RUN(sb + 0, { phase_conv(C, A, l); if (l == 0) phase_modh(C, A, 0); }); }
        if (odd) { RUN(sb + 1, { gphase_in_odd(C.lds, ws, C.G);
                   const int tail = ((MROWS / 256) * (D_IN_ODD / 256)) % C.G;
                   if (CHUNKED_SCAN && l + 1 < DEPTH && tail > 0 && (int)blockIdx.x >= tail) conv_items(C, A, l + 1, ((int)blockIdx.x - tail) * NWAVES + C.wave, (C.G - tail) * NWAVES, false, false, true, 0, YW_IN_HI); }); }
        else { RUN(sb + 1, { gphase_in(C.lds, ws, D_IN_EVEN_PAD / 256, C.G);
                   const int tail = ((MROWS / 256) * (D_IN_EVEN_PAD / 256)) % C.G;
                   if (CHUNKED_SCAN && l + 1 < DEPTH && tail > 0 && (int)blockIdx.x >= tail) conv_items(C, A, l + 1, ((int)blockIdx.x - tail) * NWAVES + C.wave, (C.G - tail) * NWAVES, false, false, true, 0, XW_IN_HI); }); }
        if (!odd) {
            RUN(sb + 2, phase_ef1(C, A, l));
            RUN(sb + 3, { const int i2 = l >> 1; gphase_lora(C.lds, ws, A.in[I_D0] + (size_t)i2 * 2 * 768, A.in[I_A0] + (size_t)i2 * 2 * 768, A.in[I_KAL] + (size_t)i2 * 768, C.G); });
#if CHUNKED_SCAN
            RUN(sb + 4, phase_csa(C, A));
            RUN(sb + 5, phase_csb(C, A, l));
#else
            RUN(sb + 4, phase_scan(C, A));
#endif
            RUN(sb + 6, phase_ef2(C, A, l));
        } else {
            RUN(sb + 2, { phase_of1(C, A, l);
                   const int busy2 = 256 + 8 * 7 - C.G;
                   if (CHUNKED_SCAN && l + 1 < DEPTH && busy2 > 0 && (int)blockIdx.x >= busy2) conv_items(C, A, l + 1, ((int)blockIdx.x - busy2) * NWAVES + C.wave, (C.G - busy2) * NWAVES, false, false, true, YW_IN_HI, YW_OF_HI); });
            RUN(sb + 3, phase_attn(C, A, l));
        }
        RUN(sb + 7, { gphase_out(C.lds, ws, MODL, C.G, l == 0 ? A.in[I_X] : (const float*)(ws + WS_X), l == 0 ? A.in[I_CTX] : (const float*)(ws + WS_X) + (size_t)NLAT * DM);
                   const int tail = ((MROWS / 256) * (DM / 256)) % C.G;
                   if (CHUNKED_SCAN && l + 1 < DEPTH && tail > 0 && (int)blockIdx.x >= tail) conv_items(C, A, l + 1, ((int)blockIdx.x - tail) * NWAVES + C.wave, (C.G - tail) * NWAVES, false, false, true, odd ? YW_OF_HI : XW_IN_HI, odd ? YW_OUT_HI : XW_OUT_HI); });
        RUN(sb + 8, phase_rt(C, A, l));
        RUN(sb + 9, { phase_tk(C, A);
                   if (CHUNKED_SCAN && l + 1 < DEPTH && (int)blockIdx.x >= 128) conv_items(C, A, l + 1, ((int)blockIdx.x - 128) * NWAVES + C.wave, (C.G - 128) * NWAVES, false, false, true, odd ? YW_OUT_HI : XW_OUT_HI, odd ? YW_TK_HI : XW_TK_HI); });
        RUN(sb + 10, gphase_e1(C.lds, ws, C.G, l));
        RUN(sb + 11, gphase_e2(C.lds, ws, C.G, l));
        RUN(sb + 12, { phase_cb(C, A, l); if (CHUNKED_SCAN && !odd && l + 1 < DEPTH) { __syncthreads(); conv_items(C, A, l + 1, C.gw, C.NGW, false, true, false); } });
    }
#undef RUN
}

#ifdef PHASE_PROBE
#define PROBE_PRE extern __shared__ __attribute__((aligned(16))) unsigned char lds_raw[]; Ctx C; mkctx(C, (LAS unsigned char*)lds_raw); unsigned char* ws = A.ws; (void)ws;
__global__ void __launch_bounds__(NTHR, 2) pr_init(Args A) { PROBE_PRE phase_init(C, A); }
__global__ void __launch_bounds__(NTHR, 2) pr_conv(Args A) { PROBE_PRE phase_conv(C, A, A.lo); }
__global__ void __launch_bounds__(NTHR, 2) pr_modh(Args A) { PROBE_PRE phase_modh(C, A, A.lo); }
__global__ void __launch_bounds__(NTHR, 2) pr_ef1(Args A) { PROBE_PRE phase_ef1(C, A, A.lo); }
__global__ void __launch_bounds__(NTHR, 2) pr_scan(Args A) { PROBE_PRE phase_scan(C, A); }
__global__ void __launch_bounds__(NTHR, 2) pr_ef2(Args A) { PROBE_PRE phase_ef2(C, A, A.lo); }
__global__ void __launch_bounds__(NTHR, 2) pr_csa(Args A) { PROBE_PRE phase_csa(C, A); }
__global__ void __launch_bounds__(NTHR, 2) pr_csb(Args A) { PROBE_PRE phase_csb(C, A, A.lo); }
__global__ void __launch_bounds__(NTHR, 2) pr_of1(Args A) { PROBE_PRE phase_of1(C, A, A.lo); }
__global__ void __launch_bounds__(NTHR, 2) pr_attn(Args A) { PROBE_PRE phase_attn(C, A, A.lo); }
__global__ void __launch_bounds__(NTHR, 2) pr_rt(Args A) { PROBE_PRE phase_rt(C, A, A.lo); }
__global__ void __launch_bounds__(NTHR, 2) pr_tk(Args A) { PROBE_PRE phase_tk(C, A); }
__global__ void __launch_bounds__(NTHR, 2) pr_cb(Args A) { PROBE_PRE phase_cb(C, A, A.lo); }
__global__ void __launch_bounds__(NTHR, 2) pr_gemm_in(Args A) { PROBE_PRE pg8::Gemm g{(const bf16_t*)(ws + WS_H), (const bf16_t*)(ws + WS_WIN), DM}; pg8::Order<0> S; S.init(MROWS / 256, A.lo, C.G, (int)blockIdx.x, nullptr, 0);
                      pg8::EpiBf16 E{(bf16_t*)(ws + WS_P), P_LD}; pg8::gemm_phase(C.lds, g, S, E); }
__global__ void __launch_bounds__(NTHR, 2) pr_gemm_lora(Args A) { PROBE_PRE pg8::Gemm g{(const bf16_t*)(ws + WS_LIN), (const bf16_t*)(ws + WS_WLORA), LORA_K}; pg8::Order<0> S; S.init(MROWS / 256, LORA_N / 256, C.G, (int)blockIdx.x, nullptr, 0);
                          const int i2 = A.lo; pg8::EpiLora E{ws + WS_SCN, (bf16_t*)(ws + WS_G), A.in[I_D0] + (size_t)i2 * 2 * 768, A.in[I_A0] + (size_t)i2 * 2 * 768, A.in[I_KAL] + (size_t)i2 * 768};
                          pg8::gemm_phase(C.lds, g, S, E); }
__global__ void __launch_bounds__(NTHR, 2) pr_gemm_out(Args A) { PROBE_PRE pg8::Gemm g{(const bf16_t*)(ws + WS_A2), (const bf16_t*)(ws + WS_WOUT), DM}; pg8::Order<0> S; S.init(MROWS / 256, DM / 256, C.G, (int)blockIdx.x, nullptr, 0);
                      pg8::EpiRes E{(float*)(ws + WS_X), (const float*)(ws + WS_MOD), (const float*)(ws + WS_X), (const float*)(ws + WS_X) + (size_t)NLAT * DM}; pg8::gemm_phase(C.lds, g, S, E); }
__global__ void __launch_bounds__(NTHR, 2) pr_gemm_e1(Args A) { PROBE_PRE pg8::Gemm g{(const bf16_t*)(ws + WS_H), (const bf16_t*)(ws + WS_WE13), DM}; pg8::Order<1> S; S.init(NEXP * 17, 4096 / 256, C.G, (int)blockIdx.x, (const int*)(ws + WS_IDX), (long)4096 * DM);
                      pg8::EpiSwiGLU E{(bf16_t*)(ws + WS_HID)}; pg8::gemm_phase(C.lds, g, S, E); }
__global__ void __launch_bounds__(NTHR, 2) pr_gemm_e2(Args A) { PROBE_PRE pg8::Gemm g{(const bf16_t*)(ws + WS_HID), (const bf16_t*)(ws + WS_WE2), D_EXP}; pg8::Order<2> S; S.init(NEXP * 17, DM / 256, C.G, (int)blockIdx.x, nullptr, (long)DM * D_EXP);
                       pg8::EpiYE E{(bf16_t*)(ws + WS_YE), (const float*)(ws + WS_GATE)}; pg8::gemm_phase(C.lds, g, S, E); }
#endif

extern "C" void kernel_launch(void* const* d_in, const int* in_sizes, int n_in, void* d_out, int out_size, void* d_ws, size_t ws_size, hipStream_t stream) {
    static int grid = 0;
    if (grid == 0) {
        if (n_in != 37 || out_size != NLAT * DM || ws_size < WS_END) { fprintf(stderr, "kernel_launch: unexpected shapes: n_in %d out %d ws %zu (need %zu)\n", n_in, out_size, ws_size, (size_t)WS_END); grid = -1; return; }
        int dev = 0, cus = 0, per_cu = 0;
        if (hipGetDevice(&dev) != hipSuccess || hipDeviceGetAttribute(&cus, hipDeviceAttributeMultiprocessorCount, dev) != hipSuccess) { grid = -1; return; }
        if (hipFuncSetAttribute((const void*)mk_fwd, hipFuncAttributeMaxDynamicSharedMemorySize, LDS_BYTES) != hipSuccess) { fprintf(stderr, "kernel_launch: hipFuncSetAttribute failed\n"); grid = -1; return; }
        if (hipOccupancyMaxActiveBlocksPerMultiprocessor(&per_cu, (const void*)mk_fwd, NTHR, LDS_BYTES) != hipSuccess || per_cu < 1) fprintf(stderr, "kernel_launch: occupancy query reports %d\n", per_cu);
        (void)hipGetLastError();
        grid = cus;
    }
    if (grid < 0) return;
    (void)hipMemsetAsync((char*)d_ws + WS_CTL, 0, CTL_BYTES, stream);
    Args a{};
    for (int i = 0; i < 37; ++i) a.in[i] = (const float*)d_in[i];
    a.out = (float*)d_out; a.ws = (unsigned char*)d_ws;
#if MK_MULTI
    for (int k = 0; k < NSTEP; ++k) {
        if (k >= 1) { const int l = (k - 1) / NSLOT, s = (k - 1) % NSLOT; if ((l & 1) && ((s >= 4 && s <= 6) || (CHUNKED_SCAN && s == 0))) continue; if (!(l & 1) && !CHUNKED_SCAN && s == 5) continue; }
        a.lo = k; a.hi = k + 1;
        hipLaunchKernelGGL(mk_fwd, dim3(grid), dim3(NTHR), LDS_BYTES, stream, a);
    }
#else
    a.lo = 0; a.hi = NSTEP;
    hipLaunchKernelGGL(mk_fwd, dim3(grid), dim3(NTHR), LDS_BYTES, stream, a);
#endif
    const hipError_t le = hipPeekAtLastError();
    if (le != hipSuccess) fprintf(stderr, "kernel_launch: launch failed: %s\n", hipGetErrorName(le));
}
```

```cpp
#include <hip/hip_runtime.h>
#include <cstdio>
#include <cstdint>
#include <cmath>

#ifndef MK_MULTI
#define MK_MULTI 0
#endif
#ifndef CHUNKED_SCAN
#define CHUNKED_SCAN 1
#endif

#define GAS __attribute__((address_space(1)))
#define LAS __attribute__((address_space(3)))
typedef unsigned short bf16_t;
typedef short bf16x8 __attribute__((ext_vector_type(8)));
typedef float f32x4 __attribute__((ext_vector_type(4)));
typedef float f32x2 __attribute__((ext_vector_type(2)));
typedef float f32x16 __attribute__((ext_vector_type(16)));
typedef unsigned u32x4 __attribute__((ext_vector_type(4)));
typedef unsigned u32x2 __attribute__((ext_vector_type(2)));
typedef __bf16 bf16x2_t __attribute__((ext_vector_type(2)));

constexpr int NB = 4, TT = 8192, DM = 1024, NLAT = NB * TT, CTXL = 256, NCTX = NB * CTXL, MROWS = NLAT + NCTX;
constexpr int DEPTH = 4;
constexpr int D_CONV = 256, RW_H = 12, RW_K = 64, D_RWKV = 768, RWKV_COLS = 2688, D_IN_EVEN = 3456, D_IN_EVEN_PAD = 3584;
constexpr int D_DIFF = 768, D_GMLP = 256, D_IN_ODD = 2816;
constexpr int NEXP = 16, D_EXP = 2048, CAP_L = 1024, CAP_C = 32, ESLOTS = 4352;
constexpr int P_LD = 3584;
constexpr int LORA_K = 384, LORA_N = 3840;
constexpr int LKEYS = CTXL + TT;
constexpr float ALPHA_DN = 1.6817928305074290f;
constexpr float DECAY_SCALE = 0.6065306597126334f;
constexpr float GN_EPS = 64e-5f, LN_EPS = 1e-5f, RMS_EPS = 1e-5f;
constexpr float QSCALE = 0.125f * 1.4426950408889634f;

constexpr size_t al256(size_t x) { return (x + 255) & ~(size_t)255; }
constexpr size_t WS_CTL = 0;
constexpr size_t CTL_BYTES = 65536;
constexpr size_t WS_MOD = WS_CTL + CTL_BYTES;
constexpr size_t WS_ROPE = WS_MOD + al256((size_t)DEPTH * 5 * 6144 * 4);
constexpr size_t WS_WIN = WS_ROPE + 32768;
constexpr size_t WS_WOUT = WS_WIN + (size_t)D_IN_EVEN_PAD * DM * 2;
constexpr size_t WS_WLORA = WS_WOUT + (size_t)DM * DM * 2;
constexpr size_t WS_WE13 = WS_WLORA + (size_t)LORA_N * LORA_K * 2;
constexpr size_t WE13_BYTES = (size_t)NEXP * 4096 * DM * 2, WE2_BYTES = (size_t)NEXP * DM * D_EXP * 2;
constexpr size_t WS_WE2 = WS_WE13 + 2 * WE13_BYTES;
constexpr size_t WS_X = WS_WE2 + 2 * WE2_BYTES;
constexpr size_t WS_H = WS_X + (size_t)MROWS * DM * 4;
constexpr size_t WS_A2 = WS_H + (size_t)MROWS * DM * 2;
constexpr size_t WS_P = WS_A2 + (size_t)MROWS * DM * 2;
constexpr size_t WS_AFF = WS_P + (size_t)MROWS * P_LD * 2;
constexpr size_t WS_SLOT = WS_AFF + (size_t)MROWS * 16 * 4;
constexpr size_t WS_IDX = WS_SLOT + (size_t)MROWS * 16 * 4;
constexpr size_t WS_GATE = WS_IDX + al256((size_t)NEXP * ESLOTS * 4);
constexpr size_t WS_R2 = WS_GATE + al256((size_t)NEXP * ESLOTS * 4);
constexpr int SC_REC = 1408, SC_ROW = 12 * SC_REC, SC_W = 0, SC_R = 512, SC_KK = 640, SC_V = 768, SC_B = 896, SC_KR = 1024;
constexpr size_t WS_SCN = WS_R2;
constexpr size_t WS_G = WS_SCN + (size_t)MROWS * SC_ROW;
constexpr size_t WS_LIN = WS_G + (size_t)MROWS * 768 * 2;
constexpr int CS_L = 64, CS_NCH = LKEYS / CS_L, CS_UNITS = NB * RW_H * 2;
constexpr size_t WS_CHK = WS_LIN + (size_t)MROWS * 384 * 2;
constexpr size_t WS_EVEN_END = WS_CHK + (size_t)CS_UNITS * CS_NCH * 32768;
constexpr size_t WS_Y = WS_P;
constexpr size_t WS_Q = WS_R2;
constexpr size_t WS_KA = WS_Q + (size_t)MROWS * 768 * 2;
constexpr size_t WS_VT = WS_KA + (size_t)NB * LKEYS * 768 * 2;
constexpr size_t WS_HID = WS_R2;
constexpr size_t WS_YE = WS_HID + (size_t)NEXP * ESLOTS * D_EXP * 2;
constexpr size_t WS_END = WS_EVEN_END;
static_assert(WS_END <= (size_t)2147483648ull, "workspace over 2 GiB");
static_assert((size_t)2 * MROWS * 768 * 4 <= (size_t)MROWS * P_LD * 2, "Y aliases P");
static_assert(WS_YE + (size_t)NEXP * ESLOTS * DM * 2 <= WS_END, "moe region");

constexpr int LDS_BYTES = 147456;
constexpr int LDS_MISC = 140 * 1024;
constexpr int LDS_PTAB = LDS_MISC + 256;
constexpr int NWAVES = 8, NTHR = 512;

__device__ __forceinline__ unsigned f2bf(float f) { unsigned u = __float_as_uint(f); return (u + 0x7fffu + ((u >> 16) & 1u)) >> 16; }
__device__ __forceinline__ unsigned pk2(float lo, float hi) { f32x2 v = {lo, hi}; bf16x2_t b = __builtin_convertvector(v, bf16x2_t); return __builtin_bit_cast(unsigned, b); }
__device__ __forceinline__ float bflo(unsigned u) { return __uint_as_float(u << 16); }
__device__ __forceinline__ float bfhi(unsigned u) { return __uint_as_float(u & 0xffff0000u); }
__device__ __forceinline__ float bf2f(bf16_t b) { return __uint_as_float((unsigned)b << 16); }
__device__ __forceinline__ float sigmoidf_(float x) { return __builtin_amdgcn_rcpf(1.f + __expf(-x)); }
#define DPP_MOV_F(v, ctrl) __uint_as_float((unsigned)__builtin_amdgcn_update_dpp(0, (int)__float_as_uint(v), (ctrl), 0xF, 0xF, true))
__device__ __forceinline__ float lx1(float v) { return DPP_MOV_F(v, 0xB1); }
__device__ __forceinline__ float lx2(float v) { return DPP_MOV_F(v, 0x4E); }
__device__ __forceinline__ float lx4(float v) { const float t = DPP_MOV_F(v, 0x141); return DPP_MOV_F(t, 0x1B); }
__device__ __forceinline__ float lx8(float v) { return DPP_MOV_F(v, 0x128); }
__device__ __forceinline__ float lx16(float v, int lane) { const auto r = __builtin_amdgcn_permlane16_swap(__float_as_uint(v), __float_as_uint(v), false, false); return __uint_as_float((lane & 16) ? r[0] : r[1]); }
__device__ __forceinline__ float lx32(float v, int lane) { const auto r = __builtin_amdgcn_permlane32_swap(__float_as_uint(v), __float_as_uint(v), false, false); return __uint_as_float((lane & 32) ? r[0] : r[1]); }
__device__ __forceinline__ float sum16(float v) {
    v += DPP_MOV_F(v, 0xB1); v += DPP_MOV_F(v, 0x4E); v += DPP_MOV_F(v, 0x141); v += DPP_MOV_F(v, 0x140);
    return v;
}
__device__ __forceinline__ float wave_sum(float v) {
    v = sum16(v);
    { const auto r = __builtin_amdgcn_permlane16_swap(__float_as_uint(v), __float_as_uint(v), false, false); v = __uint_as_float(r[0]) + __uint_as_float(r[1]); }
    { const auto r = __builtin_amdgcn_permlane32_swap(__float_as_uint(v), __float_as_uint(v), false, false); v = __uint_as_float(r[0]) + __uint_as_float(r[1]); }
    return v;
}
__device__ __forceinline__ f32x4 ld4bf_(const void* p) { const u32x2 u = *(const u32x2*)p; return (f32x4){bflo(u.x), bfhi(u.x), bflo(u.y), bfhi(u.y)}; }
__device__ __forceinline__ void st4bf_(void* p, f32x4 v) { u32x2 o; o.x = pk2(v[0], v[1]); o.y = pk2(v[2], v[3]); *(u32x2*)p = o; }
__device__ __forceinline__ float max3f(float a, float b, float c) { float r; asm("v_max3_f32 %0, %1, %2, %3" : "=v"(r) : "v"(a), "v"(b), "v"(c)); return r; }
__device__ __forceinline__ int crow(int r, int hi) { return (r & 3) + 8 * (r >> 2) + 4 * hi; }
__device__ __forceinline__ f32x2 gelu_pk(f32x2 v) {
    const f32x2 av = __builtin_elementwise_abs(v), d = av * 0.2316418882f + 1.0f;
    f32x2 t; t.x = __builtin_amdgcn_rcpf(d.x); t.y = __builtin_amdgcn_rcpf(d.y);
    f32x2 q = t * 0.5307027145f + (-0.7265760135f); q = q * t + 0.7107068705f; q = q * t + (-0.142248368f); q = q * t + 0.127414796f; q = q * t;
    const f32x2 s = (v * v) * (-0.72134752044f);
    f32x2 e; e.x = __builtin_amdgcn_exp2f(s.x); e.y = __builtin_amdgcn_exp2f(s.y);
    const f32x2 m = v * (q * e), r = v - m;
    f32x2 o; o.x = v.x < 0.f ? m.x : r.x; o.y = v.y < 0.f ? m.y : r.y; return o;
}
__device__ __forceinline__ f32x4 gelu4(f32x4 v) { const f32x2 a = gelu_pk((f32x2){v[0], v[1]}), b = gelu_pk((f32x2){v[2], v[3]}); return (f32x4){a.x, a.y, b.x, b.y}; }
__device__ __forceinline__ float tanh_fast(float x) { return 1.f - 2.f * __builtin_amdgcn_rcpf(1.f + __expf(2.f * x)); }

#define XB_TMO      128
#define XB_XCNT(j)  (256  + 64 * (j))
#define XB_XSUB(j)  (1280 + 64 * (j))
#define XB_XGEN(j)  (2304 + 64 * (j))
#define XB_TOP      3328
#define XB_TOPGEN   3392
#define XCD_BAR_WORDS 3456
#define XB_SPIN_CAP (1u << 20)

__device__ __forceinline__ unsigned xb_ld(unsigned* p)              { return __hip_atomic_load(p, __ATOMIC_RELAXED, __HIP_MEMORY_SCOPE_AGENT); }
__device__ __forceinline__ unsigned xb_add(unsigned* p, unsigned v) { return __hip_atomic_fetch_add(p, v, __ATOMIC_RELAXED, __HIP_MEMORY_SCOPE_AGENT); }
__device__ __forceinline__ unsigned xb_xcc_id() { return (unsigned)__builtin_amdgcn_s_getreg((3 << 11) | 20) & 0xFu; }
#define XB_SPIN(cond, bar) do { unsigned _sp = 0; while (cond) { __builtin_amdgcn_s_sleep(1); \
    if ((++_sp & 255u) == 0u) { if (xb_ld(&(bar)[XB_TMO])) break; if (_sp > XB_SPIN_CAP) { atomicAdd(&(bar)[XB_TMO], 1u); break; } } } } while (0)

struct XcdBarrier { unsigned* bar; unsigned x; volatile LAS unsigned* st; };

__device__ __forceinline__ XcdBarrier xcd_barrier_post(unsigned* bar, volatile LAS unsigned* st) {
    XcdBarrier b; b.bar = bar; b.x = xb_xcc_id(); b.st = st;
    if (threadIdx.x == 0) (void)xb_add(&bar[XB_XCNT(b.x)], 1u);
    return b;
}
__device__ __forceinline__ void xcd_barrier_complete(unsigned* bar, unsigned x, unsigned& nloc, unsigned& nx) {
    const unsigned G = gridDim.x * gridDim.y * gridDim.z;
    unsigned sum, cnt, mine, sp = 0u;
    for (;;) {
        sum = 0u; cnt = 0u; mine = 0u;
#pragma unroll
        for (unsigned j = 0; j < 16; ++j) { const unsigned c = xb_ld(&bar[XB_XCNT(j)]); sum += c; cnt += (c > 0u) ? 1u : 0u; mine = (j == x) ? c : mine; }
        if (sum == G) break;
        __builtin_amdgcn_s_sleep(1);
        if ((++sp & 255u) == 0u) { if (xb_ld(&bar[XB_TMO])) break; if (sp > XB_SPIN_CAP) { atomicAdd(&bar[XB_TMO], 1u); break; } }
    }
    nloc = mine > 0u ? mine : 1u; nx = cnt > 0u ? cnt : 1u;
}
__device__ __forceinline__ void xcd_barrier(const XcdBarrier& b) {
    asm volatile("s_waitcnt vmcnt(0)" ::: "memory");
    __syncthreads();
    if (threadIdx.x == 0) {
        unsigned* bar = b.bar;
        __builtin_amdgcn_s_waitcnt(0);
        unsigned nloc = b.st[0], nx = b.st[1];
        if (nloc == 0u) { xcd_barrier_complete(bar, b.x, nloc, nx); b.st[0] = nloc; b.st[1] = nx; }
        const unsigned old = xb_add(&bar[XB_XSUB(b.x)], 1u);
        const unsigned gen = old / nloc;
        if (old + 1u == (gen + 1u) * nloc) {
            __builtin_amdgcn_fence(__ATOMIC_RELEASE, "agent");
            asm volatile("s_waitcnt vmcnt(0)" ::: "memory");
            const unsigned og = xb_add(&bar[XB_TOP], 1u);
            const unsigned tg = og / nx;
            if (og + 1u == (tg + 1u) * nx) xb_add(&bar[XB_TOPGEN], 1u);
            else XB_SPIN(xb_ld(&bar[XB_TOPGEN]) == tg, bar);
            __builtin_amdgcn_fence(__ATOMIC_ACQUIRE, "agent");
            xb_add(&bar[XB_XGEN(b.x)], 1u);
            asm volatile("s_waitcnt vmcnt(0)" ::: "memory");
        } else {
            XB_SPIN(xb_ld(&bar[XB_XGEN(b.x)]) == gen, bar);
            __builtin_amdgcn_fence(__ATOMIC_ACQUIRE, "agent");
            asm volatile("s_waitcnt vmcnt(0)" ::: "memory");
        }
    }
    __syncthreads();
}

namespace pg8 {
constexpr int BM = 256, BK = 64, HALF = 128, HTB = HALF * BK * 2, STAGE_BYTES = 8 * HTB, NXCD = 8, WGM = 8;
__host__ __device__ __forceinline__ int lds_byte(int r, int c) { const int st = (r >> 4) * 2 + (c >> 5), rr = r & 15, cc = c & 31, ob = rr * 64 + cc * 2; return st * 1024 + (ob ^ (((ob >> 9) & 1) << 5)); }
__host__ __device__ __forceinline__ void stage_rc(int b, int& R, int& C) { const int st = b / 1024, sb = b % 1024, swz = sb ^ (((sb >> 9) & 1) << 5); R = (st >> 1) * 16 + swz / 64; C = (st & 1) * 32 + (swz % 64) / 2; }

struct Unit { int pm, pn, hf; };
struct Gemm { const bf16_t* A; const bf16_t* Bt; int K; };

template <int MODE> struct Order {
    static constexpr bool GATHER = (MODE == 1);
    int nM, nN, nwg, G, c; const int* idx; long bstride;
    __device__ __forceinline__ void init(int nM_, int nN_, int G_, int c_, const int* idx_, long bstride_) { nM = nM_; nN = nN_; nwg = nM * nN; G = G_; c = c_; idx = idx_; bstride = bstride_; }
    __device__ __forceinline__ bool next(int i, Unit& u) const {
        const long L = (long)i * G + c; if (L >= nwg) return false;
        int wgid = (int)L; { const int q = nwg / NXCD, r = nwg % NXCD, xcd = wgid % NXCD, off = wgid / NXCD; wgid = (xcd < r ? xcd * (q + 1) : r * (q + 1) + (xcd - r) * q) + off; }
        const int nig = WGM * nN, gid = wgid / nig, fm = gid * WGM, gsz = (nM - fm) < WGM ? (nM - fm) : WGM;
        u.pm = fm + ((wgid % nig) % gsz); u.pn = (wgid % nig) / gsz; u.hf = (MODE != 0 && (u.pm % 17) == 16) ? 1 : 0; return true;
    }
    __device__ __forceinline__ unsigned arow(const Unit& u, int r) const { if (MODE == 1) return (unsigned)idx[u.pm * BM + r]; return (unsigned)(u.pm * BM + r); }
    __device__ __forceinline__ long bbase(const Unit& u, int K) const { long o = (long)u.pn * BM * K; if (MODE != 0) o += (long)(u.pm / 17) * bstride; return o; }
};

template <int MODE> struct OrderExp {
    static constexpr bool GATHER = (MODE == 1);
    int nN, G, c0; const int* idx; long bstride;
    __device__ __forceinline__ void init(int nN_, int G_, int c_, const int* idx_, long bstride_) { nN = nN_; G = G_; c0 = c_; idx = idx_; bstride = bstride_; }
    __device__ __forceinline__ bool next(int i0, Unit& u) const {
        const int v = i0 * G + c0, i = v >> 8, c = v & 255;
        const int x = c & 7, slot = c >> 3, per = 32 / nN, nfull = 256 / (8 * per);
        if (i > nfull) return false;
        if (i < nfull) { u.pn = slot / per; const int f = (i * 8 + x) * per + (slot % per); u.pm = (f >> 4) * 17 + (f & 15); u.hf = 0; return true; }
        if (i == nfull && slot < 2 * nN) { u.pn = slot >> 1; u.pm = (x * 2 + (slot & 1)) * 17 + 16; u.hf = 1; return true; }
        return false;
    }
    __device__ __forceinline__ unsigned arow(const Unit& u, int r) const { if (MODE == 1) return (unsigned)idx[u.pm * BM + r]; return (unsigned)(u.pm * BM + r); }
    __device__ __forceinline__ long bbase(const Unit& u, int K) const { return (long)u.pn * BM * K + (long)(u.pm / 17) * bstride; }
};

template <class Epi, class Sched>
__device__ __forceinline__ void gemm_phase(LAS unsigned char* lds, const Gemm g, const Sched& S, const Epi& E) {
    int tid = threadIdx.x; asm volatile("" : "+v"(tid));
    const int wid = __builtin_amdgcn_readfirstlane(tid >> 6), wr = wid >> 2, wc = wid & 3;
    const int K = g.K, nt = K / BK;
    unsigned voffB[2];
    { const int lane = tid & 63, fr = lane & 15, fq = lane >> 4; (void)fr; (void)fq; }
#pragma unroll
    for (int i = 0; i < 2; ++i) { int R, Cc; stage_rc(tid * 16 + i * 8192, R, Cc); voffB[i] = (unsigned)(R * K + Cc) * 2u; }
    const size_t kstep = (size_t)(BK * 2);
    const size_t hstep = (size_t)HALF * K * 2;
    const unsigned ldsw = (unsigned)wid * 1024u;
    const int aoff = lds_byte(wr * 64 + (tid & 15), ((tid & 63) >> 4) * 8), boff = lds_byte(wc * 32 + (tid & 15), ((tid & 63) >> 4) * 8);
#define PG8_SA(b, h) (((b) * 2 + (h)) * HTB)
#define PG8_SB(b, h) ((4 + (b) * 2 + (h)) * HTB)
#define PG8_STAGE(bufoff, gbase, voff) do { _Pragma("unroll") for (int _i = 0; _i < 2; ++_i) \
        __builtin_amdgcn_global_load_lds((const unsigned*)((const char*)(gbase) + (voff)[_i]), (LAS unsigned*)(lds + (bufoff) + ldsw + _i * 8192), 16, 0, 0); } while (0)
#define PG8_LDA(dst, b, h) do { _Pragma("unroll") for (int m = 0; m < 4; ++m) _Pragma("unroll") for (int k = 0; k < 2; ++k) dst[m][k] = *(const LAS bf16x8*)(lds + PG8_SA(b, h) + aoff + m * 2048 + k * 1024); } while (0)
#define PG8_LDB(dst, b, h) do { _Pragma("unroll") for (int n = 0; n < 2; ++n) _Pragma("unroll") for (int k = 0; k < 2; ++k) dst[n][k] = *(const LAS bf16x8*)(lds + PG8_SB(b, h) + boff + n * 2048 + k * 1024); } while (0)
#define PG8_MMA(ai, bj, At, Bt) do { __builtin_amdgcn_s_setprio(1); _Pragma("unroll") for (int m = 0; m < 4; ++m) _Pragma("unroll") for (int n = 0; n < 2; ++n) _Pragma("unroll") for (int k = 0; k < 2; ++k) \
        acc[ai][bj][m][n] = __builtin_amdgcn_mfma_f32_16x16x32_bf16(Bt[n][k], At[m][k], acc[ai][bj][m][n], 0, 0, 0); __builtin_amdgcn_s_setprio(0); } while (0)
#define PG8_WAIT_V(n) asm volatile("s_waitcnt vmcnt(" #n ")" ::: "memory")
#define PG8_WAIT_L(n) asm volatile("s_waitcnt lgkmcnt(" #n ")" ::: "memory")
#define PG8_BAR __builtin_amdgcn_s_barrier()
#define PG8_SCHED __builtin_amdgcn_sched_barrier(0)
#define PG8_ROWOFFS(dst, u, tq) do { _Pragma("unroll") for (int _i = 0; _i < 2; ++_i) { int _R, _C; stage_rc((tq) * 16 + _i * 8192, _R, _C); _Pragma("unroll") for (int _h = 0; _h < 2; ++_h) dst[_h][_i] = (S.arow(u, _h * HALF + _R) * (unsigned)K + (unsigned)_C) * 2u; } } while (0)
    Unit cur, nxt; int ui = 0;
    if (!S.next(0, cur)) return;
    float zf = 0.f; asm volatile("" : "+v"(zf));
    f32x4 acc[2][2][4][2];
#pragma unroll
    for (int a = 0; a < 2; ++a)
#pragma unroll
        for (int b = 0; b < 2; ++b)
#pragma unroll
            for (int m = 0; m < 4; ++m)
#pragma unroll
                for (int n = 0; n < 2; ++n) acc[a][b][m][n] = (f32x4){zf, zf, zf, zf};
    bf16x8 At[4][2], B0[2][2], B1[2][2];
    unsigned vcur[2][2];
    if constexpr (Sched::GATHER) { PG8_ROWOFFS(vcur, cur, tid); }
    const char* const Ab = (const char*)g.A;
    const char* cA = Sched::GATHER ? Ab : Ab + (size_t)(unsigned)__builtin_amdgcn_readfirstlane((int)S.arow(cur, 0)) * K * 2;
#define PG8_STAGEA(bufoff, ptr, h) do { if constexpr (Sched::GATHER) { PG8_STAGE(bufoff, ptr, vcur[h]); } else { PG8_STAGE(bufoff, (ptr) + (h) * hstep, voffB); } } while (0)
    const char* cB = (const char*)g.Bt + (size_t)S.bbase(cur, K) * 2;
    PG8_STAGE(PG8_SB(0, 0), cB, voffB); PG8_STAGE(PG8_SB(0, 1), cB + hstep, voffB); PG8_STAGEA(PG8_SA(0, 0), cA, 0); PG8_STAGEA(PG8_SA(0, 1), cA, 1);
    if (wr == 1) PG8_BAR;
    PG8_WAIT_V(2); PG8_BAR;
    PG8_STAGE(PG8_SB(1, 0), cB + kstep, voffB); PG8_STAGEA(PG8_SA(1, 0), cA + kstep, 0); PG8_STAGE(PG8_SB(1, 1), cB + hstep + kstep, voffB);
    PG8_WAIT_V(6); PG8_BAR;
    for (;;) {
        const bool has_next = S.next(ui + 1, nxt);
        const char* nB = has_next ? (const char*)g.Bt + (size_t)S.bbase(nxt, K) * 2 : cB;
        const char* nA = (Sched::GATHER || !has_next) ? cA : Ab + (size_t)(unsigned)__builtin_amdgcn_readfirstlane((int)S.arow(nxt, 0)) * K * 2;
#pragma unroll 1
        for (int t = 0; t < nt; t += 2) {
            const bool last = (t == nt - 2);
            const char* a1 = cA + (size_t)(t + 1) * kstep;
            const char* a2 = last ? nA : cA + (size_t)(t + 2) * kstep; const char* b2 = last ? nB : cB + (size_t)(t + 2) * kstep;
            const char* a3 = a2 + kstep; const char* b3 = b2 + kstep;
            PG8_LDB(B0, 0, 0); PG8_LDB(B1, 0, 1); PG8_SCHED; PG8_LDA(At, 0, 0); PG8_STAGEA(PG8_SA(1, 1), a1, 1);
            PG8_WAIT_V(8); PG8_WAIT_L(0); PG8_BAR; PG8_MMA(0, 0, At, B0); PG8_MMA(0, 1, At, B1); PG8_BAR; PG8_SCHED;
            if constexpr (Sched::GATHER) { if (last && has_next) { int tq = tid; asm volatile("" : "+v"(tq)); PG8_ROWOFFS(vcur, nxt, tq); } }
            PG8_LDA(At, 0, 1); PG8_STAGE(PG8_SB(0, 0), b2, voffB); PG8_STAGE(PG8_SB(0, 1), b2 + hstep, voffB); PG8_STAGEA(PG8_SA(0, 0), a2, 0);
            PG8_WAIT_V(8); PG8_WAIT_L(0); PG8_BAR; if (!cur.hf) { PG8_MMA(1, 0, At, B0); PG8_MMA(1, 1, At, B1); } PG8_BAR; PG8_SCHED;
            PG8_LDB(B0, 1, 0); PG8_LDB(B1, 1, 1); PG8_SCHED; PG8_LDA(At, 1, 0); PG8_STAGEA(PG8_SA(0, 1), a2, 1);
            PG8_WAIT_V(8); PG8_WAIT_L(0); PG8_BAR; PG8_MMA(0, 0, At, B0); PG8_MMA(0, 1, At, B1); PG8_BAR; PG8_SCHED;
            PG8_LDA(At, 1, 1); PG8_STAGE(PG8_SB(1, 0), b3, voffB); PG8_STAGE(PG8_SB(1, 1), b3 + hstep, voffB); PG8_STAGEA(PG8_SA(1, 0), a3, 0);
            PG8_WAIT_V(8); PG8_WAIT_L(0); PG8_BAR; if (!cur.hf) { PG8_MMA(1, 0, At, B0); PG8_MMA(1, 1, At, B1); } PG8_BAR; PG8_SCHED;
        }
        if (wr == 0) PG8_BAR;
        { int tz = tid; asm volatile("" : "+v"(tz)); const int ln = tz & 63; E(acc, cur, wr, wc, ln & 15, ln >> 4); }
        if (!has_next) break;
#pragma unroll
        for (int a = 0; a < 2; ++a)
#pragma unroll
            for (int b = 0; b < 2; ++b)
#pragma unroll
                for (int m = 0; m < 4; ++m)
#pragma unroll
                    for (int n = 0; n < 2; ++n) acc[a][b][m][n] = (f32x4){zf, zf, zf, zf};
        cur = nxt; cB = nB; cA = nA; ++ui;
        if (wr == 1) PG8_BAR;
    }
    PG8_WAIT_V(0);
    PG8_BAR;
#undef PG8_SA
#undef PG8_SB
#undef PG8_STAGE
#undef PG8_LDA
#undef PG8_LDB
#undef PG8_MMA
#undef PG8_WAIT_V
#undef PG8_WAIT_L
#undef PG8_BAR
#undef PG8_SCHED
#undef PG8_ROWOFFS
#undef PG8_STAGEA
}

#define EPI_LOOP for (int ai = 0; ai < 2; ++ai) for (int m = 0; m < 4; ++m) for (int bj = 0; bj < 2; ++bj) for (int n = 0; n < 2; ++n)
__device__ __forceinline__ int colw_of(int fq) { return (fq & 1) * 16 + (fq >> 1) * 8; }
__device__ __forceinline__ void st_pair_bf16(bf16_t* p  , f32x4 v0, f32x4 v1) {
    const unsigned a0 = pk2(v0[0], v0[1]), a1 = pk2(v0[2], v0[3]), b0 = pk2(v1[0], v1[1]), b1 = pk2(v1[2], v1[3]);
    const auto r0 = __builtin_amdgcn_permlane16_swap(a0, b0, false, false); const auto r1 = __builtin_amdgcn_permlane16_swap(a1, b1, false, false);
    u32x4 o; o.x = r0[0]; o.y = r1[0]; o.z = r0[1]; o.w = r1[1]; *(u32x4*)p = o;
}
__device__ __forceinline__ void ld_pair_bf16(const void* p, u32x2& n0, u32x2& n1) {
    const u32x4 w = *(const u32x4*)p;
    const auto r0 = __builtin_amdgcn_permlane16_swap(w.x, w.z, false, false); const auto r1 = __builtin_amdgcn_permlane16_swap(w.y, w.w, false, false);
    n0.x = r0[0]; n0.y = r1[0]; n1.x = r0[1]; n1.y = r1[1];
}
struct EpiBf16 {
    bf16_t* O; int ldc;
    __device__ __forceinline__ void operator()(const f32x4 (&acc)[2][2][4][2], const Unit& u, int wr, int wc, int fr, int fq) const {
        const int row0 = u.pm * BM + wr * 64 + fr, colg = u.pn * BM + wc * 32 + colw_of(fq);
#pragma unroll
        for (int ai = 0; ai < 2; ++ai)
#pragma unroll
            for (int m = 0; m < 4; ++m) { bf16_t* rowp = O + (size_t)(row0 + ai * HALF + m * 16) * ldc + colg;
#pragma unroll
                for (int bj = 0; bj < 2; ++bj) st_pair_bf16(rowp + bj * HALF, acc[ai][bj][m][0], acc[ai][bj][m][1]); }
    }
};
struct EpiOdd {
    bf16_t* P; bf16_t* Q; bf16_t* KA; const float* rope;
    __device__ __forceinline__ void operator()(const f32x4 (&acc)[2][2][4][2], const Unit& u, int wr, int wc, int fr, int fq) const {
        const int row0 = u.pm * BM + wr * 64 + fr, col0 = u.pn * BM + wc * 32 + 4 * fq;
        if (u.pn >= 6) {
#pragma unroll
            for (int ai = 0; ai < 2; ++ai)
#pragma unroll
                for (int m = 0; m < 4; ++m) { bf16_t* rowp = P + (size_t)(row0 + ai * HALF + m * 16) * P_LD + (col0 - 4 * fq + colw_of(fq));
#pragma unroll
                    for (int bj = 0; bj < 2; ++bj) st_pair_bf16(rowp + bj * HALF, acc[ai][bj][m][0], acc[ai][bj][m][1]); }
            return;
        }
        const bool isk = u.pn >= 3, isctx = u.pm >= NLAT / BM; const int axis = wc & 1;
        const int cq = col0 - (isk ? 768 : 0);
        f32x4 csr[2][4], snr[2][4];
#pragma unroll
        for (int ai = 0; ai < 2; ++ai)
#pragma unroll
            for (int m = 0; m < 4; ++m) { const int row = row0 + ai * HALF + m * 16; csr[ai][m] = (f32x4){1.f, 1.f, 1.f, 1.f}; snr[ai][m] = (f32x4){0.f, 0.f, 0.f, 0.f};
                if (!isctx) { const int t = row & (TT - 1); const int pos = axis ? 128 + (t & 63) : (t >> 6);
                    csr[ai][m] = *(const f32x4*)(rope + pos * 16 + 4 * fq); snr[ai][m] = *(const f32x4*)(rope + 192 * 16 + pos * 16 + 4 * fq); } }
#pragma unroll
        for (int ai = 0; ai < 2; ++ai)
#pragma unroll
            for (int m = 0; m < 4; ++m) { const int row = row0 + ai * HALF + m * 16;
                const f32x4 cs = csr[ai][m], sn = snr[ai][m]; size_t orow;
                if (!isctx) { const int t = row & (TT - 1); orow = isk ? (size_t)(row >> 13) * LKEYS + CTXL + t : (size_t)row; }
                else { const int rc = row - NLAT; orow = isk ? (size_t)(rc >> 8) * LKEYS + (rc & 255) : (size_t)row; }
                bf16_t* op = (isk ? KA : Q) + orow * 768 + cq; const float sc = isk ? 1.f : QSCALE;
#pragma unroll
                for (int bj = 0; bj < 2; ++bj) { const f32x4 x1 = acc[ai][bj][m][0], x2 = acc[ai][bj][m][1];
                    const f32x4 o1 = (x1 * cs - x2 * sn) * sc, o2 = (x1 * sn + x2 * cs) * sc;
                    st_pair_bf16(op + bj * HALF - 4 * fq + colw_of(fq), o1, o2); } }
    }
};
struct EpiRes {
    float* X; const float* modl; const float* xin; const float* cin;
    __device__ __forceinline__ void operator()(const f32x4 (&acc)[2][2][4][2], const Unit& u, int wr, int wc, int fr, int fq) const {
        const int row0 = u.pm * BM + wr * 64 + fr, col0 = u.pn * BM + wc * 32 + 4 * fq;
        const int mi = (u.pm * BM < NLAT) ? (u.pm * BM) / TT : 4;
        const float* gate = modl + mi * 6144 + 2 * DM;
        const float* rsrc = (u.pm * BM < NLAT) ? xin : cin - (size_t)NLAT * DM;
        f32x4 gv[2][2];
#pragma unroll
        for (int bj = 0; bj < 2; ++bj)
#pragma unroll
            for (int n = 0; n < 2; ++n) gv[bj][n] = *(const f32x4*)(gate + col0 + bj * HALF + n * 16);
#pragma unroll
        for (int ai = 0; ai < 2; ++ai) { f32x4 xr[4][2][2];
#pragma unroll
            for (int m = 0; m < 4; ++m) { const float* rowp = rsrc + (size_t)(row0 + ai * HALF + m * 16) * DM + col0;
#pragma unroll
                for (int bj = 0; bj < 2; ++bj)
#pragma unroll
                    for (int n = 0; n < 2; ++n) xr[m][bj][n] = *(const f32x4*)(rowp + bj * HALF + n * 16); }
#pragma unroll
            for (int m = 0; m < 4; ++m) { float* rowp = X + (size_t)(row0 + ai * HALF + m * 16) * DM + col0;
#pragma unroll
                for (int bj = 0; bj < 2; ++bj)
#pragma unroll
                    for (int n = 0; n < 2; ++n) *(f32x4*)(rowp + bj * HALF + n * 16) = xr[m][bj][n] * ALPHA_DN + gv[bj][n] * acc[ai][bj][m][n]; } }
    }
};
struct EpiSwiGLU {
    bf16_t* HID;
    __device__ __forceinline__ void operator()(const f32x4 (&acc)[2][2][4][2], const Unit& u, int wr, int wc, int fr, int fq) const {
        const int row0 = u.pm * BM + wr * 64 + fr, f0 = u.pn * HALF + wc * 32 + 4 * fq;
#pragma unroll
        for (int ai = 0; ai < 2; ++ai) if (ai == 0 || !u.hf)
#pragma unroll
            for (int m = 0; m < 4; ++m) { bf16_t* rowp = HID + (size_t)(row0 + ai * HALF + m * 16) * D_EXP + u.pn * HALF + wc * 32 + colw_of(fq); f32x4 hh[2];
#pragma unroll
                for (int n = 0; n < 2; ++n) { const f32x4 a = acc[ai][0][m][n], b = acc[ai][1][m][n];
#pragma unroll
                    for (int j = 0; j < 4; ++j) hh[n][j] = a[j] * __builtin_amdgcn_rcpf(1.f + __expf(-a[j])) * b[j]; }
                st_pair_bf16(rowp, hh[0], hh[1]); }
    }
};
struct EpiYE {
    bf16_t* YE; const float* gate;
    __device__ __forceinline__ void operator()(const f32x4 (&acc)[2][2][4][2], const Unit& u, int wr, int wc, int fr, int fq) const {
        const int row0 = u.pm * BM + wr * 64 + fr, col0 = u.pn * BM + wc * 32 + 4 * fq;
        float gts[2][4];
#pragma unroll
        for (int ai = 0; ai < 2; ++ai)
#pragma unroll
            for (int m = 0; m < 4; ++m) gts[ai][m] = gate[row0 + ai * HALF + m * 16];
#pragma unroll
        for (int ai = 0; ai < 2; ++ai) if (ai == 0 || !u.hf)
#pragma unroll
            for (int m = 0; m < 4; ++m) { const int row = row0 + ai * HALF + m * 16; const float gt = gts[ai][m]; bf16_t* rowp = YE + (size_t)row * DM + (col0 - 4 * fq + colw_of(fq));
#pragma unroll
                for (int bj = 0; bj < 2; ++bj) st_pair_bf16(rowp + bj * HALF, acc[ai][bj][m][0] * gt, acc[ai][bj][m][1] * gt); }
    }
};
struct EpiLora {
    unsigned char* SCN; bf16_t* G; const float* decay0; const float* a0; const float* kalpha;
    __device__ __forceinline__ void operator()(const f32x4 (&acc)[2][2][4][2], const Unit& u, int wr, int wc, int fr, int fq) const {
        const int row0 = u.pm * BM + wr * 64 + fr;
        const int seg = u.pn / 3, cb = (u.pn % 3) * BM + wc * 32 + 4 * fq, cw = colw_of(fq) - 4 * fq;
        f32x4 par0[2][2], par1[2][2];
#pragma unroll
        for (int bj = 0; bj < 2; ++bj)
#pragma unroll
            for (int n = 0; n < 2; ++n) { const int col = cb + bj * HALF + n * 16; par0[bj][n] = (f32x4){0.f, 0.f, 0.f, 0.f}; par1[bj][n] = par0[bj][n];
                if (seg < 2) par0[bj][n] = *(const f32x4*)(decay0 + seg * 768 + col);
                else if (seg < 4) { par0[bj][n] = *(const f32x4*)(a0 + (seg - 2) * 768 + col); par1[bj][n] = *(const f32x4*)(kalpha + col); } }
#pragma unroll
        for (int bj = 0; bj < 2; ++bj) {
            const int colA = cb + bj * HALF, head = colA >> 6, kx0 = colA & 63;
            if (seg < 2) {
#pragma unroll
                for (int n = 0; n < 2; ++n) { const f32x4 d0 = par0[bj][n]; const int kx = kx0 + n * 16;
#pragma unroll
                    for (int ai = 0; ai < 2; ++ai)
#pragma unroll
                        for (int m = 0; m < 4; ++m) { const int row = row0 + ai * HALF + m * 16; f32x4 w;
#pragma unroll
                            for (int j = 0; j < 4; ++j) { const float lw = -DECAY_SCALE * sigmoidf_(d0[j] + acc[ai][bj][m][n][j]); w[j] = CHUNKED_SCAN ? lw : __expf(lw); }
                            *(f32x4*)(SCN + (size_t)(row * 12 + head) * SC_REC + SC_W + seg * 256 + kx * 4) = w; __builtin_amdgcn_sched_barrier(0); } }
            } else if (seg < 4) {
                const int d = seg - 2;
#pragma unroll
                for (int ai = 0; ai < 2; ++ai) {
                    u32x2 kkr[2][4], ksr[2][4];
                    u32x4 wk[4], ws_[4];
#pragma unroll
                    for (int m = 0; m < 4; ++m) { const unsigned char* base = SCN + (size_t)((row0 + ai * HALF + m * 16) * 12 + head) * SC_REC + (kx0 + cw) * 2;
                        wk[m] = *(const u32x4*)(base + SC_KK); ws_[m] = *(const u32x4*)(base + SC_KR + 256 * d); }
#pragma unroll
                    for (int m = 0; m < 4; ++m) {
                        { const auto r0 = __builtin_amdgcn_permlane16_swap(wk[m].x, wk[m].z, false, false); const auto r1 = __builtin_amdgcn_permlane16_swap(wk[m].y, wk[m].w, false, false);
                          kkr[0][m].x = r0[0]; kkr[0][m].y = r1[0]; kkr[1][m].x = r0[1]; kkr[1][m].y = r1[1]; }
                        { const auto r0 = __builtin_amdgcn_permlane16_swap(ws_[m].x, ws_[m].z, false, false); const auto r1 = __builtin_amdgcn_permlane16_swap(ws_[m].y, ws_[m].w, false, false);
                          ksr[0][m].x = r0[0]; ksr[0][m].y = r1[0]; ksr[1][m].x = r0[1]; ksr[1][m].y = r1[1]; } }
#pragma unroll
                    for (int m = 0; m < 4; ++m) { const int row = row0 + ai * HALF + m * 16; unsigned char* base = SCN + (size_t)(row * 12 + head) * SC_REC + (kx0 + cw) * 2; f32x4 bb[2], kr[2];
#pragma unroll
                        for (int n = 0; n < 2; ++n) { const f32x4 a00 = par0[bj][n], kal = par1[bj][n];
                            const f32x4 kk = {bflo(kkr[n][m].x), bfhi(kkr[n][m].x), bflo(kkr[n][m].y), bfhi(kkr[n][m].y)}; const f32x4 ks = {bflo(ksr[n][m].x), bfhi(ksr[n][m].x), bflo(ksr[n][m].y), bfhi(ksr[n][m].y)};
#pragma unroll
                            for (int j = 0; j < 4; ++j) { const float a = sigmoidf_(a00[j] + acc[ai][bj][m][n][j]); bb[n][j] = kk[j] * a; kr[n][j] = ks[j] * (1.f + (a - 1.f) * kal[j]); } }
                        st_pair_bf16((bf16_t*)(base + SC_B + 256 * d), bb[0], bb[1]); st_pair_bf16((bf16_t*)(base + SC_KR + 256 * d), kr[0], kr[1]); __builtin_amdgcn_sched_barrier(0); } }
            } else {
#pragma unroll
                for (int ai = 0; ai < 2; ++ai)
#pragma unroll
                    for (int m = 0; m < 4; ++m) { const int row = row0 + ai * HALF + m * 16; st_pair_bf16(G + (size_t)row * 768 + colA + cw, acc[ai][bj][m][0], acc[ai][bj][m][1]); }
            }
        }
    }
};
}

struct Args { const float* in[37]; float* out; unsigned char* ws; int lo, hi; };
enum { I_X = 0, I_C, I_CTX, I_CCTX, I_WMOD, I_BMOD, I_LNG, I_LNB, I_EWIN, I_EWOUT, I_CONVW, I_MU, I_DUP, I_D0, I_AUP, I_A0, I_GUP, I_KXI, I_KAL, I_RBON, I_GNG, I_GNB,
       I_OWIN, I_OWOUT, I_LQ1, I_LK1, I_LQ2, I_LK2, I_SUBG, I_GLNG, I_GLNB, I_GWS, I_GBS, I_WR, I_WE1, I_WE3, I_WE2 };

struct Ctx {
    LAS unsigned char* lds;
    int tid, lane, wave, G, vcu, gw, NGW;
};
__device__ __forceinline__ void mkctx(Ctx& C, LAS unsigned char* lds) {
    int tid = threadIdx.x; asm volatile("" : "+v"(tid));
    C.lds = lds; C.tid = tid; C.lane = tid & 63; C.wave = __builtin_amdgcn_readfirstlane(tid >> 6);
    C.G = gridDim.x; { const int bx = blockIdx.x; C.vcu = (C.G % 8 == 0) ? (bx % 8) * (C.G / 8) + bx / 8 : bx; }
    C.gw = blockIdx.x * NWAVES + C.wave; C.NGW = C.G * NWAVES;
}
#define GLOBAL_PTR(T, v) ((T*)(__attribute__((address_space(1))) T*)(v))
__device__ __forceinline__ void ldargs(Args& A, LAS unsigned char* lds) {
    LAS const u32x2* tb = (LAS const u32x2*)(lds + LDS_PTAB); asm volatile("" : "+v"(tb));
#pragma unroll
    for (int i = 0; i < 37; ++i) { const u32x2 v = tb[i]; A.in[i] = GLOBAL_PTR(const float, ((unsigned long long)(unsigned)__builtin_amdgcn_readfirstlane((int)v.y) << 32) | (unsigned)__builtin_amdgcn_readfirstlane((int)v.x)); }
    { const u32x2 v = tb[37]; A.out = GLOBAL_PTR(float, ((unsigned long long)(unsigned)__builtin_amdgcn_readfirstlane((int)v.y) << 32) | (unsigned)__builtin_amdgcn_readfirstlane((int)v.x)); }
    { const u32x2 v = tb[38]; A.ws = GLOBAL_PTR(unsigned char, ((unsigned long long)(unsigned)__builtin_amdgcn_readfirstlane((int)v.y) << 32) | (unsigned)__builtin_amdgcn_readfirstlane((int)v.x)); }
    A.lo = 0; A.hi = 0;
}
__device__ __forceinline__ int row_mi(int row) { return row < NLAT ? (row >> 13) : 4; }

__device__ __forceinline__ void phase_init(const Ctx& C, const Args& A) {
    unsigned char* ws = A.ws;
    float* MOD = (float*)(ws + WS_MOD);
    LAS float* sv = (LAS float*)C.lds;
    LAS float* red = sv + 5 * 1024;
    for (int i = C.tid; i < 5 * 1024; i += NTHR) { const int v = i >> 10, k = i & 1023; const float c = (v < 4) ? A.in[I_C][v * DM + k] : A.in[I_CCTX][k]; sv[i] = c / (1.f + __expf(-c)); }
    __syncthreads();
    const int j = C.tid & 127, kp = C.tid >> 7;
    for (int it = blockIdx.x; it < DEPTH * 48; it += C.G) {
        const int l = it / 48, cg = it % 48, col = cg * 128 + j;
        const float* W = A.in[I_WMOD] + (size_t)l * DM * 6144 + col;
        float a0 = 0.f, a1 = 0.f, a2 = 0.f, a3 = 0.f, a4 = 0.f;
#pragma unroll 32
        for (int k = kp * 256; k < kp * 256 + 256; ++k) { const float w = W[(size_t)k * 6144];     a0 += sv[k] * w; a1 += sv[1024 + k] * w; a2 += sv[2048 + k] * w; a3 += sv[3072 + k] * w; a4 += sv[4096 + k] * w; }
        red[(kp * 5 + 0) * 128 + j] = a0; red[(kp * 5 + 1) * 128 + j] = a1; red[(kp * 5 + 2) * 128 + j] = a2; red[(kp * 5 + 3) * 128 + j] = a3; red[(kp * 5 + 4) * 128 + j] = a4;
        __syncthreads();
        for (int o = C.tid; o < 5 * 128; o += NTHR) { const int v = o >> 7, jj = o & 127; const int cc = cg * 128 + jj;
            const float s = red[(0 * 5 + v) * 128 + jj] + red[(1 * 5 + v) * 128 + jj] + red[(2 * 5 + v) * 128 + jj] + red[(3 * 5 + v) * 128 + jj];
            MOD[((size_t)l * 5 + v) * 6144 + cc] = s + A.in[I_BMOD][l * 6144 + cc]; }
        __syncthreads();
    }
    if (blockIdx.x == C.G - 1) { float* rope = (float*)(ws + WS_ROPE);
        for (int i = C.tid; i < 192 * 16; i += NTHR) { const int pos = i >> 4, j = i & 15; const float ang = (float)(pos < 128 ? pos : pos - 128) * powf(10000.f, -(float)j * (1.f / 16.f));
            rope[i] = cosf(ang); rope[192 * 16 + i] = sinf(ang); } }
}

__device__ __forceinline__ void transpose_item(const float* W, int ldw, int k0, int n0, bf16_t* WT, int ldt, int drow0, LAS float* scr, int lane) {
    { float v[64]; const float* src = W + (size_t)k0 * ldw + n0 + lane;
#pragma unroll
      for (int k = 0; k < 64; ++k) v[k] = __builtin_nontemporal_load(src + (size_t)k * ldw);
#pragma unroll
      for (int k = 0; k < 64; ++k) scr[k * 65 + lane] = v[k]; }
    asm volatile("s_waitcnt lgkmcnt(0)" ::: "memory");
    const int c = lane & 7;
#pragma unroll
    for (int j = 0; j < 8; ++j) { const int n = (lane >> 3) + 8 * j; const LAS float* s = scr + (8 * c) * 65 + n;
        u32x4 o; o.x = pk2(s[0 * 65], s[1 * 65]); o.y = pk2(s[2 * 65], s[3 * 65]); o.z = pk2(s[4 * 65], s[5 * 65]); o.w = pk2(s[6 * 65], s[7 * 65]);
        *(u32x4*)(WT + (size_t)(drow0 + n) * ldt + k0 + 8 * c) = o; }
    asm volatile("s_waitcnt lgkmcnt(0)" ::: "memory");
}
constexpr int XW_IN_HI = 3200, XW_OUT_HI = 7040, XW_TK_HI = 9088;
constexpr int YW_IN_HI = 1344, YW_OF_HI = 6144, YW_OUT_HI = 9984, YW_TK_HI = 12032;
__device__ __forceinline__ void conv_items(const Ctx& C, const Args& A, int l, int gw, int NGW, bool do_in, bool do_out, bool do_exp, int lo = 0, int hi = 1 << 30) {
    unsigned char* ws = A.ws;
    const int i2 = l >> 1; const bool odd = (l & 1);
    LAS float* scr = (LAS float*)C.lds + C.wave * (64 * 65);
    bf16_t* WIN = (bf16_t*)(ws + WS_WIN); bf16_t* WOUT = (bf16_t*)(ws + WS_WOUT); bf16_t* WE13 = (bf16_t*)(ws + WS_WE13 + (size_t)(l & 1) * WE13_BYTES); bf16_t* WE2 = (bf16_t*)(ws + WS_WE2 + (size_t)(l & 1) * WE2_BYTES);
    const int nin = odd ? D_IN_ODD : D_IN_EVEN;
    const float* win = odd ? A.in[I_OWIN] + (size_t)i2 * DM * D_IN_ODD : A.in[I_EWIN] + (size_t)i2 * DM * D_IN_EVEN;
    const float* wout = odd ? A.in[I_OWOUT] + (size_t)i2 * DM * DM : A.in[I_EWOUT] + (size_t)i2 * DM * DM;
    const int n_in = do_in ? 16 * (nin / 64) : 0, n_out = do_out ? 16 * 16 : 0, n_e13 = do_exp ? NEXP * 2 * 16 * 32 : 0, n_e2 = do_exp ? NEXP * 32 * 16 : 0;
    const int total = (n_in + n_out + n_e13 + n_e2) < hi ? (n_in + n_out + n_e13 + n_e2) : hi;
    for (int it = lo + gw; it < total; it += NGW) {
        int r = it;
        if (r < n_in) { const int nb = nin / 64, kb = r / nb, nn = r % nb; transpose_item(win, nin, kb * 64, nn * 64, WIN, DM, nn * 64, scr, C.lane); continue; } r -= n_in;
        if (r < n_out) { const int kb = r / 16, nn = r % 16; transpose_item(wout, DM, kb * 64, nn * 64, WOUT, DM, nn * 64, scr, C.lane); continue; } r -= n_out;
        if (r < n_e13) { const int e = r / 1024, q = r % 1024, mat = q / 512, q2 = q % 512, kb = q2 / 32, nn = q2 % 32;
            const float* W = (mat ? A.in[I_WE3] : A.in[I_WE1]) + ((size_t)l * NEXP + e) * DM * D_EXP;
            const int f0 = nn * 64; const int drow = (f0 >> 7) * 256 + mat * 128 + (f0 & 127);
            transpose_item(W, D_EXP, kb * 64, f0, WE13 + (size_t)e * 4096 * DM, DM, drow, scr, C.lane); continue; } r -= n_e13;
        { const int e = r / 512, q = r % 512, kb = q / 16, nn = q % 16;
            const float* W = A.in[I_WE2] + ((size_t)l * NEXP + e) * D_EXP * DM;
            transpose_item(W, DM, kb * 64, nn * 64, WE2 + (size_t)e * DM * D_EXP, D_EXP, nn * 64, scr, C.lane); }
    }
}
__device__ __forceinline__ void phase_conv(const Ctx& C, const Args& A, int l) {
    unsigned char* ws = A.ws;
    const int i2 = l >> 1; const bool odd = (l & 1);
    bf16_t* WIN = (bf16_t*)(ws + WS_WIN);
    const bool early = CHUNKED_SCAN && odd;
    if (l > 0) { if (early || !CHUNKED_SCAN) conv_items(C, A, l, C.gw, C.NGW, !early, true, !early);
                 else { conv_items(C, A, l, C.gw, C.NGW, true, true, false); conv_items(C, A, l, C.gw, C.NGW, false, false, true, YW_TK_HI); } }
    if (!odd) {
        u32x4* z = (u32x4*)(WIN + (size_t)D_IN_EVEN * DM);
        unsigned zz = 0u; asm volatile("" : "+v"(zz));
        for (int i = blockIdx.x * NTHR + C.tid; i < (D_IN_EVEN_PAD - D_IN_EVEN) * DM / 8; i += C.G * NTHR) z[i] = (u32x4){zz, zz, zz, zz};
        bf16_t* WL = (bf16_t*)(ws + WS_WLORA);
        const float* dup = A.in[I_DUP] + (size_t)i2 * 2 * 64 * 768; const float* aup = A.in[I_AUP] + (size_t)i2 * 2 * 64 * 768; const float* gup = A.in[I_GUP] + (size_t)i2 * 128 * 768;
        for (int i = blockIdx.x * NTHR + C.tid; i < LORA_N * LORA_K; i += C.G * NTHR) {
            const int kk = i / LORA_N, n = i % LORA_N, seg = n / 768, col = n % 768; float v = 0.f;
            if (seg == 0) { if (kk < 64) v = dup[(size_t)(0 * 64 + kk) * 768 + col]; }
            else if (seg == 1) { if (kk >= 64 && kk < 128) v = dup[(size_t)(1 * 64 + kk - 64) * 768 + col]; }
            else if (seg == 2) { if (kk >= 128 && kk < 192) v = aup[(size_t)(0 * 64 + kk - 128) * 768 + col]; }
            else if (seg == 3) { if (kk >= 192 && kk < 256) v = aup[(size_t)(1 * 64 + kk - 192) * 768 + col]; }
            else { if (kk >= 256) v = gup[(size_t)(kk - 256) * 768 + col]; }
            WL[(size_t)n * LORA_K + kk] = (bf16_t)f2bf(v);
        }
    }
}

__device__ __forceinline__ void phase_modh(const Ctx& C, const Args& A, int l) {
    bf16_t* H = (bf16_t*)(A.ws + WS_H); const float* MOD = (const float*)(A.ws + WS_MOD) + (size_t)l * 5 * 6144;
    const float* xin = A.in[I_X]; const float* cin = A.in[I_CTX] - (size_t)NLAT * DM;
#define MODH_SRC(row_) (((row_) < NLAT ? xin : cin) + (size_t)(row_) * DM)
    const int row0 = (int)(((long)C.gw * MROWS) / C.NGW), row1 = (int)(((long)(C.gw + 1) * MROWS) / C.NGW);
    f32x4 shr[4], scr_[4], xn[4]; int cmi = -1;
    if (row0 < row1) {
#pragma unroll
        for (int j = 0; j < 4; ++j) xn[j] = *(const f32x4*)(MODH_SRC(row0) + 4 * C.lane + 256 * j); }
#pragma unroll
    for (int j = 0; j < 4; ++j) { shr[j] = (f32x4){0.f, 0.f, 0.f, 0.f}; scr_[j] = shr[j]; }
    for (int row = row0; row < row1; ++row) {
        const int mi = row_mi(row);
        if (mi != cmi) { cmi = mi; const float* md = MOD + mi * 6144;
#pragma unroll
            for (int j = 0; j < 4; ++j) { const int col = 4 * C.lane + 256 * j; shr[j] = *(const f32x4*)(md + col); scr_[j] = *(const f32x4*)(md + DM + col) + 1.f; } }
        f32x4 x[4];
#pragma unroll
        for (int j = 0; j < 4; ++j) x[j] = xn[j];
        if (row + 1 < row1) {
#pragma unroll
            for (int j = 0; j < 4; ++j) xn[j] = *(const f32x4*)(MODH_SRC(row + 1) + 4 * C.lane + 256 * j); }
#pragma unroll
        for (int j = 0; j < 4; ++j) { const int col = 4 * C.lane + 256 * j; const f32x4 h = x[j] * scr_[j] + shr[j]; u32x2 o; o.x = pk2(h[0], h[1]); o.y = pk2(h[2], h[3]); *(u32x2*)(H + (size_t)row * DM + col) = o; }
    }
}

__device__ __forceinline__ f32x4 ld4bf(const bf16_t* p) { const u32x2 u = *(const u32x2*)p; return (f32x4){bflo(u.x), bfhi(u.x), bflo(u.y), bfhi(u.y)}; }
__device__ __forceinline__ void st4bf(bf16_t* p, f32x4 v) { u32x2 o; o.x = pk2(v[0], v[1]); o.y = pk2(v[2], v[3]); *(u32x2*)p = o; }
__device__ __forceinline__ void seq_info(int row, bool& hasp, bool& hasn) {
    if (row < NLAT) { const int t = row & (TT - 1); hasp = t > 0; hasn = t < TT - 1; }
    else { const int t = (row - NLAT) & (CTXL - 1); hasp = t > 0; hasn = t < CTXL - 1; }
}
struct Ef1Row { u32x2 bg, ua, ub, m[11]; };
__device__ __forceinline__ f32x4 bf4(u32x2 u) { return (f32x4){bflo(u.x), bfhi(u.x), bflo(u.y), bfhi(u.y)}; }
__device__ __forceinline__ void ef1_load(Ef1Row& R, const bf16_t* P, int row, int lane) {
    row = row < 0 ? 0 : row > MROWS - 1 ? MROWS - 1 : row;
    const bf16_t* p = P + (size_t)row * P_LD + 4 * lane;
    R.bg = *(const u32x2*)p; R.ua = *(const u32x2*)(p + 256); R.ub = *(const u32x2*)(p + 512);
#pragma unroll
    for (int it = 0; it < 11; ++it) R.m[it] = *(const u32x2*)(p + 768 + it * 256);
}
__device__ __forceinline__ void phase_ef1(const Ctx& C, const Args& A, int l) {
    const int i2 = l >> 1; unsigned char* ws = A.ws;
    const bf16_t* P = (const bf16_t*)(ws + WS_P); bf16_t* A2 = (bf16_t*)(ws + WS_A2); unsigned char* SCN = ws + WS_SCN; bf16_t* LIN = (bf16_t*)(ws + WS_LIN);
    const float* cw = A.in[I_CONVW] + (size_t)i2 * 3 * 256; const float* mu = A.in[I_MU] + (size_t)i2 * RWKV_COLS; const float* kxi = A.in[I_KXI] + (size_t)i2 * 768;
    const int j4 = 4 * C.lane;
    const f32x4 w0 = *(const f32x4*)(cw + j4), w1 = *(const f32x4*)(cw + 256 + j4), w2 = *(const f32x4*)(cw + 512 + j4);
    f32x4 mur[11], kxr[3];
#pragma unroll
    for (int it = 0; it < 11; ++it) mur[it] = (it * 256 + j4 < RWKV_COLS) ? *(const f32x4*)(mu + it * 256 + j4) : (f32x4){0.f, 0.f, 0.f, 0.f};
#pragma unroll
    for (int it = 0; it < 3; ++it) kxr[it] = *(const f32x4*)(kxi + it * 256 + j4);
    const int row0 = (int)(((long)C.gw * MROWS) / C.NGW), row1 = (int)(((long)(C.gw + 1) * MROWS) / C.NGW);
    Ef1Row Ra, Rb, Rc, Rd;
    ef1_load(Ra, P, row0 - 1, C.lane); ef1_load(Rb, P, row0, C.lane); ef1_load(Rc, P, row0 + 1, C.lane);
    for (int row = row0; row < row1; ++row) {
        ef1_load(Rd, P, row + 2, C.lane);
        bool hasp, hasn; seq_info(row, hasp, hasn);
        const float fp = hasp ? 1.f : 0.f, fn = hasn ? 1.f : 0.f;
        {
            const f32x4 bg = bf4(Rb.bg), u0 = bf4(Rb.ua) * bf4(Rb.ub), um = bf4(Ra.ua) * bf4(Ra.ub) * fp, up = bf4(Rc.ua) * bf4(Rc.ub) * fn;
            st4bf(A2 + (size_t)row * DM + j4, bg * (w0 * um + w1 * u0 + w2 * up));
        }
#pragma unroll
        for (int it = 0; it < 11; ++it) {
            const int c = it * 256 + j4;
            if (c < RWKV_COLS) {
                const f32x4 x0 = bf4(Rb.m[it]), xm = bf4(Ra.m[it]) * fp, xp = bf4(Rc.m[it]) * fn, m4 = mur[it];
                const f32x4 ps = x0 + m4 * ((xm + xp) * 0.5f - x0);
                if (it < 3) { const int head = c >> 6, kx = c & 63; st4bf_(SCN + (size_t)(row * 12 + head) * SC_REC + SC_R + kx * 2, ps); }
                else if (it < 6) { const int c1 = c - 768, head = c1 >> 6, kx = c1 & 63; const f32x4 kv = ps * kxr[it < 6 ? (it >= 3 ? it - 3 : 0) : 0];
                    const float ss = sum16(kv[0] * kv[0] + kv[1] * kv[1] + kv[2] * kv[2] + kv[3] * kv[3]); const float rn = rsqrtf(ss + 1e-12f);
                    unsigned char* base = SCN + (size_t)(row * 12 + head) * SC_REC + kx * 2;
                    st4bf_(base + SC_KK, kv * rn); st4bf_(base + SC_KR, ps); st4bf_(base + SC_KR + 256, ps); }
                else if (it < 9) { const int c1 = c - 1536, head = c1 >> 6, kx = c1 & 63; st4bf_(SCN + (size_t)(row * 12 + head) * SC_REC + SC_V + kx * 2, ps); }
                else { const int c1 = c - 2304; f32x4 o;
                    if (c1 < 128) { o = (f32x4){tanh_fast(ps[0]), tanh_fast(ps[1]), tanh_fast(ps[2]), tanh_fast(ps[3])}; }
                    else if (c1 < 256) { o = ps; }
                    else { o = (f32x4){sigmoidf_(ps[0]), sigmoidf_(ps[1]), sigmoidf_(ps[2]), sigmoidf_(ps[3])}; }
                    st4bf(LIN + (size_t)row * LORA_K + c1, o); }
            }
        }
        Ra = Rb; Rb = Rc; Rc = Rd;
    }
}

__device__ __forceinline__ int scan_row(int i, int b, int d) {
    if (d == 0) return i < CTXL ? NLAT + b * CTXL + i : b * TT + (i - CTXL);
    return i < CTXL ? NLAT + b * CTXL + (CTXL - 1 - i) : b * TT + (TT - 1 - (i - CTXL));
}
__device__ __forceinline__ float red8(float v) {
    v += __uint_as_float((unsigned)__builtin_amdgcn_update_dpp(0, (int)__float_as_uint(v), 0xB1, 0xF, 0xF, true));
    v += __uint_as_float((unsigned)__builtin_amdgcn_update_dpp(0, (int)__float_as_uint(v), 0x4E, 0xF, 0xF, true));
    v += __uint_as_float((unsigned)__builtin_amdgcn_update_dpp(0, (int)__float_as_uint(v), 0x141, 0xF, 0xF, true));
    return v;
}
__device__ __forceinline__ float red16(float v) {
    v += __uint_as_float((unsigned)__builtin_amdgcn_update_dpp(0, (int)__float_as_uint(v), 0xB1, 0xF, 0xF, true));
    v += __uint_as_float((unsigned)__builtin_amdgcn_update_dpp(0, (int)__float_as_uint(v), 0x4E, 0xF, 0xF, true));
    v += __uint_as_float((unsigned)__builtin_amdgcn_update_dpp(0, (int)__float_as_uint(v), 0x141, 0xF, 0xF, true));
    v += __uint_as_float((unsigned)__builtin_amdgcn_update_dpp(0, (int)__float_as_uint(v), 0x140, 0xF, 0xF, true));
    return v;
}
__device__ __forceinline__ void phase_scan(const Ctx& C, const Args& A) {
    for (int u = blockIdx.x; u < 192; u += C.G) {
    const int half = u & 1, d = (u >> 1) & 1, h = (u >> 2) % 12, b = u / 48;
    const unsigned char* SCN = A.ws + WS_SCN; float* Y = (float*)(A.ws + WS_Y) + (size_t)d * MROWS * 768;
    LAS float* buf = (LAS float*)C.lds; LAS float* ybuf = buf + 2 * 32 * 352;
    constexpr int NCH = LKEYS / 32;
    u32x4 st[4];
    int ps_[4], psrc[4], pdst[4]; bool pf32[4];
#pragma unroll
    for (int j = 0; j < 4; ++j) { const int p = C.tid + NTHR * j; const int s = p / 52, q = p % 52; ps_[j] = s;
        if (q < 16) { psrc[j] = SC_W + 256 * d + q * 16; pdst[j] = s * 352 + q * 4; pf32[j] = true; }
        else if (q < 48) { const int vec = (q - 16) >> 3, part = (q - 16) & 7; const int so = vec == 0 ? SC_KK : vec == 1 ? SC_B + 256 * d : vec == 2 ? SC_KR + 256 * d : SC_R;
            psrc[j] = so + part * 16; pdst[j] = s * 352 + 64 * (vec + 1) + part * 8; pf32[j] = false; }
        else { const int part = q - 48; psrc[j] = SC_V + half * 64 + part * 16; pdst[j] = s * 352 + 320 + part * 8; pf32[j] = false; } }
    const int sgn = d ? -1 : 1;
    const unsigned char* SCNh = SCN + (size_t)h * SC_REC;
#define SCAN_ROW0(c) (((c) * 32 < CTXL) ? (NLAT + b * CTXL + (d ? CTXL - 1 - (c) * 32 : (c) * 32)) : (b * TT + (d ? TT - 1 - ((c) * 32 - CTXL) : (c) * 32 - CTXL)))
#define SCAN_LOADG(c) do { const int row0_ = SCAN_ROW0(c); _Pragma("unroll") for (int j = 0; j < 4; ++j) if (j < 3 || C.tid < 1664 - 3 * NTHR) { \
        st[j] = *(const u32x4*)(SCNh + (size_t)(row0_ + sgn * ps_[j]) * SC_ROW + psrc[j]); } } while (0)
#define SCAN_STORE(bi) do { _Pragma("unroll") for (int j = 0; j < 4; ++j) if (j < 3 || C.tid < 1664 - 3 * NTHR) { LAS float* dp = buf + (bi) * (32 * 352) + pdst[j]; \
        if (pf32[j]) *(LAS u32x4*)dp = st[j]; \
        else { *(LAS f32x4*)dp = (f32x4){bflo(st[j].x), bfhi(st[j].x), bflo(st[j].y), bfhi(st[j].y)}; *(LAS f32x4*)(dp + 4) = (f32x4){bflo(st[j].z), bfhi(st[j].z), bflo(st[j].w), bfhi(st[j].w)}; } } } while (0)
    SCAN_LOADG(0); SCAN_STORE(0); __syncthreads();
    f32x2 Sa = {0.f, 0.f}, Sb = {0.f, 0.f};
    const int rl = C.lane >> 4, ks = C.lane & 15;
    float ycol = 0.f;
#define SC_LD(R, s) do { const LAS float* bp_ = cur + (s) * 352 + ks * 4; \
        R##w = *(const LAS f32x4*)(bp_); R##k = *(const LAS f32x4*)(bp_ + 64); R##b = *(const LAS f32x4*)(bp_ + 128); R##q = *(const LAS f32x4*)(bp_ + 192); R##r = *(const LAS f32x4*)(bp_ + 256); \
        R##vv = cur[(s) * 352 + 320 + C.wave * 4 + rl]; } while (0)
#define SC_LO(v) ((f32x2){v[0], v[1]})
#define SC_HI(v) ((f32x2){v[2], v[3]})
#define SC_DPP(x, ctrl) __uint_as_float((unsigned)__builtin_amdgcn_update_dpp(0, (int)__float_as_uint(x), ctrl, 0xF, 0xF, true))
#define SC_STEP(R, P, s) do { \
        f32x2 pa = __builtin_elementwise_fma(Sb, SC_HI(R##k), Sa * SC_LO(R##k)), py = __builtin_elementwise_fma(Sb, SC_HI(P##r), Sa * SC_LO(P##r)); \
        float a_ = pa.x + pa.y, y_ = py.x + py.y; \
        a_ += SC_DPP(a_, 0xB1); y_ += SC_DPP(y_, 0xB1); a_ += SC_DPP(a_, 0x4E); y_ += SC_DPP(y_, 0x4E); \
        a_ += SC_DPP(a_, 0x141); y_ += SC_DPP(y_, 0x141); a_ += SC_DPP(a_, 0x140); y_ += SC_DPP(y_, 0x140); \
        ycol = (ks == ((s) & 15)) ? y_ : ycol; \
        const f32x2 na = {-a_, -a_}, vv2 = {R##vv, R##vv}; \
        Sa = __builtin_elementwise_fma(Sa, SC_LO(R##w), __builtin_elementwise_fma(na, SC_LO(R##b), vv2 * SC_LO(R##q))); \
        Sb = __builtin_elementwise_fma(Sb, SC_HI(R##w), __builtin_elementwise_fma(na, SC_HI(R##b), vv2 * SC_HI(R##q))); } while (0)
    f32x4 Aw, Ak, Ab, Aq, Ar, Bw, Bk, Bb, Bq, Br, Cw, Ck, Cb, Cq, Cr, Dw, Dk, Db, Dq, Dr; float Avv, Bvv, Cvv, Dvv;
    Dr = (f32x4){0.f, 0.f, 0.f, 0.f};
    for (int c = 0; c < NCH; ++c) {
        if (c + 1 < NCH) SCAN_LOADG(c + 1);
        {
            const LAS float* cur = buf + (c & 1) * (32 * 352);
            LAS float* yb = ybuf + (c & 1) * 1024 + C.wave * 4 + rl + ks * 32;
            SC_LD(A, 0); SC_LD(B, 1);
#pragma unroll 1
            for (int s = 0; s < 32; s += 4) {
                SC_LD(C, s + 2); __builtin_amdgcn_sched_barrier(0); SC_STEP(A, D, s); __builtin_amdgcn_sched_barrier(0);
                SC_LD(D, s + 3); __builtin_amdgcn_sched_barrier(0); SC_STEP(B, A, s + 1); __builtin_amdgcn_sched_barrier(0);
                SC_LD(A, s + 4); __builtin_amdgcn_sched_barrier(0); SC_STEP(C, B, s + 2); __builtin_amdgcn_sched_barrier(0);
                SC_LD(B, s + 5); __builtin_amdgcn_sched_barrier(0); SC_STEP(D, C, s + 3); __builtin_amdgcn_sched_barrier(0);
                if ((s & 15) == 12) yb[(s & 16) * 32] = ycol;
            }
        }
        if (c + 1 < NCH) SCAN_STORE((c + 1) & 1);
        __syncthreads();
        { const int row0_ = SCAN_ROW0(c);
#pragma unroll
          for (int i = 0; i < 2; ++i) { const int e = C.tid + NTHR * i, s = e >> 5, r = e & 31;
            const int row = (s > 0) ? row0_ + sgn * (s - 1) : scan_row(c * 32 - 1, b, d);
            if (s > 0 || c > 0) Y[(size_t)row * 768 + h * 64 + half * 32 + r] = ybuf[(c & 1) * 1024 + e]; } }
    }
    {
        f32x2 py = __builtin_elementwise_fma(Sb, SC_HI(Dr), Sa * SC_LO(Dr)); float y_ = py.x + py.y;
        y_ += SC_DPP(y_, 0xB1); y_ += SC_DPP(y_, 0x4E); y_ += SC_DPP(y_, 0x141); y_ += SC_DPP(y_, 0x140);
        if (ks == 0) Y[(size_t)scan_row(LKEYS - 1, b, d) * 768 + h * 64 + half * 32 + C.wave * 4 + rl] = y_;
    }
    __syncthreads();
    }
#undef SCAN_LOADG
#undef SCAN_STORE
#undef SCAN_ROW0
#undef SC_LD
#undef SC_STEP
#undef SC_LO
#undef SC_HI
#undef SC_DPP
}

constexpr int CSP = 72;
constexpr int CS_MAT = 64 * CSP * 2;
constexpr int CS_WT = 0, CS_KB = CS_MAT, CS_BB = 2 * CS_MAT, CS_RT = 3 * CS_MAT, CS_BHT = 4 * CS_MAT, CS_KHT = 5 * CS_MAT, CS_VMT = 6 * CS_MAT;
constexpr int CS_M2F = 7 * CS_MAT;
constexpr int CS_M1T = CS_M2F + 16384;
constexpr int CS_N2 = CS_M1T + CS_MAT;
constexpr int CS_GT = CS_N2 + CS_MAT;
constexpr int CS_Z = CS_M2F, CS_U = CS_M2F + CS_MAT;
constexpr int CS_GL = CS_GT + 2 * CS_MAT;
static_assert(CS_GL + 256 <= LDS_MISC, "chunked-scan LDS map");
template <bool SWZB = false>
__device__ __forceinline__ void cs_mma(f32x16& acc, const LAS unsigned char* Am, const LAS unsigned char* Bm, int ti, int tj, int r32, int hi) {
    const LAS unsigned char* ap = Am + (ti * 32 + r32) * (CSP * 2) + hi * 16; const int brow = tj * 32 + r32; const LAS unsigned char* bp = Bm + brow * (CSP * 2);
    const int sw = SWZB ? ((brow >> 3) & 7) : 0;
#pragma unroll
    for (int ks = 0; ks < 4; ++ks) acc = __builtin_amdgcn_mfma_f32_32x32x16_bf16(*(const LAS bf16x8*)(ap + ks * 32), *(const LAS bf16x8*)(bp + (((ks * 2 + hi) ^ sw) * 16)), acc, 0, 0, 0);
}
__device__ __forceinline__ void cs_store_t(LAS unsigned char* Om, const f32x16& acc, int ti, int tj, int r32, int hi) {
    LAS unsigned char* op = Om + (tj * 32 + r32) * (CSP * 2) + (ti * 32 + 4 * hi) * 2;
#pragma unroll
    for (int g = 0; g < 4; ++g) { u32x2 o; o.x = pk2(acc[4 * g], acc[4 * g + 1]); o.y = pk2(acc[4 * g + 2], acc[4 * g + 3]); *(LAS u32x2*)(op + g * 16) = o; }
}
#define CS_BAR() asm volatile("s_waitcnt lgkmcnt(0)\n\ts_barrier" ::: "memory")
__device__ __forceinline__ void phase_csa(const Ctx& C, const Args& A) {
    const unsigned char* SCN = A.ws + WS_SCN; unsigned char* CHK = A.ws + WS_CHK;
    LAS unsigned char* L = C.lds;
    const int r32 = C.lane & 31, hi = C.lane >> 5;
    float lwv[8]; u32x4 ukk, ub, ukr, ur, uv;
#define CSA_GEOM(cu_) const int unit = (cu_) / CS_NCH, ch = (cu_) % CS_NCH; const int d = unit & 1, h = (unit >> 1) % 12, b = unit / 24; \
        const int step0 = ch * CS_L; const int sgn = d ? -1 : 1; \
        const int row0 = (step0 < CTXL) ? (NLAT + b * CTXL + (d ? CTXL - 1 - step0 : step0)) : (b * TT + (d ? TT - 1 - (step0 - CTXL) : step0 - CTXL)); \
        const unsigned char* rec0 = SCN + (size_t)row0 * SC_ROW + (size_t)h * SC_REC;
#define CSA_LOAD(cu_) do { CSA_GEOM(cu_); \
        { const int k = C.tid & 63, sg = C.tid >> 6; _Pragma("unroll") for (int j = 0; j < 8; ++j) lwv[j] = *(const float*)(rec0 + (long)sgn * (8 * sg + j) * SC_ROW + SC_W + 256 * d + k * 4); } \
        { const int t = C.tid >> 3, k0 = (C.tid & 7) * 8; const unsigned char* rp = rec0 + (long)sgn * t * SC_ROW; \
          ukk = *(const u32x4*)(rp + SC_KK + k0 * 2); ub = *(const u32x4*)(rp + SC_B + 256 * d + k0 * 2); ukr = *(const u32x4*)(rp + SC_KR + 256 * d + k0 * 2); ur = *(const u32x4*)(rp + SC_R + k0 * 2); uv = *(const u32x4*)(rp + SC_V + k0 * 2); } } while (0)
    if ((int)blockIdx.x < CS_UNITS * CS_NCH) CSA_LOAD((int)blockIdx.x);
    for (int cu = blockIdx.x; cu < CS_UNITS * CS_NCH; cu += C.G) {
        LAS float* csf = (LAS float*)(L + CS_M2F);
        LAS float* seg = (LAS float*)(L + CS_N2);
        { const int k = C.tid & 63, sg = C.tid >> 6;
#pragma unroll
          for (int j = 1; j < 8; ++j) lwv[j] += lwv[j - 1];
          seg[sg * 64 + k] = lwv[7];
          CS_BAR();
          float off = 0.f, tot = 0.f;
#pragma unroll
          for (int s2 = 0; s2 < 8; ++s2) { const float v = seg[s2 * 64 + k]; off += (s2 < sg) ? v : 0.f; tot += v; }
#pragma unroll
          for (int j = 0; j < 8; ++j) csf[(8 * sg + j) * 65 + k] = lwv[j] + off;
          if (sg == 7) ((LAS float*)(L + CS_GL))[k] = __expf(tot); }
        CS_BAR();
        { const int t = C.tid >> 3, k0 = (C.tid & 7) * 8;
          float wt[8], kb[8], bb[8], rt[8], bh[8], kh[8];
#pragma unroll
          for (int j = 0; j < 8; ++j) { const unsigned pkk = j < 2 ? ukk.x : j < 4 ? ukk.y : j < 6 ? ukk.z : ukk.w, pb = j < 2 ? ub.x : j < 4 ? ub.y : j < 6 ? ub.z : ub.w, pkr = j < 2 ? ukr.x : j < 4 ? ukr.y : j < 6 ? ukr.z : ukr.w, pr = j < 2 ? ur.x : j < 4 ? ur.y : j < 6 ? ur.z : ur.w;
              const float kkv = (j & 1) ? bfhi(pkk) : bflo(pkk), bv = (j & 1) ? bfhi(pb) : bflo(pb), krv = (j & 1) ? bfhi(pkr) : bflo(pkr), rv = (j & 1) ? bfhi(pr) : bflo(pr);
              const float cst = csf[t * 65 + k0 + j], csp = t > 0 ? csf[(t - 1) * 65 + k0 + j] : 0.f, csl = csf[63 * 65 + k0 + j];
              const float einv = __expf(-cst), el = __expf(csl - cst);
              wt[j] = kkv * __expf(csp); kb[j] = krv * einv; bb[j] = bv * einv; rt[j] = rv * __expf(cst); bh[j] = bv * el; kh[j] = krv * el; }
          u32x4 o;
          o.x = pk2(wt[0], wt[1]); o.y = pk2(wt[2], wt[3]); o.z = pk2(wt[4], wt[5]); o.w = pk2(wt[6], wt[7]); *(LAS u32x4*)(L + CS_WT + t * (CSP * 2) + k0 * 2) = o;
          o.x = pk2(kb[0], kb[1]); o.y = pk2(kb[2], kb[3]); o.z = pk2(kb[4], kb[5]); o.w = pk2(kb[6], kb[7]); *(LAS u32x4*)(L + CS_KB + t * (CSP * 2) + k0 * 2) = o;
          o.x = pk2(bb[0], bb[1]); o.y = pk2(bb[2], bb[3]); o.z = pk2(bb[4], bb[5]); o.w = pk2(bb[6], bb[7]); *(LAS u32x4*)(L + CS_BB + t * (CSP * 2) + k0 * 2) = o;
          o.x = pk2(rt[0], rt[1]); o.y = pk2(rt[2], rt[3]); o.z = pk2(rt[4], rt[5]); o.w = pk2(rt[6], rt[7]); *(LAS u32x4*)(L + CS_RT + t * (CSP * 2) + k0 * 2) = o;
#pragma unroll
          for (int j = 0; j < 8; ++j) { const int to = ((((t >> 3) ^ ((k0 >> 3) & 7)) * 8) + (t & 7)) * 2;
              *(LAS bf16_t*)(L + CS_BHT + (k0 + j) * (CSP * 2) + to) = (bf16_t)f2bf(bh[j]); *(LAS bf16_t*)(L + CS_KHT + (k0 + j) * (CSP * 2) + to) = (bf16_t)f2bf(kh[j]);
              const unsigned pv = j < 2 ? uv.x : j < 4 ? uv.y : j < 6 ? uv.z : uv.w; *(LAS bf16_t*)(L + CS_VMT + (k0 + j) * (CSP * 2) + to) = (bf16_t)((j & 1) ? (pv >> 16) : (pv & 0xffffu)); } }
        if (cu + C.G < CS_UNITS * CS_NCH) CSA_LOAD(cu + C.G);
        CS_BAR();
        for (int job = C.wave; job < 12; job += NWAVES) { const int p = job >> 2, ti = (job >> 1) & 1, tj = job & 1;
            f32x16 acc;
#pragma unroll
            for (int i = 0; i < 16; ++i) acc[i] = 0.f;
            if (p == 0) { cs_mma(acc, L + CS_WT, L + CS_BB, ti, tj, r32, hi);
                const int i = tj * 32 + r32; LAS float* mp = (LAS float*)(L + CS_M2F) + i * 64;
#pragma unroll
                for (int reg = 0; reg < 16; ++reg) { const int t = ti * 32 + crow(reg, hi); mp[(t & 3) * 16 + (t >> 2)] = (i < t) ? acc[reg] : 0.f; } }
            else if (p == 1) { cs_mma(acc, L + CS_WT, L + CS_KB, ti, tj, r32, hi);
                const int i = tj * 32 + r32;
#pragma unroll
                for (int reg = 0; reg < 16; ++reg) { const int t = ti * 32 + crow(reg, hi); acc[reg] = (i < t) ? acc[reg] : 0.f; }
                cs_store_t(L + CS_M1T, acc, ti, tj, r32, hi); }
            else { cs_mma(acc, L + CS_BB, L + CS_RT, ti, tj, r32, hi);
                const int t = tj * 32 + r32;
#pragma unroll
                for (int reg = 0; reg < 16; ++reg) { const int i = ti * 32 + crow(reg, hi); acc[reg] = (i <= t) ? acc[reg] : 0.f; }
                cs_store_t(L + CS_N2, acc, ti, tj, r32, hi); } }
        CS_BAR();
        { const int c = C.tid >> 2, q = C.tid & 3; f32x2 acc2[8];
          { const LAS unsigned char* rcol = (c < 64) ? (L + CS_WT + c * 2) : (L + CS_M1T + (c - 64) * (CSP * 2)); const int rstride = (c < 64) ? CSP * 2 : 2;
#pragma unroll
            for (int j = 0; j < 16; ++j) acc2[j >> 1][j & 1] = bf2f(*(const LAS bf16_t*)(rcol + (4 * j + q) * rstride)); }
          const LAS float* m2c = (const LAS float*)(L + CS_M2F) + q * 16;
#pragma clang loop unroll(full)
          for (int i = 0; i < 64; ++i) {
              const float mine = -acc2[i >> 3][(i >> 2) & 1];
              float gi;
              switch (i & 3) { case 0: gi = __uint_as_float((unsigned)__builtin_amdgcn_update_dpp(0, (int)__float_as_uint(mine), 0x00, 0xF, 0xF, true)); break;
                               case 1: gi = __uint_as_float((unsigned)__builtin_amdgcn_update_dpp(0, (int)__float_as_uint(mine), 0x55, 0xF, 0xF, true)); break;
                               case 2: gi = __uint_as_float((unsigned)__builtin_amdgcn_update_dpp(0, (int)__float_as_uint(mine), 0xAA, 0xF, 0xF, true)); break;
                               default: gi = __uint_as_float((unsigned)__builtin_amdgcn_update_dpp(0, (int)__float_as_uint(mine), 0xFF, 0xF, 0xF, true)); break; }
              const f32x2 g2 = {gi, gi};
#pragma unroll
              for (int j4 = (i >> 4); j4 < 4; ++j4) { const f32x4 m = *(const LAS f32x4*)(m2c + i * 64 + j4 * 4);
#pragma unroll
                  for (int h = 0; h < 2; ++h) { const int p = 2 * j4 + h;
                      if (2 * p >= (i >> 2)) acc2[p] += (f32x2){m[2 * h], m[2 * h + 1]} * g2;
                      else if (2 * p + 1 >= (i >> 2)) acc2[p][1] += m[2 * h + 1] * gi; } }
          }
#pragma unroll
          for (int j = 0; j < 16; ++j) *(LAS bf16_t*)(L + CS_GT + c * (CSP * 2) + (4 * j + q) * 2) = (bf16_t)f2bf(-acc2[j >> 1][j & 1]); }
        CS_BAR();
        unsigned char* outp = CHK + (size_t)cu * 32768;
        for (int job = C.wave; job < 16; job += NWAVES) { const int p = job >> 2, ti = (job >> 1) & 1, tj = job & 1;
            f32x16 acc;
            if (p == 0) {
                const LAS unsigned char* rp = L + CS_RT + (tj * 32 + r32) * (CSP * 2) + (ti * 32 + 4 * hi) * 2;
#pragma unroll
                for (int g = 0; g < 4; ++g) { const u32x2 u = *(const LAS u32x2*)(rp + g * 16); acc[4 * g] = bflo(u.x); acc[4 * g + 1] = bfhi(u.x); acc[4 * g + 2] = bflo(u.y); acc[4 * g + 3] = bfhi(u.y); }
                cs_mma(acc, L + CS_GT, L + CS_N2, ti, tj, r32, hi);
#pragma unroll
                for (int g = 0; g < 4; ++g) { u32x2 o; o.x = pk2(acc[4 * g], acc[4 * g + 1]); o.y = pk2(acc[4 * g + 2], acc[4 * g + 3]);
                    *(u32x2*)(outp + 8192 + (((tj * 4 + 2 * ti + (g >> 1)) * 64 + (g & 1) * 32 + r32) * 16) + hi * 8) = o; } }
            else if (p == 1) {
#pragma unroll
                for (int i = 0; i < 16; ++i) acc[i] = 0.f;
                cs_mma(acc, L + CS_KB, L + CS_RT, ti, tj, r32, hi);
                const int t = tj * 32 + r32;
#pragma unroll
                for (int reg = 0; reg < 16; ++reg) { const int i = ti * 32 + crow(reg, hi); acc[reg] = (i <= t) ? acc[reg] : 0.f; }
                cs_mma(acc, L + CS_GT + 64 * (CSP * 2), L + CS_N2, ti, tj, r32, hi);
                cs_store_t(L + CS_Z, acc, ti, tj, r32, hi); }
            else if (p == 2) {
#pragma unroll
                for (int i = 0; i < 16; ++i) acc[i] = 0.f;
                cs_mma<true>(acc, L + CS_GT, L + CS_BHT, ti, tj, r32, hi);
                const int k = tj * 32 + r32; const float gl = ((const LAS float*)(L + CS_GL))[k];
#pragma unroll
                for (int reg = 0; reg < 16; ++reg) { const int cc = ti * 32 + crow(reg, hi); acc[reg] += (cc == k) ? gl : 0.f; }
#pragma unroll
                for (int g = 0; g < 4; ++g) { u32x2 o; o.x = pk2(acc[4 * g], acc[4 * g + 1]); o.y = pk2(acc[4 * g + 2], acc[4 * g + 3]);
                    *(u32x2*)(outp + (((tj * 4 + 2 * ti + (g >> 1)) * 64 + (g & 1) * 32 + r32) * 16) + hi * 8) = o; } }
            else {
                const int krow = tj * 32 + r32; const LAS unsigned char* kp = L + CS_KHT + krow * (CSP * 2) + hi * 8;
#pragma unroll
                for (int g = 0; g < 4; ++g) { const u32x2 u = *(const LAS u32x2*)(kp + (((ti * 4 + g) ^ ((krow >> 3) & 7)) * 16)); acc[4 * g] = bflo(u.x); acc[4 * g + 1] = bfhi(u.x); acc[4 * g + 2] = bflo(u.y); acc[4 * g + 3] = bfhi(u.y); }
                cs_mma<true>(acc, L + CS_GT + 64 * (CSP * 2), L + CS_BHT, ti, tj, r32, hi);
                cs_store_t(L + CS_U, acc, ti, tj, r32, hi); } }
        CS_BAR();
        { const int p = C.wave >> 2, ti = (C.wave >> 1) & 1, tj = C.wave & 1;
          f32x16 acc;
#pragma unroll
          for (int i = 0; i < 16; ++i) acc[i] = 0.f;
          cs_mma<true>(acc, L + (p ? CS_U : CS_Z), L + CS_VMT, ti, tj, r32, hi);
          unsigned char* op = outp + (p ? 16384 : 24576) + ((ti * 2 + tj) * 64 + C.lane) * 32;
          u32x4 o0, o1; o0.x = pk2(acc[0], acc[1]); o0.y = pk2(acc[2], acc[3]); o0.z = pk2(acc[4], acc[5]); o0.w = pk2(acc[6], acc[7]);
          o1.x = pk2(acc[8], acc[9]); o1.y = pk2(acc[10], acc[11]); o1.z = pk2(acc[12], acc[13]); o1.w = pk2(acc[14], acc[15]);
          *(u32x4*)op = o0; *(u32x4*)(op + 16) = o1; }
        CS_BAR();
    }
}
__device__ __forceinline__ void phase_csb(const Ctx& C, const Args& A, int l) {
    if ((int)blockIdx.x >= CS_UNITS) { const int gwf = ((int)blockIdx.x - CS_UNITS) * NWAVES + C.wave, ngwf = (C.G - CS_UNITS) * NWAVES;
        conv_items(C, A, l + 1, gwf, ngwf, true, false, false); conv_items(C, A, l + 1, gwf, ngwf, false, false, true, XW_TK_HI); return; }
    const unsigned char* CHK = A.ws + WS_CHK;
    LAS unsigned char* L = C.lds;
    const int r32 = C.lane & 31, hi = C.lane >> 5;
    const bool isS = C.wave < 4; const int ti = (C.wave >> 1) & 1, tj = C.wave & 1;
    for (int unit = blockIdx.x; unit < CS_UNITS; unit += C.G) {
        const int d = unit & 1, h = (unit >> 1) % 12, b = unit / 24;
        float* Y = (float*)(A.ws + WS_Y) + (size_t)d * MROWS * 768;
        for (int i = C.tid; i < 2 * CS_MAT / 4; i += NTHR) ((LAS unsigned*)L)[i] = 0u;
        CS_BAR();
        bf16x8 afA[4], afB[4], afC[4]; u32x4 cA0, cA1, cB0, cB1, cC0, cC1;
#define CSB_LOAD(A4, C0, C1, ch_) do { const unsigned char* op_ = CHK + ((size_t)unit * CS_NCH + (ch_)) * 32768; \
            const unsigned char* am_ = op_ + (isS ? 0 : 8192) + (ti * 4 * 64 + C.lane) * 16;     \
            _Pragma("unroll") for (int ks = 0; ks < 4; ++ks) A4[ks] = *(const bf16x8*)(am_ + ks * 1024); \
            const unsigned char* cp_ = op_ + (isS ? 16384 : 24576) + ((ti * 2 + tj) * 64 + C.lane) * 32; C0 = *(const u32x4*)cp_; C1 = *(const u32x4*)(cp_ + 16); } while (0)
#define CSB_STEP(A4, C0, C1, ch_) do { \
            const LAS unsigned char* Sb = L + ((ch_) & 1) * CS_MAT; LAS unsigned char* Sn = L + (((ch_) + 1) & 1) * CS_MAT; \
            f32x16 acc; \
            acc[0] = bflo(C0.x); acc[1] = bfhi(C0.x); acc[2] = bflo(C0.y); acc[3] = bfhi(C0.y); acc[4] = bflo(C0.z); acc[5] = bfhi(C0.z); acc[6] = bflo(C0.w); acc[7] = bfhi(C0.w); \
            acc[8] = bflo(C1.x); acc[9] = bfhi(C1.x); acc[10] = bflo(C1.y); acc[11] = bfhi(C1.y); acc[12] = bflo(C1.z); acc[13] = bfhi(C1.z); acc[14] = bflo(C1.w); acc[15] = bfhi(C1.w); \
            const LAS unsigned char* bp = Sb + (tj * 32 + r32) * (CSP * 2) + hi * 16; \
            _Pragma("unroll") for (int ks = 0; ks < 4; ++ks) acc = __builtin_amdgcn_mfma_f32_32x32x16_bf16(A4[ks], *(const LAS bf16x8*)(bp + ks * 32), acc, 0, 0, 0); \
            if (isS) { cs_store_t(Sn, acc, ti, tj, r32, hi); }     \
            else {     \
                const int step0 = (ch_) * CS_L; const int sgn = d ? -1 : 1; \
                const int row0 = (step0 < CTXL) ? (NLAT + b * CTXL + (d ? CTXL - 1 - step0 : step0)) : (b * TT + (d ? TT - 1 - (step0 - CTXL) : step0 - CTXL)); \
                float* yp = Y + (size_t)(row0 + sgn * (ti * 32 + 4 * hi)) * 768 + h * 64 + tj * 32 + r32; const long ys = (long)sgn * 768; \
                _Pragma("unroll") for (int reg = 0; reg < 16; ++reg) yp[ys * ((reg & 3) + 8 * (reg >> 2))] = acc[reg]; } \
            CS_BAR(); } while (0)
        CSB_LOAD(afA, cA0, cA1, 0); CSB_LOAD(afB, cB0, cB1, 1);
        static_assert(CS_NCH % 3 == 0, "chunk loop is unrolled by three");
        for (int ch = 0; ch < CS_NCH; ch += 3) {
            if (ch == 0) CSB_LOAD(afC, cC0, cC1, 2);
            CSB_STEP(afA, cA0, cA1, ch);     if (ch + 3 < CS_NCH) CSB_LOAD(afA, cA0, cA1, ch + 3);
            CSB_STEP(afB, cB0, cB1, ch + 1); if (ch + 4 < CS_NCH) CSB_LOAD(afB, cB0, cB1, ch + 4);
            CSB_STEP(afC, cC0, cC1, ch + 2); if (ch + 5 < CS_NCH) CSB_LOAD(afC, cC0, cC1, ch + 5);
        }
        CS_BAR();
    }
#undef CSB_LOAD
#undef CSB_STEP
}

#undef CS_BAR
struct Ef2Row { f32x4 y0[3], y1[3]; u32x2 r[3], v[3], k0[3], k1[3], g[3]; };
__device__ __forceinline__ void ef2_load(Ef2Row& R, const float* Y0, const float* Y1, const unsigned char* SCN, const bf16_t* G, int row, int lane) {
#pragma unroll
    for (int it = 0; it < 3; ++it) { const int c = it * 256 + 4 * lane, head = c >> 6, kx = c & 63;
        R.y0[it] = *(const f32x4*)(Y0 + (size_t)row * 768 + c); R.y1[it] = *(const f32x4*)(Y1 + (size_t)row * 768 + c);
        const unsigned char* base = SCN + (size_t)(row * 12 + head) * SC_REC + kx * 2;
        R.r[it] = *(const u32x2*)(base + SC_R); R.v[it] = *(const u32x2*)(base + SC_V); R.k0[it] = *(const u32x2*)(base + SC_KR); R.k1[it] = *(const u32x2*)(base + SC_KR + 256);
        R.g[it] = *(const u32x2*)(G + (size_t)row * 768 + c); }
}
__device__ __forceinline__ void phase_ef2(const Ctx& C, const Args& A, int l) {
    const int i2 = l >> 1; unsigned char* ws = A.ws;
    const unsigned char* SCN = ws + WS_SCN; const float* Y0 = (const float*)(ws + WS_Y); const float* Y1 = Y0 + (size_t)MROWS * 768;
    const bf16_t* G = (const bf16_t*)(ws + WS_G); bf16_t* A2 = (bf16_t*)(ws + WS_A2);
    const float* rb = A.in[I_RBON] + (size_t)i2 * 768; const float* gg = A.in[I_GNG] + (size_t)i2 * 768; const float* gb = A.in[I_GNB] + (size_t)i2 * 768;
    f32x4 rbr[3], ggr[3], gbr[3];
#pragma unroll
    for (int it = 0; it < 3; ++it) { const int c = it * 256 + 4 * C.lane; rbr[it] = *(const f32x4*)(rb + c); ggr[it] = *(const f32x4*)(gg + c); gbr[it] = *(const f32x4*)(gb + c); }
    Ef2Row Rn;
    if (C.gw < MROWS) ef2_load(Rn, Y0, Y1, SCN, G, C.gw, C.lane);
    for (int row = C.gw; row < MROWS; row += C.NGW) {
        const Ef2Row R = Rn;
        { const int nr = row + C.NGW < MROWS ? row + C.NGW : row; ef2_load(Rn, Y0, Y1, SCN, G, nr, C.lane); }
#pragma unroll
        for (int it = 0; it < 3; ++it) {
            const int c = it * 256 + 4 * C.lane;
            const f32x4 y = R.y0[it] + R.y1[it];
            const float mean = sum16((y[0] + y[1]) + (y[2] + y[3])) * (1.f / 64.f);
            const f32x4 dd = y - mean;
            const float var = sum16((dd[0] * dd[0] + dd[1] * dd[1]) + (dd[2] * dd[2] + dd[3] * dd[3])) * (1.f / 64.f);
            const float rstd = rsqrtf(var + GN_EPS);
            const f32x4 r = bf4(R.r[it]), v = bf4(R.v[it]), k0 = bf4(R.k0[it]), k1 = bf4(R.k1[it]);
            const f32x4 t = r * (k0 + k1) * 0.5f * rbr[it];
            const float bs = sum16((t[0] + t[1]) + (t[2] + t[3]));
            const f32x4 yn = dd * rstd * ggr[it] + gbr[it];
            const f32x4 g = bf4(R.g[it]);
            st4bf(A2 + (size_t)row * DM + 256 + c, g * (yn + v * bs));
        }
    }
}

__device__ __forceinline__ void phase_of1(const Ctx& C, const Args& A, int l) {
    const int i2 = l >> 1; unsigned char* ws = A.ws;
    const bf16_t* P = (const bf16_t*)(ws + WS_P); bf16_t* A2 = (bf16_t*)(ws + WS_A2); bf16_t* VT = (bf16_t*)(ws + WS_VT);
    const float* lng = A.in[I_GLNG] + (size_t)i2 * 256; const float* lnb = A.in[I_GLNB] + (size_t)i2 * 256;
    const float* gws = A.in[I_GWS] + (size_t)i2 * 4 * 128 * 128; const float* gbs = A.in[I_GBS] + (size_t)i2 * 4 * 128;
    LAS bf16_t* vt = (LAS bf16_t*)C.lds;
    LAS bf16_t* uL = (LAS bf16_t*)C.lds;
    LAS bf16_t* vT = (LAS bf16_t*)(C.lds + 128 * 528);
    const int r32 = C.lane & 31, hi = C.lane >> 5;
    for (int it = blockIdx.x; it < 256 + 8 * 7; it += C.G) {
        const bool isctx = it >= 256; const int uc = isctx ? (it - 256) / 7 : 0, pc = isctx ? (it - 256) % 7 : 0; const int u = it;
        const int b = isctx ? (uc >> 1) : (u >> 6), pos0 = isctx ? (uc & 1) * 128 : (u & 63) * 128;
        const int row0 = isctx ? NLAT + b * CTXL + pos0 : b * TT + pos0, L0 = isctx ? pos0 : CTXL + pos0;
        const int hh0 = isctx ? pc : 0, hh1 = isctx ? (pc < 6 ? pc + 1 : 0) : 6; const bool doC = !isctx || pc == 6;
        u32x4 pv[4];
        if (hh0 < hh1) {
#pragma unroll
            for (int i = 0; i < 4; ++i) { const int piece = C.tid + NTHR * i, r = piece >> 4, part = piece & 15; pv[i] = *(const u32x4*)(P + (size_t)(row0 + r) * P_LD + 1536 + hh0 * 128 + part * 8); } }
        for (int hh = hh0; hh < hh1; ++hh) {
#pragma unroll
            for (int i = 0; i < 4; ++i) { const int piece = C.tid + NTHR * i, r = piece >> 4, part = piece & 15;
                *(LAS u32x4*)(vt + r * 136 + part * 8) = pv[i]; }
            __syncthreads();
            if (hh + 1 < hh1) {
#pragma unroll
                for (int i = 0; i < 4; ++i) { const int piece = C.tid + NTHR * i, r = piece >> 4, part = piece & 15; pv[i] = *(const u32x4*)(P + (size_t)(row0 + r) * P_LD + 1536 + (hh + 1) * 128 + part * 8); } }
#pragma unroll
            for (int i = 0; i < 4; ++i) { const int item = C.tid + NTHR * i, d = item >> 4, tg = item & 15; const LAS bf16_t* s = vt + (tg * 8) * 136 + d;
                u32x4 o; o.x = (unsigned)s[0] | ((unsigned)s[136] << 16); o.y = (unsigned)s[2 * 136] | ((unsigned)s[3 * 136] << 16);
                o.z = (unsigned)s[4 * 136] | ((unsigned)s[5 * 136] << 16); o.w = (unsigned)s[6 * 136] | ((unsigned)s[7 * 136] << 16);
                *(u32x4*)(VT + ((size_t)(b * 6 + hh) * 128 + d) * LKEYS + L0 + tg * 8) = o; }
            __syncthreads();
        }
        if (doC) {
        const f32x4 lngr = *(const f32x4*)(lng + 4 * C.lane), lnbr = *(const f32x4*)(lnb + 4 * C.lane);
        u32x2 nxu, nxr;
        { const bf16_t* pr = P + (size_t)(row0 + C.wave) * P_LD + 2304 + 4 * C.lane; nxu = *(const u32x2*)pr; nxr = *(const u32x2*)(pr + 256); }
        for (int r = C.wave; r < 128; r += NWAVES) {
            const int c4 = 4 * C.lane;
            const f32x4 ur = bf4(nxu), raw = bf4(nxr);
            if (r + NWAVES < 128) { const bf16_t* pr = P + (size_t)(row0 + r + NWAVES) * P_LD + 2304 + c4; nxu = *(const u32x2*)pr; nxr = *(const u32x2*)(pr + 256); }
            { const f32x4 gu = gelu4(ur); u32x2 o; o.x = pk2(gu[0], gu[1]); o.y = pk2(gu[2], gu[3]); *(LAS u32x2*)(uL + r * 264 + c4) = o; }
            const f32x4 gv = gelu4(raw);
            const float mean = wave_sum((gv[0] + gv[1]) + (gv[2] + gv[3])) * (1.f / 256.f); const f32x4 dd = gv - mean;
            const float var = wave_sum((dd[0] * dd[0] + dd[1] * dd[1]) + (dd[2] * dd[2] + dd[3] * dd[3])) * (1.f / 256.f); const float rstd = rsqrtf(var + LN_EPS);
            const f32x4 o = dd * rstd * lngr + lnbr;
#pragma unroll
            for (int k = 0; k < 4; ++k) vT[(c4 + k) * 136 + r] = (bf16_t)f2bf(o[k]);
        }
        __syncthreads();
        {
            const int g = C.wave >> 1, cblk = C.wave & 1, cc = g * 64 + cblk * 32 + r32;
            for (int pblk = 0; pblk < 4; ++pblk) {
                f32x16 acc;
#pragma unroll
                for (int i = 0; i < 16; ++i) acc[i] = 0.f;
                const float* wrow = gws + ((size_t)g * 128 + pblk * 32 + r32) * 128 + 8 * hi;
#pragma unroll
                for (int ks = 0; ks < 8; ++ks) { const f32x4 w0 = *(const f32x4*)(wrow + ks * 16), w1 = *(const f32x4*)(wrow + ks * 16 + 4);
                    u32x4 au; au.x = pk2(w0[0], w0[1]); au.y = pk2(w0[2], w0[3]); au.z = pk2(w1[0], w1[1]); au.w = pk2(w1[2], w1[3]);
                    const bf16x8 bf = *(const LAS bf16x8*)(vT + cc * 136 + ks * 16 + 8 * hi);
                    acc = __builtin_amdgcn_mfma_f32_32x32x16_bf16(__builtin_bit_cast(bf16x8, au), bf, acc, 0, 0, 0); }
#pragma unroll
                for (int reg = 0; reg < 16; ++reg) { const int p = pblk * 32 + crow(reg, hi);
                    const float uu = bf2f(uL[p * 264 + cc]); const float mixed = acc[reg] + gbs[g * 128 + p];
                    uL[p * 264 + cc] = (bf16_t)f2bf(uu * mixed); }
            }
        }
        __syncthreads();
#pragma unroll
        for (int i = 0; i < 8; ++i) { const int piece = C.tid + NTHR * i, r = piece >> 5, part = piece & 31;
            *(u32x4*)(A2 + (size_t)(row0 + r) * DM + 768 + part * 8) = *(const LAS u32x4*)(uL + r * 264 + part * 8); }
        __syncthreads();
        }
    }
}

__device__ __forceinline__ void phase_attn(const Ctx& C, const Args& A, int l) {
    const int i2 = l >> 1; unsigned char* ws = A.ws;
    const bf16_t* Q = (const bf16_t*)(ws + WS_Q); const bf16_t* KA = (const bf16_t*)(ws + WS_KA); const bf16_t* VT = (const bf16_t*)(ws + WS_VT); bf16_t* A2 = (bf16_t*)(ws + WS_A2);
    const float lam_init = 0.8f - 0.6f * expf(-0.3f * (float)l);
    float s1 = 0.f, s2 = 0.f;
    for (int j = 0; j < 64; ++j) { s1 += A.in[I_LQ1][i2 * 64 + j] * A.in[I_LK1][i2 * 64 + j]; s2 += A.in[I_LQ2][i2 * 64 + j] * A.in[I_LK2][i2 * 64 + j]; }
    const float lam = expf(s1) - expf(s2) + lam_init;
    const float* subg = A.in[I_SUBG] + (size_t)i2 * 128;
    const int r32 = C.lane & 31, hi = C.lane >> 5, map = C.wave >> 2, qw = C.wave & 3;
    LAS unsigned char* Kt = C.lds; LAS unsigned char* Vt = C.lds + 2 * 16384; LAS float* xch = (LAS float*)C.lds;
    const int NU = 1536 + (l == 1 ? 48 : 0);
    for (int n = C.vcu; n < NU; n += C.G) {
        int bh, qt; bool isctx = false;
        if (n < 1536) { const int round = n >> 8, slot = n & 255; bh = (slot >> 5) * 3 + (round >> 1); qt = (round & 1) * 32 + (slot & 31); }
        else { isctx = true; bh = (n - 1536) >> 1; qt = (n - 1536) & 1; }
        const int b = bh / 6, h = bh % 6;
        const int qrow0 = isctx ? NLAT + b * CTXL + qt * 128 : b * TT + qt * 128;
        const int NT = isctx ? CTXL / 64 : LKEYS / 64;
        const bf16_t* Kb = KA + (size_t)b * LKEYS * 768 + h * 128;
        const bf16_t* Vb = VT + (size_t)(b * 6 + h) * 128 * LKEYS;
        bf16x8 qf[4];
        { const bf16_t* qp = Q + (size_t)(qrow0 + qw * 32 + r32) * 768 + h * 128 + map * 64 + 8 * hi;
#pragma unroll
          for (int ks = 0; ks < 4; ++ks) qf[ks] = *(const bf16x8*)(qp + ks * 16); }
        f32x16 O[4];
#pragma unroll
        for (int d = 0; d < 4; ++d)
#pragma unroll
            for (int i = 0; i < 16; ++i) O[d][i] = 0.f;
        float m = 0.f, lsum = 0.f;
        unsigned ksrc[2], vsrc[2];
#pragma unroll
        for (int i = 0; i < 2; ++i) { const int row = 4 * (2 * C.wave + i) + (C.lane >> 4), x = row & 15, pi = x < 4 ? x : x < 8 ? x + 4 : x < 12 ? x - 4 : x;
            ksrc[i] = (unsigned)(((row & ~15) + pi) * 768 + (((C.lane & 15) ^ x) * 8));
            const int d = 8 * (2 * C.wave + i) + (C.lane >> 3); vsrc[i] = (unsigned)(d * LKEYS + (((C.lane & 7) ^ ((d >> 1) & 7)) * 8)); }
#define AT_DMA_K(tt, slot) do { _Pragma("unroll") for (int i = 0; i < 2; ++i) __builtin_amdgcn_global_load_lds((const unsigned*)(Kb + (size_t)(tt) * 64 * 768 + ksrc[i]), (LAS unsigned*)(Kt + (slot) * 16384 + (2 * C.wave + i) * 1024), 16, 0, 0); } while (0)
#define AT_DMA_V(tt, slot) do { _Pragma("unroll") for (int i = 0; i < 2; ++i) __builtin_amdgcn_global_load_lds((const unsigned*)(Vb + (size_t)(tt) * 64 + vsrc[i]), (LAS unsigned*)(Vt + (slot) * 16384 + (2 * C.wave + i) * 1024), 16, 0, 0); } while (0)
#define AT_BAR() asm volatile("s_waitcnt vmcnt(0) lgkmcnt(0)\n\ts_barrier" ::: "memory")
#define AT_SB() __builtin_amdgcn_sched_barrier(0)
        const int ksw = r32 & 15, vsw = (r32 >> 1) & 7;
#define AT_QK(P0, P1, ks_) do { const float nm_ = -m; _Pragma("unroll") for (int i = 0; i < 16; ++i) { P0[i] = nm_; P1[i] = nm_; } \
            const LAS unsigned char* kbp_ = Kt + (ks_) * 16384 + r32 * 256; \
            _Pragma("unroll") for (int ks = 0; ks < 4; ++ks) { const int co_ = ((map * 8 + ks * 2 + hi) ^ ksw) * 16; \
                P0 = __builtin_amdgcn_mfma_f32_32x32x16_bf16(*(const LAS bf16x8*)(kbp_ + co_), qf[ks], P0, 0, 0, 0); P1 = __builtin_amdgcn_mfma_f32_32x32x16_bf16(*(const LAS bf16x8*)(kbp_ + 32 * 256 + co_), qf[ks], P1, 0, 0, 0); } } while (0)
#define AT_LDV(dst, vs_, d) do { _Pragma("unroll") for (int kst = 0; kst < 4; ++kst) dst[kst] = *(const LAS u32x4*)(Vt + (vs_) * 16384 + ((d) * 32 + r32) * 128 + (((kst * 2 + hi) ^ vsw) * 16)); } while (0)
#define AT_PV(src, d) do { _Pragma("unroll") for (int kst = 0; kst < 4; ++kst) O[d] = __builtin_amdgcn_mfma_f32_32x32x16_bf16(__builtin_bit_cast(bf16x8, src[kst]), pb[kst], O[d], 0, 0, 0); } while (0)
#define AT_SOFTPV(P0, P1, N0, N1, first, hasn, vs_) do { \
            asm volatile("" : "+v"(P0), "+v"(P1));     \
            float mx = max3f(P0[0], P0[1], P1[0]), mx2 = max3f(P0[2], P0[3], P1[1]); mx = max3f(mx, P1[2], P1[3]); \
            _Pragma("unroll") for (int i = 4; i < 16; i += 4) { mx = max3f(mx, P0[i], P0[i + 1]); mx2 = max3f(mx2, P0[i + 2], P0[i + 3]); mx = max3f(mx, P1[i], P1[i + 1]); mx2 = max3f(mx2, P1[i + 2], P1[i + 3]); } \
            mx = fmaxf(mx, mx2); \
            { auto rr = __builtin_amdgcn_permlane32_swap(__float_as_uint(mx), __float_as_uint(mx), false, false); mx = fmaxf(__uint_as_float(rr[0]), __uint_as_float(rr[1])); } \
            if ((first) || __any(mx > 8.f)) { const float dl = (first) ? mx : fmaxf(mx, 0.f); const float sc = __builtin_amdgcn_exp2f(-dl); lsum *= sc; \
                _Pragma("unroll") for (int d = 0; d < 4; ++d) _Pragma("unroll") for (int i = 0; i < 16; ++i) O[d][i] *= sc; \
                _Pragma("unroll") for (int i = 0; i < 16; ++i) { P0[i] -= dl; P1[i] -= dl; } \
                if (hasn) { asm volatile("s_nop 15\n\ts_nop 7" : "+v"(N0), "+v"(N1)); _Pragma("unroll") for (int i = 0; i < 16; ++i) { N0[i] -= dl; N1[i] -= dl; } } \
                m += dl; } \
            float ps = 0.f, ps2 = 0.f; \
            _Pragma("unroll") for (int i = 0; i < 16; ++i) { P0[i] = __builtin_amdgcn_exp2f(P0[i]); P1[i] = __builtin_amdgcn_exp2f(P1[i]); ps += P0[i]; ps2 += P1[i]; } \
            lsum += ps + ps2; \
            bf16x8 pb[4]; \
            { u32x4 w; w.x = pk2(P0[0], P0[1]); w.y = pk2(P0[2], P0[3]); w.z = pk2(P0[4], P0[5]); w.w = pk2(P0[6], P0[7]); pb[0] = __builtin_bit_cast(bf16x8, w); \
              w.x = pk2(P0[8], P0[9]); w.y = pk2(P0[10], P0[11]); w.z = pk2(P0[12], P0[13]); w.w = pk2(P0[14], P0[15]); pb[1] = __builtin_bit_cast(bf16x8, w); \
              w.x = pk2(P1[0], P1[1]); w.y = pk2(P1[2], P1[3]); w.z = pk2(P1[4], P1[5]); w.w = pk2(P1[6], P1[7]); pb[2] = __builtin_bit_cast(bf16x8, w); \
              w.x = pk2(P1[8], P1[9]); w.y = pk2(P1[10], P1[11]); w.z = pk2(P1[12], P1[13]); w.w = pk2(P1[14], P1[15]); pb[3] = __builtin_bit_cast(bf16x8, w); } \
            u32x4 va[4]; \
            AT_LDV(va, vs_, 0); AT_SB(); AT_PV(va, 0); AT_SB(); AT_LDV(va, vs_, 1); AT_SB(); AT_PV(va, 1); AT_SB(); AT_LDV(va, vs_, 2); AT_SB(); AT_PV(va, 2); AT_SB(); AT_LDV(va, vs_, 3); AT_SB(); AT_PV(va, 3); AT_SB(); } while (0)
        f32x16 pA0, pA1, pB0, pB1;
        AT_DMA_K(0, 0); AT_DMA_V(0, 0); AT_DMA_K(1, 1);
        AT_BAR();
        AT_QK(pA0, pA1, 0);
        asm volatile("s_waitcnt lgkmcnt(0)\n\ts_barrier" ::: "memory");
        for (int t = 0; t < NT; t += 2) {
            if (t + 2 < NT) AT_DMA_K(t + 2, 0);
            AT_DMA_V(t + 1, 1);
            AT_SB(); AT_QK(pB0, pB1, 1); AT_SB();
            AT_SOFTPV(pA0, pA1, pB0, pB1, t == 0, true, 0);
            AT_BAR();
            if (t + 3 < NT) AT_DMA_K(t + 3, 1);
            if (t + 2 < NT) AT_DMA_V(t + 2, 0);
            AT_SB(); if (t + 2 < NT) { AT_QK(pA0, pA1, 0); } AT_SB();
            AT_SOFTPV(pB0, pB1, pA0, pA1, false, t + 2 < NT, 1);
            AT_BAR();
        }
#undef AT_DMA_K
#undef AT_DMA_V
#undef AT_BAR
#undef AT_SB
#undef AT_QK
#undef AT_LDV
#undef AT_PV
#undef AT_SOFTPV
        const float ltot = lsum + lx32(lsum, C.lane);
        const float invl = 1.f / ltot;
        if (map == 1) { const float f = lam * invl;
#pragma unroll
            for (int d = 0; d < 4; ++d)
#pragma unroll
                for (int i = 0; i < 16; ++i) xch[(qw * 64 + d * 16 + i) * 64 + C.lane] = O[d][i] * f; }
        __syncthreads();
        if (map == 0) { float ss = 0.f;
#pragma unroll
            for (int d = 0; d < 4; ++d)
#pragma unroll
                for (int i = 0; i < 16; ++i) { const float o = O[d][i] * invl - xch[(qw * 64 + d * 16 + i) * 64 + C.lane]; O[d][i] = o; ss += o * o; }
            ss += lx32(ss, C.lane);
            const float rn = rsqrtf(ss * (1.f / 128.f) + RMS_EPS) * (1.f - lam_init);
            bf16_t* orow = A2 + (size_t)(qrow0 + qw * 32 + r32) * DM + h * 128;
#pragma unroll
            for (int d = 0; d < 4; ++d)
#pragma unroll
                for (int gp = 0; gp < 4; gp += 2) {
                    unsigned pk_[2][2];
#pragma unroll
                    for (int q = 0; q < 2; ++q) { const int g4 = gp + q, dd = 32 * d + 8 * g4 + 4 * hi; const f32x4 sg = *(const f32x4*)(subg + dd);
                        pk_[q][0] = pk2(O[d][4 * g4] * rn * sg[0], O[d][4 * g4 + 1] * rn * sg[1]); pk_[q][1] = pk2(O[d][4 * g4 + 2] * rn * sg[2], O[d][4 * g4 + 3] * rn * sg[3]); }
                    const auto r0 = __builtin_amdgcn_permlane32_swap(pk_[0][0], pk_[1][0], false, false); const auto r1 = __builtin_amdgcn_permlane32_swap(pk_[0][1], pk_[1][1], false, false);
                    u32x4 o; o.x = r0[0]; o.y = r1[0]; o.z = r0[1]; o.w = r1[1];
                    *(u32x4*)(orow + 32 * d + 8 * (gp + hi)) = o; } }
        __syncthreads();
    }
}

__device__ __forceinline__ void phase_rt(const Ctx& C, const Args& A, int l) {
    unsigned char* ws = A.ws; float* X = (float*)(ws + WS_X); bf16_t* H = (bf16_t*)(ws + WS_H); float* AFF = (float*)(ws + WS_AFF); float* STAT = (float*)(ws + WS_P);
    const float* MOD = (const float*)(ws + WS_MOD) + (size_t)l * 5 * 6144;
    const float* lng = A.in[I_LNG] + (size_t)(l * 2 + 0) * DM; const float* lnb = A.in[I_LNB] + (size_t)(l * 2 + 0) * DM;
    LAS float* wrs = (LAS float*)C.lds;
    { const float* wr = A.in[I_WR] + (size_t)l * DM * 16; for (int i = C.tid; i < DM * 16; i += NTHR) wrs[(i & 15) * 1024 + (i >> 4)] = wr[i]; }
    __syncthreads();
    const int row0 = (int)(((long)C.gw * MROWS) / C.NGW), row1 = (int)(((long)(C.gw + 1) * MROWS) / C.NGW);
    f32x4 lngr[4], lnbr[4], scr[4], shr[4]; int cmi = -1;
#pragma unroll
    for (int j = 0; j < 4; ++j) { const int col = 4 * C.lane + 256 * j; lngr[j] = *(const f32x4*)(lng + col); lnbr[j] = *(const f32x4*)(lnb + col); scr[j] = lngr[j]; shr[j] = lngr[j]; }
    f32x4 xn[4];
    if (row0 < row1) {
#pragma unroll
        for (int j = 0; j < 4; ++j) xn[j] = *(const f32x4*)(X + (size_t)row0 * DM + 4 * C.lane + 256 * j); }
    for (int row = row0; row < row1; ++row) {
        const int mi = row_mi(row);
        if (mi != cmi) { cmi = mi; const float* md = MOD + mi * 6144;
#pragma unroll
            for (int j = 0; j < 4; ++j) { const int col = 4 * C.lane + 256 * j; scr[j] = *(const f32x4*)(md + 4 * DM + col) + 1.f; shr[j] = *(const f32x4*)(md + 3 * DM + col); } }
        f32x4 x[4]; float s = 0.f;
#pragma unroll
        for (int j = 0; j < 4; ++j) { x[j] = xn[j]; s += (x[j][0] + x[j][1]) + (x[j][2] + x[j][3]); }
        if (row + 1 < row1) {
#pragma unroll
            for (int j = 0; j < 4; ++j) xn[j] = *(const f32x4*)(X + (size_t)(row + 1) * DM + 4 * C.lane + 256 * j); }
        const float mean = wave_sum(s) * (1.f / DM); float s2 = 0.f;
#pragma unroll
        for (int j = 0; j < 4; ++j) { x[j] = x[j] - mean; s2 += (x[j][0] * x[j][0] + x[j][1] * x[j][1]) + (x[j][2] * x[j][2] + x[j][3] * x[j][3]); }
        const float rstd = rsqrtf(wave_sum(s2) * (1.f / DM) + LN_EPS);
        if (C.lane == 0) *(f32x2*)(STAT + (size_t)row * 2) = (f32x2){mean, rstd};
        float v[16];
#pragma unroll
        for (int e = 0; e < 16; ++e) v[e] = 0.f;
#pragma unroll
        for (int j = 0; j < 4; ++j) { const int col = 4 * C.lane + 256 * j;
            const f32x4 x1 = x[j] * rstd * lngr[j] + lnbr[j];
            const f32x4 h = x1 * scr[j] + shr[j];
            st4bf(H + (size_t)row * DM + col, h);
#pragma unroll
            for (int e = 0; e < 16; ++e) { const f32x4 w = *(const LAS f32x4*)(wrs + e * 1024 + col); v[e] += (h[0] * w[0] + h[1] * w[1]) + (h[2] * w[2] + h[3] * w[3]); }
            __builtin_amdgcn_sched_barrier(0); }
#pragma unroll
        for (int i = 0; i < 8; ++i) { const float send = (C.lane & 32) ? v[i] : v[i + 8], keep = (C.lane & 32) ? v[i + 8] : v[i]; v[i] = keep + lx32(send, C.lane); }
#pragma unroll
        for (int i = 0; i < 4; ++i) { const float send = (C.lane & 16) ? v[i] : v[i + 4], keep = (C.lane & 16) ? v[i + 4] : v[i]; v[i] = keep + lx16(send, C.lane); }
#pragma unroll
        for (int i = 0; i < 2; ++i) { const float send = (C.lane & 8) ? v[i] : v[i + 2], keep = (C.lane & 8) ? v[i + 2] : v[i]; v[i] = keep + lx8(send); }
        { const float send = (C.lane & 4) ? v[0] : v[1], keep = (C.lane & 4) ? v[1] : v[0]; v[0] = keep + lx4(send); }
        float z = v[0]; z += lx1(z); z += lx2(z);
        float mx = z;
#pragma unroll
        for (int o = 4; o < 64; o <<= 1) mx = fmaxf(mx, o == 4 ? lx4(mx) : o == 8 ? lx8(mx) : o == 16 ? lx16(mx, C.lane) : lx32(mx, C.lane));
        const float ex = expf(z - mx); float sm = ex;
#pragma unroll
        for (int o = 4; o < 64; o <<= 1) sm += (o == 4 ? lx4(sm) : o == 8 ? lx8(sm) : o == 16 ? lx16(sm, C.lane) : lx32(sm, C.lane));
        if ((C.lane & 3) == 0) AFF[(size_t)row * 16 + (C.lane >> 2)] = ex / sm;
    }
}

__device__ __forceinline__ void phase_tk(const Ctx& C, const Args& A) {
    unsigned char* ws = A.ws; const float* AFF = (const float*)(ws + WS_AFF); int* SLOT = (int*)(ws + WS_SLOT); int* IDX = (int*)(ws + WS_IDX); float* GATE = (float*)(ws + WS_GATE);
    LAS unsigned* key = (LAS unsigned*)C.lds;
    LAS unsigned* hist = key + 8192;
    LAS unsigned* scn = hist + 256;
    LAS unsigned* wtot = scn + 256;
    LAS unsigned* bc = wtot + 8;
    for (int u = blockIdx.x; u < 128; u += C.G) {
        const bool isctx = u >= 64; const int uu = u & 63, b = uu >> 4, e = uu & 15;
        const int n = isctx ? CTXL : TT, cap = isctx ? CAP_C : CAP_L;
        const int row0 = isctx ? NLAT + b * CTXL : b * TT;
        const int slot0 = e * ESLOTS + (isctx ? 4 * CAP_L + b * CAP_C : b * CAP_L);
        for (int i = C.tid; i < n; i += NTHR) key[i] = __float_as_uint(AFF[(size_t)(row0 + i) * 16 + e]);
        unsigned prefix = 0u, pmask = 0u; int need = cap;
        for (int pass = 0; pass < 4; ++pass) {
            const int shift = 24 - 8 * pass;
            if (C.tid < 256) hist[C.tid] = 0u;
            __syncthreads();
            for (int i = C.tid; i < n; i += NTHR) { const unsigned k = key[i]; if ((k & pmask) == prefix) __hip_atomic_fetch_add(&hist[(k >> shift) & 255u], 1u, __ATOMIC_RELAXED, __HIP_MEMORY_SCOPE_WORKGROUP); }
            __syncthreads();
            {
                const unsigned hd = (C.tid < 256) ? hist[255 - C.tid] : 0u; unsigned inc = hd;
#pragma unroll
                for (int o = 1; o < 64; o <<= 1) { const unsigned t = __shfl_up(inc, o); if (C.lane >= o) inc += t; }
                if (C.tid < 256 && C.lane == 63) wtot[C.wave] = inc;
                __syncthreads();
                if (C.tid < 256) { unsigned base = 0u; for (int w = 0; w < C.wave; ++w) base += wtot[w];
                    const unsigned incl = base + inc, above = incl - hd;
                    if (incl >= (unsigned)need && above < (unsigned)need) { bc[0] = (unsigned)(255 - C.tid); bc[1] = (unsigned)need - above; } }
            }
            __syncthreads();
            prefix |= bc[0] << shift; pmask |= 255u << shift; need = (int)bc[1];
            __syncthreads();
        }
        const int per = (n + NTHR - 1) / NTHR; const int i0 = C.tid * per;
        unsigned cg = 0u, ce = 0u;
        for (int j = 0; j < per; ++j) { const int i = i0 + j; if (i < n) { const unsigned k = key[i]; cg += (k > prefix); ce += (k == prefix); } }
        unsigned pk = cg | (ce << 16), inc = pk;
#pragma unroll
        for (int o = 1; o < 64; o <<= 1) { const unsigned t = __shfl_up(inc, o); if (C.lane >= o) inc += t; }
        if (C.lane == 63) wtot[C.wave] = inc;
        __syncthreads();
        unsigned wbase = 0u;
        for (int w = 0; w < C.wave; ++w) wbase += wtot[w];
        const unsigned excl = wbase + inc - pk;
        unsigned rg = excl & 0xffffu, re = excl >> 16;
        const int ngt = cap - need;
        for (int j = 0; j < per; ++j) { const int i = i0 + j; if (i < n) { const unsigned k = key[i]; int pos = -1;
            if (k > prefix) { pos = (int)rg; ++rg; } else if (k == prefix) { if ((int)re < need) pos = ngt + (int)re; ++re; }
            const int row = row0 + i;
            if (pos >= 0) { IDX[slot0 + pos] = row; GATE[slot0 + pos] = __uint_as_float(k); SLOT[(size_t)row * 16 + e] = slot0 + pos; }
            else SLOT[(size_t)row * 16 + e] = -1; } }
        if (isctx && b == 0 && C.tid < ESLOTS - 4224) { IDX[e * ESLOTS + 4224 + C.tid] = 0; GATE[e * ESLOTS + 4224 + C.tid] = 0.f; }
        __syncthreads();
    }
}

__device__ __forceinline__ void phase_cb(const Ctx& C, const Args& A, int l) {
    unsigned char* ws = A.ws; float* X = (float*)(ws + WS_X); bf16_t* H = (bf16_t*)(ws + WS_H); const int* SLOT = (const int*)(ws + WS_SLOT); const bf16_t* YE = (const bf16_t*)(ws + WS_YE);
    const float* MOD = (const float*)(ws + WS_MOD) + (size_t)l * 5 * 6144; const float* MODN = MOD + 5 * 6144;
    const float* lng = A.in[I_LNG] + (size_t)(l * 2 + 1) * DM; const float* lnb = A.in[I_LNB] + (size_t)(l * 2 + 1) * DM;
    const float* lng1 = A.in[I_LNG] + (size_t)(l * 2 + 0) * DM; const float* lnb1 = A.in[I_LNB] + (size_t)(l * 2 + 0) * DM; const float* STAT = (const float*)(ws + WS_P);
    const int row0 = (int)(((long)C.gw * MROWS) / C.NGW), row1 = (int)(((long)(C.gw + 1) * MROWS) / C.NGW);
    f32x4 lngr[4], lnbr[4], gfr[4], nsc[4], nsh[4], l1g[4], l1b[4]; int cmi = -1;
#pragma unroll
    for (int j = 0; j < 4; ++j) { const int col = 4 * C.lane + 256 * j; lngr[j] = *(const f32x4*)(lng + col); lnbr[j] = *(const f32x4*)(lnb + col); gfr[j] = lngr[j]; nsc[j] = lngr[j]; nsh[j] = lngr[j];
        l1g[j] = *(const f32x4*)(lng1 + col); l1b[j] = *(const f32x4*)(lnb1 + col); }
    int svn = -1; f32x4 xn[4]; f32x2 stn = {0.f, 0.f};
    if (row0 < row1) { svn = SLOT[(size_t)row0 * 16 + (C.lane & 15)]; stn = *(const f32x2*)(STAT + (size_t)row0 * 2);
#pragma unroll
        for (int j = 0; j < 4; ++j) xn[j] = *(const f32x4*)(X + (size_t)row0 * DM + 4 * C.lane + 256 * j); }
    for (int row = row0; row < row1; ++row) {
        const int mi = row_mi(row);
        if (mi != cmi) { cmi = mi; const float* md = MOD + mi * 6144; const float* mn = MODN + mi * 6144;
#pragma unroll
            for (int j = 0; j < 4; ++j) { const int col = 4 * C.lane + 256 * j; gfr[j] = *(const f32x4*)(md + 5 * DM + col);
                if (l < DEPTH - 1) { nsc[j] = *(const f32x4*)(mn + DM + col) + 1.f; nsh[j] = *(const f32x4*)(mn + col); } } }
        const int sv = svn;
        unsigned mask = (unsigned)__ballot(sv >= 0) & 0xffffu;
        f32x4 acc[4];
#pragma unroll
        for (int j = 0; j < 4; ++j) acc[j] = (f32x4){0.f, 0.f, 0.f, 0.f};
        u32x2 y0[4], y1[4], y2[4], y3[4]; bool h0 = false, h1 = false, h2 = false, h3 = false;
        if (mask) { const int e = __builtin_ctz(mask); mask &= mask - 1; h0 = true; const int sl = __builtin_amdgcn_readlane(sv, e);
#pragma unroll
            for (int j = 0; j < 4; ++j) y0[j] = *(const u32x2*)(YE + (size_t)sl * DM + 4 * C.lane + 256 * j); }
        if (mask) { const int e = __builtin_ctz(mask); mask &= mask - 1; h1 = true; const int sl = __builtin_amdgcn_readlane(sv, e);
#pragma unroll
            for (int j = 0; j < 4; ++j) y1[j] = *(const u32x2*)(YE + (size_t)sl * DM + 4 * C.lane + 256 * j); }
        if (mask) { const int e = __builtin_ctz(mask); mask &= mask - 1; h2 = true; const int sl = __builtin_amdgcn_readlane(sv, e);
#pragma unroll
            for (int j = 0; j < 4; ++j) y2[j] = *(const u32x2*)(YE + (size_t)sl * DM + 4 * C.lane + 256 * j); }
        if (mask) { const int e = __builtin_ctz(mask); mask &= mask - 1; h3 = true; const int sl = __builtin_amdgcn_readlane(sv, e);
#pragma unroll
            for (int j = 0; j < 4; ++j) y3[j] = *(const u32x2*)(YE + (size_t)sl * DM + 4 * C.lane + 256 * j); }
        f32x4 x[4]; const f32x2 st = stn;
#pragma unroll
        for (int j = 0; j < 4; ++j) x[j] = xn[j];
        if (row + 1 < row1) { svn = SLOT[(size_t)(row + 1) * 16 + (C.lane & 15)]; stn = *(const f32x2*)(STAT + (size_t)(row + 1) * 2);
#pragma unroll
            for (int j = 0; j < 4; ++j) xn[j] = *(const f32x4*)(X + (size_t)(row + 1) * DM + 4 * C.lane + 256 * j); }
        if (h0) {
#pragma unroll
            for (int j = 0; j < 4; ++j) acc[j] += (f32x4){__uint_as_float(y0[j].x << 16), __uint_as_float(y0[j].x & 0xffff0000u), __uint_as_float(y0[j].y << 16), __uint_as_float(y0[j].y & 0xffff0000u)}; }
        if (h1) {
#pragma unroll
            for (int j = 0; j < 4; ++j) acc[j] += (f32x4){__uint_as_float(y1[j].x << 16), __uint_as_float(y1[j].x & 0xffff0000u), __uint_as_float(y1[j].y << 16), __uint_as_float(y1[j].y & 0xffff0000u)}; }
        if (h2) {
#pragma unroll
            for (int j = 0; j < 4; ++j) acc[j] += bf4(y2[j]); }
        if (h3) {
#pragma unroll
            for (int j = 0; j < 4; ++j) acc[j] += bf4(y3[j]); }
        while (mask) { const int e = __builtin_ctz(mask); mask &= mask - 1; const int sl = __builtin_amdgcn_readlane(sv, e);
#pragma unroll
            for (int j = 0; j < 4; ++j) acc[j] += ld4bf(YE + (size_t)sl * DM + 4 * C.lane + 256 * j); }
        float sm = 0.f;
#pragma unroll
        for (int j = 0; j < 4; ++j) { x[j] = ((x[j] - st[0]) * st[1] * l1g[j] + l1b[j]) * ALPHA_DN + gfr[j] * acc[j];
            sm += (x[j][0] + x[j][1]) + (x[j][2] + x[j][3]); }
        const float mean = wave_sum(sm) * (1.f / DM); float s2 = 0.f;
#pragma unroll
        for (int j = 0; j < 4; ++j) { x[j] = x[j] - mean; s2 += (x[j][0] * x[j][0] + x[j][1] * x[j][1]) + (x[j][2] * x[j][2] + x[j][3] * x[j][3]); }
        const float rstd = rsqrtf(wave_sum(s2) * (1.f / DM) + LN_EPS);
#pragma unroll
        for (int j = 0; j < 4; ++j) { const int col = 4 * C.lane + 256 * j;
            const f32x4 x2 = x[j] * rstd * lngr[j] + lnbr[j];
            if (l < DEPTH - 1) { *(f32x4*)(X + (size_t)row * DM + col) = x2; st4bf(H + (size_t)row * DM + col, x2 * nsc[j] + nsh[j]); }
            else if (row < NLAT) *(f32x4*)(A.out + (size_t)row * DM + col) = x2; }
    }
}


#ifndef GEMM_NOINLINE
#define GEMM_NOINLINE 0
#endif
#if GEMM_NOINLINE
#define GEMM_FN __device__ __noinline__
#else
#define GEMM_FN __device__ __forceinline__
#endif
GEMM_FN void gphase_in(LAS unsigned char* lds, unsigned char* ws, int nN, int G) {
    int bx = blockIdx.x; asm volatile("" : "+s"(bx), "+s"(G));
    pg8::Gemm g{(const bf16_t*)(ws + WS_H), (const bf16_t*)(ws + WS_WIN), DM}; pg8::Order<0> S; S.init(MROWS / 256, nN, G, bx, nullptr, 0);
    pg8::EpiBf16 E{(bf16_t*)(ws + WS_P), P_LD}; pg8::gemm_phase(lds, g, S, E); }
GEMM_FN void gphase_in_odd(LAS unsigned char* lds, unsigned char* ws, int G) {
    int bx = blockIdx.x; asm volatile("" : "+s"(bx), "+s"(G));
    pg8::Gemm g{(const bf16_t*)(ws + WS_H), (const bf16_t*)(ws + WS_WIN), DM}; pg8::Order<0> S; S.init(MROWS / 256, D_IN_ODD / 256, G, bx, nullptr, 0);
    pg8::EpiOdd E{(bf16_t*)(ws + WS_P), (bf16_t*)(ws + WS_Q), (bf16_t*)(ws + WS_KA), (const float*)(ws + WS_ROPE)}; pg8::gemm_phase(lds, g, S, E); }
GEMM_FN void gphase_lora(LAS unsigned char* lds, unsigned char* ws, const float* d0, const float* a0, const float* kal, int G) {
    int bx = blockIdx.x; asm volatile("" : "+s"(bx), "+s"(G));
    pg8::Gemm g{(const bf16_t*)(ws + WS_LIN), (const bf16_t*)(ws + WS_WLORA), LORA_K}; pg8::Order<0> S; S.init(MROWS / 256, LORA_N / 256, G, bx, nullptr, 0);
    pg8::EpiLora E{ws + WS_SCN, (bf16_t*)(ws + WS_G), d0, a0, kal}; pg8::gemm_phase(lds, g, S, E); }
GEMM_FN void gphase_out(LAS unsigned char* lds, unsigned char* ws, const float* modl, int G, const float* xin, const float* cin) {
    int bx = blockIdx.x; asm volatile("" : "+s"(bx), "+s"(G));
    pg8::Gemm g{(const bf16_t*)(ws + WS_A2), (const bf16_t*)(ws + WS_WOUT), DM}; pg8::Order<0> S; S.init(MROWS / 256, DM / 256, G, bx, nullptr, 0);
    pg8::EpiRes E{(float*)(ws + WS_X), modl, xin, cin}; pg8::gemm_phase(lds, g, S, E); }
GEMM_FN void gphase_e1(LAS unsigned char* lds, unsigned char* ws, int G, int l) {
    int bx = blockIdx.x; asm volatile("" : "+s"(bx), "+s"(G));
    pg8::Gemm g{(const bf16_t*)(ws + WS_H), (const bf16_t*)(ws + WS_WE13 + (size_t)(l & 1) * WE13_BYTES), DM}; pg8::EpiSwiGLU E{(bf16_t*)(ws + WS_HID)};
    pg8::OrderExp<1> S; S.init(4096 / 256, G, bx, (const int*)(ws + WS_IDX), (long)4096 * DM); pg8::gemm_phase(lds, g, S, E); }
GEMM_FN void gphase_e2(LAS unsigned char* lds, unsigned char* ws, int G, int l) {
    int bx = blockIdx.x; asm volatile("" : "+s"(bx), "+s"(G));
    pg8::Gemm g{(const bf16_t*)(ws + WS_HID), (const bf16_t*)(ws + WS_WE2 + (size_t)(l & 1) * WE2_BYTES), D_EXP}; pg8::EpiYE E{(bf16_t*)(ws + WS_YE), (const float*)(ws + WS_GATE)};
    pg8::OrderExp<2> S; S.init(DM / 256, G, bx, nullptr, (long)DM * D_EXP); pg8::gemm_phase(lds, g, S, E); }

constexpr int NSLOT = 13;
constexpr int NSTEP = 1 + DEPTH * NSLOT;
__global__ void __launch_bounds__(NTHR, 2) mk_fwd(Args KA) {
    extern __shared__ __attribute__((aligned(16))) unsigned char lds_raw[];
    volatile LAS unsigned* MISC = (volatile LAS unsigned*)((LAS unsigned char*)lds_raw + LDS_MISC);
    if (threadIdx.x < 16) MISC[threadIdx.x] = 0u;
    if (threadIdx.x == 0) { LAS unsigned long long* tb = (LAS unsigned long long*)((LAS unsigned char*)lds_raw + LDS_PTAB);
#pragma unroll
        for (int i = 0; i < 37; ++i) tb[i] = (unsigned long long)KA.in[i];
        tb[37] = (unsigned long long)KA.out; tb[38] = (unsigned long long)KA.ws; }
    __syncthreads();
    const int lo = KA.lo, hi = KA.hi;
    unsigned bar_x = 0;
    if (hi - lo > 1) { const XcdBarrier b0 = xcd_barrier_post((unsigned*)(KA.ws + WS_CTL), MISC); bar_x = b0.x; }
#ifndef PH_MASK
#define PH_MASK 0xFFFFFF
#endif
#ifndef REP_MASK
#define REP_MASK 0
#endif
#define PH_BIT(k) (((k) == 0) ? 0 : 1 + ((k) - 1) % NSLOT + (((k) - 1) % NSLOT >= 2 && ((k) - 1) % NSLOT <= 3 && odd ? 12 : 0))
#define RUN(k, ...) do { if (((PH_MASK >> PH_BIT(k)) & 1) && lo <= (k) && (k) < hi) { const int nrep = ((REP_MASK >> PH_BIT(k)) & 1) ? 2 : 1; \
        _Pragma("unroll 1") for (int rep = 0; rep < nrep; ++rep) { \
        Ctx C; mkctx(C, (LAS unsigned char*)lds_raw); Args A; ldargs(A, (LAS unsigned char*)lds_raw); unsigned char* ws = A.ws; \
        const float* MODL = (const float*)(ws + WS_MOD) + (size_t)l * 5 * 6144; (void)MODL; \
        __VA_ARGS__; if ((k) + 1 < hi || rep + 1 < nrep) { XcdBarrier bar; bar.bar = (unsigned*)(ws + WS_CTL); bar.x = bar_x; bar.st = MISC; xcd_barrier(bar); } } } } while (0)
    { const bool odd = false; const int l = 0; RUN(0, { phase_init(C, A); __syncthreads(); conv_items(C, A, 0, C.gw, C.NGW, true, true, true); }); }
#pragma unroll 1
    for (int l = 0; l < DEPTH; ++l) {
        const int sb = 1 + l * NSLOT; const bool odd = l & 1;
        if (!(CHUNKED_SCAN && odd)) { RUN(sb + 0, { phase_conv(C, A, l); if (l == 0) phase_modh(C, A, 0); }); }
        if (odd) { RUN(sb + 1, { gphase_in_odd(C.lds, ws, C.G);
                   const int tail = ((MROWS / 256) * (D_IN_ODD / 256)) % C.G;
                   if (CHUNKED_SCAN && l + 1 < DEPTH && tail > 0 && (int)blockIdx.x >= tail) conv_items(C, A, l + 1, ((int)blockIdx.x - tail) * NWAVES + C.wave, (C.G - tail) * NWAVES, false, false, true, 0, YW_IN_HI); }); }
        else { RUN(sb + 1, { gphase_in(C.lds, ws, D_IN_EVEN_PAD / 256, C.G);
                   const int tail = ((MROWS / 256) * (D_IN_EVEN_PAD / 256)) % C.G;
                   if (CHUNKED_SCAN && l + 1 < DEPTH && tail > 0 && (int)blockIdx.x >= tail) conv_items(C, A, l + 1, ((int)blockIdx.x - tail) * NWAVES + C.wave, (C.G - tail) * NWAVES, false, false, true, 0, XW_IN_HI); }); }
        if (!odd) {
            RUN(sb + 2, phase_ef1(C, A, l));
            RUN(sb + 3, { const int i2 = l >> 1; gphase_lora(C.lds, ws, A.in[I_D0] + (size_t)i2 * 2 * 768, A.in[I_A0] + (size_t)i2 * 2 * 768, A.in[I_KAL] + (size_t)i2 * 768, C.G); });
#if CHUNKED_SCAN
            RUN(sb + 4, phase_csa(C, A));
            RUN(sb + 5, phase_csb(C, A, l));
#else
            RUN(sb + 4, phase_scan(C, A));
#endif
            RUN(sb + 6, phase_ef2(C, A, l));
        } else {
            RUN(sb + 2, { phase_of1(C, A, l);
                   const int busy2 = 256 + 8 * 7 - C.G;
                   if (CHUNKED_SCAN && l + 1 < DEPTH && busy2 > 0 && (int)blockIdx.x >= busy2) conv_items(C, A, l + 1, ((int)blockIdx.x - busy2) * NWAVES + C.wave, (C.G - busy2) * NWAVES, false, false, true, YW_IN_HI, YW_OF_HI); });
            RUN(sb + 3, phase_attn(C, A, l));
        }
        RUN(sb + 7, { gphase_out(C.lds, ws, MODL, C.G, l == 0 ? A.in[I_X] : (const float*)(ws + WS_X), l == 0 ? A.in[I_CTX] : (const float*)(ws + WS_X) + (size_t)NLAT * DM);
                   const int tail = ((MROWS / 256) * (DM / 256)) % C.G;
                   if (CHUNKED_SCAN && l + 1 < DEPTH && tail > 0 && (int)blockIdx.x >= tail) conv_items(C, A, l + 1, ((int)blockIdx.x - tail) * NWAVES + C.wave, (C.G - tail) * NWAVES, false, false, true, odd ? YW_OF_HI : XW_IN_HI, odd ? YW_OUT_HI : XW_OUT_HI); });
        RUN(sb + 8, phase_rt(C, A, l));
        RUN(sb + 9, { phase_tk(C, A);
                   if (CHUNKED_SCAN && l + 1 < DEPTH && (int)blockIdx.x >= 128) conv_items(C, A, l + 1, ((int)blockIdx.x - 128) * NWAVES + C.wave, (C.G - 128) * NWAVES, false, false, true, odd ? YW_OUT_HI : XW_OUT_HI, odd ? YW_TK_HI : XW_TK_HI); });
        RUN(sb + 10, gphase_e1(C.lds, ws, C.G, l));
        RUN(sb + 11, gphase_e2(C.lds, ws, C.G, l));
        RUN(sb + 12, { phase_cb(C, A, l); if (CHUNKED_SCAN && !odd && l + 1 < DEPTH) { __syncthreads(); conv_items(C, A, l + 1, C.gw, C.NGW, false, true, false); } });
    }
#undef RUN
}

#ifdef PHASE_PROBE
#define PROBE_PRE extern __shared__ __attribute__((aligned(16))) unsigned char lds_raw[]; Ctx C; mkctx(C, (LAS unsigned char*)lds_raw); unsigned char* ws = A.ws; (void)ws;
__global__ void __launch_bounds__(NTHR, 2) pr_init(Args A) { PROBE_PRE phase_init(C, A); }
__global__ void __launch_bounds__(NTHR, 2) pr_conv(Args A) { PROBE_PRE phase_conv(C, A, A.lo); }
__global__ void __launch_bounds__(NTHR, 2) pr_modh(Args A) { PROBE_PRE phase_modh(C, A, A.lo); }
__global__ void __launch_bounds__(NTHR, 2) pr_ef1(Args A) { PROBE_PRE phase_ef1(C, A, A.lo); }
__global__ void __launch_bounds__(NTHR, 2) pr_scan(Args A) { PROBE_PRE phase_scan(C, A); }
__global__ void __launch_bounds__(NTHR, 2) pr_ef2(Args A) { PROBE_PRE phase_ef2(C, A, A.lo); }
__global__ void __launch_bounds__(NTHR, 2) pr_csa(Args A) { PROBE_PRE phase_csa(C, A); }
__global__ void __launch_bounds__(NTHR, 2) pr_csb(Args A) { PROBE_PRE phase_csb(C, A, A.lo); }
__global__ void __launch_bounds__(NTHR, 2) pr_of1(Args A) { PROBE_PRE phase_of1(C, A, A.lo); }
__global__ void __launch_bounds__(NTHR, 2) pr_attn(Args A) { PROBE_PRE phase_attn(C, A, A.lo); }
__global__ void __launch_bounds__(NTHR, 2) pr_rt(Args A) { PROBE_PRE phase_rt(C, A, A.lo); }
__global__ void __launch_bounds__(NTHR, 2) pr_tk(Args A) { PROBE_PRE phase_tk(C, A); }
__global__ void __launch_bounds__(NTHR, 2) pr_cb(Args A) { PROBE_PRE phase_cb(C, A, A.lo); }
__global__ void __launch_bounds__(NTHR, 2) pr_gemm_in(Args A) { PROBE_PRE pg8::Gemm g{(const bf16_t*)(ws + WS_H), (const bf16_t*)(ws + WS_WIN), DM}; pg8::Order<0> S; S.init(MROWS / 256, A.lo, C.G, (int)blockIdx.x, nullptr, 0);
                      pg8::EpiBf16 E{(bf16_t*)(ws + WS_P), P_LD}; pg8::gemm_phase(C.lds, g, S, E); }
__global__ void __launch_bounds__(NTHR, 2) pr_gemm_lora(Args A) { PROBE_PRE pg8::Gemm g{(const bf16_t*)(ws + WS_LIN), (const bf16_t*)(ws + WS_WLORA), LORA_K}; pg8::Order<0> S; S.init(MROWS / 256, LORA_N / 256, C.G, (int)blockIdx.x, nullptr, 0);
                          const int i2 = A.lo; pg8::EpiLora E{ws + WS_SCN, (bf16_t*)(ws + WS_G), A.in[I_D0] + (size_t)i2 * 2 * 768, A.in[I_A0] + (size_t)i2 * 2 * 768, A.in[I_KAL] + (size_t)i2 * 768};
                          pg8::gemm_phase(C.lds, g, S, E); }
__global__ void __launch_bounds__(NTHR, 2) pr_gemm_out(Args A) { PROBE_PRE pg8::Gemm g{(const bf16_t*)(ws + WS_A2), (const bf16_t*)(ws + WS_WOUT), DM}; pg8::Order<0> S; S.init(MROWS / 256, DM / 256, C.G, (int)blockIdx.x, nullptr, 0);
                      pg8::EpiRes E{(float*)(ws + WS_X), (const float*)(ws + WS_MOD), (const float*)(ws + WS_X), (const float*)(ws + WS_X) + (size_t)NLAT * DM}; pg8::gemm_phase(C.lds, g, S, E); }
__global__ void __launch_bounds__(NTHR, 2) pr_gemm_e1(Args A) { PROBE_PRE pg8::Gemm g{(const bf16_t*)(ws + WS_H), (const bf16_t*)(ws + WS_WE13), DM}; pg8::Order<1> S; S.init(NEXP * 17, 4096 / 256, C.G, (int)blockIdx.x, (const int*)(ws + WS_IDX), (long)4096 * DM);
                      pg8::EpiSwiGLU E{(bf16_t*)(ws + WS_HID)}; pg8::gemm_phase(C.lds, g, S, E); }
__global__ void __launch_bounds__(NTHR, 2) pr_gemm_e2(Args A) { PROBE_PRE pg8::Gemm g{(const bf16_t*)(ws + WS_HID), (const bf16_t*)(ws + WS_WE2), D_EXP}; pg8::Order<2> S; S.init(NEXP * 17, DM / 256, C.G, (int)blockIdx.x, nullptr, (long)DM * D_EXP);
                       pg8::EpiYE E{(bf16_t*)(ws + WS_YE), (const float*)(ws + WS_GATE)}; pg8::gemm_phase(C.lds, g, S, E); }
#endif

extern "C" void kernel_launch(void* const* d_in, const int* in_sizes, int n_in, void* d_out, int out_size, void* d_ws, size_t ws_size, hipStream_t stream) {
    static int grid = 0;
    if (grid == 0) {
        if (n_in != 37 || out_size != NLAT * DM || ws_size < WS_END) { fprintf(stderr, "kernel_launch: unexpected shapes: n_in %d out %d ws %zu (need %zu)\n", n_in, out_size, ws_size, (size_t)WS_END); grid = -1; return; }
        int dev = 0, cus = 0, per_cu = 0;
        if (hipGetDevice(&dev) != hipSuccess || hipDeviceGetAttribute(&cus, hipDeviceAttributeMultiprocessorCount, dev) != hipSuccess) { grid = -1; return; }
        if (hipFuncSetAttribute((const void*)mk_fwd, hipFuncAttributeMaxDynamicSharedMemorySize, LDS_BYTES) != hipSuccess) { fprintf(stderr, "kernel_launch: hipFuncSetAttribute failed\n"); grid = -1; return; }
        if (hipOccupancyMaxActiveBlocksPerMultiprocessor(&per_cu, (const void*)mk_fwd, NTHR, LDS_BYTES) != hipSuccess || per_cu < 1) fprintf(stderr, "kernel_launch: occupancy query reports %d\n", per_cu);
        (void)hipGetLastError();
        grid = cus;
    }
    if (grid < 0) return;
    (void)hipMemsetAsync((char*)d_ws + WS_CTL, 0, CTL_BYTES, stream);
    Args a{};
    for (int i = 0; i < 37; ++i) a.in[i] = (const float*)d_in[i];
    a.out = (float*)d_out; a.ws = (unsigned char*)d_ws;
#if MK_MULTI
    for (int k = 0; k < NSTEP; ++k) {
        if (k >= 1) { const int l = (k - 1) / NSLOT, s = (k - 1) % NSLOT; if ((l & 1) && ((s >= 4 && s <= 6) || (CHUNKED_SCAN && s == 0))) continue; if (!(l & 1) && !CHUNKED_SCAN && s == 5) continue; }
        a.lo = k; a.hi = k + 1;
        hipLaunchKernelGGL(mk_fwd, dim3(grid), dim3(NTHR), LDS_BYTES, stream, a);
    }
#else
    a.lo = 0; a.hi = NSTEP;
    hipLaunchKernelGGL(mk_fwd, dim3(grid), dim3(NTHR), LDS_BYTES, stream, a);
#endif
    const hipError_t le = hipPeekAtLastError();
    if (le != hipSuccess) fprintf(stderr, "kernel_launch: launch failed: %s\n", hipGetErrorName(le));
}
```

```cpp
#include <hip/hip_runtime.h>
#include <cstdio>
#include <cstdint>
#include <cmath>

#ifndef MK_MULTI
#define MK_MULTI 0
#endif
#ifndef CHUNKED_SCAN
#define CHUNKED_SCAN 1
#endif

#define GAS __attribute__((address_space(1)))
#define LAS __attribute__((address_space(3)))
typedef unsigned short bf16_t;
typedef short bf16x8 __attribute__((ext_vector_type(8)));
typedef float f32x4 __attribute__((ext_vector_type(4)));
typedef float f32x2 __attribute__((ext_vector_type(2)));
typedef float f32x16 __attribute__((ext_vector_type(16)));
typedef unsigned u32x4 __attribute__((ext_vector_type(4)));
typedef unsigned u32x2 __attribute__((ext_vector_type(2)));
typedef __bf16 bf16x2_t __attribute__((ext_vector_type(2)));

constexpr int NB = 4, TT = 8192, DM = 1024, NLAT = NB * TT, CTXL = 256, NCTX = NB * CTXL, MROWS = NLAT + NCTX;
constexpr int DEPTH = 4;
constexpr int D_CONV = 256, RW_H = 12, RW_K = 64, D_RWKV = 768, RWKV_COLS = 2688, D_IN_EVEN = 3456, D_IN_EVEN_PAD = 3584;
constexpr int D_DIFF = 768, D_GMLP = 256, D_IN_ODD = 2816;
constexpr int NEXP = 16, D_EXP = 2048, CAP_L = 1024, CAP_C = 32, ESLOTS = 4352;
constexpr int P_LD = 3584;
constexpr int LORA_K = 384, LORA_N = 3840;
constexpr int LKEYS = CTXL + TT;
constexpr float ALPHA_DN = 1.6817928305074290f;
constexpr float DECAY_SCALE = 0.6065306597126334f;
constexpr float GN_EPS = 64e-5f, LN_EPS = 1e-5f, RMS_EPS = 1e-5f;
constexpr float QSCALE = 0.125f * 1.4426950408889634f;

constexpr size_t al256(size_t x) { return (x + 255) & ~(size_t)255; }
constexpr size_t WS_CTL = 0;
constexpr size_t CTL_BYTES = 65536;
constexpr size_t WS_MOD = WS_CTL + CTL_BYTES;
constexpr size_t WS_ROPE = WS_MOD + al256((size_t)DEPTH * 5 * 6144 * 4);
constexpr size_t WS_WIN = WS_ROPE + 32768;
constexpr size_t WS_WOUT = WS_WIN + (size_t)D_IN_EVEN_PAD * DM * 2;
constexpr size_t WS_WLORA = WS_WOUT + (size_t)DM * DM * 2;
constexpr size_t WS_WE13 = WS_WLORA + (size_t)LORA_N * LORA_K * 2;
constexpr size_t WE13_BYTES = (size_t)NEXP * 4096 * DM * 2, WE2_BYTES = (size_t)NEXP * DM * D_EXP * 2;
constexpr size_t WS_WE2 = WS_WE13 + 2 * WE13_BYTES;
constexpr size_t WS_X = WS_WE2 + 2 * WE2_BYTES;
constexpr size_t WS_H = WS_X + (size_t)MROWS * DM * 4;
constexpr size_t WS_A2 = WS_H + (size_t)MROWS * DM * 2;
constexpr size_t WS_P = WS_A2 + (size_t)MROWS * DM * 2;
constexpr size_t WS_AFF = WS_P + (size_t)MROWS * P_LD * 2;
constexpr size_t WS_SLOT = WS_AFF + (size_t)MROWS * 16 * 4;
constexpr size_t WS_IDX = WS_SLOT + (size_t)MROWS * 16 * 4;
constexpr size_t WS_GATE = WS_IDX + al256((size_t)NEXP * ESLOTS * 4);
constexpr size_t WS_R2 = WS_GATE + al256((size_t)NEXP * ESLOTS * 4);
constexpr int SC_REC = 1408, SC_ROW = 12 * SC_REC, SC_W = 0, SC_R = 512, SC_KK = 640, SC_V = 768, SC_B = 896, SC_KR = 1024;
constexpr size_t WS_SCN = WS_R2;
constexpr size_t WS_G = WS_SCN + (size_t)MROWS * SC_ROW;
constexpr size_t WS_LIN = WS_G + (size_t)MROWS * 768 * 2;
constexpr int CS_L = 64, CS_NCH = LKEYS / CS_L, CS_UNITS = NB * RW_H * 2;
constexpr size_t WS_CHK = WS_LIN + (size_t)MROWS * 384 * 2;
constexpr size_t WS_EVEN_END = WS_CHK + (size_t)CS_UNITS * CS_NCH * 32768;
constexpr size_t WS_Y = WS_P;
constexpr size_t WS_Q = WS_R2;
constexpr size_t WS_KA = WS_Q + (size_t)MROWS * 768 * 2;
constexpr size_t WS_VT = WS_KA + (size_t)NB * LKEYS * 768 * 2;
constexpr size_t WS_HID = WS_R2;
constexpr size_t WS_YE = WS_HID + (size_t)NEXP * ESLOTS * D_EXP * 2;
constexpr size_t WS_END = WS_EVEN_END;
static_assert(WS_END <= (size_t)2147483648ull, "workspace over 2 GiB");
static_assert((size_t)2 * MROWS * 768 * 4 <= (size_t)MROWS * P_LD * 2, "Y aliases P");
static_assert(WS_YE + (size_t)NEXP * ESLOTS * DM * 2 <= WS_END, "moe region");

constexpr int LDS_BYTES = 147456;
constexpr int LDS_MISC = 140 * 1024;
constexpr int LDS_PTAB = LDS_MISC + 256;
constexpr int NWAVES = 8, NTHR = 512;

__device__ __forceinline__ unsigned f2bf(float f) { unsigned u = __float_as_uint(f); return (u + 0x7fffu + ((u >> 16) & 1u)) >> 16; }
__device__ __forceinline__ unsigned pk2(float lo, float hi) { f32x2 v = {lo, hi}; bf16x2_t b = __builtin_convertvector(v, bf16x2_t); return __builtin_bit_cast(unsigned, b); }
__device__ __forceinline__ float bflo(unsigned u) { return __uint_as_float(u << 16); }
__device__ __forceinline__ float bfhi(unsigned u) { return __uint_as_float(u & 0xffff0000u); }
__device__ __forceinline__ float bf2f(bf16_t b) { return __uint_as_float((unsigned)b << 16); }
__device__ __forceinline__ float sigmoidf_(float x) { return __builtin_amdgcn_rcpf(1.f + __expf(-x)); }
#define DPP_MOV_F(v, ctrl) __uint_as_float((unsigned)__builtin_amdgcn_update_dpp(0, (int)__float_as_uint(v), (ctrl), 0xF, 0xF, true))
__device__ __forceinline__ float lx1(float v) { return DPP_MOV_F(v, 0xB1); }
__device__ __forceinline__ float lx2(float v) { return DPP_MOV_F(v, 0x4E); }
__device__ __forceinline__ float lx4(float v) { const float t = DPP_MOV_F(v, 0x141); return DPP_MOV_F(t, 0x1B); }
__device__ __forceinline__ float lx8(float v) { return DPP_MOV_F(v, 0x128); }
__device__ __forceinline__ float lx16(float v, int lane) { const auto r = __builtin_amdgcn_permlane16_swap(__float_as_uint(v), __float_as_uint(v), false, false); return __uint_as_float((lane & 16) ? r[0] : r[1]); }
__device__ __forceinline__ float lx32(float v, int lane) { const auto r = __builtin_amdgcn_permlane32_swap(__float_as_uint(v), __float_as_uint(v), false, false); return __uint_as_float((lane & 32) ? r[0] : r[1]); }
__device__ __forceinline__ float sum16(float v) {
    v += DPP_MOV_F(v, 0xB1); v += DPP_MOV_F(v, 0x4E); v += DPP_MOV_F(v, 0x141); v += DPP_MOV_F(v, 0x140);
    return v;
}
__device__ __forceinline__ float wave_sum(float v) {
    v = sum16(v);
    { const auto r = __builtin_amdgcn_permlane16_swap(__float_as_uint(v), __float_as_uint(v), false, false); v = __uint_as_float(r[0]) + __uint_as_float(r[1]); }
    { const auto r = __builtin_amdgcn_permlane32_swap(__float_as_uint(v), __float_as_uint(v), false, false); v = __uint_as_float(r[0]) + __uint_as_float(r[1]); }
    return v;
}
__device__ __forceinline__ f32x4 ld4bf_(const void* p) { const u32x2 u = *(const u32x2*)p; return (f32x4){bflo(u.x), bfhi(u.x), bflo(u.y), bfhi(u.y)}; }
__device__ __forceinline__ void st4bf_(void* p, f32x4 v) { u32x2 o; o.x = pk2(v[0], v[1]); o.y = pk2(v[2], v[3]); *(u32x2*)p = o; }
__device__ __forceinline__ float max3f(float a, float b, float c) { float r; asm("v_max3_f32 %0, %1, %2, %3" : "=v"(r) : "v"(a), "v"(b), "v"(c)); return r; }
__device__ __forceinline__ int crow(int r, int hi) { return (r & 3) + 8 * (r >> 2) + 4 * hi; }
__device__ __forceinline__ f32x2 gelu_pk(f32x2 v) {
    const f32x2 av = __builtin_elementwise_abs(v), d = av * 0.2316418882f + 1.0f;
    f32x2 t; t.x = __builtin_amdgcn_rcpf(d.x); t.y = __builtin_amdgcn_rcpf(d.y);
    f32x2 q = t * 0.5307027145f + (-0.7265760135f); q = q * t + 0.7107068705f; q = q * t + (-0.142248368f); q = q * t + 0.127414796f; q = q * t;
    const f32x2 s = (v * v) * (-0.72134752044f);
    f32x2 e; e.x = __builtin_amdgcn_exp2f(s.x); e.y = __builtin_amdgcn_exp2f(s.y);
    const f32x2 m = v * (q * e), r = v - m;
    f32x2 o; o.x = v.x < 0.f ? m.x : r.x; o.y = v.y < 0.f ? m.y : r.y; return o;
}
__device__ __forceinline__ f32x4 gelu4(f32x4 v) { const f32x2 a = gelu_pk((f32x2){v[0], v[1]}), b = gelu_pk((f32x2){v[2], v[3]}); return (f32x4){a.x, a.y, b.x, b.y}; }
__device__ __forceinline__ float tanh_fast(float x) { return 1.f - 2.f * __builtin_amdgcn_rcpf(1.f + __expf(2.f * x)); }

#define XB_TMO      128
#define XB_XCNT(j)  (256  + 64 * (j))
#define XB_XSUB(j)  (1280 + 64 * (j))
#define XB_XGEN(j)  (2304 + 64 * (j))
#define XB_TOP      3328
#define XB_TOPGEN   3392
#define XCD_BAR_WORDS 3456
#define XB_SPIN_CAP (1u << 20)

__device__ __forceinline__ unsigned xb_ld(unsigned* p)              { return __hip_atomic_load(p, __ATOMIC_RELAXED, __HIP_MEMORY_SCOPE_AGENT); }
__device__ __forceinline__ unsigned xb_add(unsigned* p, unsigned v) { return __hip_atomic_fetch_add(p, v, __ATOMIC_RELAXED, __HIP_MEMORY_SCOPE_AGENT); }
__device__ __forceinline__ unsigned xb_xcc_id() { return (unsigned)__builtin_amdgcn_s_getreg((3 << 11) | 20) & 0xFu; }
#define XB_SPIN(cond, bar) do { unsigned _sp = 0; while (cond) { __builtin_amdgcn_s_sleep(1); \
    if ((++_sp & 255u) == 0u) { if (xb_ld(&(bar)[XB_TMO])) break; if (_sp > XB_SPIN_CAP) { atomicAdd(&(bar)[XB_TMO], 1u); break; } } } } while (0)

struct XcdBarrier { unsigned* bar; unsigned x; volatile LAS unsigned* st; };

__device__ __forceinline__ XcdBarrier xcd_barrier_post(unsigned* bar, volatile LAS unsigned* st) {
    XcdBarrier b; b.bar = bar; b.x = xb_xcc_id(); b.st = st;
    if (threadIdx.x == 0) (void)xb_add(&bar[XB_XCNT(b.x)], 1u);
    return b;
}
__device__ __forceinline__ void xcd_barrier_complete(unsigned* bar, unsigned x, unsigned& nloc, unsigned& nx) {
    const unsigned G = gridDim.x * gridDim.y * gridDim.z;
    unsigned sum, cnt, mine, sp = 0u;
    for (;;) {
        sum = 0u; cnt = 0u; mine = 0u;
#pragma unroll
        for (unsigned j = 0; j < 16; ++j) { const unsigned c = xb_ld(&bar[XB_XCNT(j)]); sum += c; cnt += (c > 0u) ? 1u : 0u; mine = (j == x) ? c : mine; }
        if (sum == G) break;
        __builtin_amdgcn_s_sleep(1);
        if ((++sp & 255u) == 0u) { if (xb_ld(&bar[XB_TMO])) break; if (sp > XB_SPIN_CAP) { atomicAdd(&bar[XB_TMO], 1u); break; } }
    }
    nloc = mine > 0u ? mine : 1u; nx = cnt > 0u ? cnt : 1u;
}
__device__ __forceinline__ void xcd_barrier(const XcdBarrier& b) {
    asm volatile("s_waitcnt vmcnt(0)" ::: "memory");
    __syncthreads();
    if (threadIdx.x == 0) {
        unsigned* bar = b.bar;
        __builtin_amdgcn_s_waitcnt(0);
        unsigned nloc = b.st[0], nx = b.st[1];
        if (nloc == 0u) { xcd_barrier_complete(bar, b.x, nloc, nx); b.st[0] = nloc; b.st[1] = nx; }
        const unsigned old = xb_add(&bar[XB_XSUB(b.x)], 1u);
        const unsigned gen = old / nloc;
        if (old + 1u == (gen + 1u) * nloc) {
            __builtin_amdgcn_fence(__ATOMIC_RELEASE, "agent");
            asm volatile("s_waitcnt vmcnt(0)" ::: "memory");
            const unsigned og = xb_add(&bar[XB_TOP], 1u);
            const unsigned tg = og / nx;
            if (og + 1u == (tg + 1u) * nx) xb_add(&bar[XB_TOPGEN], 1u);
            else XB_SPIN(xb_ld(&bar[XB_TOPGEN]) == tg, bar);
            __builtin_amdgcn_fence(__ATOMIC_ACQUIRE, "agent");
            xb_add(&bar[XB_XGEN(b.x)], 1u);
            asm volatile("s_waitcnt vmcnt(0)" ::: "memory");
        } else {
            XB_SPIN(xb_ld(&bar[XB_XGEN(b.x)]) == gen, bar);
            __builtin_amdgcn_fence(__ATOMIC_ACQUIRE, "agent");
            asm volatile("s_waitcnt vmcnt(0)" ::: "memory");
        }
    }
    __syncthreads();
}

namespace pg8 {
constexpr int BM = 256, BK = 64, HALF = 128, HTB = HALF * BK * 2, STAGE_BYTES = 8 * HTB, NXCD = 8, WGM = 8;
__host__ __device__ __forceinline__ int lds_byte(int r, int c) { const int st = (r >> 4) * 2 + (c >> 5), rr = r & 15, cc = c & 31, ob = rr * 64 + cc * 2; return st * 1024 + (ob ^ (((ob >> 9) & 1) << 5)); }
__host__ __device__ __forceinline__ void stage_rc(int b, int& R, int& C) { const int st = b / 1024, sb = b % 1024, swz = sb ^ (((sb >> 9) & 1) << 5); R = (st >> 1) * 16 + swz / 64; C = (st & 1) * 32 + (swz % 64) / 2; }

struct Unit { int pm, pn, hf; };
struct Gemm { const bf16_t* A; const bf16_t* Bt; int K; };

template <int MODE> struct Order {
    static constexpr bool GATHER = (MODE == 1);
    int nM, nN, nwg, G, c; const int* idx; long bstride;
    __device__ __forceinline__ void init(int nM_, int nN_, int G_, int c_, const int* idx_, long bstride_) { nM = nM_; nN = nN_; nwg = nM * nN; G = G_; c = c_; idx = idx_; bstride = bstride_; }
    __device__ __forceinline__ bool next(int i, Unit& u) const {
        const long L = (long)i * G + c; if (L >= nwg) return false;
        int wgid = (int)L; { const int q = nwg / NXCD, r = nwg % NXCD, xcd = wgid % NXCD, off = wgid / NXCD; wgid = (xcd < r ? xcd * (q + 1) : r * (q + 1) + (xcd - r) * q) + off; }
        const int nig = WGM * nN, gid = wgid / nig, fm = gid * WGM, gsz = (nM - fm) < WGM ? (nM - fm) : WGM;
        u.pm = fm + ((wgid % nig) % gsz); u.pn = (wgid % nig) / gsz; u.hf = (MODE != 0 && (u.pm % 17) == 16) ? 1 : 0; return true;
    }
    __device__ __forceinline__ unsigned arow(const Unit& u, int r) const { if (MODE == 1) return (unsigned)idx[u.pm * BM + r]; return (unsigned)(u.pm * BM + r); }
    __device__ __forceinline__ long bbase(const Unit& u, int K) const { long o = (long)u.pn * BM * K; if (MODE != 0) o += (long)(u.pm / 17) * bstride; return o; }
};

template <int MODE> struct OrderExp {
    static constexpr bool GATHER = (MODE == 1);
    int nN, G, c0; const int* idx; long bstride;
    __device__ __forceinline__ void init(int nN_, int G_, int c_, const int* idx_, long bstride_) { nN = nN_; G = G_; c0 = c_; idx = idx_; bstride = bstride_; }
    __device__ __forceinline__ bool next(int i0, Unit& u) const {
        const int v = i0 * G + c0, i = v >> 8, c = v & 255;
        const int x = c & 7, slot = c >> 3, per = 32 / nN, nfull = 256 / (8 * per);
        if (i > nfull) return false;
        if (i < nfull) { u.pn = slot / per; const int f = (i * 8 + x) * per + (slot % per); u.pm = (f >> 4) * 17 + (f & 15); u.hf = 0; return true; }
        if (i == nfull && slot < 2 * nN) { u.pn = slot >> 1; u.pm = (x * 2 + (slot & 1)) * 17 + 16; u.hf = 1; return true; }
        return false;
    }
    __device__ __forceinline__ unsigned arow(const Unit& u, int r) const { if (MODE == 1) return (unsigned)idx[u.pm * BM + r]; return (unsigned)(u.pm * BM + r); }
    __device__ __forceinline__ long bbase(const Unit& u, int K) const { return (long)u.pn * BM * K + (long)(u.pm / 17) * bstride; }
};

template <class Epi, class Sched>
__device__ __forceinline__ void gemm_phase(LAS unsigned char* lds, const Gemm g, const Sched& S, const Epi& E) {
    int tid = threadIdx.x; asm volatile("" : "+v"(tid));
    const int wid = __builtin_amdgcn_readfirstlane(tid >> 6), wr = wid >> 2, wc = wid & 3;
    const int K = g.K, nt = K / BK;
    unsigned voffB[2];
    { const int lane = tid & 63, fr = lane & 15, fq = lane >> 4; (void)fr; (void)fq; }
#pragma unroll
    for (int i = 0; i < 2; ++i) { int R, Cc; stage_rc(tid * 16 + i * 8192, R, Cc); voffB[i] = (unsigned)(R * K + Cc) * 2u; }
    const size_t kstep = (size_t)(BK * 2);
    const size_t hstep = (size_t)HALF * K * 2;
    const unsigned ldsw = (unsigned)wid * 1024u;
    const int aoff = lds_byte(wr * 64 + (tid & 15), ((tid & 63) >> 4) * 8), boff = lds_byte(wc * 32 + (tid & 15), ((tid & 63) >> 4) * 8);
#define PG8_SA(b, h) (((b) * 2 + (h)) * HTB)
#define PG8_SB(b, h) ((4 + (b) * 2 + (h)) * HTB)
#define PG8_STAGE(bufoff, gbase, voff) do { _Pragma("unroll") for (int _i = 0; _i < 2; ++_i) \
        __builtin_amdgcn_global_load_lds((const unsigned*)((const char*)(gbase) + (voff)[_i]), (LAS unsigned*)(lds + (bufoff) + ldsw + _i * 8192), 16, 0, 0); } while (0)
#define PG8_LDA(dst, b, h) do { _Pragma("unroll") for (int m = 0; m < 4; ++m) _Pragma("unroll") for (int k = 0; k < 2; ++k) dst[m][k] = *(const LAS bf16x8*)(lds + PG8_SA(b, h) + aoff + m * 2048 + k * 1024); } while (0)
#define PG8_LDB(dst, b, h) do { _Pragma("unroll") for (int n = 0; n < 2; ++n) _Pragma("unroll") for (int k = 0; k < 2; ++k) dst[n][k] = *(const LAS bf16x8*)(lds + PG8_SB(b, h) + boff + n * 2048 + k * 1024); } while (0)
#define PG8_MMA(ai, bj, At, Bt) do { __builtin_amdgcn_s_setprio(1); _Pragma("unroll") for (int m = 0; m < 4; ++m) _Pragma("unroll") for (int n = 0; n < 2; ++n) _Pragma("unroll") for (int k = 0; k < 2; ++k) \
        acc[ai][bj][m][n] = __builtin_amdgcn_mfma_f32_16x16x32_bf16(Bt[n][k], At[m][k], acc[ai][bj][m][n], 0, 0, 0); __builtin_amdgcn_s_setprio(0); } while (0)
#define PG8_WAIT_V(n) asm volatile("s_waitcnt vmcnt(" #n ")" ::: "memory")
#define PG8_WAIT_L(n) asm volatile("s_waitcnt lgkmcnt(" #n ")" ::: "memory")
#define PG8_BAR __builtin_amdgcn_s_barrier()
#define PG8_SCHED __builtin_amdgcn_sched_barrier(0)
#define PG8_ROWOFFS(dst, u, tq) do { _Pragma("unroll") for (int _i = 0; _i < 2; ++_i) { int _R, _C; stage_rc((tq) * 16 + _i * 8192, _R, _C); _Pragma("unroll") for (int _h = 0; _h < 2; ++_h) dst[_h][_i] = (S.arow(u, _h * HALF + _R) * (unsigned)K + (unsigned)_C) * 2u; } } while (0)
    Unit cur, nxt; int ui = 0;
    if (!S.next(0, cur)) return;
    float zf = 0.f; asm volatile("" : "+v"(zf));
    f32x4 acc[2][2][4][2];
#pragma unroll
    for (int a = 0; a < 2; ++a)
#pragma unroll
        for (int b = 0; b < 2; ++b)
#pragma unroll
            for (int m = 0; m < 4; ++m)
#pragma unroll
                for (int n = 0; n < 2; ++n) acc[a][b][m][n] = (f32x4){zf, zf, zf, zf};
    bf16x8 At[4][2], B0[2][2], B1[2][2];
    unsigned vcur[2][2];
    if constexpr (Sched::GATHER) { PG8_ROWOFFS(vcur, cur, tid); }
    const char* const Ab = (const char*)g.A;
    const char* cA = Sched::GATHER ? Ab : Ab + (size_t)(unsigned)__builtin_amdgcn_readfirstlane((int)S.arow(cur, 0)) * K * 2;
#define PG8_STAGEA(bufoff, ptr, h) do { if constexpr (Sched::GATHER) { PG8_STAGE(bufoff, ptr, vcur[h]); } else { PG8_STAGE(bufoff, (ptr) + (h) * hstep, voffB); } } while (0)
    const char* cB = (const char*)g.Bt + (size_t)S.bbase(cur, K) * 2;
    PG8_STAGE(PG8_SB(0, 0), cB, voffB); PG8_STAGE(PG8_SB(0, 1), cB + hstep, voffB); PG8_STAGEA(PG8_SA(0, 0), cA, 0); PG8_STAGEA(PG8_SA(0, 1), cA, 1);
    if (wr == 1) PG8_BAR;
    PG8_WAIT_V(2); PG8_BAR;
    PG8_STAGE(PG8_SB(1, 0), cB + kstep, voffB); PG8_STAGEA(PG8_SA(1, 0), cA + kstep, 0); PG8_STAGE(PG8_SB(1, 1), cB + hstep + kstep, voffB);
    PG8_WAIT_V(6); PG8_BAR;
    for (;;) {
        const bool has_next = S.next(ui + 1, nxt);
        const char* nB = has_next ? (const char*)g.Bt + (size_t)S.bbase(nxt, K) * 2 : cB;
        const char* nA = (Sched::GATHER || !has_next) ? cA : Ab + (size_t)(unsigned)__builtin_amdgcn_readfirstlane((int)S.arow(nxt, 0)) * K * 2;
#pragma unroll 1
        for (int t = 0; t < nt; t += 2) {
            const bool last = (t == nt - 2);
            const char* a1 = cA + (size_t)(t + 1) * kstep;
            const char* a2 = last ? nA : cA + (size_t)(t + 2) * kstep; const char* b2 = last ? nB : cB + (size_t)(t + 2) * kstep;
            const char* a3 = a2 + kstep; const char* b3 = b2 + kstep;
            PG8_LDB(B0, 0, 0); PG8_LDB(B1, 0, 1); PG8_SCHED; PG8_LDA(At, 0, 0); PG8_STAGEA(PG8_SA(1, 1), a1, 1);
            PG8_WAIT_V(8); PG8_WAIT_L(0); PG8_BAR; PG8_MMA(0, 0, At, B0); PG8_MMA(0, 1, At, B1); PG8_BAR; PG8_SCHED;
            if constexpr (Sched::GATHER) { if (last && has_next) { int tq = tid; asm volatile("" : "+v"(tq)); PG8_ROWOFFS(vcur, nxt, tq); } }
            PG8_LDA(At, 0, 1); PG8_STAGE(PG8_SB(0, 0), b2, voffB); PG8_STAGE(PG8_SB(0, 1), b2 + hstep, voffB); PG8_STAGEA(PG8_SA(0, 0), a2, 0);
            PG8_WAIT_V(8); PG8_WAIT_L(0); PG8_BAR; if (!cur.hf) { PG8_MMA(1, 0, At, B0); PG8_MMA(1, 1, At, B1); } PG8_BAR; PG8_SCHED;
            PG8_LDB(B0, 1, 0); PG8_LDB(B1, 1, 1); PG8_SCHED; PG8_LDA(At, 1, 0); PG8_STAGEA(PG8_SA(0, 1), a2, 1);
            PG8_WAIT_V(8); PG8_WAIT_L(0); PG8_BAR; PG8_MMA(0, 0, At, B0); PG8_MMA(0, 1, At, B1); PG8_BAR; PG8_SCHED;
            PG8_LDA(At, 1, 1); PG8_STAGE(PG8_SB(1, 0), b3, voffB); PG8_STAGE(PG8_SB(1, 1), b3 + hstep, voffB); PG8_STAGEA(PG8_SA(1, 0), a3, 0);
            PG8_WAIT_V(8); PG8_WAIT_L(0); PG8_BAR; if (!cur.hf) { PG8_MMA(1, 0, At, B0); PG8_MMA(1, 1, At, B1); } PG8_BAR; PG8_SCHED;
        }
        if (wr == 0) PG8_BAR;
        { int tz = tid; asm volatile("" : "+v"(tz)); const int ln = tz & 63; E(acc, cur, wr, wc, ln & 15, ln >> 4); }
        if (!has_next) break;
#pragma unroll
        for (int a = 0; a < 2; ++a)
#pragma unroll
            for (int b = 0; b < 2; ++b)
#pragma unroll
                for (int m = 0; m < 4; ++m)
#pragma unroll
                    for (int n = 0; n < 2; ++n) acc[a][b][m][n] = (f32x4){zf, zf, zf, zf};
        cur = nxt; cB = nB; cA = nA; ++ui;
        if (wr == 1) PG8_BAR;
    }
    PG8_WAIT_V(0);
    PG8_BAR;
#undef PG8_SA
#undef PG8_SB
#undef PG8_STAGE
#undef PG8_LDA
#undef PG8_LDB
#undef PG8_MMA
#undef PG8_WAIT_V
#undef PG8_WAIT_L
#undef PG8_BAR
#undef PG8_SCHED
#undef PG8_ROWOFFS
#undef PG8_STAGEA
}

#define EPI_LOOP for (int ai = 0; ai < 2; ++ai) for (int m = 0; m < 4; ++m) for (int bj = 0; bj < 2; ++bj) for (int n = 0; n < 2; ++n)
__device__ __forceinline__ int colw_of(int fq) { return (fq & 1) * 16 + (fq >> 1) * 8; }
__device__ __forceinline__ void st_pair_bf16(bf16_t* p  , f32x4 v0, f32x4 v1) {
    const unsigned a0 = pk2(v0[0], v0[1]), a1 = pk2(v0[2], v0[3]), b0 = pk2(v1[0], v1[1]), b1 = pk2(v1[2], v1[3]);
    const auto r0 = __builtin_amdgcn_permlane16_swap(a0, b0, false, false); const auto r1 = __builtin_amdgcn_permlane16_swap(a1, b1, false, false);
    u32x4 o; o.x = r0[0]; o.y = r1[0]; o.z = r0[1]; o.w = r1[1]; *(u32x4*)p = o;
}
__device__ __forceinline__ void ld_pair_bf16(const void* p, u32x2& n0, u32x2& n1) {
    const u32x4 w = *(const u32x4*)p;
    const auto r0 = __builtin_amdgcn_permlane16_swap(w.x, w.z, false, false); const auto r1 = __builtin_amdgcn_permlane16_swap(w.y, w.w, false, false);
    n0.x = r0[0]; n0.y = r1[0]; n1.x = r0[1]; n1.y = r1[1];
}
struct EpiBf16 {
    bf16_t* O; int ldc;
    __device__ __forceinline__ void operator()(const f32x4 (&acc)[2][2][4][2], const Unit& u, int wr, int wc, int fr, int fq) const {
        const int row0 = u.pm * BM + wr * 64 + fr, colg = u.pn * BM + wc * 32 + colw_of(fq);
#pragma unroll
        for (int ai = 0; ai < 2; ++ai)
#pragma unroll
            for (int m = 0; m < 4; ++m) { bf16_t* rowp = O + (size_t)(row0 + ai * HALF + m * 16) * ldc + colg;
#pragma unroll
                for (int bj = 0; bj < 2; ++bj) st_pair_bf16(rowp + bj * HALF, acc[ai][bj][m][0], acc[ai][bj][m][1]); }
    }
};
struct EpiOdd {
    bf16_t* P; bf16_t* Q; bf16_t* KA; const float* rope;
    __device__ __forceinline__ void operator()(const f32x4 (&acc)[2][2][4][2], const Unit& u, int wr, int wc, int fr, int fq) const {
        const int row0 = u.pm * BM + wr * 64 + fr, col0 = u.pn * BM + wc * 32 + 4 * fq;
        if (u.pn >= 6) {
#pragma unroll
            for (int ai = 0; ai < 2; ++ai)
#pragma unroll
                for (int m = 0; m < 4; ++m) { bf16_t* rowp = P + (size_t)(row0 + ai * HALF + m * 16) * P_LD + (col0 - 4 * fq + colw_of(fq));
#pragma unroll
                    for (int bj = 0; bj < 2; ++bj) st_pair_bf16(rowp + bj * HALF, acc[ai][bj][m][0], acc[ai][bj][m][1]); }
            return;
        }
        const bool isk = u.pn >= 3, isctx = u.pm >= NLAT / BM; const int axis = wc & 1;
        const int cq = col0 - (isk ? 768 : 0);
        f32x4 csr[2][4], snr[2][4];
#pragma unroll
        for (int ai = 0; ai < 2; ++ai)
#pragma unroll
            for (int m = 0; m < 4; ++m) { const int row = row0 + ai * HALF + m * 16; csr[ai][m] = (f32x4){1.f, 1.f, 1.f, 1.f}; snr[ai][m] = (f32x4){0.f, 0.f, 0.f, 0.f};
                if (!isctx) { const int t = row & (TT - 1); const int pos = axis ? 128 + (t & 63) : (t >> 6);
                    csr[ai][m] = *(const f32x4*)(rope + pos * 16 + 4 * fq); snr[ai][m] = *(const f32x4*)(rope + 192 * 16 + pos * 16 + 4 * fq); } }
#pragma unroll
        for (int ai = 0; ai < 2; ++ai)
#pragma unroll
            for (int m = 0; m < 4; ++m) { const int row = row0 + ai * HALF + m * 16;
                const f32x4 cs = csr[ai][m], sn = snr[ai][m]; size_t orow;
                if (!isctx) { const int t = row & (TT - 1); orow = isk ? (size_t)(row >> 13) * LKEYS + CTXL + t : (size_t)row; }
                else { const int rc = row - NLAT; orow = isk ? (size_t)(rc >> 8) * LKEYS + (rc & 255) : (size_t)row; }
                bf16_t* op = (isk ? KA : Q) + orow * 768 + cq; const float sc = isk ? 1.f : QSCALE;
#pragma unroll
                for (int bj = 0; bj < 2; ++bj) { const f32x4 x1 = acc[ai][bj][m][0], x2 = acc[ai][bj][m][1];
                    const f32x4 o1 = (x1 * cs - x2 * sn) * sc, o2 = (x1 * sn + x2 * cs) * sc;
                    st_pair_bf16(op + bj * HALF - 4 * fq + colw_of(fq), o1, o2); } }
    }
};
struct EpiRes {
    float* X; const float* modl; const float* xin; const float* cin;
    __device__ __forceinline__ void operator()(const f32x4 (&acc)[2][2][4][2], const Unit& u, int wr, int wc, int fr, int fq) const {
        const int row0 = u.pm * BM + wr * 64 + fr, col0 = u.pn * BM + wc * 32 + 4 * fq;
        const int mi = (u.pm * BM < NLAT) ? (u.pm * BM) / TT : 4;
        const float* gate = modl + mi * 6144 + 2 * DM;
        const float* rsrc = (u.pm * BM < NLAT) ? xin : cin - (size_t)NLAT * DM;
        f32x4 gv[2][2];
#pragma unroll
        for (int bj = 0; bj < 2; ++bj)
#pragma unroll
            for (int n = 0; n < 2; ++n) gv[bj][n] = *(const f32x4*)(gate + col0 + bj * HALF + n * 16);
#pragma unroll
        for (int ai = 0; ai < 2; ++ai) { f32x4 xr[4][2][2];
#pragma unroll
            for (int m = 0; m < 4; ++m) { const float* rowp = rsrc + (size_t)(row0 + ai * HALF + m * 16) * DM + col0;
#pragma unroll
                for (int bj = 0; bj < 2; ++bj)
#pragma unroll
                    for (int n = 0; n < 2; ++n) xr[m][bj][n] = *(const f32x4*)(rowp + bj * HALF + n * 16); }
#pragma unroll
            for (int m = 0; m < 4; ++m) { float* rowp = X + (size_t)(row0 + ai * HALF + m * 16) * DM + col0;
#pragma unroll
                for (int bj = 0; bj < 2; ++bj)
#pragma unroll
                    for (int n = 0; n < 2; ++n) *(f32x4*)(rowp + bj * HALF + n * 16) = xr[m][bj][n] * ALPHA_DN + gv[bj][n] * acc[ai][bj][m][n]; } }
    }
};
struct EpiSwiGLU {
    bf16_t* HID;
    __device__ __forceinline__ void operator()(const f32x4 (&acc)[2][2][4][2], const Unit& u, int wr, int wc, int fr, int fq) const {
        const int row0 = u.pm * BM + wr * 64 + fr, f0 = u.pn * HALF + wc * 32 + 4 * fq;
#pragma unroll
        for (int ai = 0; ai < 2; ++ai) if (ai == 0 || !u.hf)
#pragma unroll
            for (int m = 0; m < 4; ++m) { bf16_t* rowp = HID + (size_t)(row0 + ai * HALF + m * 16) * D_EXP + u.pn * HALF + wc * 32 + colw_of(fq); f32x4 hh[2];
#pragma unroll
                for (int n = 0; n < 2; ++n) { const f32x4 a = acc[ai][0][m][n], b = acc[ai][1][m][n];
                    const f32x4 t = a * (-1.44269504088896f); f32x4 e, r;
#pragma unroll
                    for (int j = 0; j < 4; ++j) e[j] = __builtin_amdgcn_exp2f(t[j]);
                    const f32x4 dn = e + 1.f;
#pragma unroll
                    for (int j = 0; j < 4; ++j) r[j] = __builtin_amdgcn_rcpf(dn[j]);
                    hh[n] = (a * b) * r; }
                st_pair_bf16(rowp, hh[0], hh[1]); }
    }
};
struct EpiYE {
    bf16_t* YE; const float* gate;
    __device__ __forceinline__ void operator()(const f32x4 (&acc)[2][2][4][2], const Unit& u, int wr, int wc, int fr, int fq) const {
        const int row0 = u.pm * BM + wr * 64 + fr, col0 = u.pn * BM + wc * 32 + 4 * fq;
        float gts[2][4];
#pragma unroll
        for (int ai = 0; ai < 2; ++ai)
#pragma unroll
            for (int m = 0; m < 4; ++m) gts[ai][m] = gate[row0 + ai * HALF + m * 16];
#pragma unroll
        for (int ai = 0; ai < 2; ++ai) if (ai == 0 || !u.hf)
#pragma unroll
            for (int m = 0; m < 4; ++m) { const int row = row0 + ai * HALF + m * 16; const float gt = gts[ai][m]; bf16_t* rowp = YE + (size_t)row * DM + (col0 - 4 * fq + colw_of(fq));
#pragma unroll
                for (int bj = 0; bj < 2; ++bj) st_pair_bf16(rowp + bj * HALF, acc[ai][bj][m][0] * gt, acc[ai][bj][m][1] * gt); }
    }
};
struct EpiLora {
    unsigned char* SCN; bf16_t* G; const float* decay0; const float* a0; const float* kalpha;
    __device__ __forceinline__ void operator()(const f32x4 (&acc)[2][2][4][2], const Unit& u, int wr, int wc, int fr, int fq) const {
        const int row0 = u.pm * BM + wr * 64 + fr;
        const int seg = u.pn / 3, cb = (u.pn % 3) * BM + wc * 32 + 4 * fq, cw = colw_of(fq) - 4 * fq;
        f32x4 par0[2][2], par1[2][2];
#pragma unroll
        for (int bj = 0; bj < 2; ++bj)
#pragma unroll
            for (int n = 0; n < 2; ++n) { const int col = cb + bj * HALF + n * 16; par0[bj][n] = (f32x4){0.f, 0.f, 0.f, 0.f}; par1[bj][n] = par0[bj][n];
                if (seg < 2) par0[bj][n] = *(const f32x4*)(decay0 + seg * 768 + col);
                else if (seg < 4) { par0[bj][n] = *(const f32x4*)(a0 + (seg - 2) * 768 + col); par1[bj][n] = *(const f32x4*)(kalpha + col); } }
#pragma unroll
        for (int bj = 0; bj < 2; ++bj) {
            const int colA = cb + bj * HALF, head = colA >> 6, kx0 = colA & 63;
            if (seg < 2) {
#pragma unroll
                for (int n = 0; n < 2; ++n) { const f32x4 d0 = par0[bj][n]; const int kx = kx0 + n * 16;
#pragma unroll
                    for (int ai = 0; ai < 2; ++ai)
#pragma unroll
                        for (int m = 0; m < 4; ++m) { const int row = row0 + ai * HALF + m * 16; f32x4 w;
#pragma unroll
                            for (int j = 0; j < 4; ++j) { const float lw = -DECAY_SCALE * sigmoidf_(d0[j] + acc[ai][bj][m][n][j]); w[j] = CHUNKED_SCAN ? lw : __expf(lw); }
                            *(f32x4*)(SCN + (size_t)(row * 12 + head) * SC_REC + SC_W + seg * 256 + kx * 4) = w; __builtin_amdgcn_sched_barrier(0); } }
            } else if (seg < 4) {
                const int d = seg - 2;
#pragma unroll
                for (int ai = 0; ai < 2; ++ai) {
                    u32x2 kkr[2][4], ksr[2][4];
                    u32x4 wk[4], ws_[4];
#pragma unroll
                    for (int m = 0; m < 4; ++m) { const unsigned char* base = SCN + (size_t)((row0 + ai * HALF + m * 16) * 12 + head) * SC_REC + (kx0 + cw) * 2;
                        wk[m] = *(const u32x4*)(base + SC_KK); ws_[m] = *(const u32x4*)(base + SC_KR + 256 * d); }
#pragma unroll
                    for (int m = 0; m < 4; ++m) {
                        { const auto r0 = __builtin_amdgcn_permlane16_swap(wk[m].x, wk[m].z, false, false); const auto r1 = __builtin_amdgcn_permlane16_swap(wk[m].y, wk[m].w, false, false);
                          kkr[0][m].x = r0[0]; kkr[0][m].y = r1[0]; kkr[1][m].x = r0[1]; kkr[1][m].y = r1[1]; }
                        { const auto r0 = __builtin_amdgcn_permlane16_swap(ws_[m].x, ws_[m].z, false, false); const auto r1 = __builtin_amdgcn_permlane16_swap(ws_[m].y, ws_[m].w, false, false);
                          ksr[0][m].x = r0[0]; ksr[0][m].y = r1[0]; ksr[1][m].x = r0[1]; ksr[1][m].y = r1[1]; } }
#pragma unroll
                    for (int m = 0; m < 4; ++m) { const int row = row0 + ai * HALF + m * 16; unsigned char* base = SCN + (size_t)(row * 12 + head) * SC_REC + (kx0 + cw) * 2; f32x4 bb[2], kr[2];
#pragma unroll
                        for (int n = 0; n < 2; ++n) { const f32x4 a00 = par0[bj][n], kal = par1[bj][n];
                            const f32x4 kk = {bflo(kkr[n][m].x), bfhi(kkr[n][m].x), bflo(kkr[n][m].y), bfhi(kkr[n][m].y)}; const f32x4 ks = {bflo(ksr[n][m].x), bfhi(ksr[n][m].x), bflo(ksr[n][m].y), bfhi(ksr[n][m].y)};
#pragma unroll
                            for (int j = 0; j < 4; ++j) { const float a = sigmoidf_(a00[j] + acc[ai][bj][m][n][j]); bb[n][j] = kk[j] * a; kr[n][j] = ks[j] * (1.f + (a - 1.f) * kal[j]); } }
                        st_pair_bf16((bf16_t*)(base + SC_B + 256 * d), bb[0], bb[1]); st_pair_bf16((bf16_t*)(base + SC_KR + 256 * d), kr[0], kr[1]); __builtin_amdgcn_sched_barrier(0); } }
            } else {
#pragma unroll
                for (int ai = 0; ai < 2; ++ai)
#pragma unroll
                    for (int m = 0; m < 4; ++m) { const int row = row0 + ai * HALF + m * 16; st_pair_bf16(G + (size_t)row * 768 + colA + cw, acc[ai][bj][m][0], acc[ai][bj][m][1]); }
            }
        }
    }
};
}

struct Args { const float* in[37]; float* out; unsigned char* ws; int lo, hi; };
enum { I_X = 0, I_C, I_CTX, I_CCTX, I_WMOD, I_BMOD, I_LNG, I_LNB, I_EWIN, I_EWOUT, I_CONVW, I_MU, I_DUP, I_D0, I_AUP, I_A0, I_GUP, I_KXI, I_KAL, I_RBON, I_GNG, I_GNB,
       I_OWIN, I_OWOUT, I_LQ1, I_LK1, I_LQ2, I_LK2, I_SUBG, I_GLNG, I_GLNB, I_GWS, I_GBS, I_WR, I_WE1, I_WE3, I_WE2 };

struct Ctx {
    LAS unsigned char* lds;
    int tid, lane, wave, G, vcu, gw, NGW;
};
__device__ __forceinline__ void mkctx(Ctx& C, LAS unsigned char* lds) {
    int tid = threadIdx.x; asm volatile("" : "+v"(tid));
    C.lds = lds; C.tid = tid; C.lane = tid & 63; C.wave = __builtin_amdgcn_readfirstlane(tid >> 6);
    C.G = gridDim.x; { const int bx = blockIdx.x; C.vcu = (C.G % 8 == 0) ? (bx % 8) * (C.G / 8) + bx / 8 : bx; }
    C.gw = blockIdx.x * NWAVES + C.wave; C.NGW = C.G * NWAVES;
}
#define GLOBAL_PTR(T, v) ((T*)(__attribute__((address_space(1))) T*)(v))
__device__ __forceinline__ void ldargs(Args& A, LAS unsigned char* lds) {
    LAS const u32x2* tb = (LAS const u32x2*)(lds + LDS_PTAB); asm volatile("" : "+v"(tb));
#pragma unroll
    for (int i = 0; i < 37; ++i) { const u32x2 v = tb[i]; A.in[i] = GLOBAL_PTR(const float, ((unsigned long long)(unsigned)__builtin_amdgcn_readfirstlane((int)v.y) << 32) | (unsigned)__builtin_amdgcn_readfirstlane((int)v.x)); }
    { const u32x2 v = tb[37]; A.out = GLOBAL_PTR(float, ((unsigned long long)(unsigned)__builtin_amdgcn_readfirstlane((int)v.y) << 32) | (unsigned)__builtin_amdgcn_readfirstlane((int)v.x)); }
    { const u32x2 v = tb[38]; A.ws = GLOBAL_PTR(unsigned char, ((unsigned long long)(unsigned)__builtin_amdgcn_readfirstlane((int)v.y) << 32) | (unsigned)__builtin_amdgcn_readfirstlane((int)v.x)); }
    A.lo = 0; A.hi = 0;
}
__device__ __forceinline__ int row_mi(int row) { return row < NLAT ? (row >> 13) : 4; }

__device__ __forceinline__ void phase_init(const Ctx& C, const Args& A) {
    unsigned char* ws = A.ws;
    float* MOD = (float*)(ws + WS_MOD);
    LAS float* sv = (LAS float*)C.lds;
    LAS float* red = sv + 5 * 1024;
    for (int i = C.tid; i < 5 * 1024; i += NTHR) { const int v = i >> 10, k = i & 1023; const float c = (v < 4) ? A.in[I_C][v * DM + k] : A.in[I_CCTX][k]; sv[i] = c / (1.f + __expf(-c)); }
    __syncthreads();
    const int j = C.tid & 127, kp = C.tid >> 7;
    for (int it = blockIdx.x; it < DEPTH * 48; it += C.G) {
        const int l = it / 48, cg = it % 48, col = cg * 128 + j;
        const float* W = A.in[I_WMOD] + (size_t)l * DM * 6144 + col;
        float a0 = 0.f, a1 = 0.f, a2 = 0.f, a3 = 0.f, a4 = 0.f;
#pragma unroll 32
        for (int k = kp * 256; k < kp * 256 + 256; ++k) { const float w = W[(size_t)k * 6144];     a0 += sv[k] * w; a1 += sv[1024 + k] * w; a2 += sv[2048 + k] * w; a3 += sv[3072 + k] * w; a4 += sv[4096 + k] * w; }
        red[(kp * 5 + 0) * 128 + j] = a0; red[(kp * 5 + 1) * 128 + j] = a1; red[(kp * 5 + 2) * 128 + j] = a2; red[(kp * 5 + 3) * 128 + j] = a3; red[(kp * 5 + 4) * 128 + j] = a4;
        __syncthreads();
        for (int o = C.tid; o < 5 * 128; o += NTHR) { const int v = o >> 7, jj = o & 127; const int cc = cg * 128 + jj;
            const float s = red[(0 * 5 + v) * 128 + jj] + red[(1 * 5 + v) * 128 + jj] + red[(2 * 5 + v) * 128 + jj] + red[(3 * 5 + v) * 128 + jj];
            MOD[((size_t)l * 5 + v) * 6144 + cc] = s + A.in[I_BMOD][l * 6144 + cc]; }
        __syncthreads();
    }
    if (blockIdx.x == C.G - 1) { float* rope = (float*)(ws + WS_ROPE);
        for (int i = C.tid; i < 192 * 16; i += NTHR) { const int pos = i >> 4, j = i & 15; const float ang = (float)(pos < 128 ? pos : pos - 128) * powf(10000.f, -(float)j * (1.f / 16.f));
            rope[i] = cosf(ang); rope[192 * 16 + i] = sinf(ang); } }
}

__device__ __forceinline__ void transpose_item(const float* W, int ldw, int k0, int n0, bf16_t* WT, int ldt, int drow0, LAS float* scr, int lane) {
    { float v[64]; const float* src = W + (size_t)k0 * ldw + n0 + lane;
#pragma unroll
      for (int k = 0; k < 64; ++k) v[k] = __builtin_nontemporal_load(src + (size_t)k * ldw);
#pragma unroll
      for (int k = 0; k < 64; ++k) scr[k * 65 + lane] = v[k]; }
    asm volatile("s_waitcnt lgkmcnt(0)" ::: "memory");
    const int c = lane & 7;
#pragma unroll
    for (int j = 0; j < 8; ++j) { const int n = (lane >> 3) + 8 * j; const LAS float* s = scr + (8 * c) * 65 + n;
        u32x4 o; o.x = pk2(s[0 * 65], s[1 * 65]); o.y = pk2(s[2 * 65], s[3 * 65]); o.z = pk2(s[4 * 65], s[5 * 65]); o.w = pk2(s[6 * 65], s[7 * 65]);
        *(u32x4*)(WT + (size_t)(drow0 + n) * ldt + k0 + 8 * c) = o; }
    asm volatile("s_waitcnt lgkmcnt(0)" ::: "memory");
}
constexpr int XW_IN_HI = 3200, XW_OUT_HI = 7040, XW_TK_HI = 9088;
constexpr int YW_IN_HI = 1344, YW_OF_HI = 6144, YW_OUT_HI = 9984, YW_TK_HI = 12032;
__device__ __forceinline__ void conv_items(const Ctx& C, const Args& A, int l, int gw, int NGW, bool do_in, bool do_out, bool do_exp, int lo = 0, int hi = 1 << 30) {
    unsigned char* ws = A.ws;
    const int i2 = l >> 1; const bool odd = (l & 1);
    LAS float* scr = (LAS float*)C.lds + C.wave * (64 * 65);
    bf16_t* WIN = (bf16_t*)(ws + WS_WIN); bf16_t* WOUT = (bf16_t*)(ws + WS_WOUT); bf16_t* WE13 = (bf16_t*)(ws + WS_WE13 + (size_t)(l & 1) * WE13_BYTES); bf16_t* WE2 = (bf16_t*)(ws + WS_WE2 + (size_t)(l & 1) * WE2_BYTES);
    const int nin = odd ? D_IN_ODD : D_IN_EVEN;
    const float* win = odd ? A.in[I_OWIN] + (size_t)i2 * DM * D_IN_ODD : A.in[I_EWIN] + (size_t)i2 * DM * D_IN_EVEN;
    const float* wout = odd ? A.in[I_OWOUT] + (size_t)i2 * DM * DM : A.in[I_EWOUT] + (size_t)i2 * DM * DM;
    const int n_in = do_in ? 16 * (nin / 64) : 0, n_out = do_out ? 16 * 16 : 0, n_e13 = do_exp ? NEXP * 2 * 16 * 32 : 0, n_e2 = do_exp ? NEXP * 32 * 16 : 0;
    const int total = (n_in + n_out + n_e13 + n_e2) < hi ? (n_in + n_out + n_e13 + n_e2) : hi;
    for (int it = lo + gw; it < total; it += NGW) {
        int r = it;
        if (r < n_in) { const int nb = nin / 64, kb = r / nb, nn = r % nb; transpose_item(win, nin, kb * 64, nn * 64, WIN, DM, nn * 64, scr, C.lane); continue; } r -= n_in;
        if (r < n_out) { const int kb = r / 16, nn = r % 16; transpose_item(wout, DM, kb * 64, nn * 64, WOUT, DM, nn * 64, scr, C.lane); continue; } r -= n_out;
        if (r < n_e13) { const int e = r / 1024, q = r % 1024, mat = q / 512, q2 = q % 512, kb = q2 / 32, nn = q2 % 32;
            const float* W = (mat ? A.in[I_WE3] : A.in[I_WE1]) + ((size_t)l * NEXP + e) * DM * D_EXP;
            const int f0 = nn * 64; const int drow = (f0 >> 7) * 256 + mat * 128 + (f0 & 127);
            transpose_item(W, D_EXP, kb * 64, f0, WE13 + (size_t)e * 4096 * DM, DM, drow, scr, C.lane); continue; } r -= n_e13;
        { const int e = r / 512, q = r % 512, kb = q / 16, nn = q % 16;
            const float* W = A.in[I_WE2] + ((size_t)l * NEXP + e) * D_EXP * DM;
            transpose_item(W, DM, kb * 64, nn * 64, WE2 + (size_t)e * DM * D_EXP, D_EXP, nn * 64, scr, C.lane); }
    }
}
__device__ __forceinline__ void phase_conv(const Ctx& C, const Args& A, int l) {
    unsigned char* ws = A.ws;
    const int i2 = l >> 1; const bool odd = (l & 1);
    bf16_t* WIN = (bf16_t*)(ws + WS_WIN);
    const bool early = CHUNKED_SCAN && odd;
    if (l > 0) { if (early || !CHUNKED_SCAN) conv_items(C, A, l, C.gw, C.NGW, !early, true, !early);
                 else { conv_items(C, A, l, C.gw, C.NGW, true, true, false); conv_items(C, A, l, C.gw, C.NGW, false, false, true, YW_TK_HI); } }
    if (!odd) {
        u32x4* z = (u32x4*)(WIN + (size_t)D_IN_EVEN * DM);
        unsigned zz = 0u; asm volatile("" : "+v"(zz));
        for (int i = blockIdx.x * NTHR + C.tid; i < (D_IN_EVEN_PAD - D_IN_EVEN) * DM / 8; i += C.G * NTHR) z[i] = (u32x4){zz, zz, zz, zz};
        bf16_t* WL = (bf16_t*)(ws + WS_WLORA);
        const float* dup = A.in[I_DUP] + (size_t)i2 * 2 * 64 * 768; const float* aup = A.in[I_AUP] + (size_t)i2 * 2 * 64 * 768; const float* gup = A.in[I_GUP] + (size_t)i2 * 128 * 768;
        for (int i = blockIdx.x * NTHR + C.tid; i < LORA_N * LORA_K; i += C.G * NTHR) {
            const int kk = i / LORA_N, n = i % LORA_N, seg = n / 768, col = n % 768; float v = 0.f;
            if (seg == 0) { if (kk < 64) v = dup[(size_t)(0 * 64 + kk) * 768 + col]; }
            else if (seg == 1) { if (kk >= 64 && kk < 128) v = dup[(size_t)(1 * 64 + kk - 64) * 768 + col]; }
            else if (seg == 2) { if (kk >= 128 && kk < 192) v = aup[(size_t)(0 * 64 + kk - 128) * 768 + col]; }
            else if (seg == 3) { if (kk >= 192 && kk < 256) v = aup[(size_t)(1 * 64 + kk - 192) * 768 + col]; }
            else { if (kk >= 256) v = gup[(size_t)(kk - 256) * 768 + col]; }
            WL[(size_t)n * LORA_K + kk] = (bf16_t)f2bf(v);
        }
    }
}

__device__ __forceinline__ void phase_modh(const Ctx& C, const Args& A, int l) {
    bf16_t* H = (bf16_t*)(A.ws + WS_H); const float* MOD = (const float*)(A.ws + WS_MOD) + (size_t)l * 5 * 6144;
    const float* xin = A.in[I_X]; const float* cin = A.in[I_CTX] - (size_t)NLAT * DM;
#define MODH_SRC(row_) (((row_) < NLAT ? xin : cin) + (size_t)(row_) * DM)
    const int row0 = (int)(((long)C.gw * MROWS) / C.NGW), row1 = (int)(((long)(C.gw + 1) * MROWS) / C.NGW);
    f32x4 shr[4], scr_[4], xn[4]; int cmi = -1;
    if (row0 < row1) {
#pragma unroll
        for (int j = 0; j < 4; ++j) xn[j] = *(const f32x4*)(MODH_SRC(row0) + 4 * C.lane + 256 * j); }
#pragma unroll
    for (int j = 0; j < 4; ++j) { shr[j] = (f32x4){0.f, 0.f, 0.f, 0.f}; scr_[j] = shr[j]; }
    for (int row = row0; row < row1; ++row) {
        const int mi = row_mi(row);
        if (mi != cmi) { cmi = mi; const float* md = MOD + mi * 6144;
#pragma unroll
            for (int j = 0; j < 4; ++j) { const int col = 4 * C.lane + 256 * j; shr[j] = *(const f32x4*)(md + col); scr_[j] = *(const f32x4*)(md + DM + col) + 1.f; } }
        f32x4 x[4];
#pragma unroll
        for (int j = 0; j < 4; ++j) x[j] = xn[j];
        if (row + 1 < row1) {
#pragma unroll
            for (int j = 0; j < 4; ++j) xn[j] = *(const f32x4*)(MODH_SRC(row + 1) + 4 * C.lane + 256 * j); }
#pragma unroll
        for (int j = 0; j < 4; ++j) { const int col = 4 * C.lane + 256 * j; const f32x4 h = x[j] * scr_[j] + shr[j]; u32x2 o; o.x = pk2(h[0], h[1]); o.y = pk2(h[2], h[3]); *(u32x2*)(H + (size_t)row * DM + col) = o; }
    }
}

__device__ __forceinline__ f32x4 ld4bf(const bf16_t* p) { const u32x2 u = *(const u32x2*)p; return (f32x4){bflo(u.x), bfhi(u.x), bflo(u.y), bfhi(u.y)}; }
__device__ __forceinline__ void st4bf(bf16_t* p, f32x4 v) { u32x2 o; o.x = pk2(v[0], v[1]); o.y = pk2(v[2], v[3]); *(u32x2*)p = o; }
__device__ __forceinline__ void seq_info(int row, bool& hasp, bool& hasn) {
    if (row < NLAT) { const int t = row & (TT - 1); hasp = t > 0; hasn = t < TT - 1; }
    else { const int t = (row - NLAT) & (CTXL - 1); hasp = t > 0; hasn = t < CTXL - 1; }
}
struct Ef1Row { u32x2 bg, ua, ub, m[11]; };
__device__ __forceinline__ f32x4 bf4(u32x2 u) { return (f32x4){bflo(u.x), bfhi(u.x), bflo(u.y), bfhi(u.y)}; }
__device__ __forceinline__ void ef1_load(Ef1Row& R, const bf16_t* P, int row, int lane) {
    row = row < 0 ? 0 : row > MROWS - 1 ? MROWS - 1 : row;
    const bf16_t* p = P + (size_t)row * P_LD + 4 * lane;
    R.bg = *(const u32x2*)p; R.ua = *(const u32x2*)(p + 256); R.ub = *(const u32x2*)(p + 512);
#pragma unroll
    for (int it = 0; it < 11; ++it) R.m[it] = *(const u32x2*)(p + 768 + it * 256);
}
__device__ __forceinline__ void phase_ef1(const Ctx& C, const Args& A, int l) {
    const int i2 = l >> 1; unsigned char* ws = A.ws;
    const bf16_t* P = (const bf16_t*)(ws + WS_P); bf16_t* A2 = (bf16_t*)(ws + WS_A2); unsigned char* SCN = ws + WS_SCN; bf16_t* LIN = (bf16_t*)(ws + WS_LIN);
    const float* cw = A.in[I_CONVW] + (size_t)i2 * 3 * 256; const float* mu = A.in[I_MU] + (size_t)i2 * RWKV_COLS; const float* kxi = A.in[I_KXI] + (size_t)i2 * 768;
    const int j4 = 4 * C.lane;
    const f32x4 w0 = *(const f32x4*)(cw + j4), w1 = *(const f32x4*)(cw + 256 + j4), w2 = *(const f32x4*)(cw + 512 + j4);
    f32x4 mur[11], kxr[3];
#pragma unroll
    for (int it = 0; it < 11; ++it) mur[it] = (it * 256 + j4 < RWKV_COLS) ? *(const f32x4*)(mu + it * 256 + j4) : (f32x4){0.f, 0.f, 0.f, 0.f};
#pragma unroll
    for (int it = 0; it < 3; ++it) kxr[it] = *(const f32x4*)(kxi + it * 256 + j4);
    const int row0 = (int)(((long)C.gw * MROWS) / C.NGW), row1 = (int)(((long)(C.gw + 1) * MROWS) / C.NGW);
    Ef1Row Ra, Rb, Rc, Rd;
    ef1_load(Ra, P, row0 - 1, C.lane); ef1_load(Rb, P, row0, C.lane); ef1_load(Rc, P, row0 + 1, C.lane);
    for (int row = row0; row < row1; ++row) {
        ef1_load(Rd, P, row + 2, C.lane);
        bool hasp, hasn; seq_info(row, hasp, hasn);
        const float fp = hasp ? 1.f : 0.f, fn = hasn ? 1.f : 0.f;
        {
            const f32x4 bg = bf4(Rb.bg), u0 = bf4(Rb.ua) * bf4(Rb.ub), um = bf4(Ra.ua) * bf4(Ra.ub) * fp, up = bf4(Rc.ua) * bf4(Rc.ub) * fn;
            st4bf(A2 + (size_t)row * DM + j4, bg * (w0 * um + w1 * u0 + w2 * up));
        }
#pragma unroll
        for (int it = 0; it < 11; ++it) {
            const int c = it * 256 + j4;
            if (c < RWKV_COLS) {
                const f32x4 x0 = bf4(Rb.m[it]), xm = bf4(Ra.m[it]) * fp, xp = bf4(Rc.m[it]) * fn, m4 = mur[it];
                const f32x4 ps = x0 + m4 * ((xm + xp) * 0.5f - x0);
                if (it < 3) { const int head = c >> 6, kx = c & 63; st4bf_(SCN + (size_t)(row * 12 + head) * SC_REC + SC_R + kx * 2, ps); }
                else if (it < 6) { const int c1 = c - 768, head = c1 >> 6, kx = c1 & 63; const f32x4 kv = ps * kxr[it < 6 ? (it >= 3 ? it - 3 : 0) : 0];
                    const float ss = sum16(kv[0] * kv[0] + kv[1] * kv[1] + kv[2] * kv[2] + kv[3] * kv[3]); const float rn = rsqrtf(ss + 1e-12f);
                    unsigned char* base = SCN + (size_t)(row * 12 + head) * SC_REC + kx * 2;
                    st4bf_(base + SC_KK, kv * rn); st4bf_(base + SC_KR, ps); st4bf_(base + SC_KR + 256, ps); }
                else if (it < 9) { const int c1 = c - 1536, head = c1 >> 6, kx = c1 & 63; st4bf_(SCN + (size_t)(row * 12 + head) * SC_REC + SC_V + kx * 2, ps); }
                else { const int c1 = c - 2304; f32x4 o;
                    if (c1 < 128) { o = (f32x4){tanh_fast(ps[0]), tanh_fast(ps[1]), tanh_fast(ps[2]), tanh_fast(ps[3])}; }
                    else if (c1 < 256) { o = ps; }
                    else { o = (f32x4){sigmoidf_(ps[0]), sigmoidf_(ps[1]), sigmoidf_(ps[2]), sigmoidf_(ps[3])}; }
                    st4bf(LIN + (size_t)row * LORA_K + c1, o); }
            }
        }
        Ra = Rb; Rb = Rc; Rc = Rd;
    }
}

__device__ __forceinline__ int scan_row(int i, int b, int d) {
    if (d == 0) return i < CTXL ? NLAT + b * CTXL + i : b * TT + (i - CTXL);
    return i < CTXL ? NLAT + b * CTXL + (CTXL - 1 - i) : b * TT + (TT - 1 - (i - CTXL));
}
__device__ __forceinline__ float red8(float v) {
    v += __uint_as_float((unsigned)__builtin_amdgcn_update_dpp(0, (int)__float_as_uint(v), 0xB1, 0xF, 0xF, true));
    v += __uint_as_float((unsigned)__builtin_amdgcn_update_dpp(0, (int)__float_as_uint(v), 0x4E, 0xF, 0xF, true));
    v += __uint_as_float((unsigned)__builtin_amdgcn_update_dpp(0, (int)__float_as_uint(v), 0x141, 0xF, 0xF, true));
    return v;
}
__device__ __forceinline__ float red16(float v) {
    v += __uint_as_float((unsigned)__builtin_amdgcn_update_dpp(0, (int)__float_as_uint(v), 0xB1, 0xF, 0xF, true));
    v += __uint_as_float((unsigned)__builtin_amdgcn_update_dpp(0, (int)__float_as_uint(v), 0x4E, 0xF, 0xF, true));
    v += __uint_as_float((unsigned)__builtin_amdgcn_update_dpp(0, (int)__float_as_uint(v), 0x141, 0xF, 0xF, true));
    v += __uint_as_float((unsigned)__builtin_amdgcn_update_dpp(0, (int)__float_as_uint(v), 0x140, 0xF, 0xF, true));
    return v;
}
__device__ __forceinline__ void phase_scan(const Ctx& C, const Args& A) {
    for (int u = blockIdx.x; u < 192; u += C.G) {
    const int half = u & 1, d = (u >> 1) & 1, h = (u >> 2) % 12, b = u / 48;
    const unsigned char* SCN = A.ws + WS_SCN; float* Y = (float*)(A.ws + WS_Y) + (size_t)d * MROWS * 768;
    LAS float* buf = (LAS float*)C.lds; LAS float* ybuf = buf + 2 * 32 * 352;
    constexpr int NCH = LKEYS / 32;
    u32x4 st[4];
    int ps_[4], psrc[4], pdst[4]; bool pf32[4];
#pragma unroll
    for (int j = 0; j < 4; ++j) { const int p = C.tid + NTHR * j; const int s = p / 52, q = p % 52; ps_[j] = s;
        if (q < 16) { psrc[j] = SC_W + 256 * d + q * 16; pdst[j] = s * 352 + q * 4; pf32[j] = true; }
        else if (q < 48) { const int vec = (q - 16) >> 3, part = (q - 16) & 7; const int so = vec == 0 ? SC_KK : vec == 1 ? SC_B + 256 * d : vec == 2 ? SC_KR + 256 * d : SC_R;
            psrc[j] = so + part * 16; pdst[j] = s * 352 + 64 * (vec + 1) + part * 8; pf32[j] = false; }
        else { const int part = q - 48; psrc[j] = SC_V + half * 64 + part * 16; pdst[j] = s * 352 + 320 + part * 8; pf32[j] = false; } }
    const int sgn = d ? -1 : 1;
    const unsigned char* SCNh = SCN + (size_t)h * SC_REC;
#define SCAN_ROW0(c) (((c) * 32 < CTXL) ? (NLAT + b * CTXL + (d ? CTXL - 1 - (c) * 32 : (c) * 32)) : (b * TT + (d ? TT - 1 - ((c) * 32 - CTXL) : (c) * 32 - CTXL)))
#define SCAN_LOADG(c) do { const int row0_ = SCAN_ROW0(c); _Pragma("unroll") for (int j = 0; j < 4; ++j) if (j < 3 || C.tid < 1664 - 3 * NTHR) { \
        st[j] = *(const u32x4*)(SCNh + (size_t)(row0_ + sgn * ps_[j]) * SC_ROW + psrc[j]); } } while (0)
#define SCAN_STORE(bi) do { _Pragma("unroll") for (int j = 0; j < 4; ++j) if (j < 3 || C.tid < 1664 - 3 * NTHR) { LAS float* dp = buf + (bi) * (32 * 352) + pdst[j]; \
        if (pf32[j]) *(LAS u32x4*)dp = st[j]; \
        else { *(LAS f32x4*)dp = (f32x4){bflo(st[j].x), bfhi(st[j].x), bflo(st[j].y), bfhi(st[j].y)}; *(LAS f32x4*)(dp + 4) = (f32x4){bflo(st[j].z), bfhi(st[j].z), bflo(st[j].w), bfhi(st[j].w)}; } } } while (0)
    SCAN_LOADG(0); SCAN_STORE(0); __syncthreads();
    f32x2 Sa = {0.f, 0.f}, Sb = {0.f, 0.f};
    const int rl = C.lane >> 4, ks = C.lane & 15;
    float ycol = 0.f;
#define SC_LD(R, s) do { const LAS float* bp_ = cur + (s) * 352 + ks * 4; \
        R##w = *(const LAS f32x4*)(bp_); R##k = *(const LAS f32x4*)(bp_ + 64); R##b = *(const LAS f32x4*)(bp_ + 128); R##q = *(const LAS f32x4*)(bp_ + 192); R##r = *(const LAS f32x4*)(bp_ + 256); \
        R##vv = cur[(s) * 352 + 320 + C.wave * 4 + rl]; } while (0)
#define SC_LO(v) ((f32x2){v[0], v[1]})
#define SC_HI(v) ((f32x2){v[2], v[3]})
#define SC_DPP(x, ctrl) __uint_as_float((unsigned)__builtin_amdgcn_update_dpp(0, (int)__float_as_uint(x), ctrl, 0xF, 0xF, true))
#define SC_STEP(R, P, s) do { \
        f32x2 pa = __builtin_elementwise_fma(Sb, SC_HI(R##k), Sa * SC_LO(R##k)), py = __builtin_elementwise_fma(Sb, SC_HI(P##r), Sa * SC_LO(P##r)); \
        float a_ = pa.x + pa.y, y_ = py.x + py.y; \
        a_ += SC_DPP(a_, 0xB1); y_ += SC_DPP(y_, 0xB1); a_ += SC_DPP(a_, 0x4E); y_ += SC_DPP(y_, 0x4E); \
        a_ += SC_DPP(a_, 0x141); y_ += SC_DPP(y_, 0x141); a_ += SC_DPP(a_, 0x140); y_ += SC_DPP(y_, 0x140); \
        ycol = (ks == ((s) & 15)) ? y_ : ycol; \
        const f32x2 na = {-a_, -a_}, vv2 = {R##vv, R##vv}; \
        Sa = __builtin_elementwise_fma(Sa, SC_LO(R##w), __builtin_elementwise_fma(na, SC_LO(R##b), vv2 * SC_LO(R##q))); \
        Sb = __builtin_elementwise_fma(Sb, SC_HI(R##w), __builtin_elementwise_fma(na, SC_HI(R##b), vv2 * SC_HI(R##q))); } while (0)
    f32x4 Aw, Ak, Ab, Aq, Ar, Bw, Bk, Bb, Bq, Br, Cw, Ck, Cb, Cq, Cr, Dw, Dk, Db, Dq, Dr; float Avv, Bvv, Cvv, Dvv;
    Dr = (f32x4){0.f, 0.f, 0.f, 0.f};
    for (int c = 0; c < NCH; ++c) {
        if (c + 1 < NCH) SCAN_LOADG(c + 1);
        {
            const LAS float* cur = buf + (c & 1) * (32 * 352);
            LAS float* yb = ybuf + (c & 1) * 1024 + C.wave * 4 + rl + ks * 32;
            SC_LD(A, 0); SC_LD(B, 1);
#pragma unroll 1
            for (int s = 0; s < 32; s += 4) {
                SC_LD(C, s + 2); __builtin_amdgcn_sched_barrier(0); SC_STEP(A, D, s); __builtin_amdgcn_sched_barrier(0);
                SC_LD(D, s + 3); __builtin_amdgcn_sched_barrier(0); SC_STEP(B, A, s + 1); __builtin_amdgcn_sched_barrier(0);
                SC_LD(A, s + 4); __builtin_amdgcn_sched_barrier(0); SC_STEP(C, B, s + 2); __builtin_amdgcn_sched_barrier(0);
                SC_LD(B, s + 5); __builtin_amdgcn_sched_barrier(0); SC_STEP(D, C, s + 3); __builtin_amdgcn_sched_barrier(0);
                if ((s & 15) == 12) yb[(s & 16) * 32] = ycol;
            }
        }
        if (c + 1 < NCH) SCAN_STORE((c + 1) & 1);
        __syncthreads();
        { const int row0_ = SCAN_ROW0(c);
#pragma unroll
          for (int i = 0; i < 2; ++i) { const int e = C.tid + NTHR * i, s = e >> 5, r = e & 31;
            const int row = (s > 0) ? row0_ + sgn * (s - 1) : scan_row(c * 32 - 1, b, d);
            if (s > 0 || c > 0) Y[(size_t)row * 768 + h * 64 + half * 32 + r] = ybuf[(c & 1) * 1024 + e]; } }
    }
    {
        f32x2 py = __builtin_elementwise_fma(Sb, SC_HI(Dr), Sa * SC_LO(Dr)); float y_ = py.x + py.y;
        y_ += SC_DPP(y_, 0xB1); y_ += SC_DPP(y_, 0x4E); y_ += SC_DPP(y_, 0x141); y_ += SC_DPP(y_, 0x140);
        if (ks == 0) Y[(size_t)scan_row(LKEYS - 1, b, d) * 768 + h * 64 + half * 32 + C.wave * 4 + rl] = y_;
    }
    __syncthreads();
    }
#undef SCAN_LOADG
#undef SCAN_STORE
#undef SCAN_ROW0
#undef SC_LD
#undef SC_STEP
#undef SC_LO
#undef SC_HI
#undef SC_DPP
}

constexpr int CSP = 72;
constexpr int CS_MAT = 64 * CSP * 2;
constexpr int CS_WT = 0, CS_KB = CS_MAT, CS_BB = 2 * CS_MAT, CS_RT = 3 * CS_MAT, CS_BHT = 4 * CS_MAT, CS_KHT = 5 * CS_MAT, CS_VMT = 6 * CS_MAT;
constexpr int CS_M2F = 7 * CS_MAT;
constexpr int CS_M1T = CS_M2F + 16384;
constexpr int CS_N2 = CS_M1T + CS_MAT;
constexpr int CS_GT = CS_N2 + CS_MAT;
constexpr int CS_Z = CS_M2F, CS_U = CS_M2F + CS_MAT;
constexpr int CS_GL = CS_GT + 2 * CS_MAT;
static_assert(CS_GL + 256 <= LDS_MISC, "chunked-scan LDS map");
template <bool SWZB = false>
__device__ __forceinline__ void cs_mma(f32x16& acc, const LAS unsigned char* Am, const LAS unsigned char* Bm, int ti, int tj, int r32, int hi) {
    const LAS unsigned char* ap = Am + (ti * 32 + r32) * (CSP * 2) + hi * 16; const int brow = tj * 32 + r32; const LAS unsigned char* bp = Bm + brow * (CSP * 2);
    const int sw = SWZB ? ((brow >> 3) & 7) : 0;
#pragma unroll
    for (int ks = 0; ks < 4; ++ks) acc = __builtin_amdgcn_mfma_f32_32x32x16_bf16(*(const LAS bf16x8*)(ap + ks * 32), *(const LAS bf16x8*)(bp + (((ks * 2 + hi) ^ sw) * 16)), acc, 0, 0, 0);
}
__device__ __forceinline__ void cs_store_t(LAS unsigned char* Om, const f32x16& acc, int ti, int tj, int r32, int hi) {
    LAS unsigned char* op = Om + (tj * 32 + r32) * (CSP * 2) + (ti * 32 + 4 * hi) * 2;
#pragma unroll
    for (int g = 0; g < 4; ++g) { u32x2 o; o.x = pk2(acc[4 * g], acc[4 * g + 1]); o.y = pk2(acc[4 * g + 2], acc[4 * g + 3]); *(LAS u32x2*)(op + g * 16) = o; }
}
#define CS_BAR() asm volatile("s_waitcnt lgkmcnt(0)\n\ts_barrier" ::: "memory")
__device__ __forceinline__ void phase_csa(const Ctx& C, const Args& A) {
    const unsigned char* SCN = A.ws + WS_SCN; unsigned char* CHK = A.ws + WS_CHK;
    LAS unsigned char* L = C.lds;
    const int r32 = C.lane & 31, hi = C.lane >> 5;
    float lwv[8]; u32x4 ukk, ub, ukr, ur, uv;
#define CSA_GEOM(cu_) const int unit = (cu_) / CS_NCH, ch = (cu_) % CS_NCH; const int d = unit & 1, h = (unit >> 1) % 12, b = unit / 24; \
        const int step0 = ch * CS_L; const int sgn = d ? -1 : 1; \
        const int row0 = (step0 < CTXL) ? (NLAT + b * CTXL + (d ? CTXL - 1 - step0 : step0)) : (b * TT + (d ? TT - 1 - (step0 - CTXL) : step0 - CTXL)); \
        const unsigned char* rec0 = SCN + (size_t)row0 * SC_ROW + (size_t)h * SC_REC;
#define CSA_LOAD(cu_) do { CSA_GEOM(cu_); \
        { const int k = C.tid & 63, sg = C.tid >> 6; _Pragma("unroll") for (int j = 0; j < 8; ++j) lwv[j] = *(const float*)(rec0 + (long)sgn * (8 * sg + j) * SC_ROW + SC_W + 256 * d + k * 4); } \
        { const int t = C.tid >> 3, k0 = (C.tid & 7) * 8; const unsigned char* rp = rec0 + (long)sgn * t * SC_ROW; \
          ukk = *(const u32x4*)(rp + SC_KK + k0 * 2); ub = *(const u32x4*)(rp + SC_B + 256 * d + k0 * 2); ukr = *(const u32x4*)(rp + SC_KR + 256 * d + k0 * 2); ur = *(const u32x4*)(rp + SC_R + k0 * 2); uv = *(const u32x4*)(rp + SC_V + k0 * 2); } } while (0)
    if ((int)blockIdx.x < CS_UNITS * CS_NCH) CSA_LOAD((int)blockIdx.x);
    for (int cu = blockIdx.x; cu < CS_UNITS * CS_NCH; cu += C.G) {
        LAS float* csf = (LAS float*)(L + CS_M2F);
        LAS float* seg = (LAS float*)(L + CS_N2);
        { const int k = C.tid & 63, sg = C.tid >> 6;
#pragma unroll
          for (int j = 1; j < 8; ++j) lwv[j] += lwv[j - 1];
          seg[sg * 64 + k] = lwv[7];
          CS_BAR();
          float off = 0.f, tot = 0.f;
#pragma unroll
          for (int s2 = 0; s2 < 8; ++s2) { const float v = seg[s2 * 64 + k]; off += (s2 < sg) ? v : 0.f; tot += v; }
#pragma unroll
          for (int j = 0; j < 8; ++j) csf[(8 * sg + j) * 65 + k] = lwv[j] + off;
          if (sg == 7) ((LAS float*)(L + CS_GL))[k] = __expf(tot); }
        CS_BAR();
        { const int t = C.tid >> 3, k0 = (C.tid & 7) * 8;
          float wt[8], kb[8], bb[8], rt[8], bh[8], kh[8];
#pragma unroll
          for (int j = 0; j < 8; ++j) { const unsigned pkk = j < 2 ? ukk.x : j < 4 ? ukk.y : j < 6 ? ukk.z : ukk.w, pb = j < 2 ? ub.x : j < 4 ? ub.y : j < 6 ? ub.z : ub.w, pkr = j < 2 ? ukr.x : j < 4 ? ukr.y : j < 6 ? ukr.z : ukr.w, pr = j < 2 ? ur.x : j < 4 ? ur.y : j < 6 ? ur.z : ur.w;
              const float kkv = (j & 1) ? bfhi(pkk) : bflo(pkk), bv = (j & 1) ? bfhi(pb) : bflo(pb), krv = (j & 1) ? bfhi(pkr) : bflo(pkr), rv = (j & 1) ? bfhi(pr) : bflo(pr);
              const float cst = csf[t * 65 + k0 + j], csp = t > 0 ? csf[(t - 1) * 65 + k0 + j] : 0.f, csl = csf[63 * 65 + k0 + j];
              const float einv = __expf(-cst), el = __expf(csl - cst);
              wt[j] = kkv * __expf(csp); kb[j] = krv * einv; bb[j] = bv * einv; rt[j] = rv * __expf(cst); bh[j] = bv * el; kh[j] = krv * el; }
          u32x4 o;
          o.x = pk2(wt[0], wt[1]); o.y = pk2(wt[2], wt[3]); o.z = pk2(wt[4], wt[5]); o.w = pk2(wt[6], wt[7]); *(LAS u32x4*)(L + CS_WT + t * (CSP * 2) + k0 * 2) = o;
          o.x = pk2(kb[0], kb[1]); o.y = pk2(kb[2], kb[3]); o.z = pk2(kb[4], kb[5]); o.w = pk2(kb[6], kb[7]); *(LAS u32x4*)(L + CS_KB + t * (CSP * 2) + k0 * 2) = o;
          o.x = pk2(bb[0], bb[1]); o.y = pk2(bb[2], bb[3]); o.z = pk2(bb[4], bb[5]); o.w = pk2(bb[6], bb[7]); *(LAS u32x4*)(L + CS_BB + t * (CSP * 2) + k0 * 2) = o;
          o.x = pk2(rt[0], rt[1]); o.y = pk2(rt[2], rt[3]); o.z = pk2(rt[4], rt[5]); o.w = pk2(rt[6], rt[7]); *(LAS u32x4*)(L + CS_RT + t * (CSP * 2) + k0 * 2) = o;
#pragma unroll
          for (int j = 0; j < 8; ++j) { const int to = ((((t >> 3) ^ ((k0 >> 3) & 7)) * 8) + (t & 7)) * 2;
              *(LAS bf16_t*)(L + CS_BHT + (k0 + j) * (CSP * 2) + to) = (bf16_t)f2bf(bh[j]); *(LAS bf16_t*)(L + CS_KHT + (k0 + j) * (CSP * 2) + to) = (bf16_t)f2bf(kh[j]);
              const unsigned pv = j < 2 ? uv.x : j < 4 ? uv.y : j < 6 ? uv.z : uv.w; *(LAS bf16_t*)(L + CS_VMT + (k0 + j) * (CSP * 2) + to) = (bf16_t)((j & 1) ? (pv >> 16) : (pv & 0xffffu)); } }
        if (cu + C.G < CS_UNITS * CS_NCH) CSA_LOAD(cu + C.G);
        CS_BAR();
        for (int job = C.wave; job < 12; job += NWAVES) { const int p = job >> 2, ti = (job >> 1) & 1, tj = job & 1;
            f32x16 acc;
#pragma unroll
            for (int i = 0; i < 16; ++i) acc[i] = 0.f;
            if (p == 0) { cs_mma(acc, L + CS_WT, L + CS_BB, ti, tj, r32, hi);
                const int i = tj * 32 + r32; LAS float* mp = (LAS float*)(L + CS_M2F) + i * 64;
#pragma unroll
                for (int reg = 0; reg < 16; ++reg) { const int t = ti * 32 + crow(reg, hi); mp[(t & 3) * 16 + (t >> 2)] = (i < t) ? acc[reg] : 0.f; } }
            else if (p == 1) { cs_mma(acc, L + CS_WT, L + CS_KB, ti, tj, r32, hi);
                const int i = tj * 32 + r32;
#pragma unroll
                for (int reg = 0; reg < 16; ++reg) { const int t = ti * 32 + crow(reg, hi); acc[reg] = (i < t) ? acc[reg] : 0.f; }
                cs_store_t(L + CS_M1T, acc, ti, tj, r32, hi); }
            else { cs_mma(acc, L + CS_BB, L + CS_RT, ti, tj, r32, hi);
                const int t = tj * 32 + r32;
#pragma unroll
                for (int reg = 0; reg < 16; ++reg) { const int i = ti * 32 + crow(reg, hi); acc[reg] = (i <= t) ? acc[reg] : 0.f; }
                cs_store_t(L + CS_N2, acc, ti, tj, r32, hi); } }
        CS_BAR();
        { const int c = C.tid >> 2, q = C.tid & 3; f32x2 acc2[8];
          { const LAS unsigned char* rcol = (c < 64) ? (L + CS_WT + c * 2) : (L + CS_M1T + (c - 64) * (CSP * 2)); const int rstride = (c < 64) ? CSP * 2 : 2;
#pragma unroll
            for (int j = 0; j < 16; ++j) acc2[j >> 1][j & 1] = bf2f(*(const LAS bf16_t*)(rcol + (4 * j + q) * rstride)); }
          const LAS float* m2c = (const LAS float*)(L + CS_M2F) + q * 16;
#pragma clang loop unroll(full)
          for (int i = 0; i < 64; ++i) {
              const float mine = -acc2[i >> 3][(i >> 2) & 1];
              float gi;
              switch (i & 3) { case 0: gi = __uint_as_float((unsigned)__builtin_amdgcn_update_dpp(0, (int)__float_as_uint(mine), 0x00, 0xF, 0xF, true)); break;
                               case 1: gi = __uint_as_float((unsigned)__builtin_amdgcn_update_dpp(0, (int)__float_as_uint(mine), 0x55, 0xF, 0xF, true)); break;
                               case 2: gi = __uint_as_float((unsigned)__builtin_amdgcn_update_dpp(0, (int)__float_as_uint(mine), 0xAA, 0xF, 0xF, true)); break;
                               default: gi = __uint_as_float((unsigned)__builtin_amdgcn_update_dpp(0, (int)__float_as_uint(mine), 0xFF, 0xF, 0xF, true)); break; }
              const f32x2 g2 = {gi, gi};
#pragma unroll
              for (int j4 = (i >> 4); j4 < 4; ++j4) { const f32x4 m = *(const LAS f32x4*)(m2c + i * 64 + j4 * 4);
#pragma unroll
                  for (int h = 0; h < 2; ++h) { const int p = 2 * j4 + h;
                      if (2 * p >= (i >> 2)) acc2[p] += (f32x2){m[2 * h], m[2 * h + 1]} * g2;
                      else if (2 * p + 1 >= (i >> 2)) acc2[p][1] += m[2 * h + 1] * gi; } }
          }
#pragma unroll
          for (int j = 0; j < 16; ++j) *(LAS bf16_t*)(L + CS_GT + c * (CSP * 2) + (4 * j + q) * 2) = (bf16_t)f2bf(-acc2[j >> 1][j & 1]); }
        CS_BAR();
        unsigned char* outp = CHK + (size_t)cu * 32768;
        for (int job = C.wave; job < 16; job += NWAVES) { const int p = job >> 2, ti = (job >> 1) & 1, tj = job & 1;
            f32x16 acc;
            if (p == 0) {
                const LAS unsigned char* rp = L + CS_RT + (tj * 32 + r32) * (CSP * 2) + (ti * 32 + 4 * hi) * 2;
#pragma unroll
                for (int g = 0; g < 4; ++g) { const u32x2 u = *(const LAS u32x2*)(rp + g * 16); acc[4 * g] = bflo(u.x); acc[4 * g + 1] = bfhi(u.x); acc[4 * g + 2] = bflo(u.y); acc[4 * g + 3] = bfhi(u.y); }
                cs_mma(acc, L + CS_GT, L + CS_N2, ti, tj, r32, hi);
#pragma unroll
                for (int g = 0; g < 4; ++g) { u32x2 o; o.x = pk2(acc[4 * g], acc[4 * g + 1]); o.y = pk2(acc[4 * g + 2], acc[4 * g + 3]);
                    *(u32x2*)(outp + 8192 + (((tj * 4 + 2 * ti + (g >> 1)) * 64 + (g & 1) * 32 + r32) * 16) + hi * 8) = o; } }
            else if (p == 1) {
#pragma unroll
                for (int i = 0; i < 16; ++i) acc[i] = 0.f;
                cs_mma(acc, L + CS_KB, L + CS_RT, ti, tj, r32, hi);
                const int t = tj * 32 + r32;
#pragma unroll
                for (int reg = 0; reg < 16; ++reg) { const int i = ti * 32 + crow(reg, hi); acc[reg] = (i <= t) ? acc[reg] : 0.f; }
                cs_mma(acc, L + CS_GT + 64 * (CSP * 2), L + CS_N2, ti, tj, r32, hi);
                cs_store_t(L + CS_Z, acc, ti, tj, r32, hi); }
            else if (p == 2) {
#pragma unroll
                for (int i = 0; i < 16; ++i) acc[i] = 0.f;
                cs_mma<true>(acc, L + CS_GT, L + CS_BHT, ti, tj, r32, hi);
                const int k = tj * 32 + r32; const float gl = ((const LAS float*)(L + CS_GL))[k];
#pragma unroll
                for (int reg = 0; reg < 16; ++reg) { const int cc = ti * 32 + crow(reg, hi); acc[reg] += (cc == k) ? gl : 0.f; }
#pragma unroll
                for (int g = 0; g < 4; ++g) { u32x2 o; o.x = pk2(acc[4 * g], acc[4 * g + 1]); o.y = pk2(acc[4 * g + 2], acc[4 * g + 3]);
                    *(u32x2*)(outp + (((tj * 4 + 2 * ti + (g >> 1)) * 64 + (g & 1) * 32 + r32) * 16) + hi * 8) = o; } }
            else {
                const int krow = tj * 32 + r32; const LAS unsigned char* kp = L + CS_KHT + krow * (CSP * 2) + hi * 8;
#pragma unroll
                for (int g = 0; g < 4; ++g) { const u32x2 u = *(const LAS u32x2*)(kp + (((ti * 4 + g) ^ ((krow >> 3) & 7)) * 16)); acc[4 * g] = bflo(u.x); acc[4 * g + 1] = bfhi(u.x); acc[4 * g + 2] = bflo(u.y); acc[4 * g + 3] = bfhi(u.y); }
                cs_mma<true>(acc, L + CS_GT + 64 * (CSP * 2), L + CS_BHT, ti, tj, r32, hi);
                cs_store_t(L + CS_U, acc, ti, tj, r32, hi); } }
        CS_BAR();
        { const int p = C.wave >> 2, ti = (C.wave >> 1) & 1, tj = C.wave & 1;
          f32x16 acc;
#pragma unroll
          for (int i = 0; i < 16; ++i) acc[i] = 0.f;
          cs_mma<true>(acc, L + (p ? CS_U : CS_Z), L + CS_VMT, ti, tj, r32, hi);
          unsigned char* op = outp + (p ? 16384 : 24576) + ((ti * 2 + tj) * 64 + C.lane) * 32;
          u32x4 o0, o1; o0.x = pk2(acc[0], acc[1]); o0.y = pk2(acc[2], acc[3]); o0.z = pk2(acc[4], acc[5]); o0.w = pk2(acc[6], acc[7]);
          o1.x = pk2(acc[8], acc[9]); o1.y = pk2(acc[10], acc[11]); o1.z = pk2(acc[12], acc[13]); o1.w = pk2(acc[14], acc[15]);
          *(u32x4*)op = o0; *(u32x4*)(op + 16) = o1; }
        CS_BAR();
    }
}
__device__ __forceinline__ void phase_csb(const Ctx& C, const Args& A, int l) {
    if ((int)blockIdx.x >= CS_UNITS) { const int gwf = ((int)blockIdx.x - CS_UNITS) * NWAVES + C.wave, ngwf = (C.G - CS_UNITS) * NWAVES;
        conv_items(C, A, l + 1, gwf, ngwf, true, false, false); conv_items(C, A, l + 1, gwf, ngwf, false, false, true, XW_TK_HI); return; }
    const unsigned char* CHK = A.ws + WS_CHK;
    LAS unsigned char* L = C.lds;
    const int r32 = C.lane & 31, hi = C.lane >> 5;
    const bool isS = C.wave < 4; const int ti = (C.wave >> 1) & 1, tj = C.wave & 1;
    for (int unit = blockIdx.x; unit < CS_UNITS; unit += C.G) {
        const int d = unit & 1, h = (unit >> 1) % 12, b = unit / 24;
        float* Y = (float*)(A.ws + WS_Y) + (size_t)d * MROWS * 768;
        for (int i = C.tid; i < 2 * CS_MAT / 4; i += NTHR) ((LAS unsigned*)L)[i] = 0u;
        CS_BAR();
        bf16x8 afA[4], afB[4], afC[4]; u32x4 cA0, cA1, cB0, cB1, cC0, cC1;
#define CSB_LOAD(A4, C0, C1, ch_) do { const unsigned char* op_ = CHK + ((size_t)unit * CS_NCH + (ch_)) * 32768; \
            const unsigned char* am_ = op_ + (isS ? 0 : 8192) + (ti * 4 * 64 + C.lane) * 16;     \
            _Pragma("unroll") for (int ks = 0; ks < 4; ++ks) A4[ks] = *(const bf16x8*)(am_ + ks * 1024); \
            const unsigned char* cp_ = op_ + (isS ? 16384 : 24576) + ((ti * 2 + tj) * 64 + C.lane) * 32; C0 = *(const u32x4*)cp_; C1 = *(const u32x4*)(cp_ + 16); } while (0)
#define CSB_STEP(A4, C0, C1, ch_) do { \
            const LAS unsigned char* Sb = L + ((ch_) & 1) * CS_MAT; LAS unsigned char* Sn = L + (((ch_) + 1) & 1) * CS_MAT; \
            f32x16 acc; \
            acc[0] = bflo(C0.x); acc[1] = bfhi(C0.x); acc[2] = bflo(C0.y); acc[3] = bfhi(C0.y); acc[4] = bflo(C0.z); acc[5] = bfhi(C0.z); acc[6] = bflo(C0.w); acc[7] = bfhi(C0.w); \
            acc[8] = bflo(C1.x); acc[9] = bfhi(C1.x); acc[10] = bflo(C1.y); acc[11] = bfhi(C1.y); acc[12] = bflo(C1.z); acc[13] = bfhi(C1.z); acc[14] = bflo(C1.w); acc[15] = bfhi(C1.w); \
            const LAS unsigned char* bp = Sb + (tj * 32 + r32) * (CSP * 2) + hi * 16; \
            _Pragma("unroll") for (int ks = 0; ks < 4; ++ks) acc = __builtin_amdgcn_mfma_f32_32x32x16_bf16(A4[ks], *(const LAS bf16x8*)(bp + ks * 32), acc, 0, 0, 0); \
            if (isS) { cs_store_t(Sn, acc, ti, tj, r32, hi); }     \
            else {     \
                const int step0 = (ch_) * CS_L; const int sgn = d ? -1 : 1; \
                const int row0 = (step0 < CTXL) ? (NLAT + b * CTXL + (d ? CTXL - 1 - step0 : step0)) : (b * TT + (d ? TT - 1 - (step0 - CTXL) : step0 - CTXL)); \
                float* yp = Y + (size_t)(row0 + sgn * (ti * 32 + 4 * hi)) * 768 + h * 64 + tj * 32 + r32; const long ys = (long)sgn * 768; \
                _Pragma("unroll") for (int reg = 0; reg < 16; ++reg) yp[ys * ((reg & 3) + 8 * (reg >> 2))] = acc[reg]; } \
            CS_BAR(); } while (0)
        CSB_LOAD(afA, cA0, cA1, 0); CSB_LOAD(afB, cB0, cB1, 1);
        static_assert(CS_NCH % 3 == 0, "chunk loop is unrolled by three");
        for (int ch = 0; ch < CS_NCH; ch += 3) {
            if (ch == 0) CSB_LOAD(afC, cC0, cC1, 2);
            CSB_STEP(afA, cA0, cA1, ch);     if (ch + 3 < CS_NCH) CSB_LOAD(afA, cA0, cA1, ch + 3);
            CSB_STEP(afB, cB0, cB1, ch + 1); if (ch + 4 < CS_NCH) CSB_LOAD(afB, cB0, cB1, ch + 4);
            CSB_STEP(afC, cC0, cC1, ch + 2); if (ch + 5 < CS_NCH) CSB_LOAD(afC, cC0, cC1, ch + 5);
        }
        CS_BAR();
    }
#undef CSB_LOAD
#undef CSB_STEP
}

#undef CS_BAR
struct Ef2Row { f32x4 y0[3], y1[3]; u32x2 r[3], v[3], k0[3], k1[3], g[3]; };
__device__ __forceinline__ void ef2_load(Ef2Row& R, const float* Y0, const float* Y1, const unsigned char* SCN, const bf16_t* G, int row, int lane) {
#pragma unroll
    for (int it = 0; it < 3; ++it) { const int c = it * 256 + 4 * lane, head = c >> 6, kx = c & 63;
        R.y0[it] = *(const f32x4*)(Y0 + (size_t)row * 768 + c); R.y1[it] = *(const f32x4*)(Y1 + (size_t)row * 768 + c);
        const unsigned char* base = SCN + (size_t)(row * 12 + head) * SC_REC + kx * 2;
        R.r[it] = *(const u32x2*)(base + SC_R); R.v[it] = *(const u32x2*)(base + SC_V); R.k0[it] = *(const u32x2*)(base + SC_KR); R.k1[it] = *(const u32x2*)(base + SC_KR + 256);
        R.g[it] = *(const u32x2*)(G + (size_t)row * 768 + c); }
}
__device__ __forceinline__ void phase_ef2(const Ctx& C, const Args& A, int l) {
    const int i2 = l >> 1; unsigned char* ws = A.ws;
    const unsigned char* SCN = ws + WS_SCN; const float* Y0 = (const float*)(ws + WS_Y); const float* Y1 = Y0 + (size_t)MROWS * 768;
    const bf16_t* G = (const bf16_t*)(ws + WS_G); bf16_t* A2 = (bf16_t*)(ws + WS_A2);
    const float* rb = A.in[I_RBON] + (size_t)i2 * 768; const float* gg = A.in[I_GNG] + (size_t)i2 * 768; const float* gb = A.in[I_GNB] + (size_t)i2 * 768;
    f32x4 rbr[3], ggr[3], gbr[3];
#pragma unroll
    for (int it = 0; it < 3; ++it) { const int c = it * 256 + 4 * C.lane; rbr[it] = *(const f32x4*)(rb + c); ggr[it] = *(const f32x4*)(gg + c); gbr[it] = *(const f32x4*)(gb + c); }
    Ef2Row Rn;
    if (C.gw < MROWS) ef2_load(Rn, Y0, Y1, SCN, G, C.gw, C.lane);
    for (int row = C.gw; row < MROWS; row += C.NGW) {
        const Ef2Row R = Rn;
        { const int nr = row + C.NGW < MROWS ? row + C.NGW : row; ef2_load(Rn, Y0, Y1, SCN, G, nr, C.lane); }
#pragma unroll
        for (int it = 0; it < 3; ++it) {
            const int c = it * 256 + 4 * C.lane;
            const f32x4 y = R.y0[it] + R.y1[it];
            const float mean = sum16((y[0] + y[1]) + (y[2] + y[3])) * (1.f / 64.f);
            const f32x4 dd = y - mean;
            const float var = sum16((dd[0] * dd[0] + dd[1] * dd[1]) + (dd[2] * dd[2] + dd[3] * dd[3])) * (1.f / 64.f);
            const float rstd = rsqrtf(var + GN_EPS);
            const f32x4 r = bf4(R.r[it]), v = bf4(R.v[it]), k0 = bf4(R.k0[it]), k1 = bf4(R.k1[it]);
            const f32x4 t = r * (k0 + k1) * 0.5f * rbr[it];
            const float bs = sum16((t[0] + t[1]) + (t[2] + t[3]));
            const f32x4 yn = dd * rstd * ggr[it] + gbr[it];
            const f32x4 g = bf4(R.g[it]);
            st4bf(A2 + (size_t)row * DM + 256 + c, g * (yn + v * bs));
        }
    }
}

__device__ __forceinline__ void phase_of1(const Ctx& C, const Args& A, int l) {
    const int i2 = l >> 1; unsigned char* ws = A.ws;
    const bf16_t* P = (const bf16_t*)(ws + WS_P); bf16_t* A2 = (bf16_t*)(ws + WS_A2); bf16_t* VT = (bf16_t*)(ws + WS_VT);
    const float* lng = A.in[I_GLNG] + (size_t)i2 * 256; const float* lnb = A.in[I_GLNB] + (size_t)i2 * 256;
    const float* gws = A.in[I_GWS] + (size_t)i2 * 4 * 128 * 128; const float* gbs = A.in[I_GBS] + (size_t)i2 * 4 * 128;
    LAS bf16_t* vt = (LAS bf16_t*)C.lds;
    LAS bf16_t* uL = (LAS bf16_t*)C.lds;
    LAS bf16_t* vT = (LAS bf16_t*)(C.lds + 128 * 528);
    const int r32 = C.lane & 31, hi = C.lane >> 5;
    for (int it = blockIdx.x; it < 256 + 8 * 7; it += C.G) {
        const bool isctx = it >= 256; const int uc = isctx ? (it - 256) / 7 : 0, pc = isctx ? (it - 256) % 7 : 0; const int u = it;
        const int b = isctx ? (uc >> 1) : (u >> 6), pos0 = isctx ? (uc & 1) * 128 : (u & 63) * 128;
        const int row0 = isctx ? NLAT + b * CTXL + pos0 : b * TT + pos0, L0 = isctx ? pos0 : CTXL + pos0;
        const int hh0 = isctx ? pc : 0, hh1 = isctx ? (pc < 6 ? pc + 1 : 0) : 6; const bool doC = !isctx || pc == 6;
        u32x4 pv[4];
        if (hh0 < hh1) {
#pragma unroll
            for (int i = 0; i < 4; ++i) { const int piece = C.tid + NTHR * i, r = piece >> 4, part = piece & 15; pv[i] = *(const u32x4*)(P + (size_t)(row0 + r) * P_LD + 1536 + hh0 * 128 + part * 8); } }
        for (int hh = hh0; hh < hh1; ++hh) {
#pragma unroll
            for (int i = 0; i < 4; ++i) { const int piece = C.tid + NTHR * i, r = piece >> 4, part = piece & 15;
                *(LAS u32x4*)(vt + r * 136 + part * 8) = pv[i]; }
            __syncthreads();
            if (hh + 1 < hh1) {
#pragma unroll
                for (int i = 0; i < 4; ++i) { const int piece = C.tid + NTHR * i, r = piece >> 4, part = piece & 15; pv[i] = *(const u32x4*)(P + (size_t)(row0 + r) * P_LD + 1536 + (hh + 1) * 128 + part * 8); } }
#pragma unroll
            for (int i = 0; i < 4; ++i) { const int item = C.tid + NTHR * i, d = item >> 4, tg = item & 15; const LAS bf16_t* s = vt + (tg * 8) * 136 + d;
                u32x4 o; o.x = (unsigned)s[0] | ((unsigned)s[136] << 16); o.y = (unsigned)s[2 * 136] | ((unsigned)s[3 * 136] << 16);
                o.z = (unsigned)s[4 * 136] | ((unsigned)s[5 * 136] << 16); o.w = (unsigned)s[6 * 136] | ((unsigned)s[7 * 136] << 16);
                *(u32x4*)(VT + ((size_t)(b * 6 + hh) * 128 + d) * LKEYS + L0 + tg * 8) = o; }
            __syncthreads();
        }
        if (doC) {
        const f32x4 lngr = *(const f32x4*)(lng + 4 * C.lane), lnbr = *(const f32x4*)(lnb + 4 * C.lane);
        u32x2 nxu, nxr;
        { const bf16_t* pr = P + (size_t)(row0 + C.wave) * P_LD + 2304 + 4 * C.lane; nxu = *(const u32x2*)pr; nxr = *(const u32x2*)(pr + 256); }
        for (int r = C.wave; r < 128; r += NWAVES) {
            const int c4 = 4 * C.lane;
            const f32x4 ur = bf4(nxu), raw = bf4(nxr);
            if (r + NWAVES < 128) { const bf16_t* pr = P + (size_t)(row0 + r + NWAVES) * P_LD + 2304 + c4; nxu = *(const u32x2*)pr; nxr = *(const u32x2*)(pr + 256); }
            { const f32x4 gu = gelu4(ur); u32x2 o; o.x = pk2(gu[0], gu[1]); o.y = pk2(gu[2], gu[3]); *(LAS u32x2*)(uL + r * 264 + c4) = o; }
            const f32x4 gv = gelu4(raw);
            const float mean = wave_sum((gv[0] + gv[1]) + (gv[2] + gv[3])) * (1.f / 256.f); const f32x4 dd = gv - mean;
            const float var = wave_sum((dd[0] * dd[0] + dd[1] * dd[1]) + (dd[2] * dd[2] + dd[3] * dd[3])) * (1.f / 256.f); const float rstd = rsqrtf(var + LN_EPS);
            const f32x4 o = dd * rstd * lngr + lnbr;
#pragma unroll
            for (int k = 0; k < 4; ++k) vT[(c4 + k) * 136 + r] = (bf16_t)f2bf(o[k]);
        }
        __syncthreads();
        {
            const int g = C.wave >> 1, cblk = C.wave & 1, cc = g * 64 + cblk * 32 + r32;
            for (int pblk = 0; pblk < 4; ++pblk) {
                f32x16 acc;
#pragma unroll
                for (int i = 0; i < 16; ++i) acc[i] = 0.f;
                const float* wrow = gws + ((size_t)g * 128 + pblk * 32 + r32) * 128 + 8 * hi;
#pragma unroll
                for (int ks = 0; ks < 8; ++ks) { const f32x4 w0 = *(const f32x4*)(wrow + ks * 16), w1 = *(const f32x4*)(wrow + ks * 16 + 4);
                    u32x4 au; au.x = pk2(w0[0], w0[1]); au.y = pk2(w0[2], w0[3]); au.z = pk2(w1[0], w1[1]); au.w = pk2(w1[2], w1[3]);
                    const bf16x8 bf = *(const LAS bf16x8*)(vT + cc * 136 + ks * 16 + 8 * hi);
                    acc = __builtin_amdgcn_mfma_f32_32x32x16_bf16(__builtin_bit_cast(bf16x8, au), bf, acc, 0, 0, 0); }
#pragma unroll
                for (int reg = 0; reg < 16; ++reg) { const int p = pblk * 32 + crow(reg, hi);
                    const float uu = bf2f(uL[p * 264 + cc]); const float mixed = acc[reg] + gbs[g * 128 + p];
                    uL[p * 264 + cc] = (bf16_t)f2bf(uu * mixed); }
            }
        }
        __syncthreads();
#pragma unroll
        for (int i = 0; i < 8; ++i) { const int piece = C.tid + NTHR * i, r = piece >> 5, part = piece & 31;
            *(u32x4*)(A2 + (size_t)(row0 + r) * DM + 768 + part * 8) = *(const LAS u32x4*)(uL + r * 264 + part * 8); }
        __syncthreads();
        }
    }
}

__device__ __forceinline__ void phase_attn(const Ctx& C, const Args& A, int l) {
    const int i2 = l >> 1; unsigned char* ws = A.ws;
    const bf16_t* Q = (const bf16_t*)(ws + WS_Q); const bf16_t* KA = (const bf16_t*)(ws + WS_KA); const bf16_t* VT = (const bf16_t*)(ws + WS_VT); bf16_t* A2 = (bf16_t*)(ws + WS_A2);
    const float lam_init = 0.8f - 0.6f * expf(-0.3f * (float)l);
    float s1 = 0.f, s2 = 0.f;
    for (int j = 0; j < 64; ++j) { s1 += A.in[I_LQ1][i2 * 64 + j] * A.in[I_LK1][i2 * 64 + j]; s2 += A.in[I_LQ2][i2 * 64 + j] * A.in[I_LK2][i2 * 64 + j]; }
    const float lam = expf(s1) - expf(s2) + lam_init;
    const float* subg = A.in[I_SUBG] + (size_t)i2 * 128;
    const int r32 = C.lane & 31, hi = C.lane >> 5, map = C.wave >> 2, qw = C.wave & 3;
    LAS unsigned char* Kt = C.lds; LAS unsigned char* Vt = C.lds + 2 * 16384; LAS float* xch = (LAS float*)C.lds;
    const int NU = 1536 + (l == 1 ? 48 : 0);
    for (int n = C.vcu; n < NU; n += C.G) {
        int bh, qt; bool isctx = false;
        if (n < 1536) { const int round = n >> 8, slot = n & 255; bh = (slot >> 5) * 3 + (round >> 1); qt = (round & 1) * 32 + (slot & 31); }
        else { isctx = true; bh = (n - 1536) >> 1; qt = (n - 1536) & 1; }
        const int b = bh / 6, h = bh % 6;
        const int qrow0 = isctx ? NLAT + b * CTXL + qt * 128 : b * TT + qt * 128;
        const int NT = isctx ? CTXL / 64 : LKEYS / 64;
        const bf16_t* Kb = KA + (size_t)b * LKEYS * 768 + h * 128;
        const bf16_t* Vb = VT + (size_t)(b * 6 + h) * 128 * LKEYS;
        bf16x8 qf[4];
        { const bf16_t* qp = Q + (size_t)(qrow0 + qw * 32 + r32) * 768 + h * 128 + map * 64 + 8 * hi;
#pragma unroll
          for (int ks = 0; ks < 4; ++ks) qf[ks] = *(const bf16x8*)(qp + ks * 16); }
        f32x16 O[4];
#pragma unroll
        for (int d = 0; d < 4; ++d)
#pragma unroll
            for (int i = 0; i < 16; ++i) O[d][i] = 0.f;
        float m = 0.f, lsum = 0.f;
        unsigned ksrc[2], vsrc[2];
#pragma unroll
        for (int i = 0; i < 2; ++i) { const int row = 4 * (2 * C.wave + i) + (C.lane >> 4), x = row & 15, pi = x < 4 ? x : x < 8 ? x + 4 : x < 12 ? x - 4 : x;
            ksrc[i] = (unsigned)(((row & ~15) + pi) * 768 + (((C.lane & 15) ^ x) * 8));
            const int d = 8 * (2 * C.wave + i) + (C.lane >> 3); vsrc[i] = (unsigned)(d * LKEYS + (((C.lane & 7) ^ ((d >> 1) & 7)) * 8)); }
#define AT_DMA_K(tt, slot) do { _Pragma("unroll") for (int i = 0; i < 2; ++i) __builtin_amdgcn_global_load_lds((const unsigned*)(Kb + (size_t)(tt) * 64 * 768 + ksrc[i]), (LAS unsigned*)(Kt + (slot) * 16384 + (2 * C.wave + i) * 1024), 16, 0, 0); } while (0)
#define AT_DMA_V(tt, slot) do { _Pragma("unroll") for (int i = 0; i < 2; ++i) __builtin_amdgcn_global_load_lds((const unsigned*)(Vb + (size_t)(tt) * 64 + vsrc[i]), (LAS unsigned*)(Vt + (slot) * 16384 + (2 * C.wave + i) * 1024), 16, 0, 0); } while (0)
#define AT_BAR() asm volatile("s_waitcnt vmcnt(0) lgkmcnt(0)\n\ts_barrier" ::: "memory")
#define AT_SB() __builtin_amdgcn_sched_barrier(0)
        const int ksw = r32 & 15, vsw = (r32 >> 1) & 7;
#define AT_QK(P0, P1, ks_) do { const float nm_ = -m; _Pragma("unroll") for (int i = 0; i < 16; ++i) { P0[i] = nm_; P1[i] = nm_; } \
            const LAS unsigned char* kbp_ = Kt + (ks_) * 16384 + r32 * 256; \
            _Pragma("unroll") for (int ks = 0; ks < 4; ++ks) { const int co_ = ((map * 8 + ks * 2 + hi) ^ ksw) * 16; \
                P0 = __builtin_amdgcn_mfma_f32_32x32x16_bf16(*(const LAS bf16x8*)(kbp_ + co_), qf[ks], P0, 0, 0, 0); P1 = __builtin_amdgcn_mfma_f32_32x32x16_bf16(*(const LAS bf16x8*)(kbp_ + 32 * 256 + co_), qf[ks], P1, 0, 0, 0); } } while (0)
#define AT_LDV(dst, vs_, d) do { _Pragma("unroll") for (int kst = 0; kst < 4; ++kst) dst[kst] = *(const LAS u32x4*)(Vt + (vs_) * 16384 + ((d) * 32 + r32) * 128 + (((kst * 2 + hi) ^ vsw) * 16)); } while (0)
#define AT_PV(src, d) do { _Pragma("unroll") for (int kst = 0; kst < 4; ++kst) O[d] = __builtin_amdgcn_mfma_f32_32x32x16_bf16(__builtin_bit_cast(bf16x8, src[kst]), pb[kst], O[d], 0, 0, 0); } while (0)
#define AT_SOFTPV(P0, P1, N0, N1, first, hasn, vs_) do { \
            asm volatile("" : "+v"(P0), "+v"(P1));     \
            float mx = max3f(P0[0], P0[1], P1[0]), mx2 = max3f(P0[2], P0[3], P1[1]); mx = max3f(mx, P1[2], P1[3]); \
            _Pragma("unroll") for (int i = 4; i < 16; i += 4) { mx = max3f(mx, P0[i], P0[i + 1]); mx2 = max3f(mx2, P0[i + 2], P0[i + 3]); mx = max3f(mx, P1[i], P1[i + 1]); mx2 = max3f(mx2, P1[i + 2], P1[i + 3]); } \
            mx = fmaxf(mx, mx2); \
            { auto rr = __builtin_amdgcn_permlane32_swap(__float_as_uint(mx), __float_as_uint(mx), false, false); mx = fmaxf(__uint_as_float(rr[0]), __uint_as_float(rr[1])); } \
            if ((first) || __any(mx > 8.f)) { const float dl = (first) ? mx : fmaxf(mx, 0.f); const float sc = __builtin_amdgcn_exp2f(-dl); lsum *= sc; \
                _Pragma("unroll") for (int d = 0; d < 4; ++d) _Pragma("unroll") for (int i = 0; i < 16; ++i) O[d][i] *= sc; \
                _Pragma("unroll") for (int i = 0; i < 16; ++i) { P0[i] -= dl; P1[i] -= dl; } \
                if (hasn) { asm volatile("s_nop 15\n\ts_nop 7" : "+v"(N0), "+v"(N1)); _Pragma("unroll") for (int i = 0; i < 16; ++i) { N0[i] -= dl; N1[i] -= dl; } } \
                m += dl; } \
            float ps = 0.f, ps2 = 0.f; \
            _Pragma("unroll") for (int i = 0; i < 16; ++i) { P0[i] = __builtin_amdgcn_exp2f(P0[i]); P1[i] = __builtin_amdgcn_exp2f(P1[i]); ps += P0[i]; ps2 += P1[i]; } \
            lsum += ps + ps2; \
            bf16x8 pb[4]; \
            { u32x4 w; w.x = pk2(P0[0], P0[1]); w.y = pk2(P0[2], P0[3]); w.z = pk2(P0[4], P0[5]); w.w = pk2(P0[6], P0[7]); pb[0] = __builtin_bit_cast(bf16x8, w); \
              w.x = pk2(P0[8], P0[9]); w.y = pk2(P0[10], P0[11]); w.z = pk2(P0[12], P0[13]); w.w = pk2(P0[14], P0[15]); pb[1] = __builtin_bit_cast(bf16x8, w); \
              w.x = pk2(P1[0], P1[1]); w.y = pk2(P1[2], P1[3]); w.z = pk2(P1[4], P1[5]); w.w = pk2(P1[6], P1[7]); pb[2] = __builtin_bit_cast(bf16x8, w); \
              w.x = pk2(P1[8], P1[9]); w.y = pk2(P1[10], P1[11]); w.z = pk2(P1[12], P1[13]); w.w = pk2(P1[14], P1[15]); pb[3] = __builtin_bit_cast(bf16x8, w); } \
            u32x4 va[4]; \
            AT_LDV(va, vs_, 0); AT_SB(); AT_PV(va, 0); AT_SB(); AT_LDV(va, vs_, 1); AT_SB(); AT_PV(va, 1); AT_SB(); AT_LDV(va, vs_, 2); AT_SB(); AT_PV(va, 2); AT_SB(); AT_LDV(va, vs_, 3); AT_SB(); AT_PV(va, 3); AT_SB(); } while (0)
        f32x16 pA0, pA1, pB0, pB1;
        AT_DMA_K(0, 0); AT_DMA_V(0, 0); AT_DMA_K(1, 1);
        AT_BAR();
        AT_QK(pA0, pA1, 0);
        asm volatile("s_waitcnt lgkmcnt(0)\n\ts_barrier" ::: "memory");
        for (int t = 0; t < NT; t += 2) {
            if (t + 2 < NT) AT_DMA_K(t + 2, 0);
            AT_DMA_V(t + 1, 1);
            AT_SB(); AT_QK(pB0, pB1, 1); AT_SB();
            AT_SOFTPV(pA0, pA1, pB0, pB1, t == 0, true, 0);
            AT_BAR();
            if (t + 3 < NT) AT_DMA_K(t + 3, 1);
            if (t + 2 < NT) AT_DMA_V(t + 2, 0);
            AT_SB(); if (t + 2 < NT) { AT_QK(pA0, pA1, 0); } AT_SB();
            AT_SOFTPV(pB0, pB1, pA0, pA1, false, t + 2 < NT, 1);
            AT_BAR();
        }
#undef AT_DMA_K
#undef AT_DMA_V
#undef AT_BAR
#undef AT_SB
#undef AT_QK
#undef AT_LDV
#undef AT_PV
#undef AT_SOFTPV
        const float ltot = lsum + lx32(lsum, C.lane);
        const float invl = 1.f / ltot;
        if (map == 1) { const float f = lam * invl;
#pragma unroll
            for (int d = 0; d < 4; ++d)
#pragma unroll
                for (int i = 0; i < 16; ++i) xch[(qw * 64 + d * 16 + i) * 64 + C.lane] = O[d][i] * f; }
        __syncthreads();
        if (map == 0) { float ss = 0.f;
#pragma unroll
            for (int d = 0; d < 4; ++d)
#pragma unroll
                for (int i = 0; i < 16; ++i) { const float o = O[d][i] * invl - xch[(qw * 64 + d * 16 + i) * 64 + C.lane]; O[d][i] = o; ss += o * o; }
            ss += lx32(ss, C.lane);
            const float rn = rsqrtf(ss * (1.f / 128.f) + RMS_EPS) * (1.f - lam_init);
            bf16_t* orow = A2 + (size_t)(qrow0 + qw * 32 + r32) * DM + h * 128;
#pragma unroll
            for (int d = 0; d < 4; ++d)
#pragma unroll
                for (int gp = 0; gp < 4; gp += 2) {
                    unsigned pk_[2][2];
#pragma unroll
                    for (int q = 0; q < 2; ++q) { const int g4 = gp + q, dd = 32 * d + 8 * g4 + 4 * hi; const f32x4 sg = *(const f32x4*)(subg + dd);
                        pk_[q][0] = pk2(O[d][4 * g4] * rn * sg[0], O[d][4 * g4 + 1] * rn * sg[1]); pk_[q][1] = pk2(O[d][4 * g4 + 2] * rn * sg[2], O[d][4 * g4 + 3] * rn * sg[3]); }
                    const auto r0 = __builtin_amdgcn_permlane32_swap(pk_[0][0], pk_[1][0], false, false); const auto r1 = __builtin_amdgcn_permlane32_swap(pk_[0][1], pk_[1][1], false, false);
                    u32x4 o; o.x = r0[0]; o.y = r1[0]; o.z = r0[1]; o.w = r1[1];
                    *(u32x4*)(orow + 32 * d + 8 * (gp + hi)) = o; } }
        __syncthreads();
    }
}

__device__ __forceinline__ void phase_rt(const Ctx& C, const Args& A, int l) {
    unsigned char* ws = A.ws; float* X = (float*)(ws + WS_X); bf16_t* H = (bf16_t*)(ws + WS_H); float* AFF = (float*)(ws + WS_AFF); float* STAT = (float*)(ws + WS_P);
    const float* MOD = (const float*)(ws + WS_MOD) + (size_t)l * 5 * 6144;
    const float* lng = A.in[I_LNG] + (size_t)(l * 2 + 0) * DM; const float* lnb = A.in[I_LNB] + (size_t)(l * 2 + 0) * DM;
    LAS float* wrs = (LAS float*)C.lds;
    { const float* wr = A.in[I_WR] + (size_t)l * DM * 16; for (int i = C.tid; i < DM * 16; i += NTHR) wrs[(i & 15) * 1024 + (i >> 4)] = wr[i]; }
    __syncthreads();
    const int row0 = (int)(((long)C.gw * MROWS) / C.NGW), row1 = (int)(((long)(C.gw + 1) * MROWS) / C.NGW);
    f32x4 lngr[4], lnbr[4], scr[4], shr[4]; int cmi = -1;
#pragma unroll
    for (int j = 0; j < 4; ++j) { const int col = 4 * C.lane + 256 * j; lngr[j] = *(const f32x4*)(lng + col); lnbr[j] = *(const f32x4*)(lnb + col); scr[j] = lngr[j]; shr[j] = lngr[j]; }
    f32x4 xn[4];
    if (row0 < row1) {
#pragma unroll
        for (int j = 0; j < 4; ++j) xn[j] = *(const f32x4*)(X + (size_t)row0 * DM + 4 * C.lane + 256 * j); }
    for (int row = row0; row < row1; ++row) {
        const int mi = row_mi(row);
        if (mi != cmi) { cmi = mi; const float* md = MOD + mi * 6144;
#pragma unroll
            for (int j = 0; j < 4; ++j) { const int col = 4 * C.lane + 256 * j; scr[j] = *(const f32x4*)(md + 4 * DM + col) + 1.f; shr[j] = *(const f32x4*)(md + 3 * DM + col); } }
        f32x4 x[4]; float s = 0.f;
#pragma unroll
        for (int j = 0; j < 4; ++j) { x[j] = xn[j]; s += (x[j][0] + x[j][1]) + (x[j][2] + x[j][3]); }
        if (row + 1 < row1) {
#pragma unroll
            for (int j = 0; j < 4; ++j) xn[j] = *(const f32x4*)(X + (size_t)(row + 1) * DM + 4 * C.lane + 256 * j); }
        const float mean = wave_sum(s) * (1.f / DM); float s2 = 0.f;
#pragma unroll
        for (int j = 0; j < 4; ++j) { x[j] = x[j] - mean; s2 += (x[j][0] * x[j][0] + x[j][1] * x[j][1]) + (x[j][2] * x[j][2] + x[j][3] * x[j][3]); }
        const float rstd = rsqrtf(wave_sum(s2) * (1.f / DM) + LN_EPS);
        if (C.lane == 0) *(f32x2*)(STAT + (size_t)row * 2) = (f32x2){mean, rstd};
        float v[16];
#pragma unroll
        for (int e = 0; e < 16; ++e) v[e] = 0.f;
#pragma unroll
        for (int j = 0; j < 4; ++j) { const int col = 4 * C.lane + 256 * j;
            const f32x4 x1 = x[j] * rstd * lngr[j] + lnbr[j];
            const f32x4 h = x1 * scr[j] + shr[j];
            st4bf(H + (size_t)row * DM + col, h);
#pragma unroll
            for (int e = 0; e < 16; ++e) { const f32x4 w = *(const LAS f32x4*)(wrs + e * 1024 + col); v[e] += (h[0] * w[0] + h[1] * w[1]) + (h[2] * w[2] + h[3] * w[3]); }
            __builtin_amdgcn_sched_barrier(0); }
#pragma unroll
        for (int i = 0; i < 8; ++i) { const float send = (C.lane & 32) ? v[i] : v[i + 8], keep = (C.lane & 32) ? v[i + 8] : v[i]; v[i] = keep + lx32(send, C.lane); }
#pragma unroll
        for (int i = 0; i < 4; ++i) { const float send = (C.lane & 16) ? v[i] : v[i + 4], keep = (C.lane & 16) ? v[i + 4] : v[i]; v[i] = keep + lx16(send, C.lane); }
#pragma unroll
        for (int i = 0; i < 2; ++i) { const float send = (C.lane & 8) ? v[i] : v[i + 2], keep = (C.lane & 8) ? v[i + 2] : v[i]; v[i] = keep + lx8(send); }
        { const float send = (C.lane & 4) ? v[0] : v[1], keep = (C.lane & 4) ? v[1] : v[0]; v[0] = keep + lx4(send); }
        float z = v[0]; z += lx1(z); z += lx2(z);
        float mx = z;
#pragma unroll
        for (int o = 4; o < 64; o <<= 1) mx = fmaxf(mx, o == 4 ? lx4(mx) : o == 8 ? lx8(mx) : o == 16 ? lx16(mx, C.lane) : lx32(mx, C.lane));
        const float ex = expf(z - mx); float sm = ex;
#pragma unroll
        for (int o = 4; o < 64; o <<= 1) sm += (o == 4 ? lx4(sm) : o == 8 ? lx8(sm) : o == 16 ? lx16(sm, C.lane) : lx32(sm, C.lane));
        if ((C.lane & 3) == 0) AFF[(size_t)row * 16 + (C.lane >> 2)] = ex / sm;
    }
}

__device__ __forceinline__ void phase_tk(const Ctx& C, const Args& A) {
    unsigned char* ws = A.ws; const float* AFF = (const float*)(ws + WS_AFF); int* SLOT = (int*)(ws + WS_SLOT); int* IDX = (int*)(ws + WS_IDX); float* GATE = (float*)(ws + WS_GATE);
    LAS unsigned* key = (LAS unsigned*)C.lds;
    LAS unsigned* hist = key + 8192;
    LAS unsigned* scn = hist + 256;
    LAS unsigned* wtot = scn + 256;
    LAS unsigned* bc = wtot + 8;
    for (int u = blockIdx.x; u < 128; u += C.G) {
        const bool isctx = u >= 64; const int uu = u & 63, b = uu >> 4, e = uu & 15;
        const int n = isctx ? CTXL : TT, cap = isctx ? CAP_C : CAP_L;
        const int row0 = isctx ? NLAT + b * CTXL : b * TT;
        const int slot0 = e * ESLOTS + (isctx ? 4 * CAP_L + b * CAP_C : b * CAP_L);
        for (int i = C.tid; i < n; i += NTHR) key[i] = __float_as_uint(AFF[(size_t)(row0 + i) * 16 + e]);
        unsigned prefix = 0u, pmask = 0u; int need = cap;
        for (int pass = 0; pass < 4; ++pass) {
            const int shift = 24 - 8 * pass;
            if (C.tid < 256) hist[C.tid] = 0u;
            __syncthreads();
            for (int i = C.tid; i < n; i += NTHR) { const unsigned k = key[i]; if ((k & pmask) == prefix) __hip_atomic_fetch_add(&hist[(k >> shift) & 255u], 1u, __ATOMIC_RELAXED, __HIP_MEMORY_SCOPE_WORKGROUP); }
            __syncthreads();
            {
                const unsigned hd = (C.tid < 256) ? hist[255 - C.tid] : 0u; unsigned inc = hd;
#pragma unroll
                for (int o = 1; o < 64; o <<= 1) { const unsigned t = __shfl_up(inc, o); if (C.lane >= o) inc += t; }
                if (C.tid < 256 && C.lane == 63) wtot[C.wave] = inc;
                __syncthreads();
                if (C.tid < 256) { unsigned base = 0u; for (int w = 0; w < C.wave; ++w) base += wtot[w];
                    const unsigned incl = base + inc, above = incl - hd;
                    if (incl >= (unsigned)need && above < (unsigned)need) { bc[0] = (unsigned)(255 - C.tid); bc[1] = (unsigned)need - above; } }
            }
            __syncthreads();
            prefix |= bc[0] << shift; pmask |= 255u << shift; need = (int)bc[1];
            __syncthreads();
        }
        const int per = (n + NTHR - 1) / NTHR; const int i0 = C.tid * per;
        unsigned cg = 0u, ce = 0u;
        for (int j = 0; j < per; ++j) { const int i = i0 + j; if (i < n) { const unsigned k = key[i]; cg += (k > prefix); ce += (k == prefix); } }
        unsigned pk = cg | (ce << 16), inc = pk;
#pragma unroll
        for (int o = 1; o < 64; o <<= 1) { const unsigned t = __shfl_up(inc, o); if (C.lane >= o) inc += t; }
        if (C.lane == 63) wtot[C.wave] = inc;
        __syncthreads();
        unsigned wbase = 0u;
        for (int w = 0; w < C.wave; ++w) wbase += wtot[w];
        const unsigned excl = wbase + inc - pk;
        unsigned rg = excl & 0xffffu, re = excl >> 16;
        const int ngt = cap - need;
        for (int j = 0; j < per; ++j) { const int i = i0 + j; if (i < n) { const unsigned k = key[i]; int pos = -1;
            if (k > prefix) { pos = (int)rg; ++rg; } else if (k == prefix) { if ((int)re < need) pos = ngt + (int)re; ++re; }
            const int row = row0 + i;
            if (pos >= 0) { IDX[slot0 + pos] = row; GATE[slot0 + pos] = __uint_as_float(k); SLOT[(size_t)row * 16 + e] = slot0 + pos; }
            else SLOT[(size_t)row * 16 + e] = -1; } }
        if (isctx && b == 0 && C.tid < ESLOTS - 4224) { IDX[e * ESLOTS + 4224 + C.tid] = 0; GATE[e * ESLOTS + 4224 + C.tid] = 0.f; }
        __syncthreads();
    }
}

__device__ __forceinline__ void phase_cb(const Ctx& C, const Args& A, int l) {
    unsigned char* ws = A.ws; float* X = (float*)(ws + WS_X); bf16_t* H = (bf16_t*)(ws + WS_H); const int* SLOT = (const int*)(ws + WS_SLOT); const bf16_t* YE = (const bf16_t*)(ws + WS_YE);
    const float* MOD = (const float*)(ws + WS_MOD) + (size_t)l * 5 * 6144; const float* MODN = MOD + 5 * 6144;
    const float* lng = A.in[I_LNG] + (size_t)(l * 2 + 1) * DM; const float* lnb = A.in[I_LNB] + (size_t)(l * 2 + 1) * DM;
    const float* lng1 = A.in[I_LNG] + (size_t)(l * 2 + 0) * DM; const float* lnb1 = A.in[I_LNB] + (size_t)(l * 2 + 0) * DM; const float* STAT = (const float*)(ws + WS_P);
    const int row0 = (int)(((long)C.gw * MROWS) / C.NGW), row1 = (int)(((long)(C.gw + 1) * MROWS) / C.NGW);
    f32x4 lngr[4], lnbr[4], gfr[4], nsc[4], nsh[4], l1g[4], l1b[4]; int cmi = -1;
#pragma unroll
    for (int j = 0; j < 4; ++j) { const int col = 4 * C.lane + 256 * j; lngr[j] = *(const f32x4*)(lng + col); lnbr[j] = *(const f32x4*)(lnb + col); gfr[j] = lngr[j]; nsc[j] = lngr[j]; nsh[j] = lngr[j];
        l1g[j] = *(const f32x4*)(lng1 + col); l1b[j] = *(const f32x4*)(lnb1 + col); }
    int svn = -1; f32x4 xn[4]; f32x2 stn = {0.f, 0.f};
    if (row0 < row1) { svn = SLOT[(size_t)row0 * 16 + (C.lane & 15)]; stn = *(const f32x2*)(STAT + (size_t)row0 * 2);
#pragma unroll
        for (int j = 0; j < 4; ++j) xn[j] = *(const f32x4*)(X + (size_t)row0 * DM + 4 * C.lane + 256 * j); }
    for (int row = row0; row < row1; ++row) {
        const int mi = row_mi(row);
        if (mi != cmi) { cmi = mi; const float* md = MOD + mi * 6144; const float* mn = MODN + mi * 6144;
#pragma unroll
            for (int j = 0; j < 4; ++j) { const int col = 4 * C.lane + 256 * j; gfr[j] = *(const f32x4*)(md + 5 * DM + col);
                if (l < DEPTH - 1) { nsc[j] = *(const f32x4*)(mn + DM + col) + 1.f; nsh[j] = *(const f32x4*)(mn + col); } } }
        const int sv = svn;
        unsigned mask = (unsigned)__ballot(sv >= 0) & 0xffffu;
        f32x4 acc[4];
#pragma unroll
        for (int j = 0; j < 4; ++j) acc[j] = (f32x4){0.f, 0.f, 0.f, 0.f};
        u32x2 y0[4], y1[4], y2[4], y3[4]; bool h0 = false, h1 = false, h2 = false, h3 = false;
        if (mask) { const int e = __builtin_ctz(mask); mask &= mask - 1; h0 = true; const int sl = __builtin_amdgcn_readlane(sv, e);
#pragma unroll
            for (int j = 0; j < 4; ++j) y0[j] = *(const u32x2*)(YE + (size_t)sl * DM + 4 * C.lane + 256 * j); }
        if (mask) { const int e = __builtin_ctz(mask); mask &= mask - 1; h1 = true; const int sl = __builtin_amdgcn_readlane(sv, e);
#pragma unroll
            for (int j = 0; j < 4; ++j) y1[j] = *(const u32x2*)(YE + (size_t)sl * DM + 4 * C.lane + 256 * j); }
        if (mask) { const int e = __builtin_ctz(mask); mask &= mask - 1; h2 = true; const int sl = __builtin_amdgcn_readlane(sv, e);
#pragma unroll
            for (int j = 0; j < 4; ++j) y2[j] = *(const u32x2*)(YE + (size_t)sl * DM + 4 * C.lane + 256 * j); }
        if (mask) { const int e = __builtin_ctz(mask); mask &= mask - 1; h3 = true; const int sl = __builtin_amdgcn_readlane(sv, e);
#pragma unroll
            for (int j = 0; j < 4; ++j) y3[j] = *(const u32x2*)(YE + (size_t)sl * DM + 4 * C.lane + 256 * j); }
        f32x4 x[4]; const f32x2 st = stn;
#pragma unroll
        for (int j = 0; j < 4; ++j) x[j] = xn[j];
        if (row + 1 < row1) { svn = SLOT[(size_t)(row + 1) * 16 + (C.lane & 15)]; stn = *(const f32x2*)(STAT + (size_t)(row + 1) * 2);
#pragma unroll
            for (int j = 0; j < 4; ++j) xn[j] = *(const f32x4*)(X + (size_t)(row + 1) * DM + 4 * C.lane + 256 * j); }
        if (h0) {
#pragma unroll
            for (int j = 0; j < 4; ++j) acc[j] += (f32x4){__uint_as_float(y0[j].x << 16), __uint_as_float(y0[j].x & 0xffff0000u), __uint_as_float(y0[j].y << 16), __uint_as_float(y0[j].y & 0xffff0000u)}; }
        if (h1) {
#pragma unroll
            for (int j = 0; j < 4; ++j) acc[j] += (f32x4){__uint_as_float(y1[j].x << 16), __uint_as_float(y1[j].x & 0xffff0000u), __uint_as_float(y1[j].y << 16), __uint_as_float(y1[j].y & 0xffff0000u)}; }
        if (h2) {
#pragma unroll
            for (int j = 0; j < 4; ++j) acc[j] += bf4(y2[j]); }
        if (h3) {
#pragma unroll
            for (int j = 0; j < 4; ++j) acc[j] += bf4(y3[j]); }
        while (mask) { const int e = __builtin_ctz(mask); mask &= mask - 1; const int sl = __builtin_amdgcn_readlane(sv, e);
#pragma unroll
            for (int j = 0; j < 4; ++j) acc[j] += ld4bf(YE + (size_t)sl * DM + 4 * C.lane + 256 * j); }
        float sm = 0.f;
#pragma unroll
        for (int j = 0; j < 4; ++j) { x[j] = ((x[j] - st[0]) * st[1] * l1g[j] + l1b[j]) * ALPHA_DN + gfr[j] * acc[j];
            sm += (x[j][0] + x[j][1]) + (x[j][2] + x[j][3]); }
        const float mean = wave_sum(sm) * (1.f / DM); float s2 = 0.f;
#pragma unroll
        for (int j = 0; j < 4; ++j) { x[j] = x[j] - mean; s2 += (x[j][0] * x[j][0] + x[j][1] * x[j][1]) + (x[j][2] * x[j][2] + x[j][3] * x[j][3]); }
        const float rstd = rsqrtf(wave_sum(s2) * (1.f / DM) + LN_EPS);
#pragma unroll
        for (int j = 0; j < 4; ++j) { const int col = 4 * C.lane + 256 * j;
            const f32x4 x2 = x[j] * rstd * lngr[j] + lnbr[j];
            if (l < DEPTH - 1) { *(f32x4*)(X + (size_t)row * DM + col) = x2; st4bf(H + (size_t)row * DM + col, x2 * nsc[j] + nsh[j]); }
            else if (row < NLAT) *(f32x4*)(A.out + (size_t)row * DM + col) = x2; }
    }
}


#ifndef GEMM_NOINLINE
#define GEMM_NOINLINE 0
#endif
#if GEMM_NOINLINE
#define GEMM_FN __device__ __noinline__
#else
#define GEMM_FN __device__ __forceinline__
#endif
GEMM_FN void gphase_in(LAS unsigned char* lds, unsigned char* ws, int nN, int G) {
    int bx = blockIdx.x; asm volatile("" : "+s"(bx), "+s"(G));
    pg8::Gemm g{(const bf16_t*)(ws + WS_H), (const bf16_t*)(ws + WS_WIN), DM}; pg8::Order<0> S; S.init(MROWS / 256, nN, G, bx, nullptr, 0);
    pg8::EpiBf16 E{(bf16_t*)(ws + WS_P), P_LD}; pg8::gemm_phase(lds, g, S, E); }
GEMM_FN void gphase_in_odd(LAS unsigned char* lds, unsigned char* ws, int G) {
    int bx = blockIdx.x; asm volatile("" : "+s"(bx), "+s"(G));
    pg8::Gemm g{(const bf16_t*)(ws + WS_H), (const bf16_t*)(ws + WS_WIN), DM}; pg8::Order<0> S; S.init(MROWS / 256, D_IN_ODD / 256, G, bx, nullptr, 0);
    pg8::EpiOdd E{(bf16_t*)(ws + WS_P), (bf16_t*)(ws + WS_Q), (bf16_t*)(ws + WS_KA), (const float*)(ws + WS_ROPE)}; pg8::gemm_phase(lds, g, S, E); }
GEMM_FN void gphase_lora(LAS unsigned char* lds, unsigned char* ws, const float* d0, const float* a0, const float* kal, int G) {
    int bx = blockIdx.x; asm volatile("" : "+s"(bx), "+s"(G));
    pg8::Gemm g{(const bf16_t*)(ws + WS_LIN), (const bf16_t*)(ws + WS_WLORA), LORA_K}; pg8::Order<0> S; S.init(MROWS / 256, LORA_N / 256, G, bx, nullptr, 0);
    pg8::EpiLora E{ws + WS_SCN, (bf16_t*)(ws + WS_G), d0, a0, kal}; pg8::gemm_phase(lds, g, S, E); }
GEMM_FN void gphase_out(LAS unsigned char* lds, unsigned char* ws, const float* modl, int G, const float* xin, const float* cin) {
    int bx = blockIdx.x; asm volatile("" : "+s"(bx), "+s"(G));
    pg8::Gemm g{(const bf16_t*)(ws + WS_A2), (const bf16_t*)(ws + WS_WOUT), DM}; pg8::Order<0> S; S.init(MROWS / 256, DM / 256, G, bx, nullptr, 0);
    pg8::EpiRes E{(float*)(ws + WS_X), modl, xin, cin}; pg8::gemm_phase(lds, g, S, E); }
GEMM_FN void gphase_e1(LAS unsigned char* lds, unsigned char* ws, int G, int l) {
    int bx = blockIdx.x; asm volatile("" : "+s"(bx), "+s"(G));
    pg8::Gemm g{(const bf16_t*)(ws + WS_H), (const bf16_t*)(ws + WS_WE13 + (size_t)(l & 1) * WE13_BYTES), DM}; pg8::EpiSwiGLU E{(bf16_t*)(ws + WS_HID)};
    pg8::OrderExp<1> S; S.init(4096 / 256, G, bx, (const int*)(ws + WS_IDX), (long)4096 * DM); pg8::gemm_phase(lds, g, S, E); }
GEMM_FN void gphase_e2(LAS unsigned char* lds, unsigned char* ws, int G, int l) {
    int bx = blockIdx.x; asm volatile("" : "+s"(bx), "+s"(G));
    pg8::Gemm g{(const bf16_t*)(ws + WS_HID), (const bf16_t*)(ws + WS_WE2 + (size_t)(l & 1) * WE2_BYTES), D_EXP}; pg8::EpiYE E{(bf16_t*)(ws + WS_YE), (const float*)(ws + WS_GATE)};
    pg8::OrderExp<2> S; S.init(DM / 256, G, bx, nullptr, (long)DM * D_EXP); pg8::gemm_phase(lds, g, S, E); }

constexpr int NSLOT = 13;
constexpr int NSTEP = 1 + DEPTH * NSLOT;
__global__ void __launch_bounds__(NTHR, 2) mk_fwd(Args KA) {
    extern __shared__ __attribute__((aligned(16))) unsigned char lds_raw[];
    volatile LAS unsigned* MISC = (volatile LAS unsigned*)((LAS unsigned char*)lds_raw + LDS_MISC);
    if (threadIdx.x < 16) MISC[threadIdx.x] = 0u;
    if (threadIdx.x == 0) { LAS unsigned long long* tb = (LAS unsigned long long*)((LAS unsigned char*)lds_raw + LDS_PTAB);
#pragma unroll
        for (int i = 0; i < 37; ++i) tb[i] = (unsigned long long)KA.in[i];
        tb[37] = (unsigned long long)KA.out; tb[38] = (unsigned long long)KA.ws; }
    __syncthreads();
    const int lo = KA.lo, hi = KA.hi;
    unsigned bar_x = 0;
    if (hi - lo > 1) { const XcdBarrier b0 = xcd_barrier_post((unsigned*)(KA.ws + WS_CTL), MISC); bar_x = b0.x; }
#ifndef PH_MASK
#define PH_MASK 0xFFFFFF
#endif
#ifndef REP_MASK
#define REP_MASK 0
#endif
#define PH_BIT(k) (((k) == 0) ? 0 : 1 + ((k) - 1) % NSLOT + (((k) - 1) % NSLOT >= 2 && ((k) - 1) % NSLOT <= 3 && odd ? 12 : 0))
#define RUN(k, ...) do { if (((PH_MASK >> PH_BIT(k)) & 1) && lo <= (k) && (k) < hi) { const int nrep = ((REP_MASK >> PH_BIT(k)) & 1) ? 2 : 1; \
        _Pragma("unroll 1") for (int rep = 0; rep < nrep; ++rep) { \
        Ctx C; mkctx(C, (LAS unsigned char*)lds_raw); Args A; ldargs(A, (LAS unsigned char*)lds_raw); unsigned char* ws = A.ws; \
        const float* MODL = (const float*)(ws + WS_MOD) + (size_t)l * 5 * 6144; (void)MODL; \
        __VA_ARGS__; if ((k) + 1 < hi || rep + 1 < nrep) { XcdBarrier bar; bar.bar = (unsigned*)(ws + WS_CTL); bar.x = bar_x; bar.st = MISC; xcd_barrier(bar); } } } } while (0)
    { const bool odd = false; const int l = 0; RUN(0, { phase_init(C, A); __syncthreads(); conv_items(C, A, 0, C.gw, C.NGW, true, true, true); }); }
#pragma unroll 1
    for (int l = 0; l < DEPTH; ++l) {
        const int sb = 1 + l * NSLOT; const bool odd = l & 1;
        if (!(CHUNKED_SCAN && odd)) { RUN(sb + 0, { phase_conv(C, A, l); if (l == 0) phase_modh(C, A, 0); }); }
        if (odd) { RUN(sb + 1, { gphase_in_odd(C.lds, ws, C.G);
                   const int tail = ((MROWS / 256) * (D_IN_ODD / 256)) % C.G;
                   if (CHUNKED_SCAN && l + 1 < DEPTH && tail > 0 && (int)blockIdx.x >= tail) conv_items(C, A, l + 1, ((int)blockIdx.x - tail) * NWAVES + C.wave, (C.G - tail) * NWAVES, false, false, true, 0, YW_IN_HI); }); }
        else { RUN(sb + 1, { gphase_in(C.lds, ws, D_IN_EVEN_PAD / 256, C.G);
                   const int tail = ((MROWS / 256) * (D_IN_EVEN_PAD / 256)) % C.G;
                   if (CHUNKED_SCAN && l + 1 < DEPTH && tail > 0 && (int)blockIdx.x >= tail) conv_items(C, A, l + 1, ((int)blockIdx.x - tail) * NWAVES + C.wave, (C.G - tail) * NWAVES, false, false, true, 0, XW_IN_HI); }); }
        if (!odd) {
            RUN(sb + 2, phase_ef1(C, A, l));
            RUN(sb + 3, { const int i2 = l >> 1; gphase_lora(C.lds, ws, A.in[I_D0] + (size_t)i2 * 2 * 768, A.in[I_A0] + (size_t)i2 * 2 * 768, A.in[I_KAL] + (size_t)i2 * 768, C.G); });
#if CHUNKED_SCAN
            RUN(sb + 4, phase_csa(C, A));
            RUN(sb + 5, phase_csb(C, A, l));
#else
            RUN(sb + 4, phase_scan(C, A));
#endif
            RUN(sb + 6, phase_ef2(C, A, l));
        } else {
            RUN(sb + 2, { phase_of1(C, A, l);
                   const int busy2 = 256 + 8 * 7 - C.G;
                   if (CHUNKED_SCAN && l + 1 < DEPTH && busy2 > 0 && (int)blockIdx.x >= busy2) conv_items(C, A, l + 1, ((int)blockIdx.x - busy2) * NWAVES + C.wave, (C.G - busy2) * NWAVES, false, false, true, YW_IN_HI, YW_OF_HI); });
            RUN(sb + 3, phase_attn(C, A, l));
        }
        RUN(sb + 7, { gphase_out(C.lds, ws, MODL, C.G, l == 0 ? A.in[I_X] : (const float*)(ws + WS_X), l == 0 ? A.in[I_CTX] : (const float*)(ws + WS_X) + (size_t)NLAT * DM);
                   const int tail = ((MROWS / 256) * (DM / 256)) % C.G;
                   if (CHUNKED_SCAN && l + 1 < DEPTH && tail > 0 && (int)blockIdx.x >= tail) conv_items(C, A, l + 1, ((int)blockIdx.x - tail) * NWAVES + C.wave, (C.G - tail) * NWAVES, false, false, true, odd ? YW_OF_HI : XW_IN_HI, odd ? YW_OUT_HI : XW_OUT_HI); });
        RUN(sb + 8, phase_rt(C, A, l));
        RUN(sb + 9, { phase_tk(C, A);
                   if (CHUNKED_SCAN && l + 1 < DEPTH && (int)blockIdx.x >= 128) conv_items(C, A, l + 1, ((int)blockIdx.x - 128) * NWAVES + C.wave, (C.G - 128) * NWAVES, false, false, true, odd ? YW_OUT_HI : XW_OUT_HI, odd ? YW_TK_HI : XW_TK_HI); });
        RUN(sb + 10, gphase_e1(C.lds, ws, C.G, l));
        RUN(sb + 11, gphase_e2(C.lds, ws, C.G, l));
        RUN(sb + 12, { phase_cb(C, A, l); if (CHUNKED_SCAN && !odd && l + 1 < DEPTH) { __syncthreads(); conv_items(C, A, l + 1, C.gw, C.NGW, false, true, false); } });
    }
#undef RUN
}

#ifdef PHASE_PROBE
#define PROBE_PRE extern __shared__ __attribute__((aligned(16))) unsigned char lds_raw[]; Ctx C; mkctx(C, (LAS unsigned char*)lds_raw); unsigned char* ws = A.ws; (void)ws;
__global__ void __launch_bounds__(NTHR, 2) pr_init(Args A) { PROBE_PRE phase_init(C, A); }
__global__ void __launch_bounds__(NTHR, 2) pr_conv(Args A) { PROBE_PRE phase_conv(C, A, A.lo); }
__global__ void __launch_bounds__(NTHR, 2) pr_modh(Args A) { PROBE_PRE phase_modh(C, A, A.lo); }
__global__ void __launch_bounds__(NTHR, 2) pr_ef1(Args A) { PROBE_PRE phase_ef1(C, A, A.lo); }
__global__ void __launch_bounds__(NTHR, 2) pr_scan(Args A) { PROBE_PRE phase_scan(C, A); }
__global__ void __launch_bounds__(NTHR, 2) pr_ef2(Args A) { PROBE_PRE phase_ef2(C, A, A.lo); }
__global__ void __launch_bounds__(NTHR, 2) pr_csa(Args A) { PROBE_PRE phase_csa(C, A); }
__global__ void __launch_bounds__(NTHR, 2) pr_csb(Args A) { PROBE_PRE phase_csb(C, A, A.lo); }
__global__ void __launch_bounds__(NTHR, 2) pr_of1(Args A) { PROBE_PRE phase_of1(C, A, A.lo); }
__global__ void __launch_bounds__(NTHR, 2) pr_attn(Args A) { PROBE_PRE phase_attn(C, A, A.lo); }
__global__ void __launch_bounds__(NTHR, 2) pr_rt(Args A) { PROBE_PRE phase_rt(C, A, A.lo); }
__global__ void __launch_bounds__(NTHR, 2) pr_tk(Args A) { PROBE_PRE phase_tk(C, A); }
__global__ void __launch_bounds__(NTHR, 2) pr_cb(Args A) { PROBE_PRE phase_cb(C, A, A.lo); }
__global__ void __launch_bounds__(NTHR, 2) pr_gemm_in(Args A) { PROBE_PRE pg8::Gemm g{(const bf16_t*)(ws + WS_H), (const bf16_t*)(ws + WS_WIN), DM}; pg8::Order<0> S; S.init(MROWS / 256, A.lo, C.G, (int)blockIdx.x, nullptr, 0);
                      pg8::EpiBf16 E{(bf16_t*)(ws + WS_P), P_LD}; pg8::gemm_phase(C.lds, g, S, E); }
__global__ void __launch_bounds__(NTHR, 2) pr_gemm_lora(Args A) { PROBE_PRE pg8::Gemm g{(const bf16_t*)(ws + WS_LIN), (const bf16_t*)(ws + WS_WLORA), LORA_K}; pg8::Order<0> S; S.init(MROWS / 256, LORA_N / 256, C.G, (int)blockIdx.x, nullptr, 0);
                          const int i2 = A.lo; pg8::EpiLora E{ws + WS_SCN, (bf16_t*)(ws + WS_G), A.in[I_D0] + (size_t)i2 * 2 * 768, A.in[I_A0] + (size_t)i2 * 2 * 768, A.in[I_KAL] + (size_t)i2 * 768};
                          pg8::gemm_phase(C.lds, g, S, E); }
__global__ void __launch_bounds__(NTHR, 2) pr_gemm_out(Args A) { PROBE_PRE pg8::Gemm g{(const bf16_t*)(ws + WS_A2), (const bf16_t*)(ws + WS_WOUT), DM}; pg8::Order<0> S; S.init(MROWS / 256, DM / 256, C.G, (int)blockIdx.x, nullptr, 0);
                      pg8::EpiRes E{(float*)(ws + WS_X), (const float*)(ws + WS_MOD), (const float*)(ws + WS_X), (const float*)(ws + WS_X) + (size_t)NLAT * DM}; pg8::gemm_phase(C.lds, g, S, E); }
__global__ void __launch_bounds__(NTHR, 2) pr_gemm_e1(Args A) { PROBE_PRE pg8::Gemm g{(const bf16_t*)(ws + WS_H), (const bf16_t*)(ws + WS_WE13), DM}; pg8::Order<1> S; S.init(NEXP * 17, 4096 / 256, C.G, (int)blockIdx.x, (const int*)(ws + WS_IDX), (long)4096 * DM);
                      pg8::EpiSwiGLU E{(bf16_t*)(ws + WS_HID)}; pg8::gemm_phase(C.lds, g, S, E); }
__global__ void __launch_bounds__(NTHR, 2) pr_gemm_e2(Args A) { PROBE_PRE pg8::Gemm g{(const bf16_t*)(ws + WS_HID), (const bf16_t*)(ws + WS_WE2), D_EXP}; pg8::Order<2> S; S.init(NEXP * 17, DM / 256, C.G, (int)blockIdx.x, nullptr, (long)DM * D_EXP);
                       pg8::EpiYE E{(bf16_t*)(ws + WS_YE), (const float*)(ws + WS_GATE)}; pg8::gemm_phase(C.lds, g, S, E); }
#endif

extern "C" void kernel_launch(void* const* d_in, const int* in_sizes, int n_in, void* d_out, int out_size, void* d_ws, size_t ws_size, hipStream_t stream) {
    static int grid = 0;
    if (grid == 0) {
        if (n_in != 37 || out_size != NLAT * DM || ws_size < WS_END) { fprintf(stderr, "kernel_launch: unexpected shapes: n_in %d out %d ws %zu (need %zu)\n", n_in, out_size, ws_size, (size_t)WS_END); grid = -1; return; }
        int dev = 0, cus = 0, per_cu = 0;
        if (hipGetDevice(&dev) != hipSuccess || hipDeviceGetAttribute(&cus, hipDeviceAttributeMultiprocessorCount, dev) != hipSuccess) { grid = -1; return; }
        if (hipFuncSetAttribute((const void*)mk_fwd, hipFuncAttributeMaxDynamicSharedMemorySize, LDS_BYTES) != hipSuccess) { fprintf(stderr, "kernel_launch: hipFuncSetAttribute failed\n"); grid = -1; return; }
        if (hipOccupancyMaxActiveBlocksPerMultiprocessor(&per_cu, (const void*)mk_fwd, NTHR, LDS_BYTES) != hipSuccess || per_cu < 1) fprintf(stderr, "kernel_launch: occupancy query reports %d\n", per_cu);
        (void)hipGetLastError();
        grid = cus;
    }
    if (grid < 0) return;
    (void)hipMemsetAsync((char*)d_ws + WS_CTL, 0, CTL_BYTES, stream);
    Args a{};
    for (int i = 0; i < 37; ++i) a.in[i] = (const float*)d_in[i];
    a.out = (float*)d_out; a.ws = (unsigned char*)d_ws;
#if MK_MULTI
    for (int k = 0; k < NSTEP; ++k) {
        if (k >= 1) { const int l = (k - 1) / NSLOT, s = (k - 1) % NSLOT; if ((l & 1) && ((s >= 4 && s <= 6) || (CHUNKED_SCAN && s == 0))) continue; if (!(l & 1) && !CHUNKED_SCAN && s == 5) continue; }
        a.lo = k; a.hi = k + 1;
        hipLaunchKernelGGL(mk_fwd, dim3(grid), dim3(NTHR), LDS_BYTES, stream, a);
    }
#else
    a.lo = 0; a.hi = NSTEP;
    hipLaunchKernelGGL(mk_fwd, dim3(grid), dim3(NTHR), LDS_BYTES, stream, a);
#endif
    const hipError_t le = hipPeekAtLastError();
    if (le != hipSuccess) fprintf(stderr, "kernel_launch: launch failed: %s\n", hipGetErrorName(le));
}
```
